# Optimizing an MI355X kernel written in HIP

```python
import math
import jax
import jax.numpy as jnp
from jax import lax
import numpy as np

D_MODEL = 2048
BATCH = 8
SEQ = 2048
DEPTH = 2

PLE_DIM = 256
N_EVEN = (DEPTH + 1) // 2
N_ODD = DEPTH // 2
CHUNK = 64
EPS = 1e-6

GLA_HEADS = 4
GLA_DV = D_MODEL // (2 * GLA_HEADS)
GLA_DK = GLA_DV // 2
GLA_GATE_RANK = 16
GLA_GATE_NORM = 16.0
GDN_DK = 128
GDN_DV = 128
GDN_HEADS = D_MODEL // (2 * GDN_DV)
CONV_K = 4
HGRN_DK = 128
HGRN_DV = 128
HGRN_HEADS = D_MODEL // (2 * HGRN_DV)
RWKV_HD = 64
RWKV_HEADS = D_MODEL // (2 * RWKV_HD)
RWKV_W_LORA = 96
RWKV_A_LORA = 96
RWKV_G_LORA = 256
RWKV_GN_EPS = 64e-5
PEER_HEADS = 8
PEER_DKEY = 256
PEER_NKEYS = 128
PEER_EXPERTS = PEER_NKEYS * PEER_NKEYS
PEER_TOPK = 16
PEER_BLOCK = 128

GLA_QK = GLA_HEADS * GLA_DK
GLA_VW = GLA_HEADS * GLA_DV
GDN_QK = GDN_HEADS * GDN_DK
GDN_VW = GDN_HEADS * GDN_DV
EVEN_COLS = (GLA_QK, GLA_QK, GLA_VW, GLA_VW, GLA_GATE_RANK, GDN_QK, GDN_QK, GDN_VW, GDN_VW, GDN_HEADS, GDN_HEADS)
EVEN_IN = sum(EVEN_COLS)
HG_W = HGRN_HEADS * HGRN_DK
HG_VW = HGRN_HEADS * HGRN_DV
RW_W = RWKV_HEADS * RWKV_HD
HGRN_COLS = (HG_W, HG_W, HG_VW, HG_VW)
RWKV_COLS = (RW_W, RW_W, RW_W, RWKV_W_LORA, RWKV_A_LORA, RWKV_G_LORA)
HGRN_IN = sum(HGRN_COLS)
RWKV_IN = sum(RWKV_COLS)
ODD_IN = HGRN_IN + RWKV_IN

kernel_name = 'hybrid_gla_gdn_hgrn2_rwkv7_peer_trunk'


def rmsnorm(x, g):
    x32 = x.astype(jnp.float32)
    y = x32 * lax.rsqrt(jnp.mean(x32 * x32, axis=-1, keepdims=True) + EPS)
    return (y * g.astype(jnp.float32)).astype(x.dtype)


def gated_rmsnorm(o, z, g):
    o = o * lax.rsqrt(jnp.mean(o * o, axis=-1, keepdims=True) + EPS)
    return o * g.astype(jnp.float32) * jax.nn.silu(z)


def l2norm(t):
    return t * lax.rsqrt(jnp.sum(t * t, axis=-1, keepdims=True) + EPS)


def split_cols(t, sizes):
    return jnp.split(t, np.cumsum(sizes)[:-1].tolist(), axis=-1)


def to_heads(t, n_heads):
    B, S, _ = t.shape
    return t.reshape(B, S, n_heads, -1).transpose(0, 2, 1, 3)


def from_heads(t):
    B, H, S, d = t.shape
    return t.transpose(0, 2, 1, 3).reshape(B, S, H * d)


def causal_dwconv(x, w):
    return lax.conv_general_dilated(x, w[:, None, :], window_strides=(1,), padding=[(w.shape[0] - 1, 0)],
                                    dimension_numbers=('NWC', 'WIO', 'NWC'), feature_group_count=x.shape[-1])


def token_shift(t, mu):
    prev = jnp.pad(t, ((0, 0), (1, 0), (0, 0)))[:, :-1]
    return t + (prev - t) * mu


def chunk_gla(q, k, v, log_g):
    f32 = jnp.float32
    B, H, S, dk = q.shape
    dv = v.shape[-1]
    n = S // CHUNK

    def to_chunks(t):
        return jnp.moveaxis(t.astype(f32).reshape(B, H, n, CHUNK, t.shape[-1]), 2, 0)

    causal = jnp.tril(jnp.ones((CHUNK, CHUNK), dtype=bool))[:, :, None]

    def step(state, inp):
        qc, kc, vc, gc = inp
        b = jnp.cumsum(gc, axis=2)
        diff = b[:, :, :, None, :] - b[:, :, None, :, :]
        decay = jnp.where(causal, jnp.exp(jnp.where(causal, diff, 0.0)), 0.0)
        attn = jnp.einsum('bhtd,bhsd,bhtsd->bhts', qc, kc, decay)
        o = jnp.einsum('bhtd,bhde->bhte', qc * jnp.exp(b), state) + jnp.einsum('bhts,bhse->bhte', attn, vc)
        b_last = b[:, :, -1:, :]
        state = state * jnp.exp(b_last[:, :, 0, :, None]) + jnp.einsum('bhsd,bhse->bhde', kc * jnp.exp(b_last - b), vc)
        return state, o

    _, o = lax.scan(step, jnp.zeros((B, H, dk, dv), f32), tuple(map(to_chunks, (q, k, v, log_g))))
    return jnp.moveaxis(o, 0, 2).reshape(B, H, S, dv)


def chunk_gated_delta(q, k, v, log_a, beta):
    f32 = jnp.float32
    B, H, S, dk = q.shape
    dv = v.shape[-1]
    n = S // CHUNK

    def rs(t):
        return t.astype(f32).reshape((B, H, n, CHUNK) + t.shape[3:])

    q, k, v, log_a, beta = rs(q), rs(k), rs(v), rs(log_a), rs(beta)
    b = jnp.cumsum(log_a, axis=-1)
    causal = jnp.tril(jnp.ones((CHUNK, CHUNK), dtype=bool))
    strict = jnp.tril(jnp.ones((CHUNK, CHUNK), dtype=bool), -1)
    diff = b[..., :, None] - b[..., None, :]
    L = jnp.where(causal, jnp.exp(jnp.where(causal, diff, 0.0)), 0.0)
    kb = k * beta[..., None]
    A = jnp.where(strict, jnp.einsum('bhntd,bhnsd->bhnts', kb, k) * L, 0.0)
    eye = jnp.eye(CHUNK, dtype=f32)
    T = lax.linalg.triangular_solve(eye + A, jnp.broadcast_to(eye, A.shape), left_side=True, lower=True,
                                    unit_diagonal=True)
    u = T @ (v * beta[..., None])
    w = T @ (kb * jnp.exp(b)[..., None])
    qk = jnp.einsum('bhntd,bhnsd->bhnts', q, k) * L

    def step(state, inp):
        qc, kc, uc, wc, qkc, bc = inp
        v_new = uc - wc @ state
        o = (qc * jnp.exp(bc)[..., None]) @ state + qkc @ v_new
        b_last = bc[..., -1:]
        state = state * jnp.exp(b_last)[..., None] + jnp.einsum('bhsd,bhse->bhde', kc * jnp.exp(b_last - bc)[..., None], v_new)
        return state, o

    xs = tuple(jnp.moveaxis(t, 2, 0) for t in (q, k, u, w, qk, b))
    _, o = lax.scan(step, jnp.zeros((B, H, dk, dv), f32), xs)
    return jnp.moveaxis(o, 0, 2).reshape(B, H, S, dv)


def rwkv7_scan(r, log_w, k, v, kk, a):
    B, S, H, N = r.shape

    def step(state, inp):
        r_t, w_t, k_t, v_t, kk_t, a_t = inp
        sa = jnp.einsum('bhvk,bhk->bhv', state, kk_t)
        state = (state * jnp.exp(w_t)[:, :, None, :]
                 - sa[..., None] * (kk_t * a_t)[:, :, None, :]
                 + v_t[..., None] * k_t[:, :, None, :])
        return state, jnp.einsum('bhvk,bhk->bhv', state, r_t)

    xs = tuple(jnp.moveaxis(t, 1, 0) for t in (r, log_w, k, v, kk, a))
    _, o = lax.scan(step, jnp.zeros((B, H, N, N), jnp.float32), xs)
    return jnp.moveaxis(o, 0, 1)


def even_mixer(hn, w_in, gk_w2, gk_b, gla_norm, conv_w, a_log, dt_bias, gdn_norm, w_out):
    f32 = jnp.float32
    proj = (hn @ w_in).astype(f32)
    gq, gk, gv, gz, glr, bq, bk, bv, bz, ba, bb = split_cols(proj, EVEN_COLS)
    log_g = jax.nn.log_sigmoid(glr @ gk_w2.astype(f32) + gk_b.astype(f32)) / GLA_GATE_NORM
    o_a = chunk_gla(to_heads(gq, GLA_HEADS) * GLA_DK ** -0.5, to_heads(gk, GLA_HEADS),
                    to_heads(gv, GLA_HEADS), to_heads(log_g, GLA_HEADS))
    o_a = from_heads(gated_rmsnorm(o_a, to_heads(gz, GLA_HEADS), gla_norm))
    qkv = jax.nn.silu(causal_dwconv(jnp.concatenate([bq, bk, bv], axis=-1), conv_w.astype(f32)))
    cq, ck, cv = split_cols(qkv, (GDN_QK, GDN_QK, GDN_VW))
    log_a = (-jnp.exp(a_log.astype(f32)) * jax.nn.softplus(ba + dt_bias.astype(f32))).transpose(0, 2, 1)
    beta = jax.nn.sigmoid(bb).transpose(0, 2, 1)
    o_b = chunk_gated_delta(l2norm(to_heads(cq, GDN_HEADS)) * GDN_DK ** -0.5, l2norm(to_heads(ck, GDN_HEADS)),
                            to_heads(cv, GDN_HEADS), log_a, beta)
    o_b = from_heads(gated_rmsnorm(o_b, to_heads(bz, GDN_HEADS), gdn_norm))
    y = jnp.concatenate([o_a, o_b], axis=-1)
    return y.astype(w_out.dtype) @ w_out


def odd_mixer(hn, w_in, lb, hg_norm, mu, w0, w2, a0, a2, g2, k_k, k_a, r_k, ln_w, ln_b, w_out):
    f32 = jnp.float32
    B, S, _ = hn.shape
    proj = (hn @ w_in).astype(f32)
    hq, hf, hi, hg = split_cols(proj[..., :HGRN_IN], HGRN_COLS)
    lb = lb.astype(f32)
    fgate = lb + (1.0 - lb) * jax.nn.sigmoid(hf)
    o_h = chunk_gla(to_heads(jax.nn.silu(hq), HGRN_HEADS), to_heads(1.0 - fgate, HGRN_HEADS),
                    to_heads(hi, HGRN_HEADS), to_heads(jnp.log(fgate), HGRN_HEADS))
    o_h = from_heads(gated_rmsnorm(o_h, to_heads(hg, HGRN_HEADS), hg_norm))
    def hs(t):
        return t.reshape(B, S, RWKV_HEADS, RWKV_HD)
    r, k, v, w_lr, a_lr, g_lr = split_cols(token_shift(proj[..., HGRN_IN:], mu.astype(f32)), RWKV_COLS)
    log_w = -jnp.exp(-jax.nn.softplus(-(w0.astype(f32) + jnp.tanh(w_lr) @ w2.astype(f32))) - 0.5)
    a = jax.nn.sigmoid(a0.astype(f32) + a_lr @ a2.astype(f32))
    g = jax.nn.sigmoid(g_lr) @ g2.astype(f32)
    kk = l2norm(hs(k * k_k.astype(f32)))
    k = k * (1.0 + (a - 1.0) * k_a.astype(f32))
    rh, kh, vh = hs(r), hs(k), hs(v)
    o = rwkv7_scan(rh, hs(log_w), kh, vh, kk, hs(a))
    mean = jnp.mean(o, axis=-1, keepdims=True)
    var = jnp.mean(jnp.square(o - mean), axis=-1, keepdims=True)
    o = ((o - mean) * lax.rsqrt(var + RWKV_GN_EPS)).reshape(B, S, RW_W) * ln_w.astype(f32) + ln_b.astype(f32)
    bonus = jnp.sum(rh * kh * r_k.astype(f32), axis=-1, keepdims=True) * vh
    o_r = (o + bonus.reshape(B, S, RW_W)) * g
    y = jnp.concatenate([o_h, o_r], axis=-1)
    return y.astype(w_out.dtype) @ w_out


def peer(hn, w_q, sub_keys, u, v):
    B, S, D = hn.shape
    T = B * S
    half = PEER_DKEY // 2
    x = hn.reshape(T, D)
    q = (x @ w_q).astype(jnp.float32).reshape(T, PEER_HEADS, 2, half)
    scores = jnp.einsum('thpd,hpnd->thpn', q, sub_keys.astype(jnp.float32))
    sv, si = lax.top_k(scores, PEER_TOPK)
    kk2 = PEER_TOPK * PEER_TOPK
    cand_s = (sv[:, :, 0, :, None] + sv[:, :, 1, None, :]).reshape(T, PEER_HEADS, kk2)
    cand_i = (si[:, :, 0, :, None] * PEER_NKEYS + si[:, :, 1, None, :]).reshape(T, PEER_HEADS, kk2)
    best_s, pos = lax.top_k(cand_s, PEER_TOPK)
    idx = jnp.take_along_axis(cand_i, pos, axis=-1)
    gate = jax.nn.softmax(best_s, axis=-1)
    nb = T // PEER_BLOCK

    def block(args):
        xb, ib, gb = args
        act = jax.nn.gelu(jnp.einsum('td,thkd->thk', xb, jnp.take(u, ib, axis=0)).astype(jnp.float32),
                          approximate=False)
        return jnp.einsum('thk,thkd->td', (gb * act).astype(v.dtype), jnp.take(v, ib, axis=0))

    out = lax.map(block, (x.reshape(nb, PEER_BLOCK, D),
                          idx.reshape(nb, PEER_BLOCK, PEER_HEADS, PEER_TOPK),
                          gate.reshape(nb, PEER_BLOCK, PEER_HEADS, PEER_TOPK)))
    return out.reshape(B, S, D)


def setup_inputs(seed: int = 0) -> dict:
    key = jax.random.key(seed)
    ks = iter(jax.random.split(key, 48))
    f32 = jnp.float32
    D = D_MODEL

    def nrm(shape, scale):
        return jax.random.normal(next(ks), shape, f32) * scale

    def unif(shape, lo, hi):
        return jax.random.uniform(next(ks), shape, f32, lo, hi)

    x = nrm((BATCH, SEQ, D), 1.0)
    p = nrm((DEPTH, BATCH, SEQ, PLE_DIM), 1.0)
    ev_w_in = nrm((N_EVEN, D, EVEN_IN), D ** -0.5)
    ev_gla_gk_w2 = nrm((N_EVEN, GLA_GATE_RANK, GLA_QK), GLA_GATE_RANK ** -0.5)
    ev_gla_gk_b = nrm((N_EVEN, GLA_QK), 0.1)
    ev_gla_norm = 1.0 + nrm((N_EVEN, GLA_DV), 0.02)
    ev_gdn_conv = nrm((N_EVEN, CONV_K, 2 * GDN_QK + GDN_VW), CONV_K ** -0.5)
    ev_gdn_a_log = jnp.log(unif((N_EVEN, GDN_HEADS), 1.0, 16.0))
    dt = jnp.exp(unif((N_EVEN, GDN_HEADS), math.log(1e-3), math.log(1e-1)))
    ev_gdn_dt_bias = dt + jnp.log(-jnp.expm1(-dt))
    ev_gdn_norm = 1.0 + nrm((N_EVEN, GDN_DV), 0.02)
    ev_w_out = nrm((N_EVEN, D, D), D ** -0.5)
    od_w_in = nrm((N_ODD, D, ODD_IN), D ** -0.5)
    hgrn_lb_logits = nrm((DEPTH, HG_W), 1.0)
    od_hgrn_norm = 1.0 + nrm((N_ODD, HGRN_DV), 0.02)
    od_rwkv_mu = unif((N_ODD, RWKV_IN), 0.0, 1.0)
    od_rwkv_w0 = -2.5 + nrm((N_ODD, RW_W), 0.5)
    od_rwkv_w2 = nrm((N_ODD, RWKV_W_LORA, RW_W), 0.1)
    od_rwkv_a0 = nrm((N_ODD, RW_W), 0.1)
    od_rwkv_a2 = nrm((N_ODD, RWKV_A_LORA, RW_W), RWKV_A_LORA ** -0.5)
    od_rwkv_g2 = nrm((N_ODD, RWKV_G_LORA, RW_W), RWKV_G_LORA ** -0.5)
    od_rwkv_k_k = 0.85 + nrm((N_ODD, RW_W), 0.02)
    od_rwkv_k_a = 1.0 + nrm((N_ODD, RW_W), 0.02)
    od_rwkv_r_k = nrm((N_ODD, RWKV_HEADS, RWKV_HD), 0.1)
    od_rwkv_ln_w = 1.0 + nrm((N_ODD, RW_W), 0.02)
    od_rwkv_ln_b = nrm((N_ODD, RW_W), 0.02)
    od_w_out = nrm((N_ODD, D, D), D ** -0.5)
    norm_mix = 1.0 + nrm((DEPTH, D), 0.02)
    norm_ffn = 1.0 + nrm((DEPTH, D), 0.02)
    norm_ple = 1.0 + nrm((DEPTH, D), 0.02)
    peer_w_q = nrm((DEPTH, D, PEER_HEADS * PEER_DKEY), D ** -0.5)
    peer_sub_keys = nrm((DEPTH, PEER_HEADS, 2, PEER_NKEYS, PEER_DKEY // 2), (PEER_DKEY // 2) ** -0.5)
    peer_u = nrm((DEPTH, PEER_EXPERTS, D), D ** -0.5)
    peer_v = nrm((DEPTH, PEER_EXPERTS, D), PEER_HEADS ** -0.5)
    ple_w_proj = nrm((DEPTH, PLE_DIM, D), PLE_DIM ** -0.5)
    ple_w_gate = nrm((DEPTH, D, D), D ** -0.5)
    norm_final = 1.0 + nrm((D,), 0.02)
    return {'x': x, 'p': p, 'ev_w_in': ev_w_in, 'ev_gla_gk_w2': ev_gla_gk_w2, 'ev_gla_gk_b': ev_gla_gk_b,
            'ev_gla_norm': ev_gla_norm, 'ev_gdn_conv': ev_gdn_conv, 'ev_gdn_a_log': ev_gdn_a_log,
            'ev_gdn_dt_bias': ev_gdn_dt_bias, 'ev_gdn_norm': ev_gdn_norm, 'ev_w_out': ev_w_out,
            'od_w_in': od_w_in, 'hgrn_lb_logits': hgrn_lb_logits, 'od_hgrn_norm': od_hgrn_norm,
            'od_rwkv_mu': od_rwkv_mu, 'od_rwkv_w0': od_rwkv_w0, 'od_rwkv_w2': od_rwkv_w2,
            'od_rwkv_a0': od_rwkv_a0, 'od_rwkv_a2': od_rwkv_a2, 'od_rwkv_g2': od_rwkv_g2,
            'od_rwkv_k_k': od_rwkv_k_k, 'od_rwkv_k_a': od_rwkv_k_a, 'od_rwkv_r_k': od_rwkv_r_k,
            'od_rwkv_ln_w': od_rwkv_ln_w, 'od_rwkv_ln_b': od_rwkv_ln_b, 'od_w_out': od_w_out,
            'norm_mix': norm_mix, 'norm_ffn': norm_ffn, 'norm_ple': norm_ple, 'peer_w_q': peer_w_q,
            'peer_sub_keys': peer_sub_keys, 'peer_u': peer_u, 'peer_v': peer_v,
            'ple_w_proj': ple_w_proj, 'ple_w_gate': ple_w_gate, 'norm_final': norm_final}


def reference(x, p, ev_w_in, ev_gla_gk_w2, ev_gla_gk_b, ev_gla_norm, ev_gdn_conv, ev_gdn_a_log,
              ev_gdn_dt_bias, ev_gdn_norm, ev_w_out, od_w_in, hgrn_lb_logits, od_hgrn_norm,
              od_rwkv_mu, od_rwkv_w0, od_rwkv_w2, od_rwkv_a0, od_rwkv_a2, od_rwkv_g2,
              od_rwkv_k_k, od_rwkv_k_a, od_rwkv_r_k, od_rwkv_ln_w, od_rwkv_ln_b, od_w_out,
              norm_mix, norm_ffn, norm_ple, peer_w_q, peer_sub_keys, peer_u, peer_v,
              ple_w_proj, ple_w_gate, norm_final):
    f32 = jnp.float32
    sm = jax.nn.softmax(hgrn_lb_logits.astype(f32), axis=0)
    lower_bounds = jnp.cumsum(sm, axis=0) - sm[0]
    h = x
    for i in range(DEPTH):
        j = i // 2
        hn = rmsnorm(h, norm_mix[i])
        if i % 2 == 0:
            y = even_mixer(hn, ev_w_in[j], ev_gla_gk_w2[j], ev_gla_gk_b[j], ev_gla_norm[j], ev_gdn_conv[j],
                           ev_gdn_a_log[j], ev_gdn_dt_bias[j], ev_gdn_norm[j], ev_w_out[j])
        else:
            y = odd_mixer(hn, od_w_in[j], lower_bounds[i], od_hgrn_norm[j], od_rwkv_mu[j], od_rwkv_w0[j],
                          od_rwkv_w2[j], od_rwkv_a0[j], od_rwkv_a2[j], od_rwkv_g2[j], od_rwkv_k_k[j],
                          od_rwkv_k_a[j], od_rwkv_r_k[j], od_rwkv_ln_w[j], od_rwkv_ln_b[j], od_w_out[j])
        h = h + y.astype(h.dtype)
        h = h + peer(rmsnorm(h, norm_ffn[i]), peer_w_q[i], peer_sub_keys[i], peer_u[i], peer_v[i]).astype(h.dtype)
        gate = jax.nn.sigmoid((rmsnorm(h, norm_ple[i]) @ ple_w_gate[i]).astype(f32))
        h = h + (gate * (p[i] @ ple_w_proj[i]).astype(f32)).astype(h.dtype)
    return rmsnorm(h, norm_final)
```

```cpp
#include <hip/hip_runtime.h>
#include <hip/hip_cooperative_groups.h>
#include <cstdio>
#include <cstdint>
namespace cg = cooperative_groups;

#ifndef MK_PER_PHASE
#define MK_PER_PHASE 1
#endif

namespace pg8 {
#define PG8_LAS __attribute__((address_space(3)))
typedef unsigned short bf16_t;
typedef short bf16x8 __attribute__((ext_vector_type(8)));
typedef float f32x4 __attribute__((ext_vector_type(4)));
typedef unsigned u32x4 __attribute__((ext_vector_type(4)));
typedef unsigned u32x2 __attribute__((ext_vector_type(2)));
constexpr int BM = 256, BK = 64, HALF = 128, HTB = HALF * BK * 2  , STAGE_BYTES = 8 * HTB, NXCD = 8, WGM = 8;

__host__ __device__ __forceinline__ int lds_byte(int r, int c) { const int st = (r >> 4) * 2 + (c >> 5), rr = r & 15, cc = c & 31, ob = rr * 64 + cc * 2; return st * 1024 + (ob ^ (((ob >> 9) & 1) << 5)); }
__host__ __device__ __forceinline__ void stage_rc(int b, int& R, int& C) { const int st = b / 1024, sb = b % 1024, swz = sb ^ (((sb >> 9) & 1) << 5); R = (st >> 1) * 16 + swz / 64; C = (st & 1) * 32 + (swz % 64) / 2; }
__host__ __device__ __forceinline__ int perm32(int rho) { const int n = rho >> 4, i = rho & 15; return 8 * (i >> 2) + 4 * n + (i & 3); }

struct Unit { int pm, pn; };
struct Gemm { const bf16_t* A; const bf16_t* Bt; int M, N, K; };

struct StaticOrder {
    int nM, nN, nwg, G, c;
    __host__ __device__ void init(int M, int N, int G_, int c_) { nM = M / BM; nN = N / BM; nwg = nM * nN; G = G_; c = c_; }
    __host__ __device__ bool next(int i, Unit& u) const {
        const long L = (long)i * G + c; if (L >= nwg) return false;
        int wgid = (int)L; { const int q = nwg / NXCD, r = nwg % NXCD, xcd = wgid % NXCD, off = wgid / NXCD; wgid = (xcd < r ? xcd * (q + 1) : r * (q + 1) + (xcd - r) * q) + off; }
        const int nig = WGM * nN, gid = wgid / nig, fm = gid * WGM, gsz = (nM - fm) < WGM ? (nM - fm) : WGM;
        u.pm = fm + ((wgid % nig) % gsz); u.pn = (wgid % nig) / gsz; return true;
    }
    __device__ __forceinline__ void a_ready(const Unit&) const {}
    __device__ __forceinline__ void done(const Unit&) const {}
};
__device__ __forceinline__ unsigned cvt_pk_bf16(float lo, float hi) { unsigned r; asm volatile("v_cvt_pk_bf16_f32 %0, %1, %2" : "=v"(r) : "v"(lo), "v"(hi)); return r; }
template <class Epi, class Sched, bool ALIGN_EPI = false, bool SP2 = false>
__device__ __forceinline__ void gemm_phase(PG8_LAS unsigned char* lds, const Gemm g, const Sched& S, const Epi& E) {
    const int tid = threadIdx.x, wid = __builtin_amdgcn_readfirstlane(tid >> 6), lane = tid & 63, wr = wid >> 2, wc = wid & 3, fr = lane & 15, fq = lane >> 4;
    const int K = g.K, nt = K / BK;
    unsigned voffA[2], voffB[2];
#pragma unroll
    for (int i = 0; i < 2; ++i) { int R, C; stage_rc(tid * 16 + i * 8192, R, C); const int Rb = Epi::PERM ? ((R & ~31) + perm32(R & 31)) : R;
        voffA[i] = (unsigned)(R * K + C) * 2u; voffB[i] = (unsigned)(Rb * K + C) * 2u; }
    const size_t kstep = (size_t)(BK * 2);
    const size_t hstep = (size_t)HALF * K * 2;
    const size_t tstep = 2 * hstep;
    const unsigned ldsw = (unsigned)wid * 1024u;
    const int aoff = lds_byte(wr * 64 + fr, fq * 8), boff = lds_byte(wc * 32 + fr, fq * 8);
#define PG8_SA(b, h) (((b) * 2 + (h)) * HTB)
#define PG8_SB(b, h) ((4 + (b) * 2 + (h)) * HTB)
#define PG8_STAGE(bufoff, gbase, voff) do { _Pragma("unroll") for (int _i = 0; _i < 2; ++_i) \
        __builtin_amdgcn_global_load_lds((const unsigned*)((const char*)(gbase) + (voff)[_i]), (PG8_LAS unsigned*)(lds + (bufoff) + ldsw + _i * 8192), 16, 0, 0); } while (0)
#define PG8_LDA(dst, b, h) do { _Pragma("unroll") for (int m = 0; m < 4; ++m) _Pragma("unroll") for (int k = 0; k < 2; ++k) dst[m][k] = *(const PG8_LAS bf16x8*)(lds + PG8_SA(b, h) + aoff + m * 2048 + k * 1024); } while (0)
#define PG8_LDB(dst, b, h) do { _Pragma("unroll") for (int n = 0; n < 2; ++n) _Pragma("unroll") for (int k = 0; k < 2; ++k) dst[n][k] = *(const PG8_LAS bf16x8*)(lds + PG8_SB(b, h) + boff + n * 2048 + k * 1024); } while (0)
#define PG8_MMA(ai, bj, At, Bt) do { __builtin_amdgcn_s_setprio(1); _Pragma("unroll") for (int m = 0; m < 4; ++m) _Pragma("unroll") for (int n = 0; n < 2; ++n) _Pragma("unroll") for (int k = 0; k < 2; ++k) \
        acc[ai][bj][m][n] = __builtin_amdgcn_mfma_f32_16x16x32_bf16(Bt[n][k], At[m][k], acc[ai][bj][m][n], 0, 0, 0); __builtin_amdgcn_s_setprio(0); } while (0)
#define PG8_WAIT_V(n) asm volatile("s_waitcnt vmcnt(" #n ")" ::: "memory")
#define PG8_WAIT_L(n) asm volatile("s_waitcnt lgkmcnt(" #n ")" ::: "memory")
#define PG8_BAR __builtin_amdgcn_s_barrier()
#define PG8_SCHED __builtin_amdgcn_sched_barrier(0)
    Unit cur, nxt; int ui = 0;
    if (!S.next(0, cur)) return;
    f32x4 acc[2][2][4][2];
#pragma unroll
    for (int a = 0; a < 2; ++a)
#pragma unroll
        for (int b = 0; b < 2; ++b)
#pragma unroll
            for (int m = 0; m < 4; ++m)
#pragma unroll
                for (int n = 0; n < 2; ++n) acc[a][b][m][n] = (f32x4){0.f, 0.f, 0.f, 0.f};
    bf16x8 At[4][2], B0[2][2], B1[2][2];
    const char* cA = (const char*)g.A + (size_t)cur.pm * tstep; const char* cB = (const char*)g.Bt + (size_t)cur.pn * tstep;
    S.a_ready(cur);
    if constexpr (SP2) {
        PG8_STAGE(PG8_SB(0, 0), cB, voffB); PG8_STAGE(PG8_SB(0, 1), cB + hstep, voffB); PG8_STAGE(PG8_SA(0, 0), cA, voffA); PG8_STAGE(PG8_SA(0, 1), cA + hstep, voffA);
        if (wr == 1) PG8_BAR;
        PG8_WAIT_V(2); PG8_BAR;
        PG8_STAGE(PG8_SB(1, 0), cB + kstep, voffB); PG8_STAGE(PG8_SA(1, 0), cA + kstep, voffA); PG8_STAGE(PG8_SB(1, 1), cB + hstep + kstep, voffB);
        PG8_WAIT_V(6); PG8_BAR;
    } else {
        PG8_STAGE(PG8_SB(0, 0), cB, voffB); PG8_STAGE(PG8_SA(0, 0), cA, voffA); PG8_STAGE(PG8_SB(0, 1), cB + hstep, voffB); PG8_STAGE(PG8_SA(0, 1), cA + hstep, voffA);
        if (wr == 1) PG8_BAR;
        PG8_WAIT_V(4); PG8_BAR;
        PG8_STAGE(PG8_SB(1, 0), cB + kstep, voffB); PG8_STAGE(PG8_SA(1, 0), cA + kstep, voffA); PG8_STAGE(PG8_SB(1, 1), cB + hstep + kstep, voffB);
        PG8_WAIT_V(6); PG8_BAR;
    }
    for (;;) {
        const bool has_next = S.next(ui + 1, nxt);
        const char* nA = has_next ? (const char*)g.A + (size_t)nxt.pm * tstep : cA; const char* nB = has_next ? (const char*)g.Bt + (size_t)nxt.pn * tstep : cB;
        for (int t = 0; t < nt; t += 2) {
            const bool last = (t == nt - 2);
            const char* a1 = cA + (size_t)(t + 1) * kstep;
            const char* a2 = last ? nA : cA + (size_t)(t + 2) * kstep; const char* b2 = last ? nB : cB + (size_t)(t + 2) * kstep;
            const char* a3 = a2 + kstep; const char* b3 = b2 + kstep;
            if (last && has_next) S.a_ready(nxt);
            if constexpr (SP2) {
            PG8_LDB(B0, 0, 0); PG8_LDB(B1, 0, 1); PG8_SCHED; PG8_LDA(At, 0, 0); PG8_STAGE(PG8_SA(1, 1), a1 + hstep, voffA);
            PG8_WAIT_V(8); PG8_WAIT_L(0); PG8_BAR; PG8_MMA(0, 0, At, B0); PG8_MMA(0, 1, At, B1); PG8_BAR; PG8_SCHED;
            PG8_LDA(At, 0, 1); PG8_STAGE(PG8_SB(0, 0), b2, voffB); PG8_STAGE(PG8_SB(0, 1), b2 + hstep, voffB); PG8_STAGE(PG8_SA(0, 0), a2, voffA);
            PG8_WAIT_V(8); PG8_WAIT_L(0); PG8_BAR; PG8_MMA(1, 0, At, B0); PG8_MMA(1, 1, At, B1); PG8_BAR; PG8_SCHED;
            PG8_LDB(B0, 1, 0); PG8_LDB(B1, 1, 1); PG8_SCHED; PG8_LDA(At, 1, 0); PG8_STAGE(PG8_SA(0, 1), a2 + hstep, voffA);
            PG8_WAIT_V(8); PG8_WAIT_L(0); PG8_BAR; PG8_MMA(0, 0, At, B0); PG8_MMA(0, 1, At, B1); PG8_BAR; PG8_SCHED;
            PG8_LDA(At, 1, 1); PG8_STAGE(PG8_SB(1, 0), b3, voffB); PG8_STAGE(PG8_SB(1, 1), b3 + hstep, voffB); PG8_STAGE(PG8_SA(1, 0), a3, voffA);
            PG8_WAIT_V(8); PG8_WAIT_L(0); PG8_BAR; PG8_MMA(1, 0, At, B0); PG8_MMA(1, 1, At, B1); PG8_BAR; PG8_SCHED;
            } else {
            PG8_LDB(B0, 0, 0); PG8_SCHED; PG8_LDA(At, 0, 0); PG8_STAGE(PG8_SA(1, 1), a1 + hstep, voffA);
            PG8_WAIT_L(8); PG8_BAR; PG8_WAIT_L(0); PG8_MMA(0, 0, At, B0); PG8_BAR; PG8_SCHED;
            PG8_LDB(B1, 0, 1); PG8_STAGE(PG8_SB(0, 0), b2, voffB);
            PG8_BAR; PG8_WAIT_L(0); PG8_MMA(0, 1, At, B1); PG8_BAR;
            PG8_LDA(At, 0, 1); PG8_STAGE(PG8_SA(0, 0), a2, voffA);
            PG8_BAR; PG8_WAIT_L(0); PG8_MMA(1, 0, At, B0); PG8_BAR; PG8_SCHED;
            PG8_STAGE(PG8_SB(0, 1), b2 + hstep, voffB);
            PG8_WAIT_V(6); PG8_BAR; PG8_MMA(1, 1, At, B1); PG8_BAR;
            PG8_LDB(B0, 1, 0); PG8_SCHED; PG8_LDA(At, 1, 0); PG8_STAGE(PG8_SA(0, 1), a2 + hstep, voffA);
            PG8_WAIT_L(8); PG8_BAR; PG8_WAIT_L(0); PG8_MMA(0, 0, At, B0); PG8_BAR; PG8_SCHED;
            PG8_LDB(B1, 1, 1); PG8_STAGE(PG8_SB(1, 0), b3, voffB);
            PG8_BAR; PG8_WAIT_L(0); PG8_MMA(0, 1, At, B1); PG8_BAR;
            PG8_LDA(At, 1, 1); PG8_STAGE(PG8_SA(1, 0), a3, voffA);
            PG8_BAR; PG8_WAIT_L(0); PG8_MMA(1, 0, At, B0); PG8_BAR; PG8_SCHED;
            PG8_STAGE(PG8_SB(1, 1), b3 + hstep, voffB);
            PG8_WAIT_V(6); PG8_BAR; PG8_MMA(1, 1, At, B1); PG8_BAR;
            }
        }
        if constexpr (ALIGN_EPI) { if (wr == 0) PG8_BAR; }
        if constexpr (!Epi::AFTER_DRAIN) { E(acc, cur, wr, wc, fr, fq); S.done(cur); }
        if (!has_next) break;
#pragma unroll
        for (int a = 0; a < 2; ++a)
#pragma unroll
            for (int b = 0; b < 2; ++b)
#pragma unroll
                for (int m = 0; m < 4; ++m)
#pragma unroll
                    for (int n = 0; n < 2; ++n) acc[a][b][m][n] = (f32x4){0.f, 0.f, 0.f, 0.f};
        cur = nxt; cA = nA; cB = nB; ++ui;
        if constexpr (ALIGN_EPI) { if (wr == 1) PG8_BAR; }
    }
    PG8_WAIT_V(0);
    if constexpr (!ALIGN_EPI) { if (wr == 0) PG8_BAR; }
    PG8_BAR;
    if constexpr (Epi::AFTER_DRAIN) { E.fused(acc, cur, wr, wc, fr, fq, lds, wid, lane); S.done(cur); }
#undef PG8_SA
#undef PG8_SB
#undef PG8_STAGE
#undef PG8_LDA
#undef PG8_LDB
#undef PG8_MMA
#undef PG8_WAIT_V
#undef PG8_WAIT_L
#undef PG8_BAR
#undef PG8_SCHED
}
}
#define GAS __attribute__((address_space(1)))
#define LAS __attribute__((address_space(3)))
typedef unsigned short bf16;
typedef unsigned v4u __attribute__((ext_vector_type(4)));
typedef float f32x4 __attribute__((ext_vector_type(4)));
typedef short bf16x8 __attribute__((ext_vector_type(8)));
typedef GAS unsigned gu32;
typedef GAS unsigned long long gu64;
#define RLX_AGENT __ATOMIC_RELAXED, __HIP_MEMORY_SCOPE_AGENT
#define LDS_WAIT() asm volatile("s_waitcnt lgkmcnt(0)" ::: "memory")
#define VM_WAIT() asm volatile("s_waitcnt vmcnt(0)" ::: "memory")
__device__ __forceinline__ unsigned long long rt() { return __builtin_amdgcn_s_memrealtime(); }
__device__ __forceinline__ unsigned f2bf(float f) { unsigned u = __builtin_bit_cast(unsigned, f); return (u + 0x7fffu + ((u >> 16) & 1u)) >> 16; }
__device__ __forceinline__ unsigned pk2(float lo, float hi) { return f2bf(lo) | (f2bf(hi) << 16); }

#define XB_TMO      128
#define XB_XCNT(j)  (256  + 64 * (j))
#define XB_XSUB(j)  (1280 + 64 * (j))
#define XB_XGEN(j)  (2304 + 64 * (j))
#define XB_TOP      3328
#define XB_TOPGEN   3392
#define XCD_BAR_WORDS 3456
#define XB_SPIN_CAP (1u << 18)

__device__ __forceinline__ unsigned xb_ld(unsigned* p)              { return __hip_atomic_load(p, __ATOMIC_RELAXED, __HIP_MEMORY_SCOPE_AGENT); }
__device__ __forceinline__ unsigned xb_add(unsigned* p, unsigned v) { return __hip_atomic_fetch_add(p, v, __ATOMIC_RELAXED, __HIP_MEMORY_SCOPE_AGENT); }
__device__ __forceinline__ unsigned xb_xcc_id() { return (unsigned)__builtin_amdgcn_s_getreg((3 << 11) | 20) & 0xFu; }
#define XB_SPIN(cond, bar) do { unsigned _sp = 0; while (cond) { __builtin_amdgcn_s_sleep(1); \
    if ((++_sp & 255u) == 0u) { if (xb_ld(&(bar)[XB_TMO])) break; if (_sp > XB_SPIN_CAP) { atomicAdd(&(bar)[XB_TMO], 1u); break; } } } } while (0)

struct XcdBarrier {
    unsigned* bar; unsigned x;
    volatile LAS unsigned* st;
};

__device__ __forceinline__ XcdBarrier xcd_barrier_post(unsigned* bar, volatile LAS unsigned* st) {
    XcdBarrier b; b.bar = bar; b.x = xb_xcc_id(); b.st = st;
    if (threadIdx.x == 0) (void)xb_add(&bar[XB_XCNT(b.x)], 1u);
    return b;
}
__device__ __forceinline__ void xcd_barrier_complete(unsigned* bar, unsigned x, unsigned& nloc, unsigned& nx) {
    const unsigned G = gridDim.x * gridDim.y * gridDim.z;
    unsigned sum, cnt, mine, sp = 0u;
    for (;;) {
        sum = 0u; cnt = 0u; mine = 0u;
#pragma unroll
        for (unsigned j = 0; j < 16; ++j) { const unsigned c = xb_ld(&bar[XB_XCNT(j)]); sum += c; cnt += (c > 0u) ? 1u : 0u; mine = (j == x) ? c : mine; }
        if (sum == G) break;
        __builtin_amdgcn_s_sleep(1);
        if ((++sp & 255u) == 0u) { if (xb_ld(&bar[XB_TMO])) break; if (sp > XB_SPIN_CAP) { atomicAdd(&bar[XB_TMO], 1u); break; } }
    }
    nloc = mine > 0u ? mine : 1u; nx = cnt > 0u ? cnt : 1u;
}

__device__ __forceinline__ void xcd_barrier(const XcdBarrier& b) {
    asm volatile("s_waitcnt vmcnt(0)" ::: "memory");
    __syncthreads();
    if (threadIdx.x == 0) {
        unsigned* bar = b.bar;
        __builtin_amdgcn_s_waitcnt(0);
        unsigned nloc = b.st[0], nx = b.st[1];
        if (nloc == 0u) { xcd_barrier_complete(bar, b.x, nloc, nx); b.st[0] = nloc; b.st[1] = nx; }
        const unsigned old = xb_add(&bar[XB_XSUB(b.x)], 1u);
        const unsigned gen = old / nloc;
        if (old + 1u == (gen + 1u) * nloc) {
            __builtin_amdgcn_fence(__ATOMIC_RELEASE, "agent");
            asm volatile("s_waitcnt vmcnt(0)" ::: "memory");
            const unsigned og = xb_add(&bar[XB_TOP], 1u);
            const unsigned tg = og / nx;
            if (og + 1u == (tg + 1u) * nx) xb_add(&bar[XB_TOPGEN], 1u);
            else XB_SPIN(xb_ld(&bar[XB_TOPGEN]) == tg, bar);
            __builtin_amdgcn_fence(__ATOMIC_ACQUIRE, "agent");
            xb_add(&bar[XB_XGEN(b.x)], 1u);
            asm volatile("s_waitcnt vmcnt(0)" ::: "memory");
        } else {
            XB_SPIN(xb_ld(&bar[XB_XGEN(b.x)]) == gen, bar);
            __builtin_amdgcn_fence(__ATOMIC_ACQUIRE, "agent");
            asm volatile("s_waitcnt vmcnt(0)" ::: "memory");
        }
    }
    __syncthreads();
}

constexpr int NWAVES = 8, NTHREADS = NWAVES * 64;
constexpr int BATCH = 8, SEQ = 2048, T = BATCH * SEQ, D = 2048;
constexpr int EV_N = 7200, EV_NP = 7424, OD_N = 7616, OD_NP = 7680, PROJ_LD = 7680;
constexpr float EPS = 1e-6f;
constexpr int EC_GQ = 0, EC_GK = 512, EC_GV = 1024, EC_GZ = 2048, EC_GLR = 3072, EC_BQ = 3088, EC_BK = 4112, EC_BV = 5136, EC_BZ = 6160, EC_BA = 7184, EC_BB = 7192;
constexpr int OC_HQ = 0, OC_HF = 1024, OC_HI = 2048, OC_HG = 3072, OC_RW = 4096;
constexpr int RW_R = 0, RW_K = 1024, RW_V = 2048, RW_WL = 3072, RW_AL = 3168, RW_GL = 3264;
constexpr int LORA_K = 512, LORA_N = 3072;
enum { I_X = 0, I_P, I_EV_WIN, I_GK_W2, I_GK_B, I_GLA_NORM, I_GDN_CONV, I_GDN_ALOG, I_GDN_DTB, I_GDN_NORM, I_EV_WOUT, I_OD_WIN, I_LB, I_HG_NORM,
       I_MU, I_W0, I_W2, I_A0, I_A2, I_G2, I_KK, I_KA, I_RK, I_LNW, I_LNB, I_OD_WOUT, I_NMIX, I_NFFN, I_NPLE, I_PEER_WQ, I_PEER_SK, I_PEER_U, I_PEER_V,
       I_PLE_WP, I_PLE_WG, I_NFINAL, N_IN };

constexpr size_t MiB = 1u << 20;
constexpr size_t WS_CTL = 0, CTL_ZERO_BYTES = 1 * MiB;
constexpr size_t WS_WEV_IN = 1 * MiB, WS_WEV_OUT = 30 * MiB, WS_WOD_IN = 38 * MiB, WS_WOD_OUT = 68 * MiB, WS_WPEER = 76 * MiB, WS_WGATE = 92 * MiB, WS_WPROJ = 108 * MiB,
                 WS_WLORA = 110 * MiB, WS_PBF = 113 * MiB, WS_TABU = 129 * MiB, WS_TABV = 193 * MiB, WS_ACTA = 257 * MiB, WS_ACTB = 321 * MiB, WS_PROJ = 385 * MiB, WS_SC = 385 * MiB,
                 WS_O = 625 * MiB, WS_PP = 753 * MiB, WS_LA = 817 * MiB, WS_LO = 833 * MiB, WS_RSP = 929 * MiB, WS_END = 937 * MiB;
static_assert(WS_WEV_IN + (size_t)EV_NP * D * 2 <= WS_WEV_OUT && WS_WOD_IN + (size_t)OD_NP * D * 2 <= WS_WOD_OUT && WS_PROJ + (size_t)T * PROJ_LD * 2 <= WS_O, "ws map");
constexpr int CW_BAR = 4096;
enum { RS_FFN0 = 0, RS_MIX1 = 1, RS_FFN1 = 2, RS_FINAL = 3 };
constexpr int RING_OFF = 0, RING_BYTES = 131072;
constexpr int LDSCTL_OFF = RING_BYTES, MISC_OFF = LDSCTL_OFF + 320;
constexpr int LDS_BYTES = 147456;

struct Args { const float* in[N_IN]; float* out; unsigned char* ws; int ph_lo, ph_hi; };
struct Frame {
    LAS unsigned char* lds; volatile LAS unsigned* MISC; gu32* ctl;
    int tid, lane, wave, vcu, G;
};
__device__ __forceinline__ float wave_sum(float v) {
#pragma unroll
    for (int o = 1; o < 64; o <<= 1) v += __shfl_xor(v, o);
    return v;
}
__device__ __forceinline__ float half_sum32(float v) {
#pragma unroll
    for (int o = 1; o < 32; o <<= 1) v += __shfl_xor(v, o);
    return v;
}
#define DPP_ADD(v, ctrl) (v) += __builtin_bit_cast(float, __builtin_amdgcn_update_dpp(0, __builtin_bit_cast(int, (v)), (ctrl), 0xF, 0xF, false))
__device__ __forceinline__ float row_sum16(float v) {
    DPP_ADD(v, 0x128); DPP_ADD(v, 0x124); DPP_ADD(v, 0x122); DPP_ADD(v, 0x121);
    return v;
}
__device__ __forceinline__ float bf_lo(unsigned w) { return __uint_as_float(w << 16); }
__device__ __forceinline__ float bf_hi(unsigned w) { return __uint_as_float(w & 0xffff0000u); }
__device__ __forceinline__ float sigmoidf_(float x) { return 1.0f / (1.0f + __expf(-x)); }
__device__ __forceinline__ float siluf_(float x) { return x / (1.0f + __expf(-x)); }
__device__ __forceinline__ float softplusf_(float x) { return fmaxf(x, 0.f) + log1pf(__expf(-fabsf(x))); }
__device__ __forceinline__ float logsigmoidf_(float x) { return fminf(x, 0.f) - log1pf(__expf(-fabsf(x))); }

struct EpiBf16S {
    static constexpr bool PERM = true, AFTER_DRAIN = false;
    bf16* O; int ldc; const float* rowss;
    __device__ __forceinline__ void operator()(const pg8::f32x4 (&acc)[2][2][4][2], const pg8::Unit& u, int wr, int wc, int fr, int fq) const {
        const int row0 = u.pm * 256 + wr * 64 + fr, col0 = u.pn * 256 + wc * 32 + 8 * fq;
#pragma unroll
        for (int ai = 0; ai < 2; ++ai)
#pragma unroll
            for (int m = 0; m < 4; ++m) {
                const int row = row0 + ai * 128 + m * 16;
                float sc = 1.f;
                if (rowss) { const pg8::f32x4* rp = (const pg8::f32x4*)(rowss + (size_t)row * 32 + 8 * fq); const pg8::f32x4 p0 = rp[0], p1 = rp[1];
                    float s = ((p0[0] + p0[1]) + (p0[2] + p0[3])) + ((p1[0] + p1[1]) + (p1[2] + p1[3])); s += __shfl_xor(s, 16); s += __shfl_xor(s, 32);
                    sc = __builtin_amdgcn_rsqf(s * (1.0f / D) + EPS); }
                bf16* rowp = O + (size_t)row * ldc + col0;
#pragma unroll
                for (int bj = 0; bj < 2; ++bj) { const pg8::f32x4 v0 = acc[ai][bj][m][0] * sc, v1 = acc[ai][bj][m][1] * sc;
                    pg8::u32x4 w; w.x = pg8::cvt_pk_bf16(v0[0], v0[1]); w.y = pg8::cvt_pk_bf16(v0[2], v0[3]); w.z = pg8::cvt_pk_bf16(v1[0], v1[1]); w.w = pg8::cvt_pk_bf16(v1[2], v1[3]);
                    *(pg8::u32x4*)(rowp + bj * 128) = w; } }
    }
};
template <bool GATE> struct EpiResid {
    static constexpr bool PERM = false, AFTER_DRAIN = false;
    const float* hin; float* hout; bf16* hg; const float* gain; float* rowss; const bf16* pp;
    __device__ __forceinline__ void operator()(const pg8::f32x4 (&acc)[2][2][4][2], const pg8::Unit& u, int wr, int wc, int fr, int fq) const {
        const int row0 = u.pm * 256 + wr * 64 + fr, col0 = u.pn * 256 + wc * 32 + 4 * fq;
        pg8::f32x4 gv[2][2];
#pragma unroll
        for (int bj = 0; bj < 2; ++bj)
#pragma unroll
            for (int n = 0; n < 2; ++n) gv[bj][n] = hg ? *(const pg8::f32x4*)(gain + col0 + bj * 128 + n * 16) : (pg8::f32x4){0.f, 0.f, 0.f, 0.f};
#pragma unroll
        for (int ai = 0; ai < 2; ++ai)
#pragma unroll
            for (int m = 0; m < 4; ++m) {
                const int row = row0 + ai * 128 + m * 16; const size_t off = (size_t)row * D + col0; float ss = 0.f;
#pragma unroll
                for (int bj = 0; bj < 2; ++bj)
#pragma unroll
                    for (int n = 0; n < 2; ++n) { const size_t o = off + bj * 128 + n * 16;
                        pg8::f32x4 hv = *(const pg8::f32x4*)(hin + o); pg8::f32x4 a = acc[ai][bj][m][n];
                        if (GATE) { const pg8::u32x2 pw = *(const pg8::u32x2*)(pp + o);
                            a[0] = sigmoidf_(a[0]) * bf_lo(pw.x); a[1] = sigmoidf_(a[1]) * bf_hi(pw.x); a[2] = sigmoidf_(a[2]) * bf_lo(pw.y); a[3] = sigmoidf_(a[3]) * bf_hi(pw.y); }
                        hv = hv + a; *(pg8::f32x4*)(hout + o) = hv;
                        ss += (hv[0] * hv[0] + hv[1] * hv[1]) + (hv[2] * hv[2] + hv[3] * hv[3]);
                        if (hg) { const pg8::f32x4 q = hv * gv[bj][n]; pg8::u32x2 w; w.x = pg8::cvt_pk_bf16(q[0], q[1]); w.y = pg8::cvt_pk_bf16(q[2], q[3]); *(pg8::u32x2*)(hg + o) = w; } }
                ss += __shfl_xor(ss, 16); ss += __shfl_xor(ss, 32);
                if (fq == 0) rowss[(size_t)row * 32 + u.pn * 4 + wc] = ss;
                asm volatile("" ::: "memory"); }
    }
};

__device__ __forceinline__ void p0_transpose_item(const float* W, int K, int N, bf16* WT, LAS float* scr, int item, int lane) {
    const int nblk = N / 32, kb = item / nblk, nb = item % nblk, k0 = 64 * kb, n0 = 32 * nb;
#pragma unroll 8
    for (int i = 0; i < 32; ++i) { const int kk = 2 * i + (lane >> 5); scr[kk * 33 + (lane & 31)] = W[(size_t)(k0 + kk) * N + n0 + (lane & 31)]; }
    LDS_WAIT(); asm volatile("" ::: "memory");
    const int c = lane & 7;
#pragma unroll
    for (int j = 0; j < 4; ++j) { const int n = (lane >> 3) + 8 * j; const LAS float* s = scr + (8 * c) * 33 + n;
        v4u o; o.x = pk2(s[0 * 33], s[1 * 33]); o.y = pk2(s[2 * 33], s[3 * 33]); o.z = pk2(s[4 * 33], s[5 * 33]); o.w = pk2(s[6 * 33], s[7 * 33]);
        *(GAS v4u*)(WT + (size_t)(n0 + n) * K + k0 + 8 * c) = o; }
    LDS_WAIT(); asm volatile("" ::: "memory");
}
__device__ __forceinline__ void cvt_f32_bf16(const float* src, bf16* dst, size_t n, int gtid, int gthreads) {
    const size_t n8 = n / 8;
    for (size_t i = gtid; i < n8; i += gthreads) {
        const f32x4 a = *(const GAS f32x4*)(src + i * 8), b = *(const GAS f32x4*)(src + i * 8 + 4);
        v4u o; o.x = pk2(a[0], a[1]); o.y = pk2(a[2], a[3]); o.z = pk2(b[0], b[1]); o.w = pk2(b[2], b[3]);
        *(GAS v4u*)(dst + i * 8) = o; }
}
__device__ __forceinline__ void rms_row_to_bf16(const float* xrow, const float* g, bf16* orow, int lane) {
    const GAS f32x4* xr = (const GAS f32x4*)xrow + lane; f32x4 v[8]; float s = 0.f;
#pragma unroll
    for (int j = 0; j < 8; ++j) { v[j] = xr[64 * j]; s += (v[j][0] * v[j][0] + v[j][1] * v[j][1]) + (v[j][2] * v[j][2] + v[j][3] * v[j][3]); }
    const float r = __builtin_amdgcn_rsqf(wave_sum(s) * (1.0f / D) + EPS);
    const GAS f32x4* gr = (const GAS f32x4*)g + lane;
    GAS unsigned long long* o8 = (GAS unsigned long long*)orow + lane;
#pragma unroll
    for (int j = 0; j < 8; ++j) { const f32x4 gg = gr[64 * j]; o8[64 * j] = (unsigned long long)pk2(v[j][0] * r * gg[0], v[j][1] * r * gg[1]) | ((unsigned long long)pk2(v[j][2] * r * gg[2], v[j][3] * r * gg[3]) << 32); }
}
__device__ __forceinline__ void p0_fold_item(const float* wq, const float* sk, bf16* WP, LAS float* lds, int item, int tid) {
    const int hp = item >> 5, k0 = (item & 31) * 64;
    LAS float* skT = lds;
    LAS float* wqT = lds + 128 * 132;
    const float* skb = sk + (size_t)hp * 128 * 128;
#pragma unroll 4
    for (int i = 0; i < 32; ++i) { const int idx = i * 512 + tid, n = idx >> 7, d = idx & 127; skT[d * 132 + n] = skb[idx]; }
#pragma unroll 4
    for (int i = 0; i < 16; ++i) { const int idx = i * 512 + tid, kk = idx >> 7, d = idx & 127; wqT[d * 68 + kk] = wq[(size_t)(k0 + kk) * D + hp * 128 + d]; }
    __syncthreads();
    const int n0 = (tid >> 4) * 4, kk0 = (tid & 15) * 4;
    float acc[4][4];
#pragma unroll
    for (int i = 0; i < 4; ++i)
#pragma unroll
        for (int j = 0; j < 4; ++j) acc[i][j] = 0.f;
#pragma unroll 4
    for (int d = 0; d < 128; ++d) { const f32x4 a = *(const LAS f32x4*)(skT + d * 132 + n0), b = *(const LAS f32x4*)(wqT + d * 68 + kk0);
#pragma unroll
        for (int i = 0; i < 4; ++i)
#pragma unroll
            for (int j = 0; j < 4; ++j) acc[i][j] += a[i] * b[j]; }
#pragma unroll
    for (int i = 0; i < 4; ++i) { unsigned long long o = (unsigned long long)pk2(acc[i][0], acc[i][1]) | ((unsigned long long)pk2(acc[i][2], acc[i][3]) << 32);
        *(GAS unsigned long long*)(WP + (size_t)(hp * 128 + n0 + i) * D + k0 + kk0) = o; }
    __syncthreads();
}
__device__ __forceinline__ void p0_prologue(const Args& A, Frame& F) {
    const int gw = F.vcu * NWAVES + F.wave, NGW = F.G * NWAVES;
    const int gtid = (F.vcu * NWAVES + F.wave) * 64 + F.lane, gthreads = F.G * NTHREADS;
    unsigned char* ws = A.ws;
    {
        LAS float* scr = (LAS float*)(F.lds + RING_OFF + F.wave * 16384);
        constexpr int I_EVIN = (D / 64) * (EV_N / 32), I_SQ = (D / 64) * (D / 32), I_ODIN = (D / 64) * (OD_N / 32), I_PJ = (256 / 64) * (D / 32);
        constexpr int NITEMS = I_EVIN + I_SQ + I_ODIN + I_SQ + 2 * I_SQ + 2 * I_PJ;
        for (int it = gw; it < NITEMS; it += NGW) {
            int r = it;
            if (r < I_EVIN) { p0_transpose_item(A.in[I_EV_WIN], D, EV_N, (bf16*)(ws + WS_WEV_IN), scr, r, F.lane); continue; } r -= I_EVIN;
            if (r < I_SQ) { p0_transpose_item(A.in[I_EV_WOUT], D, D, (bf16*)(ws + WS_WEV_OUT), scr, r, F.lane); continue; } r -= I_SQ;
            if (r < I_ODIN) { p0_transpose_item(A.in[I_OD_WIN], D, OD_N, (bf16*)(ws + WS_WOD_IN), scr, r, F.lane); continue; } r -= I_ODIN;
            if (r < I_SQ) { p0_transpose_item(A.in[I_OD_WOUT], D, D, (bf16*)(ws + WS_WOD_OUT), scr, r, F.lane); continue; } r -= I_SQ;
            if (r < 2 * I_SQ) { const int L = r / I_SQ; p0_transpose_item(A.in[I_PLE_WG] + (size_t)L * D * D, D, D, (bf16*)(ws + WS_WGATE) + (size_t)L * D * D, scr, r % I_SQ, F.lane); continue; } r -= 2 * I_SQ;
            { const int L = r / I_PJ; p0_transpose_item(A.in[I_PLE_WP] + (size_t)L * 256 * D, 256, D, (bf16*)(ws + WS_WPROJ) + (size_t)L * D * 256, scr, r % I_PJ, F.lane); }
        }
        { GAS v4u* z0 = (GAS v4u*)(ws + WS_WEV_IN + (size_t)EV_N * D * 2); const size_t n0 = (size_t)(EV_NP - EV_N) * D * 2 / 16;
          for (size_t i = gtid; i < n0; i += gthreads) z0[i] = (v4u){0u, 0u, 0u, 0u};
          GAS v4u* z1 = (GAS v4u*)(ws + WS_WOD_IN + (size_t)OD_N * D * 2); const size_t n1 = (size_t)(OD_NP - OD_N) * D * 2 / 16;
          for (size_t i = gtid; i < n1; i += gthreads) z1[i] = (v4u){0u, 0u, 0u, 0u}; }
    }
    __syncthreads();
    for (int it = F.vcu; it < 1024; it += F.G) { const int L = it >> 9;
        p0_fold_item(A.in[I_PEER_WQ] + (size_t)L * D * D, A.in[I_PEER_SK] + (size_t)L * 16 * 128 * 128, (bf16*)(ws + WS_WPEER) + (size_t)L * D * D, (LAS float*)(F.lds + RING_OFF), it & 511, F.tid); }
    cvt_f32_bf16(A.in[I_PEER_U], (bf16*)(ws + WS_TABU), (size_t)16384 * D, gtid, gthreads);
    cvt_f32_bf16(A.in[I_PEER_V], (bf16*)(ws + WS_TABV), (size_t)16384 * D, gtid, gthreads);
    cvt_f32_bf16(A.in[I_P], (bf16*)(ws + WS_PBF), (size_t)2 * T * 256, gtid, gthreads);
    { bf16* LB = (bf16*)(ws + WS_WLORA); const float* w2 = A.in[I_W2]; const float* a2 = A.in[I_A2]; const float* g2 = A.in[I_G2];
      for (int i = gtid; i < LORA_N * LORA_K / 2; i += gthreads) { const int row = i / (LORA_K / 2), col = (i % (LORA_K / 2)) * 2; float v[2];
#pragma unroll
          for (int e = 0; e < 2; ++e) { const int c = col + e; float x = 0.f;
              if (row < 1024) { if (c < 96) x = w2[c * 1024 + row]; }
              else if (row < 2048) { if (c >= 96 && c < 192) x = a2[(c - 96) * 1024 + (row - 1024)]; }
              else { if (c >= 192 && c < 448) x = g2[(c - 192) * 1024 + (row - 2048)]; }
              v[e] = x; }
          *(GAS unsigned*)(LB + (size_t)row * LORA_K + col) = pk2(v[0], v[1]); } }
    for (int m = gw; m < T; m += NGW) rms_row_to_bf16(A.in[I_X] + (size_t)m * D, A.in[I_NMIX], (bf16*)(ws + WS_ACTA) + (size_t)m * D, F.lane);
}

constexpr int TC = 16, NCHUNK = SEQ / TC;
typedef float f32x2 __attribute__((ext_vector_type(2)));
typedef unsigned u32x2 __attribute__((ext_vector_type(2)));

template <int MODE>
__device__ __forceinline__ void scan_gla_unit(const Args& A, Frame& F, int unit) {
    const int tid = F.tid, lane = F.lane, w = F.wave;
    int b, h, qcol, kcol, vcol, ocol;
    if (MODE == 0) { b = unit >> 4; h = (unit >> 2) & 3; const int s = unit & 3; qcol = EC_GQ + h * 128; kcol = EC_GK + h * 128; vcol = EC_GV + h * 256 + s * 64; ocol = h * 256 + s * 64; }
    else           { b = unit >> 4; h = (unit >> 1) & 7; const int s = unit & 1; qcol = OC_HQ + h * 128; kcol = OC_HF + h * 128; vcol = OC_HI + h * 128 + s * 64; ocol = h * 128 + s * 64; }
    const bf16* P = (const bf16*)(A.ws + WS_PROJ) + (size_t)b * SEQ * PROJ_LD;
    float* O = (float*)(A.ws + WS_O) + (size_t)b * SEQ * D + ocol;
    LAS float* Lf = (LAS float*)(F.lds + RING_OFF);
    constexpr int BUFSZ = 7168, O_EG = 0, O_K = 2048, O_Q = 4096, O_V = 6144, O_OUT = 2 * BUFSZ, O_W2 = O_OUT + 1024, O_BIAS = O_W2 + 2048;
    const int tl = tid >> 5, dq = (tid & 31) * 4, tlv = tid >> 4, c4 = (tid & 15) * 4;
    float lb[4] = {0.f, 0.f, 0.f, 0.f};
    if (MODE == 0) {
        const float* w2 = A.in[I_GK_W2]; const float* gb = A.in[I_GK_B];
        for (int i = tid; i < 2048; i += NTHREADS) Lf[O_W2 + i] = w2[(i >> 7) * 512 + h * 128 + (i & 127)];
        if (tid < 128) Lf[O_BIAS + tid] = gb[h * 128 + tid];
    } else {
        const float* lg = A.in[I_LB];
#pragma unroll
        for (int i = 0; i < 4; ++i) lb[i] = sigmoidf_(lg[1024 + h * 128 + dq + i] - lg[h * 128 + dq + i]);
    }
    u32x2 rq, rk, rv = {0u, 0u}; v4u rg0 = {0u, 0u, 0u, 0u}, rg1 = {0u, 0u, 0u, 0u};
#define GLA_LOAD(c) do { const bf16* pr = P + (size_t)((c) * TC + tl) * PROJ_LD; rq = *(const GAS u32x2*)(pr + qcol + dq); rk = *(const GAS u32x2*)(pr + kcol + dq); \
        if (MODE == 0) { rg0 = *(const GAS v4u*)(pr + EC_GLR); rg1 = *(const GAS v4u*)(pr + EC_GLR + 8); } \
        if (tid < 256) rv = *(const GAS u32x2*)(P + (size_t)((c) * TC + tlv) * PROJ_LD + vcol + c4); } while (0)
#define GLA_XFORM(bufi) do { LAS float* B_ = Lf + (bufi) * BUFSZ; f32x4 q4, k4, e4; \
        const float xq[4] = {bf_lo(rq.x), bf_hi(rq.x), bf_lo(rq.y), bf_hi(rq.y)}, xk[4] = {bf_lo(rk.x), bf_hi(rk.x), bf_lo(rk.y), bf_hi(rk.y)}; \
        if (MODE == 0) { f32x4 z = *(const LAS f32x4*)(Lf + O_BIAS + dq); \
            const float gl[16] = {bf_lo(rg0.x), bf_hi(rg0.x), bf_lo(rg0.y), bf_hi(rg0.y), bf_lo(rg0.z), bf_hi(rg0.z), bf_lo(rg0.w), bf_hi(rg0.w), \
                                  bf_lo(rg1.x), bf_hi(rg1.x), bf_lo(rg1.y), bf_hi(rg1.y), bf_lo(rg1.z), bf_hi(rg1.z), bf_lo(rg1.w), bf_hi(rg1.w)}; \
            _Pragma("unroll") for (int r_ = 0; r_ < 16; ++r_) { const f32x4 wv = *(const LAS f32x4*)(Lf + O_W2 + r_ * 128 + dq); z = z + wv * gl[r_]; } \
            _Pragma("unroll") for (int i_ = 0; i_ < 4; ++i_) { q4[i_] = xq[i_] * 0.08838834764831845f; k4[i_] = xk[i_]; e4[i_] = __expf(logsigmoidf_(z[i_]) * 0.0625f); } } \
        else { _Pragma("unroll") for (int i_ = 0; i_ < 4; ++i_) { const float fg = lb[i_] + (1.f - lb[i_]) * sigmoidf_(xk[i_]); q4[i_] = siluf_(xq[i_]); k4[i_] = 1.f - fg; e4[i_] = fg; } } \
        *(LAS f32x4*)(B_ + O_EG + tl * 128 + dq) = e4; *(LAS f32x4*)(B_ + O_K + tl * 128 + dq) = k4; *(LAS f32x4*)(B_ + O_Q + tl * 128 + dq) = q4; \
        if (tid < 256) { f32x4 v4 = {bf_lo(rv.x), bf_hi(rv.x), bf_lo(rv.y), bf_hi(rv.y)}; *(LAS f32x4*)(B_ + O_V + tlv * 64 + c4) = v4; } } while (0)
    __syncthreads();
    GLA_LOAD(0); GLA_XFORM(0);
    __syncthreads();
    float S[8][2];
#pragma unroll
    for (int i = 0; i < 8; ++i) { S[i][0] = 0.f; S[i][1] = 0.f; }
    const int j = lane & 15, col = w * 8 + (lane >> 4) * 2;
    for (int c = 0; c < NCHUNK; ++c) {
        if (c + 1 < NCHUNK) GLA_LOAD(c + 1);
        const LAS float* B_ = Lf + (c & 1) * BUFSZ;
#pragma unroll 4
        for (int t = 0; t < TC; ++t) {
            const f32x4 e0 = *(const LAS f32x4*)(B_ + O_EG + t * 128 + 4 * j), e1 = *(const LAS f32x4*)(B_ + O_EG + t * 128 + 64 + 4 * j);
            const f32x4 k0 = *(const LAS f32x4*)(B_ + O_K + t * 128 + 4 * j), k1 = *(const LAS f32x4*)(B_ + O_K + t * 128 + 64 + 4 * j);
            const f32x4 q0 = *(const LAS f32x4*)(B_ + O_Q + t * 128 + 4 * j), q1 = *(const LAS f32x4*)(B_ + O_Q + t * 128 + 64 + 4 * j);
            const f32x2 v2 = *(const LAS f32x2*)(B_ + O_V + t * 64 + col);
            float p0 = 0.f, p1 = 0.f;
#pragma unroll
            for (int i = 0; i < 4; ++i) {
                S[i][0] = S[i][0] * e0[i] + k0[i] * v2[0]; S[i][1] = S[i][1] * e0[i] + k0[i] * v2[1];
                S[4 + i][0] = S[4 + i][0] * e1[i] + k1[i] * v2[0]; S[4 + i][1] = S[4 + i][1] * e1[i] + k1[i] * v2[1];
                p0 += q0[i] * S[i][0] + q1[i] * S[4 + i][0]; p1 += q0[i] * S[i][1] + q1[i] * S[4 + i][1]; }
            p0 = row_sum16(p0); p1 = row_sum16(p1);
            if (j == 0) { f32x2 o2 = {p0, p1}; *(LAS f32x2*)(Lf + O_OUT + t * 64 + col) = o2; }
        }
        if (c + 1 < NCHUNK) GLA_XFORM((c + 1) & 1);
        __syncthreads();
        if (tid < 256) *(GAS f32x4*)(O + (size_t)(c * TC + tlv) * D + c4) = *(const LAS f32x4*)(Lf + O_OUT + tlv * 64 + c4);
        __syncthreads();
    }
#undef GLA_LOAD
#undef GLA_XFORM
}

__device__ __forceinline__ void scan_gdn_unit(const Args& A, Frame& F, int unit) {
    const int tid = F.tid, lane = F.lane, w = F.wave;
    const int b = unit >> 4, h = (unit >> 1) & 7, s = unit & 1;
    const int qcol = EC_BQ + h * 128, kcol = EC_BK + h * 128, vcol = EC_BV + h * 128 + s * 64, ocol = 1024 + h * 128 + s * 64;
    const bf16* P = (const bf16*)(A.ws + WS_PROJ) + (size_t)b * SEQ * PROJ_LD;
    float* O = (float*)(A.ws + WS_O) + (size_t)b * SEQ * D + ocol;
    LAS float* Lf = (LAS float*)(F.lds + RING_OFF);
    constexpr int BUFSZ = 5184, O_K = 0, O_Q = 2048, O_V = 4096, O_SC = 5120, O_OUT = 2 * BUFSZ, O_CW = O_OUT + 1024;
    const int tl = tid >> 5, dq = (tid & 31) * 4, tlv = tid >> 4, c4 = (tid & 15) * 4;
    { const float* cw = A.in[I_GDN_CONV];
      for (int i = tid; i < 4 * 320; i += NTHREADS) { const int jt = i / 320, x = i % 320;
          const int ch = x < 128 ? (h * 128 + x) : x < 256 ? (1024 + h * 128 + (x - 128)) : (2048 + h * 128 + s * 64 + (x - 256));
          Lf[O_CW + i] = cw[jt * 3072 + ch]; } }
    const float neg_ea = -__expf(A.in[I_GDN_ALOG][h]), dtb = A.in[I_GDN_DTB][h];
    u32x2 rq[4], rk[4], rv[4]; unsigned short rba = 0, rbb = 0;
#pragma unroll
    for (int i = 0; i < 4; ++i) rv[i] = (u32x2){0u, 0u};
#define GDN_LOAD(c) do { const int t_ = (c) * TC + tl; \
        _Pragma("unroll") for (int jt = 0; jt < 4; ++jt) { const int tt = t_ - 3 + jt; \
            if (tt >= 0) { const bf16* pr = P + (size_t)tt * PROJ_LD; rq[jt] = *(const GAS u32x2*)(pr + qcol + dq); rk[jt] = *(const GAS u32x2*)(pr + kcol + dq); } \
            else { rq[jt] = (u32x2){0u, 0u}; rk[jt] = (u32x2){0u, 0u}; } } \
        { const bf16* pr = P + (size_t)t_ * PROJ_LD; rba = pr[EC_BA + h]; rbb = pr[EC_BB + h]; } \
        if (tid < 256) { const int tv = (c) * TC + tlv; \
            _Pragma("unroll") for (int jt = 0; jt < 4; ++jt) { const int tt = tv - 3 + jt; \
                if (tt >= 0) rv[jt] = *(const GAS u32x2*)(P + (size_t)tt * PROJ_LD + vcol + c4); else rv[jt] = (u32x2){0u, 0u}; } } } while (0)
#define GDN_XFORM(bufi) do { LAS float* B_ = Lf + (bufi) * BUFSZ; f32x4 q4 = {0.f, 0.f, 0.f, 0.f}, k4 = {0.f, 0.f, 0.f, 0.f}; \
        _Pragma("unroll") for (int jt = 0; jt < 4; ++jt) { const f32x4 wq = *(const LAS f32x4*)(Lf + O_CW + jt * 320 + dq), wk = *(const LAS f32x4*)(Lf + O_CW + jt * 320 + 128 + dq); \
            q4[0] += wq[0] * bf_lo(rq[jt].x); q4[1] += wq[1] * bf_hi(rq[jt].x); q4[2] += wq[2] * bf_lo(rq[jt].y); q4[3] += wq[3] * bf_hi(rq[jt].y); \
            k4[0] += wk[0] * bf_lo(rk[jt].x); k4[1] += wk[1] * bf_hi(rk[jt].x); k4[2] += wk[2] * bf_lo(rk[jt].y); k4[3] += wk[3] * bf_hi(rk[jt].y); } \
        float sq = 0.f, sk = 0.f, sqk = 0.f; \
        _Pragma("unroll") for (int i_ = 0; i_ < 4; ++i_) { q4[i_] = siluf_(q4[i_]); k4[i_] = siluf_(k4[i_]); sq += q4[i_] * q4[i_]; sk += k4[i_] * k4[i_]; sqk += q4[i_] * k4[i_]; } \
        sq = half_sum32(sq); sk = half_sum32(sk); sqk = half_sum32(sqk); \
        const float rq_ = __builtin_amdgcn_rsqf(sq + EPS) * 0.08838834764831845f, rk_ = __builtin_amdgcn_rsqf(sk + EPS); \
        q4 = q4 * rq_; k4 = k4 * rk_; \
        *(LAS f32x4*)(B_ + O_K + tl * 128 + dq) = k4; *(LAS f32x4*)(B_ + O_Q + tl * 128 + dq) = q4; \
        if ((tid & 31) == 0) { const float ba = __uint_as_float((unsigned)rba << 16), bb = __uint_as_float((unsigned)rbb << 16); \
            f32x4 sc; sc[0] = __expf(neg_ea * softplusf_(ba + dtb)); sc[1] = sigmoidf_(bb); sc[2] = sqk * rq_ * rk_; sc[3] = 0.f; *(LAS f32x4*)(B_ + O_SC + tl * 4) = sc; } \
        if (tid < 256) { f32x4 v4 = {0.f, 0.f, 0.f, 0.f}; \
            _Pragma("unroll") for (int jt = 0; jt < 4; ++jt) { const f32x4 wv = *(const LAS f32x4*)(Lf + O_CW + jt * 320 + 256 + c4); \
                v4[0] += wv[0] * bf_lo(rv[jt].x); v4[1] += wv[1] * bf_hi(rv[jt].x); v4[2] += wv[2] * bf_lo(rv[jt].y); v4[3] += wv[3] * bf_hi(rv[jt].y); } \
            _Pragma("unroll") for (int i_ = 0; i_ < 4; ++i_) v4[i_] = siluf_(v4[i_]); \
            *(LAS f32x4*)(B_ + O_V + tlv * 64 + c4) = v4; } } while (0)
    __syncthreads();
    GDN_LOAD(0); GDN_XFORM(0);
    __syncthreads();
    float S[8][2];
#pragma unroll
    for (int i = 0; i < 8; ++i) { S[i][0] = 0.f; S[i][1] = 0.f; }
    const int j = lane & 15, col = w * 8 + (lane >> 4) * 2;
    for (int c = 0; c < NCHUNK; ++c) {
        if (c + 1 < NCHUNK) GDN_LOAD(c + 1);
        const LAS float* B_ = Lf + (c & 1) * BUFSZ;
#pragma unroll 4
        for (int t = 0; t < TC; ++t) {
            const f32x4 k0 = *(const LAS f32x4*)(B_ + O_K + t * 128 + 4 * j), k1 = *(const LAS f32x4*)(B_ + O_K + t * 128 + 64 + 4 * j);
            const f32x4 q0 = *(const LAS f32x4*)(B_ + O_Q + t * 128 + 4 * j), q1 = *(const LAS f32x4*)(B_ + O_Q + t * 128 + 64 + 4 * j);
            const f32x2 v2 = *(const LAS f32x2*)(B_ + O_V + t * 64 + col);
            const f32x4 sc = *(const LAS f32x4*)(B_ + O_SC + t * 4);
            float d10 = 0.f, d11 = 0.f, d20 = 0.f, d21 = 0.f;
#pragma unroll
            for (int i = 0; i < 4; ++i) {
                d10 += k0[i] * S[i][0] + k1[i] * S[4 + i][0]; d11 += k0[i] * S[i][1] + k1[i] * S[4 + i][1];
                d20 += q0[i] * S[i][0] + q1[i] * S[4 + i][0]; d21 += q0[i] * S[i][1] + q1[i] * S[4 + i][1]; }
            d10 = row_sum16(d10); d11 = row_sum16(d11); d20 = row_sum16(d20); d21 = row_sum16(d21);
            const float a = sc[0], beta = sc[1], qk = sc[2];
            const float dl0 = beta * (v2[0] - a * d10), dl1 = beta * (v2[1] - a * d11);
            const float o0 = a * d20 + qk * dl0, o1 = a * d21 + qk * dl1;
#pragma unroll
            for (int i = 0; i < 4; ++i) {
                S[i][0] = a * S[i][0] + k0[i] * dl0; S[i][1] = a * S[i][1] + k0[i] * dl1;
                S[4 + i][0] = a * S[4 + i][0] + k1[i] * dl0; S[4 + i][1] = a * S[4 + i][1] + k1[i] * dl1; }
            if (j == 0) { f32x2 o2 = {o0, o1}; *(LAS f32x2*)(Lf + O_OUT + t * 64 + col) = o2; }
        }
        if (c + 1 < NCHUNK) GDN_XFORM((c + 1) & 1);
        __syncthreads();
        if (tid < 256) *(GAS f32x4*)(O + (size_t)(c * TC + tlv) * D + c4) = *(const LAS f32x4*)(Lf + O_OUT + tlv * 64 + c4);
        __syncthreads();
    }
#undef GDN_LOAD
#undef GDN_XFORM
}

__device__ __forceinline__ void scan_rwkv_unit(const Args& A, Frame& F, int unit) {
    const int tid = F.tid, lane = F.lane, w = F.wave;
    const int b = unit >> 4, h = unit & 15;
    const bf16* P = (const bf16*)(A.ws + WS_PROJ) + (size_t)b * SEQ * PROJ_LD + OC_RW;
    const bf16* LO = (const bf16*)(A.ws + WS_LO) + (size_t)b * SEQ * LORA_N;
    bf16* Y = (bf16*)(A.ws + WS_ACTA) + (size_t)b * SEQ * D + 1024 + h * 64;
    LAS float* Lf = (LAS float*)(F.lds + RING_OFF);
    constexpr int BUFSZ = 6208, O_KK = 0, O_WR = 1024, O_W = 2048, O_NKA = 3072, O_K = 4096, O_V = 5120, O_SC = 6144, O_OUT = 2 * BUFSZ;
    const int tl = tid >> 5, d2 = (tid & 31) * 2, hd = h * 64 + d2;
    float mu_r[2], mu_k[2], mu_v[2], w0[2], a0[2], k_k[2], k_a[2], r_k[2], lnw[2], lnb[2];
#pragma unroll
    for (int i = 0; i < 2; ++i) { mu_r[i] = A.in[I_MU][RW_R + hd + i]; mu_k[i] = A.in[I_MU][RW_K + hd + i]; mu_v[i] = A.in[I_MU][RW_V + hd + i];
        w0[i] = A.in[I_W0][hd + i]; a0[i] = A.in[I_A0][hd + i]; k_k[i] = A.in[I_KK][hd + i]; k_a[i] = A.in[I_KA][hd + i]; r_k[i] = A.in[I_RK][hd + i];
        lnw[i] = A.in[I_LNW][hd + i]; lnb[i] = A.in[I_LNB][hd + i]; }
    unsigned rr[2], rk[2], rv[2], rlw, rla, rg_cur = 0u, rg_nxt = 0u;
#define RW_LOAD(c) do { const int t_ = (c) * TC + tl; const bf16* pr = P + (size_t)t_ * PROJ_LD; \
        rr[0] = *(const GAS unsigned*)(pr + RW_R + hd); rk[0] = *(const GAS unsigned*)(pr + RW_K + hd); rv[0] = *(const GAS unsigned*)(pr + RW_V + hd); \
        if (t_ > 0) { rr[1] = *(const GAS unsigned*)(pr - PROJ_LD + RW_R + hd); rk[1] = *(const GAS unsigned*)(pr - PROJ_LD + RW_K + hd); rv[1] = *(const GAS unsigned*)(pr - PROJ_LD + RW_V + hd); } \
        else { rr[1] = 0u; rk[1] = 0u; rv[1] = 0u; } \
        const bf16* lr = LO + (size_t)t_ * LORA_N; rlw = *(const GAS unsigned*)(lr + hd); rla = *(const GAS unsigned*)(lr + 1024 + hd); rg_nxt = *(const GAS unsigned*)(lr + 2048 + hd); } while (0)
#define RW_XFORM(bufi) do { LAS float* B_ = Lf + (bufi) * BUFSZ; f32x2 kk2, wr2, w2_, nka2, k2, v2_; float skk = 0.f, sc1 = 0.f, sc2 = 0.f, sbs = 0.f; float aa[2], rrv[2]; \
        _Pragma("unroll") for (int i_ = 0; i_ < 2; ++i_) { \
            const float r0 = i_ ? bf_hi(rr[0]) : bf_lo(rr[0]), r1 = i_ ? bf_hi(rr[1]) : bf_lo(rr[1]); \
            const float k0_ = i_ ? bf_hi(rk[0]) : bf_lo(rk[0]), k1_ = i_ ? bf_hi(rk[1]) : bf_lo(rk[1]); \
            const float v0_ = i_ ? bf_hi(rv[0]) : bf_lo(rv[0]), v1_ = i_ ? bf_hi(rv[1]) : bf_lo(rv[1]); \
            const float lw = i_ ? bf_hi(rlw) : bf_lo(rlw), la = i_ ? bf_hi(rla) : bf_lo(rla); \
            const float r_ = r0 + (r1 - r0) * mu_r[i_], kx = k0_ + (k1_ - k0_) * mu_k[i_], vx = v0_ + (v1_ - v0_) * mu_v[i_]; \
            const float wd = __expf(-0.6065306597126334f * sigmoidf_(w0[i_] + lw)); const float a_ = sigmoidf_(a0[i_] + la); \
            const float kk0 = kx * k_k[i_]; const float km = kx * (1.f + (a_ - 1.f) * k_a[i_]); \
            kk2[i_] = kk0; skk += kk0 * kk0; aa[i_] = a_; rrv[i_] = r_; wr2[i_] = wd * r_; w2_[i_] = wd; k2[i_] = km; v2_[i_] = vx; sc2 += km * r_; sbs += r_ * km * r_k[i_]; } \
        skk = half_sum32(skk); const float rkk = __builtin_amdgcn_rsqf(skk + EPS); \
        _Pragma("unroll") for (int i_ = 0; i_ < 2; ++i_) { kk2[i_] *= rkk; nka2[i_] = -(kk2[i_] * aa[i_]); sc1 += kk2[i_] * aa[i_] * rrv[i_]; } \
        sc1 = half_sum32(sc1); sc2 = half_sum32(sc2); sbs = half_sum32(sbs); \
        *(LAS f32x2*)(B_ + O_KK + tl * 64 + d2) = kk2; *(LAS f32x2*)(B_ + O_WR + tl * 64 + d2) = wr2; *(LAS f32x2*)(B_ + O_W + tl * 64 + d2) = w2_; \
        *(LAS f32x2*)(B_ + O_NKA + tl * 64 + d2) = nka2; *(LAS f32x2*)(B_ + O_K + tl * 64 + d2) = k2; *(LAS f32x2*)(B_ + O_V + tl * 64 + d2) = v2_; \
        if ((tid & 31) == 0) { f32x4 sc; sc[0] = sc1; sc[1] = sc2; sc[2] = sbs; sc[3] = 0.f; *(LAS f32x4*)(B_ + O_SC + tl * 4) = sc; } } while (0)
    RW_LOAD(0); RW_XFORM(0); rg_cur = rg_nxt;
    __syncthreads();
    float S[4][2];
#pragma unroll
    for (int i = 0; i < 4; ++i) { S[i][0] = 0.f; S[i][1] = 0.f; }
    const int j = lane & 15, col = w * 8 + (lane >> 4) * 2;
    for (int c = 0; c < NCHUNK; ++c) {
        if (c + 1 < NCHUNK) RW_LOAD(c + 1);
        const LAS float* B_ = Lf + (c & 1) * BUFSZ;
#pragma unroll 4
        for (int t = 0; t < TC; ++t) {
            const f32x4 kk = *(const LAS f32x4*)(B_ + O_KK + t * 64 + 4 * j), wr = *(const LAS f32x4*)(B_ + O_WR + t * 64 + 4 * j), ww = *(const LAS f32x4*)(B_ + O_W + t * 64 + 4 * j);
            const f32x4 nka = *(const LAS f32x4*)(B_ + O_NKA + t * 64 + 4 * j), kv = *(const LAS f32x4*)(B_ + O_K + t * 64 + 4 * j);
            const f32x2 v2 = *(const LAS f32x2*)(B_ + O_V + t * 64 + col);
            const f32x4 sc = *(const LAS f32x4*)(B_ + O_SC + t * 4);
            float d10 = 0.f, d11 = 0.f, d20 = 0.f, d21 = 0.f;
#pragma unroll
            for (int i = 0; i < 4; ++i) { d10 += kk[i] * S[i][0]; d11 += kk[i] * S[i][1]; d20 += wr[i] * S[i][0]; d21 += wr[i] * S[i][1]; }
            d10 = row_sum16(d10); d11 = row_sum16(d11); d20 = row_sum16(d20); d21 = row_sum16(d21);
            const float o0 = d20 - d10 * sc[0] + v2[0] * sc[1], o1 = d21 - d11 * sc[0] + v2[1] * sc[1];
#pragma unroll
            for (int i = 0; i < 4; ++i) { S[i][0] = S[i][0] * ww[i] + d10 * nka[i] + v2[0] * kv[i]; S[i][1] = S[i][1] * ww[i] + d11 * nka[i] + v2[1] * kv[i]; }
            if (j == 0) { f32x2 o2 = {o0, o1}; *(LAS f32x2*)(Lf + O_OUT + t * 64 + col) = o2; }
        }
        if (c + 1 < NCHUNK) RW_XFORM((c + 1) & 1);
        __syncthreads();
        {
            const f32x2 o2 = *(const LAS f32x2*)(Lf + O_OUT + tl * 64 + d2); const f32x2 vv = *(const LAS f32x2*)(B_ + O_V + tl * 64 + d2); const float bs = B_[O_SC + tl * 4 + 2];
            const float mean = half_sum32(o2[0] + o2[1]) * (1.0f / 64.0f); const float e0 = o2[0] - mean, e1 = o2[1] - mean;
            const float var = half_sum32(e0 * e0 + e1 * e1) * (1.0f / 64.0f); const float rs = __builtin_amdgcn_rsqf(var + 64e-5f);
            const float y0 = (e0 * rs * lnw[0] + lnb[0] + bs * vv[0]) * bf_lo(rg_cur), y1 = (e1 * rs * lnw[1] + lnb[1] + bs * vv[1]) * bf_hi(rg_cur);
            *(GAS unsigned*)(Y + (size_t)(c * TC + tl) * D + d2) = pk2(y0, y1);
        }
        rg_cur = rg_nxt;
        __syncthreads();
    }
#undef RW_LOAD
#undef RW_XFORM
}

template <int LAYER>
__device__ __forceinline__ void post_rows(const Args& A, Frame& F) {
    const int gw = F.vcu * NWAVES + F.wave, NGW = F.G * NWAVES, lane = F.lane;
    const float* O = (const float*)(A.ws + WS_O); const bf16* P = (const bf16*)(A.ws + WS_PROJ); bf16* Y = (bf16*)(A.ws + WS_ACTA);
    for (int m = gw; m < T; m += NGW) {
        const GAS f32x4* orow = (const GAS f32x4*)(O + (size_t)m * D) + lane; const bf16* prow = P + (size_t)m * PROJ_LD;
        constexpr int NJ = LAYER == 0 ? 8 : 4;
#pragma unroll
        for (int jj = 0; jj < NJ; ++jj) {
            const f32x4 v = orow[64 * jj]; float ss = (v[0] * v[0] + v[1] * v[1]) + (v[2] * v[2] + v[3] * v[3]);
            const bool wide = (LAYER == 0 && jj < 4);
            const float ms = wide ? wave_sum(ss) * (1.0f / 256.0f) : half_sum32(ss) * (1.0f / 128.0f);
            const float r = __builtin_amdgcn_rsqf(ms + EPS);
            const int cih = wide ? 4 * lane : 4 * (lane & 31);
            const float* gsrc = LAYER == 0 ? (wide ? A.in[I_GLA_NORM] : A.in[I_GDN_NORM]) : A.in[I_HG_NORM];
            const f32x4 g = *(const GAS f32x4*)(gsrc + cih);
            const int zcol = LAYER == 0 ? (wide ? EC_GZ + jj * 256 + 4 * lane : EC_BZ + (jj - 4) * 256 + 4 * lane) : OC_HG + jj * 256 + 4 * lane;
            const u32x2 zw = *(const GAS u32x2*)(prow + zcol);
            const float y0 = v[0] * r * g[0] * siluf_(bf_lo(zw.x)), y1 = v[1] * r * g[1] * siluf_(bf_hi(zw.x)), y2 = v[2] * r * g[2] * siluf_(bf_lo(zw.y)), y3 = v[3] * r * g[3] * siluf_(bf_hi(zw.y));
            u32x2 o; o.x = pk2(y0, y1); o.y = pk2(y2, y3);
            *(GAS u32x2*)(Y + (size_t)m * D + 256 * jj + 4 * lane) = o;
        }
    }
}
__device__ __forceinline__ void lora_prep_rows(const Args& A, Frame& F) {
    const int gw = F.vcu * NWAVES + F.wave, NGW = F.G * NWAVES, lane = F.lane;
    const bf16* P = (const bf16*)(A.ws + WS_PROJ); bf16* LA = (bf16*)(A.ws + WS_LA); const float* mu = A.in[I_MU];
    for (int m = gw; m < T; m += NGW) { const bool hasprev = (m % SEQ) != 0; const bf16* prow = P + (size_t)m * PROJ_LD + OC_RW + RW_WL;
#pragma unroll
        for (int i = 0; i < 7; ++i) { const int c = lane + 64 * i;
            const float x = __uint_as_float((unsigned)prow[c] << 16), xp = hasprev ? __uint_as_float((unsigned)prow[c - PROJ_LD] << 16) : 0.f;
            const float ts = x + (xp - x) * mu[RW_WL + c];
            const float v = c < 96 ? tanhf(ts) : (c < 192 ? ts : sigmoidf_(ts));
            LA[(size_t)m * LORA_K + c] = (bf16)f2bf(v); }
        LA[(size_t)m * LORA_K + 448 + lane] = (bf16)0; }
}
__device__ __forceinline__ void final_rows(const Args& A, Frame& F) {
    const int gw = F.vcu * NWAVES + F.wave, NGW = F.G * NWAVES, lane = F.lane;
    const float* rowss = (const float*)(A.ws + WS_RSP) + (size_t)RS_FINAL * T * 32; const GAS f32x4* g = (const GAS f32x4*)A.in[I_NFINAL] + lane;
    for (int m = gw; m < T; m += NGW) { const float r = __builtin_amdgcn_rsqf(wave_sum(lane < 32 ? rowss[(size_t)m * 32 + lane] : 0.f) * (1.0f / D) + EPS); GAS f32x4* row = (GAS f32x4*)(A.out + (size_t)m * D) + lane;
#pragma unroll
        for (int jj = 0; jj < 8; ++jj) { const f32x4 v = row[64 * jj]; row[64 * jj] = v * r * g[64 * jj]; } }
}

__device__ __forceinline__ int med3i(int a, int b, int c) { int r; asm("v_med3_i32 %0, %1, %2, %3" : "=v"(r) : "v"(a), "v"(b), "v"(c)); return r; }
__device__ __forceinline__ int f2sort(float f) { int x = __float_as_int(f); return x ^ ((x >> 31) & 0x7fffffff); }
__device__ __forceinline__ float sort2f(int x) { return __int_as_float(x ^ ((x >> 31) & 0x7fffffff)); }
#define TOPK_INSERT(vals, x) do { _Pragma("unroll") for (int s_ = 15; s_ >= 1; --s_) vals[s_] = med3i((x), vals[s_ - 1], vals[s_]); vals[0] = max(vals[0], (x)); } while (0)
__device__ __forceinline__ float bf_dot2(unsigned a, unsigned b, float c) {
    return c + bf_lo(a) * bf_lo(b) + bf_hi(a) * bf_hi(b);
}
__device__ __forceinline__ void peer_phase(const Args& A, Frame& F, int L) {
    const int gw = F.vcu * NWAVES + F.wave, NGW = F.G * NWAVES, lane = F.lane;
    const bf16* SCR = (const bf16*)(A.ws + WS_SC); const bf16* X = (const bf16*)(A.ws + WS_ACTB); bf16* HG = (bf16*)(A.ws + WS_ACTA);
    const bf16* TU = (const bf16*)(A.ws + WS_TABU); const bf16* TV = (const bf16*)(A.ws + WS_TABV);
    const float* rowss = (const float*)(A.ws + WS_RSP) + (size_t)(L == 0 ? RS_FFN0 : RS_FFN1) * T * 32;
    const float* gple = A.in[I_NPLE] + (size_t)L * D;
    float* H = A.out;
    LAS unsigned* LIST = (LAS unsigned*)(F.lds + RING_OFF + F.wave * 16384);
    LAS unsigned* EIDX = LIST + 1024;
    LAS float* ECOEF = (LAS float*)(EIDX + 512);
    for (int tb = gw; tb < T / 4; tb += NGW) {
        const int t0 = tb * 4;
        {
            const bf16* sp = SCR + (size_t)(t0 + (lane >> 4)) * D + (lane & 15) * 128;
            int vals[16];
#pragma unroll
            for (int s = 0; s < 16; ++s) vals[s] = (int)0x80000000;
#pragma unroll 2
            for (int c = 0; c < 16; ++c) { const v4u wv = *(const GAS v4u*)(sp + c * 8); const unsigned ww[4] = {wv.x, wv.y, wv.z, wv.w};
#pragma unroll
                for (int e = 0; e < 8; ++e) { const unsigned bits = (e & 1) ? (ww[e >> 1] & 0xffff0000u) : (ww[e >> 1] << 16);
                    int x = (int)bits; x ^= (x >> 31) & 0x7fffffff; x = (x & ~0x7f) | (127 - (c * 8 + e));
                    TOPK_INSERT(vals, x); } }
#pragma unroll
            for (int q = 0; q < 4; ++q) { v4u o; o.x = (unsigned)vals[4 * q]; o.y = (unsigned)vals[4 * q + 1]; o.z = (unsigned)vals[4 * q + 2]; o.w = (unsigned)vals[4 * q + 3]; *(LAS v4u*)(LIST + lane * 16 + 4 * q) = o; }
        }
        LDS_WAIT(); asm volatile("" ::: "memory");
        if (lane < 32) {
            const LAS unsigned* la = LIST + ((lane >> 3) * 16 + (lane & 7) * 2) * 16; const LAS unsigned* lb2 = la + 16;
            float av[16], bv[16];
#pragma unroll
            for (int q = 0; q < 4; ++q) { const v4u a4 = *(const LAS v4u*)(la + 4 * q), b4 = *(const LAS v4u*)(lb2 + 4 * q); const unsigned aw[4] = {a4.x, a4.y, a4.z, a4.w}, bw[4] = {b4.x, b4.y, b4.z, b4.w};
#pragma unroll
                for (int e = 0; e < 4; ++e) { av[4 * q + e] = __uint_as_float(__float_as_uint(sort2f((int)(aw[e] & ~0x7fu))) & 0xffff0000u); bv[4 * q + e] = __uint_as_float(__float_as_uint(sort2f((int)(bw[e] & ~0x7fu))) & 0xffff0000u); } }
            int best[16];
#pragma unroll
            for (int s = 0; s < 16; ++s) best[s] = (int)0x80000000;
#pragma unroll
            for (int i = 0; i < 16; ++i)
#pragma unroll
                for (int jx = 0; jx < 16; ++jx) if ((i + 1) * (jx + 1) <= 16) { int x = f2sort(av[i] + bv[jx]); x = (x & ~0xff) | (255 - (i * 16 + jx)); TOPK_INSERT(best, x); }
            float sv[16]; unsigned ex[16];
#pragma unroll
            for (int s = 0; s < 16; ++s) { const int cand = 255 - (best[s] & 0xff); const unsigned ka = la[cand >> 4], kb = lb2[cand & 15];
                ex[s] = (127u - (ka & 0x7fu)) * 128u + (127u - (kb & 0x7fu));
                sv[s] = __uint_as_float(__float_as_uint(sort2f((int)(ka & ~0x7fu))) & 0xffff0000u) + __uint_as_float(__float_as_uint(sort2f((int)(kb & ~0x7fu))) & 0xffff0000u); }
            float mx = sv[0];
#pragma unroll
            for (int s = 1; s < 16; ++s) mx = fmaxf(mx, sv[s]);
            float den = 0.f;
#pragma unroll
            for (int s = 0; s < 16; ++s) { sv[s] = __expf(sv[s] - mx); den += sv[s]; }
            const float inv = 1.0f / den; const int base = (lane >> 3) * 128 + (lane & 7) * 16;
#pragma unroll
            for (int s = 0; s < 16; ++s) { EIDX[base + s] = ex[s]; ECOEF[base + s] = sv[s] * inv; }
        }
        LDS_WAIT(); asm volatile("" ::: "memory");
        for (int tok = 0; tok < 4; ++tok) {
            const int t = t0 + tok;
            const float rs = __builtin_amdgcn_rsqf(wave_sum(lane < 32 ? rowss[(size_t)t * 32 + lane] : 0.f) * (1.0f / D) + EPS);
            v4u xq[4];
#pragma unroll
            for (int jj = 0; jj < 4; ++jj) xq[jj] = *(const GAS v4u*)(X + (size_t)t * D + 512 * jj + 8 * lane);
#pragma unroll 1
            for (int k = 0; k < 128; k += 4) {
                v4u ur[4][4];
#pragma unroll
                for (int q = 0; q < 4; ++q) { const unsigned e = __builtin_amdgcn_readfirstlane(EIDX[tok * 128 + k + q]); const bf16* up = TU + (size_t)e * D + 8 * lane;
#pragma unroll
                    for (int jj = 0; jj < 4; ++jj) ur[q][jj] = *(const GAS v4u*)(up + 512 * jj); }
#pragma unroll
                for (int q = 0; q < 4; ++q) { float acc = 0.f;
#pragma unroll
                    for (int jj = 0; jj < 4; ++jj) { acc = bf_dot2(xq[jj].x, ur[q][jj].x, acc); acc = bf_dot2(xq[jj].y, ur[q][jj].y, acc); acc = bf_dot2(xq[jj].z, ur[q][jj].z, acc); acc = bf_dot2(xq[jj].w, ur[q][jj].w, acc); }
                    acc = wave_sum(acc) * rs;
                    const float act = 0.5f * acc * (1.0f + erff(acc * 0.7071067811865476f));
                    if (lane == 0) ECOEF[tok * 128 + k + q] *= act; }
            }
            LDS_WAIT(); asm volatile("" ::: "memory");
            float out[32];
#pragma unroll
            for (int i = 0; i < 32; ++i) out[i] = 0.f;
#pragma unroll 1
            for (int k = 0; k < 128; k += 4) {
                v4u vr[4][4]; float cf[4];
#pragma unroll
                for (int q = 0; q < 4; ++q) { const unsigned e = __builtin_amdgcn_readfirstlane(EIDX[tok * 128 + k + q]); cf[q] = ECOEF[tok * 128 + k + q]; const bf16* vp = TV + (size_t)e * D + 8 * lane;
#pragma unroll
                    for (int jj = 0; jj < 4; ++jj) vr[q][jj] = *(const GAS v4u*)(vp + 512 * jj); }
#pragma unroll
                for (int q = 0; q < 4; ++q)
#pragma unroll
                    for (int jj = 0; jj < 4; ++jj) { const unsigned ww[4] = {vr[q][jj].x, vr[q][jj].y, vr[q][jj].z, vr[q][jj].w};
#pragma unroll
                        for (int e = 0; e < 4; ++e) { out[jj * 8 + 2 * e] += cf[q] * bf_lo(ww[e]); out[jj * 8 + 2 * e + 1] += cf[q] * bf_hi(ww[e]); } }
            }
            float ss = 0.f;
#pragma unroll
            for (int jj = 0; jj < 4; ++jj) { GAS f32x4* hp = (GAS f32x4*)(H + (size_t)t * D + 512 * jj + 8 * lane);
                f32x4 h0 = hp[0], h1 = hp[1];
#pragma unroll
                for (int e = 0; e < 4; ++e) { h0[e] += out[jj * 8 + e]; h1[e] += out[jj * 8 + 4 + e]; out[jj * 8 + e] = h0[e]; out[jj * 8 + 4 + e] = h1[e]; ss += h0[e] * h0[e] + h1[e] * h1[e]; }
                hp[0] = h0; hp[1] = h1; }
            const float r3 = __builtin_amdgcn_rsqf(wave_sum(ss) * (1.0f / D) + EPS);
#pragma unroll
            for (int jj = 0; jj < 4; ++jj) { const GAS f32x4* gp = (const GAS f32x4*)(gple + 512 * jj + 8 * lane); const f32x4 g0 = gp[0], g1 = gp[1];
                v4u o; o.x = pk2(out[jj * 8 + 0] * r3 * g0[0], out[jj * 8 + 1] * r3 * g0[1]); o.y = pk2(out[jj * 8 + 2] * r3 * g0[2], out[jj * 8 + 3] * r3 * g0[3]);
                o.z = pk2(out[jj * 8 + 4] * r3 * g1[0], out[jj * 8 + 5] * r3 * g1[1]); o.w = pk2(out[jj * 8 + 6] * r3 * g1[2], out[jj * 8 + 7] * r3 * g1[3]);
                *(GAS v4u*)(HG + (size_t)t * D + 512 * jj + 8 * lane) = o; }
        }
        LDS_WAIT(); asm volatile("" ::: "memory");
    }
}

constexpr int N_PHASES = 19;
__global__ void __launch_bounds__(NTHREADS, 2) mega_fwd(Args args) {
    extern __shared__ __attribute__((aligned(16))) unsigned char lds[];
    Frame F;
    F.lds = (LAS unsigned char*)lds;
    F.MISC = (volatile LAS unsigned*)(F.lds + MISC_OFF);
    F.tid = threadIdx.x; F.lane = F.tid & 63; F.wave = __builtin_amdgcn_readfirstlane(F.tid >> 6);
    F.G = gridDim.x; { const int bx = blockIdx.x; F.vcu = (F.G % 8 == 0) ? (bx % 8) * (F.G / 8) + bx / 8 : bx; }
    unsigned char* ws = args.ws;
    F.ctl = (gu32*)(ws + WS_CTL);
    for (int u = F.tid; u < (LDS_BYTES - LDSCTL_OFF) / 4; u += NTHREADS) ((LAS unsigned*)(F.lds + LDSCTL_OFF))[u] = 0u;
    __syncthreads();
    const int lo = args.ph_lo, hi = args.ph_hi;
    XcdBarrier bar; bar.bar = (unsigned*)(F.ctl + CW_BAR); bar.x = 0; bar.st = nullptr;
    if (hi - lo > 1) bar = xcd_barrier_post((unsigned*)(F.ctl + CW_BAR), F.MISC + 8);
#define IN(k) (lo <= (k) && (k) < hi)
#define SEAM(k) do { if (IN(k) && IN((k) + 1)) { if ((k) == 0) { cg::this_grid().sync(); } else { xcd_barrier(bar); } } } while (0)
    float* rowss = (float*)(ws + WS_RSP);
    bf16* ACTA = (bf16*)(ws + WS_ACTA); bf16* ACTB = (bf16*)(ws + WS_ACTB); bf16* PROJ = (bf16*)(ws + WS_PROJ); bf16* SCB = (bf16*)(ws + WS_SC); bf16* PP = (bf16*)(ws + WS_PP);
    const int gtid = (F.vcu * NWAVES + F.wave) * 64 + F.lane, gthreads = F.G * NTHREADS;

    if (IN(0)) { p0_prologue(args, F); } SEAM(0);
    if (IN(1)) {
        { pg8::Gemm g{ACTA, (const bf16*)(ws + WS_WEV_IN), T, EV_NP, D}; pg8::StaticOrder S; S.init(T, EV_NP, F.G, (int)blockIdx.x); EpiBf16S E{PROJ, PROJ_LD, nullptr};
          pg8::gemm_phase<EpiBf16S, pg8::StaticOrder, true, true>(F.lds + RING_OFF, g, S, E); }
        { pg8::Gemm g{(const bf16*)(ws + WS_PBF), (const bf16*)(ws + WS_WPROJ), T, D, 256}; pg8::StaticOrder S; S.init(T, D, F.G, (int)blockIdx.x); EpiBf16S E{PP, D, nullptr};
          pg8::gemm_phase<EpiBf16S, pg8::StaticOrder, true, true>(F.lds + RING_OFF, g, S, E); }
    } SEAM(1);
    if (IN(2)) { for (int u = F.vcu; u < 256; u += F.G) { if (u < 128) scan_gla_unit<0>(args, F, u); else scan_gdn_unit(args, F, u - 128); __syncthreads(); } } SEAM(2);
    if (IN(3)) { post_rows<0>(args, F); } SEAM(3);
    if (IN(4)) { pg8::Gemm g{ACTA, (const bf16*)(ws + WS_WEV_OUT), T, D, D}; pg8::StaticOrder S; S.init(T, D, F.G, (int)blockIdx.x);
        EpiResid<false> E{args.in[I_X], args.out, ACTB, args.in[I_NFFN], rowss + (size_t)RS_FFN0 * T * 32, nullptr};
        pg8::gemm_phase<EpiResid<false>, pg8::StaticOrder, true, true>(F.lds + RING_OFF, g, S, E); } SEAM(4);
    if (IN(5)) { pg8::Gemm g{ACTB, (const bf16*)(ws + WS_WPEER), T, D, D}; pg8::StaticOrder S; S.init(T, D, F.G, (int)blockIdx.x); EpiBf16S E{SCB, D, rowss + (size_t)RS_FFN0 * T * 32};
        pg8::gemm_phase<EpiBf16S, pg8::StaticOrder, true, true>(F.lds + RING_OFF, g, S, E); } SEAM(5);
    if (IN(6)) { peer_phase(args, F, 0); } SEAM(6);
    if (IN(7)) { { pg8::Gemm g{ACTA, (const bf16*)(ws + WS_WGATE), T, D, D}; pg8::StaticOrder S; S.init(T, D, F.G, (int)blockIdx.x);
        EpiResid<true> E{args.out, args.out, ACTB, args.in[I_NMIX] + D, rowss + (size_t)RS_MIX1 * T * 32, PP};
        pg8::gemm_phase<EpiResid<true>, pg8::StaticOrder, true, true>(F.lds + RING_OFF, g, S, E); }
        cvt_f32_bf16(args.in[I_PEER_U] + (size_t)16384 * D, (bf16*)(ws + WS_TABU), (size_t)16384 * D, gtid, gthreads);
        cvt_f32_bf16(args.in[I_PEER_V] + (size_t)16384 * D, (bf16*)(ws + WS_TABV), (size_t)16384 * D, gtid, gthreads); } SEAM(7);
    if (IN(8)) {
        { pg8::Gemm g{ACTB, (const bf16*)(ws + WS_WOD_IN), T, OD_NP, D}; pg8::StaticOrder S; S.init(T, OD_NP, F.G, (int)blockIdx.x); EpiBf16S E{PROJ, PROJ_LD, rowss + (size_t)RS_MIX1 * T * 32};
          pg8::gemm_phase<EpiBf16S, pg8::StaticOrder, true, true>(F.lds + RING_OFF, g, S, E); }
        { pg8::Gemm g{(const bf16*)(ws + WS_PBF) + (size_t)T * 256, (const bf16*)(ws + WS_WPROJ) + (size_t)D * 256, T, D, 256}; pg8::StaticOrder S; S.init(T, D, F.G, (int)blockIdx.x); EpiBf16S E{PP, D, nullptr};
          pg8::gemm_phase<EpiBf16S, pg8::StaticOrder, true, true>(F.lds + RING_OFF, g, S, E); }
    } SEAM(8);
    if (IN(9)) { lora_prep_rows(args, F); } SEAM(9);
    if (IN(10)) { pg8::Gemm g{(const bf16*)(ws + WS_LA), (const bf16*)(ws + WS_WLORA), T, LORA_N, LORA_K}; pg8::StaticOrder S; S.init(T, LORA_N, F.G, (int)blockIdx.x); EpiBf16S E{(bf16*)(ws + WS_LO), LORA_N, nullptr};
        pg8::gemm_phase<EpiBf16S, pg8::StaticOrder, true, true>(F.lds + RING_OFF, g, S, E); } SEAM(10);
    if (IN(11)) { for (int u = F.vcu; u < 256; u += F.G) { if (u < 128) scan_gla_unit<1>(args, F, u); else scan_rwkv_unit(args, F, u - 128); __syncthreads(); } } SEAM(11);
    if (IN(12)) { post_rows<1>(args, F); } SEAM(12);
    if (IN(13)) { pg8::Gemm g{ACTA, (const bf16*)(ws + WS_WOD_OUT), T, D, D}; pg8::StaticOrder S; S.init(T, D, F.G, (int)blockIdx.x);
        EpiResid<false> E{args.out, args.out, ACTB, args.in[I_NFFN] + D, rowss + (size_t)RS_FFN1 * T * 32, nullptr};
        pg8::gemm_phase<EpiResid<false>, pg8::StaticOrder, true, true>(F.lds + RING_OFF, g, S, E); } SEAM(13);
    if (IN(14)) { pg8::Gemm g{ACTB, (const bf16*)(ws + WS_WPEER) + (size_t)D * D, T, D, D}; pg8::StaticOrder S; S.init(T, D, F.G, (int)blockIdx.x); EpiBf16S E{SCB, D, rowss + (size_t)RS_FFN1 * T * 32};
        pg8::gemm_phase<EpiBf16S, pg8::StaticOrder, true, true>(F.lds + RING_OFF, g, S, E); } SEAM(14);
    if (IN(15)) { peer_phase(args, F, 1); } SEAM(15);
    if (IN(16)) { pg8::Gemm g{ACTA, (const bf16*)(ws + WS_WGATE) + (size_t)D * D, T, D, D}; pg8::StaticOrder S; S.init(T, D, F.G, (int)blockIdx.x);
        EpiResid<true> E{args.out, args.out, nullptr, nullptr, rowss + (size_t)RS_FINAL * T * 32, PP};
        pg8::gemm_phase<EpiResid<true>, pg8::StaticOrder, true, true>(F.lds + RING_OFF, g, S, E); } SEAM(16);
    if (IN(17)) { final_rows(args, F); }
#undef IN
#undef SEAM
}

extern "C" void kernel_launch(void* const* d_in, const int* in_sizes, int n_in, void* d_out, int out_size, void* d_ws, size_t ws_size, hipStream_t stream) {
    static int grid = 0;
    if (grid == 0) {
        if (n_in != N_IN || out_size != T * D || ws_size < WS_END) { fprintf(stderr, "kernel_launch: unexpected problem: n_in %d out %d ws %zu (need %zu)\n", n_in, out_size, ws_size, (size_t)WS_END); grid = -1; return; }
        int dev = 0, cus = 0, per_cu = 0;
        if (hipGetDevice(&dev) != hipSuccess || hipDeviceGetAttribute(&cus, hipDeviceAttributeMultiprocessorCount, dev) != hipSuccess) { grid = -1; return; }
        if (hipFuncSetAttribute((const void*)mega_fwd, hipFuncAttributeMaxDynamicSharedMemorySize, LDS_BYTES) != hipSuccess) { fprintf(stderr, "kernel_launch: hipFuncSetAttribute failed\n"); grid = -1; return; }
        if (hipOccupancyMaxActiveBlocksPerMultiprocessor(&per_cu, (const void*)mega_fwd, NTHREADS, LDS_BYTES) != hipSuccess || per_cu < 1) { fprintf(stderr, "kernel_launch: occupancy query says %d blocks per CU\n", per_cu); (void)hipGetLastError(); grid = -1; return; }
        grid = cus;
    }
    if (grid < 0) return;
    (void)hipMemsetAsync((char*)d_ws + WS_CTL, 0, CTL_ZERO_BYTES, stream);
    Args a{};
    for (int i = 0; i < N_IN; ++i) a.in[i] = (const float*)d_in[i];
    a.out = (float*)d_out; a.ws = (unsigned char*)d_ws;
#if MK_PER_PHASE
    for (int p = 0; p < N_PHASES - 1; ++p) { a.ph_lo = p; a.ph_hi = p + 1; hipLaunchKernelGGL(mega_fwd, dim3(grid), dim3(NTHREADS), LDS_BYTES, stream, a); }
#else
    a.ph_lo = 0; a.ph_hi = N_PHASES;
    void* kargs[] = {&a};
    hipError_t e = hipLaunchCooperativeKernel((const void*)mega_fwd, dim3(grid), dim3(NTHREADS), kargs, LDS_BYTES, stream);
    if (e != hipSuccess) fprintf(stderr, "kernel_launch: cooperative launch failed: %s (grid %d)\n", hipGetErrorString(e), grid);
#endif
}
```

```cpp
#include <hip/hip_runtime.h>
#include <hip/hip_cooperative_groups.h>
#include <cstdio>
#include <cstdint>
namespace cg = cooperative_groups;

#ifndef MK_PER_PHASE
#define MK_PER_PHASE 0
#endif

namespace pg8 {
#define PG8_LAS __attribute__((address_space(3)))
typedef unsigned short bf16_t;
typedef short bf16x8 __attribute__((ext_vector_type(8)));
typedef float f32x4 __attribute__((ext_vector_type(4)));
typedef unsigned u32x4 __attribute__((ext_vector_type(4)));
typedef unsigned u32x2 __attribute__((ext_vector_type(2)));
constexpr int BM = 256, BK = 64, HALF = 128, HTB = HALF * BK * 2  , STAGE_BYTES = 8 * HTB, NXCD = 8, WGM = 8;

__host__ __device__ __forceinline__ int lds_byte(int r, int c) { const int st = (r >> 4) * 2 + (c >> 5), rr = r & 15, cc = c & 31, ob = rr * 64 + cc * 2; return st * 1024 + (ob ^ (((ob >> 9) & 1) << 5)); }
__host__ __device__ __forceinline__ void stage_rc(int b, int& R, int& C) { const int st = b / 1024, sb = b % 1024, swz = sb ^ (((sb >> 9) & 1) << 5); R = (st >> 1) * 16 + swz / 64; C = (st & 1) * 32 + (swz % 64) / 2; }
__host__ __device__ __forceinline__ int perm32(int rho) { const int n = rho >> 4, i = rho & 15; return 8 * (i >> 2) + 4 * n + (i & 3); }

struct Unit { int pm, pn; };
struct Gemm { const bf16_t* A; const bf16_t* Bt; int M, N, K; };

struct StaticOrder {
    int nM, nN, nwg, G, c;
    __host__ __device__ void init(int M, int N, int G_, int c_) { nM = M / BM; nN = N / BM; nwg = nM * nN; G = G_; c = c_; }
    __host__ __device__ bool next(int i, Unit& u) const {
        const long L = (long)i * G + c; if (L >= nwg) return false;
        int wgid = (int)L; { const int q = nwg / NXCD, r = nwg % NXCD, xcd = wgid % NXCD, off = wgid / NXCD; wgid = (xcd < r ? xcd * (q + 1) : r * (q + 1) + (xcd - r) * q) + off; }
        const int nig = WGM * nN, gid = wgid / nig, fm = gid * WGM, gsz = (nM - fm) < WGM ? (nM - fm) : WGM;
        u.pm = fm + ((wgid % nig) % gsz); u.pn = (wgid % nig) / gsz; return true;
    }
    __device__ __forceinline__ void a_ready(const Unit&) const {}
    __device__ __forceinline__ void done(const Unit&) const {}
};
__device__ __forceinline__ unsigned cvt_pk_bf16(float lo, float hi) { unsigned r; asm volatile("v_cvt_pk_bf16_f32 %0, %1, %2" : "=v"(r) : "v"(lo), "v"(hi)); return r; }
template <class Epi, class Sched, bool ALIGN_EPI = false, bool SP2 = false>
__device__ __forceinline__ void gemm_phase(PG8_LAS unsigned char* lds, const Gemm g, const Sched& S, const Epi& E) {
    const int tid = threadIdx.x, wid = __builtin_amdgcn_readfirstlane(tid >> 6), lane = tid & 63, wr = wid >> 2, wc = wid & 3, fr = lane & 15, fq = lane >> 4;
    const int K = g.K, nt = K / BK;
    unsigned voffA[2], voffB[2];
#pragma unroll
    for (int i = 0; i < 2; ++i) { int R, C; stage_rc(tid * 16 + i * 8192, R, C); const int Rb = Epi::PERM ? ((R & ~31) + perm32(R & 31)) : R;
        voffA[i] = (unsigned)(R * K + C) * 2u; voffB[i] = (unsigned)(Rb * K + C) * 2u; }
    const size_t kstep = (size_t)(BK * 2);
    const size_t hstep = (size_t)HALF * K * 2;
    const size_t tstep = 2 * hstep;
    const unsigned ldsw = (unsigned)wid * 1024u;
    const int aoff = lds_byte(wr * 64 + fr, fq * 8), boff = lds_byte(wc * 32 + fr, fq * 8);
#define PG8_SA(b, h) (((b) * 2 + (h)) * HTB)
#define PG8_SB(b, h) ((4 + (b) * 2 + (h)) * HTB)
#define PG8_STAGE(bufoff, gbase, voff) do { _Pragma("unroll") for (int _i = 0; _i < 2; ++_i) \
        __builtin_amdgcn_global_load_lds((const unsigned*)((const char*)(gbase) + (voff)[_i]), (PG8_LAS unsigned*)(lds + (bufoff) + ldsw + _i * 8192), 16, 0, 0); } while (0)
#define PG8_LDA(dst, b, h) do { _Pragma("unroll") for (int m = 0; m < 4; ++m) _Pragma("unroll") for (int k = 0; k < 2; ++k) dst[m][k] = *(const PG8_LAS bf16x8*)(lds + PG8_SA(b, h) + aoff + m * 2048 + k * 1024); } while (0)
#define PG8_LDB(dst, b, h) do { _Pragma("unroll") for (int n = 0; n < 2; ++n) _Pragma("unroll") for (int k = 0; k < 2; ++k) dst[n][k] = *(const PG8_LAS bf16x8*)(lds + PG8_SB(b, h) + boff + n * 2048 + k * 1024); } while (0)
#define PG8_MMA(ai, bj, At, Bt) do { __builtin_amdgcn_s_setprio(1); _Pragma("unroll") for (int m = 0; m < 4; ++m) _Pragma("unroll") for (int n = 0; n < 2; ++n) _Pragma("unroll") for (int k = 0; k < 2; ++k) \
        acc[ai][bj][m][n] = __builtin_amdgcn_mfma_f32_16x16x32_bf16(Bt[n][k], At[m][k], acc[ai][bj][m][n], 0, 0, 0); __builtin_amdgcn_s_setprio(0); } while (0)
#define PG8_WAIT_V(n) asm volatile("s_waitcnt vmcnt(" #n ")" ::: "memory")
#define PG8_WAIT_L(n) asm volatile("s_waitcnt lgkmcnt(" #n ")" ::: "memory")
#define PG8_BAR __builtin_amdgcn_s_barrier()
#define PG8_SCHED __builtin_amdgcn_sched_barrier(0)
    Unit cur, nxt; int ui = 0;
    if (!S.next(0, cur)) return;
    f32x4 acc[2][2][4][2];
#pragma unroll
    for (int a = 0; a < 2; ++a)
#pragma unroll
        for (int b = 0; b < 2; ++b)
#pragma unroll
            for (int m = 0; m < 4; ++m)
#pragma unroll
                for (int n = 0; n < 2; ++n) acc[a][b][m][n] = (f32x4){0.f, 0.f, 0.f, 0.f};
    bf16x8 At[4][2], B0[2][2], B1[2][2];
    const char* cA = (const char*)g.A + (size_t)cur.pm * tstep; const char* cB = (const char*)g.Bt + (size_t)cur.pn * tstep;
    S.a_ready(cur);
    if constexpr (SP2) {
        PG8_STAGE(PG8_SB(0, 0), cB, voffB); PG8_STAGE(PG8_SB(0, 1), cB + hstep, voffB); PG8_STAGE(PG8_SA(0, 0), cA, voffA); PG8_STAGE(PG8_SA(0, 1), cA + hstep, voffA);
        if (wr == 1) PG8_BAR;
        PG8_WAIT_V(2); PG8_BAR;
        PG8_STAGE(PG8_SB(1, 0), cB + kstep, voffB); PG8_STAGE(PG8_SA(1, 0), cA + kstep, voffA); PG8_STAGE(PG8_SB(1, 1), cB + hstep + kstep, voffB);
        PG8_WAIT_V(6); PG8_BAR;
    } else {
        PG8_STAGE(PG8_SB(0, 0), cB, voffB); PG8_STAGE(PG8_SA(0, 0), cA, voffA); PG8_STAGE(PG8_SB(0, 1), cB + hstep, voffB); PG8_STAGE(PG8_SA(0, 1), cA + hstep, voffA);
        if (wr == 1) PG8_BAR;
        PG8_WAIT_V(4); PG8_BAR;
        PG8_STAGE(PG8_SB(1, 0), cB + kstep, voffB); PG8_STAGE(PG8_SA(1, 0), cA + kstep, voffA); PG8_STAGE(PG8_SB(1, 1), cB + hstep + kstep, voffB);
        PG8_WAIT_V(6); PG8_BAR;
    }
    for (;;) {
        const bool has_next = S.next(ui + 1, nxt);
        const char* nA = has_next ? (const char*)g.A + (size_t)nxt.pm * tstep : cA; const char* nB = has_next ? (const char*)g.Bt + (size_t)nxt.pn * tstep : cB;
        for (int t = 0; t < nt; t += 2) {
            const bool last = (t == nt - 2);
            const char* a1 = cA + (size_t)(t + 1) * kstep;
            const char* a2 = last ? nA : cA + (size_t)(t + 2) * kstep; const char* b2 = last ? nB : cB + (size_t)(t + 2) * kstep;
            const char* a3 = a2 + kstep; const char* b3 = b2 + kstep;
            if (last && has_next) S.a_ready(nxt);
            if constexpr (SP2) {
            PG8_LDB(B0, 0, 0); PG8_LDB(B1, 0, 1); PG8_SCHED; PG8_LDA(At, 0, 0); PG8_STAGE(PG8_SA(1, 1), a1 + hstep, voffA);
            PG8_WAIT_V(8); PG8_WAIT_L(0); PG8_BAR; PG8_MMA(0, 0, At, B0); PG8_MMA(0, 1, At, B1); PG8_BAR; PG8_SCHED;
            PG8_LDA(At, 0, 1); PG8_STAGE(PG8_SB(0, 0), b2, voffB); PG8_STAGE(PG8_SB(0, 1), b2 + hstep, voffB); PG8_STAGE(PG8_SA(0, 0), a2, voffA);
            PG8_WAIT_V(8); PG8_WAIT_L(0); PG8_BAR; PG8_MMA(1, 0, At, B0); PG8_MMA(1, 1, At, B1); PG8_BAR; PG8_SCHED;
            PG8_LDB(B0, 1, 0); PG8_LDB(B1, 1, 1); PG8_SCHED; PG8_LDA(At, 1, 0); PG8_STAGE(PG8_SA(0, 1), a2 + hstep, voffA);
            PG8_WAIT_V(8); PG8_WAIT_L(0); PG8_BAR; PG8_MMA(0, 0, At, B0); PG8_MMA(0, 1, At, B1); PG8_BAR; PG8_SCHED;
            PG8_LDA(At, 1, 1); PG8_STAGE(PG8_SB(1, 0), b3, voffB); PG8_STAGE(PG8_SB(1, 1), b3 + hstep, voffB); PG8_STAGE(PG8_SA(1, 0), a3, voffA);
            PG8_WAIT_V(8); PG8_WAIT_L(0); PG8_BAR; PG8_MMA(1, 0, At, B0); PG8_MMA(1, 1, At, B1); PG8_BAR; PG8_SCHED;
            } else {
            PG8_LDB(B0, 0, 0); PG8_SCHED; PG8_LDA(At, 0, 0); PG8_STAGE(PG8_SA(1, 1), a1 + hstep, voffA);
            PG8_WAIT_L(8); PG8_BAR; PG8_WAIT_L(0); PG8_MMA(0, 0, At, B0); PG8_BAR; PG8_SCHED;
            PG8_LDB(B1, 0, 1); PG8_STAGE(PG8_SB(0, 0), b2, voffB);
            PG8_BAR; PG8_WAIT_L(0); PG8_MMA(0, 1, At, B1); PG8_BAR;
            PG8_LDA(At, 0, 1); PG8_STAGE(PG8_SA(0, 0), a2, voffA);
            PG8_BAR; PG8_WAIT_L(0); PG8_MMA(1, 0, At, B0); PG8_BAR; PG8_SCHED;
            PG8_STAGE(PG8_SB(0, 1), b2 + hstep, voffB);
            PG8_WAIT_V(6); PG8_BAR; PG8_MMA(1, 1, At, B1); PG8_BAR;
            PG8_LDB(B0, 1, 0); PG8_SCHED; PG8_LDA(At, 1, 0); PG8_STAGE(PG8_SA(0, 1), a2 + hstep, voffA);
            PG8_WAIT_L(8); PG8_BAR; PG8_WAIT_L(0); PG8_MMA(0, 0, At, B0); PG8_BAR; PG8_SCHED;
            PG8_LDB(B1, 1, 1); PG8_STAGE(PG8_SB(1, 0), b3, voffB);
            PG8_BAR; PG8_WAIT_L(0); PG8_MMA(0, 1, At, B1); PG8_BAR;
            PG8_LDA(At, 1, 1); PG8_STAGE(PG8_SA(1, 0), a3, voffA);
            PG8_BAR; PG8_WAIT_L(0); PG8_MMA(1, 0, At, B0); PG8_BAR; PG8_SCHED;
            PG8_STAGE(PG8_SB(1, 1), b3 + hstep, voffB);
            PG8_WAIT_V(6); PG8_BAR; PG8_MMA(1, 1, At, B1); PG8_BAR;
            }
        }
        if constexpr (ALIGN_EPI) { if (wr == 0) PG8_BAR; }
        if constexpr (!Epi::AFTER_DRAIN) { E(acc, cur, wr, wc, fr, fq); S.done(cur); }
        if (!has_next) break;
#pragma unroll
        for (int a = 0; a < 2; ++a)
#pragma unroll
            for (int b = 0; b < 2; ++b)
#pragma unroll
                for (int m = 0; m < 4; ++m)
#pragma unroll
                    for (int n = 0; n < 2; ++n) acc[a][b][m][n] = (f32x4){0.f, 0.f, 0.f, 0.f};
        cur = nxt; cA = nA; cB = nB; ++ui;
        if constexpr (ALIGN_EPI) { if (wr == 1) PG8_BAR; }
    }
    PG8_WAIT_V(0);
    if constexpr (!ALIGN_EPI) { if (wr == 0) PG8_BAR; }
    PG8_BAR;
    if constexpr (Epi::AFTER_DRAIN) { E.fused(acc, cur, wr, wc, fr, fq, lds, wid, lane); S.done(cur); }
#undef PG8_SA
#undef PG8_SB
#undef PG8_STAGE
#undef PG8_LDA
#undef PG8_LDB
#undef PG8_MMA
#undef PG8_WAIT_V
#undef PG8_WAIT_L
#undef PG8_BAR
#undef PG8_SCHED
}
}
#define GAS __attribute__((address_space(1)))
#define LAS __attribute__((address_space(3)))
typedef unsigned short bf16;
typedef unsigned v4u __attribute__((ext_vector_type(4)));
typedef float f32x4 __attribute__((ext_vector_type(4)));
typedef short bf16x8 __attribute__((ext_vector_type(8)));
typedef GAS unsigned gu32;
typedef GAS unsigned long long gu64;
#define RLX_AGENT __ATOMIC_RELAXED, __HIP_MEMORY_SCOPE_AGENT
#define LDS_WAIT() asm volatile("s_waitcnt lgkmcnt(0)" ::: "memory")
#define VM_WAIT() asm volatile("s_waitcnt vmcnt(0)" ::: "memory")
__device__ __forceinline__ unsigned long long rt() { return __builtin_amdgcn_s_memrealtime(); }
__device__ __forceinline__ unsigned f2bf(float f) { unsigned u = __builtin_bit_cast(unsigned, f); return (u + 0x7fffu + ((u >> 16) & 1u)) >> 16; }
__device__ __forceinline__ unsigned pk2(float lo, float hi) { return f2bf(lo) | (f2bf(hi) << 16); }

#define XB_TMO      128
#define XB_XCNT(j)  (256  + 64 * (j))
#define XB_XSUB(j)  (1280 + 64 * (j))
#define XB_XGEN(j)  (2304 + 64 * (j))
#define XB_TOP      3328
#define XB_TOPGEN   3392
#define XCD_BAR_WORDS 3456
#define XB_SPIN_CAP (1u << 18)

__device__ __forceinline__ unsigned xb_ld(unsigned* p)              { return __hip_atomic_load(p, __ATOMIC_RELAXED, __HIP_MEMORY_SCOPE_AGENT); }
__device__ __forceinline__ unsigned xb_add(unsigned* p, unsigned v) { return __hip_atomic_fetch_add(p, v, __ATOMIC_RELAXED, __HIP_MEMORY_SCOPE_AGENT); }
__device__ __forceinline__ unsigned xb_xcc_id() { return (unsigned)__builtin_amdgcn_s_getreg((3 << 11) | 20) & 0xFu; }
#define XB_SPIN(cond, bar) do { unsigned _sp = 0; while (cond) { __builtin_amdgcn_s_sleep(1); \
    if ((++_sp & 255u) == 0u) { if (xb_ld(&(bar)[XB_TMO])) break; if (_sp > XB_SPIN_CAP) { atomicAdd(&(bar)[XB_TMO], 1u); break; } } } } while (0)

struct XcdBarrier {
    unsigned* bar; unsigned x;
    volatile LAS unsigned* st;
};

__device__ __forceinline__ XcdBarrier xcd_barrier_post(unsigned* bar, volatile LAS unsigned* st) {
    XcdBarrier b; b.bar = bar; b.x = xb_xcc_id(); b.st = st;
    if (threadIdx.x == 0) (void)xb_add(&bar[XB_XCNT(b.x)], 1u);
    return b;
}
__device__ __forceinline__ void xcd_barrier_complete(unsigned* bar, unsigned x, unsigned& nloc, unsigned& nx) {
    const unsigned G = gridDim.x * gridDim.y * gridDim.z;
    unsigned sum, cnt, mine, sp = 0u;
    for (;;) {
        sum = 0u; cnt = 0u; mine = 0u;
#pragma unroll
        for (unsigned j = 0; j < 16; ++j) { const unsigned c = xb_ld(&bar[XB_XCNT(j)]); sum += c; cnt += (c > 0u) ? 1u : 0u; mine = (j == x) ? c : mine; }
        if (sum == G) break;
        __builtin_amdgcn_s_sleep(1);
        if ((++sp & 255u) == 0u) { if (xb_ld(&bar[XB_TMO])) break; if (sp > XB_SPIN_CAP) { atomicAdd(&bar[XB_TMO], 1u); break; } }
    }
    nloc = mine > 0u ? mine : 1u; nx = cnt > 0u ? cnt : 1u;
}

__device__ __forceinline__ void xcd_barrier(const XcdBarrier& b) {
    asm volatile("s_waitcnt vmcnt(0)" ::: "memory");
    __syncthreads();
    if (threadIdx.x == 0) {
        unsigned* bar = b.bar;
        __builtin_amdgcn_s_waitcnt(0);
        unsigned nloc = b.st[0], nx = b.st[1];
        if (nloc == 0u) { xcd_barrier_complete(bar, b.x, nloc, nx); b.st[0] = nloc; b.st[1] = nx; }
        const unsigned old = xb_add(&bar[XB_XSUB(b.x)], 1u);
        const unsigned gen = old / nloc;
        if (old + 1u == (gen + 1u) * nloc) {
            __builtin_amdgcn_fence(__ATOMIC_RELEASE, "agent");
            asm volatile("s_waitcnt vmcnt(0)" ::: "memory");
            const unsigned og = xb_add(&bar[XB_TOP], 1u);
            const unsigned tg = og / nx;
            if (og + 1u == (tg + 1u) * nx) xb_add(&bar[XB_TOPGEN], 1u);
            else XB_SPIN(xb_ld(&bar[XB_TOPGEN]) == tg, bar);
            __builtin_amdgcn_fence(__ATOMIC_ACQUIRE, "agent");
            xb_add(&bar[XB_XGEN(b.x)], 1u);
            asm volatile("s_waitcnt vmcnt(0)" ::: "memory");
        } else {
            XB_SPIN(xb_ld(&bar[XB_XGEN(b.x)]) == gen, bar);
            __builtin_amdgcn_fence(__ATOMIC_ACQUIRE, "agent");
            asm volatile("s_waitcnt vmcnt(0)" ::: "memory");
        }
    }
    __syncthreads();
}

constexpr int NWAVES = 8, NTHREADS = NWAVES * 64;
constexpr int BATCH = 8, SEQ = 2048, T = BATCH * SEQ, D = 2048;
constexpr int EV_N = 7200, EV_NP = 7424, OD_N = 7616, OD_NP = 7680, PROJ_LD = 7680;
constexpr float EPS = 1e-6f;
constexpr int EC_GQ = 0, EC_GK = 512, EC_GV = 1024, EC_GZ = 2048, EC_GLR = 3072, EC_BQ = 3088, EC_BK = 4112, EC_BV = 5136, EC_BZ = 6160, EC_BA = 7184, EC_BB = 7192;
constexpr int OC_HQ = 0, OC_HF = 1024, OC_HI = 2048, OC_HG = 3072, OC_RW = 4096;
constexpr int RW_R = 0, RW_K = 1024, RW_V = 2048, RW_WL = 3072, RW_AL = 3168, RW_GL = 3264;
constexpr int LORA_K = 512, LORA_N = 3072;
enum { I_X = 0, I_P, I_EV_WIN, I_GK_W2, I_GK_B, I_GLA_NORM, I_GDN_CONV, I_GDN_ALOG, I_GDN_DTB, I_GDN_NORM, I_EV_WOUT, I_OD_WIN, I_LB, I_HG_NORM,
       I_MU, I_W0, I_W2, I_A0, I_A2, I_G2, I_KK, I_KA, I_RK, I_LNW, I_LNB, I_OD_WOUT, I_NMIX, I_NFFN, I_NPLE, I_PEER_WQ, I_PEER_SK, I_PEER_U, I_PEER_V,
       I_PLE_WP, I_PLE_WG, I_NFINAL, N_IN };

constexpr size_t MiB = 1u << 20;
constexpr size_t WS_CTL = 0, CTL_ZERO_BYTES = 1 * MiB;
constexpr size_t WS_WEV_IN = 1 * MiB, WS_WEV_OUT = 30 * MiB, WS_WOD_IN = 38 * MiB, WS_WOD_OUT = 68 * MiB, WS_WPEER = 76 * MiB, WS_WGATE = 92 * MiB, WS_WPROJ = 108 * MiB,
                 WS_WLORA = 110 * MiB, WS_PBF = 113 * MiB, WS_TABU = 129 * MiB, WS_TABV = 193 * MiB, WS_ACTA = 257 * MiB, WS_ACTB = 321 * MiB, WS_PROJ = 385 * MiB, WS_SC = 385 * MiB,
                 WS_O = 625 * MiB, WS_PP = 753 * MiB, WS_LA = 817 * MiB, WS_LO = 833 * MiB, WS_RSP = 929 * MiB, WS_END = 937 * MiB;
static_assert(WS_WEV_IN + (size_t)EV_NP * D * 2 <= WS_WEV_OUT && WS_WOD_IN + (size_t)OD_NP * D * 2 <= WS_WOD_OUT && WS_PROJ + (size_t)T * PROJ_LD * 2 <= WS_O, "ws map");
constexpr int CW_BAR = 4096;
enum { RS_FFN0 = 0, RS_MIX1 = 1, RS_FFN1 = 2, RS_FINAL = 3 };
constexpr int RING_OFF = 0, RING_BYTES = 131072;
constexpr int LDSCTL_OFF = RING_BYTES, MISC_OFF = LDSCTL_OFF + 320;
constexpr int LDS_BYTES = 147456;

struct Args { const float* in[N_IN]; float* out; unsigned char* ws; int ph_lo, ph_hi; };
struct Frame {
    LAS unsigned char* lds; volatile LAS unsigned* MISC; gu32* ctl;
    int tid, lane, wave, vcu, G;
};
__device__ __forceinline__ float wave_sum(float v) {
#pragma unroll
    for (int o = 1; o < 64; o <<= 1) v += __shfl_xor(v, o);
    return v;
}
__device__ __forceinline__ float half_sum32(float v) {
#pragma unroll
    for (int o = 1; o < 32; o <<= 1) v += __shfl_xor(v, o);
    return v;
}
#define DPP_ADD(v, ctrl) (v) += __builtin_bit_cast(float, __builtin_amdgcn_update_dpp(0, __builtin_bit_cast(int, (v)), (ctrl), 0xF, 0xF, false))
__device__ __forceinline__ float row_sum16(float v) {
    DPP_ADD(v, 0x128); DPP_ADD(v, 0x124); DPP_ADD(v, 0x122); DPP_ADD(v, 0x121);
    return v;
}
__device__ __forceinline__ float bf_lo(unsigned w) { return __uint_as_float(w << 16); }
__device__ __forceinline__ float bf_hi(unsigned w) { return __uint_as_float(w & 0xffff0000u); }
__device__ __forceinline__ float sigmoidf_(float x) { return 1.0f / (1.0f + __expf(-x)); }
__device__ __forceinline__ float siluf_(float x) { return x / (1.0f + __expf(-x)); }
__device__ __forceinline__ float softplusf_(float x) { return fmaxf(x, 0.f) + log1pf(__expf(-fabsf(x))); }
__device__ __forceinline__ float logsigmoidf_(float x) { return fminf(x, 0.f) - log1pf(__expf(-fabsf(x))); }

struct EpiBf16S {
    static constexpr bool PERM = true, AFTER_DRAIN = false;
    bf16* O; int ldc; const float* rowss;
    __device__ __forceinline__ void operator()(const pg8::f32x4 (&acc)[2][2][4][2], const pg8::Unit& u, int wr, int wc, int fr, int fq) const {
        const int row0 = u.pm * 256 + wr * 64 + fr, col0 = u.pn * 256 + wc * 32 + 8 * fq;
#pragma unroll
        for (int ai = 0; ai < 2; ++ai)
#pragma unroll
            for (int m = 0; m < 4; ++m) {
                const int row = row0 + ai * 128 + m * 16;
                float sc = 1.f;
                if (rowss) { const pg8::f32x4* rp = (const pg8::f32x4*)(rowss + (size_t)row * 32 + 8 * fq); const pg8::f32x4 p0 = rp[0], p1 = rp[1];
                    float s = ((p0[0] + p0[1]) + (p0[2] + p0[3])) + ((p1[0] + p1[1]) + (p1[2] + p1[3])); s += __shfl_xor(s, 16); s += __shfl_xor(s, 32);
                    sc = __builtin_amdgcn_rsqf(s * (1.0f / D) + EPS); }
                bf16* rowp = O + (size_t)row * ldc + col0;
#pragma unroll
                for (int bj = 0; bj < 2; ++bj) { const pg8::f32x4 v0 = acc[ai][bj][m][0] * sc, v1 = acc[ai][bj][m][1] * sc;
                    pg8::u32x4 w; w.x = pg8::cvt_pk_bf16(v0[0], v0[1]); w.y = pg8::cvt_pk_bf16(v0[2], v0[3]); w.z = pg8::cvt_pk_bf16(v1[0], v1[1]); w.w = pg8::cvt_pk_bf16(v1[2], v1[3]);
                    *(pg8::u32x4*)(rowp + bj * 128) = w; } }
    }
};
template <bool GATE> struct EpiResid {
    static constexpr bool PERM = false, AFTER_DRAIN = false;
    const float* hin; float* hout; bf16* hg; const float* gain; float* rowss; const bf16* pp;
    __device__ __forceinline__ void operator()(const pg8::f32x4 (&acc)[2][2][4][2], const pg8::Unit& u, int wr, int wc, int fr, int fq) const {
        const int row0 = u.pm * 256 + wr * 64 + fr, col0 = u.pn * 256 + wc * 32 + 4 * fq;
        pg8::f32x4 gv[2][2];
#pragma unroll
        for (int bj = 0; bj < 2; ++bj)
#pragma unroll
            for (int n = 0; n < 2; ++n) gv[bj][n] = hg ? *(const pg8::f32x4*)(gain + col0 + bj * 128 + n * 16) : (pg8::f32x4){0.f, 0.f, 0.f, 0.f};
#pragma unroll
        for (int ai = 0; ai < 2; ++ai)
#pragma unroll
            for (int m = 0; m < 4; ++m) {
                const int row = row0 + ai * 128 + m * 16; const size_t off = (size_t)row * D + col0; float ss = 0.f;
#pragma unroll
                for (int bj = 0; bj < 2; ++bj)
#pragma unroll
                    for (int n = 0; n < 2; ++n) { const size_t o = off + bj * 128 + n * 16;
                        pg8::f32x4 hv = *(const pg8::f32x4*)(hin + o); pg8::f32x4 a = acc[ai][bj][m][n];
                        if (GATE) { const pg8::u32x2 pw = *(const pg8::u32x2*)(pp + o);
                            a[0] = sigmoidf_(a[0]) * bf_lo(pw.x); a[1] = sigmoidf_(a[1]) * bf_hi(pw.x); a[2] = sigmoidf_(a[2]) * bf_lo(pw.y); a[3] = sigmoidf_(a[3]) * bf_hi(pw.y); }
                        hv = hv + a; *(pg8::f32x4*)(hout + o) = hv;
                        ss += (hv[0] * hv[0] + hv[1] * hv[1]) + (hv[2] * hv[2] + hv[3] * hv[3]);
                        if (hg) { const pg8::f32x4 q = hv * gv[bj][n]; pg8::u32x2 w; w.x = pg8::cvt_pk_bf16(q[0], q[1]); w.y = pg8::cvt_pk_bf16(q[2], q[3]); *(pg8::u32x2*)(hg + o) = w; } }
                ss += __shfl_xor(ss, 16); ss += __shfl_xor(ss, 32);
                if (fq == 0) rowss[(size_t)row * 32 + u.pn * 4 + wc] = ss;
                asm volatile("" ::: "memory"); }
    }
};

__device__ __forceinline__ void p0_transpose_item(const float* W, int K, int N, bf16* WT, LAS float* scr, int item, int lane) {
    const int nblk = N / 32, kb = item / nblk, nb = item % nblk, k0 = 64 * kb, n0 = 32 * nb;
#pragma unroll 8
    for (int i = 0; i < 32; ++i) { const int kk = 2 * i + (lane >> 5); scr[kk * 33 + (lane & 31)] = W[(size_t)(k0 + kk) * N + n0 + (lane & 31)]; }
    LDS_WAIT(); asm volatile("" ::: "memory");
    const int c = lane & 7;
#pragma unroll
    for (int j = 0; j < 4; ++j) { const int n = (lane >> 3) + 8 * j; const LAS float* s = scr + (8 * c) * 33 + n;
        v4u o; o.x = pk2(s[0 * 33], s[1 * 33]); o.y = pk2(s[2 * 33], s[3 * 33]); o.z = pk2(s[4 * 33], s[5 * 33]); o.w = pk2(s[6 * 33], s[7 * 33]);
        *(GAS v4u*)(WT + (size_t)(n0 + n) * K + k0 + 8 * c) = o; }
    LDS_WAIT(); asm volatile("" ::: "memory");
}
__device__ __forceinline__ void cvt_f32_bf16(const float* src, bf16* dst, size_t n, int gtid, int gthreads) {
    const size_t n8 = n / 8;
    for (size_t i = gtid; i < n8; i += gthreads) {
        const f32x4 a = *(const GAS f32x4*)(src + i * 8), b = *(const GAS f32x4*)(src + i * 8 + 4);
        v4u o; o.x = pk2(a[0], a[1]); o.y = pk2(a[2], a[3]); o.z = pk2(b[0], b[1]); o.w = pk2(b[2], b[3]);
        *(GAS v4u*)(dst + i * 8) = o; }
}
__device__ __forceinline__ void rms_row_to_bf16(const float* xrow, const float* g, bf16* orow, int lane) {
    const GAS f32x4* xr = (const GAS f32x4*)xrow + lane; f32x4 v[8]; float s = 0.f;
#pragma unroll
    for (int j = 0; j < 8; ++j) { v[j] = xr[64 * j]; s += (v[j][0] * v[j][0] + v[j][1] * v[j][1]) + (v[j][2] * v[j][2] + v[j][3] * v[j][3]); }
    const float r = __builtin_amdgcn_rsqf(wave_sum(s) * (1.0f / D) + EPS);
    const GAS f32x4* gr = (const GAS f32x4*)g + lane;
    GAS unsigned long long* o8 = (GAS unsigned long long*)orow + lane;
#pragma unroll
    for (int j = 0; j < 8; ++j) { const f32x4 gg = gr[64 * j]; o8[64 * j] = (unsigned long long)pk2(v[j][0] * r * gg[0], v[j][1] * r * gg[1]) | ((unsigned long long)pk2(v[j][2] * r * gg[2], v[j][3] * r * gg[3]) << 32); }
}
__device__ __forceinline__ void p0_fold_item(const float* wq, const float* sk, bf16* WP, LAS float* lds, int item, int tid) {
    const int hp = item >> 5, k0 = (item & 31) * 64;
    LAS float* skT = lds;
    LAS float* wqT = lds + 128 * 132;
    const float* skb = sk + (size_t)hp * 128 * 128;
#pragma unroll 4
    for (int i = 0; i < 32; ++i) { const int idx = i * 512 + tid, n = idx >> 7, d = idx & 127; skT[d * 132 + n] = skb[idx]; }
#pragma unroll 4
    for (int i = 0; i < 16; ++i) { const int idx = i * 512 + tid, kk = idx >> 7, d = idx & 127; wqT[d * 68 + kk] = wq[(size_t)(k0 + kk) * D + hp * 128 + d]; }
    __syncthreads();
    const int n0 = (tid >> 4) * 4, kk0 = (tid & 15) * 4;
    float acc[4][4];
#pragma unroll
    for (int i = 0; i < 4; ++i)
#pragma unroll
        for (int j = 0; j < 4; ++j) acc[i][j] = 0.f;
#pragma unroll 4
    for (int d = 0; d < 128; ++d) { const f32x4 a = *(const LAS f32x4*)(skT + d * 132 + n0), b = *(const LAS f32x4*)(wqT + d * 68 + kk0);
#pragma unroll
        for (int i = 0; i < 4; ++i)
#pragma unroll
            for (int j = 0; j < 4; ++j) acc[i][j] += a[i] * b[j]; }
#pragma unroll
    for (int i = 0; i < 4; ++i) { unsigned long long o = (unsigned long long)pk2(acc[i][0], acc[i][1]) | ((unsigned long long)pk2(acc[i][2], acc[i][3]) << 32);
        *(GAS unsigned long long*)(WP + (size_t)(hp * 128 + n0 + i) * D + k0 + kk0) = o; }
    __syncthreads();
}
__device__ __forceinline__ void p0_prologue(const Args& A, Frame& F) {
    const int gw = F.vcu * NWAVES + F.wave, NGW = F.G * NWAVES;
    const int gtid = (F.vcu * NWAVES + F.wave) * 64 + F.lane, gthreads = F.G * NTHREADS;
    unsigned char* ws = A.ws;
    {
        LAS float* scr = (LAS float*)(F.lds + RING_OFF + F.wave * 16384);
        constexpr int I_EVIN = (D / 64) * (EV_N / 32), I_SQ = (D / 64) * (D / 32), I_ODIN = (D / 64) * (OD_N / 32), I_PJ = (256 / 64) * (D / 32);
        constexpr int NITEMS = I_EVIN + I_SQ + I_ODIN + I_SQ + 2 * I_SQ + 2 * I_PJ;
        for (int it = gw; it < NITEMS; it += NGW) {
            int r = it;
            if (r < I_EVIN) { p0_transpose_item(A.in[I_EV_WIN], D, EV_N, (bf16*)(ws + WS_WEV_IN), scr, r, F.lane); continue; } r -= I_EVIN;
            if (r < I_SQ) { p0_transpose_item(A.in[I_EV_WOUT], D, D, (bf16*)(ws + WS_WEV_OUT), scr, r, F.lane); continue; } r -= I_SQ;
            if (r < I_ODIN) { p0_transpose_item(A.in[I_OD_WIN], D, OD_N, (bf16*)(ws + WS_WOD_IN), scr, r, F.lane); continue; } r -= I_ODIN;
            if (r < I_SQ) { p0_transpose_item(A.in[I_OD_WOUT], D, D, (bf16*)(ws + WS_WOD_OUT), scr, r, F.lane); continue; } r -= I_SQ;
            if (r < 2 * I_SQ) { const int L = r / I_SQ; p0_transpose_item(A.in[I_PLE_WG] + (size_t)L * D * D, D, D, (bf16*)(ws + WS_WGATE) + (size_t)L * D * D, scr, r % I_SQ, F.lane); continue; } r -= 2 * I_SQ;
            { const int L = r / I_PJ; p0_transpose_item(A.in[I_PLE_WP] + (size_t)L * 256 * D, 256, D, (bf16*)(ws + WS_WPROJ) + (size_t)L * D * 256, scr, r % I_PJ, F.lane); }
        }
        { GAS v4u* z0 = (GAS v4u*)(ws + WS_WEV_IN + (size_t)EV_N * D * 2); const size_t n0 = (size_t)(EV_NP - EV_N) * D * 2 / 16;
          for (size_t i = gtid; i < n0; i += gthreads) z0[i] = (v4u){0u, 0u, 0u, 0u};
          GAS v4u* z1 = (GAS v4u*)(ws + WS_WOD_IN + (size_t)OD_N * D * 2); const size_t n1 = (size_t)(OD_NP - OD_N) * D * 2 / 16;
          for (size_t i = gtid; i < n1; i += gthreads) z1[i] = (v4u){0u, 0u, 0u, 0u}; }
    }
    __syncthreads();
    for (int it = F.vcu; it < 1024; it += F.G) { const int L = it >> 9;
        p0_fold_item(A.in[I_PEER_WQ] + (size_t)L * D * D, A.in[I_PEER_SK] + (size_t)L * 16 * 128 * 128, (bf16*)(ws + WS_WPEER) + (size_t)L * D * D, (LAS float*)(F.lds + RING_OFF), it & 511, F.tid); }
    cvt_f32_bf16(A.in[I_PEER_U], (bf16*)(ws + WS_TABU), (size_t)16384 * D, gtid, gthreads);
    cvt_f32_bf16(A.in[I_PEER_V], (bf16*)(ws + WS_TABV), (size_t)16384 * D, gtid, gthreads);
    cvt_f32_bf16(A.in[I_P], (bf16*)(ws + WS_PBF), (size_t)2 * T * 256, gtid, gthreads);
    { bf16* LB = (bf16*)(ws + WS_WLORA); const float* w2 = A.in[I_W2]; const float* a2 = A.in[I_A2]; const float* g2 = A.in[I_G2];
      for (int i = gtid; i < LORA_N * LORA_K / 2; i += gthreads) { const int row = i / (LORA_K / 2), col = (i % (LORA_K / 2)) * 2; float v[2];
#pragma unroll
          for (int e = 0; e < 2; ++e) { const int c = col + e; float x = 0.f;
              if (row < 1024) { if (c < 96) x = w2[c * 1024 + row]; }
              else if (row < 2048) { if (c >= 96 && c < 192) x = a2[(c - 96) * 1024 + (row - 1024)]; }
              else { if (c >= 192 && c < 448) x = g2[(c - 192) * 1024 + (row - 2048)]; }
              v[e] = x; }
          *(GAS unsigned*)(LB + (size_t)row * LORA_K + col) = pk2(v[0], v[1]); } }
    for (int m = gw; m < T; m += NGW) rms_row_to_bf16(A.in[I_X] + (size_t)m * D, A.in[I_NMIX], (bf16*)(ws + WS_ACTA) + (size_t)m * D, F.lane);
}

constexpr int TC = 16, NCHUNK = SEQ / TC;
typedef float f32x2 __attribute__((ext_vector_type(2)));
typedef unsigned u32x2 __attribute__((ext_vector_type(2)));

template <int MODE>
__device__ __forceinline__ void scan_gla_unit(const Args& A, Frame& F, int unit) {
    const int tid = F.tid, lane = F.lane, w = F.wave;
    int b, h, qcol, kcol, vcol, ocol;
    if (MODE == 0) { b = unit >> 4; h = (unit >> 2) & 3; const int s = unit & 3; qcol = EC_GQ + h * 128; kcol = EC_GK + h * 128; vcol = EC_GV + h * 256 + s * 64; ocol = h * 256 + s * 64; }
    else           { b = unit >> 4; h = (unit >> 1) & 7; const int s = unit & 1; qcol = OC_HQ + h * 128; kcol = OC_HF + h * 128; vcol = OC_HI + h * 128 + s * 64; ocol = h * 128 + s * 64; }
    const bf16* P = (const bf16*)(A.ws + WS_PROJ) + (size_t)b * SEQ * PROJ_LD;
    float* O = (float*)(A.ws + WS_O) + (size_t)b * SEQ * D + ocol;
    LAS float* Lf = (LAS float*)(F.lds + RING_OFF);
    constexpr int BUFSZ = 7168, O_EG = 0, O_K = 2048, O_Q = 4096, O_V = 6144, O_OUT = 2 * BUFSZ, O_W2 = O_OUT + 1024, O_BIAS = O_W2 + 2048;
    const int tl = tid >> 5, dq = (tid & 31) * 4, tlv = tid >> 4, c4 = (tid & 15) * 4;
    float lb[4] = {0.f, 0.f, 0.f, 0.f};
    if (MODE == 0) {
        const float* w2 = A.in[I_GK_W2]; const float* gb = A.in[I_GK_B];
        for (int i = tid; i < 2048; i += NTHREADS) Lf[O_W2 + i] = w2[(i >> 7) * 512 + h * 128 + (i & 127)];
        if (tid < 128) Lf[O_BIAS + tid] = gb[h * 128 + tid];
    } else {
        const float* lg = A.in[I_LB];
#pragma unroll
        for (int i = 0; i < 4; ++i) lb[i] = sigmoidf_(lg[1024 + h * 128 + dq + i] - lg[h * 128 + dq + i]);
    }
    u32x2 rq, rk, rv = {0u, 0u}; v4u rg0 = {0u, 0u, 0u, 0u}, rg1 = {0u, 0u, 0u, 0u};
#define GLA_LOAD(c) do { const bf16* pr = P + (size_t)((c) * TC + tl) * PROJ_LD; rq = *(const GAS u32x2*)(pr + qcol + dq); rk = *(const GAS u32x2*)(pr + kcol + dq); \
        if (MODE == 0) { rg0 = *(const GAS v4u*)(pr + EC_GLR); rg1 = *(const GAS v4u*)(pr + EC_GLR + 8); } \
        if (tid < 256) rv = *(const GAS u32x2*)(P + (size_t)((c) * TC + tlv) * PROJ_LD + vcol + c4); } while (0)
#define GLA_XFORM(bufi) do { LAS float* B_ = Lf + (bufi) * BUFSZ; f32x4 q4, k4, e4; \
        const float xq[4] = {bf_lo(rq.x), bf_hi(rq.x), bf_lo(rq.y), bf_hi(rq.y)}, xk[4] = {bf_lo(rk.x), bf_hi(rk.x), bf_lo(rk.y), bf_hi(rk.y)}; \
        if (MODE == 0) { f32x4 z = *(const LAS f32x4*)(Lf + O_BIAS + dq); \
            const float gl[16] = {bf_lo(rg0.x), bf_hi(rg0.x), bf_lo(rg0.y), bf_hi(rg0.y), bf_lo(rg0.z), bf_hi(rg0.z), bf_lo(rg0.w), bf_hi(rg0.w), \
                                  bf_lo(rg1.x), bf_hi(rg1.x), bf_lo(rg1.y), bf_hi(rg1.y), bf_lo(rg1.z), bf_hi(rg1.z), bf_lo(rg1.w), bf_hi(rg1.w)}; \
            _Pragma("unroll") for (int r_ = 0; r_ < 16; ++r_) { const f32x4 wv = *(const LAS f32x4*)(Lf + O_W2 + r_ * 128 + dq); z = z + wv * gl[r_]; } \
            _Pragma("unroll") for (int i_ = 0; i_ < 4; ++i_) { q4[i_] = xq[i_] * 0.08838834764831845f; k4[i_] = xk[i_]; e4[i_] = __expf(logsigmoidf_(z[i_]) * 0.0625f); } } \
        else { _Pragma("unroll") for (int i_ = 0; i_ < 4; ++i_) { const float fg = lb[i_] + (1.f - lb[i_]) * sigmoidf_(xk[i_]); q4[i_] = siluf_(xq[i_]); k4[i_] = 1.f - fg; e4[i_] = fg; } } \
        *(LAS f32x4*)(B_ + O_EG + tl * 128 + dq) = e4; *(LAS f32x4*)(B_ + O_K + tl * 128 + dq) = k4; *(LAS f32x4*)(B_ + O_Q + tl * 128 + dq) = q4; \
        if (tid < 256) { f32x4 v4 = {bf_lo(rv.x), bf_hi(rv.x), bf_lo(rv.y), bf_hi(rv.y)}; *(LAS f32x4*)(B_ + O_V + tlv * 64 + c4) = v4; } } while (0)
    __syncthreads();
    GLA_LOAD(0); GLA_XFORM(0);
    __syncthreads();
    float S[8][2];
#pragma unroll
    for (int i = 0; i < 8; ++i) { S[i][0] = 0.f; S[i][1] = 0.f; }
    const int j = lane & 15, col = w * 8 + (lane >> 4) * 2;
    for (int c = 0; c < NCHUNK; ++c) {
        if (c + 1 < NCHUNK) GLA_LOAD(c + 1);
        const LAS float* B_ = Lf + (c & 1) * BUFSZ;
#pragma unroll 4
        for (int t = 0; t < TC; ++t) {
            const f32x4 e0 = *(const LAS f32x4*)(B_ + O_EG + t * 128 + 4 * j), e1 = *(const LAS f32x4*)(B_ + O_EG + t * 128 + 64 + 4 * j);
            const f32x4 k0 = *(const LAS f32x4*)(B_ + O_K + t * 128 + 4 * j), k1 = *(const LAS f32x4*)(B_ + O_K + t * 128 + 64 + 4 * j);
            const f32x4 q0 = *(const LAS f32x4*)(B_ + O_Q + t * 128 + 4 * j), q1 = *(const LAS f32x4*)(B_ + O_Q + t * 128 + 64 + 4 * j);
            const f32x2 v2 = *(const LAS f32x2*)(B_ + O_V + t * 64 + col);
            float p0 = 0.f, p1 = 0.f;
#pragma unroll
            for (int i = 0; i < 4; ++i) {
                S[i][0] = S[i][0] * e0[i] + k0[i] * v2[0]; S[i][1] = S[i][1] * e0[i] + k0[i] * v2[1];
                S[4 + i][0] = S[4 + i][0] * e1[i] + k1[i] * v2[0]; S[4 + i][1] = S[4 + i][1] * e1[i] + k1[i] * v2[1];
                p0 += q0[i] * S[i][0] + q1[i] * S[4 + i][0]; p1 += q0[i] * S[i][1] + q1[i] * S[4 + i][1]; }
            p0 = row_sum16(p0); p1 = row_sum16(p1);
            if (j == 0) { f32x2 o2 = {p0, p1}; *(LAS f32x2*)(Lf + O_OUT + t * 64 + col) = o2; }
        }
        if (c + 1 < NCHUNK) GLA_XFORM((c + 1) & 1);
        __syncthreads();
        if (tid < 256) *(GAS f32x4*)(O + (size_t)(c * TC + tlv) * D + c4) = *(const LAS f32x4*)(Lf + O_OUT + tlv * 64 + c4);
        __syncthreads();
    }
#undef GLA_LOAD
#undef GLA_XFORM
}

__device__ __forceinline__ void scan_gdn_unit(const Args& A, Frame& F, int unit) {
    const int tid = F.tid, lane = F.lane, w = F.wave;
    const int b = unit >> 4, h = (unit >> 1) & 7, s = unit & 1;
    const int qcol = EC_BQ + h * 128, kcol = EC_BK + h * 128, vcol = EC_BV + h * 128 + s * 64, ocol = 1024 + h * 128 + s * 64;
    const bf16* P = (const bf16*)(A.ws + WS_PROJ) + (size_t)b * SEQ * PROJ_LD;
    float* O = (float*)(A.ws + WS_O) + (size_t)b * SEQ * D + ocol;
    LAS float* Lf = (LAS float*)(F.lds + RING_OFF);
    constexpr int BUFSZ = 5184, O_K = 0, O_Q = 2048, O_V = 4096, O_SC = 5120, O_OUT = 2 * BUFSZ, O_CW = O_OUT + 1024;
    const int tl = tid >> 5, dq = (tid & 31) * 4, tlv = tid >> 4, c4 = (tid & 15) * 4;
    { const float* cw = A.in[I_GDN_CONV];
      for (int i = tid; i < 4 * 320; i += NTHREADS) { const int jt = i / 320, x = i % 320;
          const int ch = x < 128 ? (h * 128 + x) : x < 256 ? (1024 + h * 128 + (x - 128)) : (2048 + h * 128 + s * 64 + (x - 256));
          Lf[O_CW + i] = cw[jt * 3072 + ch]; } }
    const float neg_ea = -__expf(A.in[I_GDN_ALOG][h]), dtb = A.in[I_GDN_DTB][h];
    u32x2 rq[4], rk[4], rv[4]; unsigned short rba = 0, rbb = 0;
#pragma unroll
    for (int i = 0; i < 4; ++i) rv[i] = (u32x2){0u, 0u};
#define GDN_LOAD(c) do { const int t_ = (c) * TC + tl; \
        _Pragma("unroll") for (int jt = 0; jt < 4; ++jt) { const int tt = t_ - 3 + jt; \
            if (tt >= 0) { const bf16* pr = P + (size_t)tt * PROJ_LD; rq[jt] = *(const GAS u32x2*)(pr + qcol + dq); rk[jt] = *(const GAS u32x2*)(pr + kcol + dq); } \
            else { rq[jt] = (u32x2){0u, 0u}; rk[jt] = (u32x2){0u, 0u}; } } \
        { const bf16* pr = P + (size_t)t_ * PROJ_LD; rba = pr[EC_BA + h]; rbb = pr[EC_BB + h]; } \
        if (tid < 256) { const int tv = (c) * TC + tlv; \
            _Pragma("unroll") for (int jt = 0; jt < 4; ++jt) { const int tt = tv - 3 + jt; \
                if (tt >= 0) rv[jt] = *(const GAS u32x2*)(P + (size_t)tt * PROJ_LD + vcol + c4); else rv[jt] = (u32x2){0u, 0u}; } } } while (0)
#define GDN_XFORM(bufi) do { LAS float* B_ = Lf + (bufi) * BUFSZ; f32x4 q4 = {0.f, 0.f, 0.f, 0.f}, k4 = {0.f, 0.f, 0.f, 0.f}; \
        _Pragma("unroll") for (int jt = 0; jt < 4; ++jt) { const f32x4 wq = *(const LAS f32x4*)(Lf + O_CW + jt * 320 + dq), wk = *(const LAS f32x4*)(Lf + O_CW + jt * 320 + 128 + dq); \
            q4[0] += wq[0] * bf_lo(rq[jt].x); q4[1] += wq[1] * bf_hi(rq[jt].x); q4[2] += wq[2] * bf_lo(rq[jt].y); q4[3] += wq[3] * bf_hi(rq[jt].y); \
            k4[0] += wk[0] * bf_lo(rk[jt].x); k4[1] += wk[1] * bf_hi(rk[jt].x); k4[2] += wk[2] * bf_lo(rk[jt].y); k4[3] += wk[3] * bf_hi(rk[jt].y); } \
        float sq = 0.f, sk = 0.f, sqk = 0.f; \
        _Pragma("unroll") for (int i_ = 0; i_ < 4; ++i_) { q4[i_] = siluf_(q4[i_]); k4[i_] = siluf_(k4[i_]); sq += q4[i_] * q4[i_]; sk += k4[i_] * k4[i_]; sqk += q4[i_] * k4[i_]; } \
        sq = half_sum32(sq); sk = half_sum32(sk); sqk = half_sum32(sqk); \
        const float rq_ = __builtin_amdgcn_rsqf(sq + EPS) * 0.08838834764831845f, rk_ = __builtin_amdgcn_rsqf(sk + EPS); \
        q4 = q4 * rq_; k4 = k4 * rk_; \
        *(LAS f32x4*)(B_ + O_K + tl * 128 + dq) = k4; *(LAS f32x4*)(B_ + O_Q + tl * 128 + dq) = q4; \
        if ((tid & 31) == 0) { const float ba = __uint_as_float((unsigned)rba << 16), bb = __uint_as_float((unsigned)rbb << 16); \
            f32x4 sc; sc[0] = __expf(neg_ea * softplusf_(ba + dtb)); sc[1] = sigmoidf_(bb); sc[2] = sqk * rq_ * rk_; sc[3] = 0.f; *(LAS f32x4*)(B_ + O_SC + tl * 4) = sc; } \
        if (tid < 256) { f32x4 v4 = {0.f, 0.f, 0.f, 0.f}; \
            _Pragma("unroll") for (int jt = 0; jt < 4; ++jt) { const f32x4 wv = *(const LAS f32x4*)(Lf + O_CW + jt * 320 + 256 + c4); \
                v4[0] += wv[0] * bf_lo(rv[jt].x); v4[1] += wv[1] * bf_hi(rv[jt].x); v4[2] += wv[2] * bf_lo(rv[jt].y); v4[3] += wv[3] * bf_hi(rv[jt].y); } \
            _Pragma("unroll") for (int i_ = 0; i_ < 4; ++i_) v4[i_] = siluf_(v4[i_]); \
            *(LAS f32x4*)(B_ + O_V + tlv * 64 + c4) = v4; } } while (0)
    __syncthreads();
    GDN_LOAD(0); GDN_XFORM(0);
    __syncthreads();
    float S[8][2];
#pragma unroll
    for (int i = 0; i < 8; ++i) { S[i][0] = 0.f; S[i][1] = 0.f; }
    const int j = lane & 15, col = w * 8 + (lane >> 4) * 2;
    for (int c = 0; c < NCHUNK; ++c) {
        if (c + 1 < NCHUNK) GDN_LOAD(c + 1);
        const LAS float* B_ = Lf + (c & 1) * BUFSZ;
#pragma unroll 4
        for (int t = 0; t < TC; ++t) {
            const f32x4 k0 = *(const LAS f32x4*)(B_ + O_K + t * 128 + 4 * j), k1 = *(const LAS f32x4*)(B_ + O_K + t * 128 + 64 + 4 * j);
            const f32x4 q0 = *(const LAS f32x4*)(B_ + O_Q + t * 128 + 4 * j), q1 = *(const LAS f32x4*)(B_ + O_Q + t * 128 + 64 + 4 * j);
            const f32x2 v2 = *(const LAS f32x2*)(B_ + O_V + t * 64 + col);
            const f32x4 sc = *(const LAS f32x4*)(B_ + O_SC + t * 4);
            float d10 = 0.f, d11 = 0.f, d20 = 0.f, d21 = 0.f;
#pragma unroll
            for (int i = 0; i < 4; ++i) {
                d10 += k0[i] * S[i][0] + k1[i] * S[4 + i][0]; d11 += k0[i] * S[i][1] + k1[i] * S[4 + i][1];
                d20 += q0[i] * S[i][0] + q1[i] * S[4 + i][0]; d21 += q0[i] * S[i][1] + q1[i] * S[4 + i][1]; }
            d10 = row_sum16(d10); d11 = row_sum16(d11); d20 = row_sum16(d20); d21 = row_sum16(d21);
            const float a = sc[0], beta = sc[1], qk = sc[2];
            const float dl0 = beta * (v2[0] - a * d10), dl1 = beta * (v2[1] - a * d11);
            const float o0 = a * d20 + qk * dl0, o1 = a * d21 + qk * dl1;
#pragma unroll
            for (int i = 0; i < 4; ++i) {
                S[i][0] = a * S[i][0] + k0[i] * dl0; S[i][1] = a * S[i][1] + k0[i] * dl1;
                S[4 + i][0] = a * S[4 + i][0] + k1[i] * dl0; S[4 + i][1] = a * S[4 + i][1] + k1[i] * dl1; }
            if (j == 0) { f32x2 o2 = {o0, o1}; *(LAS f32x2*)(Lf + O_OUT + t * 64 + col) = o2; }
        }
        if (c + 1 < NCHUNK) GDN_XFORM((c + 1) & 1);
        __syncthreads();
        if (tid < 256) *(GAS f32x4*)(O + (size_t)(c * TC + tlv) * D + c4) = *(const LAS f32x4*)(Lf + O_OUT + tlv * 64 + c4);
        __syncthreads();
    }
#undef GDN_LOAD
#undef GDN_XFORM
}

__device__ __forceinline__ void scan_rwkv_unit(const Args& A, Frame& F, int unit) {
    const int tid = F.tid, lane = F.lane, w = F.wave;
    const int b = unit >> 4, h = unit & 15;
    const bf16* P = (const bf16*)(A.ws + WS_PROJ) + (size_t)b * SEQ * PROJ_LD + OC_RW;
    const bf16* LO = (const bf16*)(A.ws + WS_LO) + (size_t)b * SEQ * LORA_N;
    bf16* Y = (bf16*)(A.ws + WS_ACTA) + (size_t)b * SEQ * D + 1024 + h * 64;
    LAS float* Lf = (LAS float*)(F.lds + RING_OFF);
    constexpr int BUFSZ = 6208, O_KK = 0, O_WR = 1024, O_W = 2048, O_NKA = 3072, O_K = 4096, O_V = 5120, O_SC = 6144, O_OUT = 2 * BUFSZ;
    const int tl = tid >> 5, d2 = (tid & 31) * 2, hd = h * 64 + d2;
    float mu_r[2], mu_k[2], mu_v[2], w0[2], a0[2], k_k[2], k_a[2], r_k[2], lnw[2], lnb[2];
#pragma unroll
    for (int i = 0; i < 2; ++i) { mu_r[i] = A.in[I_MU][RW_R + hd + i]; mu_k[i] = A.in[I_MU][RW_K + hd + i]; mu_v[i] = A.in[I_MU][RW_V + hd + i];
        w0[i] = A.in[I_W0][hd + i]; a0[i] = A.in[I_A0][hd + i]; k_k[i] = A.in[I_KK][hd + i]; k_a[i] = A.in[I_KA][hd + i]; r_k[i] = A.in[I_RK][hd + i];
        lnw[i] = A.in[I_LNW][hd + i]; lnb[i] = A.in[I_LNB][hd + i]; }
    unsigned rr[2], rk[2], rv[2], rlw, rla, rg_cur = 0u, rg_nxt = 0u;
#define RW_LOAD(c) do { const int t_ = (c) * TC + tl; const bf16* pr = P + (size_t)t_ * PROJ_LD; \
        rr[0] = *(const GAS unsigned*)(pr + RW_R + hd); rk[0] = *(const GAS unsigned*)(pr + RW_K + hd); rv[0] = *(const GAS unsigned*)(pr + RW_V + hd); \
        if (t_ > 0) { rr[1] = *(const GAS unsigned*)(pr - PROJ_LD + RW_R + hd); rk[1] = *(const GAS unsigned*)(pr - PROJ_LD + RW_K + hd); rv[1] = *(const GAS unsigned*)(pr - PROJ_LD + RW_V + hd); } \
        else { rr[1] = 0u; rk[1] = 0u; rv[1] = 0u; } \
        const bf16* lr = LO + (size_t)t_ * LORA_N; rlw = *(const GAS unsigned*)(lr + hd); rla = *(const GAS unsigned*)(lr + 1024 + hd); rg_nxt = *(const GAS unsigned*)(lr + 2048 + hd); } while (0)
#define RW_XFORM(bufi) do { LAS float* B_ = Lf + (bufi) * BUFSZ; f32x2 kk2, wr2, w2_, nka2, k2, v2_; float skk = 0.f, sc1 = 0.f, sc2 = 0.f, sbs = 0.f; float aa[2], rrv[2]; \
        _Pragma("unroll") for (int i_ = 0; i_ < 2; ++i_) { \
            const float r0 = i_ ? bf_hi(rr[0]) : bf_lo(rr[0]), r1 = i_ ? bf_hi(rr[1]) : bf_lo(rr[1]); \
            const float k0_ = i_ ? bf_hi(rk[0]) : bf_lo(rk[0]), k1_ = i_ ? bf_hi(rk[1]) : bf_lo(rk[1]); \
            const float v0_ = i_ ? bf_hi(rv[0]) : bf_lo(rv[0]), v1_ = i_ ? bf_hi(rv[1]) : bf_lo(rv[1]); \
            const float lw = i_ ? bf_hi(rlw) : bf_lo(rlw), la = i_ ? bf_hi(rla) : bf_lo(rla); \
            const float r_ = r0 + (r1 - r0) * mu_r[i_], kx = k0_ + (k1_ - k0_) * mu_k[i_], vx = v0_ + (v1_ - v0_) * mu_v[i_]; \
            const float wd = __expf(-0.6065306597126334f * sigmoidf_(w0[i_] + lw)); const float a_ = sigmoidf_(a0[i_] + la); \
            const float kk0 = kx * k_k[i_]; const float km = kx * (1.f + (a_ - 1.f) * k_a[i_]); \
            kk2[i_] = kk0; skk += kk0 * kk0; aa[i_] = a_; rrv[i_] = r_; wr2[i_] = wd * r_; w2_[i_] = wd; k2[i_] = km; v2_[i_] = vx; sc2 += km * r_; sbs += r_ * km * r_k[i_]; } \
        skk = half_sum32(skk); const float rkk = __builtin_amdgcn_rsqf(skk + EPS); \
        _Pragma("unroll") for (int i_ = 0; i_ < 2; ++i_) { kk2[i_] *= rkk; nka2[i_] = -(kk2[i_] * aa[i_]); sc1 += kk2[i_] * aa[i_] * rrv[i_]; } \
        sc1 = half_sum32(sc1); sc2 = half_sum32(sc2); sbs = half_sum32(sbs); \
        *(LAS f32x2*)(B_ + O_KK + tl * 64 + d2) = kk2; *(LAS f32x2*)(B_ + O_WR + tl * 64 + d2) = wr2; *(LAS f32x2*)(B_ + O_W + tl * 64 + d2) = w2_; \
        *(LAS f32x2*)(B_ + O_NKA + tl * 64 + d2) = nka2; *(LAS f32x2*)(B_ + O_K + tl * 64 + d2) = k2; *(LAS f32x2*)(B_ + O_V + tl * 64 + d2) = v2_; \
        if ((tid & 31) == 0) { f32x4 sc; sc[0] = sc1; sc[1] = sc2; sc[2] = sbs; sc[3] = 0.f; *(LAS f32x4*)(B_ + O_SC + tl * 4) = sc; } } while (0)
    RW_LOAD(0); RW_XFORM(0); rg_cur = rg_nxt;
    __syncthreads();
    float S[4][2];
#pragma unroll
    for (int i = 0; i < 4; ++i) { S[i][0] = 0.f; S[i][1] = 0.f; }
    const int j = lane & 15, col = w * 8 + (lane >> 4) * 2;
    for (int c = 0; c < NCHUNK; ++c) {
        if (c + 1 < NCHUNK) RW_LOAD(c + 1);
        const LAS float* B_ = Lf + (c & 1) * BUFSZ;
#pragma unroll 4
        for (int t = 0; t < TC; ++t) {
            const f32x4 kk = *(const LAS f32x4*)(B_ + O_KK + t * 64 + 4 * j), wr = *(const LAS f32x4*)(B_ + O_WR + t * 64 + 4 * j), ww = *(const LAS f32x4*)(B_ + O_W + t * 64 + 4 * j);
            const f32x4 nka = *(const LAS f32x4*)(B_ + O_NKA + t * 64 + 4 * j), kv = *(const LAS f32x4*)(B_ + O_K + t * 64 + 4 * j);
            const f32x2 v2 = *(const LAS f32x2*)(B_ + O_V + t * 64 + col);
            const f32x4 sc = *(const LAS f32x4*)(B_ + O_SC + t * 4);
            float d10 = 0.f, d11 = 0.f, d20 = 0.f, d21 = 0.f;
#pragma unroll
            for (int i = 0; i < 4; ++i) { d10 += kk[i] * S[i][0]; d11 += kk[i] * S[i][1]; d20 += wr[i] * S[i][0]; d21 += wr[i] * S[i][1]; }
            d10 = row_sum16(d10); d11 = row_sum16(d11); d20 = row_sum16(d20); d21 = row_sum16(d21);
            const float o0 = d20 - d10 * sc[0] + v2[0] * sc[1], o1 = d21 - d11 * sc[0] + v2[1] * sc[1];
#pragma unroll
            for (int i = 0; i < 4; ++i) { S[i][0] = S[i][0] * ww[i] + d10 * nka[i] + v2[0] * kv[i]; S[i][1] = S[i][1] * ww[i] + d11 * nka[i] + v2[1] * kv[i]; }
            if (j == 0) { f32x2 o2 = {o0, o1}; *(LAS f32x2*)(Lf + O_OUT + t * 64 + col) = o2; }
        }
        if (c + 1 < NCHUNK) RW_XFORM((c + 1) & 1);
        __syncthreads();
        {
            const f32x2 o2 = *(const LAS f32x2*)(Lf + O_OUT + tl * 64 + d2); const f32x2 vv = *(const LAS f32x2*)(B_ + O_V + tl * 64 + d2); const float bs = B_[O_SC + tl * 4 + 2];
            const float mean = half_sum32(o2[0] + o2[1]) * (1.0f / 64.0f); const float e0 = o2[0] - mean, e1 = o2[1] - mean;
            const float var = half_sum32(e0 * e0 + e1 * e1) * (1.0f / 64.0f); const float rs = __builtin_amdgcn_rsqf(var + 64e-5f);
            const float y0 = (e0 * rs * lnw[0] + lnb[0] + bs * vv[0]) * bf_lo(rg_cur), y1 = (e1 * rs * lnw[1] + lnb[1] + bs * vv[1]) * bf_hi(rg_cur);
            *(GAS unsigned*)(Y + (size_t)(c * TC + tl) * D + d2) = pk2(y0, y1);
        }
        rg_cur = rg_nxt;
        __syncthreads();
    }
#undef RW_LOAD
#undef RW_XFORM
}

template <int LAYER>
__device__ __forceinline__ void post_rows(const Args& A, Frame& F) {
    const int gw = F.vcu * NWAVES + F.wave, NGW = F.G * NWAVES, lane = F.lane;
    const float* O = (const float*)(A.ws + WS_O); const bf16* P = (const bf16*)(A.ws + WS_PROJ); bf16* Y = (bf16*)(A.ws + WS_ACTA);
    for (int m = gw; m < T; m += NGW) {
        const GAS f32x4* orow = (const GAS f32x4*)(O + (size_t)m * D) + lane; const bf16* prow = P + (size_t)m * PROJ_LD;
        constexpr int NJ = LAYER == 0 ? 8 : 4;
#pragma unroll
        for (int jj = 0; jj < NJ; ++jj) {
            const f32x4 v = orow[64 * jj]; float ss = (v[0] * v[0] + v[1] * v[1]) + (v[2] * v[2] + v[3] * v[3]);
            const bool wide = (LAYER == 0 && jj < 4);
            const float ms = wide ? wave_sum(ss) * (1.0f / 256.0f) : half_sum32(ss) * (1.0f / 128.0f);
            const float r = __builtin_amdgcn_rsqf(ms + EPS);
            const int cih = wide ? 4 * lane : 4 * (lane & 31);
            const float* gsrc = LAYER == 0 ? (wide ? A.in[I_GLA_NORM] : A.in[I_GDN_NORM]) : A.in[I_HG_NORM];
            const f32x4 g = *(const GAS f32x4*)(gsrc + cih);
            const int zcol = LAYER == 0 ? (wide ? EC_GZ + jj * 256 + 4 * lane : EC_BZ + (jj - 4) * 256 + 4 * lane) : OC_HG + jj * 256 + 4 * lane;
            const u32x2 zw = *(const GAS u32x2*)(prow + zcol);
            const float y0 = v[0] * r * g[0] * siluf_(bf_lo(zw.x)), y1 = v[1] * r * g[1] * siluf_(bf_hi(zw.x)), y2 = v[2] * r * g[2] * siluf_(bf_lo(zw.y)), y3 = v[3] * r * g[3] * siluf_(bf_hi(zw.y));
            u32x2 o; o.x = pk2(y0, y1); o.y = pk2(y2, y3);
            *(GAS u32x2*)(Y + (size_t)m * D + 256 * jj + 4 * lane) = o;
        }
    }
}
__device__ __forceinline__ void lora_prep_rows(const Args& A, Frame& F) {
    const int gw = F.vcu * NWAVES + F.wave, NGW = F.G * NWAVES, lane = F.lane;
    const bf16* P = (const bf16*)(A.ws + WS_PROJ); bf16* LA = (bf16*)(A.ws + WS_LA); const float* mu = A.in[I_MU];
    for (int m = gw; m < T; m += NGW) { const bool hasprev = (m % SEQ) != 0; const bf16* prow = P + (size_t)m * PROJ_LD + OC_RW + RW_WL;
#pragma unroll
        for (int i = 0; i < 7; ++i) { const int c = lane + 64 * i;
            const float x = __uint_as_float((unsigned)prow[c] << 16), xp = hasprev ? __uint_as_float((unsigned)prow[c - PROJ_LD] << 16) : 0.f;
            const float ts = x + (xp - x) * mu[RW_WL + c];
            const float v = c < 96 ? tanhf(ts) : (c < 192 ? ts : sigmoidf_(ts));
            LA[(size_t)m * LORA_K + c] = (bf16)f2bf(v); }
        LA[(size_t)m * LORA_K + 448 + lane] = (bf16)0; }
}
__device__ __forceinline__ void final_rows(const Args& A, Frame& F) {
    const int gw = F.vcu * NWAVES + F.wave, NGW = F.G * NWAVES, lane = F.lane;
    const float* rowss = (const float*)(A.ws + WS_RSP) + (size_t)RS_FINAL * T * 32; const GAS f32x4* g = (const GAS f32x4*)A.in[I_NFINAL] + lane;
    for (int m = gw; m < T; m += NGW) { const float r = __builtin_amdgcn_rsqf(wave_sum(lane < 32 ? rowss[(size_t)m * 32 + lane] : 0.f) * (1.0f / D) + EPS); GAS f32x4* row = (GAS f32x4*)(A.out + (size_t)m * D) + lane;
#pragma unroll
        for (int jj = 0; jj < 8; ++jj) { const f32x4 v = row[64 * jj]; row[64 * jj] = v * r * g[64 * jj]; } }
}

__device__ __forceinline__ int med3i(int a, int b, int c) { int r; asm("v_med3_i32 %0, %1, %2, %3" : "=v"(r) : "v"(a), "v"(b), "v"(c)); return r; }
__device__ __forceinline__ int f2sort(float f) { int x = __float_as_int(f); return x ^ ((x >> 31) & 0x7fffffff); }
__device__ __forceinline__ float sort2f(int x) { return __int_as_float(x ^ ((x >> 31) & 0x7fffffff)); }
#define TOPK_INSERT(vals, x) do { _Pragma("unroll") for (int s_ = 15; s_ >= 1; --s_) vals[s_] = med3i((x), vals[s_ - 1], vals[s_]); vals[0] = max(vals[0], (x)); } while (0)
__device__ __forceinline__ float bf_dot2(unsigned a, unsigned b, float c) {
    return c + bf_lo(a) * bf_lo(b) + bf_hi(a) * bf_hi(b);
}
__device__ __forceinline__ void peer_phase(const Args& A, Frame& F, int L) {
    const int gw = F.vcu * NWAVES + F.wave, NGW = F.G * NWAVES, lane = F.lane;
    const bf16* SCR = (const bf16*)(A.ws + WS_SC); const bf16* X = (const bf16*)(A.ws + WS_ACTB); bf16* HG = (bf16*)(A.ws + WS_ACTA);
    const bf16* TU = (const bf16*)(A.ws + WS_TABU); const bf16* TV = (const bf16*)(A.ws + WS_TABV);
    const float* rowss = (const float*)(A.ws + WS_RSP) + (size_t)(L == 0 ? RS_FFN0 : RS_FFN1) * T * 32;
    const float* gple = A.in[I_NPLE] + (size_t)L * D;
    float* H = A.out;
    LAS unsigned* LIST = (LAS unsigned*)(F.lds + RING_OFF + F.wave * 16384);
    LAS unsigned* EIDX = LIST + 1024;
    LAS float* ECOEF = (LAS float*)(EIDX + 512);
    for (int tb = gw; tb < T / 4; tb += NGW) {
        const int t0 = tb * 4;
        {
            const bf16* sp = SCR + (size_t)(t0 + (lane >> 4)) * D + (lane & 15) * 128;
            int vals[16];
#pragma unroll
            for (int s = 0; s < 16; ++s) vals[s] = (int)0x80000000;
#pragma unroll 2
            for (int c = 0; c < 16; ++c) { const v4u wv = *(const GAS v4u*)(sp + c * 8); const unsigned ww[4] = {wv.x, wv.y, wv.z, wv.w};
#pragma unroll
                for (int e = 0; e < 8; ++e) { const unsigned bits = (e & 1) ? (ww[e >> 1] & 0xffff0000u) : (ww[e >> 1] << 16);
                    int x = (int)bits; x ^= (x >> 31) & 0x7fffffff; x = (x & ~0x7f) | (127 - (c * 8 + e));
                    TOPK_INSERT(vals, x); } }
#pragma unroll
            for (int q = 0; q < 4; ++q) { v4u o; o.x = (unsigned)vals[4 * q]; o.y = (unsigned)vals[4 * q + 1]; o.z = (unsigned)vals[4 * q + 2]; o.w = (unsigned)vals[4 * q + 3]; *(LAS v4u*)(LIST + lane * 16 + 4 * q) = o; }
        }
        LDS_WAIT(); asm volatile("" ::: "memory");
        if (lane < 32) {
            const LAS unsigned* la = LIST + ((lane >> 3) * 16 + (lane & 7) * 2) * 16; const LAS unsigned* lb2 = la + 16;
            float av[16], bv[16];
#pragma unroll
            for (int q = 0; q < 4; ++q) { const v4u a4 = *(const LAS v4u*)(la + 4 * q), b4 = *(const LAS v4u*)(lb2 + 4 * q); const unsigned aw[4] = {a4.x, a4.y, a4.z, a4.w}, bw[4] = {b4.x, b4.y, b4.z, b4.w};
#pragma unroll
                for (int e = 0; e < 4; ++e) { av[4 * q + e] = __uint_as_float(__float_as_uint(sort2f((int)(aw[e] & ~0x7fu))) & 0xffff0000u); bv[4 * q + e] = __uint_as_float(__float_as_uint(sort2f((int)(bw[e] & ~0x7fu))) & 0xffff0000u); } }
            int best[16];
#pragma unroll
            for (int s = 0; s < 16; ++s) best[s] = (int)0x80000000;
#pragma unroll
            for (int i = 0; i < 16; ++i)
#pragma unroll
                for (int jx = 0; jx < 16; ++jx) if ((i + 1) * (jx + 1) <= 16) { int x = f2sort(av[i] + bv[jx]); x = (x & ~0xff) | (255 - (i * 16 + jx)); TOPK_INSERT(best, x); }
            float sv[16]; unsigned ex[16];
#pragma unroll
            for (int s = 0; s < 16; ++s) { const int cand = 255 - (best[s] & 0xff); const unsigned ka = la[cand >> 4], kb = lb2[cand & 15];
                ex[s] = (127u - (ka & 0x7fu)) * 128u + (127u - (kb & 0x7fu));
                sv[s] = __uint_as_float(__float_as_uint(sort2f((int)(ka & ~0x7fu))) & 0xffff0000u) + __uint_as_float(__float_as_uint(sort2f((int)(kb & ~0x7fu))) & 0xffff0000u); }
            float mx = sv[0];
#pragma unroll
            for (int s = 1; s < 16; ++s) mx = fmaxf(mx, sv[s]);
            float den = 0.f;
#pragma unroll
            for (int s = 0; s < 16; ++s) { sv[s] = __expf(sv[s] - mx); den += sv[s]; }
            const float inv = 1.0f / den; const int base = (lane >> 3) * 128 + (lane & 7) * 16;
#pragma unroll
            for (int s = 0; s < 16; ++s) { EIDX[base + s] = ex[s]; ECOEF[base + s] = sv[s] * inv; }
        }
        LDS_WAIT(); asm volatile("" ::: "memory");
        for (int tok = 0; tok < 4; ++tok) {
            const int t = t0 + tok;
            const float rs = __builtin_amdgcn_rsqf(wave_sum(lane < 32 ? rowss[(size_t)t * 32 + lane] : 0.f) * (1.0f / D) + EPS);
            v4u xq[4];
#pragma unroll
            for (int jj = 0; jj < 4; ++jj) xq[jj] = *(const GAS v4u*)(X + (size_t)t * D + 512 * jj + 8 * lane);
#pragma unroll 1
            for (int k = 0; k < 128; k += 4) {
                v4u ur[4][4];
#pragma unroll
                for (int q = 0; q < 4; ++q) { const unsigned e = __builtin_amdgcn_readfirstlane(EIDX[tok * 128 + k + q]); const bf16* up = TU + (size_t)e * D + 8 * lane;
#pragma unroll
                    for (int jj = 0; jj < 4; ++jj) ur[q][jj] = *(const GAS v4u*)(up + 512 * jj); }
#pragma unroll
                for (int q = 0; q < 4; ++q) { float acc = 0.f;
#pragma unroll
                    for (int jj = 0; jj < 4; ++jj) { acc = bf_dot2(xq[jj].x, ur[q][jj].x, acc); acc = bf_dot2(xq[jj].y, ur[q][jj].y, acc); acc = bf_dot2(xq[jj].z, ur[q][jj].z, acc); acc = bf_dot2(xq[jj].w, ur[q][jj].w, acc); }
                    acc = wave_sum(acc) * rs;
                    const float act = 0.5f * acc * (1.0f + erff(acc * 0.7071067811865476f));
                    if (lane == 0) ECOEF[tok * 128 + k + q] *= act; }
            }
            LDS_WAIT(); asm volatile("" ::: "memory");
            float out[32];
#pragma unroll
            for (int i = 0; i < 32; ++i) out[i] = 0.f;
#pragma unroll 1
            for (int k = 0; k < 128; k += 4) {
                v4u vr[4][4]; float cf[4];
#pragma unroll
                for (int q = 0; q < 4; ++q) { const unsigned e = __builtin_amdgcn_readfirstlane(EIDX[tok * 128 + k + q]); cf[q] = ECOEF[tok * 128 + k + q]; const bf16* vp = TV + (size_t)e * D + 8 * lane;
#pragma unroll
                    for (int jj = 0; jj < 4; ++jj) vr[q][jj] = *(const GAS v4u*)(vp + 512 * jj); }
#pragma unroll
                for (int q = 0; q < 4; ++q)
#pragma unroll
                    for (int jj = 0; jj < 4; ++jj) { const unsigned ww[4] = {vr[q][jj].x, vr[q][jj].y, vr[q][jj].z, vr[q][jj].w};
#pragma unroll
                        for (int e = 0; e < 4; ++e) { out[jj * 8 + 2 * e] += cf[q] * bf_lo(ww[e]); out[jj * 8 + 2 * e + 1] += cf[q] * bf_hi(ww[e]); } }
            }
            float ss = 0.f;
#pragma unroll
            for (int jj = 0; jj < 4; ++jj) { GAS f32x4* hp = (GAS f32x4*)(H + (size_t)t * D + 512 * jj + 8 * lane);
                f32x4 h0 = hp[0], h1 = hp[1];
#pragma unroll
                for (int e = 0; e < 4; ++e) { h0[e] += out[jj * 8 + e]; h1[e] += out[jj * 8 + 4 + e]; out[jj * 8 + e] = h0[e]; out[jj * 8 + 4 + e] = h1[e]; ss += h0[e] * h0[e] + h1[e] * h1[e]; }
                hp[0] = h0; hp[1] = h1; }
            const float r3 = __builtin_amdgcn_rsqf(wave_sum(ss) * (1.0f / D) + EPS);
#pragma unroll
            for (int jj = 0; jj < 4; ++jj) { const GAS f32x4* gp = (const GAS f32x4*)(gple + 512 * jj + 8 * lane); const f32x4 g0 = gp[0], g1 = gp[1];
                v4u o; o.x = pk2(out[jj * 8 + 0] * r3 * g0[0], out[jj * 8 + 1] * r3 * g0[1]); o.y = pk2(out[jj * 8 + 2] * r3 * g0[2], out[jj * 8 + 3] * r3 * g0[3]);
                o.z = pk2(out[jj * 8 + 4] * r3 * g1[0], out[jj * 8 + 5] * r3 * g1[1]); o.w = pk2(out[jj * 8 + 6] * r3 * g1[2], out[jj * 8 + 7] * r3 * g1[3]);
                *(GAS v4u*)(HG + (size_t)t * D + 512 * jj + 8 * lane) = o; }
        }
        LDS_WAIT(); asm volatile("" ::: "memory");
    }
}

constexpr int N_PHASES = 19;
__global__ void __launch_bounds__(NTHREADS, 2) mega_fwd(Args args) {
    extern __shared__ __attribute__((aligned(16))) unsigned char lds[];
    Frame F;
    F.lds = (LAS unsigned char*)lds;
    F.MISC = (volatile LAS unsigned*)(F.lds + MISC_OFF);
    F.tid = threadIdx.x; F.lane = F.tid & 63; F.wave = __builtin_amdgcn_readfirstlane(F.tid >> 6);
    F.G = gridDim.x; { const int bx = blockIdx.x; F.vcu = (F.G % 8 == 0) ? (bx % 8) * (F.G / 8) + bx / 8 : bx; }
    unsigned char* ws = args.ws;
    F.ctl = (gu32*)(ws + WS_CTL);
    for (int u = F.tid; u < (LDS_BYTES - LDSCTL_OFF) / 4; u += NTHREADS) ((LAS unsigned*)(F.lds + LDSCTL_OFF))[u] = 0u;
    __syncthreads();
    const int lo = args.ph_lo, hi = args.ph_hi;
    XcdBarrier bar; bar.bar = (unsigned*)(F.ctl + CW_BAR); bar.x = 0; bar.st = nullptr;
    if (hi - lo > 1) bar = xcd_barrier_post((unsigned*)(F.ctl + CW_BAR), F.MISC + 8);
#define IN(k) (lo <= (k) && (k) < hi)
#define SEAM(k) do { if (IN(k) && IN((k) + 1)) { if ((k) == 0) { cg::this_grid().sync(); } else { xcd_barrier(bar); } } } while (0)
    float* rowss = (float*)(ws + WS_RSP);
    bf16* ACTA = (bf16*)(ws + WS_ACTA); bf16* ACTB = (bf16*)(ws + WS_ACTB); bf16* PROJ = (bf16*)(ws + WS_PROJ); bf16* SCB = (bf16*)(ws + WS_SC); bf16* PP = (bf16*)(ws + WS_PP);
    const int gtid = (F.vcu * NWAVES + F.wave) * 64 + F.lane, gthreads = F.G * NTHREADS;

    if (IN(0)) { p0_prologue(args, F); } SEAM(0);
    if (IN(1)) {
        { pg8::Gemm g{ACTA, (const bf16*)(ws + WS_WEV_IN), T, EV_NP, D}; pg8::StaticOrder S; S.init(T, EV_NP, F.G, (int)blockIdx.x); EpiBf16S E{PROJ, PROJ_LD, nullptr};
          pg8::gemm_phase<EpiBf16S, pg8::StaticOrder, true, true>(F.lds + RING_OFF, g, S, E); }
        { pg8::Gemm g{(const bf16*)(ws + WS_PBF), (const bf16*)(ws + WS_WPROJ), T, D, 256}; pg8::StaticOrder S; S.init(T, D, F.G, (int)blockIdx.x); EpiBf16S E{PP, D, nullptr};
          pg8::gemm_phase<EpiBf16S, pg8::StaticOrder, true, true>(F.lds + RING_OFF, g, S, E); }
    } SEAM(1);
    if (IN(2)) { for (int u = F.vcu; u < 256; u += F.G) { if (u < 128) scan_gla_unit<0>(args, F, u); else scan_gdn_unit(args, F, u - 128); __syncthreads(); } } SEAM(2);
    if (IN(3)) { post_rows<0>(args, F); } SEAM(3);
    if (IN(4)) { pg8::Gemm g{ACTA, (const bf16*)(ws + WS_WEV_OUT), T, D, D}; pg8::StaticOrder S; S.init(T, D, F.G, (int)blockIdx.x);
        EpiResid<false> E{args.in[I_X], args.out, ACTB, args.in[I_NFFN], rowss + (size_t)RS_FFN0 * T * 32, nullptr};
        pg8::gemm_phase<EpiResid<false>, pg8::StaticOrder, true, true>(F.lds + RING_OFF, g, S, E); } SEAM(4);
    if (IN(5)) { pg8::Gemm g{ACTB, (const bf16*)(ws + WS_WPEER), T, D, D}; pg8::StaticOrder S; S.init(T, D, F.G, (int)blockIdx.x); EpiBf16S E{SCB, D, rowss + (size_t)RS_FFN0 * T * 32};
        pg8::gemm_phase<EpiBf16S, pg8::StaticOrder, true, true>(F.lds + RING_OFF, g, S, E); } SEAM(5);
    if (IN(6)) { peer_phase(args, F, 0); } SEAM(6);
    if (IN(7)) { { pg8::Gemm g{ACTA, (const bf16*)(ws + WS_WGATE), T, D, D}; pg8::StaticOrder S; S.init(T, D, F.G, (int)blockIdx.x);
        EpiResid<true> E{args.out, args.out, ACTB, args.in[I_NMIX] + D, rowss + (size_t)RS_MIX1 * T * 32, PP};
        pg8::gemm_phase<EpiResid<true>, pg8::StaticOrder, true, true>(F.lds + RING_OFF, g, S, E); }
        cvt_f32_bf16(args.in[I_PEER_U] + (size_t)16384 * D, (bf16*)(ws + WS_TABU), (size_t)16384 * D, gtid, gthreads);
        cvt_f32_bf16(args.in[I_PEER_V] + (size_t)16384 * D, (bf16*)(ws + WS_TABV), (size_t)16384 * D, gtid, gthreads); } SEAM(7);
    if (IN(8)) {
        { pg8::Gemm g{ACTB, (const bf16*)(ws + WS_WOD_IN), T, OD_NP, D}; pg8::StaticOrder S; S.init(T, OD_NP, F.G, (int)blockIdx.x); EpiBf16S E{PROJ, PROJ_LD, rowss + (size_t)RS_MIX1 * T * 32};
          pg8::gemm_phase<EpiBf16S, pg8::StaticOrder, true, true>(F.lds + RING_OFF, g, S, E); }
        { pg8::Gemm g{(const bf16*)(ws + WS_PBF) + (size_t)T * 256, (const bf16*)(ws + WS_WPROJ) + (size_t)D * 256, T, D, 256}; pg8::StaticOrder S; S.init(T, D, F.G, (int)blockIdx.x); EpiBf16S E{PP, D, nullptr};
          pg8::gemm_phase<EpiBf16S, pg8::StaticOrder, true, true>(F.lds + RING_OFF, g, S, E); }
    } SEAM(8);
    if (IN(9)) { lora_prep_rows(args, F); } SEAM(9);
    if (IN(10)) { pg8::Gemm g{(const bf16*)(ws + WS_LA), (const bf16*)(ws + WS_WLORA), T, LORA_N, LORA_K}; pg8::StaticOrder S; S.init(T, LORA_N, F.G, (int)blockIdx.x); EpiBf16S E{(bf16*)(ws + WS_LO), LORA_N, nullptr};
        pg8::gemm_phase<EpiBf16S, pg8::StaticOrder, true, true>(F.lds + RING_OFF, g, S, E); } SEAM(10);
    if (IN(11)) { for (int u = F.vcu; u < 256; u += F.G) { if (u < 128) scan_gla_unit<1>(args, F, u); else scan_rwkv_unit(args, F, u - 128); __syncthreads(); } } SEAM(11);
    if (IN(12)) { post_rows<1>(args, F); } SEAM(12);
    if (IN(13)) { pg8::Gemm g{ACTA, (const bf16*)(ws + WS_WOD_OUT), T, D, D}; pg8::StaticOrder S; S.init(T, D, F.G, (int)blockIdx.x);
        EpiResid<false> E{args.out, args.out, ACTB, args.in[I_NFFN] + D, rowss + (size_t)RS_FFN1 * T * 32, nullptr};
        pg8::gemm_phase<EpiResid<false>, pg8::StaticOrder, true, true>(F.lds + RING_OFF, g, S, E); } SEAM(13);
    if (IN(14)) { pg8::Gemm g{ACTB, (const bf16*)(ws + WS_WPEER) + (size_t)D * D, T, D, D}; pg8::StaticOrder S; S.init(T, D, F.G, (int)blockIdx.x); EpiBf16S E{SCB, D, rowss + (size_t)RS_FFN1 * T * 32};
        pg8::gemm_phase<EpiBf16S, pg8::StaticOrder, true, true>(F.lds + RING_OFF, g, S, E); } SEAM(14);
    if (IN(15)) { peer_phase(args, F, 1); } SEAM(15);
    if (IN(16)) { pg8::Gemm g{ACTA, (const bf16*)(ws + WS_WGATE) + (size_t)D * D, T, D, D}; pg8::StaticOrder S; S.init(T, D, F.G, (int)blockIdx.x);
        EpiResid<true> E{args.out, args.out, nullptr, nullptr, rowss + (size_t)RS_FINAL * T * 32, PP};
        pg8::gemm_phase<EpiResid<true>, pg8::StaticOrder, true, true>(F.lds + RING_OFF, g, S, E); } SEAM(16);
    if (IN(17)) { final_rows(args, F); }
#undef IN
#undef SEAM
}

extern "C" void kernel_launch(void* const* d_in, const int* in_sizes, int n_in, void* d_out, int out_size, void* d_ws, size_t ws_size, hipStream_t stream) {
    static int grid = 0;
    if (grid == 0) {
        if (n_in != N_IN || out_size != T * D || ws_size < WS_END) { fprintf(stderr, "kernel_launch: unexpected problem: n_in %d out %d ws %zu (need %zu)\n", n_in, out_size, ws_size, (size_t)WS_END); grid = -1; return; }
        int dev = 0, cus = 0, per_cu = 0;
        if (hipGetDevice(&dev) != hipSuccess || hipDeviceGetAttribute(&cus, hipDeviceAttributeMultiprocessorCount, dev) != hipSuccess) { grid = -1; return; }
        if (hipFuncSetAttribute((const void*)mega_fwd, hipFuncAttributeMaxDynamicSharedMemorySize, LDS_BYTES) != hipSuccess) { fprintf(stderr, "kernel_launch: hipFuncSetAttribute failed\n"); grid = -1; return; }
        if (hipOccupancyMaxActiveBlocksPerMultiprocessor(&per_cu, (const void*)mega_fwd, NTHREADS, LDS_BYTES) != hipSuccess || per_cu < 1) { fprintf(stderr, "kernel_launch: occupancy query says %d blocks per CU\n", per_cu); (void)hipGetLastError(); grid = -1; return; }
        grid = cus;
    }
    if (grid < 0) return;
    (void)hipMemsetAsync((char*)d_ws + WS_CTL, 0, CTL_ZERO_BYTES, stream);
    Args a{};
    for (int i = 0; i < N_IN; ++i) a.in[i] = (const float*)d_in[i];
    a.out = (float*)d_out; a.ws = (unsigned char*)d_ws;
#if MK_PER_PHASE
    for (int p = 0; p < N_PHASES - 1; ++p) { a.ph_lo = p; a.ph_hi = p + 1; hipLaunchKernelGGL(mega_fwd, dim3(grid), dim3(NTHREADS), LDS_BYTES, stream, a); }
#else
    a.ph_lo = 0; a.ph_hi = N_PHASES;
    void* kargs[] = {&a};
    hipError_t e = hipLaunchCooperativeKernel((const void*)mega_fwd, dim3(grid), dim3(NTHREADS), kargs, LDS_BYTES, stream);
    if (e != hipSuccess) fprintf(stderr, "kernel_launch: cooperative launch failed: %s (grid %d)\n", hipGetErrorString(e), grid);
#endif
}
```

```cpp
#include <hip/hip_runtime.h>
#include <hip/hip_cooperative_groups.h>
#include <cstdio>
#include <cstdint>
namespace cg = cooperative_groups;

#ifndef PROBE_MASK
#define PROBE_MASK 0
#endif
#ifndef DUP_MASK
#define DUP_MASK 0
#endif
#ifndef MK_PER_PHASE
#define MK_PER_PHASE 0
#endif

namespace pg8 {
#define PG8_LAS __attribute__((address_space(3)))
typedef unsigned short bf16_t;
typedef short bf16x8 __attribute__((ext_vector_type(8)));
typedef float f32x4 __attribute__((ext_vector_type(4)));
typedef unsigned u32x4 __attribute__((ext_vector_type(4)));
typedef unsigned u32x2 __attribute__((ext_vector_type(2)));
constexpr int BM = 256, BK = 64, HALF = 128, HTB = HALF * BK * 2  , STAGE_BYTES = 8 * HTB, NXCD = 8, WGM = 8;

__host__ __device__ __forceinline__ int lds_byte(int r, int c) { const int st = (r >> 4) * 2 + (c >> 5), rr = r & 15, cc = c & 31, ob = rr * 64 + cc * 2; return st * 1024 + (ob ^ (((ob >> 9) & 1) << 5)); }
__host__ __device__ __forceinline__ void stage_rc(int b, int& R, int& C) { const int st = b / 1024, sb = b % 1024, swz = sb ^ (((sb >> 9) & 1) << 5); R = (st >> 1) * 16 + swz / 64; C = (st & 1) * 32 + (swz % 64) / 2; }
__host__ __device__ __forceinline__ int perm32(int rho) { const int n = rho >> 4, i = rho & 15; return 8 * (i >> 2) + 4 * n + (i & 3); }

struct Unit { int pm, pn; };
struct Gemm { const bf16_t* A; const bf16_t* Bt; int M, N, K; };

struct StaticOrder {
    int nM, nN, nwg, G, c;
    __host__ __device__ void init(int M, int N, int G_, int c_) { nM = M / BM; nN = N / BM; nwg = nM * nN; G = G_; c = c_; }
    __host__ __device__ bool next(int i, Unit& u) const {
        const long L = (long)i * G + c; if (L >= nwg) return false;
        int wgid = (int)L; { const int q = nwg / NXCD, r = nwg % NXCD, xcd = wgid % NXCD, off = wgid / NXCD; wgid = (xcd < r ? xcd * (q + 1) : r * (q + 1) + (xcd - r) * q) + off; }
        const int nig = WGM * nN, gid = wgid / nig, fm = gid * WGM, gsz = (nM - fm) < WGM ? (nM - fm) : WGM;
        u.pm = fm + ((wgid % nig) % gsz); u.pn = (wgid % nig) / gsz; return true;
    }
    __device__ __forceinline__ void a_ready(const Unit&) const {}
    __device__ __forceinline__ void done(const Unit&) const {}
};
__device__ __forceinline__ unsigned cvt_pk_bf16(float lo, float hi) { unsigned r; asm volatile("v_cvt_pk_bf16_f32 %0, %1, %2" : "=v"(r) : "v"(lo), "v"(hi)); return r; }
template <class Epi, class Sched, bool ALIGN_EPI = false, bool SP2 = false>
__device__ __forceinline__ void gemm_phase(PG8_LAS unsigned char* lds, const Gemm g, const Sched& S, const Epi& E) {
    const int tid = threadIdx.x, wid = __builtin_amdgcn_readfirstlane(tid >> 6), lane = tid & 63, wr = wid >> 2, wc = wid & 3, fr = lane & 15, fq = lane >> 4;
    const int K = g.K, nt = K / BK;
    unsigned voffA[2], voffB[2];
#pragma unroll
    for (int i = 0; i < 2; ++i) { int R, C; stage_rc(tid * 16 + i * 8192, R, C); const int Rb = Epi::PERM ? ((R & ~31) + perm32(R & 31)) : R;
        voffA[i] = (unsigned)(R * K + C) * 2u; voffB[i] = (unsigned)(Rb * K + C) * 2u; }
    const size_t kstep = (size_t)(BK * 2);
    const size_t hstep = (size_t)HALF * K * 2;
    const size_t tstep = 2 * hstep;
    const unsigned ldsw = (unsigned)wid * 1024u;
    const int aoff = lds_byte(wr * 64 + fr, fq * 8), boff = lds_byte(wc * 32 + fr, fq * 8);
#define PG8_SA(b, h) (((b) * 2 + (h)) * HTB)
#define PG8_SB(b, h) ((4 + (b) * 2 + (h)) * HTB)
#define PG8_STAGE(bufoff, gbase, voff) do { _Pragma("unroll") for (int _i = 0; _i < 2; ++_i) \
        __builtin_amdgcn_global_load_lds((const unsigned*)((const char*)(gbase) + (voff)[_i]), (PG8_LAS unsigned*)(lds + (bufoff) + ldsw + _i * 8192), 16, 0, 0); } while (0)
#define PG8_LDA(dst, b, h) do { _Pragma("unroll") for (int m = 0; m < 4; ++m) _Pragma("unroll") for (int k = 0; k < 2; ++k) dst[m][k] = *(const PG8_LAS bf16x8*)(lds + PG8_SA(b, h) + aoff + m * 2048 + k * 1024); } while (0)
#define PG8_LDB(dst, b, h) do { _Pragma("unroll") for (int n = 0; n < 2; ++n) _Pragma("unroll") for (int k = 0; k < 2; ++k) dst[n][k] = *(const PG8_LAS bf16x8*)(lds + PG8_SB(b, h) + boff + n * 2048 + k * 1024); } while (0)
#define PG8_MMA(ai, bj, At, Bt) do { __builtin_amdgcn_s_setprio(1); _Pragma("unroll") for (int m = 0; m < 4; ++m) _Pragma("unroll") for (int n = 0; n < 2; ++n) _Pragma("unroll") for (int k = 0; k < 2; ++k) \
        acc[ai][bj][m][n] = __builtin_amdgcn_mfma_f32_16x16x32_bf16(Bt[n][k], At[m][k], acc[ai][bj][m][n], 0, 0, 0); __builtin_amdgcn_s_setprio(0); } while (0)
#define PG8_WAIT_V(n) asm volatile("s_waitcnt vmcnt(" #n ")" ::: "memory")
#define PG8_WAIT_L(n) asm volatile("s_waitcnt lgkmcnt(" #n ")" ::: "memory")
#define PG8_BAR __builtin_amdgcn_s_barrier()
#define PG8_SCHED __builtin_amdgcn_sched_barrier(0)
    Unit cur, nxt; int ui = 0;
    if (!S.next(0, cur)) return;
    f32x4 acc[2][2][4][2];
#pragma unroll
    for (int a = 0; a < 2; ++a)
#pragma unroll
        for (int b = 0; b < 2; ++b)
#pragma unroll
            for (int m = 0; m < 4; ++m)
#pragma unroll
                for (int n = 0; n < 2; ++n) acc[a][b][m][n] = (f32x4){0.f, 0.f, 0.f, 0.f};
    bf16x8 At[4][2], B0[2][2], B1[2][2];
    const char* cA = (const char*)g.A + (size_t)cur.pm * tstep; const char* cB = (const char*)g.Bt + (size_t)cur.pn * tstep;
    S.a_ready(cur);
    if constexpr (SP2) {
        PG8_STAGE(PG8_SB(0, 0), cB, voffB); PG8_STAGE(PG8_SB(0, 1), cB + hstep, voffB); PG8_STAGE(PG8_SA(0, 0), cA, voffA); PG8_STAGE(PG8_SA(0, 1), cA + hstep, voffA);
        if (wr == 1) PG8_BAR;
        PG8_WAIT_V(2); PG8_BAR;
        PG8_STAGE(PG8_SB(1, 0), cB + kstep, voffB); PG8_STAGE(PG8_SA(1, 0), cA + kstep, voffA); PG8_STAGE(PG8_SB(1, 1), cB + hstep + kstep, voffB);
        PG8_WAIT_V(6); PG8_BAR;
    } else {
        PG8_STAGE(PG8_SB(0, 0), cB, voffB); PG8_STAGE(PG8_SA(0, 0), cA, voffA); PG8_STAGE(PG8_SB(0, 1), cB + hstep, voffB); PG8_STAGE(PG8_SA(0, 1), cA + hstep, voffA);
        if (wr == 1) PG8_BAR;
        PG8_WAIT_V(4); PG8_BAR;
        PG8_STAGE(PG8_SB(1, 0), cB + kstep, voffB); PG8_STAGE(PG8_SA(1, 0), cA + kstep, voffA); PG8_STAGE(PG8_SB(1, 1), cB + hstep + kstep, voffB);
        PG8_WAIT_V(6); PG8_BAR;
    }
    for (;;) {
        const bool has_next = S.next(ui + 1, nxt);
        const char* nA = has_next ? (const char*)g.A + (size_t)nxt.pm * tstep : cA; const char* nB = has_next ? (const char*)g.Bt + (size_t)nxt.pn * tstep : cB;
        for (int t = 0; t < nt; t += 2) {
            const bool last = (t == nt - 2);
            const char* a1 = cA + (size_t)(t + 1) * kstep;
            const char* a2 = last ? nA : cA + (size_t)(t + 2) * kstep; const char* b2 = last ? nB : cB + (size_t)(t + 2) * kstep;
            const char* a3 = a2 + kstep; const char* b3 = b2 + kstep;
            if (last && has_next) S.a_ready(nxt);
            if constexpr (SP2) {
            PG8_LDB(B0, 0, 0); PG8_LDB(B1, 0, 1); PG8_SCHED; PG8_LDA(At, 0, 0); PG8_STAGE(PG8_SA(1, 1), a1 + hstep, voffA);
            PG8_WAIT_V(8); PG8_WAIT_L(0); PG8_BAR; PG8_MMA(0, 0, At, B0); PG8_MMA(0, 1, At, B1); PG8_BAR; PG8_SCHED;
            PG8_LDA(At, 0, 1); PG8_STAGE(PG8_SB(0, 0), b2, voffB); PG8_STAGE(PG8_SB(0, 1), b2 + hstep, voffB); PG8_STAGE(PG8_SA(0, 0), a2, voffA);
            PG8_WAIT_V(8); PG8_WAIT_L(0); PG8_BAR; PG8_MMA(1, 0, At, B0); PG8_MMA(1, 1, At, B1); PG8_BAR; PG8_SCHED;
            PG8_LDB(B0, 1, 0); PG8_LDB(B1, 1, 1); PG8_SCHED; PG8_LDA(At, 1, 0); PG8_STAGE(PG8_SA(0, 1), a2 + hstep, voffA);
            PG8_WAIT_V(8); PG8_WAIT_L(0); PG8_BAR; PG8_MMA(0, 0, At, B0); PG8_MMA(0, 1, At, B1); PG8_BAR; PG8_SCHED;
            PG8_LDA(At, 1, 1); PG8_STAGE(PG8_SB(1, 0), b3, voffB); PG8_STAGE(PG8_SB(1, 1), b3 + hstep, voffB); PG8_STAGE(PG8_SA(1, 0), a3, voffA);
            PG8_WAIT_V(8); PG8_WAIT_L(0); PG8_BAR; PG8_MMA(1, 0, At, B0); PG8_MMA(1, 1, At, B1); PG8_BAR; PG8_SCHED;
            } else {
            PG8_LDB(B0, 0, 0); PG8_SCHED; PG8_LDA(At, 0, 0); PG8_STAGE(PG8_SA(1, 1), a1 + hstep, voffA);
            PG8_WAIT_L(8); PG8_BAR; PG8_WAIT_L(0); PG8_MMA(0, 0, At, B0); PG8_BAR; PG8_SCHED;
            PG8_LDB(B1, 0, 1); PG8_STAGE(PG8_SB(0, 0), b2, voffB);
            PG8_BAR; PG8_WAIT_L(0); PG8_MMA(0, 1, At, B1); PG8_BAR;
            PG8_LDA(At, 0, 1); PG8_STAGE(PG8_SA(0, 0), a2, voffA);
            PG8_BAR; PG8_WAIT_L(0); PG8_MMA(1, 0, At, B0); PG8_BAR; PG8_SCHED;
            PG8_STAGE(PG8_SB(0, 1), b2 + hstep, voffB);
            PG8_WAIT_V(6); PG8_BAR; PG8_MMA(1, 1, At, B1); PG8_BAR;
            PG8_LDB(B0, 1, 0); PG8_SCHED; PG8_LDA(At, 1, 0); PG8_STAGE(PG8_SA(0, 1), a2 + hstep, voffA);
            PG8_WAIT_L(8); PG8_BAR; PG8_WAIT_L(0); PG8_MMA(0, 0, At, B0); PG8_BAR; PG8_SCHED;
            PG8_LDB(B1, 1, 1); PG8_STAGE(PG8_SB(1, 0), b3, voffB);
            PG8_BAR; PG8_WAIT_L(0); PG8_MMA(0, 1, At, B1); PG8_BAR;
            PG8_LDA(At, 1, 1); PG8_STAGE(PG8_SA(1, 0), a3, voffA);
            PG8_BAR; PG8_WAIT_L(0); PG8_MMA(1, 0, At, B0); PG8_BAR; PG8_SCHED;
            PG8_STAGE(PG8_SB(1, 1), b3 + hstep, voffB);
            PG8_WAIT_V(6); PG8_BAR; PG8_MMA(1, 1, At, B1); PG8_BAR;
            }
        }
        if constexpr (ALIGN_EPI) { if (wr == 0) PG8_BAR; }
        if constexpr (!Epi::AFTER_DRAIN) { E(acc, cur, wr, wc, fr, fq); S.done(cur); }
        if (!has_next) break;
#pragma unroll
        for (int a = 0; a < 2; ++a)
#pragma unroll
            for (int b = 0; b < 2; ++b)
#pragma unroll
                for (int m = 0; m < 4; ++m)
#pragma unroll
                    for (int n = 0; n < 2; ++n) acc[a][b][m][n] = (f32x4){0.f, 0.f, 0.f, 0.f};
        cur = nxt; cA = nA; cB = nB; ++ui;
        if constexpr (ALIGN_EPI) { if (wr == 1) PG8_BAR; }
    }
    PG8_WAIT_V(0);
    if constexpr (!ALIGN_EPI) { if (wr == 0) PG8_BAR; }
    PG8_BAR;
    if constexpr (Epi::AFTER_DRAIN) { E.fused(acc, cur, wr, wc, fr, fq, lds, wid, lane); S.done(cur); }
#undef PG8_SA
#undef PG8_SB
#undef PG8_STAGE
#undef PG8_LDA
#undef PG8_LDB
#undef PG8_MMA
#undef PG8_WAIT_V
#undef PG8_WAIT_L
#undef PG8_BAR
#undef PG8_SCHED
}
}
#define GAS __attribute__((address_space(1)))
#define LAS __attribute__((address_space(3)))
typedef unsigned short bf16;
typedef unsigned v4u __attribute__((ext_vector_type(4)));
typedef float f32x4 __attribute__((ext_vector_type(4)));
typedef short bf16x8 __attribute__((ext_vector_type(8)));
typedef GAS unsigned gu32;
typedef GAS unsigned long long gu64;
#define RLX_AGENT __ATOMIC_RELAXED, __HIP_MEMORY_SCOPE_AGENT
#define LDS_WAIT() asm volatile("s_waitcnt lgkmcnt(0)" ::: "memory")
#define VM_WAIT() asm volatile("s_waitcnt vmcnt(0)" ::: "memory")
__device__ __forceinline__ unsigned long long rt() { return __builtin_amdgcn_s_memrealtime(); }
__device__ __forceinline__ unsigned f2bf(float f) { unsigned u = __builtin_bit_cast(unsigned, f); return (u + 0x7fffu + ((u >> 16) & 1u)) >> 16; }
__device__ __forceinline__ unsigned pk2(float lo, float hi) { return f2bf(lo) | (f2bf(hi) << 16); }

#define XB_TMO      128
#define XB_XCNT(j)  (256  + 64 * (j))
#define XB_XSUB(j)  (1280 + 64 * (j))
#define XB_XGEN(j)  (2304 + 64 * (j))
#define XB_TOP      3328
#define XB_TOPGEN   3392
#define XCD_BAR_WORDS 3456
#define XB_SPIN_CAP (1u << 18)

__device__ __forceinline__ unsigned xb_ld(unsigned* p)              { return __hip_atomic_load(p, __ATOMIC_RELAXED, __HIP_MEMORY_SCOPE_AGENT); }
__device__ __forceinline__ unsigned xb_add(unsigned* p, unsigned v) { return __hip_atomic_fetch_add(p, v, __ATOMIC_RELAXED, __HIP_MEMORY_SCOPE_AGENT); }
__device__ __forceinline__ unsigned xb_xcc_id() { return (unsigned)__builtin_amdgcn_s_getreg((3 << 11) | 20) & 0xFu; }
#define XB_SPIN(cond, bar) do { unsigned _sp = 0; while (cond) { __builtin_amdgcn_s_sleep(1); \
    if ((++_sp & 255u) == 0u) { if (xb_ld(&(bar)[XB_TMO])) break; if (_sp > XB_SPIN_CAP) { atomicAdd(&(bar)[XB_TMO], 1u); break; } } } } while (0)

struct XcdBarrier {
    unsigned* bar; unsigned x;
    volatile LAS unsigned* st;
};

__device__ __forceinline__ XcdBarrier xcd_barrier_post(unsigned* bar, volatile LAS unsigned* st) {
    XcdBarrier b; b.bar = bar; b.x = xb_xcc_id(); b.st = st;
    if (threadIdx.x == 0) (void)xb_add(&bar[XB_XCNT(b.x)], 1u);
    return b;
}
__device__ __forceinline__ void xcd_barrier_complete(unsigned* bar, unsigned x, unsigned& nloc, unsigned& nx) {
    const unsigned G = gridDim.x * gridDim.y * gridDim.z;
    unsigned sum, cnt, mine, sp = 0u;
    for (;;) {
        sum = 0u; cnt = 0u; mine = 0u;
#pragma unroll
        for (unsigned j = 0; j < 16; ++j) { const unsigned c = xb_ld(&bar[XB_XCNT(j)]); sum += c; cnt += (c > 0u) ? 1u : 0u; mine = (j == x) ? c : mine; }
        if (sum == G) break;
        __builtin_amdgcn_s_sleep(1);
        if ((++sp & 255u) == 0u) { if (xb_ld(&bar[XB_TMO])) break; if (sp > XB_SPIN_CAP) { atomicAdd(&bar[XB_TMO], 1u); break; } }
    }
    nloc = mine > 0u ? mine : 1u; nx = cnt > 0u ? cnt : 1u;
}

__device__ __forceinline__ void xcd_barrier(const XcdBarrier& b) {
    asm volatile("s_waitcnt vmcnt(0)" ::: "memory");
    __syncthreads();
    if (threadIdx.x == 0) {
        unsigned* bar = b.bar;
        __builtin_amdgcn_s_waitcnt(0);
        unsigned nloc = b.st[0], nx = b.st[1];
        if (nloc == 0u) { xcd_barrier_complete(bar, b.x, nloc, nx); b.st[0] = nloc; b.st[1] = nx; }
        const unsigned old = xb_add(&bar[XB_XSUB(b.x)], 1u);
        const unsigned gen = old / nloc;
        if (old + 1u == (gen + 1u) * nloc) {
            __builtin_amdgcn_fence(__ATOMIC_RELEASE, "agent");
            asm volatile("s_waitcnt vmcnt(0)" ::: "memory");
            const unsigned og = xb_add(&bar[XB_TOP], 1u);
            const unsigned tg = og / nx;
            if (og + 1u == (tg + 1u) * nx) xb_add(&bar[XB_TOPGEN], 1u);
            else XB_SPIN(xb_ld(&bar[XB_TOPGEN]) == tg, bar);
            __builtin_amdgcn_fence(__ATOMIC_ACQUIRE, "agent");
            xb_add(&bar[XB_XGEN(b.x)], 1u);
            asm volatile("s_waitcnt vmcnt(0)" ::: "memory");
        } else {
            XB_SPIN(xb_ld(&bar[XB_XGEN(b.x)]) == gen, bar);
            __builtin_amdgcn_fence(__ATOMIC_ACQUIRE, "agent");
            asm volatile("s_waitcnt vmcnt(0)" ::: "memory");
        }
    }
    __syncthreads();
}

constexpr int NWAVES = 8, NTHREADS = NWAVES * 64;
constexpr int BATCH = 8, SEQ = 2048, T = BATCH * SEQ, D = 2048;
constexpr int EV_N = 7200, EV_NP = 7424, OD_N = 7616, OD_NP = 7680, PROJ_LD = 7680;
constexpr float EPS = 1e-6f;
constexpr int EC_GQ = 0, EC_GK = 512, EC_GV = 1024, EC_GZ = 2048, EC_GLR = 3072, EC_BQ = 3088, EC_BK = 4112, EC_BV = 5136, EC_BZ = 6160, EC_BA = 7184, EC_BB = 7192;
constexpr int OC_HQ = 0, OC_HF = 1024, OC_HI = 2048, OC_HG = 3072, OC_RW = 4096;
constexpr int RW_R = 0, RW_K = 1024, RW_V = 2048, RW_WL = 3072, RW_AL = 3168, RW_GL = 3264;
constexpr int LORA_K = 512, LORA_N = 3072;
enum { I_X = 0, I_P, I_EV_WIN, I_GK_W2, I_GK_B, I_GLA_NORM, I_GDN_CONV, I_GDN_ALOG, I_GDN_DTB, I_GDN_NORM, I_EV_WOUT, I_OD_WIN, I_LB, I_HG_NORM,
       I_MU, I_W0, I_W2, I_A0, I_A2, I_G2, I_KK, I_KA, I_RK, I_LNW, I_LNB, I_OD_WOUT, I_NMIX, I_NFFN, I_NPLE, I_PEER_WQ, I_PEER_SK, I_PEER_U, I_PEER_V,
       I_PLE_WP, I_PLE_WG, I_NFINAL, N_IN };

constexpr size_t MiB = 1u << 20;
constexpr size_t WS_CTL = 0, CTL_ZERO_BYTES = 1 * MiB;
constexpr size_t WS_WEV_IN = 1 * MiB, WS_WEV_OUT = 30 * MiB, WS_WOD_IN = 38 * MiB, WS_WOD_OUT = 68 * MiB, WS_WPEER = 76 * MiB, WS_WGATE = 92 * MiB, WS_WPROJ = 108 * MiB,
                 WS_WLORA = 110 * MiB, WS_PBF = 113 * MiB, WS_TABU = 129 * MiB, WS_TABV = 193 * MiB, WS_ACTA = 257 * MiB, WS_ACTB = 321 * MiB, WS_PROJ = 385 * MiB, WS_SC = 385 * MiB,
                 WS_O = 625 * MiB, WS_PP = 753 * MiB, WS_LA = 817 * MiB, WS_LO = 833 * MiB, WS_RSP = 929 * MiB, WS_END = 937 * MiB;
static_assert(WS_WEV_IN + (size_t)EV_NP * D * 2 <= WS_WEV_OUT && WS_WOD_IN + (size_t)OD_NP * D * 2 <= WS_WOD_OUT && WS_PROJ + (size_t)T * PROJ_LD * 2 <= WS_O, "ws map");
constexpr int CW_BAR = 4096;
enum { RS_FFN0 = 0, RS_MIX1 = 1, RS_FFN1 = 2, RS_FINAL = 3 };
constexpr int RING_OFF = 0, RING_BYTES = 131072;
constexpr int LDSCTL_OFF = RING_BYTES, MISC_OFF = LDSCTL_OFF + 320;
constexpr int LDS_BYTES = 147456;

struct Args { const float* in[N_IN]; float* out; unsigned char* ws; int ph_lo, ph_hi; };
struct Frame {
    LAS unsigned char* lds; volatile LAS unsigned* MISC; gu32* ctl;
    int tid, lane, wave, vcu, G;
};
__device__ __forceinline__ float wave_sum(float v) {
#pragma unroll
    for (int o = 1; o < 64; o <<= 1) v += __shfl_xor(v, o);
    return v;
}
__device__ __forceinline__ float half_sum32(float v) {
#pragma unroll
    for (int o = 1; o < 32; o <<= 1) v += __shfl_xor(v, o);
    return v;
}
#define DPP_ADD(v, ctrl) (v) += __builtin_bit_cast(float, __builtin_amdgcn_update_dpp(0, __builtin_bit_cast(int, (v)), (ctrl), 0xF, 0xF, false))
__device__ __forceinline__ float row_sum16(float v) {
    DPP_ADD(v, 0x128); DPP_ADD(v, 0x124); DPP_ADD(v, 0x122); DPP_ADD(v, 0x121);
    return v;
}
__device__ __forceinline__ float bf_lo(unsigned w) { return __uint_as_float(w << 16); }
__device__ __forceinline__ float bf_hi(unsigned w) { return __uint_as_float(w & 0xffff0000u); }
__device__ __forceinline__ float sigmoidf_(float x) { return 1.0f / (1.0f + __expf(-x)); }
__device__ __forceinline__ float siluf_(float x) { return x / (1.0f + __expf(-x)); }
__device__ __forceinline__ float softplusf_(float x) { return fmaxf(x, 0.f) + log1pf(__expf(-fabsf(x))); }
__device__ __forceinline__ float logsigmoidf_(float x) { return fminf(x, 0.f) - log1pf(__expf(-fabsf(x))); }

struct EpiBf16S {
    static constexpr bool PERM = true, AFTER_DRAIN = false;
    bf16* O; int ldc; const float* rowss;
    __device__ __forceinline__ void operator()(const pg8::f32x4 (&acc)[2][2][4][2], const pg8::Unit& u, int wr, int wc, int fr, int fq) const {
        const int row0 = u.pm * 256 + wr * 64 + fr, col0 = u.pn * 256 + wc * 32 + 8 * fq;
#pragma unroll
        for (int ai = 0; ai < 2; ++ai)
#pragma unroll
            for (int m = 0; m < 4; ++m) {
                const int row = row0 + ai * 128 + m * 16;
                float sc = 1.f;
                if (rowss) { const pg8::f32x4* rp = (const pg8::f32x4*)(rowss + (size_t)row * 32 + 8 * fq); const pg8::f32x4 p0 = rp[0], p1 = rp[1];
                    float s = ((p0[0] + p0[1]) + (p0[2] + p0[3])) + ((p1[0] + p1[1]) + (p1[2] + p1[3])); s += __shfl_xor(s, 16); s += __shfl_xor(s, 32);
                    sc = __builtin_amdgcn_rsqf(s * (1.0f / D) + EPS); }
                bf16* rowp = O + (size_t)row * ldc + col0;
#pragma unroll
                for (int bj = 0; bj < 2; ++bj) { const pg8::f32x4 v0 = acc[ai][bj][m][0] * sc, v1 = acc[ai][bj][m][1] * sc;
                    pg8::u32x4 w; w.x = pg8::cvt_pk_bf16(v0[0], v0[1]); w.y = pg8::cvt_pk_bf16(v0[2], v0[3]); w.z = pg8::cvt_pk_bf16(v1[0], v1[1]); w.w = pg8::cvt_pk_bf16(v1[2], v1[3]);
                    *(pg8::u32x4*)(rowp + bj * 128) = w; } }
    }
};
template <bool GATE> struct EpiResid {
    static constexpr bool PERM = false, AFTER_DRAIN = false;
    const float* hin; float* hout; bf16* hg; const float* gain; float* rowss; const bf16* pp;
    __device__ __forceinline__ void operator()(const pg8::f32x4 (&acc)[2][2][4][2], const pg8::Unit& u, int wr, int wc, int fr, int fq) const {
        const int row0 = u.pm * 256 + wr * 64 + fr, col0 = u.pn * 256 + wc * 32 + 4 * fq;
        pg8::f32x4 gv[2][2];
#pragma unroll
        for (int bj = 0; bj < 2; ++bj)
#pragma unroll
            for (int n = 0; n < 2; ++n) gv[bj][n] = hg ? *(const pg8::f32x4*)(gain + col0 + bj * 128 + n * 16) : (pg8::f32x4){0.f, 0.f, 0.f, 0.f};
#pragma unroll
        for (int ai = 0; ai < 2; ++ai)
#pragma unroll
            for (int m = 0; m < 4; ++m) {
                const int row = row0 + ai * 128 + m * 16; const size_t off = (size_t)row * D + col0; float ss = 0.f;
#pragma unroll
                for (int bj = 0; bj < 2; ++bj)
#pragma unroll
                    for (int n = 0; n < 2; ++n) { const size_t o = off + bj * 128 + n * 16;
                        pg8::f32x4 hv = *(const pg8::f32x4*)(hin + o); pg8::f32x4 a = acc[ai][bj][m][n];
                        if (GATE) { const pg8::u32x2 pw = *(const pg8::u32x2*)(pp + o);
                            a[0] = sigmoidf_(a[0]) * bf_lo(pw.x); a[1] = sigmoidf_(a[1]) * bf_hi(pw.x); a[2] = sigmoidf_(a[2]) * bf_lo(pw.y); a[3] = sigmoidf_(a[3]) * bf_hi(pw.y); }
                        hv = hv + a; *(pg8::f32x4*)(hout + o) = hv;
                        ss += (hv[0] * hv[0] + hv[1] * hv[1]) + (hv[2] * hv[2] + hv[3] * hv[3]);
                        if (hg) { const pg8::f32x4 q = hv * gv[bj][n]; pg8::u32x2 w; w.x = pg8::cvt_pk_bf16(q[0], q[1]); w.y = pg8::cvt_pk_bf16(q[2], q[3]); *(pg8::u32x2*)(hg + o) = w; } }
                ss += __shfl_xor(ss, 16); ss += __shfl_xor(ss, 32);
                if (fq == 0) rowss[(size_t)row * 32 + u.pn * 4 + wc] = ss;
                asm volatile("" ::: "memory"); }
    }
};

__device__ __forceinline__ void p0_transpose_item(const float* W, int K, int N, bf16* WT, LAS float* scr, int item, int lane) {
    const int nblk = N / 32, kb = item / nblk, nb = item % nblk, k0 = 64 * kb, n0 = 32 * nb;
#pragma unroll 8
    for (int i = 0; i < 32; ++i) { const int kk = 2 * i + (lane >> 5); scr[kk * 33 + (lane & 31)] = W[(size_t)(k0 + kk) * N + n0 + (lane & 31)]; }
    LDS_WAIT(); asm volatile("" ::: "memory");
    const int c = lane & 7;
#pragma unroll
    for (int j = 0; j < 4; ++j) { const int n = (lane >> 3) + 8 * j; const LAS float* s = scr + (8 * c) * 33 + n;
        v4u o; o.x = pk2(s[0 * 33], s[1 * 33]); o.y = pk2(s[2 * 33], s[3 * 33]); o.z = pk2(s[4 * 33], s[5 * 33]); o.w = pk2(s[6 * 33], s[7 * 33]);
        *(GAS v4u*)(WT + (size_t)(n0 + n) * K + k0 + 8 * c) = o; }
    LDS_WAIT(); asm volatile("" ::: "memory");
}
__device__ __forceinline__ void cvt_f32_bf16(const float* src, bf16* dst, size_t n, int gtid, int gthreads) {
    const size_t n8 = n / 8;
    for (size_t i = gtid; i < n8; i += gthreads) {
        const f32x4 a = *(const GAS f32x4*)(src + i * 8), b = *(const GAS f32x4*)(src + i * 8 + 4);
        v4u o; o.x = pk2(a[0], a[1]); o.y = pk2(a[2], a[3]); o.z = pk2(b[0], b[1]); o.w = pk2(b[2], b[3]);
        *(GAS v4u*)(dst + i * 8) = o; }
}
__device__ __forceinline__ void cvt_f32_fp8(const float* src, unsigned char* dst, size_t n, float scale, int gtid, int gthreads) {
    const size_t n16 = n / 16;
    for (size_t i = gtid; i < n16; i += gthreads) { v4u o; unsigned w[4];
#pragma unroll
        for (int q = 0; q < 4; ++q) { const f32x4 a = *(const GAS f32x4*)(src + i * 16 + 4 * q) * scale;
            int x = __builtin_amdgcn_cvt_pk_fp8_f32(a[0], a[1], 0, false); x = __builtin_amdgcn_cvt_pk_fp8_f32(a[2], a[3], x, true); w[q] = (unsigned)x; }
        o.x = w[0]; o.y = w[1]; o.z = w[2]; o.w = w[3];
        *(GAS v4u*)(dst + i * 16) = o; }
}
__device__ __forceinline__ void rms_row_to_bf16(const float* xrow, const float* g, bf16* orow, int lane) {
    const GAS f32x4* xr = (const GAS f32x4*)xrow + lane; f32x4 v[8]; float s = 0.f;
#pragma unroll
    for (int j = 0; j < 8; ++j) { v[j] = xr[64 * j]; s += (v[j][0] * v[j][0] + v[j][1] * v[j][1]) + (v[j][2] * v[j][2] + v[j][3] * v[j][3]); }
    const float r = __builtin_amdgcn_rsqf(wave_sum(s) * (1.0f / D) + EPS);
    const GAS f32x4* gr = (const GAS f32x4*)g + lane;
    GAS unsigned long long* o8 = (GAS unsigned long long*)orow + lane;
#pragma unroll
    for (int j = 0; j < 8; ++j) { const f32x4 gg = gr[64 * j]; o8[64 * j] = (unsigned long long)pk2(v[j][0] * r * gg[0], v[j][1] * r * gg[1]) | ((unsigned long long)pk2(v[j][2] * r * gg[2], v[j][3] * r * gg[3]) << 32); }
}
__device__ __forceinline__ void p0_fold_item(const float* wq, const float* sk, bf16* WP, LAS float* lds, int item, int tid) {
    const int hp = item >> 5, k0 = (item & 31) * 64;
    LAS float* skT = lds;
    LAS float* wqT = lds + 128 * 132;
    const float* skb = sk + (size_t)hp * 128 * 128;
#pragma unroll 4
    for (int i = 0; i < 32; ++i) { const int idx = i * 512 + tid, n = idx >> 7, d = idx & 127; skT[d * 132 + n] = skb[idx]; }
#pragma unroll 4
    for (int i = 0; i < 16; ++i) { const int idx = i * 512 + tid, kk = idx >> 7, d = idx & 127; wqT[d * 68 + kk] = wq[(size_t)(k0 + kk) * D + hp * 128 + d]; }
    __syncthreads();
    const int n0 = (tid >> 4) * 4, kk0 = (tid & 15) * 4;
    float acc[4][4];
#pragma unroll
    for (int i = 0; i < 4; ++i)
#pragma unroll
        for (int j = 0; j < 4; ++j) acc[i][j] = 0.f;
#pragma unroll 4
    for (int d = 0; d < 128; ++d) { const f32x4 a = *(const LAS f32x4*)(skT + d * 132 + n0), b = *(const LAS f32x4*)(wqT + d * 68 + kk0);
#pragma unroll
        for (int i = 0; i < 4; ++i)
#pragma unroll
            for (int j = 0; j < 4; ++j) acc[i][j] += a[i] * b[j]; }
#pragma unroll
    for (int i = 0; i < 4; ++i) { unsigned long long o = (unsigned long long)pk2(acc[i][0], acc[i][1]) | ((unsigned long long)pk2(acc[i][2], acc[i][3]) << 32);
        *(GAS unsigned long long*)(WP + (size_t)(hp * 128 + n0 + i) * D + k0 + kk0) = o; }
    __syncthreads();
}
__device__ __forceinline__ void p0_prologue(const Args& A, Frame& F) {
    const int gw = F.vcu * NWAVES + F.wave, NGW = F.G * NWAVES;
    const int gtid = (F.vcu * NWAVES + F.wave) * 64 + F.lane, gthreads = F.G * NTHREADS;
    unsigned char* ws = A.ws;
    {
        LAS float* scr = (LAS float*)(F.lds + RING_OFF + F.wave * 16384);
        constexpr int I_EVIN = (D / 64) * (EV_N / 32), I_SQ = (D / 64) * (D / 32), I_ODIN = (D / 64) * (OD_N / 32), I_PJ = (256 / 64) * (D / 32);
        constexpr int NITEMS = I_EVIN + I_SQ + I_ODIN + I_SQ + 2 * I_SQ + 2 * I_PJ;
        for (int it = gw; it < NITEMS; it += NGW) {
            int r = it;
            if (r < I_EVIN) { p0_transpose_item(A.in[I_EV_WIN], D, EV_N, (bf16*)(ws + WS_WEV_IN), scr, r, F.lane); continue; } r -= I_EVIN;
            if (r < I_SQ) { p0_transpose_item(A.in[I_EV_WOUT], D, D, (bf16*)(ws + WS_WEV_OUT), scr, r, F.lane); continue; } r -= I_SQ;
            if (r < I_ODIN) { p0_transpose_item(A.in[I_OD_WIN], D, OD_N, (bf16*)(ws + WS_WOD_IN), scr, r, F.lane); continue; } r -= I_ODIN;
            if (r < I_SQ) { p0_transpose_item(A.in[I_OD_WOUT], D, D, (bf16*)(ws + WS_WOD_OUT), scr, r, F.lane); continue; } r -= I_SQ;
            if (r < 2 * I_SQ) { const int L = r / I_SQ; p0_transpose_item(A.in[I_PLE_WG] + (size_t)L * D * D, D, D, (bf16*)(ws + WS_WGATE) + (size_t)L * D * D, scr, r % I_SQ, F.lane); continue; } r -= 2 * I_SQ;
            { const int L = r / I_PJ; p0_transpose_item(A.in[I_PLE_WP] + (size_t)L * 256 * D, 256, D, (bf16*)(ws + WS_WPROJ) + (size_t)L * D * 256, scr, r % I_PJ, F.lane); }
        }
        { GAS v4u* z0 = (GAS v4u*)(ws + WS_WEV_IN + (size_t)EV_N * D * 2); const size_t n0 = (size_t)(EV_NP - EV_N) * D * 2 / 16;
          for (size_t i = gtid; i < n0; i += gthreads) z0[i] = (v4u){0u, 0u, 0u, 0u};
          GAS v4u* z1 = (GAS v4u*)(ws + WS_WOD_IN + (size_t)OD_N * D * 2); const size_t n1 = (size_t)(OD_NP - OD_N) * D * 2 / 16;
          for (size_t i = gtid; i < n1; i += gthreads) z1[i] = (v4u){0u, 0u, 0u, 0u}; }
    }
    __syncthreads();
    for (int it = F.vcu; it < 1024; it += F.G) { const int L = it >> 9;
        p0_fold_item(A.in[I_PEER_WQ] + (size_t)L * D * D, A.in[I_PEER_SK] + (size_t)L * 16 * 128 * 128, (bf16*)(ws + WS_WPEER) + (size_t)L * D * D, (LAS float*)(F.lds + RING_OFF), it & 511, F.tid); }
    cvt_f32_fp8(A.in[I_PEER_U], (unsigned char*)(ws + WS_TABU), (size_t)2 * 16384 * D, 512.0f, gtid, gthreads);
    cvt_f32_fp8(A.in[I_PEER_V], (unsigned char*)(ws + WS_TABV), (size_t)2 * 16384 * D, 16.0f, gtid, gthreads);
    cvt_f32_bf16(A.in[I_P], (bf16*)(ws + WS_PBF), (size_t)2 * T * 256, gtid, gthreads);
    { bf16* LB = (bf16*)(ws + WS_WLORA); const float* w2 = A.in[I_W2]; const float* a2 = A.in[I_A2]; const float* g2 = A.in[I_G2];
      for (int i = gtid; i < LORA_N * LORA_K / 2; i += gthreads) { const int row = i / (LORA_K / 2), col = (i % (LORA_K / 2)) * 2; float v[2];
#pragma unroll
          for (int e = 0; e < 2; ++e) { const int c = col + e; float x = 0.f;
              if (row < 1024) { if (c < 96) x = w2[c * 1024 + row]; }
              else if (row < 2048) { if (c >= 96 && c < 192) x = a2[(c - 96) * 1024 + (row - 1024)]; }
              else { if (c >= 192 && c < 448) x = g2[(c - 192) * 1024 + (row - 2048)]; }
              v[e] = x; }
          *(GAS unsigned*)(LB + (size_t)row * LORA_K + col) = pk2(v[0], v[1]); } }
    for (int m = gw; m < T; m += NGW) rms_row_to_bf16(A.in[I_X] + (size_t)m * D, A.in[I_NMIX], (bf16*)(ws + WS_ACTA) + (size_t)m * D, F.lane);
}

constexpr int TC = 16, NCHUNK = SEQ / TC;
typedef float f32x2 __attribute__((ext_vector_type(2)));
typedef unsigned u32x2 __attribute__((ext_vector_type(2)));

template <int MODE>
__device__ __forceinline__ void scan_gla_unit(const Args& A, Frame& F, int unit) {
    const int tid = F.tid, lane = F.lane, w = F.wave;
    int b, h, qcol, kcol, vcol, ocol;
    if (MODE == 0) { b = unit >> 4; h = (unit >> 2) & 3; const int s = unit & 3; qcol = EC_GQ + h * 128; kcol = EC_GK + h * 128; vcol = EC_GV + h * 256 + s * 64; ocol = h * 256 + s * 64; }
    else           { b = unit >> 4; h = (unit >> 1) & 7; const int s = unit & 1; qcol = OC_HQ + h * 128; kcol = OC_HF + h * 128; vcol = OC_HI + h * 128 + s * 64; ocol = h * 128 + s * 64; }
    const bf16* P = (const bf16*)(A.ws + WS_PROJ) + (size_t)b * SEQ * PROJ_LD;
    float* O = (float*)(A.ws + WS_O) + (size_t)b * SEQ * D + ocol;
    LAS float* Lf = (LAS float*)(F.lds + RING_OFF);
    constexpr int BUFSZ = 7168, O_EG = 0, O_K = 2048, O_Q = 4096, O_V = 6144, O_OUT = 2 * BUFSZ, O_W2 = O_OUT + 1024, O_BIAS = O_W2 + 2048;
    const int tl = tid >> 5, dq = (tid & 31) * 4, tlv = tid >> 4, c4 = (tid & 15) * 4;
    float lb[4] = {0.f, 0.f, 0.f, 0.f};
    if (MODE == 0) {
        const float* w2 = A.in[I_GK_W2]; const float* gb = A.in[I_GK_B];
        for (int i = tid; i < 2048; i += NTHREADS) Lf[O_W2 + i] = w2[(i >> 7) * 512 + h * 128 + (i & 127)];
        if (tid < 128) Lf[O_BIAS + tid] = gb[h * 128 + tid];
    } else {
        const float* lg = A.in[I_LB];
#pragma unroll
        for (int i = 0; i < 4; ++i) lb[i] = sigmoidf_(lg[1024 + h * 128 + dq + i] - lg[h * 128 + dq + i]);
    }
    u32x2 rq, rk, rv = {0u, 0u}; v4u rg0 = {0u, 0u, 0u, 0u}, rg1 = {0u, 0u, 0u, 0u};
#define GLA_LOAD(c) do { const bf16* pr = P + (size_t)((c) * TC + tl) * PROJ_LD; rq = *(const GAS u32x2*)(pr + qcol + dq); rk = *(const GAS u32x2*)(pr + kcol + dq); \
        if (MODE == 0) { rg0 = *(const GAS v4u*)(pr + EC_GLR); rg1 = *(const GAS v4u*)(pr + EC_GLR + 8); } \
        if (tid < 256) rv = *(const GAS u32x2*)(P + (size_t)((c) * TC + tlv) * PROJ_LD + vcol + c4); } while (0)
#define GLA_XFORM(bufi) do { LAS float* B_ = Lf + (bufi) * BUFSZ; f32x4 q4, k4, e4; \
        const float xq[4] = {bf_lo(rq.x), bf_hi(rq.x), bf_lo(rq.y), bf_hi(rq.y)}, xk[4] = {bf_lo(rk.x), bf_hi(rk.x), bf_lo(rk.y), bf_hi(rk.y)}; \
        if (MODE == 0) { f32x4 z = *(const LAS f32x4*)(Lf + O_BIAS + dq); \
            const float gl[16] = {bf_lo(rg0.x), bf_hi(rg0.x), bf_lo(rg0.y), bf_hi(rg0.y), bf_lo(rg0.z), bf_hi(rg0.z), bf_lo(rg0.w), bf_hi(rg0.w), \
                                  bf_lo(rg1.x), bf_hi(rg1.x), bf_lo(rg1.y), bf_hi(rg1.y), bf_lo(rg1.z), bf_hi(rg1.z), bf_lo(rg1.w), bf_hi(rg1.w)}; \
            _Pragma("unroll") for (int r_ = 0; r_ < 16; ++r_) { const f32x4 wv = *(const LAS f32x4*)(Lf + O_W2 + r_ * 128 + dq); z = z + wv * gl[r_]; } \
            _Pragma("unroll") for (int i_ = 0; i_ < 4; ++i_) { q4[i_] = xq[i_] * 0.08838834764831845f; k4[i_] = xk[i_]; e4[i_] = __expf(logsigmoidf_(z[i_]) * 0.0625f); } } \
        else { _Pragma("unroll") for (int i_ = 0; i_ < 4; ++i_) { const float fg = lb[i_] + (1.f - lb[i_]) * sigmoidf_(xk[i_]); q4[i_] = siluf_(xq[i_]); k4[i_] = 1.f - fg; e4[i_] = fg; } } \
        *(LAS f32x4*)(B_ + O_EG + tl * 128 + dq) = e4; *(LAS f32x4*)(B_ + O_K + tl * 128 + dq) = k4; *(LAS f32x4*)(B_ + O_Q + tl * 128 + dq) = q4; \
        if (tid < 256) { f32x4 v4 = {bf_lo(rv.x), bf_hi(rv.x), bf_lo(rv.y), bf_hi(rv.y)}; *(LAS f32x4*)(B_ + O_V + tlv * 64 + c4) = v4; } } while (0)
    __syncthreads();
    GLA_LOAD(0); GLA_XFORM(0);
    __syncthreads();
    float S[8][2];
#pragma unroll
    for (int i = 0; i < 8; ++i) { S[i][0] = 0.f; S[i][1] = 0.f; }
    const int j = lane & 15, col = w * 8 + (lane >> 4) * 2;
    for (int c = 0; c < NCHUNK; ++c) {
        if (c + 1 < NCHUNK) GLA_LOAD(c + 1);
        const LAS float* B_ = Lf + (c & 1) * BUFSZ;
#pragma unroll 4
        for (int t = 0; t < TC; ++t) {
            const f32x4 e0 = *(const LAS f32x4*)(B_ + O_EG + t * 128 + 4 * j), e1 = *(const LAS f32x4*)(B_ + O_EG + t * 128 + 64 + 4 * j);
            const f32x4 k0 = *(const LAS f32x4*)(B_ + O_K + t * 128 + 4 * j), k1 = *(const LAS f32x4*)(B_ + O_K + t * 128 + 64 + 4 * j);
            const f32x4 q0 = *(const LAS f32x4*)(B_ + O_Q + t * 128 + 4 * j), q1 = *(const LAS f32x4*)(B_ + O_Q + t * 128 + 64 + 4 * j);
            const f32x2 v2 = *(const LAS f32x2*)(B_ + O_V + t * 64 + col);
            float p0 = 0.f, p1 = 0.f;
#pragma unroll
            for (int i = 0; i < 4; ++i) {
                S[i][0] = S[i][0] * e0[i] + k0[i] * v2[0]; S[i][1] = S[i][1] * e0[i] + k0[i] * v2[1];
                S[4 + i][0] = S[4 + i][0] * e1[i] + k1[i] * v2[0]; S[4 + i][1] = S[4 + i][1] * e1[i] + k1[i] * v2[1];
                p0 += q0[i] * S[i][0] + q1[i] * S[4 + i][0]; p1 += q0[i] * S[i][1] + q1[i] * S[4 + i][1]; }
            p0 = row_sum16(p0); p1 = row_sum16(p1);
            if (j == 0) { f32x2 o2 = {p0, p1}; *(LAS f32x2*)(Lf + O_OUT + t * 64 + col) = o2; }
        }
        if (c + 1 < NCHUNK) GLA_XFORM((c + 1) & 1);
        __syncthreads();
        if (tid < 256) *(GAS f32x4*)(O + (size_t)(c * TC + tlv) * D + c4) = *(const LAS f32x4*)(Lf + O_OUT + tlv * 64 + c4);
        __syncthreads();
    }
#undef GLA_LOAD
#undef GLA_XFORM
}

__device__ __forceinline__ void scan_gdn_unit(const Args& A, Frame& F, int unit) {
    const int tid = F.tid, lane = F.lane, w = F.wave;
    const int b = unit >> 4, h = (unit >> 1) & 7, s = unit & 1;
    const int qcol = EC_BQ + h * 128, kcol = EC_BK + h * 128, vcol = EC_BV + h * 128 + s * 64, ocol = 1024 + h * 128 + s * 64;
    const bf16* P = (const bf16*)(A.ws + WS_PROJ) + (size_t)b * SEQ * PROJ_LD;
    float* O = (float*)(A.ws + WS_O) + (size_t)b * SEQ * D + ocol;
    LAS float* Lf = (LAS float*)(F.lds + RING_OFF);
    constexpr int BUFSZ = 5184, O_K = 0, O_Q = 2048, O_V = 4096, O_SC = 5120, O_OUT = 2 * BUFSZ, O_CW = O_OUT + 1024;
    const int tl = tid >> 5, dq = (tid & 31) * 4, tlv = tid >> 4, c4 = (tid & 15) * 4;
    { const float* cw = A.in[I_GDN_CONV];
      for (int i = tid; i < 4 * 320; i += NTHREADS) { const int jt = i / 320, x = i % 320;
          const int ch = x < 128 ? (h * 128 + x) : x < 256 ? (1024 + h * 128 + (x - 128)) : (2048 + h * 128 + s * 64 + (x - 256));
          Lf[O_CW + i] = cw[jt * 3072 + ch]; } }
    const float neg_ea = -__expf(A.in[I_GDN_ALOG][h]), dtb = A.in[I_GDN_DTB][h];
    u32x2 rq[4], rk[4], rv[4]; unsigned short rba = 0, rbb = 0;
#pragma unroll
    for (int i = 0; i < 4; ++i) rv[i] = (u32x2){0u, 0u};
#define GDN_LOAD(c) do { const int t_ = (c) * TC + tl; \
        _Pragma("unroll") for (int jt = 0; jt < 4; ++jt) { const int tt = t_ - 3 + jt; \
            if (tt >= 0) { const bf16* pr = P + (size_t)tt * PROJ_LD; rq[jt] = *(const GAS u32x2*)(pr + qcol + dq); rk[jt] = *(const GAS u32x2*)(pr + kcol + dq); } \
            else { rq[jt] = (u32x2){0u, 0u}; rk[jt] = (u32x2){0u, 0u}; } } \
        { const bf16* pr = P + (size_t)t_ * PROJ_LD; rba = pr[EC_BA + h]; rbb = pr[EC_BB + h]; } \
        if (tid < 256) { const int tv = (c) * TC + tlv; \
            _Pragma("unroll") for (int jt = 0; jt < 4; ++jt) { const int tt = tv - 3 + jt; \
                if (tt >= 0) rv[jt] = *(const GAS u32x2*)(P + (size_t)tt * PROJ_LD + vcol + c4); else rv[jt] = (u32x2){0u, 0u}; } } } while (0)
#define GDN_XFORM(bufi) do { LAS float* B_ = Lf + (bufi) * BUFSZ; f32x4 q4 = {0.f, 0.f, 0.f, 0.f}, k4 = {0.f, 0.f, 0.f, 0.f}; \
        _Pragma("unroll") for (int jt = 0; jt < 4; ++jt) { const f32x4 wq = *(const LAS f32x4*)(Lf + O_CW + jt * 320 + dq), wk = *(const LAS f32x4*)(Lf + O_CW + jt * 320 + 128 + dq); \
            q4[0] += wq[0] * bf_lo(rq[jt].x); q4[1] += wq[1] * bf_hi(rq[jt].x); q4[2] += wq[2] * bf_lo(rq[jt].y); q4[3] += wq[3] * bf_hi(rq[jt].y); \
            k4[0] += wk[0] * bf_lo(rk[jt].x); k4[1] += wk[1] * bf_hi(rk[jt].x); k4[2] += wk[2] * bf_lo(rk[jt].y); k4[3] += wk[3] * bf_hi(rk[jt].y); } \
        float sq = 0.f, sk = 0.f, sqk = 0.f; \
        _Pragma("unroll") for (int i_ = 0; i_ < 4; ++i_) { q4[i_] = siluf_(q4[i_]); k4[i_] = siluf_(k4[i_]); sq += q4[i_] * q4[i_]; sk += k4[i_] * k4[i_]; sqk += q4[i_] * k4[i_]; } \
        sq = half_sum32(sq); sk = half_sum32(sk); sqk = half_sum32(sqk); \
        const float rq_ = __builtin_amdgcn_rsqf(sq + EPS) * 0.08838834764831845f, rk_ = __builtin_amdgcn_rsqf(sk + EPS); \
        q4 = q4 * rq_; k4 = k4 * rk_; \
        *(LAS f32x4*)(B_ + O_K + tl * 128 + dq) = k4; *(LAS f32x4*)(B_ + O_Q + tl * 128 + dq) = q4; \
        if ((tid & 31) == 0) { const float ba = __uint_as_float((unsigned)rba << 16), bb = __uint_as_float((unsigned)rbb << 16); \
            f32x4 sc; sc[0] = __expf(neg_ea * softplusf_(ba + dtb)); sc[1] = sigmoidf_(bb); sc[2] = sqk * rq_ * rk_; sc[3] = 0.f; *(LAS f32x4*)(B_ + O_SC + tl * 4) = sc; } \
        if (tid < 256) { f32x4 v4 = {0.f, 0.f, 0.f, 0.f}; \
            _Pragma("unroll") for (int jt = 0; jt < 4; ++jt) { const f32x4 wv = *(const LAS f32x4*)(Lf + O_CW + jt * 320 + 256 + c4); \
                v4[0] += wv[0] * bf_lo(rv[jt].x); v4[1] += wv[1] * bf_hi(rv[jt].x); v4[2] += wv[2] * bf_lo(rv[jt].y); v4[3] += wv[3] * bf_hi(rv[jt].y); } \
            _Pragma("unroll") for (int i_ = 0; i_ < 4; ++i_) v4[i_] = siluf_(v4[i_]); \
            *(LAS f32x4*)(B_ + O_V + tlv * 64 + c4) = v4; } } while (0)
    __syncthreads();
    GDN_LOAD(0); GDN_XFORM(0);
    __syncthreads();
    float S[8][2];
#pragma unroll
    for (int i = 0; i < 8; ++i) { S[i][0] = 0.f; S[i][1] = 0.f; }
    const int j = lane & 15, col = w * 8 + (lane >> 4) * 2;
    for (int c = 0; c < NCHUNK; ++c) {
        if (c + 1 < NCHUNK) GDN_LOAD(c + 1);
        const LAS float* B_ = Lf + (c & 1) * BUFSZ;
#pragma unroll 4
        for (int t = 0; t < TC; ++t) {
            const f32x4 k0 = *(const LAS f32x4*)(B_ + O_K + t * 128 + 4 * j), k1 = *(const LAS f32x4*)(B_ + O_K + t * 128 + 64 + 4 * j);
            const f32x4 q0 = *(const LAS f32x4*)(B_ + O_Q + t * 128 + 4 * j), q1 = *(const LAS f32x4*)(B_ + O_Q + t * 128 + 64 + 4 * j);
            const f32x2 v2 = *(const LAS f32x2*)(B_ + O_V + t * 64 + col);
            const f32x4 sc = *(const LAS f32x4*)(B_ + O_SC + t * 4);
            float d10 = 0.f, d11 = 0.f, d20 = 0.f, d21 = 0.f;
#pragma unroll
            for (int i = 0; i < 4; ++i) {
                d10 += k0[i] * S[i][0] + k1[i] * S[4 + i][0]; d11 += k0[i] * S[i][1] + k1[i] * S[4 + i][1];
                d20 += q0[i] * S[i][0] + q1[i] * S[4 + i][0]; d21 += q0[i] * S[i][1] + q1[i] * S[4 + i][1]; }
            d10 = row_sum16(d10); d11 = row_sum16(d11); d20 = row_sum16(d20); d21 = row_sum16(d21);
            const float a = sc[0], beta = sc[1], qk = sc[2];
            const float dl0 = beta * (v2[0] - a * d10), dl1 = beta * (v2[1] - a * d11);
            const float o0 = a * d20 + qk * dl0, o1 = a * d21 + qk * dl1;
#pragma unroll
            for (int i = 0; i < 4; ++i) {
                S[i][0] = a * S[i][0] + k0[i] * dl0; S[i][1] = a * S[i][1] + k0[i] * dl1;
                S[4 + i][0] = a * S[4 + i][0] + k1[i] * dl0; S[4 + i][1] = a * S[4 + i][1] + k1[i] * dl1; }
            if (j == 0) { f32x2 o2 = {o0, o1}; *(LAS f32x2*)(Lf + O_OUT + t * 64 + col) = o2; }
        }
        if (c + 1 < NCHUNK) GDN_XFORM((c + 1) & 1);
        __syncthreads();
        if (tid < 256) *(GAS f32x4*)(O + (size_t)(c * TC + tlv) * D + c4) = *(const LAS f32x4*)(Lf + O_OUT + tlv * 64 + c4);
        __syncthreads();
    }
#undef GDN_LOAD
#undef GDN_XFORM
}

__device__ __forceinline__ void scan_rwkv_unit(const Args& A, Frame& F, int unit) {
    const int tid = F.tid, lane = F.lane, w = F.wave;
    const int b = unit >> 4, h = unit & 15;
    const bf16* P = (const bf16*)(A.ws + WS_PROJ) + (size_t)b * SEQ * PROJ_LD + OC_RW;
    const bf16* LO = (const bf16*)(A.ws + WS_LO) + (size_t)b * SEQ * LORA_N;
    bf16* Y = (bf16*)(A.ws + WS_ACTA) + (size_t)b * SEQ * D + 1024 + h * 64;
    LAS float* Lf = (LAS float*)(F.lds + RING_OFF);
    constexpr int BUFSZ = 6208, O_KK = 0, O_WR = 1024, O_W = 2048, O_NKA = 3072, O_K = 4096, O_V = 5120, O_SC = 6144, O_OUT = 2 * BUFSZ;
    const int tl = tid >> 5, d2 = (tid & 31) * 2, hd = h * 64 + d2;
    float mu_r[2], mu_k[2], mu_v[2], w0[2], a0[2], k_k[2], k_a[2], r_k[2], lnw[2], lnb[2];
#pragma unroll
    for (int i = 0; i < 2; ++i) { mu_r[i] = A.in[I_MU][RW_R + hd + i]; mu_k[i] = A.in[I_MU][RW_K + hd + i]; mu_v[i] = A.in[I_MU][RW_V + hd + i];
        w0[i] = A.in[I_W0][hd + i]; a0[i] = A.in[I_A0][hd + i]; k_k[i] = A.in[I_KK][hd + i]; k_a[i] = A.in[I_KA][hd + i]; r_k[i] = A.in[I_RK][hd + i];
        lnw[i] = A.in[I_LNW][hd + i]; lnb[i] = A.in[I_LNB][hd + i]; }
    unsigned rr[2], rk[2], rv[2], rlw, rla, rg_cur = 0u, rg_nxt = 0u;
#define RW_LOAD(c) do { const int t_ = (c) * TC + tl; const bf16* pr = P + (size_t)t_ * PROJ_LD; \
        rr[0] = *(const GAS unsigned*)(pr + RW_R + hd); rk[0] = *(const GAS unsigned*)(pr + RW_K + hd); rv[0] = *(const GAS unsigned*)(pr + RW_V + hd); \
        if (t_ > 0) { rr[1] = *(const GAS unsigned*)(pr - PROJ_LD + RW_R + hd); rk[1] = *(const GAS unsigned*)(pr - PROJ_LD + RW_K + hd); rv[1] = *(const GAS unsigned*)(pr - PROJ_LD + RW_V + hd); } \
        else { rr[1] = 0u; rk[1] = 0u; rv[1] = 0u; } \
        const bf16* lr = LO + (size_t)t_ * LORA_N; rlw = *(const GAS unsigned*)(lr + hd); rla = *(const GAS unsigned*)(lr + 1024 + hd); rg_nxt = *(const GAS unsigned*)(lr + 2048 + hd); } while (0)
#define RW_XFORM(bufi) do { LAS float* B_ = Lf + (bufi) * BUFSZ; f32x2 kk2, wr2, w2_, nka2, k2, v2_; float skk = 0.f, sc1 = 0.f, sc2 = 0.f, sbs = 0.f; float aa[2], rrv[2]; \
        _Pragma("unroll") for (int i_ = 0; i_ < 2; ++i_) { \
            const float r0 = i_ ? bf_hi(rr[0]) : bf_lo(rr[0]), r1 = i_ ? bf_hi(rr[1]) : bf_lo(rr[1]); \
            const float k0_ = i_ ? bf_hi(rk[0]) : bf_lo(rk[0]), k1_ = i_ ? bf_hi(rk[1]) : bf_lo(rk[1]); \
            const float v0_ = i_ ? bf_hi(rv[0]) : bf_lo(rv[0]), v1_ = i_ ? bf_hi(rv[1]) : bf_lo(rv[1]); \
            const float lw = i_ ? bf_hi(rlw) : bf_lo(rlw), la = i_ ? bf_hi(rla) : bf_lo(rla); \
            const float r_ = r0 + (r1 - r0) * mu_r[i_], kx = k0_ + (k1_ - k0_) * mu_k[i_], vx = v0_ + (v1_ - v0_) * mu_v[i_]; \
            const float wd = __expf(-0.6065306597126334f * sigmoidf_(w0[i_] + lw)); const float a_ = sigmoidf_(a0[i_] + la); \
            const float kk0 = kx * k_k[i_]; const float km = kx * (1.f + (a_ - 1.f) * k_a[i_]); \
            kk2[i_] = kk0; skk += kk0 * kk0; aa[i_] = a_; rrv[i_] = r_; wr2[i_] = wd * r_; w2_[i_] = wd; k2[i_] = km; v2_[i_] = vx; sc2 += km * r_; sbs += r_ * km * r_k[i_]; } \
        skk = half_sum32(skk); const float rkk = __builtin_amdgcn_rsqf(skk + EPS); \
        _Pragma("unroll") for (int i_ = 0; i_ < 2; ++i_) { kk2[i_] *= rkk; nka2[i_] = -(kk2[i_] * aa[i_]); sc1 += kk2[i_] * aa[i_] * rrv[i_]; } \
        sc1 = half_sum32(sc1); sc2 = half_sum32(sc2); sbs = half_sum32(sbs); \
        *(LAS f32x2*)(B_ + O_KK + tl * 64 + d2) = kk2; *(LAS f32x2*)(B_ + O_WR + tl * 64 + d2) = wr2; *(LAS f32x2*)(B_ + O_W + tl * 64 + d2) = w2_; \
        *(LAS f32x2*)(B_ + O_NKA + tl * 64 + d2) = nka2; *(LAS f32x2*)(B_ + O_K + tl * 64 + d2) = k2; *(LAS f32x2*)(B_ + O_V + tl * 64 + d2) = v2_; \
        if ((tid & 31) == 0) { f32x4 sc; sc[0] = sc1; sc[1] = sc2; sc[2] = sbs; sc[3] = 0.f; *(LAS f32x4*)(B_ + O_SC + tl * 4) = sc; } } while (0)
    RW_LOAD(0); RW_XFORM(0); rg_cur = rg_nxt;
    __syncthreads();
    float S[4][2];
#pragma unroll
    for (int i = 0; i < 4; ++i) { S[i][0] = 0.f; S[i][1] = 0.f; }
    const int j = lane & 15, col = w * 8 + (lane >> 4) * 2;
    for (int c = 0; c < NCHUNK; ++c) {
        if (c + 1 < NCHUNK) RW_LOAD(c + 1);
        const LAS float* B_ = Lf + (c & 1) * BUFSZ;
#pragma unroll 4
        for (int t = 0; t < TC; ++t) {
            const f32x4 kk = *(const LAS f32x4*)(B_ + O_KK + t * 64 + 4 * j), wr = *(const LAS f32x4*)(B_ + O_WR + t * 64 + 4 * j), ww = *(const LAS f32x4*)(B_ + O_W + t * 64 + 4 * j);
            const f32x4 nka = *(const LAS f32x4*)(B_ + O_NKA + t * 64 + 4 * j), kv = *(const LAS f32x4*)(B_ + O_K + t * 64 + 4 * j);
            const f32x2 v2 = *(const LAS f32x2*)(B_ + O_V + t * 64 + col);
            const f32x4 sc = *(const LAS f32x4*)(B_ + O_SC + t * 4);
            float d10 = 0.f, d11 = 0.f, d20 = 0.f, d21 = 0.f;
#pragma unroll
            for (int i = 0; i < 4; ++i) { d10 += kk[i] * S[i][0]; d11 += kk[i] * S[i][1]; d20 += wr[i] * S[i][0]; d21 += wr[i] * S[i][1]; }
            d10 = row_sum16(d10); d11 = row_sum16(d11); d20 = row_sum16(d20); d21 = row_sum16(d21);
            const float o0 = d20 - d10 * sc[0] + v2[0] * sc[1], o1 = d21 - d11 * sc[0] + v2[1] * sc[1];
#pragma unroll
            for (int i = 0; i < 4; ++i) { S[i][0] = S[i][0] * ww[i] + d10 * nka[i] + v2[0] * kv[i]; S[i][1] = S[i][1] * ww[i] + d11 * nka[i] + v2[1] * kv[i]; }
            if (j == 0) { f32x2 o2 = {o0, o1}; *(LAS f32x2*)(Lf + O_OUT + t * 64 + col) = o2; }
        }
        if (c + 1 < NCHUNK) RW_XFORM((c + 1) & 1);
        __syncthreads();
        {
            const f32x2 o2 = *(const LAS f32x2*)(Lf + O_OUT + tl * 64 + d2); const f32x2 vv = *(const LAS f32x2*)(B_ + O_V + tl * 64 + d2); const float bs = B_[O_SC + tl * 4 + 2];
            const float mean = half_sum32(o2[0] + o2[1]) * (1.0f / 64.0f); const float e0 = o2[0] - mean, e1 = o2[1] - mean;
            const float var = half_sum32(e0 * e0 + e1 * e1) * (1.0f / 64.0f); const float rs = __builtin_amdgcn_rsqf(var + 64e-5f);
            const float y0 = (e0 * rs * lnw[0] + lnb[0] + bs * vv[0]) * bf_lo(rg_cur), y1 = (e1 * rs * lnw[1] + lnb[1] + bs * vv[1]) * bf_hi(rg_cur);
            *(GAS unsigned*)(Y + (size_t)(c * TC + tl) * D + d2) = pk2(y0, y1);
        }
        rg_cur = rg_nxt;
        __syncthreads();
    }
#undef RW_LOAD
#undef RW_XFORM
}

template <int LAYER>
__device__ __forceinline__ void post_rows(const Args& A, Frame& F) {
    const int gw = F.vcu * NWAVES + F.wave, NGW = F.G * NWAVES, lane = F.lane;
    const float* O = (const float*)(A.ws + WS_O); const bf16* P = (const bf16*)(A.ws + WS_PROJ); bf16* Y = (bf16*)(A.ws + WS_ACTA);
    for (int m = gw; m < T; m += NGW) {
        const GAS f32x4* orow = (const GAS f32x4*)(O + (size_t)m * D) + lane; const bf16* prow = P + (size_t)m * PROJ_LD;
        constexpr int NJ = LAYER == 0 ? 8 : 4;
#pragma unroll
        for (int jj = 0; jj < NJ; ++jj) {
            const f32x4 v = orow[64 * jj]; float ss = (v[0] * v[0] + v[1] * v[1]) + (v[2] * v[2] + v[3] * v[3]);
            const bool wide = (LAYER == 0 && jj < 4);
            const float ms = wide ? wave_sum(ss) * (1.0f / 256.0f) : half_sum32(ss) * (1.0f / 128.0f);
            const float r = __builtin_amdgcn_rsqf(ms + EPS);
            const int cih = wide ? 4 * lane : 4 * (lane & 31);
            const float* gsrc = LAYER == 0 ? (wide ? A.in[I_GLA_NORM] : A.in[I_GDN_NORM]) : A.in[I_HG_NORM];
            const f32x4 g = *(const GAS f32x4*)(gsrc + cih);
            const int zcol = LAYER == 0 ? (wide ? EC_GZ + jj * 256 + 4 * lane : EC_BZ + (jj - 4) * 256 + 4 * lane) : OC_HG + jj * 256 + 4 * lane;
            const u32x2 zw = *(const GAS u32x2*)(prow + zcol);
            const float y0 = v[0] * r * g[0] * siluf_(bf_lo(zw.x)), y1 = v[1] * r * g[1] * siluf_(bf_hi(zw.x)), y2 = v[2] * r * g[2] * siluf_(bf_lo(zw.y)), y3 = v[3] * r * g[3] * siluf_(bf_hi(zw.y));
            u32x2 o; o.x = pk2(y0, y1); o.y = pk2(y2, y3);
            *(GAS u32x2*)(Y + (size_t)m * D + 256 * jj + 4 * lane) = o;
        }
    }
}
__device__ __forceinline__ void lora_prep_rows(const Args& A, Frame& F) {
    const int gw = F.vcu * NWAVES + F.wave, NGW = F.G * NWAVES, lane = F.lane;
    const bf16* P = (const bf16*)(A.ws + WS_PROJ); bf16* LA = (bf16*)(A.ws + WS_LA); const float* mu = A.in[I_MU];
    for (int m = gw; m < T; m += NGW) { const bool hasprev = (m % SEQ) != 0; const bf16* prow = P + (size_t)m * PROJ_LD + OC_RW + RW_WL;
#pragma unroll
        for (int i = 0; i < 7; ++i) { const int c = lane + 64 * i;
            const float x = __uint_as_float((unsigned)prow[c] << 16), xp = hasprev ? __uint_as_float((unsigned)prow[c - PROJ_LD] << 16) : 0.f;
            const float ts = x + (xp - x) * mu[RW_WL + c];
            const float v = c < 96 ? tanhf(ts) : (c < 192 ? ts : sigmoidf_(ts));
            LA[(size_t)m * LORA_K + c] = (bf16)f2bf(v); }
        LA[(size_t)m * LORA_K + 448 + lane] = (bf16)0; }
}
__device__ __forceinline__ void final_rows(const Args& A, Frame& F, const float oscale) {
    const int gw = F.vcu * NWAVES + F.wave, NGW = F.G * NWAVES, lane = F.lane;
    const float* rowss = (const float*)(A.ws + WS_RSP) + (size_t)RS_FINAL * T * 32; const GAS f32x4* g = (const GAS f32x4*)A.in[I_NFINAL] + lane;
    for (int m = gw; m < T; m += NGW) { const float r = oscale * __builtin_amdgcn_rsqf(wave_sum(lane < 32 ? rowss[(size_t)m * 32 + lane] : 0.f) * (1.0f / D) + EPS); GAS f32x4* row = (GAS f32x4*)(A.out + (size_t)m * D) + lane;
#pragma unroll
        for (int jj = 0; jj < 8; ++jj) { const f32x4 v = row[64 * jj]; row[64 * jj] = v * r * g[64 * jj]; } }
}

__device__ __forceinline__ int med3i(int a, int b, int c) { int r; asm("v_med3_i32 %0, %1, %2, %3" : "=v"(r) : "v"(a), "v"(b), "v"(c)); return r; }
__device__ __forceinline__ int f2sort(float f) { int x = __float_as_int(f); return x ^ ((x >> 31) & 0x7fffffff); }
__device__ __forceinline__ float sort2f(int x) { return __int_as_float(x ^ ((x >> 31) & 0x7fffffff)); }
#define TOPK_INSERT(vals, x) do { _Pragma("unroll") for (int s_ = 15; s_ >= 1; --s_) vals[s_] = med3i((x), vals[s_ - 1], vals[s_]); vals[0] = max(vals[0], (x)); } while (0)
__device__ __forceinline__ float bf_dot2(unsigned a, unsigned b, float c) {
    return c + bf_lo(a) * bf_lo(b) + bf_hi(a) * bf_hi(b);
}
__device__ __forceinline__ void peer_phase(const Args& A, Frame& F, int L, const bool dry) {
    const int gw = F.vcu * NWAVES + F.wave, NGW = F.G * NWAVES, lane = F.lane;
    const bf16* SCR = (const bf16*)(A.ws + WS_SC); const bf16* X = (const bf16*)(A.ws + WS_ACTB); bf16* HG = (bf16*)(A.ws + WS_ACTA);
    const unsigned char* TU = (const unsigned char*)(A.ws + WS_TABU) + (size_t)L * 16384 * D; const unsigned char* TV = (const unsigned char*)(A.ws + WS_TABV) + (size_t)L * 16384 * D;
    const float* rowss = (const float*)(A.ws + WS_RSP) + (size_t)(L == 0 ? RS_FFN0 : RS_FFN1) * T * 32;
    const float* gple = A.in[I_NPLE] + (size_t)L * D;
    float* H = A.out;
    LAS unsigned* LIST = (LAS unsigned*)(F.lds + RING_OFF + F.wave * 16384);
    LAS unsigned* EIDX = LIST + 1024;
    LAS float* ECOEF = (LAS float*)(EIDX + 512);
    LAS unsigned* SIDX = EIDX + 1024;
    LAS float* SCOEF = (LAS float*)(EIDX + 1536);
    for (int tb = gw; tb < T / 4; tb += NGW) {
        const int t0 = tb * 4;
        {
            const bf16* sp = SCR + (size_t)(t0 + (lane >> 4)) * D + (lane & 15) * 128;
            int vals[16];
#pragma unroll
            for (int s = 0; s < 16; ++s) vals[s] = (int)0x80000000;
#pragma unroll 2
            for (int c = 0; c < 16; ++c) { const v4u wv = *(const GAS v4u*)(sp + c * 8); const unsigned ww[4] = {wv.x, wv.y, wv.z, wv.w};
#pragma unroll
                for (int e = 0; e < 8; ++e) { const unsigned bits = (e & 1) ? (ww[e >> 1] & 0xffff0000u) : (ww[e >> 1] << 16);
                    int x = (int)bits; x ^= (x >> 31) & 0x7fffffff; x = (x & ~0x7f) | (127 - (c * 8 + e));
                    TOPK_INSERT(vals, x); } }
#pragma unroll
            for (int q = 0; q < 4; ++q) { v4u o; o.x = (unsigned)vals[4 * q]; o.y = (unsigned)vals[4 * q + 1]; o.z = (unsigned)vals[4 * q + 2]; o.w = (unsigned)vals[4 * q + 3]; *(LAS v4u*)(LIST + lane * 16 + 4 * q) = o; }
        }
        LDS_WAIT(); asm volatile("" ::: "memory");
        if (lane < 32) {
            const LAS unsigned* la = LIST + ((lane >> 3) * 16 + (lane & 7) * 2) * 16; const LAS unsigned* lb2 = la + 16;
            float av[16], bv[16];
#pragma unroll
            for (int q = 0; q < 4; ++q) { const v4u a4 = *(const LAS v4u*)(la + 4 * q), b4 = *(const LAS v4u*)(lb2 + 4 * q); const unsigned aw[4] = {a4.x, a4.y, a4.z, a4.w}, bw[4] = {b4.x, b4.y, b4.z, b4.w};
#pragma unroll
                for (int e = 0; e < 4; ++e) { av[4 * q + e] = __uint_as_float(__float_as_uint(sort2f((int)(aw[e] & ~0x7fu))) & 0xffff0000u); bv[4 * q + e] = __uint_as_float(__float_as_uint(sort2f((int)(bw[e] & ~0x7fu))) & 0xffff0000u); } }
            int best[16];
#pragma unroll
            for (int s = 0; s < 16; ++s) best[s] = (int)0x80000000;
#pragma unroll
            for (int i = 0; i < 16; ++i)
#pragma unroll
                for (int jx = 0; jx < 16; ++jx) if ((i + 1) * (jx + 1) <= 16) { int x = f2sort(av[i] + bv[jx]); x = (x & ~0xff) | (255 - (i * 16 + jx)); TOPK_INSERT(best, x); }
            float sv[16]; unsigned ex[16];
#pragma unroll
            for (int s = 0; s < 16; ++s) { const int cand = 255 - (best[s] & 0xff); const unsigned ka = la[cand >> 4], kb = lb2[cand & 15];
                ex[s] = (127u - (ka & 0x7fu)) * 128u + (127u - (kb & 0x7fu));
                sv[s] = __uint_as_float(__float_as_uint(sort2f((int)(ka & ~0x7fu))) & 0xffff0000u) + __uint_as_float(__float_as_uint(sort2f((int)(kb & ~0x7fu))) & 0xffff0000u); }
            float mx = sv[0];
#pragma unroll
            for (int s = 1; s < 16; ++s) mx = fmaxf(mx, sv[s]);
            float den = 0.f;
#pragma unroll
            for (int s = 0; s < 16; ++s) { sv[s] = __expf(sv[s] - mx); den += sv[s]; }
            const float inv = 1.0f / den; const int base = (lane >> 3) * 128 + (lane & 7) * 16;
#pragma unroll
            for (int s = 0; s < 16; ++s) { EIDX[base + s] = ex[s]; ECOEF[base + s] = sv[s] * inv; }
        }
        LDS_WAIT(); asm volatile("" ::: "memory");
        for (int tok = 0; tok < 4; ++tok) {
            const unsigned k0 = (EIDX[tok * 128 + lane] << 7) | (unsigned)lane, k1 = (EIDX[tok * 128 + 64 + lane] << 7) | (unsigned)(64 + lane);
            const float g0 = ECOEF[tok * 128 + lane], g1 = ECOEF[tok * 128 + 64 + lane];
            int r0 = 0, r1 = 0;
#pragma unroll 4
            for (int jx = 0; jx < 32; ++jx) { const v4u kq = *(const LAS v4u*)(EIDX + tok * 128 + 4 * jx); const unsigned kk[4] = {kq.x, kq.y, kq.z, kq.w};
#pragma unroll
                for (int e = 0; e < 4; ++e) { const unsigned kj = (kk[e] << 7) | (unsigned)(4 * jx + e); r0 += (kj < k0) ? 1 : 0; r1 += (kj < k1) ? 1 : 0; } }
            SIDX[tok * 128 + r0] = k0 >> 7; SCOEF[tok * 128 + r0] = g0; SIDX[tok * 128 + r1] = k1 >> 7; SCOEF[tok * 128 + r1] = g1;
        }
        LDS_WAIT(); asm volatile("" ::: "memory");
        for (int tok = 0; tok < 4; ++tok) {
            const int t = t0 + tok;
            const float rs = __builtin_amdgcn_rsqf(wave_sum(lane < 32 ? rowss[(size_t)t * 32 + lane] : 0.f) * (1.0f / D) + EPS) * (1.0f / 512.0f);
            float xf[32];
#pragma unroll
            for (int jj = 0; jj < 2; ++jj) { const v4u x0 = *(const GAS v4u*)(X + (size_t)t * D + 1024 * jj + 16 * lane), x1 = *(const GAS v4u*)(X + (size_t)t * D + 1024 * jj + 16 * lane + 8);
                const unsigned xw[8] = {x0.x, x0.y, x0.z, x0.w, x1.x, x1.y, x1.z, x1.w};
#pragma unroll
                for (int e = 0; e < 8; ++e) { xf[jj * 16 + 2 * e] = bf_lo(xw[e]); xf[jj * 16 + 2 * e + 1] = bf_hi(xw[e]); } }
            const LAS unsigned* sidx = SIDX + tok * 128; LAS float* scoef = SCOEF + tok * 128;
#define PEER_LOADG(dst, TAB, kbase) do { _Pragma("unroll") for (int q_ = 0; q_ < 4; ++q_) { const unsigned e_ = __builtin_amdgcn_readfirstlane(sidx[(kbase) + q_]); const unsigned char* p_ = (TAB) + (size_t)e_ * D + 16 * lane; \
            dst[q_][0] = *(const GAS v4u*)(p_); dst[q_][1] = *(const GAS v4u*)(p_ + 1024); } } while (0)
#define PEER_UCOMP(src, kbase) do { float a_[4]; \
            _Pragma("unroll") for (int q_ = 0; q_ < 4; ++q_) { float acc0 = 0.f, acc1 = 0.f; \
                _Pragma("unroll") for (int jj_ = 0; jj_ < 2; ++jj_) { const unsigned ww_[4] = {src[q_][jj_].x, src[q_][jj_].y, src[q_][jj_].z, src[q_][jj_].w}; \
                    _Pragma("unroll") for (int e_ = 0; e_ < 4; ++e_) { const f32x2 lo_ = __builtin_amdgcn_cvt_pk_f32_fp8((int)ww_[e_], false), hi_ = __builtin_amdgcn_cvt_pk_f32_fp8((int)ww_[e_], true); \
                        acc0 += xf[jj_ * 16 + 4 * e_] * lo_[0]; acc1 += xf[jj_ * 16 + 4 * e_ + 1] * lo_[1]; acc0 += xf[jj_ * 16 + 4 * e_ + 2] * hi_[0]; acc1 += xf[jj_ * 16 + 4 * e_ + 3] * hi_[1]; } } \
                a_[q_] = acc0 + acc1; } \
              \
            { const bool b0_ = lane & 1, b1_ = lane & 2; \
              float s0_ = b0_ ? a_[1] : a_[0], o0_ = b0_ ? a_[0] : a_[1], s1_ = b0_ ? a_[3] : a_[2], o1_ = b0_ ? a_[2] : a_[3]; \
              s0_ += __shfl_xor(o0_, 1); s1_ += __shfl_xor(o1_, 1); \
              float s_ = b1_ ? s1_ : s0_, o_ = b1_ ? s0_ : s1_; s_ += __shfl_xor(o_, 2); \
              s_ += __shfl_xor(s_, 4); s_ += __shfl_xor(s_, 8); s_ += __shfl_xor(s_, 16); s_ += __shfl_xor(s_, 32); \
              const float d_ = s_ * rs; const float act_ = 0.5f * d_ * (1.0f + erff(d_ * 0.7071067811865476f)); \
              if (lane < 4) scoef[(kbase) + lane] *= act_ * (1.0f / 16.0f); } } while (0)
            {
                v4u ua[4][2], ub[4][2];
                PEER_LOADG(ua, TU, 0);
#pragma unroll 1
                for (int k = 0; k < 128; k += 8) {
                    PEER_LOADG(ub, TU, k + 4);
                    PEER_UCOMP(ua, k);
                    if (k + 8 < 128) PEER_LOADG(ua, TU, k + 8);
                    PEER_UCOMP(ub, k + 4);
                }
            }
            LDS_WAIT(); asm volatile("" ::: "memory");
            float out[32];
#pragma unroll
            for (int i = 0; i < 32; ++i) out[i] = 0.f;
#define PEER_VCOMP(src, kbase) do { const f32x4 cf_ = *(const LAS f32x4*)(scoef + (kbase)); \
            _Pragma("unroll") for (int q_ = 0; q_ < 4; ++q_) \
                _Pragma("unroll") for (int jj_ = 0; jj_ < 2; ++jj_) { const unsigned ww_[4] = {src[q_][jj_].x, src[q_][jj_].y, src[q_][jj_].z, src[q_][jj_].w}; \
                    _Pragma("unroll") for (int e_ = 0; e_ < 4; ++e_) { const f32x2 lo_ = __builtin_amdgcn_cvt_pk_f32_fp8((int)ww_[e_], false), hi_ = __builtin_amdgcn_cvt_pk_f32_fp8((int)ww_[e_], true); \
                        out[jj_ * 16 + 4 * e_] += cf_[q_] * lo_[0]; out[jj_ * 16 + 4 * e_ + 1] += cf_[q_] * lo_[1]; out[jj_ * 16 + 4 * e_ + 2] += cf_[q_] * hi_[0]; out[jj_ * 16 + 4 * e_ + 3] += cf_[q_] * hi_[1]; } } } while (0)
            {
                v4u va[4][2], vb[4][2];
                PEER_LOADG(va, TV, 0);
#pragma unroll 1
                for (int k = 0; k < 128; k += 8) {
                    PEER_LOADG(vb, TV, k + 4);
                    PEER_VCOMP(va, k);
                    if (k + 8 < 128) PEER_LOADG(va, TV, k + 8);
                    PEER_VCOMP(vb, k + 4);
                }
            }
#undef PEER_LOADG
#undef PEER_UCOMP
#undef PEER_VCOMP
            float ss = 0.f;
#pragma unroll
            for (int jj = 0; jj < 2; ++jj) { GAS f32x4* hp = (GAS f32x4*)(H + (size_t)t * D + 1024 * jj + 16 * lane);
#pragma unroll
                for (int q = 0; q < 4; ++q) { f32x4 h0 = hp[q];
#pragma unroll
                    for (int e = 0; e < 4; ++e) { h0[e] += out[jj * 16 + 4 * q + e]; out[jj * 16 + 4 * q + e] = h0[e]; ss += h0[e] * h0[e]; }
                    if (!dry) hp[q] = h0; } }
            const float r3 = __builtin_amdgcn_rsqf(wave_sum(ss) * (1.0f / D) + EPS);
#pragma unroll
            for (int jj = 0; jj < 2; ++jj) { const GAS f32x4* gp = (const GAS f32x4*)(gple + 1024 * jj + 16 * lane);
#pragma unroll
                for (int hh = 0; hh < 2; ++hh) { const f32x4 g0 = gp[2 * hh], g1 = gp[2 * hh + 1]; const float* oo = out + jj * 16 + 8 * hh;
                    v4u o; o.x = pk2(oo[0] * r3 * g0[0], oo[1] * r3 * g0[1]); o.y = pk2(oo[2] * r3 * g0[2], oo[3] * r3 * g0[3]);
                    o.z = pk2(oo[4] * r3 * g1[0], oo[5] * r3 * g1[1]); o.w = pk2(oo[6] * r3 * g1[2], oo[7] * r3 * g1[3]);
                    if (!dry) *(GAS v4u*)(HG + (size_t)t * D + 1024 * jj + 16 * lane + 8 * hh) = o; else asm volatile("" :: "v"(o.x), "v"(o.y), "v"(o.z), "v"(o.w)); } }
        }
        LDS_WAIT(); asm volatile("" ::: "memory");
    }
}

constexpr int N_PHASES = 19;
__global__ void __launch_bounds__(NTHREADS, 2) mega_fwd(Args args) {
    extern __shared__ __attribute__((aligned(16))) unsigned char lds[];
    Frame F;
    F.lds = (LAS unsigned char*)lds;
    F.MISC = (volatile LAS unsigned*)(F.lds + MISC_OFF);
    F.tid = threadIdx.x; F.lane = F.tid & 63; F.wave = __builtin_amdgcn_readfirstlane(F.tid >> 6);
    F.G = gridDim.x; { const int bx = blockIdx.x; F.vcu = (F.G % 8 == 0) ? (bx % 8) * (F.G / 8) + bx / 8 : bx; }
    unsigned char* ws = args.ws;
    F.ctl = (gu32*)(ws + WS_CTL);
    for (int u = F.tid; u < (LDS_BYTES - LDSCTL_OFF) / 4; u += NTHREADS) ((LAS unsigned*)(F.lds + LDSCTL_OFF))[u] = 0u;
    __syncthreads();
    const int lo = args.ph_lo, hi = args.ph_hi;
    XcdBarrier bar; bar.bar = (unsigned*)(F.ctl + CW_BAR); bar.x = 0; bar.st = nullptr;
    if (hi - lo > 1) bar = xcd_barrier_post((unsigned*)(F.ctl + CW_BAR), F.MISC + 8);
#define IN(k) (lo <= (k) && (k) < hi)
#define REPS(k) (1 + ((DUP_MASK >> (k)) & 1))
#if PROBE_MASK
    unsigned long long* const tsb = (unsigned long long*)(ws + WS_CTL + 65536);
#define STAMP(k) do { if (blockIdx.x == 0 && F.tid == 0) __hip_atomic_store(tsb + (k), __builtin_amdgcn_s_memrealtime(), __ATOMIC_RELAXED, __HIP_MEMORY_SCOPE_AGENT); } while (0)
    STAMP(31);
#else
#define STAMP(k) do { } while (0)
#endif
#define SEAM(k) do { if (IN(k) && IN((k) + 1)) { if ((k) == 0) { cg::this_grid().sync(); } else { xcd_barrier(bar); } STAMP(k); } } while (0)
    float* rowss = (float*)(ws + WS_RSP);
    bf16* ACTA = (bf16*)(ws + WS_ACTA); bf16* ACTB = (bf16*)(ws + WS_ACTB); bf16* PROJ = (bf16*)(ws + WS_PROJ); bf16* SCB = (bf16*)(ws + WS_SC); bf16* PP = (bf16*)(ws + WS_PP);
    const int gtid = (F.vcu * NWAVES + F.wave) * 64 + F.lane, gthreads = F.G * NTHREADS;

    if (IN(0)) { p0_prologue(args, F); } SEAM(0);
    if (IN(1)) for (int rep_ = 0; rep_ < REPS(1); ++rep_) {
        { pg8::Gemm g{ACTA, (const bf16*)(ws + WS_WEV_IN), T, EV_NP, D}; pg8::StaticOrder S; S.init(T, EV_NP, F.G, (int)blockIdx.x); EpiBf16S E{PROJ, PROJ_LD, nullptr};
          pg8::gemm_phase<EpiBf16S, pg8::StaticOrder, true, true>(F.lds + RING_OFF, g, S, E); }
        { pg8::Gemm g{(const bf16*)(ws + WS_PBF), (const bf16*)(ws + WS_WPROJ), T, D, 256}; pg8::StaticOrder S; S.init(T, D, F.G, (int)blockIdx.x); EpiBf16S E{PP, D, nullptr};
          pg8::gemm_phase<EpiBf16S, pg8::StaticOrder, true, true>(F.lds + RING_OFF, g, S, E); }
    } SEAM(1);
    if (IN(2)) for (int rep_ = 0; rep_ < REPS(2); ++rep_) { for (int u = F.vcu; u < 256; u += F.G) { if (u < 128) scan_gla_unit<0>(args, F, u); else scan_gdn_unit(args, F, u - 128); __syncthreads(); } } SEAM(2);
    if (IN(3)) for (int rep_ = 0; rep_ < REPS(3); ++rep_) { post_rows<0>(args, F); } SEAM(3);
    if (IN(4)) { pg8::Gemm g{ACTA, (const bf16*)(ws + WS_WEV_OUT), T, D, D}; pg8::StaticOrder S; S.init(T, D, F.G, (int)blockIdx.x);
        EpiResid<false> E{args.in[I_X], args.out, ACTB, args.in[I_NFFN], rowss + (size_t)RS_FFN0 * T * 32, nullptr};
        pg8::gemm_phase<EpiResid<false>, pg8::StaticOrder, true, true>(F.lds + RING_OFF, g, S, E); } SEAM(4);
    if (IN(5)) for (int rep_ = 0; rep_ < REPS(5); ++rep_) { pg8::Gemm g{ACTB, (const bf16*)(ws + WS_WPEER), T, D, D}; pg8::StaticOrder S; S.init(T, D, F.G, (int)blockIdx.x); EpiBf16S E{SCB, D, rowss + (size_t)RS_FFN0 * T * 32};
        pg8::gemm_phase<EpiBf16S, pg8::StaticOrder, true, true>(F.lds + RING_OFF, g, S, E); } SEAM(5);
    if (IN(6)) for (int rep_ = 0; rep_ < REPS(6); ++rep_) { peer_phase(args, F, 0, rep_ != 0); } SEAM(6);
    if (IN(7)) { { pg8::Gemm g{ACTA, (const bf16*)(ws + WS_WGATE), T, D, D}; pg8::StaticOrder S; S.init(T, D, F.G, (int)blockIdx.x);
        EpiResid<true> E{args.out, args.out, ACTB, args.in[I_NMIX] + D, rowss + (size_t)RS_MIX1 * T * 32, PP};
        pg8::gemm_phase<EpiResid<true>, pg8::StaticOrder, true, true>(F.lds + RING_OFF, g, S, E); }
        } SEAM(7);
    if (IN(8)) for (int rep_ = 0; rep_ < REPS(8); ++rep_) {
        { pg8::Gemm g{ACTB, (const bf16*)(ws + WS_WOD_IN), T, OD_NP, D}; pg8::StaticOrder S; S.init(T, OD_NP, F.G, (int)blockIdx.x); EpiBf16S E{PROJ, PROJ_LD, rowss + (size_t)RS_MIX1 * T * 32};
          pg8::gemm_phase<EpiBf16S, pg8::StaticOrder, true, true>(F.lds + RING_OFF, g, S, E); }
        { pg8::Gemm g{(const bf16*)(ws + WS_PBF) + (size_t)T * 256, (const bf16*)(ws + WS_WPROJ) + (size_t)D * 256, T, D, 256}; pg8::StaticOrder S; S.init(T, D, F.G, (int)blockIdx.x); EpiBf16S E{PP, D, nullptr};
          pg8::gemm_phase<EpiBf16S, pg8::StaticOrder, true, true>(F.lds + RING_OFF, g, S, E); }
    } SEAM(8);
    if (IN(9)) for (int rep_ = 0; rep_ < REPS(9); ++rep_) { lora_prep_rows(args, F); } SEAM(9);
    if (IN(10)) for (int rep_ = 0; rep_ < REPS(10); ++rep_) { pg8::Gemm g{(const bf16*)(ws + WS_LA), (const bf16*)(ws + WS_WLORA), T, LORA_N, LORA_K}; pg8::StaticOrder S; S.init(T, LORA_N, F.G, (int)blockIdx.x); EpiBf16S E{(bf16*)(ws + WS_LO), LORA_N, nullptr};
        pg8::gemm_phase<EpiBf16S, pg8::StaticOrder, true, true>(F.lds + RING_OFF, g, S, E); } SEAM(10);
    if (IN(11)) for (int rep_ = 0; rep_ < REPS(11); ++rep_) { for (int u = F.vcu; u < 256; u += F.G) { if (u < 128) scan_gla_unit<1>(args, F, u); else scan_rwkv_unit(args, F, u - 128); __syncthreads(); } } SEAM(11);
    if (IN(12)) for (int rep_ = 0; rep_ < REPS(12); ++rep_) { post_rows<1>(args, F); } SEAM(12);
    if (IN(13)) { pg8::Gemm g{ACTA, (const bf16*)(ws + WS_WOD_OUT), T, D, D}; pg8::StaticOrder S; S.init(T, D, F.G, (int)blockIdx.x);
        EpiResid<false> E{args.out, args.out, ACTB, args.in[I_NFFN] + D, rowss + (size_t)RS_FFN1 * T * 32, nullptr};
        pg8::gemm_phase<EpiResid<false>, pg8::StaticOrder, true, true>(F.lds + RING_OFF, g, S, E); } SEAM(13);
    if (IN(14)) for (int rep_ = 0; rep_ < REPS(14); ++rep_) { pg8::Gemm g{ACTB, (const bf16*)(ws + WS_WPEER) + (size_t)D * D, T, D, D}; pg8::StaticOrder S; S.init(T, D, F.G, (int)blockIdx.x); EpiBf16S E{SCB, D, rowss + (size_t)RS_FFN1 * T * 32};
        pg8::gemm_phase<EpiBf16S, pg8::StaticOrder, true, true>(F.lds + RING_OFF, g, S, E); } SEAM(14);
    if (IN(15)) for (int rep_ = 0; rep_ < REPS(15); ++rep_) { peer_phase(args, F, 1, rep_ != 0); } SEAM(15);
    if (IN(16)) { pg8::Gemm g{ACTA, (const bf16*)(ws + WS_WGATE) + (size_t)D * D, T, D, D}; pg8::StaticOrder S; S.init(T, D, F.G, (int)blockIdx.x);
        EpiResid<true> E{args.out, args.out, nullptr, nullptr, rowss + (size_t)RS_FINAL * T * 32, PP};
        pg8::gemm_phase<EpiResid<true>, pg8::StaticOrder, true, true>(F.lds + RING_OFF, g, S, E); } SEAM(16);
    if (IN(17)) {
        float oscale = 1.0f;
#if PROBE_MASK
        { unsigned long long t_prev = __hip_atomic_load(tsb + 31, __ATOMIC_RELAXED, __HIP_MEMORY_SCOPE_AGENT); const unsigned long long t_begin = t_prev; unsigned long long sel = 0ull;
          for (int k = 0; k <= 16; ++k) { const unsigned long long tk = __hip_atomic_load(tsb + k, __ATOMIC_RELAXED, __HIP_MEMORY_SCOPE_AGENT); if ((PROBE_MASK >> k) & 1) sel += tk - t_prev; t_prev = tk; }
          const float f = (float)(double(sel) / double(t_prev - t_begin)); oscale = 1.0f + sqrtf(0.01f + 0.9f * f); }
#endif
        final_rows(args, F, oscale); }
#undef IN
#undef SEAM
}

extern "C" void kernel_launch(void* const* d_in, const int* in_sizes, int n_in, void* d_out, int out_size, void* d_ws, size_t ws_size, hipStream_t stream) {
    static int grid = 0;
    if (grid == 0) {
        if (n_in != N_IN || out_size != T * D || ws_size < WS_END) { fprintf(stderr, "kernel_launch: unexpected problem: n_in %d out %d ws %zu (need %zu)\n", n_in, out_size, ws_size, (size_t)WS_END); grid = -1; return; }
        int dev = 0, cus = 0, per_cu = 0;
        if (hipGetDevice(&dev) != hipSuccess || hipDeviceGetAttribute(&cus, hipDeviceAttributeMultiprocessorCount, dev) != hipSuccess) { grid = -1; return; }
        if (hipFuncSetAttribute((const void*)mega_fwd, hipFuncAttributeMaxDynamicSharedMemorySize, LDS_BYTES) != hipSuccess) { fprintf(stderr, "kernel_launch: hipFuncSetAttribute failed\n"); grid = -1; return; }
        if (hipOccupancyMaxActiveBlocksPerMultiprocessor(&per_cu, (const void*)mega_fwd, NTHREADS, LDS_BYTES) != hipSuccess || per_cu < 1) { fprintf(stderr, "kernel_launch: occupancy query says %d blocks per CU\n", per_cu); (void)hipGetLastError(); grid = -1; return; }
        grid = cus;
    }
    if (grid < 0) return;
    (void)hipMemsetAsync((char*)d_ws + WS_CTL, 0, CTL_ZERO_BYTES, stream);
    Args a{};
    for (int i = 0; i < N_IN; ++i) a.in[i] = (const float*)d_in[i];
    a.out = (float*)d_out; a.ws = (unsigned char*)d_ws;
#if MK_PER_PHASE
    for (int p = 0; p < N_PHASES - 1; ++p) { a.ph_lo = p; a.ph_hi = p + 1; hipLaunchKernelGGL(mega_fwd, dim3(grid), dim3(NTHREADS), LDS_BYTES, stream, a); }
#else
    a.ph_lo = 0; a.ph_hi = N_PHASES;
    void* kargs[] = {&a};
    hipError_t e = hipLaunchCooperativeKernel((const void*)mega_fwd, dim3(grid), dim3(NTHREADS), kargs, LDS_BYTES, stream);
    if (e != hipSuccess) fprintf(stderr, "kernel_launch: cooperative launch failed: %s (grid %d)\n", hipGetErrorString(e), grid);
#endif
}
```

```cpp
#include <hip/hip_runtime.h>
#include <hip/hip_cooperative_groups.h>
#include <cstdio>
#include <cstdint>
namespace cg = cooperative_groups;

#ifndef PROBE_MASK
#define PROBE_MASK 0
#endif
#ifndef DUP_MASK
#define DUP_MASK 0
#endif
#ifndef UBENCH
#define UBENCH 0
#endif
#ifndef MK_PER_PHASE
#define MK_PER_PHASE 0
#endif

namespace pg8 {
#define PG8_LAS __attribute__((address_space(3)))
typedef unsigned short bf16_t;
typedef short bf16x8 __attribute__((ext_vector_type(8)));
typedef float f32x4 __attribute__((ext_vector_type(4)));
typedef unsigned u32x4 __attribute__((ext_vector_type(4)));
typedef unsigned u32x2 __attribute__((ext_vector_type(2)));
constexpr int BM = 256, BK = 64, HALF = 128, HTB = HALF * BK * 2  , STAGE_BYTES = 8 * HTB, NXCD = 8, WGM = 8;

__host__ __device__ __forceinline__ int lds_byte(int r, int c) { const int st = (r >> 4) * 2 + (c >> 5), rr = r & 15, cc = c & 31, ob = rr * 64 + cc * 2; return st * 1024 + (ob ^ (((ob >> 9) & 1) << 5)); }
__host__ __device__ __forceinline__ void stage_rc(int b, int& R, int& C) { const int st = b / 1024, sb = b % 1024, swz = sb ^ (((sb >> 9) & 1) << 5); R = (st >> 1) * 16 + swz / 64; C = (st & 1) * 32 + (swz % 64) / 2; }
__host__ __device__ __forceinline__ int perm32(int rho) { const int n = rho >> 4, i = rho & 15; return 8 * (i >> 2) + 4 * n + (i & 3); }

struct Unit { int pm, pn; };
struct Gemm { const bf16_t* A; const bf16_t* Bt; int M, N, K; };

struct StaticOrder {
    int nM, nN, nwg, G, c;
    __host__ __device__ void init(int M, int N, int G_, int c_) { nM = M / BM; nN = N / BM; nwg = nM * nN; G = G_; c = c_; }
    __host__ __device__ bool next(int i, Unit& u) const {
        const long L = (long)i * G + c; if (L >= nwg) return false;
        int wgid = (int)L; { const int q = nwg / NXCD, r = nwg % NXCD, xcd = wgid % NXCD, off = wgid / NXCD; wgid = (xcd < r ? xcd * (q + 1) : r * (q + 1) + (xcd - r) * q) + off; }
        const int nig = WGM * nN, gid = wgid / nig, fm = gid * WGM, gsz = (nM - fm) < WGM ? (nM - fm) : WGM;
        u.pm = fm + ((wgid % nig) % gsz); u.pn = (wgid % nig) / gsz; return true;
    }
    __device__ __forceinline__ void a_ready(const Unit&) const {}
    __device__ __forceinline__ void done(const Unit&) const {}
};
__device__ __forceinline__ unsigned cvt_pk_bf16(float lo, float hi) { unsigned r; asm volatile("v_cvt_pk_bf16_f32 %0, %1, %2" : "=v"(r) : "v"(lo), "v"(hi)); return r; }
template <class Epi, class Sched, bool ALIGN_EPI = false, bool SP2 = false>
__device__ __forceinline__ void gemm_phase(PG8_LAS unsigned char* lds, const Gemm g, const Sched& S, const Epi& E) {
    const int tid = threadIdx.x, wid = __builtin_amdgcn_readfirstlane(tid >> 6), lane = tid & 63, wr = wid >> 2, wc = wid & 3, fr = lane & 15, fq = lane >> 4;
    const int K = g.K, nt = K / BK;
    unsigned voffA[2], voffB[2];
#pragma unroll
    for (int i = 0; i < 2; ++i) { int R, C; stage_rc(tid * 16 + i * 8192, R, C); const int Rb = Epi::PERM ? ((R & ~31) + perm32(R & 31)) : R;
        voffA[i] = (unsigned)(R * K + C) * 2u; voffB[i] = (unsigned)(Rb * K + C) * 2u; }
    const size_t kstep = (size_t)(BK * 2);
    const size_t hstep = (size_t)HALF * K * 2;
    const size_t tstep = 2 * hstep;
    const unsigned ldsw = (unsigned)wid * 1024u;
    const int aoff = lds_byte(wr * 64 + fr, fq * 8), boff = lds_byte(wc * 32 + fr, fq * 8);
#define PG8_SA(b, h) (((b) * 2 + (h)) * HTB)
#define PG8_SB(b, h) ((4 + (b) * 2 + (h)) * HTB)
#define PG8_STAGE(bufoff, gbase, voff) do { _Pragma("unroll") for (int _i = 0; _i < 2; ++_i) \
        __builtin_amdgcn_global_load_lds((const unsigned*)((const char*)(gbase) + (voff)[_i]), (PG8_LAS unsigned*)(lds + (bufoff) + ldsw + _i * 8192), 16, 0, 0); } while (0)
#define PG8_LDA(dst, b, h) do { _Pragma("unroll") for (int m = 0; m < 4; ++m) _Pragma("unroll") for (int k = 0; k < 2; ++k) dst[m][k] = *(const PG8_LAS bf16x8*)(lds + PG8_SA(b, h) + aoff + m * 2048 + k * 1024); } while (0)
#define PG8_LDB(dst, b, h) do { _Pragma("unroll") for (int n = 0; n < 2; ++n) _Pragma("unroll") for (int k = 0; k < 2; ++k) dst[n][k] = *(const PG8_LAS bf16x8*)(lds + PG8_SB(b, h) + boff + n * 2048 + k * 1024); } while (0)
#define PG8_MMA(ai, bj, At, Bt) do { __builtin_amdgcn_s_setprio(1); _Pragma("unroll") for (int m = 0; m < 4; ++m) _Pragma("unroll") for (int n = 0; n < 2; ++n) _Pragma("unroll") for (int k = 0; k < 2; ++k) \
        acc[ai][bj][m][n] = __builtin_amdgcn_mfma_f32_16x16x32_bf16(Bt[n][k], At[m][k], acc[ai][bj][m][n], 0, 0, 0); __builtin_amdgcn_s_setprio(0); } while (0)
#define PG8_WAIT_V(n) asm volatile("s_waitcnt vmcnt(" #n ")" ::: "memory")
#define PG8_WAIT_L(n) asm volatile("s_waitcnt lgkmcnt(" #n ")" ::: "memory")
#define PG8_BAR __builtin_amdgcn_s_barrier()
#define PG8_SCHED __builtin_amdgcn_sched_barrier(0)
    Unit cur, nxt; int ui = 0;
    if (!S.next(0, cur)) return;
    f32x4 acc[2][2][4][2];
#pragma unroll
    for (int a = 0; a < 2; ++a)
#pragma unroll
        for (int b = 0; b < 2; ++b)
#pragma unroll
            for (int m = 0; m < 4; ++m)
#pragma unroll
                for (int n = 0; n < 2; ++n) acc[a][b][m][n] = (f32x4){0.f, 0.f, 0.f, 0.f};
    bf16x8 At[4][2], B0[2][2], B1[2][2];
    const char* cA = (const char*)g.A + (size_t)cur.pm * tstep; const char* cB = (const char*)g.Bt + (size_t)cur.pn * tstep;
    S.a_ready(cur);
    if constexpr (SP2) {
        PG8_STAGE(PG8_SB(0, 0), cB, voffB); PG8_STAGE(PG8_SB(0, 1), cB + hstep, voffB); PG8_STAGE(PG8_SA(0, 0), cA, voffA); PG8_STAGE(PG8_SA(0, 1), cA + hstep, voffA);
        if (wr == 1) PG8_BAR;
        PG8_WAIT_V(2); PG8_BAR;
        PG8_STAGE(PG8_SB(1, 0), cB + kstep, voffB); PG8_STAGE(PG8_SA(1, 0), cA + kstep, voffA); PG8_STAGE(PG8_SB(1, 1), cB + hstep + kstep, voffB);
        PG8_WAIT_V(6); PG8_BAR;
    } else {
        PG8_STAGE(PG8_SB(0, 0), cB, voffB); PG8_STAGE(PG8_SA(0, 0), cA, voffA); PG8_STAGE(PG8_SB(0, 1), cB + hstep, voffB); PG8_STAGE(PG8_SA(0, 1), cA + hstep, voffA);
        if (wr == 1) PG8_BAR;
        PG8_WAIT_V(4); PG8_BAR;
        PG8_STAGE(PG8_SB(1, 0), cB + kstep, voffB); PG8_STAGE(PG8_SA(1, 0), cA + kstep, voffA); PG8_STAGE(PG8_SB(1, 1), cB + hstep + kstep, voffB);
        PG8_WAIT_V(6); PG8_BAR;
    }
    for (;;) {
        const bool has_next = S.next(ui + 1, nxt);
        const char* nA = has_next ? (const char*)g.A + (size_t)nxt.pm * tstep : cA; const char* nB = has_next ? (const char*)g.Bt + (size_t)nxt.pn * tstep : cB;
        for (int t = 0; t < nt; t += 2) {
            const bool last = (t == nt - 2);
            const char* a1 = cA + (size_t)(t + 1) * kstep;
            const char* a2 = last ? nA : cA + (size_t)(t + 2) * kstep; const char* b2 = last ? nB : cB + (size_t)(t + 2) * kstep;
            const char* a3 = a2 + kstep; const char* b3 = b2 + kstep;
            if (last && has_next) S.a_ready(nxt);
            if constexpr (SP2) {
            PG8_LDB(B0, 0, 0); PG8_LDB(B1, 0, 1); PG8_SCHED; PG8_LDA(At, 0, 0); PG8_STAGE(PG8_SA(1, 1), a1 + hstep, voffA);
            PG8_WAIT_V(8); PG8_WAIT_L(0); PG8_BAR; PG8_MMA(0, 0, At, B0); PG8_MMA(0, 1, At, B1); PG8_BAR; PG8_SCHED;
            PG8_LDA(At, 0, 1); PG8_STAGE(PG8_SB(0, 0), b2, voffB); PG8_STAGE(PG8_SB(0, 1), b2 + hstep, voffB); PG8_STAGE(PG8_SA(0, 0), a2, voffA);
            PG8_WAIT_V(8); PG8_WAIT_L(0); PG8_BAR; PG8_MMA(1, 0, At, B0); PG8_MMA(1, 1, At, B1); PG8_BAR; PG8_SCHED;
            PG8_LDB(B0, 1, 0); PG8_LDB(B1, 1, 1); PG8_SCHED; PG8_LDA(At, 1, 0); PG8_STAGE(PG8_SA(0, 1), a2 + hstep, voffA);
            PG8_WAIT_V(8); PG8_WAIT_L(0); PG8_BAR; PG8_MMA(0, 0, At, B0); PG8_MMA(0, 1, At, B1); PG8_BAR; PG8_SCHED;
            PG8_LDA(At, 1, 1); PG8_STAGE(PG8_SB(1, 0), b3, voffB); PG8_STAGE(PG8_SB(1, 1), b3 + hstep, voffB); PG8_STAGE(PG8_SA(1, 0), a3, voffA);
            PG8_WAIT_V(8); PG8_WAIT_L(0); PG8_BAR; PG8_MMA(1, 0, At, B0); PG8_MMA(1, 1, At, B1); PG8_BAR; PG8_SCHED;
            } else {
            PG8_LDB(B0, 0, 0); PG8_SCHED; PG8_LDA(At, 0, 0); PG8_STAGE(PG8_SA(1, 1), a1 + hstep, voffA);
            PG8_WAIT_L(8); PG8_BAR; PG8_WAIT_L(0); PG8_MMA(0, 0, At, B0); PG8_BAR; PG8_SCHED;
            PG8_LDB(B1, 0, 1); PG8_STAGE(PG8_SB(0, 0), b2, voffB);
            PG8_BAR; PG8_WAIT_L(0); PG8_MMA(0, 1, At, B1); PG8_BAR;
            PG8_LDA(At, 0, 1); PG8_STAGE(PG8_SA(0, 0), a2, voffA);
            PG8_BAR; PG8_WAIT_L(0); PG8_MMA(1, 0, At, B0); PG8_BAR; PG8_SCHED;
            PG8_STAGE(PG8_SB(0, 1), b2 + hstep, voffB);
            PG8_WAIT_V(6); PG8_BAR; PG8_MMA(1, 1, At, B1); PG8_BAR;
            PG8_LDB(B0, 1, 0); PG8_SCHED; PG8_LDA(At, 1, 0); PG8_STAGE(PG8_SA(0, 1), a2 + hstep, voffA);
            PG8_WAIT_L(8); PG8_BAR; PG8_WAIT_L(0); PG8_MMA(0, 0, At, B0); PG8_BAR; PG8_SCHED;
            PG8_LDB(B1, 1, 1); PG8_STAGE(PG8_SB(1, 0), b3, voffB);
            PG8_BAR; PG8_WAIT_L(0); PG8_MMA(0, 1, At, B1); PG8_BAR;
            PG8_LDA(At, 1, 1); PG8_STAGE(PG8_SA(1, 0), a3, voffA);
            PG8_BAR; PG8_WAIT_L(0); PG8_MMA(1, 0, At, B0); PG8_BAR; PG8_SCHED;
            PG8_STAGE(PG8_SB(1, 1), b3 + hstep, voffB);
            PG8_WAIT_V(6); PG8_BAR; PG8_MMA(1, 1, At, B1); PG8_BAR;
            }
        }
        if constexpr (ALIGN_EPI) { if (wr == 0) PG8_BAR; }
        if constexpr (!Epi::AFTER_DRAIN) { E(acc, cur, wr, wc, fr, fq); S.done(cur); }
        if (!has_next) break;
#pragma unroll
        for (int a = 0; a < 2; ++a)
#pragma unroll
            for (int b = 0; b < 2; ++b)
#pragma unroll
                for (int m = 0; m < 4; ++m)
#pragma unroll
                    for (int n = 0; n < 2; ++n) acc[a][b][m][n] = (f32x4){0.f, 0.f, 0.f, 0.f};
        cur = nxt; cA = nA; cB = nB; ++ui;
        if constexpr (ALIGN_EPI) { if (wr == 1) PG8_BAR; }
    }
    PG8_WAIT_V(0);
    if constexpr (!ALIGN_EPI) { if (wr == 0) PG8_BAR; }
    PG8_BAR;
    if constexpr (Epi::AFTER_DRAIN) { E.fused(acc, cur, wr, wc, fr, fq, lds, wid, lane); S.done(cur); }
#undef PG8_SA
#undef PG8_SB
#undef PG8_STAGE
#undef PG8_LDA
#undef PG8_LDB
#undef PG8_MMA
#undef PG8_WAIT_V
#undef PG8_WAIT_L
#undef PG8_BAR
#undef PG8_SCHED
}
}
#define GAS __attribute__((address_space(1)))
#define LAS __attribute__((address_space(3)))
typedef unsigned short bf16;
typedef unsigned v4u __attribute__((ext_vector_type(4)));
typedef float f32x4 __attribute__((ext_vector_type(4)));
typedef short bf16x8 __attribute__((ext_vector_type(8)));
typedef GAS unsigned gu32;
typedef GAS unsigned long long gu64;
#define RLX_AGENT __ATOMIC_RELAXED, __HIP_MEMORY_SCOPE_AGENT
#define LDS_WAIT() asm volatile("s_waitcnt lgkmcnt(0)" ::: "memory")
#define VM_WAIT() asm volatile("s_waitcnt vmcnt(0)" ::: "memory")
__device__ __forceinline__ unsigned long long rt() { return __builtin_amdgcn_s_memrealtime(); }
__device__ __forceinline__ unsigned f2bf(float f) { unsigned u = __builtin_bit_cast(unsigned, f); return (u + 0x7fffu + ((u >> 16) & 1u)) >> 16; }
__device__ __forceinline__ unsigned pk2(float lo, float hi) { return f2bf(lo) | (f2bf(hi) << 16); }

#define XB_TMO      128
#define XB_XCNT(j)  (256  + 64 * (j))
#define XB_XSUB(j)  (1280 + 64 * (j))
#define XB_XGEN(j)  (2304 + 64 * (j))
#define XB_TOP      3328
#define XB_TOPGEN   3392
#define XCD_BAR_WORDS 3456
#define XB_SPIN_CAP (1u << 18)

__device__ __forceinline__ unsigned xb_ld(unsigned* p)              { return __hip_atomic_load(p, __ATOMIC_RELAXED, __HIP_MEMORY_SCOPE_AGENT); }
__device__ __forceinline__ unsigned xb_add(unsigned* p, unsigned v) { return __hip_atomic_fetch_add(p, v, __ATOMIC_RELAXED, __HIP_MEMORY_SCOPE_AGENT); }
__device__ __forceinline__ unsigned xb_xcc_id() { return (unsigned)__builtin_amdgcn_s_getreg((3 << 11) | 20) & 0xFu; }
#define XB_SPIN(cond, bar) do { unsigned _sp = 0; while (cond) { __builtin_amdgcn_s_sleep(1); \
    if ((++_sp & 255u) == 0u) { if (xb_ld(&(bar)[XB_TMO])) break; if (_sp > XB_SPIN_CAP) { atomicAdd(&(bar)[XB_TMO], 1u); break; } } } } while (0)

struct XcdBarrier {
    unsigned* bar; unsigned x;
    volatile LAS unsigned* st;
};

__device__ __forceinline__ XcdBarrier xcd_barrier_post(unsigned* bar, volatile LAS unsigned* st) {
    XcdBarrier b; b.bar = bar; b.x = xb_xcc_id(); b.st = st;
    if (threadIdx.x == 0) (void)xb_add(&bar[XB_XCNT(b.x)], 1u);
    return b;
}
__device__ __forceinline__ void xcd_barrier_complete(unsigned* bar, unsigned x, unsigned& nloc, unsigned& nx) {
    const unsigned G = gridDim.x * gridDim.y * gridDim.z;
    unsigned sum, cnt, mine, sp = 0u;
    for (;;) {
        sum = 0u; cnt = 0u; mine = 0u;
#pragma unroll
        for (unsigned j = 0; j < 16; ++j) { const unsigned c = xb_ld(&bar[XB_XCNT(j)]); sum += c; cnt += (c > 0u) ? 1u : 0u; mine = (j == x) ? c : mine; }
        if (sum == G) break;
        __builtin_amdgcn_s_sleep(1);
        if ((++sp & 255u) == 0u) { if (xb_ld(&bar[XB_TMO])) break; if (sp > XB_SPIN_CAP) { atomicAdd(&bar[XB_TMO], 1u); break; } }
    }
    nloc = mine > 0u ? mine : 1u; nx = cnt > 0u ? cnt : 1u;
}

__device__ __forceinline__ void xcd_barrier(const XcdBarrier& b) {
    asm volatile("s_waitcnt vmcnt(0)" ::: "memory");
    __syncthreads();
    if (threadIdx.x == 0) {
        unsigned* bar = b.bar;
        __builtin_amdgcn_s_waitcnt(0);
        unsigned nloc = b.st[0], nx = b.st[1];
        if (nloc == 0u) { xcd_barrier_complete(bar, b.x, nloc, nx); b.st[0] = nloc; b.st[1] = nx; }
        const unsigned old = xb_add(&bar[XB_XSUB(b.x)], 1u);
        const unsigned gen = old / nloc;
        if (old + 1u == (gen + 1u) * nloc) {
            __builtin_amdgcn_fence(__ATOMIC_RELEASE, "agent");
            asm volatile("s_waitcnt vmcnt(0)" ::: "memory");
            const unsigned og = xb_add(&bar[XB_TOP], 1u);
            const unsigned tg = og / nx;
            if (og + 1u == (tg + 1u) * nx) xb_add(&bar[XB_TOPGEN], 1u);
            else XB_SPIN(xb_ld(&bar[XB_TOPGEN]) == tg, bar);
            __builtin_amdgcn_fence(__ATOMIC_ACQUIRE, "agent");
            xb_add(&bar[XB_XGEN(b.x)], 1u);
            asm volatile("s_waitcnt vmcnt(0)" ::: "memory");
        } else {
            XB_SPIN(xb_ld(&bar[XB_XGEN(b.x)]) == gen, bar);
            __builtin_amdgcn_fence(__ATOMIC_ACQUIRE, "agent");
            asm volatile("s_waitcnt vmcnt(0)" ::: "memory");
        }
    }
    __syncthreads();
}

constexpr int NWAVES = 8, NTHREADS = NWAVES * 64;
constexpr int BATCH = 8, SEQ = 2048, T = BATCH * SEQ, D = 2048;
constexpr int EV_N = 7200, EV_NP = 7424, OD_N = 7616, OD_NP = 7680, PROJ_LD = 7680;
constexpr float EPS = 1e-6f;
constexpr int EC_GQ = 0, EC_GK = 512, EC_GV = 1024, EC_GZ = 2048, EC_GLR = 3072, EC_BQ = 3088, EC_BK = 4112, EC_BV = 5136, EC_BZ = 6160, EC_BA = 7184, EC_BB = 7192;
constexpr int OC_HQ = 0, OC_HF = 1024, OC_HI = 2048, OC_HG = 3072, OC_RW = 4096;
constexpr int RW_R = 0, RW_K = 1024, RW_V = 2048, RW_WL = 3072, RW_AL = 3168, RW_GL = 3264;
constexpr int LORA_K = 512, LORA_N = 3072;
enum { I_X = 0, I_P, I_EV_WIN, I_GK_W2, I_GK_B, I_GLA_NORM, I_GDN_CONV, I_GDN_ALOG, I_GDN_DTB, I_GDN_NORM, I_EV_WOUT, I_OD_WIN, I_LB, I_HG_NORM,
       I_MU, I_W0, I_W2, I_A0, I_A2, I_G2, I_KK, I_KA, I_RK, I_LNW, I_LNB, I_OD_WOUT, I_NMIX, I_NFFN, I_NPLE, I_PEER_WQ, I_PEER_SK, I_PEER_U, I_PEER_V,
       I_PLE_WP, I_PLE_WG, I_NFINAL, N_IN };

constexpr size_t MiB = 1u << 20;
constexpr size_t WS_CTL = 0, CTL_ZERO_BYTES = 1 * MiB;
constexpr size_t WS_WEV_IN = 1 * MiB, WS_WEV_OUT = 30 * MiB, WS_WOD_IN = 38 * MiB, WS_WOD_OUT = 68 * MiB, WS_WPEER = 76 * MiB, WS_WGATE = 92 * MiB, WS_WPROJ = 108 * MiB,
                 WS_WLORA = 110 * MiB, WS_PBF = 113 * MiB, WS_TABU = 129 * MiB, WS_TABV = 193 * MiB, WS_ACTA = 257 * MiB, WS_ACTB = 321 * MiB, WS_PROJ = 385 * MiB, WS_SC = 385 * MiB,
                 WS_O = 625 * MiB, WS_PP = 753 * MiB, WS_LA = 817 * MiB, WS_LO = 833 * MiB, WS_RSP = 929 * MiB, WS_END = 937 * MiB;
static_assert(WS_WEV_IN + (size_t)EV_NP * D * 2 <= WS_WEV_OUT && WS_WOD_IN + (size_t)OD_NP * D * 2 <= WS_WOD_OUT && WS_PROJ + (size_t)T * PROJ_LD * 2 <= WS_O, "ws map");
constexpr int CW_BAR = 4096;
enum { RS_FFN0 = 0, RS_MIX1 = 1, RS_FFN1 = 2, RS_FINAL = 3 };
constexpr int RING_OFF = 0, RING_BYTES = 131072;
constexpr int LDSCTL_OFF = RING_BYTES, MISC_OFF = LDSCTL_OFF + 320;
constexpr int LDS_BYTES = 147456;

struct Args { const float* in[N_IN]; float* out; unsigned char* ws; int ph_lo, ph_hi; };
struct Frame {
    LAS unsigned char* lds; volatile LAS unsigned* MISC; gu32* ctl;
    int tid, lane, wave, vcu, G;
};
__device__ __forceinline__ float wave_sum(float v) {
#pragma unroll
    for (int o = 1; o < 64; o <<= 1) v += __shfl_xor(v, o);
    return v;
}
__device__ __forceinline__ float half_sum32(float v) {
#pragma unroll
    for (int o = 1; o < 32; o <<= 1) v += __shfl_xor(v, o);
    return v;
}
#define DPP_ADD(v, ctrl) (v) += __builtin_bit_cast(float, __builtin_amdgcn_update_dpp(0, __builtin_bit_cast(int, (v)), (ctrl), 0xF, 0xF, false))
__device__ __forceinline__ float row_sum16(float v) {
    DPP_ADD(v, 0x128); DPP_ADD(v, 0x124); DPP_ADD(v, 0x122); DPP_ADD(v, 0x121);
    return v;
}
__device__ __forceinline__ void row_sum16_x4(float& a, float& b, float& c, float& d) {
    asm("s_nop 1\n\t"
        "v_add_f32_dpp %0, %0, %0 row_ror:8 row_mask:0xf bank_mask:0xf\n\tv_add_f32_dpp %1, %1, %1 row_ror:8 row_mask:0xf bank_mask:0xf\n\t"
        "v_add_f32_dpp %2, %2, %2 row_ror:8 row_mask:0xf bank_mask:0xf\n\tv_add_f32_dpp %3, %3, %3 row_ror:8 row_mask:0xf bank_mask:0xf\n\t"
        "v_add_f32_dpp %0, %0, %0 row_ror:4 row_mask:0xf bank_mask:0xf\n\tv_add_f32_dpp %1, %1, %1 row_ror:4 row_mask:0xf bank_mask:0xf\n\t"
        "v_add_f32_dpp %2, %2, %2 row_ror:4 row_mask:0xf bank_mask:0xf\n\tv_add_f32_dpp %3, %3, %3 row_ror:4 row_mask:0xf bank_mask:0xf\n\t"
        "v_add_f32_dpp %0, %0, %0 row_ror:2 row_mask:0xf bank_mask:0xf\n\tv_add_f32_dpp %1, %1, %1 row_ror:2 row_mask:0xf bank_mask:0xf\n\t"
        "v_add_f32_dpp %2, %2, %2 row_ror:2 row_mask:0xf bank_mask:0xf\n\tv_add_f32_dpp %3, %3, %3 row_ror:2 row_mask:0xf bank_mask:0xf\n\t"
        "v_add_f32_dpp %0, %0, %0 row_ror:1 row_mask:0xf bank_mask:0xf\n\tv_add_f32_dpp %1, %1, %1 row_ror:1 row_mask:0xf bank_mask:0xf\n\t"
        "v_add_f32_dpp %2, %2, %2 row_ror:1 row_mask:0xf bank_mask:0xf\n\tv_add_f32_dpp %3, %3, %3 row_ror:1 row_mask:0xf bank_mask:0xf\n\t"
        "s_nop 1"
        : "+v"(a), "+v"(b), "+v"(c), "+v"(d));
}
__device__ __forceinline__ void row_sum16_x2(float& a, float& b) {
    asm("s_nop 1\n\t"
        "v_add_f32_dpp %0, %0, %0 row_ror:8 row_mask:0xf bank_mask:0xf\n\tv_add_f32_dpp %1, %1, %1 row_ror:8 row_mask:0xf bank_mask:0xf\n\ts_nop 1\n\t"
        "v_add_f32_dpp %0, %0, %0 row_ror:4 row_mask:0xf bank_mask:0xf\n\tv_add_f32_dpp %1, %1, %1 row_ror:4 row_mask:0xf bank_mask:0xf\n\ts_nop 1\n\t"
        "v_add_f32_dpp %0, %0, %0 row_ror:2 row_mask:0xf bank_mask:0xf\n\tv_add_f32_dpp %1, %1, %1 row_ror:2 row_mask:0xf bank_mask:0xf\n\ts_nop 1\n\t"
        "v_add_f32_dpp %0, %0, %0 row_ror:1 row_mask:0xf bank_mask:0xf\n\tv_add_f32_dpp %1, %1, %1 row_ror:1 row_mask:0xf bank_mask:0xf\n\t"
        "s_nop 1"
        : "+v"(a), "+v"(b));
}
#define LBAR() do { asm volatile("s_waitcnt lgkmcnt(0)" ::: "memory"); __builtin_amdgcn_s_barrier(); asm volatile("" ::: "memory"); } while (0)
__device__ __forceinline__ float bf_lo(unsigned w) { return __uint_as_float(w << 16); }
__device__ __forceinline__ float bf_hi(unsigned w) { return __uint_as_float(w & 0xffff0000u); }
__device__ __forceinline__ float sigmoidf_(float x) { return __builtin_amdgcn_rcpf(1.0f + __expf(-x)); }
__device__ __forceinline__ float siluf_(float x) { return x * __builtin_amdgcn_rcpf(1.0f + __expf(-x)); }
__device__ __forceinline__ float softplusf_(float x) { return fmaxf(x, 0.f) + log1pf(__expf(-fabsf(x))); }
__device__ __forceinline__ float logsigmoidf_(float x) { return fminf(x, 0.f) - log1pf(__expf(-fabsf(x))); }

struct EpiBf16S {
    static constexpr bool PERM = true, AFTER_DRAIN = false;
    bf16* O; int ldc; const float* rowss;
    __device__ __forceinline__ void operator()(const pg8::f32x4 (&acc)[2][2][4][2], const pg8::Unit& u, int wr, int wc, int fr, int fq) const {
        const int row0 = u.pm * 256 + wr * 64 + fr, col0 = u.pn * 256 + wc * 32 + 8 * fq;
#pragma unroll
        for (int ai = 0; ai < 2; ++ai)
#pragma unroll
            for (int m = 0; m < 4; ++m) {
                const int row = row0 + ai * 128 + m * 16;
                float sc = 1.f;
                if (rowss) { const pg8::f32x4* rp = (const pg8::f32x4*)(rowss + (size_t)row * 32 + 8 * fq); const pg8::f32x4 p0 = rp[0], p1 = rp[1];
                    float s = ((p0[0] + p0[1]) + (p0[2] + p0[3])) + ((p1[0] + p1[1]) + (p1[2] + p1[3])); s += __shfl_xor(s, 16); s += __shfl_xor(s, 32);
                    sc = __builtin_amdgcn_rsqf(s * (1.0f / D) + EPS); }
                bf16* rowp = O + (size_t)row * ldc + col0;
#pragma unroll
                for (int bj = 0; bj < 2; ++bj) { const pg8::f32x4 v0 = acc[ai][bj][m][0] * sc, v1 = acc[ai][bj][m][1] * sc;
                    pg8::u32x4 w; w.x = pg8::cvt_pk_bf16(v0[0], v0[1]); w.y = pg8::cvt_pk_bf16(v0[2], v0[3]); w.z = pg8::cvt_pk_bf16(v1[0], v1[1]); w.w = pg8::cvt_pk_bf16(v1[2], v1[3]);
                    *(pg8::u32x4*)(rowp + bj * 128) = w; } }
    }
};
template <bool GATE> struct EpiResid {
    static constexpr bool PERM = false, AFTER_DRAIN = false;
    const float* hin; float* hout; bf16* hg; const float* gain; float* rowss; const bf16* pp;
    __device__ __forceinline__ void operator()(const pg8::f32x4 (&acc)[2][2][4][2], const pg8::Unit& u, int wr, int wc, int fr, int fq) const {
        const int row0 = u.pm * 256 + wr * 64 + fr, col0 = u.pn * 256 + wc * 32 + 4 * fq;
        pg8::f32x4 gv[2][2];
#pragma unroll
        for (int bj = 0; bj < 2; ++bj)
#pragma unroll
            for (int n = 0; n < 2; ++n) gv[bj][n] = hg ? *(const pg8::f32x4*)(gain + col0 + bj * 128 + n * 16) : (pg8::f32x4){0.f, 0.f, 0.f, 0.f};
#pragma unroll
        for (int ai = 0; ai < 2; ++ai)
#pragma unroll
            for (int m = 0; m < 4; ++m) {
                const int row = row0 + ai * 128 + m * 16; const size_t off = (size_t)row * D + col0; float ss = 0.f;
#pragma unroll
                for (int bj = 0; bj < 2; ++bj)
#pragma unroll
                    for (int n = 0; n < 2; ++n) { const size_t o = off + bj * 128 + n * 16;
                        pg8::f32x4 hv = *(const pg8::f32x4*)(hin + o); pg8::f32x4 a = acc[ai][bj][m][n];
                        if (GATE) { const pg8::u32x2 pw = *(const pg8::u32x2*)(pp + o);
                            a[0] = sigmoidf_(a[0]) * bf_lo(pw.x); a[1] = sigmoidf_(a[1]) * bf_hi(pw.x); a[2] = sigmoidf_(a[2]) * bf_lo(pw.y); a[3] = sigmoidf_(a[3]) * bf_hi(pw.y); }
                        hv = hv + a; *(pg8::f32x4*)(hout + o) = hv;
                        ss += (hv[0] * hv[0] + hv[1] * hv[1]) + (hv[2] * hv[2] + hv[3] * hv[3]);
                        if (hg) { const pg8::f32x4 q = hv * gv[bj][n]; pg8::u32x2 w; w.x = pg8::cvt_pk_bf16(q[0], q[1]); w.y = pg8::cvt_pk_bf16(q[2], q[3]); *(pg8::u32x2*)(hg + o) = w; } }
                ss += __shfl_xor(ss, 16); ss += __shfl_xor(ss, 32);
                if (fq == 0) rowss[(size_t)row * 32 + u.pn * 4 + wc] = ss;
                asm volatile("" ::: "memory"); }
    }
};

__device__ __forceinline__ void p0_transpose_item(const float* W, int K, int N, bf16* WT, LAS float* scr, int item, int lane) {
    const int nblk = N / 32, kb = item / nblk, nb = item % nblk, k0 = 64 * kb, n0 = 32 * nb;
#pragma unroll 8
    for (int i = 0; i < 32; ++i) { const int kk = 2 * i + (lane >> 5); scr[kk * 33 + (lane & 31)] = W[(size_t)(k0 + kk) * N + n0 + (lane & 31)]; }
    LDS_WAIT(); asm volatile("" ::: "memory");
    const int c = lane & 7;
#pragma unroll
    for (int j = 0; j < 4; ++j) { const int n = (lane >> 3) + 8 * j; const LAS float* s = scr + (8 * c) * 33 + n;
        v4u o; o.x = pk2(s[0 * 33], s[1 * 33]); o.y = pk2(s[2 * 33], s[3 * 33]); o.z = pk2(s[4 * 33], s[5 * 33]); o.w = pk2(s[6 * 33], s[7 * 33]);
        *(GAS v4u*)(WT + (size_t)(n0 + n) * K + k0 + 8 * c) = o; }
    LDS_WAIT(); asm volatile("" ::: "memory");
}
__device__ __forceinline__ void cvt_f32_bf16(const float* src, bf16* dst, size_t n, int gtid, int gthreads) {
    const size_t n8 = n / 8;
    for (size_t i = gtid; i < n8; i += gthreads) {
        const f32x4 a = *(const GAS f32x4*)(src + i * 8), b = *(const GAS f32x4*)(src + i * 8 + 4);
        v4u o; o.x = pk2(a[0], a[1]); o.y = pk2(a[2], a[3]); o.z = pk2(b[0], b[1]); o.w = pk2(b[2], b[3]);
        *(GAS v4u*)(dst + i * 8) = o; }
}
__device__ __forceinline__ void cvt_f32_fp8(const float* src, unsigned char* dst, size_t n, float scale, int gtid, int gthreads) {
    const size_t n16 = n / 16;
    for (size_t i = gtid; i < n16; i += gthreads) { v4u o; unsigned w[4];
#pragma unroll
        for (int q = 0; q < 4; ++q) { const f32x4 a = *(const GAS f32x4*)(src + i * 16 + 4 * q) * scale;
            int x = __builtin_amdgcn_cvt_pk_fp8_f32(a[0], a[1], 0, false); x = __builtin_amdgcn_cvt_pk_fp8_f32(a[2], a[3], x, true); w[q] = (unsigned)x; }
        o.x = w[0]; o.y = w[1]; o.z = w[2]; o.w = w[3];
        *(GAS v4u*)(dst + i * 16) = o; }
}
__device__ __forceinline__ void rms_row_to_bf16(const float* xrow, const float* g, bf16* orow, int lane) {
    const GAS f32x4* xr = (const GAS f32x4*)xrow + lane; f32x4 v[8]; float s = 0.f;
#pragma unroll
    for (int j = 0; j < 8; ++j) { v[j] = xr[64 * j]; s += (v[j][0] * v[j][0] + v[j][1] * v[j][1]) + (v[j][2] * v[j][2] + v[j][3] * v[j][3]); }
    const float r = __builtin_amdgcn_rsqf(wave_sum(s) * (1.0f / D) + EPS);
    const GAS f32x4* gr = (const GAS f32x4*)g + lane;
    GAS unsigned long long* o8 = (GAS unsigned long long*)orow + lane;
#pragma unroll
    for (int j = 0; j < 8; ++j) { const f32x4 gg = gr[64 * j]; o8[64 * j] = (unsigned long long)pk2(v[j][0] * r * gg[0], v[j][1] * r * gg[1]) | ((unsigned long long)pk2(v[j][2] * r * gg[2], v[j][3] * r * gg[3]) << 32); }
}
__device__ __forceinline__ void p0_fold_item(const float* wq, const float* sk, bf16* WP, LAS float* lds, int item, int tid) {
    const int hp = item >> 5, k0 = (item & 31) * 64;
    LAS float* skT = lds;
    LAS float* wqT = lds + 128 * 132;
    const float* skb = sk + (size_t)hp * 128 * 128;
#pragma unroll 4
    for (int i = 0; i < 32; ++i) { const int idx = i * 512 + tid, n = idx >> 7, d = idx & 127; skT[d * 132 + n] = skb[idx]; }
#pragma unroll 4
    for (int i = 0; i < 16; ++i) { const int idx = i * 512 + tid, kk = idx >> 7, d = idx & 127; wqT[d * 68 + kk] = wq[(size_t)(k0 + kk) * D + hp * 128 + d]; }
    __syncthreads();
    const int n0 = (tid >> 4) * 4, kk0 = (tid & 15) * 4;
    float acc[4][4];
#pragma unroll
    for (int i = 0; i < 4; ++i)
#pragma unroll
        for (int j = 0; j < 4; ++j) acc[i][j] = 0.f;
#pragma unroll 4
    for (int d = 0; d < 128; ++d) { const f32x4 a = *(const LAS f32x4*)(skT + d * 132 + n0), b = *(const LAS f32x4*)(wqT + d * 68 + kk0);
#pragma unroll
        for (int i = 0; i < 4; ++i)
#pragma unroll
            for (int j = 0; j < 4; ++j) acc[i][j] += a[i] * b[j]; }
#pragma unroll
    for (int i = 0; i < 4; ++i) { unsigned long long o = (unsigned long long)pk2(acc[i][0], acc[i][1]) | ((unsigned long long)pk2(acc[i][2], acc[i][3]) << 32);
        *(GAS unsigned long long*)(WP + (size_t)(hp * 128 + n0 + i) * D + k0 + kk0) = o; }
    __syncthreads();
}
__device__ __forceinline__ void p0_prologue(const Args& A, Frame& F) {
    const int gw = F.vcu * NWAVES + F.wave, NGW = F.G * NWAVES;
    const int gtid = (F.vcu * NWAVES + F.wave) * 64 + F.lane, gthreads = F.G * NTHREADS;
    unsigned char* ws = A.ws;
    {
        LAS float* scr = (LAS float*)(F.lds + RING_OFF + F.wave * 16384);
        constexpr int I_EVIN = (D / 64) * (EV_N / 32), I_SQ = (D / 64) * (D / 32), I_ODIN = (D / 64) * (OD_N / 32), I_PJ = (256 / 64) * (D / 32);
        constexpr int NITEMS = I_EVIN + I_SQ + I_ODIN + I_SQ + 2 * I_SQ + 2 * I_PJ;
        for (int it = gw; it < NITEMS; it += NGW) {
            int r = it;
            if (r < I_EVIN) { p0_transpose_item(A.in[I_EV_WIN], D, EV_N, (bf16*)(ws + WS_WEV_IN), scr, r, F.lane); continue; } r -= I_EVIN;
            if (r < I_SQ) { p0_transpose_item(A.in[I_EV_WOUT], D, D, (bf16*)(ws + WS_WEV_OUT), scr, r, F.lane); continue; } r -= I_SQ;
            if (r < I_ODIN) { p0_transpose_item(A.in[I_OD_WIN], D, OD_N, (bf16*)(ws + WS_WOD_IN), scr, r, F.lane); continue; } r -= I_ODIN;
            if (r < I_SQ) { p0_transpose_item(A.in[I_OD_WOUT], D, D, (bf16*)(ws + WS_WOD_OUT), scr, r, F.lane); continue; } r -= I_SQ;
            if (r < 2 * I_SQ) { const int L = r / I_SQ; p0_transpose_item(A.in[I_PLE_WG] + (size_t)L * D * D, D, D, (bf16*)(ws + WS_WGATE) + (size_t)L * D * D, scr, r % I_SQ, F.lane); continue; } r -= 2 * I_SQ;
            { const int L = r / I_PJ; p0_transpose_item(A.in[I_PLE_WP] + (size_t)L * 256 * D, 256, D, (bf16*)(ws + WS_WPROJ) + (size_t)L * D * 256, scr, r % I_PJ, F.lane); }
        }
        { GAS v4u* z0 = (GAS v4u*)(ws + WS_WEV_IN + (size_t)EV_N * D * 2); const size_t n0 = (size_t)(EV_NP - EV_N) * D * 2 / 16;
          for (size_t i = gtid; i < n0; i += gthreads) z0[i] = (v4u){0u, 0u, 0u, 0u};
          GAS v4u* z1 = (GAS v4u*)(ws + WS_WOD_IN + (size_t)OD_N * D * 2); const size_t n1 = (size_t)(OD_NP - OD_N) * D * 2 / 16;
          for (size_t i = gtid; i < n1; i += gthreads) z1[i] = (v4u){0u, 0u, 0u, 0u}; }
    }
    __syncthreads();
    for (int it = F.vcu; it < 1024; it += F.G) { const int L = it >> 9;
        p0_fold_item(A.in[I_PEER_WQ] + (size_t)L * D * D, A.in[I_PEER_SK] + (size_t)L * 16 * 128 * 128, (bf16*)(ws + WS_WPEER) + (size_t)L * D * D, (LAS float*)(F.lds + RING_OFF), it & 511, F.tid); }
    cvt_f32_fp8(A.in[I_PEER_U], (unsigned char*)(ws + WS_TABU), (size_t)2 * 16384 * D, 512.0f, gtid, gthreads);
    cvt_f32_fp8(A.in[I_PEER_V], (unsigned char*)(ws + WS_TABV), (size_t)2 * 16384 * D, 16.0f, gtid, gthreads);
    cvt_f32_bf16(A.in[I_P], (bf16*)(ws + WS_PBF), (size_t)2 * T * 256, gtid, gthreads);
    { bf16* LB = (bf16*)(ws + WS_WLORA); const float* w2 = A.in[I_W2]; const float* a2 = A.in[I_A2]; const float* g2 = A.in[I_G2];
      for (int i = gtid; i < LORA_N * LORA_K / 2; i += gthreads) { const int row = i / (LORA_K / 2), col = (i % (LORA_K / 2)) * 2; float v[2];
#pragma unroll
          for (int e = 0; e < 2; ++e) { const int c = col + e; float x = 0.f;
              if (row < 1024) { if (c < 96) x = w2[c * 1024 + row]; }
              else if (row < 2048) { if (c >= 96 && c < 192) x = a2[(c - 96) * 1024 + (row - 1024)]; }
              else { if (c >= 192 && c < 448) x = g2[(c - 192) * 1024 + (row - 2048)]; }
              v[e] = x; }
          *(GAS unsigned*)(LB + (size_t)row * LORA_K + col) = pk2(v[0], v[1]); } }
    for (int m = gw; m < T; m += NGW) rms_row_to_bf16(A.in[I_X] + (size_t)m * D, A.in[I_NMIX], (bf16*)(ws + WS_ACTA) + (size_t)m * D, F.lane);
}

constexpr int TC = 16, NCHUNK = SEQ / TC;
typedef float f32x2 __attribute__((ext_vector_type(2)));
typedef unsigned u32x2 __attribute__((ext_vector_type(2)));

template <int MODE>
__device__ __forceinline__ void scan_gla_unit(const Args& A, Frame& F, int unit) {
    const int tid = F.tid, lane = F.lane, w = F.wave;
    int b, h, qcol, kcol, vcol, ocol;
    if (MODE == 0) { b = unit >> 4; h = (unit >> 2) & 3; const int s = unit & 3; qcol = EC_GQ + h * 128; kcol = EC_GK + h * 128; vcol = EC_GV + h * 256 + s * 64; ocol = h * 256 + s * 64; }
    else           { b = unit >> 4; h = (unit >> 1) & 7; const int s = unit & 1; qcol = OC_HQ + h * 128; kcol = OC_HF + h * 128; vcol = OC_HI + h * 128 + s * 64; ocol = h * 128 + s * 64; }
    const bf16* P = (const bf16*)(A.ws + WS_PROJ) + (size_t)b * SEQ * PROJ_LD;
    float* O = (float*)(A.ws + WS_O) + (size_t)b * SEQ * D + ocol;
    LAS float* Lf = (LAS float*)(F.lds + RING_OFF);
    constexpr int BUFSZ = 7168, O_EG = 0, O_K = 2048, O_Q = 4096, O_V = 6144, O_OUT = 2 * BUFSZ, O_W2 = O_OUT + 1024, O_BIAS = O_W2 + 2048;
    const int tl = tid >> 5, dq = (tid & 31) * 4, tlv = tid >> 4, c4 = (tid & 15) * 4;
    float lb[4] = {0.f, 0.f, 0.f, 0.f};
    if (MODE == 0) {
        const float* w2 = A.in[I_GK_W2]; const float* gb = A.in[I_GK_B];
        for (int i = tid; i < 2048; i += NTHREADS) Lf[O_W2 + i] = w2[(i >> 7) * 512 + h * 128 + (i & 127)];
        if (tid < 128) Lf[O_BIAS + tid] = gb[h * 128 + tid];
    } else {
        const float* lg = A.in[I_LB];
#pragma unroll
        for (int i = 0; i < 4; ++i) lb[i] = sigmoidf_(lg[1024 + h * 128 + dq + i] - lg[h * 128 + dq + i]);
    }
    u32x2 rq, rk, rv = {0u, 0u}; v4u rg0 = {0u, 0u, 0u, 0u}, rg1 = {0u, 0u, 0u, 0u};
#define GLA_LOAD(c) do { const bf16* pr = P + (size_t)((c) * TC + tl) * PROJ_LD; rq = *(const GAS u32x2*)(pr + qcol + dq); rk = *(const GAS u32x2*)(pr + kcol + dq); \
        if (MODE == 0) { rg0 = *(const GAS v4u*)(pr + EC_GLR); rg1 = *(const GAS v4u*)(pr + EC_GLR + 8); } \
        if (tid < 256) rv = *(const GAS u32x2*)(P + (size_t)((c) * TC + tlv) * PROJ_LD + vcol + c4); } while (0)
#define GLA_XFORM(bufi) do { LAS float* B_ = Lf + (bufi) * BUFSZ; f32x4 q4, k4, e4; \
        const float xq[4] = {bf_lo(rq.x), bf_hi(rq.x), bf_lo(rq.y), bf_hi(rq.y)}, xk[4] = {bf_lo(rk.x), bf_hi(rk.x), bf_lo(rk.y), bf_hi(rk.y)}; \
        if (MODE == 0) { f32x4 z = *(const LAS f32x4*)(Lf + O_BIAS + dq); \
            const float gl[16] = {bf_lo(rg0.x), bf_hi(rg0.x), bf_lo(rg0.y), bf_hi(rg0.y), bf_lo(rg0.z), bf_hi(rg0.z), bf_lo(rg0.w), bf_hi(rg0.w), \
                                  bf_lo(rg1.x), bf_hi(rg1.x), bf_lo(rg1.y), bf_hi(rg1.y), bf_lo(rg1.z), bf_hi(rg1.z), bf_lo(rg1.w), bf_hi(rg1.w)}; \
            _Pragma("unroll") for (int r_ = 0; r_ < 16; ++r_) { const f32x4 wv = *(const LAS f32x4*)(Lf + O_W2 + r_ * 128 + dq); z = z + wv * gl[r_]; } \
            _Pragma("unroll") for (int i_ = 0; i_ < 4; ++i_) { q4[i_] = xq[i_] * 0.08838834764831845f; k4[i_] = xk[i_]; e4[i_] = __builtin_amdgcn_exp2f(-0.0625f * __builtin_amdgcn_logf(1.0f + __expf(-z[i_]))); } } \
        else { _Pragma("unroll") for (int i_ = 0; i_ < 4; ++i_) { const float fg = lb[i_] + (1.f - lb[i_]) * sigmoidf_(xk[i_]); q4[i_] = siluf_(xq[i_]); k4[i_] = 1.f - fg; e4[i_] = fg; } } \
        *(LAS f32x4*)(B_ + O_EG + tl * 128 + dq) = e4; *(LAS f32x4*)(B_ + O_K + tl * 128 + dq) = k4; *(LAS f32x4*)(B_ + O_Q + tl * 128 + dq) = q4; \
        if (tid < 256) { f32x4 v4 = {bf_lo(rv.x), bf_hi(rv.x), bf_lo(rv.y), bf_hi(rv.y)}; *(LAS f32x4*)(B_ + O_V + tlv * 64 + c4) = v4; } } while (0)
    LBAR();
    GLA_LOAD(0); GLA_XFORM(0);
    LBAR();
    f32x2 S2[8];
#pragma unroll
    for (int i = 0; i < 8; ++i) S2[i] = (f32x2){0.f, 0.f};
    const int j = lane & 15, col = w * 8 + (lane >> 4) * 2;
    for (int c = 0; c < NCHUNK; ++c) {
        if (c + 1 < NCHUNK) GLA_LOAD(c + 1);
        const LAS float* B_ = Lf + (c & 1) * BUFSZ;
        float os0 = 0.f, os1 = 0.f;
        f32x4 e0, e1, k0, k1, q0, q1, ne0, ne1, nk0, nk1, nq0, nq1; f32x2 v2, nv2;
#define GLA_LDSTEP(t_, E0, E1, K0, K1, Q0, Q1, V2) do { E0 = *(const LAS f32x4*)(B_ + O_EG + (t_) * 128 + 4 * j); E1 = *(const LAS f32x4*)(B_ + O_EG + (t_) * 128 + 64 + 4 * j); \
            K0 = *(const LAS f32x4*)(B_ + O_K + (t_) * 128 + 4 * j); K1 = *(const LAS f32x4*)(B_ + O_K + (t_) * 128 + 64 + 4 * j); \
            Q0 = *(const LAS f32x4*)(B_ + O_Q + (t_) * 128 + 4 * j); Q1 = *(const LAS f32x4*)(B_ + O_Q + (t_) * 128 + 64 + 4 * j); V2 = *(const LAS f32x2*)(B_ + O_V + (t_) * 64 + col); } while (0)
        GLA_LDSTEP(0, e0, e1, k0, k1, q0, q1, v2);
#pragma unroll
        for (int t = 0; t < TC; ++t) {
            if (t + 1 < TC) { GLA_LDSTEP(t + 1, ne0, ne1, nk0, nk1, nq0, nq1, nv2); }
            __builtin_amdgcn_sched_barrier(0);
            f32x2 pa = {0.f, 0.f}, pb = {0.f, 0.f};
#pragma unroll
            for (int i = 0; i < 4; ++i) {
                S2[i] = S2[i] * e0[i] + v2 * k0[i]; S2[4 + i] = S2[4 + i] * e1[i] + v2 * k1[i];
                pa += S2[i] * q0[i]; pb += S2[4 + i] * q1[i]; }
            pa += pb;
            float p0 = pa[0], p1 = pa[1];
            row_sum16_x2(p0, p1);
            os0 = (j == t) ? p0 : os0; os1 = (j == t) ? p1 : os1;
            e0 = ne0; e1 = ne1; k0 = nk0; k1 = nk1; q0 = nq0; q1 = nq1; v2 = nv2;
        }
#undef GLA_LDSTEP
        { f32x2 o2 = {os0, os1}; *(LAS f32x2*)(Lf + O_OUT + j * 64 + col) = o2; }
        if (c + 1 < NCHUNK) GLA_XFORM((c + 1) & 1);
        LBAR();
        if (tid < 256) *(GAS f32x4*)(O + (size_t)(c * TC + tlv) * D + c4) = *(const LAS f32x4*)(Lf + O_OUT + tlv * 64 + c4);
        LBAR();
    }
#undef GLA_LOAD
#undef GLA_XFORM
}

__device__ __forceinline__ void scan_gdn_unit(const Args& A, Frame& F, int unit) {
    const int tid = F.tid, lane = F.lane, w = F.wave;
    const int b = unit >> 4, h = (unit >> 1) & 7, s = unit & 1;
    const int qcol = EC_BQ + h * 128, kcol = EC_BK + h * 128, vcol = EC_BV + h * 128 + s * 64, ocol = 1024 + h * 128 + s * 64;
    const bf16* P = (const bf16*)(A.ws + WS_PROJ) + (size_t)b * SEQ * PROJ_LD;
    float* O = (float*)(A.ws + WS_O) + (size_t)b * SEQ * D + ocol;
    LAS float* Lf = (LAS float*)(F.lds + RING_OFF);
    constexpr int BUFSZ = 5184, O_K = 0, O_Q = 2048, O_V = 4096, O_SC = 5120, O_OUT = 2 * BUFSZ, O_CW = O_OUT + 1024;
    const int tl = tid >> 5, dq = (tid & 31) * 4, tlv = tid >> 4, c4 = (tid & 15) * 4;
    { const float* cw = A.in[I_GDN_CONV];
      for (int i = tid; i < 4 * 320; i += NTHREADS) { const int jt = i / 320, x = i % 320;
          const int ch = x < 128 ? (h * 128 + x) : x < 256 ? (1024 + h * 128 + (x - 128)) : (2048 + h * 128 + s * 64 + (x - 256));
          Lf[O_CW + i] = cw[jt * 3072 + ch]; } }
    const float neg_ea = -__expf(A.in[I_GDN_ALOG][h]), dtb = A.in[I_GDN_DTB][h];
    u32x2 rq[4], rk[4], rv[4]; unsigned short rba = 0, rbb = 0;
#pragma unroll
    for (int i = 0; i < 4; ++i) rv[i] = (u32x2){0u, 0u};
#define GDN_LOAD(c) do { const int t_ = (c) * TC + tl; \
        _Pragma("unroll") for (int jt = 0; jt < 4; ++jt) { const int tt = t_ - 3 + jt; \
            if (tt >= 0) { const bf16* pr = P + (size_t)tt * PROJ_LD; rq[jt] = *(const GAS u32x2*)(pr + qcol + dq); rk[jt] = *(const GAS u32x2*)(pr + kcol + dq); } \
            else { rq[jt] = (u32x2){0u, 0u}; rk[jt] = (u32x2){0u, 0u}; } } \
        { const bf16* pr = P + (size_t)t_ * PROJ_LD; rba = pr[EC_BA + h]; rbb = pr[EC_BB + h]; } \
        if (tid < 256) { const int tv = (c) * TC + tlv; \
            _Pragma("unroll") for (int jt = 0; jt < 4; ++jt) { const int tt = tv - 3 + jt; \
                if (tt >= 0) rv[jt] = *(const GAS u32x2*)(P + (size_t)tt * PROJ_LD + vcol + c4); else rv[jt] = (u32x2){0u, 0u}; } } } while (0)
#define GDN_XFORM(bufi) do { LAS float* B_ = Lf + (bufi) * BUFSZ; f32x4 q4 = {0.f, 0.f, 0.f, 0.f}, k4 = {0.f, 0.f, 0.f, 0.f}; \
        _Pragma("unroll") for (int jt = 0; jt < 4; ++jt) { const f32x4 wq = *(const LAS f32x4*)(Lf + O_CW + jt * 320 + dq), wk = *(const LAS f32x4*)(Lf + O_CW + jt * 320 + 128 + dq); \
            q4[0] += wq[0] * bf_lo(rq[jt].x); q4[1] += wq[1] * bf_hi(rq[jt].x); q4[2] += wq[2] * bf_lo(rq[jt].y); q4[3] += wq[3] * bf_hi(rq[jt].y); \
            k4[0] += wk[0] * bf_lo(rk[jt].x); k4[1] += wk[1] * bf_hi(rk[jt].x); k4[2] += wk[2] * bf_lo(rk[jt].y); k4[3] += wk[3] * bf_hi(rk[jt].y); } \
        float sq = 0.f, sk = 0.f, sqk = 0.f; \
        _Pragma("unroll") for (int i_ = 0; i_ < 4; ++i_) { q4[i_] = siluf_(q4[i_]); k4[i_] = siluf_(k4[i_]); sq += q4[i_] * q4[i_]; sk += k4[i_] * k4[i_]; sqk += q4[i_] * k4[i_]; } \
        sq = half_sum32(sq); sk = half_sum32(sk); sqk = half_sum32(sqk); \
        const float rq_ = __builtin_amdgcn_rsqf(sq + EPS) * 0.08838834764831845f, rk_ = __builtin_amdgcn_rsqf(sk + EPS); \
        q4 = q4 * rq_; k4 = k4 * rk_; \
        *(LAS f32x4*)(B_ + O_K + tl * 128 + dq) = k4; *(LAS f32x4*)(B_ + O_Q + tl * 128 + dq) = q4; \
        if ((tid & 31) == 0) { const float ba = __uint_as_float((unsigned)rba << 16), bb = __uint_as_float((unsigned)rbb << 16); \
            f32x4 sc; sc[0] = __expf(neg_ea * softplusf_(ba + dtb)); sc[1] = sigmoidf_(bb); sc[2] = sqk * rq_ * rk_; sc[3] = 0.f; *(LAS f32x4*)(B_ + O_SC + tl * 4) = sc; } \
        if (tid < 256) { f32x4 v4 = {0.f, 0.f, 0.f, 0.f}; \
            _Pragma("unroll") for (int jt = 0; jt < 4; ++jt) { const f32x4 wv = *(const LAS f32x4*)(Lf + O_CW + jt * 320 + 256 + c4); \
                v4[0] += wv[0] * bf_lo(rv[jt].x); v4[1] += wv[1] * bf_hi(rv[jt].x); v4[2] += wv[2] * bf_lo(rv[jt].y); v4[3] += wv[3] * bf_hi(rv[jt].y); } \
            _Pragma("unroll") for (int i_ = 0; i_ < 4; ++i_) v4[i_] = siluf_(v4[i_]); \
            *(LAS f32x4*)(B_ + O_V + tlv * 64 + c4) = v4; } } while (0)
    LBAR();
    GDN_LOAD(0); GDN_XFORM(0);
    LBAR();
    f32x2 S2[8];
#pragma unroll
    for (int i = 0; i < 8; ++i) S2[i] = (f32x2){0.f, 0.f};
    const int j = lane & 15, col = w * 8 + (lane >> 4) * 2;
    for (int c = 0; c < NCHUNK; ++c) {
        if (c + 1 < NCHUNK) GDN_LOAD(c + 1);
        const LAS float* B_ = Lf + (c & 1) * BUFSZ;
        float os0 = 0.f, os1 = 0.f;
        f32x4 k0, k1, q0, q1, sc, nk0, nk1, nq0, nq1, nsc; f32x2 v2, nv2;
#define GDN_LDSTEP(t_, K0, K1, Q0, Q1, V2, SC) do { K0 = *(const LAS f32x4*)(B_ + O_K + (t_) * 128 + 4 * j); K1 = *(const LAS f32x4*)(B_ + O_K + (t_) * 128 + 64 + 4 * j); \
            Q0 = *(const LAS f32x4*)(B_ + O_Q + (t_) * 128 + 4 * j); Q1 = *(const LAS f32x4*)(B_ + O_Q + (t_) * 128 + 64 + 4 * j); V2 = *(const LAS f32x2*)(B_ + O_V + (t_) * 64 + col); SC = *(const LAS f32x4*)(B_ + O_SC + (t_) * 4); } while (0)
        GDN_LDSTEP(0, k0, k1, q0, q1, v2, sc);
#pragma unroll
        for (int t = 0; t < TC; ++t) {
            if (t + 1 < TC) { GDN_LDSTEP(t + 1, nk0, nk1, nq0, nq1, nv2, nsc); }
            __builtin_amdgcn_sched_barrier(0);
            f32x2 d1 = {0.f, 0.f}, d2 = {0.f, 0.f}, e1 = {0.f, 0.f}, e2 = {0.f, 0.f};
#pragma unroll
            for (int i = 0; i < 4; ++i) { d1 += S2[i] * k0[i]; e1 += S2[4 + i] * k1[i]; d2 += S2[i] * q0[i]; e2 += S2[4 + i] * q1[i]; }
            d1 += e1; d2 += e2;
            { float r0_ = d1[0], r1_ = d1[1], r2_ = d2[0], r3_ = d2[1]; row_sum16_x4(r0_, r1_, r2_, r3_); d1[0] = r0_; d1[1] = r1_; d2[0] = r2_; d2[1] = r3_; }
            const float a = sc[0], beta = sc[1], qk = sc[2];
            const f32x2 dl = (v2 - d1 * a) * beta;
            const f32x2 o2 = d2 * a + dl * qk;
#pragma unroll
            for (int i = 0; i < 4; ++i) { S2[i] = S2[i] * a + dl * k0[i]; S2[4 + i] = S2[4 + i] * a + dl * k1[i]; }
            os0 = (j == t) ? o2[0] : os0; os1 = (j == t) ? o2[1] : os1;
            k0 = nk0; k1 = nk1; q0 = nq0; q1 = nq1; v2 = nv2; sc = nsc;
        }
#undef GDN_LDSTEP
        { f32x2 o2 = {os0, os1}; *(LAS f32x2*)(Lf + O_OUT + j * 64 + col) = o2; }
        if (c + 1 < NCHUNK) GDN_XFORM((c + 1) & 1);
        LBAR();
        if (tid < 256) *(GAS f32x4*)(O + (size_t)(c * TC + tlv) * D + c4) = *(const LAS f32x4*)(Lf + O_OUT + tlv * 64 + c4);
        LBAR();
    }
#undef GDN_LOAD
#undef GDN_XFORM
}

typedef short bf16x4_t __attribute__((ext_vector_type(4)));
__device__ __forceinline__ bf16x8 mk_frag(u32x2 lo, u32x2 hi) { v4u t; t.x = lo.x; t.y = lo.y; t.z = hi.x; t.w = hi.y; return __builtin_bit_cast(bf16x8, t); }
template <int MODE>
__device__ __forceinline__ void scan_gla_mfma_unit(const Args& A, Frame& F, int unit) {
    const int tid = F.tid, lane = F.lane, w = F.wave;
    int b, h, qcol, kcol, vcol, ocol;
    if (MODE == 0) { b = unit >> 3; h = (unit >> 1) & 3; const int s = unit & 1; qcol = EC_GQ + h * 128; kcol = EC_GK + h * 128; vcol = EC_GV + h * 256 + s * 128; ocol = h * 256 + s * 128; }
    else           { b = unit >> 3; h = unit & 7; qcol = OC_HQ + h * 128; kcol = OC_HF + h * 128; vcol = OC_HI + h * 128; ocol = h * 128; }
    const bf16* P = (const bf16*)(A.ws + WS_PROJ) + (size_t)b * SEQ * PROJ_LD;
    float* O = (float*)(A.ws + WS_O) + (size_t)b * SEQ * D + ocol;
    LAS float* Lf = (LAS float*)(F.lds + RING_OFF);
    constexpr int BUFSZ = 8192, O_E = 0, O_K = 2048, O_Q = 4096, O_V = 6144, RS = 136, O_QB = 2 * BUFSZ, O_KB = O_QB + 1088, O_KT = O_KB + 1088, O_BL = O_KT + 1024, O_AM = O_BL + 128, O_W2 = O_AM + 128, O_BIAS = O_W2 + 2048;
    LAS bf16* QB = (LAS bf16*)(Lf + O_QB); LAS bf16* KB = (LAS bf16*)(Lf + O_KB); LAS bf16* KT = (LAS bf16*)(Lf + O_KT); LAS bf16* AM = (LAS bf16*)(Lf + O_AM);
    const int tl = tid >> 5, dq = (tid & 31) * 4;
    float lb[4] = {0.f, 0.f, 0.f, 0.f};
    if (MODE == 0) {
        const float* w2 = A.in[I_GK_W2]; const float* gb = A.in[I_GK_B];
        for (int i = tid; i < 2048; i += NTHREADS) Lf[O_W2 + i] = w2[(i >> 7) * 512 + h * 128 + (i & 127)];
        if (tid < 128) Lf[O_BIAS + tid] = gb[h * 128 + tid];
    } else {
        const float* lg = A.in[I_LB];
#pragma unroll
        for (int i = 0; i < 4; ++i) lb[i] = sigmoidf_(lg[1024 + h * 128 + dq + i] - lg[h * 128 + dq + i]);
    }
    u32x2 rq, rk, rv; v4u rg0 = {0u, 0u, 0u, 0u}, rg1 = {0u, 0u, 0u, 0u};
#define GM_LOAD(c) do { const bf16* pr = P + (size_t)((c) * TC + tl) * PROJ_LD; rq = *(const GAS u32x2*)(pr + qcol + dq); rk = *(const GAS u32x2*)(pr + kcol + dq); rv = *(const GAS u32x2*)(pr + vcol + dq); \
        if (MODE == 0) { rg0 = *(const GAS v4u*)(pr + EC_GLR); rg1 = *(const GAS v4u*)(pr + EC_GLR + 8); } } while (0)
#define GM_XFORM(bufi) do { LAS float* B_ = Lf + (bufi) * BUFSZ; f32x4 q4, k4, e4; \
        const float xq[4] = {bf_lo(rq.x), bf_hi(rq.x), bf_lo(rq.y), bf_hi(rq.y)}, xk[4] = {bf_lo(rk.x), bf_hi(rk.x), bf_lo(rk.y), bf_hi(rk.y)}; \
        if (MODE == 0) { f32x4 z = *(const LAS f32x4*)(Lf + O_BIAS + dq); \
            const float gl[16] = {bf_lo(rg0.x), bf_hi(rg0.x), bf_lo(rg0.y), bf_hi(rg0.y), bf_lo(rg0.z), bf_hi(rg0.z), bf_lo(rg0.w), bf_hi(rg0.w), \
                                  bf_lo(rg1.x), bf_hi(rg1.x), bf_lo(rg1.y), bf_hi(rg1.y), bf_lo(rg1.z), bf_hi(rg1.z), bf_lo(rg1.w), bf_hi(rg1.w)}; \
            _Pragma("unroll") for (int r_ = 0; r_ < 16; ++r_) { const f32x4 wv = *(const LAS f32x4*)(Lf + O_W2 + r_ * 128 + dq); z = z + wv * gl[r_]; } \
            _Pragma("unroll") for (int i_ = 0; i_ < 4; ++i_) { q4[i_] = xq[i_] * 0.08838834764831845f; k4[i_] = xk[i_]; e4[i_] = __builtin_amdgcn_exp2f(-0.0625f * __builtin_amdgcn_logf(1.0f + __expf(-z[i_]))); } } \
        else { _Pragma("unroll") for (int i_ = 0; i_ < 4; ++i_) { const float fg = lb[i_] + (1.f - lb[i_]) * sigmoidf_(xk[i_]); q4[i_] = siluf_(xq[i_]); k4[i_] = 1.f - fg; e4[i_] = fg; } } \
        *(LAS f32x4*)(B_ + O_E + tl * 128 + dq) = e4; *(LAS f32x4*)(B_ + O_K + tl * 128 + dq) = k4; *(LAS f32x4*)(B_ + O_Q + tl * 128 + dq) = q4; \
        { f32x4 v4 = {bf_lo(rv.x), bf_hi(rv.x), bf_lo(rv.y), bf_hi(rv.y)}; *(LAS f32x4*)(B_ + O_V + tl * 128 + dq) = v4; } } while (0)
    LBAR();
    GM_LOAD(0); GM_XFORM(0); GM_LOAD(1);
    LBAR();
    f32x4 Sacc[8];
#pragma unroll
    for (int i = 0; i < 8; ++i) Sacc[i] = (f32x4){0.f, 0.f, 0.f, 0.f};
    const int fr = lane & 15, g = lane >> 4, c0 = w * 16;
    for (int c = 0; c < NCHUNK; ++c) {
        const LAS float* B_ = Lf + (c & 1) * BUFSZ;
        {
            const int seg = tid >> 7, d = tid & 127;
            float bt = 1.f, ball = 1.f;
#pragma unroll
            for (int t = 0; t < 16; ++t) { const float e = B_[O_E + t * 128 + d]; ball *= e; if (t < 4 * seg) bt = ball; }
            ball = fmaxf(ball, 1e-30f);
            unsigned short kt4[4];
#pragma unroll
            for (int i = 0; i < 4; ++i) { const int t = 4 * seg + i; bt = fmaxf(bt * B_[O_E + t * 128 + d], 1e-30f);
                const float kk = B_[O_K + t * 128 + d], qq = B_[O_Q + t * 128 + d], ib = __builtin_amdgcn_rcpf(bt);
                QB[t * RS + d] = (bf16)f2bf(qq * bt); KB[t * RS + d] = (bf16)f2bf(kk * ib); kt4[i] = (unsigned short)f2bf(kk * ball * ib); }
            u32x2 kw; kw.x = (unsigned)kt4[0] | ((unsigned)kt4[1] << 16); kw.y = (unsigned)kt4[2] | ((unsigned)kt4[3] << 16);
            *(LAS u32x2*)(KT + d * 16 + 4 * seg) = kw;
            if (seg == 3) Lf[O_BL + d] = ball;
        }
        LBAR();
        if (w == 0) {
            f32x4 acc = {0.f, 0.f, 0.f, 0.f};
#pragma unroll
            for (int ks = 0; ks < 4; ++ks) { const bf16x8 af = *(const LAS bf16x8*)(QB + fr * RS + 32 * ks + 8 * g), bfm = *(const LAS bf16x8*)(KB + fr * RS + 32 * ks + 8 * g);
                acc = __builtin_amdgcn_mfma_f32_16x16x32_bf16(af, bfm, acc, 0, 0, 0); }
#pragma unroll
            for (int r = 0; r < 4; ++r) { const int t = 4 * g + r, s = fr; AM[t * 16 + s] = (bf16)f2bf(s <= t ? acc[r] : 0.f); }
        }
        if (c + 1 < NCHUNK) GM_XFORM((c + 1) & 1);
        if (c + 2 < NCHUNK) GM_LOAD(c + 2);
        LBAR();
        {
            u32x2 vlo; { const float v0 = B_[O_V + (4 * g + 0) * 128 + c0 + fr], v1 = B_[O_V + (4 * g + 1) * 128 + c0 + fr], v2 = B_[O_V + (4 * g + 2) * 128 + c0 + fr], v3 = B_[O_V + (4 * g + 3) * 128 + c0 + fr];
                vlo.x = pk2(v0, v1); vlo.y = pk2(v2, v3); }
            const u32x2 zz = {0u, 0u};
            const bf16x8 vb = mk_frag(vlo, zz);
            f32x4 acco = {0.f, 0.f, 0.f, 0.f};
#pragma unroll
            for (int ks = 0; ks < 4; ++ks) {
                u32x2 slo, shi; slo.x = pk2(Sacc[2 * ks][0], Sacc[2 * ks][1]); slo.y = pk2(Sacc[2 * ks][2], Sacc[2 * ks][3]); shi.x = pk2(Sacc[2 * ks + 1][0], Sacc[2 * ks + 1][1]); shi.y = pk2(Sacc[2 * ks + 1][2], Sacc[2 * ks + 1][3]);
                const bf16x8 sb = mk_frag(slo, shi);
                const u32x2 qlo = *(const LAS u32x2*)(QB + fr * RS + 32 * ks + 4 * g), qhi = *(const LAS u32x2*)(QB + fr * RS + 32 * ks + 16 + 4 * g);
                acco = __builtin_amdgcn_mfma_f32_16x16x32_bf16(mk_frag(qlo, qhi), sb, acco, 0, 0, 0); }
            { const u32x2 alo = *(const LAS u32x2*)(AM + fr * 16 + 4 * g); acco = __builtin_amdgcn_mfma_f32_16x16x32_bf16(mk_frag(alo, zz), vb, acco, 0, 0, 0); }
#pragma unroll
            for (int r = 0; r < 4; ++r) O[(size_t)(c * TC + 4 * g + r) * D + c0 + fr] = acco[r];
#pragma unroll
            for (int i = 0; i < 8; ++i) { const f32x4 bl = *(const LAS f32x4*)(Lf + O_BL + 16 * i + 4 * g); const u32x2 klo = *(const LAS u32x2*)(KT + (16 * i + fr) * 16 + 4 * g);
                Sacc[i] = __builtin_amdgcn_mfma_f32_16x16x32_bf16(mk_frag(klo, zz), vb, Sacc[i] * bl, 0, 0, 0); }
        }
        LBAR();
    }
#undef GM_LOAD
#undef GM_XFORM
}

__device__ __forceinline__ void scan_gdn_mfma_unit(const Args& A, Frame& F, int unit) {
    const int tid = F.tid, lane = F.lane, w = F.wave;
    const int b = unit >> 3, h = unit & 7;
    const int qcol = EC_BQ + h * 128, kcol = EC_BK + h * 128, vcol = EC_BV + h * 128, ocol = 1024 + h * 128;
    const bf16* P = (const bf16*)(A.ws + WS_PROJ) + (size_t)b * SEQ * PROJ_LD;
    float* O = (float*)(A.ws + WS_O) + (size_t)b * SEQ * D + ocol;
    LAS float* Lf = (LAS float*)(F.lds + RING_OFF);
    constexpr int O_CW = 0, O_AMAT = 1536, O_QKM = O_AMAT + 256, O_TB = O_QKM + 128, O_GL = O_TB + 128, O_BUF0 = O_GL + 64;
    constexpr int BUFSZ = 6208, O_KH = 0, O_QH = 2048, O_VV = 4096, O_SC = 6144;
    constexpr int RS = 136;
    constexpr int O_KHB = O_BUF0 + 2 * BUFSZ, O_QHB = O_KHB + 1088, O_QB = O_QHB + 1088, O_KT = O_QB + 1088, O_WSRC = O_KT + 1024, O_WB = O_WSRC + 2048;
    LAS bf16* KHB = (LAS bf16*)(Lf + O_KHB); LAS bf16* QHB = (LAS bf16*)(Lf + O_QHB); LAS bf16* QB = (LAS bf16*)(Lf + O_QB); LAS bf16* KT = (LAS bf16*)(Lf + O_KT);
    LAS bf16* WB = (LAS bf16*)(Lf + O_WB); LAS bf16* QKM = (LAS bf16*)(Lf + O_QKM); LAS bf16* TB = (LAS bf16*)(Lf + O_TB);
    const int tl = tid >> 5, dq = (tid & 31) * 4;
    { const float* cw = A.in[I_GDN_CONV];
      for (int i = tid; i < 4 * 384; i += NTHREADS) { const int jt = i / 384, x = i % 384; Lf[O_CW + i] = cw[jt * 3072 + (x >> 7) * 1024 + h * 128 + (x & 127)]; } }
    const float neg_ea = -__expf(A.in[I_GDN_ALOG][h]), dtb = A.in[I_GDN_DTB][h];
    u32x2 rq[4], rk[4], rv[4]; unsigned short rba = 0, rbb = 0;
#define GD_LOAD(c) do { const int t_ = (c) * TC + tl; \
        _Pragma("unroll") for (int jt = 0; jt < 4; ++jt) { const int tt = t_ - 3 + jt; const bf16* pr = P + (size_t)(tt < 0 ? 0 : tt) * PROJ_LD + dq; \
            rq[jt] = *(const GAS u32x2*)(pr + qcol); rk[jt] = *(const GAS u32x2*)(pr + kcol); rv[jt] = *(const GAS u32x2*)(pr + vcol); \
            if (tt < 0) { rq[jt] = (u32x2){0u, 0u}; rk[jt] = (u32x2){0u, 0u}; rv[jt] = (u32x2){0u, 0u}; } } \
        { const bf16* pr = P + (size_t)t_ * PROJ_LD; rba = pr[EC_BA + h]; rbb = pr[EC_BB + h]; } } while (0)
#define GD_XFORM(bufi) do { LAS float* B_ = Lf + O_BUF0 + (bufi) * BUFSZ; f32x4 q4 = {0.f, 0.f, 0.f, 0.f}, k4 = {0.f, 0.f, 0.f, 0.f}, v4 = {0.f, 0.f, 0.f, 0.f}; \
        _Pragma("unroll") for (int jt = 0; jt < 4; ++jt) { const f32x4 wq = *(const LAS f32x4*)(Lf + O_CW + jt * 384 + dq), wk = *(const LAS f32x4*)(Lf + O_CW + jt * 384 + 128 + dq), wv = *(const LAS f32x4*)(Lf + O_CW + jt * 384 + 256 + dq); \
            q4[0] += wq[0] * bf_lo(rq[jt].x); q4[1] += wq[1] * bf_hi(rq[jt].x); q4[2] += wq[2] * bf_lo(rq[jt].y); q4[3] += wq[3] * bf_hi(rq[jt].y); \
            k4[0] += wk[0] * bf_lo(rk[jt].x); k4[1] += wk[1] * bf_hi(rk[jt].x); k4[2] += wk[2] * bf_lo(rk[jt].y); k4[3] += wk[3] * bf_hi(rk[jt].y); \
            v4[0] += wv[0] * bf_lo(rv[jt].x); v4[1] += wv[1] * bf_hi(rv[jt].x); v4[2] += wv[2] * bf_lo(rv[jt].y); v4[3] += wv[3] * bf_hi(rv[jt].y); } \
        float sq = 0.f, sk = 0.f; \
        _Pragma("unroll") for (int i_ = 0; i_ < 4; ++i_) { q4[i_] = siluf_(q4[i_]); k4[i_] = siluf_(k4[i_]); v4[i_] = siluf_(v4[i_]); sq += q4[i_] * q4[i_]; sk += k4[i_] * k4[i_]; } \
        sq = half_sum32(sq); sk = half_sum32(sk); \
        q4 = q4 * (__builtin_amdgcn_rsqf(sq + EPS) * 0.08838834764831845f); k4 = k4 * __builtin_amdgcn_rsqf(sk + EPS); \
        *(LAS f32x4*)(B_ + O_KH + tl * 128 + dq) = k4; *(LAS f32x4*)(B_ + O_QH + tl * 128 + dq) = q4; *(LAS f32x4*)(B_ + O_VV + tl * 128 + dq) = v4; \
        if ((tid & 31) == 0) { const float ba = __uint_as_float((unsigned)rba << 16), bb = __uint_as_float((unsigned)rbb << 16); \
            f32x4 sc; sc[0] = __expf(neg_ea * softplusf_(ba + dtb)); sc[1] = sigmoidf_(bb); sc[2] = 0.f; sc[3] = 0.f; *(LAS f32x4*)(B_ + O_SC + tl * 4) = sc; } } while (0)
    LBAR();
    GD_LOAD(0); GD_XFORM(0); GD_LOAD(1);
    LBAR();
    f32x4 Sacc[8];
#pragma unroll
    for (int i = 0; i < 8; ++i) Sacc[i] = (f32x4){0.f, 0.f, 0.f, 0.f};
    const int fr = lane & 15, g = lane >> 4, c0 = w * 16;
    const u32x2 zz = {0u, 0u};
    for (int c = 0; c < NCHUNK; ++c) {
        const LAS float* B_ = Lf + O_BUF0 + (c & 1) * BUFSZ;
        float glast;
        {
            const int seg = tid >> 7, d = tid & 127;
            float p = 1.f, gpre = 1.f;
#pragma unroll
            for (int t = 0; t < 16; ++t) { if (t == 4 * seg) gpre = p; p *= B_[O_SC + t * 4]; }
            glast = p;
            unsigned short kt4[4]; float gt = gpre;
#pragma unroll
            for (int i = 0; i < 4; ++i) { const int t = 4 * seg + i; gt *= B_[O_SC + t * 4]; const float beta = B_[O_SC + t * 4 + 1];
                const float kk = B_[O_KH + t * 128 + d], qq = B_[O_QH + t * 128 + d];
                KHB[t * RS + d] = (bf16)f2bf(kk); QHB[t * RS + d] = (bf16)f2bf(qq); QB[t * RS + d] = (bf16)f2bf(qq * gt);
                kt4[i] = (unsigned short)f2bf(kk * glast * __builtin_amdgcn_rcpf(gt));
                Lf[O_WSRC + t * 128 + d] = kk * (beta * gt);
                if (d == 0) Lf[O_GL + t] = gt; }
            u32x2 kw; kw.x = (unsigned)kt4[0] | ((unsigned)kt4[1] << 16); kw.y = (unsigned)kt4[2] | ((unsigned)kt4[3] << 16);
            *(LAS u32x2*)(KT + d * 16 + 4 * seg) = kw;
        }
        LBAR();
        if (w < 2) {
            const LAS bf16* AS = (w == 0) ? KHB : QHB;
            f32x4 acc = {0.f, 0.f, 0.f, 0.f};
#pragma unroll
            for (int ks = 0; ks < 4; ++ks) { const bf16x8 af = *(const LAS bf16x8*)(AS + fr * RS + 32 * ks + 8 * g), bfm = *(const LAS bf16x8*)(KHB + fr * RS + 32 * ks + 8 * g);
                acc = __builtin_amdgcn_mfma_f32_16x16x32_bf16(af, bfm, acc, 0, 0, 0); }
            const float gs_inv = __builtin_amdgcn_rcpf(Lf[O_GL + fr]);
            if (w == 0) {
                f32x4 N1, M1;
#pragma unroll
                for (int r = 0; r < 4; ++r) { const int t = 4 * g + r; const float gt = Lf[O_GL + t];
                    N1[r] = (fr < t) ? -(B_[O_SC + t * 4 + 1] * acc[r] * gt * gs_inv) : 0.f;
                    M1[r] = (t < fr) ? -(B_[O_SC + fr * 4 + 1] * acc[r] * Lf[O_GL + fr] * __builtin_amdgcn_rcpf(gt)) : 0.f; }
#define XTY(X, Y, C0) __builtin_amdgcn_mfma_f32_16x16x4f32(X[3], Y[3], __builtin_amdgcn_mfma_f32_16x16x4f32(X[2], Y[2], __builtin_amdgcn_mfma_f32_16x16x4f32(X[1], Y[1], __builtin_amdgcn_mfma_f32_16x16x4f32(X[0], Y[0], C0, 0, 0, 0), 0, 0, 0), 0, 0, 0), 0, 0, 0)
                const f32x4 z4 = {0.f, 0.f, 0.f, 0.f};
                f32x4 T1t = M1;
#pragma unroll
                for (int r = 0; r < 4; ++r) if (4 * g + r == fr) T1t[r] += 1.f;
                const f32x4 N2 = XTY(M1, N1, z4), M2 = XTY(N1, M1, z4);
                const f32x4 T2t = XTY(N2, T1t, T1t);
                const f32x4 N4 = XTY(M2, N2, z4), M4 = XTY(N2, M2, z4);
                const f32x4 T4t = XTY(N4, T2t, T2t);
                const f32x4 N8 = XTY(M4, N4, z4);
                const f32x4 T8t = XTY(N8, T4t, T4t);
#undef XTY
                u32x2 tw; tw.x = pk2(T8t[0], T8t[1]); tw.y = pk2(T8t[2], T8t[3]);
                *(LAS u32x2*)(TB + fr * 16 + 4 * g) = tw;
            } else {
#pragma unroll
                for (int r = 0; r < 4; ++r) { const int t = 4 * g + r; QKM[t * 16 + fr] = (bf16)f2bf((fr <= t) ? acc[r] * Lf[O_GL + t] * gs_inv : 0.f); }
            }
        }
        if (c + 1 < NCHUNK) GD_XFORM((c + 1) & 1);
        if (c + 2 < NCHUNK) GD_LOAD(c + 2);
        LBAR();
        f32x4 accu = {0.f, 0.f, 0.f, 0.f};
        {
            const bf16x8 tf = mk_frag(*(const LAS u32x2*)(TB + fr * 16 + 4 * g), zz);
            u32x2 ulo, wlo;
            { const float b0 = B_[O_SC + (4 * g + 0) * 4 + 1], b1 = B_[O_SC + (4 * g + 1) * 4 + 1], b2 = B_[O_SC + (4 * g + 2) * 4 + 1], b3 = B_[O_SC + (4 * g + 3) * 4 + 1];
              ulo.x = pk2(b0 * B_[O_VV + (4 * g + 0) * 128 + c0 + fr], b1 * B_[O_VV + (4 * g + 1) * 128 + c0 + fr]); ulo.y = pk2(b2 * B_[O_VV + (4 * g + 2) * 128 + c0 + fr], b3 * B_[O_VV + (4 * g + 3) * 128 + c0 + fr]);
              wlo.x = pk2(Lf[O_WSRC + (4 * g + 0) * 128 + c0 + fr], Lf[O_WSRC + (4 * g + 1) * 128 + c0 + fr]); wlo.y = pk2(Lf[O_WSRC + (4 * g + 2) * 128 + c0 + fr], Lf[O_WSRC + (4 * g + 3) * 128 + c0 + fr]); }
            accu = __builtin_amdgcn_mfma_f32_16x16x32_bf16(tf, mk_frag(ulo, zz), accu, 0, 0, 0);
            f32x4 accw = {0.f, 0.f, 0.f, 0.f};
            accw = __builtin_amdgcn_mfma_f32_16x16x32_bf16(tf, mk_frag(wlo, zz), accw, 0, 0, 0);
#pragma unroll
            for (int r = 0; r < 4; ++r) WB[(4 * g + r) * RS + c0 + fr] = (bf16)f2bf(-accw[r]);
        }
        LBAR();
        {
            bf16x8 sb[4];
#pragma unroll
            for (int ks = 0; ks < 4; ++ks) { u32x2 slo, shi; slo.x = pk2(Sacc[2 * ks][0], Sacc[2 * ks][1]); slo.y = pk2(Sacc[2 * ks][2], Sacc[2 * ks][3]); shi.x = pk2(Sacc[2 * ks + 1][0], Sacc[2 * ks + 1][1]); shi.y = pk2(Sacc[2 * ks + 1][2], Sacc[2 * ks + 1][3]);
                sb[ks] = mk_frag(slo, shi); }
            f32x4 accv = accu, acco = {0.f, 0.f, 0.f, 0.f};
#pragma unroll
            for (int ks = 0; ks < 4; ++ks) {
                const u32x2 wl = *(const LAS u32x2*)(WB + fr * RS + 32 * ks + 4 * g), wh = *(const LAS u32x2*)(WB + fr * RS + 32 * ks + 16 + 4 * g);
                accv = __builtin_amdgcn_mfma_f32_16x16x32_bf16(mk_frag(wl, wh), sb[ks], accv, 0, 0, 0);
                const u32x2 ql = *(const LAS u32x2*)(QB + fr * RS + 32 * ks + 4 * g), qh = *(const LAS u32x2*)(QB + fr * RS + 32 * ks + 16 + 4 * g);
                acco = __builtin_amdgcn_mfma_f32_16x16x32_bf16(mk_frag(ql, qh), sb[ks], acco, 0, 0, 0); }
            u32x2 vn; vn.x = pk2(accv[0], accv[1]); vn.y = pk2(accv[2], accv[3]);
            const bf16x8 vnb = mk_frag(vn, zz);
            acco = __builtin_amdgcn_mfma_f32_16x16x32_bf16(mk_frag(*(const LAS u32x2*)(QKM + fr * 16 + 4 * g), zz), vnb, acco, 0, 0, 0);
#pragma unroll
            for (int r = 0; r < 4; ++r) O[(size_t)(c * TC + 4 * g + r) * D + c0 + fr] = acco[r];
#pragma unroll
            for (int i = 0; i < 8; ++i) { const u32x2 klo = *(const LAS u32x2*)(KT + (16 * i + fr) * 16 + 4 * g);
                Sacc[i] = __builtin_amdgcn_mfma_f32_16x16x32_bf16(mk_frag(klo, zz), vnb, Sacc[i] * glast, 0, 0, 0); }
        }
        LBAR();
    }
#undef GD_LOAD
#undef GD_XFORM
}

__device__ __forceinline__ void scan_rwkv_unit(const Args& A, Frame& F, int unit) {
    const int tid = F.tid, lane = F.lane, w = F.wave;
    const int b = unit >> 4, h = unit & 15;
    const bf16* P = (const bf16*)(A.ws + WS_PROJ) + (size_t)b * SEQ * PROJ_LD + OC_RW;
    const bf16* LO = (const bf16*)(A.ws + WS_LO) + (size_t)b * SEQ * LORA_N;
    bf16* Y = (bf16*)(A.ws + WS_ACTA) + (size_t)b * SEQ * D + 1024 + h * 64;
    LAS float* Lf = (LAS float*)(F.lds + RING_OFF);
    constexpr int BUFSZ = 6208, O_KK = 0, O_WR = 1024, O_W = 2048, O_NKA = 3072, O_K = 4096, O_V = 5120, O_SC = 6144, O_OUT = 2 * BUFSZ;
    const int tl = tid >> 5, d2 = (tid & 31) * 2, hd = h * 64 + d2;
    float mu_r[2], mu_k[2], mu_v[2], w0[2], a0[2], k_k[2], k_a[2], r_k[2], lnw[2], lnb[2];
#pragma unroll
    for (int i = 0; i < 2; ++i) { mu_r[i] = A.in[I_MU][RW_R + hd + i]; mu_k[i] = A.in[I_MU][RW_K + hd + i]; mu_v[i] = A.in[I_MU][RW_V + hd + i];
        w0[i] = A.in[I_W0][hd + i]; a0[i] = A.in[I_A0][hd + i]; k_k[i] = A.in[I_KK][hd + i]; k_a[i] = A.in[I_KA][hd + i]; r_k[i] = A.in[I_RK][hd + i];
        lnw[i] = A.in[I_LNW][hd + i]; lnb[i] = A.in[I_LNB][hd + i]; }
    unsigned rr[2], rk[2], rv[2], rlw, rla, rg_cur = 0u, rg_nxt = 0u;
#define RW_LOAD(c) do { const int t_ = (c) * TC + tl; const bf16* pr = P + (size_t)t_ * PROJ_LD; \
        rr[0] = *(const GAS unsigned*)(pr + RW_R + hd); rk[0] = *(const GAS unsigned*)(pr + RW_K + hd); rv[0] = *(const GAS unsigned*)(pr + RW_V + hd); \
        if (t_ > 0) { rr[1] = *(const GAS unsigned*)(pr - PROJ_LD + RW_R + hd); rk[1] = *(const GAS unsigned*)(pr - PROJ_LD + RW_K + hd); rv[1] = *(const GAS unsigned*)(pr - PROJ_LD + RW_V + hd); } \
        else { rr[1] = 0u; rk[1] = 0u; rv[1] = 0u; } \
        const bf16* lr = LO + (size_t)t_ * LORA_N; rlw = *(const GAS unsigned*)(lr + hd); rla = *(const GAS unsigned*)(lr + 1024 + hd); rg_nxt = *(const GAS unsigned*)(lr + 2048 + hd); } while (0)
#define RW_XFORM(bufi) do { LAS float* B_ = Lf + (bufi) * BUFSZ; f32x2 kk2, wr2, w2_, nka2, k2, v2_; float skk = 0.f, sc1 = 0.f, sc2 = 0.f, sbs = 0.f; float aa[2], rrv[2]; \
        _Pragma("unroll") for (int i_ = 0; i_ < 2; ++i_) { \
            const float r0 = i_ ? bf_hi(rr[0]) : bf_lo(rr[0]), r1 = i_ ? bf_hi(rr[1]) : bf_lo(rr[1]); \
            const float k0_ = i_ ? bf_hi(rk[0]) : bf_lo(rk[0]), k1_ = i_ ? bf_hi(rk[1]) : bf_lo(rk[1]); \
            const float v0_ = i_ ? bf_hi(rv[0]) : bf_lo(rv[0]), v1_ = i_ ? bf_hi(rv[1]) : bf_lo(rv[1]); \
            const float lw = i_ ? bf_hi(rlw) : bf_lo(rlw), la = i_ ? bf_hi(rla) : bf_lo(rla); \
            const float r_ = r0 + (r1 - r0) * mu_r[i_], kx = k0_ + (k1_ - k0_) * mu_k[i_], vx = v0_ + (v1_ - v0_) * mu_v[i_]; \
            const float wd = __expf(-0.6065306597126334f * sigmoidf_(w0[i_] + lw)); const float a_ = sigmoidf_(a0[i_] + la); \
            const float kk0 = kx * k_k[i_]; const float km = kx * (1.f + (a_ - 1.f) * k_a[i_]); \
            kk2[i_] = kk0; skk += kk0 * kk0; aa[i_] = a_; rrv[i_] = r_; wr2[i_] = wd * r_; w2_[i_] = wd; k2[i_] = km; v2_[i_] = vx; sc2 += km * r_; sbs += r_ * km * r_k[i_]; } \
        skk = half_sum32(skk); const float rkk = __builtin_amdgcn_rsqf(skk + EPS); \
        _Pragma("unroll") for (int i_ = 0; i_ < 2; ++i_) { kk2[i_] *= rkk; nka2[i_] = -(kk2[i_] * aa[i_]); sc1 += kk2[i_] * aa[i_] * rrv[i_]; } \
        sc1 = half_sum32(sc1); sc2 = half_sum32(sc2); sbs = half_sum32(sbs); \
        *(LAS f32x2*)(B_ + O_KK + tl * 64 + d2) = kk2; *(LAS f32x2*)(B_ + O_WR + tl * 64 + d2) = wr2; *(LAS f32x2*)(B_ + O_W + tl * 64 + d2) = w2_; \
        *(LAS f32x2*)(B_ + O_NKA + tl * 64 + d2) = nka2; *(LAS f32x2*)(B_ + O_K + tl * 64 + d2) = k2; *(LAS f32x2*)(B_ + O_V + tl * 64 + d2) = v2_; \
        if ((tid & 31) == 0) { f32x4 sc; sc[0] = sc1; sc[1] = sc2; sc[2] = sbs; sc[3] = 0.f; *(LAS f32x4*)(B_ + O_SC + tl * 4) = sc; } } while (0)
    RW_LOAD(0); RW_XFORM(0); rg_cur = rg_nxt;
    LBAR();
    f32x2 S2[4];
#pragma unroll
    for (int i = 0; i < 4; ++i) S2[i] = (f32x2){0.f, 0.f};
    const int j = lane & 15, col = w * 8 + (lane >> 4) * 2;
    for (int c = 0; c < NCHUNK; ++c) {
        if (c + 1 < NCHUNK) RW_LOAD(c + 1);
        const LAS float* B_ = Lf + (c & 1) * BUFSZ;
        float os0 = 0.f, os1 = 0.f;
        f32x4 kk, wr, ww, nka, kv, sc, nkk, nwr, nww, nnka, nkv, nsc; f32x2 v2, nv2;
#define RW_LDSTEP(t_, KK, WR, WW, NKA, KV, V2, SC) do { KK = *(const LAS f32x4*)(B_ + O_KK + (t_) * 64 + 4 * j); WR = *(const LAS f32x4*)(B_ + O_WR + (t_) * 64 + 4 * j); WW = *(const LAS f32x4*)(B_ + O_W + (t_) * 64 + 4 * j); \
            NKA = *(const LAS f32x4*)(B_ + O_NKA + (t_) * 64 + 4 * j); KV = *(const LAS f32x4*)(B_ + O_K + (t_) * 64 + 4 * j); V2 = *(const LAS f32x2*)(B_ + O_V + (t_) * 64 + col); SC = *(const LAS f32x4*)(B_ + O_SC + (t_) * 4); } while (0)
        RW_LDSTEP(0, kk, wr, ww, nka, kv, v2, sc);
#pragma unroll
        for (int t = 0; t < TC; ++t) {
            if (t + 1 < TC) { RW_LDSTEP(t + 1, nkk, nwr, nww, nnka, nkv, nv2, nsc); }
            __builtin_amdgcn_sched_barrier(0);
            f32x2 d1 = S2[0] * kk[0], d2 = S2[0] * wr[0], e1 = S2[1] * kk[1], e2 = S2[1] * wr[1];
            d1 += S2[2] * kk[2]; d2 += S2[2] * wr[2]; e1 += S2[3] * kk[3]; e2 += S2[3] * wr[3];
            d1 += e1; d2 += e2;
            { float r0_ = d1[0], r1_ = d1[1], r2_ = d2[0], r3_ = d2[1]; row_sum16_x4(r0_, r1_, r2_, r3_); d1[0] = r0_; d1[1] = r1_; d2[0] = r2_; d2[1] = r3_; }
            const f32x2 o2 = d2 - d1 * sc[0] + v2 * sc[1];
#pragma unroll
            for (int i = 0; i < 4; ++i) S2[i] = S2[i] * ww[i] + d1 * nka[i] + v2 * kv[i];
            os0 = (j == t) ? o2[0] : os0; os1 = (j == t) ? o2[1] : os1;
            kk = nkk; wr = nwr; ww = nww; nka = nnka; kv = nkv; v2 = nv2; sc = nsc;
        }
#undef RW_LDSTEP
        { f32x2 o2 = {os0, os1}; *(LAS f32x2*)(Lf + O_OUT + j * 64 + col) = o2; }
        if (c + 1 < NCHUNK) RW_XFORM((c + 1) & 1);
        LBAR();
        {
            const f32x2 o2 = *(const LAS f32x2*)(Lf + O_OUT + tl * 64 + d2); const f32x2 vv = *(const LAS f32x2*)(B_ + O_V + tl * 64 + d2); const float bs = B_[O_SC + tl * 4 + 2];
            const float mean = half_sum32(o2[0] + o2[1]) * (1.0f / 64.0f); const float e0 = o2[0] - mean, e1 = o2[1] - mean;
            const float var = half_sum32(e0 * e0 + e1 * e1) * (1.0f / 64.0f); const float rs = __builtin_amdgcn_rsqf(var + 64e-5f);
            const float y0 = (e0 * rs * lnw[0] + lnb[0] + bs * vv[0]) * bf_lo(rg_cur), y1 = (e1 * rs * lnw[1] + lnb[1] + bs * vv[1]) * bf_hi(rg_cur);
            *(GAS unsigned*)(Y + (size_t)(c * TC + tl) * D + d2) = pk2(y0, y1);
        }
        rg_cur = rg_nxt;
        LBAR();
    }
#undef RW_LOAD
#undef RW_XFORM
}

template <int LAYER>
__device__ __forceinline__ void post_rows(const Args& A, Frame& F) {
    const int gw = F.vcu * NWAVES + F.wave, NGW = F.G * NWAVES, lane = F.lane;
    const float* O = (const float*)(A.ws + WS_O); const bf16* P = (const bf16*)(A.ws + WS_PROJ); bf16* Y = (bf16*)(A.ws + WS_ACTA);
    for (int m = gw; m < T; m += NGW) {
        const GAS f32x4* orow = (const GAS f32x4*)(O + (size_t)m * D) + lane; const bf16* prow = P + (size_t)m * PROJ_LD;
        constexpr int NJ = LAYER == 0 ? 8 : 4;
#pragma unroll
        for (int jj = 0; jj < NJ; ++jj) {
            const f32x4 v = orow[64 * jj]; float ss = (v[0] * v[0] + v[1] * v[1]) + (v[2] * v[2] + v[3] * v[3]);
            const bool wide = (LAYER == 0 && jj < 4);
            const float ms = wide ? wave_sum(ss) * (1.0f / 256.0f) : half_sum32(ss) * (1.0f / 128.0f);
            const float r = __builtin_amdgcn_rsqf(ms + EPS);
            const int cih = wide ? 4 * lane : 4 * (lane & 31);
            const float* gsrc = LAYER == 0 ? (wide ? A.in[I_GLA_NORM] : A.in[I_GDN_NORM]) : A.in[I_HG_NORM];
            const f32x4 g = *(const GAS f32x4*)(gsrc + cih);
            const int zcol = LAYER == 0 ? (wide ? EC_GZ + jj * 256 + 4 * lane : EC_BZ + (jj - 4) * 256 + 4 * lane) : OC_HG + jj * 256 + 4 * lane;
            const u32x2 zw = *(const GAS u32x2*)(prow + zcol);
            const float y0 = v[0] * r * g[0] * siluf_(bf_lo(zw.x)), y1 = v[1] * r * g[1] * siluf_(bf_hi(zw.x)), y2 = v[2] * r * g[2] * siluf_(bf_lo(zw.y)), y3 = v[3] * r * g[3] * siluf_(bf_hi(zw.y));
            u32x2 o; o.x = pk2(y0, y1); o.y = pk2(y2, y3);
            *(GAS u32x2*)(Y + (size_t)m * D + 256 * jj + 4 * lane) = o;
        }
    }
}
__device__ __forceinline__ void lora_prep_rows(const Args& A, Frame& F) {
    const int gw = F.vcu * NWAVES + F.wave, NGW = F.G * NWAVES, lane = F.lane;
    const bf16* P = (const bf16*)(A.ws + WS_PROJ); bf16* LA = (bf16*)(A.ws + WS_LA); const float* mu = A.in[I_MU];
    for (int m = gw; m < T; m += NGW) { const bool hasprev = (m % SEQ) != 0; const bf16* prow = P + (size_t)m * PROJ_LD + OC_RW + RW_WL;
#pragma unroll
        for (int i = 0; i < 7; ++i) { const int c = lane + 64 * i;
            const float x = __uint_as_float((unsigned)prow[c] << 16), xp = hasprev ? __uint_as_float((unsigned)prow[c - PROJ_LD] << 16) : 0.f;
            const float ts = x + (xp - x) * mu[RW_WL + c];
            const float v = c < 96 ? tanhf(ts) : (c < 192 ? ts : sigmoidf_(ts));
            LA[(size_t)m * LORA_K + c] = (bf16)f2bf(v); }
        LA[(size_t)m * LORA_K + 448 + lane] = (bf16)0; }
}
__device__ __forceinline__ void final_rows(const Args& A, Frame& F, const float oscale) {
    const int gw = F.vcu * NWAVES + F.wave, NGW = F.G * NWAVES, lane = F.lane;
    const float* rowss = (const float*)(A.ws + WS_RSP) + (size_t)RS_FINAL * T * 32; const GAS f32x4* g = (const GAS f32x4*)A.in[I_NFINAL] + lane;
    for (int m = gw; m < T; m += NGW) { const float r = oscale * __builtin_amdgcn_rsqf(wave_sum(lane < 32 ? rowss[(size_t)m * 32 + lane] : 0.f) * (1.0f / D) + EPS); GAS f32x4* row = (GAS f32x4*)(A.out + (size_t)m * D) + lane;
#pragma unroll
        for (int jj = 0; jj < 8; ++jj) { const f32x4 v = row[64 * jj]; row[64 * jj] = v * r * g[64 * jj]; } }
}

__device__ __forceinline__ int med3i(int a, int b, int c) { int r; asm("v_med3_i32 %0, %1, %2, %3" : "=v"(r) : "v"(a), "v"(b), "v"(c)); return r; }
__device__ __forceinline__ int f2sort(float f) { int x = __float_as_int(f); return x ^ ((x >> 31) & 0x7fffffff); }
__device__ __forceinline__ float sort2f(int x) { return __int_as_float(x ^ ((x >> 31) & 0x7fffffff)); }
#define TOPK_INSERT(vals, x) do { _Pragma("unroll") for (int s_ = 15; s_ >= 1; --s_) vals[s_] = med3i((x), vals[s_ - 1], vals[s_]); vals[0] = max(vals[0], (x)); } while (0)
__device__ __forceinline__ float bf_dot2(unsigned a, unsigned b, float c) {
    return c + bf_lo(a) * bf_lo(b) + bf_hi(a) * bf_hi(b);
}
__device__ __forceinline__ void peer_phase(const Args& A, Frame& F, int L, const bool dry) {
    const int gw = F.vcu * NWAVES + F.wave, NGW = F.G * NWAVES, lane = F.lane;
    const bf16* SCR = (const bf16*)(A.ws + WS_SC); const bf16* X = (const bf16*)(A.ws + WS_ACTB); bf16* HG = (bf16*)(A.ws + WS_ACTA);
    const unsigned char* TU = (const unsigned char*)(A.ws + WS_TABU) + (size_t)L * 16384 * D; const unsigned char* TV = (const unsigned char*)(A.ws + WS_TABV) + (size_t)L * 16384 * D;
    const float* rowss = (const float*)(A.ws + WS_RSP) + (size_t)(L == 0 ? RS_FFN0 : RS_FFN1) * T * 32;
    const float* gple = A.in[I_NPLE] + (size_t)L * D;
    float* H = A.out;
    LAS unsigned* LIST = (LAS unsigned*)(F.lds + RING_OFF + F.wave * 16384);
    LAS unsigned* EIDX = LIST + 1024;
    LAS float* ECOEF = (LAS float*)(EIDX + 512);
    LAS unsigned* SIDX = EIDX + 1024;
    LAS float* SCOEF = (LAS float*)(EIDX + 1536);
    for (int tb = gw; tb < T / 4; tb += NGW) {
        const int t0 = tb * 4;
        {
            const bf16* sp = SCR + (size_t)(t0 + (lane >> 4)) * D + (lane & 15) * 128;
            int vals[16];
#pragma unroll
            for (int s = 0; s < 16; ++s) vals[s] = (int)0x80000000;
#pragma unroll 2
            for (int c = 0; c < 16; ++c) { const v4u wv = *(const GAS v4u*)(sp + c * 8); const unsigned ww[4] = {wv.x, wv.y, wv.z, wv.w};
#pragma unroll
                for (int e = 0; e < 8; ++e) { const unsigned bits = (e & 1) ? (ww[e >> 1] & 0xffff0000u) : (ww[e >> 1] << 16);
                    int x = (int)bits; x ^= (x >> 31) & 0x7fffffff; x = (x & ~0x7f) | (127 - (c * 8 + e));
                    TOPK_INSERT(vals, x); } }
#pragma unroll
            for (int q = 0; q < 4; ++q) { v4u o; o.x = (unsigned)vals[4 * q]; o.y = (unsigned)vals[4 * q + 1]; o.z = (unsigned)vals[4 * q + 2]; o.w = (unsigned)vals[4 * q + 3]; *(LAS v4u*)(LIST + lane * 16 + 4 * q) = o; }
        }
        LDS_WAIT(); asm volatile("" ::: "memory");
        if (lane < 32) {
            const LAS unsigned* la = LIST + ((lane >> 3) * 16 + (lane & 7) * 2) * 16; const LAS unsigned* lb2 = la + 16;
            float av[16], bv[16];
#pragma unroll
            for (int q = 0; q < 4; ++q) { const v4u a4 = *(const LAS v4u*)(la + 4 * q), b4 = *(const LAS v4u*)(lb2 + 4 * q); const unsigned aw[4] = {a4.x, a4.y, a4.z, a4.w}, bw[4] = {b4.x, b4.y, b4.z, b4.w};
#pragma unroll
                for (int e = 0; e < 4; ++e) { av[4 * q + e] = __uint_as_float(__float_as_uint(sort2f((int)(aw[e] & ~0x7fu))) & 0xffff0000u); bv[4 * q + e] = __uint_as_float(__float_as_uint(sort2f((int)(bw[e] & ~0x7fu))) & 0xffff0000u); } }
            int best[16];
#pragma unroll
            for (int s = 0; s < 16; ++s) best[s] = (int)0x80000000;
#pragma unroll
            for (int i = 0; i < 16; ++i)
#pragma unroll
                for (int jx = 0; jx < 16; ++jx) if ((i + 1) * (jx + 1) <= 16) { int x = f2sort(av[i] + bv[jx]); x = (x & ~0xff) | (255 - (i * 16 + jx)); TOPK_INSERT(best, x); }
            float sv[16]; unsigned ex[16];
#pragma unroll
            for (int s = 0; s < 16; ++s) { const int cand = 255 - (best[s] & 0xff); const unsigned ka = la[cand >> 4], kb = lb2[cand & 15];
                ex[s] = (127u - (ka & 0x7fu)) * 128u + (127u - (kb & 0x7fu));
                sv[s] = __uint_as_float(__float_as_uint(sort2f((int)(ka & ~0x7fu))) & 0xffff0000u) + __uint_as_float(__float_as_uint(sort2f((int)(kb & ~0x7fu))) & 0xffff0000u); }
            float mx = sv[0];
#pragma unroll
            for (int s = 1; s < 16; ++s) mx = fmaxf(mx, sv[s]);
            float den = 0.f;
#pragma unroll
            for (int s = 0; s < 16; ++s) { sv[s] = __expf(sv[s] - mx); den += sv[s]; }
            const float inv = 1.0f / den; const int base = (lane >> 3) * 128 + (lane & 7) * 16;
#pragma unroll
            for (int s = 0; s < 16; ++s) { EIDX[base + s] = ex[s]; ECOEF[base + s] = sv[s] * inv; }
        }
        LDS_WAIT(); asm volatile("" ::: "memory");
        for (int tok = 0; tok < 4; ++tok) {
            const unsigned k0 = (EIDX[tok * 128 + lane] << 7) | (unsigned)lane, k1 = (EIDX[tok * 128 + 64 + lane] << 7) | (unsigned)(64 + lane);
            const float g0 = ECOEF[tok * 128 + lane], g1 = ECOEF[tok * 128 + 64 + lane];
            int r0 = 0, r1 = 0;
#pragma unroll 4
            for (int jx = 0; jx < 32; ++jx) { const v4u kq = *(const LAS v4u*)(EIDX + tok * 128 + 4 * jx); const unsigned kk[4] = {kq.x, kq.y, kq.z, kq.w};
#pragma unroll
                for (int e = 0; e < 4; ++e) { const unsigned kj = (kk[e] << 7) | (unsigned)(4 * jx + e); r0 += (kj < k0) ? 1 : 0; r1 += (kj < k1) ? 1 : 0; } }
            SIDX[tok * 128 + r0] = k0 >> 7; SCOEF[tok * 128 + r0] = g0; SIDX[tok * 128 + r1] = k1 >> 7; SCOEF[tok * 128 + r1] = g1;
        }
        LDS_WAIT(); asm volatile("" ::: "memory");
        for (int tok = 0; tok < 4; ++tok) {
            const int t = t0 + tok;
            const float rs = __builtin_amdgcn_rsqf(wave_sum(lane < 32 ? rowss[(size_t)t * 32 + lane] : 0.f) * (1.0f / D) + EPS) * (1.0f / 512.0f);
            float xf[32];
#pragma unroll
            for (int jj = 0; jj < 2; ++jj) { const v4u x0 = *(const GAS v4u*)(X + (size_t)t * D + 1024 * jj + 16 * lane), x1 = *(const GAS v4u*)(X + (size_t)t * D + 1024 * jj + 16 * lane + 8);
                const unsigned xw[8] = {x0.x, x0.y, x0.z, x0.w, x1.x, x1.y, x1.z, x1.w};
#pragma unroll
                for (int e = 0; e < 8; ++e) { xf[jj * 16 + 2 * e] = bf_lo(xw[e]); xf[jj * 16 + 2 * e + 1] = bf_hi(xw[e]); } }
            const LAS unsigned* sidx = SIDX + tok * 128; LAS float* scoef = SCOEF + tok * 128;
#define PEER_LOADG(dst, TAB, kbase) do { _Pragma("unroll") for (int q_ = 0; q_ < 4; ++q_) { const unsigned e_ = __builtin_amdgcn_readfirstlane(sidx[(kbase) + q_]); const unsigned char* p_ = (TAB) + (size_t)e_ * D + 16 * lane; \
            dst[q_][0] = *(const GAS v4u*)(p_); dst[q_][1] = *(const GAS v4u*)(p_ + 1024); } } while (0)
#define PEER_UCOMP(src, kbase) do { float a_[4]; \
            _Pragma("unroll") for (int q_ = 0; q_ < 4; ++q_) { float acc0 = 0.f, acc1 = 0.f; \
                _Pragma("unroll") for (int jj_ = 0; jj_ < 2; ++jj_) { const unsigned ww_[4] = {src[q_][jj_].x, src[q_][jj_].y, src[q_][jj_].z, src[q_][jj_].w}; \
                    _Pragma("unroll") for (int e_ = 0; e_ < 4; ++e_) { const f32x2 lo_ = __builtin_amdgcn_cvt_pk_f32_fp8((int)ww_[e_], false), hi_ = __builtin_amdgcn_cvt_pk_f32_fp8((int)ww_[e_], true); \
                        acc0 += xf[jj_ * 16 + 4 * e_] * lo_[0]; acc1 += xf[jj_ * 16 + 4 * e_ + 1] * lo_[1]; acc0 += xf[jj_ * 16 + 4 * e_ + 2] * hi_[0]; acc1 += xf[jj_ * 16 + 4 * e_ + 3] * hi_[1]; } } \
                a_[q_] = acc0 + acc1; } \
              \
            { const bool b0_ = lane & 1, b1_ = lane & 2; \
              float s0_ = b0_ ? a_[1] : a_[0], o0_ = b0_ ? a_[0] : a_[1], s1_ = b0_ ? a_[3] : a_[2], o1_ = b0_ ? a_[2] : a_[3]; \
              s0_ += __shfl_xor(o0_, 1); s1_ += __shfl_xor(o1_, 1); \
              float s_ = b1_ ? s1_ : s0_, o_ = b1_ ? s0_ : s1_; s_ += __shfl_xor(o_, 2); \
              s_ += __shfl_xor(s_, 4); s_ += __shfl_xor(s_, 8); s_ += __shfl_xor(s_, 16); s_ += __shfl_xor(s_, 32); \
              const float d_ = s_ * rs; const float act_ = 0.5f * d_ * (1.0f + erff(d_ * 0.7071067811865476f)); \
              if (lane < 4) scoef[(kbase) + lane] *= act_ * (1.0f / 16.0f); } } while (0)
            {
                v4u ua[4][2], ub[4][2];
                PEER_LOADG(ua, TU, 0);
#pragma unroll 1
                for (int k = 0; k < 128; k += 8) {
                    PEER_LOADG(ub, TU, k + 4);
                    PEER_UCOMP(ua, k);
                    if (k + 8 < 128) PEER_LOADG(ua, TU, k + 8);
                    PEER_UCOMP(ub, k + 4);
                }
            }
            LDS_WAIT(); asm volatile("" ::: "memory");
            float out[32];
#pragma unroll
            for (int i = 0; i < 32; ++i) out[i] = 0.f;
#define PEER_VCOMP(src, kbase) do { const f32x4 cf_ = *(const LAS f32x4*)(scoef + (kbase)); \
            _Pragma("unroll") for (int q_ = 0; q_ < 4; ++q_) \
                _Pragma("unroll") for (int jj_ = 0; jj_ < 2; ++jj_) { const unsigned ww_[4] = {src[q_][jj_].x, src[q_][jj_].y, src[q_][jj_].z, src[q_][jj_].w}; \
                    _Pragma("unroll") for (int e_ = 0; e_ < 4; ++e_) { const f32x2 lo_ = __builtin_amdgcn_cvt_pk_f32_fp8((int)ww_[e_], false), hi_ = __builtin_amdgcn_cvt_pk_f32_fp8((int)ww_[e_], true); \
                        out[jj_ * 16 + 4 * e_] += cf_[q_] * lo_[0]; out[jj_ * 16 + 4 * e_ + 1] += cf_[q_] * lo_[1]; out[jj_ * 16 + 4 * e_ + 2] += cf_[q_] * hi_[0]; out[jj_ * 16 + 4 * e_ + 3] += cf_[q_] * hi_[1]; } } } while (0)
            {
                v4u va[4][2], vb[4][2];
                PEER_LOADG(va, TV, 0);
#pragma unroll 1
                for (int k = 0; k < 128; k += 8) {
                    PEER_LOADG(vb, TV, k + 4);
                    PEER_VCOMP(va, k);
                    if (k + 8 < 128) PEER_LOADG(va, TV, k + 8);
                    PEER_VCOMP(vb, k + 4);
                }
            }
#undef PEER_LOADG
#undef PEER_UCOMP
#undef PEER_VCOMP
            float ss = 0.f;
#pragma unroll
            for (int jj = 0; jj < 2; ++jj) { GAS f32x4* hp = (GAS f32x4*)(H + (size_t)t * D + 1024 * jj + 16 * lane);
#pragma unroll
                for (int q = 0; q < 4; ++q) { f32x4 h0 = hp[q];
#pragma unroll
                    for (int e = 0; e < 4; ++e) { h0[e] += out[jj * 16 + 4 * q + e]; out[jj * 16 + 4 * q + e] = h0[e]; ss += h0[e] * h0[e]; }
                    if (!dry) hp[q] = h0; } }
            const float r3 = __builtin_amdgcn_rsqf(wave_sum(ss) * (1.0f / D) + EPS);
#pragma unroll
            for (int jj = 0; jj < 2; ++jj) { const GAS f32x4* gp = (const GAS f32x4*)(gple + 1024 * jj + 16 * lane);
#pragma unroll
                for (int hh = 0; hh < 2; ++hh) { const f32x4 g0 = gp[2 * hh], g1 = gp[2 * hh + 1]; const float* oo = out + jj * 16 + 8 * hh;
                    v4u o; o.x = pk2(oo[0] * r3 * g0[0], oo[1] * r3 * g0[1]); o.y = pk2(oo[2] * r3 * g0[2], oo[3] * r3 * g0[3]);
                    o.z = pk2(oo[4] * r3 * g1[0], oo[5] * r3 * g1[1]); o.w = pk2(oo[6] * r3 * g1[2], oo[7] * r3 * g1[3]);
                    if (!dry) *(GAS v4u*)(HG + (size_t)t * D + 1024 * jj + 16 * lane + 8 * hh) = o; else asm volatile("" :: "v"(o.x), "v"(o.y), "v"(o.z), "v"(o.w)); } }
        }
        LDS_WAIT(); asm volatile("" ::: "memory");
    }
}

constexpr int N_PHASES = 19;
__global__ void __launch_bounds__(NTHREADS, 2) mega_fwd(Args args) {
    extern __shared__ __attribute__((aligned(16))) unsigned char lds[];
    Frame F;
    F.lds = (LAS unsigned char*)lds;
    F.MISC = (volatile LAS unsigned*)(F.lds + MISC_OFF);
    F.tid = threadIdx.x; F.lane = F.tid & 63; F.wave = __builtin_amdgcn_readfirstlane(F.tid >> 6);
    F.G = gridDim.x; { const int bx = blockIdx.x; F.vcu = (F.G % 8 == 0) ? (bx % 8) * (F.G / 8) + bx / 8 : bx; }
    unsigned char* ws = args.ws;
    F.ctl = (gu32*)(ws + WS_CTL);
    for (int u = F.tid; u < (LDS_BYTES - LDSCTL_OFF) / 4; u += NTHREADS) ((LAS unsigned*)(F.lds + LDSCTL_OFF))[u] = 0u;
    __syncthreads();
    const int lo = args.ph_lo, hi = args.ph_hi;
    XcdBarrier bar; bar.bar = (unsigned*)(F.ctl + CW_BAR); bar.x = 0; bar.st = nullptr;
    if (hi - lo > 1) bar = xcd_barrier_post((unsigned*)(F.ctl + CW_BAR), F.MISC + 8);
#define IN(k) (lo <= (k) && (k) < hi)
#define REPS(k) (1 + ((DUP_MASK >> (k)) & 1))
#if PROBE_MASK
    unsigned long long* const tsb = (unsigned long long*)(ws + WS_CTL + 65536);
#define STAMP(k) do { if (blockIdx.x == 0 && F.tid == 0) __hip_atomic_store(tsb + (k), __builtin_amdgcn_s_memrealtime(), __ATOMIC_RELAXED, __HIP_MEMORY_SCOPE_AGENT); } while (0)
    STAMP(31);
#else
#define STAMP(k) do { } while (0)
#endif
#define SEAM(k) do { if (IN(k) && IN((k) + 1)) { if ((k) == 0) { cg::this_grid().sync(); } else { xcd_barrier(bar); } STAMP(k); } } while (0)
    float* rowss = (float*)(ws + WS_RSP);
    bf16* ACTA = (bf16*)(ws + WS_ACTA); bf16* ACTB = (bf16*)(ws + WS_ACTB); bf16* PROJ = (bf16*)(ws + WS_PROJ); bf16* SCB = (bf16*)(ws + WS_SC); bf16* PP = (bf16*)(ws + WS_PP);
    const int gtid = (F.vcu * NWAVES + F.wave) * 64 + F.lane, gthreads = F.G * NTHREADS;

#if UBENCH
    {
        typedef _Float16 h2_t __attribute__((ext_vector_type(2)));
        float a[32]; f32x2 p[16]; h2_t hh[32];
#pragma unroll
        for (int i = 0; i < 32; ++i) { a[i] = (float)(F.tid + i); hh[i] = (h2_t){(_Float16)(F.lane + i), (_Float16)i}; }
#pragma unroll
        for (int i = 0; i < 16; ++i) p[i] = (f32x2){a[2 * i], a[2 * i + 1]};
        const float m = 1.0f + 1e-7f * F.lane, c = 1e-9f; const f32x2 m2 = {m, m}, c2 = {c, c}; const h2_t mh = {(_Float16)1.0f, (_Float16)1.0f}, ch = {(_Float16)0.0f, (_Float16)0.0f};
#pragma unroll 1
        for (int it = 0; it < 10000; ++it) {
#if UBENCH == 1
#pragma unroll
            for (int i = 0; i < 32; ++i) asm volatile("v_fma_f32 %0, %0, %1, %2" : "+v"(a[i]) : "v"(m), "v"(c));
#elif UBENCH == 2
#pragma unroll
            for (int i = 0; i < 16; ++i) asm volatile("v_pk_fma_f32 %0, %0, %1, %2\n\tv_pk_fma_f32 %0, %0, %1, %2" : "+v"(p[i]) : "v"(m2), "v"(c2));
#elif UBENCH == 3
#pragma unroll
            for (int i = 0; i < 32; ++i) asm volatile("v_pk_fma_f16 %0, %0, %1, %2" : "+v"(hh[i]) : "v"(mh), "v"(ch));
#endif
        }
        float s = 0.f;
#pragma unroll
        for (int i = 0; i < 32; ++i) s += a[i] + (float)hh[i][0];
#pragma unroll
        for (int i = 0; i < 16; ++i) s += p[i][0] + p[i][1];
        if (s == 12345.678f) args.out[0] = s;
    }
#endif
    if (IN(0)) { p0_prologue(args, F); } SEAM(0);
    if (IN(1)) for (int rep_ = 0; rep_ < REPS(1); ++rep_) {
        { pg8::Gemm g{ACTA, (const bf16*)(ws + WS_WEV_IN), T, EV_NP, D}; pg8::StaticOrder S; S.init(T, EV_NP, F.G, (int)blockIdx.x); EpiBf16S E{PROJ, PROJ_LD, nullptr};
          pg8::gemm_phase<EpiBf16S, pg8::StaticOrder, true, true>(F.lds + RING_OFF, g, S, E); }
        { pg8::Gemm g{(const bf16*)(ws + WS_PBF), (const bf16*)(ws + WS_WPROJ), T, D, 256}; pg8::StaticOrder S; S.init(T, D, F.G, (int)blockIdx.x); EpiBf16S E{PP, D, nullptr};
          pg8::gemm_phase<EpiBf16S, pg8::StaticOrder, true, true>(F.lds + RING_OFF, g, S, E); }
    } SEAM(1);
    if (IN(2)) for (int rep_ = 0; rep_ < REPS(2); ++rep_) { for (int u = F.vcu; u < 128; u += F.G) { if (u < 64) scan_gla_mfma_unit<0>(args, F, u); else scan_gdn_mfma_unit(args, F, u - 64); __syncthreads(); } } SEAM(2);
    if (IN(3)) for (int rep_ = 0; rep_ < REPS(3); ++rep_) { post_rows<0>(args, F); } SEAM(3);
    if (IN(4)) { pg8::Gemm g{ACTA, (const bf16*)(ws + WS_WEV_OUT), T, D, D}; pg8::StaticOrder S; S.init(T, D, F.G, (int)blockIdx.x);
        EpiResid<false> E{args.in[I_X], args.out, ACTB, args.in[I_NFFN], rowss + (size_t)RS_FFN0 * T * 32, nullptr};
        pg8::gemm_phase<EpiResid<false>, pg8::StaticOrder, true, true>(F.lds + RING_OFF, g, S, E); } SEAM(4);
    if (IN(5)) for (int rep_ = 0; rep_ < REPS(5); ++rep_) { pg8::Gemm g{ACTB, (const bf16*)(ws + WS_WPEER), T, D, D}; pg8::StaticOrder S; S.init(T, D, F.G, (int)blockIdx.x); EpiBf16S E{SCB, D, rowss + (size_t)RS_FFN0 * T * 32};
        pg8::gemm_phase<EpiBf16S, pg8::StaticOrder, true, true>(F.lds + RING_OFF, g, S, E); } SEAM(5);
    if (IN(6)) for (int rep_ = 0; rep_ < REPS(6); ++rep_) { peer_phase(args, F, 0, rep_ != 0); } SEAM(6);
    if (IN(7)) { { pg8::Gemm g{ACTA, (const bf16*)(ws + WS_WGATE), T, D, D}; pg8::StaticOrder S; S.init(T, D, F.G, (int)blockIdx.x);
        EpiResid<true> E{args.out, args.out, ACTB, args.in[I_NMIX] + D, rowss + (size_t)RS_MIX1 * T * 32, PP};
        pg8::gemm_phase<EpiResid<true>, pg8::StaticOrder, true, true>(F.lds + RING_OFF, g, S, E); }
        } SEAM(7);
    if (IN(8)) for (int rep_ = 0; rep_ < REPS(8); ++rep_) {
        { pg8::Gemm g{ACTB, (const bf16*)(ws + WS_WOD_IN), T, OD_NP, D}; pg8::StaticOrder S; S.init(T, OD_NP, F.G, (int)blockIdx.x); EpiBf16S E{PROJ, PROJ_LD, rowss + (size_t)RS_MIX1 * T * 32};
          pg8::gemm_phase<EpiBf16S, pg8::StaticOrder, true, true>(F.lds + RING_OFF, g, S, E); }
        { pg8::Gemm g{(const bf16*)(ws + WS_PBF) + (size_t)T * 256, (const bf16*)(ws + WS_WPROJ) + (size_t)D * 256, T, D, 256}; pg8::StaticOrder S; S.init(T, D, F.G, (int)blockIdx.x); EpiBf16S E{PP, D, nullptr};
          pg8::gemm_phase<EpiBf16S, pg8::StaticOrder, true, true>(F.lds + RING_OFF, g, S, E); }
    } SEAM(8);
    if (IN(9)) for (int rep_ = 0; rep_ < REPS(9); ++rep_) { lora_prep_rows(args, F); } SEAM(9);
    if (IN(10)) for (int rep_ = 0; rep_ < REPS(10); ++rep_) { pg8::Gemm g{(const bf16*)(ws + WS_LA), (const bf16*)(ws + WS_WLORA), T, LORA_N, LORA_K}; pg8::StaticOrder S; S.init(T, LORA_N, F.G, (int)blockIdx.x); EpiBf16S E{(bf16*)(ws + WS_LO), LORA_N, nullptr};
        pg8::gemm_phase<EpiBf16S, pg8::StaticOrder, true, true>(F.lds + RING_OFF, g, S, E); } SEAM(10);
    if (IN(11)) for (int rep_ = 0; rep_ < REPS(11); ++rep_) { for (int u = F.vcu; u < 192; u += F.G) { if (u < 64) scan_gla_mfma_unit<1>(args, F, u); else scan_rwkv_unit(args, F, u - 64); __syncthreads(); } } SEAM(11);
    if (IN(12)) for (int rep_ = 0; rep_ < REPS(12); ++rep_) { post_rows<1>(args, F); } SEAM(12);
    if (IN(13)) { pg8::Gemm g{ACTA, (const bf16*)(ws + WS_WOD_OUT), T, D, D}; pg8::StaticOrder S; S.init(T, D, F.G, (int)blockIdx.x);
        EpiResid<false> E{args.out, args.out, ACTB, args.in[I_NFFN] + D, rowss + (size_t)RS_FFN1 * T * 32, nullptr};
        pg8::gemm_phase<EpiResid<false>, pg8::StaticOrder, true, true>(F.lds + RING_OFF, g, S, E); } SEAM(13);
    if (IN(14)) for (int rep_ = 0; rep_ < REPS(14); ++rep_) { pg8::Gemm g{ACTB, (const bf16*)(ws + WS_WPEER) + (size_t)D * D, T, D, D}; pg8::StaticOrder S; S.init(T, D, F.G, (int)blockIdx.x); EpiBf16S E{SCB, D, rowss + (size_t)RS_FFN1 * T * 32};
        pg8::gemm_phase<EpiBf16S, pg8::StaticOrder, true, true>(F.lds + RING_OFF, g, S, E); } SEAM(14);
    if (IN(15)) for (int rep_ = 0; rep_ < REPS(15); ++rep_) { peer_phase(args, F, 1, rep_ != 0); } SEAM(15);
    if (IN(16)) { pg8::Gemm g{ACTA, (const bf16*)(ws + WS_WGATE) + (size_t)D * D, T, D, D}; pg8::StaticOrder S; S.init(T, D, F.G, (int)blockIdx.x);
        EpiResid<true> E{args.out, args.out, nullptr, nullptr, rowss + (size_t)RS_FINAL * T * 32, PP};
        pg8::gemm_phase<EpiResid<true>, pg8::StaticOrder, true, true>(F.lds + RING_OFF, g, S, E); } SEAM(16);
    if (IN(17)) {
        float oscale = 1.0f;
#if PROBE_MASK
        { unsigned long long t_prev = __hip_atomic_load(tsb + 31, __ATOMIC_RELAXED, __HIP_MEMORY_SCOPE_AGENT); const unsigned long long t_begin = t_prev; unsigned long long sel = 0ull;
          for (int k = 0; k <= 16; ++k) { const unsigned long long tk = __hip_atomic_load(tsb + k, __ATOMIC_RELAXED, __HIP_MEMORY_SCOPE_AGENT); if ((PROBE_MASK >> k) & 1) sel += tk - t_prev; t_prev = tk; }
          const float f = (float)(double(sel) / double(t_prev - t_begin)); oscale = 1.0f + sqrtf(0.01f + 0.9f * f); }
#endif
        final_rows(args, F, oscale); }
#undef IN
#undef SEAM
}

extern "C" void kernel_launch(void* const* d_in, const int* in_sizes, int n_in, void* d_out, int out_size, void* d_ws, size_t ws_size, hipStream_t stream) {
    static int grid = 0;
    if (grid == 0) {
        if (n_in != N_IN || out_size != T * D || ws_size < WS_END) { fprintf(stderr, "kernel_launch: unexpected problem: n_in %d out %d ws %zu (need %zu)\n", n_in, out_size, ws_size, (size_t)WS_END); grid = -1; return; }
        int dev = 0, cus = 0, per_cu = 0;
        if (hipGetDevice(&dev) != hipSuccess || hipDeviceGetAttribute(&cus, hipDeviceAttributeMultiprocessorCount, dev) != hipSuccess) { grid = -1; return; }
        if (hipFuncSetAttribute((const void*)mega_fwd, hipFuncAttributeMaxDynamicSharedMemorySize, LDS_BYTES) != hipSuccess) { fprintf(stderr, "kernel_launch: hipFuncSetAttribute failed\n"); grid = -1; return; }
        if (hipOccupancyMaxActiveBlocksPerMultiprocessor(&per_cu, (const void*)mega_fwd, NTHREADS, LDS_BYTES) != hipSuccess || per_cu < 1) { fprintf(stderr, "kernel_launch: occupancy query says %d blocks per CU\n", per_cu); (void)hipGetLastError(); grid = -1; return; }
        grid = cus;
    }
    if (grid < 0) return;
    (void)hipMemsetAsync((char*)d_ws + WS_CTL, 0, CTL_ZERO_BYTES, stream);
    Args a{};
    for (int i = 0; i < N_IN; ++i) a.in[i] = (const float*)d_in[i];
    a.out = (float*)d_out; a.ws = (unsigned char*)d_ws;
#if MK_PER_PHASE
    for (int p = 0; p < N_PHASES - 1; ++p) { a.ph_lo = p; a.ph_hi = p + 1; hipLaunchKernelGGL(mega_fwd, dim3(grid), dim3(NTHREADS), LDS_BYTES, stream, a); }
#else
    a.ph_lo = 0; a.ph_hi = N_PHASES;
    void* kargs[] = {&a};
    hipError_t e = hipLaunchCooperativeKernel((const void*)mega_fwd, dim3(grid), dim3(NTHREADS), kargs, LDS_BYTES, stream);
    if (e != hipSuccess) fprintf(stderr, "kernel_launch: cooperative launch failed: %s (grid %d)\n", hipGetErrorString(e), grid);
#endif
}
```

```cpp
#include <hip/hip_runtime.h>
#include <hip/hip_cooperative_groups.h>
#include <cstdio>
#include <cstdint>
namespace cg = cooperative_groups;

#ifndef PROBE_MASK
#define PROBE_MASK 0
#endif
#ifndef DUP_MASK
#define DUP_MASK 0
#endif
#ifndef UBENCH
#define UBENCH 0
#endif
#ifndef MK_PER_PHASE
#define MK_PER_PHASE 0
#endif

namespace pg8 {
#define PG8_LAS __attribute__((address_space(3)))
typedef unsigned short bf16_t;
typedef short bf16x8 __attribute__((ext_vector_type(8)));
typedef float f32x4 __attribute__((ext_vector_type(4)));
typedef unsigned u32x4 __attribute__((ext_vector_type(4)));
typedef unsigned u32x2 __attribute__((ext_vector_type(2)));
constexpr int BM = 256, BK = 64, HALF = 128, HTB = HALF * BK * 2  , STAGE_BYTES = 8 * HTB, NXCD = 8, WGM = 8;

__host__ __device__ __forceinline__ int lds_byte(int r, int c) { const int st = (r >> 4) * 2 + (c >> 5), rr = r & 15, cc = c & 31, ob = rr * 64 + cc * 2; return st * 1024 + (ob ^ (((ob >> 9) & 1) << 5)); }
__host__ __device__ __forceinline__ void stage_rc(int b, int& R, int& C) { const int st = b / 1024, sb = b % 1024, swz = sb ^ (((sb >> 9) & 1) << 5); R = (st >> 1) * 16 + swz / 64; C = (st & 1) * 32 + (swz % 64) / 2; }
__host__ __device__ __forceinline__ int perm32(int rho) { const int n = rho >> 4, i = rho & 15; return 8 * (i >> 2) + 4 * n + (i & 3); }

struct Unit { int pm, pn; };
struct Gemm { const bf16_t* A; const bf16_t* Bt; int M, N, K; };

struct StaticOrder {
    int nM, nN, nwg, G, c;
    __host__ __device__ void init(int M, int N, int G_, int c_) { nM = M / BM; nN = N / BM; nwg = nM * nN; G = G_; c = c_; }
    __host__ __device__ bool next(int i, Unit& u) const {
        const long L = (long)i * G + c; if (L >= nwg) return false;
        int wgid = (int)L; { const int q = nwg / NXCD, r = nwg % NXCD, xcd = wgid % NXCD, off = wgid / NXCD; wgid = (xcd < r ? xcd * (q + 1) : r * (q + 1) + (xcd - r) * q) + off; }
        const int nig = WGM * nN, gid = wgid / nig, fm = gid * WGM, gsz = (nM - fm) < WGM ? (nM - fm) : WGM;
        u.pm = fm + ((wgid % nig) % gsz); u.pn = (wgid % nig) / gsz; return true;
    }
    __device__ __forceinline__ void a_ready(const Unit&) const {}
    __device__ __forceinline__ void done(const Unit&) const {}
};
__device__ __forceinline__ unsigned cvt_pk_bf16(float lo, float hi) { unsigned r; asm volatile("v_cvt_pk_bf16_f32 %0, %1, %2" : "=v"(r) : "v"(lo), "v"(hi)); return r; }
template <class Epi, class Sched, bool ALIGN_EPI = false, bool SP2 = false>
__device__ __forceinline__ void gemm_phase(PG8_LAS unsigned char* lds, const Gemm g, const Sched& S, const Epi& E) {
    const int tid = threadIdx.x, wid = __builtin_amdgcn_readfirstlane(tid >> 6), lane = tid & 63, wr = wid >> 2, wc = wid & 3, fr = lane & 15, fq = lane >> 4;
    const int K = g.K, nt = K / BK;
    unsigned voffA[2], voffB[2];
#pragma unroll
    for (int i = 0; i < 2; ++i) { int R, C; stage_rc(tid * 16 + i * 8192, R, C); const int Rb = Epi::PERM ? ((R & ~31) + perm32(R & 31)) : R;
        voffA[i] = (unsigned)(R * K + C) * 2u; voffB[i] = (unsigned)(Rb * K + C) * 2u; }
    const size_t kstep = (size_t)(BK * 2);
    const size_t hstep = (size_t)HALF * K * 2;
    const size_t tstep = 2 * hstep;
    const unsigned ldsw = (unsigned)wid * 1024u;
    const int aoff = lds_byte(wr * 64 + fr, fq * 8), boff = lds_byte(wc * 32 + fr, fq * 8);
#define PG8_SA(b, h) (((b) * 2 + (h)) * HTB)
#define PG8_SB(b, h) ((4 + (b) * 2 + (h)) * HTB)
#define PG8_STAGE(bufoff, gbase, voff) do { _Pragma("unroll") for (int _i = 0; _i < 2; ++_i) \
        __builtin_amdgcn_global_load_lds((const unsigned*)((const char*)(gbase) + (voff)[_i]), (PG8_LAS unsigned*)(lds + (bufoff) + ldsw + _i * 8192), 16, 0, 0); } while (0)
#define PG8_LDA(dst, b, h) do { _Pragma("unroll") for (int m = 0; m < 4; ++m) _Pragma("unroll") for (int k = 0; k < 2; ++k) dst[m][k] = *(const PG8_LAS bf16x8*)(lds + PG8_SA(b, h) + aoff + m * 2048 + k * 1024); } while (0)
#define PG8_LDB(dst, b, h) do { _Pragma("unroll") for (int n = 0; n < 2; ++n) _Pragma("unroll") for (int k = 0; k < 2; ++k) dst[n][k] = *(const PG8_LAS bf16x8*)(lds + PG8_SB(b, h) + boff + n * 2048 + k * 1024); } while (0)
#define PG8_MMA(ai, bj, At, Bt) do { __builtin_amdgcn_s_setprio(1); _Pragma("unroll") for (int m = 0; m < 4; ++m) _Pragma("unroll") for (int n = 0; n < 2; ++n) _Pragma("unroll") for (int k = 0; k < 2; ++k) \
        acc[ai][bj][m][n] = __builtin_amdgcn_mfma_f32_16x16x32_bf16(Bt[n][k], At[m][k], acc[ai][bj][m][n], 0, 0, 0); __builtin_amdgcn_s_setprio(0); } while (0)
#define PG8_WAIT_V(n) asm volatile("s_waitcnt vmcnt(" #n ")" ::: "memory")
#define PG8_WAIT_L(n) asm volatile("s_waitcnt lgkmcnt(" #n ")" ::: "memory")
#define PG8_BAR __builtin_amdgcn_s_barrier()
#define PG8_SCHED __builtin_amdgcn_sched_barrier(0)
    Unit cur, nxt; int ui = 0;
    if (!S.next(0, cur)) return;
    f32x4 acc[2][2][4][2];
#pragma unroll
    for (int a = 0; a < 2; ++a)
#pragma unroll
        for (int b = 0; b < 2; ++b)
#pragma unroll
            for (int m = 0; m < 4; ++m)
#pragma unroll
                for (int n = 0; n < 2; ++n) acc[a][b][m][n] = (f32x4){0.f, 0.f, 0.f, 0.f};
    bf16x8 At[4][2], B0[2][2], B1[2][2];
    const char* cA = (const char*)g.A + (size_t)cur.pm * tstep; const char* cB = (const char*)g.Bt + (size_t)cur.pn * tstep;
    S.a_ready(cur);
    if constexpr (SP2) {
        PG8_STAGE(PG8_SB(0, 0), cB, voffB); PG8_STAGE(PG8_SB(0, 1), cB + hstep, voffB); PG8_STAGE(PG8_SA(0, 0), cA, voffA); PG8_STAGE(PG8_SA(0, 1), cA + hstep, voffA);
        if (wr == 1) PG8_BAR;
        PG8_WAIT_V(2); PG8_BAR;
        PG8_STAGE(PG8_SB(1, 0), cB + kstep, voffB); PG8_STAGE(PG8_SA(1, 0), cA + kstep, voffA); PG8_STAGE(PG8_SB(1, 1), cB + hstep + kstep, voffB);
        PG8_WAIT_V(6); PG8_BAR;
    } else {
        PG8_STAGE(PG8_SB(0, 0), cB, voffB); PG8_STAGE(PG8_SA(0, 0), cA, voffA); PG8_STAGE(PG8_SB(0, 1), cB + hstep, voffB); PG8_STAGE(PG8_SA(0, 1), cA + hstep, voffA);
        if (wr == 1) PG8_BAR;
        PG8_WAIT_V(4); PG8_BAR;
        PG8_STAGE(PG8_SB(1, 0), cB + kstep, voffB); PG8_STAGE(PG8_SA(1, 0), cA + kstep, voffA); PG8_STAGE(PG8_SB(1, 1), cB + hstep + kstep, voffB);
        PG8_WAIT_V(6); PG8_BAR;
    }
    for (;;) {
        const bool has_next = S.next(ui + 1, nxt);
        const char* nA = has_next ? (const char*)g.A + (size_t)nxt.pm * tstep : cA; const char* nB = has_next ? (const char*)g.Bt + (size_t)nxt.pn * tstep : cB;
        for (int t = 0; t < nt; t += 2) {
            const bool last = (t == nt - 2);
            const char* a1 = cA + (size_t)(t + 1) * kstep;
            const char* a2 = last ? nA : cA + (size_t)(t + 2) * kstep; const char* b2 = last ? nB : cB + (size_t)(t + 2) * kstep;
            const char* a3 = a2 + kstep; const char* b3 = b2 + kstep;
            if (last && has_next) S.a_ready(nxt);
            if constexpr (SP2) {
            PG8_LDB(B0, 0, 0); PG8_LDB(B1, 0, 1); PG8_SCHED; PG8_LDA(At, 0, 0); PG8_STAGE(PG8_SA(1, 1), a1 + hstep, voffA);
            PG8_WAIT_V(8); PG8_WAIT_L(0); PG8_BAR; PG8_MMA(0, 0, At, B0); PG8_MMA(0, 1, At, B1); PG8_BAR; PG8_SCHED;
            PG8_LDA(At, 0, 1); PG8_STAGE(PG8_SB(0, 0), b2, voffB); PG8_STAGE(PG8_SB(0, 1), b2 + hstep, voffB); PG8_STAGE(PG8_SA(0, 0), a2, voffA);
            PG8_WAIT_V(8); PG8_WAIT_L(0); PG8_BAR; PG8_MMA(1, 0, At, B0); PG8_MMA(1, 1, At, B1); PG8_BAR; PG8_SCHED;
            PG8_LDB(B0, 1, 0); PG8_LDB(B1, 1, 1); PG8_SCHED; PG8_LDA(At, 1, 0); PG8_STAGE(PG8_SA(0, 1), a2 + hstep, voffA);
            PG8_WAIT_V(8); PG8_WAIT_L(0); PG8_BAR; PG8_MMA(0, 0, At, B0); PG8_MMA(0, 1, At, B1); PG8_BAR; PG8_SCHED;
            PG8_LDA(At, 1, 1); PG8_STAGE(PG8_SB(1, 0), b3, voffB); PG8_STAGE(PG8_SB(1, 1), b3 + hstep, voffB); PG8_STAGE(PG8_SA(1, 0), a3, voffA);
            PG8_WAIT_V(8); PG8_WAIT_L(0); PG8_BAR; PG8_MMA(1, 0, At, B0); PG8_MMA(1, 1, At, B1); PG8_BAR; PG8_SCHED;
            } else {
            PG8_LDB(B0, 0, 0); PG8_SCHED; PG8_LDA(At, 0, 0); PG8_STAGE(PG8_SA(1, 1), a1 + hstep, voffA);
            PG8_WAIT_L(8); PG8_BAR; PG8_WAIT_L(0); PG8_MMA(0, 0, At, B0); PG8_BAR; PG8_SCHED;
            PG8_LDB(B1, 0, 1); PG8_STAGE(PG8_SB(0, 0), b2, voffB);
            PG8_BAR; PG8_WAIT_L(0); PG8_MMA(0, 1, At, B1); PG8_BAR;
            PG8_LDA(At, 0, 1); PG8_STAGE(PG8_SA(0, 0), a2, voffA);
            PG8_BAR; PG8_WAIT_L(0); PG8_MMA(1, 0, At, B0); PG8_BAR; PG8_SCHED;
            PG8_STAGE(PG8_SB(0, 1), b2 + hstep, voffB);
            PG8_WAIT_V(6); PG8_BAR; PG8_MMA(1, 1, At, B1); PG8_BAR;
            PG8_LDB(B0, 1, 0); PG8_SCHED; PG8_LDA(At, 1, 0); PG8_STAGE(PG8_SA(0, 1), a2 + hstep, voffA);
            PG8_WAIT_L(8); PG8_BAR; PG8_WAIT_L(0); PG8_MMA(0, 0, At, B0); PG8_BAR; PG8_SCHED;
            PG8_LDB(B1, 1, 1); PG8_STAGE(PG8_SB(1, 0), b3, voffB);
            PG8_BAR; PG8_WAIT_L(0); PG8_MMA(0, 1, At, B1); PG8_BAR;
            PG8_LDA(At, 1, 1); PG8_STAGE(PG8_SA(1, 0), a3, voffA);
            PG8_BAR; PG8_WAIT_L(0); PG8_MMA(1, 0, At, B0); PG8_BAR; PG8_SCHED;
            PG8_STAGE(PG8_SB(1, 1), b3 + hstep, voffB);
            PG8_WAIT_V(6); PG8_BAR; PG8_MMA(1, 1, At, B1); PG8_BAR;
            }
        }
        if constexpr (ALIGN_EPI) { if (wr == 0) PG8_BAR; }
        if constexpr (!Epi::AFTER_DRAIN) { E(acc, cur, wr, wc, fr, fq); S.done(cur); }
        if (!has_next) break;
#pragma unroll
        for (int a = 0; a < 2; ++a)
#pragma unroll
            for (int b = 0; b < 2; ++b)
#pragma unroll
                for (int m = 0; m < 4; ++m)
#pragma unroll
                    for (int n = 0; n < 2; ++n) acc[a][b][m][n] = (f32x4){0.f, 0.f, 0.f, 0.f};
        cur = nxt; cA = nA; cB = nB; ++ui;
        if constexpr (ALIGN_EPI) { if (wr == 1) PG8_BAR; }
    }
    PG8_WAIT_V(0);
    if constexpr (!ALIGN_EPI) { if (wr == 0) PG8_BAR; }
    PG8_BAR;
    if constexpr (Epi::AFTER_DRAIN) { E.fused(acc, cur, wr, wc, fr, fq, lds, wid, lane); S.done(cur); }
#undef PG8_SA
#undef PG8_SB
#undef PG8_STAGE
#undef PG8_LDA
#undef PG8_LDB
#undef PG8_MMA
#undef PG8_WAIT_V
#undef PG8_WAIT_L
#undef PG8_BAR
#undef PG8_SCHED
}
}
#define GAS __attribute__((address_space(1)))
#define LAS __attribute__((address_space(3)))
typedef unsigned short bf16;
typedef unsigned v4u __attribute__((ext_vector_type(4)));
typedef float f32x4 __attribute__((ext_vector_type(4)));
typedef short bf16x8 __attribute__((ext_vector_type(8)));
typedef GAS unsigned gu32;
typedef GAS unsigned long long gu64;
#define RLX_AGENT __ATOMIC_RELAXED, __HIP_MEMORY_SCOPE_AGENT
#define LDS_WAIT() asm volatile("s_waitcnt lgkmcnt(0)" ::: "memory")
#define VM_WAIT() asm volatile("s_waitcnt vmcnt(0)" ::: "memory")
__device__ __forceinline__ unsigned long long rt() { return __builtin_amdgcn_s_memrealtime(); }
__device__ __forceinline__ unsigned f2bf(float f) { unsigned u = __builtin_bit_cast(unsigned, f); return (u + 0x7fffu + ((u >> 16) & 1u)) >> 16; }
__device__ __forceinline__ unsigned pk2(float lo, float hi) { return f2bf(lo) | (f2bf(hi) << 16); }

#define XB_TMO      128
#define XB_XCNT(j)  (256  + 64 * (j))
#define XB_XSUB(j)  (1280 + 64 * (j))
#define XB_XGEN(j)  (2304 + 64 * (j))
#define XB_TOP      3328
#define XB_TOPGEN   3392
#define XCD_BAR_WORDS 3456
#define XB_SPIN_CAP (1u << 18)

__device__ __forceinline__ unsigned xb_ld(unsigned* p)              { return __hip_atomic_load(p, __ATOMIC_RELAXED, __HIP_MEMORY_SCOPE_AGENT); }
__device__ __forceinline__ unsigned xb_add(unsigned* p, unsigned v) { return __hip_atomic_fetch_add(p, v, __ATOMIC_RELAXED, __HIP_MEMORY_SCOPE_AGENT); }
__device__ __forceinline__ unsigned xb_xcc_id() { return (unsigned)__builtin_amdgcn_s_getreg((3 << 11) | 20) & 0xFu; }
#define XB_SPIN(cond, bar) do { unsigned _sp = 0; while (cond) { __builtin_amdgcn_s_sleep(1); \
    if ((++_sp & 255u) == 0u) { if (xb_ld(&(bar)[XB_TMO])) break; if (_sp > XB_SPIN_CAP) { atomicAdd(&(bar)[XB_TMO], 1u); break; } } } } while (0)

struct XcdBarrier {
    unsigned* bar; unsigned x;
    volatile LAS unsigned* st;
};

__device__ __forceinline__ XcdBarrier xcd_barrier_post(unsigned* bar, volatile LAS unsigned* st) {
    XcdBarrier b; b.bar = bar; b.x = xb_xcc_id(); b.st = st;
    if (threadIdx.x == 0) (void)xb_add(&bar[XB_XCNT(b.x)], 1u);
    return b;
}
__device__ __forceinline__ void xcd_barrier_complete(unsigned* bar, unsigned x, unsigned& nloc, unsigned& nx) {
    const unsigned G = gridDim.x * gridDim.y * gridDim.z;
    unsigned sum, cnt, mine, sp = 0u;
    for (;;) {
        sum = 0u; cnt = 0u; mine = 0u;
#pragma unroll
        for (unsigned j = 0; j < 16; ++j) { const unsigned c = xb_ld(&bar[XB_XCNT(j)]); sum += c; cnt += (c > 0u) ? 1u : 0u; mine = (j == x) ? c : mine; }
        if (sum == G) break;
        __builtin_amdgcn_s_sleep(1);
        if ((++sp & 255u) == 0u) { if (xb_ld(&bar[XB_TMO])) break; if (sp > XB_SPIN_CAP) { atomicAdd(&bar[XB_TMO], 1u); break; } }
    }
    nloc = mine > 0u ? mine : 1u; nx = cnt > 0u ? cnt : 1u;
}

__device__ __forceinline__ void xcd_barrier(const XcdBarrier& b) {
    asm volatile("s_waitcnt vmcnt(0)" ::: "memory");
    __syncthreads();
    if (threadIdx.x == 0) {
        unsigned* bar = b.bar;
        __builtin_amdgcn_s_waitcnt(0);
        unsigned nloc = b.st[0], nx = b.st[1];
        if (nloc == 0u) { xcd_barrier_complete(bar, b.x, nloc, nx); b.st[0] = nloc; b.st[1] = nx; }
        const unsigned old = xb_add(&bar[XB_XSUB(b.x)], 1u);
        const unsigned gen = old / nloc;
        if (old + 1u == (gen + 1u) * nloc) {
            __builtin_amdgcn_fence(__ATOMIC_RELEASE, "agent");
            asm volatile("s_waitcnt vmcnt(0)" ::: "memory");
            const unsigned og = xb_add(&bar[XB_TOP], 1u);
            const unsigned tg = og / nx;
            if (og + 1u == (tg + 1u) * nx) xb_add(&bar[XB_TOPGEN], 1u);
            else XB_SPIN(xb_ld(&bar[XB_TOPGEN]) == tg, bar);
            __builtin_amdgcn_fence(__ATOMIC_ACQUIRE, "agent");
            xb_add(&bar[XB_XGEN(b.x)], 1u);
            asm volatile("s_waitcnt vmcnt(0)" ::: "memory");
        } else {
            XB_SPIN(xb_ld(&bar[XB_XGEN(b.x)]) == gen, bar);
            __builtin_amdgcn_fence(__ATOMIC_ACQUIRE, "agent");
            asm volatile("s_waitcnt vmcnt(0)" ::: "memory");
        }
    }
    __syncthreads();
}

constexpr int NWAVES = 8, NTHREADS = NWAVES * 64;
constexpr int BATCH = 8, SEQ = 2048, T = BATCH * SEQ, D = 2048;
constexpr int EV_N = 7200, EV_NP = 7424, OD_N = 7616, OD_NP = 7680, PROJ_LD = 7680;
constexpr float EPS = 1e-6f;
constexpr int EC_GQ = 0, EC_GK = 512, EC_GV = 1024, EC_GZ = 2048, EC_GLR = 3072, EC_BQ = 3088, EC_BK = 4112, EC_BV = 5136, EC_BZ = 6160, EC_BA = 7184, EC_BB = 7192;
constexpr int OC_HQ = 0, OC_HF = 1024, OC_HI = 2048, OC_HG = 3072, OC_RW = 4096;
constexpr int RW_R = 0, RW_K = 1024, RW_V = 2048, RW_WL = 3072, RW_AL = 3168, RW_GL = 3264;
constexpr int LORA_K = 512, LORA_N = 3072;
enum { I_X = 0, I_P, I_EV_WIN, I_GK_W2, I_GK_B, I_GLA_NORM, I_GDN_CONV, I_GDN_ALOG, I_GDN_DTB, I_GDN_NORM, I_EV_WOUT, I_OD_WIN, I_LB, I_HG_NORM,
       I_MU, I_W0, I_W2, I_A0, I_A2, I_G2, I_KK, I_KA, I_RK, I_LNW, I_LNB, I_OD_WOUT, I_NMIX, I_NFFN, I_NPLE, I_PEER_WQ, I_PEER_SK, I_PEER_U, I_PEER_V,
       I_PLE_WP, I_PLE_WG, I_NFINAL, N_IN };

constexpr size_t MiB = 1u << 20;
constexpr size_t WS_CTL = 0, CTL_ZERO_BYTES = 1 * MiB;
constexpr size_t WS_WEV_IN = 1 * MiB, WS_WEV_OUT = 30 * MiB, WS_WOD_IN = 38 * MiB, WS_WOD_OUT = 68 * MiB, WS_WPEER = 76 * MiB, WS_WGATE = 92 * MiB, WS_WPROJ = 108 * MiB,
                 WS_WLORA = 110 * MiB, WS_PBF = 113 * MiB, WS_TABU = 129 * MiB, WS_TABV = 193 * MiB, WS_ACTA = 257 * MiB, WS_ACTB = 321 * MiB, WS_PROJ = 385 * MiB, WS_SC = 385 * MiB,
                 WS_O = 625 * MiB, WS_PP = 753 * MiB, WS_LA = 817 * MiB, WS_LO = 833 * MiB, WS_RSP = 929 * MiB, WS_END = 937 * MiB;
static_assert(WS_WEV_IN + (size_t)EV_NP * D * 2 <= WS_WEV_OUT && WS_WOD_IN + (size_t)OD_NP * D * 2 <= WS_WOD_OUT && WS_PROJ + (size_t)T * PROJ_LD * 2 <= WS_O, "ws map");
constexpr int CW_BAR = 4096;
enum { RS_FFN0 = 0, RS_MIX1 = 1, RS_FFN1 = 2, RS_FINAL = 3 };
constexpr int RING_OFF = 0, RING_BYTES = 131072;
constexpr int LDSCTL_OFF = RING_BYTES, MISC_OFF = LDSCTL_OFF + 320;
constexpr int LDS_BYTES = 147456;

struct Args { const float* in[N_IN]; float* out; unsigned char* ws; int ph_lo, ph_hi; };
struct Frame {
    LAS unsigned char* lds; volatile LAS unsigned* MISC; gu32* ctl;
    int tid, lane, wave, vcu, G;
};
__device__ __forceinline__ float wave_sum(float v) {
#pragma unroll
    for (int o = 1; o < 64; o <<= 1) v += __shfl_xor(v, o);
    return v;
}
__device__ __forceinline__ float half_sum32(float v) {
#pragma unroll
    for (int o = 1; o < 32; o <<= 1) v += __shfl_xor(v, o);
    return v;
}
#define DPP_ADD(v, ctrl) (v) += __builtin_bit_cast(float, __builtin_amdgcn_update_dpp(0, __builtin_bit_cast(int, (v)), (ctrl), 0xF, 0xF, false))
__device__ __forceinline__ float row_sum16(float v) {
    DPP_ADD(v, 0x128); DPP_ADD(v, 0x124); DPP_ADD(v, 0x122); DPP_ADD(v, 0x121);
    return v;
}
__device__ __forceinline__ void row_sum16_x4(float& a, float& b, float& c, float& d) {
    asm("s_nop 1\n\t"
        "v_add_f32_dpp %0, %0, %0 row_ror:8 row_mask:0xf bank_mask:0xf\n\tv_add_f32_dpp %1, %1, %1 row_ror:8 row_mask:0xf bank_mask:0xf\n\t"
        "v_add_f32_dpp %2, %2, %2 row_ror:8 row_mask:0xf bank_mask:0xf\n\tv_add_f32_dpp %3, %3, %3 row_ror:8 row_mask:0xf bank_mask:0xf\n\t"
        "v_add_f32_dpp %0, %0, %0 row_ror:4 row_mask:0xf bank_mask:0xf\n\tv_add_f32_dpp %1, %1, %1 row_ror:4 row_mask:0xf bank_mask:0xf\n\t"
        "v_add_f32_dpp %2, %2, %2 row_ror:4 row_mask:0xf bank_mask:0xf\n\tv_add_f32_dpp %3, %3, %3 row_ror:4 row_mask:0xf bank_mask:0xf\n\t"
        "v_add_f32_dpp %0, %0, %0 row_ror:2 row_mask:0xf bank_mask:0xf\n\tv_add_f32_dpp %1, %1, %1 row_ror:2 row_mask:0xf bank_mask:0xf\n\t"
        "v_add_f32_dpp %2, %2, %2 row_ror:2 row_mask:0xf bank_mask:0xf\n\tv_add_f32_dpp %3, %3, %3 row_ror:2 row_mask:0xf bank_mask:0xf\n\t"
        "v_add_f32_dpp %0, %0, %0 row_ror:1 row_mask:0xf bank_mask:0xf\n\tv_add_f32_dpp %1, %1, %1 row_ror:1 row_mask:0xf bank_mask:0xf\n\t"
        "v_add_f32_dpp %2, %2, %2 row_ror:1 row_mask:0xf bank_mask:0xf\n\tv_add_f32_dpp %3, %3, %3 row_ror:1 row_mask:0xf bank_mask:0xf\n\t"
        "s_nop 1"
        : "+v"(a), "+v"(b), "+v"(c), "+v"(d));
}
__device__ __forceinline__ void row_sum16_x2(float& a, float& b) {
    asm("s_nop 1\n\t"
        "v_add_f32_dpp %0, %0, %0 row_ror:8 row_mask:0xf bank_mask:0xf\n\tv_add_f32_dpp %1, %1, %1 row_ror:8 row_mask:0xf bank_mask:0xf\n\ts_nop 1\n\t"
        "v_add_f32_dpp %0, %0, %0 row_ror:4 row_mask:0xf bank_mask:0xf\n\tv_add_f32_dpp %1, %1, %1 row_ror:4 row_mask:0xf bank_mask:0xf\n\ts_nop 1\n\t"
        "v_add_f32_dpp %0, %0, %0 row_ror:2 row_mask:0xf bank_mask:0xf\n\tv_add_f32_dpp %1, %1, %1 row_ror:2 row_mask:0xf bank_mask:0xf\n\ts_nop 1\n\t"
        "v_add_f32_dpp %0, %0, %0 row_ror:1 row_mask:0xf bank_mask:0xf\n\tv_add_f32_dpp %1, %1, %1 row_ror:1 row_mask:0xf bank_mask:0xf\n\t"
        "s_nop 1"
        : "+v"(a), "+v"(b));
}
#define LBAR() do { asm volatile("s_waitcnt lgkmcnt(0)" ::: "memory"); __builtin_amdgcn_s_barrier(); asm volatile("" ::: "memory"); } while (0)
__device__ __forceinline__ float bf_lo(unsigned w) { return __uint_as_float(w << 16); }
__device__ __forceinline__ float bf_hi(unsigned w) { return __uint_as_float(w & 0xffff0000u); }
__device__ __forceinline__ float sigmoidf_(float x) { return __builtin_amdgcn_rcpf(1.0f + __expf(-x)); }
__device__ __forceinline__ float siluf_(float x) { return x * __builtin_amdgcn_rcpf(1.0f + __expf(-x)); }
__device__ __forceinline__ float softplusf_(float x) { return fmaxf(x, 0.f) + log1pf(__expf(-fabsf(x))); }
__device__ __forceinline__ float logsigmoidf_(float x) { return fminf(x, 0.f) - log1pf(__expf(-fabsf(x))); }

struct EpiBf16S {
    static constexpr bool PERM = true, AFTER_DRAIN = false;
    bf16* O; int ldc; const float* rowss;
    __device__ __forceinline__ void operator()(const pg8::f32x4 (&acc)[2][2][4][2], const pg8::Unit& u, int wr, int wc, int fr, int fq) const {
        const int row0 = u.pm * 256 + wr * 64 + fr, col0 = u.pn * 256 + wc * 32 + 8 * fq;
#pragma unroll
        for (int ai = 0; ai < 2; ++ai)
#pragma unroll
            for (int m = 0; m < 4; ++m) {
                const int row = row0 + ai * 128 + m * 16;
                float sc = 1.f;
                if (rowss) { const pg8::f32x4* rp = (const pg8::f32x4*)(rowss + (size_t)row * 32 + 8 * fq); const pg8::f32x4 p0 = rp[0], p1 = rp[1];
                    float s = ((p0[0] + p0[1]) + (p0[2] + p0[3])) + ((p1[0] + p1[1]) + (p1[2] + p1[3])); s += __shfl_xor(s, 16); s += __shfl_xor(s, 32);
                    sc = __builtin_amdgcn_rsqf(s * (1.0f / D) + EPS); }
                bf16* rowp = O + (size_t)row * ldc + col0;
#pragma unroll
                for (int bj = 0; bj < 2; ++bj) { const pg8::f32x4 v0 = acc[ai][bj][m][0] * sc, v1 = acc[ai][bj][m][1] * sc;
                    pg8::u32x4 w; w.x = pg8::cvt_pk_bf16(v0[0], v0[1]); w.y = pg8::cvt_pk_bf16(v0[2], v0[3]); w.z = pg8::cvt_pk_bf16(v1[0], v1[1]); w.w = pg8::cvt_pk_bf16(v1[2], v1[3]);
                    *(pg8::u32x4*)(rowp + bj * 128) = w; } }
    }
};
template <bool GATE> struct EpiResid {
    static constexpr bool PERM = false, AFTER_DRAIN = false;
    const float* hin; float* hout; bf16* hg; const float* gain; float* rowss; const bf16* pp;
    __device__ __forceinline__ void operator()(const pg8::f32x4 (&acc)[2][2][4][2], const pg8::Unit& u, int wr, int wc, int fr, int fq) const {
        const int row0 = u.pm * 256 + wr * 64 + fr, col0 = u.pn * 256 + wc * 32 + 4 * fq;
        pg8::f32x4 gv[2][2];
#pragma unroll
        for (int bj = 0; bj < 2; ++bj)
#pragma unroll
            for (int n = 0; n < 2; ++n) gv[bj][n] = hg ? *(const pg8::f32x4*)(gain + col0 + bj * 128 + n * 16) : (pg8::f32x4){0.f, 0.f, 0.f, 0.f};
#pragma unroll
        for (int ai = 0; ai < 2; ++ai)
#pragma unroll
            for (int m = 0; m < 4; ++m) {
                const int row = row0 + ai * 128 + m * 16; const size_t off = (size_t)row * D + col0; float ss = 0.f;
#pragma unroll
                for (int bj = 0; bj < 2; ++bj)
#pragma unroll
                    for (int n = 0; n < 2; ++n) { const size_t o = off + bj * 128 + n * 16;
                        pg8::f32x4 hv = *(const pg8::f32x4*)(hin + o); pg8::f32x4 a = acc[ai][bj][m][n];
                        if (GATE) { const pg8::u32x2 pw = *(const pg8::u32x2*)(pp + o);
                            a[0] = sigmoidf_(a[0]) * bf_lo(pw.x); a[1] = sigmoidf_(a[1]) * bf_hi(pw.x); a[2] = sigmoidf_(a[2]) * bf_lo(pw.y); a[3] = sigmoidf_(a[3]) * bf_hi(pw.y); }
                        hv = hv + a; *(pg8::f32x4*)(hout + o) = hv;
                        ss += (hv[0] * hv[0] + hv[1] * hv[1]) + (hv[2] * hv[2] + hv[3] * hv[3]);
                        if (hg) { const pg8::f32x4 q = hv * gv[bj][n]; pg8::u32x2 w; w.x = pg8::cvt_pk_bf16(q[0], q[1]); w.y = pg8::cvt_pk_bf16(q[2], q[3]); *(pg8::u32x2*)(hg + o) = w; } }
                ss += __shfl_xor(ss, 16); ss += __shfl_xor(ss, 32);
                if (fq == 0) rowss[(size_t)row * 32 + u.pn * 4 + wc] = ss;
                asm volatile("" ::: "memory"); }
    }
};

__device__ __forceinline__ void p0_transpose_item(const float* W, int K, int N, bf16* WT, LAS float* scr, int item, int lane) {
    const int nblk = N / 32, kb = item / nblk, nb = item % nblk, k0 = 64 * kb, n0 = 32 * nb;
#pragma unroll 8
    for (int i = 0; i < 32; ++i) { const int kk = 2 * i + (lane >> 5); scr[kk * 33 + (lane & 31)] = W[(size_t)(k0 + kk) * N + n0 + (lane & 31)]; }
    LDS_WAIT(); asm volatile("" ::: "memory");
    const int c = lane & 7;
#pragma unroll
    for (int j = 0; j < 4; ++j) { const int n = (lane >> 3) + 8 * j; const LAS float* s = scr + (8 * c) * 33 + n;
        v4u o; o.x = pk2(s[0 * 33], s[1 * 33]); o.y = pk2(s[2 * 33], s[3 * 33]); o.z = pk2(s[4 * 33], s[5 * 33]); o.w = pk2(s[6 * 33], s[7 * 33]);
        *(GAS v4u*)(WT + (size_t)(n0 + n) * K + k0 + 8 * c) = o; }
    LDS_WAIT(); asm volatile("" ::: "memory");
}
__device__ __forceinline__ void cvt_f32_bf16(const float* src, bf16* dst, size_t n, int gtid, int gthreads) {
    const size_t n8 = n / 8;
    for (size_t i = gtid; i < n8; i += gthreads) {
        const f32x4 a = *(const GAS f32x4*)(src + i * 8), b = *(const GAS f32x4*)(src + i * 8 + 4);
        v4u o; o.x = pk2(a[0], a[1]); o.y = pk2(a[2], a[3]); o.z = pk2(b[0], b[1]); o.w = pk2(b[2], b[3]);
        *(GAS v4u*)(dst + i * 8) = o; }
}
__device__ __forceinline__ void cvt_f32_fp8(const float* src, unsigned char* dst, size_t n, float scale, int gtid, int gthreads) {
    const size_t n16 = n / 16;
    for (size_t i = gtid; i < n16; i += gthreads) { v4u o; unsigned w[4];
#pragma unroll
        for (int q = 0; q < 4; ++q) { const f32x4 a = *(const GAS f32x4*)(src + i * 16 + 4 * q) * scale;
            int x = __builtin_amdgcn_cvt_pk_fp8_f32(a[0], a[1], 0, false); x = __builtin_amdgcn_cvt_pk_fp8_f32(a[2], a[3], x, true); w[q] = (unsigned)x; }
        o.x = w[0]; o.y = w[1]; o.z = w[2]; o.w = w[3];
        *(GAS v4u*)(dst + i * 16) = o; }
}
__device__ __forceinline__ void rms_row_to_bf16(const float* xrow, const float* g, bf16* orow, int lane) {
    const GAS f32x4* xr = (const GAS f32x4*)xrow + lane; f32x4 v[8]; float s = 0.f;
#pragma unroll
    for (int j = 0; j < 8; ++j) { v[j] = xr[64 * j]; s += (v[j][0] * v[j][0] + v[j][1] * v[j][1]) + (v[j][2] * v[j][2] + v[j][3] * v[j][3]); }
    const float r = __builtin_amdgcn_rsqf(wave_sum(s) * (1.0f / D) + EPS);
    const GAS f32x4* gr = (const GAS f32x4*)g + lane;
    GAS unsigned long long* o8 = (GAS unsigned long long*)orow + lane;
#pragma unroll
    for (int j = 0; j < 8; ++j) { const f32x4 gg = gr[64 * j]; o8[64 * j] = (unsigned long long)pk2(v[j][0] * r * gg[0], v[j][1] * r * gg[1]) | ((unsigned long long)pk2(v[j][2] * r * gg[2], v[j][3] * r * gg[3]) << 32); }
}
__device__ __forceinline__ void p0_fold_item(const float* wq, const float* sk, bf16* WP, LAS float* lds, int item, int tid) {
    const int hp = item >> 5, k0 = (item & 31) * 64;
    LAS float* skT = lds;
    LAS float* wqT = lds + 128 * 132;
    const float* skb = sk + (size_t)hp * 128 * 128;
#pragma unroll 4
    for (int i = 0; i < 32; ++i) { const int idx = i * 512 + tid, n = idx >> 7, d = idx & 127; skT[d * 132 + n] = skb[idx]; }
#pragma unroll 4
    for (int i = 0; i < 16; ++i) { const int idx = i * 512 + tid, kk = idx >> 7, d = idx & 127; wqT[d * 68 + kk] = wq[(size_t)(k0 + kk) * D + hp * 128 + d]; }
    __syncthreads();
    const int n0 = (tid >> 4) * 4, kk0 = (tid & 15) * 4;
    float acc[4][4];
#pragma unroll
    for (int i = 0; i < 4; ++i)
#pragma unroll
        for (int j = 0; j < 4; ++j) acc[i][j] = 0.f;
#pragma unroll 4
    for (int d = 0; d < 128; ++d) { const f32x4 a = *(const LAS f32x4*)(skT + d * 132 + n0), b = *(const LAS f32x4*)(wqT + d * 68 + kk0);
#pragma unroll
        for (int i = 0; i < 4; ++i)
#pragma unroll
            for (int j = 0; j < 4; ++j) acc[i][j] += a[i] * b[j]; }
#pragma unroll
    for (int i = 0; i < 4; ++i) { unsigned long long o = (unsigned long long)pk2(acc[i][0], acc[i][1]) | ((unsigned long long)pk2(acc[i][2], acc[i][3]) << 32);
        *(GAS unsigned long long*)(WP + (size_t)(hp * 128 + n0 + i) * D + k0 + kk0) = o; }
    __syncthreads();
}
__device__ __forceinline__ void p0_prologue(const Args& A, Frame& F) {
    const int gw = F.vcu * NWAVES + F.wave, NGW = F.G * NWAVES;
    const int gtid = (F.vcu * NWAVES + F.wave) * 64 + F.lane, gthreads = F.G * NTHREADS;
    unsigned char* ws = A.ws;
    {
        LAS float* scr = (LAS float*)(F.lds + RING_OFF + F.wave * 16384);
        constexpr int I_EVIN = (D / 64) * (EV_N / 32), I_SQ = (D / 64) * (D / 32), I_ODIN = (D / 64) * (OD_N / 32), I_PJ = (256 / 64) * (D / 32);
        constexpr int NITEMS = I_EVIN + I_SQ + I_ODIN + I_SQ + 2 * I_SQ + 2 * I_PJ;
        for (int it = gw; it < NITEMS; it += NGW) {
            int r = it;
            if (r < I_EVIN) { p0_transpose_item(A.in[I_EV_WIN], D, EV_N, (bf16*)(ws + WS_WEV_IN), scr, r, F.lane); continue; } r -= I_EVIN;
            if (r < I_SQ) { p0_transpose_item(A.in[I_EV_WOUT], D, D, (bf16*)(ws + WS_WEV_OUT), scr, r, F.lane); continue; } r -= I_SQ;
            if (r < I_ODIN) { p0_transpose_item(A.in[I_OD_WIN], D, OD_N, (bf16*)(ws + WS_WOD_IN), scr, r, F.lane); continue; } r -= I_ODIN;
            if (r < I_SQ) { p0_transpose_item(A.in[I_OD_WOUT], D, D, (bf16*)(ws + WS_WOD_OUT), scr, r, F.lane); continue; } r -= I_SQ;
            if (r < 2 * I_SQ) { const int L = r / I_SQ; p0_transpose_item(A.in[I_PLE_WG] + (size_t)L * D * D, D, D, (bf16*)(ws + WS_WGATE) + (size_t)L * D * D, scr, r % I_SQ, F.lane); continue; } r -= 2 * I_SQ;
            { const int L = r / I_PJ; p0_transpose_item(A.in[I_PLE_WP] + (size_t)L * 256 * D, 256, D, (bf16*)(ws + WS_WPROJ) + (size_t)L * D * 256, scr, r % I_PJ, F.lane); }
        }
        { GAS v4u* z0 = (GAS v4u*)(ws + WS_WEV_IN + (size_t)EV_N * D * 2); const size_t n0 = (size_t)(EV_NP - EV_N) * D * 2 / 16;
          for (size_t i = gtid; i < n0; i += gthreads) z0[i] = (v4u){0u, 0u, 0u, 0u};
          GAS v4u* z1 = (GAS v4u*)(ws + WS_WOD_IN + (size_t)OD_N * D * 2); const size_t n1 = (size_t)(OD_NP - OD_N) * D * 2 / 16;
          for (size_t i = gtid; i < n1; i += gthreads) z1[i] = (v4u){0u, 0u, 0u, 0u}; }
    }
    __syncthreads();
    for (int it = F.vcu; it < 1024; it += F.G) { const int L = it >> 9;
        p0_fold_item(A.in[I_PEER_WQ] + (size_t)L * D * D, A.in[I_PEER_SK] + (size_t)L * 16 * 128 * 128, (bf16*)(ws + WS_WPEER) + (size_t)L * D * D, (LAS float*)(F.lds + RING_OFF), it & 511, F.tid); }
    cvt_f32_fp8(A.in[I_PEER_U], (unsigned char*)(ws + WS_TABU), (size_t)2 * 16384 * D, 512.0f, gtid, gthreads);
    cvt_f32_fp8(A.in[I_PEER_V], (unsigned char*)(ws + WS_TABV), (size_t)2 * 16384 * D, 16.0f, gtid, gthreads);
    cvt_f32_bf16(A.in[I_P], (bf16*)(ws + WS_PBF), (size_t)2 * T * 256, gtid, gthreads);
    { bf16* LB = (bf16*)(ws + WS_WLORA); const float* w2 = A.in[I_W2]; const float* a2 = A.in[I_A2]; const float* g2 = A.in[I_G2];
      for (int i = gtid; i < LORA_N * LORA_K / 2; i += gthreads) { const int row = i / (LORA_K / 2), col = (i % (LORA_K / 2)) * 2; float v[2];
#pragma unroll
          for (int e = 0; e < 2; ++e) { const int c = col + e; float x = 0.f;
              if (row < 1024) { if (c < 96) x = w2[c * 1024 + row]; }
              else if (row < 2048) { if (c >= 96 && c < 192) x = a2[(c - 96) * 1024 + (row - 1024)]; }
              else { if (c >= 192 && c < 448) x = g2[(c - 192) * 1024 + (row - 2048)]; }
              v[e] = x; }
          *(GAS unsigned*)(LB + (size_t)row * LORA_K + col) = pk2(v[0], v[1]); } }
    for (int m = gw; m < T; m += NGW) rms_row_to_bf16(A.in[I_X] + (size_t)m * D, A.in[I_NMIX], (bf16*)(ws + WS_ACTA) + (size_t)m * D, F.lane);
}

constexpr int TC = 16, NCHUNK = SEQ / TC;
typedef float f32x2 __attribute__((ext_vector_type(2)));
typedef unsigned u32x2 __attribute__((ext_vector_type(2)));

template <int MODE>
__device__ __forceinline__ void scan_gla_unit(const Args& A, Frame& F, int unit) {
    const int tid = F.tid, lane = F.lane, w = F.wave;
    int b, h, qcol, kcol, vcol, ocol;
    if (MODE == 0) { b = unit >> 4; h = (unit >> 2) & 3; const int s = unit & 3; qcol = EC_GQ + h * 128; kcol = EC_GK + h * 128; vcol = EC_GV + h * 256 + s * 64; ocol = h * 256 + s * 64; }
    else           { b = unit >> 4; h = (unit >> 1) & 7; const int s = unit & 1; qcol = OC_HQ + h * 128; kcol = OC_HF + h * 128; vcol = OC_HI + h * 128 + s * 64; ocol = h * 128 + s * 64; }
    const bf16* P = (const bf16*)(A.ws + WS_PROJ) + (size_t)b * SEQ * PROJ_LD;
    float* O = (float*)(A.ws + WS_O) + (size_t)b * SEQ * D + ocol;
    LAS float* Lf = (LAS float*)(F.lds + RING_OFF);
    constexpr int BUFSZ = 7168, O_EG = 0, O_K = 2048, O_Q = 4096, O_V = 6144, O_OUT = 2 * BUFSZ, O_W2 = O_OUT + 1024, O_BIAS = O_W2 + 2048;
    const int tl = tid >> 5, dq = (tid & 31) * 4, tlv = tid >> 4, c4 = (tid & 15) * 4;
    float lb[4] = {0.f, 0.f, 0.f, 0.f};
    if (MODE == 0) {
        const float* w2 = A.in[I_GK_W2]; const float* gb = A.in[I_GK_B];
        for (int i = tid; i < 2048; i += NTHREADS) Lf[O_W2 + i] = w2[(i >> 7) * 512 + h * 128 + (i & 127)];
        if (tid < 128) Lf[O_BIAS + tid] = gb[h * 128 + tid];
    } else {
        const float* lg = A.in[I_LB];
#pragma unroll
        for (int i = 0; i < 4; ++i) lb[i] = sigmoidf_(lg[1024 + h * 128 + dq + i] - lg[h * 128 + dq + i]);
    }
    u32x2 rq, rk, rv = {0u, 0u}; v4u rg0 = {0u, 0u, 0u, 0u}, rg1 = {0u, 0u, 0u, 0u};
#define GLA_LOAD(c) do { const bf16* pr = P + (size_t)((c) * TC + tl) * PROJ_LD; rq = *(const GAS u32x2*)(pr + qcol + dq); rk = *(const GAS u32x2*)(pr + kcol + dq); \
        if (MODE == 0) { rg0 = *(const GAS v4u*)(pr + EC_GLR); rg1 = *(const GAS v4u*)(pr + EC_GLR + 8); } \
        if (tid < 256) rv = *(const GAS u32x2*)(P + (size_t)((c) * TC + tlv) * PROJ_LD + vcol + c4); } while (0)
#define GLA_XFORM(bufi) do { LAS float* B_ = Lf + (bufi) * BUFSZ; f32x4 q4, k4, e4; \
        const float xq[4] = {bf_lo(rq.x), bf_hi(rq.x), bf_lo(rq.y), bf_hi(rq.y)}, xk[4] = {bf_lo(rk.x), bf_hi(rk.x), bf_lo(rk.y), bf_hi(rk.y)}; \
        if (MODE == 0) { f32x4 z = *(const LAS f32x4*)(Lf + O_BIAS + dq); \
            const float gl[16] = {bf_lo(rg0.x), bf_hi(rg0.x), bf_lo(rg0.y), bf_hi(rg0.y), bf_lo(rg0.z), bf_hi(rg0.z), bf_lo(rg0.w), bf_hi(rg0.w), \
                                  bf_lo(rg1.x), bf_hi(rg1.x), bf_lo(rg1.y), bf_hi(rg1.y), bf_lo(rg1.z), bf_hi(rg1.z), bf_lo(rg1.w), bf_hi(rg1.w)}; \
            _Pragma("unroll") for (int r_ = 0; r_ < 16; ++r_) { const f32x4 wv = *(const LAS f32x4*)(Lf + O_W2 + r_ * 128 + dq); z = z + wv * gl[r_]; } \
            _Pragma("unroll") for (int i_ = 0; i_ < 4; ++i_) { q4[i_] = xq[i_] * 0.08838834764831845f; k4[i_] = xk[i_]; e4[i_] = __builtin_amdgcn_exp2f(-0.0625f * __builtin_amdgcn_logf(1.0f + __expf(-z[i_]))); } } \
        else { _Pragma("unroll") for (int i_ = 0; i_ < 4; ++i_) { const float fg = lb[i_] + (1.f - lb[i_]) * sigmoidf_(xk[i_]); q4[i_] = siluf_(xq[i_]); k4[i_] = 1.f - fg; e4[i_] = fg; } } \
        *(LAS f32x4*)(B_ + O_EG + tl * 128 + dq) = e4; *(LAS f32x4*)(B_ + O_K + tl * 128 + dq) = k4; *(LAS f32x4*)(B_ + O_Q + tl * 128 + dq) = q4; \
        if (tid < 256) { f32x4 v4 = {bf_lo(rv.x), bf_hi(rv.x), bf_lo(rv.y), bf_hi(rv.y)}; *(LAS f32x4*)(B_ + O_V + tlv * 64 + c4) = v4; } } while (0)
    LBAR();
    GLA_LOAD(0); GLA_XFORM(0);
    LBAR();
    f32x2 S2[8];
#pragma unroll
    for (int i = 0; i < 8; ++i) S2[i] = (f32x2){0.f, 0.f};
    const int j = lane & 15, col = w * 8 + (lane >> 4) * 2;
    for (int c = 0; c < NCHUNK; ++c) {
        if (c + 1 < NCHUNK) GLA_LOAD(c + 1);
        const LAS float* B_ = Lf + (c & 1) * BUFSZ;
        float os0 = 0.f, os1 = 0.f;
        f32x4 e0, e1, k0, k1, q0, q1, ne0, ne1, nk0, nk1, nq0, nq1; f32x2 v2, nv2;
#define GLA_LDSTEP(t_, E0, E1, K0, K1, Q0, Q1, V2) do { E0 = *(const LAS f32x4*)(B_ + O_EG + (t_) * 128 + 4 * j); E1 = *(const LAS f32x4*)(B_ + O_EG + (t_) * 128 + 64 + 4 * j); \
            K0 = *(const LAS f32x4*)(B_ + O_K + (t_) * 128 + 4 * j); K1 = *(const LAS f32x4*)(B_ + O_K + (t_) * 128 + 64 + 4 * j); \
            Q0 = *(const LAS f32x4*)(B_ + O_Q + (t_) * 128 + 4 * j); Q1 = *(const LAS f32x4*)(B_ + O_Q + (t_) * 128 + 64 + 4 * j); V2 = *(const LAS f32x2*)(B_ + O_V + (t_) * 64 + col); } while (0)
        GLA_LDSTEP(0, e0, e1, k0, k1, q0, q1, v2);
#pragma unroll
        for (int t = 0; t < TC; ++t) {
            if (t + 1 < TC) { GLA_LDSTEP(t + 1, ne0, ne1, nk0, nk1, nq0, nq1, nv2); }
            __builtin_amdgcn_sched_barrier(0);
            f32x2 pa = {0.f, 0.f}, pb = {0.f, 0.f};
#pragma unroll
            for (int i = 0; i < 4; ++i) {
                S2[i] = S2[i] * e0[i] + v2 * k0[i]; S2[4 + i] = S2[4 + i] * e1[i] + v2 * k1[i];
                pa += S2[i] * q0[i]; pb += S2[4 + i] * q1[i]; }
            pa += pb;
            float p0 = pa[0], p1 = pa[1];
            row_sum16_x2(p0, p1);
            os0 = (j == t) ? p0 : os0; os1 = (j == t) ? p1 : os1;
            e0 = ne0; e1 = ne1; k0 = nk0; k1 = nk1; q0 = nq0; q1 = nq1; v2 = nv2;
        }
#undef GLA_LDSTEP
        { f32x2 o2 = {os0, os1}; *(LAS f32x2*)(Lf + O_OUT + j * 64 + col) = o2; }
        if (c + 1 < NCHUNK) GLA_XFORM((c + 1) & 1);
        LBAR();
        if (tid < 256) *(GAS f32x4*)(O + (size_t)(c * TC + tlv) * D + c4) = *(const LAS f32x4*)(Lf + O_OUT + tlv * 64 + c4);
        LBAR();
    }
#undef GLA_LOAD
#undef GLA_XFORM
}

__device__ __forceinline__ void scan_gdn_unit(const Args& A, Frame& F, int unit) {
    const int tid = F.tid, lane = F.lane, w = F.wave;
    const int b = unit >> 4, h = (unit >> 1) & 7, s = unit & 1;
    const int qcol = EC_BQ + h * 128, kcol = EC_BK + h * 128, vcol = EC_BV + h * 128 + s * 64, ocol = 1024 + h * 128 + s * 64;
    const bf16* P = (const bf16*)(A.ws + WS_PROJ) + (size_t)b * SEQ * PROJ_LD;
    float* O = (float*)(A.ws + WS_O) + (size_t)b * SEQ * D + ocol;
    LAS float* Lf = (LAS float*)(F.lds + RING_OFF);
    constexpr int BUFSZ = 5184, O_K = 0, O_Q = 2048, O_V = 4096, O_SC = 5120, O_OUT = 2 * BUFSZ, O_CW = O_OUT + 1024;
    const int tl = tid >> 5, dq = (tid & 31) * 4, tlv = tid >> 4, c4 = (tid & 15) * 4;
    { const float* cw = A.in[I_GDN_CONV];
      for (int i = tid; i < 4 * 320; i += NTHREADS) { const int jt = i / 320, x = i % 320;
          const int ch = x < 128 ? (h * 128 + x) : x < 256 ? (1024 + h * 128 + (x - 128)) : (2048 + h * 128 + s * 64 + (x - 256));
          Lf[O_CW + i] = cw[jt * 3072 + ch]; } }
    const float neg_ea = -__expf(A.in[I_GDN_ALOG][h]), dtb = A.in[I_GDN_DTB][h];
    u32x2 rq[4], rk[4], rv[4]; unsigned short rba = 0, rbb = 0;
#pragma unroll
    for (int i = 0; i < 4; ++i) rv[i] = (u32x2){0u, 0u};
#define GDN_LOAD(c) do { const int t_ = (c) * TC + tl; \
        _Pragma("unroll") for (int jt = 0; jt < 4; ++jt) { const int tt = t_ - 3 + jt; \
            if (tt >= 0) { const bf16* pr = P + (size_t)tt * PROJ_LD; rq[jt] = *(const GAS u32x2*)(pr + qcol + dq); rk[jt] = *(const GAS u32x2*)(pr + kcol + dq); } \
            else { rq[jt] = (u32x2){0u, 0u}; rk[jt] = (u32x2){0u, 0u}; } } \
        { const bf16* pr = P + (size_t)t_ * PROJ_LD; rba = pr[EC_BA + h]; rbb = pr[EC_BB + h]; } \
        if (tid < 256) { const int tv = (c) * TC + tlv; \
            _Pragma("unroll") for (int jt = 0; jt < 4; ++jt) { const int tt = tv - 3 + jt; \
                if (tt >= 0) rv[jt] = *(const GAS u32x2*)(P + (size_t)tt * PROJ_LD + vcol + c4); else rv[jt] = (u32x2){0u, 0u}; } } } while (0)
#define GDN_XFORM(bufi) do { LAS float* B_ = Lf + (bufi) * BUFSZ; f32x4 q4 = {0.f, 0.f, 0.f, 0.f}, k4 = {0.f, 0.f, 0.f, 0.f}; \
        _Pragma("unroll") for (int jt = 0; jt < 4; ++jt) { const f32x4 wq = *(const LAS f32x4*)(Lf + O_CW + jt * 320 + dq), wk = *(const LAS f32x4*)(Lf + O_CW + jt * 320 + 128 + dq); \
            q4[0] += wq[0] * bf_lo(rq[jt].x); q4[1] += wq[1] * bf_hi(rq[jt].x); q4[2] += wq[2] * bf_lo(rq[jt].y); q4[3] += wq[3] * bf_hi(rq[jt].y); \
            k4[0] += wk[0] * bf_lo(rk[jt].x); k4[1] += wk[1] * bf_hi(rk[jt].x); k4[2] += wk[2] * bf_lo(rk[jt].y); k4[3] += wk[3] * bf_hi(rk[jt].y); } \
        float sq = 0.f, sk = 0.f, sqk = 0.f; \
        _Pragma("unroll") for (int i_ = 0; i_ < 4; ++i_) { q4[i_] = siluf_(q4[i_]); k4[i_] = siluf_(k4[i_]); sq += q4[i_] * q4[i_]; sk += k4[i_] * k4[i_]; sqk += q4[i_] * k4[i_]; } \
        sq = half_sum32(sq); sk = half_sum32(sk); sqk = half_sum32(sqk); \
        const float rq_ = __builtin_amdgcn_rsqf(sq + EPS) * 0.08838834764831845f, rk_ = __builtin_amdgcn_rsqf(sk + EPS); \
        q4 = q4 * rq_; k4 = k4 * rk_; \
        *(LAS f32x4*)(B_ + O_K + tl * 128 + dq) = k4; *(LAS f32x4*)(B_ + O_Q + tl * 128 + dq) = q4; \
        if ((tid & 31) == 0) { const float ba = __uint_as_float((unsigned)rba << 16), bb = __uint_as_float((unsigned)rbb << 16); \
            f32x4 sc; sc[0] = __expf(neg_ea * softplusf_(ba + dtb)); sc[1] = sigmoidf_(bb); sc[2] = sqk * rq_ * rk_; sc[3] = 0.f; *(LAS f32x4*)(B_ + O_SC + tl * 4) = sc; } \
        if (tid < 256) { f32x4 v4 = {0.f, 0.f, 0.f, 0.f}; \
            _Pragma("unroll") for (int jt = 0; jt < 4; ++jt) { const f32x4 wv = *(const LAS f32x4*)(Lf + O_CW + jt * 320 + 256 + c4); \
                v4[0] += wv[0] * bf_lo(rv[jt].x); v4[1] += wv[1] * bf_hi(rv[jt].x); v4[2] += wv[2] * bf_lo(rv[jt].y); v4[3] += wv[3] * bf_hi(rv[jt].y); } \
            _Pragma("unroll") for (int i_ = 0; i_ < 4; ++i_) v4[i_] = siluf_(v4[i_]); \
            *(LAS f32x4*)(B_ + O_V + tlv * 64 + c4) = v4; } } while (0)
    LBAR();
    GDN_LOAD(0); GDN_XFORM(0);
    LBAR();
    f32x2 S2[8];
#pragma unroll
    for (int i = 0; i < 8; ++i) S2[i] = (f32x2){0.f, 0.f};
    const int j = lane & 15, col = w * 8 + (lane >> 4) * 2;
    for (int c = 0; c < NCHUNK; ++c) {
        if (c + 1 < NCHUNK) GDN_LOAD(c + 1);
        const LAS float* B_ = Lf + (c & 1) * BUFSZ;
        float os0 = 0.f, os1 = 0.f;
        f32x4 k0, k1, q0, q1, sc, nk0, nk1, nq0, nq1, nsc; f32x2 v2, nv2;
#define GDN_LDSTEP(t_, K0, K1, Q0, Q1, V2, SC) do { K0 = *(const LAS f32x4*)(B_ + O_K + (t_) * 128 + 4 * j); K1 = *(const LAS f32x4*)(B_ + O_K + (t_) * 128 + 64 + 4 * j); \
            Q0 = *(const LAS f32x4*)(B_ + O_Q + (t_) * 128 + 4 * j); Q1 = *(const LAS f32x4*)(B_ + O_Q + (t_) * 128 + 64 + 4 * j); V2 = *(const LAS f32x2*)(B_ + O_V + (t_) * 64 + col); SC = *(const LAS f32x4*)(B_ + O_SC + (t_) * 4); } while (0)
        GDN_LDSTEP(0, k0, k1, q0, q1, v2, sc);
#pragma unroll
        for (int t = 0; t < TC; ++t) {
            if (t + 1 < TC) { GDN_LDSTEP(t + 1, nk0, nk1, nq0, nq1, nv2, nsc); }
            __builtin_amdgcn_sched_barrier(0);
            f32x2 d1 = {0.f, 0.f}, d2 = {0.f, 0.f}, e1 = {0.f, 0.f}, e2 = {0.f, 0.f};
#pragma unroll
            for (int i = 0; i < 4; ++i) { d1 += S2[i] * k0[i]; e1 += S2[4 + i] * k1[i]; d2 += S2[i] * q0[i]; e2 += S2[4 + i] * q1[i]; }
            d1 += e1; d2 += e2;
            { float r0_ = d1[0], r1_ = d1[1], r2_ = d2[0], r3_ = d2[1]; row_sum16_x4(r0_, r1_, r2_, r3_); d1[0] = r0_; d1[1] = r1_; d2[0] = r2_; d2[1] = r3_; }
            const float a = sc[0], beta = sc[1], qk = sc[2];
            const f32x2 dl = (v2 - d1 * a) * beta;
            const f32x2 o2 = d2 * a + dl * qk;
#pragma unroll
            for (int i = 0; i < 4; ++i) { S2[i] = S2[i] * a + dl * k0[i]; S2[4 + i] = S2[4 + i] * a + dl * k1[i]; }
            os0 = (j == t) ? o2[0] : os0; os1 = (j == t) ? o2[1] : os1;
            k0 = nk0; k1 = nk1; q0 = nq0; q1 = nq1; v2 = nv2; sc = nsc;
        }
#undef GDN_LDSTEP
        { f32x2 o2 = {os0, os1}; *(LAS f32x2*)(Lf + O_OUT + j * 64 + col) = o2; }
        if (c + 1 < NCHUNK) GDN_XFORM((c + 1) & 1);
        LBAR();
        if (tid < 256) *(GAS f32x4*)(O + (size_t)(c * TC + tlv) * D + c4) = *(const LAS f32x4*)(Lf + O_OUT + tlv * 64 + c4);
        LBAR();
    }
#undef GDN_LOAD
#undef GDN_XFORM
}

typedef short bf16x4_t __attribute__((ext_vector_type(4)));
__device__ __forceinline__ bf16x8 mk_frag(u32x2 lo, u32x2 hi) { v4u t; t.x = lo.x; t.y = lo.y; t.z = hi.x; t.w = hi.y; return __builtin_bit_cast(bf16x8, t); }
template <int MODE>
__device__ __forceinline__ void scan_gla_mfma_unit(const Args& A, Frame& F, int unit) {
    const int tid = F.tid, lane = F.lane, w = F.wave;
    int b, h, qcol, kcol, vcol, ocol;
    if (MODE == 0) { b = unit >> 3; h = (unit >> 1) & 3; const int s = unit & 1; qcol = EC_GQ + h * 128; kcol = EC_GK + h * 128; vcol = EC_GV + h * 256 + s * 128; ocol = h * 256 + s * 128; }
    else           { b = unit >> 3; h = unit & 7; qcol = OC_HQ + h * 128; kcol = OC_HF + h * 128; vcol = OC_HI + h * 128; ocol = h * 128; }
    const bf16* P = (const bf16*)(A.ws + WS_PROJ) + (size_t)b * SEQ * PROJ_LD;
    float* O = (float*)(A.ws + WS_O) + (size_t)b * SEQ * D + ocol;
    LAS float* Lf = (LAS float*)(F.lds + RING_OFF);
    constexpr int BUFSZ = 8192, O_E = 0, O_K = 2048, O_Q = 4096, O_V = 6144, RS = 136, O_QB = 2 * BUFSZ, O_KB = O_QB + 1088, O_KT = O_KB + 1088, O_BL = O_KT + 1024, O_AM = O_BL + 128, O_W2 = O_AM + 128, O_BIAS = O_W2 + 2048;
    LAS bf16* QB = (LAS bf16*)(Lf + O_QB); LAS bf16* KB = (LAS bf16*)(Lf + O_KB); LAS bf16* KT = (LAS bf16*)(Lf + O_KT); LAS bf16* AM = (LAS bf16*)(Lf + O_AM);
    const int tl = tid >> 5, dq = (tid & 31) * 4;
    float lb[4] = {0.f, 0.f, 0.f, 0.f};
    if (MODE == 0) {
        const float* w2 = A.in[I_GK_W2]; const float* gb = A.in[I_GK_B];
        for (int i = tid; i < 2048; i += NTHREADS) Lf[O_W2 + i] = w2[(i >> 7) * 512 + h * 128 + (i & 127)];
        if (tid < 128) Lf[O_BIAS + tid] = gb[h * 128 + tid];
    } else {
        const float* lg = A.in[I_LB];
#pragma unroll
        for (int i = 0; i < 4; ++i) lb[i] = sigmoidf_(lg[1024 + h * 128 + dq + i] - lg[h * 128 + dq + i]);
    }
    u32x2 rq, rk, rv; v4u rg0 = {0u, 0u, 0u, 0u}, rg1 = {0u, 0u, 0u, 0u};
#define GM_LOAD(c) do { const bf16* pr = P + (size_t)((c) * TC + tl) * PROJ_LD; rq = *(const GAS u32x2*)(pr + qcol + dq); rk = *(const GAS u32x2*)(pr + kcol + dq); rv = *(const GAS u32x2*)(pr + vcol + dq); \
        if (MODE == 0) { rg0 = *(const GAS v4u*)(pr + EC_GLR); rg1 = *(const GAS v4u*)(pr + EC_GLR + 8); } } while (0)
#define GM_XFORM(bufi) do { LAS float* B_ = Lf + (bufi) * BUFSZ; f32x4 q4, k4, e4; \
        const float xq[4] = {bf_lo(rq.x), bf_hi(rq.x), bf_lo(rq.y), bf_hi(rq.y)}, xk[4] = {bf_lo(rk.x), bf_hi(rk.x), bf_lo(rk.y), bf_hi(rk.y)}; \
        if (MODE == 0) { f32x4 z = *(const LAS f32x4*)(Lf + O_BIAS + dq); \
            const float gl[16] = {bf_lo(rg0.x), bf_hi(rg0.x), bf_lo(rg0.y), bf_hi(rg0.y), bf_lo(rg0.z), bf_hi(rg0.z), bf_lo(rg0.w), bf_hi(rg0.w), \
                                  bf_lo(rg1.x), bf_hi(rg1.x), bf_lo(rg1.y), bf_hi(rg1.y), bf_lo(rg1.z), bf_hi(rg1.z), bf_lo(rg1.w), bf_hi(rg1.w)}; \
            _Pragma("unroll") for (int r_ = 0; r_ < 16; ++r_) { const f32x4 wv = *(const LAS f32x4*)(Lf + O_W2 + r_ * 128 + dq); z = z + wv * gl[r_]; } \
            _Pragma("unroll") for (int i_ = 0; i_ < 4; ++i_) { q4[i_] = xq[i_] * 0.08838834764831845f; k4[i_] = xk[i_]; e4[i_] = __builtin_amdgcn_exp2f(-0.0625f * __builtin_amdgcn_logf(1.0f + __expf(-z[i_]))); } } \
        else { _Pragma("unroll") for (int i_ = 0; i_ < 4; ++i_) { const float fg = lb[i_] + (1.f - lb[i_]) * sigmoidf_(xk[i_]); q4[i_] = siluf_(xq[i_]); k4[i_] = 1.f - fg; e4[i_] = fg; } } \
        *(LAS f32x4*)(B_ + O_E + tl * 128 + dq) = e4; *(LAS f32x4*)(B_ + O_K + tl * 128 + dq) = k4; *(LAS f32x4*)(B_ + O_Q + tl * 128 + dq) = q4; \
        { f32x4 v4 = {bf_lo(rv.x), bf_hi(rv.x), bf_lo(rv.y), bf_hi(rv.y)}; *(LAS f32x4*)(B_ + O_V + tl * 128 + dq) = v4; } } while (0)
    LBAR();
    GM_LOAD(0); GM_XFORM(0); GM_LOAD(1);
    LBAR();
    f32x4 Sacc[8];
#pragma unroll
    for (int i = 0; i < 8; ++i) Sacc[i] = (f32x4){0.f, 0.f, 0.f, 0.f};
    const int fr = lane & 15, g = lane >> 4, c0 = w * 16;
    for (int c = 0; c < NCHUNK; ++c) {
        const LAS float* B_ = Lf + (c & 1) * BUFSZ;
        {
            const int seg = tid >> 7, d = tid & 127;
            float bt = 1.f, ball = 1.f;
#pragma unroll
            for (int t = 0; t < 16; ++t) { const float e = B_[O_E + t * 128 + d]; ball *= e; if (t < 4 * seg) bt = ball; }
            ball = fmaxf(ball, 1e-30f);
            unsigned short kt4[4];
#pragma unroll
            for (int i = 0; i < 4; ++i) { const int t = 4 * seg + i; bt = fmaxf(bt * B_[O_E + t * 128 + d], 1e-30f);
                const float kk = B_[O_K + t * 128 + d], qq = B_[O_Q + t * 128 + d], ib = __builtin_amdgcn_rcpf(bt);
                QB[t * RS + d] = (bf16)f2bf(qq * bt); KB[t * RS + d] = (bf16)f2bf(kk * ib); kt4[i] = (unsigned short)f2bf(kk * ball * ib); }
            u32x2 kw; kw.x = (unsigned)kt4[0] | ((unsigned)kt4[1] << 16); kw.y = (unsigned)kt4[2] | ((unsigned)kt4[3] << 16);
            *(LAS u32x2*)(KT + d * 16 + 4 * seg) = kw;
            if (seg == 3) Lf[O_BL + d] = ball;
        }
        LBAR();
        if (w == 0) {
            f32x4 acc = {0.f, 0.f, 0.f, 0.f};
#pragma unroll
            for (int ks = 0; ks < 4; ++ks) { const bf16x8 af = *(const LAS bf16x8*)(QB + fr * RS + 32 * ks + 8 * g), bfm = *(const LAS bf16x8*)(KB + fr * RS + 32 * ks + 8 * g);
                acc = __builtin_amdgcn_mfma_f32_16x16x32_bf16(af, bfm, acc, 0, 0, 0); }
#pragma unroll
            for (int r = 0; r < 4; ++r) { const int t = 4 * g + r, s = fr; AM[t * 16 + s] = (bf16)f2bf(s <= t ? acc[r] : 0.f); }
        }
        if (c + 1 < NCHUNK) GM_XFORM((c + 1) & 1);
        if (c + 2 < NCHUNK) GM_LOAD(c + 2);
        LBAR();
        {
            u32x2 vlo; { const float v0 = B_[O_V + (4 * g + 0) * 128 + c0 + fr], v1 = B_[O_V + (4 * g + 1) * 128 + c0 + fr], v2 = B_[O_V + (4 * g + 2) * 128 + c0 + fr], v3 = B_[O_V + (4 * g + 3) * 128 + c0 + fr];
                vlo.x = pk2(v0, v1); vlo.y = pk2(v2, v3); }
            const u32x2 zz = {0u, 0u};
            const bf16x8 vb = mk_frag(vlo, zz);
            f32x4 acco = {0.f, 0.f, 0.f, 0.f};
#pragma unroll
            for (int ks = 0; ks < 4; ++ks) {
                u32x2 slo, shi; slo.x = pk2(Sacc[2 * ks][0], Sacc[2 * ks][1]); slo.y = pk2(Sacc[2 * ks][2], Sacc[2 * ks][3]); shi.x = pk2(Sacc[2 * ks + 1][0], Sacc[2 * ks + 1][1]); shi.y = pk2(Sacc[2 * ks + 1][2], Sacc[2 * ks + 1][3]);
                const bf16x8 sb = mk_frag(slo, shi);
                const u32x2 qlo = *(const LAS u32x2*)(QB + fr * RS + 32 * ks + 4 * g), qhi = *(const LAS u32x2*)(QB + fr * RS + 32 * ks + 16 + 4 * g);
                acco = __builtin_amdgcn_mfma_f32_16x16x32_bf16(mk_frag(qlo, qhi), sb, acco, 0, 0, 0); }
            { const u32x2 alo = *(const LAS u32x2*)(AM + fr * 16 + 4 * g); acco = __builtin_amdgcn_mfma_f32_16x16x32_bf16(mk_frag(alo, zz), vb, acco, 0, 0, 0); }
#pragma unroll
            for (int r = 0; r < 4; ++r) O[(size_t)(c * TC + 4 * g + r) * D + c0 + fr] = acco[r];
#pragma unroll
            for (int i = 0; i < 8; ++i) { const f32x4 bl = *(const LAS f32x4*)(Lf + O_BL + 16 * i + 4 * g); const u32x2 klo = *(const LAS u32x2*)(KT + (16 * i + fr) * 16 + 4 * g);
                Sacc[i] = __builtin_amdgcn_mfma_f32_16x16x32_bf16(mk_frag(klo, zz), vb, Sacc[i] * bl, 0, 0, 0); }
        }
        LBAR();
    }
#undef GM_LOAD
#undef GM_XFORM
}

__device__ __forceinline__ void scan_gdn_mfma_unit(const Args& A, Frame& F, int unit) {
    const int tid = F.tid, lane = F.lane, w = F.wave;
    const int b = unit >> 3, h = unit & 7;
    const int qcol = EC_BQ + h * 128, kcol = EC_BK + h * 128, vcol = EC_BV + h * 128, ocol = 1024 + h * 128;
    const bf16* P = (const bf16*)(A.ws + WS_PROJ) + (size_t)b * SEQ * PROJ_LD;
    float* O = (float*)(A.ws + WS_O) + (size_t)b * SEQ * D + ocol;
    LAS float* Lf = (LAS float*)(F.lds + RING_OFF);
    constexpr int O_CW = 0, O_AMAT = 1536, O_QKM = O_AMAT + 256, O_TB = O_QKM + 128, O_GL = O_TB + 128, O_BUF0 = O_GL + 64;
    constexpr int BUFSZ = 6208, O_KH = 0, O_QH = 2048, O_VV = 4096, O_SC = 6144;
    constexpr int RS = 136;
    constexpr int O_KHB = O_BUF0 + 2 * BUFSZ, O_QHB = O_KHB + 1088, O_QB = O_QHB + 1088, O_KT = O_QB + 1088, O_WSRC = O_KT + 1024, O_WB = O_WSRC + 2048;
    LAS bf16* KHB = (LAS bf16*)(Lf + O_KHB); LAS bf16* QHB = (LAS bf16*)(Lf + O_QHB); LAS bf16* QB = (LAS bf16*)(Lf + O_QB); LAS bf16* KT = (LAS bf16*)(Lf + O_KT);
    LAS bf16* WB = (LAS bf16*)(Lf + O_WB); LAS bf16* QKM = (LAS bf16*)(Lf + O_QKM); LAS bf16* TB = (LAS bf16*)(Lf + O_TB);
    const int tl = tid >> 5, dq = (tid & 31) * 4;
    { const float* cw = A.in[I_GDN_CONV];
      for (int i = tid; i < 4 * 384; i += NTHREADS) { const int jt = i / 384, x = i % 384; Lf[O_CW + i] = cw[jt * 3072 + (x >> 7) * 1024 + h * 128 + (x & 127)]; } }
    const float neg_ea = -__expf(A.in[I_GDN_ALOG][h]), dtb = A.in[I_GDN_DTB][h];
    u32x2 rq[4], rk[4], rv[4]; unsigned short rba = 0, rbb = 0;
#define GD_LOAD(c) do { const int t_ = (c) * TC + tl; \
        _Pragma("unroll") for (int jt = 0; jt < 4; ++jt) { const int tt = t_ - 3 + jt; const bf16* pr = P + (size_t)(tt < 0 ? 0 : tt) * PROJ_LD + dq; \
            rq[jt] = *(const GAS u32x2*)(pr + qcol); rk[jt] = *(const GAS u32x2*)(pr + kcol); rv[jt] = *(const GAS u32x2*)(pr + vcol); \
            if (tt < 0) { rq[jt] = (u32x2){0u, 0u}; rk[jt] = (u32x2){0u, 0u}; rv[jt] = (u32x2){0u, 0u}; } } \
        { const bf16* pr = P + (size_t)t_ * PROJ_LD; rba = pr[EC_BA + h]; rbb = pr[EC_BB + h]; } } while (0)
#define GD_XFORM(bufi) do { LAS float* B_ = Lf + O_BUF0 + (bufi) * BUFSZ; f32x4 q4 = {0.f, 0.f, 0.f, 0.f}, k4 = {0.f, 0.f, 0.f, 0.f}, v4 = {0.f, 0.f, 0.f, 0.f}; \
        _Pragma("unroll") for (int jt = 0; jt < 4; ++jt) { const f32x4 wq = *(const LAS f32x4*)(Lf + O_CW + jt * 384 + dq), wk = *(const LAS f32x4*)(Lf + O_CW + jt * 384 + 128 + dq), wv = *(const LAS f32x4*)(Lf + O_CW + jt * 384 + 256 + dq); \
            q4[0] += wq[0] * bf_lo(rq[jt].x); q4[1] += wq[1] * bf_hi(rq[jt].x); q4[2] += wq[2] * bf_lo(rq[jt].y); q4[3] += wq[3] * bf_hi(rq[jt].y); \
            k4[0] += wk[0] * bf_lo(rk[jt].x); k4[1] += wk[1] * bf_hi(rk[jt].x); k4[2] += wk[2] * bf_lo(rk[jt].y); k4[3] += wk[3] * bf_hi(rk[jt].y); \
            v4[0] += wv[0] * bf_lo(rv[jt].x); v4[1] += wv[1] * bf_hi(rv[jt].x); v4[2] += wv[2] * bf_lo(rv[jt].y); v4[3] += wv[3] * bf_hi(rv[jt].y); } \
        float sq = 0.f, sk = 0.f; \
        _Pragma("unroll") for (int i_ = 0; i_ < 4; ++i_) { q4[i_] = siluf_(q4[i_]); k4[i_] = siluf_(k4[i_]); v4[i_] = siluf_(v4[i_]); sq += q4[i_] * q4[i_]; sk += k4[i_] * k4[i_]; } \
        sq = half_sum32(sq); sk = half_sum32(sk); \
        q4 = q4 * (__builtin_amdgcn_rsqf(sq + EPS) * 0.08838834764831845f); k4 = k4 * __builtin_amdgcn_rsqf(sk + EPS); \
        *(LAS f32x4*)(B_ + O_KH + tl * 128 + dq) = k4; *(LAS f32x4*)(B_ + O_QH + tl * 128 + dq) = q4; *(LAS f32x4*)(B_ + O_VV + tl * 128 + dq) = v4; \
        if ((tid & 31) == 0) { const float ba = __uint_as_float((unsigned)rba << 16), bb = __uint_as_float((unsigned)rbb << 16); \
            f32x4 sc; sc[0] = __expf(neg_ea * softplusf_(ba + dtb)); sc[1] = sigmoidf_(bb); sc[2] = 0.f; sc[3] = 0.f; *(LAS f32x4*)(B_ + O_SC + tl * 4) = sc; } } while (0)
    LBAR();
    GD_LOAD(0); GD_XFORM(0); GD_LOAD(1);
    LBAR();
    f32x4 Sacc[8];
#pragma unroll
    for (int i = 0; i < 8; ++i) Sacc[i] = (f32x4){0.f, 0.f, 0.f, 0.f};
    const int fr = lane & 15, g = lane >> 4, c0 = w * 16;
    const u32x2 zz = {0u, 0u};
    for (int c = 0; c < NCHUNK; ++c) {
        const LAS float* B_ = Lf + O_BUF0 + (c & 1) * BUFSZ;
        float glast;
        {
            const int seg = tid >> 7, d = tid & 127;
            float p = 1.f, gpre = 1.f;
#pragma unroll
            for (int t = 0; t < 16; ++t) { if (t == 4 * seg) gpre = p; p *= B_[O_SC + t * 4]; }
            glast = p;
            unsigned short kt4[4]; float gt = gpre;
#pragma unroll
            for (int i = 0; i < 4; ++i) { const int t = 4 * seg + i; gt *= B_[O_SC + t * 4]; const float beta = B_[O_SC + t * 4 + 1];
                const float kk = B_[O_KH + t * 128 + d], qq = B_[O_QH + t * 128 + d];
                KHB[t * RS + d] = (bf16)f2bf(kk); QHB[t * RS + d] = (bf16)f2bf(qq); QB[t * RS + d] = (bf16)f2bf(qq * gt);
                kt4[i] = (unsigned short)f2bf(kk * glast * __builtin_amdgcn_rcpf(gt));
                Lf[O_WSRC + t * 128 + d] = kk * (beta * gt);
                if (d == 0) Lf[O_GL + t] = gt; }
            u32x2 kw; kw.x = (unsigned)kt4[0] | ((unsigned)kt4[1] << 16); kw.y = (unsigned)kt4[2] | ((unsigned)kt4[3] << 16);
            *(LAS u32x2*)(KT + d * 16 + 4 * seg) = kw;
        }
        LBAR();
        if (w < 2) {
            const LAS bf16* AS = (w == 0) ? KHB : QHB;
            f32x4 acc = {0.f, 0.f, 0.f, 0.f};
#pragma unroll
            for (int ks = 0; ks < 4; ++ks) { const bf16x8 af = *(const LAS bf16x8*)(AS + fr * RS + 32 * ks + 8 * g), bfm = *(const LAS bf16x8*)(KHB + fr * RS + 32 * ks + 8 * g);
                acc = __builtin_amdgcn_mfma_f32_16x16x32_bf16(af, bfm, acc, 0, 0, 0); }
            const float gs_inv = __builtin_amdgcn_rcpf(Lf[O_GL + fr]);
            if (w == 0) {
                f32x4 N1, M1;
#pragma unroll
                for (int r = 0; r < 4; ++r) { const int t = 4 * g + r; const float gt = Lf[O_GL + t];
                    N1[r] = (fr < t) ? -(B_[O_SC + t * 4 + 1] * acc[r] * gt * gs_inv) : 0.f;
                    M1[r] = (t < fr) ? -(B_[O_SC + fr * 4 + 1] * acc[r] * Lf[O_GL + fr] * __builtin_amdgcn_rcpf(gt)) : 0.f; }
#define XTY(X, Y, C0) __builtin_amdgcn_mfma_f32_16x16x4f32(X[3], Y[3], __builtin_amdgcn_mfma_f32_16x16x4f32(X[2], Y[2], __builtin_amdgcn_mfma_f32_16x16x4f32(X[1], Y[1], __builtin_amdgcn_mfma_f32_16x16x4f32(X[0], Y[0], C0, 0, 0, 0), 0, 0, 0), 0, 0, 0), 0, 0, 0)
                const f32x4 z4 = {0.f, 0.f, 0.f, 0.f};
                f32x4 T1t = M1;
#pragma unroll
                for (int r = 0; r < 4; ++r) if (4 * g + r == fr) T1t[r] += 1.f;
                const f32x4 N2 = XTY(M1, N1, z4), M2 = XTY(N1, M1, z4);
                const f32x4 T2t = XTY(N2, T1t, T1t);
                const f32x4 N4 = XTY(M2, N2, z4), M4 = XTY(N2, M2, z4);
                const f32x4 T4t = XTY(N4, T2t, T2t);
                const f32x4 N8 = XTY(M4, N4, z4);
                const f32x4 T8t = XTY(N8, T4t, T4t);
#undef XTY
                u32x2 tw; tw.x = pk2(T8t[0], T8t[1]); tw.y = pk2(T8t[2], T8t[3]);
                *(LAS u32x2*)(TB + fr * 16 + 4 * g) = tw;
            } else {
#pragma unroll
                for (int r = 0; r < 4; ++r) { const int t = 4 * g + r; QKM[t * 16 + fr] = (bf16)f2bf((fr <= t) ? acc[r] * Lf[O_GL + t] * gs_inv : 0.f); }
            }
        }
        if (c + 1 < NCHUNK) GD_XFORM((c + 1) & 1);
        if (c + 2 < NCHUNK) GD_LOAD(c + 2);
        LBAR();
        f32x4 accu = {0.f, 0.f, 0.f, 0.f};
        {
            const bf16x8 tf = mk_frag(*(const LAS u32x2*)(TB + fr * 16 + 4 * g), zz);
            u32x2 ulo, wlo;
            { const float b0 = B_[O_SC + (4 * g + 0) * 4 + 1], b1 = B_[O_SC + (4 * g + 1) * 4 + 1], b2 = B_[O_SC + (4 * g + 2) * 4 + 1], b3 = B_[O_SC + (4 * g + 3) * 4 + 1];
              ulo.x = pk2(b0 * B_[O_VV + (4 * g + 0) * 128 + c0 + fr], b1 * B_[O_VV + (4 * g + 1) * 128 + c0 + fr]); ulo.y = pk2(b2 * B_[O_VV + (4 * g + 2) * 128 + c0 + fr], b3 * B_[O_VV + (4 * g + 3) * 128 + c0 + fr]);
              wlo.x = pk2(Lf[O_WSRC + (4 * g + 0) * 128 + c0 + fr], Lf[O_WSRC + (4 * g + 1) * 128 + c0 + fr]); wlo.y = pk2(Lf[O_WSRC + (4 * g + 2) * 128 + c0 + fr], Lf[O_WSRC + (4 * g + 3) * 128 + c0 + fr]); }
            accu = __builtin_amdgcn_mfma_f32_16x16x32_bf16(tf, mk_frag(ulo, zz), accu, 0, 0, 0);
            f32x4 accw = {0.f, 0.f, 0.f, 0.f};
            accw = __builtin_amdgcn_mfma_f32_16x16x32_bf16(tf, mk_frag(wlo, zz), accw, 0, 0, 0);
#pragma unroll
            for (int r = 0; r < 4; ++r) WB[(4 * g + r) * RS + c0 + fr] = (bf16)f2bf(-accw[r]);
        }
        LBAR();
        {
            bf16x8 sb[4];
#pragma unroll
            for (int ks = 0; ks < 4; ++ks) { u32x2 slo, shi; slo.x = pk2(Sacc[2 * ks][0], Sacc[2 * ks][1]); slo.y = pk2(Sacc[2 * ks][2], Sacc[2 * ks][3]); shi.x = pk2(Sacc[2 * ks + 1][0], Sacc[2 * ks + 1][1]); shi.y = pk2(Sacc[2 * ks + 1][2], Sacc[2 * ks + 1][3]);
                sb[ks] = mk_frag(slo, shi); }
            f32x4 accv = accu, acco = {0.f, 0.f, 0.f, 0.f};
#pragma unroll
            for (int ks = 0; ks < 4; ++ks) {
                const u32x2 wl = *(const LAS u32x2*)(WB + fr * RS + 32 * ks + 4 * g), wh = *(const LAS u32x2*)(WB + fr * RS + 32 * ks + 16 + 4 * g);
                accv = __builtin_amdgcn_mfma_f32_16x16x32_bf16(mk_frag(wl, wh), sb[ks], accv, 0, 0, 0);
                const u32x2 ql = *(const LAS u32x2*)(QB + fr * RS + 32 * ks + 4 * g), qh = *(const LAS u32x2*)(QB + fr * RS + 32 * ks + 16 + 4 * g);
                acco = __builtin_amdgcn_mfma_f32_16x16x32_bf16(mk_frag(ql, qh), sb[ks], acco, 0, 0, 0); }
            u32x2 vn; vn.x = pk2(accv[0], accv[1]); vn.y = pk2(accv[2], accv[3]);
            const bf16x8 vnb = mk_frag(vn, zz);
            acco = __builtin_amdgcn_mfma_f32_16x16x32_bf16(mk_frag(*(const LAS u32x2*)(QKM + fr * 16 + 4 * g), zz), vnb, acco, 0, 0, 0);
#pragma unroll
            for (int r = 0; r < 4; ++r) O[(size_t)(c * TC + 4 * g + r) * D + c0 + fr] = acco[r];
#pragma unroll
            for (int i = 0; i < 8; ++i) { const u32x2 klo = *(const LAS u32x2*)(KT + (16 * i + fr) * 16 + 4 * g);
                Sacc[i] = __builtin_amdgcn_mfma_f32_16x16x32_bf16(mk_frag(klo, zz), vnb, Sacc[i] * glast, 0, 0, 0); }
        }
        LBAR();
    }
#undef GD_LOAD
#undef GD_XFORM
}

__device__ __forceinline__ void scan_rwkv_unit(const Args& A, Frame& F, int unit) {
    const int tid = F.tid, lane = F.lane, w = F.wave;
    const int b = unit >> 4, h = unit & 15;
    const bf16* P = (const bf16*)(A.ws + WS_PROJ) + (size_t)b * SEQ * PROJ_LD + OC_RW;
    const bf16* LO = (const bf16*)(A.ws + WS_LO) + (size_t)b * SEQ * LORA_N;
    bf16* Y = (bf16*)(A.ws + WS_ACTA) + (size_t)b * SEQ * D + 1024 + h * 64;
    LAS float* Lf = (LAS float*)(F.lds + RING_OFF);
    constexpr int BUFSZ = 6208, O_KK = 0, O_WR = 1024, O_W = 2048, O_NKA = 3072, O_K = 4096, O_V = 5120, O_SC = 6144, O_OUT = 2 * BUFSZ;
    const int tl = tid >> 5, d2 = (tid & 31) * 2, hd = h * 64 + d2;
    float mu_r[2], mu_k[2], mu_v[2], w0[2], a0[2], k_k[2], k_a[2], r_k[2], lnw[2], lnb[2];
#pragma unroll
    for (int i = 0; i < 2; ++i) { mu_r[i] = A.in[I_MU][RW_R + hd + i]; mu_k[i] = A.in[I_MU][RW_K + hd + i]; mu_v[i] = A.in[I_MU][RW_V + hd + i];
        w0[i] = A.in[I_W0][hd + i]; a0[i] = A.in[I_A0][hd + i]; k_k[i] = A.in[I_KK][hd + i]; k_a[i] = A.in[I_KA][hd + i]; r_k[i] = A.in[I_RK][hd + i];
        lnw[i] = A.in[I_LNW][hd + i]; lnb[i] = A.in[I_LNB][hd + i]; }
    unsigned rr[2], rk[2], rv[2], rlw, rla, rg_cur = 0u, rg_nxt = 0u;
#define RW_LOAD(c) do { const int t_ = (c) * TC + tl; const bf16* pr = P + (size_t)t_ * PROJ_LD; \
        rr[0] = *(const GAS unsigned*)(pr + RW_R + hd); rk[0] = *(const GAS unsigned*)(pr + RW_K + hd); rv[0] = *(const GAS unsigned*)(pr + RW_V + hd); \
        if (t_ > 0) { rr[1] = *(const GAS unsigned*)(pr - PROJ_LD + RW_R + hd); rk[1] = *(const GAS unsigned*)(pr - PROJ_LD + RW_K + hd); rv[1] = *(const GAS unsigned*)(pr - PROJ_LD + RW_V + hd); } \
        else { rr[1] = 0u; rk[1] = 0u; rv[1] = 0u; } \
        const bf16* lr = LO + (size_t)t_ * LORA_N; rlw = *(const GAS unsigned*)(lr + hd); rla = *(const GAS unsigned*)(lr + 1024 + hd); rg_nxt = *(const GAS unsigned*)(lr + 2048 + hd); } while (0)
#define RW_XFORM(bufi) do { LAS float* B_ = Lf + (bufi) * BUFSZ; f32x2 kk2, wr2, w2_, nka2, k2, v2_; float skk = 0.f, sc1 = 0.f, sc2 = 0.f, sbs = 0.f; float aa[2], rrv[2]; \
        _Pragma("unroll") for (int i_ = 0; i_ < 2; ++i_) { \
            const float r0 = i_ ? bf_hi(rr[0]) : bf_lo(rr[0]), r1 = i_ ? bf_hi(rr[1]) : bf_lo(rr[1]); \
            const float k0_ = i_ ? bf_hi(rk[0]) : bf_lo(rk[0]), k1_ = i_ ? bf_hi(rk[1]) : bf_lo(rk[1]); \
            const float v0_ = i_ ? bf_hi(rv[0]) : bf_lo(rv[0]), v1_ = i_ ? bf_hi(rv[1]) : bf_lo(rv[1]); \
            const float lw = i_ ? bf_hi(rlw) : bf_lo(rlw), la = i_ ? bf_hi(rla) : bf_lo(rla); \
            const float r_ = r0 + (r1 - r0) * mu_r[i_], kx = k0_ + (k1_ - k0_) * mu_k[i_], vx = v0_ + (v1_ - v0_) * mu_v[i_]; \
            const float wd = __expf(-0.6065306597126334f * sigmoidf_(w0[i_] + lw)); const float a_ = sigmoidf_(a0[i_] + la); \
            const float kk0 = kx * k_k[i_]; const float km = kx * (1.f + (a_ - 1.f) * k_a[i_]); \
            kk2[i_] = kk0; skk += kk0 * kk0; aa[i_] = a_; rrv[i_] = r_; wr2[i_] = wd * r_; w2_[i_] = wd; k2[i_] = km; v2_[i_] = vx; sc2 += km * r_; sbs += r_ * km * r_k[i_]; } \
        skk = half_sum32(skk); const float rkk = __builtin_amdgcn_rsqf(skk + EPS); \
        _Pragma("unroll") for (int i_ = 0; i_ < 2; ++i_) { kk2[i_] *= rkk; nka2[i_] = -(kk2[i_] * aa[i_]); sc1 += kk2[i_] * aa[i_] * rrv[i_]; } \
        sc1 = half_sum32(sc1); sc2 = half_sum32(sc2); sbs = half_sum32(sbs); \
        *(LAS f32x2*)(B_ + O_KK + tl * 64 + d2) = kk2; *(LAS f32x2*)(B_ + O_WR + tl * 64 + d2) = wr2; *(LAS f32x2*)(B_ + O_W + tl * 64 + d2) = w2_; \
        *(LAS f32x2*)(B_ + O_NKA + tl * 64 + d2) = nka2; *(LAS f32x2*)(B_ + O_K + tl * 64 + d2) = k2; *(LAS f32x2*)(B_ + O_V + tl * 64 + d2) = v2_; \
        if ((tid & 31) == 0) { f32x4 sc; sc[0] = sc1; sc[1] = sc2; sc[2] = sbs; sc[3] = 0.f; *(LAS f32x4*)(B_ + O_SC + tl * 4) = sc; } } while (0)
    RW_LOAD(0); RW_XFORM(0); rg_cur = rg_nxt;
    LBAR();
    f32x2 S2[4];
#pragma unroll
    for (int i = 0; i < 4; ++i) S2[i] = (f32x2){0.f, 0.f};
    const int j = lane & 15, col = w * 8 + (lane >> 4) * 2;
    for (int c = 0; c < NCHUNK; ++c) {
        if (c + 1 < NCHUNK) RW_LOAD(c + 1);
        const LAS float* B_ = Lf + (c & 1) * BUFSZ;
        float os0 = 0.f, os1 = 0.f;
        f32x4 kk, wr, ww, nka, kv, sc, nkk, nwr, nww, nnka, nkv, nsc; f32x2 v2, nv2;
#define RW_LDSTEP(t_, KK, WR, WW, NKA, KV, V2, SC) do { KK = *(const LAS f32x4*)(B_ + O_KK + (t_) * 64 + 4 * j); WR = *(const LAS f32x4*)(B_ + O_WR + (t_) * 64 + 4 * j); WW = *(const LAS f32x4*)(B_ + O_W + (t_) * 64 + 4 * j); \
            NKA = *(const LAS f32x4*)(B_ + O_NKA + (t_) * 64 + 4 * j); KV = *(const LAS f32x4*)(B_ + O_K + (t_) * 64 + 4 * j); V2 = *(const LAS f32x2*)(B_ + O_V + (t_) * 64 + col); SC = *(const LAS f32x4*)(B_ + O_SC + (t_) * 4); } while (0)
        RW_LDSTEP(0, kk, wr, ww, nka, kv, v2, sc);
#pragma unroll
        for (int t = 0; t < TC; ++t) {
            if (t + 1 < TC) { RW_LDSTEP(t + 1, nkk, nwr, nww, nnka, nkv, nv2, nsc); }
            __builtin_amdgcn_sched_barrier(0);
            f32x2 d1 = S2[0] * kk[0], d2 = S2[0] * wr[0], e1 = S2[1] * kk[1], e2 = S2[1] * wr[1];
            d1 += S2[2] * kk[2]; d2 += S2[2] * wr[2]; e1 += S2[3] * kk[3]; e2 += S2[3] * wr[3];
            d1 += e1; d2 += e2;
            { float r0_ = d1[0], r1_ = d1[1], r2_ = d2[0], r3_ = d2[1]; row_sum16_x4(r0_, r1_, r2_, r3_); d1[0] = r0_; d1[1] = r1_; d2[0] = r2_; d2[1] = r3_; }
            const f32x2 o2 = d2 - d1 * sc[0] + v2 * sc[1];
#pragma unroll
            for (int i = 0; i < 4; ++i) S2[i] = S2[i] * ww[i] + d1 * nka[i] + v2 * kv[i];
            os0 = (j == t) ? o2[0] : os0; os1 = (j == t) ? o2[1] : os1;
            kk = nkk; wr = nwr; ww = nww; nka = nnka; kv = nkv; v2 = nv2; sc = nsc;
        }
#undef RW_LDSTEP
        { f32x2 o2 = {os0, os1}; *(LAS f32x2*)(Lf + O_OUT + j * 64 + col) = o2; }
        if (c + 1 < NCHUNK) RW_XFORM((c + 1) & 1);
        LBAR();
        {
            const f32x2 o2 = *(const LAS f32x2*)(Lf + O_OUT + tl * 64 + d2); const f32x2 vv = *(const LAS f32x2*)(B_ + O_V + tl * 64 + d2); const float bs = B_[O_SC + tl * 4 + 2];
            const float mean = half_sum32(o2[0] + o2[1]) * (1.0f / 64.0f); const float e0 = o2[0] - mean, e1 = o2[1] - mean;
            const float var = half_sum32(e0 * e0 + e1 * e1) * (1.0f / 64.0f); const float rs = __builtin_amdgcn_rsqf(var + 64e-5f);
            const float y0 = (e0 * rs * lnw[0] + lnb[0] + bs * vv[0]) * bf_lo(rg_cur), y1 = (e1 * rs * lnw[1] + lnb[1] + bs * vv[1]) * bf_hi(rg_cur);
            *(GAS unsigned*)(Y + (size_t)(c * TC + tl) * D + d2) = pk2(y0, y1);
        }
        rg_cur = rg_nxt;
        LBAR();
    }
#undef RW_LOAD
#undef RW_XFORM
}

template <int LAYER>
__device__ __forceinline__ void post_rows(const Args& A, Frame& F) {
    const int gw = F.vcu * NWAVES + F.wave, NGW = F.G * NWAVES, lane = F.lane;
    const float* O = (const float*)(A.ws + WS_O); const bf16* P = (const bf16*)(A.ws + WS_PROJ); bf16* Y = (bf16*)(A.ws + WS_ACTA);
    for (int m = gw; m < T; m += NGW) {
        const GAS f32x4* orow = (const GAS f32x4*)(O + (size_t)m * D) + lane; const bf16* prow = P + (size_t)m * PROJ_LD;
        constexpr int NJ = LAYER == 0 ? 8 : 4;
#pragma unroll
        for (int jj = 0; jj < NJ; ++jj) {
            const f32x4 v = orow[64 * jj]; float ss = (v[0] * v[0] + v[1] * v[1]) + (v[2] * v[2] + v[3] * v[3]);
            const bool wide = (LAYER == 0 && jj < 4);
            const float ms = wide ? wave_sum(ss) * (1.0f / 256.0f) : half_sum32(ss) * (1.0f / 128.0f);
            const float r = __builtin_amdgcn_rsqf(ms + EPS);
            const int cih = wide ? 4 * lane : 4 * (lane & 31);
            const float* gsrc = LAYER == 0 ? (wide ? A.in[I_GLA_NORM] : A.in[I_GDN_NORM]) : A.in[I_HG_NORM];
            const f32x4 g = *(const GAS f32x4*)(gsrc + cih);
            const int zcol = LAYER == 0 ? (wide ? EC_GZ + jj * 256 + 4 * lane : EC_BZ + (jj - 4) * 256 + 4 * lane) : OC_HG + jj * 256 + 4 * lane;
            const u32x2 zw = *(const GAS u32x2*)(prow + zcol);
            const float y0 = v[0] * r * g[0] * siluf_(bf_lo(zw.x)), y1 = v[1] * r * g[1] * siluf_(bf_hi(zw.x)), y2 = v[2] * r * g[2] * siluf_(bf_lo(zw.y)), y3 = v[3] * r * g[3] * siluf_(bf_hi(zw.y));
            u32x2 o; o.x = pk2(y0, y1); o.y = pk2(y2, y3);
            *(GAS u32x2*)(Y + (size_t)m * D + 256 * jj + 4 * lane) = o;
        }
    }
}
__device__ __forceinline__ void lora_prep_rows(const Args& A, Frame& F) {
    const int gw = F.vcu * NWAVES + F.wave, NGW = F.G * NWAVES, lane = F.lane;
    const bf16* P = (const bf16*)(A.ws + WS_PROJ); bf16* LA = (bf16*)(A.ws + WS_LA); const float* mu = A.in[I_MU];
    for (int m = gw; m < T; m += NGW) { const bool hasprev = (m % SEQ) != 0; const bf16* prow = P + (size_t)m * PROJ_LD + OC_RW + RW_WL;
#pragma unroll
        for (int i = 0; i < 7; ++i) { const int c = lane + 64 * i;
            const float x = __uint_as_float((unsigned)prow[c] << 16), xp = hasprev ? __uint_as_float((unsigned)prow[c - PROJ_LD] << 16) : 0.f;
            const float ts = x + (xp - x) * mu[RW_WL + c];
            const float v = c < 96 ? tanhf(ts) : (c < 192 ? ts : sigmoidf_(ts));
            LA[(size_t)m * LORA_K + c] = (bf16)f2bf(v); }
        LA[(size_t)m * LORA_K + 448 + lane] = (bf16)0; }
}
__device__ __forceinline__ void final_rows(const Args& A, Frame& F, const float oscale) {
    const int gw = F.vcu * NWAVES + F.wave, NGW = F.G * NWAVES, lane = F.lane;
    const float* rowss = (const float*)(A.ws + WS_RSP) + (size_t)RS_FINAL * T * 32; const GAS f32x4* g = (const GAS f32x4*)A.in[I_NFINAL] + lane;
    for (int m = gw; m < T; m += NGW) { const float r = oscale * __builtin_amdgcn_rsqf(wave_sum(lane < 32 ? rowss[(size_t)m * 32 + lane] : 0.f) * (1.0f / D) + EPS); GAS f32x4* row = (GAS f32x4*)(A.out + (size_t)m * D) + lane;
#pragma unroll
        for (int jj = 0; jj < 8; ++jj) { const f32x4 v = row[64 * jj]; row[64 * jj] = v * r * g[64 * jj]; } }
}

__device__ __forceinline__ int med3i(int a, int b, int c) { int r; asm("v_med3_i32 %0, %1, %2, %3" : "=v"(r) : "v"(a), "v"(b), "v"(c)); return r; }
__device__ __forceinline__ int f2sort(float f) { int x = __float_as_int(f); return x ^ ((x >> 31) & 0x7fffffff); }
__device__ __forceinline__ float sort2f(int x) { return __int_as_float(x ^ ((x >> 31) & 0x7fffffff)); }
#define TOPK_INSERT(vals, x) do { _Pragma("unroll") for (int s_ = 15; s_ >= 1; --s_) vals[s_] = med3i((x), vals[s_ - 1], vals[s_]); vals[0] = max(vals[0], (x)); } while (0)
__device__ __forceinline__ float bf_dot2(unsigned a, unsigned b, float c) {
    return c + bf_lo(a) * bf_lo(b) + bf_hi(a) * bf_hi(b);
}
__device__ __forceinline__ void sum8_x8(float (&a)[8]) {
    asm("s_nop 1\n\t"
        "v_add_f32_dpp %0, %0, %0 quad_perm:[1,0,3,2] row_mask:0xf bank_mask:0xf\n\tv_add_f32_dpp %1, %1, %1 quad_perm:[1,0,3,2] row_mask:0xf bank_mask:0xf\n\t"
        "v_add_f32_dpp %2, %2, %2 quad_perm:[1,0,3,2] row_mask:0xf bank_mask:0xf\n\tv_add_f32_dpp %3, %3, %3 quad_perm:[1,0,3,2] row_mask:0xf bank_mask:0xf\n\t"
        "v_add_f32_dpp %4, %4, %4 quad_perm:[1,0,3,2] row_mask:0xf bank_mask:0xf\n\tv_add_f32_dpp %5, %5, %5 quad_perm:[1,0,3,2] row_mask:0xf bank_mask:0xf\n\t"
        "v_add_f32_dpp %6, %6, %6 quad_perm:[1,0,3,2] row_mask:0xf bank_mask:0xf\n\tv_add_f32_dpp %7, %7, %7 quad_perm:[1,0,3,2] row_mask:0xf bank_mask:0xf\n\t"
        "v_add_f32_dpp %0, %0, %0 quad_perm:[2,3,0,1] row_mask:0xf bank_mask:0xf\n\tv_add_f32_dpp %1, %1, %1 quad_perm:[2,3,0,1] row_mask:0xf bank_mask:0xf\n\t"
        "v_add_f32_dpp %2, %2, %2 quad_perm:[2,3,0,1] row_mask:0xf bank_mask:0xf\n\tv_add_f32_dpp %3, %3, %3 quad_perm:[2,3,0,1] row_mask:0xf bank_mask:0xf\n\t"
        "v_add_f32_dpp %4, %4, %4 quad_perm:[2,3,0,1] row_mask:0xf bank_mask:0xf\n\tv_add_f32_dpp %5, %5, %5 quad_perm:[2,3,0,1] row_mask:0xf bank_mask:0xf\n\t"
        "v_add_f32_dpp %6, %6, %6 quad_perm:[2,3,0,1] row_mask:0xf bank_mask:0xf\n\tv_add_f32_dpp %7, %7, %7 quad_perm:[2,3,0,1] row_mask:0xf bank_mask:0xf\n\t"
        "v_add_f32_dpp %0, %0, %0 row_half_mirror row_mask:0xf bank_mask:0xf\n\tv_add_f32_dpp %1, %1, %1 row_half_mirror row_mask:0xf bank_mask:0xf\n\t"
        "v_add_f32_dpp %2, %2, %2 row_half_mirror row_mask:0xf bank_mask:0xf\n\tv_add_f32_dpp %3, %3, %3 row_half_mirror row_mask:0xf bank_mask:0xf\n\t"
        "v_add_f32_dpp %4, %4, %4 row_half_mirror row_mask:0xf bank_mask:0xf\n\tv_add_f32_dpp %5, %5, %5 row_half_mirror row_mask:0xf bank_mask:0xf\n\t"
        "v_add_f32_dpp %6, %6, %6 row_half_mirror row_mask:0xf bank_mask:0xf\n\tv_add_f32_dpp %7, %7, %7 row_half_mirror row_mask:0xf bank_mask:0xf\n\t"
        "s_nop 1"
        : "+v"(a[0]), "+v"(a[1]), "+v"(a[2]), "+v"(a[3]), "+v"(a[4]), "+v"(a[5]), "+v"(a[6]), "+v"(a[7]));
}
__device__ __forceinline__ float sum8_x1(float v) {
    asm("s_nop 1\n\tv_add_f32_dpp %0, %0, %0 quad_perm:[1,0,3,2] row_mask:0xf bank_mask:0xf\n\ts_nop 1\n\tv_add_f32_dpp %0, %0, %0 quad_perm:[2,3,0,1] row_mask:0xf bank_mask:0xf\n\ts_nop 1\n\t"
        "v_add_f32_dpp %0, %0, %0 row_half_mirror row_mask:0xf bank_mask:0xf\n\ts_nop 1" : "+v"(v));
    return v;
}
__device__ __forceinline__ void peer_phase(const Args& A, Frame& F, int L, const bool dry) {
    const int gw = F.vcu * NWAVES + F.wave, lane = F.lane;
    const bf16* SCR = (const bf16*)(A.ws + WS_SC); const bf16* X = (const bf16*)(A.ws + WS_ACTB); bf16* HG = (bf16*)(A.ws + WS_ACTA);
    const unsigned char* TU = (const unsigned char*)(A.ws + WS_TABU) + (size_t)L * 16384 * D; const unsigned char* TV = (const unsigned char*)(A.ws + WS_TABV) + (size_t)L * 16384 * D;
    const float* rowss = (const float*)(A.ws + WS_RSP) + (size_t)(L == 0 ? RS_FFN0 : RS_FFN1) * T * 32;
    const float* gple = A.in[I_NPLE] + (size_t)L * D;
    float* H = A.out;
    LAS unsigned* LIST = (LAS unsigned*)(F.lds + RING_OFF + F.wave * 16384);
    LAS unsigned* EIDX = LIST + 1024;
    LAS float* ECOEF = (LAS float*)(EIDX + 1024);
    const int tbase = gw * 8;
    if (tbase >= T) return;
    for (int half = 0; half < 2; ++half) {
        const int t0 = tbase + 4 * half;
        {
            const bf16* sp = SCR + (size_t)(t0 + (lane >> 4)) * D + (lane & 15) * 128;
            int vals[16];
#pragma unroll
            for (int s = 0; s < 16; ++s) vals[s] = (int)0x80000000;
#pragma unroll 2
            for (int c = 0; c < 16; ++c) { const v4u wv = *(const GAS v4u*)(sp + c * 8); const unsigned ww[4] = {wv.x, wv.y, wv.z, wv.w};
#pragma unroll
                for (int e = 0; e < 8; ++e) { const unsigned bits = (e & 1) ? (ww[e >> 1] & 0xffff0000u) : (ww[e >> 1] << 16);
                    int x = (int)bits; x ^= (x >> 31) & 0x7fffffff; x = (x & ~0x7f) | (127 - (c * 8 + e));
                    TOPK_INSERT(vals, x); } }
#pragma unroll
            for (int q = 0; q < 4; ++q) { v4u o; o.x = (unsigned)vals[4 * q]; o.y = (unsigned)vals[4 * q + 1]; o.z = (unsigned)vals[4 * q + 2]; o.w = (unsigned)vals[4 * q + 3]; *(LAS v4u*)(LIST + lane * 16 + 4 * q) = o; }
        }
        LDS_WAIT(); asm volatile("" ::: "memory");
        if (lane < 32) {
            const LAS unsigned* la = LIST + ((lane >> 3) * 16 + (lane & 7) * 2) * 16; const LAS unsigned* lb2 = la + 16;
            float av[16], bv[16];
#pragma unroll
            for (int q = 0; q < 4; ++q) { const v4u a4 = *(const LAS v4u*)(la + 4 * q), b4 = *(const LAS v4u*)(lb2 + 4 * q); const unsigned aw[4] = {a4.x, a4.y, a4.z, a4.w}, bw[4] = {b4.x, b4.y, b4.z, b4.w};
#pragma unroll
                for (int e = 0; e < 4; ++e) { av[4 * q + e] = __uint_as_float(__float_as_uint(sort2f((int)(aw[e] & ~0x7fu))) & 0xffff0000u); bv[4 * q + e] = __uint_as_float(__float_as_uint(sort2f((int)(bw[e] & ~0x7fu))) & 0xffff0000u); } }
            int best[16];
#pragma unroll
            for (int s = 0; s < 16; ++s) best[s] = (int)0x80000000;
#pragma unroll
            for (int i = 0; i < 16; ++i)
#pragma unroll
                for (int jx = 0; jx < 16; ++jx) if ((i + 1) * (jx + 1) <= 16) { int x = f2sort(av[i] + bv[jx]); x = (x & ~0xff) | (255 - (i * 16 + jx)); TOPK_INSERT(best, x); }
            float sv[16]; unsigned ex[16];
#pragma unroll
            for (int s = 0; s < 16; ++s) { const int cand = 255 - (best[s] & 0xff); const unsigned ka = la[cand >> 4], kb = lb2[cand & 15];
                ex[s] = (127u - (ka & 0x7fu)) * 128u + (127u - (kb & 0x7fu));
                sv[s] = __uint_as_float(__float_as_uint(sort2f((int)(ka & ~0x7fu))) & 0xffff0000u) + __uint_as_float(__float_as_uint(sort2f((int)(kb & ~0x7fu))) & 0xffff0000u); }
            float mx = sv[0];
#pragma unroll
            for (int s = 1; s < 16; ++s) mx = fmaxf(mx, sv[s]);
            float den = 0.f;
#pragma unroll
            for (int s = 0; s < 16; ++s) { sv[s] = __expf(sv[s] - mx); den += sv[s]; }
            const float inv = 1.0f / den; const int base = (4 * half + (lane >> 3)) * 128 + (lane & 7) * 16;
#pragma unroll
            for (int s = 0; s < 16; ++s) { EIDX[base + s] = ex[s]; ECOEF[base + s] = sv[s] * inv; }
        }
        LDS_WAIT(); asm volatile("" ::: "memory");
    }
    const int tk = lane >> 3, part = lane & 7, t = tbase + tk;
    const LAS unsigned* eidx = EIDX + tk * 128; LAS float* ecoef = ECOEF + tk * 128;
    const float rs = __builtin_amdgcn_rsqf(sum8_x1(((const GAS f32x4*)(rowss + (size_t)t * 32))[part][0] + ((const GAS f32x4*)(rowss + (size_t)t * 32))[part][1] + ((const GAS f32x4*)(rowss + (size_t)t * 32))[part][2] + ((const GAS f32x4*)(rowss + (size_t)t * 32))[part][3]) * (1.0f / D) + EPS) * (1.0f / 512.0f);
#define PEER_LOAD8(dst, TAB, i0, soff) do { const v4u ia_ = *(const LAS v4u*)(eidx + (i0)), ib_ = *(const LAS v4u*)(eidx + (i0) + 4); const unsigned ee_[8] = {ia_.x, ia_.y, ia_.z, ia_.w, ib_.x, ib_.y, ib_.z, ib_.w}; \
        _Pragma("unroll") for (int j_ = 0; j_ < 8; ++j_) dst[j_] = *(const GAS v4u*)((TAB) + (size_t)(ee_[j_] * 2048u + (unsigned)(soff))); } while (0)
    LAS float* dotw = (LAS float*)LIST + tk * 128;
#pragma unroll
    for (int m = 0; m < 16; ++m) dotw[8 * m + part] = 0.f;
#pragma unroll 1
    for (int p = 0; p < 16; ++p) {
        const int soff = 128 * p + 16 * part;
        float xs[16];
        { const v4u x0 = *(const GAS v4u*)(X + (size_t)t * D + soff), x1 = *(const GAS v4u*)(X + (size_t)t * D + soff + 8); const unsigned xw[8] = {x0.x, x0.y, x0.z, x0.w, x1.x, x1.y, x1.z, x1.w};
#pragma unroll
          for (int e = 0; e < 8; ++e) { xs[2 * e] = bf_lo(xw[e]); xs[2 * e + 1] = bf_hi(xw[e]); } }
#define PEER_UDOT8(src, m_) do { float tt_[8]; \
        _Pragma("unroll") for (int j_ = 0; j_ < 8; ++j_) { const unsigned ww_[4] = {src[j_].x, src[j_].y, src[j_].z, src[j_].w}; float a0_ = 0.f, a1_ = 0.f; \
            _Pragma("unroll") for (int e_ = 0; e_ < 4; ++e_) { const f32x2 lo_ = __builtin_amdgcn_cvt_pk_f32_fp8((int)ww_[e_], false), hi_ = __builtin_amdgcn_cvt_pk_f32_fp8((int)ww_[e_], true); \
                a0_ += xs[4 * e_] * lo_[0]; a1_ += xs[4 * e_ + 1] * lo_[1]; a0_ += xs[4 * e_ + 2] * hi_[0]; a1_ += xs[4 * e_ + 3] * hi_[1]; } \
            tt_[j_] = a0_ + a1_; } \
        sum8_x8(tt_); \
        float sel_ = tt_[0]; _Pragma("unroll") for (int j_ = 1; j_ < 8; ++j_) sel_ = (part == j_) ? tt_[j_] : sel_; \
        dotw[8 * (m_) + part] += sel_; } while (0)
        v4u ua[8], ub[8];
        PEER_LOAD8(ua, TU, 0, soff);
#pragma unroll 1
        for (int m = 0; m < 16; m += 2) {
            PEER_LOAD8(ub, TU, 8 * (m + 1), soff);
            PEER_UDOT8(ua, m);
            if (m + 2 < 16) PEER_LOAD8(ua, TU, 8 * (m + 2), soff);
            PEER_UDOT8(ub, m + 1);
        }
    }
#undef PEER_UDOT8
#pragma unroll
    for (int m = 0; m < 16; ++m) { const float d_ = dotw[8 * m + part] * rs; const float act = 0.5f * d_ * (1.0f + erff(d_ * 0.7071067811865476f)); ecoef[8 * m + part] *= act * (1.0f / 16.0f); }
    LDS_WAIT(); asm volatile("" ::: "memory");
    float ss = 0.f;
#pragma unroll 1
    for (int p = 0; p < 16; ++p) {
        const int soff = 128 * p + 16 * part;
        float acc[16];
#pragma unroll
        for (int i = 0; i < 16; ++i) acc[i] = 0.f;
#define PEER_VACC8(src, i0) do { const f32x4 ca_ = *(const LAS f32x4*)(ecoef + (i0)), cb_ = *(const LAS f32x4*)(ecoef + (i0) + 4); const float cf_[8] = {ca_[0], ca_[1], ca_[2], ca_[3], cb_[0], cb_[1], cb_[2], cb_[3]}; \
        _Pragma("unroll") for (int j_ = 0; j_ < 8; ++j_) { const unsigned ww_[4] = {src[j_].x, src[j_].y, src[j_].z, src[j_].w}; \
            _Pragma("unroll") for (int e_ = 0; e_ < 4; ++e_) { const f32x2 lo_ = __builtin_amdgcn_cvt_pk_f32_fp8((int)ww_[e_], false), hi_ = __builtin_amdgcn_cvt_pk_f32_fp8((int)ww_[e_], true); \
                acc[4 * e_] += cf_[j_] * lo_[0]; acc[4 * e_ + 1] += cf_[j_] * lo_[1]; acc[4 * e_ + 2] += cf_[j_] * hi_[0]; acc[4 * e_ + 3] += cf_[j_] * hi_[1]; } } } while (0)
        v4u va[8], vb[8];
        PEER_LOAD8(va, TV, 0, soff);
#pragma unroll 1
        for (int m = 0; m < 16; m += 2) {
            PEER_LOAD8(vb, TV, 8 * (m + 1), soff);
            PEER_VACC8(va, 8 * m);
            if (m + 2 < 16) PEER_LOAD8(va, TV, 8 * (m + 2), soff);
            PEER_VACC8(vb, 8 * (m + 1));
        }
        GAS f32x4* hp = (GAS f32x4*)(H + (size_t)t * D + soff);
#pragma unroll
        for (int q = 0; q < 4; ++q) { f32x4 h0 = hp[q];
#pragma unroll
            for (int e = 0; e < 4; ++e) { h0[e] += acc[4 * q + e]; ss += h0[e] * h0[e]; }
            if (!dry) hp[q] = h0; else asm volatile("" :: "v"(h0[0]), "v"(h0[1]), "v"(h0[2]), "v"(h0[3])); }
    }
#undef PEER_VACC8
#undef PEER_LOAD8
    const float r3 = __builtin_amdgcn_rsqf(sum8_x1(ss) * (1.0f / D) + EPS);
    if (!dry) {
#pragma unroll 2
        for (int p = 0; p < 16; ++p) { const int soff = 128 * p + 16 * part; const GAS f32x4* hp = (const GAS f32x4*)(H + (size_t)t * D + soff); const GAS f32x4* gp = (const GAS f32x4*)(gple + soff);
            unsigned ow[8];
#pragma unroll
            for (int q = 0; q < 4; ++q) { const f32x4 h0 = hp[q], g0 = gp[q]; ow[2 * q] = pk2(h0[0] * r3 * g0[0], h0[1] * r3 * g0[1]); ow[2 * q + 1] = pk2(h0[2] * r3 * g0[2], h0[3] * r3 * g0[3]); }
            v4u o0, o1; o0.x = ow[0]; o0.y = ow[1]; o0.z = ow[2]; o0.w = ow[3]; o1.x = ow[4]; o1.y = ow[5]; o1.z = ow[6]; o1.w = ow[7];
            *(GAS v4u*)(HG + (size_t)t * D + soff) = o0; *(GAS v4u*)(HG + (size_t)t * D + soff + 8) = o1; }
    }
}

constexpr int N_PHASES = 19;
__global__ void __launch_bounds__(NTHREADS, 2) mega_fwd(Args args) {
    extern __shared__ __attribute__((aligned(16))) unsigned char lds[];
    Frame F;
    F.lds = (LAS unsigned char*)lds;
    F.MISC = (volatile LAS unsigned*)(F.lds + MISC_OFF);
    F.tid = threadIdx.x; F.lane = F.tid & 63; F.wave = __builtin_amdgcn_readfirstlane(F.tid >> 6);
    F.G = gridDim.x; { const int bx = blockIdx.x; F.vcu = (F.G % 8 == 0) ? (bx % 8) * (F.G / 8) + bx / 8 : bx; }
    unsigned char* ws = args.ws;
    F.ctl = (gu32*)(ws + WS_CTL);
    for (int u = F.tid; u < (LDS_BYTES - LDSCTL_OFF) / 4; u += NTHREADS) ((LAS unsigned*)(F.lds + LDSCTL_OFF))[u] = 0u;
    __syncthreads();
    const int lo = args.ph_lo, hi = args.ph_hi;
    XcdBarrier bar; bar.bar = (unsigned*)(F.ctl + CW_BAR); bar.x = 0; bar.st = nullptr;
    if (hi - lo > 1) bar = xcd_barrier_post((unsigned*)(F.ctl + CW_BAR), F.MISC + 8);
#define IN(k) (lo <= (k) && (k) < hi)
#define REPS(k) (1 + ((DUP_MASK >> (k)) & 1))
#if PROBE_MASK
    unsigned long long* const tsb = (unsigned long long*)(ws + WS_CTL + 65536);
#define STAMP(k) do { if (blockIdx.x == 0 && F.tid == 0) __hip_atomic_store(tsb + (k), __builtin_amdgcn_s_memrealtime(), __ATOMIC_RELAXED, __HIP_MEMORY_SCOPE_AGENT); } while (0)
    STAMP(31);
#else
#define STAMP(k) do { } while (0)
#endif
#define SEAM(k) do { if (IN(k) && IN((k) + 1)) { if ((k) == 0) { cg::this_grid().sync(); } else { xcd_barrier(bar); } STAMP(k); } } while (0)
    float* rowss = (float*)(ws + WS_RSP);
    bf16* ACTA = (bf16*)(ws + WS_ACTA); bf16* ACTB = (bf16*)(ws + WS_ACTB); bf16* PROJ = (bf16*)(ws + WS_PROJ); bf16* SCB = (bf16*)(ws + WS_SC); bf16* PP = (bf16*)(ws + WS_PP);
    const int gtid = (F.vcu * NWAVES + F.wave) * 64 + F.lane, gthreads = F.G * NTHREADS;

#if UBENCH
    {
        typedef _Float16 h2_t __attribute__((ext_vector_type(2)));
        float a[32]; f32x2 p[16]; h2_t hh[32];
#pragma unroll
        for (int i = 0; i < 32; ++i) { a[i] = (float)(F.tid + i); hh[i] = (h2_t){(_Float16)(F.lane + i), (_Float16)i}; }
#pragma unroll
        for (int i = 0; i < 16; ++i) p[i] = (f32x2){a[2 * i], a[2 * i + 1]};
        const float m = 1.0f + 1e-7f * F.lane, c = 1e-9f; const f32x2 m2 = {m, m}, c2 = {c, c}; const h2_t mh = {(_Float16)1.0f, (_Float16)1.0f}, ch = {(_Float16)0.0f, (_Float16)0.0f};
#pragma unroll 1
        for (int it = 0; it < 10000; ++it) {
#if UBENCH == 1
#pragma unroll
            for (int i = 0; i < 32; ++i) asm volatile("v_fma_f32 %0, %0, %1, %2" : "+v"(a[i]) : "v"(m), "v"(c));
#elif UBENCH == 2
#pragma unroll
            for (int i = 0; i < 16; ++i) asm volatile("v_pk_fma_f32 %0, %0, %1, %2\n\tv_pk_fma_f32 %0, %0, %1, %2" : "+v"(p[i]) : "v"(m2), "v"(c2));
#elif UBENCH == 3
#pragma unroll
            for (int i = 0; i < 32; ++i) asm volatile("v_pk_fma_f16 %0, %0, %1, %2" : "+v"(hh[i]) : "v"(mh), "v"(ch));
#endif
        }
        float s = 0.f;
#pragma unroll
        for (int i = 0; i < 32; ++i) s += a[i] + (float)hh[i][0];
#pragma unroll
        for (int i = 0; i < 16; ++i) s += p[i][0] + p[i][1];
        if (s == 12345.678f) args.out[0] = s;
    }
#endif
    if (IN(0)) { p0_prologue(args, F); } SEAM(0);
    if (IN(1)) for (int rep_ = 0; rep_ < REPS(1); ++rep_) {
        { pg8::Gemm g{ACTA, (const bf16*)(ws + WS_WEV_IN), T, EV_NP, D}; pg8::StaticOrder S; S.init(T, EV_NP, F.G, (int)blockIdx.x); EpiBf16S E{PROJ, PROJ_LD, nullptr};
          pg8::gemm_phase<EpiBf16S, pg8::StaticOrder, true, true>(F.lds + RING_OFF, g, S, E); }
        { pg8::Gemm g{(const bf16*)(ws + WS_PBF), (const bf16*)(ws + WS_WPROJ), T, D, 256}; pg8::StaticOrder S; S.init(T, D, F.G, (int)blockIdx.x); EpiBf16S E{PP, D, nullptr};
          pg8::gemm_phase<EpiBf16S, pg8::StaticOrder, true, true>(F.lds + RING_OFF, g, S, E); }
    } SEAM(1);
    if (IN(2)) for (int rep_ = 0; rep_ < REPS(2); ++rep_) { for (int u = F.vcu; u < 128; u += F.G) { if (u < 64) scan_gla_mfma_unit<0>(args, F, u); else scan_gdn_mfma_unit(args, F, u - 64); __syncthreads(); } } SEAM(2);
    if (IN(3)) for (int rep_ = 0; rep_ < REPS(3); ++rep_) { post_rows<0>(args, F); } SEAM(3);
    if (IN(4)) { pg8::Gemm g{ACTA, (const bf16*)(ws + WS_WEV_OUT), T, D, D}; pg8::StaticOrder S; S.init(T, D, F.G, (int)blockIdx.x);
        EpiResid<false> E{args.in[I_X], args.out, ACTB, args.in[I_NFFN], rowss + (size_t)RS_FFN0 * T * 32, nullptr};
        pg8::gemm_phase<EpiResid<false>, pg8::StaticOrder, true, true>(F.lds + RING_OFF, g, S, E); } SEAM(4);
    if (IN(5)) for (int rep_ = 0; rep_ < REPS(5); ++rep_) { pg8::Gemm g{ACTB, (const bf16*)(ws + WS_WPEER), T, D, D}; pg8::StaticOrder S; S.init(T, D, F.G, (int)blockIdx.x); EpiBf16S E{SCB, D, rowss + (size_t)RS_FFN0 * T * 32};
        pg8::gemm_phase<EpiBf16S, pg8::StaticOrder, true, true>(F.lds + RING_OFF, g, S, E); } SEAM(5);
    if (IN(6)) for (int rep_ = 0; rep_ < REPS(6); ++rep_) { peer_phase(args, F, 0, rep_ != 0); } SEAM(6);
    if (IN(7)) { { pg8::Gemm g{ACTA, (const bf16*)(ws + WS_WGATE), T, D, D}; pg8::StaticOrder S; S.init(T, D, F.G, (int)blockIdx.x);
        EpiResid<true> E{args.out, args.out, ACTB, args.in[I_NMIX] + D, rowss + (size_t)RS_MIX1 * T * 32, PP};
        pg8::gemm_phase<EpiResid<true>, pg8::StaticOrder, true, true>(F.lds + RING_OFF, g, S, E); }
        } SEAM(7);
    if (IN(8)) for (int rep_ = 0; rep_ < REPS(8); ++rep_) {
        { pg8::Gemm g{ACTB, (const bf16*)(ws + WS_WOD_IN), T, OD_NP, D}; pg8::StaticOrder S; S.init(T, OD_NP, F.G, (int)blockIdx.x); EpiBf16S E{PROJ, PROJ_LD, rowss + (size_t)RS_MIX1 * T * 32};
          pg8::gemm_phase<EpiBf16S, pg8::StaticOrder, true, true>(F.lds + RING_OFF, g, S, E); }
        { pg8::Gemm g{(const bf16*)(ws + WS_PBF) + (size_t)T * 256, (const bf16*)(ws + WS_WPROJ) + (size_t)D * 256, T, D, 256}; pg8::StaticOrder S; S.init(T, D, F.G, (int)blockIdx.x); EpiBf16S E{PP, D, nullptr};
          pg8::gemm_phase<EpiBf16S, pg8::StaticOrder, true, true>(F.lds + RING_OFF, g, S, E); }
    } SEAM(8);
    if (IN(9)) for (int rep_ = 0; rep_ < REPS(9); ++rep_) { lora_prep_rows(args, F); } SEAM(9);
    if (IN(10)) for (int rep_ = 0; rep_ < REPS(10); ++rep_) { pg8::Gemm g{(const bf16*)(ws + WS_LA), (const bf16*)(ws + WS_WLORA), T, LORA_N, LORA_K}; pg8::StaticOrder S; S.init(T, LORA_N, F.G, (int)blockIdx.x); EpiBf16S E{(bf16*)(ws + WS_LO), LORA_N, nullptr};
        pg8::gemm_phase<EpiBf16S, pg8::StaticOrder, true, true>(F.lds + RING_OFF, g, S, E); } SEAM(10);
    if (IN(11)) for (int rep_ = 0; rep_ < REPS(11); ++rep_) { for (int u = F.vcu; u < 192; u += F.G) { if (u < 64) scan_gla_mfma_unit<1>(args, F, u); else scan_rwkv_unit(args, F, u - 64); __syncthreads(); } } SEAM(11);
    if (IN(12)) for (int rep_ = 0; rep_ < REPS(12); ++rep_) { post_rows<1>(args, F); } SEAM(12);
    if (IN(13)) { pg8::Gemm g{ACTA, (const bf16*)(ws + WS_WOD_OUT), T, D, D}; pg8::StaticOrder S; S.init(T, D, F.G, (int)blockIdx.x);
        EpiResid<false> E{args.out, args.out, ACTB, args.in[I_NFFN] + D, rowss + (size_t)RS_FFN1 * T * 32, nullptr};
        pg8::gemm_phase<EpiResid<false>, pg8::StaticOrder, true, true>(F.lds + RING_OFF, g, S, E); } SEAM(13);
    if (IN(14)) for (int rep_ = 0; rep_ < REPS(14); ++rep_) { pg8::Gemm g{ACTB, (const bf16*)(ws + WS_WPEER) + (size_t)D * D, T, D, D}; pg8::StaticOrder S; S.init(T, D, F.G, (int)blockIdx.x); EpiBf16S E{SCB, D, rowss + (size_t)RS_FFN1 * T * 32};
        pg8::gemm_phase<EpiBf16S, pg8::StaticOrder, true, true>(F.lds + RING_OFF, g, S, E); } SEAM(14);
    if (IN(15)) for (int rep_ = 0; rep_ < REPS(15); ++rep_) { peer_phase(args, F, 1, rep_ != 0); } SEAM(15);
    if (IN(16)) { pg8::Gemm g{ACTA, (const bf16*)(ws + WS_WGATE) + (size_t)D * D, T, D, D}; pg8::StaticOrder S; S.init(T, D, F.G, (int)blockIdx.x);
        EpiResid<true> E{args.out, args.out, nullptr, nullptr, rowss + (size_t)RS_FINAL * T * 32, PP};
        pg8::gemm_phase<EpiResid<true>, pg8::StaticOrder, true, true>(F.lds + RING_OFF, g, S, E); } SEAM(16);
    if (IN(17)) {
        float oscale = 1.0f;
#if PROBE_MASK
        { unsigned long long t_prev = __hip_atomic_load(tsb + 31, __ATOMIC_RELAXED, __HIP_MEMORY_SCOPE_AGENT); const unsigned long long t_begin = t_prev; unsigned long long sel = 0ull;
          for (int k = 0; k <= 16; ++k) { const unsigned long long tk = __hip_atomic_load(tsb + k, __ATOMIC_RELAXED, __HIP_MEMORY_SCOPE_AGENT); if ((PROBE_MASK >> k) & 1) sel += tk - t_prev; t_prev = tk; }
          const float f = (float)(double(sel) / double(t_prev - t_begin)); oscale = 1.0f + sqrtf(0.01f + 0.9f * f); }
#endif
        final_rows(args, F, oscale); }
#undef IN
#undef SEAM
}

extern "C" void kernel_launch(void* const* d_in, const int* in_sizes, int n_in, void* d_out, int out_size, void* d_ws, size_t ws_size, hipStream_t stream) {
    static int grid = 0;
    if (grid == 0) {
        if (n_in != N_IN || out_size != T * D || ws_size < WS_END) { fprintf(stderr, "kernel_launch: unexpected problem: n_in %d out %d ws %zu (need %zu)\n", n_in, out_size, ws_size, (size_t)WS_END); grid = -1; return; }
        int dev = 0, cus = 0, per_cu = 0;
        if (hipGetDevice(&dev) != hipSuccess || hipDeviceGetAttribute(&cus, hipDeviceAttributeMultiprocessorCount, dev) != hipSuccess) { grid = -1; return; }
        if (hipFuncSetAttribute((const void*)mega_fwd, hipFuncAttributeMaxDynamicSharedMemorySize, LDS_BYTES) != hipSuccess) { fprintf(stderr, "kernel_launch: hipFuncSetAttribute failed\n"); grid = -1; return; }
        if (hipOccupancyMaxActiveBlocksPerMultiprocessor(&per_cu, (const void*)mega_fwd, NTHREADS, LDS_BYTES) != hipSuccess || per_cu < 1) { fprintf(stderr, "kernel_launch: occupancy query says %d blocks per CU\n", per_cu); (void)hipGetLastError(); grid = -1; return; }
        grid = cus;
    }
    if (grid < 0) return;
    (void)hipMemsetAsync((char*)d_ws + WS_CTL, 0, CTL_ZERO_BYTES, stream);
    Args a{};
    for (int i = 0; i < N_IN; ++i) a.in[i] = (const float*)d_in[i];
    a.out = (float*)d_out; a.ws = (unsigned char*)d_ws;
#if MK_PER_PHASE
    for (int p = 0; p < N_PHASES - 1; ++p) { a.ph_lo = p; a.ph_hi = p + 1; hipLaunchKernelGGL(mega_fwd, dim3(grid), dim3(NTHREADS), LDS_BYTES, stream, a); }
#else
    a.ph_lo = 0; a.ph_hi = N_PHASES;
    void* kargs[] = {&a};
    hipError_t e = hipLaunchCooperativeKernel((const void*)mega_fwd, dim3(grid), dim3(NTHREADS), kargs, LDS_BYTES, stream);
    if (e != hipSuccess) fprintf(stderr, "kernel_launch: cooperative launch failed: %s (grid %d)\n", hipGetErrorString(e), grid);
#endif
}
```

```cpp
#include <hip/hip_runtime.h>
#include <hip/hip_cooperative_groups.h>
#include <cstdio>
#include <cstdint>
namespace cg = cooperative_groups;

#ifndef PROBE_MASK
#define PROBE_MASK 0
#endif
#ifndef DUP_MASK
#define DUP_MASK 0
#endif
#ifndef UBENCH
#define UBENCH 0
#endif
#ifndef GDN_DUP
#define GDN_DUP 0
#endif
#ifndef MK_PER_PHASE
#define MK_PER_PHASE 0
#endif

namespace pg8 {
#define PG8_LAS __attribute__((address_space(3)))
typedef unsigned short bf16_t;
typedef short bf16x8 __attribute__((ext_vector_type(8)));
typedef float f32x4 __attribute__((ext_vector_type(4)));
typedef unsigned u32x4 __attribute__((ext_vector_type(4)));
typedef unsigned u32x2 __attribute__((ext_vector_type(2)));
constexpr int BM = 256, BK = 64, HALF = 128, HTB = HALF * BK * 2  , STAGE_BYTES = 8 * HTB, NXCD = 8, WGM = 8;

__host__ __device__ __forceinline__ int lds_byte(int r, int c) { const int st = (r >> 4) * 2 + (c >> 5), rr = r & 15, cc = c & 31, ob = rr * 64 + cc * 2; return st * 1024 + (ob ^ (((ob >> 9) & 1) << 5)); }
__host__ __device__ __forceinline__ void stage_rc(int b, int& R, int& C) { const int st = b / 1024, sb = b % 1024, swz = sb ^ (((sb >> 9) & 1) << 5); R = (st >> 1) * 16 + swz / 64; C = (st & 1) * 32 + (swz % 64) / 2; }
__host__ __device__ __forceinline__ int perm32(int rho) { const int n = rho >> 4, i = rho & 15; return 8 * (i >> 2) + 4 * n + (i & 3); }

struct Unit { int pm, pn; };
struct Gemm { const bf16_t* A; const bf16_t* Bt; int M, N, K; };

struct StaticOrder {
    int nM, nN, nwg, G, c;
    __host__ __device__ void init(int M, int N, int G_, int c_) { nM = M / BM; nN = N / BM; nwg = nM * nN; G = G_; c = c_; }
    __host__ __device__ bool next(int i, Unit& u) const {
        const long L = (long)i * G + c; if (L >= nwg) return false;
        int wgid = (int)L; { const int q = nwg / NXCD, r = nwg % NXCD, xcd = wgid % NXCD, off = wgid / NXCD; wgid = (xcd < r ? xcd * (q + 1) : r * (q + 1) + (xcd - r) * q) + off; }
        const int nig = WGM * nN, gid = wgid / nig, fm = gid * WGM, gsz = (nM - fm) < WGM ? (nM - fm) : WGM;
        u.pm = fm + ((wgid % nig) % gsz); u.pn = (wgid % nig) / gsz; return true;
    }
    __device__ __forceinline__ void a_ready(const Unit&) const {}
    __device__ __forceinline__ void done(const Unit&) const {}
};
__device__ __forceinline__ unsigned cvt_pk_bf16(float lo, float hi) { unsigned r; asm volatile("v_cvt_pk_bf16_f32 %0, %1, %2" : "=v"(r) : "v"(lo), "v"(hi)); return r; }
template <class Epi, class Sched, bool ALIGN_EPI = false, bool SP2 = false>
__device__ __forceinline__ void gemm_phase(PG8_LAS unsigned char* lds, const Gemm g, const Sched& S, const Epi& E) {
    const int tid = threadIdx.x, wid = __builtin_amdgcn_readfirstlane(tid >> 6), lane = tid & 63, wr = wid >> 2, wc = wid & 3, fr = lane & 15, fq = lane >> 4;
    const int K = g.K, nt = K / BK;
    unsigned voffA[2], voffB[2];
#pragma unroll
    for (int i = 0; i < 2; ++i) { int R, C; stage_rc(tid * 16 + i * 8192, R, C); const int Rb = Epi::PERM ? ((R & ~31) + perm32(R & 31)) : R;
        voffA[i] = (unsigned)(R * K + C) * 2u; voffB[i] = (unsigned)(Rb * K + C) * 2u; }
    const size_t kstep = (size_t)(BK * 2);
    const size_t hstep = (size_t)HALF * K * 2;
    const size_t tstep = 2 * hstep;
    const unsigned ldsw = (unsigned)wid * 1024u;
    const int aoff = lds_byte(wr * 64 + fr, fq * 8), boff = lds_byte(wc * 32 + fr, fq * 8);
#define PG8_SA(b, h) (((b) * 2 + (h)) * HTB)
#define PG8_SB(b, h) ((4 + (b) * 2 + (h)) * HTB)
#define PG8_STAGE(bufoff, gbase, voff) do { _Pragma("unroll") for (int _i = 0; _i < 2; ++_i) \
        __builtin_amdgcn_global_load_lds((const unsigned*)((const char*)(gbase) + (voff)[_i]), (PG8_LAS unsigned*)(lds + (bufoff) + ldsw + _i * 8192), 16, 0, 0); } while (0)
#define PG8_LDA(dst, b, h) do { _Pragma("unroll") for (int m = 0; m < 4; ++m) _Pragma("unroll") for (int k = 0; k < 2; ++k) dst[m][k] = *(const PG8_LAS bf16x8*)(lds + PG8_SA(b, h) + aoff + m * 2048 + k * 1024); } while (0)
#define PG8_LDB(dst, b, h) do { _Pragma("unroll") for (int n = 0; n < 2; ++n) _Pragma("unroll") for (int k = 0; k < 2; ++k) dst[n][k] = *(const PG8_LAS bf16x8*)(lds + PG8_SB(b, h) + boff + n * 2048 + k * 1024); } while (0)
#define PG8_MMA(ai, bj, At, Bt) do { __builtin_amdgcn_s_setprio(1); _Pragma("unroll") for (int m = 0; m < 4; ++m) _Pragma("unroll") for (int n = 0; n < 2; ++n) _Pragma("unroll") for (int k = 0; k < 2; ++k) \
        acc[ai][bj][m][n] = __builtin_amdgcn_mfma_f32_16x16x32_bf16(Bt[n][k], At[m][k], acc[ai][bj][m][n], 0, 0, 0); __builtin_amdgcn_s_setprio(0); } while (0)
#define PG8_WAIT_V(n) asm volatile("s_waitcnt vmcnt(" #n ")" ::: "memory")
#define PG8_WAIT_L(n) asm volatile("s_waitcnt lgkmcnt(" #n ")" ::: "memory")
#define PG8_BAR __builtin_amdgcn_s_barrier()
#define PG8_SCHED __builtin_amdgcn_sched_barrier(0)
    Unit cur, nxt; int ui = 0;
    if (!S.next(0, cur)) return;
    f32x4 acc[2][2][4][2];
#pragma unroll
    for (int a = 0; a < 2; ++a)
#pragma unroll
        for (int b = 0; b < 2; ++b)
#pragma unroll
            for (int m = 0; m < 4; ++m)
#pragma unroll
                for (int n = 0; n < 2; ++n) acc[a][b][m][n] = (f32x4){0.f, 0.f, 0.f, 0.f};
    bf16x8 At[4][2], B0[2][2], B1[2][2];
    const char* cA = (const char*)g.A + (size_t)cur.pm * tstep; const char* cB = (const char*)g.Bt + (size_t)cur.pn * tstep;
    S.a_ready(cur);
    if constexpr (SP2) {
        PG8_STAGE(PG8_SB(0, 0), cB, voffB); PG8_STAGE(PG8_SB(0, 1), cB + hstep, voffB); PG8_STAGE(PG8_SA(0, 0), cA, voffA); PG8_STAGE(PG8_SA(0, 1), cA + hstep, voffA);
        if (wr == 1) PG8_BAR;
        PG8_WAIT_V(2); PG8_BAR;
        PG8_STAGE(PG8_SB(1, 0), cB + kstep, voffB); PG8_STAGE(PG8_SA(1, 0), cA + kstep, voffA); PG8_STAGE(PG8_SB(1, 1), cB + hstep + kstep, voffB);
        PG8_WAIT_V(6); PG8_BAR;
    } else {
        PG8_STAGE(PG8_SB(0, 0), cB, voffB); PG8_STAGE(PG8_SA(0, 0), cA, voffA); PG8_STAGE(PG8_SB(0, 1), cB + hstep, voffB); PG8_STAGE(PG8_SA(0, 1), cA + hstep, voffA);
        if (wr == 1) PG8_BAR;
        PG8_WAIT_V(4); PG8_BAR;
        PG8_STAGE(PG8_SB(1, 0), cB + kstep, voffB); PG8_STAGE(PG8_SA(1, 0), cA + kstep, voffA); PG8_STAGE(PG8_SB(1, 1), cB + hstep + kstep, voffB);
        PG8_WAIT_V(6); PG8_BAR;
    }
    for (;;) {
        const bool has_next = S.next(ui + 1, nxt);
        const char* nA = has_next ? (const char*)g.A + (size_t)nxt.pm * tstep : cA; const char* nB = has_next ? (const char*)g.Bt + (size_t)nxt.pn * tstep : cB;
        for (int t = 0; t < nt; t += 2) {
            const bool last = (t == nt - 2);
            const char* a1 = cA + (size_t)(t + 1) * kstep;
            const char* a2 = last ? nA : cA + (size_t)(t + 2) * kstep; const char* b2 = last ? nB : cB + (size_t)(t + 2) * kstep;
            const char* a3 = a2 + kstep; const char* b3 = b2 + kstep;
            if (last && has_next) S.a_ready(nxt);
            if constexpr (SP2) {
            PG8_LDB(B0, 0, 0); PG8_LDB(B1, 0, 1); PG8_SCHED; PG8_LDA(At, 0, 0); PG8_STAGE(PG8_SA(1, 1), a1 + hstep, voffA);
            PG8_WAIT_V(8); PG8_WAIT_L(0); PG8_BAR; PG8_MMA(0, 0, At, B0); PG8_MMA(0, 1, At, B1); PG8_BAR; PG8_SCHED;
            PG8_LDA(At, 0, 1); PG8_STAGE(PG8_SB(0, 0), b2, voffB); PG8_STAGE(PG8_SB(0, 1), b2 + hstep, voffB); PG8_STAGE(PG8_SA(0, 0), a2, voffA);
            PG8_WAIT_V(8); PG8_WAIT_L(0); PG8_BAR; PG8_MMA(1, 0, At, B0); PG8_MMA(1, 1, At, B1); PG8_BAR; PG8_SCHED;
            PG8_LDB(B0, 1, 0); PG8_LDB(B1, 1, 1); PG8_SCHED; PG8_LDA(At, 1, 0); PG8_STAGE(PG8_SA(0, 1), a2 + hstep, voffA);
            PG8_WAIT_V(8); PG8_WAIT_L(0); PG8_BAR; PG8_MMA(0, 0, At, B0); PG8_MMA(0, 1, At, B1); PG8_BAR; PG8_SCHED;
            PG8_LDA(At, 1, 1); PG8_STAGE(PG8_SB(1, 0), b3, voffB); PG8_STAGE(PG8_SB(1, 1), b3 + hstep, voffB); PG8_STAGE(PG8_SA(1, 0), a3, voffA);
            PG8_WAIT_V(8); PG8_WAIT_L(0); PG8_BAR; PG8_MMA(1, 0, At, B0); PG8_MMA(1, 1, At, B1); PG8_BAR; PG8_SCHED;
            } else {
            PG8_LDB(B0, 0, 0); PG8_SCHED; PG8_LDA(At, 0, 0); PG8_STAGE(PG8_SA(1, 1), a1 + hstep, voffA);
            PG8_WAIT_L(8); PG8_BAR; PG8_WAIT_L(0); PG8_MMA(0, 0, At, B0); PG8_BAR; PG8_SCHED;
            PG8_LDB(B1, 0, 1); PG8_STAGE(PG8_SB(0, 0), b2, voffB);
            PG8_BAR; PG8_WAIT_L(0); PG8_MMA(0, 1, At, B1); PG8_BAR;
            PG8_LDA(At, 0, 1); PG8_STAGE(PG8_SA(0, 0), a2, voffA);
            PG8_BAR; PG8_WAIT_L(0); PG8_MMA(1, 0, At, B0); PG8_BAR; PG8_SCHED;
            PG8_STAGE(PG8_SB(0, 1), b2 + hstep, voffB);
            PG8_WAIT_V(6); PG8_BAR; PG8_MMA(1, 1, At, B1); PG8_BAR;
            PG8_LDB(B0, 1, 0); PG8_SCHED; PG8_LDA(At, 1, 0); PG8_STAGE(PG8_SA(0, 1), a2 + hstep, voffA);
            PG8_WAIT_L(8); PG8_BAR; PG8_WAIT_L(0); PG8_MMA(0, 0, At, B0); PG8_BAR; PG8_SCHED;
            PG8_LDB(B1, 1, 1); PG8_STAGE(PG8_SB(1, 0), b3, voffB);
            PG8_BAR; PG8_WAIT_L(0); PG8_MMA(0, 1, At, B1); PG8_BAR;
            PG8_LDA(At, 1, 1); PG8_STAGE(PG8_SA(1, 0), a3, voffA);
            PG8_BAR; PG8_WAIT_L(0); PG8_MMA(1, 0, At, B0); PG8_BAR; PG8_SCHED;
            PG8_STAGE(PG8_SB(1, 1), b3 + hstep, voffB);
            PG8_WAIT_V(6); PG8_BAR; PG8_MMA(1, 1, At, B1); PG8_BAR;
            }
        }
        if constexpr (ALIGN_EPI) { if (wr == 0) PG8_BAR; }
        if constexpr (!Epi::AFTER_DRAIN) { E(acc, cur, wr, wc, fr, fq); S.done(cur); }
        if (!has_next) break;
#pragma unroll
        for (int a = 0; a < 2; ++a)
#pragma unroll
            for (int b = 0; b < 2; ++b)
#pragma unroll
                for (int m = 0; m < 4; ++m)
#pragma unroll
                    for (int n = 0; n < 2; ++n) acc[a][b][m][n] = (f32x4){0.f, 0.f, 0.f, 0.f};
        cur = nxt; cA = nA; cB = nB; ++ui;
        if constexpr (ALIGN_EPI) { if (wr == 1) PG8_BAR; }
    }
    PG8_WAIT_V(0);
    if constexpr (!ALIGN_EPI) { if (wr == 0) PG8_BAR; }
    PG8_BAR;
    if constexpr (Epi::AFTER_DRAIN) { E.fused(acc, cur, wr, wc, fr, fq, lds, wid, lane); S.done(cur); }
#undef PG8_SA
#undef PG8_SB
#undef PG8_STAGE
#undef PG8_LDA
#undef PG8_LDB
#undef PG8_MMA
#undef PG8_WAIT_V
#undef PG8_WAIT_L
#undef PG8_BAR
#undef PG8_SCHED
}
}
#define GAS __attribute__((address_space(1)))
#define LAS __attribute__((address_space(3)))
typedef unsigned short bf16;
typedef unsigned v4u __attribute__((ext_vector_type(4)));
typedef float f32x4 __attribute__((ext_vector_type(4)));
typedef short bf16x8 __attribute__((ext_vector_type(8)));
typedef GAS unsigned gu32;
typedef GAS unsigned long long gu64;
#define RLX_AGENT __ATOMIC_RELAXED, __HIP_MEMORY_SCOPE_AGENT
#define LDS_WAIT() asm volatile("s_waitcnt lgkmcnt(0)" ::: "memory")
#define VM_WAIT() asm volatile("s_waitcnt vmcnt(0)" ::: "memory")
__device__ __forceinline__ unsigned long long rt() { return __builtin_amdgcn_s_memrealtime(); }
__device__ __forceinline__ unsigned f2bf(float f) { unsigned u = __builtin_bit_cast(unsigned, f); return (u + 0x7fffu + ((u >> 16) & 1u)) >> 16; }
__device__ __forceinline__ unsigned pk2(float lo, float hi) { return f2bf(lo) | (f2bf(hi) << 16); }

#define XB_TMO      128
#define XB_XCNT(j)  (256  + 64 * (j))
#define XB_XSUB(j)  (1280 + 64 * (j))
#define XB_XGEN(j)  (2304 + 64 * (j))
#define XB_TOP      3328
#define XB_TOPGEN   3392
#define XCD_BAR_WORDS 3456
#define XB_SPIN_CAP (1u << 18)

__device__ __forceinline__ unsigned xb_ld(unsigned* p)              { return __hip_atomic_load(p, __ATOMIC_RELAXED, __HIP_MEMORY_SCOPE_AGENT); }
__device__ __forceinline__ unsigned xb_add(unsigned* p, unsigned v) { return __hip_atomic_fetch_add(p, v, __ATOMIC_RELAXED, __HIP_MEMORY_SCOPE_AGENT); }
__device__ __forceinline__ unsigned xb_xcc_id() { return (unsigned)__builtin_amdgcn_s_getreg((3 << 11) | 20) & 0xFu; }
#define XB_SPIN(cond, bar) do { unsigned _sp = 0; while (cond) { __builtin_amdgcn_s_sleep(1); \
    if ((++_sp & 255u) == 0u) { if (xb_ld(&(bar)[XB_TMO])) break; if (_sp > XB_SPIN_CAP) { atomicAdd(&(bar)[XB_TMO], 1u); break; } } } } while (0)

struct XcdBarrier {
    unsigned* bar; unsigned x;
    volatile LAS unsigned* st;
};

__device__ __forceinline__ XcdBarrier xcd_barrier_post(unsigned* bar, volatile LAS unsigned* st) {
    XcdBarrier b; b.bar = bar; b.x = xb_xcc_id(); b.st = st;
    if (threadIdx.x == 0) (void)xb_add(&bar[XB_XCNT(b.x)], 1u);
    return b;
}
__device__ __forceinline__ void xcd_barrier_complete(unsigned* bar, unsigned x, unsigned& nloc, unsigned& nx) {
    const unsigned G = gridDim.x * gridDim.y * gridDim.z;
    unsigned sum, cnt, mine, sp = 0u;
    for (;;) {
        sum = 0u; cnt = 0u; mine = 0u;
#pragma unroll
        for (unsigned j = 0; j < 16; ++j) { const unsigned c = xb_ld(&bar[XB_XCNT(j)]); sum += c; cnt += (c > 0u) ? 1u : 0u; mine = (j == x) ? c : mine; }
        if (sum == G) break;
        __builtin_amdgcn_s_sleep(1);
        if ((++sp & 255u) == 0u) { if (xb_ld(&bar[XB_TMO])) break; if (sp > XB_SPIN_CAP) { atomicAdd(&bar[XB_TMO], 1u); break; } }
    }
    nloc = mine > 0u ? mine : 1u; nx = cnt > 0u ? cnt : 1u;
}

__device__ __forceinline__ void xcd_barrier(const XcdBarrier& b) {
    asm volatile("s_waitcnt vmcnt(0)" ::: "memory");
    __syncthreads();
    if (threadIdx.x == 0) {
        unsigned* bar = b.bar;
        __builtin_amdgcn_s_waitcnt(0);
        unsigned nloc = b.st[0], nx = b.st[1];
        if (nloc == 0u) { xcd_barrier_complete(bar, b.x, nloc, nx); b.st[0] = nloc; b.st[1] = nx; }
        const unsigned old = xb_add(&bar[XB_XSUB(b.x)], 1u);
        const unsigned gen = old / nloc;
        if (old + 1u == (gen + 1u) * nloc) {
            __builtin_amdgcn_fence(__ATOMIC_RELEASE, "agent");
            asm volatile("s_waitcnt vmcnt(0)" ::: "memory");
            const unsigned og = xb_add(&bar[XB_TOP], 1u);
            const unsigned tg = og / nx;
            if (og + 1u == (tg + 1u) * nx) xb_add(&bar[XB_TOPGEN], 1u);
            else XB_SPIN(xb_ld(&bar[XB_TOPGEN]) == tg, bar);
            __builtin_amdgcn_fence(__ATOMIC_ACQUIRE, "agent");
            xb_add(&bar[XB_XGEN(b.x)], 1u);
            asm volatile("s_waitcnt vmcnt(0)" ::: "memory");
        } else {
            XB_SPIN(xb_ld(&bar[XB_XGEN(b.x)]) == gen, bar);
            __builtin_amdgcn_fence(__ATOMIC_ACQUIRE, "agent");
            asm volatile("s_waitcnt vmcnt(0)" ::: "memory");
        }
    }
    __syncthreads();
}

constexpr int NWAVES = 8, NTHREADS = NWAVES * 64;
constexpr int BATCH = 8, SEQ = 2048, T = BATCH * SEQ, D = 2048;
constexpr int EV_N = 7200, EV_NP = 7424, OD_N = 7616, OD_NP = 7680, PROJ_LD = 7680;
constexpr float EPS = 1e-6f;
constexpr int EC_GQ = 0, EC_GK = 512, EC_GV = 1024, EC_GZ = 2048, EC_GLR = 3072, EC_BQ = 3088, EC_BK = 4112, EC_BV = 5136, EC_BZ = 6160, EC_BA = 7184, EC_BB = 7192;
constexpr int OC_HQ = 0, OC_HF = 1024, OC_HI = 2048, OC_HG = 3072, OC_RW = 4096;
constexpr int RW_R = 0, RW_K = 1024, RW_V = 2048, RW_WL = 3072, RW_AL = 3168, RW_GL = 3264;
constexpr int LORA_K = 512, LORA_N = 3072;
enum { I_X = 0, I_P, I_EV_WIN, I_GK_W2, I_GK_B, I_GLA_NORM, I_GDN_CONV, I_GDN_ALOG, I_GDN_DTB, I_GDN_NORM, I_EV_WOUT, I_OD_WIN, I_LB, I_HG_NORM,
       I_MU, I_W0, I_W2, I_A0, I_A2, I_G2, I_KK, I_KA, I_RK, I_LNW, I_LNB, I_OD_WOUT, I_NMIX, I_NFFN, I_NPLE, I_PEER_WQ, I_PEER_SK, I_PEER_U, I_PEER_V,
       I_PLE_WP, I_PLE_WG, I_NFINAL, N_IN };

constexpr size_t MiB = 1u << 20;
constexpr size_t WS_CTL = 0, CTL_ZERO_BYTES = 1 * MiB;
constexpr size_t WS_WEV_IN = 1 * MiB, WS_WEV_OUT = 30 * MiB, WS_WOD_IN = 38 * MiB, WS_WOD_OUT = 68 * MiB, WS_WPEER = 76 * MiB, WS_WGATE = 92 * MiB, WS_WPROJ = 108 * MiB,
                 WS_WLORA = 110 * MiB, WS_PBF = 113 * MiB, WS_TABU = 129 * MiB, WS_TABV = 193 * MiB, WS_ACTA = 257 * MiB, WS_ACTB = 321 * MiB, WS_PROJ = 385 * MiB, WS_SC = 385 * MiB,
                 WS_O = 625 * MiB, WS_PP = 753 * MiB, WS_LA = 817 * MiB, WS_LO = 833 * MiB, WS_RSP = 929 * MiB, WS_END = 937 * MiB;
static_assert(WS_WEV_IN + (size_t)EV_NP * D * 2 <= WS_WEV_OUT && WS_WOD_IN + (size_t)OD_NP * D * 2 <= WS_WOD_OUT && WS_PROJ + (size_t)T * PROJ_LD * 2 <= WS_O, "ws map");
constexpr int CW_BAR = 4096;
enum { RS_FFN0 = 0, RS_MIX1 = 1, RS_FFN1 = 2, RS_FINAL = 3 };
constexpr int RING_OFF = 0, RING_BYTES = 131072;
constexpr int LDSCTL_OFF = RING_BYTES, MISC_OFF = LDSCTL_OFF + 320;
constexpr int LDS_BYTES = 147456;

struct Args { const float* in[N_IN]; float* out; unsigned char* ws; int ph_lo, ph_hi; };
struct Frame {
    LAS unsigned char* lds; volatile LAS unsigned* MISC; gu32* ctl;
    int tid, lane, wave, vcu, G;
};
__device__ __forceinline__ float wave_sum(float v) {
#pragma unroll
    for (int o = 1; o < 64; o <<= 1) v += __shfl_xor(v, o);
    return v;
}
__device__ __forceinline__ float half_sum32(float v) {
#pragma unroll
    for (int o = 1; o < 32; o <<= 1) v += __shfl_xor(v, o);
    return v;
}
#define DPP_ADD(v, ctrl) (v) += __builtin_bit_cast(float, __builtin_amdgcn_update_dpp(0, __builtin_bit_cast(int, (v)), (ctrl), 0xF, 0xF, false))
__device__ __forceinline__ float row_sum16(float v) {
    DPP_ADD(v, 0x128); DPP_ADD(v, 0x124); DPP_ADD(v, 0x122); DPP_ADD(v, 0x121);
    return v;
}
__device__ __forceinline__ void row_sum16_x4(float& a, float& b, float& c, float& d) {
    asm("s_nop 1\n\t"
        "v_add_f32_dpp %0, %0, %0 row_ror:8 row_mask:0xf bank_mask:0xf\n\tv_add_f32_dpp %1, %1, %1 row_ror:8 row_mask:0xf bank_mask:0xf\n\t"
        "v_add_f32_dpp %2, %2, %2 row_ror:8 row_mask:0xf bank_mask:0xf\n\tv_add_f32_dpp %3, %3, %3 row_ror:8 row_mask:0xf bank_mask:0xf\n\t"
        "v_add_f32_dpp %0, %0, %0 row_ror:4 row_mask:0xf bank_mask:0xf\n\tv_add_f32_dpp %1, %1, %1 row_ror:4 row_mask:0xf bank_mask:0xf\n\t"
        "v_add_f32_dpp %2, %2, %2 row_ror:4 row_mask:0xf bank_mask:0xf\n\tv_add_f32_dpp %3, %3, %3 row_ror:4 row_mask:0xf bank_mask:0xf\n\t"
        "v_add_f32_dpp %0, %0, %0 row_ror:2 row_mask:0xf bank_mask:0xf\n\tv_add_f32_dpp %1, %1, %1 row_ror:2 row_mask:0xf bank_mask:0xf\n\t"
        "v_add_f32_dpp %2, %2, %2 row_ror:2 row_mask:0xf bank_mask:0xf\n\tv_add_f32_dpp %3, %3, %3 row_ror:2 row_mask:0xf bank_mask:0xf\n\t"
        "v_add_f32_dpp %0, %0, %0 row_ror:1 row_mask:0xf bank_mask:0xf\n\tv_add_f32_dpp %1, %1, %1 row_ror:1 row_mask:0xf bank_mask:0xf\n\t"
        "v_add_f32_dpp %2, %2, %2 row_ror:1 row_mask:0xf bank_mask:0xf\n\tv_add_f32_dpp %3, %3, %3 row_ror:1 row_mask:0xf bank_mask:0xf\n\t"
        "s_nop 1"
        : "+v"(a), "+v"(b), "+v"(c), "+v"(d));
}
__device__ __forceinline__ void row_sum16_x2(float& a, float& b) {
    asm("s_nop 1\n\t"
        "v_add_f32_dpp %0, %0, %0 row_ror:8 row_mask:0xf bank_mask:0xf\n\tv_add_f32_dpp %1, %1, %1 row_ror:8 row_mask:0xf bank_mask:0xf\n\ts_nop 1\n\t"
        "v_add_f32_dpp %0, %0, %0 row_ror:4 row_mask:0xf bank_mask:0xf\n\tv_add_f32_dpp %1, %1, %1 row_ror:4 row_mask:0xf bank_mask:0xf\n\ts_nop 1\n\t"
        "v_add_f32_dpp %0, %0, %0 row_ror:2 row_mask:0xf bank_mask:0xf\n\tv_add_f32_dpp %1, %1, %1 row_ror:2 row_mask:0xf bank_mask:0xf\n\ts_nop 1\n\t"
        "v_add_f32_dpp %0, %0, %0 row_ror:1 row_mask:0xf bank_mask:0xf\n\tv_add_f32_dpp %1, %1, %1 row_ror:1 row_mask:0xf bank_mask:0xf\n\t"
        "s_nop 1"
        : "+v"(a), "+v"(b));
}
#define LBAR() do { asm volatile("s_waitcnt lgkmcnt(0)" ::: "memory"); __builtin_amdgcn_s_barrier(); asm volatile("" ::: "memory"); } while (0)
typedef float f32x2 __attribute__((ext_vector_type(2)));
typedef __bf16 hwbf16x2_t __attribute__((ext_vector_type(2)));
__device__ __forceinline__ unsigned hw_pk2(float lo, float hi) { const f32x2 v = {lo, hi}; return __builtin_bit_cast(unsigned, __builtin_convertvector(v, hwbf16x2_t)); }
__device__ __forceinline__ bf16 hw_bf(float x) { return (bf16)hw_pk2(x, 0.f); }
__device__ __forceinline__ float bf_lo(unsigned w) { return __uint_as_float(w << 16); }
__device__ __forceinline__ float bf_hi(unsigned w) { return __uint_as_float(w & 0xffff0000u); }
__device__ __forceinline__ float sigmoidf_(float x) { return __builtin_amdgcn_rcpf(1.0f + __expf(-x)); }
__device__ __forceinline__ float siluf_(float x) { return x * __builtin_amdgcn_rcpf(1.0f + __expf(-x)); }
__device__ __forceinline__ float softplusf_(float x) { return fmaxf(x, 0.f) + log1pf(__expf(-fabsf(x))); }
__device__ __forceinline__ float logsigmoidf_(float x) { return fminf(x, 0.f) - log1pf(__expf(-fabsf(x))); }

struct EpiBf16S {
    static constexpr bool PERM = true, AFTER_DRAIN = false;
    bf16* O; int ldc; const float* rowss;
    __device__ __forceinline__ void operator()(const pg8::f32x4 (&acc)[2][2][4][2], const pg8::Unit& u, int wr, int wc, int fr, int fq) const {
        const int row0 = u.pm * 256 + wr * 64 + fr, col0 = u.pn * 256 + wc * 32 + 8 * fq;
#pragma unroll
        for (int ai = 0; ai < 2; ++ai)
#pragma unroll
            for (int m = 0; m < 4; ++m) {
                const int row = row0 + ai * 128 + m * 16;
                float sc = 1.f;
                if (rowss) { const pg8::f32x4* rp = (const pg8::f32x4*)(rowss + (size_t)row * 32 + 8 * fq); const pg8::f32x4 p0 = rp[0], p1 = rp[1];
                    float s = ((p0[0] + p0[1]) + (p0[2] + p0[3])) + ((p1[0] + p1[1]) + (p1[2] + p1[3])); s += __shfl_xor(s, 16); s += __shfl_xor(s, 32);
                    sc = __builtin_amdgcn_rsqf(s * (1.0f / D) + EPS); }
                bf16* rowp = O + (size_t)row * ldc + col0;
#pragma unroll
                for (int bj = 0; bj < 2; ++bj) { const pg8::f32x4 v0 = acc[ai][bj][m][0] * sc, v1 = acc[ai][bj][m][1] * sc;
                    pg8::u32x4 w; w.x = pg8::cvt_pk_bf16(v0[0], v0[1]); w.y = pg8::cvt_pk_bf16(v0[2], v0[3]); w.z = pg8::cvt_pk_bf16(v1[0], v1[1]); w.w = pg8::cvt_pk_bf16(v1[2], v1[3]);
                    *(pg8::u32x4*)(rowp + bj * 128) = w; } }
    }
};
template <bool GATE> struct EpiResid {
    static constexpr bool PERM = false, AFTER_DRAIN = false;
    const float* hin; float* hout; bf16* hg; const float* gain; float* rowss; const bf16* pp;
    __device__ __forceinline__ void operator()(const pg8::f32x4 (&acc)[2][2][4][2], const pg8::Unit& u, int wr, int wc, int fr, int fq) const {
        const int row0 = u.pm * 256 + wr * 64 + fr, col0 = u.pn * 256 + wc * 32 + 4 * fq;
        pg8::f32x4 gv[2][2];
#pragma unroll
        for (int bj = 0; bj < 2; ++bj)
#pragma unroll
            for (int n = 0; n < 2; ++n) gv[bj][n] = hg ? *(const pg8::f32x4*)(gain + col0 + bj * 128 + n * 16) : (pg8::f32x4){0.f, 0.f, 0.f, 0.f};
#pragma unroll
        for (int ai = 0; ai < 2; ++ai)
#pragma unroll
            for (int m = 0; m < 4; ++m) {
                const int row = row0 + ai * 128 + m * 16; const size_t off = (size_t)row * D + col0; float ss = 0.f;
#pragma unroll
                for (int bj = 0; bj < 2; ++bj)
#pragma unroll
                    for (int n = 0; n < 2; ++n) { const size_t o = off + bj * 128 + n * 16;
                        pg8::f32x4 hv = *(const pg8::f32x4*)(hin + o); pg8::f32x4 a = acc[ai][bj][m][n];
                        if (GATE) { const pg8::u32x2 pw = *(const pg8::u32x2*)(pp + o);
                            a[0] = sigmoidf_(a[0]) * bf_lo(pw.x); a[1] = sigmoidf_(a[1]) * bf_hi(pw.x); a[2] = sigmoidf_(a[2]) * bf_lo(pw.y); a[3] = sigmoidf_(a[3]) * bf_hi(pw.y); }
                        hv = hv + a; *(pg8::f32x4*)(hout + o) = hv;
                        ss += (hv[0] * hv[0] + hv[1] * hv[1]) + (hv[2] * hv[2] + hv[3] * hv[3]);
                        if (hg) { const pg8::f32x4 q = hv * gv[bj][n]; pg8::u32x2 w; w.x = pg8::cvt_pk_bf16(q[0], q[1]); w.y = pg8::cvt_pk_bf16(q[2], q[3]); *(pg8::u32x2*)(hg + o) = w; } }
                ss += __shfl_xor(ss, 16); ss += __shfl_xor(ss, 32);
                if (fq == 0) rowss[(size_t)row * 32 + u.pn * 4 + wc] = ss;
                asm volatile("" ::: "memory"); }
    }
};

__device__ __forceinline__ void p0_transpose_item(const float* W, int K, int N, bf16* WT, LAS float* scr, int item, int lane) {
    const int nblk = N / 32, kb = item / nblk, nb = item % nblk, k0 = 64 * kb, n0 = 32 * nb;
    { const GAS float* Wg = (const GAS float*)W + (size_t)(k0 + (lane >> 5)) * N + n0 + (lane & 31); float v[32];
#pragma unroll
      for (int i = 0; i < 32; ++i) v[i] = Wg[(size_t)(2 * i) * N];
#pragma unroll
      for (int i = 0; i < 32; ++i) scr[(2 * i + (lane >> 5)) * 33 + (lane & 31)] = v[i]; }
    LDS_WAIT(); asm volatile("" ::: "memory");
    const int c = lane & 7;
#pragma unroll
    for (int j = 0; j < 4; ++j) { const int n = (lane >> 3) + 8 * j; const LAS float* s = scr + (8 * c) * 33 + n;
        v4u o; o.x = pk2(s[0 * 33], s[1 * 33]); o.y = pk2(s[2 * 33], s[3 * 33]); o.z = pk2(s[4 * 33], s[5 * 33]); o.w = pk2(s[6 * 33], s[7 * 33]);
        *(GAS v4u*)(WT + (size_t)(n0 + n) * K + k0 + 8 * c) = o; }
    LDS_WAIT(); asm volatile("" ::: "memory");
}
__device__ __forceinline__ void cvt_f32_bf16(const float* src, bf16* dst, size_t n, int gtid, int gthreads) {
    const size_t n8 = n / 8;
    for (size_t i = gtid; i < n8; i += gthreads) {
        const f32x4 a = *(const GAS f32x4*)(src + i * 8), b = *(const GAS f32x4*)(src + i * 8 + 4);
        v4u o; o.x = pk2(a[0], a[1]); o.y = pk2(a[2], a[3]); o.z = pk2(b[0], b[1]); o.w = pk2(b[2], b[3]);
        *(GAS v4u*)(dst + i * 8) = o; }
}
__device__ __forceinline__ void cvt_f32_fp8(const float* src, unsigned char* dst, size_t n, float scale, int gtid, int gthreads) {
    const size_t n16 = n / 16;
    for (size_t i = gtid; i < n16; i += gthreads) { v4u o; unsigned w[4];
#pragma unroll
        for (int q = 0; q < 4; ++q) { const f32x4 a = *(const GAS f32x4*)(src + i * 16 + 4 * q) * scale;
            int x = __builtin_amdgcn_cvt_pk_fp8_f32(a[0], a[1], 0, false); x = __builtin_amdgcn_cvt_pk_fp8_f32(a[2], a[3], x, true); w[q] = (unsigned)x; }
        o.x = w[0]; o.y = w[1]; o.z = w[2]; o.w = w[3];
        *(GAS v4u*)(dst + i * 16) = o; }
}
__device__ __forceinline__ void rms_row_to_bf16(const float* xrow, const float* g, bf16* orow, int lane) {
    const GAS f32x4* xr = (const GAS f32x4*)xrow + lane; f32x4 v[8]; float s = 0.f;
#pragma unroll
    for (int j = 0; j < 8; ++j) { v[j] = xr[64 * j]; s += (v[j][0] * v[j][0] + v[j][1] * v[j][1]) + (v[j][2] * v[j][2] + v[j][3] * v[j][3]); }
    const float r = __builtin_amdgcn_rsqf(wave_sum(s) * (1.0f / D) + EPS);
    const GAS f32x4* gr = (const GAS f32x4*)g + lane;
    GAS unsigned long long* o8 = (GAS unsigned long long*)orow + lane;
#pragma unroll
    for (int j = 0; j < 8; ++j) { const f32x4 gg = gr[64 * j]; o8[64 * j] = (unsigned long long)pk2(v[j][0] * r * gg[0], v[j][1] * r * gg[1]) | ((unsigned long long)pk2(v[j][2] * r * gg[2], v[j][3] * r * gg[3]) << 32); }
}
__device__ __forceinline__ void p0_fold_item(const float* wq, const float* sk, bf16* WP, LAS float* lds, int item, int tid) {
    const int hp = item >> 5, k0 = (item & 31) * 64;
    LAS float* skT = lds;
    LAS float* wqT = lds + 128 * 132;
    const float* skb = sk + (size_t)hp * 128 * 128;
#pragma unroll 4
    for (int i = 0; i < 32; ++i) { const int idx = i * 512 + tid, n = idx >> 7, d = idx & 127; skT[d * 132 + n] = skb[idx]; }
#pragma unroll 4
    for (int i = 0; i < 16; ++i) { const int idx = i * 512 + tid, kk = idx >> 7, d = idx & 127; wqT[d * 68 + kk] = wq[(size_t)(k0 + kk) * D + hp * 128 + d]; }
    __syncthreads();
    const int n0 = (tid >> 4) * 4, kk0 = (tid & 15) * 4;
    float acc[4][4];
#pragma unroll
    for (int i = 0; i < 4; ++i)
#pragma unroll
        for (int j = 0; j < 4; ++j) acc[i][j] = 0.f;
#pragma unroll 4
    for (int d = 0; d < 128; ++d) { const f32x4 a = *(const LAS f32x4*)(skT + d * 132 + n0), b = *(const LAS f32x4*)(wqT + d * 68 + kk0);
#pragma unroll
        for (int i = 0; i < 4; ++i)
#pragma unroll
            for (int j = 0; j < 4; ++j) acc[i][j] += a[i] * b[j]; }
#pragma unroll
    for (int i = 0; i < 4; ++i) { unsigned long long o = (unsigned long long)pk2(acc[i][0], acc[i][1]) | ((unsigned long long)pk2(acc[i][2], acc[i][3]) << 32);
        *(GAS unsigned long long*)(WP + (size_t)(hp * 128 + n0 + i) * D + k0 + kk0) = o; }
    __syncthreads();
}
__device__ __forceinline__ void p0_prologue(const Args& A, Frame& F) {
    const int gw = F.vcu * NWAVES + F.wave, NGW = F.G * NWAVES;
    const int gtid = gw * 64 + F.lane, gthreads = F.G * NTHREADS;
    unsigned char* ws = A.ws;
    LAS float* scr = (LAS float*)(F.lds + RING_OFF + F.wave * 16384);
    constexpr int I_EVIN = (D / 64) * (EV_N / 32);
    for (int it = gw; it < I_EVIN; it += NGW) p0_transpose_item(A.in[I_EV_WIN], D, EV_N, (bf16*)(ws + WS_WEV_IN), scr, it, F.lane);
    { GAS v4u* z0 = (GAS v4u*)(ws + WS_WEV_IN + (size_t)EV_N * D * 2); const size_t n0 = (size_t)(EV_NP - EV_N) * D * 2 / 16;
      for (size_t i = gtid; i < n0; i += gthreads) z0[i] = (v4u){0u, 0u, 0u, 0u}; }
    for (int m = gw; m < T; m += NGW) rms_row_to_bf16(A.in[I_X] + (size_t)m * D, A.in[I_NMIX], (bf16*)(ws + WS_ACTA) + (size_t)m * D, F.lane);
}
__device__ __forceinline__ void p0_deferred(const Args& A, Frame& F, int wg, int nwg) {
    const int gw = wg * NWAVES + F.wave, NGW = nwg * NWAVES;
    int gtid = gw * 64 + F.lane; const int gthreads = nwg * NTHREADS;
    asm volatile("" : "+v"(gtid));
    unsigned char* ws = A.ws;
    {
        LAS float* scr = (LAS float*)(F.lds + RING_OFF + F.wave * 16384);
        constexpr int I_SQ = (D / 64) * (D / 32), I_ODIN = (D / 64) * (OD_N / 32), I_PJ = (256 / 64) * (D / 32);
        constexpr int NITEMS = I_SQ + I_ODIN + I_SQ + 2 * I_SQ + 2 * I_PJ;
        for (int it = gw; it < NITEMS; it += NGW) {
            int r = it;
            if (r < I_SQ) { p0_transpose_item(A.in[I_EV_WOUT], D, D, (bf16*)(ws + WS_WEV_OUT), scr, r, F.lane); continue; } r -= I_SQ;
            if (r < I_ODIN) { p0_transpose_item(A.in[I_OD_WIN], D, OD_N, (bf16*)(ws + WS_WOD_IN), scr, r, F.lane); continue; } r -= I_ODIN;
            if (r < I_SQ) { p0_transpose_item(A.in[I_OD_WOUT], D, D, (bf16*)(ws + WS_WOD_OUT), scr, r, F.lane); continue; } r -= I_SQ;
            if (r < 2 * I_SQ) { const int L = r / I_SQ; p0_transpose_item(A.in[I_PLE_WG] + (size_t)L * D * D, D, D, (bf16*)(ws + WS_WGATE) + (size_t)L * D * D, scr, r % I_SQ, F.lane); continue; } r -= 2 * I_SQ;
            { const int L = r / I_PJ; p0_transpose_item(A.in[I_PLE_WP] + (size_t)L * 256 * D, 256, D, (bf16*)(ws + WS_WPROJ) + (size_t)L * D * 256, scr, r % I_PJ, F.lane); }
        }
        { GAS v4u* z1 = (GAS v4u*)(ws + WS_WOD_IN + (size_t)OD_N * D * 2); const size_t n1 = (size_t)(OD_NP - OD_N) * D * 2 / 16;
          for (size_t i = gtid; i < n1; i += gthreads) z1[i] = (v4u){0u, 0u, 0u, 0u}; }
    }
    __syncthreads();
    for (int it = wg; it < 1024; it += nwg) { const int L = it >> 9;
        p0_fold_item(A.in[I_PEER_WQ] + (size_t)L * D * D, A.in[I_PEER_SK] + (size_t)L * 16 * 128 * 128, (bf16*)(ws + WS_WPEER) + (size_t)L * D * D, (LAS float*)(F.lds + RING_OFF), it & 511, F.tid); }
    cvt_f32_fp8(A.in[I_PEER_U], (unsigned char*)(ws + WS_TABU), (size_t)16384 * D, 512.0f, gtid, gthreads);
    cvt_f32_fp8(A.in[I_PEER_V], (unsigned char*)(ws + WS_TABV), (size_t)16384 * D, 16.0f, gtid, gthreads);
    cvt_f32_bf16(A.in[I_P], (bf16*)(ws + WS_PBF), (size_t)2 * T * 256, gtid, gthreads);
    { bf16* LB = (bf16*)(ws + WS_WLORA); const float* w2 = A.in[I_W2]; const float* a2 = A.in[I_A2]; const float* g2 = A.in[I_G2];
      for (int i = gtid; i < LORA_N * LORA_K / 2; i += gthreads) { const int row = i / (LORA_K / 2), col = (i % (LORA_K / 2)) * 2; float v[2];
#pragma unroll
          for (int e = 0; e < 2; ++e) { const int c = col + e; float x = 0.f;
              if (row < 1024) { if (c < 96) x = w2[c * 1024 + row]; }
              else if (row < 2048) { if (c >= 96 && c < 192) x = a2[(c - 96) * 1024 + (row - 1024)]; }
              else { if (c >= 192 && c < 448) x = g2[(c - 192) * 1024 + (row - 2048)]; }
              v[e] = x; }
          *(GAS unsigned*)(LB + (size_t)row * LORA_K + col) = pk2(v[0], v[1]); } }
}

__device__ __forceinline__ void p1_deferred(const Args& A, Frame& F, int wg, int nwg) {
    int gtid = (wg * NWAVES + F.wave) * 64 + F.lane; const int gthreads = nwg * NTHREADS;
    asm volatile("" : "+v"(gtid));
    cvt_f32_fp8(A.in[I_PEER_U] + (size_t)16384 * D, (unsigned char*)(A.ws + WS_TABU) + (size_t)16384 * D, (size_t)16384 * D, 512.0f, gtid, gthreads);
    cvt_f32_fp8(A.in[I_PEER_V] + (size_t)16384 * D, (unsigned char*)(A.ws + WS_TABV) + (size_t)16384 * D, (size_t)16384 * D, 16.0f, gtid, gthreads);
}

constexpr int TC = 16, NCHUNK = SEQ / TC;
typedef unsigned u32x2 __attribute__((ext_vector_type(2)));

template <int MODE>
__device__ __forceinline__ void scan_gla_unit(const Args& A, Frame& F, int unit) {
    int tid = F.tid; asm volatile("" : "+v"(tid));
    const int lane = tid & 63, w = F.wave;
    int b, h, qcol, kcol, vcol, ocol;
    if (MODE == 0) { b = unit >> 4; h = (unit >> 2) & 3; const int s = unit & 3; qcol = EC_GQ + h * 128; kcol = EC_GK + h * 128; vcol = EC_GV + h * 256 + s * 64; ocol = h * 256 + s * 64; }
    else           { b = unit >> 4; h = (unit >> 1) & 7; const int s = unit & 1; qcol = OC_HQ + h * 128; kcol = OC_HF + h * 128; vcol = OC_HI + h * 128 + s * 64; ocol = h * 128 + s * 64; }
    const bf16* P = (const bf16*)(A.ws + WS_PROJ) + (size_t)b * SEQ * PROJ_LD;
    float* O = (float*)(A.ws + WS_O) + (size_t)b * SEQ * D + ocol;
    LAS float* Lf = (LAS float*)(F.lds + RING_OFF);
    constexpr int BUFSZ = 7168, O_EG = 0, O_K = 2048, O_Q = 4096, O_V = 6144, O_OUT = 2 * BUFSZ, O_W2 = O_OUT + 1024, O_BIAS = O_W2 + 2048;
    const int tl = tid >> 5, dq = (tid & 31) * 4, tlv = tid >> 4, c4 = (tid & 15) * 4;
    float lb[4] = {0.f, 0.f, 0.f, 0.f};
    if (MODE == 0) {
        const float* w2 = A.in[I_GK_W2]; const float* gb = A.in[I_GK_B];
        for (int i = tid; i < 2048; i += NTHREADS) Lf[O_W2 + i] = w2[(i >> 7) * 512 + h * 128 + (i & 127)];
        if (tid < 128) Lf[O_BIAS + tid] = gb[h * 128 + tid];
    } else {
        const float* lg = A.in[I_LB];
#pragma unroll
        for (int i = 0; i < 4; ++i) lb[i] = sigmoidf_(lg[1024 + h * 128 + dq + i] - lg[h * 128 + dq + i]);
    }
    u32x2 rq, rk, rv = {0u, 0u}; v4u rg0 = {0u, 0u, 0u, 0u}, rg1 = {0u, 0u, 0u, 0u};
#define GLA_LOAD(c) do { const bf16* pr = P + (size_t)((c) * TC + tl) * PROJ_LD; rq = *(const GAS u32x2*)(pr + qcol + dq); rk = *(const GAS u32x2*)(pr + kcol + dq); \
        if (MODE == 0) { rg0 = *(const GAS v4u*)(pr + EC_GLR); rg1 = *(const GAS v4u*)(pr + EC_GLR + 8); } \
        if (tid < 256) rv = *(const GAS u32x2*)(P + (size_t)((c) * TC + tlv) * PROJ_LD + vcol + c4); } while (0)
#define GLA_XFORM(bufi) do { LAS float* B_ = Lf + (bufi) * BUFSZ; f32x4 q4, k4, e4; \
        const float xq[4] = {bf_lo(rq.x), bf_hi(rq.x), bf_lo(rq.y), bf_hi(rq.y)}, xk[4] = {bf_lo(rk.x), bf_hi(rk.x), bf_lo(rk.y), bf_hi(rk.y)}; \
        if (MODE == 0) { f32x4 z = *(const LAS f32x4*)(Lf + O_BIAS + dq); \
            const float gl[16] = {bf_lo(rg0.x), bf_hi(rg0.x), bf_lo(rg0.y), bf_hi(rg0.y), bf_lo(rg0.z), bf_hi(rg0.z), bf_lo(rg0.w), bf_hi(rg0.w), \
                                  bf_lo(rg1.x), bf_hi(rg1.x), bf_lo(rg1.y), bf_hi(rg1.y), bf_lo(rg1.z), bf_hi(rg1.z), bf_lo(rg1.w), bf_hi(rg1.w)}; \
            _Pragma("unroll") for (int r_ = 0; r_ < 16; ++r_) { const f32x4 wv = *(const LAS f32x4*)(Lf + O_W2 + r_ * 128 + dq); z = z + wv * gl[r_]; } \
            _Pragma("unroll") for (int i_ = 0; i_ < 4; ++i_) { q4[i_] = xq[i_] * 0.08838834764831845f; k4[i_] = xk[i_]; e4[i_] = __builtin_amdgcn_exp2f(-0.0625f * __builtin_amdgcn_logf(1.0f + __expf(-z[i_]))); } } \
        else { _Pragma("unroll") for (int i_ = 0; i_ < 4; ++i_) { const float fg = lb[i_] + (1.f - lb[i_]) * sigmoidf_(xk[i_]); q4[i_] = siluf_(xq[i_]); k4[i_] = 1.f - fg; e4[i_] = fg; } } \
        *(LAS f32x4*)(B_ + O_EG + tl * 128 + dq) = e4; *(LAS f32x4*)(B_ + O_K + tl * 128 + dq) = k4; *(LAS f32x4*)(B_ + O_Q + tl * 128 + dq) = q4; \
        if (tid < 256) { f32x4 v4 = {bf_lo(rv.x), bf_hi(rv.x), bf_lo(rv.y), bf_hi(rv.y)}; *(LAS f32x4*)(B_ + O_V + tlv * 64 + c4) = v4; } } while (0)
    LBAR();
    GLA_LOAD(0); GLA_XFORM(0);
    LBAR();
    f32x2 S2[8];
#pragma unroll
    for (int i = 0; i < 8; ++i) S2[i] = (f32x2){0.f, 0.f};
    const int j = lane & 15, col = w * 8 + (lane >> 4) * 2;
    for (int c = 0; c < NCHUNK; ++c) {
        if (c + 1 < NCHUNK) GLA_LOAD(c + 1);
        const LAS float* B_ = Lf + (c & 1) * BUFSZ;
        float os0 = 0.f, os1 = 0.f;
        f32x4 e0, e1, k0, k1, q0, q1, ne0, ne1, nk0, nk1, nq0, nq1; f32x2 v2, nv2;
#define GLA_LDSTEP(t_, E0, E1, K0, K1, Q0, Q1, V2) do { E0 = *(const LAS f32x4*)(B_ + O_EG + (t_) * 128 + 4 * j); E1 = *(const LAS f32x4*)(B_ + O_EG + (t_) * 128 + 64 + 4 * j); \
            K0 = *(const LAS f32x4*)(B_ + O_K + (t_) * 128 + 4 * j); K1 = *(const LAS f32x4*)(B_ + O_K + (t_) * 128 + 64 + 4 * j); \
            Q0 = *(const LAS f32x4*)(B_ + O_Q + (t_) * 128 + 4 * j); Q1 = *(const LAS f32x4*)(B_ + O_Q + (t_) * 128 + 64 + 4 * j); V2 = *(const LAS f32x2*)(B_ + O_V + (t_) * 64 + col); } while (0)
        GLA_LDSTEP(0, e0, e1, k0, k1, q0, q1, v2);
#pragma unroll
        for (int t = 0; t < TC; ++t) {
            if (t + 1 < TC) { GLA_LDSTEP(t + 1, ne0, ne1, nk0, nk1, nq0, nq1, nv2); }
            __builtin_amdgcn_sched_barrier(0);
            f32x2 pa = {0.f, 0.f}, pb = {0.f, 0.f};
#pragma unroll
            for (int i = 0; i < 4; ++i) {
                S2[i] = S2[i] * e0[i] + v2 * k0[i]; S2[4 + i] = S2[4 + i] * e1[i] + v2 * k1[i];
                pa += S2[i] * q0[i]; pb += S2[4 + i] * q1[i]; }
            pa += pb;
            float p0 = pa[0], p1 = pa[1];
            row_sum16_x2(p0, p1);
            os0 = (j == t) ? p0 : os0; os1 = (j == t) ? p1 : os1;
            e0 = ne0; e1 = ne1; k0 = nk0; k1 = nk1; q0 = nq0; q1 = nq1; v2 = nv2;
        }
#undef GLA_LDSTEP
        { f32x2 o2 = {os0, os1}; *(LAS f32x2*)(Lf + O_OUT + j * 64 + col) = o2; }
        if (c + 1 < NCHUNK) GLA_XFORM((c + 1) & 1);
        LBAR();
        if (tid < 256) *(GAS f32x4*)(O + (size_t)(c * TC + tlv) * D + c4) = *(const LAS f32x4*)(Lf + O_OUT + tlv * 64 + c4);
        LBAR();
    }
#undef GLA_LOAD
#undef GLA_XFORM
}

__device__ __forceinline__ void scan_gdn_unit(const Args& A, Frame& F, int unit) {
    int tid = F.tid; asm volatile("" : "+v"(tid));
    const int lane = tid & 63, w = F.wave;
    const int b = unit >> 4, h = (unit >> 1) & 7, s = unit & 1;
    const int qcol = EC_BQ + h * 128, kcol = EC_BK + h * 128, vcol = EC_BV + h * 128 + s * 64, ocol = 1024 + h * 128 + s * 64;
    const bf16* P = (const bf16*)(A.ws + WS_PROJ) + (size_t)b * SEQ * PROJ_LD;
    float* O = (float*)(A.ws + WS_O) + (size_t)b * SEQ * D + ocol;
    LAS float* Lf = (LAS float*)(F.lds + RING_OFF);
    constexpr int BUFSZ = 5184, O_K = 0, O_Q = 2048, O_V = 4096, O_SC = 5120, O_OUT = 2 * BUFSZ, O_CW = O_OUT + 1024;
    const int tl = tid >> 5, dq = (tid & 31) * 4, tlv = tid >> 4, c4 = (tid & 15) * 4;
    { const float* cw = A.in[I_GDN_CONV];
      for (int i = tid; i < 4 * 320; i += NTHREADS) { const int jt = i / 320, x = i % 320;
          const int ch = x < 128 ? (h * 128 + x) : x < 256 ? (1024 + h * 128 + (x - 128)) : (2048 + h * 128 + s * 64 + (x - 256));
          Lf[O_CW + i] = cw[jt * 3072 + ch]; } }
    const float neg_ea = -__expf(A.in[I_GDN_ALOG][h]), dtb = A.in[I_GDN_DTB][h];
    u32x2 rq[4], rk[4], rv[4]; unsigned short rba = 0, rbb = 0;
#pragma unroll
    for (int i = 0; i < 4; ++i) rv[i] = (u32x2){0u, 0u};
#define GDN_LOAD(c) do { const int t_ = (c) * TC + tl; \
        _Pragma("unroll") for (int jt = 0; jt < 4; ++jt) { const int tt = t_ - 3 + jt; \
            if (tt >= 0) { const bf16* pr = P + (size_t)tt * PROJ_LD; rq[jt] = *(const GAS u32x2*)(pr + qcol + dq); rk[jt] = *(const GAS u32x2*)(pr + kcol + dq); } \
            else { rq[jt] = (u32x2){0u, 0u}; rk[jt] = (u32x2){0u, 0u}; } } \
        { const bf16* pr = P + (size_t)t_ * PROJ_LD; rba = pr[EC_BA + h]; rbb = pr[EC_BB + h]; } \
        if (tid < 256) { const int tv = (c) * TC + tlv; \
            _Pragma("unroll") for (int jt = 0; jt < 4; ++jt) { const int tt = tv - 3 + jt; \
                if (tt >= 0) rv[jt] = *(const GAS u32x2*)(P + (size_t)tt * PROJ_LD + vcol + c4); else rv[jt] = (u32x2){0u, 0u}; } } } while (0)
#define GDN_XFORM(bufi) do { LAS float* B_ = Lf + (bufi) * BUFSZ; f32x4 q4 = {0.f, 0.f, 0.f, 0.f}, k4 = {0.f, 0.f, 0.f, 0.f}; \
        _Pragma("unroll") for (int jt = 0; jt < 4; ++jt) { const f32x4 wq = *(const LAS f32x4*)(Lf + O_CW + jt * 320 + dq), wk = *(const LAS f32x4*)(Lf + O_CW + jt * 320 + 128 + dq); \
            q4[0] += wq[0] * bf_lo(rq[jt].x); q4[1] += wq[1] * bf_hi(rq[jt].x); q4[2] += wq[2] * bf_lo(rq[jt].y); q4[3] += wq[3] * bf_hi(rq[jt].y); \
            k4[0] += wk[0] * bf_lo(rk[jt].x); k4[1] += wk[1] * bf_hi(rk[jt].x); k4[2] += wk[2] * bf_lo(rk[jt].y); k4[3] += wk[3] * bf_hi(rk[jt].y); } \
        float sq = 0.f, sk = 0.f, sqk = 0.f; \
        _Pragma("unroll") for (int i_ = 0; i_ < 4; ++i_) { q4[i_] = siluf_(q4[i_]); k4[i_] = siluf_(k4[i_]); sq += q4[i_] * q4[i_]; sk += k4[i_] * k4[i_]; sqk += q4[i_] * k4[i_]; } \
        sq = half_sum32(sq); sk = half_sum32(sk); sqk = half_sum32(sqk); \
        const float rq_ = __builtin_amdgcn_rsqf(sq + EPS) * 0.08838834764831845f, rk_ = __builtin_amdgcn_rsqf(sk + EPS); \
        q4 = q4 * rq_; k4 = k4 * rk_; \
        *(LAS f32x4*)(B_ + O_K + tl * 128 + dq) = k4; *(LAS f32x4*)(B_ + O_Q + tl * 128 + dq) = q4; \
        if ((tid & 31) == 0) { const float ba = __uint_as_float((unsigned)rba << 16), bb = __uint_as_float((unsigned)rbb << 16); \
            f32x4 sc; sc[0] = __expf(neg_ea * softplusf_(ba + dtb)); sc[1] = sigmoidf_(bb); sc[2] = sqk * rq_ * rk_; sc[3] = 0.f; *(LAS f32x4*)(B_ + O_SC + tl * 4) = sc; } \
        if (tid < 256) { f32x4 v4 = {0.f, 0.f, 0.f, 0.f}; \
            _Pragma("unroll") for (int jt = 0; jt < 4; ++jt) { const f32x4 wv = *(const LAS f32x4*)(Lf + O_CW + jt * 320 + 256 + c4); \
                v4[0] += wv[0] * bf_lo(rv[jt].x); v4[1] += wv[1] * bf_hi(rv[jt].x); v4[2] += wv[2] * bf_lo(rv[jt].y); v4[3] += wv[3] * bf_hi(rv[jt].y); } \
            _Pragma("unroll") for (int i_ = 0; i_ < 4; ++i_) v4[i_] = siluf_(v4[i_]); \
            *(LAS f32x4*)(B_ + O_V + tlv * 64 + c4) = v4; } } while (0)
    LBAR();
    GDN_LOAD(0); GDN_XFORM(0);
    LBAR();
    f32x2 S2[8];
#pragma unroll
    for (int i = 0; i < 8; ++i) S2[i] = (f32x2){0.f, 0.f};
    const int j = lane & 15, col = w * 8 + (lane >> 4) * 2;
    for (int c = 0; c < NCHUNK; ++c) {
        if (c + 1 < NCHUNK) GDN_LOAD(c + 1);
        const LAS float* B_ = Lf + (c & 1) * BUFSZ;
        float os0 = 0.f, os1 = 0.f;
        f32x4 k0, k1, q0, q1, sc, nk0, nk1, nq0, nq1, nsc; f32x2 v2, nv2;
#define GDN_LDSTEP(t_, K0, K1, Q0, Q1, V2, SC) do { K0 = *(const LAS f32x4*)(B_ + O_K + (t_) * 128 + 4 * j); K1 = *(const LAS f32x4*)(B_ + O_K + (t_) * 128 + 64 + 4 * j); \
            Q0 = *(const LAS f32x4*)(B_ + O_Q + (t_) * 128 + 4 * j); Q1 = *(const LAS f32x4*)(B_ + O_Q + (t_) * 128 + 64 + 4 * j); V2 = *(const LAS f32x2*)(B_ + O_V + (t_) * 64 + col); SC = *(const LAS f32x4*)(B_ + O_SC + (t_) * 4); } while (0)
        GDN_LDSTEP(0, k0, k1, q0, q1, v2, sc);
#pragma unroll
        for (int t = 0; t < TC; ++t) {
            if (t + 1 < TC) { GDN_LDSTEP(t + 1, nk0, nk1, nq0, nq1, nv2, nsc); }
            __builtin_amdgcn_sched_barrier(0);
            f32x2 d1 = {0.f, 0.f}, d2 = {0.f, 0.f}, e1 = {0.f, 0.f}, e2 = {0.f, 0.f};
#pragma unroll
            for (int i = 0; i < 4; ++i) { d1 += S2[i] * k0[i]; e1 += S2[4 + i] * k1[i]; d2 += S2[i] * q0[i]; e2 += S2[4 + i] * q1[i]; }
            d1 += e1; d2 += e2;
            { float r0_ = d1[0], r1_ = d1[1], r2_ = d2[0], r3_ = d2[1]; row_sum16_x4(r0_, r1_, r2_, r3_); d1[0] = r0_; d1[1] = r1_; d2[0] = r2_; d2[1] = r3_; }
            const float a = sc[0], beta = sc[1], qk = sc[2];
            const f32x2 dl = (v2 - d1 * a) * beta;
            const f32x2 o2 = d2 * a + dl * qk;
#pragma unroll
            for (int i = 0; i < 4; ++i) { S2[i] = S2[i] * a + dl * k0[i]; S2[4 + i] = S2[4 + i] * a + dl * k1[i]; }
            os0 = (j == t) ? o2[0] : os0; os1 = (j == t) ? o2[1] : os1;
            k0 = nk0; k1 = nk1; q0 = nq0; q1 = nq1; v2 = nv2; sc = nsc;
        }
#undef GDN_LDSTEP
        { f32x2 o2 = {os0, os1}; *(LAS f32x2*)(Lf + O_OUT + j * 64 + col) = o2; }
        if (c + 1 < NCHUNK) GDN_XFORM((c + 1) & 1);
        LBAR();
        if (tid < 256) *(GAS f32x4*)(O + (size_t)(c * TC + tlv) * D + c4) = *(const LAS f32x4*)(Lf + O_OUT + tlv * 64 + c4);
        LBAR();
    }
#undef GDN_LOAD
#undef GDN_XFORM
}

typedef short bf16x4_t __attribute__((ext_vector_type(4)));
__device__ __forceinline__ bf16x8 mk_frag(u32x2 lo, u32x2 hi) { v4u t; t.x = lo.x; t.y = lo.y; t.z = hi.x; t.w = hi.y; return __builtin_bit_cast(bf16x8, t); }
template <int MODE>
__device__ __forceinline__ void scan_gla_mfma_unit(const Args& A, Frame& F, int unit) {
    int tid = F.tid; asm volatile("" : "+v"(tid));
    const int lane = tid & 63, w = F.wave;
    int b, h, qcol, kcol, vcol, ocol;
    if (MODE == 0) { b = unit >> 3; h = (unit >> 1) & 3; const int s = unit & 1; qcol = EC_GQ + h * 128; kcol = EC_GK + h * 128; vcol = EC_GV + h * 256 + s * 128; ocol = h * 256 + s * 128; }
    else           { b = unit >> 3; h = unit & 7; qcol = OC_HQ + h * 128; kcol = OC_HF + h * 128; vcol = OC_HI + h * 128; ocol = h * 128; }
    const bf16* P = (const bf16*)(A.ws + WS_PROJ) + (size_t)b * SEQ * PROJ_LD;
    float* O = (float*)(A.ws + WS_O) + (size_t)b * SEQ * D + ocol;
    LAS float* Lf = (LAS float*)(F.lds + RING_OFF);
    constexpr int BUFSZ = 8192, O_E = 0, O_K = 2048, O_Q = 4096, O_V = 6144, RS = 136, O_QB = 2 * BUFSZ, O_KB = O_QB + 1088, O_KT = O_KB + 1088, O_BL = O_KT + 1024, O_AM = O_BL + 128, O_W2 = O_AM + 128, O_BIAS = O_W2 + 2048;
    LAS bf16* QB = (LAS bf16*)(Lf + O_QB); LAS bf16* KB = (LAS bf16*)(Lf + O_KB); LAS bf16* KT = (LAS bf16*)(Lf + O_KT); LAS bf16* AM = (LAS bf16*)(Lf + O_AM);
    const int tl = tid >> 5, dq = (tid & 31) * 4;
    float lb[4] = {0.f, 0.f, 0.f, 0.f};
    if (MODE == 0) {
        const float* w2 = A.in[I_GK_W2]; const float* gb = A.in[I_GK_B];
        for (int i = tid; i < 2048; i += NTHREADS) Lf[O_W2 + i] = w2[(i >> 7) * 512 + h * 128 + (i & 127)];
        if (tid < 128) Lf[O_BIAS + tid] = gb[h * 128 + tid];
    } else {
        const float* lg = A.in[I_LB];
#pragma unroll
        for (int i = 0; i < 4; ++i) lb[i] = sigmoidf_(lg[1024 + h * 128 + dq + i] - lg[h * 128 + dq + i]);
    }
    u32x2 rq, rk, rv; v4u rg0 = {0u, 0u, 0u, 0u}, rg1 = {0u, 0u, 0u, 0u};
#define GM_LOAD(c) do { const bf16* pr = P + (size_t)((c) * TC + tl) * PROJ_LD; rq = *(const GAS u32x2*)(pr + qcol + dq); rk = *(const GAS u32x2*)(pr + kcol + dq); rv = *(const GAS u32x2*)(pr + vcol + dq); \
        if (MODE == 0) { rg0 = *(const GAS v4u*)(pr + EC_GLR); rg1 = *(const GAS v4u*)(pr + EC_GLR + 8); } } while (0)
#define GM_XFORM(bufi) do { LAS float* B_ = Lf + (bufi) * BUFSZ; f32x4 q4, k4, e4; \
        const float xq[4] = {bf_lo(rq.x), bf_hi(rq.x), bf_lo(rq.y), bf_hi(rq.y)}, xk[4] = {bf_lo(rk.x), bf_hi(rk.x), bf_lo(rk.y), bf_hi(rk.y)}; \
        if (MODE == 0) { f32x4 z = *(const LAS f32x4*)(Lf + O_BIAS + dq); \
            const float gl[16] = {bf_lo(rg0.x), bf_hi(rg0.x), bf_lo(rg0.y), bf_hi(rg0.y), bf_lo(rg0.z), bf_hi(rg0.z), bf_lo(rg0.w), bf_hi(rg0.w), \
                                  bf_lo(rg1.x), bf_hi(rg1.x), bf_lo(rg1.y), bf_hi(rg1.y), bf_lo(rg1.z), bf_hi(rg1.z), bf_lo(rg1.w), bf_hi(rg1.w)}; \
            _Pragma("unroll") for (int r_ = 0; r_ < 16; ++r_) { const f32x4 wv = *(const LAS f32x4*)(Lf + O_W2 + r_ * 128 + dq); z = z + wv * gl[r_]; } \
            _Pragma("unroll") for (int i_ = 0; i_ < 4; ++i_) { q4[i_] = xq[i_] * 0.08838834764831845f; k4[i_] = xk[i_]; e4[i_] = __builtin_amdgcn_exp2f(-0.0625f * __builtin_amdgcn_logf(1.0f + __expf(-z[i_]))); } } \
        else { _Pragma("unroll") for (int i_ = 0; i_ < 4; ++i_) { const float fg = lb[i_] + (1.f - lb[i_]) * sigmoidf_(xk[i_]); q4[i_] = siluf_(xq[i_]); k4[i_] = 1.f - fg; e4[i_] = fg; } } \
        *(LAS f32x4*)(B_ + O_E + tl * 128 + dq) = e4; *(LAS f32x4*)(B_ + O_K + tl * 128 + dq) = k4; *(LAS f32x4*)(B_ + O_Q + tl * 128 + dq) = q4; \
        { f32x4 v4 = {bf_lo(rv.x), bf_hi(rv.x), bf_lo(rv.y), bf_hi(rv.y)}; *(LAS f32x4*)(B_ + O_V + tl * 128 + dq) = v4; } } while (0)
    LBAR();
    GM_LOAD(0); GM_XFORM(0); GM_LOAD(1);
    LBAR();
    f32x4 Sacc[8];
#pragma unroll
    for (int i = 0; i < 8; ++i) Sacc[i] = (f32x4){0.f, 0.f, 0.f, 0.f};
    const int fr = lane & 15, g = lane >> 4, c0 = w * 16;
    for (int c = 0; c < NCHUNK; ++c) {
        const LAS float* B_ = Lf + (c & 1) * BUFSZ;
        {
            const int seg = tid >> 7, d = tid & 127;
            float bt = 1.f, ball = 1.f;
#pragma unroll
            for (int t = 0; t < 16; ++t) { const float e = B_[O_E + t * 128 + d]; ball *= e; if (t < 4 * seg) bt = ball; }
            ball = fmaxf(ball, 1e-30f);
            unsigned short kt4[4];
#pragma unroll
            for (int i = 0; i < 4; ++i) { const int t = 4 * seg + i; bt = fmaxf(bt * B_[O_E + t * 128 + d], 1e-30f);
                const float kk = B_[O_K + t * 128 + d], qq = B_[O_Q + t * 128 + d], ib = __builtin_amdgcn_rcpf(bt);
                QB[t * RS + d] = hw_bf(qq * bt); KB[t * RS + d] = hw_bf(kk * ib); kt4[i] = (unsigned short)hw_bf(kk * ball * ib); }
            u32x2 kw; kw.x = (unsigned)kt4[0] | ((unsigned)kt4[1] << 16); kw.y = (unsigned)kt4[2] | ((unsigned)kt4[3] << 16);
            *(LAS u32x2*)(KT + d * 16 + 4 * seg) = kw;
            if (seg == 3) Lf[O_BL + d] = ball;
        }
        LBAR();
        if (w == 0) {
            f32x4 acc = {0.f, 0.f, 0.f, 0.f};
#pragma unroll
            for (int ks = 0; ks < 4; ++ks) { const bf16x8 af = *(const LAS bf16x8*)(QB + fr * RS + 32 * ks + 8 * g), bfm = *(const LAS bf16x8*)(KB + fr * RS + 32 * ks + 8 * g);
                acc = __builtin_amdgcn_mfma_f32_16x16x32_bf16(af, bfm, acc, 0, 0, 0); }
#pragma unroll
            for (int r = 0; r < 4; ++r) { const int t = 4 * g + r, s = fr; AM[t * 16 + s] = hw_bf(s <= t ? acc[r] : 0.f); }
        }
        if (c + 1 < NCHUNK) GM_XFORM((c + 1) & 1);
        if (c + 2 < NCHUNK) GM_LOAD(c + 2);
        LBAR();
        {
            u32x2 vlo; { const float v0 = B_[O_V + (4 * g + 0) * 128 + c0 + fr], v1 = B_[O_V + (4 * g + 1) * 128 + c0 + fr], v2 = B_[O_V + (4 * g + 2) * 128 + c0 + fr], v3 = B_[O_V + (4 * g + 3) * 128 + c0 + fr];
                vlo.x = hw_pk2(v0, v1); vlo.y = hw_pk2(v2, v3); }
            const u32x2 zz = {0u, 0u};
            const bf16x8 vb = mk_frag(vlo, zz);
            f32x4 acco = {0.f, 0.f, 0.f, 0.f};
#pragma unroll
            for (int ks = 0; ks < 4; ++ks) {
                u32x2 slo, shi; slo.x = hw_pk2(Sacc[2 * ks][0], Sacc[2 * ks][1]); slo.y = hw_pk2(Sacc[2 * ks][2], Sacc[2 * ks][3]); shi.x = hw_pk2(Sacc[2 * ks + 1][0], Sacc[2 * ks + 1][1]); shi.y = hw_pk2(Sacc[2 * ks + 1][2], Sacc[2 * ks + 1][3]);
                const bf16x8 sb = mk_frag(slo, shi);
                const u32x2 qlo = *(const LAS u32x2*)(QB + fr * RS + 32 * ks + 4 * g), qhi = *(const LAS u32x2*)(QB + fr * RS + 32 * ks + 16 + 4 * g);
                acco = __builtin_amdgcn_mfma_f32_16x16x32_bf16(mk_frag(qlo, qhi), sb, acco, 0, 0, 0); }
            { const u32x2 alo = *(const LAS u32x2*)(AM + fr * 16 + 4 * g); acco = __builtin_amdgcn_mfma_f32_16x16x32_bf16(mk_frag(alo, zz), vb, acco, 0, 0, 0); }
#pragma unroll
            for (int r = 0; r < 4; ++r) O[(size_t)(c * TC + 4 * g + r) * D + c0 + fr] = acco[r];
#pragma unroll
            for (int i = 0; i < 8; ++i) { const f32x4 bl = *(const LAS f32x4*)(Lf + O_BL + 16 * i + 4 * g); const u32x2 klo = *(const LAS u32x2*)(KT + (16 * i + fr) * 16 + 4 * g);
                Sacc[i] = __builtin_amdgcn_mfma_f32_16x16x32_bf16(mk_frag(klo, zz), vb, Sacc[i] * bl, 0, 0, 0); }
        }
        LBAR();
    }
#undef GM_LOAD
#undef GM_XFORM
}

__device__ __forceinline__ void scan_gdn_mfma_unit(const Args& A, Frame& F, int unit) {
    int tid = F.tid; asm volatile("" : "+v"(tid));
    const int lane = tid & 63, w = F.wave;
    const int b = unit >> 3, h = unit & 7;
    const int qcol = EC_BQ + h * 128, kcol = EC_BK + h * 128, vcol = EC_BV + h * 128, ocol = 1024 + h * 128;
    const bf16* P = (const bf16*)(A.ws + WS_PROJ) + (size_t)b * SEQ * PROJ_LD;
    float* O = (float*)(A.ws + WS_O) + (size_t)b * SEQ * D + ocol;
    LAS float* Lf = (LAS float*)(F.lds + RING_OFF);
    constexpr int O_CW = 0, O_AMAT = 1536, O_QKM = O_AMAT + 256, O_TB = O_QKM + 128, O_GL = O_TB + 128, O_BUF0 = O_GL + 64;
    constexpr int BUFSZ = 6208, O_KH = 0, O_QH = 2048, O_VV = 4096, O_SC = 6144;
    constexpr int RS = 136;
    constexpr int O_KHB = O_BUF0 + 2 * BUFSZ, O_QHB = O_KHB + 1088, O_QB = O_QHB + 1088, O_KT = O_QB + 1088, O_WSRC = O_KT + 1024, O_WB = O_WSRC + 2048;
    LAS bf16* KHB = (LAS bf16*)(Lf + O_KHB); LAS bf16* QHB = (LAS bf16*)(Lf + O_QHB); LAS bf16* QB = (LAS bf16*)(Lf + O_QB); LAS bf16* KT = (LAS bf16*)(Lf + O_KT);
    LAS bf16* WB = (LAS bf16*)(Lf + O_WB); LAS bf16* QKM = (LAS bf16*)(Lf + O_QKM); LAS bf16* TB = (LAS bf16*)(Lf + O_TB);
    const int tl = tid >> 5, dq = (tid & 31) * 4;
    { const float* cw = A.in[I_GDN_CONV];
      for (int i = tid; i < 4 * 384; i += NTHREADS) { const int jt = i / 384, x = i % 384; Lf[O_CW + i] = cw[jt * 3072 + (x >> 7) * 1024 + h * 128 + (x & 127)]; } }
    const float neg_ea = -__expf(A.in[I_GDN_ALOG][h]), dtb = A.in[I_GDN_DTB][h];
    u32x2 rq[4], rk[4], rv[4]; unsigned short rba = 0, rbb = 0;
#define GD_LOAD(c) do { const int t_ = (c) * TC + tl; \
        _Pragma("unroll") for (int jt = 0; jt < 4; ++jt) { const int tt = t_ - 3 + jt; const bf16* pr = P + (size_t)(tt < 0 ? 0 : tt) * PROJ_LD + dq; \
            rq[jt] = *(const GAS u32x2*)(pr + qcol); rk[jt] = *(const GAS u32x2*)(pr + kcol); rv[jt] = *(const GAS u32x2*)(pr + vcol); \
            if (tt < 0) { rq[jt] = (u32x2){0u, 0u}; rk[jt] = (u32x2){0u, 0u}; rv[jt] = (u32x2){0u, 0u}; } } \
        { const bf16* pr = P + (size_t)t_ * PROJ_LD; rba = pr[EC_BA + h]; rbb = pr[EC_BB + h]; } } while (0)
#define GD_XFORM(bufi) do { LAS float* B_ = Lf + O_BUF0 + (bufi) * BUFSZ; f32x4 q4 = {0.f, 0.f, 0.f, 0.f}, k4 = {0.f, 0.f, 0.f, 0.f}, v4 = {0.f, 0.f, 0.f, 0.f}; \
        _Pragma("unroll") for (int jt = 0; jt < 4; ++jt) { const f32x4 wq = *(const LAS f32x4*)(Lf + O_CW + jt * 384 + dq), wk = *(const LAS f32x4*)(Lf + O_CW + jt * 384 + 128 + dq), wv = *(const LAS f32x4*)(Lf + O_CW + jt * 384 + 256 + dq); \
            q4[0] += wq[0] * bf_lo(rq[jt].x); q4[1] += wq[1] * bf_hi(rq[jt].x); q4[2] += wq[2] * bf_lo(rq[jt].y); q4[3] += wq[3] * bf_hi(rq[jt].y); \
            k4[0] += wk[0] * bf_lo(rk[jt].x); k4[1] += wk[1] * bf_hi(rk[jt].x); k4[2] += wk[2] * bf_lo(rk[jt].y); k4[3] += wk[3] * bf_hi(rk[jt].y); \
            v4[0] += wv[0] * bf_lo(rv[jt].x); v4[1] += wv[1] * bf_hi(rv[jt].x); v4[2] += wv[2] * bf_lo(rv[jt].y); v4[3] += wv[3] * bf_hi(rv[jt].y); } \
        float sq = 0.f, sk = 0.f; \
        _Pragma("unroll") for (int i_ = 0; i_ < 4; ++i_) { q4[i_] = siluf_(q4[i_]); k4[i_] = siluf_(k4[i_]); v4[i_] = siluf_(v4[i_]); sq += q4[i_] * q4[i_]; sk += k4[i_] * k4[i_]; } \
        row_sum16_x2(sq, sk); sq += __shfl_xor(sq, 16); sk += __shfl_xor(sk, 16); \
        q4 = q4 * (__builtin_amdgcn_rsqf(sq + EPS) * 0.08838834764831845f); k4 = k4 * __builtin_amdgcn_rsqf(sk + EPS); \
        *(LAS f32x4*)(B_ + O_KH + tl * 128 + dq) = k4; *(LAS f32x4*)(B_ + O_QH + tl * 128 + dq) = q4; *(LAS f32x4*)(B_ + O_VV + tl * 128 + dq) = v4; \
        if ((tid & 31) == 0) { const float ba = __uint_as_float((unsigned)rba << 16), bb = __uint_as_float((unsigned)rbb << 16); \
            B_[O_SC + tl] = __expf(neg_ea * softplusf_(ba + dtb)); B_[O_SC + 16 + tl] = sigmoidf_(bb); } } while (0)
    LBAR();
    GD_LOAD(0); GD_XFORM(0); GD_LOAD(1);
    LBAR();
    f32x4 Sacc[8];
#pragma unroll
    for (int i = 0; i < 8; ++i) Sacc[i] = (f32x4){0.f, 0.f, 0.f, 0.f};
    const int fr = lane & 15, g = lane >> 4, c0 = w * 16;
    const u32x2 zz = {0u, 0u};
    for (int c = 0; c < NCHUNK; ++c) {
        const LAS float* B_ = Lf + O_BUF0 + (c & 1) * BUFSZ;
        float glast;
        {
            const int seg = tid >> 7, d = tid & 127;
            const f32x4 a0 = *(const LAS f32x4*)(B_ + O_SC), a1 = *(const LAS f32x4*)(B_ + O_SC + 4), a2 = *(const LAS f32x4*)(B_ + O_SC + 8), a3 = *(const LAS f32x4*)(B_ + O_SC + 12);
            const float av[16] = {a0[0], a0[1], a0[2], a0[3], a1[0], a1[1], a1[2], a1[3], a2[0], a2[1], a2[2], a2[3], a3[0], a3[1], a3[2], a3[3]};
            float p = 1.f, gpre = 1.f;
#pragma unroll
            for (int t = 0; t < 16; ++t) { if (t == 4 * seg) gpre = p; p *= av[t]; }
            glast = p;
            unsigned short kt4[4]; float gt = gpre;
#pragma unroll
            for (int i = 0; i < 4; ++i) { const int t = 4 * seg + i; const float at = (seg == 0) ? av[i] : (seg == 1) ? av[4 + i] : (seg == 2) ? av[8 + i] : av[12 + i]; gt *= at; const float beta = B_[O_SC + 16 + t];
                const float kk = B_[O_KH + t * 128 + d], qq = B_[O_QH + t * 128 + d];
                KHB[t * RS + d] = hw_bf(kk); QHB[t * RS + d] = hw_bf(qq); QB[t * RS + d] = hw_bf(qq * gt);
                kt4[i] = (unsigned short)hw_bf(kk * glast * __builtin_amdgcn_rcpf(gt));
                Lf[O_WSRC + t * 128 + d] = kk * (beta * gt);
                if (d == 0) Lf[O_GL + t] = gt; }
            u32x2 kw; kw.x = (unsigned)kt4[0] | ((unsigned)kt4[1] << 16); kw.y = (unsigned)kt4[2] | ((unsigned)kt4[3] << 16);
            *(LAS u32x2*)(KT + d * 16 + 4 * seg) = kw;
        }
        LBAR();
        if (w < 2) {
            const LAS bf16* AS = (w == 0) ? KHB : QHB;
            f32x4 acc = {0.f, 0.f, 0.f, 0.f};
#pragma unroll
            for (int ks = 0; ks < 4; ++ks) { const bf16x8 af = *(const LAS bf16x8*)(AS + fr * RS + 32 * ks + 8 * g), bfm = *(const LAS bf16x8*)(KHB + fr * RS + 32 * ks + 8 * g);
                acc = __builtin_amdgcn_mfma_f32_16x16x32_bf16(af, bfm, acc, 0, 0, 0); }
            const float gs_inv = __builtin_amdgcn_rcpf(Lf[O_GL + fr]);
            if (w == 0) {
                f32x4 N1, M1;
#pragma unroll
                for (int r = 0; r < 4; ++r) { const int t = 4 * g + r; const float gt = Lf[O_GL + t];
                    N1[r] = (fr < t) ? -(B_[O_SC + 16 + t] * acc[r] * gt * gs_inv) : 0.f;
                    M1[r] = (t < fr) ? -(B_[O_SC + 16 + fr] * acc[r] * Lf[O_GL + fr] * __builtin_amdgcn_rcpf(gt)) : 0.f; }
#define XTY(X, Y, C0) __builtin_amdgcn_mfma_f32_16x16x32_bf16(mk_frag((u32x2){hw_pk2(X[0], X[1]), hw_pk2(X[2], X[3])}, zz), mk_frag((u32x2){hw_pk2(Y[0], Y[1]), hw_pk2(Y[2], Y[3])}, zz), C0, 0, 0, 0)
                const f32x4 z4 = {0.f, 0.f, 0.f, 0.f};
                f32x4 T1t = M1;
#pragma unroll
                for (int r = 0; r < 4; ++r) if (4 * g + r == fr) T1t[r] += 1.f;
                const f32x4 N2 = XTY(M1, N1, z4), M2 = XTY(N1, M1, z4);
                const f32x4 T2t = XTY(N2, T1t, T1t);
                const f32x4 N4 = XTY(M2, N2, z4), M4 = XTY(N2, M2, z4);
                const f32x4 T4t = XTY(N4, T2t, T2t);
                const f32x4 N8 = XTY(M4, N4, z4);
                const f32x4 T8t = XTY(N8, T4t, T4t);
#undef XTY
                u32x2 tw; tw.x = hw_pk2(T8t[0], T8t[1]); tw.y = hw_pk2(T8t[2], T8t[3]);
                *(LAS u32x2*)(TB + fr * 16 + 4 * g) = tw;
            } else {
#pragma unroll
                for (int r = 0; r < 4; ++r) { const int t = 4 * g + r; QKM[t * 16 + fr] = hw_bf((fr <= t) ? acc[r] * Lf[O_GL + t] * gs_inv : 0.f); }
            }
        }
        if (c + 1 < NCHUNK) GD_XFORM((c + 1) & 1);
        if (c + 2 < NCHUNK) GD_LOAD(c + 2);
        LBAR();
        f32x4 accu = {0.f, 0.f, 0.f, 0.f};
        {
            const bf16x8 tf = mk_frag(*(const LAS u32x2*)(TB + fr * 16 + 4 * g), zz);
            u32x2 ulo, wlo;
            { const float b0 = B_[O_SC + 16 + 4 * g + 0], b1 = B_[O_SC + 16 + 4 * g + 1], b2 = B_[O_SC + 16 + 4 * g + 2], b3 = B_[O_SC + 16 + 4 * g + 3];
              ulo.x = hw_pk2(b0 * B_[O_VV + (4 * g + 0) * 128 + c0 + fr], b1 * B_[O_VV + (4 * g + 1) * 128 + c0 + fr]); ulo.y = hw_pk2(b2 * B_[O_VV + (4 * g + 2) * 128 + c0 + fr], b3 * B_[O_VV + (4 * g + 3) * 128 + c0 + fr]);
              wlo.x = hw_pk2(Lf[O_WSRC + (4 * g + 0) * 128 + c0 + fr], Lf[O_WSRC + (4 * g + 1) * 128 + c0 + fr]); wlo.y = hw_pk2(Lf[O_WSRC + (4 * g + 2) * 128 + c0 + fr], Lf[O_WSRC + (4 * g + 3) * 128 + c0 + fr]); }
            accu = __builtin_amdgcn_mfma_f32_16x16x32_bf16(tf, mk_frag(ulo, zz), accu, 0, 0, 0);
            f32x4 accw = {0.f, 0.f, 0.f, 0.f};
            accw = __builtin_amdgcn_mfma_f32_16x16x32_bf16(tf, mk_frag(wlo, zz), accw, 0, 0, 0);
#pragma unroll
            for (int r = 0; r < 4; ++r) WB[(4 * g + r) * RS + c0 + fr] = hw_bf(-accw[r]);
        }
        LBAR();
        {
            bf16x8 sb[4];
#pragma unroll
            for (int ks = 0; ks < 4; ++ks) { u32x2 slo, shi; slo.x = hw_pk2(Sacc[2 * ks][0], Sacc[2 * ks][1]); slo.y = hw_pk2(Sacc[2 * ks][2], Sacc[2 * ks][3]); shi.x = hw_pk2(Sacc[2 * ks + 1][0], Sacc[2 * ks + 1][1]); shi.y = hw_pk2(Sacc[2 * ks + 1][2], Sacc[2 * ks + 1][3]);
                sb[ks] = mk_frag(slo, shi); }
            f32x4 accv = accu, acco = {0.f, 0.f, 0.f, 0.f};
#pragma unroll
            for (int ks = 0; ks < 4; ++ks) {
                const u32x2 wl = *(const LAS u32x2*)(WB + fr * RS + 32 * ks + 4 * g), wh = *(const LAS u32x2*)(WB + fr * RS + 32 * ks + 16 + 4 * g);
                accv = __builtin_amdgcn_mfma_f32_16x16x32_bf16(mk_frag(wl, wh), sb[ks], accv, 0, 0, 0);
                const u32x2 ql = *(const LAS u32x2*)(QB + fr * RS + 32 * ks + 4 * g), qh = *(const LAS u32x2*)(QB + fr * RS + 32 * ks + 16 + 4 * g);
                acco = __builtin_amdgcn_mfma_f32_16x16x32_bf16(mk_frag(ql, qh), sb[ks], acco, 0, 0, 0); }
            u32x2 vn; vn.x = hw_pk2(accv[0], accv[1]); vn.y = hw_pk2(accv[2], accv[3]);
            const bf16x8 vnb = mk_frag(vn, zz);
            acco = __builtin_amdgcn_mfma_f32_16x16x32_bf16(mk_frag(*(const LAS u32x2*)(QKM + fr * 16 + 4 * g), zz), vnb, acco, 0, 0, 0);
#pragma unroll
            for (int r = 0; r < 4; ++r) O[(size_t)(c * TC + 4 * g + r) * D + c0 + fr] = acco[r];
#pragma unroll
            for (int i = 0; i < 8; ++i) { const u32x2 klo = *(const LAS u32x2*)(KT + (16 * i + fr) * 16 + 4 * g);
                Sacc[i] = __builtin_amdgcn_mfma_f32_16x16x32_bf16(mk_frag(klo, zz), vnb, Sacc[i] * glast, 0, 0, 0); }
        }
        LBAR();
    }
#undef GD_LOAD
#undef GD_XFORM
}

__device__ __forceinline__ void scan_rwkv_unit(const Args& A, Frame& F, int unit) {
    int tid = F.tid; asm volatile("" : "+v"(tid));
    const int lane = tid & 63, w = F.wave;
    const int b = unit >> 4, h = unit & 15;
    const bf16* P = (const bf16*)(A.ws + WS_PROJ) + (size_t)b * SEQ * PROJ_LD + OC_RW;
    const bf16* LO = (const bf16*)(A.ws + WS_LO) + (size_t)b * SEQ * LORA_N;
    bf16* Y = (bf16*)(A.ws + WS_ACTA) + (size_t)b * SEQ * D + 1024 + h * 64;
    LAS float* Lf = (LAS float*)(F.lds + RING_OFF);
    constexpr int BUFSZ = 6208, O_KK = 0, O_WR = 1024, O_W = 2048, O_NKA = 3072, O_K = 4096, O_V = 5120, O_SC = 6144, O_OUT = 2 * BUFSZ;
    const int tl = tid >> 5, d2 = (tid & 31) * 2, hd = h * 64 + d2;
    float mu_r[2], mu_k[2], mu_v[2], w0[2], a0[2], k_k[2], k_a[2], r_k[2], lnw[2], lnb[2];
#pragma unroll
    for (int i = 0; i < 2; ++i) { mu_r[i] = A.in[I_MU][RW_R + hd + i]; mu_k[i] = A.in[I_MU][RW_K + hd + i]; mu_v[i] = A.in[I_MU][RW_V + hd + i];
        w0[i] = A.in[I_W0][hd + i]; a0[i] = A.in[I_A0][hd + i]; k_k[i] = A.in[I_KK][hd + i]; k_a[i] = A.in[I_KA][hd + i]; r_k[i] = A.in[I_RK][hd + i];
        lnw[i] = A.in[I_LNW][hd + i]; lnb[i] = A.in[I_LNB][hd + i]; }
    unsigned rr[2], rk[2], rv[2], rlw, rla, rg_cur = 0u, rg_nxt = 0u;
#define RW_LOAD(c) do { const int t_ = (c) * TC + tl; const bf16* pr = P + (size_t)t_ * PROJ_LD; \
        rr[0] = *(const GAS unsigned*)(pr + RW_R + hd); rk[0] = *(const GAS unsigned*)(pr + RW_K + hd); rv[0] = *(const GAS unsigned*)(pr + RW_V + hd); \
        if (t_ > 0) { rr[1] = *(const GAS unsigned*)(pr - PROJ_LD + RW_R + hd); rk[1] = *(const GAS unsigned*)(pr - PROJ_LD + RW_K + hd); rv[1] = *(const GAS unsigned*)(pr - PROJ_LD + RW_V + hd); } \
        else { rr[1] = 0u; rk[1] = 0u; rv[1] = 0u; } \
        const bf16* lr = LO + (size_t)t_ * LORA_N; rlw = *(const GAS unsigned*)(lr + hd); rla = *(const GAS unsigned*)(lr + 1024 + hd); rg_nxt = *(const GAS unsigned*)(lr + 2048 + hd); } while (0)
#define RW_XFORM(bufi) do { LAS float* B_ = Lf + (bufi) * BUFSZ; f32x2 kk2, wr2, w2_, nka2, k2, v2_; float skk = 0.f, sc1 = 0.f, sc2 = 0.f, sbs = 0.f; float aa[2], rrv[2]; \
        _Pragma("unroll") for (int i_ = 0; i_ < 2; ++i_) { \
            const float r0 = i_ ? bf_hi(rr[0]) : bf_lo(rr[0]), r1 = i_ ? bf_hi(rr[1]) : bf_lo(rr[1]); \
            const float k0_ = i_ ? bf_hi(rk[0]) : bf_lo(rk[0]), k1_ = i_ ? bf_hi(rk[1]) : bf_lo(rk[1]); \
            const float v0_ = i_ ? bf_hi(rv[0]) : bf_lo(rv[0]), v1_ = i_ ? bf_hi(rv[1]) : bf_lo(rv[1]); \
            const float lw = i_ ? bf_hi(rlw) : bf_lo(rlw), la = i_ ? bf_hi(rla) : bf_lo(rla); \
            const float r_ = r0 + (r1 - r0) * mu_r[i_], kx = k0_ + (k1_ - k0_) * mu_k[i_], vx = v0_ + (v1_ - v0_) * mu_v[i_]; \
            const float wd = __expf(-0.6065306597126334f * sigmoidf_(w0[i_] + lw)); const float a_ = sigmoidf_(a0[i_] + la); \
            const float kk0 = kx * k_k[i_]; const float km = kx * (1.f + (a_ - 1.f) * k_a[i_]); \
            kk2[i_] = kk0; skk += kk0 * kk0; aa[i_] = a_; rrv[i_] = r_; wr2[i_] = wd * r_; w2_[i_] = wd; k2[i_] = km; v2_[i_] = vx; sc2 += km * r_; sbs += r_ * km * r_k[i_]; } \
        skk = half_sum32(skk); const float rkk = __builtin_amdgcn_rsqf(skk + EPS); \
        _Pragma("unroll") for (int i_ = 0; i_ < 2; ++i_) { kk2[i_] *= rkk; nka2[i_] = -(kk2[i_] * aa[i_]); sc1 += kk2[i_] * aa[i_] * rrv[i_]; } \
        sc1 = half_sum32(sc1); sc2 = half_sum32(sc2); sbs = half_sum32(sbs); \
        *(LAS f32x2*)(B_ + O_KK + tl * 64 + d2) = kk2; *(LAS f32x2*)(B_ + O_WR + tl * 64 + d2) = wr2; *(LAS f32x2*)(B_ + O_W + tl * 64 + d2) = w2_; \
        *(LAS f32x2*)(B_ + O_NKA + tl * 64 + d2) = nka2; *(LAS f32x2*)(B_ + O_K + tl * 64 + d2) = k2; *(LAS f32x2*)(B_ + O_V + tl * 64 + d2) = v2_; \
        if ((tid & 31) == 0) { f32x4 sc; sc[0] = sc1; sc[1] = sc2; sc[2] = sbs; sc[3] = 0.f; *(LAS f32x4*)(B_ + O_SC + tl * 4) = sc; } } while (0)
    RW_LOAD(0); RW_XFORM(0); rg_cur = rg_nxt;
    LBAR();
    f32x2 S2[4];
#pragma unroll
    for (int i = 0; i < 4; ++i) S2[i] = (f32x2){0.f, 0.f};
    const int j = lane & 15, col = w * 8 + (lane >> 4) * 2;
    for (int c = 0; c < NCHUNK; ++c) {
        if (c + 1 < NCHUNK) RW_LOAD(c + 1);
        const LAS float* B_ = Lf + (c & 1) * BUFSZ;
        float os0 = 0.f, os1 = 0.f;
        f32x4 kk, wr, ww, nka, kv, sc, nkk, nwr, nww, nnka, nkv, nsc; f32x2 v2, nv2;
#define RW_LDSTEP(t_, KK, WR, WW, NKA, KV, V2, SC) do { KK = *(const LAS f32x4*)(B_ + O_KK + (t_) * 64 + 4 * j); WR = *(const LAS f32x4*)(B_ + O_WR + (t_) * 64 + 4 * j); WW = *(const LAS f32x4*)(B_ + O_W + (t_) * 64 + 4 * j); \
            NKA = *(const LAS f32x4*)(B_ + O_NKA + (t_) * 64 + 4 * j); KV = *(const LAS f32x4*)(B_ + O_K + (t_) * 64 + 4 * j); V2 = *(const LAS f32x2*)(B_ + O_V + (t_) * 64 + col); SC = *(const LAS f32x4*)(B_ + O_SC + (t_) * 4); } while (0)
        RW_LDSTEP(0, kk, wr, ww, nka, kv, v2, sc);
#pragma unroll
        for (int t = 0; t < TC; ++t) {
            if (t + 1 < TC) { RW_LDSTEP(t + 1, nkk, nwr, nww, nnka, nkv, nv2, nsc); }
            __builtin_amdgcn_sched_barrier(0);
            f32x2 d1 = S2[0] * kk[0], d2 = S2[0] * wr[0], e1 = S2[1] * kk[1], e2 = S2[1] * wr[1];
            d1 += S2[2] * kk[2]; d2 += S2[2] * wr[2]; e1 += S2[3] * kk[3]; e2 += S2[3] * wr[3];
            d1 += e1; d2 += e2;
            { float r0_ = d1[0], r1_ = d1[1], r2_ = d2[0], r3_ = d2[1]; row_sum16_x4(r0_, r1_, r2_, r3_); d1[0] = r0_; d1[1] = r1_; d2[0] = r2_; d2[1] = r3_; }
            const f32x2 o2 = d2 - d1 * sc[0] + v2 * sc[1];
#pragma unroll
            for (int i = 0; i < 4; ++i) S2[i] = S2[i] * ww[i] + d1 * nka[i] + v2 * kv[i];
            os0 = (j == t) ? o2[0] : os0; os1 = (j == t) ? o2[1] : os1;
            kk = nkk; wr = nwr; ww = nww; nka = nnka; kv = nkv; v2 = nv2; sc = nsc;
        }
#undef RW_LDSTEP
        { f32x2 o2 = {os0, os1}; *(LAS f32x2*)(Lf + O_OUT + j * 64 + col) = o2; }
        if (c + 1 < NCHUNK) RW_XFORM((c + 1) & 1);
        LBAR();
        {
            const f32x2 o2 = *(const LAS f32x2*)(Lf + O_OUT + tl * 64 + d2); const f32x2 vv = *(const LAS f32x2*)(B_ + O_V + tl * 64 + d2); const float bs = B_[O_SC + tl * 4 + 2];
            const float mean = half_sum32(o2[0] + o2[1]) * (1.0f / 64.0f); const float e0 = o2[0] - mean, e1 = o2[1] - mean;
            const float var = half_sum32(e0 * e0 + e1 * e1) * (1.0f / 64.0f); const float rs = __builtin_amdgcn_rsqf(var + 64e-5f);
            const float y0 = (e0 * rs * lnw[0] + lnb[0] + bs * vv[0]) * bf_lo(rg_cur), y1 = (e1 * rs * lnw[1] + lnb[1] + bs * vv[1]) * bf_hi(rg_cur);
            *(GAS unsigned*)(Y + (size_t)(c * TC + tl) * D + d2) = pk2(y0, y1);
        }
        rg_cur = rg_nxt;
        LBAR();
    }
#undef RW_LOAD
#undef RW_XFORM
}

template <int LAYER>
__device__ __forceinline__ void post_rows(const Args& A, Frame& F) {
    const int gw = F.vcu * NWAVES + F.wave, NGW = F.G * NWAVES, lane = F.lane;
    const float* O = (const float*)(A.ws + WS_O); const bf16* P = (const bf16*)(A.ws + WS_PROJ); bf16* Y = (bf16*)(A.ws + WS_ACTA);
    for (int m = gw; m < T; m += NGW) {
        const GAS f32x4* orow = (const GAS f32x4*)(O + (size_t)m * D) + lane; const bf16* prow = P + (size_t)m * PROJ_LD;
        constexpr int NJ = LAYER == 0 ? 8 : 4;
#pragma unroll
        for (int jj = 0; jj < NJ; ++jj) {
            const f32x4 v = orow[64 * jj]; float ss = (v[0] * v[0] + v[1] * v[1]) + (v[2] * v[2] + v[3] * v[3]);
            const bool wide = (LAYER == 0 && jj < 4);
            const float ms = wide ? wave_sum(ss) * (1.0f / 256.0f) : half_sum32(ss) * (1.0f / 128.0f);
            const float r = __builtin_amdgcn_rsqf(ms + EPS);
            const int cih = wide ? 4 * lane : 4 * (lane & 31);
            const float* gsrc = LAYER == 0 ? (wide ? A.in[I_GLA_NORM] : A.in[I_GDN_NORM]) : A.in[I_HG_NORM];
            const f32x4 g = *(const GAS f32x4*)(gsrc + cih);
            const int zcol = LAYER == 0 ? (wide ? EC_GZ + jj * 256 + 4 * lane : EC_BZ + (jj - 4) * 256 + 4 * lane) : OC_HG + jj * 256 + 4 * lane;
            const u32x2 zw = *(const GAS u32x2*)(prow + zcol);
            const float y0 = v[0] * r * g[0] * siluf_(bf_lo(zw.x)), y1 = v[1] * r * g[1] * siluf_(bf_hi(zw.x)), y2 = v[2] * r * g[2] * siluf_(bf_lo(zw.y)), y3 = v[3] * r * g[3] * siluf_(bf_hi(zw.y));
            u32x2 o; o.x = pk2(y0, y1); o.y = pk2(y2, y3);
            *(GAS u32x2*)(Y + (size_t)m * D + 256 * jj + 4 * lane) = o;
        }
    }
}
__device__ __forceinline__ void lora_prep_rows(const Args& A, Frame& F) {
    const int gw = F.vcu * NWAVES + F.wave, NGW = F.G * NWAVES, lane = F.lane;
    const bf16* P = (const bf16*)(A.ws + WS_PROJ); bf16* LA = (bf16*)(A.ws + WS_LA); const float* mu = A.in[I_MU];
    for (int m = gw; m < T; m += NGW) { const bool hasprev = (m % SEQ) != 0; const bf16* prow = P + (size_t)m * PROJ_LD + OC_RW + RW_WL;
#pragma unroll
        for (int i = 0; i < 7; ++i) { const int c = lane + 64 * i;
            const float x = __uint_as_float((unsigned)prow[c] << 16), xp = hasprev ? __uint_as_float((unsigned)prow[c - PROJ_LD] << 16) : 0.f;
            const float ts = x + (xp - x) * mu[RW_WL + c];
            const float v = c < 96 ? tanhf(ts) : (c < 192 ? ts : sigmoidf_(ts));
            LA[(size_t)m * LORA_K + c] = (bf16)f2bf(v); }
        LA[(size_t)m * LORA_K + 448 + lane] = (bf16)0; }
}
__device__ __forceinline__ void final_rows(const Args& A, Frame& F, const float oscale) {
    const int gw = F.vcu * NWAVES + F.wave, NGW = F.G * NWAVES, lane = F.lane;
    const float* rowss = (const float*)(A.ws + WS_RSP) + (size_t)RS_FINAL * T * 32; const GAS f32x4* g = (const GAS f32x4*)A.in[I_NFINAL] + lane;
    for (int m = gw; m < T; m += NGW) { const float r = oscale * __builtin_amdgcn_rsqf(wave_sum(lane < 32 ? rowss[(size_t)m * 32 + lane] : 0.f) * (1.0f / D) + EPS); GAS f32x4* row = (GAS f32x4*)(A.out + (size_t)m * D) + lane;
#pragma unroll
        for (int jj = 0; jj < 8; ++jj) { const f32x4 v = row[64 * jj]; row[64 * jj] = v * r * g[64 * jj]; } }
}

__device__ __forceinline__ void scan_rwkv_mfma_unit(const Args& A, Frame& F, int unit) {
    int tid = F.tid; asm volatile("" : "+v"(tid));
    const int lane = tid & 63, w = F.wave;
    const int b = unit >> 3, hp = unit & 7;
    const bf16* P = (const bf16*)(A.ws + WS_PROJ) + (size_t)b * SEQ * PROJ_LD + OC_RW;
    const bf16* LO = (const bf16*)(A.ws + WS_LO) + (size_t)b * SEQ * LORA_N;
    bf16* Y = (bf16*)(A.ws + WS_ACTA) + (size_t)b * SEQ * D + 1024;
    LAS float* Lf = (LAS float*)(F.lds + RING_OFF);
    constexpr int RS = 72;
    constexpr int O_CONST = 0;
    constexpr int O_XF = 1280;
    constexpr int O_VV = O_XF + 2 * 5 * 1024;
    constexpr int O_BS = O_VV + 4 * 1024;
    constexpr int O_IMG = O_BS + 64;
    constexpr int I_CT = 0, I_BT = 576, I_KL = 1152, I_RT = 1728, I_CF = 2304, I_BTT = 3328, I_KTT = 3840, I_WCB = 4352, I_G1B = 4928, I_TTB = 5056, I_RKB = 5184, I_RBB = 5312, I_W15 = 5440, I_OUT = 5504, IMGSZ = 6528;
    static_assert((O_IMG + 2 * IMGSZ) * 4 <= RING_BYTES, "rwkv lds");
    for (int i = tid; i < 1280; i += NTHREADS) { const int arr = i >> 7, ch = hp * 128 + (i & 127); float v;
        switch (arr) { case 0: v = A.in[I_MU][RW_R + ch]; break; case 1: v = A.in[I_MU][RW_K + ch]; break; case 2: v = A.in[I_MU][RW_V + ch]; break; case 3: v = A.in[I_W0][ch]; break; case 4: v = A.in[I_A0][ch]; break;
                       case 5: v = A.in[I_KK][ch]; break; case 6: v = A.in[I_KA][ch]; break; case 7: v = A.in[I_RK][ch]; break; case 8: v = A.in[I_LNW][ch]; break; default: v = A.in[I_LNB][ch]; break; }
        Lf[O_CONST + i] = v; }
    const int hx = tid >> 8, tl = (tid >> 4) & 15, d4 = (tid & 15) * 4, ch4 = hx * 64 + d4, col4 = hp * 128 + ch4;
    u32x2 rr[2], rk[2], rv[2], rlw, rla, rg_cur = {0u, 0u}, rg_nxt = {0u, 0u}, rg_far = {0u, 0u};
#define RM_LOAD(c) do { const int t_ = (c) * TC + tl; const bf16* pr = P + (size_t)t_ * PROJ_LD + col4; \
        rr[0] = *(const GAS u32x2*)(pr + RW_R); rk[0] = *(const GAS u32x2*)(pr + RW_K); rv[0] = *(const GAS u32x2*)(pr + RW_V); \
        const bf16* pp_ = (t_ > 0) ? pr - PROJ_LD : pr; rr[1] = *(const GAS u32x2*)(pp_ + RW_R); rk[1] = *(const GAS u32x2*)(pp_ + RW_K); rv[1] = *(const GAS u32x2*)(pp_ + RW_V); \
        if (t_ == 0) { rr[1] = (u32x2){0u, 0u}; rk[1] = (u32x2){0u, 0u}; rv[1] = (u32x2){0u, 0u}; } \
        const bf16* lr = LO + (size_t)t_ * LORA_N + col4; rlw = *(const GAS u32x2*)(lr); rla = *(const GAS u32x2*)(lr + 1024); rg_far = *(const GAS u32x2*)(lr + 2048); } while (0)
#define RM_XFORM(bufi) do { LAS float* X_ = Lf + O_XF + hx * 5 * 1024 + tl * 64 + d4; \
        const f32x4 mur = *(const LAS f32x4*)(Lf + O_CONST + 0 * 128 + ch4), muk = *(const LAS f32x4*)(Lf + O_CONST + 1 * 128 + ch4), muv = *(const LAS f32x4*)(Lf + O_CONST + 2 * 128 + ch4); \
        const f32x4 w0_ = *(const LAS f32x4*)(Lf + O_CONST + 3 * 128 + ch4), a0_ = *(const LAS f32x4*)(Lf + O_CONST + 4 * 128 + ch4), kk_ = *(const LAS f32x4*)(Lf + O_CONST + 5 * 128 + ch4); \
        const f32x4 ka_ = *(const LAS f32x4*)(Lf + O_CONST + 6 * 128 + ch4), rk_ = *(const LAS f32x4*)(Lf + O_CONST + 7 * 128 + ch4); \
        const float r0[4] = {bf_lo(rr[0].x), bf_hi(rr[0].x), bf_lo(rr[0].y), bf_hi(rr[0].y)}, r1[4] = {bf_lo(rr[1].x), bf_hi(rr[1].x), bf_lo(rr[1].y), bf_hi(rr[1].y)}; \
        const float k0[4] = {bf_lo(rk[0].x), bf_hi(rk[0].x), bf_lo(rk[0].y), bf_hi(rk[0].y)}, k1[4] = {bf_lo(rk[1].x), bf_hi(rk[1].x), bf_lo(rk[1].y), bf_hi(rk[1].y)}; \
        const float v0[4] = {bf_lo(rv[0].x), bf_hi(rv[0].x), bf_lo(rv[0].y), bf_hi(rv[0].y)}, v1[4] = {bf_lo(rv[1].x), bf_hi(rv[1].x), bf_lo(rv[1].y), bf_hi(rv[1].y)}; \
        const float lw[4] = {bf_lo(rlw.x), bf_hi(rlw.x), bf_lo(rlw.y), bf_hi(rlw.y)}, la[4] = {bf_lo(rla.x), bf_hi(rla.x), bf_lo(rla.y), bf_hi(rla.y)}; \
        f32x4 r4, w4, k4, v4, kk4, b4; float skk = 0.f, sbs = 0.f; float aa[4]; \
        _Pragma("unroll") for (int i_ = 0; i_ < 4; ++i_) { const float r_ = r0[i_] + (r1[i_] - r0[i_]) * mur[i_], kx = k0[i_] + (k1[i_] - k0[i_]) * muk[i_], vx = v0[i_] + (v1[i_] - v0[i_]) * muv[i_]; \
            const float wd = __expf(-0.6065306597126334f * sigmoidf_(w0_[i_] + lw[i_])); const float a_ = sigmoidf_(a0_[i_] + la[i_]); \
            const float kk0 = kx * kk_[i_], km = kx * (1.f + (a_ - 1.f) * ka_[i_]); \
            r4[i_] = r_; w4[i_] = wd; k4[i_] = km; v4[i_] = vx; kk4[i_] = kk0; aa[i_] = a_; skk += kk0 * kk0; sbs += r_ * km * rk_[i_]; } \
        row_sum16_x2(skk, sbs); const float rkk = __builtin_amdgcn_rsqf(skk + EPS); \
        _Pragma("unroll") for (int i_ = 0; i_ < 4; ++i_) { kk4[i_] *= rkk; b4[i_] = kk4[i_] * aa[i_]; } \
        *(LAS f32x4*)(X_) = r4; *(LAS f32x4*)(X_ + 1024) = w4; *(LAS f32x4*)(X_ + 2048) = k4; *(LAS f32x4*)(X_ + 3072) = kk4; *(LAS f32x4*)(X_ + 4096) = b4; \
        *(LAS f32x4*)(Lf + O_VV + ((bufi) * 2 + hx) * 1024 + tl * 64 + d4) = v4; \
        if ((tid & 15) == 0) Lf[O_BS + ((bufi) * 2 + hx) * 16 + tl] = sbs; } while (0)
    LBAR();
    RM_LOAD(0); RM_XFORM(0); rg_cur = rg_far; RM_LOAD(1); rg_nxt = rg_far;
    LBAR();
    f32x4 Macc[4];
#pragma unroll
    for (int i = 0; i < 4; ++i) Macc[i] = (f32x4){0.f, 0.f, 0.f, 0.f};
    const int fr = lane & 15, g = lane >> 4, hh = w >> 2, ww = w & 3, c0 = ww * 16;
    LAS float* IM = Lf + O_IMG + hh * IMGSZ;
    LAS bf16* CT = (LAS bf16*)(IM + I_CT); LAS bf16* BT = (LAS bf16*)(IM + I_BT); LAS bf16* KL = (LAS bf16*)(IM + I_KL); LAS bf16* RT = (LAS bf16*)(IM + I_RT);
    LAS bf16* BTT = (LAS bf16*)(IM + I_BTT); LAS bf16* KTT = (LAS bf16*)(IM + I_KTT); LAS bf16* WCB = (LAS bf16*)(IM + I_WCB);
    LAS bf16* G1B = (LAS bf16*)(IM + I_G1B); LAS bf16* TTB = (LAS bf16*)(IM + I_TTB); LAS bf16* RKB = (LAS bf16*)(IM + I_RKB); LAS bf16* RBB = (LAS bf16*)(IM + I_RBB);
    const u32x2 zz = {0u, 0u};
    for (int c = 0; c < NCHUNK; ++c) {
        {
            const int hq = tid >> 8, seg = (tid >> 6) & 3, d = tid & 63;
            const LAS float* X_ = Lf + O_XF + hq * 5 * 1024 + d; LAS float* IQ = Lf + O_IMG + hq * IMGSZ;
            LAS bf16* CTq = (LAS bf16*)(IQ + I_CT); LAS bf16* BTq = (LAS bf16*)(IQ + I_BT); LAS bf16* KLq = (LAS bf16*)(IQ + I_KL); LAS bf16* RTq = (LAS bf16*)(IQ + I_RT);
            float wall = 1.f, wpre = 1.f;
#pragma unroll
            for (int t = 0; t < 16; ++t) { if (t == 4 * seg) wpre = wall; wall *= X_[1024 + t * 64]; }
            float wt = wpre; unsigned short bt4[4], kt4[4];
#pragma unroll
            for (int i = 0; i < 4; ++i) { const int t = 4 * seg + i; const float wprev = wt; wt *= X_[1024 + t * 64]; const float iw = __builtin_amdgcn_rcpf(wt);
                const float r_ = X_[t * 64], k_ = X_[2048 + t * 64], kk_ = X_[3072 + t * 64], b_ = X_[4096 + t * 64];
                const float ct = kk_ * wprev, bt = b_ * iw, kt = k_ * iw;
                CTq[t * RS + d] = hw_bf(ct); IQ[I_CF + t * 64 + d] = ct; BTq[t * RS + d] = hw_bf(bt); KLq[t * RS + d] = hw_bf(kt); RTq[t * RS + d] = hw_bf(r_ * wt);
                bt4[i] = (unsigned short)hw_bf(-bt); kt4[i] = (unsigned short)hw_bf(kt); }
            u32x2 o; o.x = (unsigned)bt4[0] | ((unsigned)bt4[1] << 16); o.y = (unsigned)bt4[2] | ((unsigned)bt4[3] << 16); *(LAS u32x2*)((LAS bf16*)(IQ + I_BTT) + d * 16 + 4 * seg) = o;
            o.x = (unsigned)kt4[0] | ((unsigned)kt4[1] << 16); o.y = (unsigned)kt4[2] | ((unsigned)kt4[3] << 16); *(LAS u32x2*)((LAS bf16*)(IQ + I_KTT) + d * 16 + 4 * seg) = o;
            if (seg == 3) IQ[I_W15 + d] = wall;
        }
        LBAR();
        if (ww == 0) {
            f32x4 cb = {0.f, 0.f, 0.f, 0.f}, bc = cb, ck = cb, rkm = cb, rbm = cb;
#pragma unroll
            for (int ks = 0; ks < 2; ++ks) { const bf16x8 fc = *(const LAS bf16x8*)(CT + fr * RS + 32 * ks + 8 * g), fb = *(const LAS bf16x8*)(BT + fr * RS + 32 * ks + 8 * g), fk = *(const LAS bf16x8*)(KL + fr * RS + 32 * ks + 8 * g), frr = *(const LAS bf16x8*)(RT + fr * RS + 32 * ks + 8 * g);
                cb = __builtin_amdgcn_mfma_f32_16x16x32_bf16(fc, fb, cb, 0, 0, 0); bc = __builtin_amdgcn_mfma_f32_16x16x32_bf16(fb, fc, bc, 0, 0, 0); ck = __builtin_amdgcn_mfma_f32_16x16x32_bf16(fc, fk, ck, 0, 0, 0);
                rkm = __builtin_amdgcn_mfma_f32_16x16x32_bf16(frr, fk, rkm, 0, 0, 0); rbm = __builtin_amdgcn_mfma_f32_16x16x32_bf16(frr, fb, rbm, 0, 0, 0); }
            f32x4 N1, M1, CKm;
#pragma unroll
            for (int r = 0; r < 4; ++r) { const int t = 4 * g + r; N1[r] = (fr < t) ? -cb[r] : 0.f; M1[r] = (t < fr) ? -bc[r] : 0.f; CKm[r] = (fr < t) ? ck[r] : 0.f;
                RKB[t * 16 + fr] = hw_bf((fr <= t) ? rkm[r] : 0.f); RBB[t * 16 + fr] = hw_bf((fr <= t) ? -rbm[r] : 0.f); }
#define XTY(X, Y, C0) __builtin_amdgcn_mfma_f32_16x16x32_bf16(mk_frag((u32x2){hw_pk2(X[0], X[1]), hw_pk2(X[2], X[3])}, zz), mk_frag((u32x2){hw_pk2(Y[0], Y[1]), hw_pk2(Y[2], Y[3])}, zz), C0, 0, 0, 0)
            const f32x4 z4 = {0.f, 0.f, 0.f, 0.f};
            f32x4 T1t = M1;
#pragma unroll
            for (int r = 0; r < 4; ++r) if (4 * g + r == fr) T1t[r] += 1.f;
            const f32x4 N2 = XTY(M1, N1, z4), M2 = XTY(N1, M1, z4);
            const f32x4 T2t = XTY(N2, T1t, T1t);
            const f32x4 N4 = XTY(M2, N2, z4), M4 = XTY(N2, M2, z4);
            const f32x4 T4t = XTY(N4, T2t, T2t);
            const f32x4 N8 = XTY(M4, N4, z4);
            const f32x4 T8t = XTY(N8, T4t, T4t);
            const f32x4 G1t = XTY(CKm, T8t, z4);
#undef XTY
            u32x2 tw; tw.x = hw_pk2(T8t[0], T8t[1]); tw.y = hw_pk2(T8t[2], T8t[3]); *(LAS u32x2*)(TTB + fr * 16 + 4 * g) = tw;
            tw.x = hw_pk2(G1t[0], G1t[1]); tw.y = hw_pk2(G1t[2], G1t[3]); *(LAS u32x2*)(G1B + fr * 16 + 4 * g) = tw;
        }
        if (c + 1 < NCHUNK) { RM_XFORM((c + 1) & 1); }
        if (c + 2 < NCHUNK) RM_LOAD(c + 2);
        LBAR();
        const LAS float* VVc = Lf + O_VV + ((c & 1) * 2 + hh) * 1024;
        u32x2 vlo; { vlo.x = hw_pk2(VVc[(4 * g + 0) * 64 + c0 + fr], VVc[(4 * g + 1) * 64 + c0 + fr]); vlo.y = hw_pk2(VVc[(4 * g + 2) * 64 + c0 + fr], VVc[(4 * g + 3) * 64 + c0 + fr]); }
        const bf16x8 vb = mk_frag(vlo, zz);
        f32x4 accU = {0.f, 0.f, 0.f, 0.f};
        {
            accU = __builtin_amdgcn_mfma_f32_16x16x32_bf16(mk_frag(*(const LAS u32x2*)(G1B + fr * 16 + 4 * g), zz), vb, accU, 0, 0, 0);
            u32x2 clo; clo.x = hw_pk2(IM[I_CF + (4 * g + 0) * 64 + c0 + fr], IM[I_CF + (4 * g + 1) * 64 + c0 + fr]); clo.y = hw_pk2(IM[I_CF + (4 * g + 2) * 64 + c0 + fr], IM[I_CF + (4 * g + 3) * 64 + c0 + fr]);
            f32x4 accw = {0.f, 0.f, 0.f, 0.f};
            accw = __builtin_amdgcn_mfma_f32_16x16x32_bf16(mk_frag(*(const LAS u32x2*)(TTB + fr * 16 + 4 * g), zz), mk_frag(clo, zz), accw, 0, 0, 0);
#pragma unroll
            for (int r = 0; r < 4; ++r) WCB[(4 * g + r) * RS + c0 + fr] = hw_bf(accw[r]);
        }
        LBAR();
        {
            bf16x8 mb[2];
#pragma unroll
            for (int ks = 0; ks < 2; ++ks) { u32x2 slo, shi; slo.x = hw_pk2(Macc[2 * ks][0], Macc[2 * ks][1]); slo.y = hw_pk2(Macc[2 * ks][2], Macc[2 * ks][3]); shi.x = hw_pk2(Macc[2 * ks + 1][0], Macc[2 * ks + 1][1]); shi.y = hw_pk2(Macc[2 * ks + 1][2], Macc[2 * ks + 1][3]);
                mb[ks] = mk_frag(slo, shi); }
            f32x4 accR = accU, acco = {0.f, 0.f, 0.f, 0.f};
#pragma unroll
            for (int ks = 0; ks < 2; ++ks) {
                accR = __builtin_amdgcn_mfma_f32_16x16x32_bf16(mk_frag(*(const LAS u32x2*)(WCB + fr * RS + 32 * ks + 4 * g), *(const LAS u32x2*)(WCB + fr * RS + 32 * ks + 16 + 4 * g)), mb[ks], accR, 0, 0, 0);
                acco = __builtin_amdgcn_mfma_f32_16x16x32_bf16(mk_frag(*(const LAS u32x2*)(RT + fr * RS + 32 * ks + 4 * g), *(const LAS u32x2*)(RT + fr * RS + 32 * ks + 16 + 4 * g)), mb[ks], acco, 0, 0, 0); }
            u32x2 rn; rn.x = hw_pk2(accR[0], accR[1]); rn.y = hw_pk2(accR[2], accR[3]);
            const bf16x8 rb = mk_frag(rn, zz);
            acco = __builtin_amdgcn_mfma_f32_16x16x32_bf16(mk_frag(*(const LAS u32x2*)(RKB + fr * 16 + 4 * g), zz), vb, acco, 0, 0, 0);
            acco = __builtin_amdgcn_mfma_f32_16x16x32_bf16(mk_frag(*(const LAS u32x2*)(RBB + fr * 16 + 4 * g), zz), rb, acco, 0, 0, 0);
#pragma unroll
            for (int r = 0; r < 4; ++r) IM[I_OUT + (4 * g + r) * 64 + c0 + fr] = acco[r];
#pragma unroll
            for (int i = 0; i < 4; ++i) { const f32x4 w15 = *(const LAS f32x4*)(IM + I_W15 + 16 * i + 4 * g);
                f32x4 m = __builtin_amdgcn_mfma_f32_16x16x32_bf16(mk_frag(*(const LAS u32x2*)(KTT + (16 * i + fr) * 16 + 4 * g), zz), vb, Macc[i], 0, 0, 0);
                m = __builtin_amdgcn_mfma_f32_16x16x32_bf16(mk_frag(*(const LAS u32x2*)(BTT + (16 * i + fr) * 16 + 4 * g), zz), rb, m, 0, 0, 0);
                Macc[i] = m * w15; }
        }
        LBAR();
        {
            const f32x4 o4 = *(const LAS f32x4*)(Lf + O_IMG + hx * IMGSZ + I_OUT + tl * 64 + d4); const f32x4 vv = *(const LAS f32x4*)(Lf + O_VV + ((c & 1) * 2 + hx) * 1024 + tl * 64 + d4); const float bs = Lf[O_BS + ((c & 1) * 2 + hx) * 16 + tl];
            const f32x4 lnw = *(const LAS f32x4*)(Lf + O_CONST + 8 * 128 + ch4), lnb = *(const LAS f32x4*)(Lf + O_CONST + 9 * 128 + ch4);
            float sm = (o4[0] + o4[1]) + (o4[2] + o4[3]), dummy = 0.f; row_sum16_x2(sm, dummy); const float mean = sm * (1.0f / 64.0f);
            const f32x4 e4 = o4 - mean; float sv = (e4[0] * e4[0] + e4[1] * e4[1]) + (e4[2] * e4[2] + e4[3] * e4[3]); row_sum16_x2(sv, dummy); const float rs = __builtin_amdgcn_rsqf(sv * (1.0f / 64.0f) + 64e-5f);
            const float gg[4] = {bf_lo(rg_cur.x), bf_hi(rg_cur.x), bf_lo(rg_cur.y), bf_hi(rg_cur.y)};
            float y[4];
#pragma unroll
            for (int i = 0; i < 4; ++i) y[i] = (e4[i] * rs * lnw[i] + lnb[i] + bs * vv[i]) * gg[i];
            u32x2 o; o.x = hw_pk2(y[0], y[1]); o.y = hw_pk2(y[2], y[3]);
            *(GAS u32x2*)(Y + (size_t)(c * TC + tl) * D + col4) = o;
        }
        rg_cur = rg_nxt; rg_nxt = rg_far;
    }
#undef RM_LOAD
#undef RM_XFORM
}

__device__ __forceinline__ int med3i(int a, int b, int c) { int r; asm("v_med3_i32 %0, %1, %2, %3" : "=v"(r) : "v"(a), "v"(b), "v"(c)); return r; }
__device__ __forceinline__ int f2sort(float f) { int x = __float_as_int(f); return x ^ ((x >> 31) & 0x7fffffff); }
__device__ __forceinline__ float sort2f(int x) { return __int_as_float(x ^ ((x >> 31) & 0x7fffffff)); }
#define TOPK_INSERT(vals, x) do { _Pragma("unroll") for (int s_ = 15; s_ >= 1; --s_) vals[s_] = med3i((x), vals[s_ - 1], vals[s_]); vals[0] = max(vals[0], (x)); } while (0)
__device__ __forceinline__ float bf_dot2(unsigned a, unsigned b, float c) {
    return c + bf_lo(a) * bf_lo(b) + bf_hi(a) * bf_hi(b);
}
__device__ __forceinline__ void sum8_x8(float (&a)[8]) {
    asm("s_nop 1\n\t"
        "v_add_f32_dpp %0, %0, %0 quad_perm:[1,0,3,2] row_mask:0xf bank_mask:0xf\n\tv_add_f32_dpp %1, %1, %1 quad_perm:[1,0,3,2] row_mask:0xf bank_mask:0xf\n\t"
        "v_add_f32_dpp %2, %2, %2 quad_perm:[1,0,3,2] row_mask:0xf bank_mask:0xf\n\tv_add_f32_dpp %3, %3, %3 quad_perm:[1,0,3,2] row_mask:0xf bank_mask:0xf\n\t"
        "v_add_f32_dpp %4, %4, %4 quad_perm:[1,0,3,2] row_mask:0xf bank_mask:0xf\n\tv_add_f32_dpp %5, %5, %5 quad_perm:[1,0,3,2] row_mask:0xf bank_mask:0xf\n\t"
        "v_add_f32_dpp %6, %6, %6 quad_perm:[1,0,3,2] row_mask:0xf bank_mask:0xf\n\tv_add_f32_dpp %7, %7, %7 quad_perm:[1,0,3,2] row_mask:0xf bank_mask:0xf\n\t"
        "v_add_f32_dpp %0, %0, %0 quad_perm:[2,3,0,1] row_mask:0xf bank_mask:0xf\n\tv_add_f32_dpp %1, %1, %1 quad_perm:[2,3,0,1] row_mask:0xf bank_mask:0xf\n\t"
        "v_add_f32_dpp %2, %2, %2 quad_perm:[2,3,0,1] row_mask:0xf bank_mask:0xf\n\tv_add_f32_dpp %3, %3, %3 quad_perm:[2,3,0,1] row_mask:0xf bank_mask:0xf\n\t"
        "v_add_f32_dpp %4, %4, %4 quad_perm:[2,3,0,1] row_mask:0xf bank_mask:0xf\n\tv_add_f32_dpp %5, %5, %5 quad_perm:[2,3,0,1] row_mask:0xf bank_mask:0xf\n\t"
        "v_add_f32_dpp %6, %6, %6 quad_perm:[2,3,0,1] row_mask:0xf bank_mask:0xf\n\tv_add_f32_dpp %7, %7, %7 quad_perm:[2,3,0,1] row_mask:0xf bank_mask:0xf\n\t"
        "v_add_f32_dpp %0, %0, %0 row_half_mirror row_mask:0xf bank_mask:0xf\n\tv_add_f32_dpp %1, %1, %1 row_half_mirror row_mask:0xf bank_mask:0xf\n\t"
        "v_add_f32_dpp %2, %2, %2 row_half_mirror row_mask:0xf bank_mask:0xf\n\tv_add_f32_dpp %3, %3, %3 row_half_mirror row_mask:0xf bank_mask:0xf\n\t"
        "v_add_f32_dpp %4, %4, %4 row_half_mirror row_mask:0xf bank_mask:0xf\n\tv_add_f32_dpp %5, %5, %5 row_half_mirror row_mask:0xf bank_mask:0xf\n\t"
        "v_add_f32_dpp %6, %6, %6 row_half_mirror row_mask:0xf bank_mask:0xf\n\tv_add_f32_dpp %7, %7, %7 row_half_mirror row_mask:0xf bank_mask:0xf\n\t"
        "s_nop 1"
        : "+v"(a[0]), "+v"(a[1]), "+v"(a[2]), "+v"(a[3]), "+v"(a[4]), "+v"(a[5]), "+v"(a[6]), "+v"(a[7]));
}
__device__ __forceinline__ float sum8_x1(float v) {
    asm("s_nop 1\n\tv_add_f32_dpp %0, %0, %0 quad_perm:[1,0,3,2] row_mask:0xf bank_mask:0xf\n\ts_nop 1\n\tv_add_f32_dpp %0, %0, %0 quad_perm:[2,3,0,1] row_mask:0xf bank_mask:0xf\n\ts_nop 1\n\t"
        "v_add_f32_dpp %0, %0, %0 row_half_mirror row_mask:0xf bank_mask:0xf\n\ts_nop 1" : "+v"(v));
    return v;
}
__device__ __forceinline__ void peer_phase(const Args& A, Frame& F, int L, const bool dry) {
    int lane = F.lane; asm volatile("" : "+v"(lane));
    const int gw = F.vcu * NWAVES + F.wave;
    const bf16* SCR = (const bf16*)(A.ws + WS_SC); const bf16* X = (const bf16*)(A.ws + WS_ACTB); bf16* HG = (bf16*)(A.ws + WS_ACTA);
    const unsigned char* TU = (const unsigned char*)(A.ws + WS_TABU) + (size_t)L * 16384 * D; const unsigned char* TV = (const unsigned char*)(A.ws + WS_TABV) + (size_t)L * 16384 * D;
    const float* rowss = (const float*)(A.ws + WS_RSP) + (size_t)(L == 0 ? RS_FFN0 : RS_FFN1) * T * 32;
    const float* gple = A.in[I_NPLE] + (size_t)L * D;
    float* H = A.out;
    LAS unsigned* LIST = (LAS unsigned*)(F.lds + RING_OFF + F.wave * 16384);
    LAS unsigned* EIDX = LIST + 1024;
    LAS float* ECOEF = (LAS float*)(EIDX + 1024);
    const int tbase = gw * 8;
    if (tbase >= T) return;
    for (int half = 0; half < 2; ++half) {
        const int t0 = tbase + 4 * half;
        {
            const bf16* sp = SCR + (size_t)(t0 + (lane >> 4)) * D + (lane & 15) * 128;
            int vals[16];
#pragma unroll
            for (int s = 0; s < 16; ++s) vals[s] = (int)0x80000000;
#pragma unroll 2
            for (int c = 0; c < 16; ++c) { const v4u wv = *(const GAS v4u*)(sp + c * 8); const unsigned ww[4] = {wv.x, wv.y, wv.z, wv.w};
#pragma unroll
                for (int e = 0; e < 8; ++e) { const unsigned bits = (e & 1) ? (ww[e >> 1] & 0xffff0000u) : (ww[e >> 1] << 16);
                    int x = (int)bits; x ^= (x >> 31) & 0x7fffffff; x = (x & ~0x7f) | (127 - (c * 8 + e));
                    TOPK_INSERT(vals, x); } }
#pragma unroll
            for (int q = 0; q < 4; ++q) { v4u o; o.x = (unsigned)vals[4 * q]; o.y = (unsigned)vals[4 * q + 1]; o.z = (unsigned)vals[4 * q + 2]; o.w = (unsigned)vals[4 * q + 3]; *(LAS v4u*)(LIST + lane * 16 + 4 * q) = o; }
        }
        LDS_WAIT(); asm volatile("" ::: "memory");
        if (lane < 32) {
            const LAS unsigned* la = LIST + ((lane >> 3) * 16 + (lane & 7) * 2) * 16; const LAS unsigned* lb2 = la + 16;
            float av[16], bv[16];
#pragma unroll
            for (int q = 0; q < 4; ++q) { const v4u a4 = *(const LAS v4u*)(la + 4 * q), b4 = *(const LAS v4u*)(lb2 + 4 * q); const unsigned aw[4] = {a4.x, a4.y, a4.z, a4.w}, bw[4] = {b4.x, b4.y, b4.z, b4.w};
#pragma unroll
                for (int e = 0; e < 4; ++e) { av[4 * q + e] = __uint_as_float(__float_as_uint(sort2f((int)(aw[e] & ~0x7fu))) & 0xffff0000u); bv[4 * q + e] = __uint_as_float(__float_as_uint(sort2f((int)(bw[e] & ~0x7fu))) & 0xffff0000u); } }
            int best[16];
#pragma unroll
            for (int s = 0; s < 16; ++s) best[s] = (int)0x80000000;
#pragma unroll
            for (int i = 0; i < 16; ++i)
#pragma unroll
                for (int jx = 0; jx < 16; ++jx) if ((i + 1) * (jx + 1) <= 16) { int x = f2sort(av[i] + bv[jx]); x = (x & ~0xff) | (255 - (i * 16 + jx)); TOPK_INSERT(best, x); }
            float sv[16]; unsigned ex[16];
#pragma unroll
            for (int s = 0; s < 16; ++s) { const int cand = 255 - (best[s] & 0xff); const unsigned ka = la[cand >> 4], kb = lb2[cand & 15];
                ex[s] = (127u - (ka & 0x7fu)) * 128u + (127u - (kb & 0x7fu));
                sv[s] = __uint_as_float(__float_as_uint(sort2f((int)(ka & ~0x7fu))) & 0xffff0000u) + __uint_as_float(__float_as_uint(sort2f((int)(kb & ~0x7fu))) & 0xffff0000u); }
            float mx = sv[0];
#pragma unroll
            for (int s = 1; s < 16; ++s) mx = fmaxf(mx, sv[s]);
            float den = 0.f;
#pragma unroll
            for (int s = 0; s < 16; ++s) { sv[s] = __expf(sv[s] - mx); den += sv[s]; }
            const float inv = 1.0f / den; const int base = (4 * half + (lane >> 3)) * 128 + (lane & 7) * 16;
#pragma unroll
            for (int s = 0; s < 16; ++s) { EIDX[base + s] = ex[s]; ECOEF[base + s] = sv[s] * inv; }
        }
        LDS_WAIT(); asm volatile("" ::: "memory");
    }
    const int tk = lane >> 3, part = lane & 7, t = tbase + tk;
    const LAS unsigned* eidx = EIDX + tk * 128; LAS float* ecoef = ECOEF + tk * 128;
    const float rs = __builtin_amdgcn_rsqf(sum8_x1(((const GAS f32x4*)(rowss + (size_t)t * 32))[part][0] + ((const GAS f32x4*)(rowss + (size_t)t * 32))[part][1] + ((const GAS f32x4*)(rowss + (size_t)t * 32))[part][2] + ((const GAS f32x4*)(rowss + (size_t)t * 32))[part][3]) * (1.0f / D) + EPS) * (1.0f / 512.0f);
#define PEER_LOAD8(dst, TAB, i0, soff) do { const v4u ia_ = *(const LAS v4u*)(eidx + (i0)), ib_ = *(const LAS v4u*)(eidx + (i0) + 4); const unsigned ee_[8] = {ia_.x, ia_.y, ia_.z, ia_.w, ib_.x, ib_.y, ib_.z, ib_.w}; \
        _Pragma("unroll") for (int j_ = 0; j_ < 8; ++j_) dst[j_] = *(const GAS v4u*)((TAB) + (size_t)(ee_[j_] * 2048u + (unsigned)(soff))); } while (0)
    LAS float* dotw = (LAS float*)LIST + tk * 128;
#pragma unroll
    for (int m = 0; m < 16; ++m) dotw[8 * m + part] = 0.f;
#pragma unroll 1
    for (int p = 0; p < 16; ++p) {
        const int soff = 128 * p + 16 * part;
        float xs[16];
        { const v4u x0 = *(const GAS v4u*)(X + (size_t)t * D + soff), x1 = *(const GAS v4u*)(X + (size_t)t * D + soff + 8); const unsigned xw[8] = {x0.x, x0.y, x0.z, x0.w, x1.x, x1.y, x1.z, x1.w};
#pragma unroll
          for (int e = 0; e < 8; ++e) { xs[2 * e] = bf_lo(xw[e]); xs[2 * e + 1] = bf_hi(xw[e]); } }
#define PEER_UDOT8(src, m_) do { float tt_[8]; \
        _Pragma("unroll") for (int j_ = 0; j_ < 8; ++j_) { const unsigned ww_[4] = {src[j_].x, src[j_].y, src[j_].z, src[j_].w}; float a0_ = 0.f, a1_ = 0.f; \
            _Pragma("unroll") for (int e_ = 0; e_ < 4; ++e_) { const f32x2 lo_ = __builtin_amdgcn_cvt_pk_f32_fp8((int)ww_[e_], false), hi_ = __builtin_amdgcn_cvt_pk_f32_fp8((int)ww_[e_], true); \
                a0_ += xs[4 * e_] * lo_[0]; a1_ += xs[4 * e_ + 1] * lo_[1]; a0_ += xs[4 * e_ + 2] * hi_[0]; a1_ += xs[4 * e_ + 3] * hi_[1]; } \
            tt_[j_] = a0_ + a1_; } \
        sum8_x8(tt_); \
        float sel_ = tt_[0]; _Pragma("unroll") for (int j_ = 1; j_ < 8; ++j_) sel_ = (part == j_) ? tt_[j_] : sel_; \
        dotw[8 * (m_) + part] += sel_; } while (0)
        v4u ua[8], ub[8];
        PEER_LOAD8(ua, TU, 0, soff);
#pragma unroll 1
        for (int m = 0; m < 16; m += 2) {
            PEER_LOAD8(ub, TU, 8 * (m + 1), soff);
            PEER_UDOT8(ua, m);
            if (m + 2 < 16) PEER_LOAD8(ua, TU, 8 * (m + 2), soff);
            PEER_UDOT8(ub, m + 1);
        }
    }
#undef PEER_UDOT8
#pragma unroll
    for (int m = 0; m < 16; ++m) { const float d_ = dotw[8 * m + part] * rs; const float act = 0.5f * d_ * (1.0f + erff(d_ * 0.7071067811865476f)); ecoef[8 * m + part] *= act * (1.0f / 16.0f); }
    LDS_WAIT(); asm volatile("" ::: "memory");
    float ss = 0.f;
#pragma unroll 1
    for (int p = 0; p < 16; ++p) {
        const int soff = 128 * p + 16 * part;
        float acc[16];
#pragma unroll
        for (int i = 0; i < 16; ++i) acc[i] = 0.f;
#define PEER_VACC8(src, i0) do { const f32x4 ca_ = *(const LAS f32x4*)(ecoef + (i0)), cb_ = *(const LAS f32x4*)(ecoef + (i0) + 4); const float cf_[8] = {ca_[0], ca_[1], ca_[2], ca_[3], cb_[0], cb_[1], cb_[2], cb_[3]}; \
        _Pragma("unroll") for (int j_ = 0; j_ < 8; ++j_) { const unsigned ww_[4] = {src[j_].x, src[j_].y, src[j_].z, src[j_].w}; \
            _Pragma("unroll") for (int e_ = 0; e_ < 4; ++e_) { const f32x2 lo_ = __builtin_amdgcn_cvt_pk_f32_fp8((int)ww_[e_], false), hi_ = __builtin_amdgcn_cvt_pk_f32_fp8((int)ww_[e_], true); \
                acc[4 * e_] += cf_[j_] * lo_[0]; acc[4 * e_ + 1] += cf_[j_] * lo_[1]; acc[4 * e_ + 2] += cf_[j_] * hi_[0]; acc[4 * e_ + 3] += cf_[j_] * hi_[1]; } } } while (0)
        v4u va[8], vb[8];
        PEER_LOAD8(va, TV, 0, soff);
#pragma unroll 1
        for (int m = 0; m < 16; m += 2) {
            PEER_LOAD8(vb, TV, 8 * (m + 1), soff);
            PEER_VACC8(va, 8 * m);
            if (m + 2 < 16) PEER_LOAD8(va, TV, 8 * (m + 2), soff);
            PEER_VACC8(vb, 8 * (m + 1));
        }
        GAS f32x4* hp = (GAS f32x4*)(H + (size_t)t * D + soff);
#pragma unroll
        for (int q = 0; q < 4; ++q) { f32x4 h0 = hp[q];
#pragma unroll
            for (int e = 0; e < 4; ++e) { h0[e] += acc[4 * q + e]; ss += h0[e] * h0[e]; }
            if (!dry) hp[q] = h0; else asm volatile("" :: "v"(h0[0]), "v"(h0[1]), "v"(h0[2]), "v"(h0[3])); }
    }
#undef PEER_VACC8
#undef PEER_LOAD8
    const float r3 = __builtin_amdgcn_rsqf(sum8_x1(ss) * (1.0f / D) + EPS);
    if (!dry) {
#pragma unroll 2
        for (int p = 0; p < 16; ++p) { const int soff = 128 * p + 16 * part; const GAS f32x4* hp = (const GAS f32x4*)(H + (size_t)t * D + soff); const GAS f32x4* gp = (const GAS f32x4*)(gple + soff);
            unsigned ow[8];
#pragma unroll
            for (int q = 0; q < 4; ++q) { const f32x4 h0 = hp[q], g0 = gp[q]; ow[2 * q] = pk2(h0[0] * r3 * g0[0], h0[1] * r3 * g0[1]); ow[2 * q + 1] = pk2(h0[2] * r3 * g0[2], h0[3] * r3 * g0[3]); }
            v4u o0, o1; o0.x = ow[0]; o0.y = ow[1]; o0.z = ow[2]; o0.w = ow[3]; o1.x = ow[4]; o1.y = ow[5]; o1.z = ow[6]; o1.w = ow[7];
            *(GAS v4u*)(HG + (size_t)t * D + soff) = o0; *(GAS v4u*)(HG + (size_t)t * D + soff + 8) = o1; }
    }
}

constexpr int N_PHASES = 19;
__global__ void __launch_bounds__(NTHREADS, 2) mega_fwd(Args args) {
    extern __shared__ __attribute__((aligned(16))) unsigned char lds[];
    Frame F;
    F.lds = (LAS unsigned char*)lds;
    F.MISC = (volatile LAS unsigned*)(F.lds + MISC_OFF);
    F.tid = threadIdx.x; F.lane = F.tid & 63; F.wave = __builtin_amdgcn_readfirstlane(F.tid >> 6);
    F.G = gridDim.x; { const int bx = blockIdx.x; F.vcu = (F.G % 8 == 0) ? (bx % 8) * (F.G / 8) + bx / 8 : bx; }
    unsigned char* ws = args.ws;
    F.ctl = (gu32*)(ws + WS_CTL);
    for (int u = F.tid; u < (LDS_BYTES - LDSCTL_OFF) / 4; u += NTHREADS) ((LAS unsigned*)(F.lds + LDSCTL_OFF))[u] = 0u;
    __syncthreads();
    const int lo = args.ph_lo, hi = args.ph_hi;
    XcdBarrier bar; bar.bar = (unsigned*)(F.ctl + CW_BAR); bar.x = 0; bar.st = nullptr;
    if (hi - lo > 1) bar = xcd_barrier_post((unsigned*)(F.ctl + CW_BAR), F.MISC + 8);
#define IN(k) (lo <= (k) && (k) < hi)
#define REPS(k) (1 + ((DUP_MASK >> (k)) & 1))
#if PROBE_MASK
    unsigned long long* const tsb = (unsigned long long*)(ws + WS_CTL + 65536);
#define STAMP(k) do { if (blockIdx.x == 0 && F.tid == 0) __hip_atomic_store(tsb + (k), __builtin_amdgcn_s_memrealtime(), __ATOMIC_RELAXED, __HIP_MEMORY_SCOPE_AGENT); } while (0)
    STAMP(31);
#else
#define STAMP(k) do { } while (0)
#endif
#define SEAM(k) do { if (IN(k) && IN((k) + 1)) { if ((k) == 0) { cg::this_grid().sync(); } else { xcd_barrier(bar); } STAMP(k); } } while (0)
    float* rowss = (float*)(ws + WS_RSP);
    bf16* ACTA = (bf16*)(ws + WS_ACTA); bf16* ACTB = (bf16*)(ws + WS_ACTB); bf16* PROJ = (bf16*)(ws + WS_PROJ); bf16* SCB = (bf16*)(ws + WS_SC); bf16* PP = (bf16*)(ws + WS_PP);
    const int gtid = (F.vcu * NWAVES + F.wave) * 64 + F.lane, gthreads = F.G * NTHREADS;

#if UBENCH
    {
        typedef _Float16 h2_t __attribute__((ext_vector_type(2)));
        float a[32]; f32x2 p[16]; h2_t hh[32];
#pragma unroll
        for (int i = 0; i < 32; ++i) { a[i] = (float)(F.tid + i); hh[i] = (h2_t){(_Float16)(F.lane + i), (_Float16)i}; }
#pragma unroll
        for (int i = 0; i < 16; ++i) p[i] = (f32x2){a[2 * i], a[2 * i + 1]};
        const float m = 1.0f + 1e-7f * F.lane, c = 1e-9f; const f32x2 m2 = {m, m}, c2 = {c, c}; const h2_t mh = {(_Float16)1.0f, (_Float16)1.0f}, ch = {(_Float16)0.0f, (_Float16)0.0f};
#pragma unroll 1
        for (int it = 0; it < 10000; ++it) {
#if UBENCH == 1
#pragma unroll
            for (int i = 0; i < 32; ++i) asm volatile("v_fma_f32 %0, %0, %1, %2" : "+v"(a[i]) : "v"(m), "v"(c));
#elif UBENCH == 2
#pragma unroll
            for (int i = 0; i < 16; ++i) asm volatile("v_pk_fma_f32 %0, %0, %1, %2\n\tv_pk_fma_f32 %0, %0, %1, %2" : "+v"(p[i]) : "v"(m2), "v"(c2));
#elif UBENCH == 3
#pragma unroll
            for (int i = 0; i < 32; ++i) asm volatile("v_pk_fma_f16 %0, %0, %1, %2" : "+v"(hh[i]) : "v"(mh), "v"(ch));
#endif
        }
        float s = 0.f;
#pragma unroll
        for (int i = 0; i < 32; ++i) s += a[i] + (float)hh[i][0];
#pragma unroll
        for (int i = 0; i < 16; ++i) s += p[i][0] + p[i][1];
        if (s == 12345.678f) args.out[0] = s;
    }
#endif
    if (IN(0)) { p0_prologue(args, F); } SEAM(0);
    if (IN(1)) for (int rep_ = 0; rep_ < REPS(1); ++rep_) {
        { pg8::Gemm g{ACTA, (const bf16*)(ws + WS_WEV_IN), T, EV_NP, D}; pg8::StaticOrder S; S.init(T, EV_NP, F.G, (int)blockIdx.x); EpiBf16S E{PROJ, PROJ_LD, nullptr};
          pg8::gemm_phase<EpiBf16S, pg8::StaticOrder, true, true>(F.lds + RING_OFF, g, S, E); }
    } SEAM(1);
    if (IN(2)) for (int rep_ = 0; rep_ < REPS(2); ++rep_) { const bool split = F.G >= 256;
        if (!(split && F.vcu >= 128)) for (int u = F.vcu; u < 128; u += (split ? 128 : F.G)) { if (u < 64) scan_gla_mfma_unit<0>(args, F, u); else scan_gdn_mfma_unit(args, F, u - 64); __syncthreads(); }
        if (rep_ == 0) { if (split) { if (F.vcu >= 128) p0_deferred(args, F, F.vcu - 128, F.G - 128); } else p0_deferred(args, F, F.vcu, F.G); } } SEAM(2);
    if (IN(3)) for (int rep_ = 0; rep_ < REPS(3); ++rep_) { post_rows<0>(args, F); } SEAM(3);
    if (IN(4)) { pg8::Gemm g{ACTA, (const bf16*)(ws + WS_WEV_OUT), T, D, D}; pg8::StaticOrder S; S.init(T, D, F.G, (int)blockIdx.x);
        EpiResid<false> E{args.in[I_X], args.out, ACTB, args.in[I_NFFN], rowss + (size_t)RS_FFN0 * T * 32, nullptr};
        pg8::gemm_phase<EpiResid<false>, pg8::StaticOrder, true, true>(F.lds + RING_OFF, g, S, E); } SEAM(4);
    if (IN(5)) for (int rep_ = 0; rep_ < REPS(5); ++rep_) { { pg8::Gemm g{ACTB, (const bf16*)(ws + WS_WPEER), T, D, D}; pg8::StaticOrder S; S.init(T, D, F.G, (int)blockIdx.x); EpiBf16S E{SCB, D, rowss + (size_t)RS_FFN0 * T * 32};
        pg8::gemm_phase<EpiBf16S, pg8::StaticOrder, true, true>(F.lds + RING_OFF, g, S, E); }
        { pg8::Gemm g{(const bf16*)(ws + WS_PBF), (const bf16*)(ws + WS_WPROJ), T, D, 256}; pg8::StaticOrder S; S.init(T, D, F.G, (int)blockIdx.x); EpiBf16S E{PP, D, nullptr};
          pg8::gemm_phase<EpiBf16S, pg8::StaticOrder, true, true>(F.lds + RING_OFF, g, S, E); } } SEAM(5);
    if (IN(6)) for (int rep_ = 0; rep_ < REPS(6); ++rep_) { peer_phase(args, F, 0, rep_ != 0); } SEAM(6);
    if (IN(7)) { { pg8::Gemm g{ACTA, (const bf16*)(ws + WS_WGATE), T, D, D}; pg8::StaticOrder S; S.init(T, D, F.G, (int)blockIdx.x);
        EpiResid<true> E{args.out, args.out, ACTB, args.in[I_NMIX] + D, rowss + (size_t)RS_MIX1 * T * 32, PP};
        pg8::gemm_phase<EpiResid<true>, pg8::StaticOrder, true, true>(F.lds + RING_OFF, g, S, E); }
        } SEAM(7);
    if (IN(8)) for (int rep_ = 0; rep_ < REPS(8); ++rep_) {
        { pg8::Gemm g{ACTB, (const bf16*)(ws + WS_WOD_IN), T, OD_NP, D}; pg8::StaticOrder S; S.init(T, OD_NP, F.G, (int)blockIdx.x); EpiBf16S E{PROJ, PROJ_LD, rowss + (size_t)RS_MIX1 * T * 32};
          pg8::gemm_phase<EpiBf16S, pg8::StaticOrder, true, true>(F.lds + RING_OFF, g, S, E); }
        { pg8::Gemm g{(const bf16*)(ws + WS_PBF) + (size_t)T * 256, (const bf16*)(ws + WS_WPROJ) + (size_t)D * 256, T, D, 256}; pg8::StaticOrder S; S.init(T, D, F.G, (int)blockIdx.x); EpiBf16S E{PP, D, nullptr};
          pg8::gemm_phase<EpiBf16S, pg8::StaticOrder, true, true>(F.lds + RING_OFF, g, S, E); }
    } SEAM(8);
    if (IN(9)) for (int rep_ = 0; rep_ < REPS(9); ++rep_) { lora_prep_rows(args, F); } SEAM(9);
    if (IN(10)) for (int rep_ = 0; rep_ < REPS(10); ++rep_) { pg8::Gemm g{(const bf16*)(ws + WS_LA), (const bf16*)(ws + WS_WLORA), T, LORA_N, LORA_K}; pg8::StaticOrder S; S.init(T, LORA_N, F.G, (int)blockIdx.x); EpiBf16S E{(bf16*)(ws + WS_LO), LORA_N, nullptr};
        pg8::gemm_phase<EpiBf16S, pg8::StaticOrder, true, true>(F.lds + RING_OFF, g, S, E); } SEAM(10);
    if (IN(11)) for (int rep_ = 0; rep_ < REPS(11); ++rep_) { const bool split = F.G >= 256;
        if (!(split && F.vcu >= 128)) for (int u = F.vcu; u < 128; u += (split ? 128 : F.G)) { if (u < 64) scan_gla_mfma_unit<1>(args, F, u); else scan_rwkv_mfma_unit(args, F, u - 64); __syncthreads(); }
        if (rep_ == 0) { if (split) { if (F.vcu >= 128) p1_deferred(args, F, F.vcu - 128, F.G - 128); } else p1_deferred(args, F, F.vcu, F.G); } } SEAM(11);
    if (IN(12)) for (int rep_ = 0; rep_ < REPS(12); ++rep_) { post_rows<1>(args, F); } SEAM(12);
    if (IN(13)) { pg8::Gemm g{ACTA, (const bf16*)(ws + WS_WOD_OUT), T, D, D}; pg8::StaticOrder S; S.init(T, D, F.G, (int)blockIdx.x);
        EpiResid<false> E{args.out, args.out, ACTB, args.in[I_NFFN] + D, rowss + (size_t)RS_FFN1 * T * 32, nullptr};
        pg8::gemm_phase<EpiResid<false>, pg8::StaticOrder, true, true>(F.lds + RING_OFF, g, S, E); } SEAM(13);
    if (IN(14)) for (int rep_ = 0; rep_ < REPS(14); ++rep_) { pg8::Gemm g{ACTB, (const bf16*)(ws + WS_WPEER) + (size_t)D * D, T, D, D}; pg8::StaticOrder S; S.init(T, D, F.G, (int)blockIdx.x); EpiBf16S E{SCB, D, rowss + (size_t)RS_FFN1 * T * 32};
        pg8::gemm_phase<EpiBf16S, pg8::StaticOrder, true, true>(F.lds + RING_OFF, g, S, E); } SEAM(14);
    if (IN(15)) for (int rep_ = 0; rep_ < REPS(15); ++rep_) { peer_phase(args, F, 1, rep_ != 0); } SEAM(15);
    if (IN(16)) { pg8::Gemm g{ACTA, (const bf16*)(ws + WS_WGATE) + (size_t)D * D, T, D, D}; pg8::StaticOrder S; S.init(T, D, F.G, (int)blockIdx.x);
        EpiResid<true> E{args.out, args.out, nullptr, nullptr, rowss + (size_t)RS_FINAL * T * 32, PP};
        pg8::gemm_phase<EpiResid<true>, pg8::StaticOrder, true, true>(F.lds + RING_OFF, g, S, E); } SEAM(16);
    if (IN(17)) {
        float oscale = 1.0f;
#if PROBE_MASK
        { unsigned long long t_prev = __hip_atomic_load(tsb + 31, __ATOMIC_RELAXED, __HIP_MEMORY_SCOPE_AGENT); const unsigned long long t_begin = t_prev; unsigned long long sel = 0ull;
          for (int k = 0; k <= 16; ++k) { const unsigned long long tk = __hip_atomic_load(tsb + k, __ATOMIC_RELAXED, __HIP_MEMORY_SCOPE_AGENT); if ((PROBE_MASK >> k) & 1) sel += tk - t_prev; t_prev = tk; }
          const float f = (float)(double(sel) / double(t_prev - t_begin)); oscale = 1.0f + sqrtf(0.01f + 0.9f * f); }
#endif
        final_rows(args, F, oscale); }
#undef IN
#undef SEAM
}

extern "C" void kernel_launch(void* const* d_in, const int* in_sizes, int n_in, void* d_out, int out_size, void* d_ws, size_t ws_size, hipStream_t stream) {
    static int grid = 0;
    if (grid == 0) {
        if (n_in != N_IN || out_size != T * D || ws_size < WS_END) { fprintf(stderr, "kernel_launch: unexpected problem: n_in %d out %d ws %zu (need %zu)\n", n_in, out_size, ws_size, (size_t)WS_END); grid = -1; return; }
        int dev = 0, cus = 0, per_cu = 0;
        if (hipGetDevice(&dev) != hipSuccess || hipDeviceGetAttribute(&cus, hipDeviceAttributeMultiprocessorCount, dev) != hipSuccess) { grid = -1; return; }
        if (hipFuncSetAttribute((const void*)mega_fwd, hipFuncAttributeMaxDynamicSharedMemorySize, LDS_BYTES) != hipSuccess) { fprintf(stderr, "kernel_launch: hipFuncSetAttribute failed\n"); grid = -1; return; }
        if (hipOccupancyMaxActiveBlocksPerMultiprocessor(&per_cu, (const void*)mega_fwd, NTHREADS, LDS_BYTES) != hipSuccess || per_cu < 1) { fprintf(stderr, "kernel_launch: occupancy query says %d blocks per CU\n", per_cu); (void)hipGetLastError(); grid = -1; return; }
        grid = cus;
    }
    if (grid < 0) return;
    (void)hipMemsetAsync((char*)d_ws + WS_CTL, 0, CTL_ZERO_BYTES, stream);
    Args a{};
    for (int i = 0; i < N_IN; ++i) a.in[i] = (const float*)d_in[i];
    a.out = (float*)d_out; a.ws = (unsigned char*)d_ws;
#if MK_PER_PHASE
    for (int p = 0; p < N_PHASES - 1; ++p) { a.ph_lo = p; a.ph_hi = p + 1; hipLaunchKernelGGL(mega_fwd, dim3(grid), dim3(NTHREADS), LDS_BYTES, stream, a); }
#else
    a.ph_lo = 0; a.ph_hi = N_PHASES;
    void* kargs[] = {&a};
    hipError_t e = hipLaunchCooperativeKernel((const void*)mega_fwd, dim3(grid), dim3(NTHREADS), kargs, LDS_BYTES, stream);
    if (e != hipSuccess) fprintf(stderr, "kernel_launch: cooperative launch failed: %s (grid %d)\n", hipGetErrorString(e), grid);
#endif
}
```

```cpp
#include <hip/hip_runtime.h>
#include <hip/hip_cooperative_groups.h>
#include <cstdio>
#include <cstdint>
namespace cg = cooperative_groups;

#ifndef PROBE_MASK
#define PROBE_MASK 0
#endif
#ifndef DUP_MASK
#define DUP_MASK 0
#endif
#ifndef UBENCH
#define UBENCH 0
#endif
#ifndef GDN_DUP
#define GDN_DUP 0
#endif
#ifndef MK_PER_PHASE
#define MK_PER_PHASE 0
#endif

namespace pg8 {
#define PG8_LAS __attribute__((address_space(3)))
typedef unsigned short bf16_t;
typedef short bf16x8 __attribute__((ext_vector_type(8)));
typedef float f32x4 __attribute__((ext_vector_type(4)));
typedef unsigned u32x4 __attribute__((ext_vector_type(4)));
typedef unsigned u32x2 __attribute__((ext_vector_type(2)));
constexpr int BM = 256, BK = 64, HALF = 128, HTB = HALF * BK * 2  , STAGE_BYTES = 8 * HTB, NXCD = 8, WGM = 8;

__host__ __device__ __forceinline__ int lds_byte(int r, int c) { const int st = (r >> 4) * 2 + (c >> 5), rr = r & 15, cc = c & 31, ob = rr * 64 + cc * 2; return st * 1024 + (ob ^ (((ob >> 9) & 1) << 5)); }
__host__ __device__ __forceinline__ void stage_rc(int b, int& R, int& C) { const int st = b / 1024, sb = b % 1024, swz = sb ^ (((sb >> 9) & 1) << 5); R = (st >> 1) * 16 + swz / 64; C = (st & 1) * 32 + (swz % 64) / 2; }
__host__ __device__ __forceinline__ int perm32(int rho) { const int n = rho >> 4, i = rho & 15; return 8 * (i >> 2) + 4 * n + (i & 3); }

struct Unit { int pm, pn; };
struct Gemm { const bf16_t* A; const bf16_t* Bt; int M, N, K; };

struct StaticOrder {
    int nM, nN, nwg, G, c;
    __host__ __device__ void init(int M, int N, int G_, int c_) { nM = M / BM; nN = N / BM; nwg = nM * nN; G = G_; c = c_; }
    __host__ __device__ bool next(int i, Unit& u) const {
        const long L = (long)i * G + c; if (L >= nwg) return false;
        int wgid = (int)L; { const int q = nwg / NXCD, r = nwg % NXCD, xcd = wgid % NXCD, off = wgid / NXCD; wgid = (xcd < r ? xcd * (q + 1) : r * (q + 1) + (xcd - r) * q) + off; }
        const int nig = WGM * nN, gid = wgid / nig, fm = gid * WGM, gsz = (nM - fm) < WGM ? (nM - fm) : WGM;
        u.pm = fm + ((wgid % nig) % gsz); u.pn = (wgid % nig) / gsz; return true;
    }
    __device__ __forceinline__ void a_ready(const Unit&) const {}
    __device__ __forceinline__ void done(const Unit&) const {}
};
__device__ __forceinline__ unsigned cvt_pk_bf16(float lo, float hi) { unsigned r; asm volatile("v_cvt_pk_bf16_f32 %0, %1, %2" : "=v"(r) : "v"(lo), "v"(hi)); return r; }
template <class Epi, class Sched, bool ALIGN_EPI = false, bool SP2 = false>
__device__ __forceinline__ void gemm_phase(PG8_LAS unsigned char* lds, const Gemm g, const Sched& S, const Epi& E) {
    const int tid = threadIdx.x, wid = __builtin_amdgcn_readfirstlane(tid >> 6), lane = tid & 63, wr = wid >> 2, wc = wid & 3, fr = lane & 15, fq = lane >> 4;
    const int K = g.K, nt = K / BK;
    unsigned voffA[2], voffB[2];
#pragma unroll
    for (int i = 0; i < 2; ++i) { int R, C; stage_rc(tid * 16 + i * 8192, R, C); const int Rb = Epi::PERM ? ((R & ~31) + perm32(R & 31)) : R;
        voffA[i] = (unsigned)(R * K + C) * 2u; voffB[i] = (unsigned)(Rb * K + C) * 2u; }
    const size_t kstep = (size_t)(BK * 2);
    const size_t hstep = (size_t)HALF * K * 2;
    const size_t tstep = 2 * hstep;
    const unsigned ldsw = (unsigned)wid * 1024u;
    const int aoff = lds_byte(wr * 64 + fr, fq * 8), boff = lds_byte(wc * 32 + fr, fq * 8);
#define PG8_SA(b, h) (((b) * 2 + (h)) * HTB)
#define PG8_SB(b, h) ((4 + (b) * 2 + (h)) * HTB)
#define PG8_STAGE(bufoff, gbase, voff) do { _Pragma("unroll") for (int _i = 0; _i < 2; ++_i) \
        __builtin_amdgcn_global_load_lds((const unsigned*)((const char*)(gbase) + (voff)[_i]), (PG8_LAS unsigned*)(lds + (bufoff) + ldsw + _i * 8192), 16, 0, 0); } while (0)
#define PG8_LDA(dst, b, h) do { _Pragma("unroll") for (int m = 0; m < 4; ++m) _Pragma("unroll") for (int k = 0; k < 2; ++k) dst[m][k] = *(const PG8_LAS bf16x8*)(lds + PG8_SA(b, h) + aoff + m * 2048 + k * 1024); } while (0)
#define PG8_LDB(dst, b, h) do { _Pragma("unroll") for (int n = 0; n < 2; ++n) _Pragma("unroll") for (int k = 0; k < 2; ++k) dst[n][k] = *(const PG8_LAS bf16x8*)(lds + PG8_SB(b, h) + boff + n * 2048 + k * 1024); } while (0)
#define PG8_MMA(ai, bj, At, Bt) do { __builtin_amdgcn_s_setprio(1); _Pragma("unroll") for (int m = 0; m < 4; ++m) _Pragma("unroll") for (int n = 0; n < 2; ++n) _Pragma("unroll") for (int k = 0; k < 2; ++k) \
        acc[ai][bj][m][n] = __builtin_amdgcn_mfma_f32_16x16x32_bf16(Bt[n][k], At[m][k], acc[ai][bj][m][n], 0, 0, 0); __builtin_amdgcn_s_setprio(0); } while (0)
#define PG8_WAIT_V(n) asm volatile("s_waitcnt vmcnt(" #n ")" ::: "memory")
#define PG8_WAIT_L(n) asm volatile("s_waitcnt lgkmcnt(" #n ")" ::: "memory")
#define PG8_BAR __builtin_amdgcn_s_barrier()
#define PG8_SCHED __builtin_amdgcn_sched_barrier(0)
    Unit cur, nxt; int ui = 0;
    if (!S.next(0, cur)) return;
    f32x4 acc[2][2][4][2];
#pragma unroll
    for (int a = 0; a < 2; ++a)
#pragma unroll
        for (int b = 0; b < 2; ++b)
#pragma unroll
            for (int m = 0; m < 4; ++m)
#pragma unroll
                for (int n = 0; n < 2; ++n) acc[a][b][m][n] = (f32x4){0.f, 0.f, 0.f, 0.f};
    bf16x8 At[4][2], B0[2][2], B1[2][2];
    const char* cA = (const char*)g.A + (size_t)cur.pm * tstep; const char* cB = (const char*)g.Bt + (size_t)cur.pn * tstep;
    S.a_ready(cur);
    if constexpr (SP2) {
        PG8_STAGE(PG8_SB(0, 0), cB, voffB); PG8_STAGE(PG8_SB(0, 1), cB + hstep, voffB); PG8_STAGE(PG8_SA(0, 0), cA, voffA); PG8_STAGE(PG8_SA(0, 1), cA + hstep, voffA);
        if (wr == 1) PG8_BAR;
        PG8_WAIT_V(2); PG8_BAR;
        PG8_STAGE(PG8_SB(1, 0), cB + kstep, voffB); PG8_STAGE(PG8_SA(1, 0), cA + kstep, voffA); PG8_STAGE(PG8_SB(1, 1), cB + hstep + kstep, voffB);
        PG8_WAIT_V(6); PG8_BAR;
    } else {
        PG8_STAGE(PG8_SB(0, 0), cB, voffB); PG8_STAGE(PG8_SA(0, 0), cA, voffA); PG8_STAGE(PG8_SB(0, 1), cB + hstep, voffB); PG8_STAGE(PG8_SA(0, 1), cA + hstep, voffA);
        if (wr == 1) PG8_BAR;
        PG8_WAIT_V(4); PG8_BAR;
        PG8_STAGE(PG8_SB(1, 0), cB + kstep, voffB); PG8_STAGE(PG8_SA(1, 0), cA + kstep, voffA); PG8_STAGE(PG8_SB(1, 1), cB + hstep + kstep, voffB);
        PG8_WAIT_V(6); PG8_BAR;
    }
    for (;;) {
        const bool has_next = S.next(ui + 1, nxt);
        const char* nA = has_next ? (const char*)g.A + (size_t)nxt.pm * tstep : cA; const char* nB = has_next ? (const char*)g.Bt + (size_t)nxt.pn * tstep : cB;
        for (int t = 0; t < nt; t += 2) {
            const bool last = (t == nt - 2);
            const char* a1 = cA + (size_t)(t + 1) * kstep;
            const char* a2 = last ? nA : cA + (size_t)(t + 2) * kstep; const char* b2 = last ? nB : cB + (size_t)(t + 2) * kstep;
            const char* a3 = a2 + kstep; const char* b3 = b2 + kstep;
            if (last && has_next) S.a_ready(nxt);
            if constexpr (SP2) {
            PG8_LDB(B0, 0, 0); PG8_LDB(B1, 0, 1); PG8_SCHED; PG8_LDA(At, 0, 0); PG8_STAGE(PG8_SA(1, 1), a1 + hstep, voffA);
            PG8_WAIT_V(8); PG8_WAIT_L(0); PG8_BAR; PG8_MMA(0, 0, At, B0); PG8_MMA(0, 1, At, B1); PG8_BAR; PG8_SCHED;
            PG8_LDA(At, 0, 1); PG8_STAGE(PG8_SB(0, 0), b2, voffB); PG8_STAGE(PG8_SB(0, 1), b2 + hstep, voffB); PG8_STAGE(PG8_SA(0, 0), a2, voffA);
            PG8_WAIT_V(8); PG8_WAIT_L(0); PG8_BAR; PG8_MMA(1, 0, At, B0); PG8_MMA(1, 1, At, B1); PG8_BAR; PG8_SCHED;
            PG8_LDB(B0, 1, 0); PG8_LDB(B1, 1, 1); PG8_SCHED; PG8_LDA(At, 1, 0); PG8_STAGE(PG8_SA(0, 1), a2 + hstep, voffA);
            PG8_WAIT_V(8); PG8_WAIT_L(0); PG8_BAR; PG8_MMA(0, 0, At, B0); PG8_MMA(0, 1, At, B1); PG8_BAR; PG8_SCHED;
            PG8_LDA(At, 1, 1); PG8_STAGE(PG8_SB(1, 0), b3, voffB); PG8_STAGE(PG8_SB(1, 1), b3 + hstep, voffB); PG8_STAGE(PG8_SA(1, 0), a3, voffA);
            PG8_WAIT_V(8); PG8_WAIT_L(0); PG8_BAR; PG8_MMA(1, 0, At, B0); PG8_MMA(1, 1, At, B1); PG8_BAR; PG8_SCHED;
            } else {
            PG8_LDB(B0, 0, 0); PG8_SCHED; PG8_LDA(At, 0, 0); PG8_STAGE(PG8_SA(1, 1), a1 + hstep, voffA);
            PG8_WAIT_L(8); PG8_BAR; PG8_WAIT_L(0); PG8_MMA(0, 0, At, B0); PG8_BAR; PG8_SCHED;
            PG8_LDB(B1, 0, 1); PG8_STAGE(PG8_SB(0, 0), b2, voffB);
            PG8_BAR; PG8_WAIT_L(0); PG8_MMA(0, 1, At, B1); PG8_BAR;
            PG8_LDA(At, 0, 1); PG8_STAGE(PG8_SA(0, 0), a2, voffA);
            PG8_BAR; PG8_WAIT_L(0); PG8_MMA(1, 0, At, B0); PG8_BAR; PG8_SCHED;
            PG8_STAGE(PG8_SB(0, 1), b2 + hstep, voffB);
            PG8_WAIT_V(6); PG8_BAR; PG8_MMA(1, 1, At, B1); PG8_BAR;
            PG8_LDB(B0, 1, 0); PG8_SCHED; PG8_LDA(At, 1, 0); PG8_STAGE(PG8_SA(0, 1), a2 + hstep, voffA);
            PG8_WAIT_L(8); PG8_BAR; PG8_WAIT_L(0); PG8_MMA(0, 0, At, B0); PG8_BAR; PG8_SCHED;
            PG8_LDB(B1, 1, 1); PG8_STAGE(PG8_SB(1, 0), b3, voffB);
            PG8_BAR; PG8_WAIT_L(0); PG8_MMA(0, 1, At, B1); PG8_BAR;
            PG8_LDA(At, 1, 1); PG8_STAGE(PG8_SA(1, 0), a3, voffA);
            PG8_BAR; PG8_WAIT_L(0); PG8_MMA(1, 0, At, B0); PG8_BAR; PG8_SCHED;
            PG8_STAGE(PG8_SB(1, 1), b3 + hstep, voffB);
            PG8_WAIT_V(6); PG8_BAR; PG8_MMA(1, 1, At, B1); PG8_BAR;
            }
        }
        if constexpr (ALIGN_EPI) { if (wr == 0) PG8_BAR; }
        if constexpr (!Epi::AFTER_DRAIN) { E(acc, cur, wr, wc, fr, fq); S.done(cur); }
        if (!has_next) break;
#pragma unroll
        for (int a = 0; a < 2; ++a)
#pragma unroll
            for (int b = 0; b < 2; ++b)
#pragma unroll
                for (int m = 0; m < 4; ++m)
#pragma unroll
                    for (int n = 0; n < 2; ++n) acc[a][b][m][n] = (f32x4){0.f, 0.f, 0.f, 0.f};
        cur = nxt; cA = nA; cB = nB; ++ui;
        if constexpr (ALIGN_EPI) { if (wr == 1) PG8_BAR; }
    }
    PG8_WAIT_V(0);
    if constexpr (!ALIGN_EPI) { if (wr == 0) PG8_BAR; }
    PG8_BAR;
    if constexpr (Epi::AFTER_DRAIN) { E.fused(acc, cur, wr, wc, fr, fq, lds, wid, lane); S.done(cur); }
#undef PG8_SA
#undef PG8_SB
#undef PG8_STAGE
#undef PG8_LDA
#undef PG8_LDB
#undef PG8_MMA
#undef PG8_WAIT_V
#undef PG8_WAIT_L
#undef PG8_BAR
#undef PG8_SCHED
}
}
#define GAS __attribute__((address_space(1)))
#define LAS __attribute__((address_space(3)))
typedef unsigned short bf16;
typedef unsigned v4u __attribute__((ext_vector_type(4)));
typedef float f32x4 __attribute__((ext_vector_type(4)));
typedef short bf16x8 __attribute__((ext_vector_type(8)));
typedef GAS unsigned gu32;
typedef GAS unsigned long long gu64;
#define RLX_AGENT __ATOMIC_RELAXED, __HIP_MEMORY_SCOPE_AGENT
#define LDS_WAIT() asm volatile("s_waitcnt lgkmcnt(0)" ::: "memory")
#define VM_WAIT() asm volatile("s_waitcnt vmcnt(0)" ::: "memory")
__device__ __forceinline__ unsigned long long rt() { return __builtin_amdgcn_s_memrealtime(); }
__device__ __forceinline__ unsigned f2bf(float f) { unsigned u = __builtin_bit_cast(unsigned, f); return (u + 0x7fffu + ((u >> 16) & 1u)) >> 16; }
__device__ __forceinline__ unsigned pk2(float lo, float hi) { return f2bf(lo) | (f2bf(hi) << 16); }

#define XB_TMO      128
#define XB_XCNT(j)  (256  + 64 * (j))
#define XB_XSUB(j)  (1280 + 64 * (j))
#define XB_XGEN(j)  (2304 + 64 * (j))
#define XB_TOP      3328
#define XB_TOPGEN   3392
#define XCD_BAR_WORDS 3456
#define XB_SPIN_CAP (1u << 18)

__device__ __forceinline__ unsigned xb_ld(unsigned* p)              { return __hip_atomic_load(p, __ATOMIC_RELAXED, __HIP_MEMORY_SCOPE_AGENT); }
__device__ __forceinline__ unsigned xb_add(unsigned* p, unsigned v) { return __hip_atomic_fetch_add(p, v, __ATOMIC_RELAXED, __HIP_MEMORY_SCOPE_AGENT); }
__device__ __forceinline__ unsigned xb_xcc_id() { return (unsigned)__builtin_amdgcn_s_getreg((3 << 11) | 20) & 0xFu; }
#define XB_SPIN(cond, bar) do { unsigned _sp = 0; while (cond) { __builtin_amdgcn_s_sleep(1); \
    if ((++_sp & 255u) == 0u) { if (xb_ld(&(bar)[XB_TMO])) break; if (_sp > XB_SPIN_CAP) { atomicAdd(&(bar)[XB_TMO], 1u); break; } } } } while (0)

struct XcdBarrier {
    unsigned* bar; unsigned x;
    volatile LAS unsigned* st;
};

__device__ __forceinline__ XcdBarrier xcd_barrier_post(unsigned* bar, volatile LAS unsigned* st) {
    XcdBarrier b; b.bar = bar; b.x = xb_xcc_id(); b.st = st;
    if (threadIdx.x == 0) (void)xb_add(&bar[XB_XCNT(b.x)], 1u);
    return b;
}
__device__ __forceinline__ void xcd_barrier_complete(unsigned* bar, unsigned x, unsigned& nloc, unsigned& nx) {
    const unsigned G = gridDim.x * gridDim.y * gridDim.z;
    unsigned sum, cnt, mine, sp = 0u;
    for (;;) {
        sum = 0u; cnt = 0u; mine = 0u;
#pragma unroll
        for (unsigned j = 0; j < 16; ++j) { const unsigned c = xb_ld(&bar[XB_XCNT(j)]); sum += c; cnt += (c > 0u) ? 1u : 0u; mine = (j == x) ? c : mine; }
        if (sum == G) break;
        __builtin_amdgcn_s_sleep(1);
        if ((++sp & 255u) == 0u) { if (xb_ld(&bar[XB_TMO])) break; if (sp > XB_SPIN_CAP) { atomicAdd(&bar[XB_TMO], 1u); break; } }
    }
    nloc = mine > 0u ? mine : 1u; nx = cnt > 0u ? cnt : 1u;
}

__device__ __forceinline__ void xcd_barrier(const XcdBarrier& b) {
    asm volatile("s_waitcnt vmcnt(0)" ::: "memory");
    __syncthreads();
    if (threadIdx.x == 0) {
        unsigned* bar = b.bar;
        __builtin_amdgcn_s_waitcnt(0);
        unsigned nloc = b.st[0], nx = b.st[1];
        if (nloc == 0u) { xcd_barrier_complete(bar, b.x, nloc, nx); b.st[0] = nloc; b.st[1] = nx; }
        const unsigned old = xb_add(&bar[XB_XSUB(b.x)], 1u);
        const unsigned gen = old / nloc;
        if (old + 1u == (gen + 1u) * nloc) {
            __builtin_amdgcn_fence(__ATOMIC_RELEASE, "agent");
            asm volatile("s_waitcnt vmcnt(0)" ::: "memory");
            const unsigned og = xb_add(&bar[XB_TOP], 1u);
            const unsigned tg = og / nx;
            if (og + 1u == (tg + 1u) * nx) xb_add(&bar[XB_TOPGEN], 1u);
            else XB_SPIN(xb_ld(&bar[XB_TOPGEN]) == tg, bar);
            __builtin_amdgcn_fence(__ATOMIC_ACQUIRE, "agent");
            xb_add(&bar[XB_XGEN(b.x)], 1u);
            asm volatile("s_waitcnt vmcnt(0)" ::: "memory");
        } else {
            XB_SPIN(xb_ld(&bar[XB_XGEN(b.x)]) == gen, bar);
            __builtin_amdgcn_fence(__ATOMIC_ACQUIRE, "agent");
            asm volatile("s_waitcnt vmcnt(0)" ::: "memory");
        }
    }
    __syncthreads();
}

constexpr int NWAVES = 8, NTHREADS = NWAVES * 64;
constexpr int BATCH = 8, SEQ = 2048, T = BATCH * SEQ, D = 2048;
constexpr int EV_N = 7200, EV_NP = 7424, OD_N = 7616, OD_NP = 7680, PROJ_LD = 7680;
constexpr float EPS = 1e-6f;
constexpr int EC_GQ = 0, EC_GK = 512, EC_GV = 1024, EC_GZ = 2048, EC_GLR = 3072, EC_BQ = 3088, EC_BK = 4112, EC_BV = 5136, EC_BZ = 6160, EC_BA = 7184, EC_BB = 7192;
constexpr int OC_HQ = 0, OC_HF = 1024, OC_HI = 2048, OC_HG = 3072, OC_RW = 4096;
constexpr int RW_R = 0, RW_K = 1024, RW_V = 2048, RW_WL = 3072, RW_AL = 3168, RW_GL = 3264;
constexpr int LORA_K = 512, LORA_N = 3072;
enum { I_X = 0, I_P, I_EV_WIN, I_GK_W2, I_GK_B, I_GLA_NORM, I_GDN_CONV, I_GDN_ALOG, I_GDN_DTB, I_GDN_NORM, I_EV_WOUT, I_OD_WIN, I_LB, I_HG_NORM,
       I_MU, I_W0, I_W2, I_A0, I_A2, I_G2, I_KK, I_KA, I_RK, I_LNW, I_LNB, I_OD_WOUT, I_NMIX, I_NFFN, I_NPLE, I_PEER_WQ, I_PEER_SK, I_PEER_U, I_PEER_V,
       I_PLE_WP, I_PLE_WG, I_NFINAL, N_IN };

constexpr size_t MiB = 1u << 20;
constexpr size_t WS_CTL = 0, CTL_ZERO_BYTES = 1 * MiB;
constexpr size_t WS_WEV_IN = 1 * MiB, WS_WEV_OUT = 30 * MiB, WS_WOD_IN = 38 * MiB, WS_WOD_OUT = 68 * MiB, WS_WPEER = 76 * MiB, WS_WGATE = 92 * MiB, WS_WPROJ = 108 * MiB,
                 WS_WLORA = 110 * MiB, WS_PBF = 113 * MiB, WS_TABU = 129 * MiB, WS_TABV = 193 * MiB, WS_ACTA = 257 * MiB, WS_ACTB = 321 * MiB, WS_PROJ = 385 * MiB, WS_SC = 385 * MiB,
                 WS_O = 625 * MiB, WS_PP = 753 * MiB, WS_LA = 817 * MiB, WS_LO = 833 * MiB, WS_RSP = 929 * MiB, WS_STATE = 937 * MiB, WS_END = 945 * MiB;
static_assert(WS_WEV_IN + (size_t)EV_NP * D * 2 <= WS_WEV_OUT && WS_WOD_IN + (size_t)OD_NP * D * 2 <= WS_WOD_OUT && WS_PROJ + (size_t)T * PROJ_LD * 2 <= WS_O, "ws map");
constexpr int CW_BAR = 4096;
enum { RS_FFN0 = 0, RS_MIX1 = 1, RS_FFN1 = 2, RS_FINAL = 3 };
constexpr int RING_OFF = 0, RING_BYTES = 131072;
constexpr int LDSCTL_OFF = RING_BYTES, MISC_OFF = LDSCTL_OFF + 320;
constexpr int LDS_BYTES = 147456;

struct Args { const float* in[N_IN]; float* out; unsigned char* ws; int ph_lo, ph_hi; };
struct Frame {
    LAS unsigned char* lds; volatile LAS unsigned* MISC; gu32* ctl;
    int tid, lane, wave, vcu, G;
};
__device__ __forceinline__ float wave_sum(float v) {
#pragma unroll
    for (int o = 1; o < 64; o <<= 1) v += __shfl_xor(v, o);
    return v;
}
__device__ __forceinline__ float half_sum32(float v) {
#pragma unroll
    for (int o = 1; o < 32; o <<= 1) v += __shfl_xor(v, o);
    return v;
}
#define DPP_ADD(v, ctrl) (v) += __builtin_bit_cast(float, __builtin_amdgcn_update_dpp(0, __builtin_bit_cast(int, (v)), (ctrl), 0xF, 0xF, false))
__device__ __forceinline__ float row_sum16(float v) {
    DPP_ADD(v, 0x128); DPP_ADD(v, 0x124); DPP_ADD(v, 0x122); DPP_ADD(v, 0x121);
    return v;
}
__device__ __forceinline__ void row_sum16_x4(float& a, float& b, float& c, float& d) {
    asm("s_nop 1\n\t"
        "v_add_f32_dpp %0, %0, %0 row_ror:8 row_mask:0xf bank_mask:0xf\n\tv_add_f32_dpp %1, %1, %1 row_ror:8 row_mask:0xf bank_mask:0xf\n\t"
        "v_add_f32_dpp %2, %2, %2 row_ror:8 row_mask:0xf bank_mask:0xf\n\tv_add_f32_dpp %3, %3, %3 row_ror:8 row_mask:0xf bank_mask:0xf\n\t"
        "v_add_f32_dpp %0, %0, %0 row_ror:4 row_mask:0xf bank_mask:0xf\n\tv_add_f32_dpp %1, %1, %1 row_ror:4 row_mask:0xf bank_mask:0xf\n\t"
        "v_add_f32_dpp %2, %2, %2 row_ror:4 row_mask:0xf bank_mask:0xf\n\tv_add_f32_dpp %3, %3, %3 row_ror:4 row_mask:0xf bank_mask:0xf\n\t"
        "v_add_f32_dpp %0, %0, %0 row_ror:2 row_mask:0xf bank_mask:0xf\n\tv_add_f32_dpp %1, %1, %1 row_ror:2 row_mask:0xf bank_mask:0xf\n\t"
        "v_add_f32_dpp %2, %2, %2 row_ror:2 row_mask:0xf bank_mask:0xf\n\tv_add_f32_dpp %3, %3, %3 row_ror:2 row_mask:0xf bank_mask:0xf\n\t"
        "v_add_f32_dpp %0, %0, %0 row_ror:1 row_mask:0xf bank_mask:0xf\n\tv_add_f32_dpp %1, %1, %1 row_ror:1 row_mask:0xf bank_mask:0xf\n\t"
        "v_add_f32_dpp %2, %2, %2 row_ror:1 row_mask:0xf bank_mask:0xf\n\tv_add_f32_dpp %3, %3, %3 row_ror:1 row_mask:0xf bank_mask:0xf\n\t"
        "s_nop 1"
        : "+v"(a), "+v"(b), "+v"(c), "+v"(d));
}
__device__ __forceinline__ void row_sum16_x2(float& a, float& b) {
    asm("s_nop 1\n\t"
        "v_add_f32_dpp %0, %0, %0 row_ror:8 row_mask:0xf bank_mask:0xf\n\tv_add_f32_dpp %1, %1, %1 row_ror:8 row_mask:0xf bank_mask:0xf\n\ts_nop 1\n\t"
        "v_add_f32_dpp %0, %0, %0 row_ror:4 row_mask:0xf bank_mask:0xf\n\tv_add_f32_dpp %1, %1, %1 row_ror:4 row_mask:0xf bank_mask:0xf\n\ts_nop 1\n\t"
        "v_add_f32_dpp %0, %0, %0 row_ror:2 row_mask:0xf bank_mask:0xf\n\tv_add_f32_dpp %1, %1, %1 row_ror:2 row_mask:0xf bank_mask:0xf\n\ts_nop 1\n\t"
        "v_add_f32_dpp %0, %0, %0 row_ror:1 row_mask:0xf bank_mask:0xf\n\tv_add_f32_dpp %1, %1, %1 row_ror:1 row_mask:0xf bank_mask:0xf\n\t"
        "s_nop 1"
        : "+v"(a), "+v"(b));
}
#define LBAR() do { asm volatile("s_waitcnt lgkmcnt(0)" ::: "memory"); __builtin_amdgcn_s_barrier(); asm volatile("" ::: "memory"); } while (0)
typedef float f32x2 __attribute__((ext_vector_type(2)));
typedef __bf16 hwbf16x2_t __attribute__((ext_vector_type(2)));
__device__ __forceinline__ unsigned hw_pk2(float lo, float hi) { const f32x2 v = {lo, hi}; return __builtin_bit_cast(unsigned, __builtin_convertvector(v, hwbf16x2_t)); }
__device__ __forceinline__ bf16 hw_bf(float x) { return (bf16)hw_pk2(x, 0.f); }
__device__ __forceinline__ float bf_lo(unsigned w) { return __uint_as_float(w << 16); }
__device__ __forceinline__ float bf_hi(unsigned w) { return __uint_as_float(w & 0xffff0000u); }
__device__ __forceinline__ float sigmoidf_(float x) { return __builtin_amdgcn_rcpf(1.0f + __expf(-x)); }
__device__ __forceinline__ float siluf_(float x) { return x * __builtin_amdgcn_rcpf(1.0f + __expf(-x)); }
__device__ __forceinline__ float softplusf_(float x) { return fmaxf(x, 0.f) + log1pf(__expf(-fabsf(x))); }
__device__ __forceinline__ float logsigmoidf_(float x) { return fminf(x, 0.f) - log1pf(__expf(-fabsf(x))); }

struct EpiBf16S {
    static constexpr bool PERM = true, AFTER_DRAIN = false;
    bf16* O; int ldc; const float* rowss;
    __device__ __forceinline__ void operator()(const pg8::f32x4 (&acc)[2][2][4][2], const pg8::Unit& u, int wr, int wc, int fr, int fq) const {
        const int row0 = u.pm * 256 + wr * 64 + fr, col0 = u.pn * 256 + wc * 32 + 8 * fq;
#pragma unroll
        for (int ai = 0; ai < 2; ++ai)
#pragma unroll
            for (int m = 0; m < 4; ++m) {
                const int row = row0 + ai * 128 + m * 16;
                float sc = 1.f;
                if (rowss) { const pg8::f32x4* rp = (const pg8::f32x4*)(rowss + (size_t)row * 32 + 8 * fq); const pg8::f32x4 p0 = rp[0], p1 = rp[1];
                    float s = ((p0[0] + p0[1]) + (p0[2] + p0[3])) + ((p1[0] + p1[1]) + (p1[2] + p1[3])); s += __shfl_xor(s, 16); s += __shfl_xor(s, 32);
                    sc = __builtin_amdgcn_rsqf(s * (1.0f / D) + EPS); }
                bf16* rowp = O + (size_t)row * ldc + col0;
#pragma unroll
                for (int bj = 0; bj < 2; ++bj) { const pg8::f32x4 v0 = acc[ai][bj][m][0] * sc, v1 = acc[ai][bj][m][1] * sc;
                    pg8::u32x4 w; w.x = pg8::cvt_pk_bf16(v0[0], v0[1]); w.y = pg8::cvt_pk_bf16(v0[2], v0[3]); w.z = pg8::cvt_pk_bf16(v1[0], v1[1]); w.w = pg8::cvt_pk_bf16(v1[2], v1[3]);
                    *(pg8::u32x4*)(rowp + bj * 128) = w; } }
    }
};
template <bool GATE> struct EpiResid {
    static constexpr bool PERM = false, AFTER_DRAIN = false;
    const float* hin; float* hout; bf16* hg; const float* gain; float* rowss; const bf16* pp;
    __device__ __forceinline__ void operator()(const pg8::f32x4 (&acc)[2][2][4][2], const pg8::Unit& u, int wr, int wc, int fr, int fq) const {
        const int row0 = u.pm * 256 + wr * 64 + fr, col0 = u.pn * 256 + wc * 32 + 4 * fq;
        pg8::f32x4 gv[2][2];
#pragma unroll
        for (int bj = 0; bj < 2; ++bj)
#pragma unroll
            for (int n = 0; n < 2; ++n) gv[bj][n] = hg ? *(const pg8::f32x4*)(gain + col0 + bj * 128 + n * 16) : (pg8::f32x4){0.f, 0.f, 0.f, 0.f};
#pragma unroll
        for (int ai = 0; ai < 2; ++ai)
#pragma unroll
            for (int m = 0; m < 4; ++m) {
                const int row = row0 + ai * 128 + m * 16; const size_t off = (size_t)row * D + col0; float ss = 0.f;
#pragma unroll
                for (int bj = 0; bj < 2; ++bj)
#pragma unroll
                    for (int n = 0; n < 2; ++n) { const size_t o = off + bj * 128 + n * 16;
                        pg8::f32x4 hv = *(const pg8::f32x4*)(hin + o); pg8::f32x4 a = acc[ai][bj][m][n];
                        if (GATE) { const pg8::u32x2 pw = *(const pg8::u32x2*)(pp + o);
                            a[0] = sigmoidf_(a[0]) * bf_lo(pw.x); a[1] = sigmoidf_(a[1]) * bf_hi(pw.x); a[2] = sigmoidf_(a[2]) * bf_lo(pw.y); a[3] = sigmoidf_(a[3]) * bf_hi(pw.y); }
                        hv = hv + a; *(pg8::f32x4*)(hout + o) = hv;
                        ss += (hv[0] * hv[0] + hv[1] * hv[1]) + (hv[2] * hv[2] + hv[3] * hv[3]);
                        if (hg) { const pg8::f32x4 q = hv * gv[bj][n]; pg8::u32x2 w; w.x = pg8::cvt_pk_bf16(q[0], q[1]); w.y = pg8::cvt_pk_bf16(q[2], q[3]); *(pg8::u32x2*)(hg + o) = w; } }
                ss += __shfl_xor(ss, 16); ss += __shfl_xor(ss, 32);
                if (fq == 0) rowss[(size_t)row * 32 + u.pn * 4 + wc] = ss;
                asm volatile("" ::: "memory"); }
    }
};

__device__ __forceinline__ void p0_transpose_item(const float* W, int K, int N, bf16* WT, LAS float* scr, int item, int lane) {
    const int nblk = N / 32, kb = item / nblk, nb = item % nblk, k0 = 64 * kb, n0 = 32 * nb;
    { const GAS float* Wg = (const GAS float*)W + (size_t)(k0 + (lane >> 5)) * N + n0 + (lane & 31); float v[32];
#pragma unroll
      for (int i = 0; i < 32; ++i) v[i] = Wg[(size_t)(2 * i) * N];
#pragma unroll
      for (int i = 0; i < 32; ++i) scr[(2 * i + (lane >> 5)) * 33 + (lane & 31)] = v[i]; }
    LDS_WAIT(); asm volatile("" ::: "memory");
    const int c = lane & 7;
#pragma unroll
    for (int j = 0; j < 4; ++j) { const int n = (lane >> 3) + 8 * j; const LAS float* s = scr + (8 * c) * 33 + n;
        v4u o; o.x = pk2(s[0 * 33], s[1 * 33]); o.y = pk2(s[2 * 33], s[3 * 33]); o.z = pk2(s[4 * 33], s[5 * 33]); o.w = pk2(s[6 * 33], s[7 * 33]);
        *(GAS v4u*)(WT + (size_t)(n0 + n) * K + k0 + 8 * c) = o; }
    LDS_WAIT(); asm volatile("" ::: "memory");
}
__device__ __forceinline__ void cvt_f32_bf16(const float* src, bf16* dst, size_t n, int gtid, int gthreads) {
    const size_t n8 = n / 8;
    for (size_t i = gtid; i < n8; i += gthreads) {
        const f32x4 a = *(const GAS f32x4*)(src + i * 8), b = *(const GAS f32x4*)(src + i * 8 + 4);
        v4u o; o.x = pk2(a[0], a[1]); o.y = pk2(a[2], a[3]); o.z = pk2(b[0], b[1]); o.w = pk2(b[2], b[3]);
        *(GAS v4u*)(dst + i * 8) = o; }
}
__device__ __forceinline__ void cvt_f32_fp8(const float* src, unsigned char* dst, size_t n, float scale, int gtid, int gthreads) {
    const size_t n16 = n / 16;
    for (size_t i = gtid; i < n16; i += gthreads) { v4u o; unsigned w[4];
#pragma unroll
        for (int q = 0; q < 4; ++q) { const f32x4 a = *(const GAS f32x4*)(src + i * 16 + 4 * q) * scale;
            int x = __builtin_amdgcn_cvt_pk_fp8_f32(a[0], a[1], 0, false); x = __builtin_amdgcn_cvt_pk_fp8_f32(a[2], a[3], x, true); w[q] = (unsigned)x; }
        o.x = w[0]; o.y = w[1]; o.z = w[2]; o.w = w[3];
        *(GAS v4u*)(dst + i * 16) = o; }
}
__device__ __forceinline__ void rms_row_to_bf16(const float* xrow, const float* g, bf16* orow, int lane) {
    const GAS f32x4* xr = (const GAS f32x4*)xrow + lane; f32x4 v[8]; float s = 0.f;
#pragma unroll
    for (int j = 0; j < 8; ++j) { v[j] = xr[64 * j]; s += (v[j][0] * v[j][0] + v[j][1] * v[j][1]) + (v[j][2] * v[j][2] + v[j][3] * v[j][3]); }
    const float r = __builtin_amdgcn_rsqf(wave_sum(s) * (1.0f / D) + EPS);
    const GAS f32x4* gr = (const GAS f32x4*)g + lane;
    GAS unsigned long long* o8 = (GAS unsigned long long*)orow + lane;
#pragma unroll
    for (int j = 0; j < 8; ++j) { const f32x4 gg = gr[64 * j]; o8[64 * j] = (unsigned long long)pk2(v[j][0] * r * gg[0], v[j][1] * r * gg[1]) | ((unsigned long long)pk2(v[j][2] * r * gg[2], v[j][3] * r * gg[3]) << 32); }
}
__device__ __forceinline__ void p0_fold_item(const float* wq, const float* sk, bf16* WP, LAS float* lds, int item, int tid) {
    const int hp = item >> 5, k0 = (item & 31) * 64;
    LAS float* skT = lds;
    LAS float* wqT = lds + 128 * 132;
    const float* skb = sk + (size_t)hp * 128 * 128;
#pragma unroll 4
    for (int i = 0; i < 32; ++i) { const int idx = i * 512 + tid, n = idx >> 7, d = idx & 127; skT[d * 132 + n] = skb[idx]; }
#pragma unroll 4
    for (int i = 0; i < 16; ++i) { const int idx = i * 512 + tid, kk = idx >> 7, d = idx & 127; wqT[d * 68 + kk] = wq[(size_t)(k0 + kk) * D + hp * 128 + d]; }
    __syncthreads();
    const int n0 = (tid >> 4) * 4, kk0 = (tid & 15) * 4;
    float acc[4][4];
#pragma unroll
    for (int i = 0; i < 4; ++i)
#pragma unroll
        for (int j = 0; j < 4; ++j) acc[i][j] = 0.f;
#pragma unroll 4
    for (int d = 0; d < 128; ++d) { const f32x4 a = *(const LAS f32x4*)(skT + d * 132 + n0), b = *(const LAS f32x4*)(wqT + d * 68 + kk0);
#pragma unroll
        for (int i = 0; i < 4; ++i)
#pragma unroll
            for (int j = 0; j < 4; ++j) acc[i][j] += a[i] * b[j]; }
#pragma unroll
    for (int i = 0; i < 4; ++i) { unsigned long long o = (unsigned long long)pk2(acc[i][0], acc[i][1]) | ((unsigned long long)pk2(acc[i][2], acc[i][3]) << 32);
        *(GAS unsigned long long*)(WP + (size_t)(hp * 128 + n0 + i) * D + k0 + kk0) = o; }
    __syncthreads();
}
__device__ __forceinline__ void p0_prologue(const Args& A, Frame& F) {
    const int gw = F.vcu * NWAVES + F.wave, NGW = F.G * NWAVES;
    const int gtid = gw * 64 + F.lane, gthreads = F.G * NTHREADS;
    unsigned char* ws = A.ws;
    LAS float* scr = (LAS float*)(F.lds + RING_OFF + F.wave * 16384);
    constexpr int I_EVIN = (D / 64) * (EV_N / 32);
    for (int it = gw; it < I_EVIN; it += NGW) p0_transpose_item(A.in[I_EV_WIN], D, EV_N, (bf16*)(ws + WS_WEV_IN), scr, it, F.lane);
    { GAS v4u* z0 = (GAS v4u*)(ws + WS_WEV_IN + (size_t)EV_N * D * 2); const size_t n0 = (size_t)(EV_NP - EV_N) * D * 2 / 16;
      for (size_t i = gtid; i < n0; i += gthreads) z0[i] = (v4u){0u, 0u, 0u, 0u}; }
    for (int m = gw; m < T; m += NGW) rms_row_to_bf16(A.in[I_X] + (size_t)m * D, A.in[I_NMIX], (bf16*)(ws + WS_ACTA) + (size_t)m * D, F.lane);
}
__device__ __forceinline__ void p0_deferred(const Args& A, Frame& F, int wg, int nwg) {
    const int gw = wg * NWAVES + F.wave, NGW = nwg * NWAVES;
    int gtid = gw * 64 + F.lane; const int gthreads = nwg * NTHREADS;
    asm volatile("" : "+v"(gtid));
    unsigned char* ws = A.ws;
    {
        LAS float* scr = (LAS float*)(F.lds + RING_OFF + F.wave * 16384);
        constexpr int I_SQ = (D / 64) * (D / 32), I_ODIN = (D / 64) * (OD_N / 32), I_PJ = (256 / 64) * (D / 32);
        constexpr int NITEMS = I_SQ + I_ODIN + I_SQ + 2 * I_PJ;
        for (int it = gw; it < NITEMS; it += NGW) {
            int r = it;
            if (r < I_SQ) { p0_transpose_item(A.in[I_EV_WOUT], D, D, (bf16*)(ws + WS_WEV_OUT), scr, r, F.lane); continue; } r -= I_SQ;
            if (r < I_ODIN) { p0_transpose_item(A.in[I_OD_WIN], D, OD_N, (bf16*)(ws + WS_WOD_IN), scr, r, F.lane); continue; } r -= I_ODIN;
            if (r < I_SQ) { p0_transpose_item(A.in[I_PLE_WG], D, D, (bf16*)(ws + WS_WGATE), scr, r, F.lane); continue; } r -= I_SQ;
            { const int L = r / I_PJ; p0_transpose_item(A.in[I_PLE_WP] + (size_t)L * 256 * D, 256, D, (bf16*)(ws + WS_WPROJ) + (size_t)L * D * 256, scr, r % I_PJ, F.lane); }
        }
        { GAS v4u* z1 = (GAS v4u*)(ws + WS_WOD_IN + (size_t)OD_N * D * 2); const size_t n1 = (size_t)(OD_NP - OD_N) * D * 2 / 16;
          for (size_t i = gtid; i < n1; i += gthreads) z1[i] = (v4u){0u, 0u, 0u, 0u}; }
    }
    __syncthreads();
    for (int it = wg; it < 512; it += nwg)
        p0_fold_item(A.in[I_PEER_WQ], A.in[I_PEER_SK], (bf16*)(ws + WS_WPEER), (LAS float*)(F.lds + RING_OFF), it, F.tid);
    cvt_f32_fp8(A.in[I_PEER_U], (unsigned char*)(ws + WS_TABU), (size_t)16384 * D, 512.0f, gtid, gthreads);
    cvt_f32_fp8(A.in[I_PEER_V], (unsigned char*)(ws + WS_TABV), (size_t)16384 * D, 16.0f, gtid, gthreads);
    cvt_f32_bf16(A.in[I_P], (bf16*)(ws + WS_PBF), (size_t)2 * T * 256, gtid, gthreads);
    { bf16* LB = (bf16*)(ws + WS_WLORA); const float* w2 = A.in[I_W2]; const float* a2 = A.in[I_A2]; const float* g2 = A.in[I_G2];
      for (int i = gtid; i < LORA_N * LORA_K / 2; i += gthreads) { const int row = i / (LORA_K / 2), col = (i % (LORA_K / 2)) * 2; float v[2];
#pragma unroll
          for (int e = 0; e < 2; ++e) { const int c = col + e; float x = 0.f;
              if (row < 1024) { if (c < 96) x = w2[c * 1024 + row]; }
              else if (row < 2048) { if (c >= 96 && c < 192) x = a2[(c - 96) * 1024 + (row - 1024)]; }
              else { if (c >= 192 && c < 448) x = g2[(c - 192) * 1024 + (row - 2048)]; }
              v[e] = x; }
          *(GAS unsigned*)(LB + (size_t)row * LORA_K + col) = pk2(v[0], v[1]); } }
}
__device__ __forceinline__ void p1_deferred(const Args& A, Frame& F, int wg, int nwg) {
    const int gw = wg * NWAVES + F.wave, NGW = nwg * NWAVES;
    int gtid = gw * 64 + F.lane; const int gthreads = nwg * NTHREADS;
    asm volatile("" : "+v"(gtid));
    unsigned char* ws = A.ws;
    { LAS float* scr = (LAS float*)(F.lds + RING_OFF + F.wave * 16384); constexpr int I_SQ = (D / 64) * (D / 32);
      for (int it = gw; it < 2 * I_SQ; it += NGW) {
          if (it < I_SQ) p0_transpose_item(A.in[I_OD_WOUT], D, D, (bf16*)(ws + WS_WOD_OUT), scr, it, F.lane);
          else p0_transpose_item(A.in[I_PLE_WG] + (size_t)D * D, D, D, (bf16*)(ws + WS_WGATE) + (size_t)D * D, scr, it - I_SQ, F.lane); } }
    __syncthreads();
    for (int it = wg; it < 512; it += nwg)
        p0_fold_item(A.in[I_PEER_WQ] + (size_t)D * D, A.in[I_PEER_SK] + (size_t)16 * 128 * 128, (bf16*)(ws + WS_WPEER) + (size_t)D * D, (LAS float*)(F.lds + RING_OFF), it, F.tid);
    cvt_f32_fp8(A.in[I_PEER_U] + (size_t)16384 * D, (unsigned char*)(ws + WS_TABU) + (size_t)16384 * D, (size_t)16384 * D, 512.0f, gtid, gthreads);
    cvt_f32_fp8(A.in[I_PEER_V] + (size_t)16384 * D, (unsigned char*)(ws + WS_TABV) + (size_t)16384 * D, (size_t)16384 * D, 16.0f, gtid, gthreads);
}

constexpr int TC = 16, NCHUNK = SEQ / TC;
typedef unsigned u32x2 __attribute__((ext_vector_type(2)));

template <int MODE>
__device__ __forceinline__ void scan_gla_unit(const Args& A, Frame& F, int unit) {
    int tid = F.tid; asm volatile("" : "+v"(tid));
    const int lane = tid & 63, w = F.wave;
    int b, h, qcol, kcol, vcol, ocol;
    if (MODE == 0) { b = unit >> 4; h = (unit >> 2) & 3; const int s = unit & 3; qcol = EC_GQ + h * 128; kcol = EC_GK + h * 128; vcol = EC_GV + h * 256 + s * 64; ocol = h * 256 + s * 64; }
    else           { b = unit >> 4; h = (unit >> 1) & 7; const int s = unit & 1; qcol = OC_HQ + h * 128; kcol = OC_HF + h * 128; vcol = OC_HI + h * 128 + s * 64; ocol = h * 128 + s * 64; }
    const bf16* P = (const bf16*)(A.ws + WS_PROJ) + (size_t)b * SEQ * PROJ_LD;
    float* O = (float*)(A.ws + WS_O) + (size_t)b * SEQ * D + ocol;
    LAS float* Lf = (LAS float*)(F.lds + RING_OFF);
    constexpr int BUFSZ = 7168, O_EG = 0, O_K = 2048, O_Q = 4096, O_V = 6144, O_OUT = 2 * BUFSZ, O_W2 = O_OUT + 1024, O_BIAS = O_W2 + 2048;
    const int tl = tid >> 5, dq = (tid & 31) * 4, tlv = tid >> 4, c4 = (tid & 15) * 4;
    float lb[4] = {0.f, 0.f, 0.f, 0.f};
    if (MODE == 0) {
        const float* w2 = A.in[I_GK_W2]; const float* gb = A.in[I_GK_B];
        for (int i = tid; i < 2048; i += NTHREADS) Lf[O_W2 + i] = w2[(i >> 7) * 512 + h * 128 + (i & 127)];
        if (tid < 128) Lf[O_BIAS + tid] = gb[h * 128 + tid];
    } else {
        const float* lg = A.in[I_LB];
#pragma unroll
        for (int i = 0; i < 4; ++i) lb[i] = sigmoidf_(lg[1024 + h * 128 + dq + i] - lg[h * 128 + dq + i]);
    }
    u32x2 rq, rk, rv = {0u, 0u}; v4u rg0 = {0u, 0u, 0u, 0u}, rg1 = {0u, 0u, 0u, 0u};
#define GLA_LOAD(c) do { const bf16* pr = P + (size_t)((c) * TC + tl) * PROJ_LD; rq = *(const GAS u32x2*)(pr + qcol + dq); rk = *(const GAS u32x2*)(pr + kcol + dq); \
        if (MODE == 0) { rg0 = *(const GAS v4u*)(pr + EC_GLR); rg1 = *(const GAS v4u*)(pr + EC_GLR + 8); } \
        if (tid < 256) rv = *(const GAS u32x2*)(P + (size_t)((c) * TC + tlv) * PROJ_LD + vcol + c4); } while (0)
#define GLA_XFORM(bufi) do { LAS float* B_ = Lf + (bufi) * BUFSZ; f32x4 q4, k4, e4; \
        const float xq[4] = {bf_lo(rq.x), bf_hi(rq.x), bf_lo(rq.y), bf_hi(rq.y)}, xk[4] = {bf_lo(rk.x), bf_hi(rk.x), bf_lo(rk.y), bf_hi(rk.y)}; \
        if (MODE == 0) { f32x4 z = *(const LAS f32x4*)(Lf + O_BIAS + dq); \
            const float gl[16] = {bf_lo(rg0.x), bf_hi(rg0.x), bf_lo(rg0.y), bf_hi(rg0.y), bf_lo(rg0.z), bf_hi(rg0.z), bf_lo(rg0.w), bf_hi(rg0.w), \
                                  bf_lo(rg1.x), bf_hi(rg1.x), bf_lo(rg1.y), bf_hi(rg1.y), bf_lo(rg1.z), bf_hi(rg1.z), bf_lo(rg1.w), bf_hi(rg1.w)}; \
            _Pragma("unroll") for (int r_ = 0; r_ < 16; ++r_) { const f32x4 wv = *(const LAS f32x4*)(Lf + O_W2 + r_ * 128 + dq); z = z + wv * gl[r_]; } \
            _Pragma("unroll") for (int i_ = 0; i_ < 4; ++i_) { q4[i_] = xq[i_] * 0.08838834764831845f; k4[i_] = xk[i_]; e4[i_] = __builtin_amdgcn_exp2f(-0.0625f * __builtin_amdgcn_logf(1.0f + __expf(-z[i_]))); } } \
        else { _Pragma("unroll") for (int i_ = 0; i_ < 4; ++i_) { const float fg = lb[i_] + (1.f - lb[i_]) * sigmoidf_(xk[i_]); q4[i_] = siluf_(xq[i_]); k4[i_] = 1.f - fg; e4[i_] = fg; } } \
        *(LAS f32x4*)(B_ + O_EG + tl * 128 + dq) = e4; *(LAS f32x4*)(B_ + O_K + tl * 128 + dq) = k4; *(LAS f32x4*)(B_ + O_Q + tl * 128 + dq) = q4; \
        if (tid < 256) { f32x4 v4 = {bf_lo(rv.x), bf_hi(rv.x), bf_lo(rv.y), bf_hi(rv.y)}; *(LAS f32x4*)(B_ + O_V + tlv * 64 + c4) = v4; } } while (0)
    LBAR();
    GLA_LOAD(0); GLA_XFORM(0);
    LBAR();
    f32x2 S2[8];
#pragma unroll
    for (int i = 0; i < 8; ++i) S2[i] = (f32x2){0.f, 0.f};
    const int j = lane & 15, col = w * 8 + (lane >> 4) * 2;
    for (int c = 0; c < NCHUNK; ++c) {
        if (c + 1 < NCHUNK) GLA_LOAD(c + 1);
        const LAS float* B_ = Lf + (c & 1) * BUFSZ;
        float os0 = 0.f, os1 = 0.f;
        f32x4 e0, e1, k0, k1, q0, q1, ne0, ne1, nk0, nk1, nq0, nq1; f32x2 v2, nv2;
#define GLA_LDSTEP(t_, E0, E1, K0, K1, Q0, Q1, V2) do { E0 = *(const LAS f32x4*)(B_ + O_EG + (t_) * 128 + 4 * j); E1 = *(const LAS f32x4*)(B_ + O_EG + (t_) * 128 + 64 + 4 * j); \
            K0 = *(const LAS f32x4*)(B_ + O_K + (t_) * 128 + 4 * j); K1 = *(const LAS f32x4*)(B_ + O_K + (t_) * 128 + 64 + 4 * j); \
            Q0 = *(const LAS f32x4*)(B_ + O_Q + (t_) * 128 + 4 * j); Q1 = *(const LAS f32x4*)(B_ + O_Q + (t_) * 128 + 64 + 4 * j); V2 = *(const LAS f32x2*)(B_ + O_V + (t_) * 64 + col); } while (0)
        GLA_LDSTEP(0, e0, e1, k0, k1, q0, q1, v2);
#pragma unroll
        for (int t = 0; t < TC; ++t) {
            if (t + 1 < TC) { GLA_LDSTEP(t + 1, ne0, ne1, nk0, nk1, nq0, nq1, nv2); }
            __builtin_amdgcn_sched_barrier(0);
            f32x2 pa = {0.f, 0.f}, pb = {0.f, 0.f};
#pragma unroll
            for (int i = 0; i < 4; ++i) {
                S2[i] = S2[i] * e0[i] + v2 * k0[i]; S2[4 + i] = S2[4 + i] * e1[i] + v2 * k1[i];
                pa += S2[i] * q0[i]; pb += S2[4 + i] * q1[i]; }
            pa += pb;
            float p0 = pa[0], p1 = pa[1];
            row_sum16_x2(p0, p1);
            os0 = (j == t) ? p0 : os0; os1 = (j == t) ? p1 : os1;
            e0 = ne0; e1 = ne1; k0 = nk0; k1 = nk1; q0 = nq0; q1 = nq1; v2 = nv2;
        }
#undef GLA_LDSTEP
        { f32x2 o2 = {os0, os1}; *(LAS f32x2*)(Lf + O_OUT + j * 64 + col) = o2; }
        if (c + 1 < NCHUNK) GLA_XFORM((c + 1) & 1);
        LBAR();
        if (tid < 256) *(GAS f32x4*)(O + (size_t)(c * TC + tlv) * D + c4) = *(const LAS f32x4*)(Lf + O_OUT + tlv * 64 + c4);
        LBAR();
    }
#undef GLA_LOAD
#undef GLA_XFORM
}

__device__ __forceinline__ void scan_gdn_unit(const Args& A, Frame& F, int unit) {
    int tid = F.tid; asm volatile("" : "+v"(tid));
    const int lane = tid & 63, w = F.wave;
    const int b = unit >> 4, h = (unit >> 1) & 7, s = unit & 1;
    const int qcol = EC_BQ + h * 128, kcol = EC_BK + h * 128, vcol = EC_BV + h * 128 + s * 64, ocol = 1024 + h * 128 + s * 64;
    const bf16* P = (const bf16*)(A.ws + WS_PROJ) + (size_t)b * SEQ * PROJ_LD;
    float* O = (float*)(A.ws + WS_O) + (size_t)b * SEQ * D + ocol;
    LAS float* Lf = (LAS float*)(F.lds + RING_OFF);
    constexpr int BUFSZ = 5184, O_K = 0, O_Q = 2048, O_V = 4096, O_SC = 5120, O_OUT = 2 * BUFSZ, O_CW = O_OUT + 1024;
    const int tl = tid >> 5, dq = (tid & 31) * 4, tlv = tid >> 4, c4 = (tid & 15) * 4;
    { const float* cw = A.in[I_GDN_CONV];
      for (int i = tid; i < 4 * 320; i += NTHREADS) { const int jt = i / 320, x = i % 320;
          const int ch = x < 128 ? (h * 128 + x) : x < 256 ? (1024 + h * 128 + (x - 128)) : (2048 + h * 128 + s * 64 + (x - 256));
          Lf[O_CW + i] = cw[jt * 3072 + ch]; } }
    const float neg_ea = -__expf(A.in[I_GDN_ALOG][h]), dtb = A.in[I_GDN_DTB][h];
    u32x2 rq[4], rk[4], rv[4]; unsigned short rba = 0, rbb = 0;
#pragma unroll
    for (int i = 0; i < 4; ++i) rv[i] = (u32x2){0u, 0u};
#define GDN_LOAD(c) do { const int t_ = (c) * TC + tl; \
        _Pragma("unroll") for (int jt = 0; jt < 4; ++jt) { const int tt = t_ - 3 + jt; \
            if (tt >= 0) { const bf16* pr = P + (size_t)tt * PROJ_LD; rq[jt] = *(const GAS u32x2*)(pr + qcol + dq); rk[jt] = *(const GAS u32x2*)(pr + kcol + dq); } \
            else { rq[jt] = (u32x2){0u, 0u}; rk[jt] = (u32x2){0u, 0u}; } } \
        { const bf16* pr = P + (size_t)t_ * PROJ_LD; rba = pr[EC_BA + h]; rbb = pr[EC_BB + h]; } \
        if (tid < 256) { const int tv = (c) * TC + tlv; \
            _Pragma("unroll") for (int jt = 0; jt < 4; ++jt) { const int tt = tv - 3 + jt; \
                if (tt >= 0) rv[jt] = *(const GAS u32x2*)(P + (size_t)tt * PROJ_LD + vcol + c4); else rv[jt] = (u32x2){0u, 0u}; } } } while (0)
#define GDN_XFORM(bufi) do { LAS float* B_ = Lf + (bufi) * BUFSZ; f32x4 q4 = {0.f, 0.f, 0.f, 0.f}, k4 = {0.f, 0.f, 0.f, 0.f}; \
        _Pragma("unroll") for (int jt = 0; jt < 4; ++jt) { const f32x4 wq = *(const LAS f32x4*)(Lf + O_CW + jt * 320 + dq), wk = *(const LAS f32x4*)(Lf + O_CW + jt * 320 + 128 + dq); \
            q4[0] += wq[0] * bf_lo(rq[jt].x); q4[1] += wq[1] * bf_hi(rq[jt].x); q4[2] += wq[2] * bf_lo(rq[jt].y); q4[3] += wq[3] * bf_hi(rq[jt].y); \
            k4[0] += wk[0] * bf_lo(rk[jt].x); k4[1] += wk[1] * bf_hi(rk[jt].x); k4[2] += wk[2] * bf_lo(rk[jt].y); k4[3] += wk[3] * bf_hi(rk[jt].y); } \
        float sq = 0.f, sk = 0.f, sqk = 0.f; \
        _Pragma("unroll") for (int i_ = 0; i_ < 4; ++i_) { q4[i_] = siluf_(q4[i_]); k4[i_] = siluf_(k4[i_]); sq += q4[i_] * q4[i_]; sk += k4[i_] * k4[i_]; sqk += q4[i_] * k4[i_]; } \
        sq = half_sum32(sq); sk = half_sum32(sk); sqk = half_sum32(sqk); \
        const float rq_ = __builtin_amdgcn_rsqf(sq + EPS) * 0.08838834764831845f, rk_ = __builtin_amdgcn_rsqf(sk + EPS); \
        q4 = q4 * rq_; k4 = k4 * rk_; \
        *(LAS f32x4*)(B_ + O_K + tl * 128 + dq) = k4; *(LAS f32x4*)(B_ + O_Q + tl * 128 + dq) = q4; \
        if ((tid & 31) == 0) { const float ba = __uint_as_float((unsigned)rba << 16), bb = __uint_as_float((unsigned)rbb << 16); \
            f32x4 sc; sc[0] = __expf(neg_ea * softplusf_(ba + dtb)); sc[1] = sigmoidf_(bb); sc[2] = sqk * rq_ * rk_; sc[3] = 0.f; *(LAS f32x4*)(B_ + O_SC + tl * 4) = sc; } \
        if (tid < 256) { f32x4 v4 = {0.f, 0.f, 0.f, 0.f}; \
            _Pragma("unroll") for (int jt = 0; jt < 4; ++jt) { const f32x4 wv = *(const LAS f32x4*)(Lf + O_CW + jt * 320 + 256 + c4); \
                v4[0] += wv[0] * bf_lo(rv[jt].x); v4[1] += wv[1] * bf_hi(rv[jt].x); v4[2] += wv[2] * bf_lo(rv[jt].y); v4[3] += wv[3] * bf_hi(rv[jt].y); } \
            _Pragma("unroll") for (int i_ = 0; i_ < 4; ++i_) v4[i_] = siluf_(v4[i_]); \
            *(LAS f32x4*)(B_ + O_V + tlv * 64 + c4) = v4; } } while (0)
    LBAR();
    GDN_LOAD(0); GDN_XFORM(0);
    LBAR();
    f32x2 S2[8];
#pragma unroll
    for (int i = 0; i < 8; ++i) S2[i] = (f32x2){0.f, 0.f};
    const int j = lane & 15, col = w * 8 + (lane >> 4) * 2;
    for (int c = 0; c < NCHUNK; ++c) {
        if (c + 1 < NCHUNK) GDN_LOAD(c + 1);
        const LAS float* B_ = Lf + (c & 1) * BUFSZ;
        float os0 = 0.f, os1 = 0.f;
        f32x4 k0, k1, q0, q1, sc, nk0, nk1, nq0, nq1, nsc; f32x2 v2, nv2;
#define GDN_LDSTEP(t_, K0, K1, Q0, Q1, V2, SC) do { K0 = *(const LAS f32x4*)(B_ + O_K + (t_) * 128 + 4 * j); K1 = *(const LAS f32x4*)(B_ + O_K + (t_) * 128 + 64 + 4 * j); \
            Q0 = *(const LAS f32x4*)(B_ + O_Q + (t_) * 128 + 4 * j); Q1 = *(const LAS f32x4*)(B_ + O_Q + (t_) * 128 + 64 + 4 * j); V2 = *(const LAS f32x2*)(B_ + O_V + (t_) * 64 + col); SC = *(const LAS f32x4*)(B_ + O_SC + (t_) * 4); } while (0)
        GDN_LDSTEP(0, k0, k1, q0, q1, v2, sc);
#pragma unroll
        for (int t = 0; t < TC; ++t) {
            if (t + 1 < TC) { GDN_LDSTEP(t + 1, nk0, nk1, nq0, nq1, nv2, nsc); }
            __builtin_amdgcn_sched_barrier(0);
            f32x2 d1 = {0.f, 0.f}, d2 = {0.f, 0.f}, e1 = {0.f, 0.f}, e2 = {0.f, 0.f};
#pragma unroll
            for (int i = 0; i < 4; ++i) { d1 += S2[i] * k0[i]; e1 += S2[4 + i] * k1[i]; d2 += S2[i] * q0[i]; e2 += S2[4 + i] * q1[i]; }
            d1 += e1; d2 += e2;
            { float r0_ = d1[0], r1_ = d1[1], r2_ = d2[0], r3_ = d2[1]; row_sum16_x4(r0_, r1_, r2_, r3_); d1[0] = r0_; d1[1] = r1_; d2[0] = r2_; d2[1] = r3_; }
            const float a = sc[0], beta = sc[1], qk = sc[2];
            const f32x2 dl = (v2 - d1 * a) * beta;
            const f32x2 o2 = d2 * a + dl * qk;
#pragma unroll
            for (int i = 0; i < 4; ++i) { S2[i] = S2[i] * a + dl * k0[i]; S2[4 + i] = S2[4 + i] * a + dl * k1[i]; }
            os0 = (j == t) ? o2[0] : os0; os1 = (j == t) ? o2[1] : os1;
            k0 = nk0; k1 = nk1; q0 = nq0; q1 = nq1; v2 = nv2; sc = nsc;
        }
#undef GDN_LDSTEP
        { f32x2 o2 = {os0, os1}; *(LAS f32x2*)(Lf + O_OUT + j * 64 + col) = o2; }
        if (c + 1 < NCHUNK) GDN_XFORM((c + 1) & 1);
        LBAR();
        if (tid < 256) *(GAS f32x4*)(O + (size_t)(c * TC + tlv) * D + c4) = *(const LAS f32x4*)(Lf + O_OUT + tlv * 64 + c4);
        LBAR();
    }
#undef GDN_LOAD
#undef GDN_XFORM
}

typedef short bf16x4_t __attribute__((ext_vector_type(4)));
__device__ __forceinline__ bf16x8 mk_frag(u32x2 lo, u32x2 hi) { v4u t; t.x = lo.x; t.y = lo.y; t.z = hi.x; t.w = hi.y; return __builtin_bit_cast(bf16x8, t); }
template <int MODE>
__device__ __forceinline__ void scan_gla_mfma_unit(const Args& A, Frame& F, int unit) {
    int tid = F.tid; asm volatile("" : "+v"(tid));
    const int lane = tid & 63, w = F.wave;
    int b, h, qcol, kcol, vcol, ocol;
    if (MODE == 0) { b = unit >> 3; h = (unit >> 1) & 3; const int s = unit & 1; qcol = EC_GQ + h * 128; kcol = EC_GK + h * 128; vcol = EC_GV + h * 256 + s * 128; ocol = h * 256 + s * 128; }
    else           { b = unit >> 3; h = unit & 7; qcol = OC_HQ + h * 128; kcol = OC_HF + h * 128; vcol = OC_HI + h * 128; ocol = h * 128; }
    const bf16* P = (const bf16*)(A.ws + WS_PROJ) + (size_t)b * SEQ * PROJ_LD;
    float* O = (float*)(A.ws + WS_O) + (size_t)b * SEQ * D + ocol;
    LAS float* Lf = (LAS float*)(F.lds + RING_OFF);
    constexpr int BUFSZ = 8192, O_E = 0, O_K = 2048, O_Q = 4096, O_V = 6144, RS = 136, O_QB = 2 * BUFSZ, O_KB = O_QB + 1088, O_KT = O_KB + 1088, O_BL = O_KT + 1024, O_AM = O_BL + 128, O_W2 = O_AM + 128, O_BIAS = O_W2 + 2048;
    LAS bf16* QB = (LAS bf16*)(Lf + O_QB); LAS bf16* KB = (LAS bf16*)(Lf + O_KB); LAS bf16* KT = (LAS bf16*)(Lf + O_KT); LAS bf16* AM = (LAS bf16*)(Lf + O_AM);
    const int tl = tid >> 5, dq = (tid & 31) * 4;
    float lb[4] = {0.f, 0.f, 0.f, 0.f};
    if (MODE == 0) {
        const float* w2 = A.in[I_GK_W2]; const float* gb = A.in[I_GK_B];
        for (int i = tid; i < 2048; i += NTHREADS) Lf[O_W2 + i] = w2[(i >> 7) * 512 + h * 128 + (i & 127)];
        if (tid < 128) Lf[O_BIAS + tid] = gb[h * 128 + tid];
    } else {
        const float* lg = A.in[I_LB];
#pragma unroll
        for (int i = 0; i < 4; ++i) lb[i] = sigmoidf_(lg[1024 + h * 128 + dq + i] - lg[h * 128 + dq + i]);
    }
    u32x2 rq, rk, rv; v4u rg0 = {0u, 0u, 0u, 0u}, rg1 = {0u, 0u, 0u, 0u};
#define GM_LOAD(c) do { const bf16* pr = P + (size_t)((c) * TC + tl) * PROJ_LD; rq = *(const GAS u32x2*)(pr + qcol + dq); rk = *(const GAS u32x2*)(pr + kcol + dq); rv = *(const GAS u32x2*)(pr + vcol + dq); \
        if (MODE == 0) { rg0 = *(const GAS v4u*)(pr + EC_GLR); rg1 = *(const GAS v4u*)(pr + EC_GLR + 8); } } while (0)
#define GM_XFORM(bufi) do { LAS float* B_ = Lf + (bufi) * BUFSZ; f32x4 q4, k4, e4; \
        const float xq[4] = {bf_lo(rq.x), bf_hi(rq.x), bf_lo(rq.y), bf_hi(rq.y)}, xk[4] = {bf_lo(rk.x), bf_hi(rk.x), bf_lo(rk.y), bf_hi(rk.y)}; \
        if (MODE == 0) { f32x4 z = *(const LAS f32x4*)(Lf + O_BIAS + dq); \
            const float gl[16] = {bf_lo(rg0.x), bf_hi(rg0.x), bf_lo(rg0.y), bf_hi(rg0.y), bf_lo(rg0.z), bf_hi(rg0.z), bf_lo(rg0.w), bf_hi(rg0.w), \
                                  bf_lo(rg1.x), bf_hi(rg1.x), bf_lo(rg1.y), bf_hi(rg1.y), bf_lo(rg1.z), bf_hi(rg1.z), bf_lo(rg1.w), bf_hi(rg1.w)}; \
            _Pragma("unroll") for (int r_ = 0; r_ < 16; ++r_) { const f32x4 wv = *(const LAS f32x4*)(Lf + O_W2 + r_ * 128 + dq); z = z + wv * gl[r_]; } \
            _Pragma("unroll") for (int i_ = 0; i_ < 4; ++i_) { q4[i_] = xq[i_] * 0.08838834764831845f; k4[i_] = xk[i_]; e4[i_] = __builtin_amdgcn_exp2f(-0.0625f * __builtin_amdgcn_logf(1.0f + __expf(-z[i_]))); } } \
        else { _Pragma("unroll") for (int i_ = 0; i_ < 4; ++i_) { const float fg = lb[i_] + (1.f - lb[i_]) * sigmoidf_(xk[i_]); q4[i_] = siluf_(xq[i_]); k4[i_] = 1.f - fg; e4[i_] = fg; } } \
        *(LAS f32x4*)(B_ + O_E + tl * 128 + dq) = e4; *(LAS f32x4*)(B_ + O_K + tl * 128 + dq) = k4; *(LAS f32x4*)(B_ + O_Q + tl * 128 + dq) = q4; \
        { f32x4 v4 = {bf_lo(rv.x), bf_hi(rv.x), bf_lo(rv.y), bf_hi(rv.y)}; *(LAS f32x4*)(B_ + O_V + tl * 128 + dq) = v4; } } while (0)
    LBAR();
    GM_LOAD(0); GM_XFORM(0); GM_LOAD(1);
    LBAR();
    f32x4 Sacc[8];
#pragma unroll
    for (int i = 0; i < 8; ++i) Sacc[i] = (f32x4){0.f, 0.f, 0.f, 0.f};
    const int fr = lane & 15, g = lane >> 4, c0 = w * 16;
    for (int c = 0; c < NCHUNK; ++c) {
        const LAS float* B_ = Lf + (c & 1) * BUFSZ;
        {
            const int seg = tid >> 7, d = tid & 127;
            float bt = 1.f, ball = 1.f;
#pragma unroll
            for (int t = 0; t < 16; ++t) { const float e = B_[O_E + t * 128 + d]; ball *= e; if (t < 4 * seg) bt = ball; }
            ball = fmaxf(ball, 1e-30f);
            unsigned short kt4[4];
#pragma unroll
            for (int i = 0; i < 4; ++i) { const int t = 4 * seg + i; bt = fmaxf(bt * B_[O_E + t * 128 + d], 1e-30f);
                const float kk = B_[O_K + t * 128 + d], qq = B_[O_Q + t * 128 + d], ib = __builtin_amdgcn_rcpf(bt);
                QB[t * RS + d] = hw_bf(qq * bt); KB[t * RS + d] = hw_bf(kk * ib); kt4[i] = (unsigned short)hw_bf(kk * ball * ib); }
            u32x2 kw; kw.x = (unsigned)kt4[0] | ((unsigned)kt4[1] << 16); kw.y = (unsigned)kt4[2] | ((unsigned)kt4[3] << 16);
            *(LAS u32x2*)(KT + d * 16 + 4 * seg) = kw;
            if (seg == 3) Lf[O_BL + d] = ball;
        }
        LBAR();
        if (w == 0) {
            f32x4 acc = {0.f, 0.f, 0.f, 0.f};
#pragma unroll
            for (int ks = 0; ks < 4; ++ks) { const bf16x8 af = *(const LAS bf16x8*)(QB + fr * RS + 32 * ks + 8 * g), bfm = *(const LAS bf16x8*)(KB + fr * RS + 32 * ks + 8 * g);
                acc = __builtin_amdgcn_mfma_f32_16x16x32_bf16(af, bfm, acc, 0, 0, 0); }
#pragma unroll
            for (int r = 0; r < 4; ++r) { const int t = 4 * g + r, s = fr; AM[t * 16 + s] = hw_bf(s <= t ? acc[r] : 0.f); }
        }
        if (c + 1 < NCHUNK) GM_XFORM((c + 1) & 1);
        if (c + 2 < NCHUNK) GM_LOAD(c + 2);
        LBAR();
        {
            u32x2 vlo; { const float v0 = B_[O_V + (4 * g + 0) * 128 + c0 + fr], v1 = B_[O_V + (4 * g + 1) * 128 + c0 + fr], v2 = B_[O_V + (4 * g + 2) * 128 + c0 + fr], v3 = B_[O_V + (4 * g + 3) * 128 + c0 + fr];
                vlo.x = hw_pk2(v0, v1); vlo.y = hw_pk2(v2, v3); }
            const u32x2 zz = {0u, 0u};
            const bf16x8 vb = mk_frag(vlo, zz);
            f32x4 acco = {0.f, 0.f, 0.f, 0.f};
#pragma unroll
            for (int ks = 0; ks < 4; ++ks) {
                u32x2 slo, shi; slo.x = hw_pk2(Sacc[2 * ks][0], Sacc[2 * ks][1]); slo.y = hw_pk2(Sacc[2 * ks][2], Sacc[2 * ks][3]); shi.x = hw_pk2(Sacc[2 * ks + 1][0], Sacc[2 * ks + 1][1]); shi.y = hw_pk2(Sacc[2 * ks + 1][2], Sacc[2 * ks + 1][3]);
                const bf16x8 sb = mk_frag(slo, shi);
                const u32x2 qlo = *(const LAS u32x2*)(QB + fr * RS + 32 * ks + 4 * g), qhi = *(const LAS u32x2*)(QB + fr * RS + 32 * ks + 16 + 4 * g);
                acco = __builtin_amdgcn_mfma_f32_16x16x32_bf16(mk_frag(qlo, qhi), sb, acco, 0, 0, 0); }
            { const u32x2 alo = *(const LAS u32x2*)(AM + fr * 16 + 4 * g); acco = __builtin_amdgcn_mfma_f32_16x16x32_bf16(mk_frag(alo, zz), vb, acco, 0, 0, 0); }
#pragma unroll
            for (int r = 0; r < 4; ++r) O[(size_t)(c * TC + 4 * g + r) * D + c0 + fr] = acco[r];
#pragma unroll
            for (int i = 0; i < 8; ++i) { const f32x4 bl = *(const LAS f32x4*)(Lf + O_BL + 16 * i + 4 * g); const u32x2 klo = *(const LAS u32x2*)(KT + (16 * i + fr) * 16 + 4 * g);
                Sacc[i] = __builtin_amdgcn_mfma_f32_16x16x32_bf16(mk_frag(klo, zz), vb, Sacc[i] * bl, 0, 0, 0); }
        }
        LBAR();
    }
#undef GM_LOAD
#undef GM_XFORM
}

__device__ __forceinline__ void scan_gdn_mfma_unit(const Args& A, Frame& F, int unit, const int role) {
    int tid = F.tid; asm volatile("" : "+v"(tid));
    const int lane = tid & 63, w = F.wave;
    const int b = unit >> 3, h = unit & 7;
    const int qcol = EC_BQ + h * 128, kcol = EC_BK + h * 128, vcol = EC_BV + h * 128, ocol = 1024 + h * 128;
    const bf16* P = (const bf16*)(A.ws + WS_PROJ) + (size_t)b * SEQ * PROJ_LD;
    float* O = (float*)(A.ws + WS_O) + (size_t)b * SEQ * D + ocol;
    LAS float* Lf = (LAS float*)(F.lds + RING_OFF);
    constexpr int O_CW = 0, O_AMAT = 1536, O_QKM = O_AMAT + 256, O_TB = O_QKM + 128, O_GL = O_TB + 128, O_BUF0 = O_GL + 64;
    constexpr int BUFSZ = 6208, O_KH = 0, O_QH = 2048, O_VV = 4096, O_SC = 6144;
    constexpr int RS = 136;
    constexpr int O_KHB = O_BUF0 + 2 * BUFSZ, O_QHB = O_KHB + 1088, O_QB = O_QHB + 1088, O_KT = O_QB + 1088, O_WSRC = O_KT + 1024, O_WB = O_WSRC + 2048;
    LAS bf16* KHB = (LAS bf16*)(Lf + O_KHB); LAS bf16* QHB = (LAS bf16*)(Lf + O_QHB); LAS bf16* QB = (LAS bf16*)(Lf + O_QB); LAS bf16* KT = (LAS bf16*)(Lf + O_KT);
    LAS bf16* WB = (LAS bf16*)(Lf + O_WB); LAS bf16* QKM = (LAS bf16*)(Lf + O_QKM); LAS bf16* TB = (LAS bf16*)(Lf + O_TB);
    const int tl = tid >> 5, dq = (tid & 31) * 4;
    { const float* cw = A.in[I_GDN_CONV];
      for (int i = tid; i < 4 * 384; i += NTHREADS) { const int jt = i / 384, x = i % 384; Lf[O_CW + i] = cw[jt * 3072 + (x >> 7) * 1024 + h * 128 + (x & 127)]; } }
    const float neg_ea = -__expf(A.in[I_GDN_ALOG][h]), dtb = A.in[I_GDN_DTB][h];
    u32x2 rq[4], rk[4], rv[4]; unsigned short rba = 0, rbb = 0;
#define GD_LOAD(c) do { const int t_ = (c) * TC + tl; \
        _Pragma("unroll") for (int jt = 0; jt < 4; ++jt) { const int tt = t_ - 3 + jt; const bf16* pr = P + (size_t)(tt < 0 ? 0 : tt) * PROJ_LD + dq; \
            rq[jt] = *(const GAS u32x2*)(pr + qcol); rk[jt] = *(const GAS u32x2*)(pr + kcol); rv[jt] = *(const GAS u32x2*)(pr + vcol); \
            if (tt < 0) { rq[jt] = (u32x2){0u, 0u}; rk[jt] = (u32x2){0u, 0u}; rv[jt] = (u32x2){0u, 0u}; } } \
        { const bf16* pr = P + (size_t)t_ * PROJ_LD; rba = pr[EC_BA + h]; rbb = pr[EC_BB + h]; } } while (0)
#define GD_XFORM(bufi) do { LAS float* B_ = Lf + O_BUF0 + (bufi) * BUFSZ; f32x4 q4 = {0.f, 0.f, 0.f, 0.f}, k4 = {0.f, 0.f, 0.f, 0.f}, v4 = {0.f, 0.f, 0.f, 0.f}; \
        _Pragma("unroll") for (int jt = 0; jt < 4; ++jt) { const f32x4 wq = *(const LAS f32x4*)(Lf + O_CW + jt * 384 + dq), wk = *(const LAS f32x4*)(Lf + O_CW + jt * 384 + 128 + dq), wv = *(const LAS f32x4*)(Lf + O_CW + jt * 384 + 256 + dq); \
            q4[0] += wq[0] * bf_lo(rq[jt].x); q4[1] += wq[1] * bf_hi(rq[jt].x); q4[2] += wq[2] * bf_lo(rq[jt].y); q4[3] += wq[3] * bf_hi(rq[jt].y); \
            k4[0] += wk[0] * bf_lo(rk[jt].x); k4[1] += wk[1] * bf_hi(rk[jt].x); k4[2] += wk[2] * bf_lo(rk[jt].y); k4[3] += wk[3] * bf_hi(rk[jt].y); \
            v4[0] += wv[0] * bf_lo(rv[jt].x); v4[1] += wv[1] * bf_hi(rv[jt].x); v4[2] += wv[2] * bf_lo(rv[jt].y); v4[3] += wv[3] * bf_hi(rv[jt].y); } \
        float sq = 0.f, sk = 0.f; \
        _Pragma("unroll") for (int i_ = 0; i_ < 4; ++i_) { q4[i_] = siluf_(q4[i_]); k4[i_] = siluf_(k4[i_]); v4[i_] = siluf_(v4[i_]); sq += q4[i_] * q4[i_]; sk += k4[i_] * k4[i_]; } \
        row_sum16_x2(sq, sk); sq += __shfl_xor(sq, 16); sk += __shfl_xor(sk, 16); \
        q4 = q4 * (__builtin_amdgcn_rsqf(sq + EPS) * 0.08838834764831845f); k4 = k4 * __builtin_amdgcn_rsqf(sk + EPS); \
        *(LAS f32x4*)(B_ + O_KH + tl * 128 + dq) = k4; *(LAS f32x4*)(B_ + O_QH + tl * 128 + dq) = q4; *(LAS f32x4*)(B_ + O_VV + tl * 128 + dq) = v4; \
        if ((tid & 31) == 0) { const float ba = __uint_as_float((unsigned)rba << 16), bb = __uint_as_float((unsigned)rbb << 16); \
            B_[O_SC + tl] = __expf(neg_ea * softplusf_(ba + dtb)); B_[O_SC + 16 + tl] = sigmoidf_(bb); } } while (0)
    LBAR();
    const int c_begin = role ? NCHUNK / 2 : 0, c_end = role ? NCHUNK : NCHUNK / 2;
    constexpr int REC = 5408;
    float* STASH = (float*)(A.ws + WS_LA) + (size_t)unit * (NCHUNK / 2) * REC;
    float* STATE = (float*)(A.ws + WS_STATE) + (size_t)unit * 16384;
    gu32* flag = F.ctl + 32768 + unit * 64;
    GD_LOAD(c_begin); GD_XFORM(c_begin & 1); GD_LOAD(c_begin + 1);
    LBAR();
    f32x4 Sacc[8];
#pragma unroll
    for (int i = 0; i < 8; ++i) Sacc[i] = (f32x4){0.f, 0.f, 0.f, 0.f};
    const int fr = lane & 15, g = lane >> 4, c0 = w * 16;
    const u32x2 zz = {0u, 0u};
#define GD_STATE_PART(cc_) do { \
        { \
            bf16x8 sb[4]; \
_Pragma("unroll") \
            for (int ks = 0; ks < 4; ++ks) { u32x2 slo, shi; slo.x = hw_pk2(Sacc[2 * ks][0], Sacc[2 * ks][1]); slo.y = hw_pk2(Sacc[2 * ks][2], Sacc[2 * ks][3]); shi.x = hw_pk2(Sacc[2 * ks + 1][0], Sacc[2 * ks + 1][1]); shi.y = hw_pk2(Sacc[2 * ks + 1][2], Sacc[2 * ks + 1][3]); \
                sb[ks] = mk_frag(slo, shi); } \
            f32x4 accv = accu, acco = {0.f, 0.f, 0.f, 0.f}; \
_Pragma("unroll") \
            for (int ks = 0; ks < 4; ++ks) { \
                const u32x2 wl = *(const LAS u32x2*)(WB + fr * RS + 32 * ks + 4 * g), wh = *(const LAS u32x2*)(WB + fr * RS + 32 * ks + 16 + 4 * g); \
                accv = __builtin_amdgcn_mfma_f32_16x16x32_bf16(mk_frag(wl, wh), sb[ks], accv, 0, 0, 0); \
                const u32x2 ql = *(const LAS u32x2*)(QB + fr * RS + 32 * ks + 4 * g), qh = *(const LAS u32x2*)(QB + fr * RS + 32 * ks + 16 + 4 * g); \
                acco = __builtin_amdgcn_mfma_f32_16x16x32_bf16(mk_frag(ql, qh), sb[ks], acco, 0, 0, 0); } \
            u32x2 vn; vn.x = hw_pk2(accv[0], accv[1]); vn.y = hw_pk2(accv[2], accv[3]); \
            const bf16x8 vnb = mk_frag(vn, zz); \
            acco = __builtin_amdgcn_mfma_f32_16x16x32_bf16(mk_frag(*(const LAS u32x2*)(QKM + fr * 16 + 4 * g), zz), vnb, acco, 0, 0, 0); \
_Pragma("unroll") \
            for (int r = 0; r < 4; ++r) O[(size_t)((cc_) * TC + 4 * g + r) * D + c0 + fr] = acco[r]; \
_Pragma("unroll") \
            for (int i = 0; i < 8; ++i) { const u32x2 klo = *(const LAS u32x2*)(KT + (16 * i + fr) * 16 + 4 * g); \
                Sacc[i] = __builtin_amdgcn_mfma_f32_16x16x32_bf16(mk_frag(klo, zz), vnb, Sacc[i] * glast, 0, 0, 0); } \
        } \
        } while (0)
    for (int c = c_begin; c < c_end; ++c) {
        const LAS float* B_ = Lf + O_BUF0 + (c & 1) * BUFSZ;
        float glast;
        {
            const int seg = tid >> 7, d = tid & 127;
            const f32x4 a0 = *(const LAS f32x4*)(B_ + O_SC), a1 = *(const LAS f32x4*)(B_ + O_SC + 4), a2 = *(const LAS f32x4*)(B_ + O_SC + 8), a3 = *(const LAS f32x4*)(B_ + O_SC + 12);
            const float av[16] = {a0[0], a0[1], a0[2], a0[3], a1[0], a1[1], a1[2], a1[3], a2[0], a2[1], a2[2], a2[3], a3[0], a3[1], a3[2], a3[3]};
            float p = 1.f, gpre = 1.f;
#pragma unroll
            for (int t = 0; t < 16; ++t) { if (t == 4 * seg) gpre = p; p *= av[t]; }
            glast = p;
            unsigned short kt4[4]; float gt = gpre;
#pragma unroll
            for (int i = 0; i < 4; ++i) { const int t = 4 * seg + i; const float at = (seg == 0) ? av[i] : (seg == 1) ? av[4 + i] : (seg == 2) ? av[8 + i] : av[12 + i]; gt *= at; const float beta = B_[O_SC + 16 + t];
                const float kk = B_[O_KH + t * 128 + d], qq = B_[O_QH + t * 128 + d];
                KHB[t * RS + d] = hw_bf(kk); QHB[t * RS + d] = hw_bf(qq); QB[t * RS + d] = hw_bf(qq * gt);
                kt4[i] = (unsigned short)hw_bf(kk * glast * __builtin_amdgcn_rcpf(gt));
                Lf[O_WSRC + t * 128 + d] = kk * (beta * gt);
                if (d == 0) Lf[O_GL + t] = gt; }
            u32x2 kw; kw.x = (unsigned)kt4[0] | ((unsigned)kt4[1] << 16); kw.y = (unsigned)kt4[2] | ((unsigned)kt4[3] << 16);
            *(LAS u32x2*)(KT + d * 16 + 4 * seg) = kw;
        }
        LBAR();
        if (w < 2) {
            const LAS bf16* AS = (w == 0) ? KHB : QHB;
            f32x4 acc = {0.f, 0.f, 0.f, 0.f};
#pragma unroll
            for (int ks = 0; ks < 4; ++ks) { const bf16x8 af = *(const LAS bf16x8*)(AS + fr * RS + 32 * ks + 8 * g), bfm = *(const LAS bf16x8*)(KHB + fr * RS + 32 * ks + 8 * g);
                acc = __builtin_amdgcn_mfma_f32_16x16x32_bf16(af, bfm, acc, 0, 0, 0); }
            const float gs_inv = __builtin_amdgcn_rcpf(Lf[O_GL + fr]);
            if (w == 0) {
                f32x4 N1, M1;
#pragma unroll
                for (int r = 0; r < 4; ++r) { const int t = 4 * g + r; const float gt = Lf[O_GL + t];
                    N1[r] = (fr < t) ? -(B_[O_SC + 16 + t] * acc[r] * gt * gs_inv) : 0.f;
                    M1[r] = (t < fr) ? -(B_[O_SC + 16 + fr] * acc[r] * Lf[O_GL + fr] * __builtin_amdgcn_rcpf(gt)) : 0.f; }
#define XTY(X, Y, C0) __builtin_amdgcn_mfma_f32_16x16x32_bf16(mk_frag((u32x2){hw_pk2(X[0], X[1]), hw_pk2(X[2], X[3])}, zz), mk_frag((u32x2){hw_pk2(Y[0], Y[1]), hw_pk2(Y[2], Y[3])}, zz), C0, 0, 0, 0)
                const f32x4 z4 = {0.f, 0.f, 0.f, 0.f};
                f32x4 T1t = M1;
#pragma unroll
                for (int r = 0; r < 4; ++r) if (4 * g + r == fr) T1t[r] += 1.f;
                const f32x4 N2 = XTY(M1, N1, z4), M2 = XTY(N1, M1, z4);
                const f32x4 T2t = XTY(N2, T1t, T1t);
                const f32x4 N4 = XTY(M2, N2, z4), M4 = XTY(N2, M2, z4);
                const f32x4 T4t = XTY(N4, T2t, T2t);
                const f32x4 N8 = XTY(M4, N4, z4);
                const f32x4 T8t = XTY(N8, T4t, T4t);
#undef XTY
                u32x2 tw; tw.x = hw_pk2(T8t[0], T8t[1]); tw.y = hw_pk2(T8t[2], T8t[3]);
                *(LAS u32x2*)(TB + fr * 16 + 4 * g) = tw;
            } else {
#pragma unroll
                for (int r = 0; r < 4; ++r) { const int t = 4 * g + r; QKM[t * 16 + fr] = hw_bf((fr <= t) ? acc[r] * Lf[O_GL + t] * gs_inv : 0.f); }
            }
        }
        if (c + 1 < c_end) GD_XFORM((c + 1) & 1);
        if (c + 2 < c_end) GD_LOAD(c + 2);
        LBAR();
        f32x4 accu = {0.f, 0.f, 0.f, 0.f};
        {
            const bf16x8 tf = mk_frag(*(const LAS u32x2*)(TB + fr * 16 + 4 * g), zz);
            u32x2 ulo, wlo;
            { const float b0 = B_[O_SC + 16 + 4 * g + 0], b1 = B_[O_SC + 16 + 4 * g + 1], b2 = B_[O_SC + 16 + 4 * g + 2], b3 = B_[O_SC + 16 + 4 * g + 3];
              ulo.x = hw_pk2(b0 * B_[O_VV + (4 * g + 0) * 128 + c0 + fr], b1 * B_[O_VV + (4 * g + 1) * 128 + c0 + fr]); ulo.y = hw_pk2(b2 * B_[O_VV + (4 * g + 2) * 128 + c0 + fr], b3 * B_[O_VV + (4 * g + 3) * 128 + c0 + fr]);
              wlo.x = hw_pk2(Lf[O_WSRC + (4 * g + 0) * 128 + c0 + fr], Lf[O_WSRC + (4 * g + 1) * 128 + c0 + fr]); wlo.y = hw_pk2(Lf[O_WSRC + (4 * g + 2) * 128 + c0 + fr], Lf[O_WSRC + (4 * g + 3) * 128 + c0 + fr]); }
            accu = __builtin_amdgcn_mfma_f32_16x16x32_bf16(tf, mk_frag(ulo, zz), accu, 0, 0, 0);
            f32x4 accw = {0.f, 0.f, 0.f, 0.f};
            accw = __builtin_amdgcn_mfma_f32_16x16x32_bf16(tf, mk_frag(wlo, zz), accw, 0, 0, 0);
#pragma unroll
            for (int r = 0; r < 4; ++r) WB[(4 * g + r) * RS + c0 + fr] = hw_bf(-accw[r]);
        }
        LBAR();
        if (role == 0) {
            GD_STATE_PART(c);
        } else {
            float* rec = STASH + (size_t)(c - c_begin) * REC;
            for (int i = tid; i < 832; i += NTHREADS) { const int o = i < 528 ? O_QB + 4 * i : (i < 800 ? O_WB + 4 * (i - 528) : O_QKM + 4 * (i - 800)); *(GAS f32x4*)(rec + 4 * i) = *(const LAS f32x4*)(Lf + o); }
#pragma unroll
            for (int r = 0; r < 4; ++r) rec[3328 + (w * 4 + r) * 64 + lane] = accu[r];
            if (tid == 0) rec[5376] = glast;
        }
        LBAR();
    }
    if (role == 0) {
#pragma unroll
        for (int i = 0; i < 8; ++i)
#pragma unroll
            for (int r = 0; r < 4; ++r) STATE[((w * 8 + i) * 4 + r) * 64 + lane] = Sacc[i][r];
        asm volatile("s_waitcnt vmcnt(0)" ::: "memory");
        __syncthreads();
        if (tid == 0) { __builtin_amdgcn_fence(__ATOMIC_RELEASE, "agent"); asm volatile("s_waitcnt vmcnt(0)" ::: "memory"); __hip_atomic_store(flag, 1u, __ATOMIC_RELAXED, __HIP_MEMORY_SCOPE_AGENT); }
    } else {
        if (tid == 0) { unsigned sp = 0; while (__hip_atomic_load(flag, __ATOMIC_RELAXED, __HIP_MEMORY_SCOPE_AGENT) == 0u) { __builtin_amdgcn_s_sleep(8); if (++sp > (1u << 22)) break; }
            __builtin_amdgcn_fence(__ATOMIC_ACQUIRE, "agent"); asm volatile("s_waitcnt vmcnt(0)" ::: "memory"); }
        __syncthreads();
#pragma unroll
        for (int i = 0; i < 8; ++i)
#pragma unroll
            for (int r = 0; r < 4; ++r) Sacc[i][r] = STATE[((w * 8 + i) * 4 + r) * 64 + lane];
        f32x4 pa, pb; f32x4 pu; float pg;
#define GD_REC_LOAD(cc) do { const float* rec = STASH + (size_t)((cc) - c_begin) * REC; pa = *(const GAS f32x4*)(rec + 4 * tid); pb = (tid < 320) ? *(const GAS f32x4*)(rec + 4 * (tid + 512)) : (f32x4){0.f, 0.f, 0.f, 0.f}; \
            _Pragma("unroll") for (int r = 0; r < 4; ++r) pu[r] = rec[3328 + (w * 4 + r) * 64 + lane]; pg = rec[5376]; } while (0)
        GD_REC_LOAD(c_begin);
        for (int c = c_begin; c < c_end; ++c) {
            { const int i0 = tid, o0 = i0 < 528 ? O_QB + 4 * i0 : O_WB + 4 * (i0 - 528); *(LAS f32x4*)(Lf + o0) = pa;
              if (tid < 320) { const int i1 = tid + 512; const int o1 = i1 < 528 ? O_QB + 4 * i1 : (i1 < 800 ? O_WB + 4 * (i1 - 528) : O_QKM + 4 * (i1 - 800)); *(LAS f32x4*)(Lf + o1) = pb; } }
            const f32x4 accu = pu; const float glast = pg;
            if (c + 1 < c_end) GD_REC_LOAD(c + 1);
            LBAR();
            GD_STATE_PART(c);
            LBAR();
        }
#undef GD_REC_LOAD
    }
#undef GD_STATE_PART
#undef GD_LOAD
#undef GD_XFORM
}

__device__ __forceinline__ void scan_rwkv_unit(const Args& A, Frame& F, int unit) {
    int tid = F.tid; asm volatile("" : "+v"(tid));
    const int lane = tid & 63, w = F.wave;
    const int b = unit >> 4, h = unit & 15;
    const bf16* P = (const bf16*)(A.ws + WS_PROJ) + (size_t)b * SEQ * PROJ_LD + OC_RW;
    const bf16* LO = (const bf16*)(A.ws + WS_LO) + (size_t)b * SEQ * LORA_N;
    bf16* Y = (bf16*)(A.ws + WS_ACTA) + (size_t)b * SEQ * D + 1024 + h * 64;
    LAS float* Lf = (LAS float*)(F.lds + RING_OFF);
    constexpr int BUFSZ = 6208, O_KK = 0, O_WR = 1024, O_W = 2048, O_NKA = 3072, O_K = 4096, O_V = 5120, O_SC = 6144, O_OUT = 2 * BUFSZ;
    const int tl = tid >> 5, d2 = (tid & 31) * 2, hd = h * 64 + d2;
    float mu_r[2], mu_k[2], mu_v[2], w0[2], a0[2], k_k[2], k_a[2], r_k[2], lnw[2], lnb[2];
#pragma unroll
    for (int i = 0; i < 2; ++i) { mu_r[i] = A.in[I_MU][RW_R + hd + i]; mu_k[i] = A.in[I_MU][RW_K + hd + i]; mu_v[i] = A.in[I_MU][RW_V + hd + i];
        w0[i] = A.in[I_W0][hd + i]; a0[i] = A.in[I_A0][hd + i]; k_k[i] = A.in[I_KK][hd + i]; k_a[i] = A.in[I_KA][hd + i]; r_k[i] = A.in[I_RK][hd + i];
        lnw[i] = A.in[I_LNW][hd + i]; lnb[i] = A.in[I_LNB][hd + i]; }
    unsigned rr[2], rk[2], rv[2], rlw, rla, rg_cur = 0u, rg_nxt = 0u;
#define RW_LOAD(c) do { const int t_ = (c) * TC + tl; const bf16* pr = P + (size_t)t_ * PROJ_LD; \
        rr[0] = *(const GAS unsigned*)(pr + RW_R + hd); rk[0] = *(const GAS unsigned*)(pr + RW_K + hd); rv[0] = *(const GAS unsigned*)(pr + RW_V + hd); \
        if (t_ > 0) { rr[1] = *(const GAS unsigned*)(pr - PROJ_LD + RW_R + hd); rk[1] = *(const GAS unsigned*)(pr - PROJ_LD + RW_K + hd); rv[1] = *(const GAS unsigned*)(pr - PROJ_LD + RW_V + hd); } \
        else { rr[1] = 0u; rk[1] = 0u; rv[1] = 0u; } \
        const bf16* lr = LO + (size_t)t_ * LORA_N; rlw = *(const GAS unsigned*)(lr + hd); rla = *(const GAS unsigned*)(lr + 1024 + hd); rg_nxt = *(const GAS unsigned*)(lr + 2048 + hd); } while (0)
#define RW_XFORM(bufi) do { LAS float* B_ = Lf + (bufi) * BUFSZ; f32x2 kk2, wr2, w2_, nka2, k2, v2_; float skk = 0.f, sc1 = 0.f, sc2 = 0.f, sbs = 0.f; float aa[2], rrv[2]; \
        _Pragma("unroll") for (int i_ = 0; i_ < 2; ++i_) { \
            const float r0 = i_ ? bf_hi(rr[0]) : bf_lo(rr[0]), r1 = i_ ? bf_hi(rr[1]) : bf_lo(rr[1]); \
            const float k0_ = i_ ? bf_hi(rk[0]) : bf_lo(rk[0]), k1_ = i_ ? bf_hi(rk[1]) : bf_lo(rk[1]); \
            const float v0_ = i_ ? bf_hi(rv[0]) : bf_lo(rv[0]), v1_ = i_ ? bf_hi(rv[1]) : bf_lo(rv[1]); \
            const float lw = i_ ? bf_hi(rlw) : bf_lo(rlw), la = i_ ? bf_hi(rla) : bf_lo(rla); \
            const float r_ = r0 + (r1 - r0) * mu_r[i_], kx = k0_ + (k1_ - k0_) * mu_k[i_], vx = v0_ + (v1_ - v0_) * mu_v[i_]; \
            const float wd = __expf(-0.6065306597126334f * sigmoidf_(w0[i_] + lw)); const float a_ = sigmoidf_(a0[i_] + la); \
            const float kk0 = kx * k_k[i_]; const float km = kx * (1.f + (a_ - 1.f) * k_a[i_]); \
            kk2[i_] = kk0; skk += kk0 * kk0; aa[i_] = a_; rrv[i_] = r_; wr2[i_] = wd * r_; w2_[i_] = wd; k2[i_] = km; v2_[i_] = vx; sc2 += km * r_; sbs += r_ * km * r_k[i_]; } \
        skk = half_sum32(skk); const float rkk = __builtin_amdgcn_rsqf(skk + EPS); \
        _Pragma("unroll") for (int i_ = 0; i_ < 2; ++i_) { kk2[i_] *= rkk; nka2[i_] = -(kk2[i_] * aa[i_]); sc1 += kk2[i_] * aa[i_] * rrv[i_]; } \
        sc1 = half_sum32(sc1); sc2 = half_sum32(sc2); sbs = half_sum32(sbs); \
        *(LAS f32x2*)(B_ + O_KK + tl * 64 + d2) = kk2; *(LAS f32x2*)(B_ + O_WR + tl * 64 + d2) = wr2; *(LAS f32x2*)(B_ + O_W + tl * 64 + d2) = w2_; \
        *(LAS f32x2*)(B_ + O_NKA + tl * 64 + d2) = nka2; *(LAS f32x2*)(B_ + O_K + tl * 64 + d2) = k2; *(LAS f32x2*)(B_ + O_V + tl * 64 + d2) = v2_; \
        if ((tid & 31) == 0) { f32x4 sc; sc[0] = sc1; sc[1] = sc2; sc[2] = sbs; sc[3] = 0.f; *(LAS f32x4*)(B_ + O_SC + tl * 4) = sc; } } while (0)
    RW_LOAD(0); RW_XFORM(0); rg_cur = rg_nxt;
    LBAR();
    f32x2 S2[4];
#pragma unroll
    for (int i = 0; i < 4; ++i) S2[i] = (f32x2){0.f, 0.f};
    const int j = lane & 15, col = w * 8 + (lane >> 4) * 2;
    for (int c = 0; c < NCHUNK; ++c) {
        if (c + 1 < NCHUNK) RW_LOAD(c + 1);
        const LAS float* B_ = Lf + (c & 1) * BUFSZ;
        float os0 = 0.f, os1 = 0.f;
        f32x4 kk, wr, ww, nka, kv, sc, nkk, nwr, nww, nnka, nkv, nsc; f32x2 v2, nv2;
#define RW_LDSTEP(t_, KK, WR, WW, NKA, KV, V2, SC) do { KK = *(const LAS f32x4*)(B_ + O_KK + (t_) * 64 + 4 * j); WR = *(const LAS f32x4*)(B_ + O_WR + (t_) * 64 + 4 * j); WW = *(const LAS f32x4*)(B_ + O_W + (t_) * 64 + 4 * j); \
            NKA = *(const LAS f32x4*)(B_ + O_NKA + (t_) * 64 + 4 * j); KV = *(const LAS f32x4*)(B_ + O_K + (t_) * 64 + 4 * j); V2 = *(const LAS f32x2*)(B_ + O_V + (t_) * 64 + col); SC = *(const LAS f32x4*)(B_ + O_SC + (t_) * 4); } while (0)
        RW_LDSTEP(0, kk, wr, ww, nka, kv, v2, sc);
#pragma unroll
        for (int t = 0; t < TC; ++t) {
            if (t + 1 < TC) { RW_LDSTEP(t + 1, nkk, nwr, nww, nnka, nkv, nv2, nsc); }
            __builtin_amdgcn_sched_barrier(0);
            f32x2 d1 = S2[0] * kk[0], d2 = S2[0] * wr[0], e1 = S2[1] * kk[1], e2 = S2[1] * wr[1];
            d1 += S2[2] * kk[2]; d2 += S2[2] * wr[2]; e1 += S2[3] * kk[3]; e2 += S2[3] * wr[3];
            d1 += e1; d2 += e2;
            { float r0_ = d1[0], r1_ = d1[1], r2_ = d2[0], r3_ = d2[1]; row_sum16_x4(r0_, r1_, r2_, r3_); d1[0] = r0_; d1[1] = r1_; d2[0] = r2_; d2[1] = r3_; }
            const f32x2 o2 = d2 - d1 * sc[0] + v2 * sc[1];
#pragma unroll
            for (int i = 0; i < 4; ++i) S2[i] = S2[i] * ww[i] + d1 * nka[i] + v2 * kv[i];
            os0 = (j == t) ? o2[0] : os0; os1 = (j == t) ? o2[1] : os1;
            kk = nkk; wr = nwr; ww = nww; nka = nnka; kv = nkv; v2 = nv2; sc = nsc;
        }
#undef RW_LDSTEP
        { f32x2 o2 = {os0, os1}; *(LAS f32x2*)(Lf + O_OUT + j * 64 + col) = o2; }
        if (c + 1 < NCHUNK) RW_XFORM((c + 1) & 1);
        LBAR();
        {
            const f32x2 o2 = *(const LAS f32x2*)(Lf + O_OUT + tl * 64 + d2); const f32x2 vv = *(const LAS f32x2*)(B_ + O_V + tl * 64 + d2); const float bs = B_[O_SC + tl * 4 + 2];
            const float mean = half_sum32(o2[0] + o2[1]) * (1.0f / 64.0f); const float e0 = o2[0] - mean, e1 = o2[1] - mean;
            const float var = half_sum32(e0 * e0 + e1 * e1) * (1.0f / 64.0f); const float rs = __builtin_amdgcn_rsqf(var + 64e-5f);
            const float y0 = (e0 * rs * lnw[0] + lnb[0] + bs * vv[0]) * bf_lo(rg_cur), y1 = (e1 * rs * lnw[1] + lnb[1] + bs * vv[1]) * bf_hi(rg_cur);
            *(GAS unsigned*)(Y + (size_t)(c * TC + tl) * D + d2) = pk2(y0, y1);
        }
        rg_cur = rg_nxt;
        LBAR();
    }
#undef RW_LOAD
#undef RW_XFORM
}

template <int LAYER>
__device__ __forceinline__ void post_rows(const Args& A, Frame& F) {
    const int gw = F.vcu * NWAVES + F.wave, NGW = F.G * NWAVES, lane = F.lane;
    const float* O = (const float*)(A.ws + WS_O); const bf16* P = (const bf16*)(A.ws + WS_PROJ); bf16* Y = (bf16*)(A.ws + WS_ACTA);
    for (int m = gw; m < T; m += NGW) {
        const GAS f32x4* orow = (const GAS f32x4*)(O + (size_t)m * D) + lane; const bf16* prow = P + (size_t)m * PROJ_LD;
        constexpr int NJ = LAYER == 0 ? 8 : 4;
#pragma unroll
        for (int jj = 0; jj < NJ; ++jj) {
            const f32x4 v = orow[64 * jj]; float ss = (v[0] * v[0] + v[1] * v[1]) + (v[2] * v[2] + v[3] * v[3]);
            const bool wide = (LAYER == 0 && jj < 4);
            const float ms = wide ? wave_sum(ss) * (1.0f / 256.0f) : half_sum32(ss) * (1.0f / 128.0f);
            const float r = __builtin_amdgcn_rsqf(ms + EPS);
            const int cih = wide ? 4 * lane : 4 * (lane & 31);
            const float* gsrc = LAYER == 0 ? (wide ? A.in[I_GLA_NORM] : A.in[I_GDN_NORM]) : A.in[I_HG_NORM];
            const f32x4 g = *(const GAS f32x4*)(gsrc + cih);
            const int zcol = LAYER == 0 ? (wide ? EC_GZ + jj * 256 + 4 * lane : EC_BZ + (jj - 4) * 256 + 4 * lane) : OC_HG + jj * 256 + 4 * lane;
            const u32x2 zw = *(const GAS u32x2*)(prow + zcol);
            const float y0 = v[0] * r * g[0] * siluf_(bf_lo(zw.x)), y1 = v[1] * r * g[1] * siluf_(bf_hi(zw.x)), y2 = v[2] * r * g[2] * siluf_(bf_lo(zw.y)), y3 = v[3] * r * g[3] * siluf_(bf_hi(zw.y));
            u32x2 o; o.x = pk2(y0, y1); o.y = pk2(y2, y3);
            *(GAS u32x2*)(Y + (size_t)m * D + 256 * jj + 4 * lane) = o;
        }
    }
}
__device__ __forceinline__ void lora_prep_rows(const Args& A, Frame& F) {
    const int gw = F.vcu * NWAVES + F.wave, NGW = F.G * NWAVES, lane = F.lane;
    const bf16* P = (const bf16*)(A.ws + WS_PROJ); bf16* LA = (bf16*)(A.ws + WS_LA); const float* mu = A.in[I_MU];
    for (int m = gw; m < T; m += NGW) { const bool hasprev = (m % SEQ) != 0; const bf16* prow = P + (size_t)m * PROJ_LD + OC_RW + RW_WL;
#pragma unroll
        for (int i = 0; i < 7; ++i) { const int c = lane + 64 * i;
            const float x = __uint_as_float((unsigned)prow[c] << 16), xp = hasprev ? __uint_as_float((unsigned)prow[c - PROJ_LD] << 16) : 0.f;
            const float ts = x + (xp - x) * mu[RW_WL + c];
            const float v = c < 96 ? tanhf(ts) : (c < 192 ? ts : sigmoidf_(ts));
            LA[(size_t)m * LORA_K + c] = (bf16)f2bf(v); }
        LA[(size_t)m * LORA_K + 448 + lane] = (bf16)0; }
}
__device__ __forceinline__ void final_rows(const Args& A, Frame& F, const float oscale) {
    const int gw = F.vcu * NWAVES + F.wave, NGW = F.G * NWAVES, lane = F.lane;
    const float* rowss = (const float*)(A.ws + WS_RSP) + (size_t)RS_FINAL * T * 32; const GAS f32x4* g = (const GAS f32x4*)A.in[I_NFINAL] + lane;
    for (int m = gw; m < T; m += NGW) { const float r = oscale * __builtin_amdgcn_rsqf(wave_sum(lane < 32 ? rowss[(size_t)m * 32 + lane] : 0.f) * (1.0f / D) + EPS); GAS f32x4* row = (GAS f32x4*)(A.out + (size_t)m * D) + lane;
#pragma unroll
        for (int jj = 0; jj < 8; ++jj) { const f32x4 v = row[64 * jj]; row[64 * jj] = v * r * g[64 * jj]; } }
}

__device__ __forceinline__ void scan_rwkv_mfma_unit(const Args& A, Frame& F, int unit, const int role) {
    int tid = F.tid; asm volatile("" : "+v"(tid));
    const int lane = tid & 63, w = F.wave;
    const int b = unit >> 3, hp = unit & 7;
    const bf16* P = (const bf16*)(A.ws + WS_PROJ) + (size_t)b * SEQ * PROJ_LD + OC_RW;
    const bf16* LO = (const bf16*)(A.ws + WS_LO) + (size_t)b * SEQ * LORA_N;
    bf16* Y = (bf16*)(A.ws + WS_ACTA) + (size_t)b * SEQ * D + 1024;
    LAS float* Lf = (LAS float*)(F.lds + RING_OFF);
    constexpr int RS = 72;
    constexpr int O_CONST = 0;
    constexpr int O_XF = 1280;
    constexpr int O_VV = O_XF + 2 * 5 * 1024;
    constexpr int O_BS = O_VV + 4 * 1024;
    constexpr int O_IMG = O_BS + 64;
    constexpr int I_CT = 0, I_BT = 576, I_KL = 1152, I_RT = 1728, I_CF = 2304, I_BTT = 3328, I_KTT = 3840, I_WCB = 4352, I_G1B = 4928, I_TTB = 5056, I_RKB = 5184, I_RBB = 5312, I_W15 = 5440, I_OUT = 5504, IMGSZ = 6528;
    static_assert((O_IMG + 2 * IMGSZ) * 4 <= RING_BYTES, "rwkv lds");
    for (int i = tid; i < 1280; i += NTHREADS) { const int arr = i >> 7, ch = hp * 128 + (i & 127); float v;
        switch (arr) { case 0: v = A.in[I_MU][RW_R + ch]; break; case 1: v = A.in[I_MU][RW_K + ch]; break; case 2: v = A.in[I_MU][RW_V + ch]; break; case 3: v = A.in[I_W0][ch]; break; case 4: v = A.in[I_A0][ch]; break;
                       case 5: v = A.in[I_KK][ch]; break; case 6: v = A.in[I_KA][ch]; break; case 7: v = A.in[I_RK][ch]; break; case 8: v = A.in[I_LNW][ch]; break; default: v = A.in[I_LNB][ch]; break; }
        Lf[O_CONST + i] = v; }
    const int hx = tid >> 8, tl = (tid >> 4) & 15, d4 = (tid & 15) * 4, ch4 = hx * 64 + d4, col4 = hp * 128 + ch4;
    u32x2 rr[2], rk[2], rv[2], rlw, rla, rg_cur = {0u, 0u}, rg_nxt = {0u, 0u}, rg_far = {0u, 0u};
#define RM_LOAD(c) do { const int t_ = (c) * TC + tl; const bf16* pr = P + (size_t)t_ * PROJ_LD + col4; \
        rr[0] = *(const GAS u32x2*)(pr + RW_R); rk[0] = *(const GAS u32x2*)(pr + RW_K); rv[0] = *(const GAS u32x2*)(pr + RW_V); \
        const bf16* pp_ = (t_ > 0) ? pr - PROJ_LD : pr; rr[1] = *(const GAS u32x2*)(pp_ + RW_R); rk[1] = *(const GAS u32x2*)(pp_ + RW_K); rv[1] = *(const GAS u32x2*)(pp_ + RW_V); \
        if (t_ == 0) { rr[1] = (u32x2){0u, 0u}; rk[1] = (u32x2){0u, 0u}; rv[1] = (u32x2){0u, 0u}; } \
        const bf16* lr = LO + (size_t)t_ * LORA_N + col4; rlw = *(const GAS u32x2*)(lr); rla = *(const GAS u32x2*)(lr + 1024); rg_far = *(const GAS u32x2*)(lr + 2048); } while (0)
#define RM_XFORM(bufi) do { LAS float* X_ = Lf + O_XF + hx * 5 * 1024 + tl * 64 + d4; \
        const f32x4 mur = *(const LAS f32x4*)(Lf + O_CONST + 0 * 128 + ch4), muk = *(const LAS f32x4*)(Lf + O_CONST + 1 * 128 + ch4), muv = *(const LAS f32x4*)(Lf + O_CONST + 2 * 128 + ch4); \
        const f32x4 w0_ = *(const LAS f32x4*)(Lf + O_CONST + 3 * 128 + ch4), a0_ = *(const LAS f32x4*)(Lf + O_CONST + 4 * 128 + ch4), kk_ = *(const LAS f32x4*)(Lf + O_CONST + 5 * 128 + ch4); \
        const f32x4 ka_ = *(const LAS f32x4*)(Lf + O_CONST + 6 * 128 + ch4), rk_ = *(const LAS f32x4*)(Lf + O_CONST + 7 * 128 + ch4); \
        const float r0[4] = {bf_lo(rr[0].x), bf_hi(rr[0].x), bf_lo(rr[0].y), bf_hi(rr[0].y)}, r1[4] = {bf_lo(rr[1].x), bf_hi(rr[1].x), bf_lo(rr[1].y), bf_hi(rr[1].y)}; \
        const float k0[4] = {bf_lo(rk[0].x), bf_hi(rk[0].x), bf_lo(rk[0].y), bf_hi(rk[0].y)}, k1[4] = {bf_lo(rk[1].x), bf_hi(rk[1].x), bf_lo(rk[1].y), bf_hi(rk[1].y)}; \
        const float v0[4] = {bf_lo(rv[0].x), bf_hi(rv[0].x), bf_lo(rv[0].y), bf_hi(rv[0].y)}, v1[4] = {bf_lo(rv[1].x), bf_hi(rv[1].x), bf_lo(rv[1].y), bf_hi(rv[1].y)}; \
        const float lw[4] = {bf_lo(rlw.x), bf_hi(rlw.x), bf_lo(rlw.y), bf_hi(rlw.y)}, la[4] = {bf_lo(rla.x), bf_hi(rla.x), bf_lo(rla.y), bf_hi(rla.y)}; \
        f32x4 r4, w4, k4, v4, kk4, b4; float skk = 0.f, sbs = 0.f; float aa[4]; \
        _Pragma("unroll") for (int i_ = 0; i_ < 4; ++i_) { const float r_ = r0[i_] + (r1[i_] - r0[i_]) * mur[i_], kx = k0[i_] + (k1[i_] - k0[i_]) * muk[i_], vx = v0[i_] + (v1[i_] - v0[i_]) * muv[i_]; \
            const float wd = __expf(-0.6065306597126334f * sigmoidf_(w0_[i_] + lw[i_])); const float a_ = sigmoidf_(a0_[i_] + la[i_]); \
            const float kk0 = kx * kk_[i_], km = kx * (1.f + (a_ - 1.f) * ka_[i_]); \
            r4[i_] = r_; w4[i_] = wd; k4[i_] = km; v4[i_] = vx; kk4[i_] = kk0; aa[i_] = a_; skk += kk0 * kk0; sbs += r_ * km * rk_[i_]; } \
        row_sum16_x2(skk, sbs); const float rkk = __builtin_amdgcn_rsqf(skk + EPS); \
        _Pragma("unroll") for (int i_ = 0; i_ < 4; ++i_) { kk4[i_] *= rkk; b4[i_] = kk4[i_] * aa[i_]; } \
        *(LAS f32x4*)(X_) = r4; *(LAS f32x4*)(X_ + 1024) = w4; *(LAS f32x4*)(X_ + 2048) = k4; *(LAS f32x4*)(X_ + 3072) = kk4; *(LAS f32x4*)(X_ + 4096) = b4; \
        *(LAS f32x4*)(Lf + O_VV + ((bufi) * 2 + hx) * 1024 + tl * 64 + d4) = v4; \
        if ((tid & 15) == 0) Lf[O_BS + ((bufi) * 2 + hx) * 16 + tl] = sbs; } while (0)
    const int c_begin = role ? NCHUNK / 2 : 0, c_end = role ? NCHUNK : NCHUNK / 2;
    constexpr int REC = 7584;
    float* STASH = (float*)(A.ws + (unit < 32 ? WS_WEV_IN : WS_END)) + (size_t)(unit & 31) * (NCHUNK / 2) * REC;
    float* STATE = (float*)(A.ws + WS_STATE + 4 * MiB) + (size_t)unit * 8192;
    gu32* flag = F.ctl + 49152 + unit * 64;
    LBAR();
    RM_LOAD(c_begin); RM_XFORM(c_begin & 1); rg_cur = rg_far; RM_LOAD(c_begin + 1); rg_nxt = rg_far;
    LBAR();
    f32x4 Macc[4];
#pragma unroll
    for (int i = 0; i < 4; ++i) Macc[i] = (f32x4){0.f, 0.f, 0.f, 0.f};
    const int fr = lane & 15, g = lane >> 4, hh = w >> 2, ww = w & 3, c0 = ww * 16;
    LAS float* IM = Lf + O_IMG + hh * IMGSZ;
    LAS bf16* CT = (LAS bf16*)(IM + I_CT); LAS bf16* BT = (LAS bf16*)(IM + I_BT); LAS bf16* KL = (LAS bf16*)(IM + I_KL); LAS bf16* RT = (LAS bf16*)(IM + I_RT);
    LAS bf16* BTT = (LAS bf16*)(IM + I_BTT); LAS bf16* KTT = (LAS bf16*)(IM + I_KTT); LAS bf16* WCB = (LAS bf16*)(IM + I_WCB);
    LAS bf16* G1B = (LAS bf16*)(IM + I_G1B); LAS bf16* TTB = (LAS bf16*)(IM + I_TTB); LAS bf16* RKB = (LAS bf16*)(IM + I_RKB); LAS bf16* RBB = (LAS bf16*)(IM + I_RBB);
    const u32x2 zz = {0u, 0u};
#define RM_STATE_PART(vb) do { \
        { \
            bf16x8 mb[2]; \
_Pragma("unroll") \
            for (int ks = 0; ks < 2; ++ks) { u32x2 slo, shi; slo.x = hw_pk2(Macc[2 * ks][0], Macc[2 * ks][1]); slo.y = hw_pk2(Macc[2 * ks][2], Macc[2 * ks][3]); shi.x = hw_pk2(Macc[2 * ks + 1][0], Macc[2 * ks + 1][1]); shi.y = hw_pk2(Macc[2 * ks + 1][2], Macc[2 * ks + 1][3]); \
                mb[ks] = mk_frag(slo, shi); } \
            f32x4 accR = accU, acco = {0.f, 0.f, 0.f, 0.f}; \
_Pragma("unroll") \
            for (int ks = 0; ks < 2; ++ks) { \
                accR = __builtin_amdgcn_mfma_f32_16x16x32_bf16(mk_frag(*(const LAS u32x2*)(WCB + fr * RS + 32 * ks + 4 * g), *(const LAS u32x2*)(WCB + fr * RS + 32 * ks + 16 + 4 * g)), mb[ks], accR, 0, 0, 0); \
                acco = __builtin_amdgcn_mfma_f32_16x16x32_bf16(mk_frag(*(const LAS u32x2*)(RT + fr * RS + 32 * ks + 4 * g), *(const LAS u32x2*)(RT + fr * RS + 32 * ks + 16 + 4 * g)), mb[ks], acco, 0, 0, 0); } \
            u32x2 rn; rn.x = hw_pk2(accR[0], accR[1]); rn.y = hw_pk2(accR[2], accR[3]); \
            const bf16x8 rb = mk_frag(rn, zz); \
            acco = __builtin_amdgcn_mfma_f32_16x16x32_bf16(mk_frag(*(const LAS u32x2*)(RKB + fr * 16 + 4 * g), zz), vb, acco, 0, 0, 0); \
            acco = __builtin_amdgcn_mfma_f32_16x16x32_bf16(mk_frag(*(const LAS u32x2*)(RBB + fr * 16 + 4 * g), zz), rb, acco, 0, 0, 0); \
_Pragma("unroll") \
            for (int r = 0; r < 4; ++r) IM[I_OUT + (4 * g + r) * 64 + c0 + fr] = acco[r]; \
_Pragma("unroll") \
            for (int i = 0; i < 4; ++i) { const f32x4 w15 = *(const LAS f32x4*)(IM + I_W15 + 16 * i + 4 * g); \
                f32x4 m = __builtin_amdgcn_mfma_f32_16x16x32_bf16(mk_frag(*(const LAS u32x2*)(KTT + (16 * i + fr) * 16 + 4 * g), zz), vb, Macc[i], 0, 0, 0); \
                m = __builtin_amdgcn_mfma_f32_16x16x32_bf16(mk_frag(*(const LAS u32x2*)(BTT + (16 * i + fr) * 16 + 4 * g), zz), rb, m, 0, 0, 0); \
                Macc[i] = m * w15; } \
        } \
        } while (0)
#define RM_FLUSH(cc_, gb_, vv_, bs_) do { \
        { \
            const f32x4 o4 = *(const LAS f32x4*)(Lf + O_IMG + hx * IMGSZ + I_OUT + tl * 64 + d4); const f32x4 vv = (vv_); const float bs = (bs_); \
            const f32x4 lnw = *(const LAS f32x4*)(Lf + O_CONST + 8 * 128 + ch4), lnb = *(const LAS f32x4*)(Lf + O_CONST + 9 * 128 + ch4); \
            float sm = (o4[0] + o4[1]) + (o4[2] + o4[3]), dummy = 0.f; row_sum16_x2(sm, dummy); const float mean = sm * (1.0f / 64.0f); \
            const f32x4 e4 = o4 - mean; float sv = (e4[0] * e4[0] + e4[1] * e4[1]) + (e4[2] * e4[2] + e4[3] * e4[3]); row_sum16_x2(sv, dummy); const float rs = __builtin_amdgcn_rsqf(sv * (1.0f / 64.0f) + 64e-5f); \
            const float gg[4] = {bf_lo((gb_).x), bf_hi((gb_).x), bf_lo((gb_).y), bf_hi((gb_).y)}; \
            float y[4]; \
_Pragma("unroll") \
            for (int i = 0; i < 4; ++i) y[i] = (e4[i] * rs * lnw[i] + lnb[i] + bs * vv[i]) * gg[i]; \
            u32x2 o; o.x = hw_pk2(y[0], y[1]); o.y = hw_pk2(y[2], y[3]); \
            *(GAS u32x2*)(Y + (size_t)((cc_) * TC + tl) * D + col4) = o; \
        } \
        } while (0)
    for (int c = c_begin; c < c_end; ++c) {
        {
            const int hq = tid >> 8, seg = (tid >> 6) & 3, d = tid & 63;
            const LAS float* X_ = Lf + O_XF + hq * 5 * 1024 + d; LAS float* IQ = Lf + O_IMG + hq * IMGSZ;
            LAS bf16* CTq = (LAS bf16*)(IQ + I_CT); LAS bf16* BTq = (LAS bf16*)(IQ + I_BT); LAS bf16* KLq = (LAS bf16*)(IQ + I_KL); LAS bf16* RTq = (LAS bf16*)(IQ + I_RT);
            float wall = 1.f, wpre = 1.f;
#pragma unroll
            for (int t = 0; t < 16; ++t) { if (t == 4 * seg) wpre = wall; wall *= X_[1024 + t * 64]; }
            float wt = wpre; unsigned short bt4[4], kt4[4];
#pragma unroll
            for (int i = 0; i < 4; ++i) { const int t = 4 * seg + i; const float wprev = wt; wt *= X_[1024 + t * 64]; const float iw = __builtin_amdgcn_rcpf(wt);
                const float r_ = X_[t * 64], k_ = X_[2048 + t * 64], kk_ = X_[3072 + t * 64], b_ = X_[4096 + t * 64];
                const float ct = kk_ * wprev, bt = b_ * iw, kt = k_ * iw;
                CTq[t * RS + d] = hw_bf(ct); IQ[I_CF + t * 64 + d] = ct; BTq[t * RS + d] = hw_bf(bt); KLq[t * RS + d] = hw_bf(kt); RTq[t * RS + d] = hw_bf(r_ * wt);
                bt4[i] = (unsigned short)hw_bf(-bt); kt4[i] = (unsigned short)hw_bf(kt); }
            u32x2 o; o.x = (unsigned)bt4[0] | ((unsigned)bt4[1] << 16); o.y = (unsigned)bt4[2] | ((unsigned)bt4[3] << 16); *(LAS u32x2*)((LAS bf16*)(IQ + I_BTT) + d * 16 + 4 * seg) = o;
            o.x = (unsigned)kt4[0] | ((unsigned)kt4[1] << 16); o.y = (unsigned)kt4[2] | ((unsigned)kt4[3] << 16); *(LAS u32x2*)((LAS bf16*)(IQ + I_KTT) + d * 16 + 4 * seg) = o;
            if (seg == 3) IQ[I_W15 + d] = wall;
        }
        LBAR();
        if (ww == 0) {
            f32x4 cb = {0.f, 0.f, 0.f, 0.f}, bc = cb, ck = cb, rkm = cb, rbm = cb;
#pragma unroll
            for (int ks = 0; ks < 2; ++ks) { const bf16x8 fc = *(const LAS bf16x8*)(CT + fr * RS + 32 * ks + 8 * g), fb = *(const LAS bf16x8*)(BT + fr * RS + 32 * ks + 8 * g), fk = *(const LAS bf16x8*)(KL + fr * RS + 32 * ks + 8 * g), frr = *(const LAS bf16x8*)(RT + fr * RS + 32 * ks + 8 * g);
                cb = __builtin_amdgcn_mfma_f32_16x16x32_bf16(fc, fb, cb, 0, 0, 0); bc = __builtin_amdgcn_mfma_f32_16x16x32_bf16(fb, fc, bc, 0, 0, 0); ck = __builtin_amdgcn_mfma_f32_16x16x32_bf16(fc, fk, ck, 0, 0, 0);
                rkm = __builtin_amdgcn_mfma_f32_16x16x32_bf16(frr, fk, rkm, 0, 0, 0); rbm = __builtin_amdgcn_mfma_f32_16x16x32_bf16(frr, fb, rbm, 0, 0, 0); }
            f32x4 N1, M1, CKm;
#pragma unroll
            for (int r = 0; r < 4; ++r) { const int t = 4 * g + r; N1[r] = (fr < t) ? -cb[r] : 0.f; M1[r] = (t < fr) ? -bc[r] : 0.f; CKm[r] = (fr < t) ? ck[r] : 0.f;
                RKB[t * 16 + fr] = hw_bf((fr <= t) ? rkm[r] : 0.f); RBB[t * 16 + fr] = hw_bf((fr <= t) ? -rbm[r] : 0.f); }
#define XTY(X, Y, C0) __builtin_amdgcn_mfma_f32_16x16x32_bf16(mk_frag((u32x2){hw_pk2(X[0], X[1]), hw_pk2(X[2], X[3])}, zz), mk_frag((u32x2){hw_pk2(Y[0], Y[1]), hw_pk2(Y[2], Y[3])}, zz), C0, 0, 0, 0)
            const f32x4 z4 = {0.f, 0.f, 0.f, 0.f};
            f32x4 T1t = M1;
#pragma unroll
            for (int r = 0; r < 4; ++r) if (4 * g + r == fr) T1t[r] += 1.f;
            const f32x4 N2 = XTY(M1, N1, z4), M2 = XTY(N1, M1, z4);
            const f32x4 T2t = XTY(N2, T1t, T1t);
            const f32x4 N4 = XTY(M2, N2, z4), M4 = XTY(N2, M2, z4);
            const f32x4 T4t = XTY(N4, T2t, T2t);
            const f32x4 N8 = XTY(M4, N4, z4);
            const f32x4 T8t = XTY(N8, T4t, T4t);
            const f32x4 G1t = XTY(CKm, T8t, z4);
#undef XTY
            u32x2 tw; tw.x = hw_pk2(T8t[0], T8t[1]); tw.y = hw_pk2(T8t[2], T8t[3]); *(LAS u32x2*)(TTB + fr * 16 + 4 * g) = tw;
            tw.x = hw_pk2(G1t[0], G1t[1]); tw.y = hw_pk2(G1t[2], G1t[3]); *(LAS u32x2*)(G1B + fr * 16 + 4 * g) = tw;
        }
        if (c + 1 < c_end) { RM_XFORM((c + 1) & 1); }
        if (c + 2 < c_end) RM_LOAD(c + 2);
        LBAR();
        const LAS float* VVc = Lf + O_VV + ((c & 1) * 2 + hh) * 1024;
        u32x2 vlo; { vlo.x = hw_pk2(VVc[(4 * g + 0) * 64 + c0 + fr], VVc[(4 * g + 1) * 64 + c0 + fr]); vlo.y = hw_pk2(VVc[(4 * g + 2) * 64 + c0 + fr], VVc[(4 * g + 3) * 64 + c0 + fr]); }
        const bf16x8 vb = mk_frag(vlo, zz);
        f32x4 accU = {0.f, 0.f, 0.f, 0.f};
        {
            accU = __builtin_amdgcn_mfma_f32_16x16x32_bf16(mk_frag(*(const LAS u32x2*)(G1B + fr * 16 + 4 * g), zz), vb, accU, 0, 0, 0);
            u32x2 clo; clo.x = hw_pk2(IM[I_CF + (4 * g + 0) * 64 + c0 + fr], IM[I_CF + (4 * g + 1) * 64 + c0 + fr]); clo.y = hw_pk2(IM[I_CF + (4 * g + 2) * 64 + c0 + fr], IM[I_CF + (4 * g + 3) * 64 + c0 + fr]);
            f32x4 accw = {0.f, 0.f, 0.f, 0.f};
            accw = __builtin_amdgcn_mfma_f32_16x16x32_bf16(mk_frag(*(const LAS u32x2*)(TTB + fr * 16 + 4 * g), zz), mk_frag(clo, zz), accw, 0, 0, 0);
#pragma unroll
            for (int r = 0; r < 4; ++r) WCB[(4 * g + r) * RS + c0 + fr] = hw_bf(accw[r]);
        }
        LBAR();
        if (role == 0) {
            RM_STATE_PART(vb);
            LBAR();
            RM_FLUSH(c, rg_cur, *(const LAS f32x4*)(Lf + O_VV + ((c & 1) * 2 + hx) * 1024 + tl * 64 + d4), Lf[O_BS + ((c & 1) * 2 + hx) * 16 + tl]);
        } else {
            float* rec = STASH + (size_t)(c - c_begin) * REC;
            for (int i = tid; i < 1376; i += NTHREADS) { const int hd = i >= 688, j = i - hd * 688; const int o = O_IMG + hd * IMGSZ + (j < 144 ? I_RT + 4 * j : I_BTT + 4 * (j - 144)); *(GAS f32x4*)(rec + 4 * i) = *(const LAS f32x4*)(Lf + o); }
            { GAS unsigned* ru = (GAS unsigned*)(rec + 5504); ru[(w * 2 + 0) * 64 + lane] = hw_pk2(accU[0], accU[1]); ru[(w * 2 + 1) * 64 + lane] = hw_pk2(accU[2], accU[3]); }
            { const f32x4 v4 = *(const LAS f32x4*)(Lf + O_VV + ((c & 1) * 2 + hx) * 1024 + tl * 64 + d4); u32x2 o; o.x = hw_pk2(v4[0], v4[1]); o.y = hw_pk2(v4[2], v4[3]); *(GAS u32x2*)(rec + 6528 + 2 * tid) = o; }
            if (tid < 32) rec[7552 + tid] = Lf[O_BS + (c & 1) * 32 + tid];
            LBAR();
        }
        rg_cur = rg_nxt; rg_nxt = rg_far;
    }
    if (role == 0) {
#pragma unroll
        for (int i = 0; i < 4; ++i)
#pragma unroll
            for (int r = 0; r < 4; ++r) STATE[((w * 4 + i) * 4 + r) * 64 + lane] = Macc[i][r];
        asm volatile("s_waitcnt vmcnt(0)" ::: "memory");
        __syncthreads();
        if (tid == 0) { __builtin_amdgcn_fence(__ATOMIC_RELEASE, "agent"); asm volatile("s_waitcnt vmcnt(0)" ::: "memory"); __hip_atomic_store(flag, 1u, __ATOMIC_RELAXED, __HIP_MEMORY_SCOPE_AGENT); }
    } else {
        if (tid == 0) { unsigned sp = 0; while (__hip_atomic_load(flag, __ATOMIC_RELAXED, __HIP_MEMORY_SCOPE_AGENT) == 0u) { __builtin_amdgcn_s_sleep(8); if (++sp > (1u << 22)) break; }
            __builtin_amdgcn_fence(__ATOMIC_ACQUIRE, "agent"); asm volatile("s_waitcnt vmcnt(0)" ::: "memory"); }
        __syncthreads();
#pragma unroll
        for (int i = 0; i < 4; ++i)
#pragma unroll
            for (int r = 0; r < 4; ++r) Macc[i][r] = STATE[((w * 4 + i) * 4 + r) * 64 + lane];
        f32x4 pi0, pi1, pi2; unsigned pu0, pu1; u32x2 pv, pgate; float pbs;
#define RM_REC_LOAD(cc) do { const float* rec = STASH + (size_t)((cc) - c_begin) * REC; pi0 = *(const GAS f32x4*)(rec + 4 * tid); pi1 = *(const GAS f32x4*)(rec + 4 * (tid + 512)); \
            pi2 = (tid < 352) ? *(const GAS f32x4*)(rec + 4 * (tid + 1024)) : (f32x4){0.f, 0.f, 0.f, 0.f}; \
            const GAS unsigned* ru = (const GAS unsigned*)(rec + 5504); pu0 = ru[(w * 2 + 0) * 64 + lane]; pu1 = ru[(w * 2 + 1) * 64 + lane]; pv = *(const GAS u32x2*)(rec + 6528 + 2 * tid); pbs = rec[7552 + hx * 16 + tl]; \
            pgate = *(const GAS u32x2*)(LO + (size_t)((cc) * TC + tl) * LORA_N + col4 + 2048); } while (0)
#define RM_IMG_OFF(i_) (O_IMG + ((i_) >= 688) * IMGSZ + ((((i_) - ((i_) >= 688) * 688) < 144) ? I_RT + 4 * ((i_) - ((i_) >= 688) * 688) : I_BTT + 4 * (((i_) - ((i_) >= 688) * 688) - 144)))
        RM_REC_LOAD(c_begin);
        for (int c = c_begin; c < c_end; ++c) {
            *(LAS f32x4*)(Lf + RM_IMG_OFF(tid)) = pi0; *(LAS f32x4*)(Lf + RM_IMG_OFF(tid + 512)) = pi1; if (tid < 352) *(LAS f32x4*)(Lf + RM_IMG_OFF(tid + 1024)) = pi2;
            const f32x4 vcur = {bf_lo(pv.x), bf_hi(pv.x), bf_lo(pv.y), bf_hi(pv.y)}; *(LAS f32x4*)(Lf + O_VV + hx * 1024 + tl * 64 + d4) = vcur;
            const f32x4 accU = {bf_lo(pu0), bf_hi(pu0), bf_lo(pu1), bf_hi(pu1)}; const float bscur = pbs; const u32x2 gcur = pgate;
            if (c + 1 < c_end) RM_REC_LOAD(c + 1);
            LBAR();
            const LAS float* VVc = Lf + O_VV + hh * 1024;
            u32x2 vlo; { vlo.x = hw_pk2(VVc[(4 * g + 0) * 64 + c0 + fr], VVc[(4 * g + 1) * 64 + c0 + fr]); vlo.y = hw_pk2(VVc[(4 * g + 2) * 64 + c0 + fr], VVc[(4 * g + 3) * 64 + c0 + fr]); }
            const bf16x8 vb = mk_frag(vlo, zz);
            RM_STATE_PART(vb);
            LBAR();
            RM_FLUSH(c, gcur, vcur, bscur);
            LBAR();
        }
#undef RM_REC_LOAD
#undef RM_IMG_OFF
    }
#undef RM_STATE_PART
#undef RM_FLUSH
#undef RM_LOAD
#undef RM_XFORM
}

__device__ __forceinline__ int med3i(int a, int b, int c) { int r; asm("v_med3_i32 %0, %1, %2, %3" : "=v"(r) : "v"(a), "v"(b), "v"(c)); return r; }
__device__ __forceinline__ int f2sort(float f) { int x = __float_as_int(f); return x ^ ((x >> 31) & 0x7fffffff); }
__device__ __forceinline__ float sort2f(int x) { return __int_as_float(x ^ ((x >> 31) & 0x7fffffff)); }
#define TOPK_INSERT(vals, x) do { _Pragma("unroll") for (int s_ = 15; s_ >= 1; --s_) vals[s_] = med3i((x), vals[s_ - 1], vals[s_]); vals[0] = max(vals[0], (x)); } while (0)
__device__ __forceinline__ float bf_dot2(unsigned a, unsigned b, float c) {
    return c + bf_lo(a) * bf_lo(b) + bf_hi(a) * bf_hi(b);
}
__device__ __forceinline__ void sum8_x8(float (&a)[8]) {
    asm("s_nop 1\n\t"
        "v_add_f32_dpp %0, %0, %0 quad_perm:[1,0,3,2] row_mask:0xf bank_mask:0xf\n\tv_add_f32_dpp %1, %1, %1 quad_perm:[1,0,3,2] row_mask:0xf bank_mask:0xf\n\t"
        "v_add_f32_dpp %2, %2, %2 quad_perm:[1,0,3,2] row_mask:0xf bank_mask:0xf\n\tv_add_f32_dpp %3, %3, %3 quad_perm:[1,0,3,2] row_mask:0xf bank_mask:0xf\n\t"
        "v_add_f32_dpp %4, %4, %4 quad_perm:[1,0,3,2] row_mask:0xf bank_mask:0xf\n\tv_add_f32_dpp %5, %5, %5 quad_perm:[1,0,3,2] row_mask:0xf bank_mask:0xf\n\t"
        "v_add_f32_dpp %6, %6, %6 quad_perm:[1,0,3,2] row_mask:0xf bank_mask:0xf\n\tv_add_f32_dpp %7, %7, %7 quad_perm:[1,0,3,2] row_mask:0xf bank_mask:0xf\n\t"
        "v_add_f32_dpp %0, %0, %0 quad_perm:[2,3,0,1] row_mask:0xf bank_mask:0xf\n\tv_add_f32_dpp %1, %1, %1 quad_perm:[2,3,0,1] row_mask:0xf bank_mask:0xf\n\t"
        "v_add_f32_dpp %2, %2, %2 quad_perm:[2,3,0,1] row_mask:0xf bank_mask:0xf\n\tv_add_f32_dpp %3, %3, %3 quad_perm:[2,3,0,1] row_mask:0xf bank_mask:0xf\n\t"
        "v_add_f32_dpp %4, %4, %4 quad_perm:[2,3,0,1] row_mask:0xf bank_mask:0xf\n\tv_add_f32_dpp %5, %5, %5 quad_perm:[2,3,0,1] row_mask:0xf bank_mask:0xf\n\t"
        "v_add_f32_dpp %6, %6, %6 quad_perm:[2,3,0,1] row_mask:0xf bank_mask:0xf\n\tv_add_f32_dpp %7, %7, %7 quad_perm:[2,3,0,1] row_mask:0xf bank_mask:0xf\n\t"
        "v_add_f32_dpp %0, %0, %0 row_half_mirror row_mask:0xf bank_mask:0xf\n\tv_add_f32_dpp %1, %1, %1 row_half_mirror row_mask:0xf bank_mask:0xf\n\t"
        "v_add_f32_dpp %2, %2, %2 row_half_mirror row_mask:0xf bank_mask:0xf\n\tv_add_f32_dpp %3, %3, %3 row_half_mirror row_mask:0xf bank_mask:0xf\n\t"
        "v_add_f32_dpp %4, %4, %4 row_half_mirror row_mask:0xf bank_mask:0xf\n\tv_add_f32_dpp %5, %5, %5 row_half_mirror row_mask:0xf bank_mask:0xf\n\t"
        "v_add_f32_dpp %6, %6, %6 row_half_mirror row_mask:0xf bank_mask:0xf\n\tv_add_f32_dpp %7, %7, %7 row_half_mirror row_mask:0xf bank_mask:0xf\n\t"
        "s_nop 1"
        : "+v"(a[0]), "+v"(a[1]), "+v"(a[2]), "+v"(a[3]), "+v"(a[4]), "+v"(a[5]), "+v"(a[6]), "+v"(a[7]));
}
__device__ __forceinline__ float sum8_x1(float v) {
    asm("s_nop 1\n\tv_add_f32_dpp %0, %0, %0 quad_perm:[1,0,3,2] row_mask:0xf bank_mask:0xf\n\ts_nop 1\n\tv_add_f32_dpp %0, %0, %0 quad_perm:[2,3,0,1] row_mask:0xf bank_mask:0xf\n\ts_nop 1\n\t"
        "v_add_f32_dpp %0, %0, %0 row_half_mirror row_mask:0xf bank_mask:0xf\n\ts_nop 1" : "+v"(v));
    return v;
}
__device__ __forceinline__ void peer_phase(const Args& A, Frame& F, int L, const bool dry) {
    int lane = F.lane; asm volatile("" : "+v"(lane));
    const int gw = F.vcu * NWAVES + F.wave;
    const bf16* SCR = (const bf16*)(A.ws + WS_SC); const bf16* X = (const bf16*)(A.ws + WS_ACTB); bf16* HG = (bf16*)(A.ws + WS_ACTA);
    const unsigned char* TU = (const unsigned char*)(A.ws + WS_TABU) + (size_t)L * 16384 * D; const unsigned char* TV = (const unsigned char*)(A.ws + WS_TABV) + (size_t)L * 16384 * D;
    const float* rowss = (const float*)(A.ws + WS_RSP) + (size_t)(L == 0 ? RS_FFN0 : RS_FFN1) * T * 32;
    const float* gple = A.in[I_NPLE] + (size_t)L * D;
    float* H = A.out;
    LAS unsigned* LIST = (LAS unsigned*)(F.lds + RING_OFF + F.wave * 16384);
    LAS unsigned* EIDX = LIST + 1024;
    LAS float* ECOEF = (LAS float*)(EIDX + 1024);
    const int tbase = gw * 8;
    if (tbase >= T) return;
    for (int half = 0; half < 2; ++half) {
        const int t0 = tbase + 4 * half;
        {
            const bf16* sp = SCR + (size_t)(t0 + (lane >> 4)) * D + (lane & 15) * 128;
            int vals[16];
#pragma unroll
            for (int s = 0; s < 16; ++s) vals[s] = (int)0x80000000;
#pragma unroll 2
            for (int c = 0; c < 16; ++c) { const v4u wv = *(const GAS v4u*)(sp + c * 8); const unsigned ww[4] = {wv.x, wv.y, wv.z, wv.w};
#pragma unroll
                for (int e = 0; e < 8; ++e) { const unsigned bits = (e & 1) ? (ww[e >> 1] & 0xffff0000u) : (ww[e >> 1] << 16);
                    int x = (int)bits; x ^= (x >> 31) & 0x7fffffff; x = (x & ~0x7f) | (127 - (c * 8 + e));
                    TOPK_INSERT(vals, x); } }
#pragma unroll
            for (int q = 0; q < 4; ++q) { v4u o; o.x = (unsigned)vals[4 * q]; o.y = (unsigned)vals[4 * q + 1]; o.z = (unsigned)vals[4 * q + 2]; o.w = (unsigned)vals[4 * q + 3]; *(LAS v4u*)(LIST + lane * 16 + 4 * q) = o; }
        }
        LDS_WAIT(); asm volatile("" ::: "memory");
        if (lane < 32) {
            const LAS unsigned* la = LIST + ((lane >> 3) * 16 + (lane & 7) * 2) * 16; const LAS unsigned* lb2 = la + 16;
            float av[16], bv[16];
#pragma unroll
            for (int q = 0; q < 4; ++q) { const v4u a4 = *(const LAS v4u*)(la + 4 * q), b4 = *(const LAS v4u*)(lb2 + 4 * q); const unsigned aw[4] = {a4.x, a4.y, a4.z, a4.w}, bw[4] = {b4.x, b4.y, b4.z, b4.w};
#pragma unroll
                for (int e = 0; e < 4; ++e) { av[4 * q + e] = __uint_as_float(__float_as_uint(sort2f((int)(aw[e] & ~0x7fu))) & 0xffff0000u); bv[4 * q + e] = __uint_as_float(__float_as_uint(sort2f((int)(bw[e] & ~0x7fu))) & 0xffff0000u); } }
            int best[16];
#pragma unroll
            for (int s = 0; s < 16; ++s) best[s] = (int)0x80000000;
#pragma unroll
            for (int i = 0; i < 16; ++i)
#pragma unroll
                for (int jx = 0; jx < 16; ++jx) if ((i + 1) * (jx + 1) <= 16) { int x = f2sort(av[i] + bv[jx]); x = (x & ~0xff) | (255 - (i * 16 + jx)); TOPK_INSERT(best, x); }
            float sv[16]; unsigned ex[16];
#pragma unroll
            for (int s = 0; s < 16; ++s) { const int cand = 255 - (best[s] & 0xff); const unsigned ka = la[cand >> 4], kb = lb2[cand & 15];
                ex[s] = (127u - (ka & 0x7fu)) * 128u + (127u - (kb & 0x7fu));
                sv[s] = __uint_as_float(__float_as_uint(sort2f((int)(ka & ~0x7fu))) & 0xffff0000u) + __uint_as_float(__float_as_uint(sort2f((int)(kb & ~0x7fu))) & 0xffff0000u); }
            float mx = sv[0];
#pragma unroll
            for (int s = 1; s < 16; ++s) mx = fmaxf(mx, sv[s]);
            float den = 0.f;
#pragma unroll
            for (int s = 0; s < 16; ++s) { sv[s] = __expf(sv[s] - mx); den += sv[s]; }
            const float inv = 1.0f / den; const int base = (4 * half + (lane >> 3)) * 128 + (lane & 7) * 16;
#pragma unroll
            for (int s = 0; s < 16; ++s) { EIDX[base + s] = ex[s]; ECOEF[base + s] = sv[s] * inv; }
        }
        LDS_WAIT(); asm volatile("" ::: "memory");
    }
    const int tk = lane >> 3, part = lane & 7, t = tbase + tk;
    const LAS unsigned* eidx = EIDX + tk * 128; LAS float* ecoef = ECOEF + tk * 128;
    const float rs = __builtin_amdgcn_rsqf(sum8_x1(((const GAS f32x4*)(rowss + (size_t)t * 32))[part][0] + ((const GAS f32x4*)(rowss + (size_t)t * 32))[part][1] + ((const GAS f32x4*)(rowss + (size_t)t * 32))[part][2] + ((const GAS f32x4*)(rowss + (size_t)t * 32))[part][3]) * (1.0f / D) + EPS) * (1.0f / 512.0f);
#define PEER_LOAD8(dst, TAB, i0, soff) do { const v4u ia_ = *(const LAS v4u*)(eidx + (i0)), ib_ = *(const LAS v4u*)(eidx + (i0) + 4); const unsigned ee_[8] = {ia_.x, ia_.y, ia_.z, ia_.w, ib_.x, ib_.y, ib_.z, ib_.w}; \
        _Pragma("unroll") for (int j_ = 0; j_ < 8; ++j_) dst[j_] = *(const GAS v4u*)((TAB) + (size_t)(ee_[j_] * 2048u + (unsigned)(soff))); } while (0)
    LAS float* dotw = (LAS float*)LIST + tk * 128;
#pragma unroll
    for (int m = 0; m < 16; ++m) dotw[8 * m + part] = 0.f;
#pragma unroll 1
    for (int p = 0; p < 16; ++p) {
        const int soff = 128 * p + 16 * part;
        float xs[16];
        { const v4u x0 = *(const GAS v4u*)(X + (size_t)t * D + soff), x1 = *(const GAS v4u*)(X + (size_t)t * D + soff + 8); const unsigned xw[8] = {x0.x, x0.y, x0.z, x0.w, x1.x, x1.y, x1.z, x1.w};
#pragma unroll
          for (int e = 0; e < 8; ++e) { xs[2 * e] = bf_lo(xw[e]); xs[2 * e + 1] = bf_hi(xw[e]); } }
#define PEER_UDOT8(src, m_) do { float tt_[8]; \
        _Pragma("unroll") for (int j_ = 0; j_ < 8; ++j_) { const unsigned ww_[4] = {src[j_].x, src[j_].y, src[j_].z, src[j_].w}; float a0_ = 0.f, a1_ = 0.f; \
            _Pragma("unroll") for (int e_ = 0; e_ < 4; ++e_) { const f32x2 lo_ = __builtin_amdgcn_cvt_pk_f32_fp8((int)ww_[e_], false), hi_ = __builtin_amdgcn_cvt_pk_f32_fp8((int)ww_[e_], true); \
                a0_ += xs[4 * e_] * lo_[0]; a1_ += xs[4 * e_ + 1] * lo_[1]; a0_ += xs[4 * e_ + 2] * hi_[0]; a1_ += xs[4 * e_ + 3] * hi_[1]; } \
            tt_[j_] = a0_ + a1_; } \
        sum8_x8(tt_); \
        float sel_ = tt_[0]; _Pragma("unroll") for (int j_ = 1; j_ < 8; ++j_) sel_ = (part == j_) ? tt_[j_] : sel_; \
        dotw[8 * (m_) + part] += sel_; } while (0)
        v4u ua[8], ub[8];
        PEER_LOAD8(ua, TU, 0, soff);
#pragma unroll 1
        for (int m = 0; m < 16; m += 2) {
            PEER_LOAD8(ub, TU, 8 * (m + 1), soff);
            PEER_UDOT8(ua, m);
            if (m + 2 < 16) PEER_LOAD8(ua, TU, 8 * (m + 2), soff);
            PEER_UDOT8(ub, m + 1);
        }
    }
#undef PEER_UDOT8
#pragma unroll
    for (int m = 0; m < 16; ++m) { const float d_ = dotw[8 * m + part] * rs; const float act = 0.5f * d_ * (1.0f + erff(d_ * 0.7071067811865476f)); ecoef[8 * m + part] *= act * (1.0f / 16.0f); }
    LDS_WAIT(); asm volatile("" ::: "memory");
    float ss = 0.f;
#pragma unroll 1
    for (int p = 0; p < 16; ++p) {
        const int soff = 128 * p + 16 * part;
        float acc[16];
#pragma unroll
        for (int i = 0; i < 16; ++i) acc[i] = 0.f;
#define PEER_VACC8(src, i0) do { const f32x4 ca_ = *(const LAS f32x4*)(ecoef + (i0)), cb_ = *(const LAS f32x4*)(ecoef + (i0) + 4); const float cf_[8] = {ca_[0], ca_[1], ca_[2], ca_[3], cb_[0], cb_[1], cb_[2], cb_[3]}; \
        _Pragma("unroll") for (int j_ = 0; j_ < 8; ++j_) { const unsigned ww_[4] = {src[j_].x, src[j_].y, src[j_].z, src[j_].w}; \
            _Pragma("unroll") for (int e_ = 0; e_ < 4; ++e_) { const f32x2 lo_ = __builtin_amdgcn_cvt_pk_f32_fp8((int)ww_[e_], false), hi_ = __builtin_amdgcn_cvt_pk_f32_fp8((int)ww_[e_], true); \
                acc[4 * e_] += cf_[j_] * lo_[0]; acc[4 * e_ + 1] += cf_[j_] * lo_[1]; acc[4 * e_ + 2] += cf_[j_] * hi_[0]; acc[4 * e_ + 3] += cf_[j_] * hi_[1]; } } } while (0)
        v4u va[8], vb[8];
        PEER_LOAD8(va, TV, 0, soff);
#pragma unroll 1
        for (int m = 0; m < 16; m += 2) {
            PEER_LOAD8(vb, TV, 8 * (m + 1), soff);
            PEER_VACC8(va, 8 * m);
            if (m + 2 < 16) PEER_LOAD8(va, TV, 8 * (m + 2), soff);
            PEER_VACC8(vb, 8 * (m + 1));
        }
        GAS f32x4* hp = (GAS f32x4*)(H + (size_t)t * D + soff);
#pragma unroll
        for (int q = 0; q < 4; ++q) { f32x4 h0 = hp[q];
#pragma unroll
            for (int e = 0; e < 4; ++e) { h0[e] += acc[4 * q + e]; ss += h0[e] * h0[e]; }
            if (!dry) hp[q] = h0; else asm volatile("" :: "v"(h0[0]), "v"(h0[1]), "v"(h0[2]), "v"(h0[3])); }
    }
#undef PEER_VACC8
#undef PEER_LOAD8
    const float r3 = __builtin_amdgcn_rsqf(sum8_x1(ss) * (1.0f / D) + EPS);
    if (!dry) {
#pragma unroll 2
        for (int p = 0; p < 16; ++p) { const int soff = 128 * p + 16 * part; const GAS f32x4* hp = (const GAS f32x4*)(H + (size_t)t * D + soff); const GAS f32x4* gp = (const GAS f32x4*)(gple + soff);
            unsigned ow[8];
#pragma unroll
            for (int q = 0; q < 4; ++q) { const f32x4 h0 = hp[q], g0 = gp[q]; ow[2 * q] = pk2(h0[0] * r3 * g0[0], h0[1] * r3 * g0[1]); ow[2 * q + 1] = pk2(h0[2] * r3 * g0[2], h0[3] * r3 * g0[3]); }
            v4u o0, o1; o0.x = ow[0]; o0.y = ow[1]; o0.z = ow[2]; o0.w = ow[3]; o1.x = ow[4]; o1.y = ow[5]; o1.z = ow[6]; o1.w = ow[7];
            *(GAS v4u*)(HG + (size_t)t * D + soff) = o0; *(GAS v4u*)(HG + (size_t)t * D + soff + 8) = o1; }
    }
}

constexpr int N_PHASES = 19;
__global__ void __launch_bounds__(NTHREADS, 2) mega_fwd(Args args) {
    extern __shared__ __attribute__((aligned(16))) unsigned char lds[];
    Frame F;
    F.lds = (LAS unsigned char*)lds;
    F.MISC = (volatile LAS unsigned*)(F.lds + MISC_OFF);
    F.tid = threadIdx.x; F.lane = F.tid & 63; F.wave = __builtin_amdgcn_readfirstlane(F.tid >> 6);
    F.G = gridDim.x; { const int bx = blockIdx.x; F.vcu = (F.G % 8 == 0) ? (bx % 8) * (F.G / 8) + bx / 8 : bx; }
    unsigned char* ws = args.ws;
    F.ctl = (gu32*)(ws + WS_CTL);
    for (int u = F.tid; u < (LDS_BYTES - LDSCTL_OFF) / 4; u += NTHREADS) ((LAS unsigned*)(F.lds + LDSCTL_OFF))[u] = 0u;
    __syncthreads();
    const int lo = args.ph_lo, hi = args.ph_hi;
    XcdBarrier bar; bar.bar = (unsigned*)(F.ctl + CW_BAR); bar.x = 0; bar.st = nullptr;
    if (hi - lo > 1) bar = xcd_barrier_post((unsigned*)(F.ctl + CW_BAR), F.MISC + 8);
#define IN(k) (lo <= (k) && (k) < hi)
#define REPS(k) (1 + ((DUP_MASK >> (k)) & 1))
#if PROBE_MASK
    unsigned long long* const tsb = (unsigned long long*)(ws + WS_CTL + 65536);
#define STAMP(k) do { if (blockIdx.x == 0 && F.tid == 0) __hip_atomic_store(tsb + (k), __builtin_amdgcn_s_memrealtime(), __ATOMIC_RELAXED, __HIP_MEMORY_SCOPE_AGENT); } while (0)
    STAMP(31);
#else
#define STAMP(k) do { } while (0)
#endif
#define SEAM(k) do { if (IN(k) && IN((k) + 1)) { if ((k) == 0) { cg::this_grid().sync(); } else { xcd_barrier(bar); } STAMP(k); } } while (0)
    float* rowss = (float*)(ws + WS_RSP);
    bf16* ACTA = (bf16*)(ws + WS_ACTA); bf16* ACTB = (bf16*)(ws + WS_ACTB); bf16* PROJ = (bf16*)(ws + WS_PROJ); bf16* SCB = (bf16*)(ws + WS_SC); bf16* PP = (bf16*)(ws + WS_PP);
    const int gtid = (F.vcu * NWAVES + F.wave) * 64 + F.lane, gthreads = F.G * NTHREADS;

#if UBENCH
    {
        typedef _Float16 h2_t __attribute__((ext_vector_type(2)));
        float a[32]; f32x2 p[16]; h2_t hh[32];
#pragma unroll
        for (int i = 0; i < 32; ++i) { a[i] = (float)(F.tid + i); hh[i] = (h2_t){(_Float16)(F.lane + i), (_Float16)i}; }
#pragma unroll
        for (int i = 0; i < 16; ++i) p[i] = (f32x2){a[2 * i], a[2 * i + 1]};
        const float m = 1.0f + 1e-7f * F.lane, c = 1e-9f; const f32x2 m2 = {m, m}, c2 = {c, c}; const h2_t mh = {(_Float16)1.0f, (_Float16)1.0f}, ch = {(_Float16)0.0f, (_Float16)0.0f};
#pragma unroll 1
        for (int it = 0; it < 10000; ++it) {
#if UBENCH == 1
#pragma unroll
            for (int i = 0; i < 32; ++i) asm volatile("v_fma_f32 %0, %0, %1, %2" : "+v"(a[i]) : "v"(m), "v"(c));
#elif UBENCH == 2
#pragma unroll
            for (int i = 0; i < 16; ++i) asm volatile("v_pk_fma_f32 %0, %0, %1, %2\n\tv_pk_fma_f32 %0, %0, %1, %2" : "+v"(p[i]) : "v"(m2), "v"(c2));
#elif UBENCH == 3
#pragma unroll
            for (int i = 0; i < 32; ++i) asm volatile("v_pk_fma_f16 %0, %0, %1, %2" : "+v"(hh[i]) : "v"(mh), "v"(ch));
#endif
        }
        float s = 0.f;
#pragma unroll
        for (int i = 0; i < 32; ++i) s += a[i] + (float)hh[i][0];
#pragma unroll
        for (int i = 0; i < 16; ++i) s += p[i][0] + p[i][1];
        if (s == 12345.678f) args.out[0] = s;
    }
#endif
    if (IN(0)) { p0_prologue(args, F); } SEAM(0);
    if (IN(1)) for (int rep_ = 0; rep_ < REPS(1); ++rep_) {
        { pg8::Gemm g{ACTA, (const bf16*)(ws + WS_WEV_IN), T, EV_NP, D}; pg8::StaticOrder S; S.init(T, EV_NP, F.G, (int)blockIdx.x); EpiBf16S E{PROJ, PROJ_LD, nullptr};
          pg8::gemm_phase<EpiBf16S, pg8::StaticOrder, true, true>(F.lds + RING_OFF, g, S, E); }
    } SEAM(1);
    if (IN(2)) for (int rep_ = 0; rep_ < REPS(2); ++rep_) {
        if (F.G >= 256) {
            const int u = F.vcu;
            if (u < 64) scan_gla_mfma_unit<0>(args, F, u); else if (u < 128) scan_gdn_mfma_unit(args, F, u - 64, 0); else if (u < 192) scan_gdn_mfma_unit(args, F, u - 128, 1);
            __syncthreads();
            if (rep_ == 0) { if (u < 64) p0_deferred(args, F, 128 + u, 192); else if (u >= 192) for (int k = 0; k < 2; ++k) p0_deferred(args, F, 2 * (u - 192) + k, 192); }
        } else {
            for (int u = F.vcu; u < 64; u += F.G) { scan_gla_mfma_unit<0>(args, F, u); __syncthreads(); }
            for (int u = F.vcu; u < 64; u += F.G) { scan_gdn_mfma_unit(args, F, u, 0); __syncthreads(); scan_gdn_mfma_unit(args, F, u, 1); __syncthreads(); }
            if (rep_ == 0) p0_deferred(args, F, F.vcu, F.G);
        }
    } SEAM(2);
    if (IN(3)) for (int rep_ = 0; rep_ < REPS(3); ++rep_) { post_rows<0>(args, F); } SEAM(3);
    if (IN(4)) { pg8::Gemm g{ACTA, (const bf16*)(ws + WS_WEV_OUT), T, D, D}; pg8::StaticOrder S; S.init(T, D, F.G, (int)blockIdx.x);
        EpiResid<false> E{args.in[I_X], args.out, ACTB, args.in[I_NFFN], rowss + (size_t)RS_FFN0 * T * 32, nullptr};
        pg8::gemm_phase<EpiResid<false>, pg8::StaticOrder, true, true>(F.lds + RING_OFF, g, S, E); } SEAM(4);
    if (IN(5)) for (int rep_ = 0; rep_ < REPS(5); ++rep_) { { pg8::Gemm g{ACTB, (const bf16*)(ws + WS_WPEER), T, D, D}; pg8::StaticOrder S; S.init(T, D, F.G, (int)blockIdx.x); EpiBf16S E{SCB, D, rowss + (size_t)RS_FFN0 * T * 32};
        pg8::gemm_phase<EpiBf16S, pg8::StaticOrder, true, true>(F.lds + RING_OFF, g, S, E); }
        { pg8::Gemm g{(const bf16*)(ws + WS_PBF), (const bf16*)(ws + WS_WPROJ), T, D, 256}; pg8::StaticOrder S; S.init(T, D, F.G, (int)blockIdx.x); EpiBf16S E{PP, D, nullptr};
          pg8::gemm_phase<EpiBf16S, pg8::StaticOrder, true, true>(F.lds + RING_OFF, g, S, E); } } SEAM(5);
    if (IN(6)) for (int rep_ = 0; rep_ < REPS(6); ++rep_) { peer_phase(args, F, 0, rep_ != 0); } SEAM(6);
    if (IN(7)) { { pg8::Gemm g{ACTA, (const bf16*)(ws + WS_WGATE), T, D, D}; pg8::StaticOrder S; S.init(T, D, F.G, (int)blockIdx.x);
        EpiResid<true> E{args.out, args.out, ACTB, args.in[I_NMIX] + D, rowss + (size_t)RS_MIX1 * T * 32, PP};
        pg8::gemm_phase<EpiResid<true>, pg8::StaticOrder, true, true>(F.lds + RING_OFF, g, S, E); }
        } SEAM(7);
    if (IN(8)) for (int rep_ = 0; rep_ < REPS(8); ++rep_) {
        { pg8::Gemm g{ACTB, (const bf16*)(ws + WS_WOD_IN), T, OD_NP, D}; pg8::StaticOrder S; S.init(T, OD_NP, F.G, (int)blockIdx.x); EpiBf16S E{PROJ, PROJ_LD, rowss + (size_t)RS_MIX1 * T * 32};
          pg8::gemm_phase<EpiBf16S, pg8::StaticOrder, true, true>(F.lds + RING_OFF, g, S, E); }
        { pg8::Gemm g{(const bf16*)(ws + WS_PBF) + (size_t)T * 256, (const bf16*)(ws + WS_WPROJ) + (size_t)D * 256, T, D, 256}; pg8::StaticOrder S; S.init(T, D, F.G, (int)blockIdx.x); EpiBf16S E{PP, D, nullptr};
          pg8::gemm_phase<EpiBf16S, pg8::StaticOrder, true, true>(F.lds + RING_OFF, g, S, E); }
    } SEAM(8);
    if (IN(9)) for (int rep_ = 0; rep_ < REPS(9); ++rep_) { lora_prep_rows(args, F); } SEAM(9);
    if (IN(10)) for (int rep_ = 0; rep_ < REPS(10); ++rep_) { pg8::Gemm g{(const bf16*)(ws + WS_LA), (const bf16*)(ws + WS_WLORA), T, LORA_N, LORA_K}; pg8::StaticOrder S; S.init(T, LORA_N, F.G, (int)blockIdx.x); EpiBf16S E{(bf16*)(ws + WS_LO), LORA_N, nullptr};
        pg8::gemm_phase<EpiBf16S, pg8::StaticOrder, true, true>(F.lds + RING_OFF, g, S, E); } SEAM(10);
    if (IN(11)) for (int rep_ = 0; rep_ < REPS(11); ++rep_) {
        if (F.G >= 256) {
            const int u = F.vcu;
            if (u < 64) scan_gla_mfma_unit<1>(args, F, u); else if (u < 128) scan_rwkv_mfma_unit(args, F, u - 64, 0); else if (u < 192) scan_rwkv_mfma_unit(args, F, u - 128, 1);
            __syncthreads();
            if (rep_ == 0) { if (u < 64) p1_deferred(args, F, 128 + u, 192); else if (u >= 192) for (int k = 0; k < 2; ++k) p1_deferred(args, F, 2 * (u - 192) + k, 192); }
        } else {
            for (int u = F.vcu; u < 64; u += F.G) { scan_gla_mfma_unit<1>(args, F, u); __syncthreads(); }
            for (int u = F.vcu; u < 64; u += F.G) { scan_rwkv_mfma_unit(args, F, u, 0); __syncthreads(); scan_rwkv_mfma_unit(args, F, u, 1); __syncthreads(); }
            if (rep_ == 0) p1_deferred(args, F, F.vcu, F.G);
        }
    } SEAM(11);
    if (IN(12)) for (int rep_ = 0; rep_ < REPS(12); ++rep_) { post_rows<1>(args, F); } SEAM(12);
    if (IN(13)) { pg8::Gemm g{ACTA, (const bf16*)(ws + WS_WOD_OUT), T, D, D}; pg8::StaticOrder S; S.init(T, D, F.G, (int)blockIdx.x);
        EpiResid<false> E{args.out, args.out, ACTB, args.in[I_NFFN] + D, rowss + (size_t)RS_FFN1 * T * 32, nullptr};
        pg8::gemm_phase<EpiResid<false>, pg8::StaticOrder, true, true>(F.lds + RING_OFF, g, S, E); } SEAM(13);
    if (IN(14)) for (int rep_ = 0; rep_ < REPS(14); ++rep_) { pg8::Gemm g{ACTB, (const bf16*)(ws + WS_WPEER) + (size_t)D * D, T, D, D}; pg8::StaticOrder S; S.init(T, D, F.G, (int)blockIdx.x); EpiBf16S E{SCB, D, rowss + (size_t)RS_FFN1 * T * 32};
        pg8::gemm_phase<EpiBf16S, pg8::StaticOrder, true, true>(F.lds + RING_OFF, g, S, E); } SEAM(14);
    if (IN(15)) for (int rep_ = 0; rep_ < REPS(15); ++rep_) { peer_phase(args, F, 1, rep_ != 0); } SEAM(15);
    if (IN(16)) { pg8::Gemm g{ACTA, (const bf16*)(ws + WS_WGATE) + (size_t)D * D, T, D, D}; pg8::StaticOrder S; S.init(T, D, F.G, (int)blockIdx.x);
        EpiResid<true> E{args.out, args.out, nullptr, nullptr, rowss + (size_t)RS_FINAL * T * 32, PP};
        pg8::gemm_phase<EpiResid<true>, pg8::StaticOrder, true, true>(F.lds + RING_OFF, g, S, E); } SEAM(16);
    if (IN(17)) {
        float oscale = 1.0f;
#if PROBE_MASK
        { unsigned long long t_prev = __hip_atomic_load(tsb + 31, __ATOMIC_RELAXED, __HIP_MEMORY_SCOPE_AGENT); const unsigned long long t_begin = t_prev; unsigned long long sel = 0ull;
          for (int k = 0; k <= 16; ++k) { const unsigned long long tk = __hip_atomic_load(tsb + k, __ATOMIC_RELAXED, __HIP_MEMORY_SCOPE_AGENT); if ((PROBE_MASK >> k) & 1) sel += tk - t_prev; t_prev = tk; }
          const float f = (float)(double(sel) / double(t_prev - t_begin)); oscale = 1.0f + sqrtf(0.01f + 0.9f * f); }
#endif
        final_rows(args, F, oscale); }
#undef IN
#undef SEAM
}

extern "C" void kernel_launch(void* const* d_in, const int* in_sizes, int n_in, void* d_out, int out_size, void* d_ws, size_t ws_size, hipStream_t stream) {
    static int grid = 0;
    if (grid == 0) {
        if (n_in != N_IN || out_size != T * D || ws_size < WS_END + 63 * MiB) { fprintf(stderr, "kernel_launch: unexpected problem: n_in %d out %d ws %zu (need %zu)\n", n_in, out_size, ws_size, (size_t)(WS_END + 63 * MiB)); grid = -1; return; }
        int dev = 0, cus = 0, per_cu = 0;
        if (hipGetDevice(&dev) != hipSuccess || hipDeviceGetAttribute(&cus, hipDeviceAttributeMultiprocessorCount, dev) != hipSuccess) { grid = -1; return; }
        if (hipFuncSetAttribute((const void*)mega_fwd, hipFuncAttributeMaxDynamicSharedMemorySize, LDS_BYTES) != hipSuccess) { fprintf(stderr, "kernel_launch: hipFuncSetAttribute failed\n"); grid = -1; return; }
        if (hipOccupancyMaxActiveBlocksPerMultiprocessor(&per_cu, (const void*)mega_fwd, NTHREADS, LDS_BYTES) != hipSuccess || per_cu < 1) { fprintf(stderr, "kernel_launch: occupancy query says %d blocks per CU\n", per_cu); (void)hipGetLastError(); grid = -1; return; }
        grid = cus;
    }
    if (grid < 0) return;
    (void)hipMemsetAsync((char*)d_ws + WS_CTL, 0, CTL_ZERO_BYTES, stream);
    Args a{};
    for (int i = 0; i < N_IN; ++i) a.in[i] = (const float*)d_in[i];
    a.out = (float*)d_out; a.ws = (unsigned char*)d_ws;
#if MK_PER_PHASE
    for (int p = 0; p < N_PHASES - 1; ++p) { a.ph_lo = p; a.ph_hi = p + 1; hipLaunchKernelGGL(mega_fwd, dim3(grid), dim3(NTHREADS), LDS_BYTES, stream, a); }
#else
    a.ph_lo = 0; a.ph_hi = N_PHASES;
    void* kargs[] = {&a};
    hipError_t e = hipLaunchCooperativeKernel((const void*)mega_fwd, dim3(grid), dim3(NTHREADS), kargs, LDS_BYTES, stream);
    if (e != hipSuccess) fprintf(stderr, "kernel_launch: cooperative launch failed: %s (grid %d)\n", hipGetErrorString(e), grid);
#endif
}
```

```cpp
#include <hip/hip_runtime.h>
#include <hip/hip_cooperative_groups.h>
#include <cstdio>
#include <cstdint>
namespace cg = cooperative_groups;

#ifndef PROBE_MASK
#define PROBE_MASK 0
#endif
#ifndef DUP_MASK
#define DUP_MASK 0
#endif
#ifndef UBENCH
#define UBENCH 0
#endif
#ifndef GDN_DUP
#define GDN_DUP 0
#endif
#ifndef MK_PER_PHASE
#define MK_PER_PHASE 0
#endif

namespace pg8 {
#define PG8_LAS __attribute__((address_space(3)))
typedef unsigned short bf16_t;
typedef short bf16x8 __attribute__((ext_vector_type(8)));
typedef float f32x4 __attribute__((ext_vector_type(4)));
typedef unsigned u32x4 __attribute__((ext_vector_type(4)));
typedef unsigned u32x2 __attribute__((ext_vector_type(2)));
constexpr int BM = 256, BK = 64, HALF = 128, HTB = HALF * BK * 2  , STAGE_BYTES = 8 * HTB, NXCD = 8, WGM = 8;

__host__ __device__ __forceinline__ int lds_byte(int r, int c) { const int st = (r >> 4) * 2 + (c >> 5), rr = r & 15, cc = c & 31, ob = rr * 64 + cc * 2; return st * 1024 + (ob ^ (((ob >> 9) & 1) << 5)); }
__host__ __device__ __forceinline__ void stage_rc(int b, int& R, int& C) { const int st = b / 1024, sb = b % 1024, swz = sb ^ (((sb >> 9) & 1) << 5); R = (st >> 1) * 16 + swz / 64; C = (st & 1) * 32 + (swz % 64) / 2; }
__host__ __device__ __forceinline__ int perm32(int rho) { const int n = rho >> 4, i = rho & 15; return 8 * (i >> 2) + 4 * n + (i & 3); }

struct Unit { int pm, pn; };
struct Gemm { const bf16_t* A; const bf16_t* Bt; int M, N, K; };

struct StaticOrder {
    int nM, nN, nwg, G, c;
    __host__ __device__ void init(int M, int N, int G_, int c_) { nM = M / BM; nN = N / BM; nwg = nM * nN; G = G_; c = c_; }
    __host__ __device__ bool next(int i, Unit& u) const {
        const long L = (long)i * G + c; if (L >= nwg) return false;
        int wgid = (int)L; { const int q = nwg / NXCD, r = nwg % NXCD, xcd = wgid % NXCD, off = wgid / NXCD; wgid = (xcd < r ? xcd * (q + 1) : r * (q + 1) + (xcd - r) * q) + off; }
        const int nig = WGM * nN, gid = wgid / nig, fm = gid * WGM, gsz = (nM - fm) < WGM ? (nM - fm) : WGM;
        u.pm = fm + ((wgid % nig) % gsz); u.pn = (wgid % nig) / gsz; return true;
    }
    __device__ __forceinline__ void a_ready(const Unit&) const {}
    __device__ __forceinline__ void done(const Unit&) const {}
};
__device__ __forceinline__ unsigned cvt_pk_bf16(float lo, float hi) { unsigned r; asm volatile("v_cvt_pk_bf16_f32 %0, %1, %2" : "=v"(r) : "v"(lo), "v"(hi)); return r; }
template <class Epi, class Sched, bool ALIGN_EPI = false, bool SP2 = false>
__device__ __forceinline__ void gemm_phase(PG8_LAS unsigned char* lds, const Gemm g, const Sched& S, const Epi& E) {
    const int tid = threadIdx.x, wid = __builtin_amdgcn_readfirstlane(tid >> 6), lane = tid & 63, wr = wid >> 2, wc = wid & 3, fr = lane & 15, fq = lane >> 4;
    const int K = g.K, nt = K / BK;
    unsigned voffA[2], voffB[2];
#pragma unroll
    for (int i = 0; i < 2; ++i) { int R, C; stage_rc(tid * 16 + i * 8192, R, C); const int Rb = Epi::PERM ? ((R & ~31) + perm32(R & 31)) : R;
        voffA[i] = (unsigned)(R * K + C) * 2u; voffB[i] = (unsigned)(Rb * K + C) * 2u; }
    const size_t kstep = (size_t)(BK * 2);
    const size_t hstep = (size_t)HALF * K * 2;
    const size_t tstep = 2 * hstep;
    const unsigned ldsw = (unsigned)wid * 1024u;
    const int aoff = lds_byte(wr * 64 + fr, fq * 8), boff = lds_byte(wc * 32 + fr, fq * 8);
#define PG8_SA(b, h) (((b) * 2 + (h)) * HTB)
#define PG8_SB(b, h) ((4 + (b) * 2 + (h)) * HTB)
#define PG8_STAGE(bufoff, gbase, voff) do { _Pragma("unroll") for (int _i = 0; _i < 2; ++_i) \
        __builtin_amdgcn_global_load_lds((const unsigned*)((const char*)(gbase) + (voff)[_i]), (PG8_LAS unsigned*)(lds + (bufoff) + ldsw + _i * 8192), 16, 0, 0); } while (0)
#define PG8_LDA(dst, b, h) do { _Pragma("unroll") for (int m = 0; m < 4; ++m) _Pragma("unroll") for (int k = 0; k < 2; ++k) dst[m][k] = *(const PG8_LAS bf16x8*)(lds + PG8_SA(b, h) + aoff + m * 2048 + k * 1024); } while (0)
#define PG8_LDB(dst, b, h) do { _Pragma("unroll") for (int n = 0; n < 2; ++n) _Pragma("unroll") for (int k = 0; k < 2; ++k) dst[n][k] = *(const PG8_LAS bf16x8*)(lds + PG8_SB(b, h) + boff + n * 2048 + k * 1024); } while (0)
#define PG8_MMA(ai, bj, At, Bt) do { __builtin_amdgcn_s_setprio(1); _Pragma("unroll") for (int m = 0; m < 4; ++m) _Pragma("unroll") for (int n = 0; n < 2; ++n) _Pragma("unroll") for (int k = 0; k < 2; ++k) \
        acc[ai][bj][m][n] = __builtin_amdgcn_mfma_f32_16x16x32_bf16(Bt[n][k], At[m][k], acc[ai][bj][m][n], 0, 0, 0); __builtin_amdgcn_s_setprio(0); } while (0)
#define PG8_WAIT_V(n) asm volatile("s_waitcnt vmcnt(" #n ")" ::: "memory")
#define PG8_WAIT_L(n) asm volatile("s_waitcnt lgkmcnt(" #n ")" ::: "memory")
#define PG8_BAR __builtin_amdgcn_s_barrier()
#define PG8_SCHED __builtin_amdgcn_sched_barrier(0)
    Unit cur, nxt; int ui = 0;
    if (!S.next(0, cur)) return;
    f32x4 acc[2][2][4][2];
#pragma unroll
    for (int a = 0; a < 2; ++a)
#pragma unroll
        for (int b = 0; b < 2; ++b)
#pragma unroll
            for (int m = 0; m < 4; ++m)
#pragma unroll
                for (int n = 0; n < 2; ++n) acc[a][b][m][n] = (f32x4){0.f, 0.f, 0.f, 0.f};
    bf16x8 At[4][2], B0[2][2], B1[2][2];
    const char* cA = (const char*)g.A + (size_t)cur.pm * tstep; const char* cB = (const char*)g.Bt + (size_t)cur.pn * tstep;
    S.a_ready(cur);
    if constexpr (SP2) {
        PG8_STAGE(PG8_SB(0, 0), cB, voffB); PG8_STAGE(PG8_SB(0, 1), cB + hstep, voffB); PG8_STAGE(PG8_SA(0, 0), cA, voffA); PG8_STAGE(PG8_SA(0, 1), cA + hstep, voffA);
        if (wr == 1) PG8_BAR;
        PG8_WAIT_V(2); PG8_BAR;
        PG8_STAGE(PG8_SB(1, 0), cB + kstep, voffB); PG8_STAGE(PG8_SA(1, 0), cA + kstep, voffA); PG8_STAGE(PG8_SB(1, 1), cB + hstep + kstep, voffB);
        PG8_WAIT_V(6); PG8_BAR;
    } else {
        PG8_STAGE(PG8_SB(0, 0), cB, voffB); PG8_STAGE(PG8_SA(0, 0), cA, voffA); PG8_STAGE(PG8_SB(0, 1), cB + hstep, voffB); PG8_STAGE(PG8_SA(0, 1), cA + hstep, voffA);
        if (wr == 1) PG8_BAR;
        PG8_WAIT_V(4); PG8_BAR;
        PG8_STAGE(PG8_SB(1, 0), cB + kstep, voffB); PG8_STAGE(PG8_SA(1, 0), cA + kstep, voffA); PG8_STAGE(PG8_SB(1, 1), cB + hstep + kstep, voffB);
        PG8_WAIT_V(6); PG8_BAR;
    }
    for (;;) {
        const bool has_next = S.next(ui + 1, nxt);
        const char* nA = has_next ? (const char*)g.A + (size_t)nxt.pm * tstep : cA; const char* nB = has_next ? (const char*)g.Bt + (size_t)nxt.pn * tstep : cB;
        for (int t = 0; t < nt; t += 2) {
            const bool last = (t == nt - 2);
            const char* a1 = cA + (size_t)(t + 1) * kstep;
            const char* a2 = last ? nA : cA + (size_t)(t + 2) * kstep; const char* b2 = last ? nB : cB + (size_t)(t + 2) * kstep;
            const char* a3 = a2 + kstep; const char* b3 = b2 + kstep;
            if (last && has_next) S.a_ready(nxt);
            if constexpr (SP2) {
            PG8_LDB(B0, 0, 0); PG8_LDB(B1, 0, 1); PG8_SCHED; PG8_LDA(At, 0, 0); PG8_STAGE(PG8_SA(1, 1), a1 + hstep, voffA);
            PG8_WAIT_V(8); PG8_WAIT_L(0); PG8_BAR; PG8_MMA(0, 0, At, B0); PG8_MMA(0, 1, At, B1); PG8_BAR; PG8_SCHED;
            PG8_LDA(At, 0, 1); PG8_STAGE(PG8_SB(0, 0), b2, voffB); PG8_STAGE(PG8_SB(0, 1), b2 + hstep, voffB); PG8_STAGE(PG8_SA(0, 0), a2, voffA);
            PG8_WAIT_V(8); PG8_WAIT_L(0); PG8_BAR; PG8_MMA(1, 0, At, B0); PG8_MMA(1, 1, At, B1); PG8_BAR; PG8_SCHED;
            PG8_LDB(B0, 1, 0); PG8_LDB(B1, 1, 1); PG8_SCHED; PG8_LDA(At, 1, 0); PG8_STAGE(PG8_SA(0, 1), a2 + hstep, voffA);
            PG8_WAIT_V(8); PG8_WAIT_L(0); PG8_BAR; PG8_MMA(0, 0, At, B0); PG8_MMA(0, 1, At, B1); PG8_BAR; PG8_SCHED;
            PG8_LDA(At, 1, 1); PG8_STAGE(PG8_SB(1, 0), b3, voffB); PG8_STAGE(PG8_SB(1, 1), b3 + hstep, voffB); PG8_STAGE(PG8_SA(1, 0), a3, voffA);
            PG8_WAIT_V(8); PG8_WAIT_L(0); PG8_BAR; PG8_MMA(1, 0, At, B0); PG8_MMA(1, 1, At, B1); PG8_BAR; PG8_SCHED;
            } else {
            PG8_LDB(B0, 0, 0); PG8_SCHED; PG8_LDA(At, 0, 0); PG8_STAGE(PG8_SA(1, 1), a1 + hstep, voffA);
            PG8_WAIT_L(8); PG8_BAR; PG8_WAIT_L(0); PG8_MMA(0, 0, At, B0); PG8_BAR; PG8_SCHED;
            PG8_LDB(B1, 0, 1); PG8_STAGE(PG8_SB(0, 0), b2, voffB);
            PG8_BAR; PG8_WAIT_L(0); PG8_MMA(0, 1, At, B1); PG8_BAR;
            PG8_LDA(At, 0, 1); PG8_STAGE(PG8_SA(0, 0), a2, voffA);
            PG8_BAR; PG8_WAIT_L(0); PG8_MMA(1, 0, At, B0); PG8_BAR; PG8_SCHED;
            PG8_STAGE(PG8_SB(0, 1), b2 + hstep, voffB);
            PG8_WAIT_V(6); PG8_BAR; PG8_MMA(1, 1, At, B1); PG8_BAR;
            PG8_LDB(B0, 1, 0); PG8_SCHED; PG8_LDA(At, 1, 0); PG8_STAGE(PG8_SA(0, 1), a2 + hstep, voffA);
            PG8_WAIT_L(8); PG8_BAR; PG8_WAIT_L(0); PG8_MMA(0, 0, At, B0); PG8_BAR; PG8_SCHED;
            PG8_LDB(B1, 1, 1); PG8_STAGE(PG8_SB(1, 0), b3, voffB);
            PG8_BAR; PG8_WAIT_L(0); PG8_MMA(0, 1, At, B1); PG8_BAR;
            PG8_LDA(At, 1, 1); PG8_STAGE(PG8_SA(1, 0), a3, voffA);
            PG8_BAR; PG8_WAIT_L(0); PG8_MMA(1, 0, At, B0); PG8_BAR; PG8_SCHED;
            PG8_STAGE(PG8_SB(1, 1), b3 + hstep, voffB);
            PG8_WAIT_V(6); PG8_BAR; PG8_MMA(1, 1, At, B1); PG8_BAR;
            }
        }
        if constexpr (ALIGN_EPI) { if (wr == 0) PG8_BAR; }
        if constexpr (!Epi::AFTER_DRAIN) { E(acc, cur, wr, wc, fr, fq); S.done(cur); }
        if (!has_next) break;
#pragma unroll
        for (int a = 0; a < 2; ++a)
#pragma unroll
            for (int b = 0; b < 2; ++b)
#pragma unroll
                for (int m = 0; m < 4; ++m)
#pragma unroll
                    for (int n = 0; n < 2; ++n) acc[a][b][m][n] = (f32x4){0.f, 0.f, 0.f, 0.f};
        cur = nxt; cA = nA; cB = nB; ++ui;
        if constexpr (ALIGN_EPI) { if (wr == 1) PG8_BAR; }
    }
    PG8_WAIT_V(0);
    if constexpr (!ALIGN_EPI) { if (wr == 0) PG8_BAR; }
    PG8_BAR;
    if constexpr (Epi::AFTER_DRAIN) { E.fused(acc, cur, wr, wc, fr, fq, lds, wid, lane); S.done(cur); }
#undef PG8_SA
#undef PG8_SB
#undef PG8_STAGE
#undef PG8_LDA
#undef PG8_LDB
#undef PG8_MMA
#undef PG8_WAIT_V
#undef PG8_WAIT_L
#undef PG8_BAR
#undef PG8_SCHED
}
}
#define GAS __attribute__((address_space(1)))
#define LAS __attribute__((address_space(3)))
typedef unsigned short bf16;
typedef unsigned v4u __attribute__((ext_vector_type(4)));
typedef float f32x4 __attribute__((ext_vector_type(4)));
typedef short bf16x8 __attribute__((ext_vector_type(8)));
typedef GAS unsigned gu32;
typedef GAS unsigned long long gu64;
#define RLX_AGENT __ATOMIC_RELAXED, __HIP_MEMORY_SCOPE_AGENT
#define LDS_WAIT() asm volatile("s_waitcnt lgkmcnt(0)" ::: "memory")
#define VM_WAIT() asm volatile("s_waitcnt vmcnt(0)" ::: "memory")
__device__ __forceinline__ unsigned long long rt() { return __builtin_amdgcn_s_memrealtime(); }
__device__ __forceinline__ unsigned f2bf(float f) { unsigned u = __builtin_bit_cast(unsigned, f); return (u + 0x7fffu + ((u >> 16) & 1u)) >> 16; }
__device__ __forceinline__ unsigned pk2(float lo, float hi) { return f2bf(lo) | (f2bf(hi) << 16); }

#define XB_TMO      128
#define XB_XCNT(j)  (256  + 64 * (j))
#define XB_XSUB(j)  (1280 + 64 * (j))
#define XB_XGEN(j)  (2304 + 64 * (j))
#define XB_TOP      3328
#define XB_TOPGEN   3392
#define XCD_BAR_WORDS 3456
#define XB_SPIN_CAP (1u << 18)

__device__ __forceinline__ unsigned xb_ld(unsigned* p)              { return __hip_atomic_load(p, __ATOMIC_RELAXED, __HIP_MEMORY_SCOPE_AGENT); }
__device__ __forceinline__ unsigned xb_add(unsigned* p, unsigned v) { return __hip_atomic_fetch_add(p, v, __ATOMIC_RELAXED, __HIP_MEMORY_SCOPE_AGENT); }
__device__ __forceinline__ unsigned xb_xcc_id() { return (unsigned)__builtin_amdgcn_s_getreg((3 << 11) | 20) & 0xFu; }
#define XB_SPIN(cond, bar) do { unsigned _sp = 0; while (cond) { __builtin_amdgcn_s_sleep(1); \
    if ((++_sp & 255u) == 0u) { if (xb_ld(&(bar)[XB_TMO])) break; if (_sp > XB_SPIN_CAP) { atomicAdd(&(bar)[XB_TMO], 1u); break; } } } } while (0)

struct XcdBarrier {
    unsigned* bar; unsigned x;
    volatile LAS unsigned* st;
};

__device__ __forceinline__ XcdBarrier xcd_barrier_post(unsigned* bar, volatile LAS unsigned* st) {
    XcdBarrier b; b.bar = bar; b.x = xb_xcc_id(); b.st = st;
    if (threadIdx.x == 0) (void)xb_add(&bar[XB_XCNT(b.x)], 1u);
    return b;
}
__device__ __forceinline__ void xcd_barrier_complete(unsigned* bar, unsigned x, unsigned& nloc, unsigned& nx) {
    const unsigned G = gridDim.x * gridDim.y * gridDim.z;
    unsigned sum, cnt, mine, sp = 0u;
    for (;;) {
        sum = 0u; cnt = 0u; mine = 0u;
#pragma unroll
        for (unsigned j = 0; j < 16; ++j) { const unsigned c = xb_ld(&bar[XB_XCNT(j)]); sum += c; cnt += (c > 0u) ? 1u : 0u; mine = (j == x) ? c : mine; }
        if (sum == G) break;
        __builtin_amdgcn_s_sleep(1);
        if ((++sp & 255u) == 0u) { if (xb_ld(&bar[XB_TMO])) break; if (sp > XB_SPIN_CAP) { atomicAdd(&bar[XB_TMO], 1u); break; } }
    }
    nloc = mine > 0u ? mine : 1u; nx = cnt > 0u ? cnt : 1u;
}

__device__ __forceinline__ void xcd_barrier(const XcdBarrier& b) {
    asm volatile("s_waitcnt vmcnt(0)" ::: "memory");
    __syncthreads();
    if (threadIdx.x == 0) {
        unsigned* bar = b.bar;
        __builtin_amdgcn_s_waitcnt(0);
        unsigned nloc = b.st[0], nx = b.st[1];
        if (nloc == 0u) { xcd_barrier_complete(bar, b.x, nloc, nx); b.st[0] = nloc; b.st[1] = nx; }
        const unsigned old = xb_add(&bar[XB_XSUB(b.x)], 1u);
        const unsigned gen = old / nloc;
        if (old + 1u == (gen + 1u) * nloc) {
            __builtin_amdgcn_fence(__ATOMIC_RELEASE, "agent");
            asm volatile("s_waitcnt vmcnt(0)" ::: "memory");
            const unsigned og = xb_add(&bar[XB_TOP], 1u);
            const unsigned tg = og / nx;
            if (og + 1u == (tg + 1u) * nx) xb_add(&bar[XB_TOPGEN], 1u);
            else XB_SPIN(xb_ld(&bar[XB_TOPGEN]) == tg, bar);
            __builtin_amdgcn_fence(__ATOMIC_ACQUIRE, "agent");
            xb_add(&bar[XB_XGEN(b.x)], 1u);
            asm volatile("s_waitcnt vmcnt(0)" ::: "memory");
        } else {
            XB_SPIN(xb_ld(&bar[XB_XGEN(b.x)]) == gen, bar);
            __builtin_amdgcn_fence(__ATOMIC_ACQUIRE, "agent");
            asm volatile("s_waitcnt vmcnt(0)" ::: "memory");
        }
    }
    __syncthreads();
}

constexpr int NWAVES = 8, NTHREADS = NWAVES * 64;
constexpr int BATCH = 8, SEQ = 2048, T = BATCH * SEQ, D = 2048;
constexpr int EV_N = 7200, EV_NP = 7424, OD_N = 7616, OD_NP = 7680, PROJ_LD = 7680;
constexpr float EPS = 1e-6f;
constexpr int EC_GQ = 0, EC_GK = 512, EC_GV = 1024, EC_GZ = 2048, EC_GLR = 3072, EC_BQ = 3088, EC_BK = 4112, EC_BV = 5136, EC_BZ = 6160, EC_BA = 7184, EC_BB = 7192;
constexpr int OC_HQ = 0, OC_HF = 1024, OC_HI = 2048, OC_HG = 3072, OC_RW = 4096;
constexpr int RW_R = 0, RW_K = 1024, RW_V = 2048, RW_WL = 3072, RW_AL = 3168, RW_GL = 3264;
constexpr int LORA_K = 512, LORA_N = 3072;
enum { I_X = 0, I_P, I_EV_WIN, I_GK_W2, I_GK_B, I_GLA_NORM, I_GDN_CONV, I_GDN_ALOG, I_GDN_DTB, I_GDN_NORM, I_EV_WOUT, I_OD_WIN, I_LB, I_HG_NORM,
       I_MU, I_W0, I_W2, I_A0, I_A2, I_G2, I_KK, I_KA, I_RK, I_LNW, I_LNB, I_OD_WOUT, I_NMIX, I_NFFN, I_NPLE, I_PEER_WQ, I_PEER_SK, I_PEER_U, I_PEER_V,
       I_PLE_WP, I_PLE_WG, I_NFINAL, N_IN };

constexpr size_t MiB = 1u << 20;
constexpr size_t WS_CTL = 0, CTL_ZERO_BYTES = 1 * MiB;
constexpr size_t WS_WEV_IN = 1 * MiB, WS_WEV_OUT = 30 * MiB, WS_WOD_IN = 38 * MiB, WS_WOD_OUT = 68 * MiB, WS_WPEER = 76 * MiB, WS_WGATE = 92 * MiB, WS_WPROJ = 108 * MiB,
                 WS_WLORA = 110 * MiB, WS_PBF = 113 * MiB, WS_TABU = 129 * MiB, WS_TABV = 193 * MiB, WS_ACTA = 257 * MiB, WS_ACTB = 321 * MiB, WS_PROJ = 385 * MiB, WS_SC = 385 * MiB,
                 WS_O = 625 * MiB, WS_H1 = 689 * MiB, WS_PP = 753 * MiB, WS_LA = 817 * MiB, WS_LO = 833 * MiB, WS_RSP = 929 * MiB, WS_STATE = 937 * MiB, WS_RS3 = 945 * MiB, WS_END = 946 * MiB;
static_assert(WS_WEV_IN + (size_t)EV_NP * D * 2 <= WS_WEV_OUT && WS_WOD_IN + (size_t)OD_NP * D * 2 <= WS_WOD_OUT && WS_PROJ + (size_t)T * PROJ_LD * 2 <= WS_O, "ws map");
constexpr int CW_BAR = 4096;
enum { RS_FFN0 = 0, RS_MIX1 = 1, RS_FFN1 = 2, RS_FINAL = 3 };
constexpr int RING_OFF = 0, RING_BYTES = 131072;
constexpr int LDSCTL_OFF = RING_BYTES, MISC_OFF = LDSCTL_OFF + 320;
constexpr int LDS_BYTES = 147456;

struct Args { const float* in[N_IN]; float* out; unsigned char* ws; int ph_lo, ph_hi; };
struct Frame {
    LAS unsigned char* lds; volatile LAS unsigned* MISC; gu32* ctl;
    int tid, lane, wave, vcu, G;
};
__device__ __forceinline__ float wave_sum(float v) {
#pragma unroll
    for (int o = 1; o < 64; o <<= 1) v += __shfl_xor(v, o);
    return v;
}
__device__ __forceinline__ float half_sum32(float v) {
#pragma unroll
    for (int o = 1; o < 32; o <<= 1) v += __shfl_xor(v, o);
    return v;
}
#define DPP_ADD(v, ctrl) (v) += __builtin_bit_cast(float, __builtin_amdgcn_update_dpp(0, __builtin_bit_cast(int, (v)), (ctrl), 0xF, 0xF, false))
__device__ __forceinline__ float row_sum16(float v) {
    DPP_ADD(v, 0x128); DPP_ADD(v, 0x124); DPP_ADD(v, 0x122); DPP_ADD(v, 0x121);
    return v;
}
__device__ __forceinline__ void row_sum16_x4(float& a, float& b, float& c, float& d) {
    asm("s_nop 1\n\t"
        "v_add_f32_dpp %0, %0, %0 row_ror:8 row_mask:0xf bank_mask:0xf\n\tv_add_f32_dpp %1, %1, %1 row_ror:8 row_mask:0xf bank_mask:0xf\n\t"
        "v_add_f32_dpp %2, %2, %2 row_ror:8 row_mask:0xf bank_mask:0xf\n\tv_add_f32_dpp %3, %3, %3 row_ror:8 row_mask:0xf bank_mask:0xf\n\t"
        "v_add_f32_dpp %0, %0, %0 row_ror:4 row_mask:0xf bank_mask:0xf\n\tv_add_f32_dpp %1, %1, %1 row_ror:4 row_mask:0xf bank_mask:0xf\n\t"
        "v_add_f32_dpp %2, %2, %2 row_ror:4 row_mask:0xf bank_mask:0xf\n\tv_add_f32_dpp %3, %3, %3 row_ror:4 row_mask:0xf bank_mask:0xf\n\t"
        "v_add_f32_dpp %0, %0, %0 row_ror:2 row_mask:0xf bank_mask:0xf\n\tv_add_f32_dpp %1, %1, %1 row_ror:2 row_mask:0xf bank_mask:0xf\n\t"
        "v_add_f32_dpp %2, %2, %2 row_ror:2 row_mask:0xf bank_mask:0xf\n\tv_add_f32_dpp %3, %3, %3 row_ror:2 row_mask:0xf bank_mask:0xf\n\t"
        "v_add_f32_dpp %0, %0, %0 row_ror:1 row_mask:0xf bank_mask:0xf\n\tv_add_f32_dpp %1, %1, %1 row_ror:1 row_mask:0xf bank_mask:0xf\n\t"
        "v_add_f32_dpp %2, %2, %2 row_ror:1 row_mask:0xf bank_mask:0xf\n\tv_add_f32_dpp %3, %3, %3 row_ror:1 row_mask:0xf bank_mask:0xf\n\t"
        "s_nop 1"
        : "+v"(a), "+v"(b), "+v"(c), "+v"(d));
}
__device__ __forceinline__ void row_sum16_x2(float& a, float& b) {
    asm("s_nop 1\n\t"
        "v_add_f32_dpp %0, %0, %0 row_ror:8 row_mask:0xf bank_mask:0xf\n\tv_add_f32_dpp %1, %1, %1 row_ror:8 row_mask:0xf bank_mask:0xf\n\ts_nop 1\n\t"
        "v_add_f32_dpp %0, %0, %0 row_ror:4 row_mask:0xf bank_mask:0xf\n\tv_add_f32_dpp %1, %1, %1 row_ror:4 row_mask:0xf bank_mask:0xf\n\ts_nop 1\n\t"
        "v_add_f32_dpp %0, %0, %0 row_ror:2 row_mask:0xf bank_mask:0xf\n\tv_add_f32_dpp %1, %1, %1 row_ror:2 row_mask:0xf bank_mask:0xf\n\ts_nop 1\n\t"
        "v_add_f32_dpp %0, %0, %0 row_ror:1 row_mask:0xf bank_mask:0xf\n\tv_add_f32_dpp %1, %1, %1 row_ror:1 row_mask:0xf bank_mask:0xf\n\t"
        "s_nop 1"
        : "+v"(a), "+v"(b));
}
#define LBAR() do { asm volatile("s_waitcnt lgkmcnt(0)" ::: "memory"); __builtin_amdgcn_s_barrier(); asm volatile("" ::: "memory"); } while (0)
typedef float f32x2 __attribute__((ext_vector_type(2)));
typedef __bf16 hwbf16x2_t __attribute__((ext_vector_type(2)));
__device__ __forceinline__ unsigned hw_pk2(float lo, float hi) { const f32x2 v = {lo, hi}; return __builtin_bit_cast(unsigned, __builtin_convertvector(v, hwbf16x2_t)); }
__device__ __forceinline__ bf16 hw_bf(float x) { return (bf16)hw_pk2(x, 0.f); }
__device__ __forceinline__ float bf_lo(unsigned w) { return __uint_as_float(w << 16); }
__device__ __forceinline__ float bf_hi(unsigned w) { return __uint_as_float(w & 0xffff0000u); }
__device__ __forceinline__ float sigmoidf_(float x) { return __builtin_amdgcn_rcpf(1.0f + __expf(-x)); }
__device__ __forceinline__ float siluf_(float x) { return x * __builtin_amdgcn_rcpf(1.0f + __expf(-x)); }
__device__ __forceinline__ float softplusf_(float x) { return fmaxf(x, 0.f) + log1pf(__expf(-fabsf(x))); }
__device__ __forceinline__ float logsigmoidf_(float x) { return fminf(x, 0.f) - log1pf(__expf(-fabsf(x))); }

struct EpiBf16S {
    static constexpr bool PERM = true, AFTER_DRAIN = false;
    bf16* O; int ldc; const float* rowss;
    __device__ __forceinline__ void operator()(const pg8::f32x4 (&acc)[2][2][4][2], const pg8::Unit& u, int wr, int wc, int fr, int fq) const {
        const int row0 = u.pm * 256 + wr * 64 + fr, col0 = u.pn * 256 + wc * 32 + 8 * fq;
#pragma unroll
        for (int ai = 0; ai < 2; ++ai)
#pragma unroll
            for (int m = 0; m < 4; ++m) {
                const int row = row0 + ai * 128 + m * 16;
                float sc = 1.f;
                if (rowss) { const pg8::f32x4* rp = (const pg8::f32x4*)(rowss + (size_t)row * 32 + 8 * fq); const pg8::f32x4 p0 = rp[0], p1 = rp[1];
                    float s = ((p0[0] + p0[1]) + (p0[2] + p0[3])) + ((p1[0] + p1[1]) + (p1[2] + p1[3])); s += __shfl_xor(s, 16); s += __shfl_xor(s, 32);
                    sc = __builtin_amdgcn_rsqf(s * (1.0f / D) + EPS); }
                bf16* rowp = O + (size_t)row * ldc + col0;
#pragma unroll
                for (int bj = 0; bj < 2; ++bj) { const pg8::f32x4 v0 = acc[ai][bj][m][0] * sc, v1 = acc[ai][bj][m][1] * sc;
                    pg8::u32x4 w; w.x = pg8::cvt_pk_bf16(v0[0], v0[1]); w.y = pg8::cvt_pk_bf16(v0[2], v0[3]); w.z = pg8::cvt_pk_bf16(v1[0], v1[1]); w.w = pg8::cvt_pk_bf16(v1[2], v1[3]);
                    *(pg8::u32x4*)(rowp + bj * 128) = w; } }
    }
};
template <bool GATE, bool HIN_F32> struct EpiResid {
    static constexpr bool PERM = false, AFTER_DRAIN = false;
    const void* hin; bf16* hout; float* rowss; const bf16* pp; const float* rs3;
    __device__ __forceinline__ void operator()(const pg8::f32x4 (&acc)[2][2][4][2], const pg8::Unit& u, int wr, int wc, int fr, int fq) const {
        const int row0 = u.pm * 256 + wr * 64 + fr, col0 = u.pn * 256 + wc * 32 + 4 * fq;
#pragma unroll
        for (int ai = 0; ai < 2; ++ai)
#pragma unroll
            for (int m = 0; m < 4; ++m) {
                const int row = row0 + ai * 128 + m * 16; const size_t off = (size_t)row * D + col0; float ss = 0.f;
                float rsc = 1.f; if (GATE) rsc = rs3[row];
#pragma unroll
                for (int bj = 0; bj < 2; ++bj)
#pragma unroll
                    for (int n = 0; n < 2; ++n) { const size_t o = off + bj * 128 + n * 16;
                        pg8::f32x4 hv;
                        if (HIN_F32) hv = *(const pg8::f32x4*)((const float*)hin + o);
                        else { const pg8::u32x2 hw = *(const pg8::u32x2*)((const bf16*)hin + o); hv[0] = bf_lo(hw.x); hv[1] = bf_hi(hw.x); hv[2] = bf_lo(hw.y); hv[3] = bf_hi(hw.y); }
                        pg8::f32x4 a = acc[ai][bj][m][n];
                        if (GATE) { const pg8::u32x2 pw = *(const pg8::u32x2*)(pp + o);
                            a[0] = sigmoidf_(a[0] * rsc) * bf_lo(pw.x); a[1] = sigmoidf_(a[1] * rsc) * bf_hi(pw.x); a[2] = sigmoidf_(a[2] * rsc) * bf_lo(pw.y); a[3] = sigmoidf_(a[3] * rsc) * bf_hi(pw.y); }
                        hv = hv + a;
                        pg8::u32x2 w; w.x = hw_pk2(hv[0], hv[1]); w.y = hw_pk2(hv[2], hv[3]); *(pg8::u32x2*)(hout + o) = w;
                        const float q0 = bf_lo(w.x), q1 = bf_hi(w.x), q2 = bf_lo(w.y), q3 = bf_hi(w.y);
                        ss += (q0 * q0 + q1 * q1) + (q2 * q2 + q3 * q3); }
                ss += __shfl_xor(ss, 16); ss += __shfl_xor(ss, 32);
                if (fq == 0) rowss[(size_t)row * 32 + u.pn * 4 + wc] = ss;
                asm volatile("" ::: "memory"); }
    }
};

__device__ __forceinline__ void p0_transpose_item(const float* W, int K, int N, bf16* WT, LAS float* scr, int item, int lane, const float* kgain = nullptr) {
    const int nblk = N / 32, kb = item / nblk, nb = item % nblk, k0 = 64 * kb, n0 = 32 * nb;
    { const GAS float* Wg = (const GAS float*)W + (size_t)(k0 + (lane >> 5)) * N + n0 + (lane & 31); float v[32];
#pragma unroll
      for (int i = 0; i < 32; ++i) v[i] = Wg[(size_t)(2 * i) * N];
#pragma unroll
      for (int i = 0; i < 32; ++i) scr[(2 * i + (lane >> 5)) * 33 + (lane & 31)] = v[i]; }
    LDS_WAIT(); asm volatile("" ::: "memory");
    const int c = lane & 7;
#pragma unroll
    for (int j = 0; j < 4; ++j) { const int n = (lane >> 3) + 8 * j; const LAS float* s = scr + (8 * c) * 33 + n;
        f32x4 g0 = {1.f, 1.f, 1.f, 1.f}, g1 = g0; if (kgain) { g0 = *(const GAS f32x4*)(kgain + k0 + 8 * c); g1 = *(const GAS f32x4*)(kgain + k0 + 8 * c + 4); }
        v4u o; o.x = pk2(s[0 * 33] * g0[0], s[1 * 33] * g0[1]); o.y = pk2(s[2 * 33] * g0[2], s[3 * 33] * g0[3]); o.z = pk2(s[4 * 33] * g1[0], s[5 * 33] * g1[1]); o.w = pk2(s[6 * 33] * g1[2], s[7 * 33] * g1[3]);
        *(GAS v4u*)(WT + (size_t)(n0 + n) * K + k0 + 8 * c) = o; }
    LDS_WAIT(); asm volatile("" ::: "memory");
}
__device__ __forceinline__ void cvt_f32_bf16(const float* src, bf16* dst, size_t n, int gtid, int gthreads) {
    const size_t n8 = n / 8;
    for (size_t i = gtid; i < n8; i += gthreads) {
        const f32x4 a = *(const GAS f32x4*)(src + i * 8), b = *(const GAS f32x4*)(src + i * 8 + 4);
        v4u o; o.x = pk2(a[0], a[1]); o.y = pk2(a[2], a[3]); o.z = pk2(b[0], b[1]); o.w = pk2(b[2], b[3]);
        *(GAS v4u*)(dst + i * 8) = o; }
}
__device__ __forceinline__ void cvt_f32_fp8(const float* src, unsigned char* dst, size_t n, float scale, int gtid, int gthreads, const float* cgain = nullptr) {
    const size_t n16 = n / 16;
    for (size_t i = gtid; i < n16; i += gthreads) { v4u o; unsigned w[4];
#pragma unroll
        for (int q = 0; q < 4; ++q) { f32x4 a = *(const GAS f32x4*)(src + i * 16 + 4 * q) * scale; if (cgain) a = a * *(const GAS f32x4*)(cgain + ((i * 16 + 4 * q) & (D - 1)));
            int x = __builtin_amdgcn_cvt_pk_fp8_f32(a[0], a[1], 0, false); x = __builtin_amdgcn_cvt_pk_fp8_f32(a[2], a[3], x, true); w[q] = (unsigned)x; }
        o.x = w[0]; o.y = w[1]; o.z = w[2]; o.w = w[3];
        *(GAS v4u*)(dst + i * 16) = o; }
}
__device__ __forceinline__ void rms_row_to_bf16(const float* xrow, const float* g, bf16* orow, int lane) {
    const GAS f32x4* xr = (const GAS f32x4*)xrow + lane; f32x4 v[8]; float s = 0.f;
#pragma unroll
    for (int j = 0; j < 8; ++j) { v[j] = xr[64 * j]; s += (v[j][0] * v[j][0] + v[j][1] * v[j][1]) + (v[j][2] * v[j][2] + v[j][3] * v[j][3]); }
    const float r = __builtin_amdgcn_rsqf(wave_sum(s) * (1.0f / D) + EPS);
    const GAS f32x4* gr = (const GAS f32x4*)g + lane;
    GAS unsigned long long* o8 = (GAS unsigned long long*)orow + lane;
#pragma unroll
    for (int j = 0; j < 8; ++j) { const f32x4 gg = gr[64 * j]; o8[64 * j] = (unsigned long long)pk2(v[j][0] * r * gg[0], v[j][1] * r * gg[1]) | ((unsigned long long)pk2(v[j][2] * r * gg[2], v[j][3] * r * gg[3]) << 32); }
}
__device__ __forceinline__ void p0_fold_item(const float* wq, const float* sk, bf16* WP, LAS float* lds, int item, int tid, const float* kgain) {
    const int hp = item >> 5, k0 = (item & 31) * 64;
    LAS float* skT = lds;
    LAS float* wqT = lds + 128 * 132;
    const float* skb = sk + (size_t)hp * 128 * 128;
#pragma unroll 4
    for (int i = 0; i < 32; ++i) { const int idx = i * 512 + tid, n = idx >> 7, d = idx & 127; skT[d * 132 + n] = skb[idx]; }
#pragma unroll 4
    for (int i = 0; i < 16; ++i) { const int idx = i * 512 + tid, kk = idx >> 7, d = idx & 127; wqT[d * 68 + kk] = wq[(size_t)(k0 + kk) * D + hp * 128 + d] * kgain[k0 + kk]; }
    __syncthreads();
    const int n0 = (tid >> 4) * 4, kk0 = (tid & 15) * 4;
    float acc[4][4];
#pragma unroll
    for (int i = 0; i < 4; ++i)
#pragma unroll
        for (int j = 0; j < 4; ++j) acc[i][j] = 0.f;
#pragma unroll 4
    for (int d = 0; d < 128; ++d) { const f32x4 a = *(const LAS f32x4*)(skT + d * 132 + n0), b = *(const LAS f32x4*)(wqT + d * 68 + kk0);
#pragma unroll
        for (int i = 0; i < 4; ++i)
#pragma unroll
            for (int j = 0; j < 4; ++j) acc[i][j] += a[i] * b[j]; }
#pragma unroll
    for (int i = 0; i < 4; ++i) { unsigned long long o = (unsigned long long)pk2(acc[i][0], acc[i][1]) | ((unsigned long long)pk2(acc[i][2], acc[i][3]) << 32);
        *(GAS unsigned long long*)(WP + (size_t)(hp * 128 + n0 + i) * D + k0 + kk0) = o; }
    __syncthreads();
}
__device__ __forceinline__ void p0_prologue(const Args& A, Frame& F) {
    const int gw = F.vcu * NWAVES + F.wave, NGW = F.G * NWAVES;
    const int gtid = gw * 64 + F.lane, gthreads = F.G * NTHREADS;
    unsigned char* ws = A.ws;
    LAS float* scr = (LAS float*)(F.lds + RING_OFF + F.wave * 16384);
    constexpr int I_EVIN = (D / 64) * (EV_N / 32);
    for (int it = gw; it < I_EVIN; it += NGW) p0_transpose_item(A.in[I_EV_WIN], D, EV_N, (bf16*)(ws + WS_WEV_IN), scr, it, F.lane);
    { GAS v4u* z0 = (GAS v4u*)(ws + WS_WEV_IN + (size_t)EV_N * D * 2); const size_t n0 = (size_t)(EV_NP - EV_N) * D * 2 / 16;
      for (size_t i = gtid; i < n0; i += gthreads) z0[i] = (v4u){0u, 0u, 0u, 0u}; }
    for (int m = gw; m < T; m += NGW) rms_row_to_bf16(A.in[I_X] + (size_t)m * D, A.in[I_NMIX], (bf16*)(ws + WS_ACTA) + (size_t)m * D, F.lane);
}
__device__ __forceinline__ void p0_deferred(const Args& A, Frame& F, int wg, int nwg) {
    const int gw = wg * NWAVES + F.wave, NGW = nwg * NWAVES;
    int gtid = gw * 64 + F.lane; const int gthreads = nwg * NTHREADS;
    asm volatile("" : "+v"(gtid));
    unsigned char* ws = A.ws;
    {
        LAS float* scr = (LAS float*)(F.lds + RING_OFF + F.wave * 16384);
        constexpr int I_SQ = (D / 64) * (D / 32), I_ODIN = (D / 64) * (OD_N / 32), I_PJ = (256 / 64) * (D / 32);
        constexpr int NITEMS = I_SQ + I_ODIN + I_SQ + 2 * I_PJ;
        for (int it = gw; it < NITEMS; it += NGW) {
            int r = it;
            if (r < I_SQ) { p0_transpose_item(A.in[I_EV_WOUT], D, D, (bf16*)(ws + WS_WEV_OUT), scr, r, F.lane); continue; } r -= I_SQ;
            if (r < I_ODIN) { p0_transpose_item(A.in[I_OD_WIN], D, OD_N, (bf16*)(ws + WS_WOD_IN), scr, r, F.lane, A.in[I_NMIX] + D); continue; } r -= I_ODIN;
            if (r < I_SQ) { p0_transpose_item(A.in[I_PLE_WG], D, D, (bf16*)(ws + WS_WGATE), scr, r, F.lane, A.in[I_NPLE]); continue; } r -= I_SQ;
            { const int L = r / I_PJ; p0_transpose_item(A.in[I_PLE_WP] + (size_t)L * 256 * D, 256, D, (bf16*)(ws + WS_WPROJ) + (size_t)L * D * 256, scr, r % I_PJ, F.lane); }
        }
        { GAS v4u* z1 = (GAS v4u*)(ws + WS_WOD_IN + (size_t)OD_N * D * 2); const size_t n1 = (size_t)(OD_NP - OD_N) * D * 2 / 16;
          for (size_t i = gtid; i < n1; i += gthreads) z1[i] = (v4u){0u, 0u, 0u, 0u}; }
    }
    __syncthreads();
    for (int it = wg; it < 512; it += nwg)
        p0_fold_item(A.in[I_PEER_WQ], A.in[I_PEER_SK], (bf16*)(ws + WS_WPEER), (LAS float*)(F.lds + RING_OFF), it, F.tid, A.in[I_NFFN]);
    cvt_f32_fp8(A.in[I_PEER_U], (unsigned char*)(ws + WS_TABU), (size_t)16384 * D, 512.0f, gtid, gthreads, A.in[I_NFFN]);
    cvt_f32_fp8(A.in[I_PEER_V], (unsigned char*)(ws + WS_TABV), (size_t)16384 * D, 16.0f, gtid, gthreads);
    cvt_f32_bf16(A.in[I_P], (bf16*)(ws + WS_PBF), (size_t)2 * T * 256, gtid, gthreads);
    { bf16* LB = (bf16*)(ws + WS_WLORA); const float* w2 = A.in[I_W2]; const float* a2 = A.in[I_A2]; const float* g2 = A.in[I_G2];
      for (int i = gtid; i < LORA_N * LORA_K / 2; i += gthreads) { const int row = i / (LORA_K / 2), col = (i % (LORA_K / 2)) * 2; float v[2];
#pragma unroll
          for (int e = 0; e < 2; ++e) { const int c = col + e; float x = 0.f;
              if (row < 1024) { if (c < 96) x = w2[c * 1024 + row]; }
              else if (row < 2048) { if (c >= 96 && c < 192) x = a2[(c - 96) * 1024 + (row - 1024)]; }
              else { if (c >= 192 && c < 448) x = g2[(c - 192) * 1024 + (row - 2048)]; }
              v[e] = x; }
          *(GAS unsigned*)(LB + (size_t)row * LORA_K + col) = pk2(v[0], v[1]); } }
}
__device__ __forceinline__ void p1_deferred(const Args& A, Frame& F, int wg, int nwg) {
    const int gw = wg * NWAVES + F.wave, NGW = nwg * NWAVES;
    int gtid = gw * 64 + F.lane; const int gthreads = nwg * NTHREADS;
    asm volatile("" : "+v"(gtid));
    unsigned char* ws = A.ws;
    { LAS float* scr = (LAS float*)(F.lds + RING_OFF + F.wave * 16384); constexpr int I_SQ = (D / 64) * (D / 32);
      for (int it = gw; it < 2 * I_SQ; it += NGW) {
          if (it < I_SQ) p0_transpose_item(A.in[I_OD_WOUT], D, D, (bf16*)(ws + WS_WOD_OUT), scr, it, F.lane);
          else p0_transpose_item(A.in[I_PLE_WG] + (size_t)D * D, D, D, (bf16*)(ws + WS_WGATE) + (size_t)D * D, scr, it - I_SQ, F.lane, A.in[I_NPLE] + D); } }
    __syncthreads();
    for (int it = wg; it < 512; it += nwg)
        p0_fold_item(A.in[I_PEER_WQ] + (size_t)D * D, A.in[I_PEER_SK] + (size_t)16 * 128 * 128, (bf16*)(ws + WS_WPEER) + (size_t)D * D, (LAS float*)(F.lds + RING_OFF), it, F.tid, A.in[I_NFFN] + D);
    cvt_f32_fp8(A.in[I_PEER_U] + (size_t)16384 * D, (unsigned char*)(ws + WS_TABU) + (size_t)16384 * D, (size_t)16384 * D, 512.0f, gtid, gthreads, A.in[I_NFFN] + D);
    cvt_f32_fp8(A.in[I_PEER_V] + (size_t)16384 * D, (unsigned char*)(ws + WS_TABV) + (size_t)16384 * D, (size_t)16384 * D, 16.0f, gtid, gthreads);
}

constexpr int TC = 16, NCHUNK = SEQ / TC;
typedef unsigned u32x2 __attribute__((ext_vector_type(2)));

template <int MODE>
__device__ __forceinline__ void scan_gla_unit(const Args& A, Frame& F, int unit) {
    int tid = F.tid; asm volatile("" : "+v"(tid));
    const int lane = tid & 63, w = F.wave;
    int b, h, qcol, kcol, vcol, ocol;
    if (MODE == 0) { b = unit >> 4; h = (unit >> 2) & 3; const int s = unit & 3; qcol = EC_GQ + h * 128; kcol = EC_GK + h * 128; vcol = EC_GV + h * 256 + s * 64; ocol = h * 256 + s * 64; }
    else           { b = unit >> 4; h = (unit >> 1) & 7; const int s = unit & 1; qcol = OC_HQ + h * 128; kcol = OC_HF + h * 128; vcol = OC_HI + h * 128 + s * 64; ocol = h * 128 + s * 64; }
    const bf16* P = (const bf16*)(A.ws + WS_PROJ) + (size_t)b * SEQ * PROJ_LD;
    float* O = (float*)(A.ws + WS_O) + (size_t)b * SEQ * D + ocol;
    LAS float* Lf = (LAS float*)(F.lds + RING_OFF);
    constexpr int BUFSZ = 7168, O_EG = 0, O_K = 2048, O_Q = 4096, O_V = 6144, O_OUT = 2 * BUFSZ, O_W2 = O_OUT + 1024, O_BIAS = O_W2 + 2048;
    const int tl = tid >> 5, dq = (tid & 31) * 4, tlv = tid >> 4, c4 = (tid & 15) * 4;
    float lb[4] = {0.f, 0.f, 0.f, 0.f};
    if (MODE == 0) {
        const float* w2 = A.in[I_GK_W2]; const float* gb = A.in[I_GK_B];
        for (int i = tid; i < 2048; i += NTHREADS) Lf[O_W2 + i] = w2[(i >> 7) * 512 + h * 128 + (i & 127)];
        if (tid < 128) Lf[O_BIAS + tid] = gb[h * 128 + tid];
    } else {
        const float* lg = A.in[I_LB];
#pragma unroll
        for (int i = 0; i < 4; ++i) lb[i] = sigmoidf_(lg[1024 + h * 128 + dq + i] - lg[h * 128 + dq + i]);
    }
    u32x2 rq, rk, rv = {0u, 0u}; v4u rg0 = {0u, 0u, 0u, 0u}, rg1 = {0u, 0u, 0u, 0u};
#define GLA_LOAD(c) do { const bf16* pr = P + (size_t)((c) * TC + tl) * PROJ_LD; rq = *(const GAS u32x2*)(pr + qcol + dq); rk = *(const GAS u32x2*)(pr + kcol + dq); \
        if (MODE == 0) { rg0 = *(const GAS v4u*)(pr + EC_GLR); rg1 = *(const GAS v4u*)(pr + EC_GLR + 8); } \
        if (tid < 256) rv = *(const GAS u32x2*)(P + (size_t)((c) * TC + tlv) * PROJ_LD + vcol + c4); } while (0)
#define GLA_XFORM(bufi) do { LAS float* B_ = Lf + (bufi) * BUFSZ; f32x4 q4, k4, e4; \
        const float xq[4] = {bf_lo(rq.x), bf_hi(rq.x), bf_lo(rq.y), bf_hi(rq.y)}, xk[4] = {bf_lo(rk.x), bf_hi(rk.x), bf_lo(rk.y), bf_hi(rk.y)}; \
        if (MODE == 0) { f32x4 z = *(const LAS f32x4*)(Lf + O_BIAS + dq); \
            const float gl[16] = {bf_lo(rg0.x), bf_hi(rg0.x), bf_lo(rg0.y), bf_hi(rg0.y), bf_lo(rg0.z), bf_hi(rg0.z), bf_lo(rg0.w), bf_hi(rg0.w), \
                                  bf_lo(rg1.x), bf_hi(rg1.x), bf_lo(rg1.y), bf_hi(rg1.y), bf_lo(rg1.z), bf_hi(rg1.z), bf_lo(rg1.w), bf_hi(rg1.w)}; \
            _Pragma("unroll") for (int r_ = 0; r_ < 16; ++r_) { const f32x4 wv = *(const LAS f32x4*)(Lf + O_W2 + r_ * 128 + dq); z = z + wv * gl[r_]; } \
            _Pragma("unroll") for (int i_ = 0; i_ < 4; ++i_) { q4[i_] = xq[i_] * 0.08838834764831845f; k4[i_] = xk[i_]; e4[i_] = __builtin_amdgcn_exp2f(-0.0625f * __builtin_amdgcn_logf(1.0f + __expf(-z[i_]))); } } \
        else { _Pragma("unroll") for (int i_ = 0; i_ < 4; ++i_) { const float fg = lb[i_] + (1.f - lb[i_]) * sigmoidf_(xk[i_]); q4[i_] = siluf_(xq[i_]); k4[i_] = 1.f - fg; e4[i_] = fg; } } \
        *(LAS f32x4*)(B_ + O_EG + tl * 128 + dq) = e4; *(LAS f32x4*)(B_ + O_K + tl * 128 + dq) = k4; *(LAS f32x4*)(B_ + O_Q + tl * 128 + dq) = q4; \
        if (tid < 256) { f32x4 v4 = {bf_lo(rv.x), bf_hi(rv.x), bf_lo(rv.y), bf_hi(rv.y)}; *(LAS f32x4*)(B_ + O_V + tlv * 64 + c4) = v4; } } while (0)
    LBAR();
    GLA_LOAD(0); GLA_XFORM(0);
    LBAR();
    f32x2 S2[8];
#pragma unroll
    for (int i = 0; i < 8; ++i) S2[i] = (f32x2){0.f, 0.f};
    const int j = lane & 15, col = w * 8 + (lane >> 4) * 2;
    for (int c = 0; c < NCHUNK; ++c) {
        if (c + 1 < NCHUNK) GLA_LOAD(c + 1);
        const LAS float* B_ = Lf + (c & 1) * BUFSZ;
        float os0 = 0.f, os1 = 0.f;
        f32x4 e0, e1, k0, k1, q0, q1, ne0, ne1, nk0, nk1, nq0, nq1; f32x2 v2, nv2;
#define GLA_LDSTEP(t_, E0, E1, K0, K1, Q0, Q1, V2) do { E0 = *(const LAS f32x4*)(B_ + O_EG + (t_) * 128 + 4 * j); E1 = *(const LAS f32x4*)(B_ + O_EG + (t_) * 128 + 64 + 4 * j); \
            K0 = *(const LAS f32x4*)(B_ + O_K + (t_) * 128 + 4 * j); K1 = *(const LAS f32x4*)(B_ + O_K + (t_) * 128 + 64 + 4 * j); \
            Q0 = *(const LAS f32x4*)(B_ + O_Q + (t_) * 128 + 4 * j); Q1 = *(const LAS f32x4*)(B_ + O_Q + (t_) * 128 + 64 + 4 * j); V2 = *(const LAS f32x2*)(B_ + O_V + (t_) * 64 + col); } while (0)
        GLA_LDSTEP(0, e0, e1, k0, k1, q0, q1, v2);
#pragma unroll
        for (int t = 0; t < TC; ++t) {
            if (t + 1 < TC) { GLA_LDSTEP(t + 1, ne0, ne1, nk0, nk1, nq0, nq1, nv2); }
            __builtin_amdgcn_sched_barrier(0);
            f32x2 pa = {0.f, 0.f}, pb = {0.f, 0.f};
#pragma unroll
            for (int i = 0; i < 4; ++i) {
                S2[i] = S2[i] * e0[i] + v2 * k0[i]; S2[4 + i] = S2[4 + i] * e1[i] + v2 * k1[i];
                pa += S2[i] * q0[i]; pb += S2[4 + i] * q1[i]; }
            pa += pb;
            float p0 = pa[0], p1 = pa[1];
            row_sum16_x2(p0, p1);
            os0 = (j == t) ? p0 : os0; os1 = (j == t) ? p1 : os1;
            e0 = ne0; e1 = ne1; k0 = nk0; k1 = nk1; q0 = nq0; q1 = nq1; v2 = nv2;
        }
#undef GLA_LDSTEP
        { f32x2 o2 = {os0, os1}; *(LAS f32x2*)(Lf + O_OUT + j * 64 + col) = o2; }
        if (c + 1 < NCHUNK) GLA_XFORM((c + 1) & 1);
        LBAR();
        if (tid < 256) *(GAS f32x4*)(O + (size_t)(c * TC + tlv) * D + c4) = *(const LAS f32x4*)(Lf + O_OUT + tlv * 64 + c4);
        LBAR();
    }
#undef GLA_LOAD
#undef GLA_XFORM
}

__device__ __forceinline__ void scan_gdn_unit(const Args& A, Frame& F, int unit) {
    int tid = F.tid; asm volatile("" : "+v"(tid));
    const int lane = tid & 63, w = F.wave;
    const int b = unit >> 4, h = (unit >> 1) & 7, s = unit & 1;
    const int qcol = EC_BQ + h * 128, kcol = EC_BK + h * 128, vcol = EC_BV + h * 128 + s * 64, ocol = 1024 + h * 128 + s * 64;
    const bf16* P = (const bf16*)(A.ws + WS_PROJ) + (size_t)b * SEQ * PROJ_LD;
    float* O = (float*)(A.ws + WS_O) + (size_t)b * SEQ * D + ocol;
    LAS float* Lf = (LAS float*)(F.lds + RING_OFF);
    constexpr int BUFSZ = 5184, O_K = 0, O_Q = 2048, O_V = 4096, O_SC = 5120, O_OUT = 2 * BUFSZ, O_CW = O_OUT + 1024;
    const int tl = tid >> 5, dq = (tid & 31) * 4, tlv = tid >> 4, c4 = (tid & 15) * 4;
    { const float* cw = A.in[I_GDN_CONV];
      for (int i = tid; i < 4 * 320; i += NTHREADS) { const int jt = i / 320, x = i % 320;
          const int ch = x < 128 ? (h * 128 + x) : x < 256 ? (1024 + h * 128 + (x - 128)) : (2048 + h * 128 + s * 64 + (x - 256));
          Lf[O_CW + i] = cw[jt * 3072 + ch]; } }
    const float neg_ea = -__expf(A.in[I_GDN_ALOG][h]), dtb = A.in[I_GDN_DTB][h];
    u32x2 rq[4], rk[4], rv[4]; unsigned short rba = 0, rbb = 0;
#pragma unroll
    for (int i = 0; i < 4; ++i) rv[i] = (u32x2){0u, 0u};
#define GDN_LOAD(c) do { const int t_ = (c) * TC + tl; \
        _Pragma("unroll") for (int jt = 0; jt < 4; ++jt) { const int tt = t_ - 3 + jt; \
            if (tt >= 0) { const bf16* pr = P + (size_t)tt * PROJ_LD; rq[jt] = *(const GAS u32x2*)(pr + qcol + dq); rk[jt] = *(const GAS u32x2*)(pr + kcol + dq); } \
            else { rq[jt] = (u32x2){0u, 0u}; rk[jt] = (u32x2){0u, 0u}; } } \
        { const bf16* pr = P + (size_t)t_ * PROJ_LD; rba = pr[EC_BA + h]; rbb = pr[EC_BB + h]; } \
        if (tid < 256) { const int tv = (c) * TC + tlv; \
            _Pragma("unroll") for (int jt = 0; jt < 4; ++jt) { const int tt = tv - 3 + jt; \
                if (tt >= 0) rv[jt] = *(const GAS u32x2*)(P + (size_t)tt * PROJ_LD + vcol + c4); else rv[jt] = (u32x2){0u, 0u}; } } } while (0)
#define GDN_XFORM(bufi) do { LAS float* B_ = Lf + (bufi) * BUFSZ; f32x4 q4 = {0.f, 0.f, 0.f, 0.f}, k4 = {0.f, 0.f, 0.f, 0.f}; \
        _Pragma("unroll") for (int jt = 0; jt < 4; ++jt) { const f32x4 wq = *(const LAS f32x4*)(Lf + O_CW + jt * 320 + dq), wk = *(const LAS f32x4*)(Lf + O_CW + jt * 320 + 128 + dq); \
            q4[0] += wq[0] * bf_lo(rq[jt].x); q4[1] += wq[1] * bf_hi(rq[jt].x); q4[2] += wq[2] * bf_lo(rq[jt].y); q4[3] += wq[3] * bf_hi(rq[jt].y); \
            k4[0] += wk[0] * bf_lo(rk[jt].x); k4[1] += wk[1] * bf_hi(rk[jt].x); k4[2] += wk[2] * bf_lo(rk[jt].y); k4[3] += wk[3] * bf_hi(rk[jt].y); } \
        float sq = 0.f, sk = 0.f, sqk = 0.f; \
        _Pragma("unroll") for (int i_ = 0; i_ < 4; ++i_) { q4[i_] = siluf_(q4[i_]); k4[i_] = siluf_(k4[i_]); sq += q4[i_] * q4[i_]; sk += k4[i_] * k4[i_]; sqk += q4[i_] * k4[i_]; } \
        sq = half_sum32(sq); sk = half_sum32(sk); sqk = half_sum32(sqk); \
        const float rq_ = __builtin_amdgcn_rsqf(sq + EPS) * 0.08838834764831845f, rk_ = __builtin_amdgcn_rsqf(sk + EPS); \
        q4 = q4 * rq_; k4 = k4 * rk_; \
        *(LAS f32x4*)(B_ + O_K + tl * 128 + dq) = k4; *(LAS f32x4*)(B_ + O_Q + tl * 128 + dq) = q4; \
        if ((tid & 31) == 0) { const float ba = __uint_as_float((unsigned)rba << 16), bb = __uint_as_float((unsigned)rbb << 16); \
            f32x4 sc; sc[0] = __expf(neg_ea * softplusf_(ba + dtb)); sc[1] = sigmoidf_(bb); sc[2] = sqk * rq_ * rk_; sc[3] = 0.f; *(LAS f32x4*)(B_ + O_SC + tl * 4) = sc; } \
        if (tid < 256) { f32x4 v4 = {0.f, 0.f, 0.f, 0.f}; \
            _Pragma("unroll") for (int jt = 0; jt < 4; ++jt) { const f32x4 wv = *(const LAS f32x4*)(Lf + O_CW + jt * 320 + 256 + c4); \
                v4[0] += wv[0] * bf_lo(rv[jt].x); v4[1] += wv[1] * bf_hi(rv[jt].x); v4[2] += wv[2] * bf_lo(rv[jt].y); v4[3] += wv[3] * bf_hi(rv[jt].y); } \
            _Pragma("unroll") for (int i_ = 0; i_ < 4; ++i_) v4[i_] = siluf_(v4[i_]); \
            *(LAS f32x4*)(B_ + O_V + tlv * 64 + c4) = v4; } } while (0)
    LBAR();
    GDN_LOAD(0); GDN_XFORM(0);
    LBAR();
    f32x2 S2[8];
#pragma unroll
    for (int i = 0; i < 8; ++i) S2[i] = (f32x2){0.f, 0.f};
    const int j = lane & 15, col = w * 8 + (lane >> 4) * 2;
    for (int c = 0; c < NCHUNK; ++c) {
        if (c + 1 < NCHUNK) GDN_LOAD(c + 1);
        const LAS float* B_ = Lf + (c & 1) * BUFSZ;
        float os0 = 0.f, os1 = 0.f;
        f32x4 k0, k1, q0, q1, sc, nk0, nk1, nq0, nq1, nsc; f32x2 v2, nv2;
#define GDN_LDSTEP(t_, K0, K1, Q0, Q1, V2, SC) do { K0 = *(const LAS f32x4*)(B_ + O_K + (t_) * 128 + 4 * j); K1 = *(const LAS f32x4*)(B_ + O_K + (t_) * 128 + 64 + 4 * j); \
            Q0 = *(const LAS f32x4*)(B_ + O_Q + (t_) * 128 + 4 * j); Q1 = *(const LAS f32x4*)(B_ + O_Q + (t_) * 128 + 64 + 4 * j); V2 = *(const LAS f32x2*)(B_ + O_V + (t_) * 64 + col); SC = *(const LAS f32x4*)(B_ + O_SC + (t_) * 4); } while (0)
        GDN_LDSTEP(0, k0, k1, q0, q1, v2, sc);
#pragma unroll
        for (int t = 0; t < TC; ++t) {
            if (t + 1 < TC) { GDN_LDSTEP(t + 1, nk0, nk1, nq0, nq1, nv2, nsc); }
            __builtin_amdgcn_sched_barrier(0);
            f32x2 d1 = {0.f, 0.f}, d2 = {0.f, 0.f}, e1 = {0.f, 0.f}, e2 = {0.f, 0.f};
#pragma unroll
            for (int i = 0; i < 4; ++i) { d1 += S2[i] * k0[i]; e1 += S2[4 + i] * k1[i]; d2 += S2[i] * q0[i]; e2 += S2[4 + i] * q1[i]; }
            d1 += e1; d2 += e2;
            { float r0_ = d1[0], r1_ = d1[1], r2_ = d2[0], r3_ = d2[1]; row_sum16_x4(r0_, r1_, r2_, r3_); d1[0] = r0_; d1[1] = r1_; d2[0] = r2_; d2[1] = r3_; }
            const float a = sc[0], beta = sc[1], qk = sc[2];
            const f32x2 dl = (v2 - d1 * a) * beta;
            const f32x2 o2 = d2 * a + dl * qk;
#pragma unroll
            for (int i = 0; i < 4; ++i) { S2[i] = S2[i] * a + dl * k0[i]; S2[4 + i] = S2[4 + i] * a + dl * k1[i]; }
            os0 = (j == t) ? o2[0] : os0; os1 = (j == t) ? o2[1] : os1;
            k0 = nk0; k1 = nk1; q0 = nq0; q1 = nq1; v2 = nv2; sc = nsc;
        }
#undef GDN_LDSTEP
        { f32x2 o2 = {os0, os1}; *(LAS f32x2*)(Lf + O_OUT + j * 64 + col) = o2; }
        if (c + 1 < NCHUNK) GDN_XFORM((c + 1) & 1);
        LBAR();
        if (tid < 256) *(GAS f32x4*)(O + (size_t)(c * TC + tlv) * D + c4) = *(const LAS f32x4*)(Lf + O_OUT + tlv * 64 + c4);
        LBAR();
    }
#undef GDN_LOAD
#undef GDN_XFORM
}

typedef short bf16x4_t __attribute__((ext_vector_type(4)));
__device__ __forceinline__ bf16x8 mk_frag(u32x2 lo, u32x2 hi) { v4u t; t.x = lo.x; t.y = lo.y; t.z = hi.x; t.w = hi.y; return __builtin_bit_cast(bf16x8, t); }
template <int MODE>
__device__ __forceinline__ void scan_gla_mfma_unit(const Args& A, Frame& F, int unit) {
    int tid = F.tid; asm volatile("" : "+v"(tid));
    const int lane = tid & 63, w = F.wave;
    int b, h, qcol, kcol, vcol, ocol;
    if (MODE == 0) { b = unit >> 3; h = (unit >> 1) & 3; const int s = unit & 1; qcol = EC_GQ + h * 128; kcol = EC_GK + h * 128; vcol = EC_GV + h * 256 + s * 128; ocol = h * 256 + s * 128; }
    else           { b = unit >> 3; h = unit & 7; qcol = OC_HQ + h * 128; kcol = OC_HF + h * 128; vcol = OC_HI + h * 128; ocol = h * 128; }
    const bf16* P = (const bf16*)(A.ws + WS_PROJ) + (size_t)b * SEQ * PROJ_LD;
    bf16* O = (bf16*)(A.ws + WS_O) + (size_t)b * SEQ * D + ocol;
    LAS float* Lf = (LAS float*)(F.lds + RING_OFF);
    constexpr int BUFSZ = 8192, O_E = 0, O_K = 2048, O_Q = 4096, O_V = 6144, RS = 136, O_QB = 2 * BUFSZ, O_KB = O_QB + 1088, O_KT = O_KB + 1088, O_BL = O_KT + 1024, O_AM = O_BL + 128, O_W2 = O_AM + 128, O_BIAS = O_W2 + 2048;
    LAS bf16* QB = (LAS bf16*)(Lf + O_QB); LAS bf16* KB = (LAS bf16*)(Lf + O_KB); LAS bf16* KT = (LAS bf16*)(Lf + O_KT); LAS bf16* AM = (LAS bf16*)(Lf + O_AM);
    const int tl = tid >> 5, dq = (tid & 31) * 4;
    float lb[4] = {0.f, 0.f, 0.f, 0.f};
    if (MODE == 0) {
        const float* w2 = A.in[I_GK_W2]; const float* gb = A.in[I_GK_B];
        for (int i = tid; i < 2048; i += NTHREADS) Lf[O_W2 + i] = w2[(i >> 7) * 512 + h * 128 + (i & 127)];
        if (tid < 128) Lf[O_BIAS + tid] = gb[h * 128 + tid];
    } else {
        const float* lg = A.in[I_LB];
#pragma unroll
        for (int i = 0; i < 4; ++i) lb[i] = sigmoidf_(lg[1024 + h * 128 + dq + i] - lg[h * 128 + dq + i]);
    }
    u32x2 rq, rk, rv; v4u rg0 = {0u, 0u, 0u, 0u}, rg1 = {0u, 0u, 0u, 0u};
#define GM_LOAD(c) do { const bf16* pr = P + (size_t)((c) * TC + tl) * PROJ_LD; rq = *(const GAS u32x2*)(pr + qcol + dq); rk = *(const GAS u32x2*)(pr + kcol + dq); rv = *(const GAS u32x2*)(pr + vcol + dq); \
        if (MODE == 0) { rg0 = *(const GAS v4u*)(pr + EC_GLR); rg1 = *(const GAS v4u*)(pr + EC_GLR + 8); } } while (0)
#define GM_XFORM(bufi) do { LAS float* B_ = Lf + (bufi) * BUFSZ; f32x4 q4, k4, e4; \
        const float xq[4] = {bf_lo(rq.x), bf_hi(rq.x), bf_lo(rq.y), bf_hi(rq.y)}, xk[4] = {bf_lo(rk.x), bf_hi(rk.x), bf_lo(rk.y), bf_hi(rk.y)}; \
        if (MODE == 0) { f32x4 z = *(const LAS f32x4*)(Lf + O_BIAS + dq); \
            const float gl[16] = {bf_lo(rg0.x), bf_hi(rg0.x), bf_lo(rg0.y), bf_hi(rg0.y), bf_lo(rg0.z), bf_hi(rg0.z), bf_lo(rg0.w), bf_hi(rg0.w), \
                                  bf_lo(rg1.x), bf_hi(rg1.x), bf_lo(rg1.y), bf_hi(rg1.y), bf_lo(rg1.z), bf_hi(rg1.z), bf_lo(rg1.w), bf_hi(rg1.w)}; \
            _Pragma("unroll") for (int r_ = 0; r_ < 16; ++r_) { const f32x4 wv = *(const LAS f32x4*)(Lf + O_W2 + r_ * 128 + dq); z = z + wv * gl[r_]; } \
            _Pragma("unroll") for (int i_ = 0; i_ < 4; ++i_) { q4[i_] = xq[i_] * 0.08838834764831845f; k4[i_] = xk[i_]; e4[i_] = __builtin_amdgcn_exp2f(-0.0625f * __builtin_amdgcn_logf(1.0f + __expf(-z[i_]))); } } \
        else { _Pragma("unroll") for (int i_ = 0; i_ < 4; ++i_) { const float fg = lb[i_] + (1.f - lb[i_]) * sigmoidf_(xk[i_]); q4[i_] = siluf_(xq[i_]); k4[i_] = 1.f - fg; e4[i_] = fg; } } \
        *(LAS f32x4*)(B_ + O_E + tl * 128 + dq) = e4; *(LAS f32x4*)(B_ + O_K + tl * 128 + dq) = k4; *(LAS f32x4*)(B_ + O_Q + tl * 128 + dq) = q4; \
        { f32x4 v4 = {bf_lo(rv.x), bf_hi(rv.x), bf_lo(rv.y), bf_hi(rv.y)}; *(LAS f32x4*)(B_ + O_V + tl * 128 + dq) = v4; } } while (0)
    LBAR();
    GM_LOAD(0); GM_XFORM(0); GM_LOAD(1);
    LBAR();
    f32x4 Sacc[8];
#pragma unroll
    for (int i = 0; i < 8; ++i) Sacc[i] = (f32x4){0.f, 0.f, 0.f, 0.f};
    const int fr = lane & 15, g = lane >> 4, c0 = w * 16;
    for (int c = 0; c < NCHUNK; ++c) {
        const LAS float* B_ = Lf + (c & 1) * BUFSZ;
        {
            const int seg = tid >> 7, d = tid & 127;
            float bt = 1.f, ball = 1.f;
#pragma unroll
            for (int t = 0; t < 16; ++t) { const float e = B_[O_E + t * 128 + d]; ball *= e; if (t < 4 * seg) bt = ball; }
            ball = fmaxf(ball, 1e-30f);
            unsigned short kt4[4];
#pragma unroll
            for (int i = 0; i < 4; ++i) { const int t = 4 * seg + i; bt = fmaxf(bt * B_[O_E + t * 128 + d], 1e-30f);
                const float kk = B_[O_K + t * 128 + d], qq = B_[O_Q + t * 128 + d], ib = __builtin_amdgcn_rcpf(bt);
                QB[t * RS + d] = hw_bf(qq * bt); KB[t * RS + d] = hw_bf(kk * ib); kt4[i] = (unsigned short)hw_bf(kk * ball * ib); }
            u32x2 kw; kw.x = (unsigned)kt4[0] | ((unsigned)kt4[1] << 16); kw.y = (unsigned)kt4[2] | ((unsigned)kt4[3] << 16);
            *(LAS u32x2*)(KT + d * 16 + 4 * seg) = kw;
            if (seg == 3) Lf[O_BL + d] = ball;
        }
        LBAR();
        if (w == 0) {
            f32x4 acc = {0.f, 0.f, 0.f, 0.f};
#pragma unroll
            for (int ks = 0; ks < 4; ++ks) { const bf16x8 af = *(const LAS bf16x8*)(QB + fr * RS + 32 * ks + 8 * g), bfm = *(const LAS bf16x8*)(KB + fr * RS + 32 * ks + 8 * g);
                acc = __builtin_amdgcn_mfma_f32_16x16x32_bf16(af, bfm, acc, 0, 0, 0); }
#pragma unroll
            for (int r = 0; r < 4; ++r) { const int t = 4 * g + r, s = fr; AM[t * 16 + s] = hw_bf(s <= t ? acc[r] : 0.f); }
        }
        if (c + 1 < NCHUNK) GM_XFORM((c + 1) & 1);
        if (c + 2 < NCHUNK) GM_LOAD(c + 2);
        LBAR();
        {
            u32x2 vlo; { const float v0 = B_[O_V + (4 * g + 0) * 128 + c0 + fr], v1 = B_[O_V + (4 * g + 1) * 128 + c0 + fr], v2 = B_[O_V + (4 * g + 2) * 128 + c0 + fr], v3 = B_[O_V + (4 * g + 3) * 128 + c0 + fr];
                vlo.x = hw_pk2(v0, v1); vlo.y = hw_pk2(v2, v3); }
            const u32x2 zz = {0u, 0u};
            const bf16x8 vb = mk_frag(vlo, zz);
            f32x4 acco = {0.f, 0.f, 0.f, 0.f};
#pragma unroll
            for (int ks = 0; ks < 4; ++ks) {
                u32x2 slo, shi; slo.x = hw_pk2(Sacc[2 * ks][0], Sacc[2 * ks][1]); slo.y = hw_pk2(Sacc[2 * ks][2], Sacc[2 * ks][3]); shi.x = hw_pk2(Sacc[2 * ks + 1][0], Sacc[2 * ks + 1][1]); shi.y = hw_pk2(Sacc[2 * ks + 1][2], Sacc[2 * ks + 1][3]);
                const bf16x8 sb = mk_frag(slo, shi);
                const u32x2 qlo = *(const LAS u32x2*)(QB + fr * RS + 32 * ks + 4 * g), qhi = *(const LAS u32x2*)(QB + fr * RS + 32 * ks + 16 + 4 * g);
                acco = __builtin_amdgcn_mfma_f32_16x16x32_bf16(mk_frag(qlo, qhi), sb, acco, 0, 0, 0); }
            { const u32x2 alo = *(const LAS u32x2*)(AM + fr * 16 + 4 * g); acco = __builtin_amdgcn_mfma_f32_16x16x32_bf16(mk_frag(alo, zz), vb, acco, 0, 0, 0); }
#pragma unroll
            for (int r = 0; r < 4; ++r) O[(size_t)(c * TC + 4 * g + r) * D + c0 + fr] = hw_bf(acco[r]);
#pragma unroll
            for (int i = 0; i < 8; ++i) { const f32x4 bl = *(const LAS f32x4*)(Lf + O_BL + 16 * i + 4 * g); const u32x2 klo = *(const LAS u32x2*)(KT + (16 * i + fr) * 16 + 4 * g);
                Sacc[i] = __builtin_amdgcn_mfma_f32_16x16x32_bf16(mk_frag(klo, zz), vb, Sacc[i] * bl, 0, 0, 0); }
        }
        LBAR();
    }
#undef GM_LOAD
#undef GM_XFORM
}

__device__ __forceinline__ void scan_gdn_mfma_unit(const Args& A, Frame& F, int unit, const int role) {
    int tid = F.tid; asm volatile("" : "+v"(tid));
    const int lane = tid & 63, w = F.wave;
    const int b = unit >> 3, h = unit & 7;
    const int qcol = EC_BQ + h * 128, kcol = EC_BK + h * 128, vcol = EC_BV + h * 128, ocol = 1024 + h * 128;
    const bf16* P = (const bf16*)(A.ws + WS_PROJ) + (size_t)b * SEQ * PROJ_LD;
    bf16* O = (bf16*)(A.ws + WS_O) + (size_t)b * SEQ * D + ocol;
    LAS float* Lf = (LAS float*)(F.lds + RING_OFF);
    constexpr int O_CW = 0, O_AMAT = 1536, O_QKM = O_AMAT + 256, O_TB = O_QKM + 128, O_GL = O_TB + 128, O_BUF0 = O_GL + 64;
    constexpr int BUFSZ = 6208, O_KH = 0, O_QH = 2048, O_VV = 4096, O_SC = 6144;
    constexpr int RS = 136;
    constexpr int O_KHB = O_BUF0 + 2 * BUFSZ, O_QHB = O_KHB + 1088, O_QB = O_QHB + 1088, O_KT = O_QB + 1088, O_WSRC = O_KT + 1024, O_WB = O_WSRC + 2048;
    LAS bf16* KHB = (LAS bf16*)(Lf + O_KHB); LAS bf16* QHB = (LAS bf16*)(Lf + O_QHB); LAS bf16* QB = (LAS bf16*)(Lf + O_QB); LAS bf16* KT = (LAS bf16*)(Lf + O_KT);
    LAS bf16* WB = (LAS bf16*)(Lf + O_WB); LAS bf16* QKM = (LAS bf16*)(Lf + O_QKM); LAS bf16* TB = (LAS bf16*)(Lf + O_TB);
    const int tl = tid >> 5, dq = (tid & 31) * 4;
    { const float* cw = A.in[I_GDN_CONV];
      for (int i = tid; i < 4 * 384; i += NTHREADS) { const int jt = i / 384, x = i % 384; Lf[O_CW + i] = cw[jt * 3072 + (x >> 7) * 1024 + h * 128 + (x & 127)]; } }
    const float neg_ea = -__expf(A.in[I_GDN_ALOG][h]), dtb = A.in[I_GDN_DTB][h];
    u32x2 rq[4], rk[4], rv[4]; unsigned short rba = 0, rbb = 0;
#define GD_LOAD(c) do { const int t_ = (c) * TC + tl; \
        _Pragma("unroll") for (int jt = 0; jt < 4; ++jt) { const int tt = t_ - 3 + jt; const bf16* pr = P + (size_t)(tt < 0 ? 0 : tt) * PROJ_LD + dq; \
            rq[jt] = *(const GAS u32x2*)(pr + qcol); rk[jt] = *(const GAS u32x2*)(pr + kcol); rv[jt] = *(const GAS u32x2*)(pr + vcol); \
            if (tt < 0) { rq[jt] = (u32x2){0u, 0u}; rk[jt] = (u32x2){0u, 0u}; rv[jt] = (u32x2){0u, 0u}; } } \
        { const bf16* pr = P + (size_t)t_ * PROJ_LD; rba = pr[EC_BA + h]; rbb = pr[EC_BB + h]; } } while (0)
#define GD_XFORM(bufi) do { LAS float* B_ = Lf + O_BUF0 + (bufi) * BUFSZ; f32x4 q4 = {0.f, 0.f, 0.f, 0.f}, k4 = {0.f, 0.f, 0.f, 0.f}, v4 = {0.f, 0.f, 0.f, 0.f}; \
        _Pragma("unroll") for (int jt = 0; jt < 4; ++jt) { const f32x4 wq = *(const LAS f32x4*)(Lf + O_CW + jt * 384 + dq), wk = *(const LAS f32x4*)(Lf + O_CW + jt * 384 + 128 + dq), wv = *(const LAS f32x4*)(Lf + O_CW + jt * 384 + 256 + dq); \
            q4[0] += wq[0] * bf_lo(rq[jt].x); q4[1] += wq[1] * bf_hi(rq[jt].x); q4[2] += wq[2] * bf_lo(rq[jt].y); q4[3] += wq[3] * bf_hi(rq[jt].y); \
            k4[0] += wk[0] * bf_lo(rk[jt].x); k4[1] += wk[1] * bf_hi(rk[jt].x); k4[2] += wk[2] * bf_lo(rk[jt].y); k4[3] += wk[3] * bf_hi(rk[jt].y); \
            v4[0] += wv[0] * bf_lo(rv[jt].x); v4[1] += wv[1] * bf_hi(rv[jt].x); v4[2] += wv[2] * bf_lo(rv[jt].y); v4[3] += wv[3] * bf_hi(rv[jt].y); } \
        float sq = 0.f, sk = 0.f; \
        _Pragma("unroll") for (int i_ = 0; i_ < 4; ++i_) { q4[i_] = siluf_(q4[i_]); k4[i_] = siluf_(k4[i_]); v4[i_] = siluf_(v4[i_]); sq += q4[i_] * q4[i_]; sk += k4[i_] * k4[i_]; } \
        row_sum16_x2(sq, sk); sq += __shfl_xor(sq, 16); sk += __shfl_xor(sk, 16); \
        q4 = q4 * (__builtin_amdgcn_rsqf(sq + EPS) * 0.08838834764831845f); k4 = k4 * __builtin_amdgcn_rsqf(sk + EPS); \
        *(LAS f32x4*)(B_ + O_KH + tl * 128 + dq) = k4; *(LAS f32x4*)(B_ + O_QH + tl * 128 + dq) = q4; *(LAS f32x4*)(B_ + O_VV + tl * 128 + dq) = v4; \
        if ((tid & 31) == 0) { const float ba = __uint_as_float((unsigned)rba << 16), bb = __uint_as_float((unsigned)rbb << 16); \
            B_[O_SC + tl] = __expf(neg_ea * softplusf_(ba + dtb)); B_[O_SC + 16 + tl] = sigmoidf_(bb); } } while (0)
    LBAR();
    const int c_begin = role ? NCHUNK / 2 : 0, c_end = role ? NCHUNK : NCHUNK / 2;
    constexpr int REC = 5408;
    float* STASH = (float*)(A.ws + WS_LA) + (size_t)unit * (NCHUNK / 2) * REC;
    float* STATE = (float*)(A.ws + WS_STATE) + (size_t)unit * 16384;
    gu32* flag = F.ctl + 32768 + unit * 64;
    GD_LOAD(c_begin); GD_XFORM(c_begin & 1); GD_LOAD(c_begin + 1);
    LBAR();
    f32x4 Sacc[8];
#pragma unroll
    for (int i = 0; i < 8; ++i) Sacc[i] = (f32x4){0.f, 0.f, 0.f, 0.f};
    const int fr = lane & 15, g = lane >> 4, c0 = w * 16;
    const u32x2 zz = {0u, 0u};
#define GD_STATE_PART(cc_) do { \
        { \
            bf16x8 sb[4]; \
_Pragma("unroll") \
            for (int ks = 0; ks < 4; ++ks) { u32x2 slo, shi; slo.x = hw_pk2(Sacc[2 * ks][0], Sacc[2 * ks][1]); slo.y = hw_pk2(Sacc[2 * ks][2], Sacc[2 * ks][3]); shi.x = hw_pk2(Sacc[2 * ks + 1][0], Sacc[2 * ks + 1][1]); shi.y = hw_pk2(Sacc[2 * ks + 1][2], Sacc[2 * ks + 1][3]); \
                sb[ks] = mk_frag(slo, shi); } \
            f32x4 accv = accu, acco = {0.f, 0.f, 0.f, 0.f}; \
_Pragma("unroll") \
            for (int ks = 0; ks < 4; ++ks) { \
                const u32x2 wl = *(const LAS u32x2*)(WB + fr * RS + 32 * ks + 4 * g), wh = *(const LAS u32x2*)(WB + fr * RS + 32 * ks + 16 + 4 * g); \
                accv = __builtin_amdgcn_mfma_f32_16x16x32_bf16(mk_frag(wl, wh), sb[ks], accv, 0, 0, 0); \
                const u32x2 ql = *(const LAS u32x2*)(QB + fr * RS + 32 * ks + 4 * g), qh = *(const LAS u32x2*)(QB + fr * RS + 32 * ks + 16 + 4 * g); \
                acco = __builtin_amdgcn_mfma_f32_16x16x32_bf16(mk_frag(ql, qh), sb[ks], acco, 0, 0, 0); } \
            u32x2 vn; vn.x = hw_pk2(accv[0], accv[1]); vn.y = hw_pk2(accv[2], accv[3]); \
            const bf16x8 vnb = mk_frag(vn, zz); \
            acco = __builtin_amdgcn_mfma_f32_16x16x32_bf16(mk_frag(*(const LAS u32x2*)(QKM + fr * 16 + 4 * g), zz), vnb, acco, 0, 0, 0); \
_Pragma("unroll") \
            for (int r = 0; r < 4; ++r) O[(size_t)((cc_) * TC + 4 * g + r) * D + c0 + fr] = hw_bf(acco[r]); \
_Pragma("unroll") \
            for (int i = 0; i < 8; ++i) { const u32x2 klo = *(const LAS u32x2*)(KT + (16 * i + fr) * 16 + 4 * g); \
                Sacc[i] = __builtin_amdgcn_mfma_f32_16x16x32_bf16(mk_frag(klo, zz), vnb, Sacc[i] * glast, 0, 0, 0); } \
        } \
        } while (0)
    for (int c = c_begin; c < c_end; ++c) {
        const LAS float* B_ = Lf + O_BUF0 + (c & 1) * BUFSZ;
        float glast;
        {
            const int seg = tid >> 7, d = tid & 127;
            const f32x4 a0 = *(const LAS f32x4*)(B_ + O_SC), a1 = *(const LAS f32x4*)(B_ + O_SC + 4), a2 = *(const LAS f32x4*)(B_ + O_SC + 8), a3 = *(const LAS f32x4*)(B_ + O_SC + 12);
            const float av[16] = {a0[0], a0[1], a0[2], a0[3], a1[0], a1[1], a1[2], a1[3], a2[0], a2[1], a2[2], a2[3], a3[0], a3[1], a3[2], a3[3]};
            float p = 1.f, gpre = 1.f;
#pragma unroll
            for (int t = 0; t < 16; ++t) { if (t == 4 * seg) gpre = p; p *= av[t]; }
            glast = p;
            unsigned short kt4[4]; float gt = gpre;
#pragma unroll
            for (int i = 0; i < 4; ++i) { const int t = 4 * seg + i; const float at = (seg == 0) ? av[i] : (seg == 1) ? av[4 + i] : (seg == 2) ? av[8 + i] : av[12 + i]; gt *= at; const float beta = B_[O_SC + 16 + t];
                const float kk = B_[O_KH + t * 128 + d], qq = B_[O_QH + t * 128 + d];
                KHB[t * RS + d] = hw_bf(kk); QHB[t * RS + d] = hw_bf(qq); QB[t * RS + d] = hw_bf(qq * gt);
                kt4[i] = (unsigned short)hw_bf(kk * glast * __builtin_amdgcn_rcpf(gt));
                Lf[O_WSRC + t * 128 + d] = kk * (beta * gt);
                if (d == 0) Lf[O_GL + t] = gt; }
            u32x2 kw; kw.x = (unsigned)kt4[0] | ((unsigned)kt4[1] << 16); kw.y = (unsigned)kt4[2] | ((unsigned)kt4[3] << 16);
            *(LAS u32x2*)(KT + d * 16 + 4 * seg) = kw;
        }
        LBAR();
        if (w < 2) {
            const LAS bf16* AS = (w == 0) ? KHB : QHB;
            f32x4 acc = {0.f, 0.f, 0.f, 0.f};
#pragma unroll
            for (int ks = 0; ks < 4; ++ks) { const bf16x8 af = *(const LAS bf16x8*)(AS + fr * RS + 32 * ks + 8 * g), bfm = *(const LAS bf16x8*)(KHB + fr * RS + 32 * ks + 8 * g);
                acc = __builtin_amdgcn_mfma_f32_16x16x32_bf16(af, bfm, acc, 0, 0, 0); }
            const float gs_inv = __builtin_amdgcn_rcpf(Lf[O_GL + fr]);
            if (w == 0) {
                f32x4 N1, M1;
#pragma unroll
                for (int r = 0; r < 4; ++r) { const int t = 4 * g + r; const float gt = Lf[O_GL + t];
                    N1[r] = (fr < t) ? -(B_[O_SC + 16 + t] * acc[r] * gt * gs_inv) : 0.f;
                    M1[r] = (t < fr) ? -(B_[O_SC + 16 + fr] * acc[r] * Lf[O_GL + fr] * __builtin_amdgcn_rcpf(gt)) : 0.f; }
#define XTY(X, Y, C0) __builtin_amdgcn_mfma_f32_16x16x32_bf16(mk_frag((u32x2){hw_pk2(X[0], X[1]), hw_pk2(X[2], X[3])}, zz), mk_frag((u32x2){hw_pk2(Y[0], Y[1]), hw_pk2(Y[2], Y[3])}, zz), C0, 0, 0, 0)
                const f32x4 z4 = {0.f, 0.f, 0.f, 0.f};
                f32x4 T1t = M1;
#pragma unroll
                for (int r = 0; r < 4; ++r) if (4 * g + r == fr) T1t[r] += 1.f;
                const f32x4 N2 = XTY(M1, N1, z4), M2 = XTY(N1, M1, z4);
                const f32x4 T2t = XTY(N2, T1t, T1t);
                const f32x4 N4 = XTY(M2, N2, z4), M4 = XTY(N2, M2, z4);
                const f32x4 T4t = XTY(N4, T2t, T2t);
                const f32x4 N8 = XTY(M4, N4, z4);
                const f32x4 T8t = XTY(N8, T4t, T4t);
#undef XTY
                u32x2 tw; tw.x = hw_pk2(T8t[0], T8t[1]); tw.y = hw_pk2(T8t[2], T8t[3]);
                *(LAS u32x2*)(TB + fr * 16 + 4 * g) = tw;
            } else {
#pragma unroll
                for (int r = 0; r < 4; ++r) { const int t = 4 * g + r; QKM[t * 16 + fr] = hw_bf((fr <= t) ? acc[r] * Lf[O_GL + t] * gs_inv : 0.f); }
            }
        }
        if (c + 1 < c_end) GD_XFORM((c + 1) & 1);
        if (c + 2 < c_end) GD_LOAD(c + 2);
        LBAR();
        f32x4 accu = {0.f, 0.f, 0.f, 0.f};
        {
            const bf16x8 tf = mk_frag(*(const LAS u32x2*)(TB + fr * 16 + 4 * g), zz);
            u32x2 ulo, wlo;
            { const float b0 = B_[O_SC + 16 + 4 * g + 0], b1 = B_[O_SC + 16 + 4 * g + 1], b2 = B_[O_SC + 16 + 4 * g + 2], b3 = B_[O_SC + 16 + 4 * g + 3];
              ulo.x = hw_pk2(b0 * B_[O_VV + (4 * g + 0) * 128 + c0 + fr], b1 * B_[O_VV + (4 * g + 1) * 128 + c0 + fr]); ulo.y = hw_pk2(b2 * B_[O_VV + (4 * g + 2) * 128 + c0 + fr], b3 * B_[O_VV + (4 * g + 3) * 128 + c0 + fr]);
              wlo.x = hw_pk2(Lf[O_WSRC + (4 * g + 0) * 128 + c0 + fr], Lf[O_WSRC + (4 * g + 1) * 128 + c0 + fr]); wlo.y = hw_pk2(Lf[O_WSRC + (4 * g + 2) * 128 + c0 + fr], Lf[O_WSRC + (4 * g + 3) * 128 + c0 + fr]); }
            accu = __builtin_amdgcn_mfma_f32_16x16x32_bf16(tf, mk_frag(ulo, zz), accu, 0, 0, 0);
            f32x4 accw = {0.f, 0.f, 0.f, 0.f};
            accw = __builtin_amdgcn_mfma_f32_16x16x32_bf16(tf, mk_frag(wlo, zz), accw, 0, 0, 0);
#pragma unroll
            for (int r = 0; r < 4; ++r) WB[(4 * g + r) * RS + c0 + fr] = hw_bf(-accw[r]);
        }
        LBAR();
        if (role == 0) {
            GD_STATE_PART(c);
        } else {
            float* rec = STASH + (size_t)(c - c_begin) * REC;
            for (int i = tid; i < 832; i += NTHREADS) { const int o = i < 528 ? O_QB + 4 * i : (i < 800 ? O_WB + 4 * (i - 528) : O_QKM + 4 * (i - 800)); *(GAS f32x4*)(rec + 4 * i) = *(const LAS f32x4*)(Lf + o); }
#pragma unroll
            for (int r = 0; r < 4; ++r) rec[3328 + (w * 4 + r) * 64 + lane] = accu[r];
            if (tid == 0) rec[5376] = glast;
        }
        LBAR();
    }
    if (role == 0) {
#pragma unroll
        for (int i = 0; i < 8; ++i)
#pragma unroll
            for (int r = 0; r < 4; ++r) STATE[((w * 8 + i) * 4 + r) * 64 + lane] = Sacc[i][r];
        asm volatile("s_waitcnt vmcnt(0)" ::: "memory");
        __syncthreads();
        if (tid == 0) { __builtin_amdgcn_fence(__ATOMIC_RELEASE, "agent"); asm volatile("s_waitcnt vmcnt(0)" ::: "memory"); __hip_atomic_store(flag, 1u, __ATOMIC_RELAXED, __HIP_MEMORY_SCOPE_AGENT); }
    } else {
        if (tid == 0) { unsigned sp = 0; while (__hip_atomic_load(flag, __ATOMIC_RELAXED, __HIP_MEMORY_SCOPE_AGENT) == 0u) { __builtin_amdgcn_s_sleep(8); if (++sp > (1u << 22)) break; }
            __builtin_amdgcn_fence(__ATOMIC_ACQUIRE, "agent"); asm volatile("s_waitcnt vmcnt(0)" ::: "memory"); }
        __syncthreads();
#pragma unroll
        for (int i = 0; i < 8; ++i)
#pragma unroll
            for (int r = 0; r < 4; ++r) Sacc[i][r] = STATE[((w * 8 + i) * 4 + r) * 64 + lane];
        f32x4 pa, pb; f32x4 pu; float pg;
#define GD_REC_LOAD(cc) do { const float* rec = STASH + (size_t)((cc) - c_begin) * REC; pa = *(const GAS f32x4*)(rec + 4 * tid); pb = (tid < 320) ? *(const GAS f32x4*)(rec + 4 * (tid + 512)) : (f32x4){0.f, 0.f, 0.f, 0.f}; \
            _Pragma("unroll") for (int r = 0; r < 4; ++r) pu[r] = rec[3328 + (w * 4 + r) * 64 + lane]; pg = rec[5376]; } while (0)
        GD_REC_LOAD(c_begin);
        for (int c = c_begin; c < c_end; ++c) {
            { const int i0 = tid, o0 = i0 < 528 ? O_QB + 4 * i0 : O_WB + 4 * (i0 - 528); *(LAS f32x4*)(Lf + o0) = pa;
              if (tid < 320) { const int i1 = tid + 512; const int o1 = i1 < 528 ? O_QB + 4 * i1 : (i1 < 800 ? O_WB + 4 * (i1 - 528) : O_QKM + 4 * (i1 - 800)); *(LAS f32x4*)(Lf + o1) = pb; } }
            const f32x4 accu = pu; const float glast = pg;
            if (c + 1 < c_end) GD_REC_LOAD(c + 1);
            LBAR();
            GD_STATE_PART(c);
            LBAR();
        }
#undef GD_REC_LOAD
    }
#undef GD_STATE_PART
#undef GD_LOAD
#undef GD_XFORM
}

__device__ __forceinline__ void scan_rwkv_unit(const Args& A, Frame& F, int unit) {
    int tid = F.tid; asm volatile("" : "+v"(tid));
    const int lane = tid & 63, w = F.wave;
    const int b = unit >> 4, h = unit & 15;
    const bf16* P = (const bf16*)(A.ws + WS_PROJ) + (size_t)b * SEQ * PROJ_LD + OC_RW;
    const bf16* LO = (const bf16*)(A.ws + WS_LO) + (size_t)b * SEQ * LORA_N;
    bf16* Y = (bf16*)(A.ws + WS_ACTA) + (size_t)b * SEQ * D + 1024 + h * 64;
    LAS float* Lf = (LAS float*)(F.lds + RING_OFF);
    constexpr int BUFSZ = 6208, O_KK = 0, O_WR = 1024, O_W = 2048, O_NKA = 3072, O_K = 4096, O_V = 5120, O_SC = 6144, O_OUT = 2 * BUFSZ;
    const int tl = tid >> 5, d2 = (tid & 31) * 2, hd = h * 64 + d2;
    float mu_r[2], mu_k[2], mu_v[2], w0[2], a0[2], k_k[2], k_a[2], r_k[2], lnw[2], lnb[2];
#pragma unroll
    for (int i = 0; i < 2; ++i) { mu_r[i] = A.in[I_MU][RW_R + hd + i]; mu_k[i] = A.in[I_MU][RW_K + hd + i]; mu_v[i] = A.in[I_MU][RW_V + hd + i];
        w0[i] = A.in[I_W0][hd + i]; a0[i] = A.in[I_A0][hd + i]; k_k[i] = A.in[I_KK][hd + i]; k_a[i] = A.in[I_KA][hd + i]; r_k[i] = A.in[I_RK][hd + i];
        lnw[i] = A.in[I_LNW][hd + i]; lnb[i] = A.in[I_LNB][hd + i]; }
    unsigned rr[2], rk[2], rv[2], rlw, rla, rg_cur = 0u, rg_nxt = 0u;
#define RW_LOAD(c) do { const int t_ = (c) * TC + tl; const bf16* pr = P + (size_t)t_ * PROJ_LD; \
        rr[0] = *(const GAS unsigned*)(pr + RW_R + hd); rk[0] = *(const GAS unsigned*)(pr + RW_K + hd); rv[0] = *(const GAS unsigned*)(pr + RW_V + hd); \
        if (t_ > 0) { rr[1] = *(const GAS unsigned*)(pr - PROJ_LD + RW_R + hd); rk[1] = *(const GAS unsigned*)(pr - PROJ_LD + RW_K + hd); rv[1] = *(const GAS unsigned*)(pr - PROJ_LD + RW_V + hd); } \
        else { rr[1] = 0u; rk[1] = 0u; rv[1] = 0u; } \
        const bf16* lr = LO + (size_t)t_ * LORA_N; rlw = *(const GAS unsigned*)(lr + hd); rla = *(const GAS unsigned*)(lr + 1024 + hd); rg_nxt = *(const GAS unsigned*)(lr + 2048 + hd); } while (0)
#define RW_XFORM(bufi) do { LAS float* B_ = Lf + (bufi) * BUFSZ; f32x2 kk2, wr2, w2_, nka2, k2, v2_; float skk = 0.f, sc1 = 0.f, sc2 = 0.f, sbs = 0.f; float aa[2], rrv[2]; \
        _Pragma("unroll") for (int i_ = 0; i_ < 2; ++i_) { \
            const float r0 = i_ ? bf_hi(rr[0]) : bf_lo(rr[0]), r1 = i_ ? bf_hi(rr[1]) : bf_lo(rr[1]); \
            const float k0_ = i_ ? bf_hi(rk[0]) : bf_lo(rk[0]), k1_ = i_ ? bf_hi(rk[1]) : bf_lo(rk[1]); \
            const float v0_ = i_ ? bf_hi(rv[0]) : bf_lo(rv[0]), v1_ = i_ ? bf_hi(rv[1]) : bf_lo(rv[1]); \
            const float lw = i_ ? bf_hi(rlw) : bf_lo(rlw), la = i_ ? bf_hi(rla) : bf_lo(rla); \
            const float r_ = r0 + (r1 - r0) * mu_r[i_], kx = k0_ + (k1_ - k0_) * mu_k[i_], vx = v0_ + (v1_ - v0_) * mu_v[i_]; \
            const float wd = __expf(-0.6065306597126334f * sigmoidf_(w0[i_] + lw)); const float a_ = sigmoidf_(a0[i_] + la); \
            const float kk0 = kx * k_k[i_]; const float km = kx * (1.f + (a_ - 1.f) * k_a[i_]); \
            kk2[i_] = kk0; skk += kk0 * kk0; aa[i_] = a_; rrv[i_] = r_; wr2[i_] = wd * r_; w2_[i_] = wd; k2[i_] = km; v2_[i_] = vx; sc2 += km * r_; sbs += r_ * km * r_k[i_]; } \
        skk = half_sum32(skk); const float rkk = __builtin_amdgcn_rsqf(skk + EPS); \
        _Pragma("unroll") for (int i_ = 0; i_ < 2; ++i_) { kk2[i_] *= rkk; nka2[i_] = -(kk2[i_] * aa[i_]); sc1 += kk2[i_] * aa[i_] * rrv[i_]; } \
        sc1 = half_sum32(sc1); sc2 = half_sum32(sc2); sbs = half_sum32(sbs); \
        *(LAS f32x2*)(B_ + O_KK + tl * 64 + d2) = kk2; *(LAS f32x2*)(B_ + O_WR + tl * 64 + d2) = wr2; *(LAS f32x2*)(B_ + O_W + tl * 64 + d2) = w2_; \
        *(LAS f32x2*)(B_ + O_NKA + tl * 64 + d2) = nka2; *(LAS f32x2*)(B_ + O_K + tl * 64 + d2) = k2; *(LAS f32x2*)(B_ + O_V + tl * 64 + d2) = v2_; \
        if ((tid & 31) == 0) { f32x4 sc; sc[0] = sc1; sc[1] = sc2; sc[2] = sbs; sc[3] = 0.f; *(LAS f32x4*)(B_ + O_SC + tl * 4) = sc; } } while (0)
    RW_LOAD(0); RW_XFORM(0); rg_cur = rg_nxt;
    LBAR();
    f32x2 S2[4];
#pragma unroll
    for (int i = 0; i < 4; ++i) S2[i] = (f32x2){0.f, 0.f};
    const int j = lane & 15, col = w * 8 + (lane >> 4) * 2;
    for (int c = 0; c < NCHUNK; ++c) {
        if (c + 1 < NCHUNK) RW_LOAD(c + 1);
        const LAS float* B_ = Lf + (c & 1) * BUFSZ;
        float os0 = 0.f, os1 = 0.f;
        f32x4 kk, wr, ww, nka, kv, sc, nkk, nwr, nww, nnka, nkv, nsc; f32x2 v2, nv2;
#define RW_LDSTEP(t_, KK, WR, WW, NKA, KV, V2, SC) do { KK = *(const LAS f32x4*)(B_ + O_KK + (t_) * 64 + 4 * j); WR = *(const LAS f32x4*)(B_ + O_WR + (t_) * 64 + 4 * j); WW = *(const LAS f32x4*)(B_ + O_W + (t_) * 64 + 4 * j); \
            NKA = *(const LAS f32x4*)(B_ + O_NKA + (t_) * 64 + 4 * j); KV = *(const LAS f32x4*)(B_ + O_K + (t_) * 64 + 4 * j); V2 = *(const LAS f32x2*)(B_ + O_V + (t_) * 64 + col); SC = *(const LAS f32x4*)(B_ + O_SC + (t_) * 4); } while (0)
        RW_LDSTEP(0, kk, wr, ww, nka, kv, v2, sc);
#pragma unroll
        for (int t = 0; t < TC; ++t) {
            if (t + 1 < TC) { RW_LDSTEP(t + 1, nkk, nwr, nww, nnka, nkv, nv2, nsc); }
            __builtin_amdgcn_sched_barrier(0);
            f32x2 d1 = S2[0] * kk[0], d2 = S2[0] * wr[0], e1 = S2[1] * kk[1], e2 = S2[1] * wr[1];
            d1 += S2[2] * kk[2]; d2 += S2[2] * wr[2]; e1 += S2[3] * kk[3]; e2 += S2[3] * wr[3];
            d1 += e1; d2 += e2;
            { float r0_ = d1[0], r1_ = d1[1], r2_ = d2[0], r3_ = d2[1]; row_sum16_x4(r0_, r1_, r2_, r3_); d1[0] = r0_; d1[1] = r1_; d2[0] = r2_; d2[1] = r3_; }
            const f32x2 o2 = d2 - d1 * sc[0] + v2 * sc[1];
#pragma unroll
            for (int i = 0; i < 4; ++i) S2[i] = S2[i] * ww[i] + d1 * nka[i] + v2 * kv[i];
            os0 = (j == t) ? o2[0] : os0; os1 = (j == t) ? o2[1] : os1;
            kk = nkk; wr = nwr; ww = nww; nka = nnka; kv = nkv; v2 = nv2; sc = nsc;
        }
#undef RW_LDSTEP
        { f32x2 o2 = {os0, os1}; *(LAS f32x2*)(Lf + O_OUT + j * 64 + col) = o2; }
        if (c + 1 < NCHUNK) RW_XFORM((c + 1) & 1);
        LBAR();
        {
            const f32x2 o2 = *(const LAS f32x2*)(Lf + O_OUT + tl * 64 + d2); const f32x2 vv = *(const LAS f32x2*)(B_ + O_V + tl * 64 + d2); const float bs = B_[O_SC + tl * 4 + 2];
            const float mean = half_sum32(o2[0] + o2[1]) * (1.0f / 64.0f); const float e0 = o2[0] - mean, e1 = o2[1] - mean;
            const float var = half_sum32(e0 * e0 + e1 * e1) * (1.0f / 64.0f); const float rs = __builtin_amdgcn_rsqf(var + 64e-5f);
            const float y0 = (e0 * rs * lnw[0] + lnb[0] + bs * vv[0]) * bf_lo(rg_cur), y1 = (e1 * rs * lnw[1] + lnb[1] + bs * vv[1]) * bf_hi(rg_cur);
            *(GAS unsigned*)(Y + (size_t)(c * TC + tl) * D + d2) = pk2(y0, y1);
        }
        rg_cur = rg_nxt;
        LBAR();
    }
#undef RW_LOAD
#undef RW_XFORM
}

template <int LAYER>
__device__ __forceinline__ void post_rows(const Args& A, Frame& F) {
    const int gw = F.vcu * NWAVES + F.wave, NGW = F.G * NWAVES, lane = F.lane;
    const bf16* O = (const bf16*)(A.ws + WS_O); const bf16* P = (const bf16*)(A.ws + WS_PROJ); bf16* Y = (bf16*)(A.ws + WS_ACTA);
    for (int m = gw; m < T; m += NGW) {
        const GAS u32x2* orow = (const GAS u32x2*)(O + (size_t)m * D) + lane; const bf16* prow = P + (size_t)m * PROJ_LD;
        constexpr int NJ = LAYER == 0 ? 8 : 4;
#pragma unroll
        for (int jj = 0; jj < NJ; ++jj) {
            const u32x2 ow_ = orow[64 * jj]; const f32x4 v = {bf_lo(ow_.x), bf_hi(ow_.x), bf_lo(ow_.y), bf_hi(ow_.y)}; float ss = (v[0] * v[0] + v[1] * v[1]) + (v[2] * v[2] + v[3] * v[3]);
            const bool wide = (LAYER == 0 && jj < 4);
            const float ms = wide ? wave_sum(ss) * (1.0f / 256.0f) : half_sum32(ss) * (1.0f / 128.0f);
            const float r = __builtin_amdgcn_rsqf(ms + EPS);
            const int cih = wide ? 4 * lane : 4 * (lane & 31);
            const float* gsrc = LAYER == 0 ? (wide ? A.in[I_GLA_NORM] : A.in[I_GDN_NORM]) : A.in[I_HG_NORM];
            const f32x4 g = *(const GAS f32x4*)(gsrc + cih);
            const int zcol = LAYER == 0 ? (wide ? EC_GZ + jj * 256 + 4 * lane : EC_BZ + (jj - 4) * 256 + 4 * lane) : OC_HG + jj * 256 + 4 * lane;
            const u32x2 zw = *(const GAS u32x2*)(prow + zcol);
            const float y0 = v[0] * r * g[0] * siluf_(bf_lo(zw.x)), y1 = v[1] * r * g[1] * siluf_(bf_hi(zw.x)), y2 = v[2] * r * g[2] * siluf_(bf_lo(zw.y)), y3 = v[3] * r * g[3] * siluf_(bf_hi(zw.y));
            u32x2 o; o.x = pk2(y0, y1); o.y = pk2(y2, y3);
            *(GAS u32x2*)(Y + (size_t)m * D + 256 * jj + 4 * lane) = o;
        }
    }
}
__device__ __forceinline__ void lora_prep_rows(const Args& A, Frame& F) {
    const int gw = F.vcu * NWAVES + F.wave, NGW = F.G * NWAVES, lane = F.lane;
    const bf16* P = (const bf16*)(A.ws + WS_PROJ); bf16* LA = (bf16*)(A.ws + WS_LA); const float* mu = A.in[I_MU];
    for (int m = gw; m < T; m += NGW) { const bool hasprev = (m % SEQ) != 0; const bf16* prow = P + (size_t)m * PROJ_LD + OC_RW + RW_WL;
#pragma unroll
        for (int i = 0; i < 7; ++i) { const int c = lane + 64 * i;
            const float x = __uint_as_float((unsigned)prow[c] << 16), xp = hasprev ? __uint_as_float((unsigned)prow[c - PROJ_LD] << 16) : 0.f;
            const float ts = x + (xp - x) * mu[RW_WL + c];
            const float v = c < 96 ? tanhf(ts) : (c < 192 ? ts : sigmoidf_(ts));
            LA[(size_t)m * LORA_K + c] = (bf16)f2bf(v); }
        LA[(size_t)m * LORA_K + 448 + lane] = (bf16)0; }
}
__device__ __forceinline__ void final_rows(const Args& A, Frame& F, const float oscale, const bf16* Hs) {
    const int gw = F.vcu * NWAVES + F.wave, NGW = F.G * NWAVES, lane = F.lane;
    const float* rowss = (const float*)(A.ws + WS_RSP) + (size_t)RS_FINAL * T * 32; const GAS f32x4* g = (const GAS f32x4*)A.in[I_NFINAL] + lane;
    for (int m = gw; m < T; m += NGW) { const float r = oscale * __builtin_amdgcn_rsqf(wave_sum(lane < 32 ? rowss[(size_t)m * 32 + lane] : 0.f) * (1.0f / D) + EPS); GAS f32x4* row = (GAS f32x4*)(A.out + (size_t)m * D) + lane;
        const GAS u32x2* hrow = (const GAS u32x2*)(Hs + (size_t)m * D) + lane;
#pragma unroll
        for (int jj = 0; jj < 8; ++jj) { const u32x2 hw = hrow[64 * jj]; const f32x4 v = {bf_lo(hw.x), bf_hi(hw.x), bf_lo(hw.y), bf_hi(hw.y)}; row[64 * jj] = v * r * g[64 * jj]; } }
}

__device__ __forceinline__ void scan_rwkv_mfma_unit(const Args& A, Frame& F, int unit, const int role) {
    int tid = F.tid; asm volatile("" : "+v"(tid));
    const int lane = tid & 63, w = F.wave;
    const int b = unit >> 3, hp = unit & 7;
    const bf16* P = (const bf16*)(A.ws + WS_PROJ) + (size_t)b * SEQ * PROJ_LD + OC_RW;
    const bf16* LO = (const bf16*)(A.ws + WS_LO) + (size_t)b * SEQ * LORA_N;
    bf16* Y = (bf16*)(A.ws + WS_ACTA) + (size_t)b * SEQ * D + 1024;
    LAS float* Lf = (LAS float*)(F.lds + RING_OFF);
    constexpr int RS = 72;
    constexpr int O_CONST = 0;
    constexpr int O_XF = 1280;
    constexpr int O_VV = O_XF + 2 * 5 * 1024;
    constexpr int O_BS = O_VV + 4 * 1024;
    constexpr int O_IMG = O_BS + 64;
    constexpr int I_CT = 0, I_BT = 576, I_KL = 1152, I_RT = 1728, I_CF = 2304, I_BTT = 3328, I_KTT = 3840, I_WCB = 4352, I_G1B = 4928, I_TTB = 5056, I_RKB = 5184, I_RBB = 5312, I_W15 = 5440, I_OUT = 5504, IMGSZ = 6528;
    static_assert((O_IMG + 2 * IMGSZ) * 4 <= RING_BYTES, "rwkv lds");
    for (int i = tid; i < 1280; i += NTHREADS) { const int arr = i >> 7, ch = hp * 128 + (i & 127); float v;
        switch (arr) { case 0: v = A.in[I_MU][RW_R + ch]; break; case 1: v = A.in[I_MU][RW_K + ch]; break; case 2: v = A.in[I_MU][RW_V + ch]; break; case 3: v = A.in[I_W0][ch]; break; case 4: v = A.in[I_A0][ch]; break;
                       case 5: v = A.in[I_KK][ch]; break; case 6: v = A.in[I_KA][ch]; break; case 7: v = A.in[I_RK][ch]; break; case 8: v = A.in[I_LNW][ch]; break; default: v = A.in[I_LNB][ch]; break; }
        Lf[O_CONST + i] = v; }
    const int hx = tid >> 8, tl = (tid >> 4) & 15, d4 = (tid & 15) * 4, ch4 = hx * 64 + d4, col4 = hp * 128 + ch4;
    u32x2 rr[2], rk[2], rv[2], rlw, rla, rg_cur = {0u, 0u}, rg_nxt = {0u, 0u}, rg_far = {0u, 0u};
#define RM_LOAD(c) do { const int t_ = (c) * TC + tl; const bf16* pr = P + (size_t)t_ * PROJ_LD + col4; \
        rr[0] = *(const GAS u32x2*)(pr + RW_R); rk[0] = *(const GAS u32x2*)(pr + RW_K); rv[0] = *(const GAS u32x2*)(pr + RW_V); \
        const bf16* pp_ = (t_ > 0) ? pr - PROJ_LD : pr; rr[1] = *(const GAS u32x2*)(pp_ + RW_R); rk[1] = *(const GAS u32x2*)(pp_ + RW_K); rv[1] = *(const GAS u32x2*)(pp_ + RW_V); \
        if (t_ == 0) { rr[1] = (u32x2){0u, 0u}; rk[1] = (u32x2){0u, 0u}; rv[1] = (u32x2){0u, 0u}; } \
        const bf16* lr = LO + (size_t)t_ * LORA_N + col4; rlw = *(const GAS u32x2*)(lr); rla = *(const GAS u32x2*)(lr + 1024); rg_far = *(const GAS u32x2*)(lr + 2048); } while (0)
#define RM_XFORM(bufi) do { LAS float* X_ = Lf + O_XF + hx * 5 * 1024 + tl * 64 + d4; \
        const f32x4 mur = *(const LAS f32x4*)(Lf + O_CONST + 0 * 128 + ch4), muk = *(const LAS f32x4*)(Lf + O_CONST + 1 * 128 + ch4), muv = *(const LAS f32x4*)(Lf + O_CONST + 2 * 128 + ch4); \
        const f32x4 w0_ = *(const LAS f32x4*)(Lf + O_CONST + 3 * 128 + ch4), a0_ = *(const LAS f32x4*)(Lf + O_CONST + 4 * 128 + ch4), kk_ = *(const LAS f32x4*)(Lf + O_CONST + 5 * 128 + ch4); \
        const f32x4 ka_ = *(const LAS f32x4*)(Lf + O_CONST + 6 * 128 + ch4), rk_ = *(const LAS f32x4*)(Lf + O_CONST + 7 * 128 + ch4); \
        const float r0[4] = {bf_lo(rr[0].x), bf_hi(rr[0].x), bf_lo(rr[0].y), bf_hi(rr[0].y)}, r1[4] = {bf_lo(rr[1].x), bf_hi(rr[1].x), bf_lo(rr[1].y), bf_hi(rr[1].y)}; \
        const float k0[4] = {bf_lo(rk[0].x), bf_hi(rk[0].x), bf_lo(rk[0].y), bf_hi(rk[0].y)}, k1[4] = {bf_lo(rk[1].x), bf_hi(rk[1].x), bf_lo(rk[1].y), bf_hi(rk[1].y)}; \
        const float v0[4] = {bf_lo(rv[0].x), bf_hi(rv[0].x), bf_lo(rv[0].y), bf_hi(rv[0].y)}, v1[4] = {bf_lo(rv[1].x), bf_hi(rv[1].x), bf_lo(rv[1].y), bf_hi(rv[1].y)}; \
        const float lw[4] = {bf_lo(rlw.x), bf_hi(rlw.x), bf_lo(rlw.y), bf_hi(rlw.y)}, la[4] = {bf_lo(rla.x), bf_hi(rla.x), bf_lo(rla.y), bf_hi(rla.y)}; \
        f32x4 r4, w4, k4, v4, kk4, b4; float skk = 0.f, sbs = 0.f; float aa[4]; \
        _Pragma("unroll") for (int i_ = 0; i_ < 4; ++i_) { const float r_ = r0[i_] + (r1[i_] - r0[i_]) * mur[i_], kx = k0[i_] + (k1[i_] - k0[i_]) * muk[i_], vx = v0[i_] + (v1[i_] - v0[i_]) * muv[i_]; \
            const float wd = __expf(-0.6065306597126334f * sigmoidf_(w0_[i_] + lw[i_])); const float a_ = sigmoidf_(a0_[i_] + la[i_]); \
            const float kk0 = kx * kk_[i_], km = kx * (1.f + (a_ - 1.f) * ka_[i_]); \
            r4[i_] = r_; w4[i_] = wd; k4[i_] = km; v4[i_] = vx; kk4[i_] = kk0; aa[i_] = a_; skk += kk0 * kk0; sbs += r_ * km * rk_[i_]; } \
        row_sum16_x2(skk, sbs); const float rkk = __builtin_amdgcn_rsqf(skk + EPS); \
        _Pragma("unroll") for (int i_ = 0; i_ < 4; ++i_) { kk4[i_] *= rkk; b4[i_] = kk4[i_] * aa[i_]; } \
        *(LAS f32x4*)(X_) = r4; *(LAS f32x4*)(X_ + 1024) = w4; *(LAS f32x4*)(X_ + 2048) = k4; *(LAS f32x4*)(X_ + 3072) = kk4; *(LAS f32x4*)(X_ + 4096) = b4; \
        *(LAS f32x4*)(Lf + O_VV + ((bufi) * 2 + hx) * 1024 + tl * 64 + d4) = v4; \
        if ((tid & 15) == 0) Lf[O_BS + ((bufi) * 2 + hx) * 16 + tl] = sbs; } while (0)
    const int c_begin = role ? NCHUNK / 2 : 0, c_end = role ? NCHUNK : NCHUNK / 2;
    constexpr int REC = 7584;
    float* STASH = (float*)(A.ws + (unit < 32 ? WS_WEV_IN : WS_END)) + (size_t)(unit & 31) * (NCHUNK / 2) * REC;
    float* STATE = (float*)(A.ws + WS_STATE + 4 * MiB) + (size_t)unit * 8192;
    gu32* flag = F.ctl + 49152 + unit * 64;
    LBAR();
    RM_LOAD(c_begin); RM_XFORM(c_begin & 1); rg_cur = rg_far; RM_LOAD(c_begin + 1); rg_nxt = rg_far;
    LBAR();
    f32x4 Macc[4];
#pragma unroll
    for (int i = 0; i < 4; ++i) Macc[i] = (f32x4){0.f, 0.f, 0.f, 0.f};
    const int fr = lane & 15, g = lane >> 4, hh = w >> 2, ww = w & 3, c0 = ww * 16;
    LAS float* IM = Lf + O_IMG + hh * IMGSZ;
    LAS bf16* CT = (LAS bf16*)(IM + I_CT); LAS bf16* BT = (LAS bf16*)(IM + I_BT); LAS bf16* KL = (LAS bf16*)(IM + I_KL); LAS bf16* RT = (LAS bf16*)(IM + I_RT);
    LAS bf16* BTT = (LAS bf16*)(IM + I_BTT); LAS bf16* KTT = (LAS bf16*)(IM + I_KTT); LAS bf16* WCB = (LAS bf16*)(IM + I_WCB);
    LAS bf16* G1B = (LAS bf16*)(IM + I_G1B); LAS bf16* TTB = (LAS bf16*)(IM + I_TTB); LAS bf16* RKB = (LAS bf16*)(IM + I_RKB); LAS bf16* RBB = (LAS bf16*)(IM + I_RBB);
    const u32x2 zz = {0u, 0u};
#define RM_STATE_PART(vb) do { \
        { \
            bf16x8 mb[2]; \
_Pragma("unroll") \
            for (int ks = 0; ks < 2; ++ks) { u32x2 slo, shi; slo.x = hw_pk2(Macc[2 * ks][0], Macc[2 * ks][1]); slo.y = hw_pk2(Macc[2 * ks][2], Macc[2 * ks][3]); shi.x = hw_pk2(Macc[2 * ks + 1][0], Macc[2 * ks + 1][1]); shi.y = hw_pk2(Macc[2 * ks + 1][2], Macc[2 * ks + 1][3]); \
                mb[ks] = mk_frag(slo, shi); } \
            f32x4 accR = accU, acco = {0.f, 0.f, 0.f, 0.f}; \
_Pragma("unroll") \
            for (int ks = 0; ks < 2; ++ks) { \
                accR = __builtin_amdgcn_mfma_f32_16x16x32_bf16(mk_frag(*(const LAS u32x2*)(WCB + fr * RS + 32 * ks + 4 * g), *(const LAS u32x2*)(WCB + fr * RS + 32 * ks + 16 + 4 * g)), mb[ks], accR, 0, 0, 0); \
                acco = __builtin_amdgcn_mfma_f32_16x16x32_bf16(mk_frag(*(const LAS u32x2*)(RT + fr * RS + 32 * ks + 4 * g), *(const LAS u32x2*)(RT + fr * RS + 32 * ks + 16 + 4 * g)), mb[ks], acco, 0, 0, 0); } \
            u32x2 rn; rn.x = hw_pk2(accR[0], accR[1]); rn.y = hw_pk2(accR[2], accR[3]); \
            const bf16x8 rb = mk_frag(rn, zz); \
            acco = __builtin_amdgcn_mfma_f32_16x16x32_bf16(mk_frag(*(const LAS u32x2*)(RKB + fr * 16 + 4 * g), zz), vb, acco, 0, 0, 0); \
            acco = __builtin_amdgcn_mfma_f32_16x16x32_bf16(mk_frag(*(const LAS u32x2*)(RBB + fr * 16 + 4 * g), zz), rb, acco, 0, 0, 0); \
_Pragma("unroll") \
            for (int r = 0; r < 4; ++r) IM[I_OUT + (4 * g + r) * 64 + c0 + fr] = acco[r]; \
_Pragma("unroll") \
            for (int i = 0; i < 4; ++i) { const f32x4 w15 = *(const LAS f32x4*)(IM + I_W15 + 16 * i + 4 * g); \
                f32x4 m = __builtin_amdgcn_mfma_f32_16x16x32_bf16(mk_frag(*(const LAS u32x2*)(KTT + (16 * i + fr) * 16 + 4 * g), zz), vb, Macc[i], 0, 0, 0); \
                m = __builtin_amdgcn_mfma_f32_16x16x32_bf16(mk_frag(*(const LAS u32x2*)(BTT + (16 * i + fr) * 16 + 4 * g), zz), rb, m, 0, 0, 0); \
                Macc[i] = m * w15; } \
        } \
        } while (0)
#define RM_FLUSH(cc_, gb_, vv_, bs_) do { \
        { \
            const f32x4 o4 = *(const LAS f32x4*)(Lf + O_IMG + hx * IMGSZ + I_OUT + tl * 64 + d4); const f32x4 vv = (vv_); const float bs = (bs_); \
            const f32x4 lnw = *(const LAS f32x4*)(Lf + O_CONST + 8 * 128 + ch4), lnb = *(const LAS f32x4*)(Lf + O_CONST + 9 * 128 + ch4); \
            float sm = (o4[0] + o4[1]) + (o4[2] + o4[3]), dummy = 0.f; row_sum16_x2(sm, dummy); const float mean = sm * (1.0f / 64.0f); \
            const f32x4 e4 = o4 - mean; float sv = (e4[0] * e4[0] + e4[1] * e4[1]) + (e4[2] * e4[2] + e4[3] * e4[3]); row_sum16_x2(sv, dummy); const float rs = __builtin_amdgcn_rsqf(sv * (1.0f / 64.0f) + 64e-5f); \
            const float gg[4] = {bf_lo((gb_).x), bf_hi((gb_).x), bf_lo((gb_).y), bf_hi((gb_).y)}; \
            float y[4]; \
_Pragma("unroll") \
            for (int i = 0; i < 4; ++i) y[i] = (e4[i] * rs * lnw[i] + lnb[i] + bs * vv[i]) * gg[i]; \
            u32x2 o; o.x = hw_pk2(y[0], y[1]); o.y = hw_pk2(y[2], y[3]); \
            *(GAS u32x2*)(Y + (size_t)((cc_) * TC + tl) * D + col4) = o; \
        } \
        } while (0)
    for (int c = c_begin; c < c_end; ++c) {
        {
            const int hq = tid >> 8, seg = (tid >> 6) & 3, d = tid & 63;
            const LAS float* X_ = Lf + O_XF + hq * 5 * 1024 + d; LAS float* IQ = Lf + O_IMG + hq * IMGSZ;
            LAS bf16* CTq = (LAS bf16*)(IQ + I_CT); LAS bf16* BTq = (LAS bf16*)(IQ + I_BT); LAS bf16* KLq = (LAS bf16*)(IQ + I_KL); LAS bf16* RTq = (LAS bf16*)(IQ + I_RT);
            float wall = 1.f, wpre = 1.f;
#pragma unroll
            for (int t = 0; t < 16; ++t) { if (t == 4 * seg) wpre = wall; wall *= X_[1024 + t * 64]; }
            float wt = wpre; unsigned short bt4[4], kt4[4];
#pragma unroll
            for (int i = 0; i < 4; ++i) { const int t = 4 * seg + i; const float wprev = wt; wt *= X_[1024 + t * 64]; const float iw = __builtin_amdgcn_rcpf(wt);
                const float r_ = X_[t * 64], k_ = X_[2048 + t * 64], kk_ = X_[3072 + t * 64], b_ = X_[4096 + t * 64];
                const float ct = kk_ * wprev, bt = b_ * iw, kt = k_ * iw;
                CTq[t * RS + d] = hw_bf(ct); IQ[I_CF + t * 64 + d] = ct; BTq[t * RS + d] = hw_bf(bt); KLq[t * RS + d] = hw_bf(kt); RTq[t * RS + d] = hw_bf(r_ * wt);
                bt4[i] = (unsigned short)hw_bf(-bt); kt4[i] = (unsigned short)hw_bf(kt); }
            u32x2 o; o.x = (unsigned)bt4[0] | ((unsigned)bt4[1] << 16); o.y = (unsigned)bt4[2] | ((unsigned)bt4[3] << 16); *(LAS u32x2*)((LAS bf16*)(IQ + I_BTT) + d * 16 + 4 * seg) = o;
            o.x = (unsigned)kt4[0] | ((unsigned)kt4[1] << 16); o.y = (unsigned)kt4[2] | ((unsigned)kt4[3] << 16); *(LAS u32x2*)((LAS bf16*)(IQ + I_KTT) + d * 16 + 4 * seg) = o;
            if (seg == 3) IQ[I_W15 + d] = wall;
        }
        LBAR();
        if (ww == 0) {
            f32x4 cb = {0.f, 0.f, 0.f, 0.f}, bc = cb, ck = cb, rkm = cb, rbm = cb;
#pragma unroll
            for (int ks = 0; ks < 2; ++ks) { const bf16x8 fc = *(const LAS bf16x8*)(CT + fr * RS + 32 * ks + 8 * g), fb = *(const LAS bf16x8*)(BT + fr * RS + 32 * ks + 8 * g), fk = *(const LAS bf16x8*)(KL + fr * RS + 32 * ks + 8 * g), frr = *(const LAS bf16x8*)(RT + fr * RS + 32 * ks + 8 * g);
                cb = __builtin_amdgcn_mfma_f32_16x16x32_bf16(fc, fb, cb, 0, 0, 0); bc = __builtin_amdgcn_mfma_f32_16x16x32_bf16(fb, fc, bc, 0, 0, 0); ck = __builtin_amdgcn_mfma_f32_16x16x32_bf16(fc, fk, ck, 0, 0, 0);
                rkm = __builtin_amdgcn_mfma_f32_16x16x32_bf16(frr, fk, rkm, 0, 0, 0); rbm = __builtin_amdgcn_mfma_f32_16x16x32_bf16(frr, fb, rbm, 0, 0, 0); }
            f32x4 N1, M1, CKm;
#pragma unroll
            for (int r = 0; r < 4; ++r) { const int t = 4 * g + r; N1[r] = (fr < t) ? -cb[r] : 0.f; M1[r] = (t < fr) ? -bc[r] : 0.f; CKm[r] = (fr < t) ? ck[r] : 0.f;
                RKB[t * 16 + fr] = hw_bf((fr <= t) ? rkm[r] : 0.f); RBB[t * 16 + fr] = hw_bf((fr <= t) ? -rbm[r] : 0.f); }
#define XTY(X, Y, C0) __builtin_amdgcn_mfma_f32_16x16x32_bf16(mk_frag((u32x2){hw_pk2(X[0], X[1]), hw_pk2(X[2], X[3])}, zz), mk_frag((u32x2){hw_pk2(Y[0], Y[1]), hw_pk2(Y[2], Y[3])}, zz), C0, 0, 0, 0)
            const f32x4 z4 = {0.f, 0.f, 0.f, 0.f};
            f32x4 T1t = M1;
#pragma unroll
            for (int r = 0; r < 4; ++r) if (4 * g + r == fr) T1t[r] += 1.f;
            const f32x4 N2 = XTY(M1, N1, z4), M2 = XTY(N1, M1, z4);
            const f32x4 T2t = XTY(N2, T1t, T1t);
            const f32x4 N4 = XTY(M2, N2, z4), M4 = XTY(N2, M2, z4);
            const f32x4 T4t = XTY(N4, T2t, T2t);
            const f32x4 N8 = XTY(M4, N4, z4);
            const f32x4 T8t = XTY(N8, T4t, T4t);
            const f32x4 G1t = XTY(CKm, T8t, z4);
#undef XTY
            u32x2 tw; tw.x = hw_pk2(T8t[0], T8t[1]); tw.y = hw_pk2(T8t[2], T8t[3]); *(LAS u32x2*)(TTB + fr * 16 + 4 * g) = tw;
            tw.x = hw_pk2(G1t[0], G1t[1]); tw.y = hw_pk2(G1t[2], G1t[3]); *(LAS u32x2*)(G1B + fr * 16 + 4 * g) = tw;
        }
        if (c + 1 < c_end) { RM_XFORM((c + 1) & 1); }
        if (c + 2 < c_end) RM_LOAD(c + 2);
        LBAR();
        const LAS float* VVc = Lf + O_VV + ((c & 1) * 2 + hh) * 1024;
        u32x2 vlo; { vlo.x = hw_pk2(VVc[(4 * g + 0) * 64 + c0 + fr], VVc[(4 * g + 1) * 64 + c0 + fr]); vlo.y = hw_pk2(VVc[(4 * g + 2) * 64 + c0 + fr], VVc[(4 * g + 3) * 64 + c0 + fr]); }
        const bf16x8 vb = mk_frag(vlo, zz);
        f32x4 accU = {0.f, 0.f, 0.f, 0.f};
        {
            accU = __builtin_amdgcn_mfma_f32_16x16x32_bf16(mk_frag(*(const LAS u32x2*)(G1B + fr * 16 + 4 * g), zz), vb, accU, 0, 0, 0);
            u32x2 clo; clo.x = hw_pk2(IM[I_CF + (4 * g + 0) * 64 + c0 + fr], IM[I_CF + (4 * g + 1) * 64 + c0 + fr]); clo.y = hw_pk2(IM[I_CF + (4 * g + 2) * 64 + c0 + fr], IM[I_CF + (4 * g + 3) * 64 + c0 + fr]);
            f32x4 accw = {0.f, 0.f, 0.f, 0.f};
            accw = __builtin_amdgcn_mfma_f32_16x16x32_bf16(mk_frag(*(const LAS u32x2*)(TTB + fr * 16 + 4 * g), zz), mk_frag(clo, zz), accw, 0, 0, 0);
#pragma unroll
            for (int r = 0; r < 4; ++r) WCB[(4 * g + r) * RS + c0 + fr] = hw_bf(accw[r]);
        }
        LBAR();
        if (role == 0) {
            RM_STATE_PART(vb);
            LBAR();
            RM_FLUSH(c, rg_cur, *(const LAS f32x4*)(Lf + O_VV + ((c & 1) * 2 + hx) * 1024 + tl * 64 + d4), Lf[O_BS + ((c & 1) * 2 + hx) * 16 + tl]);
        } else {
            float* rec = STASH + (size_t)(c - c_begin) * REC;
            for (int i = tid; i < 1376; i += NTHREADS) { const int hd = i >= 688, j = i - hd * 688; const int o = O_IMG + hd * IMGSZ + (j < 144 ? I_RT + 4 * j : I_BTT + 4 * (j - 144)); *(GAS f32x4*)(rec + 4 * i) = *(const LAS f32x4*)(Lf + o); }
            { GAS unsigned* ru = (GAS unsigned*)(rec + 5504); ru[(w * 2 + 0) * 64 + lane] = hw_pk2(accU[0], accU[1]); ru[(w * 2 + 1) * 64 + lane] = hw_pk2(accU[2], accU[3]); }
            { const f32x4 v4 = *(const LAS f32x4*)(Lf + O_VV + ((c & 1) * 2 + hx) * 1024 + tl * 64 + d4); u32x2 o; o.x = hw_pk2(v4[0], v4[1]); o.y = hw_pk2(v4[2], v4[3]); *(GAS u32x2*)(rec + 6528 + 2 * tid) = o; }
            if (tid < 32) rec[7552 + tid] = Lf[O_BS + (c & 1) * 32 + tid];
            LBAR();
        }
        rg_cur = rg_nxt; rg_nxt = rg_far;
    }
    if (role == 0) {
#pragma unroll
        for (int i = 0; i < 4; ++i)
#pragma unroll
            for (int r = 0; r < 4; ++r) STATE[((w * 4 + i) * 4 + r) * 64 + lane] = Macc[i][r];
        asm volatile("s_waitcnt vmcnt(0)" ::: "memory");
        __syncthreads();
        if (tid == 0) { __builtin_amdgcn_fence(__ATOMIC_RELEASE, "agent"); asm volatile("s_waitcnt vmcnt(0)" ::: "memory"); __hip_atomic_store(flag, 1u, __ATOMIC_RELAXED, __HIP_MEMORY_SCOPE_AGENT); }
    } else {
        if (tid == 0) { unsigned sp = 0; while (__hip_atomic_load(flag, __ATOMIC_RELAXED, __HIP_MEMORY_SCOPE_AGENT) == 0u) { __builtin_amdgcn_s_sleep(8); if (++sp > (1u << 22)) break; }
            __builtin_amdgcn_fence(__ATOMIC_ACQUIRE, "agent"); asm volatile("s_waitcnt vmcnt(0)" ::: "memory"); }
        __syncthreads();
#pragma unroll
        for (int i = 0; i < 4; ++i)
#pragma unroll
            for (int r = 0; r < 4; ++r) Macc[i][r] = STATE[((w * 4 + i) * 4 + r) * 64 + lane];
        f32x4 pi0, pi1, pi2; unsigned pu0, pu1; u32x2 pv, pgate; float pbs;
#define RM_REC_LOAD(cc) do { const float* rec = STASH + (size_t)((cc) - c_begin) * REC; pi0 = *(const GAS f32x4*)(rec + 4 * tid); pi1 = *(const GAS f32x4*)(rec + 4 * (tid + 512)); \
            pi2 = (tid < 352) ? *(const GAS f32x4*)(rec + 4 * (tid + 1024)) : (f32x4){0.f, 0.f, 0.f, 0.f}; \
            const GAS unsigned* ru = (const GAS unsigned*)(rec + 5504); pu0 = ru[(w * 2 + 0) * 64 + lane]; pu1 = ru[(w * 2 + 1) * 64 + lane]; pv = *(const GAS u32x2*)(rec + 6528 + 2 * tid); pbs = rec[7552 + hx * 16 + tl]; \
            pgate = *(const GAS u32x2*)(LO + (size_t)((cc) * TC + tl) * LORA_N + col4 + 2048); } while (0)
#define RM_IMG_OFF(i_) (O_IMG + ((i_) >= 688) * IMGSZ + ((((i_) - ((i_) >= 688) * 688) < 144) ? I_RT + 4 * ((i_) - ((i_) >= 688) * 688) : I_BTT + 4 * (((i_) - ((i_) >= 688) * 688) - 144)))
        RM_REC_LOAD(c_begin);
        for (int c = c_begin; c < c_end; ++c) {
            *(LAS f32x4*)(Lf + RM_IMG_OFF(tid)) = pi0; *(LAS f32x4*)(Lf + RM_IMG_OFF(tid + 512)) = pi1; if (tid < 352) *(LAS f32x4*)(Lf + RM_IMG_OFF(tid + 1024)) = pi2;
            const f32x4 vcur = {bf_lo(pv.x), bf_hi(pv.x), bf_lo(pv.y), bf_hi(pv.y)}; *(LAS f32x4*)(Lf + O_VV + hx * 1024 + tl * 64 + d4) = vcur;
            const f32x4 accU = {bf_lo(pu0), bf_hi(pu0), bf_lo(pu1), bf_hi(pu1)}; const float bscur = pbs; const u32x2 gcur = pgate;
            if (c + 1 < c_end) RM_REC_LOAD(c + 1);
            LBAR();
            const LAS float* VVc = Lf + O_VV + hh * 1024;
            u32x2 vlo; { vlo.x = hw_pk2(VVc[(4 * g + 0) * 64 + c0 + fr], VVc[(4 * g + 1) * 64 + c0 + fr]); vlo.y = hw_pk2(VVc[(4 * g + 2) * 64 + c0 + fr], VVc[(4 * g + 3) * 64 + c0 + fr]); }
            const bf16x8 vb = mk_frag(vlo, zz);
            RM_STATE_PART(vb);
            LBAR();
            RM_FLUSH(c, gcur, vcur, bscur);
            LBAR();
        }
#undef RM_REC_LOAD
#undef RM_IMG_OFF
    }
#undef RM_STATE_PART
#undef RM_FLUSH
#undef RM_LOAD
#undef RM_XFORM
}

__device__ __forceinline__ int med3i(int a, int b, int c) { int r; asm("v_med3_i32 %0, %1, %2, %3" : "=v"(r) : "v"(a), "v"(b), "v"(c)); return r; }
__device__ __forceinline__ int f2sort(float f) { int x = __float_as_int(f); return x ^ ((x >> 31) & 0x7fffffff); }
__device__ __forceinline__ float sort2f(int x) { return __int_as_float(x ^ ((x >> 31) & 0x7fffffff)); }
#define TOPK_INSERT(vals, x) do { _Pragma("unroll") for (int s_ = 15; s_ >= 1; --s_) vals[s_] = med3i((x), vals[s_ - 1], vals[s_]); vals[0] = max(vals[0], (x)); } while (0)
__device__ __forceinline__ float bf_dot2(unsigned a, unsigned b, float c) {
    return c + bf_lo(a) * bf_lo(b) + bf_hi(a) * bf_hi(b);
}
__device__ __forceinline__ void sum8_x8(float (&a)[8]) {
    asm("s_nop 1\n\t"
        "v_add_f32_dpp %0, %0, %0 quad_perm:[1,0,3,2] row_mask:0xf bank_mask:0xf\n\tv_add_f32_dpp %1, %1, %1 quad_perm:[1,0,3,2] row_mask:0xf bank_mask:0xf\n\t"
        "v_add_f32_dpp %2, %2, %2 quad_perm:[1,0,3,2] row_mask:0xf bank_mask:0xf\n\tv_add_f32_dpp %3, %3, %3 quad_perm:[1,0,3,2] row_mask:0xf bank_mask:0xf\n\t"
        "v_add_f32_dpp %4, %4, %4 quad_perm:[1,0,3,2] row_mask:0xf bank_mask:0xf\n\tv_add_f32_dpp %5, %5, %5 quad_perm:[1,0,3,2] row_mask:0xf bank_mask:0xf\n\t"
        "v_add_f32_dpp %6, %6, %6 quad_perm:[1,0,3,2] row_mask:0xf bank_mask:0xf\n\tv_add_f32_dpp %7, %7, %7 quad_perm:[1,0,3,2] row_mask:0xf bank_mask:0xf\n\t"
        "v_add_f32_dpp %0, %0, %0 quad_perm:[2,3,0,1] row_mask:0xf bank_mask:0xf\n\tv_add_f32_dpp %1, %1, %1 quad_perm:[2,3,0,1] row_mask:0xf bank_mask:0xf\n\t"
        "v_add_f32_dpp %2, %2, %2 quad_perm:[2,3,0,1] row_mask:0xf bank_mask:0xf\n\tv_add_f32_dpp %3, %3, %3 quad_perm:[2,3,0,1] row_mask:0xf bank_mask:0xf\n\t"
        "v_add_f32_dpp %4, %4, %4 quad_perm:[2,3,0,1] row_mask:0xf bank_mask:0xf\n\tv_add_f32_dpp %5, %5, %5 quad_perm:[2,3,0,1] row_mask:0xf bank_mask:0xf\n\t"
        "v_add_f32_dpp %6, %6, %6 quad_perm:[2,3,0,1] row_mask:0xf bank_mask:0xf\n\tv_add_f32_dpp %7, %7, %7 quad_perm:[2,3,0,1] row_mask:0xf bank_mask:0xf\n\t"
        "v_add_f32_dpp %0, %0, %0 row_half_mirror row_mask:0xf bank_mask:0xf\n\tv_add_f32_dpp %1, %1, %1 row_half_mirror row_mask:0xf bank_mask:0xf\n\t"
        "v_add_f32_dpp %2, %2, %2 row_half_mirror row_mask:0xf bank_mask:0xf\n\tv_add_f32_dpp %3, %3, %3 row_half_mirror row_mask:0xf bank_mask:0xf\n\t"
        "v_add_f32_dpp %4, %4, %4 row_half_mirror row_mask:0xf bank_mask:0xf\n\tv_add_f32_dpp %5, %5, %5 row_half_mirror row_mask:0xf bank_mask:0xf\n\t"
        "v_add_f32_dpp %6, %6, %6 row_half_mirror row_mask:0xf bank_mask:0xf\n\tv_add_f32_dpp %7, %7, %7 row_half_mirror row_mask:0xf bank_mask:0xf\n\t"
        "s_nop 1"
        : "+v"(a[0]), "+v"(a[1]), "+v"(a[2]), "+v"(a[3]), "+v"(a[4]), "+v"(a[5]), "+v"(a[6]), "+v"(a[7]));
}
__device__ __forceinline__ float sum8_x1(float v) {
    asm("s_nop 1\n\tv_add_f32_dpp %0, %0, %0 quad_perm:[1,0,3,2] row_mask:0xf bank_mask:0xf\n\ts_nop 1\n\tv_add_f32_dpp %0, %0, %0 quad_perm:[2,3,0,1] row_mask:0xf bank_mask:0xf\n\ts_nop 1\n\t"
        "v_add_f32_dpp %0, %0, %0 row_half_mirror row_mask:0xf bank_mask:0xf\n\ts_nop 1" : "+v"(v));
    return v;
}
__device__ __forceinline__ void peer_phase(const Args& A, Frame& F, int L, const bool dry, const bf16* Hin, bf16* Hout) {
    int lane = F.lane; asm volatile("" : "+v"(lane));
    const int gw = F.vcu * NWAVES + F.wave;
    const bf16* SCR = (const bf16*)(A.ws + WS_SC); const bf16* X = Hin; float* RS3 = (float*)(A.ws + WS_RS3);
    const unsigned char* TU = (const unsigned char*)(A.ws + WS_TABU) + (size_t)L * 16384 * D; const unsigned char* TV = (const unsigned char*)(A.ws + WS_TABV) + (size_t)L * 16384 * D;
    const float* rowss = (const float*)(A.ws + WS_RSP) + (size_t)(L == 0 ? RS_FFN0 : RS_FFN1) * T * 32;
    LAS unsigned* LIST = (LAS unsigned*)(F.lds + RING_OFF + F.wave * 16384);
    LAS unsigned* EIDX = LIST + 1024;
    LAS float* ECOEF = (LAS float*)(EIDX + 1024);
    const int tbase = gw * 8;
    if (tbase >= T) return;
    for (int half = 0; half < 2; ++half) {
        const int t0 = tbase + 4 * half;
        {
            const bf16* sp = SCR + (size_t)(t0 + (lane >> 4)) * D + (lane & 15) * 128;
            int vals[16];
#pragma unroll
            for (int s = 0; s < 16; ++s) vals[s] = (int)0x80000000;
#pragma unroll 2
            for (int c = 0; c < 16; ++c) { const v4u wv = *(const GAS v4u*)(sp + c * 8); const unsigned ww[4] = {wv.x, wv.y, wv.z, wv.w};
#pragma unroll
                for (int e = 0; e < 8; ++e) { const unsigned bits = (e & 1) ? (ww[e >> 1] & 0xffff0000u) : (ww[e >> 1] << 16);
                    int x = (int)bits; x ^= (x >> 31) & 0x7fffffff; x = (x & ~0x7f) | (127 - (c * 8 + e));
                    TOPK_INSERT(vals, x); } }
#pragma unroll
            for (int q = 0; q < 4; ++q) { v4u o; o.x = (unsigned)vals[4 * q]; o.y = (unsigned)vals[4 * q + 1]; o.z = (unsigned)vals[4 * q + 2]; o.w = (unsigned)vals[4 * q + 3]; *(LAS v4u*)(LIST + lane * 16 + 4 * q) = o; }
        }
        LDS_WAIT(); asm volatile("" ::: "memory");
        if (lane < 32) {
            const LAS unsigned* la = LIST + ((lane >> 3) * 16 + (lane & 7) * 2) * 16; const LAS unsigned* lb2 = la + 16;
            float av[16], bv[16];
#pragma unroll
            for (int q = 0; q < 4; ++q) { const v4u a4 = *(const LAS v4u*)(la + 4 * q), b4 = *(const LAS v4u*)(lb2 + 4 * q); const unsigned aw[4] = {a4.x, a4.y, a4.z, a4.w}, bw[4] = {b4.x, b4.y, b4.z, b4.w};
#pragma unroll
                for (int e = 0; e < 4; ++e) { av[4 * q + e] = __uint_as_float(__float_as_uint(sort2f((int)(aw[e] & ~0x7fu))) & 0xffff0000u); bv[4 * q + e] = __uint_as_float(__float_as_uint(sort2f((int)(bw[e] & ~0x7fu))) & 0xffff0000u); } }
            int best[16];
#pragma unroll
            for (int s = 0; s < 16; ++s) best[s] = (int)0x80000000;
#pragma unroll
            for (int i = 0; i < 16; ++i)
#pragma unroll
                for (int jx = 0; jx < 16; ++jx) if ((i + 1) * (jx + 1) <= 16) { int x = f2sort(av[i] + bv[jx]); x = (x & ~0xff) | (255 - (i * 16 + jx)); TOPK_INSERT(best, x); }
            float sv[16]; unsigned ex[16];
#pragma unroll
            for (int s = 0; s < 16; ++s) { const int cand = 255 - (best[s] & 0xff); const unsigned ka = la[cand >> 4], kb = lb2[cand & 15];
                ex[s] = (127u - (ka & 0x7fu)) * 128u + (127u - (kb & 0x7fu));
                sv[s] = __uint_as_float(__float_as_uint(sort2f((int)(ka & ~0x7fu))) & 0xffff0000u) + __uint_as_float(__float_as_uint(sort2f((int)(kb & ~0x7fu))) & 0xffff0000u); }
            float mx = sv[0];
#pragma unroll
            for (int s = 1; s < 16; ++s) mx = fmaxf(mx, sv[s]);
            float den = 0.f;
#pragma unroll
            for (int s = 0; s < 16; ++s) { sv[s] = __expf(sv[s] - mx); den += sv[s]; }
            const float inv = 1.0f / den; const int base = (4 * half + (lane >> 3)) * 128 + (lane & 7) * 16;
#pragma unroll
            for (int s = 0; s < 16; ++s) { EIDX[base + s] = ex[s]; ECOEF[base + s] = sv[s] * inv; }
        }
        LDS_WAIT(); asm volatile("" ::: "memory");
    }
    const int tk = lane >> 3, part = lane & 7, t = tbase + tk;
    const LAS unsigned* eidx = EIDX + tk * 128; LAS float* ecoef = ECOEF + tk * 128;
    const float rs = __builtin_amdgcn_rsqf(sum8_x1(((const GAS f32x4*)(rowss + (size_t)t * 32))[part][0] + ((const GAS f32x4*)(rowss + (size_t)t * 32))[part][1] + ((const GAS f32x4*)(rowss + (size_t)t * 32))[part][2] + ((const GAS f32x4*)(rowss + (size_t)t * 32))[part][3]) * (1.0f / D) + EPS) * (1.0f / 512.0f);
#define PEER_LOAD8(dst, TAB, i0, soff) do { const v4u ia_ = *(const LAS v4u*)(eidx + (i0)), ib_ = *(const LAS v4u*)(eidx + (i0) + 4); const unsigned ee_[8] = {ia_.x, ia_.y, ia_.z, ia_.w, ib_.x, ib_.y, ib_.z, ib_.w}; \
        _Pragma("unroll") for (int j_ = 0; j_ < 8; ++j_) dst[j_] = *(const GAS v4u*)((TAB) + (size_t)(ee_[j_] * 2048u + (unsigned)(soff))); } while (0)
    LAS float* dotw = (LAS float*)LIST + tk * 128;
#pragma unroll
    for (int m = 0; m < 16; ++m) dotw[8 * m + part] = 0.f;
#pragma unroll 1
    for (int p = 0; p < 16; ++p) {
        const int soff = 128 * p + 16 * part;
        float xs[16];
        { const v4u x0 = *(const GAS v4u*)(X + (size_t)t * D + soff), x1 = *(const GAS v4u*)(X + (size_t)t * D + soff + 8); const unsigned xw[8] = {x0.x, x0.y, x0.z, x0.w, x1.x, x1.y, x1.z, x1.w};
#pragma unroll
          for (int e = 0; e < 8; ++e) { xs[2 * e] = bf_lo(xw[e]); xs[2 * e + 1] = bf_hi(xw[e]); } }
#define PEER_UDOT8(src, m_) do { float tt_[8]; \
        _Pragma("unroll") for (int j_ = 0; j_ < 8; ++j_) { const unsigned ww_[4] = {src[j_].x, src[j_].y, src[j_].z, src[j_].w}; float a0_ = 0.f, a1_ = 0.f; \
            _Pragma("unroll") for (int e_ = 0; e_ < 4; ++e_) { const f32x2 lo_ = __builtin_amdgcn_cvt_pk_f32_fp8((int)ww_[e_], false), hi_ = __builtin_amdgcn_cvt_pk_f32_fp8((int)ww_[e_], true); \
                a0_ += xs[4 * e_] * lo_[0]; a1_ += xs[4 * e_ + 1] * lo_[1]; a0_ += xs[4 * e_ + 2] * hi_[0]; a1_ += xs[4 * e_ + 3] * hi_[1]; } \
            tt_[j_] = a0_ + a1_; } \
        sum8_x8(tt_); \
        float sel_ = tt_[0]; _Pragma("unroll") for (int j_ = 1; j_ < 8; ++j_) sel_ = (part == j_) ? tt_[j_] : sel_; \
        dotw[8 * (m_) + part] += sel_; } while (0)
        v4u ua[8], ub[8];
        PEER_LOAD8(ua, TU, 0, soff);
#pragma unroll 1
        for (int m = 0; m < 16; m += 2) {
            PEER_LOAD8(ub, TU, 8 * (m + 1), soff);
            PEER_UDOT8(ua, m);
            if (m + 2 < 16) PEER_LOAD8(ua, TU, 8 * (m + 2), soff);
            PEER_UDOT8(ub, m + 1);
        }
    }
#undef PEER_UDOT8
#pragma unroll
    for (int m = 0; m < 16; ++m) { const float d_ = dotw[8 * m + part] * rs; const float act = 0.5f * d_ * (1.0f + erff(d_ * 0.7071067811865476f)); ecoef[8 * m + part] *= act * (1.0f / 16.0f); }
    LDS_WAIT(); asm volatile("" ::: "memory");
    float ss = 0.f;
#pragma unroll 1
    for (int p = 0; p < 16; ++p) {
        const int soff = 128 * p + 16 * part;
        float acc[16];
#pragma unroll
        for (int i = 0; i < 16; ++i) acc[i] = 0.f;
#define PEER_VACC8(src, i0) do { const f32x4 ca_ = *(const LAS f32x4*)(ecoef + (i0)), cb_ = *(const LAS f32x4*)(ecoef + (i0) + 4); const float cf_[8] = {ca_[0], ca_[1], ca_[2], ca_[3], cb_[0], cb_[1], cb_[2], cb_[3]}; \
        _Pragma("unroll") for (int j_ = 0; j_ < 8; ++j_) { const unsigned ww_[4] = {src[j_].x, src[j_].y, src[j_].z, src[j_].w}; \
            _Pragma("unroll") for (int e_ = 0; e_ < 4; ++e_) { const f32x2 lo_ = __builtin_amdgcn_cvt_pk_f32_fp8((int)ww_[e_], false), hi_ = __builtin_amdgcn_cvt_pk_f32_fp8((int)ww_[e_], true); \
                acc[4 * e_] += cf_[j_] * lo_[0]; acc[4 * e_ + 1] += cf_[j_] * lo_[1]; acc[4 * e_ + 2] += cf_[j_] * hi_[0]; acc[4 * e_ + 3] += cf_[j_] * hi_[1]; } } } while (0)
        v4u va[8], vb[8];
        PEER_LOAD8(va, TV, 0, soff);
#pragma unroll 1
        for (int m = 0; m < 16; m += 2) {
            PEER_LOAD8(vb, TV, 8 * (m + 1), soff);
            PEER_VACC8(va, 8 * m);
            if (m + 2 < 16) PEER_LOAD8(va, TV, 8 * (m + 2), soff);
            PEER_VACC8(vb, 8 * (m + 1));
        }
        { const v4u h0 = *(const GAS v4u*)(Hin + (size_t)t * D + soff), h1 = *(const GAS v4u*)(Hin + (size_t)t * D + soff + 8); const unsigned hw[8] = {h0.x, h0.y, h0.z, h0.w, h1.x, h1.y, h1.z, h1.w}; unsigned ow[8];
#pragma unroll
          for (int e = 0; e < 8; ++e) { ow[e] = hw_pk2(bf_lo(hw[e]) + acc[2 * e], bf_hi(hw[e]) + acc[2 * e + 1]); const float q0 = bf_lo(ow[e]), q1 = bf_hi(ow[e]); ss += q0 * q0 + q1 * q1; }
          v4u o0, o1; o0.x = ow[0]; o0.y = ow[1]; o0.z = ow[2]; o0.w = ow[3]; o1.x = ow[4]; o1.y = ow[5]; o1.z = ow[6]; o1.w = ow[7];
          if (!dry) { *(GAS v4u*)(Hout + (size_t)t * D + soff) = o0; *(GAS v4u*)(Hout + (size_t)t * D + soff + 8) = o1; } else asm volatile("" :: "v"(o0.x), "v"(o0.y), "v"(o0.z), "v"(o0.w), "v"(o1.x), "v"(o1.y), "v"(o1.z), "v"(o1.w)); }
    }
#undef PEER_VACC8
#undef PEER_LOAD8
    const float r3 = __builtin_amdgcn_rsqf(sum8_x1(ss) * (1.0f / D) + EPS);
    if (!dry && part == 0) RS3[t] = r3;
}

constexpr int N_PHASES = 19;
__global__ void __launch_bounds__(NTHREADS, 2) mega_fwd(Args args) {
    extern __shared__ __attribute__((aligned(16))) unsigned char lds[];
    Frame F;
    F.lds = (LAS unsigned char*)lds;
    F.MISC = (volatile LAS unsigned*)(F.lds + MISC_OFF);
    F.tid = threadIdx.x; F.lane = F.tid & 63; F.wave = __builtin_amdgcn_readfirstlane(F.tid >> 6);
    F.G = gridDim.x; { const int bx = blockIdx.x; F.vcu = (F.G % 8 == 0) ? (bx % 8) * (F.G / 8) + bx / 8 : bx; }
    unsigned char* ws = args.ws;
    F.ctl = (gu32*)(ws + WS_CTL);
    for (int u = F.tid; u < (LDS_BYTES - LDSCTL_OFF) / 4; u += NTHREADS) ((LAS unsigned*)(F.lds + LDSCTL_OFF))[u] = 0u;
    __syncthreads();
    const int lo = args.ph_lo, hi = args.ph_hi;
    XcdBarrier bar; bar.bar = (unsigned*)(F.ctl + CW_BAR); bar.x = 0; bar.st = nullptr;
    if (hi - lo > 1) bar = xcd_barrier_post((unsigned*)(F.ctl + CW_BAR), F.MISC + 8);
#define IN(k) (lo <= (k) && (k) < hi)
#define REPS(k) (1 + ((DUP_MASK >> (k)) & 1))
#if PROBE_MASK
    unsigned long long* const tsb = (unsigned long long*)(ws + WS_CTL + 65536);
#define STAMP(k) do { if (blockIdx.x == 0 && F.tid == 0) __hip_atomic_store(tsb + (k), __builtin_amdgcn_s_memrealtime(), __ATOMIC_RELAXED, __HIP_MEMORY_SCOPE_AGENT); } while (0)
    STAMP(31);
#else
#define STAMP(k) do { } while (0)
#endif
#define SEAM(k) do { if (IN(k) && IN((k) + 1)) { if ((k) == 0) { cg::this_grid().sync(); } else { xcd_barrier(bar); } STAMP(k); } } while (0)
    float* rowss = (float*)(ws + WS_RSP);
    bf16* ACTA = (bf16*)(ws + WS_ACTA); bf16* ACTB = (bf16*)(ws + WS_ACTB); bf16* H1 = (bf16*)(ws + WS_H1); const float* RS3 = (const float*)(ws + WS_RS3);
    bf16* PROJ = (bf16*)(ws + WS_PROJ); bf16* SCB = (bf16*)(ws + WS_SC); bf16* PP = (bf16*)(ws + WS_PP);
    const int gtid = (F.vcu * NWAVES + F.wave) * 64 + F.lane, gthreads = F.G * NTHREADS;

#if UBENCH
    {
        typedef _Float16 h2_t __attribute__((ext_vector_type(2)));
        float a[32]; f32x2 p[16]; h2_t hh[32];
#pragma unroll
        for (int i = 0; i < 32; ++i) { a[i] = (float)(F.tid + i); hh[i] = (h2_t){(_Float16)(F.lane + i), (_Float16)i}; }
#pragma unroll
        for (int i = 0; i < 16; ++i) p[i] = (f32x2){a[2 * i], a[2 * i + 1]};
        const float m = 1.0f + 1e-7f * F.lane, c = 1e-9f; const f32x2 m2 = {m, m}, c2 = {c, c}; const h2_t mh = {(_Float16)1.0f, (_Float16)1.0f}, ch = {(_Float16)0.0f, (_Float16)0.0f};
#pragma unroll 1
        for (int it = 0; it < 10000; ++it) {
#if UBENCH == 1
#pragma unroll
            for (int i = 0; i < 32; ++i) asm volatile("v_fma_f32 %0, %0, %1, %2" : "+v"(a[i]) : "v"(m), "v"(c));
#elif UBENCH == 2
#pragma unroll
            for (int i = 0; i < 16; ++i) asm volatile("v_pk_fma_f32 %0, %0, %1, %2\n\tv_pk_fma_f32 %0, %0, %1, %2" : "+v"(p[i]) : "v"(m2), "v"(c2));
#elif UBENCH == 3
#pragma unroll
            for (int i = 0; i < 32; ++i) asm volatile("v_pk_fma_f16 %0, %0, %1, %2" : "+v"(hh[i]) : "v"(mh), "v"(ch));
#endif
        }
        float s = 0.f;
#pragma unroll
        for (int i = 0; i < 32; ++i) s += a[i] + (float)hh[i][0];
#pragma unroll
        for (int i = 0; i < 16; ++i) s += p[i][0] + p[i][1];
        if (s == 12345.678f) args.out[0] = s;
    }
#endif
    if (IN(0)) { p0_prologue(args, F); } SEAM(0);
    if (IN(1)) for (int rep_ = 0; rep_ < REPS(1); ++rep_) {
        { pg8::Gemm g{ACTA, (const bf16*)(ws + WS_WEV_IN), T, EV_NP, D}; pg8::StaticOrder S; S.init(T, EV_NP, F.G, (int)blockIdx.x); EpiBf16S E{PROJ, PROJ_LD, nullptr};
          pg8::gemm_phase<EpiBf16S, pg8::StaticOrder, true, true>(F.lds + RING_OFF, g, S, E); }
    } SEAM(1);
    if (IN(2)) for (int rep_ = 0; rep_ < REPS(2); ++rep_) {
        if (F.G >= 256) {
            const int u = F.vcu;
            if (u < 64) scan_gla_mfma_unit<0>(args, F, u); else if (u < 128) scan_gdn_mfma_unit(args, F, u - 64, 0); else if (u < 192) scan_gdn_mfma_unit(args, F, u - 128, 1);
            __syncthreads();
            if (rep_ == 0) { if (u < 64) p0_deferred(args, F, 128 + u, 192); else if (u >= 192) for (int k = 0; k < 2; ++k) p0_deferred(args, F, 2 * (u - 192) + k, 192); }
        } else {
            for (int u = F.vcu; u < 64; u += F.G) { scan_gla_mfma_unit<0>(args, F, u); __syncthreads(); }
            for (int u = F.vcu; u < 64; u += F.G) { scan_gdn_mfma_unit(args, F, u, 0); __syncthreads(); scan_gdn_mfma_unit(args, F, u, 1); __syncthreads(); }
            if (rep_ == 0) p0_deferred(args, F, F.vcu, F.G);
        }
    } SEAM(2);
    if (IN(3)) for (int rep_ = 0; rep_ < REPS(3); ++rep_) { post_rows<0>(args, F); } SEAM(3);
    if (IN(4)) { pg8::Gemm g{ACTA, (const bf16*)(ws + WS_WEV_OUT), T, D, D}; pg8::StaticOrder S; S.init(T, D, F.G, (int)blockIdx.x);
        EpiResid<false, true> E{args.in[I_X], ACTB, rowss + (size_t)RS_FFN0 * T * 32, nullptr, nullptr};
        pg8::gemm_phase<EpiResid<false, true>, pg8::StaticOrder, true, true>(F.lds + RING_OFF, g, S, E); } SEAM(4);
    if (IN(5)) for (int rep_ = 0; rep_ < REPS(5); ++rep_) { { pg8::Gemm g{ACTB, (const bf16*)(ws + WS_WPEER), T, D, D}; pg8::StaticOrder S; S.init(T, D, F.G, (int)blockIdx.x); EpiBf16S E{SCB, D, rowss + (size_t)RS_FFN0 * T * 32};
        pg8::gemm_phase<EpiBf16S, pg8::StaticOrder, true, true>(F.lds + RING_OFF, g, S, E); }
        { pg8::Gemm g{(const bf16*)(ws + WS_PBF), (const bf16*)(ws + WS_WPROJ), T, D, 256}; pg8::StaticOrder S; S.init(T, D, F.G, (int)blockIdx.x); EpiBf16S E{PP, D, nullptr};
          pg8::gemm_phase<EpiBf16S, pg8::StaticOrder, true, true>(F.lds + RING_OFF, g, S, E); } } SEAM(5);
    if (IN(6)) for (int rep_ = 0; rep_ < REPS(6); ++rep_) { peer_phase(args, F, 0, rep_ != 0, ACTB, H1); } SEAM(6);
    if (IN(7)) { { pg8::Gemm g{H1, (const bf16*)(ws + WS_WGATE), T, D, D}; pg8::StaticOrder S; S.init(T, D, F.G, (int)blockIdx.x);
        EpiResid<true, false> E{H1, ACTB, rowss + (size_t)RS_MIX1 * T * 32, PP, RS3};
        pg8::gemm_phase<EpiResid<true, false>, pg8::StaticOrder, true, true>(F.lds + RING_OFF, g, S, E); }
        } SEAM(7);
    if (IN(8)) for (int rep_ = 0; rep_ < REPS(8); ++rep_) {
        { pg8::Gemm g{ACTB, (const bf16*)(ws + WS_WOD_IN), T, OD_NP, D}; pg8::StaticOrder S; S.init(T, OD_NP, F.G, (int)blockIdx.x); EpiBf16S E{PROJ, PROJ_LD, rowss + (size_t)RS_MIX1 * T * 32};
          pg8::gemm_phase<EpiBf16S, pg8::StaticOrder, true, true>(F.lds + RING_OFF, g, S, E); }
        { pg8::Gemm g{(const bf16*)(ws + WS_PBF) + (size_t)T * 256, (const bf16*)(ws + WS_WPROJ) + (size_t)D * 256, T, D, 256}; pg8::StaticOrder S; S.init(T, D, F.G, (int)blockIdx.x); EpiBf16S E{PP, D, nullptr};
          pg8::gemm_phase<EpiBf16S, pg8::StaticOrder, true, true>(F.lds + RING_OFF, g, S, E); }
    } SEAM(8);
    if (IN(9)) for (int rep_ = 0; rep_ < REPS(9); ++rep_) { lora_prep_rows(args, F); } SEAM(9);
    if (IN(10)) for (int rep_ = 0; rep_ < REPS(10); ++rep_) { pg8::Gemm g{(const bf16*)(ws + WS_LA), (const bf16*)(ws + WS_WLORA), T, LORA_N, LORA_K}; pg8::StaticOrder S; S.init(T, LORA_N, F.G, (int)blockIdx.x); EpiBf16S E{(bf16*)(ws + WS_LO), LORA_N, nullptr};
        pg8::gemm_phase<EpiBf16S, pg8::StaticOrder, true, true>(F.lds + RING_OFF, g, S, E); } SEAM(10);
    if (IN(11)) for (int rep_ = 0; rep_ < REPS(11); ++rep_) {
        if (F.G >= 256) {
            const int u = F.vcu;
            if (u < 64) scan_gla_mfma_unit<1>(args, F, u); else if (u < 128) scan_rwkv_mfma_unit(args, F, u - 64, 0); else if (u < 192) scan_rwkv_mfma_unit(args, F, u - 128, 1);
            __syncthreads();
            if (rep_ == 0) { if (u < 64) p1_deferred(args, F, 128 + u, 192); else if (u >= 192) for (int k = 0; k < 2; ++k) p1_deferred(args, F, 2 * (u - 192) + k, 192); }
        } else {
            for (int u = F.vcu; u < 64; u += F.G) { scan_gla_mfma_unit<1>(args, F, u); __syncthreads(); }
            for (int u = F.vcu; u < 64; u += F.G) { scan_rwkv_mfma_unit(args, F, u, 0); __syncthreads(); scan_rwkv_mfma_unit(args, F, u, 1); __syncthreads(); }
            if (rep_ == 0) p1_deferred(args, F, F.vcu, F.G);
        }
    } SEAM(11);
    if (IN(12)) for (int rep_ = 0; rep_ < REPS(12); ++rep_) { post_rows<1>(args, F); } SEAM(12);
    if (IN(13)) { pg8::Gemm g{ACTA, (const bf16*)(ws + WS_WOD_OUT), T, D, D}; pg8::StaticOrder S; S.init(T, D, F.G, (int)blockIdx.x);
        EpiResid<false, false> E{ACTB, H1, rowss + (size_t)RS_FFN1 * T * 32, nullptr, nullptr};
        pg8::gemm_phase<EpiResid<false, false>, pg8::StaticOrder, true, true>(F.lds + RING_OFF, g, S, E); } SEAM(13);
    if (IN(14)) for (int rep_ = 0; rep_ < REPS(14); ++rep_) { pg8::Gemm g{H1, (const bf16*)(ws + WS_WPEER) + (size_t)D * D, T, D, D}; pg8::StaticOrder S; S.init(T, D, F.G, (int)blockIdx.x); EpiBf16S E{SCB, D, rowss + (size_t)RS_FFN1 * T * 32};
        pg8::gemm_phase<EpiBf16S, pg8::StaticOrder, true, true>(F.lds + RING_OFF, g, S, E); } SEAM(14);
    if (IN(15)) for (int rep_ = 0; rep_ < REPS(15); ++rep_) { peer_phase(args, F, 1, rep_ != 0, H1, ACTB); } SEAM(15);
    if (IN(16)) { pg8::Gemm g{ACTB, (const bf16*)(ws + WS_WGATE) + (size_t)D * D, T, D, D}; pg8::StaticOrder S; S.init(T, D, F.G, (int)blockIdx.x);
        EpiResid<true, false> E{ACTB, H1, rowss + (size_t)RS_FINAL * T * 32, PP, RS3};
        pg8::gemm_phase<EpiResid<true, false>, pg8::StaticOrder, true, true>(F.lds + RING_OFF, g, S, E); } SEAM(16);
    if (IN(17)) {
        float oscale = 1.0f;
#if PROBE_MASK
        { unsigned long long t_prev = __hip_atomic_load(tsb + 31, __ATOMIC_RELAXED, __HIP_MEMORY_SCOPE_AGENT); const unsigned long long t_begin = t_prev; unsigned long long sel = 0ull;
          for (int k = 0; k <= 16; ++k) { const unsigned long long tk = __hip_atomic_load(tsb + k, __ATOMIC_RELAXED, __HIP_MEMORY_SCOPE_AGENT); if ((PROBE_MASK >> k) & 1) sel += tk - t_prev; t_prev = tk; }
          const float f = (float)(double(sel) / double(t_prev - t_begin)); oscale = 1.0f + sqrtf(0.01f + 0.9f * f); }
#endif
        final_rows(args, F, oscale, H1); }
#undef IN
#undef SEAM
}

extern "C" void kernel_launch(void* const* d_in, const int* in_sizes, int n_in, void* d_out, int out_size, void* d_ws, size_t ws_size, hipStream_t stream) {
    static int grid = 0;
    if (grid == 0) {
        if (n_in != N_IN || out_size != T * D || ws_size < WS_END + 63 * MiB) { fprintf(stderr, "kernel_launch: unexpected problem: n_in %d out %d ws %zu (need %zu)\n", n_in, out_size, ws_size, (size_t)(WS_END + 63 * MiB)); grid = -1; return; }
        int dev = 0, cus = 0, per_cu = 0;
        if (hipGetDevice(&dev) != hipSuccess || hipDeviceGetAttribute(&cus, hipDeviceAttributeMultiprocessorCount, dev) != hipSuccess) { grid = -1; return; }
        if (hipFuncSetAttribute((const void*)mega_fwd, hipFuncAttributeMaxDynamicSharedMemorySize, LDS_BYTES) != hipSuccess) { fprintf(stderr, "kernel_launch: hipFuncSetAttribute failed\n"); grid = -1; return; }
        if (hipOccupancyMaxActiveBlocksPerMultiprocessor(&per_cu, (const void*)mega_fwd, NTHREADS, LDS_BYTES) != hipSuccess || per_cu < 1) { fprintf(stderr, "kernel_launch: occupancy query says %d blocks per CU\n", per_cu); (void)hipGetLastError(); grid = -1; return; }
        grid = cus;
    }
    if (grid < 0) return;
    (void)hipMemsetAsync((char*)d_ws + WS_CTL, 0, CTL_ZERO_BYTES, stream);
    Args a{};
    for (int i = 0; i < N_IN; ++i) a.in[i] = (const float*)d_in[i];
    a.out = (float*)d_out; a.ws = (unsigned char*)d_ws;
#if MK_PER_PHASE
    for (int p = 0; p < N_PHASES - 1; ++p) { a.ph_lo = p; a.ph_hi = p + 1; hipLaunchKernelGGL(mega_fwd, dim3(grid), dim3(NTHREADS), LDS_BYTES, stream, a); }
#else
    a.ph_lo = 0; a.ph_hi = N_PHASES;
    void* kargs[] = {&a};
    hipError_t e = hipLaunchCooperativeKernel((const void*)mega_fwd, dim3(grid), dim3(NTHREADS), kargs, LDS_BYTES, stream);
    if (e != hipSuccess) fprintf(stderr, "kernel_launch: cooperative launch failed: %s (grid %d)\n", hipGetErrorString(e), grid);
#endif
}
```

```cpp
#include <hip/hip_runtime.h>
#include <hip/hip_cooperative_groups.h>
#include <cstdio>
#include <cstdint>
namespace cg = cooperative_groups;

#ifndef PROBE_MASK
#define PROBE_MASK 0
#endif
#ifndef DUP_MASK
#define DUP_MASK 0
#endif
#ifndef UBENCH
#define UBENCH 0
#endif
#ifndef GDN_DUP
#define GDN_DUP 0
#endif
#ifndef MK_PER_PHASE
#define MK_PER_PHASE 0
#endif

namespace pg8 {
#define PG8_LAS __attribute__((address_space(3)))
typedef unsigned short bf16_t;
typedef short bf16x8 __attribute__((ext_vector_type(8)));
typedef float f32x4 __attribute__((ext_vector_type(4)));
typedef unsigned u32x4 __attribute__((ext_vector_type(4)));
typedef unsigned u32x2 __attribute__((ext_vector_type(2)));
constexpr int BM = 256, BK = 64, HALF = 128, HTB = HALF * BK * 2  , STAGE_BYTES = 8 * HTB, NXCD = 8, WGM = 8;

__host__ __device__ __forceinline__ int lds_byte(int r, int c) { const int st = (r >> 4) * 2 + (c >> 5), rr = r & 15, cc = c & 31, ob = rr * 64 + cc * 2; return st * 1024 + (ob ^ (((ob >> 9) & 1) << 5)); }
__host__ __device__ __forceinline__ void stage_rc(int b, int& R, int& C) { const int st = b / 1024, sb = b % 1024, swz = sb ^ (((sb >> 9) & 1) << 5); R = (st >> 1) * 16 + swz / 64; C = (st & 1) * 32 + (swz % 64) / 2; }
__host__ __device__ __forceinline__ int perm32(int rho) { const int n = rho >> 4, i = rho & 15; return 8 * (i >> 2) + 4 * n + (i & 3); }

struct Unit { int pm, pn; };
struct Gemm { const bf16_t* A; const bf16_t* Bt; int M, N, K; };

struct StaticOrder {
    int nM, nN, nwg, G, c;
    __host__ __device__ void init(int M, int N, int G_, int c_) { nM = M / BM; nN = N / BM; nwg = nM * nN; G = G_; c = c_; }
    __host__ __device__ bool next(int i, Unit& u) const {
        const long L = (long)i * G + c; if (L >= nwg) return false;
        int wgid = (int)L; { const int q = nwg / NXCD, r = nwg % NXCD, xcd = wgid % NXCD, off = wgid / NXCD; wgid = (xcd < r ? xcd * (q + 1) : r * (q + 1) + (xcd - r) * q) + off; }
        const int nig = WGM * nN, gid = wgid / nig, fm = gid * WGM, gsz = (nM - fm) < WGM ? (nM - fm) : WGM;
        u.pm = fm + ((wgid % nig) % gsz); u.pn = (wgid % nig) / gsz; return true;
    }
    __device__ __forceinline__ void a_ready(const Unit&) const {}
    __device__ __forceinline__ void done(const Unit&) const {}
};
__device__ __forceinline__ unsigned cvt_pk_bf16(float lo, float hi) { unsigned r; asm volatile("v_cvt_pk_bf16_f32 %0, %1, %2" : "=v"(r) : "v"(lo), "v"(hi)); return r; }
template <class Epi, class Sched, bool ALIGN_EPI = false, bool SP2 = false>
__device__ __forceinline__ void gemm_phase(PG8_LAS unsigned char* lds, const Gemm g, const Sched& S, const Epi& E) {
    const int tid = threadIdx.x, wid = __builtin_amdgcn_readfirstlane(tid >> 6), lane = tid & 63, wr = wid >> 2, wc = wid & 3, fr = lane & 15, fq = lane >> 4;
    const int K = g.K, nt = K / BK;
    unsigned voffA[2], voffB[2];
#pragma unroll
    for (int i = 0; i < 2; ++i) { int R, C; stage_rc(tid * 16 + i * 8192, R, C); const int Rb = Epi::PERM ? ((R & ~31) + perm32(R & 31)) : R;
        voffA[i] = (unsigned)(R * K + C) * 2u; voffB[i] = (unsigned)(Rb * K + C) * 2u; }
    const size_t kstep = (size_t)(BK * 2);
    const size_t hstep = (size_t)HALF * K * 2;
    const size_t tstep = 2 * hstep;
    const unsigned ldsw = (unsigned)wid * 1024u;
    const int aoff = lds_byte(wr * 64 + fr, fq * 8), boff = lds_byte(wc * 32 + fr, fq * 8);
#define PG8_SA(b, h) (((b) * 2 + (h)) * HTB)
#define PG8_SB(b, h) ((4 + (b) * 2 + (h)) * HTB)
#define PG8_STAGE(bufoff, gbase, voff) do { _Pragma("unroll") for (int _i = 0; _i < 2; ++_i) \
        __builtin_amdgcn_global_load_lds((const unsigned*)((const char*)(gbase) + (voff)[_i]), (PG8_LAS unsigned*)(lds + (bufoff) + ldsw + _i * 8192), 16, 0, 0); } while (0)
#define PG8_LDA(dst, b, h) do { _Pragma("unroll") for (int m = 0; m < 4; ++m) _Pragma("unroll") for (int k = 0; k < 2; ++k) dst[m][k] = *(const PG8_LAS bf16x8*)(lds + PG8_SA(b, h) + aoff + m * 2048 + k * 1024); } while (0)
#define PG8_LDB(dst, b, h) do { _Pragma("unroll") for (int n = 0; n < 2; ++n) _Pragma("unroll") for (int k = 0; k < 2; ++k) dst[n][k] = *(const PG8_LAS bf16x8*)(lds + PG8_SB(b, h) + boff + n * 2048 + k * 1024); } while (0)
#define PG8_MMA(ai, bj, At, Bt) do { __builtin_amdgcn_s_setprio(1); _Pragma("unroll") for (int m = 0; m < 4; ++m) _Pragma("unroll") for (int n = 0; n < 2; ++n) _Pragma("unroll") for (int k = 0; k < 2; ++k) \
        acc[ai][bj][m][n] = __builtin_amdgcn_mfma_f32_16x16x32_bf16(Bt[n][k], At[m][k], acc[ai][bj][m][n], 0, 0, 0); __builtin_amdgcn_s_setprio(0); } while (0)
#define PG8_WAIT_V(n) asm volatile("s_waitcnt vmcnt(" #n ")" ::: "memory")
#define PG8_WAIT_L(n) asm volatile("s_waitcnt lgkmcnt(" #n ")" ::: "memory")
#define PG8_BAR __builtin_amdgcn_s_barrier()
#define PG8_SCHED __builtin_amdgcn_sched_barrier(0)
    Unit cur, nxt; int ui = 0;
    if (!S.next(0, cur)) return;
    f32x4 acc[2][2][4][2];
#pragma unroll
    for (int a = 0; a < 2; ++a)
#pragma unroll
        for (int b = 0; b < 2; ++b)
#pragma unroll
            for (int m = 0; m < 4; ++m)
#pragma unroll
                for (int n = 0; n < 2; ++n) acc[a][b][m][n] = (f32x4){0.f, 0.f, 0.f, 0.f};
    bf16x8 At[4][2], B0[2][2], B1[2][2];
    const char* cA = (const char*)g.A + (size_t)cur.pm * tstep; const char* cB = (const char*)g.Bt + (size_t)cur.pn * tstep;
    S.a_ready(cur);
    if constexpr (SP2) {
        PG8_STAGE(PG8_SB(0, 0), cB, voffB); PG8_STAGE(PG8_SB(0, 1), cB + hstep, voffB); PG8_STAGE(PG8_SA(0, 0), cA, voffA); PG8_STAGE(PG8_SA(0, 1), cA + hstep, voffA);
        if (wr == 1) PG8_BAR;
        PG8_WAIT_V(2); PG8_BAR;
        PG8_STAGE(PG8_SB(1, 0), cB + kstep, voffB); PG8_STAGE(PG8_SA(1, 0), cA + kstep, voffA); PG8_STAGE(PG8_SB(1, 1), cB + hstep + kstep, voffB);
        PG8_WAIT_V(6); PG8_BAR;
    } else {
        PG8_STAGE(PG8_SB(0, 0), cB, voffB); PG8_STAGE(PG8_SA(0, 0), cA, voffA); PG8_STAGE(PG8_SB(0, 1), cB + hstep, voffB); PG8_STAGE(PG8_SA(0, 1), cA + hstep, voffA);
        if (wr == 1) PG8_BAR;
        PG8_WAIT_V(4); PG8_BAR;
        PG8_STAGE(PG8_SB(1, 0), cB + kstep, voffB); PG8_STAGE(PG8_SA(1, 0), cA + kstep, voffA); PG8_STAGE(PG8_SB(1, 1), cB + hstep + kstep, voffB);
        PG8_WAIT_V(6); PG8_BAR;
    }
    for (;;) {
        const bool has_next = S.next(ui + 1, nxt);
        const char* nA = has_next ? (const char*)g.A + (size_t)nxt.pm * tstep : cA; const char* nB = has_next ? (const char*)g.Bt + (size_t)nxt.pn * tstep : cB;
        for (int t = 0; t < nt; t += 2) {
            const bool last = (t == nt - 2);
            const char* a1 = cA + (size_t)(t + 1) * kstep;
            const char* a2 = last ? nA : cA + (size_t)(t + 2) * kstep; const char* b2 = last ? nB : cB + (size_t)(t + 2) * kstep;
            const char* a3 = a2 + kstep; const char* b3 = b2 + kstep;
            if (last && has_next) S.a_ready(nxt);
            if constexpr (SP2) {
            PG8_LDB(B0, 0, 0); PG8_LDB(B1, 0, 1); PG8_SCHED; PG8_LDA(At, 0, 0); PG8_STAGE(PG8_SA(1, 1), a1 + hstep, voffA);
            PG8_WAIT_V(8); PG8_WAIT_L(0); PG8_BAR; PG8_MMA(0, 0, At, B0); PG8_MMA(0, 1, At, B1); PG8_BAR; PG8_SCHED;
            PG8_LDA(At, 0, 1); PG8_STAGE(PG8_SB(0, 0), b2, voffB); PG8_STAGE(PG8_SB(0, 1), b2 + hstep, voffB); PG8_STAGE(PG8_SA(0, 0), a2, voffA);
            PG8_WAIT_V(8); PG8_WAIT_L(0); PG8_BAR; PG8_MMA(1, 0, At, B0); PG8_MMA(1, 1, At, B1); PG8_BAR; PG8_SCHED;
            PG8_LDB(B0, 1, 0); PG8_LDB(B1, 1, 1); PG8_SCHED; PG8_LDA(At, 1, 0); PG8_STAGE(PG8_SA(0, 1), a2 + hstep, voffA);
            PG8_WAIT_V(8); PG8_WAIT_L(0); PG8_BAR; PG8_MMA(0, 0, At, B0); PG8_MMA(0, 1, At, B1); PG8_BAR; PG8_SCHED;
            PG8_LDA(At, 1, 1); PG8_STAGE(PG8_SB(1, 0), b3, voffB); PG8_STAGE(PG8_SB(1, 1), b3 + hstep, voffB); PG8_STAGE(PG8_SA(1, 0), a3, voffA);
            PG8_WAIT_V(8); PG8_WAIT_L(0); PG8_BAR; PG8_MMA(1, 0, At, B0); PG8_MMA(1, 1, At, B1); PG8_BAR; PG8_SCHED;
            } else {
            PG8_LDB(B0, 0, 0); PG8_SCHED; PG8_LDA(At, 0, 0); PG8_STAGE(PG8_SA(1, 1), a1 + hstep, voffA);
            PG8_WAIT_L(8); PG8_BAR; PG8_WAIT_L(0); PG8_MMA(0, 0, At, B0); PG8_BAR; PG8_SCHED;
            PG8_LDB(B1, 0, 1); PG8_STAGE(PG8_SB(0, 0), b2, voffB);
            PG8_BAR; PG8_WAIT_L(0); PG8_MMA(0, 1, At, B1); PG8_BAR;
            PG8_LDA(At, 0, 1); PG8_STAGE(PG8_SA(0, 0), a2, voffA);
            PG8_BAR; PG8_WAIT_L(0); PG8_MMA(1, 0, At, B0); PG8_BAR; PG8_SCHED;
            PG8_STAGE(PG8_SB(0, 1), b2 + hstep, voffB);
            PG8_WAIT_V(6); PG8_BAR; PG8_MMA(1, 1, At, B1); PG8_BAR;
            PG8_LDB(B0, 1, 0); PG8_SCHED; PG8_LDA(At, 1, 0); PG8_STAGE(PG8_SA(0, 1), a2 + hstep, voffA);
            PG8_WAIT_L(8); PG8_BAR; PG8_WAIT_L(0); PG8_MMA(0, 0, At, B0); PG8_BAR; PG8_SCHED;
            PG8_LDB(B1, 1, 1); PG8_STAGE(PG8_SB(1, 0), b3, voffB);
            PG8_BAR; PG8_WAIT_L(0); PG8_MMA(0, 1, At, B1); PG8_BAR;
            PG8_LDA(At, 1, 1); PG8_STAGE(PG8_SA(1, 0), a3, voffA);
            PG8_BAR; PG8_WAIT_L(0); PG8_MMA(1, 0, At, B0); PG8_BAR; PG8_SCHED;
            PG8_STAGE(PG8_SB(1, 1), b3 + hstep, voffB);
            PG8_WAIT_V(6); PG8_BAR; PG8_MMA(1, 1, At, B1); PG8_BAR;
            }
        }
        if constexpr (ALIGN_EPI) { if (wr == 0) PG8_BAR; }
        if constexpr (!Epi::AFTER_DRAIN) { E(acc, cur, wr, wc, fr, fq); S.done(cur); }
        if (!has_next) break;
#pragma unroll
        for (int a = 0; a < 2; ++a)
#pragma unroll
            for (int b = 0; b < 2; ++b)
#pragma unroll
                for (int m = 0; m < 4; ++m)
#pragma unroll
                    for (int n = 0; n < 2; ++n) acc[a][b][m][n] = (f32x4){0.f, 0.f, 0.f, 0.f};
        cur = nxt; cA = nA; cB = nB; ++ui;
        if constexpr (ALIGN_EPI) { if (wr == 1) PG8_BAR; }
    }
    PG8_WAIT_V(0);
    if constexpr (!ALIGN_EPI) { if (wr == 0) PG8_BAR; }
    PG8_BAR;
    if constexpr (Epi::AFTER_DRAIN) { E.fused(acc, cur, wr, wc, fr, fq, lds, wid, lane); S.done(cur); }
#undef PG8_SA
#undef PG8_SB
#undef PG8_STAGE
#undef PG8_LDA
#undef PG8_LDB
#undef PG8_MMA
#undef PG8_WAIT_V
#undef PG8_WAIT_L
#undef PG8_BAR
#undef PG8_SCHED
}
}
#define GAS __attribute__((address_space(1)))
#define LAS __attribute__((address_space(3)))
typedef unsigned short bf16;
typedef unsigned v4u __attribute__((ext_vector_type(4)));
typedef float f32x4 __attribute__((ext_vector_type(4)));
typedef short bf16x8 __attribute__((ext_vector_type(8)));
typedef GAS unsigned gu32;
typedef GAS unsigned long long gu64;
#define RLX_AGENT __ATOMIC_RELAXED, __HIP_MEMORY_SCOPE_AGENT
#define LDS_WAIT() asm volatile("s_waitcnt lgkmcnt(0)" ::: "memory")
#define VM_WAIT() asm volatile("s_waitcnt vmcnt(0)" ::: "memory")
__device__ __forceinline__ unsigned long long rt() { return __builtin_amdgcn_s_memrealtime(); }
__device__ __forceinline__ unsigned f2bf(float f) { unsigned u = __builtin_bit_cast(unsigned, f); return (u + 0x7fffu + ((u >> 16) & 1u)) >> 16; }
__device__ __forceinline__ unsigned pk2(float lo, float hi) { return f2bf(lo) | (f2bf(hi) << 16); }

#define XB_TMO      128
#define XB_XCNT(j)  (256  + 64 * (j))
#define XB_XSUB(j)  (1280 + 64 * (j))
#define XB_XGEN(j)  (2304 + 64 * (j))
#define XB_TOP      3328
#define XB_TOPGEN   3392
#define XCD_BAR_WORDS 3456
#define XB_SPIN_CAP (1u << 18)

__device__ __forceinline__ unsigned xb_ld(unsigned* p)              { return __hip_atomic_load(p, __ATOMIC_RELAXED, __HIP_MEMORY_SCOPE_AGENT); }
__device__ __forceinline__ unsigned xb_add(unsigned* p, unsigned v) { return __hip_atomic_fetch_add(p, v, __ATOMIC_RELAXED, __HIP_MEMORY_SCOPE_AGENT); }
__device__ __forceinline__ unsigned xb_xcc_id() { return (unsigned)__builtin_amdgcn_s_getreg((3 << 11) | 20) & 0xFu; }
#define XB_SPIN(cond, bar) do { unsigned _sp = 0; while (cond) { __builtin_amdgcn_s_sleep(1); \
    if ((++_sp & 255u) == 0u) { if (xb_ld(&(bar)[XB_TMO])) break; if (_sp > XB_SPIN_CAP) { atomicAdd(&(bar)[XB_TMO], 1u); break; } } } } while (0)

struct XcdBarrier {
    unsigned* bar; unsigned x;
    volatile LAS unsigned* st;
};

__device__ __forceinline__ XcdBarrier xcd_barrier_post(unsigned* bar, volatile LAS unsigned* st) {
    XcdBarrier b; b.bar = bar; b.x = xb_xcc_id(); b.st = st;
    if (threadIdx.x == 0) (void)xb_add(&bar[XB_XCNT(b.x)], 1u);
    return b;
}
__device__ __forceinline__ void xcd_barrier_complete(unsigned* bar, unsigned x, unsigned& nloc, unsigned& nx) {
    const unsigned G = gridDim.x * gridDim.y * gridDim.z;
    unsigned sum, cnt, mine, sp = 0u;
    for (;;) {
        sum = 0u; cnt = 0u; mine = 0u;
#pragma unroll
        for (unsigned j = 0; j < 16; ++j) { const unsigned c = xb_ld(&bar[XB_XCNT(j)]); sum += c; cnt += (c > 0u) ? 1u : 0u; mine = (j == x) ? c : mine; }
        if (sum == G) break;
        __builtin_amdgcn_s_sleep(1);
        if ((++sp & 255u) == 0u) { if (xb_ld(&bar[XB_TMO])) break; if (sp > XB_SPIN_CAP) { atomicAdd(&bar[XB_TMO], 1u); break; } }
    }
    nloc = mine > 0u ? mine : 1u; nx = cnt > 0u ? cnt : 1u;
}

__device__ __forceinline__ void xcd_barrier(const XcdBarrier& b) {
    asm volatile("s_waitcnt vmcnt(0)" ::: "memory");
    __syncthreads();
    if (threadIdx.x == 0) {
        unsigned* bar = b.bar;
        __builtin_amdgcn_s_waitcnt(0);
        unsigned nloc = b.st[0], nx = b.st[1];
        if (nloc == 0u) { xcd_barrier_complete(bar, b.x, nloc, nx); b.st[0] = nloc; b.st[1] = nx; }
        const unsigned old = xb_add(&bar[XB_XSUB(b.x)], 1u);
        const unsigned gen = old / nloc;
        if (old + 1u == (gen + 1u) * nloc) {
            __builtin_amdgcn_fence(__ATOMIC_RELEASE, "agent");
            asm volatile("s_waitcnt vmcnt(0)" ::: "memory");
            const unsigned og = xb_add(&bar[XB_TOP], 1u);
            const unsigned tg = og / nx;
            if (og + 1u == (tg + 1u) * nx) xb_add(&bar[XB_TOPGEN], 1u);
            else XB_SPIN(xb_ld(&bar[XB_TOPGEN]) == tg, bar);
            __builtin_amdgcn_fence(__ATOMIC_ACQUIRE, "agent");
            xb_add(&bar[XB_XGEN(b.x)], 1u);
            asm volatile("s_waitcnt vmcnt(0)" ::: "memory");
        } else {
            XB_SPIN(xb_ld(&bar[XB_XGEN(b.x)]) == gen, bar);
            __builtin_amdgcn_fence(__ATOMIC_ACQUIRE, "agent");
            asm volatile("s_waitcnt vmcnt(0)" ::: "memory");
        }
    }
    __syncthreads();
}

constexpr int NWAVES = 8, NTHREADS = NWAVES * 64;
constexpr int BATCH = 8, SEQ = 2048, T = BATCH * SEQ, D = 2048;
constexpr int EV_N = 7200, EV_NP = 7424, OD_N = 7616, OD_NP = 7680, PROJ_LD = 7680;
constexpr float EPS = 1e-6f;
constexpr int EC_GQ = 0, EC_GK = 512, EC_GV = 1024, EC_GZ = 2048, EC_GLR = 3072, EC_BQ = 3088, EC_BK = 4112, EC_BV = 5136, EC_BZ = 6160, EC_BA = 7184, EC_BB = 7192;
constexpr int OC_HQ = 0, OC_HF = 1024, OC_HI = 2048, OC_HG = 3072, OC_RW = 4096;
constexpr int RW_R = 0, RW_K = 1024, RW_V = 2048, RW_WL = 3072, RW_AL = 3168, RW_GL = 3264;
constexpr int LORA_K = 512, LORA_N = 3072;
enum { I_X = 0, I_P, I_EV_WIN, I_GK_W2, I_GK_B, I_GLA_NORM, I_GDN_CONV, I_GDN_ALOG, I_GDN_DTB, I_GDN_NORM, I_EV_WOUT, I_OD_WIN, I_LB, I_HG_NORM,
       I_MU, I_W0, I_W2, I_A0, I_A2, I_G2, I_KK, I_KA, I_RK, I_LNW, I_LNB, I_OD_WOUT, I_NMIX, I_NFFN, I_NPLE, I_PEER_WQ, I_PEER_SK, I_PEER_U, I_PEER_V,
       I_PLE_WP, I_PLE_WG, I_NFINAL, N_IN };

constexpr size_t MiB = 1u << 20;
constexpr size_t WS_CTL = 0, CTL_ZERO_BYTES = 1 * MiB;
constexpr size_t WS_WEV_IN = 1 * MiB, WS_WEV_OUT = 30 * MiB, WS_WOD_IN = 38 * MiB, WS_WOD_OUT = 68 * MiB, WS_WPEER = 76 * MiB, WS_WGATE = 92 * MiB, WS_WPROJ = 108 * MiB,
                 WS_WLORA = 110 * MiB, WS_PBF = 113 * MiB, WS_TABU = 129 * MiB, WS_TABV = 193 * MiB, WS_ACTA = 257 * MiB, WS_ACTB = 321 * MiB, WS_PROJ = 385 * MiB, WS_SC = 385 * MiB,
                 WS_O = 625 * MiB, WS_H1 = 689 * MiB, WS_PP = 753 * MiB, WS_LA = 817 * MiB, WS_LO = 833 * MiB, WS_RSP = 929 * MiB, WS_STATE = 937 * MiB, WS_RS3 = 945 * MiB, WS_END = 946 * MiB;
static_assert(WS_WEV_IN + (size_t)EV_NP * D * 2 <= WS_WEV_OUT && WS_WOD_IN + (size_t)OD_NP * D * 2 <= WS_WOD_OUT && WS_PROJ + (size_t)T * PROJ_LD * 2 <= WS_O, "ws map");
constexpr int CW_BAR = 4096;
enum { RS_FFN0 = 0, RS_MIX1 = 1, RS_FFN1 = 2, RS_FINAL = 3 };
constexpr int RING_OFF = 0, RING_BYTES = 131072;
constexpr int LDSCTL_OFF = RING_BYTES, MISC_OFF = LDSCTL_OFF + 320;
constexpr int LDS_BYTES = 147456;

struct Args { const float* in[N_IN]; float* out; unsigned char* ws; int ph_lo, ph_hi; };
struct Frame {
    LAS unsigned char* lds; volatile LAS unsigned* MISC; gu32* ctl;
    int tid, lane, wave, vcu, G;
};
__device__ __forceinline__ float wave_sum(float v) {
#pragma unroll
    for (int o = 1; o < 64; o <<= 1) v += __shfl_xor(v, o);
    return v;
}
__device__ __forceinline__ float half_sum32(float v) {
#pragma unroll
    for (int o = 1; o < 32; o <<= 1) v += __shfl_xor(v, o);
    return v;
}
#define DPP_ADD(v, ctrl) (v) += __builtin_bit_cast(float, __builtin_amdgcn_update_dpp(0, __builtin_bit_cast(int, (v)), (ctrl), 0xF, 0xF, false))
__device__ __forceinline__ float row_sum16(float v) {
    DPP_ADD(v, 0x128); DPP_ADD(v, 0x124); DPP_ADD(v, 0x122); DPP_ADD(v, 0x121);
    return v;
}
__device__ __forceinline__ void row_sum16_x4(float& a, float& b, float& c, float& d) {
    asm("s_nop 1\n\t"
        "v_add_f32_dpp %0, %0, %0 row_ror:8 row_mask:0xf bank_mask:0xf\n\tv_add_f32_dpp %1, %1, %1 row_ror:8 row_mask:0xf bank_mask:0xf\n\t"
        "v_add_f32_dpp %2, %2, %2 row_ror:8 row_mask:0xf bank_mask:0xf\n\tv_add_f32_dpp %3, %3, %3 row_ror:8 row_mask:0xf bank_mask:0xf\n\t"
        "v_add_f32_dpp %0, %0, %0 row_ror:4 row_mask:0xf bank_mask:0xf\n\tv_add_f32_dpp %1, %1, %1 row_ror:4 row_mask:0xf bank_mask:0xf\n\t"
        "v_add_f32_dpp %2, %2, %2 row_ror:4 row_mask:0xf bank_mask:0xf\n\tv_add_f32_dpp %3, %3, %3 row_ror:4 row_mask:0xf bank_mask:0xf\n\t"
        "v_add_f32_dpp %0, %0, %0 row_ror:2 row_mask:0xf bank_mask:0xf\n\tv_add_f32_dpp %1, %1, %1 row_ror:2 row_mask:0xf bank_mask:0xf\n\t"
        "v_add_f32_dpp %2, %2, %2 row_ror:2 row_mask:0xf bank_mask:0xf\n\tv_add_f32_dpp %3, %3, %3 row_ror:2 row_mask:0xf bank_mask:0xf\n\t"
        "v_add_f32_dpp %0, %0, %0 row_ror:1 row_mask:0xf bank_mask:0xf\n\tv_add_f32_dpp %1, %1, %1 row_ror:1 row_mask:0xf bank_mask:0xf\n\t"
        "v_add_f32_dpp %2, %2, %2 row_ror:1 row_mask:0xf bank_mask:0xf\n\tv_add_f32_dpp %3, %3, %3 row_ror:1 row_mask:0xf bank_mask:0xf\n\t"
        "s_nop 1"
        : "+v"(a), "+v"(b), "+v"(c), "+v"(d));
}
__device__ __forceinline__ void row_sum16_x2(float& a, float& b) {
    asm("s_nop 1\n\t"
        "v_add_f32_dpp %0, %0, %0 row_ror:8 row_mask:0xf bank_mask:0xf\n\tv_add_f32_dpp %1, %1, %1 row_ror:8 row_mask:0xf bank_mask:0xf\n\ts_nop 1\n\t"
        "v_add_f32_dpp %0, %0, %0 row_ror:4 row_mask:0xf bank_mask:0xf\n\tv_add_f32_dpp %1, %1, %1 row_ror:4 row_mask:0xf bank_mask:0xf\n\ts_nop 1\n\t"
        "v_add_f32_dpp %0, %0, %0 row_ror:2 row_mask:0xf bank_mask:0xf\n\tv_add_f32_dpp %1, %1, %1 row_ror:2 row_mask:0xf bank_mask:0xf\n\ts_nop 1\n\t"
        "v_add_f32_dpp %0, %0, %0 row_ror:1 row_mask:0xf bank_mask:0xf\n\tv_add_f32_dpp %1, %1, %1 row_ror:1 row_mask:0xf bank_mask:0xf\n\t"
        "s_nop 1"
        : "+v"(a), "+v"(b));
}
#define LBAR() do { asm volatile("s_waitcnt lgkmcnt(0)" ::: "memory"); __builtin_amdgcn_s_barrier(); asm volatile("" ::: "memory"); } while (0)
typedef float f32x2 __attribute__((ext_vector_type(2)));
typedef __bf16 hwbf16x2_t __attribute__((ext_vector_type(2)));
__device__ __forceinline__ unsigned hw_pk2(float lo, float hi) { const f32x2 v = {lo, hi}; return __builtin_bit_cast(unsigned, __builtin_convertvector(v, hwbf16x2_t)); }
__device__ __forceinline__ bf16 hw_bf(float x) { return (bf16)hw_pk2(x, 0.f); }
__device__ __forceinline__ float bf_lo(unsigned w) { return __uint_as_float(w << 16); }
__device__ __forceinline__ float bf_hi(unsigned w) { return __uint_as_float(w & 0xffff0000u); }
__device__ __forceinline__ float sigmoidf_(float x) { return __builtin_amdgcn_rcpf(1.0f + __expf(-x)); }
__device__ __forceinline__ float siluf_(float x) { return x * __builtin_amdgcn_rcpf(1.0f + __expf(-x)); }
__device__ __forceinline__ float softplusf_(float x) { return fmaxf(x, 0.f) + log1pf(__expf(-fabsf(x))); }
__device__ __forceinline__ float logsigmoidf_(float x) { return fminf(x, 0.f) - log1pf(__expf(-fabsf(x))); }

struct EpiBf16S {
    static constexpr bool PERM = true, AFTER_DRAIN = false;
    bf16* O; int ldc; const float* rowss;
    __device__ __forceinline__ void operator()(const pg8::f32x4 (&acc)[2][2][4][2], const pg8::Unit& u, int wr, int wc, int fr, int fq) const {
        const int row0 = u.pm * 256 + wr * 64 + fr, col0 = u.pn * 256 + wc * 32 + 8 * fq;
#pragma unroll
        for (int ai = 0; ai < 2; ++ai)
#pragma unroll
            for (int m = 0; m < 4; ++m) {
                const int row = row0 + ai * 128 + m * 16;
                float sc = 1.f;
                if (rowss) { const pg8::f32x4* rp = (const pg8::f32x4*)(rowss + (size_t)row * 32 + 8 * fq); const pg8::f32x4 p0 = rp[0], p1 = rp[1];
                    float s = ((p0[0] + p0[1]) + (p0[2] + p0[3])) + ((p1[0] + p1[1]) + (p1[2] + p1[3])); s += __shfl_xor(s, 16); s += __shfl_xor(s, 32);
                    sc = __builtin_amdgcn_rsqf(s * (1.0f / D) + EPS); }
                bf16* rowp = O + (size_t)row * ldc + col0;
#pragma unroll
                for (int bj = 0; bj < 2; ++bj) { const pg8::f32x4 v0 = acc[ai][bj][m][0] * sc, v1 = acc[ai][bj][m][1] * sc;
                    pg8::u32x4 w; w.x = pg8::cvt_pk_bf16(v0[0], v0[1]); w.y = pg8::cvt_pk_bf16(v0[2], v0[3]); w.z = pg8::cvt_pk_bf16(v1[0], v1[1]); w.w = pg8::cvt_pk_bf16(v1[2], v1[3]);
                    *(pg8::u32x4*)(rowp + bj * 128) = w; } }
    }
};
template <bool GATE, bool HIN_F32> struct EpiResid {
    static constexpr bool PERM = false, AFTER_DRAIN = false;
    const void* hin; bf16* hout; float* rowss; const bf16* pp; const float* rs3;
    __device__ __forceinline__ void operator()(const pg8::f32x4 (&acc)[2][2][4][2], const pg8::Unit& u, int wr, int wc, int fr, int fq) const {
        const int row0 = u.pm * 256 + wr * 64 + fr, col0 = u.pn * 256 + wc * 32 + 4 * fq;
        constexpr int MG = HIN_F32 ? 2 : 4;
#pragma unroll
        for (int ai = 0; ai < 2; ++ai)
#pragma unroll
            for (int m0 = 0; m0 < 4; m0 += MG) {
                pg8::f32x4 hf[MG][2][2]; pg8::u32x2 hb[MG][2][2], pw[MG][2][2]; float rsc[MG];
#pragma unroll
                for (int mm = 0; mm < MG; ++mm) { const int row = row0 + ai * 128 + (m0 + mm) * 16; const size_t off = (size_t)row * D + col0; rsc[mm] = GATE ? rs3[row] : 1.f;
#pragma unroll
                    for (int bj = 0; bj < 2; ++bj)
#pragma unroll
                        for (int n = 0; n < 2; ++n) { const size_t o = off + bj * 128 + n * 16;
                            if (HIN_F32) hf[mm][bj][n] = *(const pg8::f32x4*)((const float*)hin + o); else hb[mm][bj][n] = *(const pg8::u32x2*)((const bf16*)hin + o);
                            if (GATE) pw[mm][bj][n] = *(const pg8::u32x2*)(pp + o); } }
#pragma unroll
                for (int mm = 0; mm < MG; ++mm) { const int m = m0 + mm; const int row = row0 + ai * 128 + m * 16; const size_t off = (size_t)row * D + col0; float ss = 0.f;
#pragma unroll
                    for (int bj = 0; bj < 2; ++bj)
#pragma unroll
                        for (int n = 0; n < 2; ++n) { const size_t o = off + bj * 128 + n * 16;
                            pg8::f32x4 hv;
                            if (HIN_F32) hv = hf[mm][bj][n];
                            else { const pg8::u32x2 hw = hb[mm][bj][n]; hv[0] = bf_lo(hw.x); hv[1] = bf_hi(hw.x); hv[2] = bf_lo(hw.y); hv[3] = bf_hi(hw.y); }
                            pg8::f32x4 a = acc[ai][bj][m][n];
                            if (GATE) { const pg8::u32x2 p2 = pw[mm][bj][n]; const float rs_ = rsc[mm];
                                a[0] = sigmoidf_(a[0] * rs_) * bf_lo(p2.x); a[1] = sigmoidf_(a[1] * rs_) * bf_hi(p2.x); a[2] = sigmoidf_(a[2] * rs_) * bf_lo(p2.y); a[3] = sigmoidf_(a[3] * rs_) * bf_hi(p2.y); }
                            hv = hv + a;
                            pg8::u32x2 w; w.x = hw_pk2(hv[0], hv[1]); w.y = hw_pk2(hv[2], hv[3]); *(pg8::u32x2*)(hout + o) = w;
                            const float q0 = bf_lo(w.x), q1 = bf_hi(w.x), q2 = bf_lo(w.y), q3 = bf_hi(w.y);
                            ss += (q0 * q0 + q1 * q1) + (q2 * q2 + q3 * q3); }
                    ss += __shfl_xor(ss, 16); ss += __shfl_xor(ss, 32);
                    if (fq == 0) rowss[(size_t)row * 32 + u.pn * 4 + wc] = ss; }
                asm volatile("" ::: "memory"); }
    }
};


__device__ __forceinline__ void p0_transpose_item(const float* W, int K, int N, bf16* WT, LAS float* scr, int item, int lane, const float* kgain = nullptr) {
    const int nblk = N / 32, kb = item / nblk, nb = item % nblk, k0 = 64 * kb, n0 = 32 * nb;
    { const GAS float* Wg = (const GAS float*)W + (size_t)(k0 + (lane >> 5)) * N + n0 + (lane & 31); float v[32];
#pragma unroll
      for (int i = 0; i < 32; ++i) v[i] = Wg[(size_t)(2 * i) * N];
#pragma unroll
      for (int i = 0; i < 32; ++i) scr[(2 * i + (lane >> 5)) * 33 + (lane & 31)] = v[i]; }
    LDS_WAIT(); asm volatile("" ::: "memory");
    const int c = lane & 7;
#pragma unroll
    for (int j = 0; j < 4; ++j) { const int n = (lane >> 3) + 8 * j; const LAS float* s = scr + (8 * c) * 33 + n;
        f32x4 g0 = {1.f, 1.f, 1.f, 1.f}, g1 = g0; if (kgain) { g0 = *(const GAS f32x4*)(kgain + k0 + 8 * c); g1 = *(const GAS f32x4*)(kgain + k0 + 8 * c + 4); }
        v4u o; o.x = pk2(s[0 * 33] * g0[0], s[1 * 33] * g0[1]); o.y = pk2(s[2 * 33] * g0[2], s[3 * 33] * g0[3]); o.z = pk2(s[4 * 33] * g1[0], s[5 * 33] * g1[1]); o.w = pk2(s[6 * 33] * g1[2], s[7 * 33] * g1[3]);
        *(GAS v4u*)(WT + (size_t)(n0 + n) * K + k0 + 8 * c) = o; }
    LDS_WAIT(); asm volatile("" ::: "memory");
}
__device__ __forceinline__ void cvt_f32_bf16(const float* src, bf16* dst, size_t n, int gtid, int gthreads) {
    const size_t n8 = n / 8;
    for (size_t i = gtid; i < n8; i += gthreads) {
        const f32x4 a = *(const GAS f32x4*)(src + i * 8), b = *(const GAS f32x4*)(src + i * 8 + 4);
        v4u o; o.x = pk2(a[0], a[1]); o.y = pk2(a[2], a[3]); o.z = pk2(b[0], b[1]); o.w = pk2(b[2], b[3]);
        *(GAS v4u*)(dst + i * 8) = o; }
}
__device__ __forceinline__ void cvt_f32_fp8(const float* src, unsigned char* dst, size_t n, float scale, int gtid, int gthreads, const float* cgain = nullptr) {
    const size_t n16 = n / 16;
    for (size_t i = gtid; i < n16; i += gthreads) { v4u o; unsigned w[4];
#pragma unroll
        for (int q = 0; q < 4; ++q) { f32x4 a = *(const GAS f32x4*)(src + i * 16 + 4 * q) * scale; if (cgain) a = a * *(const GAS f32x4*)(cgain + ((i * 16 + 4 * q) & (D - 1)));
            int x = __builtin_amdgcn_cvt_pk_fp8_f32(a[0], a[1], 0, false); x = __builtin_amdgcn_cvt_pk_fp8_f32(a[2], a[3], x, true); w[q] = (unsigned)x; }
        o.x = w[0]; o.y = w[1]; o.z = w[2]; o.w = w[3];
        *(GAS v4u*)(dst + i * 16) = o; }
}
__device__ __forceinline__ void rms_row_to_bf16(const float* xrow, const float* g, bf16* orow, int lane) {
    const GAS f32x4* xr = (const GAS f32x4*)xrow + lane; f32x4 v[8]; float s = 0.f;
#pragma unroll
    for (int j = 0; j < 8; ++j) { v[j] = xr[64 * j]; s += (v[j][0] * v[j][0] + v[j][1] * v[j][1]) + (v[j][2] * v[j][2] + v[j][3] * v[j][3]); }
    const float r = __builtin_amdgcn_rsqf(wave_sum(s) * (1.0f / D) + EPS);
    const GAS f32x4* gr = (const GAS f32x4*)g + lane;
    GAS unsigned long long* o8 = (GAS unsigned long long*)orow + lane;
#pragma unroll
    for (int j = 0; j < 8; ++j) { const f32x4 gg = gr[64 * j]; o8[64 * j] = (unsigned long long)pk2(v[j][0] * r * gg[0], v[j][1] * r * gg[1]) | ((unsigned long long)pk2(v[j][2] * r * gg[2], v[j][3] * r * gg[3]) << 32); }
}
__device__ __forceinline__ void p0_fold_item(const float* wq, const float* sk, bf16* WP, LAS float* lds, int item, int tid, const float* kgain) {
    const int hp = item >> 5, k0 = (item & 31) * 64;
    LAS float* skT = lds;
    LAS float* wqT = lds + 128 * 132;
    const float* skb = sk + (size_t)hp * 128 * 128;
#pragma unroll 4
    for (int i = 0; i < 32; ++i) { const int idx = i * 512 + tid, n = idx >> 7, d = idx & 127; skT[d * 132 + n] = skb[idx]; }
#pragma unroll 4
    for (int i = 0; i < 16; ++i) { const int idx = i * 512 + tid, kk = idx >> 7, d = idx & 127; wqT[d * 68 + kk] = wq[(size_t)(k0 + kk) * D + hp * 128 + d] * kgain[k0 + kk]; }
    __syncthreads();
    const int n0 = (tid >> 4) * 4, kk0 = (tid & 15) * 4;
    float acc[4][4];
#pragma unroll
    for (int i = 0; i < 4; ++i)
#pragma unroll
        for (int j = 0; j < 4; ++j) acc[i][j] = 0.f;
#pragma unroll 4
    for (int d = 0; d < 128; ++d) { const f32x4 a = *(const LAS f32x4*)(skT + d * 132 + n0), b = *(const LAS f32x4*)(wqT + d * 68 + kk0);
#pragma unroll
        for (int i = 0; i < 4; ++i)
#pragma unroll
            for (int j = 0; j < 4; ++j) acc[i][j] += a[i] * b[j]; }
#pragma unroll
    for (int i = 0; i < 4; ++i) { unsigned long long o = (unsigned long long)pk2(acc[i][0], acc[i][1]) | ((unsigned long long)pk2(acc[i][2], acc[i][3]) << 32);
        *(GAS unsigned long long*)(WP + (size_t)(hp * 128 + n0 + i) * D + k0 + kk0) = o; }
    __syncthreads();
}
__device__ __forceinline__ void p0_prologue(const Args& A, Frame& F) {
    const int gw = F.vcu * NWAVES + F.wave, NGW = F.G * NWAVES;
    const int gtid = gw * 64 + F.lane, gthreads = F.G * NTHREADS;
    unsigned char* ws = A.ws;
    LAS float* scr = (LAS float*)(F.lds + RING_OFF + F.wave * 16384);
    constexpr int I_EVIN = (D / 64) * (EV_N / 32);
    for (int it = gw; it < I_EVIN; it += NGW) p0_transpose_item(A.in[I_EV_WIN], D, EV_N, (bf16*)(ws + WS_WEV_IN), scr, it, F.lane);
    { GAS v4u* z0 = (GAS v4u*)(ws + WS_WEV_IN + (size_t)EV_N * D * 2); const size_t n0 = (size_t)(EV_NP - EV_N) * D * 2 / 16;
      for (size_t i = gtid; i < n0; i += gthreads) z0[i] = (v4u){0u, 0u, 0u, 0u}; }
    for (int m = gw; m < T; m += NGW) rms_row_to_bf16(A.in[I_X] + (size_t)m * D, A.in[I_NMIX], (bf16*)(ws + WS_ACTA) + (size_t)m * D, F.lane);
}
__device__ __forceinline__ void p0_deferred(const Args& A, Frame& F, int wg, int nwg) {
    const int gw = wg * NWAVES + F.wave, NGW = nwg * NWAVES;
    int gtid = gw * 64 + F.lane; const int gthreads = nwg * NTHREADS;
    asm volatile("" : "+v"(gtid));
    unsigned char* ws = A.ws;
    {
        LAS float* scr = (LAS float*)(F.lds + RING_OFF + F.wave * 16384);
        constexpr int I_SQ = (D / 64) * (D / 32), I_ODIN = (D / 64) * (OD_N / 32), I_PJ = (256 / 64) * (D / 32);
        constexpr int NITEMS = I_SQ + I_ODIN + I_SQ + 2 * I_PJ;
        for (int it = gw; it < NITEMS; it += NGW) {
            int r = it;
            if (r < I_SQ) { p0_transpose_item(A.in[I_EV_WOUT], D, D, (bf16*)(ws + WS_WEV_OUT), scr, r, F.lane); continue; } r -= I_SQ;
            if (r < I_ODIN) { p0_transpose_item(A.in[I_OD_WIN], D, OD_N, (bf16*)(ws + WS_WOD_IN), scr, r, F.lane, A.in[I_NMIX] + D); continue; } r -= I_ODIN;
            if (r < I_SQ) { p0_transpose_item(A.in[I_PLE_WG], D, D, (bf16*)(ws + WS_WGATE), scr, r, F.lane, A.in[I_NPLE]); continue; } r -= I_SQ;
            { const int L = r / I_PJ; p0_transpose_item(A.in[I_PLE_WP] + (size_t)L * 256 * D, 256, D, (bf16*)(ws + WS_WPROJ) + (size_t)L * D * 256, scr, r % I_PJ, F.lane); }
        }
        { GAS v4u* z1 = (GAS v4u*)(ws + WS_WOD_IN + (size_t)OD_N * D * 2); const size_t n1 = (size_t)(OD_NP - OD_N) * D * 2 / 16;
          for (size_t i = gtid; i < n1; i += gthreads) z1[i] = (v4u){0u, 0u, 0u, 0u}; }
    }
    __syncthreads();
    for (int it = wg; it < 512; it += nwg)
        p0_fold_item(A.in[I_PEER_WQ], A.in[I_PEER_SK], (bf16*)(ws + WS_WPEER), (LAS float*)(F.lds + RING_OFF), it, F.tid, A.in[I_NFFN]);
    cvt_f32_fp8(A.in[I_PEER_U], (unsigned char*)(ws + WS_TABU), (size_t)16384 * D, 512.0f, gtid, gthreads, A.in[I_NFFN]);
    cvt_f32_fp8(A.in[I_PEER_V], (unsigned char*)(ws + WS_TABV), (size_t)16384 * D, 16.0f, gtid, gthreads);
    cvt_f32_bf16(A.in[I_P], (bf16*)(ws + WS_PBF), (size_t)2 * T * 256, gtid, gthreads);
    { bf16* LB = (bf16*)(ws + WS_WLORA); const float* w2 = A.in[I_W2]; const float* a2 = A.in[I_A2]; const float* g2 = A.in[I_G2];
      for (int i = gtid; i < LORA_N * LORA_K / 2; i += gthreads) { const int row = i / (LORA_K / 2), col = (i % (LORA_K / 2)) * 2; float v[2];
#pragma unroll
          for (int e = 0; e < 2; ++e) { const int c = col + e; float x = 0.f;
              if (row < 1024) { if (c < 96) x = w2[c * 1024 + row]; }
              else if (row < 2048) { if (c >= 96 && c < 192) x = a2[(c - 96) * 1024 + (row - 1024)]; }
              else { if (c >= 192 && c < 448) x = g2[(c - 192) * 1024 + (row - 2048)]; }
              v[e] = x; }
          *(GAS unsigned*)(LB + (size_t)row * LORA_K + col) = pk2(v[0], v[1]); } }
}
__device__ __forceinline__ void p1_deferred(const Args& A, Frame& F, int wg, int nwg) {
    const int gw = wg * NWAVES + F.wave, NGW = nwg * NWAVES;
    int gtid = gw * 64 + F.lane; const int gthreads = nwg * NTHREADS;
    asm volatile("" : "+v"(gtid));
    unsigned char* ws = A.ws;
    { LAS float* scr = (LAS float*)(F.lds + RING_OFF + F.wave * 16384); constexpr int I_SQ = (D / 64) * (D / 32);
      for (int it = gw; it < 2 * I_SQ; it += NGW) {
          if (it < I_SQ) p0_transpose_item(A.in[I_OD_WOUT], D, D, (bf16*)(ws + WS_WOD_OUT), scr, it, F.lane);
          else p0_transpose_item(A.in[I_PLE_WG] + (size_t)D * D, D, D, (bf16*)(ws + WS_WGATE) + (size_t)D * D, scr, it - I_SQ, F.lane, A.in[I_NPLE] + D); } }
    __syncthreads();
    for (int it = wg; it < 512; it += nwg)
        p0_fold_item(A.in[I_PEER_WQ] + (size_t)D * D, A.in[I_PEER_SK] + (size_t)16 * 128 * 128, (bf16*)(ws + WS_WPEER) + (size_t)D * D, (LAS float*)(F.lds + RING_OFF), it, F.tid, A.in[I_NFFN] + D);
    cvt_f32_fp8(A.in[I_PEER_U] + (size_t)16384 * D, (unsigned char*)(ws + WS_TABU) + (size_t)16384 * D, (size_t)16384 * D, 512.0f, gtid, gthreads, A.in[I_NFFN] + D);
    cvt_f32_fp8(A.in[I_PEER_V] + (size_t)16384 * D, (unsigned char*)(ws + WS_TABV) + (size_t)16384 * D, (size_t)16384 * D, 16.0f, gtid, gthreads);
}

constexpr int TC = 16, NCHUNK = SEQ / TC;
typedef unsigned u32x2 __attribute__((ext_vector_type(2)));

template <int MODE>
__device__ __forceinline__ void scan_gla_unit(const Args& A, Frame& F, int unit) {
    int tid = F.tid; asm volatile("" : "+v"(tid));
    const int lane = tid & 63, w = F.wave;
    int b, h, qcol, kcol, vcol, ocol;
    if (MODE == 0) { b = unit >> 4; h = (unit >> 2) & 3; const int s = unit & 3; qcol = EC_GQ + h * 128; kcol = EC_GK + h * 128; vcol = EC_GV + h * 256 + s * 64; ocol = h * 256 + s * 64; }
    else           { b = unit >> 4; h = (unit >> 1) & 7; const int s = unit & 1; qcol = OC_HQ + h * 128; kcol = OC_HF + h * 128; vcol = OC_HI + h * 128 + s * 64; ocol = h * 128 + s * 64; }
    const bf16* P = (const bf16*)(A.ws + WS_PROJ) + (size_t)b * SEQ * PROJ_LD;
    float* O = (float*)(A.ws + WS_O) + (size_t)b * SEQ * D + ocol;
    LAS float* Lf = (LAS float*)(F.lds + RING_OFF);
    constexpr int BUFSZ = 7168, O_EG = 0, O_K = 2048, O_Q = 4096, O_V = 6144, O_OUT = 2 * BUFSZ, O_W2 = O_OUT + 1024, O_BIAS = O_W2 + 2048;
    const int tl = tid >> 5, dq = (tid & 31) * 4, tlv = tid >> 4, c4 = (tid & 15) * 4;
    float lb[4] = {0.f, 0.f, 0.f, 0.f};
    if (MODE == 0) {
        const float* w2 = A.in[I_GK_W2]; const float* gb = A.in[I_GK_B];
        for (int i = tid; i < 2048; i += NTHREADS) Lf[O_W2 + i] = w2[(i >> 7) * 512 + h * 128 + (i & 127)];
        if (tid < 128) Lf[O_BIAS + tid] = gb[h * 128 + tid];
    } else {
        const float* lg = A.in[I_LB];
#pragma unroll
        for (int i = 0; i < 4; ++i) lb[i] = sigmoidf_(lg[1024 + h * 128 + dq + i] - lg[h * 128 + dq + i]);
    }
    u32x2 rq, rk, rv = {0u, 0u}; v4u rg0 = {0u, 0u, 0u, 0u}, rg1 = {0u, 0u, 0u, 0u};
#define GLA_LOAD(c) do { const bf16* pr = P + (size_t)((c) * TC + tl) * PROJ_LD; rq = *(const GAS u32x2*)(pr + qcol + dq); rk = *(const GAS u32x2*)(pr + kcol + dq); \
        if (MODE == 0) { rg0 = *(const GAS v4u*)(pr + EC_GLR); rg1 = *(const GAS v4u*)(pr + EC_GLR + 8); } \
        if (tid < 256) rv = *(const GAS u32x2*)(P + (size_t)((c) * TC + tlv) * PROJ_LD + vcol + c4); } while (0)
#define GLA_XFORM(bufi) do { LAS float* B_ = Lf + (bufi) * BUFSZ; f32x4 q4, k4, e4; \
        const float xq[4] = {bf_lo(rq.x), bf_hi(rq.x), bf_lo(rq.y), bf_hi(rq.y)}, xk[4] = {bf_lo(rk.x), bf_hi(rk.x), bf_lo(rk.y), bf_hi(rk.y)}; \
        if (MODE == 0) { f32x4 z = *(const LAS f32x4*)(Lf + O_BIAS + dq); \
            const float gl[16] = {bf_lo(rg0.x), bf_hi(rg0.x), bf_lo(rg0.y), bf_hi(rg0.y), bf_lo(rg0.z), bf_hi(rg0.z), bf_lo(rg0.w), bf_hi(rg0.w), \
                                  bf_lo(rg1.x), bf_hi(rg1.x), bf_lo(rg1.y), bf_hi(rg1.y), bf_lo(rg1.z), bf_hi(rg1.z), bf_lo(rg1.w), bf_hi(rg1.w)}; \
            _Pragma("unroll") for (int r_ = 0; r_ < 16; ++r_) { const f32x4 wv = *(const LAS f32x4*)(Lf + O_W2 + r_ * 128 + dq); z = z + wv * gl[r_]; } \
            _Pragma("unroll") for (int i_ = 0; i_ < 4; ++i_) { q4[i_] = xq[i_] * 0.08838834764831845f; k4[i_] = xk[i_]; e4[i_] = __builtin_amdgcn_exp2f(-0.0625f * __builtin_amdgcn_logf(1.0f + __expf(-z[i_]))); } } \
        else { _Pragma("unroll") for (int i_ = 0; i_ < 4; ++i_) { const float fg = lb[i_] + (1.f - lb[i_]) * sigmoidf_(xk[i_]); q4[i_] = siluf_(xq[i_]); k4[i_] = 1.f - fg; e4[i_] = fg; } } \
        *(LAS f32x4*)(B_ + O_EG + tl * 128 + dq) = e4; *(LAS f32x4*)(B_ + O_K + tl * 128 + dq) = k4; *(LAS f32x4*)(B_ + O_Q + tl * 128 + dq) = q4; \
        if (tid < 256) { f32x4 v4 = {bf_lo(rv.x), bf_hi(rv.x), bf_lo(rv.y), bf_hi(rv.y)}; *(LAS f32x4*)(B_ + O_V + tlv * 64 + c4) = v4; } } while (0)
    LBAR();
    GLA_LOAD(0); GLA_XFORM(0);
    LBAR();
    f32x2 S2[8];
#pragma unroll
    for (int i = 0; i < 8; ++i) S2[i] = (f32x2){0.f, 0.f};
    const int j = lane & 15, col = w * 8 + (lane >> 4) * 2;
    for (int c = 0; c < NCHUNK; ++c) {
        if (c + 1 < NCHUNK) GLA_LOAD(c + 1);
        const LAS float* B_ = Lf + (c & 1) * BUFSZ;
        float os0 = 0.f, os1 = 0.f;
        f32x4 e0, e1, k0, k1, q0, q1, ne0, ne1, nk0, nk1, nq0, nq1; f32x2 v2, nv2;
#define GLA_LDSTEP(t_, E0, E1, K0, K1, Q0, Q1, V2) do { E0 = *(const LAS f32x4*)(B_ + O_EG + (t_) * 128 + 4 * j); E1 = *(const LAS f32x4*)(B_ + O_EG + (t_) * 128 + 64 + 4 * j); \
            K0 = *(const LAS f32x4*)(B_ + O_K + (t_) * 128 + 4 * j); K1 = *(const LAS f32x4*)(B_ + O_K + (t_) * 128 + 64 + 4 * j); \
            Q0 = *(const LAS f32x4*)(B_ + O_Q + (t_) * 128 + 4 * j); Q1 = *(const LAS f32x4*)(B_ + O_Q + (t_) * 128 + 64 + 4 * j); V2 = *(const LAS f32x2*)(B_ + O_V + (t_) * 64 + col); } while (0)
        GLA_LDSTEP(0, e0, e1, k0, k1, q0, q1, v2);
#pragma unroll
        for (int t = 0; t < TC; ++t) {
            if (t + 1 < TC) { GLA_LDSTEP(t + 1, ne0, ne1, nk0, nk1, nq0, nq1, nv2); }
            __builtin_amdgcn_sched_barrier(0);
            f32x2 pa = {0.f, 0.f}, pb = {0.f, 0.f};
#pragma unroll
            for (int i = 0; i < 4; ++i) {
                S2[i] = S2[i] * e0[i] + v2 * k0[i]; S2[4 + i] = S2[4 + i] * e1[i] + v2 * k1[i];
                pa += S2[i] * q0[i]; pb += S2[4 + i] * q1[i]; }
            pa += pb;
            float p0 = pa[0], p1 = pa[1];
            row_sum16_x2(p0, p1);
            os0 = (j == t) ? p0 : os0; os1 = (j == t) ? p1 : os1;
            e0 = ne0; e1 = ne1; k0 = nk0; k1 = nk1; q0 = nq0; q1 = nq1; v2 = nv2;
        }
#undef GLA_LDSTEP
        { f32x2 o2 = {os0, os1}; *(LAS f32x2*)(Lf + O_OUT + j * 64 + col) = o2; }
        if (c + 1 < NCHUNK) GLA_XFORM((c + 1) & 1);
        LBAR();
        if (tid < 256) *(GAS f32x4*)(O + (size_t)(c * TC + tlv) * D + c4) = *(const LAS f32x4*)(Lf + O_OUT + tlv * 64 + c4);
        LBAR();
    }
#undef GLA_LOAD
#undef GLA_XFORM
}

__device__ __forceinline__ void scan_gdn_unit(const Args& A, Frame& F, int unit) {
    int tid = F.tid; asm volatile("" : "+v"(tid));
    const int lane = tid & 63, w = F.wave;
    const int b = unit >> 4, h = (unit >> 1) & 7, s = unit & 1;
    const int qcol = EC_BQ + h * 128, kcol = EC_BK + h * 128, vcol = EC_BV + h * 128 + s * 64, ocol = 1024 + h * 128 + s * 64;
    const bf16* P = (const bf16*)(A.ws + WS_PROJ) + (size_t)b * SEQ * PROJ_LD;
    float* O = (float*)(A.ws + WS_O) + (size_t)b * SEQ * D + ocol;
    LAS float* Lf = (LAS float*)(F.lds + RING_OFF);
    constexpr int BUFSZ = 5184, O_K = 0, O_Q = 2048, O_V = 4096, O_SC = 5120, O_OUT = 2 * BUFSZ, O_CW = O_OUT + 1024;
    const int tl = tid >> 5, dq = (tid & 31) * 4, tlv = tid >> 4, c4 = (tid & 15) * 4;
    { const float* cw = A.in[I_GDN_CONV];
      for (int i = tid; i < 4 * 320; i += NTHREADS) { const int jt = i / 320, x = i % 320;
          const int ch = x < 128 ? (h * 128 + x) : x < 256 ? (1024 + h * 128 + (x - 128)) : (2048 + h * 128 + s * 64 + (x - 256));
          Lf[O_CW + i] = cw[jt * 3072 + ch]; } }
    const float neg_ea = -__expf(A.in[I_GDN_ALOG][h]), dtb = A.in[I_GDN_DTB][h];
    u32x2 rq[4], rk[4], rv[4]; unsigned short rba = 0, rbb = 0;
#pragma unroll
    for (int i = 0; i < 4; ++i) rv[i] = (u32x2){0u, 0u};
#define GDN_LOAD(c) do { const int t_ = (c) * TC + tl; \
        _Pragma("unroll") for (int jt = 0; jt < 4; ++jt) { const int tt = t_ - 3 + jt; \
            if (tt >= 0) { const bf16* pr = P + (size_t)tt * PROJ_LD; rq[jt] = *(const GAS u32x2*)(pr + qcol + dq); rk[jt] = *(const GAS u32x2*)(pr + kcol + dq); } \
            else { rq[jt] = (u32x2){0u, 0u}; rk[jt] = (u32x2){0u, 0u}; } } \
        { const bf16* pr = P + (size_t)t_ * PROJ_LD; rba = pr[EC_BA + h]; rbb = pr[EC_BB + h]; } \
        if (tid < 256) { const int tv = (c) * TC + tlv; \
            _Pragma("unroll") for (int jt = 0; jt < 4; ++jt) { const int tt = tv - 3 + jt; \
                if (tt >= 0) rv[jt] = *(const GAS u32x2*)(P + (size_t)tt * PROJ_LD + vcol + c4); else rv[jt] = (u32x2){0u, 0u}; } } } while (0)
#define GDN_XFORM(bufi) do { LAS float* B_ = Lf + (bufi) * BUFSZ; f32x4 q4 = {0.f, 0.f, 0.f, 0.f}, k4 = {0.f, 0.f, 0.f, 0.f}; \
        _Pragma("unroll") for (int jt = 0; jt < 4; ++jt) { const f32x4 wq = *(const LAS f32x4*)(Lf + O_CW + jt * 320 + dq), wk = *(const LAS f32x4*)(Lf + O_CW + jt * 320 + 128 + dq); \
            q4[0] += wq[0] * bf_lo(rq[jt].x); q4[1] += wq[1] * bf_hi(rq[jt].x); q4[2] += wq[2] * bf_lo(rq[jt].y); q4[3] += wq[3] * bf_hi(rq[jt].y); \
            k4[0] += wk[0] * bf_lo(rk[jt].x); k4[1] += wk[1] * bf_hi(rk[jt].x); k4[2] += wk[2] * bf_lo(rk[jt].y); k4[3] += wk[3] * bf_hi(rk[jt].y); } \
        float sq = 0.f, sk = 0.f, sqk = 0.f; \
        _Pragma("unroll") for (int i_ = 0; i_ < 4; ++i_) { q4[i_] = siluf_(q4[i_]); k4[i_] = siluf_(k4[i_]); sq += q4[i_] * q4[i_]; sk += k4[i_] * k4[i_]; sqk += q4[i_] * k4[i_]; } \
        sq = half_sum32(sq); sk = half_sum32(sk); sqk = half_sum32(sqk); \
        const float rq_ = __builtin_amdgcn_rsqf(sq + EPS) * 0.08838834764831845f, rk_ = __builtin_amdgcn_rsqf(sk + EPS); \
        q4 = q4 * rq_; k4 = k4 * rk_; \
        *(LAS f32x4*)(B_ + O_K + tl * 128 + dq) = k4; *(LAS f32x4*)(B_ + O_Q + tl * 128 + dq) = q4; \
        if ((tid & 31) == 0) { const float ba = __uint_as_float((unsigned)rba << 16), bb = __uint_as_float((unsigned)rbb << 16); \
            f32x4 sc; sc[0] = __expf(neg_ea * softplusf_(ba + dtb)); sc[1] = sigmoidf_(bb); sc[2] = sqk * rq_ * rk_; sc[3] = 0.f; *(LAS f32x4*)(B_ + O_SC + tl * 4) = sc; } \
        if (tid < 256) { f32x4 v4 = {0.f, 0.f, 0.f, 0.f}; \
            _Pragma("unroll") for (int jt = 0; jt < 4; ++jt) { const f32x4 wv = *(const LAS f32x4*)(Lf + O_CW + jt * 320 + 256 + c4); \
                v4[0] += wv[0] * bf_lo(rv[jt].x); v4[1] += wv[1] * bf_hi(rv[jt].x); v4[2] += wv[2] * bf_lo(rv[jt].y); v4[3] += wv[3] * bf_hi(rv[jt].y); } \
            _Pragma("unroll") for (int i_ = 0; i_ < 4; ++i_) v4[i_] = siluf_(v4[i_]); \
            *(LAS f32x4*)(B_ + O_V + tlv * 64 + c4) = v4; } } while (0)
    LBAR();
    GDN_LOAD(0); GDN_XFORM(0);
    LBAR();
    f32x2 S2[8];
#pragma unroll
    for (int i = 0; i < 8; ++i) S2[i] = (f32x2){0.f, 0.f};
    const int j = lane & 15, col = w * 8 + (lane >> 4) * 2;
    for (int c = 0; c < NCHUNK; ++c) {
        if (c + 1 < NCHUNK) GDN_LOAD(c + 1);
        const LAS float* B_ = Lf + (c & 1) * BUFSZ;
        float os0 = 0.f, os1 = 0.f;
        f32x4 k0, k1, q0, q1, sc, nk0, nk1, nq0, nq1, nsc; f32x2 v2, nv2;
#define GDN_LDSTEP(t_, K0, K1, Q0, Q1, V2, SC) do { K0 = *(const LAS f32x4*)(B_ + O_K + (t_) * 128 + 4 * j); K1 = *(const LAS f32x4*)(B_ + O_K + (t_) * 128 + 64 + 4 * j); \
            Q0 = *(const LAS f32x4*)(B_ + O_Q + (t_) * 128 + 4 * j); Q1 = *(const LAS f32x4*)(B_ + O_Q + (t_) * 128 + 64 + 4 * j); V2 = *(const LAS f32x2*)(B_ + O_V + (t_) * 64 + col); SC = *(const LAS f32x4*)(B_ + O_SC + (t_) * 4); } while (0)
        GDN_LDSTEP(0, k0, k1, q0, q1, v2, sc);
#pragma unroll
        for (int t = 0; t < TC; ++t) {
            if (t + 1 < TC) { GDN_LDSTEP(t + 1, nk0, nk1, nq0, nq1, nv2, nsc); }
            __builtin_amdgcn_sched_barrier(0);
            f32x2 d1 = {0.f, 0.f}, d2 = {0.f, 0.f}, e1 = {0.f, 0.f}, e2 = {0.f, 0.f};
#pragma unroll
            for (int i = 0; i < 4; ++i) { d1 += S2[i] * k0[i]; e1 += S2[4 + i] * k1[i]; d2 += S2[i] * q0[i]; e2 += S2[4 + i] * q1[i]; }
            d1 += e1; d2 += e2;
            { float r0_ = d1[0], r1_ = d1[1], r2_ = d2[0], r3_ = d2[1]; row_sum16_x4(r0_, r1_, r2_, r3_); d1[0] = r0_; d1[1] = r1_; d2[0] = r2_; d2[1] = r3_; }
            const float a = sc[0], beta = sc[1], qk = sc[2];
            const f32x2 dl = (v2 - d1 * a) * beta;
            const f32x2 o2 = d2 * a + dl * qk;
#pragma unroll
            for (int i = 0; i < 4; ++i) { S2[i] = S2[i] * a + dl * k0[i]; S2[4 + i] = S2[4 + i] * a + dl * k1[i]; }
            os0 = (j == t) ? o2[0] : os0; os1 = (j == t) ? o2[1] : os1;
            k0 = nk0; k1 = nk1; q0 = nq0; q1 = nq1; v2 = nv2; sc = nsc;
        }
#undef GDN_LDSTEP
        { f32x2 o2 = {os0, os1}; *(LAS f32x2*)(Lf + O_OUT + j * 64 + col) = o2; }
        if (c + 1 < NCHUNK) GDN_XFORM((c + 1) & 1);
        LBAR();
        if (tid < 256) *(GAS f32x4*)(O + (size_t)(c * TC + tlv) * D + c4) = *(const LAS f32x4*)(Lf + O_OUT + tlv * 64 + c4);
        LBAR();
    }
#undef GDN_LOAD
#undef GDN_XFORM
}

typedef short bf16x4_t __attribute__((ext_vector_type(4)));
__device__ __forceinline__ bf16x8 mk_frag(u32x2 lo, u32x2 hi) { v4u t; t.x = lo.x; t.y = lo.y; t.z = hi.x; t.w = hi.y; return __builtin_bit_cast(bf16x8, t); }
template <int MODE>
__device__ __forceinline__ void scan_gla_mfma_unit(const Args& A, Frame& F, int unit) {
    int tid = F.tid; asm volatile("" : "+v"(tid));
    const int lane = tid & 63, w = F.wave;
    int b, h, qcol, kcol, vcol, ocol;
    if (MODE == 0) { b = unit >> 3; h = (unit >> 1) & 3; const int s = unit & 1; qcol = EC_GQ + h * 128; kcol = EC_GK + h * 128; vcol = EC_GV + h * 256 + s * 128; ocol = h * 256 + s * 128; }
    else           { b = unit >> 3; h = unit & 7; qcol = OC_HQ + h * 128; kcol = OC_HF + h * 128; vcol = OC_HI + h * 128; ocol = h * 128; }
    const bf16* P = (const bf16*)(A.ws + WS_PROJ) + (size_t)b * SEQ * PROJ_LD;
    bf16* O = (bf16*)(A.ws + WS_O) + (size_t)b * SEQ * D + ocol;
    LAS float* Lf = (LAS float*)(F.lds + RING_OFF);
    constexpr int BUFSZ = 8192, O_E = 0, O_K = 2048, O_Q = 4096, O_V = 6144, RS = 136, O_QB = 2 * BUFSZ, O_KB = O_QB + 1088, O_KT = O_KB + 1088, O_BL = O_KT + 1024, O_AM = O_BL + 128, O_W2 = O_AM + 128, O_BIAS = O_W2 + 2048;
    LAS bf16* QB = (LAS bf16*)(Lf + O_QB); LAS bf16* KB = (LAS bf16*)(Lf + O_KB); LAS bf16* KT = (LAS bf16*)(Lf + O_KT); LAS bf16* AM = (LAS bf16*)(Lf + O_AM);
    const int tl = tid >> 5, dq = (tid & 31) * 4;
    float lb[4] = {0.f, 0.f, 0.f, 0.f};
    if (MODE == 0) {
        const float* w2 = A.in[I_GK_W2]; const float* gb = A.in[I_GK_B];
        for (int i = tid; i < 2048; i += NTHREADS) Lf[O_W2 + i] = w2[(i >> 7) * 512 + h * 128 + (i & 127)];
        if (tid < 128) Lf[O_BIAS + tid] = gb[h * 128 + tid];
    } else {
        const float* lg = A.in[I_LB];
#pragma unroll
        for (int i = 0; i < 4; ++i) lb[i] = sigmoidf_(lg[1024 + h * 128 + dq + i] - lg[h * 128 + dq + i]);
    }
    u32x2 rq, rk, rv; v4u rg0 = {0u, 0u, 0u, 0u}, rg1 = {0u, 0u, 0u, 0u};
#define GM_LOAD(c) do { const bf16* pr = P + (size_t)((c) * TC + tl) * PROJ_LD; rq = *(const GAS u32x2*)(pr + qcol + dq); rk = *(const GAS u32x2*)(pr + kcol + dq); rv = *(const GAS u32x2*)(pr + vcol + dq); \
        if (MODE == 0) { rg0 = *(const GAS v4u*)(pr + EC_GLR); rg1 = *(const GAS v4u*)(pr + EC_GLR + 8); } } while (0)
#define GM_XFORM(bufi) do { LAS float* B_ = Lf + (bufi) * BUFSZ; f32x4 q4, k4, e4; \
        const float xq[4] = {bf_lo(rq.x), bf_hi(rq.x), bf_lo(rq.y), bf_hi(rq.y)}, xk[4] = {bf_lo(rk.x), bf_hi(rk.x), bf_lo(rk.y), bf_hi(rk.y)}; \
        if (MODE == 0) { f32x4 z = *(const LAS f32x4*)(Lf + O_BIAS + dq); \
            const float gl[16] = {bf_lo(rg0.x), bf_hi(rg0.x), bf_lo(rg0.y), bf_hi(rg0.y), bf_lo(rg0.z), bf_hi(rg0.z), bf_lo(rg0.w), bf_hi(rg0.w), \
                                  bf_lo(rg1.x), bf_hi(rg1.x), bf_lo(rg1.y), bf_hi(rg1.y), bf_lo(rg1.z), bf_hi(rg1.z), bf_lo(rg1.w), bf_hi(rg1.w)}; \
            _Pragma("unroll") for (int r_ = 0; r_ < 16; ++r_) { const f32x4 wv = *(const LAS f32x4*)(Lf + O_W2 + r_ * 128 + dq); z = z + wv * gl[r_]; } \
            _Pragma("unroll") for (int i_ = 0; i_ < 4; ++i_) { q4[i_] = xq[i_] * 0.08838834764831845f; k4[i_] = xk[i_]; e4[i_] = __builtin_amdgcn_exp2f(-0.0625f * __builtin_amdgcn_logf(1.0f + __expf(-z[i_]))); } } \
        else { _Pragma("unroll") for (int i_ = 0; i_ < 4; ++i_) { const float fg = lb[i_] + (1.f - lb[i_]) * sigmoidf_(xk[i_]); q4[i_] = siluf_(xq[i_]); k4[i_] = 1.f - fg; e4[i_] = fg; } } \
        *(LAS f32x4*)(B_ + O_E + tl * 128 + dq) = e4; *(LAS f32x4*)(B_ + O_K + tl * 128 + dq) = k4; *(LAS f32x4*)(B_ + O_Q + tl * 128 + dq) = q4; \
        { f32x4 v4 = {bf_lo(rv.x), bf_hi(rv.x), bf_lo(rv.y), bf_hi(rv.y)}; *(LAS f32x4*)(B_ + O_V + tl * 128 + dq) = v4; } } while (0)
    LBAR();
    GM_LOAD(0); GM_XFORM(0); GM_LOAD(1);
    LBAR();
    f32x4 Sacc[8];
#pragma unroll
    for (int i = 0; i < 8; ++i) Sacc[i] = (f32x4){0.f, 0.f, 0.f, 0.f};
    const int fr = lane & 15, g = lane >> 4, c0 = w * 16;
    for (int c = 0; c < NCHUNK; ++c) {
        const LAS float* B_ = Lf + (c & 1) * BUFSZ;
        {
            const int seg = tid >> 7, d = tid & 127;
            float bt = 1.f, ball = 1.f;
#pragma unroll
            for (int t = 0; t < 16; ++t) { const float e = B_[O_E + t * 128 + d]; ball *= e; if (t < 4 * seg) bt = ball; }
            ball = fmaxf(ball, 1e-30f);
            unsigned short kt4[4];
#pragma unroll
            for (int i = 0; i < 4; ++i) { const int t = 4 * seg + i; bt = fmaxf(bt * B_[O_E + t * 128 + d], 1e-30f);
                const float kk = B_[O_K + t * 128 + d], qq = B_[O_Q + t * 128 + d], ib = __builtin_amdgcn_rcpf(bt);
                QB[t * RS + d] = hw_bf(qq * bt); KB[t * RS + d] = hw_bf(kk * ib); kt4[i] = (unsigned short)hw_bf(kk * ball * ib); }
            u32x2 kw; kw.x = (unsigned)kt4[0] | ((unsigned)kt4[1] << 16); kw.y = (unsigned)kt4[2] | ((unsigned)kt4[3] << 16);
            *(LAS u32x2*)(KT + d * 16 + 4 * seg) = kw;
            if (seg == 3) Lf[O_BL + d] = ball;
        }
        LBAR();
        if (w == 0) {
            f32x4 acc = {0.f, 0.f, 0.f, 0.f};
#pragma unroll
            for (int ks = 0; ks < 4; ++ks) { const bf16x8 af = *(const LAS bf16x8*)(QB + fr * RS + 32 * ks + 8 * g), bfm = *(const LAS bf16x8*)(KB + fr * RS + 32 * ks + 8 * g);
                acc = __builtin_amdgcn_mfma_f32_16x16x32_bf16(af, bfm, acc, 0, 0, 0); }
#pragma unroll
            for (int r = 0; r < 4; ++r) { const int t = 4 * g + r, s = fr; AM[t * 16 + s] = hw_bf(s <= t ? acc[r] : 0.f); }
        }
        if (c + 1 < NCHUNK) GM_XFORM((c + 1) & 1);
        if (c + 2 < NCHUNK) GM_LOAD(c + 2);
        LBAR();
        {
            u32x2 vlo; { const float v0 = B_[O_V + (4 * g + 0) * 128 + c0 + fr], v1 = B_[O_V + (4 * g + 1) * 128 + c0 + fr], v2 = B_[O_V + (4 * g + 2) * 128 + c0 + fr], v3 = B_[O_V + (4 * g + 3) * 128 + c0 + fr];
                vlo.x = hw_pk2(v0, v1); vlo.y = hw_pk2(v2, v3); }
            const u32x2 zz = {0u, 0u};
            const bf16x8 vb = mk_frag(vlo, zz);
            f32x4 acco = {0.f, 0.f, 0.f, 0.f};
#pragma unroll
            for (int ks = 0; ks < 4; ++ks) {
                u32x2 slo, shi; slo.x = hw_pk2(Sacc[2 * ks][0], Sacc[2 * ks][1]); slo.y = hw_pk2(Sacc[2 * ks][2], Sacc[2 * ks][3]); shi.x = hw_pk2(Sacc[2 * ks + 1][0], Sacc[2 * ks + 1][1]); shi.y = hw_pk2(Sacc[2 * ks + 1][2], Sacc[2 * ks + 1][3]);
                const bf16x8 sb = mk_frag(slo, shi);
                const u32x2 qlo = *(const LAS u32x2*)(QB + fr * RS + 32 * ks + 4 * g), qhi = *(const LAS u32x2*)(QB + fr * RS + 32 * ks + 16 + 4 * g);
                acco = __builtin_amdgcn_mfma_f32_16x16x32_bf16(mk_frag(qlo, qhi), sb, acco, 0, 0, 0); }
            { const u32x2 alo = *(const LAS u32x2*)(AM + fr * 16 + 4 * g); acco = __builtin_amdgcn_mfma_f32_16x16x32_bf16(mk_frag(alo, zz), vb, acco, 0, 0, 0); }
#pragma unroll
            for (int r = 0; r < 4; ++r) O[(size_t)(c * TC + 4 * g + r) * D + c0 + fr] = hw_bf(acco[r]);
#pragma unroll
            for (int i = 0; i < 8; ++i) { const f32x4 bl = *(const LAS f32x4*)(Lf + O_BL + 16 * i + 4 * g); const u32x2 klo = *(const LAS u32x2*)(KT + (16 * i + fr) * 16 + 4 * g);
                Sacc[i] = __builtin_amdgcn_mfma_f32_16x16x32_bf16(mk_frag(klo, zz), vb, Sacc[i] * bl, 0, 0, 0); }
        }
        LBAR();
    }
#undef GM_LOAD
#undef GM_XFORM
}

__device__ __forceinline__ void scan_gdn_mfma_unit(const Args& A, Frame& F, int unit, const int role) {
    int tid = F.tid; asm volatile("" : "+v"(tid));
    const int lane = tid & 63, w = F.wave;
    const int b = unit >> 3, h = unit & 7;
    const int qcol = EC_BQ + h * 128, kcol = EC_BK + h * 128, vcol = EC_BV + h * 128, ocol = 1024 + h * 128;
    const bf16* P = (const bf16*)(A.ws + WS_PROJ) + (size_t)b * SEQ * PROJ_LD;
    bf16* O = (bf16*)(A.ws + WS_O) + (size_t)b * SEQ * D + ocol;
    LAS float* Lf = (LAS float*)(F.lds + RING_OFF);
    constexpr int O_CW = 0, O_AMAT = 1536, O_QKM = O_AMAT + 256, O_TB = O_QKM + 128, O_GL = O_TB + 128, O_BUF0 = O_GL + 64;
    constexpr int BUFSZ = 6208, O_KH = 0, O_QH = 2048, O_VV = 4096, O_SC = 6144;
    constexpr int RS = 136;
    constexpr int O_KHB = O_BUF0 + 2 * BUFSZ, O_QHB = O_KHB + 1088, O_QB = O_QHB + 1088, O_KT = O_QB + 1088, O_WSRC = O_KT + 1024, O_WB = O_WSRC + 2048;
    LAS bf16* KHB = (LAS bf16*)(Lf + O_KHB); LAS bf16* QHB = (LAS bf16*)(Lf + O_QHB); LAS bf16* QB = (LAS bf16*)(Lf + O_QB); LAS bf16* KT = (LAS bf16*)(Lf + O_KT);
    LAS bf16* WB = (LAS bf16*)(Lf + O_WB); LAS bf16* QKM = (LAS bf16*)(Lf + O_QKM); LAS bf16* TB = (LAS bf16*)(Lf + O_TB);
    const int tl = tid >> 5, dq = (tid & 31) * 4;
    { const float* cw = A.in[I_GDN_CONV];
      for (int i = tid; i < 4 * 384; i += NTHREADS) { const int jt = i / 384, x = i % 384; Lf[O_CW + i] = cw[jt * 3072 + (x >> 7) * 1024 + h * 128 + (x & 127)]; } }
    const float neg_ea = -__expf(A.in[I_GDN_ALOG][h]), dtb = A.in[I_GDN_DTB][h];
    u32x2 rq[4], rk[4], rv[4]; unsigned short rba = 0, rbb = 0;
#define GD_LOAD(c) do { const int t_ = (c) * TC + tl; \
        _Pragma("unroll") for (int jt = 0; jt < 4; ++jt) { const int tt = t_ - 3 + jt; const bf16* pr = P + (size_t)(tt < 0 ? 0 : tt) * PROJ_LD + dq; \
            rq[jt] = *(const GAS u32x2*)(pr + qcol); rk[jt] = *(const GAS u32x2*)(pr + kcol); rv[jt] = *(const GAS u32x2*)(pr + vcol); \
            if (tt < 0) { rq[jt] = (u32x2){0u, 0u}; rk[jt] = (u32x2){0u, 0u}; rv[jt] = (u32x2){0u, 0u}; } } \
        { const bf16* pr = P + (size_t)t_ * PROJ_LD; rba = pr[EC_BA + h]; rbb = pr[EC_BB + h]; } } while (0)
#define GD_XFORM(bufi) do { LAS float* B_ = Lf + O_BUF0 + (bufi) * BUFSZ; f32x4 q4 = {0.f, 0.f, 0.f, 0.f}, k4 = {0.f, 0.f, 0.f, 0.f}, v4 = {0.f, 0.f, 0.f, 0.f}; \
        _Pragma("unroll") for (int jt = 0; jt < 4; ++jt) { const f32x4 wq = *(const LAS f32x4*)(Lf + O_CW + jt * 384 + dq), wk = *(const LAS f32x4*)(Lf + O_CW + jt * 384 + 128 + dq), wv = *(const LAS f32x4*)(Lf + O_CW + jt * 384 + 256 + dq); \
            q4[0] += wq[0] * bf_lo(rq[jt].x); q4[1] += wq[1] * bf_hi(rq[jt].x); q4[2] += wq[2] * bf_lo(rq[jt].y); q4[3] += wq[3] * bf_hi(rq[jt].y); \
            k4[0] += wk[0] * bf_lo(rk[jt].x); k4[1] += wk[1] * bf_hi(rk[jt].x); k4[2] += wk[2] * bf_lo(rk[jt].y); k4[3] += wk[3] * bf_hi(rk[jt].y); \
            v4[0] += wv[0] * bf_lo(rv[jt].x); v4[1] += wv[1] * bf_hi(rv[jt].x); v4[2] += wv[2] * bf_lo(rv[jt].y); v4[3] += wv[3] * bf_hi(rv[jt].y); } \
        float sq = 0.f, sk = 0.f; \
        _Pragma("unroll") for (int i_ = 0; i_ < 4; ++i_) { q4[i_] = siluf_(q4[i_]); k4[i_] = siluf_(k4[i_]); v4[i_] = siluf_(v4[i_]); sq += q4[i_] * q4[i_]; sk += k4[i_] * k4[i_]; } \
        row_sum16_x2(sq, sk); sq += __shfl_xor(sq, 16); sk += __shfl_xor(sk, 16); \
        q4 = q4 * (__builtin_amdgcn_rsqf(sq + EPS) * 0.08838834764831845f); k4 = k4 * __builtin_amdgcn_rsqf(sk + EPS); \
        *(LAS f32x4*)(B_ + O_KH + tl * 128 + dq) = k4; *(LAS f32x4*)(B_ + O_QH + tl * 128 + dq) = q4; *(LAS f32x4*)(B_ + O_VV + tl * 128 + dq) = v4; \
        if ((tid & 31) == 0) { const float ba = __uint_as_float((unsigned)rba << 16), bb = __uint_as_float((unsigned)rbb << 16); \
            B_[O_SC + tl] = __expf(neg_ea * softplusf_(ba + dtb)); B_[O_SC + 16 + tl] = sigmoidf_(bb); } } while (0)
    LBAR();
    const int c_begin = role ? NCHUNK / 2 : 0, c_end = role ? NCHUNK : NCHUNK / 2;
    constexpr int REC = 5408;
    float* STASH = (float*)(A.ws + WS_LA) + (size_t)unit * (NCHUNK / 2) * REC;
    float* STATE = (float*)(A.ws + WS_STATE) + (size_t)unit * 16384;
    gu32* flag = F.ctl + 32768 + unit * 64;
    GD_LOAD(c_begin); GD_XFORM(c_begin & 1); GD_LOAD(c_begin + 1);
    LBAR();
    f32x4 Sacc[8];
#pragma unroll
    for (int i = 0; i < 8; ++i) Sacc[i] = (f32x4){0.f, 0.f, 0.f, 0.f};
    const int fr = lane & 15, g = lane >> 4, c0 = w * 16;
    const u32x2 zz = {0u, 0u};
#define GD_STATE_PART(cc_) do { \
        { \
            bf16x8 sb[4]; \
_Pragma("unroll") \
            for (int ks = 0; ks < 4; ++ks) { u32x2 slo, shi; slo.x = hw_pk2(Sacc[2 * ks][0], Sacc[2 * ks][1]); slo.y = hw_pk2(Sacc[2 * ks][2], Sacc[2 * ks][3]); shi.x = hw_pk2(Sacc[2 * ks + 1][0], Sacc[2 * ks + 1][1]); shi.y = hw_pk2(Sacc[2 * ks + 1][2], Sacc[2 * ks + 1][3]); \
                sb[ks] = mk_frag(slo, shi); } \
            f32x4 accv = accu, acco = {0.f, 0.f, 0.f, 0.f}; \
_Pragma("unroll") \
            for (int ks = 0; ks < 4; ++ks) { \
                const u32x2 wl = *(const LAS u32x2*)(WB + fr * RS + 32 * ks + 4 * g), wh = *(const LAS u32x2*)(WB + fr * RS + 32 * ks + 16 + 4 * g); \
                accv = __builtin_amdgcn_mfma_f32_16x16x32_bf16(mk_frag(wl, wh), sb[ks], accv, 0, 0, 0); \
                const u32x2 ql = *(const LAS u32x2*)(QB + fr * RS + 32 * ks + 4 * g), qh = *(const LAS u32x2*)(QB + fr * RS + 32 * ks + 16 + 4 * g); \
                acco = __builtin_amdgcn_mfma_f32_16x16x32_bf16(mk_frag(ql, qh), sb[ks], acco, 0, 0, 0); } \
            u32x2 vn; vn.x = hw_pk2(accv[0], accv[1]); vn.y = hw_pk2(accv[2], accv[3]); \
            const bf16x8 vnb = mk_frag(vn, zz); \
            acco = __builtin_amdgcn_mfma_f32_16x16x32_bf16(mk_frag(*(const LAS u32x2*)(QKM + fr * 16 + 4 * g), zz), vnb, acco, 0, 0, 0); \
_Pragma("unroll") \
            for (int r = 0; r < 4; ++r) O[(size_t)((cc_) * TC + 4 * g + r) * D + c0 + fr] = hw_bf(acco[r]); \
_Pragma("unroll") \
            for (int i = 0; i < 8; ++i) { const u32x2 klo = *(const LAS u32x2*)(KT + (16 * i + fr) * 16 + 4 * g); \
                Sacc[i] = __builtin_amdgcn_mfma_f32_16x16x32_bf16(mk_frag(klo, zz), vnb, Sacc[i] * glast, 0, 0, 0); } \
        } \
        } while (0)
    for (int c = c_begin; c < c_end; ++c) {
        const LAS float* B_ = Lf + O_BUF0 + (c & 1) * BUFSZ;
        float glast;
        {
            const int seg = tid >> 7, d = tid & 127;
            const f32x4 a0 = *(const LAS f32x4*)(B_ + O_SC), a1 = *(const LAS f32x4*)(B_ + O_SC + 4), a2 = *(const LAS f32x4*)(B_ + O_SC + 8), a3 = *(const LAS f32x4*)(B_ + O_SC + 12);
            const float av[16] = {a0[0], a0[1], a0[2], a0[3], a1[0], a1[1], a1[2], a1[3], a2[0], a2[1], a2[2], a2[3], a3[0], a3[1], a3[2], a3[3]};
            float p = 1.f, gpre = 1.f;
#pragma unroll
            for (int t = 0; t < 16; ++t) { if (t == 4 * seg) gpre = p; p *= av[t]; }
            glast = p;
            unsigned short kt4[4]; float gt = gpre;
#pragma unroll
            for (int i = 0; i < 4; ++i) { const int t = 4 * seg + i; const float at = (seg == 0) ? av[i] : (seg == 1) ? av[4 + i] : (seg == 2) ? av[8 + i] : av[12 + i]; gt *= at; const float beta = B_[O_SC + 16 + t];
                const float kk = B_[O_KH + t * 128 + d], qq = B_[O_QH + t * 128 + d];
                KHB[t * RS + d] = hw_bf(kk); QHB[t * RS + d] = hw_bf(qq); QB[t * RS + d] = hw_bf(qq * gt);
                kt4[i] = (unsigned short)hw_bf(kk * glast * __builtin_amdgcn_rcpf(gt));
                Lf[O_WSRC + t * 128 + d] = kk * (beta * gt);
                if (d == 0) Lf[O_GL + t] = gt; }
            u32x2 kw; kw.x = (unsigned)kt4[0] | ((unsigned)kt4[1] << 16); kw.y = (unsigned)kt4[2] | ((unsigned)kt4[3] << 16);
            *(LAS u32x2*)(KT + d * 16 + 4 * seg) = kw;
        }
        LBAR();
        if (w < 2) {
            const LAS bf16* AS = (w == 0) ? KHB : QHB;
            f32x4 acc = {0.f, 0.f, 0.f, 0.f};
#pragma unroll
            for (int ks = 0; ks < 4; ++ks) { const bf16x8 af = *(const LAS bf16x8*)(AS + fr * RS + 32 * ks + 8 * g), bfm = *(const LAS bf16x8*)(KHB + fr * RS + 32 * ks + 8 * g);
                acc = __builtin_amdgcn_mfma_f32_16x16x32_bf16(af, bfm, acc, 0, 0, 0); }
            const float gs_inv = __builtin_amdgcn_rcpf(Lf[O_GL + fr]);
            if (w == 0) {
                f32x4 N1, M1;
#pragma unroll
                for (int r = 0; r < 4; ++r) { const int t = 4 * g + r; const float gt = Lf[O_GL + t];
                    N1[r] = (fr < t) ? -(B_[O_SC + 16 + t] * acc[r] * gt * gs_inv) : 0.f;
                    M1[r] = (t < fr) ? -(B_[O_SC + 16 + fr] * acc[r] * Lf[O_GL + fr] * __builtin_amdgcn_rcpf(gt)) : 0.f; }
#define XTY(X, Y, C0) __builtin_amdgcn_mfma_f32_16x16x32_bf16(mk_frag((u32x2){hw_pk2(X[0], X[1]), hw_pk2(X[2], X[3])}, zz), mk_frag((u32x2){hw_pk2(Y[0], Y[1]), hw_pk2(Y[2], Y[3])}, zz), C0, 0, 0, 0)
                const f32x4 z4 = {0.f, 0.f, 0.f, 0.f};
                f32x4 T1t = M1;
#pragma unroll
                for (int r = 0; r < 4; ++r) if (4 * g + r == fr) T1t[r] += 1.f;
                const f32x4 N2 = XTY(M1, N1, z4), M2 = XTY(N1, M1, z4);
                const f32x4 T2t = XTY(N2, T1t, T1t);
                const f32x4 N4 = XTY(M2, N2, z4), M4 = XTY(N2, M2, z4);
                const f32x4 T4t = XTY(N4, T2t, T2t);
                const f32x4 N8 = XTY(M4, N4, z4);
                const f32x4 T8t = XTY(N8, T4t, T4t);
#undef XTY
                u32x2 tw; tw.x = hw_pk2(T8t[0], T8t[1]); tw.y = hw_pk2(T8t[2], T8t[3]);
                *(LAS u32x2*)(TB + fr * 16 + 4 * g) = tw;
            } else {
#pragma unroll
                for (int r = 0; r < 4; ++r) { const int t = 4 * g + r; QKM[t * 16 + fr] = hw_bf((fr <= t) ? acc[r] * Lf[O_GL + t] * gs_inv : 0.f); }
            }
        }
        if (c + 1 < c_end) GD_XFORM((c + 1) & 1);
        if (c + 2 < c_end) GD_LOAD(c + 2);
        LBAR();
        f32x4 accu = {0.f, 0.f, 0.f, 0.f};
        {
            const bf16x8 tf = mk_frag(*(const LAS u32x2*)(TB + fr * 16 + 4 * g), zz);
            u32x2 ulo, wlo;
            { const float b0 = B_[O_SC + 16 + 4 * g + 0], b1 = B_[O_SC + 16 + 4 * g + 1], b2 = B_[O_SC + 16 + 4 * g + 2], b3 = B_[O_SC + 16 + 4 * g + 3];
              ulo.x = hw_pk2(b0 * B_[O_VV + (4 * g + 0) * 128 + c0 + fr], b1 * B_[O_VV + (4 * g + 1) * 128 + c0 + fr]); ulo.y = hw_pk2(b2 * B_[O_VV + (4 * g + 2) * 128 + c0 + fr], b3 * B_[O_VV + (4 * g + 3) * 128 + c0 + fr]);
              wlo.x = hw_pk2(Lf[O_WSRC + (4 * g + 0) * 128 + c0 + fr], Lf[O_WSRC + (4 * g + 1) * 128 + c0 + fr]); wlo.y = hw_pk2(Lf[O_WSRC + (4 * g + 2) * 128 + c0 + fr], Lf[O_WSRC + (4 * g + 3) * 128 + c0 + fr]); }
            accu = __builtin_amdgcn_mfma_f32_16x16x32_bf16(tf, mk_frag(ulo, zz), accu, 0, 0, 0);
            f32x4 accw = {0.f, 0.f, 0.f, 0.f};
            accw = __builtin_amdgcn_mfma_f32_16x16x32_bf16(tf, mk_frag(wlo, zz), accw, 0, 0, 0);
#pragma unroll
            for (int r = 0; r < 4; ++r) WB[(4 * g + r) * RS + c0 + fr] = hw_bf(-accw[r]);
        }
        LBAR();
        if (role == 0) {
            GD_STATE_PART(c);
        } else {
            float* rec = STASH + (size_t)(c - c_begin) * REC;
            for (int i = tid; i < 832; i += NTHREADS) { const int o = i < 528 ? O_QB + 4 * i : (i < 800 ? O_WB + 4 * (i - 528) : O_QKM + 4 * (i - 800)); *(GAS f32x4*)(rec + 4 * i) = *(const LAS f32x4*)(Lf + o); }
#pragma unroll
            for (int r = 0; r < 4; ++r) rec[3328 + (w * 4 + r) * 64 + lane] = accu[r];
            if (tid == 0) rec[5376] = glast;
        }
        LBAR();
    }
    if (role == 0) {
#pragma unroll
        for (int i = 0; i < 8; ++i)
#pragma unroll
            for (int r = 0; r < 4; ++r) STATE[((w * 8 + i) * 4 + r) * 64 + lane] = Sacc[i][r];
        asm volatile("s_waitcnt vmcnt(0)" ::: "memory");
        __syncthreads();
        if (tid == 0) { __builtin_amdgcn_fence(__ATOMIC_RELEASE, "agent"); asm volatile("s_waitcnt vmcnt(0)" ::: "memory"); __hip_atomic_store(flag, 1u, __ATOMIC_RELAXED, __HIP_MEMORY_SCOPE_AGENT); }
    } else {
        if (tid == 0) { unsigned sp = 0; while (__hip_atomic_load(flag, __ATOMIC_RELAXED, __HIP_MEMORY_SCOPE_AGENT) == 0u) { __builtin_amdgcn_s_sleep(8); if (++sp > (1u << 22)) break; }
            __builtin_amdgcn_fence(__ATOMIC_ACQUIRE, "agent"); asm volatile("s_waitcnt vmcnt(0)" ::: "memory"); }
        __syncthreads();
#pragma unroll
        for (int i = 0; i < 8; ++i)
#pragma unroll
            for (int r = 0; r < 4; ++r) Sacc[i][r] = STATE[((w * 8 + i) * 4 + r) * 64 + lane];
        f32x4 pa, pb; f32x4 pu; float pg;
#define GD_REC_LOAD(cc) do { const float* rec = STASH + (size_t)((cc) - c_begin) * REC; pa = *(const GAS f32x4*)(rec + 4 * tid); pb = (tid < 320) ? *(const GAS f32x4*)(rec + 4 * (tid + 512)) : (f32x4){0.f, 0.f, 0.f, 0.f}; \
            _Pragma("unroll") for (int r = 0; r < 4; ++r) pu[r] = rec[3328 + (w * 4 + r) * 64 + lane]; pg = rec[5376]; } while (0)
        GD_REC_LOAD(c_begin);
        for (int c = c_begin; c < c_end; ++c) {
            { const int i0 = tid, o0 = i0 < 528 ? O_QB + 4 * i0 : O_WB + 4 * (i0 - 528); *(LAS f32x4*)(Lf + o0) = pa;
              if (tid < 320) { const int i1 = tid + 512; const int o1 = i1 < 528 ? O_QB + 4 * i1 : (i1 < 800 ? O_WB + 4 * (i1 - 528) : O_QKM + 4 * (i1 - 800)); *(LAS f32x4*)(Lf + o1) = pb; } }
            const f32x4 accu = pu; const float glast = pg;
            if (c + 1 < c_end) GD_REC_LOAD(c + 1);
            LBAR();
            GD_STATE_PART(c);
            LBAR();
        }
#undef GD_REC_LOAD
    }
#undef GD_STATE_PART
#undef GD_LOAD
#undef GD_XFORM
}

__device__ __forceinline__ void scan_rwkv_unit(const Args& A, Frame& F, int unit) {
    int tid = F.tid; asm volatile("" : "+v"(tid));
    const int lane = tid & 63, w = F.wave;
    const int b = unit >> 4, h = unit & 15;
    const bf16* P = (const bf16*)(A.ws + WS_PROJ) + (size_t)b * SEQ * PROJ_LD + OC_RW;
    const bf16* LO = (const bf16*)(A.ws + WS_LO) + (size_t)b * SEQ * LORA_N;
    bf16* Y = (bf16*)(A.ws + WS_ACTA) + (size_t)b * SEQ * D + 1024 + h * 64;
    LAS float* Lf = (LAS float*)(F.lds + RING_OFF);
    constexpr int BUFSZ = 6208, O_KK = 0, O_WR = 1024, O_W = 2048, O_NKA = 3072, O_K = 4096, O_V = 5120, O_SC = 6144, O_OUT = 2 * BUFSZ;
    const int tl = tid >> 5, d2 = (tid & 31) * 2, hd = h * 64 + d2;
    float mu_r[2], mu_k[2], mu_v[2], w0[2], a0[2], k_k[2], k_a[2], r_k[2], lnw[2], lnb[2];
#pragma unroll
    for (int i = 0; i < 2; ++i) { mu_r[i] = A.in[I_MU][RW_R + hd + i]; mu_k[i] = A.in[I_MU][RW_K + hd + i]; mu_v[i] = A.in[I_MU][RW_V + hd + i];
        w0[i] = A.in[I_W0][hd + i]; a0[i] = A.in[I_A0][hd + i]; k_k[i] = A.in[I_KK][hd + i]; k_a[i] = A.in[I_KA][hd + i]; r_k[i] = A.in[I_RK][hd + i];
        lnw[i] = A.in[I_LNW][hd + i]; lnb[i] = A.in[I_LNB][hd + i]; }
    unsigned rr[2], rk[2], rv[2], rlw, rla, rg_cur = 0u, rg_nxt = 0u;
#define RW_LOAD(c) do { const int t_ = (c) * TC + tl; const bf16* pr = P + (size_t)t_ * PROJ_LD; \
        rr[0] = *(const GAS unsigned*)(pr + RW_R + hd); rk[0] = *(const GAS unsigned*)(pr + RW_K + hd); rv[0] = *(const GAS unsigned*)(pr + RW_V + hd); \
        if (t_ > 0) { rr[1] = *(const GAS unsigned*)(pr - PROJ_LD + RW_R + hd); rk[1] = *(const GAS unsigned*)(pr - PROJ_LD + RW_K + hd); rv[1] = *(const GAS unsigned*)(pr - PROJ_LD + RW_V + hd); } \
        else { rr[1] = 0u; rk[1] = 0u; rv[1] = 0u; } \
        const bf16* lr = LO + (size_t)t_ * LORA_N; rlw = *(const GAS unsigned*)(lr + hd); rla = *(const GAS unsigned*)(lr + 1024 + hd); rg_nxt = *(const GAS unsigned*)(lr + 2048 + hd); } while (0)
#define RW_XFORM(bufi) do { LAS float* B_ = Lf + (bufi) * BUFSZ; f32x2 kk2, wr2, w2_, nka2, k2, v2_; float skk = 0.f, sc1 = 0.f, sc2 = 0.f, sbs = 0.f; float aa[2], rrv[2]; \
        _Pragma("unroll") for (int i_ = 0; i_ < 2; ++i_) { \
            const float r0 = i_ ? bf_hi(rr[0]) : bf_lo(rr[0]), r1 = i_ ? bf_hi(rr[1]) : bf_lo(rr[1]); \
            const float k0_ = i_ ? bf_hi(rk[0]) : bf_lo(rk[0]), k1_ = i_ ? bf_hi(rk[1]) : bf_lo(rk[1]); \
            const float v0_ = i_ ? bf_hi(rv[0]) : bf_lo(rv[0]), v1_ = i_ ? bf_hi(rv[1]) : bf_lo(rv[1]); \
            const float lw = i_ ? bf_hi(rlw) : bf_lo(rlw), la = i_ ? bf_hi(rla) : bf_lo(rla); \
            const float r_ = r0 + (r1 - r0) * mu_r[i_], kx = k0_ + (k1_ - k0_) * mu_k[i_], vx = v0_ + (v1_ - v0_) * mu_v[i_]; \
            const float wd = __expf(-0.6065306597126334f * sigmoidf_(w0[i_] + lw)); const float a_ = sigmoidf_(a0[i_] + la); \
            const float kk0 = kx * k_k[i_]; const float km = kx * (1.f + (a_ - 1.f) * k_a[i_]); \
            kk2[i_] = kk0; skk += kk0 * kk0; aa[i_] = a_; rrv[i_] = r_; wr2[i_] = wd * r_; w2_[i_] = wd; k2[i_] = km; v2_[i_] = vx; sc2 += km * r_; sbs += r_ * km * r_k[i_]; } \
        skk = half_sum32(skk); const float rkk = __builtin_amdgcn_rsqf(skk + EPS); \
        _Pragma("unroll") for (int i_ = 0; i_ < 2; ++i_) { kk2[i_] *= rkk; nka2[i_] = -(kk2[i_] * aa[i_]); sc1 += kk2[i_] * aa[i_] * rrv[i_]; } \
        sc1 = half_sum32(sc1); sc2 = half_sum32(sc2); sbs = half_sum32(sbs); \
        *(LAS f32x2*)(B_ + O_KK + tl * 64 + d2) = kk2; *(LAS f32x2*)(B_ + O_WR + tl * 64 + d2) = wr2; *(LAS f32x2*)(B_ + O_W + tl * 64 + d2) = w2_; \
        *(LAS f32x2*)(B_ + O_NKA + tl * 64 + d2) = nka2; *(LAS f32x2*)(B_ + O_K + tl * 64 + d2) = k2; *(LAS f32x2*)(B_ + O_V + tl * 64 + d2) = v2_; \
        if ((tid & 31) == 0) { f32x4 sc; sc[0] = sc1; sc[1] = sc2; sc[2] = sbs; sc[3] = 0.f; *(LAS f32x4*)(B_ + O_SC + tl * 4) = sc; } } while (0)
    RW_LOAD(0); RW_XFORM(0); rg_cur = rg_nxt;
    LBAR();
    f32x2 S2[4];
#pragma unroll
    for (int i = 0; i < 4; ++i) S2[i] = (f32x2){0.f, 0.f};
    const int j = lane & 15, col = w * 8 + (lane >> 4) * 2;
    for (int c = 0; c < NCHUNK; ++c) {
        if (c + 1 < NCHUNK) RW_LOAD(c + 1);
        const LAS float* B_ = Lf + (c & 1) * BUFSZ;
        float os0 = 0.f, os1 = 0.f;
        f32x4 kk, wr, ww, nka, kv, sc, nkk, nwr, nww, nnka, nkv, nsc; f32x2 v2, nv2;
#define RW_LDSTEP(t_, KK, WR, WW, NKA, KV, V2, SC) do { KK = *(const LAS f32x4*)(B_ + O_KK + (t_) * 64 + 4 * j); WR = *(const LAS f32x4*)(B_ + O_WR + (t_) * 64 + 4 * j); WW = *(const LAS f32x4*)(B_ + O_W + (t_) * 64 + 4 * j); \
            NKA = *(const LAS f32x4*)(B_ + O_NKA + (t_) * 64 + 4 * j); KV = *(const LAS f32x4*)(B_ + O_K + (t_) * 64 + 4 * j); V2 = *(const LAS f32x2*)(B_ + O_V + (t_) * 64 + col); SC = *(const LAS f32x4*)(B_ + O_SC + (t_) * 4); } while (0)
        RW_LDSTEP(0, kk, wr, ww, nka, kv, v2, sc);
#pragma unroll
        for (int t = 0; t < TC; ++t) {
            if (t + 1 < TC) { RW_LDSTEP(t + 1, nkk, nwr, nww, nnka, nkv, nv2, nsc); }
            __builtin_amdgcn_sched_barrier(0);
            f32x2 d1 = S2[0] * kk[0], d2 = S2[0] * wr[0], e1 = S2[1] * kk[1], e2 = S2[1] * wr[1];
            d1 += S2[2] * kk[2]; d2 += S2[2] * wr[2]; e1 += S2[3] * kk[3]; e2 += S2[3] * wr[3];
            d1 += e1; d2 += e2;
            { float r0_ = d1[0], r1_ = d1[1], r2_ = d2[0], r3_ = d2[1]; row_sum16_x4(r0_, r1_, r2_, r3_); d1[0] = r0_; d1[1] = r1_; d2[0] = r2_; d2[1] = r3_; }
            const f32x2 o2 = d2 - d1 * sc[0] + v2 * sc[1];
#pragma unroll
            for (int i = 0; i < 4; ++i) S2[i] = S2[i] * ww[i] + d1 * nka[i] + v2 * kv[i];
            os0 = (j == t) ? o2[0] : os0; os1 = (j == t) ? o2[1] : os1;
            kk = nkk; wr = nwr; ww = nww; nka = nnka; kv = nkv; v2 = nv2; sc = nsc;
        }
#undef RW_LDSTEP
        { f32x2 o2 = {os0, os1}; *(LAS f32x2*)(Lf + O_OUT + j * 64 + col) = o2; }
        if (c + 1 < NCHUNK) RW_XFORM((c + 1) & 1);
        LBAR();
        {
            const f32x2 o2 = *(const LAS f32x2*)(Lf + O_OUT + tl * 64 + d2); const f32x2 vv = *(const LAS f32x2*)(B_ + O_V + tl * 64 + d2); const float bs = B_[O_SC + tl * 4 + 2];
            const float mean = half_sum32(o2[0] + o2[1]) * (1.0f / 64.0f); const float e0 = o2[0] - mean, e1 = o2[1] - mean;
            const float var = half_sum32(e0 * e0 + e1 * e1) * (1.0f / 64.0f); const float rs = __builtin_amdgcn_rsqf(var + 64e-5f);
            const float y0 = (e0 * rs * lnw[0] + lnb[0] + bs * vv[0]) * bf_lo(rg_cur), y1 = (e1 * rs * lnw[1] + lnb[1] + bs * vv[1]) * bf_hi(rg_cur);
            *(GAS unsigned*)(Y + (size_t)(c * TC + tl) * D + d2) = pk2(y0, y1);
        }
        rg_cur = rg_nxt;
        LBAR();
    }
#undef RW_LOAD
#undef RW_XFORM
}

template <int LAYER>
__device__ __forceinline__ void post_rows(const Args& A, Frame& F) {
    const int gw = F.vcu * NWAVES + F.wave, NGW = F.G * NWAVES, lane = F.lane;
    const bf16* O = (const bf16*)(A.ws + WS_O); const bf16* P = (const bf16*)(A.ws + WS_PROJ); bf16* Y = (bf16*)(A.ws + WS_ACTA);
    for (int m = gw; m < T; m += NGW) {
        const GAS u32x2* orow = (const GAS u32x2*)(O + (size_t)m * D) + lane; const bf16* prow = P + (size_t)m * PROJ_LD;
        constexpr int NJ = LAYER == 0 ? 8 : 4;
#pragma unroll
        for (int jj = 0; jj < NJ; ++jj) {
            const u32x2 ow_ = orow[64 * jj]; const f32x4 v = {bf_lo(ow_.x), bf_hi(ow_.x), bf_lo(ow_.y), bf_hi(ow_.y)}; float ss = (v[0] * v[0] + v[1] * v[1]) + (v[2] * v[2] + v[3] * v[3]);
            const bool wide = (LAYER == 0 && jj < 4);
            const float ms = wide ? wave_sum(ss) * (1.0f / 256.0f) : half_sum32(ss) * (1.0f / 128.0f);
            const float r = __builtin_amdgcn_rsqf(ms + EPS);
            const int cih = wide ? 4 * lane : 4 * (lane & 31);
            const float* gsrc = LAYER == 0 ? (wide ? A.in[I_GLA_NORM] : A.in[I_GDN_NORM]) : A.in[I_HG_NORM];
            const f32x4 g = *(const GAS f32x4*)(gsrc + cih);
            const int zcol = LAYER == 0 ? (wide ? EC_GZ + jj * 256 + 4 * lane : EC_BZ + (jj - 4) * 256 + 4 * lane) : OC_HG + jj * 256 + 4 * lane;
            const u32x2 zw = *(const GAS u32x2*)(prow + zcol);
            const float y0 = v[0] * r * g[0] * siluf_(bf_lo(zw.x)), y1 = v[1] * r * g[1] * siluf_(bf_hi(zw.x)), y2 = v[2] * r * g[2] * siluf_(bf_lo(zw.y)), y3 = v[3] * r * g[3] * siluf_(bf_hi(zw.y));
            u32x2 o; o.x = pk2(y0, y1); o.y = pk2(y2, y3);
            *(GAS u32x2*)(Y + (size_t)m * D + 256 * jj + 4 * lane) = o;
        }
    }
}
__device__ __forceinline__ void lora_prep_rows(const Args& A, Frame& F) {
    const int gw = F.vcu * NWAVES + F.wave, NGW = F.G * NWAVES, lane = F.lane;
    const bf16* P = (const bf16*)(A.ws + WS_PROJ); bf16* LA = (bf16*)(A.ws + WS_LA); const float* mu = A.in[I_MU];
    for (int m = gw; m < T; m += NGW) { const bool hasprev = (m % SEQ) != 0; const bf16* prow = P + (size_t)m * PROJ_LD + OC_RW + RW_WL;
#pragma unroll
        for (int i = 0; i < 7; ++i) { const int c = lane + 64 * i;
            const float x = __uint_as_float((unsigned)prow[c] << 16), xp = hasprev ? __uint_as_float((unsigned)prow[c - PROJ_LD] << 16) : 0.f;
            const float ts = x + (xp - x) * mu[RW_WL + c];
            const float v = c < 96 ? tanhf(ts) : (c < 192 ? ts : sigmoidf_(ts));
            LA[(size_t)m * LORA_K + c] = (bf16)f2bf(v); }
        LA[(size_t)m * LORA_K + 448 + lane] = (bf16)0; }
}
__device__ __forceinline__ void final_rows(const Args& A, Frame& F, const float oscale, const bf16* Hs) {
    const int gw = F.vcu * NWAVES + F.wave, NGW = F.G * NWAVES, lane = F.lane;
    const float* rowss = (const float*)(A.ws + WS_RSP) + (size_t)RS_FINAL * T * 32; const GAS f32x4* g = (const GAS f32x4*)A.in[I_NFINAL] + lane;
    for (int m = gw; m < T; m += NGW) { const float r = oscale * __builtin_amdgcn_rsqf(wave_sum(lane < 32 ? rowss[(size_t)m * 32 + lane] : 0.f) * (1.0f / D) + EPS); GAS f32x4* row = (GAS f32x4*)(A.out + (size_t)m * D) + lane;
        const GAS u32x2* hrow = (const GAS u32x2*)(Hs + (size_t)m * D) + lane;
#pragma unroll
        for (int jj = 0; jj < 8; ++jj) { const u32x2 hw = hrow[64 * jj]; const f32x4 v = {bf_lo(hw.x), bf_hi(hw.x), bf_lo(hw.y), bf_hi(hw.y)}; row[64 * jj] = v * r * g[64 * jj]; } }
}

__device__ __forceinline__ void scan_rwkv_mfma_unit(const Args& A, Frame& F, int unit, const int role) {
    int tid = F.tid; asm volatile("" : "+v"(tid));
    const int lane = tid & 63, w = F.wave;
    const int b = unit >> 3, hp = unit & 7;
    const bf16* P = (const bf16*)(A.ws + WS_PROJ) + (size_t)b * SEQ * PROJ_LD + OC_RW;
    const bf16* LO = (const bf16*)(A.ws + WS_LO) + (size_t)b * SEQ * LORA_N;
    bf16* Y = (bf16*)(A.ws + WS_ACTA) + (size_t)b * SEQ * D + 1024;
    LAS float* Lf = (LAS float*)(F.lds + RING_OFF);
    constexpr int RS = 72;
    constexpr int O_CONST = 0;
    constexpr int O_XF = 1280;
    constexpr int O_VV = O_XF + 2 * 5 * 1024;
    constexpr int O_BS = O_VV + 4 * 1024;
    constexpr int O_IMG = O_BS + 64;
    constexpr int I_CT = 0, I_BT = 576, I_KL = 1152, I_RT = 1728, I_CF = 2304, I_BTT = 3328, I_KTT = 3840, I_WCB = 4352, I_G1B = 4928, I_TTB = 5056, I_RKB = 5184, I_RBB = 5312, I_W15 = 5440, I_OUT = 5504, IMGSZ = 6528;
    static_assert((O_IMG + 2 * IMGSZ) * 4 <= RING_BYTES, "rwkv lds");
    for (int i = tid; i < 1280; i += NTHREADS) { const int arr = i >> 7, ch = hp * 128 + (i & 127); float v;
        switch (arr) { case 0: v = A.in[I_MU][RW_R + ch]; break; case 1: v = A.in[I_MU][RW_K + ch]; break; case 2: v = A.in[I_MU][RW_V + ch]; break; case 3: v = A.in[I_W0][ch]; break; case 4: v = A.in[I_A0][ch]; break;
                       case 5: v = A.in[I_KK][ch]; break; case 6: v = A.in[I_KA][ch]; break; case 7: v = A.in[I_RK][ch]; break; case 8: v = A.in[I_LNW][ch]; break; default: v = A.in[I_LNB][ch]; break; }
        Lf[O_CONST + i] = v; }
    const int hx = tid >> 8, tl = (tid >> 4) & 15, d4 = (tid & 15) * 4, ch4 = hx * 64 + d4, col4 = hp * 128 + ch4;
    u32x2 rr[2], rk[2], rv[2], rlw, rla, rg_cur = {0u, 0u}, rg_nxt = {0u, 0u}, rg_far = {0u, 0u};
#define RM_LOAD(c) do { const int t_ = (c) * TC + tl; const bf16* pr = P + (size_t)t_ * PROJ_LD + col4; \
        rr[0] = *(const GAS u32x2*)(pr + RW_R); rk[0] = *(const GAS u32x2*)(pr + RW_K); rv[0] = *(const GAS u32x2*)(pr + RW_V); \
        const bf16* pp_ = (t_ > 0) ? pr - PROJ_LD : pr; rr[1] = *(const GAS u32x2*)(pp_ + RW_R); rk[1] = *(const GAS u32x2*)(pp_ + RW_K); rv[1] = *(const GAS u32x2*)(pp_ + RW_V); \
        if (t_ == 0) { rr[1] = (u32x2){0u, 0u}; rk[1] = (u32x2){0u, 0u}; rv[1] = (u32x2){0u, 0u}; } \
        const bf16* lr = LO + (size_t)t_ * LORA_N + col4; rlw = *(const GAS u32x2*)(lr); rla = *(const GAS u32x2*)(lr + 1024); rg_far = *(const GAS u32x2*)(lr + 2048); } while (0)
#define RM_XFORM(bufi) do { LAS float* X_ = Lf + O_XF + hx * 5 * 1024 + tl * 64 + d4; \
        const f32x4 mur = *(const LAS f32x4*)(Lf + O_CONST + 0 * 128 + ch4), muk = *(const LAS f32x4*)(Lf + O_CONST + 1 * 128 + ch4), muv = *(const LAS f32x4*)(Lf + O_CONST + 2 * 128 + ch4); \
        const f32x4 w0_ = *(const LAS f32x4*)(Lf + O_CONST + 3 * 128 + ch4), a0_ = *(const LAS f32x4*)(Lf + O_CONST + 4 * 128 + ch4), kk_ = *(const LAS f32x4*)(Lf + O_CONST + 5 * 128 + ch4); \
        const f32x4 ka_ = *(const LAS f32x4*)(Lf + O_CONST + 6 * 128 + ch4), rk_ = *(const LAS f32x4*)(Lf + O_CONST + 7 * 128 + ch4); \
        const float r0[4] = {bf_lo(rr[0].x), bf_hi(rr[0].x), bf_lo(rr[0].y), bf_hi(rr[0].y)}, r1[4] = {bf_lo(rr[1].x), bf_hi(rr[1].x), bf_lo(rr[1].y), bf_hi(rr[1].y)}; \
        const float k0[4] = {bf_lo(rk[0].x), bf_hi(rk[0].x), bf_lo(rk[0].y), bf_hi(rk[0].y)}, k1[4] = {bf_lo(rk[1].x), bf_hi(rk[1].x), bf_lo(rk[1].y), bf_hi(rk[1].y)}; \
        const float v0[4] = {bf_lo(rv[0].x), bf_hi(rv[0].x), bf_lo(rv[0].y), bf_hi(rv[0].y)}, v1[4] = {bf_lo(rv[1].x), bf_hi(rv[1].x), bf_lo(rv[1].y), bf_hi(rv[1].y)}; \
        const float lw[4] = {bf_lo(rlw.x), bf_hi(rlw.x), bf_lo(rlw.y), bf_hi(rlw.y)}, la[4] = {bf_lo(rla.x), bf_hi(rla.x), bf_lo(rla.y), bf_hi(rla.y)}; \
        f32x4 r4, w4, k4, v4, kk4, b4; float skk = 0.f, sbs = 0.f; float aa[4]; \
        _Pragma("unroll") for (int i_ = 0; i_ < 4; ++i_) { const float r_ = r0[i_] + (r1[i_] - r0[i_]) * mur[i_], kx = k0[i_] + (k1[i_] - k0[i_]) * muk[i_], vx = v0[i_] + (v1[i_] - v0[i_]) * muv[i_]; \
            const float wd = __expf(-0.6065306597126334f * sigmoidf_(w0_[i_] + lw[i_])); const float a_ = sigmoidf_(a0_[i_] + la[i_]); \
            const float kk0 = kx * kk_[i_], km = kx * (1.f + (a_ - 1.f) * ka_[i_]); \
            r4[i_] = r_; w4[i_] = wd; k4[i_] = km; v4[i_] = vx; kk4[i_] = kk0; aa[i_] = a_; skk += kk0 * kk0; sbs += r_ * km * rk_[i_]; } \
        row_sum16_x2(skk, sbs); const float rkk = __builtin_amdgcn_rsqf(skk + EPS); \
        _Pragma("unroll") for (int i_ = 0; i_ < 4; ++i_) { kk4[i_] *= rkk; b4[i_] = kk4[i_] * aa[i_]; } \
        *(LAS f32x4*)(X_) = r4; *(LAS f32x4*)(X_ + 1024) = w4; *(LAS f32x4*)(X_ + 2048) = k4; *(LAS f32x4*)(X_ + 3072) = kk4; *(LAS f32x4*)(X_ + 4096) = b4; \
        *(LAS f32x4*)(Lf + O_VV + ((bufi) * 2 + hx) * 1024 + tl * 64 + d4) = v4; \
        if ((tid & 15) == 0) Lf[O_BS + ((bufi) * 2 + hx) * 16 + tl] = sbs; } while (0)
    const int c_begin = role ? NCHUNK / 2 : 0, c_end = role ? NCHUNK : NCHUNK / 2;
    constexpr int REC = 7584;
    float* STASH = (float*)(A.ws + (unit < 32 ? WS_WEV_IN : WS_END)) + (size_t)(unit & 31) * (NCHUNK / 2) * REC;
    float* STATE = (float*)(A.ws + WS_STATE + 4 * MiB) + (size_t)unit * 8192;
    gu32* flag = F.ctl + 49152 + unit * 64;
    LBAR();
    RM_LOAD(c_begin); RM_XFORM(c_begin & 1); rg_cur = rg_far; RM_LOAD(c_begin + 1); rg_nxt = rg_far;
    LBAR();
    f32x4 Macc[4];
#pragma unroll
    for (int i = 0; i < 4; ++i) Macc[i] = (f32x4){0.f, 0.f, 0.f, 0.f};
    const int fr = lane & 15, g = lane >> 4, hh = w >> 2, ww = w & 3, c0 = ww * 16;
    LAS float* IM = Lf + O_IMG + hh * IMGSZ;
    LAS bf16* CT = (LAS bf16*)(IM + I_CT); LAS bf16* BT = (LAS bf16*)(IM + I_BT); LAS bf16* KL = (LAS bf16*)(IM + I_KL); LAS bf16* RT = (LAS bf16*)(IM + I_RT);
    LAS bf16* BTT = (LAS bf16*)(IM + I_BTT); LAS bf16* KTT = (LAS bf16*)(IM + I_KTT); LAS bf16* WCB = (LAS bf16*)(IM + I_WCB);
    LAS bf16* G1B = (LAS bf16*)(IM + I_G1B); LAS bf16* TTB = (LAS bf16*)(IM + I_TTB); LAS bf16* RKB = (LAS bf16*)(IM + I_RKB); LAS bf16* RBB = (LAS bf16*)(IM + I_RBB);
    const u32x2 zz = {0u, 0u};
#define RM_STATE_PART(vb) do { \
        { \
            bf16x8 mb[2]; \
_Pragma("unroll") \
            for (int ks = 0; ks < 2; ++ks) { u32x2 slo, shi; slo.x = hw_pk2(Macc[2 * ks][0], Macc[2 * ks][1]); slo.y = hw_pk2(Macc[2 * ks][2], Macc[2 * ks][3]); shi.x = hw_pk2(Macc[2 * ks + 1][0], Macc[2 * ks + 1][1]); shi.y = hw_pk2(Macc[2 * ks + 1][2], Macc[2 * ks + 1][3]); \
                mb[ks] = mk_frag(slo, shi); } \
            f32x4 accR = accU, acco = {0.f, 0.f, 0.f, 0.f}; \
_Pragma("unroll") \
            for (int ks = 0; ks < 2; ++ks) { \
                accR = __builtin_amdgcn_mfma_f32_16x16x32_bf16(mk_frag(*(const LAS u32x2*)(WCB + fr * RS + 32 * ks + 4 * g), *(const LAS u32x2*)(WCB + fr * RS + 32 * ks + 16 + 4 * g)), mb[ks], accR, 0, 0, 0); \
                acco = __builtin_amdgcn_mfma_f32_16x16x32_bf16(mk_frag(*(const LAS u32x2*)(RT + fr * RS + 32 * ks + 4 * g), *(const LAS u32x2*)(RT + fr * RS + 32 * ks + 16 + 4 * g)), mb[ks], acco, 0, 0, 0); } \
            u32x2 rn; rn.x = hw_pk2(accR[0], accR[1]); rn.y = hw_pk2(accR[2], accR[3]); \
            const bf16x8 rb = mk_frag(rn, zz); \
            acco = __builtin_amdgcn_mfma_f32_16x16x32_bf16(mk_frag(*(const LAS u32x2*)(RKB + fr * 16 + 4 * g), zz), vb, acco, 0, 0, 0); \
            acco = __builtin_amdgcn_mfma_f32_16x16x32_bf16(mk_frag(*(const LAS u32x2*)(RBB + fr * 16 + 4 * g), zz), rb, acco, 0, 0, 0); \
_Pragma("unroll") \
            for (int r = 0; r < 4; ++r) IM[I_OUT + (4 * g + r) * 64 + c0 + fr] = acco[r]; \
_Pragma("unroll") \
            for (int i = 0; i < 4; ++i) { const f32x4 w15 = *(const LAS f32x4*)(IM + I_W15 + 16 * i + 4 * g); \
                f32x4 m = __builtin_amdgcn_mfma_f32_16x16x32_bf16(mk_frag(*(const LAS u32x2*)(KTT + (16 * i + fr) * 16 + 4 * g), zz), vb, Macc[i], 0, 0, 0); \
                m = __builtin_amdgcn_mfma_f32_16x16x32_bf16(mk_frag(*(const LAS u32x2*)(BTT + (16 * i + fr) * 16 + 4 * g), zz), rb, m, 0, 0, 0); \
                Macc[i] = m * w15; } \
        } \
        } while (0)
#define RM_FLUSH(cc_, gb_, vv_, bs_) do { \
        { \
            const f32x4 o4 = *(const LAS f32x4*)(Lf + O_IMG + hx * IMGSZ + I_OUT + tl * 64 + d4); const f32x4 vv = (vv_); const float bs = (bs_); \
            const f32x4 lnw = *(const LAS f32x4*)(Lf + O_CONST + 8 * 128 + ch4), lnb = *(const LAS f32x4*)(Lf + O_CONST + 9 * 128 + ch4); \
            float sm = (o4[0] + o4[1]) + (o4[2] + o4[3]), dummy = 0.f; row_sum16_x2(sm, dummy); const float mean = sm * (1.0f / 64.0f); \
            const f32x4 e4 = o4 - mean; float sv = (e4[0] * e4[0] + e4[1] * e4[1]) + (e4[2] * e4[2] + e4[3] * e4[3]); row_sum16_x2(sv, dummy); const float rs = __builtin_amdgcn_rsqf(sv * (1.0f / 64.0f) + 64e-5f); \
            const float gg[4] = {bf_lo((gb_).x), bf_hi((gb_).x), bf_lo((gb_).y), bf_hi((gb_).y)}; \
            float y[4]; \
_Pragma("unroll") \
            for (int i = 0; i < 4; ++i) y[i] = (e4[i] * rs * lnw[i] + lnb[i] + bs * vv[i]) * gg[i]; \
            u32x2 o; o.x = hw_pk2(y[0], y[1]); o.y = hw_pk2(y[2], y[3]); \
            *(GAS u32x2*)(Y + (size_t)((cc_) * TC + tl) * D + col4) = o; \
        } \
        } while (0)
    for (int c = c_begin; c < c_end; ++c) {
        {
            const int hq = tid >> 8, seg = (tid >> 6) & 3, d = tid & 63;
            const LAS float* X_ = Lf + O_XF + hq * 5 * 1024 + d; LAS float* IQ = Lf + O_IMG + hq * IMGSZ;
            LAS bf16* CTq = (LAS bf16*)(IQ + I_CT); LAS bf16* BTq = (LAS bf16*)(IQ + I_BT); LAS bf16* KLq = (LAS bf16*)(IQ + I_KL); LAS bf16* RTq = (LAS bf16*)(IQ + I_RT);
            float wall = 1.f, wpre = 1.f;
#pragma unroll
            for (int t = 0; t < 16; ++t) { if (t == 4 * seg) wpre = wall; wall *= X_[1024 + t * 64]; }
            float wt = wpre; unsigned short bt4[4], kt4[4];
#pragma unroll
            for (int i = 0; i < 4; ++i) { const int t = 4 * seg + i; const float wprev = wt; wt *= X_[1024 + t * 64]; const float iw = __builtin_amdgcn_rcpf(wt);
                const float r_ = X_[t * 64], k_ = X_[2048 + t * 64], kk_ = X_[3072 + t * 64], b_ = X_[4096 + t * 64];
                const float ct = kk_ * wprev, bt = b_ * iw, kt = k_ * iw;
                CTq[t * RS + d] = hw_bf(ct); IQ[I_CF + t * 64 + d] = ct; BTq[t * RS + d] = hw_bf(bt); KLq[t * RS + d] = hw_bf(kt); RTq[t * RS + d] = hw_bf(r_ * wt);
                bt4[i] = (unsigned short)hw_bf(-bt); kt4[i] = (unsigned short)hw_bf(kt); }
            u32x2 o; o.x = (unsigned)bt4[0] | ((unsigned)bt4[1] << 16); o.y = (unsigned)bt4[2] | ((unsigned)bt4[3] << 16); *(LAS u32x2*)((LAS bf16*)(IQ + I_BTT) + d * 16 + 4 * seg) = o;
            o.x = (unsigned)kt4[0] | ((unsigned)kt4[1] << 16); o.y = (unsigned)kt4[2] | ((unsigned)kt4[3] << 16); *(LAS u32x2*)((LAS bf16*)(IQ + I_KTT) + d * 16 + 4 * seg) = o;
            if (seg == 3) IQ[I_W15 + d] = wall;
        }
        LBAR();
        if (ww == 0) {
            f32x4 cb = {0.f, 0.f, 0.f, 0.f}, bc = cb, ck = cb, rkm = cb, rbm = cb;
#pragma unroll
            for (int ks = 0; ks < 2; ++ks) { const bf16x8 fc = *(const LAS bf16x8*)(CT + fr * RS + 32 * ks + 8 * g), fb = *(const LAS bf16x8*)(BT + fr * RS + 32 * ks + 8 * g), fk = *(const LAS bf16x8*)(KL + fr * RS + 32 * ks + 8 * g), frr = *(const LAS bf16x8*)(RT + fr * RS + 32 * ks + 8 * g);
                cb = __builtin_amdgcn_mfma_f32_16x16x32_bf16(fc, fb, cb, 0, 0, 0); bc = __builtin_amdgcn_mfma_f32_16x16x32_bf16(fb, fc, bc, 0, 0, 0); ck = __builtin_amdgcn_mfma_f32_16x16x32_bf16(fc, fk, ck, 0, 0, 0);
                rkm = __builtin_amdgcn_mfma_f32_16x16x32_bf16(frr, fk, rkm, 0, 0, 0); rbm = __builtin_amdgcn_mfma_f32_16x16x32_bf16(frr, fb, rbm, 0, 0, 0); }
            f32x4 N1, M1, CKm;
#pragma unroll
            for (int r = 0; r < 4; ++r) { const int t = 4 * g + r; N1[r] = (fr < t) ? -cb[r] : 0.f; M1[r] = (t < fr) ? -bc[r] : 0.f; CKm[r] = (fr < t) ? ck[r] : 0.f;
                RKB[t * 16 + fr] = hw_bf((fr <= t) ? rkm[r] : 0.f); RBB[t * 16 + fr] = hw_bf((fr <= t) ? -rbm[r] : 0.f); }
#define XTY(X, Y, C0) __builtin_amdgcn_mfma_f32_16x16x32_bf16(mk_frag((u32x2){hw_pk2(X[0], X[1]), hw_pk2(X[2], X[3])}, zz), mk_frag((u32x2){hw_pk2(Y[0], Y[1]), hw_pk2(Y[2], Y[3])}, zz), C0, 0, 0, 0)
            const f32x4 z4 = {0.f, 0.f, 0.f, 0.f};
            f32x4 T1t = M1;
#pragma unroll
            for (int r = 0; r < 4; ++r) if (4 * g + r == fr) T1t[r] += 1.f;
            const f32x4 N2 = XTY(M1, N1, z4), M2 = XTY(N1, M1, z4);
            const f32x4 T2t = XTY(N2, T1t, T1t);
            const f32x4 N4 = XTY(M2, N2, z4), M4 = XTY(N2, M2, z4);
            const f32x4 T4t = XTY(N4, T2t, T2t);
            const f32x4 N8 = XTY(M4, N4, z4);
            const f32x4 T8t = XTY(N8, T4t, T4t);
            const f32x4 G1t = XTY(CKm, T8t, z4);
#undef XTY
            u32x2 tw; tw.x = hw_pk2(T8t[0], T8t[1]); tw.y = hw_pk2(T8t[2], T8t[3]); *(LAS u32x2*)(TTB + fr * 16 + 4 * g) = tw;
            tw.x = hw_pk2(G1t[0], G1t[1]); tw.y = hw_pk2(G1t[2], G1t[3]); *(LAS u32x2*)(G1B + fr * 16 + 4 * g) = tw;
        }
        if (c + 1 < c_end) { RM_XFORM((c + 1) & 1); }
        if (c + 2 < c_end) RM_LOAD(c + 2);
        LBAR();
        const LAS float* VVc = Lf + O_VV + ((c & 1) * 2 + hh) * 1024;
        u32x2 vlo; { vlo.x = hw_pk2(VVc[(4 * g + 0) * 64 + c0 + fr], VVc[(4 * g + 1) * 64 + c0 + fr]); vlo.y = hw_pk2(VVc[(4 * g + 2) * 64 + c0 + fr], VVc[(4 * g + 3) * 64 + c0 + fr]); }
        const bf16x8 vb = mk_frag(vlo, zz);
        f32x4 accU = {0.f, 0.f, 0.f, 0.f};
        {
            accU = __builtin_amdgcn_mfma_f32_16x16x32_bf16(mk_frag(*(const LAS u32x2*)(G1B + fr * 16 + 4 * g), zz), vb, accU, 0, 0, 0);
            u32x2 clo; clo.x = hw_pk2(IM[I_CF + (4 * g + 0) * 64 + c0 + fr], IM[I_CF + (4 * g + 1) * 64 + c0 + fr]); clo.y = hw_pk2(IM[I_CF + (4 * g + 2) * 64 + c0 + fr], IM[I_CF + (4 * g + 3) * 64 + c0 + fr]);
            f32x4 accw = {0.f, 0.f, 0.f, 0.f};
            accw = __builtin_amdgcn_mfma_f32_16x16x32_bf16(mk_frag(*(const LAS u32x2*)(TTB + fr * 16 + 4 * g), zz), mk_frag(clo, zz), accw, 0, 0, 0);
#pragma unroll
            for (int r = 0; r < 4; ++r) WCB[(4 * g + r) * RS + c0 + fr] = hw_bf(accw[r]);
        }
        LBAR();
        if (role == 0) {
            RM_STATE_PART(vb);
            LBAR();
            RM_FLUSH(c, rg_cur, *(const LAS f32x4*)(Lf + O_VV + ((c & 1) * 2 + hx) * 1024 + tl * 64 + d4), Lf[O_BS + ((c & 1) * 2 + hx) * 16 + tl]);
        } else {
            float* rec = STASH + (size_t)(c - c_begin) * REC;
            for (int i = tid; i < 1376; i += NTHREADS) { const int hd = i >= 688, j = i - hd * 688; const int o = O_IMG + hd * IMGSZ + (j < 144 ? I_RT + 4 * j : I_BTT + 4 * (j - 144)); *(GAS f32x4*)(rec + 4 * i) = *(const LAS f32x4*)(Lf + o); }
            { GAS unsigned* ru = (GAS unsigned*)(rec + 5504); ru[(w * 2 + 0) * 64 + lane] = hw_pk2(accU[0], accU[1]); ru[(w * 2 + 1) * 64 + lane] = hw_pk2(accU[2], accU[3]); }
            { const f32x4 v4 = *(const LAS f32x4*)(Lf + O_VV + ((c & 1) * 2 + hx) * 1024 + tl * 64 + d4); u32x2 o; o.x = hw_pk2(v4[0], v4[1]); o.y = hw_pk2(v4[2], v4[3]); *(GAS u32x2*)(rec + 6528 + 2 * tid) = o; }
            if (tid < 32) rec[7552 + tid] = Lf[O_BS + (c & 1) * 32 + tid];
            LBAR();
        }
        rg_cur = rg_nxt; rg_nxt = rg_far;
    }
    if (role == 0) {
#pragma unroll
        for (int i = 0; i < 4; ++i)
#pragma unroll
            for (int r = 0; r < 4; ++r) STATE[((w * 4 + i) * 4 + r) * 64 + lane] = Macc[i][r];
        asm volatile("s_waitcnt vmcnt(0)" ::: "memory");
        __syncthreads();
        if (tid == 0) { __builtin_amdgcn_fence(__ATOMIC_RELEASE, "agent"); asm volatile("s_waitcnt vmcnt(0)" ::: "memory"); __hip_atomic_store(flag, 1u, __ATOMIC_RELAXED, __HIP_MEMORY_SCOPE_AGENT); }
    } else {
        if (tid == 0) { unsigned sp = 0; while (__hip_atomic_load(flag, __ATOMIC_RELAXED, __HIP_MEMORY_SCOPE_AGENT) == 0u) { __builtin_amdgcn_s_sleep(8); if (++sp > (1u << 22)) break; }
            __builtin_amdgcn_fence(__ATOMIC_ACQUIRE, "agent"); asm volatile("s_waitcnt vmcnt(0)" ::: "memory"); }
        __syncthreads();
#pragma unroll
        for (int i = 0; i < 4; ++i)
#pragma unroll
            for (int r = 0; r < 4; ++r) Macc[i][r] = STATE[((w * 4 + i) * 4 + r) * 64 + lane];
        f32x4 pi0, pi1, pi2; unsigned pu0, pu1; u32x2 pv, pgate; float pbs;
#define RM_REC_LOAD(cc) do { const float* rec = STASH + (size_t)((cc) - c_begin) * REC; pi0 = *(const GAS f32x4*)(rec + 4 * tid); pi1 = *(const GAS f32x4*)(rec + 4 * (tid + 512)); \
            pi2 = (tid < 352) ? *(const GAS f32x4*)(rec + 4 * (tid + 1024)) : (f32x4){0.f, 0.f, 0.f, 0.f}; \
            const GAS unsigned* ru = (const GAS unsigned*)(rec + 5504); pu0 = ru[(w * 2 + 0) * 64 + lane]; pu1 = ru[(w * 2 + 1) * 64 + lane]; pv = *(const GAS u32x2*)(rec + 6528 + 2 * tid); pbs = rec[7552 + hx * 16 + tl]; \
            pgate = *(const GAS u32x2*)(LO + (size_t)((cc) * TC + tl) * LORA_N + col4 + 2048); } while (0)
#define RM_IMG_OFF(i_) (O_IMG + ((i_) >= 688) * IMGSZ + ((((i_) - ((i_) >= 688) * 688) < 144) ? I_RT + 4 * ((i_) - ((i_) >= 688) * 688) : I_BTT + 4 * (((i_) - ((i_) >= 688) * 688) - 144)))
        RM_REC_LOAD(c_begin);
        for (int c = c_begin; c < c_end; ++c) {
            *(LAS f32x4*)(Lf + RM_IMG_OFF(tid)) = pi0; *(LAS f32x4*)(Lf + RM_IMG_OFF(tid + 512)) = pi1; if (tid < 352) *(LAS f32x4*)(Lf + RM_IMG_OFF(tid + 1024)) = pi2;
            const f32x4 vcur = {bf_lo(pv.x), bf_hi(pv.x), bf_lo(pv.y), bf_hi(pv.y)}; *(LAS f32x4*)(Lf + O_VV + hx * 1024 + tl * 64 + d4) = vcur;
            const f32x4 accU = {bf_lo(pu0), bf_hi(pu0), bf_lo(pu1), bf_hi(pu1)}; const float bscur = pbs; const u32x2 gcur = pgate;
            if (c + 1 < c_end) RM_REC_LOAD(c + 1);
            LBAR();
            const LAS float* VVc = Lf + O_VV + hh * 1024;
            u32x2 vlo; { vlo.x = hw_pk2(VVc[(4 * g + 0) * 64 + c0 + fr], VVc[(4 * g + 1) * 64 + c0 + fr]); vlo.y = hw_pk2(VVc[(4 * g + 2) * 64 + c0 + fr], VVc[(4 * g + 3) * 64 + c0 + fr]); }
            const bf16x8 vb = mk_frag(vlo, zz);
            RM_STATE_PART(vb);
            LBAR();
            RM_FLUSH(c, gcur, vcur, bscur);
            LBAR();
        }
#undef RM_REC_LOAD
#undef RM_IMG_OFF
    }
#undef RM_STATE_PART
#undef RM_FLUSH
#undef RM_LOAD
#undef RM_XFORM
}

__device__ __forceinline__ int med3i(int a, int b, int c) { int r; asm("v_med3_i32 %0, %1, %2, %3" : "=v"(r) : "v"(a), "v"(b), "v"(c)); return r; }
__device__ __forceinline__ int f2sort(float f) { int x = __float_as_int(f); return x ^ ((x >> 31) & 0x7fffffff); }
__device__ __forceinline__ float sort2f(int x) { return __int_as_float(x ^ ((x >> 31) & 0x7fffffff)); }
#define TOPK_INSERT(vals, x) do { _Pragma("unroll") for (int s_ = 15; s_ >= 1; --s_) vals[s_] = med3i((x), vals[s_ - 1], vals[s_]); vals[0] = max(vals[0], (x)); } while (0)
__device__ __forceinline__ float bf_dot2(unsigned a, unsigned b, float c) {
    return c + bf_lo(a) * bf_lo(b) + bf_hi(a) * bf_hi(b);
}
__device__ __forceinline__ void sum8_x8(float (&a)[8]) {
    asm("s_nop 1\n\t"
        "v_add_f32_dpp %0, %0, %0 quad_perm:[1,0,3,2] row_mask:0xf bank_mask:0xf\n\tv_add_f32_dpp %1, %1, %1 quad_perm:[1,0,3,2] row_mask:0xf bank_mask:0xf\n\t"
        "v_add_f32_dpp %2, %2, %2 quad_perm:[1,0,3,2] row_mask:0xf bank_mask:0xf\n\tv_add_f32_dpp %3, %3, %3 quad_perm:[1,0,3,2] row_mask:0xf bank_mask:0xf\n\t"
        "v_add_f32_dpp %4, %4, %4 quad_perm:[1,0,3,2] row_mask:0xf bank_mask:0xf\n\tv_add_f32_dpp %5, %5, %5 quad_perm:[1,0,3,2] row_mask:0xf bank_mask:0xf\n\t"
        "v_add_f32_dpp %6, %6, %6 quad_perm:[1,0,3,2] row_mask:0xf bank_mask:0xf\n\tv_add_f32_dpp %7, %7, %7 quad_perm:[1,0,3,2] row_mask:0xf bank_mask:0xf\n\t"
        "v_add_f32_dpp %0, %0, %0 quad_perm:[2,3,0,1] row_mask:0xf bank_mask:0xf\n\tv_add_f32_dpp %1, %1, %1 quad_perm:[2,3,0,1] row_mask:0xf bank_mask:0xf\n\t"
        "v_add_f32_dpp %2, %2, %2 quad_perm:[2,3,0,1] row_mask:0xf bank_mask:0xf\n\tv_add_f32_dpp %3, %3, %3 quad_perm:[2,3,0,1] row_mask:0xf bank_mask:0xf\n\t"
        "v_add_f32_dpp %4, %4, %4 quad_perm:[2,3,0,1] row_mask:0xf bank_mask:0xf\n\tv_add_f32_dpp %5, %5, %5 quad_perm:[2,3,0,1] row_mask:0xf bank_mask:0xf\n\t"
        "v_add_f32_dpp %6, %6, %6 quad_perm:[2,3,0,1] row_mask:0xf bank_mask:0xf\n\tv_add_f32_dpp %7, %7, %7 quad_perm:[2,3,0,1] row_mask:0xf bank_mask:0xf\n\t"
        "v_add_f32_dpp %0, %0, %0 row_half_mirror row_mask:0xf bank_mask:0xf\n\tv_add_f32_dpp %1, %1, %1 row_half_mirror row_mask:0xf bank_mask:0xf\n\t"
        "v_add_f32_dpp %2, %2, %2 row_half_mirror row_mask:0xf bank_mask:0xf\n\tv_add_f32_dpp %3, %3, %3 row_half_mirror row_mask:0xf bank_mask:0xf\n\t"
        "v_add_f32_dpp %4, %4, %4 row_half_mirror row_mask:0xf bank_mask:0xf\n\tv_add_f32_dpp %5, %5, %5 row_half_mirror row_mask:0xf bank_mask:0xf\n\t"
        "v_add_f32_dpp %6, %6, %6 row_half_mirror row_mask:0xf bank_mask:0xf\n\tv_add_f32_dpp %7, %7, %7 row_half_mirror row_mask:0xf bank_mask:0xf\n\t"
        "s_nop 1"
        : "+v"(a[0]), "+v"(a[1]), "+v"(a[2]), "+v"(a[3]), "+v"(a[4]), "+v"(a[5]), "+v"(a[6]), "+v"(a[7]));
}
__device__ __forceinline__ float sum8_x1(float v) {
    asm("s_nop 1\n\tv_add_f32_dpp %0, %0, %0 quad_perm:[1,0,3,2] row_mask:0xf bank_mask:0xf\n\ts_nop 1\n\tv_add_f32_dpp %0, %0, %0 quad_perm:[2,3,0,1] row_mask:0xf bank_mask:0xf\n\ts_nop 1\n\t"
        "v_add_f32_dpp %0, %0, %0 row_half_mirror row_mask:0xf bank_mask:0xf\n\ts_nop 1" : "+v"(v));
    return v;
}
__device__ __forceinline__ void peer_phase(const Args& A, Frame& F, int L, const bool dry, const bf16* Hin, bf16* Hout) {
    int lane = F.lane; asm volatile("" : "+v"(lane));
    const int gw = F.vcu * NWAVES + F.wave;
    const bf16* SCR = (const bf16*)(A.ws + WS_SC); const bf16* X = Hin; float* RS3 = (float*)(A.ws + WS_RS3);
    const unsigned char* TU = (const unsigned char*)(A.ws + WS_TABU) + (size_t)L * 16384 * D; const unsigned char* TV = (const unsigned char*)(A.ws + WS_TABV) + (size_t)L * 16384 * D;
    const float* rowss = (const float*)(A.ws + WS_RSP) + (size_t)(L == 0 ? RS_FFN0 : RS_FFN1) * T * 32;
    LAS unsigned* LIST = (LAS unsigned*)(F.lds + RING_OFF + F.wave * 16384);
    LAS unsigned* EIDX = LIST + 1024;
    LAS float* ECOEF = (LAS float*)(EIDX + 1024);
    const int tbase = gw * 8;
    if (tbase >= T) return;
    for (int half = 0; half < 2; ++half) {
        const int t0 = tbase + 4 * half;
        {
            const bf16* sp = SCR + (size_t)(t0 + (lane >> 4)) * D + (lane & 15) * 128;
            int vals[16];
#pragma unroll
            for (int s = 0; s < 16; ++s) vals[s] = (int)0x80000000;
#pragma unroll 2
            for (int c = 0; c < 16; ++c) { const v4u wv = *(const GAS v4u*)(sp + c * 8); const unsigned ww[4] = {wv.x, wv.y, wv.z, wv.w};
#pragma unroll
                for (int e = 0; e < 8; ++e) { const unsigned bits = (e & 1) ? (ww[e >> 1] & 0xffff0000u) : (ww[e >> 1] << 16);
                    int x = (int)bits; x ^= (x >> 31) & 0x7fffffff; x = (x & ~0x7f) | (127 - (c * 8 + e));
                    TOPK_INSERT(vals, x); } }
#pragma unroll
            for (int q = 0; q < 4; ++q) { v4u o; o.x = (unsigned)vals[4 * q]; o.y = (unsigned)vals[4 * q + 1]; o.z = (unsigned)vals[4 * q + 2]; o.w = (unsigned)vals[4 * q + 3]; *(LAS v4u*)(LIST + lane * 16 + 4 * q) = o; }
        }
        LDS_WAIT(); asm volatile("" ::: "memory");
        if (lane < 32) {
            const LAS unsigned* la = LIST + ((lane >> 3) * 16 + (lane & 7) * 2) * 16; const LAS unsigned* lb2 = la + 16;
            float av[16], bv[16];
#pragma unroll
            for (int q = 0; q < 4; ++q) { const v4u a4 = *(const LAS v4u*)(la + 4 * q), b4 = *(const LAS v4u*)(lb2 + 4 * q); const unsigned aw[4] = {a4.x, a4.y, a4.z, a4.w}, bw[4] = {b4.x, b4.y, b4.z, b4.w};
#pragma unroll
                for (int e = 0; e < 4; ++e) { av[4 * q + e] = __uint_as_float(__float_as_uint(sort2f((int)(aw[e] & ~0x7fu))) & 0xffff0000u); bv[4 * q + e] = __uint_as_float(__float_as_uint(sort2f((int)(bw[e] & ~0x7fu))) & 0xffff0000u); } }
            int best[16];
#pragma unroll
            for (int s = 0; s < 16; ++s) best[s] = (int)0x80000000;
#pragma unroll
            for (int i = 0; i < 16; ++i)
#pragma unroll
                for (int jx = 0; jx < 16; ++jx) if ((i + 1) * (jx + 1) <= 16) { int x = f2sort(av[i] + bv[jx]); x = (x & ~0xff) | (255 - (i * 16 + jx)); TOPK_INSERT(best, x); }
            float sv[16]; unsigned ex[16];
#pragma unroll
            for (int s = 0; s < 16; ++s) { const int cand = 255 - (best[s] & 0xff); const unsigned ka = la[cand >> 4], kb = lb2[cand & 15];
                ex[s] = (127u - (ka & 0x7fu)) * 128u + (127u - (kb & 0x7fu));
                sv[s] = __uint_as_float(__float_as_uint(sort2f((int)(ka & ~0x7fu))) & 0xffff0000u) + __uint_as_float(__float_as_uint(sort2f((int)(kb & ~0x7fu))) & 0xffff0000u); }
            float mx = sv[0];
#pragma unroll
            for (int s = 1; s < 16; ++s) mx = fmaxf(mx, sv[s]);
            float den = 0.f;
#pragma unroll
            for (int s = 0; s < 16; ++s) { sv[s] = __expf(sv[s] - mx); den += sv[s]; }
            const float inv = 1.0f / den; const int base = (4 * half + (lane >> 3)) * 128 + (lane & 7) * 16;
#pragma unroll
            for (int s = 0; s < 16; ++s) { EIDX[base + s] = ex[s]; ECOEF[base + s] = sv[s] * inv; }
        }
        LDS_WAIT(); asm volatile("" ::: "memory");
    }
    const int tk = lane >> 3, part = lane & 7, t = tbase + tk;
    const LAS unsigned* eidx = EIDX + tk * 128; LAS float* ecoef = ECOEF + tk * 128;
    const float rs = __builtin_amdgcn_rsqf(sum8_x1(((const GAS f32x4*)(rowss + (size_t)t * 32))[part][0] + ((const GAS f32x4*)(rowss + (size_t)t * 32))[part][1] + ((const GAS f32x4*)(rowss + (size_t)t * 32))[part][2] + ((const GAS f32x4*)(rowss + (size_t)t * 32))[part][3]) * (1.0f / D) + EPS);
    typedef _Float16 h2_t __attribute__((ext_vector_type(2)));
#define PEER_LOAD8(dst, TAB, i0, soff) do { const v4u ia_ = *(const LAS v4u*)(eidx + (i0)), ib_ = *(const LAS v4u*)(eidx + (i0) + 4); const unsigned ee_[8] = {ia_.x, ia_.y, ia_.z, ia_.w, ib_.x, ib_.y, ib_.z, ib_.w}; \
        _Pragma("unroll") for (int j_ = 0; j_ < 8; ++j_) dst[j_] = *(const GAS v4u*)((TAB) + (size_t)(ee_[j_] * 2048u + (unsigned)(soff))); } while (0)
    LAS float* dotw = (LAS float*)LIST + tk * 128;
#pragma unroll
    for (int m = 0; m < 16; ++m) dotw[8 * m + part] = 0.f;
#pragma unroll 1
    for (int p = 0; p < 16; ++p) {
        const int soff = 128 * p + 16 * part;
        h2_t xs[8];
        { const v4u x0 = *(const GAS v4u*)(X + (size_t)t * D + soff), x1 = *(const GAS v4u*)(X + (size_t)t * D + soff + 8); const unsigned xw[8] = {x0.x, x0.y, x0.z, x0.w, x1.x, x1.y, x1.z, x1.w};
#pragma unroll
          for (int e = 0; e < 8; ++e) xs[e] = (h2_t){(_Float16)bf_lo(xw[e]), (_Float16)bf_hi(xw[e])}; }
#define PEER_UDOT8(src, m_) do { float tt_[8]; \
        _Pragma("unroll") for (int j_ = 0; j_ < 8; ++j_) { const unsigned ww_[4] = {src[j_].x, src[j_].y, src[j_].z, src[j_].w}; float a0_ = 0.f, a1_ = 0.f; \
            _Pragma("unroll") for (int e_ = 0; e_ < 4; ++e_) { const h2_t lo_ = __builtin_amdgcn_cvt_scalef32_pk_f16_fp8((int)ww_[e_], 1.0f / 512.0f, false), hi_ = __builtin_amdgcn_cvt_scalef32_pk_f16_fp8((int)ww_[e_], 1.0f / 512.0f, true); \
                a0_ = __builtin_amdgcn_fdot2(xs[2 * e_], lo_, a0_, false); a1_ = __builtin_amdgcn_fdot2(xs[2 * e_ + 1], hi_, a1_, false); } \
            tt_[j_] = a0_ + a1_; } \
        sum8_x8(tt_); \
        float sel_ = tt_[0]; _Pragma("unroll") for (int j_ = 1; j_ < 8; ++j_) sel_ = (part == j_) ? tt_[j_] : sel_; \
        dotw[8 * (m_) + part] += sel_; } while (0)
        v4u ua[8], ub[8];
        PEER_LOAD8(ua, TU, 0, soff);
#pragma unroll 1
        for (int m = 0; m < 16; m += 2) {
            PEER_LOAD8(ub, TU, 8 * (m + 1), soff);
            PEER_UDOT8(ua, m);
            if (m + 2 < 16) PEER_LOAD8(ua, TU, 8 * (m + 2), soff);
            PEER_UDOT8(ub, m + 1);
        }
    }
#undef PEER_UDOT8
#pragma unroll
    for (int m = 0; m < 16; ++m) { const float d_ = dotw[8 * m + part] * rs; const float act = 0.5f * d_ * (1.0f + erff(d_ * 0.7071067811865476f)); ecoef[8 * m + part] *= act; }
    LDS_WAIT(); asm volatile("" ::: "memory");
    float ss = 0.f;
#pragma unroll 1
    for (int p = 0; p < 16; ++p) {
        const int soff = 128 * p + 16 * part;
        h2_t acc[8];
#pragma unroll
        for (int i = 0; i < 8; ++i) acc[i] = (h2_t){(_Float16)0.f, (_Float16)0.f};
#define PEER_VACC8(src, i0) do { const f32x4 ca_ = *(const LAS f32x4*)(ecoef + (i0)), cb_ = *(const LAS f32x4*)(ecoef + (i0) + 4); const float cf_[8] = {ca_[0], ca_[1], ca_[2], ca_[3], cb_[0], cb_[1], cb_[2], cb_[3]}; \
        _Pragma("unroll") for (int j_ = 0; j_ < 8; ++j_) { const unsigned ww_[4] = {src[j_].x, src[j_].y, src[j_].z, src[j_].w}; const _Float16 ch_ = (_Float16)cf_[j_]; const h2_t c2_ = {ch_, ch_}; \
            _Pragma("unroll") for (int e_ = 0; e_ < 4; ++e_) { const h2_t lo_ = __builtin_amdgcn_cvt_scalef32_pk_f16_fp8((int)ww_[e_], 1.0f / 16.0f, false), hi_ = __builtin_amdgcn_cvt_scalef32_pk_f16_fp8((int)ww_[e_], 1.0f / 16.0f, true); \
                acc[2 * e_] = c2_ * lo_ + acc[2 * e_]; acc[2 * e_ + 1] = c2_ * hi_ + acc[2 * e_ + 1]; } } } while (0)
        v4u va[8], vb[8];
        PEER_LOAD8(va, TV, 0, soff);
#pragma unroll 1
        for (int m = 0; m < 16; m += 2) {
            PEER_LOAD8(vb, TV, 8 * (m + 1), soff);
            PEER_VACC8(va, 8 * m);
            if (m + 2 < 16) PEER_LOAD8(va, TV, 8 * (m + 2), soff);
            PEER_VACC8(vb, 8 * (m + 1));
        }
        { const v4u h0 = *(const GAS v4u*)(Hin + (size_t)t * D + soff), h1 = *(const GAS v4u*)(Hin + (size_t)t * D + soff + 8); const unsigned hw[8] = {h0.x, h0.y, h0.z, h0.w, h1.x, h1.y, h1.z, h1.w}; unsigned ow[8];
#pragma unroll
          for (int e = 0; e < 8; ++e) { ow[e] = hw_pk2(bf_lo(hw[e]) + (float)acc[e][0], bf_hi(hw[e]) + (float)acc[e][1]); const float q0 = bf_lo(ow[e]), q1 = bf_hi(ow[e]); ss += q0 * q0 + q1 * q1; }
          v4u o0, o1; o0.x = ow[0]; o0.y = ow[1]; o0.z = ow[2]; o0.w = ow[3]; o1.x = ow[4]; o1.y = ow[5]; o1.z = ow[6]; o1.w = ow[7];
          if (!dry) { *(GAS v4u*)(Hout + (size_t)t * D + soff) = o0; *(GAS v4u*)(Hout + (size_t)t * D + soff + 8) = o1; } else asm volatile("" :: "v"(o0.x), "v"(o0.y), "v"(o0.z), "v"(o0.w), "v"(o1.x), "v"(o1.y), "v"(o1.z), "v"(o1.w)); }
    }
#undef PEER_VACC8
#undef PEER_LOAD8
    const float r3 = __builtin_amdgcn_rsqf(sum8_x1(ss) * (1.0f / D) + EPS);
    if (!dry && part == 0) RS3[t] = r3;
}

constexpr int N_PHASES = 19;
__global__ void __launch_bounds__(NTHREADS, 2) mega_fwd(Args args) {
    extern __shared__ __attribute__((aligned(16))) unsigned char lds[];
    Frame F;
    F.lds = (LAS unsigned char*)lds;
    F.MISC = (volatile LAS unsigned*)(F.lds + MISC_OFF);
    F.tid = threadIdx.x; F.lane = F.tid & 63; F.wave = __builtin_amdgcn_readfirstlane(F.tid >> 6);
    F.G = gridDim.x; { const int bx = blockIdx.x; F.vcu = (F.G % 8 == 0) ? (bx % 8) * (F.G / 8) + bx / 8 : bx; }
    unsigned char* ws = args.ws;
    F.ctl = (gu32*)(ws + WS_CTL);
    for (int u = F.tid; u < (LDS_BYTES - LDSCTL_OFF) / 4; u += NTHREADS) ((LAS unsigned*)(F.lds + LDSCTL_OFF))[u] = 0u;
    __syncthreads();
    const int lo = args.ph_lo, hi = args.ph_hi;
    XcdBarrier bar; bar.bar = (unsigned*)(F.ctl + CW_BAR); bar.x = 0; bar.st = nullptr;
    if (hi - lo > 1) bar = xcd_barrier_post((unsigned*)(F.ctl + CW_BAR), F.MISC + 8);
#define IN(k) (lo <= (k) && (k) < hi)
#define REPS(k) (1 + ((DUP_MASK >> (k)) & 1))
#if PROBE_MASK
    unsigned long long* const tsb = (unsigned long long*)(ws + WS_CTL + 65536);
#define STAMP(k) do { if (blockIdx.x == 0 && F.tid == 0) __hip_atomic_store(tsb + (k), __builtin_amdgcn_s_memrealtime(), __ATOMIC_RELAXED, __HIP_MEMORY_SCOPE_AGENT); } while (0)
    STAMP(31);
#else
#define STAMP(k) do { } while (0)
#endif
#define SEAM(k) do { if (IN(k) && IN((k) + 1)) { if ((k) == 0) { cg::this_grid().sync(); } else { xcd_barrier(bar); } STAMP(k); } } while (0)
    float* rowss = (float*)(ws + WS_RSP);
    bf16* ACTA = (bf16*)(ws + WS_ACTA); bf16* ACTB = (bf16*)(ws + WS_ACTB); bf16* H1 = (bf16*)(ws + WS_H1); const float* RS3 = (const float*)(ws + WS_RS3);
    bf16* PROJ = (bf16*)(ws + WS_PROJ); bf16* SCB = (bf16*)(ws + WS_SC); bf16* PP = (bf16*)(ws + WS_PP);
    const int gtid = (F.vcu * NWAVES + F.wave) * 64 + F.lane, gthreads = F.G * NTHREADS;

#if UBENCH
    {
        typedef _Float16 h2_t __attribute__((ext_vector_type(2)));
        float a[32]; f32x2 p[16]; h2_t hh[32];
#pragma unroll
        for (int i = 0; i < 32; ++i) { a[i] = (float)(F.tid + i); hh[i] = (h2_t){(_Float16)(F.lane + i), (_Float16)i}; }
#pragma unroll
        for (int i = 0; i < 16; ++i) p[i] = (f32x2){a[2 * i], a[2 * i + 1]};
        const float m = 1.0f + 1e-7f * F.lane, c = 1e-9f; const f32x2 m2 = {m, m}, c2 = {c, c}; const h2_t mh = {(_Float16)1.0f, (_Float16)1.0f}, ch = {(_Float16)0.0f, (_Float16)0.0f};
#pragma unroll 1
        for (int it = 0; it < 10000; ++it) {
#if UBENCH == 1
#pragma unroll
            for (int i = 0; i < 32; ++i) asm volatile("v_fma_f32 %0, %0, %1, %2" : "+v"(a[i]) : "v"(m), "v"(c));
#elif UBENCH == 2
#pragma unroll
            for (int i = 0; i < 16; ++i) asm volatile("v_pk_fma_f32 %0, %0, %1, %2\n\tv_pk_fma_f32 %0, %0, %1, %2" : "+v"(p[i]) : "v"(m2), "v"(c2));
#elif UBENCH == 3
#pragma unroll
            for (int i = 0; i < 32; ++i) asm volatile("v_pk_fma_f16 %0, %0, %1, %2" : "+v"(hh[i]) : "v"(mh), "v"(ch));
#endif
        }
        float s = 0.f;
#pragma unroll
        for (int i = 0; i < 32; ++i) s += a[i] + (float)hh[i][0];
#pragma unroll
        for (int i = 0; i < 16; ++i) s += p[i][0] + p[i][1];
        if (s == 12345.678f) args.out[0] = s;
    }
#endif
    if (IN(0)) { p0_prologue(args, F); } SEAM(0);
    if (IN(1)) for (int rep_ = 0; rep_ < REPS(1); ++rep_) {
        { pg8::Gemm g{ACTA, (const bf16*)(ws + WS_WEV_IN), T, EV_NP, D}; pg8::StaticOrder S; S.init(T, EV_NP, F.G, (int)blockIdx.x); EpiBf16S E{PROJ, PROJ_LD, nullptr};
          pg8::gemm_phase<EpiBf16S, pg8::StaticOrder, true, true>(F.lds + RING_OFF, g, S, E); }
    } SEAM(1);
    if (IN(2)) for (int rep_ = 0; rep_ < REPS(2); ++rep_) {
        if (F.G >= 256) {
            const int u = F.vcu;
            if (u < 64) scan_gla_mfma_unit<0>(args, F, u); else if (u < 128) scan_gdn_mfma_unit(args, F, u - 64, 0); else if (u < 192) scan_gdn_mfma_unit(args, F, u - 128, 1);
            __syncthreads();
            if (rep_ == 0) for (int dr_ = 0; dr_ < 1 + ((DUP_MASK >> 22) & 1); ++dr_) { if (u < 64) p0_deferred(args, F, 128 + u, 192); else if (u >= 192) for (int k = 0; k < 2; ++k) p0_deferred(args, F, 2 * (u - 192) + k, 192); }
        } else {
            for (int u = F.vcu; u < 64; u += F.G) { scan_gla_mfma_unit<0>(args, F, u); __syncthreads(); }
            for (int u = F.vcu; u < 64; u += F.G) { scan_gdn_mfma_unit(args, F, u, 0); __syncthreads(); scan_gdn_mfma_unit(args, F, u, 1); __syncthreads(); }
            if (rep_ == 0) p0_deferred(args, F, F.vcu, F.G);
        }
    } SEAM(2);
    if (IN(3)) for (int rep_ = 0; rep_ < REPS(3); ++rep_) { post_rows<0>(args, F); } SEAM(3);
    if (IN(4)) { pg8::Gemm g{ACTA, (const bf16*)(ws + WS_WEV_OUT), T, D, D}; pg8::StaticOrder S; S.init(T, D, F.G, (int)blockIdx.x);
        EpiResid<false, true> E{args.in[I_X], ACTB, rowss + (size_t)RS_FFN0 * T * 32, nullptr, nullptr};
        pg8::gemm_phase<EpiResid<false, true>, pg8::StaticOrder, true, true>(F.lds + RING_OFF, g, S, E); }
#if (DUP_MASK >> 20) & 1
    if (IN(4)) { pg8::Gemm g{ACTA, (const bf16*)(ws + WS_WEV_OUT), T, D, D}; pg8::StaticOrder S; S.init(T, D, F.G, (int)blockIdx.x);
        EpiResid<false, true> E{args.in[I_X], ACTB, rowss + (size_t)RS_FFN0 * T * 32, nullptr, nullptr};
        pg8::gemm_phase<EpiResid<false, true>, pg8::StaticOrder, true, true>(F.lds + RING_OFF, g, S, E); }
#endif
#if (DUP_MASK >> 21) & 1
    if (IN(4)) { pg8::Gemm g{ACTA, (const bf16*)(ws + WS_WEV_IN), T, EV_NP, D}; pg8::StaticOrder S; S.init(T, EV_NP, F.G, (int)blockIdx.x); EpiBf16S E{PROJ, PROJ_LD, nullptr};
        pg8::gemm_phase<EpiBf16S, pg8::StaticOrder, true, true>(F.lds + RING_OFF, g, S, E); }
#endif
    SEAM(4);
    if (IN(5)) for (int rep_ = 0; rep_ < REPS(5); ++rep_) { { pg8::Gemm g{ACTB, (const bf16*)(ws + WS_WPEER), T, D, D}; pg8::StaticOrder S; S.init(T, D, F.G, (int)blockIdx.x); EpiBf16S E{SCB, D, rowss + (size_t)RS_FFN0 * T * 32};
        pg8::gemm_phase<EpiBf16S, pg8::StaticOrder, true, true>(F.lds + RING_OFF, g, S, E); }
        { pg8::Gemm g{(const bf16*)(ws + WS_PBF), (const bf16*)(ws + WS_WPROJ), T, D, 256}; pg8::StaticOrder S; S.init(T, D, F.G, (int)blockIdx.x); EpiBf16S E{PP, D, nullptr};
          pg8::gemm_phase<EpiBf16S, pg8::StaticOrder, true, true>(F.lds + RING_OFF, g, S, E); } } SEAM(5);
    if (IN(6)) for (int rep_ = 0; rep_ < REPS(6); ++rep_) { peer_phase(args, F, 0, rep_ != 0, ACTB, H1); } SEAM(6);
    if (IN(7)) { { pg8::Gemm g{H1, (const bf16*)(ws + WS_WGATE), T, D, D}; pg8::StaticOrder S; S.init(T, D, F.G, (int)blockIdx.x);
        EpiResid<true, false> E{H1, ACTB, rowss + (size_t)RS_MIX1 * T * 32, PP, RS3};
        pg8::gemm_phase<EpiResid<true, false>, pg8::StaticOrder, true, true>(F.lds + RING_OFF, g, S, E); }
        } SEAM(7);
    if (IN(8)) for (int rep_ = 0; rep_ < REPS(8); ++rep_) {
        { pg8::Gemm g{ACTB, (const bf16*)(ws + WS_WOD_IN), T, OD_NP, D}; pg8::StaticOrder S; S.init(T, OD_NP, F.G, (int)blockIdx.x); EpiBf16S E{PROJ, PROJ_LD, rowss + (size_t)RS_MIX1 * T * 32};
          pg8::gemm_phase<EpiBf16S, pg8::StaticOrder, true, true>(F.lds + RING_OFF, g, S, E); }
        { pg8::Gemm g{(const bf16*)(ws + WS_PBF) + (size_t)T * 256, (const bf16*)(ws + WS_WPROJ) + (size_t)D * 256, T, D, 256}; pg8::StaticOrder S; S.init(T, D, F.G, (int)blockIdx.x); EpiBf16S E{PP, D, nullptr};
          pg8::gemm_phase<EpiBf16S, pg8::StaticOrder, true, true>(F.lds + RING_OFF, g, S, E); }
    } SEAM(8);
    if (IN(9)) for (int rep_ = 0; rep_ < REPS(9); ++rep_) { lora_prep_rows(args, F); } SEAM(9);
    if (IN(10)) for (int rep_ = 0; rep_ < REPS(10); ++rep_) { pg8::Gemm g{(const bf16*)(ws + WS_LA), (const bf16*)(ws + WS_WLORA), T, LORA_N, LORA_K}; pg8::StaticOrder S; S.init(T, LORA_N, F.G, (int)blockIdx.x); EpiBf16S E{(bf16*)(ws + WS_LO), LORA_N, nullptr};
        pg8::gemm_phase<EpiBf16S, pg8::StaticOrder, true, true>(F.lds + RING_OFF, g, S, E); } SEAM(10);
    if (IN(11)) for (int rep_ = 0; rep_ < REPS(11); ++rep_) {
        if (F.G >= 256) {
            const int u = F.vcu;
            if (u < 64) scan_gla_mfma_unit<1>(args, F, u); else if (u < 128) scan_rwkv_mfma_unit(args, F, u - 64, 0); else if (u < 192) scan_rwkv_mfma_unit(args, F, u - 128, 1);
            __syncthreads();
            if (rep_ == 0) for (int dr_ = 0; dr_ < 1 + ((DUP_MASK >> 23) & 1); ++dr_) { if (u < 64) p1_deferred(args, F, 128 + u, 192); else if (u >= 192) for (int k = 0; k < 2; ++k) p1_deferred(args, F, 2 * (u - 192) + k, 192); }
        } else {
            for (int u = F.vcu; u < 64; u += F.G) { scan_gla_mfma_unit<1>(args, F, u); __syncthreads(); }
            for (int u = F.vcu; u < 64; u += F.G) { scan_rwkv_mfma_unit(args, F, u, 0); __syncthreads(); scan_rwkv_mfma_unit(args, F, u, 1); __syncthreads(); }
            if (rep_ == 0) p1_deferred(args, F, F.vcu, F.G);
        }
    } SEAM(11);
    if (IN(12)) for (int rep_ = 0; rep_ < REPS(12); ++rep_) { post_rows<1>(args, F); } SEAM(12);
    if (IN(13)) { pg8::Gemm g{ACTA, (const bf16*)(ws + WS_WOD_OUT), T, D, D}; pg8::StaticOrder S; S.init(T, D, F.G, (int)blockIdx.x);
        EpiResid<false, false> E{ACTB, H1, rowss + (size_t)RS_FFN1 * T * 32, nullptr, nullptr};
        pg8::gemm_phase<EpiResid<false, false>, pg8::StaticOrder, true, true>(F.lds + RING_OFF, g, S, E); } SEAM(13);
    if (IN(14)) for (int rep_ = 0; rep_ < REPS(14); ++rep_) { pg8::Gemm g{H1, (const bf16*)(ws + WS_WPEER) + (size_t)D * D, T, D, D}; pg8::StaticOrder S; S.init(T, D, F.G, (int)blockIdx.x); EpiBf16S E{SCB, D, rowss + (size_t)RS_FFN1 * T * 32};
        pg8::gemm_phase<EpiBf16S, pg8::StaticOrder, true, true>(F.lds + RING_OFF, g, S, E); } SEAM(14);
    if (IN(15)) for (int rep_ = 0; rep_ < REPS(15); ++rep_) { peer_phase(args, F, 1, rep_ != 0, H1, ACTB); } SEAM(15);
    if (IN(16)) { pg8::Gemm g{ACTB, (const bf16*)(ws + WS_WGATE) + (size_t)D * D, T, D, D}; pg8::StaticOrder S; S.init(T, D, F.G, (int)blockIdx.x);
        EpiResid<true, false> E{ACTB, H1, rowss + (size_t)RS_FINAL * T * 32, PP, RS3};
        pg8::gemm_phase<EpiResid<true, false>, pg8::StaticOrder, true, true>(F.lds + RING_OFF, g, S, E); } SEAM(16);
    if (IN(17)) {
        float oscale = 1.0f;
#if PROBE_MASK
        { unsigned long long t_prev = __hip_atomic_load(tsb + 31, __ATOMIC_RELAXED, __HIP_MEMORY_SCOPE_AGENT); const unsigned long long t_begin = t_prev; unsigned long long sel = 0ull;
          for (int k = 0; k <= 16; ++k) { const unsigned long long tk = __hip_atomic_load(tsb + k, __ATOMIC_RELAXED, __HIP_MEMORY_SCOPE_AGENT); if ((PROBE_MASK >> k) & 1) sel += tk - t_prev; t_prev = tk; }
          const float f = (float)(double(sel) / double(t_prev - t_begin)); oscale = 1.0f + sqrtf(0.01f + 0.9f * f); }
#endif
        final_rows(args, F, oscale, H1); }
#undef IN
#undef SEAM
}

extern "C" void kernel_launch(void* const* d_in, const int* in_sizes, int n_in, void* d_out, int out_size, void* d_ws, size_t ws_size, hipStream_t stream) {
    static int grid = 0;
    if (grid == 0) {
        if (n_in != N_IN || out_size != T * D || ws_size < WS_END + 63 * MiB) { fprintf(stderr, "kernel_launch: unexpected problem: n_in %d out %d ws %zu (need %zu)\n", n_in, out_size, ws_size, (size_t)(WS_END + 63 * MiB)); grid = -1; return; }
        int dev = 0, cus = 0, per_cu = 0;
        if (hipGetDevice(&dev) != hipSuccess || hipDeviceGetAttribute(&cus, hipDeviceAttributeMultiprocessorCount, dev) != hipSuccess) { grid = -1; return; }
        if (hipFuncSetAttribute((const void*)mega_fwd, hipFuncAttributeMaxDynamicSharedMemorySize, LDS_BYTES) != hipSuccess) { fprintf(stderr, "kernel_launch: hipFuncSetAttribute failed\n"); grid = -1; return; }
        if (hipOccupancyMaxActiveBlocksPerMultiprocessor(&per_cu, (const void*)mega_fwd, NTHREADS, LDS_BYTES) != hipSuccess || per_cu < 1) { fprintf(stderr, "kernel_launch: occupancy query says %d blocks per CU\n", per_cu); (void)hipGetLastError(); grid = -1; return; }
        grid = cus;
    }
    if (grid < 0) return;
    (void)hipMemsetAsync((char*)d_ws + WS_CTL, 0, CTL_ZERO_BYTES, stream);
    Args a{};
    for (int i = 0; i < N_IN; ++i) a.in[i] = (const float*)d_in[i];
    a.out = (float*)d_out; a.ws = (unsigned char*)d_ws;
#if MK_PER_PHASE
    for (int p = 0; p < N_PHASES - 1; ++p) { a.ph_lo = p; a.ph_hi = p + 1; hipLaunchKernelGGL(mega_fwd, dim3(grid), dim3(NTHREADS), LDS_BYTES, stream, a); }
#else
    a.ph_lo = 0; a.ph_hi = N_PHASES;
    void* kargs[] = {&a};
    hipError_t e = hipLaunchCooperativeKernel((const void*)mega_fwd, dim3(grid), dim3(NTHREADS), kargs, LDS_BYTES, stream);
    if (e != hipSuccess) fprintf(stderr, "kernel_launch: cooperative launch failed: %s (grid %d)\n", hipGetErrorString(e), grid);
#endif
}
```

```cpp
#include <hip/hip_runtime.h>
#include <hip/hip_cooperative_groups.h>
#include <cstdio>
#include <cstdint>
namespace cg = cooperative_groups;

#ifndef PROBE_MASK
#define PROBE_MASK 0
#endif
#ifndef DUP_MASK
#define DUP_MASK 0
#endif
#ifndef UBENCH
#define UBENCH 0
#endif
#ifndef GDN_DUP
#define GDN_DUP 0
#endif
#ifndef MK_PER_PHASE
#define MK_PER_PHASE 0
#endif

namespace pg8 {
#define PG8_LAS __attribute__((address_space(3)))
typedef unsigned short bf16_t;
typedef short bf16x8 __attribute__((ext_vector_type(8)));
typedef float f32x4 __attribute__((ext_vector_type(4)));
typedef unsigned u32x4 __attribute__((ext_vector_type(4)));
typedef unsigned u32x2 __attribute__((ext_vector_type(2)));
constexpr int BM = 256, BK = 64, HALF = 128, HTB = HALF * BK * 2  , STAGE_BYTES = 8 * HTB, NXCD = 8, WGM = 8;

__host__ __device__ __forceinline__ int lds_byte(int r, int c) { const int st = (r >> 4) * 2 + (c >> 5), rr = r & 15, cc = c & 31, ob = rr * 64 + cc * 2; return st * 1024 + (ob ^ (((ob >> 9) & 1) << 5)); }
__host__ __device__ __forceinline__ void stage_rc(int b, int& R, int& C) { const int st = b / 1024, sb = b % 1024, swz = sb ^ (((sb >> 9) & 1) << 5); R = (st >> 1) * 16 + swz / 64; C = (st & 1) * 32 + (swz % 64) / 2; }
__host__ __device__ __forceinline__ int perm32(int rho) { const int n = rho >> 4, i = rho & 15; return 8 * (i >> 2) + 4 * n + (i & 3); }

struct Unit { int pm, pn; };
struct Gemm { const bf16_t* A; const bf16_t* Bt; int M, N, K; };

struct StaticOrder {
    int nM, nN, nwg, G, c;
    __host__ __device__ void init(int M, int N, int G_, int c_) { nM = M / BM; nN = N / BM; nwg = nM * nN; G = G_; c = c_; }
    __host__ __device__ bool next(int i, Unit& u) const {
        const long L = (long)i * G + c; if (L >= nwg) return false;
        int wgid = (int)L; { const int q = nwg / NXCD, r = nwg % NXCD, xcd = wgid % NXCD, off = wgid / NXCD; wgid = (xcd < r ? xcd * (q + 1) : r * (q + 1) + (xcd - r) * q) + off; }
        const int nig = WGM * nN, gid = wgid / nig, fm = gid * WGM, gsz = (nM - fm) < WGM ? (nM - fm) : WGM;
        u.pm = fm + ((wgid % nig) % gsz); u.pn = (wgid % nig) / gsz; return true;
    }
    __device__ __forceinline__ void a_ready(const Unit&) const {}
    __device__ __forceinline__ void done(const Unit&) const {}
};
__device__ __forceinline__ unsigned cvt_pk_bf16(float lo, float hi) { unsigned r; asm volatile("v_cvt_pk_bf16_f32 %0, %1, %2" : "=v"(r) : "v"(lo), "v"(hi)); return r; }
template <class Epi, class Sched, bool ALIGN_EPI = false, bool SP2 = false>
__device__ __forceinline__ void gemm_phase(PG8_LAS unsigned char* lds, const Gemm g, const Sched& S, const Epi& E) {
    const int tid = threadIdx.x, wid = __builtin_amdgcn_readfirstlane(tid >> 6), lane = tid & 63, wr = wid >> 2, wc = wid & 3, fr = lane & 15, fq = lane >> 4;
    const int K = g.K, nt = K / BK;
    unsigned voffA[2], voffB[2];
#pragma unroll
    for (int i = 0; i < 2; ++i) { int R, C; stage_rc(tid * 16 + i * 8192, R, C); const int Rb = Epi::PERM ? ((R & ~31) + perm32(R & 31)) : R;
        voffA[i] = (unsigned)(R * K + C) * 2u; voffB[i] = (unsigned)(Rb * K + C) * 2u; }
    const size_t kstep = (size_t)(BK * 2);
    const size_t hstep = (size_t)HALF * K * 2;
    const size_t tstep = 2 * hstep;
    const unsigned ldsw = (unsigned)wid * 1024u;
    const int aoff = lds_byte(wr * 64 + fr, fq * 8), boff = lds_byte(wc * 32 + fr, fq * 8);
#define PG8_SA(b, h) (((b) * 2 + (h)) * HTB)
#define PG8_SB(b, h) ((4 + (b) * 2 + (h)) * HTB)
#define PG8_STAGE(bufoff, gbase, voff) do { _Pragma("unroll") for (int _i = 0; _i < 2; ++_i) \
        __builtin_amdgcn_global_load_lds((const unsigned*)((const char*)(gbase) + (voff)[_i]), (PG8_LAS unsigned*)(lds + (bufoff) + ldsw + _i * 8192), 16, 0, 0); } while (0)
#define PG8_LDA(dst, b, h) do { _Pragma("unroll") for (int m = 0; m < 4; ++m) _Pragma("unroll") for (int k = 0; k < 2; ++k) dst[m][k] = *(const PG8_LAS bf16x8*)(lds + PG8_SA(b, h) + aoff + m * 2048 + k * 1024); } while (0)
#define PG8_LDB(dst, b, h) do { _Pragma("unroll") for (int n = 0; n < 2; ++n) _Pragma("unroll") for (int k = 0; k < 2; ++k) dst[n][k] = *(const PG8_LAS bf16x8*)(lds + PG8_SB(b, h) + boff + n * 2048 + k * 1024); } while (0)
#define PG8_MMA(ai, bj, At, Bt) do { __builtin_amdgcn_s_setprio(1); _Pragma("unroll") for (int m = 0; m < 4; ++m) _Pragma("unroll") for (int n = 0; n < 2; ++n) _Pragma("unroll") for (int k = 0; k < 2; ++k) \
        acc[ai][bj][m][n] = __builtin_amdgcn_mfma_f32_16x16x32_bf16(Bt[n][k], At[m][k], acc[ai][bj][m][n], 0, 0, 0); __builtin_amdgcn_s_setprio(0); } while (0)
#define PG8_WAIT_V(n) asm volatile("s_waitcnt vmcnt(" #n ")" ::: "memory")
#define PG8_WAIT_L(n) asm volatile("s_waitcnt lgkmcnt(" #n ")" ::: "memory")
#define PG8_BAR __builtin_amdgcn_s_barrier()
#define PG8_SCHED __builtin_amdgcn_sched_barrier(0)
    Unit cur, nxt; int ui = 0;
    if (!S.next(0, cur)) return;
    f32x4 acc[2][2][4][2];
#pragma unroll
    for (int a = 0; a < 2; ++a)
#pragma unroll
        for (int b = 0; b < 2; ++b)
#pragma unroll
            for (int m = 0; m < 4; ++m)
#pragma unroll
                for (int n = 0; n < 2; ++n) acc[a][b][m][n] = (f32x4){0.f, 0.f, 0.f, 0.f};
    bf16x8 At[4][2], B0[2][2], B1[2][2];
    const char* cA = (const char*)g.A + (size_t)cur.pm * tstep; const char* cB = (const char*)g.Bt + (size_t)cur.pn * tstep;
    S.a_ready(cur);
    if constexpr (SP2) {
        PG8_STAGE(PG8_SB(0, 0), cB, voffB); PG8_STAGE(PG8_SB(0, 1), cB + hstep, voffB); PG8_STAGE(PG8_SA(0, 0), cA, voffA); PG8_STAGE(PG8_SA(0, 1), cA + hstep, voffA);
        if (wr == 1) PG8_BAR;
        PG8_WAIT_V(2); PG8_BAR;
        PG8_STAGE(PG8_SB(1, 0), cB + kstep, voffB); PG8_STAGE(PG8_SA(1, 0), cA + kstep, voffA); PG8_STAGE(PG8_SB(1, 1), cB + hstep + kstep, voffB);
        PG8_WAIT_V(6); PG8_BAR;
    } else {
        PG8_STAGE(PG8_SB(0, 0), cB, voffB); PG8_STAGE(PG8_SA(0, 0), cA, voffA); PG8_STAGE(PG8_SB(0, 1), cB + hstep, voffB); PG8_STAGE(PG8_SA(0, 1), cA + hstep, voffA);
        if (wr == 1) PG8_BAR;
        PG8_WAIT_V(4); PG8_BAR;
        PG8_STAGE(PG8_SB(1, 0), cB + kstep, voffB); PG8_STAGE(PG8_SA(1, 0), cA + kstep, voffA); PG8_STAGE(PG8_SB(1, 1), cB + hstep + kstep, voffB);
        PG8_WAIT_V(6); PG8_BAR;
    }
    for (;;) {
        const bool has_next = S.next(ui + 1, nxt);
        const char* nA = has_next ? (const char*)g.A + (size_t)nxt.pm * tstep : cA; const char* nB = has_next ? (const char*)g.Bt + (size_t)nxt.pn * tstep : cB;
        for (int t = 0; t < nt; t += 2) {
            const bool last = (t == nt - 2);
            const char* a1 = cA + (size_t)(t + 1) * kstep;
            const char* a2 = last ? nA : cA + (size_t)(t + 2) * kstep; const char* b2 = last ? nB : cB + (size_t)(t + 2) * kstep;
            const char* a3 = a2 + kstep; const char* b3 = b2 + kstep;
            if (last && has_next) S.a_ready(nxt);
            if constexpr (SP2) {
            PG8_LDB(B0, 0, 0); PG8_LDB(B1, 0, 1); PG8_SCHED; PG8_LDA(At, 0, 0); PG8_STAGE(PG8_SA(1, 1), a1 + hstep, voffA);
            PG8_WAIT_V(8); PG8_WAIT_L(0); PG8_BAR; PG8_MMA(0, 0, At, B0); PG8_MMA(0, 1, At, B1); PG8_BAR; PG8_SCHED;
            PG8_LDA(At, 0, 1); PG8_STAGE(PG8_SB(0, 0), b2, voffB); PG8_STAGE(PG8_SB(0, 1), b2 + hstep, voffB); PG8_STAGE(PG8_SA(0, 0), a2, voffA);
            PG8_WAIT_V(8); PG8_WAIT_L(0); PG8_BAR; PG8_MMA(1, 0, At, B0); PG8_MMA(1, 1, At, B1); PG8_BAR; PG8_SCHED;
            PG8_LDB(B0, 1, 0); PG8_LDB(B1, 1, 1); PG8_SCHED; PG8_LDA(At, 1, 0); PG8_STAGE(PG8_SA(0, 1), a2 + hstep, voffA);
            PG8_WAIT_V(8); PG8_WAIT_L(0); PG8_BAR; PG8_MMA(0, 0, At, B0); PG8_MMA(0, 1, At, B1); PG8_BAR; PG8_SCHED;
            PG8_LDA(At, 1, 1); PG8_STAGE(PG8_SB(1, 0), b3, voffB); PG8_STAGE(PG8_SB(1, 1), b3 + hstep, voffB); PG8_STAGE(PG8_SA(1, 0), a3, voffA);
            PG8_WAIT_V(8); PG8_WAIT_L(0); PG8_BAR; PG8_MMA(1, 0, At, B0); PG8_MMA(1, 1, At, B1); PG8_BAR; PG8_SCHED;
            } else {
            PG8_LDB(B0, 0, 0); PG8_SCHED; PG8_LDA(At, 0, 0); PG8_STAGE(PG8_SA(1, 1), a1 + hstep, voffA);
            PG8_WAIT_L(8); PG8_BAR; PG8_WAIT_L(0); PG8_MMA(0, 0, At, B0); PG8_BAR; PG8_SCHED;
            PG8_LDB(B1, 0, 1); PG8_STAGE(PG8_SB(0, 0), b2, voffB);
            PG8_BAR; PG8_WAIT_L(0); PG8_MMA(0, 1, At, B1); PG8_BAR;
            PG8_LDA(At, 0, 1); PG8_STAGE(PG8_SA(0, 0), a2, voffA);
            PG8_BAR; PG8_WAIT_L(0); PG8_MMA(1, 0, At, B0); PG8_BAR; PG8_SCHED;
            PG8_STAGE(PG8_SB(0, 1), b2 + hstep, voffB);
            PG8_WAIT_V(6); PG8_BAR; PG8_MMA(1, 1, At, B1); PG8_BAR;
            PG8_LDB(B0, 1, 0); PG8_SCHED; PG8_LDA(At, 1, 0); PG8_STAGE(PG8_SA(0, 1), a2 + hstep, voffA);
            PG8_WAIT_L(8); PG8_BAR; PG8_WAIT_L(0); PG8_MMA(0, 0, At, B0); PG8_BAR; PG8_SCHED;
            PG8_LDB(B1, 1, 1); PG8_STAGE(PG8_SB(1, 0), b3, voffB);
            PG8_BAR; PG8_WAIT_L(0); PG8_MMA(0, 1, At, B1); PG8_BAR;
            PG8_LDA(At, 1, 1); PG8_STAGE(PG8_SA(1, 0), a3, voffA);
            PG8_BAR; PG8_WAIT_L(0); PG8_MMA(1, 0, At, B0); PG8_BAR; PG8_SCHED;
            PG8_STAGE(PG8_SB(1, 1), b3 + hstep, voffB);
            PG8_WAIT_V(6); PG8_BAR; PG8_MMA(1, 1, At, B1); PG8_BAR;
            }
        }
        if constexpr (ALIGN_EPI) { if (wr == 0) PG8_BAR; }
        if constexpr (!Epi::AFTER_DRAIN) { E(acc, cur, wr, wc, fr, fq); S.done(cur); }
        if (!has_next) break;
#pragma unroll
        for (int a = 0; a < 2; ++a)
#pragma unroll
            for (int b = 0; b < 2; ++b)
#pragma unroll
                for (int m = 0; m < 4; ++m)
#pragma unroll
                    for (int n = 0; n < 2; ++n) acc[a][b][m][n] = (f32x4){0.f, 0.f, 0.f, 0.f};
        cur = nxt; cA = nA; cB = nB; ++ui;
        if constexpr (ALIGN_EPI) { if (wr == 1) PG8_BAR; }
    }
    PG8_WAIT_V(0);
    if constexpr (!ALIGN_EPI) { if (wr == 0) PG8_BAR; }
    PG8_BAR;
    if constexpr (Epi::AFTER_DRAIN) { E.fused(acc, cur, wr, wc, fr, fq, lds, wid, lane); S.done(cur); }
#undef PG8_SA
#undef PG8_SB
#undef PG8_STAGE
#undef PG8_LDA
#undef PG8_LDB
#undef PG8_MMA
#undef PG8_WAIT_V
#undef PG8_WAIT_L
#undef PG8_BAR
#undef PG8_SCHED
}
}
#define GAS __attribute__((address_space(1)))
#define LAS __attribute__((address_space(3)))
typedef unsigned short bf16;
typedef unsigned v4u __attribute__((ext_vector_type(4)));
typedef float f32x4 __attribute__((ext_vector_type(4)));
typedef short bf16x8 __attribute__((ext_vector_type(8)));
typedef GAS unsigned gu32;
typedef GAS unsigned long long gu64;
#define RLX_AGENT __ATOMIC_RELAXED, __HIP_MEMORY_SCOPE_AGENT
#define LDS_WAIT() asm volatile("s_waitcnt lgkmcnt(0)" ::: "memory")
#define VM_WAIT() asm volatile("s_waitcnt vmcnt(0)" ::: "memory")
__device__ __forceinline__ unsigned long long rt() { return __builtin_amdgcn_s_memrealtime(); }
__device__ __forceinline__ unsigned f2bf(float f) { unsigned u = __builtin_bit_cast(unsigned, f); return (u + 0x7fffu + ((u >> 16) & 1u)) >> 16; }
__device__ __forceinline__ unsigned pk2(float lo, float hi) { return f2bf(lo) | (f2bf(hi) << 16); }

#define XB_TMO      128
#define XB_XCNT(j)  (256  + 64 * (j))
#define XB_XSUB(j)  (1280 + 64 * (j))
#define XB_XGEN(j)  (2304 + 64 * (j))
#define XB_TOP      3328
#define XB_TOPGEN   3392
#define XCD_BAR_WORDS 3456
#define XB_SPIN_CAP (1u << 18)

__device__ __forceinline__ unsigned xb_ld(unsigned* p)              { return __hip_atomic_load(p, __ATOMIC_RELAXED, __HIP_MEMORY_SCOPE_AGENT); }
__device__ __forceinline__ unsigned xb_add(unsigned* p, unsigned v) { return __hip_atomic_fetch_add(p, v, __ATOMIC_RELAXED, __HIP_MEMORY_SCOPE_AGENT); }
__device__ __forceinline__ unsigned xb_xcc_id() { return (unsigned)__builtin_amdgcn_s_getreg((3 << 11) | 20) & 0xFu; }
#define XB_SPIN(cond, bar) do { unsigned _sp = 0; while (cond) { __builtin_amdgcn_s_sleep(1); \
    if ((++_sp & 255u) == 0u) { if (xb_ld(&(bar)[XB_TMO])) break; if (_sp > XB_SPIN_CAP) { atomicAdd(&(bar)[XB_TMO], 1u); break; } } } } while (0)

struct XcdBarrier {
    unsigned* bar; unsigned x;
    volatile LAS unsigned* st;
};

__device__ __forceinline__ XcdBarrier xcd_barrier_post(unsigned* bar, volatile LAS unsigned* st) {
    XcdBarrier b; b.bar = bar; b.x = xb_xcc_id(); b.st = st;
    if (threadIdx.x == 0) (void)xb_add(&bar[XB_XCNT(b.x)], 1u);
    return b;
}
__device__ __forceinline__ void xcd_barrier_complete(unsigned* bar, unsigned x, unsigned& nloc, unsigned& nx) {
    const unsigned G = gridDim.x * gridDim.y * gridDim.z;
    unsigned sum, cnt, mine, sp = 0u;
    for (;;) {
        sum = 0u; cnt = 0u; mine = 0u;
#pragma unroll
        for (unsigned j = 0; j < 16; ++j) { const unsigned c = xb_ld(&bar[XB_XCNT(j)]); sum += c; cnt += (c > 0u) ? 1u : 0u; mine = (j == x) ? c : mine; }
        if (sum == G) break;
        __builtin_amdgcn_s_sleep(1);
        if ((++sp & 255u) == 0u) { if (xb_ld(&bar[XB_TMO])) break; if (sp > XB_SPIN_CAP) { atomicAdd(&bar[XB_TMO], 1u); break; } }
    }
    nloc = mine > 0u ? mine : 1u; nx = cnt > 0u ? cnt : 1u;
}

__device__ __forceinline__ void xcd_barrier(const XcdBarrier& b) {
    asm volatile("s_waitcnt vmcnt(0)" ::: "memory");
    __syncthreads();
    if (threadIdx.x == 0) {
        unsigned* bar = b.bar;
        __builtin_amdgcn_s_waitcnt(0);
        unsigned nloc = b.st[0], nx = b.st[1];
        if (nloc == 0u) { xcd_barrier_complete(bar, b.x, nloc, nx); b.st[0] = nloc; b.st[1] = nx; }
        const unsigned old = xb_add(&bar[XB_XSUB(b.x)], 1u);
        const unsigned gen = old / nloc;
        if (old + 1u == (gen + 1u) * nloc) {
            __builtin_amdgcn_fence(__ATOMIC_RELEASE, "agent");
            asm volatile("s_waitcnt vmcnt(0)" ::: "memory");
            const unsigned og = xb_add(&bar[XB_TOP], 1u);
            const unsigned tg = og / nx;
            if (og + 1u == (tg + 1u) * nx) xb_add(&bar[XB_TOPGEN], 1u);
            else XB_SPIN(xb_ld(&bar[XB_TOPGEN]) == tg, bar);
            __builtin_amdgcn_fence(__ATOMIC_ACQUIRE, "agent");
            xb_add(&bar[XB_XGEN(b.x)], 1u);
            asm volatile("s_waitcnt vmcnt(0)" ::: "memory");
        } else {
            XB_SPIN(xb_ld(&bar[XB_XGEN(b.x)]) == gen, bar);
            __builtin_amdgcn_fence(__ATOMIC_ACQUIRE, "agent");
            asm volatile("s_waitcnt vmcnt(0)" ::: "memory");
        }
    }
    __syncthreads();
}

constexpr int NWAVES = 8, NTHREADS = NWAVES * 64;
constexpr int BATCH = 8, SEQ = 2048, T = BATCH * SEQ, D = 2048;
constexpr int EV_N = 7200, EV_NP = 7424, OD_N = 7616, OD_NP = 7680, PROJ_LD = 7680;
constexpr float EPS = 1e-6f;
constexpr int EC_GQ = 0, EC_GK = 512, EC_GV = 1024, EC_GZ = 2048, EC_GLR = 3072, EC_BQ = 3088, EC_BK = 4112, EC_BV = 5136, EC_BZ = 6160, EC_BA = 7184, EC_BB = 7192;
constexpr int OC_HQ = 0, OC_HF = 1024, OC_HI = 2048, OC_HG = 3072, OC_RW = 4096;
constexpr int RW_R = 0, RW_K = 1024, RW_V = 2048, RW_WL = 3072, RW_AL = 3168, RW_GL = 3264;
constexpr int LORA_K = 512, LORA_N = 3072;
enum { I_X = 0, I_P, I_EV_WIN, I_GK_W2, I_GK_B, I_GLA_NORM, I_GDN_CONV, I_GDN_ALOG, I_GDN_DTB, I_GDN_NORM, I_EV_WOUT, I_OD_WIN, I_LB, I_HG_NORM,
       I_MU, I_W0, I_W2, I_A0, I_A2, I_G2, I_KK, I_KA, I_RK, I_LNW, I_LNB, I_OD_WOUT, I_NMIX, I_NFFN, I_NPLE, I_PEER_WQ, I_PEER_SK, I_PEER_U, I_PEER_V,
       I_PLE_WP, I_PLE_WG, I_NFINAL, N_IN };

constexpr size_t MiB = 1u << 20;
constexpr size_t WS_CTL = 0, CTL_ZERO_BYTES = 1 * MiB;
constexpr size_t WS_WEV_IN = 1 * MiB, WS_WEV_OUT = 30 * MiB, WS_WOD_IN = 38 * MiB, WS_WOD_OUT = 68 * MiB, WS_WPEER = 76 * MiB, WS_WGATE = 92 * MiB, WS_WPROJ = 108 * MiB,
                 WS_WLORA = 110 * MiB, WS_PBF = 113 * MiB, WS_TABU = 129 * MiB, WS_TABV = 193 * MiB, WS_ACTA = 257 * MiB, WS_ACTB = 321 * MiB, WS_PROJ = 385 * MiB, WS_SC = 385 * MiB,
                 WS_O = 625 * MiB, WS_H1 = 689 * MiB, WS_PP = 753 * MiB, WS_LA = 817 * MiB, WS_LO = 833 * MiB, WS_RSP = 929 * MiB, WS_STATE = 937 * MiB, WS_RS3 = 945 * MiB, WS_END = 946 * MiB;
static_assert(WS_WEV_IN + (size_t)EV_NP * D * 2 <= WS_WEV_OUT && WS_WOD_IN + (size_t)OD_NP * D * 2 <= WS_WOD_OUT && WS_PROJ + (size_t)T * PROJ_LD * 2 <= WS_O, "ws map");
constexpr int CW_BAR = 4096;
enum { RS_FFN0 = 0, RS_MIX1 = 1, RS_FFN1 = 2, RS_FINAL = 3 };
constexpr int RING_OFF = 0, RING_BYTES = 131072;
constexpr int LDSCTL_OFF = RING_BYTES, MISC_OFF = LDSCTL_OFF + 320;
constexpr int LDS_BYTES = 147456;

struct Args { const float* in[N_IN]; float* out; unsigned char* ws; int ph_lo, ph_hi; };
struct Frame {
    LAS unsigned char* lds; volatile LAS unsigned* MISC; gu32* ctl;
    int tid, lane, wave, vcu, G;
};
__device__ __forceinline__ float wave_sum(float v) {
#pragma unroll
    for (int o = 1; o < 64; o <<= 1) v += __shfl_xor(v, o);
    return v;
}
__device__ __forceinline__ float half_sum32(float v) {
#pragma unroll
    for (int o = 1; o < 32; o <<= 1) v += __shfl_xor(v, o);
    return v;
}
#define DPP_ADD(v, ctrl) (v) += __builtin_bit_cast(float, __builtin_amdgcn_update_dpp(0, __builtin_bit_cast(int, (v)), (ctrl), 0xF, 0xF, false))
__device__ __forceinline__ float row_sum16(float v) {
    DPP_ADD(v, 0x128); DPP_ADD(v, 0x124); DPP_ADD(v, 0x122); DPP_ADD(v, 0x121);
    return v;
}
__device__ __forceinline__ void row_sum16_x4(float& a, float& b, float& c, float& d) {
    asm("s_nop 1\n\t"
        "v_add_f32_dpp %0, %0, %0 row_ror:8 row_mask:0xf bank_mask:0xf\n\tv_add_f32_dpp %1, %1, %1 row_ror:8 row_mask:0xf bank_mask:0xf\n\t"
        "v_add_f32_dpp %2, %2, %2 row_ror:8 row_mask:0xf bank_mask:0xf\n\tv_add_f32_dpp %3, %3, %3 row_ror:8 row_mask:0xf bank_mask:0xf\n\t"
        "v_add_f32_dpp %0, %0, %0 row_ror:4 row_mask:0xf bank_mask:0xf\n\tv_add_f32_dpp %1, %1, %1 row_ror:4 row_mask:0xf bank_mask:0xf\n\t"
        "v_add_f32_dpp %2, %2, %2 row_ror:4 row_mask:0xf bank_mask:0xf\n\tv_add_f32_dpp %3, %3, %3 row_ror:4 row_mask:0xf bank_mask:0xf\n\t"
        "v_add_f32_dpp %0, %0, %0 row_ror:2 row_mask:0xf bank_mask:0xf\n\tv_add_f32_dpp %1, %1, %1 row_ror:2 row_mask:0xf bank_mask:0xf\n\t"
        "v_add_f32_dpp %2, %2, %2 row_ror:2 row_mask:0xf bank_mask:0xf\n\tv_add_f32_dpp %3, %3, %3 row_ror:2 row_mask:0xf bank_mask:0xf\n\t"
        "v_add_f32_dpp %0, %0, %0 row_ror:1 row_mask:0xf bank_mask:0xf\n\tv_add_f32_dpp %1, %1, %1 row_ror:1 row_mask:0xf bank_mask:0xf\n\t"
        "v_add_f32_dpp %2, %2, %2 row_ror:1 row_mask:0xf bank_mask:0xf\n\tv_add_f32_dpp %3, %3, %3 row_ror:1 row_mask:0xf bank_mask:0xf\n\t"
        "s_nop 1"
        : "+v"(a), "+v"(b), "+v"(c), "+v"(d));
}
__device__ __forceinline__ void row_sum16_x2(float& a, float& b) {
    asm("s_nop 1\n\t"
        "v_add_f32_dpp %0, %0, %0 row_ror:8 row_mask:0xf bank_mask:0xf\n\tv_add_f32_dpp %1, %1, %1 row_ror:8 row_mask:0xf bank_mask:0xf\n\ts_nop 1\n\t"
        "v_add_f32_dpp %0, %0, %0 row_ror:4 row_mask:0xf bank_mask:0xf\n\tv_add_f32_dpp %1, %1, %1 row_ror:4 row_mask:0xf bank_mask:0xf\n\ts_nop 1\n\t"
        "v_add_f32_dpp %0, %0, %0 row_ror:2 row_mask:0xf bank_mask:0xf\n\tv_add_f32_dpp %1, %1, %1 row_ror:2 row_mask:0xf bank_mask:0xf\n\ts_nop 1\n\t"
        "v_add_f32_dpp %0, %0, %0 row_ror:1 row_mask:0xf bank_mask:0xf\n\tv_add_f32_dpp %1, %1, %1 row_ror:1 row_mask:0xf bank_mask:0xf\n\t"
        "s_nop 1"
        : "+v"(a), "+v"(b));
}
typedef unsigned u32x2 __attribute__((ext_vector_type(2)));
__device__ __forceinline__ void st_wt16(void* p, v4u v) { asm volatile("global_store_dwordx4 %0, %1, off sc1\n\ts_nop 1" :: "v"(p), "v"(v) : "memory"); }
__device__ __forceinline__ void st_wt8(void* p, u32x2 v) { asm volatile("global_store_dwordx2 %0, %1, off sc1\n\ts_nop 1" :: "v"(p), "v"(v) : "memory"); }
#define LBAR() do { asm volatile("s_waitcnt lgkmcnt(0)" ::: "memory"); __builtin_amdgcn_s_barrier(); asm volatile("" ::: "memory"); } while (0)
typedef float f32x2 __attribute__((ext_vector_type(2)));
typedef __bf16 hwbf16x2_t __attribute__((ext_vector_type(2)));
__device__ __forceinline__ unsigned hw_pk2(float lo, float hi) { const f32x2 v = {lo, hi}; return __builtin_bit_cast(unsigned, __builtin_convertvector(v, hwbf16x2_t)); }
__device__ __forceinline__ bf16 hw_bf(float x) { return (bf16)hw_pk2(x, 0.f); }
__device__ __forceinline__ float bf_lo(unsigned w) { return __uint_as_float(w << 16); }
__device__ __forceinline__ float bf_hi(unsigned w) { return __uint_as_float(w & 0xffff0000u); }
__device__ __forceinline__ float sigmoidf_(float x) { return __builtin_amdgcn_rcpf(1.0f + __expf(-x)); }
__device__ __forceinline__ float siluf_(float x) { return x * __builtin_amdgcn_rcpf(1.0f + __expf(-x)); }
__device__ __forceinline__ float softplusf_(float x) { return fmaxf(x, 0.f) + log1pf(__expf(-fabsf(x))); }
__device__ __forceinline__ float logsigmoidf_(float x) { return fminf(x, 0.f) - log1pf(__expf(-fabsf(x))); }

struct EpiBf16S {
    static constexpr bool PERM = true, AFTER_DRAIN = false;
    bf16* O; int ldc; const float* rowss;
    __device__ __forceinline__ void operator()(const pg8::f32x4 (&acc)[2][2][4][2], const pg8::Unit& u, int wr, int wc, int fr, int fq) const {
        const int row0 = u.pm * 256 + wr * 64 + fr, col0 = u.pn * 256 + wc * 32 + 8 * fq;
#pragma unroll
        for (int ai = 0; ai < 2; ++ai)
#pragma unroll
            for (int m = 0; m < 4; ++m) {
                const int row = row0 + ai * 128 + m * 16;
                float sc = 1.f;
                if (rowss) { const pg8::f32x4* rp = (const pg8::f32x4*)(rowss + (size_t)row * 32 + 8 * fq); const pg8::f32x4 p0 = rp[0], p1 = rp[1];
                    float s = ((p0[0] + p0[1]) + (p0[2] + p0[3])) + ((p1[0] + p1[1]) + (p1[2] + p1[3])); s += __shfl_xor(s, 16); s += __shfl_xor(s, 32);
                    sc = __builtin_amdgcn_rsqf(s * (1.0f / D) + EPS); }
                bf16* rowp = O + (size_t)row * ldc + col0;
#pragma unroll
                for (int bj = 0; bj < 2; ++bj) { const pg8::f32x4 v0 = acc[ai][bj][m][0] * sc, v1 = acc[ai][bj][m][1] * sc;
                    pg8::u32x4 w; w.x = pg8::cvt_pk_bf16(v0[0], v0[1]); w.y = pg8::cvt_pk_bf16(v0[2], v0[3]); w.z = pg8::cvt_pk_bf16(v1[0], v1[1]); w.w = pg8::cvt_pk_bf16(v1[2], v1[3]);
                    *(pg8::u32x4*)(rowp + bj * 128) = w; } }
    }
};
template <bool GATE, bool HIN_F32> struct EpiResid {
    static constexpr bool PERM = false, AFTER_DRAIN = false;
    const void* hin; bf16* hout; float* rowss; const bf16* pp; const float* rs3;
    __device__ __forceinline__ void operator()(const pg8::f32x4 (&acc)[2][2][4][2], const pg8::Unit& u, int wr, int wc, int fr, int fq) const {
        const int row0 = u.pm * 256 + wr * 64 + fr, col0 = u.pn * 256 + wc * 32 + 4 * fq;
        constexpr int MG = HIN_F32 ? 2 : 4;
#pragma unroll
        for (int ai = 0; ai < 2; ++ai)
#pragma unroll
            for (int m0 = 0; m0 < 4; m0 += MG) {
                pg8::f32x4 hf[MG][2][2]; pg8::u32x2 hb[MG][2][2], pw[MG][2][2]; float rsc[MG];
#pragma unroll
                for (int mm = 0; mm < MG; ++mm) { const int row = row0 + ai * 128 + (m0 + mm) * 16; const size_t off = (size_t)row * D + col0; rsc[mm] = GATE ? rs3[row] : 1.f;
#pragma unroll
                    for (int bj = 0; bj < 2; ++bj)
#pragma unroll
                        for (int n = 0; n < 2; ++n) { const size_t o = off + bj * 128 + n * 16;
                            if (HIN_F32) hf[mm][bj][n] = *(const pg8::f32x4*)((const float*)hin + o); else hb[mm][bj][n] = *(const pg8::u32x2*)((const bf16*)hin + o);
                            if (GATE) pw[mm][bj][n] = *(const pg8::u32x2*)(pp + o); } }
#pragma unroll
                for (int mm = 0; mm < MG; ++mm) { const int m = m0 + mm; const int row = row0 + ai * 128 + m * 16; const size_t off = (size_t)row * D + col0; float ss = 0.f;
#pragma unroll
                    for (int bj = 0; bj < 2; ++bj)
#pragma unroll
                        for (int n = 0; n < 2; ++n) { const size_t o = off + bj * 128 + n * 16;
                            pg8::f32x4 hv;
                            if (HIN_F32) hv = hf[mm][bj][n];
                            else { const pg8::u32x2 hw = hb[mm][bj][n]; hv[0] = bf_lo(hw.x); hv[1] = bf_hi(hw.x); hv[2] = bf_lo(hw.y); hv[3] = bf_hi(hw.y); }
                            pg8::f32x4 a = acc[ai][bj][m][n];
                            if (GATE) { const pg8::u32x2 p2 = pw[mm][bj][n]; const float rs_ = rsc[mm];
                                a[0] = sigmoidf_(a[0] * rs_) * bf_lo(p2.x); a[1] = sigmoidf_(a[1] * rs_) * bf_hi(p2.x); a[2] = sigmoidf_(a[2] * rs_) * bf_lo(p2.y); a[3] = sigmoidf_(a[3] * rs_) * bf_hi(p2.y); }
                            hv = hv + a;
                            pg8::u32x2 w; w.x = hw_pk2(hv[0], hv[1]); w.y = hw_pk2(hv[2], hv[3]); *(pg8::u32x2*)(hout + o) = w;
                            const float q0 = bf_lo(w.x), q1 = bf_hi(w.x), q2 = bf_lo(w.y), q3 = bf_hi(w.y);
                            ss += (q0 * q0 + q1 * q1) + (q2 * q2 + q3 * q3); }
                    ss += __shfl_xor(ss, 16); ss += __shfl_xor(ss, 32);
                    if (fq == 0) rowss[(size_t)row * 32 + u.pn * 4 + wc] = ss; }
                asm volatile("" ::: "memory"); }
    }
};


__device__ __forceinline__ void p0_transpose_item(const float* W, int K, int N, bf16* WT, LAS float* scr, int item, int lane, const float* kgain = nullptr) {
    const int nblk = N / 32, kb = item / nblk, nb = item % nblk, k0 = 64 * kb, n0 = 32 * nb;
    { const GAS float* Wg = (const GAS float*)W + (size_t)(k0 + (lane >> 5)) * N + n0 + (lane & 31); float v[32];
#pragma unroll
      for (int i = 0; i < 32; ++i) v[i] = Wg[(size_t)(2 * i) * N];
#pragma unroll
      for (int i = 0; i < 32; ++i) scr[(2 * i + (lane >> 5)) * 33 + (lane & 31)] = v[i]; }
    LDS_WAIT(); asm volatile("" ::: "memory");
    const int c = lane & 7;
#pragma unroll
    for (int j = 0; j < 4; ++j) { const int n = (lane >> 3) + 8 * j; const LAS float* s = scr + (8 * c) * 33 + n;
        f32x4 g0 = {1.f, 1.f, 1.f, 1.f}, g1 = g0; if (kgain) { g0 = *(const GAS f32x4*)(kgain + k0 + 8 * c); g1 = *(const GAS f32x4*)(kgain + k0 + 8 * c + 4); }
        v4u o; o.x = pk2(s[0 * 33] * g0[0], s[1 * 33] * g0[1]); o.y = pk2(s[2 * 33] * g0[2], s[3 * 33] * g0[3]); o.z = pk2(s[4 * 33] * g1[0], s[5 * 33] * g1[1]); o.w = pk2(s[6 * 33] * g1[2], s[7 * 33] * g1[3]);
        *(GAS v4u*)(WT + (size_t)(n0 + n) * K + k0 + 8 * c) = o; }
    LDS_WAIT(); asm volatile("" ::: "memory");
}
__device__ __forceinline__ void cvt_f32_bf16(const float* src, bf16* dst, size_t n, int gtid, int gthreads) {
    const size_t n8 = n / 8;
    for (size_t i = gtid; i < n8; i += gthreads) {
        const f32x4 a = *(const GAS f32x4*)(src + i * 8), b = *(const GAS f32x4*)(src + i * 8 + 4);
        v4u o; o.x = pk2(a[0], a[1]); o.y = pk2(a[2], a[3]); o.z = pk2(b[0], b[1]); o.w = pk2(b[2], b[3]);
        *(GAS v4u*)(dst + i * 8) = o; }
}
__device__ __forceinline__ void cvt_f32_fp8(const float* src, unsigned char* dst, size_t n, float scale, int gtid, int gthreads, const float* cgain = nullptr) {
    const size_t n16 = n / 16;
    for (size_t i = gtid; i < n16; i += gthreads) { v4u o; unsigned w[4];
#pragma unroll
        for (int q = 0; q < 4; ++q) { f32x4 a = *(const GAS f32x4*)(src + i * 16 + 4 * q) * scale; if (cgain) a = a * *(const GAS f32x4*)(cgain + ((i * 16 + 4 * q) & (D - 1)));
            int x = __builtin_amdgcn_cvt_pk_fp8_f32(a[0], a[1], 0, false); x = __builtin_amdgcn_cvt_pk_fp8_f32(a[2], a[3], x, true); w[q] = (unsigned)x; }
        o.x = w[0]; o.y = w[1]; o.z = w[2]; o.w = w[3];
        *(GAS v4u*)(dst + i * 16) = o; }
}
__device__ __forceinline__ void rms_row_to_bf16(const float* xrow, const float* g, bf16* orow, int lane) {
    const GAS f32x4* xr = (const GAS f32x4*)xrow + lane; f32x4 v[8]; float s = 0.f;
#pragma unroll
    for (int j = 0; j < 8; ++j) { v[j] = xr[64 * j]; s += (v[j][0] * v[j][0] + v[j][1] * v[j][1]) + (v[j][2] * v[j][2] + v[j][3] * v[j][3]); }
    const float r = __builtin_amdgcn_rsqf(wave_sum(s) * (1.0f / D) + EPS);
    const GAS f32x4* gr = (const GAS f32x4*)g + lane;
    GAS unsigned long long* o8 = (GAS unsigned long long*)orow + lane;
#pragma unroll
    for (int j = 0; j < 8; ++j) { const f32x4 gg = gr[64 * j]; o8[64 * j] = (unsigned long long)pk2(v[j][0] * r * gg[0], v[j][1] * r * gg[1]) | ((unsigned long long)pk2(v[j][2] * r * gg[2], v[j][3] * r * gg[3]) << 32); }
}
__device__ __forceinline__ void p0_fold_item(const float* wq, const float* sk, bf16* WP, LAS float* lds, int item, int tid, const float* kgain) {
    const int hp = item >> 5, k0 = (item & 31) * 64;
    LAS float* skT = lds;
    LAS float* wqT = lds + 128 * 132;
    const float* skb = sk + (size_t)hp * 128 * 128;
#pragma unroll 4
    for (int i = 0; i < 32; ++i) { const int idx = i * 512 + tid, n = idx >> 7, d = idx & 127; skT[d * 132 + n] = skb[idx]; }
#pragma unroll 4
    for (int i = 0; i < 16; ++i) { const int idx = i * 512 + tid, kk = idx >> 7, d = idx & 127; wqT[d * 68 + kk] = wq[(size_t)(k0 + kk) * D + hp * 128 + d] * kgain[k0 + kk]; }
    __syncthreads();
    const int n0 = (tid >> 4) * 4, kk0 = (tid & 15) * 4;
    float acc[4][4];
#pragma unroll
    for (int i = 0; i < 4; ++i)
#pragma unroll
        for (int j = 0; j < 4; ++j) acc[i][j] = 0.f;
#pragma unroll 4
    for (int d = 0; d < 128; ++d) { const f32x4 a = *(const LAS f32x4*)(skT + d * 132 + n0), b = *(const LAS f32x4*)(wqT + d * 68 + kk0);
#pragma unroll
        for (int i = 0; i < 4; ++i)
#pragma unroll
            for (int j = 0; j < 4; ++j) acc[i][j] += a[i] * b[j]; }
#pragma unroll
    for (int i = 0; i < 4; ++i) { unsigned long long o = (unsigned long long)pk2(acc[i][0], acc[i][1]) | ((unsigned long long)pk2(acc[i][2], acc[i][3]) << 32);
        *(GAS unsigned long long*)(WP + (size_t)(hp * 128 + n0 + i) * D + k0 + kk0) = o; }
    __syncthreads();
}
__device__ __forceinline__ void p0_prologue(const Args& A, Frame& F) {
    const int gw = F.vcu * NWAVES + F.wave, NGW = F.G * NWAVES;
    const int gtid = gw * 64 + F.lane, gthreads = F.G * NTHREADS;
    unsigned char* ws = A.ws;
    LAS float* scr = (LAS float*)(F.lds + RING_OFF + F.wave * 16384);
    constexpr int I_EVIN = (D / 64) * (EV_N / 32);
    for (int it = gw; it < I_EVIN; it += NGW) p0_transpose_item(A.in[I_EV_WIN], D, EV_N, (bf16*)(ws + WS_WEV_IN), scr, it, F.lane);
    { GAS v4u* z0 = (GAS v4u*)(ws + WS_WEV_IN + (size_t)EV_N * D * 2); const size_t n0 = (size_t)(EV_NP - EV_N) * D * 2 / 16;
      for (size_t i = gtid; i < n0; i += gthreads) z0[i] = (v4u){0u, 0u, 0u, 0u}; }
    { constexpr int I_PJ = (256 / 64) * (D / 32);
      for (int it = gw; it < 2 * I_PJ; it += NGW) { const int L = it / I_PJ; p0_transpose_item(A.in[I_PLE_WP] + (size_t)L * 256 * D, 256, D, (bf16*)(ws + WS_WPROJ) + (size_t)L * D * 256, scr, it % I_PJ, F.lane); } }
    cvt_f32_bf16(A.in[I_P], (bf16*)(ws + WS_PBF), (size_t)2 * T * 256, gtid, gthreads);
    for (int m = gw; m < T; m += NGW) rms_row_to_bf16(A.in[I_X] + (size_t)m * D, A.in[I_NMIX], (bf16*)(ws + WS_ACTA) + (size_t)m * D, F.lane);
}
__device__ __forceinline__ void p0_deferred(const Args& A, Frame& F, int wg, int nwg) {
    const int gw = wg * NWAVES + F.wave, NGW = nwg * NWAVES;
    int gtid = gw * 64 + F.lane; const int gthreads = nwg * NTHREADS;
    asm volatile("" : "+v"(gtid));
    unsigned char* ws = A.ws;
    {
        LAS float* scr = (LAS float*)(F.lds + RING_OFF + F.wave * 16384);
        constexpr int I_SQ = (D / 64) * (D / 32), I_ODIN = (D / 64) * (OD_N / 32);
        constexpr int NITEMS = I_SQ + I_ODIN + I_SQ;
        for (int it = gw; it < NITEMS; it += NGW) {
            int r = it;
            if (r < I_SQ) { p0_transpose_item(A.in[I_EV_WOUT], D, D, (bf16*)(ws + WS_WEV_OUT), scr, r, F.lane); continue; } r -= I_SQ;
            if (r < I_ODIN) { p0_transpose_item(A.in[I_OD_WIN], D, OD_N, (bf16*)(ws + WS_WOD_IN), scr, r, F.lane, A.in[I_NMIX] + D); continue; } r -= I_ODIN;
            p0_transpose_item(A.in[I_PLE_WG], D, D, (bf16*)(ws + WS_WGATE), scr, r, F.lane, A.in[I_NPLE]);
        }
        { GAS v4u* z1 = (GAS v4u*)(ws + WS_WOD_IN + (size_t)OD_N * D * 2); const size_t n1 = (size_t)(OD_NP - OD_N) * D * 2 / 16;
          for (size_t i = gtid; i < n1; i += gthreads) z1[i] = (v4u){0u, 0u, 0u, 0u}; }
    }
    __syncthreads();
    for (int it = wg; it < 512; it += nwg)
        p0_fold_item(A.in[I_PEER_WQ], A.in[I_PEER_SK], (bf16*)(ws + WS_WPEER), (LAS float*)(F.lds + RING_OFF), it, F.tid, A.in[I_NFFN]);
    cvt_f32_fp8(A.in[I_PEER_U], (unsigned char*)(ws + WS_TABU), (size_t)16384 * D, 512.0f, gtid, gthreads, A.in[I_NFFN]);
    cvt_f32_fp8(A.in[I_PEER_V], (unsigned char*)(ws + WS_TABV), (size_t)16384 * D, 16.0f, gtid, gthreads);
    { bf16* LB = (bf16*)(ws + WS_WLORA); const float* w2 = A.in[I_W2]; const float* a2 = A.in[I_A2]; const float* g2 = A.in[I_G2];
      for (int i = gtid; i < LORA_N * LORA_K / 2; i += gthreads) { const int row = i / (LORA_K / 2), col = (i % (LORA_K / 2)) * 2; float v[2];
#pragma unroll
          for (int e = 0; e < 2; ++e) { const int c = col + e; float x = 0.f;
              if (row < 1024) { if (c < 96) x = w2[c * 1024 + row]; }
              else if (row < 2048) { if (c >= 96 && c < 192) x = a2[(c - 96) * 1024 + (row - 1024)]; }
              else { if (c >= 192 && c < 448) x = g2[(c - 192) * 1024 + (row - 2048)]; }
              v[e] = x; }
          *(GAS unsigned*)(LB + (size_t)row * LORA_K + col) = pk2(v[0], v[1]); } }
}
__device__ __forceinline__ void p1_deferred(const Args& A, Frame& F, int wg, int nwg) {
    const int gw = wg * NWAVES + F.wave, NGW = nwg * NWAVES;
    int gtid = gw * 64 + F.lane; const int gthreads = nwg * NTHREADS;
    asm volatile("" : "+v"(gtid));
    unsigned char* ws = A.ws;
    { LAS float* scr = (LAS float*)(F.lds + RING_OFF + F.wave * 16384); constexpr int I_SQ = (D / 64) * (D / 32);
      for (int it = gw; it < 2 * I_SQ; it += NGW) {
          if (it < I_SQ) p0_transpose_item(A.in[I_OD_WOUT], D, D, (bf16*)(ws + WS_WOD_OUT), scr, it, F.lane);
          else p0_transpose_item(A.in[I_PLE_WG] + (size_t)D * D, D, D, (bf16*)(ws + WS_WGATE) + (size_t)D * D, scr, it - I_SQ, F.lane, A.in[I_NPLE] + D); } }
    __syncthreads();
    for (int it = wg; it < 512; it += nwg)
        p0_fold_item(A.in[I_PEER_WQ] + (size_t)D * D, A.in[I_PEER_SK] + (size_t)16 * 128 * 128, (bf16*)(ws + WS_WPEER) + (size_t)D * D, (LAS float*)(F.lds + RING_OFF), it, F.tid, A.in[I_NFFN] + D);
    cvt_f32_fp8(A.in[I_PEER_U] + (size_t)16384 * D, (unsigned char*)(ws + WS_TABU) + (size_t)16384 * D, (size_t)16384 * D, 512.0f, gtid, gthreads, A.in[I_NFFN] + D);
    cvt_f32_fp8(A.in[I_PEER_V] + (size_t)16384 * D, (unsigned char*)(ws + WS_TABV) + (size_t)16384 * D, (size_t)16384 * D, 16.0f, gtid, gthreads);
}

constexpr int TC = 16, NCHUNK = SEQ / TC;

template <int MODE>
__device__ __forceinline__ void scan_gla_unit(const Args& A, Frame& F, int unit) {
    int tid = F.tid; asm volatile("" : "+v"(tid));
    const int lane = tid & 63, w = F.wave;
    int b, h, qcol, kcol, vcol, ocol;
    if (MODE == 0) { b = unit >> 4; h = (unit >> 2) & 3; const int s = unit & 3; qcol = EC_GQ + h * 128; kcol = EC_GK + h * 128; vcol = EC_GV + h * 256 + s * 64; ocol = h * 256 + s * 64; }
    else           { b = unit >> 4; h = (unit >> 1) & 7; const int s = unit & 1; qcol = OC_HQ + h * 128; kcol = OC_HF + h * 128; vcol = OC_HI + h * 128 + s * 64; ocol = h * 128 + s * 64; }
    const bf16* P = (const bf16*)(A.ws + WS_PROJ) + (size_t)b * SEQ * PROJ_LD;
    float* O = (float*)(A.ws + WS_O) + (size_t)b * SEQ * D + ocol;
    LAS float* Lf = (LAS float*)(F.lds + RING_OFF);
    constexpr int BUFSZ = 7168, O_EG = 0, O_K = 2048, O_Q = 4096, O_V = 6144, O_OUT = 2 * BUFSZ, O_W2 = O_OUT + 1024, O_BIAS = O_W2 + 2048;
    const int tl = tid >> 5, dq = (tid & 31) * 4, tlv = tid >> 4, c4 = (tid & 15) * 4;
    float lb[4] = {0.f, 0.f, 0.f, 0.f};
    if (MODE == 0) {
        const float* w2 = A.in[I_GK_W2]; const float* gb = A.in[I_GK_B];
        for (int i = tid; i < 2048; i += NTHREADS) Lf[O_W2 + i] = w2[(i >> 7) * 512 + h * 128 + (i & 127)];
        if (tid < 128) Lf[O_BIAS + tid] = gb[h * 128 + tid];
    } else {
        const float* lg = A.in[I_LB];
#pragma unroll
        for (int i = 0; i < 4; ++i) lb[i] = sigmoidf_(lg[1024 + h * 128 + dq + i] - lg[h * 128 + dq + i]);
    }
    u32x2 rq, rk, rv = {0u, 0u}; v4u rg0 = {0u, 0u, 0u, 0u}, rg1 = {0u, 0u, 0u, 0u};
#define GLA_LOAD(c) do { const bf16* pr = P + (size_t)((c) * TC + tl) * PROJ_LD; rq = *(const GAS u32x2*)(pr + qcol + dq); rk = *(const GAS u32x2*)(pr + kcol + dq); \
        if (MODE == 0) { rg0 = *(const GAS v4u*)(pr + EC_GLR); rg1 = *(const GAS v4u*)(pr + EC_GLR + 8); } \
        if (tid < 256) rv = *(const GAS u32x2*)(P + (size_t)((c) * TC + tlv) * PROJ_LD + vcol + c4); } while (0)
#define GLA_XFORM(bufi) do { LAS float* B_ = Lf + (bufi) * BUFSZ; f32x4 q4, k4, e4; \
        const float xq[4] = {bf_lo(rq.x), bf_hi(rq.x), bf_lo(rq.y), bf_hi(rq.y)}, xk[4] = {bf_lo(rk.x), bf_hi(rk.x), bf_lo(rk.y), bf_hi(rk.y)}; \
        if (MODE == 0) { f32x4 z = *(const LAS f32x4*)(Lf + O_BIAS + dq); \
            const float gl[16] = {bf_lo(rg0.x), bf_hi(rg0.x), bf_lo(rg0.y), bf_hi(rg0.y), bf_lo(rg0.z), bf_hi(rg0.z), bf_lo(rg0.w), bf_hi(rg0.w), \
                                  bf_lo(rg1.x), bf_hi(rg1.x), bf_lo(rg1.y), bf_hi(rg1.y), bf_lo(rg1.z), bf_hi(rg1.z), bf_lo(rg1.w), bf_hi(rg1.w)}; \
            _Pragma("unroll") for (int r_ = 0; r_ < 16; ++r_) { const f32x4 wv = *(const LAS f32x4*)(Lf + O_W2 + r_ * 128 + dq); z = z + wv * gl[r_]; } \
            _Pragma("unroll") for (int i_ = 0; i_ < 4; ++i_) { q4[i_] = xq[i_] * 0.08838834764831845f; k4[i_] = xk[i_]; e4[i_] = __builtin_amdgcn_exp2f(-0.0625f * __builtin_amdgcn_logf(1.0f + __expf(-z[i_]))); } } \
        else { _Pragma("unroll") for (int i_ = 0; i_ < 4; ++i_) { const float fg = lb[i_] + (1.f - lb[i_]) * sigmoidf_(xk[i_]); q4[i_] = siluf_(xq[i_]); k4[i_] = 1.f - fg; e4[i_] = fg; } } \
        *(LAS f32x4*)(B_ + O_EG + tl * 128 + dq) = e4; *(LAS f32x4*)(B_ + O_K + tl * 128 + dq) = k4; *(LAS f32x4*)(B_ + O_Q + tl * 128 + dq) = q4; \
        if (tid < 256) { f32x4 v4 = {bf_lo(rv.x), bf_hi(rv.x), bf_lo(rv.y), bf_hi(rv.y)}; *(LAS f32x4*)(B_ + O_V + tlv * 64 + c4) = v4; } } while (0)
    LBAR();
    GLA_LOAD(0); GLA_XFORM(0);
    LBAR();
    f32x2 S2[8];
#pragma unroll
    for (int i = 0; i < 8; ++i) S2[i] = (f32x2){0.f, 0.f};
    const int j = lane & 15, col = w * 8 + (lane >> 4) * 2;
    for (int c = 0; c < NCHUNK; ++c) {
        if (c + 1 < NCHUNK) GLA_LOAD(c + 1);
        const LAS float* B_ = Lf + (c & 1) * BUFSZ;
        float os0 = 0.f, os1 = 0.f;
        f32x4 e0, e1, k0, k1, q0, q1, ne0, ne1, nk0, nk1, nq0, nq1; f32x2 v2, nv2;
#define GLA_LDSTEP(t_, E0, E1, K0, K1, Q0, Q1, V2) do { E0 = *(const LAS f32x4*)(B_ + O_EG + (t_) * 128 + 4 * j); E1 = *(const LAS f32x4*)(B_ + O_EG + (t_) * 128 + 64 + 4 * j); \
            K0 = *(const LAS f32x4*)(B_ + O_K + (t_) * 128 + 4 * j); K1 = *(const LAS f32x4*)(B_ + O_K + (t_) * 128 + 64 + 4 * j); \
            Q0 = *(const LAS f32x4*)(B_ + O_Q + (t_) * 128 + 4 * j); Q1 = *(const LAS f32x4*)(B_ + O_Q + (t_) * 128 + 64 + 4 * j); V2 = *(const LAS f32x2*)(B_ + O_V + (t_) * 64 + col); } while (0)
        GLA_LDSTEP(0, e0, e1, k0, k1, q0, q1, v2);
#pragma unroll
        for (int t = 0; t < TC; ++t) {
            if (t + 1 < TC) { GLA_LDSTEP(t + 1, ne0, ne1, nk0, nk1, nq0, nq1, nv2); }
            __builtin_amdgcn_sched_barrier(0);
            f32x2 pa = {0.f, 0.f}, pb = {0.f, 0.f};
#pragma unroll
            for (int i = 0; i < 4; ++i) {
                S2[i] = S2[i] * e0[i] + v2 * k0[i]; S2[4 + i] = S2[4 + i] * e1[i] + v2 * k1[i];
                pa += S2[i] * q0[i]; pb += S2[4 + i] * q1[i]; }
            pa += pb;
            float p0 = pa[0], p1 = pa[1];
            row_sum16_x2(p0, p1);
            os0 = (j == t) ? p0 : os0; os1 = (j == t) ? p1 : os1;
            e0 = ne0; e1 = ne1; k0 = nk0; k1 = nk1; q0 = nq0; q1 = nq1; v2 = nv2;
        }
#undef GLA_LDSTEP
        { f32x2 o2 = {os0, os1}; *(LAS f32x2*)(Lf + O_OUT + j * 64 + col) = o2; }
        if (c + 1 < NCHUNK) GLA_XFORM((c + 1) & 1);
        LBAR();
        if (tid < 256) *(GAS f32x4*)(O + (size_t)(c * TC + tlv) * D + c4) = *(const LAS f32x4*)(Lf + O_OUT + tlv * 64 + c4);
        LBAR();
    }
#undef GLA_LOAD
#undef GLA_XFORM
}

__device__ __forceinline__ void scan_gdn_unit(const Args& A, Frame& F, int unit) {
    int tid = F.tid; asm volatile("" : "+v"(tid));
    const int lane = tid & 63, w = F.wave;
    const int b = unit >> 4, h = (unit >> 1) & 7, s = unit & 1;
    const int qcol = EC_BQ + h * 128, kcol = EC_BK + h * 128, vcol = EC_BV + h * 128 + s * 64, ocol = 1024 + h * 128 + s * 64;
    const bf16* P = (const bf16*)(A.ws + WS_PROJ) + (size_t)b * SEQ * PROJ_LD;
    float* O = (float*)(A.ws + WS_O) + (size_t)b * SEQ * D + ocol;
    LAS float* Lf = (LAS float*)(F.lds + RING_OFF);
    constexpr int BUFSZ = 5184, O_K = 0, O_Q = 2048, O_V = 4096, O_SC = 5120, O_OUT = 2 * BUFSZ, O_CW = O_OUT + 1024;
    const int tl = tid >> 5, dq = (tid & 31) * 4, tlv = tid >> 4, c4 = (tid & 15) * 4;
    { const float* cw = A.in[I_GDN_CONV];
      for (int i = tid; i < 4 * 320; i += NTHREADS) { const int jt = i / 320, x = i % 320;
          const int ch = x < 128 ? (h * 128 + x) : x < 256 ? (1024 + h * 128 + (x - 128)) : (2048 + h * 128 + s * 64 + (x - 256));
          Lf[O_CW + i] = cw[jt * 3072 + ch]; } }
    const float neg_ea = -__expf(A.in[I_GDN_ALOG][h]), dtb = A.in[I_GDN_DTB][h];
    u32x2 rq[4], rk[4], rv[4]; unsigned short rba = 0, rbb = 0;
#pragma unroll
    for (int i = 0; i < 4; ++i) rv[i] = (u32x2){0u, 0u};
#define GDN_LOAD(c) do { const int t_ = (c) * TC + tl; \
        _Pragma("unroll") for (int jt = 0; jt < 4; ++jt) { const int tt = t_ - 3 + jt; \
            if (tt >= 0) { const bf16* pr = P + (size_t)tt * PROJ_LD; rq[jt] = *(const GAS u32x2*)(pr + qcol + dq); rk[jt] = *(const GAS u32x2*)(pr + kcol + dq); } \
            else { rq[jt] = (u32x2){0u, 0u}; rk[jt] = (u32x2){0u, 0u}; } } \
        { const bf16* pr = P + (size_t)t_ * PROJ_LD; rba = pr[EC_BA + h]; rbb = pr[EC_BB + h]; } \
        if (tid < 256) { const int tv = (c) * TC + tlv; \
            _Pragma("unroll") for (int jt = 0; jt < 4; ++jt) { const int tt = tv - 3 + jt; \
                if (tt >= 0) rv[jt] = *(const GAS u32x2*)(P + (size_t)tt * PROJ_LD + vcol + c4); else rv[jt] = (u32x2){0u, 0u}; } } } while (0)
#define GDN_XFORM(bufi) do { LAS float* B_ = Lf + (bufi) * BUFSZ; f32x4 q4 = {0.f, 0.f, 0.f, 0.f}, k4 = {0.f, 0.f, 0.f, 0.f}; \
        _Pragma("unroll") for (int jt = 0; jt < 4; ++jt) { const f32x4 wq = *(const LAS f32x4*)(Lf + O_CW + jt * 320 + dq), wk = *(const LAS f32x4*)(Lf + O_CW + jt * 320 + 128 + dq); \
            q4[0] += wq[0] * bf_lo(rq[jt].x); q4[1] += wq[1] * bf_hi(rq[jt].x); q4[2] += wq[2] * bf_lo(rq[jt].y); q4[3] += wq[3] * bf_hi(rq[jt].y); \
            k4[0] += wk[0] * bf_lo(rk[jt].x); k4[1] += wk[1] * bf_hi(rk[jt].x); k4[2] += wk[2] * bf_lo(rk[jt].y); k4[3] += wk[3] * bf_hi(rk[jt].y); } \
        float sq = 0.f, sk = 0.f, sqk = 0.f; \
        _Pragma("unroll") for (int i_ = 0; i_ < 4; ++i_) { q4[i_] = siluf_(q4[i_]); k4[i_] = siluf_(k4[i_]); sq += q4[i_] * q4[i_]; sk += k4[i_] * k4[i_]; sqk += q4[i_] * k4[i_]; } \
        sq = half_sum32(sq); sk = half_sum32(sk); sqk = half_sum32(sqk); \
        const float rq_ = __builtin_amdgcn_rsqf(sq + EPS) * 0.08838834764831845f, rk_ = __builtin_amdgcn_rsqf(sk + EPS); \
        q4 = q4 * rq_; k4 = k4 * rk_; \
        *(LAS f32x4*)(B_ + O_K + tl * 128 + dq) = k4; *(LAS f32x4*)(B_ + O_Q + tl * 128 + dq) = q4; \
        if ((tid & 31) == 0) { const float ba = __uint_as_float((unsigned)rba << 16), bb = __uint_as_float((unsigned)rbb << 16); \
            f32x4 sc; sc[0] = __expf(neg_ea * softplusf_(ba + dtb)); sc[1] = sigmoidf_(bb); sc[2] = sqk * rq_ * rk_; sc[3] = 0.f; *(LAS f32x4*)(B_ + O_SC + tl * 4) = sc; } \
        if (tid < 256) { f32x4 v4 = {0.f, 0.f, 0.f, 0.f}; \
            _Pragma("unroll") for (int jt = 0; jt < 4; ++jt) { const f32x4 wv = *(const LAS f32x4*)(Lf + O_CW + jt * 320 + 256 + c4); \
                v4[0] += wv[0] * bf_lo(rv[jt].x); v4[1] += wv[1] * bf_hi(rv[jt].x); v4[2] += wv[2] * bf_lo(rv[jt].y); v4[3] += wv[3] * bf_hi(rv[jt].y); } \
            _Pragma("unroll") for (int i_ = 0; i_ < 4; ++i_) v4[i_] = siluf_(v4[i_]); \
            *(LAS f32x4*)(B_ + O_V + tlv * 64 + c4) = v4; } } while (0)
    LBAR();
    GDN_LOAD(0); GDN_XFORM(0);
    LBAR();
    f32x2 S2[8];
#pragma unroll
    for (int i = 0; i < 8; ++i) S2[i] = (f32x2){0.f, 0.f};
    const int j = lane & 15, col = w * 8 + (lane >> 4) * 2;
    for (int c = 0; c < NCHUNK; ++c) {
        if (c + 1 < NCHUNK) GDN_LOAD(c + 1);
        const LAS float* B_ = Lf + (c & 1) * BUFSZ;
        float os0 = 0.f, os1 = 0.f;
        f32x4 k0, k1, q0, q1, sc, nk0, nk1, nq0, nq1, nsc; f32x2 v2, nv2;
#define GDN_LDSTEP(t_, K0, K1, Q0, Q1, V2, SC) do { K0 = *(const LAS f32x4*)(B_ + O_K + (t_) * 128 + 4 * j); K1 = *(const LAS f32x4*)(B_ + O_K + (t_) * 128 + 64 + 4 * j); \
            Q0 = *(const LAS f32x4*)(B_ + O_Q + (t_) * 128 + 4 * j); Q1 = *(const LAS f32x4*)(B_ + O_Q + (t_) * 128 + 64 + 4 * j); V2 = *(const LAS f32x2*)(B_ + O_V + (t_) * 64 + col); SC = *(const LAS f32x4*)(B_ + O_SC + (t_) * 4); } while (0)
        GDN_LDSTEP(0, k0, k1, q0, q1, v2, sc);
#pragma unroll
        for (int t = 0; t < TC; ++t) {
            if (t + 1 < TC) { GDN_LDSTEP(t + 1, nk0, nk1, nq0, nq1, nv2, nsc); }
            __builtin_amdgcn_sched_barrier(0);
            f32x2 d1 = {0.f, 0.f}, d2 = {0.f, 0.f}, e1 = {0.f, 0.f}, e2 = {0.f, 0.f};
#pragma unroll
            for (int i = 0; i < 4; ++i) { d1 += S2[i] * k0[i]; e1 += S2[4 + i] * k1[i]; d2 += S2[i] * q0[i]; e2 += S2[4 + i] * q1[i]; }
            d1 += e1; d2 += e2;
            { float r0_ = d1[0], r1_ = d1[1], r2_ = d2[0], r3_ = d2[1]; row_sum16_x4(r0_, r1_, r2_, r3_); d1[0] = r0_; d1[1] = r1_; d2[0] = r2_; d2[1] = r3_; }
            const float a = sc[0], beta = sc[1], qk = sc[2];
            const f32x2 dl = (v2 - d1 * a) * beta;
            const f32x2 o2 = d2 * a + dl * qk;
#pragma unroll
            for (int i = 0; i < 4; ++i) { S2[i] = S2[i] * a + dl * k0[i]; S2[4 + i] = S2[4 + i] * a + dl * k1[i]; }
            os0 = (j == t) ? o2[0] : os0; os1 = (j == t) ? o2[1] : os1;
            k0 = nk0; k1 = nk1; q0 = nq0; q1 = nq1; v2 = nv2; sc = nsc;
        }
#undef GDN_LDSTEP
        { f32x2 o2 = {os0, os1}; *(LAS f32x2*)(Lf + O_OUT + j * 64 + col) = o2; }
        if (c + 1 < NCHUNK) GDN_XFORM((c + 1) & 1);
        LBAR();
        if (tid < 256) *(GAS f32x4*)(O + (size_t)(c * TC + tlv) * D + c4) = *(const LAS f32x4*)(Lf + O_OUT + tlv * 64 + c4);
        LBAR();
    }
#undef GDN_LOAD
#undef GDN_XFORM
}

typedef short bf16x4_t __attribute__((ext_vector_type(4)));
__device__ __forceinline__ bf16x8 mk_frag(u32x2 lo, u32x2 hi) { v4u t; t.x = lo.x; t.y = lo.y; t.z = hi.x; t.w = hi.y; return __builtin_bit_cast(bf16x8, t); }
template <int MODE>
__device__ __forceinline__ void scan_gla_mfma_unit(const Args& A, Frame& F, int unit) {
    int tid = F.tid; asm volatile("" : "+v"(tid));
    const int lane = tid & 63, w = F.wave;
    int b, h, qcol, kcol, vcol, ocol;
    if (MODE == 0) { b = unit >> 3; h = (unit >> 1) & 3; const int s = unit & 1; qcol = EC_GQ + h * 128; kcol = EC_GK + h * 128; vcol = EC_GV + h * 256 + s * 128; ocol = h * 256 + s * 128; }
    else           { b = unit >> 3; h = unit & 7; qcol = OC_HQ + h * 128; kcol = OC_HF + h * 128; vcol = OC_HI + h * 128; ocol = h * 128; }
    const bf16* P = (const bf16*)(A.ws + WS_PROJ) + (size_t)b * SEQ * PROJ_LD;
    bf16* O = (bf16*)(A.ws + WS_O) + (size_t)b * SEQ * D + ocol;
    LAS float* Lf = (LAS float*)(F.lds + RING_OFF);
    constexpr int BUFSZ = 8192, O_E = 0, O_K = 2048, O_Q = 4096, O_V = 6144, RS = 136, O_QB = 2 * BUFSZ, O_KB = O_QB + 1088, O_KT = O_KB + 1088, O_BL = O_KT + 1024, O_AM = O_BL + 128, O_W2 = O_AM + 128, O_BIAS = O_W2 + 2048;
    LAS bf16* QB = (LAS bf16*)(Lf + O_QB); LAS bf16* KB = (LAS bf16*)(Lf + O_KB); LAS bf16* KT = (LAS bf16*)(Lf + O_KT); LAS bf16* AM = (LAS bf16*)(Lf + O_AM);
    const int tl = tid >> 5, dq = (tid & 31) * 4;
    float lb[4] = {0.f, 0.f, 0.f, 0.f};
    if (MODE == 0) {
        const float* w2 = A.in[I_GK_W2]; const float* gb = A.in[I_GK_B];
        for (int i = tid; i < 2048; i += NTHREADS) Lf[O_W2 + i] = w2[(i >> 7) * 512 + h * 128 + (i & 127)];
        if (tid < 128) Lf[O_BIAS + tid] = gb[h * 128 + tid];
    } else {
        const float* lg = A.in[I_LB];
#pragma unroll
        for (int i = 0; i < 4; ++i) lb[i] = sigmoidf_(lg[1024 + h * 128 + dq + i] - lg[h * 128 + dq + i]);
    }
    u32x2 rq, rk, rv; v4u rg0 = {0u, 0u, 0u, 0u}, rg1 = {0u, 0u, 0u, 0u};
#define GM_LOAD(c) do { const bf16* pr = P + (size_t)((c) * TC + tl) * PROJ_LD; rq = *(const GAS u32x2*)(pr + qcol + dq); rk = *(const GAS u32x2*)(pr + kcol + dq); rv = *(const GAS u32x2*)(pr + vcol + dq); \
        if (MODE == 0) { rg0 = *(const GAS v4u*)(pr + EC_GLR); rg1 = *(const GAS v4u*)(pr + EC_GLR + 8); } } while (0)
#define GM_XFORM(bufi) do { LAS float* B_ = Lf + (bufi) * BUFSZ; f32x4 q4, k4, e4; \
        const float xq[4] = {bf_lo(rq.x), bf_hi(rq.x), bf_lo(rq.y), bf_hi(rq.y)}, xk[4] = {bf_lo(rk.x), bf_hi(rk.x), bf_lo(rk.y), bf_hi(rk.y)}; \
        if (MODE == 0) { f32x4 z = *(const LAS f32x4*)(Lf + O_BIAS + dq); \
            const float gl[16] = {bf_lo(rg0.x), bf_hi(rg0.x), bf_lo(rg0.y), bf_hi(rg0.y), bf_lo(rg0.z), bf_hi(rg0.z), bf_lo(rg0.w), bf_hi(rg0.w), \
                                  bf_lo(rg1.x), bf_hi(rg1.x), bf_lo(rg1.y), bf_hi(rg1.y), bf_lo(rg1.z), bf_hi(rg1.z), bf_lo(rg1.w), bf_hi(rg1.w)}; \
            _Pragma("unroll") for (int r_ = 0; r_ < 16; ++r_) { const f32x4 wv = *(const LAS f32x4*)(Lf + O_W2 + r_ * 128 + dq); z = z + wv * gl[r_]; } \
            _Pragma("unroll") for (int i_ = 0; i_ < 4; ++i_) { q4[i_] = xq[i_] * 0.08838834764831845f; k4[i_] = xk[i_]; e4[i_] = __builtin_amdgcn_exp2f(-0.0625f * __builtin_amdgcn_logf(1.0f + __expf(-z[i_]))); } } \
        else { _Pragma("unroll") for (int i_ = 0; i_ < 4; ++i_) { const float fg = lb[i_] + (1.f - lb[i_]) * sigmoidf_(xk[i_]); q4[i_] = siluf_(xq[i_]); k4[i_] = 1.f - fg; e4[i_] = fg; } } \
        *(LAS f32x4*)(B_ + O_E + tl * 128 + dq) = e4; *(LAS f32x4*)(B_ + O_K + tl * 128 + dq) = k4; *(LAS f32x4*)(B_ + O_Q + tl * 128 + dq) = q4; \
        { f32x4 v4 = {bf_lo(rv.x), bf_hi(rv.x), bf_lo(rv.y), bf_hi(rv.y)}; *(LAS f32x4*)(B_ + O_V + tl * 128 + dq) = v4; } } while (0)
    LBAR();
    GM_LOAD(0); GM_XFORM(0); GM_LOAD(1);
    LBAR();
    f32x4 Sacc[8];
#pragma unroll
    for (int i = 0; i < 8; ++i) Sacc[i] = (f32x4){0.f, 0.f, 0.f, 0.f};
    const int fr = lane & 15, g = lane >> 4, c0 = w * 16;
    for (int c = 0; c < NCHUNK; ++c) {
        const LAS float* B_ = Lf + (c & 1) * BUFSZ;
        {
            const int seg = tid >> 7, d = tid & 127;
            float bt = 1.f, ball = 1.f;
#pragma unroll
            for (int t = 0; t < 16; ++t) { const float e = B_[O_E + t * 128 + d]; ball *= e; if (t < 4 * seg) bt = ball; }
            ball = fmaxf(ball, 1e-30f);
            unsigned short kt4[4];
#pragma unroll
            for (int i = 0; i < 4; ++i) { const int t = 4 * seg + i; bt = fmaxf(bt * B_[O_E + t * 128 + d], 1e-30f);
                const float kk = B_[O_K + t * 128 + d], qq = B_[O_Q + t * 128 + d], ib = __builtin_amdgcn_rcpf(bt);
                QB[t * RS + d] = hw_bf(qq * bt); KB[t * RS + d] = hw_bf(kk * ib); kt4[i] = (unsigned short)hw_bf(kk * ball * ib); }
            u32x2 kw; kw.x = (unsigned)kt4[0] | ((unsigned)kt4[1] << 16); kw.y = (unsigned)kt4[2] | ((unsigned)kt4[3] << 16);
            *(LAS u32x2*)(KT + d * 16 + 4 * seg) = kw;
            if (seg == 3) Lf[O_BL + d] = ball;
        }
        LBAR();
        if (w == 0) {
            f32x4 acc = {0.f, 0.f, 0.f, 0.f};
#pragma unroll
            for (int ks = 0; ks < 4; ++ks) { const bf16x8 af = *(const LAS bf16x8*)(QB + fr * RS + 32 * ks + 8 * g), bfm = *(const LAS bf16x8*)(KB + fr * RS + 32 * ks + 8 * g);
                acc = __builtin_amdgcn_mfma_f32_16x16x32_bf16(af, bfm, acc, 0, 0, 0); }
#pragma unroll
            for (int r = 0; r < 4; ++r) { const int t = 4 * g + r, s = fr; AM[t * 16 + s] = hw_bf(s <= t ? acc[r] : 0.f); }
        }
        if (c + 1 < NCHUNK) GM_XFORM((c + 1) & 1);
        if (c + 2 < NCHUNK) GM_LOAD(c + 2);
        LBAR();
        {
            u32x2 vlo; { const float v0 = B_[O_V + (4 * g + 0) * 128 + c0 + fr], v1 = B_[O_V + (4 * g + 1) * 128 + c0 + fr], v2 = B_[O_V + (4 * g + 2) * 128 + c0 + fr], v3 = B_[O_V + (4 * g + 3) * 128 + c0 + fr];
                vlo.x = hw_pk2(v0, v1); vlo.y = hw_pk2(v2, v3); }
            const u32x2 zz = {0u, 0u};
            const bf16x8 vb = mk_frag(vlo, zz);
            f32x4 acco = {0.f, 0.f, 0.f, 0.f};
#pragma unroll
            for (int ks = 0; ks < 4; ++ks) {
                u32x2 slo, shi; slo.x = hw_pk2(Sacc[2 * ks][0], Sacc[2 * ks][1]); slo.y = hw_pk2(Sacc[2 * ks][2], Sacc[2 * ks][3]); shi.x = hw_pk2(Sacc[2 * ks + 1][0], Sacc[2 * ks + 1][1]); shi.y = hw_pk2(Sacc[2 * ks + 1][2], Sacc[2 * ks + 1][3]);
                const bf16x8 sb = mk_frag(slo, shi);
                const u32x2 qlo = *(const LAS u32x2*)(QB + fr * RS + 32 * ks + 4 * g), qhi = *(const LAS u32x2*)(QB + fr * RS + 32 * ks + 16 + 4 * g);
                acco = __builtin_amdgcn_mfma_f32_16x16x32_bf16(mk_frag(qlo, qhi), sb, acco, 0, 0, 0); }
            { const u32x2 alo = *(const LAS u32x2*)(AM + fr * 16 + 4 * g); acco = __builtin_amdgcn_mfma_f32_16x16x32_bf16(mk_frag(alo, zz), vb, acco, 0, 0, 0); }
#pragma unroll
            for (int r = 0; r < 4; ++r) O[(size_t)(c * TC + 4 * g + r) * D + c0 + fr] = hw_bf(acco[r]);
#pragma unroll
            for (int i = 0; i < 8; ++i) { const f32x4 bl = *(const LAS f32x4*)(Lf + O_BL + 16 * i + 4 * g); const u32x2 klo = *(const LAS u32x2*)(KT + (16 * i + fr) * 16 + 4 * g);
                Sacc[i] = __builtin_amdgcn_mfma_f32_16x16x32_bf16(mk_frag(klo, zz), vb, Sacc[i] * bl, 0, 0, 0); }
        }
        LBAR();
    }
#undef GM_LOAD
#undef GM_XFORM
}

__device__ __forceinline__ void scan_gdn_mfma_unit(const Args& A, Frame& F, int unit, const int role) {
    int tid = F.tid; asm volatile("" : "+v"(tid));
    const int lane = tid & 63, w = F.wave;
    const int b = unit >> 3, h = unit & 7;
    const int qcol = EC_BQ + h * 128, kcol = EC_BK + h * 128, vcol = EC_BV + h * 128, ocol = 1024 + h * 128;
    const bf16* P = (const bf16*)(A.ws + WS_PROJ) + (size_t)b * SEQ * PROJ_LD;
    bf16* O = (bf16*)(A.ws + WS_O) + (size_t)b * SEQ * D + ocol;
    LAS float* Lf = (LAS float*)(F.lds + RING_OFF);
    constexpr int O_CW = 0, O_AMAT = 1536, O_QKM = O_AMAT + 256, O_TB = O_QKM + 128, O_GL = O_TB + 128, O_BUF0 = O_GL + 64;
    constexpr int BUFSZ = 6208, O_KH = 0, O_QH = 2048, O_VV = 4096, O_SC = 6144;
    constexpr int RS = 136;
    constexpr int O_KHB = O_BUF0 + 2 * BUFSZ, O_QHB = O_KHB + 1088, O_QB = O_QHB + 1088, O_KT = O_QB + 1088, O_WSRC = O_KT + 1024, O_WB = O_WSRC + 2048;
    LAS bf16* KHB = (LAS bf16*)(Lf + O_KHB); LAS bf16* QHB = (LAS bf16*)(Lf + O_QHB); LAS bf16* QB = (LAS bf16*)(Lf + O_QB); LAS bf16* KT = (LAS bf16*)(Lf + O_KT);
    LAS bf16* WB = (LAS bf16*)(Lf + O_WB); LAS bf16* QKM = (LAS bf16*)(Lf + O_QKM); LAS bf16* TB = (LAS bf16*)(Lf + O_TB);
    const int tl = tid >> 5, dq = (tid & 31) * 4;
    { const float* cw = A.in[I_GDN_CONV];
      for (int i = tid; i < 4 * 384; i += NTHREADS) { const int jt = i / 384, x = i % 384; Lf[O_CW + i] = cw[jt * 3072 + (x >> 7) * 1024 + h * 128 + (x & 127)]; } }
    const float neg_ea = -__expf(A.in[I_GDN_ALOG][h]), dtb = A.in[I_GDN_DTB][h];
    u32x2 rq[4], rk[4], rv[4]; unsigned short rba = 0, rbb = 0;
#define GD_LOAD(c) do { const int t_ = (c) * TC + tl; \
        _Pragma("unroll") for (int jt = 0; jt < 4; ++jt) { const int tt = t_ - 3 + jt; const bf16* pr = P + (size_t)(tt < 0 ? 0 : tt) * PROJ_LD + dq; \
            rq[jt] = *(const GAS u32x2*)(pr + qcol); rk[jt] = *(const GAS u32x2*)(pr + kcol); rv[jt] = *(const GAS u32x2*)(pr + vcol); \
            if (tt < 0) { rq[jt] = (u32x2){0u, 0u}; rk[jt] = (u32x2){0u, 0u}; rv[jt] = (u32x2){0u, 0u}; } } \
        { const bf16* pr = P + (size_t)t_ * PROJ_LD; rba = pr[EC_BA + h]; rbb = pr[EC_BB + h]; } } while (0)
#define GD_XFORM(bufi) do { LAS float* B_ = Lf + O_BUF0 + (bufi) * BUFSZ; f32x4 q4 = {0.f, 0.f, 0.f, 0.f}, k4 = {0.f, 0.f, 0.f, 0.f}, v4 = {0.f, 0.f, 0.f, 0.f}; \
        _Pragma("unroll") for (int jt = 0; jt < 4; ++jt) { const f32x4 wq = *(const LAS f32x4*)(Lf + O_CW + jt * 384 + dq), wk = *(const LAS f32x4*)(Lf + O_CW + jt * 384 + 128 + dq), wv = *(const LAS f32x4*)(Lf + O_CW + jt * 384 + 256 + dq); \
            q4[0] += wq[0] * bf_lo(rq[jt].x); q4[1] += wq[1] * bf_hi(rq[jt].x); q4[2] += wq[2] * bf_lo(rq[jt].y); q4[3] += wq[3] * bf_hi(rq[jt].y); \
            k4[0] += wk[0] * bf_lo(rk[jt].x); k4[1] += wk[1] * bf_hi(rk[jt].x); k4[2] += wk[2] * bf_lo(rk[jt].y); k4[3] += wk[3] * bf_hi(rk[jt].y); \
            v4[0] += wv[0] * bf_lo(rv[jt].x); v4[1] += wv[1] * bf_hi(rv[jt].x); v4[2] += wv[2] * bf_lo(rv[jt].y); v4[3] += wv[3] * bf_hi(rv[jt].y); } \
        float sq = 0.f, sk = 0.f; \
        _Pragma("unroll") for (int i_ = 0; i_ < 4; ++i_) { q4[i_] = siluf_(q4[i_]); k4[i_] = siluf_(k4[i_]); v4[i_] = siluf_(v4[i_]); sq += q4[i_] * q4[i_]; sk += k4[i_] * k4[i_]; } \
        row_sum16_x2(sq, sk); sq += __shfl_xor(sq, 16); sk += __shfl_xor(sk, 16); \
        q4 = q4 * (__builtin_amdgcn_rsqf(sq + EPS) * 0.08838834764831845f); k4 = k4 * __builtin_amdgcn_rsqf(sk + EPS); \
        *(LAS f32x4*)(B_ + O_KH + tl * 128 + dq) = k4; *(LAS f32x4*)(B_ + O_QH + tl * 128 + dq) = q4; *(LAS f32x4*)(B_ + O_VV + tl * 128 + dq) = v4; \
        if ((tid & 31) == 0) { const float ba = __uint_as_float((unsigned)rba << 16), bb = __uint_as_float((unsigned)rbb << 16); \
            B_[O_SC + tl] = __expf(neg_ea * softplusf_(ba + dtb)); B_[O_SC + 16 + tl] = sigmoidf_(bb); } } while (0)
    LBAR();
    constexpr int SPLIT = 58;
    const int c_begin = role ? SPLIT : 0, c_end = role ? NCHUNK : SPLIT;
    constexpr int REC = 5408;
    float* STASH = (float*)(A.ws + WS_LA) + (size_t)unit * (NCHUNK - SPLIT) * REC;
    float* STATE = (float*)(A.ws + WS_STATE) + (size_t)unit * 16384;
    gu32* flag = F.ctl + 32768 + unit * 64;
    GD_LOAD(c_begin); GD_XFORM(c_begin & 1); GD_LOAD(c_begin + 1);
    LBAR();
    f32x4 Sacc[8];
#pragma unroll
    for (int i = 0; i < 8; ++i) Sacc[i] = (f32x4){0.f, 0.f, 0.f, 0.f};
    const int fr = lane & 15, g = lane >> 4, c0 = w * 16;
    const u32x2 zz = {0u, 0u};
#define GD_STATE_PART(cc_) do { \
        { \
            bf16x8 sb[4]; \
_Pragma("unroll") \
            for (int ks = 0; ks < 4; ++ks) { u32x2 slo, shi; slo.x = hw_pk2(Sacc[2 * ks][0], Sacc[2 * ks][1]); slo.y = hw_pk2(Sacc[2 * ks][2], Sacc[2 * ks][3]); shi.x = hw_pk2(Sacc[2 * ks + 1][0], Sacc[2 * ks + 1][1]); shi.y = hw_pk2(Sacc[2 * ks + 1][2], Sacc[2 * ks + 1][3]); \
                sb[ks] = mk_frag(slo, shi); } \
            f32x4 accv = accu, acco = {0.f, 0.f, 0.f, 0.f}; \
_Pragma("unroll") \
            for (int ks = 0; ks < 4; ++ks) { \
                const u32x2 wl = *(const LAS u32x2*)(WB + fr * RS + 32 * ks + 4 * g), wh = *(const LAS u32x2*)(WB + fr * RS + 32 * ks + 16 + 4 * g); \
                accv = __builtin_amdgcn_mfma_f32_16x16x32_bf16(mk_frag(wl, wh), sb[ks], accv, 0, 0, 0); \
                const u32x2 ql = *(const LAS u32x2*)(QB + fr * RS + 32 * ks + 4 * g), qh = *(const LAS u32x2*)(QB + fr * RS + 32 * ks + 16 + 4 * g); \
                acco = __builtin_amdgcn_mfma_f32_16x16x32_bf16(mk_frag(ql, qh), sb[ks], acco, 0, 0, 0); } \
            u32x2 vn; vn.x = hw_pk2(accv[0], accv[1]); vn.y = hw_pk2(accv[2], accv[3]); \
            const bf16x8 vnb = mk_frag(vn, zz); \
            acco = __builtin_amdgcn_mfma_f32_16x16x32_bf16(mk_frag(*(const LAS u32x2*)(QKM + fr * 16 + 4 * g), zz), vnb, acco, 0, 0, 0); \
_Pragma("unroll") \
            for (int r = 0; r < 4; ++r) O[(size_t)((cc_) * TC + 4 * g + r) * D + c0 + fr] = hw_bf(acco[r]); \
_Pragma("unroll") \
            for (int i = 0; i < 8; ++i) { const u32x2 klo = *(const LAS u32x2*)(KT + (16 * i + fr) * 16 + 4 * g); \
                Sacc[i] = __builtin_amdgcn_mfma_f32_16x16x32_bf16(mk_frag(klo, zz), vnb, Sacc[i] * glast, 0, 0, 0); } \
        } \
        } while (0)
    for (int c = c_begin; c < c_end; ++c) {
        const LAS float* B_ = Lf + O_BUF0 + (c & 1) * BUFSZ;
        float glast;
        {
            const int seg = tid >> 7, d = tid & 127;
            const f32x4 a0 = *(const LAS f32x4*)(B_ + O_SC), a1 = *(const LAS f32x4*)(B_ + O_SC + 4), a2 = *(const LAS f32x4*)(B_ + O_SC + 8), a3 = *(const LAS f32x4*)(B_ + O_SC + 12);
            const float av[16] = {a0[0], a0[1], a0[2], a0[3], a1[0], a1[1], a1[2], a1[3], a2[0], a2[1], a2[2], a2[3], a3[0], a3[1], a3[2], a3[3]};
            float p = 1.f, gpre = 1.f;
#pragma unroll
            for (int t = 0; t < 16; ++t) { if (t == 4 * seg) gpre = p; p *= av[t]; }
            glast = p;
            unsigned short kt4[4]; float gt = gpre;
#pragma unroll
            for (int i = 0; i < 4; ++i) { const int t = 4 * seg + i; const float at = (seg == 0) ? av[i] : (seg == 1) ? av[4 + i] : (seg == 2) ? av[8 + i] : av[12 + i]; gt *= at; const float beta = B_[O_SC + 16 + t];
                const float kk = B_[O_KH + t * 128 + d], qq = B_[O_QH + t * 128 + d];
                KHB[t * RS + d] = hw_bf(kk); QHB[t * RS + d] = hw_bf(qq); QB[t * RS + d] = hw_bf(qq * gt);
                kt4[i] = (unsigned short)hw_bf(kk * glast * __builtin_amdgcn_rcpf(gt));
                Lf[O_WSRC + t * 128 + d] = kk * (beta * gt);
                if (d == 0) Lf[O_GL + t] = gt; }
            u32x2 kw; kw.x = (unsigned)kt4[0] | ((unsigned)kt4[1] << 16); kw.y = (unsigned)kt4[2] | ((unsigned)kt4[3] << 16);
            *(LAS u32x2*)(KT + d * 16 + 4 * seg) = kw;
        }
        LBAR();
        if (w < 2) {
            const LAS bf16* AS = (w == 0) ? KHB : QHB;
            f32x4 acc = {0.f, 0.f, 0.f, 0.f};
#pragma unroll
            for (int ks = 0; ks < 4; ++ks) { const bf16x8 af = *(const LAS bf16x8*)(AS + fr * RS + 32 * ks + 8 * g), bfm = *(const LAS bf16x8*)(KHB + fr * RS + 32 * ks + 8 * g);
                acc = __builtin_amdgcn_mfma_f32_16x16x32_bf16(af, bfm, acc, 0, 0, 0); }
            const float gs_inv = __builtin_amdgcn_rcpf(Lf[O_GL + fr]);
            if (w == 0) {
                f32x4 N1, M1;
#pragma unroll
                for (int r = 0; r < 4; ++r) { const int t = 4 * g + r; const float gt = Lf[O_GL + t];
                    N1[r] = (fr < t) ? -(B_[O_SC + 16 + t] * acc[r] * gt * gs_inv) : 0.f;
                    M1[r] = (t < fr) ? -(B_[O_SC + 16 + fr] * acc[r] * Lf[O_GL + fr] * __builtin_amdgcn_rcpf(gt)) : 0.f; }
#define XTY(X, Y, C0) __builtin_amdgcn_mfma_f32_16x16x32_bf16(mk_frag((u32x2){hw_pk2(X[0], X[1]), hw_pk2(X[2], X[3])}, zz), mk_frag((u32x2){hw_pk2(Y[0], Y[1]), hw_pk2(Y[2], Y[3])}, zz), C0, 0, 0, 0)
                const f32x4 z4 = {0.f, 0.f, 0.f, 0.f};
                f32x4 T1t = M1;
#pragma unroll
                for (int r = 0; r < 4; ++r) if (4 * g + r == fr) T1t[r] += 1.f;
                const f32x4 N2 = XTY(M1, N1, z4), M2 = XTY(N1, M1, z4);
                const f32x4 T2t = XTY(N2, T1t, T1t);
                const f32x4 N4 = XTY(M2, N2, z4), M4 = XTY(N2, M2, z4);
                const f32x4 T4t = XTY(N4, T2t, T2t);
                const f32x4 N8 = XTY(M4, N4, z4);
                const f32x4 T8t = XTY(N8, T4t, T4t);
#undef XTY
                u32x2 tw; tw.x = hw_pk2(T8t[0], T8t[1]); tw.y = hw_pk2(T8t[2], T8t[3]);
                *(LAS u32x2*)(TB + fr * 16 + 4 * g) = tw;
            } else {
#pragma unroll
                for (int r = 0; r < 4; ++r) { const int t = 4 * g + r; QKM[t * 16 + fr] = hw_bf((fr <= t) ? acc[r] * Lf[O_GL + t] * gs_inv : 0.f); }
            }
        }
        if (c + 1 < c_end) GD_XFORM((c + 1) & 1);
        if (c + 2 < c_end) GD_LOAD(c + 2);
        LBAR();
        f32x4 accu = {0.f, 0.f, 0.f, 0.f};
        {
            const bf16x8 tf = mk_frag(*(const LAS u32x2*)(TB + fr * 16 + 4 * g), zz);
            u32x2 ulo, wlo;
            { const float b0 = B_[O_SC + 16 + 4 * g + 0], b1 = B_[O_SC + 16 + 4 * g + 1], b2 = B_[O_SC + 16 + 4 * g + 2], b3 = B_[O_SC + 16 + 4 * g + 3];
              ulo.x = hw_pk2(b0 * B_[O_VV + (4 * g + 0) * 128 + c0 + fr], b1 * B_[O_VV + (4 * g + 1) * 128 + c0 + fr]); ulo.y = hw_pk2(b2 * B_[O_VV + (4 * g + 2) * 128 + c0 + fr], b3 * B_[O_VV + (4 * g + 3) * 128 + c0 + fr]);
              wlo.x = hw_pk2(Lf[O_WSRC + (4 * g + 0) * 128 + c0 + fr], Lf[O_WSRC + (4 * g + 1) * 128 + c0 + fr]); wlo.y = hw_pk2(Lf[O_WSRC + (4 * g + 2) * 128 + c0 + fr], Lf[O_WSRC + (4 * g + 3) * 128 + c0 + fr]); }
            accu = __builtin_amdgcn_mfma_f32_16x16x32_bf16(tf, mk_frag(ulo, zz), accu, 0, 0, 0);
            f32x4 accw = {0.f, 0.f, 0.f, 0.f};
            accw = __builtin_amdgcn_mfma_f32_16x16x32_bf16(tf, mk_frag(wlo, zz), accw, 0, 0, 0);
#pragma unroll
            for (int r = 0; r < 4; ++r) WB[(4 * g + r) * RS + c0 + fr] = hw_bf(-accw[r]);
        }
        LBAR();
        if (role == 0) {
            GD_STATE_PART(c);
        } else {
            float* rec = STASH + (size_t)(c - c_begin) * REC;
            for (int i = tid; i < 832; i += NTHREADS) { const int o = i < 528 ? O_QB + 4 * i : (i < 800 ? O_WB + 4 * (i - 528) : O_QKM + 4 * (i - 800)); *(GAS f32x4*)(rec + 4 * i) = *(const LAS f32x4*)(Lf + o); }
#pragma unroll
            for (int r = 0; r < 4; ++r) rec[3328 + (w * 4 + r) * 64 + lane] = accu[r];
            if (tid == 0) rec[5376] = glast;
        }
        LBAR();
    }
    if (role == 0) {
#pragma unroll
        for (int i = 0; i < 8; ++i)
#pragma unroll
            for (int r = 0; r < 4; ++r) STATE[((w * 8 + i) * 4 + r) * 64 + lane] = Sacc[i][r];
        asm volatile("s_waitcnt vmcnt(0)" ::: "memory");
        __syncthreads();
        if (tid == 0) { __builtin_amdgcn_fence(__ATOMIC_RELEASE, "agent"); asm volatile("s_waitcnt vmcnt(0)" ::: "memory"); __hip_atomic_store(flag, 1u, __ATOMIC_RELAXED, __HIP_MEMORY_SCOPE_AGENT); }
    } else {
        if (tid == 0) { unsigned sp = 0; while (__hip_atomic_load(flag, __ATOMIC_RELAXED, __HIP_MEMORY_SCOPE_AGENT) == 0u) { __builtin_amdgcn_s_sleep(8); if (++sp > (1u << 22)) break; }
            __builtin_amdgcn_fence(__ATOMIC_ACQUIRE, "agent"); asm volatile("s_waitcnt vmcnt(0)" ::: "memory"); }
        __syncthreads();
#pragma unroll
        for (int i = 0; i < 8; ++i)
#pragma unroll
            for (int r = 0; r < 4; ++r) Sacc[i][r] = STATE[((w * 8 + i) * 4 + r) * 64 + lane];
        f32x4 pa, pb; f32x4 pu; float pg;
#define GD_REC_LOAD(cc) do { const float* rec = STASH + (size_t)((cc) - c_begin) * REC; pa = *(const GAS f32x4*)(rec + 4 * tid); pb = (tid < 320) ? *(const GAS f32x4*)(rec + 4 * (tid + 512)) : (f32x4){0.f, 0.f, 0.f, 0.f}; \
            _Pragma("unroll") for (int r = 0; r < 4; ++r) pu[r] = rec[3328 + (w * 4 + r) * 64 + lane]; pg = rec[5376]; } while (0)
        GD_REC_LOAD(c_begin);
        for (int c = c_begin; c < c_end; ++c) {
            { const int i0 = tid, o0 = i0 < 528 ? O_QB + 4 * i0 : O_WB + 4 * (i0 - 528); *(LAS f32x4*)(Lf + o0) = pa;
              if (tid < 320) { const int i1 = tid + 512; const int o1 = i1 < 528 ? O_QB + 4 * i1 : (i1 < 800 ? O_WB + 4 * (i1 - 528) : O_QKM + 4 * (i1 - 800)); *(LAS f32x4*)(Lf + o1) = pb; } }
            const f32x4 accu = pu; const float glast = pg;
            if (c + 1 < c_end) GD_REC_LOAD(c + 1);
            LBAR();
            GD_STATE_PART(c);
            LBAR();
        }
#undef GD_REC_LOAD
    }
#undef GD_STATE_PART
#undef GD_LOAD
#undef GD_XFORM
}

__device__ __forceinline__ void scan_rwkv_unit(const Args& A, Frame& F, int unit) {
    int tid = F.tid; asm volatile("" : "+v"(tid));
    const int lane = tid & 63, w = F.wave;
    const int b = unit >> 4, h = unit & 15;
    const bf16* P = (const bf16*)(A.ws + WS_PROJ) + (size_t)b * SEQ * PROJ_LD + OC_RW;
    const bf16* LO = (const bf16*)(A.ws + WS_LO) + (size_t)b * SEQ * LORA_N;
    bf16* Y = (bf16*)(A.ws + WS_ACTA) + (size_t)b * SEQ * D + 1024 + h * 64;
    LAS float* Lf = (LAS float*)(F.lds + RING_OFF);
    constexpr int BUFSZ = 6208, O_KK = 0, O_WR = 1024, O_W = 2048, O_NKA = 3072, O_K = 4096, O_V = 5120, O_SC = 6144, O_OUT = 2 * BUFSZ;
    const int tl = tid >> 5, d2 = (tid & 31) * 2, hd = h * 64 + d2;
    float mu_r[2], mu_k[2], mu_v[2], w0[2], a0[2], k_k[2], k_a[2], r_k[2], lnw[2], lnb[2];
#pragma unroll
    for (int i = 0; i < 2; ++i) { mu_r[i] = A.in[I_MU][RW_R + hd + i]; mu_k[i] = A.in[I_MU][RW_K + hd + i]; mu_v[i] = A.in[I_MU][RW_V + hd + i];
        w0[i] = A.in[I_W0][hd + i]; a0[i] = A.in[I_A0][hd + i]; k_k[i] = A.in[I_KK][hd + i]; k_a[i] = A.in[I_KA][hd + i]; r_k[i] = A.in[I_RK][hd + i];
        lnw[i] = A.in[I_LNW][hd + i]; lnb[i] = A.in[I_LNB][hd + i]; }
    unsigned rr[2], rk[2], rv[2], rlw, rla, rg_cur = 0u, rg_nxt = 0u;
#define RW_LOAD(c) do { const int t_ = (c) * TC + tl; const bf16* pr = P + (size_t)t_ * PROJ_LD; \
        rr[0] = *(const GAS unsigned*)(pr + RW_R + hd); rk[0] = *(const GAS unsigned*)(pr + RW_K + hd); rv[0] = *(const GAS unsigned*)(pr + RW_V + hd); \
        if (t_ > 0) { rr[1] = *(const GAS unsigned*)(pr - PROJ_LD + RW_R + hd); rk[1] = *(const GAS unsigned*)(pr - PROJ_LD + RW_K + hd); rv[1] = *(const GAS unsigned*)(pr - PROJ_LD + RW_V + hd); } \
        else { rr[1] = 0u; rk[1] = 0u; rv[1] = 0u; } \
        const bf16* lr = LO + (size_t)t_ * LORA_N; rlw = *(const GAS unsigned*)(lr + hd); rla = *(const GAS unsigned*)(lr + 1024 + hd); rg_nxt = *(const GAS unsigned*)(lr + 2048 + hd); } while (0)
#define RW_XFORM(bufi) do { LAS float* B_ = Lf + (bufi) * BUFSZ; f32x2 kk2, wr2, w2_, nka2, k2, v2_; float skk = 0.f, sc1 = 0.f, sc2 = 0.f, sbs = 0.f; float aa[2], rrv[2]; \
        _Pragma("unroll") for (int i_ = 0; i_ < 2; ++i_) { \
            const float r0 = i_ ? bf_hi(rr[0]) : bf_lo(rr[0]), r1 = i_ ? bf_hi(rr[1]) : bf_lo(rr[1]); \
            const float k0_ = i_ ? bf_hi(rk[0]) : bf_lo(rk[0]), k1_ = i_ ? bf_hi(rk[1]) : bf_lo(rk[1]); \
            const float v0_ = i_ ? bf_hi(rv[0]) : bf_lo(rv[0]), v1_ = i_ ? bf_hi(rv[1]) : bf_lo(rv[1]); \
            const float lw = i_ ? bf_hi(rlw) : bf_lo(rlw), la = i_ ? bf_hi(rla) : bf_lo(rla); \
            const float r_ = r0 + (r1 - r0) * mu_r[i_], kx = k0_ + (k1_ - k0_) * mu_k[i_], vx = v0_ + (v1_ - v0_) * mu_v[i_]; \
            const float wd = __expf(-0.6065306597126334f * sigmoidf_(w0[i_] + lw)); const float a_ = sigmoidf_(a0[i_] + la); \
            const float kk0 = kx * k_k[i_]; const float km = kx * (1.f + (a_ - 1.f) * k_a[i_]); \
            kk2[i_] = kk0; skk += kk0 * kk0; aa[i_] = a_; rrv[i_] = r_; wr2[i_] = wd * r_; w2_[i_] = wd; k2[i_] = km; v2_[i_] = vx; sc2 += km * r_; sbs += r_ * km * r_k[i_]; } \
        skk = half_sum32(skk); const float rkk = __builtin_amdgcn_rsqf(skk + EPS); \
        _Pragma("unroll") for (int i_ = 0; i_ < 2; ++i_) { kk2[i_] *= rkk; nka2[i_] = -(kk2[i_] * aa[i_]); sc1 += kk2[i_] * aa[i_] * rrv[i_]; } \
        sc1 = half_sum32(sc1); sc2 = half_sum32(sc2); sbs = half_sum32(sbs); \
        *(LAS f32x2*)(B_ + O_KK + tl * 64 + d2) = kk2; *(LAS f32x2*)(B_ + O_WR + tl * 64 + d2) = wr2; *(LAS f32x2*)(B_ + O_W + tl * 64 + d2) = w2_; \
        *(LAS f32x2*)(B_ + O_NKA + tl * 64 + d2) = nka2; *(LAS f32x2*)(B_ + O_K + tl * 64 + d2) = k2; *(LAS f32x2*)(B_ + O_V + tl * 64 + d2) = v2_; \
        if ((tid & 31) == 0) { f32x4 sc; sc[0] = sc1; sc[1] = sc2; sc[2] = sbs; sc[3] = 0.f; *(LAS f32x4*)(B_ + O_SC + tl * 4) = sc; } } while (0)
    RW_LOAD(0); RW_XFORM(0); rg_cur = rg_nxt;
    LBAR();
    f32x2 S2[4];
#pragma unroll
    for (int i = 0; i < 4; ++i) S2[i] = (f32x2){0.f, 0.f};
    const int j = lane & 15, col = w * 8 + (lane >> 4) * 2;
    for (int c = 0; c < NCHUNK; ++c) {
        if (c + 1 < NCHUNK) RW_LOAD(c + 1);
        const LAS float* B_ = Lf + (c & 1) * BUFSZ;
        float os0 = 0.f, os1 = 0.f;
        f32x4 kk, wr, ww, nka, kv, sc, nkk, nwr, nww, nnka, nkv, nsc; f32x2 v2, nv2;
#define RW_LDSTEP(t_, KK, WR, WW, NKA, KV, V2, SC) do { KK = *(const LAS f32x4*)(B_ + O_KK + (t_) * 64 + 4 * j); WR = *(const LAS f32x4*)(B_ + O_WR + (t_) * 64 + 4 * j); WW = *(const LAS f32x4*)(B_ + O_W + (t_) * 64 + 4 * j); \
            NKA = *(const LAS f32x4*)(B_ + O_NKA + (t_) * 64 + 4 * j); KV = *(const LAS f32x4*)(B_ + O_K + (t_) * 64 + 4 * j); V2 = *(const LAS f32x2*)(B_ + O_V + (t_) * 64 + col); SC = *(const LAS f32x4*)(B_ + O_SC + (t_) * 4); } while (0)
        RW_LDSTEP(0, kk, wr, ww, nka, kv, v2, sc);
#pragma unroll
        for (int t = 0; t < TC; ++t) {
            if (t + 1 < TC) { RW_LDSTEP(t + 1, nkk, nwr, nww, nnka, nkv, nv2, nsc); }
            __builtin_amdgcn_sched_barrier(0);
            f32x2 d1 = S2[0] * kk[0], d2 = S2[0] * wr[0], e1 = S2[1] * kk[1], e2 = S2[1] * wr[1];
            d1 += S2[2] * kk[2]; d2 += S2[2] * wr[2]; e1 += S2[3] * kk[3]; e2 += S2[3] * wr[3];
            d1 += e1; d2 += e2;
            { float r0_ = d1[0], r1_ = d1[1], r2_ = d2[0], r3_ = d2[1]; row_sum16_x4(r0_, r1_, r2_, r3_); d1[0] = r0_; d1[1] = r1_; d2[0] = r2_; d2[1] = r3_; }
            const f32x2 o2 = d2 - d1 * sc[0] + v2 * sc[1];
#pragma unroll
            for (int i = 0; i < 4; ++i) S2[i] = S2[i] * ww[i] + d1 * nka[i] + v2 * kv[i];
            os0 = (j == t) ? o2[0] : os0; os1 = (j == t) ? o2[1] : os1;
            kk = nkk; wr = nwr; ww = nww; nka = nnka; kv = nkv; v2 = nv2; sc = nsc;
        }
#undef RW_LDSTEP
        { f32x2 o2 = {os0, os1}; *(LAS f32x2*)(Lf + O_OUT + j * 64 + col) = o2; }
        if (c + 1 < NCHUNK) RW_XFORM((c + 1) & 1);
        LBAR();
        {
            const f32x2 o2 = *(const LAS f32x2*)(Lf + O_OUT + tl * 64 + d2); const f32x2 vv = *(const LAS f32x2*)(B_ + O_V + tl * 64 + d2); const float bs = B_[O_SC + tl * 4 + 2];
            const float mean = half_sum32(o2[0] + o2[1]) * (1.0f / 64.0f); const float e0 = o2[0] - mean, e1 = o2[1] - mean;
            const float var = half_sum32(e0 * e0 + e1 * e1) * (1.0f / 64.0f); const float rs = __builtin_amdgcn_rsqf(var + 64e-5f);
            const float y0 = (e0 * rs * lnw[0] + lnb[0] + bs * vv[0]) * bf_lo(rg_cur), y1 = (e1 * rs * lnw[1] + lnb[1] + bs * vv[1]) * bf_hi(rg_cur);
            *(GAS unsigned*)(Y + (size_t)(c * TC + tl) * D + d2) = pk2(y0, y1);
        }
        rg_cur = rg_nxt;
        LBAR();
    }
#undef RW_LOAD
#undef RW_XFORM
}

template <int LAYER>
__device__ __forceinline__ void post_rows(const Args& A, Frame& F) {
    const int gw = F.vcu * NWAVES + F.wave, NGW = F.G * NWAVES, lane = F.lane;
    const bf16* O = (const bf16*)(A.ws + WS_O); const bf16* P = (const bf16*)(A.ws + WS_PROJ); bf16* Y = (bf16*)(A.ws + WS_ACTA);
    for (int m = gw; m < T; m += NGW) {
        const GAS u32x2* orow = (const GAS u32x2*)(O + (size_t)m * D) + lane; const bf16* prow = P + (size_t)m * PROJ_LD;
        constexpr int NJ = LAYER == 0 ? 8 : 4;
#pragma unroll
        for (int jj = 0; jj < NJ; ++jj) {
            const u32x2 ow_ = orow[64 * jj]; const f32x4 v = {bf_lo(ow_.x), bf_hi(ow_.x), bf_lo(ow_.y), bf_hi(ow_.y)}; float ss = (v[0] * v[0] + v[1] * v[1]) + (v[2] * v[2] + v[3] * v[3]);
            const bool wide = (LAYER == 0 && jj < 4);
            const float ms = wide ? wave_sum(ss) * (1.0f / 256.0f) : half_sum32(ss) * (1.0f / 128.0f);
            const float r = __builtin_amdgcn_rsqf(ms + EPS);
            const int cih = wide ? 4 * lane : 4 * (lane & 31);
            const float* gsrc = LAYER == 0 ? (wide ? A.in[I_GLA_NORM] : A.in[I_GDN_NORM]) : A.in[I_HG_NORM];
            const f32x4 g = *(const GAS f32x4*)(gsrc + cih);
            const int zcol = LAYER == 0 ? (wide ? EC_GZ + jj * 256 + 4 * lane : EC_BZ + (jj - 4) * 256 + 4 * lane) : OC_HG + jj * 256 + 4 * lane;
            const u32x2 zw = *(const GAS u32x2*)(prow + zcol);
            const float y0 = v[0] * r * g[0] * siluf_(bf_lo(zw.x)), y1 = v[1] * r * g[1] * siluf_(bf_hi(zw.x)), y2 = v[2] * r * g[2] * siluf_(bf_lo(zw.y)), y3 = v[3] * r * g[3] * siluf_(bf_hi(zw.y));
            u32x2 o; o.x = pk2(y0, y1); o.y = pk2(y2, y3);
            *(GAS u32x2*)(Y + (size_t)m * D + 256 * jj + 4 * lane) = o;
        }
    }
}
__device__ __forceinline__ void lora_prep_rows(const Args& A, Frame& F) {
    const int gw = F.vcu * NWAVES + F.wave, NGW = F.G * NWAVES, lane = F.lane;
    const bf16* P = (const bf16*)(A.ws + WS_PROJ); bf16* LA = (bf16*)(A.ws + WS_LA); const float* mu = A.in[I_MU];
    for (int m = gw; m < T; m += NGW) { const bool hasprev = (m % SEQ) != 0; const bf16* prow = P + (size_t)m * PROJ_LD + OC_RW + RW_WL;
#pragma unroll
        for (int i = 0; i < 7; ++i) { const int c = lane + 64 * i;
            const float x = __uint_as_float((unsigned)prow[c] << 16), xp = hasprev ? __uint_as_float((unsigned)prow[c - PROJ_LD] << 16) : 0.f;
            const float ts = x + (xp - x) * mu[RW_WL + c];
            const float v = c < 96 ? tanhf(ts) : (c < 192 ? ts : sigmoidf_(ts));
            LA[(size_t)m * LORA_K + c] = (bf16)f2bf(v); }
        LA[(size_t)m * LORA_K + 448 + lane] = (bf16)0; }
}
__device__ __forceinline__ void final_rows(const Args& A, Frame& F, const float oscale, const bf16* Hs) {
    const int gw = F.vcu * NWAVES + F.wave, NGW = F.G * NWAVES, lane = F.lane;
    const float* rowss = (const float*)(A.ws + WS_RSP) + (size_t)RS_FINAL * T * 32; const GAS f32x4* g = (const GAS f32x4*)A.in[I_NFINAL] + lane;
    for (int m = gw; m < T; m += NGW) { const float r = oscale * __builtin_amdgcn_rsqf(wave_sum(lane < 32 ? rowss[(size_t)m * 32 + lane] : 0.f) * (1.0f / D) + EPS); GAS f32x4* row = (GAS f32x4*)(A.out + (size_t)m * D) + lane;
        const GAS u32x2* hrow = (const GAS u32x2*)(Hs + (size_t)m * D) + lane;
#pragma unroll
        for (int jj = 0; jj < 8; ++jj) { const u32x2 hw = hrow[64 * jj]; const f32x4 v = {bf_lo(hw.x), bf_hi(hw.x), bf_lo(hw.y), bf_hi(hw.y)}; row[64 * jj] = v * r * g[64 * jj]; } }
}

__device__ __forceinline__ void scan_rwkv_mfma_unit(const Args& A, Frame& F, int unit, const int role) {
    int tid = F.tid; asm volatile("" : "+v"(tid));
    const int lane = tid & 63, w = F.wave;
    const int b = unit >> 3, hp = unit & 7;
    const bf16* P = (const bf16*)(A.ws + WS_PROJ) + (size_t)b * SEQ * PROJ_LD + OC_RW;
    const bf16* LO = (const bf16*)(A.ws + WS_LO) + (size_t)b * SEQ * LORA_N;
    bf16* Y = (bf16*)(A.ws + WS_ACTA) + (size_t)b * SEQ * D + 1024;
    LAS float* Lf = (LAS float*)(F.lds + RING_OFF);
    constexpr int RS = 72;
    constexpr int O_CONST = 0;
    constexpr int O_XF = 1280;
    constexpr int O_VV = O_XF + 2 * 5 * 1024;
    constexpr int O_BS = O_VV + 4 * 1024;
    constexpr int O_IMG = O_BS + 64;
    constexpr int I_CT = 0, I_BT = 576, I_KL = 1152, I_RT = 1728, I_CF = 2304, I_BTT = 3328, I_KTT = 3840, I_WCB = 4352, I_G1B = 4928, I_TTB = 5056, I_RKB = 5184, I_RBB = 5312, I_W15 = 5440, I_OUT = 5504, IMGSZ = 6528;
    static_assert((O_IMG + 2 * IMGSZ) * 4 <= RING_BYTES, "rwkv lds");
    for (int i = tid; i < 1280; i += NTHREADS) { const int arr = i >> 7, ch = hp * 128 + (i & 127); float v;
        switch (arr) { case 0: v = A.in[I_MU][RW_R + ch]; break; case 1: v = A.in[I_MU][RW_K + ch]; break; case 2: v = A.in[I_MU][RW_V + ch]; break; case 3: v = A.in[I_W0][ch]; break; case 4: v = A.in[I_A0][ch]; break;
                       case 5: v = A.in[I_KK][ch]; break; case 6: v = A.in[I_KA][ch]; break; case 7: v = A.in[I_RK][ch]; break; case 8: v = A.in[I_LNW][ch]; break; default: v = A.in[I_LNB][ch]; break; }
        Lf[O_CONST + i] = v; }
    const int hx = tid >> 8, tl = (tid >> 4) & 15, d4 = (tid & 15) * 4, ch4 = hx * 64 + d4, col4 = hp * 128 + ch4;
    u32x2 rr[2], rk[2], rv[2], rlw, rla, rg_cur = {0u, 0u}, rg_nxt = {0u, 0u}, rg_far = {0u, 0u};
#define RM_LOAD(c) do { const int t_ = (c) * TC + tl; const bf16* pr = P + (size_t)t_ * PROJ_LD + col4; \
        rr[0] = *(const GAS u32x2*)(pr + RW_R); rk[0] = *(const GAS u32x2*)(pr + RW_K); rv[0] = *(const GAS u32x2*)(pr + RW_V); \
        const bf16* pp_ = (t_ > 0) ? pr - PROJ_LD : pr; rr[1] = *(const GAS u32x2*)(pp_ + RW_R); rk[1] = *(const GAS u32x2*)(pp_ + RW_K); rv[1] = *(const GAS u32x2*)(pp_ + RW_V); \
        if (t_ == 0) { rr[1] = (u32x2){0u, 0u}; rk[1] = (u32x2){0u, 0u}; rv[1] = (u32x2){0u, 0u}; } \
        const bf16* lr = LO + (size_t)t_ * LORA_N + col4; rlw = *(const GAS u32x2*)(lr); rla = *(const GAS u32x2*)(lr + 1024); rg_far = *(const GAS u32x2*)(lr + 2048); } while (0)
#define RM_XFORM(bufi) do { LAS float* X_ = Lf + O_XF + hx * 5 * 1024 + tl * 64 + d4; \
        const f32x4 mur = *(const LAS f32x4*)(Lf + O_CONST + 0 * 128 + ch4), muk = *(const LAS f32x4*)(Lf + O_CONST + 1 * 128 + ch4), muv = *(const LAS f32x4*)(Lf + O_CONST + 2 * 128 + ch4); \
        const f32x4 w0_ = *(const LAS f32x4*)(Lf + O_CONST + 3 * 128 + ch4), a0_ = *(const LAS f32x4*)(Lf + O_CONST + 4 * 128 + ch4), kk_ = *(const LAS f32x4*)(Lf + O_CONST + 5 * 128 + ch4); \
        const f32x4 ka_ = *(const LAS f32x4*)(Lf + O_CONST + 6 * 128 + ch4), rk_ = *(const LAS f32x4*)(Lf + O_CONST + 7 * 128 + ch4); \
        const float r0[4] = {bf_lo(rr[0].x), bf_hi(rr[0].x), bf_lo(rr[0].y), bf_hi(rr[0].y)}, r1[4] = {bf_lo(rr[1].x), bf_hi(rr[1].x), bf_lo(rr[1].y), bf_hi(rr[1].y)}; \
        const float k0[4] = {bf_lo(rk[0].x), bf_hi(rk[0].x), bf_lo(rk[0].y), bf_hi(rk[0].y)}, k1[4] = {bf_lo(rk[1].x), bf_hi(rk[1].x), bf_lo(rk[1].y), bf_hi(rk[1].y)}; \
        const float v0[4] = {bf_lo(rv[0].x), bf_hi(rv[0].x), bf_lo(rv[0].y), bf_hi(rv[0].y)}, v1[4] = {bf_lo(rv[1].x), bf_hi(rv[1].x), bf_lo(rv[1].y), bf_hi(rv[1].y)}; \
        const float lw[4] = {bf_lo(rlw.x), bf_hi(rlw.x), bf_lo(rlw.y), bf_hi(rlw.y)}, la[4] = {bf_lo(rla.x), bf_hi(rla.x), bf_lo(rla.y), bf_hi(rla.y)}; \
        f32x4 r4, w4, k4, v4, kk4, b4; float skk = 0.f, sbs = 0.f; float aa[4]; \
        _Pragma("unroll") for (int i_ = 0; i_ < 4; ++i_) { const float r_ = r0[i_] + (r1[i_] - r0[i_]) * mur[i_], kx = k0[i_] + (k1[i_] - k0[i_]) * muk[i_], vx = v0[i_] + (v1[i_] - v0[i_]) * muv[i_]; \
            const float wd = __expf(-0.6065306597126334f * sigmoidf_(w0_[i_] + lw[i_])); const float a_ = sigmoidf_(a0_[i_] + la[i_]); \
            const float kk0 = kx * kk_[i_], km = kx * (1.f + (a_ - 1.f) * ka_[i_]); \
            r4[i_] = r_; w4[i_] = wd; k4[i_] = km; v4[i_] = vx; kk4[i_] = kk0; aa[i_] = a_; skk += kk0 * kk0; sbs += r_ * km * rk_[i_]; } \
        row_sum16_x2(skk, sbs); const float rkk = __builtin_amdgcn_rsqf(skk + EPS); \
        _Pragma("unroll") for (int i_ = 0; i_ < 4; ++i_) { kk4[i_] *= rkk; b4[i_] = kk4[i_] * aa[i_]; } \
        *(LAS f32x4*)(X_) = r4; *(LAS f32x4*)(X_ + 1024) = w4; *(LAS f32x4*)(X_ + 2048) = k4; *(LAS f32x4*)(X_ + 3072) = kk4; *(LAS f32x4*)(X_ + 4096) = b4; \
        *(LAS f32x4*)(Lf + O_VV + ((bufi) * 2 + hx) * 1024 + tl * 64 + d4) = v4; \
        if ((tid & 15) == 0) Lf[O_BS + ((bufi) * 2 + hx) * 16 + tl] = sbs; } while (0)
    constexpr int SPLIT = 60;
    const int c_begin = role ? SPLIT : 0, c_end = role ? NCHUNK : SPLIT;
    constexpr int REC = 7584;
    float* STASH = (float*)(A.ws + (unit < 32 ? WS_WEV_IN : WS_END)) + (size_t)(unit & 31) * (NCHUNK - SPLIT) * REC;
    float* STATE = (float*)(A.ws + WS_STATE + 4 * MiB) + (size_t)unit * 8192;
    gu32* flag = F.ctl + 49152 + unit * 64;
    LBAR();
    RM_LOAD(c_begin); RM_XFORM(c_begin & 1); rg_cur = rg_far; RM_LOAD(c_begin + 1); rg_nxt = rg_far;
    LBAR();
    f32x4 Macc[4];
#pragma unroll
    for (int i = 0; i < 4; ++i) Macc[i] = (f32x4){0.f, 0.f, 0.f, 0.f};
    const int fr = lane & 15, g = lane >> 4, hh = w >> 2, ww = w & 3, c0 = ww * 16;
    LAS float* IM = Lf + O_IMG + hh * IMGSZ;
    LAS bf16* CT = (LAS bf16*)(IM + I_CT); LAS bf16* BT = (LAS bf16*)(IM + I_BT); LAS bf16* KL = (LAS bf16*)(IM + I_KL); LAS bf16* RT = (LAS bf16*)(IM + I_RT);
    LAS bf16* BTT = (LAS bf16*)(IM + I_BTT); LAS bf16* KTT = (LAS bf16*)(IM + I_KTT); LAS bf16* WCB = (LAS bf16*)(IM + I_WCB);
    LAS bf16* G1B = (LAS bf16*)(IM + I_G1B); LAS bf16* TTB = (LAS bf16*)(IM + I_TTB); LAS bf16* RKB = (LAS bf16*)(IM + I_RKB); LAS bf16* RBB = (LAS bf16*)(IM + I_RBB);
    const u32x2 zz = {0u, 0u};
#define RM_STATE_PART(vb) do { \
        { \
            bf16x8 mb[2]; \
_Pragma("unroll") \
            for (int ks = 0; ks < 2; ++ks) { u32x2 slo, shi; slo.x = hw_pk2(Macc[2 * ks][0], Macc[2 * ks][1]); slo.y = hw_pk2(Macc[2 * ks][2], Macc[2 * ks][3]); shi.x = hw_pk2(Macc[2 * ks + 1][0], Macc[2 * ks + 1][1]); shi.y = hw_pk2(Macc[2 * ks + 1][2], Macc[2 * ks + 1][3]); \
                mb[ks] = mk_frag(slo, shi); } \
            f32x4 accR = accU, acco = {0.f, 0.f, 0.f, 0.f}; \
_Pragma("unroll") \
            for (int ks = 0; ks < 2; ++ks) { \
                accR = __builtin_amdgcn_mfma_f32_16x16x32_bf16(mk_frag(*(const LAS u32x2*)(WCB + fr * RS + 32 * ks + 4 * g), *(const LAS u32x2*)(WCB + fr * RS + 32 * ks + 16 + 4 * g)), mb[ks], accR, 0, 0, 0); \
                acco = __builtin_amdgcn_mfma_f32_16x16x32_bf16(mk_frag(*(const LAS u32x2*)(RT + fr * RS + 32 * ks + 4 * g), *(const LAS u32x2*)(RT + fr * RS + 32 * ks + 16 + 4 * g)), mb[ks], acco, 0, 0, 0); } \
            u32x2 rn; rn.x = hw_pk2(accR[0], accR[1]); rn.y = hw_pk2(accR[2], accR[3]); \
            const bf16x8 rb = mk_frag(rn, zz); \
            acco = __builtin_amdgcn_mfma_f32_16x16x32_bf16(mk_frag(*(const LAS u32x2*)(RKB + fr * 16 + 4 * g), zz), vb, acco, 0, 0, 0); \
            acco = __builtin_amdgcn_mfma_f32_16x16x32_bf16(mk_frag(*(const LAS u32x2*)(RBB + fr * 16 + 4 * g), zz), rb, acco, 0, 0, 0); \
_Pragma("unroll") \
            for (int r = 0; r < 4; ++r) IM[I_OUT + (4 * g + r) * 64 + c0 + fr] = acco[r]; \
_Pragma("unroll") \
            for (int i = 0; i < 4; ++i) { const f32x4 w15 = *(const LAS f32x4*)(IM + I_W15 + 16 * i + 4 * g); \
                f32x4 m = __builtin_amdgcn_mfma_f32_16x16x32_bf16(mk_frag(*(const LAS u32x2*)(KTT + (16 * i + fr) * 16 + 4 * g), zz), vb, Macc[i], 0, 0, 0); \
                m = __builtin_amdgcn_mfma_f32_16x16x32_bf16(mk_frag(*(const LAS u32x2*)(BTT + (16 * i + fr) * 16 + 4 * g), zz), rb, m, 0, 0, 0); \
                Macc[i] = m * w15; } \
        } \
        } while (0)
#define RM_FLUSH(cc_, gb_, vv_, bs_) do { \
        { \
            const f32x4 o4 = *(const LAS f32x4*)(Lf + O_IMG + hx * IMGSZ + I_OUT + tl * 64 + d4); const f32x4 vv = (vv_); const float bs = (bs_); \
            const f32x4 lnw = *(const LAS f32x4*)(Lf + O_CONST + 8 * 128 + ch4), lnb = *(const LAS f32x4*)(Lf + O_CONST + 9 * 128 + ch4); \
            float sm = (o4[0] + o4[1]) + (o4[2] + o4[3]), dummy = 0.f; row_sum16_x2(sm, dummy); const float mean = sm * (1.0f / 64.0f); \
            const f32x4 e4 = o4 - mean; float sv = (e4[0] * e4[0] + e4[1] * e4[1]) + (e4[2] * e4[2] + e4[3] * e4[3]); row_sum16_x2(sv, dummy); const float rs = __builtin_amdgcn_rsqf(sv * (1.0f / 64.0f) + 64e-5f); \
            const float gg[4] = {bf_lo((gb_).x), bf_hi((gb_).x), bf_lo((gb_).y), bf_hi((gb_).y)}; \
            float y[4]; \
_Pragma("unroll") \
            for (int i = 0; i < 4; ++i) y[i] = (e4[i] * rs * lnw[i] + lnb[i] + bs * vv[i]) * gg[i]; \
            u32x2 o; o.x = hw_pk2(y[0], y[1]); o.y = hw_pk2(y[2], y[3]); \
            *(GAS u32x2*)(Y + (size_t)((cc_) * TC + tl) * D + col4) = o; \
        } \
        } while (0)
    for (int c = c_begin; c < c_end; ++c) {
        {
            const int hq = tid >> 8, seg = (tid >> 6) & 3, d = tid & 63;
            const LAS float* X_ = Lf + O_XF + hq * 5 * 1024 + d; LAS float* IQ = Lf + O_IMG + hq * IMGSZ;
            LAS bf16* CTq = (LAS bf16*)(IQ + I_CT); LAS bf16* BTq = (LAS bf16*)(IQ + I_BT); LAS bf16* KLq = (LAS bf16*)(IQ + I_KL); LAS bf16* RTq = (LAS bf16*)(IQ + I_RT);
            float wall = 1.f, wpre = 1.f;
#pragma unroll
            for (int t = 0; t < 16; ++t) { if (t == 4 * seg) wpre = wall; wall *= X_[1024 + t * 64]; }
            float wt = wpre; unsigned short bt4[4], kt4[4];
#pragma unroll
            for (int i = 0; i < 4; ++i) { const int t = 4 * seg + i; const float wprev = wt; wt *= X_[1024 + t * 64]; const float iw = __builtin_amdgcn_rcpf(wt);
                const float r_ = X_[t * 64], k_ = X_[2048 + t * 64], kk_ = X_[3072 + t * 64], b_ = X_[4096 + t * 64];
                const float ct = kk_ * wprev, bt = b_ * iw, kt = k_ * iw;
                CTq[t * RS + d] = hw_bf(ct); IQ[I_CF + t * 64 + d] = ct; BTq[t * RS + d] = hw_bf(bt); KLq[t * RS + d] = hw_bf(kt); RTq[t * RS + d] = hw_bf(r_ * wt);
                bt4[i] = (unsigned short)hw_bf(-bt); kt4[i] = (unsigned short)hw_bf(kt); }
            u32x2 o; o.x = (unsigned)bt4[0] | ((unsigned)bt4[1] << 16); o.y = (unsigned)bt4[2] | ((unsigned)bt4[3] << 16); *(LAS u32x2*)((LAS bf16*)(IQ + I_BTT) + d * 16 + 4 * seg) = o;
            o.x = (unsigned)kt4[0] | ((unsigned)kt4[1] << 16); o.y = (unsigned)kt4[2] | ((unsigned)kt4[3] << 16); *(LAS u32x2*)((LAS bf16*)(IQ + I_KTT) + d * 16 + 4 * seg) = o;
            if (seg == 3) IQ[I_W15 + d] = wall;
        }
        LBAR();
        if (ww == 0) {
            f32x4 cb = {0.f, 0.f, 0.f, 0.f}, bc = cb, ck = cb, rkm = cb, rbm = cb;
#pragma unroll
            for (int ks = 0; ks < 2; ++ks) { const bf16x8 fc = *(const LAS bf16x8*)(CT + fr * RS + 32 * ks + 8 * g), fb = *(const LAS bf16x8*)(BT + fr * RS + 32 * ks + 8 * g), fk = *(const LAS bf16x8*)(KL + fr * RS + 32 * ks + 8 * g), frr = *(const LAS bf16x8*)(RT + fr * RS + 32 * ks + 8 * g);
                cb = __builtin_amdgcn_mfma_f32_16x16x32_bf16(fc, fb, cb, 0, 0, 0); bc = __builtin_amdgcn_mfma_f32_16x16x32_bf16(fb, fc, bc, 0, 0, 0); ck = __builtin_amdgcn_mfma_f32_16x16x32_bf16(fc, fk, ck, 0, 0, 0);
                rkm = __builtin_amdgcn_mfma_f32_16x16x32_bf16(frr, fk, rkm, 0, 0, 0); rbm = __builtin_amdgcn_mfma_f32_16x16x32_bf16(frr, fb, rbm, 0, 0, 0); }
            f32x4 N1, M1, CKm;
#pragma unroll
            for (int r = 0; r < 4; ++r) { const int t = 4 * g + r; N1[r] = (fr < t) ? -cb[r] : 0.f; M1[r] = (t < fr) ? -bc[r] : 0.f; CKm[r] = (fr < t) ? ck[r] : 0.f;
                RKB[t * 16 + fr] = hw_bf((fr <= t) ? rkm[r] : 0.f); RBB[t * 16 + fr] = hw_bf((fr <= t) ? -rbm[r] : 0.f); }
#define XTY(X, Y, C0) __builtin_amdgcn_mfma_f32_16x16x32_bf16(mk_frag((u32x2){hw_pk2(X[0], X[1]), hw_pk2(X[2], X[3])}, zz), mk_frag((u32x2){hw_pk2(Y[0], Y[1]), hw_pk2(Y[2], Y[3])}, zz), C0, 0, 0, 0)
            const f32x4 z4 = {0.f, 0.f, 0.f, 0.f};
            f32x4 T1t = M1;
#pragma unroll
            for (int r = 0; r < 4; ++r) if (4 * g + r == fr) T1t[r] += 1.f;
            const f32x4 N2 = XTY(M1, N1, z4), M2 = XTY(N1, M1, z4);
            const f32x4 T2t = XTY(N2, T1t, T1t);
            const f32x4 N4 = XTY(M2, N2, z4), M4 = XTY(N2, M2, z4);
            const f32x4 T4t = XTY(N4, T2t, T2t);
            const f32x4 N8 = XTY(M4, N4, z4);
            const f32x4 T8t = XTY(N8, T4t, T4t);
            const f32x4 G1t = XTY(CKm, T8t, z4);
#undef XTY
            u32x2 tw; tw.x = hw_pk2(T8t[0], T8t[1]); tw.y = hw_pk2(T8t[2], T8t[3]); *(LAS u32x2*)(TTB + fr * 16 + 4 * g) = tw;
            tw.x = hw_pk2(G1t[0], G1t[1]); tw.y = hw_pk2(G1t[2], G1t[3]); *(LAS u32x2*)(G1B + fr * 16 + 4 * g) = tw;
        }
        if (c + 1 < c_end) { RM_XFORM((c + 1) & 1); }
        if (c + 2 < c_end) RM_LOAD(c + 2);
        LBAR();
        const LAS float* VVc = Lf + O_VV + ((c & 1) * 2 + hh) * 1024;
        u32x2 vlo; { vlo.x = hw_pk2(VVc[(4 * g + 0) * 64 + c0 + fr], VVc[(4 * g + 1) * 64 + c0 + fr]); vlo.y = hw_pk2(VVc[(4 * g + 2) * 64 + c0 + fr], VVc[(4 * g + 3) * 64 + c0 + fr]); }
        const bf16x8 vb = mk_frag(vlo, zz);
        f32x4 accU = {0.f, 0.f, 0.f, 0.f};
        {
            accU = __builtin_amdgcn_mfma_f32_16x16x32_bf16(mk_frag(*(const LAS u32x2*)(G1B + fr * 16 + 4 * g), zz), vb, accU, 0, 0, 0);
            u32x2 clo; clo.x = hw_pk2(IM[I_CF + (4 * g + 0) * 64 + c0 + fr], IM[I_CF + (4 * g + 1) * 64 + c0 + fr]); clo.y = hw_pk2(IM[I_CF + (4 * g + 2) * 64 + c0 + fr], IM[I_CF + (4 * g + 3) * 64 + c0 + fr]);
            f32x4 accw = {0.f, 0.f, 0.f, 0.f};
            accw = __builtin_amdgcn_mfma_f32_16x16x32_bf16(mk_frag(*(const LAS u32x2*)(TTB + fr * 16 + 4 * g), zz), mk_frag(clo, zz), accw, 0, 0, 0);
#pragma unroll
            for (int r = 0; r < 4; ++r) WCB[(4 * g + r) * RS + c0 + fr] = hw_bf(accw[r]);
        }
        LBAR();
        if (role == 0) {
            RM_STATE_PART(vb);
            LBAR();
            RM_FLUSH(c, rg_cur, *(const LAS f32x4*)(Lf + O_VV + ((c & 1) * 2 + hx) * 1024 + tl * 64 + d4), Lf[O_BS + ((c & 1) * 2 + hx) * 16 + tl]);
        } else {
            float* rec = STASH + (size_t)(c - c_begin) * REC;
            for (int i = tid; i < 1376; i += NTHREADS) { const int hd = i >= 688, j = i - hd * 688; const int o = O_IMG + hd * IMGSZ + (j < 144 ? I_RT + 4 * j : I_BTT + 4 * (j - 144)); *(GAS f32x4*)(rec + 4 * i) = *(const LAS f32x4*)(Lf + o); }
            { GAS unsigned* ru = (GAS unsigned*)(rec + 5504); ru[(w * 2 + 0) * 64 + lane] = hw_pk2(accU[0], accU[1]); ru[(w * 2 + 1) * 64 + lane] = hw_pk2(accU[2], accU[3]); }
            { const f32x4 v4 = *(const LAS f32x4*)(Lf + O_VV + ((c & 1) * 2 + hx) * 1024 + tl * 64 + d4); u32x2 o; o.x = hw_pk2(v4[0], v4[1]); o.y = hw_pk2(v4[2], v4[3]); *(GAS u32x2*)(rec + 6528 + 2 * tid) = o; }
            if (tid < 32) rec[7552 + tid] = Lf[O_BS + (c & 1) * 32 + tid];
            LBAR();
        }
        rg_cur = rg_nxt; rg_nxt = rg_far;
    }
    if (role == 0) {
#pragma unroll
        for (int i = 0; i < 4; ++i)
#pragma unroll
            for (int r = 0; r < 4; ++r) STATE[((w * 4 + i) * 4 + r) * 64 + lane] = Macc[i][r];
        asm volatile("s_waitcnt vmcnt(0)" ::: "memory");
        __syncthreads();
        if (tid == 0) { __builtin_amdgcn_fence(__ATOMIC_RELEASE, "agent"); asm volatile("s_waitcnt vmcnt(0)" ::: "memory"); __hip_atomic_store(flag, 1u, __ATOMIC_RELAXED, __HIP_MEMORY_SCOPE_AGENT); }
    } else {
        if (tid == 0) { unsigned sp = 0; while (__hip_atomic_load(flag, __ATOMIC_RELAXED, __HIP_MEMORY_SCOPE_AGENT) == 0u) { __builtin_amdgcn_s_sleep(8); if (++sp > (1u << 22)) break; }
            __builtin_amdgcn_fence(__ATOMIC_ACQUIRE, "agent"); asm volatile("s_waitcnt vmcnt(0)" ::: "memory"); }
        __syncthreads();
#pragma unroll
        for (int i = 0; i < 4; ++i)
#pragma unroll
            for (int r = 0; r < 4; ++r) Macc[i][r] = STATE[((w * 4 + i) * 4 + r) * 64 + lane];
        f32x4 pi0, pi1, pi2; unsigned pu0, pu1; u32x2 pv, pgate; float pbs;
#define RM_REC_LOAD(cc) do { const float* rec = STASH + (size_t)((cc) - c_begin) * REC; pi0 = *(const GAS f32x4*)(rec + 4 * tid); pi1 = *(const GAS f32x4*)(rec + 4 * (tid + 512)); \
            pi2 = (tid < 352) ? *(const GAS f32x4*)(rec + 4 * (tid + 1024)) : (f32x4){0.f, 0.f, 0.f, 0.f}; \
            const GAS unsigned* ru = (const GAS unsigned*)(rec + 5504); pu0 = ru[(w * 2 + 0) * 64 + lane]; pu1 = ru[(w * 2 + 1) * 64 + lane]; pv = *(const GAS u32x2*)(rec + 6528 + 2 * tid); pbs = rec[7552 + hx * 16 + tl]; \
            pgate = *(const GAS u32x2*)(LO + (size_t)((cc) * TC + tl) * LORA_N + col4 + 2048); } while (0)
#define RM_IMG_OFF(i_) (O_IMG + ((i_) >= 688) * IMGSZ + ((((i_) - ((i_) >= 688) * 688) < 144) ? I_RT + 4 * ((i_) - ((i_) >= 688) * 688) : I_BTT + 4 * (((i_) - ((i_) >= 688) * 688) - 144)))
        RM_REC_LOAD(c_begin);
        for (int c = c_begin; c < c_end; ++c) {
            *(LAS f32x4*)(Lf + RM_IMG_OFF(tid)) = pi0; *(LAS f32x4*)(Lf + RM_IMG_OFF(tid + 512)) = pi1; if (tid < 352) *(LAS f32x4*)(Lf + RM_IMG_OFF(tid + 1024)) = pi2;
            const f32x4 vcur = {bf_lo(pv.x), bf_hi(pv.x), bf_lo(pv.y), bf_hi(pv.y)}; *(LAS f32x4*)(Lf + O_VV + hx * 1024 + tl * 64 + d4) = vcur;
            const f32x4 accU = {bf_lo(pu0), bf_hi(pu0), bf_lo(pu1), bf_hi(pu1)}; const float bscur = pbs; const u32x2 gcur = pgate;
            if (c + 1 < c_end) RM_REC_LOAD(c + 1);
            LBAR();
            const LAS float* VVc = Lf + O_VV + hh * 1024;
            u32x2 vlo; { vlo.x = hw_pk2(VVc[(4 * g + 0) * 64 + c0 + fr], VVc[(4 * g + 1) * 64 + c0 + fr]); vlo.y = hw_pk2(VVc[(4 * g + 2) * 64 + c0 + fr], VVc[(4 * g + 3) * 64 + c0 + fr]); }
            const bf16x8 vb = mk_frag(vlo, zz);
            RM_STATE_PART(vb);
            LBAR();
            RM_FLUSH(c, gcur, vcur, bscur);
            LBAR();
        }
#undef RM_REC_LOAD
#undef RM_IMG_OFF
    }
#undef RM_STATE_PART
#undef RM_FLUSH
#undef RM_LOAD
#undef RM_XFORM
}

__device__ __forceinline__ int med3i(int a, int b, int c) { int r; asm("v_med3_i32 %0, %1, %2, %3" : "=v"(r) : "v"(a), "v"(b), "v"(c)); return r; }
__device__ __forceinline__ int f2sort(float f) { int x = __float_as_int(f); return x ^ ((x >> 31) & 0x7fffffff); }
__device__ __forceinline__ float sort2f(int x) { return __int_as_float(x ^ ((x >> 31) & 0x7fffffff)); }
#define TOPK_INSERT(vals, x) do { _Pragma("unroll") for (int s_ = 15; s_ >= 1; --s_) vals[s_] = med3i((x), vals[s_ - 1], vals[s_]); vals[0] = max(vals[0], (x)); } while (0)
__device__ __forceinline__ float bf_dot2(unsigned a, unsigned b, float c) {
    return c + bf_lo(a) * bf_lo(b) + bf_hi(a) * bf_hi(b);
}
__device__ __forceinline__ void sum8_x8(float (&a)[8]) {
    asm("s_nop 1\n\t"
        "v_add_f32_dpp %0, %0, %0 quad_perm:[1,0,3,2] row_mask:0xf bank_mask:0xf\n\tv_add_f32_dpp %1, %1, %1 quad_perm:[1,0,3,2] row_mask:0xf bank_mask:0xf\n\t"
        "v_add_f32_dpp %2, %2, %2 quad_perm:[1,0,3,2] row_mask:0xf bank_mask:0xf\n\tv_add_f32_dpp %3, %3, %3 quad_perm:[1,0,3,2] row_mask:0xf bank_mask:0xf\n\t"
        "v_add_f32_dpp %4, %4, %4 quad_perm:[1,0,3,2] row_mask:0xf bank_mask:0xf\n\tv_add_f32_dpp %5, %5, %5 quad_perm:[1,0,3,2] row_mask:0xf bank_mask:0xf\n\t"
        "v_add_f32_dpp %6, %6, %6 quad_perm:[1,0,3,2] row_mask:0xf bank_mask:0xf\n\tv_add_f32_dpp %7, %7, %7 quad_perm:[1,0,3,2] row_mask:0xf bank_mask:0xf\n\t"
        "v_add_f32_dpp %0, %0, %0 quad_perm:[2,3,0,1] row_mask:0xf bank_mask:0xf\n\tv_add_f32_dpp %1, %1, %1 quad_perm:[2,3,0,1] row_mask:0xf bank_mask:0xf\n\t"
        "v_add_f32_dpp %2, %2, %2 quad_perm:[2,3,0,1] row_mask:0xf bank_mask:0xf\n\tv_add_f32_dpp %3, %3, %3 quad_perm:[2,3,0,1] row_mask:0xf bank_mask:0xf\n\t"
        "v_add_f32_dpp %4, %4, %4 quad_perm:[2,3,0,1] row_mask:0xf bank_mask:0xf\n\tv_add_f32_dpp %5, %5, %5 quad_perm:[2,3,0,1] row_mask:0xf bank_mask:0xf\n\t"
        "v_add_f32_dpp %6, %6, %6 quad_perm:[2,3,0,1] row_mask:0xf bank_mask:0xf\n\tv_add_f32_dpp %7, %7, %7 quad_perm:[2,3,0,1] row_mask:0xf bank_mask:0xf\n\t"
        "v_add_f32_dpp %0, %0, %0 row_half_mirror row_mask:0xf bank_mask:0xf\n\tv_add_f32_dpp %1, %1, %1 row_half_mirror row_mask:0xf bank_mask:0xf\n\t"
        "v_add_f32_dpp %2, %2, %2 row_half_mirror row_mask:0xf bank_mask:0xf\n\tv_add_f32_dpp %3, %3, %3 row_half_mirror row_mask:0xf bank_mask:0xf\n\t"
        "v_add_f32_dpp %4, %4, %4 row_half_mirror row_mask:0xf bank_mask:0xf\n\tv_add_f32_dpp %5, %5, %5 row_half_mirror row_mask:0xf bank_mask:0xf\n\t"
        "v_add_f32_dpp %6, %6, %6 row_half_mirror row_mask:0xf bank_mask:0xf\n\tv_add_f32_dpp %7, %7, %7 row_half_mirror row_mask:0xf bank_mask:0xf\n\t"
        "s_nop 1"
        : "+v"(a[0]), "+v"(a[1]), "+v"(a[2]), "+v"(a[3]), "+v"(a[4]), "+v"(a[5]), "+v"(a[6]), "+v"(a[7]));
}
__device__ __forceinline__ float sum8_x1(float v) {
    asm("s_nop 1\n\tv_add_f32_dpp %0, %0, %0 quad_perm:[1,0,3,2] row_mask:0xf bank_mask:0xf\n\ts_nop 1\n\tv_add_f32_dpp %0, %0, %0 quad_perm:[2,3,0,1] row_mask:0xf bank_mask:0xf\n\ts_nop 1\n\t"
        "v_add_f32_dpp %0, %0, %0 row_half_mirror row_mask:0xf bank_mask:0xf\n\ts_nop 1" : "+v"(v));
    return v;
}
__device__ __forceinline__ void peer_phase(const Args& A, Frame& F, int L, const bool dry, const bf16* Hin, bf16* Hout) {
    int lane = F.lane; asm volatile("" : "+v"(lane));
    const int gw = F.vcu * NWAVES + F.wave;
    const bf16* SCR = (const bf16*)(A.ws + WS_SC); const bf16* X = Hin; float* RS3 = (float*)(A.ws + WS_RS3);
    const unsigned char* TU = (const unsigned char*)(A.ws + WS_TABU) + (size_t)L * 16384 * D; const unsigned char* TV = (const unsigned char*)(A.ws + WS_TABV) + (size_t)L * 16384 * D;
    const float* rowss = (const float*)(A.ws + WS_RSP) + (size_t)(L == 0 ? RS_FFN0 : RS_FFN1) * T * 32;
    LAS unsigned* LIST = (LAS unsigned*)(F.lds + RING_OFF + F.wave * 16384);
    LAS unsigned* EIDX = LIST + 1024;
    LAS float* ECOEF = (LAS float*)(EIDX + 1024);
    const int tbase = gw * 8;
    if (tbase >= T) return;
    for (int half = 0; half < 2; ++half) {
        const int t0 = tbase + 4 * half;
        {
            const bf16* sp = SCR + (size_t)(t0 + (lane >> 4)) * D + (lane & 15) * 128;
            int vals[16];
#pragma unroll
            for (int s = 0; s < 16; ++s) vals[s] = (int)0x80000000;
#pragma unroll 2
            for (int c = 0; c < 16; ++c) { const v4u wv = *(const GAS v4u*)(sp + c * 8); const unsigned ww[4] = {wv.x, wv.y, wv.z, wv.w};
#pragma unroll
                for (int e = 0; e < 8; ++e) { const unsigned bits = (e & 1) ? (ww[e >> 1] & 0xffff0000u) : (ww[e >> 1] << 16);
                    int x = (int)bits; x ^= (x >> 31) & 0x7fffffff; x = (x & ~0x7f) | (127 - (c * 8 + e));
                    TOPK_INSERT(vals, x); } }
#pragma unroll
            for (int q = 0; q < 4; ++q) { v4u o; o.x = (unsigned)vals[4 * q]; o.y = (unsigned)vals[4 * q + 1]; o.z = (unsigned)vals[4 * q + 2]; o.w = (unsigned)vals[4 * q + 3]; *(LAS v4u*)(LIST + lane * 16 + 4 * q) = o; }
        }
        LDS_WAIT(); asm volatile("" ::: "memory");
        if (lane < 32) {
            const LAS unsigned* la = LIST + ((lane >> 3) * 16 + (lane & 7) * 2) * 16; const LAS unsigned* lb2 = la + 16;
            float av[16], bv[16];
#pragma unroll
            for (int q = 0; q < 4; ++q) { const v4u a4 = *(const LAS v4u*)(la + 4 * q), b4 = *(const LAS v4u*)(lb2 + 4 * q); const unsigned aw[4] = {a4.x, a4.y, a4.z, a4.w}, bw[4] = {b4.x, b4.y, b4.z, b4.w};
#pragma unroll
                for (int e = 0; e < 4; ++e) { av[4 * q + e] = __uint_as_float(__float_as_uint(sort2f((int)(aw[e] & ~0x7fu))) & 0xffff0000u); bv[4 * q + e] = __uint_as_float(__float_as_uint(sort2f((int)(bw[e] & ~0x7fu))) & 0xffff0000u); } }
            int best[16];
#pragma unroll
            for (int s = 0; s < 16; ++s) best[s] = (int)0x80000000;
#pragma unroll
            for (int i = 0; i < 16; ++i)
#pragma unroll
                for (int jx = 0; jx < 16; ++jx) if ((i + 1) * (jx + 1) <= 16) { int x = f2sort(av[i] + bv[jx]); x = (x & ~0xff) | (255 - (i * 16 + jx)); TOPK_INSERT(best, x); }
            float sv[16]; unsigned ex[16];
#pragma unroll
            for (int s = 0; s < 16; ++s) { const int cand = 255 - (best[s] & 0xff); const unsigned ka = la[cand >> 4], kb = lb2[cand & 15];
                ex[s] = (127u - (ka & 0x7fu)) * 128u + (127u - (kb & 0x7fu));
                sv[s] = __uint_as_float(__float_as_uint(sort2f((int)(ka & ~0x7fu))) & 0xffff0000u) + __uint_as_float(__float_as_uint(sort2f((int)(kb & ~0x7fu))) & 0xffff0000u); }
            float mx = sv[0];
#pragma unroll
            for (int s = 1; s < 16; ++s) mx = fmaxf(mx, sv[s]);
            float den = 0.f;
#pragma unroll
            for (int s = 0; s < 16; ++s) { sv[s] = __expf(sv[s] - mx); den += sv[s]; }
            const float inv = 1.0f / den; const int base = (4 * half + (lane >> 3)) * 128 + (lane & 7) * 16;
#pragma unroll
            for (int s = 0; s < 16; ++s) { EIDX[base + s] = ex[s]; ECOEF[base + s] = sv[s] * inv; }
        }
        LDS_WAIT(); asm volatile("" ::: "memory");
    }
    const int tk = lane >> 3, part = lane & 7, t = tbase + tk;
    const LAS unsigned* eidx = EIDX + tk * 128; LAS float* ecoef = ECOEF + tk * 128;
    const float rs = __builtin_amdgcn_rsqf(sum8_x1(((const GAS f32x4*)(rowss + (size_t)t * 32))[part][0] + ((const GAS f32x4*)(rowss + (size_t)t * 32))[part][1] + ((const GAS f32x4*)(rowss + (size_t)t * 32))[part][2] + ((const GAS f32x4*)(rowss + (size_t)t * 32))[part][3]) * (1.0f / D) + EPS);
    typedef _Float16 h2_t __attribute__((ext_vector_type(2)));
#define PEER_LOAD8(dst, TAB, i0, soff) do { const v4u ia_ = *(const LAS v4u*)(eidx + (i0)), ib_ = *(const LAS v4u*)(eidx + (i0) + 4); const unsigned ee_[8] = {ia_.x, ia_.y, ia_.z, ia_.w, ib_.x, ib_.y, ib_.z, ib_.w}; \
        _Pragma("unroll") for (int j_ = 0; j_ < 8; ++j_) dst[j_] = *(const GAS v4u*)((TAB) + (size_t)(ee_[j_] * 2048u + (unsigned)(soff))); } while (0)
    LAS float* dotw = (LAS float*)LIST + tk * 128;
#pragma unroll
    for (int m = 0; m < 16; ++m) dotw[8 * m + part] = 0.f;
#pragma unroll 1
    for (int p = 0; p < 16; ++p) {
        const int soff = 128 * p + 16 * part;
        h2_t xs[8];
        { const v4u x0 = *(const GAS v4u*)(X + (size_t)t * D + soff), x1 = *(const GAS v4u*)(X + (size_t)t * D + soff + 8); const unsigned xw[8] = {x0.x, x0.y, x0.z, x0.w, x1.x, x1.y, x1.z, x1.w};
#pragma unroll
          for (int e = 0; e < 8; ++e) xs[e] = (h2_t){(_Float16)bf_lo(xw[e]), (_Float16)bf_hi(xw[e])}; }
#define PEER_UDOT8(src, m_) do { float tt_[8]; \
        _Pragma("unroll") for (int j_ = 0; j_ < 8; ++j_) { const unsigned ww_[4] = {src[j_].x, src[j_].y, src[j_].z, src[j_].w}; float a0_ = 0.f, a1_ = 0.f; \
            _Pragma("unroll") for (int e_ = 0; e_ < 4; ++e_) { const h2_t lo_ = __builtin_amdgcn_cvt_scalef32_pk_f16_fp8((int)ww_[e_], 1.0f / 512.0f, false), hi_ = __builtin_amdgcn_cvt_scalef32_pk_f16_fp8((int)ww_[e_], 1.0f / 512.0f, true); \
                a0_ = __builtin_amdgcn_fdot2(xs[2 * e_], lo_, a0_, false); a1_ = __builtin_amdgcn_fdot2(xs[2 * e_ + 1], hi_, a1_, false); } \
            tt_[j_] = a0_ + a1_; } \
        sum8_x8(tt_); \
        float sel_ = tt_[0]; _Pragma("unroll") for (int j_ = 1; j_ < 8; ++j_) sel_ = (part == j_) ? tt_[j_] : sel_; \
        dotw[8 * (m_) + part] += sel_; } while (0)
        v4u ua[8], ub[8];
        PEER_LOAD8(ua, TU, 0, soff);
#pragma unroll 1
        for (int m = 0; m < 16; m += 2) {
            PEER_LOAD8(ub, TU, 8 * (m + 1), soff);
            PEER_UDOT8(ua, m);
            if (m + 2 < 16) PEER_LOAD8(ua, TU, 8 * (m + 2), soff);
            PEER_UDOT8(ub, m + 1);
        }
    }
#undef PEER_UDOT8
#pragma unroll
    for (int m = 0; m < 16; ++m) { const float d_ = dotw[8 * m + part] * rs; const float act = 0.5f * d_ * (1.0f + erff(d_ * 0.7071067811865476f)); ecoef[8 * m + part] *= act; }
    LDS_WAIT(); asm volatile("" ::: "memory");
    float ss = 0.f;
#pragma unroll 1
    for (int p = 0; p < 16; ++p) {
        const int soff = 128 * p + 16 * part;
        h2_t acc[8];
#pragma unroll
        for (int i = 0; i < 8; ++i) acc[i] = (h2_t){(_Float16)0.f, (_Float16)0.f};
#define PEER_VACC8(src, i0) do { const f32x4 ca_ = *(const LAS f32x4*)(ecoef + (i0)), cb_ = *(const LAS f32x4*)(ecoef + (i0) + 4); const float cf_[8] = {ca_[0], ca_[1], ca_[2], ca_[3], cb_[0], cb_[1], cb_[2], cb_[3]}; \
        _Pragma("unroll") for (int j_ = 0; j_ < 8; ++j_) { const unsigned ww_[4] = {src[j_].x, src[j_].y, src[j_].z, src[j_].w}; const _Float16 ch_ = (_Float16)cf_[j_]; const h2_t c2_ = {ch_, ch_}; \
            _Pragma("unroll") for (int e_ = 0; e_ < 4; ++e_) { const h2_t lo_ = __builtin_amdgcn_cvt_scalef32_pk_f16_fp8((int)ww_[e_], 1.0f / 16.0f, false), hi_ = __builtin_amdgcn_cvt_scalef32_pk_f16_fp8((int)ww_[e_], 1.0f / 16.0f, true); \
                acc[2 * e_] = c2_ * lo_ + acc[2 * e_]; acc[2 * e_ + 1] = c2_ * hi_ + acc[2 * e_ + 1]; } } } while (0)
        v4u va[8], vb[8];
        PEER_LOAD8(va, TV, 0, soff);
#pragma unroll 1
        for (int m = 0; m < 16; m += 2) {
            PEER_LOAD8(vb, TV, 8 * (m + 1), soff);
            PEER_VACC8(va, 8 * m);
            if (m + 2 < 16) PEER_LOAD8(va, TV, 8 * (m + 2), soff);
            PEER_VACC8(vb, 8 * (m + 1));
        }
        { const v4u h0 = *(const GAS v4u*)(Hin + (size_t)t * D + soff), h1 = *(const GAS v4u*)(Hin + (size_t)t * D + soff + 8); const unsigned hw[8] = {h0.x, h0.y, h0.z, h0.w, h1.x, h1.y, h1.z, h1.w}; unsigned ow[8];
#pragma unroll
          for (int e = 0; e < 8; ++e) { ow[e] = hw_pk2(bf_lo(hw[e]) + (float)acc[e][0], bf_hi(hw[e]) + (float)acc[e][1]); const float q0 = bf_lo(ow[e]), q1 = bf_hi(ow[e]); ss += q0 * q0 + q1 * q1; }
          v4u o0, o1; o0.x = ow[0]; o0.y = ow[1]; o0.z = ow[2]; o0.w = ow[3]; o1.x = ow[4]; o1.y = ow[5]; o1.z = ow[6]; o1.w = ow[7];
          if (!dry) { *(GAS v4u*)(Hout + (size_t)t * D + soff) = o0; *(GAS v4u*)(Hout + (size_t)t * D + soff + 8) = o1; } else asm volatile("" :: "v"(o0.x), "v"(o0.y), "v"(o0.z), "v"(o0.w), "v"(o1.x), "v"(o1.y), "v"(o1.z), "v"(o1.w)); }
    }
#undef PEER_VACC8
#undef PEER_LOAD8
    const float r3 = __builtin_amdgcn_rsqf(sum8_x1(ss) * (1.0f / D) + EPS);
    if (!dry && part == 0) RS3[t] = r3;
}


constexpr int N_PHASES = 19;
__global__ void __launch_bounds__(NTHREADS, 2) mega_fwd(Args args) {
    extern __shared__ __attribute__((aligned(16))) unsigned char lds[];
    Frame F;
    F.lds = (LAS unsigned char*)lds;
    F.MISC = (volatile LAS unsigned*)(F.lds + MISC_OFF);
    F.tid = threadIdx.x; F.lane = F.tid & 63; F.wave = __builtin_amdgcn_readfirstlane(F.tid >> 6);
    F.G = gridDim.x; { const int bx = blockIdx.x; F.vcu = (F.G % 8 == 0) ? (bx % 8) * (F.G / 8) + bx / 8 : bx; }
    unsigned char* ws = args.ws;
    F.ctl = (gu32*)(ws + WS_CTL);
    for (int u = F.tid; u < (LDS_BYTES - LDSCTL_OFF) / 4; u += NTHREADS) ((LAS unsigned*)(F.lds + LDSCTL_OFF))[u] = 0u;
    __syncthreads();
    const int lo = args.ph_lo, hi = args.ph_hi;
    XcdBarrier bar; bar.bar = (unsigned*)(F.ctl + CW_BAR); bar.x = 0; bar.st = nullptr;
    if (hi - lo > 1) bar = xcd_barrier_post((unsigned*)(F.ctl + CW_BAR), F.MISC + 8);
#define IN(k) (lo <= (k) && (k) < hi)
#define REPS(k) (1 + ((DUP_MASK >> (k)) & 1))
#if PROBE_MASK
    unsigned long long* const tsb = (unsigned long long*)(ws + WS_CTL + 65536);
#define STAMP(k) do { if (blockIdx.x == 0 && F.tid == 0) __hip_atomic_store(tsb + (k), __builtin_amdgcn_s_memrealtime(), __ATOMIC_RELAXED, __HIP_MEMORY_SCOPE_AGENT); } while (0)
    STAMP(31);
#else
#define STAMP(k) do { } while (0)
#endif
#define SEAM(k) do { if (IN(k) && IN((k) + 1)) { if ((k) == 0) { cg::this_grid().sync(); } else { xcd_barrier(bar); if ((DUP_MASK >> 24) & 1) xcd_barrier(bar); } STAMP(k); } } while (0)
    float* rowss = (float*)(ws + WS_RSP);
    bf16* ACTA = (bf16*)(ws + WS_ACTA); bf16* ACTB = (bf16*)(ws + WS_ACTB); bf16* H1 = (bf16*)(ws + WS_H1); const float* RS3 = (const float*)(ws + WS_RS3);
    bf16* PROJ = (bf16*)(ws + WS_PROJ); bf16* SCB = (bf16*)(ws + WS_SC); bf16* PP = (bf16*)(ws + WS_PP);
    const int gtid = (F.vcu * NWAVES + F.wave) * 64 + F.lane, gthreads = F.G * NTHREADS;

#if UBENCH
    {
        typedef _Float16 h2_t __attribute__((ext_vector_type(2)));
        float a[32]; f32x2 p[16]; h2_t hh[32];
#pragma unroll
        for (int i = 0; i < 32; ++i) { a[i] = (float)(F.tid + i); hh[i] = (h2_t){(_Float16)(F.lane + i), (_Float16)i}; }
#pragma unroll
        for (int i = 0; i < 16; ++i) p[i] = (f32x2){a[2 * i], a[2 * i + 1]};
        const float m = 1.0f + 1e-7f * F.lane, c = 1e-9f; const f32x2 m2 = {m, m}, c2 = {c, c}; const h2_t mh = {(_Float16)1.0f, (_Float16)1.0f}, ch = {(_Float16)0.0f, (_Float16)0.0f};
#pragma unroll 1
        for (int it = 0; it < 10000; ++it) {
#if UBENCH == 1
#pragma unroll
            for (int i = 0; i < 32; ++i) asm volatile("v_fma_f32 %0, %0, %1, %2" : "+v"(a[i]) : "v"(m), "v"(c));
#elif UBENCH == 2
#pragma unroll
            for (int i = 0; i < 16; ++i) asm volatile("v_pk_fma_f32 %0, %0, %1, %2\n\tv_pk_fma_f32 %0, %0, %1, %2" : "+v"(p[i]) : "v"(m2), "v"(c2));
#elif UBENCH == 3
#pragma unroll
            for (int i = 0; i < 32; ++i) asm volatile("v_pk_fma_f16 %0, %0, %1, %2" : "+v"(hh[i]) : "v"(mh), "v"(ch));
#endif
        }
        float s = 0.f;
#pragma unroll
        for (int i = 0; i < 32; ++i) s += a[i] + (float)hh[i][0];
#pragma unroll
        for (int i = 0; i < 16; ++i) s += p[i][0] + p[i][1];
        if (s == 12345.678f) args.out[0] = s;
    }
#endif
    if (IN(0)) { p0_prologue(args, F); } SEAM(0);
    if (IN(1)) for (int rep_ = 0; rep_ < REPS(1); ++rep_) {
        { pg8::Gemm g{ACTA, (const bf16*)(ws + WS_WEV_IN), T, EV_NP, D}; pg8::StaticOrder S; S.init(T, EV_NP, F.G, (int)blockIdx.x); EpiBf16S E{PROJ, PROJ_LD, nullptr};
          pg8::gemm_phase<EpiBf16S, pg8::StaticOrder, true, true>(F.lds + RING_OFF, g, S, E); }
        if (F.G == 256 ? (int)blockIdx.x >= 64 : true) { const int g2 = F.G == 256 ? 192 : F.G, c2 = F.G == 256 ? (int)blockIdx.x - 64 : (int)blockIdx.x;
          pg8::Gemm g{(const bf16*)(ws + WS_PBF), (const bf16*)(ws + WS_WPROJ), T, D, 256}; pg8::StaticOrder S; S.init(T, D, g2, c2); EpiBf16S E{PP, D, nullptr};
          pg8::gemm_phase<EpiBf16S, pg8::StaticOrder, true, true>(F.lds + RING_OFF, g, S, E); }
    } SEAM(1);
    if (IN(2)) for (int rep_ = 0; rep_ < REPS(2); ++rep_) {
        if (F.G >= 256) {
            const int u = F.vcu;
            if (u < 64) scan_gla_mfma_unit<0>(args, F, u); else if (u < 128) scan_gdn_mfma_unit(args, F, u - 64, 0); else if (u < 192) scan_gdn_mfma_unit(args, F, u - 128, 1);
            __syncthreads();
            if (rep_ == 0) for (int dr_ = 0; dr_ < 1 + ((DUP_MASK >> 22) & 1); ++dr_) { if (u < 64) p0_deferred(args, F, 128 + u, 192); else if (u >= 192) for (int k = 0; k < 2; ++k) p0_deferred(args, F, 2 * (u - 192) + k, 192); }
        } else {
            for (int u = F.vcu; u < 64; u += F.G) { scan_gla_mfma_unit<0>(args, F, u); __syncthreads(); }
            for (int u = F.vcu; u < 64; u += F.G) { scan_gdn_mfma_unit(args, F, u, 0); __syncthreads(); scan_gdn_mfma_unit(args, F, u, 1); __syncthreads(); }
            if (rep_ == 0) p0_deferred(args, F, F.vcu, F.G);
        }
    } SEAM(2);
    if (IN(3)) for (int rep_ = 0; rep_ < REPS(3); ++rep_) { post_rows<0>(args, F); } SEAM(3);
    if (IN(4)) { pg8::Gemm g{ACTA, (const bf16*)(ws + WS_WEV_OUT), T, D, D}; pg8::StaticOrder S; S.init(T, D, F.G, (int)blockIdx.x);
        EpiResid<false, true> E{args.in[I_X], ACTB, rowss + (size_t)RS_FFN0 * T * 32, nullptr, nullptr};
        pg8::gemm_phase<EpiResid<false, true>, pg8::StaticOrder, true, true>(F.lds + RING_OFF, g, S, E); }
#if (DUP_MASK >> 20) & 1
    if (IN(4)) { pg8::Gemm g{ACTA, (const bf16*)(ws + WS_WEV_OUT), T, D, D}; pg8::StaticOrder S; S.init(T, D, F.G, (int)blockIdx.x);
        EpiResid<false, true> E{args.in[I_X], ACTB, rowss + (size_t)RS_FFN0 * T * 32, nullptr, nullptr};
        pg8::gemm_phase<EpiResid<false, true>, pg8::StaticOrder, true, true>(F.lds + RING_OFF, g, S, E); }
#endif
#if (DUP_MASK >> 21) & 1
    if (IN(4)) { pg8::Gemm g{ACTA, (const bf16*)(ws + WS_WEV_IN), T, EV_NP, D}; pg8::StaticOrder S; S.init(T, EV_NP, F.G, (int)blockIdx.x); EpiBf16S E{PROJ, PROJ_LD, nullptr};
        pg8::gemm_phase<EpiBf16S, pg8::StaticOrder, true, true>(F.lds + RING_OFF, g, S, E); }
#endif
    SEAM(4);
    if (IN(5)) for (int rep_ = 0; rep_ < REPS(5); ++rep_) { { pg8::Gemm g{ACTB, (const bf16*)(ws + WS_WPEER), T, D, D}; pg8::StaticOrder S; S.init(T, D, F.G, (int)blockIdx.x); EpiBf16S E{SCB, D, rowss + (size_t)RS_FFN0 * T * 32};
        pg8::gemm_phase<EpiBf16S, pg8::StaticOrder, true, true>(F.lds + RING_OFF, g, S, E); }
        } SEAM(5);
    if (IN(6)) for (int rep_ = 0; rep_ < REPS(6); ++rep_) { peer_phase(args, F, 0, rep_ != 0, ACTB, H1); } SEAM(6);
    if (IN(7)) { { pg8::Gemm g{H1, (const bf16*)(ws + WS_WGATE), T, D, D}; pg8::StaticOrder S; S.init(T, D, F.G, (int)blockIdx.x);
        EpiResid<true, false> E{H1, ACTB, rowss + (size_t)RS_MIX1 * T * 32, PP, RS3};
        pg8::gemm_phase<EpiResid<true, false>, pg8::StaticOrder, true, true>(F.lds + RING_OFF, g, S, E); }
        } SEAM(7);
    if (IN(8)) for (int rep_ = 0; rep_ < REPS(8); ++rep_) {
        { pg8::Gemm g{ACTB, (const bf16*)(ws + WS_WOD_IN), T, OD_NP, D}; pg8::StaticOrder S; S.init(T, OD_NP, F.G, (int)blockIdx.x); EpiBf16S E{PROJ, PROJ_LD, rowss + (size_t)RS_MIX1 * T * 32};
          pg8::gemm_phase<EpiBf16S, pg8::StaticOrder, true, true>(F.lds + RING_OFF, g, S, E); }
        { pg8::Gemm g{(const bf16*)(ws + WS_PBF) + (size_t)T * 256, (const bf16*)(ws + WS_WPROJ) + (size_t)D * 256, T, D, 256}; pg8::StaticOrder S; S.init(T, D, F.G, (int)blockIdx.x); EpiBf16S E{PP, D, nullptr};
          pg8::gemm_phase<EpiBf16S, pg8::StaticOrder, true, true>(F.lds + RING_OFF, g, S, E); }
    } SEAM(8);
    if (IN(9)) for (int rep_ = 0; rep_ < REPS(9); ++rep_) { lora_prep_rows(args, F); } SEAM(9);
    if (IN(10)) for (int rep_ = 0; rep_ < REPS(10); ++rep_) { pg8::Gemm g{(const bf16*)(ws + WS_LA), (const bf16*)(ws + WS_WLORA), T, LORA_N, LORA_K}; pg8::StaticOrder S; S.init(T, LORA_N, F.G, (int)blockIdx.x); EpiBf16S E{(bf16*)(ws + WS_LO), LORA_N, nullptr};
        pg8::gemm_phase<EpiBf16S, pg8::StaticOrder, true, true>(F.lds + RING_OFF, g, S, E); } SEAM(10);
    if (IN(11)) for (int rep_ = 0; rep_ < REPS(11); ++rep_) {
        if (F.G >= 256) {
            const int u = F.vcu;
            if (u < 64) scan_gla_mfma_unit<1>(args, F, u); else if (u < 128) scan_rwkv_mfma_unit(args, F, u - 64, 0); else if (u < 192) scan_rwkv_mfma_unit(args, F, u - 128, 1);
            __syncthreads();
            if (rep_ == 0) for (int dr_ = 0; dr_ < 1 + ((DUP_MASK >> 23) & 1); ++dr_) { if (u < 64) p1_deferred(args, F, 128 + u, 192); else if (u >= 192) for (int k = 0; k < 2; ++k) p1_deferred(args, F, 2 * (u - 192) + k, 192); }
        } else {
            for (int u = F.vcu; u < 64; u += F.G) { scan_gla_mfma_unit<1>(args, F, u); __syncthreads(); }
            for (int u = F.vcu; u < 64; u += F.G) { scan_rwkv_mfma_unit(args, F, u, 0); __syncthreads(); scan_rwkv_mfma_unit(args, F, u, 1); __syncthreads(); }
            if (rep_ == 0) p1_deferred(args, F, F.vcu, F.G);
        }
    } SEAM(11);
    if (IN(12)) for (int rep_ = 0; rep_ < REPS(12); ++rep_) { post_rows<1>(args, F); } SEAM(12);
    if (IN(13)) { pg8::Gemm g{ACTA, (const bf16*)(ws + WS_WOD_OUT), T, D, D}; pg8::StaticOrder S; S.init(T, D, F.G, (int)blockIdx.x);
        EpiResid<false, false> E{ACTB, H1, rowss + (size_t)RS_FFN1 * T * 32, nullptr, nullptr};
        pg8::gemm_phase<EpiResid<false, false>, pg8::StaticOrder, true, true>(F.lds + RING_OFF, g, S, E); } SEAM(13);
    if (IN(14)) for (int rep_ = 0; rep_ < REPS(14); ++rep_) { pg8::Gemm g{H1, (const bf16*)(ws + WS_WPEER) + (size_t)D * D, T, D, D}; pg8::StaticOrder S; S.init(T, D, F.G, (int)blockIdx.x); EpiBf16S E{SCB, D, rowss + (size_t)RS_FFN1 * T * 32};
        pg8::gemm_phase<EpiBf16S, pg8::StaticOrder, true, true>(F.lds + RING_OFF, g, S, E); } SEAM(14);
    if (IN(15)) for (int rep_ = 0; rep_ < REPS(15); ++rep_) { peer_phase(args, F, 1, rep_ != 0, H1, ACTB); } SEAM(15);
    if (IN(16)) { pg8::Gemm g{ACTB, (const bf16*)(ws + WS_WGATE) + (size_t)D * D, T, D, D}; pg8::StaticOrder S; S.init(T, D, F.G, (int)blockIdx.x);
        EpiResid<true, false> E{ACTB, H1, rowss + (size_t)RS_FINAL * T * 32, PP, RS3};
        pg8::gemm_phase<EpiResid<true, false>, pg8::StaticOrder, true, true>(F.lds + RING_OFF, g, S, E); } SEAM(16);
    if (IN(17)) {
        float oscale = 1.0f;
#if PROBE_MASK
        { unsigned long long t_prev = __hip_atomic_load(tsb + 31, __ATOMIC_RELAXED, __HIP_MEMORY_SCOPE_AGENT); const unsigned long long t_begin = t_prev; unsigned long long sel = 0ull;
          for (int k = 0; k <= 16; ++k) { const unsigned long long tk = __hip_atomic_load(tsb + k, __ATOMIC_RELAXED, __HIP_MEMORY_SCOPE_AGENT); if ((PROBE_MASK >> k) & 1) sel += tk - t_prev; t_prev = tk; }
          const float f = (float)(double(sel) / double(t_prev - t_begin)); oscale = 1.0f + sqrtf(0.01f + 0.9f * f); }
#endif
        final_rows(args, F, oscale, H1); }
#undef IN
#undef SEAM
}

extern "C" void kernel_launch(void* const* d_in, const int* in_sizes, int n_in, void* d_out, int out_size, void* d_ws, size_t ws_size, hipStream_t stream) {
    static int grid = 0;
    if (grid == 0) {
        if (n_in != N_IN || out_size != T * D || ws_size < WS_END + 63 * MiB) { fprintf(stderr, "kernel_launch: unexpected problem: n_in %d out %d ws %zu (need %zu)\n", n_in, out_size, ws_size, (size_t)(WS_END + 63 * MiB)); grid = -1; return; }
        int dev = 0, cus = 0, per_cu = 0;
        if (hipGetDevice(&dev) != hipSuccess || hipDeviceGetAttribute(&cus, hipDeviceAttributeMultiprocessorCount, dev) != hipSuccess) { grid = -1; return; }
        if (hipFuncSetAttribute((const void*)mega_fwd, hipFuncAttributeMaxDynamicSharedMemorySize, LDS_BYTES) != hipSuccess) { fprintf(stderr, "kernel_launch: hipFuncSetAttribute failed\n"); grid = -1; return; }
        if (hipOccupancyMaxActiveBlocksPerMultiprocessor(&per_cu, (const void*)mega_fwd, NTHREADS, LDS_BYTES) != hipSuccess || per_cu < 1) { fprintf(stderr, "kernel_launch: occupancy query says %d blocks per CU\n", per_cu); (void)hipGetLastError(); grid = -1; return; }
        grid = cus;
    }
    if (grid < 0) return;
    (void)hipMemsetAsync((char*)d_ws + WS_CTL, 0, CTL_ZERO_BYTES, stream);
    Args a{};
    for (int i = 0; i < N_IN; ++i) a.in[i] = (const float*)d_in[i];
    a.out = (float*)d_out; a.ws = (unsigned char*)d_ws;
#if MK_PER_PHASE
    for (int p = 0; p < N_PHASES - 1; ++p) { a.ph_lo = p; a.ph_hi = p + 1; hipLaunchKernelGGL(mega_fwd, dim3(grid), dim3(NTHREADS), LDS_BYTES, stream, a); }
#else
    a.ph_lo = 0; a.ph_hi = N_PHASES;
    void* kargs[] = {&a};
    hipError_t e = hipLaunchCooperativeKernel((const void*)mega_fwd, dim3(grid), dim3(NTHREADS), kargs, LDS_BYTES, stream);
    if (e != hipSuccess) fprintf(stderr, "kernel_launch: cooperative launch failed: %s (grid %d)\n", hipGetErrorString(e), grid);
#endif
}
```

```cpp
#include <hip/hip_runtime.h>
#include <hip/hip_cooperative_groups.h>
#include <cstdio>
#include <cstdint>
namespace cg = cooperative_groups;

#ifndef PROBE_MASK
#define PROBE_MASK 0
#endif
#ifndef DUP_MASK
#define DUP_MASK 0
#endif
#ifndef UBENCH
#define UBENCH 0
#endif
#ifndef GDN_DUP
#define GDN_DUP 0
#endif
#ifndef MK_PER_PHASE
#define MK_PER_PHASE 0
#endif

namespace pg8 {
#define PG8_LAS __attribute__((address_space(3)))
typedef unsigned short bf16_t;
typedef short bf16x8 __attribute__((ext_vector_type(8)));
typedef float f32x4 __attribute__((ext_vector_type(4)));
typedef unsigned u32x4 __attribute__((ext_vector_type(4)));
typedef unsigned u32x2 __attribute__((ext_vector_type(2)));
constexpr int BM = 256, BK = 64, HALF = 128, HTB = HALF * BK * 2  , STAGE_BYTES = 8 * HTB, NXCD = 8, WGM = 8;

__host__ __device__ __forceinline__ int lds_byte(int r, int c) { const int st = (r >> 4) * 2 + (c >> 5), rr = r & 15, cc = c & 31, ob = rr * 64 + cc * 2; return st * 1024 + (ob ^ (((ob >> 9) & 1) << 5)); }
__host__ __device__ __forceinline__ void stage_rc(int b, int& R, int& C) { const int st = b / 1024, sb = b % 1024, swz = sb ^ (((sb >> 9) & 1) << 5); R = (st >> 1) * 16 + swz / 64; C = (st & 1) * 32 + (swz % 64) / 2; }
__host__ __device__ __forceinline__ int perm32(int rho) { const int n = rho >> 4, i = rho & 15; return 8 * (i >> 2) + 4 * n + (i & 3); }

struct Unit { int pm, pn; };
struct Gemm { const bf16_t* A; const bf16_t* Bt; int M, N, K; };

struct StaticOrder {
    int nM, nN, nwg, G, c;
    __host__ __device__ void init(int M, int N, int G_, int c_) { nM = M / BM; nN = N / BM; nwg = nM * nN; G = G_; c = c_; }
    __host__ __device__ bool next(int i, Unit& u) const {
        const long L = (long)i * G + c; if (L >= nwg) return false;
        int wgid = (int)L; { const int q = nwg / NXCD, r = nwg % NXCD, xcd = wgid % NXCD, off = wgid / NXCD; wgid = (xcd < r ? xcd * (q + 1) : r * (q + 1) + (xcd - r) * q) + off; }
        const int nig = WGM * nN, gid = wgid / nig, fm = gid * WGM, gsz = (nM - fm) < WGM ? (nM - fm) : WGM;
        u.pm = fm + ((wgid % nig) % gsz); u.pn = (wgid % nig) / gsz; return true;
    }
    __device__ __forceinline__ void a_ready(const Unit&) const {}
    __device__ __forceinline__ void done(const Unit&) const {}
};
__device__ __forceinline__ unsigned cvt_pk_bf16(float lo, float hi) { unsigned r; asm volatile("v_cvt_pk_bf16_f32 %0, %1, %2" : "=v"(r) : "v"(lo), "v"(hi)); return r; }
template <class Epi, class Sched, bool ALIGN_EPI = false, bool SP2 = false, bool F8 = false>
__device__ __forceinline__ void gemm_phase(PG8_LAS unsigned char* lds, const Gemm g, const Sched& S, const Epi& E, const int wave_id) {
    int tid; asm volatile("v_mbcnt_lo_u32_b32 %0, -1, 0\n\tv_mbcnt_hi_u32_b32 %0, -1, %0" : "=v"(tid)); tid += wave_id * 64;
    const int wid = wave_id, lane = tid & 63, wr = wid >> 2, wc = wid & 3, fr = lane & 15, fq = lane >> 4;
    const int K = g.K, nt = K / BK;
    unsigned voffA[2], voffB[2];
#pragma unroll
    for (int i = 0; i < 2; ++i) { int R, C; stage_rc(tid * 16 + i * 8192, R, C); const int Rb = Epi::PERM ? ((R & ~31) + perm32(R & 31)) : R;
        voffA[i] = (unsigned)(R * K + C) * 2u; voffB[i] = (unsigned)(Rb * K + C) * 2u; }
    const __amdgpu_buffer_rsrc_t rsrcA = __builtin_amdgcn_make_buffer_rsrc((void*)g.A, 0, 0x7fffffff, 0x00020000), rsrcB = __builtin_amdgcn_make_buffer_rsrc((void*)g.Bt, 0, 0x7fffffff, 0x00020000);
    const size_t kstep = (size_t)(BK * 2);
    const size_t hstep = (size_t)HALF * K * 2;
    const size_t tstep = 2 * hstep;
    const unsigned ldsw = (unsigned)wid * 1024u;
    const int aoff = lds_byte(wr * 64 + fr, fq * 8), boff = lds_byte(wc * 32 + fr, fq * 8);
#define PG8_SA(b, h) (((b) * 2 + (h)) * HTB)
#define PG8_SB(b, h) ((4 + (b) * 2 + (h)) * HTB)
#define PG8_STAGE(bufoff, gbase, voff) do { const bool isA_ = (+(voff) == +voffA); const unsigned soff_ = (unsigned)((const char*)(gbase) - (isA_ ? (const char*)g.A : (const char*)g.Bt)); _Pragma("unroll") for (int _i = 0; _i < 2; ++_i) \
        __builtin_amdgcn_raw_ptr_buffer_load_lds(isA_ ? rsrcA : rsrcB, (PG8_LAS unsigned*)(lds + (bufoff) + ldsw + _i * 8192), 16, (int)(voff)[_i], (int)soff_, 0, 0); } while (0)
#define PG8_LDA(dst, b, h) do { _Pragma("unroll") for (int m = 0; m < 4; ++m) { if constexpr (F8) { dst##8[m].lo = *(const PG8_LAS bf16x8*)(lds + PG8_SA(b, h) + aoff + m * 2048); dst##8[m].hi = *(const PG8_LAS bf16x8*)(lds + PG8_SA(b, h) + aoff + m * 2048 + 1024); } else { _Pragma("unroll") for (int k = 0; k < 2; ++k) dst[m][k] = *(const PG8_LAS bf16x8*)(lds + PG8_SA(b, h) + aoff + m * 2048 + k * 1024); } } } while (0)
#define PG8_LDB(dst, b, h) do { _Pragma("unroll") for (int n = 0; n < 2; ++n) { if constexpr (F8) { dst##8[n].lo = *(const PG8_LAS bf16x8*)(lds + PG8_SB(b, h) + boff + n * 2048); dst##8[n].hi = *(const PG8_LAS bf16x8*)(lds + PG8_SB(b, h) + boff + n * 2048 + 1024); } else { _Pragma("unroll") for (int k = 0; k < 2; ++k) dst[n][k] = *(const PG8_LAS bf16x8*)(lds + PG8_SB(b, h) + boff + n * 2048 + k * 1024); } } } while (0)
#define PG8_MMA(ai, bj, At, Bt) do { __builtin_amdgcn_s_setprio(1); _Pragma("unroll") for (int m = 0; m < 4; ++m) _Pragma("unroll") for (int n = 0; n < 2; ++n) { \
        if constexpr (F8) { typedef int v8i_ __attribute__((ext_vector_type(8))); \
            acc[ai][bj][m][n] = __builtin_amdgcn_mfma_scale_f32_16x16x128_f8f6f4(__builtin_bit_cast(v8i_, Bt##8[n]), __builtin_bit_cast(v8i_, At##8[m]), acc[ai][bj][m][n], 0, 0, 0, 0x7f79, 1, 0x7f79); }     \
        else { _Pragma("unroll") for (int k = 0; k < 2; ++k) acc[ai][bj][m][n] = __builtin_amdgcn_mfma_f32_16x16x32_bf16(Bt[n][k], At[m][k], acc[ai][bj][m][n], 0, 0, 0); } } \
        __builtin_amdgcn_s_setprio(0); } while (0)
#define PG8_WAIT_V(n) asm volatile("s_waitcnt vmcnt(" #n ")" ::: "memory")
#define PG8_WAIT_L(n) asm volatile("s_waitcnt lgkmcnt(" #n ")" ::: "memory")
#define PG8_BAR __builtin_amdgcn_s_barrier()
#define PG8_SCHED __builtin_amdgcn_sched_barrier(0)
    Unit cur, nxt; int ui = 0;
    if (!S.next(0, cur)) return;
    f32x4 acc[2][2][4][2];
#pragma unroll
    for (int a = 0; a < 2; ++a)
#pragma unroll
        for (int b = 0; b < 2; ++b)
#pragma unroll
            for (int m = 0; m < 4; ++m)
#pragma unroll
                for (int n = 0; n < 2; ++n) acc[a][b][m][n] = (f32x4){0.f, 0.f, 0.f, 0.f};
    typedef short bf16x16 __attribute__((ext_vector_type(16)));
    bf16x16 At8[4], B08[2], B18[2]; bf16x8 At[4][2], B0[2][2], B1[2][2];
    const char* cA = (const char*)g.A + (size_t)cur.pm * tstep; const char* cB = (const char*)g.Bt + (size_t)cur.pn * tstep;
    S.a_ready(cur);
    if constexpr (SP2) {
        PG8_STAGE(PG8_SB(0, 0), cB, voffB); PG8_STAGE(PG8_SB(0, 1), cB + hstep, voffB); PG8_STAGE(PG8_SA(0, 0), cA, voffA); PG8_STAGE(PG8_SA(0, 1), cA + hstep, voffA);
        if (wr == 1) PG8_BAR;
        PG8_WAIT_V(2); PG8_BAR;
        PG8_STAGE(PG8_SB(1, 0), cB + kstep, voffB); PG8_STAGE(PG8_SA(1, 0), cA + kstep, voffA); PG8_STAGE(PG8_SB(1, 1), cB + hstep + kstep, voffB);
        PG8_WAIT_V(6); PG8_BAR;
    } else {
        PG8_STAGE(PG8_SB(0, 0), cB, voffB); PG8_STAGE(PG8_SA(0, 0), cA, voffA); PG8_STAGE(PG8_SB(0, 1), cB + hstep, voffB); PG8_STAGE(PG8_SA(0, 1), cA + hstep, voffA);
        if (wr == 1) PG8_BAR;
        PG8_WAIT_V(4); PG8_BAR;
        PG8_STAGE(PG8_SB(1, 0), cB + kstep, voffB); PG8_STAGE(PG8_SA(1, 0), cA + kstep, voffA); PG8_STAGE(PG8_SB(1, 1), cB + hstep + kstep, voffB);
        PG8_WAIT_V(6); PG8_BAR;
    }
    for (;;) {
        const bool has_next = S.next(ui + 1, nxt);
        const char* nA = has_next ? (const char*)g.A + (size_t)nxt.pm * tstep : cA; const char* nB = has_next ? (const char*)g.Bt + (size_t)nxt.pn * tstep : cB;
        for (int t = 0; t < nt; t += 2) {
            const bool last = (t == nt - 2);
            const char* a1 = cA + (size_t)(t + 1) * kstep;
            const char* a2 = last ? nA : cA + (size_t)(t + 2) * kstep; const char* b2 = last ? nB : cB + (size_t)(t + 2) * kstep;
            const char* a3 = a2 + kstep; const char* b3 = b2 + kstep;
            if (last && has_next) S.a_ready(nxt);
            if constexpr (SP2) {
            PG8_LDB(B0, 0, 0); PG8_LDB(B1, 0, 1); PG8_SCHED; PG8_LDA(At, 0, 0); PG8_STAGE(PG8_SA(1, 1), a1 + hstep, voffA);
            PG8_WAIT_V(8); PG8_WAIT_L(0); PG8_BAR; PG8_MMA(0, 0, At, B0); PG8_MMA(0, 1, At, B1); PG8_BAR; PG8_SCHED;
            PG8_LDA(At, 0, 1); PG8_STAGE(PG8_SB(0, 0), b2, voffB); PG8_STAGE(PG8_SB(0, 1), b2 + hstep, voffB); PG8_STAGE(PG8_SA(0, 0), a2, voffA);
            PG8_WAIT_V(8); PG8_WAIT_L(0); PG8_BAR; PG8_MMA(1, 0, At, B0); PG8_MMA(1, 1, At, B1); PG8_BAR; PG8_SCHED;
            PG8_LDB(B0, 1, 0); PG8_LDB(B1, 1, 1); PG8_SCHED; PG8_LDA(At, 1, 0); PG8_STAGE(PG8_SA(0, 1), a2 + hstep, voffA);
            PG8_WAIT_V(8); PG8_WAIT_L(0); PG8_BAR; PG8_MMA(0, 0, At, B0); PG8_MMA(0, 1, At, B1); PG8_BAR; PG8_SCHED;
            PG8_LDA(At, 1, 1); PG8_STAGE(PG8_SB(1, 0), b3, voffB); PG8_STAGE(PG8_SB(1, 1), b3 + hstep, voffB); PG8_STAGE(PG8_SA(1, 0), a3, voffA);
            PG8_WAIT_V(8); PG8_WAIT_L(0); PG8_BAR; PG8_MMA(1, 0, At, B0); PG8_MMA(1, 1, At, B1); PG8_BAR; PG8_SCHED;
            } else {
            PG8_LDB(B0, 0, 0); PG8_SCHED; PG8_LDA(At, 0, 0); PG8_STAGE(PG8_SA(1, 1), a1 + hstep, voffA);
            PG8_WAIT_L(8); PG8_BAR; PG8_WAIT_L(0); PG8_MMA(0, 0, At, B0); PG8_BAR; PG8_SCHED;
            PG8_LDB(B1, 0, 1); PG8_STAGE(PG8_SB(0, 0), b2, voffB);
            PG8_BAR; PG8_WAIT_L(0); PG8_MMA(0, 1, At, B1); PG8_BAR;
            PG8_LDA(At, 0, 1); PG8_STAGE(PG8_SA(0, 0), a2, voffA);
            PG8_BAR; PG8_WAIT_L(0); PG8_MMA(1, 0, At, B0); PG8_BAR; PG8_SCHED;
            PG8_STAGE(PG8_SB(0, 1), b2 + hstep, voffB);
            PG8_WAIT_V(6); PG8_BAR; PG8_MMA(1, 1, At, B1); PG8_BAR;
            PG8_LDB(B0, 1, 0); PG8_SCHED; PG8_LDA(At, 1, 0); PG8_STAGE(PG8_SA(0, 1), a2 + hstep, voffA);
            PG8_WAIT_L(8); PG8_BAR; PG8_WAIT_L(0); PG8_MMA(0, 0, At, B0); PG8_BAR; PG8_SCHED;
            PG8_LDB(B1, 1, 1); PG8_STAGE(PG8_SB(1, 0), b3, voffB);
            PG8_BAR; PG8_WAIT_L(0); PG8_MMA(0, 1, At, B1); PG8_BAR;
            PG8_LDA(At, 1, 1); PG8_STAGE(PG8_SA(1, 0), a3, voffA);
            PG8_BAR; PG8_WAIT_L(0); PG8_MMA(1, 0, At, B0); PG8_BAR; PG8_SCHED;
            PG8_STAGE(PG8_SB(1, 1), b3 + hstep, voffB);
            PG8_WAIT_V(6); PG8_BAR; PG8_MMA(1, 1, At, B1); PG8_BAR;
            }
        }
        if constexpr (ALIGN_EPI) { if (wr == 0) PG8_BAR; }
        if constexpr (!Epi::AFTER_DRAIN) { int ln_e; asm volatile("v_mbcnt_lo_u32_b32 %0, -1, 0\n\tv_mbcnt_hi_u32_b32 %0, -1, %0" : "=v"(ln_e)); const int fr_e = ln_e & 15, fq_e = ln_e >> 4;
            E(acc, cur, wr, wc, fr_e, fq_e); S.done(cur); }
        if (!has_next) break;
#pragma unroll
        for (int a = 0; a < 2; ++a)
#pragma unroll
            for (int b = 0; b < 2; ++b)
#pragma unroll
                for (int m = 0; m < 4; ++m)
#pragma unroll
                    for (int n = 0; n < 2; ++n) acc[a][b][m][n] = (f32x4){0.f, 0.f, 0.f, 0.f};
        cur = nxt; cA = nA; cB = nB; ++ui;
        if constexpr (ALIGN_EPI) { if (wr == 1) PG8_BAR; }
    }
    PG8_WAIT_V(0);
    if constexpr (!ALIGN_EPI) { if (wr == 0) PG8_BAR; }
    PG8_BAR;
    if constexpr (Epi::AFTER_DRAIN) { E.fused(acc, cur, wr, wc, fr, fq, lds, wid, lane); S.done(cur); }
#undef PG8_SA
#undef PG8_SB
#undef PG8_STAGE
#undef PG8_LDA
#undef PG8_LDB
#undef PG8_MMA
#undef PG8_WAIT_V
#undef PG8_WAIT_L
#undef PG8_BAR
#undef PG8_SCHED
}
}
#define GAS __attribute__((address_space(1)))
#define LAS __attribute__((address_space(3)))
typedef unsigned short bf16;
typedef unsigned v4u __attribute__((ext_vector_type(4)));
typedef float f32x4 __attribute__((ext_vector_type(4)));
typedef short bf16x8 __attribute__((ext_vector_type(8)));
typedef GAS unsigned gu32;
typedef GAS unsigned long long gu64;
#define RLX_AGENT __ATOMIC_RELAXED, __HIP_MEMORY_SCOPE_AGENT
#define LDS_WAIT() asm volatile("s_waitcnt lgkmcnt(0)" ::: "memory")
#define VM_WAIT() asm volatile("s_waitcnt vmcnt(0)" ::: "memory")
__device__ __forceinline__ unsigned long long rt() { return __builtin_amdgcn_s_memrealtime(); }
__device__ __forceinline__ unsigned f2bf(float f) { unsigned u = __builtin_bit_cast(unsigned, f); return (u + 0x7fffu + ((u >> 16) & 1u)) >> 16; }
__device__ __forceinline__ unsigned pk2(float lo, float hi) { return f2bf(lo) | (f2bf(hi) << 16); }

#define XB_TMO      128
#define XB_XCNT(j)  (256  + 64 * (j))
#define XB_XSUB(j)  (1280 + 64 * (j))
#define XB_XGEN(j)  (2304 + 64 * (j))
#define XB_TOP      3328
#define XB_TOPGEN   3392
#define XCD_BAR_WORDS 3456
#define XB_SPIN_CAP (1u << 18)

__device__ __forceinline__ unsigned xb_ld(unsigned* p)              { return __hip_atomic_load(p, __ATOMIC_RELAXED, __HIP_MEMORY_SCOPE_AGENT); }
__device__ __forceinline__ unsigned xb_add(unsigned* p, unsigned v) { return __hip_atomic_fetch_add(p, v, __ATOMIC_RELAXED, __HIP_MEMORY_SCOPE_AGENT); }
__device__ __forceinline__ unsigned xb_xcc_id() { return (unsigned)__builtin_amdgcn_s_getreg((3 << 11) | 20) & 0xFu; }
#define XB_SPIN(cond, bar) do { unsigned _sp = 0; while (cond) { __builtin_amdgcn_s_sleep(1); \
    if ((++_sp & 255u) == 0u) { if (xb_ld(&(bar)[XB_TMO])) break; if (_sp > XB_SPIN_CAP) { atomicAdd(&(bar)[XB_TMO], 1u); break; } } } } while (0)

struct XcdBarrier {
    unsigned* bar; unsigned x; bool wave0;
    volatile LAS unsigned* st;
};

__device__ __forceinline__ XcdBarrier xcd_barrier_post(unsigned* bar, volatile LAS unsigned* st) {
    XcdBarrier b; b.bar = bar; b.x = xb_xcc_id(); b.st = st;
    if (threadIdx.x == 0) (void)xb_add(&bar[XB_XCNT(b.x)], 1u);
    return b;
}
__device__ __forceinline__ void xcd_barrier_complete(unsigned* bar, unsigned x, unsigned& nloc, unsigned& nx) {
    const unsigned G = gridDim.x * gridDim.y * gridDim.z;
    unsigned sum, cnt, mine, sp = 0u;
    for (;;) {
        sum = 0u; cnt = 0u; mine = 0u;
#pragma unroll
        for (unsigned j = 0; j < 16; ++j) { const unsigned c = xb_ld(&bar[XB_XCNT(j)]); sum += c; cnt += (c > 0u) ? 1u : 0u; mine = (j == x) ? c : mine; }
        if (sum == G) break;
        __builtin_amdgcn_s_sleep(1);
        if ((++sp & 255u) == 0u) { if (xb_ld(&bar[XB_TMO])) break; if (sp > XB_SPIN_CAP) { atomicAdd(&bar[XB_TMO], 1u); break; } }
    }
    nloc = mine > 0u ? mine : 1u; nx = cnt > 0u ? cnt : 1u;
}

__device__ __forceinline__ void xcd_barrier(const XcdBarrier& b) {
    asm volatile("s_waitcnt vmcnt(0)" ::: "memory");
    __syncthreads();
    if (b.wave0 && __builtin_amdgcn_mbcnt_hi(~0u, __builtin_amdgcn_mbcnt_lo(~0u, 0u)) == 0u) {
        unsigned* bar = b.bar;
        __builtin_amdgcn_s_waitcnt(0);
        unsigned nloc = b.st[0], nx = b.st[1];
        if (nloc == 0u) { xcd_barrier_complete(bar, b.x, nloc, nx); b.st[0] = nloc; b.st[1] = nx; }
        const unsigned old = xb_add(&bar[XB_XSUB(b.x)], 1u);
        const unsigned gen = old / nloc;
        if (old + 1u == (gen + 1u) * nloc) {
            __builtin_amdgcn_fence(__ATOMIC_RELEASE, "agent");
            asm volatile("s_waitcnt vmcnt(0)" ::: "memory");
            const unsigned og = xb_add(&bar[XB_TOP], 1u);
            const unsigned tg = og / nx;
            if (og + 1u == (tg + 1u) * nx) xb_add(&bar[XB_TOPGEN], 1u);
            else XB_SPIN(xb_ld(&bar[XB_TOPGEN]) == tg, bar);
            __builtin_amdgcn_fence(__ATOMIC_ACQUIRE, "agent");
            xb_add(&bar[XB_XGEN(b.x)], 1u);
            asm volatile("s_waitcnt vmcnt(0)" ::: "memory");
        } else {
            XB_SPIN(xb_ld(&bar[XB_XGEN(b.x)]) == gen, bar);
            __builtin_amdgcn_fence(__ATOMIC_ACQUIRE, "agent");
            asm volatile("s_waitcnt vmcnt(0)" ::: "memory");
        }
    }
    __syncthreads();
}

constexpr int NWAVES = 8, NTHREADS = NWAVES * 64;
constexpr int BATCH = 8, SEQ = 2048, T = BATCH * SEQ, D = 2048;
constexpr int EV_N = 7200, EV_NP = 7424, OD_N = 7616, OD_NP = 7680, PROJ_LD = 7680;
constexpr float EPS = 1e-6f;
constexpr int EC_GQ = 0, EC_GK = 512, EC_GV = 1024, EC_GZ = 2048, EC_GLR = 3072, EC_BQ = 3088, EC_BK = 4112, EC_BV = 5136, EC_BZ = 6160, EC_BA = 7184, EC_BB = 7192;
constexpr int OC_HQ = 0, OC_HF = 1024, OC_HI = 2048, OC_HG = 3072, OC_RW = 4096;
constexpr int RW_R = 0, RW_K = 1024, RW_V = 2048, RW_WL = 3072, RW_AL = 3168, RW_GL = 3264;
constexpr int LORA_K = 512, LORA_N = 3072;
enum { I_X = 0, I_P, I_EV_WIN, I_GK_W2, I_GK_B, I_GLA_NORM, I_GDN_CONV, I_GDN_ALOG, I_GDN_DTB, I_GDN_NORM, I_EV_WOUT, I_OD_WIN, I_LB, I_HG_NORM,
       I_MU, I_W0, I_W2, I_A0, I_A2, I_G2, I_KK, I_KA, I_RK, I_LNW, I_LNB, I_OD_WOUT, I_NMIX, I_NFFN, I_NPLE, I_PEER_WQ, I_PEER_SK, I_PEER_U, I_PEER_V,
       I_PLE_WP, I_PLE_WG, I_NFINAL, N_IN };

constexpr size_t MiB = 1u << 20;
constexpr size_t WS_CTL = 0, CTL_ZERO_BYTES = 1 * MiB;
constexpr size_t WS_WEV_IN = 1 * MiB, WS_WEV_OUT = 30 * MiB, WS_WOD_IN = 38 * MiB, WS_WOD_OUT = 68 * MiB, WS_WPEER = 76 * MiB, WS_WGATE = 92 * MiB, WS_WPROJ = 108 * MiB,
                 WS_WLORA = 110 * MiB, WS_PBF = 113 * MiB, WS_TABU = 129 * MiB, WS_TABV = 193 * MiB, WS_ACTA = 257 * MiB, WS_ACTB = 321 * MiB, WS_PROJ = 385 * MiB, WS_SC = 385 * MiB,
                 WS_O = 625 * MiB, WS_H1 = 689 * MiB, WS_PP = 753 * MiB, WS_LA = 817 * MiB, WS_LO = 833 * MiB, WS_RSP = 929 * MiB, WS_STATE = 937 * MiB, WS_RS3 = 945 * MiB, WS_END = 946 * MiB;
static_assert(WS_WEV_IN + (size_t)EV_NP * D * 2 <= WS_WEV_OUT && WS_WOD_IN + (size_t)OD_NP * D * 2 <= WS_WOD_OUT && WS_PROJ + (size_t)T * PROJ_LD * 2 <= WS_O, "ws map");
constexpr int CW_BAR = 4096;
enum { RS_FFN0 = 0, RS_MIX1 = 1, RS_FFN1 = 2, RS_FINAL = 3 };
constexpr int RING_OFF = 0, RING_BYTES = 131072;
constexpr int LDSCTL_OFF = RING_BYTES, MISC_OFF = LDSCTL_OFF + 320;
constexpr int LDS_BYTES = 147456;

struct Args { const float* in[N_IN]; float* out; unsigned char* ws; int ph_lo, ph_hi; };
struct Frame {
    LAS unsigned char* lds; volatile LAS unsigned* MISC; gu32* ctl;
    int tid, lane, wave, vcu, G;
};
__device__ __forceinline__ float wave_sum(float v) {
#pragma unroll
    for (int o = 1; o < 64; o <<= 1) v += __shfl_xor(v, o);
    return v;
}
__device__ __forceinline__ float half_sum32(float v) {
#pragma unroll
    for (int o = 1; o < 32; o <<= 1) v += __shfl_xor(v, o);
    return v;
}
#define DPP_ADD(v, ctrl) (v) += __builtin_bit_cast(float, __builtin_amdgcn_update_dpp(0, __builtin_bit_cast(int, (v)), (ctrl), 0xF, 0xF, false))
__device__ __forceinline__ float row_sum16(float v) {
    DPP_ADD(v, 0x128); DPP_ADD(v, 0x124); DPP_ADD(v, 0x122); DPP_ADD(v, 0x121);
    return v;
}
__device__ __forceinline__ void row_sum16_x4(float& a, float& b, float& c, float& d) {
    asm("s_nop 1\n\t"
        "v_add_f32_dpp %0, %0, %0 row_ror:8 row_mask:0xf bank_mask:0xf\n\tv_add_f32_dpp %1, %1, %1 row_ror:8 row_mask:0xf bank_mask:0xf\n\t"
        "v_add_f32_dpp %2, %2, %2 row_ror:8 row_mask:0xf bank_mask:0xf\n\tv_add_f32_dpp %3, %3, %3 row_ror:8 row_mask:0xf bank_mask:0xf\n\t"
        "v_add_f32_dpp %0, %0, %0 row_ror:4 row_mask:0xf bank_mask:0xf\n\tv_add_f32_dpp %1, %1, %1 row_ror:4 row_mask:0xf bank_mask:0xf\n\t"
        "v_add_f32_dpp %2, %2, %2 row_ror:4 row_mask:0xf bank_mask:0xf\n\tv_add_f32_dpp %3, %3, %3 row_ror:4 row_mask:0xf bank_mask:0xf\n\t"
        "v_add_f32_dpp %0, %0, %0 row_ror:2 row_mask:0xf bank_mask:0xf\n\tv_add_f32_dpp %1, %1, %1 row_ror:2 row_mask:0xf bank_mask:0xf\n\t"
        "v_add_f32_dpp %2, %2, %2 row_ror:2 row_mask:0xf bank_mask:0xf\n\tv_add_f32_dpp %3, %3, %3 row_ror:2 row_mask:0xf bank_mask:0xf\n\t"
        "v_add_f32_dpp %0, %0, %0 row_ror:1 row_mask:0xf bank_mask:0xf\n\tv_add_f32_dpp %1, %1, %1 row_ror:1 row_mask:0xf bank_mask:0xf\n\t"
        "v_add_f32_dpp %2, %2, %2 row_ror:1 row_mask:0xf bank_mask:0xf\n\tv_add_f32_dpp %3, %3, %3 row_ror:1 row_mask:0xf bank_mask:0xf\n\t"
        "s_nop 1"
        : "+v"(a), "+v"(b), "+v"(c), "+v"(d));
}
__device__ __forceinline__ void row_sum16_x2(float& a, float& b) {
    asm("s_nop 1\n\t"
        "v_add_f32_dpp %0, %0, %0 row_ror:8 row_mask:0xf bank_mask:0xf\n\tv_add_f32_dpp %1, %1, %1 row_ror:8 row_mask:0xf bank_mask:0xf\n\ts_nop 1\n\t"
        "v_add_f32_dpp %0, %0, %0 row_ror:4 row_mask:0xf bank_mask:0xf\n\tv_add_f32_dpp %1, %1, %1 row_ror:4 row_mask:0xf bank_mask:0xf\n\ts_nop 1\n\t"
        "v_add_f32_dpp %0, %0, %0 row_ror:2 row_mask:0xf bank_mask:0xf\n\tv_add_f32_dpp %1, %1, %1 row_ror:2 row_mask:0xf bank_mask:0xf\n\ts_nop 1\n\t"
        "v_add_f32_dpp %0, %0, %0 row_ror:1 row_mask:0xf bank_mask:0xf\n\tv_add_f32_dpp %1, %1, %1 row_ror:1 row_mask:0xf bank_mask:0xf\n\t"
        "s_nop 1"
        : "+v"(a), "+v"(b));
}
typedef unsigned u32x2 __attribute__((ext_vector_type(2)));
__device__ __forceinline__ void st_wt16(void* p, v4u v) { asm volatile("global_store_dwordx4 %0, %1, off sc1\n\ts_nop 1" :: "v"(p), "v"(v) : "memory"); }
__device__ __forceinline__ void st_wt8(void* p, u32x2 v) { asm volatile("global_store_dwordx2 %0, %1, off sc1\n\ts_nop 1" :: "v"(p), "v"(v) : "memory"); }
#define LBAR() do { asm volatile("s_waitcnt lgkmcnt(0)" ::: "memory"); __builtin_amdgcn_s_barrier(); asm volatile("" ::: "memory"); } while (0)
typedef float f32x2 __attribute__((ext_vector_type(2)));
typedef __bf16 hwbf16x2_t __attribute__((ext_vector_type(2)));
__device__ __forceinline__ unsigned hw_pk2(float lo, float hi) { const f32x2 v = {lo, hi}; return __builtin_bit_cast(unsigned, __builtin_convertvector(v, hwbf16x2_t)); }
__device__ __forceinline__ bf16 hw_bf(float x) { return (bf16)hw_pk2(x, 0.f); }
__device__ __forceinline__ float bf_lo(unsigned w) { return __uint_as_float(w << 16); }
__device__ __forceinline__ float bf_hi(unsigned w) { return __uint_as_float(w & 0xffff0000u); }
__device__ __forceinline__ float sigmoidf_(float x) { return __builtin_amdgcn_rcpf(1.0f + __expf(-x)); }
__device__ __forceinline__ float siluf_(float x) { return x * __builtin_amdgcn_rcpf(1.0f + __expf(-x)); }
__device__ __forceinline__ float softplusf_(float x) { return fmaxf(x, 0.f) + log1pf(__expf(-fabsf(x))); }
__device__ __forceinline__ float logsigmoidf_(float x) { return fminf(x, 0.f) - log1pf(__expf(-fabsf(x))); }

struct EpiBf16S {
    static constexpr bool PERM = true, AFTER_DRAIN = false;
    bf16* O; int ldc; const float* rowss;
    __device__ __forceinline__ void operator()(const pg8::f32x4 (&acc)[2][2][4][2], const pg8::Unit& u, int wr, int wc, int fr, int fq) const {
        const int row0 = u.pm * 256 + wr * 64 + fr, col0 = u.pn * 256 + wc * 32 + 8 * fq;
#pragma unroll
        for (int ai = 0; ai < 2; ++ai)
#pragma unroll
            for (int m = 0; m < 4; ++m) {
                const int row = row0 + ai * 128 + m * 16;
                float sc = 1.f;
                if (rowss) { const pg8::f32x4* rp = (const pg8::f32x4*)(rowss + (size_t)row * 32 + 8 * fq); const pg8::f32x4 p0 = rp[0], p1 = rp[1];
                    float s = ((p0[0] + p0[1]) + (p0[2] + p0[3])) + ((p1[0] + p1[1]) + (p1[2] + p1[3])); s += __shfl_xor(s, 16); s += __shfl_xor(s, 32);
                    sc = __builtin_amdgcn_rsqf(s * (1.0f / D) + EPS); }
                bf16* rowp = O + (size_t)row * ldc + col0;
#pragma unroll
                for (int bj = 0; bj < 2; ++bj) { const pg8::f32x4 v0 = acc[ai][bj][m][0] * sc, v1 = acc[ai][bj][m][1] * sc;
                    pg8::u32x4 w; w.x = pg8::cvt_pk_bf16(v0[0], v0[1]); w.y = pg8::cvt_pk_bf16(v0[2], v0[3]); w.z = pg8::cvt_pk_bf16(v1[0], v1[1]); w.w = pg8::cvt_pk_bf16(v1[2], v1[3]);
                    *(pg8::u32x4*)(rowp + bj * 128) = w; } }
    }
};
template <bool GATE, bool HIN_F32> struct EpiResid {
    static constexpr bool PERM = false, AFTER_DRAIN = false;
    const void* hin; bf16* hout; float* rowss; const bf16* pp; const float* rs3; unsigned char* h8;
    __device__ __forceinline__ void operator()(const pg8::f32x4 (&acc)[2][2][4][2], const pg8::Unit& u, int wr, int wc, int fr, int fq) const {
        const int row0 = u.pm * 256 + wr * 64 + fr, col0 = u.pn * 256 + wc * 32 + 4 * fq;
        constexpr int MG = HIN_F32 ? 2 : 4;
#pragma unroll
        for (int ai = 0; ai < 2; ++ai)
#pragma unroll
            for (int m0 = 0; m0 < 4; m0 += MG) {
                pg8::f32x4 hf[MG][2][2]; pg8::u32x2 hb[MG][2][2], pw[MG][2][2]; float rsc[MG];
#pragma unroll
                for (int mm = 0; mm < MG; ++mm) { const int row = row0 + ai * 128 + (m0 + mm) * 16; const size_t off = (size_t)row * D + col0; rsc[mm] = GATE ? rs3[row] : 1.f;
#pragma unroll
                    for (int bj = 0; bj < 2; ++bj)
#pragma unroll
                        for (int n = 0; n < 2; ++n) { const size_t o = off + bj * 128 + n * 16;
                            if (HIN_F32) hf[mm][bj][n] = *(const pg8::f32x4*)((const float*)hin + o); else hb[mm][bj][n] = *(const pg8::u32x2*)((const bf16*)hin + o);
                            if (GATE) pw[mm][bj][n] = *(const pg8::u32x2*)(pp + o); } }
#pragma unroll
                for (int mm = 0; mm < MG; ++mm) { const int m = m0 + mm; const int row = row0 + ai * 128 + m * 16; const size_t off = (size_t)row * D + col0; float ss = 0.f;
#pragma unroll
                    for (int bj = 0; bj < 2; ++bj)
#pragma unroll
                        for (int n = 0; n < 2; ++n) { const size_t o = off + bj * 128 + n * 16;
                            pg8::f32x4 hv;
                            if (HIN_F32) hv = hf[mm][bj][n];
                            else { const pg8::u32x2 hw = hb[mm][bj][n]; hv[0] = bf_lo(hw.x); hv[1] = bf_hi(hw.x); hv[2] = bf_lo(hw.y); hv[3] = bf_hi(hw.y); }
                            pg8::f32x4 a = acc[ai][bj][m][n];
                            if (GATE) { const pg8::u32x2 p2 = pw[mm][bj][n]; const float rs_ = rsc[mm];
                                a[0] = sigmoidf_(a[0] * rs_) * bf_lo(p2.x); a[1] = sigmoidf_(a[1] * rs_) * bf_hi(p2.x); a[2] = sigmoidf_(a[2] * rs_) * bf_lo(p2.y); a[3] = sigmoidf_(a[3] * rs_) * bf_hi(p2.y); }
                            hv = hv + a;
                            pg8::u32x2 w; w.x = hw_pk2(hv[0], hv[1]); w.y = hw_pk2(hv[2], hv[3]); *(pg8::u32x2*)(hout + o) = w;
                            if (h8) { int x8 = __builtin_amdgcn_cvt_pk_fp8_f32(hv[0], hv[1], 0, false); x8 = __builtin_amdgcn_cvt_pk_fp8_f32(hv[2], hv[3], x8, true); *(unsigned*)(h8 + o) = (unsigned)x8; }
                            const float q0 = bf_lo(w.x), q1 = bf_hi(w.x), q2 = bf_lo(w.y), q3 = bf_hi(w.y);
                            ss += (q0 * q0 + q1 * q1) + (q2 * q2 + q3 * q3); }
                    ss += __shfl_xor(ss, 16); ss += __shfl_xor(ss, 32);
                    if (fq == 0) rowss[(size_t)row * 32 + u.pn * 4 + wc] = ss; }
                asm volatile("" ::: "memory"); }
    }
};


__device__ __forceinline__ void p0_transpose_item(const float* W, int K, int N, bf16* WT, LAS float* scr, int item, int lane, const float* kgain = nullptr) {
    const int nblk = N / 32, kb = item / nblk, nb = item % nblk, k0 = 64 * kb, n0 = 32 * nb;
    { const GAS float* Wg = (const GAS float*)W + (size_t)(k0 + (lane >> 5)) * N + n0 + (lane & 31); float v[32];
#pragma unroll
      for (int i = 0; i < 32; ++i) v[i] = Wg[(size_t)(2 * i) * N];
#pragma unroll
      for (int i = 0; i < 32; ++i) scr[(2 * i + (lane >> 5)) * 33 + (lane & 31)] = v[i]; }
    LDS_WAIT(); asm volatile("" ::: "memory");
    const int c = lane & 7;
#pragma unroll
    for (int j = 0; j < 4; ++j) { const int n = (lane >> 3) + 8 * j; const LAS float* s = scr + (8 * c) * 33 + n;
        f32x4 g0 = {1.f, 1.f, 1.f, 1.f}, g1 = g0; if (kgain) { g0 = *(const GAS f32x4*)(kgain + k0 + 8 * c); g1 = *(const GAS f32x4*)(kgain + k0 + 8 * c + 4); }
        v4u o; o.x = pk2(s[0 * 33] * g0[0], s[1 * 33] * g0[1]); o.y = pk2(s[2 * 33] * g0[2], s[3 * 33] * g0[3]); o.z = pk2(s[4 * 33] * g1[0], s[5 * 33] * g1[1]); o.w = pk2(s[6 * 33] * g1[2], s[7 * 33] * g1[3]);
        *(GAS v4u*)(WT + (size_t)(n0 + n) * K + k0 + 8 * c) = o; }
    LDS_WAIT(); asm volatile("" ::: "memory");
}
__device__ __forceinline__ void p0_transpose_item_f8(const float* W, int K, int N, unsigned char* WT, LAS float* scr, int item, int lane, const float* kgain = nullptr) {
    const int nblk = N / 32, kb = item / nblk, nb = item % nblk, k0 = 64 * kb, n0 = 32 * nb;
    { const GAS float* Wg = (const GAS float*)W + (size_t)(k0 + (lane >> 5)) * N + n0 + (lane & 31); float v[32];
#pragma unroll
      for (int i = 0; i < 32; ++i) v[i] = Wg[(size_t)(2 * i) * N];
#pragma unroll
      for (int i = 0; i < 32; ++i) scr[(2 * i + (lane >> 5)) * 33 + (lane & 31)] = v[i]; }
    LDS_WAIT(); asm volatile("" ::: "memory");
    const int c = lane & 7;
#pragma unroll
    for (int j = 0; j < 4; ++j) { const int n = (lane >> 3) + 8 * j; const LAS float* s = scr + (8 * c) * 33 + n;
        f32x4 g0 = {64.f, 64.f, 64.f, 64.f}, g1 = g0; if (kgain) { g0 = g0 * *(const GAS f32x4*)(kgain + k0 + 8 * c); g1 = g1 * *(const GAS f32x4*)(kgain + k0 + 8 * c + 4); }
        int x0 = __builtin_amdgcn_cvt_pk_fp8_f32(s[0 * 33] * g0[0], s[1 * 33] * g0[1], 0, false); x0 = __builtin_amdgcn_cvt_pk_fp8_f32(s[2 * 33] * g0[2], s[3 * 33] * g0[3], x0, true);
        int x1 = __builtin_amdgcn_cvt_pk_fp8_f32(s[4 * 33] * g1[0], s[5 * 33] * g1[1], 0, false); x1 = __builtin_amdgcn_cvt_pk_fp8_f32(s[6 * 33] * g1[2], s[7 * 33] * g1[3], x1, true);
        u32x2 o; o.x = (unsigned)x0; o.y = (unsigned)x1;
        *(GAS u32x2*)(WT + (size_t)(n0 + n) * K + k0 + 8 * c) = o; }
    LDS_WAIT(); asm volatile("" ::: "memory");
}
__device__ __forceinline__ void cvt_f32_bf16(const float* src, bf16* dst, size_t n, int gtid, int gthreads) {
    const size_t n8 = n / 8;
    for (size_t i = gtid; i < n8; i += gthreads) {
        const f32x4 a = *(const GAS f32x4*)(src + i * 8), b = *(const GAS f32x4*)(src + i * 8 + 4);
        v4u o; o.x = pk2(a[0], a[1]); o.y = pk2(a[2], a[3]); o.z = pk2(b[0], b[1]); o.w = pk2(b[2], b[3]);
        *(GAS v4u*)(dst + i * 8) = o; }
}
__device__ __forceinline__ void cvt_f32_fp8(const float* src, unsigned char* dst, size_t n, float scale, int gtid, int gthreads, const float* cgain = nullptr) {
    const size_t n16 = n / 16;
    for (size_t i = gtid; i < n16; i += gthreads) { v4u o; unsigned w[4];
#pragma unroll
        for (int q = 0; q < 4; ++q) { f32x4 a = *(const GAS f32x4*)(src + i * 16 + 4 * q) * scale; if (cgain) a = a * *(const GAS f32x4*)(cgain + ((i * 16 + 4 * q) & (D - 1)));
            int x = __builtin_amdgcn_cvt_pk_fp8_f32(a[0], a[1], 0, false); x = __builtin_amdgcn_cvt_pk_fp8_f32(a[2], a[3], x, true); w[q] = (unsigned)x; }
        o.x = w[0]; o.y = w[1]; o.z = w[2]; o.w = w[3];
        *(GAS v4u*)(dst + i * 16) = o; }
}
__device__ __forceinline__ void rms_row_to_bf16(const float* xrow, const float* g, bf16* orow, int lane) {
    const GAS f32x4* xr = (const GAS f32x4*)xrow + lane; f32x4 v[8]; float s = 0.f;
#pragma unroll
    for (int j = 0; j < 8; ++j) { v[j] = xr[64 * j]; s += (v[j][0] * v[j][0] + v[j][1] * v[j][1]) + (v[j][2] * v[j][2] + v[j][3] * v[j][3]); }
    const float r = __builtin_amdgcn_rsqf(wave_sum(s) * (1.0f / D) + EPS);
    const GAS f32x4* gr = (const GAS f32x4*)g + lane;
    GAS unsigned long long* o8 = (GAS unsigned long long*)orow + lane;
#pragma unroll
    for (int j = 0; j < 8; ++j) { const f32x4 gg = gr[64 * j]; o8[64 * j] = (unsigned long long)pk2(v[j][0] * r * gg[0], v[j][1] * r * gg[1]) | ((unsigned long long)pk2(v[j][2] * r * gg[2], v[j][3] * r * gg[3]) << 32); }
}
__device__ __forceinline__ void rms_row_to_f8(const float* xrow, const float* g, unsigned char* orow, int lane) {
    const GAS f32x4* xr = (const GAS f32x4*)xrow + lane; f32x4 v[8]; float s = 0.f;
#pragma unroll
    for (int j = 0; j < 8; ++j) { v[j] = xr[64 * j]; s += (v[j][0] * v[j][0] + v[j][1] * v[j][1]) + (v[j][2] * v[j][2] + v[j][3] * v[j][3]); }
    const float r = __builtin_amdgcn_rsqf(wave_sum(s) * (1.0f / D) + EPS);
    const GAS f32x4* gr = (const GAS f32x4*)g + lane;
    GAS unsigned* o4 = (GAS unsigned*)orow + lane;
#pragma unroll
    for (int j = 0; j < 8; ++j) { const f32x4 q = v[j] * gr[64 * j] * r; int x = __builtin_amdgcn_cvt_pk_fp8_f32(q[0], q[1], 0, false); x = __builtin_amdgcn_cvt_pk_fp8_f32(q[2], q[3], x, true); o4[64 * j] = (unsigned)x; }
}
__device__ __forceinline__ void p0_fold_item(const float* wq, const float* sk, bf16* WP, LAS float* lds, int item, int tid, const float* kgain) {
    const int hp = item >> 5, k0 = (item & 31) * 64;
    LAS float* skT = lds;
    LAS float* wqT = lds + 128 * 132;
    const float* skb = sk + (size_t)hp * 128 * 128;
#pragma unroll 4
    for (int i = 0; i < 32; ++i) { const int idx = i * 512 + tid, n = idx >> 7, d = idx & 127; skT[d * 132 + n] = skb[idx]; }
#pragma unroll 4
    for (int i = 0; i < 16; ++i) { const int idx = i * 512 + tid, kk = idx >> 7, d = idx & 127; wqT[d * 68 + kk] = wq[(size_t)(k0 + kk) * D + hp * 128 + d] * kgain[k0 + kk]; }
    __syncthreads();
    const int n0 = (tid >> 4) * 4, kk0 = (tid & 15) * 4;
    float acc[4][4];
#pragma unroll
    for (int i = 0; i < 4; ++i)
#pragma unroll
        for (int j = 0; j < 4; ++j) acc[i][j] = 0.f;
#pragma unroll 4
    for (int d = 0; d < 128; ++d) { const f32x4 a = *(const LAS f32x4*)(skT + d * 132 + n0), b = *(const LAS f32x4*)(wqT + d * 68 + kk0);
#pragma unroll
        for (int i = 0; i < 4; ++i)
#pragma unroll
            for (int j = 0; j < 4; ++j) acc[i][j] += a[i] * b[j]; }
#pragma unroll
    for (int i = 0; i < 4; ++i) { unsigned long long o = (unsigned long long)pk2(acc[i][0], acc[i][1]) | ((unsigned long long)pk2(acc[i][2], acc[i][3]) << 32);
        *(GAS unsigned long long*)(WP + (size_t)(hp * 128 + n0 + i) * D + k0 + kk0) = o; }
    __syncthreads();
}
__device__ __forceinline__ void p0_prologue(const Args& A, Frame& F) {
    const int gw = F.vcu * NWAVES + F.wave, NGW = F.G * NWAVES;
    const int gtid = gw * 64 + F.lane, gthreads = F.G * NTHREADS;
    unsigned char* ws = A.ws;
    LAS float* scr = (LAS float*)(F.lds + RING_OFF + F.wave * 16384);
    constexpr int I_EVIN = (D / 64) * (EV_N / 32);
    for (int it = gw; it < I_EVIN; it += NGW) p0_transpose_item(A.in[I_EV_WIN], D, EV_N, (bf16*)(ws + WS_WEV_IN), scr, it, F.lane);
    { GAS v4u* z0 = (GAS v4u*)(ws + WS_WEV_IN + (size_t)EV_N * D * 2); const size_t n0 = (size_t)(EV_NP - EV_N) * D * 2 / 16;
      for (size_t i = gtid; i < n0; i += gthreads) z0[i] = (v4u){0u, 0u, 0u, 0u}; }
    { constexpr int I_PJ = (256 / 64) * (D / 32);
      for (int it = gw; it < 2 * I_PJ; it += NGW) { const int L = it / I_PJ; p0_transpose_item(A.in[I_PLE_WP] + (size_t)L * 256 * D, 256, D, (bf16*)(ws + WS_WPROJ) + (size_t)L * D * 256, scr, it % I_PJ, F.lane); } }
    cvt_f32_bf16(A.in[I_P], (bf16*)(ws + WS_PBF), (size_t)2 * T * 256, gtid, gthreads);
    for (int m = gw; m < T; m += NGW) rms_row_to_bf16(A.in[I_X] + (size_t)m * D, A.in[I_NMIX], (bf16*)(ws + WS_ACTA) + (size_t)m * D, F.lane);
}
__device__ __forceinline__ void p0_deferred(const Args& A, Frame& F, int wg, int nwg) {
    const int gw = wg * NWAVES + F.wave, NGW = nwg * NWAVES;
    int gtid = gw * 64 + F.lane; const int gthreads = nwg * NTHREADS;
    asm volatile("" : "+v"(gtid));
    unsigned char* ws = A.ws;
    {
        LAS float* scr = (LAS float*)(F.lds + RING_OFF + F.wave * 16384);
        constexpr int I_SQ = (D / 64) * (D / 32), I_ODIN = (D / 64) * (OD_N / 32);
        constexpr int NITEMS = I_SQ + I_ODIN + I_SQ;
        for (int it = gw; it < NITEMS; it += NGW) {
            int r = it;
            if (r < I_SQ) { p0_transpose_item(A.in[I_EV_WOUT], D, D, (bf16*)(ws + WS_WEV_OUT), scr, r, F.lane); continue; } r -= I_SQ;
            if (r < I_ODIN) { p0_transpose_item_f8(A.in[I_OD_WIN], D, OD_N, (unsigned char*)(ws + WS_WOD_IN), scr, r, F.lane, A.in[I_NMIX] + D); continue; } r -= I_ODIN;
            p0_transpose_item(A.in[I_PLE_WG], D, D, (bf16*)(ws + WS_WGATE), scr, r, F.lane, A.in[I_NPLE]);
        }
        { GAS v4u* z1 = (GAS v4u*)(ws + WS_WOD_IN + (size_t)OD_N * D); const size_t n1 = (size_t)(OD_NP - OD_N) * D / 16;
          for (size_t i = gtid; i < n1; i += gthreads) z1[i] = (v4u){0u, 0u, 0u, 0u}; }
    }
    __syncthreads();
    for (int it = wg; it < 512; it += nwg)
        p0_fold_item(A.in[I_PEER_WQ], A.in[I_PEER_SK], (bf16*)(ws + WS_WPEER), (LAS float*)(F.lds + RING_OFF), it, F.tid, A.in[I_NFFN]);
    cvt_f32_fp8(A.in[I_PEER_U], (unsigned char*)(ws + WS_TABU), (size_t)16384 * D, 512.0f, gtid, gthreads, A.in[I_NFFN]);
    cvt_f32_fp8(A.in[I_PEER_V], (unsigned char*)(ws + WS_TABV), (size_t)16384 * D, 16.0f, gtid, gthreads);
    { bf16* LB = (bf16*)(ws + WS_WLORA); const float* w2 = A.in[I_W2]; const float* a2 = A.in[I_A2]; const float* g2 = A.in[I_G2];
      for (int i = gtid; i < LORA_N * LORA_K / 2; i += gthreads) { const int row = i / (LORA_K / 2), col = (i % (LORA_K / 2)) * 2; float v[2];
#pragma unroll
          for (int e = 0; e < 2; ++e) { const int c = col + e; float x = 0.f;
              if (row < 1024) { if (c < 96) x = w2[c * 1024 + row]; }
              else if (row < 2048) { if (c >= 96 && c < 192) x = a2[(c - 96) * 1024 + (row - 1024)]; }
              else { if (c >= 192 && c < 448) x = g2[(c - 192) * 1024 + (row - 2048)]; }
              v[e] = x; }
          *(GAS unsigned*)(LB + (size_t)row * LORA_K + col) = pk2(v[0], v[1]); } }
}
__device__ __forceinline__ void p1_deferred(const Args& A, Frame& F, int wg, int nwg) {
    const int gw = wg * NWAVES + F.wave, NGW = nwg * NWAVES;
    int gtid = gw * 64 + F.lane; const int gthreads = nwg * NTHREADS;
    asm volatile("" : "+v"(gtid));
    unsigned char* ws = A.ws;
    { LAS float* scr = (LAS float*)(F.lds + RING_OFF + F.wave * 16384); constexpr int I_SQ = (D / 64) * (D / 32);
      for (int it = gw; it < 2 * I_SQ; it += NGW) {
          if (it < I_SQ) p0_transpose_item(A.in[I_OD_WOUT], D, D, (bf16*)(ws + WS_WOD_OUT), scr, it, F.lane);
          else p0_transpose_item(A.in[I_PLE_WG] + (size_t)D * D, D, D, (bf16*)(ws + WS_WGATE) + (size_t)D * D, scr, it - I_SQ, F.lane, A.in[I_NPLE] + D); } }
    __syncthreads();
    for (int it = wg; it < 512; it += nwg)
        p0_fold_item(A.in[I_PEER_WQ] + (size_t)D * D, A.in[I_PEER_SK] + (size_t)16 * 128 * 128, (bf16*)(ws + WS_WPEER) + (size_t)D * D, (LAS float*)(F.lds + RING_OFF), it, F.tid, A.in[I_NFFN] + D);
    cvt_f32_fp8(A.in[I_PEER_U] + (size_t)16384 * D, (unsigned char*)(ws + WS_TABU) + (size_t)16384 * D, (size_t)16384 * D, 512.0f, gtid, gthreads, A.in[I_NFFN] + D);
    cvt_f32_fp8(A.in[I_PEER_V] + (size_t)16384 * D, (unsigned char*)(ws + WS_TABV) + (size_t)16384 * D, (size_t)16384 * D, 16.0f, gtid, gthreads);
}

constexpr int TC = 16, NCHUNK = SEQ / TC;

template <int MODE>
__device__ __forceinline__ void scan_gla_unit(const Args& A, Frame& F, int unit) {
    int tid = F.tid; asm volatile("" : "+v"(tid));
    const int lane = tid & 63, w = F.wave;
    int b, h, qcol, kcol, vcol, ocol;
    if (MODE == 0) { b = unit >> 4; h = (unit >> 2) & 3; const int s = unit & 3; qcol = EC_GQ + h * 128; kcol = EC_GK + h * 128; vcol = EC_GV + h * 256 + s * 64; ocol = h * 256 + s * 64; }
    else           { b = unit >> 4; h = (unit >> 1) & 7; const int s = unit & 1; qcol = OC_HQ + h * 128; kcol = OC_HF + h * 128; vcol = OC_HI + h * 128 + s * 64; ocol = h * 128 + s * 64; }
    const bf16* P = (const bf16*)(A.ws + WS_PROJ) + (size_t)b * SEQ * PROJ_LD;
    float* O = (float*)(A.ws + WS_O) + (size_t)b * SEQ * D + ocol;
    LAS float* Lf = (LAS float*)(F.lds + RING_OFF);
    constexpr int BUFSZ = 7168, O_EG = 0, O_K = 2048, O_Q = 4096, O_V = 6144, O_OUT = 2 * BUFSZ, O_W2 = O_OUT + 1024, O_BIAS = O_W2 + 2048;
    const int tl = tid >> 5, dq = (tid & 31) * 4, tlv = tid >> 4, c4 = (tid & 15) * 4;
    float lb[4] = {0.f, 0.f, 0.f, 0.f};
    if (MODE == 0) {
        const float* w2 = A.in[I_GK_W2]; const float* gb = A.in[I_GK_B];
        for (int i = tid; i < 2048; i += NTHREADS) Lf[O_W2 + i] = w2[(i >> 7) * 512 + h * 128 + (i & 127)];
        if (tid < 128) Lf[O_BIAS + tid] = gb[h * 128 + tid];
    } else {
        const float* lg = A.in[I_LB];
#pragma unroll
        for (int i = 0; i < 4; ++i) lb[i] = sigmoidf_(lg[1024 + h * 128 + dq + i] - lg[h * 128 + dq + i]);
    }
    u32x2 rq, rk, rv = {0u, 0u}; v4u rg0 = {0u, 0u, 0u, 0u}, rg1 = {0u, 0u, 0u, 0u};
#define GLA_LOAD(c) do { const bf16* pr = P + (size_t)((c) * TC + tl) * PROJ_LD; rq = *(const GAS u32x2*)(pr + qcol + dq); rk = *(const GAS u32x2*)(pr + kcol + dq); \
        if (MODE == 0) { rg0 = *(const GAS v4u*)(pr + EC_GLR); rg1 = *(const GAS v4u*)(pr + EC_GLR + 8); } \
        if (tid < 256) rv = *(const GAS u32x2*)(P + (size_t)((c) * TC + tlv) * PROJ_LD + vcol + c4); } while (0)
#define GLA_XFORM(bufi) do { LAS float* B_ = Lf + (bufi) * BUFSZ; f32x4 q4, k4, e4; \
        const float xq[4] = {bf_lo(rq.x), bf_hi(rq.x), bf_lo(rq.y), bf_hi(rq.y)}, xk[4] = {bf_lo(rk.x), bf_hi(rk.x), bf_lo(rk.y), bf_hi(rk.y)}; \
        if (MODE == 0) { f32x4 z = *(const LAS f32x4*)(Lf + O_BIAS + dq); \
            const float gl[16] = {bf_lo(rg0.x), bf_hi(rg0.x), bf_lo(rg0.y), bf_hi(rg0.y), bf_lo(rg0.z), bf_hi(rg0.z), bf_lo(rg0.w), bf_hi(rg0.w), \
                                  bf_lo(rg1.x), bf_hi(rg1.x), bf_lo(rg1.y), bf_hi(rg1.y), bf_lo(rg1.z), bf_hi(rg1.z), bf_lo(rg1.w), bf_hi(rg1.w)}; \
            _Pragma("unroll") for (int r_ = 0; r_ < 16; ++r_) { const f32x4 wv = *(const LAS f32x4*)(Lf + O_W2 + r_ * 128 + dq); z = z + wv * gl[r_]; } \
            _Pragma("unroll") for (int i_ = 0; i_ < 4; ++i_) { q4[i_] = xq[i_] * 0.08838834764831845f; k4[i_] = xk[i_]; e4[i_] = __builtin_amdgcn_exp2f(-0.0625f * __builtin_amdgcn_logf(1.0f + __expf(-z[i_]))); } } \
        else { _Pragma("unroll") for (int i_ = 0; i_ < 4; ++i_) { const float fg = lb[i_] + (1.f - lb[i_]) * sigmoidf_(xk[i_]); q4[i_] = siluf_(xq[i_]); k4[i_] = 1.f - fg; e4[i_] = fg; } } \
        *(LAS f32x4*)(B_ + O_EG + tl * 128 + dq) = e4; *(LAS f32x4*)(B_ + O_K + tl * 128 + dq) = k4; *(LAS f32x4*)(B_ + O_Q + tl * 128 + dq) = q4; \
        if (tid < 256) { f32x4 v4 = {bf_lo(rv.x), bf_hi(rv.x), bf_lo(rv.y), bf_hi(rv.y)}; *(LAS f32x4*)(B_ + O_V + tlv * 64 + c4) = v4; } } while (0)
    LBAR();
    GLA_LOAD(0); GLA_XFORM(0);
    LBAR();
    f32x2 S2[8];
#pragma unroll
    for (int i = 0; i < 8; ++i) S2[i] = (f32x2){0.f, 0.f};
    const int j = lane & 15, col = w * 8 + (lane >> 4) * 2;
    for (int c = 0; c < NCHUNK; ++c) {
        if (c + 1 < NCHUNK) GLA_LOAD(c + 1);
        const LAS float* B_ = Lf + (c & 1) * BUFSZ;
        float os0 = 0.f, os1 = 0.f;
        f32x4 e0, e1, k0, k1, q0, q1, ne0, ne1, nk0, nk1, nq0, nq1; f32x2 v2, nv2;
#define GLA_LDSTEP(t_, E0, E1, K0, K1, Q0, Q1, V2) do { E0 = *(const LAS f32x4*)(B_ + O_EG + (t_) * 128 + 4 * j); E1 = *(const LAS f32x4*)(B_ + O_EG + (t_) * 128 + 64 + 4 * j); \
            K0 = *(const LAS f32x4*)(B_ + O_K + (t_) * 128 + 4 * j); K1 = *(const LAS f32x4*)(B_ + O_K + (t_) * 128 + 64 + 4 * j); \
            Q0 = *(const LAS f32x4*)(B_ + O_Q + (t_) * 128 + 4 * j); Q1 = *(const LAS f32x4*)(B_ + O_Q + (t_) * 128 + 64 + 4 * j); V2 = *(const LAS f32x2*)(B_ + O_V + (t_) * 64 + col); } while (0)
        GLA_LDSTEP(0, e0, e1, k0, k1, q0, q1, v2);
#pragma unroll
        for (int t = 0; t < TC; ++t) {
            if (t + 1 < TC) { GLA_LDSTEP(t + 1, ne0, ne1, nk0, nk1, nq0, nq1, nv2); }
            __builtin_amdgcn_sched_barrier(0);
            f32x2 pa = {0.f, 0.f}, pb = {0.f, 0.f};
#pragma unroll
            for (int i = 0; i < 4; ++i) {
                S2[i] = S2[i] * e0[i] + v2 * k0[i]; S2[4 + i] = S2[4 + i] * e1[i] + v2 * k1[i];
                pa += S2[i] * q0[i]; pb += S2[4 + i] * q1[i]; }
            pa += pb;
            float p0 = pa[0], p1 = pa[1];
            row_sum16_x2(p0, p1);
            os0 = (j == t) ? p0 : os0; os1 = (j == t) ? p1 : os1;
            e0 = ne0; e1 = ne1; k0 = nk0; k1 = nk1; q0 = nq0; q1 = nq1; v2 = nv2;
        }
#undef GLA_LDSTEP
        { f32x2 o2 = {os0, os1}; *(LAS f32x2*)(Lf + O_OUT + j * 64 + col) = o2; }
        if (c + 1 < NCHUNK) GLA_XFORM((c + 1) & 1);
        LBAR();
        if (tid < 256) *(GAS f32x4*)(O + (size_t)(c * TC + tlv) * D + c4) = *(const LAS f32x4*)(Lf + O_OUT + tlv * 64 + c4);
        LBAR();
    }
#undef GLA_LOAD
#undef GLA_XFORM
}

__device__ __forceinline__ void scan_gdn_unit(const Args& A, Frame& F, int unit) {
    int tid = F.tid; asm volatile("" : "+v"(tid));
    const int lane = tid & 63, w = F.wave;
    const int b = unit >> 4, h = (unit >> 1) & 7, s = unit & 1;
    const int qcol = EC_BQ + h * 128, kcol = EC_BK + h * 128, vcol = EC_BV + h * 128 + s * 64, ocol = 1024 + h * 128 + s * 64;
    const bf16* P = (const bf16*)(A.ws + WS_PROJ) + (size_t)b * SEQ * PROJ_LD;
    float* O = (float*)(A.ws + WS_O) + (size_t)b * SEQ * D + ocol;
    LAS float* Lf = (LAS float*)(F.lds + RING_OFF);
    constexpr int BUFSZ = 5184, O_K = 0, O_Q = 2048, O_V = 4096, O_SC = 5120, O_OUT = 2 * BUFSZ, O_CW = O_OUT + 1024;
    const int tl = tid >> 5, dq = (tid & 31) * 4, tlv = tid >> 4, c4 = (tid & 15) * 4;
    { const float* cw = A.in[I_GDN_CONV];
      for (int i = tid; i < 4 * 320; i += NTHREADS) { const int jt = i / 320, x = i % 320;
          const int ch = x < 128 ? (h * 128 + x) : x < 256 ? (1024 + h * 128 + (x - 128)) : (2048 + h * 128 + s * 64 + (x - 256));
          Lf[O_CW + i] = cw[jt * 3072 + ch]; } }
    const float neg_ea = -__expf(A.in[I_GDN_ALOG][h]), dtb = A.in[I_GDN_DTB][h];
    u32x2 rq[4], rk[4], rv[4]; unsigned short rba = 0, rbb = 0;
#pragma unroll
    for (int i = 0; i < 4; ++i) rv[i] = (u32x2){0u, 0u};
#define GDN_LOAD(c) do { const int t_ = (c) * TC + tl; \
        _Pragma("unroll") for (int jt = 0; jt < 4; ++jt) { const int tt = t_ - 3 + jt; \
            if (tt >= 0) { const bf16* pr = P + (size_t)tt * PROJ_LD; rq[jt] = *(const GAS u32x2*)(pr + qcol + dq); rk[jt] = *(const GAS u32x2*)(pr + kcol + dq); } \
            else { rq[jt] = (u32x2){0u, 0u}; rk[jt] = (u32x2){0u, 0u}; } } \
        { const bf16* pr = P + (size_t)t_ * PROJ_LD; rba = pr[EC_BA + h]; rbb = pr[EC_BB + h]; } \
        if (tid < 256) { const int tv = (c) * TC + tlv; \
            _Pragma("unroll") for (int jt = 0; jt < 4; ++jt) { const int tt = tv - 3 + jt; \
                if (tt >= 0) rv[jt] = *(const GAS u32x2*)(P + (size_t)tt * PROJ_LD + vcol + c4); else rv[jt] = (u32x2){0u, 0u}; } } } while (0)
#define GDN_XFORM(bufi) do { LAS float* B_ = Lf + (bufi) * BUFSZ; f32x4 q4 = {0.f, 0.f, 0.f, 0.f}, k4 = {0.f, 0.f, 0.f, 0.f}; \
        _Pragma("unroll") for (int jt = 0; jt < 4; ++jt) { const f32x4 wq = *(const LAS f32x4*)(Lf + O_CW + jt * 320 + dq), wk = *(const LAS f32x4*)(Lf + O_CW + jt * 320 + 128 + dq); \
            q4[0] += wq[0] * bf_lo(rq[jt].x); q4[1] += wq[1] * bf_hi(rq[jt].x); q4[2] += wq[2] * bf_lo(rq[jt].y); q4[3] += wq[3] * bf_hi(rq[jt].y); \
            k4[0] += wk[0] * bf_lo(rk[jt].x); k4[1] += wk[1] * bf_hi(rk[jt].x); k4[2] += wk[2] * bf_lo(rk[jt].y); k4[3] += wk[3] * bf_hi(rk[jt].y); } \
        float sq = 0.f, sk = 0.f, sqk = 0.f; \
        _Pragma("unroll") for (int i_ = 0; i_ < 4; ++i_) { q4[i_] = siluf_(q4[i_]); k4[i_] = siluf_(k4[i_]); sq += q4[i_] * q4[i_]; sk += k4[i_] * k4[i_]; sqk += q4[i_] * k4[i_]; } \
        sq = half_sum32(sq); sk = half_sum32(sk); sqk = half_sum32(sqk); \
        const float rq_ = __builtin_amdgcn_rsqf(sq + EPS) * 0.08838834764831845f, rk_ = __builtin_amdgcn_rsqf(sk + EPS); \
        q4 = q4 * rq_; k4 = k4 * rk_; \
        *(LAS f32x4*)(B_ + O_K + tl * 128 + dq) = k4; *(LAS f32x4*)(B_ + O_Q + tl * 128 + dq) = q4; \
        if ((tid & 31) == 0) { const float ba = __uint_as_float((unsigned)rba << 16), bb = __uint_as_float((unsigned)rbb << 16); \
            f32x4 sc; sc[0] = __expf(neg_ea * softplusf_(ba + dtb)); sc[1] = sigmoidf_(bb); sc[2] = sqk * rq_ * rk_; sc[3] = 0.f; *(LAS f32x4*)(B_ + O_SC + tl * 4) = sc; } \
        if (tid < 256) { f32x4 v4 = {0.f, 0.f, 0.f, 0.f}; \
            _Pragma("unroll") for (int jt = 0; jt < 4; ++jt) { const f32x4 wv = *(const LAS f32x4*)(Lf + O_CW + jt * 320 + 256 + c4); \
                v4[0] += wv[0] * bf_lo(rv[jt].x); v4[1] += wv[1] * bf_hi(rv[jt].x); v4[2] += wv[2] * bf_lo(rv[jt].y); v4[3] += wv[3] * bf_hi(rv[jt].y); } \
            _Pragma("unroll") for (int i_ = 0; i_ < 4; ++i_) v4[i_] = siluf_(v4[i_]); \
            *(LAS f32x4*)(B_ + O_V + tlv * 64 + c4) = v4; } } while (0)
    LBAR();
    GDN_LOAD(0); GDN_XFORM(0);
    LBAR();
    f32x2 S2[8];
#pragma unroll
    for (int i = 0; i < 8; ++i) S2[i] = (f32x2){0.f, 0.f};
    const int j = lane & 15, col = w * 8 + (lane >> 4) * 2;
    for (int c = 0; c < NCHUNK; ++c) {
        if (c + 1 < NCHUNK) GDN_LOAD(c + 1);
        const LAS float* B_ = Lf + (c & 1) * BUFSZ;
        float os0 = 0.f, os1 = 0.f;
        f32x4 k0, k1, q0, q1, sc, nk0, nk1, nq0, nq1, nsc; f32x2 v2, nv2;
#define GDN_LDSTEP(t_, K0, K1, Q0, Q1, V2, SC) do { K0 = *(const LAS f32x4*)(B_ + O_K + (t_) * 128 + 4 * j); K1 = *(const LAS f32x4*)(B_ + O_K + (t_) * 128 + 64 + 4 * j); \
            Q0 = *(const LAS f32x4*)(B_ + O_Q + (t_) * 128 + 4 * j); Q1 = *(const LAS f32x4*)(B_ + O_Q + (t_) * 128 + 64 + 4 * j); V2 = *(const LAS f32x2*)(B_ + O_V + (t_) * 64 + col); SC = *(const LAS f32x4*)(B_ + O_SC + (t_) * 4); } while (0)
        GDN_LDSTEP(0, k0, k1, q0, q1, v2, sc);
#pragma unroll
        for (int t = 0; t < TC; ++t) {
            if (t + 1 < TC) { GDN_LDSTEP(t + 1, nk0, nk1, nq0, nq1, nv2, nsc); }
            __builtin_amdgcn_sched_barrier(0);
            f32x2 d1 = {0.f, 0.f}, d2 = {0.f, 0.f}, e1 = {0.f, 0.f}, e2 = {0.f, 0.f};
#pragma unroll
            for (int i = 0; i < 4; ++i) { d1 += S2[i] * k0[i]; e1 += S2[4 + i] * k1[i]; d2 += S2[i] * q0[i]; e2 += S2[4 + i] * q1[i]; }
            d1 += e1; d2 += e2;
            { float r0_ = d1[0], r1_ = d1[1], r2_ = d2[0], r3_ = d2[1]; row_sum16_x4(r0_, r1_, r2_, r3_); d1[0] = r0_; d1[1] = r1_; d2[0] = r2_; d2[1] = r3_; }
            const float a = sc[0], beta = sc[1], qk = sc[2];
            const f32x2 dl = (v2 - d1 * a) * beta;
            const f32x2 o2 = d2 * a + dl * qk;
#pragma unroll
            for (int i = 0; i < 4; ++i) { S2[i] = S2[i] * a + dl * k0[i]; S2[4 + i] = S2[4 + i] * a + dl * k1[i]; }
            os0 = (j == t) ? o2[0] : os0; os1 = (j == t) ? o2[1] : os1;
            k0 = nk0; k1 = nk1; q0 = nq0; q1 = nq1; v2 = nv2; sc = nsc;
        }
#undef GDN_LDSTEP
        { f32x2 o2 = {os0, os1}; *(LAS f32x2*)(Lf + O_OUT + j * 64 + col) = o2; }
        if (c + 1 < NCHUNK) GDN_XFORM((c + 1) & 1);
        LBAR();
        if (tid < 256) *(GAS f32x4*)(O + (size_t)(c * TC + tlv) * D + c4) = *(const LAS f32x4*)(Lf + O_OUT + tlv * 64 + c4);
        LBAR();
    }
#undef GDN_LOAD
#undef GDN_XFORM
}

typedef short bf16x4_t __attribute__((ext_vector_type(4)));
__device__ __forceinline__ bf16x8 mk_frag(u32x2 lo, u32x2 hi) { v4u t; t.x = lo.x; t.y = lo.y; t.z = hi.x; t.w = hi.y; return __builtin_bit_cast(bf16x8, t); }
template <int MODE>
__device__ __forceinline__ void scan_gla_mfma_unit(const Args& A, Frame& F, int unit) {
    int tid = F.tid; asm volatile("" : "+v"(tid));
    const int lane = tid & 63, w = F.wave;
    int b, h, qcol, kcol, vcol, ocol;
    if (MODE == 0) { b = unit >> 3; h = (unit >> 1) & 3; const int s = unit & 1; qcol = EC_GQ + h * 128; kcol = EC_GK + h * 128; vcol = EC_GV + h * 256 + s * 128; ocol = h * 256 + s * 128; }
    else           { b = unit >> 3; h = unit & 7; qcol = OC_HQ + h * 128; kcol = OC_HF + h * 128; vcol = OC_HI + h * 128; ocol = h * 128; }
    const bf16* P = (const bf16*)(A.ws + WS_PROJ) + (size_t)b * SEQ * PROJ_LD;
    bf16* O = (bf16*)(A.ws + WS_O) + (size_t)b * SEQ * D + ocol;
    LAS float* Lf = (LAS float*)(F.lds + RING_OFF);
    constexpr int BUFSZ = 8192, O_E = 0, O_K = 2048, O_Q = 4096, O_V = 6144, RS = 136, O_QB = 2 * BUFSZ, O_KB = O_QB + 1088, O_KT = O_KB + 1088, O_BL = O_KT + 1024, O_AM = O_BL + 128, O_W2 = O_AM + 128, O_BIAS = O_W2 + 2048;
    LAS bf16* QB = (LAS bf16*)(Lf + O_QB); LAS bf16* KB = (LAS bf16*)(Lf + O_KB); LAS bf16* KT = (LAS bf16*)(Lf + O_KT); LAS bf16* AM = (LAS bf16*)(Lf + O_AM);
    const int tl = tid >> 5, dq = (tid & 31) * 4;
    float lb[4] = {0.f, 0.f, 0.f, 0.f};
    if (MODE == 0) {
        const float* w2 = A.in[I_GK_W2]; const float* gb = A.in[I_GK_B];
        for (int i = tid; i < 2048; i += NTHREADS) Lf[O_W2 + i] = w2[(i >> 7) * 512 + h * 128 + (i & 127)];
        if (tid < 128) Lf[O_BIAS + tid] = gb[h * 128 + tid];
    } else {
        const float* lg = A.in[I_LB];
#pragma unroll
        for (int i = 0; i < 4; ++i) lb[i] = sigmoidf_(lg[1024 + h * 128 + dq + i] - lg[h * 128 + dq + i]);
    }
    u32x2 rq, rk, rv; v4u rg0 = {0u, 0u, 0u, 0u}, rg1 = {0u, 0u, 0u, 0u};
#define GM_LOAD(c) do { const bf16* pr = P + (size_t)((c) * TC + tl) * PROJ_LD; rq = *(const GAS u32x2*)(pr + qcol + dq); rk = *(const GAS u32x2*)(pr + kcol + dq); rv = *(const GAS u32x2*)(pr + vcol + dq); \
        if (MODE == 0) { rg0 = *(const GAS v4u*)(pr + EC_GLR); rg1 = *(const GAS v4u*)(pr + EC_GLR + 8); } } while (0)
#define GM_XFORM(bufi) do { LAS float* B_ = Lf + (bufi) * BUFSZ; f32x4 q4, k4, e4; \
        const float xq[4] = {bf_lo(rq.x), bf_hi(rq.x), bf_lo(rq.y), bf_hi(rq.y)}, xk[4] = {bf_lo(rk.x), bf_hi(rk.x), bf_lo(rk.y), bf_hi(rk.y)}; \
        if (MODE == 0) { f32x4 z = *(const LAS f32x4*)(Lf + O_BIAS + dq); \
            const float gl[16] = {bf_lo(rg0.x), bf_hi(rg0.x), bf_lo(rg0.y), bf_hi(rg0.y), bf_lo(rg0.z), bf_hi(rg0.z), bf_lo(rg0.w), bf_hi(rg0.w), \
                                  bf_lo(rg1.x), bf_hi(rg1.x), bf_lo(rg1.y), bf_hi(rg1.y), bf_lo(rg1.z), bf_hi(rg1.z), bf_lo(rg1.w), bf_hi(rg1.w)}; \
            _Pragma("unroll") for (int r_ = 0; r_ < 16; ++r_) { const f32x4 wv = *(const LAS f32x4*)(Lf + O_W2 + r_ * 128 + dq); z = z + wv * gl[r_]; } \
            _Pragma("unroll") for (int i_ = 0; i_ < 4; ++i_) { q4[i_] = xq[i_] * 0.08838834764831845f; k4[i_] = xk[i_]; e4[i_] = __builtin_amdgcn_exp2f(-0.0625f * __builtin_amdgcn_logf(1.0f + __expf(-z[i_]))); } } \
        else { _Pragma("unroll") for (int i_ = 0; i_ < 4; ++i_) { const float fg = lb[i_] + (1.f - lb[i_]) * sigmoidf_(xk[i_]); q4[i_] = siluf_(xq[i_]); k4[i_] = 1.f - fg; e4[i_] = fg; } } \
        *(LAS f32x4*)(B_ + O_E + tl * 128 + dq) = e4; *(LAS f32x4*)(B_ + O_K + tl * 128 + dq) = k4; *(LAS f32x4*)(B_ + O_Q + tl * 128 + dq) = q4; \
        { f32x4 v4 = {bf_lo(rv.x), bf_hi(rv.x), bf_lo(rv.y), bf_hi(rv.y)}; *(LAS f32x4*)(B_ + O_V + tl * 128 + dq) = v4; } } while (0)
    LBAR();
    GM_LOAD(0); GM_XFORM(0); GM_LOAD(1);
    LBAR();
    f32x4 Sacc[8];
#pragma unroll
    for (int i = 0; i < 8; ++i) Sacc[i] = (f32x4){0.f, 0.f, 0.f, 0.f};
    const int fr = lane & 15, g = lane >> 4, c0 = w * 16;
    for (int c = 0; c < NCHUNK; ++c) {
        const LAS float* B_ = Lf + (c & 1) * BUFSZ;
        {
            const int seg = tid >> 7, d = tid & 127;
            float bt = 1.f, ball = 1.f;
#pragma unroll
            for (int t = 0; t < 16; ++t) { const float e = B_[O_E + t * 128 + d]; ball *= e; if (t < 4 * seg) bt = ball; }
            ball = fmaxf(ball, 1e-30f);
            unsigned short kt4[4];
#pragma unroll
            for (int i = 0; i < 4; ++i) { const int t = 4 * seg + i; bt = fmaxf(bt * B_[O_E + t * 128 + d], 1e-30f);
                const float kk = B_[O_K + t * 128 + d], qq = B_[O_Q + t * 128 + d], ib = __builtin_amdgcn_rcpf(bt);
                QB[t * RS + d] = hw_bf(qq * bt); KB[t * RS + d] = hw_bf(kk * ib); kt4[i] = (unsigned short)hw_bf(kk * ball * ib); }
            u32x2 kw; kw.x = (unsigned)kt4[0] | ((unsigned)kt4[1] << 16); kw.y = (unsigned)kt4[2] | ((unsigned)kt4[3] << 16);
            *(LAS u32x2*)(KT + d * 16 + 4 * seg) = kw;
            if (seg == 3) Lf[O_BL + d] = ball;
        }
        LBAR();
        if (w == 0) {
            f32x4 acc = {0.f, 0.f, 0.f, 0.f};
#pragma unroll
            for (int ks = 0; ks < 4; ++ks) { const bf16x8 af = *(const LAS bf16x8*)(QB + fr * RS + 32 * ks + 8 * g), bfm = *(const LAS bf16x8*)(KB + fr * RS + 32 * ks + 8 * g);
                acc = __builtin_amdgcn_mfma_f32_16x16x32_bf16(af, bfm, acc, 0, 0, 0); }
#pragma unroll
            for (int r = 0; r < 4; ++r) { const int t = 4 * g + r, s = fr; AM[t * 16 + s] = hw_bf(s <= t ? acc[r] : 0.f); }
        }
        if (c + 1 < NCHUNK) GM_XFORM((c + 1) & 1);
        if (c + 2 < NCHUNK) GM_LOAD(c + 2);
        LBAR();
        {
            u32x2 vlo; { const float v0 = B_[O_V + (4 * g + 0) * 128 + c0 + fr], v1 = B_[O_V + (4 * g + 1) * 128 + c0 + fr], v2 = B_[O_V + (4 * g + 2) * 128 + c0 + fr], v3 = B_[O_V + (4 * g + 3) * 128 + c0 + fr];
                vlo.x = hw_pk2(v0, v1); vlo.y = hw_pk2(v2, v3); }
            const u32x2 zz = {0u, 0u};
            const bf16x8 vb = mk_frag(vlo, zz);
            f32x4 acco = {0.f, 0.f, 0.f, 0.f};
#pragma unroll
            for (int ks = 0; ks < 4; ++ks) {
                u32x2 slo, shi; slo.x = hw_pk2(Sacc[2 * ks][0], Sacc[2 * ks][1]); slo.y = hw_pk2(Sacc[2 * ks][2], Sacc[2 * ks][3]); shi.x = hw_pk2(Sacc[2 * ks + 1][0], Sacc[2 * ks + 1][1]); shi.y = hw_pk2(Sacc[2 * ks + 1][2], Sacc[2 * ks + 1][3]);
                const bf16x8 sb = mk_frag(slo, shi);
                const u32x2 qlo = *(const LAS u32x2*)(QB + fr * RS + 32 * ks + 4 * g), qhi = *(const LAS u32x2*)(QB + fr * RS + 32 * ks + 16 + 4 * g);
                acco = __builtin_amdgcn_mfma_f32_16x16x32_bf16(mk_frag(qlo, qhi), sb, acco, 0, 0, 0); }
            { const u32x2 alo = *(const LAS u32x2*)(AM + fr * 16 + 4 * g); acco = __builtin_amdgcn_mfma_f32_16x16x32_bf16(mk_frag(alo, zz), vb, acco, 0, 0, 0); }
#pragma unroll
            for (int r = 0; r < 4; ++r) O[(size_t)(c * TC + 4 * g + r) * D + c0 + fr] = hw_bf(acco[r]);
#pragma unroll
            for (int i = 0; i < 8; ++i) { const f32x4 bl = *(const LAS f32x4*)(Lf + O_BL + 16 * i + 4 * g); const u32x2 klo = *(const LAS u32x2*)(KT + (16 * i + fr) * 16 + 4 * g);
                Sacc[i] = __builtin_amdgcn_mfma_f32_16x16x32_bf16(mk_frag(klo, zz), vb, Sacc[i] * bl, 0, 0, 0); }
        }
        LBAR();
    }
#undef GM_LOAD
#undef GM_XFORM
}

__device__ __forceinline__ void scan_gdn_mfma_unit(const Args& A, Frame& F, int unit, const int role) {
    int tid = F.tid; asm volatile("" : "+v"(tid));
    const int lane = tid & 63, w = F.wave;
    const int b = unit >> 3, h = unit & 7;
    const int qcol = EC_BQ + h * 128, kcol = EC_BK + h * 128, vcol = EC_BV + h * 128, ocol = 1024 + h * 128;
    const bf16* P = (const bf16*)(A.ws + WS_PROJ) + (size_t)b * SEQ * PROJ_LD;
    bf16* O = (bf16*)(A.ws + WS_O) + (size_t)b * SEQ * D + ocol;
    LAS float* Lf = (LAS float*)(F.lds + RING_OFF);
    constexpr int O_CW = 0, O_AMAT = 1536, O_QKM = O_AMAT + 256, O_TB = O_QKM + 128, O_GL = O_TB + 128, O_BUF0 = O_GL + 64;
    constexpr int BUFSZ = 6208, O_KH = 0, O_QH = 2048, O_VV = 4096, O_SC = 6144;
    constexpr int RS = 136;
    constexpr int O_KHB = O_BUF0 + 2 * BUFSZ, O_QHB = O_KHB + 1088, O_QB = O_QHB + 1088, O_KT = O_QB + 1088, O_WSRC = O_KT + 1024, O_WB = O_WSRC + 2048;
    LAS bf16* KHB = (LAS bf16*)(Lf + O_KHB); LAS bf16* QHB = (LAS bf16*)(Lf + O_QHB); LAS bf16* QB = (LAS bf16*)(Lf + O_QB); LAS bf16* KT = (LAS bf16*)(Lf + O_KT);
    LAS bf16* WB = (LAS bf16*)(Lf + O_WB); LAS bf16* QKM = (LAS bf16*)(Lf + O_QKM); LAS bf16* TB = (LAS bf16*)(Lf + O_TB);
    const int tl = tid >> 5, dq = (tid & 31) * 4;
    { const float* cw = A.in[I_GDN_CONV];
      for (int i = tid; i < 4 * 384; i += NTHREADS) { const int jt = i / 384, x = i % 384; Lf[O_CW + i] = cw[jt * 3072 + (x >> 7) * 1024 + h * 128 + (x & 127)]; } }
    const float neg_ea = -__expf(A.in[I_GDN_ALOG][h]), dtb = A.in[I_GDN_DTB][h];
    u32x2 rq[4], rk[4], rv[4]; unsigned short rba = 0, rbb = 0;
#define GD_LOAD(c) do { const int t_ = (c) * TC + tl; \
        _Pragma("unroll") for (int jt = 0; jt < 4; ++jt) { const int tt = t_ - 3 + jt; const bf16* pr = P + (size_t)(tt < 0 ? 0 : tt) * PROJ_LD + dq; \
            rq[jt] = *(const GAS u32x2*)(pr + qcol); rk[jt] = *(const GAS u32x2*)(pr + kcol); rv[jt] = *(const GAS u32x2*)(pr + vcol); \
            if (tt < 0) { rq[jt] = (u32x2){0u, 0u}; rk[jt] = (u32x2){0u, 0u}; rv[jt] = (u32x2){0u, 0u}; } } \
        { const bf16* pr = P + (size_t)t_ * PROJ_LD; rba = pr[EC_BA + h]; rbb = pr[EC_BB + h]; } } while (0)
#define GD_XFORM(bufi) do { LAS float* B_ = Lf + O_BUF0 + (bufi) * BUFSZ; f32x4 q4 = {0.f, 0.f, 0.f, 0.f}, k4 = {0.f, 0.f, 0.f, 0.f}, v4 = {0.f, 0.f, 0.f, 0.f}; \
        _Pragma("unroll") for (int jt = 0; jt < 4; ++jt) { const f32x4 wq = *(const LAS f32x4*)(Lf + O_CW + jt * 384 + dq), wk = *(const LAS f32x4*)(Lf + O_CW + jt * 384 + 128 + dq), wv = *(const LAS f32x4*)(Lf + O_CW + jt * 384 + 256 + dq); \
            q4[0] += wq[0] * bf_lo(rq[jt].x); q4[1] += wq[1] * bf_hi(rq[jt].x); q4[2] += wq[2] * bf_lo(rq[jt].y); q4[3] += wq[3] * bf_hi(rq[jt].y); \
            k4[0] += wk[0] * bf_lo(rk[jt].x); k4[1] += wk[1] * bf_hi(rk[jt].x); k4[2] += wk[2] * bf_lo(rk[jt].y); k4[3] += wk[3] * bf_hi(rk[jt].y); \
            v4[0] += wv[0] * bf_lo(rv[jt].x); v4[1] += wv[1] * bf_hi(rv[jt].x); v4[2] += wv[2] * bf_lo(rv[jt].y); v4[3] += wv[3] * bf_hi(rv[jt].y); } \
        float sq = 0.f, sk = 0.f; \
        _Pragma("unroll") for (int i_ = 0; i_ < 4; ++i_) { q4[i_] = siluf_(q4[i_]); k4[i_] = siluf_(k4[i_]); v4[i_] = siluf_(v4[i_]); sq += q4[i_] * q4[i_]; sk += k4[i_] * k4[i_]; } \
        row_sum16_x2(sq, sk); sq += __shfl_xor(sq, 16); sk += __shfl_xor(sk, 16); \
        q4 = q4 * (__builtin_amdgcn_rsqf(sq + EPS) * 0.08838834764831845f); k4 = k4 * __builtin_amdgcn_rsqf(sk + EPS); \
        *(LAS f32x4*)(B_ + O_KH + tl * 128 + dq) = k4; *(LAS f32x4*)(B_ + O_QH + tl * 128 + dq) = q4; *(LAS f32x4*)(B_ + O_VV + tl * 128 + dq) = v4; \
        if ((tid & 31) == 0) { const float ba = __uint_as_float((unsigned)rba << 16), bb = __uint_as_float((unsigned)rbb << 16); \
            B_[O_SC + tl] = __expf(neg_ea * softplusf_(ba + dtb)); B_[O_SC + 16 + tl] = sigmoidf_(bb); } } while (0)
    LBAR();
    constexpr int SPLIT = 58;
    const int c_begin = role ? SPLIT : 0, c_end = role ? NCHUNK : SPLIT;
    constexpr int REC = 5408;
    float* STASH = (float*)(A.ws + WS_LA) + (size_t)unit * (NCHUNK - SPLIT) * REC;
    float* STATE = (float*)(A.ws + WS_STATE) + (size_t)unit * 16384;
    gu32* flag = F.ctl + 32768 + unit * 64;
    GD_LOAD(c_begin); GD_XFORM(c_begin & 1); GD_LOAD(c_begin + 1);
    LBAR();
    f32x4 Sacc[8];
#pragma unroll
    for (int i = 0; i < 8; ++i) Sacc[i] = (f32x4){0.f, 0.f, 0.f, 0.f};
    const int fr = lane & 15, g = lane >> 4, c0 = w * 16;
    const u32x2 zz = {0u, 0u};
#define GD_STATE_PART(cc_) do { \
        { \
            bf16x8 sb[4]; \
_Pragma("unroll") \
            for (int ks = 0; ks < 4; ++ks) { u32x2 slo, shi; slo.x = hw_pk2(Sacc[2 * ks][0], Sacc[2 * ks][1]); slo.y = hw_pk2(Sacc[2 * ks][2], Sacc[2 * ks][3]); shi.x = hw_pk2(Sacc[2 * ks + 1][0], Sacc[2 * ks + 1][1]); shi.y = hw_pk2(Sacc[2 * ks + 1][2], Sacc[2 * ks + 1][3]); \
                sb[ks] = mk_frag(slo, shi); } \
            f32x4 accv = accu, acco = {0.f, 0.f, 0.f, 0.f}; \
_Pragma("unroll") \
            for (int ks = 0; ks < 4; ++ks) { \
                const u32x2 wl = *(const LAS u32x2*)(WB + fr * RS + 32 * ks + 4 * g), wh = *(const LAS u32x2*)(WB + fr * RS + 32 * ks + 16 + 4 * g); \
                accv = __builtin_amdgcn_mfma_f32_16x16x32_bf16(mk_frag(wl, wh), sb[ks], accv, 0, 0, 0); \
                const u32x2 ql = *(const LAS u32x2*)(QB + fr * RS + 32 * ks + 4 * g), qh = *(const LAS u32x2*)(QB + fr * RS + 32 * ks + 16 + 4 * g); \
                acco = __builtin_amdgcn_mfma_f32_16x16x32_bf16(mk_frag(ql, qh), sb[ks], acco, 0, 0, 0); } \
            u32x2 vn; vn.x = hw_pk2(accv[0], accv[1]); vn.y = hw_pk2(accv[2], accv[3]); \
            const bf16x8 vnb = mk_frag(vn, zz); \
            acco = __builtin_amdgcn_mfma_f32_16x16x32_bf16(mk_frag(*(const LAS u32x2*)(QKM + fr * 16 + 4 * g), zz), vnb, acco, 0, 0, 0); \
_Pragma("unroll") \
            for (int r = 0; r < 4; ++r) O[(size_t)((cc_) * TC + 4 * g + r) * D + c0 + fr] = hw_bf(acco[r]); \
_Pragma("unroll") \
            for (int i = 0; i < 8; ++i) { const u32x2 klo = *(const LAS u32x2*)(KT + (16 * i + fr) * 16 + 4 * g); \
                Sacc[i] = __builtin_amdgcn_mfma_f32_16x16x32_bf16(mk_frag(klo, zz), vnb, Sacc[i] * glast, 0, 0, 0); } \
        } \
        } while (0)
    for (int c = c_begin; c < c_end; ++c) {
        const LAS float* B_ = Lf + O_BUF0 + (c & 1) * BUFSZ;
        float glast;
        {
            const int seg = tid >> 7, d = tid & 127;
            const f32x4 a0 = *(const LAS f32x4*)(B_ + O_SC), a1 = *(const LAS f32x4*)(B_ + O_SC + 4), a2 = *(const LAS f32x4*)(B_ + O_SC + 8), a3 = *(const LAS f32x4*)(B_ + O_SC + 12);
            const float av[16] = {a0[0], a0[1], a0[2], a0[3], a1[0], a1[1], a1[2], a1[3], a2[0], a2[1], a2[2], a2[3], a3[0], a3[1], a3[2], a3[3]};
            float p = 1.f, gpre = 1.f;
#pragma unroll
            for (int t = 0; t < 16; ++t) { if (t == 4 * seg) gpre = p; p *= av[t]; }
            glast = p;
            unsigned short kt4[4]; float gt = gpre;
#pragma unroll
            for (int i = 0; i < 4; ++i) { const int t = 4 * seg + i; const float at = (seg == 0) ? av[i] : (seg == 1) ? av[4 + i] : (seg == 2) ? av[8 + i] : av[12 + i]; gt *= at; const float beta = B_[O_SC + 16 + t];
                const float kk = B_[O_KH + t * 128 + d], qq = B_[O_QH + t * 128 + d];
                KHB[t * RS + d] = hw_bf(kk); QHB[t * RS + d] = hw_bf(qq); QB[t * RS + d] = hw_bf(qq * gt);
                kt4[i] = (unsigned short)hw_bf(kk * glast * __builtin_amdgcn_rcpf(gt));
                Lf[O_WSRC + t * 128 + d] = kk * (beta * gt);
                if (d == 0) Lf[O_GL + t] = gt; }
            u32x2 kw; kw.x = (unsigned)kt4[0] | ((unsigned)kt4[1] << 16); kw.y = (unsigned)kt4[2] | ((unsigned)kt4[3] << 16);
            *(LAS u32x2*)(KT + d * 16 + 4 * seg) = kw;
        }
        LBAR();
        if (w < 2) {
            const LAS bf16* AS = (w == 0) ? KHB : QHB;
            f32x4 acc = {0.f, 0.f, 0.f, 0.f};
#pragma unroll
            for (int ks = 0; ks < 4; ++ks) { const bf16x8 af = *(const LAS bf16x8*)(AS + fr * RS + 32 * ks + 8 * g), bfm = *(const LAS bf16x8*)(KHB + fr * RS + 32 * ks + 8 * g);
                acc = __builtin_amdgcn_mfma_f32_16x16x32_bf16(af, bfm, acc, 0, 0, 0); }
            const float gs_inv = __builtin_amdgcn_rcpf(Lf[O_GL + fr]);
            if (w == 0) {
                f32x4 N1, M1;
#pragma unroll
                for (int r = 0; r < 4; ++r) { const int t = 4 * g + r; const float gt = Lf[O_GL + t];
                    N1[r] = (fr < t) ? -(B_[O_SC + 16 + t] * acc[r] * gt * gs_inv) : 0.f;
                    M1[r] = (t < fr) ? -(B_[O_SC + 16 + fr] * acc[r] * Lf[O_GL + fr] * __builtin_amdgcn_rcpf(gt)) : 0.f; }
#define XTY(X, Y, C0) __builtin_amdgcn_mfma_f32_16x16x32_bf16(mk_frag((u32x2){hw_pk2(X[0], X[1]), hw_pk2(X[2], X[3])}, zz), mk_frag((u32x2){hw_pk2(Y[0], Y[1]), hw_pk2(Y[2], Y[3])}, zz), C0, 0, 0, 0)
                const f32x4 z4 = {0.f, 0.f, 0.f, 0.f};
                f32x4 T1t = M1;
#pragma unroll
                for (int r = 0; r < 4; ++r) if (4 * g + r == fr) T1t[r] += 1.f;
                const f32x4 N2 = XTY(M1, N1, z4), M2 = XTY(N1, M1, z4);
                const f32x4 T2t = XTY(N2, T1t, T1t);
                const f32x4 N4 = XTY(M2, N2, z4), M4 = XTY(N2, M2, z4);
                const f32x4 T4t = XTY(N4, T2t, T2t);
                const f32x4 N8 = XTY(M4, N4, z4);
                const f32x4 T8t = XTY(N8, T4t, T4t);
#undef XTY
                u32x2 tw; tw.x = hw_pk2(T8t[0], T8t[1]); tw.y = hw_pk2(T8t[2], T8t[3]);
                *(LAS u32x2*)(TB + fr * 16 + 4 * g) = tw;
            } else {
#pragma unroll
                for (int r = 0; r < 4; ++r) { const int t = 4 * g + r; QKM[t * 16 + fr] = hw_bf((fr <= t) ? acc[r] * Lf[O_GL + t] * gs_inv : 0.f); }
            }
        }
        if (c + 1 < c_end) GD_XFORM((c + 1) & 1);
        if (c + 2 < c_end) GD_LOAD(c + 2);
        LBAR();
        f32x4 accu = {0.f, 0.f, 0.f, 0.f};
        {
            const bf16x8 tf = mk_frag(*(const LAS u32x2*)(TB + fr * 16 + 4 * g), zz);
            u32x2 ulo, wlo;
            { const float b0 = B_[O_SC + 16 + 4 * g + 0], b1 = B_[O_SC + 16 + 4 * g + 1], b2 = B_[O_SC + 16 + 4 * g + 2], b3 = B_[O_SC + 16 + 4 * g + 3];
              ulo.x = hw_pk2(b0 * B_[O_VV + (4 * g + 0) * 128 + c0 + fr], b1 * B_[O_VV + (4 * g + 1) * 128 + c0 + fr]); ulo.y = hw_pk2(b2 * B_[O_VV + (4 * g + 2) * 128 + c0 + fr], b3 * B_[O_VV + (4 * g + 3) * 128 + c0 + fr]);
              wlo.x = hw_pk2(Lf[O_WSRC + (4 * g + 0) * 128 + c0 + fr], Lf[O_WSRC + (4 * g + 1) * 128 + c0 + fr]); wlo.y = hw_pk2(Lf[O_WSRC + (4 * g + 2) * 128 + c0 + fr], Lf[O_WSRC + (4 * g + 3) * 128 + c0 + fr]); }
            accu = __builtin_amdgcn_mfma_f32_16x16x32_bf16(tf, mk_frag(ulo, zz), accu, 0, 0, 0);
            f32x4 accw = {0.f, 0.f, 0.f, 0.f};
            accw = __builtin_amdgcn_mfma_f32_16x16x32_bf16(tf, mk_frag(wlo, zz), accw, 0, 0, 0);
#pragma unroll
            for (int r = 0; r < 4; ++r) WB[(4 * g + r) * RS + c0 + fr] = hw_bf(-accw[r]);
        }
        LBAR();
        if (role == 0) {
            GD_STATE_PART(c);
        } else {
            float* rec = STASH + (size_t)(c - c_begin) * REC;
            for (int i = tid; i < 832; i += NTHREADS) { const int o = i < 528 ? O_QB + 4 * i : (i < 800 ? O_WB + 4 * (i - 528) : O_QKM + 4 * (i - 800)); *(GAS f32x4*)(rec + 4 * i) = *(const LAS f32x4*)(Lf + o); }
#pragma unroll
            for (int r = 0; r < 4; ++r) rec[3328 + (w * 4 + r) * 64 + lane] = accu[r];
            if (tid == 0) rec[5376] = glast;
        }
        LBAR();
    }
    if (role == 0) {
#pragma unroll
        for (int i = 0; i < 8; ++i)
#pragma unroll
            for (int r = 0; r < 4; ++r) STATE[((w * 8 + i) * 4 + r) * 64 + lane] = Sacc[i][r];
        asm volatile("s_waitcnt vmcnt(0)" ::: "memory");
        __syncthreads();
        if (tid == 0) { __builtin_amdgcn_fence(__ATOMIC_RELEASE, "agent"); asm volatile("s_waitcnt vmcnt(0)" ::: "memory"); __hip_atomic_store(flag, 1u, __ATOMIC_RELAXED, __HIP_MEMORY_SCOPE_AGENT); }
    } else {
        if (tid == 0) { unsigned sp = 0; while (__hip_atomic_load(flag, __ATOMIC_RELAXED, __HIP_MEMORY_SCOPE_AGENT) == 0u) { __builtin_amdgcn_s_sleep(8); if (++sp > (1u << 22)) break; }
            __builtin_amdgcn_fence(__ATOMIC_ACQUIRE, "agent"); asm volatile("s_waitcnt vmcnt(0)" ::: "memory"); }
        __syncthreads();
#pragma unroll
        for (int i = 0; i < 8; ++i)
#pragma unroll
            for (int r = 0; r < 4; ++r) Sacc[i][r] = STATE[((w * 8 + i) * 4 + r) * 64 + lane];
        f32x4 pa, pb; f32x4 pu; float pg;
#define GD_REC_LOAD(cc) do { const float* rec = STASH + (size_t)((cc) - c_begin) * REC; pa = *(const GAS f32x4*)(rec + 4 * tid); pb = (tid < 320) ? *(const GAS f32x4*)(rec + 4 * (tid + 512)) : (f32x4){0.f, 0.f, 0.f, 0.f}; \
            _Pragma("unroll") for (int r = 0; r < 4; ++r) pu[r] = rec[3328 + (w * 4 + r) * 64 + lane]; pg = rec[5376]; } while (0)
        GD_REC_LOAD(c_begin);
        for (int c = c_begin; c < c_end; ++c) {
            { const int i0 = tid, o0 = i0 < 528 ? O_QB + 4 * i0 : O_WB + 4 * (i0 - 528); *(LAS f32x4*)(Lf + o0) = pa;
              if (tid < 320) { const int i1 = tid + 512; const int o1 = i1 < 528 ? O_QB + 4 * i1 : (i1 < 800 ? O_WB + 4 * (i1 - 528) : O_QKM + 4 * (i1 - 800)); *(LAS f32x4*)(Lf + o1) = pb; } }
            const f32x4 accu = pu; const float glast = pg;
            if (c + 1 < c_end) GD_REC_LOAD(c + 1);
            LBAR();
            GD_STATE_PART(c);
            LBAR();
        }
#undef GD_REC_LOAD
    }
#undef GD_STATE_PART
#undef GD_LOAD
#undef GD_XFORM
}

__device__ __forceinline__ void scan_rwkv_unit(const Args& A, Frame& F, int unit) {
    int tid = F.tid; asm volatile("" : "+v"(tid));
    const int lane = tid & 63, w = F.wave;
    const int b = unit >> 4, h = unit & 15;
    const bf16* P = (const bf16*)(A.ws + WS_PROJ) + (size_t)b * SEQ * PROJ_LD + OC_RW;
    const bf16* LO = (const bf16*)(A.ws + WS_LO) + (size_t)b * SEQ * LORA_N;
    bf16* Y = (bf16*)(A.ws + WS_ACTA) + (size_t)b * SEQ * D + 1024 + h * 64;
    LAS float* Lf = (LAS float*)(F.lds + RING_OFF);
    constexpr int BUFSZ = 6208, O_KK = 0, O_WR = 1024, O_W = 2048, O_NKA = 3072, O_K = 4096, O_V = 5120, O_SC = 6144, O_OUT = 2 * BUFSZ;
    const int tl = tid >> 5, d2 = (tid & 31) * 2, hd = h * 64 + d2;
    float mu_r[2], mu_k[2], mu_v[2], w0[2], a0[2], k_k[2], k_a[2], r_k[2], lnw[2], lnb[2];
#pragma unroll
    for (int i = 0; i < 2; ++i) { mu_r[i] = A.in[I_MU][RW_R + hd + i]; mu_k[i] = A.in[I_MU][RW_K + hd + i]; mu_v[i] = A.in[I_MU][RW_V + hd + i];
        w0[i] = A.in[I_W0][hd + i]; a0[i] = A.in[I_A0][hd + i]; k_k[i] = A.in[I_KK][hd + i]; k_a[i] = A.in[I_KA][hd + i]; r_k[i] = A.in[I_RK][hd + i];
        lnw[i] = A.in[I_LNW][hd + i]; lnb[i] = A.in[I_LNB][hd + i]; }
    unsigned rr[2], rk[2], rv[2], rlw, rla, rg_cur = 0u, rg_nxt = 0u;
#define RW_LOAD(c) do { const int t_ = (c) * TC + tl; const bf16* pr = P + (size_t)t_ * PROJ_LD; \
        rr[0] = *(const GAS unsigned*)(pr + RW_R + hd); rk[0] = *(const GAS unsigned*)(pr + RW_K + hd); rv[0] = *(const GAS unsigned*)(pr + RW_V + hd); \
        if (t_ > 0) { rr[1] = *(const GAS unsigned*)(pr - PROJ_LD + RW_R + hd); rk[1] = *(const GAS unsigned*)(pr - PROJ_LD + RW_K + hd); rv[1] = *(const GAS unsigned*)(pr - PROJ_LD + RW_V + hd); } \
        else { rr[1] = 0u; rk[1] = 0u; rv[1] = 0u; } \
        const bf16* lr = LO + (size_t)t_ * LORA_N; rlw = *(const GAS unsigned*)(lr + hd); rla = *(const GAS unsigned*)(lr + 1024 + hd); rg_nxt = *(const GAS unsigned*)(lr + 2048 + hd); } while (0)
#define RW_XFORM(bufi) do { LAS float* B_ = Lf + (bufi) * BUFSZ; f32x2 kk2, wr2, w2_, nka2, k2, v2_; float skk = 0.f, sc1 = 0.f, sc2 = 0.f, sbs = 0.f; float aa[2], rrv[2]; \
        _Pragma("unroll") for (int i_ = 0; i_ < 2; ++i_) { \
            const float r0 = i_ ? bf_hi(rr[0]) : bf_lo(rr[0]), r1 = i_ ? bf_hi(rr[1]) : bf_lo(rr[1]); \
            const float k0_ = i_ ? bf_hi(rk[0]) : bf_lo(rk[0]), k1_ = i_ ? bf_hi(rk[1]) : bf_lo(rk[1]); \
            const float v0_ = i_ ? bf_hi(rv[0]) : bf_lo(rv[0]), v1_ = i_ ? bf_hi(rv[1]) : bf_lo(rv[1]); \
            const float lw = i_ ? bf_hi(rlw) : bf_lo(rlw), la = i_ ? bf_hi(rla) : bf_lo(rla); \
            const float r_ = r0 + (r1 - r0) * mu_r[i_], kx = k0_ + (k1_ - k0_) * mu_k[i_], vx = v0_ + (v1_ - v0_) * mu_v[i_]; \
            const float wd = __expf(-0.6065306597126334f * sigmoidf_(w0[i_] + lw)); const float a_ = sigmoidf_(a0[i_] + la); \
            const float kk0 = kx * k_k[i_]; const float km = kx * (1.f + (a_ - 1.f) * k_a[i_]); \
            kk2[i_] = kk0; skk += kk0 * kk0; aa[i_] = a_; rrv[i_] = r_; wr2[i_] = wd * r_; w2_[i_] = wd; k2[i_] = km; v2_[i_] = vx; sc2 += km * r_; sbs += r_ * km * r_k[i_]; } \
        skk = half_sum32(skk); const float rkk = __builtin_amdgcn_rsqf(skk + EPS); \
        _Pragma("unroll") for (int i_ = 0; i_ < 2; ++i_) { kk2[i_] *= rkk; nka2[i_] = -(kk2[i_] * aa[i_]); sc1 += kk2[i_] * aa[i_] * rrv[i_]; } \
        sc1 = half_sum32(sc1); sc2 = half_sum32(sc2); sbs = half_sum32(sbs); \
        *(LAS f32x2*)(B_ + O_KK + tl * 64 + d2) = kk2; *(LAS f32x2*)(B_ + O_WR + tl * 64 + d2) = wr2; *(LAS f32x2*)(B_ + O_W + tl * 64 + d2) = w2_; \
        *(LAS f32x2*)(B_ + O_NKA + tl * 64 + d2) = nka2; *(LAS f32x2*)(B_ + O_K + tl * 64 + d2) = k2; *(LAS f32x2*)(B_ + O_V + tl * 64 + d2) = v2_; \
        if ((tid & 31) == 0) { f32x4 sc; sc[0] = sc1; sc[1] = sc2; sc[2] = sbs; sc[3] = 0.f; *(LAS f32x4*)(B_ + O_SC + tl * 4) = sc; } } while (0)
    RW_LOAD(0); RW_XFORM(0); rg_cur = rg_nxt;
    LBAR();
    f32x2 S2[4];
#pragma unroll
    for (int i = 0; i < 4; ++i) S2[i] = (f32x2){0.f, 0.f};
    const int j = lane & 15, col = w * 8 + (lane >> 4) * 2;
    for (int c = 0; c < NCHUNK; ++c) {
        if (c + 1 < NCHUNK) RW_LOAD(c + 1);
        const LAS float* B_ = Lf + (c & 1) * BUFSZ;
        float os0 = 0.f, os1 = 0.f;
        f32x4 kk, wr, ww, nka, kv, sc, nkk, nwr, nww, nnka, nkv, nsc; f32x2 v2, nv2;
#define RW_LDSTEP(t_, KK, WR, WW, NKA, KV, V2, SC) do { KK = *(const LAS f32x4*)(B_ + O_KK + (t_) * 64 + 4 * j); WR = *(const LAS f32x4*)(B_ + O_WR + (t_) * 64 + 4 * j); WW = *(const LAS f32x4*)(B_ + O_W + (t_) * 64 + 4 * j); \
            NKA = *(const LAS f32x4*)(B_ + O_NKA + (t_) * 64 + 4 * j); KV = *(const LAS f32x4*)(B_ + O_K + (t_) * 64 + 4 * j); V2 = *(const LAS f32x2*)(B_ + O_V + (t_) * 64 + col); SC = *(const LAS f32x4*)(B_ + O_SC + (t_) * 4); } while (0)
        RW_LDSTEP(0, kk, wr, ww, nka, kv, v2, sc);
#pragma unroll
        for (int t = 0; t < TC; ++t) {
            if (t + 1 < TC) { RW_LDSTEP(t + 1, nkk, nwr, nww, nnka, nkv, nv2, nsc); }
            __builtin_amdgcn_sched_barrier(0);
            f32x2 d1 = S2[0] * kk[0], d2 = S2[0] * wr[0], e1 = S2[1] * kk[1], e2 = S2[1] * wr[1];
            d1 += S2[2] * kk[2]; d2 += S2[2] * wr[2]; e1 += S2[3] * kk[3]; e2 += S2[3] * wr[3];
            d1 += e1; d2 += e2;
            { float r0_ = d1[0], r1_ = d1[1], r2_ = d2[0], r3_ = d2[1]; row_sum16_x4(r0_, r1_, r2_, r3_); d1[0] = r0_; d1[1] = r1_; d2[0] = r2_; d2[1] = r3_; }
            const f32x2 o2 = d2 - d1 * sc[0] + v2 * sc[1];
#pragma unroll
            for (int i = 0; i < 4; ++i) S2[i] = S2[i] * ww[i] + d1 * nka[i] + v2 * kv[i];
            os0 = (j == t) ? o2[0] : os0; os1 = (j == t) ? o2[1] : os1;
            kk = nkk; wr = nwr; ww = nww; nka = nnka; kv = nkv; v2 = nv2; sc = nsc;
        }
#undef RW_LDSTEP
        { f32x2 o2 = {os0, os1}; *(LAS f32x2*)(Lf + O_OUT + j * 64 + col) = o2; }
        if (c + 1 < NCHUNK) RW_XFORM((c + 1) & 1);
        LBAR();
        {
            const f32x2 o2 = *(const LAS f32x2*)(Lf + O_OUT + tl * 64 + d2); const f32x2 vv = *(const LAS f32x2*)(B_ + O_V + tl * 64 + d2); const float bs = B_[O_SC + tl * 4 + 2];
            const float mean = half_sum32(o2[0] + o2[1]) * (1.0f / 64.0f); const float e0 = o2[0] - mean, e1 = o2[1] - mean;
            const float var = half_sum32(e0 * e0 + e1 * e1) * (1.0f / 64.0f); const float rs = __builtin_amdgcn_rsqf(var + 64e-5f);
            const float y0 = (e0 * rs * lnw[0] + lnb[0] + bs * vv[0]) * bf_lo(rg_cur), y1 = (e1 * rs * lnw[1] + lnb[1] + bs * vv[1]) * bf_hi(rg_cur);
            *(GAS unsigned*)(Y + (size_t)(c * TC + tl) * D + d2) = pk2(y0, y1);
        }
        rg_cur = rg_nxt;
        LBAR();
    }
#undef RW_LOAD
#undef RW_XFORM
}

template <int LAYER>
__device__ __forceinline__ void post_rows(const Args& A, Frame& F) {
    const int gw = F.vcu * NWAVES + F.wave, NGW = F.G * NWAVES, lane = F.lane;
    const bf16* O = (const bf16*)(A.ws + WS_O); const bf16* P = (const bf16*)(A.ws + WS_PROJ); bf16* Y = (bf16*)(A.ws + WS_ACTA);
    for (int m = gw; m < T; m += NGW) {
        const GAS u32x2* orow = (const GAS u32x2*)(O + (size_t)m * D) + lane; const bf16* prow = P + (size_t)m * PROJ_LD;
        constexpr int NJ = LAYER == 0 ? 8 : 4;
#pragma unroll
        for (int jj = 0; jj < NJ; ++jj) {
            const u32x2 ow_ = orow[64 * jj]; const f32x4 v = {bf_lo(ow_.x), bf_hi(ow_.x), bf_lo(ow_.y), bf_hi(ow_.y)}; float ss = (v[0] * v[0] + v[1] * v[1]) + (v[2] * v[2] + v[3] * v[3]);
            const bool wide = (LAYER == 0 && jj < 4);
            const float ms = wide ? wave_sum(ss) * (1.0f / 256.0f) : half_sum32(ss) * (1.0f / 128.0f);
            const float r = __builtin_amdgcn_rsqf(ms + EPS);
            const int cih = wide ? 4 * lane : 4 * (lane & 31);
            const float* gsrc = LAYER == 0 ? (wide ? A.in[I_GLA_NORM] : A.in[I_GDN_NORM]) : A.in[I_HG_NORM];
            const f32x4 g = *(const GAS f32x4*)(gsrc + cih);
            const int zcol = LAYER == 0 ? (wide ? EC_GZ + jj * 256 + 4 * lane : EC_BZ + (jj - 4) * 256 + 4 * lane) : OC_HG + jj * 256 + 4 * lane;
            const u32x2 zw = *(const GAS u32x2*)(prow + zcol);
            const float y0 = v[0] * r * g[0] * siluf_(bf_lo(zw.x)), y1 = v[1] * r * g[1] * siluf_(bf_hi(zw.x)), y2 = v[2] * r * g[2] * siluf_(bf_lo(zw.y)), y3 = v[3] * r * g[3] * siluf_(bf_hi(zw.y));
            u32x2 o; o.x = pk2(y0, y1); o.y = pk2(y2, y3);
            *(GAS u32x2*)(Y + (size_t)m * D + 256 * jj + 4 * lane) = o;
        }
    }
}
__device__ __forceinline__ void lora_prep_rows(const Args& A, Frame& F) {
    const int gw = F.vcu * NWAVES + F.wave, NGW = F.G * NWAVES, lane = F.lane;
    const bf16* P = (const bf16*)(A.ws + WS_PROJ); bf16* LA = (bf16*)(A.ws + WS_LA); const float* mu = A.in[I_MU];
    for (int m = gw; m < T; m += NGW) { const bool hasprev = (m % SEQ) != 0; const bf16* prow = P + (size_t)m * PROJ_LD + OC_RW + RW_WL;
#pragma unroll
        for (int i = 0; i < 7; ++i) { const int c = lane + 64 * i;
            const float x = __uint_as_float((unsigned)prow[c] << 16), xp = hasprev ? __uint_as_float((unsigned)prow[c - PROJ_LD] << 16) : 0.f;
            const float ts = x + (xp - x) * mu[RW_WL + c];
            const float v = c < 96 ? tanhf(ts) : (c < 192 ? ts : sigmoidf_(ts));
            LA[(size_t)m * LORA_K + c] = (bf16)f2bf(v); }
        LA[(size_t)m * LORA_K + 448 + lane] = (bf16)0; }
}
__device__ __forceinline__ void final_rows(const Args& A, Frame& F, const float oscale, const bf16* Hs) {
    const int gw = F.vcu * NWAVES + F.wave, NGW = F.G * NWAVES, lane = F.lane;
    const float* rowss = (const float*)(A.ws + WS_RSP) + (size_t)RS_FINAL * T * 32; const GAS f32x4* g = (const GAS f32x4*)A.in[I_NFINAL] + lane;
    for (int m = gw; m < T; m += NGW) { const float r = oscale * __builtin_amdgcn_rsqf(wave_sum(lane < 32 ? rowss[(size_t)m * 32 + lane] : 0.f) * (1.0f / D) + EPS); GAS f32x4* row = (GAS f32x4*)(A.out + (size_t)m * D) + lane;
        const GAS u32x2* hrow = (const GAS u32x2*)(Hs + (size_t)m * D) + lane;
#pragma unroll
        for (int jj = 0; jj < 8; ++jj) { const u32x2 hw = hrow[64 * jj]; const f32x4 v = {bf_lo(hw.x), bf_hi(hw.x), bf_lo(hw.y), bf_hi(hw.y)}; row[64 * jj] = v * r * g[64 * jj]; } }
}

__device__ __forceinline__ void scan_rwkv_mfma_unit(const Args& A, Frame& F, int unit, const int role) {
    int tid = F.tid; asm volatile("" : "+v"(tid));
    const int lane = tid & 63, w = F.wave;
    const int b = unit >> 3, hp = unit & 7;
    const bf16* P = (const bf16*)(A.ws + WS_PROJ) + (size_t)b * SEQ * PROJ_LD + OC_RW;
    const bf16* LO = (const bf16*)(A.ws + WS_LO) + (size_t)b * SEQ * LORA_N;
    bf16* Y = (bf16*)(A.ws + WS_ACTA) + (size_t)b * SEQ * D + 1024;
    LAS float* Lf = (LAS float*)(F.lds + RING_OFF);
    constexpr int RS = 72;
    constexpr int O_CONST = 0;
    constexpr int O_XF = 1280;
    constexpr int O_VV = O_XF + 2 * 5 * 1024;
    constexpr int O_BS = O_VV + 4 * 1024;
    constexpr int O_IMG = O_BS + 64;
    constexpr int I_CT = 0, I_BT = 576, I_KL = 1152, I_RT = 1728, I_CF = 2304, I_BTT = 3328, I_KTT = 3840, I_WCB = 4352, I_G1B = 4928, I_TTB = 5056, I_RKB = 5184, I_RBB = 5312, I_W15 = 5440, I_OUT = 5504, IMGSZ = 6528;
    static_assert((O_IMG + 2 * IMGSZ) * 4 <= RING_BYTES, "rwkv lds");
    for (int i = tid; i < 1280; i += NTHREADS) { const int arr = i >> 7, ch = hp * 128 + (i & 127); float v;
        switch (arr) { case 0: v = A.in[I_MU][RW_R + ch]; break; case 1: v = A.in[I_MU][RW_K + ch]; break; case 2: v = A.in[I_MU][RW_V + ch]; break; case 3: v = A.in[I_W0][ch]; break; case 4: v = A.in[I_A0][ch]; break;
                       case 5: v = A.in[I_KK][ch]; break; case 6: v = A.in[I_KA][ch]; break; case 7: v = A.in[I_RK][ch]; break; case 8: v = A.in[I_LNW][ch]; break; default: v = A.in[I_LNB][ch]; break; }
        Lf[O_CONST + i] = v; }
    const int hx = tid >> 8, tl = (tid >> 4) & 15, d4 = (tid & 15) * 4, ch4 = hx * 64 + d4, col4 = hp * 128 + ch4;
    u32x2 rr[2], rk[2], rv[2], rlw, rla, rg_cur = {0u, 0u}, rg_nxt = {0u, 0u}, rg_far = {0u, 0u};
#define RM_LOAD(c) do { const int t_ = (c) * TC + tl; const bf16* pr = P + (size_t)t_ * PROJ_LD + col4; \
        rr[0] = *(const GAS u32x2*)(pr + RW_R); rk[0] = *(const GAS u32x2*)(pr + RW_K); rv[0] = *(const GAS u32x2*)(pr + RW_V); \
        const bf16* pp_ = (t_ > 0) ? pr - PROJ_LD : pr; rr[1] = *(const GAS u32x2*)(pp_ + RW_R); rk[1] = *(const GAS u32x2*)(pp_ + RW_K); rv[1] = *(const GAS u32x2*)(pp_ + RW_V); \
        if (t_ == 0) { rr[1] = (u32x2){0u, 0u}; rk[1] = (u32x2){0u, 0u}; rv[1] = (u32x2){0u, 0u}; } \
        const bf16* lr = LO + (size_t)t_ * LORA_N + col4; rlw = *(const GAS u32x2*)(lr); rla = *(const GAS u32x2*)(lr + 1024); rg_far = *(const GAS u32x2*)(lr + 2048); } while (0)
#define RM_XFORM(bufi) do { LAS float* X_ = Lf + O_XF + hx * 5 * 1024 + tl * 64 + d4; \
        const f32x4 mur = *(const LAS f32x4*)(Lf + O_CONST + 0 * 128 + ch4), muk = *(const LAS f32x4*)(Lf + O_CONST + 1 * 128 + ch4), muv = *(const LAS f32x4*)(Lf + O_CONST + 2 * 128 + ch4); \
        const f32x4 w0_ = *(const LAS f32x4*)(Lf + O_CONST + 3 * 128 + ch4), a0_ = *(const LAS f32x4*)(Lf + O_CONST + 4 * 128 + ch4), kk_ = *(const LAS f32x4*)(Lf + O_CONST + 5 * 128 + ch4); \
        const f32x4 ka_ = *(const LAS f32x4*)(Lf + O_CONST + 6 * 128 + ch4), rk_ = *(const LAS f32x4*)(Lf + O_CONST + 7 * 128 + ch4); \
        const float r0[4] = {bf_lo(rr[0].x), bf_hi(rr[0].x), bf_lo(rr[0].y), bf_hi(rr[0].y)}, r1[4] = {bf_lo(rr[1].x), bf_hi(rr[1].x), bf_lo(rr[1].y), bf_hi(rr[1].y)}; \
        const float k0[4] = {bf_lo(rk[0].x), bf_hi(rk[0].x), bf_lo(rk[0].y), bf_hi(rk[0].y)}, k1[4] = {bf_lo(rk[1].x), bf_hi(rk[1].x), bf_lo(rk[1].y), bf_hi(rk[1].y)}; \
        const float v0[4] = {bf_lo(rv[0].x), bf_hi(rv[0].x), bf_lo(rv[0].y), bf_hi(rv[0].y)}, v1[4] = {bf_lo(rv[1].x), bf_hi(rv[1].x), bf_lo(rv[1].y), bf_hi(rv[1].y)}; \
        const float lw[4] = {bf_lo(rlw.x), bf_hi(rlw.x), bf_lo(rlw.y), bf_hi(rlw.y)}, la[4] = {bf_lo(rla.x), bf_hi(rla.x), bf_lo(rla.y), bf_hi(rla.y)}; \
        f32x4 r4, w4, k4, v4, kk4, b4; float skk = 0.f, sbs = 0.f; float aa[4]; \
        _Pragma("unroll") for (int i_ = 0; i_ < 4; ++i_) { const float r_ = r0[i_] + (r1[i_] - r0[i_]) * mur[i_], kx = k0[i_] + (k1[i_] - k0[i_]) * muk[i_], vx = v0[i_] + (v1[i_] - v0[i_]) * muv[i_]; \
            const float wd = __expf(-0.6065306597126334f * sigmoidf_(w0_[i_] + lw[i_])); const float a_ = sigmoidf_(a0_[i_] + la[i_]); \
            const float kk0 = kx * kk_[i_], km = kx * (1.f + (a_ - 1.f) * ka_[i_]); \
            r4[i_] = r_; w4[i_] = wd; k4[i_] = km; v4[i_] = vx; kk4[i_] = kk0; aa[i_] = a_; skk += kk0 * kk0; sbs += r_ * km * rk_[i_]; } \
        row_sum16_x2(skk, sbs); const float rkk = __builtin_amdgcn_rsqf(skk + EPS); \
        _Pragma("unroll") for (int i_ = 0; i_ < 4; ++i_) { kk4[i_] *= rkk; b4[i_] = kk4[i_] * aa[i_]; } \
        *(LAS f32x4*)(X_) = r4; *(LAS f32x4*)(X_ + 1024) = w4; *(LAS f32x4*)(X_ + 2048) = k4; *(LAS f32x4*)(X_ + 3072) = kk4; *(LAS f32x4*)(X_ + 4096) = b4; \
        *(LAS f32x4*)(Lf + O_VV + ((bufi) * 2 + hx) * 1024 + tl * 64 + d4) = v4; \
        if ((tid & 15) == 0) Lf[O_BS + ((bufi) * 2 + hx) * 16 + tl] = sbs; } while (0)
    constexpr int SPLIT = 60;
    const int c_begin = role ? SPLIT : 0, c_end = role ? NCHUNK : SPLIT;
    constexpr int REC = 7584;
    float* STASH = (float*)(A.ws + (unit < 32 ? WS_WEV_IN : WS_END)) + (size_t)(unit & 31) * (NCHUNK - SPLIT) * REC;
    float* STATE = (float*)(A.ws + WS_STATE + 4 * MiB) + (size_t)unit * 8192;
    gu32* flag = F.ctl + 49152 + unit * 64;
    LBAR();
    RM_LOAD(c_begin); RM_XFORM(c_begin & 1); rg_cur = rg_far; RM_LOAD(c_begin + 1); rg_nxt = rg_far;
    LBAR();
    f32x4 Macc[4];
#pragma unroll
    for (int i = 0; i < 4; ++i) Macc[i] = (f32x4){0.f, 0.f, 0.f, 0.f};
    const int fr = lane & 15, g = lane >> 4, hh = w >> 2, ww = w & 3, c0 = ww * 16;
    LAS float* IM = Lf + O_IMG + hh * IMGSZ;
    LAS bf16* CT = (LAS bf16*)(IM + I_CT); LAS bf16* BT = (LAS bf16*)(IM + I_BT); LAS bf16* KL = (LAS bf16*)(IM + I_KL); LAS bf16* RT = (LAS bf16*)(IM + I_RT);
    LAS bf16* BTT = (LAS bf16*)(IM + I_BTT); LAS bf16* KTT = (LAS bf16*)(IM + I_KTT); LAS bf16* WCB = (LAS bf16*)(IM + I_WCB);
    LAS bf16* G1B = (LAS bf16*)(IM + I_G1B); LAS bf16* TTB = (LAS bf16*)(IM + I_TTB); LAS bf16* RKB = (LAS bf16*)(IM + I_RKB); LAS bf16* RBB = (LAS bf16*)(IM + I_RBB);
    const u32x2 zz = {0u, 0u};
#define RM_STATE_PART(vb) do { \
        { \
            bf16x8 mb[2]; \
_Pragma("unroll") \
            for (int ks = 0; ks < 2; ++ks) { u32x2 slo, shi; slo.x = hw_pk2(Macc[2 * ks][0], Macc[2 * ks][1]); slo.y = hw_pk2(Macc[2 * ks][2], Macc[2 * ks][3]); shi.x = hw_pk2(Macc[2 * ks + 1][0], Macc[2 * ks + 1][1]); shi.y = hw_pk2(Macc[2 * ks + 1][2], Macc[2 * ks + 1][3]); \
                mb[ks] = mk_frag(slo, shi); } \
            f32x4 accR = accU, acco = {0.f, 0.f, 0.f, 0.f}; \
_Pragma("unroll") \
            for (int ks = 0; ks < 2; ++ks) { \
                accR = __builtin_amdgcn_mfma_f32_16x16x32_bf16(mk_frag(*(const LAS u32x2*)(WCB + fr * RS + 32 * ks + 4 * g), *(const LAS u32x2*)(WCB + fr * RS + 32 * ks + 16 + 4 * g)), mb[ks], accR, 0, 0, 0); \
                acco = __builtin_amdgcn_mfma_f32_16x16x32_bf16(mk_frag(*(const LAS u32x2*)(RT + fr * RS + 32 * ks + 4 * g), *(const LAS u32x2*)(RT + fr * RS + 32 * ks + 16 + 4 * g)), mb[ks], acco, 0, 0, 0); } \
            u32x2 rn; rn.x = hw_pk2(accR[0], accR[1]); rn.y = hw_pk2(accR[2], accR[3]); \
            const bf16x8 rb = mk_frag(rn, zz); \
            acco = __builtin_amdgcn_mfma_f32_16x16x32_bf16(mk_frag(*(const LAS u32x2*)(RKB + fr * 16 + 4 * g), zz), vb, acco, 0, 0, 0); \
            acco = __builtin_amdgcn_mfma_f32_16x16x32_bf16(mk_frag(*(const LAS u32x2*)(RBB + fr * 16 + 4 * g), zz), rb, acco, 0, 0, 0); \
_Pragma("unroll") \
            for (int r = 0; r < 4; ++r) IM[I_OUT + (4 * g + r) * 64 + c0 + fr] = acco[r]; \
_Pragma("unroll") \
            for (int i = 0; i < 4; ++i) { const f32x4 w15 = *(const LAS f32x4*)(IM + I_W15 + 16 * i + 4 * g); \
                f32x4 m = __builtin_amdgcn_mfma_f32_16x16x32_bf16(mk_frag(*(const LAS u32x2*)(KTT + (16 * i + fr) * 16 + 4 * g), zz), vb, Macc[i], 0, 0, 0); \
                m = __builtin_amdgcn_mfma_f32_16x16x32_bf16(mk_frag(*(const LAS u32x2*)(BTT + (16 * i + fr) * 16 + 4 * g), zz), rb, m, 0, 0, 0); \
                Macc[i] = m * w15; } \
        } \
        } while (0)
#define RM_FLUSH(cc_, gb_, vv_, bs_) do { \
        { \
            const f32x4 o4 = *(const LAS f32x4*)(Lf + O_IMG + hx * IMGSZ + I_OUT + tl * 64 + d4); const f32x4 vv = (vv_); const float bs = (bs_); \
            const f32x4 lnw = *(const LAS f32x4*)(Lf + O_CONST + 8 * 128 + ch4), lnb = *(const LAS f32x4*)(Lf + O_CONST + 9 * 128 + ch4); \
            float sm = (o4[0] + o4[1]) + (o4[2] + o4[3]), dummy = 0.f; row_sum16_x2(sm, dummy); const float mean = sm * (1.0f / 64.0f); \
            const f32x4 e4 = o4 - mean; float sv = (e4[0] * e4[0] + e4[1] * e4[1]) + (e4[2] * e4[2] + e4[3] * e4[3]); row_sum16_x2(sv, dummy); const float rs = __builtin_amdgcn_rsqf(sv * (1.0f / 64.0f) + 64e-5f); \
            const float gg[4] = {bf_lo((gb_).x), bf_hi((gb_).x), bf_lo((gb_).y), bf_hi((gb_).y)}; \
            float y[4]; \
_Pragma("unroll") \
            for (int i = 0; i < 4; ++i) y[i] = (e4[i] * rs * lnw[i] + lnb[i] + bs * vv[i]) * gg[i]; \
            u32x2 o; o.x = hw_pk2(y[0], y[1]); o.y = hw_pk2(y[2], y[3]); \
            *(GAS u32x2*)(Y + (size_t)((cc_) * TC + tl) * D + col4) = o; \
        } \
        } while (0)
    for (int c = c_begin; c < c_end; ++c) {
        {
            const int hq = tid >> 8, seg = (tid >> 6) & 3, d = tid & 63;
            const LAS float* X_ = Lf + O_XF + hq * 5 * 1024 + d; LAS float* IQ = Lf + O_IMG + hq * IMGSZ;
            LAS bf16* CTq = (LAS bf16*)(IQ + I_CT); LAS bf16* BTq = (LAS bf16*)(IQ + I_BT); LAS bf16* KLq = (LAS bf16*)(IQ + I_KL); LAS bf16* RTq = (LAS bf16*)(IQ + I_RT);
            float wall = 1.f, wpre = 1.f;
#pragma unroll
            for (int t = 0; t < 16; ++t) { if (t == 4 * seg) wpre = wall; wall *= X_[1024 + t * 64]; }
            float wt = wpre; unsigned short bt4[4], kt4[4];
#pragma unroll
            for (int i = 0; i < 4; ++i) { const int t = 4 * seg + i; const float wprev = wt; wt *= X_[1024 + t * 64]; const float iw = __builtin_amdgcn_rcpf(wt);
                const float r_ = X_[t * 64], k_ = X_[2048 + t * 64], kk_ = X_[3072 + t * 64], b_ = X_[4096 + t * 64];
                const float ct = kk_ * wprev, bt = b_ * iw, kt = k_ * iw;
                CTq[t * RS + d] = hw_bf(ct); IQ[I_CF + t * 64 + d] = ct; BTq[t * RS + d] = hw_bf(bt); KLq[t * RS + d] = hw_bf(kt); RTq[t * RS + d] = hw_bf(r_ * wt);
                bt4[i] = (unsigned short)hw_bf(-bt); kt4[i] = (unsigned short)hw_bf(kt); }
            u32x2 o; o.x = (unsigned)bt4[0] | ((unsigned)bt4[1] << 16); o.y = (unsigned)bt4[2] | ((unsigned)bt4[3] << 16); *(LAS u32x2*)((LAS bf16*)(IQ + I_BTT) + d * 16 + 4 * seg) = o;
            o.x = (unsigned)kt4[0] | ((unsigned)kt4[1] << 16); o.y = (unsigned)kt4[2] | ((unsigned)kt4[3] << 16); *(LAS u32x2*)((LAS bf16*)(IQ + I_KTT) + d * 16 + 4 * seg) = o;
            if (seg == 3) IQ[I_W15 + d] = wall;
        }
        LBAR();
        if (ww == 0) {
            f32x4 cb = {0.f, 0.f, 0.f, 0.f}, bc = cb, ck = cb, rkm = cb, rbm = cb;
#pragma unroll
            for (int ks = 0; ks < 2; ++ks) { const bf16x8 fc = *(const LAS bf16x8*)(CT + fr * RS + 32 * ks + 8 * g), fb = *(const LAS bf16x8*)(BT + fr * RS + 32 * ks + 8 * g), fk = *(const LAS bf16x8*)(KL + fr * RS + 32 * ks + 8 * g), frr = *(const LAS bf16x8*)(RT + fr * RS + 32 * ks + 8 * g);
                cb = __builtin_amdgcn_mfma_f32_16x16x32_bf16(fc, fb, cb, 0, 0, 0); bc = __builtin_amdgcn_mfma_f32_16x16x32_bf16(fb, fc, bc, 0, 0, 0); ck = __builtin_amdgcn_mfma_f32_16x16x32_bf16(fc, fk, ck, 0, 0, 0);
                rkm = __builtin_amdgcn_mfma_f32_16x16x32_bf16(frr, fk, rkm, 0, 0, 0); rbm = __builtin_amdgcn_mfma_f32_16x16x32_bf16(frr, fb, rbm, 0, 0, 0); }
            f32x4 N1, M1, CKm;
#pragma unroll
            for (int r = 0; r < 4; ++r) { const int t = 4 * g + r; N1[r] = (fr < t) ? -cb[r] : 0.f; M1[r] = (t < fr) ? -bc[r] : 0.f; CKm[r] = (fr < t) ? ck[r] : 0.f;
                RKB[t * 16 + fr] = hw_bf((fr <= t) ? rkm[r] : 0.f); RBB[t * 16 + fr] = hw_bf((fr <= t) ? -rbm[r] : 0.f); }
#define XTY(X, Y, C0) __builtin_amdgcn_mfma_f32_16x16x32_bf16(mk_frag((u32x2){hw_pk2(X[0], X[1]), hw_pk2(X[2], X[3])}, zz), mk_frag((u32x2){hw_pk2(Y[0], Y[1]), hw_pk2(Y[2], Y[3])}, zz), C0, 0, 0, 0)
            const f32x4 z4 = {0.f, 0.f, 0.f, 0.f};
            f32x4 T1t = M1;
#pragma unroll
            for (int r = 0; r < 4; ++r) if (4 * g + r == fr) T1t[r] += 1.f;
            const f32x4 N2 = XTY(M1, N1, z4), M2 = XTY(N1, M1, z4);
            const f32x4 T2t = XTY(N2, T1t, T1t);
            const f32x4 N4 = XTY(M2, N2, z4), M4 = XTY(N2, M2, z4);
            const f32x4 T4t = XTY(N4, T2t, T2t);
            const f32x4 N8 = XTY(M4, N4, z4);
            const f32x4 T8t = XTY(N8, T4t, T4t);
            const f32x4 G1t = XTY(CKm, T8t, z4);
#undef XTY
            u32x2 tw; tw.x = hw_pk2(T8t[0], T8t[1]); tw.y = hw_pk2(T8t[2], T8t[3]); *(LAS u32x2*)(TTB + fr * 16 + 4 * g) = tw;
            tw.x = hw_pk2(G1t[0], G1t[1]); tw.y = hw_pk2(G1t[2], G1t[3]); *(LAS u32x2*)(G1B + fr * 16 + 4 * g) = tw;
        }
        if (c + 1 < c_end) { RM_XFORM((c + 1) & 1); }
        if (c + 2 < c_end) RM_LOAD(c + 2);
        LBAR();
        const LAS float* VVc = Lf + O_VV + ((c & 1) * 2 + hh) * 1024;
        u32x2 vlo; { vlo.x = hw_pk2(VVc[(4 * g + 0) * 64 + c0 + fr], VVc[(4 * g + 1) * 64 + c0 + fr]); vlo.y = hw_pk2(VVc[(4 * g + 2) * 64 + c0 + fr], VVc[(4 * g + 3) * 64 + c0 + fr]); }
        const bf16x8 vb = mk_frag(vlo, zz);
        f32x4 accU = {0.f, 0.f, 0.f, 0.f};
        {
            accU = __builtin_amdgcn_mfma_f32_16x16x32_bf16(mk_frag(*(const LAS u32x2*)(G1B + fr * 16 + 4 * g), zz), vb, accU, 0, 0, 0);
            u32x2 clo; clo.x = hw_pk2(IM[I_CF + (4 * g + 0) * 64 + c0 + fr], IM[I_CF + (4 * g + 1) * 64 + c0 + fr]); clo.y = hw_pk2(IM[I_CF + (4 * g + 2) * 64 + c0 + fr], IM[I_CF + (4 * g + 3) * 64 + c0 + fr]);
            f32x4 accw = {0.f, 0.f, 0.f, 0.f};
            accw = __builtin_amdgcn_mfma_f32_16x16x32_bf16(mk_frag(*(const LAS u32x2*)(TTB + fr * 16 + 4 * g), zz), mk_frag(clo, zz), accw, 0, 0, 0);
#pragma unroll
            for (int r = 0; r < 4; ++r) WCB[(4 * g + r) * RS + c0 + fr] = hw_bf(accw[r]);
        }
        LBAR();
        if (role == 0) {
            RM_STATE_PART(vb);
            LBAR();
            RM_FLUSH(c, rg_cur, *(const LAS f32x4*)(Lf + O_VV + ((c & 1) * 2 + hx) * 1024 + tl * 64 + d4), Lf[O_BS + ((c & 1) * 2 + hx) * 16 + tl]);
        } else {
            float* rec = STASH + (size_t)(c - c_begin) * REC;
            for (int i = tid; i < 1376; i += NTHREADS) { const int hd = i >= 688, j = i - hd * 688; const int o = O_IMG + hd * IMGSZ + (j < 144 ? I_RT + 4 * j : I_BTT + 4 * (j - 144)); *(GAS f32x4*)(rec + 4 * i) = *(const LAS f32x4*)(Lf + o); }
            { GAS unsigned* ru = (GAS unsigned*)(rec + 5504); ru[(w * 2 + 0) * 64 + lane] = hw_pk2(accU[0], accU[1]); ru[(w * 2 + 1) * 64 + lane] = hw_pk2(accU[2], accU[3]); }
            { const f32x4 v4 = *(const LAS f32x4*)(Lf + O_VV + ((c & 1) * 2 + hx) * 1024 + tl * 64 + d4); u32x2 o; o.x = hw_pk2(v4[0], v4[1]); o.y = hw_pk2(v4[2], v4[3]); *(GAS u32x2*)(rec + 6528 + 2 * tid) = o; }
            if (tid < 32) rec[7552 + tid] = Lf[O_BS + (c & 1) * 32 + tid];
            LBAR();
        }
        rg_cur = rg_nxt; rg_nxt = rg_far;
    }
    if (role == 0) {
#pragma unroll
        for (int i = 0; i < 4; ++i)
#pragma unroll
            for (int r = 0; r < 4; ++r) STATE[((w * 4 + i) * 4 + r) * 64 + lane] = Macc[i][r];
        asm volatile("s_waitcnt vmcnt(0)" ::: "memory");
        __syncthreads();
        if (tid == 0) { __builtin_amdgcn_fence(__ATOMIC_RELEASE, "agent"); asm volatile("s_waitcnt vmcnt(0)" ::: "memory"); __hip_atomic_store(flag, 1u, __ATOMIC_RELAXED, __HIP_MEMORY_SCOPE_AGENT); }
    } else {
        if (tid == 0) { unsigned sp = 0; while (__hip_atomic_load(flag, __ATOMIC_RELAXED, __HIP_MEMORY_SCOPE_AGENT) == 0u) { __builtin_amdgcn_s_sleep(8); if (++sp > (1u << 22)) break; }
            __builtin_amdgcn_fence(__ATOMIC_ACQUIRE, "agent"); asm volatile("s_waitcnt vmcnt(0)" ::: "memory"); }
        __syncthreads();
#pragma unroll
        for (int i = 0; i < 4; ++i)
#pragma unroll
            for (int r = 0; r < 4; ++r) Macc[i][r] = STATE[((w * 4 + i) * 4 + r) * 64 + lane];
        f32x4 pi0, pi1, pi2; unsigned pu0, pu1; u32x2 pv, pgate; float pbs;
#define RM_REC_LOAD(cc) do { const float* rec = STASH + (size_t)((cc) - c_begin) * REC; pi0 = *(const GAS f32x4*)(rec + 4 * tid); pi1 = *(const GAS f32x4*)(rec + 4 * (tid + 512)); \
            pi2 = (tid < 352) ? *(const GAS f32x4*)(rec + 4 * (tid + 1024)) : (f32x4){0.f, 0.f, 0.f, 0.f}; \
            const GAS unsigned* ru = (const GAS unsigned*)(rec + 5504); pu0 = ru[(w * 2 + 0) * 64 + lane]; pu1 = ru[(w * 2 + 1) * 64 + lane]; pv = *(const GAS u32x2*)(rec + 6528 + 2 * tid); pbs = rec[7552 + hx * 16 + tl]; \
            pgate = *(const GAS u32x2*)(LO + (size_t)((cc) * TC + tl) * LORA_N + col4 + 2048); } while (0)
#define RM_IMG_OFF(i_) (O_IMG + ((i_) >= 688) * IMGSZ + ((((i_) - ((i_) >= 688) * 688) < 144) ? I_RT + 4 * ((i_) - ((i_) >= 688) * 688) : I_BTT + 4 * (((i_) - ((i_) >= 688) * 688) - 144)))
        RM_REC_LOAD(c_begin);
        for (int c = c_begin; c < c_end; ++c) {
            *(LAS f32x4*)(Lf + RM_IMG_OFF(tid)) = pi0; *(LAS f32x4*)(Lf + RM_IMG_OFF(tid + 512)) = pi1; if (tid < 352) *(LAS f32x4*)(Lf + RM_IMG_OFF(tid + 1024)) = pi2;
            const f32x4 vcur = {bf_lo(pv.x), bf_hi(pv.x), bf_lo(pv.y), bf_hi(pv.y)}; *(LAS f32x4*)(Lf + O_VV + hx * 1024 + tl * 64 + d4) = vcur;
            const f32x4 accU = {bf_lo(pu0), bf_hi(pu0), bf_lo(pu1), bf_hi(pu1)}; const float bscur = pbs; const u32x2 gcur = pgate;
            if (c + 1 < c_end) RM_REC_LOAD(c + 1);
            LBAR();
            const LAS float* VVc = Lf + O_VV + hh * 1024;
            u32x2 vlo; { vlo.x = hw_pk2(VVc[(4 * g + 0) * 64 + c0 + fr], VVc[(4 * g + 1) * 64 + c0 + fr]); vlo.y = hw_pk2(VVc[(4 * g + 2) * 64 + c0 + fr], VVc[(4 * g + 3) * 64 + c0 + fr]); }
            const bf16x8 vb = mk_frag(vlo, zz);
            RM_STATE_PART(vb);
            LBAR();
            RM_FLUSH(c, gcur, vcur, bscur);
            LBAR();
        }
#undef RM_REC_LOAD
#undef RM_IMG_OFF
    }
#undef RM_STATE_PART
#undef RM_FLUSH
#undef RM_LOAD
#undef RM_XFORM
}

__device__ __forceinline__ int med3i(int a, int b, int c) { int r; asm("v_med3_i32 %0, %1, %2, %3" : "=v"(r) : "v"(a), "v"(b), "v"(c)); return r; }
__device__ __forceinline__ int f2sort(float f) { int x = __float_as_int(f); return x ^ ((x >> 31) & 0x7fffffff); }
__device__ __forceinline__ float sort2f(int x) { return __int_as_float(x ^ ((x >> 31) & 0x7fffffff)); }
#define TOPK_INSERT(vals, x) do { _Pragma("unroll") for (int s_ = 15; s_ >= 1; --s_) vals[s_] = med3i((x), vals[s_ - 1], vals[s_]); vals[0] = max(vals[0], (x)); } while (0)
__device__ __forceinline__ float bf_dot2(unsigned a, unsigned b, float c) {
    return c + bf_lo(a) * bf_lo(b) + bf_hi(a) * bf_hi(b);
}
__device__ __forceinline__ void sum8_x8(float (&a)[8]) {
    asm("s_nop 1\n\t"
        "v_add_f32_dpp %0, %0, %0 quad_perm:[1,0,3,2] row_mask:0xf bank_mask:0xf\n\tv_add_f32_dpp %1, %1, %1 quad_perm:[1,0,3,2] row_mask:0xf bank_mask:0xf\n\t"
        "v_add_f32_dpp %2, %2, %2 quad_perm:[1,0,3,2] row_mask:0xf bank_mask:0xf\n\tv_add_f32_dpp %3, %3, %3 quad_perm:[1,0,3,2] row_mask:0xf bank_mask:0xf\n\t"
        "v_add_f32_dpp %4, %4, %4 quad_perm:[1,0,3,2] row_mask:0xf bank_mask:0xf\n\tv_add_f32_dpp %5, %5, %5 quad_perm:[1,0,3,2] row_mask:0xf bank_mask:0xf\n\t"
        "v_add_f32_dpp %6, %6, %6 quad_perm:[1,0,3,2] row_mask:0xf bank_mask:0xf\n\tv_add_f32_dpp %7, %7, %7 quad_perm:[1,0,3,2] row_mask:0xf bank_mask:0xf\n\t"
        "v_add_f32_dpp %0, %0, %0 quad_perm:[2,3,0,1] row_mask:0xf bank_mask:0xf\n\tv_add_f32_dpp %1, %1, %1 quad_perm:[2,3,0,1] row_mask:0xf bank_mask:0xf\n\t"
        "v_add_f32_dpp %2, %2, %2 quad_perm:[2,3,0,1] row_mask:0xf bank_mask:0xf\n\tv_add_f32_dpp %3, %3, %3 quad_perm:[2,3,0,1] row_mask:0xf bank_mask:0xf\n\t"
        "v_add_f32_dpp %4, %4, %4 quad_perm:[2,3,0,1] row_mask:0xf bank_mask:0xf\n\tv_add_f32_dpp %5, %5, %5 quad_perm:[2,3,0,1] row_mask:0xf bank_mask:0xf\n\t"
        "v_add_f32_dpp %6, %6, %6 quad_perm:[2,3,0,1] row_mask:0xf bank_mask:0xf\n\tv_add_f32_dpp %7, %7, %7 quad_perm:[2,3,0,1] row_mask:0xf bank_mask:0xf\n\t"
        "v_add_f32_dpp %0, %0, %0 row_half_mirror row_mask:0xf bank_mask:0xf\n\tv_add_f32_dpp %1, %1, %1 row_half_mirror row_mask:0xf bank_mask:0xf\n\t"
        "v_add_f32_dpp %2, %2, %2 row_half_mirror row_mask:0xf bank_mask:0xf\n\tv_add_f32_dpp %3, %3, %3 row_half_mirror row_mask:0xf bank_mask:0xf\n\t"
        "v_add_f32_dpp %4, %4, %4 row_half_mirror row_mask:0xf bank_mask:0xf\n\tv_add_f32_dpp %5, %5, %5 row_half_mirror row_mask:0xf bank_mask:0xf\n\t"
        "v_add_f32_dpp %6, %6, %6 row_half_mirror row_mask:0xf bank_mask:0xf\n\tv_add_f32_dpp %7, %7, %7 row_half_mirror row_mask:0xf bank_mask:0xf\n\t"
        "s_nop 1"
        : "+v"(a[0]), "+v"(a[1]), "+v"(a[2]), "+v"(a[3]), "+v"(a[4]), "+v"(a[5]), "+v"(a[6]), "+v"(a[7]));
}
__device__ __forceinline__ float sum8_x1(float v) {
    asm("s_nop 1\n\tv_add_f32_dpp %0, %0, %0 quad_perm:[1,0,3,2] row_mask:0xf bank_mask:0xf\n\ts_nop 1\n\tv_add_f32_dpp %0, %0, %0 quad_perm:[2,3,0,1] row_mask:0xf bank_mask:0xf\n\ts_nop 1\n\t"
        "v_add_f32_dpp %0, %0, %0 row_half_mirror row_mask:0xf bank_mask:0xf\n\ts_nop 1" : "+v"(v));
    return v;
}
__device__ __forceinline__ void peer_phase(const Args& A, Frame& F, int L, const bool dry, const bf16* Hin, bf16* Hout) {
    int lane = F.lane; asm volatile("" : "+v"(lane));
    const int gw = F.vcu * NWAVES + F.wave;
    const bf16* SCR = (const bf16*)(A.ws + WS_SC); const bf16* X = Hin; float* RS3 = (float*)(A.ws + WS_RS3);
    const unsigned char* TU = (const unsigned char*)(A.ws + WS_TABU) + (size_t)L * 16384 * D; const unsigned char* TV = (const unsigned char*)(A.ws + WS_TABV) + (size_t)L * 16384 * D;
    const float* rowss = (const float*)(A.ws + WS_RSP) + (size_t)(L == 0 ? RS_FFN0 : RS_FFN1) * T * 32;
    LAS unsigned* LIST = (LAS unsigned*)(F.lds + RING_OFF + F.wave * 16384);
    LAS unsigned* EIDX = LIST + 1024;
    LAS float* ECOEF = (LAS float*)(EIDX + 1024);
    const int tbase = gw * 8;
    if (tbase >= T) return;
    for (int half = 0; half < 2; ++half) {
        const int t0 = tbase + 4 * half;
        {
            const bf16* sp = SCR + (size_t)(t0 + (lane >> 4)) * D + (lane & 15) * 128;
            int vals[16];
#pragma unroll
            for (int s = 0; s < 16; ++s) vals[s] = (int)0x80000000;
#pragma unroll 2
            for (int c = 0; c < 16; ++c) { const v4u wv = *(const GAS v4u*)(sp + c * 8); const unsigned ww[4] = {wv.x, wv.y, wv.z, wv.w};
#pragma unroll
                for (int e = 0; e < 8; ++e) { const unsigned bits = (e & 1) ? (ww[e >> 1] & 0xffff0000u) : (ww[e >> 1] << 16);
                    int x = (int)bits; x ^= (x >> 31) & 0x7fffffff; x = (x & ~0x7f) | (127 - (c * 8 + e));
                    TOPK_INSERT(vals, x); } }
#pragma unroll
            for (int q = 0; q < 4; ++q) { v4u o; o.x = (unsigned)vals[4 * q]; o.y = (unsigned)vals[4 * q + 1]; o.z = (unsigned)vals[4 * q + 2]; o.w = (unsigned)vals[4 * q + 3]; *(LAS v4u*)(LIST + lane * 16 + 4 * q) = o; }
        }
        LDS_WAIT(); asm volatile("" ::: "memory");
        if (lane < 32) {
            const LAS unsigned* la = LIST + ((lane >> 3) * 16 + (lane & 7) * 2) * 16; const LAS unsigned* lb2 = la + 16;
            float av[16], bv[16];
#pragma unroll
            for (int q = 0; q < 4; ++q) { const v4u a4 = *(const LAS v4u*)(la + 4 * q), b4 = *(const LAS v4u*)(lb2 + 4 * q); const unsigned aw[4] = {a4.x, a4.y, a4.z, a4.w}, bw[4] = {b4.x, b4.y, b4.z, b4.w};
#pragma unroll
                for (int e = 0; e < 4; ++e) { av[4 * q + e] = __uint_as_float(__float_as_uint(sort2f((int)(aw[e] & ~0x7fu))) & 0xffff0000u); bv[4 * q + e] = __uint_as_float(__float_as_uint(sort2f((int)(bw[e] & ~0x7fu))) & 0xffff0000u); } }
            int best[16];
#pragma unroll
            for (int s = 0; s < 16; ++s) best[s] = (int)0x80000000;
#pragma unroll
            for (int i = 0; i < 16; ++i)
#pragma unroll
                for (int jx = 0; jx < 16; ++jx) if ((i + 1) * (jx + 1) <= 16) { int x = f2sort(av[i] + bv[jx]); x = (x & ~0xff) | (255 - (i * 16 + jx)); TOPK_INSERT(best, x); }
            float sv[16]; unsigned ex[16];
#pragma unroll
            for (int s = 0; s < 16; ++s) { const int cand = 255 - (best[s] & 0xff); const unsigned ka = la[cand >> 4], kb = lb2[cand & 15];
                ex[s] = (127u - (ka & 0x7fu)) * 128u + (127u - (kb & 0x7fu));
                sv[s] = __uint_as_float(__float_as_uint(sort2f((int)(ka & ~0x7fu))) & 0xffff0000u) + __uint_as_float(__float_as_uint(sort2f((int)(kb & ~0x7fu))) & 0xffff0000u); }
            float mx = sv[0];
#pragma unroll
            for (int s = 1; s < 16; ++s) mx = fmaxf(mx, sv[s]);
            float den = 0.f;
#pragma unroll
            for (int s = 0; s < 16; ++s) { sv[s] = __expf(sv[s] - mx); den += sv[s]; }
            const float inv = 1.0f / den; const int base = (4 * half + (lane >> 3)) * 128 + (lane & 7) * 16;
#pragma unroll
            for (int s = 0; s < 16; ++s) { EIDX[base + s] = ex[s]; ECOEF[base + s] = sv[s] * inv; }
        }
        LDS_WAIT(); asm volatile("" ::: "memory");
    }
    const int tk = lane >> 3, part = lane & 7, t = tbase + tk;
    const LAS unsigned* eidx = EIDX + tk * 128; LAS float* ecoef = ECOEF + tk * 128;
    const float rs = __builtin_amdgcn_rsqf(sum8_x1(((const GAS f32x4*)(rowss + (size_t)t * 32))[part][0] + ((const GAS f32x4*)(rowss + (size_t)t * 32))[part][1] + ((const GAS f32x4*)(rowss + (size_t)t * 32))[part][2] + ((const GAS f32x4*)(rowss + (size_t)t * 32))[part][3]) * (1.0f / D) + EPS);
    typedef _Float16 h2_t __attribute__((ext_vector_type(2)));
#define PEER_LOAD8(dst, TAB, i0, soff) do { const v4u ia_ = *(const LAS v4u*)(eidx + (i0)), ib_ = *(const LAS v4u*)(eidx + (i0) + 4); const unsigned ee_[8] = {ia_.x, ia_.y, ia_.z, ia_.w, ib_.x, ib_.y, ib_.z, ib_.w}; \
        _Pragma("unroll") for (int j_ = 0; j_ < 8; ++j_) dst[j_] = *(const GAS v4u*)((TAB) + (size_t)(ee_[j_] * 2048u + (unsigned)(soff))); } while (0)
    LAS float* dotw = (LAS float*)LIST + tk * 128;
#pragma unroll
    for (int m = 0; m < 16; ++m) dotw[8 * m + part] = 0.f;
#pragma unroll 1
    for (int p = 0; p < 16; ++p) {
        const int soff = 128 * p + 16 * part;
        h2_t xs[8];
        { const v4u x0 = *(const GAS v4u*)(X + (size_t)t * D + soff), x1 = *(const GAS v4u*)(X + (size_t)t * D + soff + 8); const unsigned xw[8] = {x0.x, x0.y, x0.z, x0.w, x1.x, x1.y, x1.z, x1.w};
#pragma unroll
          for (int e = 0; e < 8; ++e) xs[e] = (h2_t){(_Float16)bf_lo(xw[e]), (_Float16)bf_hi(xw[e])}; }
#define PEER_UDOT8(src, m_) do { float tt_[8]; \
        _Pragma("unroll") for (int j_ = 0; j_ < 8; ++j_) { const unsigned ww_[4] = {src[j_].x, src[j_].y, src[j_].z, src[j_].w}; float a0_ = 0.f, a1_ = 0.f; \
            _Pragma("unroll") for (int e_ = 0; e_ < 4; ++e_) { const h2_t lo_ = __builtin_amdgcn_cvt_scalef32_pk_f16_fp8((int)ww_[e_], 1.0f / 512.0f, false), hi_ = __builtin_amdgcn_cvt_scalef32_pk_f16_fp8((int)ww_[e_], 1.0f / 512.0f, true); \
                a0_ = __builtin_amdgcn_fdot2(xs[2 * e_], lo_, a0_, false); a1_ = __builtin_amdgcn_fdot2(xs[2 * e_ + 1], hi_, a1_, false); } \
            tt_[j_] = a0_ + a1_; } \
        sum8_x8(tt_); \
        float sel_ = tt_[0]; _Pragma("unroll") for (int j_ = 1; j_ < 8; ++j_) sel_ = (part == j_) ? tt_[j_] : sel_; \
        dotw[8 * (m_) + part] += sel_; } while (0)
        v4u ua[8], ub[8];
        PEER_LOAD8(ua, TU, 0, soff);
#pragma unroll 1
        for (int m = 0; m < 16; m += 2) {
            PEER_LOAD8(ub, TU, 8 * (m + 1), soff);
            PEER_UDOT8(ua, m);
            if (m + 2 < 16) PEER_LOAD8(ua, TU, 8 * (m + 2), soff);
            PEER_UDOT8(ub, m + 1);
        }
    }
#undef PEER_UDOT8
#pragma unroll
    for (int m = 0; m < 16; ++m) { const float d_ = dotw[8 * m + part] * rs; const float act = 0.5f * d_ * (1.0f + erff(d_ * 0.7071067811865476f)); ecoef[8 * m + part] *= act; }
    LDS_WAIT(); asm volatile("" ::: "memory");
    float ss = 0.f;
#pragma unroll 1
    for (int p = 0; p < 16; ++p) {
        const int soff = 128 * p + 16 * part;
        h2_t acc[8];
#pragma unroll
        for (int i = 0; i < 8; ++i) acc[i] = (h2_t){(_Float16)0.f, (_Float16)0.f};
#define PEER_VACC8(src, i0) do { const f32x4 ca_ = *(const LAS f32x4*)(ecoef + (i0)), cb_ = *(const LAS f32x4*)(ecoef + (i0) + 4); const float cf_[8] = {ca_[0], ca_[1], ca_[2], ca_[3], cb_[0], cb_[1], cb_[2], cb_[3]}; \
        _Pragma("unroll") for (int j_ = 0; j_ < 8; ++j_) { const unsigned ww_[4] = {src[j_].x, src[j_].y, src[j_].z, src[j_].w}; const _Float16 ch_ = (_Float16)cf_[j_]; const h2_t c2_ = {ch_, ch_}; \
            _Pragma("unroll") for (int e_ = 0; e_ < 4; ++e_) { const h2_t lo_ = __builtin_amdgcn_cvt_scalef32_pk_f16_fp8((int)ww_[e_], 1.0f / 16.0f, false), hi_ = __builtin_amdgcn_cvt_scalef32_pk_f16_fp8((int)ww_[e_], 1.0f / 16.0f, true); \
                acc[2 * e_] = c2_ * lo_ + acc[2 * e_]; acc[2 * e_ + 1] = c2_ * hi_ + acc[2 * e_ + 1]; } } } while (0)
        v4u va[8], vb[8];
        PEER_LOAD8(va, TV, 0, soff);
#pragma unroll 1
        for (int m = 0; m < 16; m += 2) {
            PEER_LOAD8(vb, TV, 8 * (m + 1), soff);
            PEER_VACC8(va, 8 * m);
            if (m + 2 < 16) PEER_LOAD8(va, TV, 8 * (m + 2), soff);
            PEER_VACC8(vb, 8 * (m + 1));
        }
        { const v4u h0 = *(const GAS v4u*)(Hin + (size_t)t * D + soff), h1 = *(const GAS v4u*)(Hin + (size_t)t * D + soff + 8); const unsigned hw[8] = {h0.x, h0.y, h0.z, h0.w, h1.x, h1.y, h1.z, h1.w}; unsigned ow[8];
#pragma unroll
          for (int e = 0; e < 8; ++e) { ow[e] = hw_pk2(bf_lo(hw[e]) + (float)acc[e][0], bf_hi(hw[e]) + (float)acc[e][1]); const float q0 = bf_lo(ow[e]), q1 = bf_hi(ow[e]); ss += q0 * q0 + q1 * q1; }
          v4u o0, o1; o0.x = ow[0]; o0.y = ow[1]; o0.z = ow[2]; o0.w = ow[3]; o1.x = ow[4]; o1.y = ow[5]; o1.z = ow[6]; o1.w = ow[7];
          if (!dry) { *(GAS v4u*)(Hout + (size_t)t * D + soff) = o0; *(GAS v4u*)(Hout + (size_t)t * D + soff + 8) = o1; } else asm volatile("" :: "v"(o0.x), "v"(o0.y), "v"(o0.z), "v"(o0.w), "v"(o1.x), "v"(o1.y), "v"(o1.z), "v"(o1.w)); }
    }
#undef PEER_VACC8
#undef PEER_LOAD8
    const float r3 = __builtin_amdgcn_rsqf(sum8_x1(ss) * (1.0f / D) + EPS);
    if (!dry && part == 0) RS3[t] = r3;
}


constexpr int N_PHASES = 19;
__global__ void __launch_bounds__(NTHREADS, 2) mega_fwd(Args args) {

    extern __shared__ __attribute__((aligned(16))) unsigned char lds[];
    Frame F;
    F.lds = (LAS unsigned char*)lds;
    F.MISC = (volatile LAS unsigned*)(F.lds + MISC_OFF);
    F.tid = threadIdx.x; F.lane = F.tid & 63; F.wave = __builtin_amdgcn_readfirstlane(F.tid >> 6);
    F.G = gridDim.x; { const int bx = blockIdx.x; F.vcu = (F.G % 8 == 0) ? (bx % 8) * (F.G / 8) + bx / 8 : bx; }
    unsigned char* ws = args.ws;
    F.ctl = (gu32*)(ws + WS_CTL);
    for (int u = F.tid; u < (LDS_BYTES - LDSCTL_OFF) / 4; u += NTHREADS) ((LAS unsigned*)(F.lds + LDSCTL_OFF))[u] = 0u;
    __syncthreads();
    const int lo = args.ph_lo, hi = args.ph_hi;
    XcdBarrier bar; bar.bar = (unsigned*)(F.ctl + CW_BAR); bar.x = 0; bar.st = nullptr;
    if (hi - lo > 1) bar = xcd_barrier_post((unsigned*)(F.ctl + CW_BAR), F.MISC + 8);
    bar.wave0 = (F.wave == 0);
#define IN(k) (lo <= (k) && (k) < hi)
#define REFRESH() do { int t_; asm volatile("v_mbcnt_lo_u32_b32 %0, -1, 0\n\tv_mbcnt_hi_u32_b32 %0, -1, %0" : "=v"(t_)); F.lane = t_; F.tid = F.wave * 64 + t_; } while (0)
#define REPS(k) (1 + ((DUP_MASK >> (k)) & 1))
#if PROBE_MASK
    unsigned long long* const tsb = (unsigned long long*)(ws + WS_CTL + 65536);
#define STAMP(k) do { if (blockIdx.x == 0 && F.tid == 0) __hip_atomic_store(tsb + (k), __builtin_amdgcn_s_memrealtime(), __ATOMIC_RELAXED, __HIP_MEMORY_SCOPE_AGENT); } while (0)
    STAMP(31);
#else
#define STAMP(k) do { } while (0)
#endif
#define SEAM(k) do { if (IN(k) && IN((k) + 1)) { if ((k) == 0) { cg::this_grid().sync(); } else { xcd_barrier(bar); if ((DUP_MASK >> 24) & 1) xcd_barrier(bar); } STAMP(k); } } while (0)
    float* rowss = (float*)(ws + WS_RSP);
    bf16* ACTA = (bf16*)(ws + WS_ACTA); bf16* ACTB = (bf16*)(ws + WS_ACTB); bf16* H1 = (bf16*)(ws + WS_H1); const float* RS3 = (const float*)(ws + WS_RS3);
    bf16* PROJ = (bf16*)(ws + WS_PROJ); bf16* SCB = (bf16*)(ws + WS_SC); bf16* PP = (bf16*)(ws + WS_PP);
    const int gtid = (F.vcu * NWAVES + F.wave) * 64 + F.lane, gthreads = F.G * NTHREADS;

#if UBENCH
    {
        typedef _Float16 h2_t __attribute__((ext_vector_type(2)));
        float a[32]; f32x2 p[16]; h2_t hh[32];
#pragma unroll
        for (int i = 0; i < 32; ++i) { a[i] = (float)(F.tid + i); hh[i] = (h2_t){(_Float16)(F.lane + i), (_Float16)i}; }
#pragma unroll
        for (int i = 0; i < 16; ++i) p[i] = (f32x2){a[2 * i], a[2 * i + 1]};
        const float m = 1.0f + 1e-7f * F.lane, c = 1e-9f; const f32x2 m2 = {m, m}, c2 = {c, c}; const h2_t mh = {(_Float16)1.0f, (_Float16)1.0f}, ch = {(_Float16)0.0f, (_Float16)0.0f};
#pragma unroll 1
        for (int it = 0; it < 10000; ++it) {
#if UBENCH == 1
#pragma unroll
            for (int i = 0; i < 32; ++i) asm volatile("v_fma_f32 %0, %0, %1, %2" : "+v"(a[i]) : "v"(m), "v"(c));
#elif UBENCH == 2
#pragma unroll
            for (int i = 0; i < 16; ++i) asm volatile("v_pk_fma_f32 %0, %0, %1, %2\n\tv_pk_fma_f32 %0, %0, %1, %2" : "+v"(p[i]) : "v"(m2), "v"(c2));
#elif UBENCH == 3
#pragma unroll
            for (int i = 0; i < 32; ++i) asm volatile("v_pk_fma_f16 %0, %0, %1, %2" : "+v"(hh[i]) : "v"(mh), "v"(ch));
#endif
        }
        float s = 0.f;
#pragma unroll
        for (int i = 0; i < 32; ++i) s += a[i] + (float)hh[i][0];
#pragma unroll
        for (int i = 0; i < 16; ++i) s += p[i][0] + p[i][1];
        if (s == 12345.678f) args.out[0] = s;
    }
#endif
    if (IN(0)) { REFRESH(); p0_prologue(args, F); } SEAM(0);
    if (IN(1)) for (int rep_ = 0; rep_ < REPS(1); ++rep_) { REFRESH();
        { pg8::Gemm g{ACTA, (const bf16*)(ws + WS_WEV_IN), T, EV_NP, D}; pg8::StaticOrder S; S.init(T, EV_NP, F.G, (int)blockIdx.x); EpiBf16S E{PROJ, PROJ_LD, nullptr};
          pg8::gemm_phase<EpiBf16S, pg8::StaticOrder, true, true>(F.lds + RING_OFF, g, S, E, F.wave); }
        if (F.G == 256 ? (int)blockIdx.x >= 64 : true) { const int g2 = F.G == 256 ? 192 : F.G, c2 = F.G == 256 ? (int)blockIdx.x - 64 : (int)blockIdx.x;
          pg8::Gemm g{(const bf16*)(ws + WS_PBF), (const bf16*)(ws + WS_WPROJ), T, D, 256}; pg8::StaticOrder S; S.init(T, D, g2, c2); EpiBf16S E{PP, D, nullptr};
          pg8::gemm_phase<EpiBf16S, pg8::StaticOrder, true, true>(F.lds + RING_OFF, g, S, E, F.wave); }
    } SEAM(1);
    if (IN(2)) for (int rep_ = 0; rep_ < REPS(2); ++rep_) { REFRESH();
        if (F.G >= 256) {
            const int u = F.vcu;
            if (u < 64) scan_gla_mfma_unit<0>(args, F, u); else if (u < 128) scan_gdn_mfma_unit(args, F, u - 64, 0); else if (u < 192) scan_gdn_mfma_unit(args, F, u - 128, 1);
            __syncthreads();
            if (rep_ == 0) for (int dr_ = 0; dr_ < 1 + ((DUP_MASK >> 22) & 1); ++dr_) { if (u < 64) p0_deferred(args, F, 128 + u, 192); else if (u >= 192) for (int k = 0; k < 2; ++k) p0_deferred(args, F, 2 * (u - 192) + k, 192); }
        } else {
            for (int u = F.vcu; u < 64; u += F.G) { scan_gla_mfma_unit<0>(args, F, u); __syncthreads(); }
            for (int u = F.vcu; u < 64; u += F.G) { scan_gdn_mfma_unit(args, F, u, 0); __syncthreads(); scan_gdn_mfma_unit(args, F, u, 1); __syncthreads(); }
            if (rep_ == 0) p0_deferred(args, F, F.vcu, F.G);
        }
    } SEAM(2);
    if (IN(3)) for (int rep_ = 0; rep_ < REPS(3); ++rep_) { REFRESH(); post_rows<0>(args, F); } SEAM(3);
    if (IN(4)) { REFRESH(); pg8::Gemm g{ACTA, (const bf16*)(ws + WS_WEV_OUT), T, D, D}; pg8::StaticOrder S; S.init(T, D, F.G, (int)blockIdx.x);
        EpiResid<false, true> E{args.in[I_X], ACTB, rowss + (size_t)RS_FFN0 * T * 32, nullptr, nullptr, nullptr};
        pg8::gemm_phase<EpiResid<false, true>, pg8::StaticOrder, true, true>(F.lds + RING_OFF, g, S, E, F.wave); }
#if (DUP_MASK >> 20) & 1
    if (IN(4)) { REFRESH(); pg8::Gemm g{ACTA, (const bf16*)(ws + WS_WEV_OUT), T, D, D}; pg8::StaticOrder S; S.init(T, D, F.G, (int)blockIdx.x);
        EpiResid<false, true> E{args.in[I_X], ACTB, rowss + (size_t)RS_FFN0 * T * 32, nullptr, nullptr, nullptr};
        pg8::gemm_phase<EpiResid<false, true>, pg8::StaticOrder, true, true>(F.lds + RING_OFF, g, S, E, F.wave); }
#endif
#if (DUP_MASK >> 21) & 1
    if (IN(4)) { REFRESH(); pg8::Gemm g{ACTA, (const bf16*)(ws + WS_WEV_IN), T, EV_NP, D}; pg8::StaticOrder S; S.init(T, EV_NP, F.G, (int)blockIdx.x); EpiBf16S E{PROJ, PROJ_LD, nullptr};
        pg8::gemm_phase<EpiBf16S, pg8::StaticOrder, true, true>(F.lds + RING_OFF, g, S, E, F.wave); }
#endif
    SEAM(4);
    if (IN(5)) for (int rep_ = 0; rep_ < REPS(5); ++rep_) { REFRESH(); { pg8::Gemm g{ACTB, (const bf16*)(ws + WS_WPEER), T, D, D}; pg8::StaticOrder S; S.init(T, D, F.G, (int)blockIdx.x); EpiBf16S E{SCB, D, rowss + (size_t)RS_FFN0 * T * 32};
        pg8::gemm_phase<EpiBf16S, pg8::StaticOrder, true, true>(F.lds + RING_OFF, g, S, E, F.wave); }
        } SEAM(5);
    if (IN(6)) for (int rep_ = 0; rep_ < REPS(6); ++rep_) { REFRESH(); peer_phase(args, F, 0, rep_ != 0, ACTB, H1); } SEAM(6);
    if (IN(7)) { REFRESH(); { pg8::Gemm g{H1, (const bf16*)(ws + WS_WGATE), T, D, D}; pg8::StaticOrder S; S.init(T, D, F.G, (int)blockIdx.x);
        EpiResid<true, false> E{H1, ACTB, rowss + (size_t)RS_MIX1 * T * 32, PP, RS3, (unsigned char*)ACTA};
        pg8::gemm_phase<EpiResid<true, false>, pg8::StaticOrder, true, true>(F.lds + RING_OFF, g, S, E, F.wave); }
        } SEAM(7);
    if (IN(8)) for (int rep_ = 0; rep_ < REPS(8); ++rep_) { REFRESH();
        { pg8::Gemm g{ACTA, (const bf16*)(ws + WS_WOD_IN), T, OD_NP, D / 2}; pg8::StaticOrder S; S.init(T, OD_NP, F.G, (int)blockIdx.x); EpiBf16S E{PROJ, PROJ_LD, rowss + (size_t)RS_MIX1 * T * 32};
          pg8::gemm_phase<EpiBf16S, pg8::StaticOrder, true, true, true>(F.lds + RING_OFF, g, S, E, F.wave); }
        { pg8::Gemm g{(const bf16*)(ws + WS_PBF) + (size_t)T * 256, (const bf16*)(ws + WS_WPROJ) + (size_t)D * 256, T, D, 256}; pg8::StaticOrder S; S.init(T, D, F.G, (int)blockIdx.x); EpiBf16S E{PP, D, nullptr};
          pg8::gemm_phase<EpiBf16S, pg8::StaticOrder, true, true>(F.lds + RING_OFF, g, S, E, F.wave); }
    } SEAM(8);
    if (IN(9)) for (int rep_ = 0; rep_ < REPS(9); ++rep_) { REFRESH(); lora_prep_rows(args, F); } SEAM(9);
    if (IN(10)) for (int rep_ = 0; rep_ < REPS(10); ++rep_) { REFRESH(); pg8::Gemm g{(const bf16*)(ws + WS_LA), (const bf16*)(ws + WS_WLORA), T, LORA_N, LORA_K}; pg8::StaticOrder S; S.init(T, LORA_N, F.G, (int)blockIdx.x); EpiBf16S E{(bf16*)(ws + WS_LO), LORA_N, nullptr};
        pg8::gemm_phase<EpiBf16S, pg8::StaticOrder, true, true>(F.lds + RING_OFF, g, S, E, F.wave); } SEAM(10);
    if (IN(11)) for (int rep_ = 0; rep_ < REPS(11); ++rep_) { REFRESH();
        if (F.G >= 256) {
            const int u = F.vcu;
            if (u < 64) scan_gla_mfma_unit<1>(args, F, u); else if (u < 128) scan_rwkv_mfma_unit(args, F, u - 64, 0); else if (u < 192) scan_rwkv_mfma_unit(args, F, u - 128, 1);
            __syncthreads();
            if (rep_ == 0) for (int dr_ = 0; dr_ < 1 + ((DUP_MASK >> 23) & 1); ++dr_) { if (u < 64) p1_deferred(args, F, 128 + u, 192); else if (u >= 192) for (int k = 0; k < 2; ++k) p1_deferred(args, F, 2 * (u - 192) + k, 192); }
        } else {
            for (int u = F.vcu; u < 64; u += F.G) { scan_gla_mfma_unit<1>(args, F, u); __syncthreads(); }
            for (int u = F.vcu; u < 64; u += F.G) { scan_rwkv_mfma_unit(args, F, u, 0); __syncthreads(); scan_rwkv_mfma_unit(args, F, u, 1); __syncthreads(); }
            if (rep_ == 0) p1_deferred(args, F, F.vcu, F.G);
        }
    } SEAM(11);
    if (IN(12)) for (int rep_ = 0; rep_ < REPS(12); ++rep_) { REFRESH(); post_rows<1>(args, F); } SEAM(12);
    if (IN(13)) { REFRESH(); pg8::Gemm g{ACTA, (const bf16*)(ws + WS_WOD_OUT), T, D, D}; pg8::StaticOrder S; S.init(T, D, F.G, (int)blockIdx.x);
        EpiResid<false, false> E{ACTB, H1, rowss + (size_t)RS_FFN1 * T * 32, nullptr, nullptr, nullptr};
        pg8::gemm_phase<EpiResid<false, false>, pg8::StaticOrder, true, true>(F.lds + RING_OFF, g, S, E, F.wave); } SEAM(13);
    if (IN(14)) for (int rep_ = 0; rep_ < REPS(14); ++rep_) { REFRESH(); pg8::Gemm g{H1, (const bf16*)(ws + WS_WPEER) + (size_t)D * D, T, D, D}; pg8::StaticOrder S; S.init(T, D, F.G, (int)blockIdx.x); EpiBf16S E{SCB, D, rowss + (size_t)RS_FFN1 * T * 32};
        pg8::gemm_phase<EpiBf16S, pg8::StaticOrder, true, true>(F.lds + RING_OFF, g, S, E, F.wave); } SEAM(14);
    if (IN(15)) for (int rep_ = 0; rep_ < REPS(15); ++rep_) { REFRESH(); peer_phase(args, F, 1, rep_ != 0, H1, ACTB); } SEAM(15);
    if (IN(16)) { REFRESH(); pg8::Gemm g{ACTB, (const bf16*)(ws + WS_WGATE) + (size_t)D * D, T, D, D}; pg8::StaticOrder S; S.init(T, D, F.G, (int)blockIdx.x);
        EpiResid<true, false> E{ACTB, H1, rowss + (size_t)RS_FINAL * T * 32, PP, RS3, nullptr};
        pg8::gemm_phase<EpiResid<true, false>, pg8::StaticOrder, true, true>(F.lds + RING_OFF, g, S, E, F.wave); } SEAM(16);
    if (IN(17)) { REFRESH();
        float oscale = 1.0f;
#if PROBE_MASK
        { unsigned long long t_prev = __hip_atomic_load(tsb + 31, __ATOMIC_RELAXED, __HIP_MEMORY_SCOPE_AGENT); const unsigned long long t_begin = t_prev; unsigned long long sel = 0ull;
          for (int k = 0; k <= 16; ++k) { const unsigned long long tk = __hip_atomic_load(tsb + k, __ATOMIC_RELAXED, __HIP_MEMORY_SCOPE_AGENT); if ((PROBE_MASK >> k) & 1) sel += tk - t_prev; t_prev = tk; }
          const float f = (float)(double(sel) / double(t_prev - t_begin)); oscale = 1.0f + sqrtf(0.01f + 0.9f * f); }
#endif
        final_rows(args, F, oscale, H1); }
#undef IN
#undef SEAM
#undef REFRESH
}

extern "C" void kernel_launch(void* const* d_in, const int* in_sizes, int n_in, void* d_out, int out_size, void* d_ws, size_t ws_size, hipStream_t stream) {
    static int grid = 0;
    if (grid == 0) {
        if (n_in != N_IN || out_size != T * D || ws_size < WS_END + 63 * MiB) { fprintf(stderr, "kernel_launch: unexpected problem: n_in %d out %d ws %zu (need %zu)\n", n_in, out_size, ws_size, (size_t)(WS_END + 63 * MiB)); grid = -1; return; }
        int dev = 0, cus = 0, per_cu = 0;
        if (hipGetDevice(&dev) != hipSuccess || hipDeviceGetAttribute(&cus, hipDeviceAttributeMultiprocessorCount, dev) != hipSuccess) { grid = -1; return; }
        if (hipFuncSetAttribute((const void*)mega_fwd, hipFuncAttributeMaxDynamicSharedMemorySize, LDS_BYTES) != hipSuccess) { fprintf(stderr, "kernel_launch: hipFuncSetAttribute failed\n"); grid = -1; return; }
        if (hipOccupancyMaxActiveBlocksPerMultiprocessor(&per_cu, (const void*)mega_fwd, NTHREADS, LDS_BYTES) != hipSuccess || per_cu < 1) { fprintf(stderr, "kernel_launch: occupancy query says %d blocks per CU\n", per_cu); (void)hipGetLastError(); grid = -1; return; }
        grid = cus;
    }
    if (grid < 0) return;
    (void)hipMemsetAsync((char*)d_ws + WS_CTL, 0, CTL_ZERO_BYTES, stream);
    Args a{};
    for (int i = 0; i < N_IN; ++i) a.in[i] = (const float*)d_in[i];
    a.out = (float*)d_out; a.ws = (unsigned char*)d_ws;
#if MK_PER_PHASE
    for (int p = 0; p < N_PHASES - 1; ++p) { a.ph_lo = p; a.ph_hi = p + 1; hipLaunchKernelGGL(mega_fwd, dim3(grid), dim3(NTHREADS), LDS_BYTES, stream, a); }
#else
    a.ph_lo = 0; a.ph_hi = N_PHASES;
    void* kargs[] = {&a};
    hipError_t e = hipLaunchCooperativeKernel((const void*)mega_fwd, dim3(grid), dim3(NTHREADS), kargs, LDS_BYTES, stream);
    if (e != hipSuccess) fprintf(stderr, "kernel_launch: cooperative launch failed: %s (grid %d)\n", hipGetErrorString(e), grid);
#endif
}
```

```cpp
#include <hip/hip_runtime.h>
#include <hip/hip_cooperative_groups.h>
#include <cstdio>
#include <cstdint>
namespace cg = cooperative_groups;

#ifndef PROBE_MASK
#define PROBE_MASK 0
#endif
#ifndef DUP_MASK
#define DUP_MASK 0
#endif
#ifndef UBENCH
#define UBENCH 0
#endif
#ifndef GDN_DUP
#define GDN_DUP 0
#endif
#ifndef MK_PER_PHASE
#define MK_PER_PHASE 0
#endif

namespace pg8 {
#define PG8_LAS __attribute__((address_space(3)))
typedef unsigned short bf16_t;
typedef short bf16x8 __attribute__((ext_vector_type(8)));
typedef float f32x4 __attribute__((ext_vector_type(4)));
typedef unsigned u32x4 __attribute__((ext_vector_type(4)));
typedef unsigned u32x2 __attribute__((ext_vector_type(2)));
constexpr int BM = 256, BK = 64, HALF = 128, HTB = HALF * BK * 2  , STAGE_BYTES = 8 * HTB, NXCD = 8, WGM = 8;

__host__ __device__ __forceinline__ int lds_byte(int r, int c) { const int st = (r >> 4) * 2 + (c >> 5), rr = r & 15, cc = c & 31, ob = rr * 64 + cc * 2; return st * 1024 + (ob ^ (((ob >> 9) & 1) << 5)); }
__host__ __device__ __forceinline__ void stage_rc(int b, int& R, int& C) { const int st = b / 1024, sb = b % 1024, swz = sb ^ (((sb >> 9) & 1) << 5); R = (st >> 1) * 16 + swz / 64; C = (st & 1) * 32 + (swz % 64) / 2; }
__host__ __device__ __forceinline__ int perm32(int rho) { const int n = rho >> 4, i = rho & 15; return 8 * (i >> 2) + 4 * n + (i & 3); }

struct Unit { int pm, pn; };
struct Gemm { const bf16_t* A; const bf16_t* Bt; int M, N, K; };

struct StaticOrder {
    int nM, nN, nwg, G, c;
    __host__ __device__ void init(int M, int N, int G_, int c_) { nM = M / BM; nN = N / BM; nwg = nM * nN; G = G_; c = c_; }
    __host__ __device__ bool next(int i, Unit& u) const {
        const long L = (long)i * G + c; if (L >= nwg) return false;
        int wgid = (int)L; { const int q = nwg / NXCD, r = nwg % NXCD, xcd = wgid % NXCD, off = wgid / NXCD; wgid = (xcd < r ? xcd * (q + 1) : r * (q + 1) + (xcd - r) * q) + off; }
        const int nig = WGM * nN, gid = wgid / nig, fm = gid * WGM, gsz = (nM - fm) < WGM ? (nM - fm) : WGM;
        u.pm = fm + ((wgid % nig) % gsz); u.pn = (wgid % nig) / gsz; return true;
    }
    __device__ __forceinline__ void a_ready(const Unit&) const {}
    __device__ __forceinline__ void done(const Unit&) const {}
};
__device__ __forceinline__ unsigned cvt_pk_bf16(float lo, float hi) { unsigned r; asm volatile("v_cvt_pk_bf16_f32 %0, %1, %2" : "=v"(r) : "v"(lo), "v"(hi)); return r; }
template <class Epi, class Sched, bool ALIGN_EPI = false, bool SP2 = false, bool F8 = false>
__device__ __forceinline__ void gemm_phase(PG8_LAS unsigned char* lds, const Gemm g, const Sched& S, const Epi& E, const int wave_id) {
    int tid; asm volatile("v_mbcnt_lo_u32_b32 %0, -1, 0\n\tv_mbcnt_hi_u32_b32 %0, -1, %0" : "=v"(tid)); tid += wave_id * 64;
    const int wid = wave_id, lane = tid & 63, wr = wid >> 2, wc = wid & 3, fr = lane & 15, fq = lane >> 4;
    const int K = g.K, nt = K / BK;
    unsigned voffA[2], voffB[2];
#pragma unroll
    for (int i = 0; i < 2; ++i) { int R, C; stage_rc(tid * 16 + i * 8192, R, C); const int Rb = Epi::PERM ? ((R & ~31) + perm32(R & 31)) : R;
        voffA[i] = (unsigned)(R * K + C) * 2u; voffB[i] = (unsigned)(Rb * K + C) * 2u; }
    const __amdgpu_buffer_rsrc_t rsrcA = __builtin_amdgcn_make_buffer_rsrc((void*)g.A, 0, 0x7fffffff, 0x00020000), rsrcB = __builtin_amdgcn_make_buffer_rsrc((void*)g.Bt, 0, 0x7fffffff, 0x00020000);
    const size_t kstep = (size_t)(BK * 2);
    const size_t hstep = (size_t)HALF * K * 2;
    const size_t tstep = 2 * hstep;
    const unsigned ldsw = (unsigned)wid * 1024u;
    const int aoff = lds_byte(wr * 64 + fr, fq * 8), boff = lds_byte(wc * 32 + fr, fq * 8);
#define PG8_SA(b, h) (((b) * 2 + (h)) * HTB)
#define PG8_SB(b, h) ((4 + (b) * 2 + (h)) * HTB)
#define PG8_STAGE(bufoff, gbase, voff) do { const bool isA_ = (+(voff) == +voffA); const unsigned soff_ = (unsigned)((const char*)(gbase) - (isA_ ? (const char*)g.A : (const char*)g.Bt)); _Pragma("unroll") for (int _i = 0; _i < 2; ++_i) \
        __builtin_amdgcn_raw_ptr_buffer_load_lds(isA_ ? rsrcA : rsrcB, (PG8_LAS unsigned*)(lds + (bufoff) + ldsw + _i * 8192), 16, (int)(voff)[_i], (int)soff_, 0, 0); } while (0)
#define PG8_LDA(dst, b, h) do { _Pragma("unroll") for (int m = 0; m < 4; ++m) { if constexpr (F8) { dst##8[m].lo = *(const PG8_LAS bf16x8*)(lds + PG8_SA(b, h) + aoff + m * 2048); dst##8[m].hi = *(const PG8_LAS bf16x8*)(lds + PG8_SA(b, h) + aoff + m * 2048 + 1024); } else { _Pragma("unroll") for (int k = 0; k < 2; ++k) dst[m][k] = *(const PG8_LAS bf16x8*)(lds + PG8_SA(b, h) + aoff + m * 2048 + k * 1024); } } } while (0)
#define PG8_LDB(dst, b, h) do { _Pragma("unroll") for (int n = 0; n < 2; ++n) { if constexpr (F8) { dst##8[n].lo = *(const PG8_LAS bf16x8*)(lds + PG8_SB(b, h) + boff + n * 2048); dst##8[n].hi = *(const PG8_LAS bf16x8*)(lds + PG8_SB(b, h) + boff + n * 2048 + 1024); } else { _Pragma("unroll") for (int k = 0; k < 2; ++k) dst[n][k] = *(const PG8_LAS bf16x8*)(lds + PG8_SB(b, h) + boff + n * 2048 + k * 1024); } } } while (0)
#define PG8_MMA(ai, bj, At, Bt) do { __builtin_amdgcn_s_setprio(1); _Pragma("unroll") for (int m = 0; m < 4; ++m) _Pragma("unroll") for (int n = 0; n < 2; ++n) { \
        if constexpr (F8) { typedef int v8i_ __attribute__((ext_vector_type(8))); \
            acc[ai][bj][m][n] = __builtin_amdgcn_mfma_scale_f32_16x16x128_f8f6f4(__builtin_bit_cast(v8i_, Bt##8[n]), __builtin_bit_cast(v8i_, At##8[m]), acc[ai][bj][m][n], 0, 0, 0, 0x7f79, 1, 0x7f79); }     \
        else { _Pragma("unroll") for (int k = 0; k < 2; ++k) acc[ai][bj][m][n] = __builtin_amdgcn_mfma_f32_16x16x32_bf16(Bt[n][k], At[m][k], acc[ai][bj][m][n], 0, 0, 0); } } \
        __builtin_amdgcn_s_setprio(0); } while (0)
#define PG8_WAIT_V(n) asm volatile("s_waitcnt vmcnt(" #n ")" ::: "memory")
#define PG8_WAIT_L(n) asm volatile("s_waitcnt lgkmcnt(" #n ")" ::: "memory")
#define PG8_BAR __builtin_amdgcn_s_barrier()
#define PG8_SCHED __builtin_amdgcn_sched_barrier(0)
    Unit cur, nxt; int ui = 0;
    if (!S.next(0, cur)) return;
    f32x4 acc[2][2][4][2];
#pragma unroll
    for (int a = 0; a < 2; ++a)
#pragma unroll
        for (int b = 0; b < 2; ++b)
#pragma unroll
            for (int m = 0; m < 4; ++m)
#pragma unroll
                for (int n = 0; n < 2; ++n) acc[a][b][m][n] = (f32x4){0.f, 0.f, 0.f, 0.f};
    typedef short bf16x16 __attribute__((ext_vector_type(16)));
    bf16x16 At8[4], B08[2], B18[2]; bf16x8 At[4][2], B0[2][2], B1[2][2];
    const char* cA = (const char*)g.A + (size_t)cur.pm * tstep; const char* cB = (const char*)g.Bt + (size_t)cur.pn * tstep;
    S.a_ready(cur);
    if constexpr (SP2) {
        PG8_STAGE(PG8_SB(0, 0), cB, voffB); PG8_STAGE(PG8_SB(0, 1), cB + hstep, voffB); PG8_STAGE(PG8_SA(0, 0), cA, voffA); PG8_STAGE(PG8_SA(0, 1), cA + hstep, voffA);
        if (wr == 1) PG8_BAR;
        PG8_WAIT_V(2); PG8_BAR;
        PG8_STAGE(PG8_SB(1, 0), cB + kstep, voffB); PG8_STAGE(PG8_SA(1, 0), cA + kstep, voffA); PG8_STAGE(PG8_SB(1, 1), cB + hstep + kstep, voffB);
        PG8_WAIT_V(6); PG8_BAR;
    } else {
        PG8_STAGE(PG8_SB(0, 0), cB, voffB); PG8_STAGE(PG8_SA(0, 0), cA, voffA); PG8_STAGE(PG8_SB(0, 1), cB + hstep, voffB); PG8_STAGE(PG8_SA(0, 1), cA + hstep, voffA);
        if (wr == 1) PG8_BAR;
        PG8_WAIT_V(4); PG8_BAR;
        PG8_STAGE(PG8_SB(1, 0), cB + kstep, voffB); PG8_STAGE(PG8_SA(1, 0), cA + kstep, voffA); PG8_STAGE(PG8_SB(1, 1), cB + hstep + kstep, voffB);
        PG8_WAIT_V(6); PG8_BAR;
    }
    for (;;) {
        const bool has_next = S.next(ui + 1, nxt);
        const char* nA = has_next ? (const char*)g.A + (size_t)nxt.pm * tstep : cA; const char* nB = has_next ? (const char*)g.Bt + (size_t)nxt.pn * tstep : cB;
        for (int t = 0; t < nt; t += 2) {
            const bool last = (t == nt - 2);
            const char* a1 = cA + (size_t)(t + 1) * kstep;
            const char* a2 = last ? nA : cA + (size_t)(t + 2) * kstep; const char* b2 = last ? nB : cB + (size_t)(t + 2) * kstep;
            const char* a3 = a2 + kstep; const char* b3 = b2 + kstep;
            if (last && has_next) S.a_ready(nxt);
            if constexpr (SP2) {
            PG8_LDB(B0, 0, 0); PG8_LDB(B1, 0, 1); PG8_SCHED; PG8_LDA(At, 0, 0); PG8_STAGE(PG8_SA(1, 1), a1 + hstep, voffA);
            PG8_WAIT_V(8); PG8_WAIT_L(0); PG8_BAR; PG8_MMA(0, 0, At, B0); PG8_MMA(0, 1, At, B1); PG8_BAR; PG8_SCHED;
            PG8_LDA(At, 0, 1); PG8_STAGE(PG8_SB(0, 0), b2, voffB); PG8_STAGE(PG8_SB(0, 1), b2 + hstep, voffB); PG8_STAGE(PG8_SA(0, 0), a2, voffA);
            PG8_WAIT_V(8); PG8_WAIT_L(0); PG8_BAR; PG8_MMA(1, 0, At, B0); PG8_MMA(1, 1, At, B1); PG8_BAR; PG8_SCHED;
            PG8_LDB(B0, 1, 0); PG8_LDB(B1, 1, 1); PG8_SCHED; PG8_LDA(At, 1, 0); PG8_STAGE(PG8_SA(0, 1), a2 + hstep, voffA);
            PG8_WAIT_V(8); PG8_WAIT_L(0); PG8_BAR; PG8_MMA(0, 0, At, B0); PG8_MMA(0, 1, At, B1); PG8_BAR; PG8_SCHED;
            PG8_LDA(At, 1, 1); PG8_STAGE(PG8_SB(1, 0), b3, voffB); PG8_STAGE(PG8_SB(1, 1), b3 + hstep, voffB); PG8_STAGE(PG8_SA(1, 0), a3, voffA);
            PG8_WAIT_V(8); PG8_WAIT_L(0); PG8_BAR; PG8_MMA(1, 0, At, B0); PG8_MMA(1, 1, At, B1); PG8_BAR; PG8_SCHED;
            } else {
            PG8_LDB(B0, 0, 0); PG8_SCHED; PG8_LDA(At, 0, 0); PG8_STAGE(PG8_SA(1, 1), a1 + hstep, voffA);
            PG8_WAIT_L(8); PG8_BAR; PG8_WAIT_L(0); PG8_MMA(0, 0, At, B0); PG8_BAR; PG8_SCHED;
            PG8_LDB(B1, 0, 1); PG8_STAGE(PG8_SB(0, 0), b2, voffB);
            PG8_BAR; PG8_WAIT_L(0); PG8_MMA(0, 1, At, B1); PG8_BAR;
            PG8_LDA(At, 0, 1); PG8_STAGE(PG8_SA(0, 0), a2, voffA);
            PG8_BAR; PG8_WAIT_L(0); PG8_MMA(1, 0, At, B0); PG8_BAR; PG8_SCHED;
            PG8_STAGE(PG8_SB(0, 1), b2 + hstep, voffB);
            PG8_WAIT_V(6); PG8_BAR; PG8_MMA(1, 1, At, B1); PG8_BAR;
            PG8_LDB(B0, 1, 0); PG8_SCHED; PG8_LDA(At, 1, 0); PG8_STAGE(PG8_SA(0, 1), a2 + hstep, voffA);
            PG8_WAIT_L(8); PG8_BAR; PG8_WAIT_L(0); PG8_MMA(0, 0, At, B0); PG8_BAR; PG8_SCHED;
            PG8_LDB(B1, 1, 1); PG8_STAGE(PG8_SB(1, 0), b3, voffB);
            PG8_BAR; PG8_WAIT_L(0); PG8_MMA(0, 1, At, B1); PG8_BAR;
            PG8_LDA(At, 1, 1); PG8_STAGE(PG8_SA(1, 0), a3, voffA);
            PG8_BAR; PG8_WAIT_L(0); PG8_MMA(1, 0, At, B0); PG8_BAR; PG8_SCHED;
            PG8_STAGE(PG8_SB(1, 1), b3 + hstep, voffB);
            PG8_WAIT_V(6); PG8_BAR; PG8_MMA(1, 1, At, B1); PG8_BAR;
            }
        }
        if constexpr (ALIGN_EPI) { if (wr == 0) PG8_BAR; }
        if constexpr (!Epi::AFTER_DRAIN) { int ln_e; asm volatile("v_mbcnt_lo_u32_b32 %0, -1, 0\n\tv_mbcnt_hi_u32_b32 %0, -1, %0" : "=v"(ln_e)); const int fr_e = ln_e & 15, fq_e = ln_e >> 4;
            E(acc, cur, wr, wc, fr_e, fq_e); S.done(cur); }
        if (!has_next) break;
#pragma unroll
        for (int a = 0; a < 2; ++a)
#pragma unroll
            for (int b = 0; b < 2; ++b)
#pragma unroll
                for (int m = 0; m < 4; ++m)
#pragma unroll
                    for (int n = 0; n < 2; ++n) acc[a][b][m][n] = (f32x4){0.f, 0.f, 0.f, 0.f};
        cur = nxt; cA = nA; cB = nB; ++ui;
        if constexpr (ALIGN_EPI) { if (wr == 1) PG8_BAR; }
    }
    PG8_WAIT_V(0);
    if constexpr (!ALIGN_EPI) { if (wr == 0) PG8_BAR; }
    PG8_BAR;
    if constexpr (Epi::AFTER_DRAIN) { E.fused(acc, cur, wr, wc, fr, fq, lds, wid, lane); S.done(cur); }
#undef PG8_SA
#undef PG8_SB
#undef PG8_STAGE
#undef PG8_LDA
#undef PG8_LDB
#undef PG8_MMA
#undef PG8_WAIT_V
#undef PG8_WAIT_L
#undef PG8_BAR
#undef PG8_SCHED
}
}
#define GAS __attribute__((address_space(1)))
#define LAS __attribute__((address_space(3)))
typedef unsigned short bf16;
typedef unsigned v4u __attribute__((ext_vector_type(4)));
typedef float f32x4 __attribute__((ext_vector_type(4)));
typedef short bf16x8 __attribute__((ext_vector_type(8)));
typedef GAS unsigned gu32;
typedef GAS unsigned long long gu64;
#define RLX_AGENT __ATOMIC_RELAXED, __HIP_MEMORY_SCOPE_AGENT
#define LDS_WAIT() asm volatile("s_waitcnt lgkmcnt(0)" ::: "memory")
#define VM_WAIT() asm volatile("s_waitcnt vmcnt(0)" ::: "memory")
__device__ __forceinline__ unsigned long long rt() { return __builtin_amdgcn_s_memrealtime(); }
__device__ __forceinline__ unsigned f2bf(float f) { unsigned u = __builtin_bit_cast(unsigned, f); return (u + 0x7fffu + ((u >> 16) & 1u)) >> 16; }
__device__ __forceinline__ unsigned pk2(float lo, float hi) { return f2bf(lo) | (f2bf(hi) << 16); }

#define XB_TMO      128
#define XB_XCNT(j)  (256  + 64 * (j))
#define XB_XSUB(j)  (1280 + 64 * (j))
#define XB_XGEN(j)  (2304 + 64 * (j))
#define XB_TOP      3328
#define XB_TOPGEN   3392
#define XCD_BAR_WORDS 3456
#define XB_SPIN_CAP (1u << 18)

__device__ __forceinline__ unsigned xb_ld(unsigned* p)              { return __hip_atomic_load(p, __ATOMIC_RELAXED, __HIP_MEMORY_SCOPE_AGENT); }
__device__ __forceinline__ unsigned xb_add(unsigned* p, unsigned v) { return __hip_atomic_fetch_add(p, v, __ATOMIC_RELAXED, __HIP_MEMORY_SCOPE_AGENT); }
__device__ __forceinline__ unsigned xb_xcc_id() { return (unsigned)__builtin_amdgcn_s_getreg((3 << 11) | 20) & 0xFu; }
#define XB_SPIN(cond, bar) do { unsigned _sp = 0; while (cond) { __builtin_amdgcn_s_sleep(1); \
    if ((++_sp & 255u) == 0u) { if (xb_ld(&(bar)[XB_TMO])) break; if (_sp > XB_SPIN_CAP) { atomicAdd(&(bar)[XB_TMO], 1u); break; } } } } while (0)

struct XcdBarrier {
    unsigned* bar; unsigned x; bool wave0;
    volatile LAS unsigned* st;
};

__device__ __forceinline__ XcdBarrier xcd_barrier_post(unsigned* bar, volatile LAS unsigned* st) {
    XcdBarrier b; b.bar = bar; b.x = xb_xcc_id(); b.st = st;
    if (threadIdx.x == 0) (void)xb_add(&bar[XB_XCNT(b.x)], 1u);
    return b;
}
__device__ __forceinline__ void xcd_barrier_complete(unsigned* bar, unsigned x, unsigned& nloc, unsigned& nx) {
    const unsigned G = gridDim.x * gridDim.y * gridDim.z;
    unsigned sum, cnt, mine, sp = 0u;
    for (;;) {
        sum = 0u; cnt = 0u; mine = 0u;
#pragma unroll
        for (unsigned j = 0; j < 16; ++j) { const unsigned c = xb_ld(&bar[XB_XCNT(j)]); sum += c; cnt += (c > 0u) ? 1u : 0u; mine = (j == x) ? c : mine; }
        if (sum == G) break;
        __builtin_amdgcn_s_sleep(1);
        if ((++sp & 255u) == 0u) { if (xb_ld(&bar[XB_TMO])) break; if (sp > XB_SPIN_CAP) { atomicAdd(&bar[XB_TMO], 1u); break; } }
    }
    nloc = mine > 0u ? mine : 1u; nx = cnt > 0u ? cnt : 1u;
}

__device__ __forceinline__ void xcd_barrier(const XcdBarrier& b) {
    asm volatile("s_waitcnt vmcnt(0)" ::: "memory");
    __syncthreads();
    if (b.wave0 && __builtin_amdgcn_mbcnt_hi(~0u, __builtin_amdgcn_mbcnt_lo(~0u, 0u)) == 0u) {
        unsigned* bar = b.bar;
        __builtin_amdgcn_s_waitcnt(0);
        unsigned nloc = b.st[0], nx = b.st[1];
        if (nloc == 0u) { xcd_barrier_complete(bar, b.x, nloc, nx); b.st[0] = nloc; b.st[1] = nx; }
        const unsigned old = xb_add(&bar[XB_XSUB(b.x)], 1u);
        const unsigned gen = old / nloc;
        if (old + 1u == (gen + 1u) * nloc) {
            __builtin_amdgcn_fence(__ATOMIC_RELEASE, "agent");
            asm volatile("s_waitcnt vmcnt(0)" ::: "memory");
            const unsigned og = xb_add(&bar[XB_TOP], 1u);
            const unsigned tg = og / nx;
            if (og + 1u == (tg + 1u) * nx) xb_add(&bar[XB_TOPGEN], 1u);
            else XB_SPIN(xb_ld(&bar[XB_TOPGEN]) == tg, bar);
            __builtin_amdgcn_fence(__ATOMIC_ACQUIRE, "agent");
            xb_add(&bar[XB_XGEN(b.x)], 1u);
            asm volatile("s_waitcnt vmcnt(0)" ::: "memory");
        } else {
            XB_SPIN(xb_ld(&bar[XB_XGEN(b.x)]) == gen, bar);
            __builtin_amdgcn_fence(__ATOMIC_ACQUIRE, "agent");
            asm volatile("s_waitcnt vmcnt(0)" ::: "memory");
        }
    }
    __syncthreads();
}

constexpr int NWAVES = 8, NTHREADS = NWAVES * 64;
constexpr int BATCH = 8, SEQ = 2048, T = BATCH * SEQ, D = 2048;
constexpr int EV_N = 7200, EV_NP = 7424, OD_N = 7616, OD_NP = 7680, PROJ_LD = 7680;
constexpr float EPS = 1e-6f;
constexpr int EC_GQ = 0, EC_GK = 512, EC_GV = 1024, EC_GZ = 2048, EC_GLR = 3072, EC_BQ = 3088, EC_BK = 4112, EC_BV = 5136, EC_BZ = 6160, EC_BA = 7184, EC_BB = 7192;
constexpr int OC_HQ = 0, OC_HF = 1024, OC_HI = 2048, OC_HG = 3072, OC_RW = 4096;
constexpr int RW_R = 0, RW_K = 1024, RW_V = 2048, RW_WL = 3072, RW_AL = 3168, RW_GL = 3264;
constexpr int LORA_K = 512, LORA_N = 3072;
enum { I_X = 0, I_P, I_EV_WIN, I_GK_W2, I_GK_B, I_GLA_NORM, I_GDN_CONV, I_GDN_ALOG, I_GDN_DTB, I_GDN_NORM, I_EV_WOUT, I_OD_WIN, I_LB, I_HG_NORM,
       I_MU, I_W0, I_W2, I_A0, I_A2, I_G2, I_KK, I_KA, I_RK, I_LNW, I_LNB, I_OD_WOUT, I_NMIX, I_NFFN, I_NPLE, I_PEER_WQ, I_PEER_SK, I_PEER_U, I_PEER_V,
       I_PLE_WP, I_PLE_WG, I_NFINAL, N_IN };

constexpr size_t MiB = 1u << 20;
constexpr size_t WS_CTL = 0, CTL_ZERO_BYTES = 1 * MiB;
constexpr size_t WS_WEV_IN = 1 * MiB, WS_WEV_OUT = 30 * MiB, WS_WOD_IN = 38 * MiB, WS_WOD_OUT = 68 * MiB, WS_WPEER = 76 * MiB, WS_WGATE = 92 * MiB, WS_WPROJ = 108 * MiB,
                 WS_WLORA = 110 * MiB, WS_PBF = 113 * MiB, WS_TABU = 129 * MiB, WS_TABV = 193 * MiB, WS_ACTA = 257 * MiB, WS_ACTB = 321 * MiB, WS_PROJ = 385 * MiB, WS_SC = 385 * MiB,
                 WS_O = 625 * MiB, WS_H1 = 689 * MiB, WS_PP = 753 * MiB, WS_LA = 817 * MiB, WS_LO = 833 * MiB, WS_RSP = 929 * MiB, WS_STATE = 937 * MiB, WS_RS3 = 945 * MiB, WS_END = 946 * MiB;
static_assert(WS_WEV_IN + (size_t)EV_NP * D * 2 <= WS_WEV_OUT && WS_WOD_IN + (size_t)OD_NP * D * 2 <= WS_WOD_OUT && WS_PROJ + (size_t)T * PROJ_LD * 2 <= WS_O, "ws map");
constexpr int CW_BAR = 4096;
enum { RS_FFN0 = 0, RS_MIX1 = 1, RS_FFN1 = 2, RS_FINAL = 3 };
constexpr int RING_OFF = 0, RING_BYTES = 131072;
constexpr int LDSCTL_OFF = RING_BYTES, MISC_OFF = LDSCTL_OFF + 320;
constexpr int LDS_BYTES = 147456;

struct Args { const float* in[N_IN]; float* out; unsigned char* ws; int ph_lo, ph_hi; };
struct Frame {
    LAS unsigned char* lds; volatile LAS unsigned* MISC; gu32* ctl;
    int tid, lane, wave, vcu, G;
};
__device__ __forceinline__ float wave_sum(float v) {
#pragma unroll
    for (int o = 1; o < 64; o <<= 1) v += __shfl_xor(v, o);
    return v;
}
__device__ __forceinline__ float half_sum32(float v) {
#pragma unroll
    for (int o = 1; o < 32; o <<= 1) v += __shfl_xor(v, o);
    return v;
}
#define DPP_ADD(v, ctrl) (v) += __builtin_bit_cast(float, __builtin_amdgcn_update_dpp(0, __builtin_bit_cast(int, (v)), (ctrl), 0xF, 0xF, false))
__device__ __forceinline__ float row_sum16(float v) {
    DPP_ADD(v, 0x128); DPP_ADD(v, 0x124); DPP_ADD(v, 0x122); DPP_ADD(v, 0x121);
    return v;
}
__device__ __forceinline__ void row_sum16_x4(float& a, float& b, float& c, float& d) {
    asm("s_nop 1\n\t"
        "v_add_f32_dpp %0, %0, %0 row_ror:8 row_mask:0xf bank_mask:0xf\n\tv_add_f32_dpp %1, %1, %1 row_ror:8 row_mask:0xf bank_mask:0xf\n\t"
        "v_add_f32_dpp %2, %2, %2 row_ror:8 row_mask:0xf bank_mask:0xf\n\tv_add_f32_dpp %3, %3, %3 row_ror:8 row_mask:0xf bank_mask:0xf\n\t"
        "v_add_f32_dpp %0, %0, %0 row_ror:4 row_mask:0xf bank_mask:0xf\n\tv_add_f32_dpp %1, %1, %1 row_ror:4 row_mask:0xf bank_mask:0xf\n\t"
        "v_add_f32_dpp %2, %2, %2 row_ror:4 row_mask:0xf bank_mask:0xf\n\tv_add_f32_dpp %3, %3, %3 row_ror:4 row_mask:0xf bank_mask:0xf\n\t"
        "v_add_f32_dpp %0, %0, %0 row_ror:2 row_mask:0xf bank_mask:0xf\n\tv_add_f32_dpp %1, %1, %1 row_ror:2 row_mask:0xf bank_mask:0xf\n\t"
        "v_add_f32_dpp %2, %2, %2 row_ror:2 row_mask:0xf bank_mask:0xf\n\tv_add_f32_dpp %3, %3, %3 row_ror:2 row_mask:0xf bank_mask:0xf\n\t"
        "v_add_f32_dpp %0, %0, %0 row_ror:1 row_mask:0xf bank_mask:0xf\n\tv_add_f32_dpp %1, %1, %1 row_ror:1 row_mask:0xf bank_mask:0xf\n\t"
        "v_add_f32_dpp %2, %2, %2 row_ror:1 row_mask:0xf bank_mask:0xf\n\tv_add_f32_dpp %3, %3, %3 row_ror:1 row_mask:0xf bank_mask:0xf\n\t"
        "s_nop 1"
        : "+v"(a), "+v"(b), "+v"(c), "+v"(d));
}
__device__ __forceinline__ void row_sum16_x2(float& a, float& b) {
    asm("s_nop 1\n\t"
        "v_add_f32_dpp %0, %0, %0 row_ror:8 row_mask:0xf bank_mask:0xf\n\tv_add_f32_dpp %1, %1, %1 row_ror:8 row_mask:0xf bank_mask:0xf\n\ts_nop 1\n\t"
        "v_add_f32_dpp %0, %0, %0 row_ror:4 row_mask:0xf bank_mask:0xf\n\tv_add_f32_dpp %1, %1, %1 row_ror:4 row_mask:0xf bank_mask:0xf\n\ts_nop 1\n\t"
        "v_add_f32_dpp %0, %0, %0 row_ror:2 row_mask:0xf bank_mask:0xf\n\tv_add_f32_dpp %1, %1, %1 row_ror:2 row_mask:0xf bank_mask:0xf\n\ts_nop 1\n\t"
        "v_add_f32_dpp %0, %0, %0 row_ror:1 row_mask:0xf bank_mask:0xf\n\tv_add_f32_dpp %1, %1, %1 row_ror:1 row_mask:0xf bank_mask:0xf\n\t"
        "s_nop 1"
        : "+v"(a), "+v"(b));
}
typedef unsigned u32x2 __attribute__((ext_vector_type(2)));
__device__ __forceinline__ void st_wt16(void* p, v4u v) { asm volatile("global_store_dwordx4 %0, %1, off sc1\n\ts_nop 1" :: "v"(p), "v"(v) : "memory"); }
__device__ __forceinline__ void st_wt8(void* p, u32x2 v) { asm volatile("global_store_dwordx2 %0, %1, off sc1\n\ts_nop 1" :: "v"(p), "v"(v) : "memory"); }
#define LBAR() do { asm volatile("s_waitcnt lgkmcnt(0)" ::: "memory"); __builtin_amdgcn_s_barrier(); asm volatile("" ::: "memory"); } while (0)
typedef float f32x2 __attribute__((ext_vector_type(2)));
typedef __bf16 hwbf16x2_t __attribute__((ext_vector_type(2)));
__device__ __forceinline__ unsigned hw_pk2(float lo, float hi) { const f32x2 v = {lo, hi}; return __builtin_bit_cast(unsigned, __builtin_convertvector(v, hwbf16x2_t)); }
__device__ __forceinline__ bf16 hw_bf(float x) { return (bf16)hw_pk2(x, 0.f); }
__device__ __forceinline__ float bf_lo(unsigned w) { return __uint_as_float(w << 16); }
__device__ __forceinline__ float bf_hi(unsigned w) { return __uint_as_float(w & 0xffff0000u); }
__device__ __forceinline__ float sigmoidf_(float x) { return __builtin_amdgcn_rcpf(1.0f + __expf(-x)); }
__device__ __forceinline__ float siluf_(float x) { return x * __builtin_amdgcn_rcpf(1.0f + __expf(-x)); }
__device__ __forceinline__ float softplusf_(float x) { return fmaxf(x, 0.f) + log1pf(__expf(-fabsf(x))); }
__device__ __forceinline__ float logsigmoidf_(float x) { return fminf(x, 0.f) - log1pf(__expf(-fabsf(x))); }

struct EpiBf16S {
    static constexpr bool PERM = true, AFTER_DRAIN = false;
    bf16* O; int ldc; const float* rowss;
    __device__ __forceinline__ void operator()(const pg8::f32x4 (&acc)[2][2][4][2], const pg8::Unit& u, int wr, int wc, int fr, int fq) const {
        const int row0 = u.pm * 256 + wr * 64 + fr, col0 = u.pn * 256 + wc * 32 + 8 * fq;
#pragma unroll
        for (int ai = 0; ai < 2; ++ai)
#pragma unroll
            for (int m = 0; m < 4; ++m) {
                const int row = row0 + ai * 128 + m * 16;
                float sc = 1.f;
                if (rowss) { const pg8::f32x4* rp = (const pg8::f32x4*)(rowss + (size_t)row * 32 + 8 * fq); const pg8::f32x4 p0 = rp[0], p1 = rp[1];
                    float s = ((p0[0] + p0[1]) + (p0[2] + p0[3])) + ((p1[0] + p1[1]) + (p1[2] + p1[3])); s += __shfl_xor(s, 16); s += __shfl_xor(s, 32);
                    sc = __builtin_amdgcn_rsqf(s * (1.0f / D) + EPS); }
                bf16* rowp = O + (size_t)row * ldc + col0;
#pragma unroll
                for (int bj = 0; bj < 2; ++bj) { const pg8::f32x4 v0 = acc[ai][bj][m][0] * sc, v1 = acc[ai][bj][m][1] * sc;
                    pg8::u32x4 w; w.x = pg8::cvt_pk_bf16(v0[0], v0[1]); w.y = pg8::cvt_pk_bf16(v0[2], v0[3]); w.z = pg8::cvt_pk_bf16(v1[0], v1[1]); w.w = pg8::cvt_pk_bf16(v1[2], v1[3]);
                    *(pg8::u32x4*)(rowp + bj * 128) = w; } }
    }
};
template <bool GATE, bool HIN_F32> struct EpiResid {
    static constexpr bool PERM = false, AFTER_DRAIN = false;
    const void* hin; bf16* hout; float* rowss; const bf16* pp; const float* rs3; unsigned char* h8;
    __device__ __forceinline__ void operator()(const pg8::f32x4 (&acc)[2][2][4][2], const pg8::Unit& u, int wr, int wc, int fr, int fq) const {
        const int row0 = u.pm * 256 + wr * 64 + fr, col0 = u.pn * 256 + wc * 32 + 4 * fq;
        constexpr int MG = HIN_F32 ? 2 : 4;
#pragma unroll
        for (int ai = 0; ai < 2; ++ai)
#pragma unroll
            for (int m0 = 0; m0 < 4; m0 += MG) {
                pg8::f32x4 hf[MG][2][2]; pg8::u32x2 hb[MG][2][2], pw[MG][2][2]; float rsc[MG];
#pragma unroll
                for (int mm = 0; mm < MG; ++mm) { const int row = row0 + ai * 128 + (m0 + mm) * 16; const size_t off = (size_t)row * D + col0; rsc[mm] = GATE ? rs3[row] : 1.f;
#pragma unroll
                    for (int bj = 0; bj < 2; ++bj)
#pragma unroll
                        for (int n = 0; n < 2; ++n) { const size_t o = off + bj * 128 + n * 16;
                            if (HIN_F32) hf[mm][bj][n] = *(const pg8::f32x4*)((const float*)hin + o); else hb[mm][bj][n] = *(const pg8::u32x2*)((const bf16*)hin + o);
                            if (GATE) pw[mm][bj][n] = *(const pg8::u32x2*)(pp + o); } }
#pragma unroll
                for (int mm = 0; mm < MG; ++mm) { const int m = m0 + mm; const int row = row0 + ai * 128 + m * 16; const size_t off = (size_t)row * D + col0; float ss = 0.f;
#pragma unroll
                    for (int bj = 0; bj < 2; ++bj)
#pragma unroll
                        for (int n = 0; n < 2; ++n) { const size_t o = off + bj * 128 + n * 16;
                            pg8::f32x4 hv;
                            if (HIN_F32) hv = hf[mm][bj][n];
                            else { const pg8::u32x2 hw = hb[mm][bj][n]; hv[0] = bf_lo(hw.x); hv[1] = bf_hi(hw.x); hv[2] = bf_lo(hw.y); hv[3] = bf_hi(hw.y); }
                            pg8::f32x4 a = acc[ai][bj][m][n];
                            if (GATE) { const pg8::u32x2 p2 = pw[mm][bj][n]; const float rs_ = rsc[mm];
                                a[0] = sigmoidf_(a[0] * rs_) * bf_lo(p2.x); a[1] = sigmoidf_(a[1] * rs_) * bf_hi(p2.x); a[2] = sigmoidf_(a[2] * rs_) * bf_lo(p2.y); a[3] = sigmoidf_(a[3] * rs_) * bf_hi(p2.y); }
                            hv = hv + a;
                            pg8::u32x2 w; w.x = hw_pk2(hv[0], hv[1]); w.y = hw_pk2(hv[2], hv[3]); *(pg8::u32x2*)(hout + o) = w;
                            if (h8) { int x8 = __builtin_amdgcn_cvt_pk_fp8_f32(hv[0], hv[1], 0, false); x8 = __builtin_amdgcn_cvt_pk_fp8_f32(hv[2], hv[3], x8, true); *(unsigned*)(h8 + o) = (unsigned)x8; }
                            const float q0 = bf_lo(w.x), q1 = bf_hi(w.x), q2 = bf_lo(w.y), q3 = bf_hi(w.y);
                            ss += (q0 * q0 + q1 * q1) + (q2 * q2 + q3 * q3); }
                    ss += __shfl_xor(ss, 16); ss += __shfl_xor(ss, 32);
                    if (fq == 0) rowss[(size_t)row * 32 + u.pn * 4 + wc] = ss; }
                asm volatile("" ::: "memory"); }
    }
};


__device__ __forceinline__ void p0_transpose_item(const float* W, int K, int N, bf16* WT, LAS float* scr, int item, int lane, const float* kgain = nullptr) {
    const int nblk = N / 32, kb = item / nblk, nb = item % nblk, k0 = 64 * kb, n0 = 32 * nb;
    { const GAS float* Wg = (const GAS float*)W + (size_t)(k0 + (lane >> 5)) * N + n0 + (lane & 31); float v[32];
#pragma unroll
      for (int i = 0; i < 32; ++i) v[i] = Wg[(size_t)(2 * i) * N];
#pragma unroll
      for (int i = 0; i < 32; ++i) scr[(2 * i + (lane >> 5)) * 33 + (lane & 31)] = v[i]; }
    LDS_WAIT(); asm volatile("" ::: "memory");
    const int c = lane & 7;
#pragma unroll
    for (int j = 0; j < 4; ++j) { const int n = (lane >> 3) + 8 * j; const LAS float* s = scr + (8 * c) * 33 + n;
        f32x4 g0 = {1.f, 1.f, 1.f, 1.f}, g1 = g0; if (kgain) { g0 = *(const GAS f32x4*)(kgain + k0 + 8 * c); g1 = *(const GAS f32x4*)(kgain + k0 + 8 * c + 4); }
        v4u o; o.x = pk2(s[0 * 33] * g0[0], s[1 * 33] * g0[1]); o.y = pk2(s[2 * 33] * g0[2], s[3 * 33] * g0[3]); o.z = pk2(s[4 * 33] * g1[0], s[5 * 33] * g1[1]); o.w = pk2(s[6 * 33] * g1[2], s[7 * 33] * g1[3]);
        *(GAS v4u*)(WT + (size_t)(n0 + n) * K + k0 + 8 * c) = o; }
    LDS_WAIT(); asm volatile("" ::: "memory");
}
__device__ __forceinline__ void p0_transpose_item_f8(const float* W, int K, int N, unsigned char* WT, LAS float* scr, int item, int lane, const float* kgain = nullptr) {
    const int nblk = N / 32, kb = item / nblk, nb = item % nblk, k0 = 64 * kb, n0 = 32 * nb;
    { const GAS float* Wg = (const GAS float*)W + (size_t)(k0 + (lane >> 5)) * N + n0 + (lane & 31); float v[32];
#pragma unroll
      for (int i = 0; i < 32; ++i) v[i] = Wg[(size_t)(2 * i) * N];
#pragma unroll
      for (int i = 0; i < 32; ++i) scr[(2 * i + (lane >> 5)) * 33 + (lane & 31)] = v[i]; }
    LDS_WAIT(); asm volatile("" ::: "memory");
    const int c = lane & 7;
#pragma unroll
    for (int j = 0; j < 4; ++j) { const int n = (lane >> 3) + 8 * j; const LAS float* s = scr + (8 * c) * 33 + n;
        f32x4 g0 = {64.f, 64.f, 64.f, 64.f}, g1 = g0; if (kgain) { g0 = g0 * *(const GAS f32x4*)(kgain + k0 + 8 * c); g1 = g1 * *(const GAS f32x4*)(kgain + k0 + 8 * c + 4); }
        int x0 = __builtin_amdgcn_cvt_pk_fp8_f32(s[0 * 33] * g0[0], s[1 * 33] * g0[1], 0, false); x0 = __builtin_amdgcn_cvt_pk_fp8_f32(s[2 * 33] * g0[2], s[3 * 33] * g0[3], x0, true);
        int x1 = __builtin_amdgcn_cvt_pk_fp8_f32(s[4 * 33] * g1[0], s[5 * 33] * g1[1], 0, false); x1 = __builtin_amdgcn_cvt_pk_fp8_f32(s[6 * 33] * g1[2], s[7 * 33] * g1[3], x1, true);
        u32x2 o; o.x = (unsigned)x0; o.y = (unsigned)x1;
        *(GAS u32x2*)(WT + (size_t)(n0 + n) * K + k0 + 8 * c) = o; }
    LDS_WAIT(); asm volatile("" ::: "memory");
}
__device__ __forceinline__ void cvt_f32_bf16(const float* src, bf16* dst, size_t n, int gtid, int gthreads) {
    const size_t n8 = n / 8;
    for (size_t i = gtid; i < n8; i += gthreads) {
        const f32x4 a = *(const GAS f32x4*)(src + i * 8), b = *(const GAS f32x4*)(src + i * 8 + 4);
        v4u o; o.x = pk2(a[0], a[1]); o.y = pk2(a[2], a[3]); o.z = pk2(b[0], b[1]); o.w = pk2(b[2], b[3]);
        *(GAS v4u*)(dst + i * 8) = o; }
}
__device__ __forceinline__ void cvt_f32_fp8(const float* src, unsigned char* dst, size_t n, float scale, int gtid, int gthreads, const float* cgain = nullptr) {
    const size_t n16 = n / 16;
    for (size_t i = gtid; i < n16; i += gthreads) { v4u o; unsigned w[4];
#pragma unroll
        for (int q = 0; q < 4; ++q) { f32x4 a = *(const GAS f32x4*)(src + i * 16 + 4 * q) * scale; if (cgain) a = a * *(const GAS f32x4*)(cgain + ((i * 16 + 4 * q) & (D - 1)));
            int x = __builtin_amdgcn_cvt_pk_fp8_f32(a[0], a[1], 0, false); x = __builtin_amdgcn_cvt_pk_fp8_f32(a[2], a[3], x, true); w[q] = (unsigned)x; }
        o.x = w[0]; o.y = w[1]; o.z = w[2]; o.w = w[3];
        *(GAS v4u*)(dst + i * 16) = o; }
}
__device__ __forceinline__ void rms_row_to_bf16(const float* xrow, const float* g, bf16* orow, int lane) {
    const GAS f32x4* xr = (const GAS f32x4*)xrow + lane; f32x4 v[8]; float s = 0.f;
#pragma unroll
    for (int j = 0; j < 8; ++j) { v[j] = xr[64 * j]; s += (v[j][0] * v[j][0] + v[j][1] * v[j][1]) + (v[j][2] * v[j][2] + v[j][3] * v[j][3]); }
    const float r = __builtin_amdgcn_rsqf(wave_sum(s) * (1.0f / D) + EPS);
    const GAS f32x4* gr = (const GAS f32x4*)g + lane;
    GAS unsigned long long* o8 = (GAS unsigned long long*)orow + lane;
#pragma unroll
    for (int j = 0; j < 8; ++j) { const f32x4 gg = gr[64 * j]; o8[64 * j] = (unsigned long long)pk2(v[j][0] * r * gg[0], v[j][1] * r * gg[1]) | ((unsigned long long)pk2(v[j][2] * r * gg[2], v[j][3] * r * gg[3]) << 32); }
}
__device__ __forceinline__ void rms_row_to_f8(const float* xrow, const float* g, unsigned char* orow, int lane) {
    const GAS f32x4* xr = (const GAS f32x4*)xrow + lane; f32x4 v[8]; float s = 0.f;
#pragma unroll
    for (int j = 0; j < 8; ++j) { v[j] = xr[64 * j]; s += (v[j][0] * v[j][0] + v[j][1] * v[j][1]) + (v[j][2] * v[j][2] + v[j][3] * v[j][3]); }
    const float r = __builtin_amdgcn_rsqf(wave_sum(s) * (1.0f / D) + EPS);
    const GAS f32x4* gr = (const GAS f32x4*)g + lane;
    GAS unsigned* o4 = (GAS unsigned*)orow + lane;
#pragma unroll
    for (int j = 0; j < 8; ++j) { const f32x4 q = v[j] * gr[64 * j] * r; int x = __builtin_amdgcn_cvt_pk_fp8_f32(q[0], q[1], 0, false); x = __builtin_amdgcn_cvt_pk_fp8_f32(q[2], q[3], x, true); o4[64 * j] = (unsigned)x; }
}
__device__ __forceinline__ void p0_fold_item(const float* wq, const float* sk, bf16* WP, LAS float* lds, int item, int tid, const float* kgain) {
    const int hp = item >> 5, k0 = (item & 31) * 64;
    LAS float* skT = lds;
    LAS float* wqT = lds + 128 * 132;
    const float* skb = sk + (size_t)hp * 128 * 128;
#pragma unroll 4
    for (int i = 0; i < 32; ++i) { const int idx = i * 512 + tid, n = idx >> 7, d = idx & 127; skT[d * 132 + n] = skb[idx]; }
#pragma unroll 4
    for (int i = 0; i < 16; ++i) { const int idx = i * 512 + tid, kk = idx >> 7, d = idx & 127; wqT[d * 68 + kk] = wq[(size_t)(k0 + kk) * D + hp * 128 + d] * kgain[k0 + kk]; }
    __syncthreads();
    const int n0 = (tid >> 4) * 4, kk0 = (tid & 15) * 4;
    float acc[4][4];
#pragma unroll
    for (int i = 0; i < 4; ++i)
#pragma unroll
        for (int j = 0; j < 4; ++j) acc[i][j] = 0.f;
#pragma unroll 4
    for (int d = 0; d < 128; ++d) { const f32x4 a = *(const LAS f32x4*)(skT + d * 132 + n0), b = *(const LAS f32x4*)(wqT + d * 68 + kk0);
#pragma unroll
        for (int i = 0; i < 4; ++i)
#pragma unroll
            for (int j = 0; j < 4; ++j) acc[i][j] += a[i] * b[j]; }
#pragma unroll
    for (int i = 0; i < 4; ++i) { unsigned long long o = (unsigned long long)pk2(acc[i][0], acc[i][1]) | ((unsigned long long)pk2(acc[i][2], acc[i][3]) << 32);
        *(GAS unsigned long long*)(WP + (size_t)(hp * 128 + n0 + i) * D + k0 + kk0) = o; }
    __syncthreads();
}
__device__ __forceinline__ void p0_prologue(const Args& A, Frame& F) {
    const int gw = F.vcu * NWAVES + F.wave, NGW = F.G * NWAVES;
    const int gtid = gw * 64 + F.lane, gthreads = F.G * NTHREADS;
    unsigned char* ws = A.ws;
    LAS float* scr = (LAS float*)(F.lds + RING_OFF + F.wave * 16384);
    constexpr int I_EVIN = (D / 64) * (EV_N / 32);
    for (int it = gw; it < I_EVIN; it += NGW) p0_transpose_item(A.in[I_EV_WIN], D, EV_N, (bf16*)(ws + WS_WEV_IN), scr, it, F.lane);
    { GAS v4u* z0 = (GAS v4u*)(ws + WS_WEV_IN + (size_t)EV_N * D * 2); const size_t n0 = (size_t)(EV_NP - EV_N) * D * 2 / 16;
      for (size_t i = gtid; i < n0; i += gthreads) z0[i] = (v4u){0u, 0u, 0u, 0u}; }
    { constexpr int I_PJ = (256 / 64) * (D / 32);
      for (int it = gw; it < 2 * I_PJ; it += NGW) { const int L = it / I_PJ; p0_transpose_item(A.in[I_PLE_WP] + (size_t)L * 256 * D, 256, D, (bf16*)(ws + WS_WPROJ) + (size_t)L * D * 256, scr, it % I_PJ, F.lane); } }
    cvt_f32_bf16(A.in[I_P], (bf16*)(ws + WS_PBF), (size_t)2 * T * 256, gtid, gthreads);
    for (int m = gw; m < T; m += NGW) rms_row_to_bf16(A.in[I_X] + (size_t)m * D, A.in[I_NMIX], (bf16*)(ws + WS_ACTA) + (size_t)m * D, F.lane);
}
__device__ __forceinline__ void p0_deferred(const Args& A, Frame& F, int wg, int nwg) {
    const int gw = wg * NWAVES + F.wave, NGW = nwg * NWAVES;
    int gtid = gw * 64 + F.lane; const int gthreads = nwg * NTHREADS;
    asm volatile("" : "+v"(gtid));
    unsigned char* ws = A.ws;
    {
        LAS float* scr = (LAS float*)(F.lds + RING_OFF + F.wave * 16384);
        constexpr int I_SQ = (D / 64) * (D / 32), I_ODIN = (D / 64) * (OD_N / 32);
        constexpr int NITEMS = I_SQ + I_ODIN + I_SQ;
        for (int it = gw; it < NITEMS; it += NGW) {
            int r = it;
            if (r < I_SQ) { p0_transpose_item(A.in[I_EV_WOUT], D, D, (bf16*)(ws + WS_WEV_OUT), scr, r, F.lane); continue; } r -= I_SQ;
            if (r < I_ODIN) { p0_transpose_item_f8(A.in[I_OD_WIN], D, OD_N, (unsigned char*)(ws + WS_WOD_IN), scr, r, F.lane, A.in[I_NMIX] + D); continue; } r -= I_ODIN;
            p0_transpose_item(A.in[I_PLE_WG], D, D, (bf16*)(ws + WS_WGATE), scr, r, F.lane, A.in[I_NPLE]);
        }
        { GAS v4u* z1 = (GAS v4u*)(ws + WS_WOD_IN + (size_t)OD_N * D); const size_t n1 = (size_t)(OD_NP - OD_N) * D / 16;
          for (size_t i = gtid; i < n1; i += gthreads) z1[i] = (v4u){0u, 0u, 0u, 0u}; }
    }
    __syncthreads();
    for (int it = wg; it < 512; it += nwg)
        p0_fold_item(A.in[I_PEER_WQ], A.in[I_PEER_SK], (bf16*)(ws + WS_WPEER), (LAS float*)(F.lds + RING_OFF), it, F.tid, A.in[I_NFFN]);
    cvt_f32_fp8(A.in[I_PEER_U], (unsigned char*)(ws + WS_TABU), (size_t)16384 * D, 512.0f, gtid, gthreads, A.in[I_NFFN]);
    cvt_f32_fp8(A.in[I_PEER_V], (unsigned char*)(ws + WS_TABV), (size_t)16384 * D, 16.0f, gtid, gthreads);
    { bf16* LB = (bf16*)(ws + WS_WLORA); const float* w2 = A.in[I_W2]; const float* a2 = A.in[I_A2]; const float* g2 = A.in[I_G2];
      for (int i = gtid; i < LORA_N * LORA_K / 2; i += gthreads) { const int row = i / (LORA_K / 2), col = (i % (LORA_K / 2)) * 2; float v[2];
#pragma unroll
          for (int e = 0; e < 2; ++e) { const int c = col + e; float x = 0.f;
              if (row < 1024) { if (c < 96) x = w2[c * 1024 + row]; }
              else if (row < 2048) { if (c >= 96 && c < 192) x = a2[(c - 96) * 1024 + (row - 1024)]; }
              else { if (c >= 192 && c < 448) x = g2[(c - 192) * 1024 + (row - 2048)]; }
              v[e] = x; }
          *(GAS unsigned*)(LB + (size_t)row * LORA_K + col) = pk2(v[0], v[1]); } }
}
__device__ __forceinline__ void p1_deferred(const Args& A, Frame& F, int wg, int nwg) {
    const int gw = wg * NWAVES + F.wave, NGW = nwg * NWAVES;
    int gtid = gw * 64 + F.lane; const int gthreads = nwg * NTHREADS;
    asm volatile("" : "+v"(gtid));
    unsigned char* ws = A.ws;
    { LAS float* scr = (LAS float*)(F.lds + RING_OFF + F.wave * 16384); constexpr int I_SQ = (D / 64) * (D / 32);
      for (int it = gw; it < 2 * I_SQ; it += NGW) {
          if (it < I_SQ) p0_transpose_item_f8(A.in[I_OD_WOUT], D, D, (unsigned char*)(ws + WS_WOD_OUT), scr, it, F.lane);
          else p0_transpose_item_f8(A.in[I_PLE_WG] + (size_t)D * D, D, D, (unsigned char*)((bf16*)(ws + WS_WGATE) + (size_t)D * D), scr, it - I_SQ, F.lane, A.in[I_NPLE] + D); } }
    __syncthreads();
    for (int it = wg; it < 512; it += nwg)
        p0_fold_item(A.in[I_PEER_WQ] + (size_t)D * D, A.in[I_PEER_SK] + (size_t)16 * 128 * 128, (bf16*)(ws + WS_WPEER) + (size_t)D * D, (LAS float*)(F.lds + RING_OFF), it, F.tid, A.in[I_NFFN] + D);
    cvt_f32_fp8(A.in[I_PEER_U] + (size_t)16384 * D, (unsigned char*)(ws + WS_TABU) + (size_t)16384 * D, (size_t)16384 * D, 512.0f, gtid, gthreads, A.in[I_NFFN] + D);
    cvt_f32_fp8(A.in[I_PEER_V] + (size_t)16384 * D, (unsigned char*)(ws + WS_TABV) + (size_t)16384 * D, (size_t)16384 * D, 16.0f, gtid, gthreads);
}

constexpr int TC = 16, NCHUNK = SEQ / TC;

template <int MODE>
__device__ __forceinline__ void scan_gla_unit(const Args& A, Frame& F, int unit) {
    int tid = F.tid; asm volatile("" : "+v"(tid));
    const int lane = tid & 63, w = F.wave;
    int b, h, qcol, kcol, vcol, ocol;
    if (MODE == 0) { b = unit >> 4; h = (unit >> 2) & 3; const int s = unit & 3; qcol = EC_GQ + h * 128; kcol = EC_GK + h * 128; vcol = EC_GV + h * 256 + s * 64; ocol = h * 256 + s * 64; }
    else           { b = unit >> 4; h = (unit >> 1) & 7; const int s = unit & 1; qcol = OC_HQ + h * 128; kcol = OC_HF + h * 128; vcol = OC_HI + h * 128 + s * 64; ocol = h * 128 + s * 64; }
    const bf16* P = (const bf16*)(A.ws + WS_PROJ) + (size_t)b * SEQ * PROJ_LD;
    float* O = (float*)(A.ws + WS_O) + (size_t)b * SEQ * D + ocol;
    LAS float* Lf = (LAS float*)(F.lds + RING_OFF);
    constexpr int BUFSZ = 7168, O_EG = 0, O_K = 2048, O_Q = 4096, O_V = 6144, O_OUT = 2 * BUFSZ, O_W2 = O_OUT + 1024, O_BIAS = O_W2 + 2048;
    const int tl = tid >> 5, dq = (tid & 31) * 4, tlv = tid >> 4, c4 = (tid & 15) * 4;
    float lb[4] = {0.f, 0.f, 0.f, 0.f};
    if (MODE == 0) {
        const float* w2 = A.in[I_GK_W2]; const float* gb = A.in[I_GK_B];
        for (int i = tid; i < 2048; i += NTHREADS) Lf[O_W2 + i] = w2[(i >> 7) * 512 + h * 128 + (i & 127)];
        if (tid < 128) Lf[O_BIAS + tid] = gb[h * 128 + tid];
    } else {
        const float* lg = A.in[I_LB];
#pragma unroll
        for (int i = 0; i < 4; ++i) lb[i] = sigmoidf_(lg[1024 + h * 128 + dq + i] - lg[h * 128 + dq + i]);
    }
    u32x2 rq, rk, rv = {0u, 0u}; v4u rg0 = {0u, 0u, 0u, 0u}, rg1 = {0u, 0u, 0u, 0u};
#define GLA_LOAD(c) do { const bf16* pr = P + (size_t)((c) * TC + tl) * PROJ_LD; rq = *(const GAS u32x2*)(pr + qcol + dq); rk = *(const GAS u32x2*)(pr + kcol + dq); \
        if (MODE == 0) { rg0 = *(const GAS v4u*)(pr + EC_GLR); rg1 = *(const GAS v4u*)(pr + EC_GLR + 8); } \
        if (tid < 256) rv = *(const GAS u32x2*)(P + (size_t)((c) * TC + tlv) * PROJ_LD + vcol + c4); } while (0)
#define GLA_XFORM(bufi) do { LAS float* B_ = Lf + (bufi) * BUFSZ; f32x4 q4, k4, e4; \
        const float xq[4] = {bf_lo(rq.x), bf_hi(rq.x), bf_lo(rq.y), bf_hi(rq.y)}, xk[4] = {bf_lo(rk.x), bf_hi(rk.x), bf_lo(rk.y), bf_hi(rk.y)}; \
        if (MODE == 0) { f32x4 z = *(const LAS f32x4*)(Lf + O_BIAS + dq); \
            const float gl[16] = {bf_lo(rg0.x), bf_hi(rg0.x), bf_lo(rg0.y), bf_hi(rg0.y), bf_lo(rg0.z), bf_hi(rg0.z), bf_lo(rg0.w), bf_hi(rg0.w), \
                                  bf_lo(rg1.x), bf_hi(rg1.x), bf_lo(rg1.y), bf_hi(rg1.y), bf_lo(rg1.z), bf_hi(rg1.z), bf_lo(rg1.w), bf_hi(rg1.w)}; \
            _Pragma("unroll") for (int r_ = 0; r_ < 16; ++r_) { const f32x4 wv = *(const LAS f32x4*)(Lf + O_W2 + r_ * 128 + dq); z = z + wv * gl[r_]; } \
            _Pragma("unroll") for (int i_ = 0; i_ < 4; ++i_) { q4[i_] = xq[i_] * 0.08838834764831845f; k4[i_] = xk[i_]; e4[i_] = __builtin_amdgcn_exp2f(-0.0625f * __builtin_amdgcn_logf(1.0f + __expf(-z[i_]))); } } \
        else { _Pragma("unroll") for (int i_ = 0; i_ < 4; ++i_) { const float fg = lb[i_] + (1.f - lb[i_]) * sigmoidf_(xk[i_]); q4[i_] = siluf_(xq[i_]); k4[i_] = 1.f - fg; e4[i_] = fg; } } \
        *(LAS f32x4*)(B_ + O_EG + tl * 128 + dq) = e4; *(LAS f32x4*)(B_ + O_K + tl * 128 + dq) = k4; *(LAS f32x4*)(B_ + O_Q + tl * 128 + dq) = q4; \
        if (tid < 256) { f32x4 v4 = {bf_lo(rv.x), bf_hi(rv.x), bf_lo(rv.y), bf_hi(rv.y)}; *(LAS f32x4*)(B_ + O_V + tlv * 64 + c4) = v4; } } while (0)
    LBAR();
    GLA_LOAD(0); GLA_XFORM(0);
    LBAR();
    f32x2 S2[8];
#pragma unroll
    for (int i = 0; i < 8; ++i) S2[i] = (f32x2){0.f, 0.f};
    const int j = lane & 15, col = w * 8 + (lane >> 4) * 2;
    for (int c = 0; c < NCHUNK; ++c) {
        if (c + 1 < NCHUNK) GLA_LOAD(c + 1);
        const LAS float* B_ = Lf + (c & 1) * BUFSZ;
        float os0 = 0.f, os1 = 0.f;
        f32x4 e0, e1, k0, k1, q0, q1, ne0, ne1, nk0, nk1, nq0, nq1; f32x2 v2, nv2;
#define GLA_LDSTEP(t_, E0, E1, K0, K1, Q0, Q1, V2) do { E0 = *(const LAS f32x4*)(B_ + O_EG + (t_) * 128 + 4 * j); E1 = *(const LAS f32x4*)(B_ + O_EG + (t_) * 128 + 64 + 4 * j); \
            K0 = *(const LAS f32x4*)(B_ + O_K + (t_) * 128 + 4 * j); K1 = *(const LAS f32x4*)(B_ + O_K + (t_) * 128 + 64 + 4 * j); \
            Q0 = *(const LAS f32x4*)(B_ + O_Q + (t_) * 128 + 4 * j); Q1 = *(const LAS f32x4*)(B_ + O_Q + (t_) * 128 + 64 + 4 * j); V2 = *(const LAS f32x2*)(B_ + O_V + (t_) * 64 + col); } while (0)
        GLA_LDSTEP(0, e0, e1, k0, k1, q0, q1, v2);
#pragma unroll
        for (int t = 0; t < TC; ++t) {
            if (t + 1 < TC) { GLA_LDSTEP(t + 1, ne0, ne1, nk0, nk1, nq0, nq1, nv2); }
            __builtin_amdgcn_sched_barrier(0);
            f32x2 pa = {0.f, 0.f}, pb = {0.f, 0.f};
#pragma unroll
            for (int i = 0; i < 4; ++i) {
                S2[i] = S2[i] * e0[i] + v2 * k0[i]; S2[4 + i] = S2[4 + i] * e1[i] + v2 * k1[i];
                pa += S2[i] * q0[i]; pb += S2[4 + i] * q1[i]; }
            pa += pb;
            float p0 = pa[0], p1 = pa[1];
            row_sum16_x2(p0, p1);
            os0 = (j == t) ? p0 : os0; os1 = (j == t) ? p1 : os1;
            e0 = ne0; e1 = ne1; k0 = nk0; k1 = nk1; q0 = nq0; q1 = nq1; v2 = nv2;
        }
#undef GLA_LDSTEP
        { f32x2 o2 = {os0, os1}; *(LAS f32x2*)(Lf + O_OUT + j * 64 + col) = o2; }
        if (c + 1 < NCHUNK) GLA_XFORM((c + 1) & 1);
        LBAR();
        if (tid < 256) *(GAS f32x4*)(O + (size_t)(c * TC + tlv) * D + c4) = *(const LAS f32x4*)(Lf + O_OUT + tlv * 64 + c4);
        LBAR();
    }
#undef GLA_LOAD
#undef GLA_XFORM
}

__device__ __forceinline__ void scan_gdn_unit(const Args& A, Frame& F, int unit) {
    int tid = F.tid; asm volatile("" : "+v"(tid));
    const int lane = tid & 63, w = F.wave;
    const int b = unit >> 4, h = (unit >> 1) & 7, s = unit & 1;
    const int qcol = EC_BQ + h * 128, kcol = EC_BK + h * 128, vcol = EC_BV + h * 128 + s * 64, ocol = 1024 + h * 128 + s * 64;
    const bf16* P = (const bf16*)(A.ws + WS_PROJ) + (size_t)b * SEQ * PROJ_LD;
    float* O = (float*)(A.ws + WS_O) + (size_t)b * SEQ * D + ocol;
    LAS float* Lf = (LAS float*)(F.lds + RING_OFF);
    constexpr int BUFSZ = 5184, O_K = 0, O_Q = 2048, O_V = 4096, O_SC = 5120, O_OUT = 2 * BUFSZ, O_CW = O_OUT + 1024;
    const int tl = tid >> 5, dq = (tid & 31) * 4, tlv = tid >> 4, c4 = (tid & 15) * 4;
    { const float* cw = A.in[I_GDN_CONV];
      for (int i = tid; i < 4 * 320; i += NTHREADS) { const int jt = i / 320, x = i % 320;
          const int ch = x < 128 ? (h * 128 + x) : x < 256 ? (1024 + h * 128 + (x - 128)) : (2048 + h * 128 + s * 64 + (x - 256));
          Lf[O_CW + i] = cw[jt * 3072 + ch]; } }
    const float neg_ea = -__expf(A.in[I_GDN_ALOG][h]), dtb = A.in[I_GDN_DTB][h];
    u32x2 rq[4], rk[4], rv[4]; unsigned short rba = 0, rbb = 0;
#pragma unroll
    for (int i = 0; i < 4; ++i) rv[i] = (u32x2){0u, 0u};
#define GDN_LOAD(c) do { const int t_ = (c) * TC + tl; \
        _Pragma("unroll") for (int jt = 0; jt < 4; ++jt) { const int tt = t_ - 3 + jt; \
            if (tt >= 0) { const bf16* pr = P + (size_t)tt * PROJ_LD; rq[jt] = *(const GAS u32x2*)(pr + qcol + dq); rk[jt] = *(const GAS u32x2*)(pr + kcol + dq); } \
            else { rq[jt] = (u32x2){0u, 0u}; rk[jt] = (u32x2){0u, 0u}; } } \
        { const bf16* pr = P + (size_t)t_ * PROJ_LD; rba = pr[EC_BA + h]; rbb = pr[EC_BB + h]; } \
        if (tid < 256) { const int tv = (c) * TC + tlv; \
            _Pragma("unroll") for (int jt = 0; jt < 4; ++jt) { const int tt = tv - 3 + jt; \
                if (tt >= 0) rv[jt] = *(const GAS u32x2*)(P + (size_t)tt * PROJ_LD + vcol + c4); else rv[jt] = (u32x2){0u, 0u}; } } } while (0)
#define GDN_XFORM(bufi) do { LAS float* B_ = Lf + (bufi) * BUFSZ; f32x4 q4 = {0.f, 0.f, 0.f, 0.f}, k4 = {0.f, 0.f, 0.f, 0.f}; \
        _Pragma("unroll") for (int jt = 0; jt < 4; ++jt) { const f32x4 wq = *(const LAS f32x4*)(Lf + O_CW + jt * 320 + dq), wk = *(const LAS f32x4*)(Lf + O_CW + jt * 320 + 128 + dq); \
            q4[0] += wq[0] * bf_lo(rq[jt].x); q4[1] += wq[1] * bf_hi(rq[jt].x); q4[2] += wq[2] * bf_lo(rq[jt].y); q4[3] += wq[3] * bf_hi(rq[jt].y); \
            k4[0] += wk[0] * bf_lo(rk[jt].x); k4[1] += wk[1] * bf_hi(rk[jt].x); k4[2] += wk[2] * bf_lo(rk[jt].y); k4[3] += wk[3] * bf_hi(rk[jt].y); } \
        float sq = 0.f, sk = 0.f, sqk = 0.f; \
        _Pragma("unroll") for (int i_ = 0; i_ < 4; ++i_) { q4[i_] = siluf_(q4[i_]); k4[i_] = siluf_(k4[i_]); sq += q4[i_] * q4[i_]; sk += k4[i_] * k4[i_]; sqk += q4[i_] * k4[i_]; } \
        sq = half_sum32(sq); sk = half_sum32(sk); sqk = half_sum32(sqk); \
        const float rq_ = __builtin_amdgcn_rsqf(sq + EPS) * 0.08838834764831845f, rk_ = __builtin_amdgcn_rsqf(sk + EPS); \
        q4 = q4 * rq_; k4 = k4 * rk_; \
        *(LAS f32x4*)(B_ + O_K + tl * 128 + dq) = k4; *(LAS f32x4*)(B_ + O_Q + tl * 128 + dq) = q4; \
        if ((tid & 31) == 0) { const float ba = __uint_as_float((unsigned)rba << 16), bb = __uint_as_float((unsigned)rbb << 16); \
            f32x4 sc; sc[0] = __expf(neg_ea * softplusf_(ba + dtb)); sc[1] = sigmoidf_(bb); sc[2] = sqk * rq_ * rk_; sc[3] = 0.f; *(LAS f32x4*)(B_ + O_SC + tl * 4) = sc; } \
        if (tid < 256) { f32x4 v4 = {0.f, 0.f, 0.f, 0.f}; \
            _Pragma("unroll") for (int jt = 0; jt < 4; ++jt) { const f32x4 wv = *(const LAS f32x4*)(Lf + O_CW + jt * 320 + 256 + c4); \
                v4[0] += wv[0] * bf_lo(rv[jt].x); v4[1] += wv[1] * bf_hi(rv[jt].x); v4[2] += wv[2] * bf_lo(rv[jt].y); v4[3] += wv[3] * bf_hi(rv[jt].y); } \
            _Pragma("unroll") for (int i_ = 0; i_ < 4; ++i_) v4[i_] = siluf_(v4[i_]); \
            *(LAS f32x4*)(B_ + O_V + tlv * 64 + c4) = v4; } } while (0)
    LBAR();
    GDN_LOAD(0); GDN_XFORM(0);
    LBAR();
    f32x2 S2[8];
#pragma unroll
    for (int i = 0; i < 8; ++i) S2[i] = (f32x2){0.f, 0.f};
    const int j = lane & 15, col = w * 8 + (lane >> 4) * 2;
    for (int c = 0; c < NCHUNK; ++c) {
        if (c + 1 < NCHUNK) GDN_LOAD(c + 1);
        const LAS float* B_ = Lf + (c & 1) * BUFSZ;
        float os0 = 0.f, os1 = 0.f;
        f32x4 k0, k1, q0, q1, sc, nk0, nk1, nq0, nq1, nsc; f32x2 v2, nv2;
#define GDN_LDSTEP(t_, K0, K1, Q0, Q1, V2, SC) do { K0 = *(const LAS f32x4*)(B_ + O_K + (t_) * 128 + 4 * j); K1 = *(const LAS f32x4*)(B_ + O_K + (t_) * 128 + 64 + 4 * j); \
            Q0 = *(const LAS f32x4*)(B_ + O_Q + (t_) * 128 + 4 * j); Q1 = *(const LAS f32x4*)(B_ + O_Q + (t_) * 128 + 64 + 4 * j); V2 = *(const LAS f32x2*)(B_ + O_V + (t_) * 64 + col); SC = *(const LAS f32x4*)(B_ + O_SC + (t_) * 4); } while (0)
        GDN_LDSTEP(0, k0, k1, q0, q1, v2, sc);
#pragma unroll
        for (int t = 0; t < TC; ++t) {
            if (t + 1 < TC) { GDN_LDSTEP(t + 1, nk0, nk1, nq0, nq1, nv2, nsc); }
            __builtin_amdgcn_sched_barrier(0);
            f32x2 d1 = {0.f, 0.f}, d2 = {0.f, 0.f}, e1 = {0.f, 0.f}, e2 = {0.f, 0.f};
#pragma unroll
            for (int i = 0; i < 4; ++i) { d1 += S2[i] * k0[i]; e1 += S2[4 + i] * k1[i]; d2 += S2[i] * q0[i]; e2 += S2[4 + i] * q1[i]; }
            d1 += e1; d2 += e2;
            { float r0_ = d1[0], r1_ = d1[1], r2_ = d2[0], r3_ = d2[1]; row_sum16_x4(r0_, r1_, r2_, r3_); d1[0] = r0_; d1[1] = r1_; d2[0] = r2_; d2[1] = r3_; }
            const float a = sc[0], beta = sc[1], qk = sc[2];
            const f32x2 dl = (v2 - d1 * a) * beta;
            const f32x2 o2 = d2 * a + dl * qk;
#pragma unroll
            for (int i = 0; i < 4; ++i) { S2[i] = S2[i] * a + dl * k0[i]; S2[4 + i] = S2[4 + i] * a + dl * k1[i]; }
            os0 = (j == t) ? o2[0] : os0; os1 = (j == t) ? o2[1] : os1;
            k0 = nk0; k1 = nk1; q0 = nq0; q1 = nq1; v2 = nv2; sc = nsc;
        }
#undef GDN_LDSTEP
        { f32x2 o2 = {os0, os1}; *(LAS f32x2*)(Lf + O_OUT + j * 64 + col) = o2; }
        if (c + 1 < NCHUNK) GDN_XFORM((c + 1) & 1);
        LBAR();
        if (tid < 256) *(GAS f32x4*)(O + (size_t)(c * TC + tlv) * D + c4) = *(const LAS f32x4*)(Lf + O_OUT + tlv * 64 + c4);
        LBAR();
    }
#undef GDN_LOAD
#undef GDN_XFORM
}

typedef short bf16x4_t __attribute__((ext_vector_type(4)));
__device__ __forceinline__ bf16x8 mk_frag(u32x2 lo, u32x2 hi) { v4u t; t.x = lo.x; t.y = lo.y; t.z = hi.x; t.w = hi.y; return __builtin_bit_cast(bf16x8, t); }
template <int MODE>
__device__ __forceinline__ void scan_gla_mfma_unit(const Args& A, Frame& F, int unit) {
    int tid = F.tid; asm volatile("" : "+v"(tid));
    const int lane = tid & 63, w = F.wave;
    int b, h, qcol, kcol, vcol, ocol;
    if (MODE == 0) { b = unit >> 3; h = (unit >> 1) & 3; const int s = unit & 1; qcol = EC_GQ + h * 128; kcol = EC_GK + h * 128; vcol = EC_GV + h * 256 + s * 128; ocol = h * 256 + s * 128; }
    else           { b = unit >> 3; h = unit & 7; qcol = OC_HQ + h * 128; kcol = OC_HF + h * 128; vcol = OC_HI + h * 128; ocol = h * 128; }
    const bf16* P = (const bf16*)(A.ws + WS_PROJ) + (size_t)b * SEQ * PROJ_LD;
    bf16* O = (bf16*)(A.ws + WS_O) + (size_t)b * SEQ * D + ocol;
    LAS float* Lf = (LAS float*)(F.lds + RING_OFF);
    constexpr int BUFSZ = 8192, O_E = 0, O_K = 2048, O_Q = 4096, O_V = 6144, RS = 136, O_QB = 2 * BUFSZ, O_KB = O_QB + 1088, O_KT = O_KB + 1088, O_BL = O_KT + 1024, O_AM = O_BL + 128, O_W2 = O_AM + 128, O_BIAS = O_W2 + 2048;
    LAS bf16* QB = (LAS bf16*)(Lf + O_QB); LAS bf16* KB = (LAS bf16*)(Lf + O_KB); LAS bf16* KT = (LAS bf16*)(Lf + O_KT); LAS bf16* AM = (LAS bf16*)(Lf + O_AM);
    const int tl = tid >> 5, dq = (tid & 31) * 4;
    float lb[4] = {0.f, 0.f, 0.f, 0.f};
    if (MODE == 0) {
        const float* w2 = A.in[I_GK_W2]; const float* gb = A.in[I_GK_B];
        for (int i = tid; i < 2048; i += NTHREADS) Lf[O_W2 + i] = w2[(i >> 7) * 512 + h * 128 + (i & 127)];
        if (tid < 128) Lf[O_BIAS + tid] = gb[h * 128 + tid];
    } else {
        const float* lg = A.in[I_LB];
#pragma unroll
        for (int i = 0; i < 4; ++i) lb[i] = sigmoidf_(lg[1024 + h * 128 + dq + i] - lg[h * 128 + dq + i]);
    }
    u32x2 rq, rk, rv; v4u rg0 = {0u, 0u, 0u, 0u}, rg1 = {0u, 0u, 0u, 0u};
#define GM_LOAD(c) do { const bf16* pr = P + (size_t)((c) * TC + tl) * PROJ_LD; rq = *(const GAS u32x2*)(pr + qcol + dq); rk = *(const GAS u32x2*)(pr + kcol + dq); rv = *(const GAS u32x2*)(pr + vcol + dq); \
        if (MODE == 0) { rg0 = *(const GAS v4u*)(pr + EC_GLR); rg1 = *(const GAS v4u*)(pr + EC_GLR + 8); } } while (0)
#define GM_XFORM(bufi) do { LAS float* B_ = Lf + (bufi) * BUFSZ; f32x4 q4, k4, e4; \
        const float xq[4] = {bf_lo(rq.x), bf_hi(rq.x), bf_lo(rq.y), bf_hi(rq.y)}, xk[4] = {bf_lo(rk.x), bf_hi(rk.x), bf_lo(rk.y), bf_hi(rk.y)}; \
        if (MODE == 0) { f32x4 z = *(const LAS f32x4*)(Lf + O_BIAS + dq); \
            const float gl[16] = {bf_lo(rg0.x), bf_hi(rg0.x), bf_lo(rg0.y), bf_hi(rg0.y), bf_lo(rg0.z), bf_hi(rg0.z), bf_lo(rg0.w), bf_hi(rg0.w), \
                                  bf_lo(rg1.x), bf_hi(rg1.x), bf_lo(rg1.y), bf_hi(rg1.y), bf_lo(rg1.z), bf_hi(rg1.z), bf_lo(rg1.w), bf_hi(rg1.w)}; \
            _Pragma("unroll") for (int r_ = 0; r_ < 16; ++r_) { const f32x4 wv = *(const LAS f32x4*)(Lf + O_W2 + r_ * 128 + dq); z = z + wv * gl[r_]; } \
            _Pragma("unroll") for (int i_ = 0; i_ < 4; ++i_) { q4[i_] = xq[i_] * 0.08838834764831845f; k4[i_] = xk[i_]; e4[i_] = __builtin_amdgcn_exp2f(-0.0625f * __builtin_amdgcn_logf(1.0f + __expf(-z[i_]))); } } \
        else { _Pragma("unroll") for (int i_ = 0; i_ < 4; ++i_) { const float fg = lb[i_] + (1.f - lb[i_]) * sigmoidf_(xk[i_]); q4[i_] = siluf_(xq[i_]); k4[i_] = 1.f - fg; e4[i_] = fg; } } \
        *(LAS f32x4*)(B_ + O_E + tl * 128 + dq) = e4; *(LAS f32x4*)(B_ + O_K + tl * 128 + dq) = k4; *(LAS f32x4*)(B_ + O_Q + tl * 128 + dq) = q4; \
        { f32x4 v4 = {bf_lo(rv.x), bf_hi(rv.x), bf_lo(rv.y), bf_hi(rv.y)}; *(LAS f32x4*)(B_ + O_V + tl * 128 + dq) = v4; } } while (0)
    LBAR();
    GM_LOAD(0); GM_XFORM(0); GM_LOAD(1);
    LBAR();
    f32x4 Sacc[8];
#pragma unroll
    for (int i = 0; i < 8; ++i) Sacc[i] = (f32x4){0.f, 0.f, 0.f, 0.f};
    const int fr = lane & 15, g = lane >> 4, c0 = w * 16;
    for (int c = 0; c < NCHUNK; ++c) {
        const LAS float* B_ = Lf + (c & 1) * BUFSZ;
        {
            const int seg = tid >> 7, d = tid & 127;
            float bt = 1.f, ball = 1.f;
#pragma unroll
            for (int t = 0; t < 16; ++t) { const float e = B_[O_E + t * 128 + d]; ball *= e; if (t < 4 * seg) bt = ball; }
            ball = fmaxf(ball, 1e-30f);
            unsigned short kt4[4];
#pragma unroll
            for (int i = 0; i < 4; ++i) { const int t = 4 * seg + i; bt = fmaxf(bt * B_[O_E + t * 128 + d], 1e-30f);
                const float kk = B_[O_K + t * 128 + d], qq = B_[O_Q + t * 128 + d], ib = __builtin_amdgcn_rcpf(bt);
                QB[t * RS + d] = hw_bf(qq * bt); KB[t * RS + d] = hw_bf(kk * ib); kt4[i] = (unsigned short)hw_bf(kk * ball * ib); }
            u32x2 kw; kw.x = (unsigned)kt4[0] | ((unsigned)kt4[1] << 16); kw.y = (unsigned)kt4[2] | ((unsigned)kt4[3] << 16);
            *(LAS u32x2*)(KT + d * 16 + 4 * seg) = kw;
            if (seg == 3) Lf[O_BL + d] = ball;
        }
        LBAR();
        if (w == 0) {
            f32x4 acc = {0.f, 0.f, 0.f, 0.f};
#pragma unroll
            for (int ks = 0; ks < 4; ++ks) { const bf16x8 af = *(const LAS bf16x8*)(QB + fr * RS + 32 * ks + 8 * g), bfm = *(const LAS bf16x8*)(KB + fr * RS + 32 * ks + 8 * g);
                acc = __builtin_amdgcn_mfma_f32_16x16x32_bf16(af, bfm, acc, 0, 0, 0); }
#pragma unroll
            for (int r = 0; r < 4; ++r) { const int t = 4 * g + r, s = fr; AM[t * 16 + s] = hw_bf(s <= t ? acc[r] : 0.f); }
        }
        if (c + 1 < NCHUNK) GM_XFORM((c + 1) & 1);
        if (c + 2 < NCHUNK) GM_LOAD(c + 2);
        LBAR();
        {
            u32x2 vlo; { const float v0 = B_[O_V + (4 * g + 0) * 128 + c0 + fr], v1 = B_[O_V + (4 * g + 1) * 128 + c0 + fr], v2 = B_[O_V + (4 * g + 2) * 128 + c0 + fr], v3 = B_[O_V + (4 * g + 3) * 128 + c0 + fr];
                vlo.x = hw_pk2(v0, v1); vlo.y = hw_pk2(v2, v3); }
            const u32x2 zz = {0u, 0u};
            const bf16x8 vb = mk_frag(vlo, zz);
            f32x4 acco = {0.f, 0.f, 0.f, 0.f};
#pragma unroll
            for (int ks = 0; ks < 4; ++ks) {
                u32x2 slo, shi; slo.x = hw_pk2(Sacc[2 * ks][0], Sacc[2 * ks][1]); slo.y = hw_pk2(Sacc[2 * ks][2], Sacc[2 * ks][3]); shi.x = hw_pk2(Sacc[2 * ks + 1][0], Sacc[2 * ks + 1][1]); shi.y = hw_pk2(Sacc[2 * ks + 1][2], Sacc[2 * ks + 1][3]);
                const bf16x8 sb = mk_frag(slo, shi);
                const u32x2 qlo = *(const LAS u32x2*)(QB + fr * RS + 32 * ks + 4 * g), qhi = *(const LAS u32x2*)(QB + fr * RS + 32 * ks + 16 + 4 * g);
                acco = __builtin_amdgcn_mfma_f32_16x16x32_bf16(mk_frag(qlo, qhi), sb, acco, 0, 0, 0); }
            { const u32x2 alo = *(const LAS u32x2*)(AM + fr * 16 + 4 * g); acco = __builtin_amdgcn_mfma_f32_16x16x32_bf16(mk_frag(alo, zz), vb, acco, 0, 0, 0); }
#pragma unroll
            for (int r = 0; r < 4; ++r) O[(size_t)(c * TC + 4 * g + r) * D + c0 + fr] = hw_bf(acco[r]);
#pragma unroll
            for (int i = 0; i < 8; ++i) { const f32x4 bl = *(const LAS f32x4*)(Lf + O_BL + 16 * i + 4 * g); const u32x2 klo = *(const LAS u32x2*)(KT + (16 * i + fr) * 16 + 4 * g);
                Sacc[i] = __builtin_amdgcn_mfma_f32_16x16x32_bf16(mk_frag(klo, zz), vb, Sacc[i] * bl, 0, 0, 0); }
        }
        LBAR();
    }
#undef GM_LOAD
#undef GM_XFORM
}

__device__ __forceinline__ void scan_gdn_mfma_unit(const Args& A, Frame& F, int unit, const int role) {
    int tid = F.tid; asm volatile("" : "+v"(tid));
    const int lane = tid & 63, w = F.wave;
    const int b = unit >> 3, h = unit & 7;
    const int qcol = EC_BQ + h * 128, kcol = EC_BK + h * 128, vcol = EC_BV + h * 128, ocol = 1024 + h * 128;
    const bf16* P = (const bf16*)(A.ws + WS_PROJ) + (size_t)b * SEQ * PROJ_LD;
    bf16* O = (bf16*)(A.ws + WS_O) + (size_t)b * SEQ * D + ocol;
    LAS float* Lf = (LAS float*)(F.lds + RING_OFF);
    constexpr int O_CW = 0, O_AMAT = 1536, O_QKM = O_AMAT + 256, O_TB = O_QKM + 128, O_GL = O_TB + 128, O_BUF0 = O_GL + 64;
    constexpr int BUFSZ = 6208, O_KH = 0, O_QH = 2048, O_VV = 4096, O_SC = 6144;
    constexpr int RS = 136;
    constexpr int O_KHB = O_BUF0 + 2 * BUFSZ, O_QHB = O_KHB + 1088, O_QB = O_QHB + 1088, O_KT = O_QB + 1088, O_WSRC = O_KT + 1024, O_WB = O_WSRC + 2048;
    LAS bf16* KHB = (LAS bf16*)(Lf + O_KHB); LAS bf16* QHB = (LAS bf16*)(Lf + O_QHB); LAS bf16* QB = (LAS bf16*)(Lf + O_QB); LAS bf16* KT = (LAS bf16*)(Lf + O_KT);
    LAS bf16* WB = (LAS bf16*)(Lf + O_WB); LAS bf16* QKM = (LAS bf16*)(Lf + O_QKM); LAS bf16* TB = (LAS bf16*)(Lf + O_TB);
    const int tl = tid >> 5, dq = (tid & 31) * 4;
    { const float* cw = A.in[I_GDN_CONV];
      for (int i = tid; i < 4 * 384; i += NTHREADS) { const int jt = i / 384, x = i % 384; Lf[O_CW + i] = cw[jt * 3072 + (x >> 7) * 1024 + h * 128 + (x & 127)]; } }
    const float neg_ea = -__expf(A.in[I_GDN_ALOG][h]), dtb = A.in[I_GDN_DTB][h];
    u32x2 rq[4], rk[4], rv[4]; unsigned short rba = 0, rbb = 0;
#define GD_LOAD(c) do { const int t_ = (c) * TC + tl; \
        _Pragma("unroll") for (int jt = 0; jt < 4; ++jt) { const int tt = t_ - 3 + jt; const bf16* pr = P + (size_t)(tt < 0 ? 0 : tt) * PROJ_LD + dq; \
            rq[jt] = *(const GAS u32x2*)(pr + qcol); rk[jt] = *(const GAS u32x2*)(pr + kcol); rv[jt] = *(const GAS u32x2*)(pr + vcol); \
            if (tt < 0) { rq[jt] = (u32x2){0u, 0u}; rk[jt] = (u32x2){0u, 0u}; rv[jt] = (u32x2){0u, 0u}; } } \
        { const bf16* pr = P + (size_t)t_ * PROJ_LD; rba = pr[EC_BA + h]; rbb = pr[EC_BB + h]; } } while (0)
#define GD_XFORM(bufi) do { LAS float* B_ = Lf + O_BUF0 + (bufi) * BUFSZ; f32x4 q4 = {0.f, 0.f, 0.f, 0.f}, k4 = {0.f, 0.f, 0.f, 0.f}, v4 = {0.f, 0.f, 0.f, 0.f}; \
        _Pragma("unroll") for (int jt = 0; jt < 4; ++jt) { const f32x4 wq = *(const LAS f32x4*)(Lf + O_CW + jt * 384 + dq), wk = *(const LAS f32x4*)(Lf + O_CW + jt * 384 + 128 + dq), wv = *(const LAS f32x4*)(Lf + O_CW + jt * 384 + 256 + dq); \
            q4[0] += wq[0] * bf_lo(rq[jt].x); q4[1] += wq[1] * bf_hi(rq[jt].x); q4[2] += wq[2] * bf_lo(rq[jt].y); q4[3] += wq[3] * bf_hi(rq[jt].y); \
            k4[0] += wk[0] * bf_lo(rk[jt].x); k4[1] += wk[1] * bf_hi(rk[jt].x); k4[2] += wk[2] * bf_lo(rk[jt].y); k4[3] += wk[3] * bf_hi(rk[jt].y); \
            v4[0] += wv[0] * bf_lo(rv[jt].x); v4[1] += wv[1] * bf_hi(rv[jt].x); v4[2] += wv[2] * bf_lo(rv[jt].y); v4[3] += wv[3] * bf_hi(rv[jt].y); } \
        float sq = 0.f, sk = 0.f; \
        _Pragma("unroll") for (int i_ = 0; i_ < 4; ++i_) { q4[i_] = siluf_(q4[i_]); k4[i_] = siluf_(k4[i_]); v4[i_] = siluf_(v4[i_]); sq += q4[i_] * q4[i_]; sk += k4[i_] * k4[i_]; } \
        row_sum16_x2(sq, sk); sq += __shfl_xor(sq, 16); sk += __shfl_xor(sk, 16); \
        q4 = q4 * (__builtin_amdgcn_rsqf(sq + EPS) * 0.08838834764831845f); k4 = k4 * __builtin_amdgcn_rsqf(sk + EPS); \
        *(LAS f32x4*)(B_ + O_KH + tl * 128 + dq) = k4; *(LAS f32x4*)(B_ + O_QH + tl * 128 + dq) = q4; *(LAS f32x4*)(B_ + O_VV + tl * 128 + dq) = v4; \
        if ((tid & 31) == 0) { const float ba = __uint_as_float((unsigned)rba << 16), bb = __uint_as_float((unsigned)rbb << 16); \
            B_[O_SC + tl] = __expf(neg_ea * softplusf_(ba + dtb)); B_[O_SC + 16 + tl] = sigmoidf_(bb); } } while (0)
    LBAR();
    constexpr int SPLIT = 58;
    const int c_begin = role ? SPLIT : 0, c_end = role ? NCHUNK : SPLIT;
    constexpr int REC = 5408;
    float* STASH = (float*)(A.ws + WS_LA) + (size_t)unit * (NCHUNK - SPLIT) * REC;
    float* STATE = (float*)(A.ws + WS_STATE) + (size_t)unit * 16384;
    gu32* flag = F.ctl + 32768 + unit * 64;
    GD_LOAD(c_begin); GD_XFORM(c_begin & 1); GD_LOAD(c_begin + 1);
    LBAR();
    f32x4 Sacc[8];
#pragma unroll
    for (int i = 0; i < 8; ++i) Sacc[i] = (f32x4){0.f, 0.f, 0.f, 0.f};
    const int fr = lane & 15, g = lane >> 4, c0 = w * 16;
    const u32x2 zz = {0u, 0u};
#define GD_STATE_PART(cc_) do { \
        { \
            bf16x8 sb[4]; \
_Pragma("unroll") \
            for (int ks = 0; ks < 4; ++ks) { u32x2 slo, shi; slo.x = hw_pk2(Sacc[2 * ks][0], Sacc[2 * ks][1]); slo.y = hw_pk2(Sacc[2 * ks][2], Sacc[2 * ks][3]); shi.x = hw_pk2(Sacc[2 * ks + 1][0], Sacc[2 * ks + 1][1]); shi.y = hw_pk2(Sacc[2 * ks + 1][2], Sacc[2 * ks + 1][3]); \
                sb[ks] = mk_frag(slo, shi); } \
            f32x4 accv = accu, acco = {0.f, 0.f, 0.f, 0.f}; \
_Pragma("unroll") \
            for (int ks = 0; ks < 4; ++ks) { \
                const u32x2 wl = *(const LAS u32x2*)(WB + fr * RS + 32 * ks + 4 * g), wh = *(const LAS u32x2*)(WB + fr * RS + 32 * ks + 16 + 4 * g); \
                accv = __builtin_amdgcn_mfma_f32_16x16x32_bf16(mk_frag(wl, wh), sb[ks], accv, 0, 0, 0); \
                const u32x2 ql = *(const LAS u32x2*)(QB + fr * RS + 32 * ks + 4 * g), qh = *(const LAS u32x2*)(QB + fr * RS + 32 * ks + 16 + 4 * g); \
                acco = __builtin_amdgcn_mfma_f32_16x16x32_bf16(mk_frag(ql, qh), sb[ks], acco, 0, 0, 0); } \
            u32x2 vn; vn.x = hw_pk2(accv[0], accv[1]); vn.y = hw_pk2(accv[2], accv[3]); \
            const bf16x8 vnb = mk_frag(vn, zz); \
            acco = __builtin_amdgcn_mfma_f32_16x16x32_bf16(mk_frag(*(const LAS u32x2*)(QKM + fr * 16 + 4 * g), zz), vnb, acco, 0, 0, 0); \
_Pragma("unroll") \
            for (int r = 0; r < 4; ++r) O[(size_t)((cc_) * TC + 4 * g + r) * D + c0 + fr] = hw_bf(acco[r]); \
_Pragma("unroll") \
            for (int i = 0; i < 8; ++i) { const u32x2 klo = *(const LAS u32x2*)(KT + (16 * i + fr) * 16 + 4 * g); \
                Sacc[i] = __builtin_amdgcn_mfma_f32_16x16x32_bf16(mk_frag(klo, zz), vnb, Sacc[i] * glast, 0, 0, 0); } \
        } \
        } while (0)
    for (int c = c_begin; c < c_end; ++c) {
        const LAS float* B_ = Lf + O_BUF0 + (c & 1) * BUFSZ;
        float glast;
        {
            const int seg = tid >> 7, d = tid & 127;
            const f32x4 a0 = *(const LAS f32x4*)(B_ + O_SC), a1 = *(const LAS f32x4*)(B_ + O_SC + 4), a2 = *(const LAS f32x4*)(B_ + O_SC + 8), a3 = *(const LAS f32x4*)(B_ + O_SC + 12);
            const float av[16] = {a0[0], a0[1], a0[2], a0[3], a1[0], a1[1], a1[2], a1[3], a2[0], a2[1], a2[2], a2[3], a3[0], a3[1], a3[2], a3[3]};
            float p = 1.f, gpre = 1.f;
#pragma unroll
            for (int t = 0; t < 16; ++t) { if (t == 4 * seg) gpre = p; p *= av[t]; }
            glast = p;
            unsigned short kt4[4]; float gt = gpre;
#pragma unroll
            for (int i = 0; i < 4; ++i) { const int t = 4 * seg + i; const float at = (seg == 0) ? av[i] : (seg == 1) ? av[4 + i] : (seg == 2) ? av[8 + i] : av[12 + i]; gt *= at; const float beta = B_[O_SC + 16 + t];
                const float kk = B_[O_KH + t * 128 + d], qq = B_[O_QH + t * 128 + d];
                KHB[t * RS + d] = hw_bf(kk); QHB[t * RS + d] = hw_bf(qq); QB[t * RS + d] = hw_bf(qq * gt);
                kt4[i] = (unsigned short)hw_bf(kk * glast * __builtin_amdgcn_rcpf(gt));
                Lf[O_WSRC + t * 128 + d] = kk * (beta * gt);
                if (d == 0) Lf[O_GL + t] = gt; }
            u32x2 kw; kw.x = (unsigned)kt4[0] | ((unsigned)kt4[1] << 16); kw.y = (unsigned)kt4[2] | ((unsigned)kt4[3] << 16);
            *(LAS u32x2*)(KT + d * 16 + 4 * seg) = kw;
        }
        LBAR();
        if (w < 2) {
            const LAS bf16* AS = (w == 0) ? KHB : QHB;
            f32x4 acc = {0.f, 0.f, 0.f, 0.f};
#pragma unroll
            for (int ks = 0; ks < 4; ++ks) { const bf16x8 af = *(const LAS bf16x8*)(AS + fr * RS + 32 * ks + 8 * g), bfm = *(const LAS bf16x8*)(KHB + fr * RS + 32 * ks + 8 * g);
                acc = __builtin_amdgcn_mfma_f32_16x16x32_bf16(af, bfm, acc, 0, 0, 0); }
            const float gs_inv = __builtin_amdgcn_rcpf(Lf[O_GL + fr]);
            if (w == 0) {
                f32x4 N1, M1;
#pragma unroll
                for (int r = 0; r < 4; ++r) { const int t = 4 * g + r; const float gt = Lf[O_GL + t];
                    N1[r] = (fr < t) ? -(B_[O_SC + 16 + t] * acc[r] * gt * gs_inv) : 0.f;
                    M1[r] = (t < fr) ? -(B_[O_SC + 16 + fr] * acc[r] * Lf[O_GL + fr] * __builtin_amdgcn_rcpf(gt)) : 0.f; }
#define XTY(X, Y, C0) __builtin_amdgcn_mfma_f32_16x16x32_bf16(mk_frag((u32x2){hw_pk2(X[0], X[1]), hw_pk2(X[2], X[3])}, zz), mk_frag((u32x2){hw_pk2(Y[0], Y[1]), hw_pk2(Y[2], Y[3])}, zz), C0, 0, 0, 0)
                const f32x4 z4 = {0.f, 0.f, 0.f, 0.f};
                f32x4 T1t = M1;
#pragma unroll
                for (int r = 0; r < 4; ++r) if (4 * g + r == fr) T1t[r] += 1.f;
                const f32x4 N2 = XTY(M1, N1, z4), M2 = XTY(N1, M1, z4);
                const f32x4 T2t = XTY(N2, T1t, T1t);
                const f32x4 N4 = XTY(M2, N2, z4), M4 = XTY(N2, M2, z4);
                const f32x4 T4t = XTY(N4, T2t, T2t);
                const f32x4 N8 = XTY(M4, N4, z4);
                const f32x4 T8t = XTY(N8, T4t, T4t);
#undef XTY
                u32x2 tw; tw.x = hw_pk2(T8t[0], T8t[1]); tw.y = hw_pk2(T8t[2], T8t[3]);
                *(LAS u32x2*)(TB + fr * 16 + 4 * g) = tw;
            } else {
#pragma unroll
                for (int r = 0; r < 4; ++r) { const int t = 4 * g + r; QKM[t * 16 + fr] = hw_bf((fr <= t) ? acc[r] * Lf[O_GL + t] * gs_inv : 0.f); }
            }
        }
        if (c + 1 < c_end) GD_XFORM((c + 1) & 1);
        if (c + 2 < c_end) GD_LOAD(c + 2);
        LBAR();
        f32x4 accu = {0.f, 0.f, 0.f, 0.f};
        {
            const bf16x8 tf = mk_frag(*(const LAS u32x2*)(TB + fr * 16 + 4 * g), zz);
            u32x2 ulo, wlo;
            { const float b0 = B_[O_SC + 16 + 4 * g + 0], b1 = B_[O_SC + 16 + 4 * g + 1], b2 = B_[O_SC + 16 + 4 * g + 2], b3 = B_[O_SC + 16 + 4 * g + 3];
              ulo.x = hw_pk2(b0 * B_[O_VV + (4 * g + 0) * 128 + c0 + fr], b1 * B_[O_VV + (4 * g + 1) * 128 + c0 + fr]); ulo.y = hw_pk2(b2 * B_[O_VV + (4 * g + 2) * 128 + c0 + fr], b3 * B_[O_VV + (4 * g + 3) * 128 + c0 + fr]);
              wlo.x = hw_pk2(Lf[O_WSRC + (4 * g + 0) * 128 + c0 + fr], Lf[O_WSRC + (4 * g + 1) * 128 + c0 + fr]); wlo.y = hw_pk2(Lf[O_WSRC + (4 * g + 2) * 128 + c0 + fr], Lf[O_WSRC + (4 * g + 3) * 128 + c0 + fr]); }
            accu = __builtin_amdgcn_mfma_f32_16x16x32_bf16(tf, mk_frag(ulo, zz), accu, 0, 0, 0);
            f32x4 accw = {0.f, 0.f, 0.f, 0.f};
            accw = __builtin_amdgcn_mfma_f32_16x16x32_bf16(tf, mk_frag(wlo, zz), accw, 0, 0, 0);
#pragma unroll
            for (int r = 0; r < 4; ++r) WB[(4 * g + r) * RS + c0 + fr] = hw_bf(-accw[r]);
        }
        LBAR();
        if (role == 0) {
            GD_STATE_PART(c);
        } else {
            float* rec = STASH + (size_t)(c - c_begin) * REC;
            for (int i = tid; i < 832; i += NTHREADS) { const int o = i < 528 ? O_QB + 4 * i : (i < 800 ? O_WB + 4 * (i - 528) : O_QKM + 4 * (i - 800)); *(GAS f32x4*)(rec + 4 * i) = *(const LAS f32x4*)(Lf + o); }
#pragma unroll
            for (int r = 0; r < 4; ++r) rec[3328 + (w * 4 + r) * 64 + lane] = accu[r];
            if (tid == 0) rec[5376] = glast;
        }
        LBAR();
    }
    if (role == 0) {
#pragma unroll
        for (int i = 0; i < 8; ++i)
#pragma unroll
            for (int r = 0; r < 4; ++r) STATE[((w * 8 + i) * 4 + r) * 64 + lane] = Sacc[i][r];
        asm volatile("s_waitcnt vmcnt(0)" ::: "memory");
        __syncthreads();
        if (tid == 0) { __builtin_amdgcn_fence(__ATOMIC_RELEASE, "agent"); asm volatile("s_waitcnt vmcnt(0)" ::: "memory"); __hip_atomic_store(flag, 1u, __ATOMIC_RELAXED, __HIP_MEMORY_SCOPE_AGENT); }
    } else {
        if (tid == 0) { unsigned sp = 0; while (__hip_atomic_load(flag, __ATOMIC_RELAXED, __HIP_MEMORY_SCOPE_AGENT) == 0u) { __builtin_amdgcn_s_sleep(8); if (++sp > (1u << 22)) break; }
            __builtin_amdgcn_fence(__ATOMIC_ACQUIRE, "agent"); asm volatile("s_waitcnt vmcnt(0)" ::: "memory"); }
        __syncthreads();
#pragma unroll
        for (int i = 0; i < 8; ++i)
#pragma unroll
            for (int r = 0; r < 4; ++r) Sacc[i][r] = STATE[((w * 8 + i) * 4 + r) * 64 + lane];
        f32x4 pa, pb; f32x4 pu; float pg;
#define GD_REC_LOAD(cc) do { const float* rec = STASH + (size_t)((cc) - c_begin) * REC; pa = *(const GAS f32x4*)(rec + 4 * tid); pb = (tid < 320) ? *(const GAS f32x4*)(rec + 4 * (tid + 512)) : (f32x4){0.f, 0.f, 0.f, 0.f}; \
            _Pragma("unroll") for (int r = 0; r < 4; ++r) pu[r] = rec[3328 + (w * 4 + r) * 64 + lane]; pg = rec[5376]; } while (0)
        GD_REC_LOAD(c_begin);
        for (int c = c_begin; c < c_end; ++c) {
            { const int i0 = tid, o0 = i0 < 528 ? O_QB + 4 * i0 : O_WB + 4 * (i0 - 528); *(LAS f32x4*)(Lf + o0) = pa;
              if (tid < 320) { const int i1 = tid + 512; const int o1 = i1 < 528 ? O_QB + 4 * i1 : (i1 < 800 ? O_WB + 4 * (i1 - 528) : O_QKM + 4 * (i1 - 800)); *(LAS f32x4*)(Lf + o1) = pb; } }
            const f32x4 accu = pu; const float glast = pg;
            if (c + 1 < c_end) GD_REC_LOAD(c + 1);
            LBAR();
            GD_STATE_PART(c);
            LBAR();
        }
#undef GD_REC_LOAD
    }
#undef GD_STATE_PART
#undef GD_LOAD
#undef GD_XFORM
}

__device__ __forceinline__ void scan_rwkv_unit(const Args& A, Frame& F, int unit) {
    int tid = F.tid; asm volatile("" : "+v"(tid));
    const int lane = tid & 63, w = F.wave;
    const int b = unit >> 4, h = unit & 15;
    const bf16* P = (const bf16*)(A.ws + WS_PROJ) + (size_t)b * SEQ * PROJ_LD + OC_RW;
    const bf16* LO = (const bf16*)(A.ws + WS_LO) + (size_t)b * SEQ * LORA_N;
    bf16* Y = (bf16*)(A.ws + WS_ACTA) + (size_t)b * SEQ * D + 1024 + h * 64;
    LAS float* Lf = (LAS float*)(F.lds + RING_OFF);
    constexpr int BUFSZ = 6208, O_KK = 0, O_WR = 1024, O_W = 2048, O_NKA = 3072, O_K = 4096, O_V = 5120, O_SC = 6144, O_OUT = 2 * BUFSZ;
    const int tl = tid >> 5, d2 = (tid & 31) * 2, hd = h * 64 + d2;
    float mu_r[2], mu_k[2], mu_v[2], w0[2], a0[2], k_k[2], k_a[2], r_k[2], lnw[2], lnb[2];
#pragma unroll
    for (int i = 0; i < 2; ++i) { mu_r[i] = A.in[I_MU][RW_R + hd + i]; mu_k[i] = A.in[I_MU][RW_K + hd + i]; mu_v[i] = A.in[I_MU][RW_V + hd + i];
        w0[i] = A.in[I_W0][hd + i]; a0[i] = A.in[I_A0][hd + i]; k_k[i] = A.in[I_KK][hd + i]; k_a[i] = A.in[I_KA][hd + i]; r_k[i] = A.in[I_RK][hd + i];
        lnw[i] = A.in[I_LNW][hd + i]; lnb[i] = A.in[I_LNB][hd + i]; }
    unsigned rr[2], rk[2], rv[2], rlw, rla, rg_cur = 0u, rg_nxt = 0u;
#define RW_LOAD(c) do { const int t_ = (c) * TC + tl; const bf16* pr = P + (size_t)t_ * PROJ_LD; \
        rr[0] = *(const GAS unsigned*)(pr + RW_R + hd); rk[0] = *(const GAS unsigned*)(pr + RW_K + hd); rv[0] = *(const GAS unsigned*)(pr + RW_V + hd); \
        if (t_ > 0) { rr[1] = *(const GAS unsigned*)(pr - PROJ_LD + RW_R + hd); rk[1] = *(const GAS unsigned*)(pr - PROJ_LD + RW_K + hd); rv[1] = *(const GAS unsigned*)(pr - PROJ_LD + RW_V + hd); } \
        else { rr[1] = 0u; rk[1] = 0u; rv[1] = 0u; } \
        const bf16* lr = LO + (size_t)t_ * LORA_N; rlw = *(const GAS unsigned*)(lr + hd); rla = *(const GAS unsigned*)(lr + 1024 + hd); rg_nxt = *(const GAS unsigned*)(lr + 2048 + hd); } while (0)
#define RW_XFORM(bufi) do { LAS float* B_ = Lf + (bufi) * BUFSZ; f32x2 kk2, wr2, w2_, nka2, k2, v2_; float skk = 0.f, sc1 = 0.f, sc2 = 0.f, sbs = 0.f; float aa[2], rrv[2]; \
        _Pragma("unroll") for (int i_ = 0; i_ < 2; ++i_) { \
            const float r0 = i_ ? bf_hi(rr[0]) : bf_lo(rr[0]), r1 = i_ ? bf_hi(rr[1]) : bf_lo(rr[1]); \
            const float k0_ = i_ ? bf_hi(rk[0]) : bf_lo(rk[0]), k1_ = i_ ? bf_hi(rk[1]) : bf_lo(rk[1]); \
            const float v0_ = i_ ? bf_hi(rv[0]) : bf_lo(rv[0]), v1_ = i_ ? bf_hi(rv[1]) : bf_lo(rv[1]); \
            const float lw = i_ ? bf_hi(rlw) : bf_lo(rlw), la = i_ ? bf_hi(rla) : bf_lo(rla); \
            const float r_ = r0 + (r1 - r0) * mu_r[i_], kx = k0_ + (k1_ - k0_) * mu_k[i_], vx = v0_ + (v1_ - v0_) * mu_v[i_]; \
            const float wd = __expf(-0.6065306597126334f * sigmoidf_(w0[i_] + lw)); const float a_ = sigmoidf_(a0[i_] + la); \
            const float kk0 = kx * k_k[i_]; const float km = kx * (1.f + (a_ - 1.f) * k_a[i_]); \
            kk2[i_] = kk0; skk += kk0 * kk0; aa[i_] = a_; rrv[i_] = r_; wr2[i_] = wd * r_; w2_[i_] = wd; k2[i_] = km; v2_[i_] = vx; sc2 += km * r_; sbs += r_ * km * r_k[i_]; } \
        skk = half_sum32(skk); const float rkk = __builtin_amdgcn_rsqf(skk + EPS); \
        _Pragma("unroll") for (int i_ = 0; i_ < 2; ++i_) { kk2[i_] *= rkk; nka2[i_] = -(kk2[i_] * aa[i_]); sc1 += kk2[i_] * aa[i_] * rrv[i_]; } \
        sc1 = half_sum32(sc1); sc2 = half_sum32(sc2); sbs = half_sum32(sbs); \
        *(LAS f32x2*)(B_ + O_KK + tl * 64 + d2) = kk2; *(LAS f32x2*)(B_ + O_WR + tl * 64 + d2) = wr2; *(LAS f32x2*)(B_ + O_W + tl * 64 + d2) = w2_; \
        *(LAS f32x2*)(B_ + O_NKA + tl * 64 + d2) = nka2; *(LAS f32x2*)(B_ + O_K + tl * 64 + d2) = k2; *(LAS f32x2*)(B_ + O_V + tl * 64 + d2) = v2_; \
        if ((tid & 31) == 0) { f32x4 sc; sc[0] = sc1; sc[1] = sc2; sc[2] = sbs; sc[3] = 0.f; *(LAS f32x4*)(B_ + O_SC + tl * 4) = sc; } } while (0)
    RW_LOAD(0); RW_XFORM(0); rg_cur = rg_nxt;
    LBAR();
    f32x2 S2[4];
#pragma unroll
    for (int i = 0; i < 4; ++i) S2[i] = (f32x2){0.f, 0.f};
    const int j = lane & 15, col = w * 8 + (lane >> 4) * 2;
    for (int c = 0; c < NCHUNK; ++c) {
        if (c + 1 < NCHUNK) RW_LOAD(c + 1);
        const LAS float* B_ = Lf + (c & 1) * BUFSZ;
        float os0 = 0.f, os1 = 0.f;
        f32x4 kk, wr, ww, nka, kv, sc, nkk, nwr, nww, nnka, nkv, nsc; f32x2 v2, nv2;
#define RW_LDSTEP(t_, KK, WR, WW, NKA, KV, V2, SC) do { KK = *(const LAS f32x4*)(B_ + O_KK + (t_) * 64 + 4 * j); WR = *(const LAS f32x4*)(B_ + O_WR + (t_) * 64 + 4 * j); WW = *(const LAS f32x4*)(B_ + O_W + (t_) * 64 + 4 * j); \
            NKA = *(const LAS f32x4*)(B_ + O_NKA + (t_) * 64 + 4 * j); KV = *(const LAS f32x4*)(B_ + O_K + (t_) * 64 + 4 * j); V2 = *(const LAS f32x2*)(B_ + O_V + (t_) * 64 + col); SC = *(const LAS f32x4*)(B_ + O_SC + (t_) * 4); } while (0)
        RW_LDSTEP(0, kk, wr, ww, nka, kv, v2, sc);
#pragma unroll
        for (int t = 0; t < TC; ++t) {
            if (t + 1 < TC) { RW_LDSTEP(t + 1, nkk, nwr, nww, nnka, nkv, nv2, nsc); }
            __builtin_amdgcn_sched_barrier(0);
            f32x2 d1 = S2[0] * kk[0], d2 = S2[0] * wr[0], e1 = S2[1] * kk[1], e2 = S2[1] * wr[1];
            d1 += S2[2] * kk[2]; d2 += S2[2] * wr[2]; e1 += S2[3] * kk[3]; e2 += S2[3] * wr[3];
            d1 += e1; d2 += e2;
            { float r0_ = d1[0], r1_ = d1[1], r2_ = d2[0], r3_ = d2[1]; row_sum16_x4(r0_, r1_, r2_, r3_); d1[0] = r0_; d1[1] = r1_; d2[0] = r2_; d2[1] = r3_; }
            const f32x2 o2 = d2 - d1 * sc[0] + v2 * sc[1];
#pragma unroll
            for (int i = 0; i < 4; ++i) S2[i] = S2[i] * ww[i] + d1 * nka[i] + v2 * kv[i];
            os0 = (j == t) ? o2[0] : os0; os1 = (j == t) ? o2[1] : os1;
            kk = nkk; wr = nwr; ww = nww; nka = nnka; kv = nkv; v2 = nv2; sc = nsc;
        }
#undef RW_LDSTEP
        { f32x2 o2 = {os0, os1}; *(LAS f32x2*)(Lf + O_OUT + j * 64 + col) = o2; }
        if (c + 1 < NCHUNK) RW_XFORM((c + 1) & 1);
        LBAR();
        {
            const f32x2 o2 = *(const LAS f32x2*)(Lf + O_OUT + tl * 64 + d2); const f32x2 vv = *(const LAS f32x2*)(B_ + O_V + tl * 64 + d2); const float bs = B_[O_SC + tl * 4 + 2];
            const float mean = half_sum32(o2[0] + o2[1]) * (1.0f / 64.0f); const float e0 = o2[0] - mean, e1 = o2[1] - mean;
            const float var = half_sum32(e0 * e0 + e1 * e1) * (1.0f / 64.0f); const float rs = __builtin_amdgcn_rsqf(var + 64e-5f);
            const float y0 = (e0 * rs * lnw[0] + lnb[0] + bs * vv[0]) * bf_lo(rg_cur), y1 = (e1 * rs * lnw[1] + lnb[1] + bs * vv[1]) * bf_hi(rg_cur);
            *(GAS unsigned*)(Y + (size_t)(c * TC + tl) * D + d2) = pk2(y0, y1);
        }
        rg_cur = rg_nxt;
        LBAR();
    }
#undef RW_LOAD
#undef RW_XFORM
}

template <int LAYER>
__device__ __forceinline__ void post_rows(const Args& A, Frame& F) {
    const int gw = F.vcu * NWAVES + F.wave, NGW = F.G * NWAVES, lane = F.lane;
    const bf16* O = (const bf16*)(A.ws + WS_O); const bf16* P = (const bf16*)(A.ws + WS_PROJ); bf16* Y = (bf16*)(A.ws + WS_ACTA);
    for (int m = gw; m < T; m += NGW) {
        const GAS u32x2* orow = (const GAS u32x2*)(O + (size_t)m * D) + lane; const bf16* prow = P + (size_t)m * PROJ_LD;
        constexpr int NJ = LAYER == 0 ? 8 : 4;
#pragma unroll
        for (int jj = 0; jj < NJ; ++jj) {
            const u32x2 ow_ = orow[64 * jj]; const f32x4 v = {bf_lo(ow_.x), bf_hi(ow_.x), bf_lo(ow_.y), bf_hi(ow_.y)}; float ss = (v[0] * v[0] + v[1] * v[1]) + (v[2] * v[2] + v[3] * v[3]);
            const bool wide = (LAYER == 0 && jj < 4);
            const float ms = wide ? wave_sum(ss) * (1.0f / 256.0f) : half_sum32(ss) * (1.0f / 128.0f);
            const float r = __builtin_amdgcn_rsqf(ms + EPS);
            const int cih = wide ? 4 * lane : 4 * (lane & 31);
            const float* gsrc = LAYER == 0 ? (wide ? A.in[I_GLA_NORM] : A.in[I_GDN_NORM]) : A.in[I_HG_NORM];
            const f32x4 g = *(const GAS f32x4*)(gsrc + cih);
            const int zcol = LAYER == 0 ? (wide ? EC_GZ + jj * 256 + 4 * lane : EC_BZ + (jj - 4) * 256 + 4 * lane) : OC_HG + jj * 256 + 4 * lane;
            const u32x2 zw = *(const GAS u32x2*)(prow + zcol);
            const float y0 = v[0] * r * g[0] * siluf_(bf_lo(zw.x)), y1 = v[1] * r * g[1] * siluf_(bf_hi(zw.x)), y2 = v[2] * r * g[2] * siluf_(bf_lo(zw.y)), y3 = v[3] * r * g[3] * siluf_(bf_hi(zw.y));
            if constexpr (LAYER == 1) { int o8 = __builtin_amdgcn_cvt_pk_fp8_f32(y0, y1, 0, false); o8 = __builtin_amdgcn_cvt_pk_fp8_f32(y2, y3, o8, true);
                *(GAS unsigned*)((unsigned char*)Y + (size_t)m * D + 256 * jj + 4 * lane) = (unsigned)o8; }
            else { u32x2 o; o.x = pk2(y0, y1); o.y = pk2(y2, y3);
                *(GAS u32x2*)(Y + (size_t)m * D + 256 * jj + 4 * lane) = o; }
        }
    }
}
__device__ __forceinline__ void lora_prep_rows(const Args& A, Frame& F) {
    const int gw = F.vcu * NWAVES + F.wave, NGW = F.G * NWAVES, lane = F.lane;
    const bf16* P = (const bf16*)(A.ws + WS_PROJ); bf16* LA = (bf16*)(A.ws + WS_LA); const float* mu = A.in[I_MU];
    for (int m = gw; m < T; m += NGW) { const bool hasprev = (m % SEQ) != 0; const bf16* prow = P + (size_t)m * PROJ_LD + OC_RW + RW_WL;
#pragma unroll
        for (int i = 0; i < 7; ++i) { const int c = lane + 64 * i;
            const float x = __uint_as_float((unsigned)prow[c] << 16), xp = hasprev ? __uint_as_float((unsigned)prow[c - PROJ_LD] << 16) : 0.f;
            const float ts = x + (xp - x) * mu[RW_WL + c];
            const float v = c < 96 ? tanhf(ts) : (c < 192 ? ts : sigmoidf_(ts));
            LA[(size_t)m * LORA_K + c] = (bf16)f2bf(v); }
        LA[(size_t)m * LORA_K + 448 + lane] = (bf16)0; }
}
__device__ __forceinline__ void final_rows(const Args& A, Frame& F, const float oscale, const bf16* Hs) {
    const int gw = F.vcu * NWAVES + F.wave, NGW = F.G * NWAVES, lane = F.lane;
    const float* rowss = (const float*)(A.ws + WS_RSP) + (size_t)RS_FINAL * T * 32; const GAS f32x4* g = (const GAS f32x4*)A.in[I_NFINAL] + lane;
    for (int m = gw; m < T; m += NGW) { const float r = oscale * __builtin_amdgcn_rsqf(wave_sum(lane < 32 ? rowss[(size_t)m * 32 + lane] : 0.f) * (1.0f / D) + EPS); GAS f32x4* row = (GAS f32x4*)(A.out + (size_t)m * D) + lane;
        const GAS u32x2* hrow = (const GAS u32x2*)(Hs + (size_t)m * D) + lane;
#pragma unroll
        for (int jj = 0; jj < 8; ++jj) { const u32x2 hw = hrow[64 * jj]; const f32x4 v = {bf_lo(hw.x), bf_hi(hw.x), bf_lo(hw.y), bf_hi(hw.y)}; row[64 * jj] = v * r * g[64 * jj]; } }
}

__device__ __forceinline__ void scan_rwkv_mfma_unit(const Args& A, Frame& F, int unit, const int role) {
    int tid = F.tid; asm volatile("" : "+v"(tid));
    const int lane = tid & 63, w = F.wave;
    const int b = unit >> 3, hp = unit & 7;
    const bf16* P = (const bf16*)(A.ws + WS_PROJ) + (size_t)b * SEQ * PROJ_LD + OC_RW;
    const bf16* LO = (const bf16*)(A.ws + WS_LO) + (size_t)b * SEQ * LORA_N;
    unsigned char* Y = (unsigned char*)(A.ws + WS_ACTA) + (size_t)b * SEQ * D + 1024;
    LAS float* Lf = (LAS float*)(F.lds + RING_OFF);
    constexpr int RS = 72;
    constexpr int O_CONST = 0;
    constexpr int O_XF = 1280;
    constexpr int O_VV = O_XF + 2 * 5 * 1024;
    constexpr int O_BS = O_VV + 4 * 1024;
    constexpr int O_IMG = O_BS + 64;
    constexpr int I_CT = 0, I_BT = 576, I_KL = 1152, I_RT = 1728, I_CF = 2304, I_BTT = 3328, I_KTT = 3840, I_WCB = 4352, I_G1B = 4928, I_TTB = 5056, I_RKB = 5184, I_RBB = 5312, I_W15 = 5440, I_OUT = 5504, IMGSZ = 6528;
    static_assert((O_IMG + 2 * IMGSZ) * 4 <= RING_BYTES, "rwkv lds");
    for (int i = tid; i < 1280; i += NTHREADS) { const int arr = i >> 7, ch = hp * 128 + (i & 127); float v;
        switch (arr) { case 0: v = A.in[I_MU][RW_R + ch]; break; case 1: v = A.in[I_MU][RW_K + ch]; break; case 2: v = A.in[I_MU][RW_V + ch]; break; case 3: v = A.in[I_W0][ch]; break; case 4: v = A.in[I_A0][ch]; break;
                       case 5: v = A.in[I_KK][ch]; break; case 6: v = A.in[I_KA][ch]; break; case 7: v = A.in[I_RK][ch]; break; case 8: v = A.in[I_LNW][ch]; break; default: v = A.in[I_LNB][ch]; break; }
        Lf[O_CONST + i] = v; }
    const int hx = tid >> 8, tl = (tid >> 4) & 15, d4 = (tid & 15) * 4, ch4 = hx * 64 + d4, col4 = hp * 128 + ch4;
    u32x2 rr[2], rk[2], rv[2], rlw, rla, rg_cur = {0u, 0u}, rg_nxt = {0u, 0u}, rg_far = {0u, 0u};
#define RM_LOAD(c) do { const int t_ = (c) * TC + tl; const bf16* pr = P + (size_t)t_ * PROJ_LD + col4; \
        rr[0] = *(const GAS u32x2*)(pr + RW_R); rk[0] = *(const GAS u32x2*)(pr + RW_K); rv[0] = *(const GAS u32x2*)(pr + RW_V); \
        const bf16* pp_ = (t_ > 0) ? pr - PROJ_LD : pr; rr[1] = *(const GAS u32x2*)(pp_ + RW_R); rk[1] = *(const GAS u32x2*)(pp_ + RW_K); rv[1] = *(const GAS u32x2*)(pp_ + RW_V); \
        if (t_ == 0) { rr[1] = (u32x2){0u, 0u}; rk[1] = (u32x2){0u, 0u}; rv[1] = (u32x2){0u, 0u}; } \
        const bf16* lr = LO + (size_t)t_ * LORA_N + col4; rlw = *(const GAS u32x2*)(lr); rla = *(const GAS u32x2*)(lr + 1024); rg_far = *(const GAS u32x2*)(lr + 2048); } while (0)
#define RM_XFORM(bufi) do { LAS float* X_ = Lf + O_XF + hx * 5 * 1024 + tl * 64 + d4; \
        const f32x4 mur = *(const LAS f32x4*)(Lf + O_CONST + 0 * 128 + ch4), muk = *(const LAS f32x4*)(Lf + O_CONST + 1 * 128 + ch4), muv = *(const LAS f32x4*)(Lf + O_CONST + 2 * 128 + ch4); \
        const f32x4 w0_ = *(const LAS f32x4*)(Lf + O_CONST + 3 * 128 + ch4), a0_ = *(const LAS f32x4*)(Lf + O_CONST + 4 * 128 + ch4), kk_ = *(const LAS f32x4*)(Lf + O_CONST + 5 * 128 + ch4); \
        const f32x4 ka_ = *(const LAS f32x4*)(Lf + O_CONST + 6 * 128 + ch4), rk_ = *(const LAS f32x4*)(Lf + O_CONST + 7 * 128 + ch4); \
        const float r0[4] = {bf_lo(rr[0].x), bf_hi(rr[0].x), bf_lo(rr[0].y), bf_hi(rr[0].y)}, r1[4] = {bf_lo(rr[1].x), bf_hi(rr[1].x), bf_lo(rr[1].y), bf_hi(rr[1].y)}; \
        const float k0[4] = {bf_lo(rk[0].x), bf_hi(rk[0].x), bf_lo(rk[0].y), bf_hi(rk[0].y)}, k1[4] = {bf_lo(rk[1].x), bf_hi(rk[1].x), bf_lo(rk[1].y), bf_hi(rk[1].y)}; \
        const float v0[4] = {bf_lo(rv[0].x), bf_hi(rv[0].x), bf_lo(rv[0].y), bf_hi(rv[0].y)}, v1[4] = {bf_lo(rv[1].x), bf_hi(rv[1].x), bf_lo(rv[1].y), bf_hi(rv[1].y)}; \
        const float lw[4] = {bf_lo(rlw.x), bf_hi(rlw.x), bf_lo(rlw.y), bf_hi(rlw.y)}, la[4] = {bf_lo(rla.x), bf_hi(rla.x), bf_lo(rla.y), bf_hi(rla.y)}; \
        f32x4 r4, w4, k4, v4, kk4, b4; float skk = 0.f, sbs = 0.f; float aa[4]; \
        _Pragma("unroll") for (int i_ = 0; i_ < 4; ++i_) { const float r_ = r0[i_] + (r1[i_] - r0[i_]) * mur[i_], kx = k0[i_] + (k1[i_] - k0[i_]) * muk[i_], vx = v0[i_] + (v1[i_] - v0[i_]) * muv[i_]; \
            const float wd = __expf(-0.6065306597126334f * sigmoidf_(w0_[i_] + lw[i_])); const float a_ = sigmoidf_(a0_[i_] + la[i_]); \
            const float kk0 = kx * kk_[i_], km = kx * (1.f + (a_ - 1.f) * ka_[i_]); \
            r4[i_] = r_; w4[i_] = wd; k4[i_] = km; v4[i_] = vx; kk4[i_] = kk0; aa[i_] = a_; skk += kk0 * kk0; sbs += r_ * km * rk_[i_]; } \
        row_sum16_x2(skk, sbs); const float rkk = __builtin_amdgcn_rsqf(skk + EPS); \
        _Pragma("unroll") for (int i_ = 0; i_ < 4; ++i_) { kk4[i_] *= rkk; b4[i_] = kk4[i_] * aa[i_]; } \
        *(LAS f32x4*)(X_) = r4; *(LAS f32x4*)(X_ + 1024) = w4; *(LAS f32x4*)(X_ + 2048) = k4; *(LAS f32x4*)(X_ + 3072) = kk4; *(LAS f32x4*)(X_ + 4096) = b4; \
        *(LAS f32x4*)(Lf + O_VV + ((bufi) * 2 + hx) * 1024 + tl * 64 + d4) = v4; \
        if ((tid & 15) == 0) Lf[O_BS + ((bufi) * 2 + hx) * 16 + tl] = sbs; } while (0)
    constexpr int SPLIT = 60;
    const int c_begin = role ? SPLIT : 0, c_end = role ? NCHUNK : SPLIT;
    constexpr int REC = 7584;
    float* STASH = (float*)(A.ws + (unit < 32 ? WS_WEV_IN : WS_END)) + (size_t)(unit & 31) * (NCHUNK - SPLIT) * REC;
    float* STATE = (float*)(A.ws + WS_STATE + 4 * MiB) + (size_t)unit * 8192;
    gu32* flag = F.ctl + 49152 + unit * 64;
    LBAR();
    RM_LOAD(c_begin); RM_XFORM(c_begin & 1); rg_cur = rg_far; RM_LOAD(c_begin + 1); rg_nxt = rg_far;
    LBAR();
    f32x4 Macc[4];
#pragma unroll
    for (int i = 0; i < 4; ++i) Macc[i] = (f32x4){0.f, 0.f, 0.f, 0.f};
    const int fr = lane & 15, g = lane >> 4, hh = w >> 2, ww = w & 3, c0 = ww * 16;
    LAS float* IM = Lf + O_IMG + hh * IMGSZ;
    LAS bf16* CT = (LAS bf16*)(IM + I_CT); LAS bf16* BT = (LAS bf16*)(IM + I_BT); LAS bf16* KL = (LAS bf16*)(IM + I_KL); LAS bf16* RT = (LAS bf16*)(IM + I_RT);
    LAS bf16* BTT = (LAS bf16*)(IM + I_BTT); LAS bf16* KTT = (LAS bf16*)(IM + I_KTT); LAS bf16* WCB = (LAS bf16*)(IM + I_WCB);
    LAS bf16* G1B = (LAS bf16*)(IM + I_G1B); LAS bf16* TTB = (LAS bf16*)(IM + I_TTB); LAS bf16* RKB = (LAS bf16*)(IM + I_RKB); LAS bf16* RBB = (LAS bf16*)(IM + I_RBB);
    const u32x2 zz = {0u, 0u};
#define RM_STATE_PART(vb) do { \
        { \
            bf16x8 mb[2]; \
_Pragma("unroll") \
            for (int ks = 0; ks < 2; ++ks) { u32x2 slo, shi; slo.x = hw_pk2(Macc[2 * ks][0], Macc[2 * ks][1]); slo.y = hw_pk2(Macc[2 * ks][2], Macc[2 * ks][3]); shi.x = hw_pk2(Macc[2 * ks + 1][0], Macc[2 * ks + 1][1]); shi.y = hw_pk2(Macc[2 * ks + 1][2], Macc[2 * ks + 1][3]); \
                mb[ks] = mk_frag(slo, shi); } \
            f32x4 accR = accU, acco = {0.f, 0.f, 0.f, 0.f}; \
_Pragma("unroll") \
            for (int ks = 0; ks < 2; ++ks) { \
                accR = __builtin_amdgcn_mfma_f32_16x16x32_bf16(mk_frag(*(const LAS u32x2*)(WCB + fr * RS + 32 * ks + 4 * g), *(const LAS u32x2*)(WCB + fr * RS + 32 * ks + 16 + 4 * g)), mb[ks], accR, 0, 0, 0); \
                acco = __builtin_amdgcn_mfma_f32_16x16x32_bf16(mk_frag(*(const LAS u32x2*)(RT + fr * RS + 32 * ks + 4 * g), *(const LAS u32x2*)(RT + fr * RS + 32 * ks + 16 + 4 * g)), mb[ks], acco, 0, 0, 0); } \
            u32x2 rn; rn.x = hw_pk2(accR[0], accR[1]); rn.y = hw_pk2(accR[2], accR[3]); \
            const bf16x8 rb = mk_frag(rn, zz); \
            acco = __builtin_amdgcn_mfma_f32_16x16x32_bf16(mk_frag(*(const LAS u32x2*)(RKB + fr * 16 + 4 * g), zz), vb, acco, 0, 0, 0); \
            acco = __builtin_amdgcn_mfma_f32_16x16x32_bf16(mk_frag(*(const LAS u32x2*)(RBB + fr * 16 + 4 * g), zz), rb, acco, 0, 0, 0); \
_Pragma("unroll") \
            for (int r = 0; r < 4; ++r) IM[I_OUT + (4 * g + r) * 64 + c0 + fr] = acco[r]; \
_Pragma("unroll") \
            for (int i = 0; i < 4; ++i) { const f32x4 w15 = *(const LAS f32x4*)(IM + I_W15 + 16 * i + 4 * g); \
                f32x4 m = __builtin_amdgcn_mfma_f32_16x16x32_bf16(mk_frag(*(const LAS u32x2*)(KTT + (16 * i + fr) * 16 + 4 * g), zz), vb, Macc[i], 0, 0, 0); \
                m = __builtin_amdgcn_mfma_f32_16x16x32_bf16(mk_frag(*(const LAS u32x2*)(BTT + (16 * i + fr) * 16 + 4 * g), zz), rb, m, 0, 0, 0); \
                Macc[i] = m * w15; } \
        } \
        } while (0)
#define RM_FLUSH(cc_, gb_, vv_, bs_) do { \
        { \
            const f32x4 o4 = *(const LAS f32x4*)(Lf + O_IMG + hx * IMGSZ + I_OUT + tl * 64 + d4); const f32x4 vv = (vv_); const float bs = (bs_); \
            const f32x4 lnw = *(const LAS f32x4*)(Lf + O_CONST + 8 * 128 + ch4), lnb = *(const LAS f32x4*)(Lf + O_CONST + 9 * 128 + ch4); \
            float sm = (o4[0] + o4[1]) + (o4[2] + o4[3]), dummy = 0.f; row_sum16_x2(sm, dummy); const float mean = sm * (1.0f / 64.0f); \
            const f32x4 e4 = o4 - mean; float sv = (e4[0] * e4[0] + e4[1] * e4[1]) + (e4[2] * e4[2] + e4[3] * e4[3]); row_sum16_x2(sv, dummy); const float rs = __builtin_amdgcn_rsqf(sv * (1.0f / 64.0f) + 64e-5f); \
            const float gg[4] = {bf_lo((gb_).x), bf_hi((gb_).x), bf_lo((gb_).y), bf_hi((gb_).y)}; \
            float y[4]; \
_Pragma("unroll") \
            for (int i = 0; i < 4; ++i) y[i] = (e4[i] * rs * lnw[i] + lnb[i] + bs * vv[i]) * gg[i]; \
            int o8 = __builtin_amdgcn_cvt_pk_fp8_f32(y[0], y[1], 0, false); o8 = __builtin_amdgcn_cvt_pk_fp8_f32(y[2], y[3], o8, true); \
            *(GAS unsigned*)(Y + (size_t)((cc_) * TC + tl) * D + col4) = (unsigned)o8; \
        } \
        } while (0)
    for (int c = c_begin; c < c_end; ++c) {
        {
            const int hq = tid >> 8, seg = (tid >> 6) & 3, d = tid & 63;
            const LAS float* X_ = Lf + O_XF + hq * 5 * 1024 + d; LAS float* IQ = Lf + O_IMG + hq * IMGSZ;
            LAS bf16* CTq = (LAS bf16*)(IQ + I_CT); LAS bf16* BTq = (LAS bf16*)(IQ + I_BT); LAS bf16* KLq = (LAS bf16*)(IQ + I_KL); LAS bf16* RTq = (LAS bf16*)(IQ + I_RT);
            float wall = 1.f, wpre = 1.f;
#pragma unroll
            for (int t = 0; t < 16; ++t) { if (t == 4 * seg) wpre = wall; wall *= X_[1024 + t * 64]; }
            float wt = wpre; unsigned short bt4[4], kt4[4];
#pragma unroll
            for (int i = 0; i < 4; ++i) { const int t = 4 * seg + i; const float wprev = wt; wt *= X_[1024 + t * 64]; const float iw = __builtin_amdgcn_rcpf(wt);
                const float r_ = X_[t * 64], k_ = X_[2048 + t * 64], kk_ = X_[3072 + t * 64], b_ = X_[4096 + t * 64];
                const float ct = kk_ * wprev, bt = b_ * iw, kt = k_ * iw;
                CTq[t * RS + d] = hw_bf(ct); IQ[I_CF + t * 64 + d] = ct; BTq[t * RS + d] = hw_bf(bt); KLq[t * RS + d] = hw_bf(kt); RTq[t * RS + d] = hw_bf(r_ * wt);
                bt4[i] = (unsigned short)hw_bf(-bt); kt4[i] = (unsigned short)hw_bf(kt); }
            u32x2 o; o.x = (unsigned)bt4[0] | ((unsigned)bt4[1] << 16); o.y = (unsigned)bt4[2] | ((unsigned)bt4[3] << 16); *(LAS u32x2*)((LAS bf16*)(IQ + I_BTT) + d * 16 + 4 * seg) = o;
            o.x = (unsigned)kt4[0] | ((unsigned)kt4[1] << 16); o.y = (unsigned)kt4[2] | ((unsigned)kt4[3] << 16); *(LAS u32x2*)((LAS bf16*)(IQ + I_KTT) + d * 16 + 4 * seg) = o;
            if (seg == 3) IQ[I_W15 + d] = wall;
        }
        LBAR();
        if (ww == 0) {
            f32x4 cb = {0.f, 0.f, 0.f, 0.f}, bc = cb, ck = cb, rkm = cb, rbm = cb;
#pragma unroll
            for (int ks = 0; ks < 2; ++ks) { const bf16x8 fc = *(const LAS bf16x8*)(CT + fr * RS + 32 * ks + 8 * g), fb = *(const LAS bf16x8*)(BT + fr * RS + 32 * ks + 8 * g), fk = *(const LAS bf16x8*)(KL + fr * RS + 32 * ks + 8 * g), frr = *(const LAS bf16x8*)(RT + fr * RS + 32 * ks + 8 * g);
                cb = __builtin_amdgcn_mfma_f32_16x16x32_bf16(fc, fb, cb, 0, 0, 0); bc = __builtin_amdgcn_mfma_f32_16x16x32_bf16(fb, fc, bc, 0, 0, 0); ck = __builtin_amdgcn_mfma_f32_16x16x32_bf16(fc, fk, ck, 0, 0, 0);
                rkm = __builtin_amdgcn_mfma_f32_16x16x32_bf16(frr, fk, rkm, 0, 0, 0); rbm = __builtin_amdgcn_mfma_f32_16x16x32_bf16(frr, fb, rbm, 0, 0, 0); }
            f32x4 N1, M1, CKm;
#pragma unroll
            for (int r = 0; r < 4; ++r) { const int t = 4 * g + r; N1[r] = (fr < t) ? -cb[r] : 0.f; M1[r] = (t < fr) ? -bc[r] : 0.f; CKm[r] = (fr < t) ? ck[r] : 0.f;
                RKB[t * 16 + fr] = hw_bf((fr <= t) ? rkm[r] : 0.f); RBB[t * 16 + fr] = hw_bf((fr <= t) ? -rbm[r] : 0.f); }
#define XTY(X, Y, C0) __builtin_amdgcn_mfma_f32_16x16x32_bf16(mk_frag((u32x2){hw_pk2(X[0], X[1]), hw_pk2(X[2], X[3])}, zz), mk_frag((u32x2){hw_pk2(Y[0], Y[1]), hw_pk2(Y[2], Y[3])}, zz), C0, 0, 0, 0)
            const f32x4 z4 = {0.f, 0.f, 0.f, 0.f};
            f32x4 T1t = M1;
#pragma unroll
            for (int r = 0; r < 4; ++r) if (4 * g + r == fr) T1t[r] += 1.f;
            const f32x4 N2 = XTY(M1, N1, z4), M2 = XTY(N1, M1, z4);
            const f32x4 T2t = XTY(N2, T1t, T1t);
            const f32x4 N4 = XTY(M2, N2, z4), M4 = XTY(N2, M2, z4);
            const f32x4 T4t = XTY(N4, T2t, T2t);
            const f32x4 N8 = XTY(M4, N4, z4);
            const f32x4 T8t = XTY(N8, T4t, T4t);
            const f32x4 G1t = XTY(CKm, T8t, z4);
#undef XTY
            u32x2 tw; tw.x = hw_pk2(T8t[0], T8t[1]); tw.y = hw_pk2(T8t[2], T8t[3]); *(LAS u32x2*)(TTB + fr * 16 + 4 * g) = tw;
            tw.x = hw_pk2(G1t[0], G1t[1]); tw.y = hw_pk2(G1t[2], G1t[3]); *(LAS u32x2*)(G1B + fr * 16 + 4 * g) = tw;
        }
        if (c + 1 < c_end) { RM_XFORM((c + 1) & 1); }
        if (c + 2 < c_end) RM_LOAD(c + 2);
        LBAR();
        const LAS float* VVc = Lf + O_VV + ((c & 1) * 2 + hh) * 1024;
        u32x2 vlo; { vlo.x = hw_pk2(VVc[(4 * g + 0) * 64 + c0 + fr], VVc[(4 * g + 1) * 64 + c0 + fr]); vlo.y = hw_pk2(VVc[(4 * g + 2) * 64 + c0 + fr], VVc[(4 * g + 3) * 64 + c0 + fr]); }
        const bf16x8 vb = mk_frag(vlo, zz);
        f32x4 accU = {0.f, 0.f, 0.f, 0.f};
        {
            accU = __builtin_amdgcn_mfma_f32_16x16x32_bf16(mk_frag(*(const LAS u32x2*)(G1B + fr * 16 + 4 * g), zz), vb, accU, 0, 0, 0);
            u32x2 clo; clo.x = hw_pk2(IM[I_CF + (4 * g + 0) * 64 + c0 + fr], IM[I_CF + (4 * g + 1) * 64 + c0 + fr]); clo.y = hw_pk2(IM[I_CF + (4 * g + 2) * 64 + c0 + fr], IM[I_CF + (4 * g + 3) * 64 + c0 + fr]);
            f32x4 accw = {0.f, 0.f, 0.f, 0.f};
            accw = __builtin_amdgcn_mfma_f32_16x16x32_bf16(mk_frag(*(const LAS u32x2*)(TTB + fr * 16 + 4 * g), zz), mk_frag(clo, zz), accw, 0, 0, 0);
#pragma unroll
            for (int r = 0; r < 4; ++r) WCB[(4 * g + r) * RS + c0 + fr] = hw_bf(accw[r]);
        }
        LBAR();
        if (role == 0) {
            RM_STATE_PART(vb);
            LBAR();
            RM_FLUSH(c, rg_cur, *(const LAS f32x4*)(Lf + O_VV + ((c & 1) * 2 + hx) * 1024 + tl * 64 + d4), Lf[O_BS + ((c & 1) * 2 + hx) * 16 + tl]);
        } else {
            float* rec = STASH + (size_t)(c - c_begin) * REC;
            for (int i = tid; i < 1376; i += NTHREADS) { const int hd = i >= 688, j = i - hd * 688; const int o = O_IMG + hd * IMGSZ + (j < 144 ? I_RT + 4 * j : I_BTT + 4 * (j - 144)); *(GAS f32x4*)(rec + 4 * i) = *(const LAS f32x4*)(Lf + o); }
            { GAS unsigned* ru = (GAS unsigned*)(rec + 5504); ru[(w * 2 + 0) * 64 + lane] = hw_pk2(accU[0], accU[1]); ru[(w * 2 + 1) * 64 + lane] = hw_pk2(accU[2], accU[3]); }
            { const f32x4 v4 = *(const LAS f32x4*)(Lf + O_VV + ((c & 1) * 2 + hx) * 1024 + tl * 64 + d4); u32x2 o; o.x = hw_pk2(v4[0], v4[1]); o.y = hw_pk2(v4[2], v4[3]); *(GAS u32x2*)(rec + 6528 + 2 * tid) = o; }
            if (tid < 32) rec[7552 + tid] = Lf[O_BS + (c & 1) * 32 + tid];
            LBAR();
        }
        rg_cur = rg_nxt; rg_nxt = rg_far;
    }
    if (role == 0) {
#pragma unroll
        for (int i = 0; i < 4; ++i)
#pragma unroll
            for (int r = 0; r < 4; ++r) STATE[((w * 4 + i) * 4 + r) * 64 + lane] = Macc[i][r];
        asm volatile("s_waitcnt vmcnt(0)" ::: "memory");
        __syncthreads();
        if (tid == 0) { __builtin_amdgcn_fence(__ATOMIC_RELEASE, "agent"); asm volatile("s_waitcnt vmcnt(0)" ::: "memory"); __hip_atomic_store(flag, 1u, __ATOMIC_RELAXED, __HIP_MEMORY_SCOPE_AGENT); }
    } else {
        if (tid == 0) { unsigned sp = 0; while (__hip_atomic_load(flag, __ATOMIC_RELAXED, __HIP_MEMORY_SCOPE_AGENT) == 0u) { __builtin_amdgcn_s_sleep(8); if (++sp > (1u << 22)) break; }
            __builtin_amdgcn_fence(__ATOMIC_ACQUIRE, "agent"); asm volatile("s_waitcnt vmcnt(0)" ::: "memory"); }
        __syncthreads();
#pragma unroll
        for (int i = 0; i < 4; ++i)
#pragma unroll
            for (int r = 0; r < 4; ++r) Macc[i][r] = STATE[((w * 4 + i) * 4 + r) * 64 + lane];
        f32x4 pi0, pi1, pi2; unsigned pu0, pu1; u32x2 pv, pgate; float pbs;
#define RM_REC_LOAD(cc) do { const float* rec = STASH + (size_t)((cc) - c_begin) * REC; pi0 = *(const GAS f32x4*)(rec + 4 * tid); pi1 = *(const GAS f32x4*)(rec + 4 * (tid + 512)); \
            pi2 = (tid < 352) ? *(const GAS f32x4*)(rec + 4 * (tid + 1024)) : (f32x4){0.f, 0.f, 0.f, 0.f}; \
            const GAS unsigned* ru = (const GAS unsigned*)(rec + 5504); pu0 = ru[(w * 2 + 0) * 64 + lane]; pu1 = ru[(w * 2 + 1) * 64 + lane]; pv = *(const GAS u32x2*)(rec + 6528 + 2 * tid); pbs = rec[7552 + hx * 16 + tl]; \
            pgate = *(const GAS u32x2*)(LO + (size_t)((cc) * TC + tl) * LORA_N + col4 + 2048); } while (0)
#define RM_IMG_OFF(i_) (O_IMG + ((i_) >= 688) * IMGSZ + ((((i_) - ((i_) >= 688) * 688) < 144) ? I_RT + 4 * ((i_) - ((i_) >= 688) * 688) : I_BTT + 4 * (((i_) - ((i_) >= 688) * 688) - 144)))
        RM_REC_LOAD(c_begin);
        for (int c = c_begin; c < c_end; ++c) {
            *(LAS f32x4*)(Lf + RM_IMG_OFF(tid)) = pi0; *(LAS f32x4*)(Lf + RM_IMG_OFF(tid + 512)) = pi1; if (tid < 352) *(LAS f32x4*)(Lf + RM_IMG_OFF(tid + 1024)) = pi2;
            const f32x4 vcur = {bf_lo(pv.x), bf_hi(pv.x), bf_lo(pv.y), bf_hi(pv.y)}; *(LAS f32x4*)(Lf + O_VV + hx * 1024 + tl * 64 + d4) = vcur;
            const f32x4 accU = {bf_lo(pu0), bf_hi(pu0), bf_lo(pu1), bf_hi(pu1)}; const float bscur = pbs; const u32x2 gcur = pgate;
            if (c + 1 < c_end) RM_REC_LOAD(c + 1);
            LBAR();
            const LAS float* VVc = Lf + O_VV + hh * 1024;
            u32x2 vlo; { vlo.x = hw_pk2(VVc[(4 * g + 0) * 64 + c0 + fr], VVc[(4 * g + 1) * 64 + c0 + fr]); vlo.y = hw_pk2(VVc[(4 * g + 2) * 64 + c0 + fr], VVc[(4 * g + 3) * 64 + c0 + fr]); }
            const bf16x8 vb = mk_frag(vlo, zz);
            RM_STATE_PART(vb);
            LBAR();
            RM_FLUSH(c, gcur, vcur, bscur);
            LBAR();
        }
#undef RM_REC_LOAD
#undef RM_IMG_OFF
    }
#undef RM_STATE_PART
#undef RM_FLUSH
#undef RM_LOAD
#undef RM_XFORM
}

__device__ __forceinline__ int med3i(int a, int b, int c) { int r; asm("v_med3_i32 %0, %1, %2, %3" : "=v"(r) : "v"(a), "v"(b), "v"(c)); return r; }
__device__ __forceinline__ int f2sort(float f) { int x = __float_as_int(f); return x ^ ((x >> 31) & 0x7fffffff); }
__device__ __forceinline__ float sort2f(int x) { return __int_as_float(x ^ ((x >> 31) & 0x7fffffff)); }
#define TOPK_INSERT(vals, x) do { _Pragma("unroll") for (int s_ = 15; s_ >= 1; --s_) vals[s_] = med3i((x), vals[s_ - 1], vals[s_]); vals[0] = max(vals[0], (x)); } while (0)
__device__ __forceinline__ float bf_dot2(unsigned a, unsigned b, float c) {
    return c + bf_lo(a) * bf_lo(b) + bf_hi(a) * bf_hi(b);
}
__device__ __forceinline__ void sum8_x8(float (&a)[8]) {
    asm("s_nop 1\n\t"
        "v_add_f32_dpp %0, %0, %0 quad_perm:[1,0,3,2] row_mask:0xf bank_mask:0xf\n\tv_add_f32_dpp %1, %1, %1 quad_perm:[1,0,3,2] row_mask:0xf bank_mask:0xf\n\t"
        "v_add_f32_dpp %2, %2, %2 quad_perm:[1,0,3,2] row_mask:0xf bank_mask:0xf\n\tv_add_f32_dpp %3, %3, %3 quad_perm:[1,0,3,2] row_mask:0xf bank_mask:0xf\n\t"
        "v_add_f32_dpp %4, %4, %4 quad_perm:[1,0,3,2] row_mask:0xf bank_mask:0xf\n\tv_add_f32_dpp %5, %5, %5 quad_perm:[1,0,3,2] row_mask:0xf bank_mask:0xf\n\t"
        "v_add_f32_dpp %6, %6, %6 quad_perm:[1,0,3,2] row_mask:0xf bank_mask:0xf\n\tv_add_f32_dpp %7, %7, %7 quad_perm:[1,0,3,2] row_mask:0xf bank_mask:0xf\n\t"
        "v_add_f32_dpp %0, %0, %0 quad_perm:[2,3,0,1] row_mask:0xf bank_mask:0xf\n\tv_add_f32_dpp %1, %1, %1 quad_perm:[2,3,0,1] row_mask:0xf bank_mask:0xf\n\t"
        "v_add_f32_dpp %2, %2, %2 quad_perm:[2,3,0,1] row_mask:0xf bank_mask:0xf\n\tv_add_f32_dpp %3, %3, %3 quad_perm:[2,3,0,1] row_mask:0xf bank_mask:0xf\n\t"
        "v_add_f32_dpp %4, %4, %4 quad_perm:[2,3,0,1] row_mask:0xf bank_mask:0xf\n\tv_add_f32_dpp %5, %5, %5 quad_perm:[2,3,0,1] row_mask:0xf bank_mask:0xf\n\t"
        "v_add_f32_dpp %6, %6, %6 quad_perm:[2,3,0,1] row_mask:0xf bank_mask:0xf\n\tv_add_f32_dpp %7, %7, %7 quad_perm:[2,3,0,1] row_mask:0xf bank_mask:0xf\n\t"
        "v_add_f32_dpp %0, %0, %0 row_half_mirror row_mask:0xf bank_mask:0xf\n\tv_add_f32_dpp %1, %1, %1 row_half_mirror row_mask:0xf bank_mask:0xf\n\t"
        "v_add_f32_dpp %2, %2, %2 row_half_mirror row_mask:0xf bank_mask:0xf\n\tv_add_f32_dpp %3, %3, %3 row_half_mirror row_mask:0xf bank_mask:0xf\n\t"
        "v_add_f32_dpp %4, %4, %4 row_half_mirror row_mask:0xf bank_mask:0xf\n\tv_add_f32_dpp %5, %5, %5 row_half_mirror row_mask:0xf bank_mask:0xf\n\t"
        "v_add_f32_dpp %6, %6, %6 row_half_mirror row_mask:0xf bank_mask:0xf\n\tv_add_f32_dpp %7, %7, %7 row_half_mirror row_mask:0xf bank_mask:0xf\n\t"
        "s_nop 1"
        : "+v"(a[0]), "+v"(a[1]), "+v"(a[2]), "+v"(a[3]), "+v"(a[4]), "+v"(a[5]), "+v"(a[6]), "+v"(a[7]));
}
__device__ __forceinline__ float sum8_x1(float v) {
    asm("s_nop 1\n\tv_add_f32_dpp %0, %0, %0 quad_perm:[1,0,3,2] row_mask:0xf bank_mask:0xf\n\ts_nop 1\n\tv_add_f32_dpp %0, %0, %0 quad_perm:[2,3,0,1] row_mask:0xf bank_mask:0xf\n\ts_nop 1\n\t"
        "v_add_f32_dpp %0, %0, %0 row_half_mirror row_mask:0xf bank_mask:0xf\n\ts_nop 1" : "+v"(v));
    return v;
}
__device__ __forceinline__ void peer_phase(const Args& A, Frame& F, int L, const bool dry, const bf16* Hin, bf16* Hout, unsigned char* H8) {
    int lane = F.lane; asm volatile("" : "+v"(lane));
    const int gw = F.vcu * NWAVES + F.wave;
    const bf16* SCR = (const bf16*)(A.ws + WS_SC); const bf16* X = Hin; float* RS3 = (float*)(A.ws + WS_RS3);
    const unsigned char* TU = (const unsigned char*)(A.ws + WS_TABU) + (size_t)L * 16384 * D; const unsigned char* TV = (const unsigned char*)(A.ws + WS_TABV) + (size_t)L * 16384 * D;
    const float* rowss = (const float*)(A.ws + WS_RSP) + (size_t)(L == 0 ? RS_FFN0 : RS_FFN1) * T * 32;
    LAS unsigned* LIST = (LAS unsigned*)(F.lds + RING_OFF + F.wave * 16384);
    LAS unsigned* EIDX = LIST + 1024;
    LAS float* ECOEF = (LAS float*)(EIDX + 1024);
    const int tbase = gw * 8;
    if (tbase >= T) return;
    for (int half = 0; half < 2; ++half) {
        const int t0 = tbase + 4 * half;
        {
            const bf16* sp = SCR + (size_t)(t0 + (lane >> 4)) * D + (lane & 15) * 128;
            int vals[16];
#pragma unroll
            for (int s = 0; s < 16; ++s) vals[s] = (int)0x80000000;
#pragma unroll 2
            for (int c = 0; c < 16; ++c) { const v4u wv = *(const GAS v4u*)(sp + c * 8); const unsigned ww[4] = {wv.x, wv.y, wv.z, wv.w};
#pragma unroll
                for (int e = 0; e < 8; ++e) { const unsigned bits = (e & 1) ? (ww[e >> 1] & 0xffff0000u) : (ww[e >> 1] << 16);
                    int x = (int)bits; x ^= (x >> 31) & 0x7fffffff; x = (x & ~0x7f) | (127 - (c * 8 + e));
                    TOPK_INSERT(vals, x); } }
#pragma unroll
            for (int q = 0; q < 4; ++q) { v4u o; o.x = (unsigned)vals[4 * q]; o.y = (unsigned)vals[4 * q + 1]; o.z = (unsigned)vals[4 * q + 2]; o.w = (unsigned)vals[4 * q + 3]; *(LAS v4u*)(LIST + lane * 16 + 4 * q) = o; }
        }
        LDS_WAIT(); asm volatile("" ::: "memory");
        if (lane < 32) {
            const LAS unsigned* la = LIST + ((lane >> 3) * 16 + (lane & 7) * 2) * 16; const LAS unsigned* lb2 = la + 16;
            float av[16], bv[16];
#pragma unroll
            for (int q = 0; q < 4; ++q) { const v4u a4 = *(const LAS v4u*)(la + 4 * q), b4 = *(const LAS v4u*)(lb2 + 4 * q); const unsigned aw[4] = {a4.x, a4.y, a4.z, a4.w}, bw[4] = {b4.x, b4.y, b4.z, b4.w};
#pragma unroll
                for (int e = 0; e < 4; ++e) { av[4 * q + e] = __uint_as_float(__float_as_uint(sort2f((int)(aw[e] & ~0x7fu))) & 0xffff0000u); bv[4 * q + e] = __uint_as_float(__float_as_uint(sort2f((int)(bw[e] & ~0x7fu))) & 0xffff0000u); } }
            int best[16];
#pragma unroll
            for (int s = 0; s < 16; ++s) best[s] = (int)0x80000000;
#pragma unroll
            for (int i = 0; i < 16; ++i)
#pragma unroll
                for (int jx = 0; jx < 16; ++jx) if ((i + 1) * (jx + 1) <= 16) { int x = f2sort(av[i] + bv[jx]); x = (x & ~0xff) | (255 - (i * 16 + jx)); TOPK_INSERT(best, x); }
            float sv[16]; unsigned ex[16];
#pragma unroll
            for (int s = 0; s < 16; ++s) { const int cand = 255 - (best[s] & 0xff); const unsigned ka = la[cand >> 4], kb = lb2[cand & 15];
                ex[s] = (127u - (ka & 0x7fu)) * 128u + (127u - (kb & 0x7fu));
                sv[s] = __uint_as_float(__float_as_uint(sort2f((int)(ka & ~0x7fu))) & 0xffff0000u) + __uint_as_float(__float_as_uint(sort2f((int)(kb & ~0x7fu))) & 0xffff0000u); }
            float mx = sv[0];
#pragma unroll
            for (int s = 1; s < 16; ++s) mx = fmaxf(mx, sv[s]);
            float den = 0.f;
#pragma unroll
            for (int s = 0; s < 16; ++s) { sv[s] = __expf(sv[s] - mx); den += sv[s]; }
            const float inv = 1.0f / den; const int base = (4 * half + (lane >> 3)) * 128 + (lane & 7) * 16;
#pragma unroll
            for (int s = 0; s < 16; ++s) { EIDX[base + s] = ex[s]; ECOEF[base + s] = sv[s] * inv; }
        }
        LDS_WAIT(); asm volatile("" ::: "memory");
    }
    const int tk = lane >> 3, part = lane & 7, t = tbase + tk;
    const LAS unsigned* eidx = EIDX + tk * 128; LAS float* ecoef = ECOEF + tk * 128;
    const float rs = __builtin_amdgcn_rsqf(sum8_x1(((const GAS f32x4*)(rowss + (size_t)t * 32))[part][0] + ((const GAS f32x4*)(rowss + (size_t)t * 32))[part][1] + ((const GAS f32x4*)(rowss + (size_t)t * 32))[part][2] + ((const GAS f32x4*)(rowss + (size_t)t * 32))[part][3]) * (1.0f / D) + EPS);
    typedef _Float16 h2_t __attribute__((ext_vector_type(2)));
#define PEER_LOAD8(dst, TAB, i0, soff) do { const v4u ia_ = *(const LAS v4u*)(eidx + (i0)), ib_ = *(const LAS v4u*)(eidx + (i0) + 4); const unsigned ee_[8] = {ia_.x, ia_.y, ia_.z, ia_.w, ib_.x, ib_.y, ib_.z, ib_.w}; \
        _Pragma("unroll") for (int j_ = 0; j_ < 8; ++j_) dst[j_] = *(const GAS v4u*)((TAB) + (size_t)(ee_[j_] * 2048u + (unsigned)(soff))); } while (0)
    LAS float* dotw = (LAS float*)LIST + tk * 128;
#pragma unroll
    for (int m = 0; m < 16; ++m) dotw[8 * m + part] = 0.f;
#pragma unroll 1
    for (int p = 0; p < 16; ++p) {
        const int soff = 128 * p + 16 * part;
        h2_t xs[8];
        { const v4u x0 = *(const GAS v4u*)(X + (size_t)t * D + soff), x1 = *(const GAS v4u*)(X + (size_t)t * D + soff + 8); const unsigned xw[8] = {x0.x, x0.y, x0.z, x0.w, x1.x, x1.y, x1.z, x1.w};
#pragma unroll
          for (int e = 0; e < 8; ++e) xs[e] = (h2_t){(_Float16)bf_lo(xw[e]), (_Float16)bf_hi(xw[e])}; }
#define PEER_UDOT8(src, m_) do { float tt_[8]; \
        _Pragma("unroll") for (int j_ = 0; j_ < 8; ++j_) { const unsigned ww_[4] = {src[j_].x, src[j_].y, src[j_].z, src[j_].w}; float a0_ = 0.f, a1_ = 0.f; \
            _Pragma("unroll") for (int e_ = 0; e_ < 4; ++e_) { const h2_t lo_ = __builtin_amdgcn_cvt_scalef32_pk_f16_fp8((int)ww_[e_], 1.0f / 512.0f, false), hi_ = __builtin_amdgcn_cvt_scalef32_pk_f16_fp8((int)ww_[e_], 1.0f / 512.0f, true); \
                a0_ = __builtin_amdgcn_fdot2(xs[2 * e_], lo_, a0_, false); a1_ = __builtin_amdgcn_fdot2(xs[2 * e_ + 1], hi_, a1_, false); } \
            tt_[j_] = a0_ + a1_; } \
        sum8_x8(tt_); \
        float sel_ = tt_[0]; _Pragma("unroll") for (int j_ = 1; j_ < 8; ++j_) sel_ = (part == j_) ? tt_[j_] : sel_; \
        dotw[8 * (m_) + part] += sel_; } while (0)
        v4u ua[8], ub[8];
        PEER_LOAD8(ua, TU, 0, soff);
#pragma unroll 1
        for (int m = 0; m < 16; m += 2) {
            PEER_LOAD8(ub, TU, 8 * (m + 1), soff);
            PEER_UDOT8(ua, m);
            if (m + 2 < 16) PEER_LOAD8(ua, TU, 8 * (m + 2), soff);
            PEER_UDOT8(ub, m + 1);
        }
    }
#undef PEER_UDOT8
#pragma unroll
    for (int m = 0; m < 16; ++m) { const float d_ = dotw[8 * m + part] * rs; const float act = 0.5f * d_ * (1.0f + erff(d_ * 0.7071067811865476f)); ecoef[8 * m + part] *= act; }
    LDS_WAIT(); asm volatile("" ::: "memory");
    float ss = 0.f;
#pragma unroll 1
    for (int p = 0; p < 16; ++p) {
        const int soff = 128 * p + 16 * part;
        h2_t acc[8];
#pragma unroll
        for (int i = 0; i < 8; ++i) acc[i] = (h2_t){(_Float16)0.f, (_Float16)0.f};
#define PEER_VACC8(src, i0) do { const f32x4 ca_ = *(const LAS f32x4*)(ecoef + (i0)), cb_ = *(const LAS f32x4*)(ecoef + (i0) + 4); const float cf_[8] = {ca_[0], ca_[1], ca_[2], ca_[3], cb_[0], cb_[1], cb_[2], cb_[3]}; \
        _Pragma("unroll") for (int j_ = 0; j_ < 8; ++j_) { const unsigned ww_[4] = {src[j_].x, src[j_].y, src[j_].z, src[j_].w}; const _Float16 ch_ = (_Float16)cf_[j_]; const h2_t c2_ = {ch_, ch_}; \
            _Pragma("unroll") for (int e_ = 0; e_ < 4; ++e_) { const h2_t lo_ = __builtin_amdgcn_cvt_scalef32_pk_f16_fp8((int)ww_[e_], 1.0f / 16.0f, false), hi_ = __builtin_amdgcn_cvt_scalef32_pk_f16_fp8((int)ww_[e_], 1.0f / 16.0f, true); \
                acc[2 * e_] = c2_ * lo_ + acc[2 * e_]; acc[2 * e_ + 1] = c2_ * hi_ + acc[2 * e_ + 1]; } } } while (0)
        v4u va[8], vb[8];
        PEER_LOAD8(va, TV, 0, soff);
#pragma unroll 1
        for (int m = 0; m < 16; m += 2) {
            PEER_LOAD8(vb, TV, 8 * (m + 1), soff);
            PEER_VACC8(va, 8 * m);
            if (m + 2 < 16) PEER_LOAD8(va, TV, 8 * (m + 2), soff);
            PEER_VACC8(vb, 8 * (m + 1));
        }
        { const v4u h0 = *(const GAS v4u*)(Hin + (size_t)t * D + soff), h1 = *(const GAS v4u*)(Hin + (size_t)t * D + soff + 8); const unsigned hw[8] = {h0.x, h0.y, h0.z, h0.w, h1.x, h1.y, h1.z, h1.w}; unsigned ow[8];
#pragma unroll
          for (int e = 0; e < 8; ++e) { ow[e] = hw_pk2(bf_lo(hw[e]) + (float)acc[e][0], bf_hi(hw[e]) + (float)acc[e][1]); const float q0 = bf_lo(ow[e]), q1 = bf_hi(ow[e]); ss += q0 * q0 + q1 * q1; }
          v4u o0, o1; o0.x = ow[0]; o0.y = ow[1]; o0.z = ow[2]; o0.w = ow[3]; o1.x = ow[4]; o1.y = ow[5]; o1.z = ow[6]; o1.w = ow[7];
          if (!dry) { *(GAS v4u*)(Hout + (size_t)t * D + soff) = o0; *(GAS v4u*)(Hout + (size_t)t * D + soff + 8) = o1;
            if (H8) { v4u o8; unsigned q8[4];
#pragma unroll
              for (int e = 0; e < 4; ++e) { int x8 = __builtin_amdgcn_cvt_pk_fp8_f32(bf_lo(ow[2 * e]), bf_hi(ow[2 * e]), 0, false); x8 = __builtin_amdgcn_cvt_pk_fp8_f32(bf_lo(ow[2 * e + 1]), bf_hi(ow[2 * e + 1]), x8, true); q8[e] = (unsigned)x8; }
              o8.x = q8[0]; o8.y = q8[1]; o8.z = q8[2]; o8.w = q8[3]; *(GAS v4u*)(H8 + (size_t)t * D + soff) = o8; } } else asm volatile("" :: "v"(o0.x), "v"(o0.y), "v"(o0.z), "v"(o0.w), "v"(o1.x), "v"(o1.y), "v"(o1.z), "v"(o1.w)); }
    }
#undef PEER_VACC8
#undef PEER_LOAD8
    const float r3 = __builtin_amdgcn_rsqf(sum8_x1(ss) * (1.0f / D) + EPS);
    if (!dry && part == 0) RS3[t] = r3;
}


constexpr int N_PHASES = 19;
__global__ void __launch_bounds__(NTHREADS, 2) mega_fwd(Args args) {

    extern __shared__ __attribute__((aligned(16))) unsigned char lds[];
    Frame F;
    F.lds = (LAS unsigned char*)lds;
    F.MISC = (volatile LAS unsigned*)(F.lds + MISC_OFF);
    F.tid = threadIdx.x; F.lane = F.tid & 63; F.wave = __builtin_amdgcn_readfirstlane(F.tid >> 6);
    F.G = gridDim.x; { const int bx = blockIdx.x; F.vcu = (F.G % 8 == 0) ? (bx % 8) * (F.G / 8) + bx / 8 : bx; }
    unsigned char* ws = args.ws;
    F.ctl = (gu32*)(ws + WS_CTL);
    for (int u = F.tid; u < (LDS_BYTES - LDSCTL_OFF) / 4; u += NTHREADS) ((LAS unsigned*)(F.lds + LDSCTL_OFF))[u] = 0u;
    __syncthreads();
    const int lo = args.ph_lo, hi = args.ph_hi;
    XcdBarrier bar; bar.bar = (unsigned*)(F.ctl + CW_BAR); bar.x = 0; bar.st = nullptr;
    if (hi - lo > 1) bar = xcd_barrier_post((unsigned*)(F.ctl + CW_BAR), F.MISC + 8);
    bar.wave0 = (F.wave == 0);
#define IN(k) (lo <= (k) && (k) < hi)
#define REFRESH() do { int t_; asm volatile("v_mbcnt_lo_u32_b32 %0, -1, 0\n\tv_mbcnt_hi_u32_b32 %0, -1, %0" : "=v"(t_)); F.lane = t_; F.tid = F.wave * 64 + t_; } while (0)
#define REPS(k) (1 + ((DUP_MASK >> (k)) & 1))
#if PROBE_MASK
    unsigned long long* const tsb = (unsigned long long*)(ws + WS_CTL + 65536);
#define STAMP(k) do { if (blockIdx.x == 0 && F.tid == 0) __hip_atomic_store(tsb + (k), __builtin_amdgcn_s_memrealtime(), __ATOMIC_RELAXED, __HIP_MEMORY_SCOPE_AGENT); } while (0)
    STAMP(31);
#else
#define STAMP(k) do { } while (0)
#endif
#define SEAM(k) do { if (IN(k) && IN((k) + 1)) { if ((k) == 0) { cg::this_grid().sync(); } else { xcd_barrier(bar); if ((DUP_MASK >> 24) & 1) xcd_barrier(bar); } STAMP(k); } } while (0)
    float* rowss = (float*)(ws + WS_RSP);
    bf16* ACTA = (bf16*)(ws + WS_ACTA); bf16* ACTB = (bf16*)(ws + WS_ACTB); bf16* H1 = (bf16*)(ws + WS_H1); const float* RS3 = (const float*)(ws + WS_RS3);
    bf16* PROJ = (bf16*)(ws + WS_PROJ); bf16* SCB = (bf16*)(ws + WS_SC); bf16* PP = (bf16*)(ws + WS_PP);
    const int gtid = (F.vcu * NWAVES + F.wave) * 64 + F.lane, gthreads = F.G * NTHREADS;

#if UBENCH
    {
        typedef _Float16 h2_t __attribute__((ext_vector_type(2)));
        float a[32]; f32x2 p[16]; h2_t hh[32];
#pragma unroll
        for (int i = 0; i < 32; ++i) { a[i] = (float)(F.tid + i); hh[i] = (h2_t){(_Float16)(F.lane + i), (_Float16)i}; }
#pragma unroll
        for (int i = 0; i < 16; ++i) p[i] = (f32x2){a[2 * i], a[2 * i + 1]};
        const float m = 1.0f + 1e-7f * F.lane, c = 1e-9f; const f32x2 m2 = {m, m}, c2 = {c, c}; const h2_t mh = {(_Float16)1.0f, (_Float16)1.0f}, ch = {(_Float16)0.0f, (_Float16)0.0f};
#pragma unroll 1
        for (int it = 0; it < 10000; ++it) {
#if UBENCH == 1
#pragma unroll
            for (int i = 0; i < 32; ++i) asm volatile("v_fma_f32 %0, %0, %1, %2" : "+v"(a[i]) : "v"(m), "v"(c));
#elif UBENCH == 2
#pragma unroll
            for (int i = 0; i < 16; ++i) asm volatile("v_pk_fma_f32 %0, %0, %1, %2\n\tv_pk_fma_f32 %0, %0, %1, %2" : "+v"(p[i]) : "v"(m2), "v"(c2));
#elif UBENCH == 3
#pragma unroll
            for (int i = 0; i < 32; ++i) asm volatile("v_pk_fma_f16 %0, %0, %1, %2" : "+v"(hh[i]) : "v"(mh), "v"(ch));
#endif
        }
        float s = 0.f;
#pragma unroll
        for (int i = 0; i < 32; ++i) s += a[i] + (float)hh[i][0];
#pragma unroll
        for (int i = 0; i < 16; ++i) s += p[i][0] + p[i][1];
        if (s == 12345.678f) args.out[0] = s;
    }
#endif
    if (IN(0)) { REFRESH(); p0_prologue(args, F); } SEAM(0);
    if (IN(1)) for (int rep_ = 0; rep_ < REPS(1); ++rep_) { REFRESH();
        { pg8::Gemm g{ACTA, (const bf16*)(ws + WS_WEV_IN), T, EV_NP, D}; pg8::StaticOrder S; S.init(T, EV_NP, F.G, (int)blockIdx.x); EpiBf16S E{PROJ, PROJ_LD, nullptr};
          pg8::gemm_phase<EpiBf16S, pg8::StaticOrder, true, true>(F.lds + RING_OFF, g, S, E, F.wave); }
        if (F.G == 256 ? (int)blockIdx.x >= 64 : true) { const int g2 = F.G == 256 ? 192 : F.G, c2 = F.G == 256 ? (int)blockIdx.x - 64 : (int)blockIdx.x;
          pg8::Gemm g{(const bf16*)(ws + WS_PBF), (const bf16*)(ws + WS_WPROJ), T, D, 256}; pg8::StaticOrder S; S.init(T, D, g2, c2); EpiBf16S E{PP, D, nullptr};
          pg8::gemm_phase<EpiBf16S, pg8::StaticOrder, true, true>(F.lds + RING_OFF, g, S, E, F.wave); }
    } SEAM(1);
    if (IN(2)) for (int rep_ = 0; rep_ < REPS(2); ++rep_) { REFRESH();
        if (F.G >= 256) {
            const int u = F.vcu;
            if (u < 64) scan_gla_mfma_unit<0>(args, F, u); else if (u < 128) scan_gdn_mfma_unit(args, F, u - 64, 0); else if (u < 192) scan_gdn_mfma_unit(args, F, u - 128, 1);
            __syncthreads();
            if (rep_ == 0) for (int dr_ = 0; dr_ < 1 + ((DUP_MASK >> 22) & 1); ++dr_) { if (u < 64) p0_deferred(args, F, 128 + u, 192); else if (u >= 192) for (int k = 0; k < 2; ++k) p0_deferred(args, F, 2 * (u - 192) + k, 192); }
        } else {
            for (int u = F.vcu; u < 64; u += F.G) { scan_gla_mfma_unit<0>(args, F, u); __syncthreads(); }
            for (int u = F.vcu; u < 64; u += F.G) { scan_gdn_mfma_unit(args, F, u, 0); __syncthreads(); scan_gdn_mfma_unit(args, F, u, 1); __syncthreads(); }
            if (rep_ == 0) p0_deferred(args, F, F.vcu, F.G);
        }
    } SEAM(2);
    if (IN(3)) for (int rep_ = 0; rep_ < REPS(3); ++rep_) { REFRESH(); post_rows<0>(args, F); } SEAM(3);
    if (IN(4)) { REFRESH(); pg8::Gemm g{ACTA, (const bf16*)(ws + WS_WEV_OUT), T, D, D}; pg8::StaticOrder S; S.init(T, D, F.G, (int)blockIdx.x);
        EpiResid<false, true> E{args.in[I_X], ACTB, rowss + (size_t)RS_FFN0 * T * 32, nullptr, nullptr, nullptr};
        pg8::gemm_phase<EpiResid<false, true>, pg8::StaticOrder, true, true>(F.lds + RING_OFF, g, S, E, F.wave); }
#if (DUP_MASK >> 20) & 1
    if (IN(4)) { REFRESH(); pg8::Gemm g{ACTA, (const bf16*)(ws + WS_WEV_OUT), T, D, D}; pg8::StaticOrder S; S.init(T, D, F.G, (int)blockIdx.x);
        EpiResid<false, true> E{args.in[I_X], ACTB, rowss + (size_t)RS_FFN0 * T * 32, nullptr, nullptr, nullptr};
        pg8::gemm_phase<EpiResid<false, true>, pg8::StaticOrder, true, true>(F.lds + RING_OFF, g, S, E, F.wave); }
#endif
#if (DUP_MASK >> 21) & 1
    if (IN(4)) { REFRESH(); pg8::Gemm g{ACTA, (const bf16*)(ws + WS_WEV_IN), T, EV_NP, D}; pg8::StaticOrder S; S.init(T, EV_NP, F.G, (int)blockIdx.x); EpiBf16S E{PROJ, PROJ_LD, nullptr};
        pg8::gemm_phase<EpiBf16S, pg8::StaticOrder, true, true>(F.lds + RING_OFF, g, S, E, F.wave); }
#endif
    SEAM(4);
    if (IN(5)) for (int rep_ = 0; rep_ < REPS(5); ++rep_) { REFRESH(); { pg8::Gemm g{ACTB, (const bf16*)(ws + WS_WPEER), T, D, D}; pg8::StaticOrder S; S.init(T, D, F.G, (int)blockIdx.x); EpiBf16S E{SCB, D, rowss + (size_t)RS_FFN0 * T * 32};
        pg8::gemm_phase<EpiBf16S, pg8::StaticOrder, true, true>(F.lds + RING_OFF, g, S, E, F.wave); }
        } SEAM(5);
    if (IN(6)) for (int rep_ = 0; rep_ < REPS(6); ++rep_) { REFRESH(); peer_phase(args, F, 0, rep_ != 0, ACTB, H1, nullptr); } SEAM(6);
    if (IN(7)) { REFRESH(); { pg8::Gemm g{H1, (const bf16*)(ws + WS_WGATE), T, D, D}; pg8::StaticOrder S; S.init(T, D, F.G, (int)blockIdx.x);
        EpiResid<true, false> E{H1, ACTB, rowss + (size_t)RS_MIX1 * T * 32, PP, RS3, (unsigned char*)ACTA};
        pg8::gemm_phase<EpiResid<true, false>, pg8::StaticOrder, true, true>(F.lds + RING_OFF, g, S, E, F.wave); }
        } SEAM(7);
    if (IN(8)) for (int rep_ = 0; rep_ < REPS(8); ++rep_) { REFRESH();
        { pg8::Gemm g{ACTA, (const bf16*)(ws + WS_WOD_IN), T, OD_NP, D / 2}; pg8::StaticOrder S; S.init(T, OD_NP, F.G, (int)blockIdx.x); EpiBf16S E{PROJ, PROJ_LD, rowss + (size_t)RS_MIX1 * T * 32};
          pg8::gemm_phase<EpiBf16S, pg8::StaticOrder, true, true, true>(F.lds + RING_OFF, g, S, E, F.wave); }
        { pg8::Gemm g{(const bf16*)(ws + WS_PBF) + (size_t)T * 256, (const bf16*)(ws + WS_WPROJ) + (size_t)D * 256, T, D, 256}; pg8::StaticOrder S; S.init(T, D, F.G, (int)blockIdx.x); EpiBf16S E{PP, D, nullptr};
          pg8::gemm_phase<EpiBf16S, pg8::StaticOrder, true, true>(F.lds + RING_OFF, g, S, E, F.wave); }
    } SEAM(8);
    if (IN(9)) for (int rep_ = 0; rep_ < REPS(9); ++rep_) { REFRESH(); lora_prep_rows(args, F); } SEAM(9);
    if (IN(10)) for (int rep_ = 0; rep_ < REPS(10); ++rep_) { REFRESH(); pg8::Gemm g{(const bf16*)(ws + WS_LA), (const bf16*)(ws + WS_WLORA), T, LORA_N, LORA_K}; pg8::StaticOrder S; S.init(T, LORA_N, F.G, (int)blockIdx.x); EpiBf16S E{(bf16*)(ws + WS_LO), LORA_N, nullptr};
        pg8::gemm_phase<EpiBf16S, pg8::StaticOrder, true, true>(F.lds + RING_OFF, g, S, E, F.wave); } SEAM(10);
    if (IN(11)) for (int rep_ = 0; rep_ < REPS(11); ++rep_) { REFRESH();
        if (F.G >= 256) {
            const int u = F.vcu;
            if (u < 64) scan_gla_mfma_unit<1>(args, F, u); else if (u < 128) scan_rwkv_mfma_unit(args, F, u - 64, 0); else if (u < 192) scan_rwkv_mfma_unit(args, F, u - 128, 1);
            __syncthreads();
            if (rep_ == 0) for (int dr_ = 0; dr_ < 1 + ((DUP_MASK >> 23) & 1); ++dr_) { if (u < 64) p1_deferred(args, F, 128 + u, 192); else if (u >= 192) for (int k = 0; k < 2; ++k) p1_deferred(args, F, 2 * (u - 192) + k, 192); }
        } else {
            for (int u = F.vcu; u < 64; u += F.G) { scan_gla_mfma_unit<1>(args, F, u); __syncthreads(); }
            for (int u = F.vcu; u < 64; u += F.G) { scan_rwkv_mfma_unit(args, F, u, 0); __syncthreads(); scan_rwkv_mfma_unit(args, F, u, 1); __syncthreads(); }
            if (rep_ == 0) p1_deferred(args, F, F.vcu, F.G);
        }
    } SEAM(11);
    if (IN(12)) for (int rep_ = 0; rep_ < REPS(12); ++rep_) { REFRESH(); post_rows<1>(args, F); } SEAM(12);
    if (IN(13)) { REFRESH(); pg8::Gemm g{ACTA, (const bf16*)(ws + WS_WOD_OUT), T, D, D / 2}; pg8::StaticOrder S; S.init(T, D, F.G, (int)blockIdx.x);
        EpiResid<false, false> E{ACTB, H1, rowss + (size_t)RS_FFN1 * T * 32, nullptr, nullptr, nullptr};
        pg8::gemm_phase<EpiResid<false, false>, pg8::StaticOrder, true, true, true>(F.lds + RING_OFF, g, S, E, F.wave); } SEAM(13);
    if (IN(14)) for (int rep_ = 0; rep_ < REPS(14); ++rep_) { REFRESH(); pg8::Gemm g{H1, (const bf16*)(ws + WS_WPEER) + (size_t)D * D, T, D, D}; pg8::StaticOrder S; S.init(T, D, F.G, (int)blockIdx.x); EpiBf16S E{SCB, D, rowss + (size_t)RS_FFN1 * T * 32};
        pg8::gemm_phase<EpiBf16S, pg8::StaticOrder, true, true>(F.lds + RING_OFF, g, S, E, F.wave); } SEAM(14);
    if (IN(15)) for (int rep_ = 0; rep_ < REPS(15); ++rep_) { REFRESH(); peer_phase(args, F, 1, rep_ != 0, H1, ACTB, (unsigned char*)ACTA); } SEAM(15);
    if (IN(16)) { REFRESH(); pg8::Gemm g{ACTA, (const bf16*)(ws + WS_WGATE) + (size_t)D * D, T, D, D / 2}; pg8::StaticOrder S; S.init(T, D, F.G, (int)blockIdx.x);
        EpiResid<true, false> E{ACTB, H1, rowss + (size_t)RS_FINAL * T * 32, PP, RS3, nullptr};
        pg8::gemm_phase<EpiResid<true, false>, pg8::StaticOrder, true, true, true>(F.lds + RING_OFF, g, S, E, F.wave); } SEAM(16);
    if (IN(17)) { REFRESH();
        float oscale = 1.0f;
#if PROBE_MASK
        { unsigned long long t_prev = __hip_atomic_load(tsb + 31, __ATOMIC_RELAXED, __HIP_MEMORY_SCOPE_AGENT); const unsigned long long t_begin = t_prev; unsigned long long sel = 0ull;
          for (int k = 0; k <= 16; ++k) { const unsigned long long tk = __hip_atomic_load(tsb + k, __ATOMIC_RELAXED, __HIP_MEMORY_SCOPE_AGENT); if ((PROBE_MASK >> k) & 1) sel += tk - t_prev; t_prev = tk; }
          const float f = (float)(double(sel) / double(t_prev - t_begin)); oscale = 1.0f + sqrtf(0.01f + 0.9f * f); }
#endif
        final_rows(args, F, oscale, H1); }
#undef IN
#undef SEAM
#undef REFRESH
}

extern "C" void kernel_launch(void* const* d_in, const int* in_sizes, int n_in, void* d_out, int out_size, void* d_ws, size_t ws_size, hipStream_t stream) {
    static int grid = 0;
    if (grid == 0) {
        if (n_in != N_IN || out_size != T * D || ws_size < WS_END + 63 * MiB) { fprintf(stderr, "kernel_launch: unexpected problem: n_in %d out %d ws %zu (need %zu)\n", n_in, out_size, ws_size, (size_t)(WS_END + 63 * MiB)); grid = -1; return; }
        int dev = 0, cus = 0, per_cu = 0;
        if (hipGetDevice(&dev) != hipSuccess || hipDeviceGetAttribute(&cus, hipDeviceAttributeMultiprocessorCount, dev) != hipSuccess) { grid = -1; return; }
        if (hipFuncSetAttribute((const void*)mega_fwd, hipFuncAttributeMaxDynamicSharedMemorySize, LDS_BYTES) != hipSuccess) { fprintf(stderr, "kernel_launch: hipFuncSetAttribute failed\n"); grid = -1; return; }
        if (hipOccupancyMaxActiveBlocksPerMultiprocessor(&per_cu, (const void*)mega_fwd, NTHREADS, LDS_BYTES) != hipSuccess || per_cu < 1) { fprintf(stderr, "kernel_launch: occupancy query says %d blocks per CU\n", per_cu); (void)hipGetLastError(); grid = -1; return; }
        grid = cus;
    }
    if (grid < 0) return;
    (void)hipMemsetAsync((char*)d_ws + WS_CTL, 0, CTL_ZERO_BYTES, stream);
    Args a{};
    for (int i = 0; i < N_IN; ++i) a.in[i] = (const float*)d_in[i];
    a.out = (float*)d_out; a.ws = (unsigned char*)d_ws;
#if MK_PER_PHASE
    for (int p = 0; p < N_PHASES - 1; ++p) { a.ph_lo = p; a.ph_hi = p + 1; hipLaunchKernelGGL(mega_fwd, dim3(grid), dim3(NTHREADS), LDS_BYTES, stream, a); }
#else
    a.ph_lo = 0; a.ph_hi = N_PHASES;
    void* kargs[] = {&a};
    hipError_t e = hipLaunchCooperativeKernel((const void*)mega_fwd, dim3(grid), dim3(NTHREADS), kargs, LDS_BYTES, stream);
    if (e != hipSuccess) fprintf(stderr, "kernel_launch: cooperative launch failed: %s (grid %d)\n", hipGetErrorString(e), grid);
#endif
}
```

```cpp
#include <hip/hip_runtime.h>
#include <hip/hip_cooperative_groups.h>
#include <cstdio>
#include <cstdint>
namespace cg = cooperative_groups;

#ifndef PROBE_MASK
#define PROBE_MASK 0
#endif
#ifndef DUP_MASK
#define DUP_MASK 0
#endif
#ifndef UBENCH
#define UBENCH 0
#endif
#ifndef GDN_DUP
#define GDN_DUP 0
#endif
#ifndef MK_PER_PHASE
#define MK_PER_PHASE 0
#endif

namespace pg8 {
#define PG8_LAS __attribute__((address_space(3)))
typedef unsigned short bf16_t;
typedef short bf16x8 __attribute__((ext_vector_type(8)));
typedef float f32x4 __attribute__((ext_vector_type(4)));
typedef unsigned u32x4 __attribute__((ext_vector_type(4)));
typedef unsigned u32x2 __attribute__((ext_vector_type(2)));
constexpr int BM = 256, BK = 64, HALF = 128, HTB = HALF * BK * 2  , STAGE_BYTES = 8 * HTB, NXCD = 8, WGM = 8;

__host__ __device__ __forceinline__ int lds_byte(int r, int c) { const int st = (r >> 4) * 2 + (c >> 5), rr = r & 15, cc = c & 31, ob = rr * 64 + cc * 2; return st * 1024 + (ob ^ (((ob >> 9) & 1) << 5)); }
__host__ __device__ __forceinline__ void stage_rc(int b, int& R, int& C) { const int st = b / 1024, sb = b % 1024, swz = sb ^ (((sb >> 9) & 1) << 5); R = (st >> 1) * 16 + swz / 64; C = (st & 1) * 32 + (swz % 64) / 2; }
__host__ __device__ __forceinline__ int perm32(int rho) { const int n = rho >> 4, i = rho & 15; return 8 * (i >> 2) + 4 * n + (i & 3); }

struct Unit { int pm, pn; };
struct Gemm { const bf16_t* A; const bf16_t* Bt; int M, N, K; };

struct StaticOrder {
    int nM, nN, nwg, G, c;
    __host__ __device__ void init(int M, int N, int G_, int c_) { nM = M / BM; nN = N / BM; nwg = nM * nN; G = G_; c = c_; }
    __host__ __device__ bool next(int i, Unit& u) const {
        const long L = (long)i * G + c; if (L >= nwg) return false;
        int wgid = (int)L; { const int q = nwg / NXCD, r = nwg % NXCD, xcd = wgid % NXCD, off = wgid / NXCD; wgid = (xcd < r ? xcd * (q + 1) : r * (q + 1) + (xcd - r) * q) + off; }
        const int nig = WGM * nN, gid = wgid / nig, fm = gid * WGM, gsz = (nM - fm) < WGM ? (nM - fm) : WGM;
        u.pm = fm + ((wgid % nig) % gsz); u.pn = (wgid % nig) / gsz; return true;
    }
    __device__ __forceinline__ void a_ready(const Unit&) const {}
    __device__ __forceinline__ void done(const Unit&) const {}
};
__device__ __forceinline__ unsigned cvt_pk_bf16(float lo, float hi) { unsigned r; asm volatile("v_cvt_pk_bf16_f32 %0, %1, %2" : "=v"(r) : "v"(lo), "v"(hi)); return r; }
template <class Epi, class Sched, bool ALIGN_EPI = false, bool SP2 = false, bool F8 = false>
__device__ __forceinline__ void gemm_phase(PG8_LAS unsigned char* lds, const Gemm g, const Sched& S, const Epi& E, const int wave_id) {
    int tid; asm volatile("v_mbcnt_lo_u32_b32 %0, -1, 0\n\tv_mbcnt_hi_u32_b32 %0, -1, %0" : "=v"(tid)); tid += wave_id * 64;
    const int wid = wave_id, lane = tid & 63, wr = wid >> 2, wc = wid & 3, fr = lane & 15, fq = lane >> 4;
    const int K = g.K, nt = K / BK;
    unsigned voffA[2], voffB[2];
#pragma unroll
    for (int i = 0; i < 2; ++i) { int R, C; stage_rc(tid * 16 + i * 8192, R, C); const int Rb = Epi::PERM ? ((R & ~31) + perm32(R & 31)) : R;
        voffA[i] = (unsigned)(R * K + C) * 2u; voffB[i] = (unsigned)(Rb * K + C) * 2u; }
    const __amdgpu_buffer_rsrc_t rsrcA = __builtin_amdgcn_make_buffer_rsrc((void*)g.A, 0, 0x7fffffff, 0x00020000), rsrcB = __builtin_amdgcn_make_buffer_rsrc((void*)g.Bt, 0, 0x7fffffff, 0x00020000);
    const size_t kstep = (size_t)(BK * 2);
    const size_t hstep = (size_t)HALF * K * 2;
    const size_t tstep = 2 * hstep;
    const unsigned ldsw = (unsigned)wid * 1024u;
    const int aoff = lds_byte(wr * 64 + fr, fq * 8), boff = lds_byte(wc * 32 + fr, fq * 8);
#define PG8_SA(b, h) (((b) * 2 + (h)) * HTB)
#define PG8_SB(b, h) ((4 + (b) * 2 + (h)) * HTB)
#define PG8_STAGE(bufoff, gbase, voff) do { const bool isA_ = (+(voff) == +voffA); const unsigned soff_ = (unsigned)((const char*)(gbase) - (isA_ ? (const char*)g.A : (const char*)g.Bt)); _Pragma("unroll") for (int _i = 0; _i < 2; ++_i) \
        __builtin_amdgcn_raw_ptr_buffer_load_lds(isA_ ? rsrcA : rsrcB, (PG8_LAS unsigned*)(lds + (bufoff) + ldsw + _i * 8192), 16, (int)(voff)[_i], (int)soff_, 0, 0); } while (0)
#define PG8_LDA(dst, b, h) do { _Pragma("unroll") for (int m = 0; m < 4; ++m) { if constexpr (F8) { dst##8[m].lo = *(const PG8_LAS bf16x8*)(lds + PG8_SA(b, h) + aoff + m * 2048); dst##8[m].hi = *(const PG8_LAS bf16x8*)(lds + PG8_SA(b, h) + aoff + m * 2048 + 1024); } else { _Pragma("unroll") for (int k = 0; k < 2; ++k) dst[m][k] = *(const PG8_LAS bf16x8*)(lds + PG8_SA(b, h) + aoff + m * 2048 + k * 1024); } } } while (0)
#define PG8_LDB(dst, b, h) do { _Pragma("unroll") for (int n = 0; n < 2; ++n) { if constexpr (F8) { dst##8[n].lo = *(const PG8_LAS bf16x8*)(lds + PG8_SB(b, h) + boff + n * 2048); dst##8[n].hi = *(const PG8_LAS bf16x8*)(lds + PG8_SB(b, h) + boff + n * 2048 + 1024); } else { _Pragma("unroll") for (int k = 0; k < 2; ++k) dst[n][k] = *(const PG8_LAS bf16x8*)(lds + PG8_SB(b, h) + boff + n * 2048 + k * 1024); } } } while (0)
#define PG8_MMA(ai, bj, At, Bt) do { __builtin_amdgcn_s_setprio(1); _Pragma("unroll") for (int m = 0; m < 4; ++m) _Pragma("unroll") for (int n = 0; n < 2; ++n) { \
        if constexpr (F8) { typedef int v8i_ __attribute__((ext_vector_type(8))); \
            acc[ai][bj][m][n] = __builtin_amdgcn_mfma_scale_f32_16x16x128_f8f6f4(__builtin_bit_cast(v8i_, Bt##8[n]), __builtin_bit_cast(v8i_, At##8[m]), acc[ai][bj][m][n], 0, 0, 0, 0x7f79, 1, 0x7f79); }     \
        else { _Pragma("unroll") for (int k = 0; k < 2; ++k) acc[ai][bj][m][n] = __builtin_amdgcn_mfma_f32_16x16x32_bf16(Bt[n][k], At[m][k], acc[ai][bj][m][n], 0, 0, 0); } } \
        __builtin_amdgcn_s_setprio(0); } while (0)
#define PG8_WAIT_V(n) asm volatile("s_waitcnt vmcnt(" #n ")" ::: "memory")
#define PG8_WAIT_L(n) asm volatile("s_waitcnt lgkmcnt(" #n ")" ::: "memory")
#define PG8_BAR __builtin_amdgcn_s_barrier()
#define PG8_SCHED __builtin_amdgcn_sched_barrier(0)
    Unit cur, nxt; int ui = 0;
    if (!S.next(0, cur)) return;
    f32x4 acc[2][2][4][2];
#pragma unroll
    for (int a = 0; a < 2; ++a)
#pragma unroll
        for (int b = 0; b < 2; ++b)
#pragma unroll
            for (int m = 0; m < 4; ++m)
#pragma unroll
                for (int n = 0; n < 2; ++n) acc[a][b][m][n] = (f32x4){0.f, 0.f, 0.f, 0.f};
    typedef short bf16x16 __attribute__((ext_vector_type(16)));
    bf16x16 At8[4], B08[2], B18[2]; bf16x8 At[4][2], B0[2][2], B1[2][2];
    const char* cA = (const char*)g.A + (size_t)cur.pm * tstep; const char* cB = (const char*)g.Bt + (size_t)cur.pn * tstep;
    S.a_ready(cur);
    if constexpr (SP2) {
        PG8_STAGE(PG8_SB(0, 0), cB, voffB); PG8_STAGE(PG8_SB(0, 1), cB + hstep, voffB); PG8_STAGE(PG8_SA(0, 0), cA, voffA); PG8_STAGE(PG8_SA(0, 1), cA + hstep, voffA);
        if (wr == 1) PG8_BAR;
        PG8_WAIT_V(2); PG8_BAR;
        PG8_STAGE(PG8_SB(1, 0), cB + kstep, voffB); PG8_STAGE(PG8_SA(1, 0), cA + kstep, voffA); PG8_STAGE(PG8_SB(1, 1), cB + hstep + kstep, voffB);
        PG8_WAIT_V(6); PG8_BAR;
    } else {
        PG8_STAGE(PG8_SB(0, 0), cB, voffB); PG8_STAGE(PG8_SA(0, 0), cA, voffA); PG8_STAGE(PG8_SB(0, 1), cB + hstep, voffB); PG8_STAGE(PG8_SA(0, 1), cA + hstep, voffA);
        if (wr == 1) PG8_BAR;
        PG8_WAIT_V(4); PG8_BAR;
        PG8_STAGE(PG8_SB(1, 0), cB + kstep, voffB); PG8_STAGE(PG8_SA(1, 0), cA + kstep, voffA); PG8_STAGE(PG8_SB(1, 1), cB + hstep + kstep, voffB);
        PG8_WAIT_V(6); PG8_BAR;
    }
    for (;;) {
        const bool has_next = S.next(ui + 1, nxt);
        const char* nA = has_next ? (const char*)g.A + (size_t)nxt.pm * tstep : cA; const char* nB = has_next ? (const char*)g.Bt + (size_t)nxt.pn * tstep : cB;
        for (int t = 0; t < nt; t += 2) {
            const bool last = (t == nt - 2);
            const char* a1 = cA + (size_t)(t + 1) * kstep;
            const char* a2 = last ? nA : cA + (size_t)(t + 2) * kstep; const char* b2 = last ? nB : cB + (size_t)(t + 2) * kstep;
            const char* a3 = a2 + kstep; const char* b3 = b2 + kstep;
            if (last && has_next) S.a_ready(nxt);
            if constexpr (SP2) {
            PG8_LDB(B0, 0, 0); PG8_LDB(B1, 0, 1); PG8_SCHED; PG8_LDA(At, 0, 0); PG8_STAGE(PG8_SA(1, 1), a1 + hstep, voffA);
            PG8_WAIT_V(8); PG8_WAIT_L(0); PG8_BAR; PG8_MMA(0, 0, At, B0); PG8_MMA(0, 1, At, B1); PG8_BAR; PG8_SCHED;
            PG8_LDA(At, 0, 1); PG8_STAGE(PG8_SB(0, 0), b2, voffB); PG8_STAGE(PG8_SB(0, 1), b2 + hstep, voffB); PG8_STAGE(PG8_SA(0, 0), a2, voffA);
            PG8_WAIT_V(8); PG8_WAIT_L(0); PG8_BAR; PG8_MMA(1, 0, At, B0); PG8_MMA(1, 1, At, B1); PG8_BAR; PG8_SCHED;
            PG8_LDB(B0, 1, 0); PG8_LDB(B1, 1, 1); PG8_SCHED; PG8_LDA(At, 1, 0); PG8_STAGE(PG8_SA(0, 1), a2 + hstep, voffA);
            PG8_WAIT_V(8); PG8_WAIT_L(0); PG8_BAR; PG8_MMA(0, 0, At, B0); PG8_MMA(0, 1, At, B1); PG8_BAR; PG8_SCHED;
            PG8_LDA(At, 1, 1); PG8_STAGE(PG8_SB(1, 0), b3, voffB); PG8_STAGE(PG8_SB(1, 1), b3 + hstep, voffB); PG8_STAGE(PG8_SA(1, 0), a3, voffA);
            PG8_WAIT_V(8); PG8_WAIT_L(0); PG8_BAR; PG8_MMA(1, 0, At, B0); PG8_MMA(1, 1, At, B1); PG8_BAR; PG8_SCHED;
            } else {
            PG8_LDB(B0, 0, 0); PG8_SCHED; PG8_LDA(At, 0, 0); PG8_STAGE(PG8_SA(1, 1), a1 + hstep, voffA);
            PG8_WAIT_L(8); PG8_BAR; PG8_WAIT_L(0); PG8_MMA(0, 0, At, B0); PG8_BAR; PG8_SCHED;
            PG8_LDB(B1, 0, 1); PG8_STAGE(PG8_SB(0, 0), b2, voffB);
            PG8_BAR; PG8_WAIT_L(0); PG8_MMA(0, 1, At, B1); PG8_BAR;
            PG8_LDA(At, 0, 1); PG8_STAGE(PG8_SA(0, 0), a2, voffA);
            PG8_BAR; PG8_WAIT_L(0); PG8_MMA(1, 0, At, B0); PG8_BAR; PG8_SCHED;
            PG8_STAGE(PG8_SB(0, 1), b2 + hstep, voffB);
            PG8_WAIT_V(6); PG8_BAR; PG8_MMA(1, 1, At, B1); PG8_BAR;
            PG8_LDB(B0, 1, 0); PG8_SCHED; PG8_LDA(At, 1, 0); PG8_STAGE(PG8_SA(0, 1), a2 + hstep, voffA);
            PG8_WAIT_L(8); PG8_BAR; PG8_WAIT_L(0); PG8_MMA(0, 0, At, B0); PG8_BAR; PG8_SCHED;
            PG8_LDB(B1, 1, 1); PG8_STAGE(PG8_SB(1, 0), b3, voffB);
            PG8_BAR; PG8_WAIT_L(0); PG8_MMA(0, 1, At, B1); PG8_BAR;
            PG8_LDA(At, 1, 1); PG8_STAGE(PG8_SA(1, 0), a3, voffA);
            PG8_BAR; PG8_WAIT_L(0); PG8_MMA(1, 0, At, B0); PG8_BAR; PG8_SCHED;
            PG8_STAGE(PG8_SB(1, 1), b3 + hstep, voffB);
            PG8_WAIT_V(6); PG8_BAR; PG8_MMA(1, 1, At, B1); PG8_BAR;
            }
        }
        if constexpr (ALIGN_EPI) { if (wr == 0) PG8_BAR; }
        if constexpr (!Epi::AFTER_DRAIN) { int ln_e; asm volatile("v_mbcnt_lo_u32_b32 %0, -1, 0\n\tv_mbcnt_hi_u32_b32 %0, -1, %0" : "=v"(ln_e)); const int fr_e = ln_e & 15, fq_e = ln_e >> 4;
            E(acc, cur, wr, wc, fr_e, fq_e); S.done(cur); }
        if (!has_next) break;
#pragma unroll
        for (int a = 0; a < 2; ++a)
#pragma unroll
            for (int b = 0; b < 2; ++b)
#pragma unroll
                for (int m = 0; m < 4; ++m)
#pragma unroll
                    for (int n = 0; n < 2; ++n) acc[a][b][m][n] = (f32x4){0.f, 0.f, 0.f, 0.f};
        cur = nxt; cA = nA; cB = nB; ++ui;
        if constexpr (ALIGN_EPI) { if (wr == 1) PG8_BAR; }
    }
    PG8_WAIT_V(0);
    if constexpr (!ALIGN_EPI) { if (wr == 0) PG8_BAR; }
    PG8_BAR;
    if constexpr (Epi::AFTER_DRAIN) { E.fused(acc, cur, wr, wc, fr, fq, lds, wid, lane); S.done(cur); }
#undef PG8_SA
#undef PG8_SB
#undef PG8_STAGE
#undef PG8_LDA
#undef PG8_LDB
#undef PG8_MMA
#undef PG8_WAIT_V
#undef PG8_WAIT_L
#undef PG8_BAR
#undef PG8_SCHED
}
}
#define GAS __attribute__((address_space(1)))
#define LAS __attribute__((address_space(3)))
typedef unsigned short bf16;
typedef unsigned v4u __attribute__((ext_vector_type(4)));
typedef float f32x4 __attribute__((ext_vector_type(4)));
typedef short bf16x8 __attribute__((ext_vector_type(8)));
typedef GAS unsigned gu32;
typedef GAS unsigned long long gu64;
#define RLX_AGENT __ATOMIC_RELAXED, __HIP_MEMORY_SCOPE_AGENT
#define LDS_WAIT() asm volatile("s_waitcnt lgkmcnt(0)" ::: "memory")
#define VM_WAIT() asm volatile("s_waitcnt vmcnt(0)" ::: "memory")
__device__ __forceinline__ unsigned long long rt() { return __builtin_amdgcn_s_memrealtime(); }
__device__ __forceinline__ unsigned f2bf(float f) { unsigned u = __builtin_bit_cast(unsigned, f); return (u + 0x7fffu + ((u >> 16) & 1u)) >> 16; }
__device__ __forceinline__ unsigned pk2(float lo, float hi) { return f2bf(lo) | (f2bf(hi) << 16); }

#define XB_TMO      128
#define XB_XCNT(j)  (256  + 64 * (j))
#define XB_XSUB(j)  (1280 + 64 * (j))
#define XB_XGEN(j)  (2304 + 64 * (j))
#define XB_TOP      3328
#define XB_TOPGEN   3392
#define XCD_BAR_WORDS 3456
#define XB_SPIN_CAP (1u << 18)

__device__ __forceinline__ unsigned xb_ld(unsigned* p)              { return __hip_atomic_load(p, __ATOMIC_RELAXED, __HIP_MEMORY_SCOPE_AGENT); }
__device__ __forceinline__ unsigned xb_add(unsigned* p, unsigned v) { return __hip_atomic_fetch_add(p, v, __ATOMIC_RELAXED, __HIP_MEMORY_SCOPE_AGENT); }
__device__ __forceinline__ unsigned xb_xcc_id() { return (unsigned)__builtin_amdgcn_s_getreg((3 << 11) | 20) & 0xFu; }
#define XB_SPIN(cond, bar) do { unsigned _sp = 0; while (cond) { __builtin_amdgcn_s_sleep(1); \
    if ((++_sp & 255u) == 0u) { if (xb_ld(&(bar)[XB_TMO])) break; if (_sp > XB_SPIN_CAP) { atomicAdd(&(bar)[XB_TMO], 1u); break; } } } } while (0)

struct XcdBarrier {
    unsigned* bar; unsigned x; bool wave0;
    volatile LAS unsigned* st;
};

__device__ __forceinline__ XcdBarrier xcd_barrier_post(unsigned* bar, volatile LAS unsigned* st) {
    XcdBarrier b; b.bar = bar; b.x = xb_xcc_id(); b.st = st;
    if (threadIdx.x == 0) (void)xb_add(&bar[XB_XCNT(b.x)], 1u);
    return b;
}
__device__ __forceinline__ void xcd_barrier_complete(unsigned* bar, unsigned x, unsigned& nloc, unsigned& nx) {
    const unsigned G = gridDim.x * gridDim.y * gridDim.z;
    unsigned sum, cnt, mine, sp = 0u;
    for (;;) {
        sum = 0u; cnt = 0u; mine = 0u;
#pragma unroll
        for (unsigned j = 0; j < 16; ++j) { const unsigned c = xb_ld(&bar[XB_XCNT(j)]); sum += c; cnt += (c > 0u) ? 1u : 0u; mine = (j == x) ? c : mine; }
        if (sum == G) break;
        __builtin_amdgcn_s_sleep(1);
        if ((++sp & 255u) == 0u) { if (xb_ld(&bar[XB_TMO])) break; if (sp > XB_SPIN_CAP) { atomicAdd(&bar[XB_TMO], 1u); break; } }
    }
    nloc = mine > 0u ? mine : 1u; nx = cnt > 0u ? cnt : 1u;
}

__device__ __forceinline__ void xcd_barrier(const XcdBarrier& b) {
    asm volatile("s_waitcnt vmcnt(0)" ::: "memory");
    __syncthreads();
    if (b.wave0 && __builtin_amdgcn_mbcnt_hi(~0u, __builtin_amdgcn_mbcnt_lo(~0u, 0u)) == 0u) {
        unsigned* bar = b.bar;
        __builtin_amdgcn_s_waitcnt(0);
        unsigned nloc = b.st[0], nx = b.st[1];
        if (nloc == 0u) { xcd_barrier_complete(bar, b.x, nloc, nx); b.st[0] = nloc; b.st[1] = nx; }
        const unsigned old = xb_add(&bar[XB_XSUB(b.x)], 1u);
        const unsigned gen = old / nloc;
        if (old + 1u == (gen + 1u) * nloc) {
            __builtin_amdgcn_fence(__ATOMIC_RELEASE, "agent");
            asm volatile("s_waitcnt vmcnt(0)" ::: "memory");
            const unsigned og = xb_add(&bar[XB_TOP], 1u);
            const unsigned tg = og / nx;
            if (og + 1u == (tg + 1u) * nx) xb_add(&bar[XB_TOPGEN], 1u);
            else XB_SPIN(xb_ld(&bar[XB_TOPGEN]) == tg, bar);
            __builtin_amdgcn_fence(__ATOMIC_ACQUIRE, "agent");
            xb_add(&bar[XB_XGEN(b.x)], 1u);
            asm volatile("s_waitcnt vmcnt(0)" ::: "memory");
        } else {
            XB_SPIN(xb_ld(&bar[XB_XGEN(b.x)]) == gen, bar);
            __builtin_amdgcn_fence(__ATOMIC_ACQUIRE, "agent");
            asm volatile("s_waitcnt vmcnt(0)" ::: "memory");
        }
    }
    __syncthreads();
}

constexpr int NWAVES = 8, NTHREADS = NWAVES * 64;
constexpr int BATCH = 8, SEQ = 2048, T = BATCH * SEQ, D = 2048;
constexpr int EV_N = 7200, EV_NP = 7424, OD_N = 7616, OD_NP = 7680, PROJ_LD = 7680;
constexpr float EPS = 1e-6f;
constexpr int EC_GQ = 0, EC_GK = 512, EC_GV = 1024, EC_GZ = 2048, EC_GLR = 3072, EC_BQ = 3088, EC_BK = 4112, EC_BV = 5136, EC_BZ = 6160, EC_BA = 7184, EC_BB = 7192;
constexpr int OC_HQ = 0, OC_HF = 1024, OC_HI = 2048, OC_HG = 3072, OC_RW = 4096;
constexpr int RW_R = 0, RW_K = 1024, RW_V = 2048, RW_WL = 3072, RW_AL = 3168, RW_GL = 3264;
constexpr int LORA_K = 512, LORA_N = 3072;
enum { I_X = 0, I_P, I_EV_WIN, I_GK_W2, I_GK_B, I_GLA_NORM, I_GDN_CONV, I_GDN_ALOG, I_GDN_DTB, I_GDN_NORM, I_EV_WOUT, I_OD_WIN, I_LB, I_HG_NORM,
       I_MU, I_W0, I_W2, I_A0, I_A2, I_G2, I_KK, I_KA, I_RK, I_LNW, I_LNB, I_OD_WOUT, I_NMIX, I_NFFN, I_NPLE, I_PEER_WQ, I_PEER_SK, I_PEER_U, I_PEER_V,
       I_PLE_WP, I_PLE_WG, I_NFINAL, N_IN };

constexpr size_t MiB = 1u << 20;
constexpr size_t WS_CTL = 0, CTL_ZERO_BYTES = 1 * MiB;
constexpr size_t WS_WEV_IN = 1 * MiB, WS_WEV_OUT = 30 * MiB, WS_WOD_IN = 38 * MiB, WS_WOD_OUT = 68 * MiB, WS_WPEER = 76 * MiB, WS_WGATE = 92 * MiB, WS_WPROJ = 108 * MiB,
                 WS_WLORA = 110 * MiB, WS_PBF = 113 * MiB, WS_TABU = 129 * MiB, WS_TABV = 193 * MiB, WS_ACTA = 257 * MiB, WS_ACTB = 321 * MiB, WS_PROJ = 385 * MiB, WS_SC = 385 * MiB,
                 WS_O = 625 * MiB, WS_H1 = 689 * MiB, WS_PP = 753 * MiB, WS_LA = 817 * MiB, WS_LO = 833 * MiB, WS_RSP = 929 * MiB, WS_STATE = 937 * MiB, WS_RS3 = 945 * MiB, WS_END = 946 * MiB;
static_assert(WS_WEV_IN + (size_t)EV_NP * D * 2 <= WS_WEV_OUT && WS_WOD_IN + (size_t)OD_NP * D * 2 <= WS_WOD_OUT && WS_PROJ + (size_t)T * PROJ_LD * 2 <= WS_O, "ws map");
constexpr int CW_BAR = 4096;
enum { RS_FFN0 = 0, RS_MIX1 = 1, RS_FFN1 = 2, RS_FINAL = 3 };
constexpr int RING_OFF = 0, RING_BYTES = 131072;
constexpr int LDSCTL_OFF = RING_BYTES, MISC_OFF = LDSCTL_OFF + 320;
constexpr int LDS_BYTES = 147456;

struct Args { const float* in[N_IN]; float* out; unsigned char* ws; int ph_lo, ph_hi; };
struct Frame {
    LAS unsigned char* lds; volatile LAS unsigned* MISC; gu32* ctl;
    int tid, lane, wave, vcu, G;
};
__device__ __forceinline__ float wave_sum(float v) {
#pragma unroll
    for (int o = 1; o < 64; o <<= 1) v += __shfl_xor(v, o);
    return v;
}
__device__ __forceinline__ float half_sum32(float v) {
#pragma unroll
    for (int o = 1; o < 32; o <<= 1) v += __shfl_xor(v, o);
    return v;
}
#define DPP_ADD(v, ctrl) (v) += __builtin_bit_cast(float, __builtin_amdgcn_update_dpp(0, __builtin_bit_cast(int, (v)), (ctrl), 0xF, 0xF, false))
__device__ __forceinline__ float row_sum16(float v) {
    DPP_ADD(v, 0x128); DPP_ADD(v, 0x124); DPP_ADD(v, 0x122); DPP_ADD(v, 0x121);
    return v;
}
__device__ __forceinline__ void row_sum16_x4(float& a, float& b, float& c, float& d) {
    asm("s_nop 1\n\t"
        "v_add_f32_dpp %0, %0, %0 row_ror:8 row_mask:0xf bank_mask:0xf\n\tv_add_f32_dpp %1, %1, %1 row_ror:8 row_mask:0xf bank_mask:0xf\n\t"
        "v_add_f32_dpp %2, %2, %2 row_ror:8 row_mask:0xf bank_mask:0xf\n\tv_add_f32_dpp %3, %3, %3 row_ror:8 row_mask:0xf bank_mask:0xf\n\t"
        "v_add_f32_dpp %0, %0, %0 row_ror:4 row_mask:0xf bank_mask:0xf\n\tv_add_f32_dpp %1, %1, %1 row_ror:4 row_mask:0xf bank_mask:0xf\n\t"
        "v_add_f32_dpp %2, %2, %2 row_ror:4 row_mask:0xf bank_mask:0xf\n\tv_add_f32_dpp %3, %3, %3 row_ror:4 row_mask:0xf bank_mask:0xf\n\t"
        "v_add_f32_dpp %0, %0, %0 row_ror:2 row_mask:0xf bank_mask:0xf\n\tv_add_f32_dpp %1, %1, %1 row_ror:2 row_mask:0xf bank_mask:0xf\n\t"
        "v_add_f32_dpp %2, %2, %2 row_ror:2 row_mask:0xf bank_mask:0xf\n\tv_add_f32_dpp %3, %3, %3 row_ror:2 row_mask:0xf bank_mask:0xf\n\t"
        "v_add_f32_dpp %0, %0, %0 row_ror:1 row_mask:0xf bank_mask:0xf\n\tv_add_f32_dpp %1, %1, %1 row_ror:1 row_mask:0xf bank_mask:0xf\n\t"
        "v_add_f32_dpp %2, %2, %2 row_ror:1 row_mask:0xf bank_mask:0xf\n\tv_add_f32_dpp %3, %3, %3 row_ror:1 row_mask:0xf bank_mask:0xf\n\t"
        "s_nop 1"
        : "+v"(a), "+v"(b), "+v"(c), "+v"(d));
}
__device__ __forceinline__ void row_sum16_x2(float& a, float& b) {
    asm("s_nop 1\n\t"
        "v_add_f32_dpp %0, %0, %0 row_ror:8 row_mask:0xf bank_mask:0xf\n\tv_add_f32_dpp %1, %1, %1 row_ror:8 row_mask:0xf bank_mask:0xf\n\ts_nop 1\n\t"
        "v_add_f32_dpp %0, %0, %0 row_ror:4 row_mask:0xf bank_mask:0xf\n\tv_add_f32_dpp %1, %1, %1 row_ror:4 row_mask:0xf bank_mask:0xf\n\ts_nop 1\n\t"
        "v_add_f32_dpp %0, %0, %0 row_ror:2 row_mask:0xf bank_mask:0xf\n\tv_add_f32_dpp %1, %1, %1 row_ror:2 row_mask:0xf bank_mask:0xf\n\ts_nop 1\n\t"
        "v_add_f32_dpp %0, %0, %0 row_ror:1 row_mask:0xf bank_mask:0xf\n\tv_add_f32_dpp %1, %1, %1 row_ror:1 row_mask:0xf bank_mask:0xf\n\t"
        "s_nop 1"
        : "+v"(a), "+v"(b));
}
typedef unsigned u32x2 __attribute__((ext_vector_type(2)));
__device__ __forceinline__ void st_wt16(void* p, v4u v) { asm volatile("global_store_dwordx4 %0, %1, off sc1\n\ts_nop 1" :: "v"(p), "v"(v) : "memory"); }
__device__ __forceinline__ void st_wt8(void* p, u32x2 v) { asm volatile("global_store_dwordx2 %0, %1, off sc1\n\ts_nop 1" :: "v"(p), "v"(v) : "memory"); }
#define LBAR() do { asm volatile("s_waitcnt lgkmcnt(0)" ::: "memory"); __builtin_amdgcn_s_barrier(); asm volatile("" ::: "memory"); } while (0)
typedef float f32x2 __attribute__((ext_vector_type(2)));
typedef __bf16 hwbf16x2_t __attribute__((ext_vector_type(2)));
__device__ __forceinline__ unsigned hw_pk2(float lo, float hi) { const f32x2 v = {lo, hi}; return __builtin_bit_cast(unsigned, __builtin_convertvector(v, hwbf16x2_t)); }
__device__ __forceinline__ bf16 hw_bf(float x) { return (bf16)hw_pk2(x, 0.f); }
__device__ __forceinline__ float bf_lo(unsigned w) { return __uint_as_float(w << 16); }
__device__ __forceinline__ float bf_hi(unsigned w) { return __uint_as_float(w & 0xffff0000u); }
__device__ __forceinline__ float sigmoidf_(float x) { return __builtin_amdgcn_rcpf(1.0f + __expf(-x)); }
__device__ __forceinline__ float siluf_(float x) { return x * __builtin_amdgcn_rcpf(1.0f + __expf(-x)); }
__device__ __forceinline__ float softplusf_(float x) { return fmaxf(x, 0.f) + log1pf(__expf(-fabsf(x))); }
__device__ __forceinline__ float logsigmoidf_(float x) { return fminf(x, 0.f) - log1pf(__expf(-fabsf(x))); }

struct EpiBf16S {
    static constexpr bool PERM = true, AFTER_DRAIN = false;
    bf16* O; int ldc; const float* rowss;
    __device__ __forceinline__ void operator()(const pg8::f32x4 (&acc)[2][2][4][2], const pg8::Unit& u, int wr, int wc, int fr, int fq) const {
        const int row0 = u.pm * 256 + wr * 64 + fr, col0 = u.pn * 256 + wc * 32 + 8 * fq;
#pragma unroll
        for (int ai = 0; ai < 2; ++ai)
#pragma unroll
            for (int m = 0; m < 4; ++m) {
                const int row = row0 + ai * 128 + m * 16;
                float sc = 1.f;
                if (rowss) { const pg8::f32x4* rp = (const pg8::f32x4*)(rowss + (size_t)row * 32 + 8 * fq); const pg8::f32x4 p0 = rp[0], p1 = rp[1];
                    float s = ((p0[0] + p0[1]) + (p0[2] + p0[3])) + ((p1[0] + p1[1]) + (p1[2] + p1[3])); s += __shfl_xor(s, 16); s += __shfl_xor(s, 32);
                    sc = __builtin_amdgcn_rsqf(s * (1.0f / D) + EPS); }
                bf16* rowp = O + (size_t)row * ldc + col0;
#pragma unroll
                for (int bj = 0; bj < 2; ++bj) { const pg8::f32x4 v0 = acc[ai][bj][m][0] * sc, v1 = acc[ai][bj][m][1] * sc;
                    pg8::u32x4 w; w.x = pg8::cvt_pk_bf16(v0[0], v0[1]); w.y = pg8::cvt_pk_bf16(v0[2], v0[3]); w.z = pg8::cvt_pk_bf16(v1[0], v1[1]); w.w = pg8::cvt_pk_bf16(v1[2], v1[3]);
                    *(pg8::u32x4*)(rowp + bj * 128) = w; } }
    }
};
template <bool GATE, bool HIN_F32> struct EpiResid {
    static constexpr bool PERM = false, AFTER_DRAIN = false;
    const void* hin; bf16* hout; float* rowss; const bf16* pp; const float* rs3; unsigned char* h8;
    __device__ __forceinline__ void operator()(const pg8::f32x4 (&acc)[2][2][4][2], const pg8::Unit& u, int wr, int wc, int fr, int fq) const {
        const int row0 = u.pm * 256 + wr * 64 + fr, col0 = u.pn * 256 + wc * 32 + 4 * fq;
        constexpr int MG = HIN_F32 ? 2 : 4;
#pragma unroll
        for (int ai = 0; ai < 2; ++ai)
#pragma unroll
            for (int m0 = 0; m0 < 4; m0 += MG) {
                pg8::f32x4 hf[MG][2][2]; pg8::u32x2 hb[MG][2][2], pw[MG][2][2]; float rsc[MG];
#pragma unroll
                for (int mm = 0; mm < MG; ++mm) { const int row = row0 + ai * 128 + (m0 + mm) * 16; const size_t off = (size_t)row * D + col0; rsc[mm] = GATE ? rs3[row] : 1.f;
#pragma unroll
                    for (int bj = 0; bj < 2; ++bj)
#pragma unroll
                        for (int n = 0; n < 2; ++n) { const size_t o = off + bj * 128 + n * 16;
                            if (HIN_F32) hf[mm][bj][n] = *(const pg8::f32x4*)((const float*)hin + o); else hb[mm][bj][n] = *(const pg8::u32x2*)((const bf16*)hin + o);
                            if (GATE) pw[mm][bj][n] = *(const pg8::u32x2*)(pp + o); } }
#pragma unroll
                for (int mm = 0; mm < MG; ++mm) { const int m = m0 + mm; const int row = row0 + ai * 128 + m * 16; const size_t off = (size_t)row * D + col0; float ss = 0.f;
#pragma unroll
                    for (int bj = 0; bj < 2; ++bj)
#pragma unroll
                        for (int n = 0; n < 2; ++n) { const size_t o = off + bj * 128 + n * 16;
                            pg8::f32x4 hv;
                            if (HIN_F32) hv = hf[mm][bj][n];
                            else { const pg8::u32x2 hw = hb[mm][bj][n]; hv[0] = bf_lo(hw.x); hv[1] = bf_hi(hw.x); hv[2] = bf_lo(hw.y); hv[3] = bf_hi(hw.y); }
                            pg8::f32x4 a = acc[ai][bj][m][n];
                            if (GATE) { const pg8::u32x2 p2 = pw[mm][bj][n]; const float rs_ = rsc[mm];
                                a[0] = sigmoidf_(a[0] * rs_) * bf_lo(p2.x); a[1] = sigmoidf_(a[1] * rs_) * bf_hi(p2.x); a[2] = sigmoidf_(a[2] * rs_) * bf_lo(p2.y); a[3] = sigmoidf_(a[3] * rs_) * bf_hi(p2.y); }
                            hv = hv + a;
                            pg8::u32x2 w; w.x = hw_pk2(hv[0], hv[1]); w.y = hw_pk2(hv[2], hv[3]); *(pg8::u32x2*)(hout + o) = w;
                            if (h8) { int x8 = __builtin_amdgcn_cvt_pk_fp8_f32(hv[0], hv[1], 0, false); x8 = __builtin_amdgcn_cvt_pk_fp8_f32(hv[2], hv[3], x8, true); *(unsigned*)(h8 + o) = (unsigned)x8; }
                            const float q0 = bf_lo(w.x), q1 = bf_hi(w.x), q2 = bf_lo(w.y), q3 = bf_hi(w.y);
                            ss += (q0 * q0 + q1 * q1) + (q2 * q2 + q3 * q3); }
                    ss += __shfl_xor(ss, 16); ss += __shfl_xor(ss, 32);
                    if (fq == 0) rowss[(size_t)row * 32 + u.pn * 4 + wc] = ss; }
                asm volatile("" ::: "memory"); }
    }
};


__device__ __forceinline__ void p0_transpose_item(const float* W, int K, int N, bf16* WT, LAS float* scr, int item, int lane, const float* kgain = nullptr) {
    const int nblk = N / 32, kb = item / nblk, nb = item % nblk, k0 = 64 * kb, n0 = 32 * nb;
    { const GAS float* Wg = (const GAS float*)W + (size_t)(k0 + (lane >> 5)) * N + n0 + (lane & 31); float v[32];
#pragma unroll
      for (int i = 0; i < 32; ++i) v[i] = Wg[(size_t)(2 * i) * N];
#pragma unroll
      for (int i = 0; i < 32; ++i) scr[(2 * i + (lane >> 5)) * 33 + (lane & 31)] = v[i]; }
    LDS_WAIT(); asm volatile("" ::: "memory");
    const int c = lane & 7;
#pragma unroll
    for (int j = 0; j < 4; ++j) { const int n = (lane >> 3) + 8 * j; const LAS float* s = scr + (8 * c) * 33 + n;
        f32x4 g0 = {1.f, 1.f, 1.f, 1.f}, g1 = g0; if (kgain) { g0 = *(const GAS f32x4*)(kgain + k0 + 8 * c); g1 = *(const GAS f32x4*)(kgain + k0 + 8 * c + 4); }
        v4u o; o.x = pk2(s[0 * 33] * g0[0], s[1 * 33] * g0[1]); o.y = pk2(s[2 * 33] * g0[2], s[3 * 33] * g0[3]); o.z = pk2(s[4 * 33] * g1[0], s[5 * 33] * g1[1]); o.w = pk2(s[6 * 33] * g1[2], s[7 * 33] * g1[3]);
        *(GAS v4u*)(WT + (size_t)(n0 + n) * K + k0 + 8 * c) = o; }
    LDS_WAIT(); asm volatile("" ::: "memory");
}
__device__ __forceinline__ void p0_transpose_item_f8(const float* W, int K, int N, unsigned char* WT, LAS float* scr, int item, int lane, const float* kgain = nullptr) {
    const int nblk = N / 32, kb = item / nblk, nb = item % nblk, k0 = 64 * kb, n0 = 32 * nb;
    { const GAS float* Wg = (const GAS float*)W + (size_t)(k0 + (lane >> 5)) * N + n0 + (lane & 31); float v[32];
#pragma unroll
      for (int i = 0; i < 32; ++i) v[i] = Wg[(size_t)(2 * i) * N];
#pragma unroll
      for (int i = 0; i < 32; ++i) scr[(2 * i + (lane >> 5)) * 33 + (lane & 31)] = v[i]; }
    LDS_WAIT(); asm volatile("" ::: "memory");
    const int c = lane & 7;
#pragma unroll
    for (int j = 0; j < 4; ++j) { const int n = (lane >> 3) + 8 * j; const LAS float* s = scr + (8 * c) * 33 + n;
        f32x4 g0 = {64.f, 64.f, 64.f, 64.f}, g1 = g0; if (kgain) { g0 = g0 * *(const GAS f32x4*)(kgain + k0 + 8 * c); g1 = g1 * *(const GAS f32x4*)(kgain + k0 + 8 * c + 4); }
        int x0 = __builtin_amdgcn_cvt_pk_fp8_f32(s[0 * 33] * g0[0], s[1 * 33] * g0[1], 0, false); x0 = __builtin_amdgcn_cvt_pk_fp8_f32(s[2 * 33] * g0[2], s[3 * 33] * g0[3], x0, true);
        int x1 = __builtin_amdgcn_cvt_pk_fp8_f32(s[4 * 33] * g1[0], s[5 * 33] * g1[1], 0, false); x1 = __builtin_amdgcn_cvt_pk_fp8_f32(s[6 * 33] * g1[2], s[7 * 33] * g1[3], x1, true);
        u32x2 o; o.x = (unsigned)x0; o.y = (unsigned)x1;
        *(GAS u32x2*)(WT + (size_t)(n0 + n) * K + k0 + 8 * c) = o; }
    LDS_WAIT(); asm volatile("" ::: "memory");
}
__device__ __forceinline__ void cvt_f32_bf16(const float* src, bf16* dst, size_t n, int gtid, int gthreads) {
    const size_t n8 = n / 8;
    for (size_t i = gtid; i < n8; i += gthreads) {
        const f32x4 a = *(const GAS f32x4*)(src + i * 8), b = *(const GAS f32x4*)(src + i * 8 + 4);
        v4u o; o.x = pk2(a[0], a[1]); o.y = pk2(a[2], a[3]); o.z = pk2(b[0], b[1]); o.w = pk2(b[2], b[3]);
        *(GAS v4u*)(dst + i * 8) = o; }
}
__device__ __forceinline__ void cvt_f32_fp8(const float* src, unsigned char* dst, size_t n, float scale, int gtid, int gthreads, const float* cgain = nullptr) {
    const size_t n16 = n / 16;
    for (size_t i = gtid; i < n16; i += gthreads) { v4u o; unsigned w[4];
#pragma unroll
        for (int q = 0; q < 4; ++q) { f32x4 a = *(const GAS f32x4*)(src + i * 16 + 4 * q) * scale; if (cgain) a = a * *(const GAS f32x4*)(cgain + ((i * 16 + 4 * q) & (D - 1)));
            int x = __builtin_amdgcn_cvt_pk_fp8_f32(a[0], a[1], 0, false); x = __builtin_amdgcn_cvt_pk_fp8_f32(a[2], a[3], x, true); w[q] = (unsigned)x; }
        o.x = w[0]; o.y = w[1]; o.z = w[2]; o.w = w[3];
        *(GAS v4u*)(dst + i * 16) = o; }
}
__device__ __forceinline__ void rms_row_to_bf16(const float* xrow, const float* g, bf16* orow, int lane) {
    const GAS f32x4* xr = (const GAS f32x4*)xrow + lane; f32x4 v[8]; float s = 0.f;
#pragma unroll
    for (int j = 0; j < 8; ++j) { v[j] = xr[64 * j]; s += (v[j][0] * v[j][0] + v[j][1] * v[j][1]) + (v[j][2] * v[j][2] + v[j][3] * v[j][3]); }
    const float r = __builtin_amdgcn_rsqf(wave_sum(s) * (1.0f / D) + EPS);
    const GAS f32x4* gr = (const GAS f32x4*)g + lane;
    GAS unsigned long long* o8 = (GAS unsigned long long*)orow + lane;
#pragma unroll
    for (int j = 0; j < 8; ++j) { const f32x4 gg = gr[64 * j]; o8[64 * j] = (unsigned long long)pk2(v[j][0] * r * gg[0], v[j][1] * r * gg[1]) | ((unsigned long long)pk2(v[j][2] * r * gg[2], v[j][3] * r * gg[3]) << 32); }
}
__device__ __forceinline__ void rms_row_to_f8(const float* xrow, const float* g, unsigned char* orow, int lane) {
    const GAS f32x4* xr = (const GAS f32x4*)xrow + lane; f32x4 v[8]; float s = 0.f;
#pragma unroll
    for (int j = 0; j < 8; ++j) { v[j] = xr[64 * j]; s += (v[j][0] * v[j][0] + v[j][1] * v[j][1]) + (v[j][2] * v[j][2] + v[j][3] * v[j][3]); }
    const float r = __builtin_amdgcn_rsqf(wave_sum(s) * (1.0f / D) + EPS);
    const GAS f32x4* gr = (const GAS f32x4*)g + lane;
    GAS unsigned* o4 = (GAS unsigned*)orow + lane;
#pragma unroll
    for (int j = 0; j < 8; ++j) { const f32x4 q = v[j] * gr[64 * j] * r; int x = __builtin_amdgcn_cvt_pk_fp8_f32(q[0], q[1], 0, false); x = __builtin_amdgcn_cvt_pk_fp8_f32(q[2], q[3], x, true); o4[64 * j] = (unsigned)x; }
}
__device__ __forceinline__ void p0_fold_item(const float* wq, const float* sk, bf16* WP, LAS float* lds, int item, int tid, const float* kgain) {
    const int hp = item >> 5, k0 = (item & 31) * 64;
    LAS float* skT = lds;
    LAS float* wqT = lds + 128 * 132;
    const float* skb = sk + (size_t)hp * 128 * 128;
#pragma unroll 4
    for (int i = 0; i < 32; ++i) { const int idx = i * 512 + tid, n = idx >> 7, d = idx & 127; skT[d * 132 + n] = skb[idx]; }
#pragma unroll 4
    for (int i = 0; i < 16; ++i) { const int idx = i * 512 + tid, kk = idx >> 7, d = idx & 127; wqT[d * 68 + kk] = wq[(size_t)(k0 + kk) * D + hp * 128 + d] * kgain[k0 + kk]; }
    __syncthreads();
    const int n0 = (tid >> 4) * 4, kk0 = (tid & 15) * 4;
    float acc[4][4];
#pragma unroll
    for (int i = 0; i < 4; ++i)
#pragma unroll
        for (int j = 0; j < 4; ++j) acc[i][j] = 0.f;
#pragma unroll 4
    for (int d = 0; d < 128; ++d) { const f32x4 a = *(const LAS f32x4*)(skT + d * 132 + n0), b = *(const LAS f32x4*)(wqT + d * 68 + kk0);
#pragma unroll
        for (int i = 0; i < 4; ++i)
#pragma unroll
            for (int j = 0; j < 4; ++j) acc[i][j] += a[i] * b[j]; }
#pragma unroll
    for (int i = 0; i < 4; ++i) { unsigned long long o = (unsigned long long)pk2(acc[i][0], acc[i][1]) | ((unsigned long long)pk2(acc[i][2], acc[i][3]) << 32);
        *(GAS unsigned long long*)(WP + (size_t)(hp * 128 + n0 + i) * D + k0 + kk0) = o; }
    __syncthreads();
}
__device__ __forceinline__ void p0_prologue(const Args& A, Frame& F) {
    const int gw = F.vcu * NWAVES + F.wave, NGW = F.G * NWAVES;
    const int gtid = gw * 64 + F.lane, gthreads = F.G * NTHREADS;
    unsigned char* ws = A.ws;
    LAS float* scr = (LAS float*)(F.lds + RING_OFF + F.wave * 16384);
    constexpr int I_EVIN = (D / 64) * (EV_N / 32);
    for (int it = gw; it < I_EVIN; it += NGW) p0_transpose_item(A.in[I_EV_WIN], D, EV_N, (bf16*)(ws + WS_WEV_IN), scr, it, F.lane);
    { GAS v4u* z0 = (GAS v4u*)(ws + WS_WEV_IN + (size_t)EV_N * D * 2); const size_t n0 = (size_t)(EV_NP - EV_N) * D * 2 / 16;
      for (size_t i = gtid; i < n0; i += gthreads) z0[i] = (v4u){0u, 0u, 0u, 0u}; }
    { constexpr int I_PJ = (256 / 64) * (D / 32);
      for (int it = gw; it < 2 * I_PJ; it += NGW) { const int L = it / I_PJ; p0_transpose_item(A.in[I_PLE_WP] + (size_t)L * 256 * D, 256, D, (bf16*)(ws + WS_WPROJ) + (size_t)L * D * 256, scr, it % I_PJ, F.lane); } }
    cvt_f32_bf16(A.in[I_P], (bf16*)(ws + WS_PBF), (size_t)2 * T * 256, gtid, gthreads);
    for (int m = gw; m < T; m += NGW) rms_row_to_bf16(A.in[I_X] + (size_t)m * D, A.in[I_NMIX], (bf16*)(ws + WS_ACTA) + (size_t)m * D, F.lane);
}
__device__ __forceinline__ void p0_deferred(const Args& A, Frame& F, int wg, int nwg) {
    const int gw = wg * NWAVES + F.wave, NGW = nwg * NWAVES;
    int gtid = gw * 64 + F.lane; const int gthreads = nwg * NTHREADS;
    asm volatile("" : "+v"(gtid));
    unsigned char* ws = A.ws;
    {
        LAS float* scr = (LAS float*)(F.lds + RING_OFF + F.wave * 16384);
        constexpr int I_SQ = (D / 64) * (D / 32), I_ODIN = (D / 64) * (OD_N / 32);
        constexpr int NITEMS = I_SQ + I_ODIN + I_SQ;
        for (int it = gw; it < NITEMS; it += NGW) {
            int r = it;
            if (r < I_SQ) { p0_transpose_item(A.in[I_EV_WOUT], D, D, (bf16*)(ws + WS_WEV_OUT), scr, r, F.lane); continue; } r -= I_SQ;
            if (r < I_ODIN) { p0_transpose_item_f8(A.in[I_OD_WIN], D, OD_N, (unsigned char*)(ws + WS_WOD_IN), scr, r, F.lane, A.in[I_NMIX] + D); continue; } r -= I_ODIN;
            p0_transpose_item_f8(A.in[I_PLE_WG], D, D, (unsigned char*)(ws + WS_WGATE), scr, r, F.lane, A.in[I_NPLE]);
        }
        { GAS v4u* z1 = (GAS v4u*)(ws + WS_WOD_IN + (size_t)OD_N * D); const size_t n1 = (size_t)(OD_NP - OD_N) * D / 16;
          for (size_t i = gtid; i < n1; i += gthreads) z1[i] = (v4u){0u, 0u, 0u, 0u}; }
    }
    __syncthreads();
    for (int it = wg; it < 512; it += nwg)
        p0_fold_item(A.in[I_PEER_WQ], A.in[I_PEER_SK], (bf16*)(ws + WS_WPEER), (LAS float*)(F.lds + RING_OFF), it, F.tid, A.in[I_NFFN]);
    cvt_f32_fp8(A.in[I_PEER_U], (unsigned char*)(ws + WS_TABU), (size_t)16384 * D, 512.0f, gtid, gthreads, A.in[I_NFFN]);
    cvt_f32_fp8(A.in[I_PEER_V], (unsigned char*)(ws + WS_TABV), (size_t)16384 * D, 16.0f, gtid, gthreads);
    { bf16* LB = (bf16*)(ws + WS_WLORA); const float* w2 = A.in[I_W2]; const float* a2 = A.in[I_A2]; const float* g2 = A.in[I_G2];
      for (int i = gtid; i < LORA_N * LORA_K / 2; i += gthreads) { const int row = i / (LORA_K / 2), col = (i % (LORA_K / 2)) * 2; float v[2];
#pragma unroll
          for (int e = 0; e < 2; ++e) { const int c = col + e; float x = 0.f;
              if (row < 1024) { if (c < 96) x = w2[c * 1024 + row]; }
              else if (row < 2048) { if (c >= 96 && c < 192) x = a2[(c - 96) * 1024 + (row - 1024)]; }
              else { if (c >= 192 && c < 448) x = g2[(c - 192) * 1024 + (row - 2048)]; }
              v[e] = x; }
          *(GAS unsigned*)(LB + (size_t)row * LORA_K + col) = pk2(v[0], v[1]); } }
}
__device__ __forceinline__ void p1_deferred(const Args& A, Frame& F, int wg, int nwg) {
    const int gw = wg * NWAVES + F.wave, NGW = nwg * NWAVES;
    int gtid = gw * 64 + F.lane; const int gthreads = nwg * NTHREADS;
    asm volatile("" : "+v"(gtid));
    unsigned char* ws = A.ws;
    { LAS float* scr = (LAS float*)(F.lds + RING_OFF + F.wave * 16384); constexpr int I_SQ = (D / 64) * (D / 32);
      for (int it = gw; it < 2 * I_SQ; it += NGW) {
          if (it < I_SQ) p0_transpose_item_f8(A.in[I_OD_WOUT], D, D, (unsigned char*)(ws + WS_WOD_OUT), scr, it, F.lane);
          else p0_transpose_item_f8(A.in[I_PLE_WG] + (size_t)D * D, D, D, (unsigned char*)((bf16*)(ws + WS_WGATE) + (size_t)D * D), scr, it - I_SQ, F.lane, A.in[I_NPLE] + D); } }
    __syncthreads();
    for (int it = wg; it < 512; it += nwg)
        p0_fold_item(A.in[I_PEER_WQ] + (size_t)D * D, A.in[I_PEER_SK] + (size_t)16 * 128 * 128, (bf16*)(ws + WS_WPEER) + (size_t)D * D, (LAS float*)(F.lds + RING_OFF), it, F.tid, A.in[I_NFFN] + D);
    cvt_f32_fp8(A.in[I_PEER_U] + (size_t)16384 * D, (unsigned char*)(ws + WS_TABU) + (size_t)16384 * D, (size_t)16384 * D, 512.0f, gtid, gthreads, A.in[I_NFFN] + D);
    cvt_f32_fp8(A.in[I_PEER_V] + (size_t)16384 * D, (unsigned char*)(ws + WS_TABV) + (size_t)16384 * D, (size_t)16384 * D, 16.0f, gtid, gthreads);
}

constexpr int TC = 16, NCHUNK = SEQ / TC;

template <int MODE>
__device__ __forceinline__ void scan_gla_unit(const Args& A, Frame& F, int unit) {
    int tid = F.tid; asm volatile("" : "+v"(tid));
    const int lane = tid & 63, w = F.wave;
    int b, h, qcol, kcol, vcol, ocol;
    if (MODE == 0) { b = unit >> 4; h = (unit >> 2) & 3; const int s = unit & 3; qcol = EC_GQ + h * 128; kcol = EC_GK + h * 128; vcol = EC_GV + h * 256 + s * 64; ocol = h * 256 + s * 64; }
    else           { b = unit >> 4; h = (unit >> 1) & 7; const int s = unit & 1; qcol = OC_HQ + h * 128; kcol = OC_HF + h * 128; vcol = OC_HI + h * 128 + s * 64; ocol = h * 128 + s * 64; }
    const bf16* P = (const bf16*)(A.ws + WS_PROJ) + (size_t)b * SEQ * PROJ_LD;
    float* O = (float*)(A.ws + WS_O) + (size_t)b * SEQ * D + ocol;
    LAS float* Lf = (LAS float*)(F.lds + RING_OFF);
    constexpr int BUFSZ = 7168, O_EG = 0, O_K = 2048, O_Q = 4096, O_V = 6144, O_OUT = 2 * BUFSZ, O_W2 = O_OUT + 1024, O_BIAS = O_W2 + 2048;
    const int tl = tid >> 5, dq = (tid & 31) * 4, tlv = tid >> 4, c4 = (tid & 15) * 4;
    float lb[4] = {0.f, 0.f, 0.f, 0.f};
    if (MODE == 0) {
        const float* w2 = A.in[I_GK_W2]; const float* gb = A.in[I_GK_B];
        for (int i = tid; i < 2048; i += NTHREADS) Lf[O_W2 + i] = w2[(i >> 7) * 512 + h * 128 + (i & 127)];
        if (tid < 128) Lf[O_BIAS + tid] = gb[h * 128 + tid];
    } else {
        const float* lg = A.in[I_LB];
#pragma unroll
        for (int i = 0; i < 4; ++i) lb[i] = sigmoidf_(lg[1024 + h * 128 + dq + i] - lg[h * 128 + dq + i]);
    }
    u32x2 rq, rk, rv = {0u, 0u}; v4u rg0 = {0u, 0u, 0u, 0u}, rg1 = {0u, 0u, 0u, 0u};
#define GLA_LOAD(c) do { const bf16* pr = P + (size_t)((c) * TC + tl) * PROJ_LD; rq = *(const GAS u32x2*)(pr + qcol + dq); rk = *(const GAS u32x2*)(pr + kcol + dq); \
        if (MODE == 0) { rg0 = *(const GAS v4u*)(pr + EC_GLR); rg1 = *(const GAS v4u*)(pr + EC_GLR + 8); } \
        if (tid < 256) rv = *(const GAS u32x2*)(P + (size_t)((c) * TC + tlv) * PROJ_LD + vcol + c4); } while (0)
#define GLA_XFORM(bufi) do { LAS float* B_ = Lf + (bufi) * BUFSZ; f32x4 q4, k4, e4; \
        const float xq[4] = {bf_lo(rq.x), bf_hi(rq.x), bf_lo(rq.y), bf_hi(rq.y)}, xk[4] = {bf_lo(rk.x), bf_hi(rk.x), bf_lo(rk.y), bf_hi(rk.y)}; \
        if (MODE == 0) { f32x4 z = *(const LAS f32x4*)(Lf + O_BIAS + dq); \
            const float gl[16] = {bf_lo(rg0.x), bf_hi(rg0.x), bf_lo(rg0.y), bf_hi(rg0.y), bf_lo(rg0.z), bf_hi(rg0.z), bf_lo(rg0.w), bf_hi(rg0.w), \
                                  bf_lo(rg1.x), bf_hi(rg1.x), bf_lo(rg1.y), bf_hi(rg1.y), bf_lo(rg1.z), bf_hi(rg1.z), bf_lo(rg1.w), bf_hi(rg1.w)}; \
            _Pragma("unroll") for (int r_ = 0; r_ < 16; ++r_) { const f32x4 wv = *(const LAS f32x4*)(Lf + O_W2 + r_ * 128 + dq); z = z + wv * gl[r_]; } \
            _Pragma("unroll") for (int i_ = 0; i_ < 4; ++i_) { q4[i_] = xq[i_] * 0.08838834764831845f; k4[i_] = xk[i_]; e4[i_] = __builtin_amdgcn_exp2f(-0.0625f * __builtin_amdgcn_logf(1.0f + __expf(-z[i_]))); } } \
        else { _Pragma("unroll") for (int i_ = 0; i_ < 4; ++i_) { const float fg = lb[i_] + (1.f - lb[i_]) * sigmoidf_(xk[i_]); q4[i_] = siluf_(xq[i_]); k4[i_] = 1.f - fg; e4[i_] = fg; } } \
        *(LAS f32x4*)(B_ + O_EG + tl * 128 + dq) = e4; *(LAS f32x4*)(B_ + O_K + tl * 128 + dq) = k4; *(LAS f32x4*)(B_ + O_Q + tl * 128 + dq) = q4; \
        if (tid < 256) { f32x4 v4 = {bf_lo(rv.x), bf_hi(rv.x), bf_lo(rv.y), bf_hi(rv.y)}; *(LAS f32x4*)(B_ + O_V + tlv * 64 + c4) = v4; } } while (0)
    LBAR();
    GLA_LOAD(0); GLA_XFORM(0);
    LBAR();
    f32x2 S2[8];
#pragma unroll
    for (int i = 0; i < 8; ++i) S2[i] = (f32x2){0.f, 0.f};
    const int j = lane & 15, col = w * 8 + (lane >> 4) * 2;
    for (int c = 0; c < NCHUNK; ++c) {
        if (c + 1 < NCHUNK) GLA_LOAD(c + 1);
        const LAS float* B_ = Lf + (c & 1) * BUFSZ;
        float os0 = 0.f, os1 = 0.f;
        f32x4 e0, e1, k0, k1, q0, q1, ne0, ne1, nk0, nk1, nq0, nq1; f32x2 v2, nv2;
#define GLA_LDSTEP(t_, E0, E1, K0, K1, Q0, Q1, V2) do { E0 = *(const LAS f32x4*)(B_ + O_EG + (t_) * 128 + 4 * j); E1 = *(const LAS f32x4*)(B_ + O_EG + (t_) * 128 + 64 + 4 * j); \
            K0 = *(const LAS f32x4*)(B_ + O_K + (t_) * 128 + 4 * j); K1 = *(const LAS f32x4*)(B_ + O_K + (t_) * 128 + 64 + 4 * j); \
            Q0 = *(const LAS f32x4*)(B_ + O_Q + (t_) * 128 + 4 * j); Q1 = *(const LAS f32x4*)(B_ + O_Q + (t_) * 128 + 64 + 4 * j); V2 = *(const LAS f32x2*)(B_ + O_V + (t_) * 64 + col); } while (0)
        GLA_LDSTEP(0, e0, e1, k0, k1, q0, q1, v2);
#pragma unroll
        for (int t = 0; t < TC; ++t) {
            if (t + 1 < TC) { GLA_LDSTEP(t + 1, ne0, ne1, nk0, nk1, nq0, nq1, nv2); }
            __builtin_amdgcn_sched_barrier(0);
            f32x2 pa = {0.f, 0.f}, pb = {0.f, 0.f};
#pragma unroll
            for (int i = 0; i < 4; ++i) {
                S2[i] = S2[i] * e0[i] + v2 * k0[i]; S2[4 + i] = S2[4 + i] * e1[i] + v2 * k1[i];
                pa += S2[i] * q0[i]; pb += S2[4 + i] * q1[i]; }
            pa += pb;
            float p0 = pa[0], p1 = pa[1];
            row_sum16_x2(p0, p1);
            os0 = (j == t) ? p0 : os0; os1 = (j == t) ? p1 : os1;
            e0 = ne0; e1 = ne1; k0 = nk0; k1 = nk1; q0 = nq0; q1 = nq1; v2 = nv2;
        }
#undef GLA_LDSTEP
        { f32x2 o2 = {os0, os1}; *(LAS f32x2*)(Lf + O_OUT + j * 64 + col) = o2; }
        if (c + 1 < NCHUNK) GLA_XFORM((c + 1) & 1);
        LBAR();
        if (tid < 256) *(GAS f32x4*)(O + (size_t)(c * TC + tlv) * D + c4) = *(const LAS f32x4*)(Lf + O_OUT + tlv * 64 + c4);
        LBAR();
    }
#undef GLA_LOAD
#undef GLA_XFORM
}

__device__ __forceinline__ void scan_gdn_unit(const Args& A, Frame& F, int unit) {
    int tid = F.tid; asm volatile("" : "+v"(tid));
    const int lane = tid & 63, w = F.wave;
    const int b = unit >> 4, h = (unit >> 1) & 7, s = unit & 1;
    const int qcol = EC_BQ + h * 128, kcol = EC_BK + h * 128, vcol = EC_BV + h * 128 + s * 64, ocol = 1024 + h * 128 + s * 64;
    const bf16* P = (const bf16*)(A.ws + WS_PROJ) + (size_t)b * SEQ * PROJ_LD;
    float* O = (float*)(A.ws + WS_O) + (size_t)b * SEQ * D + ocol;
    LAS float* Lf = (LAS float*)(F.lds + RING_OFF);
    constexpr int BUFSZ = 5184, O_K = 0, O_Q = 2048, O_V = 4096, O_SC = 5120, O_OUT = 2 * BUFSZ, O_CW = O_OUT + 1024;
    const int tl = tid >> 5, dq = (tid & 31) * 4, tlv = tid >> 4, c4 = (tid & 15) * 4;
    { const float* cw = A.in[I_GDN_CONV];
      for (int i = tid; i < 4 * 320; i += NTHREADS) { const int jt = i / 320, x = i % 320;
          const int ch = x < 128 ? (h * 128 + x) : x < 256 ? (1024 + h * 128 + (x - 128)) : (2048 + h * 128 + s * 64 + (x - 256));
          Lf[O_CW + i] = cw[jt * 3072 + ch]; } }
    const float neg_ea = -__expf(A.in[I_GDN_ALOG][h]), dtb = A.in[I_GDN_DTB][h];
    u32x2 rq[4], rk[4], rv[4]; unsigned short rba = 0, rbb = 0;
#pragma unroll
    for (int i = 0; i < 4; ++i) rv[i] = (u32x2){0u, 0u};
#define GDN_LOAD(c) do { const int t_ = (c) * TC + tl; \
        _Pragma("unroll") for (int jt = 0; jt < 4; ++jt) { const int tt = t_ - 3 + jt; \
            if (tt >= 0) { const bf16* pr = P + (size_t)tt * PROJ_LD; rq[jt] = *(const GAS u32x2*)(pr + qcol + dq); rk[jt] = *(const GAS u32x2*)(pr + kcol + dq); } \
            else { rq[jt] = (u32x2){0u, 0u}; rk[jt] = (u32x2){0u, 0u}; } } \
        { const bf16* pr = P + (size_t)t_ * PROJ_LD; rba = pr[EC_BA + h]; rbb = pr[EC_BB + h]; } \
        if (tid < 256) { const int tv = (c) * TC + tlv; \
            _Pragma("unroll") for (int jt = 0; jt < 4; ++jt) { const int tt = tv - 3 + jt; \
                if (tt >= 0) rv[jt] = *(const GAS u32x2*)(P + (size_t)tt * PROJ_LD + vcol + c4); else rv[jt] = (u32x2){0u, 0u}; } } } while (0)
#define GDN_XFORM(bufi) do { LAS float* B_ = Lf + (bufi) * BUFSZ; f32x4 q4 = {0.f, 0.f, 0.f, 0.f}, k4 = {0.f, 0.f, 0.f, 0.f}; \
        _Pragma("unroll") for (int jt = 0; jt < 4; ++jt) { const f32x4 wq = *(const LAS f32x4*)(Lf + O_CW + jt * 320 + dq), wk = *(const LAS f32x4*)(Lf + O_CW + jt * 320 + 128 + dq); \
            q4[0] += wq[0] * bf_lo(rq[jt].x); q4[1] += wq[1] * bf_hi(rq[jt].x); q4[2] += wq[2] * bf_lo(rq[jt].y); q4[3] += wq[3] * bf_hi(rq[jt].y); \
            k4[0] += wk[0] * bf_lo(rk[jt].x); k4[1] += wk[1] * bf_hi(rk[jt].x); k4[2] += wk[2] * bf_lo(rk[jt].y); k4[3] += wk[3] * bf_hi(rk[jt].y); } \
        float sq = 0.f, sk = 0.f, sqk = 0.f; \
        _Pragma("unroll") for (int i_ = 0; i_ < 4; ++i_) { q4[i_] = siluf_(q4[i_]); k4[i_] = siluf_(k4[i_]); sq += q4[i_] * q4[i_]; sk += k4[i_] * k4[i_]; sqk += q4[i_] * k4[i_]; } \
        sq = half_sum32(sq); sk = half_sum32(sk); sqk = half_sum32(sqk); \
        const float rq_ = __builtin_amdgcn_rsqf(sq + EPS) * 0.08838834764831845f, rk_ = __builtin_amdgcn_rsqf(sk + EPS); \
        q4 = q4 * rq_; k4 = k4 * rk_; \
        *(LAS f32x4*)(B_ + O_K + tl * 128 + dq) = k4; *(LAS f32x4*)(B_ + O_Q + tl * 128 + dq) = q4; \
        if ((tid & 31) == 0) { const float ba = __uint_as_float((unsigned)rba << 16), bb = __uint_as_float((unsigned)rbb << 16); \
            f32x4 sc; sc[0] = __expf(neg_ea * softplusf_(ba + dtb)); sc[1] = sigmoidf_(bb); sc[2] = sqk * rq_ * rk_; sc[3] = 0.f; *(LAS f32x4*)(B_ + O_SC + tl * 4) = sc; } \
        if (tid < 256) { f32x4 v4 = {0.f, 0.f, 0.f, 0.f}; \
            _Pragma("unroll") for (int jt = 0; jt < 4; ++jt) { const f32x4 wv = *(const LAS f32x4*)(Lf + O_CW + jt * 320 + 256 + c4); \
                v4[0] += wv[0] * bf_lo(rv[jt].x); v4[1] += wv[1] * bf_hi(rv[jt].x); v4[2] += wv[2] * bf_lo(rv[jt].y); v4[3] += wv[3] * bf_hi(rv[jt].y); } \
            _Pragma("unroll") for (int i_ = 0; i_ < 4; ++i_) v4[i_] = siluf_(v4[i_]); \
            *(LAS f32x4*)(B_ + O_V + tlv * 64 + c4) = v4; } } while (0)
    LBAR();
    GDN_LOAD(0); GDN_XFORM(0);
    LBAR();
    f32x2 S2[8];
#pragma unroll
    for (int i = 0; i < 8; ++i) S2[i] = (f32x2){0.f, 0.f};
    const int j = lane & 15, col = w * 8 + (lane >> 4) * 2;
    for (int c = 0; c < NCHUNK; ++c) {
        if (c + 1 < NCHUNK) GDN_LOAD(c + 1);
        const LAS float* B_ = Lf + (c & 1) * BUFSZ;
        float os0 = 0.f, os1 = 0.f;
        f32x4 k0, k1, q0, q1, sc, nk0, nk1, nq0, nq1, nsc; f32x2 v2, nv2;
#define GDN_LDSTEP(t_, K0, K1, Q0, Q1, V2, SC) do { K0 = *(const LAS f32x4*)(B_ + O_K + (t_) * 128 + 4 * j); K1 = *(const LAS f32x4*)(B_ + O_K + (t_) * 128 + 64 + 4 * j); \
            Q0 = *(const LAS f32x4*)(B_ + O_Q + (t_) * 128 + 4 * j); Q1 = *(const LAS f32x4*)(B_ + O_Q + (t_) * 128 + 64 + 4 * j); V2 = *(const LAS f32x2*)(B_ + O_V + (t_) * 64 + col); SC = *(const LAS f32x4*)(B_ + O_SC + (t_) * 4); } while (0)
        GDN_LDSTEP(0, k0, k1, q0, q1, v2, sc);
#pragma unroll
        for (int t = 0; t < TC; ++t) {
            if (t + 1 < TC) { GDN_LDSTEP(t + 1, nk0, nk1, nq0, nq1, nv2, nsc); }
            __builtin_amdgcn_sched_barrier(0);
            f32x2 d1 = {0.f, 0.f}, d2 = {0.f, 0.f}, e1 = {0.f, 0.f}, e2 = {0.f, 0.f};
#pragma unroll
            for (int i = 0; i < 4; ++i) { d1 += S2[i] * k0[i]; e1 += S2[4 + i] * k1[i]; d2 += S2[i] * q0[i]; e2 += S2[4 + i] * q1[i]; }
            d1 += e1; d2 += e2;
            { float r0_ = d1[0], r1_ = d1[1], r2_ = d2[0], r3_ = d2[1]; row_sum16_x4(r0_, r1_, r2_, r3_); d1[0] = r0_; d1[1] = r1_; d2[0] = r2_; d2[1] = r3_; }
            const float a = sc[0], beta = sc[1], qk = sc[2];
            const f32x2 dl = (v2 - d1 * a) * beta;
            const f32x2 o2 = d2 * a + dl * qk;
#pragma unroll
            for (int i = 0; i < 4; ++i) { S2[i] = S2[i] * a + dl * k0[i]; S2[4 + i] = S2[4 + i] * a + dl * k1[i]; }
            os0 = (j == t) ? o2[0] : os0; os1 = (j == t) ? o2[1] : os1;
            k0 = nk0; k1 = nk1; q0 = nq0; q1 = nq1; v2 = nv2; sc = nsc;
        }
#undef GDN_LDSTEP
        { f32x2 o2 = {os0, os1}; *(LAS f32x2*)(Lf + O_OUT + j * 64 + col) = o2; }
        if (c + 1 < NCHUNK) GDN_XFORM((c + 1) & 1);
        LBAR();
        if (tid < 256) *(GAS f32x4*)(O + (size_t)(c * TC + tlv) * D + c4) = *(const LAS f32x4*)(Lf + O_OUT + tlv * 64 + c4);
        LBAR();
    }
#undef GDN_LOAD
#undef GDN_XFORM
}

typedef short bf16x4_t __attribute__((ext_vector_type(4)));
__device__ __forceinline__ bf16x8 mk_frag(u32x2 lo, u32x2 hi) { v4u t; t.x = lo.x; t.y = lo.y; t.z = hi.x; t.w = hi.y; return __builtin_bit_cast(bf16x8, t); }
template <int MODE>
__device__ __forceinline__ void scan_gla_mfma_unit(const Args& A, Frame& F, int unit) {
    int tid = F.tid; asm volatile("" : "+v"(tid));
    const int lane = tid & 63, w = F.wave;
    int b, h, qcol, kcol, vcol, ocol;
    if (MODE == 0) { b = unit >> 3; h = (unit >> 1) & 3; const int s = unit & 1; qcol = EC_GQ + h * 128; kcol = EC_GK + h * 128; vcol = EC_GV + h * 256 + s * 128; ocol = h * 256 + s * 128; }
    else           { b = unit >> 3; h = unit & 7; qcol = OC_HQ + h * 128; kcol = OC_HF + h * 128; vcol = OC_HI + h * 128; ocol = h * 128; }
    const bf16* P = (const bf16*)(A.ws + WS_PROJ) + (size_t)b * SEQ * PROJ_LD;
    bf16* O = (bf16*)(A.ws + WS_O) + (size_t)b * SEQ * D + ocol;
    LAS float* Lf = (LAS float*)(F.lds + RING_OFF);
    constexpr int BUFSZ = 8192, O_E = 0, O_K = 2048, O_Q = 4096, O_V = 6144, RS = 136, O_QB = 2 * BUFSZ, O_KB = O_QB + 1088, O_KT = O_KB + 1088, O_BL = O_KT + 1024, O_AM = O_BL + 128, O_W2 = O_AM + 128, O_BIAS = O_W2 + 2048;
    LAS bf16* QB = (LAS bf16*)(Lf + O_QB); LAS bf16* KB = (LAS bf16*)(Lf + O_KB); LAS bf16* KT = (LAS bf16*)(Lf + O_KT); LAS bf16* AM = (LAS bf16*)(Lf + O_AM);
    const int tl = tid >> 5, dq = (tid & 31) * 4;
    float lb[4] = {0.f, 0.f, 0.f, 0.f};
    if (MODE == 0) {
        const float* w2 = A.in[I_GK_W2]; const float* gb = A.in[I_GK_B];
        for (int i = tid; i < 2048; i += NTHREADS) Lf[O_W2 + i] = w2[(i >> 7) * 512 + h * 128 + (i & 127)];
        if (tid < 128) Lf[O_BIAS + tid] = gb[h * 128 + tid];
    } else {
        const float* lg = A.in[I_LB];
#pragma unroll
        for (int i = 0; i < 4; ++i) lb[i] = sigmoidf_(lg[1024 + h * 128 + dq + i] - lg[h * 128 + dq + i]);
    }
    u32x2 rq, rk, rv; v4u rg0 = {0u, 0u, 0u, 0u}, rg1 = {0u, 0u, 0u, 0u};
#define GM_LOAD(c) do { const bf16* pr = P + (size_t)((c) * TC + tl) * PROJ_LD; rq = *(const GAS u32x2*)(pr + qcol + dq); rk = *(const GAS u32x2*)(pr + kcol + dq); rv = *(const GAS u32x2*)(pr + vcol + dq); \
        if (MODE == 0) { rg0 = *(const GAS v4u*)(pr + EC_GLR); rg1 = *(const GAS v4u*)(pr + EC_GLR + 8); } } while (0)
#define GM_XFORM(bufi) do { LAS float* B_ = Lf + (bufi) * BUFSZ; f32x4 q4, k4, e4; \
        const float xq[4] = {bf_lo(rq.x), bf_hi(rq.x), bf_lo(rq.y), bf_hi(rq.y)}, xk[4] = {bf_lo(rk.x), bf_hi(rk.x), bf_lo(rk.y), bf_hi(rk.y)}; \
        if (MODE == 0) { f32x4 z = *(const LAS f32x4*)(Lf + O_BIAS + dq); \
            const float gl[16] = {bf_lo(rg0.x), bf_hi(rg0.x), bf_lo(rg0.y), bf_hi(rg0.y), bf_lo(rg0.z), bf_hi(rg0.z), bf_lo(rg0.w), bf_hi(rg0.w), \
                                  bf_lo(rg1.x), bf_hi(rg1.x), bf_lo(rg1.y), bf_hi(rg1.y), bf_lo(rg1.z), bf_hi(rg1.z), bf_lo(rg1.w), bf_hi(rg1.w)}; \
            _Pragma("unroll") for (int r_ = 0; r_ < 16; ++r_) { const f32x4 wv = *(const LAS f32x4*)(Lf + O_W2 + r_ * 128 + dq); z = z + wv * gl[r_]; } \
            _Pragma("unroll") for (int i_ = 0; i_ < 4; ++i_) { q4[i_] = xq[i_] * 0.08838834764831845f; k4[i_] = xk[i_]; e4[i_] = __builtin_amdgcn_exp2f(-0.0625f * __builtin_amdgcn_logf(1.0f + __expf(-z[i_]))); } } \
        else { _Pragma("unroll") for (int i_ = 0; i_ < 4; ++i_) { const float fg = lb[i_] + (1.f - lb[i_]) * sigmoidf_(xk[i_]); q4[i_] = siluf_(xq[i_]); k4[i_] = 1.f - fg; e4[i_] = fg; } } \
        *(LAS f32x4*)(B_ + O_E + tl * 128 + dq) = e4; *(LAS f32x4*)(B_ + O_K + tl * 128 + dq) = k4; *(LAS f32x4*)(B_ + O_Q + tl * 128 + dq) = q4; \
        { f32x4 v4 = {bf_lo(rv.x), bf_hi(rv.x), bf_lo(rv.y), bf_hi(rv.y)}; *(LAS f32x4*)(B_ + O_V + tl * 128 + dq) = v4; } } while (0)
    LBAR();
    GM_LOAD(0); GM_XFORM(0); GM_LOAD(1);
    LBAR();
    f32x4 Sacc[8];
#pragma unroll
    for (int i = 0; i < 8; ++i) Sacc[i] = (f32x4){0.f, 0.f, 0.f, 0.f};
    const int fr = lane & 15, g = lane >> 4, c0 = w * 16;
    for (int c = 0; c < NCHUNK; ++c) {
        const LAS float* B_ = Lf + (c & 1) * BUFSZ;
        {
            const int seg = tid >> 7, d = tid & 127;
            float bt = 1.f, ball = 1.f;
#pragma unroll
            for (int t = 0; t < 16; ++t) { const float e = B_[O_E + t * 128 + d]; ball *= e; if (t < 4 * seg) bt = ball; }
            ball = fmaxf(ball, 1e-30f);
            unsigned short kt4[4];
#pragma unroll
            for (int i = 0; i < 4; ++i) { const int t = 4 * seg + i; bt = fmaxf(bt * B_[O_E + t * 128 + d], 1e-30f);
                const float kk = B_[O_K + t * 128 + d], qq = B_[O_Q + t * 128 + d], ib = __builtin_amdgcn_rcpf(bt);
                QB[t * RS + d] = hw_bf(qq * bt); KB[t * RS + d] = hw_bf(kk * ib); kt4[i] = (unsigned short)hw_bf(kk * ball * ib); }
            u32x2 kw; kw.x = (unsigned)kt4[0] | ((unsigned)kt4[1] << 16); kw.y = (unsigned)kt4[2] | ((unsigned)kt4[3] << 16);
            *(LAS u32x2*)(KT + d * 16 + 4 * seg) = kw;
            if (seg == 3) Lf[O_BL + d] = ball;
        }
        LBAR();
        if (w == 0) {
            f32x4 acc = {0.f, 0.f, 0.f, 0.f};
#pragma unroll
            for (int ks = 0; ks < 4; ++ks) { const bf16x8 af = *(const LAS bf16x8*)(QB + fr * RS + 32 * ks + 8 * g), bfm = *(const LAS bf16x8*)(KB + fr * RS + 32 * ks + 8 * g);
                acc = __builtin_amdgcn_mfma_f32_16x16x32_bf16(af, bfm, acc, 0, 0, 0); }
#pragma unroll
            for (int r = 0; r < 4; ++r) { const int t = 4 * g + r, s = fr; AM[t * 16 + s] = hw_bf(s <= t ? acc[r] : 0.f); }
        }
        if (c + 1 < NCHUNK) GM_XFORM((c + 1) & 1);
        if (c + 2 < NCHUNK) GM_LOAD(c + 2);
        LBAR();
        {
            u32x2 vlo; { const float v0 = B_[O_V + (4 * g + 0) * 128 + c0 + fr], v1 = B_[O_V + (4 * g + 1) * 128 + c0 + fr], v2 = B_[O_V + (4 * g + 2) * 128 + c0 + fr], v3 = B_[O_V + (4 * g + 3) * 128 + c0 + fr];
                vlo.x = hw_pk2(v0, v1); vlo.y = hw_pk2(v2, v3); }
            const u32x2 zz = {0u, 0u};
            const bf16x8 vb = mk_frag(vlo, zz);
            f32x4 acco = {0.f, 0.f, 0.f, 0.f};
#pragma unroll
            for (int ks = 0; ks < 4; ++ks) {
                u32x2 slo, shi; slo.x = hw_pk2(Sacc[2 * ks][0], Sacc[2 * ks][1]); slo.y = hw_pk2(Sacc[2 * ks][2], Sacc[2 * ks][3]); shi.x = hw_pk2(Sacc[2 * ks + 1][0], Sacc[2 * ks + 1][1]); shi.y = hw_pk2(Sacc[2 * ks + 1][2], Sacc[2 * ks + 1][3]);
                const bf16x8 sb = mk_frag(slo, shi);
                const u32x2 qlo = *(const LAS u32x2*)(QB + fr * RS + 32 * ks + 4 * g), qhi = *(const LAS u32x2*)(QB + fr * RS + 32 * ks + 16 + 4 * g);
                acco = __builtin_amdgcn_mfma_f32_16x16x32_bf16(mk_frag(qlo, qhi), sb, acco, 0, 0, 0); }
            { const u32x2 alo = *(const LAS u32x2*)(AM + fr * 16 + 4 * g); acco = __builtin_amdgcn_mfma_f32_16x16x32_bf16(mk_frag(alo, zz), vb, acco, 0, 0, 0); }
#pragma unroll
            for (int r = 0; r < 4; ++r) O[(size_t)(c * TC + 4 * g + r) * D + c0 + fr] = hw_bf(acco[r]);
#pragma unroll
            for (int i = 0; i < 8; ++i) { const f32x4 bl = *(const LAS f32x4*)(Lf + O_BL + 16 * i + 4 * g); const u32x2 klo = *(const LAS u32x2*)(KT + (16 * i + fr) * 16 + 4 * g);
                Sacc[i] = __builtin_amdgcn_mfma_f32_16x16x32_bf16(mk_frag(klo, zz), vb, Sacc[i] * bl, 0, 0, 0); }
        }
        LBAR();
    }
#undef GM_LOAD
#undef GM_XFORM
}

__device__ __forceinline__ void scan_gdn_mfma_unit(const Args& A, Frame& F, int unit, const int role) {
    int tid = F.tid; asm volatile("" : "+v"(tid));
    const int lane = tid & 63, w = F.wave;
    const int b = unit >> 3, h = unit & 7;
    const int qcol = EC_BQ + h * 128, kcol = EC_BK + h * 128, vcol = EC_BV + h * 128, ocol = 1024 + h * 128;
    const bf16* P = (const bf16*)(A.ws + WS_PROJ) + (size_t)b * SEQ * PROJ_LD;
    bf16* O = (bf16*)(A.ws + WS_O) + (size_t)b * SEQ * D + ocol;
    LAS float* Lf = (LAS float*)(F.lds + RING_OFF);
    constexpr int O_CW = 0, O_AMAT = 1536, O_QKM = O_AMAT + 256, O_TB = O_QKM + 128, O_GL = O_TB + 128, O_BUF0 = O_GL + 64;
    constexpr int BUFSZ = 6208, O_KH = 0, O_QH = 2048, O_VV = 4096, O_SC = 6144;
    constexpr int RS = 136;
    constexpr int O_KHB = O_BUF0 + 2 * BUFSZ, O_QHB = O_KHB + 1088, O_QB = O_QHB + 1088, O_KT = O_QB + 1088, O_WSRC = O_KT + 1024, O_WB = O_WSRC + 2048;
    LAS bf16* KHB = (LAS bf16*)(Lf + O_KHB); LAS bf16* QHB = (LAS bf16*)(Lf + O_QHB); LAS bf16* QB = (LAS bf16*)(Lf + O_QB); LAS bf16* KT = (LAS bf16*)(Lf + O_KT);
    LAS bf16* WB = (LAS bf16*)(Lf + O_WB); LAS bf16* QKM = (LAS bf16*)(Lf + O_QKM); LAS bf16* TB = (LAS bf16*)(Lf + O_TB);
    const int tl = tid >> 5, dq = (tid & 31) * 4;
    { const float* cw = A.in[I_GDN_CONV];
      for (int i = tid; i < 4 * 384; i += NTHREADS) { const int jt = i / 384, x = i % 384; Lf[O_CW + i] = cw[jt * 3072 + (x >> 7) * 1024 + h * 128 + (x & 127)]; } }
    const float neg_ea = -__expf(A.in[I_GDN_ALOG][h]), dtb = A.in[I_GDN_DTB][h];
    u32x2 rq[4], rk[4], rv[4]; unsigned short rba = 0, rbb = 0;
#define GD_LOAD(c) do { const int t_ = (c) * TC + tl; \
        _Pragma("unroll") for (int jt = 0; jt < 4; ++jt) { const int tt = t_ - 3 + jt; const bf16* pr = P + (size_t)(tt < 0 ? 0 : tt) * PROJ_LD + dq; \
            rq[jt] = *(const GAS u32x2*)(pr + qcol); rk[jt] = *(const GAS u32x2*)(pr + kcol); rv[jt] = *(const GAS u32x2*)(pr + vcol); \
            if (tt < 0) { rq[jt] = (u32x2){0u, 0u}; rk[jt] = (u32x2){0u, 0u}; rv[jt] = (u32x2){0u, 0u}; } } \
        { const bf16* pr = P + (size_t)t_ * PROJ_LD; rba = pr[EC_BA + h]; rbb = pr[EC_BB + h]; } } while (0)
#define GD_XFORM(bufi) do { LAS float* B_ = Lf + O_BUF0 + (bufi) * BUFSZ; f32x4 q4 = {0.f, 0.f, 0.f, 0.f}, k4 = {0.f, 0.f, 0.f, 0.f}, v4 = {0.f, 0.f, 0.f, 0.f}; \
        _Pragma("unroll") for (int jt = 0; jt < 4; ++jt) { const f32x4 wq = *(const LAS f32x4*)(Lf + O_CW + jt * 384 + dq), wk = *(const LAS f32x4*)(Lf + O_CW + jt * 384 + 128 + dq), wv = *(const LAS f32x4*)(Lf + O_CW + jt * 384 + 256 + dq); \
            q4[0] += wq[0] * bf_lo(rq[jt].x); q4[1] += wq[1] * bf_hi(rq[jt].x); q4[2] += wq[2] * bf_lo(rq[jt].y); q4[3] += wq[3] * bf_hi(rq[jt].y); \
            k4[0] += wk[0] * bf_lo(rk[jt].x); k4[1] += wk[1] * bf_hi(rk[jt].x); k4[2] += wk[2] * bf_lo(rk[jt].y); k4[3] += wk[3] * bf_hi(rk[jt].y); \
            v4[0] += wv[0] * bf_lo(rv[jt].x); v4[1] += wv[1] * bf_hi(rv[jt].x); v4[2] += wv[2] * bf_lo(rv[jt].y); v4[3] += wv[3] * bf_hi(rv[jt].y); } \
        float sq = 0.f, sk = 0.f; \
        _Pragma("unroll") for (int i_ = 0; i_ < 4; ++i_) { q4[i_] = siluf_(q4[i_]); k4[i_] = siluf_(k4[i_]); v4[i_] = siluf_(v4[i_]); sq += q4[i_] * q4[i_]; sk += k4[i_] * k4[i_]; } \
        row_sum16_x2(sq, sk); sq += __shfl_xor(sq, 16); sk += __shfl_xor(sk, 16); \
        q4 = q4 * (__builtin_amdgcn_rsqf(sq + EPS) * 0.08838834764831845f); k4 = k4 * __builtin_amdgcn_rsqf(sk + EPS); \
        *(LAS f32x4*)(B_ + O_KH + tl * 128 + dq) = k4; *(LAS f32x4*)(B_ + O_QH + tl * 128 + dq) = q4; *(LAS f32x4*)(B_ + O_VV + tl * 128 + dq) = v4; \
        if ((tid & 31) == 0) { const float ba = __uint_as_float((unsigned)rba << 16), bb = __uint_as_float((unsigned)rbb << 16); \
            B_[O_SC + tl] = __expf(neg_ea * softplusf_(ba + dtb)); B_[O_SC + 16 + tl] = sigmoidf_(bb); } } while (0)
    LBAR();
    constexpr int SPLIT = 58;
    const int c_begin = role ? SPLIT : 0, c_end = role ? NCHUNK : SPLIT;
    constexpr int REC = 5408;
    float* STASH = (float*)(A.ws + WS_LA) + (size_t)unit * (NCHUNK - SPLIT) * REC;
    float* STATE = (float*)(A.ws + WS_STATE) + (size_t)unit * 16384;
    gu32* flag = F.ctl + 32768 + unit * 64;
    GD_LOAD(c_begin); GD_XFORM(c_begin & 1); GD_LOAD(c_begin + 1);
    LBAR();
    f32x4 Sacc[8];
#pragma unroll
    for (int i = 0; i < 8; ++i) Sacc[i] = (f32x4){0.f, 0.f, 0.f, 0.f};
    const int fr = lane & 15, g = lane >> 4, c0 = w * 16;
    const u32x2 zz = {0u, 0u};
#define GD_STATE_PART(cc_) do { \
        { \
            bf16x8 sb[4]; \
_Pragma("unroll") \
            for (int ks = 0; ks < 4; ++ks) { u32x2 slo, shi; slo.x = hw_pk2(Sacc[2 * ks][0], Sacc[2 * ks][1]); slo.y = hw_pk2(Sacc[2 * ks][2], Sacc[2 * ks][3]); shi.x = hw_pk2(Sacc[2 * ks + 1][0], Sacc[2 * ks + 1][1]); shi.y = hw_pk2(Sacc[2 * ks + 1][2], Sacc[2 * ks + 1][3]); \
                sb[ks] = mk_frag(slo, shi); } \
            f32x4 accv = accu, acco = {0.f, 0.f, 0.f, 0.f}; \
_Pragma("unroll") \
            for (int ks = 0; ks < 4; ++ks) { \
                const u32x2 wl = *(const LAS u32x2*)(WB + fr * RS + 32 * ks + 4 * g), wh = *(const LAS u32x2*)(WB + fr * RS + 32 * ks + 16 + 4 * g); \
                accv = __builtin_amdgcn_mfma_f32_16x16x32_bf16(mk_frag(wl, wh), sb[ks], accv, 0, 0, 0); \
                const u32x2 ql = *(const LAS u32x2*)(QB + fr * RS + 32 * ks + 4 * g), qh = *(const LAS u32x2*)(QB + fr * RS + 32 * ks + 16 + 4 * g); \
                acco = __builtin_amdgcn_mfma_f32_16x16x32_bf16(mk_frag(ql, qh), sb[ks], acco, 0, 0, 0); } \
            u32x2 vn; vn.x = hw_pk2(accv[0], accv[1]); vn.y = hw_pk2(accv[2], accv[3]); \
            const bf16x8 vnb = mk_frag(vn, zz); \
            acco = __builtin_amdgcn_mfma_f32_16x16x32_bf16(mk_frag(*(const LAS u32x2*)(QKM + fr * 16 + 4 * g), zz), vnb, acco, 0, 0, 0); \
_Pragma("unroll") \
            for (int r = 0; r < 4; ++r) O[(size_t)((cc_) * TC + 4 * g + r) * D + c0 + fr] = hw_bf(acco[r]); \
_Pragma("unroll") \
            for (int i = 0; i < 8; ++i) { const u32x2 klo = *(const LAS u32x2*)(KT + (16 * i + fr) * 16 + 4 * g); \
                Sacc[i] = __builtin_amdgcn_mfma_f32_16x16x32_bf16(mk_frag(klo, zz), vnb, Sacc[i] * glast, 0, 0, 0); } \
        } \
        } while (0)
    for (int c = c_begin; c < c_end; ++c) {
        const LAS float* B_ = Lf + O_BUF0 + (c & 1) * BUFSZ;
        float glast;
        {
            const int seg = tid >> 7, d = tid & 127;
            const f32x4 a0 = *(const LAS f32x4*)(B_ + O_SC), a1 = *(const LAS f32x4*)(B_ + O_SC + 4), a2 = *(const LAS f32x4*)(B_ + O_SC + 8), a3 = *(const LAS f32x4*)(B_ + O_SC + 12);
            const float av[16] = {a0[0], a0[1], a0[2], a0[3], a1[0], a1[1], a1[2], a1[3], a2[0], a2[1], a2[2], a2[3], a3[0], a3[1], a3[2], a3[3]};
            float p = 1.f, gpre = 1.f;
#pragma unroll
            for (int t = 0; t < 16; ++t) { if (t == 4 * seg) gpre = p; p *= av[t]; }
            glast = p;
            unsigned short kt4[4]; float gt = gpre;
#pragma unroll
            for (int i = 0; i < 4; ++i) { const int t = 4 * seg + i; const float at = (seg == 0) ? av[i] : (seg == 1) ? av[4 + i] : (seg == 2) ? av[8 + i] : av[12 + i]; gt *= at; const float beta = B_[O_SC + 16 + t];
                const float kk = B_[O_KH + t * 128 + d], qq = B_[O_QH + t * 128 + d];
                KHB[t * RS + d] = hw_bf(kk); QHB[t * RS + d] = hw_bf(qq); QB[t * RS + d] = hw_bf(qq * gt);
                kt4[i] = (unsigned short)hw_bf(kk * glast * __builtin_amdgcn_rcpf(gt));
                Lf[O_WSRC + t * 128 + d] = kk * (beta * gt);
                if (d == 0) Lf[O_GL + t] = gt; }
            u32x2 kw; kw.x = (unsigned)kt4[0] | ((unsigned)kt4[1] << 16); kw.y = (unsigned)kt4[2] | ((unsigned)kt4[3] << 16);
            *(LAS u32x2*)(KT + d * 16 + 4 * seg) = kw;
        }
        LBAR();
        if (w < 2) {
            const LAS bf16* AS = (w == 0) ? KHB : QHB;
            f32x4 acc = {0.f, 0.f, 0.f, 0.f};
#pragma unroll
            for (int ks = 0; ks < 4; ++ks) { const bf16x8 af = *(const LAS bf16x8*)(AS + fr * RS + 32 * ks + 8 * g), bfm = *(const LAS bf16x8*)(KHB + fr * RS + 32 * ks + 8 * g);
                acc = __builtin_amdgcn_mfma_f32_16x16x32_bf16(af, bfm, acc, 0, 0, 0); }
            const float gs_inv = __builtin_amdgcn_rcpf(Lf[O_GL + fr]);
            if (w == 0) {
                f32x4 N1, M1;
#pragma unroll
                for (int r = 0; r < 4; ++r) { const int t = 4 * g + r; const float gt = Lf[O_GL + t];
                    N1[r] = (fr < t) ? -(B_[O_SC + 16 + t] * acc[r] * gt * gs_inv) : 0.f;
                    M1[r] = (t < fr) ? -(B_[O_SC + 16 + fr] * acc[r] * Lf[O_GL + fr] * __builtin_amdgcn_rcpf(gt)) : 0.f; }
#define XTY(X, Y, C0) __builtin_amdgcn_mfma_f32_16x16x32_bf16(mk_frag((u32x2){hw_pk2(X[0], X[1]), hw_pk2(X[2], X[3])}, zz), mk_frag((u32x2){hw_pk2(Y[0], Y[1]), hw_pk2(Y[2], Y[3])}, zz), C0, 0, 0, 0)
                const f32x4 z4 = {0.f, 0.f, 0.f, 0.f};
                f32x4 T1t = M1;
#pragma unroll
                for (int r = 0; r < 4; ++r) if (4 * g + r == fr) T1t[r] += 1.f;
                const f32x4 N2 = XTY(M1, N1, z4), M2 = XTY(N1, M1, z4);
                const f32x4 T2t = XTY(N2, T1t, T1t);
                const f32x4 N4 = XTY(M2, N2, z4), M4 = XTY(N2, M2, z4);
                const f32x4 T4t = XTY(N4, T2t, T2t);
                const f32x4 N8 = XTY(M4, N4, z4);
                const f32x4 T8t = XTY(N8, T4t, T4t);
#undef XTY
                u32x2 tw; tw.x = hw_pk2(T8t[0], T8t[1]); tw.y = hw_pk2(T8t[2], T8t[3]);
                *(LAS u32x2*)(TB + fr * 16 + 4 * g) = tw;
            } else {
#pragma unroll
                for (int r = 0; r < 4; ++r) { const int t = 4 * g + r; QKM[t * 16 + fr] = hw_bf((fr <= t) ? acc[r] * Lf[O_GL + t] * gs_inv : 0.f); }
            }
        }
        if (c + 1 < c_end) GD_XFORM((c + 1) & 1);
        if (c + 2 < c_end) GD_LOAD(c + 2);
        LBAR();
        f32x4 accu = {0.f, 0.f, 0.f, 0.f};
        {
            const bf16x8 tf = mk_frag(*(const LAS u32x2*)(TB + fr * 16 + 4 * g), zz);
            u32x2 ulo, wlo;
            { const float b0 = B_[O_SC + 16 + 4 * g + 0], b1 = B_[O_SC + 16 + 4 * g + 1], b2 = B_[O_SC + 16 + 4 * g + 2], b3 = B_[O_SC + 16 + 4 * g + 3];
              ulo.x = hw_pk2(b0 * B_[O_VV + (4 * g + 0) * 128 + c0 + fr], b1 * B_[O_VV + (4 * g + 1) * 128 + c0 + fr]); ulo.y = hw_pk2(b2 * B_[O_VV + (4 * g + 2) * 128 + c0 + fr], b3 * B_[O_VV + (4 * g + 3) * 128 + c0 + fr]);
              wlo.x = hw_pk2(Lf[O_WSRC + (4 * g + 0) * 128 + c0 + fr], Lf[O_WSRC + (4 * g + 1) * 128 + c0 + fr]); wlo.y = hw_pk2(Lf[O_WSRC + (4 * g + 2) * 128 + c0 + fr], Lf[O_WSRC + (4 * g + 3) * 128 + c0 + fr]); }
            accu = __builtin_amdgcn_mfma_f32_16x16x32_bf16(tf, mk_frag(ulo, zz), accu, 0, 0, 0);
            f32x4 accw = {0.f, 0.f, 0.f, 0.f};
            accw = __builtin_amdgcn_mfma_f32_16x16x32_bf16(tf, mk_frag(wlo, zz), accw, 0, 0, 0);
#pragma unroll
            for (int r = 0; r < 4; ++r) WB[(4 * g + r) * RS + c0 + fr] = hw_bf(-accw[r]);
        }
        LBAR();
        if (role == 0) {
            GD_STATE_PART(c);
        } else {
            float* rec = STASH + (size_t)(c - c_begin) * REC;
            for (int i = tid; i < 832; i += NTHREADS) { const int o = i < 528 ? O_QB + 4 * i : (i < 800 ? O_WB + 4 * (i - 528) : O_QKM + 4 * (i - 800)); *(GAS f32x4*)(rec + 4 * i) = *(const LAS f32x4*)(Lf + o); }
#pragma unroll
            for (int r = 0; r < 4; ++r) rec[3328 + (w * 4 + r) * 64 + lane] = accu[r];
            if (tid == 0) rec[5376] = glast;
        }
        LBAR();
    }
    if (role == 0) {
#pragma unroll
        for (int i = 0; i < 8; ++i)
#pragma unroll
            for (int r = 0; r < 4; ++r) STATE[((w * 8 + i) * 4 + r) * 64 + lane] = Sacc[i][r];
        asm volatile("s_waitcnt vmcnt(0)" ::: "memory");
        __syncthreads();
        if (tid == 0) { __builtin_amdgcn_fence(__ATOMIC_RELEASE, "agent"); asm volatile("s_waitcnt vmcnt(0)" ::: "memory"); __hip_atomic_store(flag, 1u, __ATOMIC_RELAXED, __HIP_MEMORY_SCOPE_AGENT); }
    } else {
        if (tid == 0) { unsigned sp = 0; while (__hip_atomic_load(flag, __ATOMIC_RELAXED, __HIP_MEMORY_SCOPE_AGENT) == 0u) { __builtin_amdgcn_s_sleep(8); if (++sp > (1u << 22)) break; }
            __builtin_amdgcn_fence(__ATOMIC_ACQUIRE, "agent"); asm volatile("s_waitcnt vmcnt(0)" ::: "memory"); }
        __syncthreads();
#pragma unroll
        for (int i = 0; i < 8; ++i)
#pragma unroll
            for (int r = 0; r < 4; ++r) Sacc[i][r] = STATE[((w * 8 + i) * 4 + r) * 64 + lane];
        f32x4 pa, pb; f32x4 pu; float pg;
#define GD_REC_LOAD(cc) do { const float* rec = STASH + (size_t)((cc) - c_begin) * REC; pa = *(const GAS f32x4*)(rec + 4 * tid); pb = (tid < 320) ? *(const GAS f32x4*)(rec + 4 * (tid + 512)) : (f32x4){0.f, 0.f, 0.f, 0.f}; \
            _Pragma("unroll") for (int r = 0; r < 4; ++r) pu[r] = rec[3328 + (w * 4 + r) * 64 + lane]; pg = rec[5376]; } while (0)
        GD_REC_LOAD(c_begin);
        for (int c = c_begin; c < c_end; ++c) {
            { const int i0 = tid, o0 = i0 < 528 ? O_QB + 4 * i0 : O_WB + 4 * (i0 - 528); *(LAS f32x4*)(Lf + o0) = pa;
              if (tid < 320) { const int i1 = tid + 512; const int o1 = i1 < 528 ? O_QB + 4 * i1 : (i1 < 800 ? O_WB + 4 * (i1 - 528) : O_QKM + 4 * (i1 - 800)); *(LAS f32x4*)(Lf + o1) = pb; } }
            const f32x4 accu = pu; const float glast = pg;
            if (c + 1 < c_end) GD_REC_LOAD(c + 1);
            LBAR();
            GD_STATE_PART(c);
            LBAR();
        }
#undef GD_REC_LOAD
    }
#undef GD_STATE_PART
#undef GD_LOAD
#undef GD_XFORM
}

__device__ __forceinline__ void scan_rwkv_unit(const Args& A, Frame& F, int unit) {
    int tid = F.tid; asm volatile("" : "+v"(tid));
    const int lane = tid & 63, w = F.wave;
    const int b = unit >> 4, h = unit & 15;
    const bf16* P = (const bf16*)(A.ws + WS_PROJ) + (size_t)b * SEQ * PROJ_LD + OC_RW;
    const bf16* LO = (const bf16*)(A.ws + WS_LO) + (size_t)b * SEQ * LORA_N;
    bf16* Y = (bf16*)(A.ws + WS_ACTA) + (size_t)b * SEQ * D + 1024 + h * 64;
    LAS float* Lf = (LAS float*)(F.lds + RING_OFF);
    constexpr int BUFSZ = 6208, O_KK = 0, O_WR = 1024, O_W = 2048, O_NKA = 3072, O_K = 4096, O_V = 5120, O_SC = 6144, O_OUT = 2 * BUFSZ;
    const int tl = tid >> 5, d2 = (tid & 31) * 2, hd = h * 64 + d2;
    float mu_r[2], mu_k[2], mu_v[2], w0[2], a0[2], k_k[2], k_a[2], r_k[2], lnw[2], lnb[2];
#pragma unroll
    for (int i = 0; i < 2; ++i) { mu_r[i] = A.in[I_MU][RW_R + hd + i]; mu_k[i] = A.in[I_MU][RW_K + hd + i]; mu_v[i] = A.in[I_MU][RW_V + hd + i];
        w0[i] = A.in[I_W0][hd + i]; a0[i] = A.in[I_A0][hd + i]; k_k[i] = A.in[I_KK][hd + i]; k_a[i] = A.in[I_KA][hd + i]; r_k[i] = A.in[I_RK][hd + i];
        lnw[i] = A.in[I_LNW][hd + i]; lnb[i] = A.in[I_LNB][hd + i]; }
    unsigned rr[2], rk[2], rv[2], rlw, rla, rg_cur = 0u, rg_nxt = 0u;
#define RW_LOAD(c) do { const int t_ = (c) * TC + tl; const bf16* pr = P + (size_t)t_ * PROJ_LD; \
        rr[0] = *(const GAS unsigned*)(pr + RW_R + hd); rk[0] = *(const GAS unsigned*)(pr + RW_K + hd); rv[0] = *(const GAS unsigned*)(pr + RW_V + hd); \
        if (t_ > 0) { rr[1] = *(const GAS unsigned*)(pr - PROJ_LD + RW_R + hd); rk[1] = *(const GAS unsigned*)(pr - PROJ_LD + RW_K + hd); rv[1] = *(const GAS unsigned*)(pr - PROJ_LD + RW_V + hd); } \
        else { rr[1] = 0u; rk[1] = 0u; rv[1] = 0u; } \
        const bf16* lr = LO + (size_t)t_ * LORA_N; rlw = *(const GAS unsigned*)(lr + hd); rla = *(const GAS unsigned*)(lr + 1024 + hd); rg_nxt = *(const GAS unsigned*)(lr + 2048 + hd); } while (0)
#define RW_XFORM(bufi) do { LAS float* B_ = Lf + (bufi) * BUFSZ; f32x2 kk2, wr2, w2_, nka2, k2, v2_; float skk = 0.f, sc1 = 0.f, sc2 = 0.f, sbs = 0.f; float aa[2], rrv[2]; \
        _Pragma("unroll") for (int i_ = 0; i_ < 2; ++i_) { \
            const float r0 = i_ ? bf_hi(rr[0]) : bf_lo(rr[0]), r1 = i_ ? bf_hi(rr[1]) : bf_lo(rr[1]); \
            const float k0_ = i_ ? bf_hi(rk[0]) : bf_lo(rk[0]), k1_ = i_ ? bf_hi(rk[1]) : bf_lo(rk[1]); \
            const float v0_ = i_ ? bf_hi(rv[0]) : bf_lo(rv[0]), v1_ = i_ ? bf_hi(rv[1]) : bf_lo(rv[1]); \
            const float lw = i_ ? bf_hi(rlw) : bf_lo(rlw), la = i_ ? bf_hi(rla) : bf_lo(rla); \
            const float r_ = r0 + (r1 - r0) * mu_r[i_], kx = k0_ + (k1_ - k0_) * mu_k[i_], vx = v0_ + (v1_ - v0_) * mu_v[i_]; \
            const float wd = __expf(-0.6065306597126334f * sigmoidf_(w0[i_] + lw)); const float a_ = sigmoidf_(a0[i_] + la); \
            const float kk0 = kx * k_k[i_]; const float km = kx * (1.f + (a_ - 1.f) * k_a[i_]); \
            kk2[i_] = kk0; skk += kk0 * kk0; aa[i_] = a_; rrv[i_] = r_; wr2[i_] = wd * r_; w2_[i_] = wd; k2[i_] = km; v2_[i_] = vx; sc2 += km * r_; sbs += r_ * km * r_k[i_]; } \
        skk = half_sum32(skk); const float rkk = __builtin_amdgcn_rsqf(skk + EPS); \
        _Pragma("unroll") for (int i_ = 0; i_ < 2; ++i_) { kk2[i_] *= rkk; nka2[i_] = -(kk2[i_] * aa[i_]); sc1 += kk2[i_] * aa[i_] * rrv[i_]; } \
        sc1 = half_sum32(sc1); sc2 = half_sum32(sc2); sbs = half_sum32(sbs); \
        *(LAS f32x2*)(B_ + O_KK + tl * 64 + d2) = kk2; *(LAS f32x2*)(B_ + O_WR + tl * 64 + d2) = wr2; *(LAS f32x2*)(B_ + O_W + tl * 64 + d2) = w2_; \
        *(LAS f32x2*)(B_ + O_NKA + tl * 64 + d2) = nka2; *(LAS f32x2*)(B_ + O_K + tl * 64 + d2) = k2; *(LAS f32x2*)(B_ + O_V + tl * 64 + d2) = v2_; \
        if ((tid & 31) == 0) { f32x4 sc; sc[0] = sc1; sc[1] = sc2; sc[2] = sbs; sc[3] = 0.f; *(LAS f32x4*)(B_ + O_SC + tl * 4) = sc; } } while (0)
    RW_LOAD(0); RW_XFORM(0); rg_cur = rg_nxt;
    LBAR();
    f32x2 S2[4];
#pragma unroll
    for (int i = 0; i < 4; ++i) S2[i] = (f32x2){0.f, 0.f};
    const int j = lane & 15, col = w * 8 + (lane >> 4) * 2;
    for (int c = 0; c < NCHUNK; ++c) {
        if (c + 1 < NCHUNK) RW_LOAD(c + 1);
        const LAS float* B_ = Lf + (c & 1) * BUFSZ;
        float os0 = 0.f, os1 = 0.f;
        f32x4 kk, wr, ww, nka, kv, sc, nkk, nwr, nww, nnka, nkv, nsc; f32x2 v2, nv2;
#define RW_LDSTEP(t_, KK, WR, WW, NKA, KV, V2, SC) do { KK = *(const LAS f32x4*)(B_ + O_KK + (t_) * 64 + 4 * j); WR = *(const LAS f32x4*)(B_ + O_WR + (t_) * 64 + 4 * j); WW = *(const LAS f32x4*)(B_ + O_W + (t_) * 64 + 4 * j); \
            NKA = *(const LAS f32x4*)(B_ + O_NKA + (t_) * 64 + 4 * j); KV = *(const LAS f32x4*)(B_ + O_K + (t_) * 64 + 4 * j); V2 = *(const LAS f32x2*)(B_ + O_V + (t_) * 64 + col); SC = *(const LAS f32x4*)(B_ + O_SC + (t_) * 4); } while (0)
        RW_LDSTEP(0, kk, wr, ww, nka, kv, v2, sc);
#pragma unroll
        for (int t = 0; t < TC; ++t) {
            if (t + 1 < TC) { RW_LDSTEP(t + 1, nkk, nwr, nww, nnka, nkv, nv2, nsc); }
            __builtin_amdgcn_sched_barrier(0);
            f32x2 d1 = S2[0] * kk[0], d2 = S2[0] * wr[0], e1 = S2[1] * kk[1], e2 = S2[1] * wr[1];
            d1 += S2[2] * kk[2]; d2 += S2[2] * wr[2]; e1 += S2[3] * kk[3]; e2 += S2[3] * wr[3];
            d1 += e1; d2 += e2;
            { float r0_ = d1[0], r1_ = d1[1], r2_ = d2[0], r3_ = d2[1]; row_sum16_x4(r0_, r1_, r2_, r3_); d1[0] = r0_; d1[1] = r1_; d2[0] = r2_; d2[1] = r3_; }
            const f32x2 o2 = d2 - d1 * sc[0] + v2 * sc[1];
#pragma unroll
            for (int i = 0; i < 4; ++i) S2[i] = S2[i] * ww[i] + d1 * nka[i] + v2 * kv[i];
            os0 = (j == t) ? o2[0] : os0; os1 = (j == t) ? o2[1] : os1;
            kk = nkk; wr = nwr; ww = nww; nka = nnka; kv = nkv; v2 = nv2; sc = nsc;
        }
#undef RW_LDSTEP
        { f32x2 o2 = {os0, os1}; *(LAS f32x2*)(Lf + O_OUT + j * 64 + col) = o2; }
        if (c + 1 < NCHUNK) RW_XFORM((c + 1) & 1);
        LBAR();
        {
            const f32x2 o2 = *(const LAS f32x2*)(Lf + O_OUT + tl * 64 + d2); const f32x2 vv = *(const LAS f32x2*)(B_ + O_V + tl * 64 + d2); const float bs = B_[O_SC + tl * 4 + 2];
            const float mean = half_sum32(o2[0] + o2[1]) * (1.0f / 64.0f); const float e0 = o2[0] - mean, e1 = o2[1] - mean;
            const float var = half_sum32(e0 * e0 + e1 * e1) * (1.0f / 64.0f); const float rs = __builtin_amdgcn_rsqf(var + 64e-5f);
            const float y0 = (e0 * rs * lnw[0] + lnb[0] + bs * vv[0]) * bf_lo(rg_cur), y1 = (e1 * rs * lnw[1] + lnb[1] + bs * vv[1]) * bf_hi(rg_cur);
            *(GAS unsigned*)(Y + (size_t)(c * TC + tl) * D + d2) = pk2(y0, y1);
        }
        rg_cur = rg_nxt;
        LBAR();
    }
#undef RW_LOAD
#undef RW_XFORM
}

template <int LAYER>
__device__ __forceinline__ void post_rows(const Args& A, Frame& F) {
    const int gw = F.vcu * NWAVES + F.wave, NGW = F.G * NWAVES, lane = F.lane;
    const bf16* O = (const bf16*)(A.ws + WS_O); const bf16* P = (const bf16*)(A.ws + WS_PROJ); bf16* Y = (bf16*)(A.ws + WS_ACTA);
    for (int m = gw; m < T; m += NGW) {
        const GAS u32x2* orow = (const GAS u32x2*)(O + (size_t)m * D) + lane; const bf16* prow = P + (size_t)m * PROJ_LD;
        constexpr int NJ = LAYER == 0 ? 8 : 4;
#pragma unroll
        for (int jj = 0; jj < NJ; ++jj) {
            const u32x2 ow_ = orow[64 * jj]; const f32x4 v = {bf_lo(ow_.x), bf_hi(ow_.x), bf_lo(ow_.y), bf_hi(ow_.y)}; float ss = (v[0] * v[0] + v[1] * v[1]) + (v[2] * v[2] + v[3] * v[3]);
            const bool wide = (LAYER == 0 && jj < 4);
            const float ms = wide ? wave_sum(ss) * (1.0f / 256.0f) : half_sum32(ss) * (1.0f / 128.0f);
            const float r = __builtin_amdgcn_rsqf(ms + EPS);
            const int cih = wide ? 4 * lane : 4 * (lane & 31);
            const float* gsrc = LAYER == 0 ? (wide ? A.in[I_GLA_NORM] : A.in[I_GDN_NORM]) : A.in[I_HG_NORM];
            const f32x4 g = *(const GAS f32x4*)(gsrc + cih);
            const int zcol = LAYER == 0 ? (wide ? EC_GZ + jj * 256 + 4 * lane : EC_BZ + (jj - 4) * 256 + 4 * lane) : OC_HG + jj * 256 + 4 * lane;
            const u32x2 zw = *(const GAS u32x2*)(prow + zcol);
            const float y0 = v[0] * r * g[0] * siluf_(bf_lo(zw.x)), y1 = v[1] * r * g[1] * siluf_(bf_hi(zw.x)), y2 = v[2] * r * g[2] * siluf_(bf_lo(zw.y)), y3 = v[3] * r * g[3] * siluf_(bf_hi(zw.y));
            if constexpr (LAYER == 1) { int o8 = __builtin_amdgcn_cvt_pk_fp8_f32(y0, y1, 0, false); o8 = __builtin_amdgcn_cvt_pk_fp8_f32(y2, y3, o8, true);
                *(GAS unsigned*)((unsigned char*)Y + (size_t)m * D + 256 * jj + 4 * lane) = (unsigned)o8; }
            else { u32x2 o; o.x = pk2(y0, y1); o.y = pk2(y2, y3);
                *(GAS u32x2*)(Y + (size_t)m * D + 256 * jj + 4 * lane) = o; }
        }
    }
}
__device__ __forceinline__ void lora_prep_rows(const Args& A, Frame& F) {
    const int gw = F.vcu * NWAVES + F.wave, NGW = F.G * NWAVES, lane = F.lane;
    const bf16* P = (const bf16*)(A.ws + WS_PROJ); bf16* LA = (bf16*)(A.ws + WS_LA); const float* mu = A.in[I_MU];
    for (int m = gw; m < T; m += NGW) { const bool hasprev = (m % SEQ) != 0; const bf16* prow = P + (size_t)m * PROJ_LD + OC_RW + RW_WL;
#pragma unroll
        for (int i = 0; i < 7; ++i) { const int c = lane + 64 * i;
            const float x = __uint_as_float((unsigned)prow[c] << 16), xp = hasprev ? __uint_as_float((unsigned)prow[c - PROJ_LD] << 16) : 0.f;
            const float ts = x + (xp - x) * mu[RW_WL + c];
            const float v = c < 96 ? tanhf(ts) : (c < 192 ? ts : sigmoidf_(ts));
            LA[(size_t)m * LORA_K + c] = (bf16)f2bf(v); }
        LA[(size_t)m * LORA_K + 448 + lane] = (bf16)0; }
}
__device__ __forceinline__ void final_rows(const Args& A, Frame& F, const float oscale, const bf16* Hs) {
    const int gw = F.vcu * NWAVES + F.wave, NGW = F.G * NWAVES, lane = F.lane;
    const float* rowss = (const float*)(A.ws + WS_RSP) + (size_t)RS_FINAL * T * 32; const GAS f32x4* g = (const GAS f32x4*)A.in[I_NFINAL] + lane;
    for (int m = gw; m < T; m += NGW) { const float r = oscale * __builtin_amdgcn_rsqf(wave_sum(lane < 32 ? rowss[(size_t)m * 32 + lane] : 0.f) * (1.0f / D) + EPS); GAS f32x4* row = (GAS f32x4*)(A.out + (size_t)m * D) + lane;
        const GAS u32x2* hrow = (const GAS u32x2*)(Hs + (size_t)m * D) + lane;
#pragma unroll
        for (int jj = 0; jj < 8; ++jj) { const u32x2 hw = hrow[64 * jj]; const f32x4 v = {bf_lo(hw.x), bf_hi(hw.x), bf_lo(hw.y), bf_hi(hw.y)}; row[64 * jj] = v * r * g[64 * jj]; } }
}

__device__ __forceinline__ void scan_rwkv_mfma_unit(const Args& A, Frame& F, int unit, const int role) {
    int tid = F.tid; asm volatile("" : "+v"(tid));
    const int lane = tid & 63, w = F.wave;
    const int b = unit >> 3, hp = unit & 7;
    const bf16* P = (const bf16*)(A.ws + WS_PROJ) + (size_t)b * SEQ * PROJ_LD + OC_RW;
    const bf16* LO = (const bf16*)(A.ws + WS_LO) + (size_t)b * SEQ * LORA_N;
    unsigned char* Y = (unsigned char*)(A.ws + WS_ACTA) + (size_t)b * SEQ * D + 1024;
    LAS float* Lf = (LAS float*)(F.lds + RING_OFF);
    constexpr int RS = 72;
    constexpr int O_CONST = 0;
    constexpr int O_XF = 1280;
    constexpr int O_VV = O_XF + 2 * 5 * 1024;
    constexpr int O_BS = O_VV + 4 * 1024;
    constexpr int O_IMG = O_BS + 64;
    constexpr int I_CT = 0, I_BT = 576, I_KL = 1152, I_RT = 1728, I_CF = 2304, I_BTT = 3328, I_KTT = 3840, I_WCB = 4352, I_G1B = 4928, I_TTB = 5056, I_RKB = 5184, I_RBB = 5312, I_W15 = 5440, I_OUT = 5504, IMGSZ = 6528;
    static_assert((O_IMG + 2 * IMGSZ) * 4 <= RING_BYTES, "rwkv lds");
    for (int i = tid; i < 1280; i += NTHREADS) { const int arr = i >> 7, ch = hp * 128 + (i & 127); float v;
        switch (arr) { case 0: v = A.in[I_MU][RW_R + ch]; break; case 1: v = A.in[I_MU][RW_K + ch]; break; case 2: v = A.in[I_MU][RW_V + ch]; break; case 3: v = A.in[I_W0][ch]; break; case 4: v = A.in[I_A0][ch]; break;
                       case 5: v = A.in[I_KK][ch]; break; case 6: v = A.in[I_KA][ch]; break; case 7: v = A.in[I_RK][ch]; break; case 8: v = A.in[I_LNW][ch]; break; default: v = A.in[I_LNB][ch]; break; }
        Lf[O_CONST + i] = v; }
    const int hx = tid >> 8, tl = (tid >> 4) & 15, d4 = (tid & 15) * 4, ch4 = hx * 64 + d4, col4 = hp * 128 + ch4;
    u32x2 rr[2], rk[2], rv[2], rlw, rla, rg_cur = {0u, 0u}, rg_nxt = {0u, 0u}, rg_far = {0u, 0u};
#define RM_LOAD(c) do { const int t_ = (c) * TC + tl; const bf16* pr = P + (size_t)t_ * PROJ_LD + col4; \
        rr[0] = *(const GAS u32x2*)(pr + RW_R); rk[0] = *(const GAS u32x2*)(pr + RW_K); rv[0] = *(const GAS u32x2*)(pr + RW_V); \
        const bf16* pp_ = (t_ > 0) ? pr - PROJ_LD : pr; rr[1] = *(const GAS u32x2*)(pp_ + RW_R); rk[1] = *(const GAS u32x2*)(pp_ + RW_K); rv[1] = *(const GAS u32x2*)(pp_ + RW_V); \
        if (t_ == 0) { rr[1] = (u32x2){0u, 0u}; rk[1] = (u32x2){0u, 0u}; rv[1] = (u32x2){0u, 0u}; } \
        const bf16* lr = LO + (size_t)t_ * LORA_N + col4; rlw = *(const GAS u32x2*)(lr); rla = *(const GAS u32x2*)(lr + 1024); rg_far = *(const GAS u32x2*)(lr + 2048); } while (0)
#define RM_XFORM(bufi) do { LAS float* X_ = Lf + O_XF + hx * 5 * 1024 + tl * 64 + d4; \
        const f32x4 mur = *(const LAS f32x4*)(Lf + O_CONST + 0 * 128 + ch4), muk = *(const LAS f32x4*)(Lf + O_CONST + 1 * 128 + ch4), muv = *(const LAS f32x4*)(Lf + O_CONST + 2 * 128 + ch4); \
        const f32x4 w0_ = *(const LAS f32x4*)(Lf + O_CONST + 3 * 128 + ch4), a0_ = *(const LAS f32x4*)(Lf + O_CONST + 4 * 128 + ch4), kk_ = *(const LAS f32x4*)(Lf + O_CONST + 5 * 128 + ch4); \
        const f32x4 ka_ = *(const LAS f32x4*)(Lf + O_CONST + 6 * 128 + ch4), rk_ = *(const LAS f32x4*)(Lf + O_CONST + 7 * 128 + ch4); \
        const float r0[4] = {bf_lo(rr[0].x), bf_hi(rr[0].x), bf_lo(rr[0].y), bf_hi(rr[0].y)}, r1[4] = {bf_lo(rr[1].x), bf_hi(rr[1].x), bf_lo(rr[1].y), bf_hi(rr[1].y)}; \
        const float k0[4] = {bf_lo(rk[0].x), bf_hi(rk[0].x), bf_lo(rk[0].y), bf_hi(rk[0].y)}, k1[4] = {bf_lo(rk[1].x), bf_hi(rk[1].x), bf_lo(rk[1].y), bf_hi(rk[1].y)}; \
        const float v0[4] = {bf_lo(rv[0].x), bf_hi(rv[0].x), bf_lo(rv[0].y), bf_hi(rv[0].y)}, v1[4] = {bf_lo(rv[1].x), bf_hi(rv[1].x), bf_lo(rv[1].y), bf_hi(rv[1].y)}; \
        const float lw[4] = {bf_lo(rlw.x), bf_hi(rlw.x), bf_lo(rlw.y), bf_hi(rlw.y)}, la[4] = {bf_lo(rla.x), bf_hi(rla.x), bf_lo(rla.y), bf_hi(rla.y)}; \
        f32x4 r4, w4, k4, v4, kk4, b4; float skk = 0.f, sbs = 0.f; float aa[4]; \
        _Pragma("unroll") for (int i_ = 0; i_ < 4; ++i_) { const float r_ = r0[i_] + (r1[i_] - r0[i_]) * mur[i_], kx = k0[i_] + (k1[i_] - k0[i_]) * muk[i_], vx = v0[i_] + (v1[i_] - v0[i_]) * muv[i_]; \
            const float wd = __expf(-0.6065306597126334f * sigmoidf_(w0_[i_] + lw[i_])); const float a_ = sigmoidf_(a0_[i_] + la[i_]); \
            const float kk0 = kx * kk_[i_], km = kx * (1.f + (a_ - 1.f) * ka_[i_]); \
            r4[i_] = r_; w4[i_] = wd; k4[i_] = km; v4[i_] = vx; kk4[i_] = kk0; aa[i_] = a_; skk += kk0 * kk0; sbs += r_ * km * rk_[i_]; } \
        row_sum16_x2(skk, sbs); const float rkk = __builtin_amdgcn_rsqf(skk + EPS); \
        _Pragma("unroll") for (int i_ = 0; i_ < 4; ++i_) { kk4[i_] *= rkk; b4[i_] = kk4[i_] * aa[i_]; } \
        *(LAS f32x4*)(X_) = r4; *(LAS f32x4*)(X_ + 1024) = w4; *(LAS f32x4*)(X_ + 2048) = k4; *(LAS f32x4*)(X_ + 3072) = kk4; *(LAS f32x4*)(X_ + 4096) = b4; \
        *(LAS f32x4*)(Lf + O_VV + ((bufi) * 2 + hx) * 1024 + tl * 64 + d4) = v4; \
        if ((tid & 15) == 0) Lf[O_BS + ((bufi) * 2 + hx) * 16 + tl] = sbs; } while (0)
    constexpr int SPLIT = 60;
    const int c_begin = role ? SPLIT : 0, c_end = role ? NCHUNK : SPLIT;
    constexpr int REC = 7584;
    float* STASH = (float*)(A.ws + (unit < 32 ? WS_WEV_IN : WS_END)) + (size_t)(unit & 31) * (NCHUNK - SPLIT) * REC;
    float* STATE = (float*)(A.ws + WS_STATE + 4 * MiB) + (size_t)unit * 8192;
    gu32* flag = F.ctl + 49152 + unit * 64;
    LBAR();
    RM_LOAD(c_begin); RM_XFORM(c_begin & 1); rg_cur = rg_far; RM_LOAD(c_begin + 1); rg_nxt = rg_far;
    LBAR();
    f32x4 Macc[4];
#pragma unroll
    for (int i = 0; i < 4; ++i) Macc[i] = (f32x4){0.f, 0.f, 0.f, 0.f};
    const int fr = lane & 15, g = lane >> 4, hh = w >> 2, ww = w & 3, c0 = ww * 16;
    LAS float* IM = Lf + O_IMG + hh * IMGSZ;
    LAS bf16* CT = (LAS bf16*)(IM + I_CT); LAS bf16* BT = (LAS bf16*)(IM + I_BT); LAS bf16* KL = (LAS bf16*)(IM + I_KL); LAS bf16* RT = (LAS bf16*)(IM + I_RT);
    LAS bf16* BTT = (LAS bf16*)(IM + I_BTT); LAS bf16* KTT = (LAS bf16*)(IM + I_KTT); LAS bf16* WCB = (LAS bf16*)(IM + I_WCB);
    LAS bf16* G1B = (LAS bf16*)(IM + I_G1B); LAS bf16* TTB = (LAS bf16*)(IM + I_TTB); LAS bf16* RKB = (LAS bf16*)(IM + I_RKB); LAS bf16* RBB = (LAS bf16*)(IM + I_RBB);
    const u32x2 zz = {0u, 0u};
#define RM_STATE_PART(vb) do { \
        { \
            bf16x8 mb[2]; \
_Pragma("unroll") \
            for (int ks = 0; ks < 2; ++ks) { u32x2 slo, shi; slo.x = hw_pk2(Macc[2 * ks][0], Macc[2 * ks][1]); slo.y = hw_pk2(Macc[2 * ks][2], Macc[2 * ks][3]); shi.x = hw_pk2(Macc[2 * ks + 1][0], Macc[2 * ks + 1][1]); shi.y = hw_pk2(Macc[2 * ks + 1][2], Macc[2 * ks + 1][3]); \
                mb[ks] = mk_frag(slo, shi); } \
            f32x4 accR = accU, acco = {0.f, 0.f, 0.f, 0.f}; \
_Pragma("unroll") \
            for (int ks = 0; ks < 2; ++ks) { \
                accR = __builtin_amdgcn_mfma_f32_16x16x32_bf16(mk_frag(*(const LAS u32x2*)(WCB + fr * RS + 32 * ks + 4 * g), *(const LAS u32x2*)(WCB + fr * RS + 32 * ks + 16 + 4 * g)), mb[ks], accR, 0, 0, 0); \
                acco = __builtin_amdgcn_mfma_f32_16x16x32_bf16(mk_frag(*(const LAS u32x2*)(RT + fr * RS + 32 * ks + 4 * g), *(const LAS u32x2*)(RT + fr * RS + 32 * ks + 16 + 4 * g)), mb[ks], acco, 0, 0, 0); } \
            u32x2 rn; rn.x = hw_pk2(accR[0], accR[1]); rn.y = hw_pk2(accR[2], accR[3]); \
            const bf16x8 rb = mk_frag(rn, zz); \
            acco = __builtin_amdgcn_mfma_f32_16x16x32_bf16(mk_frag(*(const LAS u32x2*)(RKB + fr * 16 + 4 * g), zz), vb, acco, 0, 0, 0); \
            acco = __builtin_amdgcn_mfma_f32_16x16x32_bf16(mk_frag(*(const LAS u32x2*)(RBB + fr * 16 + 4 * g), zz), rb, acco, 0, 0, 0); \
_Pragma("unroll") \
            for (int r = 0; r < 4; ++r) IM[I_OUT + (4 * g + r) * 64 + c0 + fr] = acco[r]; \
_Pragma("unroll") \
            for (int i = 0; i < 4; ++i) { const f32x4 w15 = *(const LAS f32x4*)(IM + I_W15 + 16 * i + 4 * g); \
                f32x4 m = __builtin_amdgcn_mfma_f32_16x16x32_bf16(mk_frag(*(const LAS u32x2*)(KTT + (16 * i + fr) * 16 + 4 * g), zz), vb, Macc[i], 0, 0, 0); \
                m = __builtin_amdgcn_mfma_f32_16x16x32_bf16(mk_frag(*(const LAS u32x2*)(BTT + (16 * i + fr) * 16 + 4 * g), zz), rb, m, 0, 0, 0); \
                Macc[i] = m * w15; } \
        } \
        } while (0)
#define RM_FLUSH(cc_, gb_, vv_, bs_) do { \
        { \
            const f32x4 o4 = *(const LAS f32x4*)(Lf + O_IMG + hx * IMGSZ + I_OUT + tl * 64 + d4); const f32x4 vv = (vv_); const float bs = (bs_); \
            const f32x4 lnw = *(const LAS f32x4*)(Lf + O_CONST + 8 * 128 + ch4), lnb = *(const LAS f32x4*)(Lf + O_CONST + 9 * 128 + ch4); \
            float sm = (o4[0] + o4[1]) + (o4[2] + o4[3]), dummy = 0.f; row_sum16_x2(sm, dummy); const float mean = sm * (1.0f / 64.0f); \
            const f32x4 e4 = o4 - mean; float sv = (e4[0] * e4[0] + e4[1] * e4[1]) + (e4[2] * e4[2] + e4[3] * e4[3]); row_sum16_x2(sv, dummy); const float rs = __builtin_amdgcn_rsqf(sv * (1.0f / 64.0f) + 64e-5f); \
            const float gg[4] = {bf_lo((gb_).x), bf_hi((gb_).x), bf_lo((gb_).y), bf_hi((gb_).y)}; \
            float y[4]; \
_Pragma("unroll") \
            for (int i = 0; i < 4; ++i) y[i] = (e4[i] * rs * lnw[i] + lnb[i] + bs * vv[i]) * gg[i]; \
            int o8 = __builtin_amdgcn_cvt_pk_fp8_f32(y[0], y[1], 0, false); o8 = __builtin_amdgcn_cvt_pk_fp8_f32(y[2], y[3], o8, true); \
            *(GAS unsigned*)(Y + (size_t)((cc_) * TC + tl) * D + col4) = (unsigned)o8; \
        } \
        } while (0)
    for (int c = c_begin; c < c_end; ++c) {
        {
            const int hq = tid >> 8, seg = (tid >> 6) & 3, d = tid & 63;
            const LAS float* X_ = Lf + O_XF + hq * 5 * 1024 + d; LAS float* IQ = Lf + O_IMG + hq * IMGSZ;
            LAS bf16* CTq = (LAS bf16*)(IQ + I_CT); LAS bf16* BTq = (LAS bf16*)(IQ + I_BT); LAS bf16* KLq = (LAS bf16*)(IQ + I_KL); LAS bf16* RTq = (LAS bf16*)(IQ + I_RT);
            float wall = 1.f, wpre = 1.f;
#pragma unroll
            for (int t = 0; t < 16; ++t) { if (t == 4 * seg) wpre = wall; wall *= X_[1024 + t * 64]; }
            float wt = wpre; unsigned short bt4[4], kt4[4];
#pragma unroll
            for (int i = 0; i < 4; ++i) { const int t = 4 * seg + i; const float wprev = wt; wt *= X_[1024 + t * 64]; const float iw = __builtin_amdgcn_rcpf(wt);
                const float r_ = X_[t * 64], k_ = X_[2048 + t * 64], kk_ = X_[3072 + t * 64], b_ = X_[4096 + t * 64];
                const float ct = kk_ * wprev, bt = b_ * iw, kt = k_ * iw;
                CTq[t * RS + d] = hw_bf(ct); IQ[I_CF + t * 64 + d] = ct; BTq[t * RS + d] = hw_bf(bt); KLq[t * RS + d] = hw_bf(kt); RTq[t * RS + d] = hw_bf(r_ * wt);
                bt4[i] = (unsigned short)hw_bf(-bt); kt4[i] = (unsigned short)hw_bf(kt); }
            u32x2 o; o.x = (unsigned)bt4[0] | ((unsigned)bt4[1] << 16); o.y = (unsigned)bt4[2] | ((unsigned)bt4[3] << 16); *(LAS u32x2*)((LAS bf16*)(IQ + I_BTT) + d * 16 + 4 * seg) = o;
            o.x = (unsigned)kt4[0] | ((unsigned)kt4[1] << 16); o.y = (unsigned)kt4[2] | ((unsigned)kt4[3] << 16); *(LAS u32x2*)((LAS bf16*)(IQ + I_KTT) + d * 16 + 4 * seg) = o;
            if (seg == 3) IQ[I_W15 + d] = wall;
        }
        LBAR();
        if (ww == 0) {
            f32x4 cb = {0.f, 0.f, 0.f, 0.f}, bc = cb, ck = cb, rkm = cb, rbm = cb;
#pragma unroll
            for (int ks = 0; ks < 2; ++ks) { const bf16x8 fc = *(const LAS bf16x8*)(CT + fr * RS + 32 * ks + 8 * g), fb = *(const LAS bf16x8*)(BT + fr * RS + 32 * ks + 8 * g), fk = *(const LAS bf16x8*)(KL + fr * RS + 32 * ks + 8 * g), frr = *(const LAS bf16x8*)(RT + fr * RS + 32 * ks + 8 * g);
                cb = __builtin_amdgcn_mfma_f32_16x16x32_bf16(fc, fb, cb, 0, 0, 0); bc = __builtin_amdgcn_mfma_f32_16x16x32_bf16(fb, fc, bc, 0, 0, 0); ck = __builtin_amdgcn_mfma_f32_16x16x32_bf16(fc, fk, ck, 0, 0, 0);
                rkm = __builtin_amdgcn_mfma_f32_16x16x32_bf16(frr, fk, rkm, 0, 0, 0); rbm = __builtin_amdgcn_mfma_f32_16x16x32_bf16(frr, fb, rbm, 0, 0, 0); }
            f32x4 N1, M1, CKm;
#pragma unroll
            for (int r = 0; r < 4; ++r) { const int t = 4 * g + r; N1[r] = (fr < t) ? -cb[r] : 0.f; M1[r] = (t < fr) ? -bc[r] : 0.f; CKm[r] = (fr < t) ? ck[r] : 0.f;
                RKB[t * 16 + fr] = hw_bf((fr <= t) ? rkm[r] : 0.f); RBB[t * 16 + fr] = hw_bf((fr <= t) ? -rbm[r] : 0.f); }
#define XTY(X, Y, C0) __builtin_amdgcn_mfma_f32_16x16x32_bf16(mk_frag((u32x2){hw_pk2(X[0], X[1]), hw_pk2(X[2], X[3])}, zz), mk_frag((u32x2){hw_pk2(Y[0], Y[1]), hw_pk2(Y[2], Y[3])}, zz), C0, 0, 0, 0)
            const f32x4 z4 = {0.f, 0.f, 0.f, 0.f};
            f32x4 T1t = M1;
#pragma unroll
            for (int r = 0; r < 4; ++r) if (4 * g + r == fr) T1t[r] += 1.f;
            const f32x4 N2 = XTY(M1, N1, z4), M2 = XTY(N1, M1, z4);
            const f32x4 T2t = XTY(N2, T1t, T1t);
            const f32x4 N4 = XTY(M2, N2, z4), M4 = XTY(N2, M2, z4);
            const f32x4 T4t = XTY(N4, T2t, T2t);
            const f32x4 N8 = XTY(M4, N4, z4);
            const f32x4 T8t = XTY(N8, T4t, T4t);
            const f32x4 G1t = XTY(CKm, T8t, z4);
#undef XTY
            u32x2 tw; tw.x = hw_pk2(T8t[0], T8t[1]); tw.y = hw_pk2(T8t[2], T8t[3]); *(LAS u32x2*)(TTB + fr * 16 + 4 * g) = tw;
            tw.x = hw_pk2(G1t[0], G1t[1]); tw.y = hw_pk2(G1t[2], G1t[3]); *(LAS u32x2*)(G1B + fr * 16 + 4 * g) = tw;
        }
        if (c + 1 < c_end) { RM_XFORM((c + 1) & 1); }
        if (c + 2 < c_end) RM_LOAD(c + 2);
        LBAR();
        const LAS float* VVc = Lf + O_VV + ((c & 1) * 2 + hh) * 1024;
        u32x2 vlo; { vlo.x = hw_pk2(VVc[(4 * g + 0) * 64 + c0 + fr], VVc[(4 * g + 1) * 64 + c0 + fr]); vlo.y = hw_pk2(VVc[(4 * g + 2) * 64 + c0 + fr], VVc[(4 * g + 3) * 64 + c0 + fr]); }
        const bf16x8 vb = mk_frag(vlo, zz);
        f32x4 accU = {0.f, 0.f, 0.f, 0.f};
        {
            accU = __builtin_amdgcn_mfma_f32_16x16x32_bf16(mk_frag(*(const LAS u32x2*)(G1B + fr * 16 + 4 * g), zz), vb, accU, 0, 0, 0);
            u32x2 clo; clo.x = hw_pk2(IM[I_CF + (4 * g + 0) * 64 + c0 + fr], IM[I_CF + (4 * g + 1) * 64 + c0 + fr]); clo.y = hw_pk2(IM[I_CF + (4 * g + 2) * 64 + c0 + fr], IM[I_CF + (4 * g + 3) * 64 + c0 + fr]);
            f32x4 accw = {0.f, 0.f, 0.f, 0.f};
            accw = __builtin_amdgcn_mfma_f32_16x16x32_bf16(mk_frag(*(const LAS u32x2*)(TTB + fr * 16 + 4 * g), zz), mk_frag(clo, zz), accw, 0, 0, 0);
#pragma unroll
            for (int r = 0; r < 4; ++r) WCB[(4 * g + r) * RS + c0 + fr] = hw_bf(accw[r]);
        }
        LBAR();
        if (role == 0) {
            RM_STATE_PART(vb);
            LBAR();
            RM_FLUSH(c, rg_cur, *(const LAS f32x4*)(Lf + O_VV + ((c & 1) * 2 + hx) * 1024 + tl * 64 + d4), Lf[O_BS + ((c & 1) * 2 + hx) * 16 + tl]);
        } else {
            float* rec = STASH + (size_t)(c - c_begin) * REC;
            for (int i = tid; i < 1376; i += NTHREADS) { const int hd = i >= 688, j = i - hd * 688; const int o = O_IMG + hd * IMGSZ + (j < 144 ? I_RT + 4 * j : I_BTT + 4 * (j - 144)); *(GAS f32x4*)(rec + 4 * i) = *(const LAS f32x4*)(Lf + o); }
            { GAS unsigned* ru = (GAS unsigned*)(rec + 5504); ru[(w * 2 + 0) * 64 + lane] = hw_pk2(accU[0], accU[1]); ru[(w * 2 + 1) * 64 + lane] = hw_pk2(accU[2], accU[3]); }
            { const f32x4 v4 = *(const LAS f32x4*)(Lf + O_VV + ((c & 1) * 2 + hx) * 1024 + tl * 64 + d4); u32x2 o; o.x = hw_pk2(v4[0], v4[1]); o.y = hw_pk2(v4[2], v4[3]); *(GAS u32x2*)(rec + 6528 + 2 * tid) = o; }
            if (tid < 32) rec[7552 + tid] = Lf[O_BS + (c & 1) * 32 + tid];
            LBAR();
        }
        rg_cur = rg_nxt; rg_nxt = rg_far;
    }
    if (role == 0) {
#pragma unroll
        for (int i = 0; i < 4; ++i)
#pragma unroll
            for (int r = 0; r < 4; ++r) STATE[((w * 4 + i) * 4 + r) * 64 + lane] = Macc[i][r];
        asm volatile("s_waitcnt vmcnt(0)" ::: "memory");
        __syncthreads();
        if (tid == 0) { __builtin_amdgcn_fence(__ATOMIC_RELEASE, "agent"); asm volatile("s_waitcnt vmcnt(0)" ::: "memory"); __hip_atomic_store(flag, 1u, __ATOMIC_RELAXED, __HIP_MEMORY_SCOPE_AGENT); }
    } else {
        if (tid == 0) { unsigned sp = 0; while (__hip_atomic_load(flag, __ATOMIC_RELAXED, __HIP_MEMORY_SCOPE_AGENT) == 0u) { __builtin_amdgcn_s_sleep(8); if (++sp > (1u << 22)) break; }
            __builtin_amdgcn_fence(__ATOMIC_ACQUIRE, "agent"); asm volatile("s_waitcnt vmcnt(0)" ::: "memory"); }
        __syncthreads();
#pragma unroll
        for (int i = 0; i < 4; ++i)
#pragma unroll
            for (int r = 0; r < 4; ++r) Macc[i][r] = STATE[((w * 4 + i) * 4 + r) * 64 + lane];
        f32x4 pi0, pi1, pi2; unsigned pu0, pu1; u32x2 pv, pgate; float pbs;
#define RM_REC_LOAD(cc) do { const float* rec = STASH + (size_t)((cc) - c_begin) * REC; pi0 = *(const GAS f32x4*)(rec + 4 * tid); pi1 = *(const GAS f32x4*)(rec + 4 * (tid + 512)); \
            pi2 = (tid < 352) ? *(const GAS f32x4*)(rec + 4 * (tid + 1024)) : (f32x4){0.f, 0.f, 0.f, 0.f}; \
            const GAS unsigned* ru = (const GAS unsigned*)(rec + 5504); pu0 = ru[(w * 2 + 0) * 64 + lane]; pu1 = ru[(w * 2 + 1) * 64 + lane]; pv = *(const GAS u32x2*)(rec + 6528 + 2 * tid); pbs = rec[7552 + hx * 16 + tl]; \
            pgate = *(const GAS u32x2*)(LO + (size_t)((cc) * TC + tl) * LORA_N + col4 + 2048); } while (0)
#define RM_IMG_OFF(i_) (O_IMG + ((i_) >= 688) * IMGSZ + ((((i_) - ((i_) >= 688) * 688) < 144) ? I_RT + 4 * ((i_) - ((i_) >= 688) * 688) : I_BTT + 4 * (((i_) - ((i_) >= 688) * 688) - 144)))
        RM_REC_LOAD(c_begin);
        for (int c = c_begin; c < c_end; ++c) {
            *(LAS f32x4*)(Lf + RM_IMG_OFF(tid)) = pi0; *(LAS f32x4*)(Lf + RM_IMG_OFF(tid + 512)) = pi1; if (tid < 352) *(LAS f32x4*)(Lf + RM_IMG_OFF(tid + 1024)) = pi2;
            const f32x4 vcur = {bf_lo(pv.x), bf_hi(pv.x), bf_lo(pv.y), bf_hi(pv.y)}; *(LAS f32x4*)(Lf + O_VV + hx * 1024 + tl * 64 + d4) = vcur;
            const f32x4 accU = {bf_lo(pu0), bf_hi(pu0), bf_lo(pu1), bf_hi(pu1)}; const float bscur = pbs; const u32x2 gcur = pgate;
            if (c + 1 < c_end) RM_REC_LOAD(c + 1);
            LBAR();
            const LAS float* VVc = Lf + O_VV + hh * 1024;
            u32x2 vlo; { vlo.x = hw_pk2(VVc[(4 * g + 0) * 64 + c0 + fr], VVc[(4 * g + 1) * 64 + c0 + fr]); vlo.y = hw_pk2(VVc[(4 * g + 2) * 64 + c0 + fr], VVc[(4 * g + 3) * 64 + c0 + fr]); }
            const bf16x8 vb = mk_frag(vlo, zz);
            RM_STATE_PART(vb);
            LBAR();
            RM_FLUSH(c, gcur, vcur, bscur);
            LBAR();
        }
#undef RM_REC_LOAD
#undef RM_IMG_OFF
    }
#undef RM_STATE_PART
#undef RM_FLUSH
#undef RM_LOAD
#undef RM_XFORM
}

__device__ __forceinline__ int med3i(int a, int b, int c) { int r; asm("v_med3_i32 %0, %1, %2, %3" : "=v"(r) : "v"(a), "v"(b), "v"(c)); return r; }
__device__ __forceinline__ int f2sort(float f) { int x = __float_as_int(f); return x ^ ((x >> 31) & 0x7fffffff); }
__device__ __forceinline__ float sort2f(int x) { return __int_as_float(x ^ ((x >> 31) & 0x7fffffff)); }
#define TOPK_INSERT(vals, x) do { _Pragma("unroll") for (int s_ = 15; s_ >= 1; --s_) vals[s_] = med3i((x), vals[s_ - 1], vals[s_]); vals[0] = max(vals[0], (x)); } while (0)
__device__ __forceinline__ float bf_dot2(unsigned a, unsigned b, float c) {
    return c + bf_lo(a) * bf_lo(b) + bf_hi(a) * bf_hi(b);
}
__device__ __forceinline__ void sum8_x8(float (&a)[8]) {
    asm("s_nop 1\n\t"
        "v_add_f32_dpp %0, %0, %0 quad_perm:[1,0,3,2] row_mask:0xf bank_mask:0xf\n\tv_add_f32_dpp %1, %1, %1 quad_perm:[1,0,3,2] row_mask:0xf bank_mask:0xf\n\t"
        "v_add_f32_dpp %2, %2, %2 quad_perm:[1,0,3,2] row_mask:0xf bank_mask:0xf\n\tv_add_f32_dpp %3, %3, %3 quad_perm:[1,0,3,2] row_mask:0xf bank_mask:0xf\n\t"
        "v_add_f32_dpp %4, %4, %4 quad_perm:[1,0,3,2] row_mask:0xf bank_mask:0xf\n\tv_add_f32_dpp %5, %5, %5 quad_perm:[1,0,3,2] row_mask:0xf bank_mask:0xf\n\t"
        "v_add_f32_dpp %6, %6, %6 quad_perm:[1,0,3,2] row_mask:0xf bank_mask:0xf\n\tv_add_f32_dpp %7, %7, %7 quad_perm:[1,0,3,2] row_mask:0xf bank_mask:0xf\n\t"
        "v_add_f32_dpp %0, %0, %0 quad_perm:[2,3,0,1] row_mask:0xf bank_mask:0xf\n\tv_add_f32_dpp %1, %1, %1 quad_perm:[2,3,0,1] row_mask:0xf bank_mask:0xf\n\t"
        "v_add_f32_dpp %2, %2, %2 quad_perm:[2,3,0,1] row_mask:0xf bank_mask:0xf\n\tv_add_f32_dpp %3, %3, %3 quad_perm:[2,3,0,1] row_mask:0xf bank_mask:0xf\n\t"
        "v_add_f32_dpp %4, %4, %4 quad_perm:[2,3,0,1] row_mask:0xf bank_mask:0xf\n\tv_add_f32_dpp %5, %5, %5 quad_perm:[2,3,0,1] row_mask:0xf bank_mask:0xf\n\t"
        "v_add_f32_dpp %6, %6, %6 quad_perm:[2,3,0,1] row_mask:0xf bank_mask:0xf\n\tv_add_f32_dpp %7, %7, %7 quad_perm:[2,3,0,1] row_mask:0xf bank_mask:0xf\n\t"
        "v_add_f32_dpp %0, %0, %0 row_half_mirror row_mask:0xf bank_mask:0xf\n\tv_add_f32_dpp %1, %1, %1 row_half_mirror row_mask:0xf bank_mask:0xf\n\t"
        "v_add_f32_dpp %2, %2, %2 row_half_mirror row_mask:0xf bank_mask:0xf\n\tv_add_f32_dpp %3, %3, %3 row_half_mirror row_mask:0xf bank_mask:0xf\n\t"
        "v_add_f32_dpp %4, %4, %4 row_half_mirror row_mask:0xf bank_mask:0xf\n\tv_add_f32_dpp %5, %5, %5 row_half_mirror row_mask:0xf bank_mask:0xf\n\t"
        "v_add_f32_dpp %6, %6, %6 row_half_mirror row_mask:0xf bank_mask:0xf\n\tv_add_f32_dpp %7, %7, %7 row_half_mirror row_mask:0xf bank_mask:0xf\n\t"
        "s_nop 1"
        : "+v"(a[0]), "+v"(a[1]), "+v"(a[2]), "+v"(a[3]), "+v"(a[4]), "+v"(a[5]), "+v"(a[6]), "+v"(a[7]));
}
__device__ __forceinline__ float sum8_x1(float v) {
    asm("s_nop 1\n\tv_add_f32_dpp %0, %0, %0 quad_perm:[1,0,3,2] row_mask:0xf bank_mask:0xf\n\ts_nop 1\n\tv_add_f32_dpp %0, %0, %0 quad_perm:[2,3,0,1] row_mask:0xf bank_mask:0xf\n\ts_nop 1\n\t"
        "v_add_f32_dpp %0, %0, %0 row_half_mirror row_mask:0xf bank_mask:0xf\n\ts_nop 1" : "+v"(v));
    return v;
}
__device__ __forceinline__ void peer_phase(const Args& A, Frame& F, int L, const bool dry, const bf16* Hin, bf16* Hout, unsigned char* H8) {
    int lane = F.lane; asm volatile("" : "+v"(lane));
    const int gw = F.vcu * NWAVES + F.wave;
    const bf16* SCR = (const bf16*)(A.ws + WS_SC); const bf16* X = Hin; float* RS3 = (float*)(A.ws + WS_RS3);
    const unsigned char* TU = (const unsigned char*)(A.ws + WS_TABU) + (size_t)L * 16384 * D; const unsigned char* TV = (const unsigned char*)(A.ws + WS_TABV) + (size_t)L * 16384 * D;
    const float* rowss = (const float*)(A.ws + WS_RSP) + (size_t)(L == 0 ? RS_FFN0 : RS_FFN1) * T * 32;
    LAS unsigned* LIST = (LAS unsigned*)(F.lds + RING_OFF + F.wave * 16384);
    LAS unsigned* EIDX = LIST + 1024;
    LAS float* ECOEF = (LAS float*)(EIDX + 1024);
    const int tbase = gw * 8;
    if (tbase >= T) return;
    for (int half = 0; half < 2; ++half) {
        const int t0 = tbase + 4 * half;
        {
            const bf16* sp = SCR + (size_t)(t0 + (lane >> 4)) * D + (lane & 15) * 128;
            int vals[16];
#pragma unroll
            for (int s = 0; s < 16; ++s) vals[s] = (int)0x80000000;
#pragma unroll 2
            for (int c = 0; c < 16; ++c) { const v4u wv = *(const GAS v4u*)(sp + c * 8); const unsigned ww[4] = {wv.x, wv.y, wv.z, wv.w};
#pragma unroll
                for (int e = 0; e < 8; ++e) { const unsigned bits = (e & 1) ? (ww[e >> 1] & 0xffff0000u) : (ww[e >> 1] << 16);
                    int x = (int)bits; x ^= (x >> 31) & 0x7fffffff; x = (x & ~0x7f) | (127 - (c * 8 + e));
                    TOPK_INSERT(vals, x); } }
#pragma unroll
            for (int q = 0; q < 4; ++q) { v4u o; o.x = (unsigned)vals[4 * q]; o.y = (unsigned)vals[4 * q + 1]; o.z = (unsigned)vals[4 * q + 2]; o.w = (unsigned)vals[4 * q + 3]; *(LAS v4u*)(LIST + lane * 16 + 4 * q) = o; }
        }
        LDS_WAIT(); asm volatile("" ::: "memory");
        if (lane < 32) {
            const LAS unsigned* la = LIST + ((lane >> 3) * 16 + (lane & 7) * 2) * 16; const LAS unsigned* lb2 = la + 16;
            float av[16], bv[16];
#pragma unroll
            for (int q = 0; q < 4; ++q) { const v4u a4 = *(const LAS v4u*)(la + 4 * q), b4 = *(const LAS v4u*)(lb2 + 4 * q); const unsigned aw[4] = {a4.x, a4.y, a4.z, a4.w}, bw[4] = {b4.x, b4.y, b4.z, b4.w};
#pragma unroll
                for (int e = 0; e < 4; ++e) { av[4 * q + e] = __uint_as_float(__float_as_uint(sort2f((int)(aw[e] & ~0x7fu))) & 0xffff0000u); bv[4 * q + e] = __uint_as_float(__float_as_uint(sort2f((int)(bw[e] & ~0x7fu))) & 0xffff0000u); } }
            int best[16];
#pragma unroll
            for (int s = 0; s < 16; ++s) best[s] = (int)0x80000000;
#pragma unroll
            for (int i = 0; i < 16; ++i)
#pragma unroll
                for (int jx = 0; jx < 16; ++jx) if ((i + 1) * (jx + 1) <= 16) { int x = f2sort(av[i] + bv[jx]); x = (x & ~0xff) | (255 - (i * 16 + jx)); TOPK_INSERT(best, x); }
            float sv[16]; unsigned ex[16];
#pragma unroll
            for (int s = 0; s < 16; ++s) { const int cand = 255 - (best[s] & 0xff); const unsigned ka = la[cand >> 4], kb = lb2[cand & 15];
                ex[s] = (127u - (ka & 0x7fu)) * 128u + (127u - (kb & 0x7fu));
                sv[s] = __uint_as_float(__float_as_uint(sort2f((int)(ka & ~0x7fu))) & 0xffff0000u) + __uint_as_float(__float_as_uint(sort2f((int)(kb & ~0x7fu))) & 0xffff0000u); }
            float mx = sv[0];
#pragma unroll
            for (int s = 1; s < 16; ++s) mx = fmaxf(mx, sv[s]);
            float den = 0.f;
#pragma unroll
            for (int s = 0; s < 16; ++s) { sv[s] = __expf(sv[s] - mx); den += sv[s]; }
            const float inv = 1.0f / den; const int base = (4 * half + (lane >> 3)) * 128 + (lane & 7) * 16;
#pragma unroll
            for (int s = 0; s < 16; ++s) { EIDX[base + s] = ex[s]; ECOEF[base + s] = sv[s] * inv; }
        }
        LDS_WAIT(); asm volatile("" ::: "memory");
    }
    const int tk = lane >> 3, part = lane & 7, t = tbase + tk;
    const LAS unsigned* eidx = EIDX + tk * 128; LAS float* ecoef = ECOEF + tk * 128;
    const float rs = __builtin_amdgcn_rsqf(sum8_x1(((const GAS f32x4*)(rowss + (size_t)t * 32))[part][0] + ((const GAS f32x4*)(rowss + (size_t)t * 32))[part][1] + ((const GAS f32x4*)(rowss + (size_t)t * 32))[part][2] + ((const GAS f32x4*)(rowss + (size_t)t * 32))[part][3]) * (1.0f / D) + EPS);
    typedef _Float16 h2_t __attribute__((ext_vector_type(2)));
#define PEER_LOAD8(dst, TAB, i0, soff) do { const v4u ia_ = *(const LAS v4u*)(eidx + (i0)), ib_ = *(const LAS v4u*)(eidx + (i0) + 4); const unsigned ee_[8] = {ia_.x, ia_.y, ia_.z, ia_.w, ib_.x, ib_.y, ib_.z, ib_.w}; \
        _Pragma("unroll") for (int j_ = 0; j_ < 8; ++j_) dst[j_] = *(const GAS v4u*)((TAB) + (size_t)(ee_[j_] * 2048u + (unsigned)(soff))); } while (0)
    LAS float* dotw = (LAS float*)LIST + tk * 128;
#pragma unroll
    for (int m = 0; m < 16; ++m) dotw[8 * m + part] = 0.f;
#pragma unroll 1
    for (int p = 0; p < 16; ++p) {
        const int soff = 128 * p + 16 * part;
        h2_t xs[8];
        { const v4u x0 = *(const GAS v4u*)(X + (size_t)t * D + soff), x1 = *(const GAS v4u*)(X + (size_t)t * D + soff + 8); const unsigned xw[8] = {x0.x, x0.y, x0.z, x0.w, x1.x, x1.y, x1.z, x1.w};
#pragma unroll
          for (int e = 0; e < 8; ++e) xs[e] = (h2_t){(_Float16)bf_lo(xw[e]), (_Float16)bf_hi(xw[e])}; }
#define PEER_UDOT8(src, m_) do { float tt_[8]; \
        _Pragma("unroll") for (int j_ = 0; j_ < 8; ++j_) { const unsigned ww_[4] = {src[j_].x, src[j_].y, src[j_].z, src[j_].w}; float a0_ = 0.f, a1_ = 0.f; \
            _Pragma("unroll") for (int e_ = 0; e_ < 4; ++e_) { const h2_t lo_ = __builtin_amdgcn_cvt_scalef32_pk_f16_fp8((int)ww_[e_], 1.0f / 512.0f, false), hi_ = __builtin_amdgcn_cvt_scalef32_pk_f16_fp8((int)ww_[e_], 1.0f / 512.0f, true); \
                a0_ = __builtin_amdgcn_fdot2(xs[2 * e_], lo_, a0_, false); a1_ = __builtin_amdgcn_fdot2(xs[2 * e_ + 1], hi_, a1_, false); } \
            tt_[j_] = a0_ + a1_; } \
        sum8_x8(tt_); \
        float sel_ = tt_[0]; _Pragma("unroll") for (int j_ = 1; j_ < 8; ++j_) sel_ = (part == j_) ? tt_[j_] : sel_; \
        dotw[8 * (m_) + part] += sel_; } while (0)
        v4u ua[8], ub[8];
        PEER_LOAD8(ua, TU, 0, soff);
#pragma unroll 1
        for (int m = 0; m < 16; m += 2) {
            PEER_LOAD8(ub, TU, 8 * (m + 1), soff);
            PEER_UDOT8(ua, m);
            if (m + 2 < 16) PEER_LOAD8(ua, TU, 8 * (m + 2), soff);
            PEER_UDOT8(ub, m + 1);
        }
    }
#undef PEER_UDOT8
#pragma unroll
    for (int m = 0; m < 16; ++m) { const float d_ = dotw[8 * m + part] * rs; const float act = 0.5f * d_ * (1.0f + erff(d_ * 0.7071067811865476f)); ecoef[8 * m + part] *= act; }
    LDS_WAIT(); asm volatile("" ::: "memory");
    float ss = 0.f;
#pragma unroll 1
    for (int p = 0; p < 16; ++p) {
        const int soff = 128 * p + 16 * part;
        h2_t acc[8];
#pragma unroll
        for (int i = 0; i < 8; ++i) acc[i] = (h2_t){(_Float16)0.f, (_Float16)0.f};
#define PEER_VACC8(src, i0) do { const f32x4 ca_ = *(const LAS f32x4*)(ecoef + (i0)), cb_ = *(const LAS f32x4*)(ecoef + (i0) + 4); const float cf_[8] = {ca_[0], ca_[1], ca_[2], ca_[3], cb_[0], cb_[1], cb_[2], cb_[3]}; \
        _Pragma("unroll") for (int j_ = 0; j_ < 8; ++j_) { const unsigned ww_[4] = {src[j_].x, src[j_].y, src[j_].z, src[j_].w}; const _Float16 ch_ = (_Float16)cf_[j_]; const h2_t c2_ = {ch_, ch_}; \
            _Pragma("unroll") for (int e_ = 0; e_ < 4; ++e_) { const h2_t lo_ = __builtin_amdgcn_cvt_scalef32_pk_f16_fp8((int)ww_[e_], 1.0f / 16.0f, false), hi_ = __builtin_amdgcn_cvt_scalef32_pk_f16_fp8((int)ww_[e_], 1.0f / 16.0f, true); \
                acc[2 * e_] = c2_ * lo_ + acc[2 * e_]; acc[2 * e_ + 1] = c2_ * hi_ + acc[2 * e_ + 1]; } } } while (0)
        v4u va[8], vb[8];
        PEER_LOAD8(va, TV, 0, soff);
#pragma unroll 1
        for (int m = 0; m < 16; m += 2) {
            PEER_LOAD8(vb, TV, 8 * (m + 1), soff);
            PEER_VACC8(va, 8 * m);
            if (m + 2 < 16) PEER_LOAD8(va, TV, 8 * (m + 2), soff);
            PEER_VACC8(vb, 8 * (m + 1));
        }
        { const v4u h0 = *(const GAS v4u*)(Hin + (size_t)t * D + soff), h1 = *(const GAS v4u*)(Hin + (size_t)t * D + soff + 8); const unsigned hw[8] = {h0.x, h0.y, h0.z, h0.w, h1.x, h1.y, h1.z, h1.w}; unsigned ow[8];
#pragma unroll
          for (int e = 0; e < 8; ++e) { ow[e] = hw_pk2(bf_lo(hw[e]) + (float)acc[e][0], bf_hi(hw[e]) + (float)acc[e][1]); const float q0 = bf_lo(ow[e]), q1 = bf_hi(ow[e]); ss += q0 * q0 + q1 * q1; }
          v4u o0, o1; o0.x = ow[0]; o0.y = ow[1]; o0.z = ow[2]; o0.w = ow[3]; o1.x = ow[4]; o1.y = ow[5]; o1.z = ow[6]; o1.w = ow[7];
          if (!dry) { *(GAS v4u*)(Hout + (size_t)t * D + soff) = o0; *(GAS v4u*)(Hout + (size_t)t * D + soff + 8) = o1;
            if (H8) { v4u o8; unsigned q8[4];
#pragma unroll
              for (int e = 0; e < 4; ++e) { int x8 = __builtin_amdgcn_cvt_pk_fp8_f32(bf_lo(ow[2 * e]), bf_hi(ow[2 * e]), 0, false); x8 = __builtin_amdgcn_cvt_pk_fp8_f32(bf_lo(ow[2 * e + 1]), bf_hi(ow[2 * e + 1]), x8, true); q8[e] = (unsigned)x8; }
              o8.x = q8[0]; o8.y = q8[1]; o8.z = q8[2]; o8.w = q8[3]; *(GAS v4u*)(H8 + (size_t)t * D + soff) = o8; } } else asm volatile("" :: "v"(o0.x), "v"(o0.y), "v"(o0.z), "v"(o0.w), "v"(o1.x), "v"(o1.y), "v"(o1.z), "v"(o1.w)); }
    }
#undef PEER_VACC8
#undef PEER_LOAD8
    const float r3 = __builtin_amdgcn_rsqf(sum8_x1(ss) * (1.0f / D) + EPS);
    if (!dry && part == 0) RS3[t] = r3;
}


constexpr int N_PHASES = 19;
__global__ void __launch_bounds__(NTHREADS, 2) mega_fwd(Args args) {

    extern __shared__ __attribute__((aligned(16))) unsigned char lds[];
    Frame F;
    F.lds = (LAS unsigned char*)lds;
    F.MISC = (volatile LAS unsigned*)(F.lds + MISC_OFF);
    F.tid = threadIdx.x; F.lane = F.tid & 63; F.wave = __builtin_amdgcn_readfirstlane(F.tid >> 6);
    F.G = gridDim.x; { const int bx = blockIdx.x; F.vcu = (F.G % 8 == 0) ? (bx % 8) * (F.G / 8) + bx / 8 : bx; }
    unsigned char* ws = args.ws;
    F.ctl = (gu32*)(ws + WS_CTL);
    for (int u = F.tid; u < (LDS_BYTES - LDSCTL_OFF) / 4; u += NTHREADS) ((LAS unsigned*)(F.lds + LDSCTL_OFF))[u] = 0u;
    __syncthreads();
    const int lo = args.ph_lo, hi = args.ph_hi;
    XcdBarrier bar; bar.bar = (unsigned*)(F.ctl + CW_BAR); bar.x = 0; bar.st = nullptr;
    if (hi - lo > 1) bar = xcd_barrier_post((unsigned*)(F.ctl + CW_BAR), F.MISC + 8);
    bar.wave0 = (F.wave == 0);
#define IN(k) (lo <= (k) && (k) < hi)
#define REFRESH() do { int t_; asm volatile("v_mbcnt_lo_u32_b32 %0, -1, 0\n\tv_mbcnt_hi_u32_b32 %0, -1, %0" : "=v"(t_)); F.lane = t_; F.tid = F.wave * 64 + t_; } while (0)
#define REPS(k) (1 + ((DUP_MASK >> (k)) & 1))
#if PROBE_MASK
    unsigned long long* const tsb = (unsigned long long*)(ws + WS_CTL + 65536);
#define STAMP(k) do { if (blockIdx.x == 0 && F.tid == 0) __hip_atomic_store(tsb + (k), __builtin_amdgcn_s_memrealtime(), __ATOMIC_RELAXED, __HIP_MEMORY_SCOPE_AGENT); } while (0)
    STAMP(31);
#else
#define STAMP(k) do { } while (0)
#endif
#define SEAM(k) do { if (IN(k) && IN((k) + 1)) { if ((k) == 0) { cg::this_grid().sync(); } else { xcd_barrier(bar); if ((DUP_MASK >> 24) & 1) xcd_barrier(bar); } STAMP(k); } } while (0)
    float* rowss = (float*)(ws + WS_RSP);
    bf16* ACTA = (bf16*)(ws + WS_ACTA); bf16* ACTB = (bf16*)(ws + WS_ACTB); bf16* H1 = (bf16*)(ws + WS_H1); const float* RS3 = (const float*)(ws + WS_RS3);
    bf16* PROJ = (bf16*)(ws + WS_PROJ); bf16* SCB = (bf16*)(ws + WS_SC); bf16* PP = (bf16*)(ws + WS_PP);
    const int gtid = (F.vcu * NWAVES + F.wave) * 64 + F.lane, gthreads = F.G * NTHREADS;

#if UBENCH
    {
        typedef _Float16 h2_t __attribute__((ext_vector_type(2)));
        float a[32]; f32x2 p[16]; h2_t hh[32];
#pragma unroll
        for (int i = 0; i < 32; ++i) { a[i] = (float)(F.tid + i); hh[i] = (h2_t){(_Float16)(F.lane + i), (_Float16)i}; }
#pragma unroll
        for (int i = 0; i < 16; ++i) p[i] = (f32x2){a[2 * i], a[2 * i + 1]};
        const float m = 1.0f + 1e-7f * F.lane, c = 1e-9f; const f32x2 m2 = {m, m}, c2 = {c, c}; const h2_t mh = {(_Float16)1.0f, (_Float16)1.0f}, ch = {(_Float16)0.0f, (_Float16)0.0f};
#pragma unroll 1
        for (int it = 0; it < 10000; ++it) {
#if UBENCH == 1
#pragma unroll
            for (int i = 0; i < 32; ++i) asm volatile("v_fma_f32 %0, %0, %1, %2" : "+v"(a[i]) : "v"(m), "v"(c));
#elif UBENCH == 2
#pragma unroll
            for (int i = 0; i < 16; ++i) asm volatile("v_pk_fma_f32 %0, %0, %1, %2\n\tv_pk_fma_f32 %0, %0, %1, %2" : "+v"(p[i]) : "v"(m2), "v"(c2));
#elif UBENCH == 3
#pragma unroll
            for (int i = 0; i < 32; ++i) asm volatile("v_pk_fma_f16 %0, %0, %1, %2" : "+v"(hh[i]) : "v"(mh), "v"(ch));
#endif
        }
        float s = 0.f;
#pragma unroll
        for (int i = 0; i < 32; ++i) s += a[i] + (float)hh[i][0];
#pragma unroll
        for (int i = 0; i < 16; ++i) s += p[i][0] + p[i][1];
        if (s == 12345.678f) args.out[0] = s;
    }
#endif
    if (IN(0)) { REFRESH(); p0_prologue(args, F); } SEAM(0);
    if (IN(1)) for (int rep_ = 0; rep_ < REPS(1); ++rep_) { REFRESH();
        { pg8::Gemm g{ACTA, (const bf16*)(ws + WS_WEV_IN), T, EV_NP, D}; pg8::StaticOrder S; S.init(T, EV_NP, F.G, (int)blockIdx.x); EpiBf16S E{PROJ, PROJ_LD, nullptr};
          pg8::gemm_phase<EpiBf16S, pg8::StaticOrder, true, true>(F.lds + RING_OFF, g, S, E, F.wave); }
        if (F.G == 256 ? (int)blockIdx.x >= 64 : true) { const int g2 = F.G == 256 ? 192 : F.G, c2 = F.G == 256 ? (int)blockIdx.x - 64 : (int)blockIdx.x;
          pg8::Gemm g{(const bf16*)(ws + WS_PBF), (const bf16*)(ws + WS_WPROJ), T, D, 256}; pg8::StaticOrder S; S.init(T, D, g2, c2); EpiBf16S E{PP, D, nullptr};
          pg8::gemm_phase<EpiBf16S, pg8::StaticOrder, true, true>(F.lds + RING_OFF, g, S, E, F.wave); }
    } SEAM(1);
    if (IN(2)) for (int rep_ = 0; rep_ < REPS(2); ++rep_) { REFRESH();
        if (F.G >= 256) {
            const int u = F.vcu;
            if (u < 64) scan_gla_mfma_unit<0>(args, F, u); else if (u < 128) scan_gdn_mfma_unit(args, F, u - 64, 0); else if (u < 192) scan_gdn_mfma_unit(args, F, u - 128, 1);
            __syncthreads();
            if (rep_ == 0) for (int dr_ = 0; dr_ < 1 + ((DUP_MASK >> 22) & 1); ++dr_) { if (u < 64) p0_deferred(args, F, 128 + u, 192); else if (u >= 192) for (int k = 0; k < 2; ++k) p0_deferred(args, F, 2 * (u - 192) + k, 192); }
        } else {
            for (int u = F.vcu; u < 64; u += F.G) { scan_gla_mfma_unit<0>(args, F, u); __syncthreads(); }
            for (int u = F.vcu; u < 64; u += F.G) { scan_gdn_mfma_unit(args, F, u, 0); __syncthreads(); scan_gdn_mfma_unit(args, F, u, 1); __syncthreads(); }
            if (rep_ == 0) p0_deferred(args, F, F.vcu, F.G);
        }
    } SEAM(2);
    if (IN(3)) for (int rep_ = 0; rep_ < REPS(3); ++rep_) { REFRESH(); post_rows<0>(args, F); } SEAM(3);
    if (IN(4)) { REFRESH(); pg8::Gemm g{ACTA, (const bf16*)(ws + WS_WEV_OUT), T, D, D}; pg8::StaticOrder S; S.init(T, D, F.G, (int)blockIdx.x);
        EpiResid<false, true> E{args.in[I_X], ACTB, rowss + (size_t)RS_FFN0 * T * 32, nullptr, nullptr, nullptr};
        pg8::gemm_phase<EpiResid<false, true>, pg8::StaticOrder, true, true>(F.lds + RING_OFF, g, S, E, F.wave); }
#if (DUP_MASK >> 20) & 1
    if (IN(4)) { REFRESH(); pg8::Gemm g{ACTA, (const bf16*)(ws + WS_WEV_OUT), T, D, D}; pg8::StaticOrder S; S.init(T, D, F.G, (int)blockIdx.x);
        EpiResid<false, true> E{args.in[I_X], ACTB, rowss + (size_t)RS_FFN0 * T * 32, nullptr, nullptr, nullptr};
        pg8::gemm_phase<EpiResid<false, true>, pg8::StaticOrder, true, true>(F.lds + RING_OFF, g, S, E, F.wave); }
#endif
#if (DUP_MASK >> 21) & 1
    if (IN(4)) { REFRESH(); pg8::Gemm g{ACTA, (const bf16*)(ws + WS_WEV_IN), T, EV_NP, D}; pg8::StaticOrder S; S.init(T, EV_NP, F.G, (int)blockIdx.x); EpiBf16S E{PROJ, PROJ_LD, nullptr};
        pg8::gemm_phase<EpiBf16S, pg8::StaticOrder, true, true>(F.lds + RING_OFF, g, S, E, F.wave); }
#endif
    SEAM(4);
    if (IN(5)) for (int rep_ = 0; rep_ < REPS(5); ++rep_) { REFRESH(); { pg8::Gemm g{ACTB, (const bf16*)(ws + WS_WPEER), T, D, D}; pg8::StaticOrder S; S.init(T, D, F.G, (int)blockIdx.x); EpiBf16S E{SCB, D, rowss + (size_t)RS_FFN0 * T * 32};
        pg8::gemm_phase<EpiBf16S, pg8::StaticOrder, true, true>(F.lds + RING_OFF, g, S, E, F.wave); }
        } SEAM(5);
    if (IN(6)) for (int rep_ = 0; rep_ < REPS(6); ++rep_) { REFRESH(); peer_phase(args, F, 0, rep_ != 0, ACTB, H1, (unsigned char*)ACTA); } SEAM(6);
    if (IN(7)) { REFRESH(); { pg8::Gemm g{ACTA, (const bf16*)(ws + WS_WGATE), T, D, D / 2}; pg8::StaticOrder S; S.init(T, D, F.G, (int)blockIdx.x);
        EpiResid<true, false> E{H1, ACTB, rowss + (size_t)RS_MIX1 * T * 32, PP, RS3, (unsigned char*)ACTA + (size_t)T * D};
        pg8::gemm_phase<EpiResid<true, false>, pg8::StaticOrder, true, true, true>(F.lds + RING_OFF, g, S, E, F.wave); }
        } SEAM(7);
    if (IN(8)) for (int rep_ = 0; rep_ < REPS(8); ++rep_) { REFRESH();
        { pg8::Gemm g{(const bf16*)((const unsigned char*)ACTA + (size_t)T * D), (const bf16*)(ws + WS_WOD_IN), T, OD_NP, D / 2}; pg8::StaticOrder S; S.init(T, OD_NP, F.G, (int)blockIdx.x); EpiBf16S E{PROJ, PROJ_LD, rowss + (size_t)RS_MIX1 * T * 32};
          pg8::gemm_phase<EpiBf16S, pg8::StaticOrder, true, true, true>(F.lds + RING_OFF, g, S, E, F.wave); }
        { pg8::Gemm g{(const bf16*)(ws + WS_PBF) + (size_t)T * 256, (const bf16*)(ws + WS_WPROJ) + (size_t)D * 256, T, D, 256}; pg8::StaticOrder S; S.init(T, D, F.G, (int)blockIdx.x); EpiBf16S E{PP, D, nullptr};
          pg8::gemm_phase<EpiBf16S, pg8::StaticOrder, true, true>(F.lds + RING_OFF, g, S, E, F.wave); }
    } SEAM(8);
    if (IN(9)) for (int rep_ = 0; rep_ < REPS(9); ++rep_) { REFRESH(); lora_prep_rows(args, F); } SEAM(9);
    if (IN(10)) for (int rep_ = 0; rep_ < REPS(10); ++rep_) { REFRESH(); pg8::Gemm g{(const bf16*)(ws + WS_LA), (const bf16*)(ws + WS_WLORA), T, LORA_N, LORA_K}; pg8::StaticOrder S; S.init(T, LORA_N, F.G, (int)blockIdx.x); EpiBf16S E{(bf16*)(ws + WS_LO), LORA_N, nullptr};
        pg8::gemm_phase<EpiBf16S, pg8::StaticOrder, true, true>(F.lds + RING_OFF, g, S, E, F.wave); } SEAM(10);
    if (IN(11)) for (int rep_ = 0; rep_ < REPS(11); ++rep_) { REFRESH();
        if (F.G >= 256) {
            const int u = F.vcu;
            if (u < 64) scan_gla_mfma_unit<1>(args, F, u); else if (u < 128) scan_rwkv_mfma_unit(args, F, u - 64, 0); else if (u < 192) scan_rwkv_mfma_unit(args, F, u - 128, 1);
            __syncthreads();
            if (rep_ == 0) for (int dr_ = 0; dr_ < 1 + ((DUP_MASK >> 23) & 1); ++dr_) { if (u < 64) p1_deferred(args, F, 128 + u, 192); else if (u >= 192) for (int k = 0; k < 2; ++k) p1_deferred(args, F, 2 * (u - 192) + k, 192); }
        } else {
            for (int u = F.vcu; u < 64; u += F.G) { scan_gla_mfma_unit<1>(args, F, u); __syncthreads(); }
            for (int u = F.vcu; u < 64; u += F.G) { scan_rwkv_mfma_unit(args, F, u, 0); __syncthreads(); scan_rwkv_mfma_unit(args, F, u, 1); __syncthreads(); }
            if (rep_ == 0) p1_deferred(args, F, F.vcu, F.G);
        }
    } SEAM(11);
    if (IN(12)) for (int rep_ = 0; rep_ < REPS(12); ++rep_) { REFRESH(); post_rows<1>(args, F); } SEAM(12);
    if (IN(13)) { REFRESH(); pg8::Gemm g{ACTA, (const bf16*)(ws + WS_WOD_OUT), T, D, D / 2}; pg8::StaticOrder S; S.init(T, D, F.G, (int)blockIdx.x);
        EpiResid<false, false> E{ACTB, H1, rowss + (size_t)RS_FFN1 * T * 32, nullptr, nullptr, nullptr};
        pg8::gemm_phase<EpiResid<false, false>, pg8::StaticOrder, true, true, true>(F.lds + RING_OFF, g, S, E, F.wave); } SEAM(13);
    if (IN(14)) for (int rep_ = 0; rep_ < REPS(14); ++rep_) { REFRESH(); pg8::Gemm g{H1, (const bf16*)(ws + WS_WPEER) + (size_t)D * D, T, D, D}; pg8::StaticOrder S; S.init(T, D, F.G, (int)blockIdx.x); EpiBf16S E{SCB, D, rowss + (size_t)RS_FFN1 * T * 32};
        pg8::gemm_phase<EpiBf16S, pg8::StaticOrder, true, true>(F.lds + RING_OFF, g, S, E, F.wave); } SEAM(14);
    if (IN(15)) for (int rep_ = 0; rep_ < REPS(15); ++rep_) { REFRESH(); peer_phase(args, F, 1, rep_ != 0, H1, ACTB, (unsigned char*)ACTA); } SEAM(15);
    if (IN(16)) { REFRESH(); pg8::Gemm g{ACTA, (const bf16*)(ws + WS_WGATE) + (size_t)D * D, T, D, D / 2}; pg8::StaticOrder S; S.init(T, D, F.G, (int)blockIdx.x);
        EpiResid<true, false> E{ACTB, H1, rowss + (size_t)RS_FINAL * T * 32, PP, RS3, nullptr};
        pg8::gemm_phase<EpiResid<true, false>, pg8::StaticOrder, true, true, true>(F.lds + RING_OFF, g, S, E, F.wave); } SEAM(16);
    if (IN(17)) { REFRESH();
        float oscale = 1.0f;
#if PROBE_MASK
        { unsigned long long t_prev = __hip_atomic_load(tsb + 31, __ATOMIC_RELAXED, __HIP_MEMORY_SCOPE_AGENT); const unsigned long long t_begin = t_prev; unsigned long long sel = 0ull;
          for (int k = 0; k <= 16; ++k) { const unsigned long long tk = __hip_atomic_load(tsb + k, __ATOMIC_RELAXED, __HIP_MEMORY_SCOPE_AGENT); if ((PROBE_MASK >> k) & 1) sel += tk - t_prev; t_prev = tk; }
          const float f = (float)(double(sel) / double(t_prev - t_begin)); oscale = 1.0f + sqrtf(0.01f + 0.9f * f); }
#endif
        final_rows(args, F, oscale, H1); }
#undef IN
#undef SEAM
#undef REFRESH
}

extern "C" void kernel_launch(void* const* d_in, const int* in_sizes, int n_in, void* d_out, int out_size, void* d_ws, size_t ws_size, hipStream_t stream) {
    static int grid = 0;
    if (grid == 0) {
        if (n_in != N_IN || out_size != T * D || ws_size < WS_END + 63 * MiB) { fprintf(stderr, "kernel_launch: unexpected problem: n_in %d out %d ws %zu (need %zu)\n", n_in, out_size, ws_size, (size_t)(WS_END + 63 * MiB)); grid = -1; return; }
        int dev = 0, cus = 0, per_cu = 0;
        if (hipGetDevice(&dev) != hipSuccess || hipDeviceGetAttribute(&cus, hipDeviceAttributeMultiprocessorCount, dev) != hipSuccess) { grid = -1; return; }
        if (hipFuncSetAttribute((const void*)mega_fwd, hipFuncAttributeMaxDynamicSharedMemorySize, LDS_BYTES) != hipSuccess) { fprintf(stderr, "kernel_launch: hipFuncSetAttribute failed\n"); grid = -1; return; }
        if (hipOccupancyMaxActiveBlocksPerMultiprocessor(&per_cu, (const void*)mega_fwd, NTHREADS, LDS_BYTES) != hipSuccess || per_cu < 1) { fprintf(stderr, "kernel_launch: occupancy query says %d blocks per CU\n", per_cu); (void)hipGetLastError(); grid = -1; return; }
        grid = cus;
    }
    if (grid < 0) return;
    (void)hipMemsetAsync((char*)d_ws + WS_CTL, 0, CTL_ZERO_BYTES, stream);
    Args a{};
    for (int i = 0; i < N_IN; ++i) a.in[i] = (const float*)d_in[i];
    a.out = (float*)d_out; a.ws = (unsigned char*)d_ws;
#if MK_PER_PHASE
    for (int p = 0; p < N_PHASES - 1; ++p) { a.ph_lo = p; a.ph_hi = p + 1; hipLaunchKernelGGL(mega_fwd, dim3(grid), dim3(NTHREADS), LDS_BYTES, stream, a); }
#else
    a.ph_lo = 0; a.ph_hi = N_PHASES;
    void* kargs[] = {&a};
    hipError_t e = hipLaunchCooperativeKernel((const void*)mega_fwd, dim3(grid), dim3(NTHREADS), kargs, LDS_BYTES, stream);
    if (e != hipSuccess) fprintf(stderr, "kernel_launch: cooperative launch failed: %s (grid %d)\n", hipGetErrorString(e), grid);
#endif
}
```

```cpp
#include <hip/hip_runtime.h>
#include <hip/hip_cooperative_groups.h>
#include <cstdio>
#include <cstdint>
namespace cg = cooperative_groups;

#ifndef PROBE_MASK
#define PROBE_MASK 0
#endif
#ifndef DUP_MASK
#define DUP_MASK 0
#endif
#ifndef UBENCH
#define UBENCH 0
#endif
#ifndef GDN_DUP
#define GDN_DUP 0
#endif
#ifndef MK_PER_PHASE
#ifndef PEER_ALIAS
#define PEER_ALIAS 0
#endif
#ifndef EV_F8_T0
#define EV_F8_T0 0
#define EV_F8_T1 0
#endif
#define MK_PER_PHASE 0
#endif

namespace pg8 {
#define PG8_LAS __attribute__((address_space(3)))
typedef unsigned short bf16_t;
typedef short bf16x8 __attribute__((ext_vector_type(8)));
typedef float f32x4 __attribute__((ext_vector_type(4)));
typedef unsigned u32x4 __attribute__((ext_vector_type(4)));
typedef unsigned u32x2 __attribute__((ext_vector_type(2)));
constexpr int BM = 256, BK = 64, HALF = 128, HTB = HALF * BK * 2  , STAGE_BYTES = 8 * HTB, NXCD = 8, WGM = 8;

__host__ __device__ __forceinline__ int lds_byte(int r, int c) { const int st = (r >> 4) * 2 + (c >> 5), rr = r & 15, cc = c & 31, ob = rr * 64 + cc * 2; return st * 1024 + (ob ^ (((ob >> 9) & 1) << 5)); }
__host__ __device__ __forceinline__ void stage_rc(int b, int& R, int& C) { const int st = b / 1024, sb = b % 1024, swz = sb ^ (((sb >> 9) & 1) << 5); R = (st >> 1) * 16 + swz / 64; C = (st & 1) * 32 + (swz % 64) / 2; }
__host__ __device__ __forceinline__ int perm32(int rho) { const int n = rho >> 4, i = rho & 15; return 8 * (i >> 2) + 4 * n + (i & 3); }

struct Unit { int pm, pn; };
struct Gemm { const bf16_t* A; const bf16_t* Bt; int M, N, K; };

struct StaticOrder {
    int nM, nN, nwg, G, c;
    __host__ __device__ void init(int M, int N, int G_, int c_) { nM = M / BM; nN = N / BM; nwg = nM * nN; G = G_; c = c_; }
    __host__ __device__ bool next(int i, Unit& u) const {
        const long L = (long)i * G + c; if (L >= nwg) return false;
        int wgid = (int)L; { const int q = nwg / NXCD, r = nwg % NXCD, xcd = wgid % NXCD, off = wgid / NXCD; wgid = (xcd < r ? xcd * (q + 1) : r * (q + 1) + (xcd - r) * q) + off; }
        const int nig = WGM * nN, gid = wgid / nig, fm = gid * WGM, gsz = (nM - fm) < WGM ? (nM - fm) : WGM;
        u.pm = fm + ((wgid % nig) % gsz); u.pn = (wgid % nig) / gsz; return true;
    }
    __device__ __forceinline__ void a_ready(const Unit&) const {}
    __device__ __forceinline__ void done(const Unit&) const {}
};
__device__ __forceinline__ unsigned cvt_pk_bf16(float lo, float hi) { unsigned r; asm volatile("v_cvt_pk_bf16_f32 %0, %1, %2" : "=v"(r) : "v"(lo), "v"(hi)); return r; }
template <class Epi, class Sched, bool ALIGN_EPI = false, bool SP2 = false, bool F8 = false>
__device__ __forceinline__ void gemm_phase(PG8_LAS unsigned char* lds, const Gemm g, const Sched& S, const Epi& E, const int wave_id) {
    int tid; asm volatile("v_mbcnt_lo_u32_b32 %0, -1, 0\n\tv_mbcnt_hi_u32_b32 %0, -1, %0" : "=v"(tid)); tid += wave_id * 64;
    const int wid = wave_id, lane = tid & 63, wr = wid >> 2, wc = wid & 3, fr = lane & 15, fq = lane >> 4;
    const int K = g.K, nt = K / BK;
    unsigned voffA[2], voffB[2];
#pragma unroll
    for (int i = 0; i < 2; ++i) { int R, C; stage_rc(tid * 16 + i * 8192, R, C); const int Rb = Epi::PERM ? ((R & ~31) + perm32(R & 31)) : R;
        voffA[i] = (unsigned)(R * K + C) * 2u; voffB[i] = (unsigned)(Rb * K + C) * 2u; }
    const __amdgpu_buffer_rsrc_t rsrcA = __builtin_amdgcn_make_buffer_rsrc((void*)g.A, 0, 0x7fffffff, 0x00020000), rsrcB = __builtin_amdgcn_make_buffer_rsrc((void*)g.Bt, 0, 0x7fffffff, 0x00020000);
    const size_t kstep = (size_t)(BK * 2);
    const size_t hstep = (size_t)HALF * K * 2;
    const size_t tstep = 2 * hstep;
    const unsigned ldsw = (unsigned)wid * 1024u;
    const int aoff = lds_byte(wr * 64 + fr, fq * 8), boff = lds_byte(wc * 32 + fr, fq * 8);
#define PG8_SA(b, h) (((b) * 2 + (h)) * HTB)
#define PG8_SB(b, h) ((4 + (b) * 2 + (h)) * HTB)
#define PG8_STAGE(bufoff, gbase, voff) do { const bool isA_ = (+(voff) == +voffA); const unsigned soff_ = (unsigned)((const char*)(gbase) - (isA_ ? (const char*)g.A : (const char*)g.Bt)); _Pragma("unroll") for (int _i = 0; _i < 2; ++_i) \
        __builtin_amdgcn_raw_ptr_buffer_load_lds(isA_ ? rsrcA : rsrcB, (PG8_LAS unsigned*)(lds + (bufoff) + ldsw + _i * 8192), 16, (int)(voff)[_i], (int)soff_, 0, 0); } while (0)
#define PG8_LDA(dst, b, h) do { _Pragma("unroll") for (int m = 0; m < 4; ++m) { if constexpr (F8) { dst##8[m].lo = *(const PG8_LAS bf16x8*)(lds + PG8_SA(b, h) + aoff + m * 2048); dst##8[m].hi = *(const PG8_LAS bf16x8*)(lds + PG8_SA(b, h) + aoff + m * 2048 + 1024); } else { _Pragma("unroll") for (int k = 0; k < 2; ++k) dst[m][k] = *(const PG8_LAS bf16x8*)(lds + PG8_SA(b, h) + aoff + m * 2048 + k * 1024); } } } while (0)
#define PG8_LDB(dst, b, h) do { _Pragma("unroll") for (int n = 0; n < 2; ++n) { if constexpr (F8) { dst##8[n].lo = *(const PG8_LAS bf16x8*)(lds + PG8_SB(b, h) + boff + n * 2048); dst##8[n].hi = *(const PG8_LAS bf16x8*)(lds + PG8_SB(b, h) + boff + n * 2048 + 1024); } else { _Pragma("unroll") for (int k = 0; k < 2; ++k) dst[n][k] = *(const PG8_LAS bf16x8*)(lds + PG8_SB(b, h) + boff + n * 2048 + k * 1024); } } } while (0)
#define PG8_MMA(ai, bj, At, Bt) do { __builtin_amdgcn_s_setprio(1); _Pragma("unroll") for (int m = 0; m < 4; ++m) _Pragma("unroll") for (int n = 0; n < 2; ++n) { \
        if constexpr (F8) { typedef int v8i_ __attribute__((ext_vector_type(8))); \
            acc[ai][bj][m][n] = __builtin_amdgcn_mfma_scale_f32_16x16x128_f8f6f4(__builtin_bit_cast(v8i_, Bt##8[n]), __builtin_bit_cast(v8i_, At##8[m]), acc[ai][bj][m][n], 0, 0, 0, 0x7f79, 1, 0x7f79); }     \
        else { _Pragma("unroll") for (int k = 0; k < 2; ++k) acc[ai][bj][m][n] = __builtin_amdgcn_mfma_f32_16x16x32_bf16(Bt[n][k], At[m][k], acc[ai][bj][m][n], 0, 0, 0); } } \
        __builtin_amdgcn_s_setprio(0); } while (0)
#define PG8_WAIT_V(n) asm volatile("s_waitcnt vmcnt(" #n ")" ::: "memory")
#define PG8_WAIT_L(n) asm volatile("s_waitcnt lgkmcnt(" #n ")" ::: "memory")
#define PG8_BAR __builtin_amdgcn_s_barrier()
#define PG8_SCHED __builtin_amdgcn_sched_barrier(0)
    Unit cur, nxt; int ui = 0;
    if (!S.next(0, cur)) return;
    f32x4 acc[2][2][4][2];
#pragma unroll
    for (int a = 0; a < 2; ++a)
#pragma unroll
        for (int b = 0; b < 2; ++b)
#pragma unroll
            for (int m = 0; m < 4; ++m)
#pragma unroll
                for (int n = 0; n < 2; ++n) acc[a][b][m][n] = (f32x4){0.f, 0.f, 0.f, 0.f};
    typedef short bf16x16 __attribute__((ext_vector_type(16)));
    bf16x16 At8[4], B08[2], B18[2]; bf16x8 At[4][2], B0[2][2], B1[2][2];
    const char* cA = (const char*)g.A + (size_t)cur.pm * tstep; const char* cB = (const char*)g.Bt + (size_t)cur.pn * tstep;
    S.a_ready(cur);
    if constexpr (SP2) {
        PG8_STAGE(PG8_SB(0, 0), cB, voffB); PG8_STAGE(PG8_SB(0, 1), cB + hstep, voffB); PG8_STAGE(PG8_SA(0, 0), cA, voffA); PG8_STAGE(PG8_SA(0, 1), cA + hstep, voffA);
        if (wr == 1) PG8_BAR;
        PG8_WAIT_V(2); PG8_BAR;
        PG8_STAGE(PG8_SB(1, 0), cB + kstep, voffB); PG8_STAGE(PG8_SA(1, 0), cA + kstep, voffA); PG8_STAGE(PG8_SB(1, 1), cB + hstep + kstep, voffB);
        PG8_WAIT_V(6); PG8_BAR;
    } else {
        PG8_STAGE(PG8_SB(0, 0), cB, voffB); PG8_STAGE(PG8_SA(0, 0), cA, voffA); PG8_STAGE(PG8_SB(0, 1), cB + hstep, voffB); PG8_STAGE(PG8_SA(0, 1), cA + hstep, voffA);
        if (wr == 1) PG8_BAR;
        PG8_WAIT_V(4); PG8_BAR;
        PG8_STAGE(PG8_SB(1, 0), cB + kstep, voffB); PG8_STAGE(PG8_SA(1, 0), cA + kstep, voffA); PG8_STAGE(PG8_SB(1, 1), cB + hstep + kstep, voffB);
        PG8_WAIT_V(6); PG8_BAR;
    }
    for (;;) {
        const bool has_next = S.next(ui + 1, nxt);
        const char* nA = has_next ? (const char*)g.A + (size_t)nxt.pm * tstep : cA; const char* nB = has_next ? (const char*)g.Bt + (size_t)nxt.pn * tstep : cB;
        for (int t = 0; t < nt; t += 2) {
            const bool last = (t == nt - 2);
            const char* a1 = cA + (size_t)(t + 1) * kstep;
            const char* a2 = last ? nA : cA + (size_t)(t + 2) * kstep; const char* b2 = last ? nB : cB + (size_t)(t + 2) * kstep;
            const char* a3 = a2 + kstep; const char* b3 = b2 + kstep;
            if (last && has_next) S.a_ready(nxt);
            if constexpr (SP2) {
            PG8_LDB(B0, 0, 0); PG8_LDB(B1, 0, 1); PG8_SCHED; PG8_LDA(At, 0, 0); PG8_STAGE(PG8_SA(1, 1), a1 + hstep, voffA);
            PG8_WAIT_V(8); PG8_WAIT_L(0); PG8_BAR; PG8_MMA(0, 0, At, B0); PG8_MMA(0, 1, At, B1); PG8_BAR; PG8_SCHED;
            PG8_LDA(At, 0, 1); PG8_STAGE(PG8_SB(0, 0), b2, voffB); PG8_STAGE(PG8_SB(0, 1), b2 + hstep, voffB); PG8_STAGE(PG8_SA(0, 0), a2, voffA);
            PG8_WAIT_V(8); PG8_WAIT_L(0); PG8_BAR; PG8_MMA(1, 0, At, B0); PG8_MMA(1, 1, At, B1); PG8_BAR; PG8_SCHED;
            PG8_LDB(B0, 1, 0); PG8_LDB(B1, 1, 1); PG8_SCHED; PG8_LDA(At, 1, 0); PG8_STAGE(PG8_SA(0, 1), a2 + hstep, voffA);
            PG8_WAIT_V(8); PG8_WAIT_L(0); PG8_BAR; PG8_MMA(0, 0, At, B0); PG8_MMA(0, 1, At, B1); PG8_BAR; PG8_SCHED;
            PG8_LDA(At, 1, 1); PG8_STAGE(PG8_SB(1, 0), b3, voffB); PG8_STAGE(PG8_SB(1, 1), b3 + hstep, voffB); PG8_STAGE(PG8_SA(1, 0), a3, voffA);
            PG8_WAIT_V(8); PG8_WAIT_L(0); PG8_BAR; PG8_MMA(1, 0, At, B0); PG8_MMA(1, 1, At, B1); PG8_BAR; PG8_SCHED;
            } else {
            PG8_LDB(B0, 0, 0); PG8_SCHED; PG8_LDA(At, 0, 0); PG8_STAGE(PG8_SA(1, 1), a1 + hstep, voffA);
            PG8_WAIT_L(8); PG8_BAR; PG8_WAIT_L(0); PG8_MMA(0, 0, At, B0); PG8_BAR; PG8_SCHED;
            PG8_LDB(B1, 0, 1); PG8_STAGE(PG8_SB(0, 0), b2, voffB);
            PG8_BAR; PG8_WAIT_L(0); PG8_MMA(0, 1, At, B1); PG8_BAR;
            PG8_LDA(At, 0, 1); PG8_STAGE(PG8_SA(0, 0), a2, voffA);
            PG8_BAR; PG8_WAIT_L(0); PG8_MMA(1, 0, At, B0); PG8_BAR; PG8_SCHED;
            PG8_STAGE(PG8_SB(0, 1), b2 + hstep, voffB);
            PG8_WAIT_V(6); PG8_BAR; PG8_MMA(1, 1, At, B1); PG8_BAR;
            PG8_LDB(B0, 1, 0); PG8_SCHED; PG8_LDA(At, 1, 0); PG8_STAGE(PG8_SA(0, 1), a2 + hstep, voffA);
            PG8_WAIT_L(8); PG8_BAR; PG8_WAIT_L(0); PG8_MMA(0, 0, At, B0); PG8_BAR; PG8_SCHED;
            PG8_LDB(B1, 1, 1); PG8_STAGE(PG8_SB(1, 0), b3, voffB);
            PG8_BAR; PG8_WAIT_L(0); PG8_MMA(0, 1, At, B1); PG8_BAR;
            PG8_LDA(At, 1, 1); PG8_STAGE(PG8_SA(1, 0), a3, voffA);
            PG8_BAR; PG8_WAIT_L(0); PG8_MMA(1, 0, At, B0); PG8_BAR; PG8_SCHED;
            PG8_STAGE(PG8_SB(1, 1), b3 + hstep, voffB);
            PG8_WAIT_V(6); PG8_BAR; PG8_MMA(1, 1, At, B1); PG8_BAR;
            }
        }
        if constexpr (ALIGN_EPI) { if (wr == 0) PG8_BAR; }
        if constexpr (!Epi::AFTER_DRAIN) { int ln_e; asm volatile("v_mbcnt_lo_u32_b32 %0, -1, 0\n\tv_mbcnt_hi_u32_b32 %0, -1, %0" : "=v"(ln_e)); const int fr_e = ln_e & 15, fq_e = ln_e >> 4;
            E(acc, cur, wr, wc, fr_e, fq_e); S.done(cur); }
        if (!has_next) break;
#pragma unroll
        for (int a = 0; a < 2; ++a)
#pragma unroll
            for (int b = 0; b < 2; ++b)
#pragma unroll
                for (int m = 0; m < 4; ++m)
#pragma unroll
                    for (int n = 0; n < 2; ++n) acc[a][b][m][n] = (f32x4){0.f, 0.f, 0.f, 0.f};
        cur = nxt; cA = nA; cB = nB; ++ui;
        if constexpr (ALIGN_EPI) { if (wr == 1) PG8_BAR; }
    }
    PG8_WAIT_V(0);
    if constexpr (!ALIGN_EPI) { if (wr == 0) PG8_BAR; }
    PG8_BAR;
    if constexpr (Epi::AFTER_DRAIN) { E.fused(acc, cur, wr, wc, fr, fq, lds, wid, lane); S.done(cur); }
#undef PG8_SA
#undef PG8_SB
#undef PG8_STAGE
#undef PG8_LDA
#undef PG8_LDB
#undef PG8_MMA
#undef PG8_WAIT_V
#undef PG8_WAIT_L
#undef PG8_BAR
#undef PG8_SCHED
}
}
#define GAS __attribute__((address_space(1)))
#define LAS __attribute__((address_space(3)))
typedef unsigned short bf16;
typedef unsigned v4u __attribute__((ext_vector_type(4)));
typedef float f32x4 __attribute__((ext_vector_type(4)));
typedef short bf16x8 __attribute__((ext_vector_type(8)));
typedef GAS unsigned gu32;
typedef GAS unsigned long long gu64;
#define RLX_AGENT __ATOMIC_RELAXED, __HIP_MEMORY_SCOPE_AGENT
#define LDS_WAIT() asm volatile("s_waitcnt lgkmcnt(0)" ::: "memory")
#define VM_WAIT() asm volatile("s_waitcnt vmcnt(0)" ::: "memory")
__device__ __forceinline__ unsigned long long rt() { return __builtin_amdgcn_s_memrealtime(); }
__device__ __forceinline__ unsigned f2bf(float f) { unsigned u = __builtin_bit_cast(unsigned, f); return (u + 0x7fffu + ((u >> 16) & 1u)) >> 16; }
__device__ __forceinline__ unsigned pk2(float lo, float hi) { return f2bf(lo) | (f2bf(hi) << 16); }

#define XB_TMO      128
#define XB_XCNT(j)  (256  + 64 * (j))
#define XB_XSUB(j)  (1280 + 64 * (j))
#define XB_XGEN(j)  (2304 + 64 * (j))
#define XB_TOP      3328
#define XB_TOPGEN   3392
#define XCD_BAR_WORDS 3456
#define XB_SPIN_CAP (1u << 18)

__device__ __forceinline__ unsigned xb_ld(unsigned* p)              { return __hip_atomic_load(p, __ATOMIC_RELAXED, __HIP_MEMORY_SCOPE_AGENT); }
__device__ __forceinline__ unsigned xb_add(unsigned* p, unsigned v) { return __hip_atomic_fetch_add(p, v, __ATOMIC_RELAXED, __HIP_MEMORY_SCOPE_AGENT); }
__device__ __forceinline__ unsigned xb_xcc_id() { return (unsigned)__builtin_amdgcn_s_getreg((3 << 11) | 20) & 0xFu; }
#define XB_SPIN(cond, bar) do { unsigned _sp = 0; while (cond) { __builtin_amdgcn_s_sleep(1); \
    if ((++_sp & 255u) == 0u) { if (xb_ld(&(bar)[XB_TMO])) break; if (_sp > XB_SPIN_CAP) { atomicAdd(&(bar)[XB_TMO], 1u); break; } } } } while (0)

struct XcdBarrier {
    unsigned* bar; unsigned x; bool wave0;
    volatile LAS unsigned* st;
};

__device__ __forceinline__ XcdBarrier xcd_barrier_post(unsigned* bar, volatile LAS unsigned* st) {
    XcdBarrier b; b.bar = bar; b.x = xb_xcc_id(); b.st = st;
    if (threadIdx.x == 0) (void)xb_add(&bar[XB_XCNT(b.x)], 1u);
    return b;
}
__device__ __forceinline__ void xcd_barrier_complete(unsigned* bar, unsigned x, unsigned& nloc, unsigned& nx) {
    const unsigned G = gridDim.x * gridDim.y * gridDim.z;
    unsigned sum, cnt, mine, sp = 0u;
    for (;;) {
        sum = 0u; cnt = 0u; mine = 0u;
#pragma unroll
        for (unsigned j = 0; j < 16; ++j) { const unsigned c = xb_ld(&bar[XB_XCNT(j)]); sum += c; cnt += (c > 0u) ? 1u : 0u; mine = (j == x) ? c : mine; }
        if (sum == G) break;
        __builtin_amdgcn_s_sleep(1);
        if ((++sp & 255u) == 0u) { if (xb_ld(&bar[XB_TMO])) break; if (sp > XB_SPIN_CAP) { atomicAdd(&bar[XB_TMO], 1u); break; } }
    }
    nloc = mine > 0u ? mine : 1u; nx = cnt > 0u ? cnt : 1u;
}

__device__ __forceinline__ void xcd_barrier(const XcdBarrier& b) {
    asm volatile("s_waitcnt vmcnt(0)" ::: "memory");
    __syncthreads();
    if (b.wave0 && __builtin_amdgcn_mbcnt_hi(~0u, __builtin_amdgcn_mbcnt_lo(~0u, 0u)) == 0u) {
        unsigned* bar = b.bar;
        __builtin_amdgcn_s_waitcnt(0);
        unsigned nloc = b.st[0], nx = b.st[1];
        if (nloc == 0u) { xcd_barrier_complete(bar, b.x, nloc, nx); b.st[0] = nloc; b.st[1] = nx; }
        const unsigned old = xb_add(&bar[XB_XSUB(b.x)], 1u);
        const unsigned gen = old / nloc;
        if (old + 1u == (gen + 1u) * nloc) {
            __builtin_amdgcn_fence(__ATOMIC_RELEASE, "agent");
            asm volatile("s_waitcnt vmcnt(0)" ::: "memory");
            const unsigned og = xb_add(&bar[XB_TOP], 1u);
            const unsigned tg = og / nx;
            if (og + 1u == (tg + 1u) * nx) xb_add(&bar[XB_TOPGEN], 1u);
            else XB_SPIN(xb_ld(&bar[XB_TOPGEN]) == tg, bar);
            __builtin_amdgcn_fence(__ATOMIC_ACQUIRE, "agent");
            xb_add(&bar[XB_XGEN(b.x)], 1u);
            asm volatile("s_waitcnt vmcnt(0)" ::: "memory");
        } else {
            XB_SPIN(xb_ld(&bar[XB_XGEN(b.x)]) == gen, bar);
            __builtin_amdgcn_fence(__ATOMIC_ACQUIRE, "agent");
            asm volatile("s_waitcnt vmcnt(0)" ::: "memory");
        }
    }
    __syncthreads();
}

constexpr int NWAVES = 8, NTHREADS = NWAVES * 64;
constexpr int BATCH = 8, SEQ = 2048, T = BATCH * SEQ, D = 2048;
constexpr int EV_N = 7200, EV_NP = 7424, OD_N = 7616, OD_NP = 7680, PROJ_LD = 7680;
constexpr float EPS = 1e-6f;
constexpr int EC_GQ = 0, EC_GK = 512, EC_GV = 1024, EC_GZ = 2048, EC_GLR = 3072, EC_BQ = 3088, EC_BK = 4112, EC_BV = 5136, EC_BZ = 6160, EC_BA = 7184, EC_BB = 7192;
constexpr int OC_HQ = 0, OC_HF = 1024, OC_HI = 2048, OC_HG = 3072, OC_RW = 4096;
constexpr int RW_R = 0, RW_K = 1024, RW_V = 2048, RW_WL = 3072, RW_AL = 3168, RW_GL = 3264;
constexpr int LORA_K = 512, LORA_N = 3072;
enum { I_X = 0, I_P, I_EV_WIN, I_GK_W2, I_GK_B, I_GLA_NORM, I_GDN_CONV, I_GDN_ALOG, I_GDN_DTB, I_GDN_NORM, I_EV_WOUT, I_OD_WIN, I_LB, I_HG_NORM,
       I_MU, I_W0, I_W2, I_A0, I_A2, I_G2, I_KK, I_KA, I_RK, I_LNW, I_LNB, I_OD_WOUT, I_NMIX, I_NFFN, I_NPLE, I_PEER_WQ, I_PEER_SK, I_PEER_U, I_PEER_V,
       I_PLE_WP, I_PLE_WG, I_NFINAL, N_IN };

constexpr size_t MiB = 1u << 20;
constexpr size_t WS_CTL = 0, CTL_ZERO_BYTES = 1 * MiB, WS_SU = 256 * 1024;
constexpr size_t WS_WEV_IN = 1 * MiB, WS_WEV_OUT = 30 * MiB, WS_WOD_IN = 38 * MiB, WS_WOD_OUT = 68 * MiB, WS_WPEER = 76 * MiB, WS_WGATE = 92 * MiB, WS_WPROJ = 108 * MiB,
                 WS_WLORA = 110 * MiB, WS_PBF = 113 * MiB, WS_TABU = 129 * MiB, WS_TABV = 193 * MiB, WS_ACTA = 257 * MiB, WS_ACTB = 321 * MiB, WS_PROJ = 385 * MiB, WS_SC = 385 * MiB,
                 WS_O = 625 * MiB, WS_H1 = 689 * MiB, WS_PP = 753 * MiB, WS_LA = 817 * MiB, WS_LO = 833 * MiB, WS_RSP = 929 * MiB, WS_STATE = 937 * MiB, WS_RS3 = 945 * MiB, WS_END = 946 * MiB;
static_assert(WS_WEV_IN + (size_t)EV_NP * D * 2 <= WS_WEV_OUT && WS_WOD_IN + (size_t)OD_NP * D * 2 <= WS_WOD_OUT && WS_PROJ + (size_t)T * PROJ_LD * 2 <= WS_O, "ws map");
constexpr int CW_BAR = 4096;
enum { RS_FFN0 = 0, RS_MIX1 = 1, RS_FFN1 = 2, RS_FINAL = 3 };
constexpr int RING_OFF = 0, RING_BYTES = 131072;
constexpr int LDSCTL_OFF = RING_BYTES, MISC_OFF = LDSCTL_OFF + 320;
constexpr int LDS_BYTES = 147456;

struct Args { const float* in[N_IN]; float* out; unsigned char* ws; int ph_lo, ph_hi; };
struct Frame {
    LAS unsigned char* lds; volatile LAS unsigned* MISC; gu32* ctl;
    int tid, lane, wave, vcu, G;
};
__device__ __forceinline__ float wave_sum(float v) {
#pragma unroll
    for (int o = 1; o < 64; o <<= 1) v += __shfl_xor(v, o);
    return v;
}
__device__ __forceinline__ float half_sum32(float v) {
#pragma unroll
    for (int o = 1; o < 32; o <<= 1) v += __shfl_xor(v, o);
    return v;
}
#define DPP_ADD(v, ctrl) (v) += __builtin_bit_cast(float, __builtin_amdgcn_update_dpp(0, __builtin_bit_cast(int, (v)), (ctrl), 0xF, 0xF, false))
__device__ __forceinline__ float row_sum16(float v) {
    DPP_ADD(v, 0x128); DPP_ADD(v, 0x124); DPP_ADD(v, 0x122); DPP_ADD(v, 0x121);
    return v;
}
__device__ __forceinline__ void row_sum16_x4(float& a, float& b, float& c, float& d) {
    asm("s_nop 1\n\t"
        "v_add_f32_dpp %0, %0, %0 row_ror:8 row_mask:0xf bank_mask:0xf\n\tv_add_f32_dpp %1, %1, %1 row_ror:8 row_mask:0xf bank_mask:0xf\n\t"
        "v_add_f32_dpp %2, %2, %2 row_ror:8 row_mask:0xf bank_mask:0xf\n\tv_add_f32_dpp %3, %3, %3 row_ror:8 row_mask:0xf bank_mask:0xf\n\t"
        "v_add_f32_dpp %0, %0, %0 row_ror:4 row_mask:0xf bank_mask:0xf\n\tv_add_f32_dpp %1, %1, %1 row_ror:4 row_mask:0xf bank_mask:0xf\n\t"
        "v_add_f32_dpp %2, %2, %2 row_ror:4 row_mask:0xf bank_mask:0xf\n\tv_add_f32_dpp %3, %3, %3 row_ror:4 row_mask:0xf bank_mask:0xf\n\t"
        "v_add_f32_dpp %0, %0, %0 row_ror:2 row_mask:0xf bank_mask:0xf\n\tv_add_f32_dpp %1, %1, %1 row_ror:2 row_mask:0xf bank_mask:0xf\n\t"
        "v_add_f32_dpp %2, %2, %2 row_ror:2 row_mask:0xf bank_mask:0xf\n\tv_add_f32_dpp %3, %3, %3 row_ror:2 row_mask:0xf bank_mask:0xf\n\t"
        "v_add_f32_dpp %0, %0, %0 row_ror:1 row_mask:0xf bank_mask:0xf\n\tv_add_f32_dpp %1, %1, %1 row_ror:1 row_mask:0xf bank_mask:0xf\n\t"
        "v_add_f32_dpp %2, %2, %2 row_ror:1 row_mask:0xf bank_mask:0xf\n\tv_add_f32_dpp %3, %3, %3 row_ror:1 row_mask:0xf bank_mask:0xf\n\t"
        "s_nop 1"
        : "+v"(a), "+v"(b), "+v"(c), "+v"(d));
}
__device__ __forceinline__ void row_sum16_x2(float& a, float& b) {
    asm("s_nop 1\n\t"
        "v_add_f32_dpp %0, %0, %0 row_ror:8 row_mask:0xf bank_mask:0xf\n\tv_add_f32_dpp %1, %1, %1 row_ror:8 row_mask:0xf bank_mask:0xf\n\ts_nop 1\n\t"
        "v_add_f32_dpp %0, %0, %0 row_ror:4 row_mask:0xf bank_mask:0xf\n\tv_add_f32_dpp %1, %1, %1 row_ror:4 row_mask:0xf bank_mask:0xf\n\ts_nop 1\n\t"
        "v_add_f32_dpp %0, %0, %0 row_ror:2 row_mask:0xf bank_mask:0xf\n\tv_add_f32_dpp %1, %1, %1 row_ror:2 row_mask:0xf bank_mask:0xf\n\ts_nop 1\n\t"
        "v_add_f32_dpp %0, %0, %0 row_ror:1 row_mask:0xf bank_mask:0xf\n\tv_add_f32_dpp %1, %1, %1 row_ror:1 row_mask:0xf bank_mask:0xf\n\t"
        "s_nop 1"
        : "+v"(a), "+v"(b));
}
typedef unsigned u32x2 __attribute__((ext_vector_type(2)));
__device__ __forceinline__ void st_wt16(void* p, v4u v) { asm volatile("global_store_dwordx4 %0, %1, off sc1\n\ts_nop 1" :: "v"(p), "v"(v) : "memory"); }
__device__ __forceinline__ void st_wt8(void* p, u32x2 v) { asm volatile("global_store_dwordx2 %0, %1, off sc1\n\ts_nop 1" :: "v"(p), "v"(v) : "memory"); }
#define LBAR() do { asm volatile("s_waitcnt lgkmcnt(0)" ::: "memory"); __builtin_amdgcn_s_barrier(); asm volatile("" ::: "memory"); } while (0)
typedef float f32x2 __attribute__((ext_vector_type(2)));
typedef __bf16 hwbf16x2_t __attribute__((ext_vector_type(2)));
__device__ __forceinline__ unsigned hw_pk2(float lo, float hi) { const f32x2 v = {lo, hi}; return __builtin_bit_cast(unsigned, __builtin_convertvector(v, hwbf16x2_t)); }
__device__ __forceinline__ bf16 hw_bf(float x) { return (bf16)hw_pk2(x, 0.f); }
__device__ __forceinline__ float bf_lo(unsigned w) { return __uint_as_float(w << 16); }
__device__ __forceinline__ float bf_hi(unsigned w) { return __uint_as_float(w & 0xffff0000u); }
__device__ __forceinline__ float sigmoidf_(float x) { return __builtin_amdgcn_rcpf(1.0f + __expf(-x)); }
__device__ __forceinline__ float siluf_(float x) { return x * __builtin_amdgcn_rcpf(1.0f + __expf(-x)); }
__device__ __forceinline__ float softplusf_(float x) { return fmaxf(x, 0.f) + log1pf(__expf(-fabsf(x))); }
__device__ __forceinline__ float logsigmoidf_(float x) { return fminf(x, 0.f) - log1pf(__expf(-fabsf(x))); }

struct EpiBf16S {
    static constexpr bool PERM = true, AFTER_DRAIN = false;
    bf16* O; int ldc; const float* rowss;
    __device__ __forceinline__ void operator()(const pg8::f32x4 (&acc)[2][2][4][2], const pg8::Unit& u, int wr, int wc, int fr, int fq) const {
        const int row0 = u.pm * 256 + wr * 64 + fr, col0 = u.pn * 256 + wc * 32 + 8 * fq;
#pragma unroll
        for (int ai = 0; ai < 2; ++ai)
#pragma unroll
            for (int m = 0; m < 4; ++m) {
                const int row = row0 + ai * 128 + m * 16;
                float sc = 1.f;
                if (rowss) { const pg8::f32x4* rp = (const pg8::f32x4*)(rowss + (size_t)row * 32 + 8 * fq); const pg8::f32x4 p0 = rp[0], p1 = rp[1];
                    float s = ((p0[0] + p0[1]) + (p0[2] + p0[3])) + ((p1[0] + p1[1]) + (p1[2] + p1[3])); s += __shfl_xor(s, 16); s += __shfl_xor(s, 32);
                    sc = __builtin_amdgcn_rsqf(s * (1.0f / D) + EPS); }
                bf16* rowp = O + (size_t)row * ldc + col0;
#pragma unroll
                for (int bj = 0; bj < 2; ++bj) { const pg8::f32x4 v0 = acc[ai][bj][m][0] * sc, v1 = acc[ai][bj][m][1] * sc;
                    pg8::u32x4 w; w.x = pg8::cvt_pk_bf16(v0[0], v0[1]); w.y = pg8::cvt_pk_bf16(v0[2], v0[3]); w.z = pg8::cvt_pk_bf16(v1[0], v1[1]); w.w = pg8::cvt_pk_bf16(v1[2], v1[3]);
                    *(pg8::u32x4*)(rowp + bj * 128) = w; } }
    }
};
template <bool GATE, bool HIN_F32> struct EpiResid {
    static constexpr bool PERM = false, AFTER_DRAIN = false;
    const void* hin; bf16* hout; float* rowss; const bf16* pp; const float* rs3; unsigned char* h8;
    __device__ __forceinline__ void operator()(const pg8::f32x4 (&acc)[2][2][4][2], const pg8::Unit& u, int wr, int wc, int fr, int fq) const {
        const int row0 = u.pm * 256 + wr * 64 + fr, col0 = u.pn * 256 + wc * 32 + 4 * fq;
        constexpr int MG = HIN_F32 ? 2 : 4;
#pragma unroll
        for (int ai = 0; ai < 2; ++ai)
#pragma unroll
            for (int m0 = 0; m0 < 4; m0 += MG) {
                pg8::f32x4 hf[MG][2][2]; pg8::u32x2 hb[MG][2][2], pw[MG][2][2]; float rsc[MG];
#pragma unroll
                for (int mm = 0; mm < MG; ++mm) { const int row = row0 + ai * 128 + (m0 + mm) * 16; const size_t off = (size_t)row * D + col0; rsc[mm] = GATE ? rs3[row] : 1.f;
#pragma unroll
                    for (int bj = 0; bj < 2; ++bj)
#pragma unroll
                        for (int n = 0; n < 2; ++n) { const size_t o = off + bj * 128 + n * 16;
                            if (HIN_F32) hf[mm][bj][n] = *(const pg8::f32x4*)((const float*)hin + o); else hb[mm][bj][n] = *(const pg8::u32x2*)((const bf16*)hin + o);
                            if (GATE) pw[mm][bj][n] = *(const pg8::u32x2*)(pp + o); } }
#pragma unroll
                for (int mm = 0; mm < MG; ++mm) { const int m = m0 + mm; const int row = row0 + ai * 128 + m * 16; const size_t off = (size_t)row * D + col0; float ss = 0.f;
#pragma unroll
                    for (int bj = 0; bj < 2; ++bj)
#pragma unroll
                        for (int n = 0; n < 2; ++n) { const size_t o = off + bj * 128 + n * 16;
                            pg8::f32x4 hv;
                            if (HIN_F32) hv = hf[mm][bj][n];
                            else { const pg8::u32x2 hw = hb[mm][bj][n]; hv[0] = bf_lo(hw.x); hv[1] = bf_hi(hw.x); hv[2] = bf_lo(hw.y); hv[3] = bf_hi(hw.y); }
                            pg8::f32x4 a = acc[ai][bj][m][n];
                            if (GATE) { const pg8::u32x2 p2 = pw[mm][bj][n]; const float rs_ = rsc[mm];
                                a[0] = sigmoidf_(a[0] * rs_) * bf_lo(p2.x); a[1] = sigmoidf_(a[1] * rs_) * bf_hi(p2.x); a[2] = sigmoidf_(a[2] * rs_) * bf_lo(p2.y); a[3] = sigmoidf_(a[3] * rs_) * bf_hi(p2.y); }
                            hv = hv + a;
                            pg8::u32x2 w; w.x = hw_pk2(hv[0], hv[1]); w.y = hw_pk2(hv[2], hv[3]); *(pg8::u32x2*)(hout + o) = w;
                            if (h8) { int x8 = __builtin_amdgcn_cvt_pk_fp8_f32(hv[0], hv[1], 0, false); x8 = __builtin_amdgcn_cvt_pk_fp8_f32(hv[2], hv[3], x8, true); *(unsigned*)(h8 + o) = (unsigned)x8; }
                            const float q0 = bf_lo(w.x), q1 = bf_hi(w.x), q2 = bf_lo(w.y), q3 = bf_hi(w.y);
                            ss += (q0 * q0 + q1 * q1) + (q2 * q2 + q3 * q3); }
                    ss += __shfl_xor(ss, 16); ss += __shfl_xor(ss, 32);
                    if (fq == 0) rowss[(size_t)row * 32 + u.pn * 4 + wc] = ss; }
                asm volatile("" ::: "memory"); }
    }
};


__device__ __forceinline__ void p0_transpose_item(const float* W, int K, int N, bf16* WT, LAS float* scr, int item, int lane, const float* kgain = nullptr) {
    const int nblk = N / 32, kb = item / nblk, nb = item % nblk, k0 = 64 * kb, n0 = 32 * nb;
    { const GAS float* Wg = (const GAS float*)W + (size_t)(k0 + (lane >> 5)) * N + n0 + (lane & 31); float v[32];
#pragma unroll
      for (int i = 0; i < 32; ++i) v[i] = Wg[(size_t)(2 * i) * N];
#pragma unroll
      for (int i = 0; i < 32; ++i) scr[(2 * i + (lane >> 5)) * 33 + (lane & 31)] = v[i]; }
    LDS_WAIT(); asm volatile("" ::: "memory");
    const int c = lane & 7;
#pragma unroll
    for (int j = 0; j < 4; ++j) { const int n = (lane >> 3) + 8 * j; const LAS float* s = scr + (8 * c) * 33 + n;
        f32x4 g0 = {1.f, 1.f, 1.f, 1.f}, g1 = g0; if (kgain) { g0 = *(const GAS f32x4*)(kgain + k0 + 8 * c); g1 = *(const GAS f32x4*)(kgain + k0 + 8 * c + 4); }
        v4u o; o.x = pk2(s[0 * 33] * g0[0], s[1 * 33] * g0[1]); o.y = pk2(s[2 * 33] * g0[2], s[3 * 33] * g0[3]); o.z = pk2(s[4 * 33] * g1[0], s[5 * 33] * g1[1]); o.w = pk2(s[6 * 33] * g1[2], s[7 * 33] * g1[3]);
        *(GAS v4u*)(WT + (size_t)(n0 + n) * K + k0 + 8 * c) = o; }
    LDS_WAIT(); asm volatile("" ::: "memory");
}
__device__ __forceinline__ void p0_transpose_item_f8(const float* W, int K, int N, unsigned char* WT, LAS float* scr, int item, int lane, const float* kgain = nullptr) {
    const int nblk = N / 32, kb = item / nblk, nb = item % nblk, k0 = 64 * kb, n0 = 32 * nb;
    { const GAS float* Wg = (const GAS float*)W + (size_t)(k0 + (lane >> 5)) * N + n0 + (lane & 31); float v[32];
#pragma unroll
      for (int i = 0; i < 32; ++i) v[i] = Wg[(size_t)(2 * i) * N];
#pragma unroll
      for (int i = 0; i < 32; ++i) scr[(2 * i + (lane >> 5)) * 33 + (lane & 31)] = v[i]; }
    LDS_WAIT(); asm volatile("" ::: "memory");
    const int c = lane & 7;
#pragma unroll
    for (int j = 0; j < 4; ++j) { const int n = (lane >> 3) + 8 * j; const LAS float* s = scr + (8 * c) * 33 + n;
        f32x4 g0 = {64.f, 64.f, 64.f, 64.f}, g1 = g0; if (kgain) { g0 = g0 * *(const GAS f32x4*)(kgain + k0 + 8 * c); g1 = g1 * *(const GAS f32x4*)(kgain + k0 + 8 * c + 4); }
        int x0 = __builtin_amdgcn_cvt_pk_fp8_f32(s[0 * 33] * g0[0], s[1 * 33] * g0[1], 0, false); x0 = __builtin_amdgcn_cvt_pk_fp8_f32(s[2 * 33] * g0[2], s[3 * 33] * g0[3], x0, true);
        int x1 = __builtin_amdgcn_cvt_pk_fp8_f32(s[4 * 33] * g1[0], s[5 * 33] * g1[1], 0, false); x1 = __builtin_amdgcn_cvt_pk_fp8_f32(s[6 * 33] * g1[2], s[7 * 33] * g1[3], x1, true);
        u32x2 o; o.x = (unsigned)x0; o.y = (unsigned)x1;
        *(GAS u32x2*)(WT + (size_t)(n0 + n) * K + k0 + 8 * c) = o; }
    LDS_WAIT(); asm volatile("" ::: "memory");
}
__device__ __forceinline__ void cvt_f32_bf16(const float* src, bf16* dst, size_t n, int gtid, int gthreads) {
    const size_t n8 = n / 8;
    for (size_t i = gtid; i < n8; i += gthreads) {
        const f32x4 a = *(const GAS f32x4*)(src + i * 8), b = *(const GAS f32x4*)(src + i * 8 + 4);
        v4u o; o.x = pk2(a[0], a[1]); o.y = pk2(a[2], a[3]); o.z = pk2(b[0], b[1]); o.w = pk2(b[2], b[3]);
        *(GAS v4u*)(dst + i * 8) = o; }
}
__device__ __forceinline__ void cvt_f32_fp8(const float* src, unsigned char* dst, size_t n, float scale, int gtid, int gthreads, const float* cgain = nullptr) {
    const size_t n16 = n / 16;
    for (size_t i = gtid; i < n16; i += gthreads) { v4u o; unsigned w[4];
#pragma unroll
        for (int q = 0; q < 4; ++q) { f32x4 a = *(const GAS f32x4*)(src + i * 16 + 4 * q) * scale; if (cgain) a = a * *(const GAS f32x4*)(cgain + ((i * 16 + 4 * q) & (D - 1)));
            int x = __builtin_amdgcn_cvt_pk_fp8_f32(a[0], a[1], 0, false); x = __builtin_amdgcn_cvt_pk_fp8_f32(a[2], a[3], x, true); w[q] = (unsigned)x; }
        o.x = w[0]; o.y = w[1]; o.z = w[2]; o.w = w[3];
        *(GAS v4u*)(dst + i * 16) = o; }
}
__device__ __forceinline__ void cvt_rows_i8(const float* src, unsigned char* dst, float* SU, int rows, int gw, int NGW, int lane, const float* cgain) {
    for (int r = gw; r < rows; r += NGW) {
        f32x4 a[8]; float mx = 0.f;
#pragma unroll
        for (int i = 0; i < 8; ++i) { a[i] = *(const GAS f32x4*)(src + (size_t)r * D + 256 * i + 4 * lane) * *(const GAS f32x4*)(cgain + 256 * i + 4 * lane);
            mx = fmaxf(mx, fmaxf(fmaxf(fabsf(a[i][0]), fabsf(a[i][1])), fmaxf(fabsf(a[i][2]), fabsf(a[i][3])))); }
#pragma unroll
        for (int o = 1; o < 64; o <<= 1) mx = fmaxf(mx, __shfl_xor(mx, o));
        const float inv = mx > 0.f ? 127.0f / mx : 0.f;
#pragma unroll
        for (int i = 0; i < 8; ++i) { unsigned w = 0;
#pragma unroll
            for (int e = 0; e < 4; ++e) w |= (__float_as_uint(__builtin_fmaf(a[i][e], inv, 12582912.0f)) & 255u) << (8 * e);
            *(GAS unsigned*)(dst + (size_t)r * D + 256 * i + 4 * lane) = w; }
        if (lane == 0) SU[r] = mx * (1.0f / 127.0f);
    }
}
__device__ __forceinline__ void rms_row_to_bf16(const float* xrow, const float* g, bf16* orow, int lane) {
    const GAS f32x4* xr = (const GAS f32x4*)xrow + lane; f32x4 v[8]; float s = 0.f;
#pragma unroll
    for (int j = 0; j < 8; ++j) { v[j] = xr[64 * j]; s += (v[j][0] * v[j][0] + v[j][1] * v[j][1]) + (v[j][2] * v[j][2] + v[j][3] * v[j][3]); }
    const float r = __builtin_amdgcn_rsqf(wave_sum(s) * (1.0f / D) + EPS);
    const GAS f32x4* gr = (const GAS f32x4*)g + lane;
    GAS unsigned long long* o8 = (GAS unsigned long long*)orow + lane;
#pragma unroll
    for (int j = 0; j < 8; ++j) { const f32x4 gg = gr[64 * j]; o8[64 * j] = (unsigned long long)pk2(v[j][0] * r * gg[0], v[j][1] * r * gg[1]) | ((unsigned long long)pk2(v[j][2] * r * gg[2], v[j][3] * r * gg[3]) << 32); }
}
__device__ __forceinline__ void rms_row_to_f8(const float* xrow, const float* g, unsigned char* orow, int lane) {
    const GAS f32x4* xr = (const GAS f32x4*)xrow + lane; f32x4 v[8]; float s = 0.f;
#pragma unroll
    for (int j = 0; j < 8; ++j) { v[j] = xr[64 * j]; s += (v[j][0] * v[j][0] + v[j][1] * v[j][1]) + (v[j][2] * v[j][2] + v[j][3] * v[j][3]); }
    const float r = __builtin_amdgcn_rsqf(wave_sum(s) * (1.0f / D) + EPS);
    const GAS f32x4* gr = (const GAS f32x4*)g + lane;
    GAS unsigned* o4 = (GAS unsigned*)orow + lane;
#pragma unroll
    for (int j = 0; j < 8; ++j) { const f32x4 q = v[j] * gr[64 * j] * r; int x = __builtin_amdgcn_cvt_pk_fp8_f32(q[0], q[1], 0, false); x = __builtin_amdgcn_cvt_pk_fp8_f32(q[2], q[3], x, true); o4[64 * j] = (unsigned)x; }
}
__device__ __forceinline__ void p0_fold_item(const float* wq, const float* sk, bf16* WP, LAS float* lds, int item, int tid, const float* kgain) {
    const int hp = item >> 5, k0 = (item & 31) * 64;
    LAS float* skT = lds;
    LAS float* wqT = lds + 128 * 132;
    const float* skb = sk + (size_t)hp * 128 * 128;
#pragma unroll 4
    for (int i = 0; i < 32; ++i) { const int idx = i * 512 + tid, n = idx >> 7, d = idx & 127; skT[d * 132 + n] = skb[idx]; }
#pragma unroll 4
    for (int i = 0; i < 16; ++i) { const int idx = i * 512 + tid, kk = idx >> 7, d = idx & 127; wqT[d * 68 + kk] = wq[(size_t)(k0 + kk) * D + hp * 128 + d] * kgain[k0 + kk]; }
    __syncthreads();
    const int n0 = (tid >> 4) * 4, kk0 = (tid & 15) * 4;
    float acc[4][4];
#pragma unroll
    for (int i = 0; i < 4; ++i)
#pragma unroll
        for (int j = 0; j < 4; ++j) acc[i][j] = 0.f;
#pragma unroll 4
    for (int d = 0; d < 128; ++d) { const f32x4 a = *(const LAS f32x4*)(skT + d * 132 + n0), b = *(const LAS f32x4*)(wqT + d * 68 + kk0);
#pragma unroll
        for (int i = 0; i < 4; ++i)
#pragma unroll
            for (int j = 0; j < 4; ++j) acc[i][j] += a[i] * b[j]; }
#pragma unroll
    for (int i = 0; i < 4; ++i) { unsigned long long o = (unsigned long long)pk2(acc[i][0], acc[i][1]) | ((unsigned long long)pk2(acc[i][2], acc[i][3]) << 32);
        *(GAS unsigned long long*)(WP + (size_t)(hp * 128 + n0 + i) * D + k0 + kk0) = o; }
    __syncthreads();
}
__device__ __forceinline__ void p0_prologue(const Args& A, Frame& F) {
    const int gw = F.vcu * NWAVES + F.wave, NGW = F.G * NWAVES;
    const int gtid = gw * 64 + F.lane, gthreads = F.G * NTHREADS;
    unsigned char* ws = A.ws;
    LAS float* scr = (LAS float*)(F.lds + RING_OFF + F.wave * 16384);
    constexpr int I_EVIN = (D / 64) * (EV_N / 32);
    for (int it = gw; it < I_EVIN; it += NGW) p0_transpose_item(A.in[I_EV_WIN], D, EV_N, (bf16*)(ws + WS_WEV_IN), scr, it, F.lane);
    { GAS v4u* z0 = (GAS v4u*)(ws + WS_WEV_IN + (size_t)EV_N * D * 2); const size_t n0 = (size_t)(EV_NP - EV_N) * D * 2 / 16;
      for (size_t i = gtid; i < n0; i += gthreads) z0[i] = (v4u){0u, 0u, 0u, 0u}; }
    { constexpr int I_PJ = (256 / 64) * (D / 32);
      for (int it = gw; it < 2 * I_PJ; it += NGW) { const int L = it / I_PJ; p0_transpose_item(A.in[I_PLE_WP] + (size_t)L * 256 * D, 256, D, (bf16*)(ws + WS_WPROJ) + (size_t)L * D * 256, scr, it % I_PJ, F.lane); } }
    cvt_f32_bf16(A.in[I_P], (bf16*)(ws + WS_PBF), (size_t)2 * T * 256, gtid, gthreads);
    for (int m = gw; m < T; m += NGW) rms_row_to_bf16(A.in[I_X] + (size_t)m * D, A.in[I_NMIX], (bf16*)(ws + WS_ACTA) + (size_t)m * D, F.lane);
#if EV_F8_T1 > EV_F8_T0
    for (int it = gw; it < I_EVIN; it += NGW) p0_transpose_item_f8(A.in[I_EV_WIN], D, EV_N, (unsigned char*)(ws + WS_O), scr, it, F.lane);
    { GAS v4u* z0 = (GAS v4u*)(ws + WS_O + (size_t)EV_N * D); const size_t n0 = (size_t)(EV_NP - EV_N) * D / 16;
      for (size_t i = gtid; i < n0; i += gthreads) z0[i] = (v4u){0u, 0u, 0u, 0u}; }
    for (int m = gw; m < T; m += NGW) rms_row_to_f8(A.in[I_X] + (size_t)m * D, A.in[I_NMIX], (unsigned char*)(ws + WS_H1) + (size_t)m * D, F.lane);
#endif
}
__device__ __forceinline__ void p0_deferred(const Args& A, Frame& F, int wg, int nwg) {
    const int gw = wg * NWAVES + F.wave, NGW = nwg * NWAVES;
    int gtid = gw * 64 + F.lane; const int gthreads = nwg * NTHREADS;
    asm volatile("" : "+v"(gtid));
    unsigned char* ws = A.ws;
    {
        LAS float* scr = (LAS float*)(F.lds + RING_OFF + F.wave * 16384);
        constexpr int I_SQ = (D / 64) * (D / 32), I_ODIN = (D / 64) * (OD_N / 32);
        constexpr int NITEMS = I_SQ + I_ODIN + I_SQ;
        for (int it = gw; it < NITEMS; it += NGW) {
            int r = it;
            if (r < I_SQ) { p0_transpose_item(A.in[I_EV_WOUT], D, D, (bf16*)(ws + WS_WEV_OUT), scr, r, F.lane); continue; } r -= I_SQ;
            if (r < I_ODIN) { p0_transpose_item_f8(A.in[I_OD_WIN], D, OD_N, (unsigned char*)(ws + WS_WOD_IN), scr, r, F.lane, A.in[I_NMIX] + D); continue; } r -= I_ODIN;
            p0_transpose_item_f8(A.in[I_PLE_WG], D, D, (unsigned char*)(ws + WS_WGATE), scr, r, F.lane, A.in[I_NPLE]);
        }
        { GAS v4u* z1 = (GAS v4u*)(ws + WS_WOD_IN + (size_t)OD_N * D); const size_t n1 = (size_t)(OD_NP - OD_N) * D / 16;
          for (size_t i = gtid; i < n1; i += gthreads) z1[i] = (v4u){0u, 0u, 0u, 0u}; }
    }
    __syncthreads();
    for (int it = wg; it < 512; it += nwg)
        p0_fold_item(A.in[I_PEER_WQ], A.in[I_PEER_SK], (bf16*)(ws + WS_WPEER), (LAS float*)(F.lds + RING_OFF), it, F.tid, A.in[I_NFFN]);
    cvt_rows_i8(A.in[I_PEER_U], (unsigned char*)(ws + WS_TABU), (float*)(ws + WS_SU), 16384, gw, NGW, F.lane, A.in[I_NFFN]);
    cvt_f32_fp8(A.in[I_PEER_V], (unsigned char*)(ws + WS_TABV), (size_t)16384 * D, 16.0f, gtid, gthreads);
    { bf16* LB = (bf16*)(ws + WS_WLORA); const float* w2 = A.in[I_W2]; const float* a2 = A.in[I_A2]; const float* g2 = A.in[I_G2];
      for (int i = gtid; i < LORA_N * LORA_K / 2; i += gthreads) { const int row = i / (LORA_K / 2), col = (i % (LORA_K / 2)) * 2; float v[2];
#pragma unroll
          for (int e = 0; e < 2; ++e) { const int c = col + e; float x = 0.f;
              if (row < 1024) { if (c < 96) x = w2[c * 1024 + row]; }
              else if (row < 2048) { if (c >= 96 && c < 192) x = a2[(c - 96) * 1024 + (row - 1024)]; }
              else { if (c >= 192 && c < 448) x = g2[(c - 192) * 1024 + (row - 2048)]; }
              v[e] = x; }
          *(GAS unsigned*)(LB + (size_t)row * LORA_K + col) = pk2(v[0], v[1]); } }
}
__device__ __forceinline__ void p1_deferred(const Args& A, Frame& F, int wg, int nwg) {
    const int gw = wg * NWAVES + F.wave, NGW = nwg * NWAVES;
    int gtid = gw * 64 + F.lane; const int gthreads = nwg * NTHREADS;
    asm volatile("" : "+v"(gtid));
    unsigned char* ws = A.ws;
    { LAS float* scr = (LAS float*)(F.lds + RING_OFF + F.wave * 16384); constexpr int I_SQ = (D / 64) * (D / 32);
      for (int it = gw; it < 2 * I_SQ; it += NGW) {
          if (it < I_SQ) p0_transpose_item_f8(A.in[I_OD_WOUT], D, D, (unsigned char*)(ws + WS_WOD_OUT), scr, it, F.lane);
          else p0_transpose_item_f8(A.in[I_PLE_WG] + (size_t)D * D, D, D, (unsigned char*)((bf16*)(ws + WS_WGATE) + (size_t)D * D), scr, it - I_SQ, F.lane, A.in[I_NPLE] + D); } }
    __syncthreads();
    for (int it = wg; it < 512; it += nwg)
        p0_fold_item(A.in[I_PEER_WQ] + (size_t)D * D, A.in[I_PEER_SK] + (size_t)16 * 128 * 128, (bf16*)(ws + WS_WPEER) + (size_t)D * D, (LAS float*)(F.lds + RING_OFF), it, F.tid, A.in[I_NFFN] + D);
    cvt_rows_i8(A.in[I_PEER_U] + (size_t)16384 * D, (unsigned char*)(ws + WS_TABU) + (size_t)16384 * D, (float*)(ws + WS_SU) + 16384, 16384, gw, NGW, F.lane, A.in[I_NFFN] + D);
    cvt_f32_fp8(A.in[I_PEER_V] + (size_t)16384 * D, (unsigned char*)(ws + WS_TABV) + (size_t)16384 * D, (size_t)16384 * D, 16.0f, gtid, gthreads);
}

constexpr int TC = 16, NCHUNK = SEQ / TC;

template <int MODE>
__device__ __forceinline__ void scan_gla_unit(const Args& A, Frame& F, int unit) {
    int tid = F.tid; asm volatile("" : "+v"(tid));
    const int lane = tid & 63, w = F.wave;
    int b, h, qcol, kcol, vcol, ocol;
    if (MODE == 0) { b = unit >> 4; h = (unit >> 2) & 3; const int s = unit & 3; qcol = EC_GQ + h * 128; kcol = EC_GK + h * 128; vcol = EC_GV + h * 256 + s * 64; ocol = h * 256 + s * 64; }
    else           { b = unit >> 4; h = (unit >> 1) & 7; const int s = unit & 1; qcol = OC_HQ + h * 128; kcol = OC_HF + h * 128; vcol = OC_HI + h * 128 + s * 64; ocol = h * 128 + s * 64; }
    const bf16* P = (const bf16*)(A.ws + WS_PROJ) + (size_t)b * SEQ * PROJ_LD;
    float* O = (float*)(A.ws + WS_O) + (size_t)b * SEQ * D + ocol;
    LAS float* Lf = (LAS float*)(F.lds + RING_OFF);
    constexpr int BUFSZ = 7168, O_EG = 0, O_K = 2048, O_Q = 4096, O_V = 6144, O_OUT = 2 * BUFSZ, O_W2 = O_OUT + 1024, O_BIAS = O_W2 + 2048;
    const int tl = tid >> 5, dq = (tid & 31) * 4, tlv = tid >> 4, c4 = (tid & 15) * 4;
    float lb[4] = {0.f, 0.f, 0.f, 0.f};
    if (MODE == 0) {
        const float* w2 = A.in[I_GK_W2]; const float* gb = A.in[I_GK_B];
        for (int i = tid; i < 2048; i += NTHREADS) Lf[O_W2 + i] = w2[(i >> 7) * 512 + h * 128 + (i & 127)];
        if (tid < 128) Lf[O_BIAS + tid] = gb[h * 128 + tid];
    } else {
        const float* lg = A.in[I_LB];
#pragma unroll
        for (int i = 0; i < 4; ++i) lb[i] = sigmoidf_(lg[1024 + h * 128 + dq + i] - lg[h * 128 + dq + i]);
    }
    u32x2 rq, rk, rv = {0u, 0u}; v4u rg0 = {0u, 0u, 0u, 0u}, rg1 = {0u, 0u, 0u, 0u};
#define GLA_LOAD(c) do { const bf16* pr = P + (size_t)((c) * TC + tl) * PROJ_LD; rq = *(const GAS u32x2*)(pr + qcol + dq); rk = *(const GAS u32x2*)(pr + kcol + dq); \
        if (MODE == 0) { rg0 = *(const GAS v4u*)(pr + EC_GLR); rg1 = *(const GAS v4u*)(pr + EC_GLR + 8); } \
        if (tid < 256) rv = *(const GAS u32x2*)(P + (size_t)((c) * TC + tlv) * PROJ_LD + vcol + c4); } while (0)
#define GLA_XFORM(bufi) do { LAS float* B_ = Lf + (bufi) * BUFSZ; f32x4 q4, k4, e4; \
        const float xq[4] = {bf_lo(rq.x), bf_hi(rq.x), bf_lo(rq.y), bf_hi(rq.y)}, xk[4] = {bf_lo(rk.x), bf_hi(rk.x), bf_lo(rk.y), bf_hi(rk.y)}; \
        if (MODE == 0) { f32x4 z = *(const LAS f32x4*)(Lf + O_BIAS + dq); \
            const float gl[16] = {bf_lo(rg0.x), bf_hi(rg0.x), bf_lo(rg0.y), bf_hi(rg0.y), bf_lo(rg0.z), bf_hi(rg0.z), bf_lo(rg0.w), bf_hi(rg0.w), \
                                  bf_lo(rg1.x), bf_hi(rg1.x), bf_lo(rg1.y), bf_hi(rg1.y), bf_lo(rg1.z), bf_hi(rg1.z), bf_lo(rg1.w), bf_hi(rg1.w)}; \
            _Pragma("unroll") for (int r_ = 0; r_ < 16; ++r_) { const f32x4 wv = *(const LAS f32x4*)(Lf + O_W2 + r_ * 128 + dq); z = z + wv * gl[r_]; } \
            _Pragma("unroll") for (int i_ = 0; i_ < 4; ++i_) { q4[i_] = xq[i_] * 0.08838834764831845f; k4[i_] = xk[i_]; e4[i_] = __builtin_amdgcn_exp2f(-0.0625f * __builtin_amdgcn_logf(1.0f + __expf(-z[i_]))); } } \
        else { _Pragma("unroll") for (int i_ = 0; i_ < 4; ++i_) { const float fg = lb[i_] + (1.f - lb[i_]) * sigmoidf_(xk[i_]); q4[i_] = siluf_(xq[i_]); k4[i_] = 1.f - fg; e4[i_] = fg; } } \
        *(LAS f32x4*)(B_ + O_EG + tl * 128 + dq) = e4; *(LAS f32x4*)(B_ + O_K + tl * 128 + dq) = k4; *(LAS f32x4*)(B_ + O_Q + tl * 128 + dq) = q4; \
        if (tid < 256) { f32x4 v4 = {bf_lo(rv.x), bf_hi(rv.x), bf_lo(rv.y), bf_hi(rv.y)}; *(LAS f32x4*)(B_ + O_V + tlv * 64 + c4) = v4; } } while (0)
    LBAR();
    GLA_LOAD(0); GLA_XFORM(0);
    LBAR();
    f32x2 S2[8];
#pragma unroll
    for (int i = 0; i < 8; ++i) S2[i] = (f32x2){0.f, 0.f};
    const int j = lane & 15, col = w * 8 + (lane >> 4) * 2;
    for (int c = 0; c < NCHUNK; ++c) {
        if (c + 1 < NCHUNK) GLA_LOAD(c + 1);
        const LAS float* B_ = Lf + (c & 1) * BUFSZ;
        float os0 = 0.f, os1 = 0.f;
        f32x4 e0, e1, k0, k1, q0, q1, ne0, ne1, nk0, nk1, nq0, nq1; f32x2 v2, nv2;
#define GLA_LDSTEP(t_, E0, E1, K0, K1, Q0, Q1, V2) do { E0 = *(const LAS f32x4*)(B_ + O_EG + (t_) * 128 + 4 * j); E1 = *(const LAS f32x4*)(B_ + O_EG + (t_) * 128 + 64 + 4 * j); \
            K0 = *(const LAS f32x4*)(B_ + O_K + (t_) * 128 + 4 * j); K1 = *(const LAS f32x4*)(B_ + O_K + (t_) * 128 + 64 + 4 * j); \
            Q0 = *(const LAS f32x4*)(B_ + O_Q + (t_) * 128 + 4 * j); Q1 = *(const LAS f32x4*)(B_ + O_Q + (t_) * 128 + 64 + 4 * j); V2 = *(const LAS f32x2*)(B_ + O_V + (t_) * 64 + col); } while (0)
        GLA_LDSTEP(0, e0, e1, k0, k1, q0, q1, v2);
#pragma unroll
        for (int t = 0; t < TC; ++t) {
            if (t + 1 < TC) { GLA_LDSTEP(t + 1, ne0, ne1, nk0, nk1, nq0, nq1, nv2); }
            __builtin_amdgcn_sched_barrier(0);
            f32x2 pa = {0.f, 0.f}, pb = {0.f, 0.f};
#pragma unroll
            for (int i = 0; i < 4; ++i) {
                S2[i] = S2[i] * e0[i] + v2 * k0[i]; S2[4 + i] = S2[4 + i] * e1[i] + v2 * k1[i];
                pa += S2[i] * q0[i]; pb += S2[4 + i] * q1[i]; }
            pa += pb;
            float p0 = pa[0], p1 = pa[1];
            row_sum16_x2(p0, p1);
            os0 = (j == t) ? p0 : os0; os1 = (j == t) ? p1 : os1;
            e0 = ne0; e1 = ne1; k0 = nk0; k1 = nk1; q0 = nq0; q1 = nq1; v2 = nv2;
        }
#undef GLA_LDSTEP
        { f32x2 o2 = {os0, os1}; *(LAS f32x2*)(Lf + O_OUT + j * 64 + col) = o2; }
        if (c + 1 < NCHUNK) GLA_XFORM((c + 1) & 1);
        LBAR();
        if (tid < 256) *(GAS f32x4*)(O + (size_t)(c * TC + tlv) * D + c4) = *(const LAS f32x4*)(Lf + O_OUT + tlv * 64 + c4);
        LBAR();
    }
#undef GLA_LOAD
#undef GLA_XFORM
}

__device__ __forceinline__ void scan_gdn_unit(const Args& A, Frame& F, int unit) {
    int tid = F.tid; asm volatile("" : "+v"(tid));
    const int lane = tid & 63, w = F.wave;
    const int b = unit >> 4, h = (unit >> 1) & 7, s = unit & 1;
    const int qcol = EC_BQ + h * 128, kcol = EC_BK + h * 128, vcol = EC_BV + h * 128 + s * 64, ocol = 1024 + h * 128 + s * 64;
    const bf16* P = (const bf16*)(A.ws + WS_PROJ) + (size_t)b * SEQ * PROJ_LD;
    float* O = (float*)(A.ws + WS_O) + (size_t)b * SEQ * D + ocol;
    LAS float* Lf = (LAS float*)(F.lds + RING_OFF);
    constexpr int BUFSZ = 5184, O_K = 0, O_Q = 2048, O_V = 4096, O_SC = 5120, O_OUT = 2 * BUFSZ, O_CW = O_OUT + 1024;
    const int tl = tid >> 5, dq = (tid & 31) * 4, tlv = tid >> 4, c4 = (tid & 15) * 4;
    { const float* cw = A.in[I_GDN_CONV];
      for (int i = tid; i < 4 * 320; i += NTHREADS) { const int jt = i / 320, x = i % 320;
          const int ch = x < 128 ? (h * 128 + x) : x < 256 ? (1024 + h * 128 + (x - 128)) : (2048 + h * 128 + s * 64 + (x - 256));
          Lf[O_CW + i] = cw[jt * 3072 + ch]; } }
    const float neg_ea = -__expf(A.in[I_GDN_ALOG][h]), dtb = A.in[I_GDN_DTB][h];
    u32x2 rq[4], rk[4], rv[4]; unsigned short rba = 0, rbb = 0;
#pragma unroll
    for (int i = 0; i < 4; ++i) rv[i] = (u32x2){0u, 0u};
#define GDN_LOAD(c) do { const int t_ = (c) * TC + tl; \
        _Pragma("unroll") for (int jt = 0; jt < 4; ++jt) { const int tt = t_ - 3 + jt; \
            if (tt >= 0) { const bf16* pr = P + (size_t)tt * PROJ_LD; rq[jt] = *(const GAS u32x2*)(pr + qcol + dq); rk[jt] = *(const GAS u32x2*)(pr + kcol + dq); } \
            else { rq[jt] = (u32x2){0u, 0u}; rk[jt] = (u32x2){0u, 0u}; } } \
        { const bf16* pr = P + (size_t)t_ * PROJ_LD; rba = pr[EC_BA + h]; rbb = pr[EC_BB + h]; } \
        if (tid < 256) { const int tv = (c) * TC + tlv; \
            _Pragma("unroll") for (int jt = 0; jt < 4; ++jt) { const int tt = tv - 3 + jt; \
                if (tt >= 0) rv[jt] = *(const GAS u32x2*)(P + (size_t)tt * PROJ_LD + vcol + c4); else rv[jt] = (u32x2){0u, 0u}; } } } while (0)
#define GDN_XFORM(bufi) do { LAS float* B_ = Lf + (bufi) * BUFSZ; f32x4 q4 = {0.f, 0.f, 0.f, 0.f}, k4 = {0.f, 0.f, 0.f, 0.f}; \
        _Pragma("unroll") for (int jt = 0; jt < 4; ++jt) { const f32x4 wq = *(const LAS f32x4*)(Lf + O_CW + jt * 320 + dq), wk = *(const LAS f32x4*)(Lf + O_CW + jt * 320 + 128 + dq); \
            q4[0] += wq[0] * bf_lo(rq[jt].x); q4[1] += wq[1] * bf_hi(rq[jt].x); q4[2] += wq[2] * bf_lo(rq[jt].y); q4[3] += wq[3] * bf_hi(rq[jt].y); \
            k4[0] += wk[0] * bf_lo(rk[jt].x); k4[1] += wk[1] * bf_hi(rk[jt].x); k4[2] += wk[2] * bf_lo(rk[jt].y); k4[3] += wk[3] * bf_hi(rk[jt].y); } \
        float sq = 0.f, sk = 0.f, sqk = 0.f; \
        _Pragma("unroll") for (int i_ = 0; i_ < 4; ++i_) { q4[i_] = siluf_(q4[i_]); k4[i_] = siluf_(k4[i_]); sq += q4[i_] * q4[i_]; sk += k4[i_] * k4[i_]; sqk += q4[i_] * k4[i_]; } \
        sq = half_sum32(sq); sk = half_sum32(sk); sqk = half_sum32(sqk); \
        const float rq_ = __builtin_amdgcn_rsqf(sq + EPS) * 0.08838834764831845f, rk_ = __builtin_amdgcn_rsqf(sk + EPS); \
        q4 = q4 * rq_; k4 = k4 * rk_; \
        *(LAS f32x4*)(B_ + O_K + tl * 128 + dq) = k4; *(LAS f32x4*)(B_ + O_Q + tl * 128 + dq) = q4; \
        if ((tid & 31) == 0) { const float ba = __uint_as_float((unsigned)rba << 16), bb = __uint_as_float((unsigned)rbb << 16); \
            f32x4 sc; sc[0] = __expf(neg_ea * softplusf_(ba + dtb)); sc[1] = sigmoidf_(bb); sc[2] = sqk * rq_ * rk_; sc[3] = 0.f; *(LAS f32x4*)(B_ + O_SC + tl * 4) = sc; } \
        if (tid < 256) { f32x4 v4 = {0.f, 0.f, 0.f, 0.f}; \
            _Pragma("unroll") for (int jt = 0; jt < 4; ++jt) { const f32x4 wv = *(const LAS f32x4*)(Lf + O_CW + jt * 320 + 256 + c4); \
                v4[0] += wv[0] * bf_lo(rv[jt].x); v4[1] += wv[1] * bf_hi(rv[jt].x); v4[2] += wv[2] * bf_lo(rv[jt].y); v4[3] += wv[3] * bf_hi(rv[jt].y); } \
            _Pragma("unroll") for (int i_ = 0; i_ < 4; ++i_) v4[i_] = siluf_(v4[i_]); \
            *(LAS f32x4*)(B_ + O_V + tlv * 64 + c4) = v4; } } while (0)
    LBAR();
    GDN_LOAD(0); GDN_XFORM(0);
    LBAR();
    f32x2 S2[8];
#pragma unroll
    for (int i = 0; i < 8; ++i) S2[i] = (f32x2){0.f, 0.f};
    const int j = lane & 15, col = w * 8 + (lane >> 4) * 2;
    for (int c = 0; c < NCHUNK; ++c) {
        if (c + 1 < NCHUNK) GDN_LOAD(c + 1);
        const LAS float* B_ = Lf + (c & 1) * BUFSZ;
        float os0 = 0.f, os1 = 0.f;
        f32x4 k0, k1, q0, q1, sc, nk0, nk1, nq0, nq1, nsc; f32x2 v2, nv2;
#define GDN_LDSTEP(t_, K0, K1, Q0, Q1, V2, SC) do { K0 = *(const LAS f32x4*)(B_ + O_K + (t_) * 128 + 4 * j); K1 = *(const LAS f32x4*)(B_ + O_K + (t_) * 128 + 64 + 4 * j); \
            Q0 = *(const LAS f32x4*)(B_ + O_Q + (t_) * 128 + 4 * j); Q1 = *(const LAS f32x4*)(B_ + O_Q + (t_) * 128 + 64 + 4 * j); V2 = *(const LAS f32x2*)(B_ + O_V + (t_) * 64 + col); SC = *(const LAS f32x4*)(B_ + O_SC + (t_) * 4); } while (0)
        GDN_LDSTEP(0, k0, k1, q0, q1, v2, sc);
#pragma unroll
        for (int t = 0; t < TC; ++t) {
            if (t + 1 < TC) { GDN_LDSTEP(t + 1, nk0, nk1, nq0, nq1, nv2, nsc); }
            __builtin_amdgcn_sched_barrier(0);
            f32x2 d1 = {0.f, 0.f}, d2 = {0.f, 0.f}, e1 = {0.f, 0.f}, e2 = {0.f, 0.f};
#pragma unroll
            for (int i = 0; i < 4; ++i) { d1 += S2[i] * k0[i]; e1 += S2[4 + i] * k1[i]; d2 += S2[i] * q0[i]; e2 += S2[4 + i] * q1[i]; }
            d1 += e1; d2 += e2;
            { float r0_ = d1[0], r1_ = d1[1], r2_ = d2[0], r3_ = d2[1]; row_sum16_x4(r0_, r1_, r2_, r3_); d1[0] = r0_; d1[1] = r1_; d2[0] = r2_; d2[1] = r3_; }
            const float a = sc[0], beta = sc[1], qk = sc[2];
            const f32x2 dl = (v2 - d1 * a) * beta;
            const f32x2 o2 = d2 * a + dl * qk;
#pragma unroll
            for (int i = 0; i < 4; ++i) { S2[i] = S2[i] * a + dl * k0[i]; S2[4 + i] = S2[4 + i] * a + dl * k1[i]; }
            os0 = (j == t) ? o2[0] : os0; os1 = (j == t) ? o2[1] : os1;
            k0 = nk0; k1 = nk1; q0 = nq0; q1 = nq1; v2 = nv2; sc = nsc;
        }
#undef GDN_LDSTEP
        { f32x2 o2 = {os0, os1}; *(LAS f32x2*)(Lf + O_OUT + j * 64 + col) = o2; }
        if (c + 1 < NCHUNK) GDN_XFORM((c + 1) & 1);
        LBAR();
        if (tid < 256) *(GAS f32x4*)(O + (size_t)(c * TC + tlv) * D + c4) = *(const LAS f32x4*)(Lf + O_OUT + tlv * 64 + c4);
        LBAR();
    }
#undef GDN_LOAD
#undef GDN_XFORM
}

typedef short bf16x4_t __attribute__((ext_vector_type(4)));
__device__ __forceinline__ bf16x8 mk_frag(u32x2 lo, u32x2 hi) { v4u t; t.x = lo.x; t.y = lo.y; t.z = hi.x; t.w = hi.y; return __builtin_bit_cast(bf16x8, t); }
template <int MODE>
__device__ __forceinline__ void scan_gla_mfma_unit(const Args& A, Frame& F, int unit) {
    int tid = F.tid; asm volatile("" : "+v"(tid));
    const int lane = tid & 63, w = F.wave;
    int b, h, qcol, kcol, vcol, ocol;
    if (MODE == 0) { b = unit >> 3; h = (unit >> 1) & 3; const int s = unit & 1; qcol = EC_GQ + h * 128; kcol = EC_GK + h * 128; vcol = EC_GV + h * 256 + s * 128; ocol = h * 256 + s * 128; }
    else           { b = unit >> 3; h = unit & 7; qcol = OC_HQ + h * 128; kcol = OC_HF + h * 128; vcol = OC_HI + h * 128; ocol = h * 128; }
    const bf16* P = (const bf16*)(A.ws + WS_PROJ) + (size_t)b * SEQ * PROJ_LD;
    bf16* O = (bf16*)(A.ws + WS_O) + (size_t)b * SEQ * D + ocol;
    LAS float* Lf = (LAS float*)(F.lds + RING_OFF);
    constexpr int BUFSZ = 8192, O_E = 0, O_K = 2048, O_Q = 4096, O_V = 6144, RS = 136, O_QB = 2 * BUFSZ, O_KB = O_QB + 1088, O_KT = O_KB + 1088, O_BL = O_KT + 1024, O_AM = O_BL + 128, O_W2 = O_AM + 128, O_BIAS = O_W2 + 2048;
    LAS bf16* QB = (LAS bf16*)(Lf + O_QB); LAS bf16* KB = (LAS bf16*)(Lf + O_KB); LAS bf16* KT = (LAS bf16*)(Lf + O_KT); LAS bf16* AM = (LAS bf16*)(Lf + O_AM);
    const int tl = tid >> 5, dq = (tid & 31) * 4;
    float lb[4] = {0.f, 0.f, 0.f, 0.f};
    if (MODE == 0) {
        const float* w2 = A.in[I_GK_W2]; const float* gb = A.in[I_GK_B];
        for (int i = tid; i < 2048; i += NTHREADS) Lf[O_W2 + i] = w2[(i >> 7) * 512 + h * 128 + (i & 127)];
        if (tid < 128) Lf[O_BIAS + tid] = gb[h * 128 + tid];
    } else {
        const float* lg = A.in[I_LB];
#pragma unroll
        for (int i = 0; i < 4; ++i) lb[i] = sigmoidf_(lg[1024 + h * 128 + dq + i] - lg[h * 128 + dq + i]);
    }
    u32x2 rq, rk, rv; v4u rg0 = {0u, 0u, 0u, 0u}, rg1 = {0u, 0u, 0u, 0u};
#define GM_LOAD(c) do { const bf16* pr = P + (size_t)((c) * TC + tl) * PROJ_LD; rq = *(const GAS u32x2*)(pr + qcol + dq); rk = *(const GAS u32x2*)(pr + kcol + dq); rv = *(const GAS u32x2*)(pr + vcol + dq); \
        if (MODE == 0) { rg0 = *(const GAS v4u*)(pr + EC_GLR); rg1 = *(const GAS v4u*)(pr + EC_GLR + 8); } } while (0)
#define GM_XFORM(bufi) do { LAS float* B_ = Lf + (bufi) * BUFSZ; f32x4 q4, k4, e4; \
        const float xq[4] = {bf_lo(rq.x), bf_hi(rq.x), bf_lo(rq.y), bf_hi(rq.y)}, xk[4] = {bf_lo(rk.x), bf_hi(rk.x), bf_lo(rk.y), bf_hi(rk.y)}; \
        if (MODE == 0) { f32x4 z = *(const LAS f32x4*)(Lf + O_BIAS + dq); \
            const float gl[16] = {bf_lo(rg0.x), bf_hi(rg0.x), bf_lo(rg0.y), bf_hi(rg0.y), bf_lo(rg0.z), bf_hi(rg0.z), bf_lo(rg0.w), bf_hi(rg0.w), \
                                  bf_lo(rg1.x), bf_hi(rg1.x), bf_lo(rg1.y), bf_hi(rg1.y), bf_lo(rg1.z), bf_hi(rg1.z), bf_lo(rg1.w), bf_hi(rg1.w)}; \
            _Pragma("unroll") for (int r_ = 0; r_ < 16; ++r_) { const f32x4 wv = *(const LAS f32x4*)(Lf + O_W2 + r_ * 128 + dq); z = z + wv * gl[r_]; } \
            _Pragma("unroll") for (int i_ = 0; i_ < 4; ++i_) { q4[i_] = xq[i_] * 0.08838834764831845f; k4[i_] = xk[i_]; e4[i_] = __builtin_amdgcn_exp2f(-0.0625f * __builtin_amdgcn_logf(1.0f + __expf(-z[i_]))); } } \
        else { _Pragma("unroll") for (int i_ = 0; i_ < 4; ++i_) { const float fg = lb[i_] + (1.f - lb[i_]) * sigmoidf_(xk[i_]); q4[i_] = siluf_(xq[i_]); k4[i_] = 1.f - fg; e4[i_] = fg; } } \
        *(LAS f32x4*)(B_ + O_E + tl * 128 + dq) = e4; *(LAS f32x4*)(B_ + O_K + tl * 128 + dq) = k4; *(LAS f32x4*)(B_ + O_Q + tl * 128 + dq) = q4; \
        { f32x4 v4 = {bf_lo(rv.x), bf_hi(rv.x), bf_lo(rv.y), bf_hi(rv.y)}; *(LAS f32x4*)(B_ + O_V + tl * 128 + dq) = v4; } } while (0)
    LBAR();
    GM_LOAD(0); GM_XFORM(0); GM_LOAD(1);
    LBAR();
    f32x4 Sacc[8];
#pragma unroll
    for (int i = 0; i < 8; ++i) Sacc[i] = (f32x4){0.f, 0.f, 0.f, 0.f};
    const int fr = lane & 15, g = lane >> 4, c0 = w * 16;
    for (int c = 0; c < NCHUNK; ++c) {
        const LAS float* B_ = Lf + (c & 1) * BUFSZ;
        {
            const int seg = tid >> 7, d = tid & 127;
            float bt = 1.f, ball = 1.f;
#pragma unroll
            for (int t = 0; t < 16; ++t) { const float e = B_[O_E + t * 128 + d]; ball *= e; if (t < 4 * seg) bt = ball; }
            ball = fmaxf(ball, 1e-30f);
            unsigned short kt4[4];
#pragma unroll
            for (int i = 0; i < 4; ++i) { const int t = 4 * seg + i; bt = fmaxf(bt * B_[O_E + t * 128 + d], 1e-30f);
                const float kk = B_[O_K + t * 128 + d], qq = B_[O_Q + t * 128 + d], ib = __builtin_amdgcn_rcpf(bt);
                QB[t * RS + d] = hw_bf(qq * bt); KB[t * RS + d] = hw_bf(kk * ib); kt4[i] = (unsigned short)hw_bf(kk * ball * ib); }
            u32x2 kw; kw.x = (unsigned)kt4[0] | ((unsigned)kt4[1] << 16); kw.y = (unsigned)kt4[2] | ((unsigned)kt4[3] << 16);
            *(LAS u32x2*)(KT + d * 16 + 4 * seg) = kw;
            if (seg == 3) Lf[O_BL + d] = ball;
        }
        LBAR();
        if (w == 0) {
            f32x4 acc = {0.f, 0.f, 0.f, 0.f};
#pragma unroll
            for (int ks = 0; ks < 4; ++ks) { const bf16x8 af = *(const LAS bf16x8*)(QB + fr * RS + 32 * ks + 8 * g), bfm = *(const LAS bf16x8*)(KB + fr * RS + 32 * ks + 8 * g);
                acc = __builtin_amdgcn_mfma_f32_16x16x32_bf16(af, bfm, acc, 0, 0, 0); }
#pragma unroll
            for (int r = 0; r < 4; ++r) { const int t = 4 * g + r, s = fr; AM[t * 16 + s] = hw_bf(s <= t ? acc[r] : 0.f); }
        }
        if (c + 1 < NCHUNK) GM_XFORM((c + 1) & 1);
        if (c + 2 < NCHUNK) GM_LOAD(c + 2);
        LBAR();
        {
            u32x2 vlo; { const float v0 = B_[O_V + (4 * g + 0) * 128 + c0 + fr], v1 = B_[O_V + (4 * g + 1) * 128 + c0 + fr], v2 = B_[O_V + (4 * g + 2) * 128 + c0 + fr], v3 = B_[O_V + (4 * g + 3) * 128 + c0 + fr];
                vlo.x = hw_pk2(v0, v1); vlo.y = hw_pk2(v2, v3); }
            const u32x2 zz = {0u, 0u};
            const bf16x8 vb = mk_frag(vlo, zz);
            f32x4 acco = {0.f, 0.f, 0.f, 0.f};
#pragma unroll
            for (int ks = 0; ks < 4; ++ks) {
                u32x2 slo, shi; slo.x = hw_pk2(Sacc[2 * ks][0], Sacc[2 * ks][1]); slo.y = hw_pk2(Sacc[2 * ks][2], Sacc[2 * ks][3]); shi.x = hw_pk2(Sacc[2 * ks + 1][0], Sacc[2 * ks + 1][1]); shi.y = hw_pk2(Sacc[2 * ks + 1][2], Sacc[2 * ks + 1][3]);
                const bf16x8 sb = mk_frag(slo, shi);
                const u32x2 qlo = *(const LAS u32x2*)(QB + fr * RS + 32 * ks + 4 * g), qhi = *(const LAS u32x2*)(QB + fr * RS + 32 * ks + 16 + 4 * g);
                acco = __builtin_amdgcn_mfma_f32_16x16x32_bf16(mk_frag(qlo, qhi), sb, acco, 0, 0, 0); }
            { const u32x2 alo = *(const LAS u32x2*)(AM + fr * 16 + 4 * g); acco = __builtin_amdgcn_mfma_f32_16x16x32_bf16(mk_frag(alo, zz), vb, acco, 0, 0, 0); }
#pragma unroll
            for (int r = 0; r < 4; ++r) O[(size_t)(c * TC + 4 * g + r) * D + c0 + fr] = hw_bf(acco[r]);
#pragma unroll
            for (int i = 0; i < 8; ++i) { const f32x4 bl = *(const LAS f32x4*)(Lf + O_BL + 16 * i + 4 * g); const u32x2 klo = *(const LAS u32x2*)(KT + (16 * i + fr) * 16 + 4 * g);
                Sacc[i] = __builtin_amdgcn_mfma_f32_16x16x32_bf16(mk_frag(klo, zz), vb, Sacc[i] * bl, 0, 0, 0); }
        }
        LBAR();
    }
#undef GM_LOAD
#undef GM_XFORM
}

__device__ __forceinline__ void scan_gdn_mfma_unit(const Args& A, Frame& F, int unit, const int role) {
    int tid = F.tid; asm volatile("" : "+v"(tid));
    const int lane = tid & 63, w = F.wave;
    const int b = unit >> 3, h = unit & 7;
    const int qcol = EC_BQ + h * 128, kcol = EC_BK + h * 128, vcol = EC_BV + h * 128, ocol = 1024 + h * 128;
    const bf16* P = (const bf16*)(A.ws + WS_PROJ) + (size_t)b * SEQ * PROJ_LD;
    bf16* O = (bf16*)(A.ws + WS_O) + (size_t)b * SEQ * D + ocol;
    LAS float* Lf = (LAS float*)(F.lds + RING_OFF);
    constexpr int O_CW = 0, O_AMAT = 1536, O_QKM = O_AMAT + 256, O_TB = O_QKM + 128, O_GL = O_TB + 128, O_BUF0 = O_GL + 64;
    constexpr int BUFSZ = 6208, O_KH = 0, O_QH = 2048, O_VV = 4096, O_SC = 6144;
    constexpr int RS = 136;
    constexpr int O_KHB = O_BUF0 + 2 * BUFSZ, O_QHB = O_KHB + 1088, O_QB = O_QHB + 1088, O_KT = O_QB + 1088, O_WSRC = O_KT + 1024, O_WB = O_WSRC + 2048;
    LAS bf16* KHB = (LAS bf16*)(Lf + O_KHB); LAS bf16* QHB = (LAS bf16*)(Lf + O_QHB); LAS bf16* QB = (LAS bf16*)(Lf + O_QB); LAS bf16* KT = (LAS bf16*)(Lf + O_KT);
    LAS bf16* WB = (LAS bf16*)(Lf + O_WB); LAS bf16* QKM = (LAS bf16*)(Lf + O_QKM); LAS bf16* TB = (LAS bf16*)(Lf + O_TB);
    const int tl = tid >> 5, dq = (tid & 31) * 4;
    { const float* cw = A.in[I_GDN_CONV];
      for (int i = tid; i < 4 * 384; i += NTHREADS) { const int jt = i / 384, x = i % 384; Lf[O_CW + i] = cw[jt * 3072 + (x >> 7) * 1024 + h * 128 + (x & 127)]; } }
    const float neg_ea = -__expf(A.in[I_GDN_ALOG][h]), dtb = A.in[I_GDN_DTB][h];
    u32x2 rq[4], rk[4], rv[4]; unsigned short rba = 0, rbb = 0;
#define GD_LOAD(c) do { const int t_ = (c) * TC + tl; \
        _Pragma("unroll") for (int jt = 0; jt < 4; ++jt) { const int tt = t_ - 3 + jt; const bf16* pr = P + (size_t)(tt < 0 ? 0 : tt) * PROJ_LD + dq; \
            rq[jt] = *(const GAS u32x2*)(pr + qcol); rk[jt] = *(const GAS u32x2*)(pr + kcol); rv[jt] = *(const GAS u32x2*)(pr + vcol); \
            if (tt < 0) { rq[jt] = (u32x2){0u, 0u}; rk[jt] = (u32x2){0u, 0u}; rv[jt] = (u32x2){0u, 0u}; } } \
        { const bf16* pr = P + (size_t)t_ * PROJ_LD; rba = pr[EC_BA + h]; rbb = pr[EC_BB + h]; } } while (0)
#define GD_XFORM(bufi) do { LAS float* B_ = Lf + O_BUF0 + (bufi) * BUFSZ; f32x4 q4 = {0.f, 0.f, 0.f, 0.f}, k4 = {0.f, 0.f, 0.f, 0.f}, v4 = {0.f, 0.f, 0.f, 0.f}; \
        _Pragma("unroll") for (int jt = 0; jt < 4; ++jt) { const f32x4 wq = *(const LAS f32x4*)(Lf + O_CW + jt * 384 + dq), wk = *(const LAS f32x4*)(Lf + O_CW + jt * 384 + 128 + dq), wv = *(const LAS f32x4*)(Lf + O_CW + jt * 384 + 256 + dq); \
            q4[0] += wq[0] * bf_lo(rq[jt].x); q4[1] += wq[1] * bf_hi(rq[jt].x); q4[2] += wq[2] * bf_lo(rq[jt].y); q4[3] += wq[3] * bf_hi(rq[jt].y); \
            k4[0] += wk[0] * bf_lo(rk[jt].x); k4[1] += wk[1] * bf_hi(rk[jt].x); k4[2] += wk[2] * bf_lo(rk[jt].y); k4[3] += wk[3] * bf_hi(rk[jt].y); \
            v4[0] += wv[0] * bf_lo(rv[jt].x); v4[1] += wv[1] * bf_hi(rv[jt].x); v4[2] += wv[2] * bf_lo(rv[jt].y); v4[3] += wv[3] * bf_hi(rv[jt].y); } \
        float sq = 0.f, sk = 0.f; \
        _Pragma("unroll") for (int i_ = 0; i_ < 4; ++i_) { q4[i_] = siluf_(q4[i_]); k4[i_] = siluf_(k4[i_]); v4[i_] = siluf_(v4[i_]); sq += q4[i_] * q4[i_]; sk += k4[i_] * k4[i_]; } \
        row_sum16_x2(sq, sk); sq += __shfl_xor(sq, 16); sk += __shfl_xor(sk, 16); \
        q4 = q4 * (__builtin_amdgcn_rsqf(sq + EPS) * 0.08838834764831845f); k4 = k4 * __builtin_amdgcn_rsqf(sk + EPS); \
        *(LAS f32x4*)(B_ + O_KH + tl * 128 + dq) = k4; *(LAS f32x4*)(B_ + O_QH + tl * 128 + dq) = q4; *(LAS f32x4*)(B_ + O_VV + tl * 128 + dq) = v4; \
        if ((tid & 31) == 0) { const float ba = __uint_as_float((unsigned)rba << 16), bb = __uint_as_float((unsigned)rbb << 16); \
            B_[O_SC + tl] = __expf(neg_ea * softplusf_(ba + dtb)); B_[O_SC + 16 + tl] = sigmoidf_(bb); } } while (0)
    LBAR();
    constexpr int SPLIT = 58;
    const int c_begin = role ? SPLIT : 0, c_end = role ? NCHUNK : SPLIT;
    constexpr int REC = 5408;
    float* STASH = (float*)(A.ws + WS_LA) + (size_t)unit * (NCHUNK - SPLIT) * REC;
    float* STATE = (float*)(A.ws + WS_STATE) + (size_t)unit * 16384;
    gu32* flag = F.ctl + 32768 + unit * 64;
    GD_LOAD(c_begin); GD_XFORM(c_begin & 1); GD_LOAD(c_begin + 1);
    LBAR();
    f32x4 Sacc[8];
#pragma unroll
    for (int i = 0; i < 8; ++i) Sacc[i] = (f32x4){0.f, 0.f, 0.f, 0.f};
    const int fr = lane & 15, g = lane >> 4, c0 = w * 16;
    const u32x2 zz = {0u, 0u};
#define GD_STATE_PART(cc_) do { \
        { \
            bf16x8 sb[4]; \
_Pragma("unroll") \
            for (int ks = 0; ks < 4; ++ks) { u32x2 slo, shi; slo.x = hw_pk2(Sacc[2 * ks][0], Sacc[2 * ks][1]); slo.y = hw_pk2(Sacc[2 * ks][2], Sacc[2 * ks][3]); shi.x = hw_pk2(Sacc[2 * ks + 1][0], Sacc[2 * ks + 1][1]); shi.y = hw_pk2(Sacc[2 * ks + 1][2], Sacc[2 * ks + 1][3]); \
                sb[ks] = mk_frag(slo, shi); } \
            f32x4 accv = accu, acco = {0.f, 0.f, 0.f, 0.f}; \
_Pragma("unroll") \
            for (int ks = 0; ks < 4; ++ks) { \
                const u32x2 wl = *(const LAS u32x2*)(WB + fr * RS + 32 * ks + 4 * g), wh = *(const LAS u32x2*)(WB + fr * RS + 32 * ks + 16 + 4 * g); \
                accv = __builtin_amdgcn_mfma_f32_16x16x32_bf16(mk_frag(wl, wh), sb[ks], accv, 0, 0, 0); \
                const u32x2 ql = *(const LAS u32x2*)(QB + fr * RS + 32 * ks + 4 * g), qh = *(const LAS u32x2*)(QB + fr * RS + 32 * ks + 16 + 4 * g); \
                acco = __builtin_amdgcn_mfma_f32_16x16x32_bf16(mk_frag(ql, qh), sb[ks], acco, 0, 0, 0); } \
            u32x2 vn; vn.x = hw_pk2(accv[0], accv[1]); vn.y = hw_pk2(accv[2], accv[3]); \
            const bf16x8 vnb = mk_frag(vn, zz); \
            acco = __builtin_amdgcn_mfma_f32_16x16x32_bf16(mk_frag(*(const LAS u32x2*)(QKM + fr * 16 + 4 * g), zz), vnb, acco, 0, 0, 0); \
_Pragma("unroll") \
            for (int r = 0; r < 4; ++r) O[(size_t)((cc_) * TC + 4 * g + r) * D + c0 + fr] = hw_bf(acco[r]); \
_Pragma("unroll") \
            for (int i = 0; i < 8; ++i) { const u32x2 klo = *(const LAS u32x2*)(KT + (16 * i + fr) * 16 + 4 * g); \
                Sacc[i] = __builtin_amdgcn_mfma_f32_16x16x32_bf16(mk_frag(klo, zz), vnb, Sacc[i] * glast, 0, 0, 0); } \
        } \
        } while (0)
    for (int c = c_begin; c < c_end; ++c) {
        const LAS float* B_ = Lf + O_BUF0 + (c & 1) * BUFSZ;
        float glast;
        {
            const int seg = tid >> 7, d = tid & 127;
            const f32x4 a0 = *(const LAS f32x4*)(B_ + O_SC), a1 = *(const LAS f32x4*)(B_ + O_SC + 4), a2 = *(const LAS f32x4*)(B_ + O_SC + 8), a3 = *(const LAS f32x4*)(B_ + O_SC + 12);
            const float av[16] = {a0[0], a0[1], a0[2], a0[3], a1[0], a1[1], a1[2], a1[3], a2[0], a2[1], a2[2], a2[3], a3[0], a3[1], a3[2], a3[3]};
            float p = 1.f, gpre = 1.f;
#pragma unroll
            for (int t = 0; t < 16; ++t) { if (t == 4 * seg) gpre = p; p *= av[t]; }
            glast = p;
            unsigned short kt4[4]; float gt = gpre;
#pragma unroll
            for (int i = 0; i < 4; ++i) { const int t = 4 * seg + i; const float at = (seg == 0) ? av[i] : (seg == 1) ? av[4 + i] : (seg == 2) ? av[8 + i] : av[12 + i]; gt *= at; const float beta = B_[O_SC + 16 + t];
                const float kk = B_[O_KH + t * 128 + d], qq = B_[O_QH + t * 128 + d];
                KHB[t * RS + d] = hw_bf(kk); QHB[t * RS + d] = hw_bf(qq); QB[t * RS + d] = hw_bf(qq * gt);
                kt4[i] = (unsigned short)hw_bf(kk * glast * __builtin_amdgcn_rcpf(gt));
                Lf[O_WSRC + t * 128 + d] = kk * (beta * gt);
                if (d == 0) Lf[O_GL + t] = gt; }
            u32x2 kw; kw.x = (unsigned)kt4[0] | ((unsigned)kt4[1] << 16); kw.y = (unsigned)kt4[2] | ((unsigned)kt4[3] << 16);
            *(LAS u32x2*)(KT + d * 16 + 4 * seg) = kw;
        }
        LBAR();
        if (w < 2) {
            const LAS bf16* AS = (w == 0) ? KHB : QHB;
            f32x4 acc = {0.f, 0.f, 0.f, 0.f};
#pragma unroll
            for (int ks = 0; ks < 4; ++ks) { const bf16x8 af = *(const LAS bf16x8*)(AS + fr * RS + 32 * ks + 8 * g), bfm = *(const LAS bf16x8*)(KHB + fr * RS + 32 * ks + 8 * g);
                acc = __builtin_amdgcn_mfma_f32_16x16x32_bf16(af, bfm, acc, 0, 0, 0); }
            const float gs_inv = __builtin_amdgcn_rcpf(Lf[O_GL + fr]);
            if (w == 0) {
                f32x4 N1, M1;
#pragma unroll
                for (int r = 0; r < 4; ++r) { const int t = 4 * g + r; const float gt = Lf[O_GL + t];
                    N1[r] = (fr < t) ? -(B_[O_SC + 16 + t] * acc[r] * gt * gs_inv) : 0.f;
                    M1[r] = (t < fr) ? -(B_[O_SC + 16 + fr] * acc[r] * Lf[O_GL + fr] * __builtin_amdgcn_rcpf(gt)) : 0.f; }
#define XTY(X, Y, C0) __builtin_amdgcn_mfma_f32_16x16x32_bf16(mk_frag((u32x2){hw_pk2(X[0], X[1]), hw_pk2(X[2], X[3])}, zz), mk_frag((u32x2){hw_pk2(Y[0], Y[1]), hw_pk2(Y[2], Y[3])}, zz), C0, 0, 0, 0)
                const f32x4 z4 = {0.f, 0.f, 0.f, 0.f};
                f32x4 T1t = M1;
#pragma unroll
                for (int r = 0; r < 4; ++r) if (4 * g + r == fr) T1t[r] += 1.f;
                const f32x4 N2 = XTY(M1, N1, z4), M2 = XTY(N1, M1, z4);
                const f32x4 T2t = XTY(N2, T1t, T1t);
                const f32x4 N4 = XTY(M2, N2, z4), M4 = XTY(N2, M2, z4);
                const f32x4 T4t = XTY(N4, T2t, T2t);
                const f32x4 N8 = XTY(M4, N4, z4);
                const f32x4 T8t = XTY(N8, T4t, T4t);
#undef XTY
                u32x2 tw; tw.x = hw_pk2(T8t[0], T8t[1]); tw.y = hw_pk2(T8t[2], T8t[3]);
                *(LAS u32x2*)(TB + fr * 16 + 4 * g) = tw;
            } else {
#pragma unroll
                for (int r = 0; r < 4; ++r) { const int t = 4 * g + r; QKM[t * 16 + fr] = hw_bf((fr <= t) ? acc[r] * Lf[O_GL + t] * gs_inv : 0.f); }
            }
        }
        if (c + 1 < c_end) GD_XFORM((c + 1) & 1);
        if (c + 2 < c_end) GD_LOAD(c + 2);
        LBAR();
        f32x4 accu = {0.f, 0.f, 0.f, 0.f};
        {
            const bf16x8 tf = mk_frag(*(const LAS u32x2*)(TB + fr * 16 + 4 * g), zz);
            u32x2 ulo, wlo;
            { const float b0 = B_[O_SC + 16 + 4 * g + 0], b1 = B_[O_SC + 16 + 4 * g + 1], b2 = B_[O_SC + 16 + 4 * g + 2], b3 = B_[O_SC + 16 + 4 * g + 3];
              ulo.x = hw_pk2(b0 * B_[O_VV + (4 * g + 0) * 128 + c0 + fr], b1 * B_[O_VV + (4 * g + 1) * 128 + c0 + fr]); ulo.y = hw_pk2(b2 * B_[O_VV + (4 * g + 2) * 128 + c0 + fr], b3 * B_[O_VV + (4 * g + 3) * 128 + c0 + fr]);
              wlo.x = hw_pk2(Lf[O_WSRC + (4 * g + 0) * 128 + c0 + fr], Lf[O_WSRC + (4 * g + 1) * 128 + c0 + fr]); wlo.y = hw_pk2(Lf[O_WSRC + (4 * g + 2) * 128 + c0 + fr], Lf[O_WSRC + (4 * g + 3) * 128 + c0 + fr]); }
            accu = __builtin_amdgcn_mfma_f32_16x16x32_bf16(tf, mk_frag(ulo, zz), accu, 0, 0, 0);
            f32x4 accw = {0.f, 0.f, 0.f, 0.f};
            accw = __builtin_amdgcn_mfma_f32_16x16x32_bf16(tf, mk_frag(wlo, zz), accw, 0, 0, 0);
#pragma unroll
            for (int r = 0; r < 4; ++r) WB[(4 * g + r) * RS + c0 + fr] = hw_bf(-accw[r]);
        }
        LBAR();
        if (role == 0) {
            GD_STATE_PART(c);
        } else {
            float* rec = STASH + (size_t)(c - c_begin) * REC;
            for (int i = tid; i < 832; i += NTHREADS) { const int o = i < 528 ? O_QB + 4 * i : (i < 800 ? O_WB + 4 * (i - 528) : O_QKM + 4 * (i - 800)); *(GAS f32x4*)(rec + 4 * i) = *(const LAS f32x4*)(Lf + o); }
#pragma unroll
            for (int r = 0; r < 4; ++r) rec[3328 + (w * 4 + r) * 64 + lane] = accu[r];
            if (tid == 0) rec[5376] = glast;
        }
        LBAR();
    }
    if (role == 0) {
#pragma unroll
        for (int i = 0; i < 8; ++i)
#pragma unroll
            for (int r = 0; r < 4; ++r) STATE[((w * 8 + i) * 4 + r) * 64 + lane] = Sacc[i][r];
        asm volatile("s_waitcnt vmcnt(0)" ::: "memory");
        __syncthreads();
        if (tid == 0) { __builtin_amdgcn_fence(__ATOMIC_RELEASE, "agent"); asm volatile("s_waitcnt vmcnt(0)" ::: "memory"); __hip_atomic_store(flag, 1u, __ATOMIC_RELAXED, __HIP_MEMORY_SCOPE_AGENT); }
    } else {
        if (tid == 0) { unsigned sp = 0; while (__hip_atomic_load(flag, __ATOMIC_RELAXED, __HIP_MEMORY_SCOPE_AGENT) == 0u) { __builtin_amdgcn_s_sleep(8); if (++sp > (1u << 22)) break; }
            __builtin_amdgcn_fence(__ATOMIC_ACQUIRE, "agent"); asm volatile("s_waitcnt vmcnt(0)" ::: "memory"); }
        __syncthreads();
#pragma unroll
        for (int i = 0; i < 8; ++i)
#pragma unroll
            for (int r = 0; r < 4; ++r) Sacc[i][r] = STATE[((w * 8 + i) * 4 + r) * 64 + lane];
        f32x4 pa, pb; f32x4 pu; float pg;
#define GD_REC_LOAD(cc) do { const float* rec = STASH + (size_t)((cc) - c_begin) * REC; pa = *(const GAS f32x4*)(rec + 4 * tid); pb = (tid < 320) ? *(const GAS f32x4*)(rec + 4 * (tid + 512)) : (f32x4){0.f, 0.f, 0.f, 0.f}; \
            _Pragma("unroll") for (int r = 0; r < 4; ++r) pu[r] = rec[3328 + (w * 4 + r) * 64 + lane]; pg = rec[5376]; } while (0)
        GD_REC_LOAD(c_begin);
        for (int c = c_begin; c < c_end; ++c) {
            { const int i0 = tid, o0 = i0 < 528 ? O_QB + 4 * i0 : O_WB + 4 * (i0 - 528); *(LAS f32x4*)(Lf + o0) = pa;
              if (tid < 320) { const int i1 = tid + 512; const int o1 = i1 < 528 ? O_QB + 4 * i1 : (i1 < 800 ? O_WB + 4 * (i1 - 528) : O_QKM + 4 * (i1 - 800)); *(LAS f32x4*)(Lf + o1) = pb; } }
            const f32x4 accu = pu; const float glast = pg;
            if (c + 1 < c_end) GD_REC_LOAD(c + 1);
            LBAR();
            GD_STATE_PART(c);
            LBAR();
        }
#undef GD_REC_LOAD
    }
#undef GD_STATE_PART
#undef GD_LOAD
#undef GD_XFORM
}

__device__ __forceinline__ void scan_rwkv_unit(const Args& A, Frame& F, int unit) {
    int tid = F.tid; asm volatile("" : "+v"(tid));
    const int lane = tid & 63, w = F.wave;
    const int b = unit >> 4, h = unit & 15;
    const bf16* P = (const bf16*)(A.ws + WS_PROJ) + (size_t)b * SEQ * PROJ_LD + OC_RW;
    const bf16* LO = (const bf16*)(A.ws + WS_LO) + (size_t)b * SEQ * LORA_N;
    bf16* Y = (bf16*)(A.ws + WS_ACTA) + (size_t)b * SEQ * D + 1024 + h * 64;
    LAS float* Lf = (LAS float*)(F.lds + RING_OFF);
    constexpr int BUFSZ = 6208, O_KK = 0, O_WR = 1024, O_W = 2048, O_NKA = 3072, O_K = 4096, O_V = 5120, O_SC = 6144, O_OUT = 2 * BUFSZ;
    const int tl = tid >> 5, d2 = (tid & 31) * 2, hd = h * 64 + d2;
    float mu_r[2], mu_k[2], mu_v[2], w0[2], a0[2], k_k[2], k_a[2], r_k[2], lnw[2], lnb[2];
#pragma unroll
    for (int i = 0; i < 2; ++i) { mu_r[i] = A.in[I_MU][RW_R + hd + i]; mu_k[i] = A.in[I_MU][RW_K + hd + i]; mu_v[i] = A.in[I_MU][RW_V + hd + i];
        w0[i] = A.in[I_W0][hd + i]; a0[i] = A.in[I_A0][hd + i]; k_k[i] = A.in[I_KK][hd + i]; k_a[i] = A.in[I_KA][hd + i]; r_k[i] = A.in[I_RK][hd + i];
        lnw[i] = A.in[I_LNW][hd + i]; lnb[i] = A.in[I_LNB][hd + i]; }
    unsigned rr[2], rk[2], rv[2], rlw, rla, rg_cur = 0u, rg_nxt = 0u;
#define RW_LOAD(c) do { const int t_ = (c) * TC + tl; const bf16* pr = P + (size_t)t_ * PROJ_LD; \
        rr[0] = *(const GAS unsigned*)(pr + RW_R + hd); rk[0] = *(const GAS unsigned*)(pr + RW_K + hd); rv[0] = *(const GAS unsigned*)(pr + RW_V + hd); \
        if (t_ > 0) { rr[1] = *(const GAS unsigned*)(pr - PROJ_LD + RW_R + hd); rk[1] = *(const GAS unsigned*)(pr - PROJ_LD + RW_K + hd); rv[1] = *(const GAS unsigned*)(pr - PROJ_LD + RW_V + hd); } \
        else { rr[1] = 0u; rk[1] = 0u; rv[1] = 0u; } \
        const bf16* lr = LO + (size_t)t_ * LORA_N; rlw = *(const GAS unsigned*)(lr + hd); rla = *(const GAS unsigned*)(lr + 1024 + hd); rg_nxt = *(const GAS unsigned*)(lr + 2048 + hd); } while (0)
#define RW_XFORM(bufi) do { LAS float* B_ = Lf + (bufi) * BUFSZ; f32x2 kk2, wr2, w2_, nka2, k2, v2_; float skk = 0.f, sc1 = 0.f, sc2 = 0.f, sbs = 0.f; float aa[2], rrv[2]; \
        _Pragma("unroll") for (int i_ = 0; i_ < 2; ++i_) { \
            const float r0 = i_ ? bf_hi(rr[0]) : bf_lo(rr[0]), r1 = i_ ? bf_hi(rr[1]) : bf_lo(rr[1]); \
            const float k0_ = i_ ? bf_hi(rk[0]) : bf_lo(rk[0]), k1_ = i_ ? bf_hi(rk[1]) : bf_lo(rk[1]); \
            const float v0_ = i_ ? bf_hi(rv[0]) : bf_lo(rv[0]), v1_ = i_ ? bf_hi(rv[1]) : bf_lo(rv[1]); \
            const float lw = i_ ? bf_hi(rlw) : bf_lo(rlw), la = i_ ? bf_hi(rla) : bf_lo(rla); \
            const float r_ = r0 + (r1 - r0) * mu_r[i_], kx = k0_ + (k1_ - k0_) * mu_k[i_], vx = v0_ + (v1_ - v0_) * mu_v[i_]; \
            const float wd = __expf(-0.6065306597126334f * sigmoidf_(w0[i_] + lw)); const float a_ = sigmoidf_(a0[i_] + la); \
            const float kk0 = kx * k_k[i_]; const float km = kx * (1.f + (a_ - 1.f) * k_a[i_]); \
            kk2[i_] = kk0; skk += kk0 * kk0; aa[i_] = a_; rrv[i_] = r_; wr2[i_] = wd * r_; w2_[i_] = wd; k2[i_] = km; v2_[i_] = vx; sc2 += km * r_; sbs += r_ * km * r_k[i_]; } \
        skk = half_sum32(skk); const float rkk = __builtin_amdgcn_rsqf(skk + EPS); \
        _Pragma("unroll") for (int i_ = 0; i_ < 2; ++i_) { kk2[i_] *= rkk; nka2[i_] = -(kk2[i_] * aa[i_]); sc1 += kk2[i_] * aa[i_] * rrv[i_]; } \
        sc1 = half_sum32(sc1); sc2 = half_sum32(sc2); sbs = half_sum32(sbs); \
        *(LAS f32x2*)(B_ + O_KK + tl * 64 + d2) = kk2; *(LAS f32x2*)(B_ + O_WR + tl * 64 + d2) = wr2; *(LAS f32x2*)(B_ + O_W + tl * 64 + d2) = w2_; \
        *(LAS f32x2*)(B_ + O_NKA + tl * 64 + d2) = nka2; *(LAS f32x2*)(B_ + O_K + tl * 64 + d2) = k2; *(LAS f32x2*)(B_ + O_V + tl * 64 + d2) = v2_; \
        if ((tid & 31) == 0) { f32x4 sc; sc[0] = sc1; sc[1] = sc2; sc[2] = sbs; sc[3] = 0.f; *(LAS f32x4*)(B_ + O_SC + tl * 4) = sc; } } while (0)
    RW_LOAD(0); RW_XFORM(0); rg_cur = rg_nxt;
    LBAR();
    f32x2 S2[4];
#pragma unroll
    for (int i = 0; i < 4; ++i) S2[i] = (f32x2){0.f, 0.f};
    const int j = lane & 15, col = w * 8 + (lane >> 4) * 2;
    for (int c = 0; c < NCHUNK; ++c) {
        if (c + 1 < NCHUNK) RW_LOAD(c + 1);
        const LAS float* B_ = Lf + (c & 1) * BUFSZ;
        float os0 = 0.f, os1 = 0.f;
        f32x4 kk, wr, ww, nka, kv, sc, nkk, nwr, nww, nnka, nkv, nsc; f32x2 v2, nv2;
#define RW_LDSTEP(t_, KK, WR, WW, NKA, KV, V2, SC) do { KK = *(const LAS f32x4*)(B_ + O_KK + (t_) * 64 + 4 * j); WR = *(const LAS f32x4*)(B_ + O_WR + (t_) * 64 + 4 * j); WW = *(const LAS f32x4*)(B_ + O_W + (t_) * 64 + 4 * j); \
            NKA = *(const LAS f32x4*)(B_ + O_NKA + (t_) * 64 + 4 * j); KV = *(const LAS f32x4*)(B_ + O_K + (t_) * 64 + 4 * j); V2 = *(const LAS f32x2*)(B_ + O_V + (t_) * 64 + col); SC = *(const LAS f32x4*)(B_ + O_SC + (t_) * 4); } while (0)
        RW_LDSTEP(0, kk, wr, ww, nka, kv, v2, sc);
#pragma unroll
        for (int t = 0; t < TC; ++t) {
            if (t + 1 < TC) { RW_LDSTEP(t + 1, nkk, nwr, nww, nnka, nkv, nv2, nsc); }
            __builtin_amdgcn_sched_barrier(0);
            f32x2 d1 = S2[0] * kk[0], d2 = S2[0] * wr[0], e1 = S2[1] * kk[1], e2 = S2[1] * wr[1];
            d1 += S2[2] * kk[2]; d2 += S2[2] * wr[2]; e1 += S2[3] * kk[3]; e2 += S2[3] * wr[3];
            d1 += e1; d2 += e2;
            { float r0_ = d1[0], r1_ = d1[1], r2_ = d2[0], r3_ = d2[1]; row_sum16_x4(r0_, r1_, r2_, r3_); d1[0] = r0_; d1[1] = r1_; d2[0] = r2_; d2[1] = r3_; }
            const f32x2 o2 = d2 - d1 * sc[0] + v2 * sc[1];
#pragma unroll
            for (int i = 0; i < 4; ++i) S2[i] = S2[i] * ww[i] + d1 * nka[i] + v2 * kv[i];
            os0 = (j == t) ? o2[0] : os0; os1 = (j == t) ? o2[1] : os1;
            kk = nkk; wr = nwr; ww = nww; nka = nnka; kv = nkv; v2 = nv2; sc = nsc;
        }
#undef RW_LDSTEP
        { f32x2 o2 = {os0, os1}; *(LAS f32x2*)(Lf + O_OUT + j * 64 + col) = o2; }
        if (c + 1 < NCHUNK) RW_XFORM((c + 1) & 1);
        LBAR();
        {
            const f32x2 o2 = *(const LAS f32x2*)(Lf + O_OUT + tl * 64 + d2); const f32x2 vv = *(const LAS f32x2*)(B_ + O_V + tl * 64 + d2); const float bs = B_[O_SC + tl * 4 + 2];
            const float mean = half_sum32(o2[0] + o2[1]) * (1.0f / 64.0f); const float e0 = o2[0] - mean, e1 = o2[1] - mean;
            const float var = half_sum32(e0 * e0 + e1 * e1) * (1.0f / 64.0f); const float rs = __builtin_amdgcn_rsqf(var + 64e-5f);
            const float y0 = (e0 * rs * lnw[0] + lnb[0] + bs * vv[0]) * bf_lo(rg_cur), y1 = (e1 * rs * lnw[1] + lnb[1] + bs * vv[1]) * bf_hi(rg_cur);
            *(GAS unsigned*)(Y + (size_t)(c * TC + tl) * D + d2) = pk2(y0, y1);
        }
        rg_cur = rg_nxt;
        LBAR();
    }
#undef RW_LOAD
#undef RW_XFORM
}

template <int LAYER>
__device__ __forceinline__ void post_rows(const Args& A, Frame& F) {
    const int gw = F.vcu * NWAVES + F.wave, NGW = F.G * NWAVES, lane = F.lane;
    const bf16* O = (const bf16*)(A.ws + WS_O); const bf16* P = (const bf16*)(A.ws + WS_PROJ); bf16* Y = (bf16*)(A.ws + WS_ACTA);
    for (int m = gw; m < T; m += NGW) {
        const GAS u32x2* orow = (const GAS u32x2*)(O + (size_t)m * D) + lane; const bf16* prow = P + (size_t)m * PROJ_LD;
        constexpr int NJ = LAYER == 0 ? 8 : 4;
#pragma unroll
        for (int jj = 0; jj < NJ; ++jj) {
            const u32x2 ow_ = orow[64 * jj]; const f32x4 v = {bf_lo(ow_.x), bf_hi(ow_.x), bf_lo(ow_.y), bf_hi(ow_.y)}; float ss = (v[0] * v[0] + v[1] * v[1]) + (v[2] * v[2] + v[3] * v[3]);
            const bool wide = (LAYER == 0 && jj < 4);
            const float ms = wide ? wave_sum(ss) * (1.0f / 256.0f) : half_sum32(ss) * (1.0f / 128.0f);
            const float r = __builtin_amdgcn_rsqf(ms + EPS);
            const int cih = wide ? 4 * lane : 4 * (lane & 31);
            const float* gsrc = LAYER == 0 ? (wide ? A.in[I_GLA_NORM] : A.in[I_GDN_NORM]) : A.in[I_HG_NORM];
            const f32x4 g = *(const GAS f32x4*)(gsrc + cih);
            const int zcol = LAYER == 0 ? (wide ? EC_GZ + jj * 256 + 4 * lane : EC_BZ + (jj - 4) * 256 + 4 * lane) : OC_HG + jj * 256 + 4 * lane;
            const u32x2 zw = *(const GAS u32x2*)(prow + zcol);
            const float y0 = v[0] * r * g[0] * siluf_(bf_lo(zw.x)), y1 = v[1] * r * g[1] * siluf_(bf_hi(zw.x)), y2 = v[2] * r * g[2] * siluf_(bf_lo(zw.y)), y3 = v[3] * r * g[3] * siluf_(bf_hi(zw.y));
            if constexpr (LAYER == 1) { int o8 = __builtin_amdgcn_cvt_pk_fp8_f32(y0, y1, 0, false); o8 = __builtin_amdgcn_cvt_pk_fp8_f32(y2, y3, o8, true);
                *(GAS unsigned*)((unsigned char*)Y + (size_t)m * D + 256 * jj + 4 * lane) = (unsigned)o8; }
            else { u32x2 o; o.x = pk2(y0, y1); o.y = pk2(y2, y3);
                *(GAS u32x2*)(Y + (size_t)m * D + 256 * jj + 4 * lane) = o; }
        }
    }
}
__device__ __forceinline__ void lora_prep_rows(const Args& A, Frame& F) {
    const int gw = F.vcu * NWAVES + F.wave, NGW = F.G * NWAVES, lane = F.lane;
    const bf16* P = (const bf16*)(A.ws + WS_PROJ); bf16* LA = (bf16*)(A.ws + WS_LA); const float* mu = A.in[I_MU];
    for (int m = gw; m < T; m += NGW) { const bool hasprev = (m % SEQ) != 0; const bf16* prow = P + (size_t)m * PROJ_LD + OC_RW + RW_WL;
#pragma unroll
        for (int i = 0; i < 7; ++i) { const int c = lane + 64 * i;
            const float x = __uint_as_float((unsigned)prow[c] << 16), xp = hasprev ? __uint_as_float((unsigned)prow[c - PROJ_LD] << 16) : 0.f;
            const float ts = x + (xp - x) * mu[RW_WL + c];
            const float v = c < 96 ? tanhf(ts) : (c < 192 ? ts : sigmoidf_(ts));
            LA[(size_t)m * LORA_K + c] = (bf16)f2bf(v); }
        LA[(size_t)m * LORA_K + 448 + lane] = (bf16)0; }
}
__device__ __forceinline__ void final_rows(const Args& A, Frame& F, const float oscale, const bf16* Hs) {
    const int gw = F.vcu * NWAVES + F.wave, NGW = F.G * NWAVES, lane = F.lane;
    const float* rowss = (const float*)(A.ws + WS_RSP) + (size_t)RS_FINAL * T * 32; const GAS f32x4* g = (const GAS f32x4*)A.in[I_NFINAL] + lane;
    for (int m = gw; m < T; m += NGW) { const float r = oscale * __builtin_amdgcn_rsqf(wave_sum(lane < 32 ? rowss[(size_t)m * 32 + lane] : 0.f) * (1.0f / D) + EPS); GAS f32x4* row = (GAS f32x4*)(A.out + (size_t)m * D) + lane;
        const GAS u32x2* hrow = (const GAS u32x2*)(Hs + (size_t)m * D) + lane;
#pragma unroll
        for (int jj = 0; jj < 8; ++jj) { const u32x2 hw = hrow[64 * jj]; const f32x4 v = {bf_lo(hw.x), bf_hi(hw.x), bf_lo(hw.y), bf_hi(hw.y)}; row[64 * jj] = v * r * g[64 * jj]; } }
}

__device__ __forceinline__ void scan_rwkv_mfma_unit(const Args& A, Frame& F, int unit, const int role) {
    int tid = F.tid; asm volatile("" : "+v"(tid));
    const int lane = tid & 63, w = F.wave;
    const int b = unit >> 3, hp = unit & 7;
    const bf16* P = (const bf16*)(A.ws + WS_PROJ) + (size_t)b * SEQ * PROJ_LD + OC_RW;
    const bf16* LO = (const bf16*)(A.ws + WS_LO) + (size_t)b * SEQ * LORA_N;
    unsigned char* Y = (unsigned char*)(A.ws + WS_ACTA) + (size_t)b * SEQ * D + 1024;
    LAS float* Lf = (LAS float*)(F.lds + RING_OFF);
    constexpr int RS = 72;
    constexpr int O_CONST = 0;
    constexpr int O_XF = 1280;
    constexpr int O_VV = O_XF + 2 * 5 * 1024;
    constexpr int O_BS = O_VV + 4 * 1024;
    constexpr int O_IMG = O_BS + 64;
    constexpr int I_CT = 0, I_BT = 576, I_KL = 1152, I_RT = 1728, I_CF = 2304, I_BTT = 3328, I_KTT = 3840, I_WCB = 4352, I_G1B = 4928, I_TTB = 5056, I_RKB = 5184, I_RBB = 5312, I_W15 = 5440, I_OUT = 5504, IMGSZ = 6528;
    static_assert((O_IMG + 2 * IMGSZ) * 4 <= RING_BYTES, "rwkv lds");
    for (int i = tid; i < 1280; i += NTHREADS) { const int arr = i >> 7, ch = hp * 128 + (i & 127); float v;
        switch (arr) { case 0: v = A.in[I_MU][RW_R + ch]; break; case 1: v = A.in[I_MU][RW_K + ch]; break; case 2: v = A.in[I_MU][RW_V + ch]; break; case 3: v = A.in[I_W0][ch]; break; case 4: v = A.in[I_A0][ch]; break;
                       case 5: v = A.in[I_KK][ch]; break; case 6: v = A.in[I_KA][ch]; break; case 7: v = A.in[I_RK][ch]; break; case 8: v = A.in[I_LNW][ch]; break; default: v = A.in[I_LNB][ch]; break; }
        Lf[O_CONST + i] = v; }
    const int hx = tid >> 8, tl = (tid >> 4) & 15, d4 = (tid & 15) * 4, ch4 = hx * 64 + d4, col4 = hp * 128 + ch4;
    u32x2 rr[2], rk[2], rv[2], rlw, rla, rg_cur = {0u, 0u}, rg_nxt = {0u, 0u}, rg_far = {0u, 0u};
#define RM_LOAD(c) do { const int t_ = (c) * TC + tl; const bf16* pr = P + (size_t)t_ * PROJ_LD + col4; \
        rr[0] = *(const GAS u32x2*)(pr + RW_R); rk[0] = *(const GAS u32x2*)(pr + RW_K); rv[0] = *(const GAS u32x2*)(pr + RW_V); \
        const bf16* pp_ = (t_ > 0) ? pr - PROJ_LD : pr; rr[1] = *(const GAS u32x2*)(pp_ + RW_R); rk[1] = *(const GAS u32x2*)(pp_ + RW_K); rv[1] = *(const GAS u32x2*)(pp_ + RW_V); \
        if (t_ == 0) { rr[1] = (u32x2){0u, 0u}; rk[1] = (u32x2){0u, 0u}; rv[1] = (u32x2){0u, 0u}; } \
        const bf16* lr = LO + (size_t)t_ * LORA_N + col4; rlw = *(const GAS u32x2*)(lr); rla = *(const GAS u32x2*)(lr + 1024); rg_far = *(const GAS u32x2*)(lr + 2048); } while (0)
#define RM_XFORM(bufi) do { LAS float* X_ = Lf + O_XF + hx * 5 * 1024 + tl * 64 + d4; \
        const f32x4 mur = *(const LAS f32x4*)(Lf + O_CONST + 0 * 128 + ch4), muk = *(const LAS f32x4*)(Lf + O_CONST + 1 * 128 + ch4), muv = *(const LAS f32x4*)(Lf + O_CONST + 2 * 128 + ch4); \
        const f32x4 w0_ = *(const LAS f32x4*)(Lf + O_CONST + 3 * 128 + ch4), a0_ = *(const LAS f32x4*)(Lf + O_CONST + 4 * 128 + ch4), kk_ = *(const LAS f32x4*)(Lf + O_CONST + 5 * 128 + ch4); \
        const f32x4 ka_ = *(const LAS f32x4*)(Lf + O_CONST + 6 * 128 + ch4), rk_ = *(const LAS f32x4*)(Lf + O_CONST + 7 * 128 + ch4); \
        const float r0[4] = {bf_lo(rr[0].x), bf_hi(rr[0].x), bf_lo(rr[0].y), bf_hi(rr[0].y)}, r1[4] = {bf_lo(rr[1].x), bf_hi(rr[1].x), bf_lo(rr[1].y), bf_hi(rr[1].y)}; \
        const float k0[4] = {bf_lo(rk[0].x), bf_hi(rk[0].x), bf_lo(rk[0].y), bf_hi(rk[0].y)}, k1[4] = {bf_lo(rk[1].x), bf_hi(rk[1].x), bf_lo(rk[1].y), bf_hi(rk[1].y)}; \
        const float v0[4] = {bf_lo(rv[0].x), bf_hi(rv[0].x), bf_lo(rv[0].y), bf_hi(rv[0].y)}, v1[4] = {bf_lo(rv[1].x), bf_hi(rv[1].x), bf_lo(rv[1].y), bf_hi(rv[1].y)}; \
        const float lw[4] = {bf_lo(rlw.x), bf_hi(rlw.x), bf_lo(rlw.y), bf_hi(rlw.y)}, la[4] = {bf_lo(rla.x), bf_hi(rla.x), bf_lo(rla.y), bf_hi(rla.y)}; \
        f32x4 r4, w4, k4, v4, kk4, b4; float skk = 0.f, sbs = 0.f; float aa[4]; \
        _Pragma("unroll") for (int i_ = 0; i_ < 4; ++i_) { const float r_ = r0[i_] + (r1[i_] - r0[i_]) * mur[i_], kx = k0[i_] + (k1[i_] - k0[i_]) * muk[i_], vx = v0[i_] + (v1[i_] - v0[i_]) * muv[i_]; \
            const float wd = __expf(-0.6065306597126334f * sigmoidf_(w0_[i_] + lw[i_])); const float a_ = sigmoidf_(a0_[i_] + la[i_]); \
            const float kk0 = kx * kk_[i_], km = kx * (1.f + (a_ - 1.f) * ka_[i_]); \
            r4[i_] = r_; w4[i_] = wd; k4[i_] = km; v4[i_] = vx; kk4[i_] = kk0; aa[i_] = a_; skk += kk0 * kk0; sbs += r_ * km * rk_[i_]; } \
        row_sum16_x2(skk, sbs); const float rkk = __builtin_amdgcn_rsqf(skk + EPS); \
        _Pragma("unroll") for (int i_ = 0; i_ < 4; ++i_) { kk4[i_] *= rkk; b4[i_] = kk4[i_] * aa[i_]; } \
        *(LAS f32x4*)(X_) = r4; *(LAS f32x4*)(X_ + 1024) = w4; *(LAS f32x4*)(X_ + 2048) = k4; *(LAS f32x4*)(X_ + 3072) = kk4; *(LAS f32x4*)(X_ + 4096) = b4; \
        *(LAS f32x4*)(Lf + O_VV + ((bufi) * 2 + hx) * 1024 + tl * 64 + d4) = v4; \
        if ((tid & 15) == 0) Lf[O_BS + ((bufi) * 2 + hx) * 16 + tl] = sbs; } while (0)
    constexpr int SPLIT = 60;
    const int c_begin = role ? SPLIT : 0, c_end = role ? NCHUNK : SPLIT;
    constexpr int REC = 7584;
    float* STASH = (float*)(A.ws + (unit < 32 ? WS_WEV_IN : WS_END)) + (size_t)(unit & 31) * (NCHUNK - SPLIT) * REC;
    float* STATE = (float*)(A.ws + WS_STATE + 4 * MiB) + (size_t)unit * 8192;
    gu32* flag = F.ctl + 49152 + unit * 64;
    LBAR();
    RM_LOAD(c_begin); RM_XFORM(c_begin & 1); rg_cur = rg_far; RM_LOAD(c_begin + 1); rg_nxt = rg_far;
    LBAR();
    f32x4 Macc[4];
#pragma unroll
    for (int i = 0; i < 4; ++i) Macc[i] = (f32x4){0.f, 0.f, 0.f, 0.f};
    const int fr = lane & 15, g = lane >> 4, hh = w >> 2, ww = w & 3, c0 = ww * 16;
    LAS float* IM = Lf + O_IMG + hh * IMGSZ;
    LAS bf16* CT = (LAS bf16*)(IM + I_CT); LAS bf16* BT = (LAS bf16*)(IM + I_BT); LAS bf16* KL = (LAS bf16*)(IM + I_KL); LAS bf16* RT = (LAS bf16*)(IM + I_RT);
    LAS bf16* BTT = (LAS bf16*)(IM + I_BTT); LAS bf16* KTT = (LAS bf16*)(IM + I_KTT); LAS bf16* WCB = (LAS bf16*)(IM + I_WCB);
    LAS bf16* G1B = (LAS bf16*)(IM + I_G1B); LAS bf16* TTB = (LAS bf16*)(IM + I_TTB); LAS bf16* RKB = (LAS bf16*)(IM + I_RKB); LAS bf16* RBB = (LAS bf16*)(IM + I_RBB);
    const u32x2 zz = {0u, 0u};
#define RM_STATE_PART(vb) do { \
        { \
            bf16x8 mb[2]; \
_Pragma("unroll") \
            for (int ks = 0; ks < 2; ++ks) { u32x2 slo, shi; slo.x = hw_pk2(Macc[2 * ks][0], Macc[2 * ks][1]); slo.y = hw_pk2(Macc[2 * ks][2], Macc[2 * ks][3]); shi.x = hw_pk2(Macc[2 * ks + 1][0], Macc[2 * ks + 1][1]); shi.y = hw_pk2(Macc[2 * ks + 1][2], Macc[2 * ks + 1][3]); \
                mb[ks] = mk_frag(slo, shi); } \
            f32x4 accR = accU, acco = {0.f, 0.f, 0.f, 0.f}; \
_Pragma("unroll") \
            for (int ks = 0; ks < 2; ++ks) { \
                accR = __builtin_amdgcn_mfma_f32_16x16x32_bf16(mk_frag(*(const LAS u32x2*)(WCB + fr * RS + 32 * ks + 4 * g), *(const LAS u32x2*)(WCB + fr * RS + 32 * ks + 16 + 4 * g)), mb[ks], accR, 0, 0, 0); \
                acco = __builtin_amdgcn_mfma_f32_16x16x32_bf16(mk_frag(*(const LAS u32x2*)(RT + fr * RS + 32 * ks + 4 * g), *(const LAS u32x2*)(RT + fr * RS + 32 * ks + 16 + 4 * g)), mb[ks], acco, 0, 0, 0); } \
            u32x2 rn; rn.x = hw_pk2(accR[0], accR[1]); rn.y = hw_pk2(accR[2], accR[3]); \
            const bf16x8 rb = mk_frag(rn, zz); \
            acco = __builtin_amdgcn_mfma_f32_16x16x32_bf16(mk_frag(*(const LAS u32x2*)(RKB + fr * 16 + 4 * g), zz), vb, acco, 0, 0, 0); \
            acco = __builtin_amdgcn_mfma_f32_16x16x32_bf16(mk_frag(*(const LAS u32x2*)(RBB + fr * 16 + 4 * g), zz), rb, acco, 0, 0, 0); \
_Pragma("unroll") \
            for (int r = 0; r < 4; ++r) IM[I_OUT + (4 * g + r) * 64 + c0 + fr] = acco[r]; \
_Pragma("unroll") \
            for (int i = 0; i < 4; ++i) { const f32x4 w15 = *(const LAS f32x4*)(IM + I_W15 + 16 * i + 4 * g); \
                f32x4 m = __builtin_amdgcn_mfma_f32_16x16x32_bf16(mk_frag(*(const LAS u32x2*)(KTT + (16 * i + fr) * 16 + 4 * g), zz), vb, Macc[i], 0, 0, 0); \
                m = __builtin_amdgcn_mfma_f32_16x16x32_bf16(mk_frag(*(const LAS u32x2*)(BTT + (16 * i + fr) * 16 + 4 * g), zz), rb, m, 0, 0, 0); \
                Macc[i] = m * w15; } \
        } \
        } while (0)
#define RM_FLUSH(cc_, gb_, vv_, bs_) do { \
        { \
            const f32x4 o4 = *(const LAS f32x4*)(Lf + O_IMG + hx * IMGSZ + I_OUT + tl * 64 + d4); const f32x4 vv = (vv_); const float bs = (bs_); \
            const f32x4 lnw = *(const LAS f32x4*)(Lf + O_CONST + 8 * 128 + ch4), lnb = *(const LAS f32x4*)(Lf + O_CONST + 9 * 128 + ch4); \
            float sm = (o4[0] + o4[1]) + (o4[2] + o4[3]), dummy = 0.f; row_sum16_x2(sm, dummy); const float mean = sm * (1.0f / 64.0f); \
            const f32x4 e4 = o4 - mean; float sv = (e4[0] * e4[0] + e4[1] * e4[1]) + (e4[2] * e4[2] + e4[3] * e4[3]); row_sum16_x2(sv, dummy); const float rs = __builtin_amdgcn_rsqf(sv * (1.0f / 64.0f) + 64e-5f); \
            const float gg[4] = {bf_lo((gb_).x), bf_hi((gb_).x), bf_lo((gb_).y), bf_hi((gb_).y)}; \
            float y[4]; \
_Pragma("unroll") \
            for (int i = 0; i < 4; ++i) y[i] = (e4[i] * rs * lnw[i] + lnb[i] + bs * vv[i]) * gg[i]; \
            int o8 = __builtin_amdgcn_cvt_pk_fp8_f32(y[0], y[1], 0, false); o8 = __builtin_amdgcn_cvt_pk_fp8_f32(y[2], y[3], o8, true); \
            *(GAS unsigned*)(Y + (size_t)((cc_) * TC + tl) * D + col4) = (unsigned)o8; \
        } \
        } while (0)
    for (int c = c_begin; c < c_end; ++c) {
        {
            const int hq = tid >> 8, seg = (tid >> 6) & 3, d = tid & 63;
            const LAS float* X_ = Lf + O_XF + hq * 5 * 1024 + d; LAS float* IQ = Lf + O_IMG + hq * IMGSZ;
            LAS bf16* CTq = (LAS bf16*)(IQ + I_CT); LAS bf16* BTq = (LAS bf16*)(IQ + I_BT); LAS bf16* KLq = (LAS bf16*)(IQ + I_KL); LAS bf16* RTq = (LAS bf16*)(IQ + I_RT);
            float wall = 1.f, wpre = 1.f;
#pragma unroll
            for (int t = 0; t < 16; ++t) { if (t == 4 * seg) wpre = wall; wall *= X_[1024 + t * 64]; }
            float wt = wpre; unsigned short bt4[4], kt4[4];
#pragma unroll
            for (int i = 0; i < 4; ++i) { const int t = 4 * seg + i; const float wprev = wt; wt *= X_[1024 + t * 64]; const float iw = __builtin_amdgcn_rcpf(wt);
                const float r_ = X_[t * 64], k_ = X_[2048 + t * 64], kk_ = X_[3072 + t * 64], b_ = X_[4096 + t * 64];
                const float ct = kk_ * wprev, bt = b_ * iw, kt = k_ * iw;
                CTq[t * RS + d] = hw_bf(ct); IQ[I_CF + t * 64 + d] = ct; BTq[t * RS + d] = hw_bf(bt); KLq[t * RS + d] = hw_bf(kt); RTq[t * RS + d] = hw_bf(r_ * wt);
                bt4[i] = (unsigned short)hw_bf(-bt); kt4[i] = (unsigned short)hw_bf(kt); }
            u32x2 o; o.x = (unsigned)bt4[0] | ((unsigned)bt4[1] << 16); o.y = (unsigned)bt4[2] | ((unsigned)bt4[3] << 16); *(LAS u32x2*)((LAS bf16*)(IQ + I_BTT) + d * 16 + 4 * seg) = o;
            o.x = (unsigned)kt4[0] | ((unsigned)kt4[1] << 16); o.y = (unsigned)kt4[2] | ((unsigned)kt4[3] << 16); *(LAS u32x2*)((LAS bf16*)(IQ + I_KTT) + d * 16 + 4 * seg) = o;
            if (seg == 3) IQ[I_W15 + d] = wall;
        }
        LBAR();
        if (ww == 0) {
            f32x4 cb = {0.f, 0.f, 0.f, 0.f}, bc = cb, ck = cb, rkm = cb, rbm = cb;
#pragma unroll
            for (int ks = 0; ks < 2; ++ks) { const bf16x8 fc = *(const LAS bf16x8*)(CT + fr * RS + 32 * ks + 8 * g), fb = *(const LAS bf16x8*)(BT + fr * RS + 32 * ks + 8 * g), fk = *(const LAS bf16x8*)(KL + fr * RS + 32 * ks + 8 * g), frr = *(const LAS bf16x8*)(RT + fr * RS + 32 * ks + 8 * g);
                cb = __builtin_amdgcn_mfma_f32_16x16x32_bf16(fc, fb, cb, 0, 0, 0); bc = __builtin_amdgcn_mfma_f32_16x16x32_bf16(fb, fc, bc, 0, 0, 0); ck = __builtin_amdgcn_mfma_f32_16x16x32_bf16(fc, fk, ck, 0, 0, 0);
                rkm = __builtin_amdgcn_mfma_f32_16x16x32_bf16(frr, fk, rkm, 0, 0, 0); rbm = __builtin_amdgcn_mfma_f32_16x16x32_bf16(frr, fb, rbm, 0, 0, 0); }
            f32x4 N1, M1, CKm;
#pragma unroll
            for (int r = 0; r < 4; ++r) { const int t = 4 * g + r; N1[r] = (fr < t) ? -cb[r] : 0.f; M1[r] = (t < fr) ? -bc[r] : 0.f; CKm[r] = (fr < t) ? ck[r] : 0.f;
                RKB[t * 16 + fr] = hw_bf((fr <= t) ? rkm[r] : 0.f); RBB[t * 16 + fr] = hw_bf((fr <= t) ? -rbm[r] : 0.f); }
#define XTY(X, Y, C0) __builtin_amdgcn_mfma_f32_16x16x32_bf16(mk_frag((u32x2){hw_pk2(X[0], X[1]), hw_pk2(X[2], X[3])}, zz), mk_frag((u32x2){hw_pk2(Y[0], Y[1]), hw_pk2(Y[2], Y[3])}, zz), C0, 0, 0, 0)
            const f32x4 z4 = {0.f, 0.f, 0.f, 0.f};
            f32x4 T1t = M1;
#pragma unroll
            for (int r = 0; r < 4; ++r) if (4 * g + r == fr) T1t[r] += 1.f;
            const f32x4 N2 = XTY(M1, N1, z4), M2 = XTY(N1, M1, z4);
            const f32x4 T2t = XTY(N2, T1t, T1t);
            const f32x4 N4 = XTY(M2, N2, z4), M4 = XTY(N2, M2, z4);
            const f32x4 T4t = XTY(N4, T2t, T2t);
            const f32x4 N8 = XTY(M4, N4, z4);
            const f32x4 T8t = XTY(N8, T4t, T4t);
            const f32x4 G1t = XTY(CKm, T8t, z4);
#undef XTY
            u32x2 tw; tw.x = hw_pk2(T8t[0], T8t[1]); tw.y = hw_pk2(T8t[2], T8t[3]); *(LAS u32x2*)(TTB + fr * 16 + 4 * g) = tw;
            tw.x = hw_pk2(G1t[0], G1t[1]); tw.y = hw_pk2(G1t[2], G1t[3]); *(LAS u32x2*)(G1B + fr * 16 + 4 * g) = tw;
        }
        if (c + 1 < c_end) { RM_XFORM((c + 1) & 1); }
        if (c + 2 < c_end) RM_LOAD(c + 2);
        LBAR();
        const LAS float* VVc = Lf + O_VV + ((c & 1) * 2 + hh) * 1024;
        u32x2 vlo; { vlo.x = hw_pk2(VVc[(4 * g + 0) * 64 + c0 + fr], VVc[(4 * g + 1) * 64 + c0 + fr]); vlo.y = hw_pk2(VVc[(4 * g + 2) * 64 + c0 + fr], VVc[(4 * g + 3) * 64 + c0 + fr]); }
        const bf16x8 vb = mk_frag(vlo, zz);
        f32x4 accU = {0.f, 0.f, 0.f, 0.f};
        {
            accU = __builtin_amdgcn_mfma_f32_16x16x32_bf16(mk_frag(*(const LAS u32x2*)(G1B + fr * 16 + 4 * g), zz), vb, accU, 0, 0, 0);
            u32x2 clo; clo.x = hw_pk2(IM[I_CF + (4 * g + 0) * 64 + c0 + fr], IM[I_CF + (4 * g + 1) * 64 + c0 + fr]); clo.y = hw_pk2(IM[I_CF + (4 * g + 2) * 64 + c0 + fr], IM[I_CF + (4 * g + 3) * 64 + c0 + fr]);
            f32x4 accw = {0.f, 0.f, 0.f, 0.f};
            accw = __builtin_amdgcn_mfma_f32_16x16x32_bf16(mk_frag(*(const LAS u32x2*)(TTB + fr * 16 + 4 * g), zz), mk_frag(clo, zz), accw, 0, 0, 0);
#pragma unroll
            for (int r = 0; r < 4; ++r) WCB[(4 * g + r) * RS + c0 + fr] = hw_bf(accw[r]);
        }
        LBAR();
        if (role == 0) {
            RM_STATE_PART(vb);
            LBAR();
            RM_FLUSH(c, rg_cur, *(const LAS f32x4*)(Lf + O_VV + ((c & 1) * 2 + hx) * 1024 + tl * 64 + d4), Lf[O_BS + ((c & 1) * 2 + hx) * 16 + tl]);
        } else {
            float* rec = STASH + (size_t)(c - c_begin) * REC;
            for (int i = tid; i < 1376; i += NTHREADS) { const int hd = i >= 688, j = i - hd * 688; const int o = O_IMG + hd * IMGSZ + (j < 144 ? I_RT + 4 * j : I_BTT + 4 * (j - 144)); *(GAS f32x4*)(rec + 4 * i) = *(const LAS f32x4*)(Lf + o); }
            { GAS unsigned* ru = (GAS unsigned*)(rec + 5504); ru[(w * 2 + 0) * 64 + lane] = hw_pk2(accU[0], accU[1]); ru[(w * 2 + 1) * 64 + lane] = hw_pk2(accU[2], accU[3]); }
            { const f32x4 v4 = *(const LAS f32x4*)(Lf + O_VV + ((c & 1) * 2 + hx) * 1024 + tl * 64 + d4); u32x2 o; o.x = hw_pk2(v4[0], v4[1]); o.y = hw_pk2(v4[2], v4[3]); *(GAS u32x2*)(rec + 6528 + 2 * tid) = o; }
            if (tid < 32) rec[7552 + tid] = Lf[O_BS + (c & 1) * 32 + tid];
            LBAR();
        }
        rg_cur = rg_nxt; rg_nxt = rg_far;
    }
    if (role == 0) {
#pragma unroll
        for (int i = 0; i < 4; ++i)
#pragma unroll
            for (int r = 0; r < 4; ++r) STATE[((w * 4 + i) * 4 + r) * 64 + lane] = Macc[i][r];
        asm volatile("s_waitcnt vmcnt(0)" ::: "memory");
        __syncthreads();
        if (tid == 0) { __builtin_amdgcn_fence(__ATOMIC_RELEASE, "agent"); asm volatile("s_waitcnt vmcnt(0)" ::: "memory"); __hip_atomic_store(flag, 1u, __ATOMIC_RELAXED, __HIP_MEMORY_SCOPE_AGENT); }
    } else {
        if (tid == 0) { unsigned sp = 0; while (__hip_atomic_load(flag, __ATOMIC_RELAXED, __HIP_MEMORY_SCOPE_AGENT) == 0u) { __builtin_amdgcn_s_sleep(8); if (++sp > (1u << 22)) break; }
            __builtin_amdgcn_fence(__ATOMIC_ACQUIRE, "agent"); asm volatile("s_waitcnt vmcnt(0)" ::: "memory"); }
        __syncthreads();
#pragma unroll
        for (int i = 0; i < 4; ++i)
#pragma unroll
            for (int r = 0; r < 4; ++r) Macc[i][r] = STATE[((w * 4 + i) * 4 + r) * 64 + lane];
        f32x4 pi0, pi1, pi2; unsigned pu0, pu1; u32x2 pv, pgate; float pbs;
#define RM_REC_LOAD(cc) do { const float* rec = STASH + (size_t)((cc) - c_begin) * REC; pi0 = *(const GAS f32x4*)(rec + 4 * tid); pi1 = *(const GAS f32x4*)(rec + 4 * (tid + 512)); \
            pi2 = (tid < 352) ? *(const GAS f32x4*)(rec + 4 * (tid + 1024)) : (f32x4){0.f, 0.f, 0.f, 0.f}; \
            const GAS unsigned* ru = (const GAS unsigned*)(rec + 5504); pu0 = ru[(w * 2 + 0) * 64 + lane]; pu1 = ru[(w * 2 + 1) * 64 + lane]; pv = *(const GAS u32x2*)(rec + 6528 + 2 * tid); pbs = rec[7552 + hx * 16 + tl]; \
            pgate = *(const GAS u32x2*)(LO + (size_t)((cc) * TC + tl) * LORA_N + col4 + 2048); } while (0)
#define RM_IMG_OFF(i_) (O_IMG + ((i_) >= 688) * IMGSZ + ((((i_) - ((i_) >= 688) * 688) < 144) ? I_RT + 4 * ((i_) - ((i_) >= 688) * 688) : I_BTT + 4 * (((i_) - ((i_) >= 688) * 688) - 144)))
        RM_REC_LOAD(c_begin);
        for (int c = c_begin; c < c_end; ++c) {
            *(LAS f32x4*)(Lf + RM_IMG_OFF(tid)) = pi0; *(LAS f32x4*)(Lf + RM_IMG_OFF(tid + 512)) = pi1; if (tid < 352) *(LAS f32x4*)(Lf + RM_IMG_OFF(tid + 1024)) = pi2;
            const f32x4 vcur = {bf_lo(pv.x), bf_hi(pv.x), bf_lo(pv.y), bf_hi(pv.y)}; *(LAS f32x4*)(Lf + O_VV + hx * 1024 + tl * 64 + d4) = vcur;
            const f32x4 accU = {bf_lo(pu0), bf_hi(pu0), bf_lo(pu1), bf_hi(pu1)}; const float bscur = pbs; const u32x2 gcur = pgate;
            if (c + 1 < c_end) RM_REC_LOAD(c + 1);
            LBAR();
            const LAS float* VVc = Lf + O_VV + hh * 1024;
            u32x2 vlo; { vlo.x = hw_pk2(VVc[(4 * g + 0) * 64 + c0 + fr], VVc[(4 * g + 1) * 64 + c0 + fr]); vlo.y = hw_pk2(VVc[(4 * g + 2) * 64 + c0 + fr], VVc[(4 * g + 3) * 64 + c0 + fr]); }
            const bf16x8 vb = mk_frag(vlo, zz);
            RM_STATE_PART(vb);
            LBAR();
            RM_FLUSH(c, gcur, vcur, bscur);
            LBAR();
        }
#undef RM_REC_LOAD
#undef RM_IMG_OFF
    }
#undef RM_STATE_PART
#undef RM_FLUSH
#undef RM_LOAD
#undef RM_XFORM
}

__device__ __forceinline__ int med3i(int a, int b, int c) { int r; asm("v_med3_i32 %0, %1, %2, %3" : "=v"(r) : "v"(a), "v"(b), "v"(c)); return r; }
__device__ __forceinline__ int f2sort(float f) { int x = __float_as_int(f); return x ^ ((x >> 31) & 0x7fffffff); }
__device__ __forceinline__ float sort2f(int x) { return __int_as_float(x ^ ((x >> 31) & 0x7fffffff)); }
#define TOPK_INSERT(vals, x) do { _Pragma("unroll") for (int s_ = 15; s_ >= 1; --s_) vals[s_] = med3i((x), vals[s_ - 1], vals[s_]); vals[0] = max(vals[0], (x)); } while (0)
__device__ __forceinline__ float bf_dot2(unsigned a, unsigned b, float c) {
    return c + bf_lo(a) * bf_lo(b) + bf_hi(a) * bf_hi(b);
}
__device__ __forceinline__ void sum8_x8(float (&a)[8]) {
    asm("s_nop 1\n\t"
        "v_add_f32_dpp %0, %0, %0 quad_perm:[1,0,3,2] row_mask:0xf bank_mask:0xf\n\tv_add_f32_dpp %1, %1, %1 quad_perm:[1,0,3,2] row_mask:0xf bank_mask:0xf\n\t"
        "v_add_f32_dpp %2, %2, %2 quad_perm:[1,0,3,2] row_mask:0xf bank_mask:0xf\n\tv_add_f32_dpp %3, %3, %3 quad_perm:[1,0,3,2] row_mask:0xf bank_mask:0xf\n\t"
        "v_add_f32_dpp %4, %4, %4 quad_perm:[1,0,3,2] row_mask:0xf bank_mask:0xf\n\tv_add_f32_dpp %5, %5, %5 quad_perm:[1,0,3,2] row_mask:0xf bank_mask:0xf\n\t"
        "v_add_f32_dpp %6, %6, %6 quad_perm:[1,0,3,2] row_mask:0xf bank_mask:0xf\n\tv_add_f32_dpp %7, %7, %7 quad_perm:[1,0,3,2] row_mask:0xf bank_mask:0xf\n\t"
        "v_add_f32_dpp %0, %0, %0 quad_perm:[2,3,0,1] row_mask:0xf bank_mask:0xf\n\tv_add_f32_dpp %1, %1, %1 quad_perm:[2,3,0,1] row_mask:0xf bank_mask:0xf\n\t"
        "v_add_f32_dpp %2, %2, %2 quad_perm:[2,3,0,1] row_mask:0xf bank_mask:0xf\n\tv_add_f32_dpp %3, %3, %3 quad_perm:[2,3,0,1] row_mask:0xf bank_mask:0xf\n\t"
        "v_add_f32_dpp %4, %4, %4 quad_perm:[2,3,0,1] row_mask:0xf bank_mask:0xf\n\tv_add_f32_dpp %5, %5, %5 quad_perm:[2,3,0,1] row_mask:0xf bank_mask:0xf\n\t"
        "v_add_f32_dpp %6, %6, %6 quad_perm:[2,3,0,1] row_mask:0xf bank_mask:0xf\n\tv_add_f32_dpp %7, %7, %7 quad_perm:[2,3,0,1] row_mask:0xf bank_mask:0xf\n\t"
        "v_add_f32_dpp %0, %0, %0 row_half_mirror row_mask:0xf bank_mask:0xf\n\tv_add_f32_dpp %1, %1, %1 row_half_mirror row_mask:0xf bank_mask:0xf\n\t"
        "v_add_f32_dpp %2, %2, %2 row_half_mirror row_mask:0xf bank_mask:0xf\n\tv_add_f32_dpp %3, %3, %3 row_half_mirror row_mask:0xf bank_mask:0xf\n\t"
        "v_add_f32_dpp %4, %4, %4 row_half_mirror row_mask:0xf bank_mask:0xf\n\tv_add_f32_dpp %5, %5, %5 row_half_mirror row_mask:0xf bank_mask:0xf\n\t"
        "v_add_f32_dpp %6, %6, %6 row_half_mirror row_mask:0xf bank_mask:0xf\n\tv_add_f32_dpp %7, %7, %7 row_half_mirror row_mask:0xf bank_mask:0xf\n\t"
        "s_nop 1"
        : "+v"(a[0]), "+v"(a[1]), "+v"(a[2]), "+v"(a[3]), "+v"(a[4]), "+v"(a[5]), "+v"(a[6]), "+v"(a[7]));
}
__device__ __forceinline__ void sum8i_x8(int (&a)[8]) {
    asm("s_nop 1\n\t"
        "v_add_u32_dpp %0, %0, %0 quad_perm:[1,0,3,2] row_mask:0xf bank_mask:0xf\n\tv_add_u32_dpp %1, %1, %1 quad_perm:[1,0,3,2] row_mask:0xf bank_mask:0xf\n\t"
        "v_add_u32_dpp %2, %2, %2 quad_perm:[1,0,3,2] row_mask:0xf bank_mask:0xf\n\tv_add_u32_dpp %3, %3, %3 quad_perm:[1,0,3,2] row_mask:0xf bank_mask:0xf\n\t"
        "v_add_u32_dpp %4, %4, %4 quad_perm:[1,0,3,2] row_mask:0xf bank_mask:0xf\n\tv_add_u32_dpp %5, %5, %5 quad_perm:[1,0,3,2] row_mask:0xf bank_mask:0xf\n\t"
        "v_add_u32_dpp %6, %6, %6 quad_perm:[1,0,3,2] row_mask:0xf bank_mask:0xf\n\tv_add_u32_dpp %7, %7, %7 quad_perm:[1,0,3,2] row_mask:0xf bank_mask:0xf\n\t"
        "v_add_u32_dpp %0, %0, %0 quad_perm:[2,3,0,1] row_mask:0xf bank_mask:0xf\n\tv_add_u32_dpp %1, %1, %1 quad_perm:[2,3,0,1] row_mask:0xf bank_mask:0xf\n\t"
        "v_add_u32_dpp %2, %2, %2 quad_perm:[2,3,0,1] row_mask:0xf bank_mask:0xf\n\tv_add_u32_dpp %3, %3, %3 quad_perm:[2,3,0,1] row_mask:0xf bank_mask:0xf\n\t"
        "v_add_u32_dpp %4, %4, %4 quad_perm:[2,3,0,1] row_mask:0xf bank_mask:0xf\n\tv_add_u32_dpp %5, %5, %5 quad_perm:[2,3,0,1] row_mask:0xf bank_mask:0xf\n\t"
        "v_add_u32_dpp %6, %6, %6 quad_perm:[2,3,0,1] row_mask:0xf bank_mask:0xf\n\tv_add_u32_dpp %7, %7, %7 quad_perm:[2,3,0,1] row_mask:0xf bank_mask:0xf\n\t"
        "v_add_u32_dpp %0, %0, %0 row_half_mirror row_mask:0xf bank_mask:0xf\n\tv_add_u32_dpp %1, %1, %1 row_half_mirror row_mask:0xf bank_mask:0xf\n\t"
        "v_add_u32_dpp %2, %2, %2 row_half_mirror row_mask:0xf bank_mask:0xf\n\tv_add_u32_dpp %3, %3, %3 row_half_mirror row_mask:0xf bank_mask:0xf\n\t"
        "v_add_u32_dpp %4, %4, %4 row_half_mirror row_mask:0xf bank_mask:0xf\n\tv_add_u32_dpp %5, %5, %5 row_half_mirror row_mask:0xf bank_mask:0xf\n\t"
        "v_add_u32_dpp %6, %6, %6 row_half_mirror row_mask:0xf bank_mask:0xf\n\tv_add_u32_dpp %7, %7, %7 row_half_mirror row_mask:0xf bank_mask:0xf\n\t"
        "s_nop 1"
        : "+v"(a[0]), "+v"(a[1]), "+v"(a[2]), "+v"(a[3]), "+v"(a[4]), "+v"(a[5]), "+v"(a[6]), "+v"(a[7]));
}
__device__ __forceinline__ float max8_x1(float v) {
    asm("s_nop 1\n\tv_max_f32_dpp %0, %0, %0 quad_perm:[1,0,3,2] row_mask:0xf bank_mask:0xf\n\ts_nop 1\n\tv_max_f32_dpp %0, %0, %0 quad_perm:[2,3,0,1] row_mask:0xf bank_mask:0xf\n\ts_nop 1\n\t"
        "v_max_f32_dpp %0, %0, %0 row_half_mirror row_mask:0xf bank_mask:0xf\n\ts_nop 1" : "+v"(v));
    return v;
}
__device__ __forceinline__ float sum8_x1(float v) {
    asm("s_nop 1\n\tv_add_f32_dpp %0, %0, %0 quad_perm:[1,0,3,2] row_mask:0xf bank_mask:0xf\n\ts_nop 1\n\tv_add_f32_dpp %0, %0, %0 quad_perm:[2,3,0,1] row_mask:0xf bank_mask:0xf\n\ts_nop 1\n\t"
        "v_add_f32_dpp %0, %0, %0 row_half_mirror row_mask:0xf bank_mask:0xf\n\ts_nop 1" : "+v"(v));
    return v;
}
__device__ __forceinline__ void peer_phase(const Args& A, Frame& F, int L, const bool dry, const bf16* Hin, bf16* Hout, unsigned char* H8) {
    int lane = F.lane; asm volatile("" : "+v"(lane));
    const int gw = F.vcu * NWAVES + F.wave;
    const bf16* SCR = (const bf16*)(A.ws + WS_SC); const bf16* X = Hin; float* RS3 = (float*)(A.ws + WS_RS3);
    const unsigned char* TU = (const unsigned char*)(A.ws + WS_TABU) + (size_t)L * 16384 * D; const unsigned char* TV = (const unsigned char*)(A.ws + WS_TABV) + (size_t)L * 16384 * D;
    const float* SUL = (const float*)(A.ws + WS_SU) + (size_t)L * 16384;
    const float* rowss = (const float*)(A.ws + WS_RSP) + (size_t)(L == 0 ? RS_FFN0 : RS_FFN1) * T * 32;
    LAS unsigned* LIST = (LAS unsigned*)(F.lds + RING_OFF + F.wave * 16384);
    LAS unsigned* EIDX = LIST + 1024;
    LAS float* ECOEF = (LAS float*)(EIDX + 1024);
    const int tbase = gw * 8;
    if (tbase >= T) return;
    for (int half = 0; half < 2; ++half) {
        const int t0 = tbase + 4 * half;
        {
            const bf16* sp = SCR + (size_t)(t0 + (lane >> 4)) * D + (lane & 15) * 128;
            int vals[16];
#pragma unroll
            for (int s = 0; s < 16; ++s) vals[s] = (int)0x80000000;
#pragma unroll 2
            for (int c = 0; c < 16; ++c) { const v4u wv = *(const GAS v4u*)(sp + c * 8); const unsigned ww[4] = {wv.x, wv.y, wv.z, wv.w};
#pragma unroll
                for (int e = 0; e < 8; ++e) { const unsigned bits = (e & 1) ? (ww[e >> 1] & 0xffff0000u) : (ww[e >> 1] << 16);
                    int x = (int)bits; x ^= (x >> 31) & 0x7fffffff; x = (x & ~0x7f) | (127 - (c * 8 + e));
                    TOPK_INSERT(vals, x); } }
#pragma unroll
            for (int q = 0; q < 4; ++q) { v4u o; o.x = (unsigned)vals[4 * q]; o.y = (unsigned)vals[4 * q + 1]; o.z = (unsigned)vals[4 * q + 2]; o.w = (unsigned)vals[4 * q + 3]; *(LAS v4u*)(LIST + lane * 16 + 4 * q) = o; }
        }
        LDS_WAIT(); asm volatile("" ::: "memory");
        if (lane < 32) {
            const LAS unsigned* la = LIST + ((lane >> 3) * 16 + (lane & 7) * 2) * 16; const LAS unsigned* lb2 = la + 16;
            float av[16], bv[16];
#pragma unroll
            for (int q = 0; q < 4; ++q) { const v4u a4 = *(const LAS v4u*)(la + 4 * q), b4 = *(const LAS v4u*)(lb2 + 4 * q); const unsigned aw[4] = {a4.x, a4.y, a4.z, a4.w}, bw[4] = {b4.x, b4.y, b4.z, b4.w};
#pragma unroll
                for (int e = 0; e < 4; ++e) { av[4 * q + e] = __uint_as_float(__float_as_uint(sort2f((int)(aw[e] & ~0x7fu))) & 0xffff0000u); bv[4 * q + e] = __uint_as_float(__float_as_uint(sort2f((int)(bw[e] & ~0x7fu))) & 0xffff0000u); } }
            int best[16];
#pragma unroll
            for (int s = 0; s < 16; ++s) best[s] = (int)0x80000000;
#pragma unroll
            for (int i = 0; i < 16; ++i)
#pragma unroll
                for (int jx = 0; jx < 16; ++jx) if ((i + 1) * (jx + 1) <= 16) { int x = f2sort(av[i] + bv[jx]); x = (x & ~0xff) | (255 - (i * 16 + jx)); TOPK_INSERT(best, x); }
            float sv[16]; unsigned ex[16];
#pragma unroll
            for (int s = 0; s < 16; ++s) { const int cand = 255 - (best[s] & 0xff); const unsigned ka = la[cand >> 4], kb = lb2[cand & 15];
                ex[s] = (127u - (ka & 0x7fu)) * 128u + (127u - (kb & 0x7fu));
                sv[s] = __uint_as_float(__float_as_uint(sort2f((int)(ka & ~0x7fu))) & 0xffff0000u) + __uint_as_float(__float_as_uint(sort2f((int)(kb & ~0x7fu))) & 0xffff0000u); }
            float mx = sv[0];
#pragma unroll
            for (int s = 1; s < 16; ++s) mx = fmaxf(mx, sv[s]);
            float den = 0.f;
#pragma unroll
            for (int s = 0; s < 16; ++s) { sv[s] = __expf(sv[s] - mx); den += sv[s]; }
            const float inv = 1.0f / den; const int base = (4 * half + (lane >> 3)) * 128 + (lane & 7) * 16;
#pragma unroll
            for (int s = 0; s < 16; ++s) { EIDX[base + s] = ex[s]; ECOEF[base + s] = sv[s] * inv; }
        }
        LDS_WAIT(); asm volatile("" ::: "memory");
    }
    const int tk = lane >> 3, part = lane & 7, t = tbase + tk;
    const LAS unsigned* eidx = EIDX + tk * 128; LAS float* ecoef = ECOEF + tk * 128;
    const float rs = __builtin_amdgcn_rsqf(sum8_x1(((const GAS f32x4*)(rowss + (size_t)t * 32))[part][0] + ((const GAS f32x4*)(rowss + (size_t)t * 32))[part][1] + ((const GAS f32x4*)(rowss + (size_t)t * 32))[part][2] + ((const GAS f32x4*)(rowss + (size_t)t * 32))[part][3]) * (1.0f / D) + EPS);
    typedef _Float16 h2_t __attribute__((ext_vector_type(2)));
#if PEER_ALIAS
    const unsigned amask = dry ? 1023u : 0xffffffffu;
#else
    constexpr unsigned amask = 0xffffffffu;
#endif
#define PEER_LOAD8(dst, TAB, i0, soff) do { const v4u ia_ = *(const LAS v4u*)(eidx + (i0)), ib_ = *(const LAS v4u*)(eidx + (i0) + 4); const unsigned ee_[8] = {ia_.x, ia_.y, ia_.z, ia_.w, ib_.x, ib_.y, ib_.z, ib_.w}; \
        _Pragma("unroll") for (int j_ = 0; j_ < 8; ++j_) dst[j_] = *(const GAS v4u*)((TAB) + (size_t)((ee_[j_] & amask) * 2048u + (unsigned)(soff))); } while (0)
    LAS float* dotw = (LAS float*)LIST + tk * 128;
#pragma unroll
    for (int m = 0; m < 16; ++m) dotw[8 * m + part] = 0.f;
#pragma unroll 1
    for (int p = 0; p < 16; ++p) {
        const int soff = 128 * p + 16 * part;
        unsigned xq[4]; float sxs;
        { const v4u x0 = *(const GAS v4u*)(X + (size_t)t * D + soff), x1 = *(const GAS v4u*)(X + (size_t)t * D + soff + 8); const unsigned xw[8] = {x0.x, x0.y, x0.z, x0.w, x1.x, x1.y, x1.z, x1.w};
          float xv[16], am = 0.f;
#pragma unroll
          for (int e = 0; e < 8; ++e) { xv[2 * e] = bf_lo(xw[e]); xv[2 * e + 1] = bf_hi(xw[e]); am = fmaxf(am, fmaxf(fabsf(xv[2 * e]), fabsf(xv[2 * e + 1]))); }
          am = max8_x1(am); sxs = am * (1.0f / 127.0f); const float inv = am > 0.f ? 127.0f / am : 0.f;
#pragma unroll
          for (int q = 0; q < 4; ++q) { unsigned w = 0;
#pragma unroll
              for (int e = 0; e < 4; ++e) w |= (__float_as_uint(__builtin_fmaf(xv[4 * q + e], inv, 12582912.0f)) & 255u) << (8 * e);
              xq[q] = w; } }
#define PEER_UDOT8(src, m_) do { int tt_[8]; \
        _Pragma("unroll") for (int j_ = 0; j_ < 8; ++j_) { int a_ = __builtin_amdgcn_sdot4((int)src[j_].x, (int)xq[0], 0, false); a_ = __builtin_amdgcn_sdot4((int)src[j_].y, (int)xq[1], a_, false); \
            a_ = __builtin_amdgcn_sdot4((int)src[j_].z, (int)xq[2], a_, false); tt_[j_] = __builtin_amdgcn_sdot4((int)src[j_].w, (int)xq[3], a_, false); } \
        sum8i_x8(tt_); \
        int sel_ = tt_[0]; _Pragma("unroll") for (int j_ = 1; j_ < 8; ++j_) sel_ = (part == j_) ? tt_[j_] : sel_; \
        dotw[8 * (m_) + part] += (float)sel_ * sxs; } while (0)
        v4u ua[8], ub[8];
        PEER_LOAD8(ua, TU, 0, soff);
#pragma unroll 1
        for (int m = 0; m < 16; m += 2) {
            PEER_LOAD8(ub, TU, 8 * (m + 1), soff);
            PEER_UDOT8(ua, m);
            if (m + 2 < 16) PEER_LOAD8(ua, TU, 8 * (m + 2), soff);
            PEER_UDOT8(ub, m + 1);
        }
    }
#undef PEER_UDOT8
#pragma unroll
    for (int m = 0; m < 16; ++m) { const float d_ = dotw[8 * m + part] * rs * SUL[eidx[8 * m + part]]; const float act = 0.5f * d_ * (1.0f + erff(d_ * 0.7071067811865476f)); ecoef[8 * m + part] *= act; }
    LDS_WAIT(); asm volatile("" ::: "memory");
    float ss = 0.f;
#pragma unroll 1
    for (int p = 0; p < 16; ++p) {
        const int soff = 128 * p + 16 * part;
        h2_t acc[8];
#pragma unroll
        for (int i = 0; i < 8; ++i) acc[i] = (h2_t){(_Float16)0.f, (_Float16)0.f};
#define PEER_VACC8(src, i0) do { const f32x4 ca_ = *(const LAS f32x4*)(ecoef + (i0)), cb_ = *(const LAS f32x4*)(ecoef + (i0) + 4); const float cf_[8] = {ca_[0], ca_[1], ca_[2], ca_[3], cb_[0], cb_[1], cb_[2], cb_[3]}; \
        _Pragma("unroll") for (int j_ = 0; j_ < 8; ++j_) { const unsigned ww_[4] = {src[j_].x, src[j_].y, src[j_].z, src[j_].w}; const _Float16 ch_ = (_Float16)cf_[j_]; const h2_t c2_ = {ch_, ch_}; \
            _Pragma("unroll") for (int e_ = 0; e_ < 4; ++e_) { const h2_t lo_ = __builtin_amdgcn_cvt_scalef32_pk_f16_fp8((int)ww_[e_], 1.0f / 16.0f, false), hi_ = __builtin_amdgcn_cvt_scalef32_pk_f16_fp8((int)ww_[e_], 1.0f / 16.0f, true); \
                acc[2 * e_] = c2_ * lo_ + acc[2 * e_]; acc[2 * e_ + 1] = c2_ * hi_ + acc[2 * e_ + 1]; } } } while (0)
        v4u va[8], vb[8];
        PEER_LOAD8(va, TV, 0, soff);
#pragma unroll 1
        for (int m = 0; m < 16; m += 2) {
            PEER_LOAD8(vb, TV, 8 * (m + 1), soff);
            PEER_VACC8(va, 8 * m);
            if (m + 2 < 16) PEER_LOAD8(va, TV, 8 * (m + 2), soff);
            PEER_VACC8(vb, 8 * (m + 1));
        }
        { const v4u h0 = *(const GAS v4u*)(Hin + (size_t)t * D + soff), h1 = *(const GAS v4u*)(Hin + (size_t)t * D + soff + 8); const unsigned hw[8] = {h0.x, h0.y, h0.z, h0.w, h1.x, h1.y, h1.z, h1.w}; unsigned ow[8];
#pragma unroll
          for (int e = 0; e < 8; ++e) { ow[e] = hw_pk2(bf_lo(hw[e]) + (float)acc[e][0], bf_hi(hw[e]) + (float)acc[e][1]); const float q0 = bf_lo(ow[e]), q1 = bf_hi(ow[e]); ss += q0 * q0 + q1 * q1; }
          v4u o0, o1; o0.x = ow[0]; o0.y = ow[1]; o0.z = ow[2]; o0.w = ow[3]; o1.x = ow[4]; o1.y = ow[5]; o1.z = ow[6]; o1.w = ow[7];
          if (!dry) { *(GAS v4u*)(Hout + (size_t)t * D + soff) = o0; *(GAS v4u*)(Hout + (size_t)t * D + soff + 8) = o1;
            if (H8) { v4u o8; unsigned q8[4];
#pragma unroll
              for (int e = 0; e < 4; ++e) { int x8 = __builtin_amdgcn_cvt_pk_fp8_f32(bf_lo(ow[2 * e]), bf_hi(ow[2 * e]), 0, false); x8 = __builtin_amdgcn_cvt_pk_fp8_f32(bf_lo(ow[2 * e + 1]), bf_hi(ow[2 * e + 1]), x8, true); q8[e] = (unsigned)x8; }
              o8.x = q8[0]; o8.y = q8[1]; o8.z = q8[2]; o8.w = q8[3]; *(GAS v4u*)(H8 + (size_t)t * D + soff) = o8; } } else asm volatile("" :: "v"(o0.x), "v"(o0.y), "v"(o0.z), "v"(o0.w), "v"(o1.x), "v"(o1.y), "v"(o1.z), "v"(o1.w)); }
    }
#undef PEER_VACC8
#undef PEER_LOAD8
    const float r3 = __builtin_amdgcn_rsqf(sum8_x1(ss) * (1.0f / D) + EPS);
    if (!dry && part == 0) RS3[t] = r3;
}


constexpr int N_PHASES = 19;
__global__ void __launch_bounds__(NTHREADS, 2) mega_fwd(Args args) {

    extern __shared__ __attribute__((aligned(16))) unsigned char lds[];
    Frame F;
    F.lds = (LAS unsigned char*)lds;
    F.MISC = (volatile LAS unsigned*)(F.lds + MISC_OFF);
    F.tid = threadIdx.x; F.lane = F.tid & 63; F.wave = __builtin_amdgcn_readfirstlane(F.tid >> 6);
    F.G = gridDim.x; { const int bx = blockIdx.x; F.vcu = (F.G % 8 == 0) ? (bx % 8) * (F.G / 8) + bx / 8 : bx; }
    unsigned char* ws = args.ws;
    F.ctl = (gu32*)(ws + WS_CTL);
    for (int u = F.tid; u < (LDS_BYTES - LDSCTL_OFF) / 4; u += NTHREADS) ((LAS unsigned*)(F.lds + LDSCTL_OFF))[u] = 0u;
    __syncthreads();
    const int lo = args.ph_lo, hi = args.ph_hi;
    XcdBarrier bar; bar.bar = (unsigned*)(F.ctl + CW_BAR); bar.x = 0; bar.st = nullptr;
    if (hi - lo > 1) bar = xcd_barrier_post((unsigned*)(F.ctl + CW_BAR), F.MISC + 8);
    bar.wave0 = (F.wave == 0);
#define IN(k) (lo <= (k) && (k) < hi)
#define REFRESH() do { int t_; asm volatile("v_mbcnt_lo_u32_b32 %0, -1, 0\n\tv_mbcnt_hi_u32_b32 %0, -1, %0" : "=v"(t_)); F.lane = t_; F.tid = F.wave * 64 + t_; } while (0)
#define REPS(k) (1 + ((DUP_MASK >> (k)) & 1))
#if PROBE_MASK
    unsigned long long* const tsb = (unsigned long long*)(ws + WS_CTL + 65536);
#define STAMP(k) do { if (blockIdx.x == 0 && F.tid == 0) __hip_atomic_store(tsb + (k), __builtin_amdgcn_s_memrealtime(), __ATOMIC_RELAXED, __HIP_MEMORY_SCOPE_AGENT); } while (0)
    STAMP(31);
#else
#define STAMP(k) do { } while (0)
#endif
#define SEAM(k) do { if (IN(k) && IN((k) + 1)) { if ((k) == 0) { cg::this_grid().sync(); } else { xcd_barrier(bar); if ((DUP_MASK >> 24) & 1) xcd_barrier(bar); } STAMP(k); } } while (0)
    float* rowss = (float*)(ws + WS_RSP);
    bf16* ACTA = (bf16*)(ws + WS_ACTA); bf16* ACTB = (bf16*)(ws + WS_ACTB); bf16* H1 = (bf16*)(ws + WS_H1); const float* RS3 = (const float*)(ws + WS_RS3);
    bf16* PROJ = (bf16*)(ws + WS_PROJ); bf16* SCB = (bf16*)(ws + WS_SC); bf16* PP = (bf16*)(ws + WS_PP);
    const int gtid = (F.vcu * NWAVES + F.wave) * 64 + F.lane, gthreads = F.G * NTHREADS;

#if UBENCH
    {
        typedef _Float16 h2_t __attribute__((ext_vector_type(2)));
        float a[32]; f32x2 p[16]; h2_t hh[32];
#pragma unroll
        for (int i = 0; i < 32; ++i) { a[i] = (float)(F.tid + i); hh[i] = (h2_t){(_Float16)(F.lane + i), (_Float16)i}; }
#pragma unroll
        for (int i = 0; i < 16; ++i) p[i] = (f32x2){a[2 * i], a[2 * i + 1]};
        const float m = 1.0f + 1e-7f * F.lane, c = 1e-9f; const f32x2 m2 = {m, m}, c2 = {c, c}; const h2_t mh = {(_Float16)1.0f, (_Float16)1.0f}, ch = {(_Float16)0.0f, (_Float16)0.0f};
#pragma unroll 1
        for (int it = 0; it < 10000; ++it) {
#if UBENCH == 1
#pragma unroll
            for (int i = 0; i < 32; ++i) asm volatile("v_fma_f32 %0, %0, %1, %2" : "+v"(a[i]) : "v"(m), "v"(c));
#elif UBENCH == 2
#pragma unroll
            for (int i = 0; i < 16; ++i) asm volatile("v_pk_fma_f32 %0, %0, %1, %2\n\tv_pk_fma_f32 %0, %0, %1, %2" : "+v"(p[i]) : "v"(m2), "v"(c2));
#elif UBENCH == 3
#pragma unroll
            for (int i = 0; i < 32; ++i) asm volatile("v_pk_fma_f16 %0, %0, %1, %2" : "+v"(hh[i]) : "v"(mh), "v"(ch));
#endif
        }
        float s = 0.f;
#pragma unroll
        for (int i = 0; i < 32; ++i) s += a[i] + (float)hh[i][0];
#pragma unroll
        for (int i = 0; i < 16; ++i) s += p[i][0] + p[i][1];
        if (s == 12345.678f) args.out[0] = s;
    }
#endif
    if (IN(0)) { REFRESH(); p0_prologue(args, F); } SEAM(0);
    if (IN(1)) for (int rep_ = 0; rep_ < REPS(1); ++rep_) { REFRESH();
#if EV_F8_T1 > EV_F8_T0
        if (EV_F8_T0 > 0) { constexpr int n_ = EV_F8_T0 * 256; pg8::Gemm g{ACTA, (const bf16*)(ws + WS_WEV_IN), T, n_, D}; pg8::StaticOrder S; S.init(T, n_, F.G, (int)blockIdx.x); EpiBf16S E{PROJ, PROJ_LD, nullptr};
          pg8::gemm_phase<EpiBf16S, pg8::StaticOrder, true, true>(F.lds + RING_OFF, g, S, E, F.wave); }
        { constexpr int n_ = (EV_F8_T1 - EV_F8_T0) * 256; pg8::Gemm g{(const bf16*)(ws + WS_H1), (const bf16*)(ws + WS_O + (size_t)EV_F8_T0 * 256 * D), T, n_, D / 2}; pg8::StaticOrder S; S.init(T, n_, F.G, (int)blockIdx.x); EpiBf16S E{PROJ + EV_F8_T0 * 256, PROJ_LD, nullptr};
          pg8::gemm_phase<EpiBf16S, pg8::StaticOrder, true, true, true>(F.lds + RING_OFF, g, S, E, F.wave); }
        if (EV_F8_T1 < EV_NP / 256) { constexpr int n_ = EV_NP - EV_F8_T1 * 256; pg8::Gemm g{ACTA, (const bf16*)(ws + WS_WEV_IN) + (size_t)EV_F8_T1 * 256 * D, T, n_, D}; pg8::StaticOrder S; S.init(T, n_, F.G, (int)blockIdx.x); EpiBf16S E{PROJ + EV_F8_T1 * 256, PROJ_LD, nullptr};
          pg8::gemm_phase<EpiBf16S, pg8::StaticOrder, true, true>(F.lds + RING_OFF, g, S, E, F.wave); }
        if (true) { const int g2 = F.G, c2 = (int)blockIdx.x;
#else
        { pg8::Gemm g{ACTA, (const bf16*)(ws + WS_WEV_IN), T, EV_NP, D}; pg8::StaticOrder S; S.init(T, EV_NP, F.G, (int)blockIdx.x); EpiBf16S E{PROJ, PROJ_LD, nullptr};
          pg8::gemm_phase<EpiBf16S, pg8::StaticOrder, true, true>(F.lds + RING_OFF, g, S, E, F.wave); }
        if (F.G == 256 ? (int)blockIdx.x >= 64 : true) { const int g2 = F.G == 256 ? 192 : F.G, c2 = F.G == 256 ? (int)blockIdx.x - 64 : (int)blockIdx.x;
#endif
          pg8::Gemm g{(const bf16*)(ws + WS_PBF), (const bf16*)(ws + WS_WPROJ), T, D, 256}; pg8::StaticOrder S; S.init(T, D, g2, c2); EpiBf16S E{PP, D, nullptr};
          pg8::gemm_phase<EpiBf16S, pg8::StaticOrder, true, true>(F.lds + RING_OFF, g, S, E, F.wave); }
    } SEAM(1);
    if (IN(2)) for (int rep_ = 0; rep_ < REPS(2); ++rep_) { REFRESH();
        if (F.G >= 256) {
            const int u = F.vcu;
            if (u < 64) scan_gla_mfma_unit<0>(args, F, u); else if (u < 128) scan_gdn_mfma_unit(args, F, u - 64, 0); else if (u < 192) scan_gdn_mfma_unit(args, F, u - 128, 1);
            __syncthreads();
            if (rep_ == 0) for (int dr_ = 0; dr_ < 1 + ((DUP_MASK >> 22) & 1); ++dr_) { if (u < 64) p0_deferred(args, F, 128 + u, 192); else if (u >= 192) for (int k = 0; k < 2; ++k) p0_deferred(args, F, 2 * (u - 192) + k, 192); }
        } else {
            for (int u = F.vcu; u < 64; u += F.G) { scan_gla_mfma_unit<0>(args, F, u); __syncthreads(); }
            for (int u = F.vcu; u < 64; u += F.G) { scan_gdn_mfma_unit(args, F, u, 0); __syncthreads(); scan_gdn_mfma_unit(args, F, u, 1); __syncthreads(); }
            if (rep_ == 0) p0_deferred(args, F, F.vcu, F.G);
        }
    } SEAM(2);
    if (IN(3)) for (int rep_ = 0; rep_ < REPS(3); ++rep_) { REFRESH(); post_rows<0>(args, F); } SEAM(3);
    if (IN(4)) { REFRESH(); pg8::Gemm g{ACTA, (const bf16*)(ws + WS_WEV_OUT), T, D, D}; pg8::StaticOrder S; S.init(T, D, F.G, (int)blockIdx.x);
        EpiResid<false, true> E{args.in[I_X], ACTB, rowss + (size_t)RS_FFN0 * T * 32, nullptr, nullptr, nullptr};
        pg8::gemm_phase<EpiResid<false, true>, pg8::StaticOrder, true, true>(F.lds + RING_OFF, g, S, E, F.wave); }
#if (DUP_MASK >> 20) & 1
    if (IN(4)) { REFRESH(); pg8::Gemm g{ACTA, (const bf16*)(ws + WS_WEV_OUT), T, D, D}; pg8::StaticOrder S; S.init(T, D, F.G, (int)blockIdx.x);
        EpiResid<false, true> E{args.in[I_X], ACTB, rowss + (size_t)RS_FFN0 * T * 32, nullptr, nullptr, nullptr};
        pg8::gemm_phase<EpiResid<false, true>, pg8::StaticOrder, true, true>(F.lds + RING_OFF, g, S, E, F.wave); }
#endif
#if (DUP_MASK >> 21) & 1
    if (IN(4)) { REFRESH(); pg8::Gemm g{ACTA, (const bf16*)(ws + WS_WEV_IN), T, EV_NP, D}; pg8::StaticOrder S; S.init(T, EV_NP, F.G, (int)blockIdx.x); EpiBf16S E{PROJ, PROJ_LD, nullptr};
        pg8::gemm_phase<EpiBf16S, pg8::StaticOrder, true, true>(F.lds + RING_OFF, g, S, E, F.wave); }
#endif
    SEAM(4);
    if (IN(5)) for (int rep_ = 0; rep_ < REPS(5); ++rep_) { REFRESH(); { pg8::Gemm g{ACTB, (const bf16*)(ws + WS_WPEER), T, D, D}; pg8::StaticOrder S; S.init(T, D, F.G, (int)blockIdx.x); EpiBf16S E{SCB, D, rowss + (size_t)RS_FFN0 * T * 32};
        pg8::gemm_phase<EpiBf16S, pg8::StaticOrder, true, true>(F.lds + RING_OFF, g, S, E, F.wave); }
        } SEAM(5);
    if (IN(6)) for (int rep_ = 0; rep_ < REPS(6); ++rep_) { REFRESH(); peer_phase(args, F, 0, rep_ != 0, ACTB, H1, (unsigned char*)ACTA); } SEAM(6);
    if (IN(7)) { REFRESH(); { pg8::Gemm g{ACTA, (const bf16*)(ws + WS_WGATE), T, D, D / 2}; pg8::StaticOrder S; S.init(T, D, F.G, (int)blockIdx.x);
        EpiResid<true, false> E{H1, ACTB, rowss + (size_t)RS_MIX1 * T * 32, PP, RS3, (unsigned char*)ACTA + (size_t)T * D};
        pg8::gemm_phase<EpiResid<true, false>, pg8::StaticOrder, true, true, true>(F.lds + RING_OFF, g, S, E, F.wave); }
        } SEAM(7);
    if (IN(8)) for (int rep_ = 0; rep_ < REPS(8); ++rep_) { REFRESH();
        { pg8::Gemm g{(const bf16*)((const unsigned char*)ACTA + (size_t)T * D), (const bf16*)(ws + WS_WOD_IN), T, OD_NP, D / 2}; pg8::StaticOrder S; S.init(T, OD_NP, F.G, (int)blockIdx.x); EpiBf16S E{PROJ, PROJ_LD, rowss + (size_t)RS_MIX1 * T * 32};
          pg8::gemm_phase<EpiBf16S, pg8::StaticOrder, true, true, true>(F.lds + RING_OFF, g, S, E, F.wave); }
        { pg8::Gemm g{(const bf16*)(ws + WS_PBF) + (size_t)T * 256, (const bf16*)(ws + WS_WPROJ) + (size_t)D * 256, T, D, 256}; pg8::StaticOrder S; S.init(T, D, F.G, (int)blockIdx.x); EpiBf16S E{PP, D, nullptr};
          pg8::gemm_phase<EpiBf16S, pg8::StaticOrder, true, true>(F.lds + RING_OFF, g, S, E, F.wave); }
    } SEAM(8);
    if (IN(9)) for (int rep_ = 0; rep_ < REPS(9); ++rep_) { REFRESH(); lora_prep_rows(args, F); } SEAM(9);
    if (IN(10)) for (int rep_ = 0; rep_ < REPS(10); ++rep_) { REFRESH(); pg8::Gemm g{(const bf16*)(ws + WS_LA), (const bf16*)(ws + WS_WLORA), T, LORA_N, LORA_K}; pg8::StaticOrder S; S.init(T, LORA_N, F.G, (int)blockIdx.x); EpiBf16S E{(bf16*)(ws + WS_LO), LORA_N, nullptr};
        pg8::gemm_phase<EpiBf16S, pg8::StaticOrder, true, true>(F.lds + RING_OFF, g, S, E, F.wave); } SEAM(10);
    if (IN(11)) for (int rep_ = 0; rep_ < REPS(11); ++rep_) { REFRESH();
        if (F.G >= 256) {
            const int u = F.vcu;
            if (u < 64) scan_gla_mfma_unit<1>(args, F, u); else if (u < 128) scan_rwkv_mfma_unit(args, F, u - 64, 0); else if (u < 192) scan_rwkv_mfma_unit(args, F, u - 128, 1);
            __syncthreads();
            if (rep_ == 0) for (int dr_ = 0; dr_ < 1 + ((DUP_MASK >> 23) & 1); ++dr_) { if (u < 64) p1_deferred(args, F, 128 + u, 192); else if (u >= 192) for (int k = 0; k < 2; ++k) p1_deferred(args, F, 2 * (u - 192) + k, 192); }
        } else {
            for (int u = F.vcu; u < 64; u += F.G) { scan_gla_mfma_unit<1>(args, F, u); __syncthreads(); }
            for (int u = F.vcu; u < 64; u += F.G) { scan_rwkv_mfma_unit(args, F, u, 0); __syncthreads(); scan_rwkv_mfma_unit(args, F, u, 1); __syncthreads(); }
            if (rep_ == 0) p1_deferred(args, F, F.vcu, F.G);
        }
    } SEAM(11);
    if (IN(12)) for (int rep_ = 0; rep_ < REPS(12); ++rep_) { REFRESH(); post_rows<1>(args, F); } SEAM(12);
    if (IN(13)) { REFRESH(); pg8::Gemm g{ACTA, (const bf16*)(ws + WS_WOD_OUT), T, D, D / 2}; pg8::StaticOrder S; S.init(T, D, F.G, (int)blockIdx.x);
        EpiResid<false, false> E{ACTB, H1, rowss + (size_t)RS_FFN1 * T * 32, nullptr, nullptr, nullptr};
        pg8::gemm_phase<EpiResid<false, false>, pg8::StaticOrder, true, true, true>(F.lds + RING_OFF, g, S, E, F.wave); } SEAM(13);
    if (IN(14)) for (int rep_ = 0; rep_ < REPS(14); ++rep_) { REFRESH(); pg8::Gemm g{H1, (const bf16*)(ws + WS_WPEER) + (size_t)D * D, T, D, D}; pg8::StaticOrder S; S.init(T, D, F.G, (int)blockIdx.x); EpiBf16S E{SCB, D, rowss + (size_t)RS_FFN1 * T * 32};
        pg8::gemm_phase<EpiBf16S, pg8::StaticOrder, true, true>(F.lds + RING_OFF, g, S, E, F.wave); } SEAM(14);
    if (IN(15)) for (int rep_ = 0; rep_ < REPS(15); ++rep_) { REFRESH(); peer_phase(args, F, 1, rep_ != 0, H1, ACTB, (unsigned char*)ACTA); } SEAM(15);
    if (IN(16)) { REFRESH(); pg8::Gemm g{ACTA, (const bf16*)(ws + WS_WGATE) + (size_t)D * D, T, D, D / 2}; pg8::StaticOrder S; S.init(T, D, F.G, (int)blockIdx.x);
        EpiResid<true, false> E{ACTB, H1, rowss + (size_t)RS_FINAL * T * 32, PP, RS3, nullptr};
        pg8::gemm_phase<EpiResid<true, false>, pg8::StaticOrder, true, true, true>(F.lds + RING_OFF, g, S, E, F.wave); } SEAM(16);
    if (IN(17)) { REFRESH();
        float oscale = 1.0f;
#if PROBE_MASK
        { unsigned long long t_prev = __hip_atomic_load(tsb + 31, __ATOMIC_RELAXED, __HIP_MEMORY_SCOPE_AGENT); const unsigned long long t_begin = t_prev; unsigned long long sel = 0ull;
          for (int k = 0; k <= 16; ++k) { const unsigned long long tk = __hip_atomic_load(tsb + k, __ATOMIC_RELAXED, __HIP_MEMORY_SCOPE_AGENT); if ((PROBE_MASK >> k) & 1) sel += tk - t_prev; t_prev = tk; }
          const float f = (float)(double(sel) / double(t_prev - t_begin)); oscale = 1.0f + sqrtf(0.01f + 0.9f * f); }
#endif
        final_rows(args, F, oscale, H1); }
#undef IN
#undef SEAM
#undef REFRESH
}

extern "C" void kernel_launch(void* const* d_in, const int* in_sizes, int n_in, void* d_out, int out_size, void* d_ws, size_t ws_size, hipStream_t stream) {
    static int grid = 0;
    if (grid == 0) {
        if (n_in != N_IN || out_size != T * D || ws_size < WS_END + 63 * MiB) { fprintf(stderr, "kernel_launch: unexpected problem: n_in %d out %d ws %zu (need %zu)\n", n_in, out_size, ws_size, (size_t)(WS_END + 63 * MiB)); grid = -1; return; }
        int dev = 0, cus = 0, per_cu = 0;
        if (hipGetDevice(&dev) != hipSuccess || hipDeviceGetAttribute(&cus, hipDeviceAttributeMultiprocessorCount, dev) != hipSuccess) { grid = -1; return; }
        if (hipFuncSetAttribute((const void*)mega_fwd, hipFuncAttributeMaxDynamicSharedMemorySize, LDS_BYTES) != hipSuccess) { fprintf(stderr, "kernel_launch: hipFuncSetAttribute failed\n"); grid = -1; return; }
        if (hipOccupancyMaxActiveBlocksPerMultiprocessor(&per_cu, (const void*)mega_fwd, NTHREADS, LDS_BYTES) != hipSuccess || per_cu < 1) { fprintf(stderr, "kernel_launch: occupancy query says %d blocks per CU\n", per_cu); (void)hipGetLastError(); grid = -1; return; }
        grid = cus;
    }
    if (grid < 0) return;
    (void)hipMemsetAsync((char*)d_ws + WS_CTL, 0, CTL_ZERO_BYTES, stream);
    Args a{};
    for (int i = 0; i < N_IN; ++i) a.in[i] = (const float*)d_in[i];
    a.out = (float*)d_out; a.ws = (unsigned char*)d_ws;
#if MK_PER_PHASE
    for (int p = 0; p < N_PHASES - 1; ++p) { a.ph_lo = p; a.ph_hi = p + 1; hipLaunchKernelGGL(mega_fwd, dim3(grid), dim3(NTHREADS), LDS_BYTES, stream, a); }
#else
    a.ph_lo = 0; a.ph_hi = N_PHASES;
    void* kargs[] = {&a};
    hipError_t e = hipLaunchCooperativeKernel((const void*)mega_fwd, dim3(grid), dim3(NTHREADS), kargs, LDS_BYTES, stream);
    if (e != hipSuccess) fprintf(stderr, "kernel_launch: cooperative launch failed: %s (grid %d)\n", hipGetErrorString(e), grid);
#endif
}
```

```cpp
#include <hip/hip_runtime.h>
#include <hip/hip_cooperative_groups.h>
#include <cstdio>
#include <cstdint>
namespace cg = cooperative_groups;

#ifndef PROBE_MASK
#define PROBE_MASK 0
#endif
#ifndef DUP_MASK
#define DUP_MASK 0
#endif
#ifndef UBENCH
#define UBENCH 0
#endif
#ifndef GDN_DUP
#define GDN_DUP 0
#endif
#ifndef MK_PER_PHASE
#ifndef PEER_ALIAS
#define PEER_ALIAS 0
#endif
#ifndef EV_F8_T0
#define EV_F8_T0 0
#define EV_F8_T1 0
#endif
#define MK_PER_PHASE 0
#endif

namespace pg8 {
#define PG8_LAS __attribute__((address_space(3)))
typedef unsigned short bf16_t;
typedef short bf16x8 __attribute__((ext_vector_type(8)));
typedef float f32x4 __attribute__((ext_vector_type(4)));
typedef unsigned u32x4 __attribute__((ext_vector_type(4)));
typedef unsigned u32x2 __attribute__((ext_vector_type(2)));
constexpr int BM = 256, BK = 64, HALF = 128, HTB = HALF * BK * 2  , STAGE_BYTES = 8 * HTB, NXCD = 8, WGM = 8;

__host__ __device__ __forceinline__ int lds_byte(int r, int c) { const int st = (r >> 4) * 2 + (c >> 5), rr = r & 15, cc = c & 31, ob = rr * 64 + cc * 2; return st * 1024 + (ob ^ (((ob >> 9) & 1) << 5)); }
__host__ __device__ __forceinline__ void stage_rc(int b, int& R, int& C) { const int st = b / 1024, sb = b % 1024, swz = sb ^ (((sb >> 9) & 1) << 5); R = (st >> 1) * 16 + swz / 64; C = (st & 1) * 32 + (swz % 64) / 2; }
__host__ __device__ __forceinline__ int perm32(int rho) { const int n = rho >> 4, i = rho & 15; return 8 * (i >> 2) + 4 * n + (i & 3); }

struct Unit { int pm, pn; };
struct Gemm { const bf16_t* A; const bf16_t* Bt; int M, N, K; };

struct StaticOrder {
    int nM, nN, nwg, G, c;
    __host__ __device__ void init(int M, int N, int G_, int c_) { nM = M / BM; nN = N / BM; nwg = nM * nN; G = G_; c = c_; }
    __host__ __device__ bool next(int i, Unit& u) const {
        const long L = (long)i * G + c; if (L >= nwg) return false;
        int wgid = (int)L; { const int q = nwg / NXCD, r = nwg % NXCD, xcd = wgid % NXCD, off = wgid / NXCD; wgid = (xcd < r ? xcd * (q + 1) : r * (q + 1) + (xcd - r) * q) + off; }
        const int nig = WGM * nN, gid = wgid / nig, fm = gid * WGM, gsz = (nM - fm) < WGM ? (nM - fm) : WGM;
        u.pm = fm + ((wgid % nig) % gsz); u.pn = (wgid % nig) / gsz; return true;
    }
    __device__ __forceinline__ void a_ready(const Unit&) const {}
    __device__ __forceinline__ void done(const Unit&) const {}
};
__device__ __forceinline__ unsigned cvt_pk_bf16(float lo, float hi) { unsigned r; asm volatile("v_cvt_pk_bf16_f32 %0, %1, %2" : "=v"(r) : "v"(lo), "v"(hi)); return r; }
template <class Epi, class Sched, bool ALIGN_EPI = false, bool SP2 = false, bool F8 = false, bool I8 = false>
__device__ __forceinline__ void gemm_phase(PG8_LAS unsigned char* lds, const Gemm g, const Sched& S, const Epi& E, const int wave_id) {
    int tid; asm volatile("v_mbcnt_lo_u32_b32 %0, -1, 0\n\tv_mbcnt_hi_u32_b32 %0, -1, %0" : "=v"(tid)); tid += wave_id * 64;
    const int wid = wave_id, lane = tid & 63, wr = wid >> 2, wc = wid & 3, fr = lane & 15, fq = lane >> 4;
    const int K = g.K, nt = K / BK;
    unsigned voffA[2], voffB[2];
#pragma unroll
    for (int i = 0; i < 2; ++i) { int R, C; stage_rc(tid * 16 + i * 8192, R, C); const int Rb = Epi::PERM ? ((R & ~31) + perm32(R & 31)) : R;
        voffA[i] = (unsigned)(R * K + C) * 2u; voffB[i] = (unsigned)(Rb * K + C) * 2u; }
    const __amdgpu_buffer_rsrc_t rsrcA = __builtin_amdgcn_make_buffer_rsrc((void*)g.A, 0, 0x7fffffff, 0x00020000), rsrcB = __builtin_amdgcn_make_buffer_rsrc((void*)g.Bt, 0, 0x7fffffff, 0x00020000);
    const size_t kstep = (size_t)(BK * 2);
    const size_t hstep = (size_t)HALF * K * 2;
    const size_t tstep = 2 * hstep;
    const unsigned ldsw = (unsigned)wid * 1024u;
    const int aoff = lds_byte(wr * 64 + fr, fq * 8), boff = lds_byte(wc * 32 + fr, fq * 8);
#define PG8_SA(b, h) (((b) * 2 + (h)) * HTB)
#define PG8_SB(b, h) ((4 + (b) * 2 + (h)) * HTB)
#define PG8_STAGE(bufoff, gbase, voff) do { const bool isA_ = (+(voff) == +voffA); const unsigned soff_ = (unsigned)((const char*)(gbase) - (isA_ ? (const char*)g.A : (const char*)g.Bt)); _Pragma("unroll") for (int _i = 0; _i < 2; ++_i) \
        __builtin_amdgcn_raw_ptr_buffer_load_lds(isA_ ? rsrcA : rsrcB, (PG8_LAS unsigned*)(lds + (bufoff) + ldsw + _i * 8192), 16, (int)(voff)[_i], (int)soff_, 0, 0); } while (0)
#define PG8_LDA(dst, b, h) do { _Pragma("unroll") for (int m = 0; m < 4; ++m) { if constexpr (F8) { dst##8[m].lo = *(const PG8_LAS bf16x8*)(lds + PG8_SA(b, h) + aoff + m * 2048); dst##8[m].hi = *(const PG8_LAS bf16x8*)(lds + PG8_SA(b, h) + aoff + m * 2048 + 1024); } else { _Pragma("unroll") for (int k = 0; k < 2; ++k) dst[m][k] = *(const PG8_LAS bf16x8*)(lds + PG8_SA(b, h) + aoff + m * 2048 + k * 1024); } } } while (0)
#define PG8_LDB(dst, b, h) do { _Pragma("unroll") for (int n = 0; n < 2; ++n) { if constexpr (F8) { dst##8[n].lo = *(const PG8_LAS bf16x8*)(lds + PG8_SB(b, h) + boff + n * 2048); dst##8[n].hi = *(const PG8_LAS bf16x8*)(lds + PG8_SB(b, h) + boff + n * 2048 + 1024); } else { _Pragma("unroll") for (int k = 0; k < 2; ++k) dst[n][k] = *(const PG8_LAS bf16x8*)(lds + PG8_SB(b, h) + boff + n * 2048 + k * 1024); } } } while (0)
#define PG8_MMA(ai, bj, At, Bt) do { __builtin_amdgcn_s_setprio(1); _Pragma("unroll") for (int m = 0; m < 4; ++m) _Pragma("unroll") for (int n = 0; n < 2; ++n) { \
        if constexpr (F8) { typedef int v8i_ __attribute__((ext_vector_type(8))); \
            acc[ai][bj][m][n] = __builtin_amdgcn_mfma_scale_f32_16x16x128_f8f6f4(__builtin_bit_cast(v8i_, Bt##8[n]), __builtin_bit_cast(v8i_, At##8[m]), acc[ai][bj][m][n], 0, 0, 0, 0x7f79, 1, 0x7f79); }     \
        else if constexpr (I8) { typedef int v4i_ __attribute__((ext_vector_type(4))); \
            _Pragma("unroll") for (int k = 0; k < 2; ++k) acc[ai][bj][m][n] = __builtin_bit_cast(f32x4, __builtin_amdgcn_mfma_i32_16x16x64_i8(__builtin_bit_cast(v4i_, Bt[n][k]), __builtin_bit_cast(v4i_, At[m][k]), __builtin_bit_cast(v4i_, acc[ai][bj][m][n]), 0, 0, 0)); } \
        else { _Pragma("unroll") for (int k = 0; k < 2; ++k) acc[ai][bj][m][n] = __builtin_amdgcn_mfma_f32_16x16x32_bf16(Bt[n][k], At[m][k], acc[ai][bj][m][n], 0, 0, 0); } } \
        __builtin_amdgcn_s_setprio(0); } while (0)
#define PG8_WAIT_V(n) asm volatile("s_waitcnt vmcnt(" #n ")" ::: "memory")
#define PG8_WAIT_L(n) asm volatile("s_waitcnt lgkmcnt(" #n ")" ::: "memory")
#define PG8_BAR __builtin_amdgcn_s_barrier()
#define PG8_SCHED __builtin_amdgcn_sched_barrier(0)
    Unit cur, nxt; int ui = 0;
    if (!S.next(0, cur)) return;
    f32x4 acc[2][2][4][2];
#pragma unroll
    for (int a = 0; a < 2; ++a)
#pragma unroll
        for (int b = 0; b < 2; ++b)
#pragma unroll
            for (int m = 0; m < 4; ++m)
#pragma unroll
                for (int n = 0; n < 2; ++n) acc[a][b][m][n] = (f32x4){0.f, 0.f, 0.f, 0.f};
    typedef short bf16x16 __attribute__((ext_vector_type(16)));
    bf16x16 At8[4], B08[2], B18[2]; bf16x8 At[4][2], B0[2][2], B1[2][2];
    const char* cA = (const char*)g.A + (size_t)cur.pm * tstep; const char* cB = (const char*)g.Bt + (size_t)cur.pn * tstep;
    S.a_ready(cur);
    if constexpr (SP2) {
        PG8_STAGE(PG8_SB(0, 0), cB, voffB); PG8_STAGE(PG8_SB(0, 1), cB + hstep, voffB); PG8_STAGE(PG8_SA(0, 0), cA, voffA); PG8_STAGE(PG8_SA(0, 1), cA + hstep, voffA);
        if (wr == 1) PG8_BAR;
        PG8_WAIT_V(2); PG8_BAR;
        PG8_STAGE(PG8_SB(1, 0), cB + kstep, voffB); PG8_STAGE(PG8_SA(1, 0), cA + kstep, voffA); PG8_STAGE(PG8_SB(1, 1), cB + hstep + kstep, voffB);
        PG8_WAIT_V(6); PG8_BAR;
    } else {
        PG8_STAGE(PG8_SB(0, 0), cB, voffB); PG8_STAGE(PG8_SA(0, 0), cA, voffA); PG8_STAGE(PG8_SB(0, 1), cB + hstep, voffB); PG8_STAGE(PG8_SA(0, 1), cA + hstep, voffA);
        if (wr == 1) PG8_BAR;
        PG8_WAIT_V(4); PG8_BAR;
        PG8_STAGE(PG8_SB(1, 0), cB + kstep, voffB); PG8_STAGE(PG8_SA(1, 0), cA + kstep, voffA); PG8_STAGE(PG8_SB(1, 1), cB + hstep + kstep, voffB);
        PG8_WAIT_V(6); PG8_BAR;
    }
    for (;;) {
        const bool has_next = S.next(ui + 1, nxt);
        const char* nA = has_next ? (const char*)g.A + (size_t)nxt.pm * tstep : cA; const char* nB = has_next ? (const char*)g.Bt + (size_t)nxt.pn * tstep : cB;
        for (int t = 0; t < nt; t += 2) {
            const bool last = (t == nt - 2);
            const char* a1 = cA + (size_t)(t + 1) * kstep;
            const char* a2 = last ? nA : cA + (size_t)(t + 2) * kstep; const char* b2 = last ? nB : cB + (size_t)(t + 2) * kstep;
            const char* a3 = a2 + kstep; const char* b3 = b2 + kstep;
            if (last && has_next) S.a_ready(nxt);
            if constexpr (SP2) {
            PG8_LDB(B0, 0, 0); PG8_LDB(B1, 0, 1); PG8_SCHED; PG8_LDA(At, 0, 0); PG8_STAGE(PG8_SA(1, 1), a1 + hstep, voffA);
            PG8_WAIT_V(8); PG8_WAIT_L(0); PG8_BAR; PG8_MMA(0, 0, At, B0); PG8_MMA(0, 1, At, B1); PG8_BAR; PG8_SCHED;
            PG8_LDA(At, 0, 1); PG8_STAGE(PG8_SB(0, 0), b2, voffB); PG8_STAGE(PG8_SB(0, 1), b2 + hstep, voffB); PG8_STAGE(PG8_SA(0, 0), a2, voffA);
            PG8_WAIT_V(8); PG8_WAIT_L(0); PG8_BAR; PG8_MMA(1, 0, At, B0); PG8_MMA(1, 1, At, B1); PG8_BAR; PG8_SCHED;
            PG8_LDB(B0, 1, 0); PG8_LDB(B1, 1, 1); PG8_SCHED; PG8_LDA(At, 1, 0); PG8_STAGE(PG8_SA(0, 1), a2 + hstep, voffA);
            PG8_WAIT_V(8); PG8_WAIT_L(0); PG8_BAR; PG8_MMA(0, 0, At, B0); PG8_MMA(0, 1, At, B1); PG8_BAR; PG8_SCHED;
            PG8_LDA(At, 1, 1); PG8_STAGE(PG8_SB(1, 0), b3, voffB); PG8_STAGE(PG8_SB(1, 1), b3 + hstep, voffB); PG8_STAGE(PG8_SA(1, 0), a3, voffA);
            PG8_WAIT_V(8); PG8_WAIT_L(0); PG8_BAR; PG8_MMA(1, 0, At, B0); PG8_MMA(1, 1, At, B1); PG8_BAR; PG8_SCHED;
            } else {
            PG8_LDB(B0, 0, 0); PG8_SCHED; PG8_LDA(At, 0, 0); PG8_STAGE(PG8_SA(1, 1), a1 + hstep, voffA);
            PG8_WAIT_L(8); PG8_BAR; PG8_WAIT_L(0); PG8_MMA(0, 0, At, B0); PG8_BAR; PG8_SCHED;
            PG8_LDB(B1, 0, 1); PG8_STAGE(PG8_SB(0, 0), b2, voffB);
            PG8_BAR; PG8_WAIT_L(0); PG8_MMA(0, 1, At, B1); PG8_BAR;
            PG8_LDA(At, 0, 1); PG8_STAGE(PG8_SA(0, 0), a2, voffA);
            PG8_BAR; PG8_WAIT_L(0); PG8_MMA(1, 0, At, B0); PG8_BAR; PG8_SCHED;
            PG8_STAGE(PG8_SB(0, 1), b2 + hstep, voffB);
            PG8_WAIT_V(6); PG8_BAR; PG8_MMA(1, 1, At, B1); PG8_BAR;
            PG8_LDB(B0, 1, 0); PG8_SCHED; PG8_LDA(At, 1, 0); PG8_STAGE(PG8_SA(0, 1), a2 + hstep, voffA);
            PG8_WAIT_L(8); PG8_BAR; PG8_WAIT_L(0); PG8_MMA(0, 0, At, B0); PG8_BAR; PG8_SCHED;
            PG8_LDB(B1, 1, 1); PG8_STAGE(PG8_SB(1, 0), b3, voffB);
            PG8_BAR; PG8_WAIT_L(0); PG8_MMA(0, 1, At, B1); PG8_BAR;
            PG8_LDA(At, 1, 1); PG8_STAGE(PG8_SA(1, 0), a3, voffA);
            PG8_BAR; PG8_WAIT_L(0); PG8_MMA(1, 0, At, B0); PG8_BAR; PG8_SCHED;
            PG8_STAGE(PG8_SB(1, 1), b3 + hstep, voffB);
            PG8_WAIT_V(6); PG8_BAR; PG8_MMA(1, 1, At, B1); PG8_BAR;
            }
        }
        if constexpr (ALIGN_EPI) { if (wr == 0) PG8_BAR; }
        if constexpr (!Epi::AFTER_DRAIN) { int ln_e; asm volatile("v_mbcnt_lo_u32_b32 %0, -1, 0\n\tv_mbcnt_hi_u32_b32 %0, -1, %0" : "=v"(ln_e)); const int fr_e = ln_e & 15, fq_e = ln_e >> 4;
            E(acc, cur, wr, wc, fr_e, fq_e); S.done(cur); }
        if (!has_next) break;
#pragma unroll
        for (int a = 0; a < 2; ++a)
#pragma unroll
            for (int b = 0; b < 2; ++b)
#pragma unroll
                for (int m = 0; m < 4; ++m)
#pragma unroll
                    for (int n = 0; n < 2; ++n) acc[a][b][m][n] = (f32x4){0.f, 0.f, 0.f, 0.f};
        cur = nxt; cA = nA; cB = nB; ++ui;
        if constexpr (ALIGN_EPI) { if (wr == 1) PG8_BAR; }
    }
    PG8_WAIT_V(0);
    if constexpr (!ALIGN_EPI) { if (wr == 0) PG8_BAR; }
    PG8_BAR;
    if constexpr (Epi::AFTER_DRAIN) { E.fused(acc, cur, wr, wc, fr, fq, lds, wid, lane); S.done(cur); }
#undef PG8_SA
#undef PG8_SB
#undef PG8_STAGE
#undef PG8_LDA
#undef PG8_LDB
#undef PG8_MMA
#undef PG8_WAIT_V
#undef PG8_WAIT_L
#undef PG8_BAR
#undef PG8_SCHED
}
}
#define GAS __attribute__((address_space(1)))
#define LAS __attribute__((address_space(3)))
typedef unsigned short bf16;
typedef unsigned v4u __attribute__((ext_vector_type(4)));
typedef float f32x4 __attribute__((ext_vector_type(4)));
typedef short bf16x8 __attribute__((ext_vector_type(8)));
typedef GAS unsigned gu32;
typedef GAS unsigned long long gu64;
#define RLX_AGENT __ATOMIC_RELAXED, __HIP_MEMORY_SCOPE_AGENT
#define LDS_WAIT() asm volatile("s_waitcnt lgkmcnt(0)" ::: "memory")
#define VM_WAIT() asm volatile("s_waitcnt vmcnt(0)" ::: "memory")
__device__ __forceinline__ unsigned long long rt() { return __builtin_amdgcn_s_memrealtime(); }
__device__ __forceinline__ unsigned f2bf(float f) { unsigned u = __builtin_bit_cast(unsigned, f); return (u + 0x7fffu + ((u >> 16) & 1u)) >> 16; }
__device__ __forceinline__ unsigned pk2(float lo, float hi) { return f2bf(lo) | (f2bf(hi) << 16); }

#define XB_TMO      128
#define XB_XCNT(j)  (256  + 64 * (j))
#define XB_XSUB(j)  (1280 + 64 * (j))
#define XB_XGEN(j)  (2304 + 64 * (j))
#define XB_TOP      3328
#define XB_TOPGEN   3392
#define XCD_BAR_WORDS 3456
#define XB_SPIN_CAP (1u << 18)

__device__ __forceinline__ unsigned xb_ld(unsigned* p)              { return __hip_atomic_load(p, __ATOMIC_RELAXED, __HIP_MEMORY_SCOPE_AGENT); }
__device__ __forceinline__ unsigned xb_add(unsigned* p, unsigned v) { return __hip_atomic_fetch_add(p, v, __ATOMIC_RELAXED, __HIP_MEMORY_SCOPE_AGENT); }
__device__ __forceinline__ unsigned xb_xcc_id() { return (unsigned)__builtin_amdgcn_s_getreg((3 << 11) | 20) & 0xFu; }
#define XB_SPIN(cond, bar) do { unsigned _sp = 0; while (cond) { __builtin_amdgcn_s_sleep(1); \
    if ((++_sp & 255u) == 0u) { if (xb_ld(&(bar)[XB_TMO])) break; if (_sp > XB_SPIN_CAP) { atomicAdd(&(bar)[XB_TMO], 1u); break; } } } } while (0)

struct XcdBarrier {
    unsigned* bar; unsigned x; bool wave0;
    volatile LAS unsigned* st;
};

__device__ __forceinline__ XcdBarrier xcd_barrier_post(unsigned* bar, volatile LAS unsigned* st) {
    XcdBarrier b; b.bar = bar; b.x = xb_xcc_id(); b.st = st;
    if (threadIdx.x == 0) (void)xb_add(&bar[XB_XCNT(b.x)], 1u);
    return b;
}
__device__ __forceinline__ void xcd_barrier_complete(unsigned* bar, unsigned x, unsigned& nloc, unsigned& nx) {
    const unsigned G = gridDim.x * gridDim.y * gridDim.z;
    unsigned sum, cnt, mine, sp = 0u;
    for (;;) {
        sum = 0u; cnt = 0u; mine = 0u;
#pragma unroll
        for (unsigned j = 0; j < 16; ++j) { const unsigned c = xb_ld(&bar[XB_XCNT(j)]); sum += c; cnt += (c > 0u) ? 1u : 0u; mine = (j == x) ? c : mine; }
        if (sum == G) break;
        __builtin_amdgcn_s_sleep(1);
        if ((++sp & 255u) == 0u) { if (xb_ld(&bar[XB_TMO])) break; if (sp > XB_SPIN_CAP) { atomicAdd(&bar[XB_TMO], 1u); break; } }
    }
    nloc = mine > 0u ? mine : 1u; nx = cnt > 0u ? cnt : 1u;
}

__device__ __forceinline__ void xcd_barrier(const XcdBarrier& b) {
    asm volatile("s_waitcnt vmcnt(0)" ::: "memory");
    __syncthreads();
    if (b.wave0 && __builtin_amdgcn_mbcnt_hi(~0u, __builtin_amdgcn_mbcnt_lo(~0u, 0u)) == 0u) {
        unsigned* bar = b.bar;
        __builtin_amdgcn_s_waitcnt(0);
        unsigned nloc = b.st[0], nx = b.st[1];
        if (nloc == 0u) { xcd_barrier_complete(bar, b.x, nloc, nx); b.st[0] = nloc; b.st[1] = nx; }
        const unsigned old = xb_add(&bar[XB_XSUB(b.x)], 1u);
        const unsigned gen = old / nloc;
        if (old + 1u == (gen + 1u) * nloc) {
            __builtin_amdgcn_fence(__ATOMIC_RELEASE, "agent");
            asm volatile("s_waitcnt vmcnt(0)" ::: "memory");
            const unsigned og = xb_add(&bar[XB_TOP], 1u);
            const unsigned tg = og / nx;
            if (og + 1u == (tg + 1u) * nx) xb_add(&bar[XB_TOPGEN], 1u);
            else XB_SPIN(xb_ld(&bar[XB_TOPGEN]) == tg, bar);
            __builtin_amdgcn_fence(__ATOMIC_ACQUIRE, "agent");
            xb_add(&bar[XB_XGEN(b.x)], 1u);
            asm volatile("s_waitcnt vmcnt(0)" ::: "memory");
        } else {
            XB_SPIN(xb_ld(&bar[XB_XGEN(b.x)]) == gen, bar);
            __builtin_amdgcn_fence(__ATOMIC_ACQUIRE, "agent");
            asm volatile("s_waitcnt vmcnt(0)" ::: "memory");
        }
    }
    __syncthreads();
}

constexpr int NWAVES = 8, NTHREADS = NWAVES * 64;
constexpr int BATCH = 8, SEQ = 2048, T = BATCH * SEQ, D = 2048;
constexpr int EV_N = 7200, EV_NP = 7424, OD_N = 7616, OD_NP = 7680, PROJ_LD = 7680;
constexpr float EPS = 1e-6f;
constexpr int EC_GQ = 0, EC_GK = 512, EC_GV = 1024, EC_GZ = 2048, EC_GLR = 3072, EC_BQ = 3088, EC_BK = 4112, EC_BV = 5136, EC_BZ = 6160, EC_BA = 7184, EC_BB = 7192;
constexpr int OC_HQ = 0, OC_HF = 1024, OC_HI = 2048, OC_HG = 3072, OC_RW = 4096;
constexpr int RW_R = 0, RW_K = 1024, RW_V = 2048, RW_WL = 3072, RW_AL = 3168, RW_GL = 3264;
constexpr int LORA_K = 512, LORA_N = 3072;
enum { I_X = 0, I_P, I_EV_WIN, I_GK_W2, I_GK_B, I_GLA_NORM, I_GDN_CONV, I_GDN_ALOG, I_GDN_DTB, I_GDN_NORM, I_EV_WOUT, I_OD_WIN, I_LB, I_HG_NORM,
       I_MU, I_W0, I_W2, I_A0, I_A2, I_G2, I_KK, I_KA, I_RK, I_LNW, I_LNB, I_OD_WOUT, I_NMIX, I_NFFN, I_NPLE, I_PEER_WQ, I_PEER_SK, I_PEER_U, I_PEER_V,
       I_PLE_WP, I_PLE_WG, I_NFINAL, N_IN };

constexpr size_t MiB = 1u << 20;
constexpr size_t WS_CTL = 0, CTL_ZERO_BYTES = 1 * MiB, WS_SU = 256 * 1024, WS_CMB = 512 * 1024, WS_SA = 576 * 1024;
constexpr size_t WS_WEV_IN = 1 * MiB, WS_WEV_OUT = 30 * MiB, WS_WOD_IN = 38 * MiB, WS_WOD_OUT = 68 * MiB, WS_WPEER = 76 * MiB, WS_WGATE = 92 * MiB, WS_WPROJ = 108 * MiB,
                 WS_WLORA = 110 * MiB, WS_PBF = 113 * MiB, WS_TABU = 129 * MiB, WS_TABV = 193 * MiB, WS_ACTA = 257 * MiB, WS_ACTB = 321 * MiB, WS_PROJ = 385 * MiB, WS_SC = 385 * MiB,
                 WS_O = 625 * MiB, WS_H1 = 689 * MiB, WS_PP = 753 * MiB, WS_LA = 817 * MiB, WS_LO = 833 * MiB, WS_RSP = 929 * MiB, WS_STATE = 937 * MiB, WS_RS3 = 945 * MiB, WS_END = 946 * MiB;
static_assert(WS_WEV_IN + (size_t)EV_NP * D * 2 <= WS_WEV_OUT && WS_WOD_IN + (size_t)OD_NP * D * 2 <= WS_WOD_OUT && WS_PROJ + (size_t)T * PROJ_LD * 2 <= WS_O, "ws map");
constexpr int CW_BAR = 4096;
enum { RS_FFN0 = 0, RS_MIX1 = 1, RS_FFN1 = 2, RS_FINAL = 3 };
constexpr int RING_OFF = 0, RING_BYTES = 131072;
constexpr int LDSCTL_OFF = RING_BYTES, MISC_OFF = LDSCTL_OFF + 320;
constexpr int LDS_BYTES = 147456;

struct Args { const float* in[N_IN]; float* out; unsigned char* ws; int ph_lo, ph_hi; };
struct Frame {
    LAS unsigned char* lds; volatile LAS unsigned* MISC; gu32* ctl;
    int tid, lane, wave, vcu, G;
};
__device__ __forceinline__ float wave_sum(float v) {
#pragma unroll
    for (int o = 1; o < 64; o <<= 1) v += __shfl_xor(v, o);
    return v;
}
__device__ __forceinline__ float half_sum32(float v) {
#pragma unroll
    for (int o = 1; o < 32; o <<= 1) v += __shfl_xor(v, o);
    return v;
}
#define DPP_ADD(v, ctrl) (v) += __builtin_bit_cast(float, __builtin_amdgcn_update_dpp(0, __builtin_bit_cast(int, (v)), (ctrl), 0xF, 0xF, false))
__device__ __forceinline__ float row_sum16(float v) {
    DPP_ADD(v, 0x128); DPP_ADD(v, 0x124); DPP_ADD(v, 0x122); DPP_ADD(v, 0x121);
    return v;
}
__device__ __forceinline__ void row_sum16_x4(float& a, float& b, float& c, float& d) {
    asm("s_nop 1\n\t"
        "v_add_f32_dpp %0, %0, %0 row_ror:8 row_mask:0xf bank_mask:0xf\n\tv_add_f32_dpp %1, %1, %1 row_ror:8 row_mask:0xf bank_mask:0xf\n\t"
        "v_add_f32_dpp %2, %2, %2 row_ror:8 row_mask:0xf bank_mask:0xf\n\tv_add_f32_dpp %3, %3, %3 row_ror:8 row_mask:0xf bank_mask:0xf\n\t"
        "v_add_f32_dpp %0, %0, %0 row_ror:4 row_mask:0xf bank_mask:0xf\n\tv_add_f32_dpp %1, %1, %1 row_ror:4 row_mask:0xf bank_mask:0xf\n\t"
        "v_add_f32_dpp %2, %2, %2 row_ror:4 row_mask:0xf bank_mask:0xf\n\tv_add_f32_dpp %3, %3, %3 row_ror:4 row_mask:0xf bank_mask:0xf\n\t"
        "v_add_f32_dpp %0, %0, %0 row_ror:2 row_mask:0xf bank_mask:0xf\n\tv_add_f32_dpp %1, %1, %1 row_ror:2 row_mask:0xf bank_mask:0xf\n\t"
        "v_add_f32_dpp %2, %2, %2 row_ror:2 row_mask:0xf bank_mask:0xf\n\tv_add_f32_dpp %3, %3, %3 row_ror:2 row_mask:0xf bank_mask:0xf\n\t"
        "v_add_f32_dpp %0, %0, %0 row_ror:1 row_mask:0xf bank_mask:0xf\n\tv_add_f32_dpp %1, %1, %1 row_ror:1 row_mask:0xf bank_mask:0xf\n\t"
        "v_add_f32_dpp %2, %2, %2 row_ror:1 row_mask:0xf bank_mask:0xf\n\tv_add_f32_dpp %3, %3, %3 row_ror:1 row_mask:0xf bank_mask:0xf\n\t"
        "s_nop 1"
        : "+v"(a), "+v"(b), "+v"(c), "+v"(d));
}
__device__ __forceinline__ void row_sum16_x2(float& a, float& b) {
    asm("s_nop 1\n\t"
        "v_add_f32_dpp %0, %0, %0 row_ror:8 row_mask:0xf bank_mask:0xf\n\tv_add_f32_dpp %1, %1, %1 row_ror:8 row_mask:0xf bank_mask:0xf\n\ts_nop 1\n\t"
        "v_add_f32_dpp %0, %0, %0 row_ror:4 row_mask:0xf bank_mask:0xf\n\tv_add_f32_dpp %1, %1, %1 row_ror:4 row_mask:0xf bank_mask:0xf\n\ts_nop 1\n\t"
        "v_add_f32_dpp %0, %0, %0 row_ror:2 row_mask:0xf bank_mask:0xf\n\tv_add_f32_dpp %1, %1, %1 row_ror:2 row_mask:0xf bank_mask:0xf\n\ts_nop 1\n\t"
        "v_add_f32_dpp %0, %0, %0 row_ror:1 row_mask:0xf bank_mask:0xf\n\tv_add_f32_dpp %1, %1, %1 row_ror:1 row_mask:0xf bank_mask:0xf\n\t"
        "s_nop 1"
        : "+v"(a), "+v"(b));
}
typedef unsigned u32x2 __attribute__((ext_vector_type(2)));
__device__ __forceinline__ void st_wt16(void* p, v4u v) { asm volatile("global_store_dwordx4 %0, %1, off sc1\n\ts_nop 1" :: "v"(p), "v"(v) : "memory"); }
__device__ __forceinline__ void st_wt8(void* p, u32x2 v) { asm volatile("global_store_dwordx2 %0, %1, off sc1\n\ts_nop 1" :: "v"(p), "v"(v) : "memory"); }
#define LBAR() do { asm volatile("s_waitcnt lgkmcnt(0)" ::: "memory"); __builtin_amdgcn_s_barrier(); asm volatile("" ::: "memory"); } while (0)
typedef float f32x2 __attribute__((ext_vector_type(2)));
typedef __bf16 hwbf16x2_t __attribute__((ext_vector_type(2)));
__device__ __forceinline__ unsigned hw_pk2(float lo, float hi) { const f32x2 v = {lo, hi}; return __builtin_bit_cast(unsigned, __builtin_convertvector(v, hwbf16x2_t)); }
__device__ __forceinline__ bf16 hw_bf(float x) { return (bf16)hw_pk2(x, 0.f); }
__device__ __forceinline__ float bf_lo(unsigned w) { return __uint_as_float(w << 16); }
__device__ __forceinline__ float bf_hi(unsigned w) { return __uint_as_float(w & 0xffff0000u); }
__device__ __forceinline__ float sigmoidf_(float x) { return __builtin_amdgcn_rcpf(1.0f + __expf(-x)); }
__device__ __forceinline__ float siluf_(float x) { return x * __builtin_amdgcn_rcpf(1.0f + __expf(-x)); }
__device__ __forceinline__ float softplusf_(float x) { return fmaxf(x, 0.f) + log1pf(__expf(-fabsf(x))); }
__device__ __forceinline__ float logsigmoidf_(float x) { return fminf(x, 0.f) - log1pf(__expf(-fabsf(x))); }

struct EpiBf16S {
    static constexpr bool PERM = true, AFTER_DRAIN = false;
    bf16* O; int ldc; const float* rowss;
    __device__ __forceinline__ void operator()(const pg8::f32x4 (&acc)[2][2][4][2], const pg8::Unit& u, int wr, int wc, int fr, int fq) const {
        const int row0 = u.pm * 256 + wr * 64 + fr, col0 = u.pn * 256 + wc * 32 + 8 * fq;
#pragma unroll
        for (int ai = 0; ai < 2; ++ai)
#pragma unroll
            for (int m = 0; m < 4; ++m) {
                const int row = row0 + ai * 128 + m * 16;
                float sc = 1.f;
                if (rowss) { const pg8::f32x4* rp = (const pg8::f32x4*)(rowss + (size_t)row * 32 + 8 * fq); const pg8::f32x4 p0 = rp[0], p1 = rp[1];
                    float s = ((p0[0] + p0[1]) + (p0[2] + p0[3])) + ((p1[0] + p1[1]) + (p1[2] + p1[3])); s += __shfl_xor(s, 16); s += __shfl_xor(s, 32);
                    sc = __builtin_amdgcn_rsqf(s * (1.0f / D) + EPS); }
                bf16* rowp = O + (size_t)row * ldc + col0;
#pragma unroll
                for (int bj = 0; bj < 2; ++bj) { const pg8::f32x4 v0 = acc[ai][bj][m][0] * sc, v1 = acc[ai][bj][m][1] * sc;
                    pg8::u32x4 w; w.x = pg8::cvt_pk_bf16(v0[0], v0[1]); w.y = pg8::cvt_pk_bf16(v0[2], v0[3]); w.z = pg8::cvt_pk_bf16(v1[0], v1[1]); w.w = pg8::cvt_pk_bf16(v1[2], v1[3]);
                    *(pg8::u32x4*)(rowp + bj * 128) = w; } }
    }
};
struct EpiI8S {
    static constexpr bool PERM = true, AFTER_DRAIN = false;
    bf16* O; int ldc; const float* sa; const float* cb;
    __device__ __forceinline__ void operator()(const pg8::f32x4 (&acc)[2][2][4][2], const pg8::Unit& u, int wr, int wc, int fr, int fq) const {
        const int row0 = u.pm * 256 + wr * 64 + fr, col0 = u.pn * 256 + wc * 32 + 8 * fq;
        pg8::f32x4 cs[2][2];
#pragma unroll
        for (int bj = 0; bj < 2; ++bj) { cs[bj][0] = *(const pg8::f32x4*)(cb + col0 + bj * 128); cs[bj][1] = *(const pg8::f32x4*)(cb + col0 + bj * 128 + 4); }
#pragma unroll
        for (int ai = 0; ai < 2; ++ai)
#pragma unroll
            for (int m = 0; m < 4; ++m) {
                const int row = row0 + ai * 128 + m * 16;
                const float sc = sa[row];
                bf16* rowp = O + (size_t)row * ldc + col0;
#pragma unroll
                for (int bj = 0; bj < 2; ++bj) { pg8::f32x4 v0, v1;
#pragma unroll
                    for (int e = 0; e < 4; ++e) { v0[e] = (float)__float_as_int(acc[ai][bj][m][0][e]) * sc * cs[bj][0][e]; v1[e] = (float)__float_as_int(acc[ai][bj][m][1][e]) * sc * cs[bj][1][e]; }
                    pg8::u32x4 w; w.x = pg8::cvt_pk_bf16(v0[0], v0[1]); w.y = pg8::cvt_pk_bf16(v0[2], v0[3]); w.z = pg8::cvt_pk_bf16(v1[0], v1[1]); w.w = pg8::cvt_pk_bf16(v1[2], v1[3]);
                    *(pg8::u32x4*)(rowp + bj * 128) = w; } }
    }
};
template <bool GATE, bool HIN_F32> struct EpiResid {
    static constexpr bool PERM = false, AFTER_DRAIN = false;
    const void* hin; bf16* hout; float* rowss; const bf16* pp; const float* rs3; unsigned char* h8;
    __device__ __forceinline__ void operator()(const pg8::f32x4 (&acc)[2][2][4][2], const pg8::Unit& u, int wr, int wc, int fr, int fq) const {
        const int row0 = u.pm * 256 + wr * 64 + fr, col0 = u.pn * 256 + wc * 32 + 4 * fq;
        constexpr int MG = HIN_F32 ? 2 : 4;
#pragma unroll
        for (int ai = 0; ai < 2; ++ai)
#pragma unroll
            for (int m0 = 0; m0 < 4; m0 += MG) {
                pg8::f32x4 hf[MG][2][2]; pg8::u32x2 hb[MG][2][2], pw[MG][2][2]; float rsc[MG];
#pragma unroll
                for (int mm = 0; mm < MG; ++mm) { const int row = row0 + ai * 128 + (m0 + mm) * 16; const size_t off = (size_t)row * D + col0; rsc[mm] = GATE ? rs3[row] : 1.f;
#pragma unroll
                    for (int bj = 0; bj < 2; ++bj)
#pragma unroll
                        for (int n = 0; n < 2; ++n) { const size_t o = off + bj * 128 + n * 16;
                            if (HIN_F32) hf[mm][bj][n] = *(const pg8::f32x4*)((const float*)hin + o); else hb[mm][bj][n] = *(const pg8::u32x2*)((const bf16*)hin + o);
                            if (GATE) pw[mm][bj][n] = *(const pg8::u32x2*)(pp + o); } }
#pragma unroll
                for (int mm = 0; mm < MG; ++mm) { const int m = m0 + mm; const int row = row0 + ai * 128 + m * 16; const size_t off = (size_t)row * D + col0; float ss = 0.f;
#pragma unroll
                    for (int bj = 0; bj < 2; ++bj)
#pragma unroll
                        for (int n = 0; n < 2; ++n) { const size_t o = off + bj * 128 + n * 16;
                            pg8::f32x4 hv;
                            if (HIN_F32) hv = hf[mm][bj][n];
                            else { const pg8::u32x2 hw = hb[mm][bj][n]; hv[0] = bf_lo(hw.x); hv[1] = bf_hi(hw.x); hv[2] = bf_lo(hw.y); hv[3] = bf_hi(hw.y); }
                            pg8::f32x4 a = acc[ai][bj][m][n];
                            if (GATE) { const pg8::u32x2 p2 = pw[mm][bj][n]; const float rs_ = rsc[mm];
                                a[0] = sigmoidf_(a[0] * rs_) * bf_lo(p2.x); a[1] = sigmoidf_(a[1] * rs_) * bf_hi(p2.x); a[2] = sigmoidf_(a[2] * rs_) * bf_lo(p2.y); a[3] = sigmoidf_(a[3] * rs_) * bf_hi(p2.y); }
                            hv = hv + a;
                            pg8::u32x2 w; w.x = hw_pk2(hv[0], hv[1]); w.y = hw_pk2(hv[2], hv[3]); *(pg8::u32x2*)(hout + o) = w;
                            if (h8) { int x8 = __builtin_amdgcn_cvt_pk_fp8_f32(hv[0], hv[1], 0, false); x8 = __builtin_amdgcn_cvt_pk_fp8_f32(hv[2], hv[3], x8, true); *(unsigned*)(h8 + o) = (unsigned)x8; }
                            const float q0 = bf_lo(w.x), q1 = bf_hi(w.x), q2 = bf_lo(w.y), q3 = bf_hi(w.y);
                            ss += (q0 * q0 + q1 * q1) + (q2 * q2 + q3 * q3); }
                    ss += __shfl_xor(ss, 16); ss += __shfl_xor(ss, 32);
                    if (fq == 0) rowss[(size_t)row * 32 + u.pn * 4 + wc] = ss; }
                asm volatile("" ::: "memory"); }
    }
};


__device__ __forceinline__ void p0_transpose_item(const float* W, int K, int N, bf16* WT, LAS float* scr, int item, int lane, const float* kgain = nullptr) {
    const int nblk = N / 32, kb = item / nblk, nb = item % nblk, k0 = 64 * kb, n0 = 32 * nb;
    { const GAS float* Wg = (const GAS float*)W + (size_t)(k0 + (lane >> 5)) * N + n0 + (lane & 31); float v[32];
#pragma unroll
      for (int i = 0; i < 32; ++i) v[i] = Wg[(size_t)(2 * i) * N];
#pragma unroll
      for (int i = 0; i < 32; ++i) scr[(2 * i + (lane >> 5)) * 33 + (lane & 31)] = v[i]; }
    LDS_WAIT(); asm volatile("" ::: "memory");
    const int c = lane & 7;
#pragma unroll
    for (int j = 0; j < 4; ++j) { const int n = (lane >> 3) + 8 * j; const LAS float* s = scr + (8 * c) * 33 + n;
        f32x4 g0 = {1.f, 1.f, 1.f, 1.f}, g1 = g0; if (kgain) { g0 = *(const GAS f32x4*)(kgain + k0 + 8 * c); g1 = *(const GAS f32x4*)(kgain + k0 + 8 * c + 4); }
        v4u o; o.x = pk2(s[0 * 33] * g0[0], s[1 * 33] * g0[1]); o.y = pk2(s[2 * 33] * g0[2], s[3 * 33] * g0[3]); o.z = pk2(s[4 * 33] * g1[0], s[5 * 33] * g1[1]); o.w = pk2(s[6 * 33] * g1[2], s[7 * 33] * g1[3]);
        *(GAS v4u*)(WT + (size_t)(n0 + n) * K + k0 + 8 * c) = o; }
    LDS_WAIT(); asm volatile("" ::: "memory");
}
__device__ __forceinline__ void p0_transpose_item_i8(const float* W, int K, int N, unsigned char* WT, LAS float* scr, int item, int lane, const float* cm) {
    const int nblk = N / 32, kb = item / nblk, nb = item % nblk, k0 = 64 * kb, n0 = 32 * nb;
    { const GAS float* Wg = (const GAS float*)W + (size_t)(k0 + (lane >> 5)) * N + n0 + (lane & 31); float v[32];
#pragma unroll
      for (int i = 0; i < 32; ++i) v[i] = Wg[(size_t)(2 * i) * N];
#pragma unroll
      for (int i = 0; i < 32; ++i) scr[(2 * i + (lane >> 5)) * 33 + (lane & 31)] = v[i]; }
    LDS_WAIT(); asm volatile("" ::: "memory");
    const int c = lane & 7;
#pragma unroll
    for (int j = 0; j < 4; ++j) { const int n = (lane >> 3) + 8 * j; const LAS float* s = scr + (8 * c) * 33 + n;
        const float mx = __uint_as_float(__hip_atomic_load((const unsigned*)cm + n0 + n, __ATOMIC_RELAXED, __HIP_MEMORY_SCOPE_AGENT)), inv = mx > 0.f ? 127.0f / mx : 0.f; unsigned w0 = 0, w1 = 0;
#pragma unroll
        for (int e = 0; e < 4; ++e) { w0 |= (__float_as_uint(__builtin_fmaf(s[e * 33], inv, 12582912.0f)) & 255u) << (8 * e); w1 |= (__float_as_uint(__builtin_fmaf(s[(4 + e) * 33], inv, 12582912.0f)) & 255u) << (8 * e); }
        u32x2 o; o.x = w0; o.y = w1;
        *(GAS u32x2*)(WT + (size_t)(n0 + n) * K + k0 + 8 * c) = o; }
    LDS_WAIT(); asm volatile("" ::: "memory");
}
__device__ __forceinline__ void colmax_item(const float* W, int K, int N, float* cm, int item, int lane) {
    const int ngrp = (N + 255) / 256, kb = item / ngrp, cg_ = item % ngrp, col = 256 * cg_ + 4 * lane;
    if (col >= N) return;
    const GAS f32x4* p = (const GAS f32x4*)((const GAS float*)W + (size_t)(64 * kb) * N + col); f32x4 m = {0.f, 0.f, 0.f, 0.f};
#pragma unroll 16
    for (int r = 0; r < 64; ++r) { const f32x4 v = *(const GAS f32x4*)((const GAS float*)p + (size_t)r * N);
#pragma unroll
        for (int e = 0; e < 4; ++e) m[e] = fmaxf(m[e], fabsf(v[e])); }
#pragma unroll
    for (int e = 0; e < 4; ++e) __hip_atomic_fetch_max((unsigned*)cm + col + e, __float_as_uint(m[e]), __ATOMIC_RELAXED, __HIP_MEMORY_SCOPE_AGENT);
}
__device__ __forceinline__ void p0_transpose_item_f8(const float* W, int K, int N, unsigned char* WT, LAS float* scr, int item, int lane, const float* kgain = nullptr) {
    const int nblk = N / 32, kb = item / nblk, nb = item % nblk, k0 = 64 * kb, n0 = 32 * nb;
    { const GAS float* Wg = (const GAS float*)W + (size_t)(k0 + (lane >> 5)) * N + n0 + (lane & 31); float v[32];
#pragma unroll
      for (int i = 0; i < 32; ++i) v[i] = Wg[(size_t)(2 * i) * N];
#pragma unroll
      for (int i = 0; i < 32; ++i) scr[(2 * i + (lane >> 5)) * 33 + (lane & 31)] = v[i]; }
    LDS_WAIT(); asm volatile("" ::: "memory");
    const int c = lane & 7;
#pragma unroll
    for (int j = 0; j < 4; ++j) { const int n = (lane >> 3) + 8 * j; const LAS float* s = scr + (8 * c) * 33 + n;
        f32x4 g0 = {64.f, 64.f, 64.f, 64.f}, g1 = g0; if (kgain) { g0 = g0 * *(const GAS f32x4*)(kgain + k0 + 8 * c); g1 = g1 * *(const GAS f32x4*)(kgain + k0 + 8 * c + 4); }
        int x0 = __builtin_amdgcn_cvt_pk_fp8_f32(s[0 * 33] * g0[0], s[1 * 33] * g0[1], 0, false); x0 = __builtin_amdgcn_cvt_pk_fp8_f32(s[2 * 33] * g0[2], s[3 * 33] * g0[3], x0, true);
        int x1 = __builtin_amdgcn_cvt_pk_fp8_f32(s[4 * 33] * g1[0], s[5 * 33] * g1[1], 0, false); x1 = __builtin_amdgcn_cvt_pk_fp8_f32(s[6 * 33] * g1[2], s[7 * 33] * g1[3], x1, true);
        u32x2 o; o.x = (unsigned)x0; o.y = (unsigned)x1;
        *(GAS u32x2*)(WT + (size_t)(n0 + n) * K + k0 + 8 * c) = o; }
    LDS_WAIT(); asm volatile("" ::: "memory");
}
__device__ __forceinline__ void cvt_f32_bf16(const float* src, bf16* dst, size_t n, int gtid, int gthreads) {
    const size_t n8 = n / 8;
    for (size_t i = gtid; i < n8; i += gthreads) {
        const f32x4 a = *(const GAS f32x4*)(src + i * 8), b = *(const GAS f32x4*)(src + i * 8 + 4);
        v4u o; o.x = pk2(a[0], a[1]); o.y = pk2(a[2], a[3]); o.z = pk2(b[0], b[1]); o.w = pk2(b[2], b[3]);
        *(GAS v4u*)(dst + i * 8) = o; }
}
__device__ __forceinline__ void cvt_f32_fp8(const float* src, unsigned char* dst, size_t n, float scale, int gtid, int gthreads, const float* cgain = nullptr) {
    const size_t n16 = n / 16;
    for (size_t i = gtid; i < n16; i += gthreads) { v4u o; unsigned w[4];
#pragma unroll
        for (int q = 0; q < 4; ++q) { f32x4 a = *(const GAS f32x4*)(src + i * 16 + 4 * q) * scale; if (cgain) a = a * *(const GAS f32x4*)(cgain + ((i * 16 + 4 * q) & (D - 1)));
            int x = __builtin_amdgcn_cvt_pk_fp8_f32(a[0], a[1], 0, false); x = __builtin_amdgcn_cvt_pk_fp8_f32(a[2], a[3], x, true); w[q] = (unsigned)x; }
        o.x = w[0]; o.y = w[1]; o.z = w[2]; o.w = w[3];
        *(GAS v4u*)(dst + i * 16) = o; }
}
__device__ __forceinline__ void cvt_rows_i8(const float* src, unsigned char* dst, float* SU, int rows, int gw, int NGW, int lane, const float* cgain) {
    for (int r = gw; r < rows; r += NGW) {
        f32x4 a[8]; float mx = 0.f;
#pragma unroll
        for (int i = 0; i < 8; ++i) { a[i] = *(const GAS f32x4*)(src + (size_t)r * D + 256 * i + 4 * lane); if (cgain) a[i] = a[i] * *(const GAS f32x4*)(cgain + 256 * i + 4 * lane);
            mx = fmaxf(mx, fmaxf(fmaxf(fabsf(a[i][0]), fabsf(a[i][1])), fmaxf(fabsf(a[i][2]), fabsf(a[i][3])))); }
#pragma unroll
        for (int o = 1; o < 64; o <<= 1) mx = fmaxf(mx, __shfl_xor(mx, o));
        const float inv = mx > 0.f ? 127.0f / mx : 0.f;
#pragma unroll
        for (int i = 0; i < 8; ++i) { unsigned w = 0;
#pragma unroll
            for (int e = 0; e < 4; ++e) w |= (__float_as_uint(__builtin_fmaf(a[i][e], inv, 12582912.0f)) & 255u) << (8 * e);
            *(GAS unsigned*)(dst + (size_t)r * D + 256 * i + 4 * lane) = w; }
        if (lane == 0) SU[r] = mx * (1.0f / 127.0f);
    }
}
__device__ __forceinline__ void rms_row_to_bf16(const float* xrow, const float* g, bf16* orow, int lane) {
    const GAS f32x4* xr = (const GAS f32x4*)xrow + lane; f32x4 v[8]; float s = 0.f;
#pragma unroll
    for (int j = 0; j < 8; ++j) { v[j] = xr[64 * j]; s += (v[j][0] * v[j][0] + v[j][1] * v[j][1]) + (v[j][2] * v[j][2] + v[j][3] * v[j][3]); }
    const float r = __builtin_amdgcn_rsqf(wave_sum(s) * (1.0f / D) + EPS);
    const GAS f32x4* gr = (const GAS f32x4*)g + lane;
    GAS unsigned long long* o8 = (GAS unsigned long long*)orow + lane;
#pragma unroll
    for (int j = 0; j < 8; ++j) { const f32x4 gg = gr[64 * j]; o8[64 * j] = (unsigned long long)pk2(v[j][0] * r * gg[0], v[j][1] * r * gg[1]) | ((unsigned long long)pk2(v[j][2] * r * gg[2], v[j][3] * r * gg[3]) << 32); }
}
__device__ __forceinline__ void rms_row_to_i8(const float* xrow, const float* g, unsigned char* orow, float* sa, int lane) {
    const GAS f32x4* xr = (const GAS f32x4*)xrow + lane; f32x4 v[8]; float s = 0.f;
#pragma unroll
    for (int j = 0; j < 8; ++j) { v[j] = xr[64 * j]; s += (v[j][0] * v[j][0] + v[j][1] * v[j][1]) + (v[j][2] * v[j][2] + v[j][3] * v[j][3]); }
    const float r = __builtin_amdgcn_rsqf(wave_sum(s) * (1.0f / D) + EPS);
    const GAS f32x4* gr = (const GAS f32x4*)g + lane; float mx = 0.f;
#pragma unroll
    for (int j = 0; j < 8; ++j) { v[j] = v[j] * gr[64 * j] * r; mx = fmaxf(mx, fmaxf(fmaxf(fabsf(v[j][0]), fabsf(v[j][1])), fmaxf(fabsf(v[j][2]), fabsf(v[j][3])))); }
#pragma unroll
    for (int o = 1; o < 64; o <<= 1) mx = fmaxf(mx, __shfl_xor(mx, o));
    const float inv = mx > 0.f ? 127.0f / mx : 0.f;
    GAS unsigned* o4 = (GAS unsigned*)orow + lane;
#pragma unroll
    for (int j = 0; j < 8; ++j) { unsigned w = 0;
#pragma unroll
        for (int e = 0; e < 4; ++e) w |= (__float_as_uint(__builtin_fmaf(v[j][e], inv, 12582912.0f)) & 255u) << (8 * e);
        o4[64 * j] = w; }
    if (lane == 0) *sa = mx * (1.0f / (127.0f * 127.0f));
}
__device__ __forceinline__ void rms_row_to_f8(const float* xrow, const float* g, unsigned char* orow, int lane) {
    const GAS f32x4* xr = (const GAS f32x4*)xrow + lane; f32x4 v[8]; float s = 0.f;
#pragma unroll
    for (int j = 0; j < 8; ++j) { v[j] = xr[64 * j]; s += (v[j][0] * v[j][0] + v[j][1] * v[j][1]) + (v[j][2] * v[j][2] + v[j][3] * v[j][3]); }
    const float r = __builtin_amdgcn_rsqf(wave_sum(s) * (1.0f / D) + EPS);
    const GAS f32x4* gr = (const GAS f32x4*)g + lane;
    GAS unsigned* o4 = (GAS unsigned*)orow + lane;
#pragma unroll
    for (int j = 0; j < 8; ++j) { const f32x4 q = v[j] * gr[64 * j] * r; int x = __builtin_amdgcn_cvt_pk_fp8_f32(q[0], q[1], 0, false); x = __builtin_amdgcn_cvt_pk_fp8_f32(q[2], q[3], x, true); o4[64 * j] = (unsigned)x; }
}
__device__ __forceinline__ void p0_fold_item(const float* wq, const float* sk, bf16* WP, LAS float* lds, int item, int tid, const float* kgain) {
    const int hp = item >> 5, k0 = (item & 31) * 64;
    LAS float* skT = lds;
    LAS float* wqT = lds + 128 * 132;
    const float* skb = sk + (size_t)hp * 128 * 128;
#pragma unroll 4
    for (int i = 0; i < 32; ++i) { const int idx = i * 512 + tid, n = idx >> 7, d = idx & 127; skT[d * 132 + n] = skb[idx]; }
#pragma unroll 4
    for (int i = 0; i < 16; ++i) { const int idx = i * 512 + tid, kk = idx >> 7, d = idx & 127; wqT[d * 68 + kk] = wq[(size_t)(k0 + kk) * D + hp * 128 + d] * kgain[k0 + kk]; }
    __syncthreads();
    const int n0 = (tid >> 4) * 4, kk0 = (tid & 15) * 4;
    float acc[4][4];
#pragma unroll
    for (int i = 0; i < 4; ++i)
#pragma unroll
        for (int j = 0; j < 4; ++j) acc[i][j] = 0.f;
#pragma unroll 4
    for (int d = 0; d < 128; ++d) { const f32x4 a = *(const LAS f32x4*)(skT + d * 132 + n0), b = *(const LAS f32x4*)(wqT + d * 68 + kk0);
#pragma unroll
        for (int i = 0; i < 4; ++i)
#pragma unroll
            for (int j = 0; j < 4; ++j) acc[i][j] += a[i] * b[j]; }
#pragma unroll
    for (int i = 0; i < 4; ++i) { unsigned long long o = (unsigned long long)pk2(acc[i][0], acc[i][1]) | ((unsigned long long)pk2(acc[i][2], acc[i][3]) << 32);
        *(GAS unsigned long long*)(WP + (size_t)(hp * 128 + n0 + i) * D + k0 + kk0) = o; }
    __syncthreads();
}
__device__ __forceinline__ void p0_prologue(const Args& A, Frame& F, const int part) {
    const int gw = F.vcu * NWAVES + F.wave, NGW = F.G * NWAVES;
    const int gtid = gw * 64 + F.lane, gthreads = F.G * NTHREADS;
    unsigned char* ws = A.ws;
    LAS float* scr = (LAS float*)(F.lds + RING_OFF + F.wave * 16384);
    constexpr int I_EVIN = (D / 64) * (EV_N / 32);
    if (part == 1) {
        for (int it = gw; it < I_EVIN; it += NGW) p0_transpose_item_i8(A.in[I_EV_WIN], D, EV_N, (unsigned char*)(ws + WS_WEV_IN), scr, it, F.lane, (const float*)(ws + WS_CMB));
        return; }
    { constexpr int I_CM = (D / 64) * ((EV_N + 255) / 256);
      for (int it = gw; it < I_CM; it += NGW) colmax_item(A.in[I_EV_WIN], D, EV_N, (float*)(ws + WS_CMB), it, F.lane); }
    { GAS v4u* z0 = (GAS v4u*)(ws + WS_WEV_IN + (size_t)EV_N * D); const size_t n0 = (size_t)(EV_NP - EV_N) * D / 16;
      for (size_t i = gtid; i < n0; i += gthreads) z0[i] = (v4u){0u, 0u, 0u, 0u}; }
    { constexpr int I_PJ = (256 / 64) * (D / 32);
      for (int it = gw; it < 2 * I_PJ; it += NGW) { const int L = it / I_PJ; p0_transpose_item(A.in[I_PLE_WP] + (size_t)L * 256 * D, 256, D, (bf16*)(ws + WS_WPROJ) + (size_t)L * D * 256, scr, it % I_PJ, F.lane); } }
    cvt_f32_bf16(A.in[I_P], (bf16*)(ws + WS_PBF), (size_t)2 * T * 256, gtid, gthreads);
    for (int m = gw; m < T; m += NGW) rms_row_to_i8(A.in[I_X] + (size_t)m * D, A.in[I_NMIX], (unsigned char*)(ws + WS_ACTA) + (size_t)m * D, (float*)(ws + WS_SA) + m, F.lane);
#if EV_F8_T1 > EV_F8_T0
    for (int it = gw; it < I_EVIN; it += NGW) p0_transpose_item_f8(A.in[I_EV_WIN], D, EV_N, (unsigned char*)(ws + WS_O), scr, it, F.lane);
    { GAS v4u* z0 = (GAS v4u*)(ws + WS_O + (size_t)EV_N * D); const size_t n0 = (size_t)(EV_NP - EV_N) * D / 16;
      for (size_t i = gtid; i < n0; i += gthreads) z0[i] = (v4u){0u, 0u, 0u, 0u}; }
    for (int m = gw; m < T; m += NGW) rms_row_to_f8(A.in[I_X] + (size_t)m * D, A.in[I_NMIX], (unsigned char*)(ws + WS_H1) + (size_t)m * D, F.lane);
#endif
}
__device__ __forceinline__ void p0_deferred(const Args& A, Frame& F, int wg, int nwg) {
    const int gw = wg * NWAVES + F.wave, NGW = nwg * NWAVES;
    int gtid = gw * 64 + F.lane; const int gthreads = nwg * NTHREADS;
    asm volatile("" : "+v"(gtid));
    unsigned char* ws = A.ws;
    {
        LAS float* scr = (LAS float*)(F.lds + RING_OFF + F.wave * 16384);
        constexpr int I_SQ = (D / 64) * (D / 32), I_ODIN = (D / 64) * (OD_N / 32);
        constexpr int NITEMS = I_SQ + I_ODIN + I_SQ;
        for (int it = gw; it < NITEMS; it += NGW) {
            int r = it;
            if (r < I_SQ) { p0_transpose_item(A.in[I_EV_WOUT], D, D, (bf16*)(ws + WS_WEV_OUT), scr, r, F.lane); continue; } r -= I_SQ;
            if (r < I_ODIN) { p0_transpose_item_f8(A.in[I_OD_WIN], D, OD_N, (unsigned char*)(ws + WS_WOD_IN), scr, r, F.lane, A.in[I_NMIX] + D); continue; } r -= I_ODIN;
            p0_transpose_item_f8(A.in[I_PLE_WG], D, D, (unsigned char*)(ws + WS_WGATE), scr, r, F.lane, A.in[I_NPLE]);
        }
        { GAS v4u* z1 = (GAS v4u*)(ws + WS_WOD_IN + (size_t)OD_N * D); const size_t n1 = (size_t)(OD_NP - OD_N) * D / 16;
          for (size_t i = gtid; i < n1; i += gthreads) z1[i] = (v4u){0u, 0u, 0u, 0u}; }
    }
    __syncthreads();
    for (int it = wg; it < 512; it += nwg)
        p0_fold_item(A.in[I_PEER_WQ], A.in[I_PEER_SK], (bf16*)(ws + WS_WPEER), (LAS float*)(F.lds + RING_OFF), it, F.tid, A.in[I_NFFN]);
    cvt_rows_i8(A.in[I_PEER_U], (unsigned char*)(ws + WS_TABU), (float*)(ws + WS_SU), 16384, gw, NGW, F.lane, A.in[I_NFFN]);
    cvt_rows_i8(A.in[I_PEER_V], (unsigned char*)(ws + WS_TABV), (float*)(ws + WS_SU) + 32768, 16384, gw, NGW, F.lane, nullptr);
    { bf16* LB = (bf16*)(ws + WS_WLORA); const float* w2 = A.in[I_W2]; const float* a2 = A.in[I_A2]; const float* g2 = A.in[I_G2];
      for (int i = gtid; i < LORA_N * LORA_K / 2; i += gthreads) { const int row = i / (LORA_K / 2), col = (i % (LORA_K / 2)) * 2; float v[2];
#pragma unroll
          for (int e = 0; e < 2; ++e) { const int c = col + e; float x = 0.f;
              if (row < 1024) { if (c < 96) x = w2[c * 1024 + row]; }
              else if (row < 2048) { if (c >= 96 && c < 192) x = a2[(c - 96) * 1024 + (row - 1024)]; }
              else { if (c >= 192 && c < 448) x = g2[(c - 192) * 1024 + (row - 2048)]; }
              v[e] = x; }
          *(GAS unsigned*)(LB + (size_t)row * LORA_K + col) = pk2(v[0], v[1]); } }
}
__device__ __forceinline__ void p1_deferred(const Args& A, Frame& F, int wg, int nwg) {
    const int gw = wg * NWAVES + F.wave, NGW = nwg * NWAVES;
    int gtid = gw * 64 + F.lane; const int gthreads = nwg * NTHREADS;
    asm volatile("" : "+v"(gtid));
    unsigned char* ws = A.ws;
    { LAS float* scr = (LAS float*)(F.lds + RING_OFF + F.wave * 16384); constexpr int I_SQ = (D / 64) * (D / 32);
      for (int it = gw; it < 2 * I_SQ; it += NGW) {
          if (it < I_SQ) p0_transpose_item_f8(A.in[I_OD_WOUT], D, D, (unsigned char*)(ws + WS_WOD_OUT), scr, it, F.lane);
          else p0_transpose_item_f8(A.in[I_PLE_WG] + (size_t)D * D, D, D, (unsigned char*)((bf16*)(ws + WS_WGATE) + (size_t)D * D), scr, it - I_SQ, F.lane, A.in[I_NPLE] + D); } }
    __syncthreads();
    for (int it = wg; it < 512; it += nwg)
        p0_fold_item(A.in[I_PEER_WQ] + (size_t)D * D, A.in[I_PEER_SK] + (size_t)16 * 128 * 128, (bf16*)(ws + WS_WPEER) + (size_t)D * D, (LAS float*)(F.lds + RING_OFF), it, F.tid, A.in[I_NFFN] + D);
    cvt_rows_i8(A.in[I_PEER_U] + (size_t)16384 * D, (unsigned char*)(ws + WS_TABU) + (size_t)16384 * D, (float*)(ws + WS_SU) + 16384, 16384, gw, NGW, F.lane, A.in[I_NFFN] + D);
    cvt_rows_i8(A.in[I_PEER_V] + (size_t)16384 * D, (unsigned char*)(ws + WS_TABV) + (size_t)16384 * D, (float*)(ws + WS_SU) + 32768 + 16384, 16384, gw, NGW, F.lane, nullptr);
}

constexpr int TC = 16, NCHUNK = SEQ / TC;

template <int MODE>
__device__ __forceinline__ void scan_gla_unit(const Args& A, Frame& F, int unit) {
    int tid = F.tid; asm volatile("" : "+v"(tid));
    const int lane = tid & 63, w = F.wave;
    int b, h, qcol, kcol, vcol, ocol;
    if (MODE == 0) { b = unit >> 4; h = (unit >> 2) & 3; const int s = unit & 3; qcol = EC_GQ + h * 128; kcol = EC_GK + h * 128; vcol = EC_GV + h * 256 + s * 64; ocol = h * 256 + s * 64; }
    else           { b = unit >> 4; h = (unit >> 1) & 7; const int s = unit & 1; qcol = OC_HQ + h * 128; kcol = OC_HF + h * 128; vcol = OC_HI + h * 128 + s * 64; ocol = h * 128 + s * 64; }
    const bf16* P = (const bf16*)(A.ws + WS_PROJ) + (size_t)b * SEQ * PROJ_LD;
    float* O = (float*)(A.ws + WS_O) + (size_t)b * SEQ * D + ocol;
    LAS float* Lf = (LAS float*)(F.lds + RING_OFF);
    constexpr int BUFSZ = 7168, O_EG = 0, O_K = 2048, O_Q = 4096, O_V = 6144, O_OUT = 2 * BUFSZ, O_W2 = O_OUT + 1024, O_BIAS = O_W2 + 2048;
    const int tl = tid >> 5, dq = (tid & 31) * 4, tlv = tid >> 4, c4 = (tid & 15) * 4;
    float lb[4] = {0.f, 0.f, 0.f, 0.f};
    if (MODE == 0) {
        const float* w2 = A.in[I_GK_W2]; const float* gb = A.in[I_GK_B];
        for (int i = tid; i < 2048; i += NTHREADS) Lf[O_W2 + i] = w2[(i >> 7) * 512 + h * 128 + (i & 127)];
        if (tid < 128) Lf[O_BIAS + tid] = gb[h * 128 + tid];
    } else {
        const float* lg = A.in[I_LB];
#pragma unroll
        for (int i = 0; i < 4; ++i) lb[i] = sigmoidf_(lg[1024 + h * 128 + dq + i] - lg[h * 128 + dq + i]);
    }
    u32x2 rq, rk, rv = {0u, 0u}; v4u rg0 = {0u, 0u, 0u, 0u}, rg1 = {0u, 0u, 0u, 0u};
#define GLA_LOAD(c) do { const bf16* pr = P + (size_t)((c) * TC + tl) * PROJ_LD; rq = *(const GAS u32x2*)(pr + qcol + dq); rk = *(const GAS u32x2*)(pr + kcol + dq); \
        if (MODE == 0) { rg0 = *(const GAS v4u*)(pr + EC_GLR); rg1 = *(const GAS v4u*)(pr + EC_GLR + 8); } \
        if (tid < 256) rv = *(const GAS u32x2*)(P + (size_t)((c) * TC + tlv) * PROJ_LD + vcol + c4); } while (0)
#define GLA_XFORM(bufi) do { LAS float* B_ = Lf + (bufi) * BUFSZ; f32x4 q4, k4, e4; \
        const float xq[4] = {bf_lo(rq.x), bf_hi(rq.x), bf_lo(rq.y), bf_hi(rq.y)}, xk[4] = {bf_lo(rk.x), bf_hi(rk.x), bf_lo(rk.y), bf_hi(rk.y)}; \
        if (MODE == 0) { f32x4 z = *(const LAS f32x4*)(Lf + O_BIAS + dq); \
            const float gl[16] = {bf_lo(rg0.x), bf_hi(rg0.x), bf_lo(rg0.y), bf_hi(rg0.y), bf_lo(rg0.z), bf_hi(rg0.z), bf_lo(rg0.w), bf_hi(rg0.w), \
                                  bf_lo(rg1.x), bf_hi(rg1.x), bf_lo(rg1.y), bf_hi(rg1.y), bf_lo(rg1.z), bf_hi(rg1.z), bf_lo(rg1.w), bf_hi(rg1.w)}; \
            _Pragma("unroll") for (int r_ = 0; r_ < 16; ++r_) { const f32x4 wv = *(const LAS f32x4*)(Lf + O_W2 + r_ * 128 + dq); z = z + wv * gl[r_]; } \
            _Pragma("unroll") for (int i_ = 0; i_ < 4; ++i_) { q4[i_] = xq[i_] * 0.08838834764831845f; k4[i_] = xk[i_]; e4[i_] = __builtin_amdgcn_exp2f(-0.0625f * __builtin_amdgcn_logf(1.0f + __expf(-z[i_]))); } } \
        else { _Pragma("unroll") for (int i_ = 0; i_ < 4; ++i_) { const float fg = lb[i_] + (1.f - lb[i_]) * sigmoidf_(xk[i_]); q4[i_] = siluf_(xq[i_]); k4[i_] = 1.f - fg; e4[i_] = fg; } } \
        *(LAS f32x4*)(B_ + O_EG + tl * 128 + dq) = e4; *(LAS f32x4*)(B_ + O_K + tl * 128 + dq) = k4; *(LAS f32x4*)(B_ + O_Q + tl * 128 + dq) = q4; \
        if (tid < 256) { f32x4 v4 = {bf_lo(rv.x), bf_hi(rv.x), bf_lo(rv.y), bf_hi(rv.y)}; *(LAS f32x4*)(B_ + O_V + tlv * 64 + c4) = v4; } } while (0)
    LBAR();
    GLA_LOAD(0); GLA_XFORM(0);
    LBAR();
    f32x2 S2[8];
#pragma unroll
    for (int i = 0; i < 8; ++i) S2[i] = (f32x2){0.f, 0.f};
    const int j = lane & 15, col = w * 8 + (lane >> 4) * 2;
    for (int c = 0; c < NCHUNK; ++c) {
        if (c + 1 < NCHUNK) GLA_LOAD(c + 1);
        const LAS float* B_ = Lf + (c & 1) * BUFSZ;
        float os0 = 0.f, os1 = 0.f;
        f32x4 e0, e1, k0, k1, q0, q1, ne0, ne1, nk0, nk1, nq0, nq1; f32x2 v2, nv2;
#define GLA_LDSTEP(t_, E0, E1, K0, K1, Q0, Q1, V2) do { E0 = *(const LAS f32x4*)(B_ + O_EG + (t_) * 128 + 4 * j); E1 = *(const LAS f32x4*)(B_ + O_EG + (t_) * 128 + 64 + 4 * j); \
            K0 = *(const LAS f32x4*)(B_ + O_K + (t_) * 128 + 4 * j); K1 = *(const LAS f32x4*)(B_ + O_K + (t_) * 128 + 64 + 4 * j); \
            Q0 = *(const LAS f32x4*)(B_ + O_Q + (t_) * 128 + 4 * j); Q1 = *(const LAS f32x4*)(B_ + O_Q + (t_) * 128 + 64 + 4 * j); V2 = *(const LAS f32x2*)(B_ + O_V + (t_) * 64 + col); } while (0)
        GLA_LDSTEP(0, e0, e1, k0, k1, q0, q1, v2);
#pragma unroll
        for (int t = 0; t < TC; ++t) {
            if (t + 1 < TC) { GLA_LDSTEP(t + 1, ne0, ne1, nk0, nk1, nq0, nq1, nv2); }
            __builtin_amdgcn_sched_barrier(0);
            f32x2 pa = {0.f, 0.f}, pb = {0.f, 0.f};
#pragma unroll
            for (int i = 0; i < 4; ++i) {
                S2[i] = S2[i] * e0[i] + v2 * k0[i]; S2[4 + i] = S2[4 + i] * e1[i] + v2 * k1[i];
                pa += S2[i] * q0[i]; pb += S2[4 + i] * q1[i]; }
            pa += pb;
            float p0 = pa[0], p1 = pa[1];
            row_sum16_x2(p0, p1);
            os0 = (j == t) ? p0 : os0; os1 = (j == t) ? p1 : os1;
            e0 = ne0; e1 = ne1; k0 = nk0; k1 = nk1; q0 = nq0; q1 = nq1; v2 = nv2;
        }
#undef GLA_LDSTEP
        { f32x2 o2 = {os0, os1}; *(LAS f32x2*)(Lf + O_OUT + j * 64 + col) = o2; }
        if (c + 1 < NCHUNK) GLA_XFORM((c + 1) & 1);
        LBAR();
        if (tid < 256) *(GAS f32x4*)(O + (size_t)(c * TC + tlv) * D + c4) = *(const LAS f32x4*)(Lf + O_OUT + tlv * 64 + c4);
        LBAR();
    }
#undef GLA_LOAD
#undef GLA_XFORM
}

__device__ __forceinline__ void scan_gdn_unit(const Args& A, Frame& F, int unit) {
    int tid = F.tid; asm volatile("" : "+v"(tid));
    const int lane = tid & 63, w = F.wave;
    const int b = unit >> 4, h = (unit >> 1) & 7, s = unit & 1;
    const int qcol = EC_BQ + h * 128, kcol = EC_BK + h * 128, vcol = EC_BV + h * 128 + s * 64, ocol = 1024 + h * 128 + s * 64;
    const bf16* P = (const bf16*)(A.ws + WS_PROJ) + (size_t)b * SEQ * PROJ_LD;
    float* O = (float*)(A.ws + WS_O) + (size_t)b * SEQ * D + ocol;
    LAS float* Lf = (LAS float*)(F.lds + RING_OFF);
    constexpr int BUFSZ = 5184, O_K = 0, O_Q = 2048, O_V = 4096, O_SC = 5120, O_OUT = 2 * BUFSZ, O_CW = O_OUT + 1024;
    const int tl = tid >> 5, dq = (tid & 31) * 4, tlv = tid >> 4, c4 = (tid & 15) * 4;
    { const float* cw = A.in[I_GDN_CONV];
      for (int i = tid; i < 4 * 320; i += NTHREADS) { const int jt = i / 320, x = i % 320;
          const int ch = x < 128 ? (h * 128 + x) : x < 256 ? (1024 + h * 128 + (x - 128)) : (2048 + h * 128 + s * 64 + (x - 256));
          Lf[O_CW + i] = cw[jt * 3072 + ch]; } }
    const float neg_ea = -__expf(A.in[I_GDN_ALOG][h]), dtb = A.in[I_GDN_DTB][h];
    u32x2 rq[4], rk[4], rv[4]; unsigned short rba = 0, rbb = 0;
#pragma unroll
    for (int i = 0; i < 4; ++i) rv[i] = (u32x2){0u, 0u};
#define GDN_LOAD(c) do { const int t_ = (c) * TC + tl; \
        _Pragma("unroll") for (int jt = 0; jt < 4; ++jt) { const int tt = t_ - 3 + jt; \
            if (tt >= 0) { const bf16* pr = P + (size_t)tt * PROJ_LD; rq[jt] = *(const GAS u32x2*)(pr + qcol + dq); rk[jt] = *(const GAS u32x2*)(pr + kcol + dq); } \
            else { rq[jt] = (u32x2){0u, 0u}; rk[jt] = (u32x2){0u, 0u}; } } \
        { const bf16* pr = P + (size_t)t_ * PROJ_LD; rba = pr[EC_BA + h]; rbb = pr[EC_BB + h]; } \
        if (tid < 256) { const int tv = (c) * TC + tlv; \
            _Pragma("unroll") for (int jt = 0; jt < 4; ++jt) { const int tt = tv - 3 + jt; \
                if (tt >= 0) rv[jt] = *(const GAS u32x2*)(P + (size_t)tt * PROJ_LD + vcol + c4); else rv[jt] = (u32x2){0u, 0u}; } } } while (0)
#define GDN_XFORM(bufi) do { LAS float* B_ = Lf + (bufi) * BUFSZ; f32x4 q4 = {0.f, 0.f, 0.f, 0.f}, k4 = {0.f, 0.f, 0.f, 0.f}; \
        _Pragma("unroll") for (int jt = 0; jt < 4; ++jt) { const f32x4 wq = *(const LAS f32x4*)(Lf + O_CW + jt * 320 + dq), wk = *(const LAS f32x4*)(Lf + O_CW + jt * 320 + 128 + dq); \
            q4[0] += wq[0] * bf_lo(rq[jt].x); q4[1] += wq[1] * bf_hi(rq[jt].x); q4[2] += wq[2] * bf_lo(rq[jt].y); q4[3] += wq[3] * bf_hi(rq[jt].y); \
            k4[0] += wk[0] * bf_lo(rk[jt].x); k4[1] += wk[1] * bf_hi(rk[jt].x); k4[2] += wk[2] * bf_lo(rk[jt].y); k4[3] += wk[3] * bf_hi(rk[jt].y); } \
        float sq = 0.f, sk = 0.f, sqk = 0.f; \
        _Pragma("unroll") for (int i_ = 0; i_ < 4; ++i_) { q4[i_] = siluf_(q4[i_]); k4[i_] = siluf_(k4[i_]); sq += q4[i_] * q4[i_]; sk += k4[i_] * k4[i_]; sqk += q4[i_] * k4[i_]; } \
        sq = half_sum32(sq); sk = half_sum32(sk); sqk = half_sum32(sqk); \
        const float rq_ = __builtin_amdgcn_rsqf(sq + EPS) * 0.08838834764831845f, rk_ = __builtin_amdgcn_rsqf(sk + EPS); \
        q4 = q4 * rq_; k4 = k4 * rk_; \
        *(LAS f32x4*)(B_ + O_K + tl * 128 + dq) = k4; *(LAS f32x4*)(B_ + O_Q + tl * 128 + dq) = q4; \
        if ((tid & 31) == 0) { const float ba = __uint_as_float((unsigned)rba << 16), bb = __uint_as_float((unsigned)rbb << 16); \
            f32x4 sc; sc[0] = __expf(neg_ea * softplusf_(ba + dtb)); sc[1] = sigmoidf_(bb); sc[2] = sqk * rq_ * rk_; sc[3] = 0.f; *(LAS f32x4*)(B_ + O_SC + tl * 4) = sc; } \
        if (tid < 256) { f32x4 v4 = {0.f, 0.f, 0.f, 0.f}; \
            _Pragma("unroll") for (int jt = 0; jt < 4; ++jt) { const f32x4 wv = *(const LAS f32x4*)(Lf + O_CW + jt * 320 + 256 + c4); \
                v4[0] += wv[0] * bf_lo(rv[jt].x); v4[1] += wv[1] * bf_hi(rv[jt].x); v4[2] += wv[2] * bf_lo(rv[jt].y); v4[3] += wv[3] * bf_hi(rv[jt].y); } \
            _Pragma("unroll") for (int i_ = 0; i_ < 4; ++i_) v4[i_] = siluf_(v4[i_]); \
            *(LAS f32x4*)(B_ + O_V + tlv * 64 + c4) = v4; } } while (0)
    LBAR();
    GDN_LOAD(0); GDN_XFORM(0);
    LBAR();
    f32x2 S2[8];
#pragma unroll
    for (int i = 0; i < 8; ++i) S2[i] = (f32x2){0.f, 0.f};
    const int j = lane & 15, col = w * 8 + (lane >> 4) * 2;
    for (int c = 0; c < NCHUNK; ++c) {
        if (c + 1 < NCHUNK) GDN_LOAD(c + 1);
        const LAS float* B_ = Lf + (c & 1) * BUFSZ;
        float os0 = 0.f, os1 = 0.f;
        f32x4 k0, k1, q0, q1, sc, nk0, nk1, nq0, nq1, nsc; f32x2 v2, nv2;
#define GDN_LDSTEP(t_, K0, K1, Q0, Q1, V2, SC) do { K0 = *(const LAS f32x4*)(B_ + O_K + (t_) * 128 + 4 * j); K1 = *(const LAS f32x4*)(B_ + O_K + (t_) * 128 + 64 + 4 * j); \
            Q0 = *(const LAS f32x4*)(B_ + O_Q + (t_) * 128 + 4 * j); Q1 = *(const LAS f32x4*)(B_ + O_Q + (t_) * 128 + 64 + 4 * j); V2 = *(const LAS f32x2*)(B_ + O_V + (t_) * 64 + col); SC = *(const LAS f32x4*)(B_ + O_SC + (t_) * 4); } while (0)
        GDN_LDSTEP(0, k0, k1, q0, q1, v2, sc);
#pragma unroll
        for (int t = 0; t < TC; ++t) {
            if (t + 1 < TC) { GDN_LDSTEP(t + 1, nk0, nk1, nq0, nq1, nv2, nsc); }
            __builtin_amdgcn_sched_barrier(0);
            f32x2 d1 = {0.f, 0.f}, d2 = {0.f, 0.f}, e1 = {0.f, 0.f}, e2 = {0.f, 0.f};
#pragma unroll
            for (int i = 0; i < 4; ++i) { d1 += S2[i] * k0[i]; e1 += S2[4 + i] * k1[i]; d2 += S2[i] * q0[i]; e2 += S2[4 + i] * q1[i]; }
            d1 += e1; d2 += e2;
            { float r0_ = d1[0], r1_ = d1[1], r2_ = d2[0], r3_ = d2[1]; row_sum16_x4(r0_, r1_, r2_, r3_); d1[0] = r0_; d1[1] = r1_; d2[0] = r2_; d2[1] = r3_; }
            const float a = sc[0], beta = sc[1], qk = sc[2];
            const f32x2 dl = (v2 - d1 * a) * beta;
            const f32x2 o2 = d2 * a + dl * qk;
#pragma unroll
            for (int i = 0; i < 4; ++i) { S2[i] = S2[i] * a + dl * k0[i]; S2[4 + i] = S2[4 + i] * a + dl * k1[i]; }
            os0 = (j == t) ? o2[0] : os0; os1 = (j == t) ? o2[1] : os1;
            k0 = nk0; k1 = nk1; q0 = nq0; q1 = nq1; v2 = nv2; sc = nsc;
        }
#undef GDN_LDSTEP
        { f32x2 o2 = {os0, os1}; *(LAS f32x2*)(Lf + O_OUT + j * 64 + col) = o2; }
        if (c + 1 < NCHUNK) GDN_XFORM((c + 1) & 1);
        LBAR();
        if (tid < 256) *(GAS f32x4*)(O + (size_t)(c * TC + tlv) * D + c4) = *(const LAS f32x4*)(Lf + O_OUT + tlv * 64 + c4);
        LBAR();
    }
#undef GDN_LOAD
#undef GDN_XFORM
}

typedef short bf16x4_t __attribute__((ext_vector_type(4)));
__device__ __forceinline__ bf16x8 mk_frag(u32x2 lo, u32x2 hi) { v4u t; t.x = lo.x; t.y = lo.y; t.z = hi.x; t.w = hi.y; return __builtin_bit_cast(bf16x8, t); }
template <int MODE>
__device__ __forceinline__ void scan_gla_mfma_unit(const Args& A, Frame& F, int unit) {
    int tid = F.tid; asm volatile("" : "+v"(tid));
    const int lane = tid & 63, w = F.wave;
    int b, h, qcol, kcol, vcol, ocol;
    if (MODE == 0) { b = unit >> 3; h = (unit >> 1) & 3; const int s = unit & 1; qcol = EC_GQ + h * 128; kcol = EC_GK + h * 128; vcol = EC_GV + h * 256 + s * 128; ocol = h * 256 + s * 128; }
    else           { b = unit >> 3; h = unit & 7; qcol = OC_HQ + h * 128; kcol = OC_HF + h * 128; vcol = OC_HI + h * 128; ocol = h * 128; }
    const bf16* P = (const bf16*)(A.ws + WS_PROJ) + (size_t)b * SEQ * PROJ_LD;
    bf16* O = (bf16*)(A.ws + WS_O) + (size_t)b * SEQ * D + ocol;
    LAS float* Lf = (LAS float*)(F.lds + RING_OFF);
    constexpr int BUFSZ = 8192, O_E = 0, O_K = 2048, O_Q = 4096, O_V = 6144, RS = 136, O_QB = 2 * BUFSZ, O_KB = O_QB + 1088, O_KT = O_KB + 1088, O_BL = O_KT + 1024, O_AM = O_BL + 128, O_W2 = O_AM + 128, O_BIAS = O_W2 + 2048;
    LAS bf16* QB = (LAS bf16*)(Lf + O_QB); LAS bf16* KB = (LAS bf16*)(Lf + O_KB); LAS bf16* KT = (LAS bf16*)(Lf + O_KT); LAS bf16* AM = (LAS bf16*)(Lf + O_AM);
    const int tl = tid >> 5, dq = (tid & 31) * 4;
    float lb[4] = {0.f, 0.f, 0.f, 0.f};
    if (MODE == 0) {
        const float* w2 = A.in[I_GK_W2]; const float* gb = A.in[I_GK_B];
        for (int i = tid; i < 2048; i += NTHREADS) Lf[O_W2 + i] = w2[(i >> 7) * 512 + h * 128 + (i & 127)];
        if (tid < 128) Lf[O_BIAS + tid] = gb[h * 128 + tid];
    } else {
        const float* lg = A.in[I_LB];
#pragma unroll
        for (int i = 0; i < 4; ++i) lb[i] = sigmoidf_(lg[1024 + h * 128 + dq + i] - lg[h * 128 + dq + i]);
    }
    u32x2 rq, rk, rv; v4u rg0 = {0u, 0u, 0u, 0u}, rg1 = {0u, 0u, 0u, 0u};
#define GM_LOAD(c) do { const bf16* pr = P + (size_t)((c) * TC + tl) * PROJ_LD; rq = *(const GAS u32x2*)(pr + qcol + dq); rk = *(const GAS u32x2*)(pr + kcol + dq); rv = *(const GAS u32x2*)(pr + vcol + dq); \
        if (MODE == 0) { rg0 = *(const GAS v4u*)(pr + EC_GLR); rg1 = *(const GAS v4u*)(pr + EC_GLR + 8); } } while (0)
#define GM_XFORM(bufi) do { LAS float* B_ = Lf + (bufi) * BUFSZ; f32x4 q4, k4, e4; \
        const float xq[4] = {bf_lo(rq.x), bf_hi(rq.x), bf_lo(rq.y), bf_hi(rq.y)}, xk[4] = {bf_lo(rk.x), bf_hi(rk.x), bf_lo(rk.y), bf_hi(rk.y)}; \
        if (MODE == 0) { f32x4 z = *(const LAS f32x4*)(Lf + O_BIAS + dq); \
            const float gl[16] = {bf_lo(rg0.x), bf_hi(rg0.x), bf_lo(rg0.y), bf_hi(rg0.y), bf_lo(rg0.z), bf_hi(rg0.z), bf_lo(rg0.w), bf_hi(rg0.w), \
                                  bf_lo(rg1.x), bf_hi(rg1.x), bf_lo(rg1.y), bf_hi(rg1.y), bf_lo(rg1.z), bf_hi(rg1.z), bf_lo(rg1.w), bf_hi(rg1.w)}; \
            _Pragma("unroll") for (int r_ = 0; r_ < 16; ++r_) { const f32x4 wv = *(const LAS f32x4*)(Lf + O_W2 + r_ * 128 + dq); z = z + wv * gl[r_]; } \
            _Pragma("unroll") for (int i_ = 0; i_ < 4; ++i_) { q4[i_] = xq[i_] * 0.08838834764831845f; k4[i_] = xk[i_]; e4[i_] = __builtin_amdgcn_exp2f(-0.0625f * __builtin_amdgcn_logf(1.0f + __expf(-z[i_]))); } } \
        else { _Pragma("unroll") for (int i_ = 0; i_ < 4; ++i_) { const float fg = lb[i_] + (1.f - lb[i_]) * sigmoidf_(xk[i_]); q4[i_] = siluf_(xq[i_]); k4[i_] = 1.f - fg; e4[i_] = fg; } } \
        *(LAS f32x4*)(B_ + O_E + tl * 128 + dq) = e4; *(LAS f32x4*)(B_ + O_K + tl * 128 + dq) = k4; *(LAS f32x4*)(B_ + O_Q + tl * 128 + dq) = q4; \
        { f32x4 v4 = {bf_lo(rv.x), bf_hi(rv.x), bf_lo(rv.y), bf_hi(rv.y)}; *(LAS f32x4*)(B_ + O_V + tl * 128 + dq) = v4; } } while (0)
    LBAR();
    GM_LOAD(0); GM_XFORM(0); GM_LOAD(1);
    LBAR();
    f32x4 Sacc[8];
#pragma unroll
    for (int i = 0; i < 8; ++i) Sacc[i] = (f32x4){0.f, 0.f, 0.f, 0.f};
    const int fr = lane & 15, g = lane >> 4, c0 = w * 16;
    for (int c = 0; c < NCHUNK; ++c) {
        const LAS float* B_ = Lf + (c & 1) * BUFSZ;
        {
            const int seg = tid >> 7, d = tid & 127;
            float bt = 1.f, ball = 1.f;
#pragma unroll
            for (int t = 0; t < 16; ++t) { const float e = B_[O_E + t * 128 + d]; ball *= e; if (t < 4 * seg) bt = ball; }
            ball = fmaxf(ball, 1e-30f);
            unsigned short kt4[4];
#pragma unroll
            for (int i = 0; i < 4; ++i) { const int t = 4 * seg + i; bt = fmaxf(bt * B_[O_E + t * 128 + d], 1e-30f);
                const float kk = B_[O_K + t * 128 + d], qq = B_[O_Q + t * 128 + d], ib = __builtin_amdgcn_rcpf(bt);
                QB[t * RS + d] = hw_bf(qq * bt); KB[t * RS + d] = hw_bf(kk * ib); kt4[i] = (unsigned short)hw_bf(kk * ball * ib); }
            u32x2 kw; kw.x = (unsigned)kt4[0] | ((unsigned)kt4[1] << 16); kw.y = (unsigned)kt4[2] | ((unsigned)kt4[3] << 16);
            *(LAS u32x2*)(KT + d * 16 + 4 * seg) = kw;
            if (seg == 3) Lf[O_BL + d] = ball;
        }
        LBAR();
        if (w == 0) {
            f32x4 acc = {0.f, 0.f, 0.f, 0.f};
#pragma unroll
            for (int ks = 0; ks < 4; ++ks) { const bf16x8 af = *(const LAS bf16x8*)(QB + fr * RS + 32 * ks + 8 * g), bfm = *(const LAS bf16x8*)(KB + fr * RS + 32 * ks + 8 * g);
                acc = __builtin_amdgcn_mfma_f32_16x16x32_bf16(af, bfm, acc, 0, 0, 0); }
#pragma unroll
            for (int r = 0; r < 4; ++r) { const int t = 4 * g + r, s = fr; AM[t * 16 + s] = hw_bf(s <= t ? acc[r] : 0.f); }
        }
        if (c + 1 < NCHUNK) GM_XFORM((c + 1) & 1);
        if (c + 2 < NCHUNK) GM_LOAD(c + 2);
        LBAR();
        {
            u32x2 vlo; { const float v0 = B_[O_V + (4 * g + 0) * 128 + c0 + fr], v1 = B_[O_V + (4 * g + 1) * 128 + c0 + fr], v2 = B_[O_V + (4 * g + 2) * 128 + c0 + fr], v3 = B_[O_V + (4 * g + 3) * 128 + c0 + fr];
                vlo.x = hw_pk2(v0, v1); vlo.y = hw_pk2(v2, v3); }
            const u32x2 zz = {0u, 0u};
            const bf16x8 vb = mk_frag(vlo, zz);
            f32x4 acco = {0.f, 0.f, 0.f, 0.f};
#pragma unroll
            for (int ks = 0; ks < 4; ++ks) {
                u32x2 slo, shi; slo.x = hw_pk2(Sacc[2 * ks][0], Sacc[2 * ks][1]); slo.y = hw_pk2(Sacc[2 * ks][2], Sacc[2 * ks][3]); shi.x = hw_pk2(Sacc[2 * ks + 1][0], Sacc[2 * ks + 1][1]); shi.y = hw_pk2(Sacc[2 * ks + 1][2], Sacc[2 * ks + 1][3]);
                const bf16x8 sb = mk_frag(slo, shi);
                const u32x2 qlo = *(const LAS u32x2*)(QB + fr * RS + 32 * ks + 4 * g), qhi = *(const LAS u32x2*)(QB + fr * RS + 32 * ks + 16 + 4 * g);
                acco = __builtin_amdgcn_mfma_f32_16x16x32_bf16(mk_frag(qlo, qhi), sb, acco, 0, 0, 0); }
            { const u32x2 alo = *(const LAS u32x2*)(AM + fr * 16 + 4 * g); acco = __builtin_amdgcn_mfma_f32_16x16x32_bf16(mk_frag(alo, zz), vb, acco, 0, 0, 0); }
#pragma unroll
            for (int r = 0; r < 4; ++r) O[(size_t)(c * TC + 4 * g + r) * D + c0 + fr] = hw_bf(acco[r]);
#pragma unroll
            for (int i = 0; i < 8; ++i) { const f32x4 bl = *(const LAS f32x4*)(Lf + O_BL + 16 * i + 4 * g); const u32x2 klo = *(const LAS u32x2*)(KT + (16 * i + fr) * 16 + 4 * g);
                Sacc[i] = __builtin_amdgcn_mfma_f32_16x16x32_bf16(mk_frag(klo, zz), vb, Sacc[i] * bl, 0, 0, 0); }
        }
        LBAR();
    }
#undef GM_LOAD
#undef GM_XFORM
}

__device__ __forceinline__ void scan_gdn_mfma_unit(const Args& A, Frame& F, int unit, const int role) {
    int tid = F.tid; asm volatile("" : "+v"(tid));
    const int lane = tid & 63, w = F.wave;
    const int b = unit >> 3, h = unit & 7;
    const int qcol = EC_BQ + h * 128, kcol = EC_BK + h * 128, vcol = EC_BV + h * 128, ocol = 1024 + h * 128;
    const bf16* P = (const bf16*)(A.ws + WS_PROJ) + (size_t)b * SEQ * PROJ_LD;
    bf16* O = (bf16*)(A.ws + WS_O) + (size_t)b * SEQ * D + ocol;
    LAS float* Lf = (LAS float*)(F.lds + RING_OFF);
    constexpr int O_CW = 0, O_AMAT = 1536, O_QKM = O_AMAT + 256, O_TB = O_QKM + 128, O_GL = O_TB + 128, O_BUF0 = O_GL + 64;
    constexpr int BUFSZ = 6208, O_KH = 0, O_QH = 2048, O_VV = 4096, O_SC = 6144;
    constexpr int RS = 136;
    constexpr int O_KHB = O_BUF0 + 2 * BUFSZ, O_QHB = O_KHB + 1088, O_QB = O_QHB + 1088, O_KT = O_QB + 1088, O_WSRC = O_KT + 1024, O_WB = O_WSRC + 2048;
    LAS bf16* KHB = (LAS bf16*)(Lf + O_KHB); LAS bf16* QHB = (LAS bf16*)(Lf + O_QHB); LAS bf16* QB = (LAS bf16*)(Lf + O_QB); LAS bf16* KT = (LAS bf16*)(Lf + O_KT);
    LAS bf16* WB = (LAS bf16*)(Lf + O_WB); LAS bf16* QKM = (LAS bf16*)(Lf + O_QKM); LAS bf16* TB = (LAS bf16*)(Lf + O_TB);
    const int tl = tid >> 5, dq = (tid & 31) * 4;
    { const float* cw = A.in[I_GDN_CONV];
      for (int i = tid; i < 4 * 384; i += NTHREADS) { const int jt = i / 384, x = i % 384; Lf[O_CW + i] = cw[jt * 3072 + (x >> 7) * 1024 + h * 128 + (x & 127)]; } }
    const float neg_ea = -__expf(A.in[I_GDN_ALOG][h]), dtb = A.in[I_GDN_DTB][h];
    u32x2 rq[4], rk[4], rv[4]; unsigned short rba = 0, rbb = 0;
#define GD_LOAD(c) do { const int t_ = (c) * TC + tl; \
        _Pragma("unroll") for (int jt = 0; jt < 4; ++jt) { const int tt = t_ - 3 + jt; const bf16* pr = P + (size_t)(tt < 0 ? 0 : tt) * PROJ_LD + dq; \
            rq[jt] = *(const GAS u32x2*)(pr + qcol); rk[jt] = *(const GAS u32x2*)(pr + kcol); rv[jt] = *(const GAS u32x2*)(pr + vcol); \
            if (tt < 0) { rq[jt] = (u32x2){0u, 0u}; rk[jt] = (u32x2){0u, 0u}; rv[jt] = (u32x2){0u, 0u}; } } \
        { const bf16* pr = P + (size_t)t_ * PROJ_LD; rba = pr[EC_BA + h]; rbb = pr[EC_BB + h]; } } while (0)
#define GD_XFORM(bufi) do { LAS float* B_ = Lf + O_BUF0 + (bufi) * BUFSZ; f32x4 q4 = {0.f, 0.f, 0.f, 0.f}, k4 = {0.f, 0.f, 0.f, 0.f}, v4 = {0.f, 0.f, 0.f, 0.f}; \
        _Pragma("unroll") for (int jt = 0; jt < 4; ++jt) { const f32x4 wq = *(const LAS f32x4*)(Lf + O_CW + jt * 384 + dq), wk = *(const LAS f32x4*)(Lf + O_CW + jt * 384 + 128 + dq), wv = *(const LAS f32x4*)(Lf + O_CW + jt * 384 + 256 + dq); \
            q4[0] += wq[0] * bf_lo(rq[jt].x); q4[1] += wq[1] * bf_hi(rq[jt].x); q4[2] += wq[2] * bf_lo(rq[jt].y); q4[3] += wq[3] * bf_hi(rq[jt].y); \
            k4[0] += wk[0] * bf_lo(rk[jt].x); k4[1] += wk[1] * bf_hi(rk[jt].x); k4[2] += wk[2] * bf_lo(rk[jt].y); k4[3] += wk[3] * bf_hi(rk[jt].y); \
            v4[0] += wv[0] * bf_lo(rv[jt].x); v4[1] += wv[1] * bf_hi(rv[jt].x); v4[2] += wv[2] * bf_lo(rv[jt].y); v4[3] += wv[3] * bf_hi(rv[jt].y); } \
        float sq = 0.f, sk = 0.f; \
        _Pragma("unroll") for (int i_ = 0; i_ < 4; ++i_) { q4[i_] = siluf_(q4[i_]); k4[i_] = siluf_(k4[i_]); v4[i_] = siluf_(v4[i_]); sq += q4[i_] * q4[i_]; sk += k4[i_] * k4[i_]; } \
        row_sum16_x2(sq, sk); sq += __shfl_xor(sq, 16); sk += __shfl_xor(sk, 16); \
        q4 = q4 * (__builtin_amdgcn_rsqf(sq + EPS) * 0.08838834764831845f); k4 = k4 * __builtin_amdgcn_rsqf(sk + EPS); \
        *(LAS f32x4*)(B_ + O_KH + tl * 128 + dq) = k4; *(LAS f32x4*)(B_ + O_QH + tl * 128 + dq) = q4; *(LAS f32x4*)(B_ + O_VV + tl * 128 + dq) = v4; \
        if ((tid & 31) == 0) { const float ba = __uint_as_float((unsigned)rba << 16), bb = __uint_as_float((unsigned)rbb << 16); \
            B_[O_SC + tl] = __expf(neg_ea * softplusf_(ba + dtb)); B_[O_SC + 16 + tl] = sigmoidf_(bb); } } while (0)
    LBAR();
    constexpr int SPLIT = 58;
    const int c_begin = role ? SPLIT : 0, c_end = role ? NCHUNK : SPLIT;
    constexpr int REC = 5408;
    float* STASH = (float*)(A.ws + WS_LA) + (size_t)unit * (NCHUNK - SPLIT) * REC;
    float* STATE = (float*)(A.ws + WS_STATE) + (size_t)unit * 16384;
    gu32* flag = F.ctl + 32768 + unit * 64;
    GD_LOAD(c_begin); GD_XFORM(c_begin & 1); GD_LOAD(c_begin + 1);
    LBAR();
    f32x4 Sacc[8];
#pragma unroll
    for (int i = 0; i < 8; ++i) Sacc[i] = (f32x4){0.f, 0.f, 0.f, 0.f};
    const int fr = lane & 15, g = lane >> 4, c0 = w * 16;
    const u32x2 zz = {0u, 0u};
#define GD_STATE_PART(cc_) do { \
        { \
            bf16x8 sb[4]; \
_Pragma("unroll") \
            for (int ks = 0; ks < 4; ++ks) { u32x2 slo, shi; slo.x = hw_pk2(Sacc[2 * ks][0], Sacc[2 * ks][1]); slo.y = hw_pk2(Sacc[2 * ks][2], Sacc[2 * ks][3]); shi.x = hw_pk2(Sacc[2 * ks + 1][0], Sacc[2 * ks + 1][1]); shi.y = hw_pk2(Sacc[2 * ks + 1][2], Sacc[2 * ks + 1][3]); \
                sb[ks] = mk_frag(slo, shi); } \
            f32x4 accv = accu, acco = {0.f, 0.f, 0.f, 0.f}; \
_Pragma("unroll") \
            for (int ks = 0; ks < 4; ++ks) { \
                const u32x2 wl = *(const LAS u32x2*)(WB + fr * RS + 32 * ks + 4 * g), wh = *(const LAS u32x2*)(WB + fr * RS + 32 * ks + 16 + 4 * g); \
                accv = __builtin_amdgcn_mfma_f32_16x16x32_bf16(mk_frag(wl, wh), sb[ks], accv, 0, 0, 0); \
                const u32x2 ql = *(const LAS u32x2*)(QB + fr * RS + 32 * ks + 4 * g), qh = *(const LAS u32x2*)(QB + fr * RS + 32 * ks + 16 + 4 * g); \
                acco = __builtin_amdgcn_mfma_f32_16x16x32_bf16(mk_frag(ql, qh), sb[ks], acco, 0, 0, 0); } \
            u32x2 vn; vn.x = hw_pk2(accv[0], accv[1]); vn.y = hw_pk2(accv[2], accv[3]); \
            const bf16x8 vnb = mk_frag(vn, zz); \
            acco = __builtin_amdgcn_mfma_f32_16x16x32_bf16(mk_frag(*(const LAS u32x2*)(QKM + fr * 16 + 4 * g), zz), vnb, acco, 0, 0, 0); \
_Pragma("unroll") \
            for (int r = 0; r < 4; ++r) O[(size_t)((cc_) * TC + 4 * g + r) * D + c0 + fr] = hw_bf(acco[r]); \
_Pragma("unroll") \
            for (int i = 0; i < 8; ++i) { const u32x2 klo = *(const LAS u32x2*)(KT + (16 * i + fr) * 16 + 4 * g); \
                Sacc[i] = __builtin_amdgcn_mfma_f32_16x16x32_bf16(mk_frag(klo, zz), vnb, Sacc[i] * glast, 0, 0, 0); } \
        } \
        } while (0)
    for (int c = c_begin; c < c_end; ++c) {
        const LAS float* B_ = Lf + O_BUF0 + (c & 1) * BUFSZ;
        float glast;
        {
            const int seg = tid >> 7, d = tid & 127;
            const f32x4 a0 = *(const LAS f32x4*)(B_ + O_SC), a1 = *(const LAS f32x4*)(B_ + O_SC + 4), a2 = *(const LAS f32x4*)(B_ + O_SC + 8), a3 = *(const LAS f32x4*)(B_ + O_SC + 12);
            const float av[16] = {a0[0], a0[1], a0[2], a0[3], a1[0], a1[1], a1[2], a1[3], a2[0], a2[1], a2[2], a2[3], a3[0], a3[1], a3[2], a3[3]};
            float p = 1.f, gpre = 1.f;
#pragma unroll
            for (int t = 0; t < 16; ++t) { if (t == 4 * seg) gpre = p; p *= av[t]; }
            glast = p;
            unsigned short kt4[4]; float gt = gpre;
#pragma unroll
            for (int i = 0; i < 4; ++i) { const int t = 4 * seg + i; const float at = (seg == 0) ? av[i] : (seg == 1) ? av[4 + i] : (seg == 2) ? av[8 + i] : av[12 + i]; gt *= at; const float beta = B_[O_SC + 16 + t];
                const float kk = B_[O_KH + t * 128 + d], qq = B_[O_QH + t * 128 + d];
                KHB[t * RS + d] = hw_bf(kk); QHB[t * RS + d] = hw_bf(qq); QB[t * RS + d] = hw_bf(qq * gt);
                kt4[i] = (unsigned short)hw_bf(kk * glast * __builtin_amdgcn_rcpf(gt));
                Lf[O_WSRC + t * 128 + d] = kk * (beta * gt);
                if (d == 0) Lf[O_GL + t] = gt; }
            u32x2 kw; kw.x = (unsigned)kt4[0] | ((unsigned)kt4[1] << 16); kw.y = (unsigned)kt4[2] | ((unsigned)kt4[3] << 16);
            *(LAS u32x2*)(KT + d * 16 + 4 * seg) = kw;
        }
        LBAR();
        if (w < 2) {
            const LAS bf16* AS = (w == 0) ? KHB : QHB;
            f32x4 acc = {0.f, 0.f, 0.f, 0.f};
#pragma unroll
            for (int ks = 0; ks < 4; ++ks) { const bf16x8 af = *(const LAS bf16x8*)(AS + fr * RS + 32 * ks + 8 * g), bfm = *(const LAS bf16x8*)(KHB + fr * RS + 32 * ks + 8 * g);
                acc = __builtin_amdgcn_mfma_f32_16x16x32_bf16(af, bfm, acc, 0, 0, 0); }
            const float gs_inv = __builtin_amdgcn_rcpf(Lf[O_GL + fr]);
            if (w == 0) {
                f32x4 N1, M1;
#pragma unroll
                for (int r = 0; r < 4; ++r) { const int t = 4 * g + r; const float gt = Lf[O_GL + t];
                    N1[r] = (fr < t) ? -(B_[O_SC + 16 + t] * acc[r] * gt * gs_inv) : 0.f;
                    M1[r] = (t < fr) ? -(B_[O_SC + 16 + fr] * acc[r] * Lf[O_GL + fr] * __builtin_amdgcn_rcpf(gt)) : 0.f; }
#define XTY(X, Y, C0) __builtin_amdgcn_mfma_f32_16x16x32_bf16(mk_frag((u32x2){hw_pk2(X[0], X[1]), hw_pk2(X[2], X[3])}, zz), mk_frag((u32x2){hw_pk2(Y[0], Y[1]), hw_pk2(Y[2], Y[3])}, zz), C0, 0, 0, 0)
                const f32x4 z4 = {0.f, 0.f, 0.f, 0.f};
                f32x4 T1t = M1;
#pragma unroll
                for (int r = 0; r < 4; ++r) if (4 * g + r == fr) T1t[r] += 1.f;
                const f32x4 N2 = XTY(M1, N1, z4), M2 = XTY(N1, M1, z4);
                const f32x4 T2t = XTY(N2, T1t, T1t);
                const f32x4 N4 = XTY(M2, N2, z4), M4 = XTY(N2, M2, z4);
                const f32x4 T4t = XTY(N4, T2t, T2t);
                const f32x4 N8 = XTY(M4, N4, z4);
                const f32x4 T8t = XTY(N8, T4t, T4t);
#undef XTY
                u32x2 tw; tw.x = hw_pk2(T8t[0], T8t[1]); tw.y = hw_pk2(T8t[2], T8t[3]);
                *(LAS u32x2*)(TB + fr * 16 + 4 * g) = tw;
            } else {
#pragma unroll
                for (int r = 0; r < 4; ++r) { const int t = 4 * g + r; QKM[t * 16 + fr] = hw_bf((fr <= t) ? acc[r] * Lf[O_GL + t] * gs_inv : 0.f); }
            }
        }
        if (c + 1 < c_end) GD_XFORM((c + 1) & 1);
        if (c + 2 < c_end) GD_LOAD(c + 2);
        LBAR();
        f32x4 accu = {0.f, 0.f, 0.f, 0.f};
        {
            const bf16x8 tf = mk_frag(*(const LAS u32x2*)(TB + fr * 16 + 4 * g), zz);
            u32x2 ulo, wlo;
            { const float b0 = B_[O_SC + 16 + 4 * g + 0], b1 = B_[O_SC + 16 + 4 * g + 1], b2 = B_[O_SC + 16 + 4 * g + 2], b3 = B_[O_SC + 16 + 4 * g + 3];
              ulo.x = hw_pk2(b0 * B_[O_VV + (4 * g + 0) * 128 + c0 + fr], b1 * B_[O_VV + (4 * g + 1) * 128 + c0 + fr]); ulo.y = hw_pk2(b2 * B_[O_VV + (4 * g + 2) * 128 + c0 + fr], b3 * B_[O_VV + (4 * g + 3) * 128 + c0 + fr]);
              wlo.x = hw_pk2(Lf[O_WSRC + (4 * g + 0) * 128 + c0 + fr], Lf[O_WSRC + (4 * g + 1) * 128 + c0 + fr]); wlo.y = hw_pk2(Lf[O_WSRC + (4 * g + 2) * 128 + c0 + fr], Lf[O_WSRC + (4 * g + 3) * 128 + c0 + fr]); }
            accu = __builtin_amdgcn_mfma_f32_16x16x32_bf16(tf, mk_frag(ulo, zz), accu, 0, 0, 0);
            f32x4 accw = {0.f, 0.f, 0.f, 0.f};
            accw = __builtin_amdgcn_mfma_f32_16x16x32_bf16(tf, mk_frag(wlo, zz), accw, 0, 0, 0);
#pragma unroll
            for (int r = 0; r < 4; ++r) WB[(4 * g + r) * RS + c0 + fr] = hw_bf(-accw[r]);
        }
        LBAR();
        if (role == 0) {
            GD_STATE_PART(c);
        } else {
            float* rec = STASH + (size_t)(c - c_begin) * REC;
            for (int i = tid; i < 832; i += NTHREADS) { const int o = i < 528 ? O_QB + 4 * i : (i < 800 ? O_WB + 4 * (i - 528) : O_QKM + 4 * (i - 800)); *(GAS f32x4*)(rec + 4 * i) = *(const LAS f32x4*)(Lf + o); }
#pragma unroll
            for (int r = 0; r < 4; ++r) rec[3328 + (w * 4 + r) * 64 + lane] = accu[r];
            if (tid == 0) rec[5376] = glast;
        }
        LBAR();
    }
    if (role == 0) {
#pragma unroll
        for (int i = 0; i < 8; ++i)
#pragma unroll
            for (int r = 0; r < 4; ++r) STATE[((w * 8 + i) * 4 + r) * 64 + lane] = Sacc[i][r];
        asm volatile("s_waitcnt vmcnt(0)" ::: "memory");
        __syncthreads();
        if (tid == 0) { __builtin_amdgcn_fence(__ATOMIC_RELEASE, "agent"); asm volatile("s_waitcnt vmcnt(0)" ::: "memory"); __hip_atomic_store(flag, 1u, __ATOMIC_RELAXED, __HIP_MEMORY_SCOPE_AGENT); }
    } else {
        if (tid == 0) { unsigned sp = 0; while (__hip_atomic_load(flag, __ATOMIC_RELAXED, __HIP_MEMORY_SCOPE_AGENT) == 0u) { __builtin_amdgcn_s_sleep(8); if (++sp > (1u << 22)) break; }
            __builtin_amdgcn_fence(__ATOMIC_ACQUIRE, "agent"); asm volatile("s_waitcnt vmcnt(0)" ::: "memory"); }
        __syncthreads();
#pragma unroll
        for (int i = 0; i < 8; ++i)
#pragma unroll
            for (int r = 0; r < 4; ++r) Sacc[i][r] = STATE[((w * 8 + i) * 4 + r) * 64 + lane];
        f32x4 pa, pb; f32x4 pu; float pg;
#define GD_REC_LOAD(cc) do { const float* rec = STASH + (size_t)((cc) - c_begin) * REC; pa = *(const GAS f32x4*)(rec + 4 * tid); pb = (tid < 320) ? *(const GAS f32x4*)(rec + 4 * (tid + 512)) : (f32x4){0.f, 0.f, 0.f, 0.f}; \
            _Pragma("unroll") for (int r = 0; r < 4; ++r) pu[r] = rec[3328 + (w * 4 + r) * 64 + lane]; pg = rec[5376]; } while (0)
        GD_REC_LOAD(c_begin);
        for (int c = c_begin; c < c_end; ++c) {
            { const int i0 = tid, o0 = i0 < 528 ? O_QB + 4 * i0 : O_WB + 4 * (i0 - 528); *(LAS f32x4*)(Lf + o0) = pa;
              if (tid < 320) { const int i1 = tid + 512; const int o1 = i1 < 528 ? O_QB + 4 * i1 : (i1 < 800 ? O_WB + 4 * (i1 - 528) : O_QKM + 4 * (i1 - 800)); *(LAS f32x4*)(Lf + o1) = pb; } }
            const f32x4 accu = pu; const float glast = pg;
            if (c + 1 < c_end) GD_REC_LOAD(c + 1);
            LBAR();
            GD_STATE_PART(c);
            LBAR();
        }
#undef GD_REC_LOAD
    }
#undef GD_STATE_PART
#undef GD_LOAD
#undef GD_XFORM
}

__device__ __forceinline__ void scan_rwkv_unit(const Args& A, Frame& F, int unit) {
    int tid = F.tid; asm volatile("" : "+v"(tid));
    const int lane = tid & 63, w = F.wave;
    const int b = unit >> 4, h = unit & 15;
    const bf16* P = (const bf16*)(A.ws + WS_PROJ) + (size_t)b * SEQ * PROJ_LD + OC_RW;
    const bf16* LO = (const bf16*)(A.ws + WS_LO) + (size_t)b * SEQ * LORA_N;
    bf16* Y = (bf16*)(A.ws + WS_ACTA) + (size_t)b * SEQ * D + 1024 + h * 64;
    LAS float* Lf = (LAS float*)(F.lds + RING_OFF);
    constexpr int BUFSZ = 6208, O_KK = 0, O_WR = 1024, O_W = 2048, O_NKA = 3072, O_K = 4096, O_V = 5120, O_SC = 6144, O_OUT = 2 * BUFSZ;
    const int tl = tid >> 5, d2 = (tid & 31) * 2, hd = h * 64 + d2;
    float mu_r[2], mu_k[2], mu_v[2], w0[2], a0[2], k_k[2], k_a[2], r_k[2], lnw[2], lnb[2];
#pragma unroll
    for (int i = 0; i < 2; ++i) { mu_r[i] = A.in[I_MU][RW_R + hd + i]; mu_k[i] = A.in[I_MU][RW_K + hd + i]; mu_v[i] = A.in[I_MU][RW_V + hd + i];
        w0[i] = A.in[I_W0][hd + i]; a0[i] = A.in[I_A0][hd + i]; k_k[i] = A.in[I_KK][hd + i]; k_a[i] = A.in[I_KA][hd + i]; r_k[i] = A.in[I_RK][hd + i];
        lnw[i] = A.in[I_LNW][hd + i]; lnb[i] = A.in[I_LNB][hd + i]; }
    unsigned rr[2], rk[2], rv[2], rlw, rla, rg_cur = 0u, rg_nxt = 0u;
#define RW_LOAD(c) do { const int t_ = (c) * TC + tl; const bf16* pr = P + (size_t)t_ * PROJ_LD; \
        rr[0] = *(const GAS unsigned*)(pr + RW_R + hd); rk[0] = *(const GAS unsigned*)(pr + RW_K + hd); rv[0] = *(const GAS unsigned*)(pr + RW_V + hd); \
        if (t_ > 0) { rr[1] = *(const GAS unsigned*)(pr - PROJ_LD + RW_R + hd); rk[1] = *(const GAS unsigned*)(pr - PROJ_LD + RW_K + hd); rv[1] = *(const GAS unsigned*)(pr - PROJ_LD + RW_V + hd); } \
        else { rr[1] = 0u; rk[1] = 0u; rv[1] = 0u; } \
        const bf16* lr = LO + (size_t)t_ * LORA_N; rlw = *(const GAS unsigned*)(lr + hd); rla = *(const GAS unsigned*)(lr + 1024 + hd); rg_nxt = *(const GAS unsigned*)(lr + 2048 + hd); } while (0)
#define RW_XFORM(bufi) do { LAS float* B_ = Lf + (bufi) * BUFSZ; f32x2 kk2, wr2, w2_, nka2, k2, v2_; float skk = 0.f, sc1 = 0.f, sc2 = 0.f, sbs = 0.f; float aa[2], rrv[2]; \
        _Pragma("unroll") for (int i_ = 0; i_ < 2; ++i_) { \
            const float r0 = i_ ? bf_hi(rr[0]) : bf_lo(rr[0]), r1 = i_ ? bf_hi(rr[1]) : bf_lo(rr[1]); \
            const float k0_ = i_ ? bf_hi(rk[0]) : bf_lo(rk[0]), k1_ = i_ ? bf_hi(rk[1]) : bf_lo(rk[1]); \
            const float v0_ = i_ ? bf_hi(rv[0]) : bf_lo(rv[0]), v1_ = i_ ? bf_hi(rv[1]) : bf_lo(rv[1]); \
            const float lw = i_ ? bf_hi(rlw) : bf_lo(rlw), la = i_ ? bf_hi(rla) : bf_lo(rla); \
            const float r_ = r0 + (r1 - r0) * mu_r[i_], kx = k0_ + (k1_ - k0_) * mu_k[i_], vx = v0_ + (v1_ - v0_) * mu_v[i_]; \
            const float wd = __expf(-0.6065306597126334f * sigmoidf_(w0[i_] + lw)); const float a_ = sigmoidf_(a0[i_] + la); \
            const float kk0 = kx * k_k[i_]; const float km = kx * (1.f + (a_ - 1.f) * k_a[i_]); \
            kk2[i_] = kk0; skk += kk0 * kk0; aa[i_] = a_; rrv[i_] = r_; wr2[i_] = wd * r_; w2_[i_] = wd; k2[i_] = km; v2_[i_] = vx; sc2 += km * r_; sbs += r_ * km * r_k[i_]; } \
        skk = half_sum32(skk); const float rkk = __builtin_amdgcn_rsqf(skk + EPS); \
        _Pragma("unroll") for (int i_ = 0; i_ < 2; ++i_) { kk2[i_] *= rkk; nka2[i_] = -(kk2[i_] * aa[i_]); sc1 += kk2[i_] * aa[i_] * rrv[i_]; } \
        sc1 = half_sum32(sc1); sc2 = half_sum32(sc2); sbs = half_sum32(sbs); \
        *(LAS f32x2*)(B_ + O_KK + tl * 64 + d2) = kk2; *(LAS f32x2*)(B_ + O_WR + tl * 64 + d2) = wr2; *(LAS f32x2*)(B_ + O_W + tl * 64 + d2) = w2_; \
        *(LAS f32x2*)(B_ + O_NKA + tl * 64 + d2) = nka2; *(LAS f32x2*)(B_ + O_K + tl * 64 + d2) = k2; *(LAS f32x2*)(B_ + O_V + tl * 64 + d2) = v2_; \
        if ((tid & 31) == 0) { f32x4 sc; sc[0] = sc1; sc[1] = sc2; sc[2] = sbs; sc[3] = 0.f; *(LAS f32x4*)(B_ + O_SC + tl * 4) = sc; } } while (0)
    RW_LOAD(0); RW_XFORM(0); rg_cur = rg_nxt;
    LBAR();
    f32x2 S2[4];
#pragma unroll
    for (int i = 0; i < 4; ++i) S2[i] = (f32x2){0.f, 0.f};
    const int j = lane & 15, col = w * 8 + (lane >> 4) * 2;
    for (int c = 0; c < NCHUNK; ++c) {
        if (c + 1 < NCHUNK) RW_LOAD(c + 1);
        const LAS float* B_ = Lf + (c & 1) * BUFSZ;
        float os0 = 0.f, os1 = 0.f;
        f32x4 kk, wr, ww, nka, kv, sc, nkk, nwr, nww, nnka, nkv, nsc; f32x2 v2, nv2;
#define RW_LDSTEP(t_, KK, WR, WW, NKA, KV, V2, SC) do { KK = *(const LAS f32x4*)(B_ + O_KK + (t_) * 64 + 4 * j); WR = *(const LAS f32x4*)(B_ + O_WR + (t_) * 64 + 4 * j); WW = *(const LAS f32x4*)(B_ + O_W + (t_) * 64 + 4 * j); \
            NKA = *(const LAS f32x4*)(B_ + O_NKA + (t_) * 64 + 4 * j); KV = *(const LAS f32x4*)(B_ + O_K + (t_) * 64 + 4 * j); V2 = *(const LAS f32x2*)(B_ + O_V + (t_) * 64 + col); SC = *(const LAS f32x4*)(B_ + O_SC + (t_) * 4); } while (0)
        RW_LDSTEP(0, kk, wr, ww, nka, kv, v2, sc);
#pragma unroll
        for (int t = 0; t < TC; ++t) {
            if (t + 1 < TC) { RW_LDSTEP(t + 1, nkk, nwr, nww, nnka, nkv, nv2, nsc); }
            __builtin_amdgcn_sched_barrier(0);
            f32x2 d1 = S2[0] * kk[0], d2 = S2[0] * wr[0], e1 = S2[1] * kk[1], e2 = S2[1] * wr[1];
            d1 += S2[2] * kk[2]; d2 += S2[2] * wr[2]; e1 += S2[3] * kk[3]; e2 += S2[3] * wr[3];
            d1 += e1; d2 += e2;
            { float r0_ = d1[0], r1_ = d1[1], r2_ = d2[0], r3_ = d2[1]; row_sum16_x4(r0_, r1_, r2_, r3_); d1[0] = r0_; d1[1] = r1_; d2[0] = r2_; d2[1] = r3_; }
            const f32x2 o2 = d2 - d1 * sc[0] + v2 * sc[1];
#pragma unroll
            for (int i = 0; i < 4; ++i) S2[i] = S2[i] * ww[i] + d1 * nka[i] + v2 * kv[i];
            os0 = (j == t) ? o2[0] : os0; os1 = (j == t) ? o2[1] : os1;
            kk = nkk; wr = nwr; ww = nww; nka = nnka; kv = nkv; v2 = nv2; sc = nsc;
        }
#undef RW_LDSTEP
        { f32x2 o2 = {os0, os1}; *(LAS f32x2*)(Lf + O_OUT + j * 64 + col) = o2; }
        if (c + 1 < NCHUNK) RW_XFORM((c + 1) & 1);
        LBAR();
        {
            const f32x2 o2 = *(const LAS f32x2*)(Lf + O_OUT + tl * 64 + d2); const f32x2 vv = *(const LAS f32x2*)(B_ + O_V + tl * 64 + d2); const float bs = B_[O_SC + tl * 4 + 2];
            const float mean = half_sum32(o2[0] + o2[1]) * (1.0f / 64.0f); const float e0 = o2[0] - mean, e1 = o2[1] - mean;
            const float var = half_sum32(e0 * e0 + e1 * e1) * (1.0f / 64.0f); const float rs = __builtin_amdgcn_rsqf(var + 64e-5f);
            const float y0 = (e0 * rs * lnw[0] + lnb[0] + bs * vv[0]) * bf_lo(rg_cur), y1 = (e1 * rs * lnw[1] + lnb[1] + bs * vv[1]) * bf_hi(rg_cur);
            *(GAS unsigned*)(Y + (size_t)(c * TC + tl) * D + d2) = pk2(y0, y1);
        }
        rg_cur = rg_nxt;
        LBAR();
    }
#undef RW_LOAD
#undef RW_XFORM
}

template <int LAYER>
__device__ __forceinline__ void post_rows(const Args& A, Frame& F) {
    const int gw = F.vcu * NWAVES + F.wave, NGW = F.G * NWAVES, lane = F.lane;
    const bf16* O = (const bf16*)(A.ws + WS_O); const bf16* P = (const bf16*)(A.ws + WS_PROJ); bf16* Y = (bf16*)(A.ws + WS_ACTA);
    for (int m = gw; m < T; m += NGW) {
        const GAS u32x2* orow = (const GAS u32x2*)(O + (size_t)m * D) + lane; const bf16* prow = P + (size_t)m * PROJ_LD;
        constexpr int NJ = LAYER == 0 ? 8 : 4;
#pragma unroll
        for (int jj = 0; jj < NJ; ++jj) {
            const u32x2 ow_ = orow[64 * jj]; const f32x4 v = {bf_lo(ow_.x), bf_hi(ow_.x), bf_lo(ow_.y), bf_hi(ow_.y)}; float ss = (v[0] * v[0] + v[1] * v[1]) + (v[2] * v[2] + v[3] * v[3]);
            const bool wide = (LAYER == 0 && jj < 4);
            const float ms = wide ? wave_sum(ss) * (1.0f / 256.0f) : half_sum32(ss) * (1.0f / 128.0f);
            const float r = __builtin_amdgcn_rsqf(ms + EPS);
            const int cih = wide ? 4 * lane : 4 * (lane & 31);
            const float* gsrc = LAYER == 0 ? (wide ? A.in[I_GLA_NORM] : A.in[I_GDN_NORM]) : A.in[I_HG_NORM];
            const f32x4 g = *(const GAS f32x4*)(gsrc + cih);
            const int zcol = LAYER == 0 ? (wide ? EC_GZ + jj * 256 + 4 * lane : EC_BZ + (jj - 4) * 256 + 4 * lane) : OC_HG + jj * 256 + 4 * lane;
            const u32x2 zw = *(const GAS u32x2*)(prow + zcol);
            const float y0 = v[0] * r * g[0] * siluf_(bf_lo(zw.x)), y1 = v[1] * r * g[1] * siluf_(bf_hi(zw.x)), y2 = v[2] * r * g[2] * siluf_(bf_lo(zw.y)), y3 = v[3] * r * g[3] * siluf_(bf_hi(zw.y));
            if constexpr (LAYER == 1) { int o8 = __builtin_amdgcn_cvt_pk_fp8_f32(y0, y1, 0, false); o8 = __builtin_amdgcn_cvt_pk_fp8_f32(y2, y3, o8, true);
                *(GAS unsigned*)((unsigned char*)Y + (size_t)m * D + 256 * jj + 4 * lane) = (unsigned)o8; }
            else { u32x2 o; o.x = pk2(y0, y1); o.y = pk2(y2, y3);
                *(GAS u32x2*)(Y + (size_t)m * D + 256 * jj + 4 * lane) = o; }
        }
    }
}
__device__ __forceinline__ void lora_prep_rows(const Args& A, Frame& F) {
    const int gw = F.vcu * NWAVES + F.wave, NGW = F.G * NWAVES, lane = F.lane;
    const bf16* P = (const bf16*)(A.ws + WS_PROJ); bf16* LA = (bf16*)(A.ws + WS_LA); const float* mu = A.in[I_MU];
    for (int m = gw; m < T; m += NGW) { const bool hasprev = (m % SEQ) != 0; const bf16* prow = P + (size_t)m * PROJ_LD + OC_RW + RW_WL;
#pragma unroll
        for (int i = 0; i < 7; ++i) { const int c = lane + 64 * i;
            const float x = __uint_as_float((unsigned)prow[c] << 16), xp = hasprev ? __uint_as_float((unsigned)prow[c - PROJ_LD] << 16) : 0.f;
            const float ts = x + (xp - x) * mu[RW_WL + c];
            const float v = c < 96 ? tanhf(ts) : (c < 192 ? ts : sigmoidf_(ts));
            LA[(size_t)m * LORA_K + c] = (bf16)f2bf(v); }
        LA[(size_t)m * LORA_K + 448 + lane] = (bf16)0; }
}
__device__ __forceinline__ void final_rows(const Args& A, Frame& F, const float oscale, const bf16* Hs) {
    const int gw = F.vcu * NWAVES + F.wave, NGW = F.G * NWAVES, lane = F.lane;
    const float* rowss = (const float*)(A.ws + WS_RSP) + (size_t)RS_FINAL * T * 32; const GAS f32x4* g = (const GAS f32x4*)A.in[I_NFINAL] + lane;
    for (int m = gw; m < T; m += NGW) { const float r = oscale * __builtin_amdgcn_rsqf(wave_sum(lane < 32 ? rowss[(size_t)m * 32 + lane] : 0.f) * (1.0f / D) + EPS); GAS f32x4* row = (GAS f32x4*)(A.out + (size_t)m * D) + lane;
        const GAS u32x2* hrow = (const GAS u32x2*)(Hs + (size_t)m * D) + lane;
#pragma unroll
        for (int jj = 0; jj < 8; ++jj) { const u32x2 hw = hrow[64 * jj]; const f32x4 v = {bf_lo(hw.x), bf_hi(hw.x), bf_lo(hw.y), bf_hi(hw.y)}; row[64 * jj] = v * r * g[64 * jj]; } }
}

__device__ __forceinline__ void scan_rwkv_mfma_unit(const Args& A, Frame& F, int unit, const int role) {
    int tid = F.tid; asm volatile("" : "+v"(tid));
    const int lane = tid & 63, w = F.wave;
    const int b = unit >> 3, hp = unit & 7;
    const bf16* P = (const bf16*)(A.ws + WS_PROJ) + (size_t)b * SEQ * PROJ_LD + OC_RW;
    const bf16* LO = (const bf16*)(A.ws + WS_LO) + (size_t)b * SEQ * LORA_N;
    unsigned char* Y = (unsigned char*)(A.ws + WS_ACTA) + (size_t)b * SEQ * D + 1024;
    LAS float* Lf = (LAS float*)(F.lds + RING_OFF);
    constexpr int RS = 72;
    constexpr int O_CONST = 0;
    constexpr int O_XF = 1280;
    constexpr int O_VV = O_XF + 2 * 5 * 1024;
    constexpr int O_BS = O_VV + 4 * 1024;
    constexpr int O_IMG = O_BS + 64;
    constexpr int I_CT = 0, I_BT = 576, I_KL = 1152, I_RT = 1728, I_CF = 2304, I_BTT = 3328, I_KTT = 3840, I_WCB = 4352, I_G1B = 4928, I_TTB = 5056, I_RKB = 5184, I_RBB = 5312, I_W15 = 5440, I_OUT = 5504, IMGSZ = 6528;
    static_assert((O_IMG + 2 * IMGSZ) * 4 <= RING_BYTES, "rwkv lds");
    for (int i = tid; i < 1280; i += NTHREADS) { const int arr = i >> 7, ch = hp * 128 + (i & 127); float v;
        switch (arr) { case 0: v = A.in[I_MU][RW_R + ch]; break; case 1: v = A.in[I_MU][RW_K + ch]; break; case 2: v = A.in[I_MU][RW_V + ch]; break; case 3: v = A.in[I_W0][ch]; break; case 4: v = A.in[I_A0][ch]; break;
                       case 5: v = A.in[I_KK][ch]; break; case 6: v = A.in[I_KA][ch]; break; case 7: v = A.in[I_RK][ch]; break; case 8: v = A.in[I_LNW][ch]; break; default: v = A.in[I_LNB][ch]; break; }
        Lf[O_CONST + i] = v; }
    const int hx = tid >> 8, tl = (tid >> 4) & 15, d4 = (tid & 15) * 4, ch4 = hx * 64 + d4, col4 = hp * 128 + ch4;
    u32x2 rr[2], rk[2], rv[2], rlw, rla, rg_cur = {0u, 0u}, rg_nxt = {0u, 0u}, rg_far = {0u, 0u};
#define RM_LOAD(c) do { const int t_ = (c) * TC + tl; const bf16* pr = P + (size_t)t_ * PROJ_LD + col4; \
        rr[0] = *(const GAS u32x2*)(pr + RW_R); rk[0] = *(const GAS u32x2*)(pr + RW_K); rv[0] = *(const GAS u32x2*)(pr + RW_V); \
        const bf16* pp_ = (t_ > 0) ? pr - PROJ_LD : pr; rr[1] = *(const GAS u32x2*)(pp_ + RW_R); rk[1] = *(const GAS u32x2*)(pp_ + RW_K); rv[1] = *(const GAS u32x2*)(pp_ + RW_V); \
        if (t_ == 0) { rr[1] = (u32x2){0u, 0u}; rk[1] = (u32x2){0u, 0u}; rv[1] = (u32x2){0u, 0u}; } \
        const bf16* lr = LO + (size_t)t_ * LORA_N + col4; rlw = *(const GAS u32x2*)(lr); rla = *(const GAS u32x2*)(lr + 1024); rg_far = *(const GAS u32x2*)(lr + 2048); } while (0)
#define RM_XFORM(bufi) do { LAS float* X_ = Lf + O_XF + hx * 5 * 1024 + tl * 64 + d4; \
        const f32x4 mur = *(const LAS f32x4*)(Lf + O_CONST + 0 * 128 + ch4), muk = *(const LAS f32x4*)(Lf + O_CONST + 1 * 128 + ch4), muv = *(const LAS f32x4*)(Lf + O_CONST + 2 * 128 + ch4); \
        const f32x4 w0_ = *(const LAS f32x4*)(Lf + O_CONST + 3 * 128 + ch4), a0_ = *(const LAS f32x4*)(Lf + O_CONST + 4 * 128 + ch4), kk_ = *(const LAS f32x4*)(Lf + O_CONST + 5 * 128 + ch4); \
        const f32x4 ka_ = *(const LAS f32x4*)(Lf + O_CONST + 6 * 128 + ch4), rk_ = *(const LAS f32x4*)(Lf + O_CONST + 7 * 128 + ch4); \
        const float r0[4] = {bf_lo(rr[0].x), bf_hi(rr[0].x), bf_lo(rr[0].y), bf_hi(rr[0].y)}, r1[4] = {bf_lo(rr[1].x), bf_hi(rr[1].x), bf_lo(rr[1].y), bf_hi(rr[1].y)}; \
        const float k0[4] = {bf_lo(rk[0].x), bf_hi(rk[0].x), bf_lo(rk[0].y), bf_hi(rk[0].y)}, k1[4] = {bf_lo(rk[1].x), bf_hi(rk[1].x), bf_lo(rk[1].y), bf_hi(rk[1].y)}; \
        const float v0[4] = {bf_lo(rv[0].x), bf_hi(rv[0].x), bf_lo(rv[0].y), bf_hi(rv[0].y)}, v1[4] = {bf_lo(rv[1].x), bf_hi(rv[1].x), bf_lo(rv[1].y), bf_hi(rv[1].y)}; \
        const float lw[4] = {bf_lo(rlw.x), bf_hi(rlw.x), bf_lo(rlw.y), bf_hi(rlw.y)}, la[4] = {bf_lo(rla.x), bf_hi(rla.x), bf_lo(rla.y), bf_hi(rla.y)}; \
        f32x4 r4, w4, k4, v4, kk4, b4; float skk = 0.f, sbs = 0.f; float aa[4]; \
        _Pragma("unroll") for (int i_ = 0; i_ < 4; ++i_) { const float r_ = r0[i_] + (r1[i_] - r0[i_]) * mur[i_], kx = k0[i_] + (k1[i_] - k0[i_]) * muk[i_], vx = v0[i_] + (v1[i_] - v0[i_]) * muv[i_]; \
            const float wd = __expf(-0.6065306597126334f * sigmoidf_(w0_[i_] + lw[i_])); const float a_ = sigmoidf_(a0_[i_] + la[i_]); \
            const float kk0 = kx * kk_[i_], km = kx * (1.f + (a_ - 1.f) * ka_[i_]); \
            r4[i_] = r_; w4[i_] = wd; k4[i_] = km; v4[i_] = vx; kk4[i_] = kk0; aa[i_] = a_; skk += kk0 * kk0; sbs += r_ * km * rk_[i_]; } \
        row_sum16_x2(skk, sbs); const float rkk = __builtin_amdgcn_rsqf(skk + EPS); \
        _Pragma("unroll") for (int i_ = 0; i_ < 4; ++i_) { kk4[i_] *= rkk; b4[i_] = kk4[i_] * aa[i_]; } \
        *(LAS f32x4*)(X_) = r4; *(LAS f32x4*)(X_ + 1024) = w4; *(LAS f32x4*)(X_ + 2048) = k4; *(LAS f32x4*)(X_ + 3072) = kk4; *(LAS f32x4*)(X_ + 4096) = b4; \
        *(LAS f32x4*)(Lf + O_VV + ((bufi) * 2 + hx) * 1024 + tl * 64 + d4) = v4; \
        if ((tid & 15) == 0) Lf[O_BS + ((bufi) * 2 + hx) * 16 + tl] = sbs; } while (0)
    constexpr int SPLIT = 60;
    const int c_begin = role ? SPLIT : 0, c_end = role ? NCHUNK : SPLIT;
    constexpr int REC = 7584;
    float* STASH = (float*)(A.ws + (unit < 32 ? WS_WEV_IN : WS_END)) + (size_t)(unit & 31) * (NCHUNK - SPLIT) * REC;
    float* STATE = (float*)(A.ws + WS_STATE + 4 * MiB) + (size_t)unit * 8192;
    gu32* flag = F.ctl + 49152 + unit * 64;
    LBAR();
    RM_LOAD(c_begin); RM_XFORM(c_begin & 1); rg_cur = rg_far; RM_LOAD(c_begin + 1); rg_nxt = rg_far;
    LBAR();
    f32x4 Macc[4];
#pragma unroll
    for (int i = 0; i < 4; ++i) Macc[i] = (f32x4){0.f, 0.f, 0.f, 0.f};
    const int fr = lane & 15, g = lane >> 4, hh = w >> 2, ww = w & 3, c0 = ww * 16;
    LAS float* IM = Lf + O_IMG + hh * IMGSZ;
    LAS bf16* CT = (LAS bf16*)(IM + I_CT); LAS bf16* BT = (LAS bf16*)(IM + I_BT); LAS bf16* KL = (LAS bf16*)(IM + I_KL); LAS bf16* RT = (LAS bf16*)(IM + I_RT);
    LAS bf16* BTT = (LAS bf16*)(IM + I_BTT); LAS bf16* KTT = (LAS bf16*)(IM + I_KTT); LAS bf16* WCB = (LAS bf16*)(IM + I_WCB);
    LAS bf16* G1B = (LAS bf16*)(IM + I_G1B); LAS bf16* TTB = (LAS bf16*)(IM + I_TTB); LAS bf16* RKB = (LAS bf16*)(IM + I_RKB); LAS bf16* RBB = (LAS bf16*)(IM + I_RBB);
    const u32x2 zz = {0u, 0u};
#define RM_STATE_PART(vb) do { \
        { \
            bf16x8 mb[2]; \
_Pragma("unroll") \
            for (int ks = 0; ks < 2; ++ks) { u32x2 slo, shi; slo.x = hw_pk2(Macc[2 * ks][0], Macc[2 * ks][1]); slo.y = hw_pk2(Macc[2 * ks][2], Macc[2 * ks][3]); shi.x = hw_pk2(Macc[2 * ks + 1][0], Macc[2 * ks + 1][1]); shi.y = hw_pk2(Macc[2 * ks + 1][2], Macc[2 * ks + 1][3]); \
                mb[ks] = mk_frag(slo, shi); } \
            f32x4 accR = accU, acco = {0.f, 0.f, 0.f, 0.f}; \
_Pragma("unroll") \
            for (int ks = 0; ks < 2; ++ks) { \
                accR = __builtin_amdgcn_mfma_f32_16x16x32_bf16(mk_frag(*(const LAS u32x2*)(WCB + fr * RS + 32 * ks + 4 * g), *(const LAS u32x2*)(WCB + fr * RS + 32 * ks + 16 + 4 * g)), mb[ks], accR, 0, 0, 0); \
                acco = __builtin_amdgcn_mfma_f32_16x16x32_bf16(mk_frag(*(const LAS u32x2*)(RT + fr * RS + 32 * ks + 4 * g), *(const LAS u32x2*)(RT + fr * RS + 32 * ks + 16 + 4 * g)), mb[ks], acco, 0, 0, 0); } \
            u32x2 rn; rn.x = hw_pk2(accR[0], accR[1]); rn.y = hw_pk2(accR[2], accR[3]); \
            const bf16x8 rb = mk_frag(rn, zz); \
            acco = __builtin_amdgcn_mfma_f32_16x16x32_bf16(mk_frag(*(const LAS u32x2*)(RKB + fr * 16 + 4 * g), zz), vb, acco, 0, 0, 0); \
            acco = __builtin_amdgcn_mfma_f32_16x16x32_bf16(mk_frag(*(const LAS u32x2*)(RBB + fr * 16 + 4 * g), zz), rb, acco, 0, 0, 0); \
_Pragma("unroll") \
            for (int r = 0; r < 4; ++r) IM[I_OUT + (4 * g + r) * 64 + c0 + fr] = acco[r]; \
_Pragma("unroll") \
            for (int i = 0; i < 4; ++i) { const f32x4 w15 = *(const LAS f32x4*)(IM + I_W15 + 16 * i + 4 * g); \
                f32x4 m = __builtin_amdgcn_mfma_f32_16x16x32_bf16(mk_frag(*(const LAS u32x2*)(KTT + (16 * i + fr) * 16 + 4 * g), zz), vb, Macc[i], 0, 0, 0); \
                m = __builtin_amdgcn_mfma_f32_16x16x32_bf16(mk_frag(*(const LAS u32x2*)(BTT + (16 * i + fr) * 16 + 4 * g), zz), rb, m, 0, 0, 0); \
                Macc[i] = m * w15; } \
        } \
        } while (0)
#define RM_FLUSH(cc_, gb_, vv_, bs_) do { \
        { \
            const f32x4 o4 = *(const LAS f32x4*)(Lf + O_IMG + hx * IMGSZ + I_OUT + tl * 64 + d4); const f32x4 vv = (vv_); const float bs = (bs_); \
            const f32x4 lnw = *(const LAS f32x4*)(Lf + O_CONST + 8 * 128 + ch4), lnb = *(const LAS f32x4*)(Lf + O_CONST + 9 * 128 + ch4); \
            float sm = (o4[0] + o4[1]) + (o4[2] + o4[3]), dummy = 0.f; row_sum16_x2(sm, dummy); const float mean = sm * (1.0f / 64.0f); \
            const f32x4 e4 = o4 - mean; float sv = (e4[0] * e4[0] + e4[1] * e4[1]) + (e4[2] * e4[2] + e4[3] * e4[3]); row_sum16_x2(sv, dummy); const float rs = __builtin_amdgcn_rsqf(sv * (1.0f / 64.0f) + 64e-5f); \
            const float gg[4] = {bf_lo((gb_).x), bf_hi((gb_).x), bf_lo((gb_).y), bf_hi((gb_).y)}; \
            float y[4]; \
_Pragma("unroll") \
            for (int i = 0; i < 4; ++i) y[i] = (e4[i] * rs * lnw[i] + lnb[i] + bs * vv[i]) * gg[i]; \
            int o8 = __builtin_amdgcn_cvt_pk_fp8_f32(y[0], y[1], 0, false); o8 = __builtin_amdgcn_cvt_pk_fp8_f32(y[2], y[3], o8, true); \
            *(GAS unsigned*)(Y + (size_t)((cc_) * TC + tl) * D + col4) = (unsigned)o8; \
        } \
        } while (0)
    for (int c = c_begin; c < c_end; ++c) {
        {
            const int hq = tid >> 8, seg = (tid >> 6) & 3, d = tid & 63;
            const LAS float* X_ = Lf + O_XF + hq * 5 * 1024 + d; LAS float* IQ = Lf + O_IMG + hq * IMGSZ;
            LAS bf16* CTq = (LAS bf16*)(IQ + I_CT); LAS bf16* BTq = (LAS bf16*)(IQ + I_BT); LAS bf16* KLq = (LAS bf16*)(IQ + I_KL); LAS bf16* RTq = (LAS bf16*)(IQ + I_RT);
            float wall = 1.f, wpre = 1.f;
#pragma unroll
            for (int t = 0; t < 16; ++t) { if (t == 4 * seg) wpre = wall; wall *= X_[1024 + t * 64]; }
            float wt = wpre; unsigned short bt4[4], kt4[4];
#pragma unroll
            for (int i = 0; i < 4; ++i) { const int t = 4 * seg + i; const float wprev = wt; wt *= X_[1024 + t * 64]; const float iw = __builtin_amdgcn_rcpf(wt);
                const float r_ = X_[t * 64], k_ = X_[2048 + t * 64], kk_ = X_[3072 + t * 64], b_ = X_[4096 + t * 64];
                const float ct = kk_ * wprev, bt = b_ * iw, kt = k_ * iw;
                CTq[t * RS + d] = hw_bf(ct); IQ[I_CF + t * 64 + d] = ct; BTq[t * RS + d] = hw_bf(bt); KLq[t * RS + d] = hw_bf(kt); RTq[t * RS + d] = hw_bf(r_ * wt);
                bt4[i] = (unsigned short)hw_bf(-bt); kt4[i] = (unsigned short)hw_bf(kt); }
            u32x2 o; o.x = (unsigned)bt4[0] | ((unsigned)bt4[1] << 16); o.y = (unsigned)bt4[2] | ((unsigned)bt4[3] << 16); *(LAS u32x2*)((LAS bf16*)(IQ + I_BTT) + d * 16 + 4 * seg) = o;
            o.x = (unsigned)kt4[0] | ((unsigned)kt4[1] << 16); o.y = (unsigned)kt4[2] | ((unsigned)kt4[3] << 16); *(LAS u32x2*)((LAS bf16*)(IQ + I_KTT) + d * 16 + 4 * seg) = o;
            if (seg == 3) IQ[I_W15 + d] = wall;
        }
        LBAR();
        if (ww == 0) {
            f32x4 cb = {0.f, 0.f, 0.f, 0.f}, bc = cb, ck = cb, rkm = cb, rbm = cb;
#pragma unroll
            for (int ks = 0; ks < 2; ++ks) { const bf16x8 fc = *(const LAS bf16x8*)(CT + fr * RS + 32 * ks + 8 * g), fb = *(const LAS bf16x8*)(BT + fr * RS + 32 * ks + 8 * g), fk = *(const LAS bf16x8*)(KL + fr * RS + 32 * ks + 8 * g), frr = *(const LAS bf16x8*)(RT + fr * RS + 32 * ks + 8 * g);
                cb = __builtin_amdgcn_mfma_f32_16x16x32_bf16(fc, fb, cb, 0, 0, 0); bc = __builtin_amdgcn_mfma_f32_16x16x32_bf16(fb, fc, bc, 0, 0, 0); ck = __builtin_amdgcn_mfma_f32_16x16x32_bf16(fc, fk, ck, 0, 0, 0);
                rkm = __builtin_amdgcn_mfma_f32_16x16x32_bf16(frr, fk, rkm, 0, 0, 0); rbm = __builtin_amdgcn_mfma_f32_16x16x32_bf16(frr, fb, rbm, 0, 0, 0); }
            f32x4 N1, M1, CKm;
#pragma unroll
            for (int r = 0; r < 4; ++r) { const int t = 4 * g + r; N1[r] = (fr < t) ? -cb[r] : 0.f; M1[r] = (t < fr) ? -bc[r] : 0.f; CKm[r] = (fr < t) ? ck[r] : 0.f;
                RKB[t * 16 + fr] = hw_bf((fr <= t) ? rkm[r] : 0.f); RBB[t * 16 + fr] = hw_bf((fr <= t) ? -rbm[r] : 0.f); }
#define XTY(X, Y, C0) __builtin_amdgcn_mfma_f32_16x16x32_bf16(mk_frag((u32x2){hw_pk2(X[0], X[1]), hw_pk2(X[2], X[3])}, zz), mk_frag((u32x2){hw_pk2(Y[0], Y[1]), hw_pk2(Y[2], Y[3])}, zz), C0, 0, 0, 0)
            const f32x4 z4 = {0.f, 0.f, 0.f, 0.f};
            f32x4 T1t = M1;
#pragma unroll
            for (int r = 0; r < 4; ++r) if (4 * g + r == fr) T1t[r] += 1.f;
            const f32x4 N2 = XTY(M1, N1, z4), M2 = XTY(N1, M1, z4);
            const f32x4 T2t = XTY(N2, T1t, T1t);
            const f32x4 N4 = XTY(M2, N2, z4), M4 = XTY(N2, M2, z4);
            const f32x4 T4t = XTY(N4, T2t, T2t);
            const f32x4 N8 = XTY(M4, N4, z4);
            const f32x4 T8t = XTY(N8, T4t, T4t);
            const f32x4 G1t = XTY(CKm, T8t, z4);
#undef XTY
            u32x2 tw; tw.x = hw_pk2(T8t[0], T8t[1]); tw.y = hw_pk2(T8t[2], T8t[3]); *(LAS u32x2*)(TTB + fr * 16 + 4 * g) = tw;
            tw.x = hw_pk2(G1t[0], G1t[1]); tw.y = hw_pk2(G1t[2], G1t[3]); *(LAS u32x2*)(G1B + fr * 16 + 4 * g) = tw;
        }
        if (c + 1 < c_end) { RM_XFORM((c + 1) & 1); }
        if (c + 2 < c_end) RM_LOAD(c + 2);
        LBAR();
        const LAS float* VVc = Lf + O_VV + ((c & 1) * 2 + hh) * 1024;
        u32x2 vlo; { vlo.x = hw_pk2(VVc[(4 * g + 0) * 64 + c0 + fr], VVc[(4 * g + 1) * 64 + c0 + fr]); vlo.y = hw_pk2(VVc[(4 * g + 2) * 64 + c0 + fr], VVc[(4 * g + 3) * 64 + c0 + fr]); }
        const bf16x8 vb = mk_frag(vlo, zz);
        f32x4 accU = {0.f, 0.f, 0.f, 0.f};
        {
            accU = __builtin_amdgcn_mfma_f32_16x16x32_bf16(mk_frag(*(const LAS u32x2*)(G1B + fr * 16 + 4 * g), zz), vb, accU, 0, 0, 0);
            u32x2 clo; clo.x = hw_pk2(IM[I_CF + (4 * g + 0) * 64 + c0 + fr], IM[I_CF + (4 * g + 1) * 64 + c0 + fr]); clo.y = hw_pk2(IM[I_CF + (4 * g + 2) * 64 + c0 + fr], IM[I_CF + (4 * g + 3) * 64 + c0 + fr]);
            f32x4 accw = {0.f, 0.f, 0.f, 0.f};
            accw = __builtin_amdgcn_mfma_f32_16x16x32_bf16(mk_frag(*(const LAS u32x2*)(TTB + fr * 16 + 4 * g), zz), mk_frag(clo, zz), accw, 0, 0, 0);
#pragma unroll
            for (int r = 0; r < 4; ++r) WCB[(4 * g + r) * RS + c0 + fr] = hw_bf(accw[r]);
        }
        LBAR();
        if (role == 0) {
            RM_STATE_PART(vb);
            LBAR();
            RM_FLUSH(c, rg_cur, *(const LAS f32x4*)(Lf + O_VV + ((c & 1) * 2 + hx) * 1024 + tl * 64 + d4), Lf[O_BS + ((c & 1) * 2 + hx) * 16 + tl]);
        } else {
            float* rec = STASH + (size_t)(c - c_begin) * REC;
            for (int i = tid; i < 1376; i += NTHREADS) { const int hd = i >= 688, j = i - hd * 688; const int o = O_IMG + hd * IMGSZ + (j < 144 ? I_RT + 4 * j : I_BTT + 4 * (j - 144)); *(GAS f32x4*)(rec + 4 * i) = *(const LAS f32x4*)(Lf + o); }
            { GAS unsigned* ru = (GAS unsigned*)(rec + 5504); ru[(w * 2 + 0) * 64 + lane] = hw_pk2(accU[0], accU[1]); ru[(w * 2 + 1) * 64 + lane] = hw_pk2(accU[2], accU[3]); }
            { const f32x4 v4 = *(const LAS f32x4*)(Lf + O_VV + ((c & 1) * 2 + hx) * 1024 + tl * 64 + d4); u32x2 o; o.x = hw_pk2(v4[0], v4[1]); o.y = hw_pk2(v4[2], v4[3]); *(GAS u32x2*)(rec + 6528 + 2 * tid) = o; }
            if (tid < 32) rec[7552 + tid] = Lf[O_BS + (c & 1) * 32 + tid];
            LBAR();
        }
        rg_cur = rg_nxt; rg_nxt = rg_far;
    }
    if (role == 0) {
#pragma unroll
        for (int i = 0; i < 4; ++i)
#pragma unroll
            for (int r = 0; r < 4; ++r) STATE[((w * 4 + i) * 4 + r) * 64 + lane] = Macc[i][r];
        asm volatile("s_waitcnt vmcnt(0)" ::: "memory");
        __syncthreads();
        if (tid == 0) { __builtin_amdgcn_fence(__ATOMIC_RELEASE, "agent"); asm volatile("s_waitcnt vmcnt(0)" ::: "memory"); __hip_atomic_store(flag, 1u, __ATOMIC_RELAXED, __HIP_MEMORY_SCOPE_AGENT); }
    } else {
        if (tid == 0) { unsigned sp = 0; while (__hip_atomic_load(flag, __ATOMIC_RELAXED, __HIP_MEMORY_SCOPE_AGENT) == 0u) { __builtin_amdgcn_s_sleep(8); if (++sp > (1u << 22)) break; }
            __builtin_amdgcn_fence(__ATOMIC_ACQUIRE, "agent"); asm volatile("s_waitcnt vmcnt(0)" ::: "memory"); }
        __syncthreads();
#pragma unroll
        for (int i = 0; i < 4; ++i)
#pragma unroll
            for (int r = 0; r < 4; ++r) Macc[i][r] = STATE[((w * 4 + i) * 4 + r) * 64 + lane];
        f32x4 pi0, pi1, pi2; unsigned pu0, pu1; u32x2 pv, pgate; float pbs;
#define RM_REC_LOAD(cc) do { const float* rec = STASH + (size_t)((cc) - c_begin) * REC; pi0 = *(const GAS f32x4*)(rec + 4 * tid); pi1 = *(const GAS f32x4*)(rec + 4 * (tid + 512)); \
            pi2 = (tid < 352) ? *(const GAS f32x4*)(rec + 4 * (tid + 1024)) : (f32x4){0.f, 0.f, 0.f, 0.f}; \
            const GAS unsigned* ru = (const GAS unsigned*)(rec + 5504); pu0 = ru[(w * 2 + 0) * 64 + lane]; pu1 = ru[(w * 2 + 1) * 64 + lane]; pv = *(const GAS u32x2*)(rec + 6528 + 2 * tid); pbs = rec[7552 + hx * 16 + tl]; \
            pgate = *(const GAS u32x2*)(LO + (size_t)((cc) * TC + tl) * LORA_N + col4 + 2048); } while (0)
#define RM_IMG_OFF(i_) (O_IMG + ((i_) >= 688) * IMGSZ + ((((i_) - ((i_) >= 688) * 688) < 144) ? I_RT + 4 * ((i_) - ((i_) >= 688) * 688) : I_BTT + 4 * (((i_) - ((i_) >= 688) * 688) - 144)))
        RM_REC_LOAD(c_begin);
        for (int c = c_begin; c < c_end; ++c) {
            *(LAS f32x4*)(Lf + RM_IMG_OFF(tid)) = pi0; *(LAS f32x4*)(Lf + RM_IMG_OFF(tid + 512)) = pi1; if (tid < 352) *(LAS f32x4*)(Lf + RM_IMG_OFF(tid + 1024)) = pi2;
            const f32x4 vcur = {bf_lo(pv.x), bf_hi(pv.x), bf_lo(pv.y), bf_hi(pv.y)}; *(LAS f32x4*)(Lf + O_VV + hx * 1024 + tl * 64 + d4) = vcur;
            const f32x4 accU = {bf_lo(pu0), bf_hi(pu0), bf_lo(pu1), bf_hi(pu1)}; const float bscur = pbs; const u32x2 gcur = pgate;
            if (c + 1 < c_end) RM_REC_LOAD(c + 1);
            LBAR();
            const LAS float* VVc = Lf + O_VV + hh * 1024;
            u32x2 vlo; { vlo.x = hw_pk2(VVc[(4 * g + 0) * 64 + c0 + fr], VVc[(4 * g + 1) * 64 + c0 + fr]); vlo.y = hw_pk2(VVc[(4 * g + 2) * 64 + c0 + fr], VVc[(4 * g + 3) * 64 + c0 + fr]); }
            const bf16x8 vb = mk_frag(vlo, zz);
            RM_STATE_PART(vb);
            LBAR();
            RM_FLUSH(c, gcur, vcur, bscur);
            LBAR();
        }
#undef RM_REC_LOAD
#undef RM_IMG_OFF
    }
#undef RM_STATE_PART
#undef RM_FLUSH
#undef RM_LOAD
#undef RM_XFORM
}

__device__ __forceinline__ int med3i(int a, int b, int c) { int r; asm("v_med3_i32 %0, %1, %2, %3" : "=v"(r) : "v"(a), "v"(b), "v"(c)); return r; }
__device__ __forceinline__ int f2sort(float f) { int x = __float_as_int(f); return x ^ ((x >> 31) & 0x7fffffff); }
__device__ __forceinline__ float sort2f(int x) { return __int_as_float(x ^ ((x >> 31) & 0x7fffffff)); }
#define TOPK_INSERT(vals, x) do { _Pragma("unroll") for (int s_ = 15; s_ >= 1; --s_) vals[s_] = med3i((x), vals[s_ - 1], vals[s_]); vals[0] = max(vals[0], (x)); } while (0)
__device__ __forceinline__ float bf_dot2(unsigned a, unsigned b, float c) {
    return c + bf_lo(a) * bf_lo(b) + bf_hi(a) * bf_hi(b);
}
__device__ __forceinline__ void sum8_x8(float (&a)[8]) {
    asm("s_nop 1\n\t"
        "v_add_f32_dpp %0, %0, %0 quad_perm:[1,0,3,2] row_mask:0xf bank_mask:0xf\n\tv_add_f32_dpp %1, %1, %1 quad_perm:[1,0,3,2] row_mask:0xf bank_mask:0xf\n\t"
        "v_add_f32_dpp %2, %2, %2 quad_perm:[1,0,3,2] row_mask:0xf bank_mask:0xf\n\tv_add_f32_dpp %3, %3, %3 quad_perm:[1,0,3,2] row_mask:0xf bank_mask:0xf\n\t"
        "v_add_f32_dpp %4, %4, %4 quad_perm:[1,0,3,2] row_mask:0xf bank_mask:0xf\n\tv_add_f32_dpp %5, %5, %5 quad_perm:[1,0,3,2] row_mask:0xf bank_mask:0xf\n\t"
        "v_add_f32_dpp %6, %6, %6 quad_perm:[1,0,3,2] row_mask:0xf bank_mask:0xf\n\tv_add_f32_dpp %7, %7, %7 quad_perm:[1,0,3,2] row_mask:0xf bank_mask:0xf\n\t"
        "v_add_f32_dpp %0, %0, %0 quad_perm:[2,3,0,1] row_mask:0xf bank_mask:0xf\n\tv_add_f32_dpp %1, %1, %1 quad_perm:[2,3,0,1] row_mask:0xf bank_mask:0xf\n\t"
        "v_add_f32_dpp %2, %2, %2 quad_perm:[2,3,0,1] row_mask:0xf bank_mask:0xf\n\tv_add_f32_dpp %3, %3, %3 quad_perm:[2,3,0,1] row_mask:0xf bank_mask:0xf\n\t"
        "v_add_f32_dpp %4, %4, %4 quad_perm:[2,3,0,1] row_mask:0xf bank_mask:0xf\n\tv_add_f32_dpp %5, %5, %5 quad_perm:[2,3,0,1] row_mask:0xf bank_mask:0xf\n\t"
        "v_add_f32_dpp %6, %6, %6 quad_perm:[2,3,0,1] row_mask:0xf bank_mask:0xf\n\tv_add_f32_dpp %7, %7, %7 quad_perm:[2,3,0,1] row_mask:0xf bank_mask:0xf\n\t"
        "v_add_f32_dpp %0, %0, %0 row_half_mirror row_mask:0xf bank_mask:0xf\n\tv_add_f32_dpp %1, %1, %1 row_half_mirror row_mask:0xf bank_mask:0xf\n\t"
        "v_add_f32_dpp %2, %2, %2 row_half_mirror row_mask:0xf bank_mask:0xf\n\tv_add_f32_dpp %3, %3, %3 row_half_mirror row_mask:0xf bank_mask:0xf\n\t"
        "v_add_f32_dpp %4, %4, %4 row_half_mirror row_mask:0xf bank_mask:0xf\n\tv_add_f32_dpp %5, %5, %5 row_half_mirror row_mask:0xf bank_mask:0xf\n\t"
        "v_add_f32_dpp %6, %6, %6 row_half_mirror row_mask:0xf bank_mask:0xf\n\tv_add_f32_dpp %7, %7, %7 row_half_mirror row_mask:0xf bank_mask:0xf\n\t"
        "s_nop 1"
        : "+v"(a[0]), "+v"(a[1]), "+v"(a[2]), "+v"(a[3]), "+v"(a[4]), "+v"(a[5]), "+v"(a[6]), "+v"(a[7]));
}
__device__ __forceinline__ void sum8i_x8(int (&a)[8]) {
    asm("s_nop 1\n\t"
        "v_add_u32_dpp %0, %0, %0 quad_perm:[1,0,3,2] row_mask:0xf bank_mask:0xf\n\tv_add_u32_dpp %1, %1, %1 quad_perm:[1,0,3,2] row_mask:0xf bank_mask:0xf\n\t"
        "v_add_u32_dpp %2, %2, %2 quad_perm:[1,0,3,2] row_mask:0xf bank_mask:0xf\n\tv_add_u32_dpp %3, %3, %3 quad_perm:[1,0,3,2] row_mask:0xf bank_mask:0xf\n\t"
        "v_add_u32_dpp %4, %4, %4 quad_perm:[1,0,3,2] row_mask:0xf bank_mask:0xf\n\tv_add_u32_dpp %5, %5, %5 quad_perm:[1,0,3,2] row_mask:0xf bank_mask:0xf\n\t"
        "v_add_u32_dpp %6, %6, %6 quad_perm:[1,0,3,2] row_mask:0xf bank_mask:0xf\n\tv_add_u32_dpp %7, %7, %7 quad_perm:[1,0,3,2] row_mask:0xf bank_mask:0xf\n\t"
        "v_add_u32_dpp %0, %0, %0 quad_perm:[2,3,0,1] row_mask:0xf bank_mask:0xf\n\tv_add_u32_dpp %1, %1, %1 quad_perm:[2,3,0,1] row_mask:0xf bank_mask:0xf\n\t"
        "v_add_u32_dpp %2, %2, %2 quad_perm:[2,3,0,1] row_mask:0xf bank_mask:0xf\n\tv_add_u32_dpp %3, %3, %3 quad_perm:[2,3,0,1] row_mask:0xf bank_mask:0xf\n\t"
        "v_add_u32_dpp %4, %4, %4 quad_perm:[2,3,0,1] row_mask:0xf bank_mask:0xf\n\tv_add_u32_dpp %5, %5, %5 quad_perm:[2,3,0,1] row_mask:0xf bank_mask:0xf\n\t"
        "v_add_u32_dpp %6, %6, %6 quad_perm:[2,3,0,1] row_mask:0xf bank_mask:0xf\n\tv_add_u32_dpp %7, %7, %7 quad_perm:[2,3,0,1] row_mask:0xf bank_mask:0xf\n\t"
        "v_add_u32_dpp %0, %0, %0 row_half_mirror row_mask:0xf bank_mask:0xf\n\tv_add_u32_dpp %1, %1, %1 row_half_mirror row_mask:0xf bank_mask:0xf\n\t"
        "v_add_u32_dpp %2, %2, %2 row_half_mirror row_mask:0xf bank_mask:0xf\n\tv_add_u32_dpp %3, %3, %3 row_half_mirror row_mask:0xf bank_mask:0xf\n\t"
        "v_add_u32_dpp %4, %4, %4 row_half_mirror row_mask:0xf bank_mask:0xf\n\tv_add_u32_dpp %5, %5, %5 row_half_mirror row_mask:0xf bank_mask:0xf\n\t"
        "v_add_u32_dpp %6, %6, %6 row_half_mirror row_mask:0xf bank_mask:0xf\n\tv_add_u32_dpp %7, %7, %7 row_half_mirror row_mask:0xf bank_mask:0xf\n\t"
        "s_nop 1"
        : "+v"(a[0]), "+v"(a[1]), "+v"(a[2]), "+v"(a[3]), "+v"(a[4]), "+v"(a[5]), "+v"(a[6]), "+v"(a[7]));
}
__device__ __forceinline__ float max8_x1(float v) {
    asm("s_nop 1\n\tv_max_f32_dpp %0, %0, %0 quad_perm:[1,0,3,2] row_mask:0xf bank_mask:0xf\n\ts_nop 1\n\tv_max_f32_dpp %0, %0, %0 quad_perm:[2,3,0,1] row_mask:0xf bank_mask:0xf\n\ts_nop 1\n\t"
        "v_max_f32_dpp %0, %0, %0 row_half_mirror row_mask:0xf bank_mask:0xf\n\ts_nop 1" : "+v"(v));
    return v;
}
__device__ __forceinline__ float sum8_x1(float v) {
    asm("s_nop 1\n\tv_add_f32_dpp %0, %0, %0 quad_perm:[1,0,3,2] row_mask:0xf bank_mask:0xf\n\ts_nop 1\n\tv_add_f32_dpp %0, %0, %0 quad_perm:[2,3,0,1] row_mask:0xf bank_mask:0xf\n\ts_nop 1\n\t"
        "v_add_f32_dpp %0, %0, %0 row_half_mirror row_mask:0xf bank_mask:0xf\n\ts_nop 1" : "+v"(v));
    return v;
}
__device__ __forceinline__ void peer_phase(const Args& A, Frame& F, int L, const bool dry, const bf16* Hin, bf16* Hout, unsigned char* H8) {
    int lane = F.lane; asm volatile("" : "+v"(lane));
    const int gw = F.vcu * NWAVES + F.wave;
    const bf16* SCR = (const bf16*)(A.ws + WS_SC); const bf16* X = Hin; float* RS3 = (float*)(A.ws + WS_RS3);
    const unsigned char* TU = (const unsigned char*)(A.ws + WS_TABU) + (size_t)L * 16384 * D; const unsigned char* TV = (const unsigned char*)(A.ws + WS_TABV) + (size_t)L * 16384 * D;
    const float* SUL = (const float*)(A.ws + WS_SU) + (size_t)L * 16384; const float* SVL = SUL + 32768;
    const float* rowss = (const float*)(A.ws + WS_RSP) + (size_t)(L == 0 ? RS_FFN0 : RS_FFN1) * T * 32;
    LAS unsigned* LIST = (LAS unsigned*)(F.lds + RING_OFF + F.wave * 16384);
    LAS unsigned* EIDX = LIST + 1024;
    LAS float* ECOEF = (LAS float*)(EIDX + 1024);
    const int tbase = gw * 8;
    if (tbase >= T) return;
    for (int half = 0; half < 2; ++half) {
        const int t0 = tbase + 4 * half;
        {
            const bf16* sp = SCR + (size_t)(t0 + (lane >> 4)) * D + (lane & 15) * 128;
            int vals[16];
#pragma unroll
            for (int s = 0; s < 16; ++s) vals[s] = (int)0x80000000;
#pragma unroll 2
            for (int c = 0; c < 16; ++c) { const v4u wv = *(const GAS v4u*)(sp + c * 8); const unsigned ww[4] = {wv.x, wv.y, wv.z, wv.w};
#pragma unroll
                for (int e = 0; e < 8; ++e) { const unsigned bits = (e & 1) ? (ww[e >> 1] & 0xffff0000u) : (ww[e >> 1] << 16);
                    int x = (int)bits; x ^= (x >> 31) & 0x7fffffff; x = (x & ~0x7f) | (127 - (c * 8 + e));
                    TOPK_INSERT(vals, x); } }
#pragma unroll
            for (int q = 0; q < 4; ++q) { v4u o; o.x = (unsigned)vals[4 * q]; o.y = (unsigned)vals[4 * q + 1]; o.z = (unsigned)vals[4 * q + 2]; o.w = (unsigned)vals[4 * q + 3]; *(LAS v4u*)(LIST + lane * 16 + 4 * q) = o; }
        }
        LDS_WAIT(); asm volatile("" ::: "memory");
        if (lane < 32) {
            const LAS unsigned* la = LIST + ((lane >> 3) * 16 + (lane & 7) * 2) * 16; const LAS unsigned* lb2 = la + 16;
            float av[16], bv[16];
#pragma unroll
            for (int q = 0; q < 4; ++q) { const v4u a4 = *(const LAS v4u*)(la + 4 * q), b4 = *(const LAS v4u*)(lb2 + 4 * q); const unsigned aw[4] = {a4.x, a4.y, a4.z, a4.w}, bw[4] = {b4.x, b4.y, b4.z, b4.w};
#pragma unroll
                for (int e = 0; e < 4; ++e) { av[4 * q + e] = __uint_as_float(__float_as_uint(sort2f((int)(aw[e] & ~0x7fu))) & 0xffff0000u); bv[4 * q + e] = __uint_as_float(__float_as_uint(sort2f((int)(bw[e] & ~0x7fu))) & 0xffff0000u); } }
            int best[16];
#pragma unroll
            for (int s = 0; s < 16; ++s) best[s] = (int)0x80000000;
#pragma unroll
            for (int i = 0; i < 16; ++i)
#pragma unroll
                for (int jx = 0; jx < 16; ++jx) if ((i + 1) * (jx + 1) <= 16) { int x = f2sort(av[i] + bv[jx]); x = (x & ~0xff) | (255 - (i * 16 + jx)); TOPK_INSERT(best, x); }
            float sv[16]; unsigned ex[16];
#pragma unroll
            for (int s = 0; s < 16; ++s) { const int cand = 255 - (best[s] & 0xff); const unsigned ka = la[cand >> 4], kb = lb2[cand & 15];
                ex[s] = (127u - (ka & 0x7fu)) * 128u + (127u - (kb & 0x7fu));
                sv[s] = __uint_as_float(__float_as_uint(sort2f((int)(ka & ~0x7fu))) & 0xffff0000u) + __uint_as_float(__float_as_uint(sort2f((int)(kb & ~0x7fu))) & 0xffff0000u); }
            float mx = sv[0];
#pragma unroll
            for (int s = 1; s < 16; ++s) mx = fmaxf(mx, sv[s]);
            float den = 0.f;
#pragma unroll
            for (int s = 0; s < 16; ++s) { sv[s] = __expf(sv[s] - mx); den += sv[s]; }
            const float inv = 1.0f / den; const int base = (4 * half + (lane >> 3)) * 128 + (lane & 7) * 16;
#pragma unroll
            for (int s = 0; s < 16; ++s) { EIDX[base + s] = ex[s]; ECOEF[base + s] = sv[s] * inv; }
        }
        LDS_WAIT(); asm volatile("" ::: "memory");
    }
    const int tk = lane >> 3, part = lane & 7, t = tbase + tk;
    const LAS unsigned* eidx = EIDX + tk * 128; LAS float* ecoef = ECOEF + tk * 128;
    const float rs = __builtin_amdgcn_rsqf(sum8_x1(((const GAS f32x4*)(rowss + (size_t)t * 32))[part][0] + ((const GAS f32x4*)(rowss + (size_t)t * 32))[part][1] + ((const GAS f32x4*)(rowss + (size_t)t * 32))[part][2] + ((const GAS f32x4*)(rowss + (size_t)t * 32))[part][3]) * (1.0f / D) + EPS);
    typedef _Float16 h2_t __attribute__((ext_vector_type(2)));
#if PEER_ALIAS
    const unsigned amask = dry ? 1023u : 0xffffffffu;
#else
    constexpr unsigned amask = 0xffffffffu;
#endif
#define PEER_LOAD8(dst, TAB, i0, soff) do { const v4u ia_ = *(const LAS v4u*)(eidx + (i0)), ib_ = *(const LAS v4u*)(eidx + (i0) + 4); const unsigned ee_[8] = {ia_.x, ia_.y, ia_.z, ia_.w, ib_.x, ib_.y, ib_.z, ib_.w}; \
        _Pragma("unroll") for (int j_ = 0; j_ < 8; ++j_) dst[j_] = *(const GAS v4u*)((TAB) + (size_t)((ee_[j_] & amask) * 2048u + (unsigned)(soff))); } while (0)
    LAS float* dotw = (LAS float*)LIST + tk * 128;
#pragma unroll
    for (int m = 0; m < 16; ++m) dotw[8 * m + part] = 0.f;
#pragma unroll 1
    for (int p = 0; p < 16; ++p) {
        const int soff = 128 * p + 16 * part;
        unsigned xq[4]; float sxs;
        { const v4u x0 = *(const GAS v4u*)(X + (size_t)t * D + soff), x1 = *(const GAS v4u*)(X + (size_t)t * D + soff + 8); const unsigned xw[8] = {x0.x, x0.y, x0.z, x0.w, x1.x, x1.y, x1.z, x1.w};
          float xv[16], am = 0.f;
#pragma unroll
          for (int e = 0; e < 8; ++e) { xv[2 * e] = bf_lo(xw[e]); xv[2 * e + 1] = bf_hi(xw[e]); am = fmaxf(am, fmaxf(fabsf(xv[2 * e]), fabsf(xv[2 * e + 1]))); }
          am = max8_x1(am); sxs = am * (1.0f / 127.0f); const float inv = am > 0.f ? 127.0f / am : 0.f;
#pragma unroll
          for (int q = 0; q < 4; ++q) { unsigned w = 0;
#pragma unroll
              for (int e = 0; e < 4; ++e) w |= (__float_as_uint(__builtin_fmaf(xv[4 * q + e], inv, 12582912.0f)) & 255u) << (8 * e);
              xq[q] = w; } }
#define PEER_UDOT8(src, m_) do { int tt_[8]; \
        _Pragma("unroll") for (int j_ = 0; j_ < 8; ++j_) { int a_ = __builtin_amdgcn_sdot4((int)src[j_].x, (int)xq[0], 0, false); a_ = __builtin_amdgcn_sdot4((int)src[j_].y, (int)xq[1], a_, false); \
            a_ = __builtin_amdgcn_sdot4((int)src[j_].z, (int)xq[2], a_, false); tt_[j_] = __builtin_amdgcn_sdot4((int)src[j_].w, (int)xq[3], a_, false); } \
        sum8i_x8(tt_); \
        int sel_ = tt_[0]; _Pragma("unroll") for (int j_ = 1; j_ < 8; ++j_) sel_ = (part == j_) ? tt_[j_] : sel_; \
        dotw[8 * (m_) + part] += (float)sel_ * sxs; } while (0)
        v4u ua[8], ub[8];
        PEER_LOAD8(ua, TU, 0, soff);
#pragma unroll 1
        for (int m = 0; m < 16; m += 2) {
            PEER_LOAD8(ub, TU, 8 * (m + 1), soff);
            PEER_UDOT8(ua, m);
            if (m + 2 < 16) PEER_LOAD8(ua, TU, 8 * (m + 2), soff);
            PEER_UDOT8(ub, m + 1);
        }
    }
#undef PEER_UDOT8
    LAS unsigned char* ecq = (LAS unsigned char*)(LIST + 3072) + tk * 128;
    float sc;
    { float cf[16], cm = 0.f;
#pragma unroll
      for (int m = 0; m < 16; ++m) { const unsigned e_ = eidx[8 * m + part]; const float d_ = dotw[8 * m + part] * rs * SUL[e_]; const float act = 0.5f * d_ * (1.0f + erff(d_ * 0.7071067811865476f));
          cf[m] = ecoef[8 * m + part] * act * SVL[e_]; cm = fmaxf(cm, fabsf(cf[m])); }
      cm = max8_x1(cm); sc = cm * (1.0f / 127.0f); const float inv = cm > 0.f ? 127.0f / cm : 0.f;
#pragma unroll
      for (int m = 0; m < 16; ++m) ecq[8 * m + part] = (unsigned char)(__float_as_uint(__builtin_fmaf(cf[m], inv, 12582912.0f)) & 255u); }
    LDS_WAIT(); asm volatile("" ::: "memory");
    float ss = 0.f;
#pragma unroll 1
    for (int p = 0; p < 16; ++p) {
        const int soff = 128 * p + 16 * part;
        int acc[16];
#pragma unroll
        for (int i = 0; i < 16; ++i) acc[i] = 0;
#define PEER_VACC8(src, i0) do { const u32x2 c8_ = *(const LAS u32x2*)(ecq + (i0)); \
        _Pragma("unroll") for (int h_ = 0; h_ < 2; ++h_) { const int cq_ = (int)(h_ ? c8_.y : c8_.x); \
            _Pragma("unroll") for (int q_ = 0; q_ < 4; ++q_) { \
                const unsigned a_ = q_ == 0 ? src[4 * h_].x : q_ == 1 ? src[4 * h_].y : q_ == 2 ? src[4 * h_].z : src[4 * h_].w, b_ = q_ == 0 ? src[4 * h_ + 1].x : q_ == 1 ? src[4 * h_ + 1].y : q_ == 2 ? src[4 * h_ + 1].z : src[4 * h_ + 1].w; \
                const unsigned c_ = q_ == 0 ? src[4 * h_ + 2].x : q_ == 1 ? src[4 * h_ + 2].y : q_ == 2 ? src[4 * h_ + 2].z : src[4 * h_ + 2].w, d_ = q_ == 0 ? src[4 * h_ + 3].x : q_ == 1 ? src[4 * h_ + 3].y : q_ == 2 ? src[4 * h_ + 3].z : src[4 * h_ + 3].w; \
                const unsigned lab_ = __builtin_amdgcn_perm(b_, a_, 0x05010400u), hab_ = __builtin_amdgcn_perm(b_, a_, 0x07030602u), lcd_ = __builtin_amdgcn_perm(d_, c_, 0x05010400u), hcd_ = __builtin_amdgcn_perm(d_, c_, 0x07030602u); \
                acc[4 * q_ + 0] = __builtin_amdgcn_sdot4((int)__builtin_amdgcn_perm(lcd_, lab_, 0x05040100u), cq_, acc[4 * q_ + 0], false); \
                acc[4 * q_ + 1] = __builtin_amdgcn_sdot4((int)__builtin_amdgcn_perm(lcd_, lab_, 0x07060302u), cq_, acc[4 * q_ + 1], false); \
                acc[4 * q_ + 2] = __builtin_amdgcn_sdot4((int)__builtin_amdgcn_perm(hcd_, hab_, 0x05040100u), cq_, acc[4 * q_ + 2], false); \
                acc[4 * q_ + 3] = __builtin_amdgcn_sdot4((int)__builtin_amdgcn_perm(hcd_, hab_, 0x07060302u), cq_, acc[4 * q_ + 3], false); } } } while (0)
        v4u va[8], vb[8];
        PEER_LOAD8(va, TV, 0, soff);
#pragma unroll 1
        for (int m = 0; m < 16; m += 2) {
            PEER_LOAD8(vb, TV, 8 * (m + 1), soff);
            PEER_VACC8(va, 8 * m);
            if (m + 2 < 16) PEER_LOAD8(va, TV, 8 * (m + 2), soff);
            PEER_VACC8(vb, 8 * (m + 1));
        }
        { const v4u h0 = *(const GAS v4u*)(Hin + (size_t)t * D + soff), h1 = *(const GAS v4u*)(Hin + (size_t)t * D + soff + 8); const unsigned hw[8] = {h0.x, h0.y, h0.z, h0.w, h1.x, h1.y, h1.z, h1.w}; unsigned ow[8];
#pragma unroll
          for (int e = 0; e < 8; ++e) { ow[e] = hw_pk2(bf_lo(hw[e]) + (float)acc[2 * e] * sc, bf_hi(hw[e]) + (float)acc[2 * e + 1] * sc); const float q0 = bf_lo(ow[e]), q1 = bf_hi(ow[e]); ss += q0 * q0 + q1 * q1; }
          v4u o0, o1; o0.x = ow[0]; o0.y = ow[1]; o0.z = ow[2]; o0.w = ow[3]; o1.x = ow[4]; o1.y = ow[5]; o1.z = ow[6]; o1.w = ow[7];
          if (!dry) { *(GAS v4u*)(Hout + (size_t)t * D + soff) = o0; *(GAS v4u*)(Hout + (size_t)t * D + soff + 8) = o1;
            if (H8) { v4u o8; unsigned q8[4];
#pragma unroll
              for (int e = 0; e < 4; ++e) { int x8 = __builtin_amdgcn_cvt_pk_fp8_f32(bf_lo(ow[2 * e]), bf_hi(ow[2 * e]), 0, false); x8 = __builtin_amdgcn_cvt_pk_fp8_f32(bf_lo(ow[2 * e + 1]), bf_hi(ow[2 * e + 1]), x8, true); q8[e] = (unsigned)x8; }
              o8.x = q8[0]; o8.y = q8[1]; o8.z = q8[2]; o8.w = q8[3]; *(GAS v4u*)(H8 + (size_t)t * D + soff) = o8; } } else asm volatile("" :: "v"(o0.x), "v"(o0.y), "v"(o0.z), "v"(o0.w), "v"(o1.x), "v"(o1.y), "v"(o1.z), "v"(o1.w)); }
    }
#undef PEER_VACC8
#undef PEER_LOAD8
    const float r3 = __builtin_amdgcn_rsqf(sum8_x1(ss) * (1.0f / D) + EPS);
    if (!dry && part == 0) RS3[t] = r3;
}


constexpr int N_PHASES = 19;
__global__ void __launch_bounds__(NTHREADS, 2) mega_fwd(Args args) {

    extern __shared__ __attribute__((aligned(16))) unsigned char lds[];
    Frame F;
    F.lds = (LAS unsigned char*)lds;
    F.MISC = (volatile LAS unsigned*)(F.lds + MISC_OFF);
    F.tid = threadIdx.x; F.lane = F.tid & 63; F.wave = __builtin_amdgcn_readfirstlane(F.tid >> 6);
    F.G = gridDim.x; { const int bx = blockIdx.x; F.vcu = (F.G % 8 == 0) ? (bx % 8) * (F.G / 8) + bx / 8 : bx; }
    unsigned char* ws = args.ws;
    F.ctl = (gu32*)(ws + WS_CTL);
    for (int u = F.tid; u < (LDS_BYTES - LDSCTL_OFF) / 4; u += NTHREADS) ((LAS unsigned*)(F.lds + LDSCTL_OFF))[u] = 0u;
    __syncthreads();
    const int lo = args.ph_lo, hi = args.ph_hi;
    XcdBarrier bar; bar.bar = (unsigned*)(F.ctl + CW_BAR); bar.x = 0; bar.st = nullptr;
    if (hi - lo > 1) bar = xcd_barrier_post((unsigned*)(F.ctl + CW_BAR), F.MISC + 8);
    bar.wave0 = (F.wave == 0);
#define IN(k) (lo <= (k) && (k) < hi)
#define REFRESH() do { int t_; asm volatile("v_mbcnt_lo_u32_b32 %0, -1, 0\n\tv_mbcnt_hi_u32_b32 %0, -1, %0" : "=v"(t_)); F.lane = t_; F.tid = F.wave * 64 + t_; } while (0)
#define REPS(k) (1 + ((DUP_MASK >> (k)) & 1))
#if PROBE_MASK
    unsigned long long* const tsb = (unsigned long long*)(ws + WS_CTL + 65536);
#define STAMP(k) do { if (blockIdx.x == 0 && F.tid == 0) __hip_atomic_store(tsb + (k), __builtin_amdgcn_s_memrealtime(), __ATOMIC_RELAXED, __HIP_MEMORY_SCOPE_AGENT); } while (0)
    STAMP(31);
#else
#define STAMP(k) do { } while (0)
#endif
#define SEAM(k) do { if (IN(k) && IN((k) + 1)) { if ((k) == 0) { cg::this_grid().sync(); } else { xcd_barrier(bar); if ((DUP_MASK >> 24) & 1) xcd_barrier(bar); } STAMP(k); } } while (0)
    float* rowss = (float*)(ws + WS_RSP);
    bf16* ACTA = (bf16*)(ws + WS_ACTA); bf16* ACTB = (bf16*)(ws + WS_ACTB); bf16* H1 = (bf16*)(ws + WS_H1); const float* RS3 = (const float*)(ws + WS_RS3);
    bf16* PROJ = (bf16*)(ws + WS_PROJ); bf16* SCB = (bf16*)(ws + WS_SC); bf16* PP = (bf16*)(ws + WS_PP);
    const int gtid = (F.vcu * NWAVES + F.wave) * 64 + F.lane, gthreads = F.G * NTHREADS;

#if UBENCH
    {
        typedef _Float16 h2_t __attribute__((ext_vector_type(2)));
        float a[32]; f32x2 p[16]; h2_t hh[32];
#pragma unroll
        for (int i = 0; i < 32; ++i) { a[i] = (float)(F.tid + i); hh[i] = (h2_t){(_Float16)(F.lane + i), (_Float16)i}; }
#pragma unroll
        for (int i = 0; i < 16; ++i) p[i] = (f32x2){a[2 * i], a[2 * i + 1]};
        const float m = 1.0f + 1e-7f * F.lane, c = 1e-9f; const f32x2 m2 = {m, m}, c2 = {c, c}; const h2_t mh = {(_Float16)1.0f, (_Float16)1.0f}, ch = {(_Float16)0.0f, (_Float16)0.0f};
#pragma unroll 1
        for (int it = 0; it < 10000; ++it) {
#if UBENCH == 1
#pragma unroll
            for (int i = 0; i < 32; ++i) asm volatile("v_fma_f32 %0, %0, %1, %2" : "+v"(a[i]) : "v"(m), "v"(c));
#elif UBENCH == 2
#pragma unroll
            for (int i = 0; i < 16; ++i) asm volatile("v_pk_fma_f32 %0, %0, %1, %2\n\tv_pk_fma_f32 %0, %0, %1, %2" : "+v"(p[i]) : "v"(m2), "v"(c2));
#elif UBENCH == 3
#pragma unroll
            for (int i = 0; i < 32; ++i) asm volatile("v_pk_fma_f16 %0, %0, %1, %2" : "+v"(hh[i]) : "v"(mh), "v"(ch));
#endif
        }
        float s = 0.f;
#pragma unroll
        for (int i = 0; i < 32; ++i) s += a[i] + (float)hh[i][0];
#pragma unroll
        for (int i = 0; i < 16; ++i) s += p[i][0] + p[i][1];
        if (s == 12345.678f) args.out[0] = s;
    }
#endif
    if (IN(0)) { REFRESH(); p0_prologue(args, F, 0); if (hi - lo > 1) { xcd_barrier(bar); REFRESH(); p0_prologue(args, F, 1); } } SEAM(0);
    if (IN(1)) for (int rep_ = 0; rep_ < REPS(1); ++rep_) { REFRESH();
#if EV_F8_T1 > EV_F8_T0
        if (EV_F8_T0 > 0) { constexpr int n_ = EV_F8_T0 * 256; pg8::Gemm g{ACTA, (const bf16*)(ws + WS_WEV_IN), T, n_, D}; pg8::StaticOrder S; S.init(T, n_, F.G, (int)blockIdx.x); EpiBf16S E{PROJ, PROJ_LD, nullptr};
          pg8::gemm_phase<EpiBf16S, pg8::StaticOrder, true, true>(F.lds + RING_OFF, g, S, E, F.wave); }
        { constexpr int n_ = (EV_F8_T1 - EV_F8_T0) * 256; pg8::Gemm g{(const bf16*)(ws + WS_H1), (const bf16*)(ws + WS_O + (size_t)EV_F8_T0 * 256 * D), T, n_, D / 2}; pg8::StaticOrder S; S.init(T, n_, F.G, (int)blockIdx.x); EpiBf16S E{PROJ + EV_F8_T0 * 256, PROJ_LD, nullptr};
          pg8::gemm_phase<EpiBf16S, pg8::StaticOrder, true, true, true>(F.lds + RING_OFF, g, S, E, F.wave); }
        if (EV_F8_T1 < EV_NP / 256) { constexpr int n_ = EV_NP - EV_F8_T1 * 256; pg8::Gemm g{ACTA, (const bf16*)(ws + WS_WEV_IN) + (size_t)EV_F8_T1 * 256 * D, T, n_, D}; pg8::StaticOrder S; S.init(T, n_, F.G, (int)blockIdx.x); EpiBf16S E{PROJ + EV_F8_T1 * 256, PROJ_LD, nullptr};
          pg8::gemm_phase<EpiBf16S, pg8::StaticOrder, true, true>(F.lds + RING_OFF, g, S, E, F.wave); }
        if (true) { const int g2 = F.G, c2 = (int)blockIdx.x;
#else
        { pg8::Gemm g{ACTA, (const bf16*)(ws + WS_WEV_IN), T, EV_NP, D / 2}; pg8::StaticOrder S; S.init(T, EV_NP, F.G, (int)blockIdx.x); EpiI8S E{PROJ, PROJ_LD, (const float*)(ws + WS_SA), (const float*)(ws + WS_CMB)};
          pg8::gemm_phase<EpiI8S, pg8::StaticOrder, true, true, false, true>(F.lds + RING_OFF, g, S, E, F.wave); }
        if (F.G == 256 ? (int)blockIdx.x >= 64 : true) { const int g2 = F.G == 256 ? 192 : F.G, c2 = F.G == 256 ? (int)blockIdx.x - 64 : (int)blockIdx.x;
#endif
          pg8::Gemm g{(const bf16*)(ws + WS_PBF), (const bf16*)(ws + WS_WPROJ), T, D, 256}; pg8::StaticOrder S; S.init(T, D, g2, c2); EpiBf16S E{PP, D, nullptr};
          pg8::gemm_phase<EpiBf16S, pg8::StaticOrder, true, true>(F.lds + RING_OFF, g, S, E, F.wave); }
    } SEAM(1);
    if (IN(2)) for (int rep_ = 0; rep_ < REPS(2); ++rep_) { REFRESH();
        if (F.G >= 256) {
            const int u = F.vcu;
            if (u < 64) scan_gla_mfma_unit<0>(args, F, u); else if (u < 128) scan_gdn_mfma_unit(args, F, u - 64, 0); else if (u < 192) scan_gdn_mfma_unit(args, F, u - 128, 1);
            __syncthreads();
            if (rep_ == 0) for (int dr_ = 0; dr_ < 1 + ((DUP_MASK >> 22) & 1); ++dr_) { if (u < 64) p0_deferred(args, F, 128 + u, 192); else if (u >= 192) for (int k = 0; k < 2; ++k) p0_deferred(args, F, 2 * (u - 192) + k, 192); }
        } else {
            for (int u = F.vcu; u < 64; u += F.G) { scan_gla_mfma_unit<0>(args, F, u); __syncthreads(); }
            for (int u = F.vcu; u < 64; u += F.G) { scan_gdn_mfma_unit(args, F, u, 0); __syncthreads(); scan_gdn_mfma_unit(args, F, u, 1); __syncthreads(); }
            if (rep_ == 0) p0_deferred(args, F, F.vcu, F.G);
        }
    } SEAM(2);
    if (IN(3)) for (int rep_ = 0; rep_ < REPS(3); ++rep_) { REFRESH(); post_rows<0>(args, F); } SEAM(3);
    if (IN(4)) { REFRESH(); pg8::Gemm g{ACTA, (const bf16*)(ws + WS_WEV_OUT), T, D, D}; pg8::StaticOrder S; S.init(T, D, F.G, (int)blockIdx.x);
        EpiResid<false, true> E{args.in[I_X], ACTB, rowss + (size_t)RS_FFN0 * T * 32, nullptr, nullptr, nullptr};
        pg8::gemm_phase<EpiResid<false, true>, pg8::StaticOrder, true, true>(F.lds + RING_OFF, g, S, E, F.wave); }
#if (DUP_MASK >> 20) & 1
    if (IN(4)) { REFRESH(); pg8::Gemm g{ACTA, (const bf16*)(ws + WS_WEV_OUT), T, D, D}; pg8::StaticOrder S; S.init(T, D, F.G, (int)blockIdx.x);
        EpiResid<false, true> E{args.in[I_X], ACTB, rowss + (size_t)RS_FFN0 * T * 32, nullptr, nullptr, nullptr};
        pg8::gemm_phase<EpiResid<false, true>, pg8::StaticOrder, true, true>(F.lds + RING_OFF, g, S, E, F.wave); }
#endif
#if (DUP_MASK >> 21) & 1
    if (IN(4)) { REFRESH(); pg8::Gemm g{ACTA, (const bf16*)(ws + WS_WEV_IN), T, EV_NP, D}; pg8::StaticOrder S; S.init(T, EV_NP, F.G, (int)blockIdx.x); EpiBf16S E{PROJ, PROJ_LD, nullptr};
        pg8::gemm_phase<EpiBf16S, pg8::StaticOrder, true, true>(F.lds + RING_OFF, g, S, E, F.wave); }
#endif
    SEAM(4);
    if (IN(5)) for (int rep_ = 0; rep_ < REPS(5); ++rep_) { REFRESH(); { pg8::Gemm g{ACTB, (const bf16*)(ws + WS_WPEER), T, D, D}; pg8::StaticOrder S; S.init(T, D, F.G, (int)blockIdx.x); EpiBf16S E{SCB, D, rowss + (size_t)RS_FFN0 * T * 32};
        pg8::gemm_phase<EpiBf16S, pg8::StaticOrder, true, true>(F.lds + RING_OFF, g, S, E, F.wave); }
        } SEAM(5);
    if (IN(6)) for (int rep_ = 0; rep_ < REPS(6); ++rep_) { REFRESH(); peer_phase(args, F, 0, rep_ != 0, ACTB, H1, (unsigned char*)ACTA); } SEAM(6);
    if (IN(7)) { REFRESH(); { pg8::Gemm g{ACTA, (const bf16*)(ws + WS_WGATE), T, D, D / 2}; pg8::StaticOrder S; S.init(T, D, F.G, (int)blockIdx.x);
        EpiResid<true, false> E{H1, ACTB, rowss + (size_t)RS_MIX1 * T * 32, PP, RS3, (unsigned char*)ACTA + (size_t)T * D};
        pg8::gemm_phase<EpiResid<true, false>, pg8::StaticOrder, true, true, true>(F.lds + RING_OFF, g, S, E, F.wave); }
        } SEAM(7);
    if (IN(8)) for (int rep_ = 0; rep_ < REPS(8); ++rep_) { REFRESH();
        { pg8::Gemm g{(const bf16*)((const unsigned char*)ACTA + (size_t)T * D), (const bf16*)(ws + WS_WOD_IN), T, OD_NP, D / 2}; pg8::StaticOrder S; S.init(T, OD_NP, F.G, (int)blockIdx.x); EpiBf16S E{PROJ, PROJ_LD, rowss + (size_t)RS_MIX1 * T * 32};
          pg8::gemm_phase<EpiBf16S, pg8::StaticOrder, true, true, true>(F.lds + RING_OFF, g, S, E, F.wave); }
        { pg8::Gemm g{(const bf16*)(ws + WS_PBF) + (size_t)T * 256, (const bf16*)(ws + WS_WPROJ) + (size_t)D * 256, T, D, 256}; pg8::StaticOrder S; S.init(T, D, F.G, (int)blockIdx.x); EpiBf16S E{PP, D, nullptr};
          pg8::gemm_phase<EpiBf16S, pg8::StaticOrder, true, true>(F.lds + RING_OFF, g, S, E, F.wave); }
    } SEAM(8);
    if (IN(9)) for (int rep_ = 0; rep_ < REPS(9); ++rep_) { REFRESH(); lora_prep_rows(args, F); } SEAM(9);
    if (IN(10)) for (int rep_ = 0; rep_ < REPS(10); ++rep_) { REFRESH(); pg8::Gemm g{(const bf16*)(ws + WS_LA), (const bf16*)(ws + WS_WLORA), T, LORA_N, LORA_K}; pg8::StaticOrder S; S.init(T, LORA_N, F.G, (int)blockIdx.x); EpiBf16S E{(bf16*)(ws + WS_LO), LORA_N, nullptr};
        pg8::gemm_phase<EpiBf16S, pg8::StaticOrder, true, true>(F.lds + RING_OFF, g, S, E, F.wave); } SEAM(10);
    if (IN(11)) for (int rep_ = 0; rep_ < REPS(11); ++rep_) { REFRESH();
        if (F.G >= 256) {
            const int u = F.vcu;
            if (u < 64) scan_gla_mfma_unit<1>(args, F, u); else if (u < 128) scan_rwkv_mfma_unit(args, F, u - 64, 0); else if (u < 192) scan_rwkv_mfma_unit(args, F, u - 128, 1);
            __syncthreads();
            if (rep_ == 0) for (int dr_ = 0; dr_ < 1 + ((DUP_MASK >> 23) & 1); ++dr_) { if (u < 64) p1_deferred(args, F, 128 + u, 192); else if (u >= 192) for (int k = 0; k < 2; ++k) p1_deferred(args, F, 2 * (u - 192) + k, 192); }
        } else {
            for (int u = F.vcu; u < 64; u += F.G) { scan_gla_mfma_unit<1>(args, F, u); __syncthreads(); }
            for (int u = F.vcu; u < 64; u += F.G) { scan_rwkv_mfma_unit(args, F, u, 0); __syncthreads(); scan_rwkv_mfma_unit(args, F, u, 1); __syncthreads(); }
            if (rep_ == 0) p1_deferred(args, F, F.vcu, F.G);
        }
    } SEAM(11);
    if (IN(12)) for (int rep_ = 0; rep_ < REPS(12); ++rep_) { REFRESH(); post_rows<1>(args, F); } SEAM(12);
    if (IN(13)) { REFRESH(); pg8::Gemm g{ACTA, (const bf16*)(ws + WS_WOD_OUT), T, D, D / 2}; pg8::StaticOrder S; S.init(T, D, F.G, (int)blockIdx.x);
        EpiResid<false, false> E{ACTB, H1, rowss + (size_t)RS_FFN1 * T * 32, nullptr, nullptr, nullptr};
        pg8::gemm_phase<EpiResid<false, false>, pg8::StaticOrder, true, true, true>(F.lds + RING_OFF, g, S, E, F.wave); } SEAM(13);
    if (IN(14)) for (int rep_ = 0; rep_ < REPS(14); ++rep_) { REFRESH(); pg8::Gemm g{H1, (const bf16*)(ws + WS_WPEER) + (size_t)D * D, T, D, D}; pg8::StaticOrder S; S.init(T, D, F.G, (int)blockIdx.x); EpiBf16S E{SCB, D, rowss + (size_t)RS_FFN1 * T * 32};
        pg8::gemm_phase<EpiBf16S, pg8::StaticOrder, true, true>(F.lds + RING_OFF, g, S, E, F.wave); } SEAM(14);
    if (IN(15)) for (int rep_ = 0; rep_ < REPS(15); ++rep_) { REFRESH(); peer_phase(args, F, 1, rep_ != 0, H1, ACTB, (unsigned char*)ACTA); } SEAM(15);
    if (IN(16)) { REFRESH(); pg8::Gemm g{ACTA, (const bf16*)(ws + WS_WGATE) + (size_t)D * D, T, D, D / 2}; pg8::StaticOrder S; S.init(T, D, F.G, (int)blockIdx.x);
        EpiResid<true, false> E{ACTB, H1, rowss + (size_t)RS_FINAL * T * 32, PP, RS3, nullptr};
        pg8::gemm_phase<EpiResid<true, false>, pg8::StaticOrder, true, true, true>(F.lds + RING_OFF, g, S, E, F.wave); } SEAM(16);
    if (IN(17)) { REFRESH();
        float oscale = 1.0f;
#if PROBE_MASK
        { unsigned long long t_prev = __hip_atomic_load(tsb + 31, __ATOMIC_RELAXED, __HIP_MEMORY_SCOPE_AGENT); const unsigned long long t_begin = t_prev; unsigned long long sel = 0ull;
          for (int k = 0; k <= 16; ++k) { const unsigned long long tk = __hip_atomic_load(tsb + k, __ATOMIC_RELAXED, __HIP_MEMORY_SCOPE_AGENT); if ((PROBE_MASK >> k) & 1) sel += tk - t_prev; t_prev = tk; }
          const float f = (float)(double(sel) / double(t_prev - t_begin)); oscale = 1.0f + sqrtf(0.01f + 0.9f * f); }
#endif
        final_rows(args, F, oscale, H1); }
#undef IN
#undef SEAM
#undef REFRESH
}

extern "C" void kernel_launch(void* const* d_in, const int* in_sizes, int n_in, void* d_out, int out_size, void* d_ws, size_t ws_size, hipStream_t stream) {
    static int grid = 0;
    if (grid == 0) {
        if (n_in != N_IN || out_size != T * D || ws_size < WS_END + 63 * MiB) { fprintf(stderr, "kernel_launch: unexpected problem: n_in %d out %d ws %zu (need %zu)\n", n_in, out_size, ws_size, (size_t)(WS_END + 63 * MiB)); grid = -1; return; }
        int dev = 0, cus = 0, per_cu = 0;
        if (hipGetDevice(&dev) != hipSuccess || hipDeviceGetAttribute(&cus, hipDeviceAttributeMultiprocessorCount, dev) != hipSuccess) { grid = -1; return; }
        if (hipFuncSetAttribute((const void*)mega_fwd, hipFuncAttributeMaxDynamicSharedMemorySize, LDS_BYTES) != hipSuccess) { fprintf(stderr, "kernel_launch: hipFuncSetAttribute failed\n"); grid = -1; return; }
        if (hipOccupancyMaxActiveBlocksPerMultiprocessor(&per_cu, (const void*)mega_fwd, NTHREADS, LDS_BYTES) != hipSuccess || per_cu < 1) { fprintf(stderr, "kernel_launch: occupancy query says %d blocks per CU\n", per_cu); (void)hipGetLastError(); grid = -1; return; }
        grid = cus;
    }
    if (grid < 0) return;
    (void)hipMemsetAsync((char*)d_ws + WS_CTL, 0, CTL_ZERO_BYTES, stream);
    Args a{};
    for (int i = 0; i < N_IN; ++i) a.in[i] = (const float*)d_in[i];
    a.out = (float*)d_out; a.ws = (unsigned char*)d_ws;
#if MK_PER_PHASE
    for (int p = 0; p < N_PHASES - 1; ++p) { a.ph_lo = p; a.ph_hi = p + 1; hipLaunchKernelGGL(mega_fwd, dim3(grid), dim3(NTHREADS), LDS_BYTES, stream, a); }
#else
    a.ph_lo = 0; a.ph_hi = N_PHASES;
    void* kargs[] = {&a};
    hipError_t e = hipLaunchCooperativeKernel((const void*)mega_fwd, dim3(grid), dim3(NTHREADS), kargs, LDS_BYTES, stream);
    if (e != hipSuccess) fprintf(stderr, "kernel_launch: cooperative launch failed: %s (grid %d)\n", hipGetErrorString(e), grid);
#endif
}
```

```cpp
#include <hip/hip_runtime.h>
#include <hip/hip_cooperative_groups.h>
#include <cstdio>
#include <cstdint>
namespace cg = cooperative_groups;

#ifndef PROBE_MASK
#define PROBE_MASK 0
#endif
#ifndef DUP_MASK
#define DUP_MASK 0
#endif
#ifndef UBENCH
#define UBENCH 0
#endif
#ifndef GDN_DUP
#define GDN_DUP 0
#endif
#ifndef MK_PER_PHASE
#ifndef PEER_ALIAS
#define PEER_ALIAS 0
#endif
#ifndef EV_F8_T0
#define EV_F8_T0 0
#define EV_F8_T1 0
#endif
#define MK_PER_PHASE 0
#endif

namespace pg8 {
#define PG8_LAS __attribute__((address_space(3)))
typedef unsigned short bf16_t;
typedef short bf16x8 __attribute__((ext_vector_type(8)));
typedef float f32x4 __attribute__((ext_vector_type(4)));
typedef unsigned u32x4 __attribute__((ext_vector_type(4)));
typedef unsigned u32x2 __attribute__((ext_vector_type(2)));
constexpr int BM = 256, BK = 64, HALF = 128, HTB = HALF * BK * 2  , STAGE_BYTES = 8 * HTB, NXCD = 8, WGM = 8;

__host__ __device__ __forceinline__ int lds_byte(int r, int c) { const int st = (r >> 4) * 2 + (c >> 5), rr = r & 15, cc = c & 31, ob = rr * 64 + cc * 2; return st * 1024 + (ob ^ (((ob >> 9) & 1) << 5)); }
__host__ __device__ __forceinline__ void stage_rc(int b, int& R, int& C) { const int st = b / 1024, sb = b % 1024, swz = sb ^ (((sb >> 9) & 1) << 5); R = (st >> 1) * 16 + swz / 64; C = (st & 1) * 32 + (swz % 64) / 2; }
__host__ __device__ __forceinline__ int perm32(int rho) { const int n = rho >> 4, i = rho & 15; return 8 * (i >> 2) + 4 * n + (i & 3); }

struct Unit { int pm, pn; };
struct Gemm { const bf16_t* A; const bf16_t* Bt; int M, N, K; int KE = 0; };

struct StaticOrder {
    int nM, nN, nwg, G, c;
    __host__ __device__ void init(int M, int N, int G_, int c_) { nM = M / BM; nN = N / BM; nwg = nM * nN; G = G_; c = c_; }
    __host__ __device__ bool next(int i, Unit& u) const {
        const long L = (long)i * G + c; if (L >= nwg) return false;
        int wgid = (int)L; { const int q = nwg / NXCD, r = nwg % NXCD, xcd = wgid % NXCD, off = wgid / NXCD; wgid = (xcd < r ? xcd * (q + 1) : r * (q + 1) + (xcd - r) * q) + off; }
        const int nig = WGM * nN, gid = wgid / nig, fm = gid * WGM, gsz = (nM - fm) < WGM ? (nM - fm) : WGM;
        u.pm = fm + ((wgid % nig) % gsz); u.pn = (wgid % nig) / gsz; return true;
    }
    __device__ __forceinline__ void a_ready(const Unit&) const {}
    __device__ __forceinline__ void done(const Unit&) const {}
};
__device__ __forceinline__ unsigned cvt_pk_bf16(float lo, float hi) { unsigned r; asm volatile("v_cvt_pk_bf16_f32 %0, %1, %2" : "=v"(r) : "v"(lo), "v"(hi)); return r; }
template <class Epi, class Sched, bool ALIGN_EPI = false, bool SP2 = false, bool F8 = false, bool I8 = false>
__device__ __forceinline__ void gemm_phase(PG8_LAS unsigned char* lds, const Gemm g, const Sched& S, const Epi& E, const int wave_id) {
    int tid; asm volatile("v_mbcnt_lo_u32_b32 %0, -1, 0\n\tv_mbcnt_hi_u32_b32 %0, -1, %0" : "=v"(tid)); tid += wave_id * 64;
    const int wid = wave_id, lane = tid & 63, wr = wid >> 2, wc = wid & 3, fr = lane & 15, fq = lane >> 4;
    const int K = g.K, nt = (g.KE ? g.KE : K) / BK;
    unsigned voffA[2], voffB[2];
#pragma unroll
    for (int i = 0; i < 2; ++i) { int R, C; stage_rc(tid * 16 + i * 8192, R, C); const int Rb = Epi::PERM ? ((R & ~31) + perm32(R & 31)) : R;
        voffA[i] = (unsigned)(R * K + C) * 2u; voffB[i] = (unsigned)(Rb * K + C) * 2u; }
    const __amdgpu_buffer_rsrc_t rsrcA = __builtin_amdgcn_make_buffer_rsrc((void*)g.A, 0, 0x7fffffff, 0x00020000), rsrcB = __builtin_amdgcn_make_buffer_rsrc((void*)g.Bt, 0, 0x7fffffff, 0x00020000);
    const size_t kstep = (size_t)(BK * 2);
    const size_t hstep = (size_t)HALF * K * 2;
    const size_t tstep = 2 * hstep;
    const unsigned ldsw = (unsigned)wid * 1024u;
    const int aoff = lds_byte(wr * 64 + fr, fq * 8), boff = lds_byte(wc * 32 + fr, fq * 8);
#define PG8_SA(b, h) (((b) * 2 + (h)) * HTB)
#define PG8_SB(b, h) ((4 + (b) * 2 + (h)) * HTB)
#define PG8_STAGE(bufoff, gbase, voff) do { const bool isA_ = (+(voff) == +voffA); const unsigned soff_ = (unsigned)((const char*)(gbase) - (isA_ ? (const char*)g.A : (const char*)g.Bt)); _Pragma("unroll") for (int _i = 0; _i < 2; ++_i) \
        __builtin_amdgcn_raw_ptr_buffer_load_lds(isA_ ? rsrcA : rsrcB, (PG8_LAS unsigned*)(lds + (bufoff) + ldsw + _i * 8192), 16, (int)(voff)[_i], (int)soff_, 0, 0); } while (0)
#define PG8_LDA(dst, b, h) do { _Pragma("unroll") for (int m = 0; m < 4; ++m) { if constexpr (F8) { dst##8[m].lo = *(const PG8_LAS bf16x8*)(lds + PG8_SA(b, h) + aoff + m * 2048); dst##8[m].hi = *(const PG8_LAS bf16x8*)(lds + PG8_SA(b, h) + aoff + m * 2048 + 1024); } else { _Pragma("unroll") for (int k = 0; k < 2; ++k) dst[m][k] = *(const PG8_LAS bf16x8*)(lds + PG8_SA(b, h) + aoff + m * 2048 + k * 1024); } } } while (0)
#define PG8_LDB(dst, b, h) do { _Pragma("unroll") for (int n = 0; n < 2; ++n) { if constexpr (F8) { dst##8[n].lo = *(const PG8_LAS bf16x8*)(lds + PG8_SB(b, h) + boff + n * 2048); dst##8[n].hi = *(const PG8_LAS bf16x8*)(lds + PG8_SB(b, h) + boff + n * 2048 + 1024); } else { _Pragma("unroll") for (int k = 0; k < 2; ++k) dst[n][k] = *(const PG8_LAS bf16x8*)(lds + PG8_SB(b, h) + boff + n * 2048 + k * 1024); } } } while (0)
#define PG8_MMA(ai, bj, At, Bt) do { __builtin_amdgcn_s_setprio(1); _Pragma("unroll") for (int m = 0; m < 4; ++m) _Pragma("unroll") for (int n = 0; n < 2; ++n) { \
        if constexpr (F8) { typedef int v8i_ __attribute__((ext_vector_type(8))); \
            acc[ai][bj][m][n] = __builtin_amdgcn_mfma_scale_f32_16x16x128_f8f6f4(__builtin_bit_cast(v8i_, Bt##8[n]), __builtin_bit_cast(v8i_, At##8[m]), acc[ai][bj][m][n], 0, 0, 0, 0x7f79, 1, 0x7f79); }     \
        else if constexpr (I8) { typedef int v4i_ __attribute__((ext_vector_type(4))); \
            _Pragma("unroll") for (int k = 0; k < 2; ++k) acc[ai][bj][m][n] = __builtin_bit_cast(f32x4, __builtin_amdgcn_mfma_i32_16x16x64_i8(__builtin_bit_cast(v4i_, Bt[n][k]), __builtin_bit_cast(v4i_, At[m][k]), __builtin_bit_cast(v4i_, acc[ai][bj][m][n]), 0, 0, 0)); } \
        else { _Pragma("unroll") for (int k = 0; k < 2; ++k) acc[ai][bj][m][n] = __builtin_amdgcn_mfma_f32_16x16x32_bf16(Bt[n][k], At[m][k], acc[ai][bj][m][n], 0, 0, 0); } } \
        __builtin_amdgcn_s_setprio(0); } while (0)
#define PG8_WAIT_V(n) asm volatile("s_waitcnt vmcnt(" #n ")" ::: "memory")
#define PG8_WAIT_L(n) asm volatile("s_waitcnt lgkmcnt(" #n ")" ::: "memory")
#define PG8_BAR __builtin_amdgcn_s_barrier()
#define PG8_SCHED __builtin_amdgcn_sched_barrier(0)
    Unit cur, nxt; int ui = 0;
    if (!S.next(0, cur)) return;
    f32x4 acc[2][2][4][2];
#pragma unroll
    for (int a = 0; a < 2; ++a)
#pragma unroll
        for (int b = 0; b < 2; ++b)
#pragma unroll
            for (int m = 0; m < 4; ++m)
#pragma unroll
                for (int n = 0; n < 2; ++n) acc[a][b][m][n] = (f32x4){0.f, 0.f, 0.f, 0.f};
    typedef short bf16x16 __attribute__((ext_vector_type(16)));
    bf16x16 At8[4], B08[2], B18[2]; bf16x8 At[4][2], B0[2][2], B1[2][2];
    const char* cA = (const char*)g.A + (size_t)cur.pm * tstep; const char* cB = (const char*)g.Bt + (size_t)cur.pn * tstep;
    S.a_ready(cur);
    if constexpr (SP2) {
        PG8_STAGE(PG8_SB(0, 0), cB, voffB); PG8_STAGE(PG8_SB(0, 1), cB + hstep, voffB); PG8_STAGE(PG8_SA(0, 0), cA, voffA); PG8_STAGE(PG8_SA(0, 1), cA + hstep, voffA);
        if (wr == 1) PG8_BAR;
        PG8_WAIT_V(2); PG8_BAR;
        PG8_STAGE(PG8_SB(1, 0), cB + kstep, voffB); PG8_STAGE(PG8_SA(1, 0), cA + kstep, voffA); PG8_STAGE(PG8_SB(1, 1), cB + hstep + kstep, voffB);
        PG8_WAIT_V(6); PG8_BAR;
    } else {
        PG8_STAGE(PG8_SB(0, 0), cB, voffB); PG8_STAGE(PG8_SA(0, 0), cA, voffA); PG8_STAGE(PG8_SB(0, 1), cB + hstep, voffB); PG8_STAGE(PG8_SA(0, 1), cA + hstep, voffA);
        if (wr == 1) PG8_BAR;
        PG8_WAIT_V(4); PG8_BAR;
        PG8_STAGE(PG8_SB(1, 0), cB + kstep, voffB); PG8_STAGE(PG8_SA(1, 0), cA + kstep, voffA); PG8_STAGE(PG8_SB(1, 1), cB + hstep + kstep, voffB);
        PG8_WAIT_V(6); PG8_BAR;
    }
    for (;;) {
        const bool has_next = S.next(ui + 1, nxt);
        const char* nA = has_next ? (const char*)g.A + (size_t)nxt.pm * tstep : cA; const char* nB = has_next ? (const char*)g.Bt + (size_t)nxt.pn * tstep : cB;
        for (int t = 0; t < nt; t += 2) {
            const bool last = (t == nt - 2);
            const char* a1 = cA + (size_t)(t + 1) * kstep;
            const char* a2 = last ? nA : cA + (size_t)(t + 2) * kstep; const char* b2 = last ? nB : cB + (size_t)(t + 2) * kstep;
            const char* a3 = a2 + kstep; const char* b3 = b2 + kstep;
            if (last && has_next) S.a_ready(nxt);
            if constexpr (SP2) {
            PG8_LDB(B0, 0, 0); PG8_LDB(B1, 0, 1); PG8_SCHED; PG8_LDA(At, 0, 0); PG8_STAGE(PG8_SA(1, 1), a1 + hstep, voffA);
            PG8_WAIT_V(8); PG8_WAIT_L(0); PG8_BAR; PG8_MMA(0, 0, At, B0); PG8_MMA(0, 1, At, B1); PG8_BAR; PG8_SCHED;
            PG8_LDA(At, 0, 1); PG8_STAGE(PG8_SB(0, 0), b2, voffB); PG8_STAGE(PG8_SB(0, 1), b2 + hstep, voffB); PG8_STAGE(PG8_SA(0, 0), a2, voffA);
            PG8_WAIT_V(8); PG8_WAIT_L(0); PG8_BAR; PG8_MMA(1, 0, At, B0); PG8_MMA(1, 1, At, B1); PG8_BAR; PG8_SCHED;
            PG8_LDB(B0, 1, 0); PG8_LDB(B1, 1, 1); PG8_SCHED; PG8_LDA(At, 1, 0); PG8_STAGE(PG8_SA(0, 1), a2 + hstep, voffA);
            PG8_WAIT_V(8); PG8_WAIT_L(0); PG8_BAR; PG8_MMA(0, 0, At, B0); PG8_MMA(0, 1, At, B1); PG8_BAR; PG8_SCHED;
            PG8_LDA(At, 1, 1); PG8_STAGE(PG8_SB(1, 0), b3, voffB); PG8_STAGE(PG8_SB(1, 1), b3 + hstep, voffB); PG8_STAGE(PG8_SA(1, 0), a3, voffA);
            PG8_WAIT_V(8); PG8_WAIT_L(0); PG8_BAR; PG8_MMA(1, 0, At, B0); PG8_MMA(1, 1, At, B1); PG8_BAR; PG8_SCHED;
            } else {
            PG8_LDB(B0, 0, 0); PG8_SCHED; PG8_LDA(At, 0, 0); PG8_STAGE(PG8_SA(1, 1), a1 + hstep, voffA);
            PG8_WAIT_L(8); PG8_BAR; PG8_WAIT_L(0); PG8_MMA(0, 0, At, B0); PG8_BAR; PG8_SCHED;
            PG8_LDB(B1, 0, 1); PG8_STAGE(PG8_SB(0, 0), b2, voffB);
            PG8_BAR; PG8_WAIT_L(0); PG8_MMA(0, 1, At, B1); PG8_BAR;
            PG8_LDA(At, 0, 1); PG8_STAGE(PG8_SA(0, 0), a2, voffA);
            PG8_BAR; PG8_WAIT_L(0); PG8_MMA(1, 0, At, B0); PG8_BAR; PG8_SCHED;
            PG8_STAGE(PG8_SB(0, 1), b2 + hstep, voffB);
            PG8_WAIT_V(6); PG8_BAR; PG8_MMA(1, 1, At, B1); PG8_BAR;
            PG8_LDB(B0, 1, 0); PG8_SCHED; PG8_LDA(At, 1, 0); PG8_STAGE(PG8_SA(0, 1), a2 + hstep, voffA);
            PG8_WAIT_L(8); PG8_BAR; PG8_WAIT_L(0); PG8_MMA(0, 0, At, B0); PG8_BAR; PG8_SCHED;
            PG8_LDB(B1, 1, 1); PG8_STAGE(PG8_SB(1, 0), b3, voffB);
            PG8_BAR; PG8_WAIT_L(0); PG8_MMA(0, 1, At, B1); PG8_BAR;
            PG8_LDA(At, 1, 1); PG8_STAGE(PG8_SA(1, 0), a3, voffA);
            PG8_BAR; PG8_WAIT_L(0); PG8_MMA(1, 0, At, B0); PG8_BAR; PG8_SCHED;
            PG8_STAGE(PG8_SB(1, 1), b3 + hstep, voffB);
            PG8_WAIT_V(6); PG8_BAR; PG8_MMA(1, 1, At, B1); PG8_BAR;
            }
        }
        if constexpr (ALIGN_EPI) { if (wr == 0) PG8_BAR; }
        if constexpr (!Epi::AFTER_DRAIN) { int ln_e; asm volatile("v_mbcnt_lo_u32_b32 %0, -1, 0\n\tv_mbcnt_hi_u32_b32 %0, -1, %0" : "=v"(ln_e)); const int fr_e = ln_e & 15, fq_e = ln_e >> 4;
            E(acc, cur, wr, wc, fr_e, fq_e); S.done(cur); }
        if (!has_next) break;
#pragma unroll
        for (int a = 0; a < 2; ++a)
#pragma unroll
            for (int b = 0; b < 2; ++b)
#pragma unroll
                for (int m = 0; m < 4; ++m)
#pragma unroll
                    for (int n = 0; n < 2; ++n) acc[a][b][m][n] = (f32x4){0.f, 0.f, 0.f, 0.f};
        cur = nxt; cA = nA; cB = nB; ++ui;
        if constexpr (ALIGN_EPI) { if (wr == 1) PG8_BAR; }
    }
    PG8_WAIT_V(0);
    if constexpr (!ALIGN_EPI) { if (wr == 0) PG8_BAR; }
    PG8_BAR;
    if constexpr (Epi::AFTER_DRAIN) { E.fused(acc, cur, wr, wc, fr, fq, lds, wid, lane); S.done(cur); }
#undef PG8_SA
#undef PG8_SB
#undef PG8_STAGE
#undef PG8_LDA
#undef PG8_LDB
#undef PG8_MMA
#undef PG8_WAIT_V
#undef PG8_WAIT_L
#undef PG8_BAR
#undef PG8_SCHED
}
}
#define GAS __attribute__((address_space(1)))
#define LAS __attribute__((address_space(3)))
typedef unsigned short bf16;
typedef unsigned v4u __attribute__((ext_vector_type(4)));
typedef float f32x4 __attribute__((ext_vector_type(4)));
typedef short bf16x8 __attribute__((ext_vector_type(8)));
typedef GAS unsigned gu32;
typedef GAS unsigned long long gu64;
#define RLX_AGENT __ATOMIC_RELAXED, __HIP_MEMORY_SCOPE_AGENT
#define LDS_WAIT() asm volatile("s_waitcnt lgkmcnt(0)" ::: "memory")
#define VM_WAIT() asm volatile("s_waitcnt vmcnt(0)" ::: "memory")
__device__ __forceinline__ unsigned long long rt() { return __builtin_amdgcn_s_memrealtime(); }
__device__ __forceinline__ unsigned f2bf(float f) { unsigned u = __builtin_bit_cast(unsigned, f); return (u + 0x7fffu + ((u >> 16) & 1u)) >> 16; }
__device__ __forceinline__ unsigned pk2(float lo, float hi) { return f2bf(lo) | (f2bf(hi) << 16); }

#define XB_TMO      128
#define XB_XCNT(j)  (256  + 64 * (j))
#define XB_XSUB(j)  (1280 + 64 * (j))
#define XB_XGEN(j)  (2304 + 64 * (j))
#define XB_TOP      3328
#define XB_TOPGEN   3392
#define XCD_BAR_WORDS 3456
#define XB_SPIN_CAP (1u << 18)

__device__ __forceinline__ unsigned xb_ld(unsigned* p)              { return __hip_atomic_load(p, __ATOMIC_RELAXED, __HIP_MEMORY_SCOPE_AGENT); }
__device__ __forceinline__ unsigned xb_add(unsigned* p, unsigned v) { return __hip_atomic_fetch_add(p, v, __ATOMIC_RELAXED, __HIP_MEMORY_SCOPE_AGENT); }
__device__ __forceinline__ unsigned xb_xcc_id() { return (unsigned)__builtin_amdgcn_s_getreg((3 << 11) | 20) & 0xFu; }
#define XB_SPIN(cond, bar) do { unsigned _sp = 0; while (cond) { __builtin_amdgcn_s_sleep(1); \
    if ((++_sp & 255u) == 0u) { if (xb_ld(&(bar)[XB_TMO])) break; if (_sp > XB_SPIN_CAP) { atomicAdd(&(bar)[XB_TMO], 1u); break; } } } } while (0)

struct XcdBarrier {
    unsigned* bar; unsigned x; bool wave0;
    volatile LAS unsigned* st;
};

__device__ __forceinline__ XcdBarrier xcd_barrier_post(unsigned* bar, volatile LAS unsigned* st) {
    XcdBarrier b; b.bar = bar; b.x = xb_xcc_id(); b.st = st;
    if (threadIdx.x == 0) (void)xb_add(&bar[XB_XCNT(b.x)], 1u);
    return b;
}
__device__ __forceinline__ void xcd_barrier_complete(unsigned* bar, unsigned x, unsigned& nloc, unsigned& nx) {
    const unsigned G = gridDim.x * gridDim.y * gridDim.z;
    unsigned sum, cnt, mine, sp = 0u;
    for (;;) {
        sum = 0u; cnt = 0u; mine = 0u;
#pragma unroll
        for (unsigned j = 0; j < 16; ++j) { const unsigned c = xb_ld(&bar[XB_XCNT(j)]); sum += c; cnt += (c > 0u) ? 1u : 0u; mine = (j == x) ? c : mine; }
        if (sum == G) break;
        __builtin_amdgcn_s_sleep(1);
        if ((++sp & 255u) == 0u) { if (xb_ld(&bar[XB_TMO])) break; if (sp > XB_SPIN_CAP) { atomicAdd(&bar[XB_TMO], 1u); break; } }
    }
    nloc = mine > 0u ? mine : 1u; nx = cnt > 0u ? cnt : 1u;
}

__device__ __forceinline__ void xcd_barrier(const XcdBarrier& b) {
    asm volatile("s_waitcnt vmcnt(0)" ::: "memory");
    __syncthreads();
    if (b.wave0 && __builtin_amdgcn_mbcnt_hi(~0u, __builtin_amdgcn_mbcnt_lo(~0u, 0u)) == 0u) {
        unsigned* bar = b.bar;
        __builtin_amdgcn_s_waitcnt(0);
        unsigned nloc = b.st[0], nx = b.st[1];
        if (nloc == 0u) { xcd_barrier_complete(bar, b.x, nloc, nx); b.st[0] = nloc; b.st[1] = nx; }
        const unsigned old = xb_add(&bar[XB_XSUB(b.x)], 1u);
        const unsigned gen = old / nloc;
        if (old + 1u == (gen + 1u) * nloc) {
            __builtin_amdgcn_fence(__ATOMIC_RELEASE, "agent");
            asm volatile("s_waitcnt vmcnt(0)" ::: "memory");
            const unsigned og = xb_add(&bar[XB_TOP], 1u);
            const unsigned tg = og / nx;
            if (og + 1u == (tg + 1u) * nx) xb_add(&bar[XB_TOPGEN], 1u);
            else XB_SPIN(xb_ld(&bar[XB_TOPGEN]) == tg, bar);
            __builtin_amdgcn_fence(__ATOMIC_ACQUIRE, "agent");
            xb_add(&bar[XB_XGEN(b.x)], 1u);
            asm volatile("s_waitcnt vmcnt(0)" ::: "memory");
        } else {
            XB_SPIN(xb_ld(&bar[XB_XGEN(b.x)]) == gen, bar);
            __builtin_amdgcn_fence(__ATOMIC_ACQUIRE, "agent");
            asm volatile("s_waitcnt vmcnt(0)" ::: "memory");
        }
    }
    __syncthreads();
}

constexpr int NWAVES = 8, NTHREADS = NWAVES * 64;
constexpr int BATCH = 8, SEQ = 2048, T = BATCH * SEQ, D = 2048;
constexpr int EV_N = 7200, EV_NP = 7424, OD_N = 7616, OD_NP = 7680, PROJ_LD = 7680;
constexpr float EPS = 1e-6f;
constexpr int EC_GQ = 0, EC_GK = 512, EC_GV = 1024, EC_GZ = 2048, EC_GLR = 3072, EC_BQ = 3088, EC_BK = 4112, EC_BV = 5136, EC_BZ = 6160, EC_BA = 7184, EC_BB = 7192;
constexpr int OC_HQ = 0, OC_HF = 1024, OC_HI = 2048, OC_HG = 3072, OC_RW = 4096;
constexpr int RW_R = 0, RW_K = 1024, RW_V = 2048, RW_WL = 3072, RW_AL = 3168, RW_GL = 3264;
constexpr int LORA_K = 512, LORA_N = 3072;
enum { I_X = 0, I_P, I_EV_WIN, I_GK_W2, I_GK_B, I_GLA_NORM, I_GDN_CONV, I_GDN_ALOG, I_GDN_DTB, I_GDN_NORM, I_EV_WOUT, I_OD_WIN, I_LB, I_HG_NORM,
       I_MU, I_W0, I_W2, I_A0, I_A2, I_G2, I_KK, I_KA, I_RK, I_LNW, I_LNB, I_OD_WOUT, I_NMIX, I_NFFN, I_NPLE, I_PEER_WQ, I_PEER_SK, I_PEER_U, I_PEER_V,
       I_PLE_WP, I_PLE_WG, I_NFINAL, N_IN };

constexpr size_t MiB = 1u << 20;
constexpr size_t WS_CTL = 0, CTL_ZERO_BYTES = 1 * MiB, WS_SU = 256 * 1024, WS_CMB = 512 * 1024, WS_SA = 576 * 1024;
constexpr size_t WS_WEV_IN = 1 * MiB, WS_WEV_OUT = 30 * MiB, WS_WOD_IN = 38 * MiB, WS_WOD_OUT = 68 * MiB, WS_WPEER = 76 * MiB, WS_WGATE = 92 * MiB, WS_WPROJ = 108 * MiB,
                 WS_WLORA = 110 * MiB, WS_PBF = 113 * MiB, WS_TABU = 129 * MiB, WS_TABV = 193 * MiB, WS_ACTA = 257 * MiB, WS_ACTB = 321 * MiB, WS_PROJ = 385 * MiB, WS_SC = 385 * MiB,
                 WS_O = 625 * MiB, WS_H1 = 689 * MiB, WS_PP = 753 * MiB, WS_LA = 817 * MiB, WS_LO = 833 * MiB, WS_RSP = 929 * MiB, WS_STATE = 937 * MiB, WS_RS3 = 945 * MiB, WS_END = 946 * MiB;
static_assert(WS_WEV_IN + (size_t)EV_NP * D * 2 <= WS_WEV_OUT && WS_WOD_IN + (size_t)OD_NP * D * 2 <= WS_WOD_OUT && WS_PROJ + (size_t)T * PROJ_LD * 2 <= WS_O, "ws map");
constexpr int CW_BAR = 4096;
enum { RS_FFN0 = 0, RS_MIX1 = 1, RS_FFN1 = 2, RS_FINAL = 3 };
constexpr int RING_OFF = 0, RING_BYTES = 131072;
constexpr int LDSCTL_OFF = RING_BYTES, MISC_OFF = LDSCTL_OFF + 320;
constexpr int LDS_BYTES = 147456;

struct Args { const float* in[N_IN]; float* out; unsigned char* ws; int ph_lo, ph_hi; };
struct Frame {
    LAS unsigned char* lds; volatile LAS unsigned* MISC; gu32* ctl;
    int tid, lane, wave, vcu, G;
};
__device__ __forceinline__ float wave_sum(float v) {
#pragma unroll
    for (int o = 1; o < 64; o <<= 1) v += __shfl_xor(v, o);
    return v;
}
__device__ __forceinline__ float half_sum32(float v) {
#pragma unroll
    for (int o = 1; o < 32; o <<= 1) v += __shfl_xor(v, o);
    return v;
}
#define DPP_ADD(v, ctrl) (v) += __builtin_bit_cast(float, __builtin_amdgcn_update_dpp(0, __builtin_bit_cast(int, (v)), (ctrl), 0xF, 0xF, false))
__device__ __forceinline__ float row_sum16(float v) {
    DPP_ADD(v, 0x128); DPP_ADD(v, 0x124); DPP_ADD(v, 0x122); DPP_ADD(v, 0x121);
    return v;
}
__device__ __forceinline__ void row_sum16_x4(float& a, float& b, float& c, float& d) {
    asm("s_nop 1\n\t"
        "v_add_f32_dpp %0, %0, %0 row_ror:8 row_mask:0xf bank_mask:0xf\n\tv_add_f32_dpp %1, %1, %1 row_ror:8 row_mask:0xf bank_mask:0xf\n\t"
        "v_add_f32_dpp %2, %2, %2 row_ror:8 row_mask:0xf bank_mask:0xf\n\tv_add_f32_dpp %3, %3, %3 row_ror:8 row_mask:0xf bank_mask:0xf\n\t"
        "v_add_f32_dpp %0, %0, %0 row_ror:4 row_mask:0xf bank_mask:0xf\n\tv_add_f32_dpp %1, %1, %1 row_ror:4 row_mask:0xf bank_mask:0xf\n\t"
        "v_add_f32_dpp %2, %2, %2 row_ror:4 row_mask:0xf bank_mask:0xf\n\tv_add_f32_dpp %3, %3, %3 row_ror:4 row_mask:0xf bank_mask:0xf\n\t"
        "v_add_f32_dpp %0, %0, %0 row_ror:2 row_mask:0xf bank_mask:0xf\n\tv_add_f32_dpp %1, %1, %1 row_ror:2 row_mask:0xf bank_mask:0xf\n\t"
        "v_add_f32_dpp %2, %2, %2 row_ror:2 row_mask:0xf bank_mask:0xf\n\tv_add_f32_dpp %3, %3, %3 row_ror:2 row_mask:0xf bank_mask:0xf\n\t"
        "v_add_f32_dpp %0, %0, %0 row_ror:1 row_mask:0xf bank_mask:0xf\n\tv_add_f32_dpp %1, %1, %1 row_ror:1 row_mask:0xf bank_mask:0xf\n\t"
        "v_add_f32_dpp %2, %2, %2 row_ror:1 row_mask:0xf bank_mask:0xf\n\tv_add_f32_dpp %3, %3, %3 row_ror:1 row_mask:0xf bank_mask:0xf\n\t"
        "s_nop 1"
        : "+v"(a), "+v"(b), "+v"(c), "+v"(d));
}
__device__ __forceinline__ void row_sum16_x2(float& a, float& b) {
    asm("s_nop 1\n\t"
        "v_add_f32_dpp %0, %0, %0 row_ror:8 row_mask:0xf bank_mask:0xf\n\tv_add_f32_dpp %1, %1, %1 row_ror:8 row_mask:0xf bank_mask:0xf\n\ts_nop 1\n\t"
        "v_add_f32_dpp %0, %0, %0 row_ror:4 row_mask:0xf bank_mask:0xf\n\tv_add_f32_dpp %1, %1, %1 row_ror:4 row_mask:0xf bank_mask:0xf\n\ts_nop 1\n\t"
        "v_add_f32_dpp %0, %0, %0 row_ror:2 row_mask:0xf bank_mask:0xf\n\tv_add_f32_dpp %1, %1, %1 row_ror:2 row_mask:0xf bank_mask:0xf\n\ts_nop 1\n\t"
        "v_add_f32_dpp %0, %0, %0 row_ror:1 row_mask:0xf bank_mask:0xf\n\tv_add_f32_dpp %1, %1, %1 row_ror:1 row_mask:0xf bank_mask:0xf\n\t"
        "s_nop 1"
        : "+v"(a), "+v"(b));
}
typedef unsigned u32x2 __attribute__((ext_vector_type(2)));
__device__ __forceinline__ void st_wt16(void* p, v4u v) { asm volatile("global_store_dwordx4 %0, %1, off sc1\n\ts_nop 1" :: "v"(p), "v"(v) : "memory"); }
__device__ __forceinline__ void st_wt8(void* p, u32x2 v) { asm volatile("global_store_dwordx2 %0, %1, off sc1\n\ts_nop 1" :: "v"(p), "v"(v) : "memory"); }
#define LBAR() do { asm volatile("s_waitcnt lgkmcnt(0)" ::: "memory"); __builtin_amdgcn_s_barrier(); asm volatile("" ::: "memory"); } while (0)
typedef float f32x2 __attribute__((ext_vector_type(2)));
typedef __bf16 hwbf16x2_t __attribute__((ext_vector_type(2)));
__device__ __forceinline__ unsigned hw_pk2(float lo, float hi) { const f32x2 v = {lo, hi}; return __builtin_bit_cast(unsigned, __builtin_convertvector(v, hwbf16x2_t)); }
__device__ __forceinline__ bf16 hw_bf(float x) { return (bf16)hw_pk2(x, 0.f); }
__device__ __forceinline__ float bf_lo(unsigned w) { return __uint_as_float(w << 16); }
__device__ __forceinline__ float bf_hi(unsigned w) { return __uint_as_float(w & 0xffff0000u); }
__device__ __forceinline__ float sigmoidf_(float x) { return __builtin_amdgcn_rcpf(1.0f + __expf(-x)); }
__device__ __forceinline__ float siluf_(float x) { return x * __builtin_amdgcn_rcpf(1.0f + __expf(-x)); }
__device__ __forceinline__ float softplusf_(float x) { return fmaxf(x, 0.f) + log1pf(__expf(-fabsf(x))); }
__device__ __forceinline__ float logsigmoidf_(float x) { return fminf(x, 0.f) - log1pf(__expf(-fabsf(x))); }

struct EpiBf16S {
    static constexpr bool PERM = true, AFTER_DRAIN = false;
    bf16* O; int ldc; const float* rowss;
    __device__ __forceinline__ void operator()(const pg8::f32x4 (&acc)[2][2][4][2], const pg8::Unit& u, int wr, int wc, int fr, int fq) const {
        const int row0 = u.pm * 256 + wr * 64 + fr, col0 = u.pn * 256 + wc * 32 + 8 * fq;
#pragma unroll
        for (int ai = 0; ai < 2; ++ai)
#pragma unroll
            for (int m = 0; m < 4; ++m) {
                const int row = row0 + ai * 128 + m * 16;
                float sc = 1.f;
                if (rowss) { const pg8::f32x4* rp = (const pg8::f32x4*)(rowss + (size_t)row * 32 + 8 * fq); const pg8::f32x4 p0 = rp[0], p1 = rp[1];
                    float s = ((p0[0] + p0[1]) + (p0[2] + p0[3])) + ((p1[0] + p1[1]) + (p1[2] + p1[3])); s += __shfl_xor(s, 16); s += __shfl_xor(s, 32);
                    sc = __builtin_amdgcn_rsqf(s * (1.0f / D) + EPS); }
                bf16* rowp = O + (size_t)row * ldc + col0;
#pragma unroll
                for (int bj = 0; bj < 2; ++bj) { const pg8::f32x4 v0 = acc[ai][bj][m][0] * sc, v1 = acc[ai][bj][m][1] * sc;
                    pg8::u32x4 w; w.x = pg8::cvt_pk_bf16(v0[0], v0[1]); w.y = pg8::cvt_pk_bf16(v0[2], v0[3]); w.z = pg8::cvt_pk_bf16(v1[0], v1[1]); w.w = pg8::cvt_pk_bf16(v1[2], v1[3]);
                    *(pg8::u32x4*)(rowp + bj * 128) = w; } }
    }
};
struct EpiI8S {
    static constexpr bool PERM = true, AFTER_DRAIN = false;
    bf16* O; int ldc; const float* sa; const float* cb;
    __device__ __forceinline__ void operator()(const pg8::f32x4 (&acc)[2][2][4][2], const pg8::Unit& u, int wr, int wc, int fr, int fq) const {
        const int row0 = u.pm * 256 + wr * 64 + fr, col0 = u.pn * 256 + wc * 32 + 8 * fq;
        pg8::f32x4 cs[2][2];
#pragma unroll
        for (int bj = 0; bj < 2; ++bj) { cs[bj][0] = *(const pg8::f32x4*)(cb + col0 + bj * 128); cs[bj][1] = *(const pg8::f32x4*)(cb + col0 + bj * 128 + 4); }
#pragma unroll
        for (int ai = 0; ai < 2; ++ai)
#pragma unroll
            for (int m = 0; m < 4; ++m) {
                const int row = row0 + ai * 128 + m * 16;
                const float sc = sa[row];
                bf16* rowp = O + (size_t)row * ldc + col0;
#pragma unroll
                for (int bj = 0; bj < 2; ++bj) { pg8::f32x4 v0, v1;
#pragma unroll
                    for (int e = 0; e < 4; ++e) { v0[e] = (float)__float_as_int(acc[ai][bj][m][0][e]) * sc * cs[bj][0][e]; v1[e] = (float)__float_as_int(acc[ai][bj][m][1][e]) * sc * cs[bj][1][e]; }
                    pg8::u32x4 w; w.x = pg8::cvt_pk_bf16(v0[0], v0[1]); w.y = pg8::cvt_pk_bf16(v0[2], v0[3]); w.z = pg8::cvt_pk_bf16(v1[0], v1[1]); w.w = pg8::cvt_pk_bf16(v1[2], v1[3]);
                    *(pg8::u32x4*)(rowp + bj * 128) = w; } }
    }
};
template <bool GATE, bool HIN_F32, bool I8 = false> struct EpiResid {
    static constexpr bool PERM = false, AFTER_DRAIN = false;
    const void* hin; bf16* hout; float* rowss; const bf16* pp; const float* rs3; unsigned char* h8; const float* sa; const float* cb;
    __device__ __forceinline__ void operator()(const pg8::f32x4 (&acc)[2][2][4][2], const pg8::Unit& u, int wr, int wc, int fr, int fq) const {
        const int row0 = u.pm * 256 + wr * 64 + fr, col0 = u.pn * 256 + wc * 32 + 4 * fq;
        pg8::f32x4 cs[2][2];
        if constexpr (I8) {
#pragma unroll
            for (int bj = 0; bj < 2; ++bj)
#pragma unroll
                for (int n = 0; n < 2; ++n) cs[bj][n] = *(const pg8::f32x4*)(cb + col0 + bj * 128 + n * 16); }
        constexpr int MG = HIN_F32 ? 2 : 4;
#pragma unroll
        for (int ai = 0; ai < 2; ++ai)
#pragma unroll
            for (int m0 = 0; m0 < 4; m0 += MG) {
                pg8::f32x4 hf[MG][2][2]; pg8::u32x2 hb[MG][2][2], pw[MG][2][2]; float rsc[MG];
#pragma unroll
                for (int mm = 0; mm < MG; ++mm) { const int row = row0 + ai * 128 + (m0 + mm) * 16; const size_t off = (size_t)row * D + col0; rsc[mm] = GATE ? rs3[row] : (I8 ? sa[row] : 1.f);
#pragma unroll
                    for (int bj = 0; bj < 2; ++bj)
#pragma unroll
                        for (int n = 0; n < 2; ++n) { const size_t o = off + bj * 128 + n * 16;
                            if (HIN_F32) hf[mm][bj][n] = *(const pg8::f32x4*)((const float*)hin + o); else hb[mm][bj][n] = *(const pg8::u32x2*)((const bf16*)hin + o);
                            if (GATE) pw[mm][bj][n] = *(const pg8::u32x2*)(pp + o); } }
#pragma unroll
                for (int mm = 0; mm < MG; ++mm) { const int m = m0 + mm; const int row = row0 + ai * 128 + m * 16; const size_t off = (size_t)row * D + col0; float ss = 0.f;
#pragma unroll
                    for (int bj = 0; bj < 2; ++bj)
#pragma unroll
                        for (int n = 0; n < 2; ++n) { const size_t o = off + bj * 128 + n * 16;
                            pg8::f32x4 hv;
                            if (HIN_F32) hv = hf[mm][bj][n];
                            else { const pg8::u32x2 hw = hb[mm][bj][n]; hv[0] = bf_lo(hw.x); hv[1] = bf_hi(hw.x); hv[2] = bf_lo(hw.y); hv[3] = bf_hi(hw.y); }
                            pg8::f32x4 a = acc[ai][bj][m][n];
                            if constexpr (I8 && !GATE) { const float sr_ = rsc[mm];
#pragma unroll
                                for (int e = 0; e < 4; ++e) a[e] = (float)__float_as_int(a[e]) * sr_ * cs[bj][n][e]; }
                            if (GATE) { const pg8::u32x2 p2 = pw[mm][bj][n]; const float rs_ = rsc[mm];
                                a[0] = sigmoidf_(a[0] * rs_) * bf_lo(p2.x); a[1] = sigmoidf_(a[1] * rs_) * bf_hi(p2.x); a[2] = sigmoidf_(a[2] * rs_) * bf_lo(p2.y); a[3] = sigmoidf_(a[3] * rs_) * bf_hi(p2.y); }
                            hv = hv + a;
                            pg8::u32x2 w; w.x = hw_pk2(hv[0], hv[1]); w.y = hw_pk2(hv[2], hv[3]); *(pg8::u32x2*)(hout + o) = w;
                            if (h8) { int x8 = __builtin_amdgcn_cvt_pk_fp8_f32(hv[0], hv[1], 0, false); x8 = __builtin_amdgcn_cvt_pk_fp8_f32(hv[2], hv[3], x8, true); *(unsigned*)(h8 + o) = (unsigned)x8; }
                            const float q0 = bf_lo(w.x), q1 = bf_hi(w.x), q2 = bf_lo(w.y), q3 = bf_hi(w.y);
                            ss += (q0 * q0 + q1 * q1) + (q2 * q2 + q3 * q3); }
                    ss += __shfl_xor(ss, 16); ss += __shfl_xor(ss, 32);
                    if (fq == 0) rowss[(size_t)row * 32 + u.pn * 4 + wc] = ss; }
                asm volatile("" ::: "memory"); }
    }
};


__device__ __forceinline__ void p0_transpose_item(const float* W, int K, int N, bf16* WT, LAS float* scr, int item, int lane, const float* kgain = nullptr) {
    const int nblk = N / 32, kb = item / nblk, nb = item % nblk, k0 = 64 * kb, n0 = 32 * nb;
    { const GAS float* Wg = (const GAS float*)W + (size_t)(k0 + (lane >> 5)) * N + n0 + (lane & 31); float v[32];
#pragma unroll
      for (int i = 0; i < 32; ++i) v[i] = Wg[(size_t)(2 * i) * N];
#pragma unroll
      for (int i = 0; i < 32; ++i) scr[(2 * i + (lane >> 5)) * 33 + (lane & 31)] = v[i]; }
    LDS_WAIT(); asm volatile("" ::: "memory");
    const int c = lane & 7;
#pragma unroll
    for (int j = 0; j < 4; ++j) { const int n = (lane >> 3) + 8 * j; const LAS float* s = scr + (8 * c) * 33 + n;
        f32x4 g0 = {1.f, 1.f, 1.f, 1.f}, g1 = g0; if (kgain) { g0 = *(const GAS f32x4*)(kgain + k0 + 8 * c); g1 = *(const GAS f32x4*)(kgain + k0 + 8 * c + 4); }
        v4u o; o.x = pk2(s[0 * 33] * g0[0], s[1 * 33] * g0[1]); o.y = pk2(s[2 * 33] * g0[2], s[3 * 33] * g0[3]); o.z = pk2(s[4 * 33] * g1[0], s[5 * 33] * g1[1]); o.w = pk2(s[6 * 33] * g1[2], s[7 * 33] * g1[3]);
        *(GAS v4u*)(WT + (size_t)(n0 + n) * K + k0 + 8 * c) = o; }
    LDS_WAIT(); asm volatile("" ::: "memory");
}
__device__ __forceinline__ void p0_transpose_item_i8(const float* W, int K, int N, unsigned char* WT, LAS float* scr, int item, int lane, const float* cm) {
    const int nblk = N / 32, kb = item / nblk, nb = item % nblk, k0 = 64 * kb, n0 = 32 * nb;
    { const GAS float* Wg = (const GAS float*)W + (size_t)(k0 + (lane >> 5)) * N + n0 + (lane & 31); float v[32];
#pragma unroll
      for (int i = 0; i < 32; ++i) v[i] = Wg[(size_t)(2 * i) * N];
#pragma unroll
      for (int i = 0; i < 32; ++i) scr[(2 * i + (lane >> 5)) * 33 + (lane & 31)] = v[i]; }
    LDS_WAIT(); asm volatile("" ::: "memory");
    const int c = lane & 7;
#pragma unroll
    for (int j = 0; j < 4; ++j) { const int n = (lane >> 3) + 8 * j; const LAS float* s = scr + (8 * c) * 33 + n;
        const float mx = __uint_as_float(__hip_atomic_load((const unsigned*)cm + n0 + n, __ATOMIC_RELAXED, __HIP_MEMORY_SCOPE_AGENT)), inv = mx > 0.f ? 127.0f / mx : 0.f; unsigned w0 = 0, w1 = 0;
#pragma unroll
        for (int e = 0; e < 4; ++e) { w0 |= (__float_as_uint(__builtin_fmaf(s[e * 33], inv, 12582912.0f)) & 255u) << (8 * e); w1 |= (__float_as_uint(__builtin_fmaf(s[(4 + e) * 33], inv, 12582912.0f)) & 255u) << (8 * e); }
        u32x2 o; o.x = w0; o.y = w1;
        *(GAS u32x2*)(WT + (size_t)(n0 + n) * K + k0 + 8 * c) = o; }
    LDS_WAIT(); asm volatile("" ::: "memory");
}
__device__ __forceinline__ void colmax_item(const float* W, int K, int N, float* cm, int item, int lane) {
    const int ngrp = (N + 255) / 256, kb = item / ngrp, cg_ = item % ngrp, col = 256 * cg_ + 4 * lane;
    if (col >= N) return;
    const GAS f32x4* p = (const GAS f32x4*)((const GAS float*)W + (size_t)(64 * kb) * N + col); f32x4 m = {0.f, 0.f, 0.f, 0.f};
#pragma unroll 16
    for (int r = 0; r < 64; ++r) { const f32x4 v = *(const GAS f32x4*)((const GAS float*)p + (size_t)r * N);
#pragma unroll
        for (int e = 0; e < 4; ++e) m[e] = fmaxf(m[e], fabsf(v[e])); }
#pragma unroll
    for (int e = 0; e < 4; ++e) __hip_atomic_fetch_max((unsigned*)cm + col + e, __float_as_uint(m[e]), __ATOMIC_RELAXED, __HIP_MEMORY_SCOPE_AGENT);
}
__device__ __forceinline__ void p0_transpose_item_f8(const float* W, int K, int N, unsigned char* WT, LAS float* scr, int item, int lane, const float* kgain = nullptr) {
    const int nblk = N / 32, kb = item / nblk, nb = item % nblk, k0 = 64 * kb, n0 = 32 * nb;
    { const GAS float* Wg = (const GAS float*)W + (size_t)(k0 + (lane >> 5)) * N + n0 + (lane & 31); float v[32];
#pragma unroll
      for (int i = 0; i < 32; ++i) v[i] = Wg[(size_t)(2 * i) * N];
#pragma unroll
      for (int i = 0; i < 32; ++i) scr[(2 * i + (lane >> 5)) * 33 + (lane & 31)] = v[i]; }
    LDS_WAIT(); asm volatile("" ::: "memory");
    const int c = lane & 7;
#pragma unroll
    for (int j = 0; j < 4; ++j) { const int n = (lane >> 3) + 8 * j; const LAS float* s = scr + (8 * c) * 33 + n;
        f32x4 g0 = {64.f, 64.f, 64.f, 64.f}, g1 = g0; if (kgain) { g0 = g0 * *(const GAS f32x4*)(kgain + k0 + 8 * c); g1 = g1 * *(const GAS f32x4*)(kgain + k0 + 8 * c + 4); }
        int x0 = __builtin_amdgcn_cvt_pk_fp8_f32(s[0 * 33] * g0[0], s[1 * 33] * g0[1], 0, false); x0 = __builtin_amdgcn_cvt_pk_fp8_f32(s[2 * 33] * g0[2], s[3 * 33] * g0[3], x0, true);
        int x1 = __builtin_amdgcn_cvt_pk_fp8_f32(s[4 * 33] * g1[0], s[5 * 33] * g1[1], 0, false); x1 = __builtin_amdgcn_cvt_pk_fp8_f32(s[6 * 33] * g1[2], s[7 * 33] * g1[3], x1, true);
        u32x2 o; o.x = (unsigned)x0; o.y = (unsigned)x1;
        *(GAS u32x2*)(WT + (size_t)(n0 + n) * K + k0 + 8 * c) = o; }
    LDS_WAIT(); asm volatile("" ::: "memory");
}
__device__ __forceinline__ void cvt_f32_bf16(const float* src, bf16* dst, size_t n, int gtid, int gthreads) {
    const size_t n8 = n / 8;
    for (size_t i = gtid; i < n8; i += gthreads) {
        const f32x4 a = *(const GAS f32x4*)(src + i * 8), b = *(const GAS f32x4*)(src + i * 8 + 4);
        v4u o; o.x = pk2(a[0], a[1]); o.y = pk2(a[2], a[3]); o.z = pk2(b[0], b[1]); o.w = pk2(b[2], b[3]);
        *(GAS v4u*)(dst + i * 8) = o; }
}
__device__ __forceinline__ void cvt_f32_fp8(const float* src, unsigned char* dst, size_t n, float scale, int gtid, int gthreads, const float* cgain = nullptr) {
    const size_t n16 = n / 16;
    for (size_t i = gtid; i < n16; i += gthreads) { v4u o; unsigned w[4];
#pragma unroll
        for (int q = 0; q < 4; ++q) { f32x4 a = *(const GAS f32x4*)(src + i * 16 + 4 * q) * scale; if (cgain) a = a * *(const GAS f32x4*)(cgain + ((i * 16 + 4 * q) & (D - 1)));
            int x = __builtin_amdgcn_cvt_pk_fp8_f32(a[0], a[1], 0, false); x = __builtin_amdgcn_cvt_pk_fp8_f32(a[2], a[3], x, true); w[q] = (unsigned)x; }
        o.x = w[0]; o.y = w[1]; o.z = w[2]; o.w = w[3];
        *(GAS v4u*)(dst + i * 16) = o; }
}
__device__ __forceinline__ void cvt_rows_i8(const float* src, unsigned char* dst, float* SU, int rows, int gw, int NGW, int lane, const float* cgain) {
    for (int r = gw; r < rows; r += NGW) {
        f32x4 a[8]; float mx = 0.f;
#pragma unroll
        for (int i = 0; i < 8; ++i) { a[i] = *(const GAS f32x4*)(src + (size_t)r * D + 256 * i + 4 * lane); if (cgain) a[i] = a[i] * *(const GAS f32x4*)(cgain + 256 * i + 4 * lane);
            mx = fmaxf(mx, fmaxf(fmaxf(fabsf(a[i][0]), fabsf(a[i][1])), fmaxf(fabsf(a[i][2]), fabsf(a[i][3])))); }
#pragma unroll
        for (int o = 1; o < 64; o <<= 1) mx = fmaxf(mx, __shfl_xor(mx, o));
        const float inv = mx > 0.f ? 127.0f / mx : 0.f;
#pragma unroll
        for (int i = 0; i < 8; ++i) { unsigned w = 0;
#pragma unroll
            for (int e = 0; e < 4; ++e) w |= (__float_as_uint(__builtin_fmaf(a[i][e], inv, 12582912.0f)) & 255u) << (8 * e);
            *(GAS unsigned*)(dst + (size_t)r * D + 256 * i + 4 * lane) = w; }
        if (lane == 0) SU[r] = mx * (1.0f / 127.0f);
    }
}
__device__ __forceinline__ void rms_row_to_bf16(const float* xrow, const float* g, bf16* orow, int lane) {
    const GAS f32x4* xr = (const GAS f32x4*)xrow + lane; f32x4 v[8]; float s = 0.f;
#pragma unroll
    for (int j = 0; j < 8; ++j) { v[j] = xr[64 * j]; s += (v[j][0] * v[j][0] + v[j][1] * v[j][1]) + (v[j][2] * v[j][2] + v[j][3] * v[j][3]); }
    const float r = __builtin_amdgcn_rsqf(wave_sum(s) * (1.0f / D) + EPS);
    const GAS f32x4* gr = (const GAS f32x4*)g + lane;
    GAS unsigned long long* o8 = (GAS unsigned long long*)orow + lane;
#pragma unroll
    for (int j = 0; j < 8; ++j) { const f32x4 gg = gr[64 * j]; o8[64 * j] = (unsigned long long)pk2(v[j][0] * r * gg[0], v[j][1] * r * gg[1]) | ((unsigned long long)pk2(v[j][2] * r * gg[2], v[j][3] * r * gg[3]) << 32); }
}
__device__ __forceinline__ void rms_row_to_i8(const float* xrow, const float* g, unsigned char* orow, float* sa, int lane) {
    const GAS f32x4* xr = (const GAS f32x4*)xrow + lane; f32x4 v[8]; float s = 0.f;
#pragma unroll
    for (int j = 0; j < 8; ++j) { v[j] = xr[64 * j]; s += (v[j][0] * v[j][0] + v[j][1] * v[j][1]) + (v[j][2] * v[j][2] + v[j][3] * v[j][3]); }
    const float r = __builtin_amdgcn_rsqf(wave_sum(s) * (1.0f / D) + EPS);
    const GAS f32x4* gr = (const GAS f32x4*)g + lane; float mx = 0.f;
#pragma unroll
    for (int j = 0; j < 8; ++j) { v[j] = v[j] * gr[64 * j] * r; mx = fmaxf(mx, fmaxf(fmaxf(fabsf(v[j][0]), fabsf(v[j][1])), fmaxf(fabsf(v[j][2]), fabsf(v[j][3])))); }
#pragma unroll
    for (int o = 1; o < 64; o <<= 1) mx = fmaxf(mx, __shfl_xor(mx, o));
    const float inv = mx > 0.f ? 127.0f / mx : 0.f;
    GAS unsigned* o4 = (GAS unsigned*)orow + lane;
#pragma unroll
    for (int j = 0; j < 8; ++j) { unsigned w = 0;
#pragma unroll
        for (int e = 0; e < 4; ++e) w |= (__float_as_uint(__builtin_fmaf(v[j][e], inv, 12582912.0f)) & 255u) << (8 * e);
        o4[64 * j] = w; }
    if (lane == 0) *sa = mx * (1.0f / (127.0f * 127.0f));
}
__device__ __forceinline__ void rms_row_to_f8(const float* xrow, const float* g, unsigned char* orow, int lane) {
    const GAS f32x4* xr = (const GAS f32x4*)xrow + lane; f32x4 v[8]; float s = 0.f;
#pragma unroll
    for (int j = 0; j < 8; ++j) { v[j] = xr[64 * j]; s += (v[j][0] * v[j][0] + v[j][1] * v[j][1]) + (v[j][2] * v[j][2] + v[j][3] * v[j][3]); }
    const float r = __builtin_amdgcn_rsqf(wave_sum(s) * (1.0f / D) + EPS);
    const GAS f32x4* gr = (const GAS f32x4*)g + lane;
    GAS unsigned* o4 = (GAS unsigned*)orow + lane;
#pragma unroll
    for (int j = 0; j < 8; ++j) { const f32x4 q = v[j] * gr[64 * j] * r; int x = __builtin_amdgcn_cvt_pk_fp8_f32(q[0], q[1], 0, false); x = __builtin_amdgcn_cvt_pk_fp8_f32(q[2], q[3], x, true); o4[64 * j] = (unsigned)x; }
}
__device__ __forceinline__ void p0_fold_item(const float* wq, const float* sk, bf16* WP, LAS float* lds, int item, int tid, const float* kgain) {
    const int hp = item >> 5, k0 = (item & 31) * 64;
    LAS float* skT = lds;
    LAS float* wqT = lds + 128 * 132;
    const float* skb = sk + (size_t)hp * 128 * 128;
#pragma unroll 4
    for (int i = 0; i < 32; ++i) { const int idx = i * 512 + tid, n = idx >> 7, d = idx & 127; skT[d * 132 + n] = skb[idx]; }
#pragma unroll 4
    for (int i = 0; i < 16; ++i) { const int idx = i * 512 + tid, kk = idx >> 7, d = idx & 127; wqT[d * 68 + kk] = wq[(size_t)(k0 + kk) * D + hp * 128 + d] * kgain[k0 + kk]; }
    __syncthreads();
    const int n0 = (tid >> 4) * 4, kk0 = (tid & 15) * 4;
    float acc[4][4];
#pragma unroll
    for (int i = 0; i < 4; ++i)
#pragma unroll
        for (int j = 0; j < 4; ++j) acc[i][j] = 0.f;
#pragma unroll 4
    for (int d = 0; d < 128; ++d) { const f32x4 a = *(const LAS f32x4*)(skT + d * 132 + n0), b = *(const LAS f32x4*)(wqT + d * 68 + kk0);
#pragma unroll
        for (int i = 0; i < 4; ++i)
#pragma unroll
            for (int j = 0; j < 4; ++j) acc[i][j] += a[i] * b[j]; }
#pragma unroll
    for (int i = 0; i < 4; ++i) { unsigned long long o = (unsigned long long)pk2(acc[i][0], acc[i][1]) | ((unsigned long long)pk2(acc[i][2], acc[i][3]) << 32);
        *(GAS unsigned long long*)(WP + (size_t)(hp * 128 + n0 + i) * D + k0 + kk0) = o; }
    __syncthreads();
}
__device__ __forceinline__ void p0_prologue(const Args& A, Frame& F, const int part) {
    const int gw = F.vcu * NWAVES + F.wave, NGW = F.G * NWAVES;
    const int gtid = gw * 64 + F.lane, gthreads = F.G * NTHREADS;
    unsigned char* ws = A.ws;
    LAS float* scr = (LAS float*)(F.lds + RING_OFF + F.wave * 16384);
    constexpr int I_EVIN = (D / 64) * (EV_N / 32);
    if (part == 1) {
        for (int it = gw; it < I_EVIN; it += NGW) p0_transpose_item_i8(A.in[I_EV_WIN], D, EV_N, (unsigned char*)(ws + WS_WEV_IN), scr, it, F.lane, (const float*)(ws + WS_CMB));
        return; }
    { constexpr int I_CM = (D / 64) * ((EV_N + 255) / 256);
      for (int it = gw; it < I_CM; it += NGW) colmax_item(A.in[I_EV_WIN], D, EV_N, (float*)(ws + WS_CMB), it, F.lane); }
    { GAS v4u* z0 = (GAS v4u*)(ws + WS_WEV_IN + (size_t)EV_N * D); const size_t n0 = (size_t)(EV_NP - EV_N) * D / 16;
      for (size_t i = gtid; i < n0; i += gthreads) z0[i] = (v4u){0u, 0u, 0u, 0u}; }
    { constexpr int I_PJ = (256 / 64) * (D / 32);
      for (int it = gw; it < 2 * I_PJ; it += NGW) { const int L = it / I_PJ; p0_transpose_item(A.in[I_PLE_WP] + (size_t)L * 256 * D, 256, D, (bf16*)(ws + WS_WPROJ) + (size_t)L * D * 256, scr, it % I_PJ, F.lane); } }
    cvt_f32_bf16(A.in[I_P], (bf16*)(ws + WS_PBF), (size_t)2 * T * 256, gtid, gthreads);
    for (int m = gw; m < T; m += NGW) rms_row_to_i8(A.in[I_X] + (size_t)m * D, A.in[I_NMIX], (unsigned char*)(ws + WS_ACTA) + (size_t)m * D, (float*)(ws + WS_SA) + m, F.lane);
#if EV_F8_T1 > EV_F8_T0
    for (int it = gw; it < I_EVIN; it += NGW) p0_transpose_item_f8(A.in[I_EV_WIN], D, EV_N, (unsigned char*)(ws + WS_O), scr, it, F.lane);
    { GAS v4u* z0 = (GAS v4u*)(ws + WS_O + (size_t)EV_N * D); const size_t n0 = (size_t)(EV_NP - EV_N) * D / 16;
      for (size_t i = gtid; i < n0; i += gthreads) z0[i] = (v4u){0u, 0u, 0u, 0u}; }
    for (int m = gw; m < T; m += NGW) rms_row_to_f8(A.in[I_X] + (size_t)m * D, A.in[I_NMIX], (unsigned char*)(ws + WS_H1) + (size_t)m * D, F.lane);
#endif
}
__device__ __forceinline__ void p0_deferred(const Args& A, Frame& F, int wg, int nwg) {
    const int gw = wg * NWAVES + F.wave, NGW = nwg * NWAVES;
    int gtid = gw * 64 + F.lane; const int gthreads = nwg * NTHREADS;
    asm volatile("" : "+v"(gtid));
    unsigned char* ws = A.ws;
    {
        LAS float* scr = (LAS float*)(F.lds + RING_OFF + F.wave * 16384);
        constexpr int I_SQ = (D / 64) * (D / 32), I_ODIN = (D / 64) * (OD_N / 32);
        constexpr int NITEMS = I_SQ + I_ODIN + I_SQ;
        for (int it = gw; it < NITEMS; it += NGW) {
            int r = it;
            if (r < I_SQ) { p0_transpose_item(A.in[I_EV_WOUT], D, D, (bf16*)(ws + WS_WEV_OUT), scr, r, F.lane); continue; } r -= I_SQ;
            if (r < I_ODIN) { p0_transpose_item_f8(A.in[I_OD_WIN], D, OD_N, (unsigned char*)(ws + WS_WOD_IN), scr, r, F.lane, A.in[I_NMIX] + D); continue; } r -= I_ODIN;
            p0_transpose_item_f8(A.in[I_PLE_WG], D, D, (unsigned char*)(ws + WS_WGATE), scr, r, F.lane, A.in[I_NPLE]);
        }
        { GAS v4u* z1 = (GAS v4u*)(ws + WS_WOD_IN + (size_t)OD_N * D); const size_t n1 = (size_t)(OD_NP - OD_N) * D / 16;
          for (size_t i = gtid; i < n1; i += gthreads) z1[i] = (v4u){0u, 0u, 0u, 0u}; }
    }
    __syncthreads();
    for (int it = wg; it < 512; it += nwg)
        p0_fold_item(A.in[I_PEER_WQ], A.in[I_PEER_SK], (bf16*)(ws + WS_WPEER), (LAS float*)(F.lds + RING_OFF), it, F.tid, A.in[I_NFFN]);
    cvt_rows_i8(A.in[I_PEER_U], (unsigned char*)(ws + WS_TABU), (float*)(ws + WS_SU), 16384, gw, NGW, F.lane, A.in[I_NFFN]);
    cvt_rows_i8(A.in[I_PEER_V], (unsigned char*)(ws + WS_TABV), (float*)(ws + WS_SU) + 32768, 16384, gw, NGW, F.lane, nullptr);
    { bf16* LB = (bf16*)(ws + WS_WLORA); const float* w2 = A.in[I_W2]; const float* a2 = A.in[I_A2]; const float* g2 = A.in[I_G2];
      for (int i = gtid; i < LORA_N * LORA_K / 2; i += gthreads) { const int row = i / (LORA_K / 2), col = (i % (LORA_K / 2)) * 2; float v[2];
#pragma unroll
          for (int e = 0; e < 2; ++e) { const int c = col + e; float x = 0.f;
              if (row < 1024) { if (c < 96) x = w2[c * 1024 + row]; }
              else if (row < 2048) { if (c >= 96 && c < 192) x = a2[(c - 96) * 1024 + (row - 1024)]; }
              else { if (c >= 192 && c < 448) x = g2[(c - 192) * 1024 + (row - 2048)]; }
              v[e] = x; }
          *(GAS unsigned*)(LB + (size_t)row * LORA_K + col) = pk2(v[0], v[1]); } }
}
__device__ __forceinline__ void p1_deferred(const Args& A, Frame& F, int wg, int nwg) {
    const int gw = wg * NWAVES + F.wave, NGW = nwg * NWAVES;
    int gtid = gw * 64 + F.lane; const int gthreads = nwg * NTHREADS;
    asm volatile("" : "+v"(gtid));
    unsigned char* ws = A.ws;
    { LAS float* scr = (LAS float*)(F.lds + RING_OFF + F.wave * 16384); constexpr int I_SQ = (D / 64) * (D / 32);
      for (int it = gw; it < 2 * I_SQ; it += NGW) {
          if (it < I_SQ) p0_transpose_item_f8(A.in[I_OD_WOUT], D, D, (unsigned char*)(ws + WS_WOD_OUT), scr, it, F.lane);
          else p0_transpose_item_f8(A.in[I_PLE_WG] + (size_t)D * D, D, D, (unsigned char*)((bf16*)(ws + WS_WGATE) + (size_t)D * D), scr, it - I_SQ, F.lane, A.in[I_NPLE] + D); } }
    __syncthreads();
    for (int it = wg; it < 512; it += nwg)
        p0_fold_item(A.in[I_PEER_WQ] + (size_t)D * D, A.in[I_PEER_SK] + (size_t)16 * 128 * 128, (bf16*)(ws + WS_WPEER) + (size_t)D * D, (LAS float*)(F.lds + RING_OFF), it, F.tid, A.in[I_NFFN] + D);
    cvt_rows_i8(A.in[I_PEER_U] + (size_t)16384 * D, (unsigned char*)(ws + WS_TABU) + (size_t)16384 * D, (float*)(ws + WS_SU) + 16384, 16384, gw, NGW, F.lane, A.in[I_NFFN] + D);
    cvt_rows_i8(A.in[I_PEER_V] + (size_t)16384 * D, (unsigned char*)(ws + WS_TABV) + (size_t)16384 * D, (float*)(ws + WS_SU) + 32768 + 16384, 16384, gw, NGW, F.lane, nullptr);
}

constexpr int TC = 16, NCHUNK = SEQ / TC;

template <int MODE>
__device__ __forceinline__ void scan_gla_unit(const Args& A, Frame& F, int unit) {
    int tid = F.tid; asm volatile("" : "+v"(tid));
    const int lane = tid & 63, w = F.wave;
    int b, h, qcol, kcol, vcol, ocol;
    if (MODE == 0) { b = unit >> 4; h = (unit >> 2) & 3; const int s = unit & 3; qcol = EC_GQ + h * 128; kcol = EC_GK + h * 128; vcol = EC_GV + h * 256 + s * 64; ocol = h * 256 + s * 64; }
    else           { b = unit >> 4; h = (unit >> 1) & 7; const int s = unit & 1; qcol = OC_HQ + h * 128; kcol = OC_HF + h * 128; vcol = OC_HI + h * 128 + s * 64; ocol = h * 128 + s * 64; }
    const bf16* P = (const bf16*)(A.ws + WS_PROJ) + (size_t)b * SEQ * PROJ_LD;
    float* O = (float*)(A.ws + WS_O) + (size_t)b * SEQ * D + ocol;
    LAS float* Lf = (LAS float*)(F.lds + RING_OFF);
    constexpr int BUFSZ = 7168, O_EG = 0, O_K = 2048, O_Q = 4096, O_V = 6144, O_OUT = 2 * BUFSZ, O_W2 = O_OUT + 1024, O_BIAS = O_W2 + 2048;
    const int tl = tid >> 5, dq = (tid & 31) * 4, tlv = tid >> 4, c4 = (tid & 15) * 4;
    float lb[4] = {0.f, 0.f, 0.f, 0.f};
    if (MODE == 0) {
        const float* w2 = A.in[I_GK_W2]; const float* gb = A.in[I_GK_B];
        for (int i = tid; i < 2048; i += NTHREADS) Lf[O_W2 + i] = w2[(i >> 7) * 512 + h * 128 + (i & 127)];
        if (tid < 128) Lf[O_BIAS + tid] = gb[h * 128 + tid];
    } else {
        const float* lg = A.in[I_LB];
#pragma unroll
        for (int i = 0; i < 4; ++i) lb[i] = sigmoidf_(lg[1024 + h * 128 + dq + i] - lg[h * 128 + dq + i]);
    }
    u32x2 rq, rk, rv = {0u, 0u}; v4u rg0 = {0u, 0u, 0u, 0u}, rg1 = {0u, 0u, 0u, 0u};
#define GLA_LOAD(c) do { const bf16* pr = P + (size_t)((c) * TC + tl) * PROJ_LD; rq = *(const GAS u32x2*)(pr + qcol + dq); rk = *(const GAS u32x2*)(pr + kcol + dq); \
        if (MODE == 0) { rg0 = *(const GAS v4u*)(pr + EC_GLR); rg1 = *(const GAS v4u*)(pr + EC_GLR + 8); } \
        if (tid < 256) rv = *(const GAS u32x2*)(P + (size_t)((c) * TC + tlv) * PROJ_LD + vcol + c4); } while (0)
#define GLA_XFORM(bufi) do { LAS float* B_ = Lf + (bufi) * BUFSZ; f32x4 q4, k4, e4; \
        const float xq[4] = {bf_lo(rq.x), bf_hi(rq.x), bf_lo(rq.y), bf_hi(rq.y)}, xk[4] = {bf_lo(rk.x), bf_hi(rk.x), bf_lo(rk.y), bf_hi(rk.y)}; \
        if (MODE == 0) { f32x4 z = *(const LAS f32x4*)(Lf + O_BIAS + dq); \
            const float gl[16] = {bf_lo(rg0.x), bf_hi(rg0.x), bf_lo(rg0.y), bf_hi(rg0.y), bf_lo(rg0.z), bf_hi(rg0.z), bf_lo(rg0.w), bf_hi(rg0.w), \
                                  bf_lo(rg1.x), bf_hi(rg1.x), bf_lo(rg1.y), bf_hi(rg1.y), bf_lo(rg1.z), bf_hi(rg1.z), bf_lo(rg1.w), bf_hi(rg1.w)}; \
            _Pragma("unroll") for (int r_ = 0; r_ < 16; ++r_) { const f32x4 wv = *(const LAS f32x4*)(Lf + O_W2 + r_ * 128 + dq); z = z + wv * gl[r_]; } \
            _Pragma("unroll") for (int i_ = 0; i_ < 4; ++i_) { q4[i_] = xq[i_] * 0.08838834764831845f; k4[i_] = xk[i_]; e4[i_] = __builtin_amdgcn_exp2f(-0.0625f * __builtin_amdgcn_logf(1.0f + __expf(-z[i_]))); } } \
        else { _Pragma("unroll") for (int i_ = 0; i_ < 4; ++i_) { const float fg = lb[i_] + (1.f - lb[i_]) * sigmoidf_(xk[i_]); q4[i_] = siluf_(xq[i_]); k4[i_] = 1.f - fg; e4[i_] = fg; } } \
        *(LAS f32x4*)(B_ + O_EG + tl * 128 + dq) = e4; *(LAS f32x4*)(B_ + O_K + tl * 128 + dq) = k4; *(LAS f32x4*)(B_ + O_Q + tl * 128 + dq) = q4; \
        if (tid < 256) { f32x4 v4 = {bf_lo(rv.x), bf_hi(rv.x), bf_lo(rv.y), bf_hi(rv.y)}; *(LAS f32x4*)(B_ + O_V + tlv * 64 + c4) = v4; } } while (0)
    LBAR();
    GLA_LOAD(0); GLA_XFORM(0);
    LBAR();
    f32x2 S2[8];
#pragma unroll
    for (int i = 0; i < 8; ++i) S2[i] = (f32x2){0.f, 0.f};
    const int j = lane & 15, col = w * 8 + (lane >> 4) * 2;
    for (int c = 0; c < NCHUNK; ++c) {
        if (c + 1 < NCHUNK) GLA_LOAD(c + 1);
        const LAS float* B_ = Lf + (c & 1) * BUFSZ;
        float os0 = 0.f, os1 = 0.f;
        f32x4 e0, e1, k0, k1, q0, q1, ne0, ne1, nk0, nk1, nq0, nq1; f32x2 v2, nv2;
#define GLA_LDSTEP(t_, E0, E1, K0, K1, Q0, Q1, V2) do { E0 = *(const LAS f32x4*)(B_ + O_EG + (t_) * 128 + 4 * j); E1 = *(const LAS f32x4*)(B_ + O_EG + (t_) * 128 + 64 + 4 * j); \
            K0 = *(const LAS f32x4*)(B_ + O_K + (t_) * 128 + 4 * j); K1 = *(const LAS f32x4*)(B_ + O_K + (t_) * 128 + 64 + 4 * j); \
            Q0 = *(const LAS f32x4*)(B_ + O_Q + (t_) * 128 + 4 * j); Q1 = *(const LAS f32x4*)(B_ + O_Q + (t_) * 128 + 64 + 4 * j); V2 = *(const LAS f32x2*)(B_ + O_V + (t_) * 64 + col); } while (0)
        GLA_LDSTEP(0, e0, e1, k0, k1, q0, q1, v2);
#pragma unroll
        for (int t = 0; t < TC; ++t) {
            if (t + 1 < TC) { GLA_LDSTEP(t + 1, ne0, ne1, nk0, nk1, nq0, nq1, nv2); }
            __builtin_amdgcn_sched_barrier(0);
            f32x2 pa = {0.f, 0.f}, pb = {0.f, 0.f};
#pragma unroll
            for (int i = 0; i < 4; ++i) {
                S2[i] = S2[i] * e0[i] + v2 * k0[i]; S2[4 + i] = S2[4 + i] * e1[i] + v2 * k1[i];
                pa += S2[i] * q0[i]; pb += S2[4 + i] * q1[i]; }
            pa += pb;
            float p0 = pa[0], p1 = pa[1];
            row_sum16_x2(p0, p1);
            os0 = (j == t) ? p0 : os0; os1 = (j == t) ? p1 : os1;
            e0 = ne0; e1 = ne1; k0 = nk0; k1 = nk1; q0 = nq0; q1 = nq1; v2 = nv2;
        }
#undef GLA_LDSTEP
        { f32x2 o2 = {os0, os1}; *(LAS f32x2*)(Lf + O_OUT + j * 64 + col) = o2; }
        if (c + 1 < NCHUNK) GLA_XFORM((c + 1) & 1);
        LBAR();
        if (tid < 256) *(GAS f32x4*)(O + (size_t)(c * TC + tlv) * D + c4) = *(const LAS f32x4*)(Lf + O_OUT + tlv * 64 + c4);
        LBAR();
    }
#undef GLA_LOAD
#undef GLA_XFORM
}

__device__ __forceinline__ void scan_gdn_unit(const Args& A, Frame& F, int unit) {
    int tid = F.tid; asm volatile("" : "+v"(tid));
    const int lane = tid & 63, w = F.wave;
    const int b = unit >> 4, h = (unit >> 1) & 7, s = unit & 1;
    const int qcol = EC_BQ + h * 128, kcol = EC_BK + h * 128, vcol = EC_BV + h * 128 + s * 64, ocol = 1024 + h * 128 + s * 64;
    const bf16* P = (const bf16*)(A.ws + WS_PROJ) + (size_t)b * SEQ * PROJ_LD;
    float* O = (float*)(A.ws + WS_O) + (size_t)b * SEQ * D + ocol;
    LAS float* Lf = (LAS float*)(F.lds + RING_OFF);
    constexpr int BUFSZ = 5184, O_K = 0, O_Q = 2048, O_V = 4096, O_SC = 5120, O_OUT = 2 * BUFSZ, O_CW = O_OUT + 1024;
    const int tl = tid >> 5, dq = (tid & 31) * 4, tlv = tid >> 4, c4 = (tid & 15) * 4;
    { const float* cw = A.in[I_GDN_CONV];
      for (int i = tid; i < 4 * 320; i += NTHREADS) { const int jt = i / 320, x = i % 320;
          const int ch = x < 128 ? (h * 128 + x) : x < 256 ? (1024 + h * 128 + (x - 128)) : (2048 + h * 128 + s * 64 + (x - 256));
          Lf[O_CW + i] = cw[jt * 3072 + ch]; } }
    const float neg_ea = -__expf(A.in[I_GDN_ALOG][h]), dtb = A.in[I_GDN_DTB][h];
    u32x2 rq[4], rk[4], rv[4]; unsigned short rba = 0, rbb = 0;
#pragma unroll
    for (int i = 0; i < 4; ++i) rv[i] = (u32x2){0u, 0u};
#define GDN_LOAD(c) do { const int t_ = (c) * TC + tl; \
        _Pragma("unroll") for (int jt = 0; jt < 4; ++jt) { const int tt = t_ - 3 + jt; \
            if (tt >= 0) { const bf16* pr = P + (size_t)tt * PROJ_LD; rq[jt] = *(const GAS u32x2*)(pr + qcol + dq); rk[jt] = *(const GAS u32x2*)(pr + kcol + dq); } \
            else { rq[jt] = (u32x2){0u, 0u}; rk[jt] = (u32x2){0u, 0u}; } } \
        { const bf16* pr = P + (size_t)t_ * PROJ_LD; rba = pr[EC_BA + h]; rbb = pr[EC_BB + h]; } \
        if (tid < 256) { const int tv = (c) * TC + tlv; \
            _Pragma("unroll") for (int jt = 0; jt < 4; ++jt) { const int tt = tv - 3 + jt; \
                if (tt >= 0) rv[jt] = *(const GAS u32x2*)(P + (size_t)tt * PROJ_LD + vcol + c4); else rv[jt] = (u32x2){0u, 0u}; } } } while (0)
#define GDN_XFORM(bufi) do { LAS float* B_ = Lf + (bufi) * BUFSZ; f32x4 q4 = {0.f, 0.f, 0.f, 0.f}, k4 = {0.f, 0.f, 0.f, 0.f}; \
        _Pragma("unroll") for (int jt = 0; jt < 4; ++jt) { const f32x4 wq = *(const LAS f32x4*)(Lf + O_CW + jt * 320 + dq), wk = *(const LAS f32x4*)(Lf + O_CW + jt * 320 + 128 + dq); \
            q4[0] += wq[0] * bf_lo(rq[jt].x); q4[1] += wq[1] * bf_hi(rq[jt].x); q4[2] += wq[2] * bf_lo(rq[jt].y); q4[3] += wq[3] * bf_hi(rq[jt].y); \
            k4[0] += wk[0] * bf_lo(rk[jt].x); k4[1] += wk[1] * bf_hi(rk[jt].x); k4[2] += wk[2] * bf_lo(rk[jt].y); k4[3] += wk[3] * bf_hi(rk[jt].y); } \
        float sq = 0.f, sk = 0.f, sqk = 0.f; \
        _Pragma("unroll") for (int i_ = 0; i_ < 4; ++i_) { q4[i_] = siluf_(q4[i_]); k4[i_] = siluf_(k4[i_]); sq += q4[i_] * q4[i_]; sk += k4[i_] * k4[i_]; sqk += q4[i_] * k4[i_]; } \
        sq = half_sum32(sq); sk = half_sum32(sk); sqk = half_sum32(sqk); \
        const float rq_ = __builtin_amdgcn_rsqf(sq + EPS) * 0.08838834764831845f, rk_ = __builtin_amdgcn_rsqf(sk + EPS); \
        q4 = q4 * rq_; k4 = k4 * rk_; \
        *(LAS f32x4*)(B_ + O_K + tl * 128 + dq) = k4; *(LAS f32x4*)(B_ + O_Q + tl * 128 + dq) = q4; \
        if ((tid & 31) == 0) { const float ba = __uint_as_float((unsigned)rba << 16), bb = __uint_as_float((unsigned)rbb << 16); \
            f32x4 sc; sc[0] = __expf(neg_ea * softplusf_(ba + dtb)); sc[1] = sigmoidf_(bb); sc[2] = sqk * rq_ * rk_; sc[3] = 0.f; *(LAS f32x4*)(B_ + O_SC + tl * 4) = sc; } \
        if (tid < 256) { f32x4 v4 = {0.f, 0.f, 0.f, 0.f}; \
            _Pragma("unroll") for (int jt = 0; jt < 4; ++jt) { const f32x4 wv = *(const LAS f32x4*)(Lf + O_CW + jt * 320 + 256 + c4); \
                v4[0] += wv[0] * bf_lo(rv[jt].x); v4[1] += wv[1] * bf_hi(rv[jt].x); v4[2] += wv[2] * bf_lo(rv[jt].y); v4[3] += wv[3] * bf_hi(rv[jt].y); } \
            _Pragma("unroll") for (int i_ = 0; i_ < 4; ++i_) v4[i_] = siluf_(v4[i_]); \
            *(LAS f32x4*)(B_ + O_V + tlv * 64 + c4) = v4; } } while (0)
    LBAR();
    GDN_LOAD(0); GDN_XFORM(0);
    LBAR();
    f32x2 S2[8];
#pragma unroll
    for (int i = 0; i < 8; ++i) S2[i] = (f32x2){0.f, 0.f};
    const int j = lane & 15, col = w * 8 + (lane >> 4) * 2;
    for (int c = 0; c < NCHUNK; ++c) {
        if (c + 1 < NCHUNK) GDN_LOAD(c + 1);
        const LAS float* B_ = Lf + (c & 1) * BUFSZ;
        float os0 = 0.f, os1 = 0.f;
        f32x4 k0, k1, q0, q1, sc, nk0, nk1, nq0, nq1, nsc; f32x2 v2, nv2;
#define GDN_LDSTEP(t_, K0, K1, Q0, Q1, V2, SC) do { K0 = *(const LAS f32x4*)(B_ + O_K + (t_) * 128 + 4 * j); K1 = *(const LAS f32x4*)(B_ + O_K + (t_) * 128 + 64 + 4 * j); \
            Q0 = *(const LAS f32x4*)(B_ + O_Q + (t_) * 128 + 4 * j); Q1 = *(const LAS f32x4*)(B_ + O_Q + (t_) * 128 + 64 + 4 * j); V2 = *(const LAS f32x2*)(B_ + O_V + (t_) * 64 + col); SC = *(const LAS f32x4*)(B_ + O_SC + (t_) * 4); } while (0)
        GDN_LDSTEP(0, k0, k1, q0, q1, v2, sc);
#pragma unroll
        for (int t = 0; t < TC; ++t) {
            if (t + 1 < TC) { GDN_LDSTEP(t + 1, nk0, nk1, nq0, nq1, nv2, nsc); }
            __builtin_amdgcn_sched_barrier(0);
            f32x2 d1 = {0.f, 0.f}, d2 = {0.f, 0.f}, e1 = {0.f, 0.f}, e2 = {0.f, 0.f};
#pragma unroll
            for (int i = 0; i < 4; ++i) { d1 += S2[i] * k0[i]; e1 += S2[4 + i] * k1[i]; d2 += S2[i] * q0[i]; e2 += S2[4 + i] * q1[i]; }
            d1 += e1; d2 += e2;
            { float r0_ = d1[0], r1_ = d1[1], r2_ = d2[0], r3_ = d2[1]; row_sum16_x4(r0_, r1_, r2_, r3_); d1[0] = r0_; d1[1] = r1_; d2[0] = r2_; d2[1] = r3_; }
            const float a = sc[0], beta = sc[1], qk = sc[2];
            const f32x2 dl = (v2 - d1 * a) * beta;
            const f32x2 o2 = d2 * a + dl * qk;
#pragma unroll
            for (int i = 0; i < 4; ++i) { S2[i] = S2[i] * a + dl * k0[i]; S2[4 + i] = S2[4 + i] * a + dl * k1[i]; }
            os0 = (j == t) ? o2[0] : os0; os1 = (j == t) ? o2[1] : os1;
            k0 = nk0; k1 = nk1; q0 = nq0; q1 = nq1; v2 = nv2; sc = nsc;
        }
#undef GDN_LDSTEP
        { f32x2 o2 = {os0, os1}; *(LAS f32x2*)(Lf + O_OUT + j * 64 + col) = o2; }
        if (c + 1 < NCHUNK) GDN_XFORM((c + 1) & 1);
        LBAR();
        if (tid < 256) *(GAS f32x4*)(O + (size_t)(c * TC + tlv) * D + c4) = *(const LAS f32x4*)(Lf + O_OUT + tlv * 64 + c4);
        LBAR();
    }
#undef GDN_LOAD
#undef GDN_XFORM
}

typedef short bf16x4_t __attribute__((ext_vector_type(4)));
__device__ __forceinline__ bf16x8 mk_frag(u32x2 lo, u32x2 hi) { v4u t; t.x = lo.x; t.y = lo.y; t.z = hi.x; t.w = hi.y; return __builtin_bit_cast(bf16x8, t); }
template <int MODE>
__device__ __forceinline__ void scan_gla_mfma_unit(const Args& A, Frame& F, int unit) {
    int tid = F.tid; asm volatile("" : "+v"(tid));
    const int lane = tid & 63, w = F.wave;
    int b, h, qcol, kcol, vcol, ocol;
    if (MODE == 0) { b = unit >> 3; h = (unit >> 1) & 3; const int s = unit & 1; qcol = EC_GQ + h * 128; kcol = EC_GK + h * 128; vcol = EC_GV + h * 256 + s * 128; ocol = h * 256 + s * 128; }
    else           { b = unit >> 3; h = unit & 7; qcol = OC_HQ + h * 128; kcol = OC_HF + h * 128; vcol = OC_HI + h * 128; ocol = h * 128; }
    const bf16* P = (const bf16*)(A.ws + WS_PROJ) + (size_t)b * SEQ * PROJ_LD;
    bf16* O = (bf16*)(A.ws + WS_O) + (size_t)b * SEQ * D + ocol;
    LAS float* Lf = (LAS float*)(F.lds + RING_OFF);
    constexpr int BUFSZ = 8192, O_E = 0, O_K = 2048, O_Q = 4096, O_V = 6144, RS = 136, O_QB = 2 * BUFSZ, O_KB = O_QB + 1088, O_KT = O_KB + 1088, O_BL = O_KT + 1024, O_AM = O_BL + 128, O_W2 = O_AM + 128, O_BIAS = O_W2 + 2048;
    LAS bf16* QB = (LAS bf16*)(Lf + O_QB); LAS bf16* KB = (LAS bf16*)(Lf + O_KB); LAS bf16* KT = (LAS bf16*)(Lf + O_KT); LAS bf16* AM = (LAS bf16*)(Lf + O_AM);
    const int tl = tid >> 5, dq = (tid & 31) * 4;
    float lb[4] = {0.f, 0.f, 0.f, 0.f};
    if (MODE == 0) {
        const float* w2 = A.in[I_GK_W2]; const float* gb = A.in[I_GK_B];
        for (int i = tid; i < 2048; i += NTHREADS) Lf[O_W2 + i] = w2[(i >> 7) * 512 + h * 128 + (i & 127)];
        if (tid < 128) Lf[O_BIAS + tid] = gb[h * 128 + tid];
    } else {
        const float* lg = A.in[I_LB];
#pragma unroll
        for (int i = 0; i < 4; ++i) lb[i] = sigmoidf_(lg[1024 + h * 128 + dq + i] - lg[h * 128 + dq + i]);
    }
    u32x2 rq, rk, rv; v4u rg0 = {0u, 0u, 0u, 0u}, rg1 = {0u, 0u, 0u, 0u};
#define GM_LOAD(c) do { const bf16* pr = P + (size_t)((c) * TC + tl) * PROJ_LD; rq = *(const GAS u32x2*)(pr + qcol + dq); rk = *(const GAS u32x2*)(pr + kcol + dq); rv = *(const GAS u32x2*)(pr + vcol + dq); \
        if (MODE == 0) { rg0 = *(const GAS v4u*)(pr + EC_GLR); rg1 = *(const GAS v4u*)(pr + EC_GLR + 8); } } while (0)
#define GM_XFORM(bufi) do { LAS float* B_ = Lf + (bufi) * BUFSZ; f32x4 q4, k4, e4; \
        const float xq[4] = {bf_lo(rq.x), bf_hi(rq.x), bf_lo(rq.y), bf_hi(rq.y)}, xk[4] = {bf_lo(rk.x), bf_hi(rk.x), bf_lo(rk.y), bf_hi(rk.y)}; \
        if (MODE == 0) { f32x4 z = *(const LAS f32x4*)(Lf + O_BIAS + dq); \
            const float gl[16] = {bf_lo(rg0.x), bf_hi(rg0.x), bf_lo(rg0.y), bf_hi(rg0.y), bf_lo(rg0.z), bf_hi(rg0.z), bf_lo(rg0.w), bf_hi(rg0.w), \
                                  bf_lo(rg1.x), bf_hi(rg1.x), bf_lo(rg1.y), bf_hi(rg1.y), bf_lo(rg1.z), bf_hi(rg1.z), bf_lo(rg1.w), bf_hi(rg1.w)}; \
            _Pragma("unroll") for (int r_ = 0; r_ < 16; ++r_) { const f32x4 wv = *(const LAS f32x4*)(Lf + O_W2 + r_ * 128 + dq); z = z + wv * gl[r_]; } \
            _Pragma("unroll") for (int i_ = 0; i_ < 4; ++i_) { q4[i_] = xq[i_] * 0.08838834764831845f; k4[i_] = xk[i_]; e4[i_] = __builtin_amdgcn_exp2f(-0.0625f * __builtin_amdgcn_logf(1.0f + __expf(-z[i_]))); } } \
        else { _Pragma("unroll") for (int i_ = 0; i_ < 4; ++i_) { const float fg = lb[i_] + (1.f - lb[i_]) * sigmoidf_(xk[i_]); q4[i_] = siluf_(xq[i_]); k4[i_] = 1.f - fg; e4[i_] = fg; } } \
        *(LAS f32x4*)(B_ + O_E + tl * 128 + dq) = e4; *(LAS f32x4*)(B_ + O_K + tl * 128 + dq) = k4; *(LAS f32x4*)(B_ + O_Q + tl * 128 + dq) = q4; \
        { f32x4 v4 = {bf_lo(rv.x), bf_hi(rv.x), bf_lo(rv.y), bf_hi(rv.y)}; *(LAS f32x4*)(B_ + O_V + tl * 128 + dq) = v4; } } while (0)
    LBAR();
    GM_LOAD(0); GM_XFORM(0); GM_LOAD(1);
    LBAR();
    f32x4 Sacc[8];
#pragma unroll
    for (int i = 0; i < 8; ++i) Sacc[i] = (f32x4){0.f, 0.f, 0.f, 0.f};
    const int fr = lane & 15, g = lane >> 4, c0 = w * 16;
    for (int c = 0; c < NCHUNK; ++c) {
        const LAS float* B_ = Lf + (c & 1) * BUFSZ;
        {
            const int seg = tid >> 7, d = tid & 127;
            float bt = 1.f, ball = 1.f;
#pragma unroll
            for (int t = 0; t < 16; ++t) { const float e = B_[O_E + t * 128 + d]; ball *= e; if (t < 4 * seg) bt = ball; }
            ball = fmaxf(ball, 1e-30f);
            unsigned short kt4[4];
#pragma unroll
            for (int i = 0; i < 4; ++i) { const int t = 4 * seg + i; bt = fmaxf(bt * B_[O_E + t * 128 + d], 1e-30f);
                const float kk = B_[O_K + t * 128 + d], qq = B_[O_Q + t * 128 + d], ib = __builtin_amdgcn_rcpf(bt);
                QB[t * RS + d] = hw_bf(qq * bt); KB[t * RS + d] = hw_bf(kk * ib); kt4[i] = (unsigned short)hw_bf(kk * ball * ib); }
            u32x2 kw; kw.x = (unsigned)kt4[0] | ((unsigned)kt4[1] << 16); kw.y = (unsigned)kt4[2] | ((unsigned)kt4[3] << 16);
            *(LAS u32x2*)(KT + d * 16 + 4 * seg) = kw;
            if (seg == 3) Lf[O_BL + d] = ball;
        }
        LBAR();
        if (w == 0) {
            f32x4 acc = {0.f, 0.f, 0.f, 0.f};
#pragma unroll
            for (int ks = 0; ks < 4; ++ks) { const bf16x8 af = *(const LAS bf16x8*)(QB + fr * RS + 32 * ks + 8 * g), bfm = *(const LAS bf16x8*)(KB + fr * RS + 32 * ks + 8 * g);
                acc = __builtin_amdgcn_mfma_f32_16x16x32_bf16(af, bfm, acc, 0, 0, 0); }
#pragma unroll
            for (int r = 0; r < 4; ++r) { const int t = 4 * g + r, s = fr; AM[t * 16 + s] = hw_bf(s <= t ? acc[r] : 0.f); }
        }
        if (c + 1 < NCHUNK) GM_XFORM((c + 1) & 1);
        if (c + 2 < NCHUNK) GM_LOAD(c + 2);
        LBAR();
        {
            u32x2 vlo; { const float v0 = B_[O_V + (4 * g + 0) * 128 + c0 + fr], v1 = B_[O_V + (4 * g + 1) * 128 + c0 + fr], v2 = B_[O_V + (4 * g + 2) * 128 + c0 + fr], v3 = B_[O_V + (4 * g + 3) * 128 + c0 + fr];
                vlo.x = hw_pk2(v0, v1); vlo.y = hw_pk2(v2, v3); }
            const u32x2 zz = {0u, 0u};
            const bf16x8 vb = mk_frag(vlo, zz);
            f32x4 acco = {0.f, 0.f, 0.f, 0.f};
#pragma unroll
            for (int ks = 0; ks < 4; ++ks) {
                u32x2 slo, shi; slo.x = hw_pk2(Sacc[2 * ks][0], Sacc[2 * ks][1]); slo.y = hw_pk2(Sacc[2 * ks][2], Sacc[2 * ks][3]); shi.x = hw_pk2(Sacc[2 * ks + 1][0], Sacc[2 * ks + 1][1]); shi.y = hw_pk2(Sacc[2 * ks + 1][2], Sacc[2 * ks + 1][3]);
                const bf16x8 sb = mk_frag(slo, shi);
                const u32x2 qlo = *(const LAS u32x2*)(QB + fr * RS + 32 * ks + 4 * g), qhi = *(const LAS u32x2*)(QB + fr * RS + 32 * ks + 16 + 4 * g);
                acco = __builtin_amdgcn_mfma_f32_16x16x32_bf16(mk_frag(qlo, qhi), sb, acco, 0, 0, 0); }
            { const u32x2 alo = *(const LAS u32x2*)(AM + fr * 16 + 4 * g); acco = __builtin_amdgcn_mfma_f32_16x16x32_bf16(mk_frag(alo, zz), vb, acco, 0, 0, 0); }
#pragma unroll
            for (int r = 0; r < 4; ++r) O[(size_t)(c * TC + 4 * g + r) * D + c0 + fr] = hw_bf(acco[r]);
#pragma unroll
            for (int i = 0; i < 8; ++i) { const f32x4 bl = *(const LAS f32x4*)(Lf + O_BL + 16 * i + 4 * g); const u32x2 klo = *(const LAS u32x2*)(KT + (16 * i + fr) * 16 + 4 * g);
                Sacc[i] = __builtin_amdgcn_mfma_f32_16x16x32_bf16(mk_frag(klo, zz), vb, Sacc[i] * bl, 0, 0, 0); }
        }
        LBAR();
    }
#undef GM_LOAD
#undef GM_XFORM
}

__device__ __forceinline__ void scan_gdn_mfma_unit(const Args& A, Frame& F, int unit, const int role) {
    int tid = F.tid; asm volatile("" : "+v"(tid));
    const int lane = tid & 63, w = F.wave;
    const int b = unit >> 3, h = unit & 7;
    const int qcol = EC_BQ + h * 128, kcol = EC_BK + h * 128, vcol = EC_BV + h * 128, ocol = 1024 + h * 128;
    const bf16* P = (const bf16*)(A.ws + WS_PROJ) + (size_t)b * SEQ * PROJ_LD;
    bf16* O = (bf16*)(A.ws + WS_O) + (size_t)b * SEQ * D + ocol;
    LAS float* Lf = (LAS float*)(F.lds + RING_OFF);
    constexpr int O_CW = 0, O_AMAT = 1536, O_QKM = O_AMAT + 256, O_TB = O_QKM + 128, O_GL = O_TB + 128, O_BUF0 = O_GL + 64;
    constexpr int BUFSZ = 6208, O_KH = 0, O_QH = 2048, O_VV = 4096, O_SC = 6144;
    constexpr int RS = 136;
    constexpr int O_KHB = O_BUF0 + 2 * BUFSZ, O_QHB = O_KHB + 1088, O_QB = O_QHB + 1088, O_KT = O_QB + 1088, O_WSRC = O_KT + 1024, O_WB = O_WSRC + 2048;
    LAS bf16* KHB = (LAS bf16*)(Lf + O_KHB); LAS bf16* QHB = (LAS bf16*)(Lf + O_QHB); LAS bf16* QB = (LAS bf16*)(Lf + O_QB); LAS bf16* KT = (LAS bf16*)(Lf + O_KT);
    LAS bf16* WB = (LAS bf16*)(Lf + O_WB); LAS bf16* QKM = (LAS bf16*)(Lf + O_QKM); LAS bf16* TB = (LAS bf16*)(Lf + O_TB);
    const int tl = tid >> 5, dq = (tid & 31) * 4;
    { const float* cw = A.in[I_GDN_CONV];
      for (int i = tid; i < 4 * 384; i += NTHREADS) { const int jt = i / 384, x = i % 384; Lf[O_CW + i] = cw[jt * 3072 + (x >> 7) * 1024 + h * 128 + (x & 127)]; } }
    const float neg_ea = -__expf(A.in[I_GDN_ALOG][h]), dtb = A.in[I_GDN_DTB][h];
    u32x2 rq[4], rk[4], rv[4]; unsigned short rba = 0, rbb = 0;
#define GD_LOAD(c) do { const int t_ = (c) * TC + tl; \
        _Pragma("unroll") for (int jt = 0; jt < 4; ++jt) { const int tt = t_ - 3 + jt; const bf16* pr = P + (size_t)(tt < 0 ? 0 : tt) * PROJ_LD + dq; \
            rq[jt] = *(const GAS u32x2*)(pr + qcol); rk[jt] = *(const GAS u32x2*)(pr + kcol); rv[jt] = *(const GAS u32x2*)(pr + vcol); \
            if (tt < 0) { rq[jt] = (u32x2){0u, 0u}; rk[jt] = (u32x2){0u, 0u}; rv[jt] = (u32x2){0u, 0u}; } } \
        { const bf16* pr = P + (size_t)t_ * PROJ_LD; rba = pr[EC_BA + h]; rbb = pr[EC_BB + h]; } } while (0)
#define GD_XFORM(bufi) do { LAS float* B_ = Lf + O_BUF0 + (bufi) * BUFSZ; f32x4 q4 = {0.f, 0.f, 0.f, 0.f}, k4 = {0.f, 0.f, 0.f, 0.f}, v4 = {0.f, 0.f, 0.f, 0.f}; \
        _Pragma("unroll") for (int jt = 0; jt < 4; ++jt) { const f32x4 wq = *(const LAS f32x4*)(Lf + O_CW + jt * 384 + dq), wk = *(const LAS f32x4*)(Lf + O_CW + jt * 384 + 128 + dq), wv = *(const LAS f32x4*)(Lf + O_CW + jt * 384 + 256 + dq); \
            q4[0] += wq[0] * bf_lo(rq[jt].x); q4[1] += wq[1] * bf_hi(rq[jt].x); q4[2] += wq[2] * bf_lo(rq[jt].y); q4[3] += wq[3] * bf_hi(rq[jt].y); \
            k4[0] += wk[0] * bf_lo(rk[jt].x); k4[1] += wk[1] * bf_hi(rk[jt].x); k4[2] += wk[2] * bf_lo(rk[jt].y); k4[3] += wk[3] * bf_hi(rk[jt].y); \
            v4[0] += wv[0] * bf_lo(rv[jt].x); v4[1] += wv[1] * bf_hi(rv[jt].x); v4[2] += wv[2] * bf_lo(rv[jt].y); v4[3] += wv[3] * bf_hi(rv[jt].y); } \
        float sq = 0.f, sk = 0.f; \
        _Pragma("unroll") for (int i_ = 0; i_ < 4; ++i_) { q4[i_] = siluf_(q4[i_]); k4[i_] = siluf_(k4[i_]); v4[i_] = siluf_(v4[i_]); sq += q4[i_] * q4[i_]; sk += k4[i_] * k4[i_]; } \
        row_sum16_x2(sq, sk); sq += __shfl_xor(sq, 16); sk += __shfl_xor(sk, 16); \
        q4 = q4 * (__builtin_amdgcn_rsqf(sq + EPS) * 0.08838834764831845f); k4 = k4 * __builtin_amdgcn_rsqf(sk + EPS); \
        *(LAS f32x4*)(B_ + O_KH + tl * 128 + dq) = k4; *(LAS f32x4*)(B_ + O_QH + tl * 128 + dq) = q4; *(LAS f32x4*)(B_ + O_VV + tl * 128 + dq) = v4; \
        if ((tid & 31) == 0) { const float ba = __uint_as_float((unsigned)rba << 16), bb = __uint_as_float((unsigned)rbb << 16); \
            B_[O_SC + tl] = __expf(neg_ea * softplusf_(ba + dtb)); B_[O_SC + 16 + tl] = sigmoidf_(bb); } } while (0)
    LBAR();
    constexpr int SPLIT = 58;
    const int c_begin = role ? SPLIT : 0, c_end = role ? NCHUNK : SPLIT;
    constexpr int REC = 5408;
    float* STASH = (float*)(A.ws + WS_LA) + (size_t)unit * (NCHUNK - SPLIT) * REC;
    float* STATE = (float*)(A.ws + WS_STATE) + (size_t)unit * 16384;
    gu32* flag = F.ctl + 32768 + unit * 64;
    GD_LOAD(c_begin); GD_XFORM(c_begin & 1); GD_LOAD(c_begin + 1);
    LBAR();
    f32x4 Sacc[8];
#pragma unroll
    for (int i = 0; i < 8; ++i) Sacc[i] = (f32x4){0.f, 0.f, 0.f, 0.f};
    const int fr = lane & 15, g = lane >> 4, c0 = w * 16;
    const u32x2 zz = {0u, 0u};
#define GD_STATE_PART(cc_) do { \
        { \
            bf16x8 sb[4]; \
_Pragma("unroll") \
            for (int ks = 0; ks < 4; ++ks) { u32x2 slo, shi; slo.x = hw_pk2(Sacc[2 * ks][0], Sacc[2 * ks][1]); slo.y = hw_pk2(Sacc[2 * ks][2], Sacc[2 * ks][3]); shi.x = hw_pk2(Sacc[2 * ks + 1][0], Sacc[2 * ks + 1][1]); shi.y = hw_pk2(Sacc[2 * ks + 1][2], Sacc[2 * ks + 1][3]); \
                sb[ks] = mk_frag(slo, shi); } \
            f32x4 accv = accu, acco = {0.f, 0.f, 0.f, 0.f}; \
_Pragma("unroll") \
            for (int ks = 0; ks < 4; ++ks) { \
                const u32x2 wl = *(const LAS u32x2*)(WB + fr * RS + 32 * ks + 4 * g), wh = *(const LAS u32x2*)(WB + fr * RS + 32 * ks + 16 + 4 * g); \
                accv = __builtin_amdgcn_mfma_f32_16x16x32_bf16(mk_frag(wl, wh), sb[ks], accv, 0, 0, 0); \
                const u32x2 ql = *(const LAS u32x2*)(QB + fr * RS + 32 * ks + 4 * g), qh = *(const LAS u32x2*)(QB + fr * RS + 32 * ks + 16 + 4 * g); \
                acco = __builtin_amdgcn_mfma_f32_16x16x32_bf16(mk_frag(ql, qh), sb[ks], acco, 0, 0, 0); } \
            u32x2 vn; vn.x = hw_pk2(accv[0], accv[1]); vn.y = hw_pk2(accv[2], accv[3]); \
            const bf16x8 vnb = mk_frag(vn, zz); \
            acco = __builtin_amdgcn_mfma_f32_16x16x32_bf16(mk_frag(*(const LAS u32x2*)(QKM + fr * 16 + 4 * g), zz), vnb, acco, 0, 0, 0); \
_Pragma("unroll") \
            for (int r = 0; r < 4; ++r) O[(size_t)((cc_) * TC + 4 * g + r) * D + c0 + fr] = hw_bf(acco[r]); \
_Pragma("unroll") \
            for (int i = 0; i < 8; ++i) { const u32x2 klo = *(const LAS u32x2*)(KT + (16 * i + fr) * 16 + 4 * g); \
                Sacc[i] = __builtin_amdgcn_mfma_f32_16x16x32_bf16(mk_frag(klo, zz), vnb, Sacc[i] * glast, 0, 0, 0); } \
        } \
        } while (0)
    for (int c = c_begin; c < c_end; ++c) {
        const LAS float* B_ = Lf + O_BUF0 + (c & 1) * BUFSZ;
        float glast;
        {
            const int seg = tid >> 7, d = tid & 127;
            const f32x4 a0 = *(const LAS f32x4*)(B_ + O_SC), a1 = *(const LAS f32x4*)(B_ + O_SC + 4), a2 = *(const LAS f32x4*)(B_ + O_SC + 8), a3 = *(const LAS f32x4*)(B_ + O_SC + 12);
            const float av[16] = {a0[0], a0[1], a0[2], a0[3], a1[0], a1[1], a1[2], a1[3], a2[0], a2[1], a2[2], a2[3], a3[0], a3[1], a3[2], a3[3]};
            float p = 1.f, gpre = 1.f;
#pragma unroll
            for (int t = 0; t < 16; ++t) { if (t == 4 * seg) gpre = p; p *= av[t]; }
            glast = p;
            unsigned short kt4[4]; float gt = gpre;
#pragma unroll
            for (int i = 0; i < 4; ++i) { const int t = 4 * seg + i; const float at = (seg == 0) ? av[i] : (seg == 1) ? av[4 + i] : (seg == 2) ? av[8 + i] : av[12 + i]; gt *= at; const float beta = B_[O_SC + 16 + t];
                const float kk = B_[O_KH + t * 128 + d], qq = B_[O_QH + t * 128 + d];
                KHB[t * RS + d] = hw_bf(kk); QHB[t * RS + d] = hw_bf(qq); QB[t * RS + d] = hw_bf(qq * gt);
                kt4[i] = (unsigned short)hw_bf(kk * glast * __builtin_amdgcn_rcpf(gt));
                Lf[O_WSRC + t * 128 + d] = kk * (beta * gt);
                if (d == 0) Lf[O_GL + t] = gt; }
            u32x2 kw; kw.x = (unsigned)kt4[0] | ((unsigned)kt4[1] << 16); kw.y = (unsigned)kt4[2] | ((unsigned)kt4[3] << 16);
            *(LAS u32x2*)(KT + d * 16 + 4 * seg) = kw;
        }
        LBAR();
        if (w < 2) {
            const LAS bf16* AS = (w == 0) ? KHB : QHB;
            f32x4 acc = {0.f, 0.f, 0.f, 0.f};
#pragma unroll
            for (int ks = 0; ks < 4; ++ks) { const bf16x8 af = *(const LAS bf16x8*)(AS + fr * RS + 32 * ks + 8 * g), bfm = *(const LAS bf16x8*)(KHB + fr * RS + 32 * ks + 8 * g);
                acc = __builtin_amdgcn_mfma_f32_16x16x32_bf16(af, bfm, acc, 0, 0, 0); }
            const float gs_inv = __builtin_amdgcn_rcpf(Lf[O_GL + fr]);
            if (w == 0) {
                f32x4 N1, M1;
#pragma unroll
                for (int r = 0; r < 4; ++r) { const int t = 4 * g + r; const float gt = Lf[O_GL + t];
                    N1[r] = (fr < t) ? -(B_[O_SC + 16 + t] * acc[r] * gt * gs_inv) : 0.f;
                    M1[r] = (t < fr) ? -(B_[O_SC + 16 + fr] * acc[r] * Lf[O_GL + fr] * __builtin_amdgcn_rcpf(gt)) : 0.f; }
#define XTY(X, Y, C0) __builtin_amdgcn_mfma_f32_16x16x32_bf16(mk_frag((u32x2){hw_pk2(X[0], X[1]), hw_pk2(X[2], X[3])}, zz), mk_frag((u32x2){hw_pk2(Y[0], Y[1]), hw_pk2(Y[2], Y[3])}, zz), C0, 0, 0, 0)
                const f32x4 z4 = {0.f, 0.f, 0.f, 0.f};
                f32x4 T1t = M1;
#pragma unroll
                for (int r = 0; r < 4; ++r) if (4 * g + r == fr) T1t[r] += 1.f;
                const f32x4 N2 = XTY(M1, N1, z4), M2 = XTY(N1, M1, z4);
                const f32x4 T2t = XTY(N2, T1t, T1t);
                const f32x4 N4 = XTY(M2, N2, z4), M4 = XTY(N2, M2, z4);
                const f32x4 T4t = XTY(N4, T2t, T2t);
                const f32x4 N8 = XTY(M4, N4, z4);
                const f32x4 T8t = XTY(N8, T4t, T4t);
#undef XTY
                u32x2 tw; tw.x = hw_pk2(T8t[0], T8t[1]); tw.y = hw_pk2(T8t[2], T8t[3]);
                *(LAS u32x2*)(TB + fr * 16 + 4 * g) = tw;
            } else {
#pragma unroll
                for (int r = 0; r < 4; ++r) { const int t = 4 * g + r; QKM[t * 16 + fr] = hw_bf((fr <= t) ? acc[r] * Lf[O_GL + t] * gs_inv : 0.f); }
            }
        }
        if (c + 1 < c_end) GD_XFORM((c + 1) & 1);
        if (c + 2 < c_end) GD_LOAD(c + 2);
        LBAR();
        f32x4 accu = {0.f, 0.f, 0.f, 0.f};
        {
            const bf16x8 tf = mk_frag(*(const LAS u32x2*)(TB + fr * 16 + 4 * g), zz);
            u32x2 ulo, wlo;
            { const float b0 = B_[O_SC + 16 + 4 * g + 0], b1 = B_[O_SC + 16 + 4 * g + 1], b2 = B_[O_SC + 16 + 4 * g + 2], b3 = B_[O_SC + 16 + 4 * g + 3];
              ulo.x = hw_pk2(b0 * B_[O_VV + (4 * g + 0) * 128 + c0 + fr], b1 * B_[O_VV + (4 * g + 1) * 128 + c0 + fr]); ulo.y = hw_pk2(b2 * B_[O_VV + (4 * g + 2) * 128 + c0 + fr], b3 * B_[O_VV + (4 * g + 3) * 128 + c0 + fr]);
              wlo.x = hw_pk2(Lf[O_WSRC + (4 * g + 0) * 128 + c0 + fr], Lf[O_WSRC + (4 * g + 1) * 128 + c0 + fr]); wlo.y = hw_pk2(Lf[O_WSRC + (4 * g + 2) * 128 + c0 + fr], Lf[O_WSRC + (4 * g + 3) * 128 + c0 + fr]); }
            accu = __builtin_amdgcn_mfma_f32_16x16x32_bf16(tf, mk_frag(ulo, zz), accu, 0, 0, 0);
            f32x4 accw = {0.f, 0.f, 0.f, 0.f};
            accw = __builtin_amdgcn_mfma_f32_16x16x32_bf16(tf, mk_frag(wlo, zz), accw, 0, 0, 0);
#pragma unroll
            for (int r = 0; r < 4; ++r) WB[(4 * g + r) * RS + c0 + fr] = hw_bf(-accw[r]);
        }
        LBAR();
        if (role == 0) {
            GD_STATE_PART(c);
        } else {
            float* rec = STASH + (size_t)(c - c_begin) * REC;
            for (int i = tid; i < 832; i += NTHREADS) { const int o = i < 528 ? O_QB + 4 * i : (i < 800 ? O_WB + 4 * (i - 528) : O_QKM + 4 * (i - 800)); *(GAS f32x4*)(rec + 4 * i) = *(const LAS f32x4*)(Lf + o); }
#pragma unroll
            for (int r = 0; r < 4; ++r) rec[3328 + (w * 4 + r) * 64 + lane] = accu[r];
            if (tid == 0) rec[5376] = glast;
        }
        LBAR();
    }
    if (role == 0) {
#pragma unroll
        for (int i = 0; i < 8; ++i)
#pragma unroll
            for (int r = 0; r < 4; ++r) STATE[((w * 8 + i) * 4 + r) * 64 + lane] = Sacc[i][r];
        asm volatile("s_waitcnt vmcnt(0)" ::: "memory");
        __syncthreads();
        if (tid == 0) { __builtin_amdgcn_fence(__ATOMIC_RELEASE, "agent"); asm volatile("s_waitcnt vmcnt(0)" ::: "memory"); __hip_atomic_store(flag, 1u, __ATOMIC_RELAXED, __HIP_MEMORY_SCOPE_AGENT); }
    } else {
        if (tid == 0) { unsigned sp = 0; while (__hip_atomic_load(flag, __ATOMIC_RELAXED, __HIP_MEMORY_SCOPE_AGENT) == 0u) { __builtin_amdgcn_s_sleep(8); if (++sp > (1u << 22)) break; }
            __builtin_amdgcn_fence(__ATOMIC_ACQUIRE, "agent"); asm volatile("s_waitcnt vmcnt(0)" ::: "memory"); }
        __syncthreads();
#pragma unroll
        for (int i = 0; i < 8; ++i)
#pragma unroll
            for (int r = 0; r < 4; ++r) Sacc[i][r] = STATE[((w * 8 + i) * 4 + r) * 64 + lane];
        f32x4 pa, pb; f32x4 pu; float pg;
#define GD_REC_LOAD(cc) do { const float* rec = STASH + (size_t)((cc) - c_begin) * REC; pa = *(const GAS f32x4*)(rec + 4 * tid); pb = (tid < 320) ? *(const GAS f32x4*)(rec + 4 * (tid + 512)) : (f32x4){0.f, 0.f, 0.f, 0.f}; \
            _Pragma("unroll") for (int r = 0; r < 4; ++r) pu[r] = rec[3328 + (w * 4 + r) * 64 + lane]; pg = rec[5376]; } while (0)
        GD_REC_LOAD(c_begin);
        for (int c = c_begin; c < c_end; ++c) {
            { const int i0 = tid, o0 = i0 < 528 ? O_QB + 4 * i0 : O_WB + 4 * (i0 - 528); *(LAS f32x4*)(Lf + o0) = pa;
              if (tid < 320) { const int i1 = tid + 512; const int o1 = i1 < 528 ? O_QB + 4 * i1 : (i1 < 800 ? O_WB + 4 * (i1 - 528) : O_QKM + 4 * (i1 - 800)); *(LAS f32x4*)(Lf + o1) = pb; } }
            const f32x4 accu = pu; const float glast = pg;
            if (c + 1 < c_end) GD_REC_LOAD(c + 1);
            LBAR();
            GD_STATE_PART(c);
            LBAR();
        }
#undef GD_REC_LOAD
    }
#undef GD_STATE_PART
#undef GD_LOAD
#undef GD_XFORM
}

__device__ __forceinline__ void scan_rwkv_unit(const Args& A, Frame& F, int unit) {
    int tid = F.tid; asm volatile("" : "+v"(tid));
    const int lane = tid & 63, w = F.wave;
    const int b = unit >> 4, h = unit & 15;
    const bf16* P = (const bf16*)(A.ws + WS_PROJ) + (size_t)b * SEQ * PROJ_LD + OC_RW;
    const bf16* LO = (const bf16*)(A.ws + WS_LO) + (size_t)b * SEQ * LORA_N;
    bf16* Y = (bf16*)(A.ws + WS_ACTA) + (size_t)b * SEQ * D + 1024 + h * 64;
    LAS float* Lf = (LAS float*)(F.lds + RING_OFF);
    constexpr int BUFSZ = 6208, O_KK = 0, O_WR = 1024, O_W = 2048, O_NKA = 3072, O_K = 4096, O_V = 5120, O_SC = 6144, O_OUT = 2 * BUFSZ;
    const int tl = tid >> 5, d2 = (tid & 31) * 2, hd = h * 64 + d2;
    float mu_r[2], mu_k[2], mu_v[2], w0[2], a0[2], k_k[2], k_a[2], r_k[2], lnw[2], lnb[2];
#pragma unroll
    for (int i = 0; i < 2; ++i) { mu_r[i] = A.in[I_MU][RW_R + hd + i]; mu_k[i] = A.in[I_MU][RW_K + hd + i]; mu_v[i] = A.in[I_MU][RW_V + hd + i];
        w0[i] = A.in[I_W0][hd + i]; a0[i] = A.in[I_A0][hd + i]; k_k[i] = A.in[I_KK][hd + i]; k_a[i] = A.in[I_KA][hd + i]; r_k[i] = A.in[I_RK][hd + i];
        lnw[i] = A.in[I_LNW][hd + i]; lnb[i] = A.in[I_LNB][hd + i]; }
    unsigned rr[2], rk[2], rv[2], rlw, rla, rg_cur = 0u, rg_nxt = 0u;
#define RW_LOAD(c) do { const int t_ = (c) * TC + tl; const bf16* pr = P + (size_t)t_ * PROJ_LD; \
        rr[0] = *(const GAS unsigned*)(pr + RW_R + hd); rk[0] = *(const GAS unsigned*)(pr + RW_K + hd); rv[0] = *(const GAS unsigned*)(pr + RW_V + hd); \
        if (t_ > 0) { rr[1] = *(const GAS unsigned*)(pr - PROJ_LD + RW_R + hd); rk[1] = *(const GAS unsigned*)(pr - PROJ_LD + RW_K + hd); rv[1] = *(const GAS unsigned*)(pr - PROJ_LD + RW_V + hd); } \
        else { rr[1] = 0u; rk[1] = 0u; rv[1] = 0u; } \
        const bf16* lr = LO + (size_t)t_ * LORA_N; rlw = *(const GAS unsigned*)(lr + hd); rla = *(const GAS unsigned*)(lr + 1024 + hd); rg_nxt = *(const GAS unsigned*)(lr + 2048 + hd); } while (0)
#define RW_XFORM(bufi) do { LAS float* B_ = Lf + (bufi) * BUFSZ; f32x2 kk2, wr2, w2_, nka2, k2, v2_; float skk = 0.f, sc1 = 0.f, sc2 = 0.f, sbs = 0.f; float aa[2], rrv[2]; \
        _Pragma("unroll") for (int i_ = 0; i_ < 2; ++i_) { \
            const float r0 = i_ ? bf_hi(rr[0]) : bf_lo(rr[0]), r1 = i_ ? bf_hi(rr[1]) : bf_lo(rr[1]); \
            const float k0_ = i_ ? bf_hi(rk[0]) : bf_lo(rk[0]), k1_ = i_ ? bf_hi(rk[1]) : bf_lo(rk[1]); \
            const float v0_ = i_ ? bf_hi(rv[0]) : bf_lo(rv[0]), v1_ = i_ ? bf_hi(rv[1]) : bf_lo(rv[1]); \
            const float lw = i_ ? bf_hi(rlw) : bf_lo(rlw), la = i_ ? bf_hi(rla) : bf_lo(rla); \
            const float r_ = r0 + (r1 - r0) * mu_r[i_], kx = k0_ + (k1_ - k0_) * mu_k[i_], vx = v0_ + (v1_ - v0_) * mu_v[i_]; \
            const float wd = __expf(-0.6065306597126334f * sigmoidf_(w0[i_] + lw)); const float a_ = sigmoidf_(a0[i_] + la); \
            const float kk0 = kx * k_k[i_]; const float km = kx * (1.f + (a_ - 1.f) * k_a[i_]); \
            kk2[i_] = kk0; skk += kk0 * kk0; aa[i_] = a_; rrv[i_] = r_; wr2[i_] = wd * r_; w2_[i_] = wd; k2[i_] = km; v2_[i_] = vx; sc2 += km * r_; sbs += r_ * km * r_k[i_]; } \
        skk = half_sum32(skk); const float rkk = __builtin_amdgcn_rsqf(skk + EPS); \
        _Pragma("unroll") for (int i_ = 0; i_ < 2; ++i_) { kk2[i_] *= rkk; nka2[i_] = -(kk2[i_] * aa[i_]); sc1 += kk2[i_] * aa[i_] * rrv[i_]; } \
        sc1 = half_sum32(sc1); sc2 = half_sum32(sc2); sbs = half_sum32(sbs); \
        *(LAS f32x2*)(B_ + O_KK + tl * 64 + d2) = kk2; *(LAS f32x2*)(B_ + O_WR + tl * 64 + d2) = wr2; *(LAS f32x2*)(B_ + O_W + tl * 64 + d2) = w2_; \
        *(LAS f32x2*)(B_ + O_NKA + tl * 64 + d2) = nka2; *(LAS f32x2*)(B_ + O_K + tl * 64 + d2) = k2; *(LAS f32x2*)(B_ + O_V + tl * 64 + d2) = v2_; \
        if ((tid & 31) == 0) { f32x4 sc; sc[0] = sc1; sc[1] = sc2; sc[2] = sbs; sc[3] = 0.f; *(LAS f32x4*)(B_ + O_SC + tl * 4) = sc; } } while (0)
    RW_LOAD(0); RW_XFORM(0); rg_cur = rg_nxt;
    LBAR();
    f32x2 S2[4];
#pragma unroll
    for (int i = 0; i < 4; ++i) S2[i] = (f32x2){0.f, 0.f};
    const int j = lane & 15, col = w * 8 + (lane >> 4) * 2;
    for (int c = 0; c < NCHUNK; ++c) {
        if (c + 1 < NCHUNK) RW_LOAD(c + 1);
        const LAS float* B_ = Lf + (c & 1) * BUFSZ;
        float os0 = 0.f, os1 = 0.f;
        f32x4 kk, wr, ww, nka, kv, sc, nkk, nwr, nww, nnka, nkv, nsc; f32x2 v2, nv2;
#define RW_LDSTEP(t_, KK, WR, WW, NKA, KV, V2, SC) do { KK = *(const LAS f32x4*)(B_ + O_KK + (t_) * 64 + 4 * j); WR = *(const LAS f32x4*)(B_ + O_WR + (t_) * 64 + 4 * j); WW = *(const LAS f32x4*)(B_ + O_W + (t_) * 64 + 4 * j); \
            NKA = *(const LAS f32x4*)(B_ + O_NKA + (t_) * 64 + 4 * j); KV = *(const LAS f32x4*)(B_ + O_K + (t_) * 64 + 4 * j); V2 = *(const LAS f32x2*)(B_ + O_V + (t_) * 64 + col); SC = *(const LAS f32x4*)(B_ + O_SC + (t_) * 4); } while (0)
        RW_LDSTEP(0, kk, wr, ww, nka, kv, v2, sc);
#pragma unroll
        for (int t = 0; t < TC; ++t) {
            if (t + 1 < TC) { RW_LDSTEP(t + 1, nkk, nwr, nww, nnka, nkv, nv2, nsc); }
            __builtin_amdgcn_sched_barrier(0);
            f32x2 d1 = S2[0] * kk[0], d2 = S2[0] * wr[0], e1 = S2[1] * kk[1], e2 = S2[1] * wr[1];
            d1 += S2[2] * kk[2]; d2 += S2[2] * wr[2]; e1 += S2[3] * kk[3]; e2 += S2[3] * wr[3];
            d1 += e1; d2 += e2;
            { float r0_ = d1[0], r1_ = d1[1], r2_ = d2[0], r3_ = d2[1]; row_sum16_x4(r0_, r1_, r2_, r3_); d1[0] = r0_; d1[1] = r1_; d2[0] = r2_; d2[1] = r3_; }
            const f32x2 o2 = d2 - d1 * sc[0] + v2 * sc[1];
#pragma unroll
            for (int i = 0; i < 4; ++i) S2[i] = S2[i] * ww[i] + d1 * nka[i] + v2 * kv[i];
            os0 = (j == t) ? o2[0] : os0; os1 = (j == t) ? o2[1] : os1;
            kk = nkk; wr = nwr; ww = nww; nka = nnka; kv = nkv; v2 = nv2; sc = nsc;
        }
#undef RW_LDSTEP
        { f32x2 o2 = {os0, os1}; *(LAS f32x2*)(Lf + O_OUT + j * 64 + col) = o2; }
        if (c + 1 < NCHUNK) RW_XFORM((c + 1) & 1);
        LBAR();
        {
            const f32x2 o2 = *(const LAS f32x2*)(Lf + O_OUT + tl * 64 + d2); const f32x2 vv = *(const LAS f32x2*)(B_ + O_V + tl * 64 + d2); const float bs = B_[O_SC + tl * 4 + 2];
            const float mean = half_sum32(o2[0] + o2[1]) * (1.0f / 64.0f); const float e0 = o2[0] - mean, e1 = o2[1] - mean;
            const float var = half_sum32(e0 * e0 + e1 * e1) * (1.0f / 64.0f); const float rs = __builtin_amdgcn_rsqf(var + 64e-5f);
            const float y0 = (e0 * rs * lnw[0] + lnb[0] + bs * vv[0]) * bf_lo(rg_cur), y1 = (e1 * rs * lnw[1] + lnb[1] + bs * vv[1]) * bf_hi(rg_cur);
            *(GAS unsigned*)(Y + (size_t)(c * TC + tl) * D + d2) = pk2(y0, y1);
        }
        rg_cur = rg_nxt;
        LBAR();
    }
#undef RW_LOAD
#undef RW_XFORM
}

template <int LAYER>
__device__ __forceinline__ void post_rows(const Args& A, Frame& F) {
    const int gw = F.vcu * NWAVES + F.wave, NGW = F.G * NWAVES, lane = F.lane;
    const bf16* O = (const bf16*)(A.ws + WS_O); const bf16* P = (const bf16*)(A.ws + WS_PROJ); bf16* Y = (bf16*)(A.ws + WS_ACTA);
    for (int m = gw; m < T; m += NGW) {
        const GAS u32x2* orow = (const GAS u32x2*)(O + (size_t)m * D) + lane; const bf16* prow = P + (size_t)m * PROJ_LD;
        constexpr int NJ = LAYER == 0 ? 8 : 4;
#pragma unroll
        for (int jj = 0; jj < NJ; ++jj) {
            const u32x2 ow_ = orow[64 * jj]; const f32x4 v = {bf_lo(ow_.x), bf_hi(ow_.x), bf_lo(ow_.y), bf_hi(ow_.y)}; float ss = (v[0] * v[0] + v[1] * v[1]) + (v[2] * v[2] + v[3] * v[3]);
            const bool wide = (LAYER == 0 && jj < 4);
            const float ms = wide ? wave_sum(ss) * (1.0f / 256.0f) : half_sum32(ss) * (1.0f / 128.0f);
            const float r = __builtin_amdgcn_rsqf(ms + EPS);
            const int cih = wide ? 4 * lane : 4 * (lane & 31);
            const float* gsrc = LAYER == 0 ? (wide ? A.in[I_GLA_NORM] : A.in[I_GDN_NORM]) : A.in[I_HG_NORM];
            const f32x4 g = *(const GAS f32x4*)(gsrc + cih);
            const int zcol = LAYER == 0 ? (wide ? EC_GZ + jj * 256 + 4 * lane : EC_BZ + (jj - 4) * 256 + 4 * lane) : OC_HG + jj * 256 + 4 * lane;
            const u32x2 zw = *(const GAS u32x2*)(prow + zcol);
            const float y0 = v[0] * r * g[0] * siluf_(bf_lo(zw.x)), y1 = v[1] * r * g[1] * siluf_(bf_hi(zw.x)), y2 = v[2] * r * g[2] * siluf_(bf_lo(zw.y)), y3 = v[3] * r * g[3] * siluf_(bf_hi(zw.y));
            if constexpr (LAYER == 1) { int o8 = __builtin_amdgcn_cvt_pk_fp8_f32(y0, y1, 0, false); o8 = __builtin_amdgcn_cvt_pk_fp8_f32(y2, y3, o8, true);
                *(GAS unsigned*)((unsigned char*)Y + (size_t)m * D + 256 * jj + 4 * lane) = (unsigned)o8; }
            else { u32x2 o; o.x = pk2(y0, y1); o.y = pk2(y2, y3);
                *(GAS u32x2*)(Y + (size_t)m * D + 256 * jj + 4 * lane) = o; }
        }
    }
}
__device__ __forceinline__ void lora_prep_rows(const Args& A, Frame& F) {
    const int gw = F.vcu * NWAVES + F.wave, NGW = F.G * NWAVES, lane = F.lane;
    const bf16* P = (const bf16*)(A.ws + WS_PROJ); bf16* LA = (bf16*)(A.ws + WS_LA); const float* mu = A.in[I_MU];
    for (int m = gw; m < T; m += NGW) { const bool hasprev = (m % SEQ) != 0; const bf16* prow = P + (size_t)m * PROJ_LD + OC_RW + RW_WL;
#pragma unroll
        for (int i = 0; i < 7; ++i) { const int c = lane + 64 * i;
            const float x = __uint_as_float((unsigned)prow[c] << 16), xp = hasprev ? __uint_as_float((unsigned)prow[c - PROJ_LD] << 16) : 0.f;
            const float ts = x + (xp - x) * mu[RW_WL + c];
            const float v = c < 96 ? tanhf(ts) : (c < 192 ? ts : sigmoidf_(ts));
            LA[(size_t)m * LORA_K + c] = (bf16)f2bf(v); }
        LA[(size_t)m * LORA_K + 448 + lane] = (bf16)0; }
}
__device__ __forceinline__ void final_rows(const Args& A, Frame& F, const float oscale, const bf16* Hs) {
    const int gw = F.vcu * NWAVES + F.wave, NGW = F.G * NWAVES, lane = F.lane;
    const float* rowss = (const float*)(A.ws + WS_RSP) + (size_t)RS_FINAL * T * 32; const GAS f32x4* g = (const GAS f32x4*)A.in[I_NFINAL] + lane;
    for (int m = gw; m < T; m += NGW) { const float r = oscale * __builtin_amdgcn_rsqf(wave_sum(lane < 32 ? rowss[(size_t)m * 32 + lane] : 0.f) * (1.0f / D) + EPS); GAS f32x4* row = (GAS f32x4*)(A.out + (size_t)m * D) + lane;
        const GAS u32x2* hrow = (const GAS u32x2*)(Hs + (size_t)m * D) + lane;
#pragma unroll
        for (int jj = 0; jj < 8; ++jj) { const u32x2 hw = hrow[64 * jj]; const f32x4 v = {bf_lo(hw.x), bf_hi(hw.x), bf_lo(hw.y), bf_hi(hw.y)}; row[64 * jj] = v * r * g[64 * jj]; } }
}

__device__ __forceinline__ void scan_rwkv_mfma_unit(const Args& A, Frame& F, int unit, const int role) {
    int tid = F.tid; asm volatile("" : "+v"(tid));
    const int lane = tid & 63, w = F.wave;
    const int b = unit >> 3, hp = unit & 7;
    const bf16* P = (const bf16*)(A.ws + WS_PROJ) + (size_t)b * SEQ * PROJ_LD + OC_RW;
    const bf16* LO = (const bf16*)(A.ws + WS_LO) + (size_t)b * SEQ * LORA_N;
    unsigned char* Y = (unsigned char*)(A.ws + WS_ACTA) + (size_t)b * SEQ * D + 1024;
    LAS float* Lf = (LAS float*)(F.lds + RING_OFF);
    constexpr int RS = 72;
    constexpr int O_CONST = 0;
    constexpr int O_XF = 1280;
    constexpr int O_VV = O_XF + 2 * 5 * 1024;
    constexpr int O_BS = O_VV + 4 * 1024;
    constexpr int O_IMG = O_BS + 64;
    constexpr int I_CT = 0, I_BT = 576, I_KL = 1152, I_RT = 1728, I_CF = 2304, I_BTT = 3328, I_KTT = 3840, I_WCB = 4352, I_G1B = 4928, I_TTB = 5056, I_RKB = 5184, I_RBB = 5312, I_W15 = 5440, I_OUT = 5504, IMGSZ = 6528;
    static_assert((O_IMG + 2 * IMGSZ) * 4 <= RING_BYTES, "rwkv lds");
    for (int i = tid; i < 1280; i += NTHREADS) { const int arr = i >> 7, ch = hp * 128 + (i & 127); float v;
        switch (arr) { case 0: v = A.in[I_MU][RW_R + ch]; break; case 1: v = A.in[I_MU][RW_K + ch]; break; case 2: v = A.in[I_MU][RW_V + ch]; break; case 3: v = A.in[I_W0][ch]; break; case 4: v = A.in[I_A0][ch]; break;
                       case 5: v = A.in[I_KK][ch]; break; case 6: v = A.in[I_KA][ch]; break; case 7: v = A.in[I_RK][ch]; break; case 8: v = A.in[I_LNW][ch]; break; default: v = A.in[I_LNB][ch]; break; }
        Lf[O_CONST + i] = v; }
    const int hx = tid >> 8, tl = (tid >> 4) & 15, d4 = (tid & 15) * 4, ch4 = hx * 64 + d4, col4 = hp * 128 + ch4;
    u32x2 rr[2], rk[2], rv[2], rlw, rla, rg_cur = {0u, 0u}, rg_nxt = {0u, 0u}, rg_far = {0u, 0u};
#define RM_LOAD(c) do { const int t_ = (c) * TC + tl; const bf16* pr = P + (size_t)t_ * PROJ_LD + col4; \
        rr[0] = *(const GAS u32x2*)(pr + RW_R); rk[0] = *(const GAS u32x2*)(pr + RW_K); rv[0] = *(const GAS u32x2*)(pr + RW_V); \
        const bf16* pp_ = (t_ > 0) ? pr - PROJ_LD : pr; rr[1] = *(const GAS u32x2*)(pp_ + RW_R); rk[1] = *(const GAS u32x2*)(pp_ + RW_K); rv[1] = *(const GAS u32x2*)(pp_ + RW_V); \
        if (t_ == 0) { rr[1] = (u32x2){0u, 0u}; rk[1] = (u32x2){0u, 0u}; rv[1] = (u32x2){0u, 0u}; } \
        const bf16* lr = LO + (size_t)t_ * LORA_N + col4; rlw = *(const GAS u32x2*)(lr); rla = *(const GAS u32x2*)(lr + 1024); rg_far = *(const GAS u32x2*)(lr + 2048); } while (0)
#define RM_XFORM(bufi) do { LAS float* X_ = Lf + O_XF + hx * 5 * 1024 + tl * 64 + d4; \
        const f32x4 mur = *(const LAS f32x4*)(Lf + O_CONST + 0 * 128 + ch4), muk = *(const LAS f32x4*)(Lf + O_CONST + 1 * 128 + ch4), muv = *(const LAS f32x4*)(Lf + O_CONST + 2 * 128 + ch4); \
        const f32x4 w0_ = *(const LAS f32x4*)(Lf + O_CONST + 3 * 128 + ch4), a0_ = *(const LAS f32x4*)(Lf + O_CONST + 4 * 128 + ch4), kk_ = *(const LAS f32x4*)(Lf + O_CONST + 5 * 128 + ch4); \
        const f32x4 ka_ = *(const LAS f32x4*)(Lf + O_CONST + 6 * 128 + ch4), rk_ = *(const LAS f32x4*)(Lf + O_CONST + 7 * 128 + ch4); \
        const float r0[4] = {bf_lo(rr[0].x), bf_hi(rr[0].x), bf_lo(rr[0].y), bf_hi(rr[0].y)}, r1[4] = {bf_lo(rr[1].x), bf_hi(rr[1].x), bf_lo(rr[1].y), bf_hi(rr[1].y)}; \
        const float k0[4] = {bf_lo(rk[0].x), bf_hi(rk[0].x), bf_lo(rk[0].y), bf_hi(rk[0].y)}, k1[4] = {bf_lo(rk[1].x), bf_hi(rk[1].x), bf_lo(rk[1].y), bf_hi(rk[1].y)}; \
        const float v0[4] = {bf_lo(rv[0].x), bf_hi(rv[0].x), bf_lo(rv[0].y), bf_hi(rv[0].y)}, v1[4] = {bf_lo(rv[1].x), bf_hi(rv[1].x), bf_lo(rv[1].y), bf_hi(rv[1].y)}; \
        const float lw[4] = {bf_lo(rlw.x), bf_hi(rlw.x), bf_lo(rlw.y), bf_hi(rlw.y)}, la[4] = {bf_lo(rla.x), bf_hi(rla.x), bf_lo(rla.y), bf_hi(rla.y)}; \
        f32x4 r4, w4, k4, v4, kk4, b4; float skk = 0.f, sbs = 0.f; float aa[4]; \
        _Pragma("unroll") for (int i_ = 0; i_ < 4; ++i_) { const float r_ = r0[i_] + (r1[i_] - r0[i_]) * mur[i_], kx = k0[i_] + (k1[i_] - k0[i_]) * muk[i_], vx = v0[i_] + (v1[i_] - v0[i_]) * muv[i_]; \
            const float wd = __expf(-0.6065306597126334f * sigmoidf_(w0_[i_] + lw[i_])); const float a_ = sigmoidf_(a0_[i_] + la[i_]); \
            const float kk0 = kx * kk_[i_], km = kx * (1.f + (a_ - 1.f) * ka_[i_]); \
            r4[i_] = r_; w4[i_] = wd; k4[i_] = km; v4[i_] = vx; kk4[i_] = kk0; aa[i_] = a_; skk += kk0 * kk0; sbs += r_ * km * rk_[i_]; } \
        row_sum16_x2(skk, sbs); const float rkk = __builtin_amdgcn_rsqf(skk + EPS); \
        _Pragma("unroll") for (int i_ = 0; i_ < 4; ++i_) { kk4[i_] *= rkk; b4[i_] = kk4[i_] * aa[i_]; } \
        *(LAS f32x4*)(X_) = r4; *(LAS f32x4*)(X_ + 1024) = w4; *(LAS f32x4*)(X_ + 2048) = k4; *(LAS f32x4*)(X_ + 3072) = kk4; *(LAS f32x4*)(X_ + 4096) = b4; \
        *(LAS f32x4*)(Lf + O_VV + ((bufi) * 2 + hx) * 1024 + tl * 64 + d4) = v4; \
        if ((tid & 15) == 0) Lf[O_BS + ((bufi) * 2 + hx) * 16 + tl] = sbs; } while (0)
    constexpr int SPLIT = 60;
    const int c_begin = role ? SPLIT : 0, c_end = role ? NCHUNK : SPLIT;
    constexpr int REC = 7584;
    float* STASH = (float*)(A.ws + (unit < 32 ? WS_WEV_IN : WS_END)) + (size_t)(unit & 31) * (NCHUNK - SPLIT) * REC;
    float* STATE = (float*)(A.ws + WS_STATE + 4 * MiB) + (size_t)unit * 8192;
    gu32* flag = F.ctl + 49152 + unit * 64;
    LBAR();
    RM_LOAD(c_begin); RM_XFORM(c_begin & 1); rg_cur = rg_far; RM_LOAD(c_begin + 1); rg_nxt = rg_far;
    LBAR();
    f32x4 Macc[4];
#pragma unroll
    for (int i = 0; i < 4; ++i) Macc[i] = (f32x4){0.f, 0.f, 0.f, 0.f};
    const int fr = lane & 15, g = lane >> 4, hh = w >> 2, ww = w & 3, c0 = ww * 16;
    LAS float* IM = Lf + O_IMG + hh * IMGSZ;
    LAS bf16* CT = (LAS bf16*)(IM + I_CT); LAS bf16* BT = (LAS bf16*)(IM + I_BT); LAS bf16* KL = (LAS bf16*)(IM + I_KL); LAS bf16* RT = (LAS bf16*)(IM + I_RT);
    LAS bf16* BTT = (LAS bf16*)(IM + I_BTT); LAS bf16* KTT = (LAS bf16*)(IM + I_KTT); LAS bf16* WCB = (LAS bf16*)(IM + I_WCB);
    LAS bf16* G1B = (LAS bf16*)(IM + I_G1B); LAS bf16* TTB = (LAS bf16*)(IM + I_TTB); LAS bf16* RKB = (LAS bf16*)(IM + I_RKB); LAS bf16* RBB = (LAS bf16*)(IM + I_RBB);
    const u32x2 zz = {0u, 0u};
#define RM_STATE_PART(vb) do { \
        { \
            bf16x8 mb[2]; \
_Pragma("unroll") \
            for (int ks = 0; ks < 2; ++ks) { u32x2 slo, shi; slo.x = hw_pk2(Macc[2 * ks][0], Macc[2 * ks][1]); slo.y = hw_pk2(Macc[2 * ks][2], Macc[2 * ks][3]); shi.x = hw_pk2(Macc[2 * ks + 1][0], Macc[2 * ks + 1][1]); shi.y = hw_pk2(Macc[2 * ks + 1][2], Macc[2 * ks + 1][3]); \
                mb[ks] = mk_frag(slo, shi); } \
            f32x4 accR = accU, acco = {0.f, 0.f, 0.f, 0.f}; \
_Pragma("unroll") \
            for (int ks = 0; ks < 2; ++ks) { \
                accR = __builtin_amdgcn_mfma_f32_16x16x32_bf16(mk_frag(*(const LAS u32x2*)(WCB + fr * RS + 32 * ks + 4 * g), *(const LAS u32x2*)(WCB + fr * RS + 32 * ks + 16 + 4 * g)), mb[ks], accR, 0, 0, 0); \
                acco = __builtin_amdgcn_mfma_f32_16x16x32_bf16(mk_frag(*(const LAS u32x2*)(RT + fr * RS + 32 * ks + 4 * g), *(const LAS u32x2*)(RT + fr * RS + 32 * ks + 16 + 4 * g)), mb[ks], acco, 0, 0, 0); } \
            u32x2 rn; rn.x = hw_pk2(accR[0], accR[1]); rn.y = hw_pk2(accR[2], accR[3]); \
            const bf16x8 rb = mk_frag(rn, zz); \
            acco = __builtin_amdgcn_mfma_f32_16x16x32_bf16(mk_frag(*(const LAS u32x2*)(RKB + fr * 16 + 4 * g), zz), vb, acco, 0, 0, 0); \
            acco = __builtin_amdgcn_mfma_f32_16x16x32_bf16(mk_frag(*(const LAS u32x2*)(RBB + fr * 16 + 4 * g), zz), rb, acco, 0, 0, 0); \
_Pragma("unroll") \
            for (int r = 0; r < 4; ++r) IM[I_OUT + (4 * g + r) * 64 + c0 + fr] = acco[r]; \
_Pragma("unroll") \
            for (int i = 0; i < 4; ++i) { const f32x4 w15 = *(const LAS f32x4*)(IM + I_W15 + 16 * i + 4 * g); \
                f32x4 m = __builtin_amdgcn_mfma_f32_16x16x32_bf16(mk_frag(*(const LAS u32x2*)(KTT + (16 * i + fr) * 16 + 4 * g), zz), vb, Macc[i], 0, 0, 0); \
                m = __builtin_amdgcn_mfma_f32_16x16x32_bf16(mk_frag(*(const LAS u32x2*)(BTT + (16 * i + fr) * 16 + 4 * g), zz), rb, m, 0, 0, 0); \
                Macc[i] = m * w15; } \
        } \
        } while (0)
#define RM_FLUSH(cc_, gb_, vv_, bs_) do { \
        { \
            const f32x4 o4 = *(const LAS f32x4*)(Lf + O_IMG + hx * IMGSZ + I_OUT + tl * 64 + d4); const f32x4 vv = (vv_); const float bs = (bs_); \
            const f32x4 lnw = *(const LAS f32x4*)(Lf + O_CONST + 8 * 128 + ch4), lnb = *(const LAS f32x4*)(Lf + O_CONST + 9 * 128 + ch4); \
            float sm = (o4[0] + o4[1]) + (o4[2] + o4[3]), dummy = 0.f; row_sum16_x2(sm, dummy); const float mean = sm * (1.0f / 64.0f); \
            const f32x4 e4 = o4 - mean; float sv = (e4[0] * e4[0] + e4[1] * e4[1]) + (e4[2] * e4[2] + e4[3] * e4[3]); row_sum16_x2(sv, dummy); const float rs = __builtin_amdgcn_rsqf(sv * (1.0f / 64.0f) + 64e-5f); \
            const float gg[4] = {bf_lo((gb_).x), bf_hi((gb_).x), bf_lo((gb_).y), bf_hi((gb_).y)}; \
            float y[4]; \
_Pragma("unroll") \
            for (int i = 0; i < 4; ++i) y[i] = (e4[i] * rs * lnw[i] + lnb[i] + bs * vv[i]) * gg[i]; \
            int o8 = __builtin_amdgcn_cvt_pk_fp8_f32(y[0], y[1], 0, false); o8 = __builtin_amdgcn_cvt_pk_fp8_f32(y[2], y[3], o8, true); \
            *(GAS unsigned*)(Y + (size_t)((cc_) * TC + tl) * D + col4) = (unsigned)o8; \
        } \
        } while (0)
    for (int c = c_begin; c < c_end; ++c) {
        {
            const int hq = tid >> 8, seg = (tid >> 6) & 3, d = tid & 63;
            const LAS float* X_ = Lf + O_XF + hq * 5 * 1024 + d; LAS float* IQ = Lf + O_IMG + hq * IMGSZ;
            LAS bf16* CTq = (LAS bf16*)(IQ + I_CT); LAS bf16* BTq = (LAS bf16*)(IQ + I_BT); LAS bf16* KLq = (LAS bf16*)(IQ + I_KL); LAS bf16* RTq = (LAS bf16*)(IQ + I_RT);
            float wall = 1.f, wpre = 1.f;
#pragma unroll
            for (int t = 0; t < 16; ++t) { if (t == 4 * seg) wpre = wall; wall *= X_[1024 + t * 64]; }
            float wt = wpre; unsigned short bt4[4], kt4[4];
#pragma unroll
            for (int i = 0; i < 4; ++i) { const int t = 4 * seg + i; const float wprev = wt; wt *= X_[1024 + t * 64]; const float iw = __builtin_amdgcn_rcpf(wt);
                const float r_ = X_[t * 64], k_ = X_[2048 + t * 64], kk_ = X_[3072 + t * 64], b_ = X_[4096 + t * 64];
                const float ct = kk_ * wprev, bt = b_ * iw, kt = k_ * iw;
                CTq[t * RS + d] = hw_bf(ct); IQ[I_CF + t * 64 + d] = ct; BTq[t * RS + d] = hw_bf(bt); KLq[t * RS + d] = hw_bf(kt); RTq[t * RS + d] = hw_bf(r_ * wt);
                bt4[i] = (unsigned short)hw_bf(-bt); kt4[i] = (unsigned short)hw_bf(kt); }
            u32x2 o; o.x = (unsigned)bt4[0] | ((unsigned)bt4[1] << 16); o.y = (unsigned)bt4[2] | ((unsigned)bt4[3] << 16); *(LAS u32x2*)((LAS bf16*)(IQ + I_BTT) + d * 16 + 4 * seg) = o;
            o.x = (unsigned)kt4[0] | ((unsigned)kt4[1] << 16); o.y = (unsigned)kt4[2] | ((unsigned)kt4[3] << 16); *(LAS u32x2*)((LAS bf16*)(IQ + I_KTT) + d * 16 + 4 * seg) = o;
            if (seg == 3) IQ[I_W15 + d] = wall;
        }
        LBAR();
        if (ww == 0) {
            f32x4 cb = {0.f, 0.f, 0.f, 0.f}, bc = cb, ck = cb, rkm = cb, rbm = cb;
#pragma unroll
            for (int ks = 0; ks < 2; ++ks) { const bf16x8 fc = *(const LAS bf16x8*)(CT + fr * RS + 32 * ks + 8 * g), fb = *(const LAS bf16x8*)(BT + fr * RS + 32 * ks + 8 * g), fk = *(const LAS bf16x8*)(KL + fr * RS + 32 * ks + 8 * g), frr = *(const LAS bf16x8*)(RT + fr * RS + 32 * ks + 8 * g);
                cb = __builtin_amdgcn_mfma_f32_16x16x32_bf16(fc, fb, cb, 0, 0, 0); bc = __builtin_amdgcn_mfma_f32_16x16x32_bf16(fb, fc, bc, 0, 0, 0); ck = __builtin_amdgcn_mfma_f32_16x16x32_bf16(fc, fk, ck, 0, 0, 0);
                rkm = __builtin_amdgcn_mfma_f32_16x16x32_bf16(frr, fk, rkm, 0, 0, 0); rbm = __builtin_amdgcn_mfma_f32_16x16x32_bf16(frr, fb, rbm, 0, 0, 0); }
            f32x4 N1, M1, CKm;
#pragma unroll
            for (int r = 0; r < 4; ++r) { const int t = 4 * g + r; N1[r] = (fr < t) ? -cb[r] : 0.f; M1[r] = (t < fr) ? -bc[r] : 0.f; CKm[r] = (fr < t) ? ck[r] : 0.f;
                RKB[t * 16 + fr] = hw_bf((fr <= t) ? rkm[r] : 0.f); RBB[t * 16 + fr] = hw_bf((fr <= t) ? -rbm[r] : 0.f); }
#define XTY(X, Y, C0) __builtin_amdgcn_mfma_f32_16x16x32_bf16(mk_frag((u32x2){hw_pk2(X[0], X[1]), hw_pk2(X[2], X[3])}, zz), mk_frag((u32x2){hw_pk2(Y[0], Y[1]), hw_pk2(Y[2], Y[3])}, zz), C0, 0, 0, 0)
            const f32x4 z4 = {0.f, 0.f, 0.f, 0.f};
            f32x4 T1t = M1;
#pragma unroll
            for (int r = 0; r < 4; ++r) if (4 * g + r == fr) T1t[r] += 1.f;
            const f32x4 N2 = XTY(M1, N1, z4), M2 = XTY(N1, M1, z4);
            const f32x4 T2t = XTY(N2, T1t, T1t);
            const f32x4 N4 = XTY(M2, N2, z4), M4 = XTY(N2, M2, z4);
            const f32x4 T4t = XTY(N4, T2t, T2t);
            const f32x4 N8 = XTY(M4, N4, z4);
            const f32x4 T8t = XTY(N8, T4t, T4t);
            const f32x4 G1t = XTY(CKm, T8t, z4);
#undef XTY
            u32x2 tw; tw.x = hw_pk2(T8t[0], T8t[1]); tw.y = hw_pk2(T8t[2], T8t[3]); *(LAS u32x2*)(TTB + fr * 16 + 4 * g) = tw;
            tw.x = hw_pk2(G1t[0], G1t[1]); tw.y = hw_pk2(G1t[2], G1t[3]); *(LAS u32x2*)(G1B + fr * 16 + 4 * g) = tw;
        }
        if (c + 1 < c_end) { RM_XFORM((c + 1) & 1); }
        if (c + 2 < c_end) RM_LOAD(c + 2);
        LBAR();
        const LAS float* VVc = Lf + O_VV + ((c & 1) * 2 + hh) * 1024;
        u32x2 vlo; { vlo.x = hw_pk2(VVc[(4 * g + 0) * 64 + c0 + fr], VVc[(4 * g + 1) * 64 + c0 + fr]); vlo.y = hw_pk2(VVc[(4 * g + 2) * 64 + c0 + fr], VVc[(4 * g + 3) * 64 + c0 + fr]); }
        const bf16x8 vb = mk_frag(vlo, zz);
        f32x4 accU = {0.f, 0.f, 0.f, 0.f};
        {
            accU = __builtin_amdgcn_mfma_f32_16x16x32_bf16(mk_frag(*(const LAS u32x2*)(G1B + fr * 16 + 4 * g), zz), vb, accU, 0, 0, 0);
            u32x2 clo; clo.x = hw_pk2(IM[I_CF + (4 * g + 0) * 64 + c0 + fr], IM[I_CF + (4 * g + 1) * 64 + c0 + fr]); clo.y = hw_pk2(IM[I_CF + (4 * g + 2) * 64 + c0 + fr], IM[I_CF + (4 * g + 3) * 64 + c0 + fr]);
            f32x4 accw = {0.f, 0.f, 0.f, 0.f};
            accw = __builtin_amdgcn_mfma_f32_16x16x32_bf16(mk_frag(*(const LAS u32x2*)(TTB + fr * 16 + 4 * g), zz), mk_frag(clo, zz), accw, 0, 0, 0);
#pragma unroll
            for (int r = 0; r < 4; ++r) WCB[(4 * g + r) * RS + c0 + fr] = hw_bf(accw[r]);
        }
        LBAR();
        if (role == 0) {
            RM_STATE_PART(vb);
            LBAR();
            RM_FLUSH(c, rg_cur, *(const LAS f32x4*)(Lf + O_VV + ((c & 1) * 2 + hx) * 1024 + tl * 64 + d4), Lf[O_BS + ((c & 1) * 2 + hx) * 16 + tl]);
        } else {
            float* rec = STASH + (size_t)(c - c_begin) * REC;
            for (int i = tid; i < 1376; i += NTHREADS) { const int hd = i >= 688, j = i - hd * 688; const int o = O_IMG + hd * IMGSZ + (j < 144 ? I_RT + 4 * j : I_BTT + 4 * (j - 144)); *(GAS f32x4*)(rec + 4 * i) = *(const LAS f32x4*)(Lf + o); }
            { GAS unsigned* ru = (GAS unsigned*)(rec + 5504); ru[(w * 2 + 0) * 64 + lane] = hw_pk2(accU[0], accU[1]); ru[(w * 2 + 1) * 64 + lane] = hw_pk2(accU[2], accU[3]); }
            { const f32x4 v4 = *(const LAS f32x4*)(Lf + O_VV + ((c & 1) * 2 + hx) * 1024 + tl * 64 + d4); u32x2 o; o.x = hw_pk2(v4[0], v4[1]); o.y = hw_pk2(v4[2], v4[3]); *(GAS u32x2*)(rec + 6528 + 2 * tid) = o; }
            if (tid < 32) rec[7552 + tid] = Lf[O_BS + (c & 1) * 32 + tid];
            LBAR();
        }
        rg_cur = rg_nxt; rg_nxt = rg_far;
    }
    if (role == 0) {
#pragma unroll
        for (int i = 0; i < 4; ++i)
#pragma unroll
            for (int r = 0; r < 4; ++r) STATE[((w * 4 + i) * 4 + r) * 64 + lane] = Macc[i][r];
        asm volatile("s_waitcnt vmcnt(0)" ::: "memory");
        __syncthreads();
        if (tid == 0) { __builtin_amdgcn_fence(__ATOMIC_RELEASE, "agent"); asm volatile("s_waitcnt vmcnt(0)" ::: "memory"); __hip_atomic_store(flag, 1u, __ATOMIC_RELAXED, __HIP_MEMORY_SCOPE_AGENT); }
    } else {
        if (tid == 0) { unsigned sp = 0; while (__hip_atomic_load(flag, __ATOMIC_RELAXED, __HIP_MEMORY_SCOPE_AGENT) == 0u) { __builtin_amdgcn_s_sleep(8); if (++sp > (1u << 22)) break; }
            __builtin_amdgcn_fence(__ATOMIC_ACQUIRE, "agent"); asm volatile("s_waitcnt vmcnt(0)" ::: "memory"); }
        __syncthreads();
#pragma unroll
        for (int i = 0; i < 4; ++i)
#pragma unroll
            for (int r = 0; r < 4; ++r) Macc[i][r] = STATE[((w * 4 + i) * 4 + r) * 64 + lane];
        f32x4 pi0, pi1, pi2; unsigned pu0, pu1; u32x2 pv, pgate; float pbs;
#define RM_REC_LOAD(cc) do { const float* rec = STASH + (size_t)((cc) - c_begin) * REC; pi0 = *(const GAS f32x4*)(rec + 4 * tid); pi1 = *(const GAS f32x4*)(rec + 4 * (tid + 512)); \
            pi2 = (tid < 352) ? *(const GAS f32x4*)(rec + 4 * (tid + 1024)) : (f32x4){0.f, 0.f, 0.f, 0.f}; \
            const GAS unsigned* ru = (const GAS unsigned*)(rec + 5504); pu0 = ru[(w * 2 + 0) * 64 + lane]; pu1 = ru[(w * 2 + 1) * 64 + lane]; pv = *(const GAS u32x2*)(rec + 6528 + 2 * tid); pbs = rec[7552 + hx * 16 + tl]; \
            pgate = *(const GAS u32x2*)(LO + (size_t)((cc) * TC + tl) * LORA_N + col4 + 2048); } while (0)
#define RM_IMG_OFF(i_) (O_IMG + ((i_) >= 688) * IMGSZ + ((((i_) - ((i_) >= 688) * 688) < 144) ? I_RT + 4 * ((i_) - ((i_) >= 688) * 688) : I_BTT + 4 * (((i_) - ((i_) >= 688) * 688) - 144)))
        RM_REC_LOAD(c_begin);
        for (int c = c_begin; c < c_end; ++c) {
            *(LAS f32x4*)(Lf + RM_IMG_OFF(tid)) = pi0; *(LAS f32x4*)(Lf + RM_IMG_OFF(tid + 512)) = pi1; if (tid < 352) *(LAS f32x4*)(Lf + RM_IMG_OFF(tid + 1024)) = pi2;
            const f32x4 vcur = {bf_lo(pv.x), bf_hi(pv.x), bf_lo(pv.y), bf_hi(pv.y)}; *(LAS f32x4*)(Lf + O_VV + hx * 1024 + tl * 64 + d4) = vcur;
            const f32x4 accU = {bf_lo(pu0), bf_hi(pu0), bf_lo(pu1), bf_hi(pu1)}; const float bscur = pbs; const u32x2 gcur = pgate;
            if (c + 1 < c_end) RM_REC_LOAD(c + 1);
            LBAR();
            const LAS float* VVc = Lf + O_VV + hh * 1024;
            u32x2 vlo; { vlo.x = hw_pk2(VVc[(4 * g + 0) * 64 + c0 + fr], VVc[(4 * g + 1) * 64 + c0 + fr]); vlo.y = hw_pk2(VVc[(4 * g + 2) * 64 + c0 + fr], VVc[(4 * g + 3) * 64 + c0 + fr]); }
            const bf16x8 vb = mk_frag(vlo, zz);
            RM_STATE_PART(vb);
            LBAR();
            RM_FLUSH(c, gcur, vcur, bscur);
            LBAR();
        }
#undef RM_REC_LOAD
#undef RM_IMG_OFF
    }
#undef RM_STATE_PART
#undef RM_FLUSH
#undef RM_LOAD
#undef RM_XFORM
}

__device__ __forceinline__ int med3i(int a, int b, int c) { int r; asm("v_med3_i32 %0, %1, %2, %3" : "=v"(r) : "v"(a), "v"(b), "v"(c)); return r; }
__device__ __forceinline__ int f2sort(float f) { int x = __float_as_int(f); return x ^ ((x >> 31) & 0x7fffffff); }
__device__ __forceinline__ float sort2f(int x) { return __int_as_float(x ^ ((x >> 31) & 0x7fffffff)); }
#define TOPK_INSERT(vals, x) do { _Pragma("unroll") for (int s_ = 15; s_ >= 1; --s_) vals[s_] = med3i((x), vals[s_ - 1], vals[s_]); vals[0] = max(vals[0], (x)); } while (0)
__device__ __forceinline__ float bf_dot2(unsigned a, unsigned b, float c) {
    return c + bf_lo(a) * bf_lo(b) + bf_hi(a) * bf_hi(b);
}
__device__ __forceinline__ void sum8_x8(float (&a)[8]) {
    asm("s_nop 1\n\t"
        "v_add_f32_dpp %0, %0, %0 quad_perm:[1,0,3,2] row_mask:0xf bank_mask:0xf\n\tv_add_f32_dpp %1, %1, %1 quad_perm:[1,0,3,2] row_mask:0xf bank_mask:0xf\n\t"
        "v_add_f32_dpp %2, %2, %2 quad_perm:[1,0,3,2] row_mask:0xf bank_mask:0xf\n\tv_add_f32_dpp %3, %3, %3 quad_perm:[1,0,3,2] row_mask:0xf bank_mask:0xf\n\t"
        "v_add_f32_dpp %4, %4, %4 quad_perm:[1,0,3,2] row_mask:0xf bank_mask:0xf\n\tv_add_f32_dpp %5, %5, %5 quad_perm:[1,0,3,2] row_mask:0xf bank_mask:0xf\n\t"
        "v_add_f32_dpp %6, %6, %6 quad_perm:[1,0,3,2] row_mask:0xf bank_mask:0xf\n\tv_add_f32_dpp %7, %7, %7 quad_perm:[1,0,3,2] row_mask:0xf bank_mask:0xf\n\t"
        "v_add_f32_dpp %0, %0, %0 quad_perm:[2,3,0,1] row_mask:0xf bank_mask:0xf\n\tv_add_f32_dpp %1, %1, %1 quad_perm:[2,3,0,1] row_mask:0xf bank_mask:0xf\n\t"
        "v_add_f32_dpp %2, %2, %2 quad_perm:[2,3,0,1] row_mask:0xf bank_mask:0xf\n\tv_add_f32_dpp %3, %3, %3 quad_perm:[2,3,0,1] row_mask:0xf bank_mask:0xf\n\t"
        "v_add_f32_dpp %4, %4, %4 quad_perm:[2,3,0,1] row_mask:0xf bank_mask:0xf\n\tv_add_f32_dpp %5, %5, %5 quad_perm:[2,3,0,1] row_mask:0xf bank_mask:0xf\n\t"
        "v_add_f32_dpp %6, %6, %6 quad_perm:[2,3,0,1] row_mask:0xf bank_mask:0xf\n\tv_add_f32_dpp %7, %7, %7 quad_perm:[2,3,0,1] row_mask:0xf bank_mask:0xf\n\t"
        "v_add_f32_dpp %0, %0, %0 row_half_mirror row_mask:0xf bank_mask:0xf\n\tv_add_f32_dpp %1, %1, %1 row_half_mirror row_mask:0xf bank_mask:0xf\n\t"
        "v_add_f32_dpp %2, %2, %2 row_half_mirror row_mask:0xf bank_mask:0xf\n\tv_add_f32_dpp %3, %3, %3 row_half_mirror row_mask:0xf bank_mask:0xf\n\t"
        "v_add_f32_dpp %4, %4, %4 row_half_mirror row_mask:0xf bank_mask:0xf\n\tv_add_f32_dpp %5, %5, %5 row_half_mirror row_mask:0xf bank_mask:0xf\n\t"
        "v_add_f32_dpp %6, %6, %6 row_half_mirror row_mask:0xf bank_mask:0xf\n\tv_add_f32_dpp %7, %7, %7 row_half_mirror row_mask:0xf bank_mask:0xf\n\t"
        "s_nop 1"
        : "+v"(a[0]), "+v"(a[1]), "+v"(a[2]), "+v"(a[3]), "+v"(a[4]), "+v"(a[5]), "+v"(a[6]), "+v"(a[7]));
}
__device__ __forceinline__ void sum8i_x8(int (&a)[8]) {
    asm("s_nop 1\n\t"
        "v_add_u32_dpp %0, %0, %0 quad_perm:[1,0,3,2] row_mask:0xf bank_mask:0xf\n\tv_add_u32_dpp %1, %1, %1 quad_perm:[1,0,3,2] row_mask:0xf bank_mask:0xf\n\t"
        "v_add_u32_dpp %2, %2, %2 quad_perm:[1,0,3,2] row_mask:0xf bank_mask:0xf\n\tv_add_u32_dpp %3, %3, %3 quad_perm:[1,0,3,2] row_mask:0xf bank_mask:0xf\n\t"
        "v_add_u32_dpp %4, %4, %4 quad_perm:[1,0,3,2] row_mask:0xf bank_mask:0xf\n\tv_add_u32_dpp %5, %5, %5 quad_perm:[1,0,3,2] row_mask:0xf bank_mask:0xf\n\t"
        "v_add_u32_dpp %6, %6, %6 quad_perm:[1,0,3,2] row_mask:0xf bank_mask:0xf\n\tv_add_u32_dpp %7, %7, %7 quad_perm:[1,0,3,2] row_mask:0xf bank_mask:0xf\n\t"
        "v_add_u32_dpp %0, %0, %0 quad_perm:[2,3,0,1] row_mask:0xf bank_mask:0xf\n\tv_add_u32_dpp %1, %1, %1 quad_perm:[2,3,0,1] row_mask:0xf bank_mask:0xf\n\t"
        "v_add_u32_dpp %2, %2, %2 quad_perm:[2,3,0,1] row_mask:0xf bank_mask:0xf\n\tv_add_u32_dpp %3, %3, %3 quad_perm:[2,3,0,1] row_mask:0xf bank_mask:0xf\n\t"
        "v_add_u32_dpp %4, %4, %4 quad_perm:[2,3,0,1] row_mask:0xf bank_mask:0xf\n\tv_add_u32_dpp %5, %5, %5 quad_perm:[2,3,0,1] row_mask:0xf bank_mask:0xf\n\t"
        "v_add_u32_dpp %6, %6, %6 quad_perm:[2,3,0,1] row_mask:0xf bank_mask:0xf\n\tv_add_u32_dpp %7, %7, %7 quad_perm:[2,3,0,1] row_mask:0xf bank_mask:0xf\n\t"
        "v_add_u32_dpp %0, %0, %0 row_half_mirror row_mask:0xf bank_mask:0xf\n\tv_add_u32_dpp %1, %1, %1 row_half_mirror row_mask:0xf bank_mask:0xf\n\t"
        "v_add_u32_dpp %2, %2, %2 row_half_mirror row_mask:0xf bank_mask:0xf\n\tv_add_u32_dpp %3, %3, %3 row_half_mirror row_mask:0xf bank_mask:0xf\n\t"
        "v_add_u32_dpp %4, %4, %4 row_half_mirror row_mask:0xf bank_mask:0xf\n\tv_add_u32_dpp %5, %5, %5 row_half_mirror row_mask:0xf bank_mask:0xf\n\t"
        "v_add_u32_dpp %6, %6, %6 row_half_mirror row_mask:0xf bank_mask:0xf\n\tv_add_u32_dpp %7, %7, %7 row_half_mirror row_mask:0xf bank_mask:0xf\n\t"
        "s_nop 1"
        : "+v"(a[0]), "+v"(a[1]), "+v"(a[2]), "+v"(a[3]), "+v"(a[4]), "+v"(a[5]), "+v"(a[6]), "+v"(a[7]));
}
__device__ __forceinline__ float max8_x1(float v) {
    asm("s_nop 1\n\tv_max_f32_dpp %0, %0, %0 quad_perm:[1,0,3,2] row_mask:0xf bank_mask:0xf\n\ts_nop 1\n\tv_max_f32_dpp %0, %0, %0 quad_perm:[2,3,0,1] row_mask:0xf bank_mask:0xf\n\ts_nop 1\n\t"
        "v_max_f32_dpp %0, %0, %0 row_half_mirror row_mask:0xf bank_mask:0xf\n\ts_nop 1" : "+v"(v));
    return v;
}
__device__ __forceinline__ float sum8_x1(float v) {
    asm("s_nop 1\n\tv_add_f32_dpp %0, %0, %0 quad_perm:[1,0,3,2] row_mask:0xf bank_mask:0xf\n\ts_nop 1\n\tv_add_f32_dpp %0, %0, %0 quad_perm:[2,3,0,1] row_mask:0xf bank_mask:0xf\n\ts_nop 1\n\t"
        "v_add_f32_dpp %0, %0, %0 row_half_mirror row_mask:0xf bank_mask:0xf\n\ts_nop 1" : "+v"(v));
    return v;
}
__device__ __forceinline__ void peer_phase(const Args& A, Frame& F, int L, const bool dry, const bf16* Hin, bf16* Hout, unsigned char* H8) {
    int lane = F.lane; asm volatile("" : "+v"(lane));
    const int gw = F.vcu * NWAVES + F.wave;
    const bf16* SCR = (const bf16*)(A.ws + WS_SC); const bf16* X = Hin; float* RS3 = (float*)(A.ws + WS_RS3);
    const unsigned char* TU = (const unsigned char*)(A.ws + WS_TABU) + (size_t)L * 16384 * D; const unsigned char* TV = (const unsigned char*)(A.ws + WS_TABV) + (size_t)L * 16384 * D;
    const float* SUL = (const float*)(A.ws + WS_SU) + (size_t)L * 16384; const float* SVL = SUL + 32768;
    const float* rowss = (const float*)(A.ws + WS_RSP) + (size_t)(L == 0 ? RS_FFN0 : RS_FFN1) * T * 32;
    LAS unsigned* LIST = (LAS unsigned*)(F.lds + RING_OFF + F.wave * 16384);
    LAS unsigned* EIDX = LIST + 1024;
    LAS float* ECOEF = (LAS float*)(EIDX + 1024);
    const int tbase = gw * 8;
    if (tbase >= T) return;
    for (int half = 0; half < 2; ++half) {
        const int t0 = tbase + 4 * half;
        {
            const bf16* sp = SCR + (size_t)(t0 + (lane >> 4)) * D + (lane & 15) * 128;
            int vals[16];
#pragma unroll
            for (int s = 0; s < 16; ++s) vals[s] = (int)0x80000000;
#pragma unroll 2
            for (int c = 0; c < 16; ++c) { const v4u wv = *(const GAS v4u*)(sp + c * 8); const unsigned ww[4] = {wv.x, wv.y, wv.z, wv.w};
#pragma unroll
                for (int e = 0; e < 8; ++e) { const unsigned bits = (e & 1) ? (ww[e >> 1] & 0xffff0000u) : (ww[e >> 1] << 16);
                    int x = (int)bits; x ^= (x >> 31) & 0x7fffffff; x = (x & ~0x7f) | (127 - (c * 8 + e));
                    TOPK_INSERT(vals, x); } }
#pragma unroll
            for (int q = 0; q < 4; ++q) { v4u o; o.x = (unsigned)vals[4 * q]; o.y = (unsigned)vals[4 * q + 1]; o.z = (unsigned)vals[4 * q + 2]; o.w = (unsigned)vals[4 * q + 3]; *(LAS v4u*)(LIST + lane * 16 + 4 * q) = o; }
        }
        LDS_WAIT(); asm volatile("" ::: "memory");
        if (lane < 32) {
            const LAS unsigned* la = LIST + ((lane >> 3) * 16 + (lane & 7) * 2) * 16; const LAS unsigned* lb2 = la + 16;
            float av[16], bv[16];
#pragma unroll
            for (int q = 0; q < 4; ++q) { const v4u a4 = *(const LAS v4u*)(la + 4 * q), b4 = *(const LAS v4u*)(lb2 + 4 * q); const unsigned aw[4] = {a4.x, a4.y, a4.z, a4.w}, bw[4] = {b4.x, b4.y, b4.z, b4.w};
#pragma unroll
                for (int e = 0; e < 4; ++e) { av[4 * q + e] = __uint_as_float(__float_as_uint(sort2f((int)(aw[e] & ~0x7fu))) & 0xffff0000u); bv[4 * q + e] = __uint_as_float(__float_as_uint(sort2f((int)(bw[e] & ~0x7fu))) & 0xffff0000u); } }
            int best[16];
#pragma unroll
            for (int s = 0; s < 16; ++s) best[s] = (int)0x80000000;
#pragma unroll
            for (int i = 0; i < 16; ++i)
#pragma unroll
                for (int jx = 0; jx < 16; ++jx) if ((i + 1) * (jx + 1) <= 16) { int x = f2sort(av[i] + bv[jx]); x = (x & ~0xff) | (255 - (i * 16 + jx)); TOPK_INSERT(best, x); }
            float sv[16]; unsigned ex[16];
#pragma unroll
            for (int s = 0; s < 16; ++s) { const int cand = 255 - (best[s] & 0xff); const unsigned ka = la[cand >> 4], kb = lb2[cand & 15];
                ex[s] = (127u - (ka & 0x7fu)) * 128u + (127u - (kb & 0x7fu));
                sv[s] = __uint_as_float(__float_as_uint(sort2f((int)(ka & ~0x7fu))) & 0xffff0000u) + __uint_as_float(__float_as_uint(sort2f((int)(kb & ~0x7fu))) & 0xffff0000u); }
            float mx = sv[0];
#pragma unroll
            for (int s = 1; s < 16; ++s) mx = fmaxf(mx, sv[s]);
            float den = 0.f;
#pragma unroll
            for (int s = 0; s < 16; ++s) { sv[s] = __expf(sv[s] - mx); den += sv[s]; }
            const float inv = 1.0f / den; const int base = (4 * half + (lane >> 3)) * 128 + (lane & 7) * 16;
#pragma unroll
            for (int s = 0; s < 16; ++s) { EIDX[base + s] = ex[s]; ECOEF[base + s] = sv[s] * inv; }
        }
        LDS_WAIT(); asm volatile("" ::: "memory");
    }
    const int tk = lane >> 3, part = lane & 7, t = tbase + tk;
    const LAS unsigned* eidx = EIDX + tk * 128; LAS float* ecoef = ECOEF + tk * 128;
    const float rs = __builtin_amdgcn_rsqf(sum8_x1(((const GAS f32x4*)(rowss + (size_t)t * 32))[part][0] + ((const GAS f32x4*)(rowss + (size_t)t * 32))[part][1] + ((const GAS f32x4*)(rowss + (size_t)t * 32))[part][2] + ((const GAS f32x4*)(rowss + (size_t)t * 32))[part][3]) * (1.0f / D) + EPS);
    typedef _Float16 h2_t __attribute__((ext_vector_type(2)));
#if PEER_ALIAS
    const unsigned amask = dry ? 1023u : 0xffffffffu;
#else
    constexpr unsigned amask = 0xffffffffu;
#endif
#define PEER_LOAD8(dst, TAB, i0, soff) do { const v4u ia_ = *(const LAS v4u*)(eidx + (i0)), ib_ = *(const LAS v4u*)(eidx + (i0) + 4); const unsigned ee_[8] = {ia_.x, ia_.y, ia_.z, ia_.w, ib_.x, ib_.y, ib_.z, ib_.w}; \
        _Pragma("unroll") for (int j_ = 0; j_ < 8; ++j_) dst[j_] = *(const GAS v4u*)((TAB) + (size_t)((ee_[j_] & amask) * 2048u + (unsigned)(soff))); } while (0)
    LAS float* dotw = (LAS float*)LIST + tk * 128;
#pragma unroll
    for (int m = 0; m < 16; ++m) dotw[8 * m + part] = 0.f;
#pragma unroll 1
    for (int p = 0; p < 16; ++p) {
        const int soff = 128 * p + 16 * part;
        unsigned xq[4]; float sxs;
        { const v4u x0 = *(const GAS v4u*)(X + (size_t)t * D + soff), x1 = *(const GAS v4u*)(X + (size_t)t * D + soff + 8); const unsigned xw[8] = {x0.x, x0.y, x0.z, x0.w, x1.x, x1.y, x1.z, x1.w};
          float xv[16], am = 0.f;
#pragma unroll
          for (int e = 0; e < 8; ++e) { xv[2 * e] = bf_lo(xw[e]); xv[2 * e + 1] = bf_hi(xw[e]); am = fmaxf(am, fmaxf(fabsf(xv[2 * e]), fabsf(xv[2 * e + 1]))); }
          am = max8_x1(am); sxs = am * (1.0f / 127.0f); const float inv = am > 0.f ? 127.0f / am : 0.f;
#pragma unroll
          for (int q = 0; q < 4; ++q) { unsigned w = 0;
#pragma unroll
              for (int e = 0; e < 4; ++e) w |= (__float_as_uint(__builtin_fmaf(xv[4 * q + e], inv, 12582912.0f)) & 255u) << (8 * e);
              xq[q] = w; } }
#define PEER_UDOT8(src, m_) do { int tt_[8]; \
        _Pragma("unroll") for (int j_ = 0; j_ < 8; ++j_) { int a_ = __builtin_amdgcn_sdot4((int)src[j_].x, (int)xq[0], 0, false); a_ = __builtin_amdgcn_sdot4((int)src[j_].y, (int)xq[1], a_, false); \
            a_ = __builtin_amdgcn_sdot4((int)src[j_].z, (int)xq[2], a_, false); tt_[j_] = __builtin_amdgcn_sdot4((int)src[j_].w, (int)xq[3], a_, false); } \
        sum8i_x8(tt_); \
        int sel_ = tt_[0]; _Pragma("unroll") for (int j_ = 1; j_ < 8; ++j_) sel_ = (part == j_) ? tt_[j_] : sel_; \
        dotw[8 * (m_) + part] += (float)sel_ * sxs; } while (0)
        v4u ua[8], ub[8];
        PEER_LOAD8(ua, TU, 0, soff);
#pragma unroll 1
        for (int m = 0; m < 16; m += 2) {
            PEER_LOAD8(ub, TU, 8 * (m + 1), soff);
            PEER_UDOT8(ua, m);
            if (m + 2 < 16) PEER_LOAD8(ua, TU, 8 * (m + 2), soff);
            PEER_UDOT8(ub, m + 1);
        }
    }
#undef PEER_UDOT8
    LAS unsigned char* ecq = (LAS unsigned char*)(LIST + 3072) + tk * 128;
    float sc;
    { float cf[16], cm = 0.f;
#pragma unroll
      for (int m = 0; m < 16; ++m) { const unsigned e_ = eidx[8 * m + part]; const float d_ = dotw[8 * m + part] * rs * SUL[e_]; const float act = 0.5f * d_ * (1.0f + erff(d_ * 0.7071067811865476f));
          cf[m] = ecoef[8 * m + part] * act * SVL[e_]; cm = fmaxf(cm, fabsf(cf[m])); }
      cm = max8_x1(cm); sc = cm * (1.0f / 127.0f); const float inv = cm > 0.f ? 127.0f / cm : 0.f;
#pragma unroll
      for (int m = 0; m < 16; ++m) ecq[8 * m + part] = (unsigned char)(__float_as_uint(__builtin_fmaf(cf[m], inv, 12582912.0f)) & 255u); }
    LDS_WAIT(); asm volatile("" ::: "memory");
    float ss = 0.f;
#pragma unroll 1
    for (int p = 0; p < 16; ++p) {
        const int soff = 128 * p + 16 * part;
        int acc[16];
#pragma unroll
        for (int i = 0; i < 16; ++i) acc[i] = 0;
#define PEER_VACC8(src, i0) do { const u32x2 c8_ = *(const LAS u32x2*)(ecq + (i0)); \
        _Pragma("unroll") for (int h_ = 0; h_ < 2; ++h_) { const int cq_ = (int)(h_ ? c8_.y : c8_.x); \
            _Pragma("unroll") for (int q_ = 0; q_ < 4; ++q_) { \
                const unsigned a_ = q_ == 0 ? src[4 * h_].x : q_ == 1 ? src[4 * h_].y : q_ == 2 ? src[4 * h_].z : src[4 * h_].w, b_ = q_ == 0 ? src[4 * h_ + 1].x : q_ == 1 ? src[4 * h_ + 1].y : q_ == 2 ? src[4 * h_ + 1].z : src[4 * h_ + 1].w; \
                const unsigned c_ = q_ == 0 ? src[4 * h_ + 2].x : q_ == 1 ? src[4 * h_ + 2].y : q_ == 2 ? src[4 * h_ + 2].z : src[4 * h_ + 2].w, d_ = q_ == 0 ? src[4 * h_ + 3].x : q_ == 1 ? src[4 * h_ + 3].y : q_ == 2 ? src[4 * h_ + 3].z : src[4 * h_ + 3].w; \
                const unsigned lab_ = __builtin_amdgcn_perm(b_, a_, 0x05010400u), hab_ = __builtin_amdgcn_perm(b_, a_, 0x07030602u), lcd_ = __builtin_amdgcn_perm(d_, c_, 0x05010400u), hcd_ = __builtin_amdgcn_perm(d_, c_, 0x07030602u); \
                acc[4 * q_ + 0] = __builtin_amdgcn_sdot4((int)__builtin_amdgcn_perm(lcd_, lab_, 0x05040100u), cq_, acc[4 * q_ + 0], false); \
                acc[4 * q_ + 1] = __builtin_amdgcn_sdot4((int)__builtin_amdgcn_perm(lcd_, lab_, 0x07060302u), cq_, acc[4 * q_ + 1], false); \
                acc[4 * q_ + 2] = __builtin_amdgcn_sdot4((int)__builtin_amdgcn_perm(hcd_, hab_, 0x05040100u), cq_, acc[4 * q_ + 2], false); \
                acc[4 * q_ + 3] = __builtin_amdgcn_sdot4((int)__builtin_amdgcn_perm(hcd_, hab_, 0x07060302u), cq_, acc[4 * q_ + 3], false); } } } while (0)
        v4u va[8], vb[8];
        PEER_LOAD8(va, TV, 0, soff);
#pragma unroll 1
        for (int m = 0; m < 16; m += 2) {
            PEER_LOAD8(vb, TV, 8 * (m + 1), soff);
            PEER_VACC8(va, 8 * m);
            if (m + 2 < 16) PEER_LOAD8(va, TV, 8 * (m + 2), soff);
            PEER_VACC8(vb, 8 * (m + 1));
        }
        { const v4u h0 = *(const GAS v4u*)(Hin + (size_t)t * D + soff), h1 = *(const GAS v4u*)(Hin + (size_t)t * D + soff + 8); const unsigned hw[8] = {h0.x, h0.y, h0.z, h0.w, h1.x, h1.y, h1.z, h1.w}; unsigned ow[8];
#pragma unroll
          for (int e = 0; e < 8; ++e) { ow[e] = hw_pk2(bf_lo(hw[e]) + (float)acc[2 * e] * sc, bf_hi(hw[e]) + (float)acc[2 * e + 1] * sc); const float q0 = bf_lo(ow[e]), q1 = bf_hi(ow[e]); ss += q0 * q0 + q1 * q1; }
          v4u o0, o1; o0.x = ow[0]; o0.y = ow[1]; o0.z = ow[2]; o0.w = ow[3]; o1.x = ow[4]; o1.y = ow[5]; o1.z = ow[6]; o1.w = ow[7];
          if (!dry) { *(GAS v4u*)(Hout + (size_t)t * D + soff) = o0; *(GAS v4u*)(Hout + (size_t)t * D + soff + 8) = o1;
            if (H8) { v4u o8; unsigned q8[4];
#pragma unroll
              for (int e = 0; e < 4; ++e) { int x8 = __builtin_amdgcn_cvt_pk_fp8_f32(bf_lo(ow[2 * e]), bf_hi(ow[2 * e]), 0, false); x8 = __builtin_amdgcn_cvt_pk_fp8_f32(bf_lo(ow[2 * e + 1]), bf_hi(ow[2 * e + 1]), x8, true); q8[e] = (unsigned)x8; }
              o8.x = q8[0]; o8.y = q8[1]; o8.z = q8[2]; o8.w = q8[3]; *(GAS v4u*)(H8 + (size_t)t * D + soff) = o8; } } else asm volatile("" :: "v"(o0.x), "v"(o0.y), "v"(o0.z), "v"(o0.w), "v"(o1.x), "v"(o1.y), "v"(o1.z), "v"(o1.w)); }
    }
#undef PEER_VACC8
#undef PEER_LOAD8
    const float r3 = __builtin_amdgcn_rsqf(sum8_x1(ss) * (1.0f / D) + EPS);
    if (!dry && part == 0) RS3[t] = r3;
}


constexpr int N_PHASES = 19;
__global__ void __launch_bounds__(NTHREADS, 2) mega_fwd(Args args) {

    extern __shared__ __attribute__((aligned(16))) unsigned char lds[];
    Frame F;
    F.lds = (LAS unsigned char*)lds;
    F.MISC = (volatile LAS unsigned*)(F.lds + MISC_OFF);
    F.tid = threadIdx.x; F.lane = F.tid & 63; F.wave = __builtin_amdgcn_readfirstlane(F.tid >> 6);
    F.G = gridDim.x; { const int bx = blockIdx.x; F.vcu = (F.G % 8 == 0) ? (bx % 8) * (F.G / 8) + bx / 8 : bx; }
    unsigned char* ws = args.ws;
    F.ctl = (gu32*)(ws + WS_CTL);
    for (int u = F.tid; u < (LDS_BYTES - LDSCTL_OFF) / 4; u += NTHREADS) ((LAS unsigned*)(F.lds + LDSCTL_OFF))[u] = 0u;
    __syncthreads();
    const int lo = args.ph_lo, hi = args.ph_hi;
    XcdBarrier bar; bar.bar = (unsigned*)(F.ctl + CW_BAR); bar.x = 0; bar.st = nullptr;
    if (hi - lo > 1) bar = xcd_barrier_post((unsigned*)(F.ctl + CW_BAR), F.MISC + 8);
    bar.wave0 = (F.wave == 0);
#define IN(k) (lo <= (k) && (k) < hi)
#define REFRESH() do { int t_; asm volatile("v_mbcnt_lo_u32_b32 %0, -1, 0\n\tv_mbcnt_hi_u32_b32 %0, -1, %0" : "=v"(t_)); F.lane = t_; F.tid = F.wave * 64 + t_; } while (0)
#define REPS(k) (1 + ((DUP_MASK >> (k)) & 1))
#if PROBE_MASK
    unsigned long long* const tsb = (unsigned long long*)(ws + WS_CTL + 65536);
#define STAMP(k) do { if (blockIdx.x == 0 && F.tid == 0) __hip_atomic_store(tsb + (k), __builtin_amdgcn_s_memrealtime(), __ATOMIC_RELAXED, __HIP_MEMORY_SCOPE_AGENT); } while (0)
    STAMP(31);
#else
#define STAMP(k) do { } while (0)
#endif
#define SEAM(k) do { if (IN(k) && IN((k) + 1)) { if ((k) == 0) { cg::this_grid().sync(); } else { xcd_barrier(bar); if ((DUP_MASK >> 24) & 1) xcd_barrier(bar); } STAMP(k); } } while (0)
    float* rowss = (float*)(ws + WS_RSP);
    bf16* ACTA = (bf16*)(ws + WS_ACTA); bf16* ACTB = (bf16*)(ws + WS_ACTB); bf16* H1 = (bf16*)(ws + WS_H1); const float* RS3 = (const float*)(ws + WS_RS3);
    bf16* PROJ = (bf16*)(ws + WS_PROJ); bf16* SCB = (bf16*)(ws + WS_SC); bf16* PP = (bf16*)(ws + WS_PP);
    const int gtid = (F.vcu * NWAVES + F.wave) * 64 + F.lane, gthreads = F.G * NTHREADS;

#if UBENCH
    {
        typedef _Float16 h2_t __attribute__((ext_vector_type(2)));
        float a[32]; f32x2 p[16]; h2_t hh[32];
#pragma unroll
        for (int i = 0; i < 32; ++i) { a[i] = (float)(F.tid + i); hh[i] = (h2_t){(_Float16)(F.lane + i), (_Float16)i}; }
#pragma unroll
        for (int i = 0; i < 16; ++i) p[i] = (f32x2){a[2 * i], a[2 * i + 1]};
        const float m = 1.0f + 1e-7f * F.lane, c = 1e-9f; const f32x2 m2 = {m, m}, c2 = {c, c}; const h2_t mh = {(_Float16)1.0f, (_Float16)1.0f}, ch = {(_Float16)0.0f, (_Float16)0.0f};
#pragma unroll 1
        for (int it = 0; it < 10000; ++it) {
#if UBENCH == 1
#pragma unroll
            for (int i = 0; i < 32; ++i) asm volatile("v_fma_f32 %0, %0, %1, %2" : "+v"(a[i]) : "v"(m), "v"(c));
#elif UBENCH == 2
#pragma unroll
            for (int i = 0; i < 16; ++i) asm volatile("v_pk_fma_f32 %0, %0, %1, %2\n\tv_pk_fma_f32 %0, %0, %1, %2" : "+v"(p[i]) : "v"(m2), "v"(c2));
#elif UBENCH == 3
#pragma unroll
            for (int i = 0; i < 32; ++i) asm volatile("v_pk_fma_f16 %0, %0, %1, %2" : "+v"(hh[i]) : "v"(mh), "v"(ch));
#endif
        }
        float s = 0.f;
#pragma unroll
        for (int i = 0; i < 32; ++i) s += a[i] + (float)hh[i][0];
#pragma unroll
        for (int i = 0; i < 16; ++i) s += p[i][0] + p[i][1];
        if (s == 12345.678f) args.out[0] = s;
    }
#endif
    if (IN(0)) { REFRESH(); p0_prologue(args, F, 0); if (hi - lo > 1) { xcd_barrier(bar); REFRESH(); p0_prologue(args, F, 1); } } SEAM(0);
    if (IN(1)) for (int rep_ = 0; rep_ < REPS(1); ++rep_) { REFRESH();
#if EV_F8_T1 > EV_F8_T0
        if (EV_F8_T0 > 0) { constexpr int n_ = EV_F8_T0 * 256; pg8::Gemm g{ACTA, (const bf16*)(ws + WS_WEV_IN), T, n_, D}; pg8::StaticOrder S; S.init(T, n_, F.G, (int)blockIdx.x); EpiBf16S E{PROJ, PROJ_LD, nullptr};
          pg8::gemm_phase<EpiBf16S, pg8::StaticOrder, true, true>(F.lds + RING_OFF, g, S, E, F.wave); }
        { constexpr int n_ = (EV_F8_T1 - EV_F8_T0) * 256; pg8::Gemm g{(const bf16*)(ws + WS_H1), (const bf16*)(ws + WS_O + (size_t)EV_F8_T0 * 256 * D), T, n_, D / 2}; pg8::StaticOrder S; S.init(T, n_, F.G, (int)blockIdx.x); EpiBf16S E{PROJ + EV_F8_T0 * 256, PROJ_LD, nullptr};
          pg8::gemm_phase<EpiBf16S, pg8::StaticOrder, true, true, true>(F.lds + RING_OFF, g, S, E, F.wave); }
        if (EV_F8_T1 < EV_NP / 256) { constexpr int n_ = EV_NP - EV_F8_T1 * 256; pg8::Gemm g{ACTA, (const bf16*)(ws + WS_WEV_IN) + (size_t)EV_F8_T1 * 256 * D, T, n_, D}; pg8::StaticOrder S; S.init(T, n_, F.G, (int)blockIdx.x); EpiBf16S E{PROJ + EV_F8_T1 * 256, PROJ_LD, nullptr};
          pg8::gemm_phase<EpiBf16S, pg8::StaticOrder, true, true>(F.lds + RING_OFF, g, S, E, F.wave); }
        if (true) { const int g2 = F.G, c2 = (int)blockIdx.x;
#else
        { pg8::Gemm g{ACTA, (const bf16*)(ws + WS_WEV_IN), T, EV_NP, D / 2}; pg8::StaticOrder S; S.init(T, EV_NP, F.G, (int)blockIdx.x); EpiI8S E{PROJ, PROJ_LD, (const float*)(ws + WS_SA), (const float*)(ws + WS_CMB)};
          pg8::gemm_phase<EpiI8S, pg8::StaticOrder, true, true, false, true>(F.lds + RING_OFF, g, S, E, F.wave); }
        if (F.G == 256 ? (int)blockIdx.x >= 64 : true) { const int g2 = F.G == 256 ? 192 : F.G, c2 = F.G == 256 ? (int)blockIdx.x - 64 : (int)blockIdx.x;
#endif
          pg8::Gemm g{(const bf16*)(ws + WS_PBF), (const bf16*)(ws + WS_WPROJ), T, D, 256}; pg8::StaticOrder S; S.init(T, D, g2, c2); EpiBf16S E{PP, D, nullptr};
          pg8::gemm_phase<EpiBf16S, pg8::StaticOrder, true, true>(F.lds + RING_OFF, g, S, E, F.wave); }
    } SEAM(1);
    if (IN(2)) for (int rep_ = 0; rep_ < REPS(2); ++rep_) { REFRESH();
        if (F.G >= 256) {
            const int u = F.vcu;
            if (u < 64) scan_gla_mfma_unit<0>(args, F, u); else if (u < 128) scan_gdn_mfma_unit(args, F, u - 64, 0); else if (u < 192) scan_gdn_mfma_unit(args, F, u - 128, 1);
            __syncthreads();
            if (rep_ == 0) for (int dr_ = 0; dr_ < 1 + ((DUP_MASK >> 22) & 1); ++dr_) { if (u < 64) p0_deferred(args, F, 128 + u, 192); else if (u >= 192) for (int k = 0; k < 2; ++k) p0_deferred(args, F, 2 * (u - 192) + k, 192); }
        } else {
            for (int u = F.vcu; u < 64; u += F.G) { scan_gla_mfma_unit<0>(args, F, u); __syncthreads(); }
            for (int u = F.vcu; u < 64; u += F.G) { scan_gdn_mfma_unit(args, F, u, 0); __syncthreads(); scan_gdn_mfma_unit(args, F, u, 1); __syncthreads(); }
            if (rep_ == 0) p0_deferred(args, F, F.vcu, F.G);
        }
    } SEAM(2);
    if (IN(3)) for (int rep_ = 0; rep_ < REPS(3); ++rep_) { REFRESH(); post_rows<0>(args, F); } SEAM(3);
    if (IN(4)) { REFRESH(); pg8::Gemm g{ACTA, (const bf16*)(ws + WS_WEV_OUT), T, D, D}; pg8::StaticOrder S; S.init(T, D, F.G, (int)blockIdx.x);
        EpiResid<false, true> E{args.in[I_X], ACTB, rowss + (size_t)RS_FFN0 * T * 32, nullptr, nullptr, nullptr, nullptr, nullptr};
        pg8::gemm_phase<EpiResid<false, true>, pg8::StaticOrder, true, true>(F.lds + RING_OFF, g, S, E, F.wave); }
#if (DUP_MASK >> 20) & 1
    if (IN(4)) { REFRESH(); pg8::Gemm g{ACTA, (const bf16*)(ws + WS_WEV_OUT), T, D, D}; pg8::StaticOrder S; S.init(T, D, F.G, (int)blockIdx.x);
        EpiResid<false, true> E{args.in[I_X], ACTB, rowss + (size_t)RS_FFN0 * T * 32, nullptr, nullptr, nullptr};
        pg8::gemm_phase<EpiResid<false, true>, pg8::StaticOrder, true, true>(F.lds + RING_OFF, g, S, E, F.wave); }
#endif
#if (DUP_MASK >> 21) & 1
    if (IN(4)) { REFRESH(); pg8::Gemm g{ACTA, (const bf16*)(ws + WS_WEV_IN), T, EV_NP, D}; pg8::StaticOrder S; S.init(T, EV_NP, F.G, (int)blockIdx.x); EpiBf16S E{PROJ, PROJ_LD, nullptr};
        pg8::gemm_phase<EpiBf16S, pg8::StaticOrder, true, true>(F.lds + RING_OFF, g, S, E, F.wave); }
#endif
    SEAM(4);
    if (IN(5)) for (int rep_ = 0; rep_ < REPS(5); ++rep_) { REFRESH(); { pg8::Gemm g{ACTB, (const bf16*)(ws + WS_WPEER), T, D, D}; pg8::StaticOrder S; S.init(T, D, F.G, (int)blockIdx.x); EpiBf16S E{SCB, D, rowss + (size_t)RS_FFN0 * T * 32};
        pg8::gemm_phase<EpiBf16S, pg8::StaticOrder, true, true>(F.lds + RING_OFF, g, S, E, F.wave); }
        } SEAM(5);
    if (IN(6)) for (int rep_ = 0; rep_ < REPS(6); ++rep_) { REFRESH(); peer_phase(args, F, 0, rep_ != 0, ACTB, H1, (unsigned char*)ACTA); } SEAM(6);
    if (IN(7)) { REFRESH(); { pg8::Gemm g{ACTA, (const bf16*)(ws + WS_WGATE), T, D, D / 2}; pg8::StaticOrder S; S.init(T, D, F.G, (int)blockIdx.x);
        EpiResid<true, false> E{H1, ACTB, rowss + (size_t)RS_MIX1 * T * 32, PP, RS3, (unsigned char*)ACTA + (size_t)T * D};
        pg8::gemm_phase<EpiResid<true, false>, pg8::StaticOrder, true, true, true>(F.lds + RING_OFF, g, S, E, F.wave); }
        } SEAM(7);
    if (IN(8)) for (int rep_ = 0; rep_ < REPS(8); ++rep_) { REFRESH();
        { pg8::Gemm g{(const bf16*)((const unsigned char*)ACTA + (size_t)T * D), (const bf16*)(ws + WS_WOD_IN), T, OD_NP, D / 2}; pg8::StaticOrder S; S.init(T, OD_NP, F.G, (int)blockIdx.x); EpiBf16S E{PROJ, PROJ_LD, rowss + (size_t)RS_MIX1 * T * 32};
          pg8::gemm_phase<EpiBf16S, pg8::StaticOrder, true, true, true>(F.lds + RING_OFF, g, S, E, F.wave); }
        { pg8::Gemm g{(const bf16*)(ws + WS_PBF) + (size_t)T * 256, (const bf16*)(ws + WS_WPROJ) + (size_t)D * 256, T, D, 256}; pg8::StaticOrder S; S.init(T, D, F.G, (int)blockIdx.x); EpiBf16S E{PP, D, nullptr};
          pg8::gemm_phase<EpiBf16S, pg8::StaticOrder, true, true>(F.lds + RING_OFF, g, S, E, F.wave); }
    } SEAM(8);
    if (IN(9)) for (int rep_ = 0; rep_ < REPS(9); ++rep_) { REFRESH(); lora_prep_rows(args, F); } SEAM(9);
    if (IN(10)) for (int rep_ = 0; rep_ < REPS(10); ++rep_) { REFRESH();
        { pg8::Gemm g{(const bf16*)(ws + WS_LA), (const bf16*)(ws + WS_WLORA), T, 1024, LORA_K, 128}; pg8::StaticOrder S; S.init(T, 1024, F.G, (int)blockIdx.x); EpiBf16S E{(bf16*)(ws + WS_LO), LORA_N, nullptr};
          pg8::gemm_phase<EpiBf16S, pg8::StaticOrder, true, true>(F.lds + RING_OFF, g, S, E, F.wave); }
        { pg8::Gemm g{(const bf16*)(ws + WS_LA) + 64, (const bf16*)(ws + WS_WLORA) + (size_t)1024 * LORA_K + 64, T, 1024, LORA_K, 128}; pg8::StaticOrder S; S.init(T, 1024, F.G, (int)blockIdx.x); EpiBf16S E{(bf16*)(ws + WS_LO) + 1024, LORA_N, nullptr};
          pg8::gemm_phase<EpiBf16S, pg8::StaticOrder, true, true>(F.lds + RING_OFF, g, S, E, F.wave); }
        { pg8::Gemm g{(const bf16*)(ws + WS_LA) + 192, (const bf16*)(ws + WS_WLORA) + (size_t)2048 * LORA_K + 192, T, 1024, LORA_K, 256}; pg8::StaticOrder S; S.init(T, 1024, F.G, (int)blockIdx.x); EpiBf16S E{(bf16*)(ws + WS_LO) + 2048, LORA_N, nullptr};
          pg8::gemm_phase<EpiBf16S, pg8::StaticOrder, true, true>(F.lds + RING_OFF, g, S, E, F.wave); }
    } SEAM(10);
    if (IN(11)) for (int rep_ = 0; rep_ < REPS(11); ++rep_) { REFRESH();
        if (F.G >= 256) {
            const int u = F.vcu;
            if (u < 64) scan_gla_mfma_unit<1>(args, F, u); else if (u < 128) scan_rwkv_mfma_unit(args, F, u - 64, 0); else if (u < 192) scan_rwkv_mfma_unit(args, F, u - 128, 1);
            __syncthreads();
            if (rep_ == 0) for (int dr_ = 0; dr_ < 1 + ((DUP_MASK >> 23) & 1); ++dr_) { if (u < 64) p1_deferred(args, F, 128 + u, 192); else if (u >= 192) for (int k = 0; k < 2; ++k) p1_deferred(args, F, 2 * (u - 192) + k, 192); }
        } else {
            for (int u = F.vcu; u < 64; u += F.G) { scan_gla_mfma_unit<1>(args, F, u); __syncthreads(); }
            for (int u = F.vcu; u < 64; u += F.G) { scan_rwkv_mfma_unit(args, F, u, 0); __syncthreads(); scan_rwkv_mfma_unit(args, F, u, 1); __syncthreads(); }
            if (rep_ == 0) p1_deferred(args, F, F.vcu, F.G);
        }
    } SEAM(11);
    if (IN(12)) for (int rep_ = 0; rep_ < REPS(12); ++rep_) { REFRESH(); post_rows<1>(args, F); } SEAM(12);
    if (IN(13)) { REFRESH(); pg8::Gemm g{ACTA, (const bf16*)(ws + WS_WOD_OUT), T, D, D / 2}; pg8::StaticOrder S; S.init(T, D, F.G, (int)blockIdx.x);
        EpiResid<false, false> E{ACTB, H1, rowss + (size_t)RS_FFN1 * T * 32, nullptr, nullptr, nullptr};
        pg8::gemm_phase<EpiResid<false, false>, pg8::StaticOrder, true, true, true>(F.lds + RING_OFF, g, S, E, F.wave); } SEAM(13);
    if (IN(14)) for (int rep_ = 0; rep_ < REPS(14); ++rep_) { REFRESH(); pg8::Gemm g{H1, (const bf16*)(ws + WS_WPEER) + (size_t)D * D, T, D, D}; pg8::StaticOrder S; S.init(T, D, F.G, (int)blockIdx.x); EpiBf16S E{SCB, D, rowss + (size_t)RS_FFN1 * T * 32};
        pg8::gemm_phase<EpiBf16S, pg8::StaticOrder, true, true>(F.lds + RING_OFF, g, S, E, F.wave); } SEAM(14);
    if (IN(15)) for (int rep_ = 0; rep_ < REPS(15); ++rep_) { REFRESH(); peer_phase(args, F, 1, rep_ != 0, H1, ACTB, (unsigned char*)ACTA); } SEAM(15);
    if (IN(16)) { REFRESH(); pg8::Gemm g{ACTA, (const bf16*)(ws + WS_WGATE) + (size_t)D * D, T, D, D / 2}; pg8::StaticOrder S; S.init(T, D, F.G, (int)blockIdx.x);
        EpiResid<true, false> E{ACTB, H1, rowss + (size_t)RS_FINAL * T * 32, PP, RS3, nullptr};
        pg8::gemm_phase<EpiResid<true, false>, pg8::StaticOrder, true, true, true>(F.lds + RING_OFF, g, S, E, F.wave); } SEAM(16);
    if (IN(17)) { REFRESH();
        float oscale = 1.0f;
#if PROBE_MASK
        { unsigned long long t_prev = __hip_atomic_load(tsb + 31, __ATOMIC_RELAXED, __HIP_MEMORY_SCOPE_AGENT); const unsigned long long t_begin = t_prev; unsigned long long sel = 0ull;
          for (int k = 0; k <= 16; ++k) { const unsigned long long tk = __hip_atomic_load(tsb + k, __ATOMIC_RELAXED, __HIP_MEMORY_SCOPE_AGENT); if ((PROBE_MASK >> k) & 1) sel += tk - t_prev; t_prev = tk; }
          const float f = (float)(double(sel) / double(t_prev - t_begin)); oscale = 1.0f + sqrtf(0.01f + 0.9f * f); }
#endif
        final_rows(args, F, oscale, H1); }
#undef IN
#undef SEAM
#undef REFRESH
}

extern "C" void kernel_launch(void* const* d_in, const int* in_sizes, int n_in, void* d_out, int out_size, void* d_ws, size_t ws_size, hipStream_t stream) {
    static int grid = 0;
    if (grid == 0) {
        if (n_in != N_IN || out_size != T * D || ws_size < WS_END + 63 * MiB) { fprintf(stderr, "kernel_launch: unexpected problem: n_in %d out %d ws %zu (need %zu)\n", n_in, out_size, ws_size, (size_t)(WS_END + 63 * MiB)); grid = -1; return; }
        int dev = 0, cus = 0, per_cu = 0;
        if (hipGetDevice(&dev) != hipSuccess || hipDeviceGetAttribute(&cus, hipDeviceAttributeMultiprocessorCount, dev) != hipSuccess) { grid = -1; return; }
        if (hipFuncSetAttribute((const void*)mega_fwd, hipFuncAttributeMaxDynamicSharedMemorySize, LDS_BYTES) != hipSuccess) { fprintf(stderr, "kernel_launch: hipFuncSetAttribute failed\n"); grid = -1; return; }
        if (hipOccupancyMaxActiveBlocksPerMultiprocessor(&per_cu, (const void*)mega_fwd, NTHREADS, LDS_BYTES) != hipSuccess || per_cu < 1) { fprintf(stderr, "kernel_launch: occupancy query says %d blocks per CU\n", per_cu); (void)hipGetLastError(); grid = -1; return; }
        grid = cus;
    }
    if (grid < 0) return;
    (void)hipMemsetAsync((char*)d_ws + WS_CTL, 0, CTL_ZERO_BYTES, stream);
    Args a{};
    for (int i = 0; i < N_IN; ++i) a.in[i] = (const float*)d_in[i];
    a.out = (float*)d_out; a.ws = (unsigned char*)d_ws;
#if MK_PER_PHASE
    for (int p = 0; p < N_PHASES - 1; ++p) { a.ph_lo = p; a.ph_hi = p + 1; hipLaunchKernelGGL(mega_fwd, dim3(grid), dim3(NTHREADS), LDS_BYTES, stream, a); }
#else
    a.ph_lo = 0; a.ph_hi = N_PHASES;
    void* kargs[] = {&a};
    hipError_t e = hipLaunchCooperativeKernel((const void*)mega_fwd, dim3(grid), dim3(NTHREADS), kargs, LDS_BYTES, stream);
    if (e != hipSuccess) fprintf(stderr, "kernel_launch: cooperative launch failed: %s (grid %d)\n", hipGetErrorString(e), grid);
#endif
}
```

```cpp
#include <hip/hip_runtime.h>
#include <hip/hip_cooperative_groups.h>
#include <cstdio>
#include <cstdint>
namespace cg = cooperative_groups;

#ifndef PROBE_MASK
#define PROBE_MASK 0
#endif
#ifndef DUP_MASK
#define DUP_MASK 0
#endif
#ifndef UBENCH
#define UBENCH 0
#endif
#ifndef GDN_DUP
#define GDN_DUP 0
#endif
#ifndef MK_PER_PHASE
#ifndef PEER_ALIAS
#define PEER_ALIAS 0
#endif
#ifndef EV_F8_T0
#define EV_F8_T0 0
#define EV_F8_T1 0
#endif
#define MK_PER_PHASE 0
#endif

namespace pg8 {
#define PG8_LAS __attribute__((address_space(3)))
typedef unsigned short bf16_t;
typedef short bf16x8 __attribute__((ext_vector_type(8)));
typedef float f32x4 __attribute__((ext_vector_type(4)));
typedef unsigned u32x4 __attribute__((ext_vector_type(4)));
typedef unsigned u32x2 __attribute__((ext_vector_type(2)));
constexpr int BM = 256, BK = 64, HALF = 128, HTB = HALF * BK * 2  , STAGE_BYTES = 8 * HTB, NXCD = 8, WGM = 8;

__host__ __device__ __forceinline__ int lds_byte(int r, int c) { const int st = (r >> 4) * 2 + (c >> 5), rr = r & 15, cc = c & 31, ob = rr * 64 + cc * 2; return st * 1024 + (ob ^ (((ob >> 9) & 1) << 5)); }
__host__ __device__ __forceinline__ void stage_rc(int b, int& R, int& C) { const int st = b / 1024, sb = b % 1024, swz = sb ^ (((sb >> 9) & 1) << 5); R = (st >> 1) * 16 + swz / 64; C = (st & 1) * 32 + (swz % 64) / 2; }
__host__ __device__ __forceinline__ int perm32(int rho) { const int n = rho >> 4, i = rho & 15; return 8 * (i >> 2) + 4 * n + (i & 3); }

struct Unit { int pm, pn; };
struct Gemm { const bf16_t* A; const bf16_t* Bt; int M, N, K; int KE = 0; };

struct StaticOrder {
    int nM, nN, nwg, G, c;
    __host__ __device__ void init(int M, int N, int G_, int c_) { nM = M / BM; nN = N / BM; nwg = nM * nN; G = G_; c = c_; }
    __host__ __device__ bool next(int i, Unit& u) const {
        const long L = (long)i * G + c; if (L >= nwg) return false;
        int wgid = (int)L; { const int q = nwg / NXCD, r = nwg % NXCD, xcd = wgid % NXCD, off = wgid / NXCD; wgid = (xcd < r ? xcd * (q + 1) : r * (q + 1) + (xcd - r) * q) + off; }
        const int nig = WGM * nN, gid = wgid / nig, fm = gid * WGM, gsz = (nM - fm) < WGM ? (nM - fm) : WGM;
        u.pm = fm + ((wgid % nig) % gsz); u.pn = (wgid % nig) / gsz; return true;
    }
    __device__ __forceinline__ void a_ready(const Unit&) const {}
    __device__ __forceinline__ void done(const Unit&) const {}
};
__device__ __forceinline__ unsigned cvt_pk_bf16(float lo, float hi) { unsigned r; asm volatile("v_cvt_pk_bf16_f32 %0, %1, %2" : "=v"(r) : "v"(lo), "v"(hi)); return r; }
template <class Epi, class Sched, bool ALIGN_EPI = false, bool SP2 = false, bool F8 = false, bool I8 = false>
__device__ __forceinline__ void gemm_phase(PG8_LAS unsigned char* lds, const Gemm g, const Sched& S, const Epi& E, const int wave_id) {
    int tid; asm volatile("v_mbcnt_lo_u32_b32 %0, -1, 0\n\tv_mbcnt_hi_u32_b32 %0, -1, %0" : "=v"(tid)); tid += wave_id * 64;
    const int wid = wave_id, lane = tid & 63, wr = wid >> 2, wc = wid & 3, fr = lane & 15, fq = lane >> 4;
    const int K = g.K, nt = (g.KE ? g.KE : K) / BK;
    unsigned voffA[2], voffB[2];
#pragma unroll
    for (int i = 0; i < 2; ++i) { int R, C; stage_rc(tid * 16 + i * 8192, R, C); const int Rb = Epi::PERM ? ((R & ~31) + perm32(R & 31)) : R;
        voffA[i] = (unsigned)(R * K + C) * 2u; voffB[i] = (unsigned)(Rb * K + C) * 2u; }
    const __amdgpu_buffer_rsrc_t rsrcA = __builtin_amdgcn_make_buffer_rsrc((void*)g.A, 0, 0x7fffffff, 0x00020000), rsrcB = __builtin_amdgcn_make_buffer_rsrc((void*)g.Bt, 0, 0x7fffffff, 0x00020000);
    const size_t kstep = (size_t)(BK * 2);
    const size_t hstep = (size_t)HALF * K * 2;
    const size_t tstep = 2 * hstep;
    const unsigned ldsw = (unsigned)wid * 1024u;
    const int aoff = lds_byte(wr * 64 + fr, fq * 8), boff = lds_byte(wc * 32 + fr, fq * 8);
#define PG8_SA(b, h) (((b) * 2 + (h)) * HTB)
#define PG8_SB(b, h) ((4 + (b) * 2 + (h)) * HTB)
#define PG8_STAGE(bufoff, gbase, voff) do { const bool isA_ = (+(voff) == +voffA); const unsigned soff_ = (unsigned)((const char*)(gbase) - (isA_ ? (const char*)g.A : (const char*)g.Bt)); _Pragma("unroll") for (int _i = 0; _i < 2; ++_i) \
        __builtin_amdgcn_raw_ptr_buffer_load_lds(isA_ ? rsrcA : rsrcB, (PG8_LAS unsigned*)(lds + (bufoff) + ldsw + _i * 8192), 16, (int)(voff)[_i], (int)soff_, 0, 0); } while (0)
#define PG8_LDA(dst, b, h) do { _Pragma("unroll") for (int m = 0; m < 4; ++m) { if constexpr (F8) { dst##8[m].lo = *(const PG8_LAS bf16x8*)(lds + PG8_SA(b, h) + aoff + m * 2048); dst##8[m].hi = *(const PG8_LAS bf16x8*)(lds + PG8_SA(b, h) + aoff + m * 2048 + 1024); } else { _Pragma("unroll") for (int k = 0; k < 2; ++k) dst[m][k] = *(const PG8_LAS bf16x8*)(lds + PG8_SA(b, h) + aoff + m * 2048 + k * 1024); } } } while (0)
#define PG8_LDB(dst, b, h) do { _Pragma("unroll") for (int n = 0; n < 2; ++n) { if constexpr (F8) { dst##8[n].lo = *(const PG8_LAS bf16x8*)(lds + PG8_SB(b, h) + boff + n * 2048); dst##8[n].hi = *(const PG8_LAS bf16x8*)(lds + PG8_SB(b, h) + boff + n * 2048 + 1024); } else { _Pragma("unroll") for (int k = 0; k < 2; ++k) dst[n][k] = *(const PG8_LAS bf16x8*)(lds + PG8_SB(b, h) + boff + n * 2048 + k * 1024); } } } while (0)
#define PG8_MMA(ai, bj, At, Bt) do { __builtin_amdgcn_s_setprio(1); _Pragma("unroll") for (int m = 0; m < 4; ++m) _Pragma("unroll") for (int n = 0; n < 2; ++n) { \
        if constexpr (F8) { typedef int v8i_ __attribute__((ext_vector_type(8))); \
            acc[ai][bj][m][n] = __builtin_amdgcn_mfma_scale_f32_16x16x128_f8f6f4(__builtin_bit_cast(v8i_, Bt##8[n]), __builtin_bit_cast(v8i_, At##8[m]), acc[ai][bj][m][n], 0, 0, 0, 0x7f79, 1, 0x7f79); }     \
        else if constexpr (I8) { typedef int v4i_ __attribute__((ext_vector_type(4))); \
            _Pragma("unroll") for (int k = 0; k < 2; ++k) acc[ai][bj][m][n] = __builtin_bit_cast(f32x4, __builtin_amdgcn_mfma_i32_16x16x64_i8(__builtin_bit_cast(v4i_, Bt[n][k]), __builtin_bit_cast(v4i_, At[m][k]), __builtin_bit_cast(v4i_, acc[ai][bj][m][n]), 0, 0, 0)); } \
        else { _Pragma("unroll") for (int k = 0; k < 2; ++k) acc[ai][bj][m][n] = __builtin_amdgcn_mfma_f32_16x16x32_bf16(Bt[n][k], At[m][k], acc[ai][bj][m][n], 0, 0, 0); } } \
        __builtin_amdgcn_s_setprio(0); } while (0)
#define PG8_WAIT_V(n) asm volatile("s_waitcnt vmcnt(" #n ")" ::: "memory")
#define PG8_WAIT_L(n) asm volatile("s_waitcnt lgkmcnt(" #n ")" ::: "memory")
#define PG8_BAR __builtin_amdgcn_s_barrier()
#define PG8_SCHED __builtin_amdgcn_sched_barrier(0)
    Unit cur, nxt; int ui = 0;
    if (!S.next(0, cur)) return;
    f32x4 acc[2][2][4][2];
#pragma unroll
    for (int a = 0; a < 2; ++a)
#pragma unroll
        for (int b = 0; b < 2; ++b)
#pragma unroll
            for (int m = 0; m < 4; ++m)
#pragma unroll
                for (int n = 0; n < 2; ++n) acc[a][b][m][n] = (f32x4){0.f, 0.f, 0.f, 0.f};
    typedef short bf16x16 __attribute__((ext_vector_type(16)));
    bf16x16 At8[4], B08[2], B18[2]; bf16x8 At[4][2], B0[2][2], B1[2][2];
    const char* cA = (const char*)g.A + (size_t)cur.pm * tstep; const char* cB = (const char*)g.Bt + (size_t)cur.pn * tstep;
    S.a_ready(cur);
    if constexpr (SP2) {
        PG8_STAGE(PG8_SB(0, 0), cB, voffB); PG8_STAGE(PG8_SB(0, 1), cB + hstep, voffB); PG8_STAGE(PG8_SA(0, 0), cA, voffA); PG8_STAGE(PG8_SA(0, 1), cA + hstep, voffA);
        if (wr == 1) PG8_BAR;
        PG8_WAIT_V(2); PG8_BAR;
        PG8_STAGE(PG8_SB(1, 0), cB + kstep, voffB); PG8_STAGE(PG8_SA(1, 0), cA + kstep, voffA); PG8_STAGE(PG8_SB(1, 1), cB + hstep + kstep, voffB);
        PG8_WAIT_V(6); PG8_BAR;
    } else {
        PG8_STAGE(PG8_SB(0, 0), cB, voffB); PG8_STAGE(PG8_SA(0, 0), cA, voffA); PG8_STAGE(PG8_SB(0, 1), cB + hstep, voffB); PG8_STAGE(PG8_SA(0, 1), cA + hstep, voffA);
        if (wr == 1) PG8_BAR;
        PG8_WAIT_V(4); PG8_BAR;
        PG8_STAGE(PG8_SB(1, 0), cB + kstep, voffB); PG8_STAGE(PG8_SA(1, 0), cA + kstep, voffA); PG8_STAGE(PG8_SB(1, 1), cB + hstep + kstep, voffB);
        PG8_WAIT_V(6); PG8_BAR;
    }
    for (;;) {
        const bool has_next = S.next(ui + 1, nxt);
        const char* nA = has_next ? (const char*)g.A + (size_t)nxt.pm * tstep : cA; const char* nB = has_next ? (const char*)g.Bt + (size_t)nxt.pn * tstep : cB;
        for (int t = 0; t < nt; t += 2) {
            const bool last = (t == nt - 2);
            const char* a1 = cA + (size_t)(t + 1) * kstep;
            const char* a2 = last ? nA : cA + (size_t)(t + 2) * kstep; const char* b2 = last ? nB : cB + (size_t)(t + 2) * kstep;
            const char* a3 = a2 + kstep; const char* b3 = b2 + kstep;
            if (last && has_next) S.a_ready(nxt);
            if constexpr (SP2) {
            PG8_LDB(B0, 0, 0); PG8_LDB(B1, 0, 1); PG8_SCHED; PG8_LDA(At, 0, 0); PG8_STAGE(PG8_SA(1, 1), a1 + hstep, voffA);
            PG8_WAIT_V(8); PG8_WAIT_L(0); PG8_BAR; PG8_MMA(0, 0, At, B0); PG8_MMA(0, 1, At, B1); PG8_BAR; PG8_SCHED;
            PG8_LDA(At, 0, 1); PG8_STAGE(PG8_SB(0, 0), b2, voffB); PG8_STAGE(PG8_SB(0, 1), b2 + hstep, voffB); PG8_STAGE(PG8_SA(0, 0), a2, voffA);
            PG8_WAIT_V(8); PG8_WAIT_L(0); PG8_BAR; PG8_MMA(1, 0, At, B0); PG8_MMA(1, 1, At, B1); PG8_BAR; PG8_SCHED;
            PG8_LDB(B0, 1, 0); PG8_LDB(B1, 1, 1); PG8_SCHED; PG8_LDA(At, 1, 0); PG8_STAGE(PG8_SA(0, 1), a2 + hstep, voffA);
            PG8_WAIT_V(8); PG8_WAIT_L(0); PG8_BAR; PG8_MMA(0, 0, At, B0); PG8_MMA(0, 1, At, B1); PG8_BAR; PG8_SCHED;
            PG8_LDA(At, 1, 1); PG8_STAGE(PG8_SB(1, 0), b3, voffB); PG8_STAGE(PG8_SB(1, 1), b3 + hstep, voffB); PG8_STAGE(PG8_SA(1, 0), a3, voffA);
            PG8_WAIT_V(8); PG8_WAIT_L(0); PG8_BAR; PG8_MMA(1, 0, At, B0); PG8_MMA(1, 1, At, B1); PG8_BAR; PG8_SCHED;
            } else {
            PG8_LDB(B0, 0, 0); PG8_SCHED; PG8_LDA(At, 0, 0); PG8_STAGE(PG8_SA(1, 1), a1 + hstep, voffA);
            PG8_WAIT_L(8); PG8_BAR; PG8_WAIT_L(0); PG8_MMA(0, 0, At, B0); PG8_BAR; PG8_SCHED;
            PG8_LDB(B1, 0, 1); PG8_STAGE(PG8_SB(0, 0), b2, voffB);
            PG8_BAR; PG8_WAIT_L(0); PG8_MMA(0, 1, At, B1); PG8_BAR;
            PG8_LDA(At, 0, 1); PG8_STAGE(PG8_SA(0, 0), a2, voffA);
            PG8_BAR; PG8_WAIT_L(0); PG8_MMA(1, 0, At, B0); PG8_BAR; PG8_SCHED;
            PG8_STAGE(PG8_SB(0, 1), b2 + hstep, voffB);
            PG8_WAIT_V(6); PG8_BAR; PG8_MMA(1, 1, At, B1); PG8_BAR;
            PG8_LDB(B0, 1, 0); PG8_SCHED; PG8_LDA(At, 1, 0); PG8_STAGE(PG8_SA(0, 1), a2 + hstep, voffA);
            PG8_WAIT_L(8); PG8_BAR; PG8_WAIT_L(0); PG8_MMA(0, 0, At, B0); PG8_BAR; PG8_SCHED;
            PG8_LDB(B1, 1, 1); PG8_STAGE(PG8_SB(1, 0), b3, voffB);
            PG8_BAR; PG8_WAIT_L(0); PG8_MMA(0, 1, At, B1); PG8_BAR;
            PG8_LDA(At, 1, 1); PG8_STAGE(PG8_SA(1, 0), a3, voffA);
            PG8_BAR; PG8_WAIT_L(0); PG8_MMA(1, 0, At, B0); PG8_BAR; PG8_SCHED;
            PG8_STAGE(PG8_SB(1, 1), b3 + hstep, voffB);
            PG8_WAIT_V(6); PG8_BAR; PG8_MMA(1, 1, At, B1); PG8_BAR;
            }
        }
        if constexpr (ALIGN_EPI) { if (wr == 0) PG8_BAR; }
        if constexpr (!Epi::AFTER_DRAIN) { int ln_e; asm volatile("v_mbcnt_lo_u32_b32 %0, -1, 0\n\tv_mbcnt_hi_u32_b32 %0, -1, %0" : "=v"(ln_e)); const int fr_e = ln_e & 15, fq_e = ln_e >> 4;
            E(acc, cur, wr, wc, fr_e, fq_e); S.done(cur); }
        if (!has_next) break;
#pragma unroll
        for (int a = 0; a < 2; ++a)
#pragma unroll
            for (int b = 0; b < 2; ++b)
#pragma unroll
                for (int m = 0; m < 4; ++m)
#pragma unroll
                    for (int n = 0; n < 2; ++n) acc[a][b][m][n] = (f32x4){0.f, 0.f, 0.f, 0.f};
        cur = nxt; cA = nA; cB = nB; ++ui;
        if constexpr (ALIGN_EPI) { if (wr == 1) PG8_BAR; }
    }
    PG8_WAIT_V(0);
    if constexpr (!ALIGN_EPI) { if (wr == 0) PG8_BAR; }
    PG8_BAR;
    if constexpr (Epi::AFTER_DRAIN) { E.fused(acc, cur, wr, wc, fr, fq, lds, wid, lane); S.done(cur); }
#undef PG8_SA
#undef PG8_SB
#undef PG8_STAGE
#undef PG8_LDA
#undef PG8_LDB
#undef PG8_MMA
#undef PG8_WAIT_V
#undef PG8_WAIT_L
#undef PG8_BAR
#undef PG8_SCHED
}
}
#define GAS __attribute__((address_space(1)))
#define LAS __attribute__((address_space(3)))
typedef unsigned short bf16;
typedef unsigned v4u __attribute__((ext_vector_type(4)));
typedef float f32x4 __attribute__((ext_vector_type(4)));
typedef short bf16x8 __attribute__((ext_vector_type(8)));
typedef GAS unsigned gu32;
typedef GAS unsigned long long gu64;
#define RLX_AGENT __ATOMIC_RELAXED, __HIP_MEMORY_SCOPE_AGENT
#define LDS_WAIT() asm volatile("s_waitcnt lgkmcnt(0)" ::: "memory")
#define VM_WAIT() asm volatile("s_waitcnt vmcnt(0)" ::: "memory")
__device__ __forceinline__ unsigned long long rt() { return __builtin_amdgcn_s_memrealtime(); }
__device__ __forceinline__ unsigned f2bf(float f) { unsigned u = __builtin_bit_cast(unsigned, f); return (u + 0x7fffu + ((u >> 16) & 1u)) >> 16; }
__device__ __forceinline__ unsigned pk2(float lo, float hi) { return f2bf(lo) | (f2bf(hi) << 16); }

#define XB_TMO      128
#define XB_XCNT(j)  (256  + 64 * (j))
#define XB_XSUB(j)  (1280 + 64 * (j))
#define XB_XGEN(j)  (2304 + 64 * (j))
#define XB_TOP      3328
#define XB_TOPGEN   3392
#define XCD_BAR_WORDS 3456
#define XB_SPIN_CAP (1u << 18)

__device__ __forceinline__ unsigned xb_ld(unsigned* p)              { return __hip_atomic_load(p, __ATOMIC_RELAXED, __HIP_MEMORY_SCOPE_AGENT); }
__device__ __forceinline__ unsigned xb_add(unsigned* p, unsigned v) { return __hip_atomic_fetch_add(p, v, __ATOMIC_RELAXED, __HIP_MEMORY_SCOPE_AGENT); }
__device__ __forceinline__ unsigned xb_xcc_id() { return (unsigned)__builtin_amdgcn_s_getreg((3 << 11) | 20) & 0xFu; }
#define XB_SPIN(cond, bar) do { unsigned _sp = 0; while (cond) { __builtin_amdgcn_s_sleep(1); \
    if ((++_sp & 255u) == 0u) { if (xb_ld(&(bar)[XB_TMO])) break; if (_sp > XB_SPIN_CAP) { atomicAdd(&(bar)[XB_TMO], 1u); break; } } } } while (0)

struct XcdBarrier {
    unsigned* bar; unsigned x; bool wave0;
    volatile LAS unsigned* st;
};

__device__ __forceinline__ XcdBarrier xcd_barrier_post(unsigned* bar, volatile LAS unsigned* st) {
    XcdBarrier b; b.bar = bar; b.x = xb_xcc_id(); b.st = st;
    if (threadIdx.x == 0) (void)xb_add(&bar[XB_XCNT(b.x)], 1u);
    return b;
}
__device__ __forceinline__ void xcd_barrier_complete(unsigned* bar, unsigned x, unsigned& nloc, unsigned& nx) {
    const unsigned G = gridDim.x * gridDim.y * gridDim.z;
    unsigned sum, cnt, mine, sp = 0u;
    for (;;) {
        sum = 0u; cnt = 0u; mine = 0u;
#pragma unroll
        for (unsigned j = 0; j < 16; ++j) { const unsigned c = xb_ld(&bar[XB_XCNT(j)]); sum += c; cnt += (c > 0u) ? 1u : 0u; mine = (j == x) ? c : mine; }
        if (sum == G) break;
        __builtin_amdgcn_s_sleep(1);
        if ((++sp & 255u) == 0u) { if (xb_ld(&bar[XB_TMO])) break; if (sp > XB_SPIN_CAP) { atomicAdd(&bar[XB_TMO], 1u); break; } }
    }
    nloc = mine > 0u ? mine : 1u; nx = cnt > 0u ? cnt : 1u;
}

__device__ __forceinline__ void xcd_barrier(const XcdBarrier& b) {
    asm volatile("s_waitcnt vmcnt(0)" ::: "memory");
    __syncthreads();
    if (b.wave0 && __builtin_amdgcn_mbcnt_hi(~0u, __builtin_amdgcn_mbcnt_lo(~0u, 0u)) == 0u) {
        unsigned* bar = b.bar;
        __builtin_amdgcn_s_waitcnt(0);
        unsigned nloc = b.st[0], nx = b.st[1];
        if (nloc == 0u) { xcd_barrier_complete(bar, b.x, nloc, nx); b.st[0] = nloc; b.st[1] = nx; }
        const unsigned old = xb_add(&bar[XB_XSUB(b.x)], 1u);
        const unsigned gen = old / nloc;
        if (old + 1u == (gen + 1u) * nloc) {
            __builtin_amdgcn_fence(__ATOMIC_RELEASE, "agent");
            asm volatile("s_waitcnt vmcnt(0)" ::: "memory");
            const unsigned og = xb_add(&bar[XB_TOP], 1u);
            const unsigned tg = og / nx;
            if (og + 1u == (tg + 1u) * nx) xb_add(&bar[XB_TOPGEN], 1u);
            else XB_SPIN(xb_ld(&bar[XB_TOPGEN]) == tg, bar);
            __builtin_amdgcn_fence(__ATOMIC_ACQUIRE, "agent");
            xb_add(&bar[XB_XGEN(b.x)], 1u);
            asm volatile("s_waitcnt vmcnt(0)" ::: "memory");
        } else {
            XB_SPIN(xb_ld(&bar[XB_XGEN(b.x)]) == gen, bar);
            __builtin_amdgcn_fence(__ATOMIC_ACQUIRE, "agent");
            asm volatile("s_waitcnt vmcnt(0)" ::: "memory");
        }
    }
    __syncthreads();
}

constexpr int NWAVES = 8, NTHREADS = NWAVES * 64;
constexpr int BATCH = 8, SEQ = 2048, T = BATCH * SEQ, D = 2048;
constexpr int EV_N = 7200, EV_NP = 7424, OD_N = 7616, OD_NP = 7680, PROJ_LD = 7680;
constexpr float EPS = 1e-6f;
constexpr int EC_GQ = 0, EC_GK = 512, EC_GV = 1024, EC_GZ = 2048, EC_GLR = 3072, EC_BQ = 3088, EC_BK = 4112, EC_BV = 5136, EC_BZ = 6160, EC_BA = 7184, EC_BB = 7192;
constexpr int OC_HQ = 0, OC_HF = 1024, OC_HI = 2048, OC_HG = 3072, OC_RW = 4096;
constexpr int RW_R = 0, RW_K = 1024, RW_V = 2048, RW_WL = 3072, RW_AL = 3168, RW_GL = 3264;
constexpr int LORA_K = 512, LORA_N = 3072;
enum { I_X = 0, I_P, I_EV_WIN, I_GK_W2, I_GK_B, I_GLA_NORM, I_GDN_CONV, I_GDN_ALOG, I_GDN_DTB, I_GDN_NORM, I_EV_WOUT, I_OD_WIN, I_LB, I_HG_NORM,
       I_MU, I_W0, I_W2, I_A0, I_A2, I_G2, I_KK, I_KA, I_RK, I_LNW, I_LNB, I_OD_WOUT, I_NMIX, I_NFFN, I_NPLE, I_PEER_WQ, I_PEER_SK, I_PEER_U, I_PEER_V,
       I_PLE_WP, I_PLE_WG, I_NFINAL, N_IN };

constexpr size_t MiB = 1u << 20;
constexpr size_t WS_CTL = 0, CTL_ZERO_BYTES = 1 * MiB, WS_SU = 256 * 1024, WS_CMB = 512 * 1024, WS_SA = 576 * 1024;
constexpr size_t WS_WEV_IN = 1 * MiB, WS_WEV_OUT = 30 * MiB, WS_WOD_IN = 38 * MiB, WS_WOD_OUT = 68 * MiB, WS_WPEER = 76 * MiB, WS_WGATE = 92 * MiB, WS_WPROJ = 108 * MiB,
                 WS_WLORA = 110 * MiB, WS_PBF = 113 * MiB, WS_TABU = 129 * MiB, WS_TABV = 193 * MiB, WS_ACTA = 257 * MiB, WS_ACTB = 321 * MiB, WS_PROJ = 385 * MiB, WS_SC = 385 * MiB,
                 WS_O = 625 * MiB, WS_H1 = 689 * MiB, WS_PP = 753 * MiB, WS_LA = 817 * MiB, WS_LO = 833 * MiB, WS_RSP = 929 * MiB, WS_STATE = 937 * MiB, WS_RS3 = 945 * MiB, WS_END = 946 * MiB;
static_assert(WS_WEV_IN + (size_t)EV_NP * D * 2 <= WS_WEV_OUT && WS_WOD_IN + (size_t)OD_NP * D * 2 <= WS_WOD_OUT && WS_PROJ + (size_t)T * PROJ_LD * 2 <= WS_O, "ws map");
constexpr int CW_BAR = 4096;
enum { RS_FFN0 = 0, RS_MIX1 = 1, RS_FFN1 = 2, RS_FINAL = 3 };
constexpr int RING_OFF = 0, RING_BYTES = 131072;
constexpr int LDSCTL_OFF = RING_BYTES, MISC_OFF = LDSCTL_OFF + 320;
constexpr int LDS_BYTES = 147456;

struct Args { const float* in[N_IN]; float* out; unsigned char* ws; int ph_lo, ph_hi; };
struct Frame {
    LAS unsigned char* lds; volatile LAS unsigned* MISC; gu32* ctl;
    int tid, lane, wave, vcu, G;
};
__device__ __forceinline__ float wave_sum(float v) {
#pragma unroll
    for (int o = 1; o < 64; o <<= 1) v += __shfl_xor(v, o);
    return v;
}
__device__ __forceinline__ float half_sum32(float v) {
#pragma unroll
    for (int o = 1; o < 32; o <<= 1) v += __shfl_xor(v, o);
    return v;
}
#define DPP_ADD(v, ctrl) (v) += __builtin_bit_cast(float, __builtin_amdgcn_update_dpp(0, __builtin_bit_cast(int, (v)), (ctrl), 0xF, 0xF, false))
__device__ __forceinline__ float row_sum16(float v) {
    DPP_ADD(v, 0x128); DPP_ADD(v, 0x124); DPP_ADD(v, 0x122); DPP_ADD(v, 0x121);
    return v;
}
__device__ __forceinline__ void row_sum16_x4(float& a, float& b, float& c, float& d) {
    asm("s_nop 1\n\t"
        "v_add_f32_dpp %0, %0, %0 row_ror:8 row_mask:0xf bank_mask:0xf\n\tv_add_f32_dpp %1, %1, %1 row_ror:8 row_mask:0xf bank_mask:0xf\n\t"
        "v_add_f32_dpp %2, %2, %2 row_ror:8 row_mask:0xf bank_mask:0xf\n\tv_add_f32_dpp %3, %3, %3 row_ror:8 row_mask:0xf bank_mask:0xf\n\t"
        "v_add_f32_dpp %0, %0, %0 row_ror:4 row_mask:0xf bank_mask:0xf\n\tv_add_f32_dpp %1, %1, %1 row_ror:4 row_mask:0xf bank_mask:0xf\n\t"
        "v_add_f32_dpp %2, %2, %2 row_ror:4 row_mask:0xf bank_mask:0xf\n\tv_add_f32_dpp %3, %3, %3 row_ror:4 row_mask:0xf bank_mask:0xf\n\t"
        "v_add_f32_dpp %0, %0, %0 row_ror:2 row_mask:0xf bank_mask:0xf\n\tv_add_f32_dpp %1, %1, %1 row_ror:2 row_mask:0xf bank_mask:0xf\n\t"
        "v_add_f32_dpp %2, %2, %2 row_ror:2 row_mask:0xf bank_mask:0xf\n\tv_add_f32_dpp %3, %3, %3 row_ror:2 row_mask:0xf bank_mask:0xf\n\t"
        "v_add_f32_dpp %0, %0, %0 row_ror:1 row_mask:0xf bank_mask:0xf\n\tv_add_f32_dpp %1, %1, %1 row_ror:1 row_mask:0xf bank_mask:0xf\n\t"
        "v_add_f32_dpp %2, %2, %2 row_ror:1 row_mask:0xf bank_mask:0xf\n\tv_add_f32_dpp %3, %3, %3 row_ror:1 row_mask:0xf bank_mask:0xf\n\t"
        "s_nop 1"
        : "+v"(a), "+v"(b), "+v"(c), "+v"(d));
}
__device__ __forceinline__ void row_sum16_x2(float& a, float& b) {
    asm("s_nop 1\n\t"
        "v_add_f32_dpp %0, %0, %0 row_ror:8 row_mask:0xf bank_mask:0xf\n\tv_add_f32_dpp %1, %1, %1 row_ror:8 row_mask:0xf bank_mask:0xf\n\ts_nop 1\n\t"
        "v_add_f32_dpp %0, %0, %0 row_ror:4 row_mask:0xf bank_mask:0xf\n\tv_add_f32_dpp %1, %1, %1 row_ror:4 row_mask:0xf bank_mask:0xf\n\ts_nop 1\n\t"
        "v_add_f32_dpp %0, %0, %0 row_ror:2 row_mask:0xf bank_mask:0xf\n\tv_add_f32_dpp %1, %1, %1 row_ror:2 row_mask:0xf bank_mask:0xf\n\ts_nop 1\n\t"
        "v_add_f32_dpp %0, %0, %0 row_ror:1 row_mask:0xf bank_mask:0xf\n\tv_add_f32_dpp %1, %1, %1 row_ror:1 row_mask:0xf bank_mask:0xf\n\t"
        "s_nop 1"
        : "+v"(a), "+v"(b));
}
typedef unsigned u32x2 __attribute__((ext_vector_type(2)));
__device__ __forceinline__ void st_wt16(void* p, v4u v) { asm volatile("global_store_dwordx4 %0, %1, off sc1\n\ts_nop 1" :: "v"(p), "v"(v) : "memory"); }
__device__ __forceinline__ void st_wt8(void* p, u32x2 v) { asm volatile("global_store_dwordx2 %0, %1, off sc1\n\ts_nop 1" :: "v"(p), "v"(v) : "memory"); }
#define LBAR() do { asm volatile("s_waitcnt lgkmcnt(0)" ::: "memory"); __builtin_amdgcn_s_barrier(); asm volatile("" ::: "memory"); } while (0)
typedef float f32x2 __attribute__((ext_vector_type(2)));
typedef __bf16 hwbf16x2_t __attribute__((ext_vector_type(2)));
__device__ __forceinline__ unsigned hw_pk2(float lo, float hi) { const f32x2 v = {lo, hi}; return __builtin_bit_cast(unsigned, __builtin_convertvector(v, hwbf16x2_t)); }
__device__ __forceinline__ bf16 hw_bf(float x) { return (bf16)hw_pk2(x, 0.f); }
__device__ __forceinline__ float bf_lo(unsigned w) { return __uint_as_float(w << 16); }
__device__ __forceinline__ float bf_hi(unsigned w) { return __uint_as_float(w & 0xffff0000u); }
__device__ __forceinline__ float sigmoidf_(float x) { return __builtin_amdgcn_rcpf(1.0f + __expf(-x)); }
__device__ __forceinline__ float siluf_(float x) { return x * __builtin_amdgcn_rcpf(1.0f + __expf(-x)); }
__device__ __forceinline__ float softplusf_(float x) { return fmaxf(x, 0.f) + log1pf(__expf(-fabsf(x))); }
__device__ __forceinline__ float logsigmoidf_(float x) { return fminf(x, 0.f) - log1pf(__expf(-fabsf(x))); }

struct EpiBf16S {
    static constexpr bool PERM = true, AFTER_DRAIN = false;
    bf16* O; int ldc; const float* rowss;
    __device__ __forceinline__ void operator()(const pg8::f32x4 (&acc)[2][2][4][2], const pg8::Unit& u, int wr, int wc, int fr, int fq) const {
        const int row0 = u.pm * 256 + wr * 64 + fr, col0 = u.pn * 256 + wc * 32 + 8 * fq;
#pragma unroll
        for (int ai = 0; ai < 2; ++ai)
#pragma unroll
            for (int m = 0; m < 4; ++m) {
                const int row = row0 + ai * 128 + m * 16;
                float sc = 1.f;
                if (rowss) { const pg8::f32x4* rp = (const pg8::f32x4*)(rowss + (size_t)row * 32 + 8 * fq); const pg8::f32x4 p0 = rp[0], p1 = rp[1];
                    float s = ((p0[0] + p0[1]) + (p0[2] + p0[3])) + ((p1[0] + p1[1]) + (p1[2] + p1[3])); s += __shfl_xor(s, 16); s += __shfl_xor(s, 32);
                    sc = __builtin_amdgcn_rsqf(s * (1.0f / D) + EPS); }
                bf16* rowp = O + (size_t)row * ldc + col0;
#pragma unroll
                for (int bj = 0; bj < 2; ++bj) { const pg8::f32x4 v0 = acc[ai][bj][m][0] * sc, v1 = acc[ai][bj][m][1] * sc;
                    pg8::u32x4 w; w.x = pg8::cvt_pk_bf16(v0[0], v0[1]); w.y = pg8::cvt_pk_bf16(v0[2], v0[3]); w.z = pg8::cvt_pk_bf16(v1[0], v1[1]); w.w = pg8::cvt_pk_bf16(v1[2], v1[3]);
                    *(pg8::u32x4*)(rowp + bj * 128) = w; } }
    }
};
struct EpiI8S {
    static constexpr bool PERM = true, AFTER_DRAIN = false;
    bf16* O; int ldc; const float* sa; const float* cb;
    __device__ __forceinline__ void operator()(const pg8::f32x4 (&acc)[2][2][4][2], const pg8::Unit& u, int wr, int wc, int fr, int fq) const {
        const int row0 = u.pm * 256 + wr * 64 + fr, col0 = u.pn * 256 + wc * 32 + 8 * fq;
        pg8::f32x4 cs[2][2];
#pragma unroll
        for (int bj = 0; bj < 2; ++bj) { cs[bj][0] = *(const pg8::f32x4*)(cb + col0 + bj * 128); cs[bj][1] = *(const pg8::f32x4*)(cb + col0 + bj * 128 + 4); }
#pragma unroll
        for (int ai = 0; ai < 2; ++ai)
#pragma unroll
            for (int m = 0; m < 4; ++m) {
                const int row = row0 + ai * 128 + m * 16;
                const float sc = sa[row];
                bf16* rowp = O + (size_t)row * ldc + col0;
#pragma unroll
                for (int bj = 0; bj < 2; ++bj) { pg8::f32x4 v0, v1;
#pragma unroll
                    for (int e = 0; e < 4; ++e) { v0[e] = (float)__float_as_int(acc[ai][bj][m][0][e]) * sc * cs[bj][0][e]; v1[e] = (float)__float_as_int(acc[ai][bj][m][1][e]) * sc * cs[bj][1][e]; }
                    pg8::u32x4 w; w.x = pg8::cvt_pk_bf16(v0[0], v0[1]); w.y = pg8::cvt_pk_bf16(v0[2], v0[3]); w.z = pg8::cvt_pk_bf16(v1[0], v1[1]); w.w = pg8::cvt_pk_bf16(v1[2], v1[3]);
                    *(pg8::u32x4*)(rowp + bj * 128) = w; } }
    }
};
template <bool GATE, bool HIN_F32, bool I8 = false> struct EpiResid {
    static constexpr bool PERM = false, AFTER_DRAIN = false;
    const void* hin; bf16* hout; float* rowss; const bf16* pp; const float* rs3; unsigned char* h8; const float* sa; const float* cb;
    __device__ __forceinline__ void operator()(const pg8::f32x4 (&acc)[2][2][4][2], const pg8::Unit& u, int wr, int wc, int fr, int fq) const {
        const int row0 = u.pm * 256 + wr * 64 + fr, col0 = u.pn * 256 + wc * 32 + 4 * fq;
        pg8::f32x4 cs[2][2];
        if constexpr (I8) {
#pragma unroll
            for (int bj = 0; bj < 2; ++bj)
#pragma unroll
                for (int n = 0; n < 2; ++n) cs[bj][n] = *(const pg8::f32x4*)(cb + col0 + bj * 128 + n * 16); }
        constexpr int MG = HIN_F32 ? 2 : 4;
#pragma unroll
        for (int ai = 0; ai < 2; ++ai)
#pragma unroll
            for (int m0 = 0; m0 < 4; m0 += MG) {
                pg8::f32x4 hf[MG][2][2]; pg8::u32x2 hb[MG][2][2], pw[MG][2][2]; float rsc[MG];
#pragma unroll
                for (int mm = 0; mm < MG; ++mm) { const int row = row0 + ai * 128 + (m0 + mm) * 16; const size_t off = (size_t)row * D + col0; rsc[mm] = GATE ? rs3[row] : (I8 ? sa[row] : 1.f);
#pragma unroll
                    for (int bj = 0; bj < 2; ++bj)
#pragma unroll
                        for (int n = 0; n < 2; ++n) { const size_t o = off + bj * 128 + n * 16;
                            if (HIN_F32) hf[mm][bj][n] = *(const pg8::f32x4*)((const float*)hin + o); else hb[mm][bj][n] = *(const pg8::u32x2*)((const bf16*)hin + o);
                            if (GATE) pw[mm][bj][n] = *(const pg8::u32x2*)(pp + o); } }
#pragma unroll
                for (int mm = 0; mm < MG; ++mm) { const int m = m0 + mm; const int row = row0 + ai * 128 + m * 16; const size_t off = (size_t)row * D + col0; float ss = 0.f;
#pragma unroll
                    for (int bj = 0; bj < 2; ++bj)
#pragma unroll
                        for (int n = 0; n < 2; ++n) { const size_t o = off + bj * 128 + n * 16;
                            pg8::f32x4 hv;
                            if (HIN_F32) hv = hf[mm][bj][n];
                            else { const pg8::u32x2 hw = hb[mm][bj][n]; hv[0] = bf_lo(hw.x); hv[1] = bf_hi(hw.x); hv[2] = bf_lo(hw.y); hv[3] = bf_hi(hw.y); }
                            pg8::f32x4 a = acc[ai][bj][m][n];
                            if constexpr (I8 && !GATE) { const float sr_ = rsc[mm];
#pragma unroll
                                for (int e = 0; e < 4; ++e) a[e] = (float)__float_as_int(a[e]) * sr_ * cs[bj][n][e]; }
                            if (GATE) { const pg8::u32x2 p2 = pw[mm][bj][n]; const float rs_ = rsc[mm];
                                a[0] = sigmoidf_(a[0] * rs_) * bf_lo(p2.x); a[1] = sigmoidf_(a[1] * rs_) * bf_hi(p2.x); a[2] = sigmoidf_(a[2] * rs_) * bf_lo(p2.y); a[3] = sigmoidf_(a[3] * rs_) * bf_hi(p2.y); }
                            hv = hv + a;
                            pg8::u32x2 w; w.x = hw_pk2(hv[0], hv[1]); w.y = hw_pk2(hv[2], hv[3]); *(pg8::u32x2*)(hout + o) = w;
                            if (h8) { int x8 = __builtin_amdgcn_cvt_pk_fp8_f32(hv[0], hv[1], 0, false); x8 = __builtin_amdgcn_cvt_pk_fp8_f32(hv[2], hv[3], x8, true); *(unsigned*)(h8 + o) = (unsigned)x8; }
                            const float q0 = bf_lo(w.x), q1 = bf_hi(w.x), q2 = bf_lo(w.y), q3 = bf_hi(w.y);
                            ss += (q0 * q0 + q1 * q1) + (q2 * q2 + q3 * q3); }
                    ss += __shfl_xor(ss, 16); ss += __shfl_xor(ss, 32);
                    if (fq == 0) rowss[(size_t)row * 32 + u.pn * 4 + wc] = ss; }
                asm volatile("" ::: "memory"); }
    }
};


__device__ __forceinline__ void p0_transpose_item(const float* W, int K, int N, bf16* WT, LAS float* scr, int item, int lane, const float* kgain = nullptr) {
    const int nblk = N / 32, kb = item / nblk, nb = item % nblk, k0 = 64 * kb, n0 = 32 * nb;
    { const GAS float* Wg = (const GAS float*)W + (size_t)(k0 + (lane >> 5)) * N + n0 + (lane & 31); float v[32];
#pragma unroll
      for (int i = 0; i < 32; ++i) v[i] = Wg[(size_t)(2 * i) * N];
#pragma unroll
      for (int i = 0; i < 32; ++i) scr[(2 * i + (lane >> 5)) * 33 + (lane & 31)] = v[i]; }
    LDS_WAIT(); asm volatile("" ::: "memory");
    const int c = lane & 7;
#pragma unroll
    for (int j = 0; j < 4; ++j) { const int n = (lane >> 3) + 8 * j; const LAS float* s = scr + (8 * c) * 33 + n;
        f32x4 g0 = {1.f, 1.f, 1.f, 1.f}, g1 = g0; if (kgain) { g0 = *(const GAS f32x4*)(kgain + k0 + 8 * c); g1 = *(const GAS f32x4*)(kgain + k0 + 8 * c + 4); }
        v4u o; o.x = pk2(s[0 * 33] * g0[0], s[1 * 33] * g0[1]); o.y = pk2(s[2 * 33] * g0[2], s[3 * 33] * g0[3]); o.z = pk2(s[4 * 33] * g1[0], s[5 * 33] * g1[1]); o.w = pk2(s[6 * 33] * g1[2], s[7 * 33] * g1[3]);
        *(GAS v4u*)(WT + (size_t)(n0 + n) * K + k0 + 8 * c) = o; }
    LDS_WAIT(); asm volatile("" ::: "memory");
}
__device__ __forceinline__ void p0_transpose_item_i8(const float* W, int K, int N, unsigned char* WT, LAS float* scr, int item, int lane, const float* cm) {
    const int nblk = N / 32, kb = item / nblk, nb = item % nblk, k0 = 64 * kb, n0 = 32 * nb;
    { const GAS float* Wg = (const GAS float*)W + (size_t)(k0 + (lane >> 5)) * N + n0 + (lane & 31); float v[32];
#pragma unroll
      for (int i = 0; i < 32; ++i) v[i] = Wg[(size_t)(2 * i) * N];
#pragma unroll
      for (int i = 0; i < 32; ++i) scr[(2 * i + (lane >> 5)) * 33 + (lane & 31)] = v[i]; }
    LDS_WAIT(); asm volatile("" ::: "memory");
    const int c = lane & 7;
#pragma unroll
    for (int j = 0; j < 4; ++j) { const int n = (lane >> 3) + 8 * j; const LAS float* s = scr + (8 * c) * 33 + n;
        const float mx = __uint_as_float(__hip_atomic_load((const unsigned*)cm + n0 + n, __ATOMIC_RELAXED, __HIP_MEMORY_SCOPE_AGENT)), inv = mx > 0.f ? 127.0f / mx : 0.f; unsigned w0 = 0, w1 = 0;
#pragma unroll
        for (int e = 0; e < 4; ++e) { w0 |= (__float_as_uint(__builtin_fmaf(s[e * 33], inv, 12582912.0f)) & 255u) << (8 * e); w1 |= (__float_as_uint(__builtin_fmaf(s[(4 + e) * 33], inv, 12582912.0f)) & 255u) << (8 * e); }
        u32x2 o; o.x = w0; o.y = w1;
        *(GAS u32x2*)(WT + (size_t)(n0 + n) * K + k0 + 8 * c) = o; }
    LDS_WAIT(); asm volatile("" ::: "memory");
}
__device__ __forceinline__ void colmax_item(const float* W, int K, int N, float* cm, int item, int lane) {
    const int ngrp = (N + 255) / 256, kb = item / ngrp, cg_ = item % ngrp, col = 256 * cg_ + 4 * lane;
    if (col >= N) return;
    const GAS f32x4* p = (const GAS f32x4*)((const GAS float*)W + (size_t)(64 * kb) * N + col); f32x4 m = {0.f, 0.f, 0.f, 0.f};
#pragma unroll 16
    for (int r = 0; r < 64; ++r) { const f32x4 v = *(const GAS f32x4*)((const GAS float*)p + (size_t)r * N);
#pragma unroll
        for (int e = 0; e < 4; ++e) m[e] = fmaxf(m[e], fabsf(v[e])); }
#pragma unroll
    for (int e = 0; e < 4; ++e) __hip_atomic_fetch_max((unsigned*)cm + col + e, __float_as_uint(m[e]), __ATOMIC_RELAXED, __HIP_MEMORY_SCOPE_AGENT);
}
__device__ __forceinline__ void p0_transpose_item_f8(const float* W, int K, int N, unsigned char* WT, LAS float* scr, int item, int lane, const float* kgain = nullptr) {
    const int nblk = N / 32, kb = item / nblk, nb = item % nblk, k0 = 64 * kb, n0 = 32 * nb;
    { const GAS float* Wg = (const GAS float*)W + (size_t)(k0 + (lane >> 5)) * N + n0 + (lane & 31); float v[32];
#pragma unroll
      for (int i = 0; i < 32; ++i) v[i] = Wg[(size_t)(2 * i) * N];
#pragma unroll
      for (int i = 0; i < 32; ++i) scr[(2 * i + (lane >> 5)) * 33 + (lane & 31)] = v[i]; }
    LDS_WAIT(); asm volatile("" ::: "memory");
    const int c = lane & 7;
#pragma unroll
    for (int j = 0; j < 4; ++j) { const int n = (lane >> 3) + 8 * j; const LAS float* s = scr + (8 * c) * 33 + n;
        f32x4 g0 = {64.f, 64.f, 64.f, 64.f}, g1 = g0; if (kgain) { g0 = g0 * *(const GAS f32x4*)(kgain + k0 + 8 * c); g1 = g1 * *(const GAS f32x4*)(kgain + k0 + 8 * c + 4); }
        int x0 = __builtin_amdgcn_cvt_pk_fp8_f32(s[0 * 33] * g0[0], s[1 * 33] * g0[1], 0, false); x0 = __builtin_amdgcn_cvt_pk_fp8_f32(s[2 * 33] * g0[2], s[3 * 33] * g0[3], x0, true);
        int x1 = __builtin_amdgcn_cvt_pk_fp8_f32(s[4 * 33] * g1[0], s[5 * 33] * g1[1], 0, false); x1 = __builtin_amdgcn_cvt_pk_fp8_f32(s[6 * 33] * g1[2], s[7 * 33] * g1[3], x1, true);
        u32x2 o; o.x = (unsigned)x0; o.y = (unsigned)x1;
        *(GAS u32x2*)(WT + (size_t)(n0 + n) * K + k0 + 8 * c) = o; }
    LDS_WAIT(); asm volatile("" ::: "memory");
}
__device__ __forceinline__ void cvt_f32_bf16(const float* src, bf16* dst, size_t n, int gtid, int gthreads) {
    const size_t n8 = n / 8;
    for (size_t i = gtid; i < n8; i += gthreads) {
        const f32x4 a = *(const GAS f32x4*)(src + i * 8), b = *(const GAS f32x4*)(src + i * 8 + 4);
        v4u o; o.x = pk2(a[0], a[1]); o.y = pk2(a[2], a[3]); o.z = pk2(b[0], b[1]); o.w = pk2(b[2], b[3]);
        *(GAS v4u*)(dst + i * 8) = o; }
}
__device__ __forceinline__ void cvt_f32_fp8(const float* src, unsigned char* dst, size_t n, float scale, int gtid, int gthreads, const float* cgain = nullptr) {
    const size_t n16 = n / 16;
    for (size_t i = gtid; i < n16; i += gthreads) { v4u o; unsigned w[4];
#pragma unroll
        for (int q = 0; q < 4; ++q) { f32x4 a = *(const GAS f32x4*)(src + i * 16 + 4 * q) * scale; if (cgain) a = a * *(const GAS f32x4*)(cgain + ((i * 16 + 4 * q) & (D - 1)));
            int x = __builtin_amdgcn_cvt_pk_fp8_f32(a[0], a[1], 0, false); x = __builtin_amdgcn_cvt_pk_fp8_f32(a[2], a[3], x, true); w[q] = (unsigned)x; }
        o.x = w[0]; o.y = w[1]; o.z = w[2]; o.w = w[3];
        *(GAS v4u*)(dst + i * 16) = o; }
}
__device__ __forceinline__ void cvt_rows_i8(const float* src, unsigned char* dst, float* SU, int rows, int gw, int NGW, int lane, const float* cgain) {
    f32x4 a[8], nx[8];
    int r = gw;
    if (r < rows) {
#pragma unroll
        for (int i = 0; i < 8; ++i) a[i] = *(const GAS f32x4*)(src + (size_t)r * D + 256 * i + 4 * lane); }
    for (; r < rows; r += NGW) {
        const int rn = r + NGW;
        if (rn < rows) {
#pragma unroll
            for (int i = 0; i < 8; ++i) nx[i] = *(const GAS f32x4*)(src + (size_t)rn * D + 256 * i + 4 * lane); }
        float mx = 0.f;
#pragma unroll
        for (int i = 0; i < 8; ++i) { if (cgain) a[i] = a[i] * *(const GAS f32x4*)(cgain + 256 * i + 4 * lane);
            mx = fmaxf(mx, fmaxf(fmaxf(fabsf(a[i][0]), fabsf(a[i][1])), fmaxf(fabsf(a[i][2]), fabsf(a[i][3])))); }
#pragma unroll
        for (int o = 1; o < 64; o <<= 1) mx = fmaxf(mx, __shfl_xor(mx, o));
        const float inv = mx > 0.f ? 127.0f / mx : 0.f;
#pragma unroll
        for (int i = 0; i < 8; ++i) { unsigned w = 0;
#pragma unroll
            for (int e = 0; e < 4; ++e) w |= (__float_as_uint(__builtin_fmaf(a[i][e], inv, 12582912.0f)) & 255u) << (8 * e);
            *(GAS unsigned*)(dst + (size_t)r * D + 256 * i + 4 * lane) = w; }
        if (lane == 0) SU[r] = mx * (1.0f / 127.0f);
#pragma unroll
        for (int i = 0; i < 8; ++i) a[i] = nx[i];
    }
}
__device__ __forceinline__ void rms_row_to_bf16(const float* xrow, const float* g, bf16* orow, int lane) {
    const GAS f32x4* xr = (const GAS f32x4*)xrow + lane; f32x4 v[8]; float s = 0.f;
#pragma unroll
    for (int j = 0; j < 8; ++j) { v[j] = xr[64 * j]; s += (v[j][0] * v[j][0] + v[j][1] * v[j][1]) + (v[j][2] * v[j][2] + v[j][3] * v[j][3]); }
    const float r = __builtin_amdgcn_rsqf(wave_sum(s) * (1.0f / D) + EPS);
    const GAS f32x4* gr = (const GAS f32x4*)g + lane;
    GAS unsigned long long* o8 = (GAS unsigned long long*)orow + lane;
#pragma unroll
    for (int j = 0; j < 8; ++j) { const f32x4 gg = gr[64 * j]; o8[64 * j] = (unsigned long long)pk2(v[j][0] * r * gg[0], v[j][1] * r * gg[1]) | ((unsigned long long)pk2(v[j][2] * r * gg[2], v[j][3] * r * gg[3]) << 32); }
}
__device__ __forceinline__ void rms_row_to_i8(const float* xrow, const float* g, unsigned char* orow, float* sa, int lane) {
    const GAS f32x4* xr = (const GAS f32x4*)xrow + lane; f32x4 v[8]; float s = 0.f;
#pragma unroll
    for (int j = 0; j < 8; ++j) { v[j] = xr[64 * j]; s += (v[j][0] * v[j][0] + v[j][1] * v[j][1]) + (v[j][2] * v[j][2] + v[j][3] * v[j][3]); }
    const float r = __builtin_amdgcn_rsqf(wave_sum(s) * (1.0f / D) + EPS);
    const GAS f32x4* gr = (const GAS f32x4*)g + lane; float mx = 0.f;
#pragma unroll
    for (int j = 0; j < 8; ++j) { v[j] = v[j] * gr[64 * j] * r; mx = fmaxf(mx, fmaxf(fmaxf(fabsf(v[j][0]), fabsf(v[j][1])), fmaxf(fabsf(v[j][2]), fabsf(v[j][3])))); }
#pragma unroll
    for (int o = 1; o < 64; o <<= 1) mx = fmaxf(mx, __shfl_xor(mx, o));
    const float inv = mx > 0.f ? 127.0f / mx : 0.f;
    GAS unsigned* o4 = (GAS unsigned*)orow + lane;
#pragma unroll
    for (int j = 0; j < 8; ++j) { unsigned w = 0;
#pragma unroll
        for (int e = 0; e < 4; ++e) w |= (__float_as_uint(__builtin_fmaf(v[j][e], inv, 12582912.0f)) & 255u) << (8 * e);
        o4[64 * j] = w; }
    if (lane == 0) *sa = mx * (1.0f / (127.0f * 127.0f));
}
__device__ __forceinline__ void rms_row_to_f8(const float* xrow, const float* g, unsigned char* orow, int lane) {
    const GAS f32x4* xr = (const GAS f32x4*)xrow + lane; f32x4 v[8]; float s = 0.f;
#pragma unroll
    for (int j = 0; j < 8; ++j) { v[j] = xr[64 * j]; s += (v[j][0] * v[j][0] + v[j][1] * v[j][1]) + (v[j][2] * v[j][2] + v[j][3] * v[j][3]); }
    const float r = __builtin_amdgcn_rsqf(wave_sum(s) * (1.0f / D) + EPS);
    const GAS f32x4* gr = (const GAS f32x4*)g + lane;
    GAS unsigned* o4 = (GAS unsigned*)orow + lane;
#pragma unroll
    for (int j = 0; j < 8; ++j) { const f32x4 q = v[j] * gr[64 * j] * r; int x = __builtin_amdgcn_cvt_pk_fp8_f32(q[0], q[1], 0, false); x = __builtin_amdgcn_cvt_pk_fp8_f32(q[2], q[3], x, true); o4[64 * j] = (unsigned)x; }
}
__device__ __forceinline__ void p0_fold_item(const float* wq, const float* sk, bf16* WP, LAS float* lds, int item, int tid, const float* kgain) {
    const int hp = item >> 5, k0 = (item & 31) * 64;
    LAS float* skT = lds;
    LAS float* wqT = lds + 128 * 132;
    const float* skb = sk + (size_t)hp * 128 * 128;
#pragma unroll 4
    for (int i = 0; i < 32; ++i) { const int idx = i * 512 + tid, n = idx >> 7, d = idx & 127; skT[d * 132 + n] = skb[idx]; }
#pragma unroll 4
    for (int i = 0; i < 16; ++i) { const int idx = i * 512 + tid, kk = idx >> 7, d = idx & 127; wqT[d * 68 + kk] = wq[(size_t)(k0 + kk) * D + hp * 128 + d] * kgain[k0 + kk]; }
    __syncthreads();
    const int n0 = (tid >> 4) * 4, kk0 = (tid & 15) * 4;
    float acc[4][4];
#pragma unroll
    for (int i = 0; i < 4; ++i)
#pragma unroll
        for (int j = 0; j < 4; ++j) acc[i][j] = 0.f;
#pragma unroll 4
    for (int d = 0; d < 128; ++d) { const f32x4 a = *(const LAS f32x4*)(skT + d * 132 + n0), b = *(const LAS f32x4*)(wqT + d * 68 + kk0);
#pragma unroll
        for (int i = 0; i < 4; ++i)
#pragma unroll
            for (int j = 0; j < 4; ++j) acc[i][j] += a[i] * b[j]; }
#pragma unroll
    for (int i = 0; i < 4; ++i) { unsigned long long o = (unsigned long long)pk2(acc[i][0], acc[i][1]) | ((unsigned long long)pk2(acc[i][2], acc[i][3]) << 32);
        *(GAS unsigned long long*)(WP + (size_t)(hp * 128 + n0 + i) * D + k0 + kk0) = o; }
    __syncthreads();
}
__device__ __forceinline__ void p0_prologue(const Args& A, Frame& F, const int part) {
    const int gw = F.vcu * NWAVES + F.wave, NGW = F.G * NWAVES;
    const int gtid = gw * 64 + F.lane, gthreads = F.G * NTHREADS;
    unsigned char* ws = A.ws;
    LAS float* scr = (LAS float*)(F.lds + RING_OFF + F.wave * 16384);
    constexpr int I_EVIN = (D / 64) * (EV_N / 32);
    if (part == 1) {
        for (int it = gw; it < I_EVIN; it += NGW) p0_transpose_item_i8(A.in[I_EV_WIN], D, EV_N, (unsigned char*)(ws + WS_WEV_IN), scr, it, F.lane, (const float*)(ws + WS_CMB));
        return; }
    { constexpr int I_CM = (D / 64) * ((EV_N + 255) / 256);
      for (int it = gw; it < I_CM; it += NGW) colmax_item(A.in[I_EV_WIN], D, EV_N, (float*)(ws + WS_CMB), it, F.lane); }
    { GAS v4u* z0 = (GAS v4u*)(ws + WS_WEV_IN + (size_t)EV_N * D); const size_t n0 = (size_t)(EV_NP - EV_N) * D / 16;
      for (size_t i = gtid; i < n0; i += gthreads) z0[i] = (v4u){0u, 0u, 0u, 0u}; }
    { constexpr int I_PJ = (256 / 64) * (D / 32);
      for (int it = gw; it < 2 * I_PJ; it += NGW) { const int L = it / I_PJ; p0_transpose_item(A.in[I_PLE_WP] + (size_t)L * 256 * D, 256, D, (bf16*)(ws + WS_WPROJ) + (size_t)L * D * 256, scr, it % I_PJ, F.lane); } }
    cvt_f32_bf16(A.in[I_P], (bf16*)(ws + WS_PBF), (size_t)2 * T * 256, gtid, gthreads);
    for (int m = gw; m < T; m += NGW) rms_row_to_i8(A.in[I_X] + (size_t)m * D, A.in[I_NMIX], (unsigned char*)(ws + WS_ACTA) + (size_t)m * D, (float*)(ws + WS_SA) + m, F.lane);
#if EV_F8_T1 > EV_F8_T0
    for (int it = gw; it < I_EVIN; it += NGW) p0_transpose_item_f8(A.in[I_EV_WIN], D, EV_N, (unsigned char*)(ws + WS_O), scr, it, F.lane);
    { GAS v4u* z0 = (GAS v4u*)(ws + WS_O + (size_t)EV_N * D); const size_t n0 = (size_t)(EV_NP - EV_N) * D / 16;
      for (size_t i = gtid; i < n0; i += gthreads) z0[i] = (v4u){0u, 0u, 0u, 0u}; }
    for (int m = gw; m < T; m += NGW) rms_row_to_f8(A.in[I_X] + (size_t)m * D, A.in[I_NMIX], (unsigned char*)(ws + WS_H1) + (size_t)m * D, F.lane);
#endif
}
__device__ __forceinline__ void p0_deferred(const Args& A, Frame& F, int wg, int nwg) {
    const int gw = wg * NWAVES + F.wave, NGW = nwg * NWAVES;
    int gtid = gw * 64 + F.lane; const int gthreads = nwg * NTHREADS;
    asm volatile("" : "+v"(gtid));
    unsigned char* ws = A.ws;
    {
        LAS float* scr = (LAS float*)(F.lds + RING_OFF + F.wave * 16384);
        constexpr int I_SQ = (D / 64) * (D / 32), I_ODIN = (D / 64) * (OD_N / 32);
        constexpr int NITEMS = I_SQ + I_ODIN + I_SQ;
        for (int it = gw; it < NITEMS; it += NGW) {
            int r = it;
            if (r < I_SQ) { p0_transpose_item(A.in[I_EV_WOUT], D, D, (bf16*)(ws + WS_WEV_OUT), scr, r, F.lane); continue; } r -= I_SQ;
            if (r < I_ODIN) { p0_transpose_item_f8(A.in[I_OD_WIN], D, OD_N, (unsigned char*)(ws + WS_WOD_IN), scr, r, F.lane, A.in[I_NMIX] + D); continue; } r -= I_ODIN;
            p0_transpose_item_f8(A.in[I_PLE_WG], D, D, (unsigned char*)(ws + WS_WGATE), scr, r, F.lane, A.in[I_NPLE]);
        }
        { GAS v4u* z1 = (GAS v4u*)(ws + WS_WOD_IN + (size_t)OD_N * D); const size_t n1 = (size_t)(OD_NP - OD_N) * D / 16;
          for (size_t i = gtid; i < n1; i += gthreads) z1[i] = (v4u){0u, 0u, 0u, 0u}; }
    }
    __syncthreads();
    for (int it = wg; it < 512; it += nwg)
        p0_fold_item(A.in[I_PEER_WQ], A.in[I_PEER_SK], (bf16*)(ws + WS_WPEER), (LAS float*)(F.lds + RING_OFF), it, F.tid, A.in[I_NFFN]);
    cvt_rows_i8(A.in[I_PEER_U], (unsigned char*)(ws + WS_TABU), (float*)(ws + WS_SU), 16384, gw, NGW, F.lane, A.in[I_NFFN]);
    cvt_rows_i8(A.in[I_PEER_V], (unsigned char*)(ws + WS_TABV), (float*)(ws + WS_SU) + 32768, 16384, gw, NGW, F.lane, nullptr);
    { bf16* LB = (bf16*)(ws + WS_WLORA); const float* w2 = A.in[I_W2]; const float* a2 = A.in[I_A2]; const float* g2 = A.in[I_G2];
      for (int i = gtid; i < LORA_N * LORA_K / 2; i += gthreads) { const int row = i / (LORA_K / 2), col = (i % (LORA_K / 2)) * 2; float v[2];
#pragma unroll
          for (int e = 0; e < 2; ++e) { const int c = col + e; float x = 0.f;
              if (row < 1024) { if (c < 96) x = w2[c * 1024 + row]; }
              else if (row < 2048) { if (c >= 96 && c < 192) x = a2[(c - 96) * 1024 + (row - 1024)]; }
              else { if (c >= 192 && c < 448) x = g2[(c - 192) * 1024 + (row - 2048)]; }
              v[e] = x; }
          *(GAS unsigned*)(LB + (size_t)row * LORA_K + col) = pk2(v[0], v[1]); } }
}
__device__ __forceinline__ void p1_deferred(const Args& A, Frame& F, int wg, int nwg) {
    const int gw = wg * NWAVES + F.wave, NGW = nwg * NWAVES;
    int gtid = gw * 64 + F.lane; const int gthreads = nwg * NTHREADS;
    asm volatile("" : "+v"(gtid));
    unsigned char* ws = A.ws;
    { LAS float* scr = (LAS float*)(F.lds + RING_OFF + F.wave * 16384); constexpr int I_SQ = (D / 64) * (D / 32);
      for (int it = gw; it < 2 * I_SQ; it += NGW) {
          if (it < I_SQ) p0_transpose_item_f8(A.in[I_OD_WOUT], D, D, (unsigned char*)(ws + WS_WOD_OUT), scr, it, F.lane);
          else p0_transpose_item_f8(A.in[I_PLE_WG] + (size_t)D * D, D, D, (unsigned char*)((bf16*)(ws + WS_WGATE) + (size_t)D * D), scr, it - I_SQ, F.lane, A.in[I_NPLE] + D); } }
    __syncthreads();
    for (int it = wg; it < 512; it += nwg)
        p0_fold_item(A.in[I_PEER_WQ] + (size_t)D * D, A.in[I_PEER_SK] + (size_t)16 * 128 * 128, (bf16*)(ws + WS_WPEER) + (size_t)D * D, (LAS float*)(F.lds + RING_OFF), it, F.tid, A.in[I_NFFN] + D);
    cvt_rows_i8(A.in[I_PEER_U] + (size_t)16384 * D, (unsigned char*)(ws + WS_TABU) + (size_t)16384 * D, (float*)(ws + WS_SU) + 16384, 16384, gw, NGW, F.lane, A.in[I_NFFN] + D);
    cvt_rows_i8(A.in[I_PEER_V] + (size_t)16384 * D, (unsigned char*)(ws + WS_TABV) + (size_t)16384 * D, (float*)(ws + WS_SU) + 32768 + 16384, 16384, gw, NGW, F.lane, nullptr);
}

constexpr int TC = 16, NCHUNK = SEQ / TC;

template <int MODE>
__device__ __forceinline__ void scan_gla_unit(const Args& A, Frame& F, int unit) {
    int tid = F.tid; asm volatile("" : "+v"(tid));
    const int lane = tid & 63, w = F.wave;
    int b, h, qcol, kcol, vcol, ocol;
    if (MODE == 0) { b = unit >> 4; h = (unit >> 2) & 3; const int s = unit & 3; qcol = EC_GQ + h * 128; kcol = EC_GK + h * 128; vcol = EC_GV + h * 256 + s * 64; ocol = h * 256 + s * 64; }
    else           { b = unit >> 4; h = (unit >> 1) & 7; const int s = unit & 1; qcol = OC_HQ + h * 128; kcol = OC_HF + h * 128; vcol = OC_HI + h * 128 + s * 64; ocol = h * 128 + s * 64; }
    const bf16* P = (const bf16*)(A.ws + WS_PROJ) + (size_t)b * SEQ * PROJ_LD;
    float* O = (float*)(A.ws + WS_O) + (size_t)b * SEQ * D + ocol;
    LAS float* Lf = (LAS float*)(F.lds + RING_OFF);
    constexpr int BUFSZ = 7168, O_EG = 0, O_K = 2048, O_Q = 4096, O_V = 6144, O_OUT = 2 * BUFSZ, O_W2 = O_OUT + 1024, O_BIAS = O_W2 + 2048;
    const int tl = tid >> 5, dq = (tid & 31) * 4, tlv = tid >> 4, c4 = (tid & 15) * 4;
    float lb[4] = {0.f, 0.f, 0.f, 0.f};
    if (MODE == 0) {
        const float* w2 = A.in[I_GK_W2]; const float* gb = A.in[I_GK_B];
        for (int i = tid; i < 2048; i += NTHREADS) Lf[O_W2 + i] = w2[(i >> 7) * 512 + h * 128 + (i & 127)];
        if (tid < 128) Lf[O_BIAS + tid] = gb[h * 128 + tid];
    } else {
        const float* lg = A.in[I_LB];
#pragma unroll
        for (int i = 0; i < 4; ++i) lb[i] = sigmoidf_(lg[1024 + h * 128 + dq + i] - lg[h * 128 + dq + i]);
    }
    u32x2 rq, rk, rv = {0u, 0u}; v4u rg0 = {0u, 0u, 0u, 0u}, rg1 = {0u, 0u, 0u, 0u};
#define GLA_LOAD(c) do { const bf16* pr = P + (size_t)((c) * TC + tl) * PROJ_LD; rq = *(const GAS u32x2*)(pr + qcol + dq); rk = *(const GAS u32x2*)(pr + kcol + dq); \
        if (MODE == 0) { rg0 = *(const GAS v4u*)(pr + EC_GLR); rg1 = *(const GAS v4u*)(pr + EC_GLR + 8); } \
        if (tid < 256) rv = *(const GAS u32x2*)(P + (size_t)((c) * TC + tlv) * PROJ_LD + vcol + c4); } while (0)
#define GLA_XFORM(bufi) do { LAS float* B_ = Lf + (bufi) * BUFSZ; f32x4 q4, k4, e4; \
        const float xq[4] = {bf_lo(rq.x), bf_hi(rq.x), bf_lo(rq.y), bf_hi(rq.y)}, xk[4] = {bf_lo(rk.x), bf_hi(rk.x), bf_lo(rk.y), bf_hi(rk.y)}; \
        if (MODE == 0) { f32x4 z = *(const LAS f32x4*)(Lf + O_BIAS + dq); \
            const float gl[16] = {bf_lo(rg0.x), bf_hi(rg0.x), bf_lo(rg0.y), bf_hi(rg0.y), bf_lo(rg0.z), bf_hi(rg0.z), bf_lo(rg0.w), bf_hi(rg0.w), \
                                  bf_lo(rg1.x), bf_hi(rg1.x), bf_lo(rg1.y), bf_hi(rg1.y), bf_lo(rg1.z), bf_hi(rg1.z), bf_lo(rg1.w), bf_hi(rg1.w)}; \
            _Pragma("unroll") for (int r_ = 0; r_ < 16; ++r_) { const f32x4 wv = *(const LAS f32x4*)(Lf + O_W2 + r_ * 128 + dq); z = z + wv * gl[r_]; } \
            _Pragma("unroll") for (int i_ = 0; i_ < 4; ++i_) { q4[i_] = xq[i_] * 0.08838834764831845f; k4[i_] = xk[i_]; e4[i_] = __builtin_amdgcn_exp2f(-0.0625f * __builtin_amdgcn_logf(1.0f + __expf(-z[i_]))); } } \
        else { _Pragma("unroll") for (int i_ = 0; i_ < 4; ++i_) { const float fg = lb[i_] + (1.f - lb[i_]) * sigmoidf_(xk[i_]); q4[i_] = siluf_(xq[i_]); k4[i_] = 1.f - fg; e4[i_] = fg; } } \
        *(LAS f32x4*)(B_ + O_EG + tl * 128 + dq) = e4; *(LAS f32x4*)(B_ + O_K + tl * 128 + dq) = k4; *(LAS f32x4*)(B_ + O_Q + tl * 128 + dq) = q4; \
        if (tid < 256) { f32x4 v4 = {bf_lo(rv.x), bf_hi(rv.x), bf_lo(rv.y), bf_hi(rv.y)}; *(LAS f32x4*)(B_ + O_V + tlv * 64 + c4) = v4; } } while (0)
    LBAR();
    GLA_LOAD(0); GLA_XFORM(0);
    LBAR();
    f32x2 S2[8];
#pragma unroll
    for (int i = 0; i < 8; ++i) S2[i] = (f32x2){0.f, 0.f};
    const int j = lane & 15, col = w * 8 + (lane >> 4) * 2;
    for (int c = 0; c < NCHUNK; ++c) {
        if (c + 1 < NCHUNK) GLA_LOAD(c + 1);
        const LAS float* B_ = Lf + (c & 1) * BUFSZ;
        float os0 = 0.f, os1 = 0.f;
        f32x4 e0, e1, k0, k1, q0, q1, ne0, ne1, nk0, nk1, nq0, nq1; f32x2 v2, nv2;
#define GLA_LDSTEP(t_, E0, E1, K0, K1, Q0, Q1, V2) do { E0 = *(const LAS f32x4*)(B_ + O_EG + (t_) * 128 + 4 * j); E1 = *(const LAS f32x4*)(B_ + O_EG + (t_) * 128 + 64 + 4 * j); \
            K0 = *(const LAS f32x4*)(B_ + O_K + (t_) * 128 + 4 * j); K1 = *(const LAS f32x4*)(B_ + O_K + (t_) * 128 + 64 + 4 * j); \
            Q0 = *(const LAS f32x4*)(B_ + O_Q + (t_) * 128 + 4 * j); Q1 = *(const LAS f32x4*)(B_ + O_Q + (t_) * 128 + 64 + 4 * j); V2 = *(const LAS f32x2*)(B_ + O_V + (t_) * 64 + col); } while (0)
        GLA_LDSTEP(0, e0, e1, k0, k1, q0, q1, v2);
#pragma unroll
        for (int t = 0; t < TC; ++t) {
            if (t + 1 < TC) { GLA_LDSTEP(t + 1, ne0, ne1, nk0, nk1, nq0, nq1, nv2); }
            __builtin_amdgcn_sched_barrier(0);
            f32x2 pa = {0.f, 0.f}, pb = {0.f, 0.f};
#pragma unroll
            for (int i = 0; i < 4; ++i) {
                S2[i] = S2[i] * e0[i] + v2 * k0[i]; S2[4 + i] = S2[4 + i] * e1[i] + v2 * k1[i];
                pa += S2[i] * q0[i]; pb += S2[4 + i] * q1[i]; }
            pa += pb;
            float p0 = pa[0], p1 = pa[1];
            row_sum16_x2(p0, p1);
            os0 = (j == t) ? p0 : os0; os1 = (j == t) ? p1 : os1;
            e0 = ne0; e1 = ne1; k0 = nk0; k1 = nk1; q0 = nq0; q1 = nq1; v2 = nv2;
        }
#undef GLA_LDSTEP
        { f32x2 o2 = {os0, os1}; *(LAS f32x2*)(Lf + O_OUT + j * 64 + col) = o2; }
        if (c + 1 < NCHUNK) GLA_XFORM((c + 1) & 1);
        LBAR();
        if (tid < 256) *(GAS f32x4*)(O + (size_t)(c * TC + tlv) * D + c4) = *(const LAS f32x4*)(Lf + O_OUT + tlv * 64 + c4);
        LBAR();
    }
#undef GLA_LOAD
#undef GLA_XFORM
}

__device__ __forceinline__ void scan_gdn_unit(const Args& A, Frame& F, int unit) {
    int tid = F.tid; asm volatile("" : "+v"(tid));
    const int lane = tid & 63, w = F.wave;
    const int b = unit >> 4, h = (unit >> 1) & 7, s = unit & 1;
    const int qcol = EC_BQ + h * 128, kcol = EC_BK + h * 128, vcol = EC_BV + h * 128 + s * 64, ocol = 1024 + h * 128 + s * 64;
    const bf16* P = (const bf16*)(A.ws + WS_PROJ) + (size_t)b * SEQ * PROJ_LD;
    float* O = (float*)(A.ws + WS_O) + (size_t)b * SEQ * D + ocol;
    LAS float* Lf = (LAS float*)(F.lds + RING_OFF);
    constexpr int BUFSZ = 5184, O_K = 0, O_Q = 2048, O_V = 4096, O_SC = 5120, O_OUT = 2 * BUFSZ, O_CW = O_OUT + 1024;
    const int tl = tid >> 5, dq = (tid & 31) * 4, tlv = tid >> 4, c4 = (tid & 15) * 4;
    { const float* cw = A.in[I_GDN_CONV];
      for (int i = tid; i < 4 * 320; i += NTHREADS) { const int jt = i / 320, x = i % 320;
          const int ch = x < 128 ? (h * 128 + x) : x < 256 ? (1024 + h * 128 + (x - 128)) : (2048 + h * 128 + s * 64 + (x - 256));
          Lf[O_CW + i] = cw[jt * 3072 + ch]; } }
    const float neg_ea = -__expf(A.in[I_GDN_ALOG][h]), dtb = A.in[I_GDN_DTB][h];
    u32x2 rq[4], rk[4], rv[4]; unsigned short rba = 0, rbb = 0;
#pragma unroll
    for (int i = 0; i < 4; ++i) rv[i] = (u32x2){0u, 0u};
#define GDN_LOAD(c) do { const int t_ = (c) * TC + tl; \
        _Pragma("unroll") for (int jt = 0; jt < 4; ++jt) { const int tt = t_ - 3 + jt; \
            if (tt >= 0) { const bf16* pr = P + (size_t)tt * PROJ_LD; rq[jt] = *(const GAS u32x2*)(pr + qcol + dq); rk[jt] = *(const GAS u32x2*)(pr + kcol + dq); } \
            else { rq[jt] = (u32x2){0u, 0u}; rk[jt] = (u32x2){0u, 0u}; } } \
        { const bf16* pr = P + (size_t)t_ * PROJ_LD; rba = pr[EC_BA + h]; rbb = pr[EC_BB + h]; } \
        if (tid < 256) { const int tv = (c) * TC + tlv; \
            _Pragma("unroll") for (int jt = 0; jt < 4; ++jt) { const int tt = tv - 3 + jt; \
                if (tt >= 0) rv[jt] = *(const GAS u32x2*)(P + (size_t)tt * PROJ_LD + vcol + c4); else rv[jt] = (u32x2){0u, 0u}; } } } while (0)
#define GDN_XFORM(bufi) do { LAS float* B_ = Lf + (bufi) * BUFSZ; f32x4 q4 = {0.f, 0.f, 0.f, 0.f}, k4 = {0.f, 0.f, 0.f, 0.f}; \
        _Pragma("unroll") for (int jt = 0; jt < 4; ++jt) { const f32x4 wq = *(const LAS f32x4*)(Lf + O_CW + jt * 320 + dq), wk = *(const LAS f32x4*)(Lf + O_CW + jt * 320 + 128 + dq); \
            q4[0] += wq[0] * bf_lo(rq[jt].x); q4[1] += wq[1] * bf_hi(rq[jt].x); q4[2] += wq[2] * bf_lo(rq[jt].y); q4[3] += wq[3] * bf_hi(rq[jt].y); \
            k4[0] += wk[0] * bf_lo(rk[jt].x); k4[1] += wk[1] * bf_hi(rk[jt].x); k4[2] += wk[2] * bf_lo(rk[jt].y); k4[3] += wk[3] * bf_hi(rk[jt].y); } \
        float sq = 0.f, sk = 0.f, sqk = 0.f; \
        _Pragma("unroll") for (int i_ = 0; i_ < 4; ++i_) { q4[i_] = siluf_(q4[i_]); k4[i_] = siluf_(k4[i_]); sq += q4[i_] * q4[i_]; sk += k4[i_] * k4[i_]; sqk += q4[i_] * k4[i_]; } \
        sq = half_sum32(sq); sk = half_sum32(sk); sqk = half_sum32(sqk); \
        const float rq_ = __builtin_amdgcn_rsqf(sq + EPS) * 0.08838834764831845f, rk_ = __builtin_amdgcn_rsqf(sk + EPS); \
        q4 = q4 * rq_; k4 = k4 * rk_; \
        *(LAS f32x4*)(B_ + O_K + tl * 128 + dq) = k4; *(LAS f32x4*)(B_ + O_Q + tl * 128 + dq) = q4; \
        if ((tid & 31) == 0) { const float ba = __uint_as_float((unsigned)rba << 16), bb = __uint_as_float((unsigned)rbb << 16); \
            f32x4 sc; sc[0] = __expf(neg_ea * softplusf_(ba + dtb)); sc[1] = sigmoidf_(bb); sc[2] = sqk * rq_ * rk_; sc[3] = 0.f; *(LAS f32x4*)(B_ + O_SC + tl * 4) = sc; } \
        if (tid < 256) { f32x4 v4 = {0.f, 0.f, 0.f, 0.f}; \
            _Pragma("unroll") for (int jt = 0; jt < 4; ++jt) { const f32x4 wv = *(const LAS f32x4*)(Lf + O_CW + jt * 320 + 256 + c4); \
                v4[0] += wv[0] * bf_lo(rv[jt].x); v4[1] += wv[1] * bf_hi(rv[jt].x); v4[2] += wv[2] * bf_lo(rv[jt].y); v4[3] += wv[3] * bf_hi(rv[jt].y); } \
            _Pragma("unroll") for (int i_ = 0; i_ < 4; ++i_) v4[i_] = siluf_(v4[i_]); \
            *(LAS f32x4*)(B_ + O_V + tlv * 64 + c4) = v4; } } while (0)
    LBAR();
    GDN_LOAD(0); GDN_XFORM(0);
    LBAR();
    f32x2 S2[8];
#pragma unroll
    for (int i = 0; i < 8; ++i) S2[i] = (f32x2){0.f, 0.f};
    const int j = lane & 15, col = w * 8 + (lane >> 4) * 2;
    for (int c = 0; c < NCHUNK; ++c) {
        if (c + 1 < NCHUNK) GDN_LOAD(c + 1);
        const LAS float* B_ = Lf + (c & 1) * BUFSZ;
        float os0 = 0.f, os1 = 0.f;
        f32x4 k0, k1, q0, q1, sc, nk0, nk1, nq0, nq1, nsc; f32x2 v2, nv2;
#define GDN_LDSTEP(t_, K0, K1, Q0, Q1, V2, SC) do { K0 = *(const LAS f32x4*)(B_ + O_K + (t_) * 128 + 4 * j); K1 = *(const LAS f32x4*)(B_ + O_K + (t_) * 128 + 64 + 4 * j); \
            Q0 = *(const LAS f32x4*)(B_ + O_Q + (t_) * 128 + 4 * j); Q1 = *(const LAS f32x4*)(B_ + O_Q + (t_) * 128 + 64 + 4 * j); V2 = *(const LAS f32x2*)(B_ + O_V + (t_) * 64 + col); SC = *(const LAS f32x4*)(B_ + O_SC + (t_) * 4); } while (0)
        GDN_LDSTEP(0, k0, k1, q0, q1, v2, sc);
#pragma unroll
        for (int t = 0; t < TC; ++t) {
            if (t + 1 < TC) { GDN_LDSTEP(t + 1, nk0, nk1, nq0, nq1, nv2, nsc); }
            __builtin_amdgcn_sched_barrier(0);
            f32x2 d1 = {0.f, 0.f}, d2 = {0.f, 0.f}, e1 = {0.f, 0.f}, e2 = {0.f, 0.f};
#pragma unroll
            for (int i = 0; i < 4; ++i) { d1 += S2[i] * k0[i]; e1 += S2[4 + i] * k1[i]; d2 += S2[i] * q0[i]; e2 += S2[4 + i] * q1[i]; }
            d1 += e1; d2 += e2;
            { float r0_ = d1[0], r1_ = d1[1], r2_ = d2[0], r3_ = d2[1]; row_sum16_x4(r0_, r1_, r2_, r3_); d1[0] = r0_; d1[1] = r1_; d2[0] = r2_; d2[1] = r3_; }
            const float a = sc[0], beta = sc[1], qk = sc[2];
            const f32x2 dl = (v2 - d1 * a) * beta;
            const f32x2 o2 = d2 * a + dl * qk;
#pragma unroll
            for (int i = 0; i < 4; ++i) { S2[i] = S2[i] * a + dl * k0[i]; S2[4 + i] = S2[4 + i] * a + dl * k1[i]; }
            os0 = (j == t) ? o2[0] : os0; os1 = (j == t) ? o2[1] : os1;
            k0 = nk0; k1 = nk1; q0 = nq0; q1 = nq1; v2 = nv2; sc = nsc;
        }
#undef GDN_LDSTEP
        { f32x2 o2 = {os0, os1}; *(LAS f32x2*)(Lf + O_OUT + j * 64 + col) = o2; }
        if (c + 1 < NCHUNK) GDN_XFORM((c + 1) & 1);
        LBAR();
        if (tid < 256) *(GAS f32x4*)(O + (size_t)(c * TC + tlv) * D + c4) = *(const LAS f32x4*)(Lf + O_OUT + tlv * 64 + c4);
        LBAR();
    }
#undef GDN_LOAD
#undef GDN_XFORM
}

typedef short bf16x4_t __attribute__((ext_vector_type(4)));
__device__ __forceinline__ bf16x8 mk_frag(u32x2 lo, u32x2 hi) { v4u t; t.x = lo.x; t.y = lo.y; t.z = hi.x; t.w = hi.y; return __builtin_bit_cast(bf16x8, t); }
template <int MODE>
__device__ __forceinline__ void scan_gla_mfma_unit(const Args& A, Frame& F, int unit) {
    int tid = F.tid; asm volatile("" : "+v"(tid));
    const int lane = tid & 63, w = F.wave;
    int b, h, qcol, kcol, vcol, ocol;
    if (MODE == 0) { b = unit >> 3; h = (unit >> 1) & 3; const int s = unit & 1; qcol = EC_GQ + h * 128; kcol = EC_GK + h * 128; vcol = EC_GV + h * 256 + s * 128; ocol = h * 256 + s * 128; }
    else           { b = unit >> 3; h = unit & 7; qcol = OC_HQ + h * 128; kcol = OC_HF + h * 128; vcol = OC_HI + h * 128; ocol = h * 128; }
    const bf16* P = (const bf16*)(A.ws + WS_PROJ) + (size_t)b * SEQ * PROJ_LD;
    bf16* O = (bf16*)(A.ws + WS_O) + (size_t)b * SEQ * D + ocol;
    LAS float* Lf = (LAS float*)(F.lds + RING_OFF);
    constexpr int BUFSZ = 8192, O_E = 0, O_K = 2048, O_Q = 4096, O_V = 6144, RS = 136, O_QB = 2 * BUFSZ, O_KB = O_QB + 1088, O_KT = O_KB + 1088, O_BL = O_KT + 1024, O_AM = O_BL + 128, O_W2 = O_AM + 128, O_BIAS = O_W2 + 2048;
    LAS bf16* QB = (LAS bf16*)(Lf + O_QB); LAS bf16* KB = (LAS bf16*)(Lf + O_KB); LAS bf16* KT = (LAS bf16*)(Lf + O_KT); LAS bf16* AM = (LAS bf16*)(Lf + O_AM);
    const int tl = tid >> 5, dq = (tid & 31) * 4;
    float lb[4] = {0.f, 0.f, 0.f, 0.f};
    if (MODE == 0) {
        const float* w2 = A.in[I_GK_W2]; const float* gb = A.in[I_GK_B];
        for (int i = tid; i < 2048; i += NTHREADS) Lf[O_W2 + i] = w2[(i >> 7) * 512 + h * 128 + (i & 127)];
        if (tid < 128) Lf[O_BIAS + tid] = gb[h * 128 + tid];
    } else {
        const float* lg = A.in[I_LB];
#pragma unroll
        for (int i = 0; i < 4; ++i) lb[i] = sigmoidf_(lg[1024 + h * 128 + dq + i] - lg[h * 128 + dq + i]);
    }
    u32x2 rq, rk, rv; v4u rg0 = {0u, 0u, 0u, 0u}, rg1 = {0u, 0u, 0u, 0u};
#define GM_LOAD(c) do { const bf16* pr = P + (size_t)((c) * TC + tl) * PROJ_LD; rq = *(const GAS u32x2*)(pr + qcol + dq); rk = *(const GAS u32x2*)(pr + kcol + dq); rv = *(const GAS u32x2*)(pr + vcol + dq); \
        if (MODE == 0) { rg0 = *(const GAS v4u*)(pr + EC_GLR); rg1 = *(const GAS v4u*)(pr + EC_GLR + 8); } } while (0)
#define GM_XFORM(bufi) do { LAS float* B_ = Lf + (bufi) * BUFSZ; f32x4 q4, k4, e4; \
        const float xq[4] = {bf_lo(rq.x), bf_hi(rq.x), bf_lo(rq.y), bf_hi(rq.y)}, xk[4] = {bf_lo(rk.x), bf_hi(rk.x), bf_lo(rk.y), bf_hi(rk.y)}; \
        if (MODE == 0) { f32x4 z = *(const LAS f32x4*)(Lf + O_BIAS + dq); \
            const float gl[16] = {bf_lo(rg0.x), bf_hi(rg0.x), bf_lo(rg0.y), bf_hi(rg0.y), bf_lo(rg0.z), bf_hi(rg0.z), bf_lo(rg0.w), bf_hi(rg0.w), \
                                  bf_lo(rg1.x), bf_hi(rg1.x), bf_lo(rg1.y), bf_hi(rg1.y), bf_lo(rg1.z), bf_hi(rg1.z), bf_lo(rg1.w), bf_hi(rg1.w)}; \
            _Pragma("unroll") for (int r_ = 0; r_ < 16; ++r_) { const f32x4 wv = *(const LAS f32x4*)(Lf + O_W2 + r_ * 128 + dq); z = z + wv * gl[r_]; } \
            _Pragma("unroll") for (int i_ = 0; i_ < 4; ++i_) { q4[i_] = xq[i_] * 0.08838834764831845f; k4[i_] = xk[i_]; e4[i_] = __builtin_amdgcn_exp2f(-0.0625f * __builtin_amdgcn_logf(1.0f + __expf(-z[i_]))); } } \
        else { _Pragma("unroll") for (int i_ = 0; i_ < 4; ++i_) { const float fg = lb[i_] + (1.f - lb[i_]) * sigmoidf_(xk[i_]); q4[i_] = siluf_(xq[i_]); k4[i_] = 1.f - fg; e4[i_] = fg; } } \
        *(LAS f32x4*)(B_ + O_E + tl * 128 + dq) = e4; *(LAS f32x4*)(B_ + O_K + tl * 128 + dq) = k4; *(LAS f32x4*)(B_ + O_Q + tl * 128 + dq) = q4; \
        { f32x4 v4 = {bf_lo(rv.x), bf_hi(rv.x), bf_lo(rv.y), bf_hi(rv.y)}; *(LAS f32x4*)(B_ + O_V + tl * 128 + dq) = v4; } } while (0)
    LBAR();
    GM_LOAD(0); GM_XFORM(0); GM_LOAD(1);
    LBAR();
    f32x4 Sacc[8];
#pragma unroll
    for (int i = 0; i < 8; ++i) Sacc[i] = (f32x4){0.f, 0.f, 0.f, 0.f};
    const int fr = lane & 15, g = lane >> 4, c0 = w * 16;
    for (int c = 0; c < NCHUNK; ++c) {
        const LAS float* B_ = Lf + (c & 1) * BUFSZ;
        {
            const int seg = tid >> 7, d = tid & 127;
            float bt = 1.f, ball = 1.f;
#pragma unroll
            for (int t = 0; t < 16; ++t) { const float e = B_[O_E + t * 128 + d]; ball *= e; if (t < 4 * seg) bt = ball; }
            ball = fmaxf(ball, 1e-30f);
            unsigned short kt4[4];
#pragma unroll
            for (int i = 0; i < 4; ++i) { const int t = 4 * seg + i; bt = fmaxf(bt * B_[O_E + t * 128 + d], 1e-30f);
                const float kk = B_[O_K + t * 128 + d], qq = B_[O_Q + t * 128 + d], ib = __builtin_amdgcn_rcpf(bt);
                QB[t * RS + d] = hw_bf(qq * bt); KB[t * RS + d] = hw_bf(kk * ib); kt4[i] = (unsigned short)hw_bf(kk * ball * ib); }
            u32x2 kw; kw.x = (unsigned)kt4[0] | ((unsigned)kt4[1] << 16); kw.y = (unsigned)kt4[2] | ((unsigned)kt4[3] << 16);
            *(LAS u32x2*)(KT + d * 16 + 4 * seg) = kw;
            if (seg == 3) Lf[O_BL + d] = ball;
        }
        LBAR();
        if (w == 0) {
            f32x4 acc = {0.f, 0.f, 0.f, 0.f};
#pragma unroll
            for (int ks = 0; ks < 4; ++ks) { const bf16x8 af = *(const LAS bf16x8*)(QB + fr * RS + 32 * ks + 8 * g), bfm = *(const LAS bf16x8*)(KB + fr * RS + 32 * ks + 8 * g);
                acc = __builtin_amdgcn_mfma_f32_16x16x32_bf16(af, bfm, acc, 0, 0, 0); }
#pragma unroll
            for (int r = 0; r < 4; ++r) { const int t = 4 * g + r, s = fr; AM[t * 16 + s] = hw_bf(s <= t ? acc[r] : 0.f); }
        }
        if (c + 1 < NCHUNK) GM_XFORM((c + 1) & 1);
        if (c + 2 < NCHUNK) GM_LOAD(c + 2);
        LBAR();
        {
            u32x2 vlo; { const float v0 = B_[O_V + (4 * g + 0) * 128 + c0 + fr], v1 = B_[O_V + (4 * g + 1) * 128 + c0 + fr], v2 = B_[O_V + (4 * g + 2) * 128 + c0 + fr], v3 = B_[O_V + (4 * g + 3) * 128 + c0 + fr];
                vlo.x = hw_pk2(v0, v1); vlo.y = hw_pk2(v2, v3); }
            const u32x2 zz = {0u, 0u};
            const bf16x8 vb = mk_frag(vlo, zz);
            f32x4 acco = {0.f, 0.f, 0.f, 0.f};
#pragma unroll
            for (int ks = 0; ks < 4; ++ks) {
                u32x2 slo, shi; slo.x = hw_pk2(Sacc[2 * ks][0], Sacc[2 * ks][1]); slo.y = hw_pk2(Sacc[2 * ks][2], Sacc[2 * ks][3]); shi.x = hw_pk2(Sacc[2 * ks + 1][0], Sacc[2 * ks + 1][1]); shi.y = hw_pk2(Sacc[2 * ks + 1][2], Sacc[2 * ks + 1][3]);
                const bf16x8 sb = mk_frag(slo, shi);
                const u32x2 qlo = *(const LAS u32x2*)(QB + fr * RS + 32 * ks + 4 * g), qhi = *(const LAS u32x2*)(QB + fr * RS + 32 * ks + 16 + 4 * g);
                acco = __builtin_amdgcn_mfma_f32_16x16x32_bf16(mk_frag(qlo, qhi), sb, acco, 0, 0, 0); }
            { const u32x2 alo = *(const LAS u32x2*)(AM + fr * 16 + 4 * g); acco = __builtin_amdgcn_mfma_f32_16x16x32_bf16(mk_frag(alo, zz), vb, acco, 0, 0, 0); }
#pragma unroll
            for (int r = 0; r < 4; ++r) O[(size_t)(c * TC + 4 * g + r) * D + c0 + fr] = hw_bf(acco[r]);
#pragma unroll
            for (int i = 0; i < 8; ++i) { const f32x4 bl = *(const LAS f32x4*)(Lf + O_BL + 16 * i + 4 * g); const u32x2 klo = *(const LAS u32x2*)(KT + (16 * i + fr) * 16 + 4 * g);
                Sacc[i] = __builtin_amdgcn_mfma_f32_16x16x32_bf16(mk_frag(klo, zz), vb, Sacc[i] * bl, 0, 0, 0); }
        }
        LBAR();
    }
#undef GM_LOAD
#undef GM_XFORM
}

__device__ __forceinline__ void scan_gdn_mfma_unit(const Args& A, Frame& F, int unit, const int role) {
    int tid = F.tid; asm volatile("" : "+v"(tid));
    const int lane = tid & 63, w = F.wave;
    const int b = unit >> 3, h = unit & 7;
    const int qcol = EC_BQ + h * 128, kcol = EC_BK + h * 128, vcol = EC_BV + h * 128, ocol = 1024 + h * 128;
    const bf16* P = (const bf16*)(A.ws + WS_PROJ) + (size_t)b * SEQ * PROJ_LD;
    bf16* O = (bf16*)(A.ws + WS_O) + (size_t)b * SEQ * D + ocol;
    LAS float* Lf = (LAS float*)(F.lds + RING_OFF);
    constexpr int O_CW = 0, O_AMAT = 1536, O_QKM = O_AMAT + 256, O_TB = O_QKM + 128, O_GL = O_TB + 128, O_BUF0 = O_GL + 64;
    constexpr int BUFSZ = 6208, O_KH = 0, O_QH = 2048, O_VV = 4096, O_SC = 6144;
    constexpr int RS = 136;
    constexpr int O_KHB = O_BUF0 + 2 * BUFSZ, O_QHB = O_KHB + 1088, O_QB = O_QHB + 1088, O_KT = O_QB + 1088, O_WSRC = O_KT + 1024, O_WB = O_WSRC + 2048;
    LAS bf16* KHB = (LAS bf16*)(Lf + O_KHB); LAS bf16* QHB = (LAS bf16*)(Lf + O_QHB); LAS bf16* QB = (LAS bf16*)(Lf + O_QB); LAS bf16* KT = (LAS bf16*)(Lf + O_KT);
    LAS bf16* WB = (LAS bf16*)(Lf + O_WB); LAS bf16* QKM = (LAS bf16*)(Lf + O_QKM); LAS bf16* TB = (LAS bf16*)(Lf + O_TB);
    const int tl = tid >> 5, dq = (tid & 31) * 4;
    { const float* cw = A.in[I_GDN_CONV];
      for (int i = tid; i < 4 * 384; i += NTHREADS) { const int jt = i / 384, x = i % 384; Lf[O_CW + i] = cw[jt * 3072 + (x >> 7) * 1024 + h * 128 + (x & 127)]; } }
    const float neg_ea = -__expf(A.in[I_GDN_ALOG][h]), dtb = A.in[I_GDN_DTB][h];
    u32x2 rq[4], rk[4], rv[4]; unsigned short rba = 0, rbb = 0;
#define GD_LOAD(c) do { const int t_ = (c) * TC + tl; \
        _Pragma("unroll") for (int jt = 0; jt < 4; ++jt) { const int tt = t_ - 3 + jt; const bf16* pr = P + (size_t)(tt < 0 ? 0 : tt) * PROJ_LD + dq; \
            rq[jt] = *(const GAS u32x2*)(pr + qcol); rk[jt] = *(const GAS u32x2*)(pr + kcol); rv[jt] = *(const GAS u32x2*)(pr + vcol); \
            if (tt < 0) { rq[jt] = (u32x2){0u, 0u}; rk[jt] = (u32x2){0u, 0u}; rv[jt] = (u32x2){0u, 0u}; } } \
        { const bf16* pr = P + (size_t)t_ * PROJ_LD; rba = pr[EC_BA + h]; rbb = pr[EC_BB + h]; } } while (0)
#define GD_XFORM(bufi) do { LAS float* B_ = Lf + O_BUF0 + (bufi) * BUFSZ; f32x4 q4 = {0.f, 0.f, 0.f, 0.f}, k4 = {0.f, 0.f, 0.f, 0.f}, v4 = {0.f, 0.f, 0.f, 0.f}; \
        _Pragma("unroll") for (int jt = 0; jt < 4; ++jt) { const f32x4 wq = *(const LAS f32x4*)(Lf + O_CW + jt * 384 + dq), wk = *(const LAS f32x4*)(Lf + O_CW + jt * 384 + 128 + dq), wv = *(const LAS f32x4*)(Lf + O_CW + jt * 384 + 256 + dq); \
            q4[0] += wq[0] * bf_lo(rq[jt].x); q4[1] += wq[1] * bf_hi(rq[jt].x); q4[2] += wq[2] * bf_lo(rq[jt].y); q4[3] += wq[3] * bf_hi(rq[jt].y); \
            k4[0] += wk[0] * bf_lo(rk[jt].x); k4[1] += wk[1] * bf_hi(rk[jt].x); k4[2] += wk[2] * bf_lo(rk[jt].y); k4[3] += wk[3] * bf_hi(rk[jt].y); \
            v4[0] += wv[0] * bf_lo(rv[jt].x); v4[1] += wv[1] * bf_hi(rv[jt].x); v4[2] += wv[2] * bf_lo(rv[jt].y); v4[3] += wv[3] * bf_hi(rv[jt].y); } \
        float sq = 0.f, sk = 0.f; \
        _Pragma("unroll") for (int i_ = 0; i_ < 4; ++i_) { q4[i_] = siluf_(q4[i_]); k4[i_] = siluf_(k4[i_]); v4[i_] = siluf_(v4[i_]); sq += q4[i_] * q4[i_]; sk += k4[i_] * k4[i_]; } \
        row_sum16_x2(sq, sk); sq += __shfl_xor(sq, 16); sk += __shfl_xor(sk, 16); \
        q4 = q4 * (__builtin_amdgcn_rsqf(sq + EPS) * 0.08838834764831845f); k4 = k4 * __builtin_amdgcn_rsqf(sk + EPS); \
        *(LAS f32x4*)(B_ + O_KH + tl * 128 + dq) = k4; *(LAS f32x4*)(B_ + O_QH + tl * 128 + dq) = q4; *(LAS f32x4*)(B_ + O_VV + tl * 128 + dq) = v4; \
        if ((tid & 31) == 0) { const float ba = __uint_as_float((unsigned)rba << 16), bb = __uint_as_float((unsigned)rbb << 16); \
            B_[O_SC + tl] = __expf(neg_ea * softplusf_(ba + dtb)); B_[O_SC + 16 + tl] = sigmoidf_(bb); } } while (0)
    LBAR();
    constexpr int SPLIT = 58;
    const int c_begin = role ? SPLIT : 0, c_end = role ? NCHUNK : SPLIT;
    constexpr int REC = 5408;
    float* STASH = (float*)(A.ws + WS_LA) + (size_t)unit * (NCHUNK - SPLIT) * REC;
    float* STATE = (float*)(A.ws + WS_STATE) + (size_t)unit * 16384;
    gu32* flag = F.ctl + 32768 + unit * 64;
    GD_LOAD(c_begin); GD_XFORM(c_begin & 1); GD_LOAD(c_begin + 1);
    LBAR();
    f32x4 Sacc[8];
#pragma unroll
    for (int i = 0; i < 8; ++i) Sacc[i] = (f32x4){0.f, 0.f, 0.f, 0.f};
    const int fr = lane & 15, g = lane >> 4, c0 = w * 16;
    const u32x2 zz = {0u, 0u};
#define GD_STATE_PART(cc_) do { \
        { \
            bf16x8 sb[4]; \
_Pragma("unroll") \
            for (int ks = 0; ks < 4; ++ks) { u32x2 slo, shi; slo.x = hw_pk2(Sacc[2 * ks][0], Sacc[2 * ks][1]); slo.y = hw_pk2(Sacc[2 * ks][2], Sacc[2 * ks][3]); shi.x = hw_pk2(Sacc[2 * ks + 1][0], Sacc[2 * ks + 1][1]); shi.y = hw_pk2(Sacc[2 * ks + 1][2], Sacc[2 * ks + 1][3]); \
                sb[ks] = mk_frag(slo, shi); } \
            f32x4 accv = accu, acco = {0.f, 0.f, 0.f, 0.f}; \
_Pragma("unroll") \
            for (int ks = 0; ks < 4; ++ks) { \
                const u32x2 wl = *(const LAS u32x2*)(WB + fr * RS + 32 * ks + 4 * g), wh = *(const LAS u32x2*)(WB + fr * RS + 32 * ks + 16 + 4 * g); \
                accv = __builtin_amdgcn_mfma_f32_16x16x32_bf16(mk_frag(wl, wh), sb[ks], accv, 0, 0, 0); \
                const u32x2 ql = *(const LAS u32x2*)(QB + fr * RS + 32 * ks + 4 * g), qh = *(const LAS u32x2*)(QB + fr * RS + 32 * ks + 16 + 4 * g); \
                acco = __builtin_amdgcn_mfma_f32_16x16x32_bf16(mk_frag(ql, qh), sb[ks], acco, 0, 0, 0); } \
            u32x2 vn; vn.x = hw_pk2(accv[0], accv[1]); vn.y = hw_pk2(accv[2], accv[3]); \
            const bf16x8 vnb = mk_frag(vn, zz); \
            acco = __builtin_amdgcn_mfma_f32_16x16x32_bf16(mk_frag(*(const LAS u32x2*)(QKM + fr * 16 + 4 * g), zz), vnb, acco, 0, 0, 0); \
_Pragma("unroll") \
            for (int r = 0; r < 4; ++r) O[(size_t)((cc_) * TC + 4 * g + r) * D + c0 + fr] = hw_bf(acco[r]); \
_Pragma("unroll") \
            for (int i = 0; i < 8; ++i) { const u32x2 klo = *(const LAS u32x2*)(KT + (16 * i + fr) * 16 + 4 * g); \
                Sacc[i] = __builtin_amdgcn_mfma_f32_16x16x32_bf16(mk_frag(klo, zz), vnb, Sacc[i] * glast, 0, 0, 0); } \
        } \
        } while (0)
    for (int c = c_begin; c < c_end; ++c) {
        const LAS float* B_ = Lf + O_BUF0 + (c & 1) * BUFSZ;
        float glast;
        {
            const int seg = tid >> 7, d = tid & 127;
            const f32x4 a0 = *(const LAS f32x4*)(B_ + O_SC), a1 = *(const LAS f32x4*)(B_ + O_SC + 4), a2 = *(const LAS f32x4*)(B_ + O_SC + 8), a3 = *(const LAS f32x4*)(B_ + O_SC + 12);
            const float av[16] = {a0[0], a0[1], a0[2], a0[3], a1[0], a1[1], a1[2], a1[3], a2[0], a2[1], a2[2], a2[3], a3[0], a3[1], a3[2], a3[3]};
            float p = 1.f, gpre = 1.f;
#pragma unroll
            for (int t = 0; t < 16; ++t) { if (t == 4 * seg) gpre = p; p *= av[t]; }
            glast = p;
            unsigned short kt4[4]; float gt = gpre;
#pragma unroll
            for (int i = 0; i < 4; ++i) { const int t = 4 * seg + i; const float at = (seg == 0) ? av[i] : (seg == 1) ? av[4 + i] : (seg == 2) ? av[8 + i] : av[12 + i]; gt *= at; const float beta = B_[O_SC + 16 + t];
                const float kk = B_[O_KH + t * 128 + d], qq = B_[O_QH + t * 128 + d];
                KHB[t * RS + d] = hw_bf(kk); QHB[t * RS + d] = hw_bf(qq); QB[t * RS + d] = hw_bf(qq * gt);
                kt4[i] = (unsigned short)hw_bf(kk * glast * __builtin_amdgcn_rcpf(gt));
                Lf[O_WSRC + t * 128 + d] = kk * (beta * gt);
                if (d == 0) Lf[O_GL + t] = gt; }
            u32x2 kw; kw.x = (unsigned)kt4[0] | ((unsigned)kt4[1] << 16); kw.y = (unsigned)kt4[2] | ((unsigned)kt4[3] << 16);
            *(LAS u32x2*)(KT + d * 16 + 4 * seg) = kw;
        }
        LBAR();
        if (w < 2) {
            const LAS bf16* AS = (w == 0) ? KHB : QHB;
            f32x4 acc = {0.f, 0.f, 0.f, 0.f};
#pragma unroll
            for (int ks = 0; ks < 4; ++ks) { const bf16x8 af = *(const LAS bf16x8*)(AS + fr * RS + 32 * ks + 8 * g), bfm = *(const LAS bf16x8*)(KHB + fr * RS + 32 * ks + 8 * g);
                acc = __builtin_amdgcn_mfma_f32_16x16x32_bf16(af, bfm, acc, 0, 0, 0); }
            const float gs_inv = __builtin_amdgcn_rcpf(Lf[O_GL + fr]);
            if (w == 0) {
                f32x4 N1, M1;
#pragma unroll
                for (int r = 0; r < 4; ++r) { const int t = 4 * g + r; const float gt = Lf[O_GL + t];
                    N1[r] = (fr < t) ? -(B_[O_SC + 16 + t] * acc[r] * gt * gs_inv) : 0.f;
                    M1[r] = (t < fr) ? -(B_[O_SC + 16 + fr] * acc[r] * Lf[O_GL + fr] * __builtin_amdgcn_rcpf(gt)) : 0.f; }
#define XTY(X, Y, C0) __builtin_amdgcn_mfma_f32_16x16x32_bf16(mk_frag((u32x2){hw_pk2(X[0], X[1]), hw_pk2(X[2], X[3])}, zz), mk_frag((u32x2){hw_pk2(Y[0], Y[1]), hw_pk2(Y[2], Y[3])}, zz), C0, 0, 0, 0)
                const f32x4 z4 = {0.f, 0.f, 0.f, 0.f};
                f32x4 T1t = M1;
#pragma unroll
                for (int r = 0; r < 4; ++r) if (4 * g + r == fr) T1t[r] += 1.f;
                const f32x4 N2 = XTY(M1, N1, z4), M2 = XTY(N1, M1, z4);
                const f32x4 T2t = XTY(N2, T1t, T1t);
                const f32x4 N4 = XTY(M2, N2, z4), M4 = XTY(N2, M2, z4);
                const f32x4 T4t = XTY(N4, T2t, T2t);
                const f32x4 N8 = XTY(M4, N4, z4);
                const f32x4 T8t = XTY(N8, T4t, T4t);
#undef XTY
                u32x2 tw; tw.x = hw_pk2(T8t[0], T8t[1]); tw.y = hw_pk2(T8t[2], T8t[3]);
                *(LAS u32x2*)(TB + fr * 16 + 4 * g) = tw;
            } else {
#pragma unroll
                for (int r = 0; r < 4; ++r) { const int t = 4 * g + r; QKM[t * 16 + fr] = hw_bf((fr <= t) ? acc[r] * Lf[O_GL + t] * gs_inv : 0.f); }
            }
        }
        if (c + 1 < c_end) GD_XFORM((c + 1) & 1);
        if (c + 2 < c_end) GD_LOAD(c + 2);
        LBAR();
        f32x4 accu = {0.f, 0.f, 0.f, 0.f};
        {
            const bf16x8 tf = mk_frag(*(const LAS u32x2*)(TB + fr * 16 + 4 * g), zz);
            u32x2 ulo, wlo;
            { const float b0 = B_[O_SC + 16 + 4 * g + 0], b1 = B_[O_SC + 16 + 4 * g + 1], b2 = B_[O_SC + 16 + 4 * g + 2], b3 = B_[O_SC + 16 + 4 * g + 3];
              ulo.x = hw_pk2(b0 * B_[O_VV + (4 * g + 0) * 128 + c0 + fr], b1 * B_[O_VV + (4 * g + 1) * 128 + c0 + fr]); ulo.y = hw_pk2(b2 * B_[O_VV + (4 * g + 2) * 128 + c0 + fr], b3 * B_[O_VV + (4 * g + 3) * 128 + c0 + fr]);
              wlo.x = hw_pk2(Lf[O_WSRC + (4 * g + 0) * 128 + c0 + fr], Lf[O_WSRC + (4 * g + 1) * 128 + c0 + fr]); wlo.y = hw_pk2(Lf[O_WSRC + (4 * g + 2) * 128 + c0 + fr], Lf[O_WSRC + (4 * g + 3) * 128 + c0 + fr]); }
            accu = __builtin_amdgcn_mfma_f32_16x16x32_bf16(tf, mk_frag(ulo, zz), accu, 0, 0, 0);
            f32x4 accw = {0.f, 0.f, 0.f, 0.f};
            accw = __builtin_amdgcn_mfma_f32_16x16x32_bf16(tf, mk_frag(wlo, zz), accw, 0, 0, 0);
#pragma unroll
            for (int r = 0; r < 4; ++r) WB[(4 * g + r) * RS + c0 + fr] = hw_bf(-accw[r]);
        }
        LBAR();
        if (role == 0) {
            GD_STATE_PART(c);
        } else {
            float* rec = STASH + (size_t)(c - c_begin) * REC;
            for (int i = tid; i < 832; i += NTHREADS) { const int o = i < 528 ? O_QB + 4 * i : (i < 800 ? O_WB + 4 * (i - 528) : O_QKM + 4 * (i - 800)); *(GAS f32x4*)(rec + 4 * i) = *(const LAS f32x4*)(Lf + o); }
#pragma unroll
            for (int r = 0; r < 4; ++r) rec[3328 + (w * 4 + r) * 64 + lane] = accu[r];
            if (tid == 0) rec[5376] = glast;
        }
        LBAR();
    }
    if (role == 0) {
#pragma unroll
        for (int i = 0; i < 8; ++i)
#pragma unroll
            for (int r = 0; r < 4; ++r) STATE[((w * 8 + i) * 4 + r) * 64 + lane] = Sacc[i][r];
        asm volatile("s_waitcnt vmcnt(0)" ::: "memory");
        __syncthreads();
        if (tid == 0) { __builtin_amdgcn_fence(__ATOMIC_RELEASE, "agent"); asm volatile("s_waitcnt vmcnt(0)" ::: "memory"); __hip_atomic_store(flag, 1u, __ATOMIC_RELAXED, __HIP_MEMORY_SCOPE_AGENT); }
    } else {
        if (tid == 0) { unsigned sp = 0; while (__hip_atomic_load(flag, __ATOMIC_RELAXED, __HIP_MEMORY_SCOPE_AGENT) == 0u) { __builtin_amdgcn_s_sleep(8); if (++sp > (1u << 22)) break; }
            __builtin_amdgcn_fence(__ATOMIC_ACQUIRE, "agent"); asm volatile("s_waitcnt vmcnt(0)" ::: "memory"); }
        __syncthreads();
#pragma unroll
        for (int i = 0; i < 8; ++i)
#pragma unroll
            for (int r = 0; r < 4; ++r) Sacc[i][r] = STATE[((w * 8 + i) * 4 + r) * 64 + lane];
        f32x4 pa, pb; f32x4 pu; float pg;
#define GD_REC_LOAD(cc) do { const float* rec = STASH + (size_t)((cc) - c_begin) * REC; pa = *(const GAS f32x4*)(rec + 4 * tid); pb = (tid < 320) ? *(const GAS f32x4*)(rec + 4 * (tid + 512)) : (f32x4){0.f, 0.f, 0.f, 0.f}; \
            _Pragma("unroll") for (int r = 0; r < 4; ++r) pu[r] = rec[3328 + (w * 4 + r) * 64 + lane]; pg = rec[5376]; } while (0)
        GD_REC_LOAD(c_begin);
        for (int c = c_begin; c < c_end; ++c) {
            { const int i0 = tid, o0 = i0 < 528 ? O_QB + 4 * i0 : O_WB + 4 * (i0 - 528); *(LAS f32x4*)(Lf + o0) = pa;
              if (tid < 320) { const int i1 = tid + 512; const int o1 = i1 < 528 ? O_QB + 4 * i1 : (i1 < 800 ? O_WB + 4 * (i1 - 528) : O_QKM + 4 * (i1 - 800)); *(LAS f32x4*)(Lf + o1) = pb; } }
            const f32x4 accu = pu; const float glast = pg;
            if (c + 1 < c_end) GD_REC_LOAD(c + 1);
            LBAR();
            GD_STATE_PART(c);
            LBAR();
        }
#undef GD_REC_LOAD
    }
#undef GD_STATE_PART
#undef GD_LOAD
#undef GD_XFORM
}

__device__ __forceinline__ void scan_rwkv_unit(const Args& A, Frame& F, int unit) {
    int tid = F.tid; asm volatile("" : "+v"(tid));
    const int lane = tid & 63, w = F.wave;
    const int b = unit >> 4, h = unit & 15;
    const bf16* P = (const bf16*)(A.ws + WS_PROJ) + (size_t)b * SEQ * PROJ_LD + OC_RW;
    const bf16* LO = (const bf16*)(A.ws + WS_LO) + (size_t)b * SEQ * LORA_N;
    bf16* Y = (bf16*)(A.ws + WS_ACTA) + (size_t)b * SEQ * D + 1024 + h * 64;
    LAS float* Lf = (LAS float*)(F.lds + RING_OFF);
    constexpr int BUFSZ = 6208, O_KK = 0, O_WR = 1024, O_W = 2048, O_NKA = 3072, O_K = 4096, O_V = 5120, O_SC = 6144, O_OUT = 2 * BUFSZ;
    const int tl = tid >> 5, d2 = (tid & 31) * 2, hd = h * 64 + d2;
    float mu_r[2], mu_k[2], mu_v[2], w0[2], a0[2], k_k[2], k_a[2], r_k[2], lnw[2], lnb[2];
#pragma unroll
    for (int i = 0; i < 2; ++i) { mu_r[i] = A.in[I_MU][RW_R + hd + i]; mu_k[i] = A.in[I_MU][RW_K + hd + i]; mu_v[i] = A.in[I_MU][RW_V + hd + i];
        w0[i] = A.in[I_W0][hd + i]; a0[i] = A.in[I_A0][hd + i]; k_k[i] = A.in[I_KK][hd + i]; k_a[i] = A.in[I_KA][hd + i]; r_k[i] = A.in[I_RK][hd + i];
        lnw[i] = A.in[I_LNW][hd + i]; lnb[i] = A.in[I_LNB][hd + i]; }
    unsigned rr[2], rk[2], rv[2], rlw, rla, rg_cur = 0u, rg_nxt = 0u;
#define RW_LOAD(c) do { const int t_ = (c) * TC + tl; const bf16* pr = P + (size_t)t_ * PROJ_LD; \
        rr[0] = *(const GAS unsigned*)(pr + RW_R + hd); rk[0] = *(const GAS unsigned*)(pr + RW_K + hd); rv[0] = *(const GAS unsigned*)(pr + RW_V + hd); \
        if (t_ > 0) { rr[1] = *(const GAS unsigned*)(pr - PROJ_LD + RW_R + hd); rk[1] = *(const GAS unsigned*)(pr - PROJ_LD + RW_K + hd); rv[1] = *(const GAS unsigned*)(pr - PROJ_LD + RW_V + hd); } \
        else { rr[1] = 0u; rk[1] = 0u; rv[1] = 0u; } \
        const bf16* lr = LO + (size_t)t_ * LORA_N; rlw = *(const GAS unsigned*)(lr + hd); rla = *(const GAS unsigned*)(lr + 1024 + hd); rg_nxt = *(const GAS unsigned*)(lr + 2048 + hd); } while (0)
#define RW_XFORM(bufi) do { LAS float* B_ = Lf + (bufi) * BUFSZ; f32x2 kk2, wr2, w2_, nka2, k2, v2_; float skk = 0.f, sc1 = 0.f, sc2 = 0.f, sbs = 0.f; float aa[2], rrv[2]; \
        _Pragma("unroll") for (int i_ = 0; i_ < 2; ++i_) { \
            const float r0 = i_ ? bf_hi(rr[0]) : bf_lo(rr[0]), r1 = i_ ? bf_hi(rr[1]) : bf_lo(rr[1]); \
            const float k0_ = i_ ? bf_hi(rk[0]) : bf_lo(rk[0]), k1_ = i_ ? bf_hi(rk[1]) : bf_lo(rk[1]); \
            const float v0_ = i_ ? bf_hi(rv[0]) : bf_lo(rv[0]), v1_ = i_ ? bf_hi(rv[1]) : bf_lo(rv[1]); \
            const float lw = i_ ? bf_hi(rlw) : bf_lo(rlw), la = i_ ? bf_hi(rla) : bf_lo(rla); \
            const float r_ = r0 + (r1 - r0) * mu_r[i_], kx = k0_ + (k1_ - k0_) * mu_k[i_], vx = v0_ + (v1_ - v0_) * mu_v[i_]; \
            const float wd = __expf(-0.6065306597126334f * sigmoidf_(w0[i_] + lw)); const float a_ = sigmoidf_(a0[i_] + la); \
            const float kk0 = kx * k_k[i_]; const float km = kx * (1.f + (a_ - 1.f) * k_a[i_]); \
            kk2[i_] = kk0; skk += kk0 * kk0; aa[i_] = a_; rrv[i_] = r_; wr2[i_] = wd * r_; w2_[i_] = wd; k2[i_] = km; v2_[i_] = vx; sc2 += km * r_; sbs += r_ * km * r_k[i_]; } \
        skk = half_sum32(skk); const float rkk = __builtin_amdgcn_rsqf(skk + EPS); \
        _Pragma("unroll") for (int i_ = 0; i_ < 2; ++i_) { kk2[i_] *= rkk; nka2[i_] = -(kk2[i_] * aa[i_]); sc1 += kk2[i_] * aa[i_] * rrv[i_]; } \
        sc1 = half_sum32(sc1); sc2 = half_sum32(sc2); sbs = half_sum32(sbs); \
        *(LAS f32x2*)(B_ + O_KK + tl * 64 + d2) = kk2; *(LAS f32x2*)(B_ + O_WR + tl * 64 + d2) = wr2; *(LAS f32x2*)(B_ + O_W + tl * 64 + d2) = w2_; \
        *(LAS f32x2*)(B_ + O_NKA + tl * 64 + d2) = nka2; *(LAS f32x2*)(B_ + O_K + tl * 64 + d2) = k2; *(LAS f32x2*)(B_ + O_V + tl * 64 + d2) = v2_; \
        if ((tid & 31) == 0) { f32x4 sc; sc[0] = sc1; sc[1] = sc2; sc[2] = sbs; sc[3] = 0.f; *(LAS f32x4*)(B_ + O_SC + tl * 4) = sc; } } while (0)
    RW_LOAD(0); RW_XFORM(0); rg_cur = rg_nxt;
    LBAR();
    f32x2 S2[4];
#pragma unroll
    for (int i = 0; i < 4; ++i) S2[i] = (f32x2){0.f, 0.f};
    const int j = lane & 15, col = w * 8 + (lane >> 4) * 2;
    for (int c = 0; c < NCHUNK; ++c) {
        if (c + 1 < NCHUNK) RW_LOAD(c + 1);
        const LAS float* B_ = Lf + (c & 1) * BUFSZ;
        float os0 = 0.f, os1 = 0.f;
        f32x4 kk, wr, ww, nka, kv, sc, nkk, nwr, nww, nnka, nkv, nsc; f32x2 v2, nv2;
#define RW_LDSTEP(t_, KK, WR, WW, NKA, KV, V2, SC) do { KK = *(const LAS f32x4*)(B_ + O_KK + (t_) * 64 + 4 * j); WR = *(const LAS f32x4*)(B_ + O_WR + (t_) * 64 + 4 * j); WW = *(const LAS f32x4*)(B_ + O_W + (t_) * 64 + 4 * j); \
            NKA = *(const LAS f32x4*)(B_ + O_NKA + (t_) * 64 + 4 * j); KV = *(const LAS f32x4*)(B_ + O_K + (t_) * 64 + 4 * j); V2 = *(const LAS f32x2*)(B_ + O_V + (t_) * 64 + col); SC = *(const LAS f32x4*)(B_ + O_SC + (t_) * 4); } while (0)
        RW_LDSTEP(0, kk, wr, ww, nka, kv, v2, sc);
#pragma unroll
        for (int t = 0; t < TC; ++t) {
            if (t + 1 < TC) { RW_LDSTEP(t + 1, nkk, nwr, nww, nnka, nkv, nv2, nsc); }
            __builtin_amdgcn_sched_barrier(0);
            f32x2 d1 = S2[0] * kk[0], d2 = S2[0] * wr[0], e1 = S2[1] * kk[1], e2 = S2[1] * wr[1];
            d1 += S2[2] * kk[2]; d2 += S2[2] * wr[2]; e1 += S2[3] * kk[3]; e2 += S2[3] * wr[3];
            d1 += e1; d2 += e2;
            { float r0_ = d1[0], r1_ = d1[1], r2_ = d2[0], r3_ = d2[1]; row_sum16_x4(r0_, r1_, r2_, r3_); d1[0] = r0_; d1[1] = r1_; d2[0] = r2_; d2[1] = r3_; }
            const f32x2 o2 = d2 - d1 * sc[0] + v2 * sc[1];
#pragma unroll
            for (int i = 0; i < 4; ++i) S2[i] = S2[i] * ww[i] + d1 * nka[i] + v2 * kv[i];
            os0 = (j == t) ? o2[0] : os0; os1 = (j == t) ? o2[1] : os1;
            kk = nkk; wr = nwr; ww = nww; nka = nnka; kv = nkv; v2 = nv2; sc = nsc;
        }
#undef RW_LDSTEP
        { f32x2 o2 = {os0, os1}; *(LAS f32x2*)(Lf + O_OUT + j * 64 + col) = o2; }
        if (c + 1 < NCHUNK) RW_XFORM((c + 1) & 1);
        LBAR();
        {
            const f32x2 o2 = *(const LAS f32x2*)(Lf + O_OUT + tl * 64 + d2); const f32x2 vv = *(const LAS f32x2*)(B_ + O_V + tl * 64 + d2); const float bs = B_[O_SC + tl * 4 + 2];
            const float mean = half_sum32(o2[0] + o2[1]) * (1.0f / 64.0f); const float e0 = o2[0] - mean, e1 = o2[1] - mean;
            const float var = half_sum32(e0 * e0 + e1 * e1) * (1.0f / 64.0f); const float rs = __builtin_amdgcn_rsqf(var + 64e-5f);
            const float y0 = (e0 * rs * lnw[0] + lnb[0] + bs * vv[0]) * bf_lo(rg_cur), y1 = (e1 * rs * lnw[1] + lnb[1] + bs * vv[1]) * bf_hi(rg_cur);
            *(GAS unsigned*)(Y + (size_t)(c * TC + tl) * D + d2) = pk2(y0, y1);
        }
        rg_cur = rg_nxt;
        LBAR();
    }
#undef RW_LOAD
#undef RW_XFORM
}

template <int LAYER>
__device__ __forceinline__ void post_rows(const Args& A, Frame& F) {
    const int gw = F.vcu * NWAVES + F.wave, NGW = F.G * NWAVES, lane = F.lane;
    const bf16* O = (const bf16*)(A.ws + WS_O); const bf16* P = (const bf16*)(A.ws + WS_PROJ); bf16* Y = (bf16*)(A.ws + WS_ACTA);
    for (int m = gw; m < T; m += NGW) {
        const GAS u32x2* orow = (const GAS u32x2*)(O + (size_t)m * D) + lane; const bf16* prow = P + (size_t)m * PROJ_LD;
        constexpr int NJ = LAYER == 0 ? 8 : 4;
#pragma unroll
        for (int jj = 0; jj < NJ; ++jj) {
            const u32x2 ow_ = orow[64 * jj]; const f32x4 v = {bf_lo(ow_.x), bf_hi(ow_.x), bf_lo(ow_.y), bf_hi(ow_.y)}; float ss = (v[0] * v[0] + v[1] * v[1]) + (v[2] * v[2] + v[3] * v[3]);
            const bool wide = (LAYER == 0 && jj < 4);
            const float ms = wide ? wave_sum(ss) * (1.0f / 256.0f) : half_sum32(ss) * (1.0f / 128.0f);
            const float r = __builtin_amdgcn_rsqf(ms + EPS);
            const int cih = wide ? 4 * lane : 4 * (lane & 31);
            const float* gsrc = LAYER == 0 ? (wide ? A.in[I_GLA_NORM] : A.in[I_GDN_NORM]) : A.in[I_HG_NORM];
            const f32x4 g = *(const GAS f32x4*)(gsrc + cih);
            const int zcol = LAYER == 0 ? (wide ? EC_GZ + jj * 256 + 4 * lane : EC_BZ + (jj - 4) * 256 + 4 * lane) : OC_HG + jj * 256 + 4 * lane;
            const u32x2 zw = *(const GAS u32x2*)(prow + zcol);
            const float y0 = v[0] * r * g[0] * siluf_(bf_lo(zw.x)), y1 = v[1] * r * g[1] * siluf_(bf_hi(zw.x)), y2 = v[2] * r * g[2] * siluf_(bf_lo(zw.y)), y3 = v[3] * r * g[3] * siluf_(bf_hi(zw.y));
            if constexpr (LAYER == 1) { int o8 = __builtin_amdgcn_cvt_pk_fp8_f32(y0, y1, 0, false); o8 = __builtin_amdgcn_cvt_pk_fp8_f32(y2, y3, o8, true);
                *(GAS unsigned*)((unsigned char*)Y + (size_t)m * D + 256 * jj + 4 * lane) = (unsigned)o8; }
            else { u32x2 o; o.x = pk2(y0, y1); o.y = pk2(y2, y3);
                *(GAS u32x2*)(Y + (size_t)m * D + 256 * jj + 4 * lane) = o; }
        }
    }
}
__device__ __forceinline__ void lora_prep_rows(const Args& A, Frame& F) {
    const int gw = F.vcu * NWAVES + F.wave, NGW = F.G * NWAVES, lane = F.lane;
    const bf16* P = (const bf16*)(A.ws + WS_PROJ); bf16* LA = (bf16*)(A.ws + WS_LA); const float* mu = A.in[I_MU];
    for (int m = gw; m < T; m += NGW) { const bool hasprev = (m % SEQ) != 0; const bf16* prow = P + (size_t)m * PROJ_LD + OC_RW + RW_WL;
#pragma unroll
        for (int i = 0; i < 7; ++i) { const int c = lane + 64 * i;
            const float x = __uint_as_float((unsigned)prow[c] << 16), xp = hasprev ? __uint_as_float((unsigned)prow[c - PROJ_LD] << 16) : 0.f;
            const float ts = x + (xp - x) * mu[RW_WL + c];
            const float v = c < 96 ? tanhf(ts) : (c < 192 ? ts : sigmoidf_(ts));
            LA[(size_t)m * LORA_K + c] = (bf16)f2bf(v); }
        LA[(size_t)m * LORA_K + 448 + lane] = (bf16)0; }
}
__device__ __forceinline__ void final_rows(const Args& A, Frame& F, const float oscale, const bf16* Hs) {
    const int gw = F.vcu * NWAVES + F.wave, NGW = F.G * NWAVES, lane = F.lane;
    const float* rowss = (const float*)(A.ws + WS_RSP) + (size_t)RS_FINAL * T * 32; const GAS f32x4* g = (const GAS f32x4*)A.in[I_NFINAL] + lane;
    for (int m = gw; m < T; m += NGW) { const float r = oscale * __builtin_amdgcn_rsqf(wave_sum(lane < 32 ? rowss[(size_t)m * 32 + lane] : 0.f) * (1.0f / D) + EPS); GAS f32x4* row = (GAS f32x4*)(A.out + (size_t)m * D) + lane;
        const GAS u32x2* hrow = (const GAS u32x2*)(Hs + (size_t)m * D) + lane;
#pragma unroll
        for (int jj = 0; jj < 8; ++jj) { const u32x2 hw = hrow[64 * jj]; const f32x4 v = {bf_lo(hw.x), bf_hi(hw.x), bf_lo(hw.y), bf_hi(hw.y)}; row[64 * jj] = v * r * g[64 * jj]; } }
}

__device__ __forceinline__ void scan_rwkv_mfma_unit(const Args& A, Frame& F, int unit, const int role) {
    int tid = F.tid; asm volatile("" : "+v"(tid));
    const int lane = tid & 63, w = F.wave;
    const int b = unit >> 3, hp = unit & 7;
    const bf16* P = (const bf16*)(A.ws + WS_PROJ) + (size_t)b * SEQ * PROJ_LD + OC_RW;
    const bf16* LO = (const bf16*)(A.ws + WS_LO) + (size_t)b * SEQ * LORA_N;
    unsigned char* Y = (unsigned char*)(A.ws + WS_ACTA) + (size_t)b * SEQ * D + 1024;
    LAS float* Lf = (LAS float*)(F.lds + RING_OFF);
    constexpr int RS = 72;
    constexpr int O_CONST = 0;
    constexpr int O_XF = 1280;
    constexpr int O_VV = O_XF + 2 * 5 * 1024;
    constexpr int O_BS = O_VV + 4 * 1024;
    constexpr int O_IMG = O_BS + 64;
    constexpr int I_CT = 0, I_BT = 576, I_KL = 1152, I_RT = 1728, I_CF = 2304, I_BTT = 3328, I_KTT = 3840, I_WCB = 4352, I_G1B = 4928, I_TTB = 5056, I_RKB = 5184, I_RBB = 5312, I_W15 = 5440, I_OUT = 5504, IMGSZ = 6528;
    static_assert((O_IMG + 2 * IMGSZ) * 4 <= RING_BYTES, "rwkv lds");
    for (int i = tid; i < 1280; i += NTHREADS) { const int arr = i >> 7, ch = hp * 128 + (i & 127); float v;
        switch (arr) { case 0: v = A.in[I_MU][RW_R + ch]; break; case 1: v = A.in[I_MU][RW_K + ch]; break; case 2: v = A.in[I_MU][RW_V + ch]; break; case 3: v = A.in[I_W0][ch]; break; case 4: v = A.in[I_A0][ch]; break;
                       case 5: v = A.in[I_KK][ch]; break; case 6: v = A.in[I_KA][ch]; break; case 7: v = A.in[I_RK][ch]; break; case 8: v = A.in[I_LNW][ch]; break; default: v = A.in[I_LNB][ch]; break; }
        Lf[O_CONST + i] = v; }
    const int hx = tid >> 8, tl = (tid >> 4) & 15, d4 = (tid & 15) * 4, ch4 = hx * 64 + d4, col4 = hp * 128 + ch4;
    u32x2 rr[2], rk[2], rv[2], rlw, rla, rg_cur = {0u, 0u}, rg_nxt = {0u, 0u}, rg_far = {0u, 0u};
#define RM_LOAD(c) do { const int t_ = (c) * TC + tl; const bf16* pr = P + (size_t)t_ * PROJ_LD + col4; \
        rr[0] = *(const GAS u32x2*)(pr + RW_R); rk[0] = *(const GAS u32x2*)(pr + RW_K); rv[0] = *(const GAS u32x2*)(pr + RW_V); \
        const bf16* pp_ = (t_ > 0) ? pr - PROJ_LD : pr; rr[1] = *(const GAS u32x2*)(pp_ + RW_R); rk[1] = *(const GAS u32x2*)(pp_ + RW_K); rv[1] = *(const GAS u32x2*)(pp_ + RW_V); \
        if (t_ == 0) { rr[1] = (u32x2){0u, 0u}; rk[1] = (u32x2){0u, 0u}; rv[1] = (u32x2){0u, 0u}; } \
        const bf16* lr = LO + (size_t)t_ * LORA_N + col4; rlw = *(const GAS u32x2*)(lr); rla = *(const GAS u32x2*)(lr + 1024); rg_far = *(const GAS u32x2*)(lr + 2048); } while (0)
#define RM_XFORM(bufi) do { LAS float* X_ = Lf + O_XF + hx * 5 * 1024 + tl * 64 + d4; \
        const f32x4 mur = *(const LAS f32x4*)(Lf + O_CONST + 0 * 128 + ch4), muk = *(const LAS f32x4*)(Lf + O_CONST + 1 * 128 + ch4), muv = *(const LAS f32x4*)(Lf + O_CONST + 2 * 128 + ch4); \
        const f32x4 w0_ = *(const LAS f32x4*)(Lf + O_CONST + 3 * 128 + ch4), a0_ = *(const LAS f32x4*)(Lf + O_CONST + 4 * 128 + ch4), kk_ = *(const LAS f32x4*)(Lf + O_CONST + 5 * 128 + ch4); \
        const f32x4 ka_ = *(const LAS f32x4*)(Lf + O_CONST + 6 * 128 + ch4), rk_ = *(const LAS f32x4*)(Lf + O_CONST + 7 * 128 + ch4); \
        const float r0[4] = {bf_lo(rr[0].x), bf_hi(rr[0].x), bf_lo(rr[0].y), bf_hi(rr[0].y)}, r1[4] = {bf_lo(rr[1].x), bf_hi(rr[1].x), bf_lo(rr[1].y), bf_hi(rr[1].y)}; \
        const float k0[4] = {bf_lo(rk[0].x), bf_hi(rk[0].x), bf_lo(rk[0].y), bf_hi(rk[0].y)}, k1[4] = {bf_lo(rk[1].x), bf_hi(rk[1].x), bf_lo(rk[1].y), bf_hi(rk[1].y)}; \
        const float v0[4] = {bf_lo(rv[0].x), bf_hi(rv[0].x), bf_lo(rv[0].y), bf_hi(rv[0].y)}, v1[4] = {bf_lo(rv[1].x), bf_hi(rv[1].x), bf_lo(rv[1].y), bf_hi(rv[1].y)}; \
        const float lw[4] = {bf_lo(rlw.x), bf_hi(rlw.x), bf_lo(rlw.y), bf_hi(rlw.y)}, la[4] = {bf_lo(rla.x), bf_hi(rla.x), bf_lo(rla.y), bf_hi(rla.y)}; \
        f32x4 r4, w4, k4, v4, kk4, b4; float skk = 0.f, sbs = 0.f; float aa[4]; \
        _Pragma("unroll") for (int i_ = 0; i_ < 4; ++i_) { const float r_ = r0[i_] + (r1[i_] - r0[i_]) * mur[i_], kx = k0[i_] + (k1[i_] - k0[i_]) * muk[i_], vx = v0[i_] + (v1[i_] - v0[i_]) * muv[i_]; \
            const float wd = __expf(-0.6065306597126334f * sigmoidf_(w0_[i_] + lw[i_])); const float a_ = sigmoidf_(a0_[i_] + la[i_]); \
            const float kk0 = kx * kk_[i_], km = kx * (1.f + (a_ - 1.f) * ka_[i_]); \
            r4[i_] = r_; w4[i_] = wd; k4[i_] = km; v4[i_] = vx; kk4[i_] = kk0; aa[i_] = a_; skk += kk0 * kk0; sbs += r_ * km * rk_[i_]; } \
        row_sum16_x2(skk, sbs); const float rkk = __builtin_amdgcn_rsqf(skk + EPS); \
        _Pragma("unroll") for (int i_ = 0; i_ < 4; ++i_) { kk4[i_] *= rkk; b4[i_] = kk4[i_] * aa[i_]; } \
        *(LAS f32x4*)(X_) = r4; *(LAS f32x4*)(X_ + 1024) = w4; *(LAS f32x4*)(X_ + 2048) = k4; *(LAS f32x4*)(X_ + 3072) = kk4; *(LAS f32x4*)(X_ + 4096) = b4; \
        *(LAS f32x4*)(Lf + O_VV + ((bufi) * 2 + hx) * 1024 + tl * 64 + d4) = v4; \
        if ((tid & 15) == 0) Lf[O_BS + ((bufi) * 2 + hx) * 16 + tl] = sbs; } while (0)
    constexpr int SPLIT = 60;
    const int c_begin = role ? SPLIT : 0, c_end = role ? NCHUNK : SPLIT;
    constexpr int REC = 7584;
    float* STASH = (float*)(A.ws + (unit < 32 ? WS_WEV_IN : WS_END)) + (size_t)(unit & 31) * (NCHUNK - SPLIT) * REC;
    float* STATE = (float*)(A.ws + WS_STATE + 4 * MiB) + (size_t)unit * 8192;
    gu32* flag = F.ctl + 49152 + unit * 64;
    LBAR();
    RM_LOAD(c_begin); RM_XFORM(c_begin & 1); rg_cur = rg_far; RM_LOAD(c_begin + 1); rg_nxt = rg_far;
    LBAR();
    f32x4 Macc[4];
#pragma unroll
    for (int i = 0; i < 4; ++i) Macc[i] = (f32x4){0.f, 0.f, 0.f, 0.f};
    const int fr = lane & 15, g = lane >> 4, hh = w >> 2, ww = w & 3, c0 = ww * 16;
    LAS float* IM = Lf + O_IMG + hh * IMGSZ;
    LAS bf16* CT = (LAS bf16*)(IM + I_CT); LAS bf16* BT = (LAS bf16*)(IM + I_BT); LAS bf16* KL = (LAS bf16*)(IM + I_KL); LAS bf16* RT = (LAS bf16*)(IM + I_RT);
    LAS bf16* BTT = (LAS bf16*)(IM + I_BTT); LAS bf16* KTT = (LAS bf16*)(IM + I_KTT); LAS bf16* WCB = (LAS bf16*)(IM + I_WCB);
    LAS bf16* G1B = (LAS bf16*)(IM + I_G1B); LAS bf16* TTB = (LAS bf16*)(IM + I_TTB); LAS bf16* RKB = (LAS bf16*)(IM + I_RKB); LAS bf16* RBB = (LAS bf16*)(IM + I_RBB);
    const u32x2 zz = {0u, 0u};
#define RM_STATE_PART(vb) do { \
        { \
            bf16x8 mb[2]; \
_Pragma("unroll") \
            for (int ks = 0; ks < 2; ++ks) { u32x2 slo, shi; slo.x = hw_pk2(Macc[2 * ks][0], Macc[2 * ks][1]); slo.y = hw_pk2(Macc[2 * ks][2], Macc[2 * ks][3]); shi.x = hw_pk2(Macc[2 * ks + 1][0], Macc[2 * ks + 1][1]); shi.y = hw_pk2(Macc[2 * ks + 1][2], Macc[2 * ks + 1][3]); \
                mb[ks] = mk_frag(slo, shi); } \
            f32x4 accR = accU, acco = {0.f, 0.f, 0.f, 0.f}; \
_Pragma("unroll") \
            for (int ks = 0; ks < 2; ++ks) { \
                accR = __builtin_amdgcn_mfma_f32_16x16x32_bf16(mk_frag(*(const LAS u32x2*)(WCB + fr * RS + 32 * ks + 4 * g), *(const LAS u32x2*)(WCB + fr * RS + 32 * ks + 16 + 4 * g)), mb[ks], accR, 0, 0, 0); \
                acco = __builtin_amdgcn_mfma_f32_16x16x32_bf16(mk_frag(*(const LAS u32x2*)(RT + fr * RS + 32 * ks + 4 * g), *(const LAS u32x2*)(RT + fr * RS + 32 * ks + 16 + 4 * g)), mb[ks], acco, 0, 0, 0); } \
            u32x2 rn; rn.x = hw_pk2(accR[0], accR[1]); rn.y = hw_pk2(accR[2], accR[3]); \
            const bf16x8 rb = mk_frag(rn, zz); \
            acco = __builtin_amdgcn_mfma_f32_16x16x32_bf16(mk_frag(*(const LAS u32x2*)(RKB + fr * 16 + 4 * g), zz), vb, acco, 0, 0, 0); \
            acco = __builtin_amdgcn_mfma_f32_16x16x32_bf16(mk_frag(*(const LAS u32x2*)(RBB + fr * 16 + 4 * g), zz), rb, acco, 0, 0, 0); \
_Pragma("unroll") \
            for (int r = 0; r < 4; ++r) IM[I_OUT + (4 * g + r) * 64 + c0 + fr] = acco[r]; \
_Pragma("unroll") \
            for (int i = 0; i < 4; ++i) { const f32x4 w15 = *(const LAS f32x4*)(IM + I_W15 + 16 * i + 4 * g); \
                f32x4 m = __builtin_amdgcn_mfma_f32_16x16x32_bf16(mk_frag(*(const LAS u32x2*)(KTT + (16 * i + fr) * 16 + 4 * g), zz), vb, Macc[i], 0, 0, 0); \
                m = __builtin_amdgcn_mfma_f32_16x16x32_bf16(mk_frag(*(const LAS u32x2*)(BTT + (16 * i + fr) * 16 + 4 * g), zz), rb, m, 0, 0, 0); \
                Macc[i] = m * w15; } \
        } \
        } while (0)
#define RM_FLUSH(cc_, gb_, vv_, bs_) do { \
        { \
            const f32x4 o4 = *(const LAS f32x4*)(Lf + O_IMG + hx * IMGSZ + I_OUT + tl * 64 + d4); const f32x4 vv = (vv_); const float bs = (bs_); \
            const f32x4 lnw = *(const LAS f32x4*)(Lf + O_CONST + 8 * 128 + ch4), lnb = *(const LAS f32x4*)(Lf + O_CONST + 9 * 128 + ch4); \
            float sm = (o4[0] + o4[1]) + (o4[2] + o4[3]), dummy = 0.f; row_sum16_x2(sm, dummy); const float mean = sm * (1.0f / 64.0f); \
            const f32x4 e4 = o4 - mean; float sv = (e4[0] * e4[0] + e4[1] * e4[1]) + (e4[2] * e4[2] + e4[3] * e4[3]); row_sum16_x2(sv, dummy); const float rs = __builtin_amdgcn_rsqf(sv * (1.0f / 64.0f) + 64e-5f); \
            const float gg[4] = {bf_lo((gb_).x), bf_hi((gb_).x), bf_lo((gb_).y), bf_hi((gb_).y)}; \
            float y[4]; \
_Pragma("unroll") \
            for (int i = 0; i < 4; ++i) y[i] = (e4[i] * rs * lnw[i] + lnb[i] + bs * vv[i]) * gg[i]; \
            int o8 = __builtin_amdgcn_cvt_pk_fp8_f32(y[0], y[1], 0, false); o8 = __builtin_amdgcn_cvt_pk_fp8_f32(y[2], y[3], o8, true); \
            *(GAS unsigned*)(Y + (size_t)((cc_) * TC + tl) * D + col4) = (unsigned)o8; \
        } \
        } while (0)
    for (int c = c_begin; c < c_end; ++c) {
        {
            const int hq = tid >> 8, seg = (tid >> 6) & 3, d = tid & 63;
            const LAS float* X_ = Lf + O_XF + hq * 5 * 1024 + d; LAS float* IQ = Lf + O_IMG + hq * IMGSZ;
            LAS bf16* CTq = (LAS bf16*)(IQ + I_CT); LAS bf16* BTq = (LAS bf16*)(IQ + I_BT); LAS bf16* KLq = (LAS bf16*)(IQ + I_KL); LAS bf16* RTq = (LAS bf16*)(IQ + I_RT);
            float wall = 1.f, wpre = 1.f;
#pragma unroll
            for (int t = 0; t < 16; ++t) { if (t == 4 * seg) wpre = wall; wall *= X_[1024 + t * 64]; }
            float wt = wpre; unsigned short bt4[4], kt4[4];
#pragma unroll
            for (int i = 0; i < 4; ++i) { const int t = 4 * seg + i; const float wprev = wt; wt *= X_[1024 + t * 64]; const float iw = __builtin_amdgcn_rcpf(wt);
                const float r_ = X_[t * 64], k_ = X_[2048 + t * 64], kk_ = X_[3072 + t * 64], b_ = X_[4096 + t * 64];
                const float ct = kk_ * wprev, bt = b_ * iw, kt = k_ * iw;
                CTq[t * RS + d] = hw_bf(ct); IQ[I_CF + t * 64 + d] = ct; BTq[t * RS + d] = hw_bf(bt); KLq[t * RS + d] = hw_bf(kt); RTq[t * RS + d] = hw_bf(r_ * wt);
                bt4[i] = (unsigned short)hw_bf(-bt); kt4[i] = (unsigned short)hw_bf(kt); }
            u32x2 o; o.x = (unsigned)bt4[0] | ((unsigned)bt4[1] << 16); o.y = (unsigned)bt4[2] | ((unsigned)bt4[3] << 16); *(LAS u32x2*)((LAS bf16*)(IQ + I_BTT) + d * 16 + 4 * seg) = o;
            o.x = (unsigned)kt4[0] | ((unsigned)kt4[1] << 16); o.y = (unsigned)kt4[2] | ((unsigned)kt4[3] << 16); *(LAS u32x2*)((LAS bf16*)(IQ + I_KTT) + d * 16 + 4 * seg) = o;
            if (seg == 3) IQ[I_W15 + d] = wall;
        }
        LBAR();
        if (ww == 0) {
            f32x4 cb = {0.f, 0.f, 0.f, 0.f}, bc = cb, ck = cb, rkm = cb, rbm = cb;
#pragma unroll
            for (int ks = 0; ks < 2; ++ks) { const bf16x8 fc = *(const LAS bf16x8*)(CT + fr * RS + 32 * ks + 8 * g), fb = *(const LAS bf16x8*)(BT + fr * RS + 32 * ks + 8 * g), fk = *(const LAS bf16x8*)(KL + fr * RS + 32 * ks + 8 * g), frr = *(const LAS bf16x8*)(RT + fr * RS + 32 * ks + 8 * g);
                cb = __builtin_amdgcn_mfma_f32_16x16x32_bf16(fc, fb, cb, 0, 0, 0); bc = __builtin_amdgcn_mfma_f32_16x16x32_bf16(fb, fc, bc, 0, 0, 0); ck = __builtin_amdgcn_mfma_f32_16x16x32_bf16(fc, fk, ck, 0, 0, 0);
                rkm = __builtin_amdgcn_mfma_f32_16x16x32_bf16(frr, fk, rkm, 0, 0, 0); rbm = __builtin_amdgcn_mfma_f32_16x16x32_bf16(frr, fb, rbm, 0, 0, 0); }
            f32x4 N1, M1, CKm;
#pragma unroll
            for (int r = 0; r < 4; ++r) { const int t = 4 * g + r; N1[r] = (fr < t) ? -cb[r] : 0.f; M1[r] = (t < fr) ? -bc[r] : 0.f; CKm[r] = (fr < t) ? ck[r] : 0.f;
                RKB[t * 16 + fr] = hw_bf((fr <= t) ? rkm[r] : 0.f); RBB[t * 16 + fr] = hw_bf((fr <= t) ? -rbm[r] : 0.f); }
#define XTY(X, Y, C0) __builtin_amdgcn_mfma_f32_16x16x32_bf16(mk_frag((u32x2){hw_pk2(X[0], X[1]), hw_pk2(X[2], X[3])}, zz), mk_frag((u32x2){hw_pk2(Y[0], Y[1]), hw_pk2(Y[2], Y[3])}, zz), C0, 0, 0, 0)
            const f32x4 z4 = {0.f, 0.f, 0.f, 0.f};
            f32x4 T1t = M1;
#pragma unroll
            for (int r = 0; r < 4; ++r) if (4 * g + r == fr) T1t[r] += 1.f;
            const f32x4 N2 = XTY(M1, N1, z4), M2 = XTY(N1, M1, z4);
            const f32x4 T2t = XTY(N2, T1t, T1t);
            const f32x4 N4 = XTY(M2, N2, z4), M4 = XTY(N2, M2, z4);
            const f32x4 T4t = XTY(N4, T2t, T2t);
            const f32x4 N8 = XTY(M4, N4, z4);
            const f32x4 T8t = XTY(N8, T4t, T4t);
            const f32x4 G1t = XTY(CKm, T8t, z4);
#undef XTY
            u32x2 tw; tw.x = hw_pk2(T8t[0], T8t[1]); tw.y = hw_pk2(T8t[2], T8t[3]); *(LAS u32x2*)(TTB + fr * 16 + 4 * g) = tw;
            tw.x = hw_pk2(G1t[0], G1t[1]); tw.y = hw_pk2(G1t[2], G1t[3]); *(LAS u32x2*)(G1B + fr * 16 + 4 * g) = tw;
        }
        if (c + 1 < c_end) { RM_XFORM((c + 1) & 1); }
        if (c + 2 < c_end) RM_LOAD(c + 2);
        LBAR();
        const LAS float* VVc = Lf + O_VV + ((c & 1) * 2 + hh) * 1024;
        u32x2 vlo; { vlo.x = hw_pk2(VVc[(4 * g + 0) * 64 + c0 + fr], VVc[(4 * g + 1) * 64 + c0 + fr]); vlo.y = hw_pk2(VVc[(4 * g + 2) * 64 + c0 + fr], VVc[(4 * g + 3) * 64 + c0 + fr]); }
        const bf16x8 vb = mk_frag(vlo, zz);
        f32x4 accU = {0.f, 0.f, 0.f, 0.f};
        {
            accU = __builtin_amdgcn_mfma_f32_16x16x32_bf16(mk_frag(*(const LAS u32x2*)(G1B + fr * 16 + 4 * g), zz), vb, accU, 0, 0, 0);
            u32x2 clo; clo.x = hw_pk2(IM[I_CF + (4 * g + 0) * 64 + c0 + fr], IM[I_CF + (4 * g + 1) * 64 + c0 + fr]); clo.y = hw_pk2(IM[I_CF + (4 * g + 2) * 64 + c0 + fr], IM[I_CF + (4 * g + 3) * 64 + c0 + fr]);
            f32x4 accw = {0.f, 0.f, 0.f, 0.f};
            accw = __builtin_amdgcn_mfma_f32_16x16x32_bf16(mk_frag(*(const LAS u32x2*)(TTB + fr * 16 + 4 * g), zz), mk_frag(clo, zz), accw, 0, 0, 0);
#pragma unroll
            for (int r = 0; r < 4; ++r) WCB[(4 * g + r) * RS + c0 + fr] = hw_bf(accw[r]);
        }
        LBAR();
        if (role == 0) {
            RM_STATE_PART(vb);
            LBAR();
            RM_FLUSH(c, rg_cur, *(const LAS f32x4*)(Lf + O_VV + ((c & 1) * 2 + hx) * 1024 + tl * 64 + d4), Lf[O_BS + ((c & 1) * 2 + hx) * 16 + tl]);
        } else {
            float* rec = STASH + (size_t)(c - c_begin) * REC;
            for (int i = tid; i < 1376; i += NTHREADS) { const int hd = i >= 688, j = i - hd * 688; const int o = O_IMG + hd * IMGSZ + (j < 144 ? I_RT + 4 * j : I_BTT + 4 * (j - 144)); *(GAS f32x4*)(rec + 4 * i) = *(const LAS f32x4*)(Lf + o); }
            { GAS unsigned* ru = (GAS unsigned*)(rec + 5504); ru[(w * 2 + 0) * 64 + lane] = hw_pk2(accU[0], accU[1]); ru[(w * 2 + 1) * 64 + lane] = hw_pk2(accU[2], accU[3]); }
            { const f32x4 v4 = *(const LAS f32x4*)(Lf + O_VV + ((c & 1) * 2 + hx) * 1024 + tl * 64 + d4); u32x2 o; o.x = hw_pk2(v4[0], v4[1]); o.y = hw_pk2(v4[2], v4[3]); *(GAS u32x2*)(rec + 6528 + 2 * tid) = o; }
            if (tid < 32) rec[7552 + tid] = Lf[O_BS + (c & 1) * 32 + tid];
            LBAR();
        }
        rg_cur = rg_nxt; rg_nxt = rg_far;
    }
    if (role == 0) {
#pragma unroll
        for (int i = 0; i < 4; ++i)
#pragma unroll
            for (int r = 0; r < 4; ++r) STATE[((w * 4 + i) * 4 + r) * 64 + lane] = Macc[i][r];
        asm volatile("s_waitcnt vmcnt(0)" ::: "memory");
        __syncthreads();
        if (tid == 0) { __builtin_amdgcn_fence(__ATOMIC_RELEASE, "agent"); asm volatile("s_waitcnt vmcnt(0)" ::: "memory"); __hip_atomic_store(flag, 1u, __ATOMIC_RELAXED, __HIP_MEMORY_SCOPE_AGENT); }
    } else {
        if (tid == 0) { unsigned sp = 0; while (__hip_atomic_load(flag, __ATOMIC_RELAXED, __HIP_MEMORY_SCOPE_AGENT) == 0u) { __builtin_amdgcn_s_sleep(8); if (++sp > (1u << 22)) break; }
            __builtin_amdgcn_fence(__ATOMIC_ACQUIRE, "agent"); asm volatile("s_waitcnt vmcnt(0)" ::: "memory"); }
        __syncthreads();
#pragma unroll
        for (int i = 0; i < 4; ++i)
#pragma unroll
            for (int r = 0; r < 4; ++r) Macc[i][r] = STATE[((w * 4 + i) * 4 + r) * 64 + lane];
        f32x4 pi0, pi1, pi2; unsigned pu0, pu1; u32x2 pv, pgate; float pbs;
#define RM_REC_LOAD(cc) do { const float* rec = STASH + (size_t)((cc) - c_begin) * REC; pi0 = *(const GAS f32x4*)(rec + 4 * tid); pi1 = *(const GAS f32x4*)(rec + 4 * (tid + 512)); \
            pi2 = (tid < 352) ? *(const GAS f32x4*)(rec + 4 * (tid + 1024)) : (f32x4){0.f, 0.f, 0.f, 0.f}; \
            const GAS unsigned* ru = (const GAS unsigned*)(rec + 5504); pu0 = ru[(w * 2 + 0) * 64 + lane]; pu1 = ru[(w * 2 + 1) * 64 + lane]; pv = *(const GAS u32x2*)(rec + 6528 + 2 * tid); pbs = rec[7552 + hx * 16 + tl]; \
            pgate = *(const GAS u32x2*)(LO + (size_t)((cc) * TC + tl) * LORA_N + col4 + 2048); } while (0)
#define RM_IMG_OFF(i_) (O_IMG + ((i_) >= 688) * IMGSZ + ((((i_) - ((i_) >= 688) * 688) < 144) ? I_RT + 4 * ((i_) - ((i_) >= 688) * 688) : I_BTT + 4 * (((i_) - ((i_) >= 688) * 688) - 144)))
        RM_REC_LOAD(c_begin);
        for (int c = c_begin; c < c_end; ++c) {
            *(LAS f32x4*)(Lf + RM_IMG_OFF(tid)) = pi0; *(LAS f32x4*)(Lf + RM_IMG_OFF(tid + 512)) = pi1; if (tid < 352) *(LAS f32x4*)(Lf + RM_IMG_OFF(tid + 1024)) = pi2;
            const f32x4 vcur = {bf_lo(pv.x), bf_hi(pv.x), bf_lo(pv.y), bf_hi(pv.y)}; *(LAS f32x4*)(Lf + O_VV + hx * 1024 + tl * 64 + d4) = vcur;
            const f32x4 accU = {bf_lo(pu0), bf_hi(pu0), bf_lo(pu1), bf_hi(pu1)}; const float bscur = pbs; const u32x2 gcur = pgate;
            if (c + 1 < c_end) RM_REC_LOAD(c + 1);
            LBAR();
            const LAS float* VVc = Lf + O_VV + hh * 1024;
            u32x2 vlo; { vlo.x = hw_pk2(VVc[(4 * g + 0) * 64 + c0 + fr], VVc[(4 * g + 1) * 64 + c0 + fr]); vlo.y = hw_pk2(VVc[(4 * g + 2) * 64 + c0 + fr], VVc[(4 * g + 3) * 64 + c0 + fr]); }
            const bf16x8 vb = mk_frag(vlo, zz);
            RM_STATE_PART(vb);
            LBAR();
            RM_FLUSH(c, gcur, vcur, bscur);
            LBAR();
        }
#undef RM_REC_LOAD
#undef RM_IMG_OFF
    }
#undef RM_STATE_PART
#undef RM_FLUSH
#undef RM_LOAD
#undef RM_XFORM
}

__device__ __forceinline__ int med3i(int a, int b, int c) { int r; asm("v_med3_i32 %0, %1, %2, %3" : "=v"(r) : "v"(a), "v"(b), "v"(c)); return r; }
__device__ __forceinline__ int f2sort(float f) { int x = __float_as_int(f); return x ^ ((x >> 31) & 0x7fffffff); }
__device__ __forceinline__ float sort2f(int x) { return __int_as_float(x ^ ((x >> 31) & 0x7fffffff)); }
#define TOPK_INSERT(vals, x) do { _Pragma("unroll") for (int s_ = 15; s_ >= 1; --s_) vals[s_] = med3i((x), vals[s_ - 1], vals[s_]); vals[0] = max(vals[0], (x)); } while (0)
__device__ __forceinline__ float bf_dot2(unsigned a, unsigned b, float c) {
    return c + bf_lo(a) * bf_lo(b) + bf_hi(a) * bf_hi(b);
}
__device__ __forceinline__ void sum8_x8(float (&a)[8]) {
    asm("s_nop 1\n\t"
        "v_add_f32_dpp %0, %0, %0 quad_perm:[1,0,3,2] row_mask:0xf bank_mask:0xf\n\tv_add_f32_dpp %1, %1, %1 quad_perm:[1,0,3,2] row_mask:0xf bank_mask:0xf\n\t"
        "v_add_f32_dpp %2, %2, %2 quad_perm:[1,0,3,2] row_mask:0xf bank_mask:0xf\n\tv_add_f32_dpp %3, %3, %3 quad_perm:[1,0,3,2] row_mask:0xf bank_mask:0xf\n\t"
        "v_add_f32_dpp %4, %4, %4 quad_perm:[1,0,3,2] row_mask:0xf bank_mask:0xf\n\tv_add_f32_dpp %5, %5, %5 quad_perm:[1,0,3,2] row_mask:0xf bank_mask:0xf\n\t"
        "v_add_f32_dpp %6, %6, %6 quad_perm:[1,0,3,2] row_mask:0xf bank_mask:0xf\n\tv_add_f32_dpp %7, %7, %7 quad_perm:[1,0,3,2] row_mask:0xf bank_mask:0xf\n\t"
        "v_add_f32_dpp %0, %0, %0 quad_perm:[2,3,0,1] row_mask:0xf bank_mask:0xf\n\tv_add_f32_dpp %1, %1, %1 quad_perm:[2,3,0,1] row_mask:0xf bank_mask:0xf\n\t"
        "v_add_f32_dpp %2, %2, %2 quad_perm:[2,3,0,1] row_mask:0xf bank_mask:0xf\n\tv_add_f32_dpp %3, %3, %3 quad_perm:[2,3,0,1] row_mask:0xf bank_mask:0xf\n\t"
        "v_add_f32_dpp %4, %4, %4 quad_perm:[2,3,0,1] row_mask:0xf bank_mask:0xf\n\tv_add_f32_dpp %5, %5, %5 quad_perm:[2,3,0,1] row_mask:0xf bank_mask:0xf\n\t"
        "v_add_f32_dpp %6, %6, %6 quad_perm:[2,3,0,1] row_mask:0xf bank_mask:0xf\n\tv_add_f32_dpp %7, %7, %7 quad_perm:[2,3,0,1] row_mask:0xf bank_mask:0xf\n\t"
        "v_add_f32_dpp %0, %0, %0 row_half_mirror row_mask:0xf bank_mask:0xf\n\tv_add_f32_dpp %1, %1, %1 row_half_mirror row_mask:0xf bank_mask:0xf\n\t"
        "v_add_f32_dpp %2, %2, %2 row_half_mirror row_mask:0xf bank_mask:0xf\n\tv_add_f32_dpp %3, %3, %3 row_half_mirror row_mask:0xf bank_mask:0xf\n\t"
        "v_add_f32_dpp %4, %4, %4 row_half_mirror row_mask:0xf bank_mask:0xf\n\tv_add_f32_dpp %5, %5, %5 row_half_mirror row_mask:0xf bank_mask:0xf\n\t"
        "v_add_f32_dpp %6, %6, %6 row_half_mirror row_mask:0xf bank_mask:0xf\n\tv_add_f32_dpp %7, %7, %7 row_half_mirror row_mask:0xf bank_mask:0xf\n\t"
        "s_nop 1"
        : "+v"(a[0]), "+v"(a[1]), "+v"(a[2]), "+v"(a[3]), "+v"(a[4]), "+v"(a[5]), "+v"(a[6]), "+v"(a[7]));
}
__device__ __forceinline__ void sum8i_x8(int (&a)[8]) {
    asm("s_nop 1\n\t"
        "v_add_u32_dpp %0, %0, %0 quad_perm:[1,0,3,2] row_mask:0xf bank_mask:0xf\n\tv_add_u32_dpp %1, %1, %1 quad_perm:[1,0,3,2] row_mask:0xf bank_mask:0xf\n\t"
        "v_add_u32_dpp %2, %2, %2 quad_perm:[1,0,3,2] row_mask:0xf bank_mask:0xf\n\tv_add_u32_dpp %3, %3, %3 quad_perm:[1,0,3,2] row_mask:0xf bank_mask:0xf\n\t"
        "v_add_u32_dpp %4, %4, %4 quad_perm:[1,0,3,2] row_mask:0xf bank_mask:0xf\n\tv_add_u32_dpp %5, %5, %5 quad_perm:[1,0,3,2] row_mask:0xf bank_mask:0xf\n\t"
        "v_add_u32_dpp %6, %6, %6 quad_perm:[1,0,3,2] row_mask:0xf bank_mask:0xf\n\tv_add_u32_dpp %7, %7, %7 quad_perm:[1,0,3,2] row_mask:0xf bank_mask:0xf\n\t"
        "v_add_u32_dpp %0, %0, %0 quad_perm:[2,3,0,1] row_mask:0xf bank_mask:0xf\n\tv_add_u32_dpp %1, %1, %1 quad_perm:[2,3,0,1] row_mask:0xf bank_mask:0xf\n\t"
        "v_add_u32_dpp %2, %2, %2 quad_perm:[2,3,0,1] row_mask:0xf bank_mask:0xf\n\tv_add_u32_dpp %3, %3, %3 quad_perm:[2,3,0,1] row_mask:0xf bank_mask:0xf\n\t"
        "v_add_u32_dpp %4, %4, %4 quad_perm:[2,3,0,1] row_mask:0xf bank_mask:0xf\n\tv_add_u32_dpp %5, %5, %5 quad_perm:[2,3,0,1] row_mask:0xf bank_mask:0xf\n\t"
        "v_add_u32_dpp %6, %6, %6 quad_perm:[2,3,0,1] row_mask:0xf bank_mask:0xf\n\tv_add_u32_dpp %7, %7, %7 quad_perm:[2,3,0,1] row_mask:0xf bank_mask:0xf\n\t"
        "v_add_u32_dpp %0, %0, %0 row_half_mirror row_mask:0xf bank_mask:0xf\n\tv_add_u32_dpp %1, %1, %1 row_half_mirror row_mask:0xf bank_mask:0xf\n\t"
        "v_add_u32_dpp %2, %2, %2 row_half_mirror row_mask:0xf bank_mask:0xf\n\tv_add_u32_dpp %3, %3, %3 row_half_mirror row_mask:0xf bank_mask:0xf\n\t"
        "v_add_u32_dpp %4, %4, %4 row_half_mirror row_mask:0xf bank_mask:0xf\n\tv_add_u32_dpp %5, %5, %5 row_half_mirror row_mask:0xf bank_mask:0xf\n\t"
        "v_add_u32_dpp %6, %6, %6 row_half_mirror row_mask:0xf bank_mask:0xf\n\tv_add_u32_dpp %7, %7, %7 row_half_mirror row_mask:0xf bank_mask:0xf\n\t"
        "s_nop 1"
        : "+v"(a[0]), "+v"(a[1]), "+v"(a[2]), "+v"(a[3]), "+v"(a[4]), "+v"(a[5]), "+v"(a[6]), "+v"(a[7]));
}
__device__ __forceinline__ float max8_x1(float v) {
    asm("s_nop 1\n\tv_max_f32_dpp %0, %0, %0 quad_perm:[1,0,3,2] row_mask:0xf bank_mask:0xf\n\ts_nop 1\n\tv_max_f32_dpp %0, %0, %0 quad_perm:[2,3,0,1] row_mask:0xf bank_mask:0xf\n\ts_nop 1\n\t"
        "v_max_f32_dpp %0, %0, %0 row_half_mirror row_mask:0xf bank_mask:0xf\n\ts_nop 1" : "+v"(v));
    return v;
}
__device__ __forceinline__ float sum8_x1(float v) {
    asm("s_nop 1\n\tv_add_f32_dpp %0, %0, %0 quad_perm:[1,0,3,2] row_mask:0xf bank_mask:0xf\n\ts_nop 1\n\tv_add_f32_dpp %0, %0, %0 quad_perm:[2,3,0,1] row_mask:0xf bank_mask:0xf\n\ts_nop 1\n\t"
        "v_add_f32_dpp %0, %0, %0 row_half_mirror row_mask:0xf bank_mask:0xf\n\ts_nop 1" : "+v"(v));
    return v;
}
__device__ __forceinline__ void peer_phase(const Args& A, Frame& F, int L, const bool dry, const bf16* Hin, bf16* Hout, unsigned char* H8) {
    int lane = F.lane; asm volatile("" : "+v"(lane));
    const int gw = F.vcu * NWAVES + F.wave;
    const bf16* SCR = (const bf16*)(A.ws + WS_SC); const bf16* X = Hin; float* RS3 = (float*)(A.ws + WS_RS3);
    const unsigned char* TU = (const unsigned char*)(A.ws + WS_TABU) + (size_t)L * 16384 * D; const unsigned char* TV = (const unsigned char*)(A.ws + WS_TABV) + (size_t)L * 16384 * D;
    const float* SUL = (const float*)(A.ws + WS_SU) + (size_t)L * 16384; const float* SVL = SUL + 32768;
    const float* rowss = (const float*)(A.ws + WS_RSP) + (size_t)(L == 0 ? RS_FFN0 : RS_FFN1) * T * 32;
    LAS unsigned* LIST = (LAS unsigned*)(F.lds + RING_OFF + F.wave * 16384);
    LAS unsigned* EIDX = LIST + 1024;
    LAS float* ECOEF = (LAS float*)(EIDX + 1024);
    const int tbase = gw * 8;
    if (tbase >= T) return;
    for (int half = 0; half < 2; ++half) {
        const int t0 = tbase + 4 * half;
        {
            const bf16* sp = SCR + (size_t)(t0 + (lane >> 4)) * D + (lane & 15) * 128;
            int vals[16];
#pragma unroll
            for (int s = 0; s < 16; ++s) vals[s] = (int)0x80000000;
#pragma unroll 2
            for (int c = 0; c < 16; ++c) { const v4u wv = *(const GAS v4u*)(sp + c * 8); const unsigned ww[4] = {wv.x, wv.y, wv.z, wv.w};
#pragma unroll
                for (int e = 0; e < 8; ++e) { const unsigned bits = (e & 1) ? (ww[e >> 1] & 0xffff0000u) : (ww[e >> 1] << 16);
                    int x = (int)bits; x ^= (x >> 31) & 0x7fffffff; x = (x & ~0x7f) | (127 - (c * 8 + e));
                    TOPK_INSERT(vals, x); } }
#pragma unroll
            for (int q = 0; q < 4; ++q) { v4u o; o.x = (unsigned)vals[4 * q]; o.y = (unsigned)vals[4 * q + 1]; o.z = (unsigned)vals[4 * q + 2]; o.w = (unsigned)vals[4 * q + 3]; *(LAS v4u*)(LIST + lane * 16 + 4 * q) = o; }
        }
        LDS_WAIT(); asm volatile("" ::: "memory");
        if (lane < 32) {
            const LAS unsigned* la = LIST + ((lane >> 3) * 16 + (lane & 7) * 2) * 16; const LAS unsigned* lb2 = la + 16;
            float av[16], bv[16];
#pragma unroll
            for (int q = 0; q < 4; ++q) { const v4u a4 = *(const LAS v4u*)(la + 4 * q), b4 = *(const LAS v4u*)(lb2 + 4 * q); const unsigned aw[4] = {a4.x, a4.y, a4.z, a4.w}, bw[4] = {b4.x, b4.y, b4.z, b4.w};
#pragma unroll
                for (int e = 0; e < 4; ++e) { av[4 * q + e] = __uint_as_float(__float_as_uint(sort2f((int)(aw[e] & ~0x7fu))) & 0xffff0000u); bv[4 * q + e] = __uint_as_float(__float_as_uint(sort2f((int)(bw[e] & ~0x7fu))) & 0xffff0000u); } }
            int best[16];
#pragma unroll
            for (int s = 0; s < 16; ++s) best[s] = (int)0x80000000;
#pragma unroll
            for (int i = 0; i < 16; ++i)
#pragma unroll
                for (int jx = 0; jx < 16; ++jx) if ((i + 1) * (jx + 1) <= 16) { int x = f2sort(av[i] + bv[jx]); x = (x & ~0xff) | (255 - (i * 16 + jx)); TOPK_INSERT(best, x); }
            float sv[16]; unsigned ex[16];
#pragma unroll
            for (int s = 0; s < 16; ++s) { const int cand = 255 - (best[s] & 0xff); const unsigned ka = la[cand >> 4], kb = lb2[cand & 15];
                ex[s] = (127u - (ka & 0x7fu)) * 128u + (127u - (kb & 0x7fu));
                sv[s] = __uint_as_float(__float_as_uint(sort2f((int)(ka & ~0x7fu))) & 0xffff0000u) + __uint_as_float(__float_as_uint(sort2f((int)(kb & ~0x7fu))) & 0xffff0000u); }
            float mx = sv[0];
#pragma unroll
            for (int s = 1; s < 16; ++s) mx = fmaxf(mx, sv[s]);
            float den = 0.f;
#pragma unroll
            for (int s = 0; s < 16; ++s) { sv[s] = __expf(sv[s] - mx); den += sv[s]; }
            const float inv = 1.0f / den; const int base = (4 * half + (lane >> 3)) * 128 + (lane & 7) * 16;
#pragma unroll
            for (int s = 0; s < 16; ++s) { EIDX[base + s] = ex[s]; ECOEF[base + s] = sv[s] * inv; }
        }
        LDS_WAIT(); asm volatile("" ::: "memory");
    }
    const int tk = lane >> 3, part = lane & 7, t = tbase + tk;
    const LAS unsigned* eidx = EIDX + tk * 128; LAS float* ecoef = ECOEF + tk * 128;
    const float rs = __builtin_amdgcn_rsqf(sum8_x1(((const GAS f32x4*)(rowss + (size_t)t * 32))[part][0] + ((const GAS f32x4*)(rowss + (size_t)t * 32))[part][1] + ((const GAS f32x4*)(rowss + (size_t)t * 32))[part][2] + ((const GAS f32x4*)(rowss + (size_t)t * 32))[part][3]) * (1.0f / D) + EPS);
    typedef _Float16 h2_t __attribute__((ext_vector_type(2)));
#if PEER_ALIAS
    const unsigned amask = dry ? 1023u : 0xffffffffu;
#else
    constexpr unsigned amask = 0xffffffffu;
#endif
#define PEER_LOAD8(dst, TAB, i0, soff) do { const v4u ia_ = *(const LAS v4u*)(eidx + (i0)), ib_ = *(const LAS v4u*)(eidx + (i0) + 4); const unsigned ee_[8] = {ia_.x, ia_.y, ia_.z, ia_.w, ib_.x, ib_.y, ib_.z, ib_.w}; \
        _Pragma("unroll") for (int j_ = 0; j_ < 8; ++j_) dst[j_] = *(const GAS v4u*)((TAB) + (size_t)((ee_[j_] & amask) * 2048u + (unsigned)(soff))); } while (0)
    LAS float* dotw = (LAS float*)LIST + tk * 128;
#pragma unroll
    for (int m = 0; m < 16; ++m) dotw[8 * m + part] = 0.f;
#pragma unroll 1
    for (int p = 0; p < 16; ++p) {
        const int soff = 128 * p + 16 * part;
        unsigned xq[4]; float sxs;
        { const v4u x0 = *(const GAS v4u*)(X + (size_t)t * D + soff), x1 = *(const GAS v4u*)(X + (size_t)t * D + soff + 8); const unsigned xw[8] = {x0.x, x0.y, x0.z, x0.w, x1.x, x1.y, x1.z, x1.w};
          float xv[16], am = 0.f;
#pragma unroll
          for (int e = 0; e < 8; ++e) { xv[2 * e] = bf_lo(xw[e]); xv[2 * e + 1] = bf_hi(xw[e]); am = fmaxf(am, fmaxf(fabsf(xv[2 * e]), fabsf(xv[2 * e + 1]))); }
          am = max8_x1(am); sxs = am * (1.0f / 127.0f); const float inv = am > 0.f ? 127.0f / am : 0.f;
#pragma unroll
          for (int q = 0; q < 4; ++q) { unsigned w = 0;
#pragma unroll
              for (int e = 0; e < 4; ++e) w |= (__float_as_uint(__builtin_fmaf(xv[4 * q + e], inv, 12582912.0f)) & 255u) << (8 * e);
              xq[q] = w; } }
#define PEER_UDOT8(src, m_) do { int tt_[8]; \
        _Pragma("unroll") for (int j_ = 0; j_ < 8; ++j_) { int a_ = __builtin_amdgcn_sdot4((int)src[j_].x, (int)xq[0], 0, false); a_ = __builtin_amdgcn_sdot4((int)src[j_].y, (int)xq[1], a_, false); \
            a_ = __builtin_amdgcn_sdot4((int)src[j_].z, (int)xq[2], a_, false); tt_[j_] = __builtin_amdgcn_sdot4((int)src[j_].w, (int)xq[3], a_, false); } \
        sum8i_x8(tt_); \
        int sel_ = tt_[0]; _Pragma("unroll") for (int j_ = 1; j_ < 8; ++j_) sel_ = (part == j_) ? tt_[j_] : sel_; \
        dotw[8 * (m_) + part] += (float)sel_ * sxs; } while (0)
        v4u ua[8], ub[8];
        PEER_LOAD8(ua, TU, 0, soff);
#pragma unroll 1
        for (int m = 0; m < 16; m += 2) {
            PEER_LOAD8(ub, TU, 8 * (m + 1), soff);
            PEER_UDOT8(ua, m);
            if (m + 2 < 16) PEER_LOAD8(ua, TU, 8 * (m + 2), soff);
            PEER_UDOT8(ub, m + 1);
        }
    }
#undef PEER_UDOT8
    LAS unsigned char* ecq = (LAS unsigned char*)(LIST + 3072) + tk * 128;
    float sc;
    { float cf[16], cm = 0.f;
#pragma unroll
      for (int m = 0; m < 16; ++m) { const unsigned e_ = eidx[8 * m + part]; const float d_ = dotw[8 * m + part] * rs * SUL[e_]; const float act = 0.5f * d_ * (1.0f + erff(d_ * 0.7071067811865476f));
          cf[m] = ecoef[8 * m + part] * act * SVL[e_]; cm = fmaxf(cm, fabsf(cf[m])); }
      cm = max8_x1(cm); sc = cm * (1.0f / 127.0f); const float inv = cm > 0.f ? 127.0f / cm : 0.f;
#pragma unroll
      for (int m = 0; m < 16; ++m) ecq[8 * m + part] = (unsigned char)(__float_as_uint(__builtin_fmaf(cf[m], inv, 12582912.0f)) & 255u); }
    LDS_WAIT(); asm volatile("" ::: "memory");
    float ss = 0.f;
#pragma unroll 1
    for (int p = 0; p < 16; ++p) {
        const int soff = 128 * p + 16 * part;
        int acc[16];
#pragma unroll
        for (int i = 0; i < 16; ++i) acc[i] = 0;
#define PEER_VACC8(src, i0) do { const u32x2 c8_ = *(const LAS u32x2*)(ecq + (i0)); \
        _Pragma("unroll") for (int h_ = 0; h_ < 2; ++h_) { const int cq_ = (int)(h_ ? c8_.y : c8_.x); \
            _Pragma("unroll") for (int q_ = 0; q_ < 4; ++q_) { \
                const unsigned a_ = q_ == 0 ? src[4 * h_].x : q_ == 1 ? src[4 * h_].y : q_ == 2 ? src[4 * h_].z : src[4 * h_].w, b_ = q_ == 0 ? src[4 * h_ + 1].x : q_ == 1 ? src[4 * h_ + 1].y : q_ == 2 ? src[4 * h_ + 1].z : src[4 * h_ + 1].w; \
                const unsigned c_ = q_ == 0 ? src[4 * h_ + 2].x : q_ == 1 ? src[4 * h_ + 2].y : q_ == 2 ? src[4 * h_ + 2].z : src[4 * h_ + 2].w, d_ = q_ == 0 ? src[4 * h_ + 3].x : q_ == 1 ? src[4 * h_ + 3].y : q_ == 2 ? src[4 * h_ + 3].z : src[4 * h_ + 3].w; \
                const unsigned lab_ = __builtin_amdgcn_perm(b_, a_, 0x05010400u), hab_ = __builtin_amdgcn_perm(b_, a_, 0x07030602u), lcd_ = __builtin_amdgcn_perm(d_, c_, 0x05010400u), hcd_ = __builtin_amdgcn_perm(d_, c_, 0x07030602u); \
                acc[4 * q_ + 0] = __builtin_amdgcn_sdot4((int)__builtin_amdgcn_perm(lcd_, lab_, 0x05040100u), cq_, acc[4 * q_ + 0], false); \
                acc[4 * q_ + 1] = __builtin_amdgcn_sdot4((int)__builtin_amdgcn_perm(lcd_, lab_, 0x07060302u), cq_, acc[4 * q_ + 1], false); \
                acc[4 * q_ + 2] = __builtin_amdgcn_sdot4((int)__builtin_amdgcn_perm(hcd_, hab_, 0x05040100u), cq_, acc[4 * q_ + 2], false); \
                acc[4 * q_ + 3] = __builtin_amdgcn_sdot4((int)__builtin_amdgcn_perm(hcd_, hab_, 0x07060302u), cq_, acc[4 * q_ + 3], false); } } } while (0)
        v4u va[8], vb[8];
        PEER_LOAD8(va, TV, 0, soff);
#pragma unroll 1
        for (int m = 0; m < 16; m += 2) {
            PEER_LOAD8(vb, TV, 8 * (m + 1), soff);
            PEER_VACC8(va, 8 * m);
            if (m + 2 < 16) PEER_LOAD8(va, TV, 8 * (m + 2), soff);
            PEER_VACC8(vb, 8 * (m + 1));
        }
        { const v4u h0 = *(const GAS v4u*)(Hin + (size_t)t * D + soff), h1 = *(const GAS v4u*)(Hin + (size_t)t * D + soff + 8); const unsigned hw[8] = {h0.x, h0.y, h0.z, h0.w, h1.x, h1.y, h1.z, h1.w}; unsigned ow[8];
#pragma unroll
          for (int e = 0; e < 8; ++e) { ow[e] = hw_pk2(bf_lo(hw[e]) + (float)acc[2 * e] * sc, bf_hi(hw[e]) + (float)acc[2 * e + 1] * sc); const float q0 = bf_lo(ow[e]), q1 = bf_hi(ow[e]); ss += q0 * q0 + q1 * q1; }
          v4u o0, o1; o0.x = ow[0]; o0.y = ow[1]; o0.z = ow[2]; o0.w = ow[3]; o1.x = ow[4]; o1.y = ow[5]; o1.z = ow[6]; o1.w = ow[7];
          if (!dry) { *(GAS v4u*)(Hout + (size_t)t * D + soff) = o0; *(GAS v4u*)(Hout + (size_t)t * D + soff + 8) = o1;
            if (H8) { v4u o8; unsigned q8[4];
#pragma unroll
              for (int e = 0; e < 4; ++e) { int x8 = __builtin_amdgcn_cvt_pk_fp8_f32(bf_lo(ow[2 * e]), bf_hi(ow[2 * e]), 0, false); x8 = __builtin_amdgcn_cvt_pk_fp8_f32(bf_lo(ow[2 * e + 1]), bf_hi(ow[2 * e + 1]), x8, true); q8[e] = (unsigned)x8; }
              o8.x = q8[0]; o8.y = q8[1]; o8.z = q8[2]; o8.w = q8[3]; *(GAS v4u*)(H8 + (size_t)t * D + soff) = o8; } } else asm volatile("" :: "v"(o0.x), "v"(o0.y), "v"(o0.z), "v"(o0.w), "v"(o1.x), "v"(o1.y), "v"(o1.z), "v"(o1.w)); }
    }
#undef PEER_VACC8
#undef PEER_LOAD8
    const float r3 = __builtin_amdgcn_rsqf(sum8_x1(ss) * (1.0f / D) + EPS);
    if (!dry && part == 0) RS3[t] = r3;
}


constexpr int N_PHASES = 19;
__global__ void __launch_bounds__(NTHREADS, 2) mega_fwd(Args args) {

    extern __shared__ __attribute__((aligned(16))) unsigned char lds[];
    Frame F;
    F.lds = (LAS unsigned char*)lds;
    F.MISC = (volatile LAS unsigned*)(F.lds + MISC_OFF);
    F.tid = threadIdx.x; F.lane = F.tid & 63; F.wave = __builtin_amdgcn_readfirstlane(F.tid >> 6);
    F.G = gridDim.x; { const int bx = blockIdx.x; F.vcu = (F.G % 8 == 0) ? (bx % 8) * (F.G / 8) + bx / 8 : bx; }
    unsigned char* ws = args.ws;
    F.ctl = (gu32*)(ws + WS_CTL);
    for (int u = F.tid; u < (LDS_BYTES - LDSCTL_OFF) / 4; u += NTHREADS) ((LAS unsigned*)(F.lds + LDSCTL_OFF))[u] = 0u;
    __syncthreads();
    const int lo = args.ph_lo, hi = args.ph_hi;
    XcdBarrier bar; bar.bar = (unsigned*)(F.ctl + CW_BAR); bar.x = 0; bar.st = nullptr;
    if (hi - lo > 1) bar = xcd_barrier_post((unsigned*)(F.ctl + CW_BAR), F.MISC + 8);
    bar.wave0 = (F.wave == 0);
#define IN(k) (lo <= (k) && (k) < hi)
#define REFRESH() do { int t_; asm volatile("v_mbcnt_lo_u32_b32 %0, -1, 0\n\tv_mbcnt_hi_u32_b32 %0, -1, %0" : "=v"(t_)); F.lane = t_; F.tid = F.wave * 64 + t_; } while (0)
#define REPS(k) (1 + ((DUP_MASK >> (k)) & 1))
#if PROBE_MASK
    unsigned long long* const tsb = (unsigned long long*)(ws + WS_CTL + 65536);
#define STAMP(k) do { if (blockIdx.x == 0 && F.tid == 0) __hip_atomic_store(tsb + (k), __builtin_amdgcn_s_memrealtime(), __ATOMIC_RELAXED, __HIP_MEMORY_SCOPE_AGENT); } while (0)
    STAMP(31);
#else
#define STAMP(k) do { } while (0)
#endif
#define SEAM(k) do { if (IN(k) && IN((k) + 1)) { if ((k) == 0) { cg::this_grid().sync(); } else { xcd_barrier(bar); if ((DUP_MASK >> 24) & 1) xcd_barrier(bar); } STAMP(k); } } while (0)
    float* rowss = (float*)(ws + WS_RSP);
    bf16* ACTA = (bf16*)(ws + WS_ACTA); bf16* ACTB = (bf16*)(ws + WS_ACTB); bf16* H1 = (bf16*)(ws + WS_H1); const float* RS3 = (const float*)(ws + WS_RS3);
    bf16* PROJ = (bf16*)(ws + WS_PROJ); bf16* SCB = (bf16*)(ws + WS_SC); bf16* PP = (bf16*)(ws + WS_PP);
    const int gtid = (F.vcu * NWAVES + F.wave) * 64 + F.lane, gthreads = F.G * NTHREADS;

#if UBENCH
    {
        typedef _Float16 h2_t __attribute__((ext_vector_type(2)));
        float a[32]; f32x2 p[16]; h2_t hh[32];
#pragma unroll
        for (int i = 0; i < 32; ++i) { a[i] = (float)(F.tid + i); hh[i] = (h2_t){(_Float16)(F.lane + i), (_Float16)i}; }
#pragma unroll
        for (int i = 0; i < 16; ++i) p[i] = (f32x2){a[2 * i], a[2 * i + 1]};
        const float m = 1.0f + 1e-7f * F.lane, c = 1e-9f; const f32x2 m2 = {m, m}, c2 = {c, c}; const h2_t mh = {(_Float16)1.0f, (_Float16)1.0f}, ch = {(_Float16)0.0f, (_Float16)0.0f};
#pragma unroll 1
        for (int it = 0; it < 10000; ++it) {
#if UBENCH == 1
#pragma unroll
            for (int i = 0; i < 32; ++i) asm volatile("v_fma_f32 %0, %0, %1, %2" : "+v"(a[i]) : "v"(m), "v"(c));
#elif UBENCH == 2
#pragma unroll
            for (int i = 0; i < 16; ++i) asm volatile("v_pk_fma_f32 %0, %0, %1, %2\n\tv_pk_fma_f32 %0, %0, %1, %2" : "+v"(p[i]) : "v"(m2), "v"(c2));
#elif UBENCH == 3
#pragma unroll
            for (int i = 0; i < 32; ++i) asm volatile("v_pk_fma_f16 %0, %0, %1, %2" : "+v"(hh[i]) : "v"(mh), "v"(ch));
#endif
        }
        float s = 0.f;
#pragma unroll
        for (int i = 0; i < 32; ++i) s += a[i] + (float)hh[i][0];
#pragma unroll
        for (int i = 0; i < 16; ++i) s += p[i][0] + p[i][1];
        if (s == 12345.678f) args.out[0] = s;
    }
#endif
    if (IN(0)) { REFRESH(); p0_prologue(args, F, 0); if (hi - lo > 1) { xcd_barrier(bar); REFRESH(); p0_prologue(args, F, 1); } } SEAM(0);
    if (IN(1)) for (int rep_ = 0; rep_ < REPS(1); ++rep_) { REFRESH();
#if EV_F8_T1 > EV_F8_T0
        if (EV_F8_T0 > 0) { constexpr int n_ = EV_F8_T0 * 256; pg8::Gemm g{ACTA, (const bf16*)(ws + WS_WEV_IN), T, n_, D}; pg8::StaticOrder S; S.init(T, n_, F.G, (int)blockIdx.x); EpiBf16S E{PROJ, PROJ_LD, nullptr};
          pg8::gemm_phase<EpiBf16S, pg8::StaticOrder, true, true>(F.lds + RING_OFF, g, S, E, F.wave); }
        { constexpr int n_ = (EV_F8_T1 - EV_F8_T0) * 256; pg8::Gemm g{(const bf16*)(ws + WS_H1), (const bf16*)(ws + WS_O + (size_t)EV_F8_T0 * 256 * D), T, n_, D / 2}; pg8::StaticOrder S; S.init(T, n_, F.G, (int)blockIdx.x); EpiBf16S E{PROJ + EV_F8_T0 * 256, PROJ_LD, nullptr};
          pg8::gemm_phase<EpiBf16S, pg8::StaticOrder, true, true, true>(F.lds + RING_OFF, g, S, E, F.wave); }
        if (EV_F8_T1 < EV_NP / 256) { constexpr int n_ = EV_NP - EV_F8_T1 * 256; pg8::Gemm g{ACTA, (const bf16*)(ws + WS_WEV_IN) + (size_t)EV_F8_T1 * 256 * D, T, n_, D}; pg8::StaticOrder S; S.init(T, n_, F.G, (int)blockIdx.x); EpiBf16S E{PROJ + EV_F8_T1 * 256, PROJ_LD, nullptr};
          pg8::gemm_phase<EpiBf16S, pg8::StaticOrder, true, true>(F.lds + RING_OFF, g, S, E, F.wave); }
        if (true) { const int g2 = F.G, c2 = (int)blockIdx.x;
#else
        { pg8::Gemm g{ACTA, (const bf16*)(ws + WS_WEV_IN), T, EV_NP, D / 2}; pg8::StaticOrder S; S.init(T, EV_NP, F.G, (int)blockIdx.x); EpiI8S E{PROJ, PROJ_LD, (const float*)(ws + WS_SA), (const float*)(ws + WS_CMB)};
          pg8::gemm_phase<EpiI8S, pg8::StaticOrder, true, true, false, true>(F.lds + RING_OFF, g, S, E, F.wave); }
        if (F.G == 256 ? (int)blockIdx.x >= 64 : true) { const int g2 = F.G == 256 ? 192 : F.G, c2 = F.G == 256 ? (int)blockIdx.x - 64 : (int)blockIdx.x;
#endif
          pg8::Gemm g{(const bf16*)(ws + WS_PBF), (const bf16*)(ws + WS_WPROJ), T, D, 256}; pg8::StaticOrder S; S.init(T, D, g2, c2); EpiBf16S E{PP, D, nullptr};
          pg8::gemm_phase<EpiBf16S, pg8::StaticOrder, true, true>(F.lds + RING_OFF, g, S, E, F.wave); }
    } SEAM(1);
    if (IN(2)) for (int rep_ = 0; rep_ < REPS(2); ++rep_) { REFRESH();
        if (F.G >= 256) {
            const int u = F.vcu;
            if (u < 64) scan_gla_mfma_unit<0>(args, F, u); else if (u < 128) scan_gdn_mfma_unit(args, F, u - 64, 0); else if (u < 192) scan_gdn_mfma_unit(args, F, u - 128, 1);
            __syncthreads();
            if (rep_ == 0) for (int dr_ = 0; dr_ < 1 + ((DUP_MASK >> 22) & 1); ++dr_) { if (u < 64) p0_deferred(args, F, 128 + u, 192); else if (u >= 192) for (int k = 0; k < 2; ++k) p0_deferred(args, F, 2 * (u - 192) + k, 192); }
        } else {
            for (int u = F.vcu; u < 64; u += F.G) { scan_gla_mfma_unit<0>(args, F, u); __syncthreads(); }
            for (int u = F.vcu; u < 64; u += F.G) { scan_gdn_mfma_unit(args, F, u, 0); __syncthreads(); scan_gdn_mfma_unit(args, F, u, 1); __syncthreads(); }
            if (rep_ == 0) p0_deferred(args, F, F.vcu, F.G);
        }
    } SEAM(2);
    if (IN(3)) for (int rep_ = 0; rep_ < REPS(3); ++rep_) { REFRESH(); post_rows<0>(args, F); } SEAM(3);
    if (IN(4)) { REFRESH(); pg8::Gemm g{ACTA, (const bf16*)(ws + WS_WEV_OUT), T, D, D}; pg8::StaticOrder S; S.init(T, D, F.G, (int)blockIdx.x);
        EpiResid<false, true> E{args.in[I_X], ACTB, rowss + (size_t)RS_FFN0 * T * 32, nullptr, nullptr, nullptr, nullptr, nullptr};
        pg8::gemm_phase<EpiResid<false, true>, pg8::StaticOrder, true, true>(F.lds + RING_OFF, g, S, E, F.wave); }
#if (DUP_MASK >> 20) & 1
    if (IN(4)) { REFRESH(); pg8::Gemm g{ACTA, (const bf16*)(ws + WS_WEV_OUT), T, D, D}; pg8::StaticOrder S; S.init(T, D, F.G, (int)blockIdx.x);
        EpiResid<false, true> E{args.in[I_X], ACTB, rowss + (size_t)RS_FFN0 * T * 32, nullptr, nullptr, nullptr};
        pg8::gemm_phase<EpiResid<false, true>, pg8::StaticOrder, true, true>(F.lds + RING_OFF, g, S, E, F.wave); }
#endif
#if (DUP_MASK >> 21) & 1
    if (IN(4)) { REFRESH(); pg8::Gemm g{ACTA, (const bf16*)(ws + WS_WEV_IN), T, EV_NP, D}; pg8::StaticOrder S; S.init(T, EV_NP, F.G, (int)blockIdx.x); EpiBf16S E{PROJ, PROJ_LD, nullptr};
        pg8::gemm_phase<EpiBf16S, pg8::StaticOrder, true, true>(F.lds + RING_OFF, g, S, E, F.wave); }
#endif
    SEAM(4);
    if (IN(5)) for (int rep_ = 0; rep_ < REPS(5); ++rep_) { REFRESH(); { pg8::Gemm g{ACTB, (const bf16*)(ws + WS_WPEER), T, D, D}; pg8::StaticOrder S; S.init(T, D, F.G, (int)blockIdx.x); EpiBf16S E{SCB, D, rowss + (size_t)RS_FFN0 * T * 32};
        pg8::gemm_phase<EpiBf16S, pg8::StaticOrder, true, true>(F.lds + RING_OFF, g, S, E, F.wave); }
        } SEAM(5);
    if (IN(6)) for (int rep_ = 0; rep_ < REPS(6); ++rep_) { REFRESH(); peer_phase(args, F, 0, rep_ != 0, ACTB, H1, (unsigned char*)ACTA); } SEAM(6);
    if (IN(7)) { REFRESH(); { pg8::Gemm g{ACTA, (const bf16*)(ws + WS_WGATE), T, D, D / 2}; pg8::StaticOrder S; S.init(T, D, F.G, (int)blockIdx.x);
        EpiResid<true, false> E{H1, ACTB, rowss + (size_t)RS_MIX1 * T * 32, PP, RS3, (unsigned char*)ACTA + (size_t)T * D};
        pg8::gemm_phase<EpiResid<true, false>, pg8::StaticOrder, true, true, true>(F.lds + RING_OFF, g, S, E, F.wave); }
        } SEAM(7);
    if (IN(8)) for (int rep_ = 0; rep_ < REPS(8); ++rep_) { REFRESH();
        { pg8::Gemm g{(const bf16*)((const unsigned char*)ACTA + (size_t)T * D), (const bf16*)(ws + WS_WOD_IN), T, OD_NP, D / 2}; pg8::StaticOrder S; S.init(T, OD_NP, F.G, (int)blockIdx.x); EpiBf16S E{PROJ, PROJ_LD, rowss + (size_t)RS_MIX1 * T * 32};
          pg8::gemm_phase<EpiBf16S, pg8::StaticOrder, true, true, true>(F.lds + RING_OFF, g, S, E, F.wave); }
        if (F.G < 256) { pg8::Gemm g{(const bf16*)(ws + WS_PBF) + (size_t)T * 256, (const bf16*)(ws + WS_WPROJ) + (size_t)D * 256, T, D, 256}; pg8::StaticOrder S; S.init(T, D, F.G, (int)blockIdx.x); EpiBf16S E{PP, D, nullptr};
          pg8::gemm_phase<EpiBf16S, pg8::StaticOrder, true, true>(F.lds + RING_OFF, g, S, E, F.wave); }
    } SEAM(8);
    if (IN(9)) for (int rep_ = 0; rep_ < REPS(9); ++rep_) { REFRESH(); lora_prep_rows(args, F); } SEAM(9);
    if (IN(10)) for (int rep_ = 0; rep_ < REPS(10); ++rep_) { REFRESH();
        { pg8::Gemm g{(const bf16*)(ws + WS_LA), (const bf16*)(ws + WS_WLORA), T, 1024, LORA_K, 128}; pg8::StaticOrder S; S.init(T, 1024, F.G, (int)blockIdx.x); EpiBf16S E{(bf16*)(ws + WS_LO), LORA_N, nullptr};
          pg8::gemm_phase<EpiBf16S, pg8::StaticOrder, true, true>(F.lds + RING_OFF, g, S, E, F.wave); }
        { pg8::Gemm g{(const bf16*)(ws + WS_LA) + 64, (const bf16*)(ws + WS_WLORA) + (size_t)1024 * LORA_K + 64, T, 1024, LORA_K, 128}; pg8::StaticOrder S; S.init(T, 1024, F.G, (int)blockIdx.x); EpiBf16S E{(bf16*)(ws + WS_LO) + 1024, LORA_N, nullptr};
          pg8::gemm_phase<EpiBf16S, pg8::StaticOrder, true, true>(F.lds + RING_OFF, g, S, E, F.wave); }
        { pg8::Gemm g{(const bf16*)(ws + WS_LA) + 192, (const bf16*)(ws + WS_WLORA) + (size_t)2048 * LORA_K + 192, T, 1024, LORA_K, 256}; pg8::StaticOrder S; S.init(T, 1024, F.G, (int)blockIdx.x); EpiBf16S E{(bf16*)(ws + WS_LO) + 2048, LORA_N, nullptr};
          pg8::gemm_phase<EpiBf16S, pg8::StaticOrder, true, true>(F.lds + RING_OFF, g, S, E, F.wave); }
    } SEAM(10);
    if (IN(11)) for (int rep_ = 0; rep_ < REPS(11); ++rep_) { REFRESH();
        if (F.G >= 256) {
            const int u = F.vcu;
            if (u < 64) scan_gla_mfma_unit<1>(args, F, u); else if (u < 128) scan_rwkv_mfma_unit(args, F, u - 64, 0); else if (u < 192) scan_rwkv_mfma_unit(args, F, u - 128, 1);
            __syncthreads();
            if (rep_ == 0 && u >= 64 && u < 128) {
                pg8::Gemm g{(const bf16*)(ws + WS_PBF) + (size_t)T * 256, (const bf16*)(ws + WS_WPROJ) + (size_t)D * 256, T, D, 256}; pg8::StaticOrder S; S.init(T, D, 64, u - 64); EpiBf16S E{PP, D, nullptr};
                pg8::gemm_phase<EpiBf16S, pg8::StaticOrder, true, true>(F.lds + RING_OFF, g, S, E, F.wave); }
            if (rep_ == 0) for (int dr_ = 0; dr_ < 1 + ((DUP_MASK >> 23) & 1); ++dr_) { if (u < 64) p1_deferred(args, F, 128 + u, 192); else if (u >= 192) for (int k = 0; k < 2; ++k) p1_deferred(args, F, 2 * (u - 192) + k, 192); }
        } else {
            for (int u = F.vcu; u < 64; u += F.G) { scan_gla_mfma_unit<1>(args, F, u); __syncthreads(); }
            for (int u = F.vcu; u < 64; u += F.G) { scan_rwkv_mfma_unit(args, F, u, 0); __syncthreads(); scan_rwkv_mfma_unit(args, F, u, 1); __syncthreads(); }
            if (rep_ == 0) p1_deferred(args, F, F.vcu, F.G);
        }
    } SEAM(11);
    if (IN(12)) for (int rep_ = 0; rep_ < REPS(12); ++rep_) { REFRESH(); post_rows<1>(args, F); } SEAM(12);
    if (IN(13)) { REFRESH(); pg8::Gemm g{ACTA, (const bf16*)(ws + WS_WOD_OUT), T, D, D / 2}; pg8::StaticOrder S; S.init(T, D, F.G, (int)blockIdx.x);
        EpiResid<false, false> E{ACTB, H1, rowss + (size_t)RS_FFN1 * T * 32, nullptr, nullptr, nullptr};
        pg8::gemm_phase<EpiResid<false, false>, pg8::StaticOrder, true, true, true>(F.lds + RING_OFF, g, S, E, F.wave); } SEAM(13);
    if (IN(14)) for (int rep_ = 0; rep_ < REPS(14); ++rep_) { REFRESH(); pg8::Gemm g{H1, (const bf16*)(ws + WS_WPEER) + (size_t)D * D, T, D, D}; pg8::StaticOrder S; S.init(T, D, F.G, (int)blockIdx.x); EpiBf16S E{SCB, D, rowss + (size_t)RS_FFN1 * T * 32};
        pg8::gemm_phase<EpiBf16S, pg8::StaticOrder, true, true>(F.lds + RING_OFF, g, S, E, F.wave); } SEAM(14);
    if (IN(15)) for (int rep_ = 0; rep_ < REPS(15); ++rep_) { REFRESH(); peer_phase(args, F, 1, rep_ != 0, H1, ACTB, (unsigned char*)ACTA); } SEAM(15);
    if (IN(16)) { REFRESH(); pg8::Gemm g{ACTA, (const bf16*)(ws + WS_WGATE) + (size_t)D * D, T, D, D / 2}; pg8::StaticOrder S; S.init(T, D, F.G, (int)blockIdx.x);
        EpiResid<true, false> E{ACTB, H1, rowss + (size_t)RS_FINAL * T * 32, PP, RS3, nullptr};
        pg8::gemm_phase<EpiResid<true, false>, pg8::StaticOrder, true, true, true>(F.lds + RING_OFF, g, S, E, F.wave); } SEAM(16);
    if (IN(17)) { REFRESH();
        float oscale = 1.0f;
#if PROBE_MASK
        { unsigned long long t_prev = __hip_atomic_load(tsb + 31, __ATOMIC_RELAXED, __HIP_MEMORY_SCOPE_AGENT); const unsigned long long t_begin = t_prev; unsigned long long sel = 0ull;
          for (int k = 0; k <= 16; ++k) { const unsigned long long tk = __hip_atomic_load(tsb + k, __ATOMIC_RELAXED, __HIP_MEMORY_SCOPE_AGENT); if ((PROBE_MASK >> k) & 1) sel += tk - t_prev; t_prev = tk; }
          const float f = (float)(double(sel) / double(t_prev - t_begin)); oscale = 1.0f + sqrtf(0.01f + 0.9f * f); }
#endif
        final_rows(args, F, oscale, H1); }
#undef IN
#undef SEAM
#undef REFRESH
}

extern "C" void kernel_launch(void* const* d_in, const int* in_sizes, int n_in, void* d_out, int out_size, void* d_ws, size_t ws_size, hipStream_t stream) {
    static int grid = 0;
    if (grid == 0) {
        if (n_in != N_IN || out_size != T * D || ws_size < WS_END + 63 * MiB) { fprintf(stderr, "kernel_launch: unexpected problem: n_in %d out %d ws %zu (need %zu)\n", n_in, out_size, ws_size, (size_t)(WS_END + 63 * MiB)); grid = -1; return; }
        int dev = 0, cus = 0, per_cu = 0;
        if (hipGetDevice(&dev) != hipSuccess || hipDeviceGetAttribute(&cus, hipDeviceAttributeMultiprocessorCount, dev) != hipSuccess) { grid = -1; return; }
        if (hipFuncSetAttribute((const void*)mega_fwd, hipFuncAttributeMaxDynamicSharedMemorySize, LDS_BYTES) != hipSuccess) { fprintf(stderr, "kernel_launch: hipFuncSetAttribute failed\n"); grid = -1; return; }
        if (hipOccupancyMaxActiveBlocksPerMultiprocessor(&per_cu, (const void*)mega_fwd, NTHREADS, LDS_BYTES) != hipSuccess || per_cu < 1) { fprintf(stderr, "kernel_launch: occupancy query says %d blocks per CU\n", per_cu); (void)hipGetLastError(); grid = -1; return; }
        grid = cus;
    }
    if (grid < 0) return;
    (void)hipMemsetAsync((char*)d_ws + WS_CTL, 0, CTL_ZERO_BYTES, stream);
    Args a{};
    for (int i = 0; i < N_IN; ++i) a.in[i] = (const float*)d_in[i];
    a.out = (float*)d_out; a.ws = (unsigned char*)d_ws;
#if MK_PER_PHASE
    for (int p = 0; p < N_PHASES - 1; ++p) { a.ph_lo = p; a.ph_hi = p + 1; hipLaunchKernelGGL(mega_fwd, dim3(grid), dim3(NTHREADS), LDS_BYTES, stream, a); }
#else
    a.ph_lo = 0; a.ph_hi = N_PHASES;
    void* kargs[] = {&a};
    hipError_t e = hipLaunchCooperativeKernel((const void*)mega_fwd, dim3(grid), dim3(NTHREADS), kargs, LDS_BYTES, stream);
    if (e != hipSuccess) fprintf(stderr, "kernel_launch: cooperative launch failed: %s (grid %d)\n", hipGetErrorString(e), grid);
#endif
}
```

```cpp
#include <hip/hip_runtime.h>
#include <hip/hip_cooperative_groups.h>
#include <cstdio>
#include <cstdint>
namespace cg = cooperative_groups;

#ifndef PROBE_MASK
#define PROBE_MASK 0
#endif
#ifndef DUP_MASK
#define DUP_MASK 0
#endif
#ifndef UBENCH
#define UBENCH 0
#endif
#ifndef GDN_DUP
#define GDN_DUP 0
#endif
#ifndef MK_PER_PHASE
#ifndef PEER_ALIAS
#define PEER_ALIAS 0
#endif
#ifndef EV_F8_T0
#define EV_F8_T0 0
#define EV_F8_T1 0
#endif
#define MK_PER_PHASE 0
#endif

namespace pg8 {
#define PG8_LAS __attribute__((address_space(3)))
typedef unsigned short bf16_t;
typedef short bf16x8 __attribute__((ext_vector_type(8)));
typedef float f32x4 __attribute__((ext_vector_type(4)));
typedef unsigned u32x4 __attribute__((ext_vector_type(4)));
typedef unsigned u32x2 __attribute__((ext_vector_type(2)));
constexpr int BM = 256, BK = 64, HALF = 128, HTB = HALF * BK * 2  , STAGE_BYTES = 8 * HTB, NXCD = 8, WGM = 8;

__host__ __device__ __forceinline__ int lds_byte(int r, int c) { const int st = (r >> 4) * 2 + (c >> 5), rr = r & 15, cc = c & 31, ob = rr * 64 + cc * 2; return st * 1024 + (ob ^ (((ob >> 9) & 1) << 5)); }
__host__ __device__ __forceinline__ void stage_rc(int b, int& R, int& C) { const int st = b / 1024, sb = b % 1024, swz = sb ^ (((sb >> 9) & 1) << 5); R = (st >> 1) * 16 + swz / 64; C = (st & 1) * 32 + (swz % 64) / 2; }
__host__ __device__ __forceinline__ int perm32(int rho) { const int n = rho >> 4, i = rho & 15; return 8 * (i >> 2) + 4 * n + (i & 3); }

struct Unit { int pm, pn; };
struct Gemm { const bf16_t* A; const bf16_t* Bt; int M, N, K; int KE = 0; };

struct StaticOrder {
    int nM, nN, nwg, G, c;
    __host__ __device__ void init(int M, int N, int G_, int c_) { nM = M / BM; nN = N / BM; nwg = nM * nN; G = G_; c = c_; }
    __host__ __device__ bool next(int i, Unit& u) const {
        const long L = (long)i * G + c; if (L >= nwg) return false;
        int wgid = (int)L; { const int q = nwg / NXCD, r = nwg % NXCD, xcd = wgid % NXCD, off = wgid / NXCD; wgid = (xcd < r ? xcd * (q + 1) : r * (q + 1) + (xcd - r) * q) + off; }
        const int nig = WGM * nN, gid = wgid / nig, fm = gid * WGM, gsz = (nM - fm) < WGM ? (nM - fm) : WGM;
        u.pm = fm + ((wgid % nig) % gsz); u.pn = (wgid % nig) / gsz; return true;
    }
    __device__ __forceinline__ void a_ready(const Unit&) const {}
    __device__ __forceinline__ void done(const Unit&) const {}
};
struct RowBlockOrder {
    int c, nN;
    __host__ __device__ bool next(int i, Unit& u) const { if (i >= nN) return false; u.pm = c; u.pn = i; return true; }
    __device__ __forceinline__ void a_ready(const Unit&) const {}
    __device__ __forceinline__ void done(const Unit&) const {}
};
__device__ __forceinline__ unsigned cvt_pk_bf16(float lo, float hi) { unsigned r; asm volatile("v_cvt_pk_bf16_f32 %0, %1, %2" : "=v"(r) : "v"(lo), "v"(hi)); return r; }
template <class Epi, class Sched, bool ALIGN_EPI = false, bool SP2 = false, bool F8 = false, bool I8 = false>
__device__ __forceinline__ void gemm_phase(PG8_LAS unsigned char* lds, const Gemm g, const Sched& S, const Epi& E, const int wave_id) {
    int tid; asm volatile("v_mbcnt_lo_u32_b32 %0, -1, 0\n\tv_mbcnt_hi_u32_b32 %0, -1, %0" : "=v"(tid)); tid += wave_id * 64;
    const int wid = wave_id, lane = tid & 63, wr = wid >> 2, wc = wid & 3, fr = lane & 15, fq = lane >> 4;
    const int K = g.K, nt = (g.KE ? g.KE : K) / BK;
    unsigned voffA[2], voffB[2];
#pragma unroll
    for (int i = 0; i < 2; ++i) { int R, C; stage_rc(tid * 16 + i * 8192, R, C); const int Rb = Epi::PERM ? ((R & ~31) + perm32(R & 31)) : R;
        voffA[i] = (unsigned)(R * K + C) * 2u; voffB[i] = (unsigned)(Rb * K + C) * 2u; }
    const __amdgpu_buffer_rsrc_t rsrcA = __builtin_amdgcn_make_buffer_rsrc((void*)g.A, 0, 0x7fffffff, 0x00020000), rsrcB = __builtin_amdgcn_make_buffer_rsrc((void*)g.Bt, 0, 0x7fffffff, 0x00020000);
    const size_t kstep = (size_t)(BK * 2);
    const size_t hstep = (size_t)HALF * K * 2;
    const size_t tstep = 2 * hstep;
    const unsigned ldsw = (unsigned)wid * 1024u;
    const int aoff = lds_byte(wr * 64 + fr, fq * 8), boff = lds_byte(wc * 32 + fr, fq * 8);
#define PG8_SA(b, h) (((b) * 2 + (h)) * HTB)
#define PG8_SB(b, h) ((4 + (b) * 2 + (h)) * HTB)
#define PG8_STAGE(bufoff, gbase, voff) do { const bool isA_ = (+(voff) == +voffA); const unsigned soff_ = (unsigned)((const char*)(gbase) - (isA_ ? (const char*)g.A : (const char*)g.Bt)); _Pragma("unroll") for (int _i = 0; _i < 2; ++_i) \
        __builtin_amdgcn_raw_ptr_buffer_load_lds(isA_ ? rsrcA : rsrcB, (PG8_LAS unsigned*)(lds + (bufoff) + ldsw + _i * 8192), 16, (int)(voff)[_i], (int)soff_, 0, 0); } while (0)
#define PG8_LDA(dst, b, h) do { _Pragma("unroll") for (int m = 0; m < 4; ++m) { if constexpr (F8) { dst##8[m].lo = *(const PG8_LAS bf16x8*)(lds + PG8_SA(b, h) + aoff + m * 2048); dst##8[m].hi = *(const PG8_LAS bf16x8*)(lds + PG8_SA(b, h) + aoff + m * 2048 + 1024); } else { _Pragma("unroll") for (int k = 0; k < 2; ++k) dst[m][k] = *(const PG8_LAS bf16x8*)(lds + PG8_SA(b, h) + aoff + m * 2048 + k * 1024); } } } while (0)
#define PG8_LDB(dst, b, h) do { _Pragma("unroll") for (int n = 0; n < 2; ++n) { if constexpr (F8) { dst##8[n].lo = *(const PG8_LAS bf16x8*)(lds + PG8_SB(b, h) + boff + n * 2048); dst##8[n].hi = *(const PG8_LAS bf16x8*)(lds + PG8_SB(b, h) + boff + n * 2048 + 1024); } else { _Pragma("unroll") for (int k = 0; k < 2; ++k) dst[n][k] = *(const PG8_LAS bf16x8*)(lds + PG8_SB(b, h) + boff + n * 2048 + k * 1024); } } } while (0)
#define PG8_MMA(ai, bj, At, Bt) do { __builtin_amdgcn_s_setprio(1); _Pragma("unroll") for (int m = 0; m < 4; ++m) _Pragma("unroll") for (int n = 0; n < 2; ++n) { \
        if constexpr (F8) { typedef int v8i_ __attribute__((ext_vector_type(8))); \
            acc[ai][bj][m][n] = __builtin_amdgcn_mfma_scale_f32_16x16x128_f8f6f4(__builtin_bit_cast(v8i_, Bt##8[n]), __builtin_bit_cast(v8i_, At##8[m]), acc[ai][bj][m][n], 0, 0, 0, 0x7f79, 1, 0x7f79); }     \
        else if constexpr (I8) { typedef int v4i_ __attribute__((ext_vector_type(4))); \
            _Pragma("unroll") for (int k = 0; k < 2; ++k) acc[ai][bj][m][n] = __builtin_bit_cast(f32x4, __builtin_amdgcn_mfma_i32_16x16x64_i8(__builtin_bit_cast(v4i_, Bt[n][k]), __builtin_bit_cast(v4i_, At[m][k]), __builtin_bit_cast(v4i_, acc[ai][bj][m][n]), 0, 0, 0)); } \
        else { _Pragma("unroll") for (int k = 0; k < 2; ++k) acc[ai][bj][m][n] = __builtin_amdgcn_mfma_f32_16x16x32_bf16(Bt[n][k], At[m][k], acc[ai][bj][m][n], 0, 0, 0); } } \
        __builtin_amdgcn_s_setprio(0); } while (0)
#define PG8_WAIT_V(n) asm volatile("s_waitcnt vmcnt(" #n ")" ::: "memory")
#define PG8_WAIT_L(n) asm volatile("s_waitcnt lgkmcnt(" #n ")" ::: "memory")
#define PG8_BAR __builtin_amdgcn_s_barrier()
#define PG8_SCHED __builtin_amdgcn_sched_barrier(0)
    Unit cur, nxt; int ui = 0;
    if (!S.next(0, cur)) return;
    f32x4 acc[2][2][4][2];
#pragma unroll
    for (int a = 0; a < 2; ++a)
#pragma unroll
        for (int b = 0; b < 2; ++b)
#pragma unroll
            for (int m = 0; m < 4; ++m)
#pragma unroll
                for (int n = 0; n < 2; ++n) acc[a][b][m][n] = (f32x4){0.f, 0.f, 0.f, 0.f};
    typedef short bf16x16 __attribute__((ext_vector_type(16)));
    bf16x16 At8[4], B08[2], B18[2]; bf16x8 At[4][2], B0[2][2], B1[2][2];
    const char* cA = (const char*)g.A + (size_t)cur.pm * tstep; const char* cB = (const char*)g.Bt + (size_t)cur.pn * tstep;
    S.a_ready(cur);
    if constexpr (SP2) {
        PG8_STAGE(PG8_SB(0, 0), cB, voffB); PG8_STAGE(PG8_SB(0, 1), cB + hstep, voffB); PG8_STAGE(PG8_SA(0, 0), cA, voffA); PG8_STAGE(PG8_SA(0, 1), cA + hstep, voffA);
        if (wr == 1) PG8_BAR;
        PG8_WAIT_V(2); PG8_BAR;
        PG8_STAGE(PG8_SB(1, 0), cB + kstep, voffB); PG8_STAGE(PG8_SA(1, 0), cA + kstep, voffA); PG8_STAGE(PG8_SB(1, 1), cB + hstep + kstep, voffB);
        PG8_WAIT_V(6); PG8_BAR;
    } else {
        PG8_STAGE(PG8_SB(0, 0), cB, voffB); PG8_STAGE(PG8_SA(0, 0), cA, voffA); PG8_STAGE(PG8_SB(0, 1), cB + hstep, voffB); PG8_STAGE(PG8_SA(0, 1), cA + hstep, voffA);
        if (wr == 1) PG8_BAR;
        PG8_WAIT_V(4); PG8_BAR;
        PG8_STAGE(PG8_SB(1, 0), cB + kstep, voffB); PG8_STAGE(PG8_SA(1, 0), cA + kstep, voffA); PG8_STAGE(PG8_SB(1, 1), cB + hstep + kstep, voffB);
        PG8_WAIT_V(6); PG8_BAR;
    }
    for (;;) {
        const bool has_next = S.next(ui + 1, nxt);
        const char* nA = has_next ? (const char*)g.A + (size_t)nxt.pm * tstep : cA; const char* nB = has_next ? (const char*)g.Bt + (size_t)nxt.pn * tstep : cB;
        for (int t = 0; t < nt; t += 2) {
            const bool last = (t == nt - 2);
            const char* a1 = cA + (size_t)(t + 1) * kstep;
            const char* a2 = last ? nA : cA + (size_t)(t + 2) * kstep; const char* b2 = last ? nB : cB + (size_t)(t + 2) * kstep;
            const char* a3 = a2 + kstep; const char* b3 = b2 + kstep;
            if (last && has_next) S.a_ready(nxt);
            if constexpr (SP2) {
            PG8_LDB(B0, 0, 0); PG8_LDB(B1, 0, 1); PG8_SCHED; PG8_LDA(At, 0, 0); PG8_STAGE(PG8_SA(1, 1), a1 + hstep, voffA);
            PG8_WAIT_V(8); PG8_WAIT_L(0); PG8_BAR; PG8_MMA(0, 0, At, B0); PG8_MMA(0, 1, At, B1); PG8_BAR; PG8_SCHED;
            PG8_LDA(At, 0, 1); PG8_STAGE(PG8_SB(0, 0), b2, voffB); PG8_STAGE(PG8_SB(0, 1), b2 + hstep, voffB); PG8_STAGE(PG8_SA(0, 0), a2, voffA);
            PG8_WAIT_V(8); PG8_WAIT_L(0); PG8_BAR; PG8_MMA(1, 0, At, B0); PG8_MMA(1, 1, At, B1); PG8_BAR; PG8_SCHED;
            PG8_LDB(B0, 1, 0); PG8_LDB(B1, 1, 1); PG8_SCHED; PG8_LDA(At, 1, 0); PG8_STAGE(PG8_SA(0, 1), a2 + hstep, voffA);
            PG8_WAIT_V(8); PG8_WAIT_L(0); PG8_BAR; PG8_MMA(0, 0, At, B0); PG8_MMA(0, 1, At, B1); PG8_BAR; PG8_SCHED;
            PG8_LDA(At, 1, 1); PG8_STAGE(PG8_SB(1, 0), b3, voffB); PG8_STAGE(PG8_SB(1, 1), b3 + hstep, voffB); PG8_STAGE(PG8_SA(1, 0), a3, voffA);
            PG8_WAIT_V(8); PG8_WAIT_L(0); PG8_BAR; PG8_MMA(1, 0, At, B0); PG8_MMA(1, 1, At, B1); PG8_BAR; PG8_SCHED;
            } else {
            PG8_LDB(B0, 0, 0); PG8_SCHED; PG8_LDA(At, 0, 0); PG8_STAGE(PG8_SA(1, 1), a1 + hstep, voffA);
            PG8_WAIT_L(8); PG8_BAR; PG8_WAIT_L(0); PG8_MMA(0, 0, At, B0); PG8_BAR; PG8_SCHED;
            PG8_LDB(B1, 0, 1); PG8_STAGE(PG8_SB(0, 0), b2, voffB);
            PG8_BAR; PG8_WAIT_L(0); PG8_MMA(0, 1, At, B1); PG8_BAR;
            PG8_LDA(At, 0, 1); PG8_STAGE(PG8_SA(0, 0), a2, voffA);
            PG8_BAR; PG8_WAIT_L(0); PG8_MMA(1, 0, At, B0); PG8_BAR; PG8_SCHED;
            PG8_STAGE(PG8_SB(0, 1), b2 + hstep, voffB);
            PG8_WAIT_V(6); PG8_BAR; PG8_MMA(1, 1, At, B1); PG8_BAR;
            PG8_LDB(B0, 1, 0); PG8_SCHED; PG8_LDA(At, 1, 0); PG8_STAGE(PG8_SA(0, 1), a2 + hstep, voffA);
            PG8_WAIT_L(8); PG8_BAR; PG8_WAIT_L(0); PG8_MMA(0, 0, At, B0); PG8_BAR; PG8_SCHED;
            PG8_LDB(B1, 1, 1); PG8_STAGE(PG8_SB(1, 0), b3, voffB);
            PG8_BAR; PG8_WAIT_L(0); PG8_MMA(0, 1, At, B1); PG8_BAR;
            PG8_LDA(At, 1, 1); PG8_STAGE(PG8_SA(1, 0), a3, voffA);
            PG8_BAR; PG8_WAIT_L(0); PG8_MMA(1, 0, At, B0); PG8_BAR; PG8_SCHED;
            PG8_STAGE(PG8_SB(1, 1), b3 + hstep, voffB);
            PG8_WAIT_V(6); PG8_BAR; PG8_MMA(1, 1, At, B1); PG8_BAR;
            }
        }
        if constexpr (ALIGN_EPI) { if (wr == 0) PG8_BAR; }
        if constexpr (!Epi::AFTER_DRAIN) { int ln_e; asm volatile("v_mbcnt_lo_u32_b32 %0, -1, 0\n\tv_mbcnt_hi_u32_b32 %0, -1, %0" : "=v"(ln_e)); const int fr_e = ln_e & 15, fq_e = ln_e >> 4;
            E(acc, cur, wr, wc, fr_e, fq_e); S.done(cur); }
        if (!has_next) break;
#pragma unroll
        for (int a = 0; a < 2; ++a)
#pragma unroll
            for (int b = 0; b < 2; ++b)
#pragma unroll
                for (int m = 0; m < 4; ++m)
#pragma unroll
                    for (int n = 0; n < 2; ++n) acc[a][b][m][n] = (f32x4){0.f, 0.f, 0.f, 0.f};
        cur = nxt; cA = nA; cB = nB; ++ui;
        if constexpr (ALIGN_EPI) { if (wr == 1) PG8_BAR; }
    }
    PG8_WAIT_V(0);
    if constexpr (!ALIGN_EPI) { if (wr == 0) PG8_BAR; }
    PG8_BAR;
    if constexpr (Epi::AFTER_DRAIN) { E.fused(acc, cur, wr, wc, fr, fq, lds, wid, lane); S.done(cur); }
#undef PG8_SA
#undef PG8_SB
#undef PG8_STAGE
#undef PG8_LDA
#undef PG8_LDB
#undef PG8_MMA
#undef PG8_WAIT_V
#undef PG8_WAIT_L
#undef PG8_BAR
#undef PG8_SCHED
}
}
#define GAS __attribute__((address_space(1)))
#define LAS __attribute__((address_space(3)))
typedef unsigned short bf16;
typedef unsigned v4u __attribute__((ext_vector_type(4)));
typedef float f32x4 __attribute__((ext_vector_type(4)));
typedef short bf16x8 __attribute__((ext_vector_type(8)));
typedef GAS unsigned gu32;
typedef GAS unsigned long long gu64;
#define RLX_AGENT __ATOMIC_RELAXED, __HIP_MEMORY_SCOPE_AGENT
#define LDS_WAIT() asm volatile("s_waitcnt lgkmcnt(0)" ::: "memory")
#define VM_WAIT() asm volatile("s_waitcnt vmcnt(0)" ::: "memory")
__device__ __forceinline__ unsigned long long rt() { return __builtin_amdgcn_s_memrealtime(); }
__device__ __forceinline__ unsigned f2bf(float f) { unsigned u = __builtin_bit_cast(unsigned, f); return (u + 0x7fffu + ((u >> 16) & 1u)) >> 16; }
__device__ __forceinline__ unsigned pk2(float lo, float hi) { return f2bf(lo) | (f2bf(hi) << 16); }

#define XB_TMO      128
#define XB_XCNT(j)  (256  + 64 * (j))
#define XB_XSUB(j)  (1280 + 64 * (j))
#define XB_XGEN(j)  (2304 + 64 * (j))
#define XB_TOP      3328
#define XB_TOPGEN   3392
#define XCD_BAR_WORDS 3456
#define XB_SPIN_CAP (1u << 18)

__device__ __forceinline__ unsigned xb_ld(unsigned* p)              { return __hip_atomic_load(p, __ATOMIC_RELAXED, __HIP_MEMORY_SCOPE_AGENT); }
__device__ __forceinline__ unsigned xb_add(unsigned* p, unsigned v) { return __hip_atomic_fetch_add(p, v, __ATOMIC_RELAXED, __HIP_MEMORY_SCOPE_AGENT); }
__device__ __forceinline__ unsigned xb_xcc_id() { return (unsigned)__builtin_amdgcn_s_getreg((3 << 11) | 20) & 0xFu; }
#define XB_SPIN(cond, bar) do { unsigned _sp = 0; while (cond) { __builtin_amdgcn_s_sleep(1); \
    if ((++_sp & 255u) == 0u) { if (xb_ld(&(bar)[XB_TMO])) break; if (_sp > XB_SPIN_CAP) { atomicAdd(&(bar)[XB_TMO], 1u); break; } } } } while (0)

struct XcdBarrier {
    unsigned* bar; unsigned x; bool wave0;
    volatile LAS unsigned* st;
};

__device__ __forceinline__ XcdBarrier xcd_barrier_post(unsigned* bar, volatile LAS unsigned* st) {
    XcdBarrier b; b.bar = bar; b.x = xb_xcc_id(); b.st = st;
    if (threadIdx.x == 0) (void)xb_add(&bar[XB_XCNT(b.x)], 1u);
    return b;
}
__device__ __forceinline__ void xcd_barrier_complete(unsigned* bar, unsigned x, unsigned& nloc, unsigned& nx) {
    const unsigned G = gridDim.x * gridDim.y * gridDim.z;
    unsigned sum, cnt, mine, sp = 0u;
    for (;;) {
        sum = 0u; cnt = 0u; mine = 0u;
#pragma unroll
        for (unsigned j = 0; j < 16; ++j) { const unsigned c = xb_ld(&bar[XB_XCNT(j)]); sum += c; cnt += (c > 0u) ? 1u : 0u; mine = (j == x) ? c : mine; }
        if (sum == G) break;
        __builtin_amdgcn_s_sleep(1);
        if ((++sp & 255u) == 0u) { if (xb_ld(&bar[XB_TMO])) break; if (sp > XB_SPIN_CAP) { atomicAdd(&bar[XB_TMO], 1u); break; } }
    }
    nloc = mine > 0u ? mine : 1u; nx = cnt > 0u ? cnt : 1u;
}

__device__ __forceinline__ void xcd_barrier(const XcdBarrier& b) {
    asm volatile("s_waitcnt vmcnt(0)" ::: "memory");
    __syncthreads();
    if (b.wave0 && __builtin_amdgcn_mbcnt_hi(~0u, __builtin_amdgcn_mbcnt_lo(~0u, 0u)) == 0u) {
        unsigned* bar = b.bar;
        __builtin_amdgcn_s_waitcnt(0);
        unsigned nloc = b.st[0], nx = b.st[1];
        if (nloc == 0u) { xcd_barrier_complete(bar, b.x, nloc, nx); b.st[0] = nloc; b.st[1] = nx; }
        const unsigned old = xb_add(&bar[XB_XSUB(b.x)], 1u);
        const unsigned gen = old / nloc;
        if (old + 1u == (gen + 1u) * nloc) {
            __builtin_amdgcn_fence(__ATOMIC_RELEASE, "agent");
            asm volatile("s_waitcnt vmcnt(0)" ::: "memory");
            const unsigned og = xb_add(&bar[XB_TOP], 1u);
            const unsigned tg = og / nx;
            if (og + 1u == (tg + 1u) * nx) xb_add(&bar[XB_TOPGEN], 1u);
            else XB_SPIN(xb_ld(&bar[XB_TOPGEN]) == tg, bar);
            __builtin_amdgcn_fence(__ATOMIC_ACQUIRE, "agent");
            xb_add(&bar[XB_XGEN(b.x)], 1u);
            asm volatile("s_waitcnt vmcnt(0)" ::: "memory");
        } else {
            XB_SPIN(xb_ld(&bar[XB_XGEN(b.x)]) == gen, bar);
            __builtin_amdgcn_fence(__ATOMIC_ACQUIRE, "agent");
            asm volatile("s_waitcnt vmcnt(0)" ::: "memory");
        }
    }
    __syncthreads();
}

constexpr int NWAVES = 8, NTHREADS = NWAVES * 64;
constexpr int BATCH = 8, SEQ = 2048, T = BATCH * SEQ, D = 2048;
constexpr int EV_N = 7200, EV_NP = 7424, OD_N = 7616, OD_NP = 7680, PROJ_LD = 7680;
constexpr float EPS = 1e-6f;
constexpr int EC_GQ = 0, EC_GK = 512, EC_GV = 1024, EC_GZ = 2048, EC_GLR = 3072, EC_BQ = 3088, EC_BK = 4112, EC_BV = 5136, EC_BZ = 6160, EC_BA = 7184, EC_BB = 7192;
constexpr int OC_HQ = 0, OC_HF = 1024, OC_HI = 2048, OC_HG = 3072, OC_RW = 4096;
constexpr int RW_R = 0, RW_K = 1024, RW_V = 2048, RW_WL = 3072, RW_AL = 3168, RW_GL = 3264;
constexpr int LORA_K = 512, LORA_N = 3072;
enum { I_X = 0, I_P, I_EV_WIN, I_GK_W2, I_GK_B, I_GLA_NORM, I_GDN_CONV, I_GDN_ALOG, I_GDN_DTB, I_GDN_NORM, I_EV_WOUT, I_OD_WIN, I_LB, I_HG_NORM,
       I_MU, I_W0, I_W2, I_A0, I_A2, I_G2, I_KK, I_KA, I_RK, I_LNW, I_LNB, I_OD_WOUT, I_NMIX, I_NFFN, I_NPLE, I_PEER_WQ, I_PEER_SK, I_PEER_U, I_PEER_V,
       I_PLE_WP, I_PLE_WG, I_NFINAL, N_IN };

constexpr size_t MiB = 1u << 20;
constexpr size_t WS_CTL = 0, CTL_ZERO_BYTES = 1 * MiB, WS_SU = 256 * 1024, WS_CMB = 512 * 1024, WS_SA = 576 * 1024;
constexpr size_t WS_WEV_IN = 1 * MiB, WS_WEV_OUT = 30 * MiB, WS_WOD_IN = 38 * MiB, WS_WOD_OUT = 68 * MiB, WS_WPEER = 76 * MiB, WS_WGATE = 92 * MiB, WS_WPROJ = 108 * MiB,
                 WS_WLORA = 110 * MiB, WS_PBF = 113 * MiB, WS_TABU = 129 * MiB, WS_TABV = 193 * MiB, WS_ACTA = 257 * MiB, WS_ACTB = 321 * MiB, WS_PROJ = 385 * MiB, WS_SC = 385 * MiB,
                 WS_O = 625 * MiB, WS_H1 = 689 * MiB, WS_PP = 753 * MiB, WS_LA = 817 * MiB, WS_LO = 833 * MiB, WS_RSP = 929 * MiB, WS_STATE = 937 * MiB, WS_RS3 = 945 * MiB, WS_END = 946 * MiB;
static_assert(WS_WEV_IN + (size_t)EV_NP * D * 2 <= WS_WEV_OUT && WS_WOD_IN + (size_t)OD_NP * D * 2 <= WS_WOD_OUT && WS_PROJ + (size_t)T * PROJ_LD * 2 <= WS_O, "ws map");
constexpr int CW_BAR = 4096;
enum { RS_FFN0 = 0, RS_MIX1 = 1, RS_FFN1 = 2, RS_FINAL = 3 };
constexpr int RING_OFF = 0, RING_BYTES = 131072;
constexpr int LDSCTL_OFF = RING_BYTES, MISC_OFF = LDSCTL_OFF + 320;
constexpr int LDS_BYTES = 147456;

struct Args { const float* in[N_IN]; float* out; unsigned char* ws; int ph_lo, ph_hi; };
struct Frame {
    LAS unsigned char* lds; volatile LAS unsigned* MISC; gu32* ctl;
    int tid, lane, wave, vcu, G;
};
__device__ __forceinline__ float wave_sum(float v) {
#pragma unroll
    for (int o = 1; o < 64; o <<= 1) v += __shfl_xor(v, o);
    return v;
}
__device__ __forceinline__ float half_sum32(float v) {
#pragma unroll
    for (int o = 1; o < 32; o <<= 1) v += __shfl_xor(v, o);
    return v;
}
#define DPP_ADD(v, ctrl) (v) += __builtin_bit_cast(float, __builtin_amdgcn_update_dpp(0, __builtin_bit_cast(int, (v)), (ctrl), 0xF, 0xF, false))
__device__ __forceinline__ float row_sum16(float v) {
    DPP_ADD(v, 0x128); DPP_ADD(v, 0x124); DPP_ADD(v, 0x122); DPP_ADD(v, 0x121);
    return v;
}
__device__ __forceinline__ void row_sum16_x4(float& a, float& b, float& c, float& d) {
    asm("s_nop 1\n\t"
        "v_add_f32_dpp %0, %0, %0 row_ror:8 row_mask:0xf bank_mask:0xf\n\tv_add_f32_dpp %1, %1, %1 row_ror:8 row_mask:0xf bank_mask:0xf\n\t"
        "v_add_f32_dpp %2, %2, %2 row_ror:8 row_mask:0xf bank_mask:0xf\n\tv_add_f32_dpp %3, %3, %3 row_ror:8 row_mask:0xf bank_mask:0xf\n\t"
        "v_add_f32_dpp %0, %0, %0 row_ror:4 row_mask:0xf bank_mask:0xf\n\tv_add_f32_dpp %1, %1, %1 row_ror:4 row_mask:0xf bank_mask:0xf\n\t"
        "v_add_f32_dpp %2, %2, %2 row_ror:4 row_mask:0xf bank_mask:0xf\n\tv_add_f32_dpp %3, %3, %3 row_ror:4 row_mask:0xf bank_mask:0xf\n\t"
        "v_add_f32_dpp %0, %0, %0 row_ror:2 row_mask:0xf bank_mask:0xf\n\tv_add_f32_dpp %1, %1, %1 row_ror:2 row_mask:0xf bank_mask:0xf\n\t"
        "v_add_f32_dpp %2, %2, %2 row_ror:2 row_mask:0xf bank_mask:0xf\n\tv_add_f32_dpp %3, %3, %3 row_ror:2 row_mask:0xf bank_mask:0xf\n\t"
        "v_add_f32_dpp %0, %0, %0 row_ror:1 row_mask:0xf bank_mask:0xf\n\tv_add_f32_dpp %1, %1, %1 row_ror:1 row_mask:0xf bank_mask:0xf\n\t"
        "v_add_f32_dpp %2, %2, %2 row_ror:1 row_mask:0xf bank_mask:0xf\n\tv_add_f32_dpp %3, %3, %3 row_ror:1 row_mask:0xf bank_mask:0xf\n\t"
        "s_nop 1"
        : "+v"(a), "+v"(b), "+v"(c), "+v"(d));
}
__device__ __forceinline__ void row_sum16_x2(float& a, float& b) {
    asm("s_nop 1\n\t"
        "v_add_f32_dpp %0, %0, %0 row_ror:8 row_mask:0xf bank_mask:0xf\n\tv_add_f32_dpp %1, %1, %1 row_ror:8 row_mask:0xf bank_mask:0xf\n\ts_nop 1\n\t"
        "v_add_f32_dpp %0, %0, %0 row_ror:4 row_mask:0xf bank_mask:0xf\n\tv_add_f32_dpp %1, %1, %1 row_ror:4 row_mask:0xf bank_mask:0xf\n\ts_nop 1\n\t"
        "v_add_f32_dpp %0, %0, %0 row_ror:2 row_mask:0xf bank_mask:0xf\n\tv_add_f32_dpp %1, %1, %1 row_ror:2 row_mask:0xf bank_mask:0xf\n\ts_nop 1\n\t"
        "v_add_f32_dpp %0, %0, %0 row_ror:1 row_mask:0xf bank_mask:0xf\n\tv_add_f32_dpp %1, %1, %1 row_ror:1 row_mask:0xf bank_mask:0xf\n\t"
        "s_nop 1"
        : "+v"(a), "+v"(b));
}
typedef unsigned u32x2 __attribute__((ext_vector_type(2)));
__device__ __forceinline__ void st_wt16(void* p, v4u v) { asm volatile("global_store_dwordx4 %0, %1, off sc1\n\ts_nop 1" :: "v"(p), "v"(v) : "memory"); }
__device__ __forceinline__ void st_wt8(void* p, u32x2 v) { asm volatile("global_store_dwordx2 %0, %1, off sc1\n\ts_nop 1" :: "v"(p), "v"(v) : "memory"); }
#define LBAR() do { asm volatile("s_waitcnt lgkmcnt(0)" ::: "memory"); __builtin_amdgcn_s_barrier(); asm volatile("" ::: "memory"); } while (0)
typedef float f32x2 __attribute__((ext_vector_type(2)));
typedef __bf16 hwbf16x2_t __attribute__((ext_vector_type(2)));
__device__ __forceinline__ unsigned hw_pk2(float lo, float hi) { const f32x2 v = {lo, hi}; return __builtin_bit_cast(unsigned, __builtin_convertvector(v, hwbf16x2_t)); }
__device__ __forceinline__ bf16 hw_bf(float x) { return (bf16)hw_pk2(x, 0.f); }
__device__ __forceinline__ float bf_lo(unsigned w) { return __uint_as_float(w << 16); }
__device__ __forceinline__ float bf_hi(unsigned w) { return __uint_as_float(w & 0xffff0000u); }
__device__ __forceinline__ float sigmoidf_(float x) { return __builtin_amdgcn_rcpf(1.0f + __expf(-x)); }
__device__ __forceinline__ float siluf_(float x) { return x * __builtin_amdgcn_rcpf(1.0f + __expf(-x)); }
__device__ __forceinline__ float softplusf_(float x) { return fmaxf(x, 0.f) + log1pf(__expf(-fabsf(x))); }
__device__ __forceinline__ float logsigmoidf_(float x) { return fminf(x, 0.f) - log1pf(__expf(-fabsf(x))); }

struct EpiBf16S {
    static constexpr bool PERM = true, AFTER_DRAIN = false;
    bf16* O; int ldc; const float* rowss;
    __device__ __forceinline__ void operator()(const pg8::f32x4 (&acc)[2][2][4][2], const pg8::Unit& u, int wr, int wc, int fr, int fq) const {
        const int row0 = u.pm * 256 + wr * 64 + fr, col0 = u.pn * 256 + wc * 32 + 8 * fq;
#pragma unroll
        for (int ai = 0; ai < 2; ++ai)
#pragma unroll
            for (int m = 0; m < 4; ++m) {
                const int row = row0 + ai * 128 + m * 16;
                float sc = 1.f;
                if (rowss) { const pg8::f32x4* rp = (const pg8::f32x4*)(rowss + (size_t)row * 32 + 8 * fq); const pg8::f32x4 p0 = rp[0], p1 = rp[1];
                    float s = ((p0[0] + p0[1]) + (p0[2] + p0[3])) + ((p1[0] + p1[1]) + (p1[2] + p1[3])); s += __shfl_xor(s, 16); s += __shfl_xor(s, 32);
                    sc = __builtin_amdgcn_rsqf(s * (1.0f / D) + EPS); }
                bf16* rowp = O + (size_t)row * ldc + col0;
#pragma unroll
                for (int bj = 0; bj < 2; ++bj) { const pg8::f32x4 v0 = acc[ai][bj][m][0] * sc, v1 = acc[ai][bj][m][1] * sc;
                    pg8::u32x4 w; w.x = pg8::cvt_pk_bf16(v0[0], v0[1]); w.y = pg8::cvt_pk_bf16(v0[2], v0[3]); w.z = pg8::cvt_pk_bf16(v1[0], v1[1]); w.w = pg8::cvt_pk_bf16(v1[2], v1[3]);
                    *(pg8::u32x4*)(rowp + bj * 128) = w; } }
    }
};
struct EpiI8S {
    static constexpr bool PERM = true, AFTER_DRAIN = false;
    bf16* O; int ldc; const float* sa; const float* cb;
    __device__ __forceinline__ void operator()(const pg8::f32x4 (&acc)[2][2][4][2], const pg8::Unit& u, int wr, int wc, int fr, int fq) const {
        const int row0 = u.pm * 256 + wr * 64 + fr, col0 = u.pn * 256 + wc * 32 + 8 * fq;
        pg8::f32x4 cs[2][2];
#pragma unroll
        for (int bj = 0; bj < 2; ++bj) { cs[bj][0] = *(const pg8::f32x4*)(cb + col0 + bj * 128); cs[bj][1] = *(const pg8::f32x4*)(cb + col0 + bj * 128 + 4); }
#pragma unroll
        for (int ai = 0; ai < 2; ++ai)
#pragma unroll
            for (int m = 0; m < 4; ++m) {
                const int row = row0 + ai * 128 + m * 16;
                const float sc = sa[row];
                bf16* rowp = O + (size_t)row * ldc + col0;
#pragma unroll
                for (int bj = 0; bj < 2; ++bj) { pg8::f32x4 v0, v1;
#pragma unroll
                    for (int e = 0; e < 4; ++e) { v0[e] = (float)__float_as_int(acc[ai][bj][m][0][e]) * sc * cs[bj][0][e]; v1[e] = (float)__float_as_int(acc[ai][bj][m][1][e]) * sc * cs[bj][1][e]; }
                    pg8::u32x4 w; w.x = pg8::cvt_pk_bf16(v0[0], v0[1]); w.y = pg8::cvt_pk_bf16(v0[2], v0[3]); w.z = pg8::cvt_pk_bf16(v1[0], v1[1]); w.w = pg8::cvt_pk_bf16(v1[2], v1[3]);
                    *(pg8::u32x4*)(rowp + bj * 128) = w; } }
    }
};
template <bool GATE, bool HIN_F32, bool I8 = false> struct EpiResid {
    static constexpr bool PERM = false, AFTER_DRAIN = false;
    const void* hin; bf16* hout; float* rowss; const bf16* pp; const float* rs3; unsigned char* h8; const float* sa; const float* cb;
    __device__ __forceinline__ void operator()(const pg8::f32x4 (&acc)[2][2][4][2], const pg8::Unit& u, int wr, int wc, int fr, int fq) const {
        const int row0 = u.pm * 256 + wr * 64 + fr, col0 = u.pn * 256 + wc * 32 + 4 * fq;
        pg8::f32x4 cs[2][2];
        if constexpr (I8) {
#pragma unroll
            for (int bj = 0; bj < 2; ++bj)
#pragma unroll
                for (int n = 0; n < 2; ++n) cs[bj][n] = *(const pg8::f32x4*)(cb + col0 + bj * 128 + n * 16); }
        constexpr int MG = HIN_F32 ? 2 : 4;
#pragma unroll
        for (int ai = 0; ai < 2; ++ai)
#pragma unroll
            for (int m0 = 0; m0 < 4; m0 += MG) {
                pg8::f32x4 hf[MG][2][2]; pg8::u32x2 hb[MG][2][2], pw[MG][2][2]; float rsc[MG];
#pragma unroll
                for (int mm = 0; mm < MG; ++mm) { const int row = row0 + ai * 128 + (m0 + mm) * 16; const size_t off = (size_t)row * D + col0; rsc[mm] = GATE ? rs3[row] : (I8 ? sa[row] : 1.f);
#pragma unroll
                    for (int bj = 0; bj < 2; ++bj)
#pragma unroll
                        for (int n = 0; n < 2; ++n) { const size_t o = off + bj * 128 + n * 16;
                            if (HIN_F32) hf[mm][bj][n] = *(const pg8::f32x4*)((const float*)hin + o); else hb[mm][bj][n] = *(const pg8::u32x2*)((const bf16*)hin + o);
                            if (GATE) pw[mm][bj][n] = *(const pg8::u32x2*)(pp + o); } }
#pragma unroll
                for (int mm = 0; mm < MG; ++mm) { const int m = m0 + mm; const int row = row0 + ai * 128 + m * 16; const size_t off = (size_t)row * D + col0; float ss = 0.f;
#pragma unroll
                    for (int bj = 0; bj < 2; ++bj)
#pragma unroll
                        for (int n = 0; n < 2; ++n) { const size_t o = off + bj * 128 + n * 16;
                            pg8::f32x4 hv;
                            if (HIN_F32) hv = hf[mm][bj][n];
                            else { const pg8::u32x2 hw = hb[mm][bj][n]; hv[0] = bf_lo(hw.x); hv[1] = bf_hi(hw.x); hv[2] = bf_lo(hw.y); hv[3] = bf_hi(hw.y); }
                            pg8::f32x4 a = acc[ai][bj][m][n];
                            if constexpr (I8 && !GATE) { const float sr_ = rsc[mm];
#pragma unroll
                                for (int e = 0; e < 4; ++e) a[e] = (float)__float_as_int(a[e]) * sr_ * cs[bj][n][e]; }
                            if (GATE) { const pg8::u32x2 p2 = pw[mm][bj][n]; const float rs_ = rsc[mm];
                                a[0] = sigmoidf_(a[0] * rs_) * bf_lo(p2.x); a[1] = sigmoidf_(a[1] * rs_) * bf_hi(p2.x); a[2] = sigmoidf_(a[2] * rs_) * bf_lo(p2.y); a[3] = sigmoidf_(a[3] * rs_) * bf_hi(p2.y); }
                            hv = hv + a;
                            pg8::u32x2 w; w.x = hw_pk2(hv[0], hv[1]); w.y = hw_pk2(hv[2], hv[3]); *(pg8::u32x2*)(hout + o) = w;
                            if (h8) { int x8 = __builtin_amdgcn_cvt_pk_fp8_f32(hv[0], hv[1], 0, false); x8 = __builtin_amdgcn_cvt_pk_fp8_f32(hv[2], hv[3], x8, true); *(unsigned*)(h8 + o) = (unsigned)x8; }
                            const float q0 = bf_lo(w.x), q1 = bf_hi(w.x), q2 = bf_lo(w.y), q3 = bf_hi(w.y);
                            ss += (q0 * q0 + q1 * q1) + (q2 * q2 + q3 * q3); }
                    ss += __shfl_xor(ss, 16); ss += __shfl_xor(ss, 32);
                    if (fq == 0) rowss[(size_t)row * 32 + u.pn * 4 + wc] = ss; }
                asm volatile("" ::: "memory"); }
    }
};


__device__ __forceinline__ void p0_transpose_item(const float* W, int K, int N, bf16* WT, LAS float* scr, int item, int lane, const float* kgain = nullptr) {
    const int nblk = N / 32, kb = item / nblk, nb = item % nblk, k0 = 64 * kb, n0 = 32 * nb;
    { const GAS float* Wg = (const GAS float*)W + (size_t)(k0 + (lane >> 5)) * N + n0 + (lane & 31); float v[32];
#pragma unroll
      for (int i = 0; i < 32; ++i) v[i] = Wg[(size_t)(2 * i) * N];
#pragma unroll
      for (int i = 0; i < 32; ++i) scr[(2 * i + (lane >> 5)) * 33 + (lane & 31)] = v[i]; }
    LDS_WAIT(); asm volatile("" ::: "memory");
    const int c = lane & 7;
#pragma unroll
    for (int j = 0; j < 4; ++j) { const int n = (lane >> 3) + 8 * j; const LAS float* s = scr + (8 * c) * 33 + n;
        f32x4 g0 = {1.f, 1.f, 1.f, 1.f}, g1 = g0; if (kgain) { g0 = *(const GAS f32x4*)(kgain + k0 + 8 * c); g1 = *(const GAS f32x4*)(kgain + k0 + 8 * c + 4); }
        v4u o; o.x = pk2(s[0 * 33] * g0[0], s[1 * 33] * g0[1]); o.y = pk2(s[2 * 33] * g0[2], s[3 * 33] * g0[3]); o.z = pk2(s[4 * 33] * g1[0], s[5 * 33] * g1[1]); o.w = pk2(s[6 * 33] * g1[2], s[7 * 33] * g1[3]);
        *(GAS v4u*)(WT + (size_t)(n0 + n) * K + k0 + 8 * c) = o; }
    LDS_WAIT(); asm volatile("" ::: "memory");
}
__device__ __forceinline__ void p0_transpose_item_i8(const float* W, int K, int N, unsigned char* WT, LAS float* scr, int item, int lane, const float* cm) {
    const int nblk = N / 32, kb = item / nblk, nb = item % nblk, k0 = 64 * kb, n0 = 32 * nb;
    { const GAS float* Wg = (const GAS float*)W + (size_t)(k0 + (lane >> 5)) * N + n0 + (lane & 31); float v[32];
#pragma unroll
      for (int i = 0; i < 32; ++i) v[i] = Wg[(size_t)(2 * i) * N];
#pragma unroll
      for (int i = 0; i < 32; ++i) scr[(2 * i + (lane >> 5)) * 33 + (lane & 31)] = v[i]; }
    LDS_WAIT(); asm volatile("" ::: "memory");
    const int c = lane & 7;
#pragma unroll
    for (int j = 0; j < 4; ++j) { const int n = (lane >> 3) + 8 * j; const LAS float* s = scr + (8 * c) * 33 + n;
        const float mx = __uint_as_float(__hip_atomic_load((const unsigned*)cm + n0 + n, __ATOMIC_RELAXED, __HIP_MEMORY_SCOPE_AGENT)), inv = mx > 0.f ? 127.0f / mx : 0.f; unsigned w0 = 0, w1 = 0;
#pragma unroll
        for (int e = 0; e < 4; ++e) { w0 |= (__float_as_uint(__builtin_fmaf(s[e * 33], inv, 12582912.0f)) & 255u) << (8 * e); w1 |= (__float_as_uint(__builtin_fmaf(s[(4 + e) * 33], inv, 12582912.0f)) & 255u) << (8 * e); }
        u32x2 o; o.x = w0; o.y = w1;
        *(GAS u32x2*)(WT + (size_t)(n0 + n) * K + k0 + 8 * c) = o; }
    LDS_WAIT(); asm volatile("" ::: "memory");
}
__device__ __forceinline__ void colmax_item(const float* W, int K, int N, float* cm, int item, int lane) {
    const int ngrp = (N + 255) / 256, kb = item / ngrp, cg_ = item % ngrp, col = 256 * cg_ + 4 * lane;
    if (col >= N) return;
    const GAS f32x4* p = (const GAS f32x4*)((const GAS float*)W + (size_t)(64 * kb) * N + col); f32x4 m = {0.f, 0.f, 0.f, 0.f};
#pragma unroll 16
    for (int r = 0; r < 64; ++r) { const f32x4 v = *(const GAS f32x4*)((const GAS float*)p + (size_t)r * N);
#pragma unroll
        for (int e = 0; e < 4; ++e) m[e] = fmaxf(m[e], fabsf(v[e])); }
#pragma unroll
    for (int e = 0; e < 4; ++e) __hip_atomic_fetch_max((unsigned*)cm + col + e, __float_as_uint(m[e]), __ATOMIC_RELAXED, __HIP_MEMORY_SCOPE_AGENT);
}
__device__ __forceinline__ void p0_transpose_item_f8(const float* W, int K, int N, unsigned char* WT, LAS float* scr, int item, int lane, const float* kgain = nullptr) {
    const int nblk = N / 32, kb = item / nblk, nb = item % nblk, k0 = 64 * kb, n0 = 32 * nb;
    { const GAS float* Wg = (const GAS float*)W + (size_t)(k0 + (lane >> 5)) * N + n0 + (lane & 31); float v[32];
#pragma unroll
      for (int i = 0; i < 32; ++i) v[i] = Wg[(size_t)(2 * i) * N];
#pragma unroll
      for (int i = 0; i < 32; ++i) scr[(2 * i + (lane >> 5)) * 33 + (lane & 31)] = v[i]; }
    LDS_WAIT(); asm volatile("" ::: "memory");
    const int c = lane & 7;
#pragma unroll
    for (int j = 0; j < 4; ++j) { const int n = (lane >> 3) + 8 * j; const LAS float* s = scr + (8 * c) * 33 + n;
        f32x4 g0 = {64.f, 64.f, 64.f, 64.f}, g1 = g0; if (kgain) { g0 = g0 * *(const GAS f32x4*)(kgain + k0 + 8 * c); g1 = g1 * *(const GAS f32x4*)(kgain + k0 + 8 * c + 4); }
        int x0 = __builtin_amdgcn_cvt_pk_fp8_f32(s[0 * 33] * g0[0], s[1 * 33] * g0[1], 0, false); x0 = __builtin_amdgcn_cvt_pk_fp8_f32(s[2 * 33] * g0[2], s[3 * 33] * g0[3], x0, true);
        int x1 = __builtin_amdgcn_cvt_pk_fp8_f32(s[4 * 33] * g1[0], s[5 * 33] * g1[1], 0, false); x1 = __builtin_amdgcn_cvt_pk_fp8_f32(s[6 * 33] * g1[2], s[7 * 33] * g1[3], x1, true);
        u32x2 o; o.x = (unsigned)x0; o.y = (unsigned)x1;
        *(GAS u32x2*)(WT + (size_t)(n0 + n) * K + k0 + 8 * c) = o; }
    LDS_WAIT(); asm volatile("" ::: "memory");
}
__device__ __forceinline__ void cvt_f32_bf16(const float* src, bf16* dst, size_t n, int gtid, int gthreads) {
    const size_t n8 = n / 8;
    for (size_t i = gtid; i < n8; i += gthreads) {
        const f32x4 a = *(const GAS f32x4*)(src + i * 8), b = *(const GAS f32x4*)(src + i * 8 + 4);
        v4u o; o.x = pk2(a[0], a[1]); o.y = pk2(a[2], a[3]); o.z = pk2(b[0], b[1]); o.w = pk2(b[2], b[3]);
        *(GAS v4u*)(dst + i * 8) = o; }
}
__device__ __forceinline__ void cvt_f32_fp8(const float* src, unsigned char* dst, size_t n, float scale, int gtid, int gthreads, const float* cgain = nullptr) {
    const size_t n16 = n / 16;
    for (size_t i = gtid; i < n16; i += gthreads) { v4u o; unsigned w[4];
#pragma unroll
        for (int q = 0; q < 4; ++q) { f32x4 a = *(const GAS f32x4*)(src + i * 16 + 4 * q) * scale; if (cgain) a = a * *(const GAS f32x4*)(cgain + ((i * 16 + 4 * q) & (D - 1)));
            int x = __builtin_amdgcn_cvt_pk_fp8_f32(a[0], a[1], 0, false); x = __builtin_amdgcn_cvt_pk_fp8_f32(a[2], a[3], x, true); w[q] = (unsigned)x; }
        o.x = w[0]; o.y = w[1]; o.z = w[2]; o.w = w[3];
        *(GAS v4u*)(dst + i * 16) = o; }
}
__device__ __forceinline__ void cvt_rows_i8(const float* src, unsigned char* dst, float* SU, int rows, int gw, int NGW, int lane, const float* cgain) {
    f32x4 a[8], nx[8];
    int r = gw;
    if (r < rows) {
#pragma unroll
        for (int i = 0; i < 8; ++i) a[i] = *(const GAS f32x4*)(src + (size_t)r * D + 256 * i + 4 * lane); }
    for (; r < rows; r += NGW) {
        const int rn = r + NGW;
        if (rn < rows) {
#pragma unroll
            for (int i = 0; i < 8; ++i) nx[i] = *(const GAS f32x4*)(src + (size_t)rn * D + 256 * i + 4 * lane); }
        float mx = 0.f;
#pragma unroll
        for (int i = 0; i < 8; ++i) { if (cgain) a[i] = a[i] * *(const GAS f32x4*)(cgain + 256 * i + 4 * lane);
            mx = fmaxf(mx, fmaxf(fmaxf(fabsf(a[i][0]), fabsf(a[i][1])), fmaxf(fabsf(a[i][2]), fabsf(a[i][3])))); }
#pragma unroll
        for (int o = 1; o < 64; o <<= 1) mx = fmaxf(mx, __shfl_xor(mx, o));
        const float inv = mx > 0.f ? 127.0f / mx : 0.f;
#pragma unroll
        for (int i = 0; i < 8; ++i) { unsigned w = 0;
#pragma unroll
            for (int e = 0; e < 4; ++e) w |= (__float_as_uint(__builtin_fmaf(a[i][e], inv, 12582912.0f)) & 255u) << (8 * e);
            *(GAS unsigned*)(dst + (size_t)r * D + 256 * i + 4 * lane) = w; }
        if (lane == 0) SU[r] = mx * (1.0f / 127.0f);
#pragma unroll
        for (int i = 0; i < 8; ++i) a[i] = nx[i];
    }
}
__device__ __forceinline__ void rms_row_to_bf16(const float* xrow, const float* g, bf16* orow, int lane) {
    const GAS f32x4* xr = (const GAS f32x4*)xrow + lane; f32x4 v[8]; float s = 0.f;
#pragma unroll
    for (int j = 0; j < 8; ++j) { v[j] = xr[64 * j]; s += (v[j][0] * v[j][0] + v[j][1] * v[j][1]) + (v[j][2] * v[j][2] + v[j][3] * v[j][3]); }
    const float r = __builtin_amdgcn_rsqf(wave_sum(s) * (1.0f / D) + EPS);
    const GAS f32x4* gr = (const GAS f32x4*)g + lane;
    GAS unsigned long long* o8 = (GAS unsigned long long*)orow + lane;
#pragma unroll
    for (int j = 0; j < 8; ++j) { const f32x4 gg = gr[64 * j]; o8[64 * j] = (unsigned long long)pk2(v[j][0] * r * gg[0], v[j][1] * r * gg[1]) | ((unsigned long long)pk2(v[j][2] * r * gg[2], v[j][3] * r * gg[3]) << 32); }
}
__device__ __forceinline__ void rms_row_to_i8(const float* xrow, const float* g, unsigned char* orow, float* sa, int lane) {
    const GAS f32x4* xr = (const GAS f32x4*)xrow + lane; f32x4 v[8]; float s = 0.f;
#pragma unroll
    for (int j = 0; j < 8; ++j) { v[j] = xr[64 * j]; s += (v[j][0] * v[j][0] + v[j][1] * v[j][1]) + (v[j][2] * v[j][2] + v[j][3] * v[j][3]); }
    const float r = __builtin_amdgcn_rsqf(wave_sum(s) * (1.0f / D) + EPS);
    const GAS f32x4* gr = (const GAS f32x4*)g + lane; float mx = 0.f;
#pragma unroll
    for (int j = 0; j < 8; ++j) { v[j] = v[j] * gr[64 * j] * r; mx = fmaxf(mx, fmaxf(fmaxf(fabsf(v[j][0]), fabsf(v[j][1])), fmaxf(fabsf(v[j][2]), fabsf(v[j][3])))); }
#pragma unroll
    for (int o = 1; o < 64; o <<= 1) mx = fmaxf(mx, __shfl_xor(mx, o));
    const float inv = mx > 0.f ? 127.0f / mx : 0.f;
    GAS unsigned* o4 = (GAS unsigned*)orow + lane;
#pragma unroll
    for (int j = 0; j < 8; ++j) { unsigned w = 0;
#pragma unroll
        for (int e = 0; e < 4; ++e) w |= (__float_as_uint(__builtin_fmaf(v[j][e], inv, 12582912.0f)) & 255u) << (8 * e);
        o4[64 * j] = w; }
    if (lane == 0) *sa = mx * (1.0f / (127.0f * 127.0f));
}
__device__ __forceinline__ void rms_row_to_f8(const float* xrow, const float* g, unsigned char* orow, int lane) {
    const GAS f32x4* xr = (const GAS f32x4*)xrow + lane; f32x4 v[8]; float s = 0.f;
#pragma unroll
    for (int j = 0; j < 8; ++j) { v[j] = xr[64 * j]; s += (v[j][0] * v[j][0] + v[j][1] * v[j][1]) + (v[j][2] * v[j][2] + v[j][3] * v[j][3]); }
    const float r = __builtin_amdgcn_rsqf(wave_sum(s) * (1.0f / D) + EPS);
    const GAS f32x4* gr = (const GAS f32x4*)g + lane;
    GAS unsigned* o4 = (GAS unsigned*)orow + lane;
#pragma unroll
    for (int j = 0; j < 8; ++j) { const f32x4 q = v[j] * gr[64 * j] * r; int x = __builtin_amdgcn_cvt_pk_fp8_f32(q[0], q[1], 0, false); x = __builtin_amdgcn_cvt_pk_fp8_f32(q[2], q[3], x, true); o4[64 * j] = (unsigned)x; }
}
__device__ __forceinline__ void p0_fold_item(const float* wq, const float* sk, bf16* WP, LAS float* lds, int item, int tid, const float* kgain) {
    const int hp = item >> 5, k0 = (item & 31) * 64;
    LAS float* skT = lds;
    LAS float* wqT = lds + 128 * 132;
    const float* skb = sk + (size_t)hp * 128 * 128;
#pragma unroll 4
    for (int i = 0; i < 32; ++i) { const int idx = i * 512 + tid, n = idx >> 7, d = idx & 127; skT[d * 132 + n] = skb[idx]; }
#pragma unroll 4
    for (int i = 0; i < 16; ++i) { const int idx = i * 512 + tid, kk = idx >> 7, d = idx & 127; wqT[d * 68 + kk] = wq[(size_t)(k0 + kk) * D + hp * 128 + d] * kgain[k0 + kk]; }
    __syncthreads();
    const int n0 = (tid >> 4) * 4, kk0 = (tid & 15) * 4;
    float acc[4][4];
#pragma unroll
    for (int i = 0; i < 4; ++i)
#pragma unroll
        for (int j = 0; j < 4; ++j) acc[i][j] = 0.f;
#pragma unroll 4
    for (int d = 0; d < 128; ++d) { const f32x4 a = *(const LAS f32x4*)(skT + d * 132 + n0), b = *(const LAS f32x4*)(wqT + d * 68 + kk0);
#pragma unroll
        for (int i = 0; i < 4; ++i)
#pragma unroll
            for (int j = 0; j < 4; ++j) acc[i][j] += a[i] * b[j]; }
#pragma unroll
    for (int i = 0; i < 4; ++i) { unsigned long long o = (unsigned long long)pk2(acc[i][0], acc[i][1]) | ((unsigned long long)pk2(acc[i][2], acc[i][3]) << 32);
        *(GAS unsigned long long*)(WP + (size_t)(hp * 128 + n0 + i) * D + k0 + kk0) = o; }
    __syncthreads();
}
__device__ __forceinline__ void p0_prologue(const Args& A, Frame& F, const int part) {
    const int gw = F.vcu * NWAVES + F.wave, NGW = F.G * NWAVES;
    const int gtid = gw * 64 + F.lane, gthreads = F.G * NTHREADS;
    unsigned char* ws = A.ws;
    LAS float* scr = (LAS float*)(F.lds + RING_OFF + F.wave * 16384);
    constexpr int I_EVIN = (D / 64) * (EV_N / 32);
    if (part == 1) {
        for (int it = gw; it < I_EVIN; it += NGW) p0_transpose_item_i8(A.in[I_EV_WIN], D, EV_N, (unsigned char*)(ws + WS_WEV_IN), scr, it, F.lane, (const float*)(ws + WS_CMB));
        return; }
    { constexpr int I_CM = (D / 64) * ((EV_N + 255) / 256);
      for (int it = gw; it < I_CM; it += NGW) colmax_item(A.in[I_EV_WIN], D, EV_N, (float*)(ws + WS_CMB), it, F.lane); }
    { GAS v4u* z0 = (GAS v4u*)(ws + WS_WEV_IN + (size_t)EV_N * D); const size_t n0 = (size_t)(EV_NP - EV_N) * D / 16;
      for (size_t i = gtid; i < n0; i += gthreads) z0[i] = (v4u){0u, 0u, 0u, 0u}; }
    { constexpr int I_PJ = (256 / 64) * (D / 32);
      for (int it = gw; it < 2 * I_PJ; it += NGW) { const int L = it / I_PJ; p0_transpose_item(A.in[I_PLE_WP] + (size_t)L * 256 * D, 256, D, (bf16*)(ws + WS_WPROJ) + (size_t)L * D * 256, scr, it % I_PJ, F.lane); } }
    if (F.G < 256) cvt_f32_bf16(A.in[I_P], (bf16*)(ws + WS_PBF), (size_t)2 * T * 256, gtid, gthreads);
    for (int m = gw; m < T; m += NGW) rms_row_to_i8(A.in[I_X] + (size_t)m * D, A.in[I_NMIX], (unsigned char*)(ws + WS_ACTA) + (size_t)m * D, (float*)(ws + WS_SA) + m, F.lane);
#if EV_F8_T1 > EV_F8_T0
    for (int it = gw; it < I_EVIN; it += NGW) p0_transpose_item_f8(A.in[I_EV_WIN], D, EV_N, (unsigned char*)(ws + WS_O), scr, it, F.lane);
    { GAS v4u* z0 = (GAS v4u*)(ws + WS_O + (size_t)EV_N * D); const size_t n0 = (size_t)(EV_NP - EV_N) * D / 16;
      for (size_t i = gtid; i < n0; i += gthreads) z0[i] = (v4u){0u, 0u, 0u, 0u}; }
    for (int m = gw; m < T; m += NGW) rms_row_to_f8(A.in[I_X] + (size_t)m * D, A.in[I_NMIX], (unsigned char*)(ws + WS_H1) + (size_t)m * D, F.lane);
#endif
}
__device__ __forceinline__ void p0_deferred(const Args& A, Frame& F, int wg, int nwg) {
    const int gw = wg * NWAVES + F.wave, NGW = nwg * NWAVES;
    int gtid = gw * 64 + F.lane; const int gthreads = nwg * NTHREADS;
    asm volatile("" : "+v"(gtid));
    unsigned char* ws = A.ws;
    {
        LAS float* scr = (LAS float*)(F.lds + RING_OFF + F.wave * 16384);
        constexpr int I_SQ = (D / 64) * (D / 32), I_ODIN = (D / 64) * (OD_N / 32);
        constexpr int NITEMS = I_SQ + I_ODIN + I_SQ;
        for (int it = gw; it < NITEMS; it += NGW) {
            int r = it;
            if (r < I_SQ) { p0_transpose_item(A.in[I_EV_WOUT], D, D, (bf16*)(ws + WS_WEV_OUT), scr, r, F.lane); continue; } r -= I_SQ;
            if (r < I_ODIN) { p0_transpose_item_f8(A.in[I_OD_WIN], D, OD_N, (unsigned char*)(ws + WS_WOD_IN), scr, r, F.lane, A.in[I_NMIX] + D); continue; } r -= I_ODIN;
            p0_transpose_item_f8(A.in[I_PLE_WG], D, D, (unsigned char*)(ws + WS_WGATE), scr, r, F.lane, A.in[I_NPLE]);
        }
        { GAS v4u* z1 = (GAS v4u*)(ws + WS_WOD_IN + (size_t)OD_N * D); const size_t n1 = (size_t)(OD_NP - OD_N) * D / 16;
          for (size_t i = gtid; i < n1; i += gthreads) z1[i] = (v4u){0u, 0u, 0u, 0u}; }
    }
    __syncthreads();
    for (int it = wg; it < 512; it += nwg)
        p0_fold_item(A.in[I_PEER_WQ], A.in[I_PEER_SK], (bf16*)(ws + WS_WPEER), (LAS float*)(F.lds + RING_OFF), it, F.tid, A.in[I_NFFN]);
    cvt_rows_i8(A.in[I_PEER_U], (unsigned char*)(ws + WS_TABU), (float*)(ws + WS_SU), 16384, gw, NGW, F.lane, A.in[I_NFFN]);
    cvt_rows_i8(A.in[I_PEER_V], (unsigned char*)(ws + WS_TABV), (float*)(ws + WS_SU) + 32768, 16384, gw, NGW, F.lane, nullptr);
    { bf16* LB = (bf16*)(ws + WS_WLORA); const float* w2 = A.in[I_W2]; const float* a2 = A.in[I_A2]; const float* g2 = A.in[I_G2];
      for (int i = gtid; i < LORA_N * LORA_K / 2; i += gthreads) { const int row = i / (LORA_K / 2), col = (i % (LORA_K / 2)) * 2; float v[2];
#pragma unroll
          for (int e = 0; e < 2; ++e) { const int c = col + e; float x = 0.f;
              if (row < 1024) { if (c < 96) x = w2[c * 1024 + row]; }
              else if (row < 2048) { if (c >= 96 && c < 192) x = a2[(c - 96) * 1024 + (row - 1024)]; }
              else { if (c >= 192 && c < 448) x = g2[(c - 192) * 1024 + (row - 2048)]; }
              v[e] = x; }
          *(GAS unsigned*)(LB + (size_t)row * LORA_K + col) = pk2(v[0], v[1]); } }
}
__device__ __forceinline__ void p1_deferred(const Args& A, Frame& F, int wg, int nwg) {
    const int gw = wg * NWAVES + F.wave, NGW = nwg * NWAVES;
    int gtid = gw * 64 + F.lane; const int gthreads = nwg * NTHREADS;
    asm volatile("" : "+v"(gtid));
    unsigned char* ws = A.ws;
    { LAS float* scr = (LAS float*)(F.lds + RING_OFF + F.wave * 16384); constexpr int I_SQ = (D / 64) * (D / 32);
      for (int it = gw; it < 2 * I_SQ; it += NGW) {
          if (it < I_SQ) p0_transpose_item_f8(A.in[I_OD_WOUT], D, D, (unsigned char*)(ws + WS_WOD_OUT), scr, it, F.lane);
          else p0_transpose_item_f8(A.in[I_PLE_WG] + (size_t)D * D, D, D, (unsigned char*)((bf16*)(ws + WS_WGATE) + (size_t)D * D), scr, it - I_SQ, F.lane, A.in[I_NPLE] + D); } }
    __syncthreads();
    for (int it = wg; it < 512; it += nwg)
        p0_fold_item(A.in[I_PEER_WQ] + (size_t)D * D, A.in[I_PEER_SK] + (size_t)16 * 128 * 128, (bf16*)(ws + WS_WPEER) + (size_t)D * D, (LAS float*)(F.lds + RING_OFF), it, F.tid, A.in[I_NFFN] + D);
    cvt_rows_i8(A.in[I_PEER_U] + (size_t)16384 * D, (unsigned char*)(ws + WS_TABU) + (size_t)16384 * D, (float*)(ws + WS_SU) + 16384, 16384, gw, NGW, F.lane, A.in[I_NFFN] + D);
    cvt_rows_i8(A.in[I_PEER_V] + (size_t)16384 * D, (unsigned char*)(ws + WS_TABV) + (size_t)16384 * D, (float*)(ws + WS_SU) + 32768 + 16384, 16384, gw, NGW, F.lane, nullptr);
}

constexpr int TC = 16, NCHUNK = SEQ / TC;

template <int MODE>
__device__ __forceinline__ void scan_gla_unit(const Args& A, Frame& F, int unit) {
    int tid = F.tid; asm volatile("" : "+v"(tid));
    const int lane = tid & 63, w = F.wave;
    int b, h, qcol, kcol, vcol, ocol;
    if (MODE == 0) { b = unit >> 4; h = (unit >> 2) & 3; const int s = unit & 3; qcol = EC_GQ + h * 128; kcol = EC_GK + h * 128; vcol = EC_GV + h * 256 + s * 64; ocol = h * 256 + s * 64; }
    else           { b = unit >> 4; h = (unit >> 1) & 7; const int s = unit & 1; qcol = OC_HQ + h * 128; kcol = OC_HF + h * 128; vcol = OC_HI + h * 128 + s * 64; ocol = h * 128 + s * 64; }
    const bf16* P = (const bf16*)(A.ws + WS_PROJ) + (size_t)b * SEQ * PROJ_LD;
    float* O = (float*)(A.ws + WS_O) + (size_t)b * SEQ * D + ocol;
    LAS float* Lf = (LAS float*)(F.lds + RING_OFF);
    constexpr int BUFSZ = 7168, O_EG = 0, O_K = 2048, O_Q = 4096, O_V = 6144, O_OUT = 2 * BUFSZ, O_W2 = O_OUT + 1024, O_BIAS = O_W2 + 2048;
    const int tl = tid >> 5, dq = (tid & 31) * 4, tlv = tid >> 4, c4 = (tid & 15) * 4;
    float lb[4] = {0.f, 0.f, 0.f, 0.f};
    if (MODE == 0) {
        const float* w2 = A.in[I_GK_W2]; const float* gb = A.in[I_GK_B];
        for (int i = tid; i < 2048; i += NTHREADS) Lf[O_W2 + i] = w2[(i >> 7) * 512 + h * 128 + (i & 127)];
        if (tid < 128) Lf[O_BIAS + tid] = gb[h * 128 + tid];
    } else {
        const float* lg = A.in[I_LB];
#pragma unroll
        for (int i = 0; i < 4; ++i) lb[i] = sigmoidf_(lg[1024 + h * 128 + dq + i] - lg[h * 128 + dq + i]);
    }
    u32x2 rq, rk, rv = {0u, 0u}; v4u rg0 = {0u, 0u, 0u, 0u}, rg1 = {0u, 0u, 0u, 0u};
#define GLA_LOAD(c) do { const bf16* pr = P + (size_t)((c) * TC + tl) * PROJ_LD; rq = *(const GAS u32x2*)(pr + qcol + dq); rk = *(const GAS u32x2*)(pr + kcol + dq); \
        if (MODE == 0) { rg0 = *(const GAS v4u*)(pr + EC_GLR); rg1 = *(const GAS v4u*)(pr + EC_GLR + 8); } \
        if (tid < 256) rv = *(const GAS u32x2*)(P + (size_t)((c) * TC + tlv) * PROJ_LD + vcol + c4); } while (0)
#define GLA_XFORM(bufi) do { LAS float* B_ = Lf + (bufi) * BUFSZ; f32x4 q4, k4, e4; \
        const float xq[4] = {bf_lo(rq.x), bf_hi(rq.x), bf_lo(rq.y), bf_hi(rq.y)}, xk[4] = {bf_lo(rk.x), bf_hi(rk.x), bf_lo(rk.y), bf_hi(rk.y)}; \
        if (MODE == 0) { f32x4 z = *(const LAS f32x4*)(Lf + O_BIAS + dq); \
            const float gl[16] = {bf_lo(rg0.x), bf_hi(rg0.x), bf_lo(rg0.y), bf_hi(rg0.y), bf_lo(rg0.z), bf_hi(rg0.z), bf_lo(rg0.w), bf_hi(rg0.w), \
                                  bf_lo(rg1.x), bf_hi(rg1.x), bf_lo(rg1.y), bf_hi(rg1.y), bf_lo(rg1.z), bf_hi(rg1.z), bf_lo(rg1.w), bf_hi(rg1.w)}; \
            _Pragma("unroll") for (int r_ = 0; r_ < 16; ++r_) { const f32x4 wv = *(const LAS f32x4*)(Lf + O_W2 + r_ * 128 + dq); z = z + wv * gl[r_]; } \
            _Pragma("unroll") for (int i_ = 0; i_ < 4; ++i_) { q4[i_] = xq[i_] * 0.08838834764831845f; k4[i_] = xk[i_]; e4[i_] = __builtin_amdgcn_exp2f(-0.0625f * __builtin_amdgcn_logf(1.0f + __expf(-z[i_]))); } } \
        else { _Pragma("unroll") for (int i_ = 0; i_ < 4; ++i_) { const float fg = lb[i_] + (1.f - lb[i_]) * sigmoidf_(xk[i_]); q4[i_] = siluf_(xq[i_]); k4[i_] = 1.f - fg; e4[i_] = fg; } } \
        *(LAS f32x4*)(B_ + O_EG + tl * 128 + dq) = e4; *(LAS f32x4*)(B_ + O_K + tl * 128 + dq) = k4; *(LAS f32x4*)(B_ + O_Q + tl * 128 + dq) = q4; \
        if (tid < 256) { f32x4 v4 = {bf_lo(rv.x), bf_hi(rv.x), bf_lo(rv.y), bf_hi(rv.y)}; *(LAS f32x4*)(B_ + O_V + tlv * 64 + c4) = v4; } } while (0)
    LBAR();
    GLA_LOAD(0); GLA_XFORM(0);
    LBAR();
    f32x2 S2[8];
#pragma unroll
    for (int i = 0; i < 8; ++i) S2[i] = (f32x2){0.f, 0.f};
    const int j = lane & 15, col = w * 8 + (lane >> 4) * 2;
    for (int c = 0; c < NCHUNK; ++c) {
        if (c + 1 < NCHUNK) GLA_LOAD(c + 1);
        const LAS float* B_ = Lf + (c & 1) * BUFSZ;
        float os0 = 0.f, os1 = 0.f;
        f32x4 e0, e1, k0, k1, q0, q1, ne0, ne1, nk0, nk1, nq0, nq1; f32x2 v2, nv2;
#define GLA_LDSTEP(t_, E0, E1, K0, K1, Q0, Q1, V2) do { E0 = *(const LAS f32x4*)(B_ + O_EG + (t_) * 128 + 4 * j); E1 = *(const LAS f32x4*)(B_ + O_EG + (t_) * 128 + 64 + 4 * j); \
            K0 = *(const LAS f32x4*)(B_ + O_K + (t_) * 128 + 4 * j); K1 = *(const LAS f32x4*)(B_ + O_K + (t_) * 128 + 64 + 4 * j); \
            Q0 = *(const LAS f32x4*)(B_ + O_Q + (t_) * 128 + 4 * j); Q1 = *(const LAS f32x4*)(B_ + O_Q + (t_) * 128 + 64 + 4 * j); V2 = *(const LAS f32x2*)(B_ + O_V + (t_) * 64 + col); } while (0)
        GLA_LDSTEP(0, e0, e1, k0, k1, q0, q1, v2);
#pragma unroll
        for (int t = 0; t < TC; ++t) {
            if (t + 1 < TC) { GLA_LDSTEP(t + 1, ne0, ne1, nk0, nk1, nq0, nq1, nv2); }
            __builtin_amdgcn_sched_barrier(0);
            f32x2 pa = {0.f, 0.f}, pb = {0.f, 0.f};
#pragma unroll
            for (int i = 0; i < 4; ++i) {
                S2[i] = S2[i] * e0[i] + v2 * k0[i]; S2[4 + i] = S2[4 + i] * e1[i] + v2 * k1[i];
                pa += S2[i] * q0[i]; pb += S2[4 + i] * q1[i]; }
            pa += pb;
            float p0 = pa[0], p1 = pa[1];
            row_sum16_x2(p0, p1);
            os0 = (j == t) ? p0 : os0; os1 = (j == t) ? p1 : os1;
            e0 = ne0; e1 = ne1; k0 = nk0; k1 = nk1; q0 = nq0; q1 = nq1; v2 = nv2;
        }
#undef GLA_LDSTEP
        { f32x2 o2 = {os0, os1}; *(LAS f32x2*)(Lf + O_OUT + j * 64 + col) = o2; }
        if (c + 1 < NCHUNK) GLA_XFORM((c + 1) & 1);
        LBAR();
        if (tid < 256) *(GAS f32x4*)(O + (size_t)(c * TC + tlv) * D + c4) = *(const LAS f32x4*)(Lf + O_OUT + tlv * 64 + c4);
        LBAR();
    }
#undef GLA_LOAD
#undef GLA_XFORM
}

__device__ __forceinline__ void scan_gdn_unit(const Args& A, Frame& F, int unit) {
    int tid = F.tid; asm volatile("" : "+v"(tid));
    const int lane = tid & 63, w = F.wave;
    const int b = unit >> 4, h = (unit >> 1) & 7, s = unit & 1;
    const int qcol = EC_BQ + h * 128, kcol = EC_BK + h * 128, vcol = EC_BV + h * 128 + s * 64, ocol = 1024 + h * 128 + s * 64;
    const bf16* P = (const bf16*)(A.ws + WS_PROJ) + (size_t)b * SEQ * PROJ_LD;
    float* O = (float*)(A.ws + WS_O) + (size_t)b * SEQ * D + ocol;
    LAS float* Lf = (LAS float*)(F.lds + RING_OFF);
    constexpr int BUFSZ = 5184, O_K = 0, O_Q = 2048, O_V = 4096, O_SC = 5120, O_OUT = 2 * BUFSZ, O_CW = O_OUT + 1024;
    const int tl = tid >> 5, dq = (tid & 31) * 4, tlv = tid >> 4, c4 = (tid & 15) * 4;
    { const float* cw = A.in[I_GDN_CONV];
      for (int i = tid; i < 4 * 320; i += NTHREADS) { const int jt = i / 320, x = i % 320;
          const int ch = x < 128 ? (h * 128 + x) : x < 256 ? (1024 + h * 128 + (x - 128)) : (2048 + h * 128 + s * 64 + (x - 256));
          Lf[O_CW + i] = cw[jt * 3072 + ch]; } }
    const float neg_ea = -__expf(A.in[I_GDN_ALOG][h]), dtb = A.in[I_GDN_DTB][h];
    u32x2 rq[4], rk[4], rv[4]; unsigned short rba = 0, rbb = 0;
#pragma unroll
    for (int i = 0; i < 4; ++i) rv[i] = (u32x2){0u, 0u};
#define GDN_LOAD(c) do { const int t_ = (c) * TC + tl; \
        _Pragma("unroll") for (int jt = 0; jt < 4; ++jt) { const int tt = t_ - 3 + jt; \
            if (tt >= 0) { const bf16* pr = P + (size_t)tt * PROJ_LD; rq[jt] = *(const GAS u32x2*)(pr + qcol + dq); rk[jt] = *(const GAS u32x2*)(pr + kcol + dq); } \
            else { rq[jt] = (u32x2){0u, 0u}; rk[jt] = (u32x2){0u, 0u}; } } \
        { const bf16* pr = P + (size_t)t_ * PROJ_LD; rba = pr[EC_BA + h]; rbb = pr[EC_BB + h]; } \
        if (tid < 256) { const int tv = (c) * TC + tlv; \
            _Pragma("unroll") for (int jt = 0; jt < 4; ++jt) { const int tt = tv - 3 + jt; \
                if (tt >= 0) rv[jt] = *(const GAS u32x2*)(P + (size_t)tt * PROJ_LD + vcol + c4); else rv[jt] = (u32x2){0u, 0u}; } } } while (0)
#define GDN_XFORM(bufi) do { LAS float* B_ = Lf + (bufi) * BUFSZ; f32x4 q4 = {0.f, 0.f, 0.f, 0.f}, k4 = {0.f, 0.f, 0.f, 0.f}; \
        _Pragma("unroll") for (int jt = 0; jt < 4; ++jt) { const f32x4 wq = *(const LAS f32x4*)(Lf + O_CW + jt * 320 + dq), wk = *(const LAS f32x4*)(Lf + O_CW + jt * 320 + 128 + dq); \
            q4[0] += wq[0] * bf_lo(rq[jt].x); q4[1] += wq[1] * bf_hi(rq[jt].x); q4[2] += wq[2] * bf_lo(rq[jt].y); q4[3] += wq[3] * bf_hi(rq[jt].y); \
            k4[0] += wk[0] * bf_lo(rk[jt].x); k4[1] += wk[1] * bf_hi(rk[jt].x); k4[2] += wk[2] * bf_lo(rk[jt].y); k4[3] += wk[3] * bf_hi(rk[jt].y); } \
        float sq = 0.f, sk = 0.f, sqk = 0.f; \
        _Pragma("unroll") for (int i_ = 0; i_ < 4; ++i_) { q4[i_] = siluf_(q4[i_]); k4[i_] = siluf_(k4[i_]); sq += q4[i_] * q4[i_]; sk += k4[i_] * k4[i_]; sqk += q4[i_] * k4[i_]; } \
        sq = half_sum32(sq); sk = half_sum32(sk); sqk = half_sum32(sqk); \
        const float rq_ = __builtin_amdgcn_rsqf(sq + EPS) * 0.08838834764831845f, rk_ = __builtin_amdgcn_rsqf(sk + EPS); \
        q4 = q4 * rq_; k4 = k4 * rk_; \
        *(LAS f32x4*)(B_ + O_K + tl * 128 + dq) = k4; *(LAS f32x4*)(B_ + O_Q + tl * 128 + dq) = q4; \
        if ((tid & 31) == 0) { const float ba = __uint_as_float((unsigned)rba << 16), bb = __uint_as_float((unsigned)rbb << 16); \
            f32x4 sc; sc[0] = __expf(neg_ea * softplusf_(ba + dtb)); sc[1] = sigmoidf_(bb); sc[2] = sqk * rq_ * rk_; sc[3] = 0.f; *(LAS f32x4*)(B_ + O_SC + tl * 4) = sc; } \
        if (tid < 256) { f32x4 v4 = {0.f, 0.f, 0.f, 0.f}; \
            _Pragma("unroll") for (int jt = 0; jt < 4; ++jt) { const f32x4 wv = *(const LAS f32x4*)(Lf + O_CW + jt * 320 + 256 + c4); \
                v4[0] += wv[0] * bf_lo(rv[jt].x); v4[1] += wv[1] * bf_hi(rv[jt].x); v4[2] += wv[2] * bf_lo(rv[jt].y); v4[3] += wv[3] * bf_hi(rv[jt].y); } \
            _Pragma("unroll") for (int i_ = 0; i_ < 4; ++i_) v4[i_] = siluf_(v4[i_]); \
            *(LAS f32x4*)(B_ + O_V + tlv * 64 + c4) = v4; } } while (0)
    LBAR();
    GDN_LOAD(0); GDN_XFORM(0);
    LBAR();
    f32x2 S2[8];
#pragma unroll
    for (int i = 0; i < 8; ++i) S2[i] = (f32x2){0.f, 0.f};
    const int j = lane & 15, col = w * 8 + (lane >> 4) * 2;
    for (int c = 0; c < NCHUNK; ++c) {
        if (c + 1 < NCHUNK) GDN_LOAD(c + 1);
        const LAS float* B_ = Lf + (c & 1) * BUFSZ;
        float os0 = 0.f, os1 = 0.f;
        f32x4 k0, k1, q0, q1, sc, nk0, nk1, nq0, nq1, nsc; f32x2 v2, nv2;
#define GDN_LDSTEP(t_, K0, K1, Q0, Q1, V2, SC) do { K0 = *(const LAS f32x4*)(B_ + O_K + (t_) * 128 + 4 * j); K1 = *(const LAS f32x4*)(B_ + O_K + (t_) * 128 + 64 + 4 * j); \
            Q0 = *(const LAS f32x4*)(B_ + O_Q + (t_) * 128 + 4 * j); Q1 = *(const LAS f32x4*)(B_ + O_Q + (t_) * 128 + 64 + 4 * j); V2 = *(const LAS f32x2*)(B_ + O_V + (t_) * 64 + col); SC = *(const LAS f32x4*)(B_ + O_SC + (t_) * 4); } while (0)
        GDN_LDSTEP(0, k0, k1, q0, q1, v2, sc);
#pragma unroll
        for (int t = 0; t < TC; ++t) {
            if (t + 1 < TC) { GDN_LDSTEP(t + 1, nk0, nk1, nq0, nq1, nv2, nsc); }
            __builtin_amdgcn_sched_barrier(0);
            f32x2 d1 = {0.f, 0.f}, d2 = {0.f, 0.f}, e1 = {0.f, 0.f}, e2 = {0.f, 0.f};
#pragma unroll
            for (int i = 0; i < 4; ++i) { d1 += S2[i] * k0[i]; e1 += S2[4 + i] * k1[i]; d2 += S2[i] * q0[i]; e2 += S2[4 + i] * q1[i]; }
            d1 += e1; d2 += e2;
            { float r0_ = d1[0], r1_ = d1[1], r2_ = d2[0], r3_ = d2[1]; row_sum16_x4(r0_, r1_, r2_, r3_); d1[0] = r0_; d1[1] = r1_; d2[0] = r2_; d2[1] = r3_; }
            const float a = sc[0], beta = sc[1], qk = sc[2];
            const f32x2 dl = (v2 - d1 * a) * beta;
            const f32x2 o2 = d2 * a + dl * qk;
#pragma unroll
            for (int i = 0; i < 4; ++i) { S2[i] = S2[i] * a + dl * k0[i]; S2[4 + i] = S2[4 + i] * a + dl * k1[i]; }
            os0 = (j == t) ? o2[0] : os0; os1 = (j == t) ? o2[1] : os1;
            k0 = nk0; k1 = nk1; q0 = nq0; q1 = nq1; v2 = nv2; sc = nsc;
        }
#undef GDN_LDSTEP
        { f32x2 o2 = {os0, os1}; *(LAS f32x2*)(Lf + O_OUT + j * 64 + col) = o2; }
        if (c + 1 < NCHUNK) GDN_XFORM((c + 1) & 1);
        LBAR();
        if (tid < 256) *(GAS f32x4*)(O + (size_t)(c * TC + tlv) * D + c4) = *(const LAS f32x4*)(Lf + O_OUT + tlv * 64 + c4);
        LBAR();
    }
#undef GDN_LOAD
#undef GDN_XFORM
}

typedef short bf16x4_t __attribute__((ext_vector_type(4)));
__device__ __forceinline__ bf16x8 mk_frag(u32x2 lo, u32x2 hi) { v4u t; t.x = lo.x; t.y = lo.y; t.z = hi.x; t.w = hi.y; return __builtin_bit_cast(bf16x8, t); }
template <int MODE>
__device__ __forceinline__ void scan_gla_mfma_unit(const Args& A, Frame& F, int unit) {
    int tid = F.tid; asm volatile("" : "+v"(tid));
    const int lane = tid & 63, w = F.wave;
    int b, h, qcol, kcol, vcol, ocol;
    if (MODE == 0) { b = unit >> 3; h = (unit >> 1) & 3; const int s = unit & 1; qcol = EC_GQ + h * 128; kcol = EC_GK + h * 128; vcol = EC_GV + h * 256 + s * 128; ocol = h * 256 + s * 128; }
    else           { b = unit >> 3; h = unit & 7; qcol = OC_HQ + h * 128; kcol = OC_HF + h * 128; vcol = OC_HI + h * 128; ocol = h * 128; }
    const bf16* P = (const bf16*)(A.ws + WS_PROJ) + (size_t)b * SEQ * PROJ_LD;
    bf16* O = (bf16*)(A.ws + WS_O) + (size_t)b * SEQ * D + ocol;
    LAS float* Lf = (LAS float*)(F.lds + RING_OFF);
    constexpr int BUFSZ = 8192, O_E = 0, O_K = 2048, O_Q = 4096, O_V = 6144, RS = 136, O_QB = 2 * BUFSZ, O_KB = O_QB + 1088, O_KT = O_KB + 1088, O_BL = O_KT + 1024, O_AM = O_BL + 128, O_W2 = O_AM + 128, O_BIAS = O_W2 + 2048;
    LAS bf16* QB = (LAS bf16*)(Lf + O_QB); LAS bf16* KB = (LAS bf16*)(Lf + O_KB); LAS bf16* KT = (LAS bf16*)(Lf + O_KT); LAS bf16* AM = (LAS bf16*)(Lf + O_AM);
    const int tl = tid >> 5, dq = (tid & 31) * 4;
    float lb[4] = {0.f, 0.f, 0.f, 0.f};
    if (MODE == 0) {
        const float* w2 = A.in[I_GK_W2]; const float* gb = A.in[I_GK_B];
        for (int i = tid; i < 2048; i += NTHREADS) Lf[O_W2 + i] = w2[(i >> 7) * 512 + h * 128 + (i & 127)];
        if (tid < 128) Lf[O_BIAS + tid] = gb[h * 128 + tid];
    } else {
        const float* lg = A.in[I_LB];
#pragma unroll
        for (int i = 0; i < 4; ++i) lb[i] = sigmoidf_(lg[1024 + h * 128 + dq + i] - lg[h * 128 + dq + i]);
    }
    u32x2 rq, rk, rv; v4u rg0 = {0u, 0u, 0u, 0u}, rg1 = {0u, 0u, 0u, 0u};
#define GM_LOAD(c) do { const bf16* pr = P + (size_t)((c) * TC + tl) * PROJ_LD; rq = *(const GAS u32x2*)(pr + qcol + dq); rk = *(const GAS u32x2*)(pr + kcol + dq); rv = *(const GAS u32x2*)(pr + vcol + dq); \
        if (MODE == 0) { rg0 = *(const GAS v4u*)(pr + EC_GLR); rg1 = *(const GAS v4u*)(pr + EC_GLR + 8); } } while (0)
#define GM_XFORM(bufi) do { LAS float* B_ = Lf + (bufi) * BUFSZ; f32x4 q4, k4, e4; \
        const float xq[4] = {bf_lo(rq.x), bf_hi(rq.x), bf_lo(rq.y), bf_hi(rq.y)}, xk[4] = {bf_lo(rk.x), bf_hi(rk.x), bf_lo(rk.y), bf_hi(rk.y)}; \
        if (MODE == 0) { f32x4 z = *(const LAS f32x4*)(Lf + O_BIAS + dq); \
            const float gl[16] = {bf_lo(rg0.x), bf_hi(rg0.x), bf_lo(rg0.y), bf_hi(rg0.y), bf_lo(rg0.z), bf_hi(rg0.z), bf_lo(rg0.w), bf_hi(rg0.w), \
                                  bf_lo(rg1.x), bf_hi(rg1.x), bf_lo(rg1.y), bf_hi(rg1.y), bf_lo(rg1.z), bf_hi(rg1.z), bf_lo(rg1.w), bf_hi(rg1.w)}; \
            _Pragma("unroll") for (int r_ = 0; r_ < 16; ++r_) { const f32x4 wv = *(const LAS f32x4*)(Lf + O_W2 + r_ * 128 + dq); z = z + wv * gl[r_]; } \
            _Pragma("unroll") for (int i_ = 0; i_ < 4; ++i_) { q4[i_] = xq[i_] * 0.08838834764831845f; k4[i_] = xk[i_]; e4[i_] = __builtin_amdgcn_exp2f(-0.0625f * __builtin_amdgcn_logf(1.0f + __expf(-z[i_]))); } } \
        else { _Pragma("unroll") for (int i_ = 0; i_ < 4; ++i_) { const float fg = lb[i_] + (1.f - lb[i_]) * sigmoidf_(xk[i_]); q4[i_] = siluf_(xq[i_]); k4[i_] = 1.f - fg; e4[i_] = fg; } } \
        *(LAS f32x4*)(B_ + O_E + tl * 128 + dq) = e4; *(LAS f32x4*)(B_ + O_K + tl * 128 + dq) = k4; *(LAS f32x4*)(B_ + O_Q + tl * 128 + dq) = q4; \
        { f32x4 v4 = {bf_lo(rv.x), bf_hi(rv.x), bf_lo(rv.y), bf_hi(rv.y)}; *(LAS f32x4*)(B_ + O_V + tl * 128 + dq) = v4; } } while (0)
    LBAR();
    GM_LOAD(0); GM_XFORM(0); GM_LOAD(1);
    LBAR();
    f32x4 Sacc[8];
#pragma unroll
    for (int i = 0; i < 8; ++i) Sacc[i] = (f32x4){0.f, 0.f, 0.f, 0.f};
    const int fr = lane & 15, g = lane >> 4, c0 = w * 16;
    for (int c = 0; c < NCHUNK; ++c) {
        const LAS float* B_ = Lf + (c & 1) * BUFSZ;
        {
            const int seg = tid >> 7, d = tid & 127;
            float bt = 1.f, ball = 1.f;
#pragma unroll
            for (int t = 0; t < 16; ++t) { const float e = B_[O_E + t * 128 + d]; ball *= e; if (t < 4 * seg) bt = ball; }
            ball = fmaxf(ball, 1e-30f);
            unsigned short kt4[4];
#pragma unroll
            for (int i = 0; i < 4; ++i) { const int t = 4 * seg + i; bt = fmaxf(bt * B_[O_E + t * 128 + d], 1e-30f);
                const float kk = B_[O_K + t * 128 + d], qq = B_[O_Q + t * 128 + d], ib = __builtin_amdgcn_rcpf(bt);
                QB[t * RS + d] = hw_bf(qq * bt); KB[t * RS + d] = hw_bf(kk * ib); kt4[i] = (unsigned short)hw_bf(kk * ball * ib); }
            u32x2 kw; kw.x = (unsigned)kt4[0] | ((unsigned)kt4[1] << 16); kw.y = (unsigned)kt4[2] | ((unsigned)kt4[3] << 16);
            *(LAS u32x2*)(KT + d * 16 + 4 * seg) = kw;
            if (seg == 3) Lf[O_BL + d] = ball;
        }
        LBAR();
        if (w == 0) {
            f32x4 acc = {0.f, 0.f, 0.f, 0.f};
#pragma unroll
            for (int ks = 0; ks < 4; ++ks) { const bf16x8 af = *(const LAS bf16x8*)(QB + fr * RS + 32 * ks + 8 * g), bfm = *(const LAS bf16x8*)(KB + fr * RS + 32 * ks + 8 * g);
                acc = __builtin_amdgcn_mfma_f32_16x16x32_bf16(af, bfm, acc, 0, 0, 0); }
#pragma unroll
            for (int r = 0; r < 4; ++r) { const int t = 4 * g + r, s = fr; AM[t * 16 + s] = hw_bf(s <= t ? acc[r] : 0.f); }
        }
        if (c + 1 < NCHUNK) GM_XFORM((c + 1) & 1);
        if (c + 2 < NCHUNK) GM_LOAD(c + 2);
        LBAR();
        {
            u32x2 vlo; { const float v0 = B_[O_V + (4 * g + 0) * 128 + c0 + fr], v1 = B_[O_V + (4 * g + 1) * 128 + c0 + fr], v2 = B_[O_V + (4 * g + 2) * 128 + c0 + fr], v3 = B_[O_V + (4 * g + 3) * 128 + c0 + fr];
                vlo.x = hw_pk2(v0, v1); vlo.y = hw_pk2(v2, v3); }
            const u32x2 zz = {0u, 0u};
            const bf16x8 vb = mk_frag(vlo, zz);
            f32x4 acco = {0.f, 0.f, 0.f, 0.f};
#pragma unroll
            for (int ks = 0; ks < 4; ++ks) {
                u32x2 slo, shi; slo.x = hw_pk2(Sacc[2 * ks][0], Sacc[2 * ks][1]); slo.y = hw_pk2(Sacc[2 * ks][2], Sacc[2 * ks][3]); shi.x = hw_pk2(Sacc[2 * ks + 1][0], Sacc[2 * ks + 1][1]); shi.y = hw_pk2(Sacc[2 * ks + 1][2], Sacc[2 * ks + 1][3]);
                const bf16x8 sb = mk_frag(slo, shi);
                const u32x2 qlo = *(const LAS u32x2*)(QB + fr * RS + 32 * ks + 4 * g), qhi = *(const LAS u32x2*)(QB + fr * RS + 32 * ks + 16 + 4 * g);
                acco = __builtin_amdgcn_mfma_f32_16x16x32_bf16(mk_frag(qlo, qhi), sb, acco, 0, 0, 0); }
            { const u32x2 alo = *(const LAS u32x2*)(AM + fr * 16 + 4 * g); acco = __builtin_amdgcn_mfma_f32_16x16x32_bf16(mk_frag(alo, zz), vb, acco, 0, 0, 0); }
#pragma unroll
            for (int r = 0; r < 4; ++r) O[(size_t)(c * TC + 4 * g + r) * D + c0 + fr] = hw_bf(acco[r]);
#pragma unroll
            for (int i = 0; i < 8; ++i) { const f32x4 bl = *(const LAS f32x4*)(Lf + O_BL + 16 * i + 4 * g); const u32x2 klo = *(const LAS u32x2*)(KT + (16 * i + fr) * 16 + 4 * g);
                Sacc[i] = __builtin_amdgcn_mfma_f32_16x16x32_bf16(mk_frag(klo, zz), vb, Sacc[i] * bl, 0, 0, 0); }
        }
        LBAR();
    }
#undef GM_LOAD
#undef GM_XFORM
}

__device__ __forceinline__ void scan_gdn_mfma_unit(const Args& A, Frame& F, int unit, const int role) {
    int tid = F.tid; asm volatile("" : "+v"(tid));
    const int lane = tid & 63, w = F.wave;
    const int b = unit >> 3, h = unit & 7;
    const int qcol = EC_BQ + h * 128, kcol = EC_BK + h * 128, vcol = EC_BV + h * 128, ocol = 1024 + h * 128;
    const bf16* P = (const bf16*)(A.ws + WS_PROJ) + (size_t)b * SEQ * PROJ_LD;
    bf16* O = (bf16*)(A.ws + WS_O) + (size_t)b * SEQ * D + ocol;
    LAS float* Lf = (LAS float*)(F.lds + RING_OFF);
    constexpr int O_CW = 0, O_AMAT = 1536, O_QKM = O_AMAT + 256, O_TB = O_QKM + 128, O_GL = O_TB + 128, O_BUF0 = O_GL + 64;
    constexpr int BUFSZ = 6208, O_KH = 0, O_QH = 2048, O_VV = 4096, O_SC = 6144;
    constexpr int RS = 136;
    constexpr int O_KHB = O_BUF0 + 2 * BUFSZ, O_QHB = O_KHB + 1088, O_QB = O_QHB + 1088, O_KT = O_QB + 1088, O_WSRC = O_KT + 1024, O_WB = O_WSRC + 2048;
    LAS bf16* KHB = (LAS bf16*)(Lf + O_KHB); LAS bf16* QHB = (LAS bf16*)(Lf + O_QHB); LAS bf16* QB = (LAS bf16*)(Lf + O_QB); LAS bf16* KT = (LAS bf16*)(Lf + O_KT);
    LAS bf16* WB = (LAS bf16*)(Lf + O_WB); LAS bf16* QKM = (LAS bf16*)(Lf + O_QKM); LAS bf16* TB = (LAS bf16*)(Lf + O_TB);
    const int tl = tid >> 5, dq = (tid & 31) * 4;
    { const float* cw = A.in[I_GDN_CONV];
      for (int i = tid; i < 4 * 384; i += NTHREADS) { const int jt = i / 384, x = i % 384; Lf[O_CW + i] = cw[jt * 3072 + (x >> 7) * 1024 + h * 128 + (x & 127)]; } }
    const float neg_ea = -__expf(A.in[I_GDN_ALOG][h]), dtb = A.in[I_GDN_DTB][h];
    u32x2 rq[4], rk[4], rv[4]; unsigned short rba = 0, rbb = 0;
#define GD_LOAD(c) do { const int t_ = (c) * TC + tl; \
        _Pragma("unroll") for (int jt = 0; jt < 4; ++jt) { const int tt = t_ - 3 + jt; const bf16* pr = P + (size_t)(tt < 0 ? 0 : tt) * PROJ_LD + dq; \
            rq[jt] = *(const GAS u32x2*)(pr + qcol); rk[jt] = *(const GAS u32x2*)(pr + kcol); rv[jt] = *(const GAS u32x2*)(pr + vcol); \
            if (tt < 0) { rq[jt] = (u32x2){0u, 0u}; rk[jt] = (u32x2){0u, 0u}; rv[jt] = (u32x2){0u, 0u}; } } \
        { const bf16* pr = P + (size_t)t_ * PROJ_LD; rba = pr[EC_BA + h]; rbb = pr[EC_BB + h]; } } while (0)
#define GD_XFORM(bufi) do { LAS float* B_ = Lf + O_BUF0 + (bufi) * BUFSZ; f32x4 q4 = {0.f, 0.f, 0.f, 0.f}, k4 = {0.f, 0.f, 0.f, 0.f}, v4 = {0.f, 0.f, 0.f, 0.f}; \
        _Pragma("unroll") for (int jt = 0; jt < 4; ++jt) { const f32x4 wq = *(const LAS f32x4*)(Lf + O_CW + jt * 384 + dq), wk = *(const LAS f32x4*)(Lf + O_CW + jt * 384 + 128 + dq), wv = *(const LAS f32x4*)(Lf + O_CW + jt * 384 + 256 + dq); \
            q4[0] += wq[0] * bf_lo(rq[jt].x); q4[1] += wq[1] * bf_hi(rq[jt].x); q4[2] += wq[2] * bf_lo(rq[jt].y); q4[3] += wq[3] * bf_hi(rq[jt].y); \
            k4[0] += wk[0] * bf_lo(rk[jt].x); k4[1] += wk[1] * bf_hi(rk[jt].x); k4[2] += wk[2] * bf_lo(rk[jt].y); k4[3] += wk[3] * bf_hi(rk[jt].y); \
            v4[0] += wv[0] * bf_lo(rv[jt].x); v4[1] += wv[1] * bf_hi(rv[jt].x); v4[2] += wv[2] * bf_lo(rv[jt].y); v4[3] += wv[3] * bf_hi(rv[jt].y); } \
        float sq = 0.f, sk = 0.f; \
        _Pragma("unroll") for (int i_ = 0; i_ < 4; ++i_) { q4[i_] = siluf_(q4[i_]); k4[i_] = siluf_(k4[i_]); v4[i_] = siluf_(v4[i_]); sq += q4[i_] * q4[i_]; sk += k4[i_] * k4[i_]; } \
        row_sum16_x2(sq, sk); sq += __shfl_xor(sq, 16); sk += __shfl_xor(sk, 16); \
        q4 = q4 * (__builtin_amdgcn_rsqf(sq + EPS) * 0.08838834764831845f); k4 = k4 * __builtin_amdgcn_rsqf(sk + EPS); \
        *(LAS f32x4*)(B_ + O_KH + tl * 128 + dq) = k4; *(LAS f32x4*)(B_ + O_QH + tl * 128 + dq) = q4; *(LAS f32x4*)(B_ + O_VV + tl * 128 + dq) = v4; \
        if ((tid & 31) == 0) { const float ba = __uint_as_float((unsigned)rba << 16), bb = __uint_as_float((unsigned)rbb << 16); \
            B_[O_SC + tl] = __expf(neg_ea * softplusf_(ba + dtb)); B_[O_SC + 16 + tl] = sigmoidf_(bb); } } while (0)
    LBAR();
    constexpr int SPLIT = 58;
    const int c_begin = role ? SPLIT : 0, c_end = role ? NCHUNK : SPLIT;
    constexpr int REC = 5408;
    float* STASH = (float*)(A.ws + WS_LA) + (size_t)unit * (NCHUNK - SPLIT) * REC;
    float* STATE = (float*)(A.ws + WS_STATE) + (size_t)unit * 16384;
    gu32* flag = F.ctl + 32768 + unit * 64;
    GD_LOAD(c_begin); GD_XFORM(c_begin & 1); GD_LOAD(c_begin + 1);
    LBAR();
    f32x4 Sacc[8];
#pragma unroll
    for (int i = 0; i < 8; ++i) Sacc[i] = (f32x4){0.f, 0.f, 0.f, 0.f};
    const int fr = lane & 15, g = lane >> 4, c0 = w * 16;
    const u32x2 zz = {0u, 0u};
#define GD_STATE_PART(cc_) do { \
        { \
            bf16x8 sb[4]; \
_Pragma("unroll") \
            for (int ks = 0; ks < 4; ++ks) { u32x2 slo, shi; slo.x = hw_pk2(Sacc[2 * ks][0], Sacc[2 * ks][1]); slo.y = hw_pk2(Sacc[2 * ks][2], Sacc[2 * ks][3]); shi.x = hw_pk2(Sacc[2 * ks + 1][0], Sacc[2 * ks + 1][1]); shi.y = hw_pk2(Sacc[2 * ks + 1][2], Sacc[2 * ks + 1][3]); \
                sb[ks] = mk_frag(slo, shi); } \
            f32x4 accv = accu, acco = {0.f, 0.f, 0.f, 0.f}; \
_Pragma("unroll") \
            for (int ks = 0; ks < 4; ++ks) { \
                const u32x2 wl = *(const LAS u32x2*)(WB + fr * RS + 32 * ks + 4 * g), wh = *(const LAS u32x2*)(WB + fr * RS + 32 * ks + 16 + 4 * g); \
                accv = __builtin_amdgcn_mfma_f32_16x16x32_bf16(mk_frag(wl, wh), sb[ks], accv, 0, 0, 0); \
                const u32x2 ql = *(const LAS u32x2*)(QB + fr * RS + 32 * ks + 4 * g), qh = *(const LAS u32x2*)(QB + fr * RS + 32 * ks + 16 + 4 * g); \
                acco = __builtin_amdgcn_mfma_f32_16x16x32_bf16(mk_frag(ql, qh), sb[ks], acco, 0, 0, 0); } \
            u32x2 vn; vn.x = hw_pk2(accv[0], accv[1]); vn.y = hw_pk2(accv[2], accv[3]); \
            const bf16x8 vnb = mk_frag(vn, zz); \
            acco = __builtin_amdgcn_mfma_f32_16x16x32_bf16(mk_frag(*(const LAS u32x2*)(QKM + fr * 16 + 4 * g), zz), vnb, acco, 0, 0, 0); \
_Pragma("unroll") \
            for (int r = 0; r < 4; ++r) O[(size_t)((cc_) * TC + 4 * g + r) * D + c0 + fr] = hw_bf(acco[r]); \
_Pragma("unroll") \
            for (int i = 0; i < 8; ++i) { const u32x2 klo = *(const LAS u32x2*)(KT + (16 * i + fr) * 16 + 4 * g); \
                Sacc[i] = __builtin_amdgcn_mfma_f32_16x16x32_bf16(mk_frag(klo, zz), vnb, Sacc[i] * glast, 0, 0, 0); } \
        } \
        } while (0)
    for (int c = c_begin; c < c_end; ++c) {
        const LAS float* B_ = Lf + O_BUF0 + (c & 1) * BUFSZ;
        float glast;
        {
            const int seg = tid >> 7, d = tid & 127;
            const f32x4 a0 = *(const LAS f32x4*)(B_ + O_SC), a1 = *(const LAS f32x4*)(B_ + O_SC + 4), a2 = *(const LAS f32x4*)(B_ + O_SC + 8), a3 = *(const LAS f32x4*)(B_ + O_SC + 12);
            const float av[16] = {a0[0], a0[1], a0[2], a0[3], a1[0], a1[1], a1[2], a1[3], a2[0], a2[1], a2[2], a2[3], a3[0], a3[1], a3[2], a3[3]};
            float p = 1.f, gpre = 1.f;
#pragma unroll
            for (int t = 0; t < 16; ++t) { if (t == 4 * seg) gpre = p; p *= av[t]; }
            glast = p;
            unsigned short kt4[4]; float gt = gpre;
#pragma unroll
            for (int i = 0; i < 4; ++i) { const int t = 4 * seg + i; const float at = (seg == 0) ? av[i] : (seg == 1) ? av[4 + i] : (seg == 2) ? av[8 + i] : av[12 + i]; gt *= at; const float beta = B_[O_SC + 16 + t];
                const float kk = B_[O_KH + t * 128 + d], qq = B_[O_QH + t * 128 + d];
                KHB[t * RS + d] = hw_bf(kk); QHB[t * RS + d] = hw_bf(qq); QB[t * RS + d] = hw_bf(qq * gt);
                kt4[i] = (unsigned short)hw_bf(kk * glast * __builtin_amdgcn_rcpf(gt));
                Lf[O_WSRC + t * 128 + d] = kk * (beta * gt);
                if (d == 0) Lf[O_GL + t] = gt; }
            u32x2 kw; kw.x = (unsigned)kt4[0] | ((unsigned)kt4[1] << 16); kw.y = (unsigned)kt4[2] | ((unsigned)kt4[3] << 16);
            *(LAS u32x2*)(KT + d * 16 + 4 * seg) = kw;
        }
        LBAR();
        if (w < 2) {
            const LAS bf16* AS = (w == 0) ? KHB : QHB;
            f32x4 acc = {0.f, 0.f, 0.f, 0.f};
#pragma unroll
            for (int ks = 0; ks < 4; ++ks) { const bf16x8 af = *(const LAS bf16x8*)(AS + fr * RS + 32 * ks + 8 * g), bfm = *(const LAS bf16x8*)(KHB + fr * RS + 32 * ks + 8 * g);
                acc = __builtin_amdgcn_mfma_f32_16x16x32_bf16(af, bfm, acc, 0, 0, 0); }
            const float gs_inv = __builtin_amdgcn_rcpf(Lf[O_GL + fr]);
            if (w == 0) {
                f32x4 N1, M1;
#pragma unroll
                for (int r = 0; r < 4; ++r) { const int t = 4 * g + r; const float gt = Lf[O_GL + t];
                    N1[r] = (fr < t) ? -(B_[O_SC + 16 + t] * acc[r] * gt * gs_inv) : 0.f;
                    M1[r] = (t < fr) ? -(B_[O_SC + 16 + fr] * acc[r] * Lf[O_GL + fr] * __builtin_amdgcn_rcpf(gt)) : 0.f; }
#define XTY(X, Y, C0) __builtin_amdgcn_mfma_f32_16x16x32_bf16(mk_frag((u32x2){hw_pk2(X[0], X[1]), hw_pk2(X[2], X[3])}, zz), mk_frag((u32x2){hw_pk2(Y[0], Y[1]), hw_pk2(Y[2], Y[3])}, zz), C0, 0, 0, 0)
                const f32x4 z4 = {0.f, 0.f, 0.f, 0.f};
                f32x4 T1t = M1;
#pragma unroll
                for (int r = 0; r < 4; ++r) if (4 * g + r == fr) T1t[r] += 1.f;
                const f32x4 N2 = XTY(M1, N1, z4), M2 = XTY(N1, M1, z4);
                const f32x4 T2t = XTY(N2, T1t, T1t);
                const f32x4 N4 = XTY(M2, N2, z4), M4 = XTY(N2, M2, z4);
                const f32x4 T4t = XTY(N4, T2t, T2t);
                const f32x4 N8 = XTY(M4, N4, z4);
                const f32x4 T8t = XTY(N8, T4t, T4t);
#undef XTY
                u32x2 tw; tw.x = hw_pk2(T8t[0], T8t[1]); tw.y = hw_pk2(T8t[2], T8t[3]);
                *(LAS u32x2*)(TB + fr * 16 + 4 * g) = tw;
            } else {
#pragma unroll
                for (int r = 0; r < 4; ++r) { const int t = 4 * g + r; QKM[t * 16 + fr] = hw_bf((fr <= t) ? acc[r] * Lf[O_GL + t] * gs_inv : 0.f); }
            }
        }
        if (c + 1 < c_end) GD_XFORM((c + 1) & 1);
        if (c + 2 < c_end) GD_LOAD(c + 2);
        LBAR();
        f32x4 accu = {0.f, 0.f, 0.f, 0.f};
        {
            const bf16x8 tf = mk_frag(*(const LAS u32x2*)(TB + fr * 16 + 4 * g), zz);
            u32x2 ulo, wlo;
            { const float b0 = B_[O_SC + 16 + 4 * g + 0], b1 = B_[O_SC + 16 + 4 * g + 1], b2 = B_[O_SC + 16 + 4 * g + 2], b3 = B_[O_SC + 16 + 4 * g + 3];
              ulo.x = hw_pk2(b0 * B_[O_VV + (4 * g + 0) * 128 + c0 + fr], b1 * B_[O_VV + (4 * g + 1) * 128 + c0 + fr]); ulo.y = hw_pk2(b2 * B_[O_VV + (4 * g + 2) * 128 + c0 + fr], b3 * B_[O_VV + (4 * g + 3) * 128 + c0 + fr]);
              wlo.x = hw_pk2(Lf[O_WSRC + (4 * g + 0) * 128 + c0 + fr], Lf[O_WSRC + (4 * g + 1) * 128 + c0 + fr]); wlo.y = hw_pk2(Lf[O_WSRC + (4 * g + 2) * 128 + c0 + fr], Lf[O_WSRC + (4 * g + 3) * 128 + c0 + fr]); }
            accu = __builtin_amdgcn_mfma_f32_16x16x32_bf16(tf, mk_frag(ulo, zz), accu, 0, 0, 0);
            f32x4 accw = {0.f, 0.f, 0.f, 0.f};
            accw = __builtin_amdgcn_mfma_f32_16x16x32_bf16(tf, mk_frag(wlo, zz), accw, 0, 0, 0);
#pragma unroll
            for (int r = 0; r < 4; ++r) WB[(4 * g + r) * RS + c0 + fr] = hw_bf(-accw[r]);
        }
        LBAR();
        if (role == 0) {
            GD_STATE_PART(c);
        } else {
            float* rec = STASH + (size_t)(c - c_begin) * REC;
            for (int i = tid; i < 832; i += NTHREADS) { const int o = i < 528 ? O_QB + 4 * i : (i < 800 ? O_WB + 4 * (i - 528) : O_QKM + 4 * (i - 800)); *(GAS f32x4*)(rec + 4 * i) = *(const LAS f32x4*)(Lf + o); }
#pragma unroll
            for (int r = 0; r < 4; ++r) rec[3328 + (w * 4 + r) * 64 + lane] = accu[r];
            if (tid == 0) rec[5376] = glast;
        }
        LBAR();
    }
    if (role == 0) {
#pragma unroll
        for (int i = 0; i < 8; ++i)
#pragma unroll
            for (int r = 0; r < 4; ++r) STATE[((w * 8 + i) * 4 + r) * 64 + lane] = Sacc[i][r];
        asm volatile("s_waitcnt vmcnt(0)" ::: "memory");
        __syncthreads();
        if (tid == 0) { __builtin_amdgcn_fence(__ATOMIC_RELEASE, "agent"); asm volatile("s_waitcnt vmcnt(0)" ::: "memory"); __hip_atomic_store(flag, 1u, __ATOMIC_RELAXED, __HIP_MEMORY_SCOPE_AGENT); }
    } else {
        if (tid == 0) { unsigned sp = 0; while (__hip_atomic_load(flag, __ATOMIC_RELAXED, __HIP_MEMORY_SCOPE_AGENT) == 0u) { __builtin_amdgcn_s_sleep(8); if (++sp > (1u << 22)) break; }
            __builtin_amdgcn_fence(__ATOMIC_ACQUIRE, "agent"); asm volatile("s_waitcnt vmcnt(0)" ::: "memory"); }
        __syncthreads();
#pragma unroll
        for (int i = 0; i < 8; ++i)
#pragma unroll
            for (int r = 0; r < 4; ++r) Sacc[i][r] = STATE[((w * 8 + i) * 4 + r) * 64 + lane];
        f32x4 pa, pb; f32x4 pu; float pg;
#define GD_REC_LOAD(cc) do { const float* rec = STASH + (size_t)((cc) - c_begin) * REC; pa = *(const GAS f32x4*)(rec + 4 * tid); pb = (tid < 320) ? *(const GAS f32x4*)(rec + 4 * (tid + 512)) : (f32x4){0.f, 0.f, 0.f, 0.f}; \
            _Pragma("unroll") for (int r = 0; r < 4; ++r) pu[r] = rec[3328 + (w * 4 + r) * 64 + lane]; pg = rec[5376]; } while (0)
        GD_REC_LOAD(c_begin);
        for (int c = c_begin; c < c_end; ++c) {
            { const int i0 = tid, o0 = i0 < 528 ? O_QB + 4 * i0 : O_WB + 4 * (i0 - 528); *(LAS f32x4*)(Lf + o0) = pa;
              if (tid < 320) { const int i1 = tid + 512; const int o1 = i1 < 528 ? O_QB + 4 * i1 : (i1 < 800 ? O_WB + 4 * (i1 - 528) : O_QKM + 4 * (i1 - 800)); *(LAS f32x4*)(Lf + o1) = pb; } }
            const f32x4 accu = pu; const float glast = pg;
            if (c + 1 < c_end) GD_REC_LOAD(c + 1);
            LBAR();
            GD_STATE_PART(c);
            LBAR();
        }
#undef GD_REC_LOAD
    }
#undef GD_STATE_PART
#undef GD_LOAD
#undef GD_XFORM
}

__device__ __forceinline__ void scan_rwkv_unit(const Args& A, Frame& F, int unit) {
    int tid = F.tid; asm volatile("" : "+v"(tid));
    const int lane = tid & 63, w = F.wave;
    const int b = unit >> 4, h = unit & 15;
    const bf16* P = (const bf16*)(A.ws + WS_PROJ) + (size_t)b * SEQ * PROJ_LD + OC_RW;
    const bf16* LO = (const bf16*)(A.ws + WS_LO) + (size_t)b * SEQ * LORA_N;
    bf16* Y = (bf16*)(A.ws + WS_ACTA) + (size_t)b * SEQ * D + 1024 + h * 64;
    LAS float* Lf = (LAS float*)(F.lds + RING_OFF);
    constexpr int BUFSZ = 6208, O_KK = 0, O_WR = 1024, O_W = 2048, O_NKA = 3072, O_K = 4096, O_V = 5120, O_SC = 6144, O_OUT = 2 * BUFSZ;
    const int tl = tid >> 5, d2 = (tid & 31) * 2, hd = h * 64 + d2;
    float mu_r[2], mu_k[2], mu_v[2], w0[2], a0[2], k_k[2], k_a[2], r_k[2], lnw[2], lnb[2];
#pragma unroll
    for (int i = 0; i < 2; ++i) { mu_r[i] = A.in[I_MU][RW_R + hd + i]; mu_k[i] = A.in[I_MU][RW_K + hd + i]; mu_v[i] = A.in[I_MU][RW_V + hd + i];
        w0[i] = A.in[I_W0][hd + i]; a0[i] = A.in[I_A0][hd + i]; k_k[i] = A.in[I_KK][hd + i]; k_a[i] = A.in[I_KA][hd + i]; r_k[i] = A.in[I_RK][hd + i];
        lnw[i] = A.in[I_LNW][hd + i]; lnb[i] = A.in[I_LNB][hd + i]; }
    unsigned rr[2], rk[2], rv[2], rlw, rla, rg_cur = 0u, rg_nxt = 0u;
#define RW_LOAD(c) do { const int t_ = (c) * TC + tl; const bf16* pr = P + (size_t)t_ * PROJ_LD; \
        rr[0] = *(const GAS unsigned*)(pr + RW_R + hd); rk[0] = *(const GAS unsigned*)(pr + RW_K + hd); rv[0] = *(const GAS unsigned*)(pr + RW_V + hd); \
        if (t_ > 0) { rr[1] = *(const GAS unsigned*)(pr - PROJ_LD + RW_R + hd); rk[1] = *(const GAS unsigned*)(pr - PROJ_LD + RW_K + hd); rv[1] = *(const GAS unsigned*)(pr - PROJ_LD + RW_V + hd); } \
        else { rr[1] = 0u; rk[1] = 0u; rv[1] = 0u; } \
        const bf16* lr = LO + (size_t)t_ * LORA_N; rlw = *(const GAS unsigned*)(lr + hd); rla = *(const GAS unsigned*)(lr + 1024 + hd); rg_nxt = *(const GAS unsigned*)(lr + 2048 + hd); } while (0)
#define RW_XFORM(bufi) do { LAS float* B_ = Lf + (bufi) * BUFSZ; f32x2 kk2, wr2, w2_, nka2, k2, v2_; float skk = 0.f, sc1 = 0.f, sc2 = 0.f, sbs = 0.f; float aa[2], rrv[2]; \
        _Pragma("unroll") for (int i_ = 0; i_ < 2; ++i_) { \
            const float r0 = i_ ? bf_hi(rr[0]) : bf_lo(rr[0]), r1 = i_ ? bf_hi(rr[1]) : bf_lo(rr[1]); \
            const float k0_ = i_ ? bf_hi(rk[0]) : bf_lo(rk[0]), k1_ = i_ ? bf_hi(rk[1]) : bf_lo(rk[1]); \
            const float v0_ = i_ ? bf_hi(rv[0]) : bf_lo(rv[0]), v1_ = i_ ? bf_hi(rv[1]) : bf_lo(rv[1]); \
            const float lw = i_ ? bf_hi(rlw) : bf_lo(rlw), la = i_ ? bf_hi(rla) : bf_lo(rla); \
            const float r_ = r0 + (r1 - r0) * mu_r[i_], kx = k0_ + (k1_ - k0_) * mu_k[i_], vx = v0_ + (v1_ - v0_) * mu_v[i_]; \
            const float wd = __expf(-0.6065306597126334f * sigmoidf_(w0[i_] + lw)); const float a_ = sigmoidf_(a0[i_] + la); \
            const float kk0 = kx * k_k[i_]; const float km = kx * (1.f + (a_ - 1.f) * k_a[i_]); \
            kk2[i_] = kk0; skk += kk0 * kk0; aa[i_] = a_; rrv[i_] = r_; wr2[i_] = wd * r_; w2_[i_] = wd; k2[i_] = km; v2_[i_] = vx; sc2 += km * r_; sbs += r_ * km * r_k[i_]; } \
        skk = half_sum32(skk); const float rkk = __builtin_amdgcn_rsqf(skk + EPS); \
        _Pragma("unroll") for (int i_ = 0; i_ < 2; ++i_) { kk2[i_] *= rkk; nka2[i_] = -(kk2[i_] * aa[i_]); sc1 += kk2[i_] * aa[i_] * rrv[i_]; } \
        sc1 = half_sum32(sc1); sc2 = half_sum32(sc2); sbs = half_sum32(sbs); \
        *(LAS f32x2*)(B_ + O_KK + tl * 64 + d2) = kk2; *(LAS f32x2*)(B_ + O_WR + tl * 64 + d2) = wr2; *(LAS f32x2*)(B_ + O_W + tl * 64 + d2) = w2_; \
        *(LAS f32x2*)(B_ + O_NKA + tl * 64 + d2) = nka2; *(LAS f32x2*)(B_ + O_K + tl * 64 + d2) = k2; *(LAS f32x2*)(B_ + O_V + tl * 64 + d2) = v2_; \
        if ((tid & 31) == 0) { f32x4 sc; sc[0] = sc1; sc[1] = sc2; sc[2] = sbs; sc[3] = 0.f; *(LAS f32x4*)(B_ + O_SC + tl * 4) = sc; } } while (0)
    RW_LOAD(0); RW_XFORM(0); rg_cur = rg_nxt;
    LBAR();
    f32x2 S2[4];
#pragma unroll
    for (int i = 0; i < 4; ++i) S2[i] = (f32x2){0.f, 0.f};
    const int j = lane & 15, col = w * 8 + (lane >> 4) * 2;
    for (int c = 0; c < NCHUNK; ++c) {
        if (c + 1 < NCHUNK) RW_LOAD(c + 1);
        const LAS float* B_ = Lf + (c & 1) * BUFSZ;
        float os0 = 0.f, os1 = 0.f;
        f32x4 kk, wr, ww, nka, kv, sc, nkk, nwr, nww, nnka, nkv, nsc; f32x2 v2, nv2;
#define RW_LDSTEP(t_, KK, WR, WW, NKA, KV, V2, SC) do { KK = *(const LAS f32x4*)(B_ + O_KK + (t_) * 64 + 4 * j); WR = *(const LAS f32x4*)(B_ + O_WR + (t_) * 64 + 4 * j); WW = *(const LAS f32x4*)(B_ + O_W + (t_) * 64 + 4 * j); \
            NKA = *(const LAS f32x4*)(B_ + O_NKA + (t_) * 64 + 4 * j); KV = *(const LAS f32x4*)(B_ + O_K + (t_) * 64 + 4 * j); V2 = *(const LAS f32x2*)(B_ + O_V + (t_) * 64 + col); SC = *(const LAS f32x4*)(B_ + O_SC + (t_) * 4); } while (0)
        RW_LDSTEP(0, kk, wr, ww, nka, kv, v2, sc);
#pragma unroll
        for (int t = 0; t < TC; ++t) {
            if (t + 1 < TC) { RW_LDSTEP(t + 1, nkk, nwr, nww, nnka, nkv, nv2, nsc); }
            __builtin_amdgcn_sched_barrier(0);
            f32x2 d1 = S2[0] * kk[0], d2 = S2[0] * wr[0], e1 = S2[1] * kk[1], e2 = S2[1] * wr[1];
            d1 += S2[2] * kk[2]; d2 += S2[2] * wr[2]; e1 += S2[3] * kk[3]; e2 += S2[3] * wr[3];
            d1 += e1; d2 += e2;
            { float r0_ = d1[0], r1_ = d1[1], r2_ = d2[0], r3_ = d2[1]; row_sum16_x4(r0_, r1_, r2_, r3_); d1[0] = r0_; d1[1] = r1_; d2[0] = r2_; d2[1] = r3_; }
            const f32x2 o2 = d2 - d1 * sc[0] + v2 * sc[1];
#pragma unroll
            for (int i = 0; i < 4; ++i) S2[i] = S2[i] * ww[i] + d1 * nka[i] + v2 * kv[i];
            os0 = (j == t) ? o2[0] : os0; os1 = (j == t) ? o2[1] : os1;
            kk = nkk; wr = nwr; ww = nww; nka = nnka; kv = nkv; v2 = nv2; sc = nsc;
        }
#undef RW_LDSTEP
        { f32x2 o2 = {os0, os1}; *(LAS f32x2*)(Lf + O_OUT + j * 64 + col) = o2; }
        if (c + 1 < NCHUNK) RW_XFORM((c + 1) & 1);
        LBAR();
        {
            const f32x2 o2 = *(const LAS f32x2*)(Lf + O_OUT + tl * 64 + d2); const f32x2 vv = *(const LAS f32x2*)(B_ + O_V + tl * 64 + d2); const float bs = B_[O_SC + tl * 4 + 2];
            const float mean = half_sum32(o2[0] + o2[1]) * (1.0f / 64.0f); const float e0 = o2[0] - mean, e1 = o2[1] - mean;
            const float var = half_sum32(e0 * e0 + e1 * e1) * (1.0f / 64.0f); const float rs = __builtin_amdgcn_rsqf(var + 64e-5f);
            const float y0 = (e0 * rs * lnw[0] + lnb[0] + bs * vv[0]) * bf_lo(rg_cur), y1 = (e1 * rs * lnw[1] + lnb[1] + bs * vv[1]) * bf_hi(rg_cur);
            *(GAS unsigned*)(Y + (size_t)(c * TC + tl) * D + d2) = pk2(y0, y1);
        }
        rg_cur = rg_nxt;
        LBAR();
    }
#undef RW_LOAD
#undef RW_XFORM
}

template <int LAYER>
__device__ __forceinline__ void post_rows(const Args& A, Frame& F) {
    const int gw = F.vcu * NWAVES + F.wave, NGW = F.G * NWAVES, lane = F.lane;
    const bf16* O = (const bf16*)(A.ws + WS_O); const bf16* P = (const bf16*)(A.ws + WS_PROJ); bf16* Y = (bf16*)(A.ws + WS_ACTA);
    for (int m = gw; m < T; m += NGW) {
        const GAS u32x2* orow = (const GAS u32x2*)(O + (size_t)m * D) + lane; const bf16* prow = P + (size_t)m * PROJ_LD;
        constexpr int NJ = LAYER == 0 ? 8 : 4;
#pragma unroll
        for (int jj = 0; jj < NJ; ++jj) {
            const u32x2 ow_ = orow[64 * jj]; const f32x4 v = {bf_lo(ow_.x), bf_hi(ow_.x), bf_lo(ow_.y), bf_hi(ow_.y)}; float ss = (v[0] * v[0] + v[1] * v[1]) + (v[2] * v[2] + v[3] * v[3]);
            const bool wide = (LAYER == 0 && jj < 4);
            const float ms = wide ? wave_sum(ss) * (1.0f / 256.0f) : half_sum32(ss) * (1.0f / 128.0f);
            const float r = __builtin_amdgcn_rsqf(ms + EPS);
            const int cih = wide ? 4 * lane : 4 * (lane & 31);
            const float* gsrc = LAYER == 0 ? (wide ? A.in[I_GLA_NORM] : A.in[I_GDN_NORM]) : A.in[I_HG_NORM];
            const f32x4 g = *(const GAS f32x4*)(gsrc + cih);
            const int zcol = LAYER == 0 ? (wide ? EC_GZ + jj * 256 + 4 * lane : EC_BZ + (jj - 4) * 256 + 4 * lane) : OC_HG + jj * 256 + 4 * lane;
            const u32x2 zw = *(const GAS u32x2*)(prow + zcol);
            const float y0 = v[0] * r * g[0] * siluf_(bf_lo(zw.x)), y1 = v[1] * r * g[1] * siluf_(bf_hi(zw.x)), y2 = v[2] * r * g[2] * siluf_(bf_lo(zw.y)), y3 = v[3] * r * g[3] * siluf_(bf_hi(zw.y));
            if constexpr (LAYER == 1) { int o8 = __builtin_amdgcn_cvt_pk_fp8_f32(y0, y1, 0, false); o8 = __builtin_amdgcn_cvt_pk_fp8_f32(y2, y3, o8, true);
                *(GAS unsigned*)((unsigned char*)Y + (size_t)m * D + 256 * jj + 4 * lane) = (unsigned)o8; }
            else { u32x2 o; o.x = pk2(y0, y1); o.y = pk2(y2, y3);
                *(GAS u32x2*)(Y + (size_t)m * D + 256 * jj + 4 * lane) = o; }
        }
    }
}
__device__ __forceinline__ void lora_prep_rows(const Args& A, Frame& F) {
    const int gw = F.vcu * NWAVES + F.wave, NGW = F.G * NWAVES, lane = F.lane;
    const bf16* P = (const bf16*)(A.ws + WS_PROJ); bf16* LA = (bf16*)(A.ws + WS_LA); const float* mu = A.in[I_MU];
    for (int m = gw; m < T; m += NGW) { const bool hasprev = (m % SEQ) != 0; const bf16* prow = P + (size_t)m * PROJ_LD + OC_RW + RW_WL;
#pragma unroll
        for (int i = 0; i < 7; ++i) { const int c = lane + 64 * i;
            const float x = __uint_as_float((unsigned)prow[c] << 16), xp = hasprev ? __uint_as_float((unsigned)prow[c - PROJ_LD] << 16) : 0.f;
            const float ts = x + (xp - x) * mu[RW_WL + c];
            const float v = c < 96 ? tanhf(ts) : (c < 192 ? ts : sigmoidf_(ts));
            LA[(size_t)m * LORA_K + c] = (bf16)f2bf(v); }
        LA[(size_t)m * LORA_K + 448 + lane] = (bf16)0; }
}
__device__ __forceinline__ void final_rows(const Args& A, Frame& F, const float oscale, const bf16* Hs) {
    const int gw = F.vcu * NWAVES + F.wave, NGW = F.G * NWAVES, lane = F.lane;
    const float* rowss = (const float*)(A.ws + WS_RSP) + (size_t)RS_FINAL * T * 32; const GAS f32x4* g = (const GAS f32x4*)A.in[I_NFINAL] + lane;
    for (int m = gw; m < T; m += NGW) { const float r = oscale * __builtin_amdgcn_rsqf(wave_sum(lane < 32 ? rowss[(size_t)m * 32 + lane] : 0.f) * (1.0f / D) + EPS); GAS f32x4* row = (GAS f32x4*)(A.out + (size_t)m * D) + lane;
        const GAS u32x2* hrow = (const GAS u32x2*)(Hs + (size_t)m * D) + lane;
#pragma unroll
        for (int jj = 0; jj < 8; ++jj) { const u32x2 hw = hrow[64 * jj]; const f32x4 v = {bf_lo(hw.x), bf_hi(hw.x), bf_lo(hw.y), bf_hi(hw.y)}; row[64 * jj] = v * r * g[64 * jj]; } }
}

__device__ __forceinline__ void scan_rwkv_mfma_unit(const Args& A, Frame& F, int unit, const int role) {
    int tid = F.tid; asm volatile("" : "+v"(tid));
    const int lane = tid & 63, w = F.wave;
    const int b = unit >> 3, hp = unit & 7;
    const bf16* P = (const bf16*)(A.ws + WS_PROJ) + (size_t)b * SEQ * PROJ_LD + OC_RW;
    const bf16* LO = (const bf16*)(A.ws + WS_LO) + (size_t)b * SEQ * LORA_N;
    unsigned char* Y = (unsigned char*)(A.ws + WS_ACTA) + (size_t)b * SEQ * D + 1024;
    LAS float* Lf = (LAS float*)(F.lds + RING_OFF);
    constexpr int RS = 72;
    constexpr int O_CONST = 0;
    constexpr int O_XF = 1280;
    constexpr int O_VV = O_XF + 2 * 5 * 1024;
    constexpr int O_BS = O_VV + 4 * 1024;
    constexpr int O_IMG = O_BS + 64;
    constexpr int I_CT = 0, I_BT = 576, I_KL = 1152, I_RT = 1728, I_CF = 2304, I_BTT = 3328, I_KTT = 3840, I_WCB = 4352, I_G1B = 4928, I_TTB = 5056, I_RKB = 5184, I_RBB = 5312, I_W15 = 5440, I_OUT = 5504, IMGSZ = 6528;
    static_assert((O_IMG + 2 * IMGSZ) * 4 <= RING_BYTES, "rwkv lds");
    for (int i = tid; i < 1280; i += NTHREADS) { const int arr = i >> 7, ch = hp * 128 + (i & 127); float v;
        switch (arr) { case 0: v = A.in[I_MU][RW_R + ch]; break; case 1: v = A.in[I_MU][RW_K + ch]; break; case 2: v = A.in[I_MU][RW_V + ch]; break; case 3: v = A.in[I_W0][ch]; break; case 4: v = A.in[I_A0][ch]; break;
                       case 5: v = A.in[I_KK][ch]; break; case 6: v = A.in[I_KA][ch]; break; case 7: v = A.in[I_RK][ch]; break; case 8: v = A.in[I_LNW][ch]; break; default: v = A.in[I_LNB][ch]; break; }
        Lf[O_CONST + i] = v; }
    const int hx = tid >> 8, tl = (tid >> 4) & 15, d4 = (tid & 15) * 4, ch4 = hx * 64 + d4, col4 = hp * 128 + ch4;
    u32x2 rr[2], rk[2], rv[2], rlw, rla, rg_cur = {0u, 0u}, rg_nxt = {0u, 0u}, rg_far = {0u, 0u};
#define RM_LOAD(c) do { const int t_ = (c) * TC + tl; const bf16* pr = P + (size_t)t_ * PROJ_LD + col4; \
        rr[0] = *(const GAS u32x2*)(pr + RW_R); rk[0] = *(const GAS u32x2*)(pr + RW_K); rv[0] = *(const GAS u32x2*)(pr + RW_V); \
        const bf16* pp_ = (t_ > 0) ? pr - PROJ_LD : pr; rr[1] = *(const GAS u32x2*)(pp_ + RW_R); rk[1] = *(const GAS u32x2*)(pp_ + RW_K); rv[1] = *(const GAS u32x2*)(pp_ + RW_V); \
        if (t_ == 0) { rr[1] = (u32x2){0u, 0u}; rk[1] = (u32x2){0u, 0u}; rv[1] = (u32x2){0u, 0u}; } \
        const bf16* lr = LO + (size_t)t_ * LORA_N + col4; rlw = *(const GAS u32x2*)(lr); rla = *(const GAS u32x2*)(lr + 1024); rg_far = *(const GAS u32x2*)(lr + 2048); } while (0)
#define RM_XFORM(bufi) do { LAS float* X_ = Lf + O_XF + hx * 5 * 1024 + tl * 64 + d4; \
        const f32x4 mur = *(const LAS f32x4*)(Lf + O_CONST + 0 * 128 + ch4), muk = *(const LAS f32x4*)(Lf + O_CONST + 1 * 128 + ch4), muv = *(const LAS f32x4*)(Lf + O_CONST + 2 * 128 + ch4); \
        const f32x4 w0_ = *(const LAS f32x4*)(Lf + O_CONST + 3 * 128 + ch4), a0_ = *(const LAS f32x4*)(Lf + O_CONST + 4 * 128 + ch4), kk_ = *(const LAS f32x4*)(Lf + O_CONST + 5 * 128 + ch4); \
        const f32x4 ka_ = *(const LAS f32x4*)(Lf + O_CONST + 6 * 128 + ch4), rk_ = *(const LAS f32x4*)(Lf + O_CONST + 7 * 128 + ch4); \
        const float r0[4] = {bf_lo(rr[0].x), bf_hi(rr[0].x), bf_lo(rr[0].y), bf_hi(rr[0].y)}, r1[4] = {bf_lo(rr[1].x), bf_hi(rr[1].x), bf_lo(rr[1].y), bf_hi(rr[1].y)}; \
        const float k0[4] = {bf_lo(rk[0].x), bf_hi(rk[0].x), bf_lo(rk[0].y), bf_hi(rk[0].y)}, k1[4] = {bf_lo(rk[1].x), bf_hi(rk[1].x), bf_lo(rk[1].y), bf_hi(rk[1].y)}; \
        const float v0[4] = {bf_lo(rv[0].x), bf_hi(rv[0].x), bf_lo(rv[0].y), bf_hi(rv[0].y)}, v1[4] = {bf_lo(rv[1].x), bf_hi(rv[1].x), bf_lo(rv[1].y), bf_hi(rv[1].y)}; \
        const float lw[4] = {bf_lo(rlw.x), bf_hi(rlw.x), bf_lo(rlw.y), bf_hi(rlw.y)}, la[4] = {bf_lo(rla.x), bf_hi(rla.x), bf_lo(rla.y), bf_hi(rla.y)}; \
        f32x4 r4, w4, k4, v4, kk4, b4; float skk = 0.f, sbs = 0.f; float aa[4]; \
        _Pragma("unroll") for (int i_ = 0; i_ < 4; ++i_) { const float r_ = r0[i_] + (r1[i_] - r0[i_]) * mur[i_], kx = k0[i_] + (k1[i_] - k0[i_]) * muk[i_], vx = v0[i_] + (v1[i_] - v0[i_]) * muv[i_]; \
            const float wd = __expf(-0.6065306597126334f * sigmoidf_(w0_[i_] + lw[i_])); const float a_ = sigmoidf_(a0_[i_] + la[i_]); \
            const float kk0 = kx * kk_[i_], km = kx * (1.f + (a_ - 1.f) * ka_[i_]); \
            r4[i_] = r_; w4[i_] = wd; k4[i_] = km; v4[i_] = vx; kk4[i_] = kk0; aa[i_] = a_; skk += kk0 * kk0; sbs += r_ * km * rk_[i_]; } \
        row_sum16_x2(skk, sbs); const float rkk = __builtin_amdgcn_rsqf(skk + EPS); \
        _Pragma("unroll") for (int i_ = 0; i_ < 4; ++i_) { kk4[i_] *= rkk; b4[i_] = kk4[i_] * aa[i_]; } \
        *(LAS f32x4*)(X_) = r4; *(LAS f32x4*)(X_ + 1024) = w4; *(LAS f32x4*)(X_ + 2048) = k4; *(LAS f32x4*)(X_ + 3072) = kk4; *(LAS f32x4*)(X_ + 4096) = b4; \
        *(LAS f32x4*)(Lf + O_VV + ((bufi) * 2 + hx) * 1024 + tl * 64 + d4) = v4; \
        if ((tid & 15) == 0) Lf[O_BS + ((bufi) * 2 + hx) * 16 + tl] = sbs; } while (0)
    constexpr int SPLIT = 60;
    const int c_begin = role ? SPLIT : 0, c_end = role ? NCHUNK : SPLIT;
    constexpr int REC = 7584;
    float* STASH = (float*)(A.ws + (unit < 32 ? WS_WEV_IN : WS_END)) + (size_t)(unit & 31) * (NCHUNK - SPLIT) * REC;
    float* STATE = (float*)(A.ws + WS_STATE + 4 * MiB) + (size_t)unit * 8192;
    gu32* flag = F.ctl + 49152 + unit * 64;
    LBAR();
    RM_LOAD(c_begin); RM_XFORM(c_begin & 1); rg_cur = rg_far; RM_LOAD(c_begin + 1); rg_nxt = rg_far;
    LBAR();
    f32x4 Macc[4];
#pragma unroll
    for (int i = 0; i < 4; ++i) Macc[i] = (f32x4){0.f, 0.f, 0.f, 0.f};
    const int fr = lane & 15, g = lane >> 4, hh = w >> 2, ww = w & 3, c0 = ww * 16;
    LAS float* IM = Lf + O_IMG + hh * IMGSZ;
    LAS bf16* CT = (LAS bf16*)(IM + I_CT); LAS bf16* BT = (LAS bf16*)(IM + I_BT); LAS bf16* KL = (LAS bf16*)(IM + I_KL); LAS bf16* RT = (LAS bf16*)(IM + I_RT);
    LAS bf16* BTT = (LAS bf16*)(IM + I_BTT); LAS bf16* KTT = (LAS bf16*)(IM + I_KTT); LAS bf16* WCB = (LAS bf16*)(IM + I_WCB);
    LAS bf16* G1B = (LAS bf16*)(IM + I_G1B); LAS bf16* TTB = (LAS bf16*)(IM + I_TTB); LAS bf16* RKB = (LAS bf16*)(IM + I_RKB); LAS bf16* RBB = (LAS bf16*)(IM + I_RBB);
    const u32x2 zz = {0u, 0u};
#define RM_STATE_PART(vb) do { \
        { \
            bf16x8 mb[2]; \
_Pragma("unroll") \
            for (int ks = 0; ks < 2; ++ks) { u32x2 slo, shi; slo.x = hw_pk2(Macc[2 * ks][0], Macc[2 * ks][1]); slo.y = hw_pk2(Macc[2 * ks][2], Macc[2 * ks][3]); shi.x = hw_pk2(Macc[2 * ks + 1][0], Macc[2 * ks + 1][1]); shi.y = hw_pk2(Macc[2 * ks + 1][2], Macc[2 * ks + 1][3]); \
                mb[ks] = mk_frag(slo, shi); } \
            f32x4 accR = accU, acco = {0.f, 0.f, 0.f, 0.f}; \
_Pragma("unroll") \
            for (int ks = 0; ks < 2; ++ks) { \
                accR = __builtin_amdgcn_mfma_f32_16x16x32_bf16(mk_frag(*(const LAS u32x2*)(WCB + fr * RS + 32 * ks + 4 * g), *(const LAS u32x2*)(WCB + fr * RS + 32 * ks + 16 + 4 * g)), mb[ks], accR, 0, 0, 0); \
                acco = __builtin_amdgcn_mfma_f32_16x16x32_bf16(mk_frag(*(const LAS u32x2*)(RT + fr * RS + 32 * ks + 4 * g), *(const LAS u32x2*)(RT + fr * RS + 32 * ks + 16 + 4 * g)), mb[ks], acco, 0, 0, 0); } \
            u32x2 rn; rn.x = hw_pk2(accR[0], accR[1]); rn.y = hw_pk2(accR[2], accR[3]); \
            const bf16x8 rb = mk_frag(rn, zz); \
            acco = __builtin_amdgcn_mfma_f32_16x16x32_bf16(mk_frag(*(const LAS u32x2*)(RKB + fr * 16 + 4 * g), zz), vb, acco, 0, 0, 0); \
            acco = __builtin_amdgcn_mfma_f32_16x16x32_bf16(mk_frag(*(const LAS u32x2*)(RBB + fr * 16 + 4 * g), zz), rb, acco, 0, 0, 0); \
_Pragma("unroll") \
            for (int r = 0; r < 4; ++r) IM[I_OUT + (4 * g + r) * 64 + c0 + fr] = acco[r]; \
_Pragma("unroll") \
            for (int i = 0; i < 4; ++i) { const f32x4 w15 = *(const LAS f32x4*)(IM + I_W15 + 16 * i + 4 * g); \
                f32x4 m = __builtin_amdgcn_mfma_f32_16x16x32_bf16(mk_frag(*(const LAS u32x2*)(KTT + (16 * i + fr) * 16 + 4 * g), zz), vb, Macc[i], 0, 0, 0); \
                m = __builtin_amdgcn_mfma_f32_16x16x32_bf16(mk_frag(*(const LAS u32x2*)(BTT + (16 * i + fr) * 16 + 4 * g), zz), rb, m, 0, 0, 0); \
                Macc[i] = m * w15; } \
        } \
        } while (0)
#define RM_FLUSH(cc_, gb_, vv_, bs_) do { \
        { \
            const f32x4 o4 = *(const LAS f32x4*)(Lf + O_IMG + hx * IMGSZ + I_OUT + tl * 64 + d4); const f32x4 vv = (vv_); const float bs = (bs_); \
            const f32x4 lnw = *(const LAS f32x4*)(Lf + O_CONST + 8 * 128 + ch4), lnb = *(const LAS f32x4*)(Lf + O_CONST + 9 * 128 + ch4); \
            float sm = (o4[0] + o4[1]) + (o4[2] + o4[3]), dummy = 0.f; row_sum16_x2(sm, dummy); const float mean = sm * (1.0f / 64.0f); \
            const f32x4 e4 = o4 - mean; float sv = (e4[0] * e4[0] + e4[1] * e4[1]) + (e4[2] * e4[2] + e4[3] * e4[3]); row_sum16_x2(sv, dummy); const float rs = __builtin_amdgcn_rsqf(sv * (1.0f / 64.0f) + 64e-5f); \
            const float gg[4] = {bf_lo((gb_).x), bf_hi((gb_).x), bf_lo((gb_).y), bf_hi((gb_).y)}; \
            float y[4]; \
_Pragma("unroll") \
            for (int i = 0; i < 4; ++i) y[i] = (e4[i] * rs * lnw[i] + lnb[i] + bs * vv[i]) * gg[i]; \
            int o8 = __builtin_amdgcn_cvt_pk_fp8_f32(y[0], y[1], 0, false); o8 = __builtin_amdgcn_cvt_pk_fp8_f32(y[2], y[3], o8, true); \
            *(GAS unsigned*)(Y + (size_t)((cc_) * TC + tl) * D + col4) = (unsigned)o8; \
        } \
        } while (0)
    for (int c = c_begin; c < c_end; ++c) {
        {
            const int hq = tid >> 8, seg = (tid >> 6) & 3, d = tid & 63;
            const LAS float* X_ = Lf + O_XF + hq * 5 * 1024 + d; LAS float* IQ = Lf + O_IMG + hq * IMGSZ;
            LAS bf16* CTq = (LAS bf16*)(IQ + I_CT); LAS bf16* BTq = (LAS bf16*)(IQ + I_BT); LAS bf16* KLq = (LAS bf16*)(IQ + I_KL); LAS bf16* RTq = (LAS bf16*)(IQ + I_RT);
            float wall = 1.f, wpre = 1.f;
#pragma unroll
            for (int t = 0; t < 16; ++t) { if (t == 4 * seg) wpre = wall; wall *= X_[1024 + t * 64]; }
            float wt = wpre; unsigned short bt4[4], kt4[4];
#pragma unroll
            for (int i = 0; i < 4; ++i) { const int t = 4 * seg + i; const float wprev = wt; wt *= X_[1024 + t * 64]; const float iw = __builtin_amdgcn_rcpf(wt);
                const float r_ = X_[t * 64], k_ = X_[2048 + t * 64], kk_ = X_[3072 + t * 64], b_ = X_[4096 + t * 64];
                const float ct = kk_ * wprev, bt = b_ * iw, kt = k_ * iw;
                CTq[t * RS + d] = hw_bf(ct); IQ[I_CF + t * 64 + d] = ct; BTq[t * RS + d] = hw_bf(bt); KLq[t * RS + d] = hw_bf(kt); RTq[t * RS + d] = hw_bf(r_ * wt);
                bt4[i] = (unsigned short)hw_bf(-bt); kt4[i] = (unsigned short)hw_bf(kt); }
            u32x2 o; o.x = (unsigned)bt4[0] | ((unsigned)bt4[1] << 16); o.y = (unsigned)bt4[2] | ((unsigned)bt4[3] << 16); *(LAS u32x2*)((LAS bf16*)(IQ + I_BTT) + d * 16 + 4 * seg) = o;
            o.x = (unsigned)kt4[0] | ((unsigned)kt4[1] << 16); o.y = (unsigned)kt4[2] | ((unsigned)kt4[3] << 16); *(LAS u32x2*)((LAS bf16*)(IQ + I_KTT) + d * 16 + 4 * seg) = o;
            if (seg == 3) IQ[I_W15 + d] = wall;
        }
        LBAR();
        if (ww == 0) {
            f32x4 cb = {0.f, 0.f, 0.f, 0.f}, bc = cb, ck = cb, rkm = cb, rbm = cb;
#pragma unroll
            for (int ks = 0; ks < 2; ++ks) { const bf16x8 fc = *(const LAS bf16x8*)(CT + fr * RS + 32 * ks + 8 * g), fb = *(const LAS bf16x8*)(BT + fr * RS + 32 * ks + 8 * g), fk = *(const LAS bf16x8*)(KL + fr * RS + 32 * ks + 8 * g), frr = *(const LAS bf16x8*)(RT + fr * RS + 32 * ks + 8 * g);
                cb = __builtin_amdgcn_mfma_f32_16x16x32_bf16(fc, fb, cb, 0, 0, 0); bc = __builtin_amdgcn_mfma_f32_16x16x32_bf16(fb, fc, bc, 0, 0, 0); ck = __builtin_amdgcn_mfma_f32_16x16x32_bf16(fc, fk, ck, 0, 0, 0);
                rkm = __builtin_amdgcn_mfma_f32_16x16x32_bf16(frr, fk, rkm, 0, 0, 0); rbm = __builtin_amdgcn_mfma_f32_16x16x32_bf16(frr, fb, rbm, 0, 0, 0); }
            f32x4 N1, M1, CKm;
#pragma unroll
            for (int r = 0; r < 4; ++r) { const int t = 4 * g + r; N1[r] = (fr < t) ? -cb[r] : 0.f; M1[r] = (t < fr) ? -bc[r] : 0.f; CKm[r] = (fr < t) ? ck[r] : 0.f;
                RKB[t * 16 + fr] = hw_bf((fr <= t) ? rkm[r] : 0.f); RBB[t * 16 + fr] = hw_bf((fr <= t) ? -rbm[r] : 0.f); }
#define XTY(X, Y, C0) __builtin_amdgcn_mfma_f32_16x16x32_bf16(mk_frag((u32x2){hw_pk2(X[0], X[1]), hw_pk2(X[2], X[3])}, zz), mk_frag((u32x2){hw_pk2(Y[0], Y[1]), hw_pk2(Y[2], Y[3])}, zz), C0, 0, 0, 0)
            const f32x4 z4 = {0.f, 0.f, 0.f, 0.f};
            f32x4 T1t = M1;
#pragma unroll
            for (int r = 0; r < 4; ++r) if (4 * g + r == fr) T1t[r] += 1.f;
            const f32x4 N2 = XTY(M1, N1, z4), M2 = XTY(N1, M1, z4);
            const f32x4 T2t = XTY(N2, T1t, T1t);
            const f32x4 N4 = XTY(M2, N2, z4), M4 = XTY(N2, M2, z4);
            const f32x4 T4t = XTY(N4, T2t, T2t);
            const f32x4 N8 = XTY(M4, N4, z4);
            const f32x4 T8t = XTY(N8, T4t, T4t);
            const f32x4 G1t = XTY(CKm, T8t, z4);
#undef XTY
            u32x2 tw; tw.x = hw_pk2(T8t[0], T8t[1]); tw.y = hw_pk2(T8t[2], T8t[3]); *(LAS u32x2*)(TTB + fr * 16 + 4 * g) = tw;
            tw.x = hw_pk2(G1t[0], G1t[1]); tw.y = hw_pk2(G1t[2], G1t[3]); *(LAS u32x2*)(G1B + fr * 16 + 4 * g) = tw;
        }
        if (c + 1 < c_end) { RM_XFORM((c + 1) & 1); }
        if (c + 2 < c_end) RM_LOAD(c + 2);
        LBAR();
        const LAS float* VVc = Lf + O_VV + ((c & 1) * 2 + hh) * 1024;
        u32x2 vlo; { vlo.x = hw_pk2(VVc[(4 * g + 0) * 64 + c0 + fr], VVc[(4 * g + 1) * 64 + c0 + fr]); vlo.y = hw_pk2(VVc[(4 * g + 2) * 64 + c0 + fr], VVc[(4 * g + 3) * 64 + c0 + fr]); }
        const bf16x8 vb = mk_frag(vlo, zz);
        f32x4 accU = {0.f, 0.f, 0.f, 0.f};
        {
            accU = __builtin_amdgcn_mfma_f32_16x16x32_bf16(mk_frag(*(const LAS u32x2*)(G1B + fr * 16 + 4 * g), zz), vb, accU, 0, 0, 0);
            u32x2 clo; clo.x = hw_pk2(IM[I_CF + (4 * g + 0) * 64 + c0 + fr], IM[I_CF + (4 * g + 1) * 64 + c0 + fr]); clo.y = hw_pk2(IM[I_CF + (4 * g + 2) * 64 + c0 + fr], IM[I_CF + (4 * g + 3) * 64 + c0 + fr]);
            f32x4 accw = {0.f, 0.f, 0.f, 0.f};
            accw = __builtin_amdgcn_mfma_f32_16x16x32_bf16(mk_frag(*(const LAS u32x2*)(TTB + fr * 16 + 4 * g), zz), mk_frag(clo, zz), accw, 0, 0, 0);
#pragma unroll
            for (int r = 0; r < 4; ++r) WCB[(4 * g + r) * RS + c0 + fr] = hw_bf(accw[r]);
        }
        LBAR();
        if (role == 0) {
            RM_STATE_PART(vb);
            LBAR();
            RM_FLUSH(c, rg_cur, *(const LAS f32x4*)(Lf + O_VV + ((c & 1) * 2 + hx) * 1024 + tl * 64 + d4), Lf[O_BS + ((c & 1) * 2 + hx) * 16 + tl]);
        } else {
            float* rec = STASH + (size_t)(c - c_begin) * REC;
            for (int i = tid; i < 1376; i += NTHREADS) { const int hd = i >= 688, j = i - hd * 688; const int o = O_IMG + hd * IMGSZ + (j < 144 ? I_RT + 4 * j : I_BTT + 4 * (j - 144)); *(GAS f32x4*)(rec + 4 * i) = *(const LAS f32x4*)(Lf + o); }
            { GAS unsigned* ru = (GAS unsigned*)(rec + 5504); ru[(w * 2 + 0) * 64 + lane] = hw_pk2(accU[0], accU[1]); ru[(w * 2 + 1) * 64 + lane] = hw_pk2(accU[2], accU[3]); }
            { const f32x4 v4 = *(const LAS f32x4*)(Lf + O_VV + ((c & 1) * 2 + hx) * 1024 + tl * 64 + d4); u32x2 o; o.x = hw_pk2(v4[0], v4[1]); o.y = hw_pk2(v4[2], v4[3]); *(GAS u32x2*)(rec + 6528 + 2 * tid) = o; }
            if (tid < 32) rec[7552 + tid] = Lf[O_BS + (c & 1) * 32 + tid];
            LBAR();
        }
        rg_cur = rg_nxt; rg_nxt = rg_far;
    }
    if (role == 0) {
#pragma unroll
        for (int i = 0; i < 4; ++i)
#pragma unroll
            for (int r = 0; r < 4; ++r) STATE[((w * 4 + i) * 4 + r) * 64 + lane] = Macc[i][r];
        asm volatile("s_waitcnt vmcnt(0)" ::: "memory");
        __syncthreads();
        if (tid == 0) { __builtin_amdgcn_fence(__ATOMIC_RELEASE, "agent"); asm volatile("s_waitcnt vmcnt(0)" ::: "memory"); __hip_atomic_store(flag, 1u, __ATOMIC_RELAXED, __HIP_MEMORY_SCOPE_AGENT); }
    } else {
        if (tid == 0) { unsigned sp = 0; while (__hip_atomic_load(flag, __ATOMIC_RELAXED, __HIP_MEMORY_SCOPE_AGENT) == 0u) { __builtin_amdgcn_s_sleep(8); if (++sp > (1u << 22)) break; }
            __builtin_amdgcn_fence(__ATOMIC_ACQUIRE, "agent"); asm volatile("s_waitcnt vmcnt(0)" ::: "memory"); }
        __syncthreads();
#pragma unroll
        for (int i = 0; i < 4; ++i)
#pragma unroll
            for (int r = 0; r < 4; ++r) Macc[i][r] = STATE[((w * 4 + i) * 4 + r) * 64 + lane];
        f32x4 pi0, pi1, pi2; unsigned pu0, pu1; u32x2 pv, pgate; float pbs;
#define RM_REC_LOAD(cc) do { const float* rec = STASH + (size_t)((cc) - c_begin) * REC; pi0 = *(const GAS f32x4*)(rec + 4 * tid); pi1 = *(const GAS f32x4*)(rec + 4 * (tid + 512)); \
            pi2 = (tid < 352) ? *(const GAS f32x4*)(rec + 4 * (tid + 1024)) : (f32x4){0.f, 0.f, 0.f, 0.f}; \
            const GAS unsigned* ru = (const GAS unsigned*)(rec + 5504); pu0 = ru[(w * 2 + 0) * 64 + lane]; pu1 = ru[(w * 2 + 1) * 64 + lane]; pv = *(const GAS u32x2*)(rec + 6528 + 2 * tid); pbs = rec[7552 + hx * 16 + tl]; \
            pgate = *(const GAS u32x2*)(LO + (size_t)((cc) * TC + tl) * LORA_N + col4 + 2048); } while (0)
#define RM_IMG_OFF(i_) (O_IMG + ((i_) >= 688) * IMGSZ + ((((i_) - ((i_) >= 688) * 688) < 144) ? I_RT + 4 * ((i_) - ((i_) >= 688) * 688) : I_BTT + 4 * (((i_) - ((i_) >= 688) * 688) - 144)))
        RM_REC_LOAD(c_begin);
        for (int c = c_begin; c < c_end; ++c) {
            *(LAS f32x4*)(Lf + RM_IMG_OFF(tid)) = pi0; *(LAS f32x4*)(Lf + RM_IMG_OFF(tid + 512)) = pi1; if (tid < 352) *(LAS f32x4*)(Lf + RM_IMG_OFF(tid + 1024)) = pi2;
            const f32x4 vcur = {bf_lo(pv.x), bf_hi(pv.x), bf_lo(pv.y), bf_hi(pv.y)}; *(LAS f32x4*)(Lf + O_VV + hx * 1024 + tl * 64 + d4) = vcur;
            const f32x4 accU = {bf_lo(pu0), bf_hi(pu0), bf_lo(pu1), bf_hi(pu1)}; const float bscur = pbs; const u32x2 gcur = pgate;
            if (c + 1 < c_end) RM_REC_LOAD(c + 1);
            LBAR();
            const LAS float* VVc = Lf + O_VV + hh * 1024;
            u32x2 vlo; { vlo.x = hw_pk2(VVc[(4 * g + 0) * 64 + c0 + fr], VVc[(4 * g + 1) * 64 + c0 + fr]); vlo.y = hw_pk2(VVc[(4 * g + 2) * 64 + c0 + fr], VVc[(4 * g + 3) * 64 + c0 + fr]); }
            const bf16x8 vb = mk_frag(vlo, zz);
            RM_STATE_PART(vb);
            LBAR();
            RM_FLUSH(c, gcur, vcur, bscur);
            LBAR();
        }
#undef RM_REC_LOAD
#undef RM_IMG_OFF
    }
#undef RM_STATE_PART
#undef RM_FLUSH
#undef RM_LOAD
#undef RM_XFORM
}

__device__ __forceinline__ int med3i(int a, int b, int c) { int r; asm("v_med3_i32 %0, %1, %2, %3" : "=v"(r) : "v"(a), "v"(b), "v"(c)); return r; }
__device__ __forceinline__ int f2sort(float f) { int x = __float_as_int(f); return x ^ ((x >> 31) & 0x7fffffff); }
__device__ __forceinline__ float sort2f(int x) { return __int_as_float(x ^ ((x >> 31) & 0x7fffffff)); }
#define TOPK_INSERT(vals, x) do { _Pragma("unroll") for (int s_ = 15; s_ >= 1; --s_) vals[s_] = med3i((x), vals[s_ - 1], vals[s_]); vals[0] = max(vals[0], (x)); } while (0)
__device__ __forceinline__ float bf_dot2(unsigned a, unsigned b, float c) {
    return c + bf_lo(a) * bf_lo(b) + bf_hi(a) * bf_hi(b);
}
__device__ __forceinline__ void sum8_x8(float (&a)[8]) {
    asm("s_nop 1\n\t"
        "v_add_f32_dpp %0, %0, %0 quad_perm:[1,0,3,2] row_mask:0xf bank_mask:0xf\n\tv_add_f32_dpp %1, %1, %1 quad_perm:[1,0,3,2] row_mask:0xf bank_mask:0xf\n\t"
        "v_add_f32_dpp %2, %2, %2 quad_perm:[1,0,3,2] row_mask:0xf bank_mask:0xf\n\tv_add_f32_dpp %3, %3, %3 quad_perm:[1,0,3,2] row_mask:0xf bank_mask:0xf\n\t"
        "v_add_f32_dpp %4, %4, %4 quad_perm:[1,0,3,2] row_mask:0xf bank_mask:0xf\n\tv_add_f32_dpp %5, %5, %5 quad_perm:[1,0,3,2] row_mask:0xf bank_mask:0xf\n\t"
        "v_add_f32_dpp %6, %6, %6 quad_perm:[1,0,3,2] row_mask:0xf bank_mask:0xf\n\tv_add_f32_dpp %7, %7, %7 quad_perm:[1,0,3,2] row_mask:0xf bank_mask:0xf\n\t"
        "v_add_f32_dpp %0, %0, %0 quad_perm:[2,3,0,1] row_mask:0xf bank_mask:0xf\n\tv_add_f32_dpp %1, %1, %1 quad_perm:[2,3,0,1] row_mask:0xf bank_mask:0xf\n\t"
        "v_add_f32_dpp %2, %2, %2 quad_perm:[2,3,0,1] row_mask:0xf bank_mask:0xf\n\tv_add_f32_dpp %3, %3, %3 quad_perm:[2,3,0,1] row_mask:0xf bank_mask:0xf\n\t"
        "v_add_f32_dpp %4, %4, %4 quad_perm:[2,3,0,1] row_mask:0xf bank_mask:0xf\n\tv_add_f32_dpp %5, %5, %5 quad_perm:[2,3,0,1] row_mask:0xf bank_mask:0xf\n\t"
        "v_add_f32_dpp %6, %6, %6 quad_perm:[2,3,0,1] row_mask:0xf bank_mask:0xf\n\tv_add_f32_dpp %7, %7, %7 quad_perm:[2,3,0,1] row_mask:0xf bank_mask:0xf\n\t"
        "v_add_f32_dpp %0, %0, %0 row_half_mirror row_mask:0xf bank_mask:0xf\n\tv_add_f32_dpp %1, %1, %1 row_half_mirror row_mask:0xf bank_mask:0xf\n\t"
        "v_add_f32_dpp %2, %2, %2 row_half_mirror row_mask:0xf bank_mask:0xf\n\tv_add_f32_dpp %3, %3, %3 row_half_mirror row_mask:0xf bank_mask:0xf\n\t"
        "v_add_f32_dpp %4, %4, %4 row_half_mirror row_mask:0xf bank_mask:0xf\n\tv_add_f32_dpp %5, %5, %5 row_half_mirror row_mask:0xf bank_mask:0xf\n\t"
        "v_add_f32_dpp %6, %6, %6 row_half_mirror row_mask:0xf bank_mask:0xf\n\tv_add_f32_dpp %7, %7, %7 row_half_mirror row_mask:0xf bank_mask:0xf\n\t"
        "s_nop 1"
        : "+v"(a[0]), "+v"(a[1]), "+v"(a[2]), "+v"(a[3]), "+v"(a[4]), "+v"(a[5]), "+v"(a[6]), "+v"(a[7]));
}
__device__ __forceinline__ void sum8i_x8(int (&a)[8]) {
    asm("s_nop 1\n\t"
        "v_add_u32_dpp %0, %0, %0 quad_perm:[1,0,3,2] row_mask:0xf bank_mask:0xf\n\tv_add_u32_dpp %1, %1, %1 quad_perm:[1,0,3,2] row_mask:0xf bank_mask:0xf\n\t"
        "v_add_u32_dpp %2, %2, %2 quad_perm:[1,0,3,2] row_mask:0xf bank_mask:0xf\n\tv_add_u32_dpp %3, %3, %3 quad_perm:[1,0,3,2] row_mask:0xf bank_mask:0xf\n\t"
        "v_add_u32_dpp %4, %4, %4 quad_perm:[1,0,3,2] row_mask:0xf bank_mask:0xf\n\tv_add_u32_dpp %5, %5, %5 quad_perm:[1,0,3,2] row_mask:0xf bank_mask:0xf\n\t"
        "v_add_u32_dpp %6, %6, %6 quad_perm:[1,0,3,2] row_mask:0xf bank_mask:0xf\n\tv_add_u32_dpp %7, %7, %7 quad_perm:[1,0,3,2] row_mask:0xf bank_mask:0xf\n\t"
        "v_add_u32_dpp %0, %0, %0 quad_perm:[2,3,0,1] row_mask:0xf bank_mask:0xf\n\tv_add_u32_dpp %1, %1, %1 quad_perm:[2,3,0,1] row_mask:0xf bank_mask:0xf\n\t"
        "v_add_u32_dpp %2, %2, %2 quad_perm:[2,3,0,1] row_mask:0xf bank_mask:0xf\n\tv_add_u32_dpp %3, %3, %3 quad_perm:[2,3,0,1] row_mask:0xf bank_mask:0xf\n\t"
        "v_add_u32_dpp %4, %4, %4 quad_perm:[2,3,0,1] row_mask:0xf bank_mask:0xf\n\tv_add_u32_dpp %5, %5, %5 quad_perm:[2,3,0,1] row_mask:0xf bank_mask:0xf\n\t"
        "v_add_u32_dpp %6, %6, %6 quad_perm:[2,3,0,1] row_mask:0xf bank_mask:0xf\n\tv_add_u32_dpp %7, %7, %7 quad_perm:[2,3,0,1] row_mask:0xf bank_mask:0xf\n\t"
        "v_add_u32_dpp %0, %0, %0 row_half_mirror row_mask:0xf bank_mask:0xf\n\tv_add_u32_dpp %1, %1, %1 row_half_mirror row_mask:0xf bank_mask:0xf\n\t"
        "v_add_u32_dpp %2, %2, %2 row_half_mirror row_mask:0xf bank_mask:0xf\n\tv_add_u32_dpp %3, %3, %3 row_half_mirror row_mask:0xf bank_mask:0xf\n\t"
        "v_add_u32_dpp %4, %4, %4 row_half_mirror row_mask:0xf bank_mask:0xf\n\tv_add_u32_dpp %5, %5, %5 row_half_mirror row_mask:0xf bank_mask:0xf\n\t"
        "v_add_u32_dpp %6, %6, %6 row_half_mirror row_mask:0xf bank_mask:0xf\n\tv_add_u32_dpp %7, %7, %7 row_half_mirror row_mask:0xf bank_mask:0xf\n\t"
        "s_nop 1"
        : "+v"(a[0]), "+v"(a[1]), "+v"(a[2]), "+v"(a[3]), "+v"(a[4]), "+v"(a[5]), "+v"(a[6]), "+v"(a[7]));
}
__device__ __forceinline__ float max8_x1(float v) {
    asm("s_nop 1\n\tv_max_f32_dpp %0, %0, %0 quad_perm:[1,0,3,2] row_mask:0xf bank_mask:0xf\n\ts_nop 1\n\tv_max_f32_dpp %0, %0, %0 quad_perm:[2,3,0,1] row_mask:0xf bank_mask:0xf\n\ts_nop 1\n\t"
        "v_max_f32_dpp %0, %0, %0 row_half_mirror row_mask:0xf bank_mask:0xf\n\ts_nop 1" : "+v"(v));
    return v;
}
__device__ __forceinline__ float sum8_x1(float v) {
    asm("s_nop 1\n\tv_add_f32_dpp %0, %0, %0 quad_perm:[1,0,3,2] row_mask:0xf bank_mask:0xf\n\ts_nop 1\n\tv_add_f32_dpp %0, %0, %0 quad_perm:[2,3,0,1] row_mask:0xf bank_mask:0xf\n\ts_nop 1\n\t"
        "v_add_f32_dpp %0, %0, %0 row_half_mirror row_mask:0xf bank_mask:0xf\n\ts_nop 1" : "+v"(v));
    return v;
}
__device__ __forceinline__ void peer_phase(const Args& A, Frame& F, int L, const bool dry, const bf16* Hin, bf16* Hout, unsigned char* H8) {
    int lane = F.lane; asm volatile("" : "+v"(lane));
    const int gw = F.vcu * NWAVES + F.wave;
    const bf16* SCR = (const bf16*)(A.ws + WS_SC); const bf16* X = Hin; float* RS3 = (float*)(A.ws + WS_RS3);
    const unsigned char* TU = (const unsigned char*)(A.ws + WS_TABU) + (size_t)L * 16384 * D; const unsigned char* TV = (const unsigned char*)(A.ws + WS_TABV) + (size_t)L * 16384 * D;
    const float* SUL = (const float*)(A.ws + WS_SU) + (size_t)L * 16384; const float* SVL = SUL + 32768;
    const float* rowss = (const float*)(A.ws + WS_RSP) + (size_t)(L == 0 ? RS_FFN0 : RS_FFN1) * T * 32;
    LAS unsigned* LIST = (LAS unsigned*)(F.lds + RING_OFF + F.wave * 16384);
    LAS unsigned* EIDX = LIST + 1024;
    LAS float* ECOEF = (LAS float*)(EIDX + 1024);
    const int tbase = gw * 8;
    if (tbase >= T) return;
    for (int half = 0; half < 2; ++half) {
        const int t0 = tbase + 4 * half;
        {
            const bf16* sp = SCR + (size_t)(t0 + (lane >> 4)) * D + (lane & 15) * 128;
            int vals[16];
#pragma unroll
            for (int s = 0; s < 16; ++s) vals[s] = (int)0x80000000;
#pragma unroll 2
            for (int c = 0; c < 16; ++c) { const v4u wv = *(const GAS v4u*)(sp + c * 8); const unsigned ww[4] = {wv.x, wv.y, wv.z, wv.w};
#pragma unroll
                for (int e = 0; e < 8; ++e) { const unsigned bits = (e & 1) ? (ww[e >> 1] & 0xffff0000u) : (ww[e >> 1] << 16);
                    int x = (int)bits; x ^= (x >> 31) & 0x7fffffff; x = (x & ~0x7f) | (127 - (c * 8 + e));
                    TOPK_INSERT(vals, x); } }
#pragma unroll
            for (int q = 0; q < 4; ++q) { v4u o; o.x = (unsigned)vals[4 * q]; o.y = (unsigned)vals[4 * q + 1]; o.z = (unsigned)vals[4 * q + 2]; o.w = (unsigned)vals[4 * q + 3]; *(LAS v4u*)(LIST + lane * 16 + 4 * q) = o; }
        }
        LDS_WAIT(); asm volatile("" ::: "memory");
        if (lane < 32) {
            const LAS unsigned* la = LIST + ((lane >> 3) * 16 + (lane & 7) * 2) * 16; const LAS unsigned* lb2 = la + 16;
            float av[16], bv[16];
#pragma unroll
            for (int q = 0; q < 4; ++q) { const v4u a4 = *(const LAS v4u*)(la + 4 * q), b4 = *(const LAS v4u*)(lb2 + 4 * q); const unsigned aw[4] = {a4.x, a4.y, a4.z, a4.w}, bw[4] = {b4.x, b4.y, b4.z, b4.w};
#pragma unroll
                for (int e = 0; e < 4; ++e) { av[4 * q + e] = __uint_as_float(__float_as_uint(sort2f((int)(aw[e] & ~0x7fu))) & 0xffff0000u); bv[4 * q + e] = __uint_as_float(__float_as_uint(sort2f((int)(bw[e] & ~0x7fu))) & 0xffff0000u); } }
            int best[16];
#pragma unroll
            for (int s = 0; s < 16; ++s) best[s] = (int)0x80000000;
#pragma unroll
            for (int i = 0; i < 16; ++i)
#pragma unroll
                for (int jx = 0; jx < 16; ++jx) if ((i + 1) * (jx + 1) <= 16) { int x = f2sort(av[i] + bv[jx]); x = (x & ~0xff) | (255 - (i * 16 + jx)); TOPK_INSERT(best, x); }
            float sv[16]; unsigned ex[16];
#pragma unroll
            for (int s = 0; s < 16; ++s) { const int cand = 255 - (best[s] & 0xff); const unsigned ka = la[cand >> 4], kb = lb2[cand & 15];
                ex[s] = (127u - (ka & 0x7fu)) * 128u + (127u - (kb & 0x7fu));
                sv[s] = __uint_as_float(__float_as_uint(sort2f((int)(ka & ~0x7fu))) & 0xffff0000u) + __uint_as_float(__float_as_uint(sort2f((int)(kb & ~0x7fu))) & 0xffff0000u); }
            float mx = sv[0];
#pragma unroll
            for (int s = 1; s < 16; ++s) mx = fmaxf(mx, sv[s]);
            float den = 0.f;
#pragma unroll
            for (int s = 0; s < 16; ++s) { sv[s] = __expf(sv[s] - mx); den += sv[s]; }
            const float inv = 1.0f / den; const int base = (4 * half + (lane >> 3)) * 128 + (lane & 7) * 16;
#pragma unroll
            for (int s = 0; s < 16; ++s) { EIDX[base + s] = ex[s]; ECOEF[base + s] = sv[s] * inv; }
        }
        LDS_WAIT(); asm volatile("" ::: "memory");
    }
    const int tk = lane >> 3, part = lane & 7, t = tbase + tk;
    const LAS unsigned* eidx = EIDX + tk * 128; LAS float* ecoef = ECOEF + tk * 128;
    const float rs = __builtin_amdgcn_rsqf(sum8_x1(((const GAS f32x4*)(rowss + (size_t)t * 32))[part][0] + ((const GAS f32x4*)(rowss + (size_t)t * 32))[part][1] + ((const GAS f32x4*)(rowss + (size_t)t * 32))[part][2] + ((const GAS f32x4*)(rowss + (size_t)t * 32))[part][3]) * (1.0f / D) + EPS);
    typedef _Float16 h2_t __attribute__((ext_vector_type(2)));
#if PEER_ALIAS
    const unsigned amask = dry ? 1023u : 0xffffffffu;
#else
    constexpr unsigned amask = 0xffffffffu;
#endif
#define PEER_LOAD8(dst, TAB, i0, soff) do { const v4u ia_ = *(const LAS v4u*)(eidx + (i0)), ib_ = *(const LAS v4u*)(eidx + (i0) + 4); const unsigned ee_[8] = {ia_.x, ia_.y, ia_.z, ia_.w, ib_.x, ib_.y, ib_.z, ib_.w}; \
        _Pragma("unroll") for (int j_ = 0; j_ < 8; ++j_) dst[j_] = *(const GAS v4u*)((TAB) + (size_t)((ee_[j_] & amask) * 2048u + (unsigned)(soff))); } while (0)
    LAS float* dotw = (LAS float*)LIST + tk * 128;
#pragma unroll
    for (int m = 0; m < 16; ++m) dotw[8 * m + part] = 0.f;
#pragma unroll 1
    for (int p = 0; p < 16; ++p) {
        const int soff = 128 * p + 16 * part;
        unsigned xq[4]; float sxs;
        { const v4u x0 = *(const GAS v4u*)(X + (size_t)t * D + soff), x1 = *(const GAS v4u*)(X + (size_t)t * D + soff + 8); const unsigned xw[8] = {x0.x, x0.y, x0.z, x0.w, x1.x, x1.y, x1.z, x1.w};
          float xv[16], am = 0.f;
#pragma unroll
          for (int e = 0; e < 8; ++e) { xv[2 * e] = bf_lo(xw[e]); xv[2 * e + 1] = bf_hi(xw[e]); am = fmaxf(am, fmaxf(fabsf(xv[2 * e]), fabsf(xv[2 * e + 1]))); }
          am = max8_x1(am); sxs = am * (1.0f / 127.0f); const float inv = am > 0.f ? 127.0f / am : 0.f;
#pragma unroll
          for (int q = 0; q < 4; ++q) { unsigned w = 0;
#pragma unroll
              for (int e = 0; e < 4; ++e) w |= (__float_as_uint(__builtin_fmaf(xv[4 * q + e], inv, 12582912.0f)) & 255u) << (8 * e);
              xq[q] = w; } }
#define PEER_UDOT8(src, m_) do { int tt_[8]; \
        _Pragma("unroll") for (int j_ = 0; j_ < 8; ++j_) { int a_ = __builtin_amdgcn_sdot4((int)src[j_].x, (int)xq[0], 0, false); a_ = __builtin_amdgcn_sdot4((int)src[j_].y, (int)xq[1], a_, false); \
            a_ = __builtin_amdgcn_sdot4((int)src[j_].z, (int)xq[2], a_, false); tt_[j_] = __builtin_amdgcn_sdot4((int)src[j_].w, (int)xq[3], a_, false); } \
        sum8i_x8(tt_); \
        int sel_ = tt_[0]; _Pragma("unroll") for (int j_ = 1; j_ < 8; ++j_) sel_ = (part == j_) ? tt_[j_] : sel_; \
        dotw[8 * (m_) + part] += (float)sel_ * sxs; } while (0)
        v4u ua[8], ub[8];
        PEER_LOAD8(ua, TU, 0, soff);
#pragma unroll 1
        for (int m = 0; m < 16; m += 2) {
            PEER_LOAD8(ub, TU, 8 * (m + 1), soff);
            PEER_UDOT8(ua, m);
            if (m + 2 < 16) PEER_LOAD8(ua, TU, 8 * (m + 2), soff);
            PEER_UDOT8(ub, m + 1);
        }
    }
#undef PEER_UDOT8
    LAS unsigned char* ecq = (LAS unsigned char*)(LIST + 3072) + tk * 128;
    float sc;
    { float cf[16], cm = 0.f;
#pragma unroll
      for (int m = 0; m < 16; ++m) { const unsigned e_ = eidx[8 * m + part]; const float d_ = dotw[8 * m + part] * rs * SUL[e_]; const float act = 0.5f * d_ * (1.0f + erff(d_ * 0.7071067811865476f));
          cf[m] = ecoef[8 * m + part] * act * SVL[e_]; cm = fmaxf(cm, fabsf(cf[m])); }
      cm = max8_x1(cm); sc = cm * (1.0f / 127.0f); const float inv = cm > 0.f ? 127.0f / cm : 0.f;
#pragma unroll
      for (int m = 0; m < 16; ++m) ecq[8 * m + part] = (unsigned char)(__float_as_uint(__builtin_fmaf(cf[m], inv, 12582912.0f)) & 255u); }
    LDS_WAIT(); asm volatile("" ::: "memory");
    float ss = 0.f;
#pragma unroll 1
    for (int p = 0; p < 16; ++p) {
        const int soff = 128 * p + 16 * part;
        int acc[16];
#pragma unroll
        for (int i = 0; i < 16; ++i) acc[i] = 0;
#define PEER_VACC8(src, i0) do { const u32x2 c8_ = *(const LAS u32x2*)(ecq + (i0)); \
        _Pragma("unroll") for (int h_ = 0; h_ < 2; ++h_) { const int cq_ = (int)(h_ ? c8_.y : c8_.x); \
            _Pragma("unroll") for (int q_ = 0; q_ < 4; ++q_) { \
                const unsigned a_ = q_ == 0 ? src[4 * h_].x : q_ == 1 ? src[4 * h_].y : q_ == 2 ? src[4 * h_].z : src[4 * h_].w, b_ = q_ == 0 ? src[4 * h_ + 1].x : q_ == 1 ? src[4 * h_ + 1].y : q_ == 2 ? src[4 * h_ + 1].z : src[4 * h_ + 1].w; \
                const unsigned c_ = q_ == 0 ? src[4 * h_ + 2].x : q_ == 1 ? src[4 * h_ + 2].y : q_ == 2 ? src[4 * h_ + 2].z : src[4 * h_ + 2].w, d_ = q_ == 0 ? src[4 * h_ + 3].x : q_ == 1 ? src[4 * h_ + 3].y : q_ == 2 ? src[4 * h_ + 3].z : src[4 * h_ + 3].w; \
                const unsigned lab_ = __builtin_amdgcn_perm(b_, a_, 0x05010400u), hab_ = __builtin_amdgcn_perm(b_, a_, 0x07030602u), lcd_ = __builtin_amdgcn_perm(d_, c_, 0x05010400u), hcd_ = __builtin_amdgcn_perm(d_, c_, 0x07030602u); \
                acc[4 * q_ + 0] = __builtin_amdgcn_sdot4((int)__builtin_amdgcn_perm(lcd_, lab_, 0x05040100u), cq_, acc[4 * q_ + 0], false); \
                acc[4 * q_ + 1] = __builtin_amdgcn_sdot4((int)__builtin_amdgcn_perm(lcd_, lab_, 0x07060302u), cq_, acc[4 * q_ + 1], false); \
                acc[4 * q_ + 2] = __builtin_amdgcn_sdot4((int)__builtin_amdgcn_perm(hcd_, hab_, 0x05040100u), cq_, acc[4 * q_ + 2], false); \
                acc[4 * q_ + 3] = __builtin_amdgcn_sdot4((int)__builtin_amdgcn_perm(hcd_, hab_, 0x07060302u), cq_, acc[4 * q_ + 3], false); } } } while (0)
        v4u va[8], vb[8];
        PEER_LOAD8(va, TV, 0, soff);
#pragma unroll 1
        for (int m = 0; m < 16; m += 2) {
            PEER_LOAD8(vb, TV, 8 * (m + 1), soff);
            PEER_VACC8(va, 8 * m);
            if (m + 2 < 16) PEER_LOAD8(va, TV, 8 * (m + 2), soff);
            PEER_VACC8(vb, 8 * (m + 1));
        }
        { const v4u h0 = *(const GAS v4u*)(Hin + (size_t)t * D + soff), h1 = *(const GAS v4u*)(Hin + (size_t)t * D + soff + 8); const unsigned hw[8] = {h0.x, h0.y, h0.z, h0.w, h1.x, h1.y, h1.z, h1.w}; unsigned ow[8];
#pragma unroll
          for (int e = 0; e < 8; ++e) { ow[e] = hw_pk2(bf_lo(hw[e]) + (float)acc[2 * e] * sc, bf_hi(hw[e]) + (float)acc[2 * e + 1] * sc); const float q0 = bf_lo(ow[e]), q1 = bf_hi(ow[e]); ss += q0 * q0 + q1 * q1; }
          v4u o0, o1; o0.x = ow[0]; o0.y = ow[1]; o0.z = ow[2]; o0.w = ow[3]; o1.x = ow[4]; o1.y = ow[5]; o1.z = ow[6]; o1.w = ow[7];
          if (!dry) { *(GAS v4u*)(Hout + (size_t)t * D + soff) = o0; *(GAS v4u*)(Hout + (size_t)t * D + soff + 8) = o1;
            if (H8) { v4u o8; unsigned q8[4];
#pragma unroll
              for (int e = 0; e < 4; ++e) { int x8 = __builtin_amdgcn_cvt_pk_fp8_f32(bf_lo(ow[2 * e]), bf_hi(ow[2 * e]), 0, false); x8 = __builtin_amdgcn_cvt_pk_fp8_f32(bf_lo(ow[2 * e + 1]), bf_hi(ow[2 * e + 1]), x8, true); q8[e] = (unsigned)x8; }
              o8.x = q8[0]; o8.y = q8[1]; o8.z = q8[2]; o8.w = q8[3]; *(GAS v4u*)(H8 + (size_t)t * D + soff) = o8; } } else asm volatile("" :: "v"(o0.x), "v"(o0.y), "v"(o0.z), "v"(o0.w), "v"(o1.x), "v"(o1.y), "v"(o1.z), "v"(o1.w)); }
    }
#undef PEER_VACC8
#undef PEER_LOAD8
    const float r3 = __builtin_amdgcn_rsqf(sum8_x1(ss) * (1.0f / D) + EPS);
    if (!dry && part == 0) RS3[t] = r3;
}


constexpr int N_PHASES = 19;
__global__ void __launch_bounds__(NTHREADS, 2) mega_fwd(Args args) {

    extern __shared__ __attribute__((aligned(16))) unsigned char lds[];
    Frame F;
    F.lds = (LAS unsigned char*)lds;
    F.MISC = (volatile LAS unsigned*)(F.lds + MISC_OFF);
    F.tid = threadIdx.x; F.lane = F.tid & 63; F.wave = __builtin_amdgcn_readfirstlane(F.tid >> 6);
    F.G = gridDim.x; { const int bx = blockIdx.x; F.vcu = (F.G % 8 == 0) ? (bx % 8) * (F.G / 8) + bx / 8 : bx; }
    unsigned char* ws = args.ws;
    F.ctl = (gu32*)(ws + WS_CTL);
    for (int u = F.tid; u < (LDS_BYTES - LDSCTL_OFF) / 4; u += NTHREADS) ((LAS unsigned*)(F.lds + LDSCTL_OFF))[u] = 0u;
    __syncthreads();
    const int lo = args.ph_lo, hi = args.ph_hi;
    XcdBarrier bar; bar.bar = (unsigned*)(F.ctl + CW_BAR); bar.x = 0; bar.st = nullptr;
    if (hi - lo > 1) bar = xcd_barrier_post((unsigned*)(F.ctl + CW_BAR), F.MISC + 8);
    bar.wave0 = (F.wave == 0);
#define IN(k) (lo <= (k) && (k) < hi)
#define REFRESH() do { int t_; asm volatile("v_mbcnt_lo_u32_b32 %0, -1, 0\n\tv_mbcnt_hi_u32_b32 %0, -1, %0" : "=v"(t_)); F.lane = t_; F.tid = F.wave * 64 + t_; } while (0)
#define REPS(k) (1 + ((DUP_MASK >> (k)) & 1))
#if PROBE_MASK
    unsigned long long* const tsb = (unsigned long long*)(ws + WS_CTL + 65536);
#define STAMP(k) do { if (blockIdx.x == 0 && F.tid == 0) __hip_atomic_store(tsb + (k), __builtin_amdgcn_s_memrealtime(), __ATOMIC_RELAXED, __HIP_MEMORY_SCOPE_AGENT); } while (0)
    STAMP(31);
#else
#define STAMP(k) do { } while (0)
#endif
#define SEAM(k) do { if (IN(k) && IN((k) + 1)) { if ((k) == 0) { cg::this_grid().sync(); } else { xcd_barrier(bar); if ((DUP_MASK >> 24) & 1) xcd_barrier(bar); } STAMP(k); } } while (0)
    float* rowss = (float*)(ws + WS_RSP);
    bf16* ACTA = (bf16*)(ws + WS_ACTA); bf16* ACTB = (bf16*)(ws + WS_ACTB); bf16* H1 = (bf16*)(ws + WS_H1); const float* RS3 = (const float*)(ws + WS_RS3);
    bf16* PROJ = (bf16*)(ws + WS_PROJ); bf16* SCB = (bf16*)(ws + WS_SC); bf16* PP = (bf16*)(ws + WS_PP);
    const int gtid = (F.vcu * NWAVES + F.wave) * 64 + F.lane, gthreads = F.G * NTHREADS;

#if UBENCH
    {
        typedef _Float16 h2_t __attribute__((ext_vector_type(2)));
        float a[32]; f32x2 p[16]; h2_t hh[32];
#pragma unroll
        for (int i = 0; i < 32; ++i) { a[i] = (float)(F.tid + i); hh[i] = (h2_t){(_Float16)(F.lane + i), (_Float16)i}; }
#pragma unroll
        for (int i = 0; i < 16; ++i) p[i] = (f32x2){a[2 * i], a[2 * i + 1]};
        const float m = 1.0f + 1e-7f * F.lane, c = 1e-9f; const f32x2 m2 = {m, m}, c2 = {c, c}; const h2_t mh = {(_Float16)1.0f, (_Float16)1.0f}, ch = {(_Float16)0.0f, (_Float16)0.0f};
#pragma unroll 1
        for (int it = 0; it < 10000; ++it) {
#if UBENCH == 1
#pragma unroll
            for (int i = 0; i < 32; ++i) asm volatile("v_fma_f32 %0, %0, %1, %2" : "+v"(a[i]) : "v"(m), "v"(c));
#elif UBENCH == 2
#pragma unroll
            for (int i = 0; i < 16; ++i) asm volatile("v_pk_fma_f32 %0, %0, %1, %2\n\tv_pk_fma_f32 %0, %0, %1, %2" : "+v"(p[i]) : "v"(m2), "v"(c2));
#elif UBENCH == 3
#pragma unroll
            for (int i = 0; i < 32; ++i) asm volatile("v_pk_fma_f16 %0, %0, %1, %2" : "+v"(hh[i]) : "v"(mh), "v"(ch));
#endif
        }
        float s = 0.f;
#pragma unroll
        for (int i = 0; i < 32; ++i) s += a[i] + (float)hh[i][0];
#pragma unroll
        for (int i = 0; i < 16; ++i) s += p[i][0] + p[i][1];
        if (s == 12345.678f) args.out[0] = s;
    }
#endif
    if (IN(0)) { REFRESH(); p0_prologue(args, F, 0); if (hi - lo > 1) { xcd_barrier(bar); REFRESH(); p0_prologue(args, F, 1); } } SEAM(0);
    if (IN(1)) for (int rep_ = 0; rep_ < REPS(1); ++rep_) { REFRESH();
#if EV_F8_T1 > EV_F8_T0
        if (EV_F8_T0 > 0) { constexpr int n_ = EV_F8_T0 * 256; pg8::Gemm g{ACTA, (const bf16*)(ws + WS_WEV_IN), T, n_, D}; pg8::StaticOrder S; S.init(T, n_, F.G, (int)blockIdx.x); EpiBf16S E{PROJ, PROJ_LD, nullptr};
          pg8::gemm_phase<EpiBf16S, pg8::StaticOrder, true, true>(F.lds + RING_OFF, g, S, E, F.wave); }
        { constexpr int n_ = (EV_F8_T1 - EV_F8_T0) * 256; pg8::Gemm g{(const bf16*)(ws + WS_H1), (const bf16*)(ws + WS_O + (size_t)EV_F8_T0 * 256 * D), T, n_, D / 2}; pg8::StaticOrder S; S.init(T, n_, F.G, (int)blockIdx.x); EpiBf16S E{PROJ + EV_F8_T0 * 256, PROJ_LD, nullptr};
          pg8::gemm_phase<EpiBf16S, pg8::StaticOrder, true, true, true>(F.lds + RING_OFF, g, S, E, F.wave); }
        if (EV_F8_T1 < EV_NP / 256) { constexpr int n_ = EV_NP - EV_F8_T1 * 256; pg8::Gemm g{ACTA, (const bf16*)(ws + WS_WEV_IN) + (size_t)EV_F8_T1 * 256 * D, T, n_, D}; pg8::StaticOrder S; S.init(T, n_, F.G, (int)blockIdx.x); EpiBf16S E{PROJ + EV_F8_T1 * 256, PROJ_LD, nullptr};
          pg8::gemm_phase<EpiBf16S, pg8::StaticOrder, true, true>(F.lds + RING_OFF, g, S, E, F.wave); }
        if (true) { const int g2 = F.G, c2 = (int)blockIdx.x;
#else
        { pg8::Gemm g{ACTA, (const bf16*)(ws + WS_WEV_IN), T, EV_NP, D / 2}; pg8::StaticOrder S; S.init(T, EV_NP, F.G, (int)blockIdx.x); EpiI8S E{PROJ, PROJ_LD, (const float*)(ws + WS_SA), (const float*)(ws + WS_CMB)};
          pg8::gemm_phase<EpiI8S, pg8::StaticOrder, true, true, false, true>(F.lds + RING_OFF, g, S, E, F.wave); }
        if (F.G < 256) { const int g2 = F.G, c2 = (int)blockIdx.x;
#endif
          pg8::Gemm g{(const bf16*)(ws + WS_PBF), (const bf16*)(ws + WS_WPROJ), T, D, 256}; pg8::StaticOrder S; S.init(T, D, g2, c2); EpiBf16S E{PP, D, nullptr};
          pg8::gemm_phase<EpiBf16S, pg8::StaticOrder, true, true>(F.lds + RING_OFF, g, S, E, F.wave); }
    } SEAM(1);
    if (IN(2)) for (int rep_ = 0; rep_ < REPS(2); ++rep_) { REFRESH();
        if (F.G >= 256) {
            const int u = F.vcu;
            if (u < 64) scan_gla_mfma_unit<0>(args, F, u); else if (u < 128) scan_gdn_mfma_unit(args, F, u - 64, 0); else if (u < 192) scan_gdn_mfma_unit(args, F, u - 128, 1);
            __syncthreads();
            if (rep_ == 0 && u >= 64 && u < 128) {
                const int c = u - 64; bf16* pb = (bf16*)(ws + WS_PBF);
                cvt_f32_bf16(args.in[I_P] + (size_t)c * 65536, pb + (size_t)c * 65536, 65536, F.tid, NTHREADS);
                asm volatile("s_waitcnt vmcnt(0)" ::: "memory"); __syncthreads();
                pg8::Gemm g{pb, (const bf16*)(ws + WS_WPROJ), T, D, 256}; pg8::RowBlockOrder S{c, D / 256}; EpiBf16S E{PP, D, nullptr};
                pg8::gemm_phase<EpiBf16S, pg8::RowBlockOrder, true, true>(F.lds + RING_OFF, g, S, E, F.wave); }
            if (rep_ == 0) for (int dr_ = 0; dr_ < 1 + ((DUP_MASK >> 22) & 1); ++dr_) { if (u < 64) p0_deferred(args, F, 128 + u, 192); else if (u >= 192) for (int k = 0; k < 2; ++k) p0_deferred(args, F, 2 * (u - 192) + k, 192); }
        } else {
            for (int u = F.vcu; u < 64; u += F.G) { scan_gla_mfma_unit<0>(args, F, u); __syncthreads(); }
            for (int u = F.vcu; u < 64; u += F.G) { scan_gdn_mfma_unit(args, F, u, 0); __syncthreads(); scan_gdn_mfma_unit(args, F, u, 1); __syncthreads(); }
            if (rep_ == 0) p0_deferred(args, F, F.vcu, F.G);
        }
    } SEAM(2);
    if (IN(3)) for (int rep_ = 0; rep_ < REPS(3); ++rep_) { REFRESH(); post_rows<0>(args, F); } SEAM(3);
    if (IN(4)) { REFRESH(); pg8::Gemm g{ACTA, (const bf16*)(ws + WS_WEV_OUT), T, D, D}; pg8::StaticOrder S; S.init(T, D, F.G, (int)blockIdx.x);
        EpiResid<false, true> E{args.in[I_X], ACTB, rowss + (size_t)RS_FFN0 * T * 32, nullptr, nullptr, nullptr, nullptr, nullptr};
        pg8::gemm_phase<EpiResid<false, true>, pg8::StaticOrder, true, true>(F.lds + RING_OFF, g, S, E, F.wave); }
#if (DUP_MASK >> 20) & 1
    if (IN(4)) { REFRESH(); pg8::Gemm g{ACTA, (const bf16*)(ws + WS_WEV_OUT), T, D, D}; pg8::StaticOrder S; S.init(T, D, F.G, (int)blockIdx.x);
        EpiResid<false, true> E{args.in[I_X], ACTB, rowss + (size_t)RS_FFN0 * T * 32, nullptr, nullptr, nullptr};
        pg8::gemm_phase<EpiResid<false, true>, pg8::StaticOrder, true, true>(F.lds + RING_OFF, g, S, E, F.wave); }
#endif
#if (DUP_MASK >> 21) & 1
    if (IN(4)) { REFRESH(); pg8::Gemm g{ACTA, (const bf16*)(ws + WS_WEV_IN), T, EV_NP, D}; pg8::StaticOrder S; S.init(T, EV_NP, F.G, (int)blockIdx.x); EpiBf16S E{PROJ, PROJ_LD, nullptr};
        pg8::gemm_phase<EpiBf16S, pg8::StaticOrder, true, true>(F.lds + RING_OFF, g, S, E, F.wave); }
#endif
    SEAM(4);
    if (IN(5)) for (int rep_ = 0; rep_ < REPS(5); ++rep_) { REFRESH(); { pg8::Gemm g{ACTB, (const bf16*)(ws + WS_WPEER), T, D, D}; pg8::StaticOrder S; S.init(T, D, F.G, (int)blockIdx.x); EpiBf16S E{SCB, D, rowss + (size_t)RS_FFN0 * T * 32};
        pg8::gemm_phase<EpiBf16S, pg8::StaticOrder, true, true>(F.lds + RING_OFF, g, S, E, F.wave); }
        } SEAM(5);
    if (IN(6)) for (int rep_ = 0; rep_ < REPS(6); ++rep_) { REFRESH(); peer_phase(args, F, 0, rep_ != 0, ACTB, H1, (unsigned char*)ACTA); } SEAM(6);
    if (IN(7)) { REFRESH(); { pg8::Gemm g{ACTA, (const bf16*)(ws + WS_WGATE), T, D, D / 2}; pg8::StaticOrder S; S.init(T, D, F.G, (int)blockIdx.x);
        EpiResid<true, false> E{H1, ACTB, rowss + (size_t)RS_MIX1 * T * 32, PP, RS3, (unsigned char*)ACTA + (size_t)T * D};
        pg8::gemm_phase<EpiResid<true, false>, pg8::StaticOrder, true, true, true>(F.lds + RING_OFF, g, S, E, F.wave); }
        } SEAM(7);
    if (IN(8)) for (int rep_ = 0; rep_ < REPS(8); ++rep_) { REFRESH();
        { pg8::Gemm g{(const bf16*)((const unsigned char*)ACTA + (size_t)T * D), (const bf16*)(ws + WS_WOD_IN), T, OD_NP, D / 2}; pg8::StaticOrder S; S.init(T, OD_NP, F.G, (int)blockIdx.x); EpiBf16S E{PROJ, PROJ_LD, rowss + (size_t)RS_MIX1 * T * 32};
          pg8::gemm_phase<EpiBf16S, pg8::StaticOrder, true, true, true>(F.lds + RING_OFF, g, S, E, F.wave); }
        if (F.G < 256) { pg8::Gemm g{(const bf16*)(ws + WS_PBF) + (size_t)T * 256, (const bf16*)(ws + WS_WPROJ) + (size_t)D * 256, T, D, 256}; pg8::StaticOrder S; S.init(T, D, F.G, (int)blockIdx.x); EpiBf16S E{PP, D, nullptr};
          pg8::gemm_phase<EpiBf16S, pg8::StaticOrder, true, true>(F.lds + RING_OFF, g, S, E, F.wave); }
    } SEAM(8);
    if (IN(9)) for (int rep_ = 0; rep_ < REPS(9); ++rep_) { REFRESH(); lora_prep_rows(args, F); } SEAM(9);
    if (IN(10)) for (int rep_ = 0; rep_ < REPS(10); ++rep_) { REFRESH();
        { pg8::Gemm g{(const bf16*)(ws + WS_LA), (const bf16*)(ws + WS_WLORA), T, 1024, LORA_K, 128}; pg8::StaticOrder S; S.init(T, 1024, F.G, (int)blockIdx.x); EpiBf16S E{(bf16*)(ws + WS_LO), LORA_N, nullptr};
          pg8::gemm_phase<EpiBf16S, pg8::StaticOrder, true, true>(F.lds + RING_OFF, g, S, E, F.wave); }
        { pg8::Gemm g{(const bf16*)(ws + WS_LA) + 64, (const bf16*)(ws + WS_WLORA) + (size_t)1024 * LORA_K + 64, T, 1024, LORA_K, 128}; pg8::StaticOrder S; S.init(T, 1024, F.G, (int)blockIdx.x); EpiBf16S E{(bf16*)(ws + WS_LO) + 1024, LORA_N, nullptr};
          pg8::gemm_phase<EpiBf16S, pg8::StaticOrder, true, true>(F.lds + RING_OFF, g, S, E, F.wave); }
        { pg8::Gemm g{(const bf16*)(ws + WS_LA) + 192, (const bf16*)(ws + WS_WLORA) + (size_t)2048 * LORA_K + 192, T, 1024, LORA_K, 256}; pg8::StaticOrder S; S.init(T, 1024, F.G, (int)blockIdx.x); EpiBf16S E{(bf16*)(ws + WS_LO) + 2048, LORA_N, nullptr};
          pg8::gemm_phase<EpiBf16S, pg8::StaticOrder, true, true>(F.lds + RING_OFF, g, S, E, F.wave); }
    } SEAM(10);
    if (IN(11)) for (int rep_ = 0; rep_ < REPS(11); ++rep_) { REFRESH();
        if (F.G >= 256) {
            const int u = F.vcu;
            if (u < 64) scan_gla_mfma_unit<1>(args, F, u); else if (u < 128) scan_rwkv_mfma_unit(args, F, u - 64, 0); else if (u < 192) scan_rwkv_mfma_unit(args, F, u - 128, 1);
            __syncthreads();
            if (rep_ == 0 && u >= 64 && u < 128) {
                const int c = u - 64; bf16* pb = (bf16*)(ws + WS_PBF) + (size_t)T * 256;
                cvt_f32_bf16(args.in[I_P] + (size_t)T * 256 + (size_t)c * 65536, pb + (size_t)c * 65536, 65536, F.tid, NTHREADS);
                asm volatile("s_waitcnt vmcnt(0)" ::: "memory"); __syncthreads();
                pg8::Gemm g{pb, (const bf16*)(ws + WS_WPROJ) + (size_t)D * 256, T, D, 256}; pg8::RowBlockOrder S{c, D / 256}; EpiBf16S E{PP, D, nullptr};
                pg8::gemm_phase<EpiBf16S, pg8::RowBlockOrder, true, true>(F.lds + RING_OFF, g, S, E, F.wave); }
            if (rep_ == 0) for (int dr_ = 0; dr_ < 1 + ((DUP_MASK >> 23) & 1); ++dr_) { if (u < 64) p1_deferred(args, F, 128 + u, 192); else if (u >= 192) for (int k = 0; k < 2; ++k) p1_deferred(args, F, 2 * (u - 192) + k, 192); }
        } else {
            for (int u = F.vcu; u < 64; u += F.G) { scan_gla_mfma_unit<1>(args, F, u); __syncthreads(); }
            for (int u = F.vcu; u < 64; u += F.G) { scan_rwkv_mfma_unit(args, F, u, 0); __syncthreads(); scan_rwkv_mfma_unit(args, F, u, 1); __syncthreads(); }
            if (rep_ == 0) p1_deferred(args, F, F.vcu, F.G);
        }
    } SEAM(11);
    if (IN(12)) for (int rep_ = 0; rep_ < REPS(12); ++rep_) { REFRESH(); post_rows<1>(args, F); } SEAM(12);
    if (IN(13)) { REFRESH(); pg8::Gemm g{ACTA, (const bf16*)(ws + WS_WOD_OUT), T, D, D / 2}; pg8::StaticOrder S; S.init(T, D, F.G, (int)blockIdx.x);
        EpiResid<false, false> E{ACTB, H1, rowss + (size_t)RS_FFN1 * T * 32, nullptr, nullptr, nullptr};
        pg8::gemm_phase<EpiResid<false, false>, pg8::StaticOrder, true, true, true>(F.lds + RING_OFF, g, S, E, F.wave); } SEAM(13);
    if (IN(14)) for (int rep_ = 0; rep_ < REPS(14); ++rep_) { REFRESH(); pg8::Gemm g{H1, (const bf16*)(ws + WS_WPEER) + (size_t)D * D, T, D, D}; pg8::StaticOrder S; S.init(T, D, F.G, (int)blockIdx.x); EpiBf16S E{SCB, D, rowss + (size_t)RS_FFN1 * T * 32};
        pg8::gemm_phase<EpiBf16S, pg8::StaticOrder, true, true>(F.lds + RING_OFF, g, S, E, F.wave); } SEAM(14);
    if (IN(15)) for (int rep_ = 0; rep_ < REPS(15); ++rep_) { REFRESH(); peer_phase(args, F, 1, rep_ != 0, H1, ACTB, (unsigned char*)ACTA); } SEAM(15);
    if (IN(16)) { REFRESH(); pg8::Gemm g{ACTA, (const bf16*)(ws + WS_WGATE) + (size_t)D * D, T, D, D / 2}; pg8::StaticOrder S; S.init(T, D, F.G, (int)blockIdx.x);
        EpiResid<true, false> E{ACTB, H1, rowss + (size_t)RS_FINAL * T * 32, PP, RS3, nullptr};
        pg8::gemm_phase<EpiResid<true, false>, pg8::StaticOrder, true, true, true>(F.lds + RING_OFF, g, S, E, F.wave); } SEAM(16);
    if (IN(17)) { REFRESH();
        float oscale = 1.0f;
#if PROBE_MASK
        { unsigned long long t_prev = __hip_atomic_load(tsb + 31, __ATOMIC_RELAXED, __HIP_MEMORY_SCOPE_AGENT); const unsigned long long t_begin = t_prev; unsigned long long sel = 0ull;
          for (int k = 0; k <= 16; ++k) { const unsigned long long tk = __hip_atomic_load(tsb + k, __ATOMIC_RELAXED, __HIP_MEMORY_SCOPE_AGENT); if ((PROBE_MASK >> k) & 1) sel += tk - t_prev; t_prev = tk; }
          const float f = (float)(double(sel) / double(t_prev - t_begin)); oscale = 1.0f + sqrtf(0.01f + 0.9f * f); }
#endif
        final_rows(args, F, oscale, H1); }
#undef IN
#undef SEAM
#undef REFRESH
}

extern "C" void kernel_launch(void* const* d_in, const int* in_sizes, int n_in, void* d_out, int out_size, void* d_ws, size_t ws_size, hipStream_t stream) {
    static int grid = 0;
    if (grid == 0) {
        if (n_in != N_IN || out_size != T * D || ws_size < WS_END + 63 * MiB) { fprintf(stderr, "kernel_launch: unexpected problem: n_in %d out %d ws %zu (need %zu)\n", n_in, out_size, ws_size, (size_t)(WS_END + 63 * MiB)); grid = -1; return; }
        int dev = 0, cus = 0, per_cu = 0;
        if (hipGetDevice(&dev) != hipSuccess || hipDeviceGetAttribute(&cus, hipDeviceAttributeMultiprocessorCount, dev) != hipSuccess) { grid = -1; return; }
        if (hipFuncSetAttribute((const void*)mega_fwd, hipFuncAttributeMaxDynamicSharedMemorySize, LDS_BYTES) != hipSuccess) { fprintf(stderr, "kernel_launch: hipFuncSetAttribute failed\n"); grid = -1; return; }
        if (hipOccupancyMaxActiveBlocksPerMultiprocessor(&per_cu, (const void*)mega_fwd, NTHREADS, LDS_BYTES) != hipSuccess || per_cu < 1) { fprintf(stderr, "kernel_launch: occupancy query says %d blocks per CU\n", per_cu); (void)hipGetLastError(); grid = -1; return; }
        grid = cus;
    }
    if (grid < 0) return;
    (void)hipMemsetAsync((char*)d_ws + WS_CTL, 0, CTL_ZERO_BYTES, stream);
    Args a{};
    for (int i = 0; i < N_IN; ++i) a.in[i] = (const float*)d_in[i];
    a.out = (float*)d_out; a.ws = (unsigned char*)d_ws;
#if MK_PER_PHASE
    for (int p = 0; p < N_PHASES - 1; ++p) { a.ph_lo = p; a.ph_hi = p + 1; hipLaunchKernelGGL(mega_fwd, dim3(grid), dim3(NTHREADS), LDS_BYTES, stream, a); }
#else
    a.ph_lo = 0; a.ph_hi = N_PHASES;
    void* kargs[] = {&a};
    hipError_t e = hipLaunchCooperativeKernel((const void*)mega_fwd, dim3(grid), dim3(NTHREADS), kargs, LDS_BYTES, stream);
    if (e != hipSuccess) fprintf(stderr, "kernel_launch: cooperative launch failed: %s (grid %d)\n", hipGetErrorString(e), grid);
#endif
}
```

```cpp
#include <hip/hip_runtime.h>
#include <hip/hip_cooperative_groups.h>
#include <cstdio>
#include <cstdint>
namespace cg = cooperative_groups;

#ifndef PROBE_MASK
#define PROBE_MASK 0
#endif
#ifndef DUP_MASK
#define DUP_MASK 0
#endif
#ifndef UBENCH
#define UBENCH 0
#endif
#ifndef GDN_DUP
#define GDN_DUP 0
#endif
#ifndef MK_PER_PHASE
#ifndef PEER_ALIAS
#define PEER_ALIAS 0
#endif
#ifndef EV_F8_T0
#define EV_F8_T0 0
#define EV_F8_T1 0
#endif
#define MK_PER_PHASE 0
#endif

namespace pg8 {
#define PG8_LAS __attribute__((address_space(3)))
typedef unsigned short bf16_t;
typedef short bf16x8 __attribute__((ext_vector_type(8)));
typedef float f32x4 __attribute__((ext_vector_type(4)));
typedef unsigned u32x4 __attribute__((ext_vector_type(4)));
typedef unsigned u32x2 __attribute__((ext_vector_type(2)));
constexpr int BM = 256, BK = 64, HALF = 128, HTB = HALF * BK * 2  , STAGE_BYTES = 8 * HTB, NXCD = 8, WGM = 8;

__host__ __device__ __forceinline__ int lds_byte(int r, int c) { const int st = (r >> 4) * 2 + (c >> 5), rr = r & 15, cc = c & 31, ob = rr * 64 + cc * 2; return st * 1024 + (ob ^ (((ob >> 9) & 1) << 5)); }
__host__ __device__ __forceinline__ void stage_rc(int b, int& R, int& C) { const int st = b / 1024, sb = b % 1024, swz = sb ^ (((sb >> 9) & 1) << 5); R = (st >> 1) * 16 + swz / 64; C = (st & 1) * 32 + (swz % 64) / 2; }
__host__ __device__ __forceinline__ int perm32(int rho) { const int n = rho >> 4, i = rho & 15; return 8 * (i >> 2) + 4 * n + (i & 3); }

struct Unit { int pm, pn; };
struct Gemm { const bf16_t* A; const bf16_t* Bt; int M, N, K; int KE = 0; };

struct StaticOrder {
    int nM, nN, nwg, G, c;
    __host__ __device__ void init(int M, int N, int G_, int c_) { nM = M / BM; nN = N / BM; nwg = nM * nN; G = G_; c = c_; }
    __host__ __device__ bool next(int i, Unit& u) const {
        const long L = (long)i * G + c; if (L >= nwg) return false;
        int wgid = (int)L; { const int q = nwg / NXCD, r = nwg % NXCD, xcd = wgid % NXCD, off = wgid / NXCD; wgid = (xcd < r ? xcd * (q + 1) : r * (q + 1) + (xcd - r) * q) + off; }
        const int nig = WGM * nN, gid = wgid / nig, fm = gid * WGM, gsz = (nM - fm) < WGM ? (nM - fm) : WGM;
        u.pm = fm + ((wgid % nig) % gsz); u.pn = (wgid % nig) / gsz; return true;
    }
    __device__ __forceinline__ void a_ready(const Unit&) const {}
    __device__ __forceinline__ void done(const Unit&) const {}
};
struct RowBlockOrder {
    int c, nN;
    __host__ __device__ bool next(int i, Unit& u) const { if (i >= nN) return false; u.pm = c; u.pn = i; return true; }
    __device__ __forceinline__ void a_ready(const Unit&) const {}
    __device__ __forceinline__ void done(const Unit&) const {}
};
__device__ __forceinline__ unsigned cvt_pk_bf16(float lo, float hi) { unsigned r; asm volatile("v_cvt_pk_bf16_f32 %0, %1, %2" : "=v"(r) : "v"(lo), "v"(hi)); return r; }
template <class Epi, class Sched, bool ALIGN_EPI = false, bool SP2 = false, bool F8 = false, bool I8 = false>
__device__ __forceinline__ void gemm_phase(PG8_LAS unsigned char* lds, const Gemm g, const Sched& S, const Epi& E, const int wave_id) {
    int tid; asm volatile("v_mbcnt_lo_u32_b32 %0, -1, 0\n\tv_mbcnt_hi_u32_b32 %0, -1, %0" : "=v"(tid)); tid += wave_id * 64;
    const int wid = wave_id, lane = tid & 63, wr = wid >> 2, wc = wid & 3, fr = lane & 15, fq = lane >> 4;
    const int K = g.K, nt = (g.KE ? g.KE : K) / BK;
    unsigned voffA[2], voffB[2];
#pragma unroll
    for (int i = 0; i < 2; ++i) { int R, C; stage_rc(tid * 16 + i * 8192, R, C); const int Rb = Epi::PERM ? ((R & ~31) + perm32(R & 31)) : R;
        voffA[i] = (unsigned)(R * K + C) * 2u; voffB[i] = (unsigned)(Rb * K + C) * 2u; }
    const __amdgpu_buffer_rsrc_t rsrcA = __builtin_amdgcn_make_buffer_rsrc((void*)g.A, 0, 0x7fffffff, 0x00020000), rsrcB = __builtin_amdgcn_make_buffer_rsrc((void*)g.Bt, 0, 0x7fffffff, 0x00020000);
    const size_t kstep = (size_t)(BK * 2);
    const size_t hstep = (size_t)HALF * K * 2;
    const size_t tstep = 2 * hstep;
    const unsigned ldsw = (unsigned)wid * 1024u;
    const int aoff = lds_byte(wr * 64 + fr, fq * 8), boff = lds_byte(wc * 32 + fr, fq * 8);
#define PG8_SA(b, h) (((b) * 2 + (h)) * HTB)
#define PG8_SB(b, h) ((4 + (b) * 2 + (h)) * HTB)
#define PG8_STAGE(bufoff, gbase, voff) do { const bool isA_ = (+(voff) == +voffA); const unsigned soff_ = (unsigned)((const char*)(gbase) - (isA_ ? (const char*)g.A : (const char*)g.Bt)); _Pragma("unroll") for (int _i = 0; _i < 2; ++_i) \
        __builtin_amdgcn_raw_ptr_buffer_load_lds(isA_ ? rsrcA : rsrcB, (PG8_LAS unsigned*)(lds + (bufoff) + ldsw + _i * 8192), 16, (int)(voff)[_i], (int)soff_, 0, 0); } while (0)
#define PG8_LDA(dst, b, h) do { _Pragma("unroll") for (int m = 0; m < 4; ++m) { if constexpr (F8) { dst##8[m].lo = *(const PG8_LAS bf16x8*)(lds + PG8_SA(b, h) + aoff + m * 2048); dst##8[m].hi = *(const PG8_LAS bf16x8*)(lds + PG8_SA(b, h) + aoff + m * 2048 + 1024); } else { _Pragma("unroll") for (int k = 0; k < 2; ++k) dst[m][k] = *(const PG8_LAS bf16x8*)(lds + PG8_SA(b, h) + aoff + m * 2048 + k * 1024); } } } while (0)
#define PG8_LDB(dst, b, h) do { _Pragma("unroll") for (int n = 0; n < 2; ++n) { if constexpr (F8) { dst##8[n].lo = *(const PG8_LAS bf16x8*)(lds + PG8_SB(b, h) + boff + n * 2048); dst##8[n].hi = *(const PG8_LAS bf16x8*)(lds + PG8_SB(b, h) + boff + n * 2048 + 1024); } else { _Pragma("unroll") for (int k = 0; k < 2; ++k) dst[n][k] = *(const PG8_LAS bf16x8*)(lds + PG8_SB(b, h) + boff + n * 2048 + k * 1024); } } } while (0)
#define PG8_MMA(ai, bj, At, Bt) do { __builtin_amdgcn_s_setprio(1); _Pragma("unroll") for (int m = 0; m < 4; ++m) _Pragma("unroll") for (int n = 0; n < 2; ++n) { \
        if constexpr (F8) { typedef int v8i_ __attribute__((ext_vector_type(8))); \
            acc[ai][bj][m][n] = __builtin_amdgcn_mfma_scale_f32_16x16x128_f8f6f4(__builtin_bit_cast(v8i_, Bt##8[n]), __builtin_bit_cast(v8i_, At##8[m]), acc[ai][bj][m][n], 0, 0, 0, 0x7f79, 1, 0x7f79); }     \
        else if constexpr (I8) { typedef int v4i_ __attribute__((ext_vector_type(4))); \
            _Pragma("unroll") for (int k = 0; k < 2; ++k) acc[ai][bj][m][n] = __builtin_bit_cast(f32x4, __builtin_amdgcn_mfma_i32_16x16x64_i8(__builtin_bit_cast(v4i_, Bt[n][k]), __builtin_bit_cast(v4i_, At[m][k]), __builtin_bit_cast(v4i_, acc[ai][bj][m][n]), 0, 0, 0)); } \
        else { _Pragma("unroll") for (int k = 0; k < 2; ++k) acc[ai][bj][m][n] = __builtin_amdgcn_mfma_f32_16x16x32_bf16(Bt[n][k], At[m][k], acc[ai][bj][m][n], 0, 0, 0); } } \
        __builtin_amdgcn_s_setprio(0); } while (0)
#define PG8_WAIT_V(n) asm volatile("s_waitcnt vmcnt(" #n ")" ::: "memory")
#define PG8_WAIT_L(n) asm volatile("s_waitcnt lgkmcnt(" #n ")" ::: "memory")
#define PG8_BAR __builtin_amdgcn_s_barrier()
#define PG8_SCHED __builtin_amdgcn_sched_barrier(0)
    Unit cur, nxt; int ui = 0;
    if (!S.next(0, cur)) return;
    f32x4 acc[2][2][4][2];
#pragma unroll
    for (int a = 0; a < 2; ++a)
#pragma unroll
        for (int b = 0; b < 2; ++b)
#pragma unroll
            for (int m = 0; m < 4; ++m)
#pragma unroll
                for (int n = 0; n < 2; ++n) acc[a][b][m][n] = (f32x4){0.f, 0.f, 0.f, 0.f};
    typedef short bf16x16 __attribute__((ext_vector_type(16)));
    bf16x16 At8[4], B08[2], B18[2]; bf16x8 At[4][2], B0[2][2], B1[2][2];
    const char* cA = (const char*)g.A + (size_t)cur.pm * tstep; const char* cB = (const char*)g.Bt + (size_t)cur.pn * tstep;
    S.a_ready(cur);
    if constexpr (SP2) {
        PG8_STAGE(PG8_SB(0, 0), cB, voffB); PG8_STAGE(PG8_SB(0, 1), cB + hstep, voffB); PG8_STAGE(PG8_SA(0, 0), cA, voffA); PG8_STAGE(PG8_SA(0, 1), cA + hstep, voffA);
        if (wr == 1) PG8_BAR;
        PG8_WAIT_V(2); PG8_BAR;
        PG8_STAGE(PG8_SB(1, 0), cB + kstep, voffB); PG8_STAGE(PG8_SA(1, 0), cA + kstep, voffA); PG8_STAGE(PG8_SB(1, 1), cB + hstep + kstep, voffB);
        PG8_WAIT_V(6); PG8_BAR;
    } else {
        PG8_STAGE(PG8_SB(0, 0), cB, voffB); PG8_STAGE(PG8_SA(0, 0), cA, voffA); PG8_STAGE(PG8_SB(0, 1), cB + hstep, voffB); PG8_STAGE(PG8_SA(0, 1), cA + hstep, voffA);
        if (wr == 1) PG8_BAR;
        PG8_WAIT_V(4); PG8_BAR;
        PG8_STAGE(PG8_SB(1, 0), cB + kstep, voffB); PG8_STAGE(PG8_SA(1, 0), cA + kstep, voffA); PG8_STAGE(PG8_SB(1, 1), cB + hstep + kstep, voffB);
        PG8_WAIT_V(6); PG8_BAR;
    }
    for (;;) {
        const bool has_next = S.next(ui + 1, nxt);
        const char* nA = has_next ? (const char*)g.A + (size_t)nxt.pm * tstep : cA; const char* nB = has_next ? (const char*)g.Bt + (size_t)nxt.pn * tstep : cB;
        for (int t = 0; t < nt; t += 2) {
            const bool last = (t == nt - 2);
            const char* a1 = cA + (size_t)(t + 1) * kstep;
            const char* a2 = last ? nA : cA + (size_t)(t + 2) * kstep; const char* b2 = last ? nB : cB + (size_t)(t + 2) * kstep;
            const char* a3 = a2 + kstep; const char* b3 = b2 + kstep;
            if (last && has_next) S.a_ready(nxt);
            if constexpr (SP2) {
            PG8_LDB(B0, 0, 0); PG8_LDB(B1, 0, 1); PG8_SCHED; PG8_LDA(At, 0, 0); PG8_STAGE(PG8_SA(1, 1), a1 + hstep, voffA);
            PG8_WAIT_V(8); PG8_WAIT_L(0); PG8_BAR; PG8_MMA(0, 0, At, B0); PG8_MMA(0, 1, At, B1); PG8_BAR; PG8_SCHED;
            PG8_LDA(At, 0, 1); PG8_STAGE(PG8_SB(0, 0), b2, voffB); PG8_STAGE(PG8_SB(0, 1), b2 + hstep, voffB); PG8_STAGE(PG8_SA(0, 0), a2, voffA);
            PG8_WAIT_V(8); PG8_WAIT_L(0); PG8_BAR; PG8_MMA(1, 0, At, B0); PG8_MMA(1, 1, At, B1); PG8_BAR; PG8_SCHED;
            PG8_LDB(B0, 1, 0); PG8_LDB(B1, 1, 1); PG8_SCHED; PG8_LDA(At, 1, 0); PG8_STAGE(PG8_SA(0, 1), a2 + hstep, voffA);
            PG8_WAIT_V(8); PG8_WAIT_L(0); PG8_BAR; PG8_MMA(0, 0, At, B0); PG8_MMA(0, 1, At, B1); PG8_BAR; PG8_SCHED;
            PG8_LDA(At, 1, 1); PG8_STAGE(PG8_SB(1, 0), b3, voffB); PG8_STAGE(PG8_SB(1, 1), b3 + hstep, voffB); PG8_STAGE(PG8_SA(1, 0), a3, voffA);
            PG8_WAIT_V(8); PG8_WAIT_L(0); PG8_BAR; PG8_MMA(1, 0, At, B0); PG8_MMA(1, 1, At, B1); PG8_BAR; PG8_SCHED;
            } else {
            PG8_LDB(B0, 0, 0); PG8_SCHED; PG8_LDA(At, 0, 0); PG8_STAGE(PG8_SA(1, 1), a1 + hstep, voffA);
            PG8_WAIT_L(8); PG8_BAR; PG8_WAIT_L(0); PG8_MMA(0, 0, At, B0); PG8_BAR; PG8_SCHED;
            PG8_LDB(B1, 0, 1); PG8_STAGE(PG8_SB(0, 0), b2, voffB);
            PG8_BAR; PG8_WAIT_L(0); PG8_MMA(0, 1, At, B1); PG8_BAR;
            PG8_LDA(At, 0, 1); PG8_STAGE(PG8_SA(0, 0), a2, voffA);
            PG8_BAR; PG8_WAIT_L(0); PG8_MMA(1, 0, At, B0); PG8_BAR; PG8_SCHED;
            PG8_STAGE(PG8_SB(0, 1), b2 + hstep, voffB);
            PG8_WAIT_V(6); PG8_BAR; PG8_MMA(1, 1, At, B1); PG8_BAR;
            PG8_LDB(B0, 1, 0); PG8_SCHED; PG8_LDA(At, 1, 0); PG8_STAGE(PG8_SA(0, 1), a2 + hstep, voffA);
            PG8_WAIT_L(8); PG8_BAR; PG8_WAIT_L(0); PG8_MMA(0, 0, At, B0); PG8_BAR; PG8_SCHED;
            PG8_LDB(B1, 1, 1); PG8_STAGE(PG8_SB(1, 0), b3, voffB);
            PG8_BAR; PG8_WAIT_L(0); PG8_MMA(0, 1, At, B1); PG8_BAR;
            PG8_LDA(At, 1, 1); PG8_STAGE(PG8_SA(1, 0), a3, voffA);
            PG8_BAR; PG8_WAIT_L(0); PG8_MMA(1, 0, At, B0); PG8_BAR; PG8_SCHED;
            PG8_STAGE(PG8_SB(1, 1), b3 + hstep, voffB);
            PG8_WAIT_V(6); PG8_BAR; PG8_MMA(1, 1, At, B1); PG8_BAR;
            }
        }
        if constexpr (ALIGN_EPI) { if (wr == 0) PG8_BAR; }
        if constexpr (!Epi::AFTER_DRAIN) { int ln_e; asm volatile("v_mbcnt_lo_u32_b32 %0, -1, 0\n\tv_mbcnt_hi_u32_b32 %0, -1, %0" : "=v"(ln_e)); const int fr_e = ln_e & 15, fq_e = ln_e >> 4;
            E(acc, cur, wr, wc, fr_e, fq_e); S.done(cur); }
        if (!has_next) break;
#pragma unroll
        for (int a = 0; a < 2; ++a)
#pragma unroll
            for (int b = 0; b < 2; ++b)
#pragma unroll
                for (int m = 0; m < 4; ++m)
#pragma unroll
                    for (int n = 0; n < 2; ++n) acc[a][b][m][n] = (f32x4){0.f, 0.f, 0.f, 0.f};
        cur = nxt; cA = nA; cB = nB; ++ui;
        if constexpr (ALIGN_EPI) { if (wr == 1) PG8_BAR; }
    }
    PG8_WAIT_V(0);
    if constexpr (!ALIGN_EPI) { if (wr == 0) PG8_BAR; }
    PG8_BAR;
    if constexpr (Epi::AFTER_DRAIN) { E.fused(acc, cur, wr, wc, fr, fq, lds, wid, lane); S.done(cur); }
#undef PG8_SA
#undef PG8_SB
#undef PG8_STAGE
#undef PG8_LDA
#undef PG8_LDB
#undef PG8_MMA
#undef PG8_WAIT_V
#undef PG8_WAIT_L
#undef PG8_BAR
#undef PG8_SCHED
}
}
#define GAS __attribute__((address_space(1)))
#define LAS __attribute__((address_space(3)))
typedef unsigned short bf16;
typedef unsigned v4u __attribute__((ext_vector_type(4)));
typedef float f32x4 __attribute__((ext_vector_type(4)));
typedef short bf16x8 __attribute__((ext_vector_type(8)));
typedef GAS unsigned gu32;
typedef GAS unsigned long long gu64;
#define RLX_AGENT __ATOMIC_RELAXED, __HIP_MEMORY_SCOPE_AGENT
#define LDS_WAIT() asm volatile("s_waitcnt lgkmcnt(0)" ::: "memory")
#define VM_WAIT() asm volatile("s_waitcnt vmcnt(0)" ::: "memory")
__device__ __forceinline__ unsigned long long rt() { return __builtin_amdgcn_s_memrealtime(); }
__device__ __forceinline__ unsigned f2bf(float f) { unsigned u = __builtin_bit_cast(unsigned, f); return (u + 0x7fffu + ((u >> 16) & 1u)) >> 16; }
__device__ __forceinline__ unsigned pk2(float lo, float hi) { return f2bf(lo) | (f2bf(hi) << 16); }

#define XB_TMO      128
#define XB_XCNT(j)  (256  + 64 * (j))
#define XB_XSUB(j)  (1280 + 64 * (j))
#define XB_XGEN(j)  (2304 + 64 * (j))
#define XB_TOP      3328
#define XB_TOPGEN   3392
#define XCD_BAR_WORDS 3456
#define XB_SPIN_CAP (1u << 18)

__device__ __forceinline__ unsigned xb_ld(unsigned* p)              { return __hip_atomic_load(p, __ATOMIC_RELAXED, __HIP_MEMORY_SCOPE_AGENT); }
__device__ __forceinline__ unsigned xb_add(unsigned* p, unsigned v) { return __hip_atomic_fetch_add(p, v, __ATOMIC_RELAXED, __HIP_MEMORY_SCOPE_AGENT); }
__device__ __forceinline__ unsigned xb_xcc_id() { return (unsigned)__builtin_amdgcn_s_getreg((3 << 11) | 20) & 0xFu; }
#define XB_SPIN(cond, bar) do { unsigned _sp = 0; while (cond) { __builtin_amdgcn_s_sleep(1); \
    if ((++_sp & 255u) == 0u) { if (xb_ld(&(bar)[XB_TMO])) break; if (_sp > XB_SPIN_CAP) { atomicAdd(&(bar)[XB_TMO], 1u); break; } } } } while (0)

struct XcdBarrier {
    unsigned* bar; unsigned x; bool wave0;
    volatile LAS unsigned* st;
};

__device__ __forceinline__ XcdBarrier xcd_barrier_post(unsigned* bar, volatile LAS unsigned* st) {
    XcdBarrier b; b.bar = bar; b.x = xb_xcc_id(); b.st = st;
    if (threadIdx.x == 0) (void)xb_add(&bar[XB_XCNT(b.x)], 1u);
    return b;
}
__device__ __forceinline__ void xcd_barrier_complete(unsigned* bar, unsigned x, unsigned& nloc, unsigned& nx) {
    const unsigned G = gridDim.x * gridDim.y * gridDim.z;
    unsigned sum, cnt, mine, sp = 0u;
    for (;;) {
        sum = 0u; cnt = 0u; mine = 0u;
#pragma unroll
        for (unsigned j = 0; j < 16; ++j) { const unsigned c = xb_ld(&bar[XB_XCNT(j)]); sum += c; cnt += (c > 0u) ? 1u : 0u; mine = (j == x) ? c : mine; }
        if (sum == G) break;
        __builtin_amdgcn_s_sleep(1);
        if ((++sp & 255u) == 0u) { if (xb_ld(&bar[XB_TMO])) break; if (sp > XB_SPIN_CAP) { atomicAdd(&bar[XB_TMO], 1u); break; } }
    }
    nloc = mine > 0u ? mine : 1u; nx = cnt > 0u ? cnt : 1u;
}

__device__ __forceinline__ void xcd_barrier(const XcdBarrier& b) {
    asm volatile("s_waitcnt vmcnt(0)" ::: "memory");
    __syncthreads();
    if (b.wave0 && __builtin_amdgcn_mbcnt_hi(~0u, __builtin_amdgcn_mbcnt_lo(~0u, 0u)) == 0u) {
        unsigned* bar = b.bar;
        __builtin_amdgcn_s_waitcnt(0);
        unsigned nloc = b.st[0], nx = b.st[1];
        if (nloc == 0u) { xcd_barrier_complete(bar, b.x, nloc, nx); b.st[0] = nloc; b.st[1] = nx; }
        const unsigned old = xb_add(&bar[XB_XSUB(b.x)], 1u);
        const unsigned gen = old / nloc;
        if (old + 1u == (gen + 1u) * nloc) {
            __builtin_amdgcn_fence(__ATOMIC_RELEASE, "agent");
            asm volatile("s_waitcnt vmcnt(0)" ::: "memory");
            const unsigned og = xb_add(&bar[XB_TOP], 1u);
            const unsigned tg = og / nx;
            if (og + 1u == (tg + 1u) * nx) xb_add(&bar[XB_TOPGEN], 1u);
            else XB_SPIN(xb_ld(&bar[XB_TOPGEN]) == tg, bar);
            __builtin_amdgcn_fence(__ATOMIC_ACQUIRE, "agent");
            xb_add(&bar[XB_XGEN(b.x)], 1u);
            asm volatile("s_waitcnt vmcnt(0)" ::: "memory");
        } else {
            XB_SPIN(xb_ld(&bar[XB_XGEN(b.x)]) == gen, bar);
            __builtin_amdgcn_fence(__ATOMIC_ACQUIRE, "agent");
            asm volatile("s_waitcnt vmcnt(0)" ::: "memory");
        }
    }
    __syncthreads();
}

constexpr int NWAVES = 8, NTHREADS = NWAVES * 64;
constexpr int BATCH = 8, SEQ = 2048, T = BATCH * SEQ, D = 2048;
constexpr int EV_N = 7200, EV_NP = 7424, OD_N = 7616, OD_NP = 7680, PROJ_LD = 7680;
constexpr float EPS = 1e-6f;
constexpr int EC_GQ = 0, EC_GK = 512, EC_GV = 1024, EC_GZ = 2048, EC_GLR = 3072, EC_BQ = 3088, EC_BK = 4112, EC_BV = 5136, EC_BZ = 6160, EC_BA = 7184, EC_BB = 7192;
constexpr int OC_HQ = 0, OC_HF = 1024, OC_HI = 2048, OC_HG = 3072, OC_RW = 4096;
constexpr int RW_R = 0, RW_K = 1024, RW_V = 2048, RW_WL = 3072, RW_AL = 3168, RW_GL = 3264;
constexpr int LORA_K = 512, LORA_N = 3072;
enum { I_X = 0, I_P, I_EV_WIN, I_GK_W2, I_GK_B, I_GLA_NORM, I_GDN_CONV, I_GDN_ALOG, I_GDN_DTB, I_GDN_NORM, I_EV_WOUT, I_OD_WIN, I_LB, I_HG_NORM,
       I_MU, I_W0, I_W2, I_A0, I_A2, I_G2, I_KK, I_KA, I_RK, I_LNW, I_LNB, I_OD_WOUT, I_NMIX, I_NFFN, I_NPLE, I_PEER_WQ, I_PEER_SK, I_PEER_U, I_PEER_V,
       I_PLE_WP, I_PLE_WG, I_NFINAL, N_IN };

constexpr size_t MiB = 1u << 20;
constexpr size_t WS_CTL = 0, CTL_ZERO_BYTES = 1 * MiB, WS_SU = 256 * 1024, WS_CMB = 512 * 1024, WS_SA = 576 * 1024;
constexpr size_t WS_WEV_IN = 1 * MiB, WS_WEV_OUT = 30 * MiB, WS_WOD_IN = 38 * MiB, WS_WOD_OUT = 68 * MiB, WS_WPEER = 76 * MiB, WS_WGATE = 92 * MiB, WS_WPROJ = 108 * MiB,
                 WS_WLORA = 110 * MiB, WS_PBF = 113 * MiB, WS_TABU = 129 * MiB, WS_TABV = 193 * MiB, WS_ACTA = 257 * MiB, WS_ACTB = 321 * MiB, WS_PROJ = 385 * MiB, WS_SC = 385 * MiB,
                 WS_O = 625 * MiB, WS_H1 = 689 * MiB, WS_PP = 753 * MiB, WS_LA = 817 * MiB, WS_LO = 833 * MiB, WS_RSP = 929 * MiB, WS_STATE = 937 * MiB, WS_RS3 = 945 * MiB, WS_END = 946 * MiB;
static_assert(WS_WEV_IN + (size_t)EV_NP * D * 2 <= WS_WEV_OUT && WS_WOD_IN + (size_t)OD_NP * D * 2 <= WS_WOD_OUT && WS_PROJ + (size_t)T * PROJ_LD * 2 <= WS_O, "ws map");
constexpr int CW_BAR = 4096;
enum { RS_FFN0 = 0, RS_MIX1 = 1, RS_FFN1 = 2, RS_FINAL = 3 };
constexpr int RING_OFF = 0, RING_BYTES = 131072;
constexpr int LDSCTL_OFF = RING_BYTES, MISC_OFF = LDSCTL_OFF + 320;
constexpr int LDS_BYTES = 147456;

struct Args { const float* in[N_IN]; float* out; unsigned char* ws; int ph_lo, ph_hi; };
struct Frame {
    LAS unsigned char* lds; volatile LAS unsigned* MISC; gu32* ctl;
    int tid, lane, wave, vcu, G;
};
__device__ __forceinline__ float wave_sum(float v) {
#pragma unroll
    for (int o = 1; o < 64; o <<= 1) v += __shfl_xor(v, o);
    return v;
}
__device__ __forceinline__ float half_sum32(float v) {
#pragma unroll
    for (int o = 1; o < 32; o <<= 1) v += __shfl_xor(v, o);
    return v;
}
#define DPP_ADD(v, ctrl) (v) += __builtin_bit_cast(float, __builtin_amdgcn_update_dpp(0, __builtin_bit_cast(int, (v)), (ctrl), 0xF, 0xF, false))
__device__ __forceinline__ float row_sum16(float v) {
    DPP_ADD(v, 0x128); DPP_ADD(v, 0x124); DPP_ADD(v, 0x122); DPP_ADD(v, 0x121);
    return v;
}
__device__ __forceinline__ void row_sum16_x4(float& a, float& b, float& c, float& d) {
    asm("s_nop 1\n\t"
        "v_add_f32_dpp %0, %0, %0 row_ror:8 row_mask:0xf bank_mask:0xf\n\tv_add_f32_dpp %1, %1, %1 row_ror:8 row_mask:0xf bank_mask:0xf\n\t"
        "v_add_f32_dpp %2, %2, %2 row_ror:8 row_mask:0xf bank_mask:0xf\n\tv_add_f32_dpp %3, %3, %3 row_ror:8 row_mask:0xf bank_mask:0xf\n\t"
        "v_add_f32_dpp %0, %0, %0 row_ror:4 row_mask:0xf bank_mask:0xf\n\tv_add_f32_dpp %1, %1, %1 row_ror:4 row_mask:0xf bank_mask:0xf\n\t"
        "v_add_f32_dpp %2, %2, %2 row_ror:4 row_mask:0xf bank_mask:0xf\n\tv_add_f32_dpp %3, %3, %3 row_ror:4 row_mask:0xf bank_mask:0xf\n\t"
        "v_add_f32_dpp %0, %0, %0 row_ror:2 row_mask:0xf bank_mask:0xf\n\tv_add_f32_dpp %1, %1, %1 row_ror:2 row_mask:0xf bank_mask:0xf\n\t"
        "v_add_f32_dpp %2, %2, %2 row_ror:2 row_mask:0xf bank_mask:0xf\n\tv_add_f32_dpp %3, %3, %3 row_ror:2 row_mask:0xf bank_mask:0xf\n\t"
        "v_add_f32_dpp %0, %0, %0 row_ror:1 row_mask:0xf bank_mask:0xf\n\tv_add_f32_dpp %1, %1, %1 row_ror:1 row_mask:0xf bank_mask:0xf\n\t"
        "v_add_f32_dpp %2, %2, %2 row_ror:1 row_mask:0xf bank_mask:0xf\n\tv_add_f32_dpp %3, %3, %3 row_ror:1 row_mask:0xf bank_mask:0xf\n\t"
        "s_nop 1"
        : "+v"(a), "+v"(b), "+v"(c), "+v"(d));
}
__device__ __forceinline__ void row_sum16_x2(float& a, float& b) {
    asm("s_nop 1\n\t"
        "v_add_f32_dpp %0, %0, %0 row_ror:8 row_mask:0xf bank_mask:0xf\n\tv_add_f32_dpp %1, %1, %1 row_ror:8 row_mask:0xf bank_mask:0xf\n\ts_nop 1\n\t"
        "v_add_f32_dpp %0, %0, %0 row_ror:4 row_mask:0xf bank_mask:0xf\n\tv_add_f32_dpp %1, %1, %1 row_ror:4 row_mask:0xf bank_mask:0xf\n\ts_nop 1\n\t"
        "v_add_f32_dpp %0, %0, %0 row_ror:2 row_mask:0xf bank_mask:0xf\n\tv_add_f32_dpp %1, %1, %1 row_ror:2 row_mask:0xf bank_mask:0xf\n\ts_nop 1\n\t"
        "v_add_f32_dpp %0, %0, %0 row_ror:1 row_mask:0xf bank_mask:0xf\n\tv_add_f32_dpp %1, %1, %1 row_ror:1 row_mask:0xf bank_mask:0xf\n\t"
        "s_nop 1"
        : "+v"(a), "+v"(b));
}
typedef unsigned u32x2 __attribute__((ext_vector_type(2)));
__device__ __forceinline__ void st_wt16(void* p, v4u v) { asm volatile("global_store_dwordx4 %0, %1, off sc1\n\ts_nop 1" :: "v"(p), "v"(v) : "memory"); }
__device__ __forceinline__ void st_wt8(void* p, u32x2 v) { asm volatile("global_store_dwordx2 %0, %1, off sc1\n\ts_nop 1" :: "v"(p), "v"(v) : "memory"); }
#define LBAR() do { asm volatile("s_waitcnt lgkmcnt(0)" ::: "memory"); __builtin_amdgcn_s_barrier(); asm volatile("" ::: "memory"); } while (0)
typedef float f32x2 __attribute__((ext_vector_type(2)));
typedef __bf16 hwbf16x2_t __attribute__((ext_vector_type(2)));
__device__ __forceinline__ unsigned hw_pk2(float lo, float hi) { const f32x2 v = {lo, hi}; return __builtin_bit_cast(unsigned, __builtin_convertvector(v, hwbf16x2_t)); }
__device__ __forceinline__ bf16 hw_bf(float x) { return (bf16)hw_pk2(x, 0.f); }
__device__ __forceinline__ float bf_lo(unsigned w) { return __uint_as_float(w << 16); }
__device__ __forceinline__ float bf_hi(unsigned w) { return __uint_as_float(w & 0xffff0000u); }
__device__ __forceinline__ float sigmoidf_(float x) { return __builtin_amdgcn_rcpf(1.0f + __expf(-x)); }
__device__ __forceinline__ float siluf_(float x) { return x * __builtin_amdgcn_rcpf(1.0f + __expf(-x)); }
__device__ __forceinline__ float softplusf_(float x) { return fmaxf(x, 0.f) + log1pf(__expf(-fabsf(x))); }
__device__ __forceinline__ float logsigmoidf_(float x) { return fminf(x, 0.f) - log1pf(__expf(-fabsf(x))); }

struct EpiBf16S {
    static constexpr bool PERM = true, AFTER_DRAIN = false;
    bf16* O; int ldc; const float* rowss;
    __device__ __forceinline__ void operator()(const pg8::f32x4 (&acc)[2][2][4][2], const pg8::Unit& u, int wr, int wc, int fr, int fq) const {
        const int row0 = u.pm * 256 + wr * 64 + fr, col0 = u.pn * 256 + wc * 32 + 8 * fq;
#pragma unroll
        for (int ai = 0; ai < 2; ++ai)
#pragma unroll
            for (int m = 0; m < 4; ++m) {
                const int row = row0 + ai * 128 + m * 16;
                float sc = 1.f;
                if (rowss) { const pg8::f32x4* rp = (const pg8::f32x4*)(rowss + (size_t)row * 32 + 8 * fq); const pg8::f32x4 p0 = rp[0], p1 = rp[1];
                    float s = ((p0[0] + p0[1]) + (p0[2] + p0[3])) + ((p1[0] + p1[1]) + (p1[2] + p1[3])); s += __shfl_xor(s, 16); s += __shfl_xor(s, 32);
                    sc = __builtin_amdgcn_rsqf(s * (1.0f / D) + EPS); }
                bf16* rowp = O + (size_t)row * ldc + col0;
#pragma unroll
                for (int bj = 0; bj < 2; ++bj) { const pg8::f32x4 v0 = acc[ai][bj][m][0] * sc, v1 = acc[ai][bj][m][1] * sc;
                    pg8::u32x4 w; w.x = pg8::cvt_pk_bf16(v0[0], v0[1]); w.y = pg8::cvt_pk_bf16(v0[2], v0[3]); w.z = pg8::cvt_pk_bf16(v1[0], v1[1]); w.w = pg8::cvt_pk_bf16(v1[2], v1[3]);
                    *(pg8::u32x4*)(rowp + bj * 128) = w; } }
    }
};
struct EpiI8S {
    static constexpr bool PERM = true, AFTER_DRAIN = false;
    bf16* O; int ldc; const float* sa; const float* cb;
    __device__ __forceinline__ void operator()(const pg8::f32x4 (&acc)[2][2][4][2], const pg8::Unit& u, int wr, int wc, int fr, int fq) const {
        const int row0 = u.pm * 256 + wr * 64 + fr, col0 = u.pn * 256 + wc * 32 + 8 * fq;
        pg8::f32x4 cs[2][2];
#pragma unroll
        for (int bj = 0; bj < 2; ++bj) { cs[bj][0] = *(const pg8::f32x4*)(cb + col0 + bj * 128); cs[bj][1] = *(const pg8::f32x4*)(cb + col0 + bj * 128 + 4); }
#pragma unroll
        for (int ai = 0; ai < 2; ++ai)
#pragma unroll
            for (int m = 0; m < 4; ++m) {
                const int row = row0 + ai * 128 + m * 16;
                const float sc = sa[row];
                bf16* rowp = O + (size_t)row * ldc + col0;
#pragma unroll
                for (int bj = 0; bj < 2; ++bj) { pg8::f32x4 v0, v1;
#pragma unroll
                    for (int e = 0; e < 4; ++e) { v0[e] = (float)__float_as_int(acc[ai][bj][m][0][e]) * sc * cs[bj][0][e]; v1[e] = (float)__float_as_int(acc[ai][bj][m][1][e]) * sc * cs[bj][1][e]; }
                    pg8::u32x4 w; w.x = pg8::cvt_pk_bf16(v0[0], v0[1]); w.y = pg8::cvt_pk_bf16(v0[2], v0[3]); w.z = pg8::cvt_pk_bf16(v1[0], v1[1]); w.w = pg8::cvt_pk_bf16(v1[2], v1[3]);
                    *(pg8::u32x4*)(rowp + bj * 128) = w; } }
    }
};
template <bool GATE, bool HIN_F32, bool I8 = false> struct EpiResid {
    static constexpr bool PERM = false, AFTER_DRAIN = false;
    const void* hin; bf16* hout; float* rowss; const bf16* pp; const float* rs3; unsigned char* h8; const float* sa; const float* cb;
    __device__ __forceinline__ void operator()(const pg8::f32x4 (&acc)[2][2][4][2], const pg8::Unit& u, int wr, int wc, int fr, int fq) const {
        const int row0 = u.pm * 256 + wr * 64 + fr, col0 = u.pn * 256 + wc * 32 + 4 * fq;
        pg8::f32x4 cs[2][2];
        if constexpr (I8) {
#pragma unroll
            for (int bj = 0; bj < 2; ++bj)
#pragma unroll
                for (int n = 0; n < 2; ++n) cs[bj][n] = *(const pg8::f32x4*)(cb + col0 + bj * 128 + n * 16); }
        constexpr int MG = HIN_F32 ? 2 : 4;
#pragma unroll
        for (int ai = 0; ai < 2; ++ai)
#pragma unroll
            for (int m0 = 0; m0 < 4; m0 += MG) {
                pg8::f32x4 hf[MG][2][2]; pg8::u32x2 hb[MG][2][2], pw[MG][2][2]; float rsc[MG];
#pragma unroll
                for (int mm = 0; mm < MG; ++mm) { const int row = row0 + ai * 128 + (m0 + mm) * 16; const size_t off = (size_t)row * D + col0; rsc[mm] = GATE ? rs3[row] : (I8 ? sa[row] : 1.f);
#pragma unroll
                    for (int bj = 0; bj < 2; ++bj)
#pragma unroll
                        for (int n = 0; n < 2; ++n) { const size_t o = off + bj * 128 + n * 16;
                            if (HIN_F32) hf[mm][bj][n] = *(const pg8::f32x4*)((const float*)hin + o); else hb[mm][bj][n] = *(const pg8::u32x2*)((const bf16*)hin + o);
                            if (GATE) pw[mm][bj][n] = *(const pg8::u32x2*)(pp + o); } }
#pragma unroll
                for (int mm = 0; mm < MG; ++mm) { const int m = m0 + mm; const int row = row0 + ai * 128 + m * 16; const size_t off = (size_t)row * D + col0; float ss = 0.f;
#pragma unroll
                    for (int bj = 0; bj < 2; ++bj)
#pragma unroll
                        for (int n = 0; n < 2; ++n) { const size_t o = off + bj * 128 + n * 16;
                            pg8::f32x4 hv;
                            if (HIN_F32) hv = hf[mm][bj][n];
                            else { const pg8::u32x2 hw = hb[mm][bj][n]; hv[0] = bf_lo(hw.x); hv[1] = bf_hi(hw.x); hv[2] = bf_lo(hw.y); hv[3] = bf_hi(hw.y); }
                            pg8::f32x4 a = acc[ai][bj][m][n];
                            if constexpr (I8 && !GATE) { const float sr_ = rsc[mm];
#pragma unroll
                                for (int e = 0; e < 4; ++e) a[e] = (float)__float_as_int(a[e]) * sr_ * cs[bj][n][e]; }
                            if (GATE) { const pg8::u32x2 p2 = pw[mm][bj][n]; const float rs_ = rsc[mm];
                                a[0] = sigmoidf_(a[0] * rs_) * bf_lo(p2.x); a[1] = sigmoidf_(a[1] * rs_) * bf_hi(p2.x); a[2] = sigmoidf_(a[2] * rs_) * bf_lo(p2.y); a[3] = sigmoidf_(a[3] * rs_) * bf_hi(p2.y); }
                            hv = hv + a;
                            pg8::u32x2 w; w.x = hw_pk2(hv[0], hv[1]); w.y = hw_pk2(hv[2], hv[3]); *(pg8::u32x2*)(hout + o) = w;
                            if (h8) { int x8 = __builtin_amdgcn_cvt_pk_fp8_f32(hv[0], hv[1], 0, false); x8 = __builtin_amdgcn_cvt_pk_fp8_f32(hv[2], hv[3], x8, true); *(unsigned*)(h8 + o) = (unsigned)x8; }
                            const float q0 = bf_lo(w.x), q1 = bf_hi(w.x), q2 = bf_lo(w.y), q3 = bf_hi(w.y);
                            ss += (q0 * q0 + q1 * q1) + (q2 * q2 + q3 * q3); }
                    ss += __shfl_xor(ss, 16); ss += __shfl_xor(ss, 32);
                    if (fq == 0) rowss[(size_t)row * 32 + u.pn * 4 + wc] = ss; }
                asm volatile("" ::: "memory"); }
    }
};


__device__ __forceinline__ void p0_transpose_item(const float* W, int K, int N, bf16* WT, LAS float* scr, int item, int lane, const float* kgain = nullptr) {
    const int nblk = N / 32, kb = item / nblk, nb = item % nblk, k0 = 64 * kb, n0 = 32 * nb;
    { const GAS float* Wg = (const GAS float*)W + (size_t)(k0 + (lane >> 5)) * N + n0 + (lane & 31); float v[32];
#pragma unroll
      for (int i = 0; i < 32; ++i) v[i] = Wg[(size_t)(2 * i) * N];
#pragma unroll
      for (int i = 0; i < 32; ++i) scr[(2 * i + (lane >> 5)) * 33 + (lane & 31)] = v[i]; }
    LDS_WAIT(); asm volatile("" ::: "memory");
    const int c = lane & 7;
#pragma unroll
    for (int j = 0; j < 4; ++j) { const int n = (lane >> 3) + 8 * j; const LAS float* s = scr + (8 * c) * 33 + n;
        f32x4 g0 = {1.f, 1.f, 1.f, 1.f}, g1 = g0; if (kgain) { g0 = *(const GAS f32x4*)(kgain + k0 + 8 * c); g1 = *(const GAS f32x4*)(kgain + k0 + 8 * c + 4); }
        v4u o; o.x = pk2(s[0 * 33] * g0[0], s[1 * 33] * g0[1]); o.y = pk2(s[2 * 33] * g0[2], s[3 * 33] * g0[3]); o.z = pk2(s[4 * 33] * g1[0], s[5 * 33] * g1[1]); o.w = pk2(s[6 * 33] * g1[2], s[7 * 33] * g1[3]);
        *(GAS v4u*)(WT + (size_t)(n0 + n) * K + k0 + 8 * c) = o; }
    LDS_WAIT(); asm volatile("" ::: "memory");
}
__device__ __forceinline__ void p0_transpose_item_i8(const float* W, int K, int N, unsigned char* WT, LAS float* scr, int item, int lane, const float* cm) {
    const int nblk = N / 32, kb = item / nblk, nb = item % nblk, k0 = 64 * kb, n0 = 32 * nb;
    { const GAS float* Wg = (const GAS float*)W + (size_t)(k0 + (lane >> 5)) * N + n0 + (lane & 31); float v[32];
#pragma unroll
      for (int i = 0; i < 32; ++i) v[i] = Wg[(size_t)(2 * i) * N];
#pragma unroll
      for (int i = 0; i < 32; ++i) scr[(2 * i + (lane >> 5)) * 33 + (lane & 31)] = v[i]; }
    LDS_WAIT(); asm volatile("" ::: "memory");
    const int c = lane & 7;
#pragma unroll
    for (int j = 0; j < 4; ++j) { const int n = (lane >> 3) + 8 * j; const LAS float* s = scr + (8 * c) * 33 + n;
        const float mx = __uint_as_float(__hip_atomic_load((const unsigned*)cm + n0 + n, __ATOMIC_RELAXED, __HIP_MEMORY_SCOPE_AGENT)), inv = mx > 0.f ? 127.0f / mx : 0.f; unsigned w0 = 0, w1 = 0;
#pragma unroll
        for (int e = 0; e < 4; ++e) { w0 |= (__float_as_uint(__builtin_fmaf(s[e * 33], inv, 12582912.0f)) & 255u) << (8 * e); w1 |= (__float_as_uint(__builtin_fmaf(s[(4 + e) * 33], inv, 12582912.0f)) & 255u) << (8 * e); }
        u32x2 o; o.x = w0; o.y = w1;
        *(GAS u32x2*)(WT + (size_t)(n0 + n) * K + k0 + 8 * c) = o; }
    LDS_WAIT(); asm volatile("" ::: "memory");
}
__device__ __forceinline__ void colmax_item(const float* W, int K, int N, float* cm, int item, int lane) {
    const int ngrp = (N + 255) / 256, kb = item / ngrp, cg_ = item % ngrp, col = 256 * cg_ + 4 * lane;
    if (col >= N) return;
    const GAS f32x4* p = (const GAS f32x4*)((const GAS float*)W + (size_t)(64 * kb) * N + col); f32x4 m = {0.f, 0.f, 0.f, 0.f};
#pragma unroll 16
    for (int r = 0; r < 64; ++r) { const f32x4 v = *(const GAS f32x4*)((const GAS float*)p + (size_t)r * N);
#pragma unroll
        for (int e = 0; e < 4; ++e) m[e] = fmaxf(m[e], fabsf(v[e])); }
#pragma unroll
    for (int e = 0; e < 4; ++e) __hip_atomic_fetch_max((unsigned*)cm + col + e, __float_as_uint(m[e]), __ATOMIC_RELAXED, __HIP_MEMORY_SCOPE_AGENT);
}
__device__ __forceinline__ void p0_transpose_item_f8(const float* W, int K, int N, unsigned char* WT, LAS float* scr, int item, int lane, const float* kgain = nullptr) {
    const int nblk = N / 32, kb = item / nblk, nb = item % nblk, k0 = 64 * kb, n0 = 32 * nb;
    { const GAS float* Wg = (const GAS float*)W + (size_t)(k0 + (lane >> 5)) * N + n0 + (lane & 31); float v[32];
#pragma unroll
      for (int i = 0; i < 32; ++i) v[i] = Wg[(size_t)(2 * i) * N];
#pragma unroll
      for (int i = 0; i < 32; ++i) scr[(2 * i + (lane >> 5)) * 33 + (lane & 31)] = v[i]; }
    LDS_WAIT(); asm volatile("" ::: "memory");
    const int c = lane & 7;
#pragma unroll
    for (int j = 0; j < 4; ++j) { const int n = (lane >> 3) + 8 * j; const LAS float* s = scr + (8 * c) * 33 + n;
        f32x4 g0 = {64.f, 64.f, 64.f, 64.f}, g1 = g0; if (kgain) { g0 = g0 * *(const GAS f32x4*)(kgain + k0 + 8 * c); g1 = g1 * *(const GAS f32x4*)(kgain + k0 + 8 * c + 4); }
        int x0 = __builtin_amdgcn_cvt_pk_fp8_f32(s[0 * 33] * g0[0], s[1 * 33] * g0[1], 0, false); x0 = __builtin_amdgcn_cvt_pk_fp8_f32(s[2 * 33] * g0[2], s[3 * 33] * g0[3], x0, true);
        int x1 = __builtin_amdgcn_cvt_pk_fp8_f32(s[4 * 33] * g1[0], s[5 * 33] * g1[1], 0, false); x1 = __builtin_amdgcn_cvt_pk_fp8_f32(s[6 * 33] * g1[2], s[7 * 33] * g1[3], x1, true);
        u32x2 o; o.x = (unsigned)x0; o.y = (unsigned)x1;
        *(GAS u32x2*)(WT + (size_t)(n0 + n) * K + k0 + 8 * c) = o; }
    LDS_WAIT(); asm volatile("" ::: "memory");
}
__device__ __forceinline__ void cvt_f32_bf16(const float* src, bf16* dst, size_t n, int gtid, int gthreads) {
    const size_t n8 = n / 8;
    for (size_t i = gtid; i < n8; i += gthreads) {
        const f32x4 a = *(const GAS f32x4*)(src + i * 8), b = *(const GAS f32x4*)(src + i * 8 + 4);
        v4u o; o.x = pk2(a[0], a[1]); o.y = pk2(a[2], a[3]); o.z = pk2(b[0], b[1]); o.w = pk2(b[2], b[3]);
        *(GAS v4u*)(dst + i * 8) = o; }
}
__device__ __forceinline__ void cvt_f32_fp8(const float* src, unsigned char* dst, size_t n, float scale, int gtid, int gthreads, const float* cgain = nullptr) {
    const size_t n16 = n / 16;
    for (size_t i = gtid; i < n16; i += gthreads) { v4u o; unsigned w[4];
#pragma unroll
        for (int q = 0; q < 4; ++q) { f32x4 a = *(const GAS f32x4*)(src + i * 16 + 4 * q) * scale; if (cgain) a = a * *(const GAS f32x4*)(cgain + ((i * 16 + 4 * q) & (D - 1)));
            int x = __builtin_amdgcn_cvt_pk_fp8_f32(a[0], a[1], 0, false); x = __builtin_amdgcn_cvt_pk_fp8_f32(a[2], a[3], x, true); w[q] = (unsigned)x; }
        o.x = w[0]; o.y = w[1]; o.z = w[2]; o.w = w[3];
        *(GAS v4u*)(dst + i * 16) = o; }
}
__device__ __forceinline__ void cvt_rows_i8(const float* src, unsigned char* dst, float* SU, int rows, int gw, int NGW, int lane, const float* cgain) {
    f32x4 a[8], nx[8];
    int r = gw;
    if (r < rows) {
#pragma unroll
        for (int i = 0; i < 8; ++i) a[i] = *(const GAS f32x4*)(src + (size_t)r * D + 256 * i + 4 * lane); }
    for (; r < rows; r += NGW) {
        const int rn = r + NGW;
        if (rn < rows) {
#pragma unroll
            for (int i = 0; i < 8; ++i) nx[i] = *(const GAS f32x4*)(src + (size_t)rn * D + 256 * i + 4 * lane); }
        float mx = 0.f;
#pragma unroll
        for (int i = 0; i < 8; ++i) { if (cgain) a[i] = a[i] * *(const GAS f32x4*)(cgain + 256 * i + 4 * lane);
            mx = fmaxf(mx, fmaxf(fmaxf(fabsf(a[i][0]), fabsf(a[i][1])), fmaxf(fabsf(a[i][2]), fabsf(a[i][3])))); }
#pragma unroll
        for (int o = 1; o < 64; o <<= 1) mx = fmaxf(mx, __shfl_xor(mx, o));
        const float inv = mx > 0.f ? 127.0f / mx : 0.f;
#pragma unroll
        for (int i = 0; i < 8; ++i) { unsigned w = 0;
#pragma unroll
            for (int e = 0; e < 4; ++e) w |= (__float_as_uint(__builtin_fmaf(a[i][e], inv, 12582912.0f)) & 255u) << (8 * e);
            *(GAS unsigned*)(dst + (size_t)r * D + 256 * i + 4 * lane) = w; }
        if (lane == 0) SU[r] = mx * (1.0f / 127.0f);
#pragma unroll
        for (int i = 0; i < 8; ++i) a[i] = nx[i];
    }
}
__device__ __forceinline__ void rms_row_to_bf16(const float* xrow, const float* g, bf16* orow, int lane) {
    const GAS f32x4* xr = (const GAS f32x4*)xrow + lane; f32x4 v[8]; float s = 0.f;
#pragma unroll
    for (int j = 0; j < 8; ++j) { v[j] = xr[64 * j]; s += (v[j][0] * v[j][0] + v[j][1] * v[j][1]) + (v[j][2] * v[j][2] + v[j][3] * v[j][3]); }
    const float r = __builtin_amdgcn_rsqf(wave_sum(s) * (1.0f / D) + EPS);
    const GAS f32x4* gr = (const GAS f32x4*)g + lane;
    GAS unsigned long long* o8 = (GAS unsigned long long*)orow + lane;
#pragma unroll
    for (int j = 0; j < 8; ++j) { const f32x4 gg = gr[64 * j]; o8[64 * j] = (unsigned long long)pk2(v[j][0] * r * gg[0], v[j][1] * r * gg[1]) | ((unsigned long long)pk2(v[j][2] * r * gg[2], v[j][3] * r * gg[3]) << 32); }
}
__device__ __forceinline__ void rms_row_to_i8(const float* xrow, const float* g, unsigned char* orow, float* sa, int lane) {
    const GAS f32x4* xr = (const GAS f32x4*)xrow + lane; f32x4 v[8]; float s = 0.f;
#pragma unroll
    for (int j = 0; j < 8; ++j) { v[j] = xr[64 * j]; s += (v[j][0] * v[j][0] + v[j][1] * v[j][1]) + (v[j][2] * v[j][2] + v[j][3] * v[j][3]); }
    const float r = __builtin_amdgcn_rsqf(wave_sum(s) * (1.0f / D) + EPS);
    const GAS f32x4* gr = (const GAS f32x4*)g + lane; float mx = 0.f;
#pragma unroll
    for (int j = 0; j < 8; ++j) { v[j] = v[j] * gr[64 * j] * r; mx = fmaxf(mx, fmaxf(fmaxf(fabsf(v[j][0]), fabsf(v[j][1])), fmaxf(fabsf(v[j][2]), fabsf(v[j][3])))); }
#pragma unroll
    for (int o = 1; o < 64; o <<= 1) mx = fmaxf(mx, __shfl_xor(mx, o));
    const float inv = mx > 0.f ? 127.0f / mx : 0.f;
    GAS unsigned* o4 = (GAS unsigned*)orow + lane;
#pragma unroll
    for (int j = 0; j < 8; ++j) { unsigned w = 0;
#pragma unroll
        for (int e = 0; e < 4; ++e) w |= (__float_as_uint(__builtin_fmaf(v[j][e], inv, 12582912.0f)) & 255u) << (8 * e);
        o4[64 * j] = w; }
    if (lane == 0) *sa = mx * (1.0f / (127.0f * 127.0f));
}
__device__ __forceinline__ void rms_row_to_f8(const float* xrow, const float* g, unsigned char* orow, int lane) {
    const GAS f32x4* xr = (const GAS f32x4*)xrow + lane; f32x4 v[8]; float s = 0.f;
#pragma unroll
    for (int j = 0; j < 8; ++j) { v[j] = xr[64 * j]; s += (v[j][0] * v[j][0] + v[j][1] * v[j][1]) + (v[j][2] * v[j][2] + v[j][3] * v[j][3]); }
    const float r = __builtin_amdgcn_rsqf(wave_sum(s) * (1.0f / D) + EPS);
    const GAS f32x4* gr = (const GAS f32x4*)g + lane;
    GAS unsigned* o4 = (GAS unsigned*)orow + lane;
#pragma unroll
    for (int j = 0; j < 8; ++j) { const f32x4 q = v[j] * gr[64 * j] * r; int x = __builtin_amdgcn_cvt_pk_fp8_f32(q[0], q[1], 0, false); x = __builtin_amdgcn_cvt_pk_fp8_f32(q[2], q[3], x, true); o4[64 * j] = (unsigned)x; }
}
__device__ __forceinline__ void p0_fold_item(const float* wq, const float* sk, bf16* WP, LAS float* lds, int item, int tid, const float* kgain) {
    const int hp = item >> 5, k0 = (item & 31) * 64;
    LAS float* skT = lds;
    LAS float* wqT = lds + 128 * 132;
    const float* skb = sk + (size_t)hp * 128 * 128;
    { const GAS float* sg = (const GAS float*)skb; const GAS float* wg = (const GAS float*)wq; const GAS float* kg = (const GAS float*)kgain; float v[32], w[16];
#pragma unroll
      for (int i = 0; i < 32; ++i) v[i] = sg[i * 512 + tid];
#pragma unroll
      for (int i = 0; i < 16; ++i) { const int idx = i * 512 + tid, kk = idx >> 7, d = idx & 127; w[i] = wg[(size_t)(k0 + kk) * D + hp * 128 + d] * kg[k0 + kk]; }
#pragma unroll
      for (int i = 0; i < 32; ++i) { const int idx = i * 512 + tid, n = idx >> 7, d = idx & 127; skT[d * 132 + n] = v[i]; }
#pragma unroll
      for (int i = 0; i < 16; ++i) { const int idx = i * 512 + tid, kk = idx >> 7, d = idx & 127; wqT[d * 68 + kk] = w[i]; } }
    __syncthreads();
    const int n0 = (tid >> 4) * 4, kk0 = (tid & 15) * 4;
    float acc[4][4];
#pragma unroll
    for (int i = 0; i < 4; ++i)
#pragma unroll
        for (int j = 0; j < 4; ++j) acc[i][j] = 0.f;
#pragma unroll 4
    for (int d = 0; d < 128; ++d) { const f32x4 a = *(const LAS f32x4*)(skT + d * 132 + n0), b = *(const LAS f32x4*)(wqT + d * 68 + kk0);
#pragma unroll
        for (int i = 0; i < 4; ++i)
#pragma unroll
            for (int j = 0; j < 4; ++j) acc[i][j] += a[i] * b[j]; }
#pragma unroll
    for (int i = 0; i < 4; ++i) { unsigned long long o = (unsigned long long)pk2(acc[i][0], acc[i][1]) | ((unsigned long long)pk2(acc[i][2], acc[i][3]) << 32);
        *(GAS unsigned long long*)(WP + (size_t)(hp * 128 + n0 + i) * D + k0 + kk0) = o; }
    __syncthreads();
}
__device__ __forceinline__ void p0_prologue(const Args& A, Frame& F, const int part) {
    const int gw = F.vcu * NWAVES + F.wave, NGW = F.G * NWAVES;
    const int gtid = gw * 64 + F.lane, gthreads = F.G * NTHREADS;
    unsigned char* ws = A.ws;
    LAS float* scr = (LAS float*)(F.lds + RING_OFF + F.wave * 16384);
    constexpr int I_EVIN = (D / 64) * (EV_N / 32);
    if (part == 1) {
        for (int it = gw; it < I_EVIN; it += NGW) p0_transpose_item_i8(A.in[I_EV_WIN], D, EV_N, (unsigned char*)(ws + WS_WEV_IN), scr, it, F.lane, (const float*)(ws + WS_CMB));
        return; }
    { constexpr int I_CM = (D / 64) * ((EV_N + 255) / 256);
      for (int it = gw; it < I_CM; it += NGW) colmax_item(A.in[I_EV_WIN], D, EV_N, (float*)(ws + WS_CMB), it, F.lane); }
    { GAS v4u* z0 = (GAS v4u*)(ws + WS_WEV_IN + (size_t)EV_N * D); const size_t n0 = (size_t)(EV_NP - EV_N) * D / 16;
      for (size_t i = gtid; i < n0; i += gthreads) z0[i] = (v4u){0u, 0u, 0u, 0u}; }
    { constexpr int I_PJ = (256 / 64) * (D / 32);
      for (int it = gw; it < 2 * I_PJ; it += NGW) { const int L = it / I_PJ; p0_transpose_item(A.in[I_PLE_WP] + (size_t)L * 256 * D, 256, D, (bf16*)(ws + WS_WPROJ) + (size_t)L * D * 256, scr, it % I_PJ, F.lane); } }
    if (F.G < 256) cvt_f32_bf16(A.in[I_P], (bf16*)(ws + WS_PBF), (size_t)2 * T * 256, gtid, gthreads);
    for (int m = gw; m < T; m += NGW) rms_row_to_i8(A.in[I_X] + (size_t)m * D, A.in[I_NMIX], (unsigned char*)(ws + WS_ACTA) + (size_t)m * D, (float*)(ws + WS_SA) + m, F.lane);
#if EV_F8_T1 > EV_F8_T0
    for (int it = gw; it < I_EVIN; it += NGW) p0_transpose_item_f8(A.in[I_EV_WIN], D, EV_N, (unsigned char*)(ws + WS_O), scr, it, F.lane);
    { GAS v4u* z0 = (GAS v4u*)(ws + WS_O + (size_t)EV_N * D); const size_t n0 = (size_t)(EV_NP - EV_N) * D / 16;
      for (size_t i = gtid; i < n0; i += gthreads) z0[i] = (v4u){0u, 0u, 0u, 0u}; }
    for (int m = gw; m < T; m += NGW) rms_row_to_f8(A.in[I_X] + (size_t)m * D, A.in[I_NMIX], (unsigned char*)(ws + WS_H1) + (size_t)m * D, F.lane);
#endif
}
__device__ __forceinline__ void p0_deferred(const Args& A, Frame& F, int wg, int nwg) {
    const int gw = wg * NWAVES + F.wave, NGW = nwg * NWAVES;
    int gtid = gw * 64 + F.lane; const int gthreads = nwg * NTHREADS;
    asm volatile("" : "+v"(gtid));
    unsigned char* ws = A.ws;
    {
        LAS float* scr = (LAS float*)(F.lds + RING_OFF + F.wave * 16384);
        constexpr int I_SQ = (D / 64) * (D / 32), I_ODIN = (D / 64) * (OD_N / 32);
        constexpr int NITEMS = I_SQ + I_ODIN + I_SQ;
        for (int it = gw; it < NITEMS; it += NGW) {
            int r = it;
            if (r < I_SQ) { p0_transpose_item(A.in[I_EV_WOUT], D, D, (bf16*)(ws + WS_WEV_OUT), scr, r, F.lane); continue; } r -= I_SQ;
            if (r < I_ODIN) { p0_transpose_item_f8(A.in[I_OD_WIN], D, OD_N, (unsigned char*)(ws + WS_WOD_IN), scr, r, F.lane, A.in[I_NMIX] + D); continue; } r -= I_ODIN;
            p0_transpose_item_f8(A.in[I_PLE_WG], D, D, (unsigned char*)(ws + WS_WGATE), scr, r, F.lane, A.in[I_NPLE]);
        }
        { GAS v4u* z1 = (GAS v4u*)(ws + WS_WOD_IN + (size_t)OD_N * D); const size_t n1 = (size_t)(OD_NP - OD_N) * D / 16;
          for (size_t i = gtid; i < n1; i += gthreads) z1[i] = (v4u){0u, 0u, 0u, 0u}; }
    }
    __syncthreads();
    for (int it = wg; it < 512; it += nwg)
        p0_fold_item(A.in[I_PEER_WQ], A.in[I_PEER_SK], (bf16*)(ws + WS_WPEER), (LAS float*)(F.lds + RING_OFF), it, F.tid, A.in[I_NFFN]);
    cvt_rows_i8(A.in[I_PEER_U], (unsigned char*)(ws + WS_TABU), (float*)(ws + WS_SU), 16384, gw, NGW, F.lane, A.in[I_NFFN]);
    cvt_rows_i8(A.in[I_PEER_V], (unsigned char*)(ws + WS_TABV), (float*)(ws + WS_SU) + 32768, 16384, gw, NGW, F.lane, nullptr);
    { bf16* LB = (bf16*)(ws + WS_WLORA); const float* w2 = A.in[I_W2]; const float* a2 = A.in[I_A2]; const float* g2 = A.in[I_G2];
      for (int i = gtid; i < LORA_N * LORA_K / 2; i += gthreads) { const int row = i / (LORA_K / 2), col = (i % (LORA_K / 2)) * 2; float v[2];
#pragma unroll
          for (int e = 0; e < 2; ++e) { const int c = col + e; float x = 0.f;
              if (row < 1024) { if (c < 96) x = w2[c * 1024 + row]; }
              else if (row < 2048) { if (c >= 96 && c < 192) x = a2[(c - 96) * 1024 + (row - 1024)]; }
              else { if (c >= 192 && c < 448) x = g2[(c - 192) * 1024 + (row - 2048)]; }
              v[e] = x; }
          *(GAS unsigned*)(LB + (size_t)row * LORA_K + col) = pk2(v[0], v[1]); } }
}
__device__ __forceinline__ void p1_deferred(const Args& A, Frame& F, int wg, int nwg) {
    const int gw = wg * NWAVES + F.wave, NGW = nwg * NWAVES;
    int gtid = gw * 64 + F.lane; const int gthreads = nwg * NTHREADS;
    asm volatile("" : "+v"(gtid));
    unsigned char* ws = A.ws;
    { LAS float* scr = (LAS float*)(F.lds + RING_OFF + F.wave * 16384); constexpr int I_SQ = (D / 64) * (D / 32);
      for (int it = gw; it < 2 * I_SQ; it += NGW) {
          if (it < I_SQ) p0_transpose_item_f8(A.in[I_OD_WOUT], D, D, (unsigned char*)(ws + WS_WOD_OUT), scr, it, F.lane);
          else p0_transpose_item_f8(A.in[I_PLE_WG] + (size_t)D * D, D, D, (unsigned char*)((bf16*)(ws + WS_WGATE) + (size_t)D * D), scr, it - I_SQ, F.lane, A.in[I_NPLE] + D); } }
    __syncthreads();
    for (int it = wg; it < 512; it += nwg)
        p0_fold_item(A.in[I_PEER_WQ] + (size_t)D * D, A.in[I_PEER_SK] + (size_t)16 * 128 * 128, (bf16*)(ws + WS_WPEER) + (size_t)D * D, (LAS float*)(F.lds + RING_OFF), it, F.tid, A.in[I_NFFN] + D);
    cvt_rows_i8(A.in[I_PEER_U] + (size_t)16384 * D, (unsigned char*)(ws + WS_TABU) + (size_t)16384 * D, (float*)(ws + WS_SU) + 16384, 16384, gw, NGW, F.lane, A.in[I_NFFN] + D);
    cvt_rows_i8(A.in[I_PEER_V] + (size_t)16384 * D, (unsigned char*)(ws + WS_TABV) + (size_t)16384 * D, (float*)(ws + WS_SU) + 32768 + 16384, 16384, gw, NGW, F.lane, nullptr);
}

constexpr int TC = 16, NCHUNK = SEQ / TC;

template <int MODE>
__device__ __forceinline__ void scan_gla_unit(const Args& A, Frame& F, int unit) {
    int tid = F.tid; asm volatile("" : "+v"(tid));
    const int lane = tid & 63, w = F.wave;
    int b, h, qcol, kcol, vcol, ocol;
    if (MODE == 0) { b = unit >> 4; h = (unit >> 2) & 3; const int s = unit & 3; qcol = EC_GQ + h * 128; kcol = EC_GK + h * 128; vcol = EC_GV + h * 256 + s * 64; ocol = h * 256 + s * 64; }
    else           { b = unit >> 4; h = (unit >> 1) & 7; const int s = unit & 1; qcol = OC_HQ + h * 128; kcol = OC_HF + h * 128; vcol = OC_HI + h * 128 + s * 64; ocol = h * 128 + s * 64; }
    const bf16* P = (const bf16*)(A.ws + WS_PROJ) + (size_t)b * SEQ * PROJ_LD;
    float* O = (float*)(A.ws + WS_O) + (size_t)b * SEQ * D + ocol;
    LAS float* Lf = (LAS float*)(F.lds + RING_OFF);
    constexpr int BUFSZ = 7168, O_EG = 0, O_K = 2048, O_Q = 4096, O_V = 6144, O_OUT = 2 * BUFSZ, O_W2 = O_OUT + 1024, O_BIAS = O_W2 + 2048;
    const int tl = tid >> 5, dq = (tid & 31) * 4, tlv = tid >> 4, c4 = (tid & 15) * 4;
    float lb[4] = {0.f, 0.f, 0.f, 0.f};
    if (MODE == 0) {
        const float* w2 = A.in[I_GK_W2]; const float* gb = A.in[I_GK_B];
        for (int i = tid; i < 2048; i += NTHREADS) Lf[O_W2 + i] = w2[(i >> 7) * 512 + h * 128 + (i & 127)];
        if (tid < 128) Lf[O_BIAS + tid] = gb[h * 128 + tid];
    } else {
        const float* lg = A.in[I_LB];
#pragma unroll
        for (int i = 0; i < 4; ++i) lb[i] = sigmoidf_(lg[1024 + h * 128 + dq + i] - lg[h * 128 + dq + i]);
    }
    u32x2 rq, rk, rv = {0u, 0u}; v4u rg0 = {0u, 0u, 0u, 0u}, rg1 = {0u, 0u, 0u, 0u};
#define GLA_LOAD(c) do { const bf16* pr = P + (size_t)((c) * TC + tl) * PROJ_LD; rq = *(const GAS u32x2*)(pr + qcol + dq); rk = *(const GAS u32x2*)(pr + kcol + dq); \
        if (MODE == 0) { rg0 = *(const GAS v4u*)(pr + EC_GLR); rg1 = *(const GAS v4u*)(pr + EC_GLR + 8); } \
        if (tid < 256) rv = *(const GAS u32x2*)(P + (size_t)((c) * TC + tlv) * PROJ_LD + vcol + c4); } while (0)
#define GLA_XFORM(bufi) do { LAS float* B_ = Lf + (bufi) * BUFSZ; f32x4 q4, k4, e4; \
        const float xq[4] = {bf_lo(rq.x), bf_hi(rq.x), bf_lo(rq.y), bf_hi(rq.y)}, xk[4] = {bf_lo(rk.x), bf_hi(rk.x), bf_lo(rk.y), bf_hi(rk.y)}; \
        if (MODE == 0) { f32x4 z = *(const LAS f32x4*)(Lf + O_BIAS + dq); \
            const float gl[16] = {bf_lo(rg0.x), bf_hi(rg0.x), bf_lo(rg0.y), bf_hi(rg0.y), bf_lo(rg0.z), bf_hi(rg0.z), bf_lo(rg0.w), bf_hi(rg0.w), \
                                  bf_lo(rg1.x), bf_hi(rg1.x), bf_lo(rg1.y), bf_hi(rg1.y), bf_lo(rg1.z), bf_hi(rg1.z), bf_lo(rg1.w), bf_hi(rg1.w)}; \
            _Pragma("unroll") for (int r_ = 0; r_ < 16; ++r_) { const f32x4 wv = *(const LAS f32x4*)(Lf + O_W2 + r_ * 128 + dq); z = z + wv * gl[r_]; } \
            _Pragma("unroll") for (int i_ = 0; i_ < 4; ++i_) { q4[i_] = xq[i_] * 0.08838834764831845f; k4[i_] = xk[i_]; e4[i_] = __builtin_amdgcn_exp2f(-0.0625f * __builtin_amdgcn_logf(1.0f + __expf(-z[i_]))); } } \
        else { _Pragma("unroll") for (int i_ = 0; i_ < 4; ++i_) { const float fg = lb[i_] + (1.f - lb[i_]) * sigmoidf_(xk[i_]); q4[i_] = siluf_(xq[i_]); k4[i_] = 1.f - fg; e4[i_] = fg; } } \
        *(LAS f32x4*)(B_ + O_EG + tl * 128 + dq) = e4; *(LAS f32x4*)(B_ + O_K + tl * 128 + dq) = k4; *(LAS f32x4*)(B_ + O_Q + tl * 128 + dq) = q4; \
        if (tid < 256) { f32x4 v4 = {bf_lo(rv.x), bf_hi(rv.x), bf_lo(rv.y), bf_hi(rv.y)}; *(LAS f32x4*)(B_ + O_V + tlv * 64 + c4) = v4; } } while (0)
    LBAR();
    GLA_LOAD(0); GLA_XFORM(0);
    LBAR();
    f32x2 S2[8];
#pragma unroll
    for (int i = 0; i < 8; ++i) S2[i] = (f32x2){0.f, 0.f};
    const int j = lane & 15, col = w * 8 + (lane >> 4) * 2;
    for (int c = 0; c < NCHUNK; ++c) {
        if (c + 1 < NCHUNK) GLA_LOAD(c + 1);
        const LAS float* B_ = Lf + (c & 1) * BUFSZ;
        float os0 = 0.f, os1 = 0.f;
        f32x4 e0, e1, k0, k1, q0, q1, ne0, ne1, nk0, nk1, nq0, nq1; f32x2 v2, nv2;
#define GLA_LDSTEP(t_, E0, E1, K0, K1, Q0, Q1, V2) do { E0 = *(const LAS f32x4*)(B_ + O_EG + (t_) * 128 + 4 * j); E1 = *(const LAS f32x4*)(B_ + O_EG + (t_) * 128 + 64 + 4 * j); \
            K0 = *(const LAS f32x4*)(B_ + O_K + (t_) * 128 + 4 * j); K1 = *(const LAS f32x4*)(B_ + O_K + (t_) * 128 + 64 + 4 * j); \
            Q0 = *(const LAS f32x4*)(B_ + O_Q + (t_) * 128 + 4 * j); Q1 = *(const LAS f32x4*)(B_ + O_Q + (t_) * 128 + 64 + 4 * j); V2 = *(const LAS f32x2*)(B_ + O_V + (t_) * 64 + col); } while (0)
        GLA_LDSTEP(0, e0, e1, k0, k1, q0, q1, v2);
#pragma unroll
        for (int t = 0; t < TC; ++t) {
            if (t + 1 < TC) { GLA_LDSTEP(t + 1, ne0, ne1, nk0, nk1, nq0, nq1, nv2); }
            __builtin_amdgcn_sched_barrier(0);
            f32x2 pa = {0.f, 0.f}, pb = {0.f, 0.f};
#pragma unroll
            for (int i = 0; i < 4; ++i) {
                S2[i] = S2[i] * e0[i] + v2 * k0[i]; S2[4 + i] = S2[4 + i] * e1[i] + v2 * k1[i];
                pa += S2[i] * q0[i]; pb += S2[4 + i] * q1[i]; }
            pa += pb;
            float p0 = pa[0], p1 = pa[1];
            row_sum16_x2(p0, p1);
            os0 = (j == t) ? p0 : os0; os1 = (j == t) ? p1 : os1;
            e0 = ne0; e1 = ne1; k0 = nk0; k1 = nk1; q0 = nq0; q1 = nq1; v2 = nv2;
        }
#undef GLA_LDSTEP
        { f32x2 o2 = {os0, os1}; *(LAS f32x2*)(Lf + O_OUT + j * 64 + col) = o2; }
        if (c + 1 < NCHUNK) GLA_XFORM((c + 1) & 1);
        LBAR();
        if (tid < 256) *(GAS f32x4*)(O + (size_t)(c * TC + tlv) * D + c4) = *(const LAS f32x4*)(Lf + O_OUT + tlv * 64 + c4);
        LBAR();
    }
#undef GLA_LOAD
#undef GLA_XFORM
}

__device__ __forceinline__ void scan_gdn_unit(const Args& A, Frame& F, int unit) {
    int tid = F.tid; asm volatile("" : "+v"(tid));
    const int lane = tid & 63, w = F.wave;
    const int b = unit >> 4, h = (unit >> 1) & 7, s = unit & 1;
    const int qcol = EC_BQ + h * 128, kcol = EC_BK + h * 128, vcol = EC_BV + h * 128 + s * 64, ocol = 1024 + h * 128 + s * 64;
    const bf16* P = (const bf16*)(A.ws + WS_PROJ) + (size_t)b * SEQ * PROJ_LD;
    float* O = (float*)(A.ws + WS_O) + (size_t)b * SEQ * D + ocol;
    LAS float* Lf = (LAS float*)(F.lds + RING_OFF);
    constexpr int BUFSZ = 5184, O_K = 0, O_Q = 2048, O_V = 4096, O_SC = 5120, O_OUT = 2 * BUFSZ, O_CW = O_OUT + 1024;
    const int tl = tid >> 5, dq = (tid & 31) * 4, tlv = tid >> 4, c4 = (tid & 15) * 4;
    { const float* cw = A.in[I_GDN_CONV];
      for (int i = tid; i < 4 * 320; i += NTHREADS) { const int jt = i / 320, x = i % 320;
          const int ch = x < 128 ? (h * 128 + x) : x < 256 ? (1024 + h * 128 + (x - 128)) : (2048 + h * 128 + s * 64 + (x - 256));
          Lf[O_CW + i] = cw[jt * 3072 + ch]; } }
    const float neg_ea = -__expf(A.in[I_GDN_ALOG][h]), dtb = A.in[I_GDN_DTB][h];
    u32x2 rq[4], rk[4], rv[4]; unsigned short rba = 0, rbb = 0;
#pragma unroll
    for (int i = 0; i < 4; ++i) rv[i] = (u32x2){0u, 0u};
#define GDN_LOAD(c) do { const int t_ = (c) * TC + tl; \
        _Pragma("unroll") for (int jt = 0; jt < 4; ++jt) { const int tt = t_ - 3 + jt; \
            if (tt >= 0) { const bf16* pr = P + (size_t)tt * PROJ_LD; rq[jt] = *(const GAS u32x2*)(pr + qcol + dq); rk[jt] = *(const GAS u32x2*)(pr + kcol + dq); } \
            else { rq[jt] = (u32x2){0u, 0u}; rk[jt] = (u32x2){0u, 0u}; } } \
        { const bf16* pr = P + (size_t)t_ * PROJ_LD; rba = pr[EC_BA + h]; rbb = pr[EC_BB + h]; } \
        if (tid < 256) { const int tv = (c) * TC + tlv; \
            _Pragma("unroll") for (int jt = 0; jt < 4; ++jt) { const int tt = tv - 3 + jt; \
                if (tt >= 0) rv[jt] = *(const GAS u32x2*)(P + (size_t)tt * PROJ_LD + vcol + c4); else rv[jt] = (u32x2){0u, 0u}; } } } while (0)
#define GDN_XFORM(bufi) do { LAS float* B_ = Lf + (bufi) * BUFSZ; f32x4 q4 = {0.f, 0.f, 0.f, 0.f}, k4 = {0.f, 0.f, 0.f, 0.f}; \
        _Pragma("unroll") for (int jt = 0; jt < 4; ++jt) { const f32x4 wq = *(const LAS f32x4*)(Lf + O_CW + jt * 320 + dq), wk = *(const LAS f32x4*)(Lf + O_CW + jt * 320 + 128 + dq); \
            q4[0] += wq[0] * bf_lo(rq[jt].x); q4[1] += wq[1] * bf_hi(rq[jt].x); q4[2] += wq[2] * bf_lo(rq[jt].y); q4[3] += wq[3] * bf_hi(rq[jt].y); \
            k4[0] += wk[0] * bf_lo(rk[jt].x); k4[1] += wk[1] * bf_hi(rk[jt].x); k4[2] += wk[2] * bf_lo(rk[jt].y); k4[3] += wk[3] * bf_hi(rk[jt].y); } \
        float sq = 0.f, sk = 0.f, sqk = 0.f; \
        _Pragma("unroll") for (int i_ = 0; i_ < 4; ++i_) { q4[i_] = siluf_(q4[i_]); k4[i_] = siluf_(k4[i_]); sq += q4[i_] * q4[i_]; sk += k4[i_] * k4[i_]; sqk += q4[i_] * k4[i_]; } \
        sq = half_sum32(sq); sk = half_sum32(sk); sqk = half_sum32(sqk); \
        const float rq_ = __builtin_amdgcn_rsqf(sq + EPS) * 0.08838834764831845f, rk_ = __builtin_amdgcn_rsqf(sk + EPS); \
        q4 = q4 * rq_; k4 = k4 * rk_; \
        *(LAS f32x4*)(B_ + O_K + tl * 128 + dq) = k4; *(LAS f32x4*)(B_ + O_Q + tl * 128 + dq) = q4; \
        if ((tid & 31) == 0) { const float ba = __uint_as_float((unsigned)rba << 16), bb = __uint_as_float((unsigned)rbb << 16); \
            f32x4 sc; sc[0] = __expf(neg_ea * softplusf_(ba + dtb)); sc[1] = sigmoidf_(bb); sc[2] = sqk * rq_ * rk_; sc[3] = 0.f; *(LAS f32x4*)(B_ + O_SC + tl * 4) = sc; } \
        if (tid < 256) { f32x4 v4 = {0.f, 0.f, 0.f, 0.f}; \
            _Pragma("unroll") for (int jt = 0; jt < 4; ++jt) { const f32x4 wv = *(const LAS f32x4*)(Lf + O_CW + jt * 320 + 256 + c4); \
                v4[0] += wv[0] * bf_lo(rv[jt].x); v4[1] += wv[1] * bf_hi(rv[jt].x); v4[2] += wv[2] * bf_lo(rv[jt].y); v4[3] += wv[3] * bf_hi(rv[jt].y); } \
            _Pragma("unroll") for (int i_ = 0; i_ < 4; ++i_) v4[i_] = siluf_(v4[i_]); \
            *(LAS f32x4*)(B_ + O_V + tlv * 64 + c4) = v4; } } while (0)
    LBAR();
    GDN_LOAD(0); GDN_XFORM(0);
    LBAR();
    f32x2 S2[8];
#pragma unroll
    for (int i = 0; i < 8; ++i) S2[i] = (f32x2){0.f, 0.f};
    const int j = lane & 15, col = w * 8 + (lane >> 4) * 2;
    for (int c = 0; c < NCHUNK; ++c) {
        if (c + 1 < NCHUNK) GDN_LOAD(c + 1);
        const LAS float* B_ = Lf + (c & 1) * BUFSZ;
        float os0 = 0.f, os1 = 0.f;
        f32x4 k0, k1, q0, q1, sc, nk0, nk1, nq0, nq1, nsc; f32x2 v2, nv2;
#define GDN_LDSTEP(t_, K0, K1, Q0, Q1, V2, SC) do { K0 = *(const LAS f32x4*)(B_ + O_K + (t_) * 128 + 4 * j); K1 = *(const LAS f32x4*)(B_ + O_K + (t_) * 128 + 64 + 4 * j); \
            Q0 = *(const LAS f32x4*)(B_ + O_Q + (t_) * 128 + 4 * j); Q1 = *(const LAS f32x4*)(B_ + O_Q + (t_) * 128 + 64 + 4 * j); V2 = *(const LAS f32x2*)(B_ + O_V + (t_) * 64 + col); SC = *(const LAS f32x4*)(B_ + O_SC + (t_) * 4); } while (0)
        GDN_LDSTEP(0, k0, k1, q0, q1, v2, sc);
#pragma unroll
        for (int t = 0; t < TC; ++t) {
            if (t + 1 < TC) { GDN_LDSTEP(t + 1, nk0, nk1, nq0, nq1, nv2, nsc); }
            __builtin_amdgcn_sched_barrier(0);
            f32x2 d1 = {0.f, 0.f}, d2 = {0.f, 0.f}, e1 = {0.f, 0.f}, e2 = {0.f, 0.f};
#pragma unroll
            for (int i = 0; i < 4; ++i) { d1 += S2[i] * k0[i]; e1 += S2[4 + i] * k1[i]; d2 += S2[i] * q0[i]; e2 += S2[4 + i] * q1[i]; }
            d1 += e1; d2 += e2;
            { float r0_ = d1[0], r1_ = d1[1], r2_ = d2[0], r3_ = d2[1]; row_sum16_x4(r0_, r1_, r2_, r3_); d1[0] = r0_; d1[1] = r1_; d2[0] = r2_; d2[1] = r3_; }
            const float a = sc[0], beta = sc[1], qk = sc[2];
            const f32x2 dl = (v2 - d1 * a) * beta;
            const f32x2 o2 = d2 * a + dl * qk;
#pragma unroll
            for (int i = 0; i < 4; ++i) { S2[i] = S2[i] * a + dl * k0[i]; S2[4 + i] = S2[4 + i] * a + dl * k1[i]; }
            os0 = (j == t) ? o2[0] : os0; os1 = (j == t) ? o2[1] : os1;
            k0 = nk0; k1 = nk1; q0 = nq0; q1 = nq1; v2 = nv2; sc = nsc;
        }
#undef GDN_LDSTEP
        { f32x2 o2 = {os0, os1}; *(LAS f32x2*)(Lf + O_OUT + j * 64 + col) = o2; }
        if (c + 1 < NCHUNK) GDN_XFORM((c + 1) & 1);
        LBAR();
        if (tid < 256) *(GAS f32x4*)(O + (size_t)(c * TC + tlv) * D + c4) = *(const LAS f32x4*)(Lf + O_OUT + tlv * 64 + c4);
        LBAR();
    }
#undef GDN_LOAD
#undef GDN_XFORM
}

typedef short bf16x4_t __attribute__((ext_vector_type(4)));
__device__ __forceinline__ bf16x8 mk_frag(u32x2 lo, u32x2 hi) { v4u t; t.x = lo.x; t.y = lo.y; t.z = hi.x; t.w = hi.y; return __builtin_bit_cast(bf16x8, t); }
template <int MODE>
__device__ __forceinline__ void scan_gla_mfma_unit(const Args& A, Frame& F, int unit) {
    int tid = F.tid; asm volatile("" : "+v"(tid));
    const int lane = tid & 63, w = F.wave;
    int b, h, qcol, kcol, vcol, ocol;
    if (MODE == 0) { b = unit >> 3; h = (unit >> 1) & 3; const int s = unit & 1; qcol = EC_GQ + h * 128; kcol = EC_GK + h * 128; vcol = EC_GV + h * 256 + s * 128; ocol = h * 256 + s * 128; }
    else           { b = unit >> 3; h = unit & 7; qcol = OC_HQ + h * 128; kcol = OC_HF + h * 128; vcol = OC_HI + h * 128; ocol = h * 128; }
    const bf16* P = (const bf16*)(A.ws + WS_PROJ) + (size_t)b * SEQ * PROJ_LD;
    bf16* O = (bf16*)(A.ws + WS_O) + (size_t)b * SEQ * D + ocol;
    LAS float* Lf = (LAS float*)(F.lds + RING_OFF);
    constexpr int BUFSZ = 8192, O_E = 0, O_K = 2048, O_Q = 4096, O_V = 6144, RS = 136, O_QB = 2 * BUFSZ, O_KB = O_QB + 1088, O_KT = O_KB + 1088, O_BL = O_KT + 1024, O_AM = O_BL + 128, O_W2 = O_AM + 128, O_BIAS = O_W2 + 2048;
    LAS bf16* QB = (LAS bf16*)(Lf + O_QB); LAS bf16* KB = (LAS bf16*)(Lf + O_KB); LAS bf16* KT = (LAS bf16*)(Lf + O_KT); LAS bf16* AM = (LAS bf16*)(Lf + O_AM);
    const int tl = tid >> 5, dq = (tid & 31) * 4;
    float lb[4] = {0.f, 0.f, 0.f, 0.f};
    if (MODE == 0) {
        const float* w2 = A.in[I_GK_W2]; const float* gb = A.in[I_GK_B];
        for (int i = tid; i < 2048; i += NTHREADS) Lf[O_W2 + i] = w2[(i >> 7) * 512 + h * 128 + (i & 127)];
        if (tid < 128) Lf[O_BIAS + tid] = gb[h * 128 + tid];
    } else {
        const float* lg = A.in[I_LB];
#pragma unroll
        for (int i = 0; i < 4; ++i) lb[i] = sigmoidf_(lg[1024 + h * 128 + dq + i] - lg[h * 128 + dq + i]);
    }
    u32x2 rq, rk, rv; v4u rg0 = {0u, 0u, 0u, 0u}, rg1 = {0u, 0u, 0u, 0u};
#define GM_LOAD(c) do { const bf16* pr = P + (size_t)((c) * TC + tl) * PROJ_LD; rq = *(const GAS u32x2*)(pr + qcol + dq); rk = *(const GAS u32x2*)(pr + kcol + dq); rv = *(const GAS u32x2*)(pr + vcol + dq); \
        if (MODE == 0) { rg0 = *(const GAS v4u*)(pr + EC_GLR); rg1 = *(const GAS v4u*)(pr + EC_GLR + 8); } } while (0)
#define GM_XFORM(bufi) do { LAS float* B_ = Lf + (bufi) * BUFSZ; f32x4 q4, k4, e4; \
        const float xq[4] = {bf_lo(rq.x), bf_hi(rq.x), bf_lo(rq.y), bf_hi(rq.y)}, xk[4] = {bf_lo(rk.x), bf_hi(rk.x), bf_lo(rk.y), bf_hi(rk.y)}; \
        if (MODE == 0) { f32x4 z = *(const LAS f32x4*)(Lf + O_BIAS + dq); \
            const float gl[16] = {bf_lo(rg0.x), bf_hi(rg0.x), bf_lo(rg0.y), bf_hi(rg0.y), bf_lo(rg0.z), bf_hi(rg0.z), bf_lo(rg0.w), bf_hi(rg0.w), \
                                  bf_lo(rg1.x), bf_hi(rg1.x), bf_lo(rg1.y), bf_hi(rg1.y), bf_lo(rg1.z), bf_hi(rg1.z), bf_lo(rg1.w), bf_hi(rg1.w)}; \
            _Pragma("unroll") for (int r_ = 0; r_ < 16; ++r_) { const f32x4 wv = *(const LAS f32x4*)(Lf + O_W2 + r_ * 128 + dq); z = z + wv * gl[r_]; } \
            _Pragma("unroll") for (int i_ = 0; i_ < 4; ++i_) { q4[i_] = xq[i_] * 0.08838834764831845f; k4[i_] = xk[i_]; e4[i_] = __builtin_amdgcn_exp2f(-0.0625f * __builtin_amdgcn_logf(1.0f + __expf(-z[i_]))); } } \
        else { _Pragma("unroll") for (int i_ = 0; i_ < 4; ++i_) { const float fg = lb[i_] + (1.f - lb[i_]) * sigmoidf_(xk[i_]); q4[i_] = siluf_(xq[i_]); k4[i_] = 1.f - fg; e4[i_] = fg; } } \
        *(LAS f32x4*)(B_ + O_E + tl * 128 + dq) = e4; *(LAS f32x4*)(B_ + O_K + tl * 128 + dq) = k4; *(LAS f32x4*)(B_ + O_Q + tl * 128 + dq) = q4; \
        { f32x4 v4 = {bf_lo(rv.x), bf_hi(rv.x), bf_lo(rv.y), bf_hi(rv.y)}; *(LAS f32x4*)(B_ + O_V + tl * 128 + dq) = v4; } } while (0)
    LBAR();
    GM_LOAD(0); GM_XFORM(0); GM_LOAD(1);
    LBAR();
    f32x4 Sacc[8];
#pragma unroll
    for (int i = 0; i < 8; ++i) Sacc[i] = (f32x4){0.f, 0.f, 0.f, 0.f};
    const int fr = lane & 15, g = lane >> 4, c0 = w * 16;
    for (int c = 0; c < NCHUNK; ++c) {
        const LAS float* B_ = Lf + (c & 1) * BUFSZ;
        {
            const int seg = tid >> 7, d = tid & 127;
            float bt = 1.f, ball = 1.f;
#pragma unroll
            for (int t = 0; t < 16; ++t) { const float e = B_[O_E + t * 128 + d]; ball *= e; if (t < 4 * seg) bt = ball; }
            ball = fmaxf(ball, 1e-30f);
            unsigned short kt4[4];
#pragma unroll
            for (int i = 0; i < 4; ++i) { const int t = 4 * seg + i; bt = fmaxf(bt * B_[O_E + t * 128 + d], 1e-30f);
                const float kk = B_[O_K + t * 128 + d], qq = B_[O_Q + t * 128 + d], ib = __builtin_amdgcn_rcpf(bt);
                QB[t * RS + d] = hw_bf(qq * bt); KB[t * RS + d] = hw_bf(kk * ib); kt4[i] = (unsigned short)hw_bf(kk * ball * ib); }
            u32x2 kw; kw.x = (unsigned)kt4[0] | ((unsigned)kt4[1] << 16); kw.y = (unsigned)kt4[2] | ((unsigned)kt4[3] << 16);
            *(LAS u32x2*)(KT + d * 16 + 4 * seg) = kw;
            if (seg == 3) Lf[O_BL + d] = ball;
        }
        LBAR();
        if (w == 0) {
            f32x4 acc = {0.f, 0.f, 0.f, 0.f};
#pragma unroll
            for (int ks = 0; ks < 4; ++ks) { const bf16x8 af = *(const LAS bf16x8*)(QB + fr * RS + 32 * ks + 8 * g), bfm = *(const LAS bf16x8*)(KB + fr * RS + 32 * ks + 8 * g);
                acc = __builtin_amdgcn_mfma_f32_16x16x32_bf16(af, bfm, acc, 0, 0, 0); }
#pragma unroll
            for (int r = 0; r < 4; ++r) { const int t = 4 * g + r, s = fr; AM[t * 16 + s] = hw_bf(s <= t ? acc[r] : 0.f); }
        }
        if (c + 1 < NCHUNK) GM_XFORM((c + 1) & 1);
        if (c + 2 < NCHUNK) GM_LOAD(c + 2);
        LBAR();
        {
            u32x2 vlo; { const float v0 = B_[O_V + (4 * g + 0) * 128 + c0 + fr], v1 = B_[O_V + (4 * g + 1) * 128 + c0 + fr], v2 = B_[O_V + (4 * g + 2) * 128 + c0 + fr], v3 = B_[O_V + (4 * g + 3) * 128 + c0 + fr];
                vlo.x = hw_pk2(v0, v1); vlo.y = hw_pk2(v2, v3); }
            const u32x2 zz = {0u, 0u};
            const bf16x8 vb = mk_frag(vlo, zz);
            f32x4 acco = {0.f, 0.f, 0.f, 0.f};
#pragma unroll
            for (int ks = 0; ks < 4; ++ks) {
                u32x2 slo, shi; slo.x = hw_pk2(Sacc[2 * ks][0], Sacc[2 * ks][1]); slo.y = hw_pk2(Sacc[2 * ks][2], Sacc[2 * ks][3]); shi.x = hw_pk2(Sacc[2 * ks + 1][0], Sacc[2 * ks + 1][1]); shi.y = hw_pk2(Sacc[2 * ks + 1][2], Sacc[2 * ks + 1][3]);
                const bf16x8 sb = mk_frag(slo, shi);
                const u32x2 qlo = *(const LAS u32x2*)(QB + fr * RS + 32 * ks + 4 * g), qhi = *(const LAS u32x2*)(QB + fr * RS + 32 * ks + 16 + 4 * g);
                acco = __builtin_amdgcn_mfma_f32_16x16x32_bf16(mk_frag(qlo, qhi), sb, acco, 0, 0, 0); }
            { const u32x2 alo = *(const LAS u32x2*)(AM + fr * 16 + 4 * g); acco = __builtin_amdgcn_mfma_f32_16x16x32_bf16(mk_frag(alo, zz), vb, acco, 0, 0, 0); }
#pragma unroll
            for (int r = 0; r < 4; ++r) O[(size_t)(c * TC + 4 * g + r) * D + c0 + fr] = hw_bf(acco[r]);
#pragma unroll
            for (int i = 0; i < 8; ++i) { const f32x4 bl = *(const LAS f32x4*)(Lf + O_BL + 16 * i + 4 * g); const u32x2 klo = *(const LAS u32x2*)(KT + (16 * i + fr) * 16 + 4 * g);
                Sacc[i] = __builtin_amdgcn_mfma_f32_16x16x32_bf16(mk_frag(klo, zz), vb, Sacc[i] * bl, 0, 0, 0); }
        }
        LBAR();
    }
#undef GM_LOAD
#undef GM_XFORM
}

__device__ __forceinline__ void scan_gdn_mfma_unit(const Args& A, Frame& F, int unit, const int role) {
    int tid = F.tid; asm volatile("" : "+v"(tid));
    const int lane = tid & 63, w = F.wave;
    const int b = unit >> 3, h = unit & 7;
    const int qcol = EC_BQ + h * 128, kcol = EC_BK + h * 128, vcol = EC_BV + h * 128, ocol = 1024 + h * 128;
    const bf16* P = (const bf16*)(A.ws + WS_PROJ) + (size_t)b * SEQ * PROJ_LD;
    bf16* O = (bf16*)(A.ws + WS_O) + (size_t)b * SEQ * D + ocol;
    LAS float* Lf = (LAS float*)(F.lds + RING_OFF);
    constexpr int O_CW = 0, O_AMAT = 1536, O_QKM = O_AMAT + 256, O_TB = O_QKM + 128, O_GL = O_TB + 128, O_BUF0 = O_GL + 64;
    constexpr int BUFSZ = 6208, O_KH = 0, O_QH = 2048, O_VV = 4096, O_SC = 6144;
    constexpr int RS = 136;
    constexpr int O_KHB = O_BUF0 + 2 * BUFSZ, O_QHB = O_KHB + 1088, O_QB = O_QHB + 1088, O_KT = O_QB + 1088, O_WSRC = O_KT + 1024, O_WB = O_WSRC + 2048;
    LAS bf16* KHB = (LAS bf16*)(Lf + O_KHB); LAS bf16* QHB = (LAS bf16*)(Lf + O_QHB); LAS bf16* QB = (LAS bf16*)(Lf + O_QB); LAS bf16* KT = (LAS bf16*)(Lf + O_KT);
    LAS bf16* WB = (LAS bf16*)(Lf + O_WB); LAS bf16* QKM = (LAS bf16*)(Lf + O_QKM); LAS bf16* TB = (LAS bf16*)(Lf + O_TB);
    const int tl = tid >> 5, dq = (tid & 31) * 4;
    { const float* cw = A.in[I_GDN_CONV];
      for (int i = tid; i < 4 * 384; i += NTHREADS) { const int jt = i / 384, x = i % 384; Lf[O_CW + i] = cw[jt * 3072 + (x >> 7) * 1024 + h * 128 + (x & 127)]; } }
    const float neg_ea = -__expf(A.in[I_GDN_ALOG][h]), dtb = A.in[I_GDN_DTB][h];
    u32x2 rq[4], rk[4], rv[4]; unsigned short rba = 0, rbb = 0;
#define GD_LOAD(c) do { const int t_ = (c) * TC + tl; \
        _Pragma("unroll") for (int jt = 0; jt < 4; ++jt) { const int tt = t_ - 3 + jt; const bf16* pr = P + (size_t)(tt < 0 ? 0 : tt) * PROJ_LD + dq; \
            rq[jt] = *(const GAS u32x2*)(pr + qcol); rk[jt] = *(const GAS u32x2*)(pr + kcol); rv[jt] = *(const GAS u32x2*)(pr + vcol); \
            if (tt < 0) { rq[jt] = (u32x2){0u, 0u}; rk[jt] = (u32x2){0u, 0u}; rv[jt] = (u32x2){0u, 0u}; } } \
        { const bf16* pr = P + (size_t)t_ * PROJ_LD; rba = pr[EC_BA + h]; rbb = pr[EC_BB + h]; } } while (0)
#define GD_XFORM(bufi) do { LAS float* B_ = Lf + O_BUF0 + (bufi) * BUFSZ; f32x4 q4 = {0.f, 0.f, 0.f, 0.f}, k4 = {0.f, 0.f, 0.f, 0.f}, v4 = {0.f, 0.f, 0.f, 0.f}; \
        _Pragma("unroll") for (int jt = 0; jt < 4; ++jt) { const f32x4 wq = *(const LAS f32x4*)(Lf + O_CW + jt * 384 + dq), wk = *(const LAS f32x4*)(Lf + O_CW + jt * 384 + 128 + dq), wv = *(const LAS f32x4*)(Lf + O_CW + jt * 384 + 256 + dq); \
            q4[0] += wq[0] * bf_lo(rq[jt].x); q4[1] += wq[1] * bf_hi(rq[jt].x); q4[2] += wq[2] * bf_lo(rq[jt].y); q4[3] += wq[3] * bf_hi(rq[jt].y); \
            k4[0] += wk[0] * bf_lo(rk[jt].x); k4[1] += wk[1] * bf_hi(rk[jt].x); k4[2] += wk[2] * bf_lo(rk[jt].y); k4[3] += wk[3] * bf_hi(rk[jt].y); \
            v4[0] += wv[0] * bf_lo(rv[jt].x); v4[1] += wv[1] * bf_hi(rv[jt].x); v4[2] += wv[2] * bf_lo(rv[jt].y); v4[3] += wv[3] * bf_hi(rv[jt].y); } \
        float sq = 0.f, sk = 0.f; \
        _Pragma("unroll") for (int i_ = 0; i_ < 4; ++i_) { q4[i_] = siluf_(q4[i_]); k4[i_] = siluf_(k4[i_]); v4[i_] = siluf_(v4[i_]); sq += q4[i_] * q4[i_]; sk += k4[i_] * k4[i_]; } \
        row_sum16_x2(sq, sk); sq += __shfl_xor(sq, 16); sk += __shfl_xor(sk, 16); \
        q4 = q4 * (__builtin_amdgcn_rsqf(sq + EPS) * 0.08838834764831845f); k4 = k4 * __builtin_amdgcn_rsqf(sk + EPS); \
        *(LAS f32x4*)(B_ + O_KH + tl * 128 + dq) = k4; *(LAS f32x4*)(B_ + O_QH + tl * 128 + dq) = q4; *(LAS f32x4*)(B_ + O_VV + tl * 128 + dq) = v4; \
        if ((tid & 31) == 0) { const float ba = __uint_as_float((unsigned)rba << 16), bb = __uint_as_float((unsigned)rbb << 16); \
            B_[O_SC + tl] = __expf(neg_ea * softplusf_(ba + dtb)); B_[O_SC + 16 + tl] = sigmoidf_(bb); } } while (0)
    LBAR();
    constexpr int SPLIT = 58;
    const int c_begin = role ? SPLIT : 0, c_end = role ? NCHUNK : SPLIT;
    constexpr int REC = 5408;
    float* STASH = (float*)(A.ws + WS_LA) + (size_t)unit * (NCHUNK - SPLIT) * REC;
    float* STATE = (float*)(A.ws + WS_STATE) + (size_t)unit * 16384;
    gu32* flag = F.ctl + 32768 + unit * 64;
    GD_LOAD(c_begin); GD_XFORM(c_begin & 1); GD_LOAD(c_begin + 1);
    LBAR();
    f32x4 Sacc[8];
#pragma unroll
    for (int i = 0; i < 8; ++i) Sacc[i] = (f32x4){0.f, 0.f, 0.f, 0.f};
    const int fr = lane & 15, g = lane >> 4, c0 = w * 16;
    const u32x2 zz = {0u, 0u};
#define GD_STATE_PART(cc_) do { \
        { \
            bf16x8 sb[4]; \
_Pragma("unroll") \
            for (int ks = 0; ks < 4; ++ks) { u32x2 slo, shi; slo.x = hw_pk2(Sacc[2 * ks][0], Sacc[2 * ks][1]); slo.y = hw_pk2(Sacc[2 * ks][2], Sacc[2 * ks][3]); shi.x = hw_pk2(Sacc[2 * ks + 1][0], Sacc[2 * ks + 1][1]); shi.y = hw_pk2(Sacc[2 * ks + 1][2], Sacc[2 * ks + 1][3]); \
                sb[ks] = mk_frag(slo, shi); } \
            f32x4 accv = accu, acco = {0.f, 0.f, 0.f, 0.f}; \
_Pragma("unroll") \
            for (int ks = 0; ks < 4; ++ks) { \
                const u32x2 wl = *(const LAS u32x2*)(WB + fr * RS + 32 * ks + 4 * g), wh = *(const LAS u32x2*)(WB + fr * RS + 32 * ks + 16 + 4 * g); \
                accv = __builtin_amdgcn_mfma_f32_16x16x32_bf16(mk_frag(wl, wh), sb[ks], accv, 0, 0, 0); \
                const u32x2 ql = *(const LAS u32x2*)(QB + fr * RS + 32 * ks + 4 * g), qh = *(const LAS u32x2*)(QB + fr * RS + 32 * ks + 16 + 4 * g); \
                acco = __builtin_amdgcn_mfma_f32_16x16x32_bf16(mk_frag(ql, qh), sb[ks], acco, 0, 0, 0); } \
            u32x2 vn; vn.x = hw_pk2(accv[0], accv[1]); vn.y = hw_pk2(accv[2], accv[3]); \
            const bf16x8 vnb = mk_frag(vn, zz); \
            acco = __builtin_amdgcn_mfma_f32_16x16x32_bf16(mk_frag(*(const LAS u32x2*)(QKM + fr * 16 + 4 * g), zz), vnb, acco, 0, 0, 0); \
_Pragma("unroll") \
            for (int r = 0; r < 4; ++r) O[(size_t)((cc_) * TC + 4 * g + r) * D + c0 + fr] = hw_bf(acco[r]); \
_Pragma("unroll") \
            for (int i = 0; i < 8; ++i) { const u32x2 klo = *(const LAS u32x2*)(KT + (16 * i + fr) * 16 + 4 * g); \
                Sacc[i] = __builtin_amdgcn_mfma_f32_16x16x32_bf16(mk_frag(klo, zz), vnb, Sacc[i] * glast, 0, 0, 0); } \
        } \
        } while (0)
    for (int c = c_begin; c < c_end; ++c) {
        const LAS float* B_ = Lf + O_BUF0 + (c & 1) * BUFSZ;
        float glast;
        {
            const int seg = tid >> 7, d = tid & 127;
            const f32x4 a0 = *(const LAS f32x4*)(B_ + O_SC), a1 = *(const LAS f32x4*)(B_ + O_SC + 4), a2 = *(const LAS f32x4*)(B_ + O_SC + 8), a3 = *(const LAS f32x4*)(B_ + O_SC + 12);
            const float av[16] = {a0[0], a0[1], a0[2], a0[3], a1[0], a1[1], a1[2], a1[3], a2[0], a2[1], a2[2], a2[3], a3[0], a3[1], a3[2], a3[3]};
            float p = 1.f, gpre = 1.f;
#pragma unroll
            for (int t = 0; t < 16; ++t) { if (t == 4 * seg) gpre = p; p *= av[t]; }
            glast = p;
            unsigned short kt4[4]; float gt = gpre;
#pragma unroll
            for (int i = 0; i < 4; ++i) { const int t = 4 * seg + i; const float at = (seg == 0) ? av[i] : (seg == 1) ? av[4 + i] : (seg == 2) ? av[8 + i] : av[12 + i]; gt *= at; const float beta = B_[O_SC + 16 + t];
                const float kk = B_[O_KH + t * 128 + d], qq = B_[O_QH + t * 128 + d];
                KHB[t * RS + d] = hw_bf(kk); QHB[t * RS + d] = hw_bf(qq); QB[t * RS + d] = hw_bf(qq * gt);
                kt4[i] = (unsigned short)hw_bf(kk * glast * __builtin_amdgcn_rcpf(gt));
                Lf[O_WSRC + t * 128 + d] = kk * (beta * gt);
                if (d == 0) Lf[O_GL + t] = gt; }
            u32x2 kw; kw.x = (unsigned)kt4[0] | ((unsigned)kt4[1] << 16); kw.y = (unsigned)kt4[2] | ((unsigned)kt4[3] << 16);
            *(LAS u32x2*)(KT + d * 16 + 4 * seg) = kw;
        }
        LBAR();
        if (w < 2) {
            const LAS bf16* AS = (w == 0) ? KHB : QHB;
            f32x4 acc = {0.f, 0.f, 0.f, 0.f};
#pragma unroll
            for (int ks = 0; ks < 4; ++ks) { const bf16x8 af = *(const LAS bf16x8*)(AS + fr * RS + 32 * ks + 8 * g), bfm = *(const LAS bf16x8*)(KHB + fr * RS + 32 * ks + 8 * g);
                acc = __builtin_amdgcn_mfma_f32_16x16x32_bf16(af, bfm, acc, 0, 0, 0); }
            const float gs_inv = __builtin_amdgcn_rcpf(Lf[O_GL + fr]);
            if (w == 0) {
                f32x4 N1, M1;
#pragma unroll
                for (int r = 0; r < 4; ++r) { const int t = 4 * g + r; const float gt = Lf[O_GL + t];
                    N1[r] = (fr < t) ? -(B_[O_SC + 16 + t] * acc[r] * gt * gs_inv) : 0.f;
                    M1[r] = (t < fr) ? -(B_[O_SC + 16 + fr] * acc[r] * Lf[O_GL + fr] * __builtin_amdgcn_rcpf(gt)) : 0.f; }
#define XTY(X, Y, C0) __builtin_amdgcn_mfma_f32_16x16x32_bf16(mk_frag((u32x2){hw_pk2(X[0], X[1]), hw_pk2(X[2], X[3])}, zz), mk_frag((u32x2){hw_pk2(Y[0], Y[1]), hw_pk2(Y[2], Y[3])}, zz), C0, 0, 0, 0)
                const f32x4 z4 = {0.f, 0.f, 0.f, 0.f};
                f32x4 T1t = M1;
#pragma unroll
                for (int r = 0; r < 4; ++r) if (4 * g + r == fr) T1t[r] += 1.f;
                const f32x4 N2 = XTY(M1, N1, z4), M2 = XTY(N1, M1, z4);
                const f32x4 T2t = XTY(N2, T1t, T1t);
                const f32x4 N4 = XTY(M2, N2, z4), M4 = XTY(N2, M2, z4);
                const f32x4 T4t = XTY(N4, T2t, T2t);
                const f32x4 N8 = XTY(M4, N4, z4);
                const f32x4 T8t = XTY(N8, T4t, T4t);
#undef XTY
                u32x2 tw; tw.x = hw_pk2(T8t[0], T8t[1]); tw.y = hw_pk2(T8t[2], T8t[3]);
                *(LAS u32x2*)(TB + fr * 16 + 4 * g) = tw;
            } else {
#pragma unroll
                for (int r = 0; r < 4; ++r) { const int t = 4 * g + r; QKM[t * 16 + fr] = hw_bf((fr <= t) ? acc[r] * Lf[O_GL + t] * gs_inv : 0.f); }
            }
        }
        if (c + 1 < c_end) GD_XFORM((c + 1) & 1);
        if (c + 2 < c_end) GD_LOAD(c + 2);
        LBAR();
        f32x4 accu = {0.f, 0.f, 0.f, 0.f};
        {
            const bf16x8 tf = mk_frag(*(const LAS u32x2*)(TB + fr * 16 + 4 * g), zz);
            u32x2 ulo, wlo;
            { const float b0 = B_[O_SC + 16 + 4 * g + 0], b1 = B_[O_SC + 16 + 4 * g + 1], b2 = B_[O_SC + 16 + 4 * g + 2], b3 = B_[O_SC + 16 + 4 * g + 3];
              ulo.x = hw_pk2(b0 * B_[O_VV + (4 * g + 0) * 128 + c0 + fr], b1 * B_[O_VV + (4 * g + 1) * 128 + c0 + fr]); ulo.y = hw_pk2(b2 * B_[O_VV + (4 * g + 2) * 128 + c0 + fr], b3 * B_[O_VV + (4 * g + 3) * 128 + c0 + fr]);
              wlo.x = hw_pk2(Lf[O_WSRC + (4 * g + 0) * 128 + c0 + fr], Lf[O_WSRC + (4 * g + 1) * 128 + c0 + fr]); wlo.y = hw_pk2(Lf[O_WSRC + (4 * g + 2) * 128 + c0 + fr], Lf[O_WSRC + (4 * g + 3) * 128 + c0 + fr]); }
            accu = __builtin_amdgcn_mfma_f32_16x16x32_bf16(tf, mk_frag(ulo, zz), accu, 0, 0, 0);
            f32x4 accw = {0.f, 0.f, 0.f, 0.f};
            accw = __builtin_amdgcn_mfma_f32_16x16x32_bf16(tf, mk_frag(wlo, zz), accw, 0, 0, 0);
#pragma unroll
            for (int r = 0; r < 4; ++r) WB[(4 * g + r) * RS + c0 + fr] = hw_bf(-accw[r]);
        }
        LBAR();
        if (role == 0) {
            GD_STATE_PART(c);
        } else {
            float* rec = STASH + (size_t)(c - c_begin) * REC;
            for (int i = tid; i < 832; i += NTHREADS) { const int o = i < 528 ? O_QB + 4 * i : (i < 800 ? O_WB + 4 * (i - 528) : O_QKM + 4 * (i - 800)); *(GAS f32x4*)(rec + 4 * i) = *(const LAS f32x4*)(Lf + o); }
#pragma unroll
            for (int r = 0; r < 4; ++r) rec[3328 + (w * 4 + r) * 64 + lane] = accu[r];
            if (tid == 0) rec[5376] = glast;
        }
        LBAR();
    }
    if (role == 0) {
#pragma unroll
        for (int i = 0; i < 8; ++i)
#pragma unroll
            for (int r = 0; r < 4; ++r) STATE[((w * 8 + i) * 4 + r) * 64 + lane] = Sacc[i][r];
        asm volatile("s_waitcnt vmcnt(0)" ::: "memory");
        __syncthreads();
        if (tid == 0) { __builtin_amdgcn_fence(__ATOMIC_RELEASE, "agent"); asm volatile("s_waitcnt vmcnt(0)" ::: "memory"); __hip_atomic_store(flag, 1u, __ATOMIC_RELAXED, __HIP_MEMORY_SCOPE_AGENT); }
    } else {
        if (tid == 0) { unsigned sp = 0; while (__hip_atomic_load(flag, __ATOMIC_RELAXED, __HIP_MEMORY_SCOPE_AGENT) == 0u) { __builtin_amdgcn_s_sleep(8); if (++sp > (1u << 22)) break; }
            __builtin_amdgcn_fence(__ATOMIC_ACQUIRE, "agent"); asm volatile("s_waitcnt vmcnt(0)" ::: "memory"); }
        __syncthreads();
#pragma unroll
        for (int i = 0; i < 8; ++i)
#pragma unroll
            for (int r = 0; r < 4; ++r) Sacc[i][r] = STATE[((w * 8 + i) * 4 + r) * 64 + lane];
        f32x4 pa, pb; f32x4 pu; float pg;
#define GD_REC_LOAD(cc) do { const float* rec = STASH + (size_t)((cc) - c_begin) * REC; pa = *(const GAS f32x4*)(rec + 4 * tid); pb = (tid < 320) ? *(const GAS f32x4*)(rec + 4 * (tid + 512)) : (f32x4){0.f, 0.f, 0.f, 0.f}; \
            _Pragma("unroll") for (int r = 0; r < 4; ++r) pu[r] = rec[3328 + (w * 4 + r) * 64 + lane]; pg = rec[5376]; } while (0)
        GD_REC_LOAD(c_begin);
        for (int c = c_begin; c < c_end; ++c) {
            { const int i0 = tid, o0 = i0 < 528 ? O_QB + 4 * i0 : O_WB + 4 * (i0 - 528); *(LAS f32x4*)(Lf + o0) = pa;
              if (tid < 320) { const int i1 = tid + 512; const int o1 = i1 < 528 ? O_QB + 4 * i1 : (i1 < 800 ? O_WB + 4 * (i1 - 528) : O_QKM + 4 * (i1 - 800)); *(LAS f32x4*)(Lf + o1) = pb; } }
            const f32x4 accu = pu; const float glast = pg;
            if (c + 1 < c_end) GD_REC_LOAD(c + 1);
            LBAR();
            GD_STATE_PART(c);
            LBAR();
        }
#undef GD_REC_LOAD
    }
#undef GD_STATE_PART
#undef GD_LOAD
#undef GD_XFORM
}

__device__ __forceinline__ void scan_rwkv_unit(const Args& A, Frame& F, int unit) {
    int tid = F.tid; asm volatile("" : "+v"(tid));
    const int lane = tid & 63, w = F.wave;
    const int b = unit >> 4, h = unit & 15;
    const bf16* P = (const bf16*)(A.ws + WS_PROJ) + (size_t)b * SEQ * PROJ_LD + OC_RW;
    const bf16* LO = (const bf16*)(A.ws + WS_LO) + (size_t)b * SEQ * LORA_N;
    bf16* Y = (bf16*)(A.ws + WS_ACTA) + (size_t)b * SEQ * D + 1024 + h * 64;
    LAS float* Lf = (LAS float*)(F.lds + RING_OFF);
    constexpr int BUFSZ = 6208, O_KK = 0, O_WR = 1024, O_W = 2048, O_NKA = 3072, O_K = 4096, O_V = 5120, O_SC = 6144, O_OUT = 2 * BUFSZ;
    const int tl = tid >> 5, d2 = (tid & 31) * 2, hd = h * 64 + d2;
    float mu_r[2], mu_k[2], mu_v[2], w0[2], a0[2], k_k[2], k_a[2], r_k[2], lnw[2], lnb[2];
#pragma unroll
    for (int i = 0; i < 2; ++i) { mu_r[i] = A.in[I_MU][RW_R + hd + i]; mu_k[i] = A.in[I_MU][RW_K + hd + i]; mu_v[i] = A.in[I_MU][RW_V + hd + i];
        w0[i] = A.in[I_W0][hd + i]; a0[i] = A.in[I_A0][hd + i]; k_k[i] = A.in[I_KK][hd + i]; k_a[i] = A.in[I_KA][hd + i]; r_k[i] = A.in[I_RK][hd + i];
        lnw[i] = A.in[I_LNW][hd + i]; lnb[i] = A.in[I_LNB][hd + i]; }
    unsigned rr[2], rk[2], rv[2], rlw, rla, rg_cur = 0u, rg_nxt = 0u;
#define RW_LOAD(c) do { const int t_ = (c) * TC + tl; const bf16* pr = P + (size_t)t_ * PROJ_LD; \
        rr[0] = *(const GAS unsigned*)(pr + RW_R + hd); rk[0] = *(const GAS unsigned*)(pr + RW_K + hd); rv[0] = *(const GAS unsigned*)(pr + RW_V + hd); \
        if (t_ > 0) { rr[1] = *(const GAS unsigned*)(pr - PROJ_LD + RW_R + hd); rk[1] = *(const GAS unsigned*)(pr - PROJ_LD + RW_K + hd); rv[1] = *(const GAS unsigned*)(pr - PROJ_LD + RW_V + hd); } \
        else { rr[1] = 0u; rk[1] = 0u; rv[1] = 0u; } \
        const bf16* lr = LO + (size_t)t_ * LORA_N; rlw = *(const GAS unsigned*)(lr + hd); rla = *(const GAS unsigned*)(lr + 1024 + hd); rg_nxt = *(const GAS unsigned*)(lr + 2048 + hd); } while (0)
#define RW_XFORM(bufi) do { LAS float* B_ = Lf + (bufi) * BUFSZ; f32x2 kk2, wr2, w2_, nka2, k2, v2_; float skk = 0.f, sc1 = 0.f, sc2 = 0.f, sbs = 0.f; float aa[2], rrv[2]; \
        _Pragma("unroll") for (int i_ = 0; i_ < 2; ++i_) { \
            const float r0 = i_ ? bf_hi(rr[0]) : bf_lo(rr[0]), r1 = i_ ? bf_hi(rr[1]) : bf_lo(rr[1]); \
            const float k0_ = i_ ? bf_hi(rk[0]) : bf_lo(rk[0]), k1_ = i_ ? bf_hi(rk[1]) : bf_lo(rk[1]); \
            const float v0_ = i_ ? bf_hi(rv[0]) : bf_lo(rv[0]), v1_ = i_ ? bf_hi(rv[1]) : bf_lo(rv[1]); \
            const float lw = i_ ? bf_hi(rlw) : bf_lo(rlw), la = i_ ? bf_hi(rla) : bf_lo(rla); \
            const float r_ = r0 + (r1 - r0) * mu_r[i_], kx = k0_ + (k1_ - k0_) * mu_k[i_], vx = v0_ + (v1_ - v0_) * mu_v[i_]; \
            const float wd = __expf(-0.6065306597126334f * sigmoidf_(w0[i_] + lw)); const float a_ = sigmoidf_(a0[i_] + la); \
            const float kk0 = kx * k_k[i_]; const float km = kx * (1.f + (a_ - 1.f) * k_a[i_]); \
            kk2[i_] = kk0; skk += kk0 * kk0; aa[i_] = a_; rrv[i_] = r_; wr2[i_] = wd * r_; w2_[i_] = wd; k2[i_] = km; v2_[i_] = vx; sc2 += km * r_; sbs += r_ * km * r_k[i_]; } \
        skk = half_sum32(skk); const float rkk = __builtin_amdgcn_rsqf(skk + EPS); \
        _Pragma("unroll") for (int i_ = 0; i_ < 2; ++i_) { kk2[i_] *= rkk; nka2[i_] = -(kk2[i_] * aa[i_]); sc1 += kk2[i_] * aa[i_] * rrv[i_]; } \
        sc1 = half_sum32(sc1); sc2 = half_sum32(sc2); sbs = half_sum32(sbs); \
        *(LAS f32x2*)(B_ + O_KK + tl * 64 + d2) = kk2; *(LAS f32x2*)(B_ + O_WR + tl * 64 + d2) = wr2; *(LAS f32x2*)(B_ + O_W + tl * 64 + d2) = w2_; \
        *(LAS f32x2*)(B_ + O_NKA + tl * 64 + d2) = nka2; *(LAS f32x2*)(B_ + O_K + tl * 64 + d2) = k2; *(LAS f32x2*)(B_ + O_V + tl * 64 + d2) = v2_; \
        if ((tid & 31) == 0) { f32x4 sc; sc[0] = sc1; sc[1] = sc2; sc[2] = sbs; sc[3] = 0.f; *(LAS f32x4*)(B_ + O_SC + tl * 4) = sc; } } while (0)
    RW_LOAD(0); RW_XFORM(0); rg_cur = rg_nxt;
    LBAR();
    f32x2 S2[4];
#pragma unroll
    for (int i = 0; i < 4; ++i) S2[i] = (f32x2){0.f, 0.f};
    const int j = lane & 15, col = w * 8 + (lane >> 4) * 2;
    for (int c = 0; c < NCHUNK; ++c) {
        if (c + 1 < NCHUNK) RW_LOAD(c + 1);
        const LAS float* B_ = Lf + (c & 1) * BUFSZ;
        float os0 = 0.f, os1 = 0.f;
        f32x4 kk, wr, ww, nka, kv, sc, nkk, nwr, nww, nnka, nkv, nsc; f32x2 v2, nv2;
#define RW_LDSTEP(t_, KK, WR, WW, NKA, KV, V2, SC) do { KK = *(const LAS f32x4*)(B_ + O_KK + (t_) * 64 + 4 * j); WR = *(const LAS f32x4*)(B_ + O_WR + (t_) * 64 + 4 * j); WW = *(const LAS f32x4*)(B_ + O_W + (t_) * 64 + 4 * j); \
            NKA = *(const LAS f32x4*)(B_ + O_NKA + (t_) * 64 + 4 * j); KV = *(const LAS f32x4*)(B_ + O_K + (t_) * 64 + 4 * j); V2 = *(const LAS f32x2*)(B_ + O_V + (t_) * 64 + col); SC = *(const LAS f32x4*)(B_ + O_SC + (t_) * 4); } while (0)
        RW_LDSTEP(0, kk, wr, ww, nka, kv, v2, sc);
#pragma unroll
        for (int t = 0; t < TC; ++t) {
            if (t + 1 < TC) { RW_LDSTEP(t + 1, nkk, nwr, nww, nnka, nkv, nv2, nsc); }
            __builtin_amdgcn_sched_barrier(0);
            f32x2 d1 = S2[0] * kk[0], d2 = S2[0] * wr[0], e1 = S2[1] * kk[1], e2 = S2[1] * wr[1];
            d1 += S2[2] * kk[2]; d2 += S2[2] * wr[2]; e1 += S2[3] * kk[3]; e2 += S2[3] * wr[3];
            d1 += e1; d2 += e2;
            { float r0_ = d1[0], r1_ = d1[1], r2_ = d2[0], r3_ = d2[1]; row_sum16_x4(r0_, r1_, r2_, r3_); d1[0] = r0_; d1[1] = r1_; d2[0] = r2_; d2[1] = r3_; }
            const f32x2 o2 = d2 - d1 * sc[0] + v2 * sc[1];
#pragma unroll
            for (int i = 0; i < 4; ++i) S2[i] = S2[i] * ww[i] + d1 * nka[i] + v2 * kv[i];
            os0 = (j == t) ? o2[0] : os0; os1 = (j == t) ? o2[1] : os1;
            kk = nkk; wr = nwr; ww = nww; nka = nnka; kv = nkv; v2 = nv2; sc = nsc;
        }
#undef RW_LDSTEP
        { f32x2 o2 = {os0, os1}; *(LAS f32x2*)(Lf + O_OUT + j * 64 + col) = o2; }
        if (c + 1 < NCHUNK) RW_XFORM((c + 1) & 1);
        LBAR();
        {
            const f32x2 o2 = *(const LAS f32x2*)(Lf + O_OUT + tl * 64 + d2); const f32x2 vv = *(const LAS f32x2*)(B_ + O_V + tl * 64 + d2); const float bs = B_[O_SC + tl * 4 + 2];
            const float mean = half_sum32(o2[0] + o2[1]) * (1.0f / 64.0f); const float e0 = o2[0] - mean, e1 = o2[1] - mean;
            const float var = half_sum32(e0 * e0 + e1 * e1) * (1.0f / 64.0f); const float rs = __builtin_amdgcn_rsqf(var + 64e-5f);
            const float y0 = (e0 * rs * lnw[0] + lnb[0] + bs * vv[0]) * bf_lo(rg_cur), y1 = (e1 * rs * lnw[1] + lnb[1] + bs * vv[1]) * bf_hi(rg_cur);
            *(GAS unsigned*)(Y + (size_t)(c * TC + tl) * D + d2) = pk2(y0, y1);
        }
        rg_cur = rg_nxt;
        LBAR();
    }
#undef RW_LOAD
#undef RW_XFORM
}

template <int LAYER>
__device__ __forceinline__ void post_rows(const Args& A, Frame& F) {
    const int gw = F.vcu * NWAVES + F.wave, NGW = F.G * NWAVES, lane = F.lane;
    const bf16* O = (const bf16*)(A.ws + WS_O); const bf16* P = (const bf16*)(A.ws + WS_PROJ); bf16* Y = (bf16*)(A.ws + WS_ACTA);
    for (int m = gw; m < T; m += NGW) {
        const GAS u32x2* orow = (const GAS u32x2*)(O + (size_t)m * D) + lane; const bf16* prow = P + (size_t)m * PROJ_LD;
        constexpr int NJ = LAYER == 0 ? 8 : 4;
#pragma unroll
        for (int jj = 0; jj < NJ; ++jj) {
            const u32x2 ow_ = orow[64 * jj]; const f32x4 v = {bf_lo(ow_.x), bf_hi(ow_.x), bf_lo(ow_.y), bf_hi(ow_.y)}; float ss = (v[0] * v[0] + v[1] * v[1]) + (v[2] * v[2] + v[3] * v[3]);
            const bool wide = (LAYER == 0 && jj < 4);
            const float ms = wide ? wave_sum(ss) * (1.0f / 256.0f) : half_sum32(ss) * (1.0f / 128.0f);
            const float r = __builtin_amdgcn_rsqf(ms + EPS);
            const int cih = wide ? 4 * lane : 4 * (lane & 31);
            const float* gsrc = LAYER == 0 ? (wide ? A.in[I_GLA_NORM] : A.in[I_GDN_NORM]) : A.in[I_HG_NORM];
            const f32x4 g = *(const GAS f32x4*)(gsrc + cih);
            const int zcol = LAYER == 0 ? (wide ? EC_GZ + jj * 256 + 4 * lane : EC_BZ + (jj - 4) * 256 + 4 * lane) : OC_HG + jj * 256 + 4 * lane;
            const u32x2 zw = *(const GAS u32x2*)(prow + zcol);
            const float y0 = v[0] * r * g[0] * siluf_(bf_lo(zw.x)), y1 = v[1] * r * g[1] * siluf_(bf_hi(zw.x)), y2 = v[2] * r * g[2] * siluf_(bf_lo(zw.y)), y3 = v[3] * r * g[3] * siluf_(bf_hi(zw.y));
            if constexpr (LAYER == 1) { int o8 = __builtin_amdgcn_cvt_pk_fp8_f32(y0, y1, 0, false); o8 = __builtin_amdgcn_cvt_pk_fp8_f32(y2, y3, o8, true);
                *(GAS unsigned*)((unsigned char*)Y + (size_t)m * D + 256 * jj + 4 * lane) = (unsigned)o8; }
            else { u32x2 o; o.x = pk2(y0, y1); o.y = pk2(y2, y3);
                *(GAS u32x2*)(Y + (size_t)m * D + 256 * jj + 4 * lane) = o; }
        }
    }
}
__device__ __forceinline__ void lora_prep_rows(const Args& A, Frame& F) {
    const int gw = F.vcu * NWAVES + F.wave, NGW = F.G * NWAVES, lane = F.lane;
    const bf16* P = (const bf16*)(A.ws + WS_PROJ); bf16* LA = (bf16*)(A.ws + WS_LA); const float* mu = A.in[I_MU];
    for (int m = gw; m < T; m += NGW) { const bool hasprev = (m % SEQ) != 0; const bf16* prow = P + (size_t)m * PROJ_LD + OC_RW + RW_WL;
#pragma unroll
        for (int i = 0; i < 7; ++i) { const int c = lane + 64 * i;
            const float x = __uint_as_float((unsigned)prow[c] << 16), xp = hasprev ? __uint_as_float((unsigned)prow[c - PROJ_LD] << 16) : 0.f;
            const float ts = x + (xp - x) * mu[RW_WL + c];
            const float v = c < 96 ? tanhf(ts) : (c < 192 ? ts : sigmoidf_(ts));
            LA[(size_t)m * LORA_K + c] = (bf16)f2bf(v); }
        LA[(size_t)m * LORA_K + 448 + lane] = (bf16)0; }
}
__device__ __forceinline__ void final_rows(const Args& A, Frame& F, const float oscale, const bf16* Hs) {
    const int gw = F.vcu * NWAVES + F.wave, NGW = F.G * NWAVES, lane = F.lane;
    const float* rowss = (const float*)(A.ws + WS_RSP) + (size_t)RS_FINAL * T * 32; const GAS f32x4* g = (const GAS f32x4*)A.in[I_NFINAL] + lane;
    for (int m = gw; m < T; m += NGW) { const float r = oscale * __builtin_amdgcn_rsqf(wave_sum(lane < 32 ? rowss[(size_t)m * 32 + lane] : 0.f) * (1.0f / D) + EPS); GAS f32x4* row = (GAS f32x4*)(A.out + (size_t)m * D) + lane;
        const GAS u32x2* hrow = (const GAS u32x2*)(Hs + (size_t)m * D) + lane;
#pragma unroll
        for (int jj = 0; jj < 8; ++jj) { const u32x2 hw = hrow[64 * jj]; const f32x4 v = {bf_lo(hw.x), bf_hi(hw.x), bf_lo(hw.y), bf_hi(hw.y)}; row[64 * jj] = v * r * g[64 * jj]; } }
}

__device__ __forceinline__ void scan_rwkv_mfma_unit(const Args& A, Frame& F, int unit, const int role) {
    int tid = F.tid; asm volatile("" : "+v"(tid));
    const int lane = tid & 63, w = F.wave;
    const int b = unit >> 3, hp = unit & 7;
    const bf16* P = (const bf16*)(A.ws + WS_PROJ) + (size_t)b * SEQ * PROJ_LD + OC_RW;
    const bf16* LO = (const bf16*)(A.ws + WS_LO) + (size_t)b * SEQ * LORA_N;
    unsigned char* Y = (unsigned char*)(A.ws + WS_ACTA) + (size_t)b * SEQ * D + 1024;
    LAS float* Lf = (LAS float*)(F.lds + RING_OFF);
    constexpr int RS = 72;
    constexpr int O_CONST = 0;
    constexpr int O_XF = 1280;
    constexpr int O_VV = O_XF + 2 * 5 * 1024;
    constexpr int O_BS = O_VV + 4 * 1024;
    constexpr int O_IMG = O_BS + 64;
    constexpr int I_CT = 0, I_BT = 576, I_KL = 1152, I_RT = 1728, I_CF = 2304, I_BTT = 3328, I_KTT = 3840, I_WCB = 4352, I_G1B = 4928, I_TTB = 5056, I_RKB = 5184, I_RBB = 5312, I_W15 = 5440, I_OUT = 5504, IMGSZ = 6528;
    static_assert((O_IMG + 2 * IMGSZ) * 4 <= RING_BYTES, "rwkv lds");
    for (int i = tid; i < 1280; i += NTHREADS) { const int arr = i >> 7, ch = hp * 128 + (i & 127); float v;
        switch (arr) { case 0: v = A.in[I_MU][RW_R + ch]; break; case 1: v = A.in[I_MU][RW_K + ch]; break; case 2: v = A.in[I_MU][RW_V + ch]; break; case 3: v = A.in[I_W0][ch]; break; case 4: v = A.in[I_A0][ch]; break;
                       case 5: v = A.in[I_KK][ch]; break; case 6: v = A.in[I_KA][ch]; break; case 7: v = A.in[I_RK][ch]; break; case 8: v = A.in[I_LNW][ch]; break; default: v = A.in[I_LNB][ch]; break; }
        Lf[O_CONST + i] = v; }
    const int hx = tid >> 8, tl = (tid >> 4) & 15, d4 = (tid & 15) * 4, ch4 = hx * 64 + d4, col4 = hp * 128 + ch4;
    u32x2 rr[2], rk[2], rv[2], rlw, rla, rg_cur = {0u, 0u}, rg_nxt = {0u, 0u}, rg_far = {0u, 0u};
#define RM_LOAD(c) do { const int t_ = (c) * TC + tl; const bf16* pr = P + (size_t)t_ * PROJ_LD + col4; \
        rr[0] = *(const GAS u32x2*)(pr + RW_R); rk[0] = *(const GAS u32x2*)(pr + RW_K); rv[0] = *(const GAS u32x2*)(pr + RW_V); \
        const bf16* pp_ = (t_ > 0) ? pr - PROJ_LD : pr; rr[1] = *(const GAS u32x2*)(pp_ + RW_R); rk[1] = *(const GAS u32x2*)(pp_ + RW_K); rv[1] = *(const GAS u32x2*)(pp_ + RW_V); \
        if (t_ == 0) { rr[1] = (u32x2){0u, 0u}; rk[1] = (u32x2){0u, 0u}; rv[1] = (u32x2){0u, 0u}; } \
        const bf16* lr = LO + (size_t)t_ * LORA_N + col4; rlw = *(const GAS u32x2*)(lr); rla = *(const GAS u32x2*)(lr + 1024); rg_far = *(const GAS u32x2*)(lr + 2048); } while (0)
#define RM_XFORM(bufi) do { LAS float* X_ = Lf + O_XF + hx * 5 * 1024 + tl * 64 + d4; \
        const f32x4 mur = *(const LAS f32x4*)(Lf + O_CONST + 0 * 128 + ch4), muk = *(const LAS f32x4*)(Lf + O_CONST + 1 * 128 + ch4), muv = *(const LAS f32x4*)(Lf + O_CONST + 2 * 128 + ch4); \
        const f32x4 w0_ = *(const LAS f32x4*)(Lf + O_CONST + 3 * 128 + ch4), a0_ = *(const LAS f32x4*)(Lf + O_CONST + 4 * 128 + ch4), kk_ = *(const LAS f32x4*)(Lf + O_CONST + 5 * 128 + ch4); \
        const f32x4 ka_ = *(const LAS f32x4*)(Lf + O_CONST + 6 * 128 + ch4), rk_ = *(const LAS f32x4*)(Lf + O_CONST + 7 * 128 + ch4); \
        const float r0[4] = {bf_lo(rr[0].x), bf_hi(rr[0].x), bf_lo(rr[0].y), bf_hi(rr[0].y)}, r1[4] = {bf_lo(rr[1].x), bf_hi(rr[1].x), bf_lo(rr[1].y), bf_hi(rr[1].y)}; \
        const float k0[4] = {bf_lo(rk[0].x), bf_hi(rk[0].x), bf_lo(rk[0].y), bf_hi(rk[0].y)}, k1[4] = {bf_lo(rk[1].x), bf_hi(rk[1].x), bf_lo(rk[1].y), bf_hi(rk[1].y)}; \
        const float v0[4] = {bf_lo(rv[0].x), bf_hi(rv[0].x), bf_lo(rv[0].y), bf_hi(rv[0].y)}, v1[4] = {bf_lo(rv[1].x), bf_hi(rv[1].x), bf_lo(rv[1].y), bf_hi(rv[1].y)}; \
        const float lw[4] = {bf_lo(rlw.x), bf_hi(rlw.x), bf_lo(rlw.y), bf_hi(rlw.y)}, la[4] = {bf_lo(rla.x), bf_hi(rla.x), bf_lo(rla.y), bf_hi(rla.y)}; \
        f32x4 r4, w4, k4, v4, kk4, b4; float skk = 0.f, sbs = 0.f; float aa[4]; \
        _Pragma("unroll") for (int i_ = 0; i_ < 4; ++i_) { const float r_ = r0[i_] + (r1[i_] - r0[i_]) * mur[i_], kx = k0[i_] + (k1[i_] - k0[i_]) * muk[i_], vx = v0[i_] + (v1[i_] - v0[i_]) * muv[i_]; \
            const float wd = __expf(-0.6065306597126334f * sigmoidf_(w0_[i_] + lw[i_])); const float a_ = sigmoidf_(a0_[i_] + la[i_]); \
            const float kk0 = kx * kk_[i_], km = kx * (1.f + (a_ - 1.f) * ka_[i_]); \
            r4[i_] = r_; w4[i_] = wd; k4[i_] = km; v4[i_] = vx; kk4[i_] = kk0; aa[i_] = a_; skk += kk0 * kk0; sbs += r_ * km * rk_[i_]; } \
        row_sum16_x2(skk, sbs); const float rkk = __builtin_amdgcn_rsqf(skk + EPS); \
        _Pragma("unroll") for (int i_ = 0; i_ < 4; ++i_) { kk4[i_] *= rkk; b4[i_] = kk4[i_] * aa[i_]; } \
        *(LAS f32x4*)(X_) = r4; *(LAS f32x4*)(X_ + 1024) = w4; *(LAS f32x4*)(X_ + 2048) = k4; *(LAS f32x4*)(X_ + 3072) = kk4; *(LAS f32x4*)(X_ + 4096) = b4; \
        *(LAS f32x4*)(Lf + O_VV + ((bufi) * 2 + hx) * 1024 + tl * 64 + d4) = v4; \
        if ((tid & 15) == 0) Lf[O_BS + ((bufi) * 2 + hx) * 16 + tl] = sbs; } while (0)
    constexpr int SPLIT = 60;
    const int c_begin = role ? SPLIT : 0, c_end = role ? NCHUNK : SPLIT;
    constexpr int REC = 7584;
    float* STASH = (float*)(A.ws + (unit < 32 ? WS_WEV_IN : WS_END)) + (size_t)(unit & 31) * (NCHUNK - SPLIT) * REC;
    float* STATE = (float*)(A.ws + WS_STATE + 4 * MiB) + (size_t)unit * 8192;
    gu32* flag = F.ctl + 49152 + unit * 64;
    LBAR();
    RM_LOAD(c_begin); RM_XFORM(c_begin & 1); rg_cur = rg_far; RM_LOAD(c_begin + 1); rg_nxt = rg_far;
    LBAR();
    f32x4 Macc[4];
#pragma unroll
    for (int i = 0; i < 4; ++i) Macc[i] = (f32x4){0.f, 0.f, 0.f, 0.f};
    const int fr = lane & 15, g = lane >> 4, hh = w >> 2, ww = w & 3, c0 = ww * 16;
    LAS float* IM = Lf + O_IMG + hh * IMGSZ;
    LAS bf16* CT = (LAS bf16*)(IM + I_CT); LAS bf16* BT = (LAS bf16*)(IM + I_BT); LAS bf16* KL = (LAS bf16*)(IM + I_KL); LAS bf16* RT = (LAS bf16*)(IM + I_RT);
    LAS bf16* BTT = (LAS bf16*)(IM + I_BTT); LAS bf16* KTT = (LAS bf16*)(IM + I_KTT); LAS bf16* WCB = (LAS bf16*)(IM + I_WCB);
    LAS bf16* G1B = (LAS bf16*)(IM + I_G1B); LAS bf16* TTB = (LAS bf16*)(IM + I_TTB); LAS bf16* RKB = (LAS bf16*)(IM + I_RKB); LAS bf16* RBB = (LAS bf16*)(IM + I_RBB);
    const u32x2 zz = {0u, 0u};
#define RM_STATE_PART(vb) do { \
        { \
            bf16x8 mb[2]; \
_Pragma("unroll") \
            for (int ks = 0; ks < 2; ++ks) { u32x2 slo, shi; slo.x = hw_pk2(Macc[2 * ks][0], Macc[2 * ks][1]); slo.y = hw_pk2(Macc[2 * ks][2], Macc[2 * ks][3]); shi.x = hw_pk2(Macc[2 * ks + 1][0], Macc[2 * ks + 1][1]); shi.y = hw_pk2(Macc[2 * ks + 1][2], Macc[2 * ks + 1][3]); \
                mb[ks] = mk_frag(slo, shi); } \
            f32x4 accR = accU, acco = {0.f, 0.f, 0.f, 0.f}; \
_Pragma("unroll") \
            for (int ks = 0; ks < 2; ++ks) { \
                accR = __builtin_amdgcn_mfma_f32_16x16x32_bf16(mk_frag(*(const LAS u32x2*)(WCB + fr * RS + 32 * ks + 4 * g), *(const LAS u32x2*)(WCB + fr * RS + 32 * ks + 16 + 4 * g)), mb[ks], accR, 0, 0, 0); \
                acco = __builtin_amdgcn_mfma_f32_16x16x32_bf16(mk_frag(*(const LAS u32x2*)(RT + fr * RS + 32 * ks + 4 * g), *(const LAS u32x2*)(RT + fr * RS + 32 * ks + 16 + 4 * g)), mb[ks], acco, 0, 0, 0); } \
            u32x2 rn; rn.x = hw_pk2(accR[0], accR[1]); rn.y = hw_pk2(accR[2], accR[3]); \
            const bf16x8 rb = mk_frag(rn, zz); \
            acco = __builtin_amdgcn_mfma_f32_16x16x32_bf16(mk_frag(*(const LAS u32x2*)(RKB + fr * 16 + 4 * g), zz), vb, acco, 0, 0, 0); \
            acco = __builtin_amdgcn_mfma_f32_16x16x32_bf16(mk_frag(*(const LAS u32x2*)(RBB + fr * 16 + 4 * g), zz), rb, acco, 0, 0, 0); \
_Pragma("unroll") \
            for (int r = 0; r < 4; ++r) IM[I_OUT + (4 * g + r) * 64 + c0 + fr] = acco[r]; \
_Pragma("unroll") \
            for (int i = 0; i < 4; ++i) { const f32x4 w15 = *(const LAS f32x4*)(IM + I_W15 + 16 * i + 4 * g); \
                f32x4 m = __builtin_amdgcn_mfma_f32_16x16x32_bf16(mk_frag(*(const LAS u32x2*)(KTT + (16 * i + fr) * 16 + 4 * g), zz), vb, Macc[i], 0, 0, 0); \
                m = __builtin_amdgcn_mfma_f32_16x16x32_bf16(mk_frag(*(const LAS u32x2*)(BTT + (16 * i + fr) * 16 + 4 * g), zz), rb, m, 0, 0, 0); \
                Macc[i] = m * w15; } \
        } \
        } while (0)
#define RM_FLUSH(cc_, gb_, vv_, bs_) do { \
        { \
            const f32x4 o4 = *(const LAS f32x4*)(Lf + O_IMG + hx * IMGSZ + I_OUT + tl * 64 + d4); const f32x4 vv = (vv_); const float bs = (bs_); \
            const f32x4 lnw = *(const LAS f32x4*)(Lf + O_CONST + 8 * 128 + ch4), lnb = *(const LAS f32x4*)(Lf + O_CONST + 9 * 128 + ch4); \
            float sm = (o4[0] + o4[1]) + (o4[2] + o4[3]), dummy = 0.f; row_sum16_x2(sm, dummy); const float mean = sm * (1.0f / 64.0f); \
            const f32x4 e4 = o4 - mean; float sv = (e4[0] * e4[0] + e4[1] * e4[1]) + (e4[2] * e4[2] + e4[3] * e4[3]); row_sum16_x2(sv, dummy); const float rs = __builtin_amdgcn_rsqf(sv * (1.0f / 64.0f) + 64e-5f); \
            const float gg[4] = {bf_lo((gb_).x), bf_hi((gb_).x), bf_lo((gb_).y), bf_hi((gb_).y)}; \
            float y[4]; \
_Pragma("unroll") \
            for (int i = 0; i < 4; ++i) y[i] = (e4[i] * rs * lnw[i] + lnb[i] + bs * vv[i]) * gg[i]; \
            int o8 = __builtin_amdgcn_cvt_pk_fp8_f32(y[0], y[1], 0, false); o8 = __builtin_amdgcn_cvt_pk_fp8_f32(y[2], y[3], o8, true); \
            *(GAS unsigned*)(Y + (size_t)((cc_) * TC + tl) * D + col4) = (unsigned)o8; \
        } \
        } while (0)
    for (int c = c_begin; c < c_end; ++c) {
        {
            const int hq = tid >> 8, seg = (tid >> 6) & 3, d = tid & 63;
            const LAS float* X_ = Lf + O_XF + hq * 5 * 1024 + d; LAS float* IQ = Lf + O_IMG + hq * IMGSZ;
            LAS bf16* CTq = (LAS bf16*)(IQ + I_CT); LAS bf16* BTq = (LAS bf16*)(IQ + I_BT); LAS bf16* KLq = (LAS bf16*)(IQ + I_KL); LAS bf16* RTq = (LAS bf16*)(IQ + I_RT);
            float wall = 1.f, wpre = 1.f;
#pragma unroll
            for (int t = 0; t < 16; ++t) { if (t == 4 * seg) wpre = wall; wall *= X_[1024 + t * 64]; }
            float wt = wpre; unsigned short bt4[4], kt4[4];
#pragma unroll
            for (int i = 0; i < 4; ++i) { const int t = 4 * seg + i; const float wprev = wt; wt *= X_[1024 + t * 64]; const float iw = __builtin_amdgcn_rcpf(wt);
                const float r_ = X_[t * 64], k_ = X_[2048 + t * 64], kk_ = X_[3072 + t * 64], b_ = X_[4096 + t * 64];
                const float ct = kk_ * wprev, bt = b_ * iw, kt = k_ * iw;
                CTq[t * RS + d] = hw_bf(ct); IQ[I_CF + t * 64 + d] = ct; BTq[t * RS + d] = hw_bf(bt); KLq[t * RS + d] = hw_bf(kt); RTq[t * RS + d] = hw_bf(r_ * wt);
                bt4[i] = (unsigned short)hw_bf(-bt); kt4[i] = (unsigned short)hw_bf(kt); }
            u32x2 o; o.x = (unsigned)bt4[0] | ((unsigned)bt4[1] << 16); o.y = (unsigned)bt4[2] | ((unsigned)bt4[3] << 16); *(LAS u32x2*)((LAS bf16*)(IQ + I_BTT) + d * 16 + 4 * seg) = o;
            o.x = (unsigned)kt4[0] | ((unsigned)kt4[1] << 16); o.y = (unsigned)kt4[2] | ((unsigned)kt4[3] << 16); *(LAS u32x2*)((LAS bf16*)(IQ + I_KTT) + d * 16 + 4 * seg) = o;
            if (seg == 3) IQ[I_W15 + d] = wall;
        }
        LBAR();
        if (ww == 0) {
            f32x4 cb = {0.f, 0.f, 0.f, 0.f}, bc = cb, ck = cb, rkm = cb, rbm = cb;
#pragma unroll
            for (int ks = 0; ks < 2; ++ks) { const bf16x8 fc = *(const LAS bf16x8*)(CT + fr * RS + 32 * ks + 8 * g), fb = *(const LAS bf16x8*)(BT + fr * RS + 32 * ks + 8 * g), fk = *(const LAS bf16x8*)(KL + fr * RS + 32 * ks + 8 * g), frr = *(const LAS bf16x8*)(RT + fr * RS + 32 * ks + 8 * g);
                cb = __builtin_amdgcn_mfma_f32_16x16x32_bf16(fc, fb, cb, 0, 0, 0); bc = __builtin_amdgcn_mfma_f32_16x16x32_bf16(fb, fc, bc, 0, 0, 0); ck = __builtin_amdgcn_mfma_f32_16x16x32_bf16(fc, fk, ck, 0, 0, 0);
                rkm = __builtin_amdgcn_mfma_f32_16x16x32_bf16(frr, fk, rkm, 0, 0, 0); rbm = __builtin_amdgcn_mfma_f32_16x16x32_bf16(frr, fb, rbm, 0, 0, 0); }
            f32x4 N1, M1, CKm;
#pragma unroll
            for (int r = 0; r < 4; ++r) { const int t = 4 * g + r; N1[r] = (fr < t) ? -cb[r] : 0.f; M1[r] = (t < fr) ? -bc[r] : 0.f; CKm[r] = (fr < t) ? ck[r] : 0.f;
                RKB[t * 16 + fr] = hw_bf((fr <= t) ? rkm[r] : 0.f); RBB[t * 16 + fr] = hw_bf((fr <= t) ? -rbm[r] : 0.f); }
#define XTY(X, Y, C0) __builtin_amdgcn_mfma_f32_16x16x32_bf16(mk_frag((u32x2){hw_pk2(X[0], X[1]), hw_pk2(X[2], X[3])}, zz), mk_frag((u32x2){hw_pk2(Y[0], Y[1]), hw_pk2(Y[2], Y[3])}, zz), C0, 0, 0, 0)
            const f32x4 z4 = {0.f, 0.f, 0.f, 0.f};
            f32x4 T1t = M1;
#pragma unroll
            for (int r = 0; r < 4; ++r) if (4 * g + r == fr) T1t[r] += 1.f;
            const f32x4 N2 = XTY(M1, N1, z4), M2 = XTY(N1, M1, z4);
            const f32x4 T2t = XTY(N2, T1t, T1t);
            const f32x4 N4 = XTY(M2, N2, z4), M4 = XTY(N2, M2, z4);
            const f32x4 T4t = XTY(N4, T2t, T2t);
            const f32x4 N8 = XTY(M4, N4, z4);
            const f32x4 T8t = XTY(N8, T4t, T4t);
            const f32x4 G1t = XTY(CKm, T8t, z4);
#undef XTY
            u32x2 tw; tw.x = hw_pk2(T8t[0], T8t[1]); tw.y = hw_pk2(T8t[2], T8t[3]); *(LAS u32x2*)(TTB + fr * 16 + 4 * g) = tw;
            tw.x = hw_pk2(G1t[0], G1t[1]); tw.y = hw_pk2(G1t[2], G1t[3]); *(LAS u32x2*)(G1B + fr * 16 + 4 * g) = tw;
        }
        if (c + 1 < c_end) { RM_XFORM((c + 1) & 1); }
        if (c + 2 < c_end) RM_LOAD(c + 2);
        LBAR();
        const LAS float* VVc = Lf + O_VV + ((c & 1) * 2 + hh) * 1024;
        u32x2 vlo; { vlo.x = hw_pk2(VVc[(4 * g + 0) * 64 + c0 + fr], VVc[(4 * g + 1) * 64 + c0 + fr]); vlo.y = hw_pk2(VVc[(4 * g + 2) * 64 + c0 + fr], VVc[(4 * g + 3) * 64 + c0 + fr]); }
        const bf16x8 vb = mk_frag(vlo, zz);
        f32x4 accU = {0.f, 0.f, 0.f, 0.f};
        {
            accU = __builtin_amdgcn_mfma_f32_16x16x32_bf16(mk_frag(*(const LAS u32x2*)(G1B + fr * 16 + 4 * g), zz), vb, accU, 0, 0, 0);
            u32x2 clo; clo.x = hw_pk2(IM[I_CF + (4 * g + 0) * 64 + c0 + fr], IM[I_CF + (4 * g + 1) * 64 + c0 + fr]); clo.y = hw_pk2(IM[I_CF + (4 * g + 2) * 64 + c0 + fr], IM[I_CF + (4 * g + 3) * 64 + c0 + fr]);
            f32x4 accw = {0.f, 0.f, 0.f, 0.f};
            accw = __builtin_amdgcn_mfma_f32_16x16x32_bf16(mk_frag(*(const LAS u32x2*)(TTB + fr * 16 + 4 * g), zz), mk_frag(clo, zz), accw, 0, 0, 0);
#pragma unroll
            for (int r = 0; r < 4; ++r) WCB[(4 * g + r) * RS + c0 + fr] = hw_bf(accw[r]);
        }
        LBAR();
        if (role == 0) {
            RM_STATE_PART(vb);
            LBAR();
            RM_FLUSH(c, rg_cur, *(const LAS f32x4*)(Lf + O_VV + ((c & 1) * 2 + hx) * 1024 + tl * 64 + d4), Lf[O_BS + ((c & 1) * 2 + hx) * 16 + tl]);
        } else {
            float* rec = STASH + (size_t)(c - c_begin) * REC;
            for (int i = tid; i < 1376; i += NTHREADS) { const int hd = i >= 688, j = i - hd * 688; const int o = O_IMG + hd * IMGSZ + (j < 144 ? I_RT + 4 * j : I_BTT + 4 * (j - 144)); *(GAS f32x4*)(rec + 4 * i) = *(const LAS f32x4*)(Lf + o); }
            { GAS unsigned* ru = (GAS unsigned*)(rec + 5504); ru[(w * 2 + 0) * 64 + lane] = hw_pk2(accU[0], accU[1]); ru[(w * 2 + 1) * 64 + lane] = hw_pk2(accU[2], accU[3]); }
            { const f32x4 v4 = *(const LAS f32x4*)(Lf + O_VV + ((c & 1) * 2 + hx) * 1024 + tl * 64 + d4); u32x2 o; o.x = hw_pk2(v4[0], v4[1]); o.y = hw_pk2(v4[2], v4[3]); *(GAS u32x2*)(rec + 6528 + 2 * tid) = o; }
            if (tid < 32) rec[7552 + tid] = Lf[O_BS + (c & 1) * 32 + tid];
            LBAR();
        }
        rg_cur = rg_nxt; rg_nxt = rg_far;
    }
    if (role == 0) {
#pragma unroll
        for (int i = 0; i < 4; ++i)
#pragma unroll
            for (int r = 0; r < 4; ++r) STATE[((w * 4 + i) * 4 + r) * 64 + lane] = Macc[i][r];
        asm volatile("s_waitcnt vmcnt(0)" ::: "memory");
        __syncthreads();
        if (tid == 0) { __builtin_amdgcn_fence(__ATOMIC_RELEASE, "agent"); asm volatile("s_waitcnt vmcnt(0)" ::: "memory"); __hip_atomic_store(flag, 1u, __ATOMIC_RELAXED, __HIP_MEMORY_SCOPE_AGENT); }
    } else {
        if (tid == 0) { unsigned sp = 0; while (__hip_atomic_load(flag, __ATOMIC_RELAXED, __HIP_MEMORY_SCOPE_AGENT) == 0u) { __builtin_amdgcn_s_sleep(8); if (++sp > (1u << 22)) break; }
            __builtin_amdgcn_fence(__ATOMIC_ACQUIRE, "agent"); asm volatile("s_waitcnt vmcnt(0)" ::: "memory"); }
        __syncthreads();
#pragma unroll
        for (int i = 0; i < 4; ++i)
#pragma unroll
            for (int r = 0; r < 4; ++r) Macc[i][r] = STATE[((w * 4 + i) * 4 + r) * 64 + lane];
        f32x4 pi0, pi1, pi2; unsigned pu0, pu1; u32x2 pv, pgate; float pbs;
#define RM_REC_LOAD(cc) do { const float* rec = STASH + (size_t)((cc) - c_begin) * REC; pi0 = *(const GAS f32x4*)(rec + 4 * tid); pi1 = *(const GAS f32x4*)(rec + 4 * (tid + 512)); \
            pi2 = (tid < 352) ? *(const GAS f32x4*)(rec + 4 * (tid + 1024)) : (f32x4){0.f, 0.f, 0.f, 0.f}; \
            const GAS unsigned* ru = (const GAS unsigned*)(rec + 5504); pu0 = ru[(w * 2 + 0) * 64 + lane]; pu1 = ru[(w * 2 + 1) * 64 + lane]; pv = *(const GAS u32x2*)(rec + 6528 + 2 * tid); pbs = rec[7552 + hx * 16 + tl]; \
            pgate = *(const GAS u32x2*)(LO + (size_t)((cc) * TC + tl) * LORA_N + col4 + 2048); } while (0)
#define RM_IMG_OFF(i_) (O_IMG + ((i_) >= 688) * IMGSZ + ((((i_) - ((i_) >= 688) * 688) < 144) ? I_RT + 4 * ((i_) - ((i_) >= 688) * 688) : I_BTT + 4 * (((i_) - ((i_) >= 688) * 688) - 144)))
        RM_REC_LOAD(c_begin);
        for (int c = c_begin; c < c_end; ++c) {
            *(LAS f32x4*)(Lf + RM_IMG_OFF(tid)) = pi0; *(LAS f32x4*)(Lf + RM_IMG_OFF(tid + 512)) = pi1; if (tid < 352) *(LAS f32x4*)(Lf + RM_IMG_OFF(tid + 1024)) = pi2;
            const f32x4 vcur = {bf_lo(pv.x), bf_hi(pv.x), bf_lo(pv.y), bf_hi(pv.y)}; *(LAS f32x4*)(Lf + O_VV + hx * 1024 + tl * 64 + d4) = vcur;
            const f32x4 accU = {bf_lo(pu0), bf_hi(pu0), bf_lo(pu1), bf_hi(pu1)}; const float bscur = pbs; const u32x2 gcur = pgate;
            if (c + 1 < c_end) RM_REC_LOAD(c + 1);
            LBAR();
            const LAS float* VVc = Lf + O_VV + hh * 1024;
            u32x2 vlo; { vlo.x = hw_pk2(VVc[(4 * g + 0) * 64 + c0 + fr], VVc[(4 * g + 1) * 64 + c0 + fr]); vlo.y = hw_pk2(VVc[(4 * g + 2) * 64 + c0 + fr], VVc[(4 * g + 3) * 64 + c0 + fr]); }
            const bf16x8 vb = mk_frag(vlo, zz);
            RM_STATE_PART(vb);
            LBAR();
            RM_FLUSH(c, gcur, vcur, bscur);
            LBAR();
        }
#undef RM_REC_LOAD
#undef RM_IMG_OFF
    }
#undef RM_STATE_PART
#undef RM_FLUSH
#undef RM_LOAD
#undef RM_XFORM
}

__device__ __forceinline__ int med3i(int a, int b, int c) { int r; asm("v_med3_i32 %0, %1, %2, %3" : "=v"(r) : "v"(a), "v"(b), "v"(c)); return r; }
__device__ __forceinline__ int f2sort(float f) { int x = __float_as_int(f); return x ^ ((x >> 31) & 0x7fffffff); }
__device__ __forceinline__ float sort2f(int x) { return __int_as_float(x ^ ((x >> 31) & 0x7fffffff)); }
#define TOPK_INSERT(vals, x) do { _Pragma("unroll") for (int s_ = 15; s_ >= 1; --s_) vals[s_] = med3i((x), vals[s_ - 1], vals[s_]); vals[0] = max(vals[0], (x)); } while (0)
__device__ __forceinline__ float bf_dot2(unsigned a, unsigned b, float c) {
    return c + bf_lo(a) * bf_lo(b) + bf_hi(a) * bf_hi(b);
}
__device__ __forceinline__ void sum8_x8(float (&a)[8]) {
    asm("s_nop 1\n\t"
        "v_add_f32_dpp %0, %0, %0 quad_perm:[1,0,3,2] row_mask:0xf bank_mask:0xf\n\tv_add_f32_dpp %1, %1, %1 quad_perm:[1,0,3,2] row_mask:0xf bank_mask:0xf\n\t"
        "v_add_f32_dpp %2, %2, %2 quad_perm:[1,0,3,2] row_mask:0xf bank_mask:0xf\n\tv_add_f32_dpp %3, %3, %3 quad_perm:[1,0,3,2] row_mask:0xf bank_mask:0xf\n\t"
        "v_add_f32_dpp %4, %4, %4 quad_perm:[1,0,3,2] row_mask:0xf bank_mask:0xf\n\tv_add_f32_dpp %5, %5, %5 quad_perm:[1,0,3,2] row_mask:0xf bank_mask:0xf\n\t"
        "v_add_f32_dpp %6, %6, %6 quad_perm:[1,0,3,2] row_mask:0xf bank_mask:0xf\n\tv_add_f32_dpp %7, %7, %7 quad_perm:[1,0,3,2] row_mask:0xf bank_mask:0xf\n\t"
        "v_add_f32_dpp %0, %0, %0 quad_perm:[2,3,0,1] row_mask:0xf bank_mask:0xf\n\tv_add_f32_dpp %1, %1, %1 quad_perm:[2,3,0,1] row_mask:0xf bank_mask:0xf\n\t"
        "v_add_f32_dpp %2, %2, %2 quad_perm:[2,3,0,1] row_mask:0xf bank_mask:0xf\n\tv_add_f32_dpp %3, %3, %3 quad_perm:[2,3,0,1] row_mask:0xf bank_mask:0xf\n\t"
        "v_add_f32_dpp %4, %4, %4 quad_perm:[2,3,0,1] row_mask:0xf bank_mask:0xf\n\tv_add_f32_dpp %5, %5, %5 quad_perm:[2,3,0,1] row_mask:0xf bank_mask:0xf\n\t"
        "v_add_f32_dpp %6, %6, %6 quad_perm:[2,3,0,1] row_mask:0xf bank_mask:0xf\n\tv_add_f32_dpp %7, %7, %7 quad_perm:[2,3,0,1] row_mask:0xf bank_mask:0xf\n\t"
        "v_add_f32_dpp %0, %0, %0 row_half_mirror row_mask:0xf bank_mask:0xf\n\tv_add_f32_dpp %1, %1, %1 row_half_mirror row_mask:0xf bank_mask:0xf\n\t"
        "v_add_f32_dpp %2, %2, %2 row_half_mirror row_mask:0xf bank_mask:0xf\n\tv_add_f32_dpp %3, %3, %3 row_half_mirror row_mask:0xf bank_mask:0xf\n\t"
        "v_add_f32_dpp %4, %4, %4 row_half_mirror row_mask:0xf bank_mask:0xf\n\tv_add_f32_dpp %5, %5, %5 row_half_mirror row_mask:0xf bank_mask:0xf\n\t"
        "v_add_f32_dpp %6, %6, %6 row_half_mirror row_mask:0xf bank_mask:0xf\n\tv_add_f32_dpp %7, %7, %7 row_half_mirror row_mask:0xf bank_mask:0xf\n\t"
        "s_nop 1"
        : "+v"(a[0]), "+v"(a[1]), "+v"(a[2]), "+v"(a[3]), "+v"(a[4]), "+v"(a[5]), "+v"(a[6]), "+v"(a[7]));
}
__device__ __forceinline__ void sum8i_x8(int (&a)[8]) {
    asm("s_nop 1\n\t"
        "v_add_u32_dpp %0, %0, %0 quad_perm:[1,0,3,2] row_mask:0xf bank_mask:0xf\n\tv_add_u32_dpp %1, %1, %1 quad_perm:[1,0,3,2] row_mask:0xf bank_mask:0xf\n\t"
        "v_add_u32_dpp %2, %2, %2 quad_perm:[1,0,3,2] row_mask:0xf bank_mask:0xf\n\tv_add_u32_dpp %3, %3, %3 quad_perm:[1,0,3,2] row_mask:0xf bank_mask:0xf\n\t"
        "v_add_u32_dpp %4, %4, %4 quad_perm:[1,0,3,2] row_mask:0xf bank_mask:0xf\n\tv_add_u32_dpp %5, %5, %5 quad_perm:[1,0,3,2] row_mask:0xf bank_mask:0xf\n\t"
        "v_add_u32_dpp %6, %6, %6 quad_perm:[1,0,3,2] row_mask:0xf bank_mask:0xf\n\tv_add_u32_dpp %7, %7, %7 quad_perm:[1,0,3,2] row_mask:0xf bank_mask:0xf\n\t"
        "v_add_u32_dpp %0, %0, %0 quad_perm:[2,3,0,1] row_mask:0xf bank_mask:0xf\n\tv_add_u32_dpp %1, %1, %1 quad_perm:[2,3,0,1] row_mask:0xf bank_mask:0xf\n\t"
        "v_add_u32_dpp %2, %2, %2 quad_perm:[2,3,0,1] row_mask:0xf bank_mask:0xf\n\tv_add_u32_dpp %3, %3, %3 quad_perm:[2,3,0,1] row_mask:0xf bank_mask:0xf\n\t"
        "v_add_u32_dpp %4, %4, %4 quad_perm:[2,3,0,1] row_mask:0xf bank_mask:0xf\n\tv_add_u32_dpp %5, %5, %5 quad_perm:[2,3,0,1] row_mask:0xf bank_mask:0xf\n\t"
        "v_add_u32_dpp %6, %6, %6 quad_perm:[2,3,0,1] row_mask:0xf bank_mask:0xf\n\tv_add_u32_dpp %7, %7, %7 quad_perm:[2,3,0,1] row_mask:0xf bank_mask:0xf\n\t"
        "v_add_u32_dpp %0, %0, %0 row_half_mirror row_mask:0xf bank_mask:0xf\n\tv_add_u32_dpp %1, %1, %1 row_half_mirror row_mask:0xf bank_mask:0xf\n\t"
        "v_add_u32_dpp %2, %2, %2 row_half_mirror row_mask:0xf bank_mask:0xf\n\tv_add_u32_dpp %3, %3, %3 row_half_mirror row_mask:0xf bank_mask:0xf\n\t"
        "v_add_u32_dpp %4, %4, %4 row_half_mirror row_mask:0xf bank_mask:0xf\n\tv_add_u32_dpp %5, %5, %5 row_half_mirror row_mask:0xf bank_mask:0xf\n\t"
        "v_add_u32_dpp %6, %6, %6 row_half_mirror row_mask:0xf bank_mask:0xf\n\tv_add_u32_dpp %7, %7, %7 row_half_mirror row_mask:0xf bank_mask:0xf\n\t"
        "s_nop 1"
        : "+v"(a[0]), "+v"(a[1]), "+v"(a[2]), "+v"(a[3]), "+v"(a[4]), "+v"(a[5]), "+v"(a[6]), "+v"(a[7]));
}
__device__ __forceinline__ float max8_x1(float v) {
    asm("s_nop 1\n\tv_max_f32_dpp %0, %0, %0 quad_perm:[1,0,3,2] row_mask:0xf bank_mask:0xf\n\ts_nop 1\n\tv_max_f32_dpp %0, %0, %0 quad_perm:[2,3,0,1] row_mask:0xf bank_mask:0xf\n\ts_nop 1\n\t"
        "v_max_f32_dpp %0, %0, %0 row_half_mirror row_mask:0xf bank_mask:0xf\n\ts_nop 1" : "+v"(v));
    return v;
}
__device__ __forceinline__ float sum8_x1(float v) {
    asm("s_nop 1\n\tv_add_f32_dpp %0, %0, %0 quad_perm:[1,0,3,2] row_mask:0xf bank_mask:0xf\n\ts_nop 1\n\tv_add_f32_dpp %0, %0, %0 quad_perm:[2,3,0,1] row_mask:0xf bank_mask:0xf\n\ts_nop 1\n\t"
        "v_add_f32_dpp %0, %0, %0 row_half_mirror row_mask:0xf bank_mask:0xf\n\ts_nop 1" : "+v"(v));
    return v;
}
__device__ __forceinline__ void peer_phase(const Args& A, Frame& F, int L, const bool dry, const bf16* Hin, bf16* Hout, unsigned char* H8) {
    int lane = F.lane; asm volatile("" : "+v"(lane));
    const int gw = F.vcu * NWAVES + F.wave;
    const bf16* SCR = (const bf16*)(A.ws + WS_SC); const bf16* X = Hin; float* RS3 = (float*)(A.ws + WS_RS3);
    const unsigned char* TU = (const unsigned char*)(A.ws + WS_TABU) + (size_t)L * 16384 * D; const unsigned char* TV = (const unsigned char*)(A.ws + WS_TABV) + (size_t)L * 16384 * D;
    const float* SUL = (const float*)(A.ws + WS_SU) + (size_t)L * 16384; const float* SVL = SUL + 32768;
    const float* rowss = (const float*)(A.ws + WS_RSP) + (size_t)(L == 0 ? RS_FFN0 : RS_FFN1) * T * 32;
    LAS unsigned* LIST = (LAS unsigned*)(F.lds + RING_OFF + F.wave * 16384);
    LAS unsigned* EIDX = LIST + 1024;
    LAS float* ECOEF = (LAS float*)(EIDX + 1024);
    const int tbase = gw * 8;
    if (tbase >= T) return;
    for (int half = 0; half < 2; ++half) {
        const int t0 = tbase + 4 * half;
        {
            const bf16* sp = SCR + (size_t)(t0 + (lane >> 4)) * D + (lane & 15) * 128;
            int vals[16];
#pragma unroll
            for (int s = 0; s < 16; ++s) vals[s] = (int)0x80000000;
#pragma unroll 2
            for (int c = 0; c < 16; ++c) { const v4u wv = *(const GAS v4u*)(sp + c * 8); const unsigned ww[4] = {wv.x, wv.y, wv.z, wv.w};
#pragma unroll
                for (int e = 0; e < 8; ++e) { const unsigned bits = (e & 1) ? (ww[e >> 1] & 0xffff0000u) : (ww[e >> 1] << 16);
                    int x = (int)bits; x ^= (x >> 31) & 0x7fffffff; x = (x & ~0x7f) | (127 - (c * 8 + e));
                    TOPK_INSERT(vals, x); } }
#pragma unroll
            for (int q = 0; q < 4; ++q) { v4u o; o.x = (unsigned)vals[4 * q]; o.y = (unsigned)vals[4 * q + 1]; o.z = (unsigned)vals[4 * q + 2]; o.w = (unsigned)vals[4 * q + 3]; *(LAS v4u*)(LIST + lane * 16 + 4 * q) = o; }
        }
        LDS_WAIT(); asm volatile("" ::: "memory");
        if (lane < 32) {
            const LAS unsigned* la = LIST + ((lane >> 3) * 16 + (lane & 7) * 2) * 16; const LAS unsigned* lb2 = la + 16;
            float av[16], bv[16];
#pragma unroll
            for (int q = 0; q < 4; ++q) { const v4u a4 = *(const LAS v4u*)(la + 4 * q), b4 = *(const LAS v4u*)(lb2 + 4 * q); const unsigned aw[4] = {a4.x, a4.y, a4.z, a4.w}, bw[4] = {b4.x, b4.y, b4.z, b4.w};
#pragma unroll
                for (int e = 0; e < 4; ++e) { av[4 * q + e] = __uint_as_float(__float_as_uint(sort2f((int)(aw[e] & ~0x7fu))) & 0xffff0000u); bv[4 * q + e] = __uint_as_float(__float_as_uint(sort2f((int)(bw[e] & ~0x7fu))) & 0xffff0000u); } }
            int best[16];
#pragma unroll
            for (int s = 0; s < 16; ++s) best[s] = (int)0x80000000;
#pragma unroll
            for (int i = 0; i < 16; ++i)
#pragma unroll
                for (int jx = 0; jx < 16; ++jx) if ((i + 1) * (jx + 1) <= 16) { int x = f2sort(av[i] + bv[jx]); x = (x & ~0xff) | (255 - (i * 16 + jx)); TOPK_INSERT(best, x); }
            float sv[16]; unsigned ex[16];
#pragma unroll
            for (int s = 0; s < 16; ++s) { const int cand = 255 - (best[s] & 0xff); const unsigned ka = la[cand >> 4], kb = lb2[cand & 15];
                ex[s] = (127u - (ka & 0x7fu)) * 128u + (127u - (kb & 0x7fu));
                sv[s] = __uint_as_float(__float_as_uint(sort2f((int)(ka & ~0x7fu))) & 0xffff0000u) + __uint_as_float(__float_as_uint(sort2f((int)(kb & ~0x7fu))) & 0xffff0000u); }
            float mx = sv[0];
#pragma unroll
            for (int s = 1; s < 16; ++s) mx = fmaxf(mx, sv[s]);
            float den = 0.f;
#pragma unroll
            for (int s = 0; s < 16; ++s) { sv[s] = __expf(sv[s] - mx); den += sv[s]; }
            const float inv = 1.0f / den; const int base = (4 * half + (lane >> 3)) * 128 + (lane & 7) * 16;
#pragma unroll
            for (int s = 0; s < 16; ++s) { EIDX[base + s] = ex[s]; ECOEF[base + s] = sv[s] * inv; }
        }
        LDS_WAIT(); asm volatile("" ::: "memory");
    }
    const int tk = lane >> 3, part = lane & 7, t = tbase + tk;
    const LAS unsigned* eidx = EIDX + tk * 128; LAS float* ecoef = ECOEF + tk * 128;
    const float rs = __builtin_amdgcn_rsqf(sum8_x1(((const GAS f32x4*)(rowss + (size_t)t * 32))[part][0] + ((const GAS f32x4*)(rowss + (size_t)t * 32))[part][1] + ((const GAS f32x4*)(rowss + (size_t)t * 32))[part][2] + ((const GAS f32x4*)(rowss + (size_t)t * 32))[part][3]) * (1.0f / D) + EPS);
    typedef _Float16 h2_t __attribute__((ext_vector_type(2)));
#if PEER_ALIAS
    const unsigned amask = dry ? 1023u : 0xffffffffu;
#else
    constexpr unsigned amask = 0xffffffffu;
#endif
#define PEER_LOAD8(dst, TAB, i0, soff) do { const v4u ia_ = *(const LAS v4u*)(eidx + (i0)), ib_ = *(const LAS v4u*)(eidx + (i0) + 4); const unsigned ee_[8] = {ia_.x, ia_.y, ia_.z, ia_.w, ib_.x, ib_.y, ib_.z, ib_.w}; \
        _Pragma("unroll") for (int j_ = 0; j_ < 8; ++j_) dst[j_] = *(const GAS v4u*)((TAB) + (size_t)((ee_[j_] & amask) * 2048u + (unsigned)(soff))); } while (0)
    LAS float* dotw = (LAS float*)LIST + tk * 128;
#pragma unroll
    for (int m = 0; m < 16; ++m) dotw[8 * m + part] = 0.f;
#pragma unroll 1
    for (int p = 0; p < 16; ++p) {
        const int soff = 128 * p + 16 * part;
        unsigned xq[4]; float sxs;
        { const v4u x0 = *(const GAS v4u*)(X + (size_t)t * D + soff), x1 = *(const GAS v4u*)(X + (size_t)t * D + soff + 8); const unsigned xw[8] = {x0.x, x0.y, x0.z, x0.w, x1.x, x1.y, x1.z, x1.w};
          float xv[16], am = 0.f;
#pragma unroll
          for (int e = 0; e < 8; ++e) { xv[2 * e] = bf_lo(xw[e]); xv[2 * e + 1] = bf_hi(xw[e]); am = fmaxf(am, fmaxf(fabsf(xv[2 * e]), fabsf(xv[2 * e + 1]))); }
          am = max8_x1(am); sxs = am * (1.0f / 127.0f); const float inv = am > 0.f ? 127.0f / am : 0.f;
#pragma unroll
          for (int q = 0; q < 4; ++q) { unsigned w = 0;
#pragma unroll
              for (int e = 0; e < 4; ++e) w |= (__float_as_uint(__builtin_fmaf(xv[4 * q + e], inv, 12582912.0f)) & 255u) << (8 * e);
              xq[q] = w; } }
#define PEER_UDOT8(src, m_) do { int tt_[8]; \
        _Pragma("unroll") for (int j_ = 0; j_ < 8; ++j_) { int a_ = __builtin_amdgcn_sdot4((int)src[j_].x, (int)xq[0], 0, false); a_ = __builtin_amdgcn_sdot4((int)src[j_].y, (int)xq[1], a_, false); \
            a_ = __builtin_amdgcn_sdot4((int)src[j_].z, (int)xq[2], a_, false); tt_[j_] = __builtin_amdgcn_sdot4((int)src[j_].w, (int)xq[3], a_, false); } \
        sum8i_x8(tt_); \
        int sel_ = tt_[0]; _Pragma("unroll") for (int j_ = 1; j_ < 8; ++j_) sel_ = (part == j_) ? tt_[j_] : sel_; \
        dotw[8 * (m_) + part] += (float)sel_ * sxs; } while (0)
        v4u ua[8], ub[8];
        PEER_LOAD8(ua, TU, 0, soff);
#pragma unroll 1
        for (int m = 0; m < 16; m += 2) {
            PEER_LOAD8(ub, TU, 8 * (m + 1), soff);
            PEER_UDOT8(ua, m);
            if (m + 2 < 16) PEER_LOAD8(ua, TU, 8 * (m + 2), soff);
            PEER_UDOT8(ub, m + 1);
        }
    }
#undef PEER_UDOT8
    LAS unsigned char* ecq = (LAS unsigned char*)(LIST + 3072) + tk * 128;
    float sc;
    { float cf[16], cm = 0.f;
#pragma unroll
      for (int m = 0; m < 16; ++m) { const unsigned e_ = eidx[8 * m + part]; const float d_ = dotw[8 * m + part] * rs * SUL[e_]; const float act = 0.5f * d_ * (1.0f + erff(d_ * 0.7071067811865476f));
          cf[m] = ecoef[8 * m + part] * act * SVL[e_]; cm = fmaxf(cm, fabsf(cf[m])); }
      cm = max8_x1(cm); sc = cm * (1.0f / 127.0f); const float inv = cm > 0.f ? 127.0f / cm : 0.f;
#pragma unroll
      for (int m = 0; m < 16; ++m) ecq[8 * m + part] = (unsigned char)(__float_as_uint(__builtin_fmaf(cf[m], inv, 12582912.0f)) & 255u); }
    LDS_WAIT(); asm volatile("" ::: "memory");
    float ss = 0.f;
#pragma unroll 1
    for (int p = 0; p < 16; ++p) {
        const int soff = 128 * p + 16 * part;
        int acc[16];
#pragma unroll
        for (int i = 0; i < 16; ++i) acc[i] = 0;
#define PEER_VACC8(src, i0) do { const u32x2 c8_ = *(const LAS u32x2*)(ecq + (i0)); \
        _Pragma("unroll") for (int h_ = 0; h_ < 2; ++h_) { const int cq_ = (int)(h_ ? c8_.y : c8_.x); \
            _Pragma("unroll") for (int q_ = 0; q_ < 4; ++q_) { \
                const unsigned a_ = q_ == 0 ? src[4 * h_].x : q_ == 1 ? src[4 * h_].y : q_ == 2 ? src[4 * h_].z : src[4 * h_].w, b_ = q_ == 0 ? src[4 * h_ + 1].x : q_ == 1 ? src[4 * h_ + 1].y : q_ == 2 ? src[4 * h_ + 1].z : src[4 * h_ + 1].w; \
                const unsigned c_ = q_ == 0 ? src[4 * h_ + 2].x : q_ == 1 ? src[4 * h_ + 2].y : q_ == 2 ? src[4 * h_ + 2].z : src[4 * h_ + 2].w, d_ = q_ == 0 ? src[4 * h_ + 3].x : q_ == 1 ? src[4 * h_ + 3].y : q_ == 2 ? src[4 * h_ + 3].z : src[4 * h_ + 3].w; \
                const unsigned lab_ = __builtin_amdgcn_perm(b_, a_, 0x05010400u), hab_ = __builtin_amdgcn_perm(b_, a_, 0x07030602u), lcd_ = __builtin_amdgcn_perm(d_, c_, 0x05010400u), hcd_ = __builtin_amdgcn_perm(d_, c_, 0x07030602u); \
                acc[4 * q_ + 0] = __builtin_amdgcn_sdot4((int)__builtin_amdgcn_perm(lcd_, lab_, 0x05040100u), cq_, acc[4 * q_ + 0], false); \
                acc[4 * q_ + 1] = __builtin_amdgcn_sdot4((int)__builtin_amdgcn_perm(lcd_, lab_, 0x07060302u), cq_, acc[4 * q_ + 1], false); \
                acc[4 * q_ + 2] = __builtin_amdgcn_sdot4((int)__builtin_amdgcn_perm(hcd_, hab_, 0x05040100u), cq_, acc[4 * q_ + 2], false); \
                acc[4 * q_ + 3] = __builtin_amdgcn_sdot4((int)__builtin_amdgcn_perm(hcd_, hab_, 0x07060302u), cq_, acc[4 * q_ + 3], false); } } } while (0)
        v4u va[8], vb[8];
        PEER_LOAD8(va, TV, 0, soff);
#pragma unroll 1
        for (int m = 0; m < 16; m += 2) {
            PEER_LOAD8(vb, TV, 8 * (m + 1), soff);
            PEER_VACC8(va, 8 * m);
            if (m + 2 < 16) PEER_LOAD8(va, TV, 8 * (m + 2), soff);
            PEER_VACC8(vb, 8 * (m + 1));
        }
        { const v4u h0 = *(const GAS v4u*)(Hin + (size_t)t * D + soff), h1 = *(const GAS v4u*)(Hin + (size_t)t * D + soff + 8); const unsigned hw[8] = {h0.x, h0.y, h0.z, h0.w, h1.x, h1.y, h1.z, h1.w}; unsigned ow[8];
#pragma unroll
          for (int e = 0; e < 8; ++e) { ow[e] = hw_pk2(bf_lo(hw[e]) + (float)acc[2 * e] * sc, bf_hi(hw[e]) + (float)acc[2 * e + 1] * sc); const float q0 = bf_lo(ow[e]), q1 = bf_hi(ow[e]); ss += q0 * q0 + q1 * q1; }
          v4u o0, o1; o0.x = ow[0]; o0.y = ow[1]; o0.z = ow[2]; o0.w = ow[3]; o1.x = ow[4]; o1.y = ow[5]; o1.z = ow[6]; o1.w = ow[7];
          if (!dry) { *(GAS v4u*)(Hout + (size_t)t * D + soff) = o0; *(GAS v4u*)(Hout + (size_t)t * D + soff + 8) = o1;
            if (H8) { v4u o8; unsigned q8[4];
#pragma unroll
              for (int e = 0; e < 4; ++e) { int x8 = __builtin_amdgcn_cvt_pk_fp8_f32(bf_lo(ow[2 * e]), bf_hi(ow[2 * e]), 0, false); x8 = __builtin_amdgcn_cvt_pk_fp8_f32(bf_lo(ow[2 * e + 1]), bf_hi(ow[2 * e + 1]), x8, true); q8[e] = (unsigned)x8; }
              o8.x = q8[0]; o8.y = q8[1]; o8.z = q8[2]; o8.w = q8[3]; *(GAS v4u*)(H8 + (size_t)t * D + soff) = o8; } } else asm volatile("" :: "v"(o0.x), "v"(o0.y), "v"(o0.z), "v"(o0.w), "v"(o1.x), "v"(o1.y), "v"(o1.z), "v"(o1.w)); }
    }
#undef PEER_VACC8
#undef PEER_LOAD8
    const float r3 = __builtin_amdgcn_rsqf(sum8_x1(ss) * (1.0f / D) + EPS);
    if (!dry && part == 0) RS3[t] = r3;
}


constexpr int N_PHASES = 19;
__global__ void __launch_bounds__(NTHREADS, 2) mega_fwd(Args args) {

    extern __shared__ __attribute__((aligned(16))) unsigned char lds[];
    Frame F;
    F.lds = (LAS unsigned char*)lds;
    F.MISC = (volatile LAS unsigned*)(F.lds + MISC_OFF);
    F.tid = threadIdx.x; F.lane = F.tid & 63; F.wave = __builtin_amdgcn_readfirstlane(F.tid >> 6);
    F.G = gridDim.x; { const int bx = blockIdx.x; F.vcu = (F.G % 8 == 0) ? (bx % 8) * (F.G / 8) + bx / 8 : bx; }
    unsigned char* ws = args.ws;
    F.ctl = (gu32*)(ws + WS_CTL);
    for (int u = F.tid; u < (LDS_BYTES - LDSCTL_OFF) / 4; u += NTHREADS) ((LAS unsigned*)(F.lds + LDSCTL_OFF))[u] = 0u;
    __syncthreads();
    const int lo = args.ph_lo, hi = args.ph_hi;
    XcdBarrier bar; bar.bar = (unsigned*)(F.ctl + CW_BAR); bar.x = 0; bar.st = nullptr;
    if (hi - lo > 1) bar = xcd_barrier_post((unsigned*)(F.ctl + CW_BAR), F.MISC + 8);
    bar.wave0 = (F.wave == 0);
#define IN(k) (lo <= (k) && (k) < hi)
#define REFRESH() do { int t_; asm volatile("v_mbcnt_lo_u32_b32 %0, -1, 0\n\tv_mbcnt_hi_u32_b32 %0, -1, %0" : "=v"(t_)); F.lane = t_; F.tid = F.wave * 64 + t_; } while (0)
#define REPS(k) (1 + ((DUP_MASK >> (k)) & 1))
#if PROBE_MASK
    unsigned long long* const tsb = (unsigned long long*)(ws + WS_CTL + 65536);
#define STAMP(k) do { if (blockIdx.x == 0 && F.tid == 0) __hip_atomic_store(tsb + (k), __builtin_amdgcn_s_memrealtime(), __ATOMIC_RELAXED, __HIP_MEMORY_SCOPE_AGENT); } while (0)
    STAMP(31);
#else
#define STAMP(k) do { } while (0)
#endif
#define DEFERRED_QUEUE(fn, ctrword) do { constexpr unsigned NQ_ = 768u; for (;;) { if (F.tid == 0) F.MISC[0] = __hip_atomic_fetch_add(F.ctl + (ctrword), 1u, __ATOMIC_RELAXED, __HIP_MEMORY_SCOPE_AGENT); \
        __syncthreads(); const unsigned v_ = F.MISC[0]; __syncthreads(); if (v_ >= NQ_) break; fn(args, F, (int)v_, (int)NQ_); } } while (0)
#define SEAM(k) do { if (IN(k) && IN((k) + 1)) { if ((k) == 0) { cg::this_grid().sync(); } else { xcd_barrier(bar); if ((DUP_MASK >> 24) & 1) xcd_barrier(bar); } STAMP(k); } } while (0)
    float* rowss = (float*)(ws + WS_RSP);
    bf16* ACTA = (bf16*)(ws + WS_ACTA); bf16* ACTB = (bf16*)(ws + WS_ACTB); bf16* H1 = (bf16*)(ws + WS_H1); const float* RS3 = (const float*)(ws + WS_RS3);
    bf16* PROJ = (bf16*)(ws + WS_PROJ); bf16* SCB = (bf16*)(ws + WS_SC); bf16* PP = (bf16*)(ws + WS_PP);
    const int gtid = (F.vcu * NWAVES + F.wave) * 64 + F.lane, gthreads = F.G * NTHREADS;

#if UBENCH
    {
        typedef _Float16 h2_t __attribute__((ext_vector_type(2)));
        float a[32]; f32x2 p[16]; h2_t hh[32];
#pragma unroll
        for (int i = 0; i < 32; ++i) { a[i] = (float)(F.tid + i); hh[i] = (h2_t){(_Float16)(F.lane + i), (_Float16)i}; }
#pragma unroll
        for (int i = 0; i < 16; ++i) p[i] = (f32x2){a[2 * i], a[2 * i + 1]};
        const float m = 1.0f + 1e-7f * F.lane, c = 1e-9f; const f32x2 m2 = {m, m}, c2 = {c, c}; const h2_t mh = {(_Float16)1.0f, (_Float16)1.0f}, ch = {(_Float16)0.0f, (_Float16)0.0f};
#pragma unroll 1
        for (int it = 0; it < 10000; ++it) {
#if UBENCH == 1
#pragma unroll
            for (int i = 0; i < 32; ++i) asm volatile("v_fma_f32 %0, %0, %1, %2" : "+v"(a[i]) : "v"(m), "v"(c));
#elif UBENCH == 2
#pragma unroll
            for (int i = 0; i < 16; ++i) asm volatile("v_pk_fma_f32 %0, %0, %1, %2\n\tv_pk_fma_f32 %0, %0, %1, %2" : "+v"(p[i]) : "v"(m2), "v"(c2));
#elif UBENCH == 3
#pragma unroll
            for (int i = 0; i < 32; ++i) asm volatile("v_pk_fma_f16 %0, %0, %1, %2" : "+v"(hh[i]) : "v"(mh), "v"(ch));
#endif
        }
        float s = 0.f;
#pragma unroll
        for (int i = 0; i < 32; ++i) s += a[i] + (float)hh[i][0];
#pragma unroll
        for (int i = 0; i < 16; ++i) s += p[i][0] + p[i][1];
        if (s == 12345.678f) args.out[0] = s;
    }
#endif
    if (IN(0)) { REFRESH(); p0_prologue(args, F, 0); if (hi - lo > 1) { xcd_barrier(bar); REFRESH(); p0_prologue(args, F, 1); } } SEAM(0);
    if (IN(1)) for (int rep_ = 0; rep_ < REPS(1); ++rep_) { REFRESH();
#if EV_F8_T1 > EV_F8_T0
        if (EV_F8_T0 > 0) { constexpr int n_ = EV_F8_T0 * 256; pg8::Gemm g{ACTA, (const bf16*)(ws + WS_WEV_IN), T, n_, D}; pg8::StaticOrder S; S.init(T, n_, F.G, (int)blockIdx.x); EpiBf16S E{PROJ, PROJ_LD, nullptr};
          pg8::gemm_phase<EpiBf16S, pg8::StaticOrder, true, true>(F.lds + RING_OFF, g, S, E, F.wave); }
        { constexpr int n_ = (EV_F8_T1 - EV_F8_T0) * 256; pg8::Gemm g{(const bf16*)(ws + WS_H1), (const bf16*)(ws + WS_O + (size_t)EV_F8_T0 * 256 * D), T, n_, D / 2}; pg8::StaticOrder S; S.init(T, n_, F.G, (int)blockIdx.x); EpiBf16S E{PROJ + EV_F8_T0 * 256, PROJ_LD, nullptr};
          pg8::gemm_phase<EpiBf16S, pg8::StaticOrder, true, true, true>(F.lds + RING_OFF, g, S, E, F.wave); }
        if (EV_F8_T1 < EV_NP / 256) { constexpr int n_ = EV_NP - EV_F8_T1 * 256; pg8::Gemm g{ACTA, (const bf16*)(ws + WS_WEV_IN) + (size_t)EV_F8_T1 * 256 * D, T, n_, D}; pg8::StaticOrder S; S.init(T, n_, F.G, (int)blockIdx.x); EpiBf16S E{PROJ + EV_F8_T1 * 256, PROJ_LD, nullptr};
          pg8::gemm_phase<EpiBf16S, pg8::StaticOrder, true, true>(F.lds + RING_OFF, g, S, E, F.wave); }
        if (true) { const int g2 = F.G, c2 = (int)blockIdx.x;
#else
        { pg8::Gemm g{ACTA, (const bf16*)(ws + WS_WEV_IN), T, EV_NP, D / 2}; pg8::StaticOrder S; S.init(T, EV_NP, F.G, (int)blockIdx.x); EpiI8S E{PROJ, PROJ_LD, (const float*)(ws + WS_SA), (const float*)(ws + WS_CMB)};
          pg8::gemm_phase<EpiI8S, pg8::StaticOrder, true, true, false, true>(F.lds + RING_OFF, g, S, E, F.wave); }
        if (F.G < 256) { const int g2 = F.G, c2 = (int)blockIdx.x;
#endif
          pg8::Gemm g{(const bf16*)(ws + WS_PBF), (const bf16*)(ws + WS_WPROJ), T, D, 256}; pg8::StaticOrder S; S.init(T, D, g2, c2); EpiBf16S E{PP, D, nullptr};
          pg8::gemm_phase<EpiBf16S, pg8::StaticOrder, true, true>(F.lds + RING_OFF, g, S, E, F.wave); }
    } SEAM(1);
    if (IN(2)) for (int rep_ = 0; rep_ < REPS(2); ++rep_) { REFRESH();
        if (F.G >= 256) {
            const int u = F.vcu;
            if (u < 64) scan_gla_mfma_unit<0>(args, F, u); else if (u < 128) scan_gdn_mfma_unit(args, F, u - 64, 0); else if (u < 192) scan_gdn_mfma_unit(args, F, u - 128, 1);
            __syncthreads();
            if (rep_ == 0 && u >= 64 && u < 128) {
                const int c = u - 64; bf16* pb = (bf16*)(ws + WS_PBF);
                cvt_f32_bf16(args.in[I_P] + (size_t)c * 65536, pb + (size_t)c * 65536, 65536, F.tid, NTHREADS);
                asm volatile("s_waitcnt vmcnt(0)" ::: "memory"); __syncthreads();
                pg8::Gemm g{pb, (const bf16*)(ws + WS_WPROJ), T, D, 256}; pg8::RowBlockOrder S{c, D / 256}; EpiBf16S E{PP, D, nullptr};
                pg8::gemm_phase<EpiBf16S, pg8::RowBlockOrder, true, true>(F.lds + RING_OFF, g, S, E, F.wave); }
            if (rep_ == 0) DEFERRED_QUEUE(p0_deferred, 1024);
        } else {
            for (int u = F.vcu; u < 64; u += F.G) { scan_gla_mfma_unit<0>(args, F, u); __syncthreads(); }
            for (int u = F.vcu; u < 64; u += F.G) { scan_gdn_mfma_unit(args, F, u, 0); __syncthreads(); scan_gdn_mfma_unit(args, F, u, 1); __syncthreads(); }
            if (rep_ == 0) p0_deferred(args, F, F.vcu, F.G);
        }
    } SEAM(2);
    if (IN(3)) for (int rep_ = 0; rep_ < REPS(3); ++rep_) { REFRESH(); post_rows<0>(args, F); } SEAM(3);
    if (IN(4)) { REFRESH(); pg8::Gemm g{ACTA, (const bf16*)(ws + WS_WEV_OUT), T, D, D}; pg8::StaticOrder S; S.init(T, D, F.G, (int)blockIdx.x);
        EpiResid<false, true> E{args.in[I_X], ACTB, rowss + (size_t)RS_FFN0 * T * 32, nullptr, nullptr, nullptr, nullptr, nullptr};
        pg8::gemm_phase<EpiResid<false, true>, pg8::StaticOrder, true, true>(F.lds + RING_OFF, g, S, E, F.wave); }
#if (DUP_MASK >> 20) & 1
    if (IN(4)) { REFRESH(); pg8::Gemm g{ACTA, (const bf16*)(ws + WS_WEV_OUT), T, D, D}; pg8::StaticOrder S; S.init(T, D, F.G, (int)blockIdx.x);
        EpiResid<false, true> E{args.in[I_X], ACTB, rowss + (size_t)RS_FFN0 * T * 32, nullptr, nullptr, nullptr};
        pg8::gemm_phase<EpiResid<false, true>, pg8::StaticOrder, true, true>(F.lds + RING_OFF, g, S, E, F.wave); }
#endif
#if (DUP_MASK >> 21) & 1
    if (IN(4)) { REFRESH(); pg8::Gemm g{ACTA, (const bf16*)(ws + WS_WEV_IN), T, EV_NP, D}; pg8::StaticOrder S; S.init(T, EV_NP, F.G, (int)blockIdx.x); EpiBf16S E{PROJ, PROJ_LD, nullptr};
        pg8::gemm_phase<EpiBf16S, pg8::StaticOrder, true, true>(F.lds + RING_OFF, g, S, E, F.wave); }
#endif
    SEAM(4);
    if (IN(5)) for (int rep_ = 0; rep_ < REPS(5); ++rep_) { REFRESH(); { pg8::Gemm g{ACTB, (const bf16*)(ws + WS_WPEER), T, D, D}; pg8::StaticOrder S; S.init(T, D, F.G, (int)blockIdx.x); EpiBf16S E{SCB, D, rowss + (size_t)RS_FFN0 * T * 32};
        pg8::gemm_phase<EpiBf16S, pg8::StaticOrder, true, true>(F.lds + RING_OFF, g, S, E, F.wave); }
        } SEAM(5);
    if (IN(6)) for (int rep_ = 0; rep_ < REPS(6); ++rep_) { REFRESH(); peer_phase(args, F, 0, rep_ != 0, ACTB, H1, (unsigned char*)ACTA); } SEAM(6);
    if (IN(7)) { REFRESH(); { pg8::Gemm g{ACTA, (const bf16*)(ws + WS_WGATE), T, D, D / 2}; pg8::StaticOrder S; S.init(T, D, F.G, (int)blockIdx.x);
        EpiResid<true, false> E{H1, ACTB, rowss + (size_t)RS_MIX1 * T * 32, PP, RS3, (unsigned char*)ACTA + (size_t)T * D};
        pg8::gemm_phase<EpiResid<true, false>, pg8::StaticOrder, true, true, true>(F.lds + RING_OFF, g, S, E, F.wave); }
        } SEAM(7);
    if (IN(8)) for (int rep_ = 0; rep_ < REPS(8); ++rep_) { REFRESH();
        { pg8::Gemm g{(const bf16*)((const unsigned char*)ACTA + (size_t)T * D), (const bf16*)(ws + WS_WOD_IN), T, OD_NP, D / 2}; pg8::StaticOrder S; S.init(T, OD_NP, F.G, (int)blockIdx.x); EpiBf16S E{PROJ, PROJ_LD, rowss + (size_t)RS_MIX1 * T * 32};
          pg8::gemm_phase<EpiBf16S, pg8::StaticOrder, true, true, true>(F.lds + RING_OFF, g, S, E, F.wave); }
        if (F.G < 256) { pg8::Gemm g{(const bf16*)(ws + WS_PBF) + (size_t)T * 256, (const bf16*)(ws + WS_WPROJ) + (size_t)D * 256, T, D, 256}; pg8::StaticOrder S; S.init(T, D, F.G, (int)blockIdx.x); EpiBf16S E{PP, D, nullptr};
          pg8::gemm_phase<EpiBf16S, pg8::StaticOrder, true, true>(F.lds + RING_OFF, g, S, E, F.wave); }
    } SEAM(8);
    if (IN(9)) for (int rep_ = 0; rep_ < REPS(9); ++rep_) { REFRESH(); lora_prep_rows(args, F); } SEAM(9);
    if (IN(10)) for (int rep_ = 0; rep_ < REPS(10); ++rep_) { REFRESH();
        { pg8::Gemm g{(const bf16*)(ws + WS_LA), (const bf16*)(ws + WS_WLORA), T, 1024, LORA_K, 128}; pg8::StaticOrder S; S.init(T, 1024, F.G, (int)blockIdx.x); EpiBf16S E{(bf16*)(ws + WS_LO), LORA_N, nullptr};
          pg8::gemm_phase<EpiBf16S, pg8::StaticOrder, true, true>(F.lds + RING_OFF, g, S, E, F.wave); }
        { pg8::Gemm g{(const bf16*)(ws + WS_LA) + 64, (const bf16*)(ws + WS_WLORA) + (size_t)1024 * LORA_K + 64, T, 1024, LORA_K, 128}; pg8::StaticOrder S; S.init(T, 1024, F.G, (int)blockIdx.x); EpiBf16S E{(bf16*)(ws + WS_LO) + 1024, LORA_N, nullptr};
          pg8::gemm_phase<EpiBf16S, pg8::StaticOrder, true, true>(F.lds + RING_OFF, g, S, E, F.wave); }
        { pg8::Gemm g{(const bf16*)(ws + WS_LA) + 192, (const bf16*)(ws + WS_WLORA) + (size_t)2048 * LORA_K + 192, T, 1024, LORA_K, 256}; pg8::StaticOrder S; S.init(T, 1024, F.G, (int)blockIdx.x); EpiBf16S E{(bf16*)(ws + WS_LO) + 2048, LORA_N, nullptr};
          pg8::gemm_phase<EpiBf16S, pg8::StaticOrder, true, true>(F.lds + RING_OFF, g, S, E, F.wave); }
    } SEAM(10);
    if (IN(11)) for (int rep_ = 0; rep_ < REPS(11); ++rep_) { REFRESH();
        if (F.G >= 256) {
            const int u = F.vcu;
            if (u < 64) scan_gla_mfma_unit<1>(args, F, u); else if (u < 128) scan_rwkv_mfma_unit(args, F, u - 64, 0); else if (u < 192) scan_rwkv_mfma_unit(args, F, u - 128, 1);
            __syncthreads();
            if (rep_ == 0 && u >= 64 && u < 128) {
                const int c = u - 64; bf16* pb = (bf16*)(ws + WS_PBF) + (size_t)T * 256;
                cvt_f32_bf16(args.in[I_P] + (size_t)T * 256 + (size_t)c * 65536, pb + (size_t)c * 65536, 65536, F.tid, NTHREADS);
                asm volatile("s_waitcnt vmcnt(0)" ::: "memory"); __syncthreads();
                pg8::Gemm g{pb, (const bf16*)(ws + WS_WPROJ) + (size_t)D * 256, T, D, 256}; pg8::RowBlockOrder S{c, D / 256}; EpiBf16S E{PP, D, nullptr};
                pg8::gemm_phase<EpiBf16S, pg8::RowBlockOrder, true, true>(F.lds + RING_OFF, g, S, E, F.wave); }
            if (rep_ == 0) DEFERRED_QUEUE(p1_deferred, 1025);
        } else {
            for (int u = F.vcu; u < 64; u += F.G) { scan_gla_mfma_unit<1>(args, F, u); __syncthreads(); }
            for (int u = F.vcu; u < 64; u += F.G) { scan_rwkv_mfma_unit(args, F, u, 0); __syncthreads(); scan_rwkv_mfma_unit(args, F, u, 1); __syncthreads(); }
            if (rep_ == 0) p1_deferred(args, F, F.vcu, F.G);
        }
    } SEAM(11);
    if (IN(12)) for (int rep_ = 0; rep_ < REPS(12); ++rep_) { REFRESH(); post_rows<1>(args, F); } SEAM(12);
    if (IN(13)) { REFRESH(); pg8::Gemm g{ACTA, (const bf16*)(ws + WS_WOD_OUT), T, D, D / 2}; pg8::StaticOrder S; S.init(T, D, F.G, (int)blockIdx.x);
        EpiResid<false, false> E{ACTB, H1, rowss + (size_t)RS_FFN1 * T * 32, nullptr, nullptr, nullptr};
        pg8::gemm_phase<EpiResid<false, false>, pg8::StaticOrder, true, true, true>(F.lds + RING_OFF, g, S, E, F.wave); } SEAM(13);
    if (IN(14)) for (int rep_ = 0; rep_ < REPS(14); ++rep_) { REFRESH(); pg8::Gemm g{H1, (const bf16*)(ws + WS_WPEER) + (size_t)D * D, T, D, D}; pg8::StaticOrder S; S.init(T, D, F.G, (int)blockIdx.x); EpiBf16S E{SCB, D, rowss + (size_t)RS_FFN1 * T * 32};
        pg8::gemm_phase<EpiBf16S, pg8::StaticOrder, true, true>(F.lds + RING_OFF, g, S, E, F.wave); } SEAM(14);
    if (IN(15)) for (int rep_ = 0; rep_ < REPS(15); ++rep_) { REFRESH(); peer_phase(args, F, 1, rep_ != 0, H1, ACTB, (unsigned char*)ACTA); } SEAM(15);
    if (IN(16)) { REFRESH(); pg8::Gemm g{ACTA, (const bf16*)(ws + WS_WGATE) + (size_t)D * D, T, D, D / 2}; pg8::StaticOrder S; S.init(T, D, F.G, (int)blockIdx.x);
        EpiResid<true, false> E{ACTB, H1, rowss + (size_t)RS_FINAL * T * 32, PP, RS3, nullptr};
        pg8::gemm_phase<EpiResid<true, false>, pg8::StaticOrder, true, true, true>(F.lds + RING_OFF, g, S, E, F.wave); } SEAM(16);
    if (IN(17)) { REFRESH();
        float oscale = 1.0f;
#if PROBE_MASK
        { unsigned long long t_prev = __hip_atomic_load(tsb + 31, __ATOMIC_RELAXED, __HIP_MEMORY_SCOPE_AGENT); const unsigned long long t_begin = t_prev; unsigned long long sel = 0ull;
          for (int k = 0; k <= 16; ++k) { const unsigned long long tk = __hip_atomic_load(tsb + k, __ATOMIC_RELAXED, __HIP_MEMORY_SCOPE_AGENT); if ((PROBE_MASK >> k) & 1) sel += tk - t_prev; t_prev = tk; }
          const float f = (float)(double(sel) / double(t_prev - t_begin)); oscale = 1.0f + sqrtf(0.01f + 0.9f * f); }
#endif
        final_rows(args, F, oscale, H1); }
#undef IN
#undef SEAM
#undef REFRESH
}

extern "C" void kernel_launch(void* const* d_in, const int* in_sizes, int n_in, void* d_out, int out_size, void* d_ws, size_t ws_size, hipStream_t stream) {
    static int grid = 0;
    if (grid == 0) {
        if (n_in != N_IN || out_size != T * D || ws_size < WS_END + 63 * MiB) { fprintf(stderr, "kernel_launch: unexpected problem: n_in %d out %d ws %zu (need %zu)\n", n_in, out_size, ws_size, (size_t)(WS_END + 63 * MiB)); grid = -1; return; }
        int dev = 0, cus = 0, per_cu = 0;
        if (hipGetDevice(&dev) != hipSuccess || hipDeviceGetAttribute(&cus, hipDeviceAttributeMultiprocessorCount, dev) != hipSuccess) { grid = -1; return; }
        if (hipFuncSetAttribute((const void*)mega_fwd, hipFuncAttributeMaxDynamicSharedMemorySize, LDS_BYTES) != hipSuccess) { fprintf(stderr, "kernel_launch: hipFuncSetAttribute failed\n"); grid = -1; return; }
        if (hipOccupancyMaxActiveBlocksPerMultiprocessor(&per_cu, (const void*)mega_fwd, NTHREADS, LDS_BYTES) != hipSuccess || per_cu < 1) { fprintf(stderr, "kernel_launch: occupancy query says %d blocks per CU\n", per_cu); (void)hipGetLastError(); grid = -1; return; }
        grid = cus;
    }
    if (grid < 0) return;
    (void)hipMemsetAsync((char*)d_ws + WS_CTL, 0, CTL_ZERO_BYTES, stream);
    Args a{};
    for (int i = 0; i < N_IN; ++i) a.in[i] = (const float*)d_in[i];
    a.out = (float*)d_out; a.ws = (unsigned char*)d_ws;
#if MK_PER_PHASE
    for (int p = 0; p < N_PHASES - 1; ++p) { a.ph_lo = p; a.ph_hi = p + 1; hipLaunchKernelGGL(mega_fwd, dim3(grid), dim3(NTHREADS), LDS_BYTES, stream, a); }
#else
    a.ph_lo = 0; a.ph_hi = N_PHASES;
    void* kargs[] = {&a};
    hipError_t e = hipLaunchCooperativeKernel((const void*)mega_fwd, dim3(grid), dim3(NTHREADS), kargs, LDS_BYTES, stream);
    if (e != hipSuccess) fprintf(stderr, "kernel_launch: cooperative launch failed: %s (grid %d)\n", hipGetErrorString(e), grid);
#endif
}
```

```cpp
#include <hip/hip_runtime.h>
#include <hip/hip_cooperative_groups.h>
#include <cstdio>
#include <cstdint>
namespace cg = cooperative_groups;

#ifndef PROBE_MASK
#define PROBE_MASK 0
#endif
#ifndef DUP_MASK
#define DUP_MASK 0
#endif
#ifndef UBENCH
#define UBENCH 0
#endif
#ifndef GDN_DUP
#define GDN_DUP 0
#endif
#ifndef MK_PER_PHASE
#ifndef PEER_ALIAS
#define PEER_ALIAS 0
#endif
#ifndef EV_F8_T0
#define EV_F8_T0 0
#define EV_F8_T1 0
#endif
#define MK_PER_PHASE 0
#endif

namespace pg8 {
#define PG8_LAS __attribute__((address_space(3)))
typedef unsigned short bf16_t;
typedef short bf16x8 __attribute__((ext_vector_type(8)));
typedef float f32x4 __attribute__((ext_vector_type(4)));
typedef unsigned u32x4 __attribute__((ext_vector_type(4)));
typedef unsigned u32x2 __attribute__((ext_vector_type(2)));
constexpr int BM = 256, BK = 64, HALF = 128, HTB = HALF * BK * 2  , STAGE_BYTES = 8 * HTB, NXCD = 8, WGM = 8;

__host__ __device__ __forceinline__ int lds_byte(int r, int c) { const int st = (r >> 4) * 2 + (c >> 5), rr = r & 15, cc = c & 31, ob = rr * 64 + cc * 2; return st * 1024 + (ob ^ (((ob >> 9) & 1) << 5)); }
__host__ __device__ __forceinline__ void stage_rc(int b, int& R, int& C) { const int st = b / 1024, sb = b % 1024, swz = sb ^ (((sb >> 9) & 1) << 5); R = (st >> 1) * 16 + swz / 64; C = (st & 1) * 32 + (swz % 64) / 2; }
__host__ __device__ __forceinline__ int perm32(int rho) { const int n = rho >> 4, i = rho & 15; return 8 * (i >> 2) + 4 * n + (i & 3); }

struct Unit { int pm, pn; };
struct Gemm { const bf16_t* A; const bf16_t* Bt; int M, N, K; int KE = 0; };

struct StaticOrder {
    int nM, nN, nwg, G, c;
    __host__ __device__ void init(int M, int N, int G_, int c_) { nM = M / BM; nN = N / BM; nwg = nM * nN; G = G_; c = c_; }
    __host__ __device__ bool next(int i, Unit& u) const {
        const long L = (long)i * G + c; if (L >= nwg) return false;
        int wgid = (int)L; { const int q = nwg / NXCD, r = nwg % NXCD, xcd = wgid % NXCD, off = wgid / NXCD; wgid = (xcd < r ? xcd * (q + 1) : r * (q + 1) + (xcd - r) * q) + off; }
        const int nig = WGM * nN, gid = wgid / nig, fm = gid * WGM, gsz = (nM - fm) < WGM ? (nM - fm) : WGM;
        u.pm = fm + ((wgid % nig) % gsz); u.pn = (wgid % nig) / gsz; return true;
    }
    __device__ __forceinline__ void a_ready(const Unit&) const {}
    __device__ __forceinline__ void done(const Unit&) const {}
};
struct RowBlockOrder {
    int c, nN;
    __host__ __device__ bool next(int i, Unit& u) const { if (i >= nN) return false; u.pm = c; u.pn = i; return true; }
    __device__ __forceinline__ void a_ready(const Unit&) const {}
    __device__ __forceinline__ void done(const Unit&) const {}
};
__device__ __forceinline__ unsigned cvt_pk_bf16(float lo, float hi) { unsigned r; asm volatile("v_cvt_pk_bf16_f32 %0, %1, %2" : "=v"(r) : "v"(lo), "v"(hi)); return r; }
template <class Epi, class Sched, bool ALIGN_EPI = false, bool SP2 = false, bool F8 = false, bool I8 = false>
__device__ __forceinline__ void gemm_phase(PG8_LAS unsigned char* lds, const Gemm g, const Sched& S, const Epi& E, const int wave_id) {
    int tid; asm volatile("v_mbcnt_lo_u32_b32 %0, -1, 0\n\tv_mbcnt_hi_u32_b32 %0, -1, %0" : "=v"(tid)); tid += wave_id * 64;
    const int wid = wave_id, lane = tid & 63, wr = wid >> 2, wc = wid & 3, fr = lane & 15, fq = lane >> 4;
    const int K = g.K, nt = (g.KE ? g.KE : K) / BK;
    unsigned voffA[2], voffB[2];
#pragma unroll
    for (int i = 0; i < 2; ++i) { int R, C; stage_rc(tid * 16 + i * 8192, R, C); const int Rb = Epi::PERM ? ((R & ~31) + perm32(R & 31)) : R;
        voffA[i] = (unsigned)(R * K + C) * 2u; voffB[i] = (unsigned)(Rb * K + C) * 2u; }
    const __amdgpu_buffer_rsrc_t rsrcA = __builtin_amdgcn_make_buffer_rsrc((void*)g.A, 0, 0x7fffffff, 0x00020000), rsrcB = __builtin_amdgcn_make_buffer_rsrc((void*)g.Bt, 0, 0x7fffffff, 0x00020000);
    const size_t kstep = (size_t)(BK * 2);
    const size_t hstep = (size_t)HALF * K * 2;
    const size_t tstep = 2 * hstep;
    const unsigned ldsw = (unsigned)wid * 1024u;
    const int aoff = lds_byte(wr * 64 + fr, fq * 8), boff = lds_byte(wc * 32 + fr, fq * 8);
#define PG8_SA(b, h) (((b) * 2 + (h)) * HTB)
#define PG8_SB(b, h) ((4 + (b) * 2 + (h)) * HTB)
#define PG8_STAGE(bufoff, gbase, voff) do { const bool isA_ = (+(voff) == +voffA); const unsigned soff_ = (unsigned)((const char*)(gbase) - (isA_ ? (const char*)g.A : (const char*)g.Bt)); _Pragma("unroll") for (int _i = 0; _i < 2; ++_i) \
        __builtin_amdgcn_raw_ptr_buffer_load_lds(isA_ ? rsrcA : rsrcB, (PG8_LAS unsigned*)(lds + (bufoff) + ldsw + _i * 8192), 16, (int)(voff)[_i], (int)soff_, 0, 0); } while (0)
#define PG8_LDA(dst, b, h) do { _Pragma("unroll") for (int m = 0; m < 4; ++m) { if constexpr (F8) { dst##8[m].lo = *(const PG8_LAS bf16x8*)(lds + PG8_SA(b, h) + aoff + m * 2048); dst##8[m].hi = *(const PG8_LAS bf16x8*)(lds + PG8_SA(b, h) + aoff + m * 2048 + 1024); } else { _Pragma("unroll") for (int k = 0; k < 2; ++k) dst[m][k] = *(const PG8_LAS bf16x8*)(lds + PG8_SA(b, h) + aoff + m * 2048 + k * 1024); } } } while (0)
#define PG8_LDB(dst, b, h) do { _Pragma("unroll") for (int n = 0; n < 2; ++n) { if constexpr (F8) { dst##8[n].lo = *(const PG8_LAS bf16x8*)(lds + PG8_SB(b, h) + boff + n * 2048); dst##8[n].hi = *(const PG8_LAS bf16x8*)(lds + PG8_SB(b, h) + boff + n * 2048 + 1024); } else { _Pragma("unroll") for (int k = 0; k < 2; ++k) dst[n][k] = *(const PG8_LAS bf16x8*)(lds + PG8_SB(b, h) + boff + n * 2048 + k * 1024); } } } while (0)
#define PG8_MMA(ai, bj, At, Bt) do { __builtin_amdgcn_s_setprio(1); _Pragma("unroll") for (int m = 0; m < 4; ++m) _Pragma("unroll") for (int n = 0; n < 2; ++n) { \
        if constexpr (F8) { typedef int v8i_ __attribute__((ext_vector_type(8))); \
            acc[ai][bj][m][n] = __builtin_amdgcn_mfma_scale_f32_16x16x128_f8f6f4(__builtin_bit_cast(v8i_, Bt##8[n]), __builtin_bit_cast(v8i_, At##8[m]), acc[ai][bj][m][n], 0, 0, 0, 0x7f79, 1, 0x7f79); }     \
        else if constexpr (I8) { typedef int v4i_ __attribute__((ext_vector_type(4))); \
            _Pragma("unroll") for (int k = 0; k < 2; ++k) acc[ai][bj][m][n] = __builtin_bit_cast(f32x4, __builtin_amdgcn_mfma_i32_16x16x64_i8(__builtin_bit_cast(v4i_, Bt[n][k]), __builtin_bit_cast(v4i_, At[m][k]), __builtin_bit_cast(v4i_, acc[ai][bj][m][n]), 0, 0, 0)); } \
        else { _Pragma("unroll") for (int k = 0; k < 2; ++k) acc[ai][bj][m][n] = __builtin_amdgcn_mfma_f32_16x16x32_bf16(Bt[n][k], At[m][k], acc[ai][bj][m][n], 0, 0, 0); } } \
        __builtin_amdgcn_s_setprio(0); } while (0)
#define PG8_WAIT_V(n) asm volatile("s_waitcnt vmcnt(" #n ")" ::: "memory")
#define PG8_WAIT_L(n) asm volatile("s_waitcnt lgkmcnt(" #n ")" ::: "memory")
#define PG8_BAR __builtin_amdgcn_s_barrier()
#define PG8_SCHED __builtin_amdgcn_sched_barrier(0)
    Unit cur, nxt; int ui = 0;
    if (!S.next(0, cur)) return;
    f32x4 acc[2][2][4][2];
#pragma unroll
    for (int a = 0; a < 2; ++a)
#pragma unroll
        for (int b = 0; b < 2; ++b)
#pragma unroll
            for (int m = 0; m < 4; ++m)
#pragma unroll
                for (int n = 0; n < 2; ++n) acc[a][b][m][n] = (f32x4){0.f, 0.f, 0.f, 0.f};
    typedef short bf16x16 __attribute__((ext_vector_type(16)));
    bf16x16 At8[4], B08[2], B18[2]; bf16x8 At[4][2], B0[2][2], B1[2][2];
    const char* cA = (const char*)g.A + (size_t)cur.pm * tstep; const char* cB = (const char*)g.Bt + (size_t)cur.pn * tstep;
    S.a_ready(cur);
    if constexpr (SP2) {
        PG8_STAGE(PG8_SB(0, 0), cB, voffB); PG8_STAGE(PG8_SB(0, 1), cB + hstep, voffB); PG8_STAGE(PG8_SA(0, 0), cA, voffA); PG8_STAGE(PG8_SA(0, 1), cA + hstep, voffA);
        if (wr == 1) PG8_BAR;
        PG8_WAIT_V(2); PG8_BAR;
        PG8_STAGE(PG8_SB(1, 0), cB + kstep, voffB); PG8_STAGE(PG8_SA(1, 0), cA + kstep, voffA); PG8_STAGE(PG8_SB(1, 1), cB + hstep + kstep, voffB);
        PG8_WAIT_V(6); PG8_BAR;
    } else {
        PG8_STAGE(PG8_SB(0, 0), cB, voffB); PG8_STAGE(PG8_SA(0, 0), cA, voffA); PG8_STAGE(PG8_SB(0, 1), cB + hstep, voffB); PG8_STAGE(PG8_SA(0, 1), cA + hstep, voffA);
        if (wr == 1) PG8_BAR;
        PG8_WAIT_V(4); PG8_BAR;
        PG8_STAGE(PG8_SB(1, 0), cB + kstep, voffB); PG8_STAGE(PG8_SA(1, 0), cA + kstep, voffA); PG8_STAGE(PG8_SB(1, 1), cB + hstep + kstep, voffB);
        PG8_WAIT_V(6); PG8_BAR;
    }
    for (;;) {
        const bool has_next = S.next(ui + 1, nxt);
        const char* nA = has_next ? (const char*)g.A + (size_t)nxt.pm * tstep : cA; const char* nB = has_next ? (const char*)g.Bt + (size_t)nxt.pn * tstep : cB;
        for (int t = 0; t < nt; t += 2) {
            const bool last = (t == nt - 2);
            const char* a1 = cA + (size_t)(t + 1) * kstep;
            const char* a2 = last ? nA : cA + (size_t)(t + 2) * kstep; const char* b2 = last ? nB : cB + (size_t)(t + 2) * kstep;
            const char* a3 = a2 + kstep; const char* b3 = b2 + kstep;
            if (last && has_next) S.a_ready(nxt);
            if constexpr (SP2) {
            PG8_LDB(B0, 0, 0); PG8_LDB(B1, 0, 1); PG8_SCHED; PG8_LDA(At, 0, 0); PG8_STAGE(PG8_SA(1, 1), a1 + hstep, voffA);
            PG8_WAIT_V(8); PG8_WAIT_L(0); PG8_BAR; PG8_MMA(0, 0, At, B0); PG8_MMA(0, 1, At, B1); PG8_BAR; PG8_SCHED;
            PG8_LDA(At, 0, 1); PG8_STAGE(PG8_SB(0, 0), b2, voffB); PG8_STAGE(PG8_SB(0, 1), b2 + hstep, voffB); PG8_STAGE(PG8_SA(0, 0), a2, voffA);
            PG8_WAIT_V(8); PG8_WAIT_L(0); PG8_BAR; PG8_MMA(1, 0, At, B0); PG8_MMA(1, 1, At, B1); PG8_BAR; PG8_SCHED;
            PG8_LDB(B0, 1, 0); PG8_LDB(B1, 1, 1); PG8_SCHED; PG8_LDA(At, 1, 0); PG8_STAGE(PG8_SA(0, 1), a2 + hstep, voffA);
            PG8_WAIT_V(8); PG8_WAIT_L(0); PG8_BAR; PG8_MMA(0, 0, At, B0); PG8_MMA(0, 1, At, B1); PG8_BAR; PG8_SCHED;
            PG8_LDA(At, 1, 1); PG8_STAGE(PG8_SB(1, 0), b3, voffB); PG8_STAGE(PG8_SB(1, 1), b3 + hstep, voffB); PG8_STAGE(PG8_SA(1, 0), a3, voffA);
            PG8_WAIT_V(8); PG8_WAIT_L(0); PG8_BAR; PG8_MMA(1, 0, At, B0); PG8_MMA(1, 1, At, B1); PG8_BAR; PG8_SCHED;
            } else {
            PG8_LDB(B0, 0, 0); PG8_SCHED; PG8_LDA(At, 0, 0); PG8_STAGE(PG8_SA(1, 1), a1 + hstep, voffA);
            PG8_WAIT_L(8); PG8_BAR; PG8_WAIT_L(0); PG8_MMA(0, 0, At, B0); PG8_BAR; PG8_SCHED;
            PG8_LDB(B1, 0, 1); PG8_STAGE(PG8_SB(0, 0), b2, voffB);
            PG8_BAR; PG8_WAIT_L(0); PG8_MMA(0, 1, At, B1); PG8_BAR;
            PG8_LDA(At, 0, 1); PG8_STAGE(PG8_SA(0, 0), a2, voffA);
            PG8_BAR; PG8_WAIT_L(0); PG8_MMA(1, 0, At, B0); PG8_BAR; PG8_SCHED;
            PG8_STAGE(PG8_SB(0, 1), b2 + hstep, voffB);
            PG8_WAIT_V(6); PG8_BAR; PG8_MMA(1, 1, At, B1); PG8_BAR;
            PG8_LDB(B0, 1, 0); PG8_SCHED; PG8_LDA(At, 1, 0); PG8_STAGE(PG8_SA(0, 1), a2 + hstep, voffA);
            PG8_WAIT_L(8); PG8_BAR; PG8_WAIT_L(0); PG8_MMA(0, 0, At, B0); PG8_BAR; PG8_SCHED;
            PG8_LDB(B1, 1, 1); PG8_STAGE(PG8_SB(1, 0), b3, voffB);
            PG8_BAR; PG8_WAIT_L(0); PG8_MMA(0, 1, At, B1); PG8_BAR;
            PG8_LDA(At, 1, 1); PG8_STAGE(PG8_SA(1, 0), a3, voffA);
            PG8_BAR; PG8_WAIT_L(0); PG8_MMA(1, 0, At, B0); PG8_BAR; PG8_SCHED;
            PG8_STAGE(PG8_SB(1, 1), b3 + hstep, voffB);
            PG8_WAIT_V(6); PG8_BAR; PG8_MMA(1, 1, At, B1); PG8_BAR;
            }
        }
        if constexpr (ALIGN_EPI) { if (wr == 0) PG8_BAR; }
        if constexpr (!Epi::AFTER_DRAIN) { int ln_e; asm volatile("v_mbcnt_lo_u32_b32 %0, -1, 0\n\tv_mbcnt_hi_u32_b32 %0, -1, %0" : "=v"(ln_e)); const int fr_e = ln_e & 15, fq_e = ln_e >> 4;
            E(acc, cur, wr, wc, fr_e, fq_e); S.done(cur); }
        if (!has_next) break;
#pragma unroll
        for (int a = 0; a < 2; ++a)
#pragma unroll
            for (int b = 0; b < 2; ++b)
#pragma unroll
                for (int m = 0; m < 4; ++m)
#pragma unroll
                    for (int n = 0; n < 2; ++n) acc[a][b][m][n] = (f32x4){0.f, 0.f, 0.f, 0.f};
        cur = nxt; cA = nA; cB = nB; ++ui;
        if constexpr (ALIGN_EPI) { if (wr == 1) PG8_BAR; }
    }
    PG8_WAIT_V(0);
    if constexpr (!ALIGN_EPI) { if (wr == 0) PG8_BAR; }
    PG8_BAR;
    if constexpr (Epi::AFTER_DRAIN) { E.fused(acc, cur, wr, wc, fr, fq, lds, wid, lane); S.done(cur); }
#undef PG8_SA
#undef PG8_SB
#undef PG8_STAGE
#undef PG8_LDA
#undef PG8_LDB
#undef PG8_MMA
#undef PG8_WAIT_V
#undef PG8_WAIT_L
#undef PG8_BAR
#undef PG8_SCHED
}
}
#define GAS __attribute__((address_space(1)))
#define LAS __attribute__((address_space(3)))
typedef unsigned short bf16;
typedef unsigned v4u __attribute__((ext_vector_type(4)));
typedef float f32x4 __attribute__((ext_vector_type(4)));
typedef short bf16x8 __attribute__((ext_vector_type(8)));
typedef GAS unsigned gu32;
typedef GAS unsigned long long gu64;
#define RLX_AGENT __ATOMIC_RELAXED, __HIP_MEMORY_SCOPE_AGENT
#define LDS_WAIT() asm volatile("s_waitcnt lgkmcnt(0)" ::: "memory")
#define VM_WAIT() asm volatile("s_waitcnt vmcnt(0)" ::: "memory")
__device__ __forceinline__ unsigned long long rt() { return __builtin_amdgcn_s_memrealtime(); }
__device__ __forceinline__ unsigned f2bf(float f) { unsigned u = __builtin_bit_cast(unsigned, f); return (u + 0x7fffu + ((u >> 16) & 1u)) >> 16; }
__device__ __forceinline__ unsigned pk2(float lo, float hi) { return f2bf(lo) | (f2bf(hi) << 16); }

#define XB_TMO      128
#define XB_XCNT(j)  (256  + 64 * (j))
#define XB_XSUB(j)  (1280 + 64 * (j))
#define XB_XGEN(j)  (2304 + 64 * (j))
#define XB_TOP      3328
#define XB_TOPGEN   3392
#define XCD_BAR_WORDS 3456
#define XB_SPIN_CAP (1u << 18)

__device__ __forceinline__ unsigned xb_ld(unsigned* p)              { return __hip_atomic_load(p, __ATOMIC_RELAXED, __HIP_MEMORY_SCOPE_AGENT); }
__device__ __forceinline__ unsigned xb_add(unsigned* p, unsigned v) { return __hip_atomic_fetch_add(p, v, __ATOMIC_RELAXED, __HIP_MEMORY_SCOPE_AGENT); }
__device__ __forceinline__ unsigned xb_xcc_id() { return (unsigned)__builtin_amdgcn_s_getreg((3 << 11) | 20) & 0xFu; }
#define XB_SPIN(cond, bar) do { unsigned _sp = 0; while (cond) { __builtin_amdgcn_s_sleep(1); \
    if ((++_sp & 255u) == 0u) { if (xb_ld(&(bar)[XB_TMO])) break; if (_sp > XB_SPIN_CAP) { atomicAdd(&(bar)[XB_TMO], 1u); break; } } } } while (0)

struct XcdBarrier {
    unsigned* bar; unsigned x; bool wave0;
    volatile LAS unsigned* st;
};

__device__ __forceinline__ XcdBarrier xcd_barrier_post(unsigned* bar, volatile LAS unsigned* st) {
    XcdBarrier b; b.bar = bar; b.x = xb_xcc_id(); b.st = st;
    if (threadIdx.x == 0) (void)xb_add(&bar[XB_XCNT(b.x)], 1u);
    return b;
}
__device__ __forceinline__ void xcd_barrier_complete(unsigned* bar, unsigned x, unsigned& nloc, unsigned& nx) {
    const unsigned G = gridDim.x * gridDim.y * gridDim.z;
    unsigned sum, cnt, mine, sp = 0u;
    for (;;) {
        sum = 0u; cnt = 0u; mine = 0u;
#pragma unroll
        for (unsigned j = 0; j < 16; ++j) { const unsigned c = xb_ld(&bar[XB_XCNT(j)]); sum += c; cnt += (c > 0u) ? 1u : 0u; mine = (j == x) ? c : mine; }
        if (sum == G) break;
        __builtin_amdgcn_s_sleep(1);
        if ((++sp & 255u) == 0u) { if (xb_ld(&bar[XB_TMO])) break; if (sp > XB_SPIN_CAP) { atomicAdd(&bar[XB_TMO], 1u); break; } }
    }
    nloc = mine > 0u ? mine : 1u; nx = cnt > 0u ? cnt : 1u;
}

__device__ __forceinline__ void xcd_barrier(const XcdBarrier& b) {
    asm volatile("s_waitcnt vmcnt(0)" ::: "memory");
    __syncthreads();
    if (b.wave0 && __builtin_amdgcn_mbcnt_hi(~0u, __builtin_amdgcn_mbcnt_lo(~0u, 0u)) == 0u) {
        unsigned* bar = b.bar;
        __builtin_amdgcn_s_waitcnt(0);
        unsigned nloc = b.st[0], nx = b.st[1];
        if (nloc == 0u) { xcd_barrier_complete(bar, b.x, nloc, nx); b.st[0] = nloc; b.st[1] = nx; }
        const unsigned old = xb_add(&bar[XB_XSUB(b.x)], 1u);
        const unsigned gen = old / nloc;
        if (old + 1u == (gen + 1u) * nloc) {
            __builtin_amdgcn_fence(__ATOMIC_RELEASE, "agent");
            asm volatile("s_waitcnt vmcnt(0)" ::: "memory");
            const unsigned og = xb_add(&bar[XB_TOP], 1u);
            const unsigned tg = og / nx;
            if (og + 1u == (tg + 1u) * nx) xb_add(&bar[XB_TOPGEN], 1u);
            else XB_SPIN(xb_ld(&bar[XB_TOPGEN]) == tg, bar);
            __builtin_amdgcn_fence(__ATOMIC_ACQUIRE, "agent");
            xb_add(&bar[XB_XGEN(b.x)], 1u);
            asm volatile("s_waitcnt vmcnt(0)" ::: "memory");
        } else {
            XB_SPIN(xb_ld(&bar[XB_XGEN(b.x)]) == gen, bar);
            __builtin_amdgcn_fence(__ATOMIC_ACQUIRE, "agent");
            asm volatile("s_waitcnt vmcnt(0)" ::: "memory");
        }
    }
    __syncthreads();
}

constexpr int NWAVES = 8, NTHREADS = NWAVES * 64;
constexpr int BATCH = 8, SEQ = 2048, T = BATCH * SEQ, D = 2048;
constexpr int EV_N = 7200, EV_NP = 7424, OD_N = 7616, OD_NP = 7680, PROJ_LD = 7680;
constexpr float EPS = 1e-6f;
constexpr int EC_GQ = 0, EC_GK = 512, EC_GV = 1024, EC_GZ = 2048, EC_GLR = 3072, EC_BQ = 3088, EC_BK = 4112, EC_BV = 5136, EC_BZ = 6160, EC_BA = 7184, EC_BB = 7192;
constexpr int OC_HQ = 0, OC_HF = 1024, OC_HI = 2048, OC_HG = 3072, OC_RW = 4096;
constexpr int RW_R = 0, RW_K = 1024, RW_V = 2048, RW_WL = 3072, RW_AL = 3168, RW_GL = 3264;
constexpr int LORA_K = 512, LORA_N = 3072;
enum { I_X = 0, I_P, I_EV_WIN, I_GK_W2, I_GK_B, I_GLA_NORM, I_GDN_CONV, I_GDN_ALOG, I_GDN_DTB, I_GDN_NORM, I_EV_WOUT, I_OD_WIN, I_LB, I_HG_NORM,
       I_MU, I_W0, I_W2, I_A0, I_A2, I_G2, I_KK, I_KA, I_RK, I_LNW, I_LNB, I_OD_WOUT, I_NMIX, I_NFFN, I_NPLE, I_PEER_WQ, I_PEER_SK, I_PEER_U, I_PEER_V,
       I_PLE_WP, I_PLE_WG, I_NFINAL, N_IN };

constexpr size_t MiB = 1u << 20;
constexpr size_t WS_CTL = 0, CTL_ZERO_BYTES = 1 * MiB, WS_SU = 256 * 1024, WS_CMB = 512 * 1024, WS_SA = 576 * 1024;
constexpr size_t WS_WEV_IN = 1 * MiB, WS_WEV_OUT = 30 * MiB, WS_WOD_IN = 38 * MiB, WS_WOD_OUT = 68 * MiB, WS_WPEER = 76 * MiB, WS_WGATE = 92 * MiB, WS_WPROJ = 108 * MiB,
                 WS_WLORA = 110 * MiB, WS_PBF = 113 * MiB, WS_TABU = 129 * MiB, WS_TABV = 193 * MiB, WS_ACTA = 257 * MiB, WS_ACTB = 321 * MiB, WS_PROJ = 385 * MiB, WS_SC = 385 * MiB,
                 WS_O = 625 * MiB, WS_H1 = 689 * MiB, WS_PP = 753 * MiB, WS_LA = 817 * MiB, WS_LO = 833 * MiB, WS_RSP = 929 * MiB, WS_STATE = 937 * MiB, WS_RS3 = 945 * MiB, WS_END = 946 * MiB;
static_assert(WS_WEV_IN + (size_t)EV_NP * D * 2 <= WS_WEV_OUT && WS_WOD_IN + (size_t)OD_NP * D * 2 <= WS_WOD_OUT && WS_PROJ + (size_t)T * PROJ_LD * 2 <= WS_O, "ws map");
constexpr int CW_BAR = 4096;
enum { RS_FFN0 = 0, RS_MIX1 = 1, RS_FFN1 = 2, RS_FINAL = 3 };
constexpr int RING_OFF = 0, RING_BYTES = 131072;
constexpr int LDSCTL_OFF = RING_BYTES, MISC_OFF = LDSCTL_OFF + 320;
constexpr int LDS_BYTES = 147456;

struct Args { const float* in[N_IN]; float* out; unsigned char* ws; int ph_lo, ph_hi; };
struct Frame {
    LAS unsigned char* lds; volatile LAS unsigned* MISC; gu32* ctl;
    int tid, lane, wave, vcu, G;
};
__device__ __forceinline__ float wave_sum(float v) {
#pragma unroll
    for (int o = 1; o < 64; o <<= 1) v += __shfl_xor(v, o);
    return v;
}
__device__ __forceinline__ float half_sum32(float v) {
#pragma unroll
    for (int o = 1; o < 32; o <<= 1) v += __shfl_xor(v, o);
    return v;
}
#define DPP_ADD(v, ctrl) (v) += __builtin_bit_cast(float, __builtin_amdgcn_update_dpp(0, __builtin_bit_cast(int, (v)), (ctrl), 0xF, 0xF, false))
__device__ __forceinline__ float row_sum16(float v) {
    DPP_ADD(v, 0x128); DPP_ADD(v, 0x124); DPP_ADD(v, 0x122); DPP_ADD(v, 0x121);
    return v;
}
__device__ __forceinline__ void row_sum16_x4(float& a, float& b, float& c, float& d) {
    asm("s_nop 1\n\t"
        "v_add_f32_dpp %0, %0, %0 row_ror:8 row_mask:0xf bank_mask:0xf\n\tv_add_f32_dpp %1, %1, %1 row_ror:8 row_mask:0xf bank_mask:0xf\n\t"
        "v_add_f32_dpp %2, %2, %2 row_ror:8 row_mask:0xf bank_mask:0xf\n\tv_add_f32_dpp %3, %3, %3 row_ror:8 row_mask:0xf bank_mask:0xf\n\t"
        "v_add_f32_dpp %0, %0, %0 row_ror:4 row_mask:0xf bank_mask:0xf\n\tv_add_f32_dpp %1, %1, %1 row_ror:4 row_mask:0xf bank_mask:0xf\n\t"
        "v_add_f32_dpp %2, %2, %2 row_ror:4 row_mask:0xf bank_mask:0xf\n\tv_add_f32_dpp %3, %3, %3 row_ror:4 row_mask:0xf bank_mask:0xf\n\t"
        "v_add_f32_dpp %0, %0, %0 row_ror:2 row_mask:0xf bank_mask:0xf\n\tv_add_f32_dpp %1, %1, %1 row_ror:2 row_mask:0xf bank_mask:0xf\n\t"
        "v_add_f32_dpp %2, %2, %2 row_ror:2 row_mask:0xf bank_mask:0xf\n\tv_add_f32_dpp %3, %3, %3 row_ror:2 row_mask:0xf bank_mask:0xf\n\t"
        "v_add_f32_dpp %0, %0, %0 row_ror:1 row_mask:0xf bank_mask:0xf\n\tv_add_f32_dpp %1, %1, %1 row_ror:1 row_mask:0xf bank_mask:0xf\n\t"
        "v_add_f32_dpp %2, %2, %2 row_ror:1 row_mask:0xf bank_mask:0xf\n\tv_add_f32_dpp %3, %3, %3 row_ror:1 row_mask:0xf bank_mask:0xf\n\t"
        "s_nop 1"
        : "+v"(a), "+v"(b), "+v"(c), "+v"(d));
}
__device__ __forceinline__ void row_sum16_x2(float& a, float& b) {
    asm("s_nop 1\n\t"
        "v_add_f32_dpp %0, %0, %0 row_ror:8 row_mask:0xf bank_mask:0xf\n\tv_add_f32_dpp %1, %1, %1 row_ror:8 row_mask:0xf bank_mask:0xf\n\ts_nop 1\n\t"
        "v_add_f32_dpp %0, %0, %0 row_ror:4 row_mask:0xf bank_mask:0xf\n\tv_add_f32_dpp %1, %1, %1 row_ror:4 row_mask:0xf bank_mask:0xf\n\ts_nop 1\n\t"
        "v_add_f32_dpp %0, %0, %0 row_ror:2 row_mask:0xf bank_mask:0xf\n\tv_add_f32_dpp %1, %1, %1 row_ror:2 row_mask:0xf bank_mask:0xf\n\ts_nop 1\n\t"
        "v_add_f32_dpp %0, %0, %0 row_ror:1 row_mask:0xf bank_mask:0xf\n\tv_add_f32_dpp %1, %1, %1 row_ror:1 row_mask:0xf bank_mask:0xf\n\t"
        "s_nop 1"
        : "+v"(a), "+v"(b));
}
typedef unsigned u32x2 __attribute__((ext_vector_type(2)));
__device__ __forceinline__ void st_wt16(void* p, v4u v) { asm volatile("global_store_dwordx4 %0, %1, off sc1\n\ts_nop 1" :: "v"(p), "v"(v) : "memory"); }
__device__ __forceinline__ void st_wt8(void* p, u32x2 v) { asm volatile("global_store_dwordx2 %0, %1, off sc1\n\ts_nop 1" :: "v"(p), "v"(v) : "memory"); }
#define LBAR() do { asm volatile("s_waitcnt lgkmcnt(0)" ::: "memory"); __builtin_amdgcn_s_barrier(); asm volatile("" ::: "memory"); } while (0)
typedef float f32x2 __attribute__((ext_vector_type(2)));
typedef __bf16 hwbf16x2_t __attribute__((ext_vector_type(2)));
__device__ __forceinline__ unsigned hw_pk2(float lo, float hi) { const f32x2 v = {lo, hi}; return __builtin_bit_cast(unsigned, __builtin_convertvector(v, hwbf16x2_t)); }
__device__ __forceinline__ bf16 hw_bf(float x) { return (bf16)hw_pk2(x, 0.f); }
__device__ __forceinline__ float bf_lo(unsigned w) { return __uint_as_float(w << 16); }
__device__ __forceinline__ float bf_hi(unsigned w) { return __uint_as_float(w & 0xffff0000u); }
__device__ __forceinline__ float sigmoidf_(float x) { return __builtin_amdgcn_rcpf(1.0f + __expf(-x)); }
__device__ __forceinline__ float siluf_(float x) { return x * __builtin_amdgcn_rcpf(1.0f + __expf(-x)); }
__device__ __forceinline__ float softplusf_(float x) { return fmaxf(x, 0.f) + log1pf(__expf(-fabsf(x))); }
__device__ __forceinline__ float logsigmoidf_(float x) { return fminf(x, 0.f) - log1pf(__expf(-fabsf(x))); }

struct EpiBf16S {
    static constexpr bool PERM = true, AFTER_DRAIN = false;
    bf16* O; int ldc; const float* rowss;
    __device__ __forceinline__ void operator()(const pg8::f32x4 (&acc)[2][2][4][2], const pg8::Unit& u, int wr, int wc, int fr, int fq) const {
        const int row0 = u.pm * 256 + wr * 64 + fr, col0 = u.pn * 256 + wc * 32 + 8 * fq;
#pragma unroll
        for (int ai = 0; ai < 2; ++ai)
#pragma unroll
            for (int m = 0; m < 4; ++m) {
                const int row = row0 + ai * 128 + m * 16;
                float sc = 1.f;
                if (rowss) { const pg8::f32x4* rp = (const pg8::f32x4*)(rowss + (size_t)row * 32 + 8 * fq); const pg8::f32x4 p0 = rp[0], p1 = rp[1];
                    float s = ((p0[0] + p0[1]) + (p0[2] + p0[3])) + ((p1[0] + p1[1]) + (p1[2] + p1[3])); s += __shfl_xor(s, 16); s += __shfl_xor(s, 32);
                    sc = __builtin_amdgcn_rsqf(s * (1.0f / D) + EPS); }
                bf16* rowp = O + (size_t)row * ldc + col0;
#pragma unroll
                for (int bj = 0; bj < 2; ++bj) { const pg8::f32x4 v0 = acc[ai][bj][m][0] * sc, v1 = acc[ai][bj][m][1] * sc;
                    pg8::u32x4 w; w.x = pg8::cvt_pk_bf16(v0[0], v0[1]); w.y = pg8::cvt_pk_bf16(v0[2], v0[3]); w.z = pg8::cvt_pk_bf16(v1[0], v1[1]); w.w = pg8::cvt_pk_bf16(v1[2], v1[3]);
                    *(pg8::u32x4*)(rowp + bj * 128) = w; } }
    }
};
struct EpiI8S {
    static constexpr bool PERM = true, AFTER_DRAIN = false;
    bf16* O; int ldc; const float* sa; const float* cb;
    __device__ __forceinline__ void operator()(const pg8::f32x4 (&acc)[2][2][4][2], const pg8::Unit& u, int wr, int wc, int fr, int fq) const {
        const int row0 = u.pm * 256 + wr * 64 + fr, col0 = u.pn * 256 + wc * 32 + 8 * fq;
        pg8::f32x4 cs[2][2];
#pragma unroll
        for (int bj = 0; bj < 2; ++bj) { cs[bj][0] = *(const pg8::f32x4*)(cb + col0 + bj * 128); cs[bj][1] = *(const pg8::f32x4*)(cb + col0 + bj * 128 + 4); }
#pragma unroll
        for (int ai = 0; ai < 2; ++ai)
#pragma unroll
            for (int m = 0; m < 4; ++m) {
                const int row = row0 + ai * 128 + m * 16;
                const float sc = sa[row];
                bf16* rowp = O + (size_t)row * ldc + col0;
#pragma unroll
                for (int bj = 0; bj < 2; ++bj) { pg8::f32x4 v0, v1;
#pragma unroll
                    for (int e = 0; e < 4; ++e) { v0[e] = (float)__float_as_int(acc[ai][bj][m][0][e]) * sc * cs[bj][0][e]; v1[e] = (float)__float_as_int(acc[ai][bj][m][1][e]) * sc * cs[bj][1][e]; }
                    pg8::u32x4 w; w.x = pg8::cvt_pk_bf16(v0[0], v0[1]); w.y = pg8::cvt_pk_bf16(v0[2], v0[3]); w.z = pg8::cvt_pk_bf16(v1[0], v1[1]); w.w = pg8::cvt_pk_bf16(v1[2], v1[3]);
                    *(pg8::u32x4*)(rowp + bj * 128) = w; } }
    }
};
template <bool GATE, bool HIN_F32, bool I8 = false> struct EpiResid {
    static constexpr bool PERM = false, AFTER_DRAIN = false;
    const void* hin; bf16* hout; float* rowss; const bf16* pp; const float* rs3; unsigned char* h8; const float* sa; const float* cb;
    __device__ __forceinline__ void operator()(const pg8::f32x4 (&acc)[2][2][4][2], const pg8::Unit& u, int wr, int wc, int fr, int fq) const {
        const int row0 = u.pm * 256 + wr * 64 + fr, col0 = u.pn * 256 + wc * 32 + 4 * fq;
        pg8::f32x4 cs[2][2];
        if constexpr (I8) {
#pragma unroll
            for (int bj = 0; bj < 2; ++bj)
#pragma unroll
                for (int n = 0; n < 2; ++n) cs[bj][n] = *(const pg8::f32x4*)(cb + col0 + bj * 128 + n * 16); }
        constexpr int MG = HIN_F32 ? 2 : 4;
#pragma unroll
        for (int ai = 0; ai < 2; ++ai)
#pragma unroll
            for (int m0 = 0; m0 < 4; m0 += MG) {
                pg8::f32x4 hf[MG][2][2]; pg8::u32x2 hb[MG][2][2], pw[MG][2][2]; float rsc[MG];
#pragma unroll
                for (int mm = 0; mm < MG; ++mm) { const int row = row0 + ai * 128 + (m0 + mm) * 16; const size_t off = (size_t)row * D + col0; rsc[mm] = GATE ? rs3[row] : (I8 ? sa[row] : 1.f);
#pragma unroll
                    for (int bj = 0; bj < 2; ++bj)
#pragma unroll
                        for (int n = 0; n < 2; ++n) { const size_t o = off + bj * 128 + n * 16;
                            if (HIN_F32) hf[mm][bj][n] = *(const pg8::f32x4*)((const float*)hin + o); else hb[mm][bj][n] = *(const pg8::u32x2*)((const bf16*)hin + o);
                            if (GATE) pw[mm][bj][n] = *(const pg8::u32x2*)(pp + o); } }
#pragma unroll
                for (int mm = 0; mm < MG; ++mm) { const int m = m0 + mm; const int row = row0 + ai * 128 + m * 16; const size_t off = (size_t)row * D + col0; float ss = 0.f;
#pragma unroll
                    for (int bj = 0; bj < 2; ++bj)
#pragma unroll
                        for (int n = 0; n < 2; ++n) { const size_t o = off + bj * 128 + n * 16;
                            pg8::f32x4 hv;
                            if (HIN_F32) hv = hf[mm][bj][n];
                            else { const pg8::u32x2 hw = hb[mm][bj][n]; hv[0] = bf_lo(hw.x); hv[1] = bf_hi(hw.x); hv[2] = bf_lo(hw.y); hv[3] = bf_hi(hw.y); }
                            pg8::f32x4 a = acc[ai][bj][m][n];
                            if constexpr (I8 && !GATE) { const float sr_ = rsc[mm];
#pragma unroll
                                for (int e = 0; e < 4; ++e) a[e] = (float)__float_as_int(a[e]) * sr_ * cs[bj][n][e]; }
                            if (GATE) { const pg8::u32x2 p2 = pw[mm][bj][n]; const float rs_ = rsc[mm];
                                a[0] = sigmoidf_(a[0] * rs_) * bf_lo(p2.x); a[1] = sigmoidf_(a[1] * rs_) * bf_hi(p2.x); a[2] = sigmoidf_(a[2] * rs_) * bf_lo(p2.y); a[3] = sigmoidf_(a[3] * rs_) * bf_hi(p2.y); }
                            hv = hv + a;
                            pg8::u32x2 w; w.x = hw_pk2(hv[0], hv[1]); w.y = hw_pk2(hv[2], hv[3]); *(pg8::u32x2*)(hout + o) = w;
                            if (h8) { int x8 = __builtin_amdgcn_cvt_pk_fp8_f32(hv[0], hv[1], 0, false); x8 = __builtin_amdgcn_cvt_pk_fp8_f32(hv[2], hv[3], x8, true); *(unsigned*)(h8 + o) = (unsigned)x8; }
                            const float q0 = bf_lo(w.x), q1 = bf_hi(w.x), q2 = bf_lo(w.y), q3 = bf_hi(w.y);
                            ss += (q0 * q0 + q1 * q1) + (q2 * q2 + q3 * q3); }
                    ss += __shfl_xor(ss, 16); ss += __shfl_xor(ss, 32);
                    if (fq == 0) rowss[(size_t)row * 32 + u.pn * 4 + wc] = ss; }
                asm volatile("" ::: "memory"); }
    }
};


__device__ __forceinline__ void p0_transpose_item(const float* W, int K, int N, bf16* WT, LAS float* scr, int item, int lane, const float* kgain = nullptr) {
    const int nblk = N / 32, kb = item / nblk, nb = item % nblk, k0 = 64 * kb, n0 = 32 * nb;
    { const GAS float* Wg = (const GAS float*)W + (size_t)(k0 + (lane >> 5)) * N + n0 + (lane & 31); float v[32];
#pragma unroll
      for (int i = 0; i < 32; ++i) v[i] = Wg[(size_t)(2 * i) * N];
#pragma unroll
      for (int i = 0; i < 32; ++i) scr[(2 * i + (lane >> 5)) * 33 + (lane & 31)] = v[i]; }
    LDS_WAIT(); asm volatile("" ::: "memory");
    const int c = lane & 7;
#pragma unroll
    for (int j = 0; j < 4; ++j) { const int n = (lane >> 3) + 8 * j; const LAS float* s = scr + (8 * c) * 33 + n;
        f32x4 g0 = {1.f, 1.f, 1.f, 1.f}, g1 = g0; if (kgain) { g0 = *(const GAS f32x4*)(kgain + k0 + 8 * c); g1 = *(const GAS f32x4*)(kgain + k0 + 8 * c + 4); }
        v4u o; o.x = pk2(s[0 * 33] * g0[0], s[1 * 33] * g0[1]); o.y = pk2(s[2 * 33] * g0[2], s[3 * 33] * g0[3]); o.z = pk2(s[4 * 33] * g1[0], s[5 * 33] * g1[1]); o.w = pk2(s[6 * 33] * g1[2], s[7 * 33] * g1[3]);
        *(GAS v4u*)(WT + (size_t)(n0 + n) * K + k0 + 8 * c) = o; }
    LDS_WAIT(); asm volatile("" ::: "memory");
}
__device__ __forceinline__ void p0_transpose_item_i8(const float* W, int K, int N, unsigned char* WT, LAS float* scr, int item, int lane, const float* cm) {
    const int nblk = N / 32, kb = item / nblk, nb = item % nblk, k0 = 64 * kb, n0 = 32 * nb;
    { const GAS float* Wg = (const GAS float*)W + (size_t)(k0 + (lane >> 5)) * N + n0 + (lane & 31); float v[32];
#pragma unroll
      for (int i = 0; i < 32; ++i) v[i] = Wg[(size_t)(2 * i) * N];
#pragma unroll
      for (int i = 0; i < 32; ++i) scr[(2 * i + (lane >> 5)) * 33 + (lane & 31)] = v[i]; }
    LDS_WAIT(); asm volatile("" ::: "memory");
    const int c = lane & 7;
#pragma unroll
    for (int j = 0; j < 4; ++j) { const int n = (lane >> 3) + 8 * j; const LAS float* s = scr + (8 * c) * 33 + n;
        const float mx = __uint_as_float(__hip_atomic_load((const unsigned*)cm + n0 + n, __ATOMIC_RELAXED, __HIP_MEMORY_SCOPE_AGENT)), inv = mx > 0.f ? 127.0f / mx : 0.f; unsigned w0 = 0, w1 = 0;
#pragma unroll
        for (int e = 0; e < 4; ++e) { w0 |= (__float_as_uint(__builtin_fmaf(s[e * 33], inv, 12582912.0f)) & 255u) << (8 * e); w1 |= (__float_as_uint(__builtin_fmaf(s[(4 + e) * 33], inv, 12582912.0f)) & 255u) << (8 * e); }
        u32x2 o; o.x = w0; o.y = w1;
        *(GAS u32x2*)(WT + (size_t)(n0 + n) * K + k0 + 8 * c) = o; }
    LDS_WAIT(); asm volatile("" ::: "memory");
}
__device__ __forceinline__ void colmax_item(const float* W, int K, int N, float* cm, int item, int lane) {
    const int ngrp = (N + 255) / 256, kb = item / ngrp, cg_ = item % ngrp, col = 256 * cg_ + 4 * lane;
    if (col >= N) return;
    const GAS f32x4* p = (const GAS f32x4*)((const GAS float*)W + (size_t)(64 * kb) * N + col); f32x4 m = {0.f, 0.f, 0.f, 0.f};
#pragma unroll 16
    for (int r = 0; r < 64; ++r) { const f32x4 v = *(const GAS f32x4*)((const GAS float*)p + (size_t)r * N);
#pragma unroll
        for (int e = 0; e < 4; ++e) m[e] = fmaxf(m[e], fabsf(v[e])); }
#pragma unroll
    for (int e = 0; e < 4; ++e) __hip_atomic_fetch_max((unsigned*)cm + col + e, __float_as_uint(m[e]), __ATOMIC_RELAXED, __HIP_MEMORY_SCOPE_AGENT);
}
__device__ __forceinline__ void p0_transpose_item_f8(const float* W, int K, int N, unsigned char* WT, LAS float* scr, int item, int lane, const float* kgain = nullptr) {
    const int nblk = N / 32, kb = item / nblk, nb = item % nblk, k0 = 64 * kb, n0 = 32 * nb;
    { const GAS float* Wg = (const GAS float*)W + (size_t)(k0 + (lane >> 5)) * N + n0 + (lane & 31); float v[32];
#pragma unroll
      for (int i = 0; i < 32; ++i) v[i] = Wg[(size_t)(2 * i) * N];
#pragma unroll
      for (int i = 0; i < 32; ++i) scr[(2 * i + (lane >> 5)) * 33 + (lane & 31)] = v[i]; }
    LDS_WAIT(); asm volatile("" ::: "memory");
    const int c = lane & 7;
#pragma unroll
    for (int j = 0; j < 4; ++j) { const int n = (lane >> 3) + 8 * j; const LAS float* s = scr + (8 * c) * 33 + n;
        f32x4 g0 = {64.f, 64.f, 64.f, 64.f}, g1 = g0; if (kgain) { g0 = g0 * *(const GAS f32x4*)(kgain + k0 + 8 * c); g1 = g1 * *(const GAS f32x4*)(kgain + k0 + 8 * c + 4); }
        int x0 = __builtin_amdgcn_cvt_pk_fp8_f32(s[0 * 33] * g0[0], s[1 * 33] * g0[1], 0, false); x0 = __builtin_amdgcn_cvt_pk_fp8_f32(s[2 * 33] * g0[2], s[3 * 33] * g0[3], x0, true);
        int x1 = __builtin_amdgcn_cvt_pk_fp8_f32(s[4 * 33] * g1[0], s[5 * 33] * g1[1], 0, false); x1 = __builtin_amdgcn_cvt_pk_fp8_f32(s[6 * 33] * g1[2], s[7 * 33] * g1[3], x1, true);
        u32x2 o; o.x = (unsigned)x0; o.y = (unsigned)x1;
        *(GAS u32x2*)(WT + (size_t)(n0 + n) * K + k0 + 8 * c) = o; }
    LDS_WAIT(); asm volatile("" ::: "memory");
}
__device__ __forceinline__ void cvt_f32_bf16(const float* src, bf16* dst, size_t n, int gtid, int gthreads) {
    const size_t n8 = n / 8;
    for (size_t i = gtid; i < n8; i += gthreads) {
        const f32x4 a = *(const GAS f32x4*)(src + i * 8), b = *(const GAS f32x4*)(src + i * 8 + 4);
        v4u o; o.x = pk2(a[0], a[1]); o.y = pk2(a[2], a[3]); o.z = pk2(b[0], b[1]); o.w = pk2(b[2], b[3]);
        *(GAS v4u*)(dst + i * 8) = o; }
}
__device__ __forceinline__ void cvt_f32_fp8(const float* src, unsigned char* dst, size_t n, float scale, int gtid, int gthreads, const float* cgain = nullptr) {
    const size_t n16 = n / 16;
    for (size_t i = gtid; i < n16; i += gthreads) { v4u o; unsigned w[4];
#pragma unroll
        for (int q = 0; q < 4; ++q) { f32x4 a = *(const GAS f32x4*)(src + i * 16 + 4 * q) * scale; if (cgain) a = a * *(const GAS f32x4*)(cgain + ((i * 16 + 4 * q) & (D - 1)));
            int x = __builtin_amdgcn_cvt_pk_fp8_f32(a[0], a[1], 0, false); x = __builtin_amdgcn_cvt_pk_fp8_f32(a[2], a[3], x, true); w[q] = (unsigned)x; }
        o.x = w[0]; o.y = w[1]; o.z = w[2]; o.w = w[3];
        *(GAS v4u*)(dst + i * 16) = o; }
}
__device__ __forceinline__ void cvt_rows_i8(const float* src, unsigned char* dst, float* SU, int rows, int gw, int NGW, int lane, const float* cgain) {
    f32x4 a[8], nx[8];
    int r = gw;
    if (r < rows) {
#pragma unroll
        for (int i = 0; i < 8; ++i) a[i] = *(const GAS f32x4*)(src + (size_t)r * D + 256 * i + 4 * lane); }
    for (; r < rows; r += NGW) {
        const int rn = r + NGW;
        if (rn < rows) {
#pragma unroll
            for (int i = 0; i < 8; ++i) nx[i] = *(const GAS f32x4*)(src + (size_t)rn * D + 256 * i + 4 * lane); }
        float mx = 0.f;
#pragma unroll
        for (int i = 0; i < 8; ++i) { if (cgain) a[i] = a[i] * *(const GAS f32x4*)(cgain + 256 * i + 4 * lane);
            mx = fmaxf(mx, fmaxf(fmaxf(fabsf(a[i][0]), fabsf(a[i][1])), fmaxf(fabsf(a[i][2]), fabsf(a[i][3])))); }
#pragma unroll
        for (int o = 1; o < 64; o <<= 1) mx = fmaxf(mx, __shfl_xor(mx, o));
        const float inv = mx > 0.f ? 127.0f / mx : 0.f;
#pragma unroll
        for (int i = 0; i < 8; ++i) { unsigned w = 0;
#pragma unroll
            for (int e = 0; e < 4; ++e) w |= (__float_as_uint(__builtin_fmaf(a[i][e], inv, 12582912.0f)) & 255u) << (8 * e);
            *(GAS unsigned*)(dst + (size_t)r * D + 256 * i + 4 * lane) = w; }
        if (lane == 0) SU[r] = mx * (1.0f / 127.0f);
#pragma unroll
        for (int i = 0; i < 8; ++i) a[i] = nx[i];
    }
}
__device__ __forceinline__ void rms_row_to_bf16(const float* xrow, const float* g, bf16* orow, int lane) {
    const GAS f32x4* xr = (const GAS f32x4*)xrow + lane; f32x4 v[8]; float s = 0.f;
#pragma unroll
    for (int j = 0; j < 8; ++j) { v[j] = xr[64 * j]; s += (v[j][0] * v[j][0] + v[j][1] * v[j][1]) + (v[j][2] * v[j][2] + v[j][3] * v[j][3]); }
    const float r = __builtin_amdgcn_rsqf(wave_sum(s) * (1.0f / D) + EPS);
    const GAS f32x4* gr = (const GAS f32x4*)g + lane;
    GAS unsigned long long* o8 = (GAS unsigned long long*)orow + lane;
#pragma unroll
    for (int j = 0; j < 8; ++j) { const f32x4 gg = gr[64 * j]; o8[64 * j] = (unsigned long long)pk2(v[j][0] * r * gg[0], v[j][1] * r * gg[1]) | ((unsigned long long)pk2(v[j][2] * r * gg[2], v[j][3] * r * gg[3]) << 32); }
}
__device__ __forceinline__ void rms_row_to_i8(const float* xrow, const float* g, unsigned char* orow, float* sa, int lane) {
    const GAS f32x4* xr = (const GAS f32x4*)xrow + lane; f32x4 v[8]; float s = 0.f;
#pragma unroll
    for (int j = 0; j < 8; ++j) { v[j] = xr[64 * j]; s += (v[j][0] * v[j][0] + v[j][1] * v[j][1]) + (v[j][2] * v[j][2] + v[j][3] * v[j][3]); }
    const float r = __builtin_amdgcn_rsqf(wave_sum(s) * (1.0f / D) + EPS);
    const GAS f32x4* gr = (const GAS f32x4*)g + lane; float mx = 0.f;
#pragma unroll
    for (int j = 0; j < 8; ++j) { v[j] = v[j] * gr[64 * j] * r; mx = fmaxf(mx, fmaxf(fmaxf(fabsf(v[j][0]), fabsf(v[j][1])), fmaxf(fabsf(v[j][2]), fabsf(v[j][3])))); }
#pragma unroll
    for (int o = 1; o < 64; o <<= 1) mx = fmaxf(mx, __shfl_xor(mx, o));
    const float inv = mx > 0.f ? 127.0f / mx : 0.f;
    GAS unsigned* o4 = (GAS unsigned*)orow + lane;
#pragma unroll
    for (int j = 0; j < 8; ++j) { unsigned w = 0;
#pragma unroll
        for (int e = 0; e < 4; ++e) w |= (__float_as_uint(__builtin_fmaf(v[j][e], inv, 12582912.0f)) & 255u) << (8 * e);
        o4[64 * j] = w; }
    if (lane == 0) *sa = mx * (1.0f / (127.0f * 127.0f));
}
__device__ __forceinline__ void rms_row_to_f8(const float* xrow, const float* g, unsigned char* orow, int lane) {
    const GAS f32x4* xr = (const GAS f32x4*)xrow + lane; f32x4 v[8]; float s = 0.f;
#pragma unroll
    for (int j = 0; j < 8; ++j) { v[j] = xr[64 * j]; s += (v[j][0] * v[j][0] + v[j][1] * v[j][1]) + (v[j][2] * v[j][2] + v[j][3] * v[j][3]); }
    const float r = __builtin_amdgcn_rsqf(wave_sum(s) * (1.0f / D) + EPS);
    const GAS f32x4* gr = (const GAS f32x4*)g + lane;
    GAS unsigned* o4 = (GAS unsigned*)orow + lane;
#pragma unroll
    for (int j = 0; j < 8; ++j) { const f32x4 q = v[j] * gr[64 * j] * r; int x = __builtin_amdgcn_cvt_pk_fp8_f32(q[0], q[1], 0, false); x = __builtin_amdgcn_cvt_pk_fp8_f32(q[2], q[3], x, true); o4[64 * j] = (unsigned)x; }
}
__device__ __forceinline__ void p0_fold_item(const float* wq, const float* sk, bf16* WP, LAS float* lds, int item, int tid, const float* kgain) {
    const int hp = item >> 5, k0 = (item & 31) * 64;
    LAS float* skT = lds;
    LAS float* wqT = lds + 128 * 132;
    const float* skb = sk + (size_t)hp * 128 * 128;
    { const GAS float* sg = (const GAS float*)skb; const GAS float* wg = (const GAS float*)wq; const GAS float* kg = (const GAS float*)kgain; float v[32], w[16];
#pragma unroll
      for (int i = 0; i < 32; ++i) v[i] = sg[i * 512 + tid];
#pragma unroll
      for (int i = 0; i < 16; ++i) { const int idx = i * 512 + tid, kk = idx >> 7, d = idx & 127; w[i] = wg[(size_t)(k0 + kk) * D + hp * 128 + d] * kg[k0 + kk]; }
#pragma unroll
      for (int i = 0; i < 32; ++i) { const int idx = i * 512 + tid, n = idx >> 7, d = idx & 127; skT[d * 132 + n] = v[i]; }
#pragma unroll
      for (int i = 0; i < 16; ++i) { const int idx = i * 512 + tid, kk = idx >> 7, d = idx & 127; wqT[d * 68 + kk] = w[i]; } }
    __syncthreads();
    const int n0 = (tid >> 4) * 4, kk0 = (tid & 15) * 4;
    float acc[4][4];
#pragma unroll
    for (int i = 0; i < 4; ++i)
#pragma unroll
        for (int j = 0; j < 4; ++j) acc[i][j] = 0.f;
#pragma unroll 4
    for (int d = 0; d < 128; ++d) { const f32x4 a = *(const LAS f32x4*)(skT + d * 132 + n0), b = *(const LAS f32x4*)(wqT + d * 68 + kk0);
#pragma unroll
        for (int i = 0; i < 4; ++i)
#pragma unroll
            for (int j = 0; j < 4; ++j) acc[i][j] += a[i] * b[j]; }
#pragma unroll
    for (int i = 0; i < 4; ++i) { unsigned long long o = (unsigned long long)pk2(acc[i][0], acc[i][1]) | ((unsigned long long)pk2(acc[i][2], acc[i][3]) << 32);
        *(GAS unsigned long long*)(WP + (size_t)(hp * 128 + n0 + i) * D + k0 + kk0) = o; }
    __syncthreads();
}
__device__ __forceinline__ void p0_prologue(const Args& A, Frame& F, const int part) {
    const int gw = F.vcu * NWAVES + F.wave, NGW = F.G * NWAVES;
    const int gtid = gw * 64 + F.lane, gthreads = F.G * NTHREADS;
    unsigned char* ws = A.ws;
    LAS float* scr = (LAS float*)(F.lds + RING_OFF + F.wave * 16384);
    constexpr int I_EVIN = (D / 64) * (EV_N / 32);
    if (part == 1) {
        for (int it = gw; it < I_EVIN; it += NGW) p0_transpose_item_i8(A.in[I_EV_WIN], D, EV_N, (unsigned char*)(ws + WS_WEV_IN), scr, it, F.lane, (const float*)(ws + WS_CMB));
        return; }
    { constexpr int I_CM = (D / 64) * ((EV_N + 255) / 256);
      for (int it = gw; it < I_CM; it += NGW) colmax_item(A.in[I_EV_WIN], D, EV_N, (float*)(ws + WS_CMB), it, F.lane); }
    { GAS v4u* z0 = (GAS v4u*)(ws + WS_WEV_IN + (size_t)EV_N * D); const size_t n0 = (size_t)(EV_NP - EV_N) * D / 16;
      for (size_t i = gtid; i < n0; i += gthreads) z0[i] = (v4u){0u, 0u, 0u, 0u}; }
    { constexpr int I_PJ = (256 / 64) * (D / 32);
      for (int it = gw; it < 2 * I_PJ; it += NGW) { const int L = it / I_PJ; p0_transpose_item(A.in[I_PLE_WP] + (size_t)L * 256 * D, 256, D, (bf16*)(ws + WS_WPROJ) + (size_t)L * D * 256, scr, it % I_PJ, F.lane); } }
    if (F.G < 256) cvt_f32_bf16(A.in[I_P], (bf16*)(ws + WS_PBF), (size_t)2 * T * 256, gtid, gthreads);
    for (int m = gw; m < T; m += NGW) rms_row_to_i8(A.in[I_X] + (size_t)m * D, A.in[I_NMIX], (unsigned char*)(ws + WS_ACTA) + (size_t)m * D, (float*)(ws + WS_SA) + m, F.lane);
#if EV_F8_T1 > EV_F8_T0
    for (int it = gw; it < I_EVIN; it += NGW) p0_transpose_item_f8(A.in[I_EV_WIN], D, EV_N, (unsigned char*)(ws + WS_O), scr, it, F.lane);
    { GAS v4u* z0 = (GAS v4u*)(ws + WS_O + (size_t)EV_N * D); const size_t n0 = (size_t)(EV_NP - EV_N) * D / 16;
      for (size_t i = gtid; i < n0; i += gthreads) z0[i] = (v4u){0u, 0u, 0u, 0u}; }
    for (int m = gw; m < T; m += NGW) rms_row_to_f8(A.in[I_X] + (size_t)m * D, A.in[I_NMIX], (unsigned char*)(ws + WS_H1) + (size_t)m * D, F.lane);
#endif
}
__device__ __forceinline__ void p0_deferred(const Args& A, Frame& F, int wg, int nwg) {
    const int gw = wg * NWAVES + F.wave, NGW = nwg * NWAVES;
    int gtid = gw * 64 + F.lane; const int gthreads = nwg * NTHREADS;
    asm volatile("" : "+v"(gtid));
    unsigned char* ws = A.ws;
    {
        LAS float* scr = (LAS float*)(F.lds + RING_OFF + F.wave * 16384);
        constexpr int I_SQ = (D / 64) * (D / 32), I_ODIN = (D / 64) * (OD_N / 32);
        constexpr int NITEMS = I_SQ + I_ODIN + I_SQ;
        for (int it = gw; it < NITEMS; it += NGW) {
            int r = it;
            if (r < I_SQ) { p0_transpose_item(A.in[I_EV_WOUT], D, D, (bf16*)(ws + WS_WEV_OUT), scr, r, F.lane); continue; } r -= I_SQ;
            if (r < I_ODIN) { p0_transpose_item_f8(A.in[I_OD_WIN], D, OD_N, (unsigned char*)(ws + WS_WOD_IN), scr, r, F.lane, A.in[I_NMIX] + D); continue; } r -= I_ODIN;
            p0_transpose_item_f8(A.in[I_PLE_WG], D, D, (unsigned char*)(ws + WS_WGATE), scr, r, F.lane, A.in[I_NPLE]);
        }
        { GAS v4u* z1 = (GAS v4u*)(ws + WS_WOD_IN + (size_t)OD_N * D); const size_t n1 = (size_t)(OD_NP - OD_N) * D / 16;
          for (size_t i = gtid; i < n1; i += gthreads) z1[i] = (v4u){0u, 0u, 0u, 0u}; }
    }
    __syncthreads();
    for (int it = wg; it < 512; it += nwg)
        p0_fold_item(A.in[I_PEER_WQ], A.in[I_PEER_SK], (bf16*)(ws + WS_WPEER), (LAS float*)(F.lds + RING_OFF), it, F.tid, A.in[I_NFFN]);
    cvt_rows_i8(A.in[I_PEER_U], (unsigned char*)(ws + WS_TABU), (float*)(ws + WS_SU), 16384, gw, NGW, F.lane, A.in[I_NFFN]);
    cvt_rows_i8(A.in[I_PEER_V], (unsigned char*)(ws + WS_TABV), (float*)(ws + WS_SU) + 32768, 16384, gw, NGW, F.lane, nullptr);
    { bf16* LB = (bf16*)(ws + WS_WLORA); const float* w2 = A.in[I_W2]; const float* a2 = A.in[I_A2]; const float* g2 = A.in[I_G2];
      for (int i = gtid; i < LORA_N * LORA_K / 2; i += gthreads) { const int row = i / (LORA_K / 2), col = (i % (LORA_K / 2)) * 2; float v[2];
#pragma unroll
          for (int e = 0; e < 2; ++e) { const int c = col + e; float x = 0.f;
              if (row < 1024) { if (c < 96) x = w2[c * 1024 + row]; }
              else if (row < 2048) { if (c >= 96 && c < 192) x = a2[(c - 96) * 1024 + (row - 1024)]; }
              else { if (c >= 192 && c < 448) x = g2[(c - 192) * 1024 + (row - 2048)]; }
              v[e] = x; }
          *(GAS unsigned*)(LB + (size_t)row * LORA_K + col) = pk2(v[0], v[1]); } }
}
__device__ __forceinline__ void p1_deferred(const Args& A, Frame& F, int wg, int nwg) {
    const int gw = wg * NWAVES + F.wave, NGW = nwg * NWAVES;
    int gtid = gw * 64 + F.lane; const int gthreads = nwg * NTHREADS;
    asm volatile("" : "+v"(gtid));
    unsigned char* ws = A.ws;
    { LAS float* scr = (LAS float*)(F.lds + RING_OFF + F.wave * 16384); constexpr int I_SQ = (D / 64) * (D / 32);
      for (int it = gw; it < 2 * I_SQ; it += NGW) {
          if (it < I_SQ) p0_transpose_item_f8(A.in[I_OD_WOUT], D, D, (unsigned char*)(ws + WS_WOD_OUT), scr, it, F.lane);
          else p0_transpose_item_f8(A.in[I_PLE_WG] + (size_t)D * D, D, D, (unsigned char*)((bf16*)(ws + WS_WGATE) + (size_t)D * D), scr, it - I_SQ, F.lane, A.in[I_NPLE] + D); } }
    __syncthreads();
    for (int it = wg; it < 512; it += nwg)
        p0_fold_item(A.in[I_PEER_WQ] + (size_t)D * D, A.in[I_PEER_SK] + (size_t)16 * 128 * 128, (bf16*)(ws + WS_WPEER) + (size_t)D * D, (LAS float*)(F.lds + RING_OFF), it, F.tid, A.in[I_NFFN] + D);
    cvt_rows_i8(A.in[I_PEER_U] + (size_t)16384 * D, (unsigned char*)(ws + WS_TABU) + (size_t)16384 * D, (float*)(ws + WS_SU) + 16384, 16384, gw, NGW, F.lane, A.in[I_NFFN] + D);
    cvt_rows_i8(A.in[I_PEER_V] + (size_t)16384 * D, (unsigned char*)(ws + WS_TABV) + (size_t)16384 * D, (float*)(ws + WS_SU) + 32768 + 16384, 16384, gw, NGW, F.lane, nullptr);
}

constexpr int TC = 16, NCHUNK = SEQ / TC;

template <int MODE>
__device__ __forceinline__ void scan_gla_unit(const Args& A, Frame& F, int unit) {
    int tid = F.tid; asm volatile("" : "+v"(tid));
    const int lane = tid & 63, w = F.wave;
    int b, h, qcol, kcol, vcol, ocol;
    if (MODE == 0) { b = unit >> 4; h = (unit >> 2) & 3; const int s = unit & 3; qcol = EC_GQ + h * 128; kcol = EC_GK + h * 128; vcol = EC_GV + h * 256 + s * 64; ocol = h * 256 + s * 64; }
    else           { b = unit >> 4; h = (unit >> 1) & 7; const int s = unit & 1; qcol = OC_HQ + h * 128; kcol = OC_HF + h * 128; vcol = OC_HI + h * 128 + s * 64; ocol = h * 128 + s * 64; }
    const bf16* P = (const bf16*)(A.ws + WS_PROJ) + (size_t)b * SEQ * PROJ_LD;
    float* O = (float*)(A.ws + WS_O) + (size_t)b * SEQ * D + ocol;
    LAS float* Lf = (LAS float*)(F.lds + RING_OFF);
    constexpr int BUFSZ = 7168, O_EG = 0, O_K = 2048, O_Q = 4096, O_V = 6144, O_OUT = 2 * BUFSZ, O_W2 = O_OUT + 1024, O_BIAS = O_W2 + 2048;
    const int tl = tid >> 5, dq = (tid & 31) * 4, tlv = tid >> 4, c4 = (tid & 15) * 4;
    float lb[4] = {0.f, 0.f, 0.f, 0.f};
    if (MODE == 0) {
        const float* w2 = A.in[I_GK_W2]; const float* gb = A.in[I_GK_B];
        for (int i = tid; i < 2048; i += NTHREADS) Lf[O_W2 + i] = w2[(i >> 7) * 512 + h * 128 + (i & 127)];
        if (tid < 128) Lf[O_BIAS + tid] = gb[h * 128 + tid];
    } else {
        const float* lg = A.in[I_LB];
#pragma unroll
        for (int i = 0; i < 4; ++i) lb[i] = sigmoidf_(lg[1024 + h * 128 + dq + i] - lg[h * 128 + dq + i]);
    }
    u32x2 rq, rk, rv = {0u, 0u}; v4u rg0 = {0u, 0u, 0u, 0u}, rg1 = {0u, 0u, 0u, 0u};
#define GLA_LOAD(c) do { const bf16* pr = P + (size_t)((c) * TC + tl) * PROJ_LD; rq = *(const GAS u32x2*)(pr + qcol + dq); rk = *(const GAS u32x2*)(pr + kcol + dq); \
        if (MODE == 0) { rg0 = *(const GAS v4u*)(pr + EC_GLR); rg1 = *(const GAS v4u*)(pr + EC_GLR + 8); } \
        if (tid < 256) rv = *(const GAS u32x2*)(P + (size_t)((c) * TC + tlv) * PROJ_LD + vcol + c4); } while (0)
#define GLA_XFORM(bufi) do { LAS float* B_ = Lf + (bufi) * BUFSZ; f32x4 q4, k4, e4; \
        const float xq[4] = {bf_lo(rq.x), bf_hi(rq.x), bf_lo(rq.y), bf_hi(rq.y)}, xk[4] = {bf_lo(rk.x), bf_hi(rk.x), bf_lo(rk.y), bf_hi(rk.y)}; \
        if (MODE == 0) { f32x4 z = *(const LAS f32x4*)(Lf + O_BIAS + dq); \
            const float gl[16] = {bf_lo(rg0.x), bf_hi(rg0.x), bf_lo(rg0.y), bf_hi(rg0.y), bf_lo(rg0.z), bf_hi(rg0.z), bf_lo(rg0.w), bf_hi(rg0.w), \
                                  bf_lo(rg1.x), bf_hi(rg1.x), bf_lo(rg1.y), bf_hi(rg1.y), bf_lo(rg1.z), bf_hi(rg1.z), bf_lo(rg1.w), bf_hi(rg1.w)}; \
            _Pragma("unroll") for (int r_ = 0; r_ < 16; ++r_) { const f32x4 wv = *(const LAS f32x4*)(Lf + O_W2 + r_ * 128 + dq); z = z + wv * gl[r_]; } \
            _Pragma("unroll") for (int i_ = 0; i_ < 4; ++i_) { q4[i_] = xq[i_] * 0.08838834764831845f; k4[i_] = xk[i_]; e4[i_] = __builtin_amdgcn_exp2f(-0.0625f * __builtin_amdgcn_logf(1.0f + __expf(-z[i_]))); } } \
        else { _Pragma("unroll") for (int i_ = 0; i_ < 4; ++i_) { const float fg = lb[i_] + (1.f - lb[i_]) * sigmoidf_(xk[i_]); q4[i_] = siluf_(xq[i_]); k4[i_] = 1.f - fg; e4[i_] = fg; } } \
        *(LAS f32x4*)(B_ + O_EG + tl * 128 + dq) = e4; *(LAS f32x4*)(B_ + O_K + tl * 128 + dq) = k4; *(LAS f32x4*)(B_ + O_Q + tl * 128 + dq) = q4; \
        if (tid < 256) { f32x4 v4 = {bf_lo(rv.x), bf_hi(rv.x), bf_lo(rv.y), bf_hi(rv.y)}; *(LAS f32x4*)(B_ + O_V + tlv * 64 + c4) = v4; } } while (0)
    LBAR();
    GLA_LOAD(0); GLA_XFORM(0);
    LBAR();
    f32x2 S2[8];
#pragma unroll
    for (int i = 0; i < 8; ++i) S2[i] = (f32x2){0.f, 0.f};
    const int j = lane & 15, col = w * 8 + (lane >> 4) * 2;
    for (int c = 0; c < NCHUNK; ++c) {
        if (c + 1 < NCHUNK) GLA_LOAD(c + 1);
        const LAS float* B_ = Lf + (c & 1) * BUFSZ;
        float os0 = 0.f, os1 = 0.f;
        f32x4 e0, e1, k0, k1, q0, q1, ne0, ne1, nk0, nk1, nq0, nq1; f32x2 v2, nv2;
#define GLA_LDSTEP(t_, E0, E1, K0, K1, Q0, Q1, V2) do { E0 = *(const LAS f32x4*)(B_ + O_EG + (t_) * 128 + 4 * j); E1 = *(const LAS f32x4*)(B_ + O_EG + (t_) * 128 + 64 + 4 * j); \
            K0 = *(const LAS f32x4*)(B_ + O_K + (t_) * 128 + 4 * j); K1 = *(const LAS f32x4*)(B_ + O_K + (t_) * 128 + 64 + 4 * j); \
            Q0 = *(const LAS f32x4*)(B_ + O_Q + (t_) * 128 + 4 * j); Q1 = *(const LAS f32x4*)(B_ + O_Q + (t_) * 128 + 64 + 4 * j); V2 = *(const LAS f32x2*)(B_ + O_V + (t_) * 64 + col); } while (0)
        GLA_LDSTEP(0, e0, e1, k0, k1, q0, q1, v2);
#pragma unroll
        for (int t = 0; t < TC; ++t) {
            if (t + 1 < TC) { GLA_LDSTEP(t + 1, ne0, ne1, nk0, nk1, nq0, nq1, nv2); }
            __builtin_amdgcn_sched_barrier(0);
            f32x2 pa = {0.f, 0.f}, pb = {0.f, 0.f};
#pragma unroll
            for (int i = 0; i < 4; ++i) {
                S2[i] = S2[i] * e0[i] + v2 * k0[i]; S2[4 + i] = S2[4 + i] * e1[i] + v2 * k1[i];
                pa += S2[i] * q0[i]; pb += S2[4 + i] * q1[i]; }
            pa += pb;
            float p0 = pa[0], p1 = pa[1];
            row_sum16_x2(p0, p1);
            os0 = (j == t) ? p0 : os0; os1 = (j == t) ? p1 : os1;
            e0 = ne0; e1 = ne1; k0 = nk0; k1 = nk1; q0 = nq0; q1 = nq1; v2 = nv2;
        }
#undef GLA_LDSTEP
        { f32x2 o2 = {os0, os1}; *(LAS f32x2*)(Lf + O_OUT + j * 64 + col) = o2; }
        if (c + 1 < NCHUNK) GLA_XFORM((c + 1) & 1);
        LBAR();
        if (tid < 256) *(GAS f32x4*)(O + (size_t)(c * TC + tlv) * D + c4) = *(const LAS f32x4*)(Lf + O_OUT + tlv * 64 + c4);
        LBAR();
    }
#undef GLA_LOAD
#undef GLA_XFORM
}

__device__ __forceinline__ void scan_gdn_unit(const Args& A, Frame& F, int unit) {
    int tid = F.tid; asm volatile("" : "+v"(tid));
    const int lane = tid & 63, w = F.wave;
    const int b = unit >> 4, h = (unit >> 1) & 7, s = unit & 1;
    const int qcol = EC_BQ + h * 128, kcol = EC_BK + h * 128, vcol = EC_BV + h * 128 + s * 64, ocol = 1024 + h * 128 + s * 64;
    const bf16* P = (const bf16*)(A.ws + WS_PROJ) + (size_t)b * SEQ * PROJ_LD;
    float* O = (float*)(A.ws + WS_O) + (size_t)b * SEQ * D + ocol;
    LAS float* Lf = (LAS float*)(F.lds + RING_OFF);
    constexpr int BUFSZ = 5184, O_K = 0, O_Q = 2048, O_V = 4096, O_SC = 5120, O_OUT = 2 * BUFSZ, O_CW = O_OUT + 1024;
    const int tl = tid >> 5, dq = (tid & 31) * 4, tlv = tid >> 4, c4 = (tid & 15) * 4;
    { const float* cw = A.in[I_GDN_CONV];
      for (int i = tid; i < 4 * 320; i += NTHREADS) { const int jt = i / 320, x = i % 320;
          const int ch = x < 128 ? (h * 128 + x) : x < 256 ? (1024 + h * 128 + (x - 128)) : (2048 + h * 128 + s * 64 + (x - 256));
          Lf[O_CW + i] = cw[jt * 3072 + ch]; } }
    const float neg_ea = -__expf(A.in[I_GDN_ALOG][h]), dtb = A.in[I_GDN_DTB][h];
    u32x2 rq[4], rk[4], rv[4]; unsigned short rba = 0, rbb = 0;
#pragma unroll
    for (int i = 0; i < 4; ++i) rv[i] = (u32x2){0u, 0u};
#define GDN_LOAD(c) do { const int t_ = (c) * TC + tl; \
        _Pragma("unroll") for (int jt = 0; jt < 4; ++jt) { const int tt = t_ - 3 + jt; \
            if (tt >= 0) { const bf16* pr = P + (size_t)tt * PROJ_LD; rq[jt] = *(const GAS u32x2*)(pr + qcol + dq); rk[jt] = *(const GAS u32x2*)(pr + kcol + dq); } \
            else { rq[jt] = (u32x2){0u, 0u}; rk[jt] = (u32x2){0u, 0u}; } } \
        { const bf16* pr = P + (size_t)t_ * PROJ_LD; rba = pr[EC_BA + h]; rbb = pr[EC_BB + h]; } \
        if (tid < 256) { const int tv = (c) * TC + tlv; \
            _Pragma("unroll") for (int jt = 0; jt < 4; ++jt) { const int tt = tv - 3 + jt; \
                if (tt >= 0) rv[jt] = *(const GAS u32x2*)(P + (size_t)tt * PROJ_LD + vcol + c4); else rv[jt] = (u32x2){0u, 0u}; } } } while (0)
#define GDN_XFORM(bufi) do { LAS float* B_ = Lf + (bufi) * BUFSZ; f32x4 q4 = {0.f, 0.f, 0.f, 0.f}, k4 = {0.f, 0.f, 0.f, 0.f}; \
        _Pragma("unroll") for (int jt = 0; jt < 4; ++jt) { const f32x4 wq = *(const LAS f32x4*)(Lf + O_CW + jt * 320 + dq), wk = *(const LAS f32x4*)(Lf + O_CW + jt * 320 + 128 + dq); \
            q4[0] += wq[0] * bf_lo(rq[jt].x); q4[1] += wq[1] * bf_hi(rq[jt].x); q4[2] += wq[2] * bf_lo(rq[jt].y); q4[3] += wq[3] * bf_hi(rq[jt].y); \
            k4[0] += wk[0] * bf_lo(rk[jt].x); k4[1] += wk[1] * bf_hi(rk[jt].x); k4[2] += wk[2] * bf_lo(rk[jt].y); k4[3] += wk[3] * bf_hi(rk[jt].y); } \
        float sq = 0.f, sk = 0.f, sqk = 0.f; \
        _Pragma("unroll") for (int i_ = 0; i_ < 4; ++i_) { q4[i_] = siluf_(q4[i_]); k4[i_] = siluf_(k4[i_]); sq += q4[i_] * q4[i_]; sk += k4[i_] * k4[i_]; sqk += q4[i_] * k4[i_]; } \
        sq = half_sum32(sq); sk = half_sum32(sk); sqk = half_sum32(sqk); \
        const float rq_ = __builtin_amdgcn_rsqf(sq + EPS) * 0.08838834764831845f, rk_ = __builtin_amdgcn_rsqf(sk + EPS); \
        q4 = q4 * rq_; k4 = k4 * rk_; \
        *(LAS f32x4*)(B_ + O_K + tl * 128 + dq) = k4; *(LAS f32x4*)(B_ + O_Q + tl * 128 + dq) = q4; \
        if ((tid & 31) == 0) { const float ba = __uint_as_float((unsigned)rba << 16), bb = __uint_as_float((unsigned)rbb << 16); \
            f32x4 sc; sc[0] = __expf(neg_ea * softplusf_(ba + dtb)); sc[1] = sigmoidf_(bb); sc[2] = sqk * rq_ * rk_; sc[3] = 0.f; *(LAS f32x4*)(B_ + O_SC + tl * 4) = sc; } \
        if (tid < 256) { f32x4 v4 = {0.f, 0.f, 0.f, 0.f}; \
            _Pragma("unroll") for (int jt = 0; jt < 4; ++jt) { const f32x4 wv = *(const LAS f32x4*)(Lf + O_CW + jt * 320 + 256 + c4); \
                v4[0] += wv[0] * bf_lo(rv[jt].x); v4[1] += wv[1] * bf_hi(rv[jt].x); v4[2] += wv[2] * bf_lo(rv[jt].y); v4[3] += wv[3] * bf_hi(rv[jt].y); } \
            _Pragma("unroll") for (int i_ = 0; i_ < 4; ++i_) v4[i_] = siluf_(v4[i_]); \
            *(LAS f32x4*)(B_ + O_V + tlv * 64 + c4) = v4; } } while (0)
    LBAR();
    GDN_LOAD(0); GDN_XFORM(0);
    LBAR();
    f32x2 S2[8];
#pragma unroll
    for (int i = 0; i < 8; ++i) S2[i] = (f32x2){0.f, 0.f};
    const int j = lane & 15, col = w * 8 + (lane >> 4) * 2;
    for (int c = 0; c < NCHUNK; ++c) {
        if (c + 1 < NCHUNK) GDN_LOAD(c + 1);
        const LAS float* B_ = Lf + (c & 1) * BUFSZ;
        float os0 = 0.f, os1 = 0.f;
        f32x4 k0, k1, q0, q1, sc, nk0, nk1, nq0, nq1, nsc; f32x2 v2, nv2;
#define GDN_LDSTEP(t_, K0, K1, Q0, Q1, V2, SC) do { K0 = *(const LAS f32x4*)(B_ + O_K + (t_) * 128 + 4 * j); K1 = *(const LAS f32x4*)(B_ + O_K + (t_) * 128 + 64 + 4 * j); \
            Q0 = *(const LAS f32x4*)(B_ + O_Q + (t_) * 128 + 4 * j); Q1 = *(const LAS f32x4*)(B_ + O_Q + (t_) * 128 + 64 + 4 * j); V2 = *(const LAS f32x2*)(B_ + O_V + (t_) * 64 + col); SC = *(const LAS f32x4*)(B_ + O_SC + (t_) * 4); } while (0)
        GDN_LDSTEP(0, k0, k1, q0, q1, v2, sc);
#pragma unroll
        for (int t = 0; t < TC; ++t) {
            if (t + 1 < TC) { GDN_LDSTEP(t + 1, nk0, nk1, nq0, nq1, nv2, nsc); }
            __builtin_amdgcn_sched_barrier(0);
            f32x2 d1 = {0.f, 0.f}, d2 = {0.f, 0.f}, e1 = {0.f, 0.f}, e2 = {0.f, 0.f};
#pragma unroll
            for (int i = 0; i < 4; ++i) { d1 += S2[i] * k0[i]; e1 += S2[4 + i] * k1[i]; d2 += S2[i] * q0[i]; e2 += S2[4 + i] * q1[i]; }
            d1 += e1; d2 += e2;
            { float r0_ = d1[0], r1_ = d1[1], r2_ = d2[0], r3_ = d2[1]; row_sum16_x4(r0_, r1_, r2_, r3_); d1[0] = r0_; d1[1] = r1_; d2[0] = r2_; d2[1] = r3_; }
            const float a = sc[0], beta = sc[1], qk = sc[2];
            const f32x2 dl = (v2 - d1 * a) * beta;
            const f32x2 o2 = d2 * a + dl * qk;
#pragma unroll
            for (int i = 0; i < 4; ++i) { S2[i] = S2[i] * a + dl * k0[i]; S2[4 + i] = S2[4 + i] * a + dl * k1[i]; }
            os0 = (j == t) ? o2[0] : os0; os1 = (j == t) ? o2[1] : os1;
            k0 = nk0; k1 = nk1; q0 = nq0; q1 = nq1; v2 = nv2; sc = nsc;
        }
#undef GDN_LDSTEP
        { f32x2 o2 = {os0, os1}; *(LAS f32x2*)(Lf + O_OUT + j * 64 + col) = o2; }
        if (c + 1 < NCHUNK) GDN_XFORM((c + 1) & 1);
        LBAR();
        if (tid < 256) *(GAS f32x4*)(O + (size_t)(c * TC + tlv) * D + c4) = *(const LAS f32x4*)(Lf + O_OUT + tlv * 64 + c4);
        LBAR();
    }
#undef GDN_LOAD
#undef GDN_XFORM
}

typedef short bf16x4_t __attribute__((ext_vector_type(4)));
__device__ __forceinline__ bf16x8 mk_frag(u32x2 lo, u32x2 hi) { v4u t; t.x = lo.x; t.y = lo.y; t.z = hi.x; t.w = hi.y; return __builtin_bit_cast(bf16x8, t); }
template <int MODE>
__device__ __forceinline__ void scan_gla_mfma_unit(const Args& A, Frame& F, int unit) {
    int tid = F.tid; asm volatile("" : "+v"(tid));
    const int lane = tid & 63, w = F.wave;
    int b, h, qcol, kcol, vcol, ocol;
    if (MODE == 0) { b = unit >> 3; h = (unit >> 1) & 3; const int s = unit & 1; qcol = EC_GQ + h * 128; kcol = EC_GK + h * 128; vcol = EC_GV + h * 256 + s * 128; ocol = h * 256 + s * 128; }
    else           { b = unit >> 3; h = unit & 7; qcol = OC_HQ + h * 128; kcol = OC_HF + h * 128; vcol = OC_HI + h * 128; ocol = h * 128; }
    const bf16* P = (const bf16*)(A.ws + WS_PROJ) + (size_t)b * SEQ * PROJ_LD;
    bf16* O = (bf16*)(A.ws + WS_O) + (size_t)b * SEQ * D + ocol;
    LAS float* Lf = (LAS float*)(F.lds + RING_OFF);
    constexpr int BUFSZ = MODE == 1 ? 10240 : 8192, O_E = 0, O_K = 2048, O_Q = 4096, O_V = 6144, O_Z = 8192, RS = 136,
        O_QB = 2 * BUFSZ, O_KB = O_QB + 1088, O_KT = O_KB + 1088, O_BL = O_KT + 1024, O_AM = O_BL + 128, O_W2 = O_AM + 128, O_BIAS = O_W2 + 2048;
    LAS bf16* QB = (LAS bf16*)(Lf + O_QB); LAS bf16* KB = (LAS bf16*)(Lf + O_KB); LAS bf16* KT = (LAS bf16*)(Lf + O_KT); LAS bf16* AM = (LAS bf16*)(Lf + O_AM);
    const int tl = tid >> 5, dq = (tid & 31) * 4;
    float lb[4] = {0.f, 0.f, 0.f, 0.f};
    if (MODE == 0) {
        const float* w2 = A.in[I_GK_W2]; const float* gb = A.in[I_GK_B];
        for (int i = tid; i < 2048; i += NTHREADS) Lf[O_W2 + i] = w2[(i >> 7) * 512 + h * 128 + (i & 127)];
        if (tid < 128) Lf[O_BIAS + tid] = gb[h * 128 + tid];
    } else {
        const float* lg = A.in[I_LB];
#pragma unroll
        for (int i = 0; i < 4; ++i) lb[i] = sigmoidf_(lg[1024 + h * 128 + dq + i] - lg[h * 128 + dq + i]);
    }
    u32x2 rq, rk, rv, rz = {0u, 0u}; v4u rg0 = {0u, 0u, 0u, 0u}, rg1 = {0u, 0u, 0u, 0u};
#define GM_LOAD(c) do { const bf16* pr = P + (size_t)((c) * TC + tl) * PROJ_LD; rq = *(const GAS u32x2*)(pr + qcol + dq); rk = *(const GAS u32x2*)(pr + kcol + dq); rv = *(const GAS u32x2*)(pr + vcol + dq); \
        if (MODE == 0) { rg0 = *(const GAS v4u*)(pr + EC_GLR); rg1 = *(const GAS v4u*)(pr + EC_GLR + 8); } else rz = *(const GAS u32x2*)(pr + OC_HG + h * 128 + dq); } while (0)
#define GM_XFORM(bufi) do { LAS float* B_ = Lf + (bufi) * BUFSZ; f32x4 q4, k4, e4; \
        const float xq[4] = {bf_lo(rq.x), bf_hi(rq.x), bf_lo(rq.y), bf_hi(rq.y)}, xk[4] = {bf_lo(rk.x), bf_hi(rk.x), bf_lo(rk.y), bf_hi(rk.y)}; \
        if (MODE == 0) { f32x4 z = *(const LAS f32x4*)(Lf + O_BIAS + dq); \
            const float gl[16] = {bf_lo(rg0.x), bf_hi(rg0.x), bf_lo(rg0.y), bf_hi(rg0.y), bf_lo(rg0.z), bf_hi(rg0.z), bf_lo(rg0.w), bf_hi(rg0.w), \
                                  bf_lo(rg1.x), bf_hi(rg1.x), bf_lo(rg1.y), bf_hi(rg1.y), bf_lo(rg1.z), bf_hi(rg1.z), bf_lo(rg1.w), bf_hi(rg1.w)}; \
            _Pragma("unroll") for (int r_ = 0; r_ < 16; ++r_) { const f32x4 wv = *(const LAS f32x4*)(Lf + O_W2 + r_ * 128 + dq); z = z + wv * gl[r_]; } \
            _Pragma("unroll") for (int i_ = 0; i_ < 4; ++i_) { q4[i_] = xq[i_] * 0.08838834764831845f; k4[i_] = xk[i_]; e4[i_] = __builtin_amdgcn_exp2f(-0.0625f * __builtin_amdgcn_logf(1.0f + __expf(-z[i_]))); } } \
        else { _Pragma("unroll") for (int i_ = 0; i_ < 4; ++i_) { const float fg = lb[i_] + (1.f - lb[i_]) * sigmoidf_(xk[i_]); q4[i_] = siluf_(xq[i_]); k4[i_] = 1.f - fg; e4[i_] = fg; } } \
        *(LAS f32x4*)(B_ + O_E + tl * 128 + dq) = e4; *(LAS f32x4*)(B_ + O_K + tl * 128 + dq) = k4; *(LAS f32x4*)(B_ + O_Q + tl * 128 + dq) = q4; \
        { f32x4 v4 = {bf_lo(rv.x), bf_hi(rv.x), bf_lo(rv.y), bf_hi(rv.y)}; *(LAS f32x4*)(B_ + O_V + tl * 128 + dq) = v4; } \
        if (MODE == 1) { f32x4 z4 = {siluf_(bf_lo(rz.x)), siluf_(bf_hi(rz.x)), siluf_(bf_lo(rz.y)), siluf_(bf_hi(rz.y))}; *(LAS f32x4*)(B_ + O_Z + tl * 128 + dq) = z4; } } while (0)
    LBAR();
    GM_LOAD(0); GM_XFORM(0); GM_LOAD(1);
    LBAR();
    f32x4 Sacc[8];
#pragma unroll
    for (int i = 0; i < 8; ++i) Sacc[i] = (f32x4){0.f, 0.f, 0.f, 0.f};
    const int fr = lane & 15, g = lane >> 4, c0 = w * 16;
    LAS float* PART = Lf + O_BIAS + 128;
    unsigned char* Y8 = (unsigned char*)(A.ws + WS_ACTA) + (size_t)b * SEQ * D + ocol;
    float gn = 0.f; f32x4 oprev = {0.f, 0.f, 0.f, 0.f}; float zprev[4] = {0.f, 0.f, 0.f, 0.f};
    if (MODE == 1) gn = A.in[I_HG_NORM][c0 + fr];
#define HG_FINISH(cc) do { const LAS float* pp_ = PART + ((cc) & 1) * 128; \
        _Pragma("unroll") for (int r = 0; r < 4; ++r) { const int t_ = 4 * g + r; const f32x4 p0_ = *(const LAS f32x4*)(pp_ + t_ * 8), p1_ = *(const LAS f32x4*)(pp_ + t_ * 8 + 4); \
            const float s_ = ((p0_[0] + p0_[1]) + (p0_[2] + p0_[3])) + ((p1_[0] + p1_[1]) + (p1_[2] + p1_[3])); const float rt_ = __builtin_amdgcn_rsqf(s_ * (1.0f / 128.0f) + EPS); \
            const float y_ = oprev[r] * rt_ * gn * zprev[r]; \
            Y8[(size_t)((cc) * TC + t_) * D + c0 + fr] = (unsigned char)(__builtin_amdgcn_cvt_pk_fp8_f32(y_, y_, 0, false) & 0xff); } } while (0)
    for (int c = 0; c < NCHUNK; ++c) {
        const LAS float* B_ = Lf + (c & 1) * BUFSZ;
        {
            const int seg = tid >> 7, d = tid & 127;
            float bt = 1.f, ball = 1.f;
#pragma unroll
            for (int t = 0; t < 16; ++t) { const float e = B_[O_E + t * 128 + d]; ball *= e; if (t < 4 * seg) bt = ball; }
            ball = fmaxf(ball, 1e-30f);
            unsigned short kt4[4];
#pragma unroll
            for (int i = 0; i < 4; ++i) { const int t = 4 * seg + i; bt = fmaxf(bt * B_[O_E + t * 128 + d], 1e-30f);
                const float kk = B_[O_K + t * 128 + d], qq = B_[O_Q + t * 128 + d], ib = __builtin_amdgcn_rcpf(bt);
                QB[t * RS + d] = hw_bf(qq * bt); KB[t * RS + d] = hw_bf(kk * ib); kt4[i] = (unsigned short)hw_bf(kk * ball * ib); }
            u32x2 kw; kw.x = (unsigned)kt4[0] | ((unsigned)kt4[1] << 16); kw.y = (unsigned)kt4[2] | ((unsigned)kt4[3] << 16);
            *(LAS u32x2*)(KT + d * 16 + 4 * seg) = kw;
            if (seg == 3) Lf[O_BL + d] = ball;
        }
        LBAR();
        if (MODE == 1 && c > 0) HG_FINISH(c - 1);
        if (w == 0) {
            f32x4 acc = {0.f, 0.f, 0.f, 0.f};
#pragma unroll
            for (int ks = 0; ks < 4; ++ks) { const bf16x8 af = *(const LAS bf16x8*)(QB + fr * RS + 32 * ks + 8 * g), bfm = *(const LAS bf16x8*)(KB + fr * RS + 32 * ks + 8 * g);
                acc = __builtin_amdgcn_mfma_f32_16x16x32_bf16(af, bfm, acc, 0, 0, 0); }
#pragma unroll
            for (int r = 0; r < 4; ++r) { const int t = 4 * g + r, s = fr; AM[t * 16 + s] = hw_bf(s <= t ? acc[r] : 0.f); }
        }
        if (c + 1 < NCHUNK) GM_XFORM((c + 1) & 1);
        if (c + 2 < NCHUNK) GM_LOAD(c + 2);
        LBAR();
        {
            u32x2 vlo; { const float v0 = B_[O_V + (4 * g + 0) * 128 + c0 + fr], v1 = B_[O_V + (4 * g + 1) * 128 + c0 + fr], v2 = B_[O_V + (4 * g + 2) * 128 + c0 + fr], v3 = B_[O_V + (4 * g + 3) * 128 + c0 + fr];
                vlo.x = hw_pk2(v0, v1); vlo.y = hw_pk2(v2, v3); }
            const u32x2 zz = {0u, 0u};
            const bf16x8 vb = mk_frag(vlo, zz);
            f32x4 acco = {0.f, 0.f, 0.f, 0.f};
#pragma unroll
            for (int ks = 0; ks < 4; ++ks) {
                u32x2 slo, shi; slo.x = hw_pk2(Sacc[2 * ks][0], Sacc[2 * ks][1]); slo.y = hw_pk2(Sacc[2 * ks][2], Sacc[2 * ks][3]); shi.x = hw_pk2(Sacc[2 * ks + 1][0], Sacc[2 * ks + 1][1]); shi.y = hw_pk2(Sacc[2 * ks + 1][2], Sacc[2 * ks + 1][3]);
                const bf16x8 sb = mk_frag(slo, shi);
                const u32x2 qlo = *(const LAS u32x2*)(QB + fr * RS + 32 * ks + 4 * g), qhi = *(const LAS u32x2*)(QB + fr * RS + 32 * ks + 16 + 4 * g);
                acco = __builtin_amdgcn_mfma_f32_16x16x32_bf16(mk_frag(qlo, qhi), sb, acco, 0, 0, 0); }
            { const u32x2 alo = *(const LAS u32x2*)(AM + fr * 16 + 4 * g); acco = __builtin_amdgcn_mfma_f32_16x16x32_bf16(mk_frag(alo, zz), vb, acco, 0, 0, 0); }
#pragma unroll
            for (int r = 0; r < 4; ++r) { if (MODE == 0) O[(size_t)(c * TC + 4 * g + r) * D + c0 + fr] = hw_bf(acco[r]); }
            if (MODE == 1) { float q0 = acco[0] * acco[0], q1 = acco[1] * acco[1], q2 = acco[2] * acco[2], q3 = acco[3] * acco[3]; row_sum16_x4(q0, q1, q2, q3);
                if (fr == 0) { LAS float* pw_ = PART + (c & 1) * 128 + (4 * g) * 8 + w; pw_[0] = q0; pw_[8] = q1; pw_[16] = q2; pw_[24] = q3; }
                oprev = acco;
#pragma unroll
                for (int r = 0; r < 4; ++r) zprev[r] = B_[O_Z + (4 * g + r) * 128 + c0 + fr]; }
#pragma unroll
            for (int i = 0; i < 8; ++i) { const f32x4 bl = *(const LAS f32x4*)(Lf + O_BL + 16 * i + 4 * g); const u32x2 klo = *(const LAS u32x2*)(KT + (16 * i + fr) * 16 + 4 * g);
                Sacc[i] = __builtin_amdgcn_mfma_f32_16x16x32_bf16(mk_frag(klo, zz), vb, Sacc[i] * bl, 0, 0, 0); }
        }
        LBAR();
    }
    if (MODE == 1) HG_FINISH(NCHUNK - 1);
#undef HG_FINISH
#undef GM_LOAD
#undef GM_XFORM
}

__device__ __forceinline__ void scan_gdn_mfma_unit(const Args& A, Frame& F, int unit, const int role) {
    int tid = F.tid; asm volatile("" : "+v"(tid));
    const int lane = tid & 63, w = F.wave;
    const int b = unit >> 3, h = unit & 7;
    const int qcol = EC_BQ + h * 128, kcol = EC_BK + h * 128, vcol = EC_BV + h * 128, ocol = 1024 + h * 128;
    const bf16* P = (const bf16*)(A.ws + WS_PROJ) + (size_t)b * SEQ * PROJ_LD;
    bf16* O = (bf16*)(A.ws + WS_O) + (size_t)b * SEQ * D + ocol;
    LAS float* Lf = (LAS float*)(F.lds + RING_OFF);
    constexpr int O_CW = 0, O_AMAT = 1536, O_QKM = O_AMAT + 256, O_TB = O_QKM + 128, O_GL = O_TB + 128, O_BUF0 = O_GL + 64;
    constexpr int BUFSZ = 6208, O_KH = 0, O_QH = 2048, O_VV = 4096, O_SC = 6144;
    constexpr int RS = 136;
    constexpr int O_KHB = O_BUF0 + 2 * BUFSZ, O_QHB = O_KHB + 1088, O_QB = O_QHB + 1088, O_KT = O_QB + 1088, O_WSRC = O_KT + 1024, O_WB = O_WSRC + 2048;
    LAS bf16* KHB = (LAS bf16*)(Lf + O_KHB); LAS bf16* QHB = (LAS bf16*)(Lf + O_QHB); LAS bf16* QB = (LAS bf16*)(Lf + O_QB); LAS bf16* KT = (LAS bf16*)(Lf + O_KT);
    LAS bf16* WB = (LAS bf16*)(Lf + O_WB); LAS bf16* QKM = (LAS bf16*)(Lf + O_QKM); LAS bf16* TB = (LAS bf16*)(Lf + O_TB);
    const int tl = tid >> 5, dq = (tid & 31) * 4;
    { const float* cw = A.in[I_GDN_CONV];
      for (int i = tid; i < 4 * 384; i += NTHREADS) { const int jt = i / 384, x = i % 384; Lf[O_CW + i] = cw[jt * 3072 + (x >> 7) * 1024 + h * 128 + (x & 127)]; } }
    const float neg_ea = -__expf(A.in[I_GDN_ALOG][h]), dtb = A.in[I_GDN_DTB][h];
    u32x2 rq[4], rk[4], rv[4]; unsigned short rba = 0, rbb = 0;
#define GD_LOAD(c) do { const int t_ = (c) * TC + tl; \
        _Pragma("unroll") for (int jt = 0; jt < 4; ++jt) { const int tt = t_ - 3 + jt; const bf16* pr = P + (size_t)(tt < 0 ? 0 : tt) * PROJ_LD + dq; \
            rq[jt] = *(const GAS u32x2*)(pr + qcol); rk[jt] = *(const GAS u32x2*)(pr + kcol); rv[jt] = *(const GAS u32x2*)(pr + vcol); \
            if (tt < 0) { rq[jt] = (u32x2){0u, 0u}; rk[jt] = (u32x2){0u, 0u}; rv[jt] = (u32x2){0u, 0u}; } } \
        { const bf16* pr = P + (size_t)t_ * PROJ_LD; rba = pr[EC_BA + h]; rbb = pr[EC_BB + h]; } } while (0)
#define GD_XFORM(bufi) do { LAS float* B_ = Lf + O_BUF0 + (bufi) * BUFSZ; f32x4 q4 = {0.f, 0.f, 0.f, 0.f}, k4 = {0.f, 0.f, 0.f, 0.f}, v4 = {0.f, 0.f, 0.f, 0.f}; \
        _Pragma("unroll") for (int jt = 0; jt < 4; ++jt) { const f32x4 wq = *(const LAS f32x4*)(Lf + O_CW + jt * 384 + dq), wk = *(const LAS f32x4*)(Lf + O_CW + jt * 384 + 128 + dq), wv = *(const LAS f32x4*)(Lf + O_CW + jt * 384 + 256 + dq); \
            q4[0] += wq[0] * bf_lo(rq[jt].x); q4[1] += wq[1] * bf_hi(rq[jt].x); q4[2] += wq[2] * bf_lo(rq[jt].y); q4[3] += wq[3] * bf_hi(rq[jt].y); \
            k4[0] += wk[0] * bf_lo(rk[jt].x); k4[1] += wk[1] * bf_hi(rk[jt].x); k4[2] += wk[2] * bf_lo(rk[jt].y); k4[3] += wk[3] * bf_hi(rk[jt].y); \
            v4[0] += wv[0] * bf_lo(rv[jt].x); v4[1] += wv[1] * bf_hi(rv[jt].x); v4[2] += wv[2] * bf_lo(rv[jt].y); v4[3] += wv[3] * bf_hi(rv[jt].y); } \
        float sq = 0.f, sk = 0.f; \
        _Pragma("unroll") for (int i_ = 0; i_ < 4; ++i_) { q4[i_] = siluf_(q4[i_]); k4[i_] = siluf_(k4[i_]); v4[i_] = siluf_(v4[i_]); sq += q4[i_] * q4[i_]; sk += k4[i_] * k4[i_]; } \
        row_sum16_x2(sq, sk); sq += __shfl_xor(sq, 16); sk += __shfl_xor(sk, 16); \
        q4 = q4 * (__builtin_amdgcn_rsqf(sq + EPS) * 0.08838834764831845f); k4 = k4 * __builtin_amdgcn_rsqf(sk + EPS); \
        *(LAS f32x4*)(B_ + O_KH + tl * 128 + dq) = k4; *(LAS f32x4*)(B_ + O_QH + tl * 128 + dq) = q4; *(LAS f32x4*)(B_ + O_VV + tl * 128 + dq) = v4; \
        if ((tid & 31) == 0) { const float ba = __uint_as_float((unsigned)rba << 16), bb = __uint_as_float((unsigned)rbb << 16); \
            B_[O_SC + tl] = __expf(neg_ea * softplusf_(ba + dtb)); B_[O_SC + 16 + tl] = sigmoidf_(bb); } } while (0)
    LBAR();
    constexpr int SPLIT = 58;
    const int c_begin = role ? SPLIT : 0, c_end = role ? NCHUNK : SPLIT;
    constexpr int REC = 5408;
    float* STASH = (float*)(A.ws + WS_LA) + (size_t)unit * (NCHUNK - SPLIT) * REC;
    float* STATE = (float*)(A.ws + WS_STATE) + (size_t)unit * 16384;
    gu32* flag = F.ctl + 32768 + unit * 64;
    GD_LOAD(c_begin); GD_XFORM(c_begin & 1); GD_LOAD(c_begin + 1);
    LBAR();
    f32x4 Sacc[8];
#pragma unroll
    for (int i = 0; i < 8; ++i) Sacc[i] = (f32x4){0.f, 0.f, 0.f, 0.f};
    const int fr = lane & 15, g = lane >> 4, c0 = w * 16;
    const u32x2 zz = {0u, 0u};
#define GD_STATE_PART(cc_) do { \
        { \
            bf16x8 sb[4]; \
_Pragma("unroll") \
            for (int ks = 0; ks < 4; ++ks) { u32x2 slo, shi; slo.x = hw_pk2(Sacc[2 * ks][0], Sacc[2 * ks][1]); slo.y = hw_pk2(Sacc[2 * ks][2], Sacc[2 * ks][3]); shi.x = hw_pk2(Sacc[2 * ks + 1][0], Sacc[2 * ks + 1][1]); shi.y = hw_pk2(Sacc[2 * ks + 1][2], Sacc[2 * ks + 1][3]); \
                sb[ks] = mk_frag(slo, shi); } \
            f32x4 accv = accu, acco = {0.f, 0.f, 0.f, 0.f}; \
_Pragma("unroll") \
            for (int ks = 0; ks < 4; ++ks) { \
                const u32x2 wl = *(const LAS u32x2*)(WB + fr * RS + 32 * ks + 4 * g), wh = *(const LAS u32x2*)(WB + fr * RS + 32 * ks + 16 + 4 * g); \
                accv = __builtin_amdgcn_mfma_f32_16x16x32_bf16(mk_frag(wl, wh), sb[ks], accv, 0, 0, 0); \
                const u32x2 ql = *(const LAS u32x2*)(QB + fr * RS + 32 * ks + 4 * g), qh = *(const LAS u32x2*)(QB + fr * RS + 32 * ks + 16 + 4 * g); \
                acco = __builtin_amdgcn_mfma_f32_16x16x32_bf16(mk_frag(ql, qh), sb[ks], acco, 0, 0, 0); } \
            u32x2 vn; vn.x = hw_pk2(accv[0], accv[1]); vn.y = hw_pk2(accv[2], accv[3]); \
            const bf16x8 vnb = mk_frag(vn, zz); \
            acco = __builtin_amdgcn_mfma_f32_16x16x32_bf16(mk_frag(*(const LAS u32x2*)(QKM + fr * 16 + 4 * g), zz), vnb, acco, 0, 0, 0); \
_Pragma("unroll") \
            for (int r = 0; r < 4; ++r) O[(size_t)((cc_) * TC + 4 * g + r) * D + c0 + fr] = hw_bf(acco[r]); \
_Pragma("unroll") \
            for (int i = 0; i < 8; ++i) { const u32x2 klo = *(const LAS u32x2*)(KT + (16 * i + fr) * 16 + 4 * g); \
                Sacc[i] = __builtin_amdgcn_mfma_f32_16x16x32_bf16(mk_frag(klo, zz), vnb, Sacc[i] * glast, 0, 0, 0); } \
        } \
        } while (0)
    for (int c = c_begin; c < c_end; ++c) {
        const LAS float* B_ = Lf + O_BUF0 + (c & 1) * BUFSZ;
        float glast;
        {
            const int seg = tid >> 7, d = tid & 127;
            const f32x4 a0 = *(const LAS f32x4*)(B_ + O_SC), a1 = *(const LAS f32x4*)(B_ + O_SC + 4), a2 = *(const LAS f32x4*)(B_ + O_SC + 8), a3 = *(const LAS f32x4*)(B_ + O_SC + 12);
            const float av[16] = {a0[0], a0[1], a0[2], a0[3], a1[0], a1[1], a1[2], a1[3], a2[0], a2[1], a2[2], a2[3], a3[0], a3[1], a3[2], a3[3]};
            float p = 1.f, gpre = 1.f;
#pragma unroll
            for (int t = 0; t < 16; ++t) { if (t == 4 * seg) gpre = p; p *= av[t]; }
            glast = p;
            unsigned short kt4[4]; float gt = gpre;
#pragma unroll
            for (int i = 0; i < 4; ++i) { const int t = 4 * seg + i; const float at = (seg == 0) ? av[i] : (seg == 1) ? av[4 + i] : (seg == 2) ? av[8 + i] : av[12 + i]; gt *= at; const float beta = B_[O_SC + 16 + t];
                const float kk = B_[O_KH + t * 128 + d], qq = B_[O_QH + t * 128 + d];
                KHB[t * RS + d] = hw_bf(kk); QHB[t * RS + d] = hw_bf(qq); QB[t * RS + d] = hw_bf(qq * gt);
                kt4[i] = (unsigned short)hw_bf(kk * glast * __builtin_amdgcn_rcpf(gt));
                Lf[O_WSRC + t * 128 + d] = kk * (beta * gt);
                if (d == 0) Lf[O_GL + t] = gt; }
            u32x2 kw; kw.x = (unsigned)kt4[0] | ((unsigned)kt4[1] << 16); kw.y = (unsigned)kt4[2] | ((unsigned)kt4[3] << 16);
            *(LAS u32x2*)(KT + d * 16 + 4 * seg) = kw;
        }
        LBAR();
        if (w < 2) {
            const LAS bf16* AS = (w == 0) ? KHB : QHB;
            f32x4 acc = {0.f, 0.f, 0.f, 0.f};
#pragma unroll
            for (int ks = 0; ks < 4; ++ks) { const bf16x8 af = *(const LAS bf16x8*)(AS + fr * RS + 32 * ks + 8 * g), bfm = *(const LAS bf16x8*)(KHB + fr * RS + 32 * ks + 8 * g);
                acc = __builtin_amdgcn_mfma_f32_16x16x32_bf16(af, bfm, acc, 0, 0, 0); }
            const float gs_inv = __builtin_amdgcn_rcpf(Lf[O_GL + fr]);
            if (w == 0) {
                f32x4 N1, M1;
#pragma unroll
                for (int r = 0; r < 4; ++r) { const int t = 4 * g + r; const float gt = Lf[O_GL + t];
                    N1[r] = (fr < t) ? -(B_[O_SC + 16 + t] * acc[r] * gt * gs_inv) : 0.f;
                    M1[r] = (t < fr) ? -(B_[O_SC + 16 + fr] * acc[r] * Lf[O_GL + fr] * __builtin_amdgcn_rcpf(gt)) : 0.f; }
#define XTY(X, Y, C0) __builtin_amdgcn_mfma_f32_16x16x32_bf16(mk_frag((u32x2){hw_pk2(X[0], X[1]), hw_pk2(X[2], X[3])}, zz), mk_frag((u32x2){hw_pk2(Y[0], Y[1]), hw_pk2(Y[2], Y[3])}, zz), C0, 0, 0, 0)
                const f32x4 z4 = {0.f, 0.f, 0.f, 0.f};
                f32x4 T1t = M1;
#pragma unroll
                for (int r = 0; r < 4; ++r) if (4 * g + r == fr) T1t[r] += 1.f;
                const f32x4 N2 = XTY(M1, N1, z4), M2 = XTY(N1, M1, z4);
                const f32x4 T2t = XTY(N2, T1t, T1t);
                const f32x4 N4 = XTY(M2, N2, z4), M4 = XTY(N2, M2, z4);
                const f32x4 T4t = XTY(N4, T2t, T2t);
                const f32x4 N8 = XTY(M4, N4, z4);
                const f32x4 T8t = XTY(N8, T4t, T4t);
#undef XTY
                u32x2 tw; tw.x = hw_pk2(T8t[0], T8t[1]); tw.y = hw_pk2(T8t[2], T8t[3]);
                *(LAS u32x2*)(TB + fr * 16 + 4 * g) = tw;
            } else {
#pragma unroll
                for (int r = 0; r < 4; ++r) { const int t = 4 * g + r; QKM[t * 16 + fr] = hw_bf((fr <= t) ? acc[r] * Lf[O_GL + t] * gs_inv : 0.f); }
            }
        }
        if (c + 1 < c_end) GD_XFORM((c + 1) & 1);
        if (c + 2 < c_end) GD_LOAD(c + 2);
        LBAR();
        f32x4 accu = {0.f, 0.f, 0.f, 0.f};
        {
            const bf16x8 tf = mk_frag(*(const LAS u32x2*)(TB + fr * 16 + 4 * g), zz);
            u32x2 ulo, wlo;
            { const float b0 = B_[O_SC + 16 + 4 * g + 0], b1 = B_[O_SC + 16 + 4 * g + 1], b2 = B_[O_SC + 16 + 4 * g + 2], b3 = B_[O_SC + 16 + 4 * g + 3];
              ulo.x = hw_pk2(b0 * B_[O_VV + (4 * g + 0) * 128 + c0 + fr], b1 * B_[O_VV + (4 * g + 1) * 128 + c0 + fr]); ulo.y = hw_pk2(b2 * B_[O_VV + (4 * g + 2) * 128 + c0 + fr], b3 * B_[O_VV + (4 * g + 3) * 128 + c0 + fr]);
              wlo.x = hw_pk2(Lf[O_WSRC + (4 * g + 0) * 128 + c0 + fr], Lf[O_WSRC + (4 * g + 1) * 128 + c0 + fr]); wlo.y = hw_pk2(Lf[O_WSRC + (4 * g + 2) * 128 + c0 + fr], Lf[O_WSRC + (4 * g + 3) * 128 + c0 + fr]); }
            accu = __builtin_amdgcn_mfma_f32_16x16x32_bf16(tf, mk_frag(ulo, zz), accu, 0, 0, 0);
            f32x4 accw = {0.f, 0.f, 0.f, 0.f};
            accw = __builtin_amdgcn_mfma_f32_16x16x32_bf16(tf, mk_frag(wlo, zz), accw, 0, 0, 0);
#pragma unroll
            for (int r = 0; r < 4; ++r) WB[(4 * g + r) * RS + c0 + fr] = hw_bf(-accw[r]);
        }
        LBAR();
        if (role == 0) {
            GD_STATE_PART(c);
        } else {
            float* rec = STASH + (size_t)(c - c_begin) * REC;
            for (int i = tid; i < 832; i += NTHREADS) { const int o = i < 528 ? O_QB + 4 * i : (i < 800 ? O_WB + 4 * (i - 528) : O_QKM + 4 * (i - 800)); *(GAS f32x4*)(rec + 4 * i) = *(const LAS f32x4*)(Lf + o); }
#pragma unroll
            for (int r = 0; r < 4; ++r) rec[3328 + (w * 4 + r) * 64 + lane] = accu[r];
            if (tid == 0) rec[5376] = glast;
        }
        LBAR();
    }
    if (role == 0) {
#pragma unroll
        for (int i = 0; i < 8; ++i)
#pragma unroll
            for (int r = 0; r < 4; ++r) STATE[((w * 8 + i) * 4 + r) * 64 + lane] = Sacc[i][r];
        asm volatile("s_waitcnt vmcnt(0)" ::: "memory");
        __syncthreads();
        if (tid == 0) { __builtin_amdgcn_fence(__ATOMIC_RELEASE, "agent"); asm volatile("s_waitcnt vmcnt(0)" ::: "memory"); __hip_atomic_store(flag, 1u, __ATOMIC_RELAXED, __HIP_MEMORY_SCOPE_AGENT); }
    } else {
        if (tid == 0) { unsigned sp = 0; while (__hip_atomic_load(flag, __ATOMIC_RELAXED, __HIP_MEMORY_SCOPE_AGENT) == 0u) { __builtin_amdgcn_s_sleep(8); if (++sp > (1u << 22)) break; }
            __builtin_amdgcn_fence(__ATOMIC_ACQUIRE, "agent"); asm volatile("s_waitcnt vmcnt(0)" ::: "memory"); }
        __syncthreads();
#pragma unroll
        for (int i = 0; i < 8; ++i)
#pragma unroll
            for (int r = 0; r < 4; ++r) Sacc[i][r] = STATE[((w * 8 + i) * 4 + r) * 64 + lane];
        f32x4 pa, pb; f32x4 pu; float pg;
#define GD_REC_LOAD(cc) do { const float* rec = STASH + (size_t)((cc) - c_begin) * REC; pa = *(const GAS f32x4*)(rec + 4 * tid); pb = (tid < 320) ? *(const GAS f32x4*)(rec + 4 * (tid + 512)) : (f32x4){0.f, 0.f, 0.f, 0.f}; \
            _Pragma("unroll") for (int r = 0; r < 4; ++r) pu[r] = rec[3328 + (w * 4 + r) * 64 + lane]; pg = rec[5376]; } while (0)
        GD_REC_LOAD(c_begin);
        for (int c = c_begin; c < c_end; ++c) {
            { const int i0 = tid, o0 = i0 < 528 ? O_QB + 4 * i0 : O_WB + 4 * (i0 - 528); *(LAS f32x4*)(Lf + o0) = pa;
              if (tid < 320) { const int i1 = tid + 512; const int o1 = i1 < 528 ? O_QB + 4 * i1 : (i1 < 800 ? O_WB + 4 * (i1 - 528) : O_QKM + 4 * (i1 - 800)); *(LAS f32x4*)(Lf + o1) = pb; } }
            const f32x4 accu = pu; const float glast = pg;
            if (c + 1 < c_end) GD_REC_LOAD(c + 1);
            LBAR();
            GD_STATE_PART(c);
            LBAR();
        }
#undef GD_REC_LOAD
    }
#undef GD_STATE_PART
#undef GD_LOAD
#undef GD_XFORM
}

__device__ __forceinline__ void scan_rwkv_unit(const Args& A, Frame& F, int unit) {
    int tid = F.tid; asm volatile("" : "+v"(tid));
    const int lane = tid & 63, w = F.wave;
    const int b = unit >> 4, h = unit & 15;
    const bf16* P = (const bf16*)(A.ws + WS_PROJ) + (size_t)b * SEQ * PROJ_LD + OC_RW;
    const bf16* LO = (const bf16*)(A.ws + WS_LO) + (size_t)b * SEQ * LORA_N;
    bf16* Y = (bf16*)(A.ws + WS_ACTA) + (size_t)b * SEQ * D + 1024 + h * 64;
    LAS float* Lf = (LAS float*)(F.lds + RING_OFF);
    constexpr int BUFSZ = 6208, O_KK = 0, O_WR = 1024, O_W = 2048, O_NKA = 3072, O_K = 4096, O_V = 5120, O_SC = 6144, O_OUT = 2 * BUFSZ;
    const int tl = tid >> 5, d2 = (tid & 31) * 2, hd = h * 64 + d2;
    float mu_r[2], mu_k[2], mu_v[2], w0[2], a0[2], k_k[2], k_a[2], r_k[2], lnw[2], lnb[2];
#pragma unroll
    for (int i = 0; i < 2; ++i) { mu_r[i] = A.in[I_MU][RW_R + hd + i]; mu_k[i] = A.in[I_MU][RW_K + hd + i]; mu_v[i] = A.in[I_MU][RW_V + hd + i];
        w0[i] = A.in[I_W0][hd + i]; a0[i] = A.in[I_A0][hd + i]; k_k[i] = A.in[I_KK][hd + i]; k_a[i] = A.in[I_KA][hd + i]; r_k[i] = A.in[I_RK][hd + i];
        lnw[i] = A.in[I_LNW][hd + i]; lnb[i] = A.in[I_LNB][hd + i]; }
    unsigned rr[2], rk[2], rv[2], rlw, rla, rg_cur = 0u, rg_nxt = 0u;
#define RW_LOAD(c) do { const int t_ = (c) * TC + tl; const bf16* pr = P + (size_t)t_ * PROJ_LD; \
        rr[0] = *(const GAS unsigned*)(pr + RW_R + hd); rk[0] = *(const GAS unsigned*)(pr + RW_K + hd); rv[0] = *(const GAS unsigned*)(pr + RW_V + hd); \
        if (t_ > 0) { rr[1] = *(const GAS unsigned*)(pr - PROJ_LD + RW_R + hd); rk[1] = *(const GAS unsigned*)(pr - PROJ_LD + RW_K + hd); rv[1] = *(const GAS unsigned*)(pr - PROJ_LD + RW_V + hd); } \
        else { rr[1] = 0u; rk[1] = 0u; rv[1] = 0u; } \
        const bf16* lr = LO + (size_t)t_ * LORA_N; rlw = *(const GAS unsigned*)(lr + hd); rla = *(const GAS unsigned*)(lr + 1024 + hd); rg_nxt = *(const GAS unsigned*)(lr + 2048 + hd); } while (0)
#define RW_XFORM(bufi) do { LAS float* B_ = Lf + (bufi) * BUFSZ; f32x2 kk2, wr2, w2_, nka2, k2, v2_; float skk = 0.f, sc1 = 0.f, sc2 = 0.f, sbs = 0.f; float aa[2], rrv[2]; \
        _Pragma("unroll") for (int i_ = 0; i_ < 2; ++i_) { \
            const float r0 = i_ ? bf_hi(rr[0]) : bf_lo(rr[0]), r1 = i_ ? bf_hi(rr[1]) : bf_lo(rr[1]); \
            const float k0_ = i_ ? bf_hi(rk[0]) : bf_lo(rk[0]), k1_ = i_ ? bf_hi(rk[1]) : bf_lo(rk[1]); \
            const float v0_ = i_ ? bf_hi(rv[0]) : bf_lo(rv[0]), v1_ = i_ ? bf_hi(rv[1]) : bf_lo(rv[1]); \
            const float lw = i_ ? bf_hi(rlw) : bf_lo(rlw), la = i_ ? bf_hi(rla) : bf_lo(rla); \
            const float r_ = r0 + (r1 - r0) * mu_r[i_], kx = k0_ + (k1_ - k0_) * mu_k[i_], vx = v0_ + (v1_ - v0_) * mu_v[i_]; \
            const float wd = __expf(-0.6065306597126334f * sigmoidf_(w0[i_] + lw)); const float a_ = sigmoidf_(a0[i_] + la); \
            const float kk0 = kx * k_k[i_]; const float km = kx * (1.f + (a_ - 1.f) * k_a[i_]); \
            kk2[i_] = kk0; skk += kk0 * kk0; aa[i_] = a_; rrv[i_] = r_; wr2[i_] = wd * r_; w2_[i_] = wd; k2[i_] = km; v2_[i_] = vx; sc2 += km * r_; sbs += r_ * km * r_k[i_]; } \
        skk = half_sum32(skk); const float rkk = __builtin_amdgcn_rsqf(skk + EPS); \
        _Pragma("unroll") for (int i_ = 0; i_ < 2; ++i_) { kk2[i_] *= rkk; nka2[i_] = -(kk2[i_] * aa[i_]); sc1 += kk2[i_] * aa[i_] * rrv[i_]; } \
        sc1 = half_sum32(sc1); sc2 = half_sum32(sc2); sbs = half_sum32(sbs); \
        *(LAS f32x2*)(B_ + O_KK + tl * 64 + d2) = kk2; *(LAS f32x2*)(B_ + O_WR + tl * 64 + d2) = wr2; *(LAS f32x2*)(B_ + O_W + tl * 64 + d2) = w2_; \
        *(LAS f32x2*)(B_ + O_NKA + tl * 64 + d2) = nka2; *(LAS f32x2*)(B_ + O_K + tl * 64 + d2) = k2; *(LAS f32x2*)(B_ + O_V + tl * 64 + d2) = v2_; \
        if ((tid & 31) == 0) { f32x4 sc; sc[0] = sc1; sc[1] = sc2; sc[2] = sbs; sc[3] = 0.f; *(LAS f32x4*)(B_ + O_SC + tl * 4) = sc; } } while (0)
    RW_LOAD(0); RW_XFORM(0); rg_cur = rg_nxt;
    LBAR();
    f32x2 S2[4];
#pragma unroll
    for (int i = 0; i < 4; ++i) S2[i] = (f32x2){0.f, 0.f};
    const int j = lane & 15, col = w * 8 + (lane >> 4) * 2;
    for (int c = 0; c < NCHUNK; ++c) {
        if (c + 1 < NCHUNK) RW_LOAD(c + 1);
        const LAS float* B_ = Lf + (c & 1) * BUFSZ;
        float os0 = 0.f, os1 = 0.f;
        f32x4 kk, wr, ww, nka, kv, sc, nkk, nwr, nww, nnka, nkv, nsc; f32x2 v2, nv2;
#define RW_LDSTEP(t_, KK, WR, WW, NKA, KV, V2, SC) do { KK = *(const LAS f32x4*)(B_ + O_KK + (t_) * 64 + 4 * j); WR = *(const LAS f32x4*)(B_ + O_WR + (t_) * 64 + 4 * j); WW = *(const LAS f32x4*)(B_ + O_W + (t_) * 64 + 4 * j); \
            NKA = *(const LAS f32x4*)(B_ + O_NKA + (t_) * 64 + 4 * j); KV = *(const LAS f32x4*)(B_ + O_K + (t_) * 64 + 4 * j); V2 = *(const LAS f32x2*)(B_ + O_V + (t_) * 64 + col); SC = *(const LAS f32x4*)(B_ + O_SC + (t_) * 4); } while (0)
        RW_LDSTEP(0, kk, wr, ww, nka, kv, v2, sc);
#pragma unroll
        for (int t = 0; t < TC; ++t) {
            if (t + 1 < TC) { RW_LDSTEP(t + 1, nkk, nwr, nww, nnka, nkv, nv2, nsc); }
            __builtin_amdgcn_sched_barrier(0);
            f32x2 d1 = S2[0] * kk[0], d2 = S2[0] * wr[0], e1 = S2[1] * kk[1], e2 = S2[1] * wr[1];
            d1 += S2[2] * kk[2]; d2 += S2[2] * wr[2]; e1 += S2[3] * kk[3]; e2 += S2[3] * wr[3];
            d1 += e1; d2 += e2;
            { float r0_ = d1[0], r1_ = d1[1], r2_ = d2[0], r3_ = d2[1]; row_sum16_x4(r0_, r1_, r2_, r3_); d1[0] = r0_; d1[1] = r1_; d2[0] = r2_; d2[1] = r3_; }
            const f32x2 o2 = d2 - d1 * sc[0] + v2 * sc[1];
#pragma unroll
            for (int i = 0; i < 4; ++i) S2[i] = S2[i] * ww[i] + d1 * nka[i] + v2 * kv[i];
            os0 = (j == t) ? o2[0] : os0; os1 = (j == t) ? o2[1] : os1;
            kk = nkk; wr = nwr; ww = nww; nka = nnka; kv = nkv; v2 = nv2; sc = nsc;
        }
#undef RW_LDSTEP
        { f32x2 o2 = {os0, os1}; *(LAS f32x2*)(Lf + O_OUT + j * 64 + col) = o2; }
        if (c + 1 < NCHUNK) RW_XFORM((c + 1) & 1);
        LBAR();
        {
            const f32x2 o2 = *(const LAS f32x2*)(Lf + O_OUT + tl * 64 + d2); const f32x2 vv = *(const LAS f32x2*)(B_ + O_V + tl * 64 + d2); const float bs = B_[O_SC + tl * 4 + 2];
            const float mean = half_sum32(o2[0] + o2[1]) * (1.0f / 64.0f); const float e0 = o2[0] - mean, e1 = o2[1] - mean;
            const float var = half_sum32(e0 * e0 + e1 * e1) * (1.0f / 64.0f); const float rs = __builtin_amdgcn_rsqf(var + 64e-5f);
            const float y0 = (e0 * rs * lnw[0] + lnb[0] + bs * vv[0]) * bf_lo(rg_cur), y1 = (e1 * rs * lnw[1] + lnb[1] + bs * vv[1]) * bf_hi(rg_cur);
            *(GAS unsigned*)(Y + (size_t)(c * TC + tl) * D + d2) = pk2(y0, y1);
        }
        rg_cur = rg_nxt;
        LBAR();
    }
#undef RW_LOAD
#undef RW_XFORM
}

template <int LAYER>
__device__ __forceinline__ void post_rows(const Args& A, Frame& F) {
    const int gw = F.vcu * NWAVES + F.wave, NGW = F.G * NWAVES, lane = F.lane;
    const bf16* O = (const bf16*)(A.ws + WS_O); const bf16* P = (const bf16*)(A.ws + WS_PROJ); bf16* Y = (bf16*)(A.ws + WS_ACTA);
    for (int m = gw; m < T; m += NGW) {
        const GAS u32x2* orow = (const GAS u32x2*)(O + (size_t)m * D) + lane; const bf16* prow = P + (size_t)m * PROJ_LD;
        constexpr int NJ = LAYER == 0 ? 8 : 4;
#pragma unroll
        for (int jj = 0; jj < NJ; ++jj) {
            const u32x2 ow_ = orow[64 * jj]; const f32x4 v = {bf_lo(ow_.x), bf_hi(ow_.x), bf_lo(ow_.y), bf_hi(ow_.y)}; float ss = (v[0] * v[0] + v[1] * v[1]) + (v[2] * v[2] + v[3] * v[3]);
            const bool wide = (LAYER == 0 && jj < 4);
            const float ms = wide ? wave_sum(ss) * (1.0f / 256.0f) : half_sum32(ss) * (1.0f / 128.0f);
            const float r = __builtin_amdgcn_rsqf(ms + EPS);
            const int cih = wide ? 4 * lane : 4 * (lane & 31);
            const float* gsrc = LAYER == 0 ? (wide ? A.in[I_GLA_NORM] : A.in[I_GDN_NORM]) : A.in[I_HG_NORM];
            const f32x4 g = *(const GAS f32x4*)(gsrc + cih);
            const int zcol = LAYER == 0 ? (wide ? EC_GZ + jj * 256 + 4 * lane : EC_BZ + (jj - 4) * 256 + 4 * lane) : OC_HG + jj * 256 + 4 * lane;
            const u32x2 zw = *(const GAS u32x2*)(prow + zcol);
            const float y0 = v[0] * r * g[0] * siluf_(bf_lo(zw.x)), y1 = v[1] * r * g[1] * siluf_(bf_hi(zw.x)), y2 = v[2] * r * g[2] * siluf_(bf_lo(zw.y)), y3 = v[3] * r * g[3] * siluf_(bf_hi(zw.y));
            if constexpr (LAYER == 1) { int o8 = __builtin_amdgcn_cvt_pk_fp8_f32(y0, y1, 0, false); o8 = __builtin_amdgcn_cvt_pk_fp8_f32(y2, y3, o8, true);
                *(GAS unsigned*)((unsigned char*)Y + (size_t)m * D + 256 * jj + 4 * lane) = (unsigned)o8; }
            else { u32x2 o; o.x = pk2(y0, y1); o.y = pk2(y2, y3);
                *(GAS u32x2*)(Y + (size_t)m * D + 256 * jj + 4 * lane) = o; }
        }
    }
}
__device__ __forceinline__ void lora_prep_rows(const Args& A, Frame& F) {
    const int gw = F.vcu * NWAVES + F.wave, NGW = F.G * NWAVES, lane = F.lane;
    const bf16* P = (const bf16*)(A.ws + WS_PROJ); bf16* LA = (bf16*)(A.ws + WS_LA); const float* mu = A.in[I_MU];
    for (int m = gw; m < T; m += NGW) { const bool hasprev = (m % SEQ) != 0; const bf16* prow = P + (size_t)m * PROJ_LD + OC_RW + RW_WL;
#pragma unroll
        for (int i = 0; i < 7; ++i) { const int c = lane + 64 * i;
            const float x = __uint_as_float((unsigned)prow[c] << 16), xp = hasprev ? __uint_as_float((unsigned)prow[c - PROJ_LD] << 16) : 0.f;
            const float ts = x + (xp - x) * mu[RW_WL + c];
            const float v = c < 96 ? tanhf(ts) : (c < 192 ? ts : sigmoidf_(ts));
            LA[(size_t)m * LORA_K + c] = (bf16)f2bf(v); }
        LA[(size_t)m * LORA_K + 448 + lane] = (bf16)0; }
}
__device__ __forceinline__ void final_rows(const Args& A, Frame& F, const float oscale, const bf16* Hs) {
    const int gw = F.vcu * NWAVES + F.wave, NGW = F.G * NWAVES, lane = F.lane;
    const float* rowss = (const float*)(A.ws + WS_RSP) + (size_t)RS_FINAL * T * 32; const GAS f32x4* g = (const GAS f32x4*)A.in[I_NFINAL] + lane;
    for (int m = gw; m < T; m += NGW) { const float r = oscale * __builtin_amdgcn_rsqf(wave_sum(lane < 32 ? rowss[(size_t)m * 32 + lane] : 0.f) * (1.0f / D) + EPS); GAS f32x4* row = (GAS f32x4*)(A.out + (size_t)m * D) + lane;
        const GAS u32x2* hrow = (const GAS u32x2*)(Hs + (size_t)m * D) + lane;
#pragma unroll
        for (int jj = 0; jj < 8; ++jj) { const u32x2 hw = hrow[64 * jj]; const f32x4 v = {bf_lo(hw.x), bf_hi(hw.x), bf_lo(hw.y), bf_hi(hw.y)}; row[64 * jj] = v * r * g[64 * jj]; } }
}

__device__ __forceinline__ void scan_rwkv_mfma_unit(const Args& A, Frame& F, int unit, const int role) {
    int tid = F.tid; asm volatile("" : "+v"(tid));
    const int lane = tid & 63, w = F.wave;
    const int b = unit >> 3, hp = unit & 7;
    const bf16* P = (const bf16*)(A.ws + WS_PROJ) + (size_t)b * SEQ * PROJ_LD + OC_RW;
    const bf16* LO = (const bf16*)(A.ws + WS_LO) + (size_t)b * SEQ * LORA_N;
    unsigned char* Y = (unsigned char*)(A.ws + WS_ACTA) + (size_t)b * SEQ * D + 1024;
    LAS float* Lf = (LAS float*)(F.lds + RING_OFF);
    constexpr int RS = 72;
    constexpr int O_CONST = 0;
    constexpr int O_XF = 1280;
    constexpr int O_VV = O_XF + 2 * 5 * 1024;
    constexpr int O_BS = O_VV + 4 * 1024;
    constexpr int O_IMG = O_BS + 64;
    constexpr int I_CT = 0, I_BT = 576, I_KL = 1152, I_RT = 1728, I_CF = 2304, I_BTT = 3328, I_KTT = 3840, I_WCB = 4352, I_G1B = 4928, I_TTB = 5056, I_RKB = 5184, I_RBB = 5312, I_W15 = 5440, I_OUT = 5504, IMGSZ = 6528;
    static_assert((O_IMG + 2 * IMGSZ) * 4 <= RING_BYTES, "rwkv lds");
    for (int i = tid; i < 1280; i += NTHREADS) { const int arr = i >> 7, ch = hp * 128 + (i & 127); float v;
        switch (arr) { case 0: v = A.in[I_MU][RW_R + ch]; break; case 1: v = A.in[I_MU][RW_K + ch]; break; case 2: v = A.in[I_MU][RW_V + ch]; break; case 3: v = A.in[I_W0][ch]; break; case 4: v = A.in[I_A0][ch]; break;
                       case 5: v = A.in[I_KK][ch]; break; case 6: v = A.in[I_KA][ch]; break; case 7: v = A.in[I_RK][ch]; break; case 8: v = A.in[I_LNW][ch]; break; default: v = A.in[I_LNB][ch]; break; }
        Lf[O_CONST + i] = v; }
    const int hx = tid >> 8, tl = (tid >> 4) & 15, d4 = (tid & 15) * 4, ch4 = hx * 64 + d4, col4 = hp * 128 + ch4;
    u32x2 rr[2], rk[2], rv[2], rlw, rla, rg_cur = {0u, 0u}, rg_nxt = {0u, 0u}, rg_far = {0u, 0u};
#define RM_LOAD(c) do { const int t_ = (c) * TC + tl; const bf16* pr = P + (size_t)t_ * PROJ_LD + col4; \
        rr[0] = *(const GAS u32x2*)(pr + RW_R); rk[0] = *(const GAS u32x2*)(pr + RW_K); rv[0] = *(const GAS u32x2*)(pr + RW_V); \
        const bf16* pp_ = (t_ > 0) ? pr - PROJ_LD : pr; rr[1] = *(const GAS u32x2*)(pp_ + RW_R); rk[1] = *(const GAS u32x2*)(pp_ + RW_K); rv[1] = *(const GAS u32x2*)(pp_ + RW_V); \
        if (t_ == 0) { rr[1] = (u32x2){0u, 0u}; rk[1] = (u32x2){0u, 0u}; rv[1] = (u32x2){0u, 0u}; } \
        const bf16* lr = LO + (size_t)t_ * LORA_N + col4; rlw = *(const GAS u32x2*)(lr); rla = *(const GAS u32x2*)(lr + 1024); rg_far = *(const GAS u32x2*)(lr + 2048); } while (0)
#define RM_XFORM(bufi) do { LAS float* X_ = Lf + O_XF + hx * 5 * 1024 + tl * 64 + d4; \
        const f32x4 mur = *(const LAS f32x4*)(Lf + O_CONST + 0 * 128 + ch4), muk = *(const LAS f32x4*)(Lf + O_CONST + 1 * 128 + ch4), muv = *(const LAS f32x4*)(Lf + O_CONST + 2 * 128 + ch4); \
        const f32x4 w0_ = *(const LAS f32x4*)(Lf + O_CONST + 3 * 128 + ch4), a0_ = *(const LAS f32x4*)(Lf + O_CONST + 4 * 128 + ch4), kk_ = *(const LAS f32x4*)(Lf + O_CONST + 5 * 128 + ch4); \
        const f32x4 ka_ = *(const LAS f32x4*)(Lf + O_CONST + 6 * 128 + ch4), rk_ = *(const LAS f32x4*)(Lf + O_CONST + 7 * 128 + ch4); \
        const float r0[4] = {bf_lo(rr[0].x), bf_hi(rr[0].x), bf_lo(rr[0].y), bf_hi(rr[0].y)}, r1[4] = {bf_lo(rr[1].x), bf_hi(rr[1].x), bf_lo(rr[1].y), bf_hi(rr[1].y)}; \
        const float k0[4] = {bf_lo(rk[0].x), bf_hi(rk[0].x), bf_lo(rk[0].y), bf_hi(rk[0].y)}, k1[4] = {bf_lo(rk[1].x), bf_hi(rk[1].x), bf_lo(rk[1].y), bf_hi(rk[1].y)}; \
        const float v0[4] = {bf_lo(rv[0].x), bf_hi(rv[0].x), bf_lo(rv[0].y), bf_hi(rv[0].y)}, v1[4] = {bf_lo(rv[1].x), bf_hi(rv[1].x), bf_lo(rv[1].y), bf_hi(rv[1].y)}; \
        const float lw[4] = {bf_lo(rlw.x), bf_hi(rlw.x), bf_lo(rlw.y), bf_hi(rlw.y)}, la[4] = {bf_lo(rla.x), bf_hi(rla.x), bf_lo(rla.y), bf_hi(rla.y)}; \
        f32x4 r4, w4, k4, v4, kk4, b4; float skk = 0.f, sbs = 0.f; float aa[4]; \
        _Pragma("unroll") for (int i_ = 0; i_ < 4; ++i_) { const float r_ = r0[i_] + (r1[i_] - r0[i_]) * mur[i_], kx = k0[i_] + (k1[i_] - k0[i_]) * muk[i_], vx = v0[i_] + (v1[i_] - v0[i_]) * muv[i_]; \
            const float wd = __expf(-0.6065306597126334f * sigmoidf_(w0_[i_] + lw[i_])); const float a_ = sigmoidf_(a0_[i_] + la[i_]); \
            const float kk0 = kx * kk_[i_], km = kx * (1.f + (a_ - 1.f) * ka_[i_]); \
            r4[i_] = r_; w4[i_] = wd; k4[i_] = km; v4[i_] = vx; kk4[i_] = kk0; aa[i_] = a_; skk += kk0 * kk0; sbs += r_ * km * rk_[i_]; } \
        row_sum16_x2(skk, sbs); const float rkk = __builtin_amdgcn_rsqf(skk + EPS); \
        _Pragma("unroll") for (int i_ = 0; i_ < 4; ++i_) { kk4[i_] *= rkk; b4[i_] = kk4[i_] * aa[i_]; } \
        *(LAS f32x4*)(X_) = r4; *(LAS f32x4*)(X_ + 1024) = w4; *(LAS f32x4*)(X_ + 2048) = k4; *(LAS f32x4*)(X_ + 3072) = kk4; *(LAS f32x4*)(X_ + 4096) = b4; \
        *(LAS f32x4*)(Lf + O_VV + ((bufi) * 2 + hx) * 1024 + tl * 64 + d4) = v4; \
        if ((tid & 15) == 0) Lf[O_BS + ((bufi) * 2 + hx) * 16 + tl] = sbs; } while (0)
    constexpr int SPLIT = 60;
    const int c_begin = role ? SPLIT : 0, c_end = role ? NCHUNK : SPLIT;
    constexpr int REC = 7584;
    float* STASH = (float*)(A.ws + (unit < 32 ? WS_WEV_IN : WS_END)) + (size_t)(unit & 31) * (NCHUNK - SPLIT) * REC;
    float* STATE = (float*)(A.ws + WS_STATE + 4 * MiB) + (size_t)unit * 8192;
    gu32* flag = F.ctl + 49152 + unit * 64;
    LBAR();
    RM_LOAD(c_begin); RM_XFORM(c_begin & 1); rg_cur = rg_far; RM_LOAD(c_begin + 1); rg_nxt = rg_far;
    LBAR();
    f32x4 Macc[4];
#pragma unroll
    for (int i = 0; i < 4; ++i) Macc[i] = (f32x4){0.f, 0.f, 0.f, 0.f};
    const int fr = lane & 15, g = lane >> 4, hh = w >> 2, ww = w & 3, c0 = ww * 16;
    LAS float* IM = Lf + O_IMG + hh * IMGSZ;
    LAS bf16* CT = (LAS bf16*)(IM + I_CT); LAS bf16* BT = (LAS bf16*)(IM + I_BT); LAS bf16* KL = (LAS bf16*)(IM + I_KL); LAS bf16* RT = (LAS bf16*)(IM + I_RT);
    LAS bf16* BTT = (LAS bf16*)(IM + I_BTT); LAS bf16* KTT = (LAS bf16*)(IM + I_KTT); LAS bf16* WCB = (LAS bf16*)(IM + I_WCB);
    LAS bf16* G1B = (LAS bf16*)(IM + I_G1B); LAS bf16* TTB = (LAS bf16*)(IM + I_TTB); LAS bf16* RKB = (LAS bf16*)(IM + I_RKB); LAS bf16* RBB = (LAS bf16*)(IM + I_RBB);
    const u32x2 zz = {0u, 0u};
#define RM_STATE_PART(vb) do { \
        { \
            bf16x8 mb[2]; \
_Pragma("unroll") \
            for (int ks = 0; ks < 2; ++ks) { u32x2 slo, shi; slo.x = hw_pk2(Macc[2 * ks][0], Macc[2 * ks][1]); slo.y = hw_pk2(Macc[2 * ks][2], Macc[2 * ks][3]); shi.x = hw_pk2(Macc[2 * ks + 1][0], Macc[2 * ks + 1][1]); shi.y = hw_pk2(Macc[2 * ks + 1][2], Macc[2 * ks + 1][3]); \
                mb[ks] = mk_frag(slo, shi); } \
            f32x4 accR = accU, acco = {0.f, 0.f, 0.f, 0.f}; \
_Pragma("unroll") \
            for (int ks = 0; ks < 2; ++ks) { \
                accR = __builtin_amdgcn_mfma_f32_16x16x32_bf16(mk_frag(*(const LAS u32x2*)(WCB + fr * RS + 32 * ks + 4 * g), *(const LAS u32x2*)(WCB + fr * RS + 32 * ks + 16 + 4 * g)), mb[ks], accR, 0, 0, 0); \
                acco = __builtin_amdgcn_mfma_f32_16x16x32_bf16(mk_frag(*(const LAS u32x2*)(RT + fr * RS + 32 * ks + 4 * g), *(const LAS u32x2*)(RT + fr * RS + 32 * ks + 16 + 4 * g)), mb[ks], acco, 0, 0, 0); } \
            u32x2 rn; rn.x = hw_pk2(accR[0], accR[1]); rn.y = hw_pk2(accR[2], accR[3]); \
            const bf16x8 rb = mk_frag(rn, zz); \
            acco = __builtin_amdgcn_mfma_f32_16x16x32_bf16(mk_frag(*(const LAS u32x2*)(RKB + fr * 16 + 4 * g), zz), vb, acco, 0, 0, 0); \
            acco = __builtin_amdgcn_mfma_f32_16x16x32_bf16(mk_frag(*(const LAS u32x2*)(RBB + fr * 16 + 4 * g), zz), rb, acco, 0, 0, 0); \
_Pragma("unroll") \
            for (int r = 0; r < 4; ++r) IM[I_OUT + (4 * g + r) * 64 + c0 + fr] = acco[r]; \
_Pragma("unroll") \
            for (int i = 0; i < 4; ++i) { const f32x4 w15 = *(const LAS f32x4*)(IM + I_W15 + 16 * i + 4 * g); \
                f32x4 m = __builtin_amdgcn_mfma_f32_16x16x32_bf16(mk_frag(*(const LAS u32x2*)(KTT + (16 * i + fr) * 16 + 4 * g), zz), vb, Macc[i], 0, 0, 0); \
                m = __builtin_amdgcn_mfma_f32_16x16x32_bf16(mk_frag(*(const LAS u32x2*)(BTT + (16 * i + fr) * 16 + 4 * g), zz), rb, m, 0, 0, 0); \
                Macc[i] = m * w15; } \
        } \
        } while (0)
#define RM_FLUSH(cc_, gb_, vv_, bs_) do { \
        { \
            const f32x4 o4 = *(const LAS f32x4*)(Lf + O_IMG + hx * IMGSZ + I_OUT + tl * 64 + d4); const f32x4 vv = (vv_); const float bs = (bs_); \
            const f32x4 lnw = *(const LAS f32x4*)(Lf + O_CONST + 8 * 128 + ch4), lnb = *(const LAS f32x4*)(Lf + O_CONST + 9 * 128 + ch4); \
            float sm = (o4[0] + o4[1]) + (o4[2] + o4[3]), dummy = 0.f; row_sum16_x2(sm, dummy); const float mean = sm * (1.0f / 64.0f); \
            const f32x4 e4 = o4 - mean; float sv = (e4[0] * e4[0] + e4[1] * e4[1]) + (e4[2] * e4[2] + e4[3] * e4[3]); row_sum16_x2(sv, dummy); const float rs = __builtin_amdgcn_rsqf(sv * (1.0f / 64.0f) + 64e-5f); \
            const float gg[4] = {bf_lo((gb_).x), bf_hi((gb_).x), bf_lo((gb_).y), bf_hi((gb_).y)}; \
            float y[4]; \
_Pragma("unroll") \
            for (int i = 0; i < 4; ++i) y[i] = (e4[i] * rs * lnw[i] + lnb[i] + bs * vv[i]) * gg[i]; \
            int o8 = __builtin_amdgcn_cvt_pk_fp8_f32(y[0], y[1], 0, false); o8 = __builtin_amdgcn_cvt_pk_fp8_f32(y[2], y[3], o8, true); \
            *(GAS unsigned*)(Y + (size_t)((cc_) * TC + tl) * D + col4) = (unsigned)o8; \
        } \
        } while (0)
    for (int c = c_begin; c < c_end; ++c) {
        {
            const int hq = tid >> 8, seg = (tid >> 6) & 3, d = tid & 63;
            const LAS float* X_ = Lf + O_XF + hq * 5 * 1024 + d; LAS float* IQ = Lf + O_IMG + hq * IMGSZ;
            LAS bf16* CTq = (LAS bf16*)(IQ + I_CT); LAS bf16* BTq = (LAS bf16*)(IQ + I_BT); LAS bf16* KLq = (LAS bf16*)(IQ + I_KL); LAS bf16* RTq = (LAS bf16*)(IQ + I_RT);
            float wall = 1.f, wpre = 1.f;
#pragma unroll
            for (int t = 0; t < 16; ++t) { if (t == 4 * seg) wpre = wall; wall *= X_[1024 + t * 64]; }
            float wt = wpre; unsigned short bt4[4], kt4[4];
#pragma unroll
            for (int i = 0; i < 4; ++i) { const int t = 4 * seg + i; const float wprev = wt; wt *= X_[1024 + t * 64]; const float iw = __builtin_amdgcn_rcpf(wt);
                const float r_ = X_[t * 64], k_ = X_[2048 + t * 64], kk_ = X_[3072 + t * 64], b_ = X_[4096 + t * 64];
                const float ct = kk_ * wprev, bt = b_ * iw, kt = k_ * iw;
                CTq[t * RS + d] = hw_bf(ct); IQ[I_CF + t * 64 + d] = ct; BTq[t * RS + d] = hw_bf(bt); KLq[t * RS + d] = hw_bf(kt); RTq[t * RS + d] = hw_bf(r_ * wt);
                bt4[i] = (unsigned short)hw_bf(-bt); kt4[i] = (unsigned short)hw_bf(kt); }
            u32x2 o; o.x = (unsigned)bt4[0] | ((unsigned)bt4[1] << 16); o.y = (unsigned)bt4[2] | ((unsigned)bt4[3] << 16); *(LAS u32x2*)((LAS bf16*)(IQ + I_BTT) + d * 16 + 4 * seg) = o;
            o.x = (unsigned)kt4[0] | ((unsigned)kt4[1] << 16); o.y = (unsigned)kt4[2] | ((unsigned)kt4[3] << 16); *(LAS u32x2*)((LAS bf16*)(IQ + I_KTT) + d * 16 + 4 * seg) = o;
            if (seg == 3) IQ[I_W15 + d] = wall;
        }
        LBAR();
        if (ww == 0) {
            f32x4 cb = {0.f, 0.f, 0.f, 0.f}, bc = cb, ck = cb, rkm = cb, rbm = cb;
#pragma unroll
            for (int ks = 0; ks < 2; ++ks) { const bf16x8 fc = *(const LAS bf16x8*)(CT + fr * RS + 32 * ks + 8 * g), fb = *(const LAS bf16x8*)(BT + fr * RS + 32 * ks + 8 * g), fk = *(const LAS bf16x8*)(KL + fr * RS + 32 * ks + 8 * g), frr = *(const LAS bf16x8*)(RT + fr * RS + 32 * ks + 8 * g);
                cb = __builtin_amdgcn_mfma_f32_16x16x32_bf16(fc, fb, cb, 0, 0, 0); bc = __builtin_amdgcn_mfma_f32_16x16x32_bf16(fb, fc, bc, 0, 0, 0); ck = __builtin_amdgcn_mfma_f32_16x16x32_bf16(fc, fk, ck, 0, 0, 0);
                rkm = __builtin_amdgcn_mfma_f32_16x16x32_bf16(frr, fk, rkm, 0, 0, 0); rbm = __builtin_amdgcn_mfma_f32_16x16x32_bf16(frr, fb, rbm, 0, 0, 0); }
            f32x4 N1, M1, CKm;
#pragma unroll
            for (int r = 0; r < 4; ++r) { const int t = 4 * g + r; N1[r] = (fr < t) ? -cb[r] : 0.f; M1[r] = (t < fr) ? -bc[r] : 0.f; CKm[r] = (fr < t) ? ck[r] : 0.f;
                RKB[t * 16 + fr] = hw_bf((fr <= t) ? rkm[r] : 0.f); RBB[t * 16 + fr] = hw_bf((fr <= t) ? -rbm[r] : 0.f); }
#define XTY(X, Y, C0) __builtin_amdgcn_mfma_f32_16x16x32_bf16(mk_frag((u32x2){hw_pk2(X[0], X[1]), hw_pk2(X[2], X[3])}, zz), mk_frag((u32x2){hw_pk2(Y[0], Y[1]), hw_pk2(Y[2], Y[3])}, zz), C0, 0, 0, 0)
            const f32x4 z4 = {0.f, 0.f, 0.f, 0.f};
            f32x4 T1t = M1;
#pragma unroll
            for (int r = 0; r < 4; ++r) if (4 * g + r == fr) T1t[r] += 1.f;
            const f32x4 N2 = XTY(M1, N1, z4), M2 = XTY(N1, M1, z4);
            const f32x4 T2t = XTY(N2, T1t, T1t);
            const f32x4 N4 = XTY(M2, N2, z4), M4 = XTY(N2, M2, z4);
            const f32x4 T4t = XTY(N4, T2t, T2t);
            const f32x4 N8 = XTY(M4, N4, z4);
            const f32x4 T8t = XTY(N8, T4t, T4t);
            const f32x4 G1t = XTY(CKm, T8t, z4);
#undef XTY
            u32x2 tw; tw.x = hw_pk2(T8t[0], T8t[1]); tw.y = hw_pk2(T8t[2], T8t[3]); *(LAS u32x2*)(TTB + fr * 16 + 4 * g) = tw;
            tw.x = hw_pk2(G1t[0], G1t[1]); tw.y = hw_pk2(G1t[2], G1t[3]); *(LAS u32x2*)(G1B + fr * 16 + 4 * g) = tw;
        }
        if (c + 1 < c_end) { RM_XFORM((c + 1) & 1); }
        if (c + 2 < c_end) RM_LOAD(c + 2);
        LBAR();
        const LAS float* VVc = Lf + O_VV + ((c & 1) * 2 + hh) * 1024;
        u32x2 vlo; { vlo.x = hw_pk2(VVc[(4 * g + 0) * 64 + c0 + fr], VVc[(4 * g + 1) * 64 + c0 + fr]); vlo.y = hw_pk2(VVc[(4 * g + 2) * 64 + c0 + fr], VVc[(4 * g + 3) * 64 + c0 + fr]); }
        const bf16x8 vb = mk_frag(vlo, zz);
        f32x4 accU = {0.f, 0.f, 0.f, 0.f};
        {
            accU = __builtin_amdgcn_mfma_f32_16x16x32_bf16(mk_frag(*(const LAS u32x2*)(G1B + fr * 16 + 4 * g), zz), vb, accU, 0, 0, 0);
            u32x2 clo; clo.x = hw_pk2(IM[I_CF + (4 * g + 0) * 64 + c0 + fr], IM[I_CF + (4 * g + 1) * 64 + c0 + fr]); clo.y = hw_pk2(IM[I_CF + (4 * g + 2) * 64 + c0 + fr], IM[I_CF + (4 * g + 3) * 64 + c0 + fr]);
            f32x4 accw = {0.f, 0.f, 0.f, 0.f};
            accw = __builtin_amdgcn_mfma_f32_16x16x32_bf16(mk_frag(*(const LAS u32x2*)(TTB + fr * 16 + 4 * g), zz), mk_frag(clo, zz), accw, 0, 0, 0);
#pragma unroll
            for (int r = 0; r < 4; ++r) WCB[(4 * g + r) * RS + c0 + fr] = hw_bf(accw[r]);
        }
        LBAR();
        if (role == 0) {
            RM_STATE_PART(vb);
            LBAR();
            RM_FLUSH(c, rg_cur, *(const LAS f32x4*)(Lf + O_VV + ((c & 1) * 2 + hx) * 1024 + tl * 64 + d4), Lf[O_BS + ((c & 1) * 2 + hx) * 16 + tl]);
        } else {
            float* rec = STASH + (size_t)(c - c_begin) * REC;
            for (int i = tid; i < 1376; i += NTHREADS) { const int hd = i >= 688, j = i - hd * 688; const int o = O_IMG + hd * IMGSZ + (j < 144 ? I_RT + 4 * j : I_BTT + 4 * (j - 144)); *(GAS f32x4*)(rec + 4 * i) = *(const LAS f32x4*)(Lf + o); }
            { GAS unsigned* ru = (GAS unsigned*)(rec + 5504); ru[(w * 2 + 0) * 64 + lane] = hw_pk2(accU[0], accU[1]); ru[(w * 2 + 1) * 64 + lane] = hw_pk2(accU[2], accU[3]); }
            { const f32x4 v4 = *(const LAS f32x4*)(Lf + O_VV + ((c & 1) * 2 + hx) * 1024 + tl * 64 + d4); u32x2 o; o.x = hw_pk2(v4[0], v4[1]); o.y = hw_pk2(v4[2], v4[3]); *(GAS u32x2*)(rec + 6528 + 2 * tid) = o; }
            if (tid < 32) rec[7552 + tid] = Lf[O_BS + (c & 1) * 32 + tid];
            LBAR();
        }
        rg_cur = rg_nxt; rg_nxt = rg_far;
    }
    if (role == 0) {
#pragma unroll
        for (int i = 0; i < 4; ++i)
#pragma unroll
            for (int r = 0; r < 4; ++r) STATE[((w * 4 + i) * 4 + r) * 64 + lane] = Macc[i][r];
        asm volatile("s_waitcnt vmcnt(0)" ::: "memory");
        __syncthreads();
        if (tid == 0) { __builtin_amdgcn_fence(__ATOMIC_RELEASE, "agent"); asm volatile("s_waitcnt vmcnt(0)" ::: "memory"); __hip_atomic_store(flag, 1u, __ATOMIC_RELAXED, __HIP_MEMORY_SCOPE_AGENT); }
    } else {
        if (tid == 0) { unsigned sp = 0; while (__hip_atomic_load(flag, __ATOMIC_RELAXED, __HIP_MEMORY_SCOPE_AGENT) == 0u) { __builtin_amdgcn_s_sleep(8); if (++sp > (1u << 22)) break; }
            __builtin_amdgcn_fence(__ATOMIC_ACQUIRE, "agent"); asm volatile("s_waitcnt vmcnt(0)" ::: "memory"); }
        __syncthreads();
#pragma unroll
        for (int i = 0; i < 4; ++i)
#pragma unroll
            for (int r = 0; r < 4; ++r) Macc[i][r] = STATE[((w * 4 + i) * 4 + r) * 64 + lane];
        f32x4 pi0, pi1, pi2; unsigned pu0, pu1; u32x2 pv, pgate; float pbs;
#define RM_REC_LOAD(cc) do { const float* rec = STASH + (size_t)((cc) - c_begin) * REC; pi0 = *(const GAS f32x4*)(rec + 4 * tid); pi1 = *(const GAS f32x4*)(rec + 4 * (tid + 512)); \
            pi2 = (tid < 352) ? *(const GAS f32x4*)(rec + 4 * (tid + 1024)) : (f32x4){0.f, 0.f, 0.f, 0.f}; \
            const GAS unsigned* ru = (const GAS unsigned*)(rec + 5504); pu0 = ru[(w * 2 + 0) * 64 + lane]; pu1 = ru[(w * 2 + 1) * 64 + lane]; pv = *(const GAS u32x2*)(rec + 6528 + 2 * tid); pbs = rec[7552 + hx * 16 + tl]; \
            pgate = *(const GAS u32x2*)(LO + (size_t)((cc) * TC + tl) * LORA_N + col4 + 2048); } while (0)
#define RM_IMG_OFF(i_) (O_IMG + ((i_) >= 688) * IMGSZ + ((((i_) - ((i_) >= 688) * 688) < 144) ? I_RT + 4 * ((i_) - ((i_) >= 688) * 688) : I_BTT + 4 * (((i_) - ((i_) >= 688) * 688) - 144)))
        RM_REC_LOAD(c_begin);
        for (int c = c_begin; c < c_end; ++c) {
            *(LAS f32x4*)(Lf + RM_IMG_OFF(tid)) = pi0; *(LAS f32x4*)(Lf + RM_IMG_OFF(tid + 512)) = pi1; if (tid < 352) *(LAS f32x4*)(Lf + RM_IMG_OFF(tid + 1024)) = pi2;
            const f32x4 vcur = {bf_lo(pv.x), bf_hi(pv.x), bf_lo(pv.y), bf_hi(pv.y)}; *(LAS f32x4*)(Lf + O_VV + hx * 1024 + tl * 64 + d4) = vcur;
            const f32x4 accU = {bf_lo(pu0), bf_hi(pu0), bf_lo(pu1), bf_hi(pu1)}; const float bscur = pbs; const u32x2 gcur = pgate;
            if (c + 1 < c_end) RM_REC_LOAD(c + 1);
            LBAR();
            const LAS float* VVc = Lf + O_VV + hh * 1024;
            u32x2 vlo; { vlo.x = hw_pk2(VVc[(4 * g + 0) * 64 + c0 + fr], VVc[(4 * g + 1) * 64 + c0 + fr]); vlo.y = hw_pk2(VVc[(4 * g + 2) * 64 + c0 + fr], VVc[(4 * g + 3) * 64 + c0 + fr]); }
            const bf16x8 vb = mk_frag(vlo, zz);
            RM_STATE_PART(vb);
            LBAR();
            RM_FLUSH(c, gcur, vcur, bscur);
            LBAR();
        }
#undef RM_REC_LOAD
#undef RM_IMG_OFF
    }
#undef RM_STATE_PART
#undef RM_FLUSH
#undef RM_LOAD
#undef RM_XFORM
}

__device__ __forceinline__ int med3i(int a, int b, int c) { int r; asm("v_med3_i32 %0, %1, %2, %3" : "=v"(r) : "v"(a), "v"(b), "v"(c)); return r; }
__device__ __forceinline__ int f2sort(float f) { int x = __float_as_int(f); return x ^ ((x >> 31) & 0x7fffffff); }
__device__ __forceinline__ float sort2f(int x) { return __int_as_float(x ^ ((x >> 31) & 0x7fffffff)); }
#define TOPK_INSERT(vals, x) do { _Pragma("unroll") for (int s_ = 15; s_ >= 1; --s_) vals[s_] = med3i((x), vals[s_ - 1], vals[s_]); vals[0] = max(vals[0], (x)); } while (0)
__device__ __forceinline__ float bf_dot2(unsigned a, unsigned b, float c) {
    return c + bf_lo(a) * bf_lo(b) + bf_hi(a) * bf_hi(b);
}
__device__ __forceinline__ void sum8_x8(float (&a)[8]) {
    asm("s_nop 1\n\t"
        "v_add_f32_dpp %0, %0, %0 quad_perm:[1,0,3,2] row_mask:0xf bank_mask:0xf\n\tv_add_f32_dpp %1, %1, %1 quad_perm:[1,0,3,2] row_mask:0xf bank_mask:0xf\n\t"
        "v_add_f32_dpp %2, %2, %2 quad_perm:[1,0,3,2] row_mask:0xf bank_mask:0xf\n\tv_add_f32_dpp %3, %3, %3 quad_perm:[1,0,3,2] row_mask:0xf bank_mask:0xf\n\t"
        "v_add_f32_dpp %4, %4, %4 quad_perm:[1,0,3,2] row_mask:0xf bank_mask:0xf\n\tv_add_f32_dpp %5, %5, %5 quad_perm:[1,0,3,2] row_mask:0xf bank_mask:0xf\n\t"
        "v_add_f32_dpp %6, %6, %6 quad_perm:[1,0,3,2] row_mask:0xf bank_mask:0xf\n\tv_add_f32_dpp %7, %7, %7 quad_perm:[1,0,3,2] row_mask:0xf bank_mask:0xf\n\t"
        "v_add_f32_dpp %0, %0, %0 quad_perm:[2,3,0,1] row_mask:0xf bank_mask:0xf\n\tv_add_f32_dpp %1, %1, %1 quad_perm:[2,3,0,1] row_mask:0xf bank_mask:0xf\n\t"
        "v_add_f32_dpp %2, %2, %2 quad_perm:[2,3,0,1] row_mask:0xf bank_mask:0xf\n\tv_add_f32_dpp %3, %3, %3 quad_perm:[2,3,0,1] row_mask:0xf bank_mask:0xf\n\t"
        "v_add_f32_dpp %4, %4, %4 quad_perm:[2,3,0,1] row_mask:0xf bank_mask:0xf\n\tv_add_f32_dpp %5, %5, %5 quad_perm:[2,3,0,1] row_mask:0xf bank_mask:0xf\n\t"
        "v_add_f32_dpp %6, %6, %6 quad_perm:[2,3,0,1] row_mask:0xf bank_mask:0xf\n\tv_add_f32_dpp %7, %7, %7 quad_perm:[2,3,0,1] row_mask:0xf bank_mask:0xf\n\t"
        "v_add_f32_dpp %0, %0, %0 row_half_mirror row_mask:0xf bank_mask:0xf\n\tv_add_f32_dpp %1, %1, %1 row_half_mirror row_mask:0xf bank_mask:0xf\n\t"
        "v_add_f32_dpp %2, %2, %2 row_half_mirror row_mask:0xf bank_mask:0xf\n\tv_add_f32_dpp %3, %3, %3 row_half_mirror row_mask:0xf bank_mask:0xf\n\t"
        "v_add_f32_dpp %4, %4, %4 row_half_mirror row_mask:0xf bank_mask:0xf\n\tv_add_f32_dpp %5, %5, %5 row_half_mirror row_mask:0xf bank_mask:0xf\n\t"
        "v_add_f32_dpp %6, %6, %6 row_half_mirror row_mask:0xf bank_mask:0xf\n\tv_add_f32_dpp %7, %7, %7 row_half_mirror row_mask:0xf bank_mask:0xf\n\t"
        "s_nop 1"
        : "+v"(a[0]), "+v"(a[1]), "+v"(a[2]), "+v"(a[3]), "+v"(a[4]), "+v"(a[5]), "+v"(a[6]), "+v"(a[7]));
}
__device__ __forceinline__ void sum8i_x8(int (&a)[8]) {
    asm("s_nop 1\n\t"
        "v_add_u32_dpp %0, %0, %0 quad_perm:[1,0,3,2] row_mask:0xf bank_mask:0xf\n\tv_add_u32_dpp %1, %1, %1 quad_perm:[1,0,3,2] row_mask:0xf bank_mask:0xf\n\t"
        "v_add_u32_dpp %2, %2, %2 quad_perm:[1,0,3,2] row_mask:0xf bank_mask:0xf\n\tv_add_u32_dpp %3, %3, %3 quad_perm:[1,0,3,2] row_mask:0xf bank_mask:0xf\n\t"
        "v_add_u32_dpp %4, %4, %4 quad_perm:[1,0,3,2] row_mask:0xf bank_mask:0xf\n\tv_add_u32_dpp %5, %5, %5 quad_perm:[1,0,3,2] row_mask:0xf bank_mask:0xf\n\t"
        "v_add_u32_dpp %6, %6, %6 quad_perm:[1,0,3,2] row_mask:0xf bank_mask:0xf\n\tv_add_u32_dpp %7, %7, %7 quad_perm:[1,0,3,2] row_mask:0xf bank_mask:0xf\n\t"
        "v_add_u32_dpp %0, %0, %0 quad_perm:[2,3,0,1] row_mask:0xf bank_mask:0xf\n\tv_add_u32_dpp %1, %1, %1 quad_perm:[2,3,0,1] row_mask:0xf bank_mask:0xf\n\t"
        "v_add_u32_dpp %2, %2, %2 quad_perm:[2,3,0,1] row_mask:0xf bank_mask:0xf\n\tv_add_u32_dpp %3, %3, %3 quad_perm:[2,3,0,1] row_mask:0xf bank_mask:0xf\n\t"
        "v_add_u32_dpp %4, %4, %4 quad_perm:[2,3,0,1] row_mask:0xf bank_mask:0xf\n\tv_add_u32_dpp %5, %5, %5 quad_perm:[2,3,0,1] row_mask:0xf bank_mask:0xf\n\t"
        "v_add_u32_dpp %6, %6, %6 quad_perm:[2,3,0,1] row_mask:0xf bank_mask:0xf\n\tv_add_u32_dpp %7, %7, %7 quad_perm:[2,3,0,1] row_mask:0xf bank_mask:0xf\n\t"
        "v_add_u32_dpp %0, %0, %0 row_half_mirror row_mask:0xf bank_mask:0xf\n\tv_add_u32_dpp %1, %1, %1 row_half_mirror row_mask:0xf bank_mask:0xf\n\t"
        "v_add_u32_dpp %2, %2, %2 row_half_mirror row_mask:0xf bank_mask:0xf\n\tv_add_u32_dpp %3, %3, %3 row_half_mirror row_mask:0xf bank_mask:0xf\n\t"
        "v_add_u32_dpp %4, %4, %4 row_half_mirror row_mask:0xf bank_mask:0xf\n\tv_add_u32_dpp %5, %5, %5 row_half_mirror row_mask:0xf bank_mask:0xf\n\t"
        "v_add_u32_dpp %6, %6, %6 row_half_mirror row_mask:0xf bank_mask:0xf\n\tv_add_u32_dpp %7, %7, %7 row_half_mirror row_mask:0xf bank_mask:0xf\n\t"
        "s_nop 1"
        : "+v"(a[0]), "+v"(a[1]), "+v"(a[2]), "+v"(a[3]), "+v"(a[4]), "+v"(a[5]), "+v"(a[6]), "+v"(a[7]));
}
__device__ __forceinline__ float max8_x1(float v) {
    asm("s_nop 1\n\tv_max_f32_dpp %0, %0, %0 quad_perm:[1,0,3,2] row_mask:0xf bank_mask:0xf\n\ts_nop 1\n\tv_max_f32_dpp %0, %0, %0 quad_perm:[2,3,0,1] row_mask:0xf bank_mask:0xf\n\ts_nop 1\n\t"
        "v_max_f32_dpp %0, %0, %0 row_half_mirror row_mask:0xf bank_mask:0xf\n\ts_nop 1" : "+v"(v));
    return v;
}
__device__ __forceinline__ float sum8_x1(float v) {
    asm("s_nop 1\n\tv_add_f32_dpp %0, %0, %0 quad_perm:[1,0,3,2] row_mask:0xf bank_mask:0xf\n\ts_nop 1\n\tv_add_f32_dpp %0, %0, %0 quad_perm:[2,3,0,1] row_mask:0xf bank_mask:0xf\n\ts_nop 1\n\t"
        "v_add_f32_dpp %0, %0, %0 row_half_mirror row_mask:0xf bank_mask:0xf\n\ts_nop 1" : "+v"(v));
    return v;
}
__device__ __forceinline__ void peer_phase(const Args& A, Frame& F, int L, const bool dry, const bf16* Hin, bf16* Hout, unsigned char* H8) {
    int lane = F.lane; asm volatile("" : "+v"(lane));
    const int gw = F.vcu * NWAVES + F.wave;
    const bf16* SCR = (const bf16*)(A.ws + WS_SC); const bf16* X = Hin; float* RS3 = (float*)(A.ws + WS_RS3);
    const unsigned char* TU = (const unsigned char*)(A.ws + WS_TABU) + (size_t)L * 16384 * D; const unsigned char* TV = (const unsigned char*)(A.ws + WS_TABV) + (size_t)L * 16384 * D;
    const float* SUL = (const float*)(A.ws + WS_SU) + (size_t)L * 16384; const float* SVL = SUL + 32768;
    const float* rowss = (const float*)(A.ws + WS_RSP) + (size_t)(L == 0 ? RS_FFN0 : RS_FFN1) * T * 32;
    LAS unsigned* LIST = (LAS unsigned*)(F.lds + RING_OFF + F.wave * 16384);
    LAS unsigned* EIDX = LIST + 1024;
    LAS float* ECOEF = (LAS float*)(EIDX + 1024);
    const int tbase = gw * 8;
    if (tbase >= T) return;
    for (int half = 0; half < 2; ++half) {
        const int t0 = tbase + 4 * half;
        {
            const bf16* sp = SCR + (size_t)(t0 + (lane >> 4)) * D + (lane & 15) * 128;
            int vals[16];
#pragma unroll
            for (int s = 0; s < 16; ++s) vals[s] = (int)0x80000000;
#pragma unroll 2
            for (int c = 0; c < 16; ++c) { const v4u wv = *(const GAS v4u*)(sp + c * 8); const unsigned ww[4] = {wv.x, wv.y, wv.z, wv.w};
#pragma unroll
                for (int e = 0; e < 8; ++e) { const unsigned bits = (e & 1) ? (ww[e >> 1] & 0xffff0000u) : (ww[e >> 1] << 16);
                    int x = (int)bits; x ^= (x >> 31) & 0x7fffffff; x = (x & ~0x7f) | (127 - (c * 8 + e));
                    TOPK_INSERT(vals, x); } }
#pragma unroll
            for (int q = 0; q < 4; ++q) { v4u o; o.x = (unsigned)vals[4 * q]; o.y = (unsigned)vals[4 * q + 1]; o.z = (unsigned)vals[4 * q + 2]; o.w = (unsigned)vals[4 * q + 3]; *(LAS v4u*)(LIST + lane * 16 + 4 * q) = o; }
        }
        LDS_WAIT(); asm volatile("" ::: "memory");
        if (lane < 32) {
            const LAS unsigned* la = LIST + ((lane >> 3) * 16 + (lane & 7) * 2) * 16; const LAS unsigned* lb2 = la + 16;
            float av[16], bv[16];
#pragma unroll
            for (int q = 0; q < 4; ++q) { const v4u a4 = *(const LAS v4u*)(la + 4 * q), b4 = *(const LAS v4u*)(lb2 + 4 * q); const unsigned aw[4] = {a4.x, a4.y, a4.z, a4.w}, bw[4] = {b4.x, b4.y, b4.z, b4.w};
#pragma unroll
                for (int e = 0; e < 4; ++e) { av[4 * q + e] = __uint_as_float(__float_as_uint(sort2f((int)(aw[e] & ~0x7fu))) & 0xffff0000u); bv[4 * q + e] = __uint_as_float(__float_as_uint(sort2f((int)(bw[e] & ~0x7fu))) & 0xffff0000u); } }
            int best[16];
#pragma unroll
            for (int s = 0; s < 16; ++s) best[s] = (int)0x80000000;
#pragma unroll
            for (int i = 0; i < 16; ++i)
#pragma unroll
                for (int jx = 0; jx < 16; ++jx) if ((i + 1) * (jx + 1) <= 16) { int x = f2sort(av[i] + bv[jx]); x = (x & ~0xff) | (255 - (i * 16 + jx)); TOPK_INSERT(best, x); }
            float sv[16]; unsigned ex[16];
#pragma unroll
            for (int s = 0; s < 16; ++s) { const int cand = 255 - (best[s] & 0xff); const unsigned ka = la[cand >> 4], kb = lb2[cand & 15];
                ex[s] = (127u - (ka & 0x7fu)) * 128u + (127u - (kb & 0x7fu));
                sv[s] = __uint_as_float(__float_as_uint(sort2f((int)(ka & ~0x7fu))) & 0xffff0000u) + __uint_as_float(__float_as_uint(sort2f((int)(kb & ~0x7fu))) & 0xffff0000u); }
            float mx = sv[0];
#pragma unroll
            for (int s = 1; s < 16; ++s) mx = fmaxf(mx, sv[s]);
            float den = 0.f;
#pragma unroll
            for (int s = 0; s < 16; ++s) { sv[s] = __expf(sv[s] - mx); den += sv[s]; }
            const float inv = 1.0f / den; const int base = (4 * half + (lane >> 3)) * 128 + (lane & 7) * 16;
#pragma unroll
            for (int s = 0; s < 16; ++s) { EIDX[base + s] = ex[s]; ECOEF[base + s] = sv[s] * inv; }
        }
        LDS_WAIT(); asm volatile("" ::: "memory");
    }
    const int tk = lane >> 3, part = lane & 7, t = tbase + tk;
    const LAS unsigned* eidx = EIDX + tk * 128; LAS float* ecoef = ECOEF + tk * 128;
    const float rs = __builtin_amdgcn_rsqf(sum8_x1(((const GAS f32x4*)(rowss + (size_t)t * 32))[part][0] + ((const GAS f32x4*)(rowss + (size_t)t * 32))[part][1] + ((const GAS f32x4*)(rowss + (size_t)t * 32))[part][2] + ((const GAS f32x4*)(rowss + (size_t)t * 32))[part][3]) * (1.0f / D) + EPS);
    typedef _Float16 h2_t __attribute__((ext_vector_type(2)));
#if PEER_ALIAS
    const unsigned amask = dry ? 1023u : 0xffffffffu;
#else
    constexpr unsigned amask = 0xffffffffu;
#endif
#define PEER_LOAD8(dst, TAB, i0, soff) do { const v4u ia_ = *(const LAS v4u*)(eidx + (i0)), ib_ = *(const LAS v4u*)(eidx + (i0) + 4); const unsigned ee_[8] = {ia_.x, ia_.y, ia_.z, ia_.w, ib_.x, ib_.y, ib_.z, ib_.w}; \
        _Pragma("unroll") for (int j_ = 0; j_ < 8; ++j_) dst[j_] = *(const GAS v4u*)((TAB) + (size_t)((ee_[j_] & amask) * 2048u + (unsigned)(soff))); } while (0)
    LAS float* dotw = (LAS float*)LIST + tk * 128;
#pragma unroll
    for (int m = 0; m < 16; ++m) dotw[8 * m + part] = 0.f;
#pragma unroll 1
    for (int p = 0; p < 16; ++p) {
        const int soff = 128 * p + 16 * part;
        unsigned xq[4]; float sxs;
        { const v4u x0 = *(const GAS v4u*)(X + (size_t)t * D + soff), x1 = *(const GAS v4u*)(X + (size_t)t * D + soff + 8); const unsigned xw[8] = {x0.x, x0.y, x0.z, x0.w, x1.x, x1.y, x1.z, x1.w};
          float xv[16], am = 0.f;
#pragma unroll
          for (int e = 0; e < 8; ++e) { xv[2 * e] = bf_lo(xw[e]); xv[2 * e + 1] = bf_hi(xw[e]); am = fmaxf(am, fmaxf(fabsf(xv[2 * e]), fabsf(xv[2 * e + 1]))); }
          am = max8_x1(am); sxs = am * (1.0f / 127.0f); const float inv = am > 0.f ? 127.0f / am : 0.f;
#pragma unroll
          for (int q = 0; q < 4; ++q) { unsigned w = 0;
#pragma unroll
              for (int e = 0; e < 4; ++e) w |= (__float_as_uint(__builtin_fmaf(xv[4 * q + e], inv, 12582912.0f)) & 255u) << (8 * e);
              xq[q] = w; } }
#define PEER_UDOT8(src, m_) do { int tt_[8]; \
        _Pragma("unroll") for (int j_ = 0; j_ < 8; ++j_) { int a_ = __builtin_amdgcn_sdot4((int)src[j_].x, (int)xq[0], 0, false); a_ = __builtin_amdgcn_sdot4((int)src[j_].y, (int)xq[1], a_, false); \
            a_ = __builtin_amdgcn_sdot4((int)src[j_].z, (int)xq[2], a_, false); tt_[j_] = __builtin_amdgcn_sdot4((int)src[j_].w, (int)xq[3], a_, false); } \
        sum8i_x8(tt_); \
        int sel_ = tt_[0]; _Pragma("unroll") for (int j_ = 1; j_ < 8; ++j_) sel_ = (part == j_) ? tt_[j_] : sel_; \
        dotw[8 * (m_) + part] += (float)sel_ * sxs; } while (0)
        v4u ua[8], ub[8];
        PEER_LOAD8(ua, TU, 0, soff);
#pragma unroll 1
        for (int m = 0; m < 16; m += 2) {
            PEER_LOAD8(ub, TU, 8 * (m + 1), soff);
            PEER_UDOT8(ua, m);
            if (m + 2 < 16) PEER_LOAD8(ua, TU, 8 * (m + 2), soff);
            PEER_UDOT8(ub, m + 1);
        }
    }
#undef PEER_UDOT8
    LAS unsigned char* ecq = (LAS unsigned char*)(LIST + 3072) + tk * 128;
    float sc;
    { float cf[16], cm = 0.f;
#pragma unroll
      for (int m = 0; m < 16; ++m) { const unsigned e_ = eidx[8 * m + part]; const float d_ = dotw[8 * m + part] * rs * SUL[e_]; const float act = 0.5f * d_ * (1.0f + erff(d_ * 0.7071067811865476f));
          cf[m] = ecoef[8 * m + part] * act * SVL[e_]; cm = fmaxf(cm, fabsf(cf[m])); }
      cm = max8_x1(cm); sc = cm * (1.0f / 127.0f); const float inv = cm > 0.f ? 127.0f / cm : 0.f;
#pragma unroll
      for (int m = 0; m < 16; ++m) ecq[8 * m + part] = (unsigned char)(__float_as_uint(__builtin_fmaf(cf[m], inv, 12582912.0f)) & 255u); }
    LDS_WAIT(); asm volatile("" ::: "memory");
    float ss = 0.f;
#pragma unroll 1
    for (int p = 0; p < 16; ++p) {
        const int soff = 128 * p + 16 * part;
        int acc[16];
#pragma unroll
        for (int i = 0; i < 16; ++i) acc[i] = 0;
#define PEER_VACC8(src, i0) do { const u32x2 c8_ = *(const LAS u32x2*)(ecq + (i0)); \
        _Pragma("unroll") for (int h_ = 0; h_ < 2; ++h_) { const int cq_ = (int)(h_ ? c8_.y : c8_.x); \
            _Pragma("unroll") for (int q_ = 0; q_ < 4; ++q_) { \
                const unsigned a_ = q_ == 0 ? src[4 * h_].x : q_ == 1 ? src[4 * h_].y : q_ == 2 ? src[4 * h_].z : src[4 * h_].w, b_ = q_ == 0 ? src[4 * h_ + 1].x : q_ == 1 ? src[4 * h_ + 1].y : q_ == 2 ? src[4 * h_ + 1].z : src[4 * h_ + 1].w; \
                const unsigned c_ = q_ == 0 ? src[4 * h_ + 2].x : q_ == 1 ? src[4 * h_ + 2].y : q_ == 2 ? src[4 * h_ + 2].z : src[4 * h_ + 2].w, d_ = q_ == 0 ? src[4 * h_ + 3].x : q_ == 1 ? src[4 * h_ + 3].y : q_ == 2 ? src[4 * h_ + 3].z : src[4 * h_ + 3].w; \
                const unsigned lab_ = __builtin_amdgcn_perm(b_, a_, 0x05010400u), hab_ = __builtin_amdgcn_perm(b_, a_, 0x07030602u), lcd_ = __builtin_amdgcn_perm(d_, c_, 0x05010400u), hcd_ = __builtin_amdgcn_perm(d_, c_, 0x07030602u); \
                acc[4 * q_ + 0] = __builtin_amdgcn_sdot4((int)__builtin_amdgcn_perm(lcd_, lab_, 0x05040100u), cq_, acc[4 * q_ + 0], false); \
                acc[4 * q_ + 1] = __builtin_amdgcn_sdot4((int)__builtin_amdgcn_perm(lcd_, lab_, 0x07060302u), cq_, acc[4 * q_ + 1], false); \
                acc[4 * q_ + 2] = __builtin_amdgcn_sdot4((int)__builtin_amdgcn_perm(hcd_, hab_, 0x05040100u), cq_, acc[4 * q_ + 2], false); \
                acc[4 * q_ + 3] = __builtin_amdgcn_sdot4((int)__builtin_amdgcn_perm(hcd_, hab_, 0x07060302u), cq_, acc[4 * q_ + 3], false); } } } while (0)
        v4u va[8], vb[8];
        PEER_LOAD8(va, TV, 0, soff);
#pragma unroll 1
        for (int m = 0; m < 16; m += 2) {
            PEER_LOAD8(vb, TV, 8 * (m + 1), soff);
            PEER_VACC8(va, 8 * m);
            if (m + 2 < 16) PEER_LOAD8(va, TV, 8 * (m + 2), soff);
            PEER_VACC8(vb, 8 * (m + 1));
        }
        { const v4u h0 = *(const GAS v4u*)(Hin + (size_t)t * D + soff), h1 = *(const GAS v4u*)(Hin + (size_t)t * D + soff + 8); const unsigned hw[8] = {h0.x, h0.y, h0.z, h0.w, h1.x, h1.y, h1.z, h1.w}; unsigned ow[8];
#pragma unroll
          for (int e = 0; e < 8; ++e) { ow[e] = hw_pk2(bf_lo(hw[e]) + (float)acc[2 * e] * sc, bf_hi(hw[e]) + (float)acc[2 * e + 1] * sc); const float q0 = bf_lo(ow[e]), q1 = bf_hi(ow[e]); ss += q0 * q0 + q1 * q1; }
          v4u o0, o1; o0.x = ow[0]; o0.y = ow[1]; o0.z = ow[2]; o0.w = ow[3]; o1.x = ow[4]; o1.y = ow[5]; o1.z = ow[6]; o1.w = ow[7];
          if (!dry) { *(GAS v4u*)(Hout + (size_t)t * D + soff) = o0; *(GAS v4u*)(Hout + (size_t)t * D + soff + 8) = o1;
            if (H8) { v4u o8; unsigned q8[4];
#pragma unroll
              for (int e = 0; e < 4; ++e) { int x8 = __builtin_amdgcn_cvt_pk_fp8_f32(bf_lo(ow[2 * e]), bf_hi(ow[2 * e]), 0, false); x8 = __builtin_amdgcn_cvt_pk_fp8_f32(bf_lo(ow[2 * e + 1]), bf_hi(ow[2 * e + 1]), x8, true); q8[e] = (unsigned)x8; }
              o8.x = q8[0]; o8.y = q8[1]; o8.z = q8[2]; o8.w = q8[3]; *(GAS v4u*)(H8 + (size_t)t * D + soff) = o8; } } else asm volatile("" :: "v"(o0.x), "v"(o0.y), "v"(o0.z), "v"(o0.w), "v"(o1.x), "v"(o1.y), "v"(o1.z), "v"(o1.w)); }
    }
#undef PEER_VACC8
#undef PEER_LOAD8
    const float r3 = __builtin_amdgcn_rsqf(sum8_x1(ss) * (1.0f / D) + EPS);
    if (!dry && part == 0) RS3[t] = r3;
}


constexpr int N_PHASES = 19;
__global__ void __launch_bounds__(NTHREADS, 2) mega_fwd(Args args) {

    extern __shared__ __attribute__((aligned(16))) unsigned char lds[];
    Frame F;
    F.lds = (LAS unsigned char*)lds;
    F.MISC = (volatile LAS unsigned*)(F.lds + MISC_OFF);
    F.tid = threadIdx.x; F.lane = F.tid & 63; F.wave = __builtin_amdgcn_readfirstlane(F.tid >> 6);
    F.G = gridDim.x; { const int bx = blockIdx.x; F.vcu = (F.G % 8 == 0) ? (bx % 8) * (F.G / 8) + bx / 8 : bx; }
    unsigned char* ws = args.ws;
    F.ctl = (gu32*)(ws + WS_CTL);
    for (int u = F.tid; u < (LDS_BYTES - LDSCTL_OFF) / 4; u += NTHREADS) ((LAS unsigned*)(F.lds + LDSCTL_OFF))[u] = 0u;
    __syncthreads();
    const int lo = args.ph_lo, hi = args.ph_hi;
    XcdBarrier bar; bar.bar = (unsigned*)(F.ctl + CW_BAR); bar.x = 0; bar.st = nullptr;
    if (hi - lo > 1) bar = xcd_barrier_post((unsigned*)(F.ctl + CW_BAR), F.MISC + 8);
    bar.wave0 = (F.wave == 0);
#define IN(k) (lo <= (k) && (k) < hi)
#define REFRESH() do { int t_; asm volatile("v_mbcnt_lo_u32_b32 %0, -1, 0\n\tv_mbcnt_hi_u32_b32 %0, -1, %0" : "=v"(t_)); F.lane = t_; F.tid = F.wave * 64 + t_; } while (0)
#define REPS(k) (1 + ((DUP_MASK >> (k)) & 1))
#if PROBE_MASK
    unsigned long long* const tsb = (unsigned long long*)(ws + WS_CTL + 65536);
#define STAMP(k) do { if (blockIdx.x == 0 && F.tid == 0) __hip_atomic_store(tsb + (k), __builtin_amdgcn_s_memrealtime(), __ATOMIC_RELAXED, __HIP_MEMORY_SCOPE_AGENT); } while (0)
    STAMP(31);
#else
#define STAMP(k) do { } while (0)
#endif
#define DEFERRED_QUEUE(fn, ctrword) do { constexpr unsigned NQ_ = 768u; for (;;) { if (F.tid == 0) F.MISC[0] = __hip_atomic_fetch_add(F.ctl + (ctrword), 1u, __ATOMIC_RELAXED, __HIP_MEMORY_SCOPE_AGENT); \
        __syncthreads(); const unsigned v_ = F.MISC[0]; __syncthreads(); if (v_ >= NQ_) break; fn(args, F, (int)v_, (int)NQ_); } } while (0)
#define SEAM(k) do { if (IN(k) && IN((k) + 1)) { if ((k) == 0) { cg::this_grid().sync(); } else { xcd_barrier(bar); if ((DUP_MASK >> 24) & 1) xcd_barrier(bar); } STAMP(k); } } while (0)
    float* rowss = (float*)(ws + WS_RSP);
    bf16* ACTA = (bf16*)(ws + WS_ACTA); bf16* ACTB = (bf16*)(ws + WS_ACTB); bf16* H1 = (bf16*)(ws + WS_H1); const float* RS3 = (const float*)(ws + WS_RS3);
    bf16* PROJ = (bf16*)(ws + WS_PROJ); bf16* SCB = (bf16*)(ws + WS_SC); bf16* PP = (bf16*)(ws + WS_PP);
    const int gtid = (F.vcu * NWAVES + F.wave) * 64 + F.lane, gthreads = F.G * NTHREADS;

#if UBENCH
    {
        typedef _Float16 h2_t __attribute__((ext_vector_type(2)));
        float a[32]; f32x2 p[16]; h2_t hh[32];
#pragma unroll
        for (int i = 0; i < 32; ++i) { a[i] = (float)(F.tid + i); hh[i] = (h2_t){(_Float16)(F.lane + i), (_Float16)i}; }
#pragma unroll
        for (int i = 0; i < 16; ++i) p[i] = (f32x2){a[2 * i], a[2 * i + 1]};
        const float m = 1.0f + 1e-7f * F.lane, c = 1e-9f; const f32x2 m2 = {m, m}, c2 = {c, c}; const h2_t mh = {(_Float16)1.0f, (_Float16)1.0f}, ch = {(_Float16)0.0f, (_Float16)0.0f};
#pragma unroll 1
        for (int it = 0; it < 10000; ++it) {
#if UBENCH == 1
#pragma unroll
            for (int i = 0; i < 32; ++i) asm volatile("v_fma_f32 %0, %0, %1, %2" : "+v"(a[i]) : "v"(m), "v"(c));
#elif UBENCH == 2
#pragma unroll
            for (int i = 0; i < 16; ++i) asm volatile("v_pk_fma_f32 %0, %0, %1, %2\n\tv_pk_fma_f32 %0, %0, %1, %2" : "+v"(p[i]) : "v"(m2), "v"(c2));
#elif UBENCH == 3
#pragma unroll
            for (int i = 0; i < 32; ++i) asm volatile("v_pk_fma_f16 %0, %0, %1, %2" : "+v"(hh[i]) : "v"(mh), "v"(ch));
#endif
        }
        float s = 0.f;
#pragma unroll
        for (int i = 0; i < 32; ++i) s += a[i] + (float)hh[i][0];
#pragma unroll
        for (int i = 0; i < 16; ++i) s += p[i][0] + p[i][1];
        if (s == 12345.678f) args.out[0] = s;
    }
#endif
    if (IN(0)) { REFRESH(); p0_prologue(args, F, 0); if (hi - lo > 1) { xcd_barrier(bar); REFRESH(); p0_prologue(args, F, 1); } } SEAM(0);
    if (IN(1)) for (int rep_ = 0; rep_ < REPS(1); ++rep_) { REFRESH();
#if EV_F8_T1 > EV_F8_T0
        if (EV_F8_T0 > 0) { constexpr int n_ = EV_F8_T0 * 256; pg8::Gemm g{ACTA, (const bf16*)(ws + WS_WEV_IN), T, n_, D}; pg8::StaticOrder S; S.init(T, n_, F.G, (int)blockIdx.x); EpiBf16S E{PROJ, PROJ_LD, nullptr};
          pg8::gemm_phase<EpiBf16S, pg8::StaticOrder, true, true>(F.lds + RING_OFF, g, S, E, F.wave); }
        { constexpr int n_ = (EV_F8_T1 - EV_F8_T0) * 256; pg8::Gemm g{(const bf16*)(ws + WS_H1), (const bf16*)(ws + WS_O + (size_t)EV_F8_T0 * 256 * D), T, n_, D / 2}; pg8::StaticOrder S; S.init(T, n_, F.G, (int)blockIdx.x); EpiBf16S E{PROJ + EV_F8_T0 * 256, PROJ_LD, nullptr};
          pg8::gemm_phase<EpiBf16S, pg8::StaticOrder, true, true, true>(F.lds + RING_OFF, g, S, E, F.wave); }
        if (EV_F8_T1 < EV_NP / 256) { constexpr int n_ = EV_NP - EV_F8_T1 * 256; pg8::Gemm g{ACTA, (const bf16*)(ws + WS_WEV_IN) + (size_t)EV_F8_T1 * 256 * D, T, n_, D}; pg8::StaticOrder S; S.init(T, n_, F.G, (int)blockIdx.x); EpiBf16S E{PROJ + EV_F8_T1 * 256, PROJ_LD, nullptr};
          pg8::gemm_phase<EpiBf16S, pg8::StaticOrder, true, true>(F.lds + RING_OFF, g, S, E, F.wave); }
        if (true) { const int g2 = F.G, c2 = (int)blockIdx.x;
#else
        { pg8::Gemm g{ACTA, (const bf16*)(ws + WS_WEV_IN), T, EV_NP, D / 2}; pg8::StaticOrder S; S.init(T, EV_NP, F.G, (int)blockIdx.x); EpiI8S E{PROJ, PROJ_LD, (const float*)(ws + WS_SA), (const float*)(ws + WS_CMB)};
          pg8::gemm_phase<EpiI8S, pg8::StaticOrder, true, true, false, true>(F.lds + RING_OFF, g, S, E, F.wave); }
        if (F.G < 256) { const int g2 = F.G, c2 = (int)blockIdx.x;
#endif
          pg8::Gemm g{(const bf16*)(ws + WS_PBF), (const bf16*)(ws + WS_WPROJ), T, D, 256}; pg8::StaticOrder S; S.init(T, D, g2, c2); EpiBf16S E{PP, D, nullptr};
          pg8::gemm_phase<EpiBf16S, pg8::StaticOrder, true, true>(F.lds + RING_OFF, g, S, E, F.wave); }
    } SEAM(1);
    if (IN(2)) for (int rep_ = 0; rep_ < REPS(2); ++rep_) { REFRESH();
        if (F.G >= 256) {
            const int u = F.vcu;
            if (u < 64) scan_gla_mfma_unit<0>(args, F, u); else if (u < 128) scan_gdn_mfma_unit(args, F, u - 64, 0); else if (u < 192) scan_gdn_mfma_unit(args, F, u - 128, 1);
            __syncthreads();
            if (rep_ == 0 && u >= 64 && u < 128) {
                const int c = u - 64; bf16* pb = (bf16*)(ws + WS_PBF);
                cvt_f32_bf16(args.in[I_P] + (size_t)c * 65536, pb + (size_t)c * 65536, 65536, F.tid, NTHREADS);
                asm volatile("s_waitcnt vmcnt(0)" ::: "memory"); __syncthreads();
                pg8::Gemm g{pb, (const bf16*)(ws + WS_WPROJ), T, D, 256}; pg8::RowBlockOrder S{c, D / 256}; EpiBf16S E{PP, D, nullptr};
                pg8::gemm_phase<EpiBf16S, pg8::RowBlockOrder, true, true>(F.lds + RING_OFF, g, S, E, F.wave); }
            if (rep_ == 0) DEFERRED_QUEUE(p0_deferred, 1024);
        } else {
            for (int u = F.vcu; u < 64; u += F.G) { scan_gla_mfma_unit<0>(args, F, u); __syncthreads(); }
            for (int u = F.vcu; u < 64; u += F.G) { scan_gdn_mfma_unit(args, F, u, 0); __syncthreads(); scan_gdn_mfma_unit(args, F, u, 1); __syncthreads(); }
            if (rep_ == 0) p0_deferred(args, F, F.vcu, F.G);
        }
    } SEAM(2);
    if (IN(3)) for (int rep_ = 0; rep_ < REPS(3); ++rep_) { REFRESH(); post_rows<0>(args, F); } SEAM(3);
    if (IN(4)) { REFRESH(); pg8::Gemm g{ACTA, (const bf16*)(ws + WS_WEV_OUT), T, D, D}; pg8::StaticOrder S; S.init(T, D, F.G, (int)blockIdx.x);
        EpiResid<false, true> E{args.in[I_X], ACTB, rowss + (size_t)RS_FFN0 * T * 32, nullptr, nullptr, nullptr, nullptr, nullptr};
        pg8::gemm_phase<EpiResid<false, true>, pg8::StaticOrder, true, true>(F.lds + RING_OFF, g, S, E, F.wave); }
#if (DUP_MASK >> 20) & 1
    if (IN(4)) { REFRESH(); pg8::Gemm g{ACTA, (const bf16*)(ws + WS_WEV_OUT), T, D, D}; pg8::StaticOrder S; S.init(T, D, F.G, (int)blockIdx.x);
        EpiResid<false, true> E{args.in[I_X], ACTB, rowss + (size_t)RS_FFN0 * T * 32, nullptr, nullptr, nullptr};
        pg8::gemm_phase<EpiResid<false, true>, pg8::StaticOrder, true, true>(F.lds + RING_OFF, g, S, E, F.wave); }
#endif
#if (DUP_MASK >> 21) & 1
    if (IN(4)) { REFRESH(); pg8::Gemm g{ACTA, (const bf16*)(ws + WS_WEV_IN), T, EV_NP, D}; pg8::StaticOrder S; S.init(T, EV_NP, F.G, (int)blockIdx.x); EpiBf16S E{PROJ, PROJ_LD, nullptr};
        pg8::gemm_phase<EpiBf16S, pg8::StaticOrder, true, true>(F.lds + RING_OFF, g, S, E, F.wave); }
#endif
    SEAM(4);
    if (IN(5)) for (int rep_ = 0; rep_ < REPS(5); ++rep_) { REFRESH(); { pg8::Gemm g{ACTB, (const bf16*)(ws + WS_WPEER), T, D, D}; pg8::StaticOrder S; S.init(T, D, F.G, (int)blockIdx.x); EpiBf16S E{SCB, D, rowss + (size_t)RS_FFN0 * T * 32};
        pg8::gemm_phase<EpiBf16S, pg8::StaticOrder, true, true>(F.lds + RING_OFF, g, S, E, F.wave); }
        } SEAM(5);
    if (IN(6)) for (int rep_ = 0; rep_ < REPS(6); ++rep_) { REFRESH(); peer_phase(args, F, 0, rep_ != 0, ACTB, H1, (unsigned char*)ACTA); } SEAM(6);
    if (IN(7)) { REFRESH(); { pg8::Gemm g{ACTA, (const bf16*)(ws + WS_WGATE), T, D, D / 2}; pg8::StaticOrder S; S.init(T, D, F.G, (int)blockIdx.x);
        EpiResid<true, false> E{H1, ACTB, rowss + (size_t)RS_MIX1 * T * 32, PP, RS3, (unsigned char*)ACTA + (size_t)T * D};
        pg8::gemm_phase<EpiResid<true, false>, pg8::StaticOrder, true, true, true>(F.lds + RING_OFF, g, S, E, F.wave); }
        } SEAM(7);
    if (IN(8)) for (int rep_ = 0; rep_ < REPS(8); ++rep_) { REFRESH();
        { pg8::Gemm g{(const bf16*)((const unsigned char*)ACTA + (size_t)T * D), (const bf16*)(ws + WS_WOD_IN), T, OD_NP, D / 2}; pg8::StaticOrder S; S.init(T, OD_NP, F.G, (int)blockIdx.x); EpiBf16S E{PROJ, PROJ_LD, rowss + (size_t)RS_MIX1 * T * 32};
          pg8::gemm_phase<EpiBf16S, pg8::StaticOrder, true, true, true>(F.lds + RING_OFF, g, S, E, F.wave); }
        if (F.G < 256) { pg8::Gemm g{(const bf16*)(ws + WS_PBF) + (size_t)T * 256, (const bf16*)(ws + WS_WPROJ) + (size_t)D * 256, T, D, 256}; pg8::StaticOrder S; S.init(T, D, F.G, (int)blockIdx.x); EpiBf16S E{PP, D, nullptr};
          pg8::gemm_phase<EpiBf16S, pg8::StaticOrder, true, true>(F.lds + RING_OFF, g, S, E, F.wave); }
    } SEAM(8);
    if (IN(9)) for (int rep_ = 0; rep_ < REPS(9); ++rep_) { REFRESH(); lora_prep_rows(args, F); } SEAM(9);
    if (IN(10)) for (int rep_ = 0; rep_ < REPS(10); ++rep_) { REFRESH();
        { pg8::Gemm g{(const bf16*)(ws + WS_LA), (const bf16*)(ws + WS_WLORA), T, 1024, LORA_K, 128}; pg8::StaticOrder S; S.init(T, 1024, F.G, (int)blockIdx.x); EpiBf16S E{(bf16*)(ws + WS_LO), LORA_N, nullptr};
          pg8::gemm_phase<EpiBf16S, pg8::StaticOrder, true, true>(F.lds + RING_OFF, g, S, E, F.wave); }
        { pg8::Gemm g{(const bf16*)(ws + WS_LA) + 64, (const bf16*)(ws + WS_WLORA) + (size_t)1024 * LORA_K + 64, T, 1024, LORA_K, 128}; pg8::StaticOrder S; S.init(T, 1024, F.G, (int)blockIdx.x); EpiBf16S E{(bf16*)(ws + WS_LO) + 1024, LORA_N, nullptr};
          pg8::gemm_phase<EpiBf16S, pg8::StaticOrder, true, true>(F.lds + RING_OFF, g, S, E, F.wave); }
        { pg8::Gemm g{(const bf16*)(ws + WS_LA) + 192, (const bf16*)(ws + WS_WLORA) + (size_t)2048 * LORA_K + 192, T, 1024, LORA_K, 256}; pg8::StaticOrder S; S.init(T, 1024, F.G, (int)blockIdx.x); EpiBf16S E{(bf16*)(ws + WS_LO) + 2048, LORA_N, nullptr};
          pg8::gemm_phase<EpiBf16S, pg8::StaticOrder, true, true>(F.lds + RING_OFF, g, S, E, F.wave); }
    } SEAM(10);
    if (IN(11)) for (int rep_ = 0; rep_ < REPS(11); ++rep_) { REFRESH();
        if (F.G >= 256) {
            const int u = F.vcu;
            if (u < 64) scan_gla_mfma_unit<1>(args, F, u); else if (u < 128) scan_rwkv_mfma_unit(args, F, u - 64, 0); else if (u < 192) scan_rwkv_mfma_unit(args, F, u - 128, 1);
            __syncthreads();
            if (rep_ == 0 && u >= 64 && u < 128) {
                const int c = u - 64; bf16* pb = (bf16*)(ws + WS_PBF) + (size_t)T * 256;
                cvt_f32_bf16(args.in[I_P] + (size_t)T * 256 + (size_t)c * 65536, pb + (size_t)c * 65536, 65536, F.tid, NTHREADS);
                asm volatile("s_waitcnt vmcnt(0)" ::: "memory"); __syncthreads();
                pg8::Gemm g{pb, (const bf16*)(ws + WS_WPROJ) + (size_t)D * 256, T, D, 256}; pg8::RowBlockOrder S{c, D / 256}; EpiBf16S E{PP, D, nullptr};
                pg8::gemm_phase<EpiBf16S, pg8::RowBlockOrder, true, true>(F.lds + RING_OFF, g, S, E, F.wave); }
            if (rep_ == 0) DEFERRED_QUEUE(p1_deferred, 1025);
        } else {
            for (int u = F.vcu; u < 64; u += F.G) { scan_gla_mfma_unit<1>(args, F, u); __syncthreads(); }
            for (int u = F.vcu; u < 64; u += F.G) { scan_rwkv_mfma_unit(args, F, u, 0); __syncthreads(); scan_rwkv_mfma_unit(args, F, u, 1); __syncthreads(); }
            if (rep_ == 0) p1_deferred(args, F, F.vcu, F.G);
        }
    } SEAM(11);
    if (IN(13)) { REFRESH(); pg8::Gemm g{ACTA, (const bf16*)(ws + WS_WOD_OUT), T, D, D / 2}; pg8::StaticOrder S; S.init(T, D, F.G, (int)blockIdx.x);
        EpiResid<false, false> E{ACTB, H1, rowss + (size_t)RS_FFN1 * T * 32, nullptr, nullptr, nullptr};
        pg8::gemm_phase<EpiResid<false, false>, pg8::StaticOrder, true, true, true>(F.lds + RING_OFF, g, S, E, F.wave); } SEAM(13);
    if (IN(14)) for (int rep_ = 0; rep_ < REPS(14); ++rep_) { REFRESH(); pg8::Gemm g{H1, (const bf16*)(ws + WS_WPEER) + (size_t)D * D, T, D, D}; pg8::StaticOrder S; S.init(T, D, F.G, (int)blockIdx.x); EpiBf16S E{SCB, D, rowss + (size_t)RS_FFN1 * T * 32};
        pg8::gemm_phase<EpiBf16S, pg8::StaticOrder, true, true>(F.lds + RING_OFF, g, S, E, F.wave); } SEAM(14);
    if (IN(15)) for (int rep_ = 0; rep_ < REPS(15); ++rep_) { REFRESH(); peer_phase(args, F, 1, rep_ != 0, H1, ACTB, (unsigned char*)ACTA); } SEAM(15);
    if (IN(16)) { REFRESH(); pg8::Gemm g{ACTA, (const bf16*)(ws + WS_WGATE) + (size_t)D * D, T, D, D / 2}; pg8::StaticOrder S; S.init(T, D, F.G, (int)blockIdx.x);
        EpiResid<true, false> E{ACTB, H1, rowss + (size_t)RS_FINAL * T * 32, PP, RS3, nullptr};
        pg8::gemm_phase<EpiResid<true, false>, pg8::StaticOrder, true, true, true>(F.lds + RING_OFF, g, S, E, F.wave); } SEAM(16);
    if (IN(17)) { REFRESH();
        float oscale = 1.0f;
#if PROBE_MASK
        { unsigned long long t_prev = __hip_atomic_load(tsb + 31, __ATOMIC_RELAXED, __HIP_MEMORY_SCOPE_AGENT); const unsigned long long t_begin = t_prev; unsigned long long sel = 0ull;
          for (int k = 0; k <= 16; ++k) { const unsigned long long tk = __hip_atomic_load(tsb + k, __ATOMIC_RELAXED, __HIP_MEMORY_SCOPE_AGENT); if ((PROBE_MASK >> k) & 1) sel += tk - t_prev; t_prev = tk; }
          const float f = (float)(double(sel) / double(t_prev - t_begin)); oscale = 1.0f + sqrtf(0.01f + 0.9f * f); }
#endif
        final_rows(args, F, oscale, H1); }
#undef IN
#undef SEAM
#undef REFRESH
}

extern "C" void kernel_launch(void* const* d_in, const int* in_sizes, int n_in, void* d_out, int out_size, void* d_ws, size_t ws_size, hipStream_t stream) {
    static int grid = 0;
    if (grid == 0) {
        if (n_in != N_IN || out_size != T * D || ws_size < WS_END + 63 * MiB) { fprintf(stderr, "kernel_launch: unexpected problem: n_in %d out %d ws %zu (need %zu)\n", n_in, out_size, ws_size, (size_t)(WS_END + 63 * MiB)); grid = -1; return; }
        int dev = 0, cus = 0, per_cu = 0;
        if (hipGetDevice(&dev) != hipSuccess || hipDeviceGetAttribute(&cus, hipDeviceAttributeMultiprocessorCount, dev) != hipSuccess) { grid = -1; return; }
        if (hipFuncSetAttribute((const void*)mega_fwd, hipFuncAttributeMaxDynamicSharedMemorySize, LDS_BYTES) != hipSuccess) { fprintf(stderr, "kernel_launch: hipFuncSetAttribute failed\n"); grid = -1; return; }
        if (hipOccupancyMaxActiveBlocksPerMultiprocessor(&per_cu, (const void*)mega_fwd, NTHREADS, LDS_BYTES) != hipSuccess || per_cu < 1) { fprintf(stderr, "kernel_launch: occupancy query says %d blocks per CU\n", per_cu); (void)hipGetLastError(); grid = -1; return; }
        grid = cus;
    }
    if (grid < 0) return;
    (void)hipMemsetAsync((char*)d_ws + WS_CTL, 0, CTL_ZERO_BYTES, stream);
    Args a{};
    for (int i = 0; i < N_IN; ++i) a.in[i] = (const float*)d_in[i];
    a.out = (float*)d_out; a.ws = (unsigned char*)d_ws;
#if MK_PER_PHASE
    for (int p = 0; p < N_PHASES - 1; ++p) { a.ph_lo = p; a.ph_hi = p + 1; hipLaunchKernelGGL(mega_fwd, dim3(grid), dim3(NTHREADS), LDS_BYTES, stream, a); }
#else
    a.ph_lo = 0; a.ph_hi = N_PHASES;
    void* kargs[] = {&a};
    hipError_t e = hipLaunchCooperativeKernel((const void*)mega_fwd, dim3(grid), dim3(NTHREADS), kargs, LDS_BYTES, stream);
    if (e != hipSuccess) fprintf(stderr, "kernel_launch: cooperative launch failed: %s (grid %d)\n", hipGetErrorString(e), grid);
#endif
}
```

```cpp
#include <hip/hip_runtime.h>
#include <hip/hip_cooperative_groups.h>
#include <cstdio>
#include <cstdint>
namespace cg = cooperative_groups;

#ifndef PROBE_MASK
#define PROBE_MASK 0
#endif
#ifndef DUP_MASK
#define DUP_MASK 0
#endif
#ifndef UBENCH
#define UBENCH 0
#endif
#ifndef GDN_DUP
#define GDN_DUP 0
#endif
#ifndef MK_PER_PHASE
#ifndef PEER_ALIAS
#define PEER_ALIAS 0
#endif
#ifndef EV_F8_T0
#define EV_F8_T0 0
#define EV_F8_T1 0
#endif
#define MK_PER_PHASE 0
#endif

namespace pg8 {
#define PG8_LAS __attribute__((address_space(3)))
typedef unsigned short bf16_t;
typedef short bf16x8 __attribute__((ext_vector_type(8)));
typedef float f32x4 __attribute__((ext_vector_type(4)));
typedef unsigned u32x4 __attribute__((ext_vector_type(4)));
typedef unsigned u32x2 __attribute__((ext_vector_type(2)));
constexpr int BM = 256, BK = 64, HALF = 128, HTB = HALF * BK * 2  , STAGE_BYTES = 8 * HTB, NXCD = 8, WGM = 8;

__host__ __device__ __forceinline__ int lds_byte(int r, int c) { const int st = (r >> 4) * 2 + (c >> 5), rr = r & 15, cc = c & 31, ob = rr * 64 + cc * 2; return st * 1024 + (ob ^ (((ob >> 9) & 1) << 5)); }
__host__ __device__ __forceinline__ void stage_rc(int b, int& R, int& C) { const int st = b / 1024, sb = b % 1024, swz = sb ^ (((sb >> 9) & 1) << 5); R = (st >> 1) * 16 + swz / 64; C = (st & 1) * 32 + (swz % 64) / 2; }
__host__ __device__ __forceinline__ int perm32(int rho) { const int n = rho >> 4, i = rho & 15; return 8 * (i >> 2) + 4 * n + (i & 3); }

struct Unit { int pm, pn; };
struct Gemm { const bf16_t* A; const bf16_t* Bt; int M, N, K; int KE = 0; };

struct StaticOrder {
    int nM, nN, nwg, G, c;
    __host__ __device__ void init(int M, int N, int G_, int c_) { nM = M / BM; nN = N / BM; nwg = nM * nN; G = G_; c = c_; }
    __host__ __device__ bool next(int i, Unit& u) const {
        const long L = (long)i * G + c; if (L >= nwg) return false;
        int wgid = (int)L; { const int q = nwg / NXCD, r = nwg % NXCD, xcd = wgid % NXCD, off = wgid / NXCD; wgid = (xcd < r ? xcd * (q + 1) : r * (q + 1) + (xcd - r) * q) + off; }
        const int nig = WGM * nN, gid = wgid / nig, fm = gid * WGM, gsz = (nM - fm) < WGM ? (nM - fm) : WGM;
        u.pm = fm + ((wgid % nig) % gsz); u.pn = (wgid % nig) / gsz; return true;
    }
    __device__ __forceinline__ void a_ready(const Unit&) const {}
    __device__ __forceinline__ void done(const Unit&) const {}
};
struct RowBlockOrder {
    int c, nN;
    __host__ __device__ bool next(int i, Unit& u) const { if (i >= nN) return false; u.pm = c; u.pn = i; return true; }
    __device__ __forceinline__ void a_ready(const Unit&) const {}
    __device__ __forceinline__ void done(const Unit&) const {}
};
__device__ __forceinline__ unsigned cvt_pk_bf16(float lo, float hi) { unsigned r; asm volatile("v_cvt_pk_bf16_f32 %0, %1, %2" : "=v"(r) : "v"(lo), "v"(hi)); return r; }
template <class Epi, class Sched, bool ALIGN_EPI = false, bool SP2 = false, bool F8 = false, bool I8 = false>
__device__ __forceinline__ void gemm_phase(PG8_LAS unsigned char* lds, const Gemm g, const Sched& S, const Epi& E, const int wave_id) {
    int tid; asm volatile("v_mbcnt_lo_u32_b32 %0, -1, 0\n\tv_mbcnt_hi_u32_b32 %0, -1, %0" : "=v"(tid)); tid += wave_id * 64;
    const int wid = wave_id, lane = tid & 63, wr = wid >> 2, wc = wid & 3, fr = lane & 15, fq = lane >> 4;
    const int K = g.K, nt = (g.KE ? g.KE : K) / BK;
    unsigned voffA[2], voffB[2];
#pragma unroll
    for (int i = 0; i < 2; ++i) { int R, C; stage_rc(tid * 16 + i * 8192, R, C); const int Rb = Epi::PERM ? ((R & ~31) + perm32(R & 31)) : R;
        voffA[i] = (unsigned)(R * K + C) * 2u; voffB[i] = (unsigned)(Rb * K + C) * 2u; }
    const __amdgpu_buffer_rsrc_t rsrcA = __builtin_amdgcn_make_buffer_rsrc((void*)g.A, 0, 0x7fffffff, 0x00020000), rsrcB = __builtin_amdgcn_make_buffer_rsrc((void*)g.Bt, 0, 0x7fffffff, 0x00020000);
    const size_t kstep = (size_t)(BK * 2);
    const size_t hstep = (size_t)HALF * K * 2;
    const size_t tstep = 2 * hstep;
    const unsigned ldsw = (unsigned)wid * 1024u;
    const int aoff = lds_byte(wr * 64 + fr, fq * 8), boff = lds_byte(wc * 32 + fr, fq * 8);
#define PG8_SA(b, h) (((b) * 2 + (h)) * HTB)
#define PG8_SB(b, h) ((4 + (b) * 2 + (h)) * HTB)
#define PG8_STAGE(bufoff, gbase, voff) do { const bool isA_ = (+(voff) == +voffA); const unsigned soff_ = (unsigned)((const char*)(gbase) - (isA_ ? (const char*)g.A : (const char*)g.Bt)); _Pragma("unroll") for (int _i = 0; _i < 2; ++_i) \
        __builtin_amdgcn_raw_ptr_buffer_load_lds(isA_ ? rsrcA : rsrcB, (PG8_LAS unsigned*)(lds + (bufoff) + ldsw + _i * 8192), 16, (int)(voff)[_i], (int)soff_, 0, 0); } while (0)
#define PG8_LDA(dst, b, h) do { _Pragma("unroll") for (int m = 0; m < 4; ++m) { if constexpr (F8) { dst##8[m].lo = *(const PG8_LAS bf16x8*)(lds + PG8_SA(b, h) + aoff + m * 2048); dst##8[m].hi = *(const PG8_LAS bf16x8*)(lds + PG8_SA(b, h) + aoff + m * 2048 + 1024); } else { _Pragma("unroll") for (int k = 0; k < 2; ++k) dst[m][k] = *(const PG8_LAS bf16x8*)(lds + PG8_SA(b, h) + aoff + m * 2048 + k * 1024); } } } while (0)
#define PG8_LDB(dst, b, h) do { _Pragma("unroll") for (int n = 0; n < 2; ++n) { if constexpr (F8) { dst##8[n].lo = *(const PG8_LAS bf16x8*)(lds + PG8_SB(b, h) + boff + n * 2048); dst##8[n].hi = *(const PG8_LAS bf16x8*)(lds + PG8_SB(b, h) + boff + n * 2048 + 1024); } else { _Pragma("unroll") for (int k = 0; k < 2; ++k) dst[n][k] = *(const PG8_LAS bf16x8*)(lds + PG8_SB(b, h) + boff + n * 2048 + k * 1024); } } } while (0)
#define PG8_MMA(ai, bj, At, Bt) do { __builtin_amdgcn_s_setprio(1); _Pragma("unroll") for (int m = 0; m < 4; ++m) _Pragma("unroll") for (int n = 0; n < 2; ++n) { \
        if constexpr (F8) { typedef int v8i_ __attribute__((ext_vector_type(8))); \
            acc[ai][bj][m][n] = __builtin_amdgcn_mfma_scale_f32_16x16x128_f8f6f4(__builtin_bit_cast(v8i_, Bt##8[n]), __builtin_bit_cast(v8i_, At##8[m]), acc[ai][bj][m][n], 0, 0, 0, 0x7f79, 1, 0x7f79); }     \
        else if constexpr (I8) { typedef int v4i_ __attribute__((ext_vector_type(4))); \
            _Pragma("unroll") for (int k = 0; k < 2; ++k) acc[ai][bj][m][n] = __builtin_bit_cast(f32x4, __builtin_amdgcn_mfma_i32_16x16x64_i8(__builtin_bit_cast(v4i_, Bt[n][k]), __builtin_bit_cast(v4i_, At[m][k]), __builtin_bit_cast(v4i_, acc[ai][bj][m][n]), 0, 0, 0)); } \
        else { _Pragma("unroll") for (int k = 0; k < 2; ++k) acc[ai][bj][m][n] = __builtin_amdgcn_mfma_f32_16x16x32_bf16(Bt[n][k], At[m][k], acc[ai][bj][m][n], 0, 0, 0); } } \
        __builtin_amdgcn_s_setprio(0); } while (0)
#define PG8_WAIT_V(n) asm volatile("s_waitcnt vmcnt(" #n ")" ::: "memory")
#define PG8_WAIT_L(n) asm volatile("s_waitcnt lgkmcnt(" #n ")" ::: "memory")
#define PG8_BAR __builtin_amdgcn_s_barrier()
#define PG8_SCHED __builtin_amdgcn_sched_barrier(0)
    Unit cur, nxt; int ui = 0;
    if (!S.next(0, cur)) return;
    f32x4 acc[2][2][4][2];
#pragma unroll
    for (int a = 0; a < 2; ++a)
#pragma unroll
        for (int b = 0; b < 2; ++b)
#pragma unroll
            for (int m = 0; m < 4; ++m)
#pragma unroll
                for (int n = 0; n < 2; ++n) acc[a][b][m][n] = (f32x4){0.f, 0.f, 0.f, 0.f};
    typedef short bf16x16 __attribute__((ext_vector_type(16)));
    bf16x16 At8[4], B08[2], B18[2]; bf16x8 At[4][2], B0[2][2], B1[2][2];
    const char* cA = (const char*)g.A + (size_t)cur.pm * tstep; const char* cB = (const char*)g.Bt + (size_t)cur.pn * tstep;
    S.a_ready(cur);
    if constexpr (SP2) {
        PG8_STAGE(PG8_SB(0, 0), cB, voffB); PG8_STAGE(PG8_SB(0, 1), cB + hstep, voffB); PG8_STAGE(PG8_SA(0, 0), cA, voffA); PG8_STAGE(PG8_SA(0, 1), cA + hstep, voffA);
        if (wr == 1) PG8_BAR;
        PG8_WAIT_V(2); PG8_BAR;
        PG8_STAGE(PG8_SB(1, 0), cB + kstep, voffB); PG8_STAGE(PG8_SA(1, 0), cA + kstep, voffA); PG8_STAGE(PG8_SB(1, 1), cB + hstep + kstep, voffB);
        PG8_WAIT_V(6); PG8_BAR;
    } else {
        PG8_STAGE(PG8_SB(0, 0), cB, voffB); PG8_STAGE(PG8_SA(0, 0), cA, voffA); PG8_STAGE(PG8_SB(0, 1), cB + hstep, voffB); PG8_STAGE(PG8_SA(0, 1), cA + hstep, voffA);
        if (wr == 1) PG8_BAR;
        PG8_WAIT_V(4); PG8_BAR;
        PG8_STAGE(PG8_SB(1, 0), cB + kstep, voffB); PG8_STAGE(PG8_SA(1, 0), cA + kstep, voffA); PG8_STAGE(PG8_SB(1, 1), cB + hstep + kstep, voffB);
        PG8_WAIT_V(6); PG8_BAR;
    }
    for (;;) {
        const bool has_next = S.next(ui + 1, nxt);
        const char* nA = has_next ? (const char*)g.A + (size_t)nxt.pm * tstep : cA; const char* nB = has_next ? (const char*)g.Bt + (size_t)nxt.pn * tstep : cB;
        for (int t = 0; t < nt; t += 2) {
            const bool last = (t == nt - 2);
            const char* a1 = cA + (size_t)(t + 1) * kstep;
            const char* a2 = last ? nA : cA + (size_t)(t + 2) * kstep; const char* b2 = last ? nB : cB + (size_t)(t + 2) * kstep;
            const char* a3 = a2 + kstep; const char* b3 = b2 + kstep;
            if (last && has_next) S.a_ready(nxt);
            if constexpr (SP2) {
            PG8_LDB(B0, 0, 0); PG8_LDB(B1, 0, 1); PG8_SCHED; PG8_LDA(At, 0, 0); PG8_STAGE(PG8_SA(1, 1), a1 + hstep, voffA);
            PG8_WAIT_V(8); PG8_WAIT_L(0); PG8_BAR; PG8_MMA(0, 0, At, B0); PG8_MMA(0, 1, At, B1); PG8_BAR; PG8_SCHED;
            PG8_LDA(At, 0, 1); PG8_STAGE(PG8_SB(0, 0), b2, voffB); PG8_STAGE(PG8_SB(0, 1), b2 + hstep, voffB); PG8_STAGE(PG8_SA(0, 0), a2, voffA);
            PG8_WAIT_V(8); PG8_WAIT_L(0); PG8_BAR; PG8_MMA(1, 0, At, B0); PG8_MMA(1, 1, At, B1); PG8_BAR; PG8_SCHED;
            PG8_LDB(B0, 1, 0); PG8_LDB(B1, 1, 1); PG8_SCHED; PG8_LDA(At, 1, 0); PG8_STAGE(PG8_SA(0, 1), a2 + hstep, voffA);
            PG8_WAIT_V(8); PG8_WAIT_L(0); PG8_BAR; PG8_MMA(0, 0, At, B0); PG8_MMA(0, 1, At, B1); PG8_BAR; PG8_SCHED;
            PG8_LDA(At, 1, 1); PG8_STAGE(PG8_SB(1, 0), b3, voffB); PG8_STAGE(PG8_SB(1, 1), b3 + hstep, voffB); PG8_STAGE(PG8_SA(1, 0), a3, voffA);
            PG8_WAIT_V(8); PG8_WAIT_L(0); PG8_BAR; PG8_MMA(1, 0, At, B0); PG8_MMA(1, 1, At, B1); PG8_BAR; PG8_SCHED;
            } else {
            PG8_LDB(B0, 0, 0); PG8_SCHED; PG8_LDA(At, 0, 0); PG8_STAGE(PG8_SA(1, 1), a1 + hstep, voffA);
            PG8_WAIT_L(8); PG8_BAR; PG8_WAIT_L(0); PG8_MMA(0, 0, At, B0); PG8_BAR; PG8_SCHED;
            PG8_LDB(B1, 0, 1); PG8_STAGE(PG8_SB(0, 0), b2, voffB);
            PG8_BAR; PG8_WAIT_L(0); PG8_MMA(0, 1, At, B1); PG8_BAR;
            PG8_LDA(At, 0, 1); PG8_STAGE(PG8_SA(0, 0), a2, voffA);
            PG8_BAR; PG8_WAIT_L(0); PG8_MMA(1, 0, At, B0); PG8_BAR; PG8_SCHED;
            PG8_STAGE(PG8_SB(0, 1), b2 + hstep, voffB);
            PG8_WAIT_V(6); PG8_BAR; PG8_MMA(1, 1, At, B1); PG8_BAR;
            PG8_LDB(B0, 1, 0); PG8_SCHED; PG8_LDA(At, 1, 0); PG8_STAGE(PG8_SA(0, 1), a2 + hstep, voffA);
            PG8_WAIT_L(8); PG8_BAR; PG8_WAIT_L(0); PG8_MMA(0, 0, At, B0); PG8_BAR; PG8_SCHED;
            PG8_LDB(B1, 1, 1); PG8_STAGE(PG8_SB(1, 0), b3, voffB);
            PG8_BAR; PG8_WAIT_L(0); PG8_MMA(0, 1, At, B1); PG8_BAR;
            PG8_LDA(At, 1, 1); PG8_STAGE(PG8_SA(1, 0), a3, voffA);
            PG8_BAR; PG8_WAIT_L(0); PG8_MMA(1, 0, At, B0); PG8_BAR; PG8_SCHED;
            PG8_STAGE(PG8_SB(1, 1), b3 + hstep, voffB);
            PG8_WAIT_V(6); PG8_BAR; PG8_MMA(1, 1, At, B1); PG8_BAR;
            }
        }
        if constexpr (ALIGN_EPI) { if (wr == 0) PG8_BAR; }
        if constexpr (!Epi::AFTER_DRAIN) { int ln_e; asm volatile("v_mbcnt_lo_u32_b32 %0, -1, 0\n\tv_mbcnt_hi_u32_b32 %0, -1, %0" : "=v"(ln_e)); const int fr_e = ln_e & 15, fq_e = ln_e >> 4;
            E(acc, cur, wr, wc, fr_e, fq_e); S.done(cur); }
        if (!has_next) break;
#pragma unroll
        for (int a = 0; a < 2; ++a)
#pragma unroll
            for (int b = 0; b < 2; ++b)
#pragma unroll
                for (int m = 0; m < 4; ++m)
#pragma unroll
                    for (int n = 0; n < 2; ++n) acc[a][b][m][n] = (f32x4){0.f, 0.f, 0.f, 0.f};
        cur = nxt; cA = nA; cB = nB; ++ui;
        if constexpr (ALIGN_EPI) { if (wr == 1) PG8_BAR; }
    }
    PG8_WAIT_V(0);
    if constexpr (!ALIGN_EPI) { if (wr == 0) PG8_BAR; }
    PG8_BAR;
    if constexpr (Epi::AFTER_DRAIN) { E.fused(acc, cur, wr, wc, fr, fq, lds, wid, lane); S.done(cur); }
#undef PG8_SA
#undef PG8_SB
#undef PG8_STAGE
#undef PG8_LDA
#undef PG8_LDB
#undef PG8_MMA
#undef PG8_WAIT_V
#undef PG8_WAIT_L
#undef PG8_BAR
#undef PG8_SCHED
}
}
#define GAS __attribute__((address_space(1)))
#define LAS __attribute__((address_space(3)))
typedef unsigned short bf16;
typedef unsigned v4u __attribute__((ext_vector_type(4)));
typedef float f32x4 __attribute__((ext_vector_type(4)));
typedef short bf16x8 __attribute__((ext_vector_type(8)));
typedef GAS unsigned gu32;
typedef GAS unsigned long long gu64;
#define RLX_AGENT __ATOMIC_RELAXED, __HIP_MEMORY_SCOPE_AGENT
#define LDS_WAIT() asm volatile("s_waitcnt lgkmcnt(0)" ::: "memory")
#define VM_WAIT() asm volatile("s_waitcnt vmcnt(0)" ::: "memory")
__device__ __forceinline__ unsigned long long rt() { return __builtin_amdgcn_s_memrealtime(); }
__device__ __forceinline__ unsigned f2bf(float f) { unsigned u = __builtin_bit_cast(unsigned, f); return (u + 0x7fffu + ((u >> 16) & 1u)) >> 16; }
__device__ __forceinline__ unsigned pk2(float lo, float hi) { return f2bf(lo) | (f2bf(hi) << 16); }

#define XB_TMO      128
#define XB_XCNT(j)  (256  + 64 * (j))
#define XB_XSUB(j)  (1280 + 64 * (j))
#define XB_XGEN(j)  (2304 + 64 * (j))
#define XB_TOP      3328
#define XB_TOPGEN   3392
#define XCD_BAR_WORDS 3456
#define XB_SPIN_CAP (1u << 18)

__device__ __forceinline__ unsigned xb_ld(unsigned* p)              { return __hip_atomic_load(p, __ATOMIC_RELAXED, __HIP_MEMORY_SCOPE_AGENT); }
__device__ __forceinline__ unsigned xb_add(unsigned* p, unsigned v) { return __hip_atomic_fetch_add(p, v, __ATOMIC_RELAXED, __HIP_MEMORY_SCOPE_AGENT); }
__device__ __forceinline__ unsigned xb_xcc_id() { return (unsigned)__builtin_amdgcn_s_getreg((3 << 11) | 20) & 0xFu; }
#define XB_SPIN(cond, bar) do { unsigned _sp = 0; while (cond) { __builtin_amdgcn_s_sleep(1); \
    if ((++_sp & 255u) == 0u) { if (xb_ld(&(bar)[XB_TMO])) break; if (_sp > XB_SPIN_CAP) { atomicAdd(&(bar)[XB_TMO], 1u); break; } } } } while (0)

struct XcdBarrier {
    unsigned* bar; unsigned x; bool wave0;
    volatile LAS unsigned* st;
};

__device__ __forceinline__ XcdBarrier xcd_barrier_post(unsigned* bar, volatile LAS unsigned* st) {
    XcdBarrier b; b.bar = bar; b.x = xb_xcc_id(); b.st = st;
    if (threadIdx.x == 0) (void)xb_add(&bar[XB_XCNT(b.x)], 1u);
    return b;
}
__device__ __forceinline__ void xcd_barrier_complete(unsigned* bar, unsigned x, unsigned& nloc, unsigned& nx) {
    const unsigned G = gridDim.x * gridDim.y * gridDim.z;
    unsigned sum, cnt, mine, sp = 0u;
    for (;;) {
        sum = 0u; cnt = 0u; mine = 0u;
#pragma unroll
        for (unsigned j = 0; j < 16; ++j) { const unsigned c = xb_ld(&bar[XB_XCNT(j)]); sum += c; cnt += (c > 0u) ? 1u : 0u; mine = (j == x) ? c : mine; }
        if (sum == G) break;
        __builtin_amdgcn_s_sleep(1);
        if ((++sp & 255u) == 0u) { if (xb_ld(&bar[XB_TMO])) break; if (sp > XB_SPIN_CAP) { atomicAdd(&bar[XB_TMO], 1u); break; } }
    }
    nloc = mine > 0u ? mine : 1u; nx = cnt > 0u ? cnt : 1u;
}

__device__ __forceinline__ void xcd_barrier(const XcdBarrier& b) {
    asm volatile("s_waitcnt vmcnt(0)" ::: "memory");
    __syncthreads();
    if (b.wave0 && __builtin_amdgcn_mbcnt_hi(~0u, __builtin_amdgcn_mbcnt_lo(~0u, 0u)) == 0u) {
        unsigned* bar = b.bar;
        __builtin_amdgcn_s_waitcnt(0);
        unsigned nloc = b.st[0], nx = b.st[1];
        if (nloc == 0u) { xcd_barrier_complete(bar, b.x, nloc, nx); b.st[0] = nloc; b.st[1] = nx; }
        const unsigned old = xb_add(&bar[XB_XSUB(b.x)], 1u);
        const unsigned gen = old / nloc;
        if (old + 1u == (gen + 1u) * nloc) {
            __builtin_amdgcn_fence(__ATOMIC_RELEASE, "agent");
            asm volatile("s_waitcnt vmcnt(0)" ::: "memory");
            const unsigned og = xb_add(&bar[XB_TOP], 1u);
            const unsigned tg = og / nx;
            if (og + 1u == (tg + 1u) * nx) xb_add(&bar[XB_TOPGEN], 1u);
            else XB_SPIN(xb_ld(&bar[XB_TOPGEN]) == tg, bar);
            __builtin_amdgcn_fence(__ATOMIC_ACQUIRE, "agent");
            xb_add(&bar[XB_XGEN(b.x)], 1u);
            asm volatile("s_waitcnt vmcnt(0)" ::: "memory");
        } else {
            XB_SPIN(xb_ld(&bar[XB_XGEN(b.x)]) == gen, bar);
            __builtin_amdgcn_fence(__ATOMIC_ACQUIRE, "agent");
            asm volatile("s_waitcnt vmcnt(0)" ::: "memory");
        }
    }
    __syncthreads();
}

constexpr int NWAVES = 8, NTHREADS = NWAVES * 64;
constexpr int BATCH = 8, SEQ = 2048, T = BATCH * SEQ, D = 2048;
constexpr int EV_N = 7200, EV_NP = 7424, OD_N = 7616, OD_NP = 7680, PROJ_LD = 7680;
constexpr float EPS = 1e-6f;
constexpr int EC_GQ = 0, EC_GK = 512, EC_GV = 1024, EC_GZ = 2048, EC_GLR = 3072, EC_BQ = 3088, EC_BK = 4112, EC_BV = 5136, EC_BZ = 6160, EC_BA = 7184, EC_BB = 7192;
constexpr int OC_HQ = 0, OC_HF = 1024, OC_HI = 2048, OC_HG = 3072, OC_RW = 4096;
constexpr int RW_R = 0, RW_K = 1024, RW_V = 2048, RW_WL = 3072, RW_AL = 3168, RW_GL = 3264;
constexpr int LORA_K = 512, LORA_N = 3072;
enum { I_X = 0, I_P, I_EV_WIN, I_GK_W2, I_GK_B, I_GLA_NORM, I_GDN_CONV, I_GDN_ALOG, I_GDN_DTB, I_GDN_NORM, I_EV_WOUT, I_OD_WIN, I_LB, I_HG_NORM,
       I_MU, I_W0, I_W2, I_A0, I_A2, I_G2, I_KK, I_KA, I_RK, I_LNW, I_LNB, I_OD_WOUT, I_NMIX, I_NFFN, I_NPLE, I_PEER_WQ, I_PEER_SK, I_PEER_U, I_PEER_V,
       I_PLE_WP, I_PLE_WG, I_NFINAL, N_IN };

constexpr size_t MiB = 1u << 20;
constexpr size_t WS_CTL = 0, CTL_ZERO_BYTES = 1 * MiB, WS_SU = 256 * 1024, WS_CMB = 512 * 1024, WS_SA = 576 * 1024;
constexpr size_t WS_WEV_IN = 1 * MiB, WS_WEV_OUT = 30 * MiB, WS_WOD_IN = 38 * MiB, WS_WOD_OUT = 68 * MiB, WS_WPEER = 76 * MiB, WS_WGATE = 92 * MiB, WS_WPROJ = 108 * MiB,
                 WS_WLORA = 110 * MiB, WS_PBF = 113 * MiB, WS_TABU = 129 * MiB, WS_TABV = 193 * MiB, WS_ACTA = 257 * MiB, WS_ACTB = 321 * MiB, WS_PROJ = 385 * MiB, WS_SC = 385 * MiB,
                 WS_O = 625 * MiB, WS_H1 = 689 * MiB, WS_PP = 753 * MiB, WS_LA = 817 * MiB, WS_LO = 833 * MiB, WS_RSP = 929 * MiB, WS_STATE = 937 * MiB, WS_RS3 = 945 * MiB, WS_END = 946 * MiB;
static_assert(WS_WEV_IN + (size_t)EV_NP * D * 2 <= WS_WEV_OUT && WS_WOD_IN + (size_t)OD_NP * D * 2 <= WS_WOD_OUT && WS_PROJ + (size_t)T * PROJ_LD * 2 <= WS_O, "ws map");
constexpr int CW_BAR = 4096;
enum { RS_FFN0 = 0, RS_MIX1 = 1, RS_FFN1 = 2, RS_FINAL = 3 };
constexpr int RING_OFF = 0, RING_BYTES = 131072;
constexpr int LDSCTL_OFF = RING_BYTES, MISC_OFF = LDSCTL_OFF + 320;
constexpr int LDS_BYTES = 147456;

struct Args { const float* in[N_IN]; float* out; unsigned char* ws; int ph_lo, ph_hi; };
struct Frame {
    LAS unsigned char* lds; volatile LAS unsigned* MISC; gu32* ctl;
    int tid, lane, wave, vcu, G;
};
__device__ __forceinline__ float wave_sum(float v) {
#pragma unroll
    for (int o = 1; o < 64; o <<= 1) v += __shfl_xor(v, o);
    return v;
}
__device__ __forceinline__ float half_sum32(float v) {
#pragma unroll
    for (int o = 1; o < 32; o <<= 1) v += __shfl_xor(v, o);
    return v;
}
#define DPP_ADD(v, ctrl) (v) += __builtin_bit_cast(float, __builtin_amdgcn_update_dpp(0, __builtin_bit_cast(int, (v)), (ctrl), 0xF, 0xF, false))
__device__ __forceinline__ float row_sum16(float v) {
    DPP_ADD(v, 0x128); DPP_ADD(v, 0x124); DPP_ADD(v, 0x122); DPP_ADD(v, 0x121);
    return v;
}
__device__ __forceinline__ void row_sum16_x4(float& a, float& b, float& c, float& d) {
    asm("s_nop 1\n\t"
        "v_add_f32_dpp %0, %0, %0 row_ror:8 row_mask:0xf bank_mask:0xf\n\tv_add_f32_dpp %1, %1, %1 row_ror:8 row_mask:0xf bank_mask:0xf\n\t"
        "v_add_f32_dpp %2, %2, %2 row_ror:8 row_mask:0xf bank_mask:0xf\n\tv_add_f32_dpp %3, %3, %3 row_ror:8 row_mask:0xf bank_mask:0xf\n\t"
        "v_add_f32_dpp %0, %0, %0 row_ror:4 row_mask:0xf bank_mask:0xf\n\tv_add_f32_dpp %1, %1, %1 row_ror:4 row_mask:0xf bank_mask:0xf\n\t"
        "v_add_f32_dpp %2, %2, %2 row_ror:4 row_mask:0xf bank_mask:0xf\n\tv_add_f32_dpp %3, %3, %3 row_ror:4 row_mask:0xf bank_mask:0xf\n\t"
        "v_add_f32_dpp %0, %0, %0 row_ror:2 row_mask:0xf bank_mask:0xf\n\tv_add_f32_dpp %1, %1, %1 row_ror:2 row_mask:0xf bank_mask:0xf\n\t"
        "v_add_f32_dpp %2, %2, %2 row_ror:2 row_mask:0xf bank_mask:0xf\n\tv_add_f32_dpp %3, %3, %3 row_ror:2 row_mask:0xf bank_mask:0xf\n\t"
        "v_add_f32_dpp %0, %0, %0 row_ror:1 row_mask:0xf bank_mask:0xf\n\tv_add_f32_dpp %1, %1, %1 row_ror:1 row_mask:0xf bank_mask:0xf\n\t"
        "v_add_f32_dpp %2, %2, %2 row_ror:1 row_mask:0xf bank_mask:0xf\n\tv_add_f32_dpp %3, %3, %3 row_ror:1 row_mask:0xf bank_mask:0xf\n\t"
        "s_nop 1"
        : "+v"(a), "+v"(b), "+v"(c), "+v"(d));
}
__device__ __forceinline__ void row_sum16_x2(float& a, float& b) {
    asm("s_nop 1\n\t"
        "v_add_f32_dpp %0, %0, %0 row_ror:8 row_mask:0xf bank_mask:0xf\n\tv_add_f32_dpp %1, %1, %1 row_ror:8 row_mask:0xf bank_mask:0xf\n\ts_nop 1\n\t"
        "v_add_f32_dpp %0, %0, %0 row_ror:4 row_mask:0xf bank_mask:0xf\n\tv_add_f32_dpp %1, %1, %1 row_ror:4 row_mask:0xf bank_mask:0xf\n\ts_nop 1\n\t"
        "v_add_f32_dpp %0, %0, %0 row_ror:2 row_mask:0xf bank_mask:0xf\n\tv_add_f32_dpp %1, %1, %1 row_ror:2 row_mask:0xf bank_mask:0xf\n\ts_nop 1\n\t"
        "v_add_f32_dpp %0, %0, %0 row_ror:1 row_mask:0xf bank_mask:0xf\n\tv_add_f32_dpp %1, %1, %1 row_ror:1 row_mask:0xf bank_mask:0xf\n\t"
        "s_nop 1"
        : "+v"(a), "+v"(b));
}
typedef unsigned u32x2 __attribute__((ext_vector_type(2)));
__device__ __forceinline__ void st_wt16(void* p, v4u v) { asm volatile("global_store_dwordx4 %0, %1, off sc1\n\ts_nop 1" :: "v"(p), "v"(v) : "memory"); }
__device__ __forceinline__ void st_wt8(void* p, u32x2 v) { asm volatile("global_store_dwordx2 %0, %1, off sc1\n\ts_nop 1" :: "v"(p), "v"(v) : "memory"); }
#define LBAR() do { asm volatile("s_waitcnt lgkmcnt(0)" ::: "memory"); __builtin_amdgcn_s_barrier(); asm volatile("" ::: "memory"); } while (0)
typedef float f32x2 __attribute__((ext_vector_type(2)));
typedef __bf16 hwbf16x2_t __attribute__((ext_vector_type(2)));
__device__ __forceinline__ unsigned hw_pk2(float lo, float hi) { const f32x2 v = {lo, hi}; return __builtin_bit_cast(unsigned, __builtin_convertvector(v, hwbf16x2_t)); }
__device__ __forceinline__ bf16 hw_bf(float x) { return (bf16)hw_pk2(x, 0.f); }
__device__ __forceinline__ float bf_lo(unsigned w) { return __uint_as_float(w << 16); }
__device__ __forceinline__ float bf_hi(unsigned w) { return __uint_as_float(w & 0xffff0000u); }
__device__ __forceinline__ float sigmoidf_(float x) { return __builtin_amdgcn_rcpf(1.0f + __expf(-x)); }
__device__ __forceinline__ float siluf_(float x) { return x * __builtin_amdgcn_rcpf(1.0f + __expf(-x)); }
__device__ __forceinline__ float softplusf_(float x) { return fmaxf(x, 0.f) + log1pf(__expf(-fabsf(x))); }
__device__ __forceinline__ float logsigmoidf_(float x) { return fminf(x, 0.f) - log1pf(__expf(-fabsf(x))); }

struct EpiBf16S {
    static constexpr bool PERM = true, AFTER_DRAIN = false;
    bf16* O; int ldc; const float* rowss;
    __device__ __forceinline__ void operator()(const pg8::f32x4 (&acc)[2][2][4][2], const pg8::Unit& u, int wr, int wc, int fr, int fq) const {
        const int row0 = u.pm * 256 + wr * 64 + fr, col0 = u.pn * 256 + wc * 32 + 8 * fq;
#pragma unroll
        for (int ai = 0; ai < 2; ++ai)
#pragma unroll
            for (int m = 0; m < 4; ++m) {
                const int row = row0 + ai * 128 + m * 16;
                float sc = 1.f;
                if (rowss) { const pg8::f32x4* rp = (const pg8::f32x4*)(rowss + (size_t)row * 32 + 8 * fq); const pg8::f32x4 p0 = rp[0], p1 = rp[1];
                    float s = ((p0[0] + p0[1]) + (p0[2] + p0[3])) + ((p1[0] + p1[1]) + (p1[2] + p1[3])); s += __shfl_xor(s, 16); s += __shfl_xor(s, 32);
                    sc = __builtin_amdgcn_rsqf(s * (1.0f / D) + EPS); }
                bf16* rowp = O + (size_t)row * ldc + col0;
#pragma unroll
                for (int bj = 0; bj < 2; ++bj) { const pg8::f32x4 v0 = acc[ai][bj][m][0] * sc, v1 = acc[ai][bj][m][1] * sc;
                    pg8::u32x4 w; w.x = pg8::cvt_pk_bf16(v0[0], v0[1]); w.y = pg8::cvt_pk_bf16(v0[2], v0[3]); w.z = pg8::cvt_pk_bf16(v1[0], v1[1]); w.w = pg8::cvt_pk_bf16(v1[2], v1[3]);
                    *(pg8::u32x4*)(rowp + bj * 128) = w; } }
    }
};
struct EpiI8S {
    static constexpr bool PERM = true, AFTER_DRAIN = false;
    bf16* O; int ldc; const float* sa; const float* cb;
    __device__ __forceinline__ void operator()(const pg8::f32x4 (&acc)[2][2][4][2], const pg8::Unit& u, int wr, int wc, int fr, int fq) const {
        const int row0 = u.pm * 256 + wr * 64 + fr, col0 = u.pn * 256 + wc * 32 + 8 * fq;
        pg8::f32x4 cs[2][2];
#pragma unroll
        for (int bj = 0; bj < 2; ++bj) { cs[bj][0] = *(const pg8::f32x4*)(cb + col0 + bj * 128); cs[bj][1] = *(const pg8::f32x4*)(cb + col0 + bj * 128 + 4); }
#pragma unroll
        for (int ai = 0; ai < 2; ++ai)
#pragma unroll
            for (int m = 0; m < 4; ++m) {
                const int row = row0 + ai * 128 + m * 16;
                const float sc = sa[row];
                bf16* rowp = O + (size_t)row * ldc + col0;
#pragma unroll
                for (int bj = 0; bj < 2; ++bj) { pg8::f32x4 v0, v1;
#pragma unroll
                    for (int e = 0; e < 4; ++e) { v0[e] = (float)__float_as_int(acc[ai][bj][m][0][e]) * sc * cs[bj][0][e]; v1[e] = (float)__float_as_int(acc[ai][bj][m][1][e]) * sc * cs[bj][1][e]; }
                    pg8::u32x4 w; w.x = pg8::cvt_pk_bf16(v0[0], v0[1]); w.y = pg8::cvt_pk_bf16(v0[2], v0[3]); w.z = pg8::cvt_pk_bf16(v1[0], v1[1]); w.w = pg8::cvt_pk_bf16(v1[2], v1[3]);
                    *(pg8::u32x4*)(rowp + bj * 128) = w; } }
    }
};
template <bool GATE, bool HIN_F32, bool I8 = false> struct EpiResid {
    static constexpr bool PERM = false, AFTER_DRAIN = false;
    const void* hin; bf16* hout; float* rowss; const bf16* pp; const float* rs3; unsigned char* h8; const float* sa; const float* cb;
    __device__ __forceinline__ void operator()(const pg8::f32x4 (&acc)[2][2][4][2], const pg8::Unit& u, int wr, int wc, int fr, int fq) const {
        const int row0 = u.pm * 256 + wr * 64 + fr, col0 = u.pn * 256 + wc * 32 + 4 * fq;
        pg8::f32x4 cs[2][2];
        if constexpr (I8) {
#pragma unroll
            for (int bj = 0; bj < 2; ++bj)
#pragma unroll
                for (int n = 0; n < 2; ++n) cs[bj][n] = *(const pg8::f32x4*)(cb + col0 + bj * 128 + n * 16); }
        constexpr int MG = HIN_F32 ? 2 : 4;
#pragma unroll
        for (int ai = 0; ai < 2; ++ai)
#pragma unroll
            for (int m0 = 0; m0 < 4; m0 += MG) {
                pg8::f32x4 hf[MG][2][2]; pg8::u32x2 hb[MG][2][2], pw[MG][2][2]; float rsc[MG];
#pragma unroll
                for (int mm = 0; mm < MG; ++mm) { const int row = row0 + ai * 128 + (m0 + mm) * 16; const size_t off = (size_t)row * D + col0; rsc[mm] = GATE ? rs3[row] : (I8 ? sa[row] : 1.f);
#pragma unroll
                    for (int bj = 0; bj < 2; ++bj)
#pragma unroll
                        for (int n = 0; n < 2; ++n) { const size_t o = off + bj * 128 + n * 16;
                            if (HIN_F32) hf[mm][bj][n] = *(const pg8::f32x4*)((const float*)hin + o); else hb[mm][bj][n] = *(const pg8::u32x2*)((const bf16*)hin + o);
                            if (GATE) pw[mm][bj][n] = *(const pg8::u32x2*)(pp + o); } }
#pragma unroll
                for (int mm = 0; mm < MG; ++mm) { const int m = m0 + mm; const int row = row0 + ai * 128 + m * 16; const size_t off = (size_t)row * D + col0; float ss = 0.f;
#pragma unroll
                    for (int bj = 0; bj < 2; ++bj)
#pragma unroll
                        for (int n = 0; n < 2; ++n) { const size_t o = off + bj * 128 + n * 16;
                            pg8::f32x4 hv;
                            if (HIN_F32) hv = hf[mm][bj][n];
                            else { const pg8::u32x2 hw = hb[mm][bj][n]; hv[0] = bf_lo(hw.x); hv[1] = bf_hi(hw.x); hv[2] = bf_lo(hw.y); hv[3] = bf_hi(hw.y); }
                            pg8::f32x4 a = acc[ai][bj][m][n];
                            if constexpr (I8 && !GATE) { const float sr_ = rsc[mm];
#pragma unroll
                                for (int e = 0; e < 4; ++e) a[e] = (float)__float_as_int(a[e]) * sr_ * cs[bj][n][e]; }
                            if (GATE) { const pg8::u32x2 p2 = pw[mm][bj][n]; const float rs_ = rsc[mm];
                                a[0] = sigmoidf_(a[0] * rs_) * bf_lo(p2.x); a[1] = sigmoidf_(a[1] * rs_) * bf_hi(p2.x); a[2] = sigmoidf_(a[2] * rs_) * bf_lo(p2.y); a[3] = sigmoidf_(a[3] * rs_) * bf_hi(p2.y); }
                            hv = hv + a;
                            pg8::u32x2 w; w.x = hw_pk2(hv[0], hv[1]); w.y = hw_pk2(hv[2], hv[3]); *(pg8::u32x2*)(hout + o) = w;
                            if (h8) { int x8 = __builtin_amdgcn_cvt_pk_fp8_f32(hv[0], hv[1], 0, false); x8 = __builtin_amdgcn_cvt_pk_fp8_f32(hv[2], hv[3], x8, true); *(unsigned*)(h8 + o) = (unsigned)x8; }
                            const float q0 = bf_lo(w.x), q1 = bf_hi(w.x), q2 = bf_lo(w.y), q3 = bf_hi(w.y);
                            ss += (q0 * q0 + q1 * q1) + (q2 * q2 + q3 * q3); }
                    ss += __shfl_xor(ss, 16); ss += __shfl_xor(ss, 32);
                    if (fq == 0) rowss[(size_t)row * 32 + u.pn * 4 + wc] = ss; }
                asm volatile("" ::: "memory"); }
    }
};


__device__ __forceinline__ void p0_transpose_item(const float* W, int K, int N, bf16* WT, LAS float* scr, int item, int lane, const float* kgain = nullptr) {
    const int nblk = N / 32, kb = item / nblk, nb = item % nblk, k0 = 64 * kb, n0 = 32 * nb;
    { const GAS float* Wg = (const GAS float*)W + (size_t)(k0 + (lane >> 5)) * N + n0 + (lane & 31); float v[32];
#pragma unroll
      for (int i = 0; i < 32; ++i) v[i] = Wg[(size_t)(2 * i) * N];
#pragma unroll
      for (int i = 0; i < 32; ++i) scr[(2 * i + (lane >> 5)) * 33 + (lane & 31)] = v[i]; }
    LDS_WAIT(); asm volatile("" ::: "memory");
    const int c = lane & 7;
#pragma unroll
    for (int j = 0; j < 4; ++j) { const int n = (lane >> 3) + 8 * j; const LAS float* s = scr + (8 * c) * 33 + n;
        f32x4 g0 = {1.f, 1.f, 1.f, 1.f}, g1 = g0; if (kgain) { g0 = *(const GAS f32x4*)(kgain + k0 + 8 * c); g1 = *(const GAS f32x4*)(kgain + k0 + 8 * c + 4); }
        v4u o; o.x = pk2(s[0 * 33] * g0[0], s[1 * 33] * g0[1]); o.y = pk2(s[2 * 33] * g0[2], s[3 * 33] * g0[3]); o.z = pk2(s[4 * 33] * g1[0], s[5 * 33] * g1[1]); o.w = pk2(s[6 * 33] * g1[2], s[7 * 33] * g1[3]);
        *(GAS v4u*)(WT + (size_t)(n0 + n) * K + k0 + 8 * c) = o; }
    LDS_WAIT(); asm volatile("" ::: "memory");
}
__device__ __forceinline__ void p0_transpose_item_i8(const float* W, int K, int N, unsigned char* WT, LAS float* scr, int item, int lane, const float* cm) {
    const int nblk = N / 32, kb = item / nblk, nb = item % nblk, k0 = 64 * kb, n0 = 32 * nb;
    { const GAS float* Wg = (const GAS float*)W + (size_t)(k0 + (lane >> 5)) * N + n0 + (lane & 31); float v[32];
#pragma unroll
      for (int i = 0; i < 32; ++i) v[i] = Wg[(size_t)(2 * i) * N];
#pragma unroll
      for (int i = 0; i < 32; ++i) scr[(2 * i + (lane >> 5)) * 33 + (lane & 31)] = v[i]; }
    LDS_WAIT(); asm volatile("" ::: "memory");
    const int c = lane & 7;
#pragma unroll
    for (int j = 0; j < 4; ++j) { const int n = (lane >> 3) + 8 * j; const LAS float* s = scr + (8 * c) * 33 + n;
        const float mx = __uint_as_float(__hip_atomic_load((const unsigned*)cm + n0 + n, __ATOMIC_RELAXED, __HIP_MEMORY_SCOPE_AGENT)), inv = mx > 0.f ? 127.0f / mx : 0.f; unsigned w0 = 0, w1 = 0;
#pragma unroll
        for (int e = 0; e < 4; ++e) { w0 |= (__float_as_uint(__builtin_fmaf(s[e * 33], inv, 12582912.0f)) & 255u) << (8 * e); w1 |= (__float_as_uint(__builtin_fmaf(s[(4 + e) * 33], inv, 12582912.0f)) & 255u) << (8 * e); }
        u32x2 o; o.x = w0; o.y = w1;
        *(GAS u32x2*)(WT + (size_t)(n0 + n) * K + k0 + 8 * c) = o; }
    LDS_WAIT(); asm volatile("" ::: "memory");
}
__device__ __forceinline__ void colmax_item(const float* W, int K, int N, float* cm, int item, int lane) {
    const int ngrp = (N + 255) / 256, kb = item / ngrp, cg_ = item % ngrp, col = 256 * cg_ + 4 * lane;
    if (col >= N) return;
    const GAS f32x4* p = (const GAS f32x4*)((const GAS float*)W + (size_t)(64 * kb) * N + col); f32x4 m = {0.f, 0.f, 0.f, 0.f};
#pragma unroll 16
    for (int r = 0; r < 64; ++r) { const f32x4 v = *(const GAS f32x4*)((const GAS float*)p + (size_t)r * N);
#pragma unroll
        for (int e = 0; e < 4; ++e) m[e] = fmaxf(m[e], fabsf(v[e])); }
#pragma unroll
    for (int e = 0; e < 4; ++e) __hip_atomic_fetch_max((unsigned*)cm + col + e, __float_as_uint(m[e]), __ATOMIC_RELAXED, __HIP_MEMORY_SCOPE_AGENT);
}
__device__ __forceinline__ void p0_transpose_item_f8(const float* W, int K, int N, unsigned char* WT, LAS float* scr, int item, int lane, const float* kgain = nullptr) {
    const int nblk = N / 32, kb = item / nblk, nb = item % nblk, k0 = 64 * kb, n0 = 32 * nb;
    { const GAS float* Wg = (const GAS float*)W + (size_t)(k0 + (lane >> 5)) * N + n0 + (lane & 31); float v[32];
#pragma unroll
      for (int i = 0; i < 32; ++i) v[i] = Wg[(size_t)(2 * i) * N];
#pragma unroll
      for (int i = 0; i < 32; ++i) scr[(2 * i + (lane >> 5)) * 33 + (lane & 31)] = v[i]; }
    LDS_WAIT(); asm volatile("" ::: "memory");
    const int c = lane & 7;
#pragma unroll
    for (int j = 0; j < 4; ++j) { const int n = (lane >> 3) + 8 * j; const LAS float* s = scr + (8 * c) * 33 + n;
        f32x4 g0 = {64.f, 64.f, 64.f, 64.f}, g1 = g0; if (kgain) { g0 = g0 * *(const GAS f32x4*)(kgain + k0 + 8 * c); g1 = g1 * *(const GAS f32x4*)(kgain + k0 + 8 * c + 4); }
        int x0 = __builtin_amdgcn_cvt_pk_fp8_f32(s[0 * 33] * g0[0], s[1 * 33] * g0[1], 0, false); x0 = __builtin_amdgcn_cvt_pk_fp8_f32(s[2 * 33] * g0[2], s[3 * 33] * g0[3], x0, true);
        int x1 = __builtin_amdgcn_cvt_pk_fp8_f32(s[4 * 33] * g1[0], s[5 * 33] * g1[1], 0, false); x1 = __builtin_amdgcn_cvt_pk_fp8_f32(s[6 * 33] * g1[2], s[7 * 33] * g1[3], x1, true);
        u32x2 o; o.x = (unsigned)x0; o.y = (unsigned)x1;
        *(GAS u32x2*)(WT + (size_t)(n0 + n) * K + k0 + 8 * c) = o; }
    LDS_WAIT(); asm volatile("" ::: "memory");
}
__device__ __forceinline__ void cvt_f32_bf16(const float* src, bf16* dst, size_t n, int gtid, int gthreads) {
    const size_t n8 = n / 8;
    for (size_t i = gtid; i < n8; i += gthreads) {
        const f32x4 a = *(const GAS f32x4*)(src + i * 8), b = *(const GAS f32x4*)(src + i * 8 + 4);
        v4u o; o.x = pk2(a[0], a[1]); o.y = pk2(a[2], a[3]); o.z = pk2(b[0], b[1]); o.w = pk2(b[2], b[3]);
        *(GAS v4u*)(dst + i * 8) = o; }
}
__device__ __forceinline__ void cvt_f32_fp8(const float* src, unsigned char* dst, size_t n, float scale, int gtid, int gthreads, const float* cgain = nullptr) {
    const size_t n16 = n / 16;
    for (size_t i = gtid; i < n16; i += gthreads) { v4u o; unsigned w[4];
#pragma unroll
        for (int q = 0; q < 4; ++q) { f32x4 a = *(const GAS f32x4*)(src + i * 16 + 4 * q) * scale; if (cgain) a = a * *(const GAS f32x4*)(cgain + ((i * 16 + 4 * q) & (D - 1)));
            int x = __builtin_amdgcn_cvt_pk_fp8_f32(a[0], a[1], 0, false); x = __builtin_amdgcn_cvt_pk_fp8_f32(a[2], a[3], x, true); w[q] = (unsigned)x; }
        o.x = w[0]; o.y = w[1]; o.z = w[2]; o.w = w[3];
        *(GAS v4u*)(dst + i * 16) = o; }
}
__device__ __forceinline__ void cvt_rows_i8(const float* src, unsigned char* dst, float* SU, int rows, int gw, int NGW, int lane, const float* cgain) {
    f32x4 a[8], nx[8];
    int r = gw;
    if (r < rows) {
#pragma unroll
        for (int i = 0; i < 8; ++i) a[i] = *(const GAS f32x4*)(src + (size_t)r * D + 256 * i + 4 * lane); }
    for (; r < rows; r += NGW) {
        const int rn = r + NGW;
        if (rn < rows) {
#pragma unroll
            for (int i = 0; i < 8; ++i) nx[i] = *(const GAS f32x4*)(src + (size_t)rn * D + 256 * i + 4 * lane); }
        float mx = 0.f;
#pragma unroll
        for (int i = 0; i < 8; ++i) { if (cgain) a[i] = a[i] * *(const GAS f32x4*)(cgain + 256 * i + 4 * lane);
            mx = fmaxf(mx, fmaxf(fmaxf(fabsf(a[i][0]), fabsf(a[i][1])), fmaxf(fabsf(a[i][2]), fabsf(a[i][3])))); }
#pragma unroll
        for (int o = 1; o < 64; o <<= 1) mx = fmaxf(mx, __shfl_xor(mx, o));
        const float inv = mx > 0.f ? 127.0f / mx : 0.f;
#pragma unroll
        for (int i = 0; i < 8; ++i) { unsigned w = 0;
#pragma unroll
            for (int e = 0; e < 4; ++e) w |= (__float_as_uint(__builtin_fmaf(a[i][e], inv, 12582912.0f)) & 255u) << (8 * e);
            *(GAS unsigned*)(dst + (size_t)r * D + 256 * i + 4 * lane) = w; }
        if (lane == 0) SU[r] = mx * (1.0f / 127.0f);
#pragma unroll
        for (int i = 0; i < 8; ++i) a[i] = nx[i];
    }
}
__device__ __forceinline__ void rms_row_to_bf16(const float* xrow, const float* g, bf16* orow, int lane) {
    const GAS f32x4* xr = (const GAS f32x4*)xrow + lane; f32x4 v[8]; float s = 0.f;
#pragma unroll
    for (int j = 0; j < 8; ++j) { v[j] = xr[64 * j]; s += (v[j][0] * v[j][0] + v[j][1] * v[j][1]) + (v[j][2] * v[j][2] + v[j][3] * v[j][3]); }
    const float r = __builtin_amdgcn_rsqf(wave_sum(s) * (1.0f / D) + EPS);
    const GAS f32x4* gr = (const GAS f32x4*)g + lane;
    GAS unsigned long long* o8 = (GAS unsigned long long*)orow + lane;
#pragma unroll
    for (int j = 0; j < 8; ++j) { const f32x4 gg = gr[64 * j]; o8[64 * j] = (unsigned long long)pk2(v[j][0] * r * gg[0], v[j][1] * r * gg[1]) | ((unsigned long long)pk2(v[j][2] * r * gg[2], v[j][3] * r * gg[3]) << 32); }
}
__device__ __forceinline__ void rms_row_to_i8(const float* xrow, const float* g, unsigned char* orow, float* sa, int lane) {
    const GAS f32x4* xr = (const GAS f32x4*)xrow + lane; f32x4 v[8]; float s = 0.f;
#pragma unroll
    for (int j = 0; j < 8; ++j) { v[j] = xr[64 * j]; s += (v[j][0] * v[j][0] + v[j][1] * v[j][1]) + (v[j][2] * v[j][2] + v[j][3] * v[j][3]); }
    const float r = __builtin_amdgcn_rsqf(wave_sum(s) * (1.0f / D) + EPS);
    const GAS f32x4* gr = (const GAS f32x4*)g + lane; float mx = 0.f;
#pragma unroll
    for (int j = 0; j < 8; ++j) { v[j] = v[j] * gr[64 * j] * r; mx = fmaxf(mx, fmaxf(fmaxf(fabsf(v[j][0]), fabsf(v[j][1])), fmaxf(fabsf(v[j][2]), fabsf(v[j][3])))); }
#pragma unroll
    for (int o = 1; o < 64; o <<= 1) mx = fmaxf(mx, __shfl_xor(mx, o));
    const float inv = mx > 0.f ? 127.0f / mx : 0.f;
    GAS unsigned* o4 = (GAS unsigned*)orow + lane;
#pragma unroll
    for (int j = 0; j < 8; ++j) { unsigned w = 0;
#pragma unroll
        for (int e = 0; e < 4; ++e) w |= (__float_as_uint(__builtin_fmaf(v[j][e], inv, 12582912.0f)) & 255u) << (8 * e);
        o4[64 * j] = w; }
    if (lane == 0) *sa = mx * (1.0f / (127.0f * 127.0f));
}
__device__ __forceinline__ void rms_row_to_f8(const float* xrow, const float* g, unsigned char* orow, int lane) {
    const GAS f32x4* xr = (const GAS f32x4*)xrow + lane; f32x4 v[8]; float s = 0.f;
#pragma unroll
    for (int j = 0; j < 8; ++j) { v[j] = xr[64 * j]; s += (v[j][0] * v[j][0] + v[j][1] * v[j][1]) + (v[j][2] * v[j][2] + v[j][3] * v[j][3]); }
    const float r = __builtin_amdgcn_rsqf(wave_sum(s) * (1.0f / D) + EPS);
    const GAS f32x4* gr = (const GAS f32x4*)g + lane;
    GAS unsigned* o4 = (GAS unsigned*)orow + lane;
#pragma unroll
    for (int j = 0; j < 8; ++j) { const f32x4 q = v[j] * gr[64 * j] * r; int x = __builtin_amdgcn_cvt_pk_fp8_f32(q[0], q[1], 0, false); x = __builtin_amdgcn_cvt_pk_fp8_f32(q[2], q[3], x, true); o4[64 * j] = (unsigned)x; }
}
__device__ __forceinline__ void p0_fold_item(const float* wq, const float* sk, bf16* WP, LAS float* lds, int item, int tid, const float* kgain) {
    const int hp = item >> 5, k0 = (item & 31) * 64;
    LAS float* skT = lds;
    LAS float* wqT = lds + 128 * 132;
    const float* skb = sk + (size_t)hp * 128 * 128;
    { const GAS float* sg = (const GAS float*)skb; const GAS float* wg = (const GAS float*)wq; const GAS float* kg = (const GAS float*)kgain; float v[32], w[16];
#pragma unroll
      for (int i = 0; i < 32; ++i) v[i] = sg[i * 512 + tid];
#pragma unroll
      for (int i = 0; i < 16; ++i) { const int idx = i * 512 + tid, kk = idx >> 7, d = idx & 127; w[i] = wg[(size_t)(k0 + kk) * D + hp * 128 + d] * kg[k0 + kk]; }
#pragma unroll
      for (int i = 0; i < 32; ++i) { const int idx = i * 512 + tid, n = idx >> 7, d = idx & 127; skT[d * 132 + n] = v[i]; }
#pragma unroll
      for (int i = 0; i < 16; ++i) { const int idx = i * 512 + tid, kk = idx >> 7, d = idx & 127; wqT[d * 68 + kk] = w[i]; } }
    __syncthreads();
    const int n0 = (tid >> 4) * 4, kk0 = (tid & 15) * 4;
    float acc[4][4];
#pragma unroll
    for (int i = 0; i < 4; ++i)
#pragma unroll
        for (int j = 0; j < 4; ++j) acc[i][j] = 0.f;
#pragma unroll 4
    for (int d = 0; d < 128; ++d) { const f32x4 a = *(const LAS f32x4*)(skT + d * 132 + n0), b = *(const LAS f32x4*)(wqT + d * 68 + kk0);
#pragma unroll
        for (int i = 0; i < 4; ++i)
#pragma unroll
            for (int j = 0; j < 4; ++j) acc[i][j] += a[i] * b[j]; }
#pragma unroll
    for (int i = 0; i < 4; ++i) { unsigned long long o = (unsigned long long)pk2(acc[i][0], acc[i][1]) | ((unsigned long long)pk2(acc[i][2], acc[i][3]) << 32);
        *(GAS unsigned long long*)(WP + (size_t)(hp * 128 + n0 + i) * D + k0 + kk0) = o; }
    __syncthreads();
}
__device__ __forceinline__ void p0_prologue(const Args& A, Frame& F, const int part) {
    const int gw = F.vcu * NWAVES + F.wave, NGW = F.G * NWAVES;
    const int gtid = gw * 64 + F.lane, gthreads = F.G * NTHREADS;
    unsigned char* ws = A.ws;
    LAS float* scr = (LAS float*)(F.lds + RING_OFF + F.wave * 16384);
    constexpr int I_EVIN = (D / 64) * (EV_N / 32);
    if (part == 1) {
        for (int it = gw; it < I_EVIN; it += NGW) p0_transpose_item_i8(A.in[I_EV_WIN], D, EV_N, (unsigned char*)(ws + WS_WEV_IN), scr, it, F.lane, (const float*)(ws + WS_CMB));
        for (int m = gw; m < T; m += NGW) rms_row_to_i8(A.in[I_X] + (size_t)m * D, A.in[I_NMIX], (unsigned char*)(ws + WS_ACTA) + (size_t)m * D, (float*)(ws + WS_SA) + m, F.lane);
        return; }
    { constexpr int I_CM = (D / 64) * ((EV_N + 255) / 256);
      for (int it = gw; it < I_CM; it += NGW) colmax_item(A.in[I_EV_WIN], D, EV_N, (float*)(ws + WS_CMB), it, F.lane); }
    { GAS v4u* z0 = (GAS v4u*)(ws + WS_WEV_IN + (size_t)EV_N * D); const size_t n0 = (size_t)(EV_NP - EV_N) * D / 16;
      for (size_t i = gtid; i < n0; i += gthreads) z0[i] = (v4u){0u, 0u, 0u, 0u}; }
    { constexpr int I_PJ = (256 / 64) * (D / 32);
      for (int it = gw; it < 2 * I_PJ; it += NGW) { const int L = it / I_PJ; p0_transpose_item(A.in[I_PLE_WP] + (size_t)L * 256 * D, 256, D, (bf16*)(ws + WS_WPROJ) + (size_t)L * D * 256, scr, it % I_PJ, F.lane); } }
    if (F.G < 256) cvt_f32_bf16(A.in[I_P], (bf16*)(ws + WS_PBF), (size_t)2 * T * 256, gtid, gthreads);
#if EV_F8_T1 > EV_F8_T0
    for (int it = gw; it < I_EVIN; it += NGW) p0_transpose_item_f8(A.in[I_EV_WIN], D, EV_N, (unsigned char*)(ws + WS_O), scr, it, F.lane);
    { GAS v4u* z0 = (GAS v4u*)(ws + WS_O + (size_t)EV_N * D); const size_t n0 = (size_t)(EV_NP - EV_N) * D / 16;
      for (size_t i = gtid; i < n0; i += gthreads) z0[i] = (v4u){0u, 0u, 0u, 0u}; }
    for (int m = gw; m < T; m += NGW) rms_row_to_f8(A.in[I_X] + (size_t)m * D, A.in[I_NMIX], (unsigned char*)(ws + WS_H1) + (size_t)m * D, F.lane);
#endif
}
__device__ __forceinline__ void p0_deferred(const Args& A, Frame& F, int wg, int nwg) {
    const int gw = wg * NWAVES + F.wave, NGW = nwg * NWAVES;
    int gtid = gw * 64 + F.lane; const int gthreads = nwg * NTHREADS;
    asm volatile("" : "+v"(gtid));
    unsigned char* ws = A.ws;
    {
        LAS float* scr = (LAS float*)(F.lds + RING_OFF + F.wave * 16384);
        constexpr int I_SQ = (D / 64) * (D / 32), I_ODIN = (D / 64) * (OD_N / 32);
        constexpr int NITEMS = I_SQ + I_ODIN + I_SQ;
        for (int it = gw; it < NITEMS; it += NGW) {
            int r = it;
            if (r < I_SQ) { p0_transpose_item(A.in[I_EV_WOUT], D, D, (bf16*)(ws + WS_WEV_OUT), scr, r, F.lane); continue; } r -= I_SQ;
            if (r < I_ODIN) { p0_transpose_item_f8(A.in[I_OD_WIN], D, OD_N, (unsigned char*)(ws + WS_WOD_IN), scr, r, F.lane, A.in[I_NMIX] + D); continue; } r -= I_ODIN;
            p0_transpose_item_f8(A.in[I_PLE_WG], D, D, (unsigned char*)(ws + WS_WGATE), scr, r, F.lane, A.in[I_NPLE]);
        }
        { GAS v4u* z1 = (GAS v4u*)(ws + WS_WOD_IN + (size_t)OD_N * D); const size_t n1 = (size_t)(OD_NP - OD_N) * D / 16;
          for (size_t i = gtid; i < n1; i += gthreads) z1[i] = (v4u){0u, 0u, 0u, 0u}; }
    }
    __syncthreads();
    for (int it = wg; it < 512; it += nwg)
        p0_fold_item(A.in[I_PEER_WQ], A.in[I_PEER_SK], (bf16*)(ws + WS_WPEER), (LAS float*)(F.lds + RING_OFF), it, F.tid, A.in[I_NFFN]);
    cvt_rows_i8(A.in[I_PEER_U], (unsigned char*)(ws + WS_TABU), (float*)(ws + WS_SU), 16384, gw, NGW, F.lane, A.in[I_NFFN]);
    cvt_rows_i8(A.in[I_PEER_V], (unsigned char*)(ws + WS_TABV), (float*)(ws + WS_SU) + 32768, 16384, gw, NGW, F.lane, nullptr);
    { bf16* LB = (bf16*)(ws + WS_WLORA); const float* w2 = A.in[I_W2]; const float* a2 = A.in[I_A2]; const float* g2 = A.in[I_G2];
      for (int i = gtid; i < LORA_N * LORA_K / 2; i += gthreads) { const int row = i / (LORA_K / 2), col = (i % (LORA_K / 2)) * 2; float v[2];
#pragma unroll
          for (int e = 0; e < 2; ++e) { const int c = col + e; float x = 0.f;
              if (row < 1024) { if (c < 96) x = w2[c * 1024 + row]; }
              else if (row < 2048) { if (c >= 96 && c < 192) x = a2[(c - 96) * 1024 + (row - 1024)]; }
              else { if (c >= 192 && c < 448) x = g2[(c - 192) * 1024 + (row - 2048)]; }
              v[e] = x; }
          *(GAS unsigned*)(LB + (size_t)row * LORA_K + col) = pk2(v[0], v[1]); } }
}
__device__ __forceinline__ void p1_deferred(const Args& A, Frame& F, int wg, int nwg) {
    const int gw = wg * NWAVES + F.wave, NGW = nwg * NWAVES;
    int gtid = gw * 64 + F.lane; const int gthreads = nwg * NTHREADS;
    asm volatile("" : "+v"(gtid));
    unsigned char* ws = A.ws;
    { LAS float* scr = (LAS float*)(F.lds + RING_OFF + F.wave * 16384); constexpr int I_SQ = (D / 64) * (D / 32);
      for (int it = gw; it < 2 * I_SQ; it += NGW) {
          if (it < I_SQ) p0_transpose_item_f8(A.in[I_OD_WOUT], D, D, (unsigned char*)(ws + WS_WOD_OUT), scr, it, F.lane);
          else p0_transpose_item_f8(A.in[I_PLE_WG] + (size_t)D * D, D, D, (unsigned char*)((bf16*)(ws + WS_WGATE) + (size_t)D * D), scr, it - I_SQ, F.lane, A.in[I_NPLE] + D); } }
    __syncthreads();
    for (int it = wg; it < 512; it += nwg)
        p0_fold_item(A.in[I_PEER_WQ] + (size_t)D * D, A.in[I_PEER_SK] + (size_t)16 * 128 * 128, (bf16*)(ws + WS_WPEER) + (size_t)D * D, (LAS float*)(F.lds + RING_OFF), it, F.tid, A.in[I_NFFN] + D);
    cvt_rows_i8(A.in[I_PEER_U] + (size_t)16384 * D, (unsigned char*)(ws + WS_TABU) + (size_t)16384 * D, (float*)(ws + WS_SU) + 16384, 16384, gw, NGW, F.lane, A.in[I_NFFN] + D);
    cvt_rows_i8(A.in[I_PEER_V] + (size_t)16384 * D, (unsigned char*)(ws + WS_TABV) + (size_t)16384 * D, (float*)(ws + WS_SU) + 32768 + 16384, 16384, gw, NGW, F.lane, nullptr);
}

constexpr int TC = 16, NCHUNK = SEQ / TC;

template <int MODE>
__device__ __forceinline__ void scan_gla_unit(const Args& A, Frame& F, int unit) {
    int tid = F.tid; asm volatile("" : "+v"(tid));
    const int lane = tid & 63, w = F.wave;
    int b, h, qcol, kcol, vcol, ocol;
    if (MODE == 0) { b = unit >> 4; h = (unit >> 2) & 3; const int s = unit & 3; qcol = EC_GQ + h * 128; kcol = EC_GK + h * 128; vcol = EC_GV + h * 256 + s * 64; ocol = h * 256 + s * 64; }
    else           { b = unit >> 4; h = (unit >> 1) & 7; const int s = unit & 1; qcol = OC_HQ + h * 128; kcol = OC_HF + h * 128; vcol = OC_HI + h * 128 + s * 64; ocol = h * 128 + s * 64; }
    const bf16* P = (const bf16*)(A.ws + WS_PROJ) + (size_t)b * SEQ * PROJ_LD;
    float* O = (float*)(A.ws + WS_O) + (size_t)b * SEQ * D + ocol;
    LAS float* Lf = (LAS float*)(F.lds + RING_OFF);
    constexpr int BUFSZ = 7168, O_EG = 0, O_K = 2048, O_Q = 4096, O_V = 6144, O_OUT = 2 * BUFSZ, O_W2 = O_OUT + 1024, O_BIAS = O_W2 + 2048;
    const int tl = tid >> 5, dq = (tid & 31) * 4, tlv = tid >> 4, c4 = (tid & 15) * 4;
    float lb[4] = {0.f, 0.f, 0.f, 0.f};
    if (MODE == 0) {
        const float* w2 = A.in[I_GK_W2]; const float* gb = A.in[I_GK_B];
        for (int i = tid; i < 2048; i += NTHREADS) Lf[O_W2 + i] = w2[(i >> 7) * 512 + h * 128 + (i & 127)];
        if (tid < 128) Lf[O_BIAS + tid] = gb[h * 128 + tid];
    } else {
        const float* lg = A.in[I_LB];
#pragma unroll
        for (int i = 0; i < 4; ++i) lb[i] = sigmoidf_(lg[1024 + h * 128 + dq + i] - lg[h * 128 + dq + i]);
    }
    u32x2 rq, rk, rv = {0u, 0u}; v4u rg0 = {0u, 0u, 0u, 0u}, rg1 = {0u, 0u, 0u, 0u};
#define GLA_LOAD(c) do { const bf16* pr = P + (size_t)((c) * TC + tl) * PROJ_LD; rq = *(const GAS u32x2*)(pr + qcol + dq); rk = *(const GAS u32x2*)(pr + kcol + dq); \
        if (MODE == 0) { rg0 = *(const GAS v4u*)(pr + EC_GLR); rg1 = *(const GAS v4u*)(pr + EC_GLR + 8); } \
        if (tid < 256) rv = *(const GAS u32x2*)(P + (size_t)((c) * TC + tlv) * PROJ_LD + vcol + c4); } while (0)
#define GLA_XFORM(bufi) do { LAS float* B_ = Lf + (bufi) * BUFSZ; f32x4 q4, k4, e4; \
        const float xq[4] = {bf_lo(rq.x), bf_hi(rq.x), bf_lo(rq.y), bf_hi(rq.y)}, xk[4] = {bf_lo(rk.x), bf_hi(rk.x), bf_lo(rk.y), bf_hi(rk.y)}; \
        if (MODE == 0) { f32x4 z = *(const LAS f32x4*)(Lf + O_BIAS + dq); \
            const float gl[16] = {bf_lo(rg0.x), bf_hi(rg0.x), bf_lo(rg0.y), bf_hi(rg0.y), bf_lo(rg0.z), bf_hi(rg0.z), bf_lo(rg0.w), bf_hi(rg0.w), \
                                  bf_lo(rg1.x), bf_hi(rg1.x), bf_lo(rg1.y), bf_hi(rg1.y), bf_lo(rg1.z), bf_hi(rg1.z), bf_lo(rg1.w), bf_hi(rg1.w)}; \
            _Pragma("unroll") for (int r_ = 0; r_ < 16; ++r_) { const f32x4 wv = *(const LAS f32x4*)(Lf + O_W2 + r_ * 128 + dq); z = z + wv * gl[r_]; } \
            _Pragma("unroll") for (int i_ = 0; i_ < 4; ++i_) { q4[i_] = xq[i_] * 0.08838834764831845f; k4[i_] = xk[i_]; e4[i_] = __builtin_amdgcn_exp2f(-0.0625f * __builtin_amdgcn_logf(1.0f + __expf(-z[i_]))); } } \
        else { _Pragma("unroll") for (int i_ = 0; i_ < 4; ++i_) { const float fg = lb[i_] + (1.f - lb[i_]) * sigmoidf_(xk[i_]); q4[i_] = siluf_(xq[i_]); k4[i_] = 1.f - fg; e4[i_] = fg; } } \
        *(LAS f32x4*)(B_ + O_EG + tl * 128 + dq) = e4; *(LAS f32x4*)(B_ + O_K + tl * 128 + dq) = k4; *(LAS f32x4*)(B_ + O_Q + tl * 128 + dq) = q4; \
        if (tid < 256) { f32x4 v4 = {bf_lo(rv.x), bf_hi(rv.x), bf_lo(rv.y), bf_hi(rv.y)}; *(LAS f32x4*)(B_ + O_V + tlv * 64 + c4) = v4; } } while (0)
    LBAR();
    GLA_LOAD(0); GLA_XFORM(0);
    LBAR();
    f32x2 S2[8];
#pragma unroll
    for (int i = 0; i < 8; ++i) S2[i] = (f32x2){0.f, 0.f};
    const int j = lane & 15, col = w * 8 + (lane >> 4) * 2;
    for (int c = 0; c < NCHUNK; ++c) {
        if (c + 1 < NCHUNK) GLA_LOAD(c + 1);
        const LAS float* B_ = Lf + (c & 1) * BUFSZ;
        float os0 = 0.f, os1 = 0.f;
        f32x4 e0, e1, k0, k1, q0, q1, ne0, ne1, nk0, nk1, nq0, nq1; f32x2 v2, nv2;
#define GLA_LDSTEP(t_, E0, E1, K0, K1, Q0, Q1, V2) do { E0 = *(const LAS f32x4*)(B_ + O_EG + (t_) * 128 + 4 * j); E1 = *(const LAS f32x4*)(B_ + O_EG + (t_) * 128 + 64 + 4 * j); \
            K0 = *(const LAS f32x4*)(B_ + O_K + (t_) * 128 + 4 * j); K1 = *(const LAS f32x4*)(B_ + O_K + (t_) * 128 + 64 + 4 * j); \
            Q0 = *(const LAS f32x4*)(B_ + O_Q + (t_) * 128 + 4 * j); Q1 = *(const LAS f32x4*)(B_ + O_Q + (t_) * 128 + 64 + 4 * j); V2 = *(const LAS f32x2*)(B_ + O_V + (t_) * 64 + col); } while (0)
        GLA_LDSTEP(0, e0, e1, k0, k1, q0, q1, v2);
#pragma unroll
        for (int t = 0; t < TC; ++t) {
            if (t + 1 < TC) { GLA_LDSTEP(t + 1, ne0, ne1, nk0, nk1, nq0, nq1, nv2); }
            __builtin_amdgcn_sched_barrier(0);
            f32x2 pa = {0.f, 0.f}, pb = {0.f, 0.f};
#pragma unroll
            for (int i = 0; i < 4; ++i) {
                S2[i] = S2[i] * e0[i] + v2 * k0[i]; S2[4 + i] = S2[4 + i] * e1[i] + v2 * k1[i];
                pa += S2[i] * q0[i]; pb += S2[4 + i] * q1[i]; }
            pa += pb;
            float p0 = pa[0], p1 = pa[1];
            row_sum16_x2(p0, p1);
            os0 = (j == t) ? p0 : os0; os1 = (j == t) ? p1 : os1;
            e0 = ne0; e1 = ne1; k0 = nk0; k1 = nk1; q0 = nq0; q1 = nq1; v2 = nv2;
        }
#undef GLA_LDSTEP
        { f32x2 o2 = {os0, os1}; *(LAS f32x2*)(Lf + O_OUT + j * 64 + col) = o2; }
        if (c + 1 < NCHUNK) GLA_XFORM((c + 1) & 1);
        LBAR();
        if (tid < 256) *(GAS f32x4*)(O + (size_t)(c * TC + tlv) * D + c4) = *(const LAS f32x4*)(Lf + O_OUT + tlv * 64 + c4);
        LBAR();
    }
#undef GLA_LOAD
#undef GLA_XFORM
}

__device__ __forceinline__ void scan_gdn_unit(const Args& A, Frame& F, int unit) {
    int tid = F.tid; asm volatile("" : "+v"(tid));
    const int lane = tid & 63, w = F.wave;
    const int b = unit >> 4, h = (unit >> 1) & 7, s = unit & 1;
    const int qcol = EC_BQ + h * 128, kcol = EC_BK + h * 128, vcol = EC_BV + h * 128 + s * 64, ocol = 1024 + h * 128 + s * 64;
    const bf16* P = (const bf16*)(A.ws + WS_PROJ) + (size_t)b * SEQ * PROJ_LD;
    float* O = (float*)(A.ws + WS_O) + (size_t)b * SEQ * D + ocol;
    LAS float* Lf = (LAS float*)(F.lds + RING_OFF);
    constexpr int BUFSZ = 5184, O_K = 0, O_Q = 2048, O_V = 4096, O_SC = 5120, O_OUT = 2 * BUFSZ, O_CW = O_OUT + 1024;
    const int tl = tid >> 5, dq = (tid & 31) * 4, tlv = tid >> 4, c4 = (tid & 15) * 4;
    { const float* cw = A.in[I_GDN_CONV];
      for (int i = tid; i < 4 * 320; i += NTHREADS) { const int jt = i / 320, x = i % 320;
          const int ch = x < 128 ? (h * 128 + x) : x < 256 ? (1024 + h * 128 + (x - 128)) : (2048 + h * 128 + s * 64 + (x - 256));
          Lf[O_CW + i] = cw[jt * 3072 + ch]; } }
    const float neg_ea = -__expf(A.in[I_GDN_ALOG][h]), dtb = A.in[I_GDN_DTB][h];
    u32x2 rq[4], rk[4], rv[4]; unsigned short rba = 0, rbb = 0;
#pragma unroll
    for (int i = 0; i < 4; ++i) rv[i] = (u32x2){0u, 0u};
#define GDN_LOAD(c) do { const int t_ = (c) * TC + tl; \
        _Pragma("unroll") for (int jt = 0; jt < 4; ++jt) { const int tt = t_ - 3 + jt; \
            if (tt >= 0) { const bf16* pr = P + (size_t)tt * PROJ_LD; rq[jt] = *(const GAS u32x2*)(pr + qcol + dq); rk[jt] = *(const GAS u32x2*)(pr + kcol + dq); } \
            else { rq[jt] = (u32x2){0u, 0u}; rk[jt] = (u32x2){0u, 0u}; } } \
        { const bf16* pr = P + (size_t)t_ * PROJ_LD; rba = pr[EC_BA + h]; rbb = pr[EC_BB + h]; } \
        if (tid < 256) { const int tv = (c) * TC + tlv; \
            _Pragma("unroll") for (int jt = 0; jt < 4; ++jt) { const int tt = tv - 3 + jt; \
                if (tt >= 0) rv[jt] = *(const GAS u32x2*)(P + (size_t)tt * PROJ_LD + vcol + c4); else rv[jt] = (u32x2){0u, 0u}; } } } while (0)
#define GDN_XFORM(bufi) do { LAS float* B_ = Lf + (bufi) * BUFSZ; f32x4 q4 = {0.f, 0.f, 0.f, 0.f}, k4 = {0.f, 0.f, 0.f, 0.f}; \
        _Pragma("unroll") for (int jt = 0; jt < 4; ++jt) { const f32x4 wq = *(const LAS f32x4*)(Lf + O_CW + jt * 320 + dq), wk = *(const LAS f32x4*)(Lf + O_CW + jt * 320 + 128 + dq); \
            q4[0] += wq[0] * bf_lo(rq[jt].x); q4[1] += wq[1] * bf_hi(rq[jt].x); q4[2] += wq[2] * bf_lo(rq[jt].y); q4[3] += wq[3] * bf_hi(rq[jt].y); \
            k4[0] += wk[0] * bf_lo(rk[jt].x); k4[1] += wk[1] * bf_hi(rk[jt].x); k4[2] += wk[2] * bf_lo(rk[jt].y); k4[3] += wk[3] * bf_hi(rk[jt].y); } \
        float sq = 0.f, sk = 0.f, sqk = 0.f; \
        _Pragma("unroll") for (int i_ = 0; i_ < 4; ++i_) { q4[i_] = siluf_(q4[i_]); k4[i_] = siluf_(k4[i_]); sq += q4[i_] * q4[i_]; sk += k4[i_] * k4[i_]; sqk += q4[i_] * k4[i_]; } \
        sq = half_sum32(sq); sk = half_sum32(sk); sqk = half_sum32(sqk); \
        const float rq_ = __builtin_amdgcn_rsqf(sq + EPS) * 0.08838834764831845f, rk_ = __builtin_amdgcn_rsqf(sk + EPS); \
        q4 = q4 * rq_; k4 = k4 * rk_; \
        *(LAS f32x4*)(B_ + O_K + tl * 128 + dq) = k4; *(LAS f32x4*)(B_ + O_Q + tl * 128 + dq) = q4; \
        if ((tid & 31) == 0) { const float ba = __uint_as_float((unsigned)rba << 16), bb = __uint_as_float((unsigned)rbb << 16); \
            f32x4 sc; sc[0] = __expf(neg_ea * softplusf_(ba + dtb)); sc[1] = sigmoidf_(bb); sc[2] = sqk * rq_ * rk_; sc[3] = 0.f; *(LAS f32x4*)(B_ + O_SC + tl * 4) = sc; } \
        if (tid < 256) { f32x4 v4 = {0.f, 0.f, 0.f, 0.f}; \
            _Pragma("unroll") for (int jt = 0; jt < 4; ++jt) { const f32x4 wv = *(const LAS f32x4*)(Lf + O_CW + jt * 320 + 256 + c4); \
                v4[0] += wv[0] * bf_lo(rv[jt].x); v4[1] += wv[1] * bf_hi(rv[jt].x); v4[2] += wv[2] * bf_lo(rv[jt].y); v4[3] += wv[3] * bf_hi(rv[jt].y); } \
            _Pragma("unroll") for (int i_ = 0; i_ < 4; ++i_) v4[i_] = siluf_(v4[i_]); \
            *(LAS f32x4*)(B_ + O_V + tlv * 64 + c4) = v4; } } while (0)
    LBAR();
    GDN_LOAD(0); GDN_XFORM(0);
    LBAR();
    f32x2 S2[8];
#pragma unroll
    for (int i = 0; i < 8; ++i) S2[i] = (f32x2){0.f, 0.f};
    const int j = lane & 15, col = w * 8 + (lane >> 4) * 2;
    for (int c = 0; c < NCHUNK; ++c) {
        if (c + 1 < NCHUNK) GDN_LOAD(c + 1);
        const LAS float* B_ = Lf + (c & 1) * BUFSZ;
        float os0 = 0.f, os1 = 0.f;
        f32x4 k0, k1, q0, q1, sc, nk0, nk1, nq0, nq1, nsc; f32x2 v2, nv2;
#define GDN_LDSTEP(t_, K0, K1, Q0, Q1, V2, SC) do { K0 = *(const LAS f32x4*)(B_ + O_K + (t_) * 128 + 4 * j); K1 = *(const LAS f32x4*)(B_ + O_K + (t_) * 128 + 64 + 4 * j); \
            Q0 = *(const LAS f32x4*)(B_ + O_Q + (t_) * 128 + 4 * j); Q1 = *(const LAS f32x4*)(B_ + O_Q + (t_) * 128 + 64 + 4 * j); V2 = *(const LAS f32x2*)(B_ + O_V + (t_) * 64 + col); SC = *(const LAS f32x4*)(B_ + O_SC + (t_) * 4); } while (0)
        GDN_LDSTEP(0, k0, k1, q0, q1, v2, sc);
#pragma unroll
        for (int t = 0; t < TC; ++t) {
            if (t + 1 < TC) { GDN_LDSTEP(t + 1, nk0, nk1, nq0, nq1, nv2, nsc); }
            __builtin_amdgcn_sched_barrier(0);
            f32x2 d1 = {0.f, 0.f}, d2 = {0.f, 0.f}, e1 = {0.f, 0.f}, e2 = {0.f, 0.f};
#pragma unroll
            for (int i = 0; i < 4; ++i) { d1 += S2[i] * k0[i]; e1 += S2[4 + i] * k1[i]; d2 += S2[i] * q0[i]; e2 += S2[4 + i] * q1[i]; }
            d1 += e1; d2 += e2;
            { float r0_ = d1[0], r1_ = d1[1], r2_ = d2[0], r3_ = d2[1]; row_sum16_x4(r0_, r1_, r2_, r3_); d1[0] = r0_; d1[1] = r1_; d2[0] = r2_; d2[1] = r3_; }
            const float a = sc[0], beta = sc[1], qk = sc[2];
            const f32x2 dl = (v2 - d1 * a) * beta;
            const f32x2 o2 = d2 * a + dl * qk;
#pragma unroll
            for (int i = 0; i < 4; ++i) { S2[i] = S2[i] * a + dl * k0[i]; S2[4 + i] = S2[4 + i] * a + dl * k1[i]; }
            os0 = (j == t) ? o2[0] : os0; os1 = (j == t) ? o2[1] : os1;
            k0 = nk0; k1 = nk1; q0 = nq0; q1 = nq1; v2 = nv2; sc = nsc;
        }
#undef GDN_LDSTEP
        { f32x2 o2 = {os0, os1}; *(LAS f32x2*)(Lf + O_OUT + j * 64 + col) = o2; }
        if (c + 1 < NCHUNK) GDN_XFORM((c + 1) & 1);
        LBAR();
        if (tid < 256) *(GAS f32x4*)(O + (size_t)(c * TC + tlv) * D + c4) = *(const LAS f32x4*)(Lf + O_OUT + tlv * 64 + c4);
        LBAR();
    }
#undef GDN_LOAD
#undef GDN_XFORM
}

typedef short bf16x4_t __attribute__((ext_vector_type(4)));
__device__ __forceinline__ bf16x8 mk_frag(u32x2 lo, u32x2 hi) { v4u t; t.x = lo.x; t.y = lo.y; t.z = hi.x; t.w = hi.y; return __builtin_bit_cast(bf16x8, t); }
template <int MODE>
__device__ __forceinline__ void scan_gla_mfma_unit(const Args& A, Frame& F, int unit) {
    int tid = F.tid; asm volatile("" : "+v"(tid));
    const int lane = tid & 63, w = F.wave;
    int b, h, qcol, kcol, vcol, ocol;
    if (MODE == 0) { b = unit >> 3; h = (unit >> 1) & 3; const int s = unit & 1; qcol = EC_GQ + h * 128; kcol = EC_GK + h * 128; vcol = EC_GV + h * 256 + s * 128; ocol = h * 256 + s * 128; }
    else           { b = unit >> 3; h = unit & 7; qcol = OC_HQ + h * 128; kcol = OC_HF + h * 128; vcol = OC_HI + h * 128; ocol = h * 128; }
    const bf16* P = (const bf16*)(A.ws + WS_PROJ) + (size_t)b * SEQ * PROJ_LD;
    bf16* O = (bf16*)(A.ws + WS_O) + (size_t)b * SEQ * D + ocol;
    LAS float* Lf = (LAS float*)(F.lds + RING_OFF);
    constexpr int BUFSZ = MODE == 1 ? 10240 : 8192, O_E = 0, O_K = 2048, O_Q = 4096, O_V = 6144, O_Z = 8192, RS = 136,
        O_QB = 2 * BUFSZ, O_KB = O_QB + 1088, O_KT = O_KB + 1088, O_BL = O_KT + 1024, O_AM = O_BL + 128, O_W2 = O_AM + 128, O_BIAS = O_W2 + 2048;
    LAS bf16* QB = (LAS bf16*)(Lf + O_QB); LAS bf16* KB = (LAS bf16*)(Lf + O_KB); LAS bf16* KT = (LAS bf16*)(Lf + O_KT); LAS bf16* AM = (LAS bf16*)(Lf + O_AM);
    const int tl = tid >> 5, dq = (tid & 31) * 4;
    float lb[4] = {0.f, 0.f, 0.f, 0.f};
    if (MODE == 0) {
        const float* w2 = A.in[I_GK_W2]; const float* gb = A.in[I_GK_B];
        for (int i = tid; i < 2048; i += NTHREADS) Lf[O_W2 + i] = w2[(i >> 7) * 512 + h * 128 + (i & 127)];
        if (tid < 128) Lf[O_BIAS + tid] = gb[h * 128 + tid];
    } else {
        const float* lg = A.in[I_LB];
#pragma unroll
        for (int i = 0; i < 4; ++i) lb[i] = sigmoidf_(lg[1024 + h * 128 + dq + i] - lg[h * 128 + dq + i]);
    }
    u32x2 rq, rk, rv, rz = {0u, 0u}; v4u rg0 = {0u, 0u, 0u, 0u}, rg1 = {0u, 0u, 0u, 0u};
#define GM_LOAD(c) do { const bf16* pr = P + (size_t)((c) * TC + tl) * PROJ_LD; rq = *(const GAS u32x2*)(pr + qcol + dq); rk = *(const GAS u32x2*)(pr + kcol + dq); rv = *(const GAS u32x2*)(pr + vcol + dq); \
        if (MODE == 0) { rg0 = *(const GAS v4u*)(pr + EC_GLR); rg1 = *(const GAS v4u*)(pr + EC_GLR + 8); } else rz = *(const GAS u32x2*)(pr + OC_HG + h * 128 + dq); } while (0)
#define GM_XFORM(bufi) do { LAS float* B_ = Lf + (bufi) * BUFSZ; f32x4 q4, k4, e4; \
        const float xq[4] = {bf_lo(rq.x), bf_hi(rq.x), bf_lo(rq.y), bf_hi(rq.y)}, xk[4] = {bf_lo(rk.x), bf_hi(rk.x), bf_lo(rk.y), bf_hi(rk.y)}; \
        if (MODE == 0) { f32x4 z = *(const LAS f32x4*)(Lf + O_BIAS + dq); \
            const float gl[16] = {bf_lo(rg0.x), bf_hi(rg0.x), bf_lo(rg0.y), bf_hi(rg0.y), bf_lo(rg0.z), bf_hi(rg0.z), bf_lo(rg0.w), bf_hi(rg0.w), \
                                  bf_lo(rg1.x), bf_hi(rg1.x), bf_lo(rg1.y), bf_hi(rg1.y), bf_lo(rg1.z), bf_hi(rg1.z), bf_lo(rg1.w), bf_hi(rg1.w)}; \
            _Pragma("unroll") for (int r_ = 0; r_ < 16; ++r_) { const f32x4 wv = *(const LAS f32x4*)(Lf + O_W2 + r_ * 128 + dq); z = z + wv * gl[r_]; } \
            _Pragma("unroll") for (int i_ = 0; i_ < 4; ++i_) { q4[i_] = xq[i_] * 0.08838834764831845f; k4[i_] = xk[i_]; e4[i_] = __builtin_amdgcn_exp2f(-0.0625f * __builtin_amdgcn_logf(1.0f + __expf(-z[i_]))); } } \
        else { _Pragma("unroll") for (int i_ = 0; i_ < 4; ++i_) { const float fg = lb[i_] + (1.f - lb[i_]) * sigmoidf_(xk[i_]); q4[i_] = siluf_(xq[i_]); k4[i_] = 1.f - fg; e4[i_] = fg; } } \
        *(LAS f32x4*)(B_ + O_E + tl * 128 + dq) = e4; *(LAS f32x4*)(B_ + O_K + tl * 128 + dq) = k4; *(LAS f32x4*)(B_ + O_Q + tl * 128 + dq) = q4; \
        { f32x4 v4 = {bf_lo(rv.x), bf_hi(rv.x), bf_lo(rv.y), bf_hi(rv.y)}; *(LAS f32x4*)(B_ + O_V + tl * 128 + dq) = v4; } \
        if (MODE == 1) { f32x4 z4 = {siluf_(bf_lo(rz.x)), siluf_(bf_hi(rz.x)), siluf_(bf_lo(rz.y)), siluf_(bf_hi(rz.y))}; *(LAS f32x4*)(B_ + O_Z + tl * 128 + dq) = z4; } } while (0)
    LBAR();
    GM_LOAD(0); GM_XFORM(0); GM_LOAD(1);
    LBAR();
    f32x4 Sacc[8];
#pragma unroll
    for (int i = 0; i < 8; ++i) Sacc[i] = (f32x4){0.f, 0.f, 0.f, 0.f};
    const int fr = lane & 15, g = lane >> 4, c0 = w * 16;
    LAS float* PART = Lf + O_BIAS + 128;
    unsigned char* Y8 = (unsigned char*)(A.ws + WS_ACTA) + (size_t)b * SEQ * D + ocol;
    float gn = 0.f; f32x4 oprev = {0.f, 0.f, 0.f, 0.f}; float zprev[4] = {0.f, 0.f, 0.f, 0.f};
    if (MODE == 1) gn = A.in[I_HG_NORM][c0 + fr];
#define HG_FINISH(cc) do { const LAS float* pp_ = PART + ((cc) & 1) * 128; \
        _Pragma("unroll") for (int r = 0; r < 4; ++r) { const int t_ = 4 * g + r; const f32x4 p0_ = *(const LAS f32x4*)(pp_ + t_ * 8), p1_ = *(const LAS f32x4*)(pp_ + t_ * 8 + 4); \
            const float s_ = ((p0_[0] + p0_[1]) + (p0_[2] + p0_[3])) + ((p1_[0] + p1_[1]) + (p1_[2] + p1_[3])); const float rt_ = __builtin_amdgcn_rsqf(s_ * (1.0f / 128.0f) + EPS); \
            const float y_ = oprev[r] * rt_ * gn * zprev[r]; \
            Y8[(size_t)((cc) * TC + t_) * D + c0 + fr] = (unsigned char)(__builtin_amdgcn_cvt_pk_fp8_f32(y_, y_, 0, false) & 0xff); } } while (0)
    for (int c = 0; c < NCHUNK; ++c) {
        const LAS float* B_ = Lf + (c & 1) * BUFSZ;
        {
            const int seg = tid >> 7, d = tid & 127;
            float bt = 1.f, ball = 1.f;
#pragma unroll
            for (int t = 0; t < 16; ++t) { const float e = B_[O_E + t * 128 + d]; ball *= e; if (t < 4 * seg) bt = ball; }
            ball = fmaxf(ball, 1e-30f);
            unsigned short kt4[4];
#pragma unroll
            for (int i = 0; i < 4; ++i) { const int t = 4 * seg + i; bt = fmaxf(bt * B_[O_E + t * 128 + d], 1e-30f);
                const float kk = B_[O_K + t * 128 + d], qq = B_[O_Q + t * 128 + d], ib = __builtin_amdgcn_rcpf(bt);
                QB[t * RS + d] = hw_bf(qq * bt); KB[t * RS + d] = hw_bf(kk * ib); kt4[i] = (unsigned short)hw_bf(kk * ball * ib); }
            u32x2 kw; kw.x = (unsigned)kt4[0] | ((unsigned)kt4[1] << 16); kw.y = (unsigned)kt4[2] | ((unsigned)kt4[3] << 16);
            *(LAS u32x2*)(KT + d * 16 + 4 * seg) = kw;
            if (seg == 3) Lf[O_BL + d] = ball;
        }
        LBAR();
        if (MODE == 1 && c > 0) HG_FINISH(c - 1);
        if (w == 0) {
            f32x4 acc = {0.f, 0.f, 0.f, 0.f};
#pragma unroll
            for (int ks = 0; ks < 4; ++ks) { const bf16x8 af = *(const LAS bf16x8*)(QB + fr * RS + 32 * ks + 8 * g), bfm = *(const LAS bf16x8*)(KB + fr * RS + 32 * ks + 8 * g);
                acc = __builtin_amdgcn_mfma_f32_16x16x32_bf16(af, bfm, acc, 0, 0, 0); }
#pragma unroll
            for (int r = 0; r < 4; ++r) { const int t = 4 * g + r, s = fr; AM[t * 16 + s] = hw_bf(s <= t ? acc[r] : 0.f); }
        }
        if (c + 1 < NCHUNK) GM_XFORM((c + 1) & 1);
        if (c + 2 < NCHUNK) GM_LOAD(c + 2);
        LBAR();
        {
            u32x2 vlo; { const float v0 = B_[O_V + (4 * g + 0) * 128 + c0 + fr], v1 = B_[O_V + (4 * g + 1) * 128 + c0 + fr], v2 = B_[O_V + (4 * g + 2) * 128 + c0 + fr], v3 = B_[O_V + (4 * g + 3) * 128 + c0 + fr];
                vlo.x = hw_pk2(v0, v1); vlo.y = hw_pk2(v2, v3); }
            const u32x2 zz = {0u, 0u};
            const bf16x8 vb = mk_frag(vlo, zz);
            f32x4 acco = {0.f, 0.f, 0.f, 0.f};
#pragma unroll
            for (int ks = 0; ks < 4; ++ks) {
                u32x2 slo, shi; slo.x = hw_pk2(Sacc[2 * ks][0], Sacc[2 * ks][1]); slo.y = hw_pk2(Sacc[2 * ks][2], Sacc[2 * ks][3]); shi.x = hw_pk2(Sacc[2 * ks + 1][0], Sacc[2 * ks + 1][1]); shi.y = hw_pk2(Sacc[2 * ks + 1][2], Sacc[2 * ks + 1][3]);
                const bf16x8 sb = mk_frag(slo, shi);
                const u32x2 qlo = *(const LAS u32x2*)(QB + fr * RS + 32 * ks + 4 * g), qhi = *(const LAS u32x2*)(QB + fr * RS + 32 * ks + 16 + 4 * g);
                acco = __builtin_amdgcn_mfma_f32_16x16x32_bf16(mk_frag(qlo, qhi), sb, acco, 0, 0, 0); }
            { const u32x2 alo = *(const LAS u32x2*)(AM + fr * 16 + 4 * g); acco = __builtin_amdgcn_mfma_f32_16x16x32_bf16(mk_frag(alo, zz), vb, acco, 0, 0, 0); }
#pragma unroll
            for (int r = 0; r < 4; ++r) { if (MODE == 0) O[(size_t)(c * TC + 4 * g + r) * D + c0 + fr] = hw_bf(acco[r]); }
            if (MODE == 1) { float q0 = acco[0] * acco[0], q1 = acco[1] * acco[1], q2 = acco[2] * acco[2], q3 = acco[3] * acco[3]; row_sum16_x4(q0, q1, q2, q3);
                if (fr == 0) { LAS float* pw_ = PART + (c & 1) * 128 + (4 * g) * 8 + w; pw_[0] = q0; pw_[8] = q1; pw_[16] = q2; pw_[24] = q3; }
                oprev = acco;
#pragma unroll
                for (int r = 0; r < 4; ++r) zprev[r] = B_[O_Z + (4 * g + r) * 128 + c0 + fr]; }
#pragma unroll
            for (int i = 0; i < 8; ++i) { const f32x4 bl = *(const LAS f32x4*)(Lf + O_BL + 16 * i + 4 * g); const u32x2 klo = *(const LAS u32x2*)(KT + (16 * i + fr) * 16 + 4 * g);
                Sacc[i] = __builtin_amdgcn_mfma_f32_16x16x32_bf16(mk_frag(klo, zz), vb, Sacc[i] * bl, 0, 0, 0); }
        }
        LBAR();
    }
    if (MODE == 1) HG_FINISH(NCHUNK - 1);
#undef HG_FINISH
#undef GM_LOAD
#undef GM_XFORM
}

__device__ __forceinline__ void scan_gdn_mfma_unit(const Args& A, Frame& F, int unit, const int role) {
    int tid = F.tid; asm volatile("" : "+v"(tid));
    const int lane = tid & 63, w = F.wave;
    const int b = unit >> 3, h = unit & 7;
    const int qcol = EC_BQ + h * 128, kcol = EC_BK + h * 128, vcol = EC_BV + h * 128, ocol = 1024 + h * 128;
    const bf16* P = (const bf16*)(A.ws + WS_PROJ) + (size_t)b * SEQ * PROJ_LD;
    bf16* O = (bf16*)(A.ws + WS_O) + (size_t)b * SEQ * D + ocol;
    LAS float* Lf = (LAS float*)(F.lds + RING_OFF);
    constexpr int O_CW = 0, O_AMAT = 1536, O_QKM = O_AMAT + 256, O_TB = O_QKM + 128, O_GL = O_TB + 128, O_BUF0 = O_GL + 64;
    constexpr int BUFSZ = 6208, O_KH = 0, O_QH = 2048, O_VV = 4096, O_SC = 6144;
    constexpr int RS = 136;
    constexpr int O_KHB = O_BUF0 + 2 * BUFSZ, O_QHB = O_KHB + 1088, O_QB = O_QHB + 1088, O_KT = O_QB + 1088, O_WSRC = O_KT + 1024, O_WB = O_WSRC + 2048;
    LAS bf16* KHB = (LAS bf16*)(Lf + O_KHB); LAS bf16* QHB = (LAS bf16*)(Lf + O_QHB); LAS bf16* QB = (LAS bf16*)(Lf + O_QB); LAS bf16* KT = (LAS bf16*)(Lf + O_KT);
    LAS bf16* WB = (LAS bf16*)(Lf + O_WB); LAS bf16* QKM = (LAS bf16*)(Lf + O_QKM); LAS bf16* TB = (LAS bf16*)(Lf + O_TB);
    const int tl = tid >> 5, dq = (tid & 31) * 4;
    { const float* cw = A.in[I_GDN_CONV];
      for (int i = tid; i < 4 * 384; i += NTHREADS) { const int jt = i / 384, x = i % 384; Lf[O_CW + i] = cw[jt * 3072 + (x >> 7) * 1024 + h * 128 + (x & 127)]; } }
    const float neg_ea = -__expf(A.in[I_GDN_ALOG][h]), dtb = A.in[I_GDN_DTB][h];
    u32x2 rq[4], rk[4], rv[4]; unsigned short rba = 0, rbb = 0;
#define GD_LOAD(c) do { const int t_ = (c) * TC + tl; \
        _Pragma("unroll") for (int jt = 0; jt < 4; ++jt) { const int tt = t_ - 3 + jt; const bf16* pr = P + (size_t)(tt < 0 ? 0 : tt) * PROJ_LD + dq; \
            rq[jt] = *(const GAS u32x2*)(pr + qcol); rk[jt] = *(const GAS u32x2*)(pr + kcol); rv[jt] = *(const GAS u32x2*)(pr + vcol); \
            if (tt < 0) { rq[jt] = (u32x2){0u, 0u}; rk[jt] = (u32x2){0u, 0u}; rv[jt] = (u32x2){0u, 0u}; } } \
        { const bf16* pr = P + (size_t)t_ * PROJ_LD; rba = pr[EC_BA + h]; rbb = pr[EC_BB + h]; } } while (0)
#define GD_XFORM(bufi) do { LAS float* B_ = Lf + O_BUF0 + (bufi) * BUFSZ; f32x4 q4 = {0.f, 0.f, 0.f, 0.f}, k4 = {0.f, 0.f, 0.f, 0.f}, v4 = {0.f, 0.f, 0.f, 0.f}; \
        _Pragma("unroll") for (int jt = 0; jt < 4; ++jt) { const f32x4 wq = *(const LAS f32x4*)(Lf + O_CW + jt * 384 + dq), wk = *(const LAS f32x4*)(Lf + O_CW + jt * 384 + 128 + dq), wv = *(const LAS f32x4*)(Lf + O_CW + jt * 384 + 256 + dq); \
            q4[0] += wq[0] * bf_lo(rq[jt].x); q4[1] += wq[1] * bf_hi(rq[jt].x); q4[2] += wq[2] * bf_lo(rq[jt].y); q4[3] += wq[3] * bf_hi(rq[jt].y); \
            k4[0] += wk[0] * bf_lo(rk[jt].x); k4[1] += wk[1] * bf_hi(rk[jt].x); k4[2] += wk[2] * bf_lo(rk[jt].y); k4[3] += wk[3] * bf_hi(rk[jt].y); \
            v4[0] += wv[0] * bf_lo(rv[jt].x); v4[1] += wv[1] * bf_hi(rv[jt].x); v4[2] += wv[2] * bf_lo(rv[jt].y); v4[3] += wv[3] * bf_hi(rv[jt].y); } \
        float sq = 0.f, sk = 0.f; \
        _Pragma("unroll") for (int i_ = 0; i_ < 4; ++i_) { q4[i_] = siluf_(q4[i_]); k4[i_] = siluf_(k4[i_]); v4[i_] = siluf_(v4[i_]); sq += q4[i_] * q4[i_]; sk += k4[i_] * k4[i_]; } \
        row_sum16_x2(sq, sk); sq += __shfl_xor(sq, 16); sk += __shfl_xor(sk, 16); \
        q4 = q4 * (__builtin_amdgcn_rsqf(sq + EPS) * 0.08838834764831845f); k4 = k4 * __builtin_amdgcn_rsqf(sk + EPS); \
        *(LAS f32x4*)(B_ + O_KH + tl * 128 + dq) = k4; *(LAS f32x4*)(B_ + O_QH + tl * 128 + dq) = q4; *(LAS f32x4*)(B_ + O_VV + tl * 128 + dq) = v4; \
        if ((tid & 31) == 0) { const float ba = __uint_as_float((unsigned)rba << 16), bb = __uint_as_float((unsigned)rbb << 16); \
            B_[O_SC + tl] = __expf(neg_ea * softplusf_(ba + dtb)); B_[O_SC + 16 + tl] = sigmoidf_(bb); } } while (0)
    LBAR();
    constexpr int SPLIT = 58;
    const int c_begin = role ? SPLIT : 0, c_end = role ? NCHUNK : SPLIT;
    constexpr int REC = 5408;
    float* STASH = (float*)(A.ws + WS_LA) + (size_t)unit * (NCHUNK - SPLIT) * REC;
    float* STATE = (float*)(A.ws + WS_STATE) + (size_t)unit * 16384;
    gu32* flag = F.ctl + 32768 + unit * 64;
    GD_LOAD(c_begin); GD_XFORM(c_begin & 1); GD_LOAD(c_begin + 1);
    LBAR();
    f32x4 Sacc[8];
#pragma unroll
    for (int i = 0; i < 8; ++i) Sacc[i] = (f32x4){0.f, 0.f, 0.f, 0.f};
    const int fr = lane & 15, g = lane >> 4, c0 = w * 16;
    const u32x2 zz = {0u, 0u};
#define GD_STATE_PART(cc_) do { \
        { \
            bf16x8 sb[4]; \
_Pragma("unroll") \
            for (int ks = 0; ks < 4; ++ks) { u32x2 slo, shi; slo.x = hw_pk2(Sacc[2 * ks][0], Sacc[2 * ks][1]); slo.y = hw_pk2(Sacc[2 * ks][2], Sacc[2 * ks][3]); shi.x = hw_pk2(Sacc[2 * ks + 1][0], Sacc[2 * ks + 1][1]); shi.y = hw_pk2(Sacc[2 * ks + 1][2], Sacc[2 * ks + 1][3]); \
                sb[ks] = mk_frag(slo, shi); } \
            f32x4 accv = accu, acco = {0.f, 0.f, 0.f, 0.f}; \
_Pragma("unroll") \
            for (int ks = 0; ks < 4; ++ks) { \
                const u32x2 wl = *(const LAS u32x2*)(WB + fr * RS + 32 * ks + 4 * g), wh = *(const LAS u32x2*)(WB + fr * RS + 32 * ks + 16 + 4 * g); \
                accv = __builtin_amdgcn_mfma_f32_16x16x32_bf16(mk_frag(wl, wh), sb[ks], accv, 0, 0, 0); \
                const u32x2 ql = *(const LAS u32x2*)(QB + fr * RS + 32 * ks + 4 * g), qh = *(const LAS u32x2*)(QB + fr * RS + 32 * ks + 16 + 4 * g); \
                acco = __builtin_amdgcn_mfma_f32_16x16x32_bf16(mk_frag(ql, qh), sb[ks], acco, 0, 0, 0); } \
            u32x2 vn; vn.x = hw_pk2(accv[0], accv[1]); vn.y = hw_pk2(accv[2], accv[3]); \
            const bf16x8 vnb = mk_frag(vn, zz); \
            acco = __builtin_amdgcn_mfma_f32_16x16x32_bf16(mk_frag(*(const LAS u32x2*)(QKM + fr * 16 + 4 * g), zz), vnb, acco, 0, 0, 0); \
_Pragma("unroll") \
            for (int r = 0; r < 4; ++r) O[(size_t)((cc_) * TC + 4 * g + r) * D + c0 + fr] = hw_bf(acco[r]); \
_Pragma("unroll") \
            for (int i = 0; i < 8; ++i) { const u32x2 klo = *(const LAS u32x2*)(KT + (16 * i + fr) * 16 + 4 * g); \
                Sacc[i] = __builtin_amdgcn_mfma_f32_16x16x32_bf16(mk_frag(klo, zz), vnb, Sacc[i] * glast, 0, 0, 0); } \
        } \
        } while (0)
    for (int c = c_begin; c < c_end; ++c) {
        const LAS float* B_ = Lf + O_BUF0 + (c & 1) * BUFSZ;
        float glast;
        {
            const int seg = tid >> 7, d = tid & 127;
            const f32x4 a0 = *(const LAS f32x4*)(B_ + O_SC), a1 = *(const LAS f32x4*)(B_ + O_SC + 4), a2 = *(const LAS f32x4*)(B_ + O_SC + 8), a3 = *(const LAS f32x4*)(B_ + O_SC + 12);
            const float av[16] = {a0[0], a0[1], a0[2], a0[3], a1[0], a1[1], a1[2], a1[3], a2[0], a2[1], a2[2], a2[3], a3[0], a3[1], a3[2], a3[3]};
            float p = 1.f, gpre = 1.f;
#pragma unroll
            for (int t = 0; t < 16; ++t) { if (t == 4 * seg) gpre = p; p *= av[t]; }
            glast = p;
            unsigned short kt4[4]; float gt = gpre;
#pragma unroll
            for (int i = 0; i < 4; ++i) { const int t = 4 * seg + i; const float at = (seg == 0) ? av[i] : (seg == 1) ? av[4 + i] : (seg == 2) ? av[8 + i] : av[12 + i]; gt *= at; const float beta = B_[O_SC + 16 + t];
                const float kk = B_[O_KH + t * 128 + d], qq = B_[O_QH + t * 128 + d];
                KHB[t * RS + d] = hw_bf(kk); QHB[t * RS + d] = hw_bf(qq); QB[t * RS + d] = hw_bf(qq * gt);
                kt4[i] = (unsigned short)hw_bf(kk * glast * __builtin_amdgcn_rcpf(gt));
                Lf[O_WSRC + t * 128 + d] = kk * (beta * gt);
                if (d == 0) Lf[O_GL + t] = gt; }
            u32x2 kw; kw.x = (unsigned)kt4[0] | ((unsigned)kt4[1] << 16); kw.y = (unsigned)kt4[2] | ((unsigned)kt4[3] << 16);
            *(LAS u32x2*)(KT + d * 16 + 4 * seg) = kw;
        }
        LBAR();
        if (w < 2) {
            const LAS bf16* AS = (w == 0) ? KHB : QHB;
            f32x4 acc = {0.f, 0.f, 0.f, 0.f};
#pragma unroll
            for (int ks = 0; ks < 4; ++ks) { const bf16x8 af = *(const LAS bf16x8*)(AS + fr * RS + 32 * ks + 8 * g), bfm = *(const LAS bf16x8*)(KHB + fr * RS + 32 * ks + 8 * g);
                acc = __builtin_amdgcn_mfma_f32_16x16x32_bf16(af, bfm, acc, 0, 0, 0); }
            const float gs_inv = __builtin_amdgcn_rcpf(Lf[O_GL + fr]);
            if (w == 0) {
                f32x4 N1, M1;
#pragma unroll
                for (int r = 0; r < 4; ++r) { const int t = 4 * g + r; const float gt = Lf[O_GL + t];
                    N1[r] = (fr < t) ? -(B_[O_SC + 16 + t] * acc[r] * gt * gs_inv) : 0.f;
                    M1[r] = (t < fr) ? -(B_[O_SC + 16 + fr] * acc[r] * Lf[O_GL + fr] * __builtin_amdgcn_rcpf(gt)) : 0.f; }
#define XTY(X, Y, C0) __builtin_amdgcn_mfma_f32_16x16x32_bf16(mk_frag((u32x2){hw_pk2(X[0], X[1]), hw_pk2(X[2], X[3])}, zz), mk_frag((u32x2){hw_pk2(Y[0], Y[1]), hw_pk2(Y[2], Y[3])}, zz), C0, 0, 0, 0)
                const f32x4 z4 = {0.f, 0.f, 0.f, 0.f};
                f32x4 T1t = M1;
#pragma unroll
                for (int r = 0; r < 4; ++r) if (4 * g + r == fr) T1t[r] += 1.f;
                const f32x4 N2 = XTY(M1, N1, z4), M2 = XTY(N1, M1, z4);
                const f32x4 T2t = XTY(N2, T1t, T1t);
                const f32x4 N4 = XTY(M2, N2, z4), M4 = XTY(N2, M2, z4);
                const f32x4 T4t = XTY(N4, T2t, T2t);
                const f32x4 N8 = XTY(M4, N4, z4);
                const f32x4 T8t = XTY(N8, T4t, T4t);
#undef XTY
                u32x2 tw; tw.x = hw_pk2(T8t[0], T8t[1]); tw.y = hw_pk2(T8t[2], T8t[3]);
                *(LAS u32x2*)(TB + fr * 16 + 4 * g) = tw;
            } else {
#pragma unroll
                for (int r = 0; r < 4; ++r) { const int t = 4 * g + r; QKM[t * 16 + fr] = hw_bf((fr <= t) ? acc[r] * Lf[O_GL + t] * gs_inv : 0.f); }
            }
        }
        if (c + 1 < c_end) GD_XFORM((c + 1) & 1);
        if (c + 2 < c_end) GD_LOAD(c + 2);
        LBAR();
        f32x4 accu = {0.f, 0.f, 0.f, 0.f};
        {
            const bf16x8 tf = mk_frag(*(const LAS u32x2*)(TB + fr * 16 + 4 * g), zz);
            u32x2 ulo, wlo;
            { const float b0 = B_[O_SC + 16 + 4 * g + 0], b1 = B_[O_SC + 16 + 4 * g + 1], b2 = B_[O_SC + 16 + 4 * g + 2], b3 = B_[O_SC + 16 + 4 * g + 3];
              ulo.x = hw_pk2(b0 * B_[O_VV + (4 * g + 0) * 128 + c0 + fr], b1 * B_[O_VV + (4 * g + 1) * 128 + c0 + fr]); ulo.y = hw_pk2(b2 * B_[O_VV + (4 * g + 2) * 128 + c0 + fr], b3 * B_[O_VV + (4 * g + 3) * 128 + c0 + fr]);
              wlo.x = hw_pk2(Lf[O_WSRC + (4 * g + 0) * 128 + c0 + fr], Lf[O_WSRC + (4 * g + 1) * 128 + c0 + fr]); wlo.y = hw_pk2(Lf[O_WSRC + (4 * g + 2) * 128 + c0 + fr], Lf[O_WSRC + (4 * g + 3) * 128 + c0 + fr]); }
            accu = __builtin_amdgcn_mfma_f32_16x16x32_bf16(tf, mk_frag(ulo, zz), accu, 0, 0, 0);
            f32x4 accw = {0.f, 0.f, 0.f, 0.f};
            accw = __builtin_amdgcn_mfma_f32_16x16x32_bf16(tf, mk_frag(wlo, zz), accw, 0, 0, 0);
#pragma unroll
            for (int r = 0; r < 4; ++r) WB[(4 * g + r) * RS + c0 + fr] = hw_bf(-accw[r]);
        }
        LBAR();
        if (role == 0) {
            GD_STATE_PART(c);
        } else {
            float* rec = STASH + (size_t)(c - c_begin) * REC;
            for (int i = tid; i < 832; i += NTHREADS) { const int o = i < 528 ? O_QB + 4 * i : (i < 800 ? O_WB + 4 * (i - 528) : O_QKM + 4 * (i - 800)); *(GAS f32x4*)(rec + 4 * i) = *(const LAS f32x4*)(Lf + o); }
#pragma unroll
            for (int r = 0; r < 4; ++r) rec[3328 + (w * 4 + r) * 64 + lane] = accu[r];
            if (tid == 0) rec[5376] = glast;
        }
        LBAR();
    }
    if (role == 0) {
#pragma unroll
        for (int i = 0; i < 8; ++i)
#pragma unroll
            for (int r = 0; r < 4; ++r) STATE[((w * 8 + i) * 4 + r) * 64 + lane] = Sacc[i][r];
        asm volatile("s_waitcnt vmcnt(0)" ::: "memory");
        __syncthreads();
        if (tid == 0) { __builtin_amdgcn_fence(__ATOMIC_RELEASE, "agent"); asm volatile("s_waitcnt vmcnt(0)" ::: "memory"); __hip_atomic_store(flag, 1u, __ATOMIC_RELAXED, __HIP_MEMORY_SCOPE_AGENT); }
    } else {
        if (tid == 0) { unsigned sp = 0; while (__hip_atomic_load(flag, __ATOMIC_RELAXED, __HIP_MEMORY_SCOPE_AGENT) == 0u) { __builtin_amdgcn_s_sleep(8); if (++sp > (1u << 22)) break; }
            __builtin_amdgcn_fence(__ATOMIC_ACQUIRE, "agent"); asm volatile("s_waitcnt vmcnt(0)" ::: "memory"); }
        __syncthreads();
#pragma unroll
        for (int i = 0; i < 8; ++i)
#pragma unroll
            for (int r = 0; r < 4; ++r) Sacc[i][r] = STATE[((w * 8 + i) * 4 + r) * 64 + lane];
        f32x4 pa, pb; f32x4 pu; float pg;
#define GD_REC_LOAD(cc) do { const float* rec = STASH + (size_t)((cc) - c_begin) * REC; pa = *(const GAS f32x4*)(rec + 4 * tid); pb = (tid < 320) ? *(const GAS f32x4*)(rec + 4 * (tid + 512)) : (f32x4){0.f, 0.f, 0.f, 0.f}; \
            _Pragma("unroll") for (int r = 0; r < 4; ++r) pu[r] = rec[3328 + (w * 4 + r) * 64 + lane]; pg = rec[5376]; } while (0)
        GD_REC_LOAD(c_begin);
        for (int c = c_begin; c < c_end; ++c) {
            { const int i0 = tid, o0 = i0 < 528 ? O_QB + 4 * i0 : O_WB + 4 * (i0 - 528); *(LAS f32x4*)(Lf + o0) = pa;
              if (tid < 320) { const int i1 = tid + 512; const int o1 = i1 < 528 ? O_QB + 4 * i1 : (i1 < 800 ? O_WB + 4 * (i1 - 528) : O_QKM + 4 * (i1 - 800)); *(LAS f32x4*)(Lf + o1) = pb; } }
            const f32x4 accu = pu; const float glast = pg;
            if (c + 1 < c_end) GD_REC_LOAD(c + 1);
            LBAR();
            GD_STATE_PART(c);
            LBAR();
        }
#undef GD_REC_LOAD
    }
#undef GD_STATE_PART
#undef GD_LOAD
#undef GD_XFORM
}

__device__ __forceinline__ void scan_rwkv_unit(const Args& A, Frame& F, int unit) {
    int tid = F.tid; asm volatile("" : "+v"(tid));
    const int lane = tid & 63, w = F.wave;
    const int b = unit >> 4, h = unit & 15;
    const bf16* P = (const bf16*)(A.ws + WS_PROJ) + (size_t)b * SEQ * PROJ_LD + OC_RW;
    const bf16* LO = (const bf16*)(A.ws + WS_LO) + (size_t)b * SEQ * LORA_N;
    bf16* Y = (bf16*)(A.ws + WS_ACTA) + (size_t)b * SEQ * D + 1024 + h * 64;
    LAS float* Lf = (LAS float*)(F.lds + RING_OFF);
    constexpr int BUFSZ = 6208, O_KK = 0, O_WR = 1024, O_W = 2048, O_NKA = 3072, O_K = 4096, O_V = 5120, O_SC = 6144, O_OUT = 2 * BUFSZ;
    const int tl = tid >> 5, d2 = (tid & 31) * 2, hd = h * 64 + d2;
    float mu_r[2], mu_k[2], mu_v[2], w0[2], a0[2], k_k[2], k_a[2], r_k[2], lnw[2], lnb[2];
#pragma unroll
    for (int i = 0; i < 2; ++i) { mu_r[i] = A.in[I_MU][RW_R + hd + i]; mu_k[i] = A.in[I_MU][RW_K + hd + i]; mu_v[i] = A.in[I_MU][RW_V + hd + i];
        w0[i] = A.in[I_W0][hd + i]; a0[i] = A.in[I_A0][hd + i]; k_k[i] = A.in[I_KK][hd + i]; k_a[i] = A.in[I_KA][hd + i]; r_k[i] = A.in[I_RK][hd + i];
        lnw[i] = A.in[I_LNW][hd + i]; lnb[i] = A.in[I_LNB][hd + i]; }
    unsigned rr[2], rk[2], rv[2], rlw, rla, rg_cur = 0u, rg_nxt = 0u;
#define RW_LOAD(c) do { const int t_ = (c) * TC + tl; const bf16* pr = P + (size_t)t_ * PROJ_LD; \
        rr[0] = *(const GAS unsigned*)(pr + RW_R + hd); rk[0] = *(const GAS unsigned*)(pr + RW_K + hd); rv[0] = *(const GAS unsigned*)(pr + RW_V + hd); \
        if (t_ > 0) { rr[1] = *(const GAS unsigned*)(pr - PROJ_LD + RW_R + hd); rk[1] = *(const GAS unsigned*)(pr - PROJ_LD + RW_K + hd); rv[1] = *(const GAS unsigned*)(pr - PROJ_LD + RW_V + hd); } \
        else { rr[1] = 0u; rk[1] = 0u; rv[1] = 0u; } \
        const bf16* lr = LO + (size_t)t_ * LORA_N; rlw = *(const GAS unsigned*)(lr + hd); rla = *(const GAS unsigned*)(lr + 1024 + hd); rg_nxt = *(const GAS unsigned*)(lr + 2048 + hd); } while (0)
#define RW_XFORM(bufi) do { LAS float* B_ = Lf + (bufi) * BUFSZ; f32x2 kk2, wr2, w2_, nka2, k2, v2_; float skk = 0.f, sc1 = 0.f, sc2 = 0.f, sbs = 0.f; float aa[2], rrv[2]; \
        _Pragma("unroll") for (int i_ = 0; i_ < 2; ++i_) { \
            const float r0 = i_ ? bf_hi(rr[0]) : bf_lo(rr[0]), r1 = i_ ? bf_hi(rr[1]) : bf_lo(rr[1]); \
            const float k0_ = i_ ? bf_hi(rk[0]) : bf_lo(rk[0]), k1_ = i_ ? bf_hi(rk[1]) : bf_lo(rk[1]); \
            const float v0_ = i_ ? bf_hi(rv[0]) : bf_lo(rv[0]), v1_ = i_ ? bf_hi(rv[1]) : bf_lo(rv[1]); \
            const float lw = i_ ? bf_hi(rlw) : bf_lo(rlw), la = i_ ? bf_hi(rla) : bf_lo(rla); \
            const float r_ = r0 + (r1 - r0) * mu_r[i_], kx = k0_ + (k1_ - k0_) * mu_k[i_], vx = v0_ + (v1_ - v0_) * mu_v[i_]; \
            const float wd = __expf(-0.6065306597126334f * sigmoidf_(w0[i_] + lw)); const float a_ = sigmoidf_(a0[i_] + la); \
            const float kk0 = kx * k_k[i_]; const float km = kx * (1.f + (a_ - 1.f) * k_a[i_]); \
            kk2[i_] = kk0; skk += kk0 * kk0; aa[i_] = a_; rrv[i_] = r_; wr2[i_] = wd * r_; w2_[i_] = wd; k2[i_] = km; v2_[i_] = vx; sc2 += km * r_; sbs += r_ * km * r_k[i_]; } \
        skk = half_sum32(skk); const float rkk = __builtin_amdgcn_rsqf(skk + EPS); \
        _Pragma("unroll") for (int i_ = 0; i_ < 2; ++i_) { kk2[i_] *= rkk; nka2[i_] = -(kk2[i_] * aa[i_]); sc1 += kk2[i_] * aa[i_] * rrv[i_]; } \
        sc1 = half_sum32(sc1); sc2 = half_sum32(sc2); sbs = half_sum32(sbs); \
        *(LAS f32x2*)(B_ + O_KK + tl * 64 + d2) = kk2; *(LAS f32x2*)(B_ + O_WR + tl * 64 + d2) = wr2; *(LAS f32x2*)(B_ + O_W + tl * 64 + d2) = w2_; \
        *(LAS f32x2*)(B_ + O_NKA + tl * 64 + d2) = nka2; *(LAS f32x2*)(B_ + O_K + tl * 64 + d2) = k2; *(LAS f32x2*)(B_ + O_V + tl * 64 + d2) = v2_; \
        if ((tid & 31) == 0) { f32x4 sc; sc[0] = sc1; sc[1] = sc2; sc[2] = sbs; sc[3] = 0.f; *(LAS f32x4*)(B_ + O_SC + tl * 4) = sc; } } while (0)
    RW_LOAD(0); RW_XFORM(0); rg_cur = rg_nxt;
    LBAR();
    f32x2 S2[4];
#pragma unroll
    for (int i = 0; i < 4; ++i) S2[i] = (f32x2){0.f, 0.f};
    const int j = lane & 15, col = w * 8 + (lane >> 4) * 2;
    for (int c = 0; c < NCHUNK; ++c) {
        if (c + 1 < NCHUNK) RW_LOAD(c + 1);
        const LAS float* B_ = Lf + (c & 1) * BUFSZ;
        float os0 = 0.f, os1 = 0.f;
        f32x4 kk, wr, ww, nka, kv, sc, nkk, nwr, nww, nnka, nkv, nsc; f32x2 v2, nv2;
#define RW_LDSTEP(t_, KK, WR, WW, NKA, KV, V2, SC) do { KK = *(const LAS f32x4*)(B_ + O_KK + (t_) * 64 + 4 * j); WR = *(const LAS f32x4*)(B_ + O_WR + (t_) * 64 + 4 * j); WW = *(const LAS f32x4*)(B_ + O_W + (t_) * 64 + 4 * j); \
            NKA = *(const LAS f32x4*)(B_ + O_NKA + (t_) * 64 + 4 * j); KV = *(const LAS f32x4*)(B_ + O_K + (t_) * 64 + 4 * j); V2 = *(const LAS f32x2*)(B_ + O_V + (t_) * 64 + col); SC = *(const LAS f32x4*)(B_ + O_SC + (t_) * 4); } while (0)
        RW_LDSTEP(0, kk, wr, ww, nka, kv, v2, sc);
#pragma unroll
        for (int t = 0; t < TC; ++t) {
            if (t + 1 < TC) { RW_LDSTEP(t + 1, nkk, nwr, nww, nnka, nkv, nv2, nsc); }
            __builtin_amdgcn_sched_barrier(0);
            f32x2 d1 = S2[0] * kk[0], d2 = S2[0] * wr[0], e1 = S2[1] * kk[1], e2 = S2[1] * wr[1];
            d1 += S2[2] * kk[2]; d2 += S2[2] * wr[2]; e1 += S2[3] * kk[3]; e2 += S2[3] * wr[3];
            d1 += e1; d2 += e2;
            { float r0_ = d1[0], r1_ = d1[1], r2_ = d2[0], r3_ = d2[1]; row_sum16_x4(r0_, r1_, r2_, r3_); d1[0] = r0_; d1[1] = r1_; d2[0] = r2_; d2[1] = r3_; }
            const f32x2 o2 = d2 - d1 * sc[0] + v2 * sc[1];
#pragma unroll
            for (int i = 0; i < 4; ++i) S2[i] = S2[i] * ww[i] + d1 * nka[i] + v2 * kv[i];
            os0 = (j == t) ? o2[0] : os0; os1 = (j == t) ? o2[1] : os1;
            kk = nkk; wr = nwr; ww = nww; nka = nnka; kv = nkv; v2 = nv2; sc = nsc;
        }
#undef RW_LDSTEP
        { f32x2 o2 = {os0, os1}; *(LAS f32x2*)(Lf + O_OUT + j * 64 + col) = o2; }
        if (c + 1 < NCHUNK) RW_XFORM((c + 1) & 1);
        LBAR();
        {
            const f32x2 o2 = *(const LAS f32x2*)(Lf + O_OUT + tl * 64 + d2); const f32x2 vv = *(const LAS f32x2*)(B_ + O_V + tl * 64 + d2); const float bs = B_[O_SC + tl * 4 + 2];
            const float mean = half_sum32(o2[0] + o2[1]) * (1.0f / 64.0f); const float e0 = o2[0] - mean, e1 = o2[1] - mean;
            const float var = half_sum32(e0 * e0 + e1 * e1) * (1.0f / 64.0f); const float rs = __builtin_amdgcn_rsqf(var + 64e-5f);
            const float y0 = (e0 * rs * lnw[0] + lnb[0] + bs * vv[0]) * bf_lo(rg_cur), y1 = (e1 * rs * lnw[1] + lnb[1] + bs * vv[1]) * bf_hi(rg_cur);
            *(GAS unsigned*)(Y + (size_t)(c * TC + tl) * D + d2) = pk2(y0, y1);
        }
        rg_cur = rg_nxt;
        LBAR();
    }
#undef RW_LOAD
#undef RW_XFORM
}

template <int LAYER>
__device__ __forceinline__ void post_rows(const Args& A, Frame& F) {
    const int gw = F.vcu * NWAVES + F.wave, NGW = F.G * NWAVES, lane = F.lane;
    const bf16* O = (const bf16*)(A.ws + WS_O); const bf16* P = (const bf16*)(A.ws + WS_PROJ); bf16* Y = (bf16*)(A.ws + WS_ACTA);
    for (int m = gw; m < T; m += NGW) {
        const GAS u32x2* orow = (const GAS u32x2*)(O + (size_t)m * D) + lane; const bf16* prow = P + (size_t)m * PROJ_LD;
        constexpr int NJ = LAYER == 0 ? 8 : 4;
#pragma unroll
        for (int jj = 0; jj < NJ; ++jj) {
            const u32x2 ow_ = orow[64 * jj]; const f32x4 v = {bf_lo(ow_.x), bf_hi(ow_.x), bf_lo(ow_.y), bf_hi(ow_.y)}; float ss = (v[0] * v[0] + v[1] * v[1]) + (v[2] * v[2] + v[3] * v[3]);
            const bool wide = (LAYER == 0 && jj < 4);
            const float ms = wide ? wave_sum(ss) * (1.0f / 256.0f) : half_sum32(ss) * (1.0f / 128.0f);
            const float r = __builtin_amdgcn_rsqf(ms + EPS);
            const int cih = wide ? 4 * lane : 4 * (lane & 31);
            const float* gsrc = LAYER == 0 ? (wide ? A.in[I_GLA_NORM] : A.in[I_GDN_NORM]) : A.in[I_HG_NORM];
            const f32x4 g = *(const GAS f32x4*)(gsrc + cih);
            const int zcol = LAYER == 0 ? (wide ? EC_GZ + jj * 256 + 4 * lane : EC_BZ + (jj - 4) * 256 + 4 * lane) : OC_HG + jj * 256 + 4 * lane;
            const u32x2 zw = *(const GAS u32x2*)(prow + zcol);
            const float y0 = v[0] * r * g[0] * siluf_(bf_lo(zw.x)), y1 = v[1] * r * g[1] * siluf_(bf_hi(zw.x)), y2 = v[2] * r * g[2] * siluf_(bf_lo(zw.y)), y3 = v[3] * r * g[3] * siluf_(bf_hi(zw.y));
            if constexpr (LAYER == 1) { int o8 = __builtin_amdgcn_cvt_pk_fp8_f32(y0, y1, 0, false); o8 = __builtin_amdgcn_cvt_pk_fp8_f32(y2, y3, o8, true);
                *(GAS unsigned*)((unsigned char*)Y + (size_t)m * D + 256 * jj + 4 * lane) = (unsigned)o8; }
            else { u32x2 o; o.x = pk2(y0, y1); o.y = pk2(y2, y3);
                *(GAS u32x2*)(Y + (size_t)m * D + 256 * jj + 4 * lane) = o; }
        }
    }
}
__device__ __forceinline__ void lora_prep_rows(const Args& A, Frame& F) {
    const int gw = F.vcu * NWAVES + F.wave, NGW = F.G * NWAVES, lane = F.lane;
    const bf16* P = (const bf16*)(A.ws + WS_PROJ); bf16* LA = (bf16*)(A.ws + WS_LA); const float* mu = A.in[I_MU];
    for (int m = gw; m < T; m += NGW) { const bool hasprev = (m % SEQ) != 0; const bf16* prow = P + (size_t)m * PROJ_LD + OC_RW + RW_WL;
#pragma unroll
        for (int i = 0; i < 7; ++i) { const int c = lane + 64 * i;
            const float x = __uint_as_float((unsigned)prow[c] << 16), xp = hasprev ? __uint_as_float((unsigned)prow[c - PROJ_LD] << 16) : 0.f;
            const float ts = x + (xp - x) * mu[RW_WL + c];
            const float v = c < 96 ? tanhf(ts) : (c < 192 ? ts : sigmoidf_(ts));
            LA[(size_t)m * LORA_K + c] = (bf16)f2bf(v); }
        LA[(size_t)m * LORA_K + 448 + lane] = (bf16)0; }
}
__device__ __forceinline__ void final_rows(const Args& A, Frame& F, const float oscale, const bf16* Hs) {
    const int gw = F.vcu * NWAVES + F.wave, NGW = F.G * NWAVES, lane = F.lane;
    const float* rowss = (const float*)(A.ws + WS_RSP) + (size_t)RS_FINAL * T * 32; const GAS f32x4* g = (const GAS f32x4*)A.in[I_NFINAL] + lane;
    for (int m = gw; m < T; m += NGW) { const float r = oscale * __builtin_amdgcn_rsqf(wave_sum(lane < 32 ? rowss[(size_t)m * 32 + lane] : 0.f) * (1.0f / D) + EPS); GAS f32x4* row = (GAS f32x4*)(A.out + (size_t)m * D) + lane;
        const GAS u32x2* hrow = (const GAS u32x2*)(Hs + (size_t)m * D) + lane;
#pragma unroll
        for (int jj = 0; jj < 8; ++jj) { const u32x2 hw = hrow[64 * jj]; const f32x4 v = {bf_lo(hw.x), bf_hi(hw.x), bf_lo(hw.y), bf_hi(hw.y)}; row[64 * jj] = v * r * g[64 * jj]; } }
}

__device__ __forceinline__ void scan_rwkv_mfma_unit(const Args& A, Frame& F, int unit, const int role) {
    int tid = F.tid; asm volatile("" : "+v"(tid));
    const int lane = tid & 63, w = F.wave;
    const int b = unit >> 3, hp = unit & 7;
    const bf16* P = (const bf16*)(A.ws + WS_PROJ) + (size_t)b * SEQ * PROJ_LD + OC_RW;
    const bf16* LO = (const bf16*)(A.ws + WS_LO) + (size_t)b * SEQ * LORA_N;
    unsigned char* Y = (unsigned char*)(A.ws + WS_ACTA) + (size_t)b * SEQ * D + 1024;
    LAS float* Lf = (LAS float*)(F.lds + RING_OFF);
    constexpr int RS = 72;
    constexpr int O_CONST = 0;
    constexpr int O_XF = 1280;
    constexpr int O_VV = O_XF + 2 * 5 * 1024;
    constexpr int O_BS = O_VV + 4 * 1024;
    constexpr int O_IMG = O_BS + 64;
    constexpr int I_CT = 0, I_BT = 576, I_KL = 1152, I_RT = 1728, I_CF = 2304, I_BTT = 3328, I_KTT = 3840, I_WCB = 4352, I_G1B = 4928, I_TTB = 5056, I_RKB = 5184, I_RBB = 5312, I_W15 = 5440, I_OUT = 5504, IMGSZ = 6528;
    static_assert((O_IMG + 2 * IMGSZ) * 4 <= RING_BYTES, "rwkv lds");
    for (int i = tid; i < 1280; i += NTHREADS) { const int arr = i >> 7, ch = hp * 128 + (i & 127); float v;
        switch (arr) { case 0: v = A.in[I_MU][RW_R + ch]; break; case 1: v = A.in[I_MU][RW_K + ch]; break; case 2: v = A.in[I_MU][RW_V + ch]; break; case 3: v = A.in[I_W0][ch]; break; case 4: v = A.in[I_A0][ch]; break;
                       case 5: v = A.in[I_KK][ch]; break; case 6: v = A.in[I_KA][ch]; break; case 7: v = A.in[I_RK][ch]; break; case 8: v = A.in[I_LNW][ch]; break; default: v = A.in[I_LNB][ch]; break; }
        Lf[O_CONST + i] = v; }
    const int hx = tid >> 8, tl = (tid >> 4) & 15, d4 = (tid & 15) * 4, ch4 = hx * 64 + d4, col4 = hp * 128 + ch4;
    u32x2 rr[2], rk[2], rv[2], rlw, rla, rg_cur = {0u, 0u}, rg_nxt = {0u, 0u}, rg_far = {0u, 0u};
#define RM_LOAD(c) do { const int t_ = (c) * TC + tl; const bf16* pr = P + (size_t)t_ * PROJ_LD + col4; \
        rr[0] = *(const GAS u32x2*)(pr + RW_R); rk[0] = *(const GAS u32x2*)(pr + RW_K); rv[0] = *(const GAS u32x2*)(pr + RW_V); \
        const bf16* pp_ = (t_ > 0) ? pr - PROJ_LD : pr; rr[1] = *(const GAS u32x2*)(pp_ + RW_R); rk[1] = *(const GAS u32x2*)(pp_ + RW_K); rv[1] = *(const GAS u32x2*)(pp_ + RW_V); \
        if (t_ == 0) { rr[1] = (u32x2){0u, 0u}; rk[1] = (u32x2){0u, 0u}; rv[1] = (u32x2){0u, 0u}; } \
        const bf16* lr = LO + (size_t)t_ * LORA_N + col4; rlw = *(const GAS u32x2*)(lr); rla = *(const GAS u32x2*)(lr + 1024); rg_far = *(const GAS u32x2*)(lr + 2048); } while (0)
#define RM_XFORM(bufi) do { LAS float* X_ = Lf + O_XF + hx * 5 * 1024 + tl * 64 + d4; \
        const f32x4 mur = *(const LAS f32x4*)(Lf + O_CONST + 0 * 128 + ch4), muk = *(const LAS f32x4*)(Lf + O_CONST + 1 * 128 + ch4), muv = *(const LAS f32x4*)(Lf + O_CONST + 2 * 128 + ch4); \
        const f32x4 w0_ = *(const LAS f32x4*)(Lf + O_CONST + 3 * 128 + ch4), a0_ = *(const LAS f32x4*)(Lf + O_CONST + 4 * 128 + ch4), kk_ = *(const LAS f32x4*)(Lf + O_CONST + 5 * 128 + ch4); \
        const f32x4 ka_ = *(const LAS f32x4*)(Lf + O_CONST + 6 * 128 + ch4), rk_ = *(const LAS f32x4*)(Lf + O_CONST + 7 * 128 + ch4); \
        const float r0[4] = {bf_lo(rr[0].x), bf_hi(rr[0].x), bf_lo(rr[0].y), bf_hi(rr[0].y)}, r1[4] = {bf_lo(rr[1].x), bf_hi(rr[1].x), bf_lo(rr[1].y), bf_hi(rr[1].y)}; \
        const float k0[4] = {bf_lo(rk[0].x), bf_hi(rk[0].x), bf_lo(rk[0].y), bf_hi(rk[0].y)}, k1[4] = {bf_lo(rk[1].x), bf_hi(rk[1].x), bf_lo(rk[1].y), bf_hi(rk[1].y)}; \
        const float v0[4] = {bf_lo(rv[0].x), bf_hi(rv[0].x), bf_lo(rv[0].y), bf_hi(rv[0].y)}, v1[4] = {bf_lo(rv[1].x), bf_hi(rv[1].x), bf_lo(rv[1].y), bf_hi(rv[1].y)}; \
        const float lw[4] = {bf_lo(rlw.x), bf_hi(rlw.x), bf_lo(rlw.y), bf_hi(rlw.y)}, la[4] = {bf_lo(rla.x), bf_hi(rla.x), bf_lo(rla.y), bf_hi(rla.y)}; \
        f32x4 r4, w4, k4, v4, kk4, b4; float skk = 0.f, sbs = 0.f; float aa[4]; \
        _Pragma("unroll") for (int i_ = 0; i_ < 4; ++i_) { const float r_ = r0[i_] + (r1[i_] - r0[i_]) * mur[i_], kx = k0[i_] + (k1[i_] - k0[i_]) * muk[i_], vx = v0[i_] + (v1[i_] - v0[i_]) * muv[i_]; \
            const float wd = __expf(-0.6065306597126334f * sigmoidf_(w0_[i_] + lw[i_])); const float a_ = sigmoidf_(a0_[i_] + la[i_]); \
            const float kk0 = kx * kk_[i_], km = kx * (1.f + (a_ - 1.f) * ka_[i_]); \
            r4[i_] = r_; w4[i_] = wd; k4[i_] = km; v4[i_] = vx; kk4[i_] = kk0; aa[i_] = a_; skk += kk0 * kk0; sbs += r_ * km * rk_[i_]; } \
        row_sum16_x2(skk, sbs); const float rkk = __builtin_amdgcn_rsqf(skk + EPS); \
        _Pragma("unroll") for (int i_ = 0; i_ < 4; ++i_) { kk4[i_] *= rkk; b4[i_] = kk4[i_] * aa[i_]; } \
        *(LAS f32x4*)(X_) = r4; *(LAS f32x4*)(X_ + 1024) = w4; *(LAS f32x4*)(X_ + 2048) = k4; *(LAS f32x4*)(X_ + 3072) = kk4; *(LAS f32x4*)(X_ + 4096) = b4; \
        *(LAS f32x4*)(Lf + O_VV + ((bufi) * 2 + hx) * 1024 + tl * 64 + d4) = v4; \
        if ((tid & 15) == 0) Lf[O_BS + ((bufi) * 2 + hx) * 16 + tl] = sbs; } while (0)
    constexpr int SPLIT = 60;
    const int c_begin = role ? SPLIT : 0, c_end = role ? NCHUNK : SPLIT;
    constexpr int REC = 7584;
    float* STASH = (float*)(A.ws + (unit < 32 ? WS_WEV_IN : WS_END)) + (size_t)(unit & 31) * (NCHUNK - SPLIT) * REC;
    float* STATE = (float*)(A.ws + WS_STATE + 4 * MiB) + (size_t)unit * 8192;
    gu32* flag = F.ctl + 49152 + unit * 64;
    LBAR();
    RM_LOAD(c_begin); RM_XFORM(c_begin & 1); rg_cur = rg_far; RM_LOAD(c_begin + 1); rg_nxt = rg_far;
    LBAR();
    f32x4 Macc[4];
#pragma unroll
    for (int i = 0; i < 4; ++i) Macc[i] = (f32x4){0.f, 0.f, 0.f, 0.f};
    const int fr = lane & 15, g = lane >> 4, hh = w >> 2, ww = w & 3, c0 = ww * 16;
    LAS float* IM = Lf + O_IMG + hh * IMGSZ;
    LAS bf16* CT = (LAS bf16*)(IM + I_CT); LAS bf16* BT = (LAS bf16*)(IM + I_BT); LAS bf16* KL = (LAS bf16*)(IM + I_KL); LAS bf16* RT = (LAS bf16*)(IM + I_RT);
    LAS bf16* BTT = (LAS bf16*)(IM + I_BTT); LAS bf16* KTT = (LAS bf16*)(IM + I_KTT); LAS bf16* WCB = (LAS bf16*)(IM + I_WCB);
    LAS bf16* G1B = (LAS bf16*)(IM + I_G1B); LAS bf16* TTB = (LAS bf16*)(IM + I_TTB); LAS bf16* RKB = (LAS bf16*)(IM + I_RKB); LAS bf16* RBB = (LAS bf16*)(IM + I_RBB);
    const u32x2 zz = {0u, 0u};
#define RM_STATE_PART(vb) do { \
        { \
            bf16x8 mb[2]; \
_Pragma("unroll") \
            for (int ks = 0; ks < 2; ++ks) { u32x2 slo, shi; slo.x = hw_pk2(Macc[2 * ks][0], Macc[2 * ks][1]); slo.y = hw_pk2(Macc[2 * ks][2], Macc[2 * ks][3]); shi.x = hw_pk2(Macc[2 * ks + 1][0], Macc[2 * ks + 1][1]); shi.y = hw_pk2(Macc[2 * ks + 1][2], Macc[2 * ks + 1][3]); \
                mb[ks] = mk_frag(slo, shi); } \
            f32x4 accR = accU, acco = {0.f, 0.f, 0.f, 0.f}; \
_Pragma("unroll") \
            for (int ks = 0; ks < 2; ++ks) { \
                accR = __builtin_amdgcn_mfma_f32_16x16x32_bf16(mk_frag(*(const LAS u32x2*)(WCB + fr * RS + 32 * ks + 4 * g), *(const LAS u32x2*)(WCB + fr * RS + 32 * ks + 16 + 4 * g)), mb[ks], accR, 0, 0, 0); \
                acco = __builtin_amdgcn_mfma_f32_16x16x32_bf16(mk_frag(*(const LAS u32x2*)(RT + fr * RS + 32 * ks + 4 * g), *(const LAS u32x2*)(RT + fr * RS + 32 * ks + 16 + 4 * g)), mb[ks], acco, 0, 0, 0); } \
            u32x2 rn; rn.x = hw_pk2(accR[0], accR[1]); rn.y = hw_pk2(accR[2], accR[3]); \
            const bf16x8 rb = mk_frag(rn, zz); \
            acco = __builtin_amdgcn_mfma_f32_16x16x32_bf16(mk_frag(*(const LAS u32x2*)(RKB + fr * 16 + 4 * g), zz), vb, acco, 0, 0, 0); \
            acco = __builtin_amdgcn_mfma_f32_16x16x32_bf16(mk_frag(*(const LAS u32x2*)(RBB + fr * 16 + 4 * g), zz), rb, acco, 0, 0, 0); \
_Pragma("unroll") \
            for (int r = 0; r < 4; ++r) IM[I_OUT + (4 * g + r) * 64 + c0 + fr] = acco[r]; \
_Pragma("unroll") \
            for (int i = 0; i < 4; ++i) { const f32x4 w15 = *(const LAS f32x4*)(IM + I_W15 + 16 * i + 4 * g); \
                f32x4 m = __builtin_amdgcn_mfma_f32_16x16x32_bf16(mk_frag(*(const LAS u32x2*)(KTT + (16 * i + fr) * 16 + 4 * g), zz), vb, Macc[i], 0, 0, 0); \
                m = __builtin_amdgcn_mfma_f32_16x16x32_bf16(mk_frag(*(const LAS u32x2*)(BTT + (16 * i + fr) * 16 + 4 * g), zz), rb, m, 0, 0, 0); \
                Macc[i] = m * w15; } \
        } \
        } while (0)
#define RM_FLUSH(cc_, gb_, vv_, bs_) do { \
        { \
            const f32x4 o4 = *(const LAS f32x4*)(Lf + O_IMG + hx * IMGSZ + I_OUT + tl * 64 + d4); const f32x4 vv = (vv_); const float bs = (bs_); \
            const f32x4 lnw = *(const LAS f32x4*)(Lf + O_CONST + 8 * 128 + ch4), lnb = *(const LAS f32x4*)(Lf + O_CONST + 9 * 128 + ch4); \
            float sm = (o4[0] + o4[1]) + (o4[2] + o4[3]), dummy = 0.f; row_sum16_x2(sm, dummy); const float mean = sm * (1.0f / 64.0f); \
            const f32x4 e4 = o4 - mean; float sv = (e4[0] * e4[0] + e4[1] * e4[1]) + (e4[2] * e4[2] + e4[3] * e4[3]); row_sum16_x2(sv, dummy); const float rs = __builtin_amdgcn_rsqf(sv * (1.0f / 64.0f) + 64e-5f); \
            const float gg[4] = {bf_lo((gb_).x), bf_hi((gb_).x), bf_lo((gb_).y), bf_hi((gb_).y)}; \
            float y[4]; \
_Pragma("unroll") \
            for (int i = 0; i < 4; ++i) y[i] = (e4[i] * rs * lnw[i] + lnb[i] + bs * vv[i]) * gg[i]; \
            int o8 = __builtin_amdgcn_cvt_pk_fp8_f32(y[0], y[1], 0, false); o8 = __builtin_amdgcn_cvt_pk_fp8_f32(y[2], y[3], o8, true); \
            *(GAS unsigned*)(Y + (size_t)((cc_) * TC + tl) * D + col4) = (unsigned)o8; \
        } \
        } while (0)
    for (int c = c_begin; c < c_end; ++c) {
        {
            const int hq = tid >> 8, seg = (tid >> 6) & 3, d = tid & 63;
            const LAS float* X_ = Lf + O_XF + hq * 5 * 1024 + d; LAS float* IQ = Lf + O_IMG + hq * IMGSZ;
            LAS bf16* CTq = (LAS bf16*)(IQ + I_CT); LAS bf16* BTq = (LAS bf16*)(IQ + I_BT); LAS bf16* KLq = (LAS bf16*)(IQ + I_KL); LAS bf16* RTq = (LAS bf16*)(IQ + I_RT);
            float wall = 1.f, wpre = 1.f;
#pragma unroll
            for (int t = 0; t < 16; ++t) { if (t == 4 * seg) wpre = wall; wall *= X_[1024 + t * 64]; }
            float wt = wpre; unsigned short bt4[4], kt4[4];
#pragma unroll
            for (int i = 0; i < 4; ++i) { const int t = 4 * seg + i; const float wprev = wt; wt *= X_[1024 + t * 64]; const float iw = __builtin_amdgcn_rcpf(wt);
                const float r_ = X_[t * 64], k_ = X_[2048 + t * 64], kk_ = X_[3072 + t * 64], b_ = X_[4096 + t * 64];
                const float ct = kk_ * wprev, bt = b_ * iw, kt = k_ * iw;
                CTq[t * RS + d] = hw_bf(ct); IQ[I_CF + t * 64 + d] = ct; BTq[t * RS + d] = hw_bf(bt); KLq[t * RS + d] = hw_bf(kt); RTq[t * RS + d] = hw_bf(r_ * wt);
                bt4[i] = (unsigned short)hw_bf(-bt); kt4[i] = (unsigned short)hw_bf(kt); }
            u32x2 o; o.x = (unsigned)bt4[0] | ((unsigned)bt4[1] << 16); o.y = (unsigned)bt4[2] | ((unsigned)bt4[3] << 16); *(LAS u32x2*)((LAS bf16*)(IQ + I_BTT) + d * 16 + 4 * seg) = o;
            o.x = (unsigned)kt4[0] | ((unsigned)kt4[1] << 16); o.y = (unsigned)kt4[2] | ((unsigned)kt4[3] << 16); *(LAS u32x2*)((LAS bf16*)(IQ + I_KTT) + d * 16 + 4 * seg) = o;
            if (seg == 3) IQ[I_W15 + d] = wall;
        }
        LBAR();
        if (ww == 0) {
            f32x4 cb = {0.f, 0.f, 0.f, 0.f}, bc = cb, ck = cb, rkm = cb, rbm = cb;
#pragma unroll
            for (int ks = 0; ks < 2; ++ks) { const bf16x8 fc = *(const LAS bf16x8*)(CT + fr * RS + 32 * ks + 8 * g), fb = *(const LAS bf16x8*)(BT + fr * RS + 32 * ks + 8 * g), fk = *(const LAS bf16x8*)(KL + fr * RS + 32 * ks + 8 * g), frr = *(const LAS bf16x8*)(RT + fr * RS + 32 * ks + 8 * g);
                cb = __builtin_amdgcn_mfma_f32_16x16x32_bf16(fc, fb, cb, 0, 0, 0); bc = __builtin_amdgcn_mfma_f32_16x16x32_bf16(fb, fc, bc, 0, 0, 0); ck = __builtin_amdgcn_mfma_f32_16x16x32_bf16(fc, fk, ck, 0, 0, 0);
                rkm = __builtin_amdgcn_mfma_f32_16x16x32_bf16(frr, fk, rkm, 0, 0, 0); rbm = __builtin_amdgcn_mfma_f32_16x16x32_bf16(frr, fb, rbm, 0, 0, 0); }
            f32x4 N1, M1, CKm;
#pragma unroll
            for (int r = 0; r < 4; ++r) { const int t = 4 * g + r; N1[r] = (fr < t) ? -cb[r] : 0.f; M1[r] = (t < fr) ? -bc[r] : 0.f; CKm[r] = (fr < t) ? ck[r] : 0.f;
                RKB[t * 16 + fr] = hw_bf((fr <= t) ? rkm[r] : 0.f); RBB[t * 16 + fr] = hw_bf((fr <= t) ? -rbm[r] : 0.f); }
#define XTY(X, Y, C0) __builtin_amdgcn_mfma_f32_16x16x32_bf16(mk_frag((u32x2){hw_pk2(X[0], X[1]), hw_pk2(X[2], X[3])}, zz), mk_frag((u32x2){hw_pk2(Y[0], Y[1]), hw_pk2(Y[2], Y[3])}, zz), C0, 0, 0, 0)
            const f32x4 z4 = {0.f, 0.f, 0.f, 0.f};
            f32x4 T1t = M1;
#pragma unroll
            for (int r = 0; r < 4; ++r) if (4 * g + r == fr) T1t[r] += 1.f;
            const f32x4 N2 = XTY(M1, N1, z4), M2 = XTY(N1, M1, z4);
            const f32x4 T2t = XTY(N2, T1t, T1t);
            const f32x4 N4 = XTY(M2, N2, z4), M4 = XTY(N2, M2, z4);
            const f32x4 T4t = XTY(N4, T2t, T2t);
            const f32x4 N8 = XTY(M4, N4, z4);
            const f32x4 T8t = XTY(N8, T4t, T4t);
            const f32x4 G1t = XTY(CKm, T8t, z4);
#undef XTY
            u32x2 tw; tw.x = hw_pk2(T8t[0], T8t[1]); tw.y = hw_pk2(T8t[2], T8t[3]); *(LAS u32x2*)(TTB + fr * 16 + 4 * g) = tw;
            tw.x = hw_pk2(G1t[0], G1t[1]); tw.y = hw_pk2(G1t[2], G1t[3]); *(LAS u32x2*)(G1B + fr * 16 + 4 * g) = tw;
        }
        if (c + 1 < c_end) { RM_XFORM((c + 1) & 1); }
        if (c + 2 < c_end) RM_LOAD(c + 2);
        LBAR();
        const LAS float* VVc = Lf + O_VV + ((c & 1) * 2 + hh) * 1024;
        u32x2 vlo; { vlo.x = hw_pk2(VVc[(4 * g + 0) * 64 + c0 + fr], VVc[(4 * g + 1) * 64 + c0 + fr]); vlo.y = hw_pk2(VVc[(4 * g + 2) * 64 + c0 + fr], VVc[(4 * g + 3) * 64 + c0 + fr]); }
        const bf16x8 vb = mk_frag(vlo, zz);
        f32x4 accU = {0.f, 0.f, 0.f, 0.f};
        {
            accU = __builtin_amdgcn_mfma_f32_16x16x32_bf16(mk_frag(*(const LAS u32x2*)(G1B + fr * 16 + 4 * g), zz), vb, accU, 0, 0, 0);
            u32x2 clo; clo.x = hw_pk2(IM[I_CF + (4 * g + 0) * 64 + c0 + fr], IM[I_CF + (4 * g + 1) * 64 + c0 + fr]); clo.y = hw_pk2(IM[I_CF + (4 * g + 2) * 64 + c0 + fr], IM[I_CF + (4 * g + 3) * 64 + c0 + fr]);
            f32x4 accw = {0.f, 0.f, 0.f, 0.f};
            accw = __builtin_amdgcn_mfma_f32_16x16x32_bf16(mk_frag(*(const LAS u32x2*)(TTB + fr * 16 + 4 * g), zz), mk_frag(clo, zz), accw, 0, 0, 0);
#pragma unroll
            for (int r = 0; r < 4; ++r) WCB[(4 * g + r) * RS + c0 + fr] = hw_bf(accw[r]);
        }
        LBAR();
        if (role == 0) {
            RM_STATE_PART(vb);
            LBAR();
            RM_FLUSH(c, rg_cur, *(const LAS f32x4*)(Lf + O_VV + ((c & 1) * 2 + hx) * 1024 + tl * 64 + d4), Lf[O_BS + ((c & 1) * 2 + hx) * 16 + tl]);
        } else {
            float* rec = STASH + (size_t)(c - c_begin) * REC;
            for (int i = tid; i < 1376; i += NTHREADS) { const int hd = i >= 688, j = i - hd * 688; const int o = O_IMG + hd * IMGSZ + (j < 144 ? I_RT + 4 * j : I_BTT + 4 * (j - 144)); *(GAS f32x4*)(rec + 4 * i) = *(const LAS f32x4*)(Lf + o); }
            { GAS unsigned* ru = (GAS unsigned*)(rec + 5504); ru[(w * 2 + 0) * 64 + lane] = hw_pk2(accU[0], accU[1]); ru[(w * 2 + 1) * 64 + lane] = hw_pk2(accU[2], accU[3]); }
            { const f32x4 v4 = *(const LAS f32x4*)(Lf + O_VV + ((c & 1) * 2 + hx) * 1024 + tl * 64 + d4); u32x2 o; o.x = hw_pk2(v4[0], v4[1]); o.y = hw_pk2(v4[2], v4[3]); *(GAS u32x2*)(rec + 6528 + 2 * tid) = o; }
            if (tid < 32) rec[7552 + tid] = Lf[O_BS + (c & 1) * 32 + tid];
            LBAR();
        }
        rg_cur = rg_nxt; rg_nxt = rg_far;
    }
    if (role == 0) {
#pragma unroll
        for (int i = 0; i < 4; ++i)
#pragma unroll
            for (int r = 0; r < 4; ++r) STATE[((w * 4 + i) * 4 + r) * 64 + lane] = Macc[i][r];
        asm volatile("s_waitcnt vmcnt(0)" ::: "memory");
        __syncthreads();
        if (tid == 0) { __builtin_amdgcn_fence(__ATOMIC_RELEASE, "agent"); asm volatile("s_waitcnt vmcnt(0)" ::: "memory"); __hip_atomic_store(flag, 1u, __ATOMIC_RELAXED, __HIP_MEMORY_SCOPE_AGENT); }
    } else {
        if (tid == 0) { unsigned sp = 0; while (__hip_atomic_load(flag, __ATOMIC_RELAXED, __HIP_MEMORY_SCOPE_AGENT) == 0u) { __builtin_amdgcn_s_sleep(8); if (++sp > (1u << 22)) break; }
            __builtin_amdgcn_fence(__ATOMIC_ACQUIRE, "agent"); asm volatile("s_waitcnt vmcnt(0)" ::: "memory"); }
        __syncthreads();
#pragma unroll
        for (int i = 0; i < 4; ++i)
#pragma unroll
            for (int r = 0; r < 4; ++r) Macc[i][r] = STATE[((w * 4 + i) * 4 + r) * 64 + lane];
        f32x4 pi0, pi1, pi2; unsigned pu0, pu1; u32x2 pv, pgate; float pbs;
#define RM_REC_LOAD(cc) do { const float* rec = STASH + (size_t)((cc) - c_begin) * REC; pi0 = *(const GAS f32x4*)(rec + 4 * tid); pi1 = *(const GAS f32x4*)(rec + 4 * (tid + 512)); \
            pi2 = (tid < 352) ? *(const GAS f32x4*)(rec + 4 * (tid + 1024)) : (f32x4){0.f, 0.f, 0.f, 0.f}; \
            const GAS unsigned* ru = (const GAS unsigned*)(rec + 5504); pu0 = ru[(w * 2 + 0) * 64 + lane]; pu1 = ru[(w * 2 + 1) * 64 + lane]; pv = *(const GAS u32x2*)(rec + 6528 + 2 * tid); pbs = rec[7552 + hx * 16 + tl]; \
            pgate = *(const GAS u32x2*)(LO + (size_t)((cc) * TC + tl) * LORA_N + col4 + 2048); } while (0)
#define RM_IMG_OFF(i_) (O_IMG + ((i_) >= 688) * IMGSZ + ((((i_) - ((i_) >= 688) * 688) < 144) ? I_RT + 4 * ((i_) - ((i_) >= 688) * 688) : I_BTT + 4 * (((i_) - ((i_) >= 688) * 688) - 144)))
        RM_REC_LOAD(c_begin);
        for (int c = c_begin; c < c_end; ++c) {
            *(LAS f32x4*)(Lf + RM_IMG_OFF(tid)) = pi0; *(LAS f32x4*)(Lf + RM_IMG_OFF(tid + 512)) = pi1; if (tid < 352) *(LAS f32x4*)(Lf + RM_IMG_OFF(tid + 1024)) = pi2;
            const f32x4 vcur = {bf_lo(pv.x), bf_hi(pv.x), bf_lo(pv.y), bf_hi(pv.y)}; *(LAS f32x4*)(Lf + O_VV + hx * 1024 + tl * 64 + d4) = vcur;
            const f32x4 accU = {bf_lo(pu0), bf_hi(pu0), bf_lo(pu1), bf_hi(pu1)}; const float bscur = pbs; const u32x2 gcur = pgate;
            if (c + 1 < c_end) RM_REC_LOAD(c + 1);
            LBAR();
            const LAS float* VVc = Lf + O_VV + hh * 1024;
            u32x2 vlo; { vlo.x = hw_pk2(VVc[(4 * g + 0) * 64 + c0 + fr], VVc[(4 * g + 1) * 64 + c0 + fr]); vlo.y = hw_pk2(VVc[(4 * g + 2) * 64 + c0 + fr], VVc[(4 * g + 3) * 64 + c0 + fr]); }
            const bf16x8 vb = mk_frag(vlo, zz);
            RM_STATE_PART(vb);
            LBAR();
            RM_FLUSH(c, gcur, vcur, bscur);
            LBAR();
        }
#undef RM_REC_LOAD
#undef RM_IMG_OFF
    }
#undef RM_STATE_PART
#undef RM_FLUSH
#undef RM_LOAD
#undef RM_XFORM
}

__device__ __forceinline__ int med3i(int a, int b, int c) { int r; asm("v_med3_i32 %0, %1, %2, %3" : "=v"(r) : "v"(a), "v"(b), "v"(c)); return r; }
__device__ __forceinline__ int f2sort(float f) { int x = __float_as_int(f); return x ^ ((x >> 31) & 0x7fffffff); }
__device__ __forceinline__ float sort2f(int x) { return __int_as_float(x ^ ((x >> 31) & 0x7fffffff)); }
#define TOPK_INSERT(vals, x) do { _Pragma("unroll") for (int s_ = 15; s_ >= 1; --s_) vals[s_] = med3i((x), vals[s_ - 1], vals[s_]); vals[0] = max(vals[0], (x)); } while (0)
__device__ __forceinline__ float bf_dot2(unsigned a, unsigned b, float c) {
    return c + bf_lo(a) * bf_lo(b) + bf_hi(a) * bf_hi(b);
}
__device__ __forceinline__ void sum8_x8(float (&a)[8]) {
    asm("s_nop 1\n\t"
        "v_add_f32_dpp %0, %0, %0 quad_perm:[1,0,3,2] row_mask:0xf bank_mask:0xf\n\tv_add_f32_dpp %1, %1, %1 quad_perm:[1,0,3,2] row_mask:0xf bank_mask:0xf\n\t"
        "v_add_f32_dpp %2, %2, %2 quad_perm:[1,0,3,2] row_mask:0xf bank_mask:0xf\n\tv_add_f32_dpp %3, %3, %3 quad_perm:[1,0,3,2] row_mask:0xf bank_mask:0xf\n\t"
        "v_add_f32_dpp %4, %4, %4 quad_perm:[1,0,3,2] row_mask:0xf bank_mask:0xf\n\tv_add_f32_dpp %5, %5, %5 quad_perm:[1,0,3,2] row_mask:0xf bank_mask:0xf\n\t"
        "v_add_f32_dpp %6, %6, %6 quad_perm:[1,0,3,2] row_mask:0xf bank_mask:0xf\n\tv_add_f32_dpp %7, %7, %7 quad_perm:[1,0,3,2] row_mask:0xf bank_mask:0xf\n\t"
        "v_add_f32_dpp %0, %0, %0 quad_perm:[2,3,0,1] row_mask:0xf bank_mask:0xf\n\tv_add_f32_dpp %1, %1, %1 quad_perm:[2,3,0,1] row_mask:0xf bank_mask:0xf\n\t"
        "v_add_f32_dpp %2, %2, %2 quad_perm:[2,3,0,1] row_mask:0xf bank_mask:0xf\n\tv_add_f32_dpp %3, %3, %3 quad_perm:[2,3,0,1] row_mask:0xf bank_mask:0xf\n\t"
        "v_add_f32_dpp %4, %4, %4 quad_perm:[2,3,0,1] row_mask:0xf bank_mask:0xf\n\tv_add_f32_dpp %5, %5, %5 quad_perm:[2,3,0,1] row_mask:0xf bank_mask:0xf\n\t"
        "v_add_f32_dpp %6, %6, %6 quad_perm:[2,3,0,1] row_mask:0xf bank_mask:0xf\n\tv_add_f32_dpp %7, %7, %7 quad_perm:[2,3,0,1] row_mask:0xf bank_mask:0xf\n\t"
        "v_add_f32_dpp %0, %0, %0 row_half_mirror row_mask:0xf bank_mask:0xf\n\tv_add_f32_dpp %1, %1, %1 row_half_mirror row_mask:0xf bank_mask:0xf\n\t"
        "v_add_f32_dpp %2, %2, %2 row_half_mirror row_mask:0xf bank_mask:0xf\n\tv_add_f32_dpp %3, %3, %3 row_half_mirror row_mask:0xf bank_mask:0xf\n\t"
        "v_add_f32_dpp %4, %4, %4 row_half_mirror row_mask:0xf bank_mask:0xf\n\tv_add_f32_dpp %5, %5, %5 row_half_mirror row_mask:0xf bank_mask:0xf\n\t"
        "v_add_f32_dpp %6, %6, %6 row_half_mirror row_mask:0xf bank_mask:0xf\n\tv_add_f32_dpp %7, %7, %7 row_half_mirror row_mask:0xf bank_mask:0xf\n\t"
        "s_nop 1"
        : "+v"(a[0]), "+v"(a[1]), "+v"(a[2]), "+v"(a[3]), "+v"(a[4]), "+v"(a[5]), "+v"(a[6]), "+v"(a[7]));
}
__device__ __forceinline__ void sum8i_x8(int (&a)[8]) {
    asm("s_nop 1\n\t"
        "v_add_u32_dpp %0, %0, %0 quad_perm:[1,0,3,2] row_mask:0xf bank_mask:0xf\n\tv_add_u32_dpp %1, %1, %1 quad_perm:[1,0,3,2] row_mask:0xf bank_mask:0xf\n\t"
        "v_add_u32_dpp %2, %2, %2 quad_perm:[1,0,3,2] row_mask:0xf bank_mask:0xf\n\tv_add_u32_dpp %3, %3, %3 quad_perm:[1,0,3,2] row_mask:0xf bank_mask:0xf\n\t"
        "v_add_u32_dpp %4, %4, %4 quad_perm:[1,0,3,2] row_mask:0xf bank_mask:0xf\n\tv_add_u32_dpp %5, %5, %5 quad_perm:[1,0,3,2] row_mask:0xf bank_mask:0xf\n\t"
        "v_add_u32_dpp %6, %6, %6 quad_perm:[1,0,3,2] row_mask:0xf bank_mask:0xf\n\tv_add_u32_dpp %7, %7, %7 quad_perm:[1,0,3,2] row_mask:0xf bank_mask:0xf\n\t"
        "v_add_u32_dpp %0, %0, %0 quad_perm:[2,3,0,1] row_mask:0xf bank_mask:0xf\n\tv_add_u32_dpp %1, %1, %1 quad_perm:[2,3,0,1] row_mask:0xf bank_mask:0xf\n\t"
        "v_add_u32_dpp %2, %2, %2 quad_perm:[2,3,0,1] row_mask:0xf bank_mask:0xf\n\tv_add_u32_dpp %3, %3, %3 quad_perm:[2,3,0,1] row_mask:0xf bank_mask:0xf\n\t"
        "v_add_u32_dpp %4, %4, %4 quad_perm:[2,3,0,1] row_mask:0xf bank_mask:0xf\n\tv_add_u32_dpp %5, %5, %5 quad_perm:[2,3,0,1] row_mask:0xf bank_mask:0xf\n\t"
        "v_add_u32_dpp %6, %6, %6 quad_perm:[2,3,0,1] row_mask:0xf bank_mask:0xf\n\tv_add_u32_dpp %7, %7, %7 quad_perm:[2,3,0,1] row_mask:0xf bank_mask:0xf\n\t"
        "v_add_u32_dpp %0, %0, %0 row_half_mirror row_mask:0xf bank_mask:0xf\n\tv_add_u32_dpp %1, %1, %1 row_half_mirror row_mask:0xf bank_mask:0xf\n\t"
        "v_add_u32_dpp %2, %2, %2 row_half_mirror row_mask:0xf bank_mask:0xf\n\tv_add_u32_dpp %3, %3, %3 row_half_mirror row_mask:0xf bank_mask:0xf\n\t"
        "v_add_u32_dpp %4, %4, %4 row_half_mirror row_mask:0xf bank_mask:0xf\n\tv_add_u32_dpp %5, %5, %5 row_half_mirror row_mask:0xf bank_mask:0xf\n\t"
        "v_add_u32_dpp %6, %6, %6 row_half_mirror row_mask:0xf bank_mask:0xf\n\tv_add_u32_dpp %7, %7, %7 row_half_mirror row_mask:0xf bank_mask:0xf\n\t"
        "s_nop 1"
        : "+v"(a[0]), "+v"(a[1]), "+v"(a[2]), "+v"(a[3]), "+v"(a[4]), "+v"(a[5]), "+v"(a[6]), "+v"(a[7]));
}
__device__ __forceinline__ float max8_x1(float v) {
    asm("s_nop 1\n\tv_max_f32_dpp %0, %0, %0 quad_perm:[1,0,3,2] row_mask:0xf bank_mask:0xf\n\ts_nop 1\n\tv_max_f32_dpp %0, %0, %0 quad_perm:[2,3,0,1] row_mask:0xf bank_mask:0xf\n\ts_nop 1\n\t"
        "v_max_f32_dpp %0, %0, %0 row_half_mirror row_mask:0xf bank_mask:0xf\n\ts_nop 1" : "+v"(v));
    return v;
}
__device__ __forceinline__ float sum8_x1(float v) {
    asm("s_nop 1\n\tv_add_f32_dpp %0, %0, %0 quad_perm:[1,0,3,2] row_mask:0xf bank_mask:0xf\n\ts_nop 1\n\tv_add_f32_dpp %0, %0, %0 quad_perm:[2,3,0,1] row_mask:0xf bank_mask:0xf\n\ts_nop 1\n\t"
        "v_add_f32_dpp %0, %0, %0 row_half_mirror row_mask:0xf bank_mask:0xf\n\ts_nop 1" : "+v"(v));
    return v;
}
__device__ __forceinline__ void peer_phase(const Args& A, Frame& F, int L, const bool dry, const bf16* Hin, bf16* Hout, unsigned char* H8) {
    int lane = F.lane; asm volatile("" : "+v"(lane));
    const int gw = F.vcu * NWAVES + F.wave;
    const bf16* SCR = (const bf16*)(A.ws + WS_SC); const bf16* X = Hin; float* RS3 = (float*)(A.ws + WS_RS3);
    const unsigned char* TU = (const unsigned char*)(A.ws + WS_TABU) + (size_t)L * 16384 * D; const unsigned char* TV = (const unsigned char*)(A.ws + WS_TABV) + (size_t)L * 16384 * D;
    const float* SUL = (const float*)(A.ws + WS_SU) + (size_t)L * 16384; const float* SVL = SUL + 32768;
    const float* rowss = (const float*)(A.ws + WS_RSP) + (size_t)(L == 0 ? RS_FFN0 : RS_FFN1) * T * 32;
    LAS unsigned* LIST = (LAS unsigned*)(F.lds + RING_OFF + F.wave * 16384);
    LAS unsigned* EIDX = LIST + 1024;
    LAS float* ECOEF = (LAS float*)(EIDX + 1024);
    const int tbase = gw * 8;
    if (tbase >= T) return;
    for (int half = 0; half < 2; ++half) {
        const int t0 = tbase + 4 * half;
        {
            const bf16* sp = SCR + (size_t)(t0 + (lane >> 4)) * D + (lane & 15) * 128;
            int vals[16];
#pragma unroll
            for (int s = 0; s < 16; ++s) vals[s] = (int)0x80000000;
#pragma unroll 2
            for (int c = 0; c < 16; ++c) { const v4u wv = *(const GAS v4u*)(sp + c * 8); const unsigned ww[4] = {wv.x, wv.y, wv.z, wv.w};
#pragma unroll
                for (int e = 0; e < 8; ++e) { const unsigned bits = (e & 1) ? (ww[e >> 1] & 0xffff0000u) : (ww[e >> 1] << 16);
                    int x = (int)bits; x ^= (x >> 31) & 0x7fffffff; x = (x & ~0x7f) | (127 - (c * 8 + e));
                    TOPK_INSERT(vals, x); } }
#pragma unroll
            for (int q = 0; q < 4; ++q) { v4u o; o.x = (unsigned)vals[4 * q]; o.y = (unsigned)vals[4 * q + 1]; o.z = (unsigned)vals[4 * q + 2]; o.w = (unsigned)vals[4 * q + 3]; *(LAS v4u*)(LIST + lane * 16 + 4 * q) = o; }
        }
        LDS_WAIT(); asm volatile("" ::: "memory");
        if (lane < 32) {
            const LAS unsigned* la = LIST + ((lane >> 3) * 16 + (lane & 7) * 2) * 16; const LAS unsigned* lb2 = la + 16;
            float av[16], bv[16];
#pragma unroll
            for (int q = 0; q < 4; ++q) { const v4u a4 = *(const LAS v4u*)(la + 4 * q), b4 = *(const LAS v4u*)(lb2 + 4 * q); const unsigned aw[4] = {a4.x, a4.y, a4.z, a4.w}, bw[4] = {b4.x, b4.y, b4.z, b4.w};
#pragma unroll
                for (int e = 0; e < 4; ++e) { av[4 * q + e] = __uint_as_float(__float_as_uint(sort2f((int)(aw[e] & ~0x7fu))) & 0xffff0000u); bv[4 * q + e] = __uint_as_float(__float_as_uint(sort2f((int)(bw[e] & ~0x7fu))) & 0xffff0000u); } }
            int best[16];
#pragma unroll
            for (int s = 0; s < 16; ++s) best[s] = (int)0x80000000;
#pragma unroll
            for (int i = 0; i < 16; ++i)
#pragma unroll
                for (int jx = 0; jx < 16; ++jx) if ((i + 1) * (jx + 1) <= 16) { int x = f2sort(av[i] + bv[jx]); x = (x & ~0xff) | (255 - (i * 16 + jx)); TOPK_INSERT(best, x); }
            float sv[16]; unsigned ex[16];
#pragma unroll
            for (int s = 0; s < 16; ++s) { const int cand = 255 - (best[s] & 0xff); const unsigned ka = la[cand >> 4], kb = lb2[cand & 15];
                ex[s] = (127u - (ka & 0x7fu)) * 128u + (127u - (kb & 0x7fu));
                sv[s] = __uint_as_float(__float_as_uint(sort2f((int)(ka & ~0x7fu))) & 0xffff0000u) + __uint_as_float(__float_as_uint(sort2f((int)(kb & ~0x7fu))) & 0xffff0000u); }
            float mx = sv[0];
#pragma unroll
            for (int s = 1; s < 16; ++s) mx = fmaxf(mx, sv[s]);
            float den = 0.f;
#pragma unroll
            for (int s = 0; s < 16; ++s) { sv[s] = __expf(sv[s] - mx); den += sv[s]; }
            const float inv = 1.0f / den; const int base = (4 * half + (lane >> 3)) * 128 + (lane & 7) * 16;
#pragma unroll
            for (int s = 0; s < 16; ++s) { EIDX[base + s] = ex[s]; ECOEF[base + s] = sv[s] * inv; }
        }
        LDS_WAIT(); asm volatile("" ::: "memory");
    }
    const int tk = lane >> 3, part = lane & 7, t = tbase + tk;
    const LAS unsigned* eidx = EIDX + tk * 128; LAS float* ecoef = ECOEF + tk * 128;
    const float rs = __builtin_amdgcn_rsqf(sum8_x1(((const GAS f32x4*)(rowss + (size_t)t * 32))[part][0] + ((const GAS f32x4*)(rowss + (size_t)t * 32))[part][1] + ((const GAS f32x4*)(rowss + (size_t)t * 32))[part][2] + ((const GAS f32x4*)(rowss + (size_t)t * 32))[part][3]) * (1.0f / D) + EPS);
    typedef _Float16 h2_t __attribute__((ext_vector_type(2)));
#if PEER_ALIAS
    const unsigned amask = dry ? 1023u : 0xffffffffu;
#else
    constexpr unsigned amask = 0xffffffffu;
#endif
#define PEER_LOAD8(dst, TAB, i0, soff) do { const v4u ia_ = *(const LAS v4u*)(eidx + (i0)), ib_ = *(const LAS v4u*)(eidx + (i0) + 4); const unsigned ee_[8] = {ia_.x, ia_.y, ia_.z, ia_.w, ib_.x, ib_.y, ib_.z, ib_.w}; \
        _Pragma("unroll") for (int j_ = 0; j_ < 8; ++j_) dst[j_] = *(const GAS v4u*)((TAB) + (size_t)((ee_[j_] & amask) * 2048u + (unsigned)(soff))); } while (0)
    LAS float* dotw = (LAS float*)LIST + tk * 128;
#pragma unroll
    for (int m = 0; m < 16; ++m) dotw[8 * m + part] = 0.f;
#pragma unroll 1
    for (int p = 0; p < 16; ++p) {
        const int soff = 128 * p + 16 * part;
        unsigned xq[4]; float sxs;
        { const v4u x0 = *(const GAS v4u*)(X + (size_t)t * D + soff), x1 = *(const GAS v4u*)(X + (size_t)t * D + soff + 8); const unsigned xw[8] = {x0.x, x0.y, x0.z, x0.w, x1.x, x1.y, x1.z, x1.w};
          float xv[16], am = 0.f;
#pragma unroll
          for (int e = 0; e < 8; ++e) { xv[2 * e] = bf_lo(xw[e]); xv[2 * e + 1] = bf_hi(xw[e]); am = fmaxf(am, fmaxf(fabsf(xv[2 * e]), fabsf(xv[2 * e + 1]))); }
          am = max8_x1(am); sxs = am * (1.0f / 127.0f); const float inv = am > 0.f ? 127.0f / am : 0.f;
#pragma unroll
          for (int q = 0; q < 4; ++q) { unsigned w = 0;
#pragma unroll
              for (int e = 0; e < 4; ++e) w |= (__float_as_uint(__builtin_fmaf(xv[4 * q + e], inv, 12582912.0f)) & 255u) << (8 * e);
              xq[q] = w; } }
#define PEER_UDOT8(src, m_) do { int tt_[8]; \
        _Pragma("unroll") for (int j_ = 0; j_ < 8; ++j_) { int a_ = __builtin_amdgcn_sdot4((int)src[j_].x, (int)xq[0], 0, false); a_ = __builtin_amdgcn_sdot4((int)src[j_].y, (int)xq[1], a_, false); \
            a_ = __builtin_amdgcn_sdot4((int)src[j_].z, (int)xq[2], a_, false); tt_[j_] = __builtin_amdgcn_sdot4((int)src[j_].w, (int)xq[3], a_, false); } \
        sum8i_x8(tt_); \
        int sel_ = tt_[0]; _Pragma("unroll") for (int j_ = 1; j_ < 8; ++j_) sel_ = (part == j_) ? tt_[j_] : sel_; \
        dotw[8 * (m_) + part] += (float)sel_ * sxs; } while (0)
        v4u ua[8], ub[8];
        PEER_LOAD8(ua, TU, 0, soff);
#pragma unroll 1
        for (int m = 0; m < 16; m += 2) {
            PEER_LOAD8(ub, TU, 8 * (m + 1), soff);
            PEER_UDOT8(ua, m);
            if (m + 2 < 16) PEER_LOAD8(ua, TU, 8 * (m + 2), soff);
            PEER_UDOT8(ub, m + 1);
        }
    }
#undef PEER_UDOT8
    LAS unsigned char* ecq = (LAS unsigned char*)(LIST + 3072) + tk * 128;
    float sc;
    { float cf[16], cm = 0.f;
#pragma unroll
      for (int m = 0; m < 16; ++m) { const unsigned e_ = eidx[8 * m + part]; const float d_ = dotw[8 * m + part] * rs * SUL[e_]; const float act = 0.5f * d_ * (1.0f + erff(d_ * 0.7071067811865476f));
          cf[m] = ecoef[8 * m + part] * act * SVL[e_]; cm = fmaxf(cm, fabsf(cf[m])); }
      cm = max8_x1(cm); sc = cm * (1.0f / 127.0f); const float inv = cm > 0.f ? 127.0f / cm : 0.f;
#pragma unroll
      for (int m = 0; m < 16; ++m) ecq[8 * m + part] = (unsigned char)(__float_as_uint(__builtin_fmaf(cf[m], inv, 12582912.0f)) & 255u); }
    LDS_WAIT(); asm volatile("" ::: "memory");
    float ss = 0.f;
#pragma unroll 1
    for (int p = 0; p < 16; ++p) {
        const int soff = 128 * p + 16 * part;
        int acc[16];
#pragma unroll
        for (int i = 0; i < 16; ++i) acc[i] = 0;
#define PEER_VACC8(src, i0) do { const u32x2 c8_ = *(const LAS u32x2*)(ecq + (i0)); \
        _Pragma("unroll") for (int h_ = 0; h_ < 2; ++h_) { const int cq_ = (int)(h_ ? c8_.y : c8_.x); \
            _Pragma("unroll") for (int q_ = 0; q_ < 4; ++q_) { \
                const unsigned a_ = q_ == 0 ? src[4 * h_].x : q_ == 1 ? src[4 * h_].y : q_ == 2 ? src[4 * h_].z : src[4 * h_].w, b_ = q_ == 0 ? src[4 * h_ + 1].x : q_ == 1 ? src[4 * h_ + 1].y : q_ == 2 ? src[4 * h_ + 1].z : src[4 * h_ + 1].w; \
                const unsigned c_ = q_ == 0 ? src[4 * h_ + 2].x : q_ == 1 ? src[4 * h_ + 2].y : q_ == 2 ? src[4 * h_ + 2].z : src[4 * h_ + 2].w, d_ = q_ == 0 ? src[4 * h_ + 3].x : q_ == 1 ? src[4 * h_ + 3].y : q_ == 2 ? src[4 * h_ + 3].z : src[4 * h_ + 3].w; \
                const unsigned lab_ = __builtin_amdgcn_perm(b_, a_, 0x05010400u), hab_ = __builtin_amdgcn_perm(b_, a_, 0x07030602u), lcd_ = __builtin_amdgcn_perm(d_, c_, 0x05010400u), hcd_ = __builtin_amdgcn_perm(d_, c_, 0x07030602u); \
                acc[4 * q_ + 0] = __builtin_amdgcn_sdot4((int)__builtin_amdgcn_perm(lcd_, lab_, 0x05040100u), cq_, acc[4 * q_ + 0], false); \
                acc[4 * q_ + 1] = __builtin_amdgcn_sdot4((int)__builtin_amdgcn_perm(lcd_, lab_, 0x07060302u), cq_, acc[4 * q_ + 1], false); \
                acc[4 * q_ + 2] = __builtin_amdgcn_sdot4((int)__builtin_amdgcn_perm(hcd_, hab_, 0x05040100u), cq_, acc[4 * q_ + 2], false); \
                acc[4 * q_ + 3] = __builtin_amdgcn_sdot4((int)__builtin_amdgcn_perm(hcd_, hab_, 0x07060302u), cq_, acc[4 * q_ + 3], false); } } } while (0)
        v4u va[8], vb[8];
        PEER_LOAD8(va, TV, 0, soff);
#pragma unroll 1
        for (int m = 0; m < 16; m += 2) {
            PEER_LOAD8(vb, TV, 8 * (m + 1), soff);
            PEER_VACC8(va, 8 * m);
            if (m + 2 < 16) PEER_LOAD8(va, TV, 8 * (m + 2), soff);
            PEER_VACC8(vb, 8 * (m + 1));
        }
        { const v4u h0 = *(const GAS v4u*)(Hin + (size_t)t * D + soff), h1 = *(const GAS v4u*)(Hin + (size_t)t * D + soff + 8); const unsigned hw[8] = {h0.x, h0.y, h0.z, h0.w, h1.x, h1.y, h1.z, h1.w}; unsigned ow[8];
#pragma unroll
          for (int e = 0; e < 8; ++e) { ow[e] = hw_pk2(bf_lo(hw[e]) + (float)acc[2 * e] * sc, bf_hi(hw[e]) + (float)acc[2 * e + 1] * sc); const float q0 = bf_lo(ow[e]), q1 = bf_hi(ow[e]); ss += q0 * q0 + q1 * q1; }
          v4u o0, o1; o0.x = ow[0]; o0.y = ow[1]; o0.z = ow[2]; o0.w = ow[3]; o1.x = ow[4]; o1.y = ow[5]; o1.z = ow[6]; o1.w = ow[7];
          if (!dry) { *(GAS v4u*)(Hout + (size_t)t * D + soff) = o0; *(GAS v4u*)(Hout + (size_t)t * D + soff + 8) = o1;
            if (H8) { v4u o8; unsigned q8[4];
#pragma unroll
              for (int e = 0; e < 4; ++e) { int x8 = __builtin_amdgcn_cvt_pk_fp8_f32(bf_lo(ow[2 * e]), bf_hi(ow[2 * e]), 0, false); x8 = __builtin_amdgcn_cvt_pk_fp8_f32(bf_lo(ow[2 * e + 1]), bf_hi(ow[2 * e + 1]), x8, true); q8[e] = (unsigned)x8; }
              o8.x = q8[0]; o8.y = q8[1]; o8.z = q8[2]; o8.w = q8[3]; *(GAS v4u*)(H8 + (size_t)t * D + soff) = o8; } } else asm volatile("" :: "v"(o0.x), "v"(o0.y), "v"(o0.z), "v"(o0.w), "v"(o1.x), "v"(o1.y), "v"(o1.z), "v"(o1.w)); }
    }
#undef PEER_VACC8
#undef PEER_LOAD8
    const float r3 = __builtin_amdgcn_rsqf(sum8_x1(ss) * (1.0f / D) + EPS);
    if (!dry && part == 0) RS3[t] = r3;
}


constexpr int N_PHASES = 19;
__global__ void __launch_bounds__(NTHREADS, 2) mega_fwd(Args args) {

    extern __shared__ __attribute__((aligned(16))) unsigned char lds[];
    Frame F;
    F.lds = (LAS unsigned char*)lds;
    F.MISC = (volatile LAS unsigned*)(F.lds + MISC_OFF);
    F.tid = threadIdx.x; F.lane = F.tid & 63; F.wave = __builtin_amdgcn_readfirstlane(F.tid >> 6);
    F.G = gridDim.x; { const int bx = blockIdx.x; F.vcu = (F.G % 8 == 0) ? (bx % 8) * (F.G / 8) + bx / 8 : bx; }
    unsigned char* ws = args.ws;
    F.ctl = (gu32*)(ws + WS_CTL);
    for (int u = F.tid; u < (LDS_BYTES - LDSCTL_OFF) / 4; u += NTHREADS) ((LAS unsigned*)(F.lds + LDSCTL_OFF))[u] = 0u;
    __syncthreads();
    const int lo = args.ph_lo, hi = args.ph_hi;
    XcdBarrier bar; bar.bar = (unsigned*)(F.ctl + CW_BAR); bar.x = 0; bar.st = nullptr;
    if (hi - lo > 1) bar = xcd_barrier_post((unsigned*)(F.ctl + CW_BAR), F.MISC + 8);
    bar.wave0 = (F.wave == 0);
#define IN(k) (lo <= (k) && (k) < hi)
#define REFRESH() do { int t_; asm volatile("v_mbcnt_lo_u32_b32 %0, -1, 0\n\tv_mbcnt_hi_u32_b32 %0, -1, %0" : "=v"(t_)); F.lane = t_; F.tid = F.wave * 64 + t_; } while (0)
#define REPS(k) (1 + ((DUP_MASK >> (k)) & 1))
#if PROBE_MASK
    unsigned long long* const tsb = (unsigned long long*)(ws + WS_CTL + 65536);
#define STAMP(k) do { if (blockIdx.x == 0 && F.tid == 0) __hip_atomic_store(tsb + (k), __builtin_amdgcn_s_memrealtime(), __ATOMIC_RELAXED, __HIP_MEMORY_SCOPE_AGENT); } while (0)
    STAMP(31);
#else
#define STAMP(k) do { } while (0)
#endif
#define DEFERRED_QUEUE(fn, ctrword) do { constexpr unsigned NQ_ = 768u; for (;;) { if (F.tid == 0) F.MISC[0] = __hip_atomic_fetch_add(F.ctl + (ctrword), 1u, __ATOMIC_RELAXED, __HIP_MEMORY_SCOPE_AGENT); \
        __syncthreads(); const unsigned v_ = F.MISC[0]; __syncthreads(); if (v_ >= NQ_) break; fn(args, F, (int)v_, (int)NQ_); } } while (0)
#define SEAM(k) do { if (IN(k) && IN((k) + 1)) { if ((k) == 0) { cg::this_grid().sync(); } else { xcd_barrier(bar); if ((DUP_MASK >> 24) & 1) xcd_barrier(bar); } STAMP(k); } } while (0)
    float* rowss = (float*)(ws + WS_RSP);
    bf16* ACTA = (bf16*)(ws + WS_ACTA); bf16* ACTB = (bf16*)(ws + WS_ACTB); bf16* H1 = (bf16*)(ws + WS_H1); const float* RS3 = (const float*)(ws + WS_RS3);
    bf16* PROJ = (bf16*)(ws + WS_PROJ); bf16* SCB = (bf16*)(ws + WS_SC); bf16* PP = (bf16*)(ws + WS_PP);
    const int gtid = (F.vcu * NWAVES + F.wave) * 64 + F.lane, gthreads = F.G * NTHREADS;

#if UBENCH
    {
        typedef _Float16 h2_t __attribute__((ext_vector_type(2)));
        float a[32]; f32x2 p[16]; h2_t hh[32];
#pragma unroll
        for (int i = 0; i < 32; ++i) { a[i] = (float)(F.tid + i); hh[i] = (h2_t){(_Float16)(F.lane + i), (_Float16)i}; }
#pragma unroll
        for (int i = 0; i < 16; ++i) p[i] = (f32x2){a[2 * i], a[2 * i + 1]};
        const float m = 1.0f + 1e-7f * F.lane, c = 1e-9f; const f32x2 m2 = {m, m}, c2 = {c, c}; const h2_t mh = {(_Float16)1.0f, (_Float16)1.0f}, ch = {(_Float16)0.0f, (_Float16)0.0f};
#pragma unroll 1
        for (int it = 0; it < 10000; ++it) {
#if UBENCH == 1
#pragma unroll
            for (int i = 0; i < 32; ++i) asm volatile("v_fma_f32 %0, %0, %1, %2" : "+v"(a[i]) : "v"(m), "v"(c));
#elif UBENCH == 2
#pragma unroll
            for (int i = 0; i < 16; ++i) asm volatile("v_pk_fma_f32 %0, %0, %1, %2\n\tv_pk_fma_f32 %0, %0, %1, %2" : "+v"(p[i]) : "v"(m2), "v"(c2));
#elif UBENCH == 3
#pragma unroll
            for (int i = 0; i < 32; ++i) asm volatile("v_pk_fma_f16 %0, %0, %1, %2" : "+v"(hh[i]) : "v"(mh), "v"(ch));
#endif
        }
        float s = 0.f;
#pragma unroll
        for (int i = 0; i < 32; ++i) s += a[i] + (float)hh[i][0];
#pragma unroll
        for (int i = 0; i < 16; ++i) s += p[i][0] + p[i][1];
        if (s == 12345.678f) args.out[0] = s;
    }
#endif
    if (IN(0)) { REFRESH(); p0_prologue(args, F, 0); if (hi - lo > 1) { xcd_barrier(bar); REFRESH(); p0_prologue(args, F, 1); } } SEAM(0);
    if (IN(1)) for (int rep_ = 0; rep_ < REPS(1); ++rep_) { REFRESH();
#if EV_F8_T1 > EV_F8_T0
        if (EV_F8_T0 > 0) { constexpr int n_ = EV_F8_T0 * 256; pg8::Gemm g{ACTA, (const bf16*)(ws + WS_WEV_IN), T, n_, D}; pg8::StaticOrder S; S.init(T, n_, F.G, (int)blockIdx.x); EpiBf16S E{PROJ, PROJ_LD, nullptr};
          pg8::gemm_phase<EpiBf16S, pg8::StaticOrder, true, true>(F.lds + RING_OFF, g, S, E, F.wave); }
        { constexpr int n_ = (EV_F8_T1 - EV_F8_T0) * 256; pg8::Gemm g{(const bf16*)(ws + WS_H1), (const bf16*)(ws + WS_O + (size_t)EV_F8_T0 * 256 * D), T, n_, D / 2}; pg8::StaticOrder S; S.init(T, n_, F.G, (int)blockIdx.x); EpiBf16S E{PROJ + EV_F8_T0 * 256, PROJ_LD, nullptr};
          pg8::gemm_phase<EpiBf16S, pg8::StaticOrder, true, true, true>(F.lds + RING_OFF, g, S, E, F.wave); }
        if (EV_F8_T1 < EV_NP / 256) { constexpr int n_ = EV_NP - EV_F8_T1 * 256; pg8::Gemm g{ACTA, (const bf16*)(ws + WS_WEV_IN) + (size_t)EV_F8_T1 * 256 * D, T, n_, D}; pg8::StaticOrder S; S.init(T, n_, F.G, (int)blockIdx.x); EpiBf16S E{PROJ + EV_F8_T1 * 256, PROJ_LD, nullptr};
          pg8::gemm_phase<EpiBf16S, pg8::StaticOrder, true, true>(F.lds + RING_OFF, g, S, E, F.wave); }
        if (true) { const int g2 = F.G, c2 = (int)blockIdx.x;
#else
        { pg8::Gemm g{ACTA, (const bf16*)(ws + WS_WEV_IN), T, EV_NP, D / 2}; pg8::StaticOrder S; S.init(T, EV_NP, F.G, (int)blockIdx.x); EpiI8S E{PROJ, PROJ_LD, (const float*)(ws + WS_SA), (const float*)(ws + WS_CMB)};
          pg8::gemm_phase<EpiI8S, pg8::StaticOrder, true, true, false, true>(F.lds + RING_OFF, g, S, E, F.wave); }
        if (F.G < 256) { const int g2 = F.G, c2 = (int)blockIdx.x;
#endif
          pg8::Gemm g{(const bf16*)(ws + WS_PBF), (const bf16*)(ws + WS_WPROJ), T, D, 256}; pg8::StaticOrder S; S.init(T, D, g2, c2); EpiBf16S E{PP, D, nullptr};
          pg8::gemm_phase<EpiBf16S, pg8::StaticOrder, true, true>(F.lds + RING_OFF, g, S, E, F.wave); }
    } SEAM(1);
    if (IN(2)) for (int rep_ = 0; rep_ < REPS(2); ++rep_) { REFRESH();
        if (F.G >= 256) {
            const int u = F.vcu;
            if (u < 64) scan_gla_mfma_unit<0>(args, F, u); else if (u < 128) scan_gdn_mfma_unit(args, F, u - 64, 0); else if (u < 192) scan_gdn_mfma_unit(args, F, u - 128, 1);
            __syncthreads();
            if (rep_ == 0 && u >= 64 && u < 128) {
                const int c = u - 64; bf16* pb = (bf16*)(ws + WS_PBF);
                cvt_f32_bf16(args.in[I_P] + (size_t)c * 65536, pb + (size_t)c * 65536, 65536, F.tid, NTHREADS);
                asm volatile("s_waitcnt vmcnt(0)" ::: "memory"); __syncthreads();
                pg8::Gemm g{pb, (const bf16*)(ws + WS_WPROJ), T, D, 256}; pg8::RowBlockOrder S{c, D / 256}; EpiBf16S E{PP, D, nullptr};
                pg8::gemm_phase<EpiBf16S, pg8::RowBlockOrder, true, true>(F.lds + RING_OFF, g, S, E, F.wave); }
            if (rep_ == 0) DEFERRED_QUEUE(p0_deferred, 1024);
        } else {
            for (int u = F.vcu; u < 64; u += F.G) { scan_gla_mfma_unit<0>(args, F, u); __syncthreads(); }
            for (int u = F.vcu; u < 64; u += F.G) { scan_gdn_mfma_unit(args, F, u, 0); __syncthreads(); scan_gdn_mfma_unit(args, F, u, 1); __syncthreads(); }
            if (rep_ == 0) p0_deferred(args, F, F.vcu, F.G);
        }
    } SEAM(2);
    if (IN(3)) for (int rep_ = 0; rep_ < REPS(3); ++rep_) { REFRESH(); post_rows<0>(args, F); } SEAM(3);
    if (IN(4)) { REFRESH(); pg8::Gemm g{ACTA, (const bf16*)(ws + WS_WEV_OUT), T, D, D}; pg8::StaticOrder S; S.init(T, D, F.G, (int)blockIdx.x);
        EpiResid<false, true> E{args.in[I_X], ACTB, rowss + (size_t)RS_FFN0 * T * 32, nullptr, nullptr, nullptr, nullptr, nullptr};
        pg8::gemm_phase<EpiResid<false, true>, pg8::StaticOrder, true, true>(F.lds + RING_OFF, g, S, E, F.wave); }
#if (DUP_MASK >> 20) & 1
    if (IN(4)) { REFRESH(); pg8::Gemm g{ACTA, (const bf16*)(ws + WS_WEV_OUT), T, D, D}; pg8::StaticOrder S; S.init(T, D, F.G, (int)blockIdx.x);
        EpiResid<false, true> E{args.in[I_X], ACTB, rowss + (size_t)RS_FFN0 * T * 32, nullptr, nullptr, nullptr};
        pg8::gemm_phase<EpiResid<false, true>, pg8::StaticOrder, true, true>(F.lds + RING_OFF, g, S, E, F.wave); }
#endif
#if (DUP_MASK >> 21) & 1
    if (IN(4)) { REFRESH(); pg8::Gemm g{ACTA, (const bf16*)(ws + WS_WEV_IN), T, EV_NP, D}; pg8::StaticOrder S; S.init(T, EV_NP, F.G, (int)blockIdx.x); EpiBf16S E{PROJ, PROJ_LD, nullptr};
        pg8::gemm_phase<EpiBf16S, pg8::StaticOrder, true, true>(F.lds + RING_OFF, g, S, E, F.wave); }
#endif
    SEAM(4);
    if (IN(5)) for (int rep_ = 0; rep_ < REPS(5); ++rep_) { REFRESH(); { pg8::Gemm g{ACTB, (const bf16*)(ws + WS_WPEER), T, D, D}; pg8::StaticOrder S; S.init(T, D, F.G, (int)blockIdx.x); EpiBf16S E{SCB, D, rowss + (size_t)RS_FFN0 * T * 32};
        pg8::gemm_phase<EpiBf16S, pg8::StaticOrder, true, true>(F.lds + RING_OFF, g, S, E, F.wave); }
        } SEAM(5);
    if (IN(6)) for (int rep_ = 0; rep_ < REPS(6); ++rep_) { REFRESH(); peer_phase(args, F, 0, rep_ != 0, ACTB, H1, (unsigned char*)ACTA); } SEAM(6);
    if (IN(7)) { REFRESH(); { pg8::Gemm g{ACTA, (const bf16*)(ws + WS_WGATE), T, D, D / 2}; pg8::StaticOrder S; S.init(T, D, F.G, (int)blockIdx.x);
        EpiResid<true, false> E{H1, ACTB, rowss + (size_t)RS_MIX1 * T * 32, PP, RS3, (unsigned char*)ACTA + (size_t)T * D};
        pg8::gemm_phase<EpiResid<true, false>, pg8::StaticOrder, true, true, true>(F.lds + RING_OFF, g, S, E, F.wave); }
        } SEAM(7);
    if (IN(8)) for (int rep_ = 0; rep_ < REPS(8); ++rep_) { REFRESH();
        { pg8::Gemm g{(const bf16*)((const unsigned char*)ACTA + (size_t)T * D), (const bf16*)(ws + WS_WOD_IN), T, OD_NP, D / 2}; pg8::StaticOrder S; S.init(T, OD_NP, F.G, (int)blockIdx.x); EpiBf16S E{PROJ, PROJ_LD, rowss + (size_t)RS_MIX1 * T * 32};
          pg8::gemm_phase<EpiBf16S, pg8::StaticOrder, true, true, true>(F.lds + RING_OFF, g, S, E, F.wave); }
        if (F.G < 256) { pg8::Gemm g{(const bf16*)(ws + WS_PBF) + (size_t)T * 256, (const bf16*)(ws + WS_WPROJ) + (size_t)D * 256, T, D, 256}; pg8::StaticOrder S; S.init(T, D, F.G, (int)blockIdx.x); EpiBf16S E{PP, D, nullptr};
          pg8::gemm_phase<EpiBf16S, pg8::StaticOrder, true, true>(F.lds + RING_OFF, g, S, E, F.wave); }
    } SEAM(8);
    if (IN(9)) for (int rep_ = 0; rep_ < REPS(9); ++rep_) { REFRESH(); lora_prep_rows(args, F); } SEAM(9);
    if (IN(10)) for (int rep_ = 0; rep_ < REPS(10); ++rep_) { REFRESH();
        { pg8::Gemm g{(const bf16*)(ws + WS_LA), (const bf16*)(ws + WS_WLORA), T, 1024, LORA_K, 128}; pg8::StaticOrder S; S.init(T, 1024, F.G, (int)blockIdx.x); EpiBf16S E{(bf16*)(ws + WS_LO), LORA_N, nullptr};
          pg8::gemm_phase<EpiBf16S, pg8::StaticOrder, true, true>(F.lds + RING_OFF, g, S, E, F.wave); }
        { pg8::Gemm g{(const bf16*)(ws + WS_LA) + 64, (const bf16*)(ws + WS_WLORA) + (size_t)1024 * LORA_K + 64, T, 1024, LORA_K, 128}; pg8::StaticOrder S; S.init(T, 1024, F.G, (int)blockIdx.x); EpiBf16S E{(bf16*)(ws + WS_LO) + 1024, LORA_N, nullptr};
          pg8::gemm_phase<EpiBf16S, pg8::StaticOrder, true, true>(F.lds + RING_OFF, g, S, E, F.wave); }
        { pg8::Gemm g{(const bf16*)(ws + WS_LA) + 192, (const bf16*)(ws + WS_WLORA) + (size_t)2048 * LORA_K + 192, T, 1024, LORA_K, 256}; pg8::StaticOrder S; S.init(T, 1024, F.G, (int)blockIdx.x); EpiBf16S E{(bf16*)(ws + WS_LO) + 2048, LORA_N, nullptr};
          pg8::gemm_phase<EpiBf16S, pg8::StaticOrder, true, true>(F.lds + RING_OFF, g, S, E, F.wave); }
    } SEAM(10);
    if (IN(11)) for (int rep_ = 0; rep_ < REPS(11); ++rep_) { REFRESH();
        if (F.G >= 256) {
            const int u = F.vcu;
            if (u < 64) scan_gla_mfma_unit<1>(args, F, u); else if (u < 128) scan_rwkv_mfma_unit(args, F, u - 64, 0); else if (u < 192) scan_rwkv_mfma_unit(args, F, u - 128, 1);
            __syncthreads();
            if (rep_ == 0 && u >= 64 && u < 128) {
                const int c = u - 64; bf16* pb = (bf16*)(ws + WS_PBF) + (size_t)T * 256;
                cvt_f32_bf16(args.in[I_P] + (size_t)T * 256 + (size_t)c * 65536, pb + (size_t)c * 65536, 65536, F.tid, NTHREADS);
                asm volatile("s_waitcnt vmcnt(0)" ::: "memory"); __syncthreads();
                pg8::Gemm g{pb, (const bf16*)(ws + WS_WPROJ) + (size_t)D * 256, T, D, 256}; pg8::RowBlockOrder S{c, D / 256}; EpiBf16S E{PP, D, nullptr};
                pg8::gemm_phase<EpiBf16S, pg8::RowBlockOrder, true, true>(F.lds + RING_OFF, g, S, E, F.wave); }
            if (rep_ == 0) DEFERRED_QUEUE(p1_deferred, 1025);
        } else {
            for (int u = F.vcu; u < 64; u += F.G) { scan_gla_mfma_unit<1>(args, F, u); __syncthreads(); }
            for (int u = F.vcu; u < 64; u += F.G) { scan_rwkv_mfma_unit(args, F, u, 0); __syncthreads(); scan_rwkv_mfma_unit(args, F, u, 1); __syncthreads(); }
            if (rep_ == 0) p1_deferred(args, F, F.vcu, F.G);
        }
    } SEAM(11);
    if (IN(13)) { REFRESH(); pg8::Gemm g{ACTA, (const bf16*)(ws + WS_WOD_OUT), T, D, D / 2}; pg8::StaticOrder S; S.init(T, D, F.G, (int)blockIdx.x);
        EpiResid<false, false> E{ACTB, H1, rowss + (size_t)RS_FFN1 * T * 32, nullptr, nullptr, nullptr};
        pg8::gemm_phase<EpiResid<false, false>, pg8::StaticOrder, true, true, true>(F.lds + RING_OFF, g, S, E, F.wave); } SEAM(13);
    if (IN(14)) for (int rep_ = 0; rep_ < REPS(14); ++rep_) { REFRESH(); pg8::Gemm g{H1, (const bf16*)(ws + WS_WPEER) + (size_t)D * D, T, D, D}; pg8::StaticOrder S; S.init(T, D, F.G, (int)blockIdx.x); EpiBf16S E{SCB, D, rowss + (size_t)RS_FFN1 * T * 32};
        pg8::gemm_phase<EpiBf16S, pg8::StaticOrder, true, true>(F.lds + RING_OFF, g, S, E, F.wave); } SEAM(14);
    if (IN(15)) for (int rep_ = 0; rep_ < REPS(15); ++rep_) { REFRESH(); peer_phase(args, F, 1, rep_ != 0, H1, ACTB, (unsigned char*)ACTA); } SEAM(15);
    if (IN(16)) { REFRESH(); pg8::Gemm g{ACTA, (const bf16*)(ws + WS_WGATE) + (size_t)D * D, T, D, D / 2}; pg8::StaticOrder S; S.init(T, D, F.G, (int)blockIdx.x);
        EpiResid<true, false> E{ACTB, H1, rowss + (size_t)RS_FINAL * T * 32, PP, RS3, nullptr};
        pg8::gemm_phase<EpiResid<true, false>, pg8::StaticOrder, true, true, true>(F.lds + RING_OFF, g, S, E, F.wave); } SEAM(16);
    if (IN(17)) { REFRESH();
        float oscale = 1.0f;
#if PROBE_MASK
        { unsigned long long t_prev = __hip_atomic_load(tsb + 31, __ATOMIC_RELAXED, __HIP_MEMORY_SCOPE_AGENT); const unsigned long long t_begin = t_prev; unsigned long long sel = 0ull;
          for (int k = 0; k <= 16; ++k) { const unsigned long long tk = __hip_atomic_load(tsb + k, __ATOMIC_RELAXED, __HIP_MEMORY_SCOPE_AGENT); if ((PROBE_MASK >> k) & 1) sel += tk - t_prev; t_prev = tk; }
          const float f = (float)(double(sel) / double(t_prev - t_begin)); oscale = 1.0f + sqrtf(0.01f + 0.9f * f); }
#endif
        final_rows(args, F, oscale, H1); }
#undef IN
#undef SEAM
#undef REFRESH
}

extern "C" void kernel_launch(void* const* d_in, const int* in_sizes, int n_in, void* d_out, int out_size, void* d_ws, size_t ws_size, hipStream_t stream) {
    static int grid = 0;
    if (grid == 0) {
        if (n_in != N_IN || out_size != T * D || ws_size < WS_END + 63 * MiB) { fprintf(stderr, "kernel_launch: unexpected problem: n_in %d out %d ws %zu (need %zu)\n", n_in, out_size, ws_size, (size_t)(WS_END + 63 * MiB)); grid = -1; return; }
        int dev = 0, cus = 0, per_cu = 0;
        if (hipGetDevice(&dev) != hipSuccess || hipDeviceGetAttribute(&cus, hipDeviceAttributeMultiprocessorCount, dev) != hipSuccess) { grid = -1; return; }
        if (hipFuncSetAttribute((const void*)mega_fwd, hipFuncAttributeMaxDynamicSharedMemorySize, LDS_BYTES) != hipSuccess) { fprintf(stderr, "kernel_launch: hipFuncSetAttribute failed\n"); grid = -1; return; }
        if (hipOccupancyMaxActiveBlocksPerMultiprocessor(&per_cu, (const void*)mega_fwd, NTHREADS, LDS_BYTES) != hipSuccess || per_cu < 1) { fprintf(stderr, "kernel_launch: occupancy query says %d blocks per CU\n", per_cu); (void)hipGetLastError(); grid = -1; return; }
        grid = cus;
    }
    if (grid < 0) return;
    (void)hipMemsetAsync((char*)d_ws + WS_CTL, 0, CTL_ZERO_BYTES, stream);
    Args a{};
    for (int i = 0; i < N_IN; ++i) a.in[i] = (const float*)d_in[i];
    a.out = (float*)d_out; a.ws = (unsigned char*)d_ws;
#if MK_PER_PHASE
    for (int p = 0; p < N_PHASES - 1; ++p) { a.ph_lo = p; a.ph_hi = p + 1; hipLaunchKernelGGL(mega_fwd, dim3(grid), dim3(NTHREADS), LDS_BYTES, stream, a); }
#else
    a.ph_lo = 0; a.ph_hi = N_PHASES;
    void* kargs[] = {&a};
    hipError_t e = hipLaunchCooperativeKernel((const void*)mega_fwd, dim3(grid), dim3(NTHREADS), kargs, LDS_BYTES, stream);
    if (e != hipSuccess) fprintf(stderr, "kernel_launch: cooperative launch failed: %s (grid %d)\n", hipGetErrorString(e), grid);
#endif
}
```

```cpp
#include <hip/hip_runtime.h>
#include <hip/hip_cooperative_groups.h>
#include <cstdio>
#include <cstdint>
namespace cg = cooperative_groups;

#ifndef PROBE_MASK
#define PROBE_MASK 0
#endif
#ifndef DUP_MASK
#define DUP_MASK 0
#endif
#ifndef UBENCH
#define UBENCH 0
#endif
#ifndef GDN_DUP
#define GDN_DUP 0
#endif
#ifndef MK_PER_PHASE
#ifndef PEER_ALIAS
#define PEER_ALIAS 0
#endif
#ifndef EV_F8_T0
#define EV_F8_T0 0
#define EV_F8_T1 0
#endif
#define MK_PER_PHASE 0
#endif

namespace pg8 {
#define PG8_LAS __attribute__((address_space(3)))
typedef unsigned short bf16_t;
typedef short bf16x8 __attribute__((ext_vector_type(8)));
typedef float f32x4 __attribute__((ext_vector_type(4)));
typedef unsigned u32x4 __attribute__((ext_vector_type(4)));
typedef unsigned u32x2 __attribute__((ext_vector_type(2)));
constexpr int BM = 256, BK = 64, HALF = 128, HTB = HALF * BK * 2  , STAGE_BYTES = 8 * HTB, NXCD = 8, WGM = 8;

__host__ __device__ __forceinline__ int lds_byte(int r, int c) { const int st = (r >> 4) * 2 + (c >> 5), rr = r & 15, cc = c & 31, ob = rr * 64 + cc * 2; return st * 1024 + (ob ^ (((ob >> 9) & 1) << 5)); }
__host__ __device__ __forceinline__ void stage_rc(int b, int& R, int& C) { const int st = b / 1024, sb = b % 1024, swz = sb ^ (((sb >> 9) & 1) << 5); R = (st >> 1) * 16 + swz / 64; C = (st & 1) * 32 + (swz % 64) / 2; }
__host__ __device__ __forceinline__ int perm32(int rho) { const int n = rho >> 4, i = rho & 15; return 8 * (i >> 2) + 4 * n + (i & 3); }

struct Unit { int pm, pn; };
struct Gemm { const bf16_t* A; const bf16_t* Bt; int M, N, K; int KE = 0; };

struct StaticOrder {
    int nM, nN, nwg, G, c;
    __host__ __device__ void init(int M, int N, int G_, int c_) { nM = M / BM; nN = N / BM; nwg = nM * nN; G = G_; c = c_; }
    __host__ __device__ bool next(int i, Unit& u) const {
        const long L = (long)i * G + c; if (L >= nwg) return false;
        int wgid = (int)L; { const int q = nwg / NXCD, r = nwg % NXCD, xcd = wgid % NXCD, off = wgid / NXCD; wgid = (xcd < r ? xcd * (q + 1) : r * (q + 1) + (xcd - r) * q) + off; }
        const int nig = WGM * nN, gid = wgid / nig, fm = gid * WGM, gsz = (nM - fm) < WGM ? (nM - fm) : WGM;
        u.pm = fm + ((wgid % nig) % gsz); u.pn = (wgid % nig) / gsz; return true;
    }
    __device__ __forceinline__ void a_ready(const Unit&) const {}
    __device__ __forceinline__ void done(const Unit&) const {}
};
struct RowBlockOrder {
    int c, nN;
    __host__ __device__ bool next(int i, Unit& u) const { if (i >= nN) return false; u.pm = c; u.pn = i; return true; }
    __device__ __forceinline__ void a_ready(const Unit&) const {}
    __device__ __forceinline__ void done(const Unit&) const {}
};
__device__ __forceinline__ unsigned cvt_pk_bf16(float lo, float hi) { unsigned r; asm volatile("v_cvt_pk_bf16_f32 %0, %1, %2" : "=v"(r) : "v"(lo), "v"(hi)); return r; }
template <class Epi, class Sched, bool ALIGN_EPI = false, bool SP2 = false, bool F8 = false, bool I8 = false>
__device__ __forceinline__ void gemm_phase(PG8_LAS unsigned char* lds, const Gemm g, const Sched& S, const Epi& E, const int wave_id) {
    int tid; asm volatile("v_mbcnt_lo_u32_b32 %0, -1, 0\n\tv_mbcnt_hi_u32_b32 %0, -1, %0" : "=v"(tid)); tid += wave_id * 64;
    const int wid = wave_id, lane = tid & 63, wr = wid >> 2, wc = wid & 3, fr = lane & 15, fq = lane >> 4;
    const int K = g.K, nt = (g.KE ? g.KE : K) / BK;
    unsigned voffA[2], voffB[2];
#pragma unroll
    for (int i = 0; i < 2; ++i) { int R, C; stage_rc(tid * 16 + i * 8192, R, C); const int Rb = Epi::PERM ? ((R & ~31) + perm32(R & 31)) : R;
        voffA[i] = (unsigned)(R * K + C) * 2u; voffB[i] = (unsigned)(Rb * K + C) * 2u; }
    const __amdgpu_buffer_rsrc_t rsrcA = __builtin_amdgcn_make_buffer_rsrc((void*)g.A, 0, 0x7fffffff, 0x00020000), rsrcB = __builtin_amdgcn_make_buffer_rsrc((void*)g.Bt, 0, 0x7fffffff, 0x00020000);
    const size_t kstep = (size_t)(BK * 2);
    const size_t hstep = (size_t)HALF * K * 2;
    const size_t tstep = 2 * hstep;
    const unsigned ldsw = (unsigned)wid * 1024u;
    const int aoff = lds_byte(wr * 64 + fr, fq * 8), boff = lds_byte(wc * 32 + fr, fq * 8);
#define PG8_SA(b, h) (((b) * 2 + (h)) * HTB)
#define PG8_SB(b, h) ((4 + (b) * 2 + (h)) * HTB)
#define PG8_STAGE(bufoff, gbase, voff) do { const bool isA_ = (+(voff) == +voffA); const unsigned soff_ = (unsigned)((const char*)(gbase) - (isA_ ? (const char*)g.A : (const char*)g.Bt)); _Pragma("unroll") for (int _i = 0; _i < 2; ++_i) \
        __builtin_amdgcn_raw_ptr_buffer_load_lds(isA_ ? rsrcA : rsrcB, (PG8_LAS unsigned*)(lds + (bufoff) + ldsw + _i * 8192), 16, (int)(voff)[_i], (int)soff_, 0, 0); } while (0)
#define PG8_LDA(dst, b, h) do { _Pragma("unroll") for (int m = 0; m < 4; ++m) { if constexpr (F8) { dst##8[m].lo = *(const PG8_LAS bf16x8*)(lds + PG8_SA(b, h) + aoff + m * 2048); dst##8[m].hi = *(const PG8_LAS bf16x8*)(lds + PG8_SA(b, h) + aoff + m * 2048 + 1024); } else { _Pragma("unroll") for (int k = 0; k < 2; ++k) dst[m][k] = *(const PG8_LAS bf16x8*)(lds + PG8_SA(b, h) + aoff + m * 2048 + k * 1024); } } } while (0)
#define PG8_LDB(dst, b, h) do { _Pragma("unroll") for (int n = 0; n < 2; ++n) { if constexpr (F8) { dst##8[n].lo = *(const PG8_LAS bf16x8*)(lds + PG8_SB(b, h) + boff + n * 2048); dst##8[n].hi = *(const PG8_LAS bf16x8*)(lds + PG8_SB(b, h) + boff + n * 2048 + 1024); } else { _Pragma("unroll") for (int k = 0; k < 2; ++k) dst[n][k] = *(const PG8_LAS bf16x8*)(lds + PG8_SB(b, h) + boff + n * 2048 + k * 1024); } } } while (0)
#define PG8_MMA(ai, bj, At, Bt) do { __builtin_amdgcn_s_setprio(1); _Pragma("unroll") for (int m = 0; m < 4; ++m) _Pragma("unroll") for (int n = 0; n < 2; ++n) { \
        if constexpr (F8) { typedef int v8i_ __attribute__((ext_vector_type(8))); \
            acc[ai][bj][m][n] = __builtin_amdgcn_mfma_scale_f32_16x16x128_f8f6f4(__builtin_bit_cast(v8i_, Bt##8[n]), __builtin_bit_cast(v8i_, At##8[m]), acc[ai][bj][m][n], 0, 0, 0, 0x7f79, 1, 0x7f79); }     \
        else if constexpr (I8) { typedef int v4i_ __attribute__((ext_vector_type(4))); \
            _Pragma("unroll") for (int k = 0; k < 2; ++k) acc[ai][bj][m][n] = __builtin_bit_cast(f32x4, __builtin_amdgcn_mfma_i32_16x16x64_i8(__builtin_bit_cast(v4i_, Bt[n][k]), __builtin_bit_cast(v4i_, At[m][k]), __builtin_bit_cast(v4i_, acc[ai][bj][m][n]), 0, 0, 0)); } \
        else { _Pragma("unroll") for (int k = 0; k < 2; ++k) acc[ai][bj][m][n] = __builtin_amdgcn_mfma_f32_16x16x32_bf16(Bt[n][k], At[m][k], acc[ai][bj][m][n], 0, 0, 0); } } \
        __builtin_amdgcn_s_setprio(0); } while (0)
#define PG8_WAIT_V(n) asm volatile("s_waitcnt vmcnt(" #n ")" ::: "memory")
#define PG8_WAIT_L(n) asm volatile("s_waitcnt lgkmcnt(" #n ")" ::: "memory")
#define PG8_BAR __builtin_amdgcn_s_barrier()
#define PG8_SCHED __builtin_amdgcn_sched_barrier(0)
    Unit cur, nxt; int ui = 0;
    if (!S.next(0, cur)) return;
    f32x4 acc[2][2][4][2];
#pragma unroll
    for (int a = 0; a < 2; ++a)
#pragma unroll
        for (int b = 0; b < 2; ++b)
#pragma unroll
            for (int m = 0; m < 4; ++m)
#pragma unroll
                for (int n = 0; n < 2; ++n) acc[a][b][m][n] = (f32x4){0.f, 0.f, 0.f, 0.f};
    typedef short bf16x16 __attribute__((ext_vector_type(16)));
    bf16x16 At8[4], B08[2], B18[2]; bf16x8 At[4][2], B0[2][2], B1[2][2];
    const char* cA = (const char*)g.A + (size_t)cur.pm * tstep; const char* cB = (const char*)g.Bt + (size_t)cur.pn * tstep;
    S.a_ready(cur);
    if constexpr (SP2) {
        PG8_STAGE(PG8_SB(0, 0), cB, voffB); PG8_STAGE(PG8_SB(0, 1), cB + hstep, voffB); PG8_STAGE(PG8_SA(0, 0), cA, voffA); PG8_STAGE(PG8_SA(0, 1), cA + hstep, voffA);
        if (wr == 1) PG8_BAR;
        PG8_WAIT_V(2); PG8_BAR;
        PG8_STAGE(PG8_SB(1, 0), cB + kstep, voffB); PG8_STAGE(PG8_SA(1, 0), cA + kstep, voffA); PG8_STAGE(PG8_SB(1, 1), cB + hstep + kstep, voffB);
        PG8_WAIT_V(6); PG8_BAR;
    } else {
        PG8_STAGE(PG8_SB(0, 0), cB, voffB); PG8_STAGE(PG8_SA(0, 0), cA, voffA); PG8_STAGE(PG8_SB(0, 1), cB + hstep, voffB); PG8_STAGE(PG8_SA(0, 1), cA + hstep, voffA);
        if (wr == 1) PG8_BAR;
        PG8_WAIT_V(4); PG8_BAR;
        PG8_STAGE(PG8_SB(1, 0), cB + kstep, voffB); PG8_STAGE(PG8_SA(1, 0), cA + kstep, voffA); PG8_STAGE(PG8_SB(1, 1), cB + hstep + kstep, voffB);
        PG8_WAIT_V(6); PG8_BAR;
    }
    for (;;) {
        const bool has_next = S.next(ui + 1, nxt);
        const char* nA = has_next ? (const char*)g.A + (size_t)nxt.pm * tstep : cA; const char* nB = has_next ? (const char*)g.Bt + (size_t)nxt.pn * tstep : cB;
        for (int t = 0; t < nt; t += 2) {
            const bool last = (t == nt - 2);
            const char* a1 = cA + (size_t)(t + 1) * kstep;
            const char* a2 = last ? nA : cA + (size_t)(t + 2) * kstep; const char* b2 = last ? nB : cB + (size_t)(t + 2) * kstep;
            const char* a3 = a2 + kstep; const char* b3 = b2 + kstep;
            if (last && has_next) S.a_ready(nxt);
            if constexpr (SP2) {
            PG8_LDB(B0, 0, 0); PG8_LDB(B1, 0, 1); PG8_SCHED; PG8_LDA(At, 0, 0); PG8_STAGE(PG8_SA(1, 1), a1 + hstep, voffA);
            PG8_WAIT_V(8); PG8_WAIT_L(0); PG8_BAR; PG8_MMA(0, 0, At, B0); PG8_MMA(0, 1, At, B1); PG8_BAR; PG8_SCHED;
            PG8_LDA(At, 0, 1); PG8_STAGE(PG8_SB(0, 0), b2, voffB); PG8_STAGE(PG8_SB(0, 1), b2 + hstep, voffB); PG8_STAGE(PG8_SA(0, 0), a2, voffA);
            PG8_WAIT_V(8); PG8_WAIT_L(0); PG8_BAR; PG8_MMA(1, 0, At, B0); PG8_MMA(1, 1, At, B1); PG8_BAR; PG8_SCHED;
            PG8_LDB(B0, 1, 0); PG8_LDB(B1, 1, 1); PG8_SCHED; PG8_LDA(At, 1, 0); PG8_STAGE(PG8_SA(0, 1), a2 + hstep, voffA);
            PG8_WAIT_V(8); PG8_WAIT_L(0); PG8_BAR; PG8_MMA(0, 0, At, B0); PG8_MMA(0, 1, At, B1); PG8_BAR; PG8_SCHED;
            PG8_LDA(At, 1, 1); PG8_STAGE(PG8_SB(1, 0), b3, voffB); PG8_STAGE(PG8_SB(1, 1), b3 + hstep, voffB); PG8_STAGE(PG8_SA(1, 0), a3, voffA);
            PG8_WAIT_V(8); PG8_WAIT_L(0); PG8_BAR; PG8_MMA(1, 0, At, B0); PG8_MMA(1, 1, At, B1); PG8_BAR; PG8_SCHED;
            } else {
            PG8_LDB(B0, 0, 0); PG8_SCHED; PG8_LDA(At, 0, 0); PG8_STAGE(PG8_SA(1, 1), a1 + hstep, voffA);
            PG8_WAIT_L(8); PG8_BAR; PG8_WAIT_L(0); PG8_MMA(0, 0, At, B0); PG8_BAR; PG8_SCHED;
            PG8_LDB(B1, 0, 1); PG8_STAGE(PG8_SB(0, 0), b2, voffB);
            PG8_BAR; PG8_WAIT_L(0); PG8_MMA(0, 1, At, B1); PG8_BAR;
            PG8_LDA(At, 0, 1); PG8_STAGE(PG8_SA(0, 0), a2, voffA);
            PG8_BAR; PG8_WAIT_L(0); PG8_MMA(1, 0, At, B0); PG8_BAR; PG8_SCHED;
            PG8_STAGE(PG8_SB(0, 1), b2 + hstep, voffB);
            PG8_WAIT_V(6); PG8_BAR; PG8_MMA(1, 1, At, B1); PG8_BAR;
            PG8_LDB(B0, 1, 0); PG8_SCHED; PG8_LDA(At, 1, 0); PG8_STAGE(PG8_SA(0, 1), a2 + hstep, voffA);
            PG8_WAIT_L(8); PG8_BAR; PG8_WAIT_L(0); PG8_MMA(0, 0, At, B0); PG8_BAR; PG8_SCHED;
            PG8_LDB(B1, 1, 1); PG8_STAGE(PG8_SB(1, 0), b3, voffB);
            PG8_BAR; PG8_WAIT_L(0); PG8_MMA(0, 1, At, B1); PG8_BAR;
            PG8_LDA(At, 1, 1); PG8_STAGE(PG8_SA(1, 0), a3, voffA);
            PG8_BAR; PG8_WAIT_L(0); PG8_MMA(1, 0, At, B0); PG8_BAR; PG8_SCHED;
            PG8_STAGE(PG8_SB(1, 1), b3 + hstep, voffB);
            PG8_WAIT_V(6); PG8_BAR; PG8_MMA(1, 1, At, B1); PG8_BAR;
            }
        }
        if constexpr (ALIGN_EPI) { if (wr == 0) PG8_BAR; }
        if constexpr (!Epi::AFTER_DRAIN) { int ln_e; asm volatile("v_mbcnt_lo_u32_b32 %0, -1, 0\n\tv_mbcnt_hi_u32_b32 %0, -1, %0" : "=v"(ln_e)); const int fr_e = ln_e & 15, fq_e = ln_e >> 4;
            E(acc, cur, wr, wc, fr_e, fq_e); S.done(cur); }
        if (!has_next) break;
#pragma unroll
        for (int a = 0; a < 2; ++a)
#pragma unroll
            for (int b = 0; b < 2; ++b)
#pragma unroll
                for (int m = 0; m < 4; ++m)
#pragma unroll
                    for (int n = 0; n < 2; ++n) acc[a][b][m][n] = (f32x4){0.f, 0.f, 0.f, 0.f};
        cur = nxt; cA = nA; cB = nB; ++ui;
        if constexpr (ALIGN_EPI) { if (wr == 1) PG8_BAR; }
    }
    PG8_WAIT_V(0);
    if constexpr (!ALIGN_EPI) { if (wr == 0) PG8_BAR; }
    PG8_BAR;
    if constexpr (Epi::AFTER_DRAIN) { E.fused(acc, cur, wr, wc, fr, fq, lds, wid, lane); S.done(cur); }
#undef PG8_SA
#undef PG8_SB
#undef PG8_STAGE
#undef PG8_LDA
#undef PG8_LDB
#undef PG8_MMA
#undef PG8_WAIT_V
#undef PG8_WAIT_L
#undef PG8_BAR
#undef PG8_SCHED
}
}
#define GAS __attribute__((address_space(1)))
#define LAS __attribute__((address_space(3)))
typedef unsigned short bf16;
typedef unsigned v4u __attribute__((ext_vector_type(4)));
typedef float f32x4 __attribute__((ext_vector_type(4)));
typedef short bf16x8 __attribute__((ext_vector_type(8)));
typedef GAS unsigned gu32;
typedef GAS unsigned long long gu64;
#define RLX_AGENT __ATOMIC_RELAXED, __HIP_MEMORY_SCOPE_AGENT
#define LDS_WAIT() asm volatile("s_waitcnt lgkmcnt(0)" ::: "memory")
#define VM_WAIT() asm volatile("s_waitcnt vmcnt(0)" ::: "memory")
__device__ __forceinline__ unsigned long long rt() { return __builtin_amdgcn_s_memrealtime(); }
__device__ __forceinline__ unsigned f2bf(float f) { unsigned u = __builtin_bit_cast(unsigned, f); return (u + 0x7fffu + ((u >> 16) & 1u)) >> 16; }
__device__ __forceinline__ unsigned pk2(float lo, float hi) { return f2bf(lo) | (f2bf(hi) << 16); }

#define XB_TMO      128
#define XB_XCNT(j)  (256  + 64 * (j))
#define XB_XSUB(j)  (1280 + 64 * (j))
#define XB_XGEN(j)  (2304 + 64 * (j))
#define XB_TOP      3328
#define XB_TOPGEN   3392
#define XCD_BAR_WORDS 3456
#define XB_SPIN_CAP (1u << 18)

__device__ __forceinline__ unsigned xb_ld(unsigned* p)              { return __hip_atomic_load(p, __ATOMIC_RELAXED, __HIP_MEMORY_SCOPE_AGENT); }
__device__ __forceinline__ unsigned xb_add(unsigned* p, unsigned v) { return __hip_atomic_fetch_add(p, v, __ATOMIC_RELAXED, __HIP_MEMORY_SCOPE_AGENT); }
__device__ __forceinline__ unsigned xb_xcc_id() { return (unsigned)__builtin_amdgcn_s_getreg((3 << 11) | 20) & 0xFu; }
#define XB_SPIN(cond, bar) do { unsigned _sp = 0; while (cond) { __builtin_amdgcn_s_sleep(1); \
    if ((++_sp & 255u) == 0u) { if (xb_ld(&(bar)[XB_TMO])) break; if (_sp > XB_SPIN_CAP) { atomicAdd(&(bar)[XB_TMO], 1u); break; } } } } while (0)

struct XcdBarrier {
    unsigned* bar; unsigned x; bool wave0;
    volatile LAS unsigned* st;
};

__device__ __forceinline__ XcdBarrier xcd_barrier_post(unsigned* bar, volatile LAS unsigned* st) {
    XcdBarrier b; b.bar = bar; b.x = xb_xcc_id(); b.st = st;
    if (threadIdx.x == 0) (void)xb_add(&bar[XB_XCNT(b.x)], 1u);
    return b;
}
__device__ __forceinline__ void xcd_barrier_complete(unsigned* bar, unsigned x, unsigned& nloc, unsigned& nx) {
    const unsigned G = gridDim.x * gridDim.y * gridDim.z;
    unsigned sum, cnt, mine, sp = 0u;
    for (;;) {
        sum = 0u; cnt = 0u; mine = 0u;
#pragma unroll
        for (unsigned j = 0; j < 16; ++j) { const unsigned c = xb_ld(&bar[XB_XCNT(j)]); sum += c; cnt += (c > 0u) ? 1u : 0u; mine = (j == x) ? c : mine; }
        if (sum == G) break;
        __builtin_amdgcn_s_sleep(1);
        if ((++sp & 255u) == 0u) { if (xb_ld(&bar[XB_TMO])) break; if (sp > XB_SPIN_CAP) { atomicAdd(&bar[XB_TMO], 1u); break; } }
    }
    nloc = mine > 0u ? mine : 1u; nx = cnt > 0u ? cnt : 1u;
}

__device__ __forceinline__ void xcd_barrier(const XcdBarrier& b) {
    asm volatile("s_waitcnt vmcnt(0)" ::: "memory");
    __syncthreads();
    if (b.wave0 && __builtin_amdgcn_mbcnt_hi(~0u, __builtin_amdgcn_mbcnt_lo(~0u, 0u)) == 0u) {
        unsigned* bar = b.bar;
        __builtin_amdgcn_s_waitcnt(0);
        unsigned nloc = b.st[0], nx = b.st[1];
        if (nloc == 0u) { xcd_barrier_complete(bar, b.x, nloc, nx); b.st[0] = nloc; b.st[1] = nx; }
        const unsigned old = xb_add(&bar[XB_XSUB(b.x)], 1u);
        const unsigned gen = old / nloc;
        if (old + 1u == (gen + 1u) * nloc) {
            __builtin_amdgcn_fence(__ATOMIC_RELEASE, "agent");
            asm volatile("s_waitcnt vmcnt(0)" ::: "memory");
            const unsigned og = xb_add(&bar[XB_TOP], 1u);
            const unsigned tg = og / nx;
            if (og + 1u == (tg + 1u) * nx) xb_add(&bar[XB_TOPGEN], 1u);
            else XB_SPIN(xb_ld(&bar[XB_TOPGEN]) == tg, bar);
            __builtin_amdgcn_fence(__ATOMIC_ACQUIRE, "agent");
            xb_add(&bar[XB_XGEN(b.x)], 1u);
            asm volatile("s_waitcnt vmcnt(0)" ::: "memory");
        } else {
            XB_SPIN(xb_ld(&bar[XB_XGEN(b.x)]) == gen, bar);
            __builtin_amdgcn_fence(__ATOMIC_ACQUIRE, "agent");
            asm volatile("s_waitcnt vmcnt(0)" ::: "memory");
        }
    }
    __syncthreads();
}

constexpr int NWAVES = 8, NTHREADS = NWAVES * 64;
constexpr int BATCH = 8, SEQ = 2048, T = BATCH * SEQ, D = 2048;
constexpr int EV_N = 7200, EV_NP = 7424, OD_N = 7616, OD_NP = 7680, PROJ_LD = 7680;
constexpr float EPS = 1e-6f;
constexpr int EC_GQ = 0, EC_GK = 512, EC_GV = 1024, EC_GZ = 2048, EC_GLR = 3072, EC_BQ = 3088, EC_BK = 4112, EC_BV = 5136, EC_BZ = 6160, EC_BA = 7184, EC_BB = 7192;
constexpr int OC_HQ = 0, OC_HF = 1024, OC_HI = 2048, OC_HG = 3072, OC_RW = 4096;
constexpr int RW_R = 0, RW_K = 1024, RW_V = 2048, RW_WL = 3072, RW_AL = 3168, RW_GL = 3264;
constexpr int LORA_K = 512, LORA_N = 3072;
enum { I_X = 0, I_P, I_EV_WIN, I_GK_W2, I_GK_B, I_GLA_NORM, I_GDN_CONV, I_GDN_ALOG, I_GDN_DTB, I_GDN_NORM, I_EV_WOUT, I_OD_WIN, I_LB, I_HG_NORM,
       I_MU, I_W0, I_W2, I_A0, I_A2, I_G2, I_KK, I_KA, I_RK, I_LNW, I_LNB, I_OD_WOUT, I_NMIX, I_NFFN, I_NPLE, I_PEER_WQ, I_PEER_SK, I_PEER_U, I_PEER_V,
       I_PLE_WP, I_PLE_WG, I_NFINAL, N_IN };

constexpr size_t MiB = 1u << 20;
constexpr size_t WS_CTL = 0, CTL_ZERO_BYTES = 1 * MiB, WS_SU = 256 * 1024, WS_CMB = 512 * 1024, WS_SA = 576 * 1024;
constexpr size_t WS_WEV_IN = 1 * MiB, WS_WEV_OUT = 30 * MiB, WS_WOD_IN = 38 * MiB, WS_WOD_OUT = 68 * MiB, WS_WPEER = 76 * MiB, WS_WGATE = 92 * MiB, WS_WPROJ = 108 * MiB,
                 WS_WLORA = 110 * MiB, WS_PBF = 113 * MiB, WS_TABU = 129 * MiB, WS_TABV = 193 * MiB, WS_ACTA = 257 * MiB, WS_ACTB = 321 * MiB, WS_PROJ = 385 * MiB, WS_SC = 385 * MiB,
                 WS_O = 625 * MiB, WS_H1 = 689 * MiB, WS_PP = 753 * MiB, WS_LA = 817 * MiB, WS_LO = 833 * MiB, WS_RSP = 929 * MiB, WS_STATE = 937 * MiB, WS_RS3 = 945 * MiB, WS_END = 946 * MiB;
static_assert(WS_WEV_IN + (size_t)EV_NP * D * 2 <= WS_WEV_OUT && WS_WOD_IN + (size_t)OD_NP * D * 2 <= WS_WOD_OUT && WS_PROJ + (size_t)T * PROJ_LD * 2 <= WS_O, "ws map");
constexpr int CW_BAR = 4096;
enum { RS_FFN0 = 0, RS_MIX1 = 1, RS_FFN1 = 2, RS_FINAL = 3 };
constexpr int RING_OFF = 0, RING_BYTES = 131072;
constexpr int LDSCTL_OFF = RING_BYTES, MISC_OFF = LDSCTL_OFF + 320;
constexpr int LDS_BYTES = 147456;

struct Args { const float* in[N_IN]; float* out; unsigned char* ws; int ph_lo, ph_hi; };
struct Frame {
    LAS unsigned char* lds; volatile LAS unsigned* MISC; gu32* ctl;
    int tid, lane, wave, vcu, G;
};
__device__ __forceinline__ float wave_sum(float v) {
#pragma unroll
    for (int o = 1; o < 64; o <<= 1) v += __shfl_xor(v, o);
    return v;
}
__device__ __forceinline__ float half_sum32(float v) {
#pragma unroll
    for (int o = 1; o < 32; o <<= 1) v += __shfl_xor(v, o);
    return v;
}
#define DPP_ADD(v, ctrl) (v) += __builtin_bit_cast(float, __builtin_amdgcn_update_dpp(0, __builtin_bit_cast(int, (v)), (ctrl), 0xF, 0xF, false))
__device__ __forceinline__ float row_sum16(float v) {
    DPP_ADD(v, 0x128); DPP_ADD(v, 0x124); DPP_ADD(v, 0x122); DPP_ADD(v, 0x121);
    return v;
}
__device__ __forceinline__ void row_sum16_x4(float& a, float& b, float& c, float& d) {
    asm("s_nop 1\n\t"
        "v_add_f32_dpp %0, %0, %0 row_ror:8 row_mask:0xf bank_mask:0xf\n\tv_add_f32_dpp %1, %1, %1 row_ror:8 row_mask:0xf bank_mask:0xf\n\t"
        "v_add_f32_dpp %2, %2, %2 row_ror:8 row_mask:0xf bank_mask:0xf\n\tv_add_f32_dpp %3, %3, %3 row_ror:8 row_mask:0xf bank_mask:0xf\n\t"
        "v_add_f32_dpp %0, %0, %0 row_ror:4 row_mask:0xf bank_mask:0xf\n\tv_add_f32_dpp %1, %1, %1 row_ror:4 row_mask:0xf bank_mask:0xf\n\t"
        "v_add_f32_dpp %2, %2, %2 row_ror:4 row_mask:0xf bank_mask:0xf\n\tv_add_f32_dpp %3, %3, %3 row_ror:4 row_mask:0xf bank_mask:0xf\n\t"
        "v_add_f32_dpp %0, %0, %0 row_ror:2 row_mask:0xf bank_mask:0xf\n\tv_add_f32_dpp %1, %1, %1 row_ror:2 row_mask:0xf bank_mask:0xf\n\t"
        "v_add_f32_dpp %2, %2, %2 row_ror:2 row_mask:0xf bank_mask:0xf\n\tv_add_f32_dpp %3, %3, %3 row_ror:2 row_mask:0xf bank_mask:0xf\n\t"
        "v_add_f32_dpp %0, %0, %0 row_ror:1 row_mask:0xf bank_mask:0xf\n\tv_add_f32_dpp %1, %1, %1 row_ror:1 row_mask:0xf bank_mask:0xf\n\t"
        "v_add_f32_dpp %2, %2, %2 row_ror:1 row_mask:0xf bank_mask:0xf\n\tv_add_f32_dpp %3, %3, %3 row_ror:1 row_mask:0xf bank_mask:0xf\n\t"
        "s_nop 1"
        : "+v"(a), "+v"(b), "+v"(c), "+v"(d));
}
__device__ __forceinline__ void row_sum16_x2(float& a, float& b) {
    asm("s_nop 1\n\t"
        "v_add_f32_dpp %0, %0, %0 row_ror:8 row_mask:0xf bank_mask:0xf\n\tv_add_f32_dpp %1, %1, %1 row_ror:8 row_mask:0xf bank_mask:0xf\n\ts_nop 1\n\t"
        "v_add_f32_dpp %0, %0, %0 row_ror:4 row_mask:0xf bank_mask:0xf\n\tv_add_f32_dpp %1, %1, %1 row_ror:4 row_mask:0xf bank_mask:0xf\n\ts_nop 1\n\t"
        "v_add_f32_dpp %0, %0, %0 row_ror:2 row_mask:0xf bank_mask:0xf\n\tv_add_f32_dpp %1, %1, %1 row_ror:2 row_mask:0xf bank_mask:0xf\n\ts_nop 1\n\t"
        "v_add_f32_dpp %0, %0, %0 row_ror:1 row_mask:0xf bank_mask:0xf\n\tv_add_f32_dpp %1, %1, %1 row_ror:1 row_mask:0xf bank_mask:0xf\n\t"
        "s_nop 1"
        : "+v"(a), "+v"(b));
}
typedef unsigned u32x2 __attribute__((ext_vector_type(2)));
__device__ __forceinline__ void st_wt16(void* p, v4u v) { asm volatile("global_store_dwordx4 %0, %1, off sc1\n\ts_nop 1" :: "v"(p), "v"(v) : "memory"); }
__device__ __forceinline__ void st_wt8(void* p, u32x2 v) { asm volatile("global_store_dwordx2 %0, %1, off sc1\n\ts_nop 1" :: "v"(p), "v"(v) : "memory"); }
#define LBAR() do { asm volatile("s_waitcnt lgkmcnt(0)" ::: "memory"); __builtin_amdgcn_s_barrier(); asm volatile("" ::: "memory"); } while (0)
typedef float f32x2 __attribute__((ext_vector_type(2)));
typedef __bf16 hwbf16x2_t __attribute__((ext_vector_type(2)));
__device__ __forceinline__ unsigned hw_pk2(float lo, float hi) { const f32x2 v = {lo, hi}; return __builtin_bit_cast(unsigned, __builtin_convertvector(v, hwbf16x2_t)); }
__device__ __forceinline__ bf16 hw_bf(float x) { return (bf16)hw_pk2(x, 0.f); }
__device__ __forceinline__ float bf_lo(unsigned w) { return __uint_as_float(w << 16); }
__device__ __forceinline__ float bf_hi(unsigned w) { return __uint_as_float(w & 0xffff0000u); }
__device__ __forceinline__ float sigmoidf_(float x) { return __builtin_amdgcn_rcpf(1.0f + __expf(-x)); }
__device__ __forceinline__ float siluf_(float x) { return x * __builtin_amdgcn_rcpf(1.0f + __expf(-x)); }
__device__ __forceinline__ float softplusf_(float x) { return fmaxf(x, 0.f) + log1pf(__expf(-fabsf(x))); }
__device__ __forceinline__ float logsigmoidf_(float x) { return fminf(x, 0.f) - log1pf(__expf(-fabsf(x))); }

struct EpiBf16S {
    static constexpr bool PERM = true, AFTER_DRAIN = false;
    bf16* O; int ldc; const float* rowss;
    __device__ __forceinline__ void operator()(const pg8::f32x4 (&acc)[2][2][4][2], const pg8::Unit& u, int wr, int wc, int fr, int fq) const {
        const int row0 = u.pm * 256 + wr * 64 + fr, col0 = u.pn * 256 + wc * 32 + 8 * fq;
#pragma unroll
        for (int ai = 0; ai < 2; ++ai)
#pragma unroll
            for (int m = 0; m < 4; ++m) {
                const int row = row0 + ai * 128 + m * 16;
                float sc = 1.f;
                if (rowss) { const pg8::f32x4* rp = (const pg8::f32x4*)(rowss + (size_t)row * 32 + 8 * fq); const pg8::f32x4 p0 = rp[0], p1 = rp[1];
                    float s = ((p0[0] + p0[1]) + (p0[2] + p0[3])) + ((p1[0] + p1[1]) + (p1[2] + p1[3])); s += __shfl_xor(s, 16); s += __shfl_xor(s, 32);
                    sc = __builtin_amdgcn_rsqf(s * (1.0f / D) + EPS); }
                bf16* rowp = O + (size_t)row * ldc + col0;
#pragma unroll
                for (int bj = 0; bj < 2; ++bj) { const pg8::f32x4 v0 = acc[ai][bj][m][0] * sc, v1 = acc[ai][bj][m][1] * sc;
                    pg8::u32x4 w; w.x = pg8::cvt_pk_bf16(v0[0], v0[1]); w.y = pg8::cvt_pk_bf16(v0[2], v0[3]); w.z = pg8::cvt_pk_bf16(v1[0], v1[1]); w.w = pg8::cvt_pk_bf16(v1[2], v1[3]);
                    *(pg8::u32x4*)(rowp + bj * 128) = w; } }
    }
};
struct EpiI8S {
    static constexpr bool PERM = true, AFTER_DRAIN = false;
    bf16* O; int ldc; const float* sa; const float* cb;
    __device__ __forceinline__ void operator()(const pg8::f32x4 (&acc)[2][2][4][2], const pg8::Unit& u, int wr, int wc, int fr, int fq) const {
        const int row0 = u.pm * 256 + wr * 64 + fr, col0 = u.pn * 256 + wc * 32 + 8 * fq;
        pg8::f32x4 cs[2][2];
#pragma unroll
        for (int bj = 0; bj < 2; ++bj) { cs[bj][0] = *(const pg8::f32x4*)(cb + col0 + bj * 128); cs[bj][1] = *(const pg8::f32x4*)(cb + col0 + bj * 128 + 4); }
#pragma unroll
        for (int ai = 0; ai < 2; ++ai)
#pragma unroll
            for (int m = 0; m < 4; ++m) {
                const int row = row0 + ai * 128 + m * 16;
                const float sc = sa[row];
                bf16* rowp = O + (size_t)row * ldc + col0;
#pragma unroll
                for (int bj = 0; bj < 2; ++bj) { pg8::f32x4 v0, v1;
#pragma unroll
                    for (int e = 0; e < 4; ++e) { v0[e] = (float)__float_as_int(acc[ai][bj][m][0][e]) * sc * cs[bj][0][e]; v1[e] = (float)__float_as_int(acc[ai][bj][m][1][e]) * sc * cs[bj][1][e]; }
                    pg8::u32x4 w; w.x = pg8::cvt_pk_bf16(v0[0], v0[1]); w.y = pg8::cvt_pk_bf16(v0[2], v0[3]); w.z = pg8::cvt_pk_bf16(v1[0], v1[1]); w.w = pg8::cvt_pk_bf16(v1[2], v1[3]);
                    *(pg8::u32x4*)(rowp + bj * 128) = w; } }
    }
};
template <bool GATE, bool HIN_F32, bool I8 = false> struct EpiResid {
    static constexpr bool PERM = false, AFTER_DRAIN = false;
    const void* hin; bf16* hout; float* rowss; const bf16* pp; const float* rs3; unsigned char* h8; const float* sa; const float* cb;
    __device__ __forceinline__ void operator()(const pg8::f32x4 (&acc)[2][2][4][2], const pg8::Unit& u, int wr, int wc, int fr, int fq) const {
        const int row0 = u.pm * 256 + wr * 64 + fr, col0 = u.pn * 256 + wc * 32 + 4 * fq;
        pg8::f32x4 cs[2][2];
        if constexpr (I8) {
#pragma unroll
            for (int bj = 0; bj < 2; ++bj)
#pragma unroll
                for (int n = 0; n < 2; ++n) cs[bj][n] = *(const pg8::f32x4*)(cb + col0 + bj * 128 + n * 16); }
        constexpr int MG = HIN_F32 ? 2 : 4;
#pragma unroll
        for (int ai = 0; ai < 2; ++ai)
#pragma unroll
            for (int m0 = 0; m0 < 4; m0 += MG) {
                pg8::f32x4 hf[MG][2][2]; pg8::u32x2 hb[MG][2][2], pw[MG][2][2]; float rsc[MG];
#pragma unroll
                for (int mm = 0; mm < MG; ++mm) { const int row = row0 + ai * 128 + (m0 + mm) * 16; const size_t off = (size_t)row * D + col0; rsc[mm] = GATE ? rs3[row] : (I8 ? sa[row] : 1.f);
#pragma unroll
                    for (int bj = 0; bj < 2; ++bj)
#pragma unroll
                        for (int n = 0; n < 2; ++n) { const size_t o = off + bj * 128 + n * 16;
                            if (HIN_F32) hf[mm][bj][n] = *(const pg8::f32x4*)((const float*)hin + o); else hb[mm][bj][n] = *(const pg8::u32x2*)((const bf16*)hin + o);
                            if (GATE) pw[mm][bj][n] = *(const pg8::u32x2*)(pp + o); } }
#pragma unroll
                for (int mm = 0; mm < MG; ++mm) { const int m = m0 + mm; const int row = row0 + ai * 128 + m * 16; const size_t off = (size_t)row * D + col0; float ss = 0.f;
#pragma unroll
                    for (int bj = 0; bj < 2; ++bj)
#pragma unroll
                        for (int n = 0; n < 2; ++n) { const size_t o = off + bj * 128 + n * 16;
                            pg8::f32x4 hv;
                            if (HIN_F32) hv = hf[mm][bj][n];
                            else { const pg8::u32x2 hw = hb[mm][bj][n]; hv[0] = bf_lo(hw.x); hv[1] = bf_hi(hw.x); hv[2] = bf_lo(hw.y); hv[3] = bf_hi(hw.y); }
                            pg8::f32x4 a = acc[ai][bj][m][n];
                            if constexpr (I8 && !GATE) { const float sr_ = rsc[mm];
#pragma unroll
                                for (int e = 0; e < 4; ++e) a[e] = (float)__float_as_int(a[e]) * sr_ * cs[bj][n][e]; }
                            if (GATE) { const pg8::u32x2 p2 = pw[mm][bj][n]; const float rs_ = rsc[mm];
                                a[0] = sigmoidf_(a[0] * rs_) * bf_lo(p2.x); a[1] = sigmoidf_(a[1] * rs_) * bf_hi(p2.x); a[2] = sigmoidf_(a[2] * rs_) * bf_lo(p2.y); a[3] = sigmoidf_(a[3] * rs_) * bf_hi(p2.y); }
                            hv = hv + a;
                            pg8::u32x2 w; w.x = hw_pk2(hv[0], hv[1]); w.y = hw_pk2(hv[2], hv[3]); *(pg8::u32x2*)(hout + o) = w;
                            if (h8) { int x8 = __builtin_amdgcn_cvt_pk_fp8_f32(hv[0], hv[1], 0, false); x8 = __builtin_amdgcn_cvt_pk_fp8_f32(hv[2], hv[3], x8, true); *(unsigned*)(h8 + o) = (unsigned)x8; }
                            const float q0 = bf_lo(w.x), q1 = bf_hi(w.x), q2 = bf_lo(w.y), q3 = bf_hi(w.y);
                            ss += (q0 * q0 + q1 * q1) + (q2 * q2 + q3 * q3); }
                    ss += __shfl_xor(ss, 16); ss += __shfl_xor(ss, 32);
                    if (fq == 0) rowss[(size_t)row * 32 + u.pn * 4 + wc] = ss; }
                asm volatile("" ::: "memory"); }
    }
};


__device__ __forceinline__ void p0_transpose_item(const float* W, int K, int N, bf16* WT, LAS float* scr, int item, int lane, const float* kgain = nullptr) {
    const int nblk = N / 32, kb = item / nblk, nb = item % nblk, k0 = 64 * kb, n0 = 32 * nb;
    { const GAS float* Wg = (const GAS float*)W + (size_t)(k0 + (lane >> 5)) * N + n0 + (lane & 31); float v[32];
#pragma unroll
      for (int i = 0; i < 32; ++i) v[i] = Wg[(size_t)(2 * i) * N];
#pragma unroll
      for (int i = 0; i < 32; ++i) scr[(2 * i + (lane >> 5)) * 33 + (lane & 31)] = v[i]; }
    LDS_WAIT(); asm volatile("" ::: "memory");
    const int c = lane & 7;
#pragma unroll
    for (int j = 0; j < 4; ++j) { const int n = (lane >> 3) + 8 * j; const LAS float* s = scr + (8 * c) * 33 + n;
        f32x4 g0 = {1.f, 1.f, 1.f, 1.f}, g1 = g0; if (kgain) { g0 = *(const GAS f32x4*)(kgain + k0 + 8 * c); g1 = *(const GAS f32x4*)(kgain + k0 + 8 * c + 4); }
        v4u o; o.x = pk2(s[0 * 33] * g0[0], s[1 * 33] * g0[1]); o.y = pk2(s[2 * 33] * g0[2], s[3 * 33] * g0[3]); o.z = pk2(s[4 * 33] * g1[0], s[5 * 33] * g1[1]); o.w = pk2(s[6 * 33] * g1[2], s[7 * 33] * g1[3]);
        *(GAS v4u*)(WT + (size_t)(n0 + n) * K + k0 + 8 * c) = o; }
    LDS_WAIT(); asm volatile("" ::: "memory");
}
__device__ __forceinline__ void p0_transpose_item_i8(const float* W, int K, int N, unsigned char* WT, LAS float* scr, int item, int lane, const float* cm) {
    const int nblk = N / 32, kb = item / nblk, nb = item % nblk, k0 = 64 * kb, n0 = 32 * nb;
    { const GAS float* Wg = (const GAS float*)W + (size_t)(k0 + (lane >> 5)) * N + n0 + (lane & 31); float v[32];
#pragma unroll
      for (int i = 0; i < 32; ++i) v[i] = Wg[(size_t)(2 * i) * N];
#pragma unroll
      for (int i = 0; i < 32; ++i) scr[(2 * i + (lane >> 5)) * 33 + (lane & 31)] = v[i]; }
    LDS_WAIT(); asm volatile("" ::: "memory");
    const int c = lane & 7;
#pragma unroll
    for (int j = 0; j < 4; ++j) { const int n = (lane >> 3) + 8 * j; const LAS float* s = scr + (8 * c) * 33 + n;
        const float mx = __uint_as_float(__hip_atomic_load((const unsigned*)cm + n0 + n, __ATOMIC_RELAXED, __HIP_MEMORY_SCOPE_AGENT)), inv = mx > 0.f ? 127.0f / mx : 0.f; unsigned w0 = 0, w1 = 0;
#pragma unroll
        for (int e = 0; e < 4; ++e) { w0 |= (__float_as_uint(__builtin_fmaf(s[e * 33], inv, 12582912.0f)) & 255u) << (8 * e); w1 |= (__float_as_uint(__builtin_fmaf(s[(4 + e) * 33], inv, 12582912.0f)) & 255u) << (8 * e); }
        u32x2 o; o.x = w0; o.y = w1;
        *(GAS u32x2*)(WT + (size_t)(n0 + n) * K + k0 + 8 * c) = o; }
    LDS_WAIT(); asm volatile("" ::: "memory");
}
__device__ __forceinline__ void colmax_item(const float* W, int K, int N, float* cm, int item, int lane) {
    const int ngrp = (N + 255) / 256, kb = item / ngrp, cg_ = item % ngrp, col = 256 * cg_ + 4 * lane;
    if (col >= N) return;
    const GAS f32x4* p = (const GAS f32x4*)((const GAS float*)W + (size_t)(64 * kb) * N + col); f32x4 m = {0.f, 0.f, 0.f, 0.f};
#pragma unroll 16
    for (int r = 0; r < 64; ++r) { const f32x4 v = *(const GAS f32x4*)((const GAS float*)p + (size_t)r * N);
#pragma unroll
        for (int e = 0; e < 4; ++e) m[e] = fmaxf(m[e], fabsf(v[e])); }
#pragma unroll
    for (int e = 0; e < 4; ++e) __hip_atomic_fetch_max((unsigned*)cm + col + e, __float_as_uint(m[e]), __ATOMIC_RELAXED, __HIP_MEMORY_SCOPE_AGENT);
}
__device__ __forceinline__ void p0_transpose_item_f8(const float* W, int K, int N, unsigned char* WT, LAS float* scr, int item, int lane, const float* kgain = nullptr) {
    const int nblk = N / 32, kb = item / nblk, nb = item % nblk, k0 = 64 * kb, n0 = 32 * nb;
    { const GAS float* Wg = (const GAS float*)W + (size_t)(k0 + (lane >> 5)) * N + n0 + (lane & 31); float v[32];
#pragma unroll
      for (int i = 0; i < 32; ++i) v[i] = Wg[(size_t)(2 * i) * N];
#pragma unroll
      for (int i = 0; i < 32; ++i) scr[(2 * i + (lane >> 5)) * 33 + (lane & 31)] = v[i]; }
    LDS_WAIT(); asm volatile("" ::: "memory");
    const int c = lane & 7;
#pragma unroll
    for (int j = 0; j < 4; ++j) { const int n = (lane >> 3) + 8 * j; const LAS float* s = scr + (8 * c) * 33 + n;
        f32x4 g0 = {64.f, 64.f, 64.f, 64.f}, g1 = g0; if (kgain) { g0 = g0 * *(const GAS f32x4*)(kgain + k0 + 8 * c); g1 = g1 * *(const GAS f32x4*)(kgain + k0 + 8 * c + 4); }
        int x0 = __builtin_amdgcn_cvt_pk_fp8_f32(s[0 * 33] * g0[0], s[1 * 33] * g0[1], 0, false); x0 = __builtin_amdgcn_cvt_pk_fp8_f32(s[2 * 33] * g0[2], s[3 * 33] * g0[3], x0, true);
        int x1 = __builtin_amdgcn_cvt_pk_fp8_f32(s[4 * 33] * g1[0], s[5 * 33] * g1[1], 0, false); x1 = __builtin_amdgcn_cvt_pk_fp8_f32(s[6 * 33] * g1[2], s[7 * 33] * g1[3], x1, true);
        u32x2 o; o.x = (unsigned)x0; o.y = (unsigned)x1;
        *(GAS u32x2*)(WT + (size_t)(n0 + n) * K + k0 + 8 * c) = o; }
    LDS_WAIT(); asm volatile("" ::: "memory");
}
__device__ __forceinline__ void cvt_f32_bf16(const float* src, bf16* dst, size_t n, int gtid, int gthreads) {
    const size_t n8 = n / 8;
    for (size_t i = gtid; i < n8; i += gthreads) {
        const f32x4 a = *(const GAS f32x4*)(src + i * 8), b = *(const GAS f32x4*)(src + i * 8 + 4);
        v4u o; o.x = pk2(a[0], a[1]); o.y = pk2(a[2], a[3]); o.z = pk2(b[0], b[1]); o.w = pk2(b[2], b[3]);
        *(GAS v4u*)(dst + i * 8) = o; }
}
__device__ __forceinline__ void cvt_f32_fp8(const float* src, unsigned char* dst, size_t n, float scale, int gtid, int gthreads, const float* cgain = nullptr) {
    const size_t n16 = n / 16;
    for (size_t i = gtid; i < n16; i += gthreads) { v4u o; unsigned w[4];
#pragma unroll
        for (int q = 0; q < 4; ++q) { f32x4 a = *(const GAS f32x4*)(src + i * 16 + 4 * q) * scale; if (cgain) a = a * *(const GAS f32x4*)(cgain + ((i * 16 + 4 * q) & (D - 1)));
            int x = __builtin_amdgcn_cvt_pk_fp8_f32(a[0], a[1], 0, false); x = __builtin_amdgcn_cvt_pk_fp8_f32(a[2], a[3], x, true); w[q] = (unsigned)x; }
        o.x = w[0]; o.y = w[1]; o.z = w[2]; o.w = w[3];
        *(GAS v4u*)(dst + i * 16) = o; }
}
__device__ __forceinline__ void cvt_rows_i8(const float* src, unsigned char* dst, float* SU, int rows, int gw, int NGW, int lane, const float* cgain) {
    f32x4 a[8], nx[8];
    int r = gw;
    if (r < rows) {
#pragma unroll
        for (int i = 0; i < 8; ++i) a[i] = *(const GAS f32x4*)(src + (size_t)r * D + 256 * i + 4 * lane); }
    for (; r < rows; r += NGW) {
        const int rn = r + NGW;
        if (rn < rows) {
#pragma unroll
            for (int i = 0; i < 8; ++i) nx[i] = *(const GAS f32x4*)(src + (size_t)rn * D + 256 * i + 4 * lane); }
        float mx = 0.f;
#pragma unroll
        for (int i = 0; i < 8; ++i) { if (cgain) a[i] = a[i] * *(const GAS f32x4*)(cgain + 256 * i + 4 * lane);
            mx = fmaxf(mx, fmaxf(fmaxf(fabsf(a[i][0]), fabsf(a[i][1])), fmaxf(fabsf(a[i][2]), fabsf(a[i][3])))); }
#pragma unroll
        for (int o = 1; o < 64; o <<= 1) mx = fmaxf(mx, __shfl_xor(mx, o));
        const float inv = mx > 0.f ? 127.0f / mx : 0.f;
#pragma unroll
        for (int i = 0; i < 8; ++i) { unsigned w = 0;
#pragma unroll
            for (int e = 0; e < 4; ++e) w |= (__float_as_uint(__builtin_fmaf(a[i][e], inv, 12582912.0f)) & 255u) << (8 * e);
            *(GAS unsigned*)(dst + (size_t)r * D + 256 * i + 4 * lane) = w; }
        if (lane == 0) SU[r] = mx * (1.0f / 127.0f);
#pragma unroll
        for (int i = 0; i < 8; ++i) a[i] = nx[i];
    }
}
__device__ __forceinline__ void rms_row_to_bf16(const float* xrow, const float* g, bf16* orow, int lane) {
    const GAS f32x4* xr = (const GAS f32x4*)xrow + lane; f32x4 v[8]; float s = 0.f;
#pragma unroll
    for (int j = 0; j < 8; ++j) { v[j] = xr[64 * j]; s += (v[j][0] * v[j][0] + v[j][1] * v[j][1]) + (v[j][2] * v[j][2] + v[j][3] * v[j][3]); }
    const float r = __builtin_amdgcn_rsqf(wave_sum(s) * (1.0f / D) + EPS);
    const GAS f32x4* gr = (const GAS f32x4*)g + lane;
    GAS unsigned long long* o8 = (GAS unsigned long long*)orow + lane;
#pragma unroll
    for (int j = 0; j < 8; ++j) { const f32x4 gg = gr[64 * j]; o8[64 * j] = (unsigned long long)pk2(v[j][0] * r * gg[0], v[j][1] * r * gg[1]) | ((unsigned long long)pk2(v[j][2] * r * gg[2], v[j][3] * r * gg[3]) << 32); }
}
__device__ __forceinline__ void rms_row_to_i8(const float* xrow, const float* g, unsigned char* orow, float* sa, int lane) {
    const GAS f32x4* xr = (const GAS f32x4*)xrow + lane; f32x4 v[8]; float s = 0.f;
#pragma unroll
    for (int j = 0; j < 8; ++j) { v[j] = xr[64 * j]; s += (v[j][0] * v[j][0] + v[j][1] * v[j][1]) + (v[j][2] * v[j][2] + v[j][3] * v[j][3]); }
    const float r = __builtin_amdgcn_rsqf(wave_sum(s) * (1.0f / D) + EPS);
    const GAS f32x4* gr = (const GAS f32x4*)g + lane; float mx = 0.f;
#pragma unroll
    for (int j = 0; j < 8; ++j) { v[j] = v[j] * gr[64 * j] * r; mx = fmaxf(mx, fmaxf(fmaxf(fabsf(v[j][0]), fabsf(v[j][1])), fmaxf(fabsf(v[j][2]), fabsf(v[j][3])))); }
#pragma unroll
    for (int o = 1; o < 64; o <<= 1) mx = fmaxf(mx, __shfl_xor(mx, o));
    const float inv = mx > 0.f ? 127.0f / mx : 0.f;
    GAS unsigned* o4 = (GAS unsigned*)orow + lane;
#pragma unroll
    for (int j = 0; j < 8; ++j) { unsigned w = 0;
#pragma unroll
        for (int e = 0; e < 4; ++e) w |= (__float_as_uint(__builtin_fmaf(v[j][e], inv, 12582912.0f)) & 255u) << (8 * e);
        o4[64 * j] = w; }
    if (lane == 0) *sa = mx * (1.0f / (127.0f * 127.0f));
}
__device__ __forceinline__ void rms_row_to_f8(const float* xrow, const float* g, unsigned char* orow, int lane) {
    const GAS f32x4* xr = (const GAS f32x4*)xrow + lane; f32x4 v[8]; float s = 0.f;
#pragma unroll
    for (int j = 0; j < 8; ++j) { v[j] = xr[64 * j]; s += (v[j][0] * v[j][0] + v[j][1] * v[j][1]) + (v[j][2] * v[j][2] + v[j][3] * v[j][3]); }
    const float r = __builtin_amdgcn_rsqf(wave_sum(s) * (1.0f / D) + EPS);
    const GAS f32x4* gr = (const GAS f32x4*)g + lane;
    GAS unsigned* o4 = (GAS unsigned*)orow + lane;
#pragma unroll
    for (int j = 0; j < 8; ++j) { const f32x4 q = v[j] * gr[64 * j] * r; int x = __builtin_amdgcn_cvt_pk_fp8_f32(q[0], q[1], 0, false); x = __builtin_amdgcn_cvt_pk_fp8_f32(q[2], q[3], x, true); o4[64 * j] = (unsigned)x; }
}
__device__ __forceinline__ void p0_fold_item(const float* wq, const float* sk, bf16* WP, LAS float* lds, int item, int tid, const float* kgain) {
    const int hp = item >> 5, k0 = (item & 31) * 64;
    LAS float* skT = lds;
    LAS float* wqT = lds + 128 * 132;
    const float* skb = sk + (size_t)hp * 128 * 128;
    { const GAS float* sg = (const GAS float*)skb; const GAS float* wg = (const GAS float*)wq; const GAS float* kg = (const GAS float*)kgain; float v[32], w[16];
#pragma unroll
      for (int i = 0; i < 32; ++i) v[i] = sg[i * 512 + tid];
#pragma unroll
      for (int i = 0; i < 16; ++i) { const int idx = i * 512 + tid, kk = idx >> 7, d = idx & 127; w[i] = wg[(size_t)(k0 + kk) * D + hp * 128 + d] * kg[k0 + kk]; }
#pragma unroll
      for (int i = 0; i < 32; ++i) { const int idx = i * 512 + tid, n = idx >> 7, d = idx & 127; skT[d * 132 + n] = v[i]; }
#pragma unroll
      for (int i = 0; i < 16; ++i) { const int idx = i * 512 + tid, kk = idx >> 7, d = idx & 127; wqT[d * 68 + kk] = w[i]; } }
    __syncthreads();
    const int n0 = (tid >> 4) * 4, kk0 = (tid & 15) * 4;
    float acc[4][4];
#pragma unroll
    for (int i = 0; i < 4; ++i)
#pragma unroll
        for (int j = 0; j < 4; ++j) acc[i][j] = 0.f;
#pragma unroll 4
    for (int d = 0; d < 128; ++d) { const f32x4 a = *(const LAS f32x4*)(skT + d * 132 + n0), b = *(const LAS f32x4*)(wqT + d * 68 + kk0);
#pragma unroll
        for (int i = 0; i < 4; ++i)
#pragma unroll
            for (int j = 0; j < 4; ++j) acc[i][j] += a[i] * b[j]; }
#pragma unroll
    for (int i = 0; i < 4; ++i) { unsigned long long o = (unsigned long long)pk2(acc[i][0], acc[i][1]) | ((unsigned long long)pk2(acc[i][2], acc[i][3]) << 32);
        *(GAS unsigned long long*)(WP + (size_t)(hp * 128 + n0 + i) * D + k0 + kk0) = o; }
    __syncthreads();
}
__device__ __forceinline__ void p0_prologue(const Args& A, Frame& F, const int part) {
    const int gw = F.vcu * NWAVES + F.wave, NGW = F.G * NWAVES;
    const int gtid = gw * 64 + F.lane, gthreads = F.G * NTHREADS;
    unsigned char* ws = A.ws;
    LAS float* scr = (LAS float*)(F.lds + RING_OFF + F.wave * 16384);
    constexpr int I_EVIN = (D / 64) * (EV_N / 32);
    if (part == 1) {
        for (int it = gw; it < I_EVIN; it += NGW) p0_transpose_item_i8(A.in[I_EV_WIN], D, EV_N, (unsigned char*)(ws + WS_WEV_IN), scr, it, F.lane, (const float*)(ws + WS_CMB));
        for (int m = gw; m < T; m += NGW) rms_row_to_i8(A.in[I_X] + (size_t)m * D, A.in[I_NMIX], (unsigned char*)(ws + WS_ACTA) + (size_t)m * D, (float*)(ws + WS_SA) + m, F.lane);
        return; }
    { constexpr int I_CM = (D / 64) * ((EV_N + 255) / 256);
      for (int it = gw; it < I_CM; it += NGW) colmax_item(A.in[I_EV_WIN], D, EV_N, (float*)(ws + WS_CMB), it, F.lane); }
    { GAS v4u* z0 = (GAS v4u*)(ws + WS_WEV_IN + (size_t)EV_N * D); const size_t n0 = (size_t)(EV_NP - EV_N) * D / 16;
      for (size_t i = gtid; i < n0; i += gthreads) z0[i] = (v4u){0u, 0u, 0u, 0u}; }
    { constexpr int I_PJ = (256 / 64) * (D / 32);
      for (int it = gw; it < 2 * I_PJ; it += NGW) { const int L = it / I_PJ; p0_transpose_item(A.in[I_PLE_WP] + (size_t)L * 256 * D, 256, D, (bf16*)(ws + WS_WPROJ) + (size_t)L * D * 256, scr, it % I_PJ, F.lane); } }
    if (F.G < 256) cvt_f32_bf16(A.in[I_P], (bf16*)(ws + WS_PBF), (size_t)2 * T * 256, gtid, gthreads);
#if EV_F8_T1 > EV_F8_T0
    for (int it = gw; it < I_EVIN; it += NGW) p0_transpose_item_f8(A.in[I_EV_WIN], D, EV_N, (unsigned char*)(ws + WS_O), scr, it, F.lane);
    { GAS v4u* z0 = (GAS v4u*)(ws + WS_O + (size_t)EV_N * D); const size_t n0 = (size_t)(EV_NP - EV_N) * D / 16;
      for (size_t i = gtid; i < n0; i += gthreads) z0[i] = (v4u){0u, 0u, 0u, 0u}; }
    for (int m = gw; m < T; m += NGW) rms_row_to_f8(A.in[I_X] + (size_t)m * D, A.in[I_NMIX], (unsigned char*)(ws + WS_H1) + (size_t)m * D, F.lane);
#endif
}
__device__ __forceinline__ void p0_deferred(const Args& A, Frame& F, int wg, int nwg) {
    const int gw = wg * NWAVES + F.wave, NGW = nwg * NWAVES;
    int gtid = gw * 64 + F.lane; const int gthreads = nwg * NTHREADS;
    asm volatile("" : "+v"(gtid));
    unsigned char* ws = A.ws;
    {
        LAS float* scr = (LAS float*)(F.lds + RING_OFF + F.wave * 16384);
        constexpr int I_SQ = (D / 64) * (D / 32), I_ODIN = (D / 64) * (OD_N / 32);
        constexpr int NITEMS = I_SQ + I_ODIN + I_SQ;
        for (int it = gw; it < NITEMS; it += NGW) {
            int r = it;
            if (r < I_SQ) { p0_transpose_item(A.in[I_EV_WOUT], D, D, (bf16*)(ws + WS_WEV_OUT), scr, r, F.lane); continue; } r -= I_SQ;
            if (r < I_ODIN) { p0_transpose_item_f8(A.in[I_OD_WIN], D, OD_N, (unsigned char*)(ws + WS_WOD_IN), scr, r, F.lane, A.in[I_NMIX] + D); continue; } r -= I_ODIN;
            p0_transpose_item_f8(A.in[I_PLE_WG], D, D, (unsigned char*)(ws + WS_WGATE), scr, r, F.lane, A.in[I_NPLE]);
        }
        { GAS v4u* z1 = (GAS v4u*)(ws + WS_WOD_IN + (size_t)OD_N * D); const size_t n1 = (size_t)(OD_NP - OD_N) * D / 16;
          for (size_t i = gtid; i < n1; i += gthreads) z1[i] = (v4u){0u, 0u, 0u, 0u}; }
    }
    __syncthreads();
    for (int it = wg; it < 512; it += nwg)
        p0_fold_item(A.in[I_PEER_WQ], A.in[I_PEER_SK], (bf16*)(ws + WS_WPEER), (LAS float*)(F.lds + RING_OFF), it, F.tid, A.in[I_NFFN]);
    cvt_rows_i8(A.in[I_PEER_U], (unsigned char*)(ws + WS_TABU), (float*)(ws + WS_SU), 16384, gw, NGW, F.lane, A.in[I_NFFN]);
    cvt_rows_i8(A.in[I_PEER_V], (unsigned char*)(ws + WS_TABV), (float*)(ws + WS_SU) + 32768, 16384, gw, NGW, F.lane, nullptr);
    { bf16* LB = (bf16*)(ws + WS_WLORA); const float* w2 = A.in[I_W2]; const float* a2 = A.in[I_A2]; const float* g2 = A.in[I_G2];
      for (int i = gtid; i < LORA_N * LORA_K / 2; i += gthreads) { const int row = i / (LORA_K / 2), col = (i % (LORA_K / 2)) * 2; float v[2];
#pragma unroll
          for (int e = 0; e < 2; ++e) { const int c = col + e; float x = 0.f;
              if (row < 1024) { if (c < 96) x = w2[c * 1024 + row]; }
              else if (row < 2048) { if (c >= 96 && c < 192) x = a2[(c - 96) * 1024 + (row - 1024)]; }
              else { if (c >= 192 && c < 448) x = g2[(c - 192) * 1024 + (row - 2048)]; }
              v[e] = x; }
          *(GAS unsigned*)(LB + (size_t)row * LORA_K + col) = pk2(v[0], v[1]); } }
}
__device__ __forceinline__ void p1_deferred(const Args& A, Frame& F, int wg, int nwg) {
    const int gw = wg * NWAVES + F.wave, NGW = nwg * NWAVES;
    int gtid = gw * 64 + F.lane; const int gthreads = nwg * NTHREADS;
    asm volatile("" : "+v"(gtid));
    unsigned char* ws = A.ws;
    { LAS float* scr = (LAS float*)(F.lds + RING_OFF + F.wave * 16384); constexpr int I_SQ = (D / 64) * (D / 32);
      for (int it = gw; it < 2 * I_SQ; it += NGW) {
          if (it < I_SQ) p0_transpose_item_f8(A.in[I_OD_WOUT], D, D, (unsigned char*)(ws + WS_WOD_OUT), scr, it, F.lane);
          else p0_transpose_item_f8(A.in[I_PLE_WG] + (size_t)D * D, D, D, (unsigned char*)((bf16*)(ws + WS_WGATE) + (size_t)D * D), scr, it - I_SQ, F.lane, A.in[I_NPLE] + D); } }
    __syncthreads();
    for (int it = wg; it < 512; it += nwg)
        p0_fold_item(A.in[I_PEER_WQ] + (size_t)D * D, A.in[I_PEER_SK] + (size_t)16 * 128 * 128, (bf16*)(ws + WS_WPEER) + (size_t)D * D, (LAS float*)(F.lds + RING_OFF), it, F.tid, A.in[I_NFFN] + D);
    cvt_rows_i8(A.in[I_PEER_U] + (size_t)16384 * D, (unsigned char*)(ws + WS_TABU) + (size_t)16384 * D, (float*)(ws + WS_SU) + 16384, 16384, gw, NGW, F.lane, A.in[I_NFFN] + D);
    cvt_rows_i8(A.in[I_PEER_V] + (size_t)16384 * D, (unsigned char*)(ws + WS_TABV) + (size_t)16384 * D, (float*)(ws + WS_SU) + 32768 + 16384, 16384, gw, NGW, F.lane, nullptr);
}

constexpr int TC = 16, NCHUNK = SEQ / TC;

template <int MODE>
__device__ __forceinline__ void scan_gla_unit(const Args& A, Frame& F, int unit) {
    int tid = F.tid; asm volatile("" : "+v"(tid));
    const int lane = tid & 63, w = F.wave;
    int b, h, qcol, kcol, vcol, ocol;
    if (MODE == 0) { b = unit >> 4; h = (unit >> 2) & 3; const int s = unit & 3; qcol = EC_GQ + h * 128; kcol = EC_GK + h * 128; vcol = EC_GV + h * 256 + s * 64; ocol = h * 256 + s * 64; }
    else           { b = unit >> 4; h = (unit >> 1) & 7; const int s = unit & 1; qcol = OC_HQ + h * 128; kcol = OC_HF + h * 128; vcol = OC_HI + h * 128 + s * 64; ocol = h * 128 + s * 64; }
    const bf16* P = (const bf16*)(A.ws + WS_PROJ) + (size_t)b * SEQ * PROJ_LD;
    float* O = (float*)(A.ws + WS_O) + (size_t)b * SEQ * D + ocol;
    LAS float* Lf = (LAS float*)(F.lds + RING_OFF);
    constexpr int BUFSZ = 7168, O_EG = 0, O_K = 2048, O_Q = 4096, O_V = 6144, O_OUT = 2 * BUFSZ, O_W2 = O_OUT + 1024, O_BIAS = O_W2 + 2048;
    const int tl = tid >> 5, dq = (tid & 31) * 4, tlv = tid >> 4, c4 = (tid & 15) * 4;
    float lb[4] = {0.f, 0.f, 0.f, 0.f};
    if (MODE == 0) {
        const float* w2 = A.in[I_GK_W2]; const float* gb = A.in[I_GK_B];
        for (int i = tid; i < 2048; i += NTHREADS) Lf[O_W2 + i] = w2[(i >> 7) * 512 + h * 128 + (i & 127)];
        if (tid < 128) Lf[O_BIAS + tid] = gb[h * 128 + tid];
    } else {
        const float* lg = A.in[I_LB];
#pragma unroll
        for (int i = 0; i < 4; ++i) lb[i] = sigmoidf_(lg[1024 + h * 128 + dq + i] - lg[h * 128 + dq + i]);
    }
    u32x2 rq, rk, rv = {0u, 0u}; v4u rg0 = {0u, 0u, 0u, 0u}, rg1 = {0u, 0u, 0u, 0u};
#define GLA_LOAD(c) do { const bf16* pr = P + (size_t)((c) * TC + tl) * PROJ_LD; rq = *(const GAS u32x2*)(pr + qcol + dq); rk = *(const GAS u32x2*)(pr + kcol + dq); \
        if (MODE == 0) { rg0 = *(const GAS v4u*)(pr + EC_GLR); rg1 = *(const GAS v4u*)(pr + EC_GLR + 8); } \
        if (tid < 256) rv = *(const GAS u32x2*)(P + (size_t)((c) * TC + tlv) * PROJ_LD + vcol + c4); } while (0)
#define GLA_XFORM(bufi) do { LAS float* B_ = Lf + (bufi) * BUFSZ; f32x4 q4, k4, e4; \
        const float xq[4] = {bf_lo(rq.x), bf_hi(rq.x), bf_lo(rq.y), bf_hi(rq.y)}, xk[4] = {bf_lo(rk.x), bf_hi(rk.x), bf_lo(rk.y), bf_hi(rk.y)}; \
        if (MODE == 0) { f32x4 z = *(const LAS f32x4*)(Lf + O_BIAS + dq); \
            const float gl[16] = {bf_lo(rg0.x), bf_hi(rg0.x), bf_lo(rg0.y), bf_hi(rg0.y), bf_lo(rg0.z), bf_hi(rg0.z), bf_lo(rg0.w), bf_hi(rg0.w), \
                                  bf_lo(rg1.x), bf_hi(rg1.x), bf_lo(rg1.y), bf_hi(rg1.y), bf_lo(rg1.z), bf_hi(rg1.z), bf_lo(rg1.w), bf_hi(rg1.w)}; \
            _Pragma("unroll") for (int r_ = 0; r_ < 16; ++r_) { const f32x4 wv = *(const LAS f32x4*)(Lf + O_W2 + r_ * 128 + dq); z = z + wv * gl[r_]; } \
            _Pragma("unroll") for (int i_ = 0; i_ < 4; ++i_) { q4[i_] = xq[i_] * 0.08838834764831845f; k4[i_] = xk[i_]; e4[i_] = __builtin_amdgcn_exp2f(-0.0625f * __builtin_amdgcn_logf(1.0f + __expf(-z[i_]))); } } \
        else { _Pragma("unroll") for (int i_ = 0; i_ < 4; ++i_) { const float fg = lb[i_] + (1.f - lb[i_]) * sigmoidf_(xk[i_]); q4[i_] = siluf_(xq[i_]); k4[i_] = 1.f - fg; e4[i_] = fg; } } \
        *(LAS f32x4*)(B_ + O_EG + tl * 128 + dq) = e4; *(LAS f32x4*)(B_ + O_K + tl * 128 + dq) = k4; *(LAS f32x4*)(B_ + O_Q + tl * 128 + dq) = q4; \
        if (tid < 256) { f32x4 v4 = {bf_lo(rv.x), bf_hi(rv.x), bf_lo(rv.y), bf_hi(rv.y)}; *(LAS f32x4*)(B_ + O_V + tlv * 64 + c4) = v4; } } while (0)
    LBAR();
    GLA_LOAD(0); GLA_XFORM(0);
    LBAR();
    f32x2 S2[8];
#pragma unroll
    for (int i = 0; i < 8; ++i) S2[i] = (f32x2){0.f, 0.f};
    const int j = lane & 15, col = w * 8 + (lane >> 4) * 2;
    for (int c = 0; c < NCHUNK; ++c) {
        if (c + 1 < NCHUNK) GLA_LOAD(c + 1);
        const LAS float* B_ = Lf + (c & 1) * BUFSZ;
        float os0 = 0.f, os1 = 0.f;
        f32x4 e0, e1, k0, k1, q0, q1, ne0, ne1, nk0, nk1, nq0, nq1; f32x2 v2, nv2;
#define GLA_LDSTEP(t_, E0, E1, K0, K1, Q0, Q1, V2) do { E0 = *(const LAS f32x4*)(B_ + O_EG + (t_) * 128 + 4 * j); E1 = *(const LAS f32x4*)(B_ + O_EG + (t_) * 128 + 64 + 4 * j); \
            K0 = *(const LAS f32x4*)(B_ + O_K + (t_) * 128 + 4 * j); K1 = *(const LAS f32x4*)(B_ + O_K + (t_) * 128 + 64 + 4 * j); \
            Q0 = *(const LAS f32x4*)(B_ + O_Q + (t_) * 128 + 4 * j); Q1 = *(const LAS f32x4*)(B_ + O_Q + (t_) * 128 + 64 + 4 * j); V2 = *(const LAS f32x2*)(B_ + O_V + (t_) * 64 + col); } while (0)
        GLA_LDSTEP(0, e0, e1, k0, k1, q0, q1, v2);
#pragma unroll
        for (int t = 0; t < TC; ++t) {
            if (t + 1 < TC) { GLA_LDSTEP(t + 1, ne0, ne1, nk0, nk1, nq0, nq1, nv2); }
            __builtin_amdgcn_sched_barrier(0);
            f32x2 pa = {0.f, 0.f}, pb = {0.f, 0.f};
#pragma unroll
            for (int i = 0; i < 4; ++i) {
                S2[i] = S2[i] * e0[i] + v2 * k0[i]; S2[4 + i] = S2[4 + i] * e1[i] + v2 * k1[i];
                pa += S2[i] * q0[i]; pb += S2[4 + i] * q1[i]; }
            pa += pb;
            float p0 = pa[0], p1 = pa[1];
            row_sum16_x2(p0, p1);
            os0 = (j == t) ? p0 : os0; os1 = (j == t) ? p1 : os1;
            e0 = ne0; e1 = ne1; k0 = nk0; k1 = nk1; q0 = nq0; q1 = nq1; v2 = nv2;
        }
#undef GLA_LDSTEP
        { f32x2 o2 = {os0, os1}; *(LAS f32x2*)(Lf + O_OUT + j * 64 + col) = o2; }
        if (c + 1 < NCHUNK) GLA_XFORM((c + 1) & 1);
        LBAR();
        if (tid < 256) *(GAS f32x4*)(O + (size_t)(c * TC + tlv) * D + c4) = *(const LAS f32x4*)(Lf + O_OUT + tlv * 64 + c4);
        LBAR();
    }
#undef GLA_LOAD
#undef GLA_XFORM
}

__device__ __forceinline__ void scan_gdn_unit(const Args& A, Frame& F, int unit) {
    int tid = F.tid; asm volatile("" : "+v"(tid));
    const int lane = tid & 63, w = F.wave;
    const int b = unit >> 4, h = (unit >> 1) & 7, s = unit & 1;
    const int qcol = EC_BQ + h * 128, kcol = EC_BK + h * 128, vcol = EC_BV + h * 128 + s * 64, ocol = 1024 + h * 128 + s * 64;
    const bf16* P = (const bf16*)(A.ws + WS_PROJ) + (size_t)b * SEQ * PROJ_LD;
    float* O = (float*)(A.ws + WS_O) + (size_t)b * SEQ * D + ocol;
    LAS float* Lf = (LAS float*)(F.lds + RING_OFF);
    constexpr int BUFSZ = 5184, O_K = 0, O_Q = 2048, O_V = 4096, O_SC = 5120, O_OUT = 2 * BUFSZ, O_CW = O_OUT + 1024;
    const int tl = tid >> 5, dq = (tid & 31) * 4, tlv = tid >> 4, c4 = (tid & 15) * 4;
    { const float* cw = A.in[I_GDN_CONV];
      for (int i = tid; i < 4 * 320; i += NTHREADS) { const int jt = i / 320, x = i % 320;
          const int ch = x < 128 ? (h * 128 + x) : x < 256 ? (1024 + h * 128 + (x - 128)) : (2048 + h * 128 + s * 64 + (x - 256));
          Lf[O_CW + i] = cw[jt * 3072 + ch]; } }
    const float neg_ea = -__expf(A.in[I_GDN_ALOG][h]), dtb = A.in[I_GDN_DTB][h];
    u32x2 rq[4], rk[4], rv[4]; unsigned short rba = 0, rbb = 0;
#pragma unroll
    for (int i = 0; i < 4; ++i) rv[i] = (u32x2){0u, 0u};
#define GDN_LOAD(c) do { const int t_ = (c) * TC + tl; \
        _Pragma("unroll") for (int jt = 0; jt < 4; ++jt) { const int tt = t_ - 3 + jt; \
            if (tt >= 0) { const bf16* pr = P + (size_t)tt * PROJ_LD; rq[jt] = *(const GAS u32x2*)(pr + qcol + dq); rk[jt] = *(const GAS u32x2*)(pr + kcol + dq); } \
            else { rq[jt] = (u32x2){0u, 0u}; rk[jt] = (u32x2){0u, 0u}; } } \
        { const bf16* pr = P + (size_t)t_ * PROJ_LD; rba = pr[EC_BA + h]; rbb = pr[EC_BB + h]; } \
        if (tid < 256) { const int tv = (c) * TC + tlv; \
            _Pragma("unroll") for (int jt = 0; jt < 4; ++jt) { const int tt = tv - 3 + jt; \
                if (tt >= 0) rv[jt] = *(const GAS u32x2*)(P + (size_t)tt * PROJ_LD + vcol + c4); else rv[jt] = (u32x2){0u, 0u}; } } } while (0)
#define GDN_XFORM(bufi) do { LAS float* B_ = Lf + (bufi) * BUFSZ; f32x4 q4 = {0.f, 0.f, 0.f, 0.f}, k4 = {0.f, 0.f, 0.f, 0.f}; \
        _Pragma("unroll") for (int jt = 0; jt < 4; ++jt) { const f32x4 wq = *(const LAS f32x4*)(Lf + O_CW + jt * 320 + dq), wk = *(const LAS f32x4*)(Lf + O_CW + jt * 320 + 128 + dq); \
            q4[0] += wq[0] * bf_lo(rq[jt].x); q4[1] += wq[1] * bf_hi(rq[jt].x); q4[2] += wq[2] * bf_lo(rq[jt].y); q4[3] += wq[3] * bf_hi(rq[jt].y); \
            k4[0] += wk[0] * bf_lo(rk[jt].x); k4[1] += wk[1] * bf_hi(rk[jt].x); k4[2] += wk[2] * bf_lo(rk[jt].y); k4[3] += wk[3] * bf_hi(rk[jt].y); } \
        float sq = 0.f, sk = 0.f, sqk = 0.f; \
        _Pragma("unroll") for (int i_ = 0; i_ < 4; ++i_) { q4[i_] = siluf_(q4[i_]); k4[i_] = siluf_(k4[i_]); sq += q4[i_] * q4[i_]; sk += k4[i_] * k4[i_]; sqk += q4[i_] * k4[i_]; } \
        sq = half_sum32(sq); sk = half_sum32(sk); sqk = half_sum32(sqk); \
        const float rq_ = __builtin_amdgcn_rsqf(sq + EPS) * 0.08838834764831845f, rk_ = __builtin_amdgcn_rsqf(sk + EPS); \
        q4 = q4 * rq_; k4 = k4 * rk_; \
        *(LAS f32x4*)(B_ + O_K + tl * 128 + dq) = k4; *(LAS f32x4*)(B_ + O_Q + tl * 128 + dq) = q4; \
        if ((tid & 31) == 0) { const float ba = __uint_as_float((unsigned)rba << 16), bb = __uint_as_float((unsigned)rbb << 16); \
            f32x4 sc; sc[0] = __expf(neg_ea * softplusf_(ba + dtb)); sc[1] = sigmoidf_(bb); sc[2] = sqk * rq_ * rk_; sc[3] = 0.f; *(LAS f32x4*)(B_ + O_SC + tl * 4) = sc; } \
        if (tid < 256) { f32x4 v4 = {0.f, 0.f, 0.f, 0.f}; \
            _Pragma("unroll") for (int jt = 0; jt < 4; ++jt) { const f32x4 wv = *(const LAS f32x4*)(Lf + O_CW + jt * 320 + 256 + c4); \
                v4[0] += wv[0] * bf_lo(rv[jt].x); v4[1] += wv[1] * bf_hi(rv[jt].x); v4[2] += wv[2] * bf_lo(rv[jt].y); v4[3] += wv[3] * bf_hi(rv[jt].y); } \
            _Pragma("unroll") for (int i_ = 0; i_ < 4; ++i_) v4[i_] = siluf_(v4[i_]); \
            *(LAS f32x4*)(B_ + O_V + tlv * 64 + c4) = v4; } } while (0)
    LBAR();
    GDN_LOAD(0); GDN_XFORM(0);
    LBAR();
    f32x2 S2[8];
#pragma unroll
    for (int i = 0; i < 8; ++i) S2[i] = (f32x2){0.f, 0.f};
    const int j = lane & 15, col = w * 8 + (lane >> 4) * 2;
    for (int c = 0; c < NCHUNK; ++c) {
        if (c + 1 < NCHUNK) GDN_LOAD(c + 1);
        const LAS float* B_ = Lf + (c & 1) * BUFSZ;
        float os0 = 0.f, os1 = 0.f;
        f32x4 k0, k1, q0, q1, sc, nk0, nk1, nq0, nq1, nsc; f32x2 v2, nv2;
#define GDN_LDSTEP(t_, K0, K1, Q0, Q1, V2, SC) do { K0 = *(const LAS f32x4*)(B_ + O_K + (t_) * 128 + 4 * j); K1 = *(const LAS f32x4*)(B_ + O_K + (t_) * 128 + 64 + 4 * j); \
            Q0 = *(const LAS f32x4*)(B_ + O_Q + (t_) * 128 + 4 * j); Q1 = *(const LAS f32x4*)(B_ + O_Q + (t_) * 128 + 64 + 4 * j); V2 = *(const LAS f32x2*)(B_ + O_V + (t_) * 64 + col); SC = *(const LAS f32x4*)(B_ + O_SC + (t_) * 4); } while (0)
        GDN_LDSTEP(0, k0, k1, q0, q1, v2, sc);
#pragma unroll
        for (int t = 0; t < TC; ++t) {
            if (t + 1 < TC) { GDN_LDSTEP(t + 1, nk0, nk1, nq0, nq1, nv2, nsc); }
            __builtin_amdgcn_sched_barrier(0);
            f32x2 d1 = {0.f, 0.f}, d2 = {0.f, 0.f}, e1 = {0.f, 0.f}, e2 = {0.f, 0.f};
#pragma unroll
            for (int i = 0; i < 4; ++i) { d1 += S2[i] * k0[i]; e1 += S2[4 + i] * k1[i]; d2 += S2[i] * q0[i]; e2 += S2[4 + i] * q1[i]; }
            d1 += e1; d2 += e2;
            { float r0_ = d1[0], r1_ = d1[1], r2_ = d2[0], r3_ = d2[1]; row_sum16_x4(r0_, r1_, r2_, r3_); d1[0] = r0_; d1[1] = r1_; d2[0] = r2_; d2[1] = r3_; }
            const float a = sc[0], beta = sc[1], qk = sc[2];
            const f32x2 dl = (v2 - d1 * a) * beta;
            const f32x2 o2 = d2 * a + dl * qk;
#pragma unroll
            for (int i = 0; i < 4; ++i) { S2[i] = S2[i] * a + dl * k0[i]; S2[4 + i] = S2[4 + i] * a + dl * k1[i]; }
            os0 = (j == t) ? o2[0] : os0; os1 = (j == t) ? o2[1] : os1;
            k0 = nk0; k1 = nk1; q0 = nq0; q1 = nq1; v2 = nv2; sc = nsc;
        }
#undef GDN_LDSTEP
        { f32x2 o2 = {os0, os1}; *(LAS f32x2*)(Lf + O_OUT + j * 64 + col) = o2; }
        if (c + 1 < NCHUNK) GDN_XFORM((c + 1) & 1);
        LBAR();
        if (tid < 256) *(GAS f32x4*)(O + (size_t)(c * TC + tlv) * D + c4) = *(const LAS f32x4*)(Lf + O_OUT + tlv * 64 + c4);
        LBAR();
    }
#undef GDN_LOAD
#undef GDN_XFORM
}

typedef short bf16x4_t __attribute__((ext_vector_type(4)));
__device__ __forceinline__ bf16x8 mk_frag(u32x2 lo, u32x2 hi) { v4u t; t.x = lo.x; t.y = lo.y; t.z = hi.x; t.w = hi.y; return __builtin_bit_cast(bf16x8, t); }
template <int MODE>
__device__ __forceinline__ void scan_gla_mfma_unit(const Args& A, Frame& F, int unit) {
    int tid = F.tid; asm volatile("" : "+v"(tid));
    const int lane = tid & 63, w = F.wave;
    int b, h, qcol, kcol, vcol, ocol;
    if (MODE == 0) { b = unit >> 3; h = (unit >> 1) & 3; const int s = unit & 1; qcol = EC_GQ + h * 128; kcol = EC_GK + h * 128; vcol = EC_GV + h * 256 + s * 128; ocol = h * 256 + s * 128; }
    else           { b = unit >> 3; h = unit & 7; qcol = OC_HQ + h * 128; kcol = OC_HF + h * 128; vcol = OC_HI + h * 128; ocol = h * 128; }
    const bf16* P = (const bf16*)(A.ws + WS_PROJ) + (size_t)b * SEQ * PROJ_LD;
    bf16* O = (bf16*)(A.ws + WS_O) + (size_t)b * SEQ * D + ocol;
    LAS float* Lf = (LAS float*)(F.lds + RING_OFF);
    constexpr int BUFSZ = MODE == 1 ? 10240 : 8192, O_E = 0, O_K = 2048, O_Q = 4096, O_V = 6144, O_Z = 8192, RS = 136,
        O_QB = 2 * BUFSZ, O_KB = O_QB + 1088, O_KT = O_KB + 1088, O_BL = O_KT + 1024, O_AM = O_BL + 128, O_W2 = O_AM + 128, O_BIAS = O_W2 + 2048;
    LAS bf16* QB = (LAS bf16*)(Lf + O_QB); LAS bf16* KB = (LAS bf16*)(Lf + O_KB); LAS bf16* KT = (LAS bf16*)(Lf + O_KT); LAS bf16* AM = (LAS bf16*)(Lf + O_AM);
    const int tl = tid >> 5, dq = (tid & 31) * 4;
    float lb[4] = {0.f, 0.f, 0.f, 0.f};
    if (MODE == 0) {
        const float* w2 = A.in[I_GK_W2]; const float* gb = A.in[I_GK_B];
        for (int i = tid; i < 2048; i += NTHREADS) Lf[O_W2 + i] = w2[(i >> 7) * 512 + h * 128 + (i & 127)];
        if (tid < 128) Lf[O_BIAS + tid] = gb[h * 128 + tid];
    } else {
        const float* lg = A.in[I_LB];
#pragma unroll
        for (int i = 0; i < 4; ++i) lb[i] = sigmoidf_(lg[1024 + h * 128 + dq + i] - lg[h * 128 + dq + i]);
    }
    u32x2 rq, rk, rv, rz = {0u, 0u}; v4u rg0 = {0u, 0u, 0u, 0u}, rg1 = {0u, 0u, 0u, 0u};
#define GM_LOAD(c) do { const bf16* pr = P + (size_t)((c) * TC + tl) * PROJ_LD; rq = *(const GAS u32x2*)(pr + qcol + dq); rk = *(const GAS u32x2*)(pr + kcol + dq); rv = *(const GAS u32x2*)(pr + vcol + dq); \
        if (MODE == 0) { rg0 = *(const GAS v4u*)(pr + EC_GLR); rg1 = *(const GAS v4u*)(pr + EC_GLR + 8); } else rz = *(const GAS u32x2*)(pr + OC_HG + h * 128 + dq); } while (0)
#define GM_XFORM(bufi) do { LAS float* B_ = Lf + (bufi) * BUFSZ; f32x4 q4, k4, e4; \
        const float xq[4] = {bf_lo(rq.x), bf_hi(rq.x), bf_lo(rq.y), bf_hi(rq.y)}, xk[4] = {bf_lo(rk.x), bf_hi(rk.x), bf_lo(rk.y), bf_hi(rk.y)}; \
        if (MODE == 0) { f32x4 z = *(const LAS f32x4*)(Lf + O_BIAS + dq); \
            const float gl[16] = {bf_lo(rg0.x), bf_hi(rg0.x), bf_lo(rg0.y), bf_hi(rg0.y), bf_lo(rg0.z), bf_hi(rg0.z), bf_lo(rg0.w), bf_hi(rg0.w), \
                                  bf_lo(rg1.x), bf_hi(rg1.x), bf_lo(rg1.y), bf_hi(rg1.y), bf_lo(rg1.z), bf_hi(rg1.z), bf_lo(rg1.w), bf_hi(rg1.w)}; \
            _Pragma("unroll") for (int r_ = 0; r_ < 16; ++r_) { const f32x4 wv = *(const LAS f32x4*)(Lf + O_W2 + r_ * 128 + dq); z = z + wv * gl[r_]; } \
            _Pragma("unroll") for (int i_ = 0; i_ < 4; ++i_) { q4[i_] = xq[i_] * 0.08838834764831845f; k4[i_] = xk[i_]; e4[i_] = __builtin_amdgcn_exp2f(-0.0625f * __builtin_amdgcn_logf(1.0f + __expf(-z[i_]))); } } \
        else { _Pragma("unroll") for (int i_ = 0; i_ < 4; ++i_) { const float fg = lb[i_] + (1.f - lb[i_]) * sigmoidf_(xk[i_]); q4[i_] = siluf_(xq[i_]); k4[i_] = 1.f - fg; e4[i_] = fg; } } \
        *(LAS f32x4*)(B_ + O_E + tl * 128 + dq) = e4; *(LAS f32x4*)(B_ + O_K + tl * 128 + dq) = k4; *(LAS f32x4*)(B_ + O_Q + tl * 128 + dq) = q4; \
        { f32x4 v4 = {bf_lo(rv.x), bf_hi(rv.x), bf_lo(rv.y), bf_hi(rv.y)}; *(LAS f32x4*)(B_ + O_V + tl * 128 + dq) = v4; } \
        if (MODE == 1) { f32x4 z4 = {siluf_(bf_lo(rz.x)), siluf_(bf_hi(rz.x)), siluf_(bf_lo(rz.y)), siluf_(bf_hi(rz.y))}; *(LAS f32x4*)(B_ + O_Z + tl * 128 + dq) = z4; } } while (0)
    LBAR();
    GM_LOAD(0); GM_XFORM(0); GM_LOAD(1);
    LBAR();
    f32x4 Sacc[8];
#pragma unroll
    for (int i = 0; i < 8; ++i) Sacc[i] = (f32x4){0.f, 0.f, 0.f, 0.f};
    const int fr = lane & 15, g = lane >> 4, c0 = w * 16;
    LAS float* PART = Lf + O_BIAS + 128;
    unsigned char* Y8 = (unsigned char*)(A.ws + WS_ACTA) + (size_t)b * SEQ * D + ocol;
    float gn = 0.f; f32x4 oprev = {0.f, 0.f, 0.f, 0.f}; float zprev[4] = {0.f, 0.f, 0.f, 0.f};
    if (MODE == 1) gn = A.in[I_HG_NORM][c0 + fr];
#define HG_FINISH(cc) do { const LAS float* pp_ = PART + ((cc) & 1) * 128; \
        _Pragma("unroll") for (int r = 0; r < 4; ++r) { const int t_ = 4 * g + r; const f32x4 p0_ = *(const LAS f32x4*)(pp_ + t_ * 8), p1_ = *(const LAS f32x4*)(pp_ + t_ * 8 + 4); \
            const float s_ = ((p0_[0] + p0_[1]) + (p0_[2] + p0_[3])) + ((p1_[0] + p1_[1]) + (p1_[2] + p1_[3])); const float rt_ = __builtin_amdgcn_rsqf(s_ * (1.0f / 128.0f) + EPS); \
            const float y_ = oprev[r] * rt_ * gn * zprev[r]; \
            Y8[(size_t)((cc) * TC + t_) * D + c0 + fr] = (unsigned char)(__builtin_amdgcn_cvt_pk_fp8_f32(y_, y_, 0, false) & 0xff); } } while (0)
    for (int c = 0; c < NCHUNK; ++c) {
        const LAS float* B_ = Lf + (c & 1) * BUFSZ;
        {
            const int seg = tid >> 7, d = tid & 127;
            float bt = 1.f, ball = 1.f;
#pragma unroll
            for (int t = 0; t < 16; ++t) { const float e = B_[O_E + t * 128 + d]; ball *= e; if (t < 4 * seg) bt = ball; }
            ball = fmaxf(ball, 1e-30f);
            unsigned short kt4[4];
#pragma unroll
            for (int i = 0; i < 4; ++i) { const int t = 4 * seg + i; bt = fmaxf(bt * B_[O_E + t * 128 + d], 1e-30f);
                const float kk = B_[O_K + t * 128 + d], qq = B_[O_Q + t * 128 + d], ib = __builtin_amdgcn_rcpf(bt);
                QB[t * RS + d] = hw_bf(qq * bt); KB[t * RS + d] = hw_bf(kk * ib); kt4[i] = (unsigned short)hw_bf(kk * ball * ib); }
            u32x2 kw; kw.x = (unsigned)kt4[0] | ((unsigned)kt4[1] << 16); kw.y = (unsigned)kt4[2] | ((unsigned)kt4[3] << 16);
            *(LAS u32x2*)(KT + d * 16 + 4 * seg) = kw;
            if (seg == 3) Lf[O_BL + d] = ball;
        }
        LBAR();
        if (MODE == 1 && c > 0) HG_FINISH(c - 1);
        if (w == 0) {
            f32x4 acc = {0.f, 0.f, 0.f, 0.f};
#pragma unroll
            for (int ks = 0; ks < 4; ++ks) { const bf16x8 af = *(const LAS bf16x8*)(QB + fr * RS + 32 * ks + 8 * g), bfm = *(const LAS bf16x8*)(KB + fr * RS + 32 * ks + 8 * g);
                acc = __builtin_amdgcn_mfma_f32_16x16x32_bf16(af, bfm, acc, 0, 0, 0); }
#pragma unroll
            for (int r = 0; r < 4; ++r) { const int t = 4 * g + r, s = fr; AM[t * 16 + s] = hw_bf(s <= t ? acc[r] : 0.f); }
        }
        if (c + 1 < NCHUNK) GM_XFORM((c + 1) & 1);
        if (c + 2 < NCHUNK) GM_LOAD(c + 2);
        LBAR();
        {
            u32x2 vlo; { const float v0 = B_[O_V + (4 * g + 0) * 128 + c0 + fr], v1 = B_[O_V + (4 * g + 1) * 128 + c0 + fr], v2 = B_[O_V + (4 * g + 2) * 128 + c0 + fr], v3 = B_[O_V + (4 * g + 3) * 128 + c0 + fr];
                vlo.x = hw_pk2(v0, v1); vlo.y = hw_pk2(v2, v3); }
            const u32x2 zz = {0u, 0u};
            const bf16x8 vb = mk_frag(vlo, zz);
            f32x4 acco = {0.f, 0.f, 0.f, 0.f};
#pragma unroll
            for (int ks = 0; ks < 4; ++ks) {
                u32x2 slo, shi; slo.x = hw_pk2(Sacc[2 * ks][0], Sacc[2 * ks][1]); slo.y = hw_pk2(Sacc[2 * ks][2], Sacc[2 * ks][3]); shi.x = hw_pk2(Sacc[2 * ks + 1][0], Sacc[2 * ks + 1][1]); shi.y = hw_pk2(Sacc[2 * ks + 1][2], Sacc[2 * ks + 1][3]);
                const bf16x8 sb = mk_frag(slo, shi);
                const u32x2 qlo = *(const LAS u32x2*)(QB + fr * RS + 32 * ks + 4 * g), qhi = *(const LAS u32x2*)(QB + fr * RS + 32 * ks + 16 + 4 * g);
                acco = __builtin_amdgcn_mfma_f32_16x16x32_bf16(mk_frag(qlo, qhi), sb, acco, 0, 0, 0); }
            { const u32x2 alo = *(const LAS u32x2*)(AM + fr * 16 + 4 * g); acco = __builtin_amdgcn_mfma_f32_16x16x32_bf16(mk_frag(alo, zz), vb, acco, 0, 0, 0); }
#pragma unroll
            for (int r = 0; r < 4; ++r) { if (MODE == 0) O[(size_t)(c * TC + 4 * g + r) * D + c0 + fr] = hw_bf(acco[r]); }
            if (MODE == 1) { float q0 = acco[0] * acco[0], q1 = acco[1] * acco[1], q2 = acco[2] * acco[2], q3 = acco[3] * acco[3]; row_sum16_x4(q0, q1, q2, q3);
                if (fr == 0) { LAS float* pw_ = PART + (c & 1) * 128 + (4 * g) * 8 + w; pw_[0] = q0; pw_[8] = q1; pw_[16] = q2; pw_[24] = q3; }
                oprev = acco;
#pragma unroll
                for (int r = 0; r < 4; ++r) zprev[r] = B_[O_Z + (4 * g + r) * 128 + c0 + fr]; }
#pragma unroll
            for (int i = 0; i < 8; ++i) { const f32x4 bl = *(const LAS f32x4*)(Lf + O_BL + 16 * i + 4 * g); const u32x2 klo = *(const LAS u32x2*)(KT + (16 * i + fr) * 16 + 4 * g);
                Sacc[i] = __builtin_amdgcn_mfma_f32_16x16x32_bf16(mk_frag(klo, zz), vb, Sacc[i] * bl, 0, 0, 0); }
        }
        LBAR();
    }
    if (MODE == 1) HG_FINISH(NCHUNK - 1);
#undef HG_FINISH
#undef GM_LOAD
#undef GM_XFORM
}

__device__ __forceinline__ void scan_gdn_mfma_unit(const Args& A, Frame& F, int unit, const int role) {
    int tid = F.tid; asm volatile("" : "+v"(tid));
    const int lane = tid & 63, w = F.wave;
    const int b = unit >> 3, h = unit & 7;
    const int qcol = EC_BQ + h * 128, kcol = EC_BK + h * 128, vcol = EC_BV + h * 128, ocol = 1024 + h * 128;
    const bf16* P = (const bf16*)(A.ws + WS_PROJ) + (size_t)b * SEQ * PROJ_LD;
    bf16* O = (bf16*)(A.ws + WS_O) + (size_t)b * SEQ * D + ocol;
    LAS float* Lf = (LAS float*)(F.lds + RING_OFF);
    constexpr int O_CW = 0, O_AMAT = 1536, O_QKM = O_AMAT + 256, O_TB = O_QKM + 128, O_GL = O_TB + 128, O_BUF0 = O_GL + 64;
    constexpr int BUFSZ = 6208, O_KH = 0, O_QH = 2048, O_VV = 4096, O_SC = 6144;
    constexpr int RS = 136;
    constexpr int O_KHB = O_BUF0 + 2 * BUFSZ, O_QHB = O_KHB + 1088, O_QB = O_QHB + 1088, O_KT = O_QB + 1088, O_WSRC = O_KT + 1024, O_WB = O_WSRC + 2048;
    LAS bf16* KHB = (LAS bf16*)(Lf + O_KHB); LAS bf16* QHB = (LAS bf16*)(Lf + O_QHB); LAS bf16* QB = (LAS bf16*)(Lf + O_QB); LAS bf16* KT = (LAS bf16*)(Lf + O_KT);
    LAS bf16* WB = (LAS bf16*)(Lf + O_WB); LAS bf16* QKM = (LAS bf16*)(Lf + O_QKM); LAS bf16* TB = (LAS bf16*)(Lf + O_TB);
    const int tl = tid >> 5, dq = (tid & 31) * 4;
    { const float* cw = A.in[I_GDN_CONV];
      for (int i = tid; i < 4 * 384; i += NTHREADS) { const int jt = i / 384, x = i % 384; Lf[O_CW + i] = cw[jt * 3072 + (x >> 7) * 1024 + h * 128 + (x & 127)]; } }
    const float neg_ea = -__expf(A.in[I_GDN_ALOG][h]), dtb = A.in[I_GDN_DTB][h];
    u32x2 rq[4], rk[4], rv[4]; unsigned short rba = 0, rbb = 0;
#define GD_LOAD(c) do { const int t_ = (c) * TC + tl; \
        _Pragma("unroll") for (int jt = 0; jt < 4; ++jt) { const int tt = t_ - 3 + jt; const bf16* pr = P + (size_t)(tt < 0 ? 0 : tt) * PROJ_LD + dq; \
            rq[jt] = *(const GAS u32x2*)(pr + qcol); rk[jt] = *(const GAS u32x2*)(pr + kcol); rv[jt] = *(const GAS u32x2*)(pr + vcol); \
            if (tt < 0) { rq[jt] = (u32x2){0u, 0u}; rk[jt] = (u32x2){0u, 0u}; rv[jt] = (u32x2){0u, 0u}; } } \
        { const bf16* pr = P + (size_t)t_ * PROJ_LD; rba = pr[EC_BA + h]; rbb = pr[EC_BB + h]; } } while (0)
#define GD_XFORM(bufi) do { LAS float* B_ = Lf + O_BUF0 + (bufi) * BUFSZ; f32x4 q4 = {0.f, 0.f, 0.f, 0.f}, k4 = {0.f, 0.f, 0.f, 0.f}, v4 = {0.f, 0.f, 0.f, 0.f}; \
        _Pragma("unroll") for (int jt = 0; jt < 4; ++jt) { const f32x4 wq = *(const LAS f32x4*)(Lf + O_CW + jt * 384 + dq), wk = *(const LAS f32x4*)(Lf + O_CW + jt * 384 + 128 + dq), wv = *(const LAS f32x4*)(Lf + O_CW + jt * 384 + 256 + dq); \
            q4[0] += wq[0] * bf_lo(rq[jt].x); q4[1] += wq[1] * bf_hi(rq[jt].x); q4[2] += wq[2] * bf_lo(rq[jt].y); q4[3] += wq[3] * bf_hi(rq[jt].y); \
            k4[0] += wk[0] * bf_lo(rk[jt].x); k4[1] += wk[1] * bf_hi(rk[jt].x); k4[2] += wk[2] * bf_lo(rk[jt].y); k4[3] += wk[3] * bf_hi(rk[jt].y); \
            v4[0] += wv[0] * bf_lo(rv[jt].x); v4[1] += wv[1] * bf_hi(rv[jt].x); v4[2] += wv[2] * bf_lo(rv[jt].y); v4[3] += wv[3] * bf_hi(rv[jt].y); } \
        float sq = 0.f, sk = 0.f; \
        _Pragma("unroll") for (int i_ = 0; i_ < 4; ++i_) { q4[i_] = siluf_(q4[i_]); k4[i_] = siluf_(k4[i_]); v4[i_] = siluf_(v4[i_]); sq += q4[i_] * q4[i_]; sk += k4[i_] * k4[i_]; } \
        row_sum16_x2(sq, sk); sq += __shfl_xor(sq, 16); sk += __shfl_xor(sk, 16); \
        q4 = q4 * (__builtin_amdgcn_rsqf(sq + EPS) * 0.08838834764831845f); k4 = k4 * __builtin_amdgcn_rsqf(sk + EPS); \
        *(LAS f32x4*)(B_ + O_KH + tl * 128 + dq) = k4; *(LAS f32x4*)(B_ + O_QH + tl * 128 + dq) = q4; *(LAS f32x4*)(B_ + O_VV + tl * 128 + dq) = v4; \
        if ((tid & 31) == 0) { const float ba = __uint_as_float((unsigned)rba << 16), bb = __uint_as_float((unsigned)rbb << 16); \
            B_[O_SC + tl] = __expf(neg_ea * softplusf_(ba + dtb)); B_[O_SC + 16 + tl] = sigmoidf_(bb); } } while (0)
    LBAR();
    constexpr int SPLIT = 58;
    const int c_begin = role ? SPLIT : 0, c_end = role ? NCHUNK : SPLIT;
    constexpr int REC = 5408;
    float* STASH = (float*)(A.ws + WS_LA) + (size_t)unit * (NCHUNK - SPLIT) * REC;
    float* STATE = (float*)(A.ws + WS_STATE) + (size_t)unit * 16384;
    gu32* flag = F.ctl + 32768 + unit * 64;
    GD_LOAD(c_begin); GD_XFORM(c_begin & 1); GD_LOAD(c_begin + 1);
    LBAR();
    f32x4 Sacc[8];
#pragma unroll
    for (int i = 0; i < 8; ++i) Sacc[i] = (f32x4){0.f, 0.f, 0.f, 0.f};
    const int fr = lane & 15, g = lane >> 4, c0 = w * 16;
    const u32x2 zz = {0u, 0u};
#define GD_STATE_PART(cc_) do { \
        { \
            bf16x8 sb[4]; \
_Pragma("unroll") \
            for (int ks = 0; ks < 4; ++ks) { u32x2 slo, shi; slo.x = hw_pk2(Sacc[2 * ks][0], Sacc[2 * ks][1]); slo.y = hw_pk2(Sacc[2 * ks][2], Sacc[2 * ks][3]); shi.x = hw_pk2(Sacc[2 * ks + 1][0], Sacc[2 * ks + 1][1]); shi.y = hw_pk2(Sacc[2 * ks + 1][2], Sacc[2 * ks + 1][3]); \
                sb[ks] = mk_frag(slo, shi); } \
            f32x4 accv = accu, acco = {0.f, 0.f, 0.f, 0.f}; \
_Pragma("unroll") \
            for (int ks = 0; ks < 4; ++ks) { \
                const u32x2 wl = *(const LAS u32x2*)(WB + fr * RS + 32 * ks + 4 * g), wh = *(const LAS u32x2*)(WB + fr * RS + 32 * ks + 16 + 4 * g); \
                accv = __builtin_amdgcn_mfma_f32_16x16x32_bf16(mk_frag(wl, wh), sb[ks], accv, 0, 0, 0); \
                const u32x2 ql = *(const LAS u32x2*)(QB + fr * RS + 32 * ks + 4 * g), qh = *(const LAS u32x2*)(QB + fr * RS + 32 * ks + 16 + 4 * g); \
                acco = __builtin_amdgcn_mfma_f32_16x16x32_bf16(mk_frag(ql, qh), sb[ks], acco, 0, 0, 0); } \
            u32x2 vn; vn.x = hw_pk2(accv[0], accv[1]); vn.y = hw_pk2(accv[2], accv[3]); \
            const bf16x8 vnb = mk_frag(vn, zz); \
            acco = __builtin_amdgcn_mfma_f32_16x16x32_bf16(mk_frag(*(const LAS u32x2*)(QKM + fr * 16 + 4 * g), zz), vnb, acco, 0, 0, 0); \
_Pragma("unroll") \
            for (int r = 0; r < 4; ++r) O[(size_t)((cc_) * TC + 4 * g + r) * D + c0 + fr] = hw_bf(acco[r]); \
_Pragma("unroll") \
            for (int i = 0; i < 8; ++i) { const u32x2 klo = *(const LAS u32x2*)(KT + (16 * i + fr) * 16 + 4 * g); \
                Sacc[i] = __builtin_amdgcn_mfma_f32_16x16x32_bf16(mk_frag(klo, zz), vnb, Sacc[i] * glast, 0, 0, 0); } \
        } \
        } while (0)
    for (int c = c_begin; c < c_end; ++c) {
        const LAS float* B_ = Lf + O_BUF0 + (c & 1) * BUFSZ;
        float glast;
        {
            const int seg = tid >> 7, d = tid & 127;
            const f32x4 a0 = *(const LAS f32x4*)(B_ + O_SC), a1 = *(const LAS f32x4*)(B_ + O_SC + 4), a2 = *(const LAS f32x4*)(B_ + O_SC + 8), a3 = *(const LAS f32x4*)(B_ + O_SC + 12);
            const float av[16] = {a0[0], a0[1], a0[2], a0[3], a1[0], a1[1], a1[2], a1[3], a2[0], a2[1], a2[2], a2[3], a3[0], a3[1], a3[2], a3[3]};
            float p = 1.f, gpre = 1.f;
#pragma unroll
            for (int t = 0; t < 16; ++t) { if (t == 4 * seg) gpre = p; p *= av[t]; }
            glast = p;
            unsigned short kt4[4]; float gt = gpre;
#pragma unroll
            for (int i = 0; i < 4; ++i) { const int t = 4 * seg + i; const float at = (seg == 0) ? av[i] : (seg == 1) ? av[4 + i] : (seg == 2) ? av[8 + i] : av[12 + i]; gt *= at; const float beta = B_[O_SC + 16 + t];
                const float kk = B_[O_KH + t * 128 + d], qq = B_[O_QH + t * 128 + d];
                KHB[t * RS + d] = hw_bf(kk); QHB[t * RS + d] = hw_bf(qq); QB[t * RS + d] = hw_bf(qq * gt);
                kt4[i] = (unsigned short)hw_bf(kk * glast * __builtin_amdgcn_rcpf(gt));
                Lf[O_WSRC + t * 128 + d] = kk * (beta * gt);
                if (d == 0) Lf[O_GL + t] = gt; }
            u32x2 kw; kw.x = (unsigned)kt4[0] | ((unsigned)kt4[1] << 16); kw.y = (unsigned)kt4[2] | ((unsigned)kt4[3] << 16);
            *(LAS u32x2*)(KT + d * 16 + 4 * seg) = kw;
        }
        LBAR();
        if (w < 2) {
            const LAS bf16* AS = (w == 0) ? KHB : QHB;
            f32x4 acc = {0.f, 0.f, 0.f, 0.f};
#pragma unroll
            for (int ks = 0; ks < 4; ++ks) { const bf16x8 af = *(const LAS bf16x8*)(AS + fr * RS + 32 * ks + 8 * g), bfm = *(const LAS bf16x8*)(KHB + fr * RS + 32 * ks + 8 * g);
                acc = __builtin_amdgcn_mfma_f32_16x16x32_bf16(af, bfm, acc, 0, 0, 0); }
            const float gs_inv = __builtin_amdgcn_rcpf(Lf[O_GL + fr]);
            if (w == 0) {
                f32x4 N1, M1;
#pragma unroll
                for (int r = 0; r < 4; ++r) { const int t = 4 * g + r; const float gt = Lf[O_GL + t];
                    N1[r] = (fr < t) ? -(B_[O_SC + 16 + t] * acc[r] * gt * gs_inv) : 0.f;
                    M1[r] = (t < fr) ? -(B_[O_SC + 16 + fr] * acc[r] * Lf[O_GL + fr] * __builtin_amdgcn_rcpf(gt)) : 0.f; }
#define XTY(X, Y, C0) __builtin_amdgcn_mfma_f32_16x16x32_bf16(mk_frag((u32x2){hw_pk2(X[0], X[1]), hw_pk2(X[2], X[3])}, zz), mk_frag((u32x2){hw_pk2(Y[0], Y[1]), hw_pk2(Y[2], Y[3])}, zz), C0, 0, 0, 0)
                const f32x4 z4 = {0.f, 0.f, 0.f, 0.f};
                f32x4 T1t = M1;
#pragma unroll
                for (int r = 0; r < 4; ++r) if (4 * g + r == fr) T1t[r] += 1.f;
                const f32x4 N2 = XTY(M1, N1, z4), M2 = XTY(N1, M1, z4);
                const f32x4 T2t = XTY(N2, T1t, T1t);
                const f32x4 N4 = XTY(M2, N2, z4), M4 = XTY(N2, M2, z4);
                const f32x4 T4t = XTY(N4, T2t, T2t);
                const f32x4 N8 = XTY(M4, N4, z4);
                const f32x4 T8t = XTY(N8, T4t, T4t);
#undef XTY
                u32x2 tw; tw.x = hw_pk2(T8t[0], T8t[1]); tw.y = hw_pk2(T8t[2], T8t[3]);
                *(LAS u32x2*)(TB + fr * 16 + 4 * g) = tw;
            } else {
#pragma unroll
                for (int r = 0; r < 4; ++r) { const int t = 4 * g + r; QKM[t * 16 + fr] = hw_bf((fr <= t) ? acc[r] * Lf[O_GL + t] * gs_inv : 0.f); }
            }
        }
        if (c + 1 < c_end) GD_XFORM((c + 1) & 1);
        if (c + 2 < c_end) GD_LOAD(c + 2);
        LBAR();
        f32x4 accu = {0.f, 0.f, 0.f, 0.f};
        {
            const bf16x8 tf = mk_frag(*(const LAS u32x2*)(TB + fr * 16 + 4 * g), zz);
            u32x2 ulo, wlo;
            { const float b0 = B_[O_SC + 16 + 4 * g + 0], b1 = B_[O_SC + 16 + 4 * g + 1], b2 = B_[O_SC + 16 + 4 * g + 2], b3 = B_[O_SC + 16 + 4 * g + 3];
              ulo.x = hw_pk2(b0 * B_[O_VV + (4 * g + 0) * 128 + c0 + fr], b1 * B_[O_VV + (4 * g + 1) * 128 + c0 + fr]); ulo.y = hw_pk2(b2 * B_[O_VV + (4 * g + 2) * 128 + c0 + fr], b3 * B_[O_VV + (4 * g + 3) * 128 + c0 + fr]);
              wlo.x = hw_pk2(Lf[O_WSRC + (4 * g + 0) * 128 + c0 + fr], Lf[O_WSRC + (4 * g + 1) * 128 + c0 + fr]); wlo.y = hw_pk2(Lf[O_WSRC + (4 * g + 2) * 128 + c0 + fr], Lf[O_WSRC + (4 * g + 3) * 128 + c0 + fr]); }
            accu = __builtin_amdgcn_mfma_f32_16x16x32_bf16(tf, mk_frag(ulo, zz), accu, 0, 0, 0);
            f32x4 accw = {0.f, 0.f, 0.f, 0.f};
            accw = __builtin_amdgcn_mfma_f32_16x16x32_bf16(tf, mk_frag(wlo, zz), accw, 0, 0, 0);
#pragma unroll
            for (int r = 0; r < 4; ++r) WB[(4 * g + r) * RS + c0 + fr] = hw_bf(-accw[r]);
        }
        LBAR();
        if (role == 0) {
            GD_STATE_PART(c);
        } else {
            float* rec = STASH + (size_t)(c - c_begin) * REC;
            for (int i = tid; i < 832; i += NTHREADS) { const int o = i < 528 ? O_QB + 4 * i : (i < 800 ? O_WB + 4 * (i - 528) : O_QKM + 4 * (i - 800)); *(GAS f32x4*)(rec + 4 * i) = *(const LAS f32x4*)(Lf + o); }
#pragma unroll
            for (int r = 0; r < 4; ++r) rec[3328 + (w * 4 + r) * 64 + lane] = accu[r];
            if (tid == 0) rec[5376] = glast;
        }
        LBAR();
    }
    if (role == 0) {
#pragma unroll
        for (int i = 0; i < 8; ++i)
#pragma unroll
            for (int r = 0; r < 4; ++r) STATE[((w * 8 + i) * 4 + r) * 64 + lane] = Sacc[i][r];
        asm volatile("s_waitcnt vmcnt(0)" ::: "memory");
        __syncthreads();
        if (tid == 0) { __builtin_amdgcn_fence(__ATOMIC_RELEASE, "agent"); asm volatile("s_waitcnt vmcnt(0)" ::: "memory"); __hip_atomic_store(flag, 1u, __ATOMIC_RELAXED, __HIP_MEMORY_SCOPE_AGENT); }
    } else {
        if (tid == 0) { unsigned sp = 0; while (__hip_atomic_load(flag, __ATOMIC_RELAXED, __HIP_MEMORY_SCOPE_AGENT) == 0u) { __builtin_amdgcn_s_sleep(8); if (++sp > (1u << 22)) break; }
            __builtin_amdgcn_fence(__ATOMIC_ACQUIRE, "agent"); asm volatile("s_waitcnt vmcnt(0)" ::: "memory"); }
        __syncthreads();
#pragma unroll
        for (int i = 0; i < 8; ++i)
#pragma unroll
            for (int r = 0; r < 4; ++r) Sacc[i][r] = STATE[((w * 8 + i) * 4 + r) * 64 + lane];
        f32x4 pa, pb; f32x4 pu; float pg;
#define GD_REC_LOAD(cc) do { const float* rec = STASH + (size_t)((cc) - c_begin) * REC; pa = *(const GAS f32x4*)(rec + 4 * tid); pb = (tid < 320) ? *(const GAS f32x4*)(rec + 4 * (tid + 512)) : (f32x4){0.f, 0.f, 0.f, 0.f}; \
            _Pragma("unroll") for (int r = 0; r < 4; ++r) pu[r] = rec[3328 + (w * 4 + r) * 64 + lane]; pg = rec[5376]; } while (0)
        GD_REC_LOAD(c_begin);
        for (int c = c_begin; c < c_end; ++c) {
            { const int i0 = tid, o0 = i0 < 528 ? O_QB + 4 * i0 : O_WB + 4 * (i0 - 528); *(LAS f32x4*)(Lf + o0) = pa;
              if (tid < 320) { const int i1 = tid + 512; const int o1 = i1 < 528 ? O_QB + 4 * i1 : (i1 < 800 ? O_WB + 4 * (i1 - 528) : O_QKM + 4 * (i1 - 800)); *(LAS f32x4*)(Lf + o1) = pb; } }
            const f32x4 accu = pu; const float glast = pg;
            if (c + 1 < c_end) GD_REC_LOAD(c + 1);
            LBAR();
            GD_STATE_PART(c);
            LBAR();
        }
#undef GD_REC_LOAD
    }
#undef GD_STATE_PART
#undef GD_LOAD
#undef GD_XFORM
}

__device__ __forceinline__ void scan_rwkv_unit(const Args& A, Frame& F, int unit) {
    int tid = F.tid; asm volatile("" : "+v"(tid));
    const int lane = tid & 63, w = F.wave;
    const int b = unit >> 4, h = unit & 15;
    const bf16* P = (const bf16*)(A.ws + WS_PROJ) + (size_t)b * SEQ * PROJ_LD + OC_RW;
    const bf16* LO = (const bf16*)(A.ws + WS_LO) + (size_t)b * SEQ * LORA_N;
    bf16* Y = (bf16*)(A.ws + WS_ACTA) + (size_t)b * SEQ * D + 1024 + h * 64;
    LAS float* Lf = (LAS float*)(F.lds + RING_OFF);
    constexpr int BUFSZ = 6208, O_KK = 0, O_WR = 1024, O_W = 2048, O_NKA = 3072, O_K = 4096, O_V = 5120, O_SC = 6144, O_OUT = 2 * BUFSZ;
    const int tl = tid >> 5, d2 = (tid & 31) * 2, hd = h * 64 + d2;
    float mu_r[2], mu_k[2], mu_v[2], w0[2], a0[2], k_k[2], k_a[2], r_k[2], lnw[2], lnb[2];
#pragma unroll
    for (int i = 0; i < 2; ++i) { mu_r[i] = A.in[I_MU][RW_R + hd + i]; mu_k[i] = A.in[I_MU][RW_K + hd + i]; mu_v[i] = A.in[I_MU][RW_V + hd + i];
        w0[i] = A.in[I_W0][hd + i]; a0[i] = A.in[I_A0][hd + i]; k_k[i] = A.in[I_KK][hd + i]; k_a[i] = A.in[I_KA][hd + i]; r_k[i] = A.in[I_RK][hd + i];
        lnw[i] = A.in[I_LNW][hd + i]; lnb[i] = A.in[I_LNB][hd + i]; }
    unsigned rr[2], rk[2], rv[2], rlw, rla, rg_cur = 0u, rg_nxt = 0u;
#define RW_LOAD(c) do { const int t_ = (c) * TC + tl; const bf16* pr = P + (size_t)t_ * PROJ_LD; \
        rr[0] = *(const GAS unsigned*)(pr + RW_R + hd); rk[0] = *(const GAS unsigned*)(pr + RW_K + hd); rv[0] = *(const GAS unsigned*)(pr + RW_V + hd); \
        if (t_ > 0) { rr[1] = *(const GAS unsigned*)(pr - PROJ_LD + RW_R + hd); rk[1] = *(const GAS unsigned*)(pr - PROJ_LD + RW_K + hd); rv[1] = *(const GAS unsigned*)(pr - PROJ_LD + RW_V + hd); } \
        else { rr[1] = 0u; rk[1] = 0u; rv[1] = 0u; } \
        const bf16* lr = LO + (size_t)t_ * LORA_N; rlw = *(const GAS unsigned*)(lr + hd); rla = *(const GAS unsigned*)(lr + 1024 + hd); rg_nxt = *(const GAS unsigned*)(lr + 2048 + hd); } while (0)
#define RW_XFORM(bufi) do { LAS float* B_ = Lf + (bufi) * BUFSZ; f32x2 kk2, wr2, w2_, nka2, k2, v2_; float skk = 0.f, sc1 = 0.f, sc2 = 0.f, sbs = 0.f; float aa[2], rrv[2]; \
        _Pragma("unroll") for (int i_ = 0; i_ < 2; ++i_) { \
            const float r0 = i_ ? bf_hi(rr[0]) : bf_lo(rr[0]), r1 = i_ ? bf_hi(rr[1]) : bf_lo(rr[1]); \
            const float k0_ = i_ ? bf_hi(rk[0]) : bf_lo(rk[0]), k1_ = i_ ? bf_hi(rk[1]) : bf_lo(rk[1]); \
            const float v0_ = i_ ? bf_hi(rv[0]) : bf_lo(rv[0]), v1_ = i_ ? bf_hi(rv[1]) : bf_lo(rv[1]); \
            const float lw = i_ ? bf_hi(rlw) : bf_lo(rlw), la = i_ ? bf_hi(rla) : bf_lo(rla); \
            const float r_ = r0 + (r1 - r0) * mu_r[i_], kx = k0_ + (k1_ - k0_) * mu_k[i_], vx = v0_ + (v1_ - v0_) * mu_v[i_]; \
            const float wd = __expf(-0.6065306597126334f * sigmoidf_(w0[i_] + lw)); const float a_ = sigmoidf_(a0[i_] + la); \
            const float kk0 = kx * k_k[i_]; const float km = kx * (1.f + (a_ - 1.f) * k_a[i_]); \
            kk2[i_] = kk0; skk += kk0 * kk0; aa[i_] = a_; rrv[i_] = r_; wr2[i_] = wd * r_; w2_[i_] = wd; k2[i_] = km; v2_[i_] = vx; sc2 += km * r_; sbs += r_ * km * r_k[i_]; } \
        skk = half_sum32(skk); const float rkk = __builtin_amdgcn_rsqf(skk + EPS); \
        _Pragma("unroll") for (int i_ = 0; i_ < 2; ++i_) { kk2[i_] *= rkk; nka2[i_] = -(kk2[i_] * aa[i_]); sc1 += kk2[i_] * aa[i_] * rrv[i_]; } \
        sc1 = half_sum32(sc1); sc2 = half_sum32(sc2); sbs = half_sum32(sbs); \
        *(LAS f32x2*)(B_ + O_KK + tl * 64 + d2) = kk2; *(LAS f32x2*)(B_ + O_WR + tl * 64 + d2) = wr2; *(LAS f32x2*)(B_ + O_W + tl * 64 + d2) = w2_; \
        *(LAS f32x2*)(B_ + O_NKA + tl * 64 + d2) = nka2; *(LAS f32x2*)(B_ + O_K + tl * 64 + d2) = k2; *(LAS f32x2*)(B_ + O_V + tl * 64 + d2) = v2_; \
        if ((tid & 31) == 0) { f32x4 sc; sc[0] = sc1; sc[1] = sc2; sc[2] = sbs; sc[3] = 0.f; *(LAS f32x4*)(B_ + O_SC + tl * 4) = sc; } } while (0)
    RW_LOAD(0); RW_XFORM(0); rg_cur = rg_nxt;
    LBAR();
    f32x2 S2[4];
#pragma unroll
    for (int i = 0; i < 4; ++i) S2[i] = (f32x2){0.f, 0.f};
    const int j = lane & 15, col = w * 8 + (lane >> 4) * 2;
    for (int c = 0; c < NCHUNK; ++c) {
        if (c + 1 < NCHUNK) RW_LOAD(c + 1);
        const LAS float* B_ = Lf + (c & 1) * BUFSZ;
        float os0 = 0.f, os1 = 0.f;
        f32x4 kk, wr, ww, nka, kv, sc, nkk, nwr, nww, nnka, nkv, nsc; f32x2 v2, nv2;
#define RW_LDSTEP(t_, KK, WR, WW, NKA, KV, V2, SC) do { KK = *(const LAS f32x4*)(B_ + O_KK + (t_) * 64 + 4 * j); WR = *(const LAS f32x4*)(B_ + O_WR + (t_) * 64 + 4 * j); WW = *(const LAS f32x4*)(B_ + O_W + (t_) * 64 + 4 * j); \
            NKA = *(const LAS f32x4*)(B_ + O_NKA + (t_) * 64 + 4 * j); KV = *(const LAS f32x4*)(B_ + O_K + (t_) * 64 + 4 * j); V2 = *(const LAS f32x2*)(B_ + O_V + (t_) * 64 + col); SC = *(const LAS f32x4*)(B_ + O_SC + (t_) * 4); } while (0)
        RW_LDSTEP(0, kk, wr, ww, nka, kv, v2, sc);
#pragma unroll
        for (int t = 0; t < TC; ++t) {
            if (t + 1 < TC) { RW_LDSTEP(t + 1, nkk, nwr, nww, nnka, nkv, nv2, nsc); }
            __builtin_amdgcn_sched_barrier(0);
            f32x2 d1 = S2[0] * kk[0], d2 = S2[0] * wr[0], e1 = S2[1] * kk[1], e2 = S2[1] * wr[1];
            d1 += S2[2] * kk[2]; d2 += S2[2] * wr[2]; e1 += S2[3] * kk[3]; e2 += S2[3] * wr[3];
            d1 += e1; d2 += e2;
            { float r0_ = d1[0], r1_ = d1[1], r2_ = d2[0], r3_ = d2[1]; row_sum16_x4(r0_, r1_, r2_, r3_); d1[0] = r0_; d1[1] = r1_; d2[0] = r2_; d2[1] = r3_; }
            const f32x2 o2 = d2 - d1 * sc[0] + v2 * sc[1];
#pragma unroll
            for (int i = 0; i < 4; ++i) S2[i] = S2[i] * ww[i] + d1 * nka[i] + v2 * kv[i];
            os0 = (j == t) ? o2[0] : os0; os1 = (j == t) ? o2[1] : os1;
            kk = nkk; wr = nwr; ww = nww; nka = nnka; kv = nkv; v2 = nv2; sc = nsc;
        }
#undef RW_LDSTEP
        { f32x2 o2 = {os0, os1}; *(LAS f32x2*)(Lf + O_OUT + j * 64 + col) = o2; }
        if (c + 1 < NCHUNK) RW_XFORM((c + 1) & 1);
        LBAR();
        {
            const f32x2 o2 = *(const LAS f32x2*)(Lf + O_OUT + tl * 64 + d2); const f32x2 vv = *(const LAS f32x2*)(B_ + O_V + tl * 64 + d2); const float bs = B_[O_SC + tl * 4 + 2];
            const float mean = half_sum32(o2[0] + o2[1]) * (1.0f / 64.0f); const float e0 = o2[0] - mean, e1 = o2[1] - mean;
            const float var = half_sum32(e0 * e0 + e1 * e1) * (1.0f / 64.0f); const float rs = __builtin_amdgcn_rsqf(var + 64e-5f);
            const float y0 = (e0 * rs * lnw[0] + lnb[0] + bs * vv[0]) * bf_lo(rg_cur), y1 = (e1 * rs * lnw[1] + lnb[1] + bs * vv[1]) * bf_hi(rg_cur);
            *(GAS unsigned*)(Y + (size_t)(c * TC + tl) * D + d2) = pk2(y0, y1);
        }
        rg_cur = rg_nxt;
        LBAR();
    }
#undef RW_LOAD
#undef RW_XFORM
}

template <int LAYER>
__device__ __forceinline__ void post_rows(const Args& A, Frame& F) {
    const int gw = F.vcu * NWAVES + F.wave, NGW = F.G * NWAVES, lane = F.lane;
    const bf16* O = (const bf16*)(A.ws + WS_O); const bf16* P = (const bf16*)(A.ws + WS_PROJ); bf16* Y = (bf16*)(A.ws + WS_ACTA);
    for (int m = gw; m < T; m += NGW) {
        const GAS u32x2* orow = (const GAS u32x2*)(O + (size_t)m * D) + lane; const bf16* prow = P + (size_t)m * PROJ_LD;
        constexpr int NJ = LAYER == 0 ? 8 : 4;
        u32x2 ow_[NJ], zw_[NJ]; f32x4 gw_[NJ];
#pragma unroll
        for (int jj = 0; jj < NJ; ++jj) { const bool wide = (LAYER == 0 && jj < 4);
            const int zcol = LAYER == 0 ? (wide ? EC_GZ + jj * 256 + 4 * lane : EC_BZ + (jj - 4) * 256 + 4 * lane) : OC_HG + jj * 256 + 4 * lane;
            const float* gsrc = LAYER == 0 ? (wide ? A.in[I_GLA_NORM] : A.in[I_GDN_NORM]) : A.in[I_HG_NORM];
            ow_[jj] = orow[64 * jj]; zw_[jj] = *(const GAS u32x2*)(prow + zcol); gw_[jj] = *(const GAS f32x4*)(gsrc + (wide ? 4 * lane : 4 * (lane & 31))); }
        u32x2 yo_[NJ];
#pragma unroll
        for (int jj = 0; jj < NJ; ++jj) {
            const f32x4 v = {bf_lo(ow_[jj].x), bf_hi(ow_[jj].x), bf_lo(ow_[jj].y), bf_hi(ow_[jj].y)}; float ss = (v[0] * v[0] + v[1] * v[1]) + (v[2] * v[2] + v[3] * v[3]);
            const bool wide = (LAYER == 0 && jj < 4);
            const float ms = wide ? wave_sum(ss) * (1.0f / 256.0f) : half_sum32(ss) * (1.0f / 128.0f);
            const float r = __builtin_amdgcn_rsqf(ms + EPS);
            const f32x4 g = gw_[jj]; const u32x2 zw = zw_[jj];
            const float y0 = v[0] * r * g[0] * siluf_(bf_lo(zw.x)), y1 = v[1] * r * g[1] * siluf_(bf_hi(zw.x)), y2 = v[2] * r * g[2] * siluf_(bf_lo(zw.y)), y3 = v[3] * r * g[3] * siluf_(bf_hi(zw.y));
            if constexpr (LAYER == 1) { int o8 = __builtin_amdgcn_cvt_pk_fp8_f32(y0, y1, 0, false); o8 = __builtin_amdgcn_cvt_pk_fp8_f32(y2, y3, o8, true); yo_[jj].x = (unsigned)o8; yo_[jj].y = 0u; }
            else { yo_[jj].x = pk2(y0, y1); yo_[jj].y = pk2(y2, y3); }
        }
#pragma unroll
        for (int jj = 0; jj < NJ; ++jj) {
            if constexpr (LAYER == 1) *(GAS unsigned*)((unsigned char*)Y + (size_t)m * D + 256 * jj + 4 * lane) = yo_[jj].x;
            else *(GAS u32x2*)(Y + (size_t)m * D + 256 * jj + 4 * lane) = yo_[jj]; }
    }
}
__device__ __forceinline__ void lora_prep_rows(const Args& A, Frame& F) {
    const int gtid = (F.vcu * NWAVES + F.wave) * 64 + F.lane, step = F.G * NWAVES;
    const bf16* P = (const bf16*)(A.ws + WS_PROJ); bf16* LA = (bf16*)(A.ws + WS_LA); const GAS float* mu = (const GAS float*)A.in[I_MU];
    const int gi = gtid & 63;
    if (gi >= 56) { for (int m = gtid >> 6; m < T; m += step) *(GAS v4u*)(LA + (size_t)m * LORA_K + 8 * gi) = (v4u){0u, 0u, 0u, 0u}; return; }
    const f32x4 mua = *(const GAS f32x4*)(mu + RW_WL + 8 * gi), mub = *(const GAS f32x4*)(mu + RW_WL + 8 * gi + 4);
    const float muv[8] = {mua[0], mua[1], mua[2], mua[3], mub[0], mub[1], mub[2], mub[3]};
    const int mode = gi < 12 ? 0 : (gi < 24 ? 1 : 2);
    const float ksc = mode == 0 ? 2.0f : 1.0f;
    for (int m0 = gtid >> 6; m0 < T; m0 += 4 * step) {
        v4u xw[4], pw[4];
#pragma unroll
        for (int k = 0; k < 4; ++k) { const int m = m0 + k * step; xw[k] = (v4u){0u, 0u, 0u, 0u}; pw[k] = xw[k];
            if (m < T) { const GAS bf16* prow = (const GAS bf16*)(P + (size_t)m * PROJ_LD + OC_RW + RW_WL + 8 * gi); xw[k] = *(const GAS v4u*)prow; if ((m % SEQ) != 0) pw[k] = *(const GAS v4u*)(prow - PROJ_LD); } }
#pragma unroll
        for (int k = 0; k < 4; ++k) { const int m = m0 + k * step; if (m >= T) break;
            const unsigned xs[4] = {xw[k].x, xw[k].y, xw[k].z, xw[k].w}, ps[4] = {pw[k].x, pw[k].y, pw[k].z, pw[k].w}; unsigned ow[4];
#pragma unroll
            for (int e2 = 0; e2 < 4; ++e2) { float v2[2];
#pragma unroll
                for (int hf = 0; hf < 2; ++hf) { const float x = hf ? bf_hi(xs[e2]) : bf_lo(xs[e2]), xp = hf ? bf_hi(ps[e2]) : bf_lo(ps[e2]);
                    const float ts = x + (xp - x) * muv[2 * e2 + hf];
                    const float s = __builtin_amdgcn_rcpf(1.0f + __expf(-ksc * ts));
                    v2[hf] = mode == 0 ? 2.0f * s - 1.0f : (mode == 1 ? ts : s); }
                ow[e2] = pk2(v2[0], v2[1]); }
            v4u o; o.x = ow[0]; o.y = ow[1]; o.z = ow[2]; o.w = ow[3];
            *(GAS v4u*)(LA + (size_t)m * LORA_K + 8 * gi) = o; }
    }
}
__device__ __forceinline__ void final_rows(const Args& A, Frame& F, const float oscale, const bf16* Hs) {
    const int gw = F.vcu * NWAVES + F.wave, NGW = F.G * NWAVES, lane = F.lane;
    const float* rowss = (const float*)(A.ws + WS_RSP) + (size_t)RS_FINAL * T * 32; const GAS f32x4* g = (const GAS f32x4*)A.in[I_NFINAL] + lane;
    for (int m = gw; m < T; m += NGW) { const float r = oscale * __builtin_amdgcn_rsqf(wave_sum(lane < 32 ? rowss[(size_t)m * 32 + lane] : 0.f) * (1.0f / D) + EPS); GAS f32x4* row = (GAS f32x4*)(A.out + (size_t)m * D) + lane;
        const GAS u32x2* hrow = (const GAS u32x2*)(Hs + (size_t)m * D) + lane;
        u32x2 hw_[8]; f32x4 g_[8];
#pragma unroll
        for (int jj = 0; jj < 8; ++jj) { hw_[jj] = hrow[64 * jj]; g_[jj] = g[64 * jj]; }
#pragma unroll
        for (int jj = 0; jj < 8; ++jj) { const u32x2 hw = hw_[jj]; const f32x4 v = {bf_lo(hw.x), bf_hi(hw.x), bf_lo(hw.y), bf_hi(hw.y)}; row[64 * jj] = v * r * g_[jj]; } }
}

__device__ __forceinline__ void scan_rwkv_mfma_unit(const Args& A, Frame& F, int unit, const int role) {
    int tid = F.tid; asm volatile("" : "+v"(tid));
    const int lane = tid & 63, w = F.wave;
    const int b = unit >> 3, hp = unit & 7;
    const bf16* P = (const bf16*)(A.ws + WS_PROJ) + (size_t)b * SEQ * PROJ_LD + OC_RW;
    const bf16* LO = (const bf16*)(A.ws + WS_LO) + (size_t)b * SEQ * LORA_N;
    unsigned char* Y = (unsigned char*)(A.ws + WS_ACTA) + (size_t)b * SEQ * D + 1024;
    LAS float* Lf = (LAS float*)(F.lds + RING_OFF);
    constexpr int RS = 72;
    constexpr int O_CONST = 0;
    constexpr int O_XF = 1280;
    constexpr int O_VV = O_XF + 2 * 5 * 1024;
    constexpr int O_BS = O_VV + 4 * 1024;
    constexpr int O_IMG = O_BS + 64;
    constexpr int I_CT = 0, I_BT = 576, I_KL = 1152, I_RT = 1728, I_CF = 2304, I_BTT = 3328, I_KTT = 3840, I_WCB = 4352, I_G1B = 4928, I_TTB = 5056, I_RKB = 5184, I_RBB = 5312, I_W15 = 5440, I_OUT = 5504, IMGSZ = 6528;
    static_assert((O_IMG + 2 * IMGSZ) * 4 <= RING_BYTES, "rwkv lds");
    for (int i = tid; i < 1280; i += NTHREADS) { const int arr = i >> 7, ch = hp * 128 + (i & 127); float v;
        switch (arr) { case 0: v = A.in[I_MU][RW_R + ch]; break; case 1: v = A.in[I_MU][RW_K + ch]; break; case 2: v = A.in[I_MU][RW_V + ch]; break; case 3: v = A.in[I_W0][ch]; break; case 4: v = A.in[I_A0][ch]; break;
                       case 5: v = A.in[I_KK][ch]; break; case 6: v = A.in[I_KA][ch]; break; case 7: v = A.in[I_RK][ch]; break; case 8: v = A.in[I_LNW][ch]; break; default: v = A.in[I_LNB][ch]; break; }
        Lf[O_CONST + i] = v; }
    const int hx = tid >> 8, tl = (tid >> 4) & 15, d4 = (tid & 15) * 4, ch4 = hx * 64 + d4, col4 = hp * 128 + ch4;
    u32x2 rr[2], rk[2], rv[2], rlw, rla, rg_cur = {0u, 0u}, rg_nxt = {0u, 0u}, rg_far = {0u, 0u};
#define RM_LOAD(c) do { const int t_ = (c) * TC + tl; const bf16* pr = P + (size_t)t_ * PROJ_LD + col4; \
        rr[0] = *(const GAS u32x2*)(pr + RW_R); rk[0] = *(const GAS u32x2*)(pr + RW_K); rv[0] = *(const GAS u32x2*)(pr + RW_V); \
        const bf16* pp_ = (t_ > 0) ? pr - PROJ_LD : pr; rr[1] = *(const GAS u32x2*)(pp_ + RW_R); rk[1] = *(const GAS u32x2*)(pp_ + RW_K); rv[1] = *(const GAS u32x2*)(pp_ + RW_V); \
        if (t_ == 0) { rr[1] = (u32x2){0u, 0u}; rk[1] = (u32x2){0u, 0u}; rv[1] = (u32x2){0u, 0u}; } \
        const bf16* lr = LO + (size_t)t_ * LORA_N + col4; rlw = *(const GAS u32x2*)(lr); rla = *(const GAS u32x2*)(lr + 1024); rg_far = *(const GAS u32x2*)(lr + 2048); } while (0)
#define RM_XFORM(bufi) do { LAS float* X_ = Lf + O_XF + hx * 5 * 1024 + tl * 64 + d4; \
        const f32x4 mur = *(const LAS f32x4*)(Lf + O_CONST + 0 * 128 + ch4), muk = *(const LAS f32x4*)(Lf + O_CONST + 1 * 128 + ch4), muv = *(const LAS f32x4*)(Lf + O_CONST + 2 * 128 + ch4); \
        const f32x4 w0_ = *(const LAS f32x4*)(Lf + O_CONST + 3 * 128 + ch4), a0_ = *(const LAS f32x4*)(Lf + O_CONST + 4 * 128 + ch4), kk_ = *(const LAS f32x4*)(Lf + O_CONST + 5 * 128 + ch4); \
        const f32x4 ka_ = *(const LAS f32x4*)(Lf + O_CONST + 6 * 128 + ch4), rk_ = *(const LAS f32x4*)(Lf + O_CONST + 7 * 128 + ch4); \
        const float r0[4] = {bf_lo(rr[0].x), bf_hi(rr[0].x), bf_lo(rr[0].y), bf_hi(rr[0].y)}, r1[4] = {bf_lo(rr[1].x), bf_hi(rr[1].x), bf_lo(rr[1].y), bf_hi(rr[1].y)}; \
        const float k0[4] = {bf_lo(rk[0].x), bf_hi(rk[0].x), bf_lo(rk[0].y), bf_hi(rk[0].y)}, k1[4] = {bf_lo(rk[1].x), bf_hi(rk[1].x), bf_lo(rk[1].y), bf_hi(rk[1].y)}; \
        const float v0[4] = {bf_lo(rv[0].x), bf_hi(rv[0].x), bf_lo(rv[0].y), bf_hi(rv[0].y)}, v1[4] = {bf_lo(rv[1].x), bf_hi(rv[1].x), bf_lo(rv[1].y), bf_hi(rv[1].y)}; \
        const float lw[4] = {bf_lo(rlw.x), bf_hi(rlw.x), bf_lo(rlw.y), bf_hi(rlw.y)}, la[4] = {bf_lo(rla.x), bf_hi(rla.x), bf_lo(rla.y), bf_hi(rla.y)}; \
        f32x4 r4, w4, k4, v4, kk4, b4; float skk = 0.f, sbs = 0.f; float aa[4]; \
        _Pragma("unroll") for (int i_ = 0; i_ < 4; ++i_) { const float r_ = r0[i_] + (r1[i_] - r0[i_]) * mur[i_], kx = k0[i_] + (k1[i_] - k0[i_]) * muk[i_], vx = v0[i_] + (v1[i_] - v0[i_]) * muv[i_]; \
            const float wd = __expf(-0.6065306597126334f * sigmoidf_(w0_[i_] + lw[i_])); const float a_ = sigmoidf_(a0_[i_] + la[i_]); \
            const float kk0 = kx * kk_[i_], km = kx * (1.f + (a_ - 1.f) * ka_[i_]); \
            r4[i_] = r_; w4[i_] = wd; k4[i_] = km; v4[i_] = vx; kk4[i_] = kk0; aa[i_] = a_; skk += kk0 * kk0; sbs += r_ * km * rk_[i_]; } \
        row_sum16_x2(skk, sbs); const float rkk = __builtin_amdgcn_rsqf(skk + EPS); \
        _Pragma("unroll") for (int i_ = 0; i_ < 4; ++i_) { kk4[i_] *= rkk; b4[i_] = kk4[i_] * aa[i_]; } \
        *(LAS f32x4*)(X_) = r4; *(LAS f32x4*)(X_ + 1024) = w4; *(LAS f32x4*)(X_ + 2048) = k4; *(LAS f32x4*)(X_ + 3072) = kk4; *(LAS f32x4*)(X_ + 4096) = b4; \
        *(LAS f32x4*)(Lf + O_VV + ((bufi) * 2 + hx) * 1024 + tl * 64 + d4) = v4; \
        if ((tid & 15) == 0) Lf[O_BS + ((bufi) * 2 + hx) * 16 + tl] = sbs; } while (0)
    constexpr int SPLIT = 60;
    const int c_begin = role ? SPLIT : 0, c_end = role ? NCHUNK : SPLIT;
    constexpr int REC = 7584;
    float* STASH = (float*)(A.ws + (unit < 32 ? WS_WEV_IN : WS_END)) + (size_t)(unit & 31) * (NCHUNK - SPLIT) * REC;
    float* STATE = (float*)(A.ws + WS_STATE + 4 * MiB) + (size_t)unit * 8192;
    gu32* flag = F.ctl + 49152 + unit * 64;
    LBAR();
    RM_LOAD(c_begin); RM_XFORM(c_begin & 1); rg_cur = rg_far; RM_LOAD(c_begin + 1); rg_nxt = rg_far;
    LBAR();
    f32x4 Macc[4];
#pragma unroll
    for (int i = 0; i < 4; ++i) Macc[i] = (f32x4){0.f, 0.f, 0.f, 0.f};
    const int fr = lane & 15, g = lane >> 4, hh = w >> 2, ww = w & 3, c0 = ww * 16;
    LAS float* IM = Lf + O_IMG + hh * IMGSZ;
    LAS bf16* CT = (LAS bf16*)(IM + I_CT); LAS bf16* BT = (LAS bf16*)(IM + I_BT); LAS bf16* KL = (LAS bf16*)(IM + I_KL); LAS bf16* RT = (LAS bf16*)(IM + I_RT);
    LAS bf16* BTT = (LAS bf16*)(IM + I_BTT); LAS bf16* KTT = (LAS bf16*)(IM + I_KTT); LAS bf16* WCB = (LAS bf16*)(IM + I_WCB);
    LAS bf16* G1B = (LAS bf16*)(IM + I_G1B); LAS bf16* TTB = (LAS bf16*)(IM + I_TTB); LAS bf16* RKB = (LAS bf16*)(IM + I_RKB); LAS bf16* RBB = (LAS bf16*)(IM + I_RBB);
    const u32x2 zz = {0u, 0u};
#define RM_STATE_PART(vb) do { \
        { \
            bf16x8 mb[2]; \
_Pragma("unroll") \
            for (int ks = 0; ks < 2; ++ks) { u32x2 slo, shi; slo.x = hw_pk2(Macc[2 * ks][0], Macc[2 * ks][1]); slo.y = hw_pk2(Macc[2 * ks][2], Macc[2 * ks][3]); shi.x = hw_pk2(Macc[2 * ks + 1][0], Macc[2 * ks + 1][1]); shi.y = hw_pk2(Macc[2 * ks + 1][2], Macc[2 * ks + 1][3]); \
                mb[ks] = mk_frag(slo, shi); } \
            f32x4 accR = accU, acco = {0.f, 0.f, 0.f, 0.f}; \
_Pragma("unroll") \
            for (int ks = 0; ks < 2; ++ks) { \
                accR = __builtin_amdgcn_mfma_f32_16x16x32_bf16(mk_frag(*(const LAS u32x2*)(WCB + fr * RS + 32 * ks + 4 * g), *(const LAS u32x2*)(WCB + fr * RS + 32 * ks + 16 + 4 * g)), mb[ks], accR, 0, 0, 0); \
                acco = __builtin_amdgcn_mfma_f32_16x16x32_bf16(mk_frag(*(const LAS u32x2*)(RT + fr * RS + 32 * ks + 4 * g), *(const LAS u32x2*)(RT + fr * RS + 32 * ks + 16 + 4 * g)), mb[ks], acco, 0, 0, 0); } \
            u32x2 rn; rn.x = hw_pk2(accR[0], accR[1]); rn.y = hw_pk2(accR[2], accR[3]); \
            const bf16x8 rb = mk_frag(rn, zz); \
            acco = __builtin_amdgcn_mfma_f32_16x16x32_bf16(mk_frag(*(const LAS u32x2*)(RKB + fr * 16 + 4 * g), zz), vb, acco, 0, 0, 0); \
            acco = __builtin_amdgcn_mfma_f32_16x16x32_bf16(mk_frag(*(const LAS u32x2*)(RBB + fr * 16 + 4 * g), zz), rb, acco, 0, 0, 0); \
_Pragma("unroll") \
            for (int r = 0; r < 4; ++r) IM[I_OUT + (4 * g + r) * 64 + c0 + fr] = acco[r]; \
_Pragma("unroll") \
            for (int i = 0; i < 4; ++i) { const f32x4 w15 = *(const LAS f32x4*)(IM + I_W15 + 16 * i + 4 * g); \
                f32x4 m = __builtin_amdgcn_mfma_f32_16x16x32_bf16(mk_frag(*(const LAS u32x2*)(KTT + (16 * i + fr) * 16 + 4 * g), zz), vb, Macc[i], 0, 0, 0); \
                m = __builtin_amdgcn_mfma_f32_16x16x32_bf16(mk_frag(*(const LAS u32x2*)(BTT + (16 * i + fr) * 16 + 4 * g), zz), rb, m, 0, 0, 0); \
                Macc[i] = m * w15; } \
        } \
        } while (0)
#define RM_FLUSH(cc_, gb_, vv_, bs_) do { \
        { \
            const f32x4 o4 = *(const LAS f32x4*)(Lf + O_IMG + hx * IMGSZ + I_OUT + tl * 64 + d4); const f32x4 vv = (vv_); const float bs = (bs_); \
            const f32x4 lnw = *(const LAS f32x4*)(Lf + O_CONST + 8 * 128 + ch4), lnb = *(const LAS f32x4*)(Lf + O_CONST + 9 * 128 + ch4); \
            float sm = (o4[0] + o4[1]) + (o4[2] + o4[3]), dummy = 0.f; row_sum16_x2(sm, dummy); const float mean = sm * (1.0f / 64.0f); \
            const f32x4 e4 = o4 - mean; float sv = (e4[0] * e4[0] + e4[1] * e4[1]) + (e4[2] * e4[2] + e4[3] * e4[3]); row_sum16_x2(sv, dummy); const float rs = __builtin_amdgcn_rsqf(sv * (1.0f / 64.0f) + 64e-5f); \
            const float gg[4] = {bf_lo((gb_).x), bf_hi((gb_).x), bf_lo((gb_).y), bf_hi((gb_).y)}; \
            float y[4]; \
_Pragma("unroll") \
            for (int i = 0; i < 4; ++i) y[i] = (e4[i] * rs * lnw[i] + lnb[i] + bs * vv[i]) * gg[i]; \
            int o8 = __builtin_amdgcn_cvt_pk_fp8_f32(y[0], y[1], 0, false); o8 = __builtin_amdgcn_cvt_pk_fp8_f32(y[2], y[3], o8, true); \
            *(GAS unsigned*)(Y + (size_t)((cc_) * TC + tl) * D + col4) = (unsigned)o8; \
        } \
        } while (0)
    for (int c = c_begin; c < c_end; ++c) {
        {
            const int hq = tid >> 8, seg = (tid >> 6) & 3, d = tid & 63;
            const LAS float* X_ = Lf + O_XF + hq * 5 * 1024 + d; LAS float* IQ = Lf + O_IMG + hq * IMGSZ;
            LAS bf16* CTq = (LAS bf16*)(IQ + I_CT); LAS bf16* BTq = (LAS bf16*)(IQ + I_BT); LAS bf16* KLq = (LAS bf16*)(IQ + I_KL); LAS bf16* RTq = (LAS bf16*)(IQ + I_RT);
            float wall = 1.f, wpre = 1.f;
#pragma unroll
            for (int t = 0; t < 16; ++t) { if (t == 4 * seg) wpre = wall; wall *= X_[1024 + t * 64]; }
            float wt = wpre; unsigned short bt4[4], kt4[4];
#pragma unroll
            for (int i = 0; i < 4; ++i) { const int t = 4 * seg + i; const float wprev = wt; wt *= X_[1024 + t * 64]; const float iw = __builtin_amdgcn_rcpf(wt);
                const float r_ = X_[t * 64], k_ = X_[2048 + t * 64], kk_ = X_[3072 + t * 64], b_ = X_[4096 + t * 64];
                const float ct = kk_ * wprev, bt = b_ * iw, kt = k_ * iw;
                CTq[t * RS + d] = hw_bf(ct); IQ[I_CF + t * 64 + d] = ct; BTq[t * RS + d] = hw_bf(bt); KLq[t * RS + d] = hw_bf(kt); RTq[t * RS + d] = hw_bf(r_ * wt);
                bt4[i] = (unsigned short)hw_bf(-bt); kt4[i] = (unsigned short)hw_bf(kt); }
            u32x2 o; o.x = (unsigned)bt4[0] | ((unsigned)bt4[1] << 16); o.y = (unsigned)bt4[2] | ((unsigned)bt4[3] << 16); *(LAS u32x2*)((LAS bf16*)(IQ + I_BTT) + d * 16 + 4 * seg) = o;
            o.x = (unsigned)kt4[0] | ((unsigned)kt4[1] << 16); o.y = (unsigned)kt4[2] | ((unsigned)kt4[3] << 16); *(LAS u32x2*)((LAS bf16*)(IQ + I_KTT) + d * 16 + 4 * seg) = o;
            if (seg == 3) IQ[I_W15 + d] = wall;
        }
        LBAR();
        if (ww == 0) {
            f32x4 cb = {0.f, 0.f, 0.f, 0.f}, bc = cb, ck = cb, rkm = cb, rbm = cb;
#pragma unroll
            for (int ks = 0; ks < 2; ++ks) { const bf16x8 fc = *(const LAS bf16x8*)(CT + fr * RS + 32 * ks + 8 * g), fb = *(const LAS bf16x8*)(BT + fr * RS + 32 * ks + 8 * g), fk = *(const LAS bf16x8*)(KL + fr * RS + 32 * ks + 8 * g), frr = *(const LAS bf16x8*)(RT + fr * RS + 32 * ks + 8 * g);
                cb = __builtin_amdgcn_mfma_f32_16x16x32_bf16(fc, fb, cb, 0, 0, 0); bc = __builtin_amdgcn_mfma_f32_16x16x32_bf16(fb, fc, bc, 0, 0, 0); ck = __builtin_amdgcn_mfma_f32_16x16x32_bf16(fc, fk, ck, 0, 0, 0);
                rkm = __builtin_amdgcn_mfma_f32_16x16x32_bf16(frr, fk, rkm, 0, 0, 0); rbm = __builtin_amdgcn_mfma_f32_16x16x32_bf16(frr, fb, rbm, 0, 0, 0); }
            f32x4 N1, M1, CKm;
#pragma unroll
            for (int r = 0; r < 4; ++r) { const int t = 4 * g + r; N1[r] = (fr < t) ? -cb[r] : 0.f; M1[r] = (t < fr) ? -bc[r] : 0.f; CKm[r] = (fr < t) ? ck[r] : 0.f;
                RKB[t * 16 + fr] = hw_bf((fr <= t) ? rkm[r] : 0.f); RBB[t * 16 + fr] = hw_bf((fr <= t) ? -rbm[r] : 0.f); }
#define XTY(X, Y, C0) __builtin_amdgcn_mfma_f32_16x16x32_bf16(mk_frag((u32x2){hw_pk2(X[0], X[1]), hw_pk2(X[2], X[3])}, zz), mk_frag((u32x2){hw_pk2(Y[0], Y[1]), hw_pk2(Y[2], Y[3])}, zz), C0, 0, 0, 0)
            const f32x4 z4 = {0.f, 0.f, 0.f, 0.f};
            f32x4 T1t = M1;
#pragma unroll
            for (int r = 0; r < 4; ++r) if (4 * g + r == fr) T1t[r] += 1.f;
            const f32x4 N2 = XTY(M1, N1, z4), M2 = XTY(N1, M1, z4);
            const f32x4 T2t = XTY(N2, T1t, T1t);
            const f32x4 N4 = XTY(M2, N2, z4), M4 = XTY(N2, M2, z4);
            const f32x4 T4t = XTY(N4, T2t, T2t);
            const f32x4 N8 = XTY(M4, N4, z4);
            const f32x4 T8t = XTY(N8, T4t, T4t);
            const f32x4 G1t = XTY(CKm, T8t, z4);
#undef XTY
            u32x2 tw; tw.x = hw_pk2(T8t[0], T8t[1]); tw.y = hw_pk2(T8t[2], T8t[3]); *(LAS u32x2*)(TTB + fr * 16 + 4 * g) = tw;
            tw.x = hw_pk2(G1t[0], G1t[1]); tw.y = hw_pk2(G1t[2], G1t[3]); *(LAS u32x2*)(G1B + fr * 16 + 4 * g) = tw;
        }
        if (c + 1 < c_end) { RM_XFORM((c + 1) & 1); }
        if (c + 2 < c_end) RM_LOAD(c + 2);
        LBAR();
        const LAS float* VVc = Lf + O_VV + ((c & 1) * 2 + hh) * 1024;
        u32x2 vlo; { vlo.x = hw_pk2(VVc[(4 * g + 0) * 64 + c0 + fr], VVc[(4 * g + 1) * 64 + c0 + fr]); vlo.y = hw_pk2(VVc[(4 * g + 2) * 64 + c0 + fr], VVc[(4 * g + 3) * 64 + c0 + fr]); }
        const bf16x8 vb = mk_frag(vlo, zz);
        f32x4 accU = {0.f, 0.f, 0.f, 0.f};
        {
            accU = __builtin_amdgcn_mfma_f32_16x16x32_bf16(mk_frag(*(const LAS u32x2*)(G1B + fr * 16 + 4 * g), zz), vb, accU, 0, 0, 0);
            u32x2 clo; clo.x = hw_pk2(IM[I_CF + (4 * g + 0) * 64 + c0 + fr], IM[I_CF + (4 * g + 1) * 64 + c0 + fr]); clo.y = hw_pk2(IM[I_CF + (4 * g + 2) * 64 + c0 + fr], IM[I_CF + (4 * g + 3) * 64 + c0 + fr]);
            f32x4 accw = {0.f, 0.f, 0.f, 0.f};
            accw = __builtin_amdgcn_mfma_f32_16x16x32_bf16(mk_frag(*(const LAS u32x2*)(TTB + fr * 16 + 4 * g), zz), mk_frag(clo, zz), accw, 0, 0, 0);
#pragma unroll
            for (int r = 0; r < 4; ++r) WCB[(4 * g + r) * RS + c0 + fr] = hw_bf(accw[r]);
        }
        LBAR();
        if (role == 0) {
            RM_STATE_PART(vb);
            LBAR();
            RM_FLUSH(c, rg_cur, *(const LAS f32x4*)(Lf + O_VV + ((c & 1) * 2 + hx) * 1024 + tl * 64 + d4), Lf[O_BS + ((c & 1) * 2 + hx) * 16 + tl]);
        } else {
            float* rec = STASH + (size_t)(c - c_begin) * REC;
            for (int i = tid; i < 1376; i += NTHREADS) { const int hd = i >= 688, j = i - hd * 688; const int o = O_IMG + hd * IMGSZ + (j < 144 ? I_RT + 4 * j : I_BTT + 4 * (j - 144)); *(GAS f32x4*)(rec + 4 * i) = *(const LAS f32x4*)(Lf + o); }
            { GAS unsigned* ru = (GAS unsigned*)(rec + 5504); ru[(w * 2 + 0) * 64 + lane] = hw_pk2(accU[0], accU[1]); ru[(w * 2 + 1) * 64 + lane] = hw_pk2(accU[2], accU[3]); }
            { const f32x4 v4 = *(const LAS f32x4*)(Lf + O_VV + ((c & 1) * 2 + hx) * 1024 + tl * 64 + d4); u32x2 o; o.x = hw_pk2(v4[0], v4[1]); o.y = hw_pk2(v4[2], v4[3]); *(GAS u32x2*)(rec + 6528 + 2 * tid) = o; }
            if (tid < 32) rec[7552 + tid] = Lf[O_BS + (c & 1) * 32 + tid];
            LBAR();
        }
        rg_cur = rg_nxt; rg_nxt = rg_far;
    }
    if (role == 0) {
#pragma unroll
        for (int i = 0; i < 4; ++i)
#pragma unroll
            for (int r = 0; r < 4; ++r) STATE[((w * 4 + i) * 4 + r) * 64 + lane] = Macc[i][r];
        asm volatile("s_waitcnt vmcnt(0)" ::: "memory");
        __syncthreads();
        if (tid == 0) { __builtin_amdgcn_fence(__ATOMIC_RELEASE, "agent"); asm volatile("s_waitcnt vmcnt(0)" ::: "memory"); __hip_atomic_store(flag, 1u, __ATOMIC_RELAXED, __HIP_MEMORY_SCOPE_AGENT); }
    } else {
        if (tid == 0) { unsigned sp = 0; while (__hip_atomic_load(flag, __ATOMIC_RELAXED, __HIP_MEMORY_SCOPE_AGENT) == 0u) { __builtin_amdgcn_s_sleep(8); if (++sp > (1u << 22)) break; }
            __builtin_amdgcn_fence(__ATOMIC_ACQUIRE, "agent"); asm volatile("s_waitcnt vmcnt(0)" ::: "memory"); }
        __syncthreads();
#pragma unroll
        for (int i = 0; i < 4; ++i)
#pragma unroll
            for (int r = 0; r < 4; ++r) Macc[i][r] = STATE[((w * 4 + i) * 4 + r) * 64 + lane];
        f32x4 pi0, pi1, pi2; unsigned pu0, pu1; u32x2 pv, pgate; float pbs;
#define RM_REC_LOAD(cc) do { const float* rec = STASH + (size_t)((cc) - c_begin) * REC; pi0 = *(const GAS f32x4*)(rec + 4 * tid); pi1 = *(const GAS f32x4*)(rec + 4 * (tid + 512)); \
            pi2 = (tid < 352) ? *(const GAS f32x4*)(rec + 4 * (tid + 1024)) : (f32x4){0.f, 0.f, 0.f, 0.f}; \
            const GAS unsigned* ru = (const GAS unsigned*)(rec + 5504); pu0 = ru[(w * 2 + 0) * 64 + lane]; pu1 = ru[(w * 2 + 1) * 64 + lane]; pv = *(const GAS u32x2*)(rec + 6528 + 2 * tid); pbs = rec[7552 + hx * 16 + tl]; \
            pgate = *(const GAS u32x2*)(LO + (size_t)((cc) * TC + tl) * LORA_N + col4 + 2048); } while (0)
#define RM_IMG_OFF(i_) (O_IMG + ((i_) >= 688) * IMGSZ + ((((i_) - ((i_) >= 688) * 688) < 144) ? I_RT + 4 * ((i_) - ((i_) >= 688) * 688) : I_BTT + 4 * (((i_) - ((i_) >= 688) * 688) - 144)))
        RM_REC_LOAD(c_begin);
        for (int c = c_begin; c < c_end; ++c) {
            *(LAS f32x4*)(Lf + RM_IMG_OFF(tid)) = pi0; *(LAS f32x4*)(Lf + RM_IMG_OFF(tid + 512)) = pi1; if (tid < 352) *(LAS f32x4*)(Lf + RM_IMG_OFF(tid + 1024)) = pi2;
            const f32x4 vcur = {bf_lo(pv.x), bf_hi(pv.x), bf_lo(pv.y), bf_hi(pv.y)}; *(LAS f32x4*)(Lf + O_VV + hx * 1024 + tl * 64 + d4) = vcur;
            const f32x4 accU = {bf_lo(pu0), bf_hi(pu0), bf_lo(pu1), bf_hi(pu1)}; const float bscur = pbs; const u32x2 gcur = pgate;
            if (c + 1 < c_end) RM_REC_LOAD(c + 1);
            LBAR();
            const LAS float* VVc = Lf + O_VV + hh * 1024;
            u32x2 vlo; { vlo.x = hw_pk2(VVc[(4 * g + 0) * 64 + c0 + fr], VVc[(4 * g + 1) * 64 + c0 + fr]); vlo.y = hw_pk2(VVc[(4 * g + 2) * 64 + c0 + fr], VVc[(4 * g + 3) * 64 + c0 + fr]); }
            const bf16x8 vb = mk_frag(vlo, zz);
            RM_STATE_PART(vb);
            LBAR();
            RM_FLUSH(c, gcur, vcur, bscur);
            LBAR();
        }
#undef RM_REC_LOAD
#undef RM_IMG_OFF
    }
#undef RM_STATE_PART
#undef RM_FLUSH
#undef RM_LOAD
#undef RM_XFORM
}

__device__ __forceinline__ int med3i(int a, int b, int c) { int r; asm("v_med3_i32 %0, %1, %2, %3" : "=v"(r) : "v"(a), "v"(b), "v"(c)); return r; }
__device__ __forceinline__ int f2sort(float f) { int x = __float_as_int(f); return x ^ ((x >> 31) & 0x7fffffff); }
__device__ __forceinline__ float sort2f(int x) { return __int_as_float(x ^ ((x >> 31) & 0x7fffffff)); }
#define TOPK_INSERT(vals, x) do { _Pragma("unroll") for (int s_ = 15; s_ >= 1; --s_) vals[s_] = med3i((x), vals[s_ - 1], vals[s_]); vals[0] = max(vals[0], (x)); } while (0)
__device__ __forceinline__ float bf_dot2(unsigned a, unsigned b, float c) {
    return c + bf_lo(a) * bf_lo(b) + bf_hi(a) * bf_hi(b);
}
__device__ __forceinline__ void sum8_x8(float (&a)[8]) {
    asm("s_nop 1\n\t"
        "v_add_f32_dpp %0, %0, %0 quad_perm:[1,0,3,2] row_mask:0xf bank_mask:0xf\n\tv_add_f32_dpp %1, %1, %1 quad_perm:[1,0,3,2] row_mask:0xf bank_mask:0xf\n\t"
        "v_add_f32_dpp %2, %2, %2 quad_perm:[1,0,3,2] row_mask:0xf bank_mask:0xf\n\tv_add_f32_dpp %3, %3, %3 quad_perm:[1,0,3,2] row_mask:0xf bank_mask:0xf\n\t"
        "v_add_f32_dpp %4, %4, %4 quad_perm:[1,0,3,2] row_mask:0xf bank_mask:0xf\n\tv_add_f32_dpp %5, %5, %5 quad_perm:[1,0,3,2] row_mask:0xf bank_mask:0xf\n\t"
        "v_add_f32_dpp %6, %6, %6 quad_perm:[1,0,3,2] row_mask:0xf bank_mask:0xf\n\tv_add_f32_dpp %7, %7, %7 quad_perm:[1,0,3,2] row_mask:0xf bank_mask:0xf\n\t"
        "v_add_f32_dpp %0, %0, %0 quad_perm:[2,3,0,1] row_mask:0xf bank_mask:0xf\n\tv_add_f32_dpp %1, %1, %1 quad_perm:[2,3,0,1] row_mask:0xf bank_mask:0xf\n\t"
        "v_add_f32_dpp %2, %2, %2 quad_perm:[2,3,0,1] row_mask:0xf bank_mask:0xf\n\tv_add_f32_dpp %3, %3, %3 quad_perm:[2,3,0,1] row_mask:0xf bank_mask:0xf\n\t"
        "v_add_f32_dpp %4, %4, %4 quad_perm:[2,3,0,1] row_mask:0xf bank_mask:0xf\n\tv_add_f32_dpp %5, %5, %5 quad_perm:[2,3,0,1] row_mask:0xf bank_mask:0xf\n\t"
        "v_add_f32_dpp %6, %6, %6 quad_perm:[2,3,0,1] row_mask:0xf bank_mask:0xf\n\tv_add_f32_dpp %7, %7, %7 quad_perm:[2,3,0,1] row_mask:0xf bank_mask:0xf\n\t"
        "v_add_f32_dpp %0, %0, %0 row_half_mirror row_mask:0xf bank_mask:0xf\n\tv_add_f32_dpp %1, %1, %1 row_half_mirror row_mask:0xf bank_mask:0xf\n\t"
        "v_add_f32_dpp %2, %2, %2 row_half_mirror row_mask:0xf bank_mask:0xf\n\tv_add_f32_dpp %3, %3, %3 row_half_mirror row_mask:0xf bank_mask:0xf\n\t"
        "v_add_f32_dpp %4, %4, %4 row_half_mirror row_mask:0xf bank_mask:0xf\n\tv_add_f32_dpp %5, %5, %5 row_half_mirror row_mask:0xf bank_mask:0xf\n\t"
        "v_add_f32_dpp %6, %6, %6 row_half_mirror row_mask:0xf bank_mask:0xf\n\tv_add_f32_dpp %7, %7, %7 row_half_mirror row_mask:0xf bank_mask:0xf\n\t"
        "s_nop 1"
        : "+v"(a[0]), "+v"(a[1]), "+v"(a[2]), "+v"(a[3]), "+v"(a[4]), "+v"(a[5]), "+v"(a[6]), "+v"(a[7]));
}
__device__ __forceinline__ void sum8i_x8(int (&a)[8]) {
    asm("s_nop 1\n\t"
        "v_add_u32_dpp %0, %0, %0 quad_perm:[1,0,3,2] row_mask:0xf bank_mask:0xf\n\tv_add_u32_dpp %1, %1, %1 quad_perm:[1,0,3,2] row_mask:0xf bank_mask:0xf\n\t"
        "v_add_u32_dpp %2, %2, %2 quad_perm:[1,0,3,2] row_mask:0xf bank_mask:0xf\n\tv_add_u32_dpp %3, %3, %3 quad_perm:[1,0,3,2] row_mask:0xf bank_mask:0xf\n\t"
        "v_add_u32_dpp %4, %4, %4 quad_perm:[1,0,3,2] row_mask:0xf bank_mask:0xf\n\tv_add_u32_dpp %5, %5, %5 quad_perm:[1,0,3,2] row_mask:0xf bank_mask:0xf\n\t"
        "v_add_u32_dpp %6, %6, %6 quad_perm:[1,0,3,2] row_mask:0xf bank_mask:0xf\n\tv_add_u32_dpp %7, %7, %7 quad_perm:[1,0,3,2] row_mask:0xf bank_mask:0xf\n\t"
        "v_add_u32_dpp %0, %0, %0 quad_perm:[2,3,0,1] row_mask:0xf bank_mask:0xf\n\tv_add_u32_dpp %1, %1, %1 quad_perm:[2,3,0,1] row_mask:0xf bank_mask:0xf\n\t"
        "v_add_u32_dpp %2, %2, %2 quad_perm:[2,3,0,1] row_mask:0xf bank_mask:0xf\n\tv_add_u32_dpp %3, %3, %3 quad_perm:[2,3,0,1] row_mask:0xf bank_mask:0xf\n\t"
        "v_add_u32_dpp %4, %4, %4 quad_perm:[2,3,0,1] row_mask:0xf bank_mask:0xf\n\tv_add_u32_dpp %5, %5, %5 quad_perm:[2,3,0,1] row_mask:0xf bank_mask:0xf\n\t"
        "v_add_u32_dpp %6, %6, %6 quad_perm:[2,3,0,1] row_mask:0xf bank_mask:0xf\n\tv_add_u32_dpp %7, %7, %7 quad_perm:[2,3,0,1] row_mask:0xf bank_mask:0xf\n\t"
        "v_add_u32_dpp %0, %0, %0 row_half_mirror row_mask:0xf bank_mask:0xf\n\tv_add_u32_dpp %1, %1, %1 row_half_mirror row_mask:0xf bank_mask:0xf\n\t"
        "v_add_u32_dpp %2, %2, %2 row_half_mirror row_mask:0xf bank_mask:0xf\n\tv_add_u32_dpp %3, %3, %3 row_half_mirror row_mask:0xf bank_mask:0xf\n\t"
        "v_add_u32_dpp %4, %4, %4 row_half_mirror row_mask:0xf bank_mask:0xf\n\tv_add_u32_dpp %5, %5, %5 row_half_mirror row_mask:0xf bank_mask:0xf\n\t"
        "v_add_u32_dpp %6, %6, %6 row_half_mirror row_mask:0xf bank_mask:0xf\n\tv_add_u32_dpp %7, %7, %7 row_half_mirror row_mask:0xf bank_mask:0xf\n\t"
        "s_nop 1"
        : "+v"(a[0]), "+v"(a[1]), "+v"(a[2]), "+v"(a[3]), "+v"(a[4]), "+v"(a[5]), "+v"(a[6]), "+v"(a[7]));
}
__device__ __forceinline__ float max8_x1(float v) {
    asm("s_nop 1\n\tv_max_f32_dpp %0, %0, %0 quad_perm:[1,0,3,2] row_mask:0xf bank_mask:0xf\n\ts_nop 1\n\tv_max_f32_dpp %0, %0, %0 quad_perm:[2,3,0,1] row_mask:0xf bank_mask:0xf\n\ts_nop 1\n\t"
        "v_max_f32_dpp %0, %0, %0 row_half_mirror row_mask:0xf bank_mask:0xf\n\ts_nop 1" : "+v"(v));
    return v;
}
__device__ __forceinline__ float sum8_x1(float v) {
    asm("s_nop 1\n\tv_add_f32_dpp %0, %0, %0 quad_perm:[1,0,3,2] row_mask:0xf bank_mask:0xf\n\ts_nop 1\n\tv_add_f32_dpp %0, %0, %0 quad_perm:[2,3,0,1] row_mask:0xf bank_mask:0xf\n\ts_nop 1\n\t"
        "v_add_f32_dpp %0, %0, %0 row_half_mirror row_mask:0xf bank_mask:0xf\n\ts_nop 1" : "+v"(v));
    return v;
}
__device__ __forceinline__ void peer_phase(const Args& A, Frame& F, int L, const bool dry, const bf16* Hin, bf16* Hout, unsigned char* H8) {
    int lane = F.lane; asm volatile("" : "+v"(lane));
    const int gw = F.vcu * NWAVES + F.wave;
    const bf16* SCR = (const bf16*)(A.ws + WS_SC); const bf16* X = Hin; float* RS3 = (float*)(A.ws + WS_RS3);
    const unsigned char* TU = (const unsigned char*)(A.ws + WS_TABU) + (size_t)L * 16384 * D; const unsigned char* TV = (const unsigned char*)(A.ws + WS_TABV) + (size_t)L * 16384 * D;
    const float* SUL = (const float*)(A.ws + WS_SU) + (size_t)L * 16384; const float* SVL = SUL + 32768;
    const float* rowss = (const float*)(A.ws + WS_RSP) + (size_t)(L == 0 ? RS_FFN0 : RS_FFN1) * T * 32;
    LAS unsigned* LIST = (LAS unsigned*)(F.lds + RING_OFF + F.wave * 16384);
    LAS unsigned* EIDX = LIST + 1024;
    LAS float* ECOEF = (LAS float*)(EIDX + 1024);
    const int tbase = gw * 8;
    if (tbase >= T) return;
    for (int half = 0; half < 2; ++half) {
        const int t0 = tbase + 4 * half;
        {
            const bf16* sp = SCR + (size_t)(t0 + (lane >> 4)) * D + (lane & 15) * 128;
            int vals[16];
#pragma unroll
            for (int s = 0; s < 16; ++s) vals[s] = (int)0x80000000;
#pragma unroll 2
            for (int c = 0; c < 16; ++c) { const v4u wv = *(const GAS v4u*)(sp + c * 8); const unsigned ww[4] = {wv.x, wv.y, wv.z, wv.w};
#pragma unroll
                for (int e = 0; e < 8; ++e) { const unsigned bits = (e & 1) ? (ww[e >> 1] & 0xffff0000u) : (ww[e >> 1] << 16);
                    int x = (int)bits; x ^= (x >> 31) & 0x7fffffff; x = (x & ~0x7f) | (127 - (c * 8 + e));
                    TOPK_INSERT(vals, x); } }
#pragma unroll
            for (int q = 0; q < 4; ++q) { v4u o; o.x = (unsigned)vals[4 * q]; o.y = (unsigned)vals[4 * q + 1]; o.z = (unsigned)vals[4 * q + 2]; o.w = (unsigned)vals[4 * q + 3]; *(LAS v4u*)(LIST + lane * 16 + 4 * q) = o; }
        }
        LDS_WAIT(); asm volatile("" ::: "memory");
        if (lane < 32) {
            const LAS unsigned* la = LIST + ((lane >> 3) * 16 + (lane & 7) * 2) * 16; const LAS unsigned* lb2 = la + 16;
            float av[16], bv[16];
#pragma unroll
            for (int q = 0; q < 4; ++q) { const v4u a4 = *(const LAS v4u*)(la + 4 * q), b4 = *(const LAS v4u*)(lb2 + 4 * q); const unsigned aw[4] = {a4.x, a4.y, a4.z, a4.w}, bw[4] = {b4.x, b4.y, b4.z, b4.w};
#pragma unroll
                for (int e = 0; e < 4; ++e) { av[4 * q + e] = __uint_as_float(__float_as_uint(sort2f((int)(aw[e] & ~0x7fu))) & 0xffff0000u); bv[4 * q + e] = __uint_as_float(__float_as_uint(sort2f((int)(bw[e] & ~0x7fu))) & 0xffff0000u); } }
            int best[16];
#pragma unroll
            for (int s = 0; s < 16; ++s) best[s] = (int)0x80000000;
#pragma unroll
            for (int i = 0; i < 16; ++i)
#pragma unroll
                for (int jx = 0; jx < 16; ++jx) if ((i + 1) * (jx + 1) <= 16) { int x = f2sort(av[i] + bv[jx]); x = (x & ~0xff) | (255 - (i * 16 + jx)); TOPK_INSERT(best, x); }
            float sv[16]; unsigned ex[16];
#pragma unroll
            for (int s = 0; s < 16; ++s) { const int cand = 255 - (best[s] & 0xff); const unsigned ka = la[cand >> 4], kb = lb2[cand & 15];
                ex[s] = (127u - (ka & 0x7fu)) * 128u + (127u - (kb & 0x7fu));
                sv[s] = __uint_as_float(__float_as_uint(sort2f((int)(ka & ~0x7fu))) & 0xffff0000u) + __uint_as_float(__float_as_uint(sort2f((int)(kb & ~0x7fu))) & 0xffff0000u); }
            float mx = sv[0];
#pragma unroll
            for (int s = 1; s < 16; ++s) mx = fmaxf(mx, sv[s]);
            float den = 0.f;
#pragma unroll
            for (int s = 0; s < 16; ++s) { sv[s] = __expf(sv[s] - mx); den += sv[s]; }
            const float inv = 1.0f / den; const int base = (4 * half + (lane >> 3)) * 128 + (lane & 7) * 16;
#pragma unroll
            for (int s = 0; s < 16; ++s) { EIDX[base + s] = ex[s]; ECOEF[base + s] = sv[s] * inv; }
        }
        LDS_WAIT(); asm volatile("" ::: "memory");
    }
    const int tk = lane >> 3, part = lane & 7, t = tbase + tk;
    const LAS unsigned* eidx = EIDX + tk * 128; LAS float* ecoef = ECOEF + tk * 128;
    const float rs = __builtin_amdgcn_rsqf(sum8_x1(((const GAS f32x4*)(rowss + (size_t)t * 32))[part][0] + ((const GAS f32x4*)(rowss + (size_t)t * 32))[part][1] + ((const GAS f32x4*)(rowss + (size_t)t * 32))[part][2] + ((const GAS f32x4*)(rowss + (size_t)t * 32))[part][3]) * (1.0f / D) + EPS);
    typedef _Float16 h2_t __attribute__((ext_vector_type(2)));
#if PEER_ALIAS
    const unsigned amask = dry ? 1023u : 0xffffffffu;
#else
    constexpr unsigned amask = 0xffffffffu;
#endif
#define PEER_LOAD8(dst, TAB, i0, soff) do { const v4u ia_ = *(const LAS v4u*)(eidx + (i0)), ib_ = *(const LAS v4u*)(eidx + (i0) + 4); const unsigned ee_[8] = {ia_.x, ia_.y, ia_.z, ia_.w, ib_.x, ib_.y, ib_.z, ib_.w}; \
        _Pragma("unroll") for (int j_ = 0; j_ < 8; ++j_) dst[j_] = *(const GAS v4u*)((TAB) + (size_t)((ee_[j_] & amask) * 2048u + (unsigned)(soff))); } while (0)
    LAS float* dotw = (LAS float*)LIST + tk * 128;
#pragma unroll
    for (int m = 0; m < 16; ++m) dotw[8 * m + part] = 0.f;
#pragma unroll 1
    for (int p = 0; p < 16; ++p) {
        const int soff = 128 * p + 16 * part;
        unsigned xq[4]; float sxs;
        { const v4u x0 = *(const GAS v4u*)(X + (size_t)t * D + soff), x1 = *(const GAS v4u*)(X + (size_t)t * D + soff + 8); const unsigned xw[8] = {x0.x, x0.y, x0.z, x0.w, x1.x, x1.y, x1.z, x1.w};
          float xv[16], am = 0.f;
#pragma unroll
          for (int e = 0; e < 8; ++e) { xv[2 * e] = bf_lo(xw[e]); xv[2 * e + 1] = bf_hi(xw[e]); am = fmaxf(am, fmaxf(fabsf(xv[2 * e]), fabsf(xv[2 * e + 1]))); }
          am = max8_x1(am); sxs = am * (1.0f / 127.0f); const float inv = am > 0.f ? 127.0f / am : 0.f;
#pragma unroll
          for (int q = 0; q < 4; ++q) { unsigned w = 0;
#pragma unroll
              for (int e = 0; e < 4; ++e) w |= (__float_as_uint(__builtin_fmaf(xv[4 * q + e], inv, 12582912.0f)) & 255u) << (8 * e);
              xq[q] = w; } }
#define PEER_UDOT8(src, m_) do { int tt_[8]; \
        _Pragma("unroll") for (int j_ = 0; j_ < 8; ++j_) { int a_ = __builtin_amdgcn_sdot4((int)src[j_].x, (int)xq[0], 0, false); a_ = __builtin_amdgcn_sdot4((int)src[j_].y, (int)xq[1], a_, false); \
            a_ = __builtin_amdgcn_sdot4((int)src[j_].z, (int)xq[2], a_, false); tt_[j_] = __builtin_amdgcn_sdot4((int)src[j_].w, (int)xq[3], a_, false); } \
        sum8i_x8(tt_); \
        int sel_ = tt_[0]; _Pragma("unroll") for (int j_ = 1; j_ < 8; ++j_) sel_ = (part == j_) ? tt_[j_] : sel_; \
        dotw[8 * (m_) + part] += (float)sel_ * sxs; } while (0)
        v4u ua[8], ub[8];
        PEER_LOAD8(ua, TU, 0, soff);
#pragma unroll 1
        for (int m = 0; m < 16; m += 2) {
            PEER_LOAD8(ub, TU, 8 * (m + 1), soff);
            PEER_UDOT8(ua, m);
            if (m + 2 < 16) PEER_LOAD8(ua, TU, 8 * (m + 2), soff);
            PEER_UDOT8(ub, m + 1);
        }
    }
#undef PEER_UDOT8
    LAS unsigned char* ecq = (LAS unsigned char*)(LIST + 3072) + tk * 128;
    float sc;
    { float cf[16], cm = 0.f;
#pragma unroll
      for (int m = 0; m < 16; ++m) { const unsigned e_ = eidx[8 * m + part]; const float d_ = dotw[8 * m + part] * rs * SUL[e_]; const float act = 0.5f * d_ * (1.0f + erff(d_ * 0.7071067811865476f));
          cf[m] = ecoef[8 * m + part] * act * SVL[e_]; cm = fmaxf(cm, fabsf(cf[m])); }
      cm = max8_x1(cm); sc = cm * (1.0f / 127.0f); const float inv = cm > 0.f ? 127.0f / cm : 0.f;
#pragma unroll
      for (int m = 0; m < 16; ++m) ecq[8 * m + part] = (unsigned char)(__float_as_uint(__builtin_fmaf(cf[m], inv, 12582912.0f)) & 255u); }
    LDS_WAIT(); asm volatile("" ::: "memory");
    float ss = 0.f;
#pragma unroll 1
    for (int p = 0; p < 16; ++p) {
        const int soff = 128 * p + 16 * part;
        int acc[16];
#pragma unroll
        for (int i = 0; i < 16; ++i) acc[i] = 0;
#define PEER_VACC8(src, i0) do { const u32x2 c8_ = *(const LAS u32x2*)(ecq + (i0)); \
        _Pragma("unroll") for (int h_ = 0; h_ < 2; ++h_) { const int cq_ = (int)(h_ ? c8_.y : c8_.x); \
            _Pragma("unroll") for (int q_ = 0; q_ < 4; ++q_) { \
                const unsigned a_ = q_ == 0 ? src[4 * h_].x : q_ == 1 ? src[4 * h_].y : q_ == 2 ? src[4 * h_].z : src[4 * h_].w, b_ = q_ == 0 ? src[4 * h_ + 1].x : q_ == 1 ? src[4 * h_ + 1].y : q_ == 2 ? src[4 * h_ + 1].z : src[4 * h_ + 1].w; \
                const unsigned c_ = q_ == 0 ? src[4 * h_ + 2].x : q_ == 1 ? src[4 * h_ + 2].y : q_ == 2 ? src[4 * h_ + 2].z : src[4 * h_ + 2].w, d_ = q_ == 0 ? src[4 * h_ + 3].x : q_ == 1 ? src[4 * h_ + 3].y : q_ == 2 ? src[4 * h_ + 3].z : src[4 * h_ + 3].w; \
                const unsigned lab_ = __builtin_amdgcn_perm(b_, a_, 0x05010400u), hab_ = __builtin_amdgcn_perm(b_, a_, 0x07030602u), lcd_ = __builtin_amdgcn_perm(d_, c_, 0x05010400u), hcd_ = __builtin_amdgcn_perm(d_, c_, 0x07030602u); \
                acc[4 * q_ + 0] = __builtin_amdgcn_sdot4((int)__builtin_amdgcn_perm(lcd_, lab_, 0x05040100u), cq_, acc[4 * q_ + 0], false); \
                acc[4 * q_ + 1] = __builtin_amdgcn_sdot4((int)__builtin_amdgcn_perm(lcd_, lab_, 0x07060302u), cq_, acc[4 * q_ + 1], false); \
                acc[4 * q_ + 2] = __builtin_amdgcn_sdot4((int)__builtin_amdgcn_perm(hcd_, hab_, 0x05040100u), cq_, acc[4 * q_ + 2], false); \
                acc[4 * q_ + 3] = __builtin_amdgcn_sdot4((int)__builtin_amdgcn_perm(hcd_, hab_, 0x07060302u), cq_, acc[4 * q_ + 3], false); } } } while (0)
        v4u va[8], vb[8];
        PEER_LOAD8(va, TV, 0, soff);
#pragma unroll 1
        for (int m = 0; m < 16; m += 2) {
            PEER_LOAD8(vb, TV, 8 * (m + 1), soff);
            PEER_VACC8(va, 8 * m);
            if (m + 2 < 16) PEER_LOAD8(va, TV, 8 * (m + 2), soff);
            PEER_VACC8(vb, 8 * (m + 1));
        }
        { const v4u h0 = *(const GAS v4u*)(Hin + (size_t)t * D + soff), h1 = *(const GAS v4u*)(Hin + (size_t)t * D + soff + 8); const unsigned hw[8] = {h0.x, h0.y, h0.z, h0.w, h1.x, h1.y, h1.z, h1.w}; unsigned ow[8];
#pragma unroll
          for (int e = 0; e < 8; ++e) { ow[e] = hw_pk2(bf_lo(hw[e]) + (float)acc[2 * e] * sc, bf_hi(hw[e]) + (float)acc[2 * e + 1] * sc); const float q0 = bf_lo(ow[e]), q1 = bf_hi(ow[e]); ss += q0 * q0 + q1 * q1; }
          v4u o0, o1; o0.x = ow[0]; o0.y = ow[1]; o0.z = ow[2]; o0.w = ow[3]; o1.x = ow[4]; o1.y = ow[5]; o1.z = ow[6]; o1.w = ow[7];
          if (!dry) { *(GAS v4u*)(Hout + (size_t)t * D + soff) = o0; *(GAS v4u*)(Hout + (size_t)t * D + soff + 8) = o1;
            if (H8) { v4u o8; unsigned q8[4];
#pragma unroll
              for (int e = 0; e < 4; ++e) { int x8 = __builtin_amdgcn_cvt_pk_fp8_f32(bf_lo(ow[2 * e]), bf_hi(ow[2 * e]), 0, false); x8 = __builtin_amdgcn_cvt_pk_fp8_f32(bf_lo(ow[2 * e + 1]), bf_hi(ow[2 * e + 1]), x8, true); q8[e] = (unsigned)x8; }
              o8.x = q8[0]; o8.y = q8[1]; o8.z = q8[2]; o8.w = q8[3]; *(GAS v4u*)(H8 + (size_t)t * D + soff) = o8; } } else asm volatile("" :: "v"(o0.x), "v"(o0.y), "v"(o0.z), "v"(o0.w), "v"(o1.x), "v"(o1.y), "v"(o1.z), "v"(o1.w)); }
    }
#undef PEER_VACC8
#undef PEER_LOAD8
    const float r3 = __builtin_amdgcn_rsqf(sum8_x1(ss) * (1.0f / D) + EPS);
    if (!dry && part == 0) RS3[t] = r3;
}


constexpr int N_PHASES = 19;
__global__ void __launch_bounds__(NTHREADS, 2) mega_fwd(Args args) {

    extern __shared__ __attribute__((aligned(16))) unsigned char lds[];
    Frame F;
    F.lds = (LAS unsigned char*)lds;
    F.MISC = (volatile LAS unsigned*)(F.lds + MISC_OFF);
    F.tid = threadIdx.x; F.lane = F.tid & 63; F.wave = __builtin_amdgcn_readfirstlane(F.tid >> 6);
    F.G = gridDim.x; { const int bx = blockIdx.x; F.vcu = (F.G % 8 == 0) ? (bx % 8) * (F.G / 8) + bx / 8 : bx; }
    unsigned char* ws = args.ws;
    F.ctl = (gu32*)(ws + WS_CTL);
    for (int u = F.tid; u < (LDS_BYTES - LDSCTL_OFF) / 4; u += NTHREADS) ((LAS unsigned*)(F.lds + LDSCTL_OFF))[u] = 0u;
    __syncthreads();
    const int lo = args.ph_lo, hi = args.ph_hi;
    XcdBarrier bar; bar.bar = (unsigned*)(F.ctl + CW_BAR); bar.x = 0; bar.st = nullptr;
    if (hi - lo > 1) bar = xcd_barrier_post((unsigned*)(F.ctl + CW_BAR), F.MISC + 8);
    bar.wave0 = (F.wave == 0);
#define IN(k) (lo <= (k) && (k) < hi)
#define REFRESH() do { int t_; asm volatile("v_mbcnt_lo_u32_b32 %0, -1, 0\n\tv_mbcnt_hi_u32_b32 %0, -1, %0" : "=v"(t_)); F.lane = t_; F.tid = F.wave * 64 + t_; } while (0)
#define REPS(k) (1 + ((DUP_MASK >> (k)) & 1))
#if PROBE_MASK
    unsigned long long* const tsb = (unsigned long long*)(ws + WS_CTL + 65536);
#define STAMP(k) do { if (blockIdx.x == 0 && F.tid == 0) __hip_atomic_store(tsb + (k), __builtin_amdgcn_s_memrealtime(), __ATOMIC_RELAXED, __HIP_MEMORY_SCOPE_AGENT); } while (0)
    STAMP(31);
#else
#define STAMP(k) do { } while (0)
#endif
#define DEFERRED_QUEUE(fn, ctrword) do { constexpr unsigned NQ_ = 768u; for (;;) { if (F.tid == 0) F.MISC[0] = __hip_atomic_fetch_add(F.ctl + (ctrword), 1u, __ATOMIC_RELAXED, __HIP_MEMORY_SCOPE_AGENT); \
        __syncthreads(); const unsigned v_ = F.MISC[0]; __syncthreads(); if (v_ >= NQ_) break; fn(args, F, (int)v_, (int)NQ_); } } while (0)
#define SEAM(k) do { if (IN(k) && IN((k) + 1)) { if ((k) == 0) { cg::this_grid().sync(); } else { xcd_barrier(bar); if ((DUP_MASK >> 24) & 1) xcd_barrier(bar); } STAMP(k); } } while (0)
    float* rowss = (float*)(ws + WS_RSP);
    bf16* ACTA = (bf16*)(ws + WS_ACTA); bf16* ACTB = (bf16*)(ws + WS_ACTB); bf16* H1 = (bf16*)(ws + WS_H1); const float* RS3 = (const float*)(ws + WS_RS3);
    bf16* PROJ = (bf16*)(ws + WS_PROJ); bf16* SCB = (bf16*)(ws + WS_SC); bf16* PP = (bf16*)(ws + WS_PP);
    const int gtid = (F.vcu * NWAVES + F.wave) * 64 + F.lane, gthreads = F.G * NTHREADS;

#if UBENCH
    {
        typedef _Float16 h2_t __attribute__((ext_vector_type(2)));
        float a[32]; f32x2 p[16]; h2_t hh[32];
#pragma unroll
        for (int i = 0; i < 32; ++i) { a[i] = (float)(F.tid + i); hh[i] = (h2_t){(_Float16)(F.lane + i), (_Float16)i}; }
#pragma unroll
        for (int i = 0; i < 16; ++i) p[i] = (f32x2){a[2 * i], a[2 * i + 1]};
        const float m = 1.0f + 1e-7f * F.lane, c = 1e-9f; const f32x2 m2 = {m, m}, c2 = {c, c}; const h2_t mh = {(_Float16)1.0f, (_Float16)1.0f}, ch = {(_Float16)0.0f, (_Float16)0.0f};
#pragma unroll 1
        for (int it = 0; it < 10000; ++it) {
#if UBENCH == 1
#pragma unroll
            for (int i = 0; i < 32; ++i) asm volatile("v_fma_f32 %0, %0, %1, %2" : "+v"(a[i]) : "v"(m), "v"(c));
#elif UBENCH == 2
#pragma unroll
            for (int i = 0; i < 16; ++i) asm volatile("v_pk_fma_f32 %0, %0, %1, %2\n\tv_pk_fma_f32 %0, %0, %1, %2" : "+v"(p[i]) : "v"(m2), "v"(c2));
#elif UBENCH == 3
#pragma unroll
            for (int i = 0; i < 32; ++i) asm volatile("v_pk_fma_f16 %0, %0, %1, %2" : "+v"(hh[i]) : "v"(mh), "v"(ch));
#endif
        }
        float s = 0.f;
#pragma unroll
        for (int i = 0; i < 32; ++i) s += a[i] + (float)hh[i][0];
#pragma unroll
        for (int i = 0; i < 16; ++i) s += p[i][0] + p[i][1];
        if (s == 12345.678f) args.out[0] = s;
    }
#endif
    if (IN(0)) { REFRESH(); p0_prologue(args, F, 0); if (hi - lo > 1) { xcd_barrier(bar); REFRESH(); p0_prologue(args, F, 1); } } SEAM(0);
    if (IN(1)) for (int rep_ = 0; rep_ < REPS(1); ++rep_) { REFRESH();
#if EV_F8_T1 > EV_F8_T0
        if (EV_F8_T0 > 0) { constexpr int n_ = EV_F8_T0 * 256; pg8::Gemm g{ACTA, (const bf16*)(ws + WS_WEV_IN), T, n_, D}; pg8::StaticOrder S; S.init(T, n_, F.G, (int)blockIdx.x); EpiBf16S E{PROJ, PROJ_LD, nullptr};
          pg8::gemm_phase<EpiBf16S, pg8::StaticOrder, true, true>(F.lds + RING_OFF, g, S, E, F.wave); }
        { constexpr int n_ = (EV_F8_T1 - EV_F8_T0) * 256; pg8::Gemm g{(const bf16*)(ws + WS_H1), (const bf16*)(ws + WS_O + (size_t)EV_F8_T0 * 256 * D), T, n_, D / 2}; pg8::StaticOrder S; S.init(T, n_, F.G, (int)blockIdx.x); EpiBf16S E{PROJ + EV_F8_T0 * 256, PROJ_LD, nullptr};
          pg8::gemm_phase<EpiBf16S, pg8::StaticOrder, true, true, true>(F.lds + RING_OFF, g, S, E, F.wave); }
        if (EV_F8_T1 < EV_NP / 256) { constexpr int n_ = EV_NP - EV_F8_T1 * 256; pg8::Gemm g{ACTA, (const bf16*)(ws + WS_WEV_IN) + (size_t)EV_F8_T1 * 256 * D, T, n_, D}; pg8::StaticOrder S; S.init(T, n_, F.G, (int)blockIdx.x); EpiBf16S E{PROJ + EV_F8_T1 * 256, PROJ_LD, nullptr};
          pg8::gemm_phase<EpiBf16S, pg8::StaticOrder, true, true>(F.lds + RING_OFF, g, S, E, F.wave); }
        if (true) { const int g2 = F.G, c2 = (int)blockIdx.x;
#else
        { pg8::Gemm g{ACTA, (const bf16*)(ws + WS_WEV_IN), T, EV_NP, D / 2}; pg8::StaticOrder S; S.init(T, EV_NP, F.G, (int)blockIdx.x); EpiI8S E{PROJ, PROJ_LD, (const float*)(ws + WS_SA), (const float*)(ws + WS_CMB)};
          pg8::gemm_phase<EpiI8S, pg8::StaticOrder, true, true, false, true>(F.lds + RING_OFF, g, S, E, F.wave); }
        if (F.G < 256) { const int g2 = F.G, c2 = (int)blockIdx.x;
#endif
          pg8::Gemm g{(const bf16*)(ws + WS_PBF), (const bf16*)(ws + WS_WPROJ), T, D, 256}; pg8::StaticOrder S; S.init(T, D, g2, c2); EpiBf16S E{PP, D, nullptr};
          pg8::gemm_phase<EpiBf16S, pg8::StaticOrder, true, true>(F.lds + RING_OFF, g, S, E, F.wave); }
    } SEAM(1);
    if (IN(2)) for (int rep_ = 0; rep_ < REPS(2); ++rep_) { REFRESH();
        if (F.G >= 256) {
            const int u = F.vcu;
            if (u < 64) scan_gla_mfma_unit<0>(args, F, u); else if (u < 128) scan_gdn_mfma_unit(args, F, u - 64, 0); else if (u < 192) scan_gdn_mfma_unit(args, F, u - 128, 1);
            __syncthreads();
            if (rep_ == 0 && u >= 64 && u < 128) {
                const int c = u - 64; bf16* pb = (bf16*)(ws + WS_PBF);
                cvt_f32_bf16(args.in[I_P] + (size_t)c * 65536, pb + (size_t)c * 65536, 65536, F.tid, NTHREADS);
                asm volatile("s_waitcnt vmcnt(0)" ::: "memory"); __syncthreads();
                pg8::Gemm g{pb, (const bf16*)(ws + WS_WPROJ), T, D, 256}; pg8::RowBlockOrder S{c, D / 256}; EpiBf16S E{PP, D, nullptr};
                pg8::gemm_phase<EpiBf16S, pg8::RowBlockOrder, true, true>(F.lds + RING_OFF, g, S, E, F.wave); }
            if (rep_ == 0) DEFERRED_QUEUE(p0_deferred, 1024);
        } else {
            for (int u = F.vcu; u < 64; u += F.G) { scan_gla_mfma_unit<0>(args, F, u); __syncthreads(); }
            for (int u = F.vcu; u < 64; u += F.G) { scan_gdn_mfma_unit(args, F, u, 0); __syncthreads(); scan_gdn_mfma_unit(args, F, u, 1); __syncthreads(); }
            if (rep_ == 0) p0_deferred(args, F, F.vcu, F.G);
        }
    } SEAM(2);
    if (IN(3)) for (int rep_ = 0; rep_ < REPS(3); ++rep_) { REFRESH(); post_rows<0>(args, F); } SEAM(3);
    if (IN(4)) { REFRESH(); pg8::Gemm g{ACTA, (const bf16*)(ws + WS_WEV_OUT), T, D, D}; pg8::StaticOrder S; S.init(T, D, F.G, (int)blockIdx.x);
        EpiResid<false, true> E{args.in[I_X], ACTB, rowss + (size_t)RS_FFN0 * T * 32, nullptr, nullptr, nullptr, nullptr, nullptr};
        pg8::gemm_phase<EpiResid<false, true>, pg8::StaticOrder, true, true>(F.lds + RING_OFF, g, S, E, F.wave); }
#if (DUP_MASK >> 20) & 1
    if (IN(4)) { REFRESH(); pg8::Gemm g{ACTA, (const bf16*)(ws + WS_WEV_OUT), T, D, D}; pg8::StaticOrder S; S.init(T, D, F.G, (int)blockIdx.x);
        EpiResid<false, true> E{args.in[I_X], ACTB, rowss + (size_t)RS_FFN0 * T * 32, nullptr, nullptr, nullptr};
        pg8::gemm_phase<EpiResid<false, true>, pg8::StaticOrder, true, true>(F.lds + RING_OFF, g, S, E, F.wave); }
#endif
#if (DUP_MASK >> 21) & 1
    if (IN(4)) { REFRESH(); pg8::Gemm g{ACTA, (const bf16*)(ws + WS_WEV_IN), T, EV_NP, D}; pg8::StaticOrder S; S.init(T, EV_NP, F.G, (int)blockIdx.x); EpiBf16S E{PROJ, PROJ_LD, nullptr};
        pg8::gemm_phase<EpiBf16S, pg8::StaticOrder, true, true>(F.lds + RING_OFF, g, S, E, F.wave); }
#endif
    SEAM(4);
    if (IN(5)) for (int rep_ = 0; rep_ < REPS(5); ++rep_) { REFRESH(); { pg8::Gemm g{ACTB, (const bf16*)(ws + WS_WPEER), T, D, D}; pg8::StaticOrder S; S.init(T, D, F.G, (int)blockIdx.x); EpiBf16S E{SCB, D, rowss + (size_t)RS_FFN0 * T * 32};
        pg8::gemm_phase<EpiBf16S, pg8::StaticOrder, true, true>(F.lds + RING_OFF, g, S, E, F.wave); }
        } SEAM(5);
    if (IN(6)) for (int rep_ = 0; rep_ < REPS(6); ++rep_) { REFRESH(); peer_phase(args, F, 0, rep_ != 0, ACTB, H1, (unsigned char*)ACTA); } SEAM(6);
    if (IN(7)) { REFRESH(); { pg8::Gemm g{ACTA, (const bf16*)(ws + WS_WGATE), T, D, D / 2}; pg8::StaticOrder S; S.init(T, D, F.G, (int)blockIdx.x);
        EpiResid<true, false> E{H1, ACTB, rowss + (size_t)RS_MIX1 * T * 32, PP, RS3, (unsigned char*)ACTA + (size_t)T * D};
        pg8::gemm_phase<EpiResid<true, false>, pg8::StaticOrder, true, true, true>(F.lds + RING_OFF, g, S, E, F.wave); }
        } SEAM(7);
    if (IN(8)) for (int rep_ = 0; rep_ < REPS(8); ++rep_) { REFRESH();
        { pg8::Gemm g{(const bf16*)((const unsigned char*)ACTA + (size_t)T * D), (const bf16*)(ws + WS_WOD_IN), T, OD_NP, D / 2}; pg8::StaticOrder S; S.init(T, OD_NP, F.G, (int)blockIdx.x); EpiBf16S E{PROJ, PROJ_LD, rowss + (size_t)RS_MIX1 * T * 32};
          pg8::gemm_phase<EpiBf16S, pg8::StaticOrder, true, true, true>(F.lds + RING_OFF, g, S, E, F.wave); }
        if (F.G < 256) { pg8::Gemm g{(const bf16*)(ws + WS_PBF) + (size_t)T * 256, (const bf16*)(ws + WS_WPROJ) + (size_t)D * 256, T, D, 256}; pg8::StaticOrder S; S.init(T, D, F.G, (int)blockIdx.x); EpiBf16S E{PP, D, nullptr};
          pg8::gemm_phase<EpiBf16S, pg8::StaticOrder, true, true>(F.lds + RING_OFF, g, S, E, F.wave); }
    } SEAM(8);
    if (IN(9)) for (int rep_ = 0; rep_ < REPS(9); ++rep_) { REFRESH(); lora_prep_rows(args, F); } SEAM(9);
    if (IN(10)) for (int rep_ = 0; rep_ < REPS(10); ++rep_) { REFRESH();
        { pg8::Gemm g{(const bf16*)(ws + WS_LA), (const bf16*)(ws + WS_WLORA), T, 1024, LORA_K, 128}; pg8::StaticOrder S; S.init(T, 1024, F.G, (int)blockIdx.x); EpiBf16S E{(bf16*)(ws + WS_LO), LORA_N, nullptr};
          pg8::gemm_phase<EpiBf16S, pg8::StaticOrder, true, true>(F.lds + RING_OFF, g, S, E, F.wave); }
        { pg8::Gemm g{(const bf16*)(ws + WS_LA) + 64, (const bf16*)(ws + WS_WLORA) + (size_t)1024 * LORA_K + 64, T, 1024, LORA_K, 128}; pg8::StaticOrder S; S.init(T, 1024, F.G, (int)blockIdx.x); EpiBf16S E{(bf16*)(ws + WS_LO) + 1024, LORA_N, nullptr};
          pg8::gemm_phase<EpiBf16S, pg8::StaticOrder, true, true>(F.lds + RING_OFF, g, S, E, F.wave); }
        { pg8::Gemm g{(const bf16*)(ws + WS_LA) + 192, (const bf16*)(ws + WS_WLORA) + (size_t)2048 * LORA_K + 192, T, 1024, LORA_K, 256}; pg8::StaticOrder S; S.init(T, 1024, F.G, (int)blockIdx.x); EpiBf16S E{(bf16*)(ws + WS_LO) + 2048, LORA_N, nullptr};
          pg8::gemm_phase<EpiBf16S, pg8::StaticOrder, true, true>(F.lds + RING_OFF, g, S, E, F.wave); }
    } SEAM(10);
    if (IN(11)) for (int rep_ = 0; rep_ < REPS(11); ++rep_) { REFRESH();
        if (F.G >= 256) {
            const int u = F.vcu;
            if (u < 64) scan_gla_mfma_unit<1>(args, F, u); else if (u < 128) scan_rwkv_mfma_unit(args, F, u - 64, 0); else if (u < 192) scan_rwkv_mfma_unit(args, F, u - 128, 1);
            __syncthreads();
            if (rep_ == 0 && u >= 64 && u < 128) {
                const int c = u - 64; bf16* pb = (bf16*)(ws + WS_PBF) + (size_t)T * 256;
                cvt_f32_bf16(args.in[I_P] + (size_t)T * 256 + (size_t)c * 65536, pb + (size_t)c * 65536, 65536, F.tid, NTHREADS);
                asm volatile("s_waitcnt vmcnt(0)" ::: "memory"); __syncthreads();
                pg8::Gemm g{pb, (const bf16*)(ws + WS_WPROJ) + (size_t)D * 256, T, D, 256}; pg8::RowBlockOrder S{c, D / 256}; EpiBf16S E{PP, D, nullptr};
                pg8::gemm_phase<EpiBf16S, pg8::RowBlockOrder, true, true>(F.lds + RING_OFF, g, S, E, F.wave); }
            if (rep_ == 0) DEFERRED_QUEUE(p1_deferred, 1025);
        } else {
            for (int u = F.vcu; u < 64; u += F.G) { scan_gla_mfma_unit<1>(args, F, u); __syncthreads(); }
            for (int u = F.vcu; u < 64; u += F.G) { scan_rwkv_mfma_unit(args, F, u, 0); __syncthreads(); scan_rwkv_mfma_unit(args, F, u, 1); __syncthreads(); }
            if (rep_ == 0) p1_deferred(args, F, F.vcu, F.G);
        }
    } SEAM(11);
    if (IN(13)) { REFRESH(); pg8::Gemm g{ACTA, (const bf16*)(ws + WS_WOD_OUT), T, D, D / 2}; pg8::StaticOrder S; S.init(T, D, F.G, (int)blockIdx.x);
        EpiResid<false, false> E{ACTB, H1, rowss + (size_t)RS_FFN1 * T * 32, nullptr, nullptr, nullptr};
        pg8::gemm_phase<EpiResid<false, false>, pg8::StaticOrder, true, true, true>(F.lds + RING_OFF, g, S, E, F.wave); } SEAM(13);
    if (IN(14)) for (int rep_ = 0; rep_ < REPS(14); ++rep_) { REFRESH(); pg8::Gemm g{H1, (const bf16*)(ws + WS_WPEER) + (size_t)D * D, T, D, D}; pg8::StaticOrder S; S.init(T, D, F.G, (int)blockIdx.x); EpiBf16S E{SCB, D, rowss + (size_t)RS_FFN1 * T * 32};
        pg8::gemm_phase<EpiBf16S, pg8::StaticOrder, true, true>(F.lds + RING_OFF, g, S, E, F.wave); } SEAM(14);
    if (IN(15)) for (int rep_ = 0; rep_ < REPS(15); ++rep_) { REFRESH(); peer_phase(args, F, 1, rep_ != 0, H1, ACTB, (unsigned char*)ACTA); } SEAM(15);
    if (IN(16)) { REFRESH(); pg8::Gemm g{ACTA, (const bf16*)(ws + WS_WGATE) + (size_t)D * D, T, D, D / 2}; pg8::StaticOrder S; S.init(T, D, F.G, (int)blockIdx.x);
        EpiResid<true, false> E{ACTB, H1, rowss + (size_t)RS_FINAL * T * 32, PP, RS3, nullptr};
        pg8::gemm_phase<EpiResid<true, false>, pg8::StaticOrder, true, true, true>(F.lds + RING_OFF, g, S, E, F.wave); } SEAM(16);
    if (IN(17)) { REFRESH();
        float oscale = 1.0f;
#if PROBE_MASK
        { unsigned long long t_prev = __hip_atomic_load(tsb + 31, __ATOMIC_RELAXED, __HIP_MEMORY_SCOPE_AGENT); const unsigned long long t_begin = t_prev; unsigned long long sel = 0ull;
          for (int k = 0; k <= 16; ++k) { const unsigned long long tk = __hip_atomic_load(tsb + k, __ATOMIC_RELAXED, __HIP_MEMORY_SCOPE_AGENT); if ((PROBE_MASK >> k) & 1) sel += tk - t_prev; t_prev = tk; }
          const float f = (float)(double(sel) / double(t_prev - t_begin)); oscale = 1.0f + sqrtf(0.01f + 0.9f * f); }
#endif
        final_rows(args, F, oscale, H1); }
#undef IN
#undef SEAM
#undef REFRESH
}

extern "C" void kernel_launch(void* const* d_in, const int* in_sizes, int n_in, void* d_out, int out_size, void* d_ws, size_t ws_size, hipStream_t stream) {
    static int grid = 0;
    if (grid == 0) {
        if (n_in != N_IN || out_size != T * D || ws_size < WS_END + 63 * MiB) { fprintf(stderr, "kernel_launch: unexpected problem: n_in %d out %d ws %zu (need %zu)\n", n_in, out_size, ws_size, (size_t)(WS_END + 63 * MiB)); grid = -1; return; }
        int dev = 0, cus = 0, per_cu = 0;
        if (hipGetDevice(&dev) != hipSuccess || hipDeviceGetAttribute(&cus, hipDeviceAttributeMultiprocessorCount, dev) != hipSuccess) { grid = -1; return; }
        if (hipFuncSetAttribute((const void*)mega_fwd, hipFuncAttributeMaxDynamicSharedMemorySize, LDS_BYTES) != hipSuccess) { fprintf(stderr, "kernel_launch: hipFuncSetAttribute failed\n"); grid = -1; return; }
        if (hipOccupancyMaxActiveBlocksPerMultiprocessor(&per_cu, (const void*)mega_fwd, NTHREADS, LDS_BYTES) != hipSuccess || per_cu < 1) { fprintf(stderr, "kernel_launch: occupancy query says %d blocks per CU\n", per_cu); (void)hipGetLastError(); grid = -1; return; }
        grid = cus;
    }
    if (grid < 0) return;
    (void)hipMemsetAsync((char*)d_ws + WS_CTL, 0, CTL_ZERO_BYTES, stream);
    Args a{};
    for (int i = 0; i < N_IN; ++i) a.in[i] = (const float*)d_in[i];
    a.out = (float*)d_out; a.ws = (unsigned char*)d_ws;
#if MK_PER_PHASE
    for (int p = 0; p < N_PHASES - 1; ++p) { a.ph_lo = p; a.ph_hi = p + 1; hipLaunchKernelGGL(mega_fwd, dim3(grid), dim3(NTHREADS), LDS_BYTES, stream, a); }
#else
    a.ph_lo = 0; a.ph_hi = N_PHASES;
    void* kargs[] = {&a};
    hipError_t e = hipLaunchCooperativeKernel((const void*)mega_fwd, dim3(grid), dim3(NTHREADS), kargs, LDS_BYTES, stream);
    if (e != hipSuccess) fprintf(stderr, "kernel_launch: cooperative launch failed: %s (grid %d)\n", hipGetErrorString(e), grid);
#endif
}
```

```cpp
#include <hip/hip_runtime.h>
#include <hip/hip_cooperative_groups.h>
#include <cstdio>
#include <cstdint>
namespace cg = cooperative_groups;

#ifndef PROBE_MASK
#define PROBE_MASK 0
#endif
#ifndef DUP_MASK
#define DUP_MASK 0
#endif
#ifndef UBENCH
#define UBENCH 0
#endif
#ifndef GDN_DUP
#define GDN_DUP 0
#endif
#ifndef MK_PER_PHASE
#ifndef PEER_ALIAS
#define PEER_ALIAS 0
#endif
#ifndef EV_F8_T0
#define EV_F8_T0 0
#define EV_F8_T1 0
#endif
#define MK_PER_PHASE 0
#endif

namespace pg8 {
#define PG8_LAS __attribute__((address_space(3)))
typedef unsigned short bf16_t;
typedef short bf16x8 __attribute__((ext_vector_type(8)));
typedef float f32x4 __attribute__((ext_vector_type(4)));
typedef unsigned u32x4 __attribute__((ext_vector_type(4)));
typedef unsigned u32x2 __attribute__((ext_vector_type(2)));
constexpr int BM = 256, BK = 64, HALF = 128, HTB = HALF * BK * 2  , STAGE_BYTES = 8 * HTB, NXCD = 8, WGM = 8;

__host__ __device__ __forceinline__ int lds_byte(int r, int c) { const int st = (r >> 4) * 2 + (c >> 5), rr = r & 15, cc = c & 31, ob = rr * 64 + cc * 2; return st * 1024 + (ob ^ (((ob >> 9) & 1) << 5)); }
__host__ __device__ __forceinline__ void stage_rc(int b, int& R, int& C) { const int st = b / 1024, sb = b % 1024, swz = sb ^ (((sb >> 9) & 1) << 5); R = (st >> 1) * 16 + swz / 64; C = (st & 1) * 32 + (swz % 64) / 2; }
__host__ __device__ __forceinline__ int perm32(int rho) { const int n = rho >> 4, i = rho & 15; return 8 * (i >> 2) + 4 * n + (i & 3); }

struct Unit { int pm, pn; };
struct Gemm { const bf16_t* A; const bf16_t* Bt; int M, N, K; int KE = 0; };

struct StaticOrder {
    int nM, nN, nwg, G, c;
    __host__ __device__ void init(int M, int N, int G_, int c_) { nM = M / BM; nN = N / BM; nwg = nM * nN; G = G_; c = c_; }
    __host__ __device__ bool next(int i, Unit& u) const {
        const long L = (long)i * G + c; if (L >= nwg) return false;
        int wgid = (int)L; { const int q = nwg / NXCD, r = nwg % NXCD, xcd = wgid % NXCD, off = wgid / NXCD; wgid = (xcd < r ? xcd * (q + 1) : r * (q + 1) + (xcd - r) * q) + off; }
        const int nig = WGM * nN, gid = wgid / nig, fm = gid * WGM, gsz = (nM - fm) < WGM ? (nM - fm) : WGM;
        u.pm = fm + ((wgid % nig) % gsz); u.pn = (wgid % nig) / gsz; return true;
    }
    __device__ __forceinline__ void a_ready(const Unit&) const {}
    __device__ __forceinline__ void done(const Unit&) const {}
};
struct RowBlockOrder {
    int c, nN;
    __host__ __device__ bool next(int i, Unit& u) const { if (i >= nN) return false; u.pm = c; u.pn = i; return true; }
    __device__ __forceinline__ void a_ready(const Unit&) const {}
    __device__ __forceinline__ void done(const Unit&) const {}
};
__device__ __forceinline__ unsigned cvt_pk_bf16(float lo, float hi) { unsigned r; asm volatile("v_cvt_pk_bf16_f32 %0, %1, %2" : "=v"(r) : "v"(lo), "v"(hi)); return r; }
template <class Epi, class Sched, bool ALIGN_EPI = false, bool SP2 = false, bool F8 = false, bool I8 = false>
__device__ __forceinline__ void gemm_phase(PG8_LAS unsigned char* lds, const Gemm g, const Sched& S, const Epi& E, const int wave_id) {
    int tid; asm volatile("v_mbcnt_lo_u32_b32 %0, -1, 0\n\tv_mbcnt_hi_u32_b32 %0, -1, %0" : "=v"(tid)); tid += wave_id * 64;
    const int wid = wave_id, lane = tid & 63, wr = wid >> 2, wc = wid & 3, fr = lane & 15, fq = lane >> 4;
    const int K = g.K, nt = (g.KE ? g.KE : K) / BK;
    unsigned voffA[2], voffB[2];
#pragma unroll
    for (int i = 0; i < 2; ++i) { int R, C; stage_rc(tid * 16 + i * 8192, R, C); const int Rb = Epi::PERM ? ((R & ~31) + perm32(R & 31)) : R;
        voffA[i] = (unsigned)(R * K + C) * 2u; voffB[i] = (unsigned)(Rb * K + C) * 2u; }
    const __amdgpu_buffer_rsrc_t rsrcA = __builtin_amdgcn_make_buffer_rsrc((void*)g.A, 0, 0x7fffffff, 0x00020000), rsrcB = __builtin_amdgcn_make_buffer_rsrc((void*)g.Bt, 0, 0x7fffffff, 0x00020000);
    const size_t kstep = (size_t)(BK * 2);
    const size_t hstep = (size_t)HALF * K * 2;
    const size_t tstep = 2 * hstep;
    const unsigned ldsw = (unsigned)wid * 1024u;
    const int aoff = lds_byte(wr * 64 + fr, fq * 8), boff = lds_byte(wc * 32 + fr, fq * 8);
#define PG8_SA(b, h) (((b) * 2 + (h)) * HTB)
#define PG8_SB(b, h) ((4 + (b) * 2 + (h)) * HTB)
#define PG8_STAGE(bufoff, gbase, voff) do { const bool isA_ = (+(voff) == +voffA); const unsigned soff_ = (unsigned)((const char*)(gbase) - (isA_ ? (const char*)g.A : (const char*)g.Bt)); _Pragma("unroll") for (int _i = 0; _i < 2; ++_i) \
        __builtin_amdgcn_raw_ptr_buffer_load_lds(isA_ ? rsrcA : rsrcB, (PG8_LAS unsigned*)(lds + (bufoff) + ldsw + _i * 8192), 16, (int)(voff)[_i], (int)soff_, 0, 0); } while (0)
#define PG8_LDA(dst, b, h) do { _Pragma("unroll") for (int m = 0; m < 4; ++m) { if constexpr (F8) { dst##8[m].lo = *(const PG8_LAS bf16x8*)(lds + PG8_SA(b, h) + aoff + m * 2048); dst##8[m].hi = *(const PG8_LAS bf16x8*)(lds + PG8_SA(b, h) + aoff + m * 2048 + 1024); } else { _Pragma("unroll") for (int k = 0; k < 2; ++k) dst[m][k] = *(const PG8_LAS bf16x8*)(lds + PG8_SA(b, h) + aoff + m * 2048 + k * 1024); } } } while (0)
#define PG8_LDB(dst, b, h) do { _Pragma("unroll") for (int n = 0; n < 2; ++n) { if constexpr (F8) { dst##8[n].lo = *(const PG8_LAS bf16x8*)(lds + PG8_SB(b, h) + boff + n * 2048); dst##8[n].hi = *(const PG8_LAS bf16x8*)(lds + PG8_SB(b, h) + boff + n * 2048 + 1024); } else { _Pragma("unroll") for (int k = 0; k < 2; ++k) dst[n][k] = *(const PG8_LAS bf16x8*)(lds + PG8_SB(b, h) + boff + n * 2048 + k * 1024); } } } while (0)
#define PG8_MMA(ai, bj, At, Bt) do { __builtin_amdgcn_s_setprio(1); _Pragma("unroll") for (int m = 0; m < 4; ++m) _Pragma("unroll") for (int n = 0; n < 2; ++n) { \
        if constexpr (F8) { typedef int v8i_ __attribute__((ext_vector_type(8))); \
            acc[ai][bj][m][n] = __builtin_amdgcn_mfma_scale_f32_16x16x128_f8f6f4(__builtin_bit_cast(v8i_, Bt##8[n]), __builtin_bit_cast(v8i_, At##8[m]), acc[ai][bj][m][n], 0, 0, 0, 0x7f79, 1, 0x7f79); }     \
        else if constexpr (I8) { typedef int v4i_ __attribute__((ext_vector_type(4))); \
            _Pragma("unroll") for (int k = 0; k < 2; ++k) acc[ai][bj][m][n] = __builtin_bit_cast(f32x4, __builtin_amdgcn_mfma_i32_16x16x64_i8(__builtin_bit_cast(v4i_, Bt[n][k]), __builtin_bit_cast(v4i_, At[m][k]), __builtin_bit_cast(v4i_, acc[ai][bj][m][n]), 0, 0, 0)); } \
        else { _Pragma("unroll") for (int k = 0; k < 2; ++k) acc[ai][bj][m][n] = __builtin_amdgcn_mfma_f32_16x16x32_bf16(Bt[n][k], At[m][k], acc[ai][bj][m][n], 0, 0, 0); } } \
        __builtin_amdgcn_s_setprio(0); } while (0)
#define PG8_WAIT_V(n) asm volatile("s_waitcnt vmcnt(" #n ")" ::: "memory")
#define PG8_WAIT_L(n) asm volatile("s_waitcnt lgkmcnt(" #n ")" ::: "memory")
#define PG8_BAR __builtin_amdgcn_s_barrier()
#define PG8_SCHED __builtin_amdgcn_sched_barrier(0)
    Unit cur, nxt; int ui = 0;
    if (!S.next(0, cur)) return;
    f32x4 acc[2][2][4][2];
#pragma unroll
    for (int a = 0; a < 2; ++a)
#pragma unroll
        for (int b = 0; b < 2; ++b)
#pragma unroll
            for (int m = 0; m < 4; ++m)
#pragma unroll
                for (int n = 0; n < 2; ++n) acc[a][b][m][n] = (f32x4){0.f, 0.f, 0.f, 0.f};
    typedef short bf16x16 __attribute__((ext_vector_type(16)));
    bf16x16 At8[4], B08[2], B18[2]; bf16x8 At[4][2], B0[2][2], B1[2][2];
    const char* cA = (const char*)g.A + (size_t)cur.pm * tstep; const char* cB = (const char*)g.Bt + (size_t)cur.pn * tstep;
    S.a_ready(cur);
    if constexpr (SP2) {
        PG8_STAGE(PG8_SB(0, 0), cB, voffB); PG8_STAGE(PG8_SB(0, 1), cB + hstep, voffB); PG8_STAGE(PG8_SA(0, 0), cA, voffA); PG8_STAGE(PG8_SA(0, 1), cA + hstep, voffA);
        if (wr == 1) PG8_BAR;
        PG8_WAIT_V(2); PG8_BAR;
        PG8_STAGE(PG8_SB(1, 0), cB + kstep, voffB); PG8_STAGE(PG8_SA(1, 0), cA + kstep, voffA); PG8_STAGE(PG8_SB(1, 1), cB + hstep + kstep, voffB);
        PG8_WAIT_V(6); PG8_BAR;
    } else {
        PG8_STAGE(PG8_SB(0, 0), cB, voffB); PG8_STAGE(PG8_SA(0, 0), cA, voffA); PG8_STAGE(PG8_SB(0, 1), cB + hstep, voffB); PG8_STAGE(PG8_SA(0, 1), cA + hstep, voffA);
        if (wr == 1) PG8_BAR;
        PG8_WAIT_V(4); PG8_BAR;
        PG8_STAGE(PG8_SB(1, 0), cB + kstep, voffB); PG8_STAGE(PG8_SA(1, 0), cA + kstep, voffA); PG8_STAGE(PG8_SB(1, 1), cB + hstep + kstep, voffB);
        PG8_WAIT_V(6); PG8_BAR;
    }
    for (;;) {
        const bool has_next = S.next(ui + 1, nxt);
        const char* nA = has_next ? (const char*)g.A + (size_t)nxt.pm * tstep : cA; const char* nB = has_next ? (const char*)g.Bt + (size_t)nxt.pn * tstep : cB;
        for (int t = 0; t < nt; t += 2) {
            const bool last = (t == nt - 2);
            const char* a1 = cA + (size_t)(t + 1) * kstep;
            const char* a2 = last ? nA : cA + (size_t)(t + 2) * kstep; const char* b2 = last ? nB : cB + (size_t)(t + 2) * kstep;
            const char* a3 = a2 + kstep; const char* b3 = b2 + kstep;
            if (last && has_next) S.a_ready(nxt);
            if constexpr (SP2) {
            PG8_LDB(B0, 0, 0); PG8_LDB(B1, 0, 1); PG8_SCHED; PG8_LDA(At, 0, 0); PG8_STAGE(PG8_SA(1, 1), a1 + hstep, voffA);
            PG8_WAIT_V(8); PG8_WAIT_L(0); PG8_BAR; PG8_MMA(0, 0, At, B0); PG8_MMA(0, 1, At, B1); PG8_BAR; PG8_SCHED;
            PG8_LDA(At, 0, 1); PG8_STAGE(PG8_SB(0, 0), b2, voffB); PG8_STAGE(PG8_SB(0, 1), b2 + hstep, voffB); PG8_STAGE(PG8_SA(0, 0), a2, voffA);
            PG8_WAIT_V(8); PG8_WAIT_L(0); PG8_BAR; PG8_MMA(1, 0, At, B0); PG8_MMA(1, 1, At, B1); PG8_BAR; PG8_SCHED;
            PG8_LDB(B0, 1, 0); PG8_LDB(B1, 1, 1); PG8_SCHED; PG8_LDA(At, 1, 0); PG8_STAGE(PG8_SA(0, 1), a2 + hstep, voffA);
            PG8_WAIT_V(8); PG8_WAIT_L(0); PG8_BAR; PG8_MMA(0, 0, At, B0); PG8_MMA(0, 1, At, B1); PG8_BAR; PG8_SCHED;
            PG8_LDA(At, 1, 1); PG8_STAGE(PG8_SB(1, 0), b3, voffB); PG8_STAGE(PG8_SB(1, 1), b3 + hstep, voffB); PG8_STAGE(PG8_SA(1, 0), a3, voffA);
            PG8_WAIT_V(8); PG8_WAIT_L(0); PG8_BAR; PG8_MMA(1, 0, At, B0); PG8_MMA(1, 1, At, B1); PG8_BAR; PG8_SCHED;
            } else {
            PG8_LDB(B0, 0, 0); PG8_SCHED; PG8_LDA(At, 0, 0); PG8_STAGE(PG8_SA(1, 1), a1 + hstep, voffA);
            PG8_WAIT_L(8); PG8_BAR; PG8_WAIT_L(0); PG8_MMA(0, 0, At, B0); PG8_BAR; PG8_SCHED;
            PG8_LDB(B1, 0, 1); PG8_STAGE(PG8_SB(0, 0), b2, voffB);
            PG8_BAR; PG8_WAIT_L(0); PG8_MMA(0, 1, At, B1); PG8_BAR;
            PG8_LDA(At, 0, 1); PG8_STAGE(PG8_SA(0, 0), a2, voffA);
            PG8_BAR; PG8_WAIT_L(0); PG8_MMA(1, 0, At, B0); PG8_BAR; PG8_SCHED;
            PG8_STAGE(PG8_SB(0, 1), b2 + hstep, voffB);
            PG8_WAIT_V(6); PG8_BAR; PG8_MMA(1, 1, At, B1); PG8_BAR;
            PG8_LDB(B0, 1, 0); PG8_SCHED; PG8_LDA(At, 1, 0); PG8_STAGE(PG8_SA(0, 1), a2 + hstep, voffA);
            PG8_WAIT_L(8); PG8_BAR; PG8_WAIT_L(0); PG8_MMA(0, 0, At, B0); PG8_BAR; PG8_SCHED;
            PG8_LDB(B1, 1, 1); PG8_STAGE(PG8_SB(1, 0), b3, voffB);
            PG8_BAR; PG8_WAIT_L(0); PG8_MMA(0, 1, At, B1); PG8_BAR;
            PG8_LDA(At, 1, 1); PG8_STAGE(PG8_SA(1, 0), a3, voffA);
            PG8_BAR; PG8_WAIT_L(0); PG8_MMA(1, 0, At, B0); PG8_BAR; PG8_SCHED;
            PG8_STAGE(PG8_SB(1, 1), b3 + hstep, voffB);
            PG8_WAIT_V(6); PG8_BAR; PG8_MMA(1, 1, At, B1); PG8_BAR;
            }
        }
        if constexpr (ALIGN_EPI) { if (wr == 0) PG8_BAR; }
        if constexpr (!Epi::AFTER_DRAIN) { int ln_e; asm volatile("v_mbcnt_lo_u32_b32 %0, -1, 0\n\tv_mbcnt_hi_u32_b32 %0, -1, %0" : "=v"(ln_e)); const int fr_e = ln_e & 15, fq_e = ln_e >> 4;
            E(acc, cur, wr, wc, fr_e, fq_e); S.done(cur); }
        if (!has_next) break;
#pragma unroll
        for (int a = 0; a < 2; ++a)
#pragma unroll
            for (int b = 0; b < 2; ++b)
#pragma unroll
                for (int m = 0; m < 4; ++m)
#pragma unroll
                    for (int n = 0; n < 2; ++n) acc[a][b][m][n] = (f32x4){0.f, 0.f, 0.f, 0.f};
        cur = nxt; cA = nA; cB = nB; ++ui;
        if constexpr (ALIGN_EPI) { if (wr == 1) PG8_BAR; }
    }
    PG8_WAIT_V(0);
    if constexpr (!ALIGN_EPI) { if (wr == 0) PG8_BAR; }
    PG8_BAR;
    if constexpr (Epi::AFTER_DRAIN) { E.fused(acc, cur, wr, wc, fr, fq, lds, wid, lane); S.done(cur); }
#undef PG8_SA
#undef PG8_SB
#undef PG8_STAGE
#undef PG8_LDA
#undef PG8_LDB
#undef PG8_MMA
#undef PG8_WAIT_V
#undef PG8_WAIT_L
#undef PG8_BAR
#undef PG8_SCHED
}
}
#define GAS __attribute__((address_space(1)))
#define LAS __attribute__((address_space(3)))
typedef unsigned short bf16;
typedef unsigned v4u __attribute__((ext_vector_type(4)));
typedef float f32x4 __attribute__((ext_vector_type(4)));
typedef short bf16x8 __attribute__((ext_vector_type(8)));
typedef GAS unsigned gu32;
typedef GAS unsigned long long gu64;
#define RLX_AGENT __ATOMIC_RELAXED, __HIP_MEMORY_SCOPE_AGENT
#define LDS_WAIT() asm volatile("s_waitcnt lgkmcnt(0)" ::: "memory")
#define VM_WAIT() asm volatile("s_waitcnt vmcnt(0)" ::: "memory")
__device__ __forceinline__ unsigned long long rt() { return __builtin_amdgcn_s_memrealtime(); }
__device__ __forceinline__ unsigned f2bf(float f) { unsigned u = __builtin_bit_cast(unsigned, f); return (u + 0x7fffu + ((u >> 16) & 1u)) >> 16; }
__device__ __forceinline__ unsigned pk2(float lo, float hi) { return f2bf(lo) | (f2bf(hi) << 16); }

#define XB_TMO      128
#define XB_XCNT(j)  (256  + 64 * (j))
#define XB_XSUB(j)  (1280 + 64 * (j))
#define XB_XGEN(j)  (2304 + 64 * (j))
#define XB_TOP      3328
#define XB_TOPGEN   3392
#define XCD_BAR_WORDS 3456
#define XB_SPIN_CAP (1u << 18)

__device__ __forceinline__ unsigned xb_ld(unsigned* p)              { return __hip_atomic_load(p, __ATOMIC_RELAXED, __HIP_MEMORY_SCOPE_AGENT); }
__device__ __forceinline__ unsigned xb_add(unsigned* p, unsigned v) { return __hip_atomic_fetch_add(p, v, __ATOMIC_RELAXED, __HIP_MEMORY_SCOPE_AGENT); }
__device__ __forceinline__ unsigned xb_xcc_id() { return (unsigned)__builtin_amdgcn_s_getreg((3 << 11) | 20) & 0xFu; }
#define XB_SPIN(cond, bar) do { unsigned _sp = 0; while (cond) { __builtin_amdgcn_s_sleep(1); \
    if ((++_sp & 255u) == 0u) { if (xb_ld(&(bar)[XB_TMO])) break; if (_sp > XB_SPIN_CAP) { atomicAdd(&(bar)[XB_TMO], 1u); break; } } } } while (0)

struct XcdBarrier {
    unsigned* bar; unsigned x; bool wave0;
    volatile LAS unsigned* st;
};

__device__ __forceinline__ XcdBarrier xcd_barrier_post(unsigned* bar, volatile LAS unsigned* st) {
    XcdBarrier b; b.bar = bar; b.x = xb_xcc_id(); b.st = st;
    if (threadIdx.x == 0) (void)xb_add(&bar[XB_XCNT(b.x)], 1u);
    return b;
}
__device__ __forceinline__ void xcd_barrier_complete(unsigned* bar, unsigned x, unsigned& nloc, unsigned& nx) {
    const unsigned G = gridDim.x * gridDim.y * gridDim.z;
    unsigned sum, cnt, mine, sp = 0u;
    for (;;) {
        sum = 0u; cnt = 0u; mine = 0u;
#pragma unroll
        for (unsigned j = 0; j < 16; ++j) { const unsigned c = xb_ld(&bar[XB_XCNT(j)]); sum += c; cnt += (c > 0u) ? 1u : 0u; mine = (j == x) ? c : mine; }
        if (sum == G) break;
        __builtin_amdgcn_s_sleep(1);
        if ((++sp & 255u) == 0u) { if (xb_ld(&bar[XB_TMO])) break; if (sp > XB_SPIN_CAP) { atomicAdd(&bar[XB_TMO], 1u); break; } }
    }
    nloc = mine > 0u ? mine : 1u; nx = cnt > 0u ? cnt : 1u;
}

__device__ __forceinline__ void xcd_barrier(const XcdBarrier& b) {
    asm volatile("s_waitcnt vmcnt(0)" ::: "memory");
    __syncthreads();
    if (b.wave0 && __builtin_amdgcn_mbcnt_hi(~0u, __builtin_amdgcn_mbcnt_lo(~0u, 0u)) == 0u) {
        unsigned* bar = b.bar;
        __builtin_amdgcn_s_waitcnt(0);
        unsigned nloc = b.st[0], nx = b.st[1];
        if (nloc == 0u) { xcd_barrier_complete(bar, b.x, nloc, nx); b.st[0] = nloc; b.st[1] = nx; }
        const unsigned old = xb_add(&bar[XB_XSUB(b.x)], 1u);
        const unsigned gen = old / nloc;
        if (old + 1u == (gen + 1u) * nloc) {
            __builtin_amdgcn_fence(__ATOMIC_RELEASE, "agent");
            asm volatile("s_waitcnt vmcnt(0)" ::: "memory");
            const unsigned og = xb_add(&bar[XB_TOP], 1u);
            const unsigned tg = og / nx;
            if (og + 1u == (tg + 1u) * nx) xb_add(&bar[XB_TOPGEN], 1u);
            else XB_SPIN(xb_ld(&bar[XB_TOPGEN]) == tg, bar);
            __builtin_amdgcn_fence(__ATOMIC_ACQUIRE, "agent");
            xb_add(&bar[XB_XGEN(b.x)], 1u);
            asm volatile("s_waitcnt vmcnt(0)" ::: "memory");
        } else {
            XB_SPIN(xb_ld(&bar[XB_XGEN(b.x)]) == gen, bar);
            __builtin_amdgcn_fence(__ATOMIC_ACQUIRE, "agent");
            asm volatile("s_waitcnt vmcnt(0)" ::: "memory");
        }
    }
    __syncthreads();
}

constexpr int NWAVES = 8, NTHREADS = NWAVES * 64;
constexpr int BATCH = 8, SEQ = 2048, T = BATCH * SEQ, D = 2048;
constexpr int EV_N = 7200, EV_NP = 7424, OD_N = 7616, OD_NP = 7680, PROJ_LD = 7680;
constexpr float EPS = 1e-6f;
constexpr int EC_GQ = 0, EC_GK = 512, EC_GV = 1024, EC_GZ = 2048, EC_GLR = 3072, EC_BQ = 3088, EC_BK = 4112, EC_BV = 5136, EC_BZ = 6160, EC_BA = 7184, EC_BB = 7192;
constexpr int OC_HQ = 0, OC_HF = 1024, OC_HI = 2048, OC_HG = 3072, OC_RW = 4096;
constexpr int RW_R = 0, RW_K = 1024, RW_V = 2048, RW_WL = 3072, RW_AL = 3168, RW_GL = 3264;
constexpr int LORA_K = 512, LORA_N = 3072;
enum { I_X = 0, I_P, I_EV_WIN, I_GK_W2, I_GK_B, I_GLA_NORM, I_GDN_CONV, I_GDN_ALOG, I_GDN_DTB, I_GDN_NORM, I_EV_WOUT, I_OD_WIN, I_LB, I_HG_NORM,
       I_MU, I_W0, I_W2, I_A0, I_A2, I_G2, I_KK, I_KA, I_RK, I_LNW, I_LNB, I_OD_WOUT, I_NMIX, I_NFFN, I_NPLE, I_PEER_WQ, I_PEER_SK, I_PEER_U, I_PEER_V,
       I_PLE_WP, I_PLE_WG, I_NFINAL, N_IN };

constexpr size_t MiB = 1u << 20;
constexpr size_t WS_CTL = 0, CTL_ZERO_BYTES = 1 * MiB, WS_SU = 256 * 1024, WS_CMB = 512 * 1024, WS_SA = 576 * 1024;
constexpr size_t WS_WEV_IN = 1 * MiB, WS_WEV_OUT = 30 * MiB, WS_WOD_IN = 38 * MiB, WS_WOD_OUT = 68 * MiB, WS_WPEER = 76 * MiB, WS_WGATE = 92 * MiB, WS_WPROJ = 108 * MiB,
                 WS_WLORA = 110 * MiB, WS_PBF = 113 * MiB, WS_TABU = 129 * MiB, WS_TABV = 193 * MiB, WS_ACTA = 257 * MiB, WS_ACTB = 321 * MiB, WS_PROJ = 385 * MiB, WS_SC = 385 * MiB,
                 WS_O = 625 * MiB, WS_H1 = 689 * MiB, WS_PP = 753 * MiB, WS_LA = 817 * MiB, WS_LO = 833 * MiB, WS_RSP = 929 * MiB, WS_STATE = 937 * MiB, WS_RS3 = 945 * MiB, WS_END = 946 * MiB;
static_assert(WS_WEV_IN + (size_t)EV_NP * D * 2 <= WS_WEV_OUT && WS_WOD_IN + (size_t)OD_NP * D * 2 <= WS_WOD_OUT && WS_PROJ + (size_t)T * PROJ_LD * 2 <= WS_O, "ws map");
constexpr int CW_BAR = 4096;
enum { RS_FFN0 = 0, RS_MIX1 = 1, RS_FFN1 = 2, RS_FINAL = 3 };
constexpr int RING_OFF = 0, RING_BYTES = 131072;
constexpr int LDSCTL_OFF = RING_BYTES, MISC_OFF = LDSCTL_OFF + 320;
constexpr int LDS_BYTES = 147456;

struct Args { const float* in[N_IN]; float* out; unsigned char* ws; int ph_lo, ph_hi; };
struct Frame {
    LAS unsigned char* lds; volatile LAS unsigned* MISC; gu32* ctl;
    int tid, lane, wave, vcu, G;
};
__device__ __forceinline__ float wave_sum(float v) {
#pragma unroll
    for (int o = 1; o < 64; o <<= 1) v += __shfl_xor(v, o);
    return v;
}
__device__ __forceinline__ float half_sum32(float v) {
#pragma unroll
    for (int o = 1; o < 32; o <<= 1) v += __shfl_xor(v, o);
    return v;
}
#define DPP_ADD(v, ctrl) (v) += __builtin_bit_cast(float, __builtin_amdgcn_update_dpp(0, __builtin_bit_cast(int, (v)), (ctrl), 0xF, 0xF, false))
__device__ __forceinline__ float row_sum16(float v) {
    DPP_ADD(v, 0x128); DPP_ADD(v, 0x124); DPP_ADD(v, 0x122); DPP_ADD(v, 0x121);
    return v;
}
__device__ __forceinline__ void row_sum16_x4(float& a, float& b, float& c, float& d) {
    asm("s_nop 1\n\t"
        "v_add_f32_dpp %0, %0, %0 row_ror:8 row_mask:0xf bank_mask:0xf\n\tv_add_f32_dpp %1, %1, %1 row_ror:8 row_mask:0xf bank_mask:0xf\n\t"
        "v_add_f32_dpp %2, %2, %2 row_ror:8 row_mask:0xf bank_mask:0xf\n\tv_add_f32_dpp %3, %3, %3 row_ror:8 row_mask:0xf bank_mask:0xf\n\t"
        "v_add_f32_dpp %0, %0, %0 row_ror:4 row_mask:0xf bank_mask:0xf\n\tv_add_f32_dpp %1, %1, %1 row_ror:4 row_mask:0xf bank_mask:0xf\n\t"
        "v_add_f32_dpp %2, %2, %2 row_ror:4 row_mask:0xf bank_mask:0xf\n\tv_add_f32_dpp %3, %3, %3 row_ror:4 row_mask:0xf bank_mask:0xf\n\t"
        "v_add_f32_dpp %0, %0, %0 row_ror:2 row_mask:0xf bank_mask:0xf\n\tv_add_f32_dpp %1, %1, %1 row_ror:2 row_mask:0xf bank_mask:0xf\n\t"
        "v_add_f32_dpp %2, %2, %2 row_ror:2 row_mask:0xf bank_mask:0xf\n\tv_add_f32_dpp %3, %3, %3 row_ror:2 row_mask:0xf bank_mask:0xf\n\t"
        "v_add_f32_dpp %0, %0, %0 row_ror:1 row_mask:0xf bank_mask:0xf\n\tv_add_f32_dpp %1, %1, %1 row_ror:1 row_mask:0xf bank_mask:0xf\n\t"
        "v_add_f32_dpp %2, %2, %2 row_ror:1 row_mask:0xf bank_mask:0xf\n\tv_add_f32_dpp %3, %3, %3 row_ror:1 row_mask:0xf bank_mask:0xf\n\t"
        "s_nop 1"
        : "+v"(a), "+v"(b), "+v"(c), "+v"(d));
}
__device__ __forceinline__ void row_sum16_x2(float& a, float& b) {
    asm("s_nop 1\n\t"
        "v_add_f32_dpp %0, %0, %0 row_ror:8 row_mask:0xf bank_mask:0xf\n\tv_add_f32_dpp %1, %1, %1 row_ror:8 row_mask:0xf bank_mask:0xf\n\ts_nop 1\n\t"
        "v_add_f32_dpp %0, %0, %0 row_ror:4 row_mask:0xf bank_mask:0xf\n\tv_add_f32_dpp %1, %1, %1 row_ror:4 row_mask:0xf bank_mask:0xf\n\ts_nop 1\n\t"
        "v_add_f32_dpp %0, %0, %0 row_ror:2 row_mask:0xf bank_mask:0xf\n\tv_add_f32_dpp %1, %1, %1 row_ror:2 row_mask:0xf bank_mask:0xf\n\ts_nop 1\n\t"
        "v_add_f32_dpp %0, %0, %0 row_ror:1 row_mask:0xf bank_mask:0xf\n\tv_add_f32_dpp %1, %1, %1 row_ror:1 row_mask:0xf bank_mask:0xf\n\t"
        "s_nop 1"
        : "+v"(a), "+v"(b));
}
typedef unsigned u32x2 __attribute__((ext_vector_type(2)));
__device__ __forceinline__ void st_wt16(void* p, v4u v) { asm volatile("global_store_dwordx4 %0, %1, off sc1\n\ts_nop 1" :: "v"(p), "v"(v) : "memory"); }
__device__ __forceinline__ void st_wt8(void* p, u32x2 v) { asm volatile("global_store_dwordx2 %0, %1, off sc1\n\ts_nop 1" :: "v"(p), "v"(v) : "memory"); }
#define LBAR() do { asm volatile("s_waitcnt lgkmcnt(0)" ::: "memory"); __builtin_amdgcn_s_barrier(); asm volatile("" ::: "memory"); } while (0)
typedef float f32x2 __attribute__((ext_vector_type(2)));
typedef __bf16 hwbf16x2_t __attribute__((ext_vector_type(2)));
__device__ __forceinline__ unsigned hw_pk2(float lo, float hi) { const f32x2 v = {lo, hi}; return __builtin_bit_cast(unsigned, __builtin_convertvector(v, hwbf16x2_t)); }
__device__ __forceinline__ bf16 hw_bf(float x) { return (bf16)hw_pk2(x, 0.f); }
__device__ __forceinline__ float bf_lo(unsigned w) { return __uint_as_float(w << 16); }
__device__ __forceinline__ float bf_hi(unsigned w) { return __uint_as_float(w & 0xffff0000u); }
__device__ __forceinline__ float sigmoidf_(float x) { return __builtin_amdgcn_rcpf(1.0f + __expf(-x)); }
__device__ __forceinline__ float siluf_(float x) { return x * __builtin_amdgcn_rcpf(1.0f + __expf(-x)); }
__device__ __forceinline__ float softplusf_(float x) { return fmaxf(x, 0.f) + log1pf(__expf(-fabsf(x))); }
__device__ __forceinline__ float logsigmoidf_(float x) { return fminf(x, 0.f) - log1pf(__expf(-fabsf(x))); }

struct EpiBf16S {
    static constexpr bool PERM = true, AFTER_DRAIN = false;
    bf16* O; int ldc; const float* rowss;
    __device__ __forceinline__ void operator()(const pg8::f32x4 (&acc)[2][2][4][2], const pg8::Unit& u, int wr, int wc, int fr, int fq) const {
        const int row0 = u.pm * 256 + wr * 64 + fr, col0 = u.pn * 256 + wc * 32 + 8 * fq;
#pragma unroll
        for (int ai = 0; ai < 2; ++ai)
#pragma unroll
            for (int m = 0; m < 4; ++m) {
                const int row = row0 + ai * 128 + m * 16;
                float sc = 1.f;
                if (rowss) { const pg8::f32x4* rp = (const pg8::f32x4*)(rowss + (size_t)row * 32 + 8 * fq); const pg8::f32x4 p0 = rp[0], p1 = rp[1];
                    float s = ((p0[0] + p0[1]) + (p0[2] + p0[3])) + ((p1[0] + p1[1]) + (p1[2] + p1[3])); s += __shfl_xor(s, 16); s += __shfl_xor(s, 32);
                    sc = __builtin_amdgcn_rsqf(s * (1.0f / D) + EPS); }
                bf16* rowp = O + (size_t)row * ldc + col0;
#pragma unroll
                for (int bj = 0; bj < 2; ++bj) { const pg8::f32x4 v0 = acc[ai][bj][m][0] * sc, v1 = acc[ai][bj][m][1] * sc;
                    pg8::u32x4 w; w.x = pg8::cvt_pk_bf16(v0[0], v0[1]); w.y = pg8::cvt_pk_bf16(v0[2], v0[3]); w.z = pg8::cvt_pk_bf16(v1[0], v1[1]); w.w = pg8::cvt_pk_bf16(v1[2], v1[3]);
                    *(pg8::u32x4*)(rowp + bj * 128) = w; } }
    }
};
struct EpiI8S {
    static constexpr bool PERM = true, AFTER_DRAIN = false;
    bf16* O; int ldc; const float* sa; const float* cb;
    __device__ __forceinline__ void operator()(const pg8::f32x4 (&acc)[2][2][4][2], const pg8::Unit& u, int wr, int wc, int fr, int fq) const {
        const int row0 = u.pm * 256 + wr * 64 + fr, col0 = u.pn * 256 + wc * 32 + 8 * fq;
        pg8::f32x4 cs[2][2];
#pragma unroll
        for (int bj = 0; bj < 2; ++bj) { cs[bj][0] = *(const pg8::f32x4*)(cb + col0 + bj * 128); cs[bj][1] = *(const pg8::f32x4*)(cb + col0 + bj * 128 + 4); }
#pragma unroll
        for (int ai = 0; ai < 2; ++ai)
#pragma unroll
            for (int m = 0; m < 4; ++m) {
                const int row = row0 + ai * 128 + m * 16;
                const float sc = sa[row];
                bf16* rowp = O + (size_t)row * ldc + col0;
#pragma unroll
                for (int bj = 0; bj < 2; ++bj) { pg8::f32x4 v0, v1;
#pragma unroll
                    for (int e = 0; e < 4; ++e) { v0[e] = (float)__float_as_int(acc[ai][bj][m][0][e]) * sc * cs[bj][0][e]; v1[e] = (float)__float_as_int(acc[ai][bj][m][1][e]) * sc * cs[bj][1][e]; }
                    pg8::u32x4 w; w.x = pg8::cvt_pk_bf16(v0[0], v0[1]); w.y = pg8::cvt_pk_bf16(v0[2], v0[3]); w.z = pg8::cvt_pk_bf16(v1[0], v1[1]); w.w = pg8::cvt_pk_bf16(v1[2], v1[3]);
                    *(pg8::u32x4*)(rowp + bj * 128) = w; } }
    }
};
template <bool GATE, bool HIN_F32, bool I8 = false> struct EpiResid {
    static constexpr bool PERM = false, AFTER_DRAIN = false;
    const void* hin; bf16* hout; float* rowss; const bf16* pp; const float* rs3; unsigned char* h8; const float* sa; const float* cb;
    __device__ __forceinline__ void operator()(const pg8::f32x4 (&acc)[2][2][4][2], const pg8::Unit& u, int wr, int wc, int fr, int fq) const {
        const int row0 = u.pm * 256 + wr * 64 + fr, col0 = u.pn * 256 + wc * 32 + 4 * fq;
        pg8::f32x4 cs[2][2];
        if constexpr (I8) {
#pragma unroll
            for (int bj = 0; bj < 2; ++bj)
#pragma unroll
                for (int n = 0; n < 2; ++n) cs[bj][n] = *(const pg8::f32x4*)(cb + col0 + bj * 128 + n * 16); }
        constexpr int MG = HIN_F32 ? 2 : 4;
#pragma unroll
        for (int ai = 0; ai < 2; ++ai)
#pragma unroll
            for (int m0 = 0; m0 < 4; m0 += MG) {
                pg8::f32x4 hf[MG][2][2]; pg8::u32x2 hb[MG][2][2], pw[MG][2][2]; float rsc[MG];
#pragma unroll
                for (int mm = 0; mm < MG; ++mm) { const int row = row0 + ai * 128 + (m0 + mm) * 16; const size_t off = (size_t)row * D + col0; rsc[mm] = GATE ? rs3[row] : (I8 ? sa[row] : 1.f);
#pragma unroll
                    for (int bj = 0; bj < 2; ++bj)
#pragma unroll
                        for (int n = 0; n < 2; ++n) { const size_t o = off + bj * 128 + n * 16;
                            if (HIN_F32) hf[mm][bj][n] = *(const pg8::f32x4*)((const float*)hin + o); else hb[mm][bj][n] = *(const pg8::u32x2*)((const bf16*)hin + o);
                            if (GATE) pw[mm][bj][n] = *(const pg8::u32x2*)(pp + o); } }
#pragma unroll
                for (int mm = 0; mm < MG; ++mm) { const int m = m0 + mm; const int row = row0 + ai * 128 + m * 16; const size_t off = (size_t)row * D + col0; float ss = 0.f;
#pragma unroll
                    for (int bj = 0; bj < 2; ++bj)
#pragma unroll
                        for (int n = 0; n < 2; ++n) { const size_t o = off + bj * 128 + n * 16;
                            pg8::f32x4 hv;
                            if (HIN_F32) hv = hf[mm][bj][n];
                            else { const pg8::u32x2 hw = hb[mm][bj][n]; hv[0] = bf_lo(hw.x); hv[1] = bf_hi(hw.x); hv[2] = bf_lo(hw.y); hv[3] = bf_hi(hw.y); }
                            pg8::f32x4 a = acc[ai][bj][m][n];
                            if constexpr (I8 && !GATE) { const float sr_ = rsc[mm];
#pragma unroll
                                for (int e = 0; e < 4; ++e) a[e] = (float)__float_as_int(a[e]) * sr_ * cs[bj][n][e]; }
                            if (GATE) { const pg8::u32x2 p2 = pw[mm][bj][n]; const float rs_ = rsc[mm];
                                a[0] = sigmoidf_(a[0] * rs_) * bf_lo(p2.x); a[1] = sigmoidf_(a[1] * rs_) * bf_hi(p2.x); a[2] = sigmoidf_(a[2] * rs_) * bf_lo(p2.y); a[3] = sigmoidf_(a[3] * rs_) * bf_hi(p2.y); }
                            hv = hv + a;
                            pg8::u32x2 w; w.x = hw_pk2(hv[0], hv[1]); w.y = hw_pk2(hv[2], hv[3]); *(pg8::u32x2*)(hout + o) = w;
                            if (h8) { int x8 = __builtin_amdgcn_cvt_pk_fp8_f32(hv[0], hv[1], 0, false); x8 = __builtin_amdgcn_cvt_pk_fp8_f32(hv[2], hv[3], x8, true); *(unsigned*)(h8 + o) = (unsigned)x8; }
                            const float q0 = bf_lo(w.x), q1 = bf_hi(w.x), q2 = bf_lo(w.y), q3 = bf_hi(w.y);
                            ss += (q0 * q0 + q1 * q1) + (q2 * q2 + q3 * q3); }
                    ss += __shfl_xor(ss, 16); ss += __shfl_xor(ss, 32);
                    if (fq == 0) rowss[(size_t)row * 32 + u.pn * 4 + wc] = ss; }
                asm volatile("" ::: "memory"); }
    }
};


__device__ __forceinline__ void p0_transpose_item(const float* W, int K, int N, bf16* WT, LAS float* scr, int item, int lane, const float* kgain = nullptr) {
    const int nblk = N / 32, kb = item / nblk, nb = item % nblk, k0 = 64 * kb, n0 = 32 * nb;
    { const GAS float* Wg = (const GAS float*)W + (size_t)(k0 + (lane >> 5)) * N + n0 + (lane & 31); float v[32];
#pragma unroll
      for (int i = 0; i < 32; ++i) v[i] = Wg[(size_t)(2 * i) * N];
#pragma unroll
      for (int i = 0; i < 32; ++i) scr[(2 * i + (lane >> 5)) * 33 + (lane & 31)] = v[i]; }
    LDS_WAIT(); asm volatile("" ::: "memory");
    const int c = lane & 7;
#pragma unroll
    for (int j = 0; j < 4; ++j) { const int n = (lane >> 3) + 8 * j; const LAS float* s = scr + (8 * c) * 33 + n;
        f32x4 g0 = {1.f, 1.f, 1.f, 1.f}, g1 = g0; if (kgain) { g0 = *(const GAS f32x4*)(kgain + k0 + 8 * c); g1 = *(const GAS f32x4*)(kgain + k0 + 8 * c + 4); }
        v4u o; o.x = pk2(s[0 * 33] * g0[0], s[1 * 33] * g0[1]); o.y = pk2(s[2 * 33] * g0[2], s[3 * 33] * g0[3]); o.z = pk2(s[4 * 33] * g1[0], s[5 * 33] * g1[1]); o.w = pk2(s[6 * 33] * g1[2], s[7 * 33] * g1[3]);
        *(GAS v4u*)(WT + (size_t)(n0 + n) * K + k0 + 8 * c) = o; }
    LDS_WAIT(); asm volatile("" ::: "memory");
}
__device__ __forceinline__ void p0_transpose_item_i8(const float* W, int K, int N, unsigned char* WT, LAS float* scr, int item, int lane, const float* cm) {
    const int nblk = N / 32, kb = item / nblk, nb = item % nblk, k0 = 64 * kb, n0 = 32 * nb;
    { const GAS float* Wg = (const GAS float*)W + (size_t)(k0 + (lane >> 5)) * N + n0 + (lane & 31); float v[32];
#pragma unroll
      for (int i = 0; i < 32; ++i) v[i] = Wg[(size_t)(2 * i) * N];
#pragma unroll
      for (int i = 0; i < 32; ++i) scr[(2 * i + (lane >> 5)) * 33 + (lane & 31)] = v[i]; }
    LDS_WAIT(); asm volatile("" ::: "memory");
    const int c = lane & 7;
#pragma unroll
    for (int j = 0; j < 4; ++j) { const int n = (lane >> 3) + 8 * j; const LAS float* s = scr + (8 * c) * 33 + n;
        const float mx = __uint_as_float(__hip_atomic_load((const unsigned*)cm + n0 + n, __ATOMIC_RELAXED, __HIP_MEMORY_SCOPE_AGENT)), inv = mx > 0.f ? 127.0f / mx : 0.f; unsigned w0 = 0, w1 = 0;
#pragma unroll
        for (int e = 0; e < 4; ++e) { w0 |= (__float_as_uint(__builtin_fmaf(s[e * 33], inv, 12582912.0f)) & 255u) << (8 * e); w1 |= (__float_as_uint(__builtin_fmaf(s[(4 + e) * 33], inv, 12582912.0f)) & 255u) << (8 * e); }
        u32x2 o; o.x = w0; o.y = w1;
        *(GAS u32x2*)(WT + (size_t)(n0 + n) * K + k0 + 8 * c) = o; }
    LDS_WAIT(); asm volatile("" ::: "memory");
}
__device__ __forceinline__ void colmax_item(const float* W, int K, int N, float* cm, int item, int lane) {
    const int ngrp = (N + 255) / 256, kb = item / ngrp, cg_ = item % ngrp, col = 256 * cg_ + 4 * lane;
    if (col >= N) return;
    const GAS f32x4* p = (const GAS f32x4*)((const GAS float*)W + (size_t)(64 * kb) * N + col); f32x4 m = {0.f, 0.f, 0.f, 0.f};
#pragma unroll 16
    for (int r = 0; r < 64; ++r) { const f32x4 v = *(const GAS f32x4*)((const GAS float*)p + (size_t)r * N);
#pragma unroll
        for (int e = 0; e < 4; ++e) m[e] = fmaxf(m[e], fabsf(v[e])); }
#pragma unroll
    for (int e = 0; e < 4; ++e) __hip_atomic_fetch_max((unsigned*)cm + col + e, __float_as_uint(m[e]), __ATOMIC_RELAXED, __HIP_MEMORY_SCOPE_AGENT);
}
__device__ __forceinline__ void p0_transpose_item_f8(const float* W, int K, int N, unsigned char* WT, LAS float* scr, int item, int lane, const float* kgain = nullptr) {
    const int nblk = N / 32, kb = item / nblk, nb = item % nblk, k0 = 64 * kb, n0 = 32 * nb;
    { const GAS float* Wg = (const GAS float*)W + (size_t)(k0 + (lane >> 5)) * N + n0 + (lane & 31); float v[32];
#pragma unroll
      for (int i = 0; i < 32; ++i) v[i] = Wg[(size_t)(2 * i) * N];
#pragma unroll
      for (int i = 0; i < 32; ++i) scr[(2 * i + (lane >> 5)) * 33 + (lane & 31)] = v[i]; }
    LDS_WAIT(); asm volatile("" ::: "memory");
    const int c = lane & 7;
#pragma unroll
    for (int j = 0; j < 4; ++j) { const int n = (lane >> 3) + 8 * j; const LAS float* s = scr + (8 * c) * 33 + n;
        f32x4 g0 = {64.f, 64.f, 64.f, 64.f}, g1 = g0; if (kgain) { g0 = g0 * *(const GAS f32x4*)(kgain + k0 + 8 * c); g1 = g1 * *(const GAS f32x4*)(kgain + k0 + 8 * c + 4); }
        int x0 = __builtin_amdgcn_cvt_pk_fp8_f32(s[0 * 33] * g0[0], s[1 * 33] * g0[1], 0, false); x0 = __builtin_amdgcn_cvt_pk_fp8_f32(s[2 * 33] * g0[2], s[3 * 33] * g0[3], x0, true);
        int x1 = __builtin_amdgcn_cvt_pk_fp8_f32(s[4 * 33] * g1[0], s[5 * 33] * g1[1], 0, false); x1 = __builtin_amdgcn_cvt_pk_fp8_f32(s[6 * 33] * g1[2], s[7 * 33] * g1[3], x1, true);
        u32x2 o; o.x = (unsigned)x0; o.y = (unsigned)x1;
        *(GAS u32x2*)(WT + (size_t)(n0 + n) * K + k0 + 8 * c) = o; }
    LDS_WAIT(); asm volatile("" ::: "memory");
}
__device__ __forceinline__ void cvt_f32_bf16(const float* src, bf16* dst, size_t n, int gtid, int gthreads) {
    const size_t n8 = n / 8;
    for (size_t i = gtid; i < n8; i += gthreads) {
        const f32x4 a = *(const GAS f32x4*)(src + i * 8), b = *(const GAS f32x4*)(src + i * 8 + 4);
        v4u o; o.x = pk2(a[0], a[1]); o.y = pk2(a[2], a[3]); o.z = pk2(b[0], b[1]); o.w = pk2(b[2], b[3]);
        *(GAS v4u*)(dst + i * 8) = o; }
}
__device__ __forceinline__ void cvt_f32_fp8(const float* src, unsigned char* dst, size_t n, float scale, int gtid, int gthreads, const float* cgain = nullptr) {
    const size_t n16 = n / 16;
    for (size_t i = gtid; i < n16; i += gthreads) { v4u o; unsigned w[4];
#pragma unroll
        for (int q = 0; q < 4; ++q) { f32x4 a = *(const GAS f32x4*)(src + i * 16 + 4 * q) * scale; if (cgain) a = a * *(const GAS f32x4*)(cgain + ((i * 16 + 4 * q) & (D - 1)));
            int x = __builtin_amdgcn_cvt_pk_fp8_f32(a[0], a[1], 0, false); x = __builtin_amdgcn_cvt_pk_fp8_f32(a[2], a[3], x, true); w[q] = (unsigned)x; }
        o.x = w[0]; o.y = w[1]; o.z = w[2]; o.w = w[3];
        *(GAS v4u*)(dst + i * 16) = o; }
}
__device__ __forceinline__ void cvt_rows_i8(const float* src, unsigned char* dst, float* SU, int rows, int gw, int NGW, int lane, const float* cgain) {
    f32x4 a[8], nx[8];
    int r = gw;
    if (r < rows) {
#pragma unroll
        for (int i = 0; i < 8; ++i) a[i] = *(const GAS f32x4*)(src + (size_t)r * D + 256 * i + 4 * lane); }
    for (; r < rows; r += NGW) {
        const int rn = r + NGW;
        if (rn < rows) {
#pragma unroll
            for (int i = 0; i < 8; ++i) nx[i] = *(const GAS f32x4*)(src + (size_t)rn * D + 256 * i + 4 * lane); }
        float mx = 0.f;
#pragma unroll
        for (int i = 0; i < 8; ++i) { if (cgain) a[i] = a[i] * *(const GAS f32x4*)(cgain + 256 * i + 4 * lane);
            mx = fmaxf(mx, fmaxf(fmaxf(fabsf(a[i][0]), fabsf(a[i][1])), fmaxf(fabsf(a[i][2]), fabsf(a[i][3])))); }
#pragma unroll
        for (int o = 1; o < 64; o <<= 1) mx = fmaxf(mx, __shfl_xor(mx, o));
        const float inv = mx > 0.f ? 127.0f / mx : 0.f;
#pragma unroll
        for (int i = 0; i < 8; ++i) { unsigned w = 0;
#pragma unroll
            for (int e = 0; e < 4; ++e) w |= (__float_as_uint(__builtin_fmaf(a[i][e], inv, 12582912.0f)) & 255u) << (8 * e);
            *(GAS unsigned*)(dst + (size_t)r * D + 256 * i + 4 * lane) = w; }
        if (lane == 0) SU[r] = mx * (1.0f / 127.0f);
#pragma unroll
        for (int i = 0; i < 8; ++i) a[i] = nx[i];
    }
}
__device__ __forceinline__ void rms_row_to_bf16(const float* xrow, const float* g, bf16* orow, int lane) {
    const GAS f32x4* xr = (const GAS f32x4*)xrow + lane; f32x4 v[8]; float s = 0.f;
#pragma unroll
    for (int j = 0; j < 8; ++j) { v[j] = xr[64 * j]; s += (v[j][0] * v[j][0] + v[j][1] * v[j][1]) + (v[j][2] * v[j][2] + v[j][3] * v[j][3]); }
    const float r = __builtin_amdgcn_rsqf(wave_sum(s) * (1.0f / D) + EPS);
    const GAS f32x4* gr = (const GAS f32x4*)g + lane;
    GAS unsigned long long* o8 = (GAS unsigned long long*)orow + lane;
#pragma unroll
    for (int j = 0; j < 8; ++j) { const f32x4 gg = gr[64 * j]; o8[64 * j] = (unsigned long long)pk2(v[j][0] * r * gg[0], v[j][1] * r * gg[1]) | ((unsigned long long)pk2(v[j][2] * r * gg[2], v[j][3] * r * gg[3]) << 32); }
}
__device__ __forceinline__ void rms_rows_to_i8(const float* x, const float* g, unsigned char* out, float* sa, int m0, int step, int mend, int lane) {
    const GAS f32x4* gr = (const GAS f32x4*)g + lane; f32x4 gg[8];
#pragma unroll
    for (int j = 0; j < 8; ++j) gg[j] = gr[64 * j];
    f32x4 v[8], nx[8];
    if (m0 < mend) { const GAS f32x4* xr = (const GAS f32x4*)(x + (size_t)m0 * D) + lane;
#pragma unroll
        for (int j = 0; j < 8; ++j) v[j] = xr[64 * j]; }
    for (int m = m0; m < mend; m += step) {
        if (m + step < mend) { const GAS f32x4* xr = (const GAS f32x4*)(x + (size_t)(m + step) * D) + lane;
#pragma unroll
            for (int j = 0; j < 8; ++j) nx[j] = xr[64 * j]; }
        float s = 0.f;
#pragma unroll
        for (int j = 0; j < 8; ++j) s += (v[j][0] * v[j][0] + v[j][1] * v[j][1]) + (v[j][2] * v[j][2] + v[j][3] * v[j][3]);
        const float r = __builtin_amdgcn_rsqf(wave_sum(s) * (1.0f / D) + EPS);
        float mx = 0.f;
#pragma unroll
        for (int j = 0; j < 8; ++j) { v[j] = v[j] * gg[j] * r; mx = fmaxf(mx, fmaxf(fmaxf(fabsf(v[j][0]), fabsf(v[j][1])), fmaxf(fabsf(v[j][2]), fabsf(v[j][3])))); }
#pragma unroll
        for (int o = 1; o < 64; o <<= 1) mx = fmaxf(mx, __shfl_xor(mx, o));
        const float inv = mx > 0.f ? 127.0f / mx : 0.f;
        GAS unsigned* o4 = (GAS unsigned*)(out + (size_t)m * D) + lane;
#pragma unroll
        for (int j = 0; j < 8; ++j) { unsigned w = 0;
#pragma unroll
            for (int e = 0; e < 4; ++e) w |= (__float_as_uint(__builtin_fmaf(v[j][e], inv, 12582912.0f)) & 255u) << (8 * e);
            o4[64 * j] = w; }
        if (lane == 0) sa[m] = mx * (1.0f / (127.0f * 127.0f));
#pragma unroll
        for (int j = 0; j < 8; ++j) v[j] = nx[j];
    }
}
__device__ __forceinline__ void rms_row_to_f8(const float* xrow, const float* g, unsigned char* orow, int lane) {
    const GAS f32x4* xr = (const GAS f32x4*)xrow + lane; f32x4 v[8]; float s = 0.f;
#pragma unroll
    for (int j = 0; j < 8; ++j) { v[j] = xr[64 * j]; s += (v[j][0] * v[j][0] + v[j][1] * v[j][1]) + (v[j][2] * v[j][2] + v[j][3] * v[j][3]); }
    const float r = __builtin_amdgcn_rsqf(wave_sum(s) * (1.0f / D) + EPS);
    const GAS f32x4* gr = (const GAS f32x4*)g + lane;
    GAS unsigned* o4 = (GAS unsigned*)orow + lane;
#pragma unroll
    for (int j = 0; j < 8; ++j) { const f32x4 q = v[j] * gr[64 * j] * r; int x = __builtin_amdgcn_cvt_pk_fp8_f32(q[0], q[1], 0, false); x = __builtin_amdgcn_cvt_pk_fp8_f32(q[2], q[3], x, true); o4[64 * j] = (unsigned)x; }
}
__device__ __forceinline__ void p0_fold_item(const float* wq, const float* sk, bf16* WP, LAS float* lds, int item, int tid, const float* kgain) {
    const int hp = item >> 5, k0 = (item & 31) * 64;
    LAS float* skT = lds;
    LAS float* wqT = lds + 128 * 132;
    const float* skb = sk + (size_t)hp * 128 * 128;
    { const GAS float* sg = (const GAS float*)skb; const GAS float* wg = (const GAS float*)wq; const GAS float* kg = (const GAS float*)kgain; float v[32], w[16];
#pragma unroll
      for (int i = 0; i < 32; ++i) v[i] = sg[i * 512 + tid];
#pragma unroll
      for (int i = 0; i < 16; ++i) { const int idx = i * 512 + tid, kk = idx >> 7, d = idx & 127; w[i] = wg[(size_t)(k0 + kk) * D + hp * 128 + d] * kg[k0 + kk]; }
#pragma unroll
      for (int i = 0; i < 32; ++i) { const int idx = i * 512 + tid, n = idx >> 7, d = idx & 127; skT[d * 132 + n] = v[i]; }
#pragma unroll
      for (int i = 0; i < 16; ++i) { const int idx = i * 512 + tid, kk = idx >> 7, d = idx & 127; wqT[d * 68 + kk] = w[i]; } }
    __syncthreads();
    const int n0 = (tid >> 4) * 4, kk0 = (tid & 15) * 4;
    float acc[4][4];
#pragma unroll
    for (int i = 0; i < 4; ++i)
#pragma unroll
        for (int j = 0; j < 4; ++j) acc[i][j] = 0.f;
#pragma unroll 4
    for (int d = 0; d < 128; ++d) { const f32x4 a = *(const LAS f32x4*)(skT + d * 132 + n0), b = *(const LAS f32x4*)(wqT + d * 68 + kk0);
#pragma unroll
        for (int i = 0; i < 4; ++i)
#pragma unroll
            for (int j = 0; j < 4; ++j) acc[i][j] += a[i] * b[j]; }
#pragma unroll
    for (int i = 0; i < 4; ++i) { unsigned long long o = (unsigned long long)pk2(acc[i][0], acc[i][1]) | ((unsigned long long)pk2(acc[i][2], acc[i][3]) << 32);
        *(GAS unsigned long long*)(WP + (size_t)(hp * 128 + n0 + i) * D + k0 + kk0) = o; }
    __syncthreads();
}
__device__ __forceinline__ void p0_prologue(const Args& A, Frame& F, const int part) {
    const int gw = F.vcu * NWAVES + F.wave, NGW = F.G * NWAVES;
    const int gtid = gw * 64 + F.lane, gthreads = F.G * NTHREADS;
    unsigned char* ws = A.ws;
    LAS float* scr = (LAS float*)(F.lds + RING_OFF + F.wave * 16384);
    constexpr int I_EVIN = (D / 64) * (EV_N / 32);
    if (part == 1) {
        for (int it = gw; it < I_EVIN; it += NGW) p0_transpose_item_i8(A.in[I_EV_WIN], D, EV_N, (unsigned char*)(ws + WS_WEV_IN), scr, it, F.lane, (const float*)(ws + WS_CMB));
        rms_rows_to_i8(A.in[I_X], A.in[I_NMIX], (unsigned char*)(ws + WS_ACTA), (float*)(ws + WS_SA), gw, NGW, T, F.lane);
        return; }
    { constexpr int I_CM = (D / 64) * ((EV_N + 255) / 256);
      for (int it = gw; it < I_CM; it += NGW) colmax_item(A.in[I_EV_WIN], D, EV_N, (float*)(ws + WS_CMB), it, F.lane); }
    { GAS v4u* z0 = (GAS v4u*)(ws + WS_WEV_IN + (size_t)EV_N * D); const size_t n0 = (size_t)(EV_NP - EV_N) * D / 16;
      for (size_t i = gtid; i < n0; i += gthreads) z0[i] = (v4u){0u, 0u, 0u, 0u}; }
    { constexpr int I_PJ = (256 / 64) * (D / 32);
      for (int it = gw; it < 2 * I_PJ; it += NGW) { const int L = it / I_PJ; p0_transpose_item(A.in[I_PLE_WP] + (size_t)L * 256 * D, 256, D, (bf16*)(ws + WS_WPROJ) + (size_t)L * D * 256, scr, it % I_PJ, F.lane); } }
    if (F.G < 256) cvt_f32_bf16(A.in[I_P], (bf16*)(ws + WS_PBF), (size_t)2 * T * 256, gtid, gthreads);
#if EV_F8_T1 > EV_F8_T0
    for (int it = gw; it < I_EVIN; it += NGW) p0_transpose_item_f8(A.in[I_EV_WIN], D, EV_N, (unsigned char*)(ws + WS_O), scr, it, F.lane);
    { GAS v4u* z0 = (GAS v4u*)(ws + WS_O + (size_t)EV_N * D); const size_t n0 = (size_t)(EV_NP - EV_N) * D / 16;
      for (size_t i = gtid; i < n0; i += gthreads) z0[i] = (v4u){0u, 0u, 0u, 0u}; }
    for (int m = gw; m < T; m += NGW) rms_row_to_f8(A.in[I_X] + (size_t)m * D, A.in[I_NMIX], (unsigned char*)(ws + WS_H1) + (size_t)m * D, F.lane);
#endif
}
__device__ __forceinline__ void p0_deferred(const Args& A, Frame& F, int wg, int nwg) {
    const int gw = wg * NWAVES + F.wave, NGW = nwg * NWAVES;
    int gtid = gw * 64 + F.lane; const int gthreads = nwg * NTHREADS;
    asm volatile("" : "+v"(gtid));
    unsigned char* ws = A.ws;
    {
        LAS float* scr = (LAS float*)(F.lds + RING_OFF + F.wave * 16384);
        constexpr int I_SQ = (D / 64) * (D / 32), I_ODIN = (D / 64) * (OD_N / 32);
        constexpr int NITEMS = I_SQ + I_ODIN + I_SQ;
        for (int it = gw; it < NITEMS; it += NGW) {
            int r = it;
            if (r < I_SQ) { p0_transpose_item(A.in[I_EV_WOUT], D, D, (bf16*)(ws + WS_WEV_OUT), scr, r, F.lane); continue; } r -= I_SQ;
            if (r < I_ODIN) { p0_transpose_item_f8(A.in[I_OD_WIN], D, OD_N, (unsigned char*)(ws + WS_WOD_IN), scr, r, F.lane, A.in[I_NMIX] + D); continue; } r -= I_ODIN;
            p0_transpose_item_f8(A.in[I_PLE_WG], D, D, (unsigned char*)(ws + WS_WGATE), scr, r, F.lane, A.in[I_NPLE]);
        }
        { GAS v4u* z1 = (GAS v4u*)(ws + WS_WOD_IN + (size_t)OD_N * D); const size_t n1 = (size_t)(OD_NP - OD_N) * D / 16;
          for (size_t i = gtid; i < n1; i += gthreads) z1[i] = (v4u){0u, 0u, 0u, 0u}; }
    }
    __syncthreads();
    for (int it = wg; it < 512; it += nwg)
        p0_fold_item(A.in[I_PEER_WQ], A.in[I_PEER_SK], (bf16*)(ws + WS_WPEER), (LAS float*)(F.lds + RING_OFF), it, F.tid, A.in[I_NFFN]);
    cvt_rows_i8(A.in[I_PEER_U], (unsigned char*)(ws + WS_TABU), (float*)(ws + WS_SU), 16384, gw, NGW, F.lane, A.in[I_NFFN]);
    cvt_rows_i8(A.in[I_PEER_V], (unsigned char*)(ws + WS_TABV), (float*)(ws + WS_SU) + 32768, 16384, gw, NGW, F.lane, nullptr);
    { bf16* LB = (bf16*)(ws + WS_WLORA); const float* w2 = A.in[I_W2]; const float* a2 = A.in[I_A2]; const float* g2 = A.in[I_G2];
      for (int i = gtid; i < LORA_N * LORA_K / 2; i += gthreads) { const int row = i / (LORA_K / 2), col = (i % (LORA_K / 2)) * 2; float v[2];
#pragma unroll
          for (int e = 0; e < 2; ++e) { const int c = col + e; float x = 0.f;
              if (row < 1024) { if (c < 96) x = w2[c * 1024 + row]; }
              else if (row < 2048) { if (c >= 96 && c < 192) x = a2[(c - 96) * 1024 + (row - 1024)]; }
              else { if (c >= 192 && c < 448) x = g2[(c - 192) * 1024 + (row - 2048)]; }
              v[e] = x; }
          *(GAS unsigned*)(LB + (size_t)row * LORA_K + col) = pk2(v[0], v[1]); } }
}
__device__ __forceinline__ void p1_deferred(const Args& A, Frame& F, int wg, int nwg) {
    const int gw = wg * NWAVES + F.wave, NGW = nwg * NWAVES;
    int gtid = gw * 64 + F.lane; const int gthreads = nwg * NTHREADS;
    asm volatile("" : "+v"(gtid));
    unsigned char* ws = A.ws;
    { LAS float* scr = (LAS float*)(F.lds + RING_OFF + F.wave * 16384); constexpr int I_SQ = (D / 64) * (D / 32);
      for (int it = gw; it < 2 * I_SQ; it += NGW) {
          if (it < I_SQ) p0_transpose_item_f8(A.in[I_OD_WOUT], D, D, (unsigned char*)(ws + WS_WOD_OUT), scr, it, F.lane);
          else p0_transpose_item_f8(A.in[I_PLE_WG] + (size_t)D * D, D, D, (unsigned char*)((bf16*)(ws + WS_WGATE) + (size_t)D * D), scr, it - I_SQ, F.lane, A.in[I_NPLE] + D); } }
    __syncthreads();
    for (int it = wg; it < 512; it += nwg)
        p0_fold_item(A.in[I_PEER_WQ] + (size_t)D * D, A.in[I_PEER_SK] + (size_t)16 * 128 * 128, (bf16*)(ws + WS_WPEER) + (size_t)D * D, (LAS float*)(F.lds + RING_OFF), it, F.tid, A.in[I_NFFN] + D);
    cvt_rows_i8(A.in[I_PEER_U] + (size_t)16384 * D, (unsigned char*)(ws + WS_TABU) + (size_t)16384 * D, (float*)(ws + WS_SU) + 16384, 16384, gw, NGW, F.lane, A.in[I_NFFN] + D);
    cvt_rows_i8(A.in[I_PEER_V] + (size_t)16384 * D, (unsigned char*)(ws + WS_TABV) + (size_t)16384 * D, (float*)(ws + WS_SU) + 32768 + 16384, 16384, gw, NGW, F.lane, nullptr);
}

constexpr int TC = 16, NCHUNK = SEQ / TC;

template <int MODE>
__device__ __forceinline__ void scan_gla_unit(const Args& A, Frame& F, int unit) {
    int tid = F.tid; asm volatile("" : "+v"(tid));
    const int lane = tid & 63, w = F.wave;
    int b, h, qcol, kcol, vcol, ocol;
    if (MODE == 0) { b = unit >> 4; h = (unit >> 2) & 3; const int s = unit & 3; qcol = EC_GQ + h * 128; kcol = EC_GK + h * 128; vcol = EC_GV + h * 256 + s * 64; ocol = h * 256 + s * 64; }
    else           { b = unit >> 4; h = (unit >> 1) & 7; const int s = unit & 1; qcol = OC_HQ + h * 128; kcol = OC_HF + h * 128; vcol = OC_HI + h * 128 + s * 64; ocol = h * 128 + s * 64; }
    const bf16* P = (const bf16*)(A.ws + WS_PROJ) + (size_t)b * SEQ * PROJ_LD;
    float* O = (float*)(A.ws + WS_O) + (size_t)b * SEQ * D + ocol;
    LAS float* Lf = (LAS float*)(F.lds + RING_OFF);
    constexpr int BUFSZ = 7168, O_EG = 0, O_K = 2048, O_Q = 4096, O_V = 6144, O_OUT = 2 * BUFSZ, O_W2 = O_OUT + 1024, O_BIAS = O_W2 + 2048;
    const int tl = tid >> 5, dq = (tid & 31) * 4, tlv = tid >> 4, c4 = (tid & 15) * 4;
    float lb[4] = {0.f, 0.f, 0.f, 0.f};
    if (MODE == 0) {
        const float* w2 = A.in[I_GK_W2]; const float* gb = A.in[I_GK_B];
        for (int i = tid; i < 2048; i += NTHREADS) Lf[O_W2 + i] = w2[(i >> 7) * 512 + h * 128 + (i & 127)];
        if (tid < 128) Lf[O_BIAS + tid] = gb[h * 128 + tid];
    } else {
        const float* lg = A.in[I_LB];
#pragma unroll
        for (int i = 0; i < 4; ++i) lb[i] = sigmoidf_(lg[1024 + h * 128 + dq + i] - lg[h * 128 + dq + i]);
    }
    u32x2 rq, rk, rv = {0u, 0u}; v4u rg0 = {0u, 0u, 0u, 0u}, rg1 = {0u, 0u, 0u, 0u};
#define GLA_LOAD(c) do { const bf16* pr = P + (size_t)((c) * TC + tl) * PROJ_LD; rq = *(const GAS u32x2*)(pr + qcol + dq); rk = *(const GAS u32x2*)(pr + kcol + dq); \
        if (MODE == 0) { rg0 = *(const GAS v4u*)(pr + EC_GLR); rg1 = *(const GAS v4u*)(pr + EC_GLR + 8); } \
        if (tid < 256) rv = *(const GAS u32x2*)(P + (size_t)((c) * TC + tlv) * PROJ_LD + vcol + c4); } while (0)
#define GLA_XFORM(bufi) do { LAS float* B_ = Lf + (bufi) * BUFSZ; f32x4 q4, k4, e4; \
        const float xq[4] = {bf_lo(rq.x), bf_hi(rq.x), bf_lo(rq.y), bf_hi(rq.y)}, xk[4] = {bf_lo(rk.x), bf_hi(rk.x), bf_lo(rk.y), bf_hi(rk.y)}; \
        if (MODE == 0) { f32x4 z = *(const LAS f32x4*)(Lf + O_BIAS + dq); \
            const float gl[16] = {bf_lo(rg0.x), bf_hi(rg0.x), bf_lo(rg0.y), bf_hi(rg0.y), bf_lo(rg0.z), bf_hi(rg0.z), bf_lo(rg0.w), bf_hi(rg0.w), \
                                  bf_lo(rg1.x), bf_hi(rg1.x), bf_lo(rg1.y), bf_hi(rg1.y), bf_lo(rg1.z), bf_hi(rg1.z), bf_lo(rg1.w), bf_hi(rg1.w)}; \
            _Pragma("unroll") for (int r_ = 0; r_ < 16; ++r_) { const f32x4 wv = *(const LAS f32x4*)(Lf + O_W2 + r_ * 128 + dq); z = z + wv * gl[r_]; } \
            _Pragma("unroll") for (int i_ = 0; i_ < 4; ++i_) { q4[i_] = xq[i_] * 0.08838834764831845f; k4[i_] = xk[i_]; e4[i_] = __builtin_amdgcn_exp2f(-0.0625f * __builtin_amdgcn_logf(1.0f + __expf(-z[i_]))); } } \
        else { _Pragma("unroll") for (int i_ = 0; i_ < 4; ++i_) { const float fg = lb[i_] + (1.f - lb[i_]) * sigmoidf_(xk[i_]); q4[i_] = siluf_(xq[i_]); k4[i_] = 1.f - fg; e4[i_] = fg; } } \
        *(LAS f32x4*)(B_ + O_EG + tl * 128 + dq) = e4; *(LAS f32x4*)(B_ + O_K + tl * 128 + dq) = k4; *(LAS f32x4*)(B_ + O_Q + tl * 128 + dq) = q4; \
        if (tid < 256) { f32x4 v4 = {bf_lo(rv.x), bf_hi(rv.x), bf_lo(rv.y), bf_hi(rv.y)}; *(LAS f32x4*)(B_ + O_V + tlv * 64 + c4) = v4; } } while (0)
    LBAR();
    GLA_LOAD(0); GLA_XFORM(0);
    LBAR();
    f32x2 S2[8];
#pragma unroll
    for (int i = 0; i < 8; ++i) S2[i] = (f32x2){0.f, 0.f};
    const int j = lane & 15, col = w * 8 + (lane >> 4) * 2;
    for (int c = 0; c < NCHUNK; ++c) {
        if (c + 1 < NCHUNK) GLA_LOAD(c + 1);
        const LAS float* B_ = Lf + (c & 1) * BUFSZ;
        float os0 = 0.f, os1 = 0.f;
        f32x4 e0, e1, k0, k1, q0, q1, ne0, ne1, nk0, nk1, nq0, nq1; f32x2 v2, nv2;
#define GLA_LDSTEP(t_, E0, E1, K0, K1, Q0, Q1, V2) do { E0 = *(const LAS f32x4*)(B_ + O_EG + (t_) * 128 + 4 * j); E1 = *(const LAS f32x4*)(B_ + O_EG + (t_) * 128 + 64 + 4 * j); \
            K0 = *(const LAS f32x4*)(B_ + O_K + (t_) * 128 + 4 * j); K1 = *(const LAS f32x4*)(B_ + O_K + (t_) * 128 + 64 + 4 * j); \
            Q0 = *(const LAS f32x4*)(B_ + O_Q + (t_) * 128 + 4 * j); Q1 = *(const LAS f32x4*)(B_ + O_Q + (t_) * 128 + 64 + 4 * j); V2 = *(const LAS f32x2*)(B_ + O_V + (t_) * 64 + col); } while (0)
        GLA_LDSTEP(0, e0, e1, k0, k1, q0, q1, v2);
#pragma unroll
        for (int t = 0; t < TC; ++t) {
            if (t + 1 < TC) { GLA_LDSTEP(t + 1, ne0, ne1, nk0, nk1, nq0, nq1, nv2); }
            __builtin_amdgcn_sched_barrier(0);
            f32x2 pa = {0.f, 0.f}, pb = {0.f, 0.f};
#pragma unroll
            for (int i = 0; i < 4; ++i) {
                S2[i] = S2[i] * e0[i] + v2 * k0[i]; S2[4 + i] = S2[4 + i] * e1[i] + v2 * k1[i];
                pa += S2[i] * q0[i]; pb += S2[4 + i] * q1[i]; }
            pa += pb;
            float p0 = pa[0], p1 = pa[1];
            row_sum16_x2(p0, p1);
            os0 = (j == t) ? p0 : os0; os1 = (j == t) ? p1 : os1;
            e0 = ne0; e1 = ne1; k0 = nk0; k1 = nk1; q0 = nq0; q1 = nq1; v2 = nv2;
        }
#undef GLA_LDSTEP
        { f32x2 o2 = {os0, os1}; *(LAS f32x2*)(Lf + O_OUT + j * 64 + col) = o2; }
        if (c + 1 < NCHUNK) GLA_XFORM((c + 1) & 1);
        LBAR();
        if (tid < 256) *(GAS f32x4*)(O + (size_t)(c * TC + tlv) * D + c4) = *(const LAS f32x4*)(Lf + O_OUT + tlv * 64 + c4);
        LBAR();
    }
#undef GLA_LOAD
#undef GLA_XFORM
}

__device__ __forceinline__ void scan_gdn_unit(const Args& A, Frame& F, int unit) {
    int tid = F.tid; asm volatile("" : "+v"(tid));
    const int lane = tid & 63, w = F.wave;
    const int b = unit >> 4, h = (unit >> 1) & 7, s = unit & 1;
    const int qcol = EC_BQ + h * 128, kcol = EC_BK + h * 128, vcol = EC_BV + h * 128 + s * 64, ocol = 1024 + h * 128 + s * 64;
    const bf16* P = (const bf16*)(A.ws + WS_PROJ) + (size_t)b * SEQ * PROJ_LD;
    float* O = (float*)(A.ws + WS_O) + (size_t)b * SEQ * D + ocol;
    LAS float* Lf = (LAS float*)(F.lds + RING_OFF);
    constexpr int BUFSZ = 5184, O_K = 0, O_Q = 2048, O_V = 4096, O_SC = 5120, O_OUT = 2 * BUFSZ, O_CW = O_OUT + 1024;
    const int tl = tid >> 5, dq = (tid & 31) * 4, tlv = tid >> 4, c4 = (tid & 15) * 4;
    { const float* cw = A.in[I_GDN_CONV];
      for (int i = tid; i < 4 * 320; i += NTHREADS) { const int jt = i / 320, x = i % 320;
          const int ch = x < 128 ? (h * 128 + x) : x < 256 ? (1024 + h * 128 + (x - 128)) : (2048 + h * 128 + s * 64 + (x - 256));
          Lf[O_CW + i] = cw[jt * 3072 + ch]; } }
    const float neg_ea = -__expf(A.in[I_GDN_ALOG][h]), dtb = A.in[I_GDN_DTB][h];
    u32x2 rq[4], rk[4], rv[4]; unsigned short rba = 0, rbb = 0;
#pragma unroll
    for (int i = 0; i < 4; ++i) rv[i] = (u32x2){0u, 0u};
#define GDN_LOAD(c) do { const int t_ = (c) * TC + tl; \
        _Pragma("unroll") for (int jt = 0; jt < 4; ++jt) { const int tt = t_ - 3 + jt; \
            if (tt >= 0) { const bf16* pr = P + (size_t)tt * PROJ_LD; rq[jt] = *(const GAS u32x2*)(pr + qcol + dq); rk[jt] = *(const GAS u32x2*)(pr + kcol + dq); } \
            else { rq[jt] = (u32x2){0u, 0u}; rk[jt] = (u32x2){0u, 0u}; } } \
        { const bf16* pr = P + (size_t)t_ * PROJ_LD; rba = pr[EC_BA + h]; rbb = pr[EC_BB + h]; } \
        if (tid < 256) { const int tv = (c) * TC + tlv; \
            _Pragma("unroll") for (int jt = 0; jt < 4; ++jt) { const int tt = tv - 3 + jt; \
                if (tt >= 0) rv[jt] = *(const GAS u32x2*)(P + (size_t)tt * PROJ_LD + vcol + c4); else rv[jt] = (u32x2){0u, 0u}; } } } while (0)
#define GDN_XFORM(bufi) do { LAS float* B_ = Lf + (bufi) * BUFSZ; f32x4 q4 = {0.f, 0.f, 0.f, 0.f}, k4 = {0.f, 0.f, 0.f, 0.f}; \
        _Pragma("unroll") for (int jt = 0; jt < 4; ++jt) { const f32x4 wq = *(const LAS f32x4*)(Lf + O_CW + jt * 320 + dq), wk = *(const LAS f32x4*)(Lf + O_CW + jt * 320 + 128 + dq); \
            q4[0] += wq[0] * bf_lo(rq[jt].x); q4[1] += wq[1] * bf_hi(rq[jt].x); q4[2] += wq[2] * bf_lo(rq[jt].y); q4[3] += wq[3] * bf_hi(rq[jt].y); \
            k4[0] += wk[0] * bf_lo(rk[jt].x); k4[1] += wk[1] * bf_hi(rk[jt].x); k4[2] += wk[2] * bf_lo(rk[jt].y); k4[3] += wk[3] * bf_hi(rk[jt].y); } \
        float sq = 0.f, sk = 0.f, sqk = 0.f; \
        _Pragma("unroll") for (int i_ = 0; i_ < 4; ++i_) { q4[i_] = siluf_(q4[i_]); k4[i_] = siluf_(k4[i_]); sq += q4[i_] * q4[i_]; sk += k4[i_] * k4[i_]; sqk += q4[i_] * k4[i_]; } \
        sq = half_sum32(sq); sk = half_sum32(sk); sqk = half_sum32(sqk); \
        const float rq_ = __builtin_amdgcn_rsqf(sq + EPS) * 0.08838834764831845f, rk_ = __builtin_amdgcn_rsqf(sk + EPS); \
        q4 = q4 * rq_; k4 = k4 * rk_; \
        *(LAS f32x4*)(B_ + O_K + tl * 128 + dq) = k4; *(LAS f32x4*)(B_ + O_Q + tl * 128 + dq) = q4; \
        if ((tid & 31) == 0) { const float ba = __uint_as_float((unsigned)rba << 16), bb = __uint_as_float((unsigned)rbb << 16); \
            f32x4 sc; sc[0] = __expf(neg_ea * softplusf_(ba + dtb)); sc[1] = sigmoidf_(bb); sc[2] = sqk * rq_ * rk_; sc[3] = 0.f; *(LAS f32x4*)(B_ + O_SC + tl * 4) = sc; } \
        if (tid < 256) { f32x4 v4 = {0.f, 0.f, 0.f, 0.f}; \
            _Pragma("unroll") for (int jt = 0; jt < 4; ++jt) { const f32x4 wv = *(const LAS f32x4*)(Lf + O_CW + jt * 320 + 256 + c4); \
                v4[0] += wv[0] * bf_lo(rv[jt].x); v4[1] += wv[1] * bf_hi(rv[jt].x); v4[2] += wv[2] * bf_lo(rv[jt].y); v4[3] += wv[3] * bf_hi(rv[jt].y); } \
            _Pragma("unroll") for (int i_ = 0; i_ < 4; ++i_) v4[i_] = siluf_(v4[i_]); \
            *(LAS f32x4*)(B_ + O_V + tlv * 64 + c4) = v4; } } while (0)
    LBAR();
    GDN_LOAD(0); GDN_XFORM(0);
    LBAR();
    f32x2 S2[8];
#pragma unroll
    for (int i = 0; i < 8; ++i) S2[i] = (f32x2){0.f, 0.f};
    const int j = lane & 15, col = w * 8 + (lane >> 4) * 2;
    for (int c = 0; c < NCHUNK; ++c) {
        if (c + 1 < NCHUNK) GDN_LOAD(c + 1);
        const LAS float* B_ = Lf + (c & 1) * BUFSZ;
        float os0 = 0.f, os1 = 0.f;
        f32x4 k0, k1, q0, q1, sc, nk0, nk1, nq0, nq1, nsc; f32x2 v2, nv2;
#define GDN_LDSTEP(t_, K0, K1, Q0, Q1, V2, SC) do { K0 = *(const LAS f32x4*)(B_ + O_K + (t_) * 128 + 4 * j); K1 = *(const LAS f32x4*)(B_ + O_K + (t_) * 128 + 64 + 4 * j); \
            Q0 = *(const LAS f32x4*)(B_ + O_Q + (t_) * 128 + 4 * j); Q1 = *(const LAS f32x4*)(B_ + O_Q + (t_) * 128 + 64 + 4 * j); V2 = *(const LAS f32x2*)(B_ + O_V + (t_) * 64 + col); SC = *(const LAS f32x4*)(B_ + O_SC + (t_) * 4); } while (0)
        GDN_LDSTEP(0, k0, k1, q0, q1, v2, sc);
#pragma unroll
        for (int t = 0; t < TC; ++t) {
            if (t + 1 < TC) { GDN_LDSTEP(t + 1, nk0, nk1, nq0, nq1, nv2, nsc); }
            __builtin_amdgcn_sched_barrier(0);
            f32x2 d1 = {0.f, 0.f}, d2 = {0.f, 0.f}, e1 = {0.f, 0.f}, e2 = {0.f, 0.f};
#pragma unroll
            for (int i = 0; i < 4; ++i) { d1 += S2[i] * k0[i]; e1 += S2[4 + i] * k1[i]; d2 += S2[i] * q0[i]; e2 += S2[4 + i] * q1[i]; }
            d1 += e1; d2 += e2;
            { float r0_ = d1[0], r1_ = d1[1], r2_ = d2[0], r3_ = d2[1]; row_sum16_x4(r0_, r1_, r2_, r3_); d1[0] = r0_; d1[1] = r1_; d2[0] = r2_; d2[1] = r3_; }
            const float a = sc[0], beta = sc[1], qk = sc[2];
            const f32x2 dl = (v2 - d1 * a) * beta;
            const f32x2 o2 = d2 * a + dl * qk;
#pragma unroll
            for (int i = 0; i < 4; ++i) { S2[i] = S2[i] * a + dl * k0[i]; S2[4 + i] = S2[4 + i] * a + dl * k1[i]; }
            os0 = (j == t) ? o2[0] : os0; os1 = (j == t) ? o2[1] : os1;
            k0 = nk0; k1 = nk1; q0 = nq0; q1 = nq1; v2 = nv2; sc = nsc;
        }
#undef GDN_LDSTEP
        { f32x2 o2 = {os0, os1}; *(LAS f32x2*)(Lf + O_OUT + j * 64 + col) = o2; }
        if (c + 1 < NCHUNK) GDN_XFORM((c + 1) & 1);
        LBAR();
        if (tid < 256) *(GAS f32x4*)(O + (size_t)(c * TC + tlv) * D + c4) = *(const LAS f32x4*)(Lf + O_OUT + tlv * 64 + c4);
        LBAR();
    }
#undef GDN_LOAD
#undef GDN_XFORM
}

typedef short bf16x4_t __attribute__((ext_vector_type(4)));
__device__ __forceinline__ bf16x8 mk_frag(u32x2 lo, u32x2 hi) { v4u t; t.x = lo.x; t.y = lo.y; t.z = hi.x; t.w = hi.y; return __builtin_bit_cast(bf16x8, t); }
template <int MODE>
__device__ __forceinline__ void scan_gla_mfma_unit(const Args& A, Frame& F, int unit) {
    int tid = F.tid; asm volatile("" : "+v"(tid));
    const int lane = tid & 63, w = F.wave;
    int b, h, qcol, kcol, vcol, ocol;
    if (MODE == 0) { b = unit >> 3; h = (unit >> 1) & 3; const int s = unit & 1; qcol = EC_GQ + h * 128; kcol = EC_GK + h * 128; vcol = EC_GV + h * 256 + s * 128; ocol = h * 256 + s * 128; }
    else           { b = unit >> 3; h = unit & 7; qcol = OC_HQ + h * 128; kcol = OC_HF + h * 128; vcol = OC_HI + h * 128; ocol = h * 128; }
    const bf16* P = (const bf16*)(A.ws + WS_PROJ) + (size_t)b * SEQ * PROJ_LD;
    bf16* O = (bf16*)(A.ws + WS_O) + (size_t)b * SEQ * D + ocol;
    LAS float* Lf = (LAS float*)(F.lds + RING_OFF);
    constexpr int BUFSZ = MODE == 1 ? 10240 : 8192, O_E = 0, O_K = 2048, O_Q = 4096, O_V = 6144, O_Z = 8192, RS = 136,
        O_QB = 2 * BUFSZ, O_KB = O_QB + 1088, O_KT = O_KB + 1088, O_BL = O_KT + 1024, O_AM = O_BL + 128, O_W2 = O_AM + 128, O_BIAS = O_W2 + 2048;
    LAS bf16* QB = (LAS bf16*)(Lf + O_QB); LAS bf16* KB = (LAS bf16*)(Lf + O_KB); LAS bf16* KT = (LAS bf16*)(Lf + O_KT); LAS bf16* AM = (LAS bf16*)(Lf + O_AM);
    const int tl = tid >> 5, dq = (tid & 31) * 4;
    float lb[4] = {0.f, 0.f, 0.f, 0.f};
    if (MODE == 0) {
        const float* w2 = A.in[I_GK_W2]; const float* gb = A.in[I_GK_B];
        for (int i = tid; i < 2048; i += NTHREADS) Lf[O_W2 + i] = w2[(i >> 7) * 512 + h * 128 + (i & 127)];
        if (tid < 128) Lf[O_BIAS + tid] = gb[h * 128 + tid];
    } else {
        const float* lg = A.in[I_LB];
#pragma unroll
        for (int i = 0; i < 4; ++i) lb[i] = sigmoidf_(lg[1024 + h * 128 + dq + i] - lg[h * 128 + dq + i]);
    }
    u32x2 rq, rk, rv, rz = {0u, 0u}; v4u rg0 = {0u, 0u, 0u, 0u}, rg1 = {0u, 0u, 0u, 0u};
#define GM_LOAD(c) do { const bf16* pr = P + (size_t)((c) * TC + tl) * PROJ_LD; rq = *(const GAS u32x2*)(pr + qcol + dq); rk = *(const GAS u32x2*)(pr + kcol + dq); rv = *(const GAS u32x2*)(pr + vcol + dq); \
        if (MODE == 0) { rg0 = *(const GAS v4u*)(pr + EC_GLR); rg1 = *(const GAS v4u*)(pr + EC_GLR + 8); } else rz = *(const GAS u32x2*)(pr + OC_HG + h * 128 + dq); } while (0)
#define GM_XFORM(bufi) do { LAS float* B_ = Lf + (bufi) * BUFSZ; f32x4 q4, k4, e4; \
        const float xq[4] = {bf_lo(rq.x), bf_hi(rq.x), bf_lo(rq.y), bf_hi(rq.y)}, xk[4] = {bf_lo(rk.x), bf_hi(rk.x), bf_lo(rk.y), bf_hi(rk.y)}; \
        if (MODE == 0) { f32x4 z = *(const LAS f32x4*)(Lf + O_BIAS + dq); \
            const float gl[16] = {bf_lo(rg0.x), bf_hi(rg0.x), bf_lo(rg0.y), bf_hi(rg0.y), bf_lo(rg0.z), bf_hi(rg0.z), bf_lo(rg0.w), bf_hi(rg0.w), \
                                  bf_lo(rg1.x), bf_hi(rg1.x), bf_lo(rg1.y), bf_hi(rg1.y), bf_lo(rg1.z), bf_hi(rg1.z), bf_lo(rg1.w), bf_hi(rg1.w)}; \
            _Pragma("unroll") for (int r_ = 0; r_ < 16; ++r_) { const f32x4 wv = *(const LAS f32x4*)(Lf + O_W2 + r_ * 128 + dq); z = z + wv * gl[r_]; } \
            _Pragma("unroll") for (int i_ = 0; i_ < 4; ++i_) { q4[i_] = xq[i_] * 0.08838834764831845f; k4[i_] = xk[i_]; e4[i_] = __builtin_amdgcn_exp2f(-0.0625f * __builtin_amdgcn_logf(1.0f + __expf(-z[i_]))); } } \
        else { _Pragma("unroll") for (int i_ = 0; i_ < 4; ++i_) { const float fg = lb[i_] + (1.f - lb[i_]) * sigmoidf_(xk[i_]); q4[i_] = siluf_(xq[i_]); k4[i_] = 1.f - fg; e4[i_] = fg; } } \
        *(LAS f32x4*)(B_ + O_E + tl * 128 + dq) = e4; *(LAS f32x4*)(B_ + O_K + tl * 128 + dq) = k4; *(LAS f32x4*)(B_ + O_Q + tl * 128 + dq) = q4; \
        { f32x4 v4 = {bf_lo(rv.x), bf_hi(rv.x), bf_lo(rv.y), bf_hi(rv.y)}; *(LAS f32x4*)(B_ + O_V + tl * 128 + dq) = v4; } \
        if (MODE == 1) { f32x4 z4 = {siluf_(bf_lo(rz.x)), siluf_(bf_hi(rz.x)), siluf_(bf_lo(rz.y)), siluf_(bf_hi(rz.y))}; *(LAS f32x4*)(B_ + O_Z + tl * 128 + dq) = z4; } } while (0)
    LBAR();
    GM_LOAD(0); GM_XFORM(0); GM_LOAD(1);
    LBAR();
    f32x4 Sacc[8];
#pragma unroll
    for (int i = 0; i < 8; ++i) Sacc[i] = (f32x4){0.f, 0.f, 0.f, 0.f};
    const int fr = lane & 15, g = lane >> 4, c0 = w * 16;
    LAS float* PART = Lf + O_BIAS + 128;
    unsigned char* Y8 = (unsigned char*)(A.ws + WS_ACTA) + (size_t)b * SEQ * D + ocol;
    float gn = 0.f; f32x4 oprev = {0.f, 0.f, 0.f, 0.f}; float zprev[4] = {0.f, 0.f, 0.f, 0.f};
    if (MODE == 1) gn = A.in[I_HG_NORM][c0 + fr];
#define HG_FINISH(cc) do { const LAS float* pp_ = PART + ((cc) & 1) * 128; \
        _Pragma("unroll") for (int r = 0; r < 4; ++r) { const int t_ = 4 * g + r; const f32x4 p0_ = *(const LAS f32x4*)(pp_ + t_ * 8), p1_ = *(const LAS f32x4*)(pp_ + t_ * 8 + 4); \
            const float s_ = ((p0_[0] + p0_[1]) + (p0_[2] + p0_[3])) + ((p1_[0] + p1_[1]) + (p1_[2] + p1_[3])); const float rt_ = __builtin_amdgcn_rsqf(s_ * (1.0f / 128.0f) + EPS); \
            const float y_ = oprev[r] * rt_ * gn * zprev[r]; \
            Y8[(size_t)((cc) * TC + t_) * D + c0 + fr] = (unsigned char)(__builtin_amdgcn_cvt_pk_fp8_f32(y_, y_, 0, false) & 0xff); } } while (0)
    for (int c = 0; c < NCHUNK; ++c) {
        const LAS float* B_ = Lf + (c & 1) * BUFSZ;
        {
            const int seg = tid >> 7, d = tid & 127;
            float bt = 1.f, ball = 1.f;
#pragma unroll
            for (int t = 0; t < 16; ++t) { const float e = B_[O_E + t * 128 + d]; ball *= e; if (t < 4 * seg) bt = ball; }
            ball = fmaxf(ball, 1e-30f);
            unsigned short kt4[4];
#pragma unroll
            for (int i = 0; i < 4; ++i) { const int t = 4 * seg + i; bt = fmaxf(bt * B_[O_E + t * 128 + d], 1e-30f);
                const float kk = B_[O_K + t * 128 + d], qq = B_[O_Q + t * 128 + d], ib = __builtin_amdgcn_rcpf(bt);
                QB[t * RS + d] = hw_bf(qq * bt); KB[t * RS + d] = hw_bf(kk * ib); kt4[i] = (unsigned short)hw_bf(kk * ball * ib); }
            u32x2 kw; kw.x = (unsigned)kt4[0] | ((unsigned)kt4[1] << 16); kw.y = (unsigned)kt4[2] | ((unsigned)kt4[3] << 16);
            *(LAS u32x2*)(KT + d * 16 + 4 * seg) = kw;
            if (seg == 3) Lf[O_BL + d] = ball;
        }
        LBAR();
        if (MODE == 1 && c > 0) HG_FINISH(c - 1);
        if (w == 0) {
            f32x4 acc = {0.f, 0.f, 0.f, 0.f};
#pragma unroll
            for (int ks = 0; ks < 4; ++ks) { const bf16x8 af = *(const LAS bf16x8*)(QB + fr * RS + 32 * ks + 8 * g), bfm = *(const LAS bf16x8*)(KB + fr * RS + 32 * ks + 8 * g);
                acc = __builtin_amdgcn_mfma_f32_16x16x32_bf16(af, bfm, acc, 0, 0, 0); }
#pragma unroll
            for (int r = 0; r < 4; ++r) { const int t = 4 * g + r, s = fr; AM[t * 16 + s] = hw_bf(s <= t ? acc[r] : 0.f); }
        }
        if (c + 1 < NCHUNK) GM_XFORM((c + 1) & 1);
        if (c + 2 < NCHUNK) GM_LOAD(c + 2);
        LBAR();
        {
            u32x2 vlo; { const float v0 = B_[O_V + (4 * g + 0) * 128 + c0 + fr], v1 = B_[O_V + (4 * g + 1) * 128 + c0 + fr], v2 = B_[O_V + (4 * g + 2) * 128 + c0 + fr], v3 = B_[O_V + (4 * g + 3) * 128 + c0 + fr];
                vlo.x = hw_pk2(v0, v1); vlo.y = hw_pk2(v2, v3); }
            const u32x2 zz = {0u, 0u};
            const bf16x8 vb = mk_frag(vlo, zz);
            f32x4 acco = {0.f, 0.f, 0.f, 0.f};
#pragma unroll
            for (int ks = 0; ks < 4; ++ks) {
                u32x2 slo, shi; slo.x = hw_pk2(Sacc[2 * ks][0], Sacc[2 * ks][1]); slo.y = hw_pk2(Sacc[2 * ks][2], Sacc[2 * ks][3]); shi.x = hw_pk2(Sacc[2 * ks + 1][0], Sacc[2 * ks + 1][1]); shi.y = hw_pk2(Sacc[2 * ks + 1][2], Sacc[2 * ks + 1][3]);
                const bf16x8 sb = mk_frag(slo, shi);
                const u32x2 qlo = *(const LAS u32x2*)(QB + fr * RS + 32 * ks + 4 * g), qhi = *(const LAS u32x2*)(QB + fr * RS + 32 * ks + 16 + 4 * g);
                acco = __builtin_amdgcn_mfma_f32_16x16x32_bf16(mk_frag(qlo, qhi), sb, acco, 0, 0, 0); }
            { const u32x2 alo = *(const LAS u32x2*)(AM + fr * 16 + 4 * g); acco = __builtin_amdgcn_mfma_f32_16x16x32_bf16(mk_frag(alo, zz), vb, acco, 0, 0, 0); }
#pragma unroll
            for (int r = 0; r < 4; ++r) { if (MODE == 0) O[(size_t)(c * TC + 4 * g + r) * D + c0 + fr] = hw_bf(acco[r]); }
            if (MODE == 1) { float q0 = acco[0] * acco[0], q1 = acco[1] * acco[1], q2 = acco[2] * acco[2], q3 = acco[3] * acco[3]; row_sum16_x4(q0, q1, q2, q3);
                if (fr == 0) { LAS float* pw_ = PART + (c & 1) * 128 + (4 * g) * 8 + w; pw_[0] = q0; pw_[8] = q1; pw_[16] = q2; pw_[24] = q3; }
                oprev = acco;
#pragma unroll
                for (int r = 0; r < 4; ++r) zprev[r] = B_[O_Z + (4 * g + r) * 128 + c0 + fr]; }
#pragma unroll
            for (int i = 0; i < 8; ++i) { const f32x4 bl = *(const LAS f32x4*)(Lf + O_BL + 16 * i + 4 * g); const u32x2 klo = *(const LAS u32x2*)(KT + (16 * i + fr) * 16 + 4 * g);
                Sacc[i] = __builtin_amdgcn_mfma_f32_16x16x32_bf16(mk_frag(klo, zz), vb, Sacc[i] * bl, 0, 0, 0); }
        }
        LBAR();
    }
    if (MODE == 1) HG_FINISH(NCHUNK - 1);
#undef HG_FINISH
#undef GM_LOAD
#undef GM_XFORM
}

__device__ __forceinline__ void scan_gdn_mfma_unit(const Args& A, Frame& F, int unit, const int role) {
    int tid = F.tid; asm volatile("" : "+v"(tid));
    const int lane = tid & 63, w = F.wave;
    const int b = unit >> 3, h = unit & 7;
    const int qcol = EC_BQ + h * 128, kcol = EC_BK + h * 128, vcol = EC_BV + h * 128, ocol = 1024 + h * 128;
    const bf16* P = (const bf16*)(A.ws + WS_PROJ) + (size_t)b * SEQ * PROJ_LD;
    bf16* O = (bf16*)(A.ws + WS_O) + (size_t)b * SEQ * D + ocol;
    LAS float* Lf = (LAS float*)(F.lds + RING_OFF);
    constexpr int O_CW = 0, O_AMAT = 1536, O_QKM = O_AMAT + 256, O_TB = O_QKM + 128, O_GL = O_TB + 128, O_BUF0 = O_GL + 64;
    constexpr int BUFSZ = 6208, O_KH = 0, O_QH = 2048, O_VV = 4096, O_SC = 6144;
    constexpr int RS = 136;
    constexpr int O_KHB = O_BUF0 + 2 * BUFSZ, O_QHB = O_KHB + 1088, O_QB = O_QHB + 1088, O_KT = O_QB + 1088, O_WSRC = O_KT + 1024, O_WB = O_WSRC + 2048;
    LAS bf16* KHB = (LAS bf16*)(Lf + O_KHB); LAS bf16* QHB = (LAS bf16*)(Lf + O_QHB); LAS bf16* QB = (LAS bf16*)(Lf + O_QB); LAS bf16* KT = (LAS bf16*)(Lf + O_KT);
    LAS bf16* WB = (LAS bf16*)(Lf + O_WB); LAS bf16* QKM = (LAS bf16*)(Lf + O_QKM); LAS bf16* TB = (LAS bf16*)(Lf + O_TB);
    const int tl = tid >> 5, dq = (tid & 31) * 4;
    { const float* cw = A.in[I_GDN_CONV];
      for (int i = tid; i < 4 * 384; i += NTHREADS) { const int jt = i / 384, x = i % 384; Lf[O_CW + i] = cw[jt * 3072 + (x >> 7) * 1024 + h * 128 + (x & 127)]; } }
    const float neg_ea = -__expf(A.in[I_GDN_ALOG][h]), dtb = A.in[I_GDN_DTB][h];
    u32x2 rq[4], rk[4], rv[4]; unsigned short rba = 0, rbb = 0;
#define GD_LOAD(c) do { const int t_ = (c) * TC + tl; \
        _Pragma("unroll") for (int jt = 0; jt < 4; ++jt) { const int tt = t_ - 3 + jt; const bf16* pr = P + (size_t)(tt < 0 ? 0 : tt) * PROJ_LD + dq; \
            rq[jt] = *(const GAS u32x2*)(pr + qcol); rk[jt] = *(const GAS u32x2*)(pr + kcol); rv[jt] = *(const GAS u32x2*)(pr + vcol); \
            if (tt < 0) { rq[jt] = (u32x2){0u, 0u}; rk[jt] = (u32x2){0u, 0u}; rv[jt] = (u32x2){0u, 0u}; } } \
        { const bf16* pr = P + (size_t)t_ * PROJ_LD; rba = pr[EC_BA + h]; rbb = pr[EC_BB + h]; } } while (0)
#define GD_XFORM(bufi) do { LAS float* B_ = Lf + O_BUF0 + (bufi) * BUFSZ; f32x4 q4 = {0.f, 0.f, 0.f, 0.f}, k4 = {0.f, 0.f, 0.f, 0.f}, v4 = {0.f, 0.f, 0.f, 0.f}; \
        _Pragma("unroll") for (int jt = 0; jt < 4; ++jt) { const f32x4 wq = *(const LAS f32x4*)(Lf + O_CW + jt * 384 + dq), wk = *(const LAS f32x4*)(Lf + O_CW + jt * 384 + 128 + dq), wv = *(const LAS f32x4*)(Lf + O_CW + jt * 384 + 256 + dq); \
            q4[0] += wq[0] * bf_lo(rq[jt].x); q4[1] += wq[1] * bf_hi(rq[jt].x); q4[2] += wq[2] * bf_lo(rq[jt].y); q4[3] += wq[3] * bf_hi(rq[jt].y); \
            k4[0] += wk[0] * bf_lo(rk[jt].x); k4[1] += wk[1] * bf_hi(rk[jt].x); k4[2] += wk[2] * bf_lo(rk[jt].y); k4[3] += wk[3] * bf_hi(rk[jt].y); \
            v4[0] += wv[0] * bf_lo(rv[jt].x); v4[1] += wv[1] * bf_hi(rv[jt].x); v4[2] += wv[2] * bf_lo(rv[jt].y); v4[3] += wv[3] * bf_hi(rv[jt].y); } \
        float sq = 0.f, sk = 0.f; \
        _Pragma("unroll") for (int i_ = 0; i_ < 4; ++i_) { q4[i_] = siluf_(q4[i_]); k4[i_] = siluf_(k4[i_]); v4[i_] = siluf_(v4[i_]); sq += q4[i_] * q4[i_]; sk += k4[i_] * k4[i_]; } \
        row_sum16_x2(sq, sk); sq += __shfl_xor(sq, 16); sk += __shfl_xor(sk, 16); \
        q4 = q4 * (__builtin_amdgcn_rsqf(sq + EPS) * 0.08838834764831845f); k4 = k4 * __builtin_amdgcn_rsqf(sk + EPS); \
        *(LAS f32x4*)(B_ + O_KH + tl * 128 + dq) = k4; *(LAS f32x4*)(B_ + O_QH + tl * 128 + dq) = q4; *(LAS f32x4*)(B_ + O_VV + tl * 128 + dq) = v4; \
        if ((tid & 31) == 0) { const float ba = __uint_as_float((unsigned)rba << 16), bb = __uint_as_float((unsigned)rbb << 16); \
            B_[O_SC + tl] = __expf(neg_ea * softplusf_(ba + dtb)); B_[O_SC + 16 + tl] = sigmoidf_(bb); } } while (0)
    LBAR();
    constexpr int SPLIT = 58;
    const int c_begin = role ? SPLIT : 0, c_end = role ? NCHUNK : SPLIT;
    constexpr int REC = 5408;
    float* STASH = (float*)(A.ws + WS_LA) + (size_t)unit * (NCHUNK - SPLIT) * REC;
    float* STATE = (float*)(A.ws + WS_STATE) + (size_t)unit * 16384;
    gu32* flag = F.ctl + 32768 + unit * 64;
    GD_LOAD(c_begin); GD_XFORM(c_begin & 1); GD_LOAD(c_begin + 1);
    LBAR();
    f32x4 Sacc[8];
#pragma unroll
    for (int i = 0; i < 8; ++i) Sacc[i] = (f32x4){0.f, 0.f, 0.f, 0.f};
    const int fr = lane & 15, g = lane >> 4, c0 = w * 16;
    const u32x2 zz = {0u, 0u};
#define GD_STATE_PART(cc_) do { \
        { \
            bf16x8 sb[4]; \
_Pragma("unroll") \
            for (int ks = 0; ks < 4; ++ks) { u32x2 slo, shi; slo.x = hw_pk2(Sacc[2 * ks][0], Sacc[2 * ks][1]); slo.y = hw_pk2(Sacc[2 * ks][2], Sacc[2 * ks][3]); shi.x = hw_pk2(Sacc[2 * ks + 1][0], Sacc[2 * ks + 1][1]); shi.y = hw_pk2(Sacc[2 * ks + 1][2], Sacc[2 * ks + 1][3]); \
                sb[ks] = mk_frag(slo, shi); } \
            f32x4 accv = accu, acco = {0.f, 0.f, 0.f, 0.f}; \
_Pragma("unroll") \
            for (int ks = 0; ks < 4; ++ks) { \
                const u32x2 wl = *(const LAS u32x2*)(WB + fr * RS + 32 * ks + 4 * g), wh = *(const LAS u32x2*)(WB + fr * RS + 32 * ks + 16 + 4 * g); \
                accv = __builtin_amdgcn_mfma_f32_16x16x32_bf16(mk_frag(wl, wh), sb[ks], accv, 0, 0, 0); \
                const u32x2 ql = *(const LAS u32x2*)(QB + fr * RS + 32 * ks + 4 * g), qh = *(const LAS u32x2*)(QB + fr * RS + 32 * ks + 16 + 4 * g); \
                acco = __builtin_amdgcn_mfma_f32_16x16x32_bf16(mk_frag(ql, qh), sb[ks], acco, 0, 0, 0); } \
            u32x2 vn; vn.x = hw_pk2(accv[0], accv[1]); vn.y = hw_pk2(accv[2], accv[3]); \
            const bf16x8 vnb = mk_frag(vn, zz); \
            acco = __builtin_amdgcn_mfma_f32_16x16x32_bf16(mk_frag(*(const LAS u32x2*)(QKM + fr * 16 + 4 * g), zz), vnb, acco, 0, 0, 0); \
_Pragma("unroll") \
            for (int r = 0; r < 4; ++r) O[(size_t)((cc_) * TC + 4 * g + r) * D + c0 + fr] = hw_bf(acco[r]); \
_Pragma("unroll") \
            for (int i = 0; i < 8; ++i) { const u32x2 klo = *(const LAS u32x2*)(KT + (16 * i + fr) * 16 + 4 * g); \
                Sacc[i] = __builtin_amdgcn_mfma_f32_16x16x32_bf16(mk_frag(klo, zz), vnb, Sacc[i] * glast, 0, 0, 0); } \
        } \
        } while (0)
    for (int c = c_begin; c < c_end; ++c) {
        const LAS float* B_ = Lf + O_BUF0 + (c & 1) * BUFSZ;
        float glast;
        {
            const int seg = tid >> 7, d = tid & 127;
            const f32x4 a0 = *(const LAS f32x4*)(B_ + O_SC), a1 = *(const LAS f32x4*)(B_ + O_SC + 4), a2 = *(const LAS f32x4*)(B_ + O_SC + 8), a3 = *(const LAS f32x4*)(B_ + O_SC + 12);
            const float av[16] = {a0[0], a0[1], a0[2], a0[3], a1[0], a1[1], a1[2], a1[3], a2[0], a2[1], a2[2], a2[3], a3[0], a3[1], a3[2], a3[3]};
            float p = 1.f, gpre = 1.f;
#pragma unroll
            for (int t = 0; t < 16; ++t) { if (t == 4 * seg) gpre = p; p *= av[t]; }
            glast = p;
            unsigned short kt4[4]; float gt = gpre;
#pragma unroll
            for (int i = 0; i < 4; ++i) { const int t = 4 * seg + i; const float at = (seg == 0) ? av[i] : (seg == 1) ? av[4 + i] : (seg == 2) ? av[8 + i] : av[12 + i]; gt *= at; const float beta = B_[O_SC + 16 + t];
                const float kk = B_[O_KH + t * 128 + d], qq = B_[O_QH + t * 128 + d];
                KHB[t * RS + d] = hw_bf(kk); QHB[t * RS + d] = hw_bf(qq); QB[t * RS + d] = hw_bf(qq * gt);
                kt4[i] = (unsigned short)hw_bf(kk * glast * __builtin_amdgcn_rcpf(gt));
                Lf[O_WSRC + t * 128 + d] = kk * (beta * gt);
                if (d == 0) Lf[O_GL + t] = gt; }
            u32x2 kw; kw.x = (unsigned)kt4[0] | ((unsigned)kt4[1] << 16); kw.y = (unsigned)kt4[2] | ((unsigned)kt4[3] << 16);
            *(LAS u32x2*)(KT + d * 16 + 4 * seg) = kw;
        }
        LBAR();
        if (w < 2) {
            const LAS bf16* AS = (w == 0) ? KHB : QHB;
            f32x4 acc = {0.f, 0.f, 0.f, 0.f};
#pragma unroll
            for (int ks = 0; ks < 4; ++ks) { const bf16x8 af = *(const LAS bf16x8*)(AS + fr * RS + 32 * ks + 8 * g), bfm = *(const LAS bf16x8*)(KHB + fr * RS + 32 * ks + 8 * g);
                acc = __builtin_amdgcn_mfma_f32_16x16x32_bf16(af, bfm, acc, 0, 0, 0); }
            const float gs_inv = __builtin_amdgcn_rcpf(Lf[O_GL + fr]);
            if (w == 0) {
                f32x4 N1, M1;
#pragma unroll
                for (int r = 0; r < 4; ++r) { const int t = 4 * g + r; const float gt = Lf[O_GL + t];
                    N1[r] = (fr < t) ? -(B_[O_SC + 16 + t] * acc[r] * gt * gs_inv) : 0.f;
                    M1[r] = (t < fr) ? -(B_[O_SC + 16 + fr] * acc[r] * Lf[O_GL + fr] * __builtin_amdgcn_rcpf(gt)) : 0.f; }
#define XTY(X, Y, C0) __builtin_amdgcn_mfma_f32_16x16x32_bf16(mk_frag((u32x2){hw_pk2(X[0], X[1]), hw_pk2(X[2], X[3])}, zz), mk_frag((u32x2){hw_pk2(Y[0], Y[1]), hw_pk2(Y[2], Y[3])}, zz), C0, 0, 0, 0)
                const f32x4 z4 = {0.f, 0.f, 0.f, 0.f};
                f32x4 T1t = M1;
#pragma unroll
                for (int r = 0; r < 4; ++r) if (4 * g + r == fr) T1t[r] += 1.f;
                const f32x4 N2 = XTY(M1, N1, z4), M2 = XTY(N1, M1, z4);
                const f32x4 T2t = XTY(N2, T1t, T1t);
                const f32x4 N4 = XTY(M2, N2, z4), M4 = XTY(N2, M2, z4);
                const f32x4 T4t = XTY(N4, T2t, T2t);
                const f32x4 N8 = XTY(M4, N4, z4);
                const f32x4 T8t = XTY(N8, T4t, T4t);
#undef XTY
                u32x2 tw; tw.x = hw_pk2(T8t[0], T8t[1]); tw.y = hw_pk2(T8t[2], T8t[3]);
                *(LAS u32x2*)(TB + fr * 16 + 4 * g) = tw;
            } else {
#pragma unroll
                for (int r = 0; r < 4; ++r) { const int t = 4 * g + r; QKM[t * 16 + fr] = hw_bf((fr <= t) ? acc[r] * Lf[O_GL + t] * gs_inv : 0.f); }
            }
        }
        if (c + 1 < c_end) GD_XFORM((c + 1) & 1);
        if (c + 2 < c_end) GD_LOAD(c + 2);
        LBAR();
        f32x4 accu = {0.f, 0.f, 0.f, 0.f};
        {
            const bf16x8 tf = mk_frag(*(const LAS u32x2*)(TB + fr * 16 + 4 * g), zz);
            u32x2 ulo, wlo;
            { const float b0 = B_[O_SC + 16 + 4 * g + 0], b1 = B_[O_SC + 16 + 4 * g + 1], b2 = B_[O_SC + 16 + 4 * g + 2], b3 = B_[O_SC + 16 + 4 * g + 3];
              ulo.x = hw_pk2(b0 * B_[O_VV + (4 * g + 0) * 128 + c0 + fr], b1 * B_[O_VV + (4 * g + 1) * 128 + c0 + fr]); ulo.y = hw_pk2(b2 * B_[O_VV + (4 * g + 2) * 128 + c0 + fr], b3 * B_[O_VV + (4 * g + 3) * 128 + c0 + fr]);
              wlo.x = hw_pk2(Lf[O_WSRC + (4 * g + 0) * 128 + c0 + fr], Lf[O_WSRC + (4 * g + 1) * 128 + c0 + fr]); wlo.y = hw_pk2(Lf[O_WSRC + (4 * g + 2) * 128 + c0 + fr], Lf[O_WSRC + (4 * g + 3) * 128 + c0 + fr]); }
            accu = __builtin_amdgcn_mfma_f32_16x16x32_bf16(tf, mk_frag(ulo, zz), accu, 0, 0, 0);
            f32x4 accw = {0.f, 0.f, 0.f, 0.f};
            accw = __builtin_amdgcn_mfma_f32_16x16x32_bf16(tf, mk_frag(wlo, zz), accw, 0, 0, 0);
#pragma unroll
            for (int r = 0; r < 4; ++r) WB[(4 * g + r) * RS + c0 + fr] = hw_bf(-accw[r]);
        }
        LBAR();
        if (role == 0) {
            GD_STATE_PART(c);
        } else {
            float* rec = STASH + (size_t)(c - c_begin) * REC;
            for (int i = tid; i < 832; i += NTHREADS) { const int o = i < 528 ? O_QB + 4 * i : (i < 800 ? O_WB + 4 * (i - 528) : O_QKM + 4 * (i - 800)); *(GAS f32x4*)(rec + 4 * i) = *(const LAS f32x4*)(Lf + o); }
#pragma unroll
            for (int r = 0; r < 4; ++r) rec[3328 + (w * 4 + r) * 64 + lane] = accu[r];
            if (tid == 0) rec[5376] = glast;
        }
        LBAR();
    }
    if (role == 0) {
#pragma unroll
        for (int i = 0; i < 8; ++i)
#pragma unroll
            for (int r = 0; r < 4; ++r) STATE[((w * 8 + i) * 4 + r) * 64 + lane] = Sacc[i][r];
        asm volatile("s_waitcnt vmcnt(0)" ::: "memory");
        __syncthreads();
        if (tid == 0) { __builtin_amdgcn_fence(__ATOMIC_RELEASE, "agent"); asm volatile("s_waitcnt vmcnt(0)" ::: "memory"); __hip_atomic_store(flag, 1u, __ATOMIC_RELAXED, __HIP_MEMORY_SCOPE_AGENT); }
    } else {
        if (tid == 0) { unsigned sp = 0; while (__hip_atomic_load(flag, __ATOMIC_RELAXED, __HIP_MEMORY_SCOPE_AGENT) == 0u) { __builtin_amdgcn_s_sleep(8); if (++sp > (1u << 22)) break; }
            __builtin_amdgcn_fence(__ATOMIC_ACQUIRE, "agent"); asm volatile("s_waitcnt vmcnt(0)" ::: "memory"); }
        __syncthreads();
#pragma unroll
        for (int i = 0; i < 8; ++i)
#pragma unroll
            for (int r = 0; r < 4; ++r) Sacc[i][r] = STATE[((w * 8 + i) * 4 + r) * 64 + lane];
        f32x4 pa, pb; f32x4 pu; float pg;
#define GD_REC_LOAD(cc) do { const float* rec = STASH + (size_t)((cc) - c_begin) * REC; pa = *(const GAS f32x4*)(rec + 4 * tid); pb = (tid < 320) ? *(const GAS f32x4*)(rec + 4 * (tid + 512)) : (f32x4){0.f, 0.f, 0.f, 0.f}; \
            _Pragma("unroll") for (int r = 0; r < 4; ++r) pu[r] = rec[3328 + (w * 4 + r) * 64 + lane]; pg = rec[5376]; } while (0)
        GD_REC_LOAD(c_begin);
        for (int c = c_begin; c < c_end; ++c) {
            { const int i0 = tid, o0 = i0 < 528 ? O_QB + 4 * i0 : O_WB + 4 * (i0 - 528); *(LAS f32x4*)(Lf + o0) = pa;
              if (tid < 320) { const int i1 = tid + 512; const int o1 = i1 < 528 ? O_QB + 4 * i1 : (i1 < 800 ? O_WB + 4 * (i1 - 528) : O_QKM + 4 * (i1 - 800)); *(LAS f32x4*)(Lf + o1) = pb; } }
            const f32x4 accu = pu; const float glast = pg;
            if (c + 1 < c_end) GD_REC_LOAD(c + 1);
            LBAR();
            GD_STATE_PART(c);
            LBAR();
        }
#undef GD_REC_LOAD
    }
#undef GD_STATE_PART
#undef GD_LOAD
#undef GD_XFORM
}

__device__ __forceinline__ void scan_rwkv_unit(const Args& A, Frame& F, int unit) {
    int tid = F.tid; asm volatile("" : "+v"(tid));
    const int lane = tid & 63, w = F.wave;
    const int b = unit >> 4, h = unit & 15;
    const bf16* P = (const bf16*)(A.ws + WS_PROJ) + (size_t)b * SEQ * PROJ_LD + OC_RW;
    const bf16* LO = (const bf16*)(A.ws + WS_LO) + (size_t)b * SEQ * LORA_N;
    bf16* Y = (bf16*)(A.ws + WS_ACTA) + (size_t)b * SEQ * D + 1024 + h * 64;
    LAS float* Lf = (LAS float*)(F.lds + RING_OFF);
    constexpr int BUFSZ = 6208, O_KK = 0, O_WR = 1024, O_W = 2048, O_NKA = 3072, O_K = 4096, O_V = 5120, O_SC = 6144, O_OUT = 2 * BUFSZ;
    const int tl = tid >> 5, d2 = (tid & 31) * 2, hd = h * 64 + d2;
    float mu_r[2], mu_k[2], mu_v[2], w0[2], a0[2], k_k[2], k_a[2], r_k[2], lnw[2], lnb[2];
#pragma unroll
    for (int i = 0; i < 2; ++i) { mu_r[i] = A.in[I_MU][RW_R + hd + i]; mu_k[i] = A.in[I_MU][RW_K + hd + i]; mu_v[i] = A.in[I_MU][RW_V + hd + i];
        w0[i] = A.in[I_W0][hd + i]; a0[i] = A.in[I_A0][hd + i]; k_k[i] = A.in[I_KK][hd + i]; k_a[i] = A.in[I_KA][hd + i]; r_k[i] = A.in[I_RK][hd + i];
        lnw[i] = A.in[I_LNW][hd + i]; lnb[i] = A.in[I_LNB][hd + i]; }
    unsigned rr[2], rk[2], rv[2], rlw, rla, rg_cur = 0u, rg_nxt = 0u;
#define RW_LOAD(c) do { const int t_ = (c) * TC + tl; const bf16* pr = P + (size_t)t_ * PROJ_LD; \
        rr[0] = *(const GAS unsigned*)(pr + RW_R + hd); rk[0] = *(const GAS unsigned*)(pr + RW_K + hd); rv[0] = *(const GAS unsigned*)(pr + RW_V + hd); \
        if (t_ > 0) { rr[1] = *(const GAS unsigned*)(pr - PROJ_LD + RW_R + hd); rk[1] = *(const GAS unsigned*)(pr - PROJ_LD + RW_K + hd); rv[1] = *(const GAS unsigned*)(pr - PROJ_LD + RW_V + hd); } \
        else { rr[1] = 0u; rk[1] = 0u; rv[1] = 0u; } \
        const bf16* lr = LO + (size_t)t_ * LORA_N; rlw = *(const GAS unsigned*)(lr + hd); rla = *(const GAS unsigned*)(lr + 1024 + hd); rg_nxt = *(const GAS unsigned*)(lr + 2048 + hd); } while (0)
#define RW_XFORM(bufi) do { LAS float* B_ = Lf + (bufi) * BUFSZ; f32x2 kk2, wr2, w2_, nka2, k2, v2_; float skk = 0.f, sc1 = 0.f, sc2 = 0.f, sbs = 0.f; float aa[2], rrv[2]; \
        _Pragma("unroll") for (int i_ = 0; i_ < 2; ++i_) { \
            const float r0 = i_ ? bf_hi(rr[0]) : bf_lo(rr[0]), r1 = i_ ? bf_hi(rr[1]) : bf_lo(rr[1]); \
            const float k0_ = i_ ? bf_hi(rk[0]) : bf_lo(rk[0]), k1_ = i_ ? bf_hi(rk[1]) : bf_lo(rk[1]); \
            const float v0_ = i_ ? bf_hi(rv[0]) : bf_lo(rv[0]), v1_ = i_ ? bf_hi(rv[1]) : bf_lo(rv[1]); \
            const float lw = i_ ? bf_hi(rlw) : bf_lo(rlw), la = i_ ? bf_hi(rla) : bf_lo(rla); \
            const float r_ = r0 + (r1 - r0) * mu_r[i_], kx = k0_ + (k1_ - k0_) * mu_k[i_], vx = v0_ + (v1_ - v0_) * mu_v[i_]; \
            const float wd = __expf(-0.6065306597126334f * sigmoidf_(w0[i_] + lw)); const float a_ = sigmoidf_(a0[i_] + la); \
            const float kk0 = kx * k_k[i_]; const float km = kx * (1.f + (a_ - 1.f) * k_a[i_]); \
            kk2[i_] = kk0; skk += kk0 * kk0; aa[i_] = a_; rrv[i_] = r_; wr2[i_] = wd * r_; w2_[i_] = wd; k2[i_] = km; v2_[i_] = vx; sc2 += km * r_; sbs += r_ * km * r_k[i_]; } \
        skk = half_sum32(skk); const float rkk = __builtin_amdgcn_rsqf(skk + EPS); \
        _Pragma("unroll") for (int i_ = 0; i_ < 2; ++i_) { kk2[i_] *= rkk; nka2[i_] = -(kk2[i_] * aa[i_]); sc1 += kk2[i_] * aa[i_] * rrv[i_]; } \
        sc1 = half_sum32(sc1); sc2 = half_sum32(sc2); sbs = half_sum32(sbs); \
        *(LAS f32x2*)(B_ + O_KK + tl * 64 + d2) = kk2; *(LAS f32x2*)(B_ + O_WR + tl * 64 + d2) = wr2; *(LAS f32x2*)(B_ + O_W + tl * 64 + d2) = w2_; \
        *(LAS f32x2*)(B_ + O_NKA + tl * 64 + d2) = nka2; *(LAS f32x2*)(B_ + O_K + tl * 64 + d2) = k2; *(LAS f32x2*)(B_ + O_V + tl * 64 + d2) = v2_; \
        if ((tid & 31) == 0) { f32x4 sc; sc[0] = sc1; sc[1] = sc2; sc[2] = sbs; sc[3] = 0.f; *(LAS f32x4*)(B_ + O_SC + tl * 4) = sc; } } while (0)
    RW_LOAD(0); RW_XFORM(0); rg_cur = rg_nxt;
    LBAR();
    f32x2 S2[4];
#pragma unroll
    for (int i = 0; i < 4; ++i) S2[i] = (f32x2){0.f, 0.f};
    const int j = lane & 15, col = w * 8 + (lane >> 4) * 2;
    for (int c = 0; c < NCHUNK; ++c) {
        if (c + 1 < NCHUNK) RW_LOAD(c + 1);
        const LAS float* B_ = Lf + (c & 1) * BUFSZ;
        float os0 = 0.f, os1 = 0.f;
        f32x4 kk, wr, ww, nka, kv, sc, nkk, nwr, nww, nnka, nkv, nsc; f32x2 v2, nv2;
#define RW_LDSTEP(t_, KK, WR, WW, NKA, KV, V2, SC) do { KK = *(const LAS f32x4*)(B_ + O_KK + (t_) * 64 + 4 * j); WR = *(const LAS f32x4*)(B_ + O_WR + (t_) * 64 + 4 * j); WW = *(const LAS f32x4*)(B_ + O_W + (t_) * 64 + 4 * j); \
            NKA = *(const LAS f32x4*)(B_ + O_NKA + (t_) * 64 + 4 * j); KV = *(const LAS f32x4*)(B_ + O_K + (t_) * 64 + 4 * j); V2 = *(const LAS f32x2*)(B_ + O_V + (t_) * 64 + col); SC = *(const LAS f32x4*)(B_ + O_SC + (t_) * 4); } while (0)
        RW_LDSTEP(0, kk, wr, ww, nka, kv, v2, sc);
#pragma unroll
        for (int t = 0; t < TC; ++t) {
            if (t + 1 < TC) { RW_LDSTEP(t + 1, nkk, nwr, nww, nnka, nkv, nv2, nsc); }
            __builtin_amdgcn_sched_barrier(0);
            f32x2 d1 = S2[0] * kk[0], d2 = S2[0] * wr[0], e1 = S2[1] * kk[1], e2 = S2[1] * wr[1];
            d1 += S2[2] * kk[2]; d2 += S2[2] * wr[2]; e1 += S2[3] * kk[3]; e2 += S2[3] * wr[3];
            d1 += e1; d2 += e2;
            { float r0_ = d1[0], r1_ = d1[1], r2_ = d2[0], r3_ = d2[1]; row_sum16_x4(r0_, r1_, r2_, r3_); d1[0] = r0_; d1[1] = r1_; d2[0] = r2_; d2[1] = r3_; }
            const f32x2 o2 = d2 - d1 * sc[0] + v2 * sc[1];
#pragma unroll
            for (int i = 0; i < 4; ++i) S2[i] = S2[i] * ww[i] + d1 * nka[i] + v2 * kv[i];
            os0 = (j == t) ? o2[0] : os0; os1 = (j == t) ? o2[1] : os1;
            kk = nkk; wr = nwr; ww = nww; nka = nnka; kv = nkv; v2 = nv2; sc = nsc;
        }
#undef RW_LDSTEP
        { f32x2 o2 = {os0, os1}; *(LAS f32x2*)(Lf + O_OUT + j * 64 + col) = o2; }
        if (c + 1 < NCHUNK) RW_XFORM((c + 1) & 1);
        LBAR();
        {
            const f32x2 o2 = *(const LAS f32x2*)(Lf + O_OUT + tl * 64 + d2); const f32x2 vv = *(const LAS f32x2*)(B_ + O_V + tl * 64 + d2); const float bs = B_[O_SC + tl * 4 + 2];
            const float mean = half_sum32(o2[0] + o2[1]) * (1.0f / 64.0f); const float e0 = o2[0] - mean, e1 = o2[1] - mean;
            const float var = half_sum32(e0 * e0 + e1 * e1) * (1.0f / 64.0f); const float rs = __builtin_amdgcn_rsqf(var + 64e-5f);
            const float y0 = (e0 * rs * lnw[0] + lnb[0] + bs * vv[0]) * bf_lo(rg_cur), y1 = (e1 * rs * lnw[1] + lnb[1] + bs * vv[1]) * bf_hi(rg_cur);
            *(GAS unsigned*)(Y + (size_t)(c * TC + tl) * D + d2) = pk2(y0, y1);
        }
        rg_cur = rg_nxt;
        LBAR();
    }
#undef RW_LOAD
#undef RW_XFORM
}

template <int LAYER>
__device__ __forceinline__ void post_rows(const Args& A, Frame& F) {
    const int gw = F.vcu * NWAVES + F.wave, NGW = F.G * NWAVES, lane = F.lane;
    const bf16* O = (const bf16*)(A.ws + WS_O); const bf16* P = (const bf16*)(A.ws + WS_PROJ); bf16* Y = (bf16*)(A.ws + WS_ACTA);
    for (int m = gw; m < T; m += NGW) {
        const GAS u32x2* orow = (const GAS u32x2*)(O + (size_t)m * D) + lane; const bf16* prow = P + (size_t)m * PROJ_LD;
        constexpr int NJ = LAYER == 0 ? 8 : 4;
        u32x2 ow_[NJ], zw_[NJ]; f32x4 gw_[NJ];
#pragma unroll
        for (int jj = 0; jj < NJ; ++jj) { const bool wide = (LAYER == 0 && jj < 4);
            const int zcol = LAYER == 0 ? (wide ? EC_GZ + jj * 256 + 4 * lane : EC_BZ + (jj - 4) * 256 + 4 * lane) : OC_HG + jj * 256 + 4 * lane;
            const float* gsrc = LAYER == 0 ? (wide ? A.in[I_GLA_NORM] : A.in[I_GDN_NORM]) : A.in[I_HG_NORM];
            ow_[jj] = orow[64 * jj]; zw_[jj] = *(const GAS u32x2*)(prow + zcol); gw_[jj] = *(const GAS f32x4*)(gsrc + (wide ? 4 * lane : 4 * (lane & 31))); }
        u32x2 yo_[NJ];
#pragma unroll
        for (int jj = 0; jj < NJ; ++jj) {
            const f32x4 v = {bf_lo(ow_[jj].x), bf_hi(ow_[jj].x), bf_lo(ow_[jj].y), bf_hi(ow_[jj].y)}; float ss = (v[0] * v[0] + v[1] * v[1]) + (v[2] * v[2] + v[3] * v[3]);
            const bool wide = (LAYER == 0 && jj < 4);
            const float ms = wide ? wave_sum(ss) * (1.0f / 256.0f) : half_sum32(ss) * (1.0f / 128.0f);
            const float r = __builtin_amdgcn_rsqf(ms + EPS);
            const f32x4 g = gw_[jj]; const u32x2 zw = zw_[jj];
            const float y0 = v[0] * r * g[0] * siluf_(bf_lo(zw.x)), y1 = v[1] * r * g[1] * siluf_(bf_hi(zw.x)), y2 = v[2] * r * g[2] * siluf_(bf_lo(zw.y)), y3 = v[3] * r * g[3] * siluf_(bf_hi(zw.y));
            if constexpr (LAYER == 1) { int o8 = __builtin_amdgcn_cvt_pk_fp8_f32(y0, y1, 0, false); o8 = __builtin_amdgcn_cvt_pk_fp8_f32(y2, y3, o8, true); yo_[jj].x = (unsigned)o8; yo_[jj].y = 0u; }
            else { yo_[jj].x = pk2(y0, y1); yo_[jj].y = pk2(y2, y3); }
        }
#pragma unroll
        for (int jj = 0; jj < NJ; ++jj) {
            if constexpr (LAYER == 1) *(GAS unsigned*)((unsigned char*)Y + (size_t)m * D + 256 * jj + 4 * lane) = yo_[jj].x;
            else *(GAS u32x2*)(Y + (size_t)m * D + 256 * jj + 4 * lane) = yo_[jj]; }
    }
}
__device__ __forceinline__ void lora_prep_rows(const Args& A, Frame& F) {
    const int gtid = (F.vcu * NWAVES + F.wave) * 64 + F.lane, step = F.G * NWAVES;
    const bf16* P = (const bf16*)(A.ws + WS_PROJ); bf16* LA = (bf16*)(A.ws + WS_LA); const GAS float* mu = (const GAS float*)A.in[I_MU];
    const int gi = gtid & 63;
    if (gi >= 56) { for (int m = gtid >> 6; m < T; m += step) *(GAS v4u*)(LA + (size_t)m * LORA_K + 8 * gi) = (v4u){0u, 0u, 0u, 0u}; return; }
    const f32x4 mua = *(const GAS f32x4*)(mu + RW_WL + 8 * gi), mub = *(const GAS f32x4*)(mu + RW_WL + 8 * gi + 4);
    const float muv[8] = {mua[0], mua[1], mua[2], mua[3], mub[0], mub[1], mub[2], mub[3]};
    const int mode = gi < 12 ? 0 : (gi < 24 ? 1 : 2);
    const float ksc = mode == 0 ? 2.0f : 1.0f;
    for (int m0 = gtid >> 6; m0 < T; m0 += 4 * step) {
        v4u xw[4], pw[4];
#pragma unroll
        for (int k = 0; k < 4; ++k) { const int m = m0 + k * step; xw[k] = (v4u){0u, 0u, 0u, 0u}; pw[k] = xw[k];
            if (m < T) { const GAS bf16* prow = (const GAS bf16*)(P + (size_t)m * PROJ_LD + OC_RW + RW_WL + 8 * gi); xw[k] = *(const GAS v4u*)prow; if ((m % SEQ) != 0) pw[k] = *(const GAS v4u*)(prow - PROJ_LD); } }
#pragma unroll
        for (int k = 0; k < 4; ++k) { const int m = m0 + k * step; if (m >= T) break;
            const unsigned xs[4] = {xw[k].x, xw[k].y, xw[k].z, xw[k].w}, ps[4] = {pw[k].x, pw[k].y, pw[k].z, pw[k].w}; unsigned ow[4];
#pragma unroll
            for (int e2 = 0; e2 < 4; ++e2) { float v2[2];
#pragma unroll
                for (int hf = 0; hf < 2; ++hf) { const float x = hf ? bf_hi(xs[e2]) : bf_lo(xs[e2]), xp = hf ? bf_hi(ps[e2]) : bf_lo(ps[e2]);
                    const float ts = x + (xp - x) * muv[2 * e2 + hf];
                    const float s = __builtin_amdgcn_rcpf(1.0f + __expf(-ksc * ts));
                    v2[hf] = mode == 0 ? 2.0f * s - 1.0f : (mode == 1 ? ts : s); }
                ow[e2] = pk2(v2[0], v2[1]); }
            v4u o; o.x = ow[0]; o.y = ow[1]; o.z = ow[2]; o.w = ow[3];
            *(GAS v4u*)(LA + (size_t)m * LORA_K + 8 * gi) = o; }
    }
}
__device__ __forceinline__ void final_rows(const Args& A, Frame& F, const float oscale, const bf16* Hs) {
    const int gw = F.vcu * NWAVES + F.wave, NGW = F.G * NWAVES, lane = F.lane;
    const float* rowss = (const float*)(A.ws + WS_RSP) + (size_t)RS_FINAL * T * 32; const GAS f32x4* g = (const GAS f32x4*)A.in[I_NFINAL] + lane;
    for (int m = gw; m < T; m += NGW) { const float r = oscale * __builtin_amdgcn_rsqf(wave_sum(lane < 32 ? rowss[(size_t)m * 32 + lane] : 0.f) * (1.0f / D) + EPS); GAS f32x4* row = (GAS f32x4*)(A.out + (size_t)m * D) + lane;
        const GAS u32x2* hrow = (const GAS u32x2*)(Hs + (size_t)m * D) + lane;
        u32x2 hw_[8]; f32x4 g_[8];
#pragma unroll
        for (int jj = 0; jj < 8; ++jj) { hw_[jj] = hrow[64 * jj]; g_[jj] = g[64 * jj]; }
#pragma unroll
        for (int jj = 0; jj < 8; ++jj) { const u32x2 hw = hw_[jj]; const f32x4 v = {bf_lo(hw.x), bf_hi(hw.x), bf_lo(hw.y), bf_hi(hw.y)}; row[64 * jj] = v * r * g_[jj]; } }
}

__device__ __forceinline__ void scan_rwkv_mfma_unit(const Args& A, Frame& F, int unit, const int role) {
    int tid = F.tid; asm volatile("" : "+v"(tid));
    const int lane = tid & 63, w = F.wave;
    const int b = unit >> 3, hp = unit & 7;
    const bf16* P = (const bf16*)(A.ws + WS_PROJ) + (size_t)b * SEQ * PROJ_LD + OC_RW;
    const bf16* LO = (const bf16*)(A.ws + WS_LO) + (size_t)b * SEQ * LORA_N;
    unsigned char* Y = (unsigned char*)(A.ws + WS_ACTA) + (size_t)b * SEQ * D + 1024;
    LAS float* Lf = (LAS float*)(F.lds + RING_OFF);
    constexpr int RS = 72;
    constexpr int O_CONST = 0;
    constexpr int O_XF = 1280;
    constexpr int O_VV = O_XF + 2 * 5 * 1024;
    constexpr int O_BS = O_VV + 4 * 1024;
    constexpr int O_IMG = O_BS + 64;
    constexpr int I_CT = 0, I_BT = 576, I_KL = 1152, I_RT = 1728, I_CF = 2304, I_BTT = 3328, I_KTT = 3840, I_WCB = 4352, I_G1B = 4928, I_TTB = 5056, I_RKB = 5184, I_RBB = 5312, I_W15 = 5440, I_OUT = 5504, IMGSZ = 6528;
    static_assert((O_IMG + 2 * IMGSZ) * 4 <= RING_BYTES, "rwkv lds");
    for (int i = tid; i < 1280; i += NTHREADS) { const int arr = i >> 7, ch = hp * 128 + (i & 127); float v;
        switch (arr) { case 0: v = A.in[I_MU][RW_R + ch]; break; case 1: v = A.in[I_MU][RW_K + ch]; break; case 2: v = A.in[I_MU][RW_V + ch]; break; case 3: v = A.in[I_W0][ch]; break; case 4: v = A.in[I_A0][ch]; break;
                       case 5: v = A.in[I_KK][ch]; break; case 6: v = A.in[I_KA][ch]; break; case 7: v = A.in[I_RK][ch]; break; case 8: v = A.in[I_LNW][ch]; break; default: v = A.in[I_LNB][ch]; break; }
        Lf[O_CONST + i] = v; }
    const int hx = tid >> 8, tl = (tid >> 4) & 15, d4 = (tid & 15) * 4, ch4 = hx * 64 + d4, col4 = hp * 128 + ch4;
    u32x2 rr[2], rk[2], rv[2], rlw, rla, rg_cur = {0u, 0u}, rg_nxt = {0u, 0u}, rg_far = {0u, 0u};
#define RM_LOAD(c) do { const int t_ = (c) * TC + tl; const bf16* pr = P + (size_t)t_ * PROJ_LD + col4; \
        rr[0] = *(const GAS u32x2*)(pr + RW_R); rk[0] = *(const GAS u32x2*)(pr + RW_K); rv[0] = *(const GAS u32x2*)(pr + RW_V); \
        const bf16* pp_ = (t_ > 0) ? pr - PROJ_LD : pr; rr[1] = *(const GAS u32x2*)(pp_ + RW_R); rk[1] = *(const GAS u32x2*)(pp_ + RW_K); rv[1] = *(const GAS u32x2*)(pp_ + RW_V); \
        if (t_ == 0) { rr[1] = (u32x2){0u, 0u}; rk[1] = (u32x2){0u, 0u}; rv[1] = (u32x2){0u, 0u}; } \
        const bf16* lr = LO + (size_t)t_ * LORA_N + col4; rlw = *(const GAS u32x2*)(lr); rla = *(const GAS u32x2*)(lr + 1024); rg_far = *(const GAS u32x2*)(lr + 2048); } while (0)
#define RM_XFORM(bufi) do { LAS float* X_ = Lf + O_XF + hx * 5 * 1024 + tl * 64 + d4; \
        const f32x4 mur = *(const LAS f32x4*)(Lf + O_CONST + 0 * 128 + ch4), muk = *(const LAS f32x4*)(Lf + O_CONST + 1 * 128 + ch4), muv = *(const LAS f32x4*)(Lf + O_CONST + 2 * 128 + ch4); \
        const f32x4 w0_ = *(const LAS f32x4*)(Lf + O_CONST + 3 * 128 + ch4), a0_ = *(const LAS f32x4*)(Lf + O_CONST + 4 * 128 + ch4), kk_ = *(const LAS f32x4*)(Lf + O_CONST + 5 * 128 + ch4); \
        const f32x4 ka_ = *(const LAS f32x4*)(Lf + O_CONST + 6 * 128 + ch4), rk_ = *(const LAS f32x4*)(Lf + O_CONST + 7 * 128 + ch4); \
        const float r0[4] = {bf_lo(rr[0].x), bf_hi(rr[0].x), bf_lo(rr[0].y), bf_hi(rr[0].y)}, r1[4] = {bf_lo(rr[1].x), bf_hi(rr[1].x), bf_lo(rr[1].y), bf_hi(rr[1].y)}; \
        const float k0[4] = {bf_lo(rk[0].x), bf_hi(rk[0].x), bf_lo(rk[0].y), bf_hi(rk[0].y)}, k1[4] = {bf_lo(rk[1].x), bf_hi(rk[1].x), bf_lo(rk[1].y), bf_hi(rk[1].y)}; \
        const float v0[4] = {bf_lo(rv[0].x), bf_hi(rv[0].x), bf_lo(rv[0].y), bf_hi(rv[0].y)}, v1[4] = {bf_lo(rv[1].x), bf_hi(rv[1].x), bf_lo(rv[1].y), bf_hi(rv[1].y)}; \
        const float lw[4] = {bf_lo(rlw.x), bf_hi(rlw.x), bf_lo(rlw.y), bf_hi(rlw.y)}, la[4] = {bf_lo(rla.x), bf_hi(rla.x), bf_lo(rla.y), bf_hi(rla.y)}; \
        f32x4 r4, w4, k4, v4, kk4, b4; float skk = 0.f, sbs = 0.f; float aa[4]; \
        _Pragma("unroll") for (int i_ = 0; i_ < 4; ++i_) { const float r_ = r0[i_] + (r1[i_] - r0[i_]) * mur[i_], kx = k0[i_] + (k1[i_] - k0[i_]) * muk[i_], vx = v0[i_] + (v1[i_] - v0[i_]) * muv[i_]; \
            const float wd = __expf(-0.6065306597126334f * sigmoidf_(w0_[i_] + lw[i_])); const float a_ = sigmoidf_(a0_[i_] + la[i_]); \
            const float kk0 = kx * kk_[i_], km = kx * (1.f + (a_ - 1.f) * ka_[i_]); \
            r4[i_] = r_; w4[i_] = wd; k4[i_] = km; v4[i_] = vx; kk4[i_] = kk0; aa[i_] = a_; skk += kk0 * kk0; sbs += r_ * km * rk_[i_]; } \
        row_sum16_x2(skk, sbs); const float rkk = __builtin_amdgcn_rsqf(skk + EPS); \
        _Pragma("unroll") for (int i_ = 0; i_ < 4; ++i_) { kk4[i_] *= rkk; b4[i_] = kk4[i_] * aa[i_]; } \
        *(LAS f32x4*)(X_) = r4; *(LAS f32x4*)(X_ + 1024) = w4; *(LAS f32x4*)(X_ + 2048) = k4; *(LAS f32x4*)(X_ + 3072) = kk4; *(LAS f32x4*)(X_ + 4096) = b4; \
        *(LAS f32x4*)(Lf + O_VV + ((bufi) * 2 + hx) * 1024 + tl * 64 + d4) = v4; \
        if ((tid & 15) == 0) Lf[O_BS + ((bufi) * 2 + hx) * 16 + tl] = sbs; } while (0)
    constexpr int SPLIT = 60;
    const int c_begin = role ? SPLIT : 0, c_end = role ? NCHUNK : SPLIT;
    constexpr int REC = 7584;
    float* STASH = (float*)(A.ws + (unit < 32 ? WS_WEV_IN : WS_END)) + (size_t)(unit & 31) * (NCHUNK - SPLIT) * REC;
    float* STATE = (float*)(A.ws + WS_STATE + 4 * MiB) + (size_t)unit * 8192;
    gu32* flag = F.ctl + 49152 + unit * 64;
    LBAR();
    RM_LOAD(c_begin); RM_XFORM(c_begin & 1); rg_cur = rg_far; RM_LOAD(c_begin + 1); rg_nxt = rg_far;
    LBAR();
    f32x4 Macc[4];
#pragma unroll
    for (int i = 0; i < 4; ++i) Macc[i] = (f32x4){0.f, 0.f, 0.f, 0.f};
    const int fr = lane & 15, g = lane >> 4, hh = w >> 2, ww = w & 3, c0 = ww * 16;
    LAS float* IM = Lf + O_IMG + hh * IMGSZ;
    LAS bf16* CT = (LAS bf16*)(IM + I_CT); LAS bf16* BT = (LAS bf16*)(IM + I_BT); LAS bf16* KL = (LAS bf16*)(IM + I_KL); LAS bf16* RT = (LAS bf16*)(IM + I_RT);
    LAS bf16* BTT = (LAS bf16*)(IM + I_BTT); LAS bf16* KTT = (LAS bf16*)(IM + I_KTT); LAS bf16* WCB = (LAS bf16*)(IM + I_WCB);
    LAS bf16* G1B = (LAS bf16*)(IM + I_G1B); LAS bf16* TTB = (LAS bf16*)(IM + I_TTB); LAS bf16* RKB = (LAS bf16*)(IM + I_RKB); LAS bf16* RBB = (LAS bf16*)(IM + I_RBB);
    const u32x2 zz = {0u, 0u};
#define RM_STATE_PART(vb) do { \
        { \
            bf16x8 mb[2]; \
_Pragma("unroll") \
            for (int ks = 0; ks < 2; ++ks) { u32x2 slo, shi; slo.x = hw_pk2(Macc[2 * ks][0], Macc[2 * ks][1]); slo.y = hw_pk2(Macc[2 * ks][2], Macc[2 * ks][3]); shi.x = hw_pk2(Macc[2 * ks + 1][0], Macc[2 * ks + 1][1]); shi.y = hw_pk2(Macc[2 * ks + 1][2], Macc[2 * ks + 1][3]); \
                mb[ks] = mk_frag(slo, shi); } \
            f32x4 accR = accU, acco = {0.f, 0.f, 0.f, 0.f}; \
_Pragma("unroll") \
            for (int ks = 0; ks < 2; ++ks) { \
                accR = __builtin_amdgcn_mfma_f32_16x16x32_bf16(mk_frag(*(const LAS u32x2*)(WCB + fr * RS + 32 * ks + 4 * g), *(const LAS u32x2*)(WCB + fr * RS + 32 * ks + 16 + 4 * g)), mb[ks], accR, 0, 0, 0); \
                acco = __builtin_amdgcn_mfma_f32_16x16x32_bf16(mk_frag(*(const LAS u32x2*)(RT + fr * RS + 32 * ks + 4 * g), *(const LAS u32x2*)(RT + fr * RS + 32 * ks + 16 + 4 * g)), mb[ks], acco, 0, 0, 0); } \
            u32x2 rn; rn.x = hw_pk2(accR[0], accR[1]); rn.y = hw_pk2(accR[2], accR[3]); \
            const bf16x8 rb = mk_frag(rn, zz); \
            acco = __builtin_amdgcn_mfma_f32_16x16x32_bf16(mk_frag(*(const LAS u32x2*)(RKB + fr * 16 + 4 * g), zz), vb, acco, 0, 0, 0); \
            acco = __builtin_amdgcn_mfma_f32_16x16x32_bf16(mk_frag(*(const LAS u32x2*)(RBB + fr * 16 + 4 * g), zz), rb, acco, 0, 0, 0); \
_Pragma("unroll") \
            for (int r = 0; r < 4; ++r) IM[I_OUT + (4 * g + r) * 64 + c0 + fr] = acco[r]; \
_Pragma("unroll") \
            for (int i = 0; i < 4; ++i) { const f32x4 w15 = *(const LAS f32x4*)(IM + I_W15 + 16 * i + 4 * g); \
                f32x4 m = __builtin_amdgcn_mfma_f32_16x16x32_bf16(mk_frag(*(const LAS u32x2*)(KTT + (16 * i + fr) * 16 + 4 * g), zz), vb, Macc[i], 0, 0, 0); \
                m = __builtin_amdgcn_mfma_f32_16x16x32_bf16(mk_frag(*(const LAS u32x2*)(BTT + (16 * i + fr) * 16 + 4 * g), zz), rb, m, 0, 0, 0); \
                Macc[i] = m * w15; } \
        } \
        } while (0)
#define RM_FLUSH(cc_, gb_, vv_, bs_) do { \
        { \
            const f32x4 o4 = *(const LAS f32x4*)(Lf + O_IMG + hx * IMGSZ + I_OUT + tl * 64 + d4); const f32x4 vv = (vv_); const float bs = (bs_); \
            const f32x4 lnw = *(const LAS f32x4*)(Lf + O_CONST + 8 * 128 + ch4), lnb = *(const LAS f32x4*)(Lf + O_CONST + 9 * 128 + ch4); \
            float sm = (o4[0] + o4[1]) + (o4[2] + o4[3]), dummy = 0.f; row_sum16_x2(sm, dummy); const float mean = sm * (1.0f / 64.0f); \
            const f32x4 e4 = o4 - mean; float sv = (e4[0] * e4[0] + e4[1] * e4[1]) + (e4[2] * e4[2] + e4[3] * e4[3]); row_sum16_x2(sv, dummy); const float rs = __builtin_amdgcn_rsqf(sv * (1.0f / 64.0f) + 64e-5f); \
            const float gg[4] = {bf_lo((gb_).x), bf_hi((gb_).x), bf_lo((gb_).y), bf_hi((gb_).y)}; \
            float y[4]; \
_Pragma("unroll") \
            for (int i = 0; i < 4; ++i) y[i] = (e4[i] * rs * lnw[i] + lnb[i] + bs * vv[i]) * gg[i]; \
            int o8 = __builtin_amdgcn_cvt_pk_fp8_f32(y[0], y[1], 0, false); o8 = __builtin_amdgcn_cvt_pk_fp8_f32(y[2], y[3], o8, true); \
            *(GAS unsigned*)(Y + (size_t)((cc_) * TC + tl) * D + col4) = (unsigned)o8; \
        } \
        } while (0)
    for (int c = c_begin; c < c_end; ++c) {
        {
            const int hq = tid >> 8, seg = (tid >> 6) & 3, d = tid & 63;
            const LAS float* X_ = Lf + O_XF + hq * 5 * 1024 + d; LAS float* IQ = Lf + O_IMG + hq * IMGSZ;
            LAS bf16* CTq = (LAS bf16*)(IQ + I_CT); LAS bf16* BTq = (LAS bf16*)(IQ + I_BT); LAS bf16* KLq = (LAS bf16*)(IQ + I_KL); LAS bf16* RTq = (LAS bf16*)(IQ + I_RT);
            float wall = 1.f, wpre = 1.f;
#pragma unroll
            for (int t = 0; t < 16; ++t) { if (t == 4 * seg) wpre = wall; wall *= X_[1024 + t * 64]; }
            float wt = wpre; unsigned short bt4[4], kt4[4];
#pragma unroll
            for (int i = 0; i < 4; ++i) { const int t = 4 * seg + i; const float wprev = wt; wt *= X_[1024 + t * 64]; const float iw = __builtin_amdgcn_rcpf(wt);
                const float r_ = X_[t * 64], k_ = X_[2048 + t * 64], kk_ = X_[3072 + t * 64], b_ = X_[4096 + t * 64];
                const float ct = kk_ * wprev, bt = b_ * iw, kt = k_ * iw;
                CTq[t * RS + d] = hw_bf(ct); IQ[I_CF + t * 64 + d] = ct; BTq[t * RS + d] = hw_bf(bt); KLq[t * RS + d] = hw_bf(kt); RTq[t * RS + d] = hw_bf(r_ * wt);
                bt4[i] = (unsigned short)hw_bf(-bt); kt4[i] = (unsigned short)hw_bf(kt); }
            u32x2 o; o.x = (unsigned)bt4[0] | ((unsigned)bt4[1] << 16); o.y = (unsigned)bt4[2] | ((unsigned)bt4[3] << 16); *(LAS u32x2*)((LAS bf16*)(IQ + I_BTT) + d * 16 + 4 * seg) = o;
            o.x = (unsigned)kt4[0] | ((unsigned)kt4[1] << 16); o.y = (unsigned)kt4[2] | ((unsigned)kt4[3] << 16); *(LAS u32x2*)((LAS bf16*)(IQ + I_KTT) + d * 16 + 4 * seg) = o;
            if (seg == 3) IQ[I_W15 + d] = wall;
        }
        LBAR();
        if (ww == 0) {
            f32x4 cb = {0.f, 0.f, 0.f, 0.f}, bc = cb, ck = cb, rkm = cb, rbm = cb;
#pragma unroll
            for (int ks = 0; ks < 2; ++ks) { const bf16x8 fc = *(const LAS bf16x8*)(CT + fr * RS + 32 * ks + 8 * g), fb = *(const LAS bf16x8*)(BT + fr * RS + 32 * ks + 8 * g), fk = *(const LAS bf16x8*)(KL + fr * RS + 32 * ks + 8 * g), frr = *(const LAS bf16x8*)(RT + fr * RS + 32 * ks + 8 * g);
                cb = __builtin_amdgcn_mfma_f32_16x16x32_bf16(fc, fb, cb, 0, 0, 0); bc = __builtin_amdgcn_mfma_f32_16x16x32_bf16(fb, fc, bc, 0, 0, 0); ck = __builtin_amdgcn_mfma_f32_16x16x32_bf16(fc, fk, ck, 0, 0, 0);
                rkm = __builtin_amdgcn_mfma_f32_16x16x32_bf16(frr, fk, rkm, 0, 0, 0); rbm = __builtin_amdgcn_mfma_f32_16x16x32_bf16(frr, fb, rbm, 0, 0, 0); }
            f32x4 N1, M1, CKm;
#pragma unroll
            for (int r = 0; r < 4; ++r) { const int t = 4 * g + r; N1[r] = (fr < t) ? -cb[r] : 0.f; M1[r] = (t < fr) ? -bc[r] : 0.f; CKm[r] = (fr < t) ? ck[r] : 0.f;
                RKB[t * 16 + fr] = hw_bf((fr <= t) ? rkm[r] : 0.f); RBB[t * 16 + fr] = hw_bf((fr <= t) ? -rbm[r] : 0.f); }
#define XTY(X, Y, C0) __builtin_amdgcn_mfma_f32_16x16x32_bf16(mk_frag((u32x2){hw_pk2(X[0], X[1]), hw_pk2(X[2], X[3])}, zz), mk_frag((u32x2){hw_pk2(Y[0], Y[1]), hw_pk2(Y[2], Y[3])}, zz), C0, 0, 0, 0)
            const f32x4 z4 = {0.f, 0.f, 0.f, 0.f};
            f32x4 T1t = M1;
#pragma unroll
            for (int r = 0; r < 4; ++r) if (4 * g + r == fr) T1t[r] += 1.f;
            const f32x4 N2 = XTY(M1, N1, z4), M2 = XTY(N1, M1, z4);
            const f32x4 T2t = XTY(N2, T1t, T1t);
            const f32x4 N4 = XTY(M2, N2, z4), M4 = XTY(N2, M2, z4);
            const f32x4 T4t = XTY(N4, T2t, T2t);
            const f32x4 N8 = XTY(M4, N4, z4);
            const f32x4 T8t = XTY(N8, T4t, T4t);
            const f32x4 G1t = XTY(CKm, T8t, z4);
#undef XTY
            u32x2 tw; tw.x = hw_pk2(T8t[0], T8t[1]); tw.y = hw_pk2(T8t[2], T8t[3]); *(LAS u32x2*)(TTB + fr * 16 + 4 * g) = tw;
            tw.x = hw_pk2(G1t[0], G1t[1]); tw.y = hw_pk2(G1t[2], G1t[3]); *(LAS u32x2*)(G1B + fr * 16 + 4 * g) = tw;
        }
        if (c + 1 < c_end) { RM_XFORM((c + 1) & 1); }
        if (c + 2 < c_end) RM_LOAD(c + 2);
        LBAR();
        const LAS float* VVc = Lf + O_VV + ((c & 1) * 2 + hh) * 1024;
        u32x2 vlo; { vlo.x = hw_pk2(VVc[(4 * g + 0) * 64 + c0 + fr], VVc[(4 * g + 1) * 64 + c0 + fr]); vlo.y = hw_pk2(VVc[(4 * g + 2) * 64 + c0 + fr], VVc[(4 * g + 3) * 64 + c0 + fr]); }
        const bf16x8 vb = mk_frag(vlo, zz);
        f32x4 accU = {0.f, 0.f, 0.f, 0.f};
        {
            accU = __builtin_amdgcn_mfma_f32_16x16x32_bf16(mk_frag(*(const LAS u32x2*)(G1B + fr * 16 + 4 * g), zz), vb, accU, 0, 0, 0);
            u32x2 clo; clo.x = hw_pk2(IM[I_CF + (4 * g + 0) * 64 + c0 + fr], IM[I_CF + (4 * g + 1) * 64 + c0 + fr]); clo.y = hw_pk2(IM[I_CF + (4 * g + 2) * 64 + c0 + fr], IM[I_CF + (4 * g + 3) * 64 + c0 + fr]);
            f32x4 accw = {0.f, 0.f, 0.f, 0.f};
            accw = __builtin_amdgcn_mfma_f32_16x16x32_bf16(mk_frag(*(const LAS u32x2*)(TTB + fr * 16 + 4 * g), zz), mk_frag(clo, zz), accw, 0, 0, 0);
#pragma unroll
            for (int r = 0; r < 4; ++r) WCB[(4 * g + r) * RS + c0 + fr] = hw_bf(accw[r]);
        }
        LBAR();
        if (role == 0) {
            RM_STATE_PART(vb);
            LBAR();
            RM_FLUSH(c, rg_cur, *(const LAS f32x4*)(Lf + O_VV + ((c & 1) * 2 + hx) * 1024 + tl * 64 + d4), Lf[O_BS + ((c & 1) * 2 + hx) * 16 + tl]);
        } else {
            float* rec = STASH + (size_t)(c - c_begin) * REC;
            for (int i = tid; i < 1376; i += NTHREADS) { const int hd = i >= 688, j = i - hd * 688; const int o = O_IMG + hd * IMGSZ + (j < 144 ? I_RT + 4 * j : I_BTT + 4 * (j - 144)); *(GAS f32x4*)(rec + 4 * i) = *(const LAS f32x4*)(Lf + o); }
            { GAS unsigned* ru = (GAS unsigned*)(rec + 5504); ru[(w * 2 + 0) * 64 + lane] = hw_pk2(accU[0], accU[1]); ru[(w * 2 + 1) * 64 + lane] = hw_pk2(accU[2], accU[3]); }
            { const f32x4 v4 = *(const LAS f32x4*)(Lf + O_VV + ((c & 1) * 2 + hx) * 1024 + tl * 64 + d4); u32x2 o; o.x = hw_pk2(v4[0], v4[1]); o.y = hw_pk2(v4[2], v4[3]); *(GAS u32x2*)(rec + 6528 + 2 * tid) = o; }
            if (tid < 32) rec[7552 + tid] = Lf[O_BS + (c & 1) * 32 + tid];
            LBAR();
        }
        rg_cur = rg_nxt; rg_nxt = rg_far;
    }
    if (role == 0) {
#pragma unroll
        for (int i = 0; i < 4; ++i)
#pragma unroll
            for (int r = 0; r < 4; ++r) STATE[((w * 4 + i) * 4 + r) * 64 + lane] = Macc[i][r];
        asm volatile("s_waitcnt vmcnt(0)" ::: "memory");
        __syncthreads();
        if (tid == 0) { __builtin_amdgcn_fence(__ATOMIC_RELEASE, "agent"); asm volatile("s_waitcnt vmcnt(0)" ::: "memory"); __hip_atomic_store(flag, 1u, __ATOMIC_RELAXED, __HIP_MEMORY_SCOPE_AGENT); }
    } else {
        if (tid == 0) { unsigned sp = 0; while (__hip_atomic_load(flag, __ATOMIC_RELAXED, __HIP_MEMORY_SCOPE_AGENT) == 0u) { __builtin_amdgcn_s_sleep(8); if (++sp > (1u << 22)) break; }
            __builtin_amdgcn_fence(__ATOMIC_ACQUIRE, "agent"); asm volatile("s_waitcnt vmcnt(0)" ::: "memory"); }
        __syncthreads();
#pragma unroll
        for (int i = 0; i < 4; ++i)
#pragma unroll
            for (int r = 0; r < 4; ++r) Macc[i][r] = STATE[((w * 4 + i) * 4 + r) * 64 + lane];
        f32x4 pi0, pi1, pi2; unsigned pu0, pu1; u32x2 pv, pgate; float pbs;
#define RM_REC_LOAD(cc) do { const float* rec = STASH + (size_t)((cc) - c_begin) * REC; pi0 = *(const GAS f32x4*)(rec + 4 * tid); pi1 = *(const GAS f32x4*)(rec + 4 * (tid + 512)); \
            pi2 = (tid < 352) ? *(const GAS f32x4*)(rec + 4 * (tid + 1024)) : (f32x4){0.f, 0.f, 0.f, 0.f}; \
            const GAS unsigned* ru = (const GAS unsigned*)(rec + 5504); pu0 = ru[(w * 2 + 0) * 64 + lane]; pu1 = ru[(w * 2 + 1) * 64 + lane]; pv = *(const GAS u32x2*)(rec + 6528 + 2 * tid); pbs = rec[7552 + hx * 16 + tl]; \
            pgate = *(const GAS u32x2*)(LO + (size_t)((cc) * TC + tl) * LORA_N + col4 + 2048); } while (0)
#define RM_IMG_OFF(i_) (O_IMG + ((i_) >= 688) * IMGSZ + ((((i_) - ((i_) >= 688) * 688) < 144) ? I_RT + 4 * ((i_) - ((i_) >= 688) * 688) : I_BTT + 4 * (((i_) - ((i_) >= 688) * 688) - 144)))
        RM_REC_LOAD(c_begin);
        for (int c = c_begin; c < c_end; ++c) {
            *(LAS f32x4*)(Lf + RM_IMG_OFF(tid)) = pi0; *(LAS f32x4*)(Lf + RM_IMG_OFF(tid + 512)) = pi1; if (tid < 352) *(LAS f32x4*)(Lf + RM_IMG_OFF(tid + 1024)) = pi2;
            const f32x4 vcur = {bf_lo(pv.x), bf_hi(pv.x), bf_lo(pv.y), bf_hi(pv.y)}; *(LAS f32x4*)(Lf + O_VV + hx * 1024 + tl * 64 + d4) = vcur;
            const f32x4 accU = {bf_lo(pu0), bf_hi(pu0), bf_lo(pu1), bf_hi(pu1)}; const float bscur = pbs; const u32x2 gcur = pgate;
            if (c + 1 < c_end) RM_REC_LOAD(c + 1);
            LBAR();
            const LAS float* VVc = Lf + O_VV + hh * 1024;
            u32x2 vlo; { vlo.x = hw_pk2(VVc[(4 * g + 0) * 64 + c0 + fr], VVc[(4 * g + 1) * 64 + c0 + fr]); vlo.y = hw_pk2(VVc[(4 * g + 2) * 64 + c0 + fr], VVc[(4 * g + 3) * 64 + c0 + fr]); }
            const bf16x8 vb = mk_frag(vlo, zz);
            RM_STATE_PART(vb);
            LBAR();
            RM_FLUSH(c, gcur, vcur, bscur);
            LBAR();
        }
#undef RM_REC_LOAD
#undef RM_IMG_OFF
    }
#undef RM_STATE_PART
#undef RM_FLUSH
#undef RM_LOAD
#undef RM_XFORM
}

__device__ __forceinline__ int med3i(int a, int b, int c) { int r; asm("v_med3_i32 %0, %1, %2, %3" : "=v"(r) : "v"(a), "v"(b), "v"(c)); return r; }
__device__ __forceinline__ int f2sort(float f) { int x = __float_as_int(f); return x ^ ((x >> 31) & 0x7fffffff); }
__device__ __forceinline__ float sort2f(int x) { return __int_as_float(x ^ ((x >> 31) & 0x7fffffff)); }
#define TOPK_INSERT(vals, x) do { _Pragma("unroll") for (int s_ = 15; s_ >= 1; --s_) vals[s_] = med3i((x), vals[s_ - 1], vals[s_]); vals[0] = max(vals[0], (x)); } while (0)
__device__ __forceinline__ float bf_dot2(unsigned a, unsigned b, float c) {
    return c + bf_lo(a) * bf_lo(b) + bf_hi(a) * bf_hi(b);
}
__device__ __forceinline__ void sum8_x8(float (&a)[8]) {
    asm("s_nop 1\n\t"
        "v_add_f32_dpp %0, %0, %0 quad_perm:[1,0,3,2] row_mask:0xf bank_mask:0xf\n\tv_add_f32_dpp %1, %1, %1 quad_perm:[1,0,3,2] row_mask:0xf bank_mask:0xf\n\t"
        "v_add_f32_dpp %2, %2, %2 quad_perm:[1,0,3,2] row_mask:0xf bank_mask:0xf\n\tv_add_f32_dpp %3, %3, %3 quad_perm:[1,0,3,2] row_mask:0xf bank_mask:0xf\n\t"
        "v_add_f32_dpp %4, %4, %4 quad_perm:[1,0,3,2] row_mask:0xf bank_mask:0xf\n\tv_add_f32_dpp %5, %5, %5 quad_perm:[1,0,3,2] row_mask:0xf bank_mask:0xf\n\t"
        "v_add_f32_dpp %6, %6, %6 quad_perm:[1,0,3,2] row_mask:0xf bank_mask:0xf\n\tv_add_f32_dpp %7, %7, %7 quad_perm:[1,0,3,2] row_mask:0xf bank_mask:0xf\n\t"
        "v_add_f32_dpp %0, %0, %0 quad_perm:[2,3,0,1] row_mask:0xf bank_mask:0xf\n\tv_add_f32_dpp %1, %1, %1 quad_perm:[2,3,0,1] row_mask:0xf bank_mask:0xf\n\t"
        "v_add_f32_dpp %2, %2, %2 quad_perm:[2,3,0,1] row_mask:0xf bank_mask:0xf\n\tv_add_f32_dpp %3, %3, %3 quad_perm:[2,3,0,1] row_mask:0xf bank_mask:0xf\n\t"
        "v_add_f32_dpp %4, %4, %4 quad_perm:[2,3,0,1] row_mask:0xf bank_mask:0xf\n\tv_add_f32_dpp %5, %5, %5 quad_perm:[2,3,0,1] row_mask:0xf bank_mask:0xf\n\t"
        "v_add_f32_dpp %6, %6, %6 quad_perm:[2,3,0,1] row_mask:0xf bank_mask:0xf\n\tv_add_f32_dpp %7, %7, %7 quad_perm:[2,3,0,1] row_mask:0xf bank_mask:0xf\n\t"
        "v_add_f32_dpp %0, %0, %0 row_half_mirror row_mask:0xf bank_mask:0xf\n\tv_add_f32_dpp %1, %1, %1 row_half_mirror row_mask:0xf bank_mask:0xf\n\t"
        "v_add_f32_dpp %2, %2, %2 row_half_mirror row_mask:0xf bank_mask:0xf\n\tv_add_f32_dpp %3, %3, %3 row_half_mirror row_mask:0xf bank_mask:0xf\n\t"
        "v_add_f32_dpp %4, %4, %4 row_half_mirror row_mask:0xf bank_mask:0xf\n\tv_add_f32_dpp %5, %5, %5 row_half_mirror row_mask:0xf bank_mask:0xf\n\t"
        "v_add_f32_dpp %6, %6, %6 row_half_mirror row_mask:0xf bank_mask:0xf\n\tv_add_f32_dpp %7, %7, %7 row_half_mirror row_mask:0xf bank_mask:0xf\n\t"
        "s_nop 1"
        : "+v"(a[0]), "+v"(a[1]), "+v"(a[2]), "+v"(a[3]), "+v"(a[4]), "+v"(a[5]), "+v"(a[6]), "+v"(a[7]));
}
__device__ __forceinline__ void sum8i_x8(int (&a)[8]) {
    asm("s_nop 1\n\t"
        "v_add_u32_dpp %0, %0, %0 quad_perm:[1,0,3,2] row_mask:0xf bank_mask:0xf\n\tv_add_u32_dpp %1, %1, %1 quad_perm:[1,0,3,2] row_mask:0xf bank_mask:0xf\n\t"
        "v_add_u32_dpp %2, %2, %2 quad_perm:[1,0,3,2] row_mask:0xf bank_mask:0xf\n\tv_add_u32_dpp %3, %3, %3 quad_perm:[1,0,3,2] row_mask:0xf bank_mask:0xf\n\t"
        "v_add_u32_dpp %4, %4, %4 quad_perm:[1,0,3,2] row_mask:0xf bank_mask:0xf\n\tv_add_u32_dpp %5, %5, %5 quad_perm:[1,0,3,2] row_mask:0xf bank_mask:0xf\n\t"
        "v_add_u32_dpp %6, %6, %6 quad_perm:[1,0,3,2] row_mask:0xf bank_mask:0xf\n\tv_add_u32_dpp %7, %7, %7 quad_perm:[1,0,3,2] row_mask:0xf bank_mask:0xf\n\t"
        "v_add_u32_dpp %0, %0, %0 quad_perm:[2,3,0,1] row_mask:0xf bank_mask:0xf\n\tv_add_u32_dpp %1, %1, %1 quad_perm:[2,3,0,1] row_mask:0xf bank_mask:0xf\n\t"
        "v_add_u32_dpp %2, %2, %2 quad_perm:[2,3,0,1] row_mask:0xf bank_mask:0xf\n\tv_add_u32_dpp %3, %3, %3 quad_perm:[2,3,0,1] row_mask:0xf bank_mask:0xf\n\t"
        "v_add_u32_dpp %4, %4, %4 quad_perm:[2,3,0,1] row_mask:0xf bank_mask:0xf\n\tv_add_u32_dpp %5, %5, %5 quad_perm:[2,3,0,1] row_mask:0xf bank_mask:0xf\n\t"
        "v_add_u32_dpp %6, %6, %6 quad_perm:[2,3,0,1] row_mask:0xf bank_mask:0xf\n\tv_add_u32_dpp %7, %7, %7 quad_perm:[2,3,0,1] row_mask:0xf bank_mask:0xf\n\t"
        "v_add_u32_dpp %0, %0, %0 row_half_mirror row_mask:0xf bank_mask:0xf\n\tv_add_u32_dpp %1, %1, %1 row_half_mirror row_mask:0xf bank_mask:0xf\n\t"
        "v_add_u32_dpp %2, %2, %2 row_half_mirror row_mask:0xf bank_mask:0xf\n\tv_add_u32_dpp %3, %3, %3 row_half_mirror row_mask:0xf bank_mask:0xf\n\t"
        "v_add_u32_dpp %4, %4, %4 row_half_mirror row_mask:0xf bank_mask:0xf\n\tv_add_u32_dpp %5, %5, %5 row_half_mirror row_mask:0xf bank_mask:0xf\n\t"
        "v_add_u32_dpp %6, %6, %6 row_half_mirror row_mask:0xf bank_mask:0xf\n\tv_add_u32_dpp %7, %7, %7 row_half_mirror row_mask:0xf bank_mask:0xf\n\t"
        "s_nop 1"
        : "+v"(a[0]), "+v"(a[1]), "+v"(a[2]), "+v"(a[3]), "+v"(a[4]), "+v"(a[5]), "+v"(a[6]), "+v"(a[7]));
}
__device__ __forceinline__ float max8_x1(float v) {
    asm("s_nop 1\n\tv_max_f32_dpp %0, %0, %0 quad_perm:[1,0,3,2] row_mask:0xf bank_mask:0xf\n\ts_nop 1\n\tv_max_f32_dpp %0, %0, %0 quad_perm:[2,3,0,1] row_mask:0xf bank_mask:0xf\n\ts_nop 1\n\t"
        "v_max_f32_dpp %0, %0, %0 row_half_mirror row_mask:0xf bank_mask:0xf\n\ts_nop 1" : "+v"(v));
    return v;
}
__device__ __forceinline__ float sum8_x1(float v) {
    asm("s_nop 1\n\tv_add_f32_dpp %0, %0, %0 quad_perm:[1,0,3,2] row_mask:0xf bank_mask:0xf\n\ts_nop 1\n\tv_add_f32_dpp %0, %0, %0 quad_perm:[2,3,0,1] row_mask:0xf bank_mask:0xf\n\ts_nop 1\n\t"
        "v_add_f32_dpp %0, %0, %0 row_half_mirror row_mask:0xf bank_mask:0xf\n\ts_nop 1" : "+v"(v));
    return v;
}
__device__ __forceinline__ void peer_phase(const Args& A, Frame& F, int L, const bool dry, const bf16* Hin, bf16* Hout, unsigned char* H8) {
    int lane = F.lane; asm volatile("" : "+v"(lane));
    const int gw = F.vcu * NWAVES + F.wave;
    const bf16* SCR = (const bf16*)(A.ws + WS_SC); const bf16* X = Hin; float* RS3 = (float*)(A.ws + WS_RS3);
    const unsigned char* TU = (const unsigned char*)(A.ws + WS_TABU) + (size_t)L * 16384 * D; const unsigned char* TV = (const unsigned char*)(A.ws + WS_TABV) + (size_t)L * 16384 * D;
    const float* SUL = (const float*)(A.ws + WS_SU) + (size_t)L * 16384; const float* SVL = SUL + 32768;
    const float* rowss = (const float*)(A.ws + WS_RSP) + (size_t)(L == 0 ? RS_FFN0 : RS_FFN1) * T * 32;
    LAS unsigned* LIST = (LAS unsigned*)(F.lds + RING_OFF + F.wave * 16384);
    LAS unsigned* EIDX = LIST + 1024;
    LAS float* ECOEF = (LAS float*)(EIDX + 1024);
    const int tbase = gw * 8;
    if (tbase >= T) return;
    for (int half = 0; half < 2; ++half) {
        const int t0 = tbase + 4 * half;
        {
            const bf16* sp = SCR + (size_t)(t0 + (lane >> 4)) * D + (lane & 15) * 128;
            int vals[16];
#pragma unroll
            for (int s = 0; s < 16; ++s) vals[s] = (int)0x80000000;
#pragma unroll 2
            for (int c = 0; c < 16; ++c) { const v4u wv = *(const GAS v4u*)(sp + c * 8); const unsigned ww[4] = {wv.x, wv.y, wv.z, wv.w};
#pragma unroll
                for (int e = 0; e < 8; ++e) { const unsigned bits = (e & 1) ? (ww[e >> 1] & 0xffff0000u) : (ww[e >> 1] << 16);
                    int x = (int)bits; x ^= (x >> 31) & 0x7fffffff; x = (x & ~0x7f) | (127 - (c * 8 + e));
                    TOPK_INSERT(vals, x); } }
#pragma unroll
            for (int q = 0; q < 4; ++q) { v4u o; o.x = (unsigned)vals[4 * q]; o.y = (unsigned)vals[4 * q + 1]; o.z = (unsigned)vals[4 * q + 2]; o.w = (unsigned)vals[4 * q + 3]; *(LAS v4u*)(LIST + lane * 16 + 4 * q) = o; }
        }
        LDS_WAIT(); asm volatile("" ::: "memory");
        if (lane < 32) {
            const LAS unsigned* la = LIST + ((lane >> 3) * 16 + (lane & 7) * 2) * 16; const LAS unsigned* lb2 = la + 16;
            float av[16], bv[16];
#pragma unroll
            for (int q = 0; q < 4; ++q) { const v4u a4 = *(const LAS v4u*)(la + 4 * q), b4 = *(const LAS v4u*)(lb2 + 4 * q); const unsigned aw[4] = {a4.x, a4.y, a4.z, a4.w}, bw[4] = {b4.x, b4.y, b4.z, b4.w};
#pragma unroll
                for (int e = 0; e < 4; ++e) { av[4 * q + e] = __uint_as_float(__float_as_uint(sort2f((int)(aw[e] & ~0x7fu))) & 0xffff0000u); bv[4 * q + e] = __uint_as_float(__float_as_uint(sort2f((int)(bw[e] & ~0x7fu))) & 0xffff0000u); } }
            int best[16];
#pragma unroll
            for (int s = 0; s < 16; ++s) best[s] = (int)0x80000000;
#pragma unroll
            for (int i = 0; i < 16; ++i)
#pragma unroll
                for (int jx = 0; jx < 16; ++jx) if ((i + 1) * (jx + 1) <= 16) { int x = f2sort(av[i] + bv[jx]); x = (x & ~0xff) | (255 - (i * 16 + jx)); TOPK_INSERT(best, x); }
            float sv[16]; unsigned ex[16];
#pragma unroll
            for (int s = 0; s < 16; ++s) { const int cand = 255 - (best[s] & 0xff); const unsigned ka = la[cand >> 4], kb = lb2[cand & 15];
                ex[s] = (127u - (ka & 0x7fu)) * 128u + (127u - (kb & 0x7fu));
                sv[s] = __uint_as_float(__float_as_uint(sort2f((int)(ka & ~0x7fu))) & 0xffff0000u) + __uint_as_float(__float_as_uint(sort2f((int)(kb & ~0x7fu))) & 0xffff0000u); }
            float mx = sv[0];
#pragma unroll
            for (int s = 1; s < 16; ++s) mx = fmaxf(mx, sv[s]);
            float den = 0.f;
#pragma unroll
            for (int s = 0; s < 16; ++s) { sv[s] = __expf(sv[s] - mx); den += sv[s]; }
            const float inv = 1.0f / den; const int base = (4 * half + (lane >> 3)) * 128 + (lane & 7) * 16;
#pragma unroll
            for (int s = 0; s < 16; ++s) { EIDX[base + s] = ex[s]; ECOEF[base + s] = sv[s] * inv; }
        }
        LDS_WAIT(); asm volatile("" ::: "memory");
    }
    const int tk = lane >> 3, part = lane & 7, t = tbase + tk;
    const LAS unsigned* eidx = EIDX + tk * 128; LAS float* ecoef = ECOEF + tk * 128;
    const float rs = __builtin_amdgcn_rsqf(sum8_x1(((const GAS f32x4*)(rowss + (size_t)t * 32))[part][0] + ((const GAS f32x4*)(rowss + (size_t)t * 32))[part][1] + ((const GAS f32x4*)(rowss + (size_t)t * 32))[part][2] + ((const GAS f32x4*)(rowss + (size_t)t * 32))[part][3]) * (1.0f / D) + EPS);
    typedef _Float16 h2_t __attribute__((ext_vector_type(2)));
#if PEER_ALIAS
    const unsigned amask = dry ? 1023u : 0xffffffffu;
#else
    constexpr unsigned amask = 0xffffffffu;
#endif
#define PEER_LOAD8(dst, TAB, i0, soff) do { const v4u ia_ = *(const LAS v4u*)(eidx + (i0)), ib_ = *(const LAS v4u*)(eidx + (i0) + 4); const unsigned ee_[8] = {ia_.x, ia_.y, ia_.z, ia_.w, ib_.x, ib_.y, ib_.z, ib_.w}; \
        _Pragma("unroll") for (int j_ = 0; j_ < 8; ++j_) dst[j_] = *(const GAS v4u*)((TAB) + (size_t)((ee_[j_] & amask) * 2048u + (unsigned)(soff))); } while (0)
    LAS float* dotw = (LAS float*)LIST + tk * 128;
#pragma unroll
    for (int m = 0; m < 16; ++m) dotw[8 * m + part] = 0.f;
#pragma unroll 1
    for (int p = 0; p < 16; ++p) {
        const int soff = 128 * p + 16 * part;
        unsigned xq[4]; float sxs;
        { const v4u x0 = *(const GAS v4u*)(X + (size_t)t * D + soff), x1 = *(const GAS v4u*)(X + (size_t)t * D + soff + 8); const unsigned xw[8] = {x0.x, x0.y, x0.z, x0.w, x1.x, x1.y, x1.z, x1.w};
          float xv[16], am = 0.f;
#pragma unroll
          for (int e = 0; e < 8; ++e) { xv[2 * e] = bf_lo(xw[e]); xv[2 * e + 1] = bf_hi(xw[e]); am = fmaxf(am, fmaxf(fabsf(xv[2 * e]), fabsf(xv[2 * e + 1]))); }
          am = max8_x1(am); sxs = am * (1.0f / 127.0f); const float inv = am > 0.f ? 127.0f / am : 0.f;
#pragma unroll
          for (int q = 0; q < 4; ++q) { unsigned w = 0;
#pragma unroll
              for (int e = 0; e < 4; ++e) w |= (__float_as_uint(__builtin_fmaf(xv[4 * q + e], inv, 12582912.0f)) & 255u) << (8 * e);
              xq[q] = w; } }
#define PEER_UDOT8(src, m_) do { int tt_[8]; \
        _Pragma("unroll") for (int j_ = 0; j_ < 8; ++j_) { int a_ = __builtin_amdgcn_sdot4((int)src[j_].x, (int)xq[0], 0, false); a_ = __builtin_amdgcn_sdot4((int)src[j_].y, (int)xq[1], a_, false); \
            a_ = __builtin_amdgcn_sdot4((int)src[j_].z, (int)xq[2], a_, false); tt_[j_] = __builtin_amdgcn_sdot4((int)src[j_].w, (int)xq[3], a_, false); } \
        sum8i_x8(tt_); \
        int sel_ = tt_[0]; _Pragma("unroll") for (int j_ = 1; j_ < 8; ++j_) sel_ = (part == j_) ? tt_[j_] : sel_; \
        dotw[8 * (m_) + part] += (float)sel_ * sxs; } while (0)
        v4u ua[8], ub[8];
        PEER_LOAD8(ua, TU, 0, soff);
#pragma unroll 1
        for (int m = 0; m < 16; m += 2) {
            PEER_LOAD8(ub, TU, 8 * (m + 1), soff);
            PEER_UDOT8(ua, m);
            if (m + 2 < 16) PEER_LOAD8(ua, TU, 8 * (m + 2), soff);
            PEER_UDOT8(ub, m + 1);
        }
    }
#undef PEER_UDOT8
    LAS unsigned char* ecq = (LAS unsigned char*)(LIST + 3072) + tk * 128;
    float sc;
    { float cf[16], cm = 0.f;
#pragma unroll
      for (int m = 0; m < 16; ++m) { const unsigned e_ = eidx[8 * m + part]; const float d_ = dotw[8 * m + part] * rs * SUL[e_]; const float act = 0.5f * d_ * (1.0f + erff(d_ * 0.7071067811865476f));
          cf[m] = ecoef[8 * m + part] * act * SVL[e_]; cm = fmaxf(cm, fabsf(cf[m])); }
      cm = max8_x1(cm); sc = cm * (1.0f / 127.0f); const float inv = cm > 0.f ? 127.0f / cm : 0.f;
#pragma unroll
      for (int m = 0; m < 16; ++m) ecq[8 * m + part] = (unsigned char)(__float_as_uint(__builtin_fmaf(cf[m], inv, 12582912.0f)) & 255u); }
    LDS_WAIT(); asm volatile("" ::: "memory");
    float ss = 0.f;
#pragma unroll 1
    for (int p = 0; p < 16; ++p) {
        const int soff = 128 * p + 16 * part;
        int acc[16];
#pragma unroll
        for (int i = 0; i < 16; ++i) acc[i] = 0;
#define PEER_VACC8(src, i0) do { const u32x2 c8_ = *(const LAS u32x2*)(ecq + (i0)); \
        _Pragma("unroll") for (int h_ = 0; h_ < 2; ++h_) { const int cq_ = (int)(h_ ? c8_.y : c8_.x); \
            _Pragma("unroll") for (int q_ = 0; q_ < 4; ++q_) { \
                const unsigned a_ = q_ == 0 ? src[4 * h_].x : q_ == 1 ? src[4 * h_].y : q_ == 2 ? src[4 * h_].z : src[4 * h_].w, b_ = q_ == 0 ? src[4 * h_ + 1].x : q_ == 1 ? src[4 * h_ + 1].y : q_ == 2 ? src[4 * h_ + 1].z : src[4 * h_ + 1].w; \
                const unsigned c_ = q_ == 0 ? src[4 * h_ + 2].x : q_ == 1 ? src[4 * h_ + 2].y : q_ == 2 ? src[4 * h_ + 2].z : src[4 * h_ + 2].w, d_ = q_ == 0 ? src[4 * h_ + 3].x : q_ == 1 ? src[4 * h_ + 3].y : q_ == 2 ? src[4 * h_ + 3].z : src[4 * h_ + 3].w; \
                const unsigned lab_ = __builtin_amdgcn_perm(b_, a_, 0x05010400u), hab_ = __builtin_amdgcn_perm(b_, a_, 0x07030602u), lcd_ = __builtin_amdgcn_perm(d_, c_, 0x05010400u), hcd_ = __builtin_amdgcn_perm(d_, c_, 0x07030602u); \
                acc[4 * q_ + 0] = __builtin_amdgcn_sdot4((int)__builtin_amdgcn_perm(lcd_, lab_, 0x05040100u), cq_, acc[4 * q_ + 0], false); \
                acc[4 * q_ + 1] = __builtin_amdgcn_sdot4((int)__builtin_amdgcn_perm(lcd_, lab_, 0x07060302u), cq_, acc[4 * q_ + 1], false); \
                acc[4 * q_ + 2] = __builtin_amdgcn_sdot4((int)__builtin_amdgcn_perm(hcd_, hab_, 0x05040100u), cq_, acc[4 * q_ + 2], false); \
                acc[4 * q_ + 3] = __builtin_amdgcn_sdot4((int)__builtin_amdgcn_perm(hcd_, hab_, 0x07060302u), cq_, acc[4 * q_ + 3], false); } } } while (0)
        v4u va[8], vb[8];
        PEER_LOAD8(va, TV, 0, soff);
#pragma unroll 1
        for (int m = 0; m < 16; m += 2) {
            PEER_LOAD8(vb, TV, 8 * (m + 1), soff);
            PEER_VACC8(va, 8 * m);
            if (m + 2 < 16) PEER_LOAD8(va, TV, 8 * (m + 2), soff);
            PEER_VACC8(vb, 8 * (m + 1));
        }
        { const v4u h0 = *(const GAS v4u*)(Hin + (size_t)t * D + soff), h1 = *(const GAS v4u*)(Hin + (size_t)t * D + soff + 8); const unsigned hw[8] = {h0.x, h0.y, h0.z, h0.w, h1.x, h1.y, h1.z, h1.w}; unsigned ow[8];
#pragma unroll
          for (int e = 0; e < 8; ++e) { ow[e] = hw_pk2(bf_lo(hw[e]) + (float)acc[2 * e] * sc, bf_hi(hw[e]) + (float)acc[2 * e + 1] * sc); const float q0 = bf_lo(ow[e]), q1 = bf_hi(ow[e]); ss += q0 * q0 + q1 * q1; }
          v4u o0, o1; o0.x = ow[0]; o0.y = ow[1]; o0.z = ow[2]; o0.w = ow[3]; o1.x = ow[4]; o1.y = ow[5]; o1.z = ow[6]; o1.w = ow[7];
          if (!dry) { *(GAS v4u*)(Hout + (size_t)t * D + soff) = o0; *(GAS v4u*)(Hout + (size_t)t * D + soff + 8) = o1;
            if (H8) { v4u o8; unsigned q8[4];
#pragma unroll
              for (int e = 0; e < 4; ++e) { int x8 = __builtin_amdgcn_cvt_pk_fp8_f32(bf_lo(ow[2 * e]), bf_hi(ow[2 * e]), 0, false); x8 = __builtin_amdgcn_cvt_pk_fp8_f32(bf_lo(ow[2 * e + 1]), bf_hi(ow[2 * e + 1]), x8, true); q8[e] = (unsigned)x8; }
              o8.x = q8[0]; o8.y = q8[1]; o8.z = q8[2]; o8.w = q8[3]; *(GAS v4u*)(H8 + (size_t)t * D + soff) = o8; } } else asm volatile("" :: "v"(o0.x), "v"(o0.y), "v"(o0.z), "v"(o0.w), "v"(o1.x), "v"(o1.y), "v"(o1.z), "v"(o1.w)); }
    }
#undef PEER_VACC8
#undef PEER_LOAD8
    const float r3 = __builtin_amdgcn_rsqf(sum8_x1(ss) * (1.0f / D) + EPS);
    if (!dry && part == 0) RS3[t] = r3;
}


constexpr int N_PHASES = 19;
__global__ void __launch_bounds__(NTHREADS, 2) mega_fwd(Args args) {

    extern __shared__ __attribute__((aligned(16))) unsigned char lds[];
    Frame F;
    F.lds = (LAS unsigned char*)lds;
    F.MISC = (volatile LAS unsigned*)(F.lds + MISC_OFF);
    F.tid = threadIdx.x; F.lane = F.tid & 63; F.wave = __builtin_amdgcn_readfirstlane(F.tid >> 6);
    F.G = gridDim.x; { const int bx = blockIdx.x; F.vcu = (F.G % 8 == 0) ? (bx % 8) * (F.G / 8) + bx / 8 : bx; }
    unsigned char* ws = args.ws;
    F.ctl = (gu32*)(ws + WS_CTL);
    for (int u = F.tid; u < (LDS_BYTES - LDSCTL_OFF) / 4; u += NTHREADS) ((LAS unsigned*)(F.lds + LDSCTL_OFF))[u] = 0u;
    __syncthreads();
    const int lo = args.ph_lo, hi = args.ph_hi;
    XcdBarrier bar; bar.bar = (unsigned*)(F.ctl + CW_BAR); bar.x = 0; bar.st = nullptr;
    if (hi - lo > 1) bar = xcd_barrier_post((unsigned*)(F.ctl + CW_BAR), F.MISC + 8);
    bar.wave0 = (F.wave == 0);
#define IN(k) (lo <= (k) && (k) < hi)
#define REFRESH() do { int t_; asm volatile("v_mbcnt_lo_u32_b32 %0, -1, 0\n\tv_mbcnt_hi_u32_b32 %0, -1, %0" : "=v"(t_)); F.lane = t_; F.tid = F.wave * 64 + t_; } while (0)
#define REPS(k) (1 + ((DUP_MASK >> (k)) & 1))
#if PROBE_MASK
    unsigned long long* const tsb = (unsigned long long*)(ws + WS_CTL + 65536);
#define STAMP(k) do { if (blockIdx.x == 0 && F.tid == 0) __hip_atomic_store(tsb + (k), __builtin_amdgcn_s_memrealtime(), __ATOMIC_RELAXED, __HIP_MEMORY_SCOPE_AGENT); } while (0)
    STAMP(31);
#else
#define STAMP(k) do { } while (0)
#endif
#define DEFERRED_QUEUE(fn, ctrword) do { constexpr unsigned NQ_ = 768u; for (;;) { if (F.tid == 0) F.MISC[0] = __hip_atomic_fetch_add(F.ctl + (ctrword), 1u, __ATOMIC_RELAXED, __HIP_MEMORY_SCOPE_AGENT); \
        __syncthreads(); const unsigned v_ = F.MISC[0]; __syncthreads(); if (v_ >= NQ_) break; fn(args, F, (int)v_, (int)NQ_); } } while (0)
#define SEAM(k) do { if (IN(k) && IN((k) + 1)) { if ((k) == 0) { if (gridDim.x == 123457u) cg::this_grid().sync(); xcd_barrier(bar); }      else { xcd_barrier(bar); if ((DUP_MASK >> 24) & 1) xcd_barrier(bar); } STAMP(k); } } while (0)
    float* rowss = (float*)(ws + WS_RSP);
    bf16* ACTA = (bf16*)(ws + WS_ACTA); bf16* ACTB = (bf16*)(ws + WS_ACTB); bf16* H1 = (bf16*)(ws + WS_H1); const float* RS3 = (const float*)(ws + WS_RS3);
    bf16* PROJ = (bf16*)(ws + WS_PROJ); bf16* SCB = (bf16*)(ws + WS_SC); bf16* PP = (bf16*)(ws + WS_PP);
    const int gtid = (F.vcu * NWAVES + F.wave) * 64 + F.lane, gthreads = F.G * NTHREADS;

#if UBENCH
    {
        typedef _Float16 h2_t __attribute__((ext_vector_type(2)));
        float a[32]; f32x2 p[16]; h2_t hh[32];
#pragma unroll
        for (int i = 0; i < 32; ++i) { a[i] = (float)(F.tid + i); hh[i] = (h2_t){(_Float16)(F.lane + i), (_Float16)i}; }
#pragma unroll
        for (int i = 0; i < 16; ++i) p[i] = (f32x2){a[2 * i], a[2 * i + 1]};
        const float m = 1.0f + 1e-7f * F.lane, c = 1e-9f; const f32x2 m2 = {m, m}, c2 = {c, c}; const h2_t mh = {(_Float16)1.0f, (_Float16)1.0f}, ch = {(_Float16)0.0f, (_Float16)0.0f};
#pragma unroll 1
        for (int it = 0; it < 10000; ++it) {
#if UBENCH == 1
#pragma unroll
            for (int i = 0; i < 32; ++i) asm volatile("v_fma_f32 %0, %0, %1, %2" : "+v"(a[i]) : "v"(m), "v"(c));
#elif UBENCH == 2
#pragma unroll
            for (int i = 0; i < 16; ++i) asm volatile("v_pk_fma_f32 %0, %0, %1, %2\n\tv_pk_fma_f32 %0, %0, %1, %2" : "+v"(p[i]) : "v"(m2), "v"(c2));
#elif UBENCH == 3
#pragma unroll
            for (int i = 0; i < 32; ++i) asm volatile("v_pk_fma_f16 %0, %0, %1, %2" : "+v"(hh[i]) : "v"(mh), "v"(ch));
#endif
        }
        float s = 0.f;
#pragma unroll
        for (int i = 0; i < 32; ++i) s += a[i] + (float)hh[i][0];
#pragma unroll
        for (int i = 0; i < 16; ++i) s += p[i][0] + p[i][1];
        if (s == 12345.678f) args.out[0] = s;
    }
#endif
    if (IN(0)) { REFRESH(); p0_prologue(args, F, 0); if (hi - lo > 1) { xcd_barrier(bar); REFRESH(); p0_prologue(args, F, 1); } } SEAM(0);
    if (IN(1)) for (int rep_ = 0; rep_ < REPS(1); ++rep_) { REFRESH();
#if EV_F8_T1 > EV_F8_T0
        if (EV_F8_T0 > 0) { constexpr int n_ = EV_F8_T0 * 256; pg8::Gemm g{ACTA, (const bf16*)(ws + WS_WEV_IN), T, n_, D}; pg8::StaticOrder S; S.init(T, n_, F.G, (int)blockIdx.x); EpiBf16S E{PROJ, PROJ_LD, nullptr};
          pg8::gemm_phase<EpiBf16S, pg8::StaticOrder, true, true>(F.lds + RING_OFF, g, S, E, F.wave); }
        { constexpr int n_ = (EV_F8_T1 - EV_F8_T0) * 256; pg8::Gemm g{(const bf16*)(ws + WS_H1), (const bf16*)(ws + WS_O + (size_t)EV_F8_T0 * 256 * D), T, n_, D / 2}; pg8::StaticOrder S; S.init(T, n_, F.G, (int)blockIdx.x); EpiBf16S E{PROJ + EV_F8_T0 * 256, PROJ_LD, nullptr};
          pg8::gemm_phase<EpiBf16S, pg8::StaticOrder, true, true, true>(F.lds + RING_OFF, g, S, E, F.wave); }
        if (EV_F8_T1 < EV_NP / 256) { constexpr int n_ = EV_NP - EV_F8_T1 * 256; pg8::Gemm g{ACTA, (const bf16*)(ws + WS_WEV_IN) + (size_t)EV_F8_T1 * 256 * D, T, n_, D}; pg8::StaticOrder S; S.init(T, n_, F.G, (int)blockIdx.x); EpiBf16S E{PROJ + EV_F8_T1 * 256, PROJ_LD, nullptr};
          pg8::gemm_phase<EpiBf16S, pg8::StaticOrder, true, true>(F.lds + RING_OFF, g, S, E, F.wave); }
        if (true) { const int g2 = F.G, c2 = (int)blockIdx.x;
#else
        { pg8::Gemm g{ACTA, (const bf16*)(ws + WS_WEV_IN), T, EV_NP, D / 2}; pg8::StaticOrder S; S.init(T, EV_NP, F.G, (int)blockIdx.x); EpiI8S E{PROJ, PROJ_LD, (const float*)(ws + WS_SA), (const float*)(ws + WS_CMB)};
          pg8::gemm_phase<EpiI8S, pg8::StaticOrder, true, true, false, true>(F.lds + RING_OFF, g, S, E, F.wave); }
        if (F.G < 256) { const int g2 = F.G, c2 = (int)blockIdx.x;
#endif
          pg8::Gemm g{(const bf16*)(ws + WS_PBF), (const bf16*)(ws + WS_WPROJ), T, D, 256}; pg8::StaticOrder S; S.init(T, D, g2, c2); EpiBf16S E{PP, D, nullptr};
          pg8::gemm_phase<EpiBf16S, pg8::StaticOrder, true, true>(F.lds + RING_OFF, g, S, E, F.wave); }
    } SEAM(1);
    if (IN(2)) for (int rep_ = 0; rep_ < REPS(2); ++rep_) { REFRESH();
        if (F.G >= 256) {
            const int u = F.vcu;
            if (u < 64) scan_gla_mfma_unit<0>(args, F, u); else if (u < 128) scan_gdn_mfma_unit(args, F, u - 64, 0); else if (u < 192) scan_gdn_mfma_unit(args, F, u - 128, 1);
            __syncthreads();
            if (rep_ == 0 && u >= 64 && u < 128) {
                const int c = u - 64; bf16* pb = (bf16*)(ws + WS_PBF);
                cvt_f32_bf16(args.in[I_P] + (size_t)c * 65536, pb + (size_t)c * 65536, 65536, F.tid, NTHREADS);
                asm volatile("s_waitcnt vmcnt(0)" ::: "memory"); __syncthreads();
                pg8::Gemm g{pb, (const bf16*)(ws + WS_WPROJ), T, D, 256}; pg8::RowBlockOrder S{c, D / 256}; EpiBf16S E{PP, D, nullptr};
                pg8::gemm_phase<EpiBf16S, pg8::RowBlockOrder, true, true>(F.lds + RING_OFF, g, S, E, F.wave); }
            if (rep_ == 0) DEFERRED_QUEUE(p0_deferred, 1024);
        } else {
            for (int u = F.vcu; u < 64; u += F.G) { scan_gla_mfma_unit<0>(args, F, u); __syncthreads(); }
            for (int u = F.vcu; u < 64; u += F.G) { scan_gdn_mfma_unit(args, F, u, 0); __syncthreads(); scan_gdn_mfma_unit(args, F, u, 1); __syncthreads(); }
            if (rep_ == 0) p0_deferred(args, F, F.vcu, F.G);
        }
    } SEAM(2);
    if (IN(3)) for (int rep_ = 0; rep_ < REPS(3); ++rep_) { REFRESH(); post_rows<0>(args, F); } SEAM(3);
    if (IN(4)) { REFRESH(); pg8::Gemm g{ACTA, (const bf16*)(ws + WS_WEV_OUT), T, D, D}; pg8::StaticOrder S; S.init(T, D, F.G, (int)blockIdx.x);
        EpiResid<false, true> E{args.in[I_X], ACTB, rowss + (size_t)RS_FFN0 * T * 32, nullptr, nullptr, nullptr, nullptr, nullptr};
        pg8::gemm_phase<EpiResid<false, true>, pg8::StaticOrder, true, true>(F.lds + RING_OFF, g, S, E, F.wave); }
#if (DUP_MASK >> 20) & 1
    if (IN(4)) { REFRESH(); pg8::Gemm g{ACTA, (const bf16*)(ws + WS_WEV_OUT), T, D, D}; pg8::StaticOrder S; S.init(T, D, F.G, (int)blockIdx.x);
        EpiResid<false, true> E{args.in[I_X], ACTB, rowss + (size_t)RS_FFN0 * T * 32, nullptr, nullptr, nullptr};
        pg8::gemm_phase<EpiResid<false, true>, pg8::StaticOrder, true, true>(F.lds + RING_OFF, g, S, E, F.wave); }
#endif
#if (DUP_MASK >> 21) & 1
    if (IN(4)) { REFRESH(); pg8::Gemm g{ACTA, (const bf16*)(ws + WS_WEV_IN), T, EV_NP, D}; pg8::StaticOrder S; S.init(T, EV_NP, F.G, (int)blockIdx.x); EpiBf16S E{PROJ, PROJ_LD, nullptr};
        pg8::gemm_phase<EpiBf16S, pg8::StaticOrder, true, true>(F.lds + RING_OFF, g, S, E, F.wave); }
#endif
    SEAM(4);
    if (IN(5)) for (int rep_ = 0; rep_ < REPS(5); ++rep_) { REFRESH(); { pg8::Gemm g{ACTB, (const bf16*)(ws + WS_WPEER), T, D, D}; pg8::StaticOrder S; S.init(T, D, F.G, (int)blockIdx.x); EpiBf16S E{SCB, D, rowss + (size_t)RS_FFN0 * T * 32};
        pg8::gemm_phase<EpiBf16S, pg8::StaticOrder, true, true>(F.lds + RING_OFF, g, S, E, F.wave); }
        } SEAM(5);
    if (IN(6)) for (int rep_ = 0; rep_ < REPS(6); ++rep_) { REFRESH(); peer_phase(args, F, 0, rep_ != 0, ACTB, H1, (unsigned char*)ACTA); } SEAM(6);
    if (IN(7)) { REFRESH(); { pg8::Gemm g{ACTA, (const bf16*)(ws + WS_WGATE), T, D, D / 2}; pg8::StaticOrder S; S.init(T, D, F.G, (int)blockIdx.x);
        EpiResid<true, false> E{H1, ACTB, rowss + (size_t)RS_MIX1 * T * 32, PP, RS3, (unsigned char*)ACTA + (size_t)T * D};
        pg8::gemm_phase<EpiResid<true, false>, pg8::StaticOrder, true, true, true>(F.lds + RING_OFF, g, S, E, F.wave); }
        } SEAM(7);
    if (IN(8)) for (int rep_ = 0; rep_ < REPS(8); ++rep_) { REFRESH();
        { pg8::Gemm g{(const bf16*)((const unsigned char*)ACTA + (size_t)T * D), (const bf16*)(ws + WS_WOD_IN), T, OD_NP, D / 2}; pg8::StaticOrder S; S.init(T, OD_NP, F.G, (int)blockIdx.x); EpiBf16S E{PROJ, PROJ_LD, rowss + (size_t)RS_MIX1 * T * 32};
          pg8::gemm_phase<EpiBf16S, pg8::StaticOrder, true, true, true>(F.lds + RING_OFF, g, S, E, F.wave); }
        if (F.G < 256) { pg8::Gemm g{(const bf16*)(ws + WS_PBF) + (size_t)T * 256, (const bf16*)(ws + WS_WPROJ) + (size_t)D * 256, T, D, 256}; pg8::StaticOrder S; S.init(T, D, F.G, (int)blockIdx.x); EpiBf16S E{PP, D, nullptr};
          pg8::gemm_phase<EpiBf16S, pg8::StaticOrder, true, true>(F.lds + RING_OFF, g, S, E, F.wave); }
    } SEAM(8);
    if (IN(9)) for (int rep_ = 0; rep_ < REPS(9); ++rep_) { REFRESH(); lora_prep_rows(args, F); } SEAM(9);
    if (IN(10)) for (int rep_ = 0; rep_ < REPS(10); ++rep_) { REFRESH();
        { pg8::Gemm g{(const bf16*)(ws + WS_LA), (const bf16*)(ws + WS_WLORA), T, 1024, LORA_K, 128}; pg8::StaticOrder S; S.init(T, 1024, F.G, (int)blockIdx.x); EpiBf16S E{(bf16*)(ws + WS_LO), LORA_N, nullptr};
          pg8::gemm_phase<EpiBf16S, pg8::StaticOrder, true, true>(F.lds + RING_OFF, g, S, E, F.wave); }
        { pg8::Gemm g{(const bf16*)(ws + WS_LA) + 64, (const bf16*)(ws + WS_WLORA) + (size_t)1024 * LORA_K + 64, T, 1024, LORA_K, 128}; pg8::StaticOrder S; S.init(T, 1024, F.G, (int)blockIdx.x); EpiBf16S E{(bf16*)(ws + WS_LO) + 1024, LORA_N, nullptr};
          pg8::gemm_phase<EpiBf16S, pg8::StaticOrder, true, true>(F.lds + RING_OFF, g, S, E, F.wave); }
        { pg8::Gemm g{(const bf16*)(ws + WS_LA) + 192, (const bf16*)(ws + WS_WLORA) + (size_t)2048 * LORA_K + 192, T, 1024, LORA_K, 256}; pg8::StaticOrder S; S.init(T, 1024, F.G, (int)blockIdx.x); EpiBf16S E{(bf16*)(ws + WS_LO) + 2048, LORA_N, nullptr};
          pg8::gemm_phase<EpiBf16S, pg8::StaticOrder, true, true>(F.lds + RING_OFF, g, S, E, F.wave); }
    } SEAM(10);
    if (IN(11)) for (int rep_ = 0; rep_ < REPS(11); ++rep_) { REFRESH();
        if (F.G >= 256) {
            const int u = F.vcu;
            if (u < 64) scan_gla_mfma_unit<1>(args, F, u); else if (u < 128) scan_rwkv_mfma_unit(args, F, u - 64, 0); else if (u < 192) scan_rwkv_mfma_unit(args, F, u - 128, 1);
            __syncthreads();
            if (rep_ == 0 && u >= 64 && u < 128) {
                const int c = u - 64; bf16* pb = (bf16*)(ws + WS_PBF) + (size_t)T * 256;
                cvt_f32_bf16(args.in[I_P] + (size_t)T * 256 + (size_t)c * 65536, pb + (size_t)c * 65536, 65536, F.tid, NTHREADS);
                asm volatile("s_waitcnt vmcnt(0)" ::: "memory"); __syncthreads();
                pg8::Gemm g{pb, (const bf16*)(ws + WS_WPROJ) + (size_t)D * 256, T, D, 256}; pg8::RowBlockOrder S{c, D / 256}; EpiBf16S E{PP, D, nullptr};
                pg8::gemm_phase<EpiBf16S, pg8::RowBlockOrder, true, true>(F.lds + RING_OFF, g, S, E, F.wave); }
            if (rep_ == 0) DEFERRED_QUEUE(p1_deferred, 1025);
        } else {
            for (int u = F.vcu; u < 64; u += F.G) { scan_gla_mfma_unit<1>(args, F, u); __syncthreads(); }
            for (int u = F.vcu; u < 64; u += F.G) { scan_rwkv_mfma_unit(args, F, u, 0); __syncthreads(); scan_rwkv_mfma_unit(args, F, u, 1); __syncthreads(); }
            if (rep_ == 0) p1_deferred(args, F, F.vcu, F.G);
        }
    } SEAM(11);
    if (IN(13)) { REFRESH(); pg8::Gemm g{ACTA, (const bf16*)(ws + WS_WOD_OUT), T, D, D / 2}; pg8::StaticOrder S; S.init(T, D, F.G, (int)blockIdx.x);
        EpiResid<false, false> E{ACTB, H1, rowss + (size_t)RS_FFN1 * T * 32, nullptr, nullptr, nullptr};
        pg8::gemm_phase<EpiResid<false, false>, pg8::StaticOrder, true, true, true>(F.lds + RING_OFF, g, S, E, F.wave); } SEAM(13);
    if (IN(14)) for (int rep_ = 0; rep_ < REPS(14); ++rep_) { REFRESH(); pg8::Gemm g{H1, (const bf16*)(ws + WS_WPEER) + (size_t)D * D, T, D, D}; pg8::StaticOrder S; S.init(T, D, F.G, (int)blockIdx.x); EpiBf16S E{SCB, D, rowss + (size_t)RS_FFN1 * T * 32};
        pg8::gemm_phase<EpiBf16S, pg8::StaticOrder, true, true>(F.lds + RING_OFF, g, S, E, F.wave); } SEAM(14);
    if (IN(15)) for (int rep_ = 0; rep_ < REPS(15); ++rep_) { REFRESH(); peer_phase(args, F, 1, rep_ != 0, H1, ACTB, (unsigned char*)ACTA); } SEAM(15);
    if (IN(16)) { REFRESH(); pg8::Gemm g{ACTA, (const bf16*)(ws + WS_WGATE) + (size_t)D * D, T, D, D / 2}; pg8::StaticOrder S; S.init(T, D, F.G, (int)blockIdx.x);
        EpiResid<true, false> E{ACTB, H1, rowss + (size_t)RS_FINAL * T * 32, PP, RS3, nullptr};
        pg8::gemm_phase<EpiResid<true, false>, pg8::StaticOrder, true, true, true>(F.lds + RING_OFF, g, S, E, F.wave); } SEAM(16);
    if (IN(17)) { REFRESH();
        float oscale = 1.0f;
#if PROBE_MASK
        { unsigned long long t_prev = __hip_atomic_load(tsb + 31, __ATOMIC_RELAXED, __HIP_MEMORY_SCOPE_AGENT); const unsigned long long t_begin = t_prev; unsigned long long sel = 0ull;
          for (int k = 0; k <= 16; ++k) { const unsigned long long tk = __hip_atomic_load(tsb + k, __ATOMIC_RELAXED, __HIP_MEMORY_SCOPE_AGENT); if ((PROBE_MASK >> k) & 1) sel += tk - t_prev; t_prev = tk; }
          const float f = (float)(double(sel) / double(t_prev - t_begin)); oscale = 1.0f + sqrtf(0.01f + 0.9f * f); }
#endif
        final_rows(args, F, oscale, H1); }
#undef IN
#undef SEAM
#undef REFRESH
}

extern "C" void kernel_launch(void* const* d_in, const int* in_sizes, int n_in, void* d_out, int out_size, void* d_ws, size_t ws_size, hipStream_t stream) {
    static int grid = 0;
    if (grid == 0) {
        if (n_in != N_IN || out_size != T * D || ws_size < WS_END + 63 * MiB) { fprintf(stderr, "kernel_launch: unexpected problem: n_in %d out %d ws %zu (need %zu)\n", n_in, out_size, ws_size, (size_t)(WS_END + 63 * MiB)); grid = -1; return; }
        int dev = 0, cus = 0, per_cu = 0;
        if (hipGetDevice(&dev) != hipSuccess || hipDeviceGetAttribute(&cus, hipDeviceAttributeMultiprocessorCount, dev) != hipSuccess) { grid = -1; return; }
        if (hipFuncSetAttribute((const void*)mega_fwd, hipFuncAttributeMaxDynamicSharedMemorySize, LDS_BYTES) != hipSuccess) { fprintf(stderr, "kernel_launch: hipFuncSetAttribute failed\n"); grid = -1; return; }
        if (hipOccupancyMaxActiveBlocksPerMultiprocessor(&per_cu, (const void*)mega_fwd, NTHREADS, LDS_BYTES) != hipSuccess || per_cu < 1) { fprintf(stderr, "kernel_launch: occupancy query says %d blocks per CU\n", per_cu); (void)hipGetLastError(); grid = -1; return; }
        grid = cus;
    }
    if (grid < 0) return;
    (void)hipMemsetAsync((char*)d_ws + WS_CTL, 0, CTL_ZERO_BYTES, stream);
    Args a{};
    for (int i = 0; i < N_IN; ++i) a.in[i] = (const float*)d_in[i];
    a.out = (float*)d_out; a.ws = (unsigned char*)d_ws;
#if MK_PER_PHASE
    for (int p = 0; p < N_PHASES - 1; ++p) { a.ph_lo = p; a.ph_hi = p + 1; hipLaunchKernelGGL(mega_fwd, dim3(grid), dim3(NTHREADS), LDS_BYTES, stream, a); }
#else
    a.ph_lo = 0; a.ph_hi = N_PHASES;
    void* kargs[] = {&a};
    hipError_t e = hipLaunchCooperativeKernel((const void*)mega_fwd, dim3(grid), dim3(NTHREADS), kargs, LDS_BYTES, stream);
    if (e != hipSuccess) fprintf(stderr, "kernel_launch: cooperative launch failed: %s (grid %d)\n", hipGetErrorString(e), grid);
#endif
}
```

```cpp
#include <hip/hip_runtime.h>
#include <hip/hip_cooperative_groups.h>
#include <cstdio>
#include <cstdint>
namespace cg = cooperative_groups;

#ifndef PROBE_MASK
#define PROBE_MASK 0
#endif
#ifndef DUP_MASK
#define DUP_MASK 0
#endif
#ifndef UBENCH
#define UBENCH 0
#endif
#ifndef GDN_DUP
#define GDN_DUP 0
#endif
#ifndef MK_PER_PHASE
#ifndef PROBE_SUB
#define PROBE_SUB 0
#define PROBE_BASE 1
#define PROBE_QCTR 1024
#endif
#ifndef GDN_S1
#define GDN_S1 36
#define GDN_S2 78
#define RWKV_S1 36
#define RWKV_S2 76
#endif
#ifndef PEER_ALIAS
#define PEER_ALIAS 0
#endif
#ifndef EV_F8_T0
#define EV_F8_T0 0
#define EV_F8_T1 0
#endif
#define MK_PER_PHASE 0
#endif

namespace pg8 {
#define PG8_LAS __attribute__((address_space(3)))
typedef unsigned short bf16_t;
typedef short bf16x8 __attribute__((ext_vector_type(8)));
typedef float f32x4 __attribute__((ext_vector_type(4)));
typedef unsigned u32x4 __attribute__((ext_vector_type(4)));
typedef unsigned u32x2 __attribute__((ext_vector_type(2)));
constexpr int BM = 256, BK = 64, HALF = 128, HTB = HALF * BK * 2  , STAGE_BYTES = 8 * HTB, NXCD = 8, WGM = 8;

__host__ __device__ __forceinline__ int lds_byte(int r, int c) { const int st = (r >> 4) * 2 + (c >> 5), rr = r & 15, cc = c & 31, ob = rr * 64 + cc * 2; return st * 1024 + (ob ^ (((ob >> 9) & 1) << 5)); }
__host__ __device__ __forceinline__ void stage_rc(int b, int& R, int& C) { const int st = b / 1024, sb = b % 1024, swz = sb ^ (((sb >> 9) & 1) << 5); R = (st >> 1) * 16 + swz / 64; C = (st & 1) * 32 + (swz % 64) / 2; }
__host__ __device__ __forceinline__ int perm32(int rho) { const int n = rho >> 4, i = rho & 15; return 8 * (i >> 2) + 4 * n + (i & 3); }

struct Unit { int pm, pn; };
struct Gemm { const bf16_t* A; const bf16_t* Bt; int M, N, K; int KE = 0; };

struct StaticOrder {
    int nM, nN, nwg, G, c;
    __host__ __device__ void init(int M, int N, int G_, int c_) { nM = M / BM; nN = N / BM; nwg = nM * nN; G = G_; c = c_; }
    __host__ __device__ bool next(int i, Unit& u) const {
        const long L = (long)i * G + c; if (L >= nwg) return false;
        int wgid = (int)L; { const int q = nwg / NXCD, r = nwg % NXCD, xcd = wgid % NXCD, off = wgid / NXCD; wgid = (xcd < r ? xcd * (q + 1) : r * (q + 1) + (xcd - r) * q) + off; }
        const int nig = WGM * nN, gid = wgid / nig, fm = gid * WGM, gsz = (nM - fm) < WGM ? (nM - fm) : WGM;
        u.pm = fm + ((wgid % nig) % gsz); u.pn = (wgid % nig) / gsz; return true;
    }
    __device__ __forceinline__ void a_ready(const Unit&) const {}
    __device__ __forceinline__ void done(const Unit&) const {}
};
struct RowBlockOrder {
    int c, nN;
    __host__ __device__ bool next(int i, Unit& u) const { if (i >= nN) return false; u.pm = c; u.pn = i; return true; }
    __device__ __forceinline__ void a_ready(const Unit&) const {}
    __device__ __forceinline__ void done(const Unit&) const {}
};
__device__ __forceinline__ unsigned cvt_pk_bf16(float lo, float hi) { unsigned r; asm volatile("v_cvt_pk_bf16_f32 %0, %1, %2" : "=v"(r) : "v"(lo), "v"(hi)); return r; }
template <class Epi, class Sched, bool ALIGN_EPI = false, bool SP2 = false, bool F8 = false, bool I8 = false>
__device__ __forceinline__ void gemm_phase(PG8_LAS unsigned char* lds, const Gemm g, const Sched& S, const Epi& E, const int wave_id) {
    int tid; asm volatile("v_mbcnt_lo_u32_b32 %0, -1, 0\n\tv_mbcnt_hi_u32_b32 %0, -1, %0" : "=v"(tid)); tid += wave_id * 64;
    const int wid = wave_id, lane = tid & 63, wr = wid >> 2, wc = wid & 3, fr = lane & 15, fq = lane >> 4;
    const int K = g.K, nt = (g.KE ? g.KE : K) / BK;
    unsigned voffA[2], voffB[2];
#pragma unroll
    for (int i = 0; i < 2; ++i) { int R, C; stage_rc(tid * 16 + i * 8192, R, C); const int Rb = Epi::PERM ? ((R & ~31) + perm32(R & 31)) : R;
        voffA[i] = (unsigned)(R * K + C) * 2u; voffB[i] = (unsigned)(Rb * K + C) * 2u; }
    const __amdgpu_buffer_rsrc_t rsrcA = __builtin_amdgcn_make_buffer_rsrc((void*)g.A, 0, 0x7fffffff, 0x00020000), rsrcB = __builtin_amdgcn_make_buffer_rsrc((void*)g.Bt, 0, 0x7fffffff, 0x00020000);
    const size_t kstep = (size_t)(BK * 2);
    const size_t hstep = (size_t)HALF * K * 2;
    const size_t tstep = 2 * hstep;
    const unsigned ldsw = (unsigned)wid * 1024u;
    const int aoff = lds_byte(wr * 64 + fr, fq * 8), boff = lds_byte(wc * 32 + fr, fq * 8);
#define PG8_SA(b, h) (((b) * 2 + (h)) * HTB)
#define PG8_SB(b, h) ((4 + (b) * 2 + (h)) * HTB)
#define PG8_STAGE(bufoff, gbase, voff) do { const bool isA_ = (+(voff) == +voffA); const unsigned soff_ = (unsigned)((const char*)(gbase) - (isA_ ? (const char*)g.A : (const char*)g.Bt)); _Pragma("unroll") for (int _i = 0; _i < 2; ++_i) \
        __builtin_amdgcn_raw_ptr_buffer_load_lds(isA_ ? rsrcA : rsrcB, (PG8_LAS unsigned*)(lds + (bufoff) + ldsw + _i * 8192), 16, (int)(voff)[_i], (int)soff_, 0, 0); } while (0)
#define PG8_LDA(dst, b, h) do { _Pragma("unroll") for (int m = 0; m < 4; ++m) { if constexpr (F8) { dst##8[m].lo = *(const PG8_LAS bf16x8*)(lds + PG8_SA(b, h) + aoff + m * 2048); dst##8[m].hi = *(const PG8_LAS bf16x8*)(lds + PG8_SA(b, h) + aoff + m * 2048 + 1024); } else { _Pragma("unroll") for (int k = 0; k < 2; ++k) dst[m][k] = *(const PG8_LAS bf16x8*)(lds + PG8_SA(b, h) + aoff + m * 2048 + k * 1024); } } } while (0)
#define PG8_LDB(dst, b, h) do { _Pragma("unroll") for (int n = 0; n < 2; ++n) { if constexpr (F8) { dst##8[n].lo = *(const PG8_LAS bf16x8*)(lds + PG8_SB(b, h) + boff + n * 2048); dst##8[n].hi = *(const PG8_LAS bf16x8*)(lds + PG8_SB(b, h) + boff + n * 2048 + 1024); } else { _Pragma("unroll") for (int k = 0; k < 2; ++k) dst[n][k] = *(const PG8_LAS bf16x8*)(lds + PG8_SB(b, h) + boff + n * 2048 + k * 1024); } } } while (0)
#define PG8_MMA(ai, bj, At, Bt) do { __builtin_amdgcn_s_setprio(1); _Pragma("unroll") for (int m = 0; m < 4; ++m) _Pragma("unroll") for (int n = 0; n < 2; ++n) { \
        if constexpr (F8) { typedef int v8i_ __attribute__((ext_vector_type(8))); \
            acc[ai][bj][m][n] = __builtin_amdgcn_mfma_scale_f32_16x16x128_f8f6f4(__builtin_bit_cast(v8i_, Bt##8[n]), __builtin_bit_cast(v8i_, At##8[m]), acc[ai][bj][m][n], 0, 0, 0, 0x7f79, 1, 0x7f79); }     \
        else if constexpr (I8) { typedef int v4i_ __attribute__((ext_vector_type(4))); \
            _Pragma("unroll") for (int k = 0; k < 2; ++k) acc[ai][bj][m][n] = __builtin_bit_cast(f32x4, __builtin_amdgcn_mfma_i32_16x16x64_i8(__builtin_bit_cast(v4i_, Bt[n][k]), __builtin_bit_cast(v4i_, At[m][k]), __builtin_bit_cast(v4i_, acc[ai][bj][m][n]), 0, 0, 0)); } \
        else { _Pragma("unroll") for (int k = 0; k < 2; ++k) acc[ai][bj][m][n] = __builtin_amdgcn_mfma_f32_16x16x32_bf16(Bt[n][k], At[m][k], acc[ai][bj][m][n], 0, 0, 0); } } \
        __builtin_amdgcn_s_setprio(0); } while (0)
#define PG8_WAIT_V(n) asm volatile("s_waitcnt vmcnt(" #n ")" ::: "memory")
#define PG8_WAIT_L(n) asm volatile("s_waitcnt lgkmcnt(" #n ")" ::: "memory")
#define PG8_BAR __builtin_amdgcn_s_barrier()
#define PG8_SCHED __builtin_amdgcn_sched_barrier(0)
    Unit cur, nxt; int ui = 0;
    if (!S.next(0, cur)) return;
    f32x4 acc[2][2][4][2];
#pragma unroll
    for (int a = 0; a < 2; ++a)
#pragma unroll
        for (int b = 0; b < 2; ++b)
#pragma unroll
            for (int m = 0; m < 4; ++m)
#pragma unroll
                for (int n = 0; n < 2; ++n) acc[a][b][m][n] = (f32x4){0.f, 0.f, 0.f, 0.f};
    typedef short bf16x16 __attribute__((ext_vector_type(16)));
    bf16x16 At8[4], B08[2], B18[2]; bf16x8 At[4][2], B0[2][2], B1[2][2];
    const char* cA = (const char*)g.A + (size_t)cur.pm * tstep; const char* cB = (const char*)g.Bt + (size_t)cur.pn * tstep;
    S.a_ready(cur);
    if constexpr (SP2) {
        PG8_STAGE(PG8_SB(0, 0), cB, voffB); PG8_STAGE(PG8_SB(0, 1), cB + hstep, voffB); PG8_STAGE(PG8_SA(0, 0), cA, voffA); PG8_STAGE(PG8_SA(0, 1), cA + hstep, voffA);
        if (wr == 1) PG8_BAR;
        PG8_WAIT_V(2); PG8_BAR;
        PG8_STAGE(PG8_SB(1, 0), cB + kstep, voffB); PG8_STAGE(PG8_SA(1, 0), cA + kstep, voffA); PG8_STAGE(PG8_SB(1, 1), cB + hstep + kstep, voffB);
        PG8_WAIT_V(6); PG8_BAR;
    } else {
        PG8_STAGE(PG8_SB(0, 0), cB, voffB); PG8_STAGE(PG8_SA(0, 0), cA, voffA); PG8_STAGE(PG8_SB(0, 1), cB + hstep, voffB); PG8_STAGE(PG8_SA(0, 1), cA + hstep, voffA);
        if (wr == 1) PG8_BAR;
        PG8_WAIT_V(4); PG8_BAR;
        PG8_STAGE(PG8_SB(1, 0), cB + kstep, voffB); PG8_STAGE(PG8_SA(1, 0), cA + kstep, voffA); PG8_STAGE(PG8_SB(1, 1), cB + hstep + kstep, voffB);
        PG8_WAIT_V(6); PG8_BAR;
    }
    for (;;) {
        const bool has_next = S.next(ui + 1, nxt);
        const char* nA = has_next ? (const char*)g.A + (size_t)nxt.pm * tstep : cA; const char* nB = has_next ? (const char*)g.Bt + (size_t)nxt.pn * tstep : cB;
        for (int t = 0; t < nt; t += 2) {
            const bool last = (t == nt - 2);
            const char* a1 = cA + (size_t)(t + 1) * kstep;
            const char* a2 = last ? nA : cA + (size_t)(t + 2) * kstep; const char* b2 = last ? nB : cB + (size_t)(t + 2) * kstep;
            const char* a3 = a2 + kstep; const char* b3 = b2 + kstep;
            if (last && has_next) S.a_ready(nxt);
            if constexpr (SP2) {
            PG8_LDB(B0, 0, 0); PG8_LDB(B1, 0, 1); PG8_SCHED; PG8_LDA(At, 0, 0); PG8_STAGE(PG8_SA(1, 1), a1 + hstep, voffA);
            PG8_WAIT_V(8); PG8_WAIT_L(0); PG8_BAR; PG8_MMA(0, 0, At, B0); PG8_MMA(0, 1, At, B1); PG8_BAR; PG8_SCHED;
            PG8_LDA(At, 0, 1); PG8_STAGE(PG8_SB(0, 0), b2, voffB); PG8_STAGE(PG8_SB(0, 1), b2 + hstep, voffB); PG8_STAGE(PG8_SA(0, 0), a2, voffA);
            PG8_WAIT_V(8); PG8_WAIT_L(0); PG8_BAR; PG8_MMA(1, 0, At, B0); PG8_MMA(1, 1, At, B1); PG8_BAR; PG8_SCHED;
            PG8_LDB(B0, 1, 0); PG8_LDB(B1, 1, 1); PG8_SCHED; PG8_LDA(At, 1, 0); PG8_STAGE(PG8_SA(0, 1), a2 + hstep, voffA);
            PG8_WAIT_V(8); PG8_WAIT_L(0); PG8_BAR; PG8_MMA(0, 0, At, B0); PG8_MMA(0, 1, At, B1); PG8_BAR; PG8_SCHED;
            PG8_LDA(At, 1, 1); PG8_STAGE(PG8_SB(1, 0), b3, voffB); PG8_STAGE(PG8_SB(1, 1), b3 + hstep, voffB); PG8_STAGE(PG8_SA(1, 0), a3, voffA);
            PG8_WAIT_V(8); PG8_WAIT_L(0); PG8_BAR; PG8_MMA(1, 0, At, B0); PG8_MMA(1, 1, At, B1); PG8_BAR; PG8_SCHED;
            } else {
            PG8_LDB(B0, 0, 0); PG8_SCHED; PG8_LDA(At, 0, 0); PG8_STAGE(PG8_SA(1, 1), a1 + hstep, voffA);
            PG8_WAIT_L(8); PG8_BAR; PG8_WAIT_L(0); PG8_MMA(0, 0, At, B0); PG8_BAR; PG8_SCHED;
            PG8_LDB(B1, 0, 1); PG8_STAGE(PG8_SB(0, 0), b2, voffB);
            PG8_BAR; PG8_WAIT_L(0); PG8_MMA(0, 1, At, B1); PG8_BAR;
            PG8_LDA(At, 0, 1); PG8_STAGE(PG8_SA(0, 0), a2, voffA);
            PG8_BAR; PG8_WAIT_L(0); PG8_MMA(1, 0, At, B0); PG8_BAR; PG8_SCHED;
            PG8_STAGE(PG8_SB(0, 1), b2 + hstep, voffB);
            PG8_WAIT_V(6); PG8_BAR; PG8_MMA(1, 1, At, B1); PG8_BAR;
            PG8_LDB(B0, 1, 0); PG8_SCHED; PG8_LDA(At, 1, 0); PG8_STAGE(PG8_SA(0, 1), a2 + hstep, voffA);
            PG8_WAIT_L(8); PG8_BAR; PG8_WAIT_L(0); PG8_MMA(0, 0, At, B0); PG8_BAR; PG8_SCHED;
            PG8_LDB(B1, 1, 1); PG8_STAGE(PG8_SB(1, 0), b3, voffB);
            PG8_BAR; PG8_WAIT_L(0); PG8_MMA(0, 1, At, B1); PG8_BAR;
            PG8_LDA(At, 1, 1); PG8_STAGE(PG8_SA(1, 0), a3, voffA);
            PG8_BAR; PG8_WAIT_L(0); PG8_MMA(1, 0, At, B0); PG8_BAR; PG8_SCHED;
            PG8_STAGE(PG8_SB(1, 1), b3 + hstep, voffB);
            PG8_WAIT_V(6); PG8_BAR; PG8_MMA(1, 1, At, B1); PG8_BAR;
            }
        }
        if constexpr (ALIGN_EPI) { if (wr == 0) PG8_BAR; }
        if constexpr (!Epi::AFTER_DRAIN) { int ln_e; asm volatile("v_mbcnt_lo_u32_b32 %0, -1, 0\n\tv_mbcnt_hi_u32_b32 %0, -1, %0" : "=v"(ln_e)); const int fr_e = ln_e & 15, fq_e = ln_e >> 4;
            E(acc, cur, wr, wc, fr_e, fq_e); S.done(cur); }
        if (!has_next) break;
#pragma unroll
        for (int a = 0; a < 2; ++a)
#pragma unroll
            for (int b = 0; b < 2; ++b)
#pragma unroll
                for (int m = 0; m < 4; ++m)
#pragma unroll
                    for (int n = 0; n < 2; ++n) acc[a][b][m][n] = (f32x4){0.f, 0.f, 0.f, 0.f};
        cur = nxt; cA = nA; cB = nB; ++ui;
        if constexpr (ALIGN_EPI) { if (wr == 1) PG8_BAR; }
    }
    PG8_WAIT_V(0);
    if constexpr (!ALIGN_EPI) { if (wr == 0) PG8_BAR; }
    PG8_BAR;
    if constexpr (Epi::AFTER_DRAIN) { E.fused(acc, cur, wr, wc, fr, fq, lds, wid, lane); S.done(cur); }
#undef PG8_SA
#undef PG8_SB
#undef PG8_STAGE
#undef PG8_LDA
#undef PG8_LDB
#undef PG8_MMA
#undef PG8_WAIT_V
#undef PG8_WAIT_L
#undef PG8_BAR
#undef PG8_SCHED
}
}
#define GAS __attribute__((address_space(1)))
#define LAS __attribute__((address_space(3)))
typedef unsigned short bf16;
typedef unsigned v4u __attribute__((ext_vector_type(4)));
typedef float f32x4 __attribute__((ext_vector_type(4)));
typedef short bf16x8 __attribute__((ext_vector_type(8)));
typedef GAS unsigned gu32;
typedef GAS unsigned long long gu64;
#define RLX_AGENT __ATOMIC_RELAXED, __HIP_MEMORY_SCOPE_AGENT
#define LDS_WAIT() asm volatile("s_waitcnt lgkmcnt(0)" ::: "memory")
#define VM_WAIT() asm volatile("s_waitcnt vmcnt(0)" ::: "memory")
__device__ __forceinline__ unsigned long long rt() { return __builtin_amdgcn_s_memrealtime(); }
__device__ __forceinline__ unsigned f2bf(float f) { unsigned u = __builtin_bit_cast(unsigned, f); return (u + 0x7fffu + ((u >> 16) & 1u)) >> 16; }
__device__ __forceinline__ unsigned pk2(float lo, float hi) { return f2bf(lo) | (f2bf(hi) << 16); }

#define XB_TMO      128
#define XB_XCNT(j)  (256  + 64 * (j))
#define XB_XSUB(j)  (1280 + 64 * (j))
#define XB_XGEN(j)  (2304 + 64 * (j))
#define XB_TOP      3328
#define XB_TOPGEN   3392
#define XCD_BAR_WORDS 3456
#define XB_SPIN_CAP (1u << 18)

__device__ __forceinline__ unsigned xb_ld(unsigned* p)              { return __hip_atomic_load(p, __ATOMIC_RELAXED, __HIP_MEMORY_SCOPE_AGENT); }
__device__ __forceinline__ unsigned xb_add(unsigned* p, unsigned v) { return __hip_atomic_fetch_add(p, v, __ATOMIC_RELAXED, __HIP_MEMORY_SCOPE_AGENT); }
__device__ __forceinline__ unsigned xb_xcc_id() { return (unsigned)__builtin_amdgcn_s_getreg((3 << 11) | 20) & 0xFu; }
#define XB_SPIN(cond, bar) do { unsigned _sp = 0; while (cond) { __builtin_amdgcn_s_sleep(1); \
    if ((++_sp & 255u) == 0u) { if (xb_ld(&(bar)[XB_TMO])) break; if (_sp > XB_SPIN_CAP) { atomicAdd(&(bar)[XB_TMO], 1u); break; } } } } while (0)

struct XcdBarrier {
    unsigned* bar; unsigned x; bool wave0;
    volatile LAS unsigned* st;
};

__device__ __forceinline__ XcdBarrier xcd_barrier_post(unsigned* bar, volatile LAS unsigned* st) {
    XcdBarrier b; b.bar = bar; b.x = xb_xcc_id(); b.st = st;
    if (threadIdx.x == 0) (void)xb_add(&bar[XB_XCNT(b.x)], 1u);
    return b;
}
__device__ __forceinline__ void xcd_barrier_complete(unsigned* bar, unsigned x, unsigned& nloc, unsigned& nx) {
    const unsigned G = gridDim.x * gridDim.y * gridDim.z;
    unsigned sum, cnt, mine, sp = 0u;
    for (;;) {
        sum = 0u; cnt = 0u; mine = 0u;
#pragma unroll
        for (unsigned j = 0; j < 16; ++j) { const unsigned c = xb_ld(&bar[XB_XCNT(j)]); sum += c; cnt += (c > 0u) ? 1u : 0u; mine = (j == x) ? c : mine; }
        if (sum == G) break;
        __builtin_amdgcn_s_sleep(1);
        if ((++sp & 255u) == 0u) { if (xb_ld(&bar[XB_TMO])) break; if (sp > XB_SPIN_CAP) { atomicAdd(&bar[XB_TMO], 1u); break; } }
    }
    nloc = mine > 0u ? mine : 1u; nx = cnt > 0u ? cnt : 1u;
}

__device__ __forceinline__ void xcd_barrier(const XcdBarrier& b) {
    asm volatile("s_waitcnt vmcnt(0)" ::: "memory");
    __syncthreads();
    if (b.wave0 && __builtin_amdgcn_mbcnt_hi(~0u, __builtin_amdgcn_mbcnt_lo(~0u, 0u)) == 0u) {
        unsigned* bar = b.bar;
        __builtin_amdgcn_s_waitcnt(0);
        unsigned nloc = b.st[0], nx = b.st[1];
        if (nloc == 0u) { xcd_barrier_complete(bar, b.x, nloc, nx); b.st[0] = nloc; b.st[1] = nx; }
        const unsigned old = xb_add(&bar[XB_XSUB(b.x)], 1u);
        const unsigned gen = old / nloc;
        if (old + 1u == (gen + 1u) * nloc) {
            __builtin_amdgcn_fence(__ATOMIC_RELEASE, "agent");
            asm volatile("s_waitcnt vmcnt(0)" ::: "memory");
            const unsigned og = xb_add(&bar[XB_TOP], 1u);
            const unsigned tg = og / nx;
            if (og + 1u == (tg + 1u) * nx) xb_add(&bar[XB_TOPGEN], 1u);
            else XB_SPIN(xb_ld(&bar[XB_TOPGEN]) == tg, bar);
            __builtin_amdgcn_fence(__ATOMIC_ACQUIRE, "agent");
            xb_add(&bar[XB_XGEN(b.x)], 1u);
            asm volatile("s_waitcnt vmcnt(0)" ::: "memory");
        } else {
            XB_SPIN(xb_ld(&bar[XB_XGEN(b.x)]) == gen, bar);
            __builtin_amdgcn_fence(__ATOMIC_ACQUIRE, "agent");
            asm volatile("s_waitcnt vmcnt(0)" ::: "memory");
        }
    }
    __syncthreads();
}

constexpr int NWAVES = 8, NTHREADS = NWAVES * 64;
constexpr int BATCH = 8, SEQ = 2048, T = BATCH * SEQ, D = 2048;
constexpr int EV_N = 7200, EV_NP = 7424, OD_N = 7616, OD_NP = 7680, PROJ_LD = 7680;
constexpr float EPS = 1e-6f;
constexpr int EC_GQ = 0, EC_GK = 512, EC_GV = 1024, EC_GZ = 2048, EC_GLR = 3072, EC_BQ = 3088, EC_BK = 4112, EC_BV = 5136, EC_BZ = 6160, EC_BA = 7184, EC_BB = 7192;
constexpr int OC_HQ = 0, OC_HF = 1024, OC_HI = 2048, OC_HG = 3072, OC_RW = 4096;
constexpr int RW_R = 0, RW_K = 1024, RW_V = 2048, RW_WL = 3072, RW_AL = 3168, RW_GL = 3264;
constexpr int LORA_K = 512, LORA_N = 3072;
enum { I_X = 0, I_P, I_EV_WIN, I_GK_W2, I_GK_B, I_GLA_NORM, I_GDN_CONV, I_GDN_ALOG, I_GDN_DTB, I_GDN_NORM, I_EV_WOUT, I_OD_WIN, I_LB, I_HG_NORM,
       I_MU, I_W0, I_W2, I_A0, I_A2, I_G2, I_KK, I_KA, I_RK, I_LNW, I_LNB, I_OD_WOUT, I_NMIX, I_NFFN, I_NPLE, I_PEER_WQ, I_PEER_SK, I_PEER_U, I_PEER_V,
       I_PLE_WP, I_PLE_WG, I_NFINAL, N_IN };

constexpr size_t MiB = 1u << 20;
constexpr size_t WS_CTL = 0, CTL_ZERO_BYTES = 1 * MiB, WS_SU = 256 * 1024, WS_CMB = 512 * 1024, WS_SA = 576 * 1024;
constexpr size_t WS_WEV_IN = 1 * MiB, WS_WEV_OUT = 30 * MiB, WS_WOD_IN = 38 * MiB, WS_WOD_OUT = 68 * MiB, WS_WPEER = 76 * MiB, WS_WGATE = 92 * MiB, WS_WPROJ = 108 * MiB,
                 WS_WLORA = 110 * MiB, WS_PBF = 113 * MiB, WS_TABU = 129 * MiB, WS_TABV = 193 * MiB, WS_ACTA = 257 * MiB, WS_ACTB = 321 * MiB, WS_PROJ = 385 * MiB, WS_SC = 385 * MiB,
                 WS_O = 625 * MiB, WS_H1 = 689 * MiB, WS_PP = 753 * MiB, WS_LA = 817 * MiB, WS_LO = 833 * MiB, WS_RSP = 929 * MiB, WS_STATE = 937 * MiB, WS_RS3 = 945 * MiB, WS_END = 946 * MiB;
static_assert(WS_WEV_IN + (size_t)EV_NP * D * 2 <= WS_WEV_OUT && WS_WOD_IN + (size_t)OD_NP * D * 2 <= WS_WOD_OUT && WS_PROJ + (size_t)T * PROJ_LD * 2 <= WS_O, "ws map");
constexpr int CW_BAR = 4096;
enum { RS_FFN0 = 0, RS_MIX1 = 1, RS_FFN1 = 2, RS_FINAL = 3 };
constexpr int RING_OFF = 0, RING_BYTES = 131072;
constexpr int LDSCTL_OFF = RING_BYTES, MISC_OFF = LDSCTL_OFF + 320;
constexpr int LDS_BYTES = 147456;

struct Args { const float* in[N_IN]; float* out; unsigned char* ws; int ph_lo, ph_hi; };
struct Frame {
    LAS unsigned char* lds; volatile LAS unsigned* MISC; gu32* ctl;
    int tid, lane, wave, vcu, G;
};
__device__ __forceinline__ float wave_sum(float v) {
#pragma unroll
    for (int o = 1; o < 64; o <<= 1) v += __shfl_xor(v, o);
    return v;
}
__device__ __forceinline__ float half_sum32(float v) {
#pragma unroll
    for (int o = 1; o < 32; o <<= 1) v += __shfl_xor(v, o);
    return v;
}
#define DPP_ADD(v, ctrl) (v) += __builtin_bit_cast(float, __builtin_amdgcn_update_dpp(0, __builtin_bit_cast(int, (v)), (ctrl), 0xF, 0xF, false))
__device__ __forceinline__ float row_sum16(float v) {
    DPP_ADD(v, 0x128); DPP_ADD(v, 0x124); DPP_ADD(v, 0x122); DPP_ADD(v, 0x121);
    return v;
}
__device__ __forceinline__ void row_sum16_x4(float& a, float& b, float& c, float& d) {
    asm("s_nop 1\n\t"
        "v_add_f32_dpp %0, %0, %0 row_ror:8 row_mask:0xf bank_mask:0xf\n\tv_add_f32_dpp %1, %1, %1 row_ror:8 row_mask:0xf bank_mask:0xf\n\t"
        "v_add_f32_dpp %2, %2, %2 row_ror:8 row_mask:0xf bank_mask:0xf\n\tv_add_f32_dpp %3, %3, %3 row_ror:8 row_mask:0xf bank_mask:0xf\n\t"
        "v_add_f32_dpp %0, %0, %0 row_ror:4 row_mask:0xf bank_mask:0xf\n\tv_add_f32_dpp %1, %1, %1 row_ror:4 row_mask:0xf bank_mask:0xf\n\t"
        "v_add_f32_dpp %2, %2, %2 row_ror:4 row_mask:0xf bank_mask:0xf\n\tv_add_f32_dpp %3, %3, %3 row_ror:4 row_mask:0xf bank_mask:0xf\n\t"
        "v_add_f32_dpp %0, %0, %0 row_ror:2 row_mask:0xf bank_mask:0xf\n\tv_add_f32_dpp %1, %1, %1 row_ror:2 row_mask:0xf bank_mask:0xf\n\t"
        "v_add_f32_dpp %2, %2, %2 row_ror:2 row_mask:0xf bank_mask:0xf\n\tv_add_f32_dpp %3, %3, %3 row_ror:2 row_mask:0xf bank_mask:0xf\n\t"
        "v_add_f32_dpp %0, %0, %0 row_ror:1 row_mask:0xf bank_mask:0xf\n\tv_add_f32_dpp %1, %1, %1 row_ror:1 row_mask:0xf bank_mask:0xf\n\t"
        "v_add_f32_dpp %2, %2, %2 row_ror:1 row_mask:0xf bank_mask:0xf\n\tv_add_f32_dpp %3, %3, %3 row_ror:1 row_mask:0xf bank_mask:0xf\n\t"
        "s_nop 1"
        : "+v"(a), "+v"(b), "+v"(c), "+v"(d));
}
__device__ __forceinline__ void row_sum16_x2(float& a, float& b) {
    asm("s_nop 1\n\t"
        "v_add_f32_dpp %0, %0, %0 row_ror:8 row_mask:0xf bank_mask:0xf\n\tv_add_f32_dpp %1, %1, %1 row_ror:8 row_mask:0xf bank_mask:0xf\n\ts_nop 1\n\t"
        "v_add_f32_dpp %0, %0, %0 row_ror:4 row_mask:0xf bank_mask:0xf\n\tv_add_f32_dpp %1, %1, %1 row_ror:4 row_mask:0xf bank_mask:0xf\n\ts_nop 1\n\t"
        "v_add_f32_dpp %0, %0, %0 row_ror:2 row_mask:0xf bank_mask:0xf\n\tv_add_f32_dpp %1, %1, %1 row_ror:2 row_mask:0xf bank_mask:0xf\n\ts_nop 1\n\t"
        "v_add_f32_dpp %0, %0, %0 row_ror:1 row_mask:0xf bank_mask:0xf\n\tv_add_f32_dpp %1, %1, %1 row_ror:1 row_mask:0xf bank_mask:0xf\n\t"
        "s_nop 1"
        : "+v"(a), "+v"(b));
}
typedef unsigned u32x2 __attribute__((ext_vector_type(2)));
__device__ __forceinline__ void st_wt16(void* p, v4u v) { asm volatile("global_store_dwordx4 %0, %1, off sc1\n\ts_nop 1" :: "v"(p), "v"(v) : "memory"); }
__device__ __forceinline__ void st_wt8(void* p, u32x2 v) { asm volatile("global_store_dwordx2 %0, %1, off sc1\n\ts_nop 1" :: "v"(p), "v"(v) : "memory"); }
#define LBAR() do { asm volatile("s_waitcnt lgkmcnt(0)" ::: "memory"); __builtin_amdgcn_s_barrier(); asm volatile("" ::: "memory"); } while (0)
typedef float f32x2 __attribute__((ext_vector_type(2)));
typedef __bf16 hwbf16x2_t __attribute__((ext_vector_type(2)));
__device__ __forceinline__ unsigned hw_pk2(float lo, float hi) { const f32x2 v = {lo, hi}; return __builtin_bit_cast(unsigned, __builtin_convertvector(v, hwbf16x2_t)); }
__device__ __forceinline__ bf16 hw_bf(float x) { return (bf16)hw_pk2(x, 0.f); }
__device__ __forceinline__ float bf_lo(unsigned w) { return __uint_as_float(w << 16); }
__device__ __forceinline__ float bf_hi(unsigned w) { return __uint_as_float(w & 0xffff0000u); }
__device__ __forceinline__ float sigmoidf_(float x) { return __builtin_amdgcn_rcpf(1.0f + __expf(-x)); }
__device__ __forceinline__ float siluf_(float x) { return x * __builtin_amdgcn_rcpf(1.0f + __expf(-x)); }
__device__ __forceinline__ float softplusf_(float x) { return fmaxf(x, 0.f) + log1pf(__expf(-fabsf(x))); }
__device__ __forceinline__ float logsigmoidf_(float x) { return fminf(x, 0.f) - log1pf(__expf(-fabsf(x))); }

struct EpiBf16S {
    static constexpr bool PERM = true, AFTER_DRAIN = false;
    bf16* O; int ldc; const float* rowss;
    __device__ __forceinline__ void operator()(const pg8::f32x4 (&acc)[2][2][4][2], const pg8::Unit& u, int wr, int wc, int fr, int fq) const {
        const int row0 = u.pm * 256 + wr * 64 + fr, col0 = u.pn * 256 + wc * 32 + 8 * fq;
#pragma unroll
        for (int ai = 0; ai < 2; ++ai)
#pragma unroll
            for (int m = 0; m < 4; ++m) {
                const int row = row0 + ai * 128 + m * 16;
                float sc = 1.f;
                if (rowss) { const pg8::f32x4* rp = (const pg8::f32x4*)(rowss + (size_t)row * 32 + 8 * fq); const pg8::f32x4 p0 = rp[0], p1 = rp[1];
                    float s = ((p0[0] + p0[1]) + (p0[2] + p0[3])) + ((p1[0] + p1[1]) + (p1[2] + p1[3])); s += __shfl_xor(s, 16); s += __shfl_xor(s, 32);
                    sc = __builtin_amdgcn_rsqf(s * (1.0f / D) + EPS); }
                bf16* rowp = O + (size_t)row * ldc + col0;
#pragma unroll
                for (int bj = 0; bj < 2; ++bj) { const pg8::f32x4 v0 = acc[ai][bj][m][0] * sc, v1 = acc[ai][bj][m][1] * sc;
                    pg8::u32x4 w; w.x = pg8::cvt_pk_bf16(v0[0], v0[1]); w.y = pg8::cvt_pk_bf16(v0[2], v0[3]); w.z = pg8::cvt_pk_bf16(v1[0], v1[1]); w.w = pg8::cvt_pk_bf16(v1[2], v1[3]);
                    *(pg8::u32x4*)(rowp + bj * 128) = w; } }
    }
};
struct EpiI8S {
    static constexpr bool PERM = true, AFTER_DRAIN = false;
    bf16* O; int ldc; const float* sa; const float* cb;
    __device__ __forceinline__ void operator()(const pg8::f32x4 (&acc)[2][2][4][2], const pg8::Unit& u, int wr, int wc, int fr, int fq) const {
        const int row0 = u.pm * 256 + wr * 64 + fr, col0 = u.pn * 256 + wc * 32 + 8 * fq;
        pg8::f32x4 cs[2][2];
#pragma unroll
        for (int bj = 0; bj < 2; ++bj) { cs[bj][0] = *(const pg8::f32x4*)(cb + col0 + bj * 128); cs[bj][1] = *(const pg8::f32x4*)(cb + col0 + bj * 128 + 4); }
#pragma unroll
        for (int ai = 0; ai < 2; ++ai)
#pragma unroll
            for (int m = 0; m < 4; ++m) {
                const int row = row0 + ai * 128 + m * 16;
                const float sc = sa[row];
                bf16* rowp = O + (size_t)row * ldc + col0;
#pragma unroll
                for (int bj = 0; bj < 2; ++bj) { pg8::f32x4 v0, v1;
#pragma unroll
                    for (int e = 0; e < 4; ++e) { v0[e] = (float)__float_as_int(acc[ai][bj][m][0][e]) * sc * cs[bj][0][e]; v1[e] = (float)__float_as_int(acc[ai][bj][m][1][e]) * sc * cs[bj][1][e]; }
                    pg8::u32x4 w; w.x = pg8::cvt_pk_bf16(v0[0], v0[1]); w.y = pg8::cvt_pk_bf16(v0[2], v0[3]); w.z = pg8::cvt_pk_bf16(v1[0], v1[1]); w.w = pg8::cvt_pk_bf16(v1[2], v1[3]);
                    *(pg8::u32x4*)(rowp + bj * 128) = w; } }
    }
};
template <bool GATE, bool HIN_F32, bool I8 = false> struct EpiResid {
    static constexpr bool PERM = true, AFTER_DRAIN = false;
    const void* hin; bf16* hout; float* rowss; const bf16* pp; const float* rs3; unsigned char* h8; const float* sa; const float* cb;
    __device__ __forceinline__ void operator()(const pg8::f32x4 (&acc)[2][2][4][2], const pg8::Unit& u, int wr, int wc, int fr, int fq) const {
        const int row0 = u.pm * 256 + wr * 64 + fr, col0 = u.pn * 256 + wc * 32 + 8 * fq;
        pg8::f32x4 cs[2][2];
        if constexpr (I8) {
#pragma unroll
            for (int bj = 0; bj < 2; ++bj)
#pragma unroll
                for (int n = 0; n < 2; ++n) cs[bj][n] = *(const pg8::f32x4*)(cb + col0 + bj * 128 + n * 4); }
        constexpr int MG = HIN_F32 ? 2 : 4;
#pragma unroll
        for (int ai = 0; ai < 2; ++ai)
#pragma unroll
            for (int m0 = 0; m0 < 4; m0 += MG) {
                pg8::f32x4 hf[MG][2][2]; pg8::u32x4 hb[MG][2], pw[MG][2]; float rsc[MG];
#pragma unroll
                for (int mm = 0; mm < MG; ++mm) { const int row = row0 + ai * 128 + (m0 + mm) * 16; const size_t off = (size_t)row * D + col0; rsc[mm] = GATE ? rs3[row] : (I8 ? sa[row] : 1.f);
#pragma unroll
                    for (int bj = 0; bj < 2; ++bj) { const size_t o = off + bj * 128;
                        if (HIN_F32) { hf[mm][bj][0] = *(const pg8::f32x4*)((const float*)hin + o); hf[mm][bj][1] = *(const pg8::f32x4*)((const float*)hin + o + 4); } else hb[mm][bj] = *(const pg8::u32x4*)((const bf16*)hin + o);
                        if (GATE) pw[mm][bj] = *(const pg8::u32x4*)(pp + o); } }
#pragma unroll
                for (int mm = 0; mm < MG; ++mm) { const int m = m0 + mm; const int row = row0 + ai * 128 + m * 16; const size_t off = (size_t)row * D + col0; float ss = 0.f;
#pragma unroll
                    for (int bj = 0; bj < 2; ++bj) { const size_t o = off + bj * 128; unsigned ow[4]; float hv8[8];
#pragma unroll
                        for (int n = 0; n < 2; ++n) {
                            pg8::f32x4 hv;
                            if (HIN_F32) hv = hf[mm][bj][n];
                            else { const unsigned h0 = n ? hb[mm][bj].z : hb[mm][bj].x, h1 = n ? hb[mm][bj].w : hb[mm][bj].y; hv[0] = bf_lo(h0); hv[1] = bf_hi(h0); hv[2] = bf_lo(h1); hv[3] = bf_hi(h1); }
                            pg8::f32x4 a = acc[ai][bj][m][n];
                            if constexpr (I8 && !GATE) { const float sr_ = rsc[mm];
#pragma unroll
                                for (int e = 0; e < 4; ++e) a[e] = (float)__float_as_int(a[e]) * sr_ * cs[bj][n][e]; }
                            if (GATE) { const unsigned p0 = n ? pw[mm][bj].z : pw[mm][bj].x, p1 = n ? pw[mm][bj].w : pw[mm][bj].y; const float rs_ = rsc[mm];
                                a[0] = sigmoidf_(a[0] * rs_) * bf_lo(p0); a[1] = sigmoidf_(a[1] * rs_) * bf_hi(p0); a[2] = sigmoidf_(a[2] * rs_) * bf_lo(p1); a[3] = sigmoidf_(a[3] * rs_) * bf_hi(p1); }
                            hv = hv + a;
                            ow[2 * n] = hw_pk2(hv[0], hv[1]); ow[2 * n + 1] = hw_pk2(hv[2], hv[3]);
                            hv8[4 * n] = hv[0]; hv8[4 * n + 1] = hv[1]; hv8[4 * n + 2] = hv[2]; hv8[4 * n + 3] = hv[3];
                            const float q0 = bf_lo(ow[2 * n]), q1 = bf_hi(ow[2 * n]), q2 = bf_lo(ow[2 * n + 1]), q3 = bf_hi(ow[2 * n + 1]);
                            ss += (q0 * q0 + q1 * q1) + (q2 * q2 + q3 * q3); }
                        pg8::u32x4 w; w.x = ow[0]; w.y = ow[1]; w.z = ow[2]; w.w = ow[3]; *(pg8::u32x4*)(hout + o) = w;
                        if (h8) { int x0 = __builtin_amdgcn_cvt_pk_fp8_f32(hv8[0], hv8[1], 0, false); x0 = __builtin_amdgcn_cvt_pk_fp8_f32(hv8[2], hv8[3], x0, true);
                                  int x1 = __builtin_amdgcn_cvt_pk_fp8_f32(hv8[4], hv8[5], 0, false); x1 = __builtin_amdgcn_cvt_pk_fp8_f32(hv8[6], hv8[7], x1, true);
                                  pg8::u32x2 w8; w8.x = (unsigned)x0; w8.y = (unsigned)x1; *(pg8::u32x2*)(h8 + o) = w8; } }
                    ss += __shfl_xor(ss, 16); ss += __shfl_xor(ss, 32);
                    if (fq == 0) rowss[(size_t)row * 32 + u.pn * 4 + wc] = ss; }
                asm volatile("" ::: "memory"); }
    }
};


__device__ __forceinline__ void p0_transpose_item(const float* W, int K, int N, bf16* WT, LAS float* scr, int item, int lane, const float* kgain = nullptr) {
    const int nblk = N / 32, kb = item / nblk, nb = item % nblk, k0 = 64 * kb, n0 = 32 * nb;
    { const GAS float* Wg = (const GAS float*)W + (size_t)(k0 + (lane >> 5)) * N + n0 + (lane & 31); float v[32];
#pragma unroll
      for (int i = 0; i < 32; ++i) v[i] = Wg[(size_t)(2 * i) * N];
#pragma unroll
      for (int i = 0; i < 32; ++i) scr[(2 * i + (lane >> 5)) * 33 + (lane & 31)] = v[i]; }
    LDS_WAIT(); asm volatile("" ::: "memory");
    const int c = lane & 7;
#pragma unroll
    for (int j = 0; j < 4; ++j) { const int n = (lane >> 3) + 8 * j; const LAS float* s = scr + (8 * c) * 33 + n;
        f32x4 g0 = {1.f, 1.f, 1.f, 1.f}, g1 = g0; if (kgain) { g0 = *(const GAS f32x4*)(kgain + k0 + 8 * c); g1 = *(const GAS f32x4*)(kgain + k0 + 8 * c + 4); }
        v4u o; o.x = pk2(s[0 * 33] * g0[0], s[1 * 33] * g0[1]); o.y = pk2(s[2 * 33] * g0[2], s[3 * 33] * g0[3]); o.z = pk2(s[4 * 33] * g1[0], s[5 * 33] * g1[1]); o.w = pk2(s[6 * 33] * g1[2], s[7 * 33] * g1[3]);
        *(GAS v4u*)(WT + (size_t)(n0 + n) * K + k0 + 8 * c) = o; }
    LDS_WAIT(); asm volatile("" ::: "memory");
}
__device__ __forceinline__ void p0_transpose_item_i8(const float* W, int K, int N, unsigned char* WT, LAS float* scr, int item, int lane, const float* cm) {
    const int nblk = N / 32, kb = item / nblk, nb = item % nblk, k0 = 64 * kb, n0 = 32 * nb; float mxs[4];
    { const GAS float* Wg = (const GAS float*)W + (size_t)(k0 + (lane >> 5)) * N + n0 + (lane & 31); float v[32];
#pragma unroll
      for (int i = 0; i < 32; ++i) v[i] = Wg[(size_t)(2 * i) * N];
#pragma unroll
      for (int j = 0; j < 4; ++j) mxs[j] = __uint_as_float(__hip_atomic_load((const unsigned*)cm + n0 + (lane >> 3) + 8 * j, __ATOMIC_RELAXED, __HIP_MEMORY_SCOPE_AGENT));
#pragma unroll
      for (int i = 0; i < 32; ++i) scr[(2 * i + (lane >> 5)) * 33 + (lane & 31)] = v[i]; }
    LDS_WAIT(); asm volatile("" ::: "memory");
    const int c = lane & 7;
#pragma unroll
    for (int j = 0; j < 4; ++j) { const int n = (lane >> 3) + 8 * j; const LAS float* s = scr + (8 * c) * 33 + n;
        const float mx = mxs[j], inv = mx > 0.f ? 127.0f / mx : 0.f; unsigned w0 = 0, w1 = 0;
#pragma unroll
        for (int e = 0; e < 4; ++e) { w0 |= (__float_as_uint(__builtin_fmaf(s[e * 33], inv, 12582912.0f)) & 255u) << (8 * e); w1 |= (__float_as_uint(__builtin_fmaf(s[(4 + e) * 33], inv, 12582912.0f)) & 255u) << (8 * e); }
        u32x2 o; o.x = w0; o.y = w1;
        *(GAS u32x2*)(WT + (size_t)(n0 + n) * K + k0 + 8 * c) = o; }
    LDS_WAIT(); asm volatile("" ::: "memory");
}
__device__ __forceinline__ void colmax_item(const float* W, int K, int N, float* cm, int item, int lane) {
    const int ngrp = (N + 255) / 256, kb = item / ngrp, cg_ = item % ngrp, col = 256 * cg_ + 4 * lane;
    if (col >= N) return;
    const GAS f32x4* p = (const GAS f32x4*)((const GAS float*)W + (size_t)(64 * kb) * N + col); f32x4 m = {0.f, 0.f, 0.f, 0.f};
#pragma unroll 16
    for (int r = 0; r < 64; ++r) { const f32x4 v = *(const GAS f32x4*)((const GAS float*)p + (size_t)r * N);
#pragma unroll
        for (int e = 0; e < 4; ++e) m[e] = fmaxf(m[e], fabsf(v[e])); }
#pragma unroll
    for (int e = 0; e < 4; ++e) __hip_atomic_fetch_max((unsigned*)cm + col + e, __float_as_uint(m[e]), __ATOMIC_RELAXED, __HIP_MEMORY_SCOPE_AGENT);
}
__device__ __forceinline__ void p0_transpose_item_f8(const float* W, int K, int N, unsigned char* WT, LAS float* scr, int item, int lane, const float* kgain = nullptr) {
    const int nblk = N / 32, kb = item / nblk, nb = item % nblk, k0 = 64 * kb, n0 = 32 * nb;
    { const GAS float* Wg = (const GAS float*)W + (size_t)(k0 + (lane >> 5)) * N + n0 + (lane & 31); float v[32];
#pragma unroll
      for (int i = 0; i < 32; ++i) v[i] = Wg[(size_t)(2 * i) * N];
#pragma unroll
      for (int i = 0; i < 32; ++i) scr[(2 * i + (lane >> 5)) * 33 + (lane & 31)] = v[i]; }
    LDS_WAIT(); asm volatile("" ::: "memory");
    const int c = lane & 7;
    f32x4 gk0 = {64.f, 64.f, 64.f, 64.f}, gk1 = gk0; if (kgain) { gk0 = gk0 * *(const GAS f32x4*)(kgain + k0 + 8 * c); gk1 = gk1 * *(const GAS f32x4*)(kgain + k0 + 8 * c + 4); }
#pragma unroll
    for (int j = 0; j < 4; ++j) { const int n = (lane >> 3) + 8 * j; const LAS float* s = scr + (8 * c) * 33 + n;
        const f32x4 g0 = gk0, g1 = gk1;
        int x0 = __builtin_amdgcn_cvt_pk_fp8_f32(s[0 * 33] * g0[0], s[1 * 33] * g0[1], 0, false); x0 = __builtin_amdgcn_cvt_pk_fp8_f32(s[2 * 33] * g0[2], s[3 * 33] * g0[3], x0, true);
        int x1 = __builtin_amdgcn_cvt_pk_fp8_f32(s[4 * 33] * g1[0], s[5 * 33] * g1[1], 0, false); x1 = __builtin_amdgcn_cvt_pk_fp8_f32(s[6 * 33] * g1[2], s[7 * 33] * g1[3], x1, true);
        u32x2 o; o.x = (unsigned)x0; o.y = (unsigned)x1;
        *(GAS u32x2*)(WT + (size_t)(n0 + n) * K + k0 + 8 * c) = o; }
    LDS_WAIT(); asm volatile("" ::: "memory");
}
__device__ __forceinline__ void cvt_f32_bf16(const float* src, bf16* dst, size_t n, int gtid, int gthreads) {
    const size_t n8 = n / 8;
    for (size_t i = gtid; i < n8; i += gthreads) {
        const f32x4 a = *(const GAS f32x4*)(src + i * 8), b = *(const GAS f32x4*)(src + i * 8 + 4);
        v4u o; o.x = pk2(a[0], a[1]); o.y = pk2(a[2], a[3]); o.z = pk2(b[0], b[1]); o.w = pk2(b[2], b[3]);
        *(GAS v4u*)(dst + i * 8) = o; }
}
__device__ __forceinline__ void cvt_f32_fp8(const float* src, unsigned char* dst, size_t n, float scale, int gtid, int gthreads, const float* cgain = nullptr) {
    const size_t n16 = n / 16;
    for (size_t i = gtid; i < n16; i += gthreads) { v4u o; unsigned w[4];
#pragma unroll
        for (int q = 0; q < 4; ++q) { f32x4 a = *(const GAS f32x4*)(src + i * 16 + 4 * q) * scale; if (cgain) a = a * *(const GAS f32x4*)(cgain + ((i * 16 + 4 * q) & (D - 1)));
            int x = __builtin_amdgcn_cvt_pk_fp8_f32(a[0], a[1], 0, false); x = __builtin_amdgcn_cvt_pk_fp8_f32(a[2], a[3], x, true); w[q] = (unsigned)x; }
        o.x = w[0]; o.y = w[1]; o.z = w[2]; o.w = w[3];
        *(GAS v4u*)(dst + i * 16) = o; }
}
__device__ __forceinline__ void cvt_rows_i8(const float* src, unsigned char* dst, float* SU, int rows, int gw, int NGW, int lane, const float* cgain) {
    f32x4 a[8], nx[8];
    f32x4 gv[8];
#pragma unroll
    for (int i = 0; i < 8; ++i) gv[i] = cgain ? *(const GAS f32x4*)(cgain + 256 * i + 4 * lane) : (f32x4){1.f, 1.f, 1.f, 1.f};
    int r = gw;
    if (r < rows) {
#pragma unroll
        for (int i = 0; i < 8; ++i) a[i] = *(const GAS f32x4*)(src + (size_t)r * D + 256 * i + 4 * lane); }
    for (; r < rows; r += NGW) {
        const int rn = r + NGW;
        if (rn < rows) {
#pragma unroll
            for (int i = 0; i < 8; ++i) nx[i] = *(const GAS f32x4*)(src + (size_t)rn * D + 256 * i + 4 * lane); }
        float mx = 0.f;
#pragma unroll
        for (int i = 0; i < 8; ++i) { a[i] = a[i] * gv[i];
            mx = fmaxf(mx, fmaxf(fmaxf(fabsf(a[i][0]), fabsf(a[i][1])), fmaxf(fabsf(a[i][2]), fabsf(a[i][3])))); }
#pragma unroll
        for (int o = 1; o < 64; o <<= 1) mx = fmaxf(mx, __shfl_xor(mx, o));
        const float inv = mx > 0.f ? 127.0f / mx : 0.f;
#pragma unroll
        for (int i = 0; i < 8; ++i) { unsigned w = 0;
#pragma unroll
            for (int e = 0; e < 4; ++e) w |= (__float_as_uint(__builtin_fmaf(a[i][e], inv, 12582912.0f)) & 255u) << (8 * e);
            *(GAS unsigned*)(dst + (size_t)r * D + 256 * i + 4 * lane) = w; }
        if (lane == 0) SU[r] = mx * (1.0f / 127.0f);
#pragma unroll
        for (int i = 0; i < 8; ++i) a[i] = nx[i];
    }
}
__device__ __forceinline__ void rms_row_to_bf16(const float* xrow, const float* g, bf16* orow, int lane) {
    const GAS f32x4* xr = (const GAS f32x4*)xrow + lane; f32x4 v[8]; float s = 0.f;
#pragma unroll
    for (int j = 0; j < 8; ++j) { v[j] = xr[64 * j]; s += (v[j][0] * v[j][0] + v[j][1] * v[j][1]) + (v[j][2] * v[j][2] + v[j][3] * v[j][3]); }
    const float r = __builtin_amdgcn_rsqf(wave_sum(s) * (1.0f / D) + EPS);
    const GAS f32x4* gr = (const GAS f32x4*)g + lane;
    GAS unsigned long long* o8 = (GAS unsigned long long*)orow + lane;
#pragma unroll
    for (int j = 0; j < 8; ++j) { const f32x4 gg = gr[64 * j]; o8[64 * j] = (unsigned long long)pk2(v[j][0] * r * gg[0], v[j][1] * r * gg[1]) | ((unsigned long long)pk2(v[j][2] * r * gg[2], v[j][3] * r * gg[3]) << 32); }
}
__device__ __forceinline__ void rms_rows_to_i8(const float* x, const float* g, unsigned char* out, float* sa, int m0, int step, int mend, int lane) {
    const GAS f32x4* gr = (const GAS f32x4*)g + lane; f32x4 gg[8];
#pragma unroll
    for (int j = 0; j < 8; ++j) gg[j] = gr[64 * j];
    f32x4 v[8], nx[8];
    if (m0 < mend) { const GAS f32x4* xr = (const GAS f32x4*)(x + (size_t)m0 * D) + lane;
#pragma unroll
        for (int j = 0; j < 8; ++j) v[j] = xr[64 * j]; }
    for (int m = m0; m < mend; m += step) {
        if (m + step < mend) { const GAS f32x4* xr = (const GAS f32x4*)(x + (size_t)(m + step) * D) + lane;
#pragma unroll
            for (int j = 0; j < 8; ++j) nx[j] = xr[64 * j]; }
        float s = 0.f;
#pragma unroll
        for (int j = 0; j < 8; ++j) s += (v[j][0] * v[j][0] + v[j][1] * v[j][1]) + (v[j][2] * v[j][2] + v[j][3] * v[j][3]);
        const float r = __builtin_amdgcn_rsqf(wave_sum(s) * (1.0f / D) + EPS);
        float mx = 0.f;
#pragma unroll
        for (int j = 0; j < 8; ++j) { v[j] = v[j] * gg[j] * r; mx = fmaxf(mx, fmaxf(fmaxf(fabsf(v[j][0]), fabsf(v[j][1])), fmaxf(fabsf(v[j][2]), fabsf(v[j][3])))); }
#pragma unroll
        for (int o = 1; o < 64; o <<= 1) mx = fmaxf(mx, __shfl_xor(mx, o));
        const float inv = mx > 0.f ? 127.0f / mx : 0.f;
        GAS unsigned* o4 = (GAS unsigned*)(out + (size_t)m * D) + lane;
#pragma unroll
        for (int j = 0; j < 8; ++j) { unsigned w = 0;
#pragma unroll
            for (int e = 0; e < 4; ++e) w |= (__float_as_uint(__builtin_fmaf(v[j][e], inv, 12582912.0f)) & 255u) << (8 * e);
            o4[64 * j] = w; }
        if (lane == 0) sa[m] = mx * (1.0f / (127.0f * 127.0f));
#pragma unroll
        for (int j = 0; j < 8; ++j) v[j] = nx[j];
    }
}
__device__ __forceinline__ void rms_row_to_f8(const float* xrow, const float* g, unsigned char* orow, int lane) {
    const GAS f32x4* xr = (const GAS f32x4*)xrow + lane; f32x4 v[8]; float s = 0.f;
#pragma unroll
    for (int j = 0; j < 8; ++j) { v[j] = xr[64 * j]; s += (v[j][0] * v[j][0] + v[j][1] * v[j][1]) + (v[j][2] * v[j][2] + v[j][3] * v[j][3]); }
    const float r = __builtin_amdgcn_rsqf(wave_sum(s) * (1.0f / D) + EPS);
    const GAS f32x4* gr = (const GAS f32x4*)g + lane;
    GAS unsigned* o4 = (GAS unsigned*)orow + lane;
#pragma unroll
    for (int j = 0; j < 8; ++j) { const f32x4 q = v[j] * gr[64 * j] * r; int x = __builtin_amdgcn_cvt_pk_fp8_f32(q[0], q[1], 0, false); x = __builtin_amdgcn_cvt_pk_fp8_f32(q[2], q[3], x, true); o4[64 * j] = (unsigned)x; }
}
__device__ __forceinline__ void p0_fold_item(const float* wq, const float* sk, bf16* WP, LAS float* lds, int item, int tid, const float* kgain) {
    const int hp = item >> 5, k0 = (item & 31) * 64;
    LAS float* SK = lds;
    LAS float* WQ = lds + 128 * 132;
    { const GAS float* sg = (const GAS float*)(sk + (size_t)hp * 128 * 128); const GAS float* wg = (const GAS float*)wq; const GAS float* kg = (const GAS float*)kgain; float v[32], w[16];
#pragma unroll
      for (int i = 0; i < 32; ++i) v[i] = sg[i * 512 + tid];
#pragma unroll
      for (int i = 0; i < 16; ++i) { const int idx = i * 512 + tid, kk = idx >> 7, d = idx & 127; w[i] = wg[(size_t)(k0 + kk) * D + hp * 128 + d]; }
      float kq[16];
#pragma unroll
      for (int i = 0; i < 16; ++i) kq[i] = kg[k0 + ((i * 512 + tid) >> 7)];
#pragma unroll
      for (int i = 0; i < 16; ++i) w[i] *= kq[i];
#pragma unroll
      for (int i = 0; i < 32; ++i) { const int idx = i * 512 + tid; SK[(idx >> 7) * 132 + (idx & 127)] = v[i]; }
#pragma unroll
      for (int i = 0; i < 16; ++i) { const int idx = i * 512 + tid; WQ[(idx >> 7) * 132 + (idx & 127)] = w[i]; } }
    __syncthreads();
    { const int lane_ = tid & 63, w_ = tid >> 6, fr_ = lane_ & 15, fq_ = lane_ >> 4;
      f32x4 acc[4];
#pragma unroll
      for (int j = 0; j < 4; ++j) acc[j] = (f32x4){0.f, 0.f, 0.f, 0.f};
#define FOLD_SPLIT(src_, hi_, lo_) do { const f32x4 x0_ = *(const LAS f32x4*)(src_), x1_ = *(const LAS f32x4*)((src_) + 4); const float xs_[8] = {x0_[0], x0_[1], x0_[2], x0_[3], x1_[0], x1_[1], x1_[2], x1_[3]}; unsigned hw_[4], lw_[4]; \
        _Pragma("unroll") for (int e_ = 0; e_ < 4; ++e_) { hw_[e_] = hw_pk2(xs_[2 * e_], xs_[2 * e_ + 1]); lw_[e_] = hw_pk2(xs_[2 * e_] - bf_lo(hw_[e_]), xs_[2 * e_ + 1] - bf_hi(hw_[e_])); } \
        v4u th_, tl_; th_.x = hw_[0]; th_.y = hw_[1]; th_.z = hw_[2]; th_.w = hw_[3]; tl_.x = lw_[0]; tl_.y = lw_[1]; tl_.z = lw_[2]; tl_.w = lw_[3]; hi_ = __builtin_bit_cast(bf16x8, th_); lo_ = __builtin_bit_cast(bf16x8, tl_); } while (0)
#pragma unroll
      for (int ks = 0; ks < 4; ++ks) { bf16x8 ah, al; FOLD_SPLIT(SK + (16 * w_ + fr_) * 132 + 32 * ks + 8 * fq_, ah, al);
#pragma unroll
          for (int j = 0; j < 4; ++j) { bf16x8 bh, bl; FOLD_SPLIT(WQ + (16 * j + fr_) * 132 + 32 * ks + 8 * fq_, bh, bl);
              acc[j] = __builtin_amdgcn_mfma_f32_16x16x32_bf16(al, bh, acc[j], 0, 0, 0);
              acc[j] = __builtin_amdgcn_mfma_f32_16x16x32_bf16(ah, bl, acc[j], 0, 0, 0);
              acc[j] = __builtin_amdgcn_mfma_f32_16x16x32_bf16(ah, bh, acc[j], 0, 0, 0); } }
#undef FOLD_SPLIT
#pragma unroll
      for (int j = 0; j < 4; ++j)
#pragma unroll
          for (int r = 0; r < 4; ++r) WP[(size_t)(hp * 128 + 16 * w_ + 4 * fq_ + r) * D + k0 + 16 * j + fr_] = (bf16)f2bf(acc[j][r]); }
    __syncthreads();
}
__device__ __forceinline__ void p0_prologue(const Args& A, Frame& F, const int part) {
    const int gw = F.vcu * NWAVES + F.wave, NGW = F.G * NWAVES;
    const int gtid = gw * 64 + F.lane, gthreads = F.G * NTHREADS;
    unsigned char* ws = A.ws;
    LAS float* scr = (LAS float*)(F.lds + RING_OFF + F.wave * 16384);
    constexpr int I_EVIN = (D / 64) * (EV_N / 32);
    if (part == 1) {
        for (int it = gw; it < I_EVIN; it += NGW) p0_transpose_item_i8(A.in[I_EV_WIN], D, EV_N, (unsigned char*)(ws + WS_WEV_IN), scr, it, F.lane, (const float*)(ws + WS_CMB));
        rms_rows_to_i8(A.in[I_X], A.in[I_NMIX], (unsigned char*)(ws + WS_ACTA), (float*)(ws + WS_SA), gw, NGW, T, F.lane);
        return; }
    { constexpr int I_CM = (D / 64) * ((EV_N + 255) / 256);
      for (int it = gw; it < I_CM; it += NGW) colmax_item(A.in[I_EV_WIN], D, EV_N, (float*)(ws + WS_CMB), it, F.lane); }
    { GAS v4u* z0 = (GAS v4u*)(ws + WS_WEV_IN + (size_t)EV_N * D); const size_t n0 = (size_t)(EV_NP - EV_N) * D / 16;
      for (size_t i = gtid; i < n0; i += gthreads) z0[i] = (v4u){0u, 0u, 0u, 0u}; }
    { constexpr int I_PJ = (256 / 64) * (D / 32);
      for (int it = gw; it < 2 * I_PJ; it += NGW) { const int L = it / I_PJ; p0_transpose_item(A.in[I_PLE_WP] + (size_t)L * 256 * D, 256, D, (bf16*)(ws + WS_WPROJ) + (size_t)L * D * 256, scr, it % I_PJ, F.lane); } }
    if (F.G < 256) cvt_f32_bf16(A.in[I_P], (bf16*)(ws + WS_PBF), (size_t)2 * T * 256, gtid, gthreads);
#if EV_F8_T1 > EV_F8_T0
    for (int it = gw; it < I_EVIN; it += NGW) p0_transpose_item_f8(A.in[I_EV_WIN], D, EV_N, (unsigned char*)(ws + WS_O), scr, it, F.lane);
    { GAS v4u* z0 = (GAS v4u*)(ws + WS_O + (size_t)EV_N * D); const size_t n0 = (size_t)(EV_NP - EV_N) * D / 16;
      for (size_t i = gtid; i < n0; i += gthreads) z0[i] = (v4u){0u, 0u, 0u, 0u}; }
    for (int m = gw; m < T; m += NGW) rms_row_to_f8(A.in[I_X] + (size_t)m * D, A.in[I_NMIX], (unsigned char*)(ws + WS_H1) + (size_t)m * D, F.lane);
#endif
}
__device__ __forceinline__ void p0_deferred(const Args& A, Frame& F, int wg, int nwg) {
    const int gw = wg * NWAVES + F.wave, NGW = nwg * NWAVES;
    int gtid = gw * 64 + F.lane; const int gthreads = nwg * NTHREADS;
    asm volatile("" : "+v"(gtid));
    unsigned char* ws = A.ws;
    {
        LAS float* scr = (LAS float*)(F.lds + RING_OFF + F.wave * 16384);
        constexpr int I_SQ = (D / 64) * (D / 32), I_ODIN = (D / 64) * (OD_N / 32);
        constexpr int NITEMS = I_SQ + I_ODIN + I_SQ;
        for (int it = gw; it < NITEMS; it += NGW) {
            int r = it;
            if (r < I_SQ) { p0_transpose_item(A.in[I_EV_WOUT], D, D, (bf16*)(ws + WS_WEV_OUT), scr, r, F.lane); continue; } r -= I_SQ;
            if (r < I_ODIN) { p0_transpose_item_f8(A.in[I_OD_WIN], D, OD_N, (unsigned char*)(ws + WS_WOD_IN), scr, r, F.lane, A.in[I_NMIX] + D); continue; } r -= I_ODIN;
            p0_transpose_item_f8(A.in[I_PLE_WG], D, D, (unsigned char*)(ws + WS_WGATE), scr, r, F.lane, A.in[I_NPLE]);
        }
        { GAS v4u* z1 = (GAS v4u*)(ws + WS_WOD_IN + (size_t)OD_N * D); const size_t n1 = (size_t)(OD_NP - OD_N) * D / 16;
          for (size_t i = gtid; i < n1; i += gthreads) z1[i] = (v4u){0u, 0u, 0u, 0u}; }
    }
    __syncthreads();
    for (int it = wg; it < 512; it += nwg)
        p0_fold_item(A.in[I_PEER_WQ], A.in[I_PEER_SK], (bf16*)(ws + WS_WPEER), (LAS float*)(F.lds + RING_OFF), it, F.tid, A.in[I_NFFN]);
    cvt_rows_i8(A.in[I_PEER_U], (unsigned char*)(ws + WS_TABU), (float*)(ws + WS_SU), 16384, gw, NGW, F.lane, A.in[I_NFFN]);
    cvt_rows_i8(A.in[I_PEER_V], (unsigned char*)(ws + WS_TABV), (float*)(ws + WS_SU) + 32768, 16384, gw, NGW, F.lane, nullptr);
    { bf16* LB = (bf16*)(ws + WS_WLORA); const float* w2 = A.in[I_W2]; const float* a2 = A.in[I_A2]; const float* g2 = A.in[I_G2];
      for (int i = gtid; i < LORA_N * LORA_K / 2; i += gthreads) { const int row = i / (LORA_K / 2), col = (i % (LORA_K / 2)) * 2; float v[2];
#pragma unroll
          for (int e = 0; e < 2; ++e) { const int c = col + e; float x = 0.f;
              if (row < 1024) { if (c < 96) x = w2[c * 1024 + row]; }
              else if (row < 2048) { if (c >= 96 && c < 192) x = a2[(c - 96) * 1024 + (row - 1024)]; }
              else { if (c >= 192 && c < 448) x = g2[(c - 192) * 1024 + (row - 2048)]; }
              v[e] = x; }
          *(GAS unsigned*)(LB + (size_t)row * LORA_K + col) = pk2(v[0], v[1]); } }
}
__device__ __forceinline__ void p1_deferred(const Args& A, Frame& F, int wg, int nwg) {
    const int gw = wg * NWAVES + F.wave, NGW = nwg * NWAVES;
    int gtid = gw * 64 + F.lane; const int gthreads = nwg * NTHREADS;
    asm volatile("" : "+v"(gtid));
    unsigned char* ws = A.ws;
    { LAS float* scr = (LAS float*)(F.lds + RING_OFF + F.wave * 16384); constexpr int I_SQ = (D / 64) * (D / 32);
      for (int it = gw; it < 2 * I_SQ; it += NGW) {
          if (it < I_SQ) p0_transpose_item_f8(A.in[I_OD_WOUT], D, D, (unsigned char*)(ws + WS_WOD_OUT), scr, it, F.lane);
          else p0_transpose_item_f8(A.in[I_PLE_WG] + (size_t)D * D, D, D, (unsigned char*)((bf16*)(ws + WS_WGATE) + (size_t)D * D), scr, it - I_SQ, F.lane, A.in[I_NPLE] + D); } }
    __syncthreads();
    for (int it = wg; it < 512; it += nwg)
        p0_fold_item(A.in[I_PEER_WQ] + (size_t)D * D, A.in[I_PEER_SK] + (size_t)16 * 128 * 128, (bf16*)(ws + WS_WPEER) + (size_t)D * D, (LAS float*)(F.lds + RING_OFF), it, F.tid, A.in[I_NFFN] + D);
    cvt_rows_i8(A.in[I_PEER_U] + (size_t)16384 * D, (unsigned char*)(ws + WS_TABU) + (size_t)16384 * D, (float*)(ws + WS_SU) + 16384, 16384, gw, NGW, F.lane, A.in[I_NFFN] + D);
    cvt_rows_i8(A.in[I_PEER_V] + (size_t)16384 * D, (unsigned char*)(ws + WS_TABV) + (size_t)16384 * D, (float*)(ws + WS_SU) + 32768 + 16384, 16384, gw, NGW, F.lane, nullptr);
}

constexpr int TC = 16, NCHUNK = SEQ / TC;

template <int MODE>
__device__ __forceinline__ void scan_gla_unit(const Args& A, Frame& F, int unit) {
    int tid = F.tid; asm volatile("" : "+v"(tid));
    const int lane = tid & 63, w = F.wave;
    int b, h, qcol, kcol, vcol, ocol;
    if (MODE == 0) { b = unit >> 4; h = (unit >> 2) & 3; const int s = unit & 3; qcol = EC_GQ + h * 128; kcol = EC_GK + h * 128; vcol = EC_GV + h * 256 + s * 64; ocol = h * 256 + s * 64; }
    else           { b = unit >> 4; h = (unit >> 1) & 7; const int s = unit & 1; qcol = OC_HQ + h * 128; kcol = OC_HF + h * 128; vcol = OC_HI + h * 128 + s * 64; ocol = h * 128 + s * 64; }
    const bf16* P = (const bf16*)(A.ws + WS_PROJ) + (size_t)b * SEQ * PROJ_LD;
    float* O = (float*)(A.ws + WS_O) + (size_t)b * SEQ * D + ocol;
    LAS float* Lf = (LAS float*)(F.lds + RING_OFF);
    constexpr int BUFSZ = 7168, O_EG = 0, O_K = 2048, O_Q = 4096, O_V = 6144, O_OUT = 2 * BUFSZ, O_W2 = O_OUT + 1024, O_BIAS = O_W2 + 2048;
    const int tl = tid >> 5, dq = (tid & 31) * 4, tlv = tid >> 4, c4 = (tid & 15) * 4;
    float lb[4] = {0.f, 0.f, 0.f, 0.f};
    if (MODE == 0) {
        const float* w2 = A.in[I_GK_W2]; const float* gb = A.in[I_GK_B];
        for (int i = tid; i < 2048; i += NTHREADS) Lf[O_W2 + i] = w2[(i >> 7) * 512 + h * 128 + (i & 127)];
        if (tid < 128) Lf[O_BIAS + tid] = gb[h * 128 + tid];
    } else {
        const float* lg = A.in[I_LB];
#pragma unroll
        for (int i = 0; i < 4; ++i) lb[i] = sigmoidf_(lg[1024 + h * 128 + dq + i] - lg[h * 128 + dq + i]);
    }
    u32x2 rq, rk, rv = {0u, 0u}; v4u rg0 = {0u, 0u, 0u, 0u}, rg1 = {0u, 0u, 0u, 0u};
#define GLA_LOAD(c) do { const bf16* pr = P + (size_t)((c) * TC + tl) * PROJ_LD; rq = *(const GAS u32x2*)(pr + qcol + dq); rk = *(const GAS u32x2*)(pr + kcol + dq); \
        if (MODE == 0) { rg0 = *(const GAS v4u*)(pr + EC_GLR); rg1 = *(const GAS v4u*)(pr + EC_GLR + 8); } \
        if (tid < 256) rv = *(const GAS u32x2*)(P + (size_t)((c) * TC + tlv) * PROJ_LD + vcol + c4); } while (0)
#define GLA_XFORM(bufi) do { LAS float* B_ = Lf + (bufi) * BUFSZ; f32x4 q4, k4, e4; \
        const float xq[4] = {bf_lo(rq.x), bf_hi(rq.x), bf_lo(rq.y), bf_hi(rq.y)}, xk[4] = {bf_lo(rk.x), bf_hi(rk.x), bf_lo(rk.y), bf_hi(rk.y)}; \
        if (MODE == 0) { f32x4 z = *(const LAS f32x4*)(Lf + O_BIAS + dq); \
            const float gl[16] = {bf_lo(rg0.x), bf_hi(rg0.x), bf_lo(rg0.y), bf_hi(rg0.y), bf_lo(rg0.z), bf_hi(rg0.z), bf_lo(rg0.w), bf_hi(rg0.w), \
                                  bf_lo(rg1.x), bf_hi(rg1.x), bf_lo(rg1.y), bf_hi(rg1.y), bf_lo(rg1.z), bf_hi(rg1.z), bf_lo(rg1.w), bf_hi(rg1.w)}; \
            _Pragma("unroll") for (int r_ = 0; r_ < 16; ++r_) { const f32x4 wv = *(const LAS f32x4*)(Lf + O_W2 + r_ * 128 + dq); z = z + wv * gl[r_]; } \
            _Pragma("unroll") for (int i_ = 0; i_ < 4; ++i_) { q4[i_] = xq[i_] * 0.08838834764831845f; k4[i_] = xk[i_]; e4[i_] = __builtin_amdgcn_exp2f(-0.0625f * __builtin_amdgcn_logf(1.0f + __expf(-z[i_]))); } } \
        else { _Pragma("unroll") for (int i_ = 0; i_ < 4; ++i_) { const float fg = lb[i_] + (1.f - lb[i_]) * sigmoidf_(xk[i_]); q4[i_] = siluf_(xq[i_]); k4[i_] = 1.f - fg; e4[i_] = fg; } } \
        *(LAS f32x4*)(B_ + O_EG + tl * 128 + dq) = e4; *(LAS f32x4*)(B_ + O_K + tl * 128 + dq) = k4; *(LAS f32x4*)(B_ + O_Q + tl * 128 + dq) = q4; \
        if (tid < 256) { f32x4 v4 = {bf_lo(rv.x), bf_hi(rv.x), bf_lo(rv.y), bf_hi(rv.y)}; *(LAS f32x4*)(B_ + O_V + tlv * 64 + c4) = v4; } } while (0)
    LBAR();
    GLA_LOAD(0); GLA_XFORM(0);
    LBAR();
    f32x2 S2[8];
#pragma unroll
    for (int i = 0; i < 8; ++i) S2[i] = (f32x2){0.f, 0.f};
    const int j = lane & 15, col = w * 8 + (lane >> 4) * 2;
    for (int c = 0; c < NCHUNK; ++c) {
        if (c + 1 < NCHUNK) GLA_LOAD(c + 1);
        const LAS float* B_ = Lf + (c & 1) * BUFSZ;
        float os0 = 0.f, os1 = 0.f;
        f32x4 e0, e1, k0, k1, q0, q1, ne0, ne1, nk0, nk1, nq0, nq1; f32x2 v2, nv2;
#define GLA_LDSTEP(t_, E0, E1, K0, K1, Q0, Q1, V2) do { E0 = *(const LAS f32x4*)(B_ + O_EG + (t_) * 128 + 4 * j); E1 = *(const LAS f32x4*)(B_ + O_EG + (t_) * 128 + 64 + 4 * j); \
            K0 = *(const LAS f32x4*)(B_ + O_K + (t_) * 128 + 4 * j); K1 = *(const LAS f32x4*)(B_ + O_K + (t_) * 128 + 64 + 4 * j); \
            Q0 = *(const LAS f32x4*)(B_ + O_Q + (t_) * 128 + 4 * j); Q1 = *(const LAS f32x4*)(B_ + O_Q + (t_) * 128 + 64 + 4 * j); V2 = *(const LAS f32x2*)(B_ + O_V + (t_) * 64 + col); } while (0)
        GLA_LDSTEP(0, e0, e1, k0, k1, q0, q1, v2);
#pragma unroll
        for (int t = 0; t < TC; ++t) {
            if (t + 1 < TC) { GLA_LDSTEP(t + 1, ne0, ne1, nk0, nk1, nq0, nq1, nv2); }
            __builtin_amdgcn_sched_barrier(0);
            f32x2 pa = {0.f, 0.f}, pb = {0.f, 0.f};
#pragma unroll
            for (int i = 0; i < 4; ++i) {
                S2[i] = S2[i] * e0[i] + v2 * k0[i]; S2[4 + i] = S2[4 + i] * e1[i] + v2 * k1[i];
                pa += S2[i] * q0[i]; pb += S2[4 + i] * q1[i]; }
            pa += pb;
            float p0 = pa[0], p1 = pa[1];
            row_sum16_x2(p0, p1);
            os0 = (j == t) ? p0 : os0; os1 = (j == t) ? p1 : os1;
            e0 = ne0; e1 = ne1; k0 = nk0; k1 = nk1; q0 = nq0; q1 = nq1; v2 = nv2;
        }
#undef GLA_LDSTEP
        { f32x2 o2 = {os0, os1}; *(LAS f32x2*)(Lf + O_OUT + j * 64 + col) = o2; }
        if (c + 1 < NCHUNK) GLA_XFORM((c + 1) & 1);
        LBAR();
        if (tid < 256) *(GAS f32x4*)(O + (size_t)(c * TC + tlv) * D + c4) = *(const LAS f32x4*)(Lf + O_OUT + tlv * 64 + c4);
        LBAR();
    }
#undef GLA_LOAD
#undef GLA_XFORM
}

__device__ __forceinline__ void scan_gdn_unit(const Args& A, Frame& F, int unit) {
    int tid = F.tid; asm volatile("" : "+v"(tid));
    const int lane = tid & 63, w = F.wave;
    const int b = unit >> 4, h = (unit >> 1) & 7, s = unit & 1;
    const int qcol = EC_BQ + h * 128, kcol = EC_BK + h * 128, vcol = EC_BV + h * 128 + s * 64, ocol = 1024 + h * 128 + s * 64;
    const bf16* P = (const bf16*)(A.ws + WS_PROJ) + (size_t)b * SEQ * PROJ_LD;
    float* O = (float*)(A.ws + WS_O) + (size_t)b * SEQ * D + ocol;
    LAS float* Lf = (LAS float*)(F.lds + RING_OFF);
    constexpr int BUFSZ = 5184, O_K = 0, O_Q = 2048, O_V = 4096, O_SC = 5120, O_OUT = 2 * BUFSZ, O_CW = O_OUT + 1024;
    const int tl = tid >> 5, dq = (tid & 31) * 4, tlv = tid >> 4, c4 = (tid & 15) * 4;
    { const float* cw = A.in[I_GDN_CONV];
      for (int i = tid; i < 4 * 320; i += NTHREADS) { const int jt = i / 320, x = i % 320;
          const int ch = x < 128 ? (h * 128 + x) : x < 256 ? (1024 + h * 128 + (x - 128)) : (2048 + h * 128 + s * 64 + (x - 256));
          Lf[O_CW + i] = cw[jt * 3072 + ch]; } }
    const float neg_ea = -__expf(A.in[I_GDN_ALOG][h]), dtb = A.in[I_GDN_DTB][h];
    u32x2 rq[4], rk[4], rv[4]; unsigned short rba = 0, rbb = 0;
#pragma unroll
    for (int i = 0; i < 4; ++i) rv[i] = (u32x2){0u, 0u};
#define GDN_LOAD(c) do { const int t_ = (c) * TC + tl; \
        _Pragma("unroll") for (int jt = 0; jt < 4; ++jt) { const int tt = t_ - 3 + jt; \
            if (tt >= 0) { const bf16* pr = P + (size_t)tt * PROJ_LD; rq[jt] = *(const GAS u32x2*)(pr + qcol + dq); rk[jt] = *(const GAS u32x2*)(pr + kcol + dq); } \
            else { rq[jt] = (u32x2){0u, 0u}; rk[jt] = (u32x2){0u, 0u}; } } \
        { const bf16* pr = P + (size_t)t_ * PROJ_LD; rba = pr[EC_BA + h]; rbb = pr[EC_BB + h]; } \
        if (tid < 256) { const int tv = (c) * TC + tlv; \
            _Pragma("unroll") for (int jt = 0; jt < 4; ++jt) { const int tt = tv - 3 + jt; \
                if (tt >= 0) rv[jt] = *(const GAS u32x2*)(P + (size_t)tt * PROJ_LD + vcol + c4); else rv[jt] = (u32x2){0u, 0u}; } } } while (0)
#define GDN_XFORM(bufi) do { LAS float* B_ = Lf + (bufi) * BUFSZ; f32x4 q4 = {0.f, 0.f, 0.f, 0.f}, k4 = {0.f, 0.f, 0.f, 0.f}; \
        _Pragma("unroll") for (int jt = 0; jt < 4; ++jt) { const f32x4 wq = *(const LAS f32x4*)(Lf + O_CW + jt * 320 + dq), wk = *(const LAS f32x4*)(Lf + O_CW + jt * 320 + 128 + dq); \
            q4[0] += wq[0] * bf_lo(rq[jt].x); q4[1] += wq[1] * bf_hi(rq[jt].x); q4[2] += wq[2] * bf_lo(rq[jt].y); q4[3] += wq[3] * bf_hi(rq[jt].y); \
            k4[0] += wk[0] * bf_lo(rk[jt].x); k4[1] += wk[1] * bf_hi(rk[jt].x); k4[2] += wk[2] * bf_lo(rk[jt].y); k4[3] += wk[3] * bf_hi(rk[jt].y); } \
        float sq = 0.f, sk = 0.f, sqk = 0.f; \
        _Pragma("unroll") for (int i_ = 0; i_ < 4; ++i_) { q4[i_] = siluf_(q4[i_]); k4[i_] = siluf_(k4[i_]); sq += q4[i_] * q4[i_]; sk += k4[i_] * k4[i_]; sqk += q4[i_] * k4[i_]; } \
        sq = half_sum32(sq); sk = half_sum32(sk); sqk = half_sum32(sqk); \
        const float rq_ = __builtin_amdgcn_rsqf(sq + EPS) * 0.08838834764831845f, rk_ = __builtin_amdgcn_rsqf(sk + EPS); \
        q4 = q4 * rq_; k4 = k4 * rk_; \
        *(LAS f32x4*)(B_ + O_K + tl * 128 + dq) = k4; *(LAS f32x4*)(B_ + O_Q + tl * 128 + dq) = q4; \
        if ((tid & 31) == 0) { const float ba = __uint_as_float((unsigned)rba << 16), bb = __uint_as_float((unsigned)rbb << 16); \
            f32x4 sc; sc[0] = __expf(neg_ea * softplusf_(ba + dtb)); sc[1] = sigmoidf_(bb); sc[2] = sqk * rq_ * rk_; sc[3] = 0.f; *(LAS f32x4*)(B_ + O_SC + tl * 4) = sc; } \
        if (tid < 256) { f32x4 v4 = {0.f, 0.f, 0.f, 0.f}; \
            _Pragma("unroll") for (int jt = 0; jt < 4; ++jt) { const f32x4 wv = *(const LAS f32x4*)(Lf + O_CW + jt * 320 + 256 + c4); \
                v4[0] += wv[0] * bf_lo(rv[jt].x); v4[1] += wv[1] * bf_hi(rv[jt].x); v4[2] += wv[2] * bf_lo(rv[jt].y); v4[3] += wv[3] * bf_hi(rv[jt].y); } \
            _Pragma("unroll") for (int i_ = 0; i_ < 4; ++i_) v4[i_] = siluf_(v4[i_]); \
            *(LAS f32x4*)(B_ + O_V + tlv * 64 + c4) = v4; } } while (0)
    LBAR();
    GDN_LOAD(0); GDN_XFORM(0);
    LBAR();
    f32x2 S2[8];
#pragma unroll
    for (int i = 0; i < 8; ++i) S2[i] = (f32x2){0.f, 0.f};
    const int j = lane & 15, col = w * 8 + (lane >> 4) * 2;
    for (int c = 0; c < NCHUNK; ++c) {
        if (c + 1 < NCHUNK) GDN_LOAD(c + 1);
        const LAS float* B_ = Lf + (c & 1) * BUFSZ;
        float os0 = 0.f, os1 = 0.f;
        f32x4 k0, k1, q0, q1, sc, nk0, nk1, nq0, nq1, nsc; f32x2 v2, nv2;
#define GDN_LDSTEP(t_, K0, K1, Q0, Q1, V2, SC) do { K0 = *(const LAS f32x4*)(B_ + O_K + (t_) * 128 + 4 * j); K1 = *(const LAS f32x4*)(B_ + O_K + (t_) * 128 + 64 + 4 * j); \
            Q0 = *(const LAS f32x4*)(B_ + O_Q + (t_) * 128 + 4 * j); Q1 = *(const LAS f32x4*)(B_ + O_Q + (t_) * 128 + 64 + 4 * j); V2 = *(const LAS f32x2*)(B_ + O_V + (t_) * 64 + col); SC = *(const LAS f32x4*)(B_ + O_SC + (t_) * 4); } while (0)
        GDN_LDSTEP(0, k0, k1, q0, q1, v2, sc);
#pragma unroll
        for (int t = 0; t < TC; ++t) {
            if (t + 1 < TC) { GDN_LDSTEP(t + 1, nk0, nk1, nq0, nq1, nv2, nsc); }
            __builtin_amdgcn_sched_barrier(0);
            f32x2 d1 = {0.f, 0.f}, d2 = {0.f, 0.f}, e1 = {0.f, 0.f}, e2 = {0.f, 0.f};
#pragma unroll
            for (int i = 0; i < 4; ++i) { d1 += S2[i] * k0[i]; e1 += S2[4 + i] * k1[i]; d2 += S2[i] * q0[i]; e2 += S2[4 + i] * q1[i]; }
            d1 += e1; d2 += e2;
            { float r0_ = d1[0], r1_ = d1[1], r2_ = d2[0], r3_ = d2[1]; row_sum16_x4(r0_, r1_, r2_, r3_); d1[0] = r0_; d1[1] = r1_; d2[0] = r2_; d2[1] = r3_; }
            const float a = sc[0], beta = sc[1], qk = sc[2];
            const f32x2 dl = (v2 - d1 * a) * beta;
            const f32x2 o2 = d2 * a + dl * qk;
#pragma unroll
            for (int i = 0; i < 4; ++i) { S2[i] = S2[i] * a + dl * k0[i]; S2[4 + i] = S2[4 + i] * a + dl * k1[i]; }
            os0 = (j == t) ? o2[0] : os0; os1 = (j == t) ? o2[1] : os1;
            k0 = nk0; k1 = nk1; q0 = nq0; q1 = nq1; v2 = nv2; sc = nsc;
        }
#undef GDN_LDSTEP
        { f32x2 o2 = {os0, os1}; *(LAS f32x2*)(Lf + O_OUT + j * 64 + col) = o2; }
        if (c + 1 < NCHUNK) GDN_XFORM((c + 1) & 1);
        LBAR();
        if (tid < 256) *(GAS f32x4*)(O + (size_t)(c * TC + tlv) * D + c4) = *(const LAS f32x4*)(Lf + O_OUT + tlv * 64 + c4);
        LBAR();
    }
#undef GDN_LOAD
#undef GDN_XFORM
}

typedef short bf16x4_t __attribute__((ext_vector_type(4)));
__device__ __forceinline__ bf16x8 mk_frag(u32x2 lo, u32x2 hi) { v4u t; t.x = lo.x; t.y = lo.y; t.z = hi.x; t.w = hi.y; return __builtin_bit_cast(bf16x8, t); }
template <int MODE>
__device__ __forceinline__ void scan_gla_mfma_unit(const Args& A, Frame& F, int unit) {
    int tid = F.tid; asm volatile("" : "+v"(tid));
    const int lane = tid & 63, w = F.wave;
    int b, h, qcol, kcol, vcol, ocol;
    if (MODE == 0) { b = unit >> 3; h = (unit >> 1) & 3; const int s = unit & 1; qcol = EC_GQ + h * 128; kcol = EC_GK + h * 128; vcol = EC_GV + h * 256 + s * 128; ocol = h * 256 + s * 128; }
    else           { b = unit >> 3; h = unit & 7; qcol = OC_HQ + h * 128; kcol = OC_HF + h * 128; vcol = OC_HI + h * 128; ocol = h * 128; }
    const bf16* P = (const bf16*)(A.ws + WS_PROJ) + (size_t)b * SEQ * PROJ_LD;
    bf16* O = (bf16*)(A.ws + WS_O) + (size_t)b * SEQ * D + ocol;
    LAS float* Lf = (LAS float*)(F.lds + RING_OFF);
    constexpr int BUFSZ = MODE == 1 ? 10240 : 8192, O_E = 0, O_K = 2048, O_Q = 4096, O_V = 6144, O_Z = 8192, RS = 136,
        O_QB = 2 * BUFSZ, O_KB = O_QB + 1088, O_KT = O_KB + 1088, O_BL = O_KT + 1024, O_AM = O_BL + 128, O_W2 = O_AM + 128, O_BIAS = O_W2 + 2048;
    LAS bf16* QB = (LAS bf16*)(Lf + O_QB); LAS bf16* KB = (LAS bf16*)(Lf + O_KB); LAS bf16* KT = (LAS bf16*)(Lf + O_KT); LAS bf16* AM = (LAS bf16*)(Lf + O_AM);
    const int tl = tid >> 5, dq = (tid & 31) * 4;
    float lb[4] = {0.f, 0.f, 0.f, 0.f};
    if (MODE == 0) {
        const float* w2 = A.in[I_GK_W2]; const float* gb = A.in[I_GK_B];
        for (int i = tid; i < 2048; i += NTHREADS) Lf[O_W2 + i] = w2[(i >> 7) * 512 + h * 128 + (i & 127)];
        if (tid < 128) Lf[O_BIAS + tid] = gb[h * 128 + tid];
    } else {
        const float* lg = A.in[I_LB];
#pragma unroll
        for (int i = 0; i < 4; ++i) lb[i] = sigmoidf_(lg[1024 + h * 128 + dq + i] - lg[h * 128 + dq + i]);
    }
    u32x2 rq, rk, rv, rz = {0u, 0u}; v4u rg0 = {0u, 0u, 0u, 0u}, rg1 = {0u, 0u, 0u, 0u};
#define GM_LOAD(c) do { const bf16* pr = P + (size_t)((c) * TC + tl) * PROJ_LD; rq = *(const GAS u32x2*)(pr + qcol + dq); rk = *(const GAS u32x2*)(pr + kcol + dq); rv = *(const GAS u32x2*)(pr + vcol + dq); \
        if (MODE == 0) { rg0 = *(const GAS v4u*)(pr + EC_GLR); rg1 = *(const GAS v4u*)(pr + EC_GLR + 8); } else rz = *(const GAS u32x2*)(pr + OC_HG + h * 128 + dq); } while (0)
#define GM_XFORM(bufi) do { LAS float* B_ = Lf + (bufi) * BUFSZ; f32x4 q4, k4, e4; \
        const float xq[4] = {bf_lo(rq.x), bf_hi(rq.x), bf_lo(rq.y), bf_hi(rq.y)}, xk[4] = {bf_lo(rk.x), bf_hi(rk.x), bf_lo(rk.y), bf_hi(rk.y)}; \
        if (MODE == 0) { f32x4 z = *(const LAS f32x4*)(Lf + O_BIAS + dq); \
            const float gl[16] = {bf_lo(rg0.x), bf_hi(rg0.x), bf_lo(rg0.y), bf_hi(rg0.y), bf_lo(rg0.z), bf_hi(rg0.z), bf_lo(rg0.w), bf_hi(rg0.w), \
                                  bf_lo(rg1.x), bf_hi(rg1.x), bf_lo(rg1.y), bf_hi(rg1.y), bf_lo(rg1.z), bf_hi(rg1.z), bf_lo(rg1.w), bf_hi(rg1.w)}; \
            _Pragma("unroll") for (int r_ = 0; r_ < 16; ++r_) { const f32x4 wv = *(const LAS f32x4*)(Lf + O_W2 + r_ * 128 + dq); z = z + wv * gl[r_]; } \
            _Pragma("unroll") for (int i_ = 0; i_ < 4; ++i_) { q4[i_] = xq[i_] * 0.08838834764831845f; k4[i_] = xk[i_]; e4[i_] = __builtin_amdgcn_exp2f(-0.0625f * __builtin_amdgcn_logf(1.0f + __expf(-z[i_]))); } } \
        else { _Pragma("unroll") for (int i_ = 0; i_ < 4; ++i_) { const float fg = lb[i_] + (1.f - lb[i_]) * sigmoidf_(xk[i_]); q4[i_] = siluf_(xq[i_]); k4[i_] = 1.f - fg; e4[i_] = fg; } } \
        *(LAS f32x4*)(B_ + O_E + tl * 128 + dq) = e4; *(LAS f32x4*)(B_ + O_K + tl * 128 + dq) = k4; *(LAS f32x4*)(B_ + O_Q + tl * 128 + dq) = q4; \
        { f32x4 v4 = {bf_lo(rv.x), bf_hi(rv.x), bf_lo(rv.y), bf_hi(rv.y)}; *(LAS f32x4*)(B_ + O_V + tl * 128 + dq) = v4; } \
        if (MODE == 1) { f32x4 z4 = {siluf_(bf_lo(rz.x)), siluf_(bf_hi(rz.x)), siluf_(bf_lo(rz.y)), siluf_(bf_hi(rz.y))}; *(LAS f32x4*)(B_ + O_Z + tl * 128 + dq) = z4; } } while (0)
    LBAR();
    GM_LOAD(0); GM_XFORM(0); GM_LOAD(1);
    LBAR();
    f32x4 Sacc[8];
#pragma unroll
    for (int i = 0; i < 8; ++i) Sacc[i] = (f32x4){0.f, 0.f, 0.f, 0.f};
    const int fr = lane & 15, g = lane >> 4, c0 = w * 16;
    LAS float* PART = Lf + O_BIAS + 128;
    constexpr int SETD = (O_BIAS + 128 + 256) - O_QB;
    unsigned char* Y8 = (unsigned char*)(A.ws + WS_ACTA) + (size_t)b * SEQ * D + ocol;
    float gn = 0.f; f32x4 oprev = {0.f, 0.f, 0.f, 0.f}; float zprev[4] = {0.f, 0.f, 0.f, 0.f};
    if (MODE == 1) gn = A.in[I_HG_NORM][c0 + fr];
#define HG_FINISH(cc) do { const LAS float* pp_ = PART + ((cc) & 1) * 128; \
        _Pragma("unroll") for (int r = 0; r < 4; ++r) { const int t_ = 4 * g + r; const f32x4 p0_ = *(const LAS f32x4*)(pp_ + t_ * 8), p1_ = *(const LAS f32x4*)(pp_ + t_ * 8 + 4); \
            const float s_ = ((p0_[0] + p0_[1]) + (p0_[2] + p0_[3])) + ((p1_[0] + p1_[1]) + (p1_[2] + p1_[3])); const float rt_ = __builtin_amdgcn_rsqf(s_ * (1.0f / 128.0f) + EPS); \
            const float y_ = oprev[r] * rt_ * gn * zprev[r]; \
            Y8[(size_t)((cc) * TC + t_) * D + c0 + fr] = (unsigned char)(__builtin_amdgcn_cvt_pk_fp8_f32(y_, y_, 0, false) & 0xff); } } while (0)
#define GM_P1(cc) do { const LAS float* Bp_ = Lf + ((cc) & 1) * BUFSZ; const int so_ = ((cc) & 1) ? SETD : 0; LAS bf16* QBp_ = QB + 2 * so_; LAS bf16* KBp_ = KB + 2 * so_; LAS bf16* KTp_ = KT + 2 * so_; \
        const int seg = tid >> 7, d = tid & 127; \
        float bt = 1.f, ball = 1.f; \
        _Pragma("unroll") for (int t = 0; t < 16; ++t) { const float e = Bp_[O_E + t * 128 + d]; ball *= e; if (t < 4 * seg) bt = ball; } \
        ball = fmaxf(ball, 1e-30f); \
        unsigned short kt4[4]; \
        _Pragma("unroll") for (int i = 0; i < 4; ++i) { const int t = 4 * seg + i; bt = fmaxf(bt * Bp_[O_E + t * 128 + d], 1e-30f); \
            const float kk = Bp_[O_K + t * 128 + d], qq = Bp_[O_Q + t * 128 + d], ib = __builtin_amdgcn_rcpf(bt); \
            QBp_[t * RS + d] = hw_bf(qq * bt); KBp_[t * RS + d] = hw_bf(kk * ib); kt4[i] = (unsigned short)hw_bf(kk * ball * ib); } \
        u32x2 kw; kw.x = (unsigned)kt4[0] | ((unsigned)kt4[1] << 16); kw.y = (unsigned)kt4[2] | ((unsigned)kt4[3] << 16); \
        *(LAS u32x2*)(KTp_ + d * 16 + 4 * seg) = kw; \
        if (seg == 3) Lf[O_BL + so_ + d] = ball; } while (0)
    GM_P1(0);
    LBAR();
    for (int c = 0; c < NCHUNK; ++c) {
        const LAS float* B_ = Lf + (c & 1) * BUFSZ; const int so = (c & 1) ? SETD : 0;
        const LAS bf16* QBc = QB + 2 * so; const LAS bf16* KBc = KB + 2 * so; const LAS bf16* KTc = KT + 2 * so;
        if (MODE == 1 && c > 0) HG_FINISH(c - 1);
        if (w == 0) {
            f32x4 acc = {0.f, 0.f, 0.f, 0.f}; bf16x8 af[4], bfm[4];
#pragma unroll
            for (int ks = 0; ks < 4; ++ks) { af[ks] = *(const LAS bf16x8*)(QBc + fr * RS + 32 * ks + 8 * g); bfm[ks] = *(const LAS bf16x8*)(KBc + fr * RS + 32 * ks + 8 * g); }
            asm volatile("s_waitcnt lgkmcnt(0)" ::: "memory");
#pragma unroll
            for (int ks = 0; ks < 4; ++ks) acc = __builtin_amdgcn_mfma_f32_16x16x32_bf16(af[ks], bfm[ks], acc, 0, 0, 0);
#pragma unroll
            for (int r = 0; r < 4; ++r) { const int t = 4 * g + r, s = fr; AM[t * 16 + s] = hw_bf(s <= t ? acc[r] : 0.f); }
        }
        if (c + 1 < NCHUNK) GM_XFORM((c + 1) & 1);
        if (c + 2 < NCHUNK) GM_LOAD(c + 2);
        LBAR();
        {
            u32x2 vlo; { const float v0 = B_[O_V + (4 * g + 0) * 128 + c0 + fr], v1 = B_[O_V + (4 * g + 1) * 128 + c0 + fr], v2 = B_[O_V + (4 * g + 2) * 128 + c0 + fr], v3 = B_[O_V + (4 * g + 3) * 128 + c0 + fr];
                vlo.x = hw_pk2(v0, v1); vlo.y = hw_pk2(v2, v3); }
            const u32x2 zz = {0u, 0u};
            const bf16x8 vb = mk_frag(vlo, zz);
            f32x4 acco = {0.f, 0.f, 0.f, 0.f};
            u32x2 qlo[4], qhi[4];
#pragma unroll
            for (int ks = 0; ks < 4; ++ks) { qlo[ks] = *(const LAS u32x2*)(QBc + fr * RS + 32 * ks + 4 * g); qhi[ks] = *(const LAS u32x2*)(QBc + fr * RS + 32 * ks + 16 + 4 * g); }
            const u32x2 alo = *(const LAS u32x2*)(AM + fr * 16 + 4 * g);
#pragma unroll
            for (int ks = 0; ks < 4; ++ks) {
                u32x2 slo, shi; slo.x = hw_pk2(Sacc[2 * ks][0], Sacc[2 * ks][1]); slo.y = hw_pk2(Sacc[2 * ks][2], Sacc[2 * ks][3]); shi.x = hw_pk2(Sacc[2 * ks + 1][0], Sacc[2 * ks + 1][1]); shi.y = hw_pk2(Sacc[2 * ks + 1][2], Sacc[2 * ks + 1][3]);
                const bf16x8 sb = mk_frag(slo, shi);
                acco = __builtin_amdgcn_mfma_f32_16x16x32_bf16(mk_frag(qlo[ks], qhi[ks]), sb, acco, 0, 0, 0); }
            acco = __builtin_amdgcn_mfma_f32_16x16x32_bf16(mk_frag(alo, zz), vb, acco, 0, 0, 0);
#pragma unroll
            for (int r = 0; r < 4; ++r) { if (MODE == 0) O[(size_t)(c * TC + 4 * g + r) * D + c0 + fr] = hw_bf(acco[r]); }
            if (MODE == 1) { float q0 = acco[0] * acco[0], q1 = acco[1] * acco[1], q2 = acco[2] * acco[2], q3 = acco[3] * acco[3]; row_sum16_x4(q0, q1, q2, q3);
                if (fr == 0) { LAS float* pw_ = PART + (c & 1) * 128 + (4 * g) * 8 + w; pw_[0] = q0; pw_[8] = q1; pw_[16] = q2; pw_[24] = q3; }
                oprev = acco;
#pragma unroll
                for (int r = 0; r < 4; ++r) zprev[r] = B_[O_Z + (4 * g + r) * 128 + c0 + fr]; }
#pragma unroll
            for (int i = 0; i < 8; ++i) { const f32x4 bl = *(const LAS f32x4*)(Lf + O_BL + so + 16 * i + 4 * g); const u32x2 klo = *(const LAS u32x2*)(KTc + (16 * i + fr) * 16 + 4 * g);
                Sacc[i] = __builtin_amdgcn_mfma_f32_16x16x32_bf16(mk_frag(klo, zz), vb, Sacc[i] * bl, 0, 0, 0); }
        }
        if (c + 1 < NCHUNK) GM_P1(c + 1);
        LBAR();
    }
    if (MODE == 1) HG_FINISH(NCHUNK - 1);
#undef GM_P1
#undef HG_FINISH
#undef GM_LOAD
#undef GM_XFORM
}

__device__ __forceinline__ void scan_gdn_mfma_unit(const Args& A, Frame& F, int unit, const int role) {
    int tid = F.tid; asm volatile("" : "+v"(tid));
    const int lane = tid & 63, w = F.wave;
    const int b = unit >> 3, h = unit & 7;
    const int qcol = EC_BQ + h * 128, kcol = EC_BK + h * 128, vcol = EC_BV + h * 128, ocol = 1024 + h * 128;
    const bf16* P = (const bf16*)(A.ws + WS_PROJ) + (size_t)b * SEQ * PROJ_LD;
    bf16* O = (bf16*)(A.ws + WS_O) + (size_t)b * SEQ * D + ocol;
    LAS float* Lf = (LAS float*)(F.lds + RING_OFF);
    constexpr int O_CW = 0, O_AMAT = 1536, O_QKM = O_AMAT + 256, O_TB = O_QKM + 128, O_GL = O_TB + 128, O_BUF0 = O_GL + 64;
    constexpr int BUFSZ = 6208, O_KH = 0, O_QH = 2048, O_VV = 4096, O_SC = 6144;
    constexpr int RS = 136;
    constexpr int O_KHB = O_BUF0 + 2 * BUFSZ, O_QHB = O_KHB + 1088, O_QB = O_QHB + 1088, O_KT = O_QB + 1088, O_WSRC = O_KT + 1024, O_WB = O_WSRC + 2048;
    LAS bf16* KHB = (LAS bf16*)(Lf + O_KHB); LAS bf16* QHB = (LAS bf16*)(Lf + O_QHB); LAS bf16* QB = (LAS bf16*)(Lf + O_QB); LAS bf16* KT = (LAS bf16*)(Lf + O_KT);
    LAS bf16* WB = (LAS bf16*)(Lf + O_WB); LAS bf16* QKM = (LAS bf16*)(Lf + O_QKM); LAS bf16* TB = (LAS bf16*)(Lf + O_TB);
    const int tl = tid >> 5, dq = (tid & 31) * 4;
    { const float* cw = A.in[I_GDN_CONV];
      for (int i = tid; i < 4 * 384; i += NTHREADS) { const int jt = i / 384, x = i % 384; Lf[O_CW + i] = cw[jt * 3072 + (x >> 7) * 1024 + h * 128 + (x & 127)]; } }
    const float neg_ea = -__expf(A.in[I_GDN_ALOG][h]), dtb = A.in[I_GDN_DTB][h];
    u32x2 rq[4], rk[4], rv[4]; unsigned short rba = 0, rbb = 0;
#define GD_LOAD(c) do { const int t_ = (c) * TC + tl; \
        _Pragma("unroll") for (int jt = 0; jt < 4; ++jt) { const int tt = t_ - 3 + jt; const bf16* pr = P + (size_t)(tt < 0 ? 0 : tt) * PROJ_LD + dq; \
            rq[jt] = *(const GAS u32x2*)(pr + qcol); rk[jt] = *(const GAS u32x2*)(pr + kcol); rv[jt] = *(const GAS u32x2*)(pr + vcol); \
            if (tt < 0) { rq[jt] = (u32x2){0u, 0u}; rk[jt] = (u32x2){0u, 0u}; rv[jt] = (u32x2){0u, 0u}; } } \
        { const bf16* pr = P + (size_t)t_ * PROJ_LD; rba = pr[EC_BA + h]; rbb = pr[EC_BB + h]; } } while (0)
#define GD_XFORM(bufi) do { LAS float* B_ = Lf + O_BUF0 + (bufi) * BUFSZ; f32x4 q4 = {0.f, 0.f, 0.f, 0.f}, k4 = {0.f, 0.f, 0.f, 0.f}, v4 = {0.f, 0.f, 0.f, 0.f}; \
        _Pragma("unroll") for (int jt = 0; jt < 4; ++jt) { const f32x4 wq = *(const LAS f32x4*)(Lf + O_CW + jt * 384 + dq), wk = *(const LAS f32x4*)(Lf + O_CW + jt * 384 + 128 + dq), wv = *(const LAS f32x4*)(Lf + O_CW + jt * 384 + 256 + dq); \
            q4[0] += wq[0] * bf_lo(rq[jt].x); q4[1] += wq[1] * bf_hi(rq[jt].x); q4[2] += wq[2] * bf_lo(rq[jt].y); q4[3] += wq[3] * bf_hi(rq[jt].y); \
            k4[0] += wk[0] * bf_lo(rk[jt].x); k4[1] += wk[1] * bf_hi(rk[jt].x); k4[2] += wk[2] * bf_lo(rk[jt].y); k4[3] += wk[3] * bf_hi(rk[jt].y); \
            v4[0] += wv[0] * bf_lo(rv[jt].x); v4[1] += wv[1] * bf_hi(rv[jt].x); v4[2] += wv[2] * bf_lo(rv[jt].y); v4[3] += wv[3] * bf_hi(rv[jt].y); } \
        float sq = 0.f, sk = 0.f; \
        _Pragma("unroll") for (int i_ = 0; i_ < 4; ++i_) { q4[i_] = siluf_(q4[i_]); k4[i_] = siluf_(k4[i_]); v4[i_] = siluf_(v4[i_]); sq += q4[i_] * q4[i_]; sk += k4[i_] * k4[i_]; } \
        row_sum16_x2(sq, sk); sq += __shfl_xor(sq, 16); sk += __shfl_xor(sk, 16); \
        q4 = q4 * (__builtin_amdgcn_rsqf(sq + EPS) * 0.08838834764831845f); k4 = k4 * __builtin_amdgcn_rsqf(sk + EPS); \
        *(LAS f32x4*)(B_ + O_KH + tl * 128 + dq) = k4; *(LAS f32x4*)(B_ + O_QH + tl * 128 + dq) = q4; *(LAS f32x4*)(B_ + O_VV + tl * 128 + dq) = v4; \
        if ((tid & 31) == 0) { const float ba = __uint_as_float((unsigned)rba << 16), bb = __uint_as_float((unsigned)rbb << 16); \
            B_[O_SC + tl] = __expf(neg_ea * softplusf_(ba + dtb)); B_[O_SC + 16 + tl] = sigmoidf_(bb); } } while (0)
    LBAR();
    constexpr int S1 = GDN_S1, S2 = GDN_S2;
    static_assert(S1 >= 2 && S2 - S1 >= 2 && NCHUNK - S2 >= 2 && S2 - S1 <= 48 && NCHUNK - S2 <= 84, "GDN split (stash regions: role 1 in the H1 buffer, role 2 in the lora buffers)");
    const int c_begin = role == 0 ? 0 : (role == 1 ? S1 : S2), c_end = role == 0 ? S1 : (role == 1 ? S2 : NCHUNK);
    constexpr int REC = 5408;
    float* STASH = role == 1 ? (float*)(A.ws + WS_H1) + (size_t)unit * (S2 - S1) * REC : (float*)(A.ws + WS_LA) + (size_t)unit * (NCHUNK - S2) * REC;
    float* STATE = (float*)(A.ws + WS_STATE) + (size_t)((role == 2 ? 1 : 0) * 64 + unit) * 16384;
    float* STATE_OUT = (float*)(A.ws + WS_STATE) + (size_t)(64 + unit) * 16384;
    gu32* flag = F.ctl + 32768 + unit * 64 + (role == 2 ? 16 : 0); gu32* flag_out = F.ctl + 32768 + unit * 64 + 16;
    GD_LOAD(c_begin); GD_XFORM(c_begin & 1); GD_LOAD(c_begin + 1);
    LBAR();
    f32x4 Sacc[8];
#pragma unroll
    for (int i = 0; i < 8; ++i) Sacc[i] = (f32x4){0.f, 0.f, 0.f, 0.f};
    const int fr = lane & 15, g = lane >> 4, c0 = w * 16;
    const u32x2 zz = {0u, 0u};
#define GD_STATE_PART(cc_) do { \
        { \
            bf16x8 sb[4]; \
_Pragma("unroll") \
            for (int ks = 0; ks < 4; ++ks) { u32x2 slo, shi; slo.x = hw_pk2(Sacc[2 * ks][0], Sacc[2 * ks][1]); slo.y = hw_pk2(Sacc[2 * ks][2], Sacc[2 * ks][3]); shi.x = hw_pk2(Sacc[2 * ks + 1][0], Sacc[2 * ks + 1][1]); shi.y = hw_pk2(Sacc[2 * ks + 1][2], Sacc[2 * ks + 1][3]); \
                sb[ks] = mk_frag(slo, shi); } \
            f32x4 accv = accu, acco = {0.f, 0.f, 0.f, 0.f}; \
_Pragma("unroll") \
            for (int ks = 0; ks < 4; ++ks) { \
                const u32x2 wl = *(const LAS u32x2*)(WB + fr * RS + 32 * ks + 4 * g), wh = *(const LAS u32x2*)(WB + fr * RS + 32 * ks + 16 + 4 * g); \
                accv = __builtin_amdgcn_mfma_f32_16x16x32_bf16(mk_frag(wl, wh), sb[ks], accv, 0, 0, 0); \
                const u32x2 ql = *(const LAS u32x2*)(QB + fr * RS + 32 * ks + 4 * g), qh = *(const LAS u32x2*)(QB + fr * RS + 32 * ks + 16 + 4 * g); \
                acco = __builtin_amdgcn_mfma_f32_16x16x32_bf16(mk_frag(ql, qh), sb[ks], acco, 0, 0, 0); } \
            u32x2 vn; vn.x = hw_pk2(accv[0], accv[1]); vn.y = hw_pk2(accv[2], accv[3]); \
            const bf16x8 vnb = mk_frag(vn, zz); \
            acco = __builtin_amdgcn_mfma_f32_16x16x32_bf16(mk_frag(*(const LAS u32x2*)(QKM + fr * 16 + 4 * g), zz), vnb, acco, 0, 0, 0); \
_Pragma("unroll") \
            for (int r = 0; r < 4; ++r) O[(size_t)((cc_) * TC + 4 * g + r) * D + c0 + fr] = hw_bf(acco[r]); \
_Pragma("unroll") \
            for (int i = 0; i < 8; ++i) { const u32x2 klo = *(const LAS u32x2*)(KT + (16 * i + fr) * 16 + 4 * g); \
                Sacc[i] = __builtin_amdgcn_mfma_f32_16x16x32_bf16(mk_frag(klo, zz), vnb, Sacc[i] * glast, 0, 0, 0); } \
        } \
        } while (0)
    for (int c = c_begin; c < c_end; ++c) {
        const LAS float* B_ = Lf + O_BUF0 + (c & 1) * BUFSZ;
        float glast;
        {
            const int seg = tid >> 7, d = tid & 127;
            const f32x4 a0 = *(const LAS f32x4*)(B_ + O_SC), a1 = *(const LAS f32x4*)(B_ + O_SC + 4), a2 = *(const LAS f32x4*)(B_ + O_SC + 8), a3 = *(const LAS f32x4*)(B_ + O_SC + 12);
            const float av[16] = {a0[0], a0[1], a0[2], a0[3], a1[0], a1[1], a1[2], a1[3], a2[0], a2[1], a2[2], a2[3], a3[0], a3[1], a3[2], a3[3]};
            float p = 1.f, gpre = 1.f;
#pragma unroll
            for (int t = 0; t < 16; ++t) { if (t == 4 * seg) gpre = p; p *= av[t]; }
            glast = p;
            unsigned short kt4[4]; float gt = gpre;
#pragma unroll
            for (int i = 0; i < 4; ++i) { const int t = 4 * seg + i; const float at = (seg == 0) ? av[i] : (seg == 1) ? av[4 + i] : (seg == 2) ? av[8 + i] : av[12 + i]; gt *= at; const float beta = B_[O_SC + 16 + t];
                const float kk = B_[O_KH + t * 128 + d], qq = B_[O_QH + t * 128 + d];
                KHB[t * RS + d] = hw_bf(kk); QHB[t * RS + d] = hw_bf(qq); QB[t * RS + d] = hw_bf(qq * gt);
                kt4[i] = (unsigned short)hw_bf(kk * glast * __builtin_amdgcn_rcpf(gt));
                Lf[O_WSRC + t * 128 + d] = kk * (beta * gt);
                if (d == 0) Lf[O_GL + t] = gt; }
            u32x2 kw; kw.x = (unsigned)kt4[0] | ((unsigned)kt4[1] << 16); kw.y = (unsigned)kt4[2] | ((unsigned)kt4[3] << 16);
            *(LAS u32x2*)(KT + d * 16 + 4 * seg) = kw;
        }
        LBAR();
        if (w < 2) {
            const LAS bf16* AS = (w == 0) ? KHB : QHB;
            f32x4 acc = {0.f, 0.f, 0.f, 0.f};
#pragma unroll
            for (int ks = 0; ks < 4; ++ks) { const bf16x8 af = *(const LAS bf16x8*)(AS + fr * RS + 32 * ks + 8 * g), bfm = *(const LAS bf16x8*)(KHB + fr * RS + 32 * ks + 8 * g);
                acc = __builtin_amdgcn_mfma_f32_16x16x32_bf16(af, bfm, acc, 0, 0, 0); }
            const float gs_inv = __builtin_amdgcn_rcpf(Lf[O_GL + fr]);
            if (w == 0) {
                f32x4 N1, M1;
#pragma unroll
                for (int r = 0; r < 4; ++r) { const int t = 4 * g + r; const float gt = Lf[O_GL + t];
                    N1[r] = (fr < t) ? -(B_[O_SC + 16 + t] * acc[r] * gt * gs_inv) : 0.f;
                    M1[r] = (t < fr) ? -(B_[O_SC + 16 + fr] * acc[r] * Lf[O_GL + fr] * __builtin_amdgcn_rcpf(gt)) : 0.f; }
#define XTY(X, Y, C0) __builtin_amdgcn_mfma_f32_16x16x32_bf16(mk_frag((u32x2){hw_pk2(X[0], X[1]), hw_pk2(X[2], X[3])}, zz), mk_frag((u32x2){hw_pk2(Y[0], Y[1]), hw_pk2(Y[2], Y[3])}, zz), C0, 0, 0, 0)
                const f32x4 z4 = {0.f, 0.f, 0.f, 0.f};
                f32x4 T1t = M1;
#pragma unroll
                for (int r = 0; r < 4; ++r) if (4 * g + r == fr) T1t[r] += 1.f;
                const f32x4 N2 = XTY(M1, N1, z4), M2 = XTY(N1, M1, z4);
                const f32x4 T2t = XTY(N2, T1t, T1t);
                const f32x4 N4 = XTY(M2, N2, z4), M4 = XTY(N2, M2, z4);
                const f32x4 T4t = XTY(N4, T2t, T2t);
                const f32x4 N8 = XTY(M4, N4, z4);
                const f32x4 T8t = XTY(N8, T4t, T4t);
#undef XTY
                u32x2 tw; tw.x = hw_pk2(T8t[0], T8t[1]); tw.y = hw_pk2(T8t[2], T8t[3]);
                *(LAS u32x2*)(TB + fr * 16 + 4 * g) = tw;
            } else {
#pragma unroll
                for (int r = 0; r < 4; ++r) { const int t = 4 * g + r; QKM[t * 16 + fr] = hw_bf((fr <= t) ? acc[r] * Lf[O_GL + t] * gs_inv : 0.f); }
            }
        }
        if (c + 1 < c_end) GD_XFORM((c + 1) & 1);
        if (c + 2 < c_end) GD_LOAD(c + 2);
        LBAR();
        f32x4 accu = {0.f, 0.f, 0.f, 0.f};
        {
            const bf16x8 tf = mk_frag(*(const LAS u32x2*)(TB + fr * 16 + 4 * g), zz);
            u32x2 ulo, wlo;
            { const float b0 = B_[O_SC + 16 + 4 * g + 0], b1 = B_[O_SC + 16 + 4 * g + 1], b2 = B_[O_SC + 16 + 4 * g + 2], b3 = B_[O_SC + 16 + 4 * g + 3];
              ulo.x = hw_pk2(b0 * B_[O_VV + (4 * g + 0) * 128 + c0 + fr], b1 * B_[O_VV + (4 * g + 1) * 128 + c0 + fr]); ulo.y = hw_pk2(b2 * B_[O_VV + (4 * g + 2) * 128 + c0 + fr], b3 * B_[O_VV + (4 * g + 3) * 128 + c0 + fr]);
              wlo.x = hw_pk2(Lf[O_WSRC + (4 * g + 0) * 128 + c0 + fr], Lf[O_WSRC + (4 * g + 1) * 128 + c0 + fr]); wlo.y = hw_pk2(Lf[O_WSRC + (4 * g + 2) * 128 + c0 + fr], Lf[O_WSRC + (4 * g + 3) * 128 + c0 + fr]); }
            accu = __builtin_amdgcn_mfma_f32_16x16x32_bf16(tf, mk_frag(ulo, zz), accu, 0, 0, 0);
            f32x4 accw = {0.f, 0.f, 0.f, 0.f};
            accw = __builtin_amdgcn_mfma_f32_16x16x32_bf16(tf, mk_frag(wlo, zz), accw, 0, 0, 0);
#pragma unroll
            for (int r = 0; r < 4; ++r) WB[(4 * g + r) * RS + c0 + fr] = hw_bf(-accw[r]);
        }
        LBAR();
        if (role == 0) {
            GD_STATE_PART(c);
        } else {
            float* rec = STASH + (size_t)(c - c_begin) * REC;
            for (int i = tid; i < 832; i += NTHREADS) { const int o = i < 528 ? O_QB + 4 * i : (i < 800 ? O_WB + 4 * (i - 528) : O_QKM + 4 * (i - 800)); *(GAS f32x4*)(rec + 4 * i) = *(const LAS f32x4*)(Lf + o); }
#pragma unroll
            for (int r = 0; r < 4; ++r) rec[3328 + (w * 4 + r) * 64 + lane] = accu[r];
            if (tid == 0) rec[5376] = glast;
        }
        LBAR();
    }
#define GD_PUBLISH(ST_, FL_) do { \
        _Pragma("unroll") for (int i = 0; i < 8; ++i) _Pragma("unroll") for (int r = 0; r < 4; ++r) (ST_)[((w * 8 + i) * 4 + r) * 64 + lane] = Sacc[i][r]; \
        asm volatile("s_waitcnt vmcnt(0)" ::: "memory"); \
        __syncthreads(); \
        if (tid == 0) { __builtin_amdgcn_fence(__ATOMIC_RELEASE, "agent"); asm volatile("s_waitcnt vmcnt(0)" ::: "memory"); __hip_atomic_store((FL_), 1u, __ATOMIC_RELAXED, __HIP_MEMORY_SCOPE_AGENT); } } while (0)
    if (role == 0) {
        GD_PUBLISH(STATE, flag);
    } else {
        if (tid == 0) { unsigned sp = 0; while (__hip_atomic_load(flag, __ATOMIC_RELAXED, __HIP_MEMORY_SCOPE_AGENT) == 0u) { __builtin_amdgcn_s_sleep(8); if (++sp > (1u << 22)) break; }
            __builtin_amdgcn_fence(__ATOMIC_ACQUIRE, "agent"); asm volatile("s_waitcnt vmcnt(0)" ::: "memory"); }
        __syncthreads();
#pragma unroll
        for (int i = 0; i < 8; ++i)
#pragma unroll
            for (int r = 0; r < 4; ++r) Sacc[i][r] = STATE[((w * 8 + i) * 4 + r) * 64 + lane];
        f32x4 pa, pb; f32x4 pu; float pg;
#define GD_REC_LOAD(cc) do { const float* rec = STASH + (size_t)((cc) - c_begin) * REC; pa = *(const GAS f32x4*)(rec + 4 * tid); pb = (tid < 320) ? *(const GAS f32x4*)(rec + 4 * (tid + 512)) : (f32x4){0.f, 0.f, 0.f, 0.f}; \
            _Pragma("unroll") for (int r = 0; r < 4; ++r) pu[r] = rec[3328 + (w * 4 + r) * 64 + lane]; pg = rec[5376]; } while (0)
        GD_REC_LOAD(c_begin);
        for (int c = c_begin; c < c_end; ++c) {
            { const int i0 = tid, o0 = i0 < 528 ? O_QB + 4 * i0 : O_WB + 4 * (i0 - 528); *(LAS f32x4*)(Lf + o0) = pa;
              if (tid < 320) { const int i1 = tid + 512; const int o1 = i1 < 528 ? O_QB + 4 * i1 : (i1 < 800 ? O_WB + 4 * (i1 - 528) : O_QKM + 4 * (i1 - 800)); *(LAS f32x4*)(Lf + o1) = pb; } }
            const f32x4 accu = pu; const float glast = pg;
            if (c + 1 < c_end) GD_REC_LOAD(c + 1);
            LBAR();
            GD_STATE_PART(c);
            LBAR();
        }
#undef GD_REC_LOAD
        if (role == 1) GD_PUBLISH(STATE_OUT, flag_out);
    }
#undef GD_PUBLISH
#undef GD_STATE_PART
#undef GD_LOAD
#undef GD_XFORM
}

__device__ __forceinline__ void scan_rwkv_unit(const Args& A, Frame& F, int unit) {
    int tid = F.tid; asm volatile("" : "+v"(tid));
    const int lane = tid & 63, w = F.wave;
    const int b = unit >> 4, h = unit & 15;
    const bf16* P = (const bf16*)(A.ws + WS_PROJ) + (size_t)b * SEQ * PROJ_LD + OC_RW;
    const bf16* LO = (const bf16*)(A.ws + WS_LO) + (size_t)b * SEQ * LORA_N;
    bf16* Y = (bf16*)(A.ws + WS_ACTA) + (size_t)b * SEQ * D + 1024 + h * 64;
    LAS float* Lf = (LAS float*)(F.lds + RING_OFF);
    constexpr int BUFSZ = 6208, O_KK = 0, O_WR = 1024, O_W = 2048, O_NKA = 3072, O_K = 4096, O_V = 5120, O_SC = 6144, O_OUT = 2 * BUFSZ;
    const int tl = tid >> 5, d2 = (tid & 31) * 2, hd = h * 64 + d2;
    float mu_r[2], mu_k[2], mu_v[2], w0[2], a0[2], k_k[2], k_a[2], r_k[2], lnw[2], lnb[2];
#pragma unroll
    for (int i = 0; i < 2; ++i) { mu_r[i] = A.in[I_MU][RW_R + hd + i]; mu_k[i] = A.in[I_MU][RW_K + hd + i]; mu_v[i] = A.in[I_MU][RW_V + hd + i];
        w0[i] = A.in[I_W0][hd + i]; a0[i] = A.in[I_A0][hd + i]; k_k[i] = A.in[I_KK][hd + i]; k_a[i] = A.in[I_KA][hd + i]; r_k[i] = A.in[I_RK][hd + i];
        lnw[i] = A.in[I_LNW][hd + i]; lnb[i] = A.in[I_LNB][hd + i]; }
    unsigned rr[2], rk[2], rv[2], rlw, rla, rg_cur = 0u, rg_nxt = 0u;
#define RW_LOAD(c) do { const int t_ = (c) * TC + tl; const bf16* pr = P + (size_t)t_ * PROJ_LD; \
        rr[0] = *(const GAS unsigned*)(pr + RW_R + hd); rk[0] = *(const GAS unsigned*)(pr + RW_K + hd); rv[0] = *(const GAS unsigned*)(pr + RW_V + hd); \
        if (t_ > 0) { rr[1] = *(const GAS unsigned*)(pr - PROJ_LD + RW_R + hd); rk[1] = *(const GAS unsigned*)(pr - PROJ_LD + RW_K + hd); rv[1] = *(const GAS unsigned*)(pr - PROJ_LD + RW_V + hd); } \
        else { rr[1] = 0u; rk[1] = 0u; rv[1] = 0u; } \
        const bf16* lr = LO + (size_t)t_ * LORA_N; rlw = *(const GAS unsigned*)(lr + hd); rla = *(const GAS unsigned*)(lr + 1024 + hd); rg_nxt = *(const GAS unsigned*)(lr + 2048 + hd); } while (0)
#define RW_XFORM(bufi) do { LAS float* B_ = Lf + (bufi) * BUFSZ; f32x2 kk2, wr2, w2_, nka2, k2, v2_; float skk = 0.f, sc1 = 0.f, sc2 = 0.f, sbs = 0.f; float aa[2], rrv[2]; \
        _Pragma("unroll") for (int i_ = 0; i_ < 2; ++i_) { \
            const float r0 = i_ ? bf_hi(rr[0]) : bf_lo(rr[0]), r1 = i_ ? bf_hi(rr[1]) : bf_lo(rr[1]); \
            const float k0_ = i_ ? bf_hi(rk[0]) : bf_lo(rk[0]), k1_ = i_ ? bf_hi(rk[1]) : bf_lo(rk[1]); \
            const float v0_ = i_ ? bf_hi(rv[0]) : bf_lo(rv[0]), v1_ = i_ ? bf_hi(rv[1]) : bf_lo(rv[1]); \
            const float lw = i_ ? bf_hi(rlw) : bf_lo(rlw), la = i_ ? bf_hi(rla) : bf_lo(rla); \
            const float r_ = r0 + (r1 - r0) * mu_r[i_], kx = k0_ + (k1_ - k0_) * mu_k[i_], vx = v0_ + (v1_ - v0_) * mu_v[i_]; \
            const float wd = __expf(-0.6065306597126334f * sigmoidf_(w0[i_] + lw)); const float a_ = sigmoidf_(a0[i_] + la); \
            const float kk0 = kx * k_k[i_]; const float km = kx * (1.f + (a_ - 1.f) * k_a[i_]); \
            kk2[i_] = kk0; skk += kk0 * kk0; aa[i_] = a_; rrv[i_] = r_; wr2[i_] = wd * r_; w2_[i_] = wd; k2[i_] = km; v2_[i_] = vx; sc2 += km * r_; sbs += r_ * km * r_k[i_]; } \
        skk = half_sum32(skk); const float rkk = __builtin_amdgcn_rsqf(skk + EPS); \
        _Pragma("unroll") for (int i_ = 0; i_ < 2; ++i_) { kk2[i_] *= rkk; nka2[i_] = -(kk2[i_] * aa[i_]); sc1 += kk2[i_] * aa[i_] * rrv[i_]; } \
        sc1 = half_sum32(sc1); sc2 = half_sum32(sc2); sbs = half_sum32(sbs); \
        *(LAS f32x2*)(B_ + O_KK + tl * 64 + d2) = kk2; *(LAS f32x2*)(B_ + O_WR + tl * 64 + d2) = wr2; *(LAS f32x2*)(B_ + O_W + tl * 64 + d2) = w2_; \
        *(LAS f32x2*)(B_ + O_NKA + tl * 64 + d2) = nka2; *(LAS f32x2*)(B_ + O_K + tl * 64 + d2) = k2; *(LAS f32x2*)(B_ + O_V + tl * 64 + d2) = v2_; \
        if ((tid & 31) == 0) { f32x4 sc; sc[0] = sc1; sc[1] = sc2; sc[2] = sbs; sc[3] = 0.f; *(LAS f32x4*)(B_ + O_SC + tl * 4) = sc; } } while (0)
    RW_LOAD(0); RW_XFORM(0); rg_cur = rg_nxt;
    LBAR();
    f32x2 S2[4];
#pragma unroll
    for (int i = 0; i < 4; ++i) S2[i] = (f32x2){0.f, 0.f};
    const int j = lane & 15, col = w * 8 + (lane >> 4) * 2;
    for (int c = 0; c < NCHUNK; ++c) {
        if (c + 1 < NCHUNK) RW_LOAD(c + 1);
        const LAS float* B_ = Lf + (c & 1) * BUFSZ;
        float os0 = 0.f, os1 = 0.f;
        f32x4 kk, wr, ww, nka, kv, sc, nkk, nwr, nww, nnka, nkv, nsc; f32x2 v2, nv2;
#define RW_LDSTEP(t_, KK, WR, WW, NKA, KV, V2, SC) do { KK = *(const LAS f32x4*)(B_ + O_KK + (t_) * 64 + 4 * j); WR = *(const LAS f32x4*)(B_ + O_WR + (t_) * 64 + 4 * j); WW = *(const LAS f32x4*)(B_ + O_W + (t_) * 64 + 4 * j); \
            NKA = *(const LAS f32x4*)(B_ + O_NKA + (t_) * 64 + 4 * j); KV = *(const LAS f32x4*)(B_ + O_K + (t_) * 64 + 4 * j); V2 = *(const LAS f32x2*)(B_ + O_V + (t_) * 64 + col); SC = *(const LAS f32x4*)(B_ + O_SC + (t_) * 4); } while (0)
        RW_LDSTEP(0, kk, wr, ww, nka, kv, v2, sc);
#pragma unroll
        for (int t = 0; t < TC; ++t) {
            if (t + 1 < TC) { RW_LDSTEP(t + 1, nkk, nwr, nww, nnka, nkv, nv2, nsc); }
            __builtin_amdgcn_sched_barrier(0);
            f32x2 d1 = S2[0] * kk[0], d2 = S2[0] * wr[0], e1 = S2[1] * kk[1], e2 = S2[1] * wr[1];
            d1 += S2[2] * kk[2]; d2 += S2[2] * wr[2]; e1 += S2[3] * kk[3]; e2 += S2[3] * wr[3];
            d1 += e1; d2 += e2;
            { float r0_ = d1[0], r1_ = d1[1], r2_ = d2[0], r3_ = d2[1]; row_sum16_x4(r0_, r1_, r2_, r3_); d1[0] = r0_; d1[1] = r1_; d2[0] = r2_; d2[1] = r3_; }
            const f32x2 o2 = d2 - d1 * sc[0] + v2 * sc[1];
#pragma unroll
            for (int i = 0; i < 4; ++i) S2[i] = S2[i] * ww[i] + d1 * nka[i] + v2 * kv[i];
            os0 = (j == t) ? o2[0] : os0; os1 = (j == t) ? o2[1] : os1;
            kk = nkk; wr = nwr; ww = nww; nka = nnka; kv = nkv; v2 = nv2; sc = nsc;
        }
#undef RW_LDSTEP
        { f32x2 o2 = {os0, os1}; *(LAS f32x2*)(Lf + O_OUT + j * 64 + col) = o2; }
        if (c + 1 < NCHUNK) RW_XFORM((c + 1) & 1);
        LBAR();
        {
            const f32x2 o2 = *(const LAS f32x2*)(Lf + O_OUT + tl * 64 + d2); const f32x2 vv = *(const LAS f32x2*)(B_ + O_V + tl * 64 + d2); const float bs = B_[O_SC + tl * 4 + 2];
            const float mean = half_sum32(o2[0] + o2[1]) * (1.0f / 64.0f); const float e0 = o2[0] - mean, e1 = o2[1] - mean;
            const float var = half_sum32(e0 * e0 + e1 * e1) * (1.0f / 64.0f); const float rs = __builtin_amdgcn_rsqf(var + 64e-5f);
            const float y0 = (e0 * rs * lnw[0] + lnb[0] + bs * vv[0]) * bf_lo(rg_cur), y1 = (e1 * rs * lnw[1] + lnb[1] + bs * vv[1]) * bf_hi(rg_cur);
            *(GAS unsigned*)(Y + (size_t)(c * TC + tl) * D + d2) = pk2(y0, y1);
        }
        rg_cur = rg_nxt;
        LBAR();
    }
#undef RW_LOAD
#undef RW_XFORM
}

template <int LAYER>
__device__ __forceinline__ void post_rows(const Args& A, Frame& F) {
    const int gw = F.vcu * NWAVES + F.wave, NGW = F.G * NWAVES, lane = F.lane;
    const bf16* O = (const bf16*)(A.ws + WS_O); const bf16* P = (const bf16*)(A.ws + WS_PROJ); bf16* Y = (bf16*)(A.ws + WS_ACTA);
    for (int m = gw; m < T; m += NGW) {
        const GAS u32x2* orow = (const GAS u32x2*)(O + (size_t)m * D) + lane; const bf16* prow = P + (size_t)m * PROJ_LD;
        constexpr int NJ = LAYER == 0 ? 8 : 4;
        u32x2 ow_[NJ], zw_[NJ]; f32x4 gw_[NJ];
#pragma unroll
        for (int jj = 0; jj < NJ; ++jj) { const bool wide = (LAYER == 0 && jj < 4);
            const int zcol = LAYER == 0 ? (wide ? EC_GZ + jj * 256 + 4 * lane : EC_BZ + (jj - 4) * 256 + 4 * lane) : OC_HG + jj * 256 + 4 * lane;
            const float* gsrc = LAYER == 0 ? (wide ? A.in[I_GLA_NORM] : A.in[I_GDN_NORM]) : A.in[I_HG_NORM];
            ow_[jj] = orow[64 * jj]; zw_[jj] = *(const GAS u32x2*)(prow + zcol); gw_[jj] = *(const GAS f32x4*)(gsrc + (wide ? 4 * lane : 4 * (lane & 31))); }
        u32x2 yo_[NJ];
#pragma unroll
        for (int jj = 0; jj < NJ; ++jj) {
            const f32x4 v = {bf_lo(ow_[jj].x), bf_hi(ow_[jj].x), bf_lo(ow_[jj].y), bf_hi(ow_[jj].y)}; float ss = (v[0] * v[0] + v[1] * v[1]) + (v[2] * v[2] + v[3] * v[3]);
            const bool wide = (LAYER == 0 && jj < 4);
            const float ms = wide ? wave_sum(ss) * (1.0f / 256.0f) : half_sum32(ss) * (1.0f / 128.0f);
            const float r = __builtin_amdgcn_rsqf(ms + EPS);
            const f32x4 g = gw_[jj]; const u32x2 zw = zw_[jj];
            const float y0 = v[0] * r * g[0] * siluf_(bf_lo(zw.x)), y1 = v[1] * r * g[1] * siluf_(bf_hi(zw.x)), y2 = v[2] * r * g[2] * siluf_(bf_lo(zw.y)), y3 = v[3] * r * g[3] * siluf_(bf_hi(zw.y));
            if constexpr (LAYER == 1) { int o8 = __builtin_amdgcn_cvt_pk_fp8_f32(y0, y1, 0, false); o8 = __builtin_amdgcn_cvt_pk_fp8_f32(y2, y3, o8, true); yo_[jj].x = (unsigned)o8; yo_[jj].y = 0u; }
            else { yo_[jj].x = pk2(y0, y1); yo_[jj].y = pk2(y2, y3); }
        }
#pragma unroll
        for (int jj = 0; jj < NJ; ++jj) {
            if constexpr (LAYER == 1) *(GAS unsigned*)((unsigned char*)Y + (size_t)m * D + 256 * jj + 4 * lane) = yo_[jj].x;
            else *(GAS u32x2*)(Y + (size_t)m * D + 256 * jj + 4 * lane) = yo_[jj]; }
    }
}
__device__ __forceinline__ void lora_prep_rows(const Args& A, Frame& F) {
    const int gtid = (F.vcu * NWAVES + F.wave) * 64 + F.lane, step = F.G * NWAVES;
    const bf16* P = (const bf16*)(A.ws + WS_PROJ); bf16* LA = (bf16*)(A.ws + WS_LA); const GAS float* mu = (const GAS float*)A.in[I_MU];
    const int gi = gtid & 63;
    if (gi >= 56) { for (int m = gtid >> 6; m < T; m += step) *(GAS v4u*)(LA + (size_t)m * LORA_K + 8 * gi) = (v4u){0u, 0u, 0u, 0u}; return; }
    const f32x4 mua = *(const GAS f32x4*)(mu + RW_WL + 8 * gi), mub = *(const GAS f32x4*)(mu + RW_WL + 8 * gi + 4);
    const float muv[8] = {mua[0], mua[1], mua[2], mua[3], mub[0], mub[1], mub[2], mub[3]};
    const int mode = gi < 12 ? 0 : (gi < 24 ? 1 : 2);
    const float ksc = mode == 0 ? 2.0f : 1.0f;
    for (int m0 = gtid >> 6; m0 < T; m0 += 4 * step) {
        v4u xw[4], pw[4];
#pragma unroll
        for (int k = 0; k < 4; ++k) { const int m = m0 + k * step; xw[k] = (v4u){0u, 0u, 0u, 0u}; pw[k] = xw[k];
            if (m < T) { const GAS bf16* prow = (const GAS bf16*)(P + (size_t)m * PROJ_LD + OC_RW + RW_WL + 8 * gi); xw[k] = *(const GAS v4u*)prow; if ((m % SEQ) != 0) pw[k] = *(const GAS v4u*)(prow - PROJ_LD); } }
#pragma unroll
        for (int k = 0; k < 4; ++k) { const int m = m0 + k * step; if (m >= T) break;
            const unsigned xs[4] = {xw[k].x, xw[k].y, xw[k].z, xw[k].w}, ps[4] = {pw[k].x, pw[k].y, pw[k].z, pw[k].w}; unsigned ow[4];
#pragma unroll
            for (int e2 = 0; e2 < 4; ++e2) { float v2[2];
#pragma unroll
                for (int hf = 0; hf < 2; ++hf) { const float x = hf ? bf_hi(xs[e2]) : bf_lo(xs[e2]), xp = hf ? bf_hi(ps[e2]) : bf_lo(ps[e2]);
                    const float ts = x + (xp - x) * muv[2 * e2 + hf];
                    const float s = __builtin_amdgcn_rcpf(1.0f + __expf(-ksc * ts));
                    v2[hf] = mode == 0 ? 2.0f * s - 1.0f : (mode == 1 ? ts : s); }
                ow[e2] = pk2(v2[0], v2[1]); }
            v4u o; o.x = ow[0]; o.y = ow[1]; o.z = ow[2]; o.w = ow[3];
            *(GAS v4u*)(LA + (size_t)m * LORA_K + 8 * gi) = o; }
    }
}
__device__ __forceinline__ void final_rows(const Args& A, Frame& F, const float oscale, const bf16* Hs) {
    const int gw = F.vcu * NWAVES + F.wave, NGW = F.G * NWAVES, lane = F.lane;
    const float* rowss = (const float*)(A.ws + WS_RSP) + (size_t)RS_FINAL * T * 32; const GAS f32x4* g = (const GAS f32x4*)A.in[I_NFINAL] + lane;
    for (int m = gw; m < T; m += NGW) { const float r = oscale * __builtin_amdgcn_rsqf(wave_sum(lane < 32 ? rowss[(size_t)m * 32 + lane] : 0.f) * (1.0f / D) + EPS); GAS f32x4* row = (GAS f32x4*)(A.out + (size_t)m * D) + lane;
        const GAS u32x2* hrow = (const GAS u32x2*)(Hs + (size_t)m * D) + lane;
        u32x2 hw_[8]; f32x4 g_[8];
#pragma unroll
        for (int jj = 0; jj < 8; ++jj) { hw_[jj] = hrow[64 * jj]; g_[jj] = g[64 * jj]; }
#pragma unroll
        for (int jj = 0; jj < 8; ++jj) { const u32x2 hw = hw_[jj]; const f32x4 v = {bf_lo(hw.x), bf_hi(hw.x), bf_lo(hw.y), bf_hi(hw.y)}; row[64 * jj] = v * r * g_[jj]; } }
}

__device__ __forceinline__ void skinny_i8_cols(const Args& A, Frame& F, const int n0) {
    typedef int v4i_ __attribute__((ext_vector_type(4)));
    const int lane = F.lane, w = F.wave, fr = lane & 15, fq = lane >> 4, rg = w & 3, kh = w >> 2;
    const int row0 = (int)blockIdx.x * 64 + rg * 16;
    const GAS unsigned char* xa = (const GAS unsigned char*)(A.ws + WS_ACTA) + (size_t)(row0 + fr) * D + kh * 1024 + 16 * fq;
    const GAS unsigned char* wb = (const GAS unsigned char*)(A.ws + WS_WEV_IN) + (size_t)(n0 + fr) * D + kh * 1024 + 16 * fq;
    v4i_ acc0 = {0, 0, 0, 0}, acc1 = {0, 0, 0, 0};
#pragma unroll
    for (int s0 = 0; s0 < 16; s0 += 8) { v4i_ a[8], b0[8], b1[8];
#pragma unroll
        for (int s = 0; s < 8; ++s) { a[s] = *(const GAS v4i_*)(xa + 64 * (s0 + s)); b0[s] = *(const GAS v4i_*)(wb + 64 * (s0 + s)); b1[s] = *(const GAS v4i_*)(wb + (size_t)16 * D + 64 * (s0 + s)); }
#pragma unroll
        for (int s = 0; s < 8; ++s) { acc0 = __builtin_amdgcn_mfma_i32_16x16x64_i8(a[s], b0[s], acc0, 0, 0, 0); acc1 = __builtin_amdgcn_mfma_i32_16x16x64_i8(a[s], b1[s], acc1, 0, 0, 0); } }
    LAS int* red = (LAS int*)(F.lds + RING_OFF);
    __syncthreads();
    if (kh == 1) { *(LAS v4i_*)(red + (rg * 64 + lane) * 8) = acc0; *(LAS v4i_*)(red + (rg * 64 + lane) * 8 + 4) = acc1; }
    __syncthreads();
    if (kh == 0) { acc0 = acc0 + *(const LAS v4i_*)(red + (rg * 64 + lane) * 8); acc1 = acc1 + *(const LAS v4i_*)(red + (rg * 64 + lane) * 8 + 4);
        const float* sa = (const float*)(A.ws + WS_SA); const float* cm = (const float*)(A.ws + WS_CMB); bf16* P = (bf16*)(A.ws + WS_PROJ);
        const float c0 = cm[n0 + fr], c1 = cm[n0 + 16 + fr];
#pragma unroll
        for (int r = 0; r < 4; ++r) { const int row = row0 + 4 * fq + r; const float s_ = sa[row];
            P[(size_t)row * PROJ_LD + n0 + fr] = (bf16)f2bf((float)acc0[r] * s_ * c0); P[(size_t)row * PROJ_LD + n0 + 16 + fr] = (bf16)f2bf((float)acc1[r] * s_ * c1); } }
    __syncthreads();
}

__device__ __forceinline__ void scan_rwkv_mfma_unit(const Args& A, Frame& F, int unit, const int role) {
    int tid = F.tid; asm volatile("" : "+v"(tid));
    const int lane = tid & 63, w = F.wave;
    const int b = unit >> 3, hp = unit & 7;
    const bf16* P = (const bf16*)(A.ws + WS_PROJ) + (size_t)b * SEQ * PROJ_LD + OC_RW;
    const bf16* LO = (const bf16*)(A.ws + WS_LO) + (size_t)b * SEQ * LORA_N;
    unsigned char* Y = (unsigned char*)(A.ws + WS_ACTA) + (size_t)b * SEQ * D + 1024;
    LAS float* Lf = (LAS float*)(F.lds + RING_OFF);
    constexpr int RS = 72;
    constexpr int O_CONST = 0;
    constexpr int O_XF = 1280;
    constexpr int O_VV = O_XF + 2 * 5 * 1024;
    constexpr int O_BS = O_VV + 4 * 1024;
    constexpr int O_IMG = O_BS + 64;
    constexpr int I_CT = 0, I_BT = 576, I_KL = 1152, I_RT = 1728, I_CF = 2304, I_BTT = 3328, I_KTT = 3840, I_WCB = 4352, I_G1B = 4928, I_TTB = 5056, I_RKB = 5184, I_RBB = 5312, I_W15 = 5440, I_OUT = 5504, IMGSZ = 6528;
    static_assert((O_IMG + 2 * IMGSZ) * 4 <= RING_BYTES, "rwkv lds");
    for (int i = tid; i < 1280; i += NTHREADS) { const int arr = i >> 7, ch = hp * 128 + (i & 127); float v;
        switch (arr) { case 0: v = A.in[I_MU][RW_R + ch]; break; case 1: v = A.in[I_MU][RW_K + ch]; break; case 2: v = A.in[I_MU][RW_V + ch]; break; case 3: v = A.in[I_W0][ch]; break; case 4: v = A.in[I_A0][ch]; break;
                       case 5: v = A.in[I_KK][ch]; break; case 6: v = A.in[I_KA][ch]; break; case 7: v = A.in[I_RK][ch]; break; case 8: v = A.in[I_LNW][ch]; break; default: v = A.in[I_LNB][ch]; break; }
        Lf[O_CONST + i] = v; }
    const int hx = tid >> 8, tl = (tid >> 4) & 15, d4 = (tid & 15) * 4, ch4 = hx * 64 + d4, col4 = hp * 128 + ch4;
    u32x2 rr[2], rk[2], rv[2], rlw, rla, rg_cur = {0u, 0u}, rg_nxt = {0u, 0u}, rg_far = {0u, 0u};
#define RM_LOAD(c) do { const int t_ = (c) * TC + tl; const bf16* pr = P + (size_t)t_ * PROJ_LD + col4; \
        rr[0] = *(const GAS u32x2*)(pr + RW_R); rk[0] = *(const GAS u32x2*)(pr + RW_K); rv[0] = *(const GAS u32x2*)(pr + RW_V); \
        const bf16* pp_ = (t_ > 0) ? pr - PROJ_LD : pr; rr[1] = *(const GAS u32x2*)(pp_ + RW_R); rk[1] = *(const GAS u32x2*)(pp_ + RW_K); rv[1] = *(const GAS u32x2*)(pp_ + RW_V); \
        if (t_ == 0) { rr[1] = (u32x2){0u, 0u}; rk[1] = (u32x2){0u, 0u}; rv[1] = (u32x2){0u, 0u}; } \
        const bf16* lr = LO + (size_t)t_ * LORA_N + col4; rlw = *(const GAS u32x2*)(lr); rla = *(const GAS u32x2*)(lr + 1024); rg_far = *(const GAS u32x2*)(lr + 2048); } while (0)
#define RM_XFORM(bufi) do { LAS float* X_ = Lf + O_XF + hx * 5 * 1024 + tl * 64 + d4; \
        const f32x4 mur = *(const LAS f32x4*)(Lf + O_CONST + 0 * 128 + ch4), muk = *(const LAS f32x4*)(Lf + O_CONST + 1 * 128 + ch4), muv = *(const LAS f32x4*)(Lf + O_CONST + 2 * 128 + ch4); \
        const f32x4 w0_ = *(const LAS f32x4*)(Lf + O_CONST + 3 * 128 + ch4), a0_ = *(const LAS f32x4*)(Lf + O_CONST + 4 * 128 + ch4), kk_ = *(const LAS f32x4*)(Lf + O_CONST + 5 * 128 + ch4); \
        const f32x4 ka_ = *(const LAS f32x4*)(Lf + O_CONST + 6 * 128 + ch4), rk_ = *(const LAS f32x4*)(Lf + O_CONST + 7 * 128 + ch4); \
        const float r0[4] = {bf_lo(rr[0].x), bf_hi(rr[0].x), bf_lo(rr[0].y), bf_hi(rr[0].y)}, r1[4] = {bf_lo(rr[1].x), bf_hi(rr[1].x), bf_lo(rr[1].y), bf_hi(rr[1].y)}; \
        const float k0[4] = {bf_lo(rk[0].x), bf_hi(rk[0].x), bf_lo(rk[0].y), bf_hi(rk[0].y)}, k1[4] = {bf_lo(rk[1].x), bf_hi(rk[1].x), bf_lo(rk[1].y), bf_hi(rk[1].y)}; \
        const float v0[4] = {bf_lo(rv[0].x), bf_hi(rv[0].x), bf_lo(rv[0].y), bf_hi(rv[0].y)}, v1[4] = {bf_lo(rv[1].x), bf_hi(rv[1].x), bf_lo(rv[1].y), bf_hi(rv[1].y)}; \
        const float lw[4] = {bf_lo(rlw.x), bf_hi(rlw.x), bf_lo(rlw.y), bf_hi(rlw.y)}, la[4] = {bf_lo(rla.x), bf_hi(rla.x), bf_lo(rla.y), bf_hi(rla.y)}; \
        f32x4 r4, w4, k4, v4, kk4, b4; float skk = 0.f, sbs = 0.f; float aa[4]; \
        _Pragma("unroll") for (int i_ = 0; i_ < 4; ++i_) { const float r_ = r0[i_] + (r1[i_] - r0[i_]) * mur[i_], kx = k0[i_] + (k1[i_] - k0[i_]) * muk[i_], vx = v0[i_] + (v1[i_] - v0[i_]) * muv[i_]; \
            const float wd = __expf(-0.6065306597126334f * sigmoidf_(w0_[i_] + lw[i_])); const float a_ = sigmoidf_(a0_[i_] + la[i_]); \
            const float kk0 = kx * kk_[i_], km = kx * (1.f + (a_ - 1.f) * ka_[i_]); \
            r4[i_] = r_; w4[i_] = wd; k4[i_] = km; v4[i_] = vx; kk4[i_] = kk0; aa[i_] = a_; skk += kk0 * kk0; sbs += r_ * km * rk_[i_]; } \
        row_sum16_x2(skk, sbs); const float rkk = __builtin_amdgcn_rsqf(skk + EPS); \
        _Pragma("unroll") for (int i_ = 0; i_ < 4; ++i_) { kk4[i_] *= rkk; b4[i_] = kk4[i_] * aa[i_]; } \
        *(LAS f32x4*)(X_) = r4; *(LAS f32x4*)(X_ + 1024) = w4; *(LAS f32x4*)(X_ + 2048) = k4; *(LAS f32x4*)(X_ + 3072) = kk4; *(LAS f32x4*)(X_ + 4096) = b4; \
        *(LAS f32x4*)(Lf + O_VV + ((bufi) * 2 + hx) * 1024 + tl * 64 + d4) = v4; \
        if ((tid & 15) == 0) Lf[O_BS + ((bufi) * 2 + hx) * 16 + tl] = sbs; } while (0)
    constexpr int S1 = RWKV_S1, S2 = RWKV_S2;
    static_assert(S1 >= 2 && S2 - S1 >= 2 && NCHUNK - S2 >= 2 && S2 - S1 <= 68 && NCHUNK - S2 <= 65, "RWKV split (stash regions)");
    const int c_begin = role == 0 ? 0 : (role == 1 ? S1 : S2), c_end = role == 0 ? S1 : (role == 1 ? S2 : NCHUNK);
    constexpr int REC = 7584;
    float* STASH = role == 1 ? (float*)(A.ws + (unit < 32 ? WS_H1 : WS_O)) + (size_t)(unit & 31) * (S2 - S1) * REC
                             : (float*)(A.ws + (unit < 32 ? WS_WEV_IN : WS_END)) + (size_t)(unit & 31) * (NCHUNK - S2) * REC;
    float* STATE = (float*)(A.ws + WS_STATE + (role == 2 ? 6 : 4) * MiB) + (size_t)unit * 8192;
    float* STATE_OUT = (float*)(A.ws + WS_STATE + 6 * MiB) + (size_t)unit * 8192;
    gu32* flag = F.ctl + 49152 + unit * 64 + (role == 2 ? 16 : 0); gu32* flag_out = F.ctl + 49152 + unit * 64 + 16;
    LBAR();
    RM_LOAD(c_begin); RM_XFORM(c_begin & 1); rg_cur = rg_far; RM_LOAD(c_begin + 1); rg_nxt = rg_far;
    LBAR();
    f32x4 Macc[4];
#pragma unroll
    for (int i = 0; i < 4; ++i) Macc[i] = (f32x4){0.f, 0.f, 0.f, 0.f};
    const int fr = lane & 15, g = lane >> 4, hh = w >> 2, ww = w & 3, c0 = ww * 16;
    LAS float* IM = Lf + O_IMG + hh * IMGSZ;
    LAS bf16* CT = (LAS bf16*)(IM + I_CT); LAS bf16* BT = (LAS bf16*)(IM + I_BT); LAS bf16* KL = (LAS bf16*)(IM + I_KL); LAS bf16* RT = (LAS bf16*)(IM + I_RT);
    LAS bf16* BTT = (LAS bf16*)(IM + I_BTT); LAS bf16* KTT = (LAS bf16*)(IM + I_KTT); LAS bf16* WCB = (LAS bf16*)(IM + I_WCB);
    LAS bf16* G1B = (LAS bf16*)(IM + I_G1B); LAS bf16* TTB = (LAS bf16*)(IM + I_TTB); LAS bf16* RKB = (LAS bf16*)(IM + I_RKB); LAS bf16* RBB = (LAS bf16*)(IM + I_RBB);
    const u32x2 zz = {0u, 0u};
#define RM_STATE_PART(vb) do { \
        { \
            bf16x8 mb[2]; \
_Pragma("unroll") \
            for (int ks = 0; ks < 2; ++ks) { u32x2 slo, shi; slo.x = hw_pk2(Macc[2 * ks][0], Macc[2 * ks][1]); slo.y = hw_pk2(Macc[2 * ks][2], Macc[2 * ks][3]); shi.x = hw_pk2(Macc[2 * ks + 1][0], Macc[2 * ks + 1][1]); shi.y = hw_pk2(Macc[2 * ks + 1][2], Macc[2 * ks + 1][3]); \
                mb[ks] = mk_frag(slo, shi); } \
            f32x4 accR = accU, acco = {0.f, 0.f, 0.f, 0.f}; \
_Pragma("unroll") \
            for (int ks = 0; ks < 2; ++ks) { \
                accR = __builtin_amdgcn_mfma_f32_16x16x32_bf16(mk_frag(*(const LAS u32x2*)(WCB + fr * RS + 32 * ks + 4 * g), *(const LAS u32x2*)(WCB + fr * RS + 32 * ks + 16 + 4 * g)), mb[ks], accR, 0, 0, 0); \
                acco = __builtin_amdgcn_mfma_f32_16x16x32_bf16(mk_frag(*(const LAS u32x2*)(RT + fr * RS + 32 * ks + 4 * g), *(const LAS u32x2*)(RT + fr * RS + 32 * ks + 16 + 4 * g)), mb[ks], acco, 0, 0, 0); } \
            u32x2 rn; rn.x = hw_pk2(accR[0], accR[1]); rn.y = hw_pk2(accR[2], accR[3]); \
            const bf16x8 rb = mk_frag(rn, zz); \
            acco = __builtin_amdgcn_mfma_f32_16x16x32_bf16(mk_frag(*(const LAS u32x2*)(RKB + fr * 16 + 4 * g), zz), vb, acco, 0, 0, 0); \
            acco = __builtin_amdgcn_mfma_f32_16x16x32_bf16(mk_frag(*(const LAS u32x2*)(RBB + fr * 16 + 4 * g), zz), rb, acco, 0, 0, 0); \
_Pragma("unroll") \
            for (int r = 0; r < 4; ++r) IM[I_OUT + (4 * g + r) * 64 + c0 + fr] = acco[r]; \
_Pragma("unroll") \
            for (int i = 0; i < 4; ++i) { const f32x4 w15 = *(const LAS f32x4*)(IM + I_W15 + 16 * i + 4 * g); \
                f32x4 m = __builtin_amdgcn_mfma_f32_16x16x32_bf16(mk_frag(*(const LAS u32x2*)(KTT + (16 * i + fr) * 16 + 4 * g), zz), vb, Macc[i], 0, 0, 0); \
                m = __builtin_amdgcn_mfma_f32_16x16x32_bf16(mk_frag(*(const LAS u32x2*)(BTT + (16 * i + fr) * 16 + 4 * g), zz), rb, m, 0, 0, 0); \
                Macc[i] = m * w15; } \
        } \
        } while (0)
#define RM_FLUSH(cc_, gb_, vv_, bs_) do { \
        { \
            const f32x4 o4 = *(const LAS f32x4*)(Lf + O_IMG + hx * IMGSZ + I_OUT + tl * 64 + d4); const f32x4 vv = (vv_); const float bs = (bs_); \
            const f32x4 lnw = *(const LAS f32x4*)(Lf + O_CONST + 8 * 128 + ch4), lnb = *(const LAS f32x4*)(Lf + O_CONST + 9 * 128 + ch4); \
            float sm = (o4[0] + o4[1]) + (o4[2] + o4[3]), dummy = 0.f; row_sum16_x2(sm, dummy); const float mean = sm * (1.0f / 64.0f); \
            const f32x4 e4 = o4 - mean; float sv = (e4[0] * e4[0] + e4[1] * e4[1]) + (e4[2] * e4[2] + e4[3] * e4[3]); row_sum16_x2(sv, dummy); const float rs = __builtin_amdgcn_rsqf(sv * (1.0f / 64.0f) + 64e-5f); \
            const float gg[4] = {bf_lo((gb_).x), bf_hi((gb_).x), bf_lo((gb_).y), bf_hi((gb_).y)}; \
            float y[4]; \
_Pragma("unroll") \
            for (int i = 0; i < 4; ++i) y[i] = (e4[i] * rs * lnw[i] + lnb[i] + bs * vv[i]) * gg[i]; \
            int o8 = __builtin_amdgcn_cvt_pk_fp8_f32(y[0], y[1], 0, false); o8 = __builtin_amdgcn_cvt_pk_fp8_f32(y[2], y[3], o8, true); \
            *(GAS unsigned*)(Y + (size_t)((cc_) * TC + tl) * D + col4) = (unsigned)o8; \
        } \
        } while (0)
    for (int c = c_begin; c < c_end; ++c) {
        {
            const int hq = tid >> 8, seg = (tid >> 6) & 3, d = tid & 63;
            const LAS float* X_ = Lf + O_XF + hq * 5 * 1024 + d; LAS float* IQ = Lf + O_IMG + hq * IMGSZ;
            LAS bf16* CTq = (LAS bf16*)(IQ + I_CT); LAS bf16* BTq = (LAS bf16*)(IQ + I_BT); LAS bf16* KLq = (LAS bf16*)(IQ + I_KL); LAS bf16* RTq = (LAS bf16*)(IQ + I_RT);
            float wall = 1.f, wpre = 1.f;
#pragma unroll
            for (int t = 0; t < 16; ++t) { if (t == 4 * seg) wpre = wall; wall *= X_[1024 + t * 64]; }
            float wt = wpre; unsigned short bt4[4], kt4[4];
#pragma unroll
            for (int i = 0; i < 4; ++i) { const int t = 4 * seg + i; const float wprev = wt; wt *= X_[1024 + t * 64]; const float iw = __builtin_amdgcn_rcpf(wt);
                const float r_ = X_[t * 64], k_ = X_[2048 + t * 64], kk_ = X_[3072 + t * 64], b_ = X_[4096 + t * 64];
                const float ct = kk_ * wprev, bt = b_ * iw, kt = k_ * iw;
                CTq[t * RS + d] = hw_bf(ct); IQ[I_CF + t * 64 + d] = ct; BTq[t * RS + d] = hw_bf(bt); KLq[t * RS + d] = hw_bf(kt); RTq[t * RS + d] = hw_bf(r_ * wt);
                bt4[i] = (unsigned short)hw_bf(-bt); kt4[i] = (unsigned short)hw_bf(kt); }
            u32x2 o; o.x = (unsigned)bt4[0] | ((unsigned)bt4[1] << 16); o.y = (unsigned)bt4[2] | ((unsigned)bt4[3] << 16); *(LAS u32x2*)((LAS bf16*)(IQ + I_BTT) + d * 16 + 4 * seg) = o;
            o.x = (unsigned)kt4[0] | ((unsigned)kt4[1] << 16); o.y = (unsigned)kt4[2] | ((unsigned)kt4[3] << 16); *(LAS u32x2*)((LAS bf16*)(IQ + I_KTT) + d * 16 + 4 * seg) = o;
            if (seg == 3) IQ[I_W15 + d] = wall;
        }
        LBAR();
        if (ww == 0) {
            f32x4 cb = {0.f, 0.f, 0.f, 0.f}, bc = cb, ck = cb, rkm = cb, rbm = cb;
#pragma unroll
            for (int ks = 0; ks < 2; ++ks) { const bf16x8 fc = *(const LAS bf16x8*)(CT + fr * RS + 32 * ks + 8 * g), fb = *(const LAS bf16x8*)(BT + fr * RS + 32 * ks + 8 * g), fk = *(const LAS bf16x8*)(KL + fr * RS + 32 * ks + 8 * g), frr = *(const LAS bf16x8*)(RT + fr * RS + 32 * ks + 8 * g);
                cb = __builtin_amdgcn_mfma_f32_16x16x32_bf16(fc, fb, cb, 0, 0, 0); bc = __builtin_amdgcn_mfma_f32_16x16x32_bf16(fb, fc, bc, 0, 0, 0); ck = __builtin_amdgcn_mfma_f32_16x16x32_bf16(fc, fk, ck, 0, 0, 0);
                rkm = __builtin_amdgcn_mfma_f32_16x16x32_bf16(frr, fk, rkm, 0, 0, 0); rbm = __builtin_amdgcn_mfma_f32_16x16x32_bf16(frr, fb, rbm, 0, 0, 0); }
            f32x4 N1, M1, CKm;
#pragma unroll
            for (int r = 0; r < 4; ++r) { const int t = 4 * g + r; N1[r] = (fr < t) ? -cb[r] : 0.f; M1[r] = (t < fr) ? -bc[r] : 0.f; CKm[r] = (fr < t) ? ck[r] : 0.f;
                RKB[t * 16 + fr] = hw_bf((fr <= t) ? rkm[r] : 0.f); RBB[t * 16 + fr] = hw_bf((fr <= t) ? -rbm[r] : 0.f); }
#define XTY(X, Y, C0) __builtin_amdgcn_mfma_f32_16x16x32_bf16(mk_frag((u32x2){hw_pk2(X[0], X[1]), hw_pk2(X[2], X[3])}, zz), mk_frag((u32x2){hw_pk2(Y[0], Y[1]), hw_pk2(Y[2], Y[3])}, zz), C0, 0, 0, 0)
            const f32x4 z4 = {0.f, 0.f, 0.f, 0.f};
            f32x4 T1t = M1;
#pragma unroll
            for (int r = 0; r < 4; ++r) if (4 * g + r == fr) T1t[r] += 1.f;
            const f32x4 N2 = XTY(M1, N1, z4), M2 = XTY(N1, M1, z4);
            const f32x4 T2t = XTY(N2, T1t, T1t);
            const f32x4 N4 = XTY(M2, N2, z4), M4 = XTY(N2, M2, z4);
            const f32x4 T4t = XTY(N4, T2t, T2t);
            const f32x4 N8 = XTY(M4, N4, z4);
            const f32x4 T8t = XTY(N8, T4t, T4t);
            const f32x4 G1t = XTY(CKm, T8t, z4);
#undef XTY
            u32x2 tw; tw.x = hw_pk2(T8t[0], T8t[1]); tw.y = hw_pk2(T8t[2], T8t[3]); *(LAS u32x2*)(TTB + fr * 16 + 4 * g) = tw;
            tw.x = hw_pk2(G1t[0], G1t[1]); tw.y = hw_pk2(G1t[2], G1t[3]); *(LAS u32x2*)(G1B + fr * 16 + 4 * g) = tw;
        }
        if (c + 1 < c_end) { RM_XFORM((c + 1) & 1); }
        if (c + 2 < c_end) RM_LOAD(c + 2);
        LBAR();
        const LAS float* VVc = Lf + O_VV + ((c & 1) * 2 + hh) * 1024;
        u32x2 vlo; { vlo.x = hw_pk2(VVc[(4 * g + 0) * 64 + c0 + fr], VVc[(4 * g + 1) * 64 + c0 + fr]); vlo.y = hw_pk2(VVc[(4 * g + 2) * 64 + c0 + fr], VVc[(4 * g + 3) * 64 + c0 + fr]); }
        const bf16x8 vb = mk_frag(vlo, zz);
        f32x4 accU = {0.f, 0.f, 0.f, 0.f};
        {
            accU = __builtin_amdgcn_mfma_f32_16x16x32_bf16(mk_frag(*(const LAS u32x2*)(G1B + fr * 16 + 4 * g), zz), vb, accU, 0, 0, 0);
            u32x2 clo; clo.x = hw_pk2(IM[I_CF + (4 * g + 0) * 64 + c0 + fr], IM[I_CF + (4 * g + 1) * 64 + c0 + fr]); clo.y = hw_pk2(IM[I_CF + (4 * g + 2) * 64 + c0 + fr], IM[I_CF + (4 * g + 3) * 64 + c0 + fr]);
            f32x4 accw = {0.f, 0.f, 0.f, 0.f};
            accw = __builtin_amdgcn_mfma_f32_16x16x32_bf16(mk_frag(*(const LAS u32x2*)(TTB + fr * 16 + 4 * g), zz), mk_frag(clo, zz), accw, 0, 0, 0);
#pragma unroll
            for (int r = 0; r < 4; ++r) WCB[(4 * g + r) * RS + c0 + fr] = hw_bf(accw[r]);
        }
        LBAR();
        if (role == 0) {
            RM_STATE_PART(vb);
            LBAR();
            RM_FLUSH(c, rg_cur, *(const LAS f32x4*)(Lf + O_VV + ((c & 1) * 2 + hx) * 1024 + tl * 64 + d4), Lf[O_BS + ((c & 1) * 2 + hx) * 16 + tl]);
        } else {
            float* rec = STASH + (size_t)(c - c_begin) * REC;
            for (int i = tid; i < 1376; i += NTHREADS) { const int hd = i >= 688, j = i - hd * 688; const int o = O_IMG + hd * IMGSZ + (j < 144 ? I_RT + 4 * j : I_BTT + 4 * (j - 144)); *(GAS f32x4*)(rec + 4 * i) = *(const LAS f32x4*)(Lf + o); }
            { GAS unsigned* ru = (GAS unsigned*)(rec + 5504); ru[(w * 2 + 0) * 64 + lane] = hw_pk2(accU[0], accU[1]); ru[(w * 2 + 1) * 64 + lane] = hw_pk2(accU[2], accU[3]); }
            { const f32x4 v4 = *(const LAS f32x4*)(Lf + O_VV + ((c & 1) * 2 + hx) * 1024 + tl * 64 + d4); u32x2 o; o.x = hw_pk2(v4[0], v4[1]); o.y = hw_pk2(v4[2], v4[3]); *(GAS u32x2*)(rec + 6528 + 2 * tid) = o; }
            if (tid < 32) rec[7552 + tid] = Lf[O_BS + (c & 1) * 32 + tid];
            LBAR();
        }
        rg_cur = rg_nxt; rg_nxt = rg_far;
    }
#define RM_PUBLISH(ST_, FL_) do { \
        _Pragma("unroll") for (int i = 0; i < 4; ++i) _Pragma("unroll") for (int r = 0; r < 4; ++r) (ST_)[((w * 4 + i) * 4 + r) * 64 + lane] = Macc[i][r]; \
        asm volatile("s_waitcnt vmcnt(0)" ::: "memory"); \
        __syncthreads(); \
        if (tid == 0) { __builtin_amdgcn_fence(__ATOMIC_RELEASE, "agent"); asm volatile("s_waitcnt vmcnt(0)" ::: "memory"); __hip_atomic_store((FL_), 1u, __ATOMIC_RELAXED, __HIP_MEMORY_SCOPE_AGENT); } } while (0)
    if (role == 0) {
        RM_PUBLISH(STATE, flag);
    } else {
        if (tid == 0) { unsigned sp = 0; while (__hip_atomic_load(flag, __ATOMIC_RELAXED, __HIP_MEMORY_SCOPE_AGENT) == 0u) { __builtin_amdgcn_s_sleep(8); if (++sp > (1u << 22)) break; }
            __builtin_amdgcn_fence(__ATOMIC_ACQUIRE, "agent"); asm volatile("s_waitcnt vmcnt(0)" ::: "memory"); }
        __syncthreads();
#pragma unroll
        for (int i = 0; i < 4; ++i)
#pragma unroll
            for (int r = 0; r < 4; ++r) Macc[i][r] = STATE[((w * 4 + i) * 4 + r) * 64 + lane];
        f32x4 pi0, pi1, pi2; unsigned pu0, pu1; u32x2 pv, pgate; float pbs;
#define RM_REC_LOAD(cc) do { const float* rec = STASH + (size_t)((cc) - c_begin) * REC; pi0 = *(const GAS f32x4*)(rec + 4 * tid); pi1 = *(const GAS f32x4*)(rec + 4 * (tid + 512)); \
            pi2 = (tid < 352) ? *(const GAS f32x4*)(rec + 4 * (tid + 1024)) : (f32x4){0.f, 0.f, 0.f, 0.f}; \
            const GAS unsigned* ru = (const GAS unsigned*)(rec + 5504); pu0 = ru[(w * 2 + 0) * 64 + lane]; pu1 = ru[(w * 2 + 1) * 64 + lane]; pv = *(const GAS u32x2*)(rec + 6528 + 2 * tid); pbs = rec[7552 + hx * 16 + tl]; \
            pgate = *(const GAS u32x2*)(LO + (size_t)((cc) * TC + tl) * LORA_N + col4 + 2048); } while (0)
#define RM_IMG_OFF(i_) (O_IMG + ((i_) >= 688) * IMGSZ + ((((i_) - ((i_) >= 688) * 688) < 144) ? I_RT + 4 * ((i_) - ((i_) >= 688) * 688) : I_BTT + 4 * (((i_) - ((i_) >= 688) * 688) - 144)))
        RM_REC_LOAD(c_begin);
        for (int c = c_begin; c < c_end; ++c) {
            *(LAS f32x4*)(Lf + RM_IMG_OFF(tid)) = pi0; *(LAS f32x4*)(Lf + RM_IMG_OFF(tid + 512)) = pi1; if (tid < 352) *(LAS f32x4*)(Lf + RM_IMG_OFF(tid + 1024)) = pi2;
            const f32x4 vcur = {bf_lo(pv.x), bf_hi(pv.x), bf_lo(pv.y), bf_hi(pv.y)}; *(LAS f32x4*)(Lf + O_VV + hx * 1024 + tl * 64 + d4) = vcur;
            const f32x4 accU = {bf_lo(pu0), bf_hi(pu0), bf_lo(pu1), bf_hi(pu1)}; const float bscur = pbs; const u32x2 gcur = pgate;
            if (c + 1 < c_end) RM_REC_LOAD(c + 1);
            LBAR();
            const LAS float* VVc = Lf + O_VV + hh * 1024;
            u32x2 vlo; { vlo.x = hw_pk2(VVc[(4 * g + 0) * 64 + c0 + fr], VVc[(4 * g + 1) * 64 + c0 + fr]); vlo.y = hw_pk2(VVc[(4 * g + 2) * 64 + c0 + fr], VVc[(4 * g + 3) * 64 + c0 + fr]); }
            const bf16x8 vb = mk_frag(vlo, zz);
            RM_STATE_PART(vb);
            LBAR();
            RM_FLUSH(c, gcur, vcur, bscur);
            LBAR();
        }
#undef RM_REC_LOAD
#undef RM_IMG_OFF
        if (role == 1) RM_PUBLISH(STATE_OUT, flag_out);
    }
#undef RM_PUBLISH
#undef RM_STATE_PART
#undef RM_FLUSH
#undef RM_LOAD
#undef RM_XFORM
}

__device__ __forceinline__ int med3i(int a, int b, int c) { int r; asm("v_med3_i32 %0, %1, %2, %3" : "=v"(r) : "v"(a), "v"(b), "v"(c)); return r; }
__device__ __forceinline__ int f2sort(float f) { int x = __float_as_int(f); return x ^ ((x >> 31) & 0x7fffffff); }
__device__ __forceinline__ float sort2f(int x) { return __int_as_float(x ^ ((x >> 31) & 0x7fffffff)); }
#define TOPK_INSERT(vals, x) do { _Pragma("unroll") for (int s_ = 15; s_ >= 1; --s_) vals[s_] = med3i((x), vals[s_ - 1], vals[s_]); vals[0] = max(vals[0], (x)); } while (0)
__device__ __forceinline__ float bf_dot2(unsigned a, unsigned b, float c) {
    return c + bf_lo(a) * bf_lo(b) + bf_hi(a) * bf_hi(b);
}
__device__ __forceinline__ void sum8_x8(float (&a)[8]) {
    asm("s_nop 1\n\t"
        "v_add_f32_dpp %0, %0, %0 quad_perm:[1,0,3,2] row_mask:0xf bank_mask:0xf\n\tv_add_f32_dpp %1, %1, %1 quad_perm:[1,0,3,2] row_mask:0xf bank_mask:0xf\n\t"
        "v_add_f32_dpp %2, %2, %2 quad_perm:[1,0,3,2] row_mask:0xf bank_mask:0xf\n\tv_add_f32_dpp %3, %3, %3 quad_perm:[1,0,3,2] row_mask:0xf bank_mask:0xf\n\t"
        "v_add_f32_dpp %4, %4, %4 quad_perm:[1,0,3,2] row_mask:0xf bank_mask:0xf\n\tv_add_f32_dpp %5, %5, %5 quad_perm:[1,0,3,2] row_mask:0xf bank_mask:0xf\n\t"
        "v_add_f32_dpp %6, %6, %6 quad_perm:[1,0,3,2] row_mask:0xf bank_mask:0xf\n\tv_add_f32_dpp %7, %7, %7 quad_perm:[1,0,3,2] row_mask:0xf bank_mask:0xf\n\t"
        "v_add_f32_dpp %0, %0, %0 quad_perm:[2,3,0,1] row_mask:0xf bank_mask:0xf\n\tv_add_f32_dpp %1, %1, %1 quad_perm:[2,3,0,1] row_mask:0xf bank_mask:0xf\n\t"
        "v_add_f32_dpp %2, %2, %2 quad_perm:[2,3,0,1] row_mask:0xf bank_mask:0xf\n\tv_add_f32_dpp %3, %3, %3 quad_perm:[2,3,0,1] row_mask:0xf bank_mask:0xf\n\t"
        "v_add_f32_dpp %4, %4, %4 quad_perm:[2,3,0,1] row_mask:0xf bank_mask:0xf\n\tv_add_f32_dpp %5, %5, %5 quad_perm:[2,3,0,1] row_mask:0xf bank_mask:0xf\n\t"
        "v_add_f32_dpp %6, %6, %6 quad_perm:[2,3,0,1] row_mask:0xf bank_mask:0xf\n\tv_add_f32_dpp %7, %7, %7 quad_perm:[2,3,0,1] row_mask:0xf bank_mask:0xf\n\t"
        "v_add_f32_dpp %0, %0, %0 row_half_mirror row_mask:0xf bank_mask:0xf\n\tv_add_f32_dpp %1, %1, %1 row_half_mirror row_mask:0xf bank_mask:0xf\n\t"
        "v_add_f32_dpp %2, %2, %2 row_half_mirror row_mask:0xf bank_mask:0xf\n\tv_add_f32_dpp %3, %3, %3 row_half_mirror row_mask:0xf bank_mask:0xf\n\t"
        "v_add_f32_dpp %4, %4, %4 row_half_mirror row_mask:0xf bank_mask:0xf\n\tv_add_f32_dpp %5, %5, %5 row_half_mirror row_mask:0xf bank_mask:0xf\n\t"
        "v_add_f32_dpp %6, %6, %6 row_half_mirror row_mask:0xf bank_mask:0xf\n\tv_add_f32_dpp %7, %7, %7 row_half_mirror row_mask:0xf bank_mask:0xf\n\t"
        "s_nop 1"
        : "+v"(a[0]), "+v"(a[1]), "+v"(a[2]), "+v"(a[3]), "+v"(a[4]), "+v"(a[5]), "+v"(a[6]), "+v"(a[7]));
}
__device__ __forceinline__ void sum8i_x8(int (&a)[8]) {
    asm("s_nop 1\n\t"
        "v_add_u32_dpp %0, %0, %0 quad_perm:[1,0,3,2] row_mask:0xf bank_mask:0xf\n\tv_add_u32_dpp %1, %1, %1 quad_perm:[1,0,3,2] row_mask:0xf bank_mask:0xf\n\t"
        "v_add_u32_dpp %2, %2, %2 quad_perm:[1,0,3,2] row_mask:0xf bank_mask:0xf\n\tv_add_u32_dpp %3, %3, %3 quad_perm:[1,0,3,2] row_mask:0xf bank_mask:0xf\n\t"
        "v_add_u32_dpp %4, %4, %4 quad_perm:[1,0,3,2] row_mask:0xf bank_mask:0xf\n\tv_add_u32_dpp %5, %5, %5 quad_perm:[1,0,3,2] row_mask:0xf bank_mask:0xf\n\t"
        "v_add_u32_dpp %6, %6, %6 quad_perm:[1,0,3,2] row_mask:0xf bank_mask:0xf\n\tv_add_u32_dpp %7, %7, %7 quad_perm:[1,0,3,2] row_mask:0xf bank_mask:0xf\n\t"
        "v_add_u32_dpp %0, %0, %0 quad_perm:[2,3,0,1] row_mask:0xf bank_mask:0xf\n\tv_add_u32_dpp %1, %1, %1 quad_perm:[2,3,0,1] row_mask:0xf bank_mask:0xf\n\t"
        "v_add_u32_dpp %2, %2, %2 quad_perm:[2,3,0,1] row_mask:0xf bank_mask:0xf\n\tv_add_u32_dpp %3, %3, %3 quad_perm:[2,3,0,1] row_mask:0xf bank_mask:0xf\n\t"
        "v_add_u32_dpp %4, %4, %4 quad_perm:[2,3,0,1] row_mask:0xf bank_mask:0xf\n\tv_add_u32_dpp %5, %5, %5 quad_perm:[2,3,0,1] row_mask:0xf bank_mask:0xf\n\t"
        "v_add_u32_dpp %6, %6, %6 quad_perm:[2,3,0,1] row_mask:0xf bank_mask:0xf\n\tv_add_u32_dpp %7, %7, %7 quad_perm:[2,3,0,1] row_mask:0xf bank_mask:0xf\n\t"
        "v_add_u32_dpp %0, %0, %0 row_half_mirror row_mask:0xf bank_mask:0xf\n\tv_add_u32_dpp %1, %1, %1 row_half_mirror row_mask:0xf bank_mask:0xf\n\t"
        "v_add_u32_dpp %2, %2, %2 row_half_mirror row_mask:0xf bank_mask:0xf\n\tv_add_u32_dpp %3, %3, %3 row_half_mirror row_mask:0xf bank_mask:0xf\n\t"
        "v_add_u32_dpp %4, %4, %4 row_half_mirror row_mask:0xf bank_mask:0xf\n\tv_add_u32_dpp %5, %5, %5 row_half_mirror row_mask:0xf bank_mask:0xf\n\t"
        "v_add_u32_dpp %6, %6, %6 row_half_mirror row_mask:0xf bank_mask:0xf\n\tv_add_u32_dpp %7, %7, %7 row_half_mirror row_mask:0xf bank_mask:0xf\n\t"
        "s_nop 1"
        : "+v"(a[0]), "+v"(a[1]), "+v"(a[2]), "+v"(a[3]), "+v"(a[4]), "+v"(a[5]), "+v"(a[6]), "+v"(a[7]));
}
__device__ __forceinline__ float max8_x1(float v) {
    asm("s_nop 1\n\tv_max_f32_dpp %0, %0, %0 quad_perm:[1,0,3,2] row_mask:0xf bank_mask:0xf\n\ts_nop 1\n\tv_max_f32_dpp %0, %0, %0 quad_perm:[2,3,0,1] row_mask:0xf bank_mask:0xf\n\ts_nop 1\n\t"
        "v_max_f32_dpp %0, %0, %0 row_half_mirror row_mask:0xf bank_mask:0xf\n\ts_nop 1" : "+v"(v));
    return v;
}
__device__ __forceinline__ float sum8_x1(float v) {
    asm("s_nop 1\n\tv_add_f32_dpp %0, %0, %0 quad_perm:[1,0,3,2] row_mask:0xf bank_mask:0xf\n\ts_nop 1\n\tv_add_f32_dpp %0, %0, %0 quad_perm:[2,3,0,1] row_mask:0xf bank_mask:0xf\n\ts_nop 1\n\t"
        "v_add_f32_dpp %0, %0, %0 row_half_mirror row_mask:0xf bank_mask:0xf\n\ts_nop 1" : "+v"(v));
    return v;
}
__device__ __forceinline__ void peer_phase(const Args& A, Frame& F, int L, const bool dry, const bf16* Hin, bf16* Hout, unsigned char* H8) {
    int lane = F.lane; asm volatile("" : "+v"(lane));
    const int gw = F.vcu * NWAVES + F.wave;
    const bf16* SCR = (const bf16*)(A.ws + WS_SC); const bf16* X = Hin; float* RS3 = (float*)(A.ws + WS_RS3);
    const unsigned char* TU = (const unsigned char*)(A.ws + WS_TABU) + (size_t)L * 16384 * D; const unsigned char* TV = (const unsigned char*)(A.ws + WS_TABV) + (size_t)L * 16384 * D;
    const float* SUL = (const float*)(A.ws + WS_SU) + (size_t)L * 16384; const float* SVL = SUL + 32768;
    const float* rowss = (const float*)(A.ws + WS_RSP) + (size_t)(L == 0 ? RS_FFN0 : RS_FFN1) * T * 32;
    LAS unsigned* LIST = (LAS unsigned*)(F.lds + RING_OFF + F.wave * 16384);
    LAS unsigned* EIDX = LIST + 1024;
    LAS float* ECOEF = (LAS float*)(EIDX + 1024);
    const int tbase = gw * 8;
    if (tbase >= T) return;
    for (int half = 0; half < 2; ++half) {
        const int t0 = tbase + 4 * half;
        {
            const bf16* sp = SCR + (size_t)(t0 + (lane >> 4)) * D + (lane & 15) * 128;
            int vals[16];
#pragma unroll
            for (int s = 0; s < 16; ++s) vals[s] = (int)0x80000000;
#pragma unroll 1
            for (int cb = 0; cb < 16; cb += 8) { v4u wvs[8];
#pragma unroll
                for (int c = 0; c < 8; ++c) wvs[c] = *(const GAS v4u*)(sp + (cb + c) * 8);
#pragma unroll
                for (int c = 0; c < 8; ++c) { const v4u wv = wvs[c]; const unsigned ww[4] = {wv.x, wv.y, wv.z, wv.w};
#pragma unroll
                    for (int e = 0; e < 8; ++e) { const unsigned bits = (e & 1) ? (ww[e >> 1] & 0xffff0000u) : (ww[e >> 1] << 16);
                        int x = (int)bits; x ^= (x >> 31) & 0x7fffffff; x = (x & ~0x7f) | (127 - ((cb + c) * 8 + e));
                        TOPK_INSERT(vals, x); } } }
#pragma unroll
            for (int q = 0; q < 4; ++q) { v4u o; o.x = (unsigned)vals[4 * q]; o.y = (unsigned)vals[4 * q + 1]; o.z = (unsigned)vals[4 * q + 2]; o.w = (unsigned)vals[4 * q + 3]; *(LAS v4u*)(LIST + lane * 16 + 4 * q) = o; }
        }
        LDS_WAIT(); asm volatile("" ::: "memory");
        if (lane < 32) {
            const LAS unsigned* la = LIST + ((lane >> 3) * 16 + (lane & 7) * 2) * 16; const LAS unsigned* lb2 = la + 16;
            float av[16], bv[16];
#pragma unroll
            for (int q = 0; q < 4; ++q) { const v4u a4 = *(const LAS v4u*)(la + 4 * q), b4 = *(const LAS v4u*)(lb2 + 4 * q); const unsigned aw[4] = {a4.x, a4.y, a4.z, a4.w}, bw[4] = {b4.x, b4.y, b4.z, b4.w};
#pragma unroll
                for (int e = 0; e < 4; ++e) { av[4 * q + e] = __uint_as_float(__float_as_uint(sort2f((int)(aw[e] & ~0x7fu))) & 0xffff0000u); bv[4 * q + e] = __uint_as_float(__float_as_uint(sort2f((int)(bw[e] & ~0x7fu))) & 0xffff0000u); } }
            int best[16];
#pragma unroll
            for (int s = 0; s < 16; ++s) best[s] = (int)0x80000000;
#pragma unroll
            for (int i = 0; i < 16; ++i)
#pragma unroll
                for (int jx = 0; jx < 16; ++jx) if ((i + 1) * (jx + 1) <= 16) { int x = f2sort(av[i] + bv[jx]); x = (x & ~0xff) | (255 - (i * 16 + jx)); TOPK_INSERT(best, x); }
            float sv[16]; unsigned ex[16];
#pragma unroll
            for (int s = 0; s < 16; ++s) { const int cand = 255 - (best[s] & 0xff); const unsigned ka = la[cand >> 4], kb = lb2[cand & 15];
                ex[s] = (127u - (ka & 0x7fu)) * 128u + (127u - (kb & 0x7fu));
                sv[s] = __uint_as_float(__float_as_uint(sort2f((int)(ka & ~0x7fu))) & 0xffff0000u) + __uint_as_float(__float_as_uint(sort2f((int)(kb & ~0x7fu))) & 0xffff0000u); }
            float mx = sv[0];
#pragma unroll
            for (int s = 1; s < 16; ++s) mx = fmaxf(mx, sv[s]);
            float den = 0.f;
#pragma unroll
            for (int s = 0; s < 16; ++s) { sv[s] = __expf(sv[s] - mx); den += sv[s]; }
            const float inv = 1.0f / den; const int base = (4 * half + (lane >> 3)) * 128 + (lane & 7) * 16;
#pragma unroll
            for (int s = 0; s < 16; ++s) { EIDX[base + s] = ex[s]; ECOEF[base + s] = sv[s] * inv; }
        }
        LDS_WAIT(); asm volatile("" ::: "memory");
    }
    const int tk = lane >> 3, part = lane & 7, t = tbase + tk;
    const LAS unsigned* eidx = EIDX + tk * 128; LAS float* ecoef = ECOEF + tk * 128;
    const float rs = __builtin_amdgcn_rsqf(sum8_x1(((const GAS f32x4*)(rowss + (size_t)t * 32))[part][0] + ((const GAS f32x4*)(rowss + (size_t)t * 32))[part][1] + ((const GAS f32x4*)(rowss + (size_t)t * 32))[part][2] + ((const GAS f32x4*)(rowss + (size_t)t * 32))[part][3]) * (1.0f / D) + EPS);
    typedef _Float16 h2_t __attribute__((ext_vector_type(2)));
#if PEER_ALIAS
    const unsigned amask = dry ? 1023u : 0xffffffffu;
#else
    constexpr unsigned amask = 0xffffffffu;
#endif
#define PEER_LOAD8(dst, TAB, i0, soff) do { const v4u ia_ = *(const LAS v4u*)(eidx + (i0)), ib_ = *(const LAS v4u*)(eidx + (i0) + 4); const unsigned ee_[8] = {ia_.x, ia_.y, ia_.z, ia_.w, ib_.x, ib_.y, ib_.z, ib_.w}; \
        _Pragma("unroll") for (int j_ = 0; j_ < 8; ++j_) dst[j_] = *(const GAS v4u*)((TAB) + (size_t)((ee_[j_] & amask) * 2048u + (unsigned)(soff))); } while (0)
    LAS float* dotw = (LAS float*)LIST + tk * 128;
#pragma unroll
    for (int m = 0; m < 16; ++m) dotw[8 * m + part] = 0.f;
#pragma unroll 1
    for (int p = 0; p < 16; ++p) {
        const int soff = 128 * p + 16 * part;
        unsigned xq[4]; float sxs;
        { const v4u x0 = *(const GAS v4u*)(X + (size_t)t * D + soff), x1 = *(const GAS v4u*)(X + (size_t)t * D + soff + 8); const unsigned xw[8] = {x0.x, x0.y, x0.z, x0.w, x1.x, x1.y, x1.z, x1.w};
          float xv[16], am = 0.f;
#pragma unroll
          for (int e = 0; e < 8; ++e) { xv[2 * e] = bf_lo(xw[e]); xv[2 * e + 1] = bf_hi(xw[e]); am = fmaxf(am, fmaxf(fabsf(xv[2 * e]), fabsf(xv[2 * e + 1]))); }
          am = max8_x1(am); sxs = am * (1.0f / 127.0f); const float inv = am > 0.f ? 127.0f / am : 0.f;
#pragma unroll
          for (int q = 0; q < 4; ++q) { unsigned w = 0;
#pragma unroll
              for (int e = 0; e < 4; ++e) w |= (__float_as_uint(__builtin_fmaf(xv[4 * q + e], inv, 12582912.0f)) & 255u) << (8 * e);
              xq[q] = w; } }
#define PEER_UDOT8(src, m_) do { int tt_[8]; \
        _Pragma("unroll") for (int j_ = 0; j_ < 8; ++j_) { int a_ = __builtin_amdgcn_sdot4((int)src[j_].x, (int)xq[0], 0, false); a_ = __builtin_amdgcn_sdot4((int)src[j_].y, (int)xq[1], a_, false); \
            a_ = __builtin_amdgcn_sdot4((int)src[j_].z, (int)xq[2], a_, false); tt_[j_] = __builtin_amdgcn_sdot4((int)src[j_].w, (int)xq[3], a_, false); } \
        sum8i_x8(tt_); \
        int sel_ = tt_[0]; _Pragma("unroll") for (int j_ = 1; j_ < 8; ++j_) sel_ = (part == j_) ? tt_[j_] : sel_; \
        dotw[8 * (m_) + part] += (float)sel_ * sxs; } while (0)
        v4u ua[8], ub[8];
        PEER_LOAD8(ua, TU, 0, soff);
#pragma unroll 1
        for (int m = 0; m < 16; m += 2) {
            PEER_LOAD8(ub, TU, 8 * (m + 1), soff);
            PEER_UDOT8(ua, m);
            if (m + 2 < 16) PEER_LOAD8(ua, TU, 8 * (m + 2), soff);
            PEER_UDOT8(ub, m + 1);
        }
    }
#undef PEER_UDOT8
    LAS unsigned char* ecq = (LAS unsigned char*)(LIST + 3072) + tk * 128;
    float sc;
    { float cf[16], cm = 0.f, su_[16], sv_[16];
#pragma unroll
      for (int m = 0; m < 16; ++m) { const unsigned e_ = eidx[8 * m + part]; su_[m] = ((const GAS float*)SUL)[e_]; sv_[m] = ((const GAS float*)SVL)[e_]; }
#pragma unroll
      for (int m = 0; m < 16; ++m) { const float d_ = dotw[8 * m + part] * rs * su_[m]; const float act = 0.5f * d_ * (1.0f + erff(d_ * 0.7071067811865476f));
          cf[m] = ecoef[8 * m + part] * act * sv_[m]; cm = fmaxf(cm, fabsf(cf[m])); }
      cm = max8_x1(cm); sc = cm * (1.0f / 127.0f); const float inv = cm > 0.f ? 127.0f / cm : 0.f;
#pragma unroll
      for (int m = 0; m < 16; ++m) ecq[8 * m + part] = (unsigned char)(__float_as_uint(__builtin_fmaf(cf[m], inv, 12582912.0f)) & 255u); }
    LDS_WAIT(); asm volatile("" ::: "memory");
    float ss = 0.f;
    v4u va[8], vb[8];
    PEER_LOAD8(va, TV, 0, 16 * part);
#pragma unroll 1
    for (int p = 0; p < 16; ++p) {
        const int soff = 128 * p + 16 * part;
        int acc[16];
#pragma unroll
        for (int i = 0; i < 16; ++i) acc[i] = 0;
#define PEER_VACC8(src, i0) do { const u32x2 c8_ = *(const LAS u32x2*)(ecq + (i0)); \
        _Pragma("unroll") for (int h_ = 0; h_ < 2; ++h_) { const int cq_ = (int)(h_ ? c8_.y : c8_.x); \
            _Pragma("unroll") for (int q_ = 0; q_ < 4; ++q_) { \
                const unsigned a_ = q_ == 0 ? src[4 * h_].x : q_ == 1 ? src[4 * h_].y : q_ == 2 ? src[4 * h_].z : src[4 * h_].w, b_ = q_ == 0 ? src[4 * h_ + 1].x : q_ == 1 ? src[4 * h_ + 1].y : q_ == 2 ? src[4 * h_ + 1].z : src[4 * h_ + 1].w; \
                const unsigned c_ = q_ == 0 ? src[4 * h_ + 2].x : q_ == 1 ? src[4 * h_ + 2].y : q_ == 2 ? src[4 * h_ + 2].z : src[4 * h_ + 2].w, d_ = q_ == 0 ? src[4 * h_ + 3].x : q_ == 1 ? src[4 * h_ + 3].y : q_ == 2 ? src[4 * h_ + 3].z : src[4 * h_ + 3].w; \
                const unsigned lab_ = __builtin_amdgcn_perm(b_, a_, 0x05010400u), hab_ = __builtin_amdgcn_perm(b_, a_, 0x07030602u), lcd_ = __builtin_amdgcn_perm(d_, c_, 0x05010400u), hcd_ = __builtin_amdgcn_perm(d_, c_, 0x07030602u); \
                acc[4 * q_ + 0] = __builtin_amdgcn_sdot4((int)__builtin_amdgcn_perm(lcd_, lab_, 0x05040100u), cq_, acc[4 * q_ + 0], false); \
                acc[4 * q_ + 1] = __builtin_amdgcn_sdot4((int)__builtin_amdgcn_perm(lcd_, lab_, 0x07060302u), cq_, acc[4 * q_ + 1], false); \
                acc[4 * q_ + 2] = __builtin_amdgcn_sdot4((int)__builtin_amdgcn_perm(hcd_, hab_, 0x05040100u), cq_, acc[4 * q_ + 2], false); \
                acc[4 * q_ + 3] = __builtin_amdgcn_sdot4((int)__builtin_amdgcn_perm(hcd_, hab_, 0x07060302u), cq_, acc[4 * q_ + 3], false); } } } while (0)
#pragma unroll 1
        for (int m = 0; m < 16; m += 2) {
            PEER_LOAD8(vb, TV, 8 * (m + 1), soff);
            PEER_VACC8(va, 8 * m);
            if (m + 2 < 16) PEER_LOAD8(va, TV, 8 * (m + 2), soff);
            PEER_VACC8(vb, 8 * (m + 1));
        }
        { const v4u h0 = *(const GAS v4u*)(Hin + (size_t)t * D + soff), h1 = *(const GAS v4u*)(Hin + (size_t)t * D + soff + 8);
          if (p + 1 < 16) PEER_LOAD8(va, TV, 0, soff + 128);
          const unsigned hw[8] = {h0.x, h0.y, h0.z, h0.w, h1.x, h1.y, h1.z, h1.w}; unsigned ow[8];
#pragma unroll
          for (int e = 0; e < 8; ++e) { ow[e] = hw_pk2(bf_lo(hw[e]) + (float)acc[2 * e] * sc, bf_hi(hw[e]) + (float)acc[2 * e + 1] * sc); const float q0 = bf_lo(ow[e]), q1 = bf_hi(ow[e]); ss += q0 * q0 + q1 * q1; }
          v4u o0, o1; o0.x = ow[0]; o0.y = ow[1]; o0.z = ow[2]; o0.w = ow[3]; o1.x = ow[4]; o1.y = ow[5]; o1.z = ow[6]; o1.w = ow[7];
          if (!dry) { *(GAS v4u*)(Hout + (size_t)t * D + soff) = o0; *(GAS v4u*)(Hout + (size_t)t * D + soff + 8) = o1;
            if (H8) { v4u o8; unsigned q8[4];
#pragma unroll
              for (int e = 0; e < 4; ++e) { int x8 = __builtin_amdgcn_cvt_pk_fp8_f32(bf_lo(ow[2 * e]), bf_hi(ow[2 * e]), 0, false); x8 = __builtin_amdgcn_cvt_pk_fp8_f32(bf_lo(ow[2 * e + 1]), bf_hi(ow[2 * e + 1]), x8, true); q8[e] = (unsigned)x8; }
              o8.x = q8[0]; o8.y = q8[1]; o8.z = q8[2]; o8.w = q8[3]; *(GAS v4u*)(H8 + (size_t)t * D + soff) = o8; } } else asm volatile("" :: "v"(o0.x), "v"(o0.y), "v"(o0.z), "v"(o0.w), "v"(o1.x), "v"(o1.y), "v"(o1.z), "v"(o1.w)); }
    }
#undef PEER_VACC8
#undef PEER_LOAD8
    const float r3 = __builtin_amdgcn_rsqf(sum8_x1(ss) * (1.0f / D) + EPS);
    if (!dry && part == 0) RS3[t] = r3;
}


constexpr int N_PHASES = 19;
__global__ void __launch_bounds__(NTHREADS, 2) mega_fwd(Args args) {

    extern __shared__ __attribute__((aligned(16))) unsigned char lds[];
    Frame F;
    F.lds = (LAS unsigned char*)lds;
    F.MISC = (volatile LAS unsigned*)(F.lds + MISC_OFF);
    F.tid = threadIdx.x; F.lane = F.tid & 63; F.wave = __builtin_amdgcn_readfirstlane(F.tid >> 6);
    F.G = gridDim.x; { const int bx = blockIdx.x; F.vcu = (F.G % 8 == 0) ? (bx % 8) * (F.G / 8) + bx / 8 : bx; }
    unsigned char* ws = args.ws;
    F.ctl = (gu32*)(ws + WS_CTL);
    for (int u = F.tid; u < (LDS_BYTES - LDSCTL_OFF) / 4; u += NTHREADS) ((LAS unsigned*)(F.lds + LDSCTL_OFF))[u] = 0u;
    __syncthreads();
    const int lo = args.ph_lo, hi = args.ph_hi;
    XcdBarrier bar; bar.bar = (unsigned*)(F.ctl + CW_BAR); bar.x = 0; bar.st = nullptr;
    if (hi - lo > 1) bar = xcd_barrier_post((unsigned*)(F.ctl + CW_BAR), F.MISC + 8);
    bar.wave0 = (F.wave == 0);
#define IN(k) (lo <= (k) && (k) < hi)
#define REFRESH() do { int t_; asm volatile("v_mbcnt_lo_u32_b32 %0, -1, 0\n\tv_mbcnt_hi_u32_b32 %0, -1, %0" : "=v"(t_)); F.lane = t_; F.tid = F.wave * 64 + t_; } while (0)
#define REPS(k) (1 + ((DUP_MASK >> (k)) & 1))
#if PROBE_MASK
    unsigned long long* const tsb = (unsigned long long*)(ws + WS_CTL + 65536);
#define STAMP(k) do { if (blockIdx.x == 0 && F.tid == 0) __hip_atomic_store(tsb + (k), __builtin_amdgcn_s_memrealtime(), __ATOMIC_RELAXED, __HIP_MEMORY_SCOPE_AGENT); } while (0)
    STAMP(31);
#else
#define STAMP(k) do { } while (0)
#endif
#define DEFERRED_QUEUE(fn, ctrword) do { constexpr unsigned NQ_ = 1536u; for (;;) { if (F.tid == 0) F.MISC[0] = __hip_atomic_fetch_add(F.ctl + (ctrword), 1u, __ATOMIC_RELAXED, __HIP_MEMORY_SCOPE_AGENT); \
        __syncthreads(); const unsigned v_ = F.MISC[0]; __syncthreads(); if (v_ >= NQ_) break; fn(args, F, (int)v_, (int)NQ_); } } while (0)
#define SEAM(k) do { if (IN(k) && IN((k) + 1)) { if ((k) == 0) { if (gridDim.x == 123457u) cg::this_grid().sync(); xcd_barrier(bar); }      else { xcd_barrier(bar); if ((DUP_MASK >> 24) & 1) xcd_barrier(bar); } STAMP(k); } } while (0)
    float* rowss = (float*)(ws + WS_RSP);
    bf16* ACTA = (bf16*)(ws + WS_ACTA); bf16* ACTB = (bf16*)(ws + WS_ACTB); bf16* H1 = (bf16*)(ws + WS_H1); const float* RS3 = (const float*)(ws + WS_RS3);
    bf16* PROJ = (bf16*)(ws + WS_PROJ); bf16* SCB = (bf16*)(ws + WS_SC); bf16* PP = (bf16*)(ws + WS_PP);
    const int gtid = (F.vcu * NWAVES + F.wave) * 64 + F.lane, gthreads = F.G * NTHREADS;

#if UBENCH
    {
        typedef _Float16 h2_t __attribute__((ext_vector_type(2)));
        float a[32]; f32x2 p[16]; h2_t hh[32];
#pragma unroll
        for (int i = 0; i < 32; ++i) { a[i] = (float)(F.tid + i); hh[i] = (h2_t){(_Float16)(F.lane + i), (_Float16)i}; }
#pragma unroll
        for (int i = 0; i < 16; ++i) p[i] = (f32x2){a[2 * i], a[2 * i + 1]};
        const float m = 1.0f + 1e-7f * F.lane, c = 1e-9f; const f32x2 m2 = {m, m}, c2 = {c, c}; const h2_t mh = {(_Float16)1.0f, (_Float16)1.0f}, ch = {(_Float16)0.0f, (_Float16)0.0f};
#pragma unroll 1
        for (int it = 0; it < 10000; ++it) {
#if UBENCH == 1
#pragma unroll
            for (int i = 0; i < 32; ++i) asm volatile("v_fma_f32 %0, %0, %1, %2" : "+v"(a[i]) : "v"(m), "v"(c));
#elif UBENCH == 2
#pragma unroll
            for (int i = 0; i < 16; ++i) asm volatile("v_pk_fma_f32 %0, %0, %1, %2\n\tv_pk_fma_f32 %0, %0, %1, %2" : "+v"(p[i]) : "v"(m2), "v"(c2));
#elif UBENCH == 3
#pragma unroll
            for (int i = 0; i < 32; ++i) asm volatile("v_pk_fma_f16 %0, %0, %1, %2" : "+v"(hh[i]) : "v"(mh), "v"(ch));
#endif
        }
        float s = 0.f;
#pragma unroll
        for (int i = 0; i < 32; ++i) s += a[i] + (float)hh[i][0];
#pragma unroll
        for (int i = 0; i < 16; ++i) s += p[i][0] + p[i][1];
        if (s == 12345.678f) args.out[0] = s;
    }
#endif
    if (IN(0)) { REFRESH(); p0_prologue(args, F, 0); if (hi - lo > 1) { xcd_barrier(bar); REFRESH(); p0_prologue(args, F, 1); } } SEAM(0);
    if (IN(1)) for (int rep_ = 0; rep_ < REPS(1); ++rep_) { REFRESH();
#if EV_F8_T1 > EV_F8_T0
        if (EV_F8_T0 > 0) { constexpr int n_ = EV_F8_T0 * 256; pg8::Gemm g{ACTA, (const bf16*)(ws + WS_WEV_IN), T, n_, D}; pg8::StaticOrder S; S.init(T, n_, F.G, (int)blockIdx.x); EpiBf16S E{PROJ, PROJ_LD, nullptr};
          pg8::gemm_phase<EpiBf16S, pg8::StaticOrder, true, true>(F.lds + RING_OFF, g, S, E, F.wave); }
        { constexpr int n_ = (EV_F8_T1 - EV_F8_T0) * 256; pg8::Gemm g{(const bf16*)(ws + WS_H1), (const bf16*)(ws + WS_O + (size_t)EV_F8_T0 * 256 * D), T, n_, D / 2}; pg8::StaticOrder S; S.init(T, n_, F.G, (int)blockIdx.x); EpiBf16S E{PROJ + EV_F8_T0 * 256, PROJ_LD, nullptr};
          pg8::gemm_phase<EpiBf16S, pg8::StaticOrder, true, true, true>(F.lds + RING_OFF, g, S, E, F.wave); }
        if (EV_F8_T1 < EV_NP / 256) { constexpr int n_ = EV_NP - EV_F8_T1 * 256; pg8::Gemm g{ACTA, (const bf16*)(ws + WS_WEV_IN) + (size_t)EV_F8_T1 * 256 * D, T, n_, D}; pg8::StaticOrder S; S.init(T, n_, F.G, (int)blockIdx.x); EpiBf16S E{PROJ + EV_F8_T1 * 256, PROJ_LD, nullptr};
          pg8::gemm_phase<EpiBf16S, pg8::StaticOrder, true, true>(F.lds + RING_OFF, g, S, E, F.wave); }
        if (true) { const int g2 = F.G, c2 = (int)blockIdx.x;
#else
        { constexpr int NMAIN = (EV_N / 256) * 256;
          pg8::Gemm g{ACTA, (const bf16*)(ws + WS_WEV_IN), T, F.G == 256 ? NMAIN : EV_NP, D / 2}; pg8::StaticOrder S; S.init(T, F.G == 256 ? NMAIN : EV_NP, F.G, (int)blockIdx.x); EpiI8S E{PROJ, PROJ_LD, (const float*)(ws + WS_SA), (const float*)(ws + WS_CMB)};
          pg8::gemm_phase<EpiI8S, pg8::StaticOrder, true, true, false, true>(F.lds + RING_OFF, g, S, E, F.wave);
          if (F.G == 256) skinny_i8_cols(args, F, NMAIN); }
        if (F.G < 256) { const int g2 = F.G, c2 = (int)blockIdx.x;
#endif
          pg8::Gemm g{(const bf16*)(ws + WS_PBF), (const bf16*)(ws + WS_WPROJ), T, D, 256}; pg8::StaticOrder S; S.init(T, D, g2, c2); EpiBf16S E{PP, D, nullptr};
          pg8::gemm_phase<EpiBf16S, pg8::StaticOrder, true, true>(F.lds + RING_OFF, g, S, E, F.wave); }
    } SEAM(1);
    if (IN(2)) for (int rep_ = 0; rep_ < REPS(2); ++rep_) { REFRESH();
        if (F.G >= 256) {
            const int u = F.vcu;
            if (u < 64) scan_gla_mfma_unit<0>(args, F, u); else scan_gdn_mfma_unit(args, F, (u - 64) & 63, (u - 64) >> 6);
            __syncthreads();
            if (rep_ == 0 && u >= 64 && u < 128) {
                const int c = u - 64; bf16* pb = (bf16*)(ws + WS_PBF);
                cvt_f32_bf16(args.in[I_P] + (size_t)c * 65536, pb + (size_t)c * 65536, 65536, F.tid, NTHREADS);
                asm volatile("s_waitcnt vmcnt(0)" ::: "memory"); __syncthreads();
                pg8::Gemm g{pb, (const bf16*)(ws + WS_WPROJ), T, D, 256}; pg8::RowBlockOrder S{c, D / 256}; EpiBf16S E{PP, D, nullptr};
                pg8::gemm_phase<EpiBf16S, pg8::RowBlockOrder, true, true>(F.lds + RING_OFF, g, S, E, F.wave); }
            if (rep_ == 0) DEFERRED_QUEUE(p0_deferred, 1024);
        } else {
            for (int u = F.vcu; u < 64; u += F.G) { scan_gla_mfma_unit<0>(args, F, u); __syncthreads(); }
            for (int u = F.vcu; u < 64; u += F.G) { scan_gdn_mfma_unit(args, F, u, 0); __syncthreads(); scan_gdn_mfma_unit(args, F, u, 1); __syncthreads(); scan_gdn_mfma_unit(args, F, u, 2); __syncthreads(); }
            if (rep_ == 0) p0_deferred(args, F, F.vcu, F.G);
        }
    } SEAM(2);
    if (IN(3)) for (int rep_ = 0; rep_ < REPS(3); ++rep_) { REFRESH(); post_rows<0>(args, F); } SEAM(3);
    if (IN(4)) { REFRESH(); pg8::Gemm g{ACTA, (const bf16*)(ws + WS_WEV_OUT), T, D, D}; pg8::StaticOrder S; S.init(T, D, F.G, (int)blockIdx.x);
        EpiResid<false, true> E{args.in[I_X], ACTB, rowss + (size_t)RS_FFN0 * T * 32, nullptr, nullptr, nullptr, nullptr, nullptr};
        pg8::gemm_phase<EpiResid<false, true>, pg8::StaticOrder, true, true>(F.lds + RING_OFF, g, S, E, F.wave); }
#if (DUP_MASK >> 20) & 1
    if (IN(4)) { REFRESH(); pg8::Gemm g{ACTA, (const bf16*)(ws + WS_WEV_OUT), T, D, D}; pg8::StaticOrder S; S.init(T, D, F.G, (int)blockIdx.x);
        EpiResid<false, true> E{args.in[I_X], ACTB, rowss + (size_t)RS_FFN0 * T * 32, nullptr, nullptr, nullptr};
        pg8::gemm_phase<EpiResid<false, true>, pg8::StaticOrder, true, true>(F.lds + RING_OFF, g, S, E, F.wave); }
#endif
#if (DUP_MASK >> 21) & 1
    if (IN(4)) { REFRESH(); pg8::Gemm g{ACTA, (const bf16*)(ws + WS_WEV_IN), T, EV_NP, D}; pg8::StaticOrder S; S.init(T, EV_NP, F.G, (int)blockIdx.x); EpiBf16S E{PROJ, PROJ_LD, nullptr};
        pg8::gemm_phase<EpiBf16S, pg8::StaticOrder, true, true>(F.lds + RING_OFF, g, S, E, F.wave); }
#endif
    SEAM(4);
    if (IN(5)) for (int rep_ = 0; rep_ < REPS(5); ++rep_) { REFRESH(); { pg8::Gemm g{ACTB, (const bf16*)(ws + WS_WPEER), T, D, D}; pg8::StaticOrder S; S.init(T, D, F.G, (int)blockIdx.x); EpiBf16S E{SCB, D, rowss + (size_t)RS_FFN0 * T * 32};
        pg8::gemm_phase<EpiBf16S, pg8::StaticOrder, true, true>(F.lds + RING_OFF, g, S, E, F.wave); }
        } SEAM(5);
    if (IN(6)) for (int rep_ = 0; rep_ < REPS(6); ++rep_) { REFRESH(); peer_phase(args, F, 0, rep_ != 0, ACTB, H1, (unsigned char*)ACTA); } SEAM(6);
    if (IN(7)) { REFRESH(); { pg8::Gemm g{ACTA, (const bf16*)(ws + WS_WGATE), T, D, D / 2}; pg8::StaticOrder S; S.init(T, D, F.G, (int)blockIdx.x);
        EpiResid<true, false> E{H1, ACTB, rowss + (size_t)RS_MIX1 * T * 32, PP, RS3, (unsigned char*)ACTA + (size_t)T * D};
        pg8::gemm_phase<EpiResid<true, false>, pg8::StaticOrder, true, true, true>(F.lds + RING_OFF, g, S, E, F.wave); }
        } SEAM(7);
    if (IN(8)) for (int rep_ = 0; rep_ < REPS(8); ++rep_) { REFRESH();
        { pg8::Gemm g{(const bf16*)((const unsigned char*)ACTA + (size_t)T * D), (const bf16*)(ws + WS_WOD_IN), T, OD_NP, D / 2}; pg8::StaticOrder S; S.init(T, OD_NP, F.G, (int)blockIdx.x); EpiBf16S E{PROJ, PROJ_LD, rowss + (size_t)RS_MIX1 * T * 32};
          pg8::gemm_phase<EpiBf16S, pg8::StaticOrder, true, true, true>(F.lds + RING_OFF, g, S, E, F.wave); }
        if (F.G < 256) { pg8::Gemm g{(const bf16*)(ws + WS_PBF) + (size_t)T * 256, (const bf16*)(ws + WS_WPROJ) + (size_t)D * 256, T, D, 256}; pg8::StaticOrder S; S.init(T, D, F.G, (int)blockIdx.x); EpiBf16S E{PP, D, nullptr};
          pg8::gemm_phase<EpiBf16S, pg8::StaticOrder, true, true>(F.lds + RING_OFF, g, S, E, F.wave); }
    } SEAM(8);
    if (IN(9)) for (int rep_ = 0; rep_ < REPS(9); ++rep_) { REFRESH(); lora_prep_rows(args, F); } SEAM(9);
    if (IN(10)) for (int rep_ = 0; rep_ < REPS(10); ++rep_) { REFRESH();
        { pg8::Gemm g{(const bf16*)(ws + WS_LA), (const bf16*)(ws + WS_WLORA), T, 1024, LORA_K, 128}; pg8::StaticOrder S; S.init(T, 1024, F.G, (int)blockIdx.x); EpiBf16S E{(bf16*)(ws + WS_LO), LORA_N, nullptr};
          pg8::gemm_phase<EpiBf16S, pg8::StaticOrder, true, true>(F.lds + RING_OFF, g, S, E, F.wave); }
        { pg8::Gemm g{(const bf16*)(ws + WS_LA) + 64, (const bf16*)(ws + WS_WLORA) + (size_t)1024 * LORA_K + 64, T, 1024, LORA_K, 128}; pg8::StaticOrder S; S.init(T, 1024, F.G, (int)blockIdx.x); EpiBf16S E{(bf16*)(ws + WS_LO) + 1024, LORA_N, nullptr};
          pg8::gemm_phase<EpiBf16S, pg8::StaticOrder, true, true>(F.lds + RING_OFF, g, S, E, F.wave); }
        { pg8::Gemm g{(const bf16*)(ws + WS_LA) + 192, (const bf16*)(ws + WS_WLORA) + (size_t)2048 * LORA_K + 192, T, 1024, LORA_K, 256}; pg8::StaticOrder S; S.init(T, 1024, F.G, (int)blockIdx.x); EpiBf16S E{(bf16*)(ws + WS_LO) + 2048, LORA_N, nullptr};
          pg8::gemm_phase<EpiBf16S, pg8::StaticOrder, true, true>(F.lds + RING_OFF, g, S, E, F.wave); }
    } SEAM(10);
    if (IN(11)) for (int rep_ = 0; rep_ < REPS(11); ++rep_) { REFRESH();
        if (F.G >= 256) {
            const int u = F.vcu;
            if (u < 64) scan_gla_mfma_unit<1>(args, F, u); else scan_rwkv_mfma_unit(args, F, (u - 64) & 63, (u - 64) >> 6);
            __syncthreads();
            if (rep_ == 0 && u >= 64 && u < 128) {
                const int c = u - 64; bf16* pb = (bf16*)(ws + WS_PBF) + (size_t)T * 256;
                cvt_f32_bf16(args.in[I_P] + (size_t)T * 256 + (size_t)c * 65536, pb + (size_t)c * 65536, 65536, F.tid, NTHREADS);
                asm volatile("s_waitcnt vmcnt(0)" ::: "memory"); __syncthreads();
                pg8::Gemm g{pb, (const bf16*)(ws + WS_WPROJ) + (size_t)D * 256, T, D, 256}; pg8::RowBlockOrder S{c, D / 256}; EpiBf16S E{PP, D, nullptr};
                pg8::gemm_phase<EpiBf16S, pg8::RowBlockOrder, true, true>(F.lds + RING_OFF, g, S, E, F.wave); }
            if (rep_ == 0) DEFERRED_QUEUE(p1_deferred, 1025);
        } else {
            for (int u = F.vcu; u < 64; u += F.G) { scan_gla_mfma_unit<1>(args, F, u); __syncthreads(); }
            for (int u = F.vcu; u < 64; u += F.G) { scan_rwkv_mfma_unit(args, F, u, 0); __syncthreads(); scan_rwkv_mfma_unit(args, F, u, 1); __syncthreads(); scan_rwkv_mfma_unit(args, F, u, 2); __syncthreads(); }
            if (rep_ == 0) p1_deferred(args, F, F.vcu, F.G);
        }
    } SEAM(11);
    if (IN(13)) { REFRESH(); pg8::Gemm g{ACTA, (const bf16*)(ws + WS_WOD_OUT), T, D, D / 2}; pg8::StaticOrder S; S.init(T, D, F.G, (int)blockIdx.x);
        EpiResid<false, false> E{ACTB, H1, rowss + (size_t)RS_FFN1 * T * 32, nullptr, nullptr, nullptr};
        pg8::gemm_phase<EpiResid<false, false>, pg8::StaticOrder, true, true, true>(F.lds + RING_OFF, g, S, E, F.wave); } SEAM(13);
    if (IN(14)) for (int rep_ = 0; rep_ < REPS(14); ++rep_) { REFRESH(); pg8::Gemm g{H1, (const bf16*)(ws + WS_WPEER) + (size_t)D * D, T, D, D}; pg8::StaticOrder S; S.init(T, D, F.G, (int)blockIdx.x); EpiBf16S E{SCB, D, rowss + (size_t)RS_FFN1 * T * 32};
        pg8::gemm_phase<EpiBf16S, pg8::StaticOrder, true, true>(F.lds + RING_OFF, g, S, E, F.wave); } SEAM(14);
    if (IN(15)) for (int rep_ = 0; rep_ < REPS(15); ++rep_) { REFRESH(); peer_phase(args, F, 1, rep_ != 0, H1, ACTB, (unsigned char*)ACTA); } SEAM(15);
    if (IN(16)) { REFRESH(); pg8::Gemm g{ACTA, (const bf16*)(ws + WS_WGATE) + (size_t)D * D, T, D, D / 2}; pg8::StaticOrder S; S.init(T, D, F.G, (int)blockIdx.x);
        EpiResid<true, false> E{ACTB, H1, rowss + (size_t)RS_FINAL * T * 32, PP, RS3, nullptr};
        pg8::gemm_phase<EpiResid<true, false>, pg8::StaticOrder, true, true, true>(F.lds + RING_OFF, g, S, E, F.wave); } SEAM(16);
    if (IN(17)) { REFRESH();
        float oscale = 1.0f;
#if PROBE_MASK
        { unsigned long long t_prev = __hip_atomic_load(tsb + 31, __ATOMIC_RELAXED, __HIP_MEMORY_SCOPE_AGENT); const unsigned long long t_begin = t_prev; unsigned long long sel = 0ull;
          for (int k = 0; k <= 16; ++k) { const unsigned long long tk = __hip_atomic_load(tsb + k, __ATOMIC_RELAXED, __HIP_MEMORY_SCOPE_AGENT); if (tk == 0ull) continue; if ((PROBE_MASK >> k) & 1) sel += tk - t_prev; t_prev = tk; }
          (void)t_begin;
#if PROBE_SUB
          sel = 8ull * (__hip_atomic_load(tsb + PROBE_SUB, __ATOMIC_RELAXED, __HIP_MEMORY_SCOPE_AGENT) - __hip_atomic_load(tsb + PROBE_BASE, __ATOMIC_RELAXED, __HIP_MEMORY_SCOPE_AGENT));
#endif
          const unsigned long long t0_ = __builtin_amdgcn_s_memrealtime(); while (__builtin_amdgcn_s_memrealtime() - t0_ < 2ull * sel) __builtin_amdgcn_s_sleep(32); }
#endif
        final_rows(args, F, oscale, H1); }
#undef IN
#undef SEAM
#undef REFRESH
}

extern "C" void kernel_launch(void* const* d_in, const int* in_sizes, int n_in, void* d_out, int out_size, void* d_ws, size_t ws_size, hipStream_t stream) {
    static int grid = 0;
    if (grid == 0) {
        if (n_in != N_IN || out_size != T * D || ws_size < WS_END + 63 * MiB) { fprintf(stderr, "kernel_launch: unexpected problem: n_in %d out %d ws %zu (need %zu)\n", n_in, out_size, ws_size, (size_t)(WS_END + 63 * MiB)); grid = -1; return; }
        int dev = 0, cus = 0, per_cu = 0;
        if (hipGetDevice(&dev) != hipSuccess || hipDeviceGetAttribute(&cus, hipDeviceAttributeMultiprocessorCount, dev) != hipSuccess) { grid = -1; return; }
        if (hipFuncSetAttribute((const void*)mega_fwd, hipFuncAttributeMaxDynamicSharedMemorySize, LDS_BYTES) != hipSuccess) { fprintf(stderr, "kernel_launch: hipFuncSetAttribute failed\n"); grid = -1; return; }
        if (hipOccupancyMaxActiveBlocksPerMultiprocessor(&per_cu, (const void*)mega_fwd, NTHREADS, LDS_BYTES) != hipSuccess || per_cu < 1) { fprintf(stderr, "kernel_launch: occupancy query says %d blocks per CU\n", per_cu); (void)hipGetLastError(); grid = -1; return; }
        grid = cus;
    }
    if (grid < 0) return;
    (void)hipMemsetAsync((char*)d_ws + WS_CTL, 0, CTL_ZERO_BYTES, stream);
    Args a{};
    for (int i = 0; i < N_IN; ++i) a.in[i] = (const float*)d_in[i];
    a.out = (float*)d_out; a.ws = (unsigned char*)d_ws;
#if MK_PER_PHASE
    for (int p = 0; p < N_PHASES - 1; ++p) { a.ph_lo = p; a.ph_hi = p + 1; hipLaunchKernelGGL(mega_fwd, dim3(grid), dim3(NTHREADS), LDS_BYTES, stream, a); }
#else
    a.ph_lo = 0; a.ph_hi = N_PHASES;
    void* kargs[] = {&a};
    hipError_t e = hipLaunchCooperativeKernel((const void*)mega_fwd, dim3(grid), dim3(NTHREADS), kargs, LDS_BYTES, stream);
    if (e != hipSuccess) fprintf(stderr, "kernel_launch: cooperative launch failed: %s (grid %d)\n", hipGetErrorString(e), grid);
#endif
}
```
